# Optimizing an MI355X kernel written in HIP

```python
import jax
import jax.numpy as jnp
from jax import lax
import numpy as np

D_MODEL = 1024
BATCH = 8
SEQ = 4096
DEPTH = 2

F32 = jnp.float32

MIX_W = D_MODEL
N_GROUPS = 4
GROUP_W = MIX_W // N_GROUPS
HEAD_DIM = 64
N_HEADS_G = GROUP_W // HEAD_DIM
NORM_EPS = 1e-5
Q_BLOCK = 128

RET_CHUNK = 128
RET_THETA = 10000.0
RWKV_W_LORA = 32
RWKV_A_LORA = 32
RWKV_G_LORA = 64
RWKV_LN_EPS = 64e-5
DSA_Q_LORA = 128
DSA_KV_DIM = HEAD_DIM
IDX_HEADS = 8
IDX_DIM = 32
DSA_TOPK_MAX = 256
ROPE_THETA = 500000.0
ROPE_FRAC = 4
N_EXPERTS = 32
TOP_K = 4
D_FF = D_MODEL
SWIGLU_ALPHA = 1.702
SWIGLU_LIMIT = 7.0
MOE_BLOCK = 512

RET_COLS = 4 * GROUP_W
RWKV_COLS = 3 * GROUP_W + RWKV_W_LORA + RWKV_A_LORA + RWKV_G_LORA
DSA_COLS = DSA_Q_LORA + 2 * DSA_KV_DIM + IDX_DIM + IDX_HEADS
SB_COLS = 3 * GROUP_W
IN_COLS = RET_COLS + RWKV_COLS + DSA_COLS + SB_COLS
GROUP_SPLITS = (RET_COLS, RET_COLS + RWKV_COLS, RET_COLS + RWKV_COLS + DSA_COLS)
RWKV_SPLITS = (GROUP_W, 2 * GROUP_W, 3 * GROUP_W, 3 * GROUP_W + RWKV_W_LORA,
               3 * GROUP_W + RWKV_W_LORA + RWKV_A_LORA)
DSA_SPLITS = (DSA_Q_LORA, DSA_Q_LORA + DSA_KV_DIM, DSA_Q_LORA + 2 * DSA_KV_DIM,
              DSA_Q_LORA + 2 * DSA_KV_DIM + IDX_DIM)

kernel_name = 'hybrid_parallel_heads_moe_decoder'


def rms_norm(x, g, eps=NORM_EPS):
    xf = x.astype(F32)
    y = xf * lax.rsqrt(jnp.mean(xf * xf, axis=-1, keepdims=True) + eps)
    return (y * g.astype(F32)).astype(x.dtype)


def head_norm(x, g, eps):
    xf = x.astype(F32)
    xf = xf - jnp.mean(xf, axis=-1, keepdims=True)
    y = xf * lax.rsqrt(jnp.mean(xf * xf, axis=-1, keepdims=True) + eps)
    return (y.reshape(x.shape[:-2] + (-1,)) * g.astype(F32)).astype(x.dtype)


def rope(x, pos, rot_dim, theta):
    half = rot_dim // 2
    inv = theta ** (-jnp.arange(half, dtype=F32) / half)
    ang = pos.astype(F32)[..., None] * inv
    ang = ang.reshape(ang.shape[:2] + (1,) * (x.ndim - 3) + (half,))
    cos, sin = jnp.cos(ang), jnp.sin(ang)
    xr = x[..., :rot_dim].astype(F32)
    x1, x2 = xr[..., :half], xr[..., half:]
    rot = jnp.concatenate([x1 * cos - x2 * sin, x1 * sin + x2 * cos], axis=-1).astype(x.dtype)
    return jnp.concatenate([rot, x[..., rot_dim:]], axis=-1)


def retention(q, k, v, gate, pos, gn):
    B, S, H, d = q.shape
    q = rope(q, pos, d, RET_THETA)
    k = rope(k, pos, d, RET_THETA) * d ** -0.5
    lg = jnp.log(1.0 - 2.0 ** (-5.0 - jnp.arange(H, dtype=F32)))
    C = RET_CHUNK
    nc = S // C
    idx = jnp.arange(C, dtype=F32)
    diff = idx[:, None] - idx[None, :]
    decay_in = jnp.where(diff >= 0, jnp.exp(lg[:, None, None] * jnp.maximum(diff, 0.0)), 0.0)
    q_dec = jnp.exp(lg[:, None] * (idx + 1.0))
    k_dec = jnp.exp(lg[:, None] * (C - 1.0 - idx))
    chunk_dec = jnp.exp(lg * C)

    def to_chunks(t):
        return t.astype(F32).reshape(B, nc, C, H, d).transpose(1, 0, 3, 2, 4)

    def step(state, qkv):
        qc, kc, vc = qkv
        inner = jnp.einsum('bhnm,bhmv->bhnv', jnp.einsum('bhnd,bhmd->bhnm', qc, kc) * decay_in, vc)
        cross = jnp.einsum('bhnd,bhdv->bhnv', qc * q_dec[..., None], state)
        state = state * chunk_dec[:, None, None] + jnp.einsum('bhmd,bhmv->bhdv', kc * k_dec[..., None], vc)
        return state, inner + cross

    state0 = jnp.zeros((B, H, d, d), F32)
    _, out = lax.scan(step, state0, (to_chunks(q), to_chunks(k), to_chunks(v)))
    out = out.transpose(1, 0, 3, 2, 4).reshape(B, S, H, d).astype(v.dtype)
    return jax.nn.silu(gate) * head_norm(out, gn, NORM_EPS)


def token_shift(z, mu):
    prev = jnp.pad(z, ((0, 0), (1, 0), (0, 0)))[:, :-1]
    return z + (prev - z) * mu


def rwkv7(feats, w0, w2, a0, a2, g2, k_k, k_a, r_k, ln_g):
    B, S, _ = feats.shape
    H, d = N_HEADS_G, HEAD_DIM
    r, k, v, wd, ad, gd = jnp.split(feats, RWKV_SPLITS, axis=-1)
    w_log = -jax.nn.softplus(-(w0 + jnp.tanh(wd) @ w2)) - 0.5
    decay = jnp.exp(-jnp.exp(w_log.astype(F32)))
    a = jax.nn.sigmoid(a0 + ad @ a2)
    gate = jax.nn.sigmoid(gd) @ g2

    def heads(t):
        return t.reshape(B, S, H, d)

    kk = heads((k * k_k).astype(F32))
    kk = kk / jnp.maximum(jnp.sqrt(jnp.sum(kk * kk, axis=-1, keepdims=True)), 1e-12)
    k = k * (1.0 + (a - 1.0) * k_a)
    r_h, k_h, v_h, a_h = heads(r), heads(k), heads(v), heads(a)
    b_h = kk * a_h.astype(F32)

    def step(state, inp):
        rt, wt, kt, vt, kkt, bt = inp
        sa = jnp.einsum('bhvk,bhk->bhv', state, -kkt)
        state = (state * wt[:, :, None, :] + sa[..., None] * bt[:, :, None, :]
                 + vt[..., None] * kt[:, :, None, :])
        return state, jnp.einsum('bhvk,bhk->bhv', state, rt)

    def seq_first(t):
        return t.astype(F32).transpose(1, 0, 2, 3)

    state0 = jnp.zeros((B, H, d, d), F32)
    _, y = lax.scan(step, state0, (seq_first(r_h), seq_first(heads(decay)), seq_first(k_h),
                                   seq_first(v_h), seq_first(kk), seq_first(b_h)))
    y = y.transpose(1, 0, 2, 3).astype(feats.dtype)
    y = head_norm(y, ln_g, RWKV_LN_EPS)
    bonus = (jnp.sum(r_h * k_h * r_k, axis=-1, keepdims=True) * v_h).reshape(B, S, H * d)
    return (y + bonus) * gate


def dsa_attention(cq, k, v, k_idx, w_idx, pos, q_norm, wq_up, wqi_up, o_norm):
    B, S, _ = cq.shape
    H, d = N_HEADS_G, HEAD_DIM
    cq = rms_norm(cq, q_norm)
    q = rope((cq @ wq_up).reshape(B, S, H, d), pos, d // ROPE_FRAC, ROPE_THETA)
    qi = rope((cq @ wqi_up).reshape(B, S, IDX_HEADS, IDX_DIM), pos, IDX_DIM // ROPE_FRAC, ROPE_THETA)
    k = rope(k, pos, d // ROPE_FRAC, ROPE_THETA)
    k_idx = rope(k_idx, pos, IDX_DIM // ROPE_FRAC, ROPE_THETA)
    w_idx = w_idx * (IDX_HEADS ** -0.5 * IDX_DIM ** -0.5)
    topk = min(DSA_TOPK_MAX, S // 4)
    nb = S // Q_BLOCK
    key_pos = jnp.arange(S)

    def blocks(t):
        return t.reshape((B, nb, Q_BLOCK) + t.shape[2:]).swapaxes(0, 1)

    def gather_rows(table, sel):
        return jax.vmap(lambda tb, ib: tb[ib])(table, sel)

    def one_block(args):
        qb, qib, wb, start = args
        q_pos = start + jnp.arange(Q_BLOCK)
        rel = jax.nn.relu(jnp.einsum('bthe,bse->bths', qib, k_idx))
        score = jnp.einsum('bth,bths->bts', wb, rel).astype(F32)
        causal = key_pos[None, :] <= q_pos[:, None]
        score = jnp.where(causal[None], score, -jnp.inf)
        vals, sel = lax.top_k(score, topk)
        valid = jnp.isfinite(vals)
        kg = gather_rows(k, sel)
        vg = gather_rows(v, sel)
        logits = jnp.einsum('bthd,btkd->bthk', qb, kg).astype(F32) * d ** -0.5
        logits = jnp.where(valid[:, :, None, :], logits, -jnp.inf)
        p = jax.nn.softmax(logits, axis=-1).astype(vg.dtype)
        return jnp.einsum('bthk,btkd->bthd', p, vg)

    starts = jnp.arange(nb) * Q_BLOCK
    out = lax.map(one_block, (blocks(q), blocks(qi), blocks(w_idx), starts))
    out = out.swapaxes(0, 1).reshape(B, S, H * d)
    return rms_norm(out, o_norm)


def stick_breaking(q, k, v, o_norm):
    B, S, H, d = q.shape
    nb = S // Q_BLOCK
    key_pos = jnp.arange(S)

    def one_block(args):
        qb, start = args
        q_pos = start + jnp.arange(Q_BLOCK)
        z = jnp.einsum('bthd,bshd->bhts', qb, k).astype(F32) * d ** -0.5
        mask = (key_pos[None, :] < q_pos[:, None])[None, None]
        log_1m = jnp.where(mask, jax.nn.log_sigmoid(-z), 0.0)
        after = lax.cumsum(log_1m, axis=3, reverse=True) - log_1m
        A = jnp.where(mask, jnp.exp(jax.nn.log_sigmoid(z) + after), 0.0)
        return jnp.einsum('bhts,bshd->bthd', A.astype(v.dtype), v)

    q_blocks = q.reshape(B, nb, Q_BLOCK, H, d).swapaxes(0, 1)
    out = lax.map(one_block, (q_blocks, jnp.arange(nb) * Q_BLOCK))
    out = out.swapaxes(0, 1).reshape(B, S, H * d)
    return rms_norm(out, o_norm)


def clamped_swiglu(h):
    glu, lin = jnp.split(h, 2, axis=-1)
    glu = jnp.minimum(glu, SWIGLU_LIMIT)
    lin = jnp.clip(lin, -SWIGLU_LIMIT, SWIGLU_LIMIT)
    return glu * jax.nn.sigmoid(SWIGLU_ALPHA * glu) * (lin + 1.0)


def moe(h, router_w, router_b, w1, b1, w2, b2):
    B, S, D = h.shape
    n = B * S
    xt = h.reshape(n, D)
    logits = (xt @ router_w + router_b).astype(F32)
    top_val, top_idx = lax.top_k(logits, TOP_K)
    gate = jax.nn.softmax(top_val, axis=-1)
    n_assign = n * TOP_K
    expert = top_idx.reshape(-1).astype(jnp.int32)
    token = jnp.arange(n_assign, dtype=jnp.int32) // TOP_K
    weight = gate.reshape(-1)
    order = jnp.argsort(expert)
    expert_s, token_s, weight_s = expert[order], token[order], weight[order]
    counts = jnp.zeros((N_EXPERTS,), jnp.int32).at[expert].add(1)
    starts = jnp.cumsum(counts) - counts
    padded = (counts + MOE_BLOCK - 1) // MOE_BLOCK * MOE_BLOCK
    pad_end = jnp.cumsum(padded)
    pad_start = pad_end - padded
    dest = pad_start[expert_s] + jnp.arange(n_assign, dtype=jnp.int32) - starts[expert_s]
    n_blocks = -(-n_assign // MOE_BLOCK) + N_EXPERTS
    rows = n_blocks * MOE_BLOCK
    row_token = jnp.full((rows,), n, jnp.int32).at[dest].set(token_s)
    row_weight = jnp.zeros((rows,), F32).at[dest].set(weight_s)
    block_start = jnp.arange(n_blocks, dtype=jnp.int32) * MOE_BLOCK
    block_expert = jnp.minimum(jnp.sum(pad_end[None, :] <= block_start[:, None], axis=1), N_EXPERTS - 1)
    x_pad = jnp.concatenate([xt, jnp.zeros((1, D), xt.dtype)], axis=0)

    def one_block(args):
        tok, e = args
        hb = clamped_swiglu(x_pad[tok] @ w1[e] + b1[e])
        return hb @ w2[e] + b2[e]

    y = lax.map(one_block, (row_token.reshape(n_blocks, MOE_BLOCK), block_expert))
    y = y.reshape(rows, D) * row_weight[:, None].astype(y.dtype)
    out = jax.ops.segment_sum(y, row_token, num_segments=n + 1)[:n]
    return out.reshape(B, S, D)


def setup_inputs(seed: int = 0) -> dict:
    key = jax.random.key(seed)
    ks = list(jax.random.split(key, 40))
    kit = iter(ks)

    def nrm(shape, scale):
        return jax.random.normal(next(kit), shape, F32) * scale

    def gain(shape):
        return 1.0 + nrm(shape, 0.02)

    L = DEPTH
    x = nrm((BATCH, SEQ, D_MODEL), 1.0)
    c = nrm((BATCH, D_MODEL), 1.0)
    offsets = jax.random.randint(next(kit), (BATCH, 1), 0, 2048, dtype=jnp.int32)
    positions = offsets + jnp.arange(SEQ, dtype=jnp.int32)[None, :]
    return {
        'x': x,
        'c': c,
        'positions': positions,
        'ada_w': nrm((L, D_MODEL, 6 * D_MODEL), 0.5 * D_MODEL ** -0.5),
        'ada_b': nrm((L, 6 * D_MODEL), 0.02),
        'norm_mix': gain((L, D_MODEL)),
        'norm_ffn': gain((L, D_MODEL)),
        'w_in': nrm((L, D_MODEL, IN_COLS), D_MODEL ** -0.5),
        'ret_gn': gain((L, GROUP_W)),
        'rwkv_mu': jax.random.uniform(next(kit), (L, RWKV_COLS), F32, 0.0, 1.0),
        'rwkv_w0': jax.random.uniform(next(kit), (L, GROUP_W), F32, -6.5, -1.5),
        'rwkv_w2': nrm((L, RWKV_W_LORA, GROUP_W), 0.1),
        'rwkv_a0': nrm((L, GROUP_W), 0.5),
        'rwkv_a2': nrm((L, RWKV_A_LORA, GROUP_W), 0.1),
        'rwkv_g2': nrm((L, RWKV_G_LORA, GROUP_W), RWKV_G_LORA ** -0.5),
        'rwkv_kk': 0.85 + nrm((L, GROUP_W), 0.05),
        'rwkv_ka': 1.0 + nrm((L, GROUP_W), 0.05),
        'rwkv_rk': nrm((L, N_HEADS_G, HEAD_DIM), 0.1),
        'rwkv_ln': gain((L, GROUP_W)),
        'dsa_qnorm': gain((L, DSA_Q_LORA)),
        'dsa_wq_up': nrm((L, DSA_Q_LORA, GROUP_W), DSA_Q_LORA ** -0.5),
        'dsa_wqi_up': nrm((L, DSA_Q_LORA, IDX_HEADS * IDX_DIM), DSA_Q_LORA ** -0.5),
        'dsa_onorm': gain((L, GROUP_W)),
        'sb_onorm': gain((L, GROUP_W)),
        'w_out': nrm((L, MIX_W, D_MODEL), MIX_W ** -0.5),
        'router_w': nrm((L, D_MODEL, N_EXPERTS), D_MODEL ** -0.5),
        'router_b': nrm((L, N_EXPERTS), 0.01),
        'moe_w1': nrm((L, N_EXPERTS, D_MODEL, 2 * D_FF), D_MODEL ** -0.5),
        'moe_b1': nrm((L, N_EXPERTS, 2 * D_FF), 0.02),
        'moe_w2': nrm((L, N_EXPERTS, D_FF, D_MODEL), D_FF ** -0.5),
        'moe_b2': nrm((L, N_EXPERTS, D_MODEL), 0.02),
        'norm_final': gain((D_MODEL,)),
    }


def reference(x, c, positions, ada_w, ada_b, norm_mix, norm_ffn, w_in, ret_gn,
              rwkv_mu, rwkv_w0, rwkv_w2, rwkv_a0, rwkv_a2, rwkv_g2, rwkv_kk, rwkv_ka, rwkv_rk, rwkv_ln,
              dsa_qnorm, dsa_wq_up, dsa_wqi_up, dsa_onorm, sb_onorm, w_out,
              router_w, router_b, moe_w1, moe_b1, moe_w2, moe_b2, norm_final):
    B, S, D = x.shape
    H, d = N_HEADS_G, HEAD_DIM

    def heads(t):
        return t.reshape(B, S, H, d)

    cond = jax.nn.silu(c)
    for l in range(DEPTH):
        mod = cond @ ada_w[l] + ada_b[l]
        sh1, sc1, g1, sh2, sc2, g2 = jnp.split(mod[:, None, :], 6, axis=-1)
        h = rms_norm(x, norm_mix[l]) * (1.0 + sc1) + sh1
        proj = h @ w_in[l]
        ret_f, rwkv_f, dsa_f, sb_f = jnp.split(proj, GROUP_SPLITS, axis=-1)
        rq, rk, rv, rg = jnp.split(ret_f, 4, axis=-1)
        y_ret = retention(heads(rq), heads(rk), heads(rv), rg, positions, ret_gn[l])
        y_rwkv = rwkv7(token_shift(rwkv_f, rwkv_mu[l]), rwkv_w0[l], rwkv_w2[l], rwkv_a0[l], rwkv_a2[l],
                       rwkv_g2[l], rwkv_kk[l], rwkv_ka[l], rwkv_rk[l], rwkv_ln[l])
        cq, dk, dv, dki, dwi = jnp.split(dsa_f, DSA_SPLITS, axis=-1)
        y_dsa = dsa_attention(cq, dk, dv, dki, dwi, positions, dsa_qnorm[l], dsa_wq_up[l],
                              dsa_wqi_up[l], dsa_onorm[l])
        sq, sk, sv = jnp.split(sb_f, 3, axis=-1)
        y_sb = stick_breaking(heads(sq), heads(sk), heads(sv), sb_onorm[l])
        mixed = jnp.concatenate([y_ret, y_rwkv, y_dsa, y_sb], axis=-1) @ w_out[l]
        x = x + g1 * mixed
        h = rms_norm(x, norm_ffn[l]) * (1.0 + sc2) + sh2
        x = x + g2 * moe(h, router_w[l], router_b[l], moe_w1[l], moe_b1[l], moe_w2[l], moe_b2[l])
    return rms_norm(x, norm_final)
```

```cpp
#include <hip/hip_runtime.h>
#include <cstdio>
#include <cstdint>
#include <cmath>

#ifndef MK_N_LAUNCHES
#define MK_N_LAUNCHES 0
#endif

namespace pg8 {
#define PG8_LAS __attribute__((address_space(3)))
typedef unsigned short bf16_t;
typedef short bf16x8 __attribute__((ext_vector_type(8)));
typedef float f32x4 __attribute__((ext_vector_type(4)));
typedef unsigned u32x4 __attribute__((ext_vector_type(4)));
typedef unsigned u32x2 __attribute__((ext_vector_type(2)));
constexpr int BM = 256, BK = 64, HALF = 128, HTB = HALF * BK * 2  , STAGE_BYTES = 8 * HTB, NXCD = 8, WGM = 8;

__host__ __device__ __forceinline__ int lds_byte(int r, int c) { const int st = (r >> 4) * 2 + (c >> 5), rr = r & 15, cc = c & 31, ob = rr * 64 + cc * 2; return st * 1024 + (ob ^ (((ob >> 9) & 1) << 5)); }
__host__ __device__ __forceinline__ void stage_rc(int b, int& R, int& C) { const int st = b / 1024, sb = b % 1024, swz = sb ^ (((sb >> 9) & 1) << 5); R = (st >> 1) * 16 + swz / 64; C = (st & 1) * 32 + (swz % 64) / 2; }
__host__ __device__ __forceinline__ int perm32(int rho) { const int n = rho >> 4, i = rho & 15; return 8 * (i >> 2) + 4 * n + (i & 3); }

struct Unit { int pm, pn; };
struct Gemm { const bf16_t* A; const bf16_t* Bt; int M, N, K; };

struct StaticOrder {
    int nM, nN, nwg, G, c;
    __host__ __device__ void init(int M, int N, int G_, int c_) { nM = M / BM; nN = N / BM; nwg = nM * nN; G = G_; c = c_; }
    __host__ __device__ bool next(int i, Unit& u) const {
        const long L = (long)i * G + c; if (L >= nwg) return false;
        int wgid = (int)L; { const int q = nwg / NXCD, r = nwg % NXCD, xcd = wgid % NXCD, off = wgid / NXCD; wgid = (xcd < r ? xcd * (q + 1) : r * (q + 1) + (xcd - r) * q) + off; }
        const int nig = WGM * nN, gid = wgid / nig, fm = gid * WGM, gsz = (nM - fm) < WGM ? (nM - fm) : WGM;
        u.pm = fm + ((wgid % nig) % gsz); u.pn = (wgid % nig) / gsz; return true;
    }
    __device__ __forceinline__ void a_ready(const Unit&) const {}
    __device__ __forceinline__ void done(const Unit&) const {}
};
__device__ __forceinline__ unsigned cvt_pk_bf16(float lo, float hi) { unsigned r; asm volatile("v_cvt_pk_bf16_f32 %0, %1, %2" : "=v"(r) : "v"(lo), "v"(hi)); return r; }
struct EpiF32 {
    static constexpr bool PERM = false, AFTER_DRAIN = false;
    float* C; int ldc;
    __device__ __forceinline__ void operator()(const f32x4 (&acc)[2][2][4][2], const Unit& u, int wr, int wc, int fr, int fq) const {
        const int row0 = u.pm * BM + wr * 64 + fr, col0 = u.pn * BM + wc * 32 + 4 * fq;
#pragma unroll
        for (int ai = 0; ai < 2; ++ai)
#pragma unroll
            for (int m = 0; m < 4; ++m) { float* rowp = C + (size_t)(row0 + ai * HALF + m * 16) * ldc + col0;
#pragma unroll
                for (int bj = 0; bj < 2; ++bj)
#pragma unroll
                    for (int n = 0; n < 2; ++n) *(f32x4*)(rowp + bj * HALF + n * 16) = acc[ai][bj][m][n]; }
    }
};
struct EpiRes {
    static constexpr bool PERM = false, AFTER_DRAIN = false;
    const float* xin; float* xout; const float* gate;
    __device__ __forceinline__ void operator()(const f32x4 (&acc)[2][2][4][2], const Unit& u, int wr, int wc, int fr, int fq) const {
        const int row0 = u.pm * BM + wr * 64 + fr, col0 = u.pn * BM + wc * 32 + 4 * fq;
        const float* gp = gate + (size_t)((u.pm * BM) >> 12) * 6144 + col0;
        f32x4 gv[2][2];
#pragma unroll
        for (int bj = 0; bj < 2; ++bj)
#pragma unroll
            for (int n = 0; n < 2; ++n) gv[bj][n] = *(const f32x4*)(gp + bj * HALF + n * 16);
#pragma unroll
        for (int ai = 0; ai < 2; ++ai)
#pragma unroll
            for (int m = 0; m < 4; ++m) { const size_t ro = (size_t)(row0 + ai * HALF + m * 16) * 1024 + col0;
#pragma unroll
                for (int bj = 0; bj < 2; ++bj)
#pragma unroll
                    for (int n = 0; n < 2; ++n) { const f32x4 xv = *(const f32x4*)(xin + ro + bj * HALF + n * 16); *(f32x4*)(xout + ro + bj * HALF + n * 16) = xv + gv[bj][n] * acc[ai][bj][m][n]; } }
    }
};
__device__ __forceinline__ float swiglu1(float glu, float lin) {
    glu = fminf(glu, 7.0f); lin = fminf(fmaxf(lin, -7.0f), 7.0f);
    return glu * (1.0f / (1.0f + __expf(-1.702f * glu))) * (lin + 1.0f);
}
struct EpiSwiglu {
    static constexpr bool PERM = true, AFTER_DRAIN = false;
    bf16_t* O; const float* b1;
    __device__ __forceinline__ void operator()(const f32x4 (&acc)[2][2][4][2], const Unit& u, int wr, int wc, int fr, int fq) const {
        const int e = u.pn >> 3, j = u.pn & 7, row0 = u.pm * BM + wr * 64 + fr, c0 = 128 * j + wc * 32 + 8 * fq;
        const float* bp = b1 + (size_t)e * 2048 + c0;
        f32x4 bg[2], bl[2];
#pragma unroll
        for (int n = 0; n < 2; ++n) { bg[n] = *(const f32x4*)(bp + 4 * n); bl[n] = *(const f32x4*)(bp + 1024 + 4 * n); }
#pragma unroll
        for (int ai = 0; ai < 2; ++ai)
#pragma unroll
            for (int m = 0; m < 4; ++m) { bf16_t* rowp = O + (size_t)(row0 + ai * HALF + m * 16) * 1024 + c0;
                const f32x4 g0 = acc[ai][0][m][0] + bg[0], g1 = acc[ai][0][m][1] + bg[1], l0 = acc[ai][1][m][0] + bl[0], l1 = acc[ai][1][m][1] + bl[1];
                u32x4 w;
                w.x = cvt_pk_bf16(swiglu1(g0[0], l0[0]), swiglu1(g0[1], l0[1])); w.y = cvt_pk_bf16(swiglu1(g0[2], l0[2]), swiglu1(g0[3], l0[3]));
                w.z = cvt_pk_bf16(swiglu1(g1[0], l1[0]), swiglu1(g1[1], l1[1])); w.w = cvt_pk_bf16(swiglu1(g1[2], l1[2]), swiglu1(g1[3], l1[3]));
                *(u32x4*)rowp = w; }
    }
};
struct EpiY {
    static constexpr bool PERM = true, AFTER_DRAIN = false;
    bf16_t* O; const float* b2;
    __device__ __forceinline__ void operator()(const f32x4 (&acc)[2][2][4][2], const Unit& u, int wr, int wc, int fr, int fq) const {
        const int e = u.pn >> 2, j = u.pn & 3, row0 = u.pm * BM + wr * 64 + fr, c0 = 256 * j + wc * 32 + 8 * fq;
        const float* bp = b2 + (size_t)e * 1024 + c0;
        f32x4 bv[2][2];
#pragma unroll
        for (int bj = 0; bj < 2; ++bj)
#pragma unroll
            for (int n = 0; n < 2; ++n) bv[bj][n] = *(const f32x4*)(bp + bj * HALF + 4 * n);
#pragma unroll
        for (int ai = 0; ai < 2; ++ai)
#pragma unroll
            for (int m = 0; m < 4; ++m) { bf16_t* rowp = O + (size_t)(row0 + ai * HALF + m * 16) * 1024 + c0;
#pragma unroll
                for (int bj = 0; bj < 2; ++bj) { const f32x4 v0 = acc[ai][bj][m][0] + bv[bj][0], v1 = acc[ai][bj][m][1] + bv[bj][1];
                    u32x4 w; w.x = cvt_pk_bf16(v0[0], v0[1]); w.y = cvt_pk_bf16(v0[2], v0[3]); w.z = cvt_pk_bf16(v1[0], v1[1]); w.w = cvt_pk_bf16(v1[2], v1[3]);
                    *(u32x4*)(rowp + bj * HALF) = w; } }
    }
};
struct MoeOrder {
    const PG8_LAS int* tstart; int NJ, G, c;
    __device__ __forceinline__ bool next(int i, Unit& u) const {
        const int T = tstart[32]; const long L = (long)i * G + c; if (L >= (long)T * NJ) return false;
        const int pm = (int)(L / NJ), j = (int)(L % NJ); int e = 0;
#pragma unroll
        for (int k = 1; k < 32; ++k) e += (tstart[k] <= pm) ? 1 : 0;
        u.pm = pm; u.pn = e * NJ + j; return true;
    }
    __device__ __forceinline__ void a_ready(const Unit&) const {}
    __device__ __forceinline__ void done(const Unit&) const {}
};

template <class Epi, class Sched, bool ALIGN_EPI = false, bool SP2 = false>
__device__ __forceinline__ void gemm_phase(PG8_LAS unsigned char* lds, const Gemm g, const Sched& S, const Epi& E) {
    const int tid = threadIdx.x, wid = __builtin_amdgcn_readfirstlane(tid >> 6), lane = tid & 63, wr = wid >> 2, wc = wid & 3, fr = lane & 15, fq = lane >> 4;
    const int K = g.K, nt = K / BK;
    unsigned voffA[2], voffB[2];
#pragma unroll
    for (int i = 0; i < 2; ++i) { int R, C; stage_rc(tid * 16 + i * 8192, R, C); const int Rb = Epi::PERM ? ((R & ~31) + perm32(R & 31)) : R;
        voffA[i] = (unsigned)(R * K + C) * 2u; voffB[i] = (unsigned)(Rb * K + C) * 2u; }
    const size_t kstep = (size_t)(BK * 2);
    const size_t hstep = (size_t)HALF * K * 2;
    const size_t tstep = 2 * hstep;
    const unsigned ldsw = (unsigned)wid * 1024u;
    const int aoff = lds_byte(wr * 64 + fr, fq * 8), boff = lds_byte(wc * 32 + fr, fq * 8);
#define PG8_SA(b, h) (((b) * 2 + (h)) * HTB)
#define PG8_SB(b, h) ((4 + (b) * 2 + (h)) * HTB)
#define PG8_STAGE(bufoff, gbase, voff) do { _Pragma("unroll") for (int _i = 0; _i < 2; ++_i) \
        __builtin_amdgcn_global_load_lds((const unsigned*)((const char*)(gbase) + (voff)[_i]), (PG8_LAS unsigned*)(lds + (bufoff) + ldsw + _i * 8192), 16, 0, 0); } while (0)
#define PG8_LDA(dst, b, h) do { _Pragma("unroll") for (int m = 0; m < 4; ++m) _Pragma("unroll") for (int k = 0; k < 2; ++k) dst[m][k] = *(const PG8_LAS bf16x8*)(lds + PG8_SA(b, h) + aoff + m * 2048 + k * 1024); } while (0)
#define PG8_LDB(dst, b, h) do { _Pragma("unroll") for (int n = 0; n < 2; ++n) _Pragma("unroll") for (int k = 0; k < 2; ++k) dst[n][k] = *(const PG8_LAS bf16x8*)(lds + PG8_SB(b, h) + boff + n * 2048 + k * 1024); } while (0)
#define PG8_MMA(ai, bj, At, Bt) do { __builtin_amdgcn_s_setprio(1); _Pragma("unroll") for (int m = 0; m < 4; ++m) _Pragma("unroll") for (int n = 0; n < 2; ++n) _Pragma("unroll") for (int k = 0; k < 2; ++k) \
        acc[ai][bj][m][n] = __builtin_amdgcn_mfma_f32_16x16x32_bf16(Bt[n][k], At[m][k], acc[ai][bj][m][n], 0, 0, 0); __builtin_amdgcn_s_setprio(0); } while (0)
#define PG8_WAIT_V(n) asm volatile("s_waitcnt vmcnt(" #n ")" ::: "memory")
#define PG8_WAIT_L(n) asm volatile("s_waitcnt lgkmcnt(" #n ")" ::: "memory")
#define PG8_BAR __builtin_amdgcn_s_barrier()
#define PG8_SCHED __builtin_amdgcn_sched_barrier(0)
    Unit cur, nxt; int ui = 0;
    if (!S.next(0, cur)) return;
    f32x4 acc[2][2][4][2];
#pragma unroll
    for (int a = 0; a < 2; ++a)
#pragma unroll
        for (int b = 0; b < 2; ++b)
#pragma unroll
            for (int m = 0; m < 4; ++m)
#pragma unroll
                for (int n = 0; n < 2; ++n) acc[a][b][m][n] = (f32x4){0.f, 0.f, 0.f, 0.f};
    bf16x8 At[4][2], B0[2][2], B1[2][2];
    const char* cA = (const char*)g.A + (size_t)cur.pm * tstep; const char* cB = (const char*)g.Bt + (size_t)cur.pn * tstep;
    S.a_ready(cur);
    if constexpr (SP2) {
        PG8_STAGE(PG8_SB(0, 0), cB, voffB); PG8_STAGE(PG8_SB(0, 1), cB + hstep, voffB); PG8_STAGE(PG8_SA(0, 0), cA, voffA); PG8_STAGE(PG8_SA(0, 1), cA + hstep, voffA);
        if (wr == 1) PG8_BAR;
        PG8_WAIT_V(2); PG8_BAR;
        PG8_STAGE(PG8_SB(1, 0), cB + kstep, voffB); PG8_STAGE(PG8_SA(1, 0), cA + kstep, voffA); PG8_STAGE(PG8_SB(1, 1), cB + hstep + kstep, voffB);
        PG8_WAIT_V(6); PG8_BAR;
    } else {
        PG8_STAGE(PG8_SB(0, 0), cB, voffB); PG8_STAGE(PG8_SA(0, 0), cA, voffA); PG8_STAGE(PG8_SB(0, 1), cB + hstep, voffB); PG8_STAGE(PG8_SA(0, 1), cA + hstep, voffA);
        if (wr == 1) PG8_BAR;
        PG8_WAIT_V(4); PG8_BAR;
        PG8_STAGE(PG8_SB(1, 0), cB + kstep, voffB); PG8_STAGE(PG8_SA(1, 0), cA + kstep, voffA); PG8_STAGE(PG8_SB(1, 1), cB + hstep + kstep, voffB);
        PG8_WAIT_V(6); PG8_BAR;
    }
    for (;;) {
        const bool has_next = S.next(ui + 1, nxt);
        const char* nA = has_next ? (const char*)g.A + (size_t)nxt.pm * tstep : cA; const char* nB = has_next ? (const char*)g.Bt + (size_t)nxt.pn * tstep : cB;
        for (int t = 0; t < nt; t += 2) {
            const bool last = (t == nt - 2);
            const char* a1 = cA + (size_t)(t + 1) * kstep;
            const char* a2 = last ? nA : cA + (size_t)(t + 2) * kstep; const char* b2 = last ? nB : cB + (size_t)(t + 2) * kstep;
            const char* a3 = a2 + kstep; const char* b3 = b2 + kstep;
            if (last && has_next) S.a_ready(nxt);
            if constexpr (SP2) {
            PG8_LDB(B0, 0, 0); PG8_LDB(B1, 0, 1); PG8_SCHED; PG8_LDA(At, 0, 0); PG8_STAGE(PG8_SA(1, 1), a1 + hstep, voffA);
            PG8_WAIT_V(8); PG8_WAIT_L(0); PG8_BAR; PG8_MMA(0, 0, At, B0); PG8_MMA(0, 1, At, B1); PG8_BAR; PG8_SCHED;
            PG8_LDA(At, 0, 1); PG8_STAGE(PG8_SB(0, 0), b2, voffB); PG8_STAGE(PG8_SB(0, 1), b2 + hstep, voffB); PG8_STAGE(PG8_SA(0, 0), a2, voffA);
            PG8_WAIT_V(8); PG8_WAIT_L(0); PG8_BAR; PG8_MMA(1, 0, At, B0); PG8_MMA(1, 1, At, B1); PG8_BAR; PG8_SCHED;
            PG8_LDB(B0, 1, 0); PG8_LDB(B1, 1, 1); PG8_SCHED; PG8_LDA(At, 1, 0); PG8_STAGE(PG8_SA(0, 1), a2 + hstep, voffA);
            PG8_WAIT_V(8); PG8_WAIT_L(0); PG8_BAR; PG8_MMA(0, 0, At, B0); PG8_MMA(0, 1, At, B1); PG8_BAR; PG8_SCHED;
            PG8_LDA(At, 1, 1); PG8_STAGE(PG8_SB(1, 0), b3, voffB); PG8_STAGE(PG8_SB(1, 1), b3 + hstep, voffB); PG8_STAGE(PG8_SA(1, 0), a3, voffA);
            PG8_WAIT_V(8); PG8_WAIT_L(0); PG8_BAR; PG8_MMA(1, 0, At, B0); PG8_MMA(1, 1, At, B1); PG8_BAR; PG8_SCHED;
            } else {
            PG8_LDB(B0, 0, 0); PG8_SCHED; PG8_LDA(At, 0, 0); PG8_STAGE(PG8_SA(1, 1), a1 + hstep, voffA);
            PG8_WAIT_L(8); PG8_BAR; PG8_WAIT_L(0); PG8_MMA(0, 0, At, B0); PG8_BAR; PG8_SCHED;
            PG8_LDB(B1, 0, 1); PG8_STAGE(PG8_SB(0, 0), b2, voffB);
            PG8_BAR; PG8_WAIT_L(0); PG8_MMA(0, 1, At, B1); PG8_BAR;
            PG8_LDA(At, 0, 1); PG8_STAGE(PG8_SA(0, 0), a2, voffA);
            PG8_BAR; PG8_WAIT_L(0); PG8_MMA(1, 0, At, B0); PG8_BAR; PG8_SCHED;
            PG8_STAGE(PG8_SB(0, 1), b2 + hstep, voffB);
            PG8_WAIT_V(6); PG8_BAR; PG8_MMA(1, 1, At, B1); PG8_BAR;
            PG8_LDB(B0, 1, 0); PG8_SCHED; PG8_LDA(At, 1, 0); PG8_STAGE(PG8_SA(0, 1), a2 + hstep, voffA);
            PG8_WAIT_L(8); PG8_BAR; PG8_WAIT_L(0); PG8_MMA(0, 0, At, B0); PG8_BAR; PG8_SCHED;
            PG8_LDB(B1, 1, 1); PG8_STAGE(PG8_SB(1, 0), b3, voffB);
            PG8_BAR; PG8_WAIT_L(0); PG8_MMA(0, 1, At, B1); PG8_BAR;
            PG8_LDA(At, 1, 1); PG8_STAGE(PG8_SA(1, 0), a3, voffA);
            PG8_BAR; PG8_WAIT_L(0); PG8_MMA(1, 0, At, B0); PG8_BAR; PG8_SCHED;
            PG8_STAGE(PG8_SB(1, 1), b3 + hstep, voffB);
            PG8_WAIT_V(6); PG8_BAR; PG8_MMA(1, 1, At, B1); PG8_BAR;
            }
        }
        if constexpr (ALIGN_EPI) { if (wr == 0) PG8_BAR; }
        if constexpr (!Epi::AFTER_DRAIN) { E(acc, cur, wr, wc, fr, fq); S.done(cur); }
        if (!has_next) break;
#pragma unroll
        for (int a = 0; a < 2; ++a)
#pragma unroll
            for (int b = 0; b < 2; ++b)
#pragma unroll
                for (int m = 0; m < 4; ++m)
#pragma unroll
                    for (int n = 0; n < 2; ++n) acc[a][b][m][n] = (f32x4){0.f, 0.f, 0.f, 0.f};
        cur = nxt; cA = nA; cB = nB; ++ui;
        if constexpr (ALIGN_EPI) { if (wr == 1) PG8_BAR; }
    }
    PG8_WAIT_V(0);
    if constexpr (!ALIGN_EPI) { if (wr == 0) PG8_BAR; }
    PG8_BAR;
    if constexpr (Epi::AFTER_DRAIN) { E.fused(acc, cur, wr, wc, fr, fq, lds, wid, lane); S.done(cur); }
#undef PG8_SA
#undef PG8_SB
#undef PG8_STAGE
#undef PG8_LDA
#undef PG8_LDB
#undef PG8_MMA
#undef PG8_WAIT_V
#undef PG8_WAIT_L
#undef PG8_BAR
#undef PG8_SCHED
}
}

constexpr int NWAVES = 8;
constexpr int NB = 8, SEQ = 4096, DM = 1024, MTOK = NB * SEQ, NLAYER = 2;
constexpr int INC = 2984, INCP = 3072;
constexpr int C_RET = 0, C_RW = 1024, C_DSA = 1920, C_SB = 2216;
constexpr int NEXP = 32, MOE_ROWS = MTOK * 4 + NEXP * 256;
constexpr int ROPE_W = 88;
constexpr int NPL = 12, NPHASE = 1 + NLAYER * NPL;
enum { I_X = 0, I_C, I_POS, I_ADAW, I_ADAB, I_NMIX, I_NFFN, I_WIN, I_RETGN, I_MU, I_W0, I_W2, I_A0, I_A2, I_G2, I_KK, I_KA, I_RK, I_LN, I_QNORM, I_WQ, I_WQI, I_DONORM, I_SONORM, I_WOUT, I_RW, I_RB, I_MW1, I_MB1, I_MW2, I_MB2, I_NFINAL, N_IN };

constexpr size_t MiB = 1u << 20;
constexpr size_t WS_CTL = 0, CTL_ZERO_BYTES = 1 * MiB;
constexpr size_t WS_MOD = 1 * MiB, WS_ROPE = 2 * MiB, WS_WIN = 14 * MiB, WS_WOUT = 26 * MiB, WS_W1 = 30 * MiB, WS_W2 = 286 * MiB;
constexpr size_t WS_XA = 414 * MiB, WS_H = 542 * MiB, WS_MIX = 606 * MiB, WS_TOPI = 670 * MiB, WS_TOPW = 671 * MiB, WS_POS = 672 * MiB;
constexpr size_t WS_R = 674 * MiB;
constexpr size_t WS_P = WS_R, WS_RWA = 1058 * MiB  , WS_DQ = 1314 * MiB, WS_DQI = 1346 * MiB, WS_DK = 1378 * MiB, WS_DV = 1386 * MiB, WS_DKI = 1394 * MiB, WS_DW = 1398 * MiB;
constexpr size_t WS_YO = 1400 * MiB  , WS_SC = 1528 * MiB  ;
constexpr size_t WS_XS = WS_R  , WS_ACT = 946 * MiB  ;
constexpr size_t WS_END = 2040 * MiB;
static_assert((size_t)MOE_ROWS * 2048 <= 272 * MiB, "moe buffers");
constexpr int CW_TMO = 0, CW_CODE = 1, CW_BAR = 4096, CW_CNT = 8192  , CW_CUR = 8320  ;
constexpr int RING_BYTES = 131072, MISC_OFF = RING_BYTES + 320, TST_OFF = RING_BYTES + 1024  , LDS_BYTES = 147456;

#define GAS __attribute__((address_space(1)))
#define LAS __attribute__((address_space(3)))
typedef unsigned short bf16;
typedef unsigned v4u __attribute__((ext_vector_type(4)));
typedef unsigned v2u __attribute__((ext_vector_type(2)));
typedef float f32x4 __attribute__((ext_vector_type(4)));
typedef GAS unsigned gu32;
#define RLX_AGENT __ATOMIC_RELAXED, __HIP_MEMORY_SCOPE_AGENT
#define LDS_WAIT() asm volatile("s_waitcnt lgkmcnt(0)" ::: "memory")
#define VM_WAIT() asm volatile("s_waitcnt vmcnt(0)" ::: "memory")
__device__ __forceinline__ unsigned f2bf(float f) { unsigned u = __builtin_bit_cast(unsigned, f); return (u + 0x7fffu + ((u >> 16) & 1u)) >> 16; }
__device__ __forceinline__ unsigned pk2(float lo, float hi) { return f2bf(lo) | (f2bf(hi) << 16); }
__device__ __forceinline__ float bf_lo(unsigned w) { return __builtin_bit_cast(float, w << 16); }
__device__ __forceinline__ float bf_hi(unsigned w) { return __builtin_bit_cast(float, w & 0xffff0000u); }
__device__ __forceinline__ float wave_sum(float v) {
#pragma unroll
    for (int o = 1; o < 64; o <<= 1) v += __shfl_xor(v, o);
    return v;
}
__device__ __forceinline__ float wave_max(float v) {
#pragma unroll
    for (int o = 1; o < 64; o <<= 1) v = fmaxf(v, __shfl_xor(v, o));
    return v;
}
__device__ __forceinline__ float grp16_sum(float v) { v += __shfl_xor(v, 1); v += __shfl_xor(v, 2); v += __shfl_xor(v, 4); v += __shfl_xor(v, 8); return v; }
__device__ __forceinline__ float grp8_sum(float v) { v += __shfl_xor(v, 1); v += __shfl_xor(v, 2); v += __shfl_xor(v, 4); return v; }
__device__ __forceinline__ float sum4(f32x4 a) { return (a.x + a.y) + (a.z + a.w); }
__device__ __forceinline__ float dot4(f32x4 a, f32x4 b) { return (a.x * b.x + a.y * b.y) + (a.z * b.z + a.w * b.w); }
__device__ __forceinline__ float sigm(float x) { return 1.0f / (1.0f + expf(-x)); }
__device__ __forceinline__ float softplusf(float x) { return fmaxf(x, 0.0f) + log1pf(expf(-fabsf(x))); }
__device__ __forceinline__ f32x4 shx4(f32x4 v, int m) { f32x4 r; r.x = __shfl_xor(v.x, m); r.y = __shfl_xor(v.y, m); r.z = __shfl_xor(v.z, m); r.w = __shfl_xor(v.w, m); return r; }

#define XB_TMO      128
#define XB_XCNT(j)  (256  + 64 * (j))
#define XB_XSUB(j)  (1280 + 64 * (j))
#define XB_XGEN(j)  (2304 + 64 * (j))
#define XB_TOP      3328
#define XB_TOPGEN   3392
#define XCD_BAR_WORDS 3456
#define XB_SPIN_CAP (1u << 18)

__device__ __forceinline__ unsigned xb_ld(unsigned* p)              { return __hip_atomic_load(p, __ATOMIC_RELAXED, __HIP_MEMORY_SCOPE_AGENT); }
__device__ __forceinline__ unsigned xb_add(unsigned* p, unsigned v) { return __hip_atomic_fetch_add(p, v, __ATOMIC_RELAXED, __HIP_MEMORY_SCOPE_AGENT); }
__device__ __forceinline__ unsigned xb_xcc_id() { return (unsigned)__builtin_amdgcn_s_getreg((3 << 11) | 20) & 0xFu; }
#define XB_SPIN(cond, bar) do { unsigned _sp = 0; while (cond) { __builtin_amdgcn_s_sleep(1); \
    if ((++_sp & 255u) == 0u) { if (xb_ld(&(bar)[XB_TMO])) break; if (_sp > XB_SPIN_CAP) { atomicAdd(&(bar)[XB_TMO], 1u); break; } } } } while (0)

struct XcdBarrier {
    unsigned* bar; unsigned x;
    volatile LAS unsigned* st;
};

__device__ __forceinline__ XcdBarrier xcd_barrier_post(unsigned* bar, volatile LAS unsigned* st) {
    XcdBarrier b; b.bar = bar; b.x = xb_xcc_id(); b.st = st;
    if (threadIdx.x == 0) (void)xb_add(&bar[XB_XCNT(b.x)], 1u);
    return b;
}
__device__ __forceinline__ void xcd_barrier_complete(unsigned* bar, unsigned x, unsigned& nloc, unsigned& nx) {
    const unsigned G = gridDim.x * gridDim.y * gridDim.z;
    unsigned sum, cnt, mine, sp = 0u;
    for (;;) {
        sum = 0u; cnt = 0u; mine = 0u;
#pragma unroll
        for (unsigned j = 0; j < 16; ++j) { const unsigned c = xb_ld(&bar[XB_XCNT(j)]); sum += c; cnt += (c > 0u) ? 1u : 0u; mine = (j == x) ? c : mine; }
        if (sum == G) break;
        __builtin_amdgcn_s_sleep(1);
        if ((++sp & 255u) == 0u) { if (xb_ld(&bar[XB_TMO])) break; if (sp > XB_SPIN_CAP) { atomicAdd(&bar[XB_TMO], 1u); break; } }
    }
    nloc = mine > 0u ? mine : 1u; nx = cnt > 0u ? cnt : 1u;
}

__device__ __forceinline__ void xcd_barrier(const XcdBarrier& b) {
    asm volatile("s_waitcnt vmcnt(0)" ::: "memory");
    __syncthreads();
    if (threadIdx.x == 0) {
        unsigned* bar = b.bar;
        __builtin_amdgcn_s_waitcnt(0);
        unsigned nloc = b.st[0], nx = b.st[1];
        if (nloc == 0u) { xcd_barrier_complete(bar, b.x, nloc, nx); b.st[0] = nloc; b.st[1] = nx; }
        const unsigned old = xb_add(&bar[XB_XSUB(b.x)], 1u);
        const unsigned gen = old / nloc;
        if (old + 1u == (gen + 1u) * nloc) {
            __builtin_amdgcn_fence(__ATOMIC_RELEASE, "agent");
            asm volatile("s_waitcnt vmcnt(0)" ::: "memory");
            const unsigned og = xb_add(&bar[XB_TOP], 1u);
            const unsigned tg = og / nx;
            if (og + 1u == (tg + 1u) * nx) xb_add(&bar[XB_TOPGEN], 1u);
            else XB_SPIN(xb_ld(&bar[XB_TOPGEN]) == tg, bar);
            __builtin_amdgcn_fence(__ATOMIC_ACQUIRE, "agent");
            xb_add(&bar[XB_XGEN(b.x)], 1u);
            asm volatile("s_waitcnt vmcnt(0)" ::: "memory");
        } else {
            XB_SPIN(xb_ld(&bar[XB_XGEN(b.x)]) == gen, bar);
            __builtin_amdgcn_fence(__ATOMIC_ACQUIRE, "agent");
            asm volatile("s_waitcnt vmcnt(0)" ::: "memory");
        }
    }
    __syncthreads();
}
struct Args { const float* in[N_IN]; float* out; unsigned char* ws; double invf[44]; int ph_lo, ph_hi, li, pad; };
struct WI { LAS unsigned char* lds; int tid, lane, wave, vcu, G, gw, NGW; };
constexpr size_t RWA_STRIDE = 32 * MiB / 4;
constexpr size_t YO_STRIDE = 32 * MiB / 4;

__device__ __forceinline__ int wave_sum_i(int v) {
#pragma unroll
    for (int o = 1; o < 64; o <<= 1) v += __shfl_xor(v, o);
    return v;
}
__device__ __forceinline__ void sincos_d(double ang, float& s, float& c) {
    const double q = __builtin_rint(ang * 0.63661977236758134308);
    double r = __builtin_fma(-q, 1.57079632679489661923, ang); r = __builtin_fma(-q, 6.123233995736766e-17, r);
    const double r2 = r * r;
    const double sp = r * (1.0 + r2 * (-1.0 / 6 + r2 * (1.0 / 120 + r2 * (-1.0 / 5040 + r2 * (1.0 / 362880 + r2 * (-1.0 / 39916800 + r2 * (1.0 / 6227020800.0)))))));
    const double cp = 1.0 + r2 * (-0.5 + r2 * (1.0 / 24 + r2 * (-1.0 / 720 + r2 * (1.0 / 40320 + r2 * (-1.0 / 3628800 + r2 * (1.0 / 479001600 + r2 * (-1.0 / 87178291200.0)))))));
    const int qi = ((int)q) & 3;
    const double ss = (qi == 0) ? sp : (qi == 1) ? cp : (qi == 2) ? -sp : -cp;
    const double cc = (qi == 0) ? cp : (qi == 1) ? -sp : (qi == 2) ? -cp : sp;
    s = (float)ss; c = (float)cc;
}

__device__ __forceinline__ void tr_item(const float* W, int ldw, int nvalid, int k0, int nsrc0, bf16* WT, size_t dstrow0, LAS float* scr, int lane) {
#pragma unroll 8
    for (int i = 0; i < 32; ++i) { const int kk = 2 * i + (lane >> 5), c = lane & 31, n = nsrc0 + c; scr[kk * 33 + c] = (n < nvalid) ? W[(size_t)(k0 + kk) * ldw + n] : 0.0f; }
    LDS_WAIT(); asm volatile("" ::: "memory");
    const int c8 = lane & 7;
#pragma unroll
    for (int j = 0; j < 4; ++j) { const int n = (lane >> 3) + 8 * j; const LAS float* s = scr + (8 * c8) * 33 + n;
        v4u o; o.x = pk2(s[0 * 33], s[1 * 33]); o.y = pk2(s[2 * 33], s[3 * 33]); o.z = pk2(s[4 * 33], s[5 * 33]); o.w = pk2(s[6 * 33], s[7 * 33]);
        *(v4u*)(WT + (dstrow0 + n) * 1024 + k0 + 8 * c8) = o; }
    LDS_WAIT(); asm volatile("" ::: "memory");
}
__device__ __forceinline__ void ph_prologue(const Args& A, const WI& w) {
    LAS float* sc = (LAS float*)w.lds;
    { const float* cin = A.in[I_C]; for (int i = w.tid; i < NB * DM; i += NWAVES * 64) { const float v = cin[i]; sc[i] = v / (1.0f + expf(-v)); } }
    __syncthreads();
    float* MOD = (float*)(A.ws + WS_MOD);
    if (w.wave == 0 && w.vcu < 192) {
        const int l = w.vcu / 96, col = (w.vcu % 96) * 64 + w.lane;
        const float* wp = A.in[I_ADAW] + (size_t)l * DM * 6144 + col;
        float acc[8];
#pragma unroll
        for (int b = 0; b < 8; ++b) acc[b] = 0.0f;
        for (int k = 0; k < DM; ++k) { const float wv = wp[(size_t)k * 6144];
#pragma unroll
            for (int b = 0; b < 8; ++b) acc[b] += sc[b * DM + k] * wv; }
        const float bias = A.in[I_ADAB][l * 6144 + col];
#pragma unroll
        for (int b = 0; b < 8; ++b) MOD[(size_t)(l * 8 + b) * 6144 + col] = acc[b] + bias;
    }
    LAS float* scr = (LAS float*)(w.lds + 32768 + w.wave * 8448);
    constexpr int I_IN = NLAYER * 16 * 96, I_OUT = NLAYER * 16 * 32, I_W1 = NLAYER * NEXP * 16 * 64, I_W2 = NLAYER * NEXP * 16 * 32, NIT = I_IN + I_OUT + I_W1 + I_W2;
    for (int it = w.gw; it < NIT; it += w.NGW) {
        int r = it;
        if (r < I_IN) { const int l = r / 1536, rr = r % 1536, kb = rr / 96, nb = rr % 96;
            tr_item(A.in[I_WIN] + (size_t)l * DM * INC, INC, INC, kb * 64, nb * 32, (bf16*)(A.ws + WS_WIN) + (size_t)l * INCP * DM, (size_t)nb * 32, scr, w.lane); continue; }
        r -= I_IN;
        if (r < I_OUT) { const int l = r / 512, rr = r % 512, kb = rr / 32, nb = rr % 32;
            tr_item(A.in[I_WOUT] + (size_t)l * DM * DM, DM, DM, kb * 64, nb * 32, (bf16*)(A.ws + WS_WOUT) + (size_t)l * DM * DM, (size_t)nb * 32, scr, w.lane); continue; }
        r -= I_OUT;
        if (r < I_W1) { const int le = r / 1024, rr = r % 1024, kb = rr / 64, nb = rr % 64, j = nb >> 3, bj = (nb >> 2) & 1, cc0 = (nb & 3) * 32;
            tr_item(A.in[I_MW1] + (size_t)le * DM * 2048, 2048, 2048, kb * 64, bj * 1024 + 128 * j + cc0, (bf16*)(A.ws + WS_W1) + (size_t)le * 2048 * DM, (size_t)nb * 32, scr, w.lane); continue; }
        r -= I_W1;
        { const int le = r / 512, rr = r % 512, kb = rr / 32, nb = rr % 32;
            tr_item(A.in[I_MW2] + (size_t)le * DM * DM, DM, DM, kb * 64, nb * 32, (bf16*)(A.ws + WS_W2) + (size_t)le * DM * DM, (size_t)nb * 32, scr, w.lane); }
    }
    float* RT = (float*)(A.ws + WS_ROPE); const int* pos = (const int*)A.in[I_POS];
    for (int g = w.gw * 64 + w.lane; g < MTOK * 44; g += w.NGW * 64) {
        const int tok = g / 44, f = g % 44; int co, so;
        if (f < 32) { co = f; so = 32 + f; } else if (f < 40) { co = 64 + (f - 32); so = 72 + (f - 32); } else { co = 80 + (f - 40); so = 84 + (f - 40); }
        float s, c; sincos_d((double)pos[tok] * A.invf[f], s, c);
        RT[(size_t)tok * ROPE_W + co] = c; RT[(size_t)tok * ROPE_W + so] = s;
    }
}

__device__ __forceinline__ void emit_h_row(const f32x4 (&v)[4], float rstd, const float* g, const float* sc, const float* sh, bf16* hrow, int lane) {
#pragma unroll
    for (int j = 0; j < 4; ++j) { const int k = 4 * (lane + 64 * j);
        const f32x4 gv = *(const f32x4*)(g + k), scv = *(const f32x4*)(sc + k), shv = *(const f32x4*)(sh + k);
        const f32x4 h = v[j] * rstd * gv * (1.0f + scv) + shv;
        v2u o; o.x = pk2(h.x, h.y); o.y = pk2(h.z, h.w); *(v2u*)(hrow + k) = o; }
}
__device__ __forceinline__ void ph_norm1(const Args& A, const WI& w) {
    const float* MOD = (const float*)(A.ws + WS_MOD); bf16* H = (bf16*)(A.ws + WS_H);
    for (int m = w.gw; m < MTOK; m += w.NGW) {
        const float* xr = A.in[I_X] + (size_t)m * DM; f32x4 v[4]; float ss = 0.0f;
#pragma unroll
        for (int j = 0; j < 4; ++j) { v[j] = *(const f32x4*)(xr + 4 * (w.lane + 64 * j)); ss += dot4(v[j], v[j]); }
        ss = wave_sum(ss); const float rstd = 1.0f / sqrtf(ss * (1.0f / DM) + 1e-5f);
        const float* mb = MOD + (size_t)(m >> 12) * 6144;
        emit_h_row(v, rstd, A.in[I_NMIX], mb + 1024, mb, H + (size_t)m * DM, w.lane);
    }
}

__device__ __forceinline__ void rwkv_prep(const Args& A, int l, int m, int lane) {
    const float* P = (const float*)(A.ws + WS_P); float* RWA = (float*)(A.ws + WS_RWA);
    const int t = m & (SEQ - 1), c4 = 4 * lane;
    const float* pr = P + (size_t)m * INCP + C_RW; const float* pp = pr - INCP; const float* mu = A.in[I_MU] + l * 896;
    f32x4 fr, fk, fv;
    { const f32x4 z = *(const f32x4*)(pr + c4), mm = *(const f32x4*)(mu + c4); f32x4 p = {0.f, 0.f, 0.f, 0.f}; if (t) p = *(const f32x4*)(pp + c4); fr = z + (p - z) * mm; }
    { const f32x4 z = *(const f32x4*)(pr + 256 + c4), mm = *(const f32x4*)(mu + 256 + c4); f32x4 p = {0.f, 0.f, 0.f, 0.f}; if (t) p = *(const f32x4*)(pp + 256 + c4); fk = z + (p - z) * mm; }
    { const f32x4 z = *(const f32x4*)(pr + 512 + c4), mm = *(const f32x4*)(mu + 512 + c4); f32x4 p = {0.f, 0.f, 0.f, 0.f}; if (t) p = *(const f32x4*)(pp + 512 + c4); fv = z + (p - z) * mm; }
    float x0, x1;
    { const float z = pr[768 + lane], p = t ? pp[768 + lane] : 0.0f; x0 = z + (p - z) * mu[768 + lane]; }
    { const float z = pr[832 + lane], p = t ? pp[832 + lane] : 0.0f; x1 = z + (p - z) * mu[832 + lane]; }
    x0 = (lane < 32) ? tanhf(x0) : x0; x1 = sigm(x1);
    f32x4 wacc = *(const f32x4*)(A.in[I_W0] + l * 256 + c4), aacc = *(const f32x4*)(A.in[I_A0] + l * 256 + c4), gacc = {0.f, 0.f, 0.f, 0.f};
    const float* w2 = A.in[I_W2] + l * 32 * 256 + c4; const float* a2 = A.in[I_A2] + l * 32 * 256 + c4; const float* g2 = A.in[I_G2] + l * 64 * 256 + c4;
#pragma unroll 8
    for (int i = 0; i < 32; ++i) { const float s = __shfl(x0, i); wacc += s * *(const f32x4*)(w2 + i * 256); }
#pragma unroll 8
    for (int i = 0; i < 32; ++i) { const float s = __shfl(x0, 32 + i); aacc += s * *(const f32x4*)(a2 + i * 256); }
#pragma unroll 8
    for (int i = 0; i < 64; ++i) { const float s = __shfl(x1, i); gacc += s * *(const f32x4*)(g2 + i * 256); }
    f32x4 dec, av;
#pragma unroll
    for (int i = 0; i < 4; ++i) { const float wl = -softplusf(-wacc[i]) - 0.5f; dec[i] = expf(-expf(wl)); av[i] = sigm(aacc[i]); }
    f32x4 kk = fk * *(const f32x4*)(A.in[I_KK] + l * 256 + c4);
    const float nrm = fmaxf(sqrtf(grp16_sum(dot4(kk, kk))), 1e-12f); kk = kk / nrm;
    const f32x4 kmod = fk * (1.0f + (av - 1.0f) * *(const f32x4*)(A.in[I_KA] + l * 256 + c4));
    const f32x4 bb = kk * av;
    const float bs = grp16_sum(dot4(fr * kmod, *(const f32x4*)(A.in[I_RK] + l * 256 + c4)));
    const size_t o = (size_t)m * 256 + c4;
    *(f32x4*)(RWA + 0 * RWA_STRIDE + o) = fr; *(f32x4*)(RWA + 1 * RWA_STRIDE + o) = dec; *(f32x4*)(RWA + 2 * RWA_STRIDE + o) = kmod; *(f32x4*)(RWA + 3 * RWA_STRIDE + o) = fv;
    *(f32x4*)(RWA + 4 * RWA_STRIDE + o) = -kk; *(f32x4*)(RWA + 5 * RWA_STRIDE + o) = bb; *(f32x4*)(RWA + 6 * RWA_STRIDE + o) = gacc; *(f32x4*)(RWA + 7 * RWA_STRIDE + o) = bs * fv;
}
__device__ __forceinline__ void dsa_prep(const Args& A, int l, int m, int lane) {
    const float* P = (const float*)(A.ws + WS_P); const float* RT = (const float*)(A.ws + WS_ROPE) + (size_t)m * ROPE_W;
    const float* pd = P + (size_t)m * INCP + C_DSA; const int c4 = 4 * lane;
    float c0 = pd[lane], c1 = pd[64 + lane];
    const float rstd = 1.0f / sqrtf(wave_sum(c0 * c0 + c1 * c1) * (1.0f / 128.0f) + 1e-5f);
    c0 *= rstd * A.in[I_QNORM][l * 128 + lane]; c1 *= rstd * A.in[I_QNORM][l * 128 + 64 + lane];
    f32x4 q = {0.f, 0.f, 0.f, 0.f}, qi = {0.f, 0.f, 0.f, 0.f};
    const float* wq = A.in[I_WQ] + (size_t)l * 128 * 256 + c4; const float* wqi = A.in[I_WQI] + (size_t)l * 128 * 256 + c4;
#pragma unroll 8
    for (int i = 0; i < 64; ++i) { const float s = __shfl(c0, i); q += s * *(const f32x4*)(wq + i * 256); qi += s * *(const f32x4*)(wqi + i * 256); }
#pragma unroll 8
    for (int i = 0; i < 64; ++i) { const float s = __shfl(c1, i); q += s * *(const f32x4*)(wq + (64 + i) * 256); qi += s * *(const f32x4*)(wqi + (64 + i) * 256); }
    { const int r = lane & 15; const f32x4 ot = shx4(q, 2);
      if (r < 4) { const int fi = 4 * (r & 1); const f32x4 cs = *(const f32x4*)(RT + 64 + fi), sn = *(const f32x4*)(RT + 72 + fi); q = (r < 2) ? q * cs - ot * sn : ot * sn + q * cs; } }
    { const int r = lane & 7; const f32x4 ot = shx4(qi, 1);
      if (r < 2) { const f32x4 cs = *(const f32x4*)(RT + 80), sn = *(const f32x4*)(RT + 84); qi = (r < 1) ? qi * cs - ot * sn : ot * sn + qi * cs; } }
    *(f32x4*)((float*)(A.ws + WS_DQ) + (size_t)m * 256 + c4) = q * 0.125f;
    *(f32x4*)((float*)(A.ws + WS_DQI) + (size_t)m * 256 + c4) = qi;
    { const int r = lane & 15; f32x4 kx = *(const f32x4*)(pd + 128 + 4 * r); const f32x4 ot = shx4(kx, 2);
      if (r < 4) { const int fi = 4 * (r & 1); const f32x4 cs = *(const f32x4*)(RT + 64 + fi), sn = *(const f32x4*)(RT + 72 + fi); kx = (r < 2) ? kx * cs - ot * sn : ot * sn + kx * cs; }
      if (lane < 16) { *(f32x4*)((float*)(A.ws + WS_DK) + (size_t)m * 64 + c4) = kx; *(f32x4*)((float*)(A.ws + WS_DV) + (size_t)m * 64 + c4) = *(const f32x4*)(pd + 192 + c4); } }
    { const int r = lane & 7; f32x4 ki = *(const f32x4*)(pd + 256 + 4 * r); const f32x4 ot = shx4(ki, 1);
      if (r < 2) { const f32x4 cs = *(const f32x4*)(RT + 80), sn = *(const f32x4*)(RT + 84); ki = (r < 1) ? ki * cs - ot * sn : ot * sn + ki * cs; }
      if (lane < 8) *(f32x4*)((float*)(A.ws + WS_DKI) + (size_t)m * 32 + c4) = ki;
      if (lane < 2) *(f32x4*)((float*)(A.ws + WS_DW) + (size_t)m * 8 + c4) = *(const f32x4*)(pd + 288 + c4) * 0.0625f; }
}

__device__ __forceinline__ void ret_scan(const Args& A, const WI& w, int bh) {
    const int b = bh >> 2, h = bh & 3; const float gamma = 1.0f - exp2f(-5.0f - (float)h);
    LAS float* qs = (LAS float*)w.lds; LAS float* ks = qs + 2048; LAS float* vs = ks + 2048; LAS float* part = vs + 2048;
    const float* P = (const float*)(A.ws + WS_P); const float* RT = (const float*)(A.ws + WS_ROPE); float* YRET = (float*)(A.ws + WS_YO);
    float S[8];
#pragma unroll
    for (int i = 0; i < 8; ++i) S[i] = 0.0f;
    const int tt = w.tid >> 4, d0 = (w.tid & 15) * 4;
    for (int t0 = 0; t0 < SEQ; t0 += 32) {
        { const size_t m = (size_t)b * SEQ + t0 + tt; const float* pr = P + m * INCP + C_RET + h * 64; const float* rt = RT + m * ROPE_W;
          const int fi = d0 & 31, dp = d0 ^ 32;
          const f32x4 cs = *(const f32x4*)(rt + fi), sn = *(const f32x4*)(rt + 32 + fi);
          const f32x4 qm = *(const f32x4*)(pr + d0), qo = *(const f32x4*)(pr + dp), km = *(const f32x4*)(pr + 256 + d0), ko = *(const f32x4*)(pr + 256 + dp);
          const f32x4 qn = (d0 < 32) ? qm * cs - qo * sn : qo * sn + qm * cs;
          const f32x4 kn = ((d0 < 32) ? km * cs - ko * sn : ko * sn + km * cs) * 0.125f;
          *(LAS f32x4*)(qs + tt * 64 + d0) = qn; *(LAS f32x4*)(ks + tt * 64 + d0) = kn; *(LAS f32x4*)(vs + tt * 64 + d0) = *(const f32x4*)(pr + 512 + d0); }
        __syncthreads();
        for (int s = 0; s < 32; ++s) { const float vv = vs[s * 64 + w.lane]; float po = 0.0f;
#pragma unroll
            for (int i = 0; i < 8; ++i) { S[i] = gamma * S[i] + ks[s * 64 + w.wave * 8 + i] * vv; po += qs[s * 64 + w.wave * 8 + i] * S[i]; }
            part[(w.wave * 32 + s) * 64 + w.lane] = po; }
        __syncthreads();
        { f32x4 o = {0.f, 0.f, 0.f, 0.f};
#pragma unroll
          for (int kg = 0; kg < 8; ++kg) o += *(const LAS f32x4*)(part + (kg * 32 + tt) * 64 + d0);
          *(f32x4*)(YRET + ((size_t)b * SEQ + t0 + tt) * 256 + h * 64 + d0) = o; }
        __syncthreads();
    }
}
__device__ __forceinline__ void rwkv_scan(const Args& A, const WI& w, int bh) {
    const int b = bh >> 2, h = bh & 3;
    LAS float* sr = (LAS float*)w.lds; LAS float* sw = sr + 2048; LAS float* sk = sw + 2048; LAS float* sv = sk + 2048; LAS float* sn = sv + 2048; LAS float* sb = sn + 2048; LAS float* sy = sb + 2048;
    const float* RWA = (const float*)(A.ws + WS_RWA); float* YRW = (float*)(A.ws + WS_YO) + YO_STRIDE;
    float S[8];
#pragma unroll
    for (int i = 0; i < 8; ++i) S[i] = 0.0f;
    const int vrow = w.tid >> 3, kq = w.tid & 7, tt = w.tid >> 4, d0 = (w.tid & 15) * 4;
    for (int t0 = 0; t0 < SEQ; t0 += 32) {
        { const size_t o = ((size_t)b * SEQ + t0 + tt) * 256 + h * 64 + d0; const int lo = tt * 64 + d0;
          *(LAS f32x4*)(sr + lo) = *(const f32x4*)(RWA + 0 * RWA_STRIDE + o); *(LAS f32x4*)(sw + lo) = *(const f32x4*)(RWA + 1 * RWA_STRIDE + o); *(LAS f32x4*)(sk + lo) = *(const f32x4*)(RWA + 2 * RWA_STRIDE + o);
          *(LAS f32x4*)(sv + lo) = *(const f32x4*)(RWA + 3 * RWA_STRIDE + o); *(LAS f32x4*)(sn + lo) = *(const f32x4*)(RWA + 4 * RWA_STRIDE + o); *(LAS f32x4*)(sb + lo) = *(const f32x4*)(RWA + 5 * RWA_STRIDE + o); }
        __syncthreads();
        for (int s = 0; s < 32; ++s) { const int lo = s * 64 + kq * 8;
            const f32x4 w0 = *(const LAS f32x4*)(sw + lo), w1 = *(const LAS f32x4*)(sw + lo + 4), n0 = *(const LAS f32x4*)(sn + lo), n1 = *(const LAS f32x4*)(sn + lo + 4);
            const f32x4 b0 = *(const LAS f32x4*)(sb + lo), b1 = *(const LAS f32x4*)(sb + lo + 4), k0 = *(const LAS f32x4*)(sk + lo), k1 = *(const LAS f32x4*)(sk + lo + 4);
            const f32x4 r0 = *(const LAS f32x4*)(sr + lo), r1 = *(const LAS f32x4*)(sr + lo + 4); const float vv = sv[s * 64 + vrow];
            float sa = (S[0] * n0.x + S[1] * n0.y) + (S[2] * n0.z + S[3] * n0.w) + (S[4] * n1.x + S[5] * n1.y) + (S[6] * n1.z + S[7] * n1.w);
            sa = grp8_sum(sa);
            S[0] = S[0] * w0.x + sa * b0.x + vv * k0.x; S[1] = S[1] * w0.y + sa * b0.y + vv * k0.y; S[2] = S[2] * w0.z + sa * b0.z + vv * k0.z; S[3] = S[3] * w0.w + sa * b0.w + vv * k0.w;
            S[4] = S[4] * w1.x + sa * b1.x + vv * k1.x; S[5] = S[5] * w1.y + sa * b1.y + vv * k1.y; S[6] = S[6] * w1.z + sa * b1.z + vv * k1.z; S[7] = S[7] * w1.w + sa * b1.w + vv * k1.w;
            float y = (S[0] * r0.x + S[1] * r0.y) + (S[2] * r0.z + S[3] * r0.w) + (S[4] * r1.x + S[5] * r1.y) + (S[6] * r1.z + S[7] * r1.w);
            y = grp8_sum(y);
            if (kq == 0) sy[s * 64 + vrow] = y; }
        __syncthreads();
        *(f32x4*)(YRW + ((size_t)b * SEQ + t0 + tt) * 256 + h * 64 + d0) = *(const LAS f32x4*)(sy + tt * 64 + d0);
        __syncthreads();
    }
}
__device__ __forceinline__ void sb_row(const Args& A, int it, int lane) {
    const int t = it & (SEQ - 1), bh = it >> 12, b = bh >> 2, h = bh & 3;
    const float* P = (const float*)(A.ws + WS_P); float* YSB = (float*)(A.ws + WS_YO) + 3 * YO_STRIDE;
    const size_t m = (size_t)b * SEQ + t;
    const float* qrow = P + m * INCP + C_SB + h * 64;
    float q[64], acc[64];
#pragma unroll
    for (int d = 0; d < 64; ++d) { q[d] = qrow[d]; acc[d] = 0.0f; }
    float carry = 0.0f;
    for (int base = t - 1; base >= 0; base -= 64) {
        const int s = base - lane; const bool valid = s >= 0; const int sc = valid ? s : 0;
        const float* kr = P + ((size_t)b * SEQ + sc) * INCP + C_SB + 256 + h * 64;
        float z = 0.0f;
#pragma unroll
        for (int d4 = 0; d4 < 16; ++d4) { const f32x4 kv = *(const f32x4*)(kr + 4 * d4); z += (q[4 * d4] * kv.x + q[4 * d4 + 1] * kv.y) + (q[4 * d4 + 2] * kv.z + q[4 * d4 + 3] * kv.w); }
        z *= 0.125f;
        const float Ln = valid ? -softplusf(z) : 0.0f;
        float inc = Ln;
#pragma unroll
        for (int off = 1; off < 64; off <<= 1) { const float y = __shfl_up(inc, off); if (lane >= off) inc += y; }
        const float tot = __shfl(inc, 63);
        const float la = (z + Ln) + carry + (inc - Ln);
        const float a = valid ? expf(la) : 0.0f;
        carry += tot;
        const float* vr = kr + 256;
#pragma unroll
        for (int d4 = 0; d4 < 16; ++d4) { const f32x4 vv = *(const f32x4*)(vr + 4 * d4); acc[4 * d4] += a * vv.x; acc[4 * d4 + 1] += a * vv.y; acc[4 * d4 + 2] += a * vv.z; acc[4 * d4 + 3] += a * vv.w; }
        if (carry < -104.0f) break;
    }
    float o = 0.0f;
#pragma unroll
    for (int d = 0; d < 64; ++d) { const float r = wave_sum(acc[d]); o = (lane == d) ? r : o; }
    YSB[m * 256 + h * 64 + lane] = o;
}
__device__ __forceinline__ void dsa_score_row(const Args& A, int m, int lane, LAS float* sqi) {
    const int b = m >> 12, t = m & (SEQ - 1), n = t + 1;
    *(LAS f32x4*)(sqi + 4 * lane) = *(const f32x4*)((const float*)(A.ws + WS_DQI) + (size_t)m * 256 + 4 * lane);
    const float* dw = (const float*)(A.ws + WS_DW) + (size_t)m * 8;
    const f32x4 wa = *(const f32x4*)dw, wb = *(const f32x4*)(dw + 4);
    float* sc = (float*)(A.ws + WS_SC) + (size_t)m * SEQ; const float* DKI = (const float*)(A.ws + WS_DKI);
    LDS_WAIT();
    for (int s0 = 0; s0 < n; s0 += 64) { const int s = s0 + lane;
        if (s < n) { const float* kr = DKI + ((size_t)b * SEQ + s) * 32; f32x4 kv[8];
#pragma unroll
            for (int e = 0; e < 8; ++e) kv[e] = *(const f32x4*)(kr + 4 * e);
            float tot = 0.0f;
#pragma unroll
            for (int hh = 0; hh < 8; ++hh) { float d = 0.0f;
#pragma unroll
                for (int e = 0; e < 8; ++e) d += dot4(*(const LAS f32x4*)(sqi + hh * 32 + 4 * e), kv[e]);
                const float wv = (hh < 4) ? wa[hh] : wb[hh - 4]; tot += wv * fmaxf(d, 0.0f); }
            sc[s] = tot + 0.0f; } }
}

__device__ __forceinline__ void dsa_attend_row(const Args& A, int m, int lane, LAS float* wl) {
    LAS float* sq = wl; LAS int* slist = (LAS int*)(wl + 256); LAS float* sp = wl + 512; LAS unsigned* keys = (LAS unsigned*)(wl + 1536);
    const int b = m >> 12, t = m & (SEQ - 1), n = t + 1;
    *(LAS f32x4*)(sq + 4 * lane) = *(const f32x4*)((const float*)(A.ws + WS_DQ) + (size_t)m * 256 + 4 * lane);
    const float* sc = (const float*)(A.ws + WS_SC) + (size_t)m * SEQ;
    int nsel;
    if (n <= 256) {
#pragma unroll
        for (int c = 0; c < 4; ++c) { const int idx = lane + 64 * c; if (idx < n) slist[idx] = idx; }
        nsel = n;
    } else {
        const int nj = (n + 63) >> 6;
        for (int j = 0; j < nj; ++j) { const int s = j * 64 + lane; unsigned key = 0u;
            if (s < n) { const unsigned bits = __float_as_uint(sc[s]); key = (bits & 0x80000000u) ? ~bits : (bits | 0x80000000u); }
            keys[s] = key; }
        LDS_WAIT();
        unsigned T = 0u;
        for (int bit = 31; bit >= 0; --bit) { const unsigned cand = T | (1u << bit); int cnt = 0;
            for (int j = 0; j < nj; ++j) cnt += (keys[j * 64 + lane] >= cand) ? 1 : 0;
            cnt = wave_sum_i(cnt);
            if (cnt >= 256) T = cand; }
        int cgt = 0;
        for (int j = 0; j < nj; ++j) cgt += (keys[j * 64 + lane] > T) ? 1 : 0;
        cgt = wave_sum_i(cgt);
        const int r = 256 - cgt;
        int base = 0, eqseen = 0; const unsigned long long ltm = (1ull << lane) - 1ull;
        for (int j = 0; j < nj; ++j) { const unsigned kx = keys[j * 64 + lane]; const bool gt = kx > T, eq = kx == T;
            const unsigned long long meq = __ballot(eq); const int er = eqseen + __popcll(meq & ltm);
            const bool sel = gt || (eq && er < r);
            const unsigned long long ms = __ballot(sel); if (sel) slist[base + __popcll(ms & ltm)] = j * 64 + lane;
            base += __popcll(ms); eqseen += __popcll(meq); }
        nsel = 256;
    }
    LDS_WAIT();
    const float* DK = (const float*)(A.ws + WS_DK); const float* DV = (const float*)(A.ws + WS_DV);
    float lg[4][4];
#pragma unroll 1
    for (int c = 0; c < 4; ++c) { const int idx = lane + 64 * c; const bool ok = idx < nsel; const int s = ok ? slist[idx] : 0;
        asm volatile("" ::: "memory");
        const float* kr = DK + ((size_t)b * SEQ + s) * 64; float d[4] = {0.f, 0.f, 0.f, 0.f};
#pragma unroll
        for (int e = 0; e < 16; ++e) { const f32x4 kv = *(const f32x4*)(kr + 4 * e);
#pragma unroll
            for (int hh = 0; hh < 4; ++hh) d[hh] += dot4(*(const LAS f32x4*)(sq + hh * 64 + 4 * e), kv); }
        *(LAS f32x4*)(sp + 4 * idx) = ok ? (f32x4){d[0], d[1], d[2], d[3]} : (f32x4){-INFINITY, -INFINITY, -INFINITY, -INFINITY}; }
    LDS_WAIT();
#pragma unroll
    for (int c = 0; c < 4; ++c) { const f32x4 v = *(const LAS f32x4*)(sp + 4 * (lane + 64 * c)); lg[c][0] = v.x; lg[c][1] = v.y; lg[c][2] = v.z; lg[c][3] = v.w; }
#pragma unroll
    for (int hh = 0; hh < 4; ++hh) {
        const float mx = wave_max(fmaxf(fmaxf(lg[0][hh], lg[1][hh]), fmaxf(lg[2][hh], lg[3][hh])));
        float e[4], se = 0.0f;
#pragma unroll
        for (int c = 0; c < 4; ++c) { e[c] = (lane + 64 * c < nsel) ? expf(lg[c][hh] - mx) : 0.0f; se += e[c]; }
        const float inv = 1.0f / wave_sum(se);
#pragma unroll
        for (int c = 0; c < 4; ++c) lg[c][hh] = e[c] * inv; }
#pragma unroll
    for (int c = 0; c < 4; ++c) { const int idx = lane + 64 * c; if (idx < nsel) *(LAS f32x4*)(sp + 4 * idx) = (f32x4){lg[c][0], lg[c][1], lg[c][2], lg[c][3]}; }
    LDS_WAIT();
    f32x4 o = {0.f, 0.f, 0.f, 0.f};
    for (int i = 0; i < nsel; ++i) { const int s = slist[i]; const f32x4 pv = *(const LAS f32x4*)(sp + 4 * i); const float vv = DV[((size_t)b * SEQ + s) * 64 + lane]; o += pv * vv; }
    float* YD = (float*)(A.ws + WS_YO) + 2 * YO_STRIDE + (size_t)m * 256;
    YD[lane] = o.x; YD[64 + lane] = o.y; YD[128 + lane] = o.z; YD[192 + lane] = o.w;
    LDS_WAIT();
}

__device__ __forceinline__ f32x4 head_norm4(f32x4 y, float eps, f32x4 g) {
    const float mean = grp16_sum(sum4(y)) * (1.0f / 64.0f); const f32x4 yc = y - mean;
    const float var = grp16_sum(dot4(yc, yc)) * (1.0f / 64.0f); return yc * (1.0f / sqrtf(var + eps)) * g;
}
__device__ __forceinline__ void post_row(const Args& A, int l, int m, int lane) {
    const float* P = (const float*)(A.ws + WS_P); const float* YO = (const float*)(A.ws + WS_YO); const float* RWA = (const float*)(A.ws + WS_RWA);
    bf16* MX = (bf16*)(A.ws + WS_MIX) + (size_t)m * DM; const int c4 = 4 * lane; const size_t o = (size_t)m * 256 + c4;
    { f32x4 y = head_norm4(*(const f32x4*)(YO + o), 1e-5f, *(const f32x4*)(A.in[I_RETGN] + l * 256 + c4));
      const f32x4 g = *(const f32x4*)(P + (size_t)m * INCP + C_RET + 768 + c4);
#pragma unroll
      for (int i = 0; i < 4; ++i) y[i] *= g[i] * sigm(g[i]);
      v2u w; w.x = pk2(y.x, y.y); w.y = pk2(y.z, y.w); *(v2u*)(MX + c4) = w; }
    { f32x4 y = head_norm4(*(const f32x4*)(YO + YO_STRIDE + o), 64e-5f, *(const f32x4*)(A.in[I_LN] + l * 256 + c4));
      y = (y + *(const f32x4*)(RWA + 7 * RWA_STRIDE + o)) * *(const f32x4*)(RWA + 6 * RWA_STRIDE + o);
      v2u w; w.x = pk2(y.x, y.y); w.y = pk2(y.z, y.w); *(v2u*)(MX + 256 + c4) = w; }
    { f32x4 y = *(const f32x4*)(YO + 2 * YO_STRIDE + o); const float r = 1.0f / sqrtf(wave_sum(dot4(y, y)) * (1.0f / 256.0f) + 1e-5f);
      y = y * r * *(const f32x4*)(A.in[I_DONORM] + l * 256 + c4);
      v2u w; w.x = pk2(y.x, y.y); w.y = pk2(y.z, y.w); *(v2u*)(MX + 512 + c4) = w; }
    { f32x4 y = *(const f32x4*)(YO + 3 * YO_STRIDE + o); const float r = 1.0f / sqrtf(wave_sum(dot4(y, y)) * (1.0f / 256.0f) + 1e-5f);
      y = y * r * *(const f32x4*)(A.in[I_SONORM] + l * 256 + c4);
      v2u w; w.x = pk2(y.x, y.y); w.y = pk2(y.z, y.w); *(v2u*)(MX + 768 + c4) = w; }
}

__device__ __forceinline__ void router_row(const Args& A, int l, int m, int lane) {
    const float* XA = (const float*)(A.ws + WS_XA) + (size_t)m * DM; const float* MOD = (const float*)(A.ws + WS_MOD) + (size_t)(l * 8 + (m >> 12)) * 6144;
    f32x4 v[4]; float ss = 0.0f;
#pragma unroll
    for (int j = 0; j < 4; ++j) { v[j] = *(const f32x4*)(XA + 4 * (lane + 64 * j)); ss += dot4(v[j], v[j]); }
    ss = wave_sum(ss); const float rstd = 1.0f / sqrtf(ss * (1.0f / DM) + 1e-5f);
    const float* g = A.in[I_NFFN] + l * DM; const float* scp = MOD + 4 * 1024; const float* shp = MOD + 3 * 1024;
    emit_h_row(v, rstd, g, scp, shp, (bf16*)(A.ws + WS_H) + (size_t)m * DM, lane);
    float p[32];
#pragma unroll
    for (int e = 0; e < 32; ++e) p[e] = 0.0f;
    const float* rw = A.in[I_RW] + (size_t)l * DM * 32;
#pragma unroll
    for (int j = 0; j < 4; ++j) { const int k = 4 * (lane + 64 * j);
        const f32x4 h = v[j] * rstd * *(const f32x4*)(g + k) * (1.0f + *(const f32x4*)(scp + k)) + *(const f32x4*)(shp + k);
#pragma unroll
        for (int i = 0; i < 4; ++i) { const float* row = rw + (size_t)(k + i) * 32;
#pragma unroll
            for (int q4 = 0; q4 < 8; ++q4) { const f32x4 r = *(const f32x4*)(row + 4 * q4); p[4 * q4] += h[i] * r.x; p[4 * q4 + 1] += h[i] * r.y; p[4 * q4 + 2] += h[i] * r.z; p[4 * q4 + 3] += h[i] * r.w; } } }
    const float* rb = A.in[I_RB] + l * 32;
#pragma unroll
    for (int e = 0; e < 32; ++e) p[e] = wave_sum(p[e]) + rb[e];
    unsigned used = 0u; float tv[4]; int ti[4];
#pragma unroll
    for (int kk = 0; kk < 4; ++kk) { float best = -INFINITY; int bi = 0;
#pragma unroll
        for (int e = 0; e < 32; ++e) { const bool c = !((used >> e) & 1u) && (p[e] > best); best = c ? p[e] : best; bi = c ? e : bi; }
        used |= 1u << bi; tv[kk] = best; ti[kk] = bi; }
    const float e1 = expf(tv[1] - tv[0]), e2 = expf(tv[2] - tv[0]), e3 = expf(tv[3] - tv[0]); const float inv = 1.0f / (1.0f + e1 + e2 + e3);
    if (lane == 0) {
        int* TI = (int*)(A.ws + WS_TOPI) + (size_t)m * 4; float* TW = (float*)(A.ws + WS_TOPW) + (size_t)m * 4;
        TI[0] = ti[0]; TI[1] = ti[1]; TI[2] = ti[2]; TI[3] = ti[3]; TW[0] = inv; TW[1] = e1 * inv; TW[2] = e2 * inv; TW[3] = e3 * inv;
        unsigned* cnt = (unsigned*)(A.ws + WS_CTL) + CW_CNT + l * 32;
        atomicAdd(cnt + ti[0], 1u); atomicAdd(cnt + ti[1], 1u); atomicAdd(cnt + ti[2], 1u); atomicAdd(cnt + ti[3], 1u);
    }
}
__device__ __forceinline__ void build_expert_table(const Args& A, const WI& w, int l) {
    LAS int* tst = (LAS int*)(w.lds + TST_OFF);
    if (w.tid == 0) { const unsigned* cnt = (const unsigned*)(A.ws + WS_CTL) + CW_CNT + l * 32; int acc = 0;
        for (int e = 0; e < 32; ++e) { tst[e] = acc; acc += (int)((__hip_atomic_load(cnt + e, RLX_AGENT) + 255u) >> 8); }
        tst[32] = acc; }
    __syncthreads();
}
__device__ __forceinline__ void scatter_row(const Args& A, const WI& w, int l, int m) {
    const LAS int* tst = (const LAS int*)(w.lds + TST_OFF);
    int pos = 0;
    if (w.lane < 4) { const int e = ((const int*)(A.ws + WS_TOPI))[(size_t)m * 4 + w.lane];
        const unsigned slot = atomicAdd((unsigned*)(A.ws + WS_CTL) + CW_CUR + l * 32 + e, 1u);
        pos = tst[e] * 256 + (int)slot; ((int*)(A.ws + WS_POS))[(size_t)m * 4 + w.lane] = pos; }
    const v4u* src = (const v4u*)((const bf16*)(A.ws + WS_H) + (size_t)m * DM);
    const v4u a = src[w.lane], b = src[64 + w.lane];
#pragma unroll
    for (int k = 0; k < 4; ++k) { const int pk = __shfl(pos, k); v4u* dst = (v4u*)((bf16*)(A.ws + WS_XS) + (size_t)pk * DM); dst[w.lane] = a; dst[64 + w.lane] = b; }
}
__device__ __forceinline__ void combine_row(const Args& A, int l, int m, int lane) {
    float* XA = (float*)(A.ws + WS_XA) + (size_t)m * DM; const float* MOD = (const float*)(A.ws + WS_MOD) + (size_t)(l * 8 + (m >> 12)) * 6144;
    const int* PS = (const int*)(A.ws + WS_POS) + (size_t)m * 4; const float* TW = (const float*)(A.ws + WS_TOPW) + (size_t)m * 4;
    const bf16* YS = (const bf16*)(A.ws + WS_XS);
    f32x4 v[4], acc[4];
#pragma unroll
    for (int j = 0; j < 4; ++j) { v[j] = *(const f32x4*)(XA + 4 * (lane + 64 * j)); acc[j] = (f32x4){0.f, 0.f, 0.f, 0.f}; }
#pragma unroll
    for (int k = 0; k < 4; ++k) { const int pos = PS[k]; const float gt = TW[k]; const v2u* yr = (const v2u*)(YS + (size_t)pos * DM);
#pragma unroll
        for (int j = 0; j < 4; ++j) { const v2u y = yr[lane + 64 * j]; acc[j] += gt * (f32x4){bf_lo(y.x), bf_hi(y.x), bf_lo(y.y), bf_hi(y.y)}; } }
    float ss = 0.0f;
#pragma unroll
    for (int j = 0; j < 4; ++j) { const int kx = 4 * (lane + 64 * j); v[j] += *(const f32x4*)(MOD + 5 * 1024 + kx) * acc[j]; ss += dot4(v[j], v[j]); }
    ss = wave_sum(ss); const float rstd = 1.0f / sqrtf(ss * (1.0f / DM) + 1e-5f);
    if (l + 1 < NLAYER) {
#pragma unroll
        for (int j = 0; j < 4; ++j) *(f32x4*)(XA + 4 * (lane + 64 * j)) = v[j];
        const float* mb = MOD + 8 * 6144;
        emit_h_row(v, rstd, A.in[I_NMIX] + (l + 1) * DM, mb + 1024, mb, (bf16*)(A.ws + WS_H) + (size_t)m * DM, lane);
    } else {
        float* orow = A.out + (size_t)m * DM; const float* gf = A.in[I_NFINAL];
#pragma unroll
        for (int j = 0; j < 4; ++j) { const int kx = 4 * (lane + 64 * j); *(f32x4*)(orow + kx) = v[j] * rstd * *(const f32x4*)(gf + kx); }
    }
}

constexpr int N_LAUNCHES = MK_N_LAUNCHES;
template <int SEL> __global__ void __launch_bounds__(NWAVES * 64, 2) fwd(Args A) {
    extern __shared__ __attribute__((aligned(16))) unsigned char lds[];
    WI w;
    w.lds = (LAS unsigned char*)lds;
    w.tid = threadIdx.x; w.lane = w.tid & 63; w.wave = __builtin_amdgcn_readfirstlane(w.tid >> 6);
    w.G = gridDim.x; { const int bx = blockIdx.x; w.vcu = (w.G % 8 == 0) ? (bx % 8) * (w.G / 8) + bx / 8 : bx; }
    w.gw = w.vcu * NWAVES + w.wave; w.NGW = w.G * NWAVES;
    volatile LAS unsigned* MISC = (volatile LAS unsigned*)(w.lds + MISC_OFF);
    for (int u = w.tid; u < (LDS_BYTES - RING_BYTES) / 4; u += NWAVES * 64) ((LAS unsigned*)(w.lds + RING_BYTES))[u] = 0u;
    __syncthreads();
    gu32* ctl = (gu32*)(A.ws + WS_CTL);
    XcdBarrier bar; bar.bar = (unsigned*)(ctl + CW_BAR); bar.x = 0; bar.st = nullptr;
    if (N_LAUNCHES == 1) bar = xcd_barrier_post((unsigned*)(ctl + CW_BAR), MISC + 8);
#define GRID_BAR() do { if (N_LAUNCHES == 1) { xcd_barrier(bar); } } while (0)
    const int lo = A.ph_lo, hi = A.ph_hi;
#define IN(k) (lo <= (k) && (k) < hi)
#define KON(k) if constexpr (SEL < 0 || SEL == (k))
#define BOTH(k) (IN(k) && IN((k) + 1))
    PG8_LAS unsigned char* ring = (PG8_LAS unsigned char*)lds;

    KON(0) if (IN(0)) { ph_prologue(A, w); if (BOTH(0)) GRID_BAR(); }

    for (int l = 0; l < NLAYER; ++l) {
        const int pb = 1 + l * NPL;
        const float* MODL = (const float*)(A.ws + WS_MOD) + (size_t)l * 8 * 6144;
        KON(1) if (IN(pb + 0)) { if (l == 0) ph_norm1(A, w); if (BOTH(pb + 0)) GRID_BAR(); }
        KON(2) if (IN(pb + 1)) {
            pg8::Gemm g{(const bf16*)(A.ws + WS_H), (const bf16*)(A.ws + WS_WIN) + (size_t)l * INCP * DM, MTOK, INCP, DM}; pg8::StaticOrder S; S.init(MTOK, INCP, w.G, (int)blockIdx.x);
            pg8::EpiF32 E{(float*)(A.ws + WS_P), INCP};
            pg8::gemm_phase<pg8::EpiF32, pg8::StaticOrder, true, true>(ring, g, S, E);
            if (BOTH(pb + 1)) GRID_BAR();
        }
        KON(3) if (IN(pb + 2)) {
            for (int m = w.gw; m < MTOK; m += w.NGW) { rwkv_prep(A, l, m, w.lane); dsa_prep(A, l, m, w.lane); }
            if (BOTH(pb + 2)) GRID_BAR();
        }
        KON(4) if (IN(pb + 3)) {
            if (w.vcu < 32) ret_scan(A, w, w.vcu); else if (w.vcu < 64) rwkv_scan(A, w, w.vcu - 32);
            __syncthreads();
            for (int it = w.gw; it < MTOK * 4; it += w.NGW) sb_row(A, it, w.lane);
            { LAS float* sqi = (LAS float*)(w.lds + w.wave * 1024); for (int m = w.gw; m < MTOK; m += w.NGW) dsa_score_row(A, m, w.lane, sqi); }
            if (BOTH(pb + 3)) GRID_BAR();
        }
        KON(5) if (IN(pb + 4)) {
            LAS float* wl = (LAS float*)(w.lds + (w.wave & 3) * 22528);
            if (w.wave < 4) for (int m = w.vcu * 4 + w.wave; m < MTOK; m += w.G * 4) dsa_attend_row(A, m, w.lane, wl);
            if (BOTH(pb + 4)) GRID_BAR();
        }
        KON(6) if (IN(pb + 5)) {
            for (int m = w.gw; m < MTOK; m += w.NGW) post_row(A, l, m, w.lane);
            if (BOTH(pb + 5)) GRID_BAR();
        }
        KON(7) if (IN(pb + 6)) {
            pg8::Gemm g{(const bf16*)(A.ws + WS_MIX), (const bf16*)(A.ws + WS_WOUT) + (size_t)l * DM * DM, MTOK, DM, DM}; pg8::StaticOrder S; S.init(MTOK, DM, w.G, (int)blockIdx.x);
            pg8::EpiRes E{l == 0 ? A.in[I_X] : (const float*)(A.ws + WS_XA), (float*)(A.ws + WS_XA), MODL + 2 * 1024};
            pg8::gemm_phase<pg8::EpiRes, pg8::StaticOrder, true, true>(ring, g, S, E);
            if (BOTH(pb + 6)) GRID_BAR();
        }
        KON(8) if (IN(pb + 7)) {
            for (int m = w.gw; m < MTOK; m += w.NGW) router_row(A, l, m, w.lane);
            if (BOTH(pb + 7)) GRID_BAR();
        }
        KON(9) if (IN(pb + 8)) {
            build_expert_table(A, w, l);
            for (int m = w.gw; m < MTOK; m += w.NGW) scatter_row(A, w, l, m);
            if (BOTH(pb + 8)) GRID_BAR();
        }
        KON(10) if (IN(pb + 9)) {
            build_expert_table(A, w, l);
            pg8::Gemm g{(const bf16*)(A.ws + WS_XS), (const bf16*)(A.ws + WS_W1) + (size_t)l * NEXP * 2048 * DM, MOE_ROWS, NEXP * 2048, DM};
            pg8::MoeOrder S{(const PG8_LAS int*)(w.lds + TST_OFF), 8, w.G, w.vcu};
            pg8::EpiSwiglu E{(bf16*)(A.ws + WS_ACT), A.in[I_MB1] + (size_t)l * NEXP * 2048};
            pg8::gemm_phase<pg8::EpiSwiglu, pg8::MoeOrder, true, true>(ring, g, S, E);
            if (BOTH(pb + 9)) GRID_BAR();
        }
        KON(11) if (IN(pb + 10)) {
            build_expert_table(A, w, l);
            pg8::Gemm g{(const bf16*)(A.ws + WS_ACT), (const bf16*)(A.ws + WS_W2) + (size_t)l * NEXP * DM * DM, MOE_ROWS, NEXP * DM, DM};
            pg8::MoeOrder S{(const PG8_LAS int*)(w.lds + TST_OFF), 4, w.G, w.vcu};
            pg8::EpiY E{(bf16*)(A.ws + WS_XS), A.in[I_MB2] + (size_t)l * NEXP * DM};
            pg8::gemm_phase<pg8::EpiY, pg8::MoeOrder, true, true>(ring, g, S, E);
            if (BOTH(pb + 10)) GRID_BAR();
        }
        KON(12) if (IN(pb + 11)) {
            for (int m = w.gw; m < MTOK; m += w.NGW) combine_row(A, l, m, w.lane);
            if (BOTH(pb + 11)) GRID_BAR();
        }
    }
#undef IN
#undef KON
#undef BOTH
}


template <int K> static void launch_one(int grid, hipStream_t stream, const Args& a) {
    static bool attr = false;
    if (!attr) { (void)hipFuncSetAttribute((const void*)fwd<K>, hipFuncAttributeMaxDynamicSharedMemorySize, LDS_BYTES); attr = true; }
    hipLaunchKernelGGL(fwd<K>, dim3(grid), dim3(NWAVES * 64), LDS_BYTES, stream, a);
}
static void launch_kind(int kind, int grid, hipStream_t stream, const Args& a) {
    switch (kind) {
        case 0: launch_one<0>(grid, stream, a); break; case 1: launch_one<1>(grid, stream, a); break; case 2: launch_one<2>(grid, stream, a); break;
        case 3: launch_one<3>(grid, stream, a); break; case 4: launch_one<4>(grid, stream, a); break; case 5: launch_one<5>(grid, stream, a); break;
        case 6: launch_one<6>(grid, stream, a); break; case 7: launch_one<7>(grid, stream, a); break; case 8: launch_one<8>(grid, stream, a); break;
        case 9: launch_one<9>(grid, stream, a); break; case 10: launch_one<10>(grid, stream, a); break; case 11: launch_one<11>(grid, stream, a); break;
        default: launch_one<12>(grid, stream, a); break;
    }
}
extern "C" void kernel_launch(void* const* d_in, const int* in_sizes, int n_in, void* d_out, int out_size, void* d_ws, size_t ws_size, hipStream_t stream) {
    static int grid = 0;
    if (grid == 0) {
        if (n_in != N_IN || out_size != MTOK * DM || ws_size < WS_END) { fprintf(stderr, "kernel_launch: unexpected shapes (n_in %d, out %d, ws %zu)\n", n_in, out_size, ws_size); grid = -1; return; }
        int dev = 0, cus = 0;
        if (hipGetDevice(&dev) != hipSuccess || hipDeviceGetAttribute(&cus, hipDeviceAttributeMultiprocessorCount, dev) != hipSuccess) { grid = -1; return; }
        if constexpr (N_LAUNCHES == 1) {
            if (hipFuncSetAttribute((const void*)fwd<-1>, hipFuncAttributeMaxDynamicSharedMemorySize, LDS_BYTES) != hipSuccess) { fprintf(stderr, "kernel_launch: hipFuncSetAttribute failed\n"); grid = -1; return; }
            int per_cu = 0;
            if (hipOccupancyMaxActiveBlocksPerMultiprocessor(&per_cu, (const void*)fwd<-1>, NWAVES * 64, LDS_BYTES) != hipSuccess || per_cu < 1) fprintf(stderr, "kernel_launch: occupancy query says %d\n", per_cu);
            (void)hipGetLastError();
        }
        grid = cus;
    }
    if (grid < 0) return;
    (void)in_sizes;
    if (hipMemsetAsync((char*)d_ws + WS_CTL, 0, CTL_ZERO_BYTES, stream) != hipSuccess) return;
    Args a{};
    for (int i = 0; i < N_IN; ++i) a.in[i] = (const float*)d_in[i];
    a.out = (float*)d_out; a.ws = (unsigned char*)d_ws;
    for (int f = 0; f < 44; ++f) a.invf[f] = (f < 32) ? pow(10000.0, -(double)f / 32.0) : (f < 40) ? pow(500000.0, -(double)(f - 32) / 8.0) : pow(500000.0, -(double)(f - 40) / 4.0);
    if constexpr (N_LAUNCHES == 1) {
        a.ph_lo = 0; a.ph_hi = NPHASE; a.li = 0;
        hipLaunchKernelGGL(fwd<-1>, dim3(grid), dim3(NWAVES * 64), LDS_BYTES, stream, a);
    } else {
        for (int p = 0; p < NPHASE; ++p) {
            if (p == 1 + NPL) continue;
            a.ph_lo = p; a.ph_hi = p + 1; a.li = p;
            const int kind = (p == 0) ? 0 : 1 + (p - 1) % NPL;
            launch_kind(kind, grid, stream, a);
        }
    }
}
```

```cpp
#include <hip/hip_runtime.h>
#include <cstdio>
#include <cstdint>
#include <cmath>

#ifndef MK_N_LAUNCHES
#define MK_N_LAUNCHES 1
#endif

namespace pg8 {
#define PG8_LAS __attribute__((address_space(3)))
typedef unsigned short bf16_t;
typedef short bf16x8 __attribute__((ext_vector_type(8)));
typedef float f32x4 __attribute__((ext_vector_type(4)));
typedef unsigned u32x4 __attribute__((ext_vector_type(4)));
typedef unsigned u32x2 __attribute__((ext_vector_type(2)));
constexpr int BM = 256, BK = 64, HALF = 128, HTB = HALF * BK * 2  , STAGE_BYTES = 8 * HTB, NXCD = 8, WGM = 8;

__host__ __device__ __forceinline__ int lds_byte(int r, int c) { const int st = (r >> 4) * 2 + (c >> 5), rr = r & 15, cc = c & 31, ob = rr * 64 + cc * 2; return st * 1024 + (ob ^ (((ob >> 9) & 1) << 5)); }
__host__ __device__ __forceinline__ void stage_rc(int b, int& R, int& C) { const int st = b / 1024, sb = b % 1024, swz = sb ^ (((sb >> 9) & 1) << 5); R = (st >> 1) * 16 + swz / 64; C = (st & 1) * 32 + (swz % 64) / 2; }
__host__ __device__ __forceinline__ int perm32(int rho) { const int n = rho >> 4, i = rho & 15; return 8 * (i >> 2) + 4 * n + (i & 3); }

struct Unit { int pm, pn; };
struct Gemm { const bf16_t* A; const bf16_t* Bt; int M, N, K; };

struct StaticOrder {
    int nM, nN, nwg, G, c;
    __host__ __device__ void init(int M, int N, int G_, int c_) { nM = M / BM; nN = N / BM; nwg = nM * nN; G = G_; c = c_; }
    __host__ __device__ bool next(int i, Unit& u) const {
        const long L = (long)i * G + c; if (L >= nwg) return false;
        int wgid = (int)L; { const int q = nwg / NXCD, r = nwg % NXCD, xcd = wgid % NXCD, off = wgid / NXCD; wgid = (xcd < r ? xcd * (q + 1) : r * (q + 1) + (xcd - r) * q) + off; }
        const int nig = WGM * nN, gid = wgid / nig, fm = gid * WGM, gsz = (nM - fm) < WGM ? (nM - fm) : WGM;
        u.pm = fm + ((wgid % nig) % gsz); u.pn = (wgid % nig) / gsz; return true;
    }
    __device__ __forceinline__ void a_ready(const Unit&) const {}
    __device__ __forceinline__ void done(const Unit&) const {}
};
__device__ __forceinline__ unsigned cvt_pk_bf16(float lo, float hi) { unsigned r; asm volatile("v_cvt_pk_bf16_f32 %0, %1, %2" : "=v"(r) : "v"(lo), "v"(hi)); return r; }
struct EpiF32 {
    static constexpr bool PERM = false, AFTER_DRAIN = false;
    float* C; int ldc;
    __device__ __forceinline__ void operator()(const f32x4 (&acc)[2][2][4][2], const Unit& u, int wr, int wc, int fr, int fq) const {
        const int row0 = u.pm * BM + wr * 64 + fr, col0 = u.pn * BM + wc * 32 + 4 * fq;
#pragma unroll
        for (int ai = 0; ai < 2; ++ai)
#pragma unroll
            for (int m = 0; m < 4; ++m) { float* rowp = C + (size_t)(row0 + ai * HALF + m * 16) * ldc + col0;
#pragma unroll
                for (int bj = 0; bj < 2; ++bj)
#pragma unroll
                    for (int n = 0; n < 2; ++n) *(f32x4*)(rowp + bj * HALF + n * 16) = acc[ai][bj][m][n]; }
    }
};
struct EpiRes {
    static constexpr bool PERM = false, AFTER_DRAIN = false;
    const float* xin; float* xout; const float* gate;
    __device__ __forceinline__ void operator()(const f32x4 (&acc)[2][2][4][2], const Unit& u, int wr, int wc, int fr, int fq) const {
        const int row0 = u.pm * BM + wr * 64 + fr, col0 = u.pn * BM + wc * 32 + 4 * fq;
        const float* gp = gate + (size_t)((u.pm * BM) >> 12) * 6144 + col0;
        f32x4 gv[2][2];
#pragma unroll
        for (int bj = 0; bj < 2; ++bj)
#pragma unroll
            for (int n = 0; n < 2; ++n) gv[bj][n] = *(const f32x4*)(gp + bj * HALF + n * 16);
#pragma unroll
        for (int ai = 0; ai < 2; ++ai)
#pragma unroll
            for (int m = 0; m < 4; ++m) { const size_t ro = (size_t)(row0 + ai * HALF + m * 16) * 1024 + col0;
#pragma unroll
                for (int bj = 0; bj < 2; ++bj)
#pragma unroll
                    for (int n = 0; n < 2; ++n) { const f32x4 xv = *(const f32x4*)(xin + ro + bj * HALF + n * 16); *(f32x4*)(xout + ro + bj * HALF + n * 16) = xv + gv[bj][n] * acc[ai][bj][m][n]; } }
    }
};
__device__ __forceinline__ float swiglu1(float glu, float lin) {
    glu = fminf(glu, 7.0f); lin = fminf(fmaxf(lin, -7.0f), 7.0f);
    return glu * (1.0f / (1.0f + __expf(-1.702f * glu))) * (lin + 1.0f);
}
struct EpiSwiglu {
    static constexpr bool PERM = true, AFTER_DRAIN = false;
    bf16_t* O; const float* b1;
    __device__ __forceinline__ void operator()(const f32x4 (&acc)[2][2][4][2], const Unit& u, int wr, int wc, int fr, int fq) const {
        const int e = u.pn >> 3, j = u.pn & 7, row0 = u.pm * BM + wr * 64 + fr, c0 = 128 * j + wc * 32 + 8 * fq;
        const float* bp = b1 + (size_t)e * 2048 + c0;
        f32x4 bg[2], bl[2];
#pragma unroll
        for (int n = 0; n < 2; ++n) { bg[n] = *(const f32x4*)(bp + 4 * n); bl[n] = *(const f32x4*)(bp + 1024 + 4 * n); }
#pragma unroll
        for (int ai = 0; ai < 2; ++ai)
#pragma unroll
            for (int m = 0; m < 4; ++m) { bf16_t* rowp = O + (size_t)(row0 + ai * HALF + m * 16) * 1024 + c0;
                const f32x4 g0 = acc[ai][0][m][0] + bg[0], g1 = acc[ai][0][m][1] + bg[1], l0 = acc[ai][1][m][0] + bl[0], l1 = acc[ai][1][m][1] + bl[1];
                u32x4 w;
                w.x = cvt_pk_bf16(swiglu1(g0[0], l0[0]), swiglu1(g0[1], l0[1])); w.y = cvt_pk_bf16(swiglu1(g0[2], l0[2]), swiglu1(g0[3], l0[3]));
                w.z = cvt_pk_bf16(swiglu1(g1[0], l1[0]), swiglu1(g1[1], l1[1])); w.w = cvt_pk_bf16(swiglu1(g1[2], l1[2]), swiglu1(g1[3], l1[3]));
                *(u32x4*)rowp = w; }
    }
};
struct EpiY {
    static constexpr bool PERM = true, AFTER_DRAIN = false;
    bf16_t* O; const float* b2;
    __device__ __forceinline__ void operator()(const f32x4 (&acc)[2][2][4][2], const Unit& u, int wr, int wc, int fr, int fq) const {
        const int e = u.pn >> 2, j = u.pn & 3, row0 = u.pm * BM + wr * 64 + fr, c0 = 256 * j + wc * 32 + 8 * fq;
        const float* bp = b2 + (size_t)e * 1024 + c0;
        f32x4 bv[2][2];
#pragma unroll
        for (int bj = 0; bj < 2; ++bj)
#pragma unroll
            for (int n = 0; n < 2; ++n) bv[bj][n] = *(const f32x4*)(bp + bj * HALF + 4 * n);
#pragma unroll
        for (int ai = 0; ai < 2; ++ai)
#pragma unroll
            for (int m = 0; m < 4; ++m) { bf16_t* rowp = O + (size_t)(row0 + ai * HALF + m * 16) * 1024 + c0;
#pragma unroll
                for (int bj = 0; bj < 2; ++bj) { const f32x4 v0 = acc[ai][bj][m][0] + bv[bj][0], v1 = acc[ai][bj][m][1] + bv[bj][1];
                    u32x4 w; w.x = cvt_pk_bf16(v0[0], v0[1]); w.y = cvt_pk_bf16(v0[2], v0[3]); w.z = cvt_pk_bf16(v1[0], v1[1]); w.w = cvt_pk_bf16(v1[2], v1[3]);
                    *(u32x4*)(rowp + bj * HALF) = w; } }
    }
};
struct MoeOrder {
    const PG8_LAS int* tab; int NJ, G, c;
    __device__ __forceinline__ bool next(int i, Unit& u) const {
        const int T = tab[0]; const long L = (long)i * G + c; if (L >= (long)T * NJ) return false;
        const int pm = (int)(L / NJ), j = (int)(L % NJ);
        u.pm = pm; u.pn = tab[1 + pm] * NJ + j; return true;
    }
    __device__ __forceinline__ void a_ready(const Unit&) const {}
    __device__ __forceinline__ void done(const Unit&) const {}
};

template <class Epi, class Sched, bool ALIGN_EPI = false, bool SP2 = false>
__device__ __forceinline__ void gemm_phase(PG8_LAS unsigned char* lds, const Gemm g, const Sched& S, const Epi& E) {
    int tid_ = threadIdx.x; asm volatile("" : "+v"(tid_));
    const int tid = tid_, wid = __builtin_amdgcn_readfirstlane(tid >> 6), lane = tid & 63, wr = wid >> 2, wc = wid & 3, fr = lane & 15, fq = lane >> 4;
    const int K = g.K, nt = K / BK;
    unsigned voffA[2], voffB[2];
#pragma unroll
    for (int i = 0; i < 2; ++i) { int R, C; stage_rc(tid * 16 + i * 8192, R, C); const int Rb = Epi::PERM ? ((R & ~31) + perm32(R & 31)) : R;
        voffA[i] = (unsigned)(R * K + C) * 2u; voffB[i] = (unsigned)(Rb * K + C) * 2u; }
    const size_t kstep = (size_t)(BK * 2);
    const size_t hstep = (size_t)HALF * K * 2;
    const size_t tstep = 2 * hstep;
    const unsigned ldsw = (unsigned)wid * 1024u;
    const int aoff = lds_byte(wr * 64 + fr, fq * 8), boff = lds_byte(wc * 32 + fr, fq * 8);
#define PG8_SA(b, h) (((b) * 2 + (h)) * HTB)
#define PG8_SB(b, h) ((4 + (b) * 2 + (h)) * HTB)
#define PG8_STAGE(bufoff, gbase, voff) do { _Pragma("unroll") for (int _i = 0; _i < 2; ++_i) \
        __builtin_amdgcn_global_load_lds((const unsigned*)((const char*)(gbase) + (voff)[_i]), (PG8_LAS unsigned*)(lds + (bufoff) + ldsw + _i * 8192), 16, 0, 0); } while (0)
#define PG8_LDA(dst, b, h) do { _Pragma("unroll") for (int m = 0; m < 4; ++m) _Pragma("unroll") for (int k = 0; k < 2; ++k) dst[m][k] = *(const PG8_LAS bf16x8*)(lds + PG8_SA(b, h) + aoff + m * 2048 + k * 1024); } while (0)
#define PG8_LDB(dst, b, h) do { _Pragma("unroll") for (int n = 0; n < 2; ++n) _Pragma("unroll") for (int k = 0; k < 2; ++k) dst[n][k] = *(const PG8_LAS bf16x8*)(lds + PG8_SB(b, h) + boff + n * 2048 + k * 1024); } while (0)
#define PG8_MMA(ai, bj, At, Bt) do { __builtin_amdgcn_s_setprio(1); _Pragma("unroll") for (int m = 0; m < 4; ++m) _Pragma("unroll") for (int n = 0; n < 2; ++n) _Pragma("unroll") for (int k = 0; k < 2; ++k) \
        acc[ai][bj][m][n] = __builtin_amdgcn_mfma_f32_16x16x32_bf16(Bt[n][k], At[m][k], acc[ai][bj][m][n], 0, 0, 0); __builtin_amdgcn_s_setprio(0); } while (0)
#define PG8_WAIT_V(n) asm volatile("s_waitcnt vmcnt(" #n ")" ::: "memory")
#define PG8_WAIT_L(n) asm volatile("s_waitcnt lgkmcnt(" #n ")" ::: "memory")
#define PG8_BAR __builtin_amdgcn_s_barrier()
#define PG8_SCHED __builtin_amdgcn_sched_barrier(0)
    Unit cur, nxt; int ui = 0;
    if (!S.next(0, cur)) return;
    f32x4 acc[2][2][4][2];
#pragma unroll
    for (int a = 0; a < 2; ++a)
#pragma unroll
        for (int b = 0; b < 2; ++b)
#pragma unroll
            for (int m = 0; m < 4; ++m)
#pragma unroll
                for (int n = 0; n < 2; ++n) acc[a][b][m][n] = (f32x4){0.f, 0.f, 0.f, 0.f};
    bf16x8 At[4][2], B0[2][2], B1[2][2];
    const char* cA = (const char*)g.A + (size_t)cur.pm * tstep; const char* cB = (const char*)g.Bt + (size_t)cur.pn * tstep;
    S.a_ready(cur);
    if constexpr (SP2) {
        PG8_STAGE(PG8_SB(0, 0), cB, voffB); PG8_STAGE(PG8_SB(0, 1), cB + hstep, voffB); PG8_STAGE(PG8_SA(0, 0), cA, voffA); PG8_STAGE(PG8_SA(0, 1), cA + hstep, voffA);
        if (wr == 1) PG8_BAR;
        PG8_WAIT_V(2); PG8_BAR;
        PG8_STAGE(PG8_SB(1, 0), cB + kstep, voffB); PG8_STAGE(PG8_SA(1, 0), cA + kstep, voffA); PG8_STAGE(PG8_SB(1, 1), cB + hstep + kstep, voffB);
        PG8_WAIT_V(6); PG8_BAR;
    } else {
        PG8_STAGE(PG8_SB(0, 0), cB, voffB); PG8_STAGE(PG8_SA(0, 0), cA, voffA); PG8_STAGE(PG8_SB(0, 1), cB + hstep, voffB); PG8_STAGE(PG8_SA(0, 1), cA + hstep, voffA);
        if (wr == 1) PG8_BAR;
        PG8_WAIT_V(4); PG8_BAR;
        PG8_STAGE(PG8_SB(1, 0), cB + kstep, voffB); PG8_STAGE(PG8_SA(1, 0), cA + kstep, voffA); PG8_STAGE(PG8_SB(1, 1), cB + hstep + kstep, voffB);
        PG8_WAIT_V(6); PG8_BAR;
    }
    for (;;) {
        const bool has_next = S.next(ui + 1, nxt);
        const char* nA = has_next ? (const char*)g.A + (size_t)nxt.pm * tstep : cA; const char* nB = has_next ? (const char*)g.Bt + (size_t)nxt.pn * tstep : cB;
        for (int t = 0; t < nt; t += 2) {
            const bool last = (t == nt - 2);
            const char* a1 = cA + (size_t)(t + 1) * kstep;
            const char* a2 = last ? nA : cA + (size_t)(t + 2) * kstep; const char* b2 = last ? nB : cB + (size_t)(t + 2) * kstep;
            const char* a3 = a2 + kstep; const char* b3 = b2 + kstep;
            if (last && has_next) S.a_ready(nxt);
            if constexpr (SP2) {
            PG8_LDB(B0, 0, 0); PG8_LDB(B1, 0, 1); PG8_SCHED; PG8_LDA(At, 0, 0); PG8_STAGE(PG8_SA(1, 1), a1 + hstep, voffA);
            PG8_WAIT_V(8); PG8_WAIT_L(0); PG8_BAR; PG8_MMA(0, 0, At, B0); PG8_MMA(0, 1, At, B1); PG8_BAR; PG8_SCHED;
            PG8_LDA(At, 0, 1); PG8_STAGE(PG8_SB(0, 0), b2, voffB); PG8_STAGE(PG8_SB(0, 1), b2 + hstep, voffB); PG8_STAGE(PG8_SA(0, 0), a2, voffA);
            PG8_WAIT_V(8); PG8_WAIT_L(0); PG8_BAR; PG8_MMA(1, 0, At, B0); PG8_MMA(1, 1, At, B1); PG8_BAR; PG8_SCHED;
            PG8_LDB(B0, 1, 0); PG8_LDB(B1, 1, 1); PG8_SCHED; PG8_LDA(At, 1, 0); PG8_STAGE(PG8_SA(0, 1), a2 + hstep, voffA);
            PG8_WAIT_V(8); PG8_WAIT_L(0); PG8_BAR; PG8_MMA(0, 0, At, B0); PG8_MMA(0, 1, At, B1); PG8_BAR; PG8_SCHED;
            PG8_LDA(At, 1, 1); PG8_STAGE(PG8_SB(1, 0), b3, voffB); PG8_STAGE(PG8_SB(1, 1), b3 + hstep, voffB); PG8_STAGE(PG8_SA(1, 0), a3, voffA);
            PG8_WAIT_V(8); PG8_WAIT_L(0); PG8_BAR; PG8_MMA(1, 0, At, B0); PG8_MMA(1, 1, At, B1); PG8_BAR; PG8_SCHED;
            } else {
            PG8_LDB(B0, 0, 0); PG8_SCHED; PG8_LDA(At, 0, 0); PG8_STAGE(PG8_SA(1, 1), a1 + hstep, voffA);
            PG8_WAIT_L(8); PG8_BAR; PG8_WAIT_L(0); PG8_MMA(0, 0, At, B0); PG8_BAR; PG8_SCHED;
            PG8_LDB(B1, 0, 1); PG8_STAGE(PG8_SB(0, 0), b2, voffB);
            PG8_BAR; PG8_WAIT_L(0); PG8_MMA(0, 1, At, B1); PG8_BAR;
            PG8_LDA(At, 0, 1); PG8_STAGE(PG8_SA(0, 0), a2, voffA);
            PG8_BAR; PG8_WAIT_L(0); PG8_MMA(1, 0, At, B0); PG8_BAR; PG8_SCHED;
            PG8_STAGE(PG8_SB(0, 1), b2 + hstep, voffB);
            PG8_WAIT_V(6); PG8_BAR; PG8_MMA(1, 1, At, B1); PG8_BAR;
            PG8_LDB(B0, 1, 0); PG8_SCHED; PG8_LDA(At, 1, 0); PG8_STAGE(PG8_SA(0, 1), a2 + hstep, voffA);
            PG8_WAIT_L(8); PG8_BAR; PG8_WAIT_L(0); PG8_MMA(0, 0, At, B0); PG8_BAR; PG8_SCHED;
            PG8_LDB(B1, 1, 1); PG8_STAGE(PG8_SB(1, 0), b3, voffB);
            PG8_BAR; PG8_WAIT_L(0); PG8_MMA(0, 1, At, B1); PG8_BAR;
            PG8_LDA(At, 1, 1); PG8_STAGE(PG8_SA(1, 0), a3, voffA);
            PG8_BAR; PG8_WAIT_L(0); PG8_MMA(1, 0, At, B0); PG8_BAR; PG8_SCHED;
            PG8_STAGE(PG8_SB(1, 1), b3 + hstep, voffB);
            PG8_WAIT_V(6); PG8_BAR; PG8_MMA(1, 1, At, B1); PG8_BAR;
            }
        }
        if constexpr (ALIGN_EPI) { if (wr == 0) PG8_BAR; }
        if constexpr (!Epi::AFTER_DRAIN) { E(acc, cur, wr, wc, fr, fq); S.done(cur); }
        if (!has_next) break;
#pragma unroll
        for (int a = 0; a < 2; ++a)
#pragma unroll
            for (int b = 0; b < 2; ++b)
#pragma unroll
                for (int m = 0; m < 4; ++m)
#pragma unroll
                    for (int n = 0; n < 2; ++n) acc[a][b][m][n] = (f32x4){0.f, 0.f, 0.f, 0.f};
        cur = nxt; cA = nA; cB = nB; ++ui;
        if constexpr (ALIGN_EPI) { if (wr == 1) PG8_BAR; }
    }
    PG8_WAIT_V(0);
    if constexpr (!ALIGN_EPI) { if (wr == 0) PG8_BAR; }
    PG8_BAR;
    if constexpr (Epi::AFTER_DRAIN) { E.fused(acc, cur, wr, wc, fr, fq, lds, wid, lane); S.done(cur); }
#undef PG8_SA
#undef PG8_SB
#undef PG8_STAGE
#undef PG8_LDA
#undef PG8_LDB
#undef PG8_MMA
#undef PG8_WAIT_V
#undef PG8_WAIT_L
#undef PG8_BAR
#undef PG8_SCHED
}
}

constexpr int NWAVES = 8;
constexpr int NB = 8, SEQ = 4096, DM = 1024, MTOK = NB * SEQ, NLAYER = 2;
constexpr int INC = 2984, INCP = 3072;
constexpr int C_RET = 0, C_RW = 1024, C_DSA = 1920, C_SB = 2216;
constexpr int NEXP = 32, MOE_ROWS = MTOK * 4 + NEXP * 256;
constexpr int ROPE_W = 88;
constexpr int NPL = 12, NPHASE = 1 + NLAYER * NPL;
enum { I_X = 0, I_C, I_POS, I_ADAW, I_ADAB, I_NMIX, I_NFFN, I_WIN, I_RETGN, I_MU, I_W0, I_W2, I_A0, I_A2, I_G2, I_KK, I_KA, I_RK, I_LN, I_QNORM, I_WQ, I_WQI, I_DONORM, I_SONORM, I_WOUT, I_RW, I_RB, I_MW1, I_MB1, I_MW2, I_MB2, I_NFINAL, N_IN };

constexpr size_t MiB = 1u << 20;
constexpr size_t WS_CTL = 0, CTL_ZERO_BYTES = 1 * MiB;
constexpr size_t WS_MOD = 1 * MiB, WS_ROPE = 2 * MiB, WS_WIN = 14 * MiB, WS_WOUT = 26 * MiB, WS_W1 = 30 * MiB, WS_W2 = 286 * MiB;
constexpr size_t WS_XA = 414 * MiB, WS_H = 542 * MiB, WS_MIX = 606 * MiB, WS_TOPI = 670 * MiB, WS_TOPW = 671 * MiB, WS_POS = 672 * MiB;
constexpr size_t WS_R = 674 * MiB;
constexpr size_t WS_P = WS_R, WS_RWA = 1058 * MiB  , WS_DQ = 1314 * MiB, WS_DQI = 1346 * MiB, WS_DK = 1378 * MiB, WS_DV = 1386 * MiB, WS_DKI = 1394 * MiB, WS_DW = 1398 * MiB;
constexpr size_t WS_YO = 1400 * MiB  , WS_SC = 1528 * MiB  ;
constexpr size_t WS_XS = WS_R  , WS_ACT = 946 * MiB  ;
constexpr size_t WS_END = 2040 * MiB;
static_assert((size_t)MOE_ROWS * 2048 <= 272 * MiB, "moe buffers");
constexpr int CW_TMO = 0, CW_CODE = 1, CW_BAR = 4096, CW_CNT = 8192  , CW_CUR = 8320  ;
constexpr int RING_BYTES = 131072, MISC_OFF = RING_BYTES + 320, TST_OFF = RING_BYTES + 1024  , TAB_OFF = RING_BYTES + 2048  , LDS_BYTES = 147456;

#if defined(__HIP_DEVICE_COMPILE__)
#define GAS __attribute__((address_space(1)))
#define CAS __attribute__((address_space(4)))
#else
#define GAS
#define CAS
#endif
#define LAS __attribute__((address_space(3)))
typedef unsigned short bf16;
typedef unsigned v4u __attribute__((ext_vector_type(4)));
typedef unsigned v2u __attribute__((ext_vector_type(2)));
typedef float f32x4 __attribute__((ext_vector_type(4)));
typedef GAS unsigned gu32;
#define RLX_AGENT __ATOMIC_RELAXED, __HIP_MEMORY_SCOPE_AGENT
#define LDS_WAIT() asm volatile("s_waitcnt lgkmcnt(0)" ::: "memory")
#define VM_WAIT() asm volatile("s_waitcnt vmcnt(0)" ::: "memory")
__device__ __forceinline__ unsigned f2bf(float f) { unsigned u = __builtin_bit_cast(unsigned, f); return (u + 0x7fffu + ((u >> 16) & 1u)) >> 16; }
__device__ __forceinline__ unsigned pk2(float lo, float hi) { return f2bf(lo) | (f2bf(hi) << 16); }
__device__ __forceinline__ float bf_lo(unsigned w) { return __builtin_bit_cast(float, w << 16); }
__device__ __forceinline__ float bf_hi(unsigned w) { return __builtin_bit_cast(float, w & 0xffff0000u); }
__device__ __forceinline__ float wave_sum(float v) {
#pragma unroll
    for (int o = 1; o < 64; o <<= 1) v += __shfl_xor(v, o);
    return v;
}
__device__ __forceinline__ float wave_max(float v) {
#pragma unroll
    for (int o = 1; o < 64; o <<= 1) v = fmaxf(v, __shfl_xor(v, o));
    return v;
}
__device__ __forceinline__ float grp16_sum(float v) { v += __shfl_xor(v, 1); v += __shfl_xor(v, 2); v += __shfl_xor(v, 4); v += __shfl_xor(v, 8); return v; }
__device__ __forceinline__ float grp8_sum(float v) { v += __shfl_xor(v, 1); v += __shfl_xor(v, 2); v += __shfl_xor(v, 4); return v; }
__device__ __forceinline__ float sum4(f32x4 a) { return (a.x + a.y) + (a.z + a.w); }
__device__ __forceinline__ float dot4(f32x4 a, f32x4 b) { return (a.x * b.x + a.y * b.y) + (a.z * b.z + a.w * b.w); }
__device__ __forceinline__ float sigm(float x) { return 1.0f / (1.0f + expf(-x)); }
__device__ __forceinline__ float softplusf(float x) { return fmaxf(x, 0.0f) + log1pf(expf(-fabsf(x))); }
__device__ __forceinline__ f32x4 shx4(f32x4 v, int m) { f32x4 r; r.x = __shfl_xor(v.x, m); r.y = __shfl_xor(v.y, m); r.z = __shfl_xor(v.z, m); r.w = __shfl_xor(v.w, m); return r; }

#define XB_TMO      128
#define XB_XCNT(j)  (256  + 64 * (j))
#define XB_XSUB(j)  (1280 + 64 * (j))
#define XB_XGEN(j)  (2304 + 64 * (j))
#define XB_TOP      3328
#define XB_TOPGEN   3392
#define XCD_BAR_WORDS 3456
#define XB_SPIN_CAP (1u << 18)

__device__ __forceinline__ unsigned xb_ld(unsigned* p)              { return __hip_atomic_load(p, __ATOMIC_RELAXED, __HIP_MEMORY_SCOPE_AGENT); }
__device__ __forceinline__ unsigned xb_add(unsigned* p, unsigned v) { return __hip_atomic_fetch_add(p, v, __ATOMIC_RELAXED, __HIP_MEMORY_SCOPE_AGENT); }
__device__ __forceinline__ unsigned xb_xcc_id() { return (unsigned)__builtin_amdgcn_s_getreg((3 << 11) | 20) & 0xFu; }
#define XB_SPIN(cond, bar) do { unsigned _sp = 0; while (cond) { __builtin_amdgcn_s_sleep(1); \
    if ((++_sp & 255u) == 0u) { if (xb_ld(&(bar)[XB_TMO])) break; if (_sp > XB_SPIN_CAP) { atomicAdd(&(bar)[XB_TMO], 1u); break; } } } } while (0)

struct XcdBarrier {
    unsigned* bar; unsigned x;
    volatile LAS unsigned* st;
};

__device__ __forceinline__ XcdBarrier xcd_barrier_post(unsigned* bar, volatile LAS unsigned* st) {
    XcdBarrier b; b.bar = bar; b.x = xb_xcc_id(); b.st = st;
    if (threadIdx.x == 0) (void)xb_add(&bar[XB_XCNT(b.x)], 1u);
    return b;
}
__device__ __forceinline__ void xcd_barrier_complete(unsigned* bar, unsigned x, unsigned& nloc, unsigned& nx) {
    const unsigned G = gridDim.x * gridDim.y * gridDim.z;
    unsigned sum, cnt, mine, sp = 0u;
    for (;;) {
        sum = 0u; cnt = 0u; mine = 0u;
#pragma unroll
        for (unsigned j = 0; j < 16; ++j) { const unsigned c = xb_ld(&bar[XB_XCNT(j)]); sum += c; cnt += (c > 0u) ? 1u : 0u; mine = (j == x) ? c : mine; }
        if (sum == G) break;
        __builtin_amdgcn_s_sleep(1);
        if ((++sp & 255u) == 0u) { if (xb_ld(&bar[XB_TMO])) break; if (sp > XB_SPIN_CAP) { atomicAdd(&bar[XB_TMO], 1u); break; } }
    }
    nloc = mine > 0u ? mine : 1u; nx = cnt > 0u ? cnt : 1u;
}

__device__ __forceinline__ void xcd_barrier(const XcdBarrier& b) {
    asm volatile("s_waitcnt vmcnt(0)" ::: "memory");
    __syncthreads();
    if (threadIdx.x == 0) {
        unsigned* bar = b.bar;
        __builtin_amdgcn_s_waitcnt(0);
        unsigned nloc = b.st[0], nx = b.st[1];
        if (nloc == 0u) { xcd_barrier_complete(bar, b.x, nloc, nx); b.st[0] = nloc; b.st[1] = nx; }
        const unsigned old = xb_add(&bar[XB_XSUB(b.x)], 1u);
        const unsigned gen = old / nloc;
        if (old + 1u == (gen + 1u) * nloc) {
            __builtin_amdgcn_fence(__ATOMIC_RELEASE, "agent");
            asm volatile("s_waitcnt vmcnt(0)" ::: "memory");
            const unsigned og = xb_add(&bar[XB_TOP], 1u);
            const unsigned tg = og / nx;
            if (og + 1u == (tg + 1u) * nx) xb_add(&bar[XB_TOPGEN], 1u);
            else XB_SPIN(xb_ld(&bar[XB_TOPGEN]) == tg, bar);
            __builtin_amdgcn_fence(__ATOMIC_ACQUIRE, "agent");
            xb_add(&bar[XB_XGEN(b.x)], 1u);
            asm volatile("s_waitcnt vmcnt(0)" ::: "memory");
        } else {
            XB_SPIN(xb_ld(&bar[XB_XGEN(b.x)]) == gen, bar);
            __builtin_amdgcn_fence(__ATOMIC_ACQUIRE, "agent");
            asm volatile("s_waitcnt vmcnt(0)" ::: "memory");
        }
    }
    __syncthreads();
}
struct ArgsH { const float* in[N_IN]; float* out; unsigned char* ws; double invf[44]; int ph_lo, ph_hi, li, pad; };
struct ArgsD { const GAS float* in[N_IN]; GAS float* out; GAS unsigned char* ws; double invf[44]; int ph_lo, ph_hi, li, pad; };
static_assert(sizeof(ArgsH) == sizeof(ArgsD), "args layout");
typedef const CAS ArgsD& ARef;
__device__ __forceinline__ const CAS ArgsD* kargs() {
#if defined(__HIP_DEVICE_COMPILE__)
    const CAS ArgsD* p = (const CAS ArgsD*)__builtin_amdgcn_kernarg_segment_ptr(); asm volatile("" : "+s"(p)); return p;
#else
    return nullptr;
#endif
}
struct WI { LAS unsigned char* lds; int tid, lane, wave, vcu, G, gw, NGW, bx; };
constexpr size_t RWA_STRIDE = 32 * MiB / 4;
constexpr size_t YO_STRIDE = 32 * MiB / 4;

__device__ __forceinline__ int wave_sum_i(int v) {
#pragma unroll
    for (int o = 1; o < 64; o <<= 1) v += __shfl_xor(v, o);
    return v;
}
__device__ __forceinline__ void sincos_d(double ang, float& s, float& c) {
    const double q = __builtin_rint(ang * 0.63661977236758134308);
    double r = __builtin_fma(-q, 1.57079632679489661923, ang); r = __builtin_fma(-q, 6.123233995736766e-17, r);
    const double r2 = r * r;
    const double sp = r * (1.0 + r2 * (-1.0 / 6 + r2 * (1.0 / 120 + r2 * (-1.0 / 5040 + r2 * (1.0 / 362880 + r2 * (-1.0 / 39916800 + r2 * (1.0 / 6227020800.0)))))));
    const double cp = 1.0 + r2 * (-0.5 + r2 * (1.0 / 24 + r2 * (-1.0 / 720 + r2 * (1.0 / 40320 + r2 * (-1.0 / 3628800 + r2 * (1.0 / 479001600 + r2 * (-1.0 / 87178291200.0)))))));
    const int qi = ((int)q) & 3;
    const double ss = (qi == 0) ? sp : (qi == 1) ? cp : (qi == 2) ? -sp : -cp;
    const double cc = (qi == 0) ? cp : (qi == 1) ? -sp : (qi == 2) ? -cp : sp;
    s = (float)ss; c = (float)cc;
}

__device__ __forceinline__ void tr_item(const float* W, int ldw, int nvalid, int k0, int nsrc0, bf16* WT, size_t dstrow0, LAS float* scr, int lane) {
#pragma unroll 8
    for (int i = 0; i < 32; ++i) { const int kk = 2 * i + (lane >> 5), c = lane & 31, n = nsrc0 + c; scr[kk * 33 + c] = (n < nvalid) ? W[(size_t)(k0 + kk) * ldw + n] : 0.0f; }
    LDS_WAIT(); asm volatile("" ::: "memory");
    const int c8 = lane & 7;
#pragma unroll
    for (int j = 0; j < 4; ++j) { const int n = (lane >> 3) + 8 * j; const LAS float* s = scr + (8 * c8) * 33 + n;
        v4u o; o.x = pk2(s[0 * 33], s[1 * 33]); o.y = pk2(s[2 * 33], s[3 * 33]); o.z = pk2(s[4 * 33], s[5 * 33]); o.w = pk2(s[6 * 33], s[7 * 33]);
        *(v4u*)(WT + (dstrow0 + n) * 1024 + k0 + 8 * c8) = o; }
    LDS_WAIT(); asm volatile("" ::: "memory");
}
__device__ __forceinline__ void ph_prologue(ARef A, const WI& w) {
    LAS float* sc = (LAS float*)w.lds;
    { const float* cin = A.in[I_C]; for (int i = w.tid; i < NB * DM; i += NWAVES * 64) { const float v = cin[i]; sc[i] = v / (1.0f + expf(-v)); } }
    __syncthreads();
    float* MOD = (float*)(A.ws + WS_MOD);
    if (w.wave == 0 && w.vcu < 192) {
        const int l = w.vcu / 96, col = (w.vcu % 96) * 64 + w.lane;
        const float* wp = A.in[I_ADAW] + (size_t)l * DM * 6144 + col;
        float acc[8];
#pragma unroll
        for (int b = 0; b < 8; ++b) acc[b] = 0.0f;
        for (int k = 0; k < DM; ++k) { const float wv = wp[(size_t)k * 6144];
#pragma unroll
            for (int b = 0; b < 8; ++b) acc[b] += sc[b * DM + k] * wv; }
        const float bias = A.in[I_ADAB][l * 6144 + col];
#pragma unroll
        for (int b = 0; b < 8; ++b) MOD[(size_t)(l * 8 + b) * 6144 + col] = acc[b] + bias;
    }
    LAS float* scr = (LAS float*)(w.lds + 32768 + w.wave * 8448);
    constexpr int I_IN = NLAYER * 16 * 96, I_OUT = NLAYER * 16 * 32, I_W1 = NLAYER * NEXP * 16 * 64, I_W2 = NLAYER * NEXP * 16 * 32, NIT = I_IN + I_OUT + I_W1 + I_W2;
    for (int it = w.gw; it < NIT; it += w.NGW) {
        int r = it;
        if (r < I_IN) { const int l = r / 1536, rr = r % 1536, kb = rr / 96, nb = rr % 96;
            tr_item(A.in[I_WIN] + (size_t)l * DM * INC, INC, INC, kb * 64, nb * 32, (bf16*)(A.ws + WS_WIN) + (size_t)l * INCP * DM, (size_t)nb * 32, scr, w.lane); continue; }
        r -= I_IN;
        if (r < I_OUT) { const int l = r / 512, rr = r % 512, kb = rr / 32, nb = rr % 32;
            tr_item(A.in[I_WOUT] + (size_t)l * DM * DM, DM, DM, kb * 64, nb * 32, (bf16*)(A.ws + WS_WOUT) + (size_t)l * DM * DM, (size_t)nb * 32, scr, w.lane); continue; }
        r -= I_OUT;
        if (r < I_W1) { const int le = r / 1024, rr = r % 1024, kb = rr / 64, nb = rr % 64, j = nb >> 3, bj = (nb >> 2) & 1, cc0 = (nb & 3) * 32;
            tr_item(A.in[I_MW1] + (size_t)le * DM * 2048, 2048, 2048, kb * 64, bj * 1024 + 128 * j + cc0, (bf16*)(A.ws + WS_W1) + (size_t)le * 2048 * DM, (size_t)nb * 32, scr, w.lane); continue; }
        r -= I_W1;
        { const int le = r / 512, rr = r % 512, kb = rr / 32, nb = rr % 32;
            tr_item(A.in[I_MW2] + (size_t)le * DM * DM, DM, DM, kb * 64, nb * 32, (bf16*)(A.ws + WS_W2) + (size_t)le * DM * DM, (size_t)nb * 32, scr, w.lane); }
    }
    float* RT = (float*)(A.ws + WS_ROPE); const int* pos = (const int*)A.in[I_POS];
    for (int g = w.gw * 64 + w.lane; g < MTOK * 44; g += w.NGW * 64) {
        const int tok = g / 44, f = g % 44; int co, so;
        if (f < 32) { co = f; so = 32 + f; } else if (f < 40) { co = 64 + (f - 32); so = 72 + (f - 32); } else { co = 80 + (f - 40); so = 84 + (f - 40); }
        float s, c; sincos_d((double)pos[tok] * A.invf[f], s, c);
        RT[(size_t)tok * ROPE_W + co] = c; RT[(size_t)tok * ROPE_W + so] = s;
    }
}

__device__ __forceinline__ void emit_h_row(const f32x4 (&v)[4], float rstd, const float* g, const float* sc, const float* sh, bf16* hrow, int lane) {
#pragma unroll
    for (int j = 0; j < 4; ++j) { const int k = 4 * (lane + 64 * j);
        const f32x4 gv = *(const f32x4*)(g + k), scv = *(const f32x4*)(sc + k), shv = *(const f32x4*)(sh + k);
        const f32x4 h = v[j] * rstd * gv * (1.0f + scv) + shv;
        v2u o; o.x = pk2(h.x, h.y); o.y = pk2(h.z, h.w); *(v2u*)(hrow + k) = o; }
}
__device__ __forceinline__ void ph_norm1(ARef A, const WI& w) {
    const float* MOD = (const float*)(A.ws + WS_MOD); bf16* H = (bf16*)(A.ws + WS_H);
    for (int m = w.gw; m < MTOK; m += w.NGW) {
        const float* xr = A.in[I_X] + (size_t)m * DM; f32x4 v[4]; float ss = 0.0f;
#pragma unroll
        for (int j = 0; j < 4; ++j) { v[j] = *(const f32x4*)(xr + 4 * (w.lane + 64 * j)); ss += dot4(v[j], v[j]); }
        ss = wave_sum(ss); const float rstd = 1.0f / sqrtf(ss * (1.0f / DM) + 1e-5f);
        const float* mb = MOD + (size_t)(m >> 12) * 6144;
        emit_h_row(v, rstd, A.in[I_NMIX], mb + 1024, mb, H + (size_t)m * DM, w.lane);
    }
}

__device__ __forceinline__ void rwkv_prep(ARef A, int l, int m, int lane) {
    const float* P = (const float*)(A.ws + WS_P); float* RWA = (float*)(A.ws + WS_RWA);
    const int t = m & (SEQ - 1), c4 = 4 * lane;
    const float* pr = P + (size_t)m * INCP + C_RW; const float* pp = pr - INCP; const float* mu = A.in[I_MU] + l * 896;
    f32x4 fr, fk, fv;
    { const f32x4 z = *(const f32x4*)(pr + c4), mm = *(const f32x4*)(mu + c4); f32x4 p = {0.f, 0.f, 0.f, 0.f}; if (t) p = *(const f32x4*)(pp + c4); fr = z + (p - z) * mm; }
    { const f32x4 z = *(const f32x4*)(pr + 256 + c4), mm = *(const f32x4*)(mu + 256 + c4); f32x4 p = {0.f, 0.f, 0.f, 0.f}; if (t) p = *(const f32x4*)(pp + 256 + c4); fk = z + (p - z) * mm; }
    { const f32x4 z = *(const f32x4*)(pr + 512 + c4), mm = *(const f32x4*)(mu + 512 + c4); f32x4 p = {0.f, 0.f, 0.f, 0.f}; if (t) p = *(const f32x4*)(pp + 512 + c4); fv = z + (p - z) * mm; }
    float x0, x1;
    { const float z = pr[768 + lane], p = t ? pp[768 + lane] : 0.0f; x0 = z + (p - z) * mu[768 + lane]; }
    { const float z = pr[832 + lane], p = t ? pp[832 + lane] : 0.0f; x1 = z + (p - z) * mu[832 + lane]; }
    x0 = (lane < 32) ? tanhf(x0) : x0; x1 = sigm(x1);
    f32x4 wacc = *(const f32x4*)(A.in[I_W0] + l * 256 + c4), aacc = *(const f32x4*)(A.in[I_A0] + l * 256 + c4), gacc = {0.f, 0.f, 0.f, 0.f};
    const float* w2 = A.in[I_W2] + l * 32 * 256 + c4; const float* a2 = A.in[I_A2] + l * 32 * 256 + c4; const float* g2 = A.in[I_G2] + l * 64 * 256 + c4;
#pragma unroll 8
    for (int i = 0; i < 32; ++i) { const float s = __shfl(x0, i); wacc += s * *(const f32x4*)(w2 + i * 256); }
#pragma unroll 8
    for (int i = 0; i < 32; ++i) { const float s = __shfl(x0, 32 + i); aacc += s * *(const f32x4*)(a2 + i * 256); }
#pragma unroll 8
    for (int i = 0; i < 64; ++i) { const float s = __shfl(x1, i); gacc += s * *(const f32x4*)(g2 + i * 256); }
    f32x4 dec, av;
#pragma unroll
    for (int i = 0; i < 4; ++i) { const float wl = -softplusf(-wacc[i]) - 0.5f; dec[i] = expf(-expf(wl)); av[i] = sigm(aacc[i]); }
    f32x4 kk = fk * *(const f32x4*)(A.in[I_KK] + l * 256 + c4);
    const float nrm = fmaxf(sqrtf(grp16_sum(dot4(kk, kk))), 1e-12f); kk = kk / nrm;
    const f32x4 kmod = fk * (1.0f + (av - 1.0f) * *(const f32x4*)(A.in[I_KA] + l * 256 + c4));
    const f32x4 bb = kk * av;
    const float bs = grp16_sum(dot4(fr * kmod, *(const f32x4*)(A.in[I_RK] + l * 256 + c4)));
    const size_t o = (size_t)m * 256 + c4;
    *(f32x4*)(RWA + 0 * RWA_STRIDE + o) = fr; *(f32x4*)(RWA + 1 * RWA_STRIDE + o) = dec; *(f32x4*)(RWA + 2 * RWA_STRIDE + o) = kmod; *(f32x4*)(RWA + 3 * RWA_STRIDE + o) = fv;
    *(f32x4*)(RWA + 4 * RWA_STRIDE + o) = -kk; *(f32x4*)(RWA + 5 * RWA_STRIDE + o) = bb; *(f32x4*)(RWA + 6 * RWA_STRIDE + o) = gacc; *(f32x4*)(RWA + 7 * RWA_STRIDE + o) = bs * fv;
}
__device__ __forceinline__ void dsa_prep(ARef A, int l, int m, int lane) {
    const float* P = (const float*)(A.ws + WS_P); const float* RT = (const float*)(A.ws + WS_ROPE) + (size_t)m * ROPE_W;
    const float* pd = P + (size_t)m * INCP + C_DSA; const int c4 = 4 * lane;
    float c0 = pd[lane], c1 = pd[64 + lane];
    const float rstd = 1.0f / sqrtf(wave_sum(c0 * c0 + c1 * c1) * (1.0f / 128.0f) + 1e-5f);
    c0 *= rstd * A.in[I_QNORM][l * 128 + lane]; c1 *= rstd * A.in[I_QNORM][l * 128 + 64 + lane];
    f32x4 q = {0.f, 0.f, 0.f, 0.f}, qi = {0.f, 0.f, 0.f, 0.f};
    const float* wq = A.in[I_WQ] + (size_t)l * 128 * 256 + c4; const float* wqi = A.in[I_WQI] + (size_t)l * 128 * 256 + c4;
#pragma unroll 8
    for (int i = 0; i < 64; ++i) { const float s = __shfl(c0, i); q += s * *(const f32x4*)(wq + i * 256); qi += s * *(const f32x4*)(wqi + i * 256); }
#pragma unroll 8
    for (int i = 0; i < 64; ++i) { const float s = __shfl(c1, i); q += s * *(const f32x4*)(wq + (64 + i) * 256); qi += s * *(const f32x4*)(wqi + (64 + i) * 256); }
    { const int r = lane & 15; const f32x4 ot = shx4(q, 2);
      if (r < 4) { const int fi = 4 * (r & 1); const f32x4 cs = *(const f32x4*)(RT + 64 + fi), sn = *(const f32x4*)(RT + 72 + fi); q = (r < 2) ? q * cs - ot * sn : ot * sn + q * cs; } }
    { const int r = lane & 7; const f32x4 ot = shx4(qi, 1);
      if (r < 2) { const f32x4 cs = *(const f32x4*)(RT + 80), sn = *(const f32x4*)(RT + 84); qi = (r < 1) ? qi * cs - ot * sn : ot * sn + qi * cs; } }
    *(f32x4*)((float*)(A.ws + WS_DQ) + (size_t)m * 256 + c4) = q * 0.125f;
    *(f32x4*)((float*)(A.ws + WS_DQI) + (size_t)m * 256 + c4) = qi;
    { const int r = lane & 15; f32x4 kx = *(const f32x4*)(pd + 128 + 4 * r); const f32x4 ot = shx4(kx, 2);
      if (r < 4) { const int fi = 4 * (r & 1); const f32x4 cs = *(const f32x4*)(RT + 64 + fi), sn = *(const f32x4*)(RT + 72 + fi); kx = (r < 2) ? kx * cs - ot * sn : ot * sn + kx * cs; }
      if (lane < 16) { *(f32x4*)((float*)(A.ws + WS_DK) + (size_t)m * 64 + c4) = kx; *(f32x4*)((float*)(A.ws + WS_DV) + (size_t)m * 64 + c4) = *(const f32x4*)(pd + 192 + c4); } }
    { const int r = lane & 7; f32x4 ki = *(const f32x4*)(pd + 256 + 4 * r); const f32x4 ot = shx4(ki, 1);
      if (r < 2) { const f32x4 cs = *(const f32x4*)(RT + 80), sn = *(const f32x4*)(RT + 84); ki = (r < 1) ? ki * cs - ot * sn : ot * sn + ki * cs; }
      if (lane < 8) *(f32x4*)((float*)(A.ws + WS_DKI) + (size_t)m * 32 + c4) = ki;
      if (lane < 2) *(f32x4*)((float*)(A.ws + WS_DW) + (size_t)m * 8 + c4) = *(const f32x4*)(pd + 288 + c4) * 0.0625f; }
}

__device__ __forceinline__ void ret_scan(ARef A, const WI& w, int bh) {
    const int b = bh >> 2, h = bh & 3; const float gamma = 1.0f - exp2f(-5.0f - (float)h);
    LAS float* qs = (LAS float*)w.lds; LAS float* ks = qs + 2048; LAS float* vs = ks + 2048; LAS float* part = vs + 2048;
    const float* P = (const float*)(A.ws + WS_P); const float* RT = (const float*)(A.ws + WS_ROPE); float* YRET = (float*)(A.ws + WS_YO);
    float S[8];
#pragma unroll
    for (int i = 0; i < 8; ++i) S[i] = 0.0f;
    const int tt = w.tid >> 4, d0 = (w.tid & 15) * 4;
    for (int t0 = 0; t0 < SEQ; t0 += 32) {
        { const size_t m = (size_t)b * SEQ + t0 + tt; const float* pr = P + m * INCP + C_RET + h * 64; const float* rt = RT + m * ROPE_W;
          const int fi = d0 & 31, dp = d0 ^ 32;
          const f32x4 cs = *(const f32x4*)(rt + fi), sn = *(const f32x4*)(rt + 32 + fi);
          const f32x4 qm = *(const f32x4*)(pr + d0), qo = *(const f32x4*)(pr + dp), km = *(const f32x4*)(pr + 256 + d0), ko = *(const f32x4*)(pr + 256 + dp);
          const f32x4 qn = (d0 < 32) ? qm * cs - qo * sn : qo * sn + qm * cs;
          const f32x4 kn = ((d0 < 32) ? km * cs - ko * sn : ko * sn + km * cs) * 0.125f;
          *(LAS f32x4*)(qs + tt * 64 + d0) = qn; *(LAS f32x4*)(ks + tt * 64 + d0) = kn; *(LAS f32x4*)(vs + tt * 64 + d0) = *(const f32x4*)(pr + 512 + d0); }
        __syncthreads();
        for (int s = 0; s < 32; ++s) { const float vv = vs[s * 64 + w.lane]; float po = 0.0f;
#pragma unroll
            for (int i = 0; i < 8; ++i) { S[i] = gamma * S[i] + ks[s * 64 + w.wave * 8 + i] * vv; po += qs[s * 64 + w.wave * 8 + i] * S[i]; }
            part[(w.wave * 32 + s) * 64 + w.lane] = po; }
        __syncthreads();
        { f32x4 o = {0.f, 0.f, 0.f, 0.f};
#pragma unroll
          for (int kg = 0; kg < 8; ++kg) o += *(const LAS f32x4*)(part + (kg * 32 + tt) * 64 + d0);
          *(f32x4*)(YRET + ((size_t)b * SEQ + t0 + tt) * 256 + h * 64 + d0) = o; }
        __syncthreads();
    }
}
__device__ __forceinline__ void rwkv_scan(ARef A, const WI& w, int bh) {
    const int b = bh >> 2, h = bh & 3;
    LAS float* sr = (LAS float*)w.lds; LAS float* sw = sr + 2048; LAS float* sk = sw + 2048; LAS float* sv = sk + 2048; LAS float* sn = sv + 2048; LAS float* sb = sn + 2048; LAS float* sy = sb + 2048;
    const float* RWA = (const float*)(A.ws + WS_RWA); float* YRW = (float*)(A.ws + WS_YO) + YO_STRIDE;
    float S[8];
#pragma unroll
    for (int i = 0; i < 8; ++i) S[i] = 0.0f;
    const int vrow = w.tid >> 3, kq = w.tid & 7, tt = w.tid >> 4, d0 = (w.tid & 15) * 4;
    for (int t0 = 0; t0 < SEQ; t0 += 32) {
        { const size_t o = ((size_t)b * SEQ + t0 + tt) * 256 + h * 64 + d0; const int lo = tt * 64 + d0;
          *(LAS f32x4*)(sr + lo) = *(const f32x4*)(RWA + 0 * RWA_STRIDE + o); *(LAS f32x4*)(sw + lo) = *(const f32x4*)(RWA + 1 * RWA_STRIDE + o); *(LAS f32x4*)(sk + lo) = *(const f32x4*)(RWA + 2 * RWA_STRIDE + o);
          *(LAS f32x4*)(sv + lo) = *(const f32x4*)(RWA + 3 * RWA_STRIDE + o); *(LAS f32x4*)(sn + lo) = *(const f32x4*)(RWA + 4 * RWA_STRIDE + o); *(LAS f32x4*)(sb + lo) = *(const f32x4*)(RWA + 5 * RWA_STRIDE + o); }
        __syncthreads();
        for (int s = 0; s < 32; ++s) { const int lo = s * 64 + kq * 8;
            const f32x4 w0 = *(const LAS f32x4*)(sw + lo), w1 = *(const LAS f32x4*)(sw + lo + 4), n0 = *(const LAS f32x4*)(sn + lo), n1 = *(const LAS f32x4*)(sn + lo + 4);
            const f32x4 b0 = *(const LAS f32x4*)(sb + lo), b1 = *(const LAS f32x4*)(sb + lo + 4), k0 = *(const LAS f32x4*)(sk + lo), k1 = *(const LAS f32x4*)(sk + lo + 4);
            const f32x4 r0 = *(const LAS f32x4*)(sr + lo), r1 = *(const LAS f32x4*)(sr + lo + 4); const float vv = sv[s * 64 + vrow];
            float sa = (S[0] * n0.x + S[1] * n0.y) + (S[2] * n0.z + S[3] * n0.w) + (S[4] * n1.x + S[5] * n1.y) + (S[6] * n1.z + S[7] * n1.w);
            sa = grp8_sum(sa);
            S[0] = S[0] * w0.x + sa * b0.x + vv * k0.x; S[1] = S[1] * w0.y + sa * b0.y + vv * k0.y; S[2] = S[2] * w0.z + sa * b0.z + vv * k0.z; S[3] = S[3] * w0.w + sa * b0.w + vv * k0.w;
            S[4] = S[4] * w1.x + sa * b1.x + vv * k1.x; S[5] = S[5] * w1.y + sa * b1.y + vv * k1.y; S[6] = S[6] * w1.z + sa * b1.z + vv * k1.z; S[7] = S[7] * w1.w + sa * b1.w + vv * k1.w;
            float y = (S[0] * r0.x + S[1] * r0.y) + (S[2] * r0.z + S[3] * r0.w) + (S[4] * r1.x + S[5] * r1.y) + (S[6] * r1.z + S[7] * r1.w);
            y = grp8_sum(y);
            if (kq == 0) sy[s * 64 + vrow] = y; }
        __syncthreads();
        *(f32x4*)(YRW + ((size_t)b * SEQ + t0 + tt) * 256 + h * 64 + d0) = *(const LAS f32x4*)(sy + tt * 64 + d0);
        __syncthreads();
    }
}
__device__ __forceinline__ void sb_row(ARef A, int it, int lane) {
    const int t = it & (SEQ - 1), bh = it >> 12, b = bh >> 2, h = bh & 3;
    const float* P = (const float*)(A.ws + WS_P); float* YSB = (float*)(A.ws + WS_YO) + 3 * YO_STRIDE;
    const size_t m = (size_t)b * SEQ + t;
    const float* qrow = P + m * INCP + C_SB + h * 64;
    float q[64], acc[64];
#pragma unroll
    for (int d = 0; d < 64; ++d) { q[d] = qrow[d]; acc[d] = 0.0f; }
    float carry = 0.0f;
    for (int base = t - 1; base >= 0; base -= 64) {
        const int s = base - lane; const bool valid = s >= 0; const int sc = valid ? s : 0;
        const float* kr = P + ((size_t)b * SEQ + sc) * INCP + C_SB + 256 + h * 64;
        float z = 0.0f;
#pragma unroll
        for (int d4 = 0; d4 < 16; ++d4) { const f32x4 kv = *(const f32x4*)(kr + 4 * d4); z += (q[4 * d4] * kv.x + q[4 * d4 + 1] * kv.y) + (q[4 * d4 + 2] * kv.z + q[4 * d4 + 3] * kv.w); }
        z *= 0.125f;
        const float Ln = valid ? -softplusf(z) : 0.0f;
        float inc = Ln;
#pragma unroll
        for (int off = 1; off < 64; off <<= 1) { const float y = __shfl_up(inc, off); if (lane >= off) inc += y; }
        const float tot = __shfl(inc, 63);
        const float la = (z + Ln) + carry + (inc - Ln);
        const float a = valid ? expf(la) : 0.0f;
        carry += tot;
        const float* vr = kr + 256;
#pragma unroll
        for (int d4 = 0; d4 < 16; ++d4) { const f32x4 vv = *(const f32x4*)(vr + 4 * d4); acc[4 * d4] += a * vv.x; acc[4 * d4 + 1] += a * vv.y; acc[4 * d4 + 2] += a * vv.z; acc[4 * d4 + 3] += a * vv.w; }
        if (carry < -104.0f) break;
    }
    float o = 0.0f;
#pragma unroll
    for (int d = 0; d < 64; ++d) { const float r = wave_sum(acc[d]); o = (lane == d) ? r : o; }
    YSB[m * 256 + h * 64 + lane] = o;
}
__device__ __forceinline__ void dsa_score_row(ARef A, int m, int lane, LAS float* sqi) {
    const int b = m >> 12, t = m & (SEQ - 1), n = t + 1;
    *(LAS f32x4*)(sqi + 4 * lane) = *(const f32x4*)((const float*)(A.ws + WS_DQI) + (size_t)m * 256 + 4 * lane);
    const float* dw = (const float*)(A.ws + WS_DW) + (size_t)m * 8;
    const f32x4 wa = *(const f32x4*)dw, wb = *(const f32x4*)(dw + 4);
    float* sc = (float*)(A.ws + WS_SC) + (size_t)m * SEQ; const float* DKI = (const float*)(A.ws + WS_DKI);
    LDS_WAIT();
    for (int s0 = 0; s0 < n; s0 += 64) { const int s = s0 + lane;
        if (s < n) { const float* kr = DKI + ((size_t)b * SEQ + s) * 32; f32x4 kv[8];
#pragma unroll
            for (int e = 0; e < 8; ++e) kv[e] = *(const f32x4*)(kr + 4 * e);
            float tot = 0.0f;
#pragma unroll
            for (int hh = 0; hh < 8; ++hh) { float d = 0.0f;
#pragma unroll
                for (int e = 0; e < 8; ++e) d += dot4(*(const LAS f32x4*)(sqi + hh * 32 + 4 * e), kv[e]);
                const float wv = (hh < 4) ? wa[hh] : wb[hh - 4]; tot += wv * fmaxf(d, 0.0f); }
            sc[s] = tot + 0.0f; } }
}

__device__ __forceinline__ void dsa_attend_row(ARef A, int m, int lane, LAS float* wl) {
    LAS float* sq = wl; LAS int* slist = (LAS int*)(wl + 256); LAS float* sp = wl + 512; LAS unsigned* keys = (LAS unsigned*)(wl + 1536);
    const int b = m >> 12, t = m & (SEQ - 1), n = t + 1;
    *(LAS f32x4*)(sq + 4 * lane) = *(const f32x4*)((const float*)(A.ws + WS_DQ) + (size_t)m * 256 + 4 * lane);
    const float* sc = (const float*)(A.ws + WS_SC) + (size_t)m * SEQ;
    int nsel;
    if (n <= 256) {
#pragma unroll
        for (int c = 0; c < 4; ++c) { const int idx = lane + 64 * c; if (idx < n) slist[idx] = idx; }
        nsel = n;
    } else {
        const int nj = (n + 63) >> 6;
        for (int j = 0; j < nj; ++j) { const int s = j * 64 + lane; unsigned key = 0u;
            if (s < n) { const unsigned bits = __float_as_uint(sc[s]); key = (bits & 0x80000000u) ? ~bits : (bits | 0x80000000u); }
            keys[s] = key; }
        LDS_WAIT();
        unsigned T = 0u;
        for (int bit = 31; bit >= 0; --bit) { const unsigned cand = T | (1u << bit); int cnt = 0;
            for (int j = 0; j < nj; ++j) cnt += (keys[j * 64 + lane] >= cand) ? 1 : 0;
            cnt = wave_sum_i(cnt);
            if (cnt >= 256) T = cand; }
        int cgt = 0;
        for (int j = 0; j < nj; ++j) cgt += (keys[j * 64 + lane] > T) ? 1 : 0;
        cgt = wave_sum_i(cgt);
        const int r = 256 - cgt;
        int base = 0, eqseen = 0; const unsigned long long ltm = (1ull << lane) - 1ull;
        for (int j = 0; j < nj; ++j) { const unsigned kx = keys[j * 64 + lane]; const bool gt = kx > T, eq = kx == T;
            const unsigned long long meq = __ballot(eq); const int er = eqseen + __popcll(meq & ltm);
            const bool sel = gt || (eq && er < r);
            const unsigned long long ms = __ballot(sel); if (sel) slist[base + __popcll(ms & ltm)] = j * 64 + lane;
            base += __popcll(ms); eqseen += __popcll(meq); }
        nsel = 256;
    }
    LDS_WAIT();
    const float* DK = (const float*)(A.ws + WS_DK); const float* DV = (const float*)(A.ws + WS_DV);
    float lg[4][4];
#pragma unroll 1
    for (int c = 0; c < 4; ++c) { const int idx = lane + 64 * c; const bool ok = idx < nsel; const int s = ok ? slist[idx] : 0;
        asm volatile("" ::: "memory");
        const float* kr = DK + ((size_t)b * SEQ + s) * 64; float d[4] = {0.f, 0.f, 0.f, 0.f};
#pragma unroll
        for (int e = 0; e < 16; ++e) { const f32x4 kv = *(const f32x4*)(kr + 4 * e);
#pragma unroll
            for (int hh = 0; hh < 4; ++hh) d[hh] += dot4(*(const LAS f32x4*)(sq + hh * 64 + 4 * e), kv); }
        *(LAS f32x4*)(sp + 4 * idx) = ok ? (f32x4){d[0], d[1], d[2], d[3]} : (f32x4){-INFINITY, -INFINITY, -INFINITY, -INFINITY}; }
    LDS_WAIT();
#pragma unroll
    for (int c = 0; c < 4; ++c) { const f32x4 v = *(const LAS f32x4*)(sp + 4 * (lane + 64 * c)); lg[c][0] = v.x; lg[c][1] = v.y; lg[c][2] = v.z; lg[c][3] = v.w; }
#pragma unroll
    for (int hh = 0; hh < 4; ++hh) {
        const float mx = wave_max(fmaxf(fmaxf(lg[0][hh], lg[1][hh]), fmaxf(lg[2][hh], lg[3][hh])));
        float e[4], se = 0.0f;
#pragma unroll
        for (int c = 0; c < 4; ++c) { e[c] = (lane + 64 * c < nsel) ? expf(lg[c][hh] - mx) : 0.0f; se += e[c]; }
        const float inv = 1.0f / wave_sum(se);
#pragma unroll
        for (int c = 0; c < 4; ++c) lg[c][hh] = e[c] * inv; }
#pragma unroll
    for (int c = 0; c < 4; ++c) { const int idx = lane + 64 * c; if (idx < nsel) *(LAS f32x4*)(sp + 4 * idx) = (f32x4){lg[c][0], lg[c][1], lg[c][2], lg[c][3]}; }
    LDS_WAIT();
    f32x4 o = {0.f, 0.f, 0.f, 0.f};
    for (int i = 0; i < nsel; ++i) { const int s = slist[i]; const f32x4 pv = *(const LAS f32x4*)(sp + 4 * i); const float vv = DV[((size_t)b * SEQ + s) * 64 + lane]; o += pv * vv; }
    float* YD = (float*)(A.ws + WS_YO) + 2 * YO_STRIDE + (size_t)m * 256;
    YD[lane] = o.x; YD[64 + lane] = o.y; YD[128 + lane] = o.z; YD[192 + lane] = o.w;
    LDS_WAIT();
}

__device__ __forceinline__ f32x4 head_norm4(f32x4 y, float eps, f32x4 g) {
    const float mean = grp16_sum(sum4(y)) * (1.0f / 64.0f); const f32x4 yc = y - mean;
    const float var = grp16_sum(dot4(yc, yc)) * (1.0f / 64.0f); return yc * (1.0f / sqrtf(var + eps)) * g;
}
__device__ __forceinline__ void post_row(ARef A, int l, int m, int lane) {
    const float* P = (const float*)(A.ws + WS_P); const float* YO = (const float*)(A.ws + WS_YO); const float* RWA = (const float*)(A.ws + WS_RWA);
    bf16* MX = (bf16*)(A.ws + WS_MIX) + (size_t)m * DM; const int c4 = 4 * lane; const size_t o = (size_t)m * 256 + c4;
    { f32x4 y = head_norm4(*(const f32x4*)(YO + o), 1e-5f, *(const f32x4*)(A.in[I_RETGN] + l * 256 + c4));
      const f32x4 g = *(const f32x4*)(P + (size_t)m * INCP + C_RET + 768 + c4);
#pragma unroll
      for (int i = 0; i < 4; ++i) y[i] *= g[i] * sigm(g[i]);
      v2u w; w.x = pk2(y.x, y.y); w.y = pk2(y.z, y.w); *(v2u*)(MX + c4) = w; }
    { f32x4 y = head_norm4(*(const f32x4*)(YO + YO_STRIDE + o), 64e-5f, *(const f32x4*)(A.in[I_LN] + l * 256 + c4));
      y = (y + *(const f32x4*)(RWA + 7 * RWA_STRIDE + o)) * *(const f32x4*)(RWA + 6 * RWA_STRIDE + o);
      v2u w; w.x = pk2(y.x, y.y); w.y = pk2(y.z, y.w); *(v2u*)(MX + 256 + c4) = w; }
    { f32x4 y = *(const f32x4*)(YO + 2 * YO_STRIDE + o); const float r = 1.0f / sqrtf(wave_sum(dot4(y, y)) * (1.0f / 256.0f) + 1e-5f);
      y = y * r * *(const f32x4*)(A.in[I_DONORM] + l * 256 + c4);
      v2u w; w.x = pk2(y.x, y.y); w.y = pk2(y.z, y.w); *(v2u*)(MX + 512 + c4) = w; }
    { f32x4 y = *(const f32x4*)(YO + 3 * YO_STRIDE + o); const float r = 1.0f / sqrtf(wave_sum(dot4(y, y)) * (1.0f / 256.0f) + 1e-5f);
      y = y * r * *(const f32x4*)(A.in[I_SONORM] + l * 256 + c4);
      v2u w; w.x = pk2(y.x, y.y); w.y = pk2(y.z, y.w); *(v2u*)(MX + 768 + c4) = w; }
}

__device__ __forceinline__ void router_row(ARef A, int l, int m, int lane) {
    const float* XA = (const float*)(A.ws + WS_XA) + (size_t)m * DM; const float* MOD = (const float*)(A.ws + WS_MOD) + (size_t)(l * 8 + (m >> 12)) * 6144;
    f32x4 v[4]; float ss = 0.0f;
#pragma unroll
    for (int j = 0; j < 4; ++j) { v[j] = *(const f32x4*)(XA + 4 * (lane + 64 * j)); ss += dot4(v[j], v[j]); }
    ss = wave_sum(ss); const float rstd = 1.0f / sqrtf(ss * (1.0f / DM) + 1e-5f);
    const float* g = A.in[I_NFFN] + l * DM; const float* scp = MOD + 4 * 1024; const float* shp = MOD + 3 * 1024;
    emit_h_row(v, rstd, g, scp, shp, (bf16*)(A.ws + WS_H) + (size_t)m * DM, lane);
    float p[32];
#pragma unroll
    for (int e = 0; e < 32; ++e) p[e] = 0.0f;
    const float* rw = A.in[I_RW] + (size_t)l * DM * 32;
#pragma unroll
    for (int j = 0; j < 4; ++j) { const int k = 4 * (lane + 64 * j);
        const f32x4 h = v[j] * rstd * *(const f32x4*)(g + k) * (1.0f + *(const f32x4*)(scp + k)) + *(const f32x4*)(shp + k);
#pragma unroll
        for (int i = 0; i < 4; ++i) { const float* row = rw + (size_t)(k + i) * 32;
#pragma unroll
            for (int q4 = 0; q4 < 8; ++q4) { const f32x4 r = *(const f32x4*)(row + 4 * q4); p[4 * q4] += h[i] * r.x; p[4 * q4 + 1] += h[i] * r.y; p[4 * q4 + 2] += h[i] * r.z; p[4 * q4 + 3] += h[i] * r.w; } } }
    const float* rb = A.in[I_RB] + l * 32;
#pragma unroll
    for (int e = 0; e < 32; ++e) p[e] = wave_sum(p[e]) + rb[e];
    unsigned used = 0u; float tv[4]; int ti[4];
#pragma unroll
    for (int kk = 0; kk < 4; ++kk) { float best = -INFINITY; int bi = 0;
#pragma unroll
        for (int e = 0; e < 32; ++e) { const bool c = !((used >> e) & 1u) && (p[e] > best); best = c ? p[e] : best; bi = c ? e : bi; }
        used |= 1u << bi; tv[kk] = best; ti[kk] = bi; }
    const float e1 = expf(tv[1] - tv[0]), e2 = expf(tv[2] - tv[0]), e3 = expf(tv[3] - tv[0]); const float inv = 1.0f / (1.0f + e1 + e2 + e3);
    if (lane == 0) {
        int* TI = (int*)(A.ws + WS_TOPI) + (size_t)m * 4; float* TW = (float*)(A.ws + WS_TOPW) + (size_t)m * 4;
        TI[0] = ti[0]; TI[1] = ti[1]; TI[2] = ti[2]; TI[3] = ti[3]; TW[0] = inv; TW[1] = e1 * inv; TW[2] = e2 * inv; TW[3] = e3 * inv;
        unsigned* cnt = (unsigned*)(A.ws + WS_CTL) + CW_CNT + l * 32;
        atomicAdd(cnt + ti[0], 1u); atomicAdd(cnt + ti[1], 1u); atomicAdd(cnt + ti[2], 1u); atomicAdd(cnt + ti[3], 1u);
    }
}
__device__ __forceinline__ void build_expert_table(ARef A, const WI& w, int l) {
    LAS int* tst = (LAS int*)(w.lds + TST_OFF); LAS int* tab = (LAS int*)(w.lds + TAB_OFF);
    if (w.tid == 0) { const unsigned* cnt = (const unsigned*)(A.ws + WS_CTL) + CW_CNT + l * 32; int acc = 0;
        for (int e = 0; e < 32; ++e) { tst[e] = acc; acc += (int)((__hip_atomic_load(cnt + e, RLX_AGENT) + 255u) >> 8); }
        tst[32] = acc; tab[0] = acc; }
    __syncthreads();
    if (w.tid < 32) { const int e = w.tid; for (int pm = tst[e]; pm < tst[e + 1]; ++pm) tab[1 + pm] = e; }
    __syncthreads();
}
__device__ __forceinline__ void scatter_row(ARef A, const WI& w, int l, int m) {
    const LAS int* tst = (const LAS int*)(w.lds + TST_OFF);
    int pos = 0;
    if (w.lane < 4) { const int e = ((const int*)(A.ws + WS_TOPI))[(size_t)m * 4 + w.lane];
        const unsigned slot = atomicAdd((unsigned*)(A.ws + WS_CTL) + CW_CUR + l * 32 + e, 1u);
        pos = tst[e] * 256 + (int)slot; ((int*)(A.ws + WS_POS))[(size_t)m * 4 + w.lane] = pos; }
    const v4u* src = (const v4u*)((const bf16*)(A.ws + WS_H) + (size_t)m * DM);
    const v4u a = src[w.lane], b = src[64 + w.lane];
#pragma unroll
    for (int k = 0; k < 4; ++k) { const int pk = __shfl(pos, k); v4u* dst = (v4u*)((bf16*)(A.ws + WS_XS) + (size_t)pk * DM); dst[w.lane] = a; dst[64 + w.lane] = b; }
}
__device__ __forceinline__ void combine_row(ARef A, int l, int m, int lane) {
    float* XA = (float*)(A.ws + WS_XA) + (size_t)m * DM; const float* MOD = (const float*)(A.ws + WS_MOD) + (size_t)(l * 8 + (m >> 12)) * 6144;
    const int* PS = (const int*)(A.ws + WS_POS) + (size_t)m * 4; const float* TW = (const float*)(A.ws + WS_TOPW) + (size_t)m * 4;
    const bf16* YS = (const bf16*)(A.ws + WS_XS);
    f32x4 v[4], acc[4];
#pragma unroll
    for (int j = 0; j < 4; ++j) { v[j] = *(const f32x4*)(XA + 4 * (lane + 64 * j)); acc[j] = (f32x4){0.f, 0.f, 0.f, 0.f}; }
#pragma unroll
    for (int k = 0; k < 4; ++k) { const int pos = PS[k]; const float gt = TW[k]; const v2u* yr = (const v2u*)(YS + (size_t)pos * DM);
#pragma unroll
        for (int j = 0; j < 4; ++j) { const v2u y = yr[lane + 64 * j]; acc[j] += gt * (f32x4){bf_lo(y.x), bf_hi(y.x), bf_lo(y.y), bf_hi(y.y)}; } }
    float ss = 0.0f;
#pragma unroll
    for (int j = 0; j < 4; ++j) { const int kx = 4 * (lane + 64 * j); v[j] += *(const f32x4*)(MOD + 5 * 1024 + kx) * acc[j]; ss += dot4(v[j], v[j]); }
    ss = wave_sum(ss); const float rstd = 1.0f / sqrtf(ss * (1.0f / DM) + 1e-5f);
    if (l + 1 < NLAYER) {
#pragma unroll
        for (int j = 0; j < 4; ++j) *(f32x4*)(XA + 4 * (lane + 64 * j)) = v[j];
        const float* mb = MOD + 8 * 6144;
        emit_h_row(v, rstd, A.in[I_NMIX] + (l + 1) * DM, mb + 1024, mb, (bf16*)(A.ws + WS_H) + (size_t)m * DM, lane);
    } else {
        float* orow = A.out + (size_t)m * DM; const float* gf = A.in[I_NFINAL];
#pragma unroll
        for (int j = 0; j < 4; ++j) { const int kx = 4 * (lane + 64 * j); *(f32x4*)(orow + kx) = v[j] * rstd * *(const f32x4*)(gf + kx); }
    }
}

constexpr int N_LAUNCHES = MK_N_LAUNCHES;
template <int SEL> __global__ void __launch_bounds__(NWAVES * 64, 2) fwd(ArgsH Ah) {
    extern __shared__ __attribute__((aligned(16))) unsigned char lds[];
    (void)Ah;
#define MAKE_WI() WI w; { int tz = threadIdx.x; asm volatile("" : "+v"(tz)); int bz = blockIdx.x, gz = gridDim.x; asm volatile("" : "+s"(bz), "+s"(gz)); \
        w.lds = (LAS unsigned char*)lds; w.tid = tz; w.lane = tz & 63; w.wave = __builtin_amdgcn_readfirstlane(tz >> 6); w.G = gz; w.bx = bz; w.vcu = (gz % 8 == 0) ? (bz % 8) * (gz / 8) + bz / 8 : bz; \
        w.gw = w.vcu * NWAVES + w.wave; w.NGW = gz * NWAVES; }
    { const int t0 = threadIdx.x; for (int u = t0; u < (LDS_BYTES - RING_BYTES) / 4; u += NWAVES * 64) ((LAS unsigned*)((LAS unsigned char*)lds + RING_BYTES))[u] = 0u; }
    __syncthreads();
    int lo, hi; { ARef A0 = *kargs(); lo = A0.ph_lo; hi = A0.ph_hi; }
    if (N_LAUNCHES == 1) { ARef A0 = *kargs(); (void)xcd_barrier_post((unsigned*)((gu32*)(A0.ws + WS_CTL) + CW_BAR), (volatile LAS unsigned*)((LAS unsigned char*)lds + MISC_OFF) + 8); }
#define GRID_BAR() do { if (N_LAUNCHES == 1) { ARef Ab = *kargs(); XcdBarrier bar_; bar_.bar = (unsigned*)((gu32*)(Ab.ws + WS_CTL) + CW_BAR); bar_.x = xb_xcc_id(); bar_.st = (volatile LAS unsigned*)((LAS unsigned char*)lds + MISC_OFF) + 8; xcd_barrier(bar_); } } while (0)
#define IN(k) (lo <= (k) && (k) < hi)
#ifndef PHMASK
#define PHMASK 0xffffffffu
#endif
#define KON(k) if constexpr ((SEL < 0 && ((PHMASK >> (k)) & 1u)) || SEL == (k))
#define BOTH(k) (IN(k) && IN((k) + 1))
#define ring ((PG8_LAS unsigned char*)lds)

    KON(0) if (IN(0)) { ARef A = *kargs(); MAKE_WI(); ph_prologue(A, w); if (BOTH(0)) GRID_BAR(); }

    for (int l = 0; l < NLAYER; ++l) {
        const int pb = 1 + l * NPL;
        KON(1) if (IN(pb + 0)) { ARef A = *kargs(); MAKE_WI(); if (l == 0) ph_norm1(A, w); if (BOTH(pb + 0)) GRID_BAR(); }
        KON(2) if (IN(pb + 1)) { ARef A = *kargs(); MAKE_WI();
            pg8::Gemm g{(const bf16*)(A.ws + WS_H), (const bf16*)(A.ws + WS_WIN) + (size_t)l * INCP * DM, MTOK, INCP, DM}; pg8::StaticOrder S; S.init(MTOK, INCP, w.G, w.bx);
            pg8::EpiF32 E{(float*)(A.ws + WS_P), INCP};
            pg8::gemm_phase<pg8::EpiF32, pg8::StaticOrder, true, true>(ring, g, S, E);
            if (BOTH(pb + 1)) GRID_BAR();
        }
        KON(3) if (IN(pb + 2)) { ARef A = *kargs(); MAKE_WI();
            for (int m = w.gw; m < MTOK; m += w.NGW) { rwkv_prep(A, l, m, w.lane); dsa_prep(A, l, m, w.lane); }
            if (BOTH(pb + 2)) GRID_BAR();
        }
        KON(4) if (IN(pb + 3)) { ARef A = *kargs(); MAKE_WI();
            if (w.vcu < 32) ret_scan(A, w, w.vcu); else if (w.vcu < 64) rwkv_scan(A, w, w.vcu - 32);
            __syncthreads();
            for (int it = w.gw; it < MTOK * 4; it += w.NGW) sb_row(A, it, w.lane);
            { LAS float* sqi = (LAS float*)(w.lds + w.wave * 1024); for (int m = w.gw; m < MTOK; m += w.NGW) dsa_score_row(A, m, w.lane, sqi); }
            if (BOTH(pb + 3)) GRID_BAR();
        }
        KON(5) if (IN(pb + 4)) { ARef A = *kargs(); MAKE_WI();
            LAS float* wl = (LAS float*)(w.lds + (w.wave & 3) * 22528);
            if (w.wave < 4) for (int m = w.vcu * 4 + w.wave; m < MTOK; m += w.G * 4) dsa_attend_row(A, m, w.lane, wl);
            if (BOTH(pb + 4)) GRID_BAR();
        }
        KON(6) if (IN(pb + 5)) { ARef A = *kargs(); MAKE_WI();
            for (int m = w.gw; m < MTOK; m += w.NGW) post_row(A, l, m, w.lane);
            if (BOTH(pb + 5)) GRID_BAR();
        }
        KON(7) if (IN(pb + 6)) { ARef A = *kargs(); MAKE_WI();
            pg8::Gemm g{(const bf16*)(A.ws + WS_MIX), (const bf16*)(A.ws + WS_WOUT) + (size_t)l * DM * DM, MTOK, DM, DM}; pg8::StaticOrder S; S.init(MTOK, DM, w.G, w.bx);
            pg8::EpiRes E{l == 0 ? A.in[I_X] : (const float*)(A.ws + WS_XA), (float*)(A.ws + WS_XA), (const float*)(A.ws + WS_MOD) + (size_t)l * 8 * 6144 + 2 * 1024};
            pg8::gemm_phase<pg8::EpiRes, pg8::StaticOrder, true, true>(ring, g, S, E);
            if (BOTH(pb + 6)) GRID_BAR();
        }
        KON(8) if (IN(pb + 7)) { ARef A = *kargs(); MAKE_WI();
            for (int m = w.gw; m < MTOK; m += w.NGW) router_row(A, l, m, w.lane);
            if (BOTH(pb + 7)) GRID_BAR();
        }
        KON(9) if (IN(pb + 8)) { ARef A = *kargs(); MAKE_WI();
            build_expert_table(A, w, l);
            for (int m = w.gw; m < MTOK; m += w.NGW) scatter_row(A, w, l, m);
            if (BOTH(pb + 8)) GRID_BAR();
        }
        KON(10) if (IN(pb + 9)) { ARef A = *kargs(); MAKE_WI();
            build_expert_table(A, w, l);
            pg8::Gemm g{(const bf16*)(A.ws + WS_XS), (const bf16*)(A.ws + WS_W1) + (size_t)l * NEXP * 2048 * DM, MOE_ROWS, NEXP * 2048, DM};
            pg8::MoeOrder S{(const PG8_LAS int*)(w.lds + TAB_OFF), 8, w.G, w.vcu};
            pg8::EpiSwiglu E{(bf16*)(A.ws + WS_ACT), A.in[I_MB1] + (size_t)l * NEXP * 2048};
            pg8::gemm_phase<pg8::EpiSwiglu, pg8::MoeOrder, true, true>(ring, g, S, E);
            if (BOTH(pb + 9)) GRID_BAR();
        }
        KON(11) if (IN(pb + 10)) { ARef A = *kargs(); MAKE_WI();
            build_expert_table(A, w, l);
            pg8::Gemm g{(const bf16*)(A.ws + WS_ACT), (const bf16*)(A.ws + WS_W2) + (size_t)l * NEXP * DM * DM, MOE_ROWS, NEXP * DM, DM};
            pg8::MoeOrder S{(const PG8_LAS int*)(w.lds + TAB_OFF), 4, w.G, w.vcu};
            pg8::EpiY E{(bf16*)(A.ws + WS_XS), A.in[I_MB2] + (size_t)l * NEXP * DM};
            pg8::gemm_phase<pg8::EpiY, pg8::MoeOrder, true, true>(ring, g, S, E);
            if (BOTH(pb + 10)) GRID_BAR();
        }
        KON(12) if (IN(pb + 11)) { ARef A = *kargs(); MAKE_WI();
            for (int m = w.gw; m < MTOK; m += w.NGW) combine_row(A, l, m, w.lane);
            if (BOTH(pb + 11)) GRID_BAR();
        }
    }
#undef IN
#undef ring
#undef MAKE_WI
#undef GRID_BAR
#undef KON
#undef BOTH
}


#if MK_N_LAUNCHES != 1
template <int K> static void launch_one(int grid, hipStream_t stream, const ArgsH& a) {
    static bool attr = false;
    if (!attr) { (void)hipFuncSetAttribute((const void*)fwd<K>, hipFuncAttributeMaxDynamicSharedMemorySize, LDS_BYTES); attr = true; }
    hipLaunchKernelGGL(fwd<K>, dim3(grid), dim3(NWAVES * 64), LDS_BYTES, stream, a);
}
static void launch_kind(int kind, int grid, hipStream_t stream, const ArgsH& a) {
    switch (kind) {
        case 0: launch_one<0>(grid, stream, a); break; case 1: launch_one<1>(grid, stream, a); break; case 2: launch_one<2>(grid, stream, a); break;
        case 3: launch_one<3>(grid, stream, a); break; case 4: launch_one<4>(grid, stream, a); break; case 5: launch_one<5>(grid, stream, a); break;
        case 6: launch_one<6>(grid, stream, a); break; case 7: launch_one<7>(grid, stream, a); break; case 8: launch_one<8>(grid, stream, a); break;
        case 9: launch_one<9>(grid, stream, a); break; case 10: launch_one<10>(grid, stream, a); break; case 11: launch_one<11>(grid, stream, a); break;
        default: launch_one<12>(grid, stream, a); break;
    }
}
#endif
extern "C" void kernel_launch(void* const* d_in, const int* in_sizes, int n_in, void* d_out, int out_size, void* d_ws, size_t ws_size, hipStream_t stream) {
    static int grid = 0;
    if (grid == 0) {
        if (n_in != N_IN || out_size != MTOK * DM || ws_size < WS_END) { fprintf(stderr, "kernel_launch: unexpected shapes (n_in %d, out %d, ws %zu)\n", n_in, out_size, ws_size); grid = -1; return; }
        int dev = 0, cus = 0;
        if (hipGetDevice(&dev) != hipSuccess || hipDeviceGetAttribute(&cus, hipDeviceAttributeMultiprocessorCount, dev) != hipSuccess) { grid = -1; return; }
#if MK_N_LAUNCHES == 1
        {
            if (hipFuncSetAttribute((const void*)fwd<-1>, hipFuncAttributeMaxDynamicSharedMemorySize, LDS_BYTES) != hipSuccess) { fprintf(stderr, "kernel_launch: hipFuncSetAttribute failed\n"); grid = -1; return; }
            int per_cu = 0;
            if (hipOccupancyMaxActiveBlocksPerMultiprocessor(&per_cu, (const void*)fwd<-1>, NWAVES * 64, LDS_BYTES) != hipSuccess || per_cu < 1) fprintf(stderr, "kernel_launch: occupancy query says %d\n", per_cu);
            (void)hipGetLastError();
        }
#endif
        grid = cus;
    }
    if (grid < 0) return;
    (void)in_sizes;
    if (hipMemsetAsync((char*)d_ws + WS_CTL, 0, CTL_ZERO_BYTES, stream) != hipSuccess) return;
    ArgsH a{};
    for (int i = 0; i < N_IN; ++i) a.in[i] = (const float*)d_in[i];
    a.out = (float*)d_out; a.ws = (unsigned char*)d_ws;
    for (int f = 0; f < 44; ++f) a.invf[f] = (f < 32) ? pow(10000.0, -(double)f / 32.0) : (f < 40) ? pow(500000.0, -(double)(f - 32) / 8.0) : pow(500000.0, -(double)(f - 40) / 4.0);
#if MK_N_LAUNCHES == 1
    a.ph_lo = 0; a.ph_hi = NPHASE; a.li = 0;
    hipLaunchKernelGGL(fwd<-1>, dim3(grid), dim3(NWAVES * 64), LDS_BYTES, stream, a);
#else
    {
        for (int p = 0; p < NPHASE; ++p) {
            if (p == 1 + NPL) continue;
            a.ph_lo = p; a.ph_hi = p + 1; a.li = p;
            const int kind = (p == 0) ? 0 : 1 + (p - 1) % NPL;
            launch_kind(kind, grid, stream, a);
        }
    }
#endif
}
```

```cpp
#include <hip/hip_runtime.h>
#include <cstdio>
#include <cstdint>
#include <cmath>

#ifndef MK_N_LAUNCHES
#define MK_N_LAUNCHES 1
#endif

namespace pg8 {
#define PG8_LAS __attribute__((address_space(3)))
typedef unsigned short bf16_t;
typedef short bf16x8 __attribute__((ext_vector_type(8)));
typedef float f32x4 __attribute__((ext_vector_type(4)));
typedef unsigned u32x4 __attribute__((ext_vector_type(4)));
typedef unsigned u32x2 __attribute__((ext_vector_type(2)));
constexpr int BM = 256, BK = 64, HALF = 128, HTB = HALF * BK * 2  , STAGE_BYTES = 8 * HTB, NXCD = 8, WGM = 8;

__host__ __device__ __forceinline__ int lds_byte(int r, int c) { const int st = (r >> 4) * 2 + (c >> 5), rr = r & 15, cc = c & 31, ob = rr * 64 + cc * 2; return st * 1024 + (ob ^ (((ob >> 9) & 1) << 5)); }
__host__ __device__ __forceinline__ void stage_rc(int b, int& R, int& C) { const int st = b / 1024, sb = b % 1024, swz = sb ^ (((sb >> 9) & 1) << 5); R = (st >> 1) * 16 + swz / 64; C = (st & 1) * 32 + (swz % 64) / 2; }
__host__ __device__ __forceinline__ int perm32(int rho) { const int n = rho >> 4, i = rho & 15; return 8 * (i >> 2) + 4 * n + (i & 3); }

struct Unit { int pm, pn; };
struct Gemm { const bf16_t* A; const bf16_t* Bt; int M, N, K; };

struct StaticOrder {
    int nM, nN, nwg, G, c;
    __host__ __device__ void init(int M, int N, int G_, int c_) { nM = M / BM; nN = N / BM; nwg = nM * nN; G = G_; c = c_; }
    __host__ __device__ bool next(int i, Unit& u) const {
        const long L = (long)i * G + c; if (L >= nwg) return false;
        int wgid = (int)L; { const int q = nwg / NXCD, r = nwg % NXCD, xcd = wgid % NXCD, off = wgid / NXCD; wgid = (xcd < r ? xcd * (q + 1) : r * (q + 1) + (xcd - r) * q) + off; }
        const int nig = WGM * nN, gid = wgid / nig, fm = gid * WGM, gsz = (nM - fm) < WGM ? (nM - fm) : WGM;
        u.pm = fm + ((wgid % nig) % gsz); u.pn = (wgid % nig) / gsz; return true;
    }
    __device__ __forceinline__ void a_ready(const Unit&) const {}
    __device__ __forceinline__ void done(const Unit&) const {}
};
__device__ __forceinline__ unsigned cvt_pk_bf16(float lo, float hi) { unsigned r; asm volatile("v_cvt_pk_bf16_f32 %0, %1, %2" : "=v"(r) : "v"(lo), "v"(hi)); return r; }
struct EpiF32 {
    static constexpr bool PERM = false, AFTER_DRAIN = false;
    float* C; int ldc;
    __device__ __forceinline__ void operator()(const f32x4 (&acc)[2][2][4][2], const Unit& u, int wr, int wc, int fr, int fq) const {
        const int row0 = u.pm * BM + wr * 64 + fr, col0 = u.pn * BM + wc * 32 + 4 * fq;
#pragma unroll
        for (int ai = 0; ai < 2; ++ai)
#pragma unroll
            for (int m = 0; m < 4; ++m) { float* rowp = C + (size_t)(row0 + ai * HALF + m * 16) * ldc + col0;
#pragma unroll
                for (int bj = 0; bj < 2; ++bj)
#pragma unroll
                    for (int n = 0; n < 2; ++n) *(f32x4*)(rowp + bj * HALF + n * 16) = acc[ai][bj][m][n]; }
    }
};
struct EpiRes {
    static constexpr bool PERM = false, AFTER_DRAIN = false;
    const float* xin; float* xout; const float* gate;
    __device__ __forceinline__ void operator()(const f32x4 (&acc)[2][2][4][2], const Unit& u, int wr, int wc, int fr, int fq) const {
        const int row0 = u.pm * BM + wr * 64 + fr, col0 = u.pn * BM + wc * 32 + 4 * fq;
        const float* gp = gate + (size_t)((u.pm * BM) >> 12) * 6144 + col0;
        f32x4 gv[2][2];
#pragma unroll
        for (int bj = 0; bj < 2; ++bj)
#pragma unroll
            for (int n = 0; n < 2; ++n) gv[bj][n] = *(const f32x4*)(gp + bj * HALF + n * 16);
#pragma unroll
        for (int ai = 0; ai < 2; ++ai)
#pragma unroll
            for (int m = 0; m < 4; ++m) { const size_t ro = (size_t)(row0 + ai * HALF + m * 16) * 1024 + col0;
#pragma unroll
                for (int bj = 0; bj < 2; ++bj)
#pragma unroll
                    for (int n = 0; n < 2; ++n) { const f32x4 xv = *(const f32x4*)(xin + ro + bj * HALF + n * 16); *(f32x4*)(xout + ro + bj * HALF + n * 16) = xv + gv[bj][n] * acc[ai][bj][m][n]; } }
    }
};
__device__ __forceinline__ float swiglu1(float glu, float lin) {
    glu = fminf(glu, 7.0f); lin = fminf(fmaxf(lin, -7.0f), 7.0f);
    return glu * (1.0f / (1.0f + __expf(-1.702f * glu))) * (lin + 1.0f);
}
struct EpiSwiglu {
    static constexpr bool PERM = true, AFTER_DRAIN = false;
    bf16_t* O; const float* b1;
    __device__ __forceinline__ void operator()(const f32x4 (&acc)[2][2][4][2], const Unit& u, int wr, int wc, int fr, int fq) const {
        const int e = u.pn >> 3, j = u.pn & 7, row0 = u.pm * BM + wr * 64 + fr, c0 = 128 * j + wc * 32 + 8 * fq;
        const float* bp = b1 + (size_t)e * 2048 + c0;
        f32x4 bg[2], bl[2];
#pragma unroll
        for (int n = 0; n < 2; ++n) { bg[n] = *(const f32x4*)(bp + 4 * n); bl[n] = *(const f32x4*)(bp + 1024 + 4 * n); }
#pragma unroll
        for (int ai = 0; ai < 2; ++ai)
#pragma unroll
            for (int m = 0; m < 4; ++m) { bf16_t* rowp = O + (size_t)(row0 + ai * HALF + m * 16) * 1024 + c0;
                const f32x4 g0 = acc[ai][0][m][0] + bg[0], g1 = acc[ai][0][m][1] + bg[1], l0 = acc[ai][1][m][0] + bl[0], l1 = acc[ai][1][m][1] + bl[1];
                u32x4 w;
                w.x = cvt_pk_bf16(swiglu1(g0[0], l0[0]), swiglu1(g0[1], l0[1])); w.y = cvt_pk_bf16(swiglu1(g0[2], l0[2]), swiglu1(g0[3], l0[3]));
                w.z = cvt_pk_bf16(swiglu1(g1[0], l1[0]), swiglu1(g1[1], l1[1])); w.w = cvt_pk_bf16(swiglu1(g1[2], l1[2]), swiglu1(g1[3], l1[3]));
                *(u32x4*)rowp = w; }
    }
};
struct EpiY {
    static constexpr bool PERM = true, AFTER_DRAIN = false;
    bf16_t* O; const float* b2;
    __device__ __forceinline__ void operator()(const f32x4 (&acc)[2][2][4][2], const Unit& u, int wr, int wc, int fr, int fq) const {
        const int e = u.pn >> 2, j = u.pn & 3, row0 = u.pm * BM + wr * 64 + fr, c0 = 256 * j + wc * 32 + 8 * fq;
        const float* bp = b2 + (size_t)e * 1024 + c0;
        f32x4 bv[2][2];
#pragma unroll
        for (int bj = 0; bj < 2; ++bj)
#pragma unroll
            for (int n = 0; n < 2; ++n) bv[bj][n] = *(const f32x4*)(bp + bj * HALF + 4 * n);
#pragma unroll
        for (int ai = 0; ai < 2; ++ai)
#pragma unroll
            for (int m = 0; m < 4; ++m) { bf16_t* rowp = O + (size_t)(row0 + ai * HALF + m * 16) * 1024 + c0;
#pragma unroll
                for (int bj = 0; bj < 2; ++bj) { const f32x4 v0 = acc[ai][bj][m][0] + bv[bj][0], v1 = acc[ai][bj][m][1] + bv[bj][1];
                    u32x4 w; w.x = cvt_pk_bf16(v0[0], v0[1]); w.y = cvt_pk_bf16(v0[2], v0[3]); w.z = cvt_pk_bf16(v1[0], v1[1]); w.w = cvt_pk_bf16(v1[2], v1[3]);
                    *(u32x4*)(rowp + bj * HALF) = w; } }
    }
};
struct MoeOrder {
    const PG8_LAS int* tab; int NJ, G, c;
    __device__ __forceinline__ bool next(int i, Unit& u) const {
        const int T = tab[0]; const long L = (long)i * G + c; if (L >= (long)T * NJ) return false;
        const int pm = (int)(L / NJ), j = (int)(L % NJ);
        u.pm = pm; u.pn = tab[1 + pm] * NJ + j; return true;
    }
    __device__ __forceinline__ void a_ready(const Unit&) const {}
    __device__ __forceinline__ void done(const Unit&) const {}
};

template <class Epi, class Sched, bool ALIGN_EPI = false, bool SP2 = false>
__device__ __forceinline__ void gemm_phase(PG8_LAS unsigned char* lds, const Gemm g, const Sched& S, const Epi& E) {
    int tid_ = threadIdx.x; asm volatile("" : "+v"(tid_));
    const int tid = tid_, wid = __builtin_amdgcn_readfirstlane(tid >> 6), lane = tid & 63, wr = wid >> 2, wc = wid & 3, fr = lane & 15, fq = lane >> 4;
    const int K = g.K, nt = K / BK;
    unsigned voffA[2], voffB[2];
#pragma unroll
    for (int i = 0; i < 2; ++i) { int R, C; stage_rc(tid * 16 + i * 8192, R, C); const int Rb = Epi::PERM ? ((R & ~31) + perm32(R & 31)) : R;
        voffA[i] = (unsigned)(R * K + C) * 2u; voffB[i] = (unsigned)(Rb * K + C) * 2u; }
    const size_t kstep = (size_t)(BK * 2);
    const size_t hstep = (size_t)HALF * K * 2;
    const size_t tstep = 2 * hstep;
    const unsigned ldsw = (unsigned)wid * 1024u;
    const int aoff = lds_byte(wr * 64 + fr, fq * 8), boff = lds_byte(wc * 32 + fr, fq * 8);
#define PG8_SA(b, h) (((b) * 2 + (h)) * HTB)
#define PG8_SB(b, h) ((4 + (b) * 2 + (h)) * HTB)
#define PG8_STAGE(bufoff, gbase, voff) do { _Pragma("unroll") for (int _i = 0; _i < 2; ++_i) \
        __builtin_amdgcn_global_load_lds((const unsigned*)((const char*)(gbase) + (voff)[_i]), (PG8_LAS unsigned*)(lds + (bufoff) + ldsw + _i * 8192), 16, 0, 0); } while (0)
#define PG8_LDA(dst, b, h) do { _Pragma("unroll") for (int m = 0; m < 4; ++m) _Pragma("unroll") for (int k = 0; k < 2; ++k) dst[m][k] = *(const PG8_LAS bf16x8*)(lds + PG8_SA(b, h) + aoff + m * 2048 + k * 1024); } while (0)
#define PG8_LDB(dst, b, h) do { _Pragma("unroll") for (int n = 0; n < 2; ++n) _Pragma("unroll") for (int k = 0; k < 2; ++k) dst[n][k] = *(const PG8_LAS bf16x8*)(lds + PG8_SB(b, h) + boff + n * 2048 + k * 1024); } while (0)
#define PG8_MMA(ai, bj, At, Bt) do { __builtin_amdgcn_s_setprio(1); _Pragma("unroll") for (int m = 0; m < 4; ++m) _Pragma("unroll") for (int n = 0; n < 2; ++n) _Pragma("unroll") for (int k = 0; k < 2; ++k) \
        acc[ai][bj][m][n] = __builtin_amdgcn_mfma_f32_16x16x32_bf16(Bt[n][k], At[m][k], acc[ai][bj][m][n], 0, 0, 0); __builtin_amdgcn_s_setprio(0); } while (0)
#define PG8_WAIT_V(n) asm volatile("s_waitcnt vmcnt(" #n ")" ::: "memory")
#define PG8_WAIT_L(n) asm volatile("s_waitcnt lgkmcnt(" #n ")" ::: "memory")
#define PG8_BAR __builtin_amdgcn_s_barrier()
#define PG8_SCHED __builtin_amdgcn_sched_barrier(0)
    Unit cur, nxt; int ui = 0;
    if (!S.next(0, cur)) return;
    f32x4 acc[2][2][4][2];
#pragma unroll
    for (int a = 0; a < 2; ++a)
#pragma unroll
        for (int b = 0; b < 2; ++b)
#pragma unroll
            for (int m = 0; m < 4; ++m)
#pragma unroll
                for (int n = 0; n < 2; ++n) acc[a][b][m][n] = (f32x4){0.f, 0.f, 0.f, 0.f};
    bf16x8 At[4][2], B0[2][2], B1[2][2];
    const char* cA = (const char*)g.A + (size_t)cur.pm * tstep; const char* cB = (const char*)g.Bt + (size_t)cur.pn * tstep;
    S.a_ready(cur);
    if constexpr (SP2) {
        PG8_STAGE(PG8_SB(0, 0), cB, voffB); PG8_STAGE(PG8_SB(0, 1), cB + hstep, voffB); PG8_STAGE(PG8_SA(0, 0), cA, voffA); PG8_STAGE(PG8_SA(0, 1), cA + hstep, voffA);
        if (wr == 1) PG8_BAR;
        PG8_WAIT_V(2); PG8_BAR;
        PG8_STAGE(PG8_SB(1, 0), cB + kstep, voffB); PG8_STAGE(PG8_SA(1, 0), cA + kstep, voffA); PG8_STAGE(PG8_SB(1, 1), cB + hstep + kstep, voffB);
        PG8_WAIT_V(6); PG8_BAR;
    } else {
        PG8_STAGE(PG8_SB(0, 0), cB, voffB); PG8_STAGE(PG8_SA(0, 0), cA, voffA); PG8_STAGE(PG8_SB(0, 1), cB + hstep, voffB); PG8_STAGE(PG8_SA(0, 1), cA + hstep, voffA);
        if (wr == 1) PG8_BAR;
        PG8_WAIT_V(4); PG8_BAR;
        PG8_STAGE(PG8_SB(1, 0), cB + kstep, voffB); PG8_STAGE(PG8_SA(1, 0), cA + kstep, voffA); PG8_STAGE(PG8_SB(1, 1), cB + hstep + kstep, voffB);
        PG8_WAIT_V(6); PG8_BAR;
    }
    for (;;) {
        const bool has_next = S.next(ui + 1, nxt);
        const char* nA = has_next ? (const char*)g.A + (size_t)nxt.pm * tstep : cA; const char* nB = has_next ? (const char*)g.Bt + (size_t)nxt.pn * tstep : cB;
        for (int t = 0; t < nt; t += 2) {
            const bool last = (t == nt - 2);
            const char* a1 = cA + (size_t)(t + 1) * kstep;
            const char* a2 = last ? nA : cA + (size_t)(t + 2) * kstep; const char* b2 = last ? nB : cB + (size_t)(t + 2) * kstep;
            const char* a3 = a2 + kstep; const char* b3 = b2 + kstep;
            if (last && has_next) S.a_ready(nxt);
            if constexpr (SP2) {
            PG8_LDB(B0, 0, 0); PG8_LDB(B1, 0, 1); PG8_SCHED; PG8_LDA(At, 0, 0); PG8_STAGE(PG8_SA(1, 1), a1 + hstep, voffA);
            PG8_WAIT_V(8); PG8_WAIT_L(0); PG8_BAR; PG8_MMA(0, 0, At, B0); PG8_MMA(0, 1, At, B1); PG8_BAR; PG8_SCHED;
            PG8_LDA(At, 0, 1); PG8_STAGE(PG8_SB(0, 0), b2, voffB); PG8_STAGE(PG8_SB(0, 1), b2 + hstep, voffB); PG8_STAGE(PG8_SA(0, 0), a2, voffA);
            PG8_WAIT_V(8); PG8_WAIT_L(0); PG8_BAR; PG8_MMA(1, 0, At, B0); PG8_MMA(1, 1, At, B1); PG8_BAR; PG8_SCHED;
            PG8_LDB(B0, 1, 0); PG8_LDB(B1, 1, 1); PG8_SCHED; PG8_LDA(At, 1, 0); PG8_STAGE(PG8_SA(0, 1), a2 + hstep, voffA);
            PG8_WAIT_V(8); PG8_WAIT_L(0); PG8_BAR; PG8_MMA(0, 0, At, B0); PG8_MMA(0, 1, At, B1); PG8_BAR; PG8_SCHED;
            PG8_LDA(At, 1, 1); PG8_STAGE(PG8_SB(1, 0), b3, voffB); PG8_STAGE(PG8_SB(1, 1), b3 + hstep, voffB); PG8_STAGE(PG8_SA(1, 0), a3, voffA);
            PG8_WAIT_V(8); PG8_WAIT_L(0); PG8_BAR; PG8_MMA(1, 0, At, B0); PG8_MMA(1, 1, At, B1); PG8_BAR; PG8_SCHED;
            } else {
            PG8_LDB(B0, 0, 0); PG8_SCHED; PG8_LDA(At, 0, 0); PG8_STAGE(PG8_SA(1, 1), a1 + hstep, voffA);
            PG8_WAIT_L(8); PG8_BAR; PG8_WAIT_L(0); PG8_MMA(0, 0, At, B0); PG8_BAR; PG8_SCHED;
            PG8_LDB(B1, 0, 1); PG8_STAGE(PG8_SB(0, 0), b2, voffB);
            PG8_BAR; PG8_WAIT_L(0); PG8_MMA(0, 1, At, B1); PG8_BAR;
            PG8_LDA(At, 0, 1); PG8_STAGE(PG8_SA(0, 0), a2, voffA);
            PG8_BAR; PG8_WAIT_L(0); PG8_MMA(1, 0, At, B0); PG8_BAR; PG8_SCHED;
            PG8_STAGE(PG8_SB(0, 1), b2 + hstep, voffB);
            PG8_WAIT_V(6); PG8_BAR; PG8_MMA(1, 1, At, B1); PG8_BAR;
            PG8_LDB(B0, 1, 0); PG8_SCHED; PG8_LDA(At, 1, 0); PG8_STAGE(PG8_SA(0, 1), a2 + hstep, voffA);
            PG8_WAIT_L(8); PG8_BAR; PG8_WAIT_L(0); PG8_MMA(0, 0, At, B0); PG8_BAR; PG8_SCHED;
            PG8_LDB(B1, 1, 1); PG8_STAGE(PG8_SB(1, 0), b3, voffB);
            PG8_BAR; PG8_WAIT_L(0); PG8_MMA(0, 1, At, B1); PG8_BAR;
            PG8_LDA(At, 1, 1); PG8_STAGE(PG8_SA(1, 0), a3, voffA);
            PG8_BAR; PG8_WAIT_L(0); PG8_MMA(1, 0, At, B0); PG8_BAR; PG8_SCHED;
            PG8_STAGE(PG8_SB(1, 1), b3 + hstep, voffB);
            PG8_WAIT_V(6); PG8_BAR; PG8_MMA(1, 1, At, B1); PG8_BAR;
            }
        }
        if constexpr (ALIGN_EPI) { if (wr == 0) PG8_BAR; }
        if constexpr (!Epi::AFTER_DRAIN) { E(acc, cur, wr, wc, fr, fq); S.done(cur); }
        if (!has_next) break;
#pragma unroll
        for (int a = 0; a < 2; ++a)
#pragma unroll
            for (int b = 0; b < 2; ++b)
#pragma unroll
                for (int m = 0; m < 4; ++m)
#pragma unroll
                    for (int n = 0; n < 2; ++n) acc[a][b][m][n] = (f32x4){0.f, 0.f, 0.f, 0.f};
        cur = nxt; cA = nA; cB = nB; ++ui;
        if constexpr (ALIGN_EPI) { if (wr == 1) PG8_BAR; }
    }
    PG8_WAIT_V(0);
    if constexpr (!ALIGN_EPI) { if (wr == 0) PG8_BAR; }
    PG8_BAR;
    if constexpr (Epi::AFTER_DRAIN) { E.fused(acc, cur, wr, wc, fr, fq, lds, wid, lane); S.done(cur); }
#undef PG8_SA
#undef PG8_SB
#undef PG8_STAGE
#undef PG8_LDA
#undef PG8_LDB
#undef PG8_MMA
#undef PG8_WAIT_V
#undef PG8_WAIT_L
#undef PG8_BAR
#undef PG8_SCHED
}
}

constexpr int NWAVES = 8;
constexpr int NB = 8, SEQ = 4096, DM = 1024, MTOK = NB * SEQ, NLAYER = 2;
constexpr int INC = 2984, INCP = 3072;
constexpr int C_RET = 0, C_RW = 1024, C_DSA = 1920, C_SB = 2216;
constexpr int NEXP = 32, MOE_ROWS = MTOK * 4 + NEXP * 256;
constexpr int ROPE_W = 88;
constexpr int NPL = 12, NPHASE = 1 + NLAYER * NPL;
enum { I_X = 0, I_C, I_POS, I_ADAW, I_ADAB, I_NMIX, I_NFFN, I_WIN, I_RETGN, I_MU, I_W0, I_W2, I_A0, I_A2, I_G2, I_KK, I_KA, I_RK, I_LN, I_QNORM, I_WQ, I_WQI, I_DONORM, I_SONORM, I_WOUT, I_RW, I_RB, I_MW1, I_MB1, I_MW2, I_MB2, I_NFINAL, N_IN };

constexpr size_t MiB = 1u << 20;
constexpr size_t WS_CTL = 0, CTL_ZERO_BYTES = 1 * MiB;
constexpr size_t WS_MOD = 1 * MiB, WS_ROPE = 2 * MiB, WS_WIN = 14 * MiB, WS_WOUT = 26 * MiB, WS_W1 = 30 * MiB, WS_W2 = 286 * MiB;
constexpr size_t WS_XA = 414 * MiB, WS_H = 542 * MiB, WS_MIX = 606 * MiB, WS_TOPI = 670 * MiB, WS_TOPW = 671 * MiB, WS_POS = 672 * MiB;
constexpr size_t WS_R = 674 * MiB;
constexpr size_t WS_P = WS_R, WS_RWA = 1058 * MiB  , WS_DQ = 1314 * MiB  , WS_DKB = 1330 * MiB  , WS_DVB = 1334 * MiB  , WS_DQI = 1346 * MiB  , WS_DKI = 1394 * MiB  , WS_DW = 1398 * MiB;
constexpr size_t WS_YO = 1400 * MiB  , WS_SC = 1528 * MiB  ;
constexpr size_t WS_XS = WS_R  , WS_ACT = 946 * MiB  ;
constexpr size_t WS_END = 2040 * MiB;
static_assert((size_t)MOE_ROWS * 2048 <= 272 * MiB, "moe buffers");
constexpr int CW_TMO = 0, CW_CODE = 1, CW_BAR = 4096, CW_CNT = 8192  , CW_CUR = 8320  ;
constexpr int RING_BYTES = 131072, MISC_OFF = RING_BYTES + 320, TST_OFF = RING_BYTES + 1024  , TAB_OFF = RING_BYTES + 2048  , LDS_BYTES = 147456;

#if defined(__HIP_DEVICE_COMPILE__)
#define GAS __attribute__((address_space(1)))
#define CAS __attribute__((address_space(4)))
#else
#define GAS
#define CAS
#endif
#define LAS __attribute__((address_space(3)))
typedef unsigned short bf16;
typedef unsigned v4u __attribute__((ext_vector_type(4)));
typedef unsigned v2u __attribute__((ext_vector_type(2)));
typedef float f32x4 __attribute__((ext_vector_type(4)));
typedef GAS unsigned gu32;
#define RLX_AGENT __ATOMIC_RELAXED, __HIP_MEMORY_SCOPE_AGENT
#define LDS_WAIT() asm volatile("s_waitcnt lgkmcnt(0)" ::: "memory")
#define VM_WAIT() asm volatile("s_waitcnt vmcnt(0)" ::: "memory")
__device__ __forceinline__ unsigned f2bf(float f) { unsigned u = __builtin_bit_cast(unsigned, f); return (u + 0x7fffu + ((u >> 16) & 1u)) >> 16; }
__device__ __forceinline__ unsigned pk2(float lo, float hi) { return f2bf(lo) | (f2bf(hi) << 16); }
__device__ __forceinline__ float bf_lo(unsigned w) { return __builtin_bit_cast(float, w << 16); }
__device__ __forceinline__ float bf_hi(unsigned w) { return __builtin_bit_cast(float, w & 0xffff0000u); }
__device__ __forceinline__ float wave_sum(float v) {
#pragma unroll
    for (int o = 1; o < 64; o <<= 1) v += __shfl_xor(v, o);
    return v;
}
__device__ __forceinline__ float wave_max(float v) {
#pragma unroll
    for (int o = 1; o < 64; o <<= 1) v = fmaxf(v, __shfl_xor(v, o));
    return v;
}
__device__ __forceinline__ float grp16_sum(float v) { v += __shfl_xor(v, 1); v += __shfl_xor(v, 2); v += __shfl_xor(v, 4); v += __shfl_xor(v, 8); return v; }
__device__ __forceinline__ float grp8_sum(float v) { v += __shfl_xor(v, 1); v += __shfl_xor(v, 2); v += __shfl_xor(v, 4); return v; }
__device__ __forceinline__ float sum4(f32x4 a) { return (a.x + a.y) + (a.z + a.w); }
__device__ __forceinline__ float dot4(f32x4 a, f32x4 b) { return (a.x * b.x + a.y * b.y) + (a.z * b.z + a.w * b.w); }
__device__ __forceinline__ float sigm(float x) { return 1.0f / (1.0f + expf(-x)); }
__device__ __forceinline__ float softplusf(float x) { return fmaxf(x, 0.0f) + log1pf(expf(-fabsf(x))); }
__device__ __forceinline__ f32x4 shx4(f32x4 v, int m) { f32x4 r; r.x = __shfl_xor(v.x, m); r.y = __shfl_xor(v.y, m); r.z = __shfl_xor(v.z, m); r.w = __shfl_xor(v.w, m); return r; }

#define XB_TMO      128
#define XB_XCNT(j)  (256  + 64 * (j))
#define XB_XSUB(j)  (1280 + 64 * (j))
#define XB_XGEN(j)  (2304 + 64 * (j))
#define XB_TOP      3328
#define XB_TOPGEN   3392
#define XCD_BAR_WORDS 3456
#define XB_SPIN_CAP (1u << 18)

__device__ __forceinline__ unsigned xb_ld(unsigned* p)              { return __hip_atomic_load(p, __ATOMIC_RELAXED, __HIP_MEMORY_SCOPE_AGENT); }
__device__ __forceinline__ unsigned xb_add(unsigned* p, unsigned v) { return __hip_atomic_fetch_add(p, v, __ATOMIC_RELAXED, __HIP_MEMORY_SCOPE_AGENT); }
__device__ __forceinline__ unsigned xb_xcc_id() { return (unsigned)__builtin_amdgcn_s_getreg((3 << 11) | 20) & 0xFu; }
#define XB_SPIN(cond, bar) do { unsigned _sp = 0; while (cond) { __builtin_amdgcn_s_sleep(1); \
    if ((++_sp & 255u) == 0u) { if (xb_ld(&(bar)[XB_TMO])) break; if (_sp > XB_SPIN_CAP) { atomicAdd(&(bar)[XB_TMO], 1u); break; } } } } while (0)

struct XcdBarrier {
    unsigned* bar; unsigned x;
    volatile LAS unsigned* st;
};

__device__ __forceinline__ XcdBarrier xcd_barrier_post(unsigned* bar, volatile LAS unsigned* st) {
    XcdBarrier b; b.bar = bar; b.x = xb_xcc_id(); b.st = st;
    if (threadIdx.x == 0) (void)xb_add(&bar[XB_XCNT(b.x)], 1u);
    return b;
}
__device__ __forceinline__ void xcd_barrier_complete(unsigned* bar, unsigned x, unsigned& nloc, unsigned& nx) {
    const unsigned G = gridDim.x * gridDim.y * gridDim.z;
    unsigned sum, cnt, mine, sp = 0u;
    for (;;) {
        sum = 0u; cnt = 0u; mine = 0u;
#pragma unroll
        for (unsigned j = 0; j < 16; ++j) { const unsigned c = xb_ld(&bar[XB_XCNT(j)]); sum += c; cnt += (c > 0u) ? 1u : 0u; mine = (j == x) ? c : mine; }
        if (sum == G) break;
        __builtin_amdgcn_s_sleep(1);
        if ((++sp & 255u) == 0u) { if (xb_ld(&bar[XB_TMO])) break; if (sp > XB_SPIN_CAP) { atomicAdd(&bar[XB_TMO], 1u); break; } }
    }
    nloc = mine > 0u ? mine : 1u; nx = cnt > 0u ? cnt : 1u;
}

__device__ __forceinline__ void xcd_barrier(const XcdBarrier& b) {
    asm volatile("s_waitcnt vmcnt(0)" ::: "memory");
    __syncthreads();
    if (threadIdx.x == 0) {
        unsigned* bar = b.bar;
        __builtin_amdgcn_s_waitcnt(0);
        unsigned nloc = b.st[0], nx = b.st[1];
        if (nloc == 0u) { xcd_barrier_complete(bar, b.x, nloc, nx); b.st[0] = nloc; b.st[1] = nx; }
        const unsigned old = xb_add(&bar[XB_XSUB(b.x)], 1u);
        const unsigned gen = old / nloc;
        if (old + 1u == (gen + 1u) * nloc) {
            __builtin_amdgcn_fence(__ATOMIC_RELEASE, "agent");
            asm volatile("s_waitcnt vmcnt(0)" ::: "memory");
            const unsigned og = xb_add(&bar[XB_TOP], 1u);
            const unsigned tg = og / nx;
            if (og + 1u == (tg + 1u) * nx) xb_add(&bar[XB_TOPGEN], 1u);
            else XB_SPIN(xb_ld(&bar[XB_TOPGEN]) == tg, bar);
            __builtin_amdgcn_fence(__ATOMIC_ACQUIRE, "agent");
            xb_add(&bar[XB_XGEN(b.x)], 1u);
            asm volatile("s_waitcnt vmcnt(0)" ::: "memory");
        } else {
            XB_SPIN(xb_ld(&bar[XB_XGEN(b.x)]) == gen, bar);
            __builtin_amdgcn_fence(__ATOMIC_ACQUIRE, "agent");
            asm volatile("s_waitcnt vmcnt(0)" ::: "memory");
        }
    }
    __syncthreads();
}
struct ArgsH { const float* in[N_IN]; float* out; unsigned char* ws; double invf[44]; int ph_lo, ph_hi, li, pad; };
struct ArgsD { const GAS float* in[N_IN]; GAS float* out; GAS unsigned char* ws; double invf[44]; int ph_lo, ph_hi, li, pad; };
static_assert(sizeof(ArgsH) == sizeof(ArgsD), "args layout");
typedef const CAS ArgsD& ARef;
__device__ __forceinline__ const CAS ArgsD* kargs() {
#if defined(__HIP_DEVICE_COMPILE__)
    const CAS ArgsD* p = (const CAS ArgsD*)__builtin_amdgcn_kernarg_segment_ptr(); asm volatile("" : "+s"(p)); return p;
#else
    return nullptr;
#endif
}
struct WI { LAS unsigned char* lds; int tid, lane, wave, vcu, G, gw, NGW, bx; };
constexpr size_t RWA_STRIDE = 32 * MiB / 4;
constexpr size_t YO_STRIDE = 32 * MiB / 4;

__device__ __forceinline__ int wave_sum_i(int v) {
#pragma unroll
    for (int o = 1; o < 64; o <<= 1) v += __shfl_xor(v, o);
    return v;
}
__device__ __forceinline__ void sincos_d(double ang, float& s, float& c) {
    const double q = __builtin_rint(ang * 0.63661977236758134308);
    double r = __builtin_fma(-q, 1.57079632679489661923, ang); r = __builtin_fma(-q, 6.123233995736766e-17, r);
    const double r2 = r * r;
    const double sp = r * (1.0 + r2 * (-1.0 / 6 + r2 * (1.0 / 120 + r2 * (-1.0 / 5040 + r2 * (1.0 / 362880 + r2 * (-1.0 / 39916800 + r2 * (1.0 / 6227020800.0)))))));
    const double cp = 1.0 + r2 * (-0.5 + r2 * (1.0 / 24 + r2 * (-1.0 / 720 + r2 * (1.0 / 40320 + r2 * (-1.0 / 3628800 + r2 * (1.0 / 479001600 + r2 * (-1.0 / 87178291200.0)))))));
    const int qi = ((int)q) & 3;
    const double ss = (qi == 0) ? sp : (qi == 1) ? cp : (qi == 2) ? -sp : -cp;
    const double cc = (qi == 0) ? cp : (qi == 1) ? -sp : (qi == 2) ? -cp : sp;
    s = (float)ss; c = (float)cc;
}

__device__ __forceinline__ void tr_item(const float* W, int ldw, int nvalid, int k0, int nsrc0, bf16* WT, size_t dstrow0, LAS float* scr, int lane) {
#pragma unroll 8
    for (int i = 0; i < 32; ++i) { const int kk = 2 * i + (lane >> 5), c = lane & 31, n = nsrc0 + c; scr[kk * 33 + c] = (n < nvalid) ? W[(size_t)(k0 + kk) * ldw + n] : 0.0f; }
    LDS_WAIT(); asm volatile("" ::: "memory");
    const int c8 = lane & 7;
#pragma unroll
    for (int j = 0; j < 4; ++j) { const int n = (lane >> 3) + 8 * j; const LAS float* s = scr + (8 * c8) * 33 + n;
        v4u o; o.x = pk2(s[0 * 33], s[1 * 33]); o.y = pk2(s[2 * 33], s[3 * 33]); o.z = pk2(s[4 * 33], s[5 * 33]); o.w = pk2(s[6 * 33], s[7 * 33]);
        *(v4u*)(WT + (dstrow0 + n) * 1024 + k0 + 8 * c8) = o; }
    LDS_WAIT(); asm volatile("" ::: "memory");
}
__device__ __forceinline__ void ph_prologue(ARef A, const WI& w) {
    LAS float* sc = (LAS float*)w.lds;
    { const float* cin = A.in[I_C]; for (int i = w.tid; i < NB * DM; i += NWAVES * 64) { const float v = cin[i]; sc[i] = v / (1.0f + expf(-v)); } }
    __syncthreads();
    float* MOD = (float*)(A.ws + WS_MOD);
    if (w.wave == 0 && w.vcu < 192) {
        const int l = w.vcu / 96, col = (w.vcu % 96) * 64 + w.lane;
        const float* wp = A.in[I_ADAW] + (size_t)l * DM * 6144 + col;
        float acc[8];
#pragma unroll
        for (int b = 0; b < 8; ++b) acc[b] = 0.0f;
        for (int k = 0; k < DM; ++k) { const float wv = wp[(size_t)k * 6144];
#pragma unroll
            for (int b = 0; b < 8; ++b) acc[b] += sc[b * DM + k] * wv; }
        const float bias = A.in[I_ADAB][l * 6144 + col];
#pragma unroll
        for (int b = 0; b < 8; ++b) MOD[(size_t)(l * 8 + b) * 6144 + col] = acc[b] + bias;
    }
    LAS float* scr = (LAS float*)(w.lds + 32768 + w.wave * 8448);
    constexpr int I_IN = NLAYER * 16 * 96, I_OUT = NLAYER * 16 * 32, I_W1 = NLAYER * NEXP * 16 * 64, I_W2 = NLAYER * NEXP * 16 * 32, NIT = I_IN + I_OUT + I_W1 + I_W2;
    for (int it = w.gw; it < NIT; it += w.NGW) {
        int r = it;
        if (r < I_IN) { const int l = r / 1536, rr = r % 1536, kb = rr / 96, nb = rr % 96;
            tr_item(A.in[I_WIN] + (size_t)l * DM * INC, INC, INC, kb * 64, nb * 32, (bf16*)(A.ws + WS_WIN) + (size_t)l * INCP * DM, (size_t)nb * 32, scr, w.lane); continue; }
        r -= I_IN;
        if (r < I_OUT) { const int l = r / 512, rr = r % 512, kb = rr / 32, nb = rr % 32;
            tr_item(A.in[I_WOUT] + (size_t)l * DM * DM, DM, DM, kb * 64, nb * 32, (bf16*)(A.ws + WS_WOUT) + (size_t)l * DM * DM, (size_t)nb * 32, scr, w.lane); continue; }
        r -= I_OUT;
        if (r < I_W1) { const int le = r / 1024, rr = r % 1024, kb = rr / 64, nb = rr % 64, j = nb >> 3, bj = (nb >> 2) & 1, cc0 = (nb & 3) * 32;
            tr_item(A.in[I_MW1] + (size_t)le * DM * 2048, 2048, 2048, kb * 64, bj * 1024 + 128 * j + cc0, (bf16*)(A.ws + WS_W1) + (size_t)le * 2048 * DM, (size_t)nb * 32, scr, w.lane); continue; }
        r -= I_W1;
        { const int le = r / 512, rr = r % 512, kb = rr / 32, nb = rr % 32;
            tr_item(A.in[I_MW2] + (size_t)le * DM * DM, DM, DM, kb * 64, nb * 32, (bf16*)(A.ws + WS_W2) + (size_t)le * DM * DM, (size_t)nb * 32, scr, w.lane); }
    }
    float* RT = (float*)(A.ws + WS_ROPE); const int* pos = (const int*)A.in[I_POS];
    for (int g = w.gw * 64 + w.lane; g < MTOK * 44; g += w.NGW * 64) {
        const int tok = g / 44, f = g % 44; int co, so;
        if (f < 32) { co = f; so = 32 + f; } else if (f < 40) { co = 64 + (f - 32); so = 72 + (f - 32); } else { co = 80 + (f - 40); so = 84 + (f - 40); }
        float s, c; sincos_d((double)pos[tok] * A.invf[f], s, c);
        RT[(size_t)tok * ROPE_W + co] = c; RT[(size_t)tok * ROPE_W + so] = s;
    }
}

__device__ __forceinline__ void emit_h_row(const f32x4 (&v)[4], float rstd, const float* g, const float* sc, const float* sh, bf16* hrow, int lane) {
#pragma unroll
    for (int j = 0; j < 4; ++j) { const int k = 4 * (lane + 64 * j);
        const f32x4 gv = *(const f32x4*)(g + k), scv = *(const f32x4*)(sc + k), shv = *(const f32x4*)(sh + k);
        const f32x4 h = v[j] * rstd * gv * (1.0f + scv) + shv;
        v2u o; o.x = pk2(h.x, h.y); o.y = pk2(h.z, h.w); *(v2u*)(hrow + k) = o; }
}
__device__ __forceinline__ void ph_norm1(ARef A, const WI& w) {
    const float* MOD = (const float*)(A.ws + WS_MOD); bf16* H = (bf16*)(A.ws + WS_H);
    for (int m = w.gw; m < MTOK; m += w.NGW) {
        const float* xr = A.in[I_X] + (size_t)m * DM; f32x4 v[4]; float ss = 0.0f;
#pragma unroll
        for (int j = 0; j < 4; ++j) { v[j] = *(const f32x4*)(xr + 4 * (w.lane + 64 * j)); ss += dot4(v[j], v[j]); }
        ss = wave_sum(ss); const float rstd = 1.0f / sqrtf(ss * (1.0f / DM) + 1e-5f);
        const float* mb = MOD + (size_t)(m >> 12) * 6144;
        emit_h_row(v, rstd, A.in[I_NMIX], mb + 1024, mb, H + (size_t)m * DM, w.lane);
    }
}

__device__ __forceinline__ void rwkv_prep(ARef A, int l, int m, int lane) {
    const float* P = (const float*)(A.ws + WS_P); float* RWA = (float*)(A.ws + WS_RWA);
    const int t = m & (SEQ - 1), c4 = 4 * lane;
    const float* pr = P + (size_t)m * INCP + C_RW; const float* pp = pr - INCP; const float* mu = A.in[I_MU] + l * 896;
    f32x4 fr, fk, fv;
    { const f32x4 z = *(const f32x4*)(pr + c4), mm = *(const f32x4*)(mu + c4); f32x4 p = {0.f, 0.f, 0.f, 0.f}; if (t) p = *(const f32x4*)(pp + c4); fr = z + (p - z) * mm; }
    { const f32x4 z = *(const f32x4*)(pr + 256 + c4), mm = *(const f32x4*)(mu + 256 + c4); f32x4 p = {0.f, 0.f, 0.f, 0.f}; if (t) p = *(const f32x4*)(pp + 256 + c4); fk = z + (p - z) * mm; }
    { const f32x4 z = *(const f32x4*)(pr + 512 + c4), mm = *(const f32x4*)(mu + 512 + c4); f32x4 p = {0.f, 0.f, 0.f, 0.f}; if (t) p = *(const f32x4*)(pp + 512 + c4); fv = z + (p - z) * mm; }
    float x0, x1;
    { const float z = pr[768 + lane], p = t ? pp[768 + lane] : 0.0f; x0 = z + (p - z) * mu[768 + lane]; }
    { const float z = pr[832 + lane], p = t ? pp[832 + lane] : 0.0f; x1 = z + (p - z) * mu[832 + lane]; }
    x0 = (lane < 32) ? tanhf(x0) : x0; x1 = sigm(x1);
    f32x4 wacc = *(const f32x4*)(A.in[I_W0] + l * 256 + c4), aacc = *(const f32x4*)(A.in[I_A0] + l * 256 + c4), gacc = {0.f, 0.f, 0.f, 0.f};
    const float* w2 = A.in[I_W2] + l * 32 * 256 + c4; const float* a2 = A.in[I_A2] + l * 32 * 256 + c4; const float* g2 = A.in[I_G2] + l * 64 * 256 + c4;
#pragma unroll 8
    for (int i = 0; i < 32; ++i) { const float s = __shfl(x0, i); wacc += s * *(const f32x4*)(w2 + i * 256); }
#pragma unroll 8
    for (int i = 0; i < 32; ++i) { const float s = __shfl(x0, 32 + i); aacc += s * *(const f32x4*)(a2 + i * 256); }
#pragma unroll 8
    for (int i = 0; i < 64; ++i) { const float s = __shfl(x1, i); gacc += s * *(const f32x4*)(g2 + i * 256); }
    f32x4 dec, av;
#pragma unroll
    for (int i = 0; i < 4; ++i) { const float wl = -softplusf(-wacc[i]) - 0.5f; dec[i] = expf(-expf(wl)); av[i] = sigm(aacc[i]); }
    f32x4 kk = fk * *(const f32x4*)(A.in[I_KK] + l * 256 + c4);
    const float nrm = fmaxf(sqrtf(grp16_sum(dot4(kk, kk))), 1e-12f); kk = kk / nrm;
    const f32x4 kmod = fk * (1.0f + (av - 1.0f) * *(const f32x4*)(A.in[I_KA] + l * 256 + c4));
    const f32x4 bb = kk * av;
    const float bs = grp16_sum(dot4(fr * kmod, *(const f32x4*)(A.in[I_RK] + l * 256 + c4)));
    const size_t o = (size_t)m * 256 + c4;
    *(f32x4*)(RWA + 0 * RWA_STRIDE + o) = fr; *(f32x4*)(RWA + 1 * RWA_STRIDE + o) = dec; *(f32x4*)(RWA + 2 * RWA_STRIDE + o) = kmod; *(f32x4*)(RWA + 3 * RWA_STRIDE + o) = fv;
    *(f32x4*)(RWA + 4 * RWA_STRIDE + o) = -kk; *(f32x4*)(RWA + 5 * RWA_STRIDE + o) = bb; *(f32x4*)(RWA + 6 * RWA_STRIDE + o) = gacc; *(f32x4*)(RWA + 7 * RWA_STRIDE + o) = bs * fv;
}
__device__ __forceinline__ void dsa_prep(ARef A, int l, int m, int lane) {
    const float* P = (const float*)(A.ws + WS_P); const float* RT = (const float*)(A.ws + WS_ROPE) + (size_t)m * ROPE_W;
    const float* pd = P + (size_t)m * INCP + C_DSA; const int c4 = 4 * lane;
    float c0 = pd[lane], c1 = pd[64 + lane];
    const float rstd = 1.0f / sqrtf(wave_sum(c0 * c0 + c1 * c1) * (1.0f / 128.0f) + 1e-5f);
    c0 *= rstd * A.in[I_QNORM][l * 128 + lane]; c1 *= rstd * A.in[I_QNORM][l * 128 + 64 + lane];
    f32x4 q = {0.f, 0.f, 0.f, 0.f}, qi = {0.f, 0.f, 0.f, 0.f};
    const float* wq = A.in[I_WQ] + (size_t)l * 128 * 256 + c4; const float* wqi = A.in[I_WQI] + (size_t)l * 128 * 256 + c4;
#pragma unroll 8
    for (int i = 0; i < 64; ++i) { const float s = __shfl(c0, i); q += s * *(const f32x4*)(wq + i * 256); qi += s * *(const f32x4*)(wqi + i * 256); }
#pragma unroll 8
    for (int i = 0; i < 64; ++i) { const float s = __shfl(c1, i); q += s * *(const f32x4*)(wq + (64 + i) * 256); qi += s * *(const f32x4*)(wqi + (64 + i) * 256); }
    { const int r = lane & 15; const f32x4 ot = shx4(q, 2);
      if (r < 4) { const int fi = 4 * (r & 1); const f32x4 cs = *(const f32x4*)(RT + 64 + fi), sn = *(const f32x4*)(RT + 72 + fi); q = (r < 2) ? q * cs - ot * sn : ot * sn + q * cs; } }
    { const int r = lane & 7; const f32x4 ot = shx4(qi, 1);
      if (r < 2) { const f32x4 cs = *(const f32x4*)(RT + 80), sn = *(const f32x4*)(RT + 84); qi = (r < 1) ? qi * cs - ot * sn : ot * sn + qi * cs; } }
    { const f32x4 qs = q * 0.18033688011112042f; v2u o; o.x = pk2(qs.x, qs.y); o.y = pk2(qs.z, qs.w); *(v2u*)((bf16*)(A.ws + WS_DQ) + (size_t)m * 256 + c4) = o; }
    { typedef _Float16 h4 __attribute__((ext_vector_type(4))); h4 hq; hq.x = (_Float16)qi.x; hq.y = (_Float16)qi.y; hq.z = (_Float16)qi.z; hq.w = (_Float16)qi.w; *(h4*)((_Float16*)(A.ws + WS_DQI) + (size_t)m * 256 + c4) = hq; }
    { const int r = lane & 15; f32x4 kx = *(const f32x4*)(pd + 128 + 4 * r); const f32x4 ot = shx4(kx, 2);
      if (r < 4) { const int fi = 4 * (r & 1); const f32x4 cs = *(const f32x4*)(RT + 64 + fi), sn = *(const f32x4*)(RT + 72 + fi); kx = (r < 2) ? kx * cs - ot * sn : ot * sn + kx * cs; }
      if (lane < 16) { v2u o; o.x = pk2(kx.x, kx.y); o.y = pk2(kx.z, kx.w); *(v2u*)((bf16*)(A.ws + WS_DKB) + (size_t)m * 64 + c4) = o;
                       const f32x4 vx = *(const f32x4*)(pd + 192 + c4); v2u ov; ov.x = pk2(vx.x, vx.y); ov.y = pk2(vx.z, vx.w); *(v2u*)((bf16*)(A.ws + WS_DVB) + (size_t)m * 64 + c4) = ov; } }
    { const int r = lane & 7; f32x4 ki = *(const f32x4*)(pd + 256 + 4 * r); const f32x4 ot = shx4(ki, 1);
      if (r < 2) { const f32x4 cs = *(const f32x4*)(RT + 80), sn = *(const f32x4*)(RT + 84); ki = (r < 1) ? ki * cs - ot * sn : ot * sn + ki * cs; }
      if (lane < 8) { typedef _Float16 h4 __attribute__((ext_vector_type(4))); h4 hk; hk.x = (_Float16)ki.x; hk.y = (_Float16)ki.y; hk.z = (_Float16)ki.z; hk.w = (_Float16)ki.w; *(h4*)((_Float16*)(A.ws + WS_DKI) + (size_t)m * 32 + c4) = hk; }
      if (lane < 2) *(f32x4*)((float*)(A.ws + WS_DW) + (size_t)m * 8 + c4) = *(const f32x4*)(pd + 288 + c4) * 0.0625f; }
}

__device__ __forceinline__ void ret_scan(ARef A, const WI& w, int bh) {
    const int b = bh >> 2, h = bh & 3; const float gamma = 1.0f - exp2f(-5.0f - (float)h);
    LAS float* qs = (LAS float*)w.lds; LAS float* ks = qs + 2048; LAS float* vs = ks + 2048; LAS float* part = vs + 2048;
    const float* P = (const float*)(A.ws + WS_P); const float* RT = (const float*)(A.ws + WS_ROPE); float* YRET = (float*)(A.ws + WS_YO);
    float S[8];
#pragma unroll
    for (int i = 0; i < 8; ++i) S[i] = 0.0f;
    const int tt = w.tid >> 4, d0 = (w.tid & 15) * 4;
    for (int t0 = 0; t0 < SEQ; t0 += 32) {
        { const size_t m = (size_t)b * SEQ + t0 + tt; const float* pr = P + m * INCP + C_RET + h * 64; const float* rt = RT + m * ROPE_W;
          const int fi = d0 & 31, dp = d0 ^ 32;
          const f32x4 cs = *(const f32x4*)(rt + fi), sn = *(const f32x4*)(rt + 32 + fi);
          const f32x4 qm = *(const f32x4*)(pr + d0), qo = *(const f32x4*)(pr + dp), km = *(const f32x4*)(pr + 256 + d0), ko = *(const f32x4*)(pr + 256 + dp);
          const f32x4 qn = (d0 < 32) ? qm * cs - qo * sn : qo * sn + qm * cs;
          const f32x4 kn = ((d0 < 32) ? km * cs - ko * sn : ko * sn + km * cs) * 0.125f;
          *(LAS f32x4*)(qs + tt * 64 + d0) = qn; *(LAS f32x4*)(ks + tt * 64 + d0) = kn; *(LAS f32x4*)(vs + tt * 64 + d0) = *(const f32x4*)(pr + 512 + d0); }
        __syncthreads();
        for (int s = 0; s < 32; ++s) { const float vv = vs[s * 64 + w.lane]; float po = 0.0f;
#pragma unroll
            for (int i = 0; i < 8; ++i) { S[i] = gamma * S[i] + ks[s * 64 + w.wave * 8 + i] * vv; po += qs[s * 64 + w.wave * 8 + i] * S[i]; }
            part[(w.wave * 32 + s) * 64 + w.lane] = po; }
        __syncthreads();
        { f32x4 o = {0.f, 0.f, 0.f, 0.f};
#pragma unroll
          for (int kg = 0; kg < 8; ++kg) o += *(const LAS f32x4*)(part + (kg * 32 + tt) * 64 + d0);
          *(f32x4*)(YRET + ((size_t)b * SEQ + t0 + tt) * 256 + h * 64 + d0) = o; }
        __syncthreads();
    }
}
__device__ __forceinline__ void rwkv_scan(ARef A, const WI& w, int bh) {
    const int b = bh >> 2, h = bh & 3;
    LAS float* sr = (LAS float*)w.lds; LAS float* sw = sr + 2048; LAS float* sk = sw + 2048; LAS float* sv = sk + 2048; LAS float* sn = sv + 2048; LAS float* sb = sn + 2048; LAS float* sy = sb + 2048;
    const float* RWA = (const float*)(A.ws + WS_RWA); float* YRW = (float*)(A.ws + WS_YO) + YO_STRIDE;
    float S[8];
#pragma unroll
    for (int i = 0; i < 8; ++i) S[i] = 0.0f;
    const int vrow = w.tid >> 3, kq = w.tid & 7, tt = w.tid >> 4, d0 = (w.tid & 15) * 4;
    for (int t0 = 0; t0 < SEQ; t0 += 32) {
        { const size_t o = ((size_t)b * SEQ + t0 + tt) * 256 + h * 64 + d0; const int lo = tt * 64 + d0;
          *(LAS f32x4*)(sr + lo) = *(const f32x4*)(RWA + 0 * RWA_STRIDE + o); *(LAS f32x4*)(sw + lo) = *(const f32x4*)(RWA + 1 * RWA_STRIDE + o); *(LAS f32x4*)(sk + lo) = *(const f32x4*)(RWA + 2 * RWA_STRIDE + o);
          *(LAS f32x4*)(sv + lo) = *(const f32x4*)(RWA + 3 * RWA_STRIDE + o); *(LAS f32x4*)(sn + lo) = *(const f32x4*)(RWA + 4 * RWA_STRIDE + o); *(LAS f32x4*)(sb + lo) = *(const f32x4*)(RWA + 5 * RWA_STRIDE + o); }
        __syncthreads();
        for (int s = 0; s < 32; ++s) { const int lo = s * 64 + kq * 8;
            const f32x4 w0 = *(const LAS f32x4*)(sw + lo), w1 = *(const LAS f32x4*)(sw + lo + 4), n0 = *(const LAS f32x4*)(sn + lo), n1 = *(const LAS f32x4*)(sn + lo + 4);
            const f32x4 b0 = *(const LAS f32x4*)(sb + lo), b1 = *(const LAS f32x4*)(sb + lo + 4), k0 = *(const LAS f32x4*)(sk + lo), k1 = *(const LAS f32x4*)(sk + lo + 4);
            const f32x4 r0 = *(const LAS f32x4*)(sr + lo), r1 = *(const LAS f32x4*)(sr + lo + 4); const float vv = sv[s * 64 + vrow];
            float sa = (S[0] * n0.x + S[1] * n0.y) + (S[2] * n0.z + S[3] * n0.w) + (S[4] * n1.x + S[5] * n1.y) + (S[6] * n1.z + S[7] * n1.w);
            sa = grp8_sum(sa);
            S[0] = S[0] * w0.x + sa * b0.x + vv * k0.x; S[1] = S[1] * w0.y + sa * b0.y + vv * k0.y; S[2] = S[2] * w0.z + sa * b0.z + vv * k0.z; S[3] = S[3] * w0.w + sa * b0.w + vv * k0.w;
            S[4] = S[4] * w1.x + sa * b1.x + vv * k1.x; S[5] = S[5] * w1.y + sa * b1.y + vv * k1.y; S[6] = S[6] * w1.z + sa * b1.z + vv * k1.z; S[7] = S[7] * w1.w + sa * b1.w + vv * k1.w;
            float y = (S[0] * r0.x + S[1] * r0.y) + (S[2] * r0.z + S[3] * r0.w) + (S[4] * r1.x + S[5] * r1.y) + (S[6] * r1.z + S[7] * r1.w);
            y = grp8_sum(y);
            if (kq == 0) sy[s * 64 + vrow] = y; }
        __syncthreads();
        *(f32x4*)(YRW + ((size_t)b * SEQ + t0 + tt) * 256 + h * 64 + d0) = *(const LAS f32x4*)(sy + tt * 64 + d0);
        __syncthreads();
    }
}
__device__ __forceinline__ void sb_row(ARef A, int it, int lane) {
    const int t = it & (SEQ - 1), bh = it >> 12, b = bh >> 2, h = bh & 3;
    const float* P = (const float*)(A.ws + WS_P); float* YSB = (float*)(A.ws + WS_YO) + 3 * YO_STRIDE;
    const size_t m = (size_t)b * SEQ + t;
    const float* qrow = P + m * INCP + C_SB + h * 64;
    float q[64], acc[64];
#pragma unroll
    for (int d = 0; d < 64; ++d) { q[d] = qrow[d]; acc[d] = 0.0f; }
    float carry = 0.0f;
    for (int base = t - 1; base >= 0; base -= 64) {
        const int s = base - lane; const bool valid = s >= 0; const int sc = valid ? s : 0;
        const float* kr = P + ((size_t)b * SEQ + sc) * INCP + C_SB + 256 + h * 64;
        float z = 0.0f;
#pragma unroll
        for (int d4 = 0; d4 < 16; ++d4) { const f32x4 kv = *(const f32x4*)(kr + 4 * d4); z += (q[4 * d4] * kv.x + q[4 * d4 + 1] * kv.y) + (q[4 * d4 + 2] * kv.z + q[4 * d4 + 3] * kv.w); }
        z *= 0.125f;
        const float Ln = valid ? -softplusf(z) : 0.0f;
        float inc = Ln;
#pragma unroll
        for (int off = 1; off < 64; off <<= 1) { const float y = __shfl_up(inc, off); if (lane >= off) inc += y; }
        const float tot = __shfl(inc, 63);
        const float la = (z + Ln) + carry + (inc - Ln);
        const float a = valid ? expf(la) : 0.0f;
        carry += tot;
        const float* vr = kr + 256;
#pragma unroll
        for (int d4 = 0; d4 < 16; ++d4) { const f32x4 vv = *(const f32x4*)(vr + 4 * d4); acc[4 * d4] += a * vv.x; acc[4 * d4 + 1] += a * vv.y; acc[4 * d4 + 2] += a * vv.z; acc[4 * d4 + 3] += a * vv.w; }
        if (carry < -104.0f) break;
    }
    float o = 0.0f;
#pragma unroll
    for (int d = 0; d < 64; ++d) { const float r = wave_sum(acc[d]); o = (lane == d) ? r : o; }
    YSB[m * 256 + h * 64 + lane] = o;
}
typedef _Float16 f16x8 __attribute__((ext_vector_type(8)));
__device__ __forceinline__ void dsa_scores_mfma(ARef A, const WI& w) {
    const _Float16* QIH = (const _Float16*)(A.ws + WS_DQI); const _Float16* KIH = (const _Float16*)(A.ws + WS_DKI);
    const float* DW = (const float*)(A.ws + WS_DW); float* SC = (float*)(A.ws + WS_SC);
    const int col = w.lane & 15, q4 = w.lane >> 4;
    for (int u = w.gw; u < 2048; u += w.NGW) {
        const int pi = u >> 1, par = u & 1, b = pi >> 7, p = pi & 127;
#pragma unroll 1
        for (int side = 0; side < 2; ++side) {
            const int qb = side ? 255 - p : p; const size_t m0 = (size_t)b * SEQ + 16 * qb;
            f16x8 bq[8];
#pragma unroll
            for (int h = 0; h < 8; ++h) bq[h] = *(const f16x8*)(QIH + (m0 + col) * 256 + h * 32 + 8 * q4);
            const float* dw = DW + (m0 + col) * 8; const f32x4 wa = *(const f32x4*)dw, wb = *(const f32x4*)(dw + 4);
            float* srow = SC + (m0 + col) * SEQ + 4 * q4;
            const _Float16* kbase = KIH + ((size_t)b * SEQ + col) * 32 + 8 * q4;
            for (int kb = par; kb <= qb; kb += 2) {
                const f16x8 ak = *(const f16x8*)(kbase + (size_t)kb * 16 * 32);
                f32x4 acc = {0.f, 0.f, 0.f, 0.f};
#pragma unroll
                for (int h = 0; h < 8; ++h) { const f32x4 c = __builtin_amdgcn_mfma_f32_16x16x32_f16(ak, bq[h], (f32x4){0.f, 0.f, 0.f, 0.f}, 0, 0, 0); const float wv = (h < 4) ? wa[h] : wb[h - 4];
                    acc.x += wv * fmaxf(c.x, 0.f); acc.y += wv * fmaxf(c.y, 0.f); acc.z += wv * fmaxf(c.z, 0.f); acc.w += wv * fmaxf(c.w, 0.f); }
                *(f32x4*)(srow + 16 * kb) = acc + 0.0f;
            }
        }
    }
}

typedef short bf16x8v __attribute__((ext_vector_type(8)));
typedef short s16x4v __attribute__((ext_vector_type(4)));
__device__ __forceinline__ unsigned score_key(float f) { const unsigned bits = __float_as_uint(f); return (bits & 0x80000000u) ? ~bits : (bits | 0x80000000u); }
constexpr int VST_PITCH = 144;
__device__ __forceinline__ void dsa_row_mfma(ARef A, int m, int lane, LAS unsigned char* wl) {
    LAS int* slist = (LAS int*)wl;
    LAS unsigned char* vst = wl + 1024;
    const int b = m >> 12, t = m & (SEQ - 1), n = t + 1, col = lane & 15, q4 = lane >> 4;
    const float* sc = (const float*)(A.ws + WS_SC) + (size_t)m * SEQ;
    int nsel;
    if (n <= 256) {
#pragma unroll
        for (int c = 0; c < 4; ++c) { const int idx = lane + 64 * c; slist[idx] = (idx < n) ? idx : 0; }
        nsel = n;
    } else {
        unsigned u[64];
#pragma unroll
        for (int j4 = 0; j4 < 16; ++j4) { f32x4 v = {0.f, 0.f, 0.f, 0.f}; if (256 * j4 < n) v = *(const f32x4*)(sc + 256 * j4 + 4 * lane);
#pragma unroll
            for (int i = 0; i < 4; ++i) u[4 * j4 + i] = (256 * j4 + 4 * lane + i < n) ? score_key(v[i]) : 0u; }
        unsigned T = 0u;
        for (int bit = 31; bit >= 0; --bit) { const unsigned cand = T | (1u << bit); int cnt = 0;
#pragma unroll
            for (int j = 0; j < 64; ++j) cnt += (u[j] >= cand) ? 1 : 0;
            if (wave_sum_i(cnt) >= 256) T = cand; }
        unsigned long long gtb = 0ull, eqb = 0ull;
#pragma unroll
        for (int j = 0; j < 64; ++j) { gtb |= (unsigned long long)((u[j] > T) ? 1u : 0u) << j; eqb |= (unsigned long long)((u[j] == T) ? 1u : 0u) << j; }
        const int tgt = wave_sum_i(__popcll(gtb)), teq = wave_sum_i(__popcll(eqb));
        unsigned long long selb = gtb | eqb;
        if (tgt + teq > 256) {
            const int take = 256 - tgt; int lo = 0;
            for (int bit = 11; bit >= 0; --bit) { const int cand = lo | (1 << bit); const int J4 = cand >> 8; int ni = (cand & 255) - 4 * lane; ni = ni < 0 ? 0 : (ni > 4 ? 4 : ni);
                const int jc = 4 * J4 + ni; const unsigned long long msk = (jc >= 64) ? ~0ull : ((1ull << jc) - 1ull);
                if (wave_sum_i(__popcll(eqb & msk)) < take) lo = cand; }
            { const int cand = lo + 1; const int J4 = cand >> 8; int ni = (cand & 255) - 4 * lane; ni = ni < 0 ? 0 : (ni > 4 ? 4 : ni);
              const int jc = (cand >= SEQ) ? 64 : 4 * J4 + ni; const unsigned long long msk = (jc >= 64) ? ~0ull : ((1ull << jc) - 1ull); selb = gtb | (eqb & msk); }
        }
        const int mine = __popcll(selb); int off = mine;
#pragma unroll
        for (int d = 1; d < 64; d <<= 1) { const int y = __shfl_up(off, d); if (lane >= d) off += y; }
        off -= mine;
        while (selb) { const int j = __builtin_ctzll(selb); selb &= selb - 1ull; slist[off] = 256 * (j >> 2) + 4 * lane + (j & 3); ++off; }
        nsel = 256;
    }
    LDS_WAIT();
    const bf16* DKB = (const bf16*)(A.ws + WS_DKB) + (size_t)b * SEQ * 64; const bf16* DVB = (const bf16*)(A.ws + WS_DVB) + (size_t)b * SEQ * 64;
    bf16x8v bq0 = {0, 0, 0, 0, 0, 0, 0, 0}, bq1 = {0, 0, 0, 0, 0, 0, 0, 0};
    if (col < 4) { const bf16* qp = (const bf16*)(A.ws + WS_DQ) + (size_t)m * 256 + col * 64 + 8 * q4; bq0 = *(const bf16x8v*)qp; bq1 = *(const bf16x8v*)(qp + 32); }
    f32x4 lg[16];
#pragma unroll
    for (int kb = 0; kb < 16; ++kb) { const int s = slist[16 * kb + col]; const bf16* kr = DKB + (size_t)s * 64 + 8 * q4;
        const bf16x8v a0 = *(const bf16x8v*)kr, a1 = *(const bf16x8v*)(kr + 32);
        f32x4 c = __builtin_amdgcn_mfma_f32_16x16x32_bf16(a0, bq0, (f32x4){0.f, 0.f, 0.f, 0.f}, 0, 0, 0);
        lg[kb] = __builtin_amdgcn_mfma_f32_16x16x32_bf16(a1, bq1, c, 0, 0, 0); }
    if (nsel < 256) {
#pragma unroll
        for (int kb = 0; kb < 16; ++kb)
#pragma unroll
            for (int r = 0; r < 4; ++r) if (16 * kb + 4 * q4 + r >= nsel) lg[kb][r] = -INFINITY; }
    float mx = -INFINITY;
#pragma unroll
    for (int kb = 0; kb < 16; ++kb) mx = fmaxf(fmaxf(mx, fmaxf(lg[kb].x, lg[kb].y)), fmaxf(lg[kb].z, lg[kb].w));
    mx = fmaxf(mx, __shfl_xor(mx, 16)); mx = fmaxf(mx, __shfl_xor(mx, 32));
    float sm = 0.f;
#pragma unroll
    for (int kb = 0; kb < 16; ++kb) { lg[kb].x = exp2f(lg[kb].x - mx); lg[kb].y = exp2f(lg[kb].y - mx); lg[kb].z = exp2f(lg[kb].z - mx); lg[kb].w = exp2f(lg[kb].w - mx); sm += (lg[kb].x + lg[kb].y) + (lg[kb].z + lg[kb].w); }
    sm += __shfl_xor(sm, 16); sm += __shfl_xor(sm, 32);
    const float inv = 1.0f / sm;
    bf16x8v pa[8];
#pragma unroll
    for (int i = 0; i < 8; ++i) { const f32x4 x = lg[2 * i] * inv, y = lg[2 * i + 1] * inv;
        pg8::u32x4 wv; wv.x = pg8::cvt_pk_bf16(x.x, x.y); wv.y = pg8::cvt_pk_bf16(x.z, x.w); wv.z = pg8::cvt_pk_bf16(y.x, y.y); wv.w = pg8::cvt_pk_bf16(y.z, y.w);
        pa[i] = __builtin_bit_cast(bf16x8v, wv); }
    f32x4 o[4];
#pragma unroll
    for (int nb = 0; nb < 4; ++nb) o[nb] = (f32x4){0.f, 0.f, 0.f, 0.f};
    const int srow = lane >> 3, spc = lane & 7, tj = col >> 2, tc = col & 3;
#pragma unroll
    for (int c = 0; c < 4; ++c) {
#pragma unroll
        for (int i = 0; i < 8; ++i) { const int s = slist[64 * c + srow + 8 * i]; const v4u v = *(const v4u*)(DVB + (size_t)s * 64 + 8 * spc); *(LAS v4u*)(vst + (srow + 8 * i) * VST_PITCH + 16 * spc) = v; }
        LDS_WAIT();
#pragma unroll
        for (int k2 = 0; k2 < 2; ++k2)
#pragma unroll
            for (int nb = 0; nb < 4; ++nb) {
                LAS unsigned char* a1 = vst + (32 * k2 + 4 * q4 + tj) * VST_PITCH + (16 * nb + 4 * tc) * 2;
                const s16x4v r1 = __builtin_bit_cast(s16x4v, __builtin_amdgcn_ds_read_tr16_b64_v4i16((LAS s16x4v*)a1));
                const s16x4v r2 = __builtin_bit_cast(s16x4v, __builtin_amdgcn_ds_read_tr16_b64_v4i16((LAS s16x4v*)(a1 + 16 * VST_PITCH)));
                const bf16x8v bv = {r1[0], r1[1], r1[2], r1[3], r2[0], r2[1], r2[2], r2[3]};
                o[nb] = __builtin_amdgcn_mfma_f32_16x16x32_bf16(pa[2 * c + k2], bv, o[nb], 0, 0, 0); }
        LDS_WAIT();
    }
    if (lane < 16) { float* YD = (float*)(A.ws + WS_YO) + 2 * YO_STRIDE + (size_t)m * 256;
#pragma unroll
        for (int nb = 0; nb < 4; ++nb) { YD[16 * nb + lane] = o[nb].x; YD[64 + 16 * nb + lane] = o[nb].y; YD[128 + 16 * nb + lane] = o[nb].z; YD[192 + 16 * nb + lane] = o[nb].w; } }
}

__device__ __forceinline__ f32x4 head_norm4(f32x4 y, float eps, f32x4 g) {
    const float mean = grp16_sum(sum4(y)) * (1.0f / 64.0f); const f32x4 yc = y - mean;
    const float var = grp16_sum(dot4(yc, yc)) * (1.0f / 64.0f); return yc * (1.0f / sqrtf(var + eps)) * g;
}
__device__ __forceinline__ void post_row(ARef A, int l, int m, int lane) {
    const float* P = (const float*)(A.ws + WS_P); const float* YO = (const float*)(A.ws + WS_YO); const float* RWA = (const float*)(A.ws + WS_RWA);
    bf16* MX = (bf16*)(A.ws + WS_MIX) + (size_t)m * DM; const int c4 = 4 * lane; const size_t o = (size_t)m * 256 + c4;
    { f32x4 y = head_norm4(*(const f32x4*)(YO + o), 1e-5f, *(const f32x4*)(A.in[I_RETGN] + l * 256 + c4));
      const f32x4 g = *(const f32x4*)(P + (size_t)m * INCP + C_RET + 768 + c4);
#pragma unroll
      for (int i = 0; i < 4; ++i) y[i] *= g[i] * sigm(g[i]);
      v2u w; w.x = pk2(y.x, y.y); w.y = pk2(y.z, y.w); *(v2u*)(MX + c4) = w; }
    { f32x4 y = head_norm4(*(const f32x4*)(YO + YO_STRIDE + o), 64e-5f, *(const f32x4*)(A.in[I_LN] + l * 256 + c4));
      y = (y + *(const f32x4*)(RWA + 7 * RWA_STRIDE + o)) * *(const f32x4*)(RWA + 6 * RWA_STRIDE + o);
      v2u w; w.x = pk2(y.x, y.y); w.y = pk2(y.z, y.w); *(v2u*)(MX + 256 + c4) = w; }
    { f32x4 y = *(const f32x4*)(YO + 2 * YO_STRIDE + o); const float r = 1.0f / sqrtf(wave_sum(dot4(y, y)) * (1.0f / 256.0f) + 1e-5f);
      y = y * r * *(const f32x4*)(A.in[I_DONORM] + l * 256 + c4);
      v2u w; w.x = pk2(y.x, y.y); w.y = pk2(y.z, y.w); *(v2u*)(MX + 512 + c4) = w; }
    { f32x4 y = *(const f32x4*)(YO + 3 * YO_STRIDE + o); const float r = 1.0f / sqrtf(wave_sum(dot4(y, y)) * (1.0f / 256.0f) + 1e-5f);
      y = y * r * *(const f32x4*)(A.in[I_SONORM] + l * 256 + c4);
      v2u w; w.x = pk2(y.x, y.y); w.y = pk2(y.z, y.w); *(v2u*)(MX + 768 + c4) = w; }
}

__device__ __forceinline__ void router_row(ARef A, int l, int m, int lane) {
    const float* XA = (const float*)(A.ws + WS_XA) + (size_t)m * DM; const float* MOD = (const float*)(A.ws + WS_MOD) + (size_t)(l * 8 + (m >> 12)) * 6144;
    f32x4 v[4]; float ss = 0.0f;
#pragma unroll
    for (int j = 0; j < 4; ++j) { v[j] = *(const f32x4*)(XA + 4 * (lane + 64 * j)); ss += dot4(v[j], v[j]); }
    ss = wave_sum(ss); const float rstd = 1.0f / sqrtf(ss * (1.0f / DM) + 1e-5f);
    const float* g = A.in[I_NFFN] + l * DM; const float* scp = MOD + 4 * 1024; const float* shp = MOD + 3 * 1024;
    emit_h_row(v, rstd, g, scp, shp, (bf16*)(A.ws + WS_H) + (size_t)m * DM, lane);
    float p[32];
#pragma unroll
    for (int e = 0; e < 32; ++e) p[e] = 0.0f;
    const float* rw = A.in[I_RW] + (size_t)l * DM * 32;
#pragma unroll 1
    for (int j = 0; j < 4; ++j) { const int k = 4 * (lane + 64 * j);
        const f32x4 h = *(const f32x4*)(XA + k) * rstd * *(const f32x4*)(g + k) * (1.0f + *(const f32x4*)(scp + k)) + *(const f32x4*)(shp + k);
        const float* row = rw + (size_t)k * 32;
#pragma unroll
        for (int i = 0; i < 4; ++i) {
#pragma unroll
            for (int q4 = 0; q4 < 8; ++q4) { const f32x4 r = *(const f32x4*)(row + i * 32 + 4 * q4); p[4 * q4] += h[i] * r.x; p[4 * q4 + 1] += h[i] * r.y; p[4 * q4 + 2] += h[i] * r.z; p[4 * q4 + 3] += h[i] * r.w; } } }
    const float* rb = A.in[I_RB] + l * 32;
#pragma unroll
    for (int e = 0; e < 32; ++e) p[e] = wave_sum(p[e]) + rb[e];
    unsigned used = 0u; float tv[4]; int ti[4];
#pragma unroll
    for (int kk = 0; kk < 4; ++kk) { float best = -INFINITY; int bi = 0;
#pragma unroll
        for (int e = 0; e < 32; ++e) { const bool c = !((used >> e) & 1u) && (p[e] > best); best = c ? p[e] : best; bi = c ? e : bi; }
        used |= 1u << bi; tv[kk] = best; ti[kk] = bi; }
    const float e1 = expf(tv[1] - tv[0]), e2 = expf(tv[2] - tv[0]), e3 = expf(tv[3] - tv[0]); const float inv = 1.0f / (1.0f + e1 + e2 + e3);
    if (lane == 0) {
        int* TI = (int*)(A.ws + WS_TOPI) + (size_t)m * 4; float* TW = (float*)(A.ws + WS_TOPW) + (size_t)m * 4;
        TI[0] = ti[0]; TI[1] = ti[1]; TI[2] = ti[2]; TI[3] = ti[3]; TW[0] = inv; TW[1] = e1 * inv; TW[2] = e2 * inv; TW[3] = e3 * inv;
        unsigned* cnt = (unsigned*)(A.ws + WS_CTL) + CW_CNT + l * 32;
        atomicAdd(cnt + ti[0], 1u); atomicAdd(cnt + ti[1], 1u); atomicAdd(cnt + ti[2], 1u); atomicAdd(cnt + ti[3], 1u);
    }
}
__device__ __forceinline__ void build_expert_table(ARef A, const WI& w, int l) {
    LAS int* tst = (LAS int*)(w.lds + TST_OFF); LAS int* tab = (LAS int*)(w.lds + TAB_OFF);
    if (w.tid == 0) { const unsigned* cnt = (const unsigned*)(A.ws + WS_CTL) + CW_CNT + l * 32; int acc = 0;
        for (int e = 0; e < 32; ++e) { tst[e] = acc; acc += (int)((__hip_atomic_load(cnt + e, RLX_AGENT) + 255u) >> 8); }
        tst[32] = acc; tab[0] = acc; }
    __syncthreads();
    if (w.tid < 32) { const int e = w.tid; for (int pm = tst[e]; pm < tst[e + 1]; ++pm) tab[1 + pm] = e; }
    __syncthreads();
}
__device__ __forceinline__ void scatter_row(ARef A, const WI& w, int l, int m) {
    const LAS int* tst = (const LAS int*)(w.lds + TST_OFF);
    int pos = 0;
    if (w.lane < 4) { const int e = ((const int*)(A.ws + WS_TOPI))[(size_t)m * 4 + w.lane];
        const unsigned slot = atomicAdd((unsigned*)(A.ws + WS_CTL) + CW_CUR + l * 32 + e, 1u);
        pos = tst[e] * 256 + (int)slot; ((int*)(A.ws + WS_POS))[(size_t)m * 4 + w.lane] = pos; }
    const v4u* src = (const v4u*)((const bf16*)(A.ws + WS_H) + (size_t)m * DM);
    const v4u a = src[w.lane], b = src[64 + w.lane];
#pragma unroll
    for (int k = 0; k < 4; ++k) { const int pk = __shfl(pos, k); v4u* dst = (v4u*)((bf16*)(A.ws + WS_XS) + (size_t)pk * DM); dst[w.lane] = a; dst[64 + w.lane] = b; }
}
__device__ __forceinline__ void combine_row(ARef A, int l, int m, int lane) {
    float* XA = (float*)(A.ws + WS_XA) + (size_t)m * DM; const float* MOD = (const float*)(A.ws + WS_MOD) + (size_t)(l * 8 + (m >> 12)) * 6144;
    const int* PS = (const int*)(A.ws + WS_POS) + (size_t)m * 4; const float* TW = (const float*)(A.ws + WS_TOPW) + (size_t)m * 4;
    const bf16* YS = (const bf16*)(A.ws + WS_XS);
    f32x4 v[4], acc[4];
#pragma unroll
    for (int j = 0; j < 4; ++j) { v[j] = *(const f32x4*)(XA + 4 * (lane + 64 * j)); acc[j] = (f32x4){0.f, 0.f, 0.f, 0.f}; }
#pragma unroll
    for (int k = 0; k < 4; ++k) { const int pos = PS[k]; const float gt = TW[k]; const v2u* yr = (const v2u*)(YS + (size_t)pos * DM);
#pragma unroll
        for (int j = 0; j < 4; ++j) { const v2u y = yr[lane + 64 * j]; acc[j] += gt * (f32x4){bf_lo(y.x), bf_hi(y.x), bf_lo(y.y), bf_hi(y.y)}; } }
    float ss = 0.0f;
#pragma unroll
    for (int j = 0; j < 4; ++j) { const int kx = 4 * (lane + 64 * j); v[j] += *(const f32x4*)(MOD + 5 * 1024 + kx) * acc[j]; ss += dot4(v[j], v[j]); }
    ss = wave_sum(ss); const float rstd = 1.0f / sqrtf(ss * (1.0f / DM) + 1e-5f);
    if (l + 1 < NLAYER) {
#pragma unroll
        for (int j = 0; j < 4; ++j) *(f32x4*)(XA + 4 * (lane + 64 * j)) = v[j];
        const float* mb = MOD + 8 * 6144;
        emit_h_row(v, rstd, A.in[I_NMIX] + (l + 1) * DM, mb + 1024, mb, (bf16*)(A.ws + WS_H) + (size_t)m * DM, lane);
    } else {
        float* orow = A.out + (size_t)m * DM; const float* gf = A.in[I_NFINAL];
#pragma unroll
        for (int j = 0; j < 4; ++j) { const int kx = 4 * (lane + 64 * j); *(f32x4*)(orow + kx) = v[j] * rstd * *(const f32x4*)(gf + kx); }
    }
}

constexpr int N_LAUNCHES = MK_N_LAUNCHES;
template <int SEL> __global__ void __launch_bounds__(NWAVES * 64, 2) fwd(ArgsH Ah) {
    extern __shared__ __attribute__((aligned(16))) unsigned char lds[];
    (void)Ah;
#define MAKE_WI() WI w; { int tz = threadIdx.x; asm volatile("" : "+v"(tz)); int bz = blockIdx.x, gz = gridDim.x; asm volatile("" : "+s"(bz), "+s"(gz)); \
        w.lds = (LAS unsigned char*)lds; w.tid = tz; w.lane = tz & 63; w.wave = __builtin_amdgcn_readfirstlane(tz >> 6); w.G = gz; w.bx = bz; w.vcu = (gz % 8 == 0) ? (bz % 8) * (gz / 8) + bz / 8 : bz; \
        w.gw = w.vcu * NWAVES + w.wave; w.NGW = gz * NWAVES; }
    { const int t0 = threadIdx.x; for (int u = t0; u < (LDS_BYTES - RING_BYTES) / 4; u += NWAVES * 64) ((LAS unsigned*)((LAS unsigned char*)lds + RING_BYTES))[u] = 0u; }
    __syncthreads();
    int lo, hi; { ARef A0 = *kargs(); lo = A0.ph_lo; hi = A0.ph_hi; }
    if (N_LAUNCHES == 1) { ARef A0 = *kargs(); (void)xcd_barrier_post((unsigned*)((gu32*)(A0.ws + WS_CTL) + CW_BAR), (volatile LAS unsigned*)((LAS unsigned char*)lds + MISC_OFF) + 8); }
#define GRID_BAR() do { if (N_LAUNCHES == 1) { ARef Ab = *kargs(); XcdBarrier bar_; bar_.bar = (unsigned*)((gu32*)(Ab.ws + WS_CTL) + CW_BAR); bar_.x = xb_xcc_id(); bar_.st = (volatile LAS unsigned*)((LAS unsigned char*)lds + MISC_OFF) + 8; xcd_barrier(bar_); } } while (0)
#define IN(k) (lo <= (k) && (k) < hi)
#ifndef PHMASK
#define PHMASK 0xffffffffu
#endif
#define KON(k) if constexpr ((SEL < 0 && ((PHMASK >> (k)) & 1u)) || SEL == (k))
#define BOTH(k) (IN(k) && IN((k) + 1))
#define ring ((PG8_LAS unsigned char*)lds)

    KON(0) if (IN(0)) { ARef A = *kargs(); MAKE_WI(); ph_prologue(A, w); if (BOTH(0)) GRID_BAR(); }

#define LAYER_BODY(l) do {\
        const int pb = 1 + l * NPL; \
        KON(1) if (IN(pb + 0)) { ARef A = *kargs(); MAKE_WI(); if (l == 0) ph_norm1(A, w); if (BOTH(pb + 0)) GRID_BAR(); } \
        KON(2) if (IN(pb + 1)) { ARef A = *kargs(); MAKE_WI(); \
            pg8::Gemm g{(const bf16*)(A.ws + WS_H), (const bf16*)(A.ws + WS_WIN) + (size_t)l * INCP * DM, MTOK, INCP, DM}; pg8::StaticOrder S; S.init(MTOK, INCP, w.G, w.bx); \
            pg8::EpiF32 E{(float*)(A.ws + WS_P), INCP}; \
            pg8::gemm_phase<pg8::EpiF32, pg8::StaticOrder, true, true>(ring, g, S, E); \
            if (BOTH(pb + 1)) GRID_BAR(); \
        } \
        KON(3) if (IN(pb + 2)) { ARef A = *kargs(); MAKE_WI(); \
            for (int m = w.gw; m < MTOK; m += w.NGW) { rwkv_prep(A, l, m, w.lane); dsa_prep(A, l, m, w.lane); } \
            if (BOTH(pb + 2)) GRID_BAR(); \
        } \
        KON(4) if (IN(pb + 3)) { ARef A = *kargs(); MAKE_WI(); \
            if (w.vcu < 32) ret_scan(A, w, w.vcu); else if (w.vcu < 64) rwkv_scan(A, w, w.vcu - 32); \
            __syncthreads(); \
            for (int it = w.gw; it < MTOK * 4; it += w.NGW) sb_row(A, it, w.lane); \
            dsa_scores_mfma(A, w); \
            if (BOTH(pb + 3)) GRID_BAR(); \
        } \
        KON(5) if (IN(pb + 4)) { ARef A = *kargs(); MAKE_WI(); \
            LAS unsigned char* wl = w.lds + w.wave * 10240; \
            for (int i = w.gw; i < MTOK; i += w.NGW) { const int m = (i & 1) ? (MTOK - 1 - (i >> 1)) : (i >> 1); dsa_row_mfma(A, m, w.lane, wl); } \
            if (BOTH(pb + 4)) GRID_BAR(); \
        } \
        KON(6) if (IN(pb + 5)) { ARef A = *kargs(); MAKE_WI(); \
            for (int m = w.gw; m < MTOK; m += w.NGW) post_row(A, l, m, w.lane); \
            if (BOTH(pb + 5)) GRID_BAR(); \
        } \
        KON(7) if (IN(pb + 6)) { ARef A = *kargs(); MAKE_WI(); \
            pg8::Gemm g{(const bf16*)(A.ws + WS_MIX), (const bf16*)(A.ws + WS_WOUT) + (size_t)l * DM * DM, MTOK, DM, DM}; pg8::StaticOrder S; S.init(MTOK, DM, w.G, w.bx); \
            pg8::EpiRes E{l == 0 ? A.in[I_X] : (const float*)(A.ws + WS_XA), (float*)(A.ws + WS_XA), (const float*)(A.ws + WS_MOD) + (size_t)l * 8 * 6144 + 2 * 1024}; \
            pg8::gemm_phase<pg8::EpiRes, pg8::StaticOrder, true, true>(ring, g, S, E); \
            if (BOTH(pb + 6)) GRID_BAR(); \
        } \
        KON(8) if (IN(pb + 7)) { ARef A = *kargs(); MAKE_WI(); \
            for (int m = w.gw; m < MTOK; m += w.NGW) router_row(A, l, m, w.lane); \
            if (BOTH(pb + 7)) GRID_BAR(); \
        } \
        KON(9) if (IN(pb + 8)) { ARef A = *kargs(); MAKE_WI(); \
            build_expert_table(A, w, l); \
            for (int m = w.gw; m < MTOK; m += w.NGW) scatter_row(A, w, l, m); \
            if (BOTH(pb + 8)) GRID_BAR(); \
        } \
        KON(10) if (IN(pb + 9)) { ARef A = *kargs(); MAKE_WI(); \
            build_expert_table(A, w, l); \
            pg8::Gemm g{(const bf16*)(A.ws + WS_XS), (const bf16*)(A.ws + WS_W1) + (size_t)l * NEXP * 2048 * DM, MOE_ROWS, NEXP * 2048, DM}; \
            pg8::MoeOrder S{(const PG8_LAS int*)(w.lds + TAB_OFF), 8, w.G, w.vcu}; \
            pg8::EpiSwiglu E{(bf16*)(A.ws + WS_ACT), A.in[I_MB1] + (size_t)l * NEXP * 2048}; \
            pg8::gemm_phase<pg8::EpiSwiglu, pg8::MoeOrder, true, true>(ring, g, S, E); \
            if (BOTH(pb + 9)) GRID_BAR(); \
        } \
        KON(11) if (IN(pb + 10)) { ARef A = *kargs(); MAKE_WI(); \
            build_expert_table(A, w, l); \
            pg8::Gemm g{(const bf16*)(A.ws + WS_ACT), (const bf16*)(A.ws + WS_W2) + (size_t)l * NEXP * DM * DM, MOE_ROWS, NEXP * DM, DM}; \
            pg8::MoeOrder S{(const PG8_LAS int*)(w.lds + TAB_OFF), 4, w.G, w.vcu}; \
            pg8::EpiY E{(bf16*)(A.ws + WS_XS), A.in[I_MB2] + (size_t)l * NEXP * DM}; \
            pg8::gemm_phase<pg8::EpiY, pg8::MoeOrder, true, true>(ring, g, S, E); \
            if (BOTH(pb + 10)) GRID_BAR(); \
        } \
        KON(12) if (IN(pb + 11)) { ARef A = *kargs(); MAKE_WI(); \
            for (int m = w.gw; m < MTOK; m += w.NGW) combine_row(A, l, m, w.lane); \
            if (BOTH(pb + 11)) GRID_BAR(); \
        } \
    } while (0)
    LAYER_BODY(0);
    LAYER_BODY(1);
#undef LAYER_BODY
#undef IN
#undef ring
#undef MAKE_WI
#undef GRID_BAR
#undef KON
#undef BOTH
}


#if MK_N_LAUNCHES != 1
template <int K> static void launch_one(int grid, hipStream_t stream, const ArgsH& a) {
    static bool attr = false;
    if (!attr) { (void)hipFuncSetAttribute((const void*)fwd<K>, hipFuncAttributeMaxDynamicSharedMemorySize, LDS_BYTES); attr = true; }
    hipLaunchKernelGGL(fwd<K>, dim3(grid), dim3(NWAVES * 64), LDS_BYTES, stream, a);
}
static void launch_kind(int kind, int grid, hipStream_t stream, const ArgsH& a) {
    switch (kind) {
        case 0: launch_one<0>(grid, stream, a); break; case 1: launch_one<1>(grid, stream, a); break; case 2: launch_one<2>(grid, stream, a); break;
        case 3: launch_one<3>(grid, stream, a); break; case 4: launch_one<4>(grid, stream, a); break; case 5: launch_one<5>(grid, stream, a); break;
        case 6: launch_one<6>(grid, stream, a); break; case 7: launch_one<7>(grid, stream, a); break; case 8: launch_one<8>(grid, stream, a); break;
        case 9: launch_one<9>(grid, stream, a); break; case 10: launch_one<10>(grid, stream, a); break; case 11: launch_one<11>(grid, stream, a); break;
        default: launch_one<12>(grid, stream, a); break;
    }
}
#endif
extern "C" void kernel_launch(void* const* d_in, const int* in_sizes, int n_in, void* d_out, int out_size, void* d_ws, size_t ws_size, hipStream_t stream) {
    static int grid = 0;
    if (grid == 0) {
        if (n_in != N_IN || out_size != MTOK * DM || ws_size < WS_END) { fprintf(stderr, "kernel_launch: unexpected shapes (n_in %d, out %d, ws %zu)\n", n_in, out_size, ws_size); grid = -1; return; }
        int dev = 0, cus = 0;
        if (hipGetDevice(&dev) != hipSuccess || hipDeviceGetAttribute(&cus, hipDeviceAttributeMultiprocessorCount, dev) != hipSuccess) { grid = -1; return; }
#if MK_N_LAUNCHES == 1
        {
            if (hipFuncSetAttribute((const void*)fwd<-1>, hipFuncAttributeMaxDynamicSharedMemorySize, LDS_BYTES) != hipSuccess) { fprintf(stderr, "kernel_launch: hipFuncSetAttribute failed\n"); grid = -1; return; }
            int per_cu = 0;
            if (hipOccupancyMaxActiveBlocksPerMultiprocessor(&per_cu, (const void*)fwd<-1>, NWAVES * 64, LDS_BYTES) != hipSuccess || per_cu < 1) fprintf(stderr, "kernel_launch: occupancy query says %d\n", per_cu);
            (void)hipGetLastError();
        }
#endif
        grid = cus;
    }
    if (grid < 0) return;
    (void)in_sizes;
    if (hipMemsetAsync((char*)d_ws + WS_CTL, 0, CTL_ZERO_BYTES, stream) != hipSuccess) return;
    ArgsH a{};
    for (int i = 0; i < N_IN; ++i) a.in[i] = (const float*)d_in[i];
    a.out = (float*)d_out; a.ws = (unsigned char*)d_ws;
    for (int f = 0; f < 44; ++f) a.invf[f] = (f < 32) ? pow(10000.0, -(double)f / 32.0) : (f < 40) ? pow(500000.0, -(double)(f - 32) / 8.0) : pow(500000.0, -(double)(f - 40) / 4.0);
#if MK_N_LAUNCHES == 1
    a.ph_lo = 0; a.ph_hi = NPHASE; a.li = 0;
    hipLaunchKernelGGL(fwd<-1>, dim3(grid), dim3(NWAVES * 64), LDS_BYTES, stream, a);
#else
    {
        for (int p = 0; p < NPHASE; ++p) {
            if (p == 1 + NPL) continue;
            a.ph_lo = p; a.ph_hi = p + 1; a.li = p;
            const int kind = (p == 0) ? 0 : 1 + (p - 1) % NPL;
            launch_kind(kind, grid, stream, a);
        }
    }
#endif
}
```

```cpp
#include <hip/hip_runtime.h>
#include <cstdio>
#include <cstdint>
#include <cmath>

#ifndef MK_N_LAUNCHES
#define MK_N_LAUNCHES 1
#endif

namespace pg8 {
#define PG8_LAS __attribute__((address_space(3)))
typedef unsigned short bf16_t;
typedef short bf16x8 __attribute__((ext_vector_type(8)));
typedef float f32x4 __attribute__((ext_vector_type(4)));
typedef unsigned u32x4 __attribute__((ext_vector_type(4)));
typedef unsigned u32x2 __attribute__((ext_vector_type(2)));
constexpr int BM = 256, BK = 64, HALF = 128, HTB = HALF * BK * 2  , STAGE_BYTES = 8 * HTB, NXCD = 8, WGM = 8;

__host__ __device__ __forceinline__ int lds_byte(int r, int c) { const int st = (r >> 4) * 2 + (c >> 5), rr = r & 15, cc = c & 31, ob = rr * 64 + cc * 2; return st * 1024 + (ob ^ (((ob >> 9) & 1) << 5)); }
__host__ __device__ __forceinline__ void stage_rc(int b, int& R, int& C) { const int st = b / 1024, sb = b % 1024, swz = sb ^ (((sb >> 9) & 1) << 5); R = (st >> 1) * 16 + swz / 64; C = (st & 1) * 32 + (swz % 64) / 2; }
__host__ __device__ __forceinline__ int perm32(int rho) { const int n = rho >> 4, i = rho & 15; return 8 * (i >> 2) + 4 * n + (i & 3); }

struct Unit { int pm, pn; };
struct Gemm { const bf16_t* A; const bf16_t* Bt; int M, N, K; };

struct StaticOrder {
    int nM, nN, nwg, G, c;
    __host__ __device__ void init(int M, int N, int G_, int c_) { nM = M / BM; nN = N / BM; nwg = nM * nN; G = G_; c = c_; }
    __host__ __device__ bool next(int i, Unit& u) const {
        const long L = (long)i * G + c; if (L >= nwg) return false;
        int wgid = (int)L; { const int q = nwg / NXCD, r = nwg % NXCD, xcd = wgid % NXCD, off = wgid / NXCD; wgid = (xcd < r ? xcd * (q + 1) : r * (q + 1) + (xcd - r) * q) + off; }
        const int nig = WGM * nN, gid = wgid / nig, fm = gid * WGM, gsz = (nM - fm) < WGM ? (nM - fm) : WGM;
        u.pm = fm + ((wgid % nig) % gsz); u.pn = (wgid % nig) / gsz; return true;
    }
    __device__ __forceinline__ void a_ready(const Unit&) const {}
    __device__ __forceinline__ void done(const Unit&) const {}
};
__device__ __forceinline__ unsigned cvt_pk_bf16(float lo, float hi) { unsigned r; asm volatile("v_cvt_pk_bf16_f32 %0, %1, %2" : "=v"(r) : "v"(lo), "v"(hi)); return r; }
struct EpiF32 {
    static constexpr bool PERM = false, AFTER_DRAIN = false;
    float* C; int ldc;
    __device__ __forceinline__ void operator()(const f32x4 (&acc)[2][2][4][2], const Unit& u, int wr, int wc, int fr, int fq) const {
        const int row0 = u.pm * BM + wr * 64 + fr, col0 = u.pn * BM + wc * 32 + 4 * fq;
#pragma unroll
        for (int ai = 0; ai < 2; ++ai)
#pragma unroll
            for (int m = 0; m < 4; ++m) { float* rowp = C + (size_t)(row0 + ai * HALF + m * 16) * ldc + col0;
#pragma unroll
                for (int bj = 0; bj < 2; ++bj)
#pragma unroll
                    for (int n = 0; n < 2; ++n) *(f32x4*)(rowp + bj * HALF + n * 16) = acc[ai][bj][m][n]; }
    }
};
struct EpiRes {
    static constexpr bool PERM = false, AFTER_DRAIN = false;
    const float* xin; float* xout; const float* gate;
    __device__ __forceinline__ void operator()(const f32x4 (&acc)[2][2][4][2], const Unit& u, int wr, int wc, int fr, int fq) const {
        const int row0 = u.pm * BM + wr * 64 + fr, col0 = u.pn * BM + wc * 32 + 4 * fq;
        const float* gp = gate + (size_t)((u.pm * BM) >> 12) * 6144 + col0;
        f32x4 gv[2][2];
#pragma unroll
        for (int bj = 0; bj < 2; ++bj)
#pragma unroll
            for (int n = 0; n < 2; ++n) gv[bj][n] = *(const f32x4*)(gp + bj * HALF + n * 16);
#pragma unroll
        for (int ai = 0; ai < 2; ++ai)
#pragma unroll
            for (int m = 0; m < 4; ++m) { const size_t ro = (size_t)(row0 + ai * HALF + m * 16) * 1024 + col0;
#pragma unroll
                for (int bj = 0; bj < 2; ++bj)
#pragma unroll
                    for (int n = 0; n < 2; ++n) { const f32x4 xv = *(const f32x4*)(xin + ro + bj * HALF + n * 16); *(f32x4*)(xout + ro + bj * HALF + n * 16) = xv + gv[bj][n] * acc[ai][bj][m][n]; } }
    }
};
__device__ __forceinline__ float swiglu1(float glu, float lin) {
    glu = fminf(glu, 7.0f); lin = fminf(fmaxf(lin, -7.0f), 7.0f);
    return glu * (1.0f / (1.0f + __expf(-1.702f * glu))) * (lin + 1.0f);
}
struct EpiSwiglu {
    static constexpr bool PERM = true, AFTER_DRAIN = false;
    bf16_t* O; const float* b1;
    __device__ __forceinline__ void operator()(const f32x4 (&acc)[2][2][4][2], const Unit& u, int wr, int wc, int fr, int fq) const {
        const int e = u.pn >> 3, j = u.pn & 7, row0 = u.pm * BM + wr * 64 + fr, c0 = 128 * j + wc * 32 + 8 * fq;
        const float* bp = b1 + (size_t)e * 2048 + c0;
        f32x4 bg[2], bl[2];
#pragma unroll
        for (int n = 0; n < 2; ++n) { bg[n] = *(const f32x4*)(bp + 4 * n); bl[n] = *(const f32x4*)(bp + 1024 + 4 * n); }
#pragma unroll
        for (int ai = 0; ai < 2; ++ai)
#pragma unroll
            for (int m = 0; m < 4; ++m) { bf16_t* rowp = O + (size_t)(row0 + ai * HALF + m * 16) * 1024 + c0;
                const f32x4 g0 = acc[ai][0][m][0] + bg[0], g1 = acc[ai][0][m][1] + bg[1], l0 = acc[ai][1][m][0] + bl[0], l1 = acc[ai][1][m][1] + bl[1];
                u32x4 w;
                w.x = cvt_pk_bf16(swiglu1(g0[0], l0[0]), swiglu1(g0[1], l0[1])); w.y = cvt_pk_bf16(swiglu1(g0[2], l0[2]), swiglu1(g0[3], l0[3]));
                w.z = cvt_pk_bf16(swiglu1(g1[0], l1[0]), swiglu1(g1[1], l1[1])); w.w = cvt_pk_bf16(swiglu1(g1[2], l1[2]), swiglu1(g1[3], l1[3]));
                *(u32x4*)rowp = w; }
    }
};
struct EpiY {
    static constexpr bool PERM = true, AFTER_DRAIN = false;
    bf16_t* O; const float* b2;
    __device__ __forceinline__ void operator()(const f32x4 (&acc)[2][2][4][2], const Unit& u, int wr, int wc, int fr, int fq) const {
        const int e = u.pn >> 2, j = u.pn & 3, row0 = u.pm * BM + wr * 64 + fr, c0 = 256 * j + wc * 32 + 8 * fq;
        const float* bp = b2 + (size_t)e * 1024 + c0;
        f32x4 bv[2][2];
#pragma unroll
        for (int bj = 0; bj < 2; ++bj)
#pragma unroll
            for (int n = 0; n < 2; ++n) bv[bj][n] = *(const f32x4*)(bp + bj * HALF + 4 * n);
#pragma unroll
        for (int ai = 0; ai < 2; ++ai)
#pragma unroll
            for (int m = 0; m < 4; ++m) { bf16_t* rowp = O + (size_t)(row0 + ai * HALF + m * 16) * 1024 + c0;
#pragma unroll
                for (int bj = 0; bj < 2; ++bj) { const f32x4 v0 = acc[ai][bj][m][0] + bv[bj][0], v1 = acc[ai][bj][m][1] + bv[bj][1];
                    u32x4 w; w.x = cvt_pk_bf16(v0[0], v0[1]); w.y = cvt_pk_bf16(v0[2], v0[3]); w.z = cvt_pk_bf16(v1[0], v1[1]); w.w = cvt_pk_bf16(v1[2], v1[3]);
                    *(u32x4*)(rowp + bj * HALF) = w; } }
    }
};
struct MoeOrder {
    const PG8_LAS int* tab; int NJ, G, c;
    __device__ __forceinline__ bool next(int i, Unit& u) const {
        const int T = tab[0]; const long L = (long)i * G + c; if (L >= (long)T * NJ) return false;
        const int pm = (int)(L / NJ), j = (int)(L % NJ);
        u.pm = pm; u.pn = tab[1 + pm] * NJ + j; return true;
    }
    __device__ __forceinline__ void a_ready(const Unit&) const {}
    __device__ __forceinline__ void done(const Unit&) const {}
};

template <class Epi, class Sched, bool ALIGN_EPI = false, bool SP2 = false>
__device__ __forceinline__ void gemm_phase(PG8_LAS unsigned char* lds, const Gemm g, const Sched& S, const Epi& E, int tid_in) {
    int tid_ = tid_in; asm volatile("" : "+v"(tid_));
    const int tid = tid_, wid = __builtin_amdgcn_readfirstlane(tid >> 6), lane = tid & 63, wr = wid >> 2, wc = wid & 3, fr = lane & 15, fq = lane >> 4;
    const int K = g.K, nt = K / BK;
    unsigned voffA[2], voffB[2];
#pragma unroll
    for (int i = 0; i < 2; ++i) { int R, C; stage_rc(tid * 16 + i * 8192, R, C); const int Rb = Epi::PERM ? ((R & ~31) + perm32(R & 31)) : R;
        voffA[i] = (unsigned)(R * K + C) * 2u; voffB[i] = (unsigned)(Rb * K + C) * 2u; }
    const size_t kstep = (size_t)(BK * 2);
    const size_t hstep = (size_t)HALF * K * 2;
    const size_t tstep = 2 * hstep;
    const unsigned ldsw = (unsigned)wid * 1024u;
    const int aoff = lds_byte(wr * 64 + fr, fq * 8), boff = lds_byte(wc * 32 + fr, fq * 8);
#define PG8_SA(b, h) (((b) * 2 + (h)) * HTB)
#define PG8_SB(b, h) ((4 + (b) * 2 + (h)) * HTB)
#define PG8_STAGE(bufoff, gbase, voff) do { _Pragma("unroll") for (int _i = 0; _i < 2; ++_i) \
        __builtin_amdgcn_global_load_lds((const unsigned*)((const char*)(gbase) + (voff)[_i]), (PG8_LAS unsigned*)(lds + (bufoff) + ldsw + _i * 8192), 16, 0, 0); } while (0)
#define PG8_LDA(dst, b, h) do { _Pragma("unroll") for (int m = 0; m < 4; ++m) _Pragma("unroll") for (int k = 0; k < 2; ++k) dst[m][k] = *(const PG8_LAS bf16x8*)(lds + PG8_SA(b, h) + aoff + m * 2048 + k * 1024); } while (0)
#define PG8_LDB(dst, b, h) do { _Pragma("unroll") for (int n = 0; n < 2; ++n) _Pragma("unroll") for (int k = 0; k < 2; ++k) dst[n][k] = *(const PG8_LAS bf16x8*)(lds + PG8_SB(b, h) + boff + n * 2048 + k * 1024); } while (0)
#define PG8_MMA(ai, bj, At, Bt) do { __builtin_amdgcn_s_setprio(1); _Pragma("unroll") for (int m = 0; m < 4; ++m) _Pragma("unroll") for (int n = 0; n < 2; ++n) _Pragma("unroll") for (int k = 0; k < 2; ++k) \
        acc[ai][bj][m][n] = __builtin_amdgcn_mfma_f32_16x16x32_bf16(Bt[n][k], At[m][k], acc[ai][bj][m][n], 0, 0, 0); __builtin_amdgcn_s_setprio(0); } while (0)
#define PG8_WAIT_V(n) asm volatile("s_waitcnt vmcnt(" #n ")" ::: "memory")
#define PG8_WAIT_L(n) asm volatile("s_waitcnt lgkmcnt(" #n ")" ::: "memory")
#define PG8_BAR __builtin_amdgcn_s_barrier()
#define PG8_SCHED __builtin_amdgcn_sched_barrier(0)
    Unit cur, nxt; int ui = 0;
    if (!S.next(0, cur)) return;
    f32x4 acc[2][2][4][2];
#pragma unroll
    for (int a = 0; a < 2; ++a)
#pragma unroll
        for (int b = 0; b < 2; ++b)
#pragma unroll
            for (int m = 0; m < 4; ++m)
#pragma unroll
                for (int n = 0; n < 2; ++n) acc[a][b][m][n] = (f32x4){0.f, 0.f, 0.f, 0.f};
    bf16x8 At[4][2], B0[2][2], B1[2][2];
    const char* cA = (const char*)g.A + (size_t)cur.pm * tstep; const char* cB = (const char*)g.Bt + (size_t)cur.pn * tstep;
    S.a_ready(cur);
    if constexpr (SP2) {
        PG8_STAGE(PG8_SB(0, 0), cB, voffB); PG8_STAGE(PG8_SB(0, 1), cB + hstep, voffB); PG8_STAGE(PG8_SA(0, 0), cA, voffA); PG8_STAGE(PG8_SA(0, 1), cA + hstep, voffA);
        if (wr == 1) PG8_BAR;
        PG8_WAIT_V(2); PG8_BAR;
        PG8_STAGE(PG8_SB(1, 0), cB + kstep, voffB); PG8_STAGE(PG8_SA(1, 0), cA + kstep, voffA); PG8_STAGE(PG8_SB(1, 1), cB + hstep + kstep, voffB);
        PG8_WAIT_V(6); PG8_BAR;
    } else {
        PG8_STAGE(PG8_SB(0, 0), cB, voffB); PG8_STAGE(PG8_SA(0, 0), cA, voffA); PG8_STAGE(PG8_SB(0, 1), cB + hstep, voffB); PG8_STAGE(PG8_SA(0, 1), cA + hstep, voffA);
        if (wr == 1) PG8_BAR;
        PG8_WAIT_V(4); PG8_BAR;
        PG8_STAGE(PG8_SB(1, 0), cB + kstep, voffB); PG8_STAGE(PG8_SA(1, 0), cA + kstep, voffA); PG8_STAGE(PG8_SB(1, 1), cB + hstep + kstep, voffB);
        PG8_WAIT_V(6); PG8_BAR;
    }
    for (;;) {
        const bool has_next = S.next(ui + 1, nxt);
        const char* nA = has_next ? (const char*)g.A + (size_t)nxt.pm * tstep : cA; const char* nB = has_next ? (const char*)g.Bt + (size_t)nxt.pn * tstep : cB;
        for (int t = 0; t < nt; t += 2) {
            const bool last = (t == nt - 2);
            const char* a1 = cA + (size_t)(t + 1) * kstep;
            const char* a2 = last ? nA : cA + (size_t)(t + 2) * kstep; const char* b2 = last ? nB : cB + (size_t)(t + 2) * kstep;
            const char* a3 = a2 + kstep; const char* b3 = b2 + kstep;
            if (last && has_next) S.a_ready(nxt);
            if constexpr (SP2) {
            PG8_LDB(B0, 0, 0); PG8_LDB(B1, 0, 1); PG8_SCHED; PG8_LDA(At, 0, 0); PG8_STAGE(PG8_SA(1, 1), a1 + hstep, voffA);
            PG8_WAIT_V(8); PG8_WAIT_L(0); PG8_BAR; PG8_MMA(0, 0, At, B0); PG8_MMA(0, 1, At, B1); PG8_BAR; PG8_SCHED;
            PG8_LDA(At, 0, 1); PG8_STAGE(PG8_SB(0, 0), b2, voffB); PG8_STAGE(PG8_SB(0, 1), b2 + hstep, voffB); PG8_STAGE(PG8_SA(0, 0), a2, voffA);
            PG8_WAIT_V(8); PG8_WAIT_L(0); PG8_BAR; PG8_MMA(1, 0, At, B0); PG8_MMA(1, 1, At, B1); PG8_BAR; PG8_SCHED;
            PG8_LDB(B0, 1, 0); PG8_LDB(B1, 1, 1); PG8_SCHED; PG8_LDA(At, 1, 0); PG8_STAGE(PG8_SA(0, 1), a2 + hstep, voffA);
            PG8_WAIT_V(8); PG8_WAIT_L(0); PG8_BAR; PG8_MMA(0, 0, At, B0); PG8_MMA(0, 1, At, B1); PG8_BAR; PG8_SCHED;
            PG8_LDA(At, 1, 1); PG8_STAGE(PG8_SB(1, 0), b3, voffB); PG8_STAGE(PG8_SB(1, 1), b3 + hstep, voffB); PG8_STAGE(PG8_SA(1, 0), a3, voffA);
            PG8_WAIT_V(8); PG8_WAIT_L(0); PG8_BAR; PG8_MMA(1, 0, At, B0); PG8_MMA(1, 1, At, B1); PG8_BAR; PG8_SCHED;
            } else {
            PG8_LDB(B0, 0, 0); PG8_SCHED; PG8_LDA(At, 0, 0); PG8_STAGE(PG8_SA(1, 1), a1 + hstep, voffA);
            PG8_WAIT_L(8); PG8_BAR; PG8_WAIT_L(0); PG8_MMA(0, 0, At, B0); PG8_BAR; PG8_SCHED;
            PG8_LDB(B1, 0, 1); PG8_STAGE(PG8_SB(0, 0), b2, voffB);
            PG8_BAR; PG8_WAIT_L(0); PG8_MMA(0, 1, At, B1); PG8_BAR;
            PG8_LDA(At, 0, 1); PG8_STAGE(PG8_SA(0, 0), a2, voffA);
            PG8_BAR; PG8_WAIT_L(0); PG8_MMA(1, 0, At, B0); PG8_BAR; PG8_SCHED;
            PG8_STAGE(PG8_SB(0, 1), b2 + hstep, voffB);
            PG8_WAIT_V(6); PG8_BAR; PG8_MMA(1, 1, At, B1); PG8_BAR;
            PG8_LDB(B0, 1, 0); PG8_SCHED; PG8_LDA(At, 1, 0); PG8_STAGE(PG8_SA(0, 1), a2 + hstep, voffA);
            PG8_WAIT_L(8); PG8_BAR; PG8_WAIT_L(0); PG8_MMA(0, 0, At, B0); PG8_BAR; PG8_SCHED;
            PG8_LDB(B1, 1, 1); PG8_STAGE(PG8_SB(1, 0), b3, voffB);
            PG8_BAR; PG8_WAIT_L(0); PG8_MMA(0, 1, At, B1); PG8_BAR;
            PG8_LDA(At, 1, 1); PG8_STAGE(PG8_SA(1, 0), a3, voffA);
            PG8_BAR; PG8_WAIT_L(0); PG8_MMA(1, 0, At, B0); PG8_BAR; PG8_SCHED;
            PG8_STAGE(PG8_SB(1, 1), b3 + hstep, voffB);
            PG8_WAIT_V(6); PG8_BAR; PG8_MMA(1, 1, At, B1); PG8_BAR;
            }
        }
        if constexpr (ALIGN_EPI) { if (wr == 0) PG8_BAR; }
        if constexpr (!Epi::AFTER_DRAIN) { E(acc, cur, wr, wc, fr, fq); S.done(cur); }
        if (!has_next) break;
#pragma unroll
        for (int a = 0; a < 2; ++a)
#pragma unroll
            for (int b = 0; b < 2; ++b)
#pragma unroll
                for (int m = 0; m < 4; ++m)
#pragma unroll
                    for (int n = 0; n < 2; ++n) acc[a][b][m][n] = (f32x4){0.f, 0.f, 0.f, 0.f};
        cur = nxt; cA = nA; cB = nB; ++ui;
        if constexpr (ALIGN_EPI) { if (wr == 1) PG8_BAR; }
    }
    PG8_WAIT_V(0);
    if constexpr (!ALIGN_EPI) { if (wr == 0) PG8_BAR; }
    PG8_BAR;
    if constexpr (Epi::AFTER_DRAIN) { E.fused(acc, cur, wr, wc, fr, fq, lds, wid, lane); S.done(cur); }
#undef PG8_SA
#undef PG8_SB
#undef PG8_STAGE
#undef PG8_LDA
#undef PG8_LDB
#undef PG8_MMA
#undef PG8_WAIT_V
#undef PG8_WAIT_L
#undef PG8_BAR
#undef PG8_SCHED
}
}

constexpr int NWAVES = 8;
constexpr int NB = 8, SEQ = 4096, DM = 1024, MTOK = NB * SEQ, NLAYER = 2;
constexpr int INC = 2984, INCP = 3072;
constexpr int C_RET = 0, C_RW = 1024, C_DSA = 1920, C_SB = 2216;
constexpr int NEXP = 32, MOE_ROWS = MTOK * 4 + NEXP * 256;
constexpr int ROPE_W = 88;
constexpr int NCH = 16, TCH = SEQ / NCH;
constexpr int NPL = 12, NPHASE = 1 + NLAYER * NPL;
enum { I_X = 0, I_C, I_POS, I_ADAW, I_ADAB, I_NMIX, I_NFFN, I_WIN, I_RETGN, I_MU, I_W0, I_W2, I_A0, I_A2, I_G2, I_KK, I_KA, I_RK, I_LN, I_QNORM, I_WQ, I_WQI, I_DONORM, I_SONORM, I_WOUT, I_RW, I_RB, I_MW1, I_MB1, I_MW2, I_MB2, I_NFINAL, N_IN };

constexpr size_t MiB = 1u << 20;
constexpr size_t WS_CTL = 0, CTL_ZERO_BYTES = 1 * MiB;
constexpr size_t WS_MOD = 1 * MiB, WS_ROPE = 2 * MiB, WS_WIN = 14 * MiB, WS_WOUT = 26 * MiB, WS_W1 = 30 * MiB, WS_W2 = 286 * MiB;
constexpr size_t WS_XA = 414 * MiB, WS_H = 542 * MiB, WS_MIX = 606 * MiB, WS_TOPI = 670 * MiB, WS_TOPW = 671 * MiB, WS_POS = 672 * MiB;
constexpr size_t WS_R = 674 * MiB;
constexpr size_t WS_P = WS_R, WS_RWA = 1058 * MiB  , WS_DQ = 1314 * MiB  , WS_DKB = 1330 * MiB  , WS_DVB = 1334 * MiB  , WS_DQI = 1346 * MiB  , WS_DKI = 1394 * MiB  , WS_DW = 1398 * MiB;
constexpr size_t WS_PT = 1362 * MiB  ;
constexpr size_t WS_CH = WS_H  , WS_SI = WS_H + 16 * MiB  , WS_SIR = WS_H + 24 * MiB  ,
                 WS_CHR = WS_H + 32 * MiB  , WS_PTR = WS_H + 40 * MiB  ;
constexpr size_t WS_SQ = WS_MIX  , WS_SK = WS_MIX + 16 * MiB, WS_SV = WS_MIX + 32 * MiB;
constexpr size_t WS_YO = 1400 * MiB  , WS_SC = 1528 * MiB  ;
constexpr size_t WS_XS = WS_R  , WS_ACT = 946 * MiB  ;
constexpr size_t WS_END = 2040 * MiB;
static_assert((size_t)MOE_ROWS * 2048 <= 272 * MiB, "moe buffers");
constexpr int CW_TMO = 0, CW_CODE = 1, CW_BAR = 4096, CW_CNT = 8192  , CW_CUR = 8320  ;
constexpr int RING_BYTES = 131072, MISC_OFF = RING_BYTES + 320, TST_OFF = RING_BYTES + 1024  , TAB_OFF = RING_BYTES + 2048  , LDS_BYTES = 147456;

#if defined(__HIP_DEVICE_COMPILE__)
#define GAS __attribute__((address_space(1)))
#define CAS __attribute__((address_space(4)))
#else
#define GAS
#define CAS
#endif
#define LAS __attribute__((address_space(3)))
typedef unsigned short bf16;
typedef unsigned v4u __attribute__((ext_vector_type(4)));
typedef unsigned v2u __attribute__((ext_vector_type(2)));
typedef float f32x4 __attribute__((ext_vector_type(4)));
typedef GAS unsigned gu32;
typedef short bf16x8v __attribute__((ext_vector_type(8)));
typedef short s16x4v __attribute__((ext_vector_type(4)));
#define RLX_AGENT __ATOMIC_RELAXED, __HIP_MEMORY_SCOPE_AGENT
#define LDS_WAIT() asm volatile("s_waitcnt lgkmcnt(0)" ::: "memory")
#define VM_WAIT() asm volatile("s_waitcnt vmcnt(0)" ::: "memory")
__device__ __forceinline__ unsigned f2bf(float f) { unsigned u = __builtin_bit_cast(unsigned, f); return (u + 0x7fffu + ((u >> 16) & 1u)) >> 16; }
__device__ __forceinline__ unsigned pk2(float lo, float hi) { return f2bf(lo) | (f2bf(hi) << 16); }
__device__ __forceinline__ float bf_lo(unsigned w) { return __builtin_bit_cast(float, w << 16); }
__device__ __forceinline__ float bf_hi(unsigned w) { return __builtin_bit_cast(float, w & 0xffff0000u); }
__device__ __forceinline__ float wave_sum(float v) {
#pragma unroll
    for (int o = 1; o < 64; o <<= 1) v += __shfl_xor(v, o);
    return v;
}
__device__ __forceinline__ float wave_max(float v) {
#pragma unroll
    for (int o = 1; o < 64; o <<= 1) v = fmaxf(v, __shfl_xor(v, o));
    return v;
}
__device__ __forceinline__ float grp16_sum(float v) { v += __shfl_xor(v, 1); v += __shfl_xor(v, 2); v += __shfl_xor(v, 4); v += __shfl_xor(v, 8); return v; }
__device__ __forceinline__ float grp8_sum(float v) { v += __shfl_xor(v, 1); v += __shfl_xor(v, 2); v += __shfl_xor(v, 4); return v; }
__device__ __forceinline__ float sum4(f32x4 a) { return (a.x + a.y) + (a.z + a.w); }
__device__ __forceinline__ float dot4(f32x4 a, f32x4 b) { return (a.x * b.x + a.y * b.y) + (a.z * b.z + a.w * b.w); }
__device__ __forceinline__ float sigm(float x) { return 1.0f / (1.0f + expf(-x)); }
__device__ __forceinline__ float softplusf(float x) { return fmaxf(x, 0.0f) + log1pf(expf(-fabsf(x))); }
__device__ __forceinline__ f32x4 shx4(f32x4 v, int m) { f32x4 r; r.x = __shfl_xor(v.x, m); r.y = __shfl_xor(v.y, m); r.z = __shfl_xor(v.z, m); r.w = __shfl_xor(v.w, m); return r; }

#define XB_TMO      128
#define XB_XCNT(j)  (256  + 64 * (j))
#define XB_XSUB(j)  (1280 + 64 * (j))
#define XB_XGEN(j)  (2304 + 64 * (j))
#define XB_TOP      3328
#define XB_TOPGEN   3392
#define XCD_BAR_WORDS 3456
#define XB_SPIN_CAP (1u << 18)

__device__ __forceinline__ unsigned xb_ld(unsigned* p)              { return __hip_atomic_load(p, __ATOMIC_RELAXED, __HIP_MEMORY_SCOPE_AGENT); }
__device__ __forceinline__ unsigned xb_add(unsigned* p, unsigned v) { return __hip_atomic_fetch_add(p, v, __ATOMIC_RELAXED, __HIP_MEMORY_SCOPE_AGENT); }
__device__ __forceinline__ unsigned xb_xcc_id() { return (unsigned)__builtin_amdgcn_s_getreg((3 << 11) | 20) & 0xFu; }
#define XB_SPIN(cond, bar) do { unsigned _sp = 0; while (cond) { __builtin_amdgcn_s_sleep(1); \
    if ((++_sp & 255u) == 0u) { if (xb_ld(&(bar)[XB_TMO])) break; if (_sp > XB_SPIN_CAP) { atomicAdd(&(bar)[XB_TMO], 1u); break; } } } } while (0)

struct XcdBarrier {
    unsigned* bar; unsigned x;
    volatile LAS unsigned* st;
};

__device__ __forceinline__ XcdBarrier xcd_barrier_post(unsigned* bar, volatile LAS unsigned* st, int xb_tid) {
    XcdBarrier b; b.bar = bar; b.x = xb_xcc_id(); b.st = st;
    if (xb_tid == 0) (void)xb_add(&bar[XB_XCNT(b.x)], 1u);
    return b;
}
__device__ __forceinline__ void xcd_barrier_complete(unsigned* bar, unsigned x, unsigned& nloc, unsigned& nx) {
    const unsigned G = gridDim.x * gridDim.y * gridDim.z;
    unsigned sum, cnt, mine, sp = 0u;
    for (;;) {
        sum = 0u; cnt = 0u; mine = 0u;
#pragma unroll
        for (unsigned j = 0; j < 16; ++j) { const unsigned c = xb_ld(&bar[XB_XCNT(j)]); sum += c; cnt += (c > 0u) ? 1u : 0u; mine = (j == x) ? c : mine; }
        if (sum == G) break;
        __builtin_amdgcn_s_sleep(1);
        if ((++sp & 255u) == 0u) { if (xb_ld(&bar[XB_TMO])) break; if (sp > XB_SPIN_CAP) { atomicAdd(&bar[XB_TMO], 1u); break; } }
    }
    nloc = mine > 0u ? mine : 1u; nx = cnt > 0u ? cnt : 1u;
}

__device__ __forceinline__ void xcd_barrier(const XcdBarrier& b, int xb_tid) {
    asm volatile("s_waitcnt vmcnt(0)" ::: "memory");
    __syncthreads();
    if (xb_tid == 0) {
        unsigned* bar = b.bar;
        __builtin_amdgcn_s_waitcnt(0);
        unsigned nloc = b.st[0], nx = b.st[1];
        if (nloc == 0u) { xcd_barrier_complete(bar, b.x, nloc, nx); b.st[0] = nloc; b.st[1] = nx; }
        const unsigned old = xb_add(&bar[XB_XSUB(b.x)], 1u);
        const unsigned gen = old / nloc;
        if (old + 1u == (gen + 1u) * nloc) {
            __builtin_amdgcn_fence(__ATOMIC_RELEASE, "agent");
            asm volatile("s_waitcnt vmcnt(0)" ::: "memory");
            const unsigned og = xb_add(&bar[XB_TOP], 1u);
            const unsigned tg = og / nx;
            if (og + 1u == (tg + 1u) * nx) xb_add(&bar[XB_TOPGEN], 1u);
            else XB_SPIN(xb_ld(&bar[XB_TOPGEN]) == tg, bar);
            __builtin_amdgcn_fence(__ATOMIC_ACQUIRE, "agent");
            xb_add(&bar[XB_XGEN(b.x)], 1u);
            asm volatile("s_waitcnt vmcnt(0)" ::: "memory");
        } else {
            XB_SPIN(xb_ld(&bar[XB_XGEN(b.x)]) == gen, bar);
            __builtin_amdgcn_fence(__ATOMIC_ACQUIRE, "agent");
            asm volatile("s_waitcnt vmcnt(0)" ::: "memory");
        }
    }
    __syncthreads();
}
struct ArgsH { const float* in[N_IN]; float* out; unsigned char* ws; double invf[44]; int ph_lo, ph_hi, li, pad; };
struct ArgsD { const GAS float* in[N_IN]; GAS float* out; GAS unsigned char* ws; double invf[44]; int ph_lo, ph_hi, li, pad; };
static_assert(sizeof(ArgsH) == sizeof(ArgsD), "args layout");
typedef const CAS ArgsD& ARef;
__device__ __forceinline__ const CAS ArgsD* kargs() {
#if defined(__HIP_DEVICE_COMPILE__)
    const CAS ArgsD* p = (const CAS ArgsD*)__builtin_amdgcn_kernarg_segment_ptr(); asm volatile("" : "+s"(p)); return p;
#else
    return nullptr;
#endif
}
struct WI { LAS unsigned char* lds; int tid, lane, wave, vcu, G, gw, NGW, bx; };
constexpr size_t RWA_STRIDE = 32 * MiB / 4;
constexpr size_t YO_STRIDE = 32 * MiB / 4;

__device__ __forceinline__ int wave_sum_i(int v) {
#pragma unroll
    for (int o = 1; o < 64; o <<= 1) v += __shfl_xor(v, o);
    return v;
}
__device__ __forceinline__ void sincos_d(double ang, float& s, float& c) {
    const double q = __builtin_rint(ang * 0.63661977236758134308);
    double r = __builtin_fma(-q, 1.57079632679489661923, ang); r = __builtin_fma(-q, 6.123233995736766e-17, r);
    const double r2 = r * r;
    const double sp = r * (1.0 + r2 * (-1.0 / 6 + r2 * (1.0 / 120 + r2 * (-1.0 / 5040 + r2 * (1.0 / 362880 + r2 * (-1.0 / 39916800 + r2 * (1.0 / 6227020800.0)))))));
    const double cp = 1.0 + r2 * (-0.5 + r2 * (1.0 / 24 + r2 * (-1.0 / 720 + r2 * (1.0 / 40320 + r2 * (-1.0 / 3628800 + r2 * (1.0 / 479001600 + r2 * (-1.0 / 87178291200.0)))))));
    const int qi = ((int)q) & 3;
    const double ss = (qi == 0) ? sp : (qi == 1) ? cp : (qi == 2) ? -sp : -cp;
    const double cc = (qi == 0) ? cp : (qi == 1) ? -sp : (qi == 2) ? -cp : sp;
    s = (float)ss; c = (float)cc;
}

__device__ __forceinline__ void tr_item(const float* W, int ldw, int nvalid, int k0, int nsrc0, bf16* WT, size_t dstrow0, LAS float* scr, int lane) {
#pragma unroll 8
    for (int i = 0; i < 32; ++i) { const int kk = 2 * i + (lane >> 5), c = lane & 31, n = nsrc0 + c; scr[kk * 33 + c] = (n < nvalid) ? W[(size_t)(k0 + kk) * ldw + n] : 0.0f; }
    LDS_WAIT(); asm volatile("" ::: "memory");
    const int c8 = lane & 7;
#pragma unroll
    for (int j = 0; j < 4; ++j) { const int n = (lane >> 3) + 8 * j; const LAS float* s = scr + (8 * c8) * 33 + n;
        v4u o; o.x = pk2(s[0 * 33], s[1 * 33]); o.y = pk2(s[2 * 33], s[3 * 33]); o.z = pk2(s[4 * 33], s[5 * 33]); o.w = pk2(s[6 * 33], s[7 * 33]);
        *(v4u*)(WT + (dstrow0 + n) * 1024 + k0 + 8 * c8) = o; }
    LDS_WAIT(); asm volatile("" ::: "memory");
}
__device__ __forceinline__ void ph_prologue(ARef A, const WI& w) {
    LAS float* sc = (LAS float*)w.lds;
    { const float* cin = A.in[I_C]; for (int i = w.tid; i < NB * DM; i += NWAVES * 64) { const float v = cin[i]; sc[i] = v / (1.0f + expf(-v)); } }
    __syncthreads();
    float* MOD = (float*)(A.ws + WS_MOD);
    if (w.wave == 0 && w.vcu < 192) {
        const int l = w.vcu / 96, col = (w.vcu % 96) * 64 + w.lane;
        const float* wp = A.in[I_ADAW] + (size_t)l * DM * 6144 + col;
        float acc[8];
#pragma unroll
        for (int b = 0; b < 8; ++b) acc[b] = 0.0f;
        for (int k = 0; k < DM; ++k) { const float wv = wp[(size_t)k * 6144];
#pragma unroll
            for (int b = 0; b < 8; ++b) acc[b] += sc[b * DM + k] * wv; }
        const float bias = A.in[I_ADAB][l * 6144 + col];
#pragma unroll
        for (int b = 0; b < 8; ++b) MOD[(size_t)(l * 8 + b) * 6144 + col] = acc[b] + bias;
    }
    LAS float* scr = (LAS float*)(w.lds + 32768 + w.wave * 8448);
    constexpr int I_IN = NLAYER * 16 * 96, I_OUT = NLAYER * 16 * 32, I_W1 = NLAYER * NEXP * 16 * 64, I_W2 = NLAYER * NEXP * 16 * 32, NIT = I_IN + I_OUT + I_W1 + I_W2;
    for (int it = w.gw; it < NIT; it += w.NGW) {
        int r = it;
        if (r < I_IN) { const int l = r / 1536, rr = r % 1536, kb = rr / 96, nb = rr % 96;
            tr_item(A.in[I_WIN] + (size_t)l * DM * INC, INC, INC, kb * 64, nb * 32, (bf16*)(A.ws + WS_WIN) + (size_t)l * INCP * DM, (size_t)nb * 32, scr, w.lane); continue; }
        r -= I_IN;
        if (r < I_OUT) { const int l = r / 512, rr = r % 512, kb = rr / 32, nb = rr % 32;
            tr_item(A.in[I_WOUT] + (size_t)l * DM * DM, DM, DM, kb * 64, nb * 32, (bf16*)(A.ws + WS_WOUT) + (size_t)l * DM * DM, (size_t)nb * 32, scr, w.lane); continue; }
        r -= I_OUT;
        if (r < I_W1) { const int le = r / 1024, rr = r % 1024, kb = rr / 64, nb = rr % 64, j = nb >> 3, bj = (nb >> 2) & 1, cc0 = (nb & 3) * 32;
            tr_item(A.in[I_MW1] + (size_t)le * DM * 2048, 2048, 2048, kb * 64, bj * 1024 + 128 * j + cc0, (bf16*)(A.ws + WS_W1) + (size_t)le * 2048 * DM, (size_t)nb * 32, scr, w.lane); continue; }
        r -= I_W1;
        { const int le = r / 512, rr = r % 512, kb = rr / 32, nb = rr % 32;
            tr_item(A.in[I_MW2] + (size_t)le * DM * DM, DM, DM, kb * 64, nb * 32, (bf16*)(A.ws + WS_W2) + (size_t)le * DM * DM, (size_t)nb * 32, scr, w.lane); }
    }
    float* RT = (float*)(A.ws + WS_ROPE); const int* pos = (const int*)A.in[I_POS];
    for (int g = w.gw * 64 + w.lane; g < MTOK * 44; g += w.NGW * 64) {
        const int tok = g / 44, f = g % 44; int co, so;
        if (f < 32) { co = f; so = 32 + f; } else if (f < 40) { co = 64 + (f - 32); so = 72 + (f - 32); } else { co = 80 + (f - 40); so = 84 + (f - 40); }
        float s, c; sincos_d((double)pos[tok] * A.invf[f], s, c);
        RT[(size_t)tok * ROPE_W + co] = c; RT[(size_t)tok * ROPE_W + so] = s;
    }
}

__device__ __forceinline__ void emit_h_row(const f32x4 (&v)[4], float rstd, const float* g, const float* sc, const float* sh, bf16* hrow, int lane) {
#pragma unroll
    for (int j = 0; j < 4; ++j) { const int k = 4 * (lane + 64 * j);
        const f32x4 gv = *(const f32x4*)(g + k), scv = *(const f32x4*)(sc + k), shv = *(const f32x4*)(sh + k);
        const f32x4 h = v[j] * rstd * gv * (1.0f + scv) + shv;
        v2u o; o.x = pk2(h.x, h.y); o.y = pk2(h.z, h.w); *(v2u*)(hrow + k) = o; }
}
__device__ __forceinline__ void ph_norm1(ARef A, const WI& w) {
    const float* MOD = (const float*)(A.ws + WS_MOD); bf16* H = (bf16*)(A.ws + WS_H);
    for (int m = w.gw; m < MTOK; m += w.NGW) {
        const float* xr = A.in[I_X] + (size_t)m * DM; f32x4 v[4]; float ss = 0.0f;
#pragma unroll
        for (int j = 0; j < 4; ++j) { v[j] = *(const f32x4*)(xr + 4 * (w.lane + 64 * j)); ss += dot4(v[j], v[j]); }
        ss = wave_sum(ss); const float rstd = 1.0f / sqrtf(ss * (1.0f / DM) + 1e-5f);
        const float* mb = MOD + (size_t)(m >> 12) * 6144;
        emit_h_row(v, rstd, A.in[I_NMIX], mb + 1024, mb, H + (size_t)m * DM, w.lane);
    }
}

__device__ __forceinline__ void rwkv_prep(ARef A, int l, int m, int lane) {
    const float* P = (const float*)(A.ws + WS_P); float* RWA = (float*)(A.ws + WS_RWA);
    const int t = m & (SEQ - 1), c4 = 4 * lane;
    const float* pr = P + (size_t)m * INCP + C_RW; const float* pp = pr - INCP; const float* mu = A.in[I_MU] + l * 896;
    f32x4 fr, fk, fv;
    { const f32x4 z = *(const f32x4*)(pr + c4), mm = *(const f32x4*)(mu + c4); f32x4 p = {0.f, 0.f, 0.f, 0.f}; if (t) p = *(const f32x4*)(pp + c4); fr = z + (p - z) * mm; }
    { const f32x4 z = *(const f32x4*)(pr + 256 + c4), mm = *(const f32x4*)(mu + 256 + c4); f32x4 p = {0.f, 0.f, 0.f, 0.f}; if (t) p = *(const f32x4*)(pp + 256 + c4); fk = z + (p - z) * mm; }
    { const f32x4 z = *(const f32x4*)(pr + 512 + c4), mm = *(const f32x4*)(mu + 512 + c4); f32x4 p = {0.f, 0.f, 0.f, 0.f}; if (t) p = *(const f32x4*)(pp + 512 + c4); fv = z + (p - z) * mm; }
    float x0, x1;
    { const float z = pr[768 + lane], p = t ? pp[768 + lane] : 0.0f; x0 = z + (p - z) * mu[768 + lane]; }
    { const float z = pr[832 + lane], p = t ? pp[832 + lane] : 0.0f; x1 = z + (p - z) * mu[832 + lane]; }
    x0 = (lane < 32) ? tanhf(x0) : x0; x1 = sigm(x1);
    f32x4 wacc = *(const f32x4*)(A.in[I_W0] + l * 256 + c4), aacc = *(const f32x4*)(A.in[I_A0] + l * 256 + c4), gacc = {0.f, 0.f, 0.f, 0.f};
    const float* w2 = A.in[I_W2] + l * 32 * 256 + c4; const float* a2 = A.in[I_A2] + l * 32 * 256 + c4; const float* g2 = A.in[I_G2] + l * 64 * 256 + c4;
#pragma unroll 8
    for (int i = 0; i < 32; ++i) { const float s = __shfl(x0, i); wacc += s * *(const f32x4*)(w2 + i * 256); }
#pragma unroll 8
    for (int i = 0; i < 32; ++i) { const float s = __shfl(x0, 32 + i); aacc += s * *(const f32x4*)(a2 + i * 256); }
#pragma unroll 8
    for (int i = 0; i < 64; ++i) { const float s = __shfl(x1, i); gacc += s * *(const f32x4*)(g2 + i * 256); }
    f32x4 dec, av;
#pragma unroll
    for (int i = 0; i < 4; ++i) { const float wl = -softplusf(-wacc[i]) - 0.5f; dec[i] = expf(-expf(wl)); av[i] = sigm(aacc[i]); }
    f32x4 kk = fk * *(const f32x4*)(A.in[I_KK] + l * 256 + c4);
    const float nrm = fmaxf(sqrtf(grp16_sum(dot4(kk, kk))), 1e-12f); kk = kk / nrm;
    const f32x4 kmod = fk * (1.0f + (av - 1.0f) * *(const f32x4*)(A.in[I_KA] + l * 256 + c4));
    const f32x4 bb = kk * av;
    const float bs = grp16_sum(dot4(fr * kmod, *(const f32x4*)(A.in[I_RK] + l * 256 + c4)));
    const size_t o = (size_t)m * 256 + c4;
    *(f32x4*)(RWA + 0 * RWA_STRIDE + o) = fr; *(f32x4*)(RWA + 1 * RWA_STRIDE + o) = dec; *(f32x4*)(RWA + 2 * RWA_STRIDE + o) = kmod; *(f32x4*)(RWA + 3 * RWA_STRIDE + o) = fv;
    *(f32x4*)(RWA + 4 * RWA_STRIDE + o) = -kk; *(f32x4*)(RWA + 5 * RWA_STRIDE + o) = bb; *(f32x4*)(RWA + 6 * RWA_STRIDE + o) = gacc; *(f32x4*)(RWA + 7 * RWA_STRIDE + o) = bs * fv;
}
__device__ __forceinline__ void dsa_prep(ARef A, int l, int m, int lane) {
    const float* P = (const float*)(A.ws + WS_P); const float* RT = (const float*)(A.ws + WS_ROPE) + (size_t)m * ROPE_W;
    const float* pd = P + (size_t)m * INCP + C_DSA; const int c4 = 4 * lane;
    float c0 = pd[lane], c1 = pd[64 + lane];
    const float rstd = 1.0f / sqrtf(wave_sum(c0 * c0 + c1 * c1) * (1.0f / 128.0f) + 1e-5f);
    c0 *= rstd * A.in[I_QNORM][l * 128 + lane]; c1 *= rstd * A.in[I_QNORM][l * 128 + 64 + lane];
    f32x4 q = {0.f, 0.f, 0.f, 0.f}, qi = {0.f, 0.f, 0.f, 0.f};
    const float* wq = A.in[I_WQ] + (size_t)l * 128 * 256 + c4; const float* wqi = A.in[I_WQI] + (size_t)l * 128 * 256 + c4;
#pragma unroll 8
    for (int i = 0; i < 64; ++i) { const float s = __shfl(c0, i); q += s * *(const f32x4*)(wq + i * 256); qi += s * *(const f32x4*)(wqi + i * 256); }
#pragma unroll 8
    for (int i = 0; i < 64; ++i) { const float s = __shfl(c1, i); q += s * *(const f32x4*)(wq + (64 + i) * 256); qi += s * *(const f32x4*)(wqi + (64 + i) * 256); }
    { const int r = lane & 15; const f32x4 ot = shx4(q, 2);
      if (r < 4) { const int fi = 4 * (r & 1); const f32x4 cs = *(const f32x4*)(RT + 64 + fi), sn = *(const f32x4*)(RT + 72 + fi); q = (r < 2) ? q * cs - ot * sn : ot * sn + q * cs; } }
    { const int r = lane & 7; const f32x4 ot = shx4(qi, 1);
      if (r < 2) { const f32x4 cs = *(const f32x4*)(RT + 80), sn = *(const f32x4*)(RT + 84); qi = (r < 1) ? qi * cs - ot * sn : ot * sn + qi * cs; } }
    { const f32x4 qs = q * 0.18033688011112042f; v2u o; o.x = pk2(qs.x, qs.y); o.y = pk2(qs.z, qs.w); *(v2u*)((bf16*)(A.ws + WS_DQ) + (size_t)m * 256 + c4) = o; }
    { typedef _Float16 h4 __attribute__((ext_vector_type(4))); h4 hq; hq.x = (_Float16)qi.x; hq.y = (_Float16)qi.y; hq.z = (_Float16)qi.z; hq.w = (_Float16)qi.w; *(h4*)((_Float16*)(A.ws + WS_DQI) + (size_t)m * 256 + c4) = hq; }
    { const int r = lane & 15; f32x4 kx = *(const f32x4*)(pd + 128 + 4 * r); const f32x4 ot = shx4(kx, 2);
      if (r < 4) { const int fi = 4 * (r & 1); const f32x4 cs = *(const f32x4*)(RT + 64 + fi), sn = *(const f32x4*)(RT + 72 + fi); kx = (r < 2) ? kx * cs - ot * sn : ot * sn + kx * cs; }
      if (lane < 16) { v2u o; o.x = pk2(kx.x, kx.y); o.y = pk2(kx.z, kx.w); *(v2u*)((bf16*)(A.ws + WS_DKB) + (size_t)m * 64 + c4) = o;
                       const f32x4 vx = *(const f32x4*)(pd + 192 + c4); v2u ov; ov.x = pk2(vx.x, vx.y); ov.y = pk2(vx.z, vx.w); *(v2u*)((bf16*)(A.ws + WS_DVB) + (size_t)m * 64 + c4) = ov; } }
    { const int r = lane & 7; f32x4 ki = *(const f32x4*)(pd + 256 + 4 * r); const f32x4 ot = shx4(ki, 1);
      if (r < 2) { const f32x4 cs = *(const f32x4*)(RT + 80), sn = *(const f32x4*)(RT + 84); ki = (r < 1) ? ki * cs - ot * sn : ot * sn + ki * cs; }
      if (lane < 8) { typedef _Float16 h4 __attribute__((ext_vector_type(4))); h4 hk; hk.x = (_Float16)ki.x; hk.y = (_Float16)ki.y; hk.z = (_Float16)ki.z; hk.w = (_Float16)ki.w; *(h4*)((_Float16*)(A.ws + WS_DKI) + (size_t)m * 32 + c4) = hk; }
      if (lane < 2) *(f32x4*)((float*)(A.ws + WS_DW) + (size_t)m * 8 + c4) = *(const f32x4*)(pd + 288 + c4) * 0.0625f; }
}

__device__ __forceinline__ void sb_prep(ARef A, int m, int lane) {
    const float* ps = (const float*)(A.ws + WS_P) + (size_t)m * INCP + C_SB + 4 * lane;
    const f32x4 q = *(const f32x4*)ps * 0.18033688011112042f, k = *(const f32x4*)(ps + 256), v = *(const f32x4*)(ps + 512);
    v2u o; o.x = pk2(q.x, q.y); o.y = pk2(q.z, q.w); *(v2u*)((bf16*)(A.ws + WS_SQ) + (size_t)m * 256 + 4 * lane) = o;
    o.x = pk2(k.x, k.y); o.y = pk2(k.z, k.w); *(v2u*)((bf16*)(A.ws + WS_SK) + (size_t)m * 256 + 4 * lane) = o;
    o.x = pk2(v.x, v.y); o.y = pk2(v.z, v.w); *(v2u*)((bf16*)(A.ws + WS_SV) + (size_t)m * 256 + 4 * lane) = o;
}

__device__ __forceinline__ float quad_sum(float v) {
    v += __builtin_bit_cast(float, __builtin_amdgcn_mov_dpp(__builtin_bit_cast(int, v), 0xB1, 0xF, 0xF, true));
    v += __builtin_bit_cast(float, __builtin_amdgcn_mov_dpp(__builtin_bit_cast(int, v), 0x4E, 0xF, 0xF, true));
    return v;
}
__device__ __forceinline__ void scan_rwkv_task(ARef A, const WI& w, int task) {
    const int bh = task >> 4, c = task & 15, b = bh >> 2, h = bh & 3;
    LAS float* sw = (LAS float*)w.lds; LAS float* sn = sw + 2048; LAS float* sb = sn + 2048; LAS float* sk = sb + 2048; LAS float* sr = sk + 2048; LAS float* sv = sr + 2048; LAS float* so = sv + 2048;
    const float* RWA = (const float*)(A.ws + WS_RWA);
    const int row = w.tid >> 2, kq = w.tid & 3;
    float S[16];
#pragma unroll
    for (int j = 0; j < 16; ++j) S[j] = (row >= 64 && 16 * kq + j == row - 64) ? 1.0f : 0.0f;
    const size_t tok0 = (size_t)b * SEQ + (size_t)c * TCH;
    const int st = w.tid >> 4, sd = (w.tid & 15) * 4;
    for (int sub = 0; sub < TCH / 32; ++sub) {
        const size_t o = (tok0 + sub * 32 + st) * 256 + h * 64 + sd;
        const f32x4 a0 = *(const f32x4*)(RWA + 1 * RWA_STRIDE + o), a1 = *(const f32x4*)(RWA + 4 * RWA_STRIDE + o), a2 = *(const f32x4*)(RWA + 5 * RWA_STRIDE + o);
        const f32x4 a3 = *(const f32x4*)(RWA + 2 * RWA_STRIDE + o), a4 = *(const f32x4*)(RWA + 0 * RWA_STRIDE + o), a5 = *(const f32x4*)(RWA + 3 * RWA_STRIDE + o);
        __syncthreads();
        { const int lo = st * 64 + sd; *(LAS f32x4*)(sw + lo) = a0; *(LAS f32x4*)(sn + lo) = a1; *(LAS f32x4*)(sb + lo) = a2; *(LAS f32x4*)(sk + lo) = a3; *(LAS f32x4*)(sr + lo) = a4; *(LAS f32x4*)(sv + lo) = a5; }
        __syncthreads();
        for (int s = 0; s < 32; ++s) {
            const int lo = s * 64 + kq * 16;
            const float vv = (row < 64) ? sv[s * 64 + row] : 0.0f;
            float sa = 0.0f;
#pragma unroll
            for (int j4 = 0; j4 < 4; ++j4) { const f32x4 n = *(const LAS f32x4*)(sn + lo + 4 * j4); sa += (S[4 * j4] * n.x + S[4 * j4 + 1] * n.y) + (S[4 * j4 + 2] * n.z + S[4 * j4 + 3] * n.w); }
            sa = quad_sum(sa);
            float y = 0.0f;
#pragma unroll
            for (int j4 = 0; j4 < 4; ++j4) { const f32x4 wv = *(const LAS f32x4*)(sw + lo + 4 * j4), bv = *(const LAS f32x4*)(sb + lo + 4 * j4), kv = *(const LAS f32x4*)(sk + lo + 4 * j4), rv = *(const LAS f32x4*)(sr + lo + 4 * j4);
                S[4 * j4] = S[4 * j4] * wv.x + (sa * bv.x + vv * kv.x); S[4 * j4 + 1] = S[4 * j4 + 1] * wv.y + (sa * bv.y + vv * kv.y);
                S[4 * j4 + 2] = S[4 * j4 + 2] * wv.z + (sa * bv.z + vv * kv.z); S[4 * j4 + 3] = S[4 * j4 + 3] * wv.w + (sa * bv.w + vv * kv.w);
                y += (S[4 * j4] * rv.x + S[4 * j4 + 1] * rv.y) + (S[4 * j4 + 2] * rv.z + S[4 * j4 + 3] * rv.w); }
            y = quad_sum(y);
            if (kq == 0) so[s * 128 + row] = y;
        }
        __syncthreads();
        { const int fs = w.tid >> 4, c8 = (w.tid & 15) * 8; const f32x4 x0 = *(const LAS f32x4*)(so + fs * 128 + c8), x1 = *(const LAS f32x4*)(so + fs * 128 + c8 + 4);
          float* dst = (c8 < 64) ? ((float*)(A.ws + WS_YO) + YO_STRIDE) : ((float*)(A.ws + WS_PT) - 64);
          float* dp = dst + (tok0 + sub * 32 + fs) * 256 + h * 64 + c8; *(f32x4*)dp = x0; *(f32x4*)(dp + 4) = x1; }
    }
    { float* ch = (float*)(A.ws + WS_CH) + ((size_t)(bh * NCH + c) * 128 + row) * 64 + 16 * kq;
#pragma unroll
      for (int j4 = 0; j4 < 4; ++j4) *(f32x4*)(ch + 4 * j4) = (f32x4){S[4 * j4], S[4 * j4 + 1], S[4 * j4 + 2], S[4 * j4 + 3]}; }
    __syncthreads();
}
__device__ __forceinline__ void scan_ret_task(ARef A, const WI& w, int task) {
    const int bh = task >> 3, cp = task & 7, b = bh >> 2, h = bh & 3, un = w.tid >> 8, lt = w.tid & 255, c = 2 * cp + un;
    const float lg2g = log2f(1.0f - exp2f(-5.0f - (float)h)), gamma = exp2f(lg2g);
    LAS float* sk = (LAS float*)w.lds + un * 8192; LAS float* sq = sk + 2048; LAS float* sv = sq + 2048; LAS float* so = sv + 2048;
    const float* P = (const float*)(A.ws + WS_P); const float* RT = (const float*)(A.ws + WS_ROPE);
    const int row = lt >> 2, kq = lt & 3;
    float S[16];
#pragma unroll
    for (int j = 0; j < 16; ++j) S[j] = 0.0f;
    const size_t tok0 = (size_t)b * SEQ + (size_t)c * TCH;
    const int st = lt >> 3, sd = (lt & 7) * 8;
    for (int sub = 0; sub < TCH / 32; ++sub) {
        const size_t m = tok0 + sub * 32 + st; const float* pr = P + m * INCP + C_RET + h * 64; const float* rt = RT + m * ROPE_W; const int fi = sd & 31, dp = sd ^ 32;
        f32x4 qn[2], kn[2], vn[2];
#pragma unroll
        for (int u = 0; u < 2; ++u) { const f32x4 cs = *(const f32x4*)(rt + fi + 4 * u), sn = *(const f32x4*)(rt + 32 + fi + 4 * u);
            const f32x4 qm = *(const f32x4*)(pr + sd + 4 * u), qo = *(const f32x4*)(pr + dp + 4 * u), km = *(const f32x4*)(pr + 256 + sd + 4 * u), ko = *(const f32x4*)(pr + 256 + dp + 4 * u);
            qn[u] = (sd < 32) ? qm * cs - qo * sn : qo * sn + qm * cs; kn[u] = ((sd < 32) ? km * cs - ko * sn : ko * sn + km * cs) * 0.125f; vn[u] = *(const f32x4*)(pr + 512 + sd + 4 * u); }
        { const float gt = exp2f(lg2g * (float)(sub * 32 + st + 1)); const f32x4 p0 = qn[0] * gt, p1 = qn[1] * gt;
          v4u pw; pw.x = pk2(p0.x, p0.y); pw.y = pk2(p0.z, p0.w); pw.z = pk2(p1.x, p1.y); pw.w = pk2(p1.z, p1.w); *(v4u*)((bf16*)(A.ws + WS_PTR) + m * 256 + h * 64 + sd) = pw; }
        __syncthreads();
        { const int lo = st * 64 + sd; *(LAS f32x4*)(sq + lo) = qn[0]; *(LAS f32x4*)(sq + lo + 4) = qn[1]; *(LAS f32x4*)(sk + lo) = kn[0]; *(LAS f32x4*)(sk + lo + 4) = kn[1]; *(LAS f32x4*)(sv + lo) = vn[0]; *(LAS f32x4*)(sv + lo + 4) = vn[1]; }
        __syncthreads();
        for (int s = 0; s < 32; ++s) {
            const int lo = s * 64 + kq * 16; const float vv = sv[s * 64 + row]; float y = 0.0f;
#pragma unroll
            for (int j4 = 0; j4 < 4; ++j4) { const f32x4 kv = *(const LAS f32x4*)(sk + lo + 4 * j4), rv = *(const LAS f32x4*)(sq + lo + 4 * j4);
                S[4 * j4] = S[4 * j4] * gamma + vv * kv.x; S[4 * j4 + 1] = S[4 * j4 + 1] * gamma + vv * kv.y; S[4 * j4 + 2] = S[4 * j4 + 2] * gamma + vv * kv.z; S[4 * j4 + 3] = S[4 * j4 + 3] * gamma + vv * kv.w;
                y += (S[4 * j4] * rv.x + S[4 * j4 + 1] * rv.y) + (S[4 * j4 + 2] * rv.z + S[4 * j4 + 3] * rv.w); }
            y = quad_sum(y);
            if (kq == 0) so[s * 64 + row] = y;
        }
        __syncthreads();
        { const int fs = lt >> 3, c8 = (lt & 7) * 8; float* dp2 = (float*)(A.ws + WS_YO) + (tok0 + sub * 32 + fs) * 256 + h * 64 + c8;
          *(f32x4*)dp2 = *(const LAS f32x4*)(so + fs * 64 + c8); *(f32x4*)(dp2 + 4) = *(const LAS f32x4*)(so + fs * 64 + c8 + 4); }
    }
    { float* ch = (float*)(A.ws + WS_CHR) + ((size_t)(bh * NCH + c) * 64 + row) * 64 + 16 * kq;
#pragma unroll
      for (int j4 = 0; j4 < 4; ++j4) *(f32x4*)(ch + 4 * j4) = (f32x4){S[4 * j4], S[4 * j4 + 1], S[4 * j4 + 2], S[4 * j4 + 3]}; }
    __syncthreads();
}
__device__ __forceinline__ void prefix_chain(ARef A, const WI& w, int bh) {
    LAS float* s0 = (LAS float*)w.lds;
    const int v = w.tid >> 3, k8 = (w.tid & 7) * 8;
    const float* CH = (const float*)(A.ws + WS_CH) + (size_t)bh * NCH * 128 * 64; float* SI = (float*)(A.ws + WS_SI) + (size_t)bh * NCH * 64 * 64;
    f32x4 c0 = {0.f, 0.f, 0.f, 0.f}, c1 = {0.f, 0.f, 0.f, 0.f};
    for (int c = 0; c < NCH; ++c) {
        *(f32x4*)(SI + ((size_t)c * 64 + v) * 64 + k8) = c0; *(f32x4*)(SI + ((size_t)c * 64 + v) * 64 + k8 + 4) = c1;
        if (c == NCH - 1) break;
        __syncthreads();
        *(LAS f32x4*)(s0 + v * 68 + k8) = c0; *(LAS f32x4*)(s0 + v * 68 + k8 + 4) = c1;
        __syncthreads();
        const float* ch = CH + (size_t)c * 128 * 64;
        f32x4 n0 = *(const f32x4*)(ch + (size_t)v * 64 + k8), n1 = *(const f32x4*)(ch + (size_t)v * 64 + k8 + 4);
#pragma unroll 8
        for (int kp = 0; kp < 64; ++kp) { const float s = s0[v * 68 + kp]; const float* pr = ch + (size_t)(64 + kp) * 64 + k8; n0 += s * *(const f32x4*)pr; n1 += s * *(const f32x4*)(pr + 4); }
        c0 = n0; c1 = n1;
    }
    const int h = bh & 3; const float gT = exp2f((float)TCH * log2f(1.0f - exp2f(-5.0f - (float)h)));
    const float* CHR = (const float*)(A.ws + WS_CHR) + (size_t)bh * NCH * 64 * 64; float* SIR = (float*)(A.ws + WS_SIR) + (size_t)bh * NCH * 64 * 64;
    c0 = (f32x4){0.f, 0.f, 0.f, 0.f}; c1 = c0;
    for (int c = 0; c < NCH; ++c) {
        *(f32x4*)(SIR + ((size_t)c * 64 + v) * 64 + k8) = c0; *(f32x4*)(SIR + ((size_t)c * 64 + v) * 64 + k8 + 4) = c1;
        if (c == NCH - 1) break;
        c0 = c0 * gT + *(const f32x4*)(CHR + ((size_t)c * 64 + v) * 64 + k8); c1 = c1 * gT + *(const f32x4*)(CHR + ((size_t)c * 64 + v) * 64 + k8 + 4);
    }
    __syncthreads();
}
typedef float f32x16 __attribute__((ext_vector_type(16)));
constexpr int SBV_PITCH = 144;
__device__ __forceinline__ float lane32_swap(float v) { return __shfl_xor(v, 32); }
__device__ __forceinline__ void sb_tile_mfma(ARef A, int unit, int lane, LAS unsigned char* vl) {
    const int tq = unit & 127, bh = unit >> 7, b = bh >> 2, h = bh & 3, t0 = tq * 32, r32 = lane & 31, hi = lane >> 5;
    const float* PS = (const float*)(A.ws + WS_P) + (size_t)b * SEQ * INCP + C_SB + h * 64;
    bf16x8v qf[4];
#pragma unroll
    for (int ks = 0; ks < 4; ++ks) { const float* qp = PS + (size_t)(t0 + r32) * INCP + 16 * ks + 8 * hi; const f32x4 x = *(const f32x4*)qp * 0.18033688011112042f, y = *(const f32x4*)(qp + 4) * 0.18033688011112042f;
        pg8::u32x4 wv; wv.x = pk2(x.x, x.y); wv.y = pk2(x.z, x.w); wv.z = pk2(y.x, y.y); wv.w = pk2(y.z, y.w); qf[ks] = __builtin_bit_cast(bf16x8v, wv); }
    f32x16 o0, o1;
#pragma unroll
    for (int r = 0; r < 16; ++r) { o0[r] = 0.0f; o1[r] = 0.0f; }
    float carry = 0.0f;
    const int g16 = lane >> 4, tj = (lane & 15) >> 2, tc = lane & 3;
    for (int kb0 = t0; kb0 >= 0; kb0 -= 32) {
#pragma unroll
        for (int i = 0; i < 4; ++i) { const int p = lane + 64 * i, row = p >> 3, ch = p & 7; const float* vp = PS + 512 + (size_t)(kb0 + row) * INCP + 8 * ch; const f32x4 x = *(const f32x4*)vp, y = *(const f32x4*)(vp + 4);
            v4u v; v.x = pk2(x.x, x.y); v.y = pk2(x.z, x.w); v.z = pk2(y.x, y.y); v.w = pk2(y.z, y.w); *(LAS v4u*)(vl + row * SBV_PITCH + 16 * ch) = v; }
        f32x16 st;
#pragma unroll
        for (int r = 0; r < 16; ++r) st[r] = 0.0f;
#pragma unroll
        for (int ks = 0; ks < 4; ++ks) { const float* kp = PS + 256 + (size_t)(kb0 + r32) * INCP + 16 * ks + 8 * hi; const f32x4 x = *(const f32x4*)kp, y = *(const f32x4*)(kp + 4);
            pg8::u32x4 wv; wv.x = pk2(x.x, x.y); wv.y = pk2(x.z, x.w); wv.z = pk2(y.x, y.y); wv.w = pk2(y.z, y.w); st = __builtin_amdgcn_mfma_f32_32x32x16_bf16(__builtin_bit_cast(bf16x8v, wv), qf[ks], st, 0, 0, 0); }
        float sp[16]; const bool diag = (kb0 == t0);
#pragma unroll
        for (int r = 0; r < 16; ++r) { const float zl = st[r]; float s = (zl > 30.0f) ? zl : __builtin_amdgcn_logf(1.0f + __builtin_amdgcn_exp2f(zl));
            if (diag && ((r & 3) + 8 * (r >> 2) + 4 * hi >= r32)) s = 0.0f;
            sp[r] = s; }
        float G[4], Gp[4], suf[4];
#pragma unroll
        for (int q = 0; q < 4; ++q) { G[q] = (sp[4 * q] + sp[4 * q + 1]) + (sp[4 * q + 2] + sp[4 * q + 3]); Gp[q] = lane32_swap(G[q]); }
        suf[3] = 0.0f; suf[2] = G[3] + Gp[3]; suf[1] = suf[2] + (G[2] + Gp[2]); suf[0] = suf[1] + (G[1] + Gp[1]);
        const float tot = suf[0] + (G[0] + Gp[0]);
        pg8::u32x4 pw0, pw1;
        float av[16];
#pragma unroll
        for (int q = 0; q < 4; ++q) { float run = carry + suf[q] + (hi == 0 ? Gp[q] : 0.0f);
#pragma unroll
            for (int i = 3; i >= 0; --i) { const int r = 4 * q + i; const float la = (st[r] - sp[r]) - run; float a = __builtin_amdgcn_exp2f(la);
                if (diag && ((r & 3) + 8 * (r >> 2) + 4 * hi >= r32)) a = 0.0f;
                av[r] = a; run += sp[r]; } }
        pw0.x = pg8::cvt_pk_bf16(av[0], av[1]); pw0.y = pg8::cvt_pk_bf16(av[2], av[3]); pw0.z = pg8::cvt_pk_bf16(av[4], av[5]); pw0.w = pg8::cvt_pk_bf16(av[6], av[7]);
        pw1.x = pg8::cvt_pk_bf16(av[8], av[9]); pw1.y = pg8::cvt_pk_bf16(av[10], av[11]); pw1.z = pg8::cvt_pk_bf16(av[12], av[13]); pw1.w = pg8::cvt_pk_bf16(av[14], av[15]);
        const bf16x8v pa0 = __builtin_bit_cast(bf16x8v, pw0), pa1 = __builtin_bit_cast(bf16x8v, pw1);
        LDS_WAIT();
#pragma unroll
        for (int s = 0; s < 2; ++s)
#pragma unroll
            for (int nb = 0; nb < 2; ++nb) {
                LAS unsigned char* a1 = vl + (16 * s + 4 * (g16 >> 1) + tj) * SBV_PITCH + (32 * nb + 16 * (g16 & 1) + 4 * tc) * 2;
                const s16x4v r1 = __builtin_bit_cast(s16x4v, __builtin_amdgcn_ds_read_tr16_b64_v4i16((LAS s16x4v*)a1));
                const s16x4v r2 = __builtin_bit_cast(s16x4v, __builtin_amdgcn_ds_read_tr16_b64_v4i16((LAS s16x4v*)(a1 + 8 * SBV_PITCH)));
                const bf16x8v bv = {r1[0], r1[1], r1[2], r1[3], r2[0], r2[1], r2[2], r2[3]};
                if (nb == 0) o0 = __builtin_amdgcn_mfma_f32_32x32x16_bf16(s ? pa1 : pa0, bv, o0, 0, 0, 0); else o1 = __builtin_amdgcn_mfma_f32_32x32x16_bf16(s ? pa1 : pa0, bv, o1, 0, 0, 0); }
        LDS_WAIT();
        carry += tot;
        if (__all(carry > 150.0f)) break;
    }
    float* YS = (float*)(A.ws + WS_YO) + 3 * YO_STRIDE + ((size_t)b * SEQ + t0) * 256 + h * 64 + r32;
#pragma unroll
    for (int r = 0; r < 16; ++r) { const int qo = (r & 3) + 8 * (r >> 2) + 4 * hi; YS[(size_t)qo * 256] = o0[r]; YS[(size_t)qo * 256 + 32] = o1[r]; }
}

typedef _Float16 f16x8 __attribute__((ext_vector_type(8)));
__device__ __forceinline__ void dsa_scores_mfma(ARef A, const WI& w) {
    const _Float16* QIH = (const _Float16*)(A.ws + WS_DQI); const _Float16* KIH = (const _Float16*)(A.ws + WS_DKI);
    const float* DW = (const float*)(A.ws + WS_DW); float* SC = (float*)(A.ws + WS_SC);
    const int col = w.lane & 15, q4 = w.lane >> 4;
    for (int u = w.gw; u < 2048; u += w.NGW) {
        const int pi = u >> 1, par = u & 1, b = pi >> 7, p = pi & 127;
#pragma unroll 1
        for (int side = 0; side < 2; ++side) {
            const int qb = side ? 255 - p : p; const size_t m0 = (size_t)b * SEQ + 16 * qb;
            f16x8 bq[8];
#pragma unroll
            for (int h = 0; h < 8; ++h) bq[h] = *(const f16x8*)(QIH + (m0 + col) * 256 + h * 32 + 8 * q4);
            const float* dw = DW + (m0 + col) * 8; const f32x4 wa = *(const f32x4*)dw, wb = *(const f32x4*)(dw + 4);
            float* srow = SC + (m0 + col) * SEQ + 4 * q4;
            const _Float16* kbase = KIH + ((size_t)b * SEQ + col) * 32 + 8 * q4;
            for (int kb = par; kb <= qb; kb += 2) {
                const f16x8 ak = *(const f16x8*)(kbase + (size_t)kb * 16 * 32);
                f32x4 acc = {0.f, 0.f, 0.f, 0.f};
#pragma unroll
                for (int h = 0; h < 8; ++h) { const f32x4 c = __builtin_amdgcn_mfma_f32_16x16x32_f16(ak, bq[h], (f32x4){0.f, 0.f, 0.f, 0.f}, 0, 0, 0); const float wv = (h < 4) ? wa[h] : wb[h - 4];
                    acc.x += wv * fmaxf(c.x, 0.f); acc.y += wv * fmaxf(c.y, 0.f); acc.z += wv * fmaxf(c.z, 0.f); acc.w += wv * fmaxf(c.w, 0.f); }
                *(f32x4*)(srow + 16 * kb) = acc + 0.0f;
            }
        }
    }
}

__device__ __forceinline__ unsigned score_key(float f) { const unsigned bits = __float_as_uint(f); return (bits & 0x80000000u) ? ~bits : (bits | 0x80000000u); }
constexpr int VST_PITCH = 144;
__device__ __forceinline__ void dsa_row_mfma(ARef A, int m, int lane, LAS unsigned char* wl) {
    LAS int* slist = (LAS int*)wl;
    LAS unsigned char* vst = wl + 1024;
    const int b = m >> 12, t = m & (SEQ - 1), n = t + 1, col = lane & 15, q4 = lane >> 4;
    const float* sc = (const float*)(A.ws + WS_SC) + (size_t)m * SEQ;
    int nsel;
    if (n <= 256) {
#pragma unroll
        for (int c = 0; c < 4; ++c) { const int idx = lane + 64 * c; slist[idx] = (idx < n) ? idx : 0; }
        nsel = n;
    } else {
        unsigned u[64];
#pragma unroll
        for (int j4 = 0; j4 < 16; ++j4) { f32x4 v = {0.f, 0.f, 0.f, 0.f}; if (256 * j4 < n) v = *(const f32x4*)(sc + 256 * j4 + 4 * lane);
#pragma unroll
            for (int i = 0; i < 4; ++i) u[4 * j4 + i] = (256 * j4 + 4 * lane + i < n) ? score_key(v[i]) : 0u; }
        unsigned T = 0u;
        for (int bit = 31; bit >= 0; --bit) { const unsigned cand = T | (1u << bit); int cnt = 0;
#pragma unroll
            for (int j = 0; j < 64; ++j) cnt += (u[j] >= cand) ? 1 : 0;
            if (wave_sum_i(cnt) >= 256) T = cand; }
        unsigned long long gtb = 0ull, eqb = 0ull;
#pragma unroll
        for (int j = 0; j < 64; ++j) { gtb |= (unsigned long long)((u[j] > T) ? 1u : 0u) << j; eqb |= (unsigned long long)((u[j] == T) ? 1u : 0u) << j; }
        const int tgt = wave_sum_i(__popcll(gtb)), teq = wave_sum_i(__popcll(eqb));
        unsigned long long selb = gtb | eqb;
        if (tgt + teq > 256) {
            const int take = 256 - tgt; int lo = 0;
            for (int bit = 11; bit >= 0; --bit) { const int cand = lo | (1 << bit); const int J4 = cand >> 8; int ni = (cand & 255) - 4 * lane; ni = ni < 0 ? 0 : (ni > 4 ? 4 : ni);
                const int jc = 4 * J4 + ni; const unsigned long long msk = (jc >= 64) ? ~0ull : ((1ull << jc) - 1ull);
                if (wave_sum_i(__popcll(eqb & msk)) < take) lo = cand; }
            { const int cand = lo + 1; const int J4 = cand >> 8; int ni = (cand & 255) - 4 * lane; ni = ni < 0 ? 0 : (ni > 4 ? 4 : ni);
              const int jc = (cand >= SEQ) ? 64 : 4 * J4 + ni; const unsigned long long msk = (jc >= 64) ? ~0ull : ((1ull << jc) - 1ull); selb = gtb | (eqb & msk); }
        }
        const int mine = __popcll(selb); int off = mine;
#pragma unroll
        for (int d = 1; d < 64; d <<= 1) { const int y = __shfl_up(off, d); if (lane >= d) off += y; }
        off -= mine;
        while (selb) { const int j = __builtin_ctzll(selb); selb &= selb - 1ull; slist[off] = 256 * (j >> 2) + 4 * lane + (j & 3); ++off; }
        nsel = 256;
    }
    LDS_WAIT();
    const bf16* DKB = (const bf16*)(A.ws + WS_DKB) + (size_t)b * SEQ * 64; const bf16* DVB = (const bf16*)(A.ws + WS_DVB) + (size_t)b * SEQ * 64;
    bf16x8v bq0 = {0, 0, 0, 0, 0, 0, 0, 0}, bq1 = {0, 0, 0, 0, 0, 0, 0, 0};
    if (col < 4) { const bf16* qp = (const bf16*)(A.ws + WS_DQ) + (size_t)m * 256 + col * 64 + 8 * q4; bq0 = *(const bf16x8v*)qp; bq1 = *(const bf16x8v*)(qp + 32); }
    f32x4 lg[16];
#pragma unroll
    for (int kb = 0; kb < 16; ++kb) { const int s = slist[16 * kb + col]; const bf16* kr = DKB + (size_t)s * 64 + 8 * q4;
        const bf16x8v a0 = *(const bf16x8v*)kr, a1 = *(const bf16x8v*)(kr + 32);
        f32x4 c = __builtin_amdgcn_mfma_f32_16x16x32_bf16(a0, bq0, (f32x4){0.f, 0.f, 0.f, 0.f}, 0, 0, 0);
        lg[kb] = __builtin_amdgcn_mfma_f32_16x16x32_bf16(a1, bq1, c, 0, 0, 0); }
    if (nsel < 256) {
#pragma unroll
        for (int kb = 0; kb < 16; ++kb)
#pragma unroll
            for (int r = 0; r < 4; ++r) if (16 * kb + 4 * q4 + r >= nsel) lg[kb][r] = -INFINITY; }
    float mx = -INFINITY;
#pragma unroll
    for (int kb = 0; kb < 16; ++kb) mx = fmaxf(fmaxf(mx, fmaxf(lg[kb].x, lg[kb].y)), fmaxf(lg[kb].z, lg[kb].w));
    mx = fmaxf(mx, __shfl_xor(mx, 16)); mx = fmaxf(mx, __shfl_xor(mx, 32));
    float sm = 0.f;
#pragma unroll
    for (int kb = 0; kb < 16; ++kb) { lg[kb].x = exp2f(lg[kb].x - mx); lg[kb].y = exp2f(lg[kb].y - mx); lg[kb].z = exp2f(lg[kb].z - mx); lg[kb].w = exp2f(lg[kb].w - mx); sm += (lg[kb].x + lg[kb].y) + (lg[kb].z + lg[kb].w); }
    sm += __shfl_xor(sm, 16); sm += __shfl_xor(sm, 32);
    const float inv = 1.0f / sm;
    bf16x8v pa[8];
#pragma unroll
    for (int i = 0; i < 8; ++i) { const f32x4 x = lg[2 * i] * inv, y = lg[2 * i + 1] * inv;
        pg8::u32x4 wv; wv.x = pg8::cvt_pk_bf16(x.x, x.y); wv.y = pg8::cvt_pk_bf16(x.z, x.w); wv.z = pg8::cvt_pk_bf16(y.x, y.y); wv.w = pg8::cvt_pk_bf16(y.z, y.w);
        pa[i] = __builtin_bit_cast(bf16x8v, wv); }
    f32x4 o[4];
#pragma unroll
    for (int nb = 0; nb < 4; ++nb) o[nb] = (f32x4){0.f, 0.f, 0.f, 0.f};
    const int srow = lane >> 3, spc = lane & 7, tj = col >> 2, tc = col & 3;
#pragma unroll
    for (int c = 0; c < 4; ++c) {
#pragma unroll
        for (int i = 0; i < 8; ++i) { const int s = slist[64 * c + srow + 8 * i]; const v4u v = *(const v4u*)(DVB + (size_t)s * 64 + 8 * spc); *(LAS v4u*)(vst + (srow + 8 * i) * VST_PITCH + 16 * spc) = v; }
        LDS_WAIT();
#pragma unroll
        for (int k2 = 0; k2 < 2; ++k2)
#pragma unroll
            for (int nb = 0; nb < 4; ++nb) {
                LAS unsigned char* a1 = vst + (32 * k2 + 4 * q4 + tj) * VST_PITCH + (16 * nb + 4 * tc) * 2;
                const s16x4v r1 = __builtin_bit_cast(s16x4v, __builtin_amdgcn_ds_read_tr16_b64_v4i16((LAS s16x4v*)a1));
                const s16x4v r2 = __builtin_bit_cast(s16x4v, __builtin_amdgcn_ds_read_tr16_b64_v4i16((LAS s16x4v*)(a1 + 16 * VST_PITCH)));
                const bf16x8v bv = {r1[0], r1[1], r1[2], r1[3], r2[0], r2[1], r2[2], r2[3]};
                o[nb] = __builtin_amdgcn_mfma_f32_16x16x32_bf16(pa[2 * c + k2], bv, o[nb], 0, 0, 0); }
        LDS_WAIT();
    }
    if (lane < 16) { float* YD = (float*)(A.ws + WS_YO) + 2 * YO_STRIDE + (size_t)m * 256;
#pragma unroll
        for (int nb = 0; nb < 4; ++nb) { YD[16 * nb + lane] = o[nb].x; YD[64 + 16 * nb + lane] = o[nb].y; YD[128 + 16 * nb + lane] = o[nb].z; YD[192 + 16 * nb + lane] = o[nb].w; } }
}

__device__ __forceinline__ f32x4 head_norm4(f32x4 y, float eps, f32x4 g) {
    const float mean = grp16_sum(sum4(y)) * (1.0f / 64.0f); const f32x4 yc = y - mean;
    const float var = grp16_sum(dot4(yc, yc)) * (1.0f / 64.0f); return yc * (1.0f / sqrtf(var + eps)) * g;
}
template <bool BF> __device__ __forceinline__ f32x4 state_corr(const LAS float* sl, int hh, int r16, const void* pv) {
    const LAS float* r0 = sl + (hh * 64 + 4 * r16) * 64; const int x0 = (4 * r16) & 15;
    f32x4 out = {0.f, 0.f, 0.f, 0.f};
#pragma unroll 2
    for (int k8 = 0; k8 < 8; ++k8) {
        f32x4 pa, pb;
        if (BF) { const v4u x = ((const v4u*)pv)[k8]; pa = (f32x4){bf_lo(x.x), bf_hi(x.x), bf_lo(x.y), bf_hi(x.y)}; pb = (f32x4){bf_lo(x.z), bf_hi(x.z), bf_lo(x.w), bf_hi(x.w)}; }
        else { pa = ((const f32x4*)pv)[2 * k8]; pb = ((const f32x4*)pv)[2 * k8 + 1]; }
#pragma unroll
        for (int i = 0; i < 4; ++i) { const LAS float* rowp = r0 + i * 64; const int xs = (x0 + i) & 15;
            out[i] += dot4(*(const LAS f32x4*)(rowp + 4 * ((2 * k8) ^ xs)), pa) + dot4(*(const LAS f32x4*)(rowp + 4 * ((2 * k8 + 1) ^ xs)), pb); }
    }
    return out;
}
__device__ __forceinline__ void post_row(ARef A, int l, int m, int lane, const LAS float* slw, const LAS float* slr) {
    const float* P = (const float*)(A.ws + WS_P); const float* YO = (const float*)(A.ws + WS_YO); const float* RWA = (const float*)(A.ws + WS_RWA);
    bf16* MX = (bf16*)(A.ws + WS_MIX) + (size_t)m * DM; const int c4 = 4 * lane, hh = lane >> 4, r16 = lane & 15; const size_t o = (size_t)m * 256 + c4;
    { f32x4 y = *(const f32x4*)(YO + o) + state_corr<true>(slr, hh, r16, (const bf16*)(A.ws + WS_PTR) + (size_t)m * 256 + hh * 64);
      y = head_norm4(y, 1e-5f, *(const f32x4*)(A.in[I_RETGN] + l * 256 + c4));
      const f32x4 g = *(const f32x4*)(P + (size_t)m * INCP + C_RET + 768 + c4);
#pragma unroll
      for (int i = 0; i < 4; ++i) y[i] *= g[i] * sigm(g[i]);
      v2u w; w.x = pk2(y.x, y.y); w.y = pk2(y.z, y.w); *(v2u*)(MX + c4) = w; }
    { f32x4 y = *(const f32x4*)(YO + YO_STRIDE + o) + state_corr<false>(slw, hh, r16, (const float*)(A.ws + WS_PT) + (size_t)m * 256 + hh * 64);
      y = head_norm4(y, 64e-5f, *(const f32x4*)(A.in[I_LN] + l * 256 + c4));
      y = (y + *(const f32x4*)(RWA + 7 * RWA_STRIDE + o)) * *(const f32x4*)(RWA + 6 * RWA_STRIDE + o);
      v2u w; w.x = pk2(y.x, y.y); w.y = pk2(y.z, y.w); *(v2u*)(MX + 256 + c4) = w; }
    { f32x4 y = *(const f32x4*)(YO + 2 * YO_STRIDE + o); const float r = 1.0f / sqrtf(wave_sum(dot4(y, y)) * (1.0f / 256.0f) + 1e-5f);
      y = y * r * *(const f32x4*)(A.in[I_DONORM] + l * 256 + c4);
      v2u w; w.x = pk2(y.x, y.y); w.y = pk2(y.z, y.w); *(v2u*)(MX + 512 + c4) = w; }
    { f32x4 y = *(const f32x4*)(YO + 3 * YO_STRIDE + o); const float r = 1.0f / sqrtf(wave_sum(dot4(y, y)) * (1.0f / 256.0f) + 1e-5f);
      y = y * r * *(const f32x4*)(A.in[I_SONORM] + l * 256 + c4);
      v2u w; w.x = pk2(y.x, y.y); w.y = pk2(y.z, y.w); *(v2u*)(MX + 768 + c4) = w; }
}
__device__ __forceinline__ void ph_post(ARef A, const WI& w, int l) {
    LAS float* slw = (LAS float*)w.lds; LAS float* slr = slw + 16384;
    for (int u = w.vcu; u < NB * NCH * 2; u += w.G) {
        const int b = u >> 5, c = (u >> 1) & 15, half = u & 1;
        __syncthreads();
        for (int e = w.tid; e < 4096; e += NWAVES * 64) { const int hh = e >> 10, v = (e >> 4) & 63, k4 = e & 15;
            const size_t src = ((size_t)((b * 4 + hh) * NCH + c) * 64 + v) * 64 + 4 * k4; const int dst = (hh * 64 + v) * 64 + 4 * (k4 ^ (v & 15));
            *(LAS f32x4*)(slw + dst) = *(const f32x4*)((const float*)(A.ws + WS_SI) + src); *(LAS f32x4*)(slr + dst) = *(const f32x4*)((const float*)(A.ws + WS_SIR) + src); }
        __syncthreads();
        const int tok0 = b * SEQ + c * TCH + half * 128 + w.wave * 16;
        for (int i = 0; i < 16; ++i) post_row(A, l, tok0 + i, w.lane, slw, slr);
    }
}

__device__ __forceinline__ void router_row(ARef A, int l, int m, int lane) {
    const float* XA = (const float*)(A.ws + WS_XA) + (size_t)m * DM; const float* MOD = (const float*)(A.ws + WS_MOD) + (size_t)(l * 8 + (m >> 12)) * 6144;
    f32x4 v[4]; float ss = 0.0f;
#pragma unroll
    for (int j = 0; j < 4; ++j) { v[j] = *(const f32x4*)(XA + 4 * (lane + 64 * j)); ss += dot4(v[j], v[j]); }
    ss = wave_sum(ss); const float rstd = 1.0f / sqrtf(ss * (1.0f / DM) + 1e-5f);
    const float* g = A.in[I_NFFN] + l * DM; const float* scp = MOD + 4 * 1024; const float* shp = MOD + 3 * 1024;
    emit_h_row(v, rstd, g, scp, shp, (bf16*)(A.ws + WS_H) + (size_t)m * DM, lane);
    float p[32];
#pragma unroll
    for (int e = 0; e < 32; ++e) p[e] = 0.0f;
    const float* rw = A.in[I_RW] + (size_t)l * DM * 32;
#pragma unroll 1
    for (int j = 0; j < 4; ++j) { const int k = 4 * (lane + 64 * j);
        const f32x4 h = *(const f32x4*)(XA + k) * rstd * *(const f32x4*)(g + k) * (1.0f + *(const f32x4*)(scp + k)) + *(const f32x4*)(shp + k);
        const float* row = rw + (size_t)k * 32;
#pragma unroll
        for (int i = 0; i < 4; ++i) {
#pragma unroll
            for (int q4 = 0; q4 < 8; ++q4) { const f32x4 r = *(const f32x4*)(row + i * 32 + 4 * q4); p[4 * q4] += h[i] * r.x; p[4 * q4 + 1] += h[i] * r.y; p[4 * q4 + 2] += h[i] * r.z; p[4 * q4 + 3] += h[i] * r.w; } } }
    const float* rb = A.in[I_RB] + l * 32;
#pragma unroll
    for (int e = 0; e < 32; ++e) p[e] = wave_sum(p[e]) + rb[e];
    unsigned used = 0u; float tv[4]; int ti[4];
#pragma unroll
    for (int kk = 0; kk < 4; ++kk) { float best = -INFINITY; int bi = 0;
#pragma unroll
        for (int e = 0; e < 32; ++e) { const bool c = !((used >> e) & 1u) && (p[e] > best); best = c ? p[e] : best; bi = c ? e : bi; }
        used |= 1u << bi; tv[kk] = best; ti[kk] = bi; }
    const float e1 = expf(tv[1] - tv[0]), e2 = expf(tv[2] - tv[0]), e3 = expf(tv[3] - tv[0]); const float inv = 1.0f / (1.0f + e1 + e2 + e3);
    if (lane == 0) {
        int* TI = (int*)(A.ws + WS_TOPI) + (size_t)m * 4; float* TW = (float*)(A.ws + WS_TOPW) + (size_t)m * 4;
        TI[0] = ti[0]; TI[1] = ti[1]; TI[2] = ti[2]; TI[3] = ti[3]; TW[0] = inv; TW[1] = e1 * inv; TW[2] = e2 * inv; TW[3] = e3 * inv;
        unsigned* cnt = (unsigned*)(A.ws + WS_CTL) + CW_CNT + l * 32;
        atomicAdd(cnt + ti[0], 1u); atomicAdd(cnt + ti[1], 1u); atomicAdd(cnt + ti[2], 1u); atomicAdd(cnt + ti[3], 1u);
    }
}
__device__ __forceinline__ void build_expert_table(ARef A, const WI& w, int l) {
    LAS int* tst = (LAS int*)(w.lds + TST_OFF); LAS int* tab = (LAS int*)(w.lds + TAB_OFF);
    if (w.tid == 0) { const unsigned* cnt = (const unsigned*)(A.ws + WS_CTL) + CW_CNT + l * 32; int acc = 0;
        for (int e = 0; e < 32; ++e) { tst[e] = acc; acc += (int)((__hip_atomic_load(cnt + e, RLX_AGENT) + 255u) >> 8); }
        tst[32] = acc; tab[0] = acc; }
    __syncthreads();
    if (w.tid < 32) { const int e = w.tid; for (int pm = tst[e]; pm < tst[e + 1]; ++pm) tab[1 + pm] = e; }
    __syncthreads();
}
__device__ __forceinline__ void scatter_row(ARef A, const WI& w, int l, int m) {
    const LAS int* tst = (const LAS int*)(w.lds + TST_OFF);
    int pos = 0;
    if (w.lane < 4) { const int e = ((const int*)(A.ws + WS_TOPI))[(size_t)m * 4 + w.lane];
        const unsigned slot = atomicAdd((unsigned*)(A.ws + WS_CTL) + CW_CUR + l * 32 + e, 1u);
        pos = tst[e] * 256 + (int)slot; ((int*)(A.ws + WS_POS))[(size_t)m * 4 + w.lane] = pos; }
    const v4u* src = (const v4u*)((const bf16*)(A.ws + WS_H) + (size_t)m * DM);
    const v4u a = src[w.lane], b = src[64 + w.lane];
#pragma unroll
    for (int k = 0; k < 4; ++k) { const int pk = __shfl(pos, k); v4u* dst = (v4u*)((bf16*)(A.ws + WS_XS) + (size_t)pk * DM); dst[w.lane] = a; dst[64 + w.lane] = b; }
}
__device__ __forceinline__ void combine_row(ARef A, int l, int m, int lane) {
    float* XA = (float*)(A.ws + WS_XA) + (size_t)m * DM; const float* MOD = (const float*)(A.ws + WS_MOD) + (size_t)(l * 8 + (m >> 12)) * 6144;
    const int* PS = (const int*)(A.ws + WS_POS) + (size_t)m * 4; const float* TW = (const float*)(A.ws + WS_TOPW) + (size_t)m * 4;
    const bf16* YS = (const bf16*)(A.ws + WS_XS);
    f32x4 v[4], acc[4];
#pragma unroll
    for (int j = 0; j < 4; ++j) { v[j] = *(const f32x4*)(XA + 4 * (lane + 64 * j)); acc[j] = (f32x4){0.f, 0.f, 0.f, 0.f}; }
#pragma unroll
    for (int k = 0; k < 4; ++k) { const int pos = PS[k]; const float gt = TW[k]; const v2u* yr = (const v2u*)(YS + (size_t)pos * DM);
#pragma unroll
        for (int j = 0; j < 4; ++j) { const v2u y = yr[lane + 64 * j]; acc[j] += gt * (f32x4){bf_lo(y.x), bf_hi(y.x), bf_lo(y.y), bf_hi(y.y)}; } }
    float ss = 0.0f;
#pragma unroll
    for (int j = 0; j < 4; ++j) { const int kx = 4 * (lane + 64 * j); v[j] += *(const f32x4*)(MOD + 5 * 1024 + kx) * acc[j]; ss += dot4(v[j], v[j]); }
    ss = wave_sum(ss); const float rstd = 1.0f / sqrtf(ss * (1.0f / DM) + 1e-5f);
    if (l + 1 < NLAYER) {
#pragma unroll
        for (int j = 0; j < 4; ++j) *(f32x4*)(XA + 4 * (lane + 64 * j)) = v[j];
        const float* mb = MOD + 8 * 6144;
        emit_h_row(v, rstd, A.in[I_NMIX] + (l + 1) * DM, mb + 1024, mb, (bf16*)(A.ws + WS_H) + (size_t)m * DM, lane);
    } else {
        float* orow = A.out + (size_t)m * DM; const float* gf = A.in[I_NFINAL];
#pragma unroll
        for (int j = 0; j < 4; ++j) { const int kx = 4 * (lane + 64 * j); *(f32x4*)(orow + kx) = v[j] * rstd * *(const f32x4*)(gf + kx); }
    }
}

constexpr int N_LAUNCHES = MK_N_LAUNCHES;
template <int SEL> __global__ void __launch_bounds__(NWAVES * 64, 2) fwd(ArgsH Ah) {
    extern __shared__ __attribute__((aligned(16))) unsigned char lds[];
    (void)Ah;
    const int wave_s = __builtin_amdgcn_readfirstlane((int)threadIdx.x >> 6);
    auto tid_now = [&]() -> int { int ws_ = wave_s; unsigned z_ = 0u; asm volatile("" : "+s"(ws_), "+s"(z_)); return ws_ * 64 + (int)__builtin_amdgcn_mbcnt_hi(~0u, __builtin_amdgcn_mbcnt_lo(~0u, z_)); };
#define TID_NOW() tid_now()
#define MAKE_WI() WI w; { int tz = TID_NOW(); asm volatile("" : "+v"(tz)); int bz = blockIdx.x, gz = gridDim.x; asm volatile("" : "+s"(bz), "+s"(gz)); \
        w.lds = (LAS unsigned char*)lds; w.tid = tz; w.lane = tz & 63; w.wave = __builtin_amdgcn_readfirstlane(tz >> 6); w.G = gz; w.bx = bz; w.vcu = (gz % 8 == 0) ? (bz % 8) * (gz / 8) + bz / 8 : bz; \
        w.gw = w.vcu * NWAVES + w.wave; w.NGW = gz * NWAVES; }
    { const int t0 = threadIdx.x; for (int u = t0; u < (LDS_BYTES - RING_BYTES) / 4; u += NWAVES * 64) ((LAS unsigned*)((LAS unsigned char*)lds + RING_BYTES))[u] = 0u; }
    __syncthreads();
    int lo, hi; { ARef A0 = *kargs(); lo = A0.ph_lo; hi = A0.ph_hi; }
    if (N_LAUNCHES == 1) { ARef A0 = *kargs(); (void)xcd_barrier_post((unsigned*)((gu32*)(A0.ws + WS_CTL) + CW_BAR), (volatile LAS unsigned*)((LAS unsigned char*)lds + MISC_OFF) + 8, TID_NOW()); }
#define GRID_BAR() do { if (N_LAUNCHES == 1) { ARef Ab = *kargs(); XcdBarrier bar_; bar_.bar = (unsigned*)((gu32*)(Ab.ws + WS_CTL) + CW_BAR); bar_.x = xb_xcc_id(); bar_.st = (volatile LAS unsigned*)((LAS unsigned char*)lds + MISC_OFF) + 8; xcd_barrier(bar_, TID_NOW()); } } while (0)
#define IN(k) (lo <= (k) && (k) < hi)
#ifndef PHMASK
#define PHMASK 0xffffffffu
#endif
#define KON(k) if constexpr ((SEL < 0 && ((PHMASK >> (k)) & 1u)) || SEL == (k))
#define BOTH(k) (IN(k) && IN((k) + 1))
#ifndef PROBE_REP
#define PROBE_REP 0
#endif
#define REP(bit) for (int rep_ = 0; rep_ < (((PROBE_REP >> (bit)) & 1) ? 2 : 1); ++rep_)
#define ring ((PG8_LAS unsigned char*)lds)

    KON(0) if (IN(0)) { ARef A = *kargs(); MAKE_WI(); REP(0) ph_prologue(A, w); if (BOTH(0)) GRID_BAR(); }

#define LAYER_BODY(l) do {\
        const int pb = 1 + l * NPL; \
        KON(1) if (IN(pb + 0)) { ARef A = *kargs(); MAKE_WI(); if (l == 0) ph_norm1(A, w); if (BOTH(pb + 0)) GRID_BAR(); } \
        KON(2) if (IN(pb + 1)) { ARef A = *kargs(); MAKE_WI(); \
            pg8::Gemm g{(const bf16*)(A.ws + WS_H), (const bf16*)(A.ws + WS_WIN) + (size_t)l * INCP * DM, MTOK, INCP, DM}; pg8::StaticOrder S; S.init(MTOK, INCP, w.G, w.bx); \
            pg8::EpiF32 E{(float*)(A.ws + WS_P), INCP}; \
            REP(1) pg8::gemm_phase<pg8::EpiF32, pg8::StaticOrder, true, true>(ring, g, S, E, w.tid); \
            if (BOTH(pb + 1)) GRID_BAR(); \
        } \
        KON(3) if (IN(pb + 2)) { ARef A = *kargs(); MAKE_WI(); \
            REP(2) for (int m = w.gw; m < MTOK; m += w.NGW) { rwkv_prep(A, l, m, w.lane); dsa_prep(A, l, m, w.lane); } \
            if (BOTH(pb + 2)) GRID_BAR(); \
        } \
        KON(4) if (IN(pb + 3)) { ARef A = *kargs(); MAKE_WI(); \
            REP(3) { for (int tk = w.vcu; tk < 32 * NCH; tk += w.G) scan_rwkv_task(A, w, tk); \
            for (int tk = w.vcu; tk < 32 * NCH / 2; tk += w.G) scan_ret_task(A, w, tk); } \
            REP(4) { LAS unsigned char* vl = w.lds + w.wave * 4608; for (int it = w.gw; it < 32 * 128; it += w.NGW) sb_tile_mfma(A, it, w.lane, vl); } \
            REP(5) dsa_scores_mfma(A, w); \
            if (BOTH(pb + 3)) GRID_BAR(); \
        } \
        KON(5) if (IN(pb + 4)) { ARef A = *kargs(); MAKE_WI(); \
            if (w.vcu < 32) prefix_chain(A, w, w.vcu); \
            LAS unsigned char* wl = w.lds + w.wave * 10240; \
            REP(6) for (int i = w.gw; i < MTOK; i += w.NGW) { const int m = (i & 1) ? (MTOK - 1 - (i >> 1)) : (i >> 1); dsa_row_mfma(A, m, w.lane, wl); } \
            if (BOTH(pb + 4)) GRID_BAR(); \
        } \
        KON(6) if (IN(pb + 5)) { ARef A = *kargs(); MAKE_WI(); \
            REP(7) ph_post(A, w, l); \
            if (BOTH(pb + 5)) GRID_BAR(); \
        } \
        KON(7) if (IN(pb + 6)) { ARef A = *kargs(); MAKE_WI(); \
            pg8::Gemm g{(const bf16*)(A.ws + WS_MIX), (const bf16*)(A.ws + WS_WOUT) + (size_t)l * DM * DM, MTOK, DM, DM}; pg8::StaticOrder S; S.init(MTOK, DM, w.G, w.bx); \
            pg8::EpiRes E{l == 0 ? A.in[I_X] : (const float*)(A.ws + WS_XA), (float*)(A.ws + WS_XA), (const float*)(A.ws + WS_MOD) + (size_t)l * 8 * 6144 + 2 * 1024}; \
            pg8::gemm_phase<pg8::EpiRes, pg8::StaticOrder, true, true>(ring, g, S, E, w.tid); \
            if (BOTH(pb + 6)) GRID_BAR(); \
        } \
        KON(8) if (IN(pb + 7)) { ARef A = *kargs(); MAKE_WI(); \
            for (int m = w.gw; m < MTOK; m += w.NGW) router_row(A, l, m, w.lane); \
            if (BOTH(pb + 7)) GRID_BAR(); \
        } \
        KON(9) if (IN(pb + 8)) { ARef A = *kargs(); MAKE_WI(); \
            build_expert_table(A, w, l); \
            for (int m = w.gw; m < MTOK; m += w.NGW) scatter_row(A, w, l, m); \
            if (BOTH(pb + 8)) GRID_BAR(); \
        } \
        KON(10) if (IN(pb + 9)) { ARef A = *kargs(); MAKE_WI(); \
            build_expert_table(A, w, l); \
            pg8::Gemm g{(const bf16*)(A.ws + WS_XS), (const bf16*)(A.ws + WS_W1) + (size_t)l * NEXP * 2048 * DM, MOE_ROWS, NEXP * 2048, DM}; \
            pg8::MoeOrder S{(const PG8_LAS int*)(w.lds + TAB_OFF), 8, w.G, w.vcu}; \
            pg8::EpiSwiglu E{(bf16*)(A.ws + WS_ACT), A.in[I_MB1] + (size_t)l * NEXP * 2048}; \
            REP(8) pg8::gemm_phase<pg8::EpiSwiglu, pg8::MoeOrder, true, true>(ring, g, S, E, w.tid); \
            if (BOTH(pb + 9)) GRID_BAR(); \
        } \
        KON(11) if (IN(pb + 10)) { ARef A = *kargs(); MAKE_WI(); \
            build_expert_table(A, w, l); \
            pg8::Gemm g{(const bf16*)(A.ws + WS_ACT), (const bf16*)(A.ws + WS_W2) + (size_t)l * NEXP * DM * DM, MOE_ROWS, NEXP * DM, DM}; \
            pg8::MoeOrder S{(const PG8_LAS int*)(w.lds + TAB_OFF), 4, w.G, w.vcu}; \
            pg8::EpiY E{(bf16*)(A.ws + WS_XS), A.in[I_MB2] + (size_t)l * NEXP * DM}; \
            REP(9) pg8::gemm_phase<pg8::EpiY, pg8::MoeOrder, true, true>(ring, g, S, E, w.tid); \
            if (BOTH(pb + 10)) GRID_BAR(); \
        } \
        KON(12) if (IN(pb + 11)) { ARef A = *kargs(); MAKE_WI(); \
            for (int m = w.gw; m < MTOK; m += w.NGW) combine_row(A, l, m, w.lane); \
            if (BOTH(pb + 11)) GRID_BAR(); \
        } \
    } while (0)
    LAYER_BODY(0);
    LAYER_BODY(1);
#undef LAYER_BODY
#undef IN
#undef ring
#undef MAKE_WI
#undef TID_NOW
#undef GRID_BAR
#undef KON
#undef BOTH
}


#if MK_N_LAUNCHES != 1
template <int K> static void launch_one(int grid, hipStream_t stream, const ArgsH& a) {
    static bool attr = false;
    if (!attr) { (void)hipFuncSetAttribute((const void*)fwd<K>, hipFuncAttributeMaxDynamicSharedMemorySize, LDS_BYTES); attr = true; }
    hipLaunchKernelGGL(fwd<K>, dim3(grid), dim3(NWAVES * 64), LDS_BYTES, stream, a);
}
static void launch_kind(int kind, int grid, hipStream_t stream, const ArgsH& a) {
    switch (kind) {
        case 0: launch_one<0>(grid, stream, a); break; case 1: launch_one<1>(grid, stream, a); break; case 2: launch_one<2>(grid, stream, a); break;
        case 3: launch_one<3>(grid, stream, a); break; case 4: launch_one<4>(grid, stream, a); break; case 5: launch_one<5>(grid, stream, a); break;
        case 6: launch_one<6>(grid, stream, a); break; case 7: launch_one<7>(grid, stream, a); break; case 8: launch_one<8>(grid, stream, a); break;
        case 9: launch_one<9>(grid, stream, a); break; case 10: launch_one<10>(grid, stream, a); break; case 11: launch_one<11>(grid, stream, a); break;
        default: launch_one<12>(grid, stream, a); break;
    }
}
#endif
extern "C" void kernel_launch(void* const* d_in, const int* in_sizes, int n_in, void* d_out, int out_size, void* d_ws, size_t ws_size, hipStream_t stream) {
    static int grid = 0;
    if (grid == 0) {
        if (n_in != N_IN || out_size != MTOK * DM || ws_size < WS_END) { fprintf(stderr, "kernel_launch: unexpected shapes (n_in %d, out %d, ws %zu)\n", n_in, out_size, ws_size); grid = -1; return; }
        int dev = 0, cus = 0;
        if (hipGetDevice(&dev) != hipSuccess || hipDeviceGetAttribute(&cus, hipDeviceAttributeMultiprocessorCount, dev) != hipSuccess) { grid = -1; return; }
#if MK_N_LAUNCHES == 1
        {
            if (hipFuncSetAttribute((const void*)fwd<-1>, hipFuncAttributeMaxDynamicSharedMemorySize, LDS_BYTES) != hipSuccess) { fprintf(stderr, "kernel_launch: hipFuncSetAttribute failed\n"); grid = -1; return; }
            int per_cu = 0;
            if (hipOccupancyMaxActiveBlocksPerMultiprocessor(&per_cu, (const void*)fwd<-1>, NWAVES * 64, LDS_BYTES) != hipSuccess || per_cu < 1) fprintf(stderr, "kernel_launch: occupancy query says %d\n", per_cu);
            (void)hipGetLastError();
        }
#endif
        grid = cus;
    }
    if (grid < 0) return;
    (void)in_sizes;
    if (hipMemsetAsync((char*)d_ws + WS_CTL, 0, CTL_ZERO_BYTES, stream) != hipSuccess) return;
    ArgsH a{};
    for (int i = 0; i < N_IN; ++i) a.in[i] = (const float*)d_in[i];
    a.out = (float*)d_out; a.ws = (unsigned char*)d_ws;
    for (int f = 0; f < 44; ++f) a.invf[f] = (f < 32) ? pow(10000.0, -(double)f / 32.0) : (f < 40) ? pow(500000.0, -(double)(f - 32) / 8.0) : pow(500000.0, -(double)(f - 40) / 4.0);
#if MK_N_LAUNCHES == 1
    a.ph_lo = 0; a.ph_hi = NPHASE; a.li = 0;
    hipLaunchKernelGGL(fwd<-1>, dim3(grid), dim3(NWAVES * 64), LDS_BYTES, stream, a);
#else
    {
        for (int p = 0; p < NPHASE; ++p) {
            if (p == 1 + NPL) continue;
            a.ph_lo = p; a.ph_hi = p + 1; a.li = p;
            const int kind = (p == 0) ? 0 : 1 + (p - 1) % NPL;
            launch_kind(kind, grid, stream, a);
        }
    }
#endif
}
```

```cpp
#include <hip/hip_runtime.h>
#include <cstdio>
#include <cstdint>
#include <cmath>

#ifndef MK_N_LAUNCHES
#define MK_N_LAUNCHES 1
#endif

namespace pg8 {
#define PG8_LAS __attribute__((address_space(3)))
typedef unsigned short bf16_t;
typedef short bf16x8 __attribute__((ext_vector_type(8)));
typedef float f32x4 __attribute__((ext_vector_type(4)));
typedef unsigned u32x4 __attribute__((ext_vector_type(4)));
typedef unsigned u32x2 __attribute__((ext_vector_type(2)));
constexpr int BM = 256, BK = 64, HALF = 128, HTB = HALF * BK * 2  , STAGE_BYTES = 8 * HTB, NXCD = 8, WGM = 8;

__host__ __device__ __forceinline__ int lds_byte(int r, int c) { const int st = (r >> 4) * 2 + (c >> 5), rr = r & 15, cc = c & 31, ob = rr * 64 + cc * 2; return st * 1024 + (ob ^ (((ob >> 9) & 1) << 5)); }
__host__ __device__ __forceinline__ void stage_rc(int b, int& R, int& C) { const int st = b / 1024, sb = b % 1024, swz = sb ^ (((sb >> 9) & 1) << 5); R = (st >> 1) * 16 + swz / 64; C = (st & 1) * 32 + (swz % 64) / 2; }
__host__ __device__ __forceinline__ int perm32(int rho) { const int n = rho >> 4, i = rho & 15; return 8 * (i >> 2) + 4 * n + (i & 3); }

struct Unit { int pm, pn; };
struct Gemm { const bf16_t* A; const bf16_t* Bt; int M, N, K; };

struct StaticOrder {
    int nM, nN, nwg, G, c;
    __host__ __device__ void init(int M, int N, int G_, int c_) { nM = M / BM; nN = N / BM; nwg = nM * nN; G = G_; c = c_; }
    __host__ __device__ bool next(int i, Unit& u) const {
        const long L = (long)i * G + c; if (L >= nwg) return false;
        int wgid = (int)L; { const int q = nwg / NXCD, r = nwg % NXCD, xcd = wgid % NXCD, off = wgid / NXCD; wgid = (xcd < r ? xcd * (q + 1) : r * (q + 1) + (xcd - r) * q) + off; }
        const int nig = WGM * nN, gid = wgid / nig, fm = gid * WGM, gsz = (nM - fm) < WGM ? (nM - fm) : WGM;
        u.pm = fm + ((wgid % nig) % gsz); u.pn = (wgid % nig) / gsz; return true;
    }
    __device__ __forceinline__ void a_ready(const Unit&) const {}
    __device__ __forceinline__ void done(const Unit&) const {}
};
__device__ __forceinline__ unsigned cvt_pk_bf16(float lo, float hi) { unsigned r; asm volatile("v_cvt_pk_bf16_f32 %0, %1, %2" : "=v"(r) : "v"(lo), "v"(hi)); return r; }
struct EpiF32 {
    static constexpr bool PERM = false, AFTER_DRAIN = false;
    float* C; int ldc;
    __device__ __forceinline__ void operator()(const f32x4 (&acc)[2][2][4][2], const Unit& u, int wr, int wc, int fr, int fq) const {
        const int row0 = u.pm * BM + wr * 64 + fr, col0 = u.pn * BM + wc * 32 + 4 * fq;
#pragma unroll
        for (int ai = 0; ai < 2; ++ai)
#pragma unroll
            for (int m = 0; m < 4; ++m) { float* rowp = C + (size_t)(row0 + ai * HALF + m * 16) * ldc + col0;
#pragma unroll
                for (int bj = 0; bj < 2; ++bj)
#pragma unroll
                    for (int n = 0; n < 2; ++n) *(f32x4*)(rowp + bj * HALF + n * 16) = acc[ai][bj][m][n]; }
    }
};
struct EpiRes {
    static constexpr bool PERM = false, AFTER_DRAIN = false;
    const float* xin; float* xout; const float* gate;
    __device__ __forceinline__ void operator()(const f32x4 (&acc)[2][2][4][2], const Unit& u, int wr, int wc, int fr, int fq) const {
        const int row0 = u.pm * BM + wr * 64 + fr, col0 = u.pn * BM + wc * 32 + 4 * fq;
        const float* gp = gate + (size_t)((u.pm * BM) >> 12) * 6144 + col0;
        f32x4 gv[2][2];
#pragma unroll
        for (int bj = 0; bj < 2; ++bj)
#pragma unroll
            for (int n = 0; n < 2; ++n) gv[bj][n] = *(const f32x4*)(gp + bj * HALF + n * 16);
#pragma unroll
        for (int ai = 0; ai < 2; ++ai)
#pragma unroll
            for (int m = 0; m < 4; ++m) { const size_t ro = (size_t)(row0 + ai * HALF + m * 16) * 1024 + col0;
#pragma unroll
                for (int bj = 0; bj < 2; ++bj)
#pragma unroll
                    for (int n = 0; n < 2; ++n) { const f32x4 xv = *(const f32x4*)(xin + ro + bj * HALF + n * 16); *(f32x4*)(xout + ro + bj * HALF + n * 16) = xv + gv[bj][n] * acc[ai][bj][m][n]; } }
    }
};
__device__ __forceinline__ float swiglu1(float glu, float lin) {
    glu = fminf(glu, 7.0f); lin = fminf(fmaxf(lin, -7.0f), 7.0f);
    return glu * (1.0f / (1.0f + __expf(-1.702f * glu))) * (lin + 1.0f);
}
struct EpiSwiglu {
    static constexpr bool PERM = true, AFTER_DRAIN = false;
    bf16_t* O; const float* b1;
    __device__ __forceinline__ void operator()(const f32x4 (&acc)[2][2][4][2], const Unit& u, int wr, int wc, int fr, int fq) const {
        const int e = u.pn >> 3, j = u.pn & 7, row0 = u.pm * BM + wr * 64 + fr, c0 = 128 * j + wc * 32 + 8 * fq;
        const float* bp = b1 + (size_t)e * 2048 + c0;
        f32x4 bg[2], bl[2];
#pragma unroll
        for (int n = 0; n < 2; ++n) { bg[n] = *(const f32x4*)(bp + 4 * n); bl[n] = *(const f32x4*)(bp + 1024 + 4 * n); }
#pragma unroll
        for (int ai = 0; ai < 2; ++ai)
#pragma unroll
            for (int m = 0; m < 4; ++m) { bf16_t* rowp = O + (size_t)(row0 + ai * HALF + m * 16) * 1024 + c0;
                const f32x4 g0 = acc[ai][0][m][0] + bg[0], g1 = acc[ai][0][m][1] + bg[1], l0 = acc[ai][1][m][0] + bl[0], l1 = acc[ai][1][m][1] + bl[1];
                u32x4 w;
                w.x = cvt_pk_bf16(swiglu1(g0[0], l0[0]), swiglu1(g0[1], l0[1])); w.y = cvt_pk_bf16(swiglu1(g0[2], l0[2]), swiglu1(g0[3], l0[3]));
                w.z = cvt_pk_bf16(swiglu1(g1[0], l1[0]), swiglu1(g1[1], l1[1])); w.w = cvt_pk_bf16(swiglu1(g1[2], l1[2]), swiglu1(g1[3], l1[3]));
                *(u32x4*)rowp = w; }
    }
};
struct EpiY {
    static constexpr bool PERM = true, AFTER_DRAIN = false;
    bf16_t* O; const float* b2;
    __device__ __forceinline__ void operator()(const f32x4 (&acc)[2][2][4][2], const Unit& u, int wr, int wc, int fr, int fq) const {
        const int e = u.pn >> 2, j = u.pn & 3, row0 = u.pm * BM + wr * 64 + fr, c0 = 256 * j + wc * 32 + 8 * fq;
        const float* bp = b2 + (size_t)e * 1024 + c0;
        f32x4 bv[2][2];
#pragma unroll
        for (int bj = 0; bj < 2; ++bj)
#pragma unroll
            for (int n = 0; n < 2; ++n) bv[bj][n] = *(const f32x4*)(bp + bj * HALF + 4 * n);
#pragma unroll
        for (int ai = 0; ai < 2; ++ai)
#pragma unroll
            for (int m = 0; m < 4; ++m) { bf16_t* rowp = O + (size_t)(row0 + ai * HALF + m * 16) * 1024 + c0;
#pragma unroll
                for (int bj = 0; bj < 2; ++bj) { const f32x4 v0 = acc[ai][bj][m][0] + bv[bj][0], v1 = acc[ai][bj][m][1] + bv[bj][1];
                    u32x4 w; w.x = cvt_pk_bf16(v0[0], v0[1]); w.y = cvt_pk_bf16(v0[2], v0[3]); w.z = cvt_pk_bf16(v1[0], v1[1]); w.w = cvt_pk_bf16(v1[2], v1[3]);
                    *(u32x4*)(rowp + bj * HALF) = w; } }
    }
};
struct MoeOrder {
    const PG8_LAS int* tab; int NJ, G, c;
    __device__ __forceinline__ bool next(int i, Unit& u) const {
        const int T = tab[0]; const long L = (long)i * G + c; if (L >= (long)T * NJ) return false;
        const int pm = (int)(L / NJ), j = (int)(L % NJ);
        u.pm = pm; u.pn = tab[1 + pm] * NJ + j; return true;
    }
    __device__ __forceinline__ void a_ready(const Unit&) const {}
    __device__ __forceinline__ void done(const Unit&) const {}
};

template <class Epi, class Sched, bool ALIGN_EPI = false, bool SP2 = false>
__device__ __forceinline__ void gemm_phase(PG8_LAS unsigned char* lds, const Gemm g, const Sched& S, const Epi& E, int tid_in) {
    int tid_ = tid_in; asm volatile("" : "+v"(tid_));
    const int tid = tid_, wid = __builtin_amdgcn_readfirstlane(tid >> 6), lane = tid & 63, wr = wid >> 2, wc = wid & 3, fr = lane & 15, fq = lane >> 4;
    const int K = g.K, nt = K / BK;
    unsigned voffA[2], voffB[2];
#pragma unroll
    for (int i = 0; i < 2; ++i) { int R, C; stage_rc(tid * 16 + i * 8192, R, C); const int Rb = Epi::PERM ? ((R & ~31) + perm32(R & 31)) : R;
        voffA[i] = (unsigned)(R * K + C) * 2u; voffB[i] = (unsigned)(Rb * K + C) * 2u; }
    const size_t kstep = (size_t)(BK * 2);
    const size_t hstep = (size_t)HALF * K * 2;
    const size_t tstep = 2 * hstep;
    const unsigned ldsw = (unsigned)wid * 1024u;
    const int aoff = lds_byte(wr * 64 + fr, fq * 8), boff = lds_byte(wc * 32 + fr, fq * 8);
#define PG8_SA(b, h) (((b) * 2 + (h)) * HTB)
#define PG8_SB(b, h) ((4 + (b) * 2 + (h)) * HTB)
#define PG8_STAGE(bufoff, gbase, voff) do { _Pragma("unroll") for (int _i = 0; _i < 2; ++_i) \
        __builtin_amdgcn_global_load_lds((const unsigned*)((const char*)(gbase) + (voff)[_i]), (PG8_LAS unsigned*)(lds + (bufoff) + ldsw + _i * 8192), 16, 0, 0); } while (0)
#define PG8_LDA(dst, b, h) do { _Pragma("unroll") for (int m = 0; m < 4; ++m) _Pragma("unroll") for (int k = 0; k < 2; ++k) dst[m][k] = *(const PG8_LAS bf16x8*)(lds + PG8_SA(b, h) + aoff + m * 2048 + k * 1024); } while (0)
#define PG8_LDB(dst, b, h) do { _Pragma("unroll") for (int n = 0; n < 2; ++n) _Pragma("unroll") for (int k = 0; k < 2; ++k) dst[n][k] = *(const PG8_LAS bf16x8*)(lds + PG8_SB(b, h) + boff + n * 2048 + k * 1024); } while (0)
#define PG8_MMA(ai, bj, At, Bt) do { __builtin_amdgcn_s_setprio(1); _Pragma("unroll") for (int m = 0; m < 4; ++m) _Pragma("unroll") for (int n = 0; n < 2; ++n) _Pragma("unroll") for (int k = 0; k < 2; ++k) \
        acc[ai][bj][m][n] = __builtin_amdgcn_mfma_f32_16x16x32_bf16(Bt[n][k], At[m][k], acc[ai][bj][m][n], 0, 0, 0); __builtin_amdgcn_s_setprio(0); } while (0)
#define PG8_WAIT_V(n) asm volatile("s_waitcnt vmcnt(" #n ")" ::: "memory")
#define PG8_WAIT_L(n) asm volatile("s_waitcnt lgkmcnt(" #n ")" ::: "memory")
#define PG8_BAR __builtin_amdgcn_s_barrier()
#define PG8_SCHED __builtin_amdgcn_sched_barrier(0)
    Unit cur, nxt; int ui = 0;
    if (!S.next(0, cur)) return;
    f32x4 acc[2][2][4][2];
#pragma unroll
    for (int a = 0; a < 2; ++a)
#pragma unroll
        for (int b = 0; b < 2; ++b)
#pragma unroll
            for (int m = 0; m < 4; ++m)
#pragma unroll
                for (int n = 0; n < 2; ++n) acc[a][b][m][n] = (f32x4){0.f, 0.f, 0.f, 0.f};
    bf16x8 At[4][2], B0[2][2], B1[2][2];
    const char* cA = (const char*)g.A + (size_t)cur.pm * tstep; const char* cB = (const char*)g.Bt + (size_t)cur.pn * tstep;
    S.a_ready(cur);
    if constexpr (SP2) {
        PG8_STAGE(PG8_SB(0, 0), cB, voffB); PG8_STAGE(PG8_SB(0, 1), cB + hstep, voffB); PG8_STAGE(PG8_SA(0, 0), cA, voffA); PG8_STAGE(PG8_SA(0, 1), cA + hstep, voffA);
        if (wr == 1) PG8_BAR;
        PG8_WAIT_V(2); PG8_BAR;
        PG8_STAGE(PG8_SB(1, 0), cB + kstep, voffB); PG8_STAGE(PG8_SA(1, 0), cA + kstep, voffA); PG8_STAGE(PG8_SB(1, 1), cB + hstep + kstep, voffB);
        PG8_WAIT_V(6); PG8_BAR;
    } else {
        PG8_STAGE(PG8_SB(0, 0), cB, voffB); PG8_STAGE(PG8_SA(0, 0), cA, voffA); PG8_STAGE(PG8_SB(0, 1), cB + hstep, voffB); PG8_STAGE(PG8_SA(0, 1), cA + hstep, voffA);
        if (wr == 1) PG8_BAR;
        PG8_WAIT_V(4); PG8_BAR;
        PG8_STAGE(PG8_SB(1, 0), cB + kstep, voffB); PG8_STAGE(PG8_SA(1, 0), cA + kstep, voffA); PG8_STAGE(PG8_SB(1, 1), cB + hstep + kstep, voffB);
        PG8_WAIT_V(6); PG8_BAR;
    }
    for (;;) {
        const bool has_next = S.next(ui + 1, nxt);
        const char* nA = has_next ? (const char*)g.A + (size_t)nxt.pm * tstep : cA; const char* nB = has_next ? (const char*)g.Bt + (size_t)nxt.pn * tstep : cB;
        for (int t = 0; t < nt; t += 2) {
            const bool last = (t == nt - 2);
            const char* a1 = cA + (size_t)(t + 1) * kstep;
            const char* a2 = last ? nA : cA + (size_t)(t + 2) * kstep; const char* b2 = last ? nB : cB + (size_t)(t + 2) * kstep;
            const char* a3 = a2 + kstep; const char* b3 = b2 + kstep;
            if (last && has_next) S.a_ready(nxt);
            if constexpr (SP2) {
            PG8_LDB(B0, 0, 0); PG8_LDB(B1, 0, 1); PG8_SCHED; PG8_LDA(At, 0, 0); PG8_STAGE(PG8_SA(1, 1), a1 + hstep, voffA);
            PG8_WAIT_V(8); PG8_WAIT_L(0); PG8_BAR; PG8_MMA(0, 0, At, B0); PG8_MMA(0, 1, At, B1); PG8_BAR; PG8_SCHED;
            PG8_LDA(At, 0, 1); PG8_STAGE(PG8_SB(0, 0), b2, voffB); PG8_STAGE(PG8_SB(0, 1), b2 + hstep, voffB); PG8_STAGE(PG8_SA(0, 0), a2, voffA);
            PG8_WAIT_V(8); PG8_WAIT_L(0); PG8_BAR; PG8_MMA(1, 0, At, B0); PG8_MMA(1, 1, At, B1); PG8_BAR; PG8_SCHED;
            PG8_LDB(B0, 1, 0); PG8_LDB(B1, 1, 1); PG8_SCHED; PG8_LDA(At, 1, 0); PG8_STAGE(PG8_SA(0, 1), a2 + hstep, voffA);
            PG8_WAIT_V(8); PG8_WAIT_L(0); PG8_BAR; PG8_MMA(0, 0, At, B0); PG8_MMA(0, 1, At, B1); PG8_BAR; PG8_SCHED;
            PG8_LDA(At, 1, 1); PG8_STAGE(PG8_SB(1, 0), b3, voffB); PG8_STAGE(PG8_SB(1, 1), b3 + hstep, voffB); PG8_STAGE(PG8_SA(1, 0), a3, voffA);
            PG8_WAIT_V(8); PG8_WAIT_L(0); PG8_BAR; PG8_MMA(1, 0, At, B0); PG8_MMA(1, 1, At, B1); PG8_BAR; PG8_SCHED;
            } else {
            PG8_LDB(B0, 0, 0); PG8_SCHED; PG8_LDA(At, 0, 0); PG8_STAGE(PG8_SA(1, 1), a1 + hstep, voffA);
            PG8_WAIT_L(8); PG8_BAR; PG8_WAIT_L(0); PG8_MMA(0, 0, At, B0); PG8_BAR; PG8_SCHED;
            PG8_LDB(B1, 0, 1); PG8_STAGE(PG8_SB(0, 0), b2, voffB);
            PG8_BAR; PG8_WAIT_L(0); PG8_MMA(0, 1, At, B1); PG8_BAR;
            PG8_LDA(At, 0, 1); PG8_STAGE(PG8_SA(0, 0), a2, voffA);
            PG8_BAR; PG8_WAIT_L(0); PG8_MMA(1, 0, At, B0); PG8_BAR; PG8_SCHED;
            PG8_STAGE(PG8_SB(0, 1), b2 + hstep, voffB);
            PG8_WAIT_V(6); PG8_BAR; PG8_MMA(1, 1, At, B1); PG8_BAR;
            PG8_LDB(B0, 1, 0); PG8_SCHED; PG8_LDA(At, 1, 0); PG8_STAGE(PG8_SA(0, 1), a2 + hstep, voffA);
            PG8_WAIT_L(8); PG8_BAR; PG8_WAIT_L(0); PG8_MMA(0, 0, At, B0); PG8_BAR; PG8_SCHED;
            PG8_LDB(B1, 1, 1); PG8_STAGE(PG8_SB(1, 0), b3, voffB);
            PG8_BAR; PG8_WAIT_L(0); PG8_MMA(0, 1, At, B1); PG8_BAR;
            PG8_LDA(At, 1, 1); PG8_STAGE(PG8_SA(1, 0), a3, voffA);
            PG8_BAR; PG8_WAIT_L(0); PG8_MMA(1, 0, At, B0); PG8_BAR; PG8_SCHED;
            PG8_STAGE(PG8_SB(1, 1), b3 + hstep, voffB);
            PG8_WAIT_V(6); PG8_BAR; PG8_MMA(1, 1, At, B1); PG8_BAR;
            }
        }
        if constexpr (ALIGN_EPI) { if (wr == 0) PG8_BAR; }
        if constexpr (!Epi::AFTER_DRAIN) { E(acc, cur, wr, wc, fr, fq); S.done(cur); }
        if (!has_next) break;
#pragma unroll
        for (int a = 0; a < 2; ++a)
#pragma unroll
            for (int b = 0; b < 2; ++b)
#pragma unroll
                for (int m = 0; m < 4; ++m)
#pragma unroll
                    for (int n = 0; n < 2; ++n) acc[a][b][m][n] = (f32x4){0.f, 0.f, 0.f, 0.f};
        cur = nxt; cA = nA; cB = nB; ++ui;
        if constexpr (ALIGN_EPI) { if (wr == 1) PG8_BAR; }
    }
    PG8_WAIT_V(0);
    if constexpr (!ALIGN_EPI) { if (wr == 0) PG8_BAR; }
    PG8_BAR;
    if constexpr (Epi::AFTER_DRAIN) { E.fused(acc, cur, wr, wc, fr, fq, lds, wid, lane); S.done(cur); }
#undef PG8_SA
#undef PG8_SB
#undef PG8_STAGE
#undef PG8_LDA
#undef PG8_LDB
#undef PG8_MMA
#undef PG8_WAIT_V
#undef PG8_WAIT_L
#undef PG8_BAR
#undef PG8_SCHED
}
}

constexpr int NWAVES = 8;
constexpr int NB = 8, SEQ = 4096, DM = 1024, MTOK = NB * SEQ, NLAYER = 2;
constexpr int INC = 2984, INCP = 3072;
constexpr int C_RET = 0, C_RW = 1024, C_DSA = 1920, C_SB = 2216;
constexpr int NEXP = 32, MOE_ROWS = MTOK * 4 + NEXP * 256;
constexpr int ROPE_W = 88;
constexpr int NCH = 16, TCH = SEQ / NCH;
constexpr int NPL = 12, NPHASE = 1 + NLAYER * NPL;
enum { I_X = 0, I_C, I_POS, I_ADAW, I_ADAB, I_NMIX, I_NFFN, I_WIN, I_RETGN, I_MU, I_W0, I_W2, I_A0, I_A2, I_G2, I_KK, I_KA, I_RK, I_LN, I_QNORM, I_WQ, I_WQI, I_DONORM, I_SONORM, I_WOUT, I_RW, I_RB, I_MW1, I_MB1, I_MW2, I_MB2, I_NFINAL, N_IN };

constexpr size_t MiB = 1u << 20;
constexpr size_t WS_CTL = 0, CTL_ZERO_BYTES = 1 * MiB;
constexpr size_t WS_MOD = 1 * MiB, WS_ROPE = 2 * MiB, WS_WIN = 14 * MiB, WS_WOUT = 26 * MiB, WS_W1 = 30 * MiB, WS_W2 = 286 * MiB;
constexpr size_t WS_XA = 414 * MiB, WS_H = 542 * MiB, WS_MIX = 606 * MiB, WS_TOPI = 670 * MiB, WS_TOPW = 671 * MiB, WS_POS = 672 * MiB;
constexpr size_t WS_R = 674 * MiB;
constexpr size_t WS_P = WS_R, WS_RWA = 1058 * MiB  , WS_DQ = 1314 * MiB  , WS_DKB = 1330 * MiB  , WS_DVB = 1334 * MiB  , WS_DQI = 1346 * MiB  , WS_DKI = 1394 * MiB  , WS_DW = 1398 * MiB;
constexpr size_t WS_PT = 1362 * MiB  ;
constexpr size_t WS_CH = WS_H  , WS_SI = WS_H + 16 * MiB  , WS_SIR = WS_H + 24 * MiB  ,
                 WS_CHR = WS_H + 32 * MiB  , WS_PTR = WS_H + 40 * MiB  ;
constexpr size_t WS_SQ = WS_MIX  , WS_SK = WS_MIX + 16 * MiB, WS_SV = WS_MIX + 32 * MiB;
constexpr size_t WS_YO = 1400 * MiB  , WS_SC = 1528 * MiB  ;
constexpr size_t WS_XS = WS_R  , WS_ACT = 946 * MiB  ;
constexpr size_t WS_END = 2040 * MiB;
static_assert((size_t)MOE_ROWS * 2048 <= 272 * MiB, "moe buffers");
constexpr int CW_TMO = 0, CW_CODE = 1, CW_BAR = 4096, CW_BLKCNT = 16384  ;
constexpr int RING_BYTES = 131072, MISC_OFF = RING_BYTES + 320, TST_OFF = RING_BYTES + 1024  , TAB_OFF = RING_BYTES + 2048  , HIST_OFF = RING_BYTES + 5120  , BASE_OFF = RING_BYTES + 5376  , LDS_BYTES = 147456;

#if defined(__HIP_DEVICE_COMPILE__)
#define GAS __attribute__((address_space(1)))
#define CAS __attribute__((address_space(4)))
#else
#define GAS
#define CAS
#endif
#define LAS __attribute__((address_space(3)))
typedef unsigned short bf16;
typedef unsigned v4u __attribute__((ext_vector_type(4)));
typedef unsigned v2u __attribute__((ext_vector_type(2)));
typedef float f32x4 __attribute__((ext_vector_type(4)));
typedef GAS unsigned gu32;
typedef short bf16x8v __attribute__((ext_vector_type(8)));
typedef short s16x4v __attribute__((ext_vector_type(4)));
#define RLX_AGENT __ATOMIC_RELAXED, __HIP_MEMORY_SCOPE_AGENT
#define LDS_WAIT() asm volatile("s_waitcnt lgkmcnt(0)" ::: "memory")
#define VM_WAIT() asm volatile("s_waitcnt vmcnt(0)" ::: "memory")
__device__ __forceinline__ unsigned f2bf(float f) { unsigned u = __builtin_bit_cast(unsigned, f); return (u + 0x7fffu + ((u >> 16) & 1u)) >> 16; }
__device__ __forceinline__ unsigned pk2(float lo, float hi) { return f2bf(lo) | (f2bf(hi) << 16); }
__device__ __forceinline__ float bf_lo(unsigned w) { return __builtin_bit_cast(float, w << 16); }
__device__ __forceinline__ float bf_hi(unsigned w) { return __builtin_bit_cast(float, w & 0xffff0000u); }
__device__ __forceinline__ float wave_sum(float v) {
#pragma unroll
    for (int o = 1; o < 64; o <<= 1) v += __shfl_xor(v, o);
    return v;
}
__device__ __forceinline__ float wave_max(float v) {
#pragma unroll
    for (int o = 1; o < 64; o <<= 1) v = fmaxf(v, __shfl_xor(v, o));
    return v;
}
__device__ __forceinline__ float grp16_sum(float v) { v += __shfl_xor(v, 1); v += __shfl_xor(v, 2); v += __shfl_xor(v, 4); v += __shfl_xor(v, 8); return v; }
__device__ __forceinline__ float grp8_sum(float v) { v += __shfl_xor(v, 1); v += __shfl_xor(v, 2); v += __shfl_xor(v, 4); return v; }
__device__ __forceinline__ float sum4(f32x4 a) { return (a.x + a.y) + (a.z + a.w); }
__device__ __forceinline__ float dot4(f32x4 a, f32x4 b) { return (a.x * b.x + a.y * b.y) + (a.z * b.z + a.w * b.w); }
__device__ __forceinline__ float sigm(float x) { return 1.0f / (1.0f + expf(-x)); }
__device__ __forceinline__ float softplusf(float x) { return fmaxf(x, 0.0f) + log1pf(expf(-fabsf(x))); }
__device__ __forceinline__ f32x4 shx4(f32x4 v, int m) { f32x4 r; r.x = __shfl_xor(v.x, m); r.y = __shfl_xor(v.y, m); r.z = __shfl_xor(v.z, m); r.w = __shfl_xor(v.w, m); return r; }

#define XB_TMO      128
#define XB_XCNT(j)  (256  + 64 * (j))
#define XB_XSUB(j)  (1280 + 64 * (j))
#define XB_XGEN(j)  (2304 + 64 * (j))
#define XB_TOP      3328
#define XB_TOPGEN   3392
#define XCD_BAR_WORDS 3456
#define XB_SPIN_CAP (1u << 18)

__device__ __forceinline__ unsigned xb_ld(unsigned* p)              { return __hip_atomic_load(p, __ATOMIC_RELAXED, __HIP_MEMORY_SCOPE_AGENT); }
__device__ __forceinline__ unsigned xb_add(unsigned* p, unsigned v) { return __hip_atomic_fetch_add(p, v, __ATOMIC_RELAXED, __HIP_MEMORY_SCOPE_AGENT); }
__device__ __forceinline__ unsigned xb_xcc_id() { return (unsigned)__builtin_amdgcn_s_getreg((3 << 11) | 20) & 0xFu; }
#define XB_SPIN(cond, bar) do { unsigned _sp = 0; while (cond) { __builtin_amdgcn_s_sleep(1); \
    if ((++_sp & 255u) == 0u) { if (xb_ld(&(bar)[XB_TMO])) break; if (_sp > XB_SPIN_CAP) { atomicAdd(&(bar)[XB_TMO], 1u); break; } } } } while (0)

struct XcdBarrier {
    unsigned* bar; unsigned x;
    volatile LAS unsigned* st;
};

__device__ __forceinline__ XcdBarrier xcd_barrier_post(unsigned* bar, volatile LAS unsigned* st, int xb_tid) {
    XcdBarrier b; b.bar = bar; b.x = xb_xcc_id(); b.st = st;
    if (xb_tid == 0) (void)xb_add(&bar[XB_XCNT(b.x)], 1u);
    return b;
}
__device__ __forceinline__ void xcd_barrier_complete(unsigned* bar, unsigned x, unsigned& nloc, unsigned& nx) {
    const unsigned G = gridDim.x * gridDim.y * gridDim.z;
    unsigned sum, cnt, mine, sp = 0u;
    for (;;) {
        sum = 0u; cnt = 0u; mine = 0u;
#pragma unroll
        for (unsigned j = 0; j < 16; ++j) { const unsigned c = xb_ld(&bar[XB_XCNT(j)]); sum += c; cnt += (c > 0u) ? 1u : 0u; mine = (j == x) ? c : mine; }
        if (sum == G) break;
        __builtin_amdgcn_s_sleep(1);
        if ((++sp & 255u) == 0u) { if (xb_ld(&bar[XB_TMO])) break; if (sp > XB_SPIN_CAP) { atomicAdd(&bar[XB_TMO], 1u); break; } }
    }
    nloc = mine > 0u ? mine : 1u; nx = cnt > 0u ? cnt : 1u;
}

__device__ __forceinline__ void xcd_barrier(const XcdBarrier& b, int xb_tid) {
    asm volatile("s_waitcnt vmcnt(0)" ::: "memory");
    __syncthreads();
    if (xb_tid == 0) {
        unsigned* bar = b.bar;
        __builtin_amdgcn_s_waitcnt(0);
        unsigned nloc = b.st[0], nx = b.st[1];
        if (nloc == 0u) { xcd_barrier_complete(bar, b.x, nloc, nx); b.st[0] = nloc; b.st[1] = nx; }
        const unsigned old = xb_add(&bar[XB_XSUB(b.x)], 1u);
        const unsigned gen = old / nloc;
        if (old + 1u == (gen + 1u) * nloc) {
            __builtin_amdgcn_fence(__ATOMIC_RELEASE, "agent");
            asm volatile("s_waitcnt vmcnt(0)" ::: "memory");
            const unsigned og = xb_add(&bar[XB_TOP], 1u);
            const unsigned tg = og / nx;
            if (og + 1u == (tg + 1u) * nx) xb_add(&bar[XB_TOPGEN], 1u);
            else XB_SPIN(xb_ld(&bar[XB_TOPGEN]) == tg, bar);
            __builtin_amdgcn_fence(__ATOMIC_ACQUIRE, "agent");
            xb_add(&bar[XB_XGEN(b.x)], 1u);
            asm volatile("s_waitcnt vmcnt(0)" ::: "memory");
        } else {
            XB_SPIN(xb_ld(&bar[XB_XGEN(b.x)]) == gen, bar);
            __builtin_amdgcn_fence(__ATOMIC_ACQUIRE, "agent");
            asm volatile("s_waitcnt vmcnt(0)" ::: "memory");
        }
    }
    __syncthreads();
}
struct ArgsH { const float* in[N_IN]; float* out; unsigned char* ws; double invf[44]; int ph_lo, ph_hi, li, pad; };
struct ArgsD { const GAS float* in[N_IN]; GAS float* out; GAS unsigned char* ws; double invf[44]; int ph_lo, ph_hi, li, pad; };
static_assert(sizeof(ArgsH) == sizeof(ArgsD), "args layout");
typedef const CAS ArgsD& ARef;
__device__ __forceinline__ const CAS ArgsD* kargs() {
#if defined(__HIP_DEVICE_COMPILE__)
    const CAS ArgsD* p = (const CAS ArgsD*)__builtin_amdgcn_kernarg_segment_ptr(); asm volatile("" : "+s"(p)); return p;
#else
    return nullptr;
#endif
}
struct WI { LAS unsigned char* lds; int tid, lane, wave, vcu, G, gw, NGW, bx; };
constexpr size_t RWA_STRIDE = 32 * MiB / 4;
constexpr size_t YO_STRIDE = 32 * MiB / 4;

__device__ __forceinline__ int wave_sum_i(int v) {
#pragma unroll
    for (int o = 1; o < 64; o <<= 1) v += __shfl_xor(v, o);
    return v;
}
__device__ __forceinline__ void sincos_d(double ang, float& s, float& c) {
    const double q = __builtin_rint(ang * 0.63661977236758134308);
    double r = __builtin_fma(-q, 1.57079632679489661923, ang); r = __builtin_fma(-q, 6.123233995736766e-17, r);
    const double r2 = r * r;
    const double sp = r * (1.0 + r2 * (-1.0 / 6 + r2 * (1.0 / 120 + r2 * (-1.0 / 5040 + r2 * (1.0 / 362880 + r2 * (-1.0 / 39916800 + r2 * (1.0 / 6227020800.0)))))));
    const double cp = 1.0 + r2 * (-0.5 + r2 * (1.0 / 24 + r2 * (-1.0 / 720 + r2 * (1.0 / 40320 + r2 * (-1.0 / 3628800 + r2 * (1.0 / 479001600 + r2 * (-1.0 / 87178291200.0)))))));
    const int qi = ((int)q) & 3;
    const double ss = (qi == 0) ? sp : (qi == 1) ? cp : (qi == 2) ? -sp : -cp;
    const double cc = (qi == 0) ? cp : (qi == 1) ? -sp : (qi == 2) ? -cp : sp;
    s = (float)ss; c = (float)cc;
}

__device__ __forceinline__ void tr_item(const float* W, int ldw, int nvalid, int k0, int nsrc0, bf16* WT, size_t dstrow0, LAS float* scr, int lane) {
#pragma unroll 8
    for (int i = 0; i < 32; ++i) { const int kk = 2 * i + (lane >> 5), c = lane & 31, n = nsrc0 + c; scr[kk * 33 + c] = (n < nvalid) ? W[(size_t)(k0 + kk) * ldw + n] : 0.0f; }
    LDS_WAIT(); asm volatile("" ::: "memory");
    const int c8 = lane & 7;
#pragma unroll
    for (int j = 0; j < 4; ++j) { const int n = (lane >> 3) + 8 * j; const LAS float* s = scr + (8 * c8) * 33 + n;
        v4u o; o.x = pk2(s[0 * 33], s[1 * 33]); o.y = pk2(s[2 * 33], s[3 * 33]); o.z = pk2(s[4 * 33], s[5 * 33]); o.w = pk2(s[6 * 33], s[7 * 33]);
        *(v4u*)(WT + (dstrow0 + n) * 1024 + k0 + 8 * c8) = o; }
    LDS_WAIT(); asm volatile("" ::: "memory");
}
__device__ __forceinline__ void ph_prologue(ARef A, const WI& w) {
    LAS float* sc = (LAS float*)w.lds;
    { const float* cin = A.in[I_C]; for (int i = w.tid; i < NB * DM; i += NWAVES * 64) { const float v = cin[i]; sc[i] = v / (1.0f + expf(-v)); } }
    __syncthreads();
    float* MOD = (float*)(A.ws + WS_MOD);
    if (w.wave == 0 && w.vcu < 192) {
        const int l = w.vcu / 96, col = (w.vcu % 96) * 64 + w.lane;
        const float* wp = A.in[I_ADAW] + (size_t)l * DM * 6144 + col;
        float acc[8];
#pragma unroll
        for (int b = 0; b < 8; ++b) acc[b] = 0.0f;
        for (int k = 0; k < DM; ++k) { const float wv = wp[(size_t)k * 6144];
#pragma unroll
            for (int b = 0; b < 8; ++b) acc[b] += sc[b * DM + k] * wv; }
        const float bias = A.in[I_ADAB][l * 6144 + col];
#pragma unroll
        for (int b = 0; b < 8; ++b) MOD[(size_t)(l * 8 + b) * 6144 + col] = acc[b] + bias;
    }
    LAS float* scr = (LAS float*)(w.lds + 32768 + w.wave * 8448);
    constexpr int I_IN = NLAYER * 16 * 96, I_OUT = NLAYER * 16 * 32, I_W1 = NLAYER * NEXP * 16 * 64, I_W2 = NLAYER * NEXP * 16 * 32, NIT = I_IN + I_OUT + I_W1 + I_W2;
    for (int it = w.gw; it < NIT; it += w.NGW) {
        int r = it;
        if (r < I_IN) { const int l = r / 1536, rr = r % 1536, kb = rr / 96, nb = rr % 96;
            tr_item(A.in[I_WIN] + (size_t)l * DM * INC, INC, INC, kb * 64, nb * 32, (bf16*)(A.ws + WS_WIN) + (size_t)l * INCP * DM, (size_t)nb * 32, scr, w.lane); continue; }
        r -= I_IN;
        if (r < I_OUT) { const int l = r / 512, rr = r % 512, kb = rr / 32, nb = rr % 32;
            tr_item(A.in[I_WOUT] + (size_t)l * DM * DM, DM, DM, kb * 64, nb * 32, (bf16*)(A.ws + WS_WOUT) + (size_t)l * DM * DM, (size_t)nb * 32, scr, w.lane); continue; }
        r -= I_OUT;
        if (r < I_W1) { const int le = r / 1024, rr = r % 1024, kb = rr / 64, nb = rr % 64, j = nb >> 3, bj = (nb >> 2) & 1, cc0 = (nb & 3) * 32;
            tr_item(A.in[I_MW1] + (size_t)le * DM * 2048, 2048, 2048, kb * 64, bj * 1024 + 128 * j + cc0, (bf16*)(A.ws + WS_W1) + (size_t)le * 2048 * DM, (size_t)nb * 32, scr, w.lane); continue; }
        r -= I_W1;
        { const int le = r / 512, rr = r % 512, kb = rr / 32, nb = rr % 32;
            tr_item(A.in[I_MW2] + (size_t)le * DM * DM, DM, DM, kb * 64, nb * 32, (bf16*)(A.ws + WS_W2) + (size_t)le * DM * DM, (size_t)nb * 32, scr, w.lane); }
    }
    float* RT = (float*)(A.ws + WS_ROPE); const int* pos = (const int*)A.in[I_POS];
    for (int g = w.gw * 64 + w.lane; g < MTOK * 44; g += w.NGW * 64) {
        const int tok = g / 44, f = g % 44; int co, so;
        if (f < 32) { co = f; so = 32 + f; } else if (f < 40) { co = 64 + (f - 32); so = 72 + (f - 32); } else { co = 80 + (f - 40); so = 84 + (f - 40); }
        float s, c; sincos_d((double)pos[tok] * A.invf[f], s, c);
        RT[(size_t)tok * ROPE_W + co] = c; RT[(size_t)tok * ROPE_W + so] = s;
    }
}

__device__ __forceinline__ void emit_h_row(const f32x4 (&v)[4], float rstd, const float* g, const float* sc, const float* sh, bf16* hrow, int lane) {
#pragma unroll
    for (int j = 0; j < 4; ++j) { const int k = 4 * (lane + 64 * j);
        const f32x4 gv = *(const f32x4*)(g + k), scv = *(const f32x4*)(sc + k), shv = *(const f32x4*)(sh + k);
        const f32x4 h = v[j] * rstd * gv * (1.0f + scv) + shv;
        v2u o; o.x = pk2(h.x, h.y); o.y = pk2(h.z, h.w); *(v2u*)(hrow + k) = o; }
}
__device__ __forceinline__ void ph_norm1(ARef A, const WI& w) {
    const float* MOD = (const float*)(A.ws + WS_MOD); bf16* H = (bf16*)(A.ws + WS_H);
    for (int m = w.gw; m < MTOK; m += w.NGW) {
        const float* xr = A.in[I_X] + (size_t)m * DM; f32x4 v[4]; float ss = 0.0f;
#pragma unroll
        for (int j = 0; j < 4; ++j) { v[j] = *(const f32x4*)(xr + 4 * (w.lane + 64 * j)); ss += dot4(v[j], v[j]); }
        ss = wave_sum(ss); const float rstd = 1.0f / sqrtf(ss * (1.0f / DM) + 1e-5f);
        const float* mb = MOD + (size_t)(m >> 12) * 6144;
        emit_h_row(v, rstd, A.in[I_NMIX], mb + 1024, mb, H + (size_t)m * DM, w.lane);
    }
}

__device__ __forceinline__ void rwkv_prep(ARef A, int l, int m, int lane) {
    const float* P = (const float*)(A.ws + WS_P); float* RWA = (float*)(A.ws + WS_RWA);
    const int t = m & (SEQ - 1), c4 = 4 * lane;
    const float* pr = P + (size_t)m * INCP + C_RW; const float* pp = pr - INCP; const float* mu = A.in[I_MU] + l * 896;
    f32x4 fr, fk, fv;
    { const f32x4 z = *(const f32x4*)(pr + c4), mm = *(const f32x4*)(mu + c4); f32x4 p = {0.f, 0.f, 0.f, 0.f}; if (t) p = *(const f32x4*)(pp + c4); fr = z + (p - z) * mm; }
    { const f32x4 z = *(const f32x4*)(pr + 256 + c4), mm = *(const f32x4*)(mu + 256 + c4); f32x4 p = {0.f, 0.f, 0.f, 0.f}; if (t) p = *(const f32x4*)(pp + 256 + c4); fk = z + (p - z) * mm; }
    { const f32x4 z = *(const f32x4*)(pr + 512 + c4), mm = *(const f32x4*)(mu + 512 + c4); f32x4 p = {0.f, 0.f, 0.f, 0.f}; if (t) p = *(const f32x4*)(pp + 512 + c4); fv = z + (p - z) * mm; }
    float x0, x1;
    { const float z = pr[768 + lane], p = t ? pp[768 + lane] : 0.0f; x0 = z + (p - z) * mu[768 + lane]; }
    { const float z = pr[832 + lane], p = t ? pp[832 + lane] : 0.0f; x1 = z + (p - z) * mu[832 + lane]; }
    x0 = (lane < 32) ? tanhf(x0) : x0; x1 = sigm(x1);
    f32x4 wacc = *(const f32x4*)(A.in[I_W0] + l * 256 + c4), aacc = *(const f32x4*)(A.in[I_A0] + l * 256 + c4), gacc = {0.f, 0.f, 0.f, 0.f};
    const float* w2 = A.in[I_W2] + l * 32 * 256 + c4; const float* a2 = A.in[I_A2] + l * 32 * 256 + c4; const float* g2 = A.in[I_G2] + l * 64 * 256 + c4;
#pragma unroll 8
    for (int i = 0; i < 32; ++i) { const float s = __shfl(x0, i); wacc += s * *(const f32x4*)(w2 + i * 256); }
#pragma unroll 8
    for (int i = 0; i < 32; ++i) { const float s = __shfl(x0, 32 + i); aacc += s * *(const f32x4*)(a2 + i * 256); }
#pragma unroll 8
    for (int i = 0; i < 64; ++i) { const float s = __shfl(x1, i); gacc += s * *(const f32x4*)(g2 + i * 256); }
    f32x4 dec, av;
#pragma unroll
    for (int i = 0; i < 4; ++i) { const float wl = -softplusf(-wacc[i]) - 0.5f; dec[i] = expf(-expf(wl)); av[i] = sigm(aacc[i]); }
    f32x4 kk = fk * *(const f32x4*)(A.in[I_KK] + l * 256 + c4);
    const float nrm = fmaxf(sqrtf(grp16_sum(dot4(kk, kk))), 1e-12f); kk = kk / nrm;
    const f32x4 kmod = fk * (1.0f + (av - 1.0f) * *(const f32x4*)(A.in[I_KA] + l * 256 + c4));
    const f32x4 bb = kk * av;
    const float bs = grp16_sum(dot4(fr * kmod, *(const f32x4*)(A.in[I_RK] + l * 256 + c4)));
    const size_t o = (size_t)m * 256 + c4;
    *(f32x4*)(RWA + 0 * RWA_STRIDE + o) = fr; *(f32x4*)(RWA + 1 * RWA_STRIDE + o) = dec; *(f32x4*)(RWA + 2 * RWA_STRIDE + o) = kmod; *(f32x4*)(RWA + 3 * RWA_STRIDE + o) = fv;
    *(f32x4*)(RWA + 4 * RWA_STRIDE + o) = -kk; *(f32x4*)(RWA + 5 * RWA_STRIDE + o) = bb; *(f32x4*)(RWA + 6 * RWA_STRIDE + o) = gacc; *(f32x4*)(RWA + 7 * RWA_STRIDE + o) = bs * fv;
}
__device__ __forceinline__ void dsa_prep(ARef A, int l, int m, int lane) {
    const float* P = (const float*)(A.ws + WS_P); const float* RT = (const float*)(A.ws + WS_ROPE) + (size_t)m * ROPE_W;
    const float* pd = P + (size_t)m * INCP + C_DSA; const int c4 = 4 * lane;
    float c0 = pd[lane], c1 = pd[64 + lane];
    const float rstd = 1.0f / sqrtf(wave_sum(c0 * c0 + c1 * c1) * (1.0f / 128.0f) + 1e-5f);
    c0 *= rstd * A.in[I_QNORM][l * 128 + lane]; c1 *= rstd * A.in[I_QNORM][l * 128 + 64 + lane];
    f32x4 q = {0.f, 0.f, 0.f, 0.f}, qi = {0.f, 0.f, 0.f, 0.f};
    const float* wq = A.in[I_WQ] + (size_t)l * 128 * 256 + c4; const float* wqi = A.in[I_WQI] + (size_t)l * 128 * 256 + c4;
#pragma unroll 8
    for (int i = 0; i < 64; ++i) { const float s = __shfl(c0, i); q += s * *(const f32x4*)(wq + i * 256); qi += s * *(const f32x4*)(wqi + i * 256); }
#pragma unroll 8
    for (int i = 0; i < 64; ++i) { const float s = __shfl(c1, i); q += s * *(const f32x4*)(wq + (64 + i) * 256); qi += s * *(const f32x4*)(wqi + (64 + i) * 256); }
    { const int r = lane & 15; const f32x4 ot = shx4(q, 2);
      if (r < 4) { const int fi = 4 * (r & 1); const f32x4 cs = *(const f32x4*)(RT + 64 + fi), sn = *(const f32x4*)(RT + 72 + fi); q = (r < 2) ? q * cs - ot * sn : ot * sn + q * cs; } }
    { const int r = lane & 7; const f32x4 ot = shx4(qi, 1);
      if (r < 2) { const f32x4 cs = *(const f32x4*)(RT + 80), sn = *(const f32x4*)(RT + 84); qi = (r < 1) ? qi * cs - ot * sn : ot * sn + qi * cs; } }
    { const f32x4 qs = q * 0.18033688011112042f; v2u o; o.x = pk2(qs.x, qs.y); o.y = pk2(qs.z, qs.w); *(v2u*)((bf16*)(A.ws + WS_DQ) + (size_t)m * 256 + c4) = o; }
    { typedef _Float16 h4 __attribute__((ext_vector_type(4))); h4 hq; hq.x = (_Float16)qi.x; hq.y = (_Float16)qi.y; hq.z = (_Float16)qi.z; hq.w = (_Float16)qi.w; *(h4*)((_Float16*)(A.ws + WS_DQI) + (size_t)m * 256 + c4) = hq; }
    { const int r = lane & 15; f32x4 kx = *(const f32x4*)(pd + 128 + 4 * r); const f32x4 ot = shx4(kx, 2);
      if (r < 4) { const int fi = 4 * (r & 1); const f32x4 cs = *(const f32x4*)(RT + 64 + fi), sn = *(const f32x4*)(RT + 72 + fi); kx = (r < 2) ? kx * cs - ot * sn : ot * sn + kx * cs; }
      if (lane < 16) { v2u o; o.x = pk2(kx.x, kx.y); o.y = pk2(kx.z, kx.w); *(v2u*)((bf16*)(A.ws + WS_DKB) + (size_t)m * 64 + c4) = o;
                       const f32x4 vx = *(const f32x4*)(pd + 192 + c4); v2u ov; ov.x = pk2(vx.x, vx.y); ov.y = pk2(vx.z, vx.w); *(v2u*)((bf16*)(A.ws + WS_DVB) + (size_t)m * 64 + c4) = ov; } }
    { const int r = lane & 7; f32x4 ki = *(const f32x4*)(pd + 256 + 4 * r); const f32x4 ot = shx4(ki, 1);
      if (r < 2) { const f32x4 cs = *(const f32x4*)(RT + 80), sn = *(const f32x4*)(RT + 84); ki = (r < 1) ? ki * cs - ot * sn : ot * sn + ki * cs; }
      if (lane < 8) { typedef _Float16 h4 __attribute__((ext_vector_type(4))); h4 hk; hk.x = (_Float16)ki.x; hk.y = (_Float16)ki.y; hk.z = (_Float16)ki.z; hk.w = (_Float16)ki.w; *(h4*)((_Float16*)(A.ws + WS_DKI) + (size_t)m * 32 + c4) = hk; }
      if (lane < 2) *(f32x4*)((float*)(A.ws + WS_DW) + (size_t)m * 8 + c4) = *(const f32x4*)(pd + 288 + c4) * 0.0625f; }
}

__device__ __forceinline__ void sb_prep(ARef A, int m, int lane) {
    const float* ps = (const float*)(A.ws + WS_P) + (size_t)m * INCP + C_SB + 4 * lane;
    const f32x4 q = *(const f32x4*)ps * 0.18033688011112042f, k = *(const f32x4*)(ps + 256), v = *(const f32x4*)(ps + 512);
    v2u o; o.x = pk2(q.x, q.y); o.y = pk2(q.z, q.w); *(v2u*)((bf16*)(A.ws + WS_SQ) + (size_t)m * 256 + 4 * lane) = o;
    o.x = pk2(k.x, k.y); o.y = pk2(k.z, k.w); *(v2u*)((bf16*)(A.ws + WS_SK) + (size_t)m * 256 + 4 * lane) = o;
    o.x = pk2(v.x, v.y); o.y = pk2(v.z, v.w); *(v2u*)((bf16*)(A.ws + WS_SV) + (size_t)m * 256 + 4 * lane) = o;
}

__device__ __forceinline__ float quad_sum(float v) {
    v += __builtin_bit_cast(float, __builtin_amdgcn_mov_dpp(__builtin_bit_cast(int, v), 0xB1, 0xF, 0xF, true));
    v += __builtin_bit_cast(float, __builtin_amdgcn_mov_dpp(__builtin_bit_cast(int, v), 0x4E, 0xF, 0xF, true));
    return v;
}
__device__ __forceinline__ void scan_rwkv_task(ARef A, const WI& w, int task) {
    const int bh = task >> 4, c = task & 15, b = bh >> 2, h = bh & 3;
    LAS float* sw = (LAS float*)w.lds; LAS float* sn = sw + 2048; LAS float* sb = sn + 2048; LAS float* sk = sb + 2048; LAS float* sr = sk + 2048; LAS float* sv = sr + 2048; LAS float* so = sv + 2048;
    const float* RWA = (const float*)(A.ws + WS_RWA);
    const int row = w.tid >> 2, kq = w.tid & 3;
    float S[16];
#pragma unroll
    for (int j = 0; j < 16; ++j) S[j] = (row >= 64 && 16 * kq + j == row - 64) ? 1.0f : 0.0f;
    const size_t tok0 = (size_t)b * SEQ + (size_t)c * TCH;
    const int st = w.tid >> 4, sd = (w.tid & 15) * 4;
    for (int sub = 0; sub < TCH / 32; ++sub) {
        const size_t o = (tok0 + sub * 32 + st) * 256 + h * 64 + sd;
        const f32x4 a0 = *(const f32x4*)(RWA + 1 * RWA_STRIDE + o), a1 = *(const f32x4*)(RWA + 4 * RWA_STRIDE + o), a2 = *(const f32x4*)(RWA + 5 * RWA_STRIDE + o);
        const f32x4 a3 = *(const f32x4*)(RWA + 2 * RWA_STRIDE + o), a4 = *(const f32x4*)(RWA + 0 * RWA_STRIDE + o), a5 = *(const f32x4*)(RWA + 3 * RWA_STRIDE + o);
        __syncthreads();
        { const int lo = st * 64 + sd; *(LAS f32x4*)(sw + lo) = a0; *(LAS f32x4*)(sn + lo) = a1; *(LAS f32x4*)(sb + lo) = a2; *(LAS f32x4*)(sk + lo) = a3; *(LAS f32x4*)(sr + lo) = a4; *(LAS f32x4*)(sv + lo) = a5; }
        __syncthreads();
        for (int s = 0; s < 32; ++s) {
            const int lo = s * 64 + kq * 16;
            const float vv = (row < 64) ? sv[s * 64 + row] : 0.0f;
            float sa = 0.0f;
#pragma unroll
            for (int j4 = 0; j4 < 4; ++j4) { const f32x4 n = *(const LAS f32x4*)(sn + lo + 4 * j4); sa += (S[4 * j4] * n.x + S[4 * j4 + 1] * n.y) + (S[4 * j4 + 2] * n.z + S[4 * j4 + 3] * n.w); }
            sa = quad_sum(sa);
            float y = 0.0f;
#pragma unroll
            for (int j4 = 0; j4 < 4; ++j4) { const f32x4 wv = *(const LAS f32x4*)(sw + lo + 4 * j4), bv = *(const LAS f32x4*)(sb + lo + 4 * j4), kv = *(const LAS f32x4*)(sk + lo + 4 * j4), rv = *(const LAS f32x4*)(sr + lo + 4 * j4);
                S[4 * j4] = S[4 * j4] * wv.x + (sa * bv.x + vv * kv.x); S[4 * j4 + 1] = S[4 * j4 + 1] * wv.y + (sa * bv.y + vv * kv.y);
                S[4 * j4 + 2] = S[4 * j4 + 2] * wv.z + (sa * bv.z + vv * kv.z); S[4 * j4 + 3] = S[4 * j4 + 3] * wv.w + (sa * bv.w + vv * kv.w);
                y += (S[4 * j4] * rv.x + S[4 * j4 + 1] * rv.y) + (S[4 * j4 + 2] * rv.z + S[4 * j4 + 3] * rv.w); }
            y = quad_sum(y);
            if (kq == 0) so[s * 128 + row] = y;
        }
        __syncthreads();
        { const int fs = w.tid >> 4, c8 = (w.tid & 15) * 8; const f32x4 x0 = *(const LAS f32x4*)(so + fs * 128 + c8), x1 = *(const LAS f32x4*)(so + fs * 128 + c8 + 4);
          float* dst = (c8 < 64) ? ((float*)(A.ws + WS_YO) + YO_STRIDE) : ((float*)(A.ws + WS_PT) - 64);
          float* dp = dst + (tok0 + sub * 32 + fs) * 256 + h * 64 + c8; *(f32x4*)dp = x0; *(f32x4*)(dp + 4) = x1; }
    }
    { float* ch = (float*)(A.ws + WS_CH) + ((size_t)(bh * NCH + c) * 128 + row) * 64 + 16 * kq;
#pragma unroll
      for (int j4 = 0; j4 < 4; ++j4) *(f32x4*)(ch + 4 * j4) = (f32x4){S[4 * j4], S[4 * j4 + 1], S[4 * j4 + 2], S[4 * j4 + 3]}; }
    __syncthreads();
}
__device__ __forceinline__ void scan_ret_task(ARef A, const WI& w, int task) {
    const int bh = task >> 3, cp = task & 7, b = bh >> 2, h = bh & 3, un = w.tid >> 8, lt = w.tid & 255, c = 2 * cp + un;
    const float lg2g = log2f(1.0f - exp2f(-5.0f - (float)h)), gamma = exp2f(lg2g);
    LAS float* sk = (LAS float*)w.lds + un * 8192; LAS float* sq = sk + 2048; LAS float* sv = sq + 2048; LAS float* so = sv + 2048;
    const float* P = (const float*)(A.ws + WS_P); const float* RT = (const float*)(A.ws + WS_ROPE);
    const int row = lt >> 2, kq = lt & 3;
    float S[16];
#pragma unroll
    for (int j = 0; j < 16; ++j) S[j] = 0.0f;
    const size_t tok0 = (size_t)b * SEQ + (size_t)c * TCH;
    const int st = lt >> 3, sd = (lt & 7) * 8;
    for (int sub = 0; sub < TCH / 32; ++sub) {
        const size_t m = tok0 + sub * 32 + st; const float* pr = P + m * INCP + C_RET + h * 64; const float* rt = RT + m * ROPE_W; const int fi = sd & 31, dp = sd ^ 32;
        f32x4 qn[2], kn[2], vn[2];
#pragma unroll
        for (int u = 0; u < 2; ++u) { const f32x4 cs = *(const f32x4*)(rt + fi + 4 * u), sn = *(const f32x4*)(rt + 32 + fi + 4 * u);
            const f32x4 qm = *(const f32x4*)(pr + sd + 4 * u), qo = *(const f32x4*)(pr + dp + 4 * u), km = *(const f32x4*)(pr + 256 + sd + 4 * u), ko = *(const f32x4*)(pr + 256 + dp + 4 * u);
            qn[u] = (sd < 32) ? qm * cs - qo * sn : qo * sn + qm * cs; kn[u] = ((sd < 32) ? km * cs - ko * sn : ko * sn + km * cs) * 0.125f; vn[u] = *(const f32x4*)(pr + 512 + sd + 4 * u); }
        { const float gt = exp2f(lg2g * (float)(sub * 32 + st + 1)); const f32x4 p0 = qn[0] * gt, p1 = qn[1] * gt;
          v4u pw; pw.x = pk2(p0.x, p0.y); pw.y = pk2(p0.z, p0.w); pw.z = pk2(p1.x, p1.y); pw.w = pk2(p1.z, p1.w); *(v4u*)((bf16*)(A.ws + WS_PTR) + m * 256 + h * 64 + sd) = pw; }
        __syncthreads();
        { const int lo = st * 64 + sd; *(LAS f32x4*)(sq + lo) = qn[0]; *(LAS f32x4*)(sq + lo + 4) = qn[1]; *(LAS f32x4*)(sk + lo) = kn[0]; *(LAS f32x4*)(sk + lo + 4) = kn[1]; *(LAS f32x4*)(sv + lo) = vn[0]; *(LAS f32x4*)(sv + lo + 4) = vn[1]; }
        __syncthreads();
        for (int s = 0; s < 32; ++s) {
            const int lo = s * 64 + kq * 16; const float vv = sv[s * 64 + row]; float y = 0.0f;
#pragma unroll
            for (int j4 = 0; j4 < 4; ++j4) { const f32x4 kv = *(const LAS f32x4*)(sk + lo + 4 * j4), rv = *(const LAS f32x4*)(sq + lo + 4 * j4);
                S[4 * j4] = S[4 * j4] * gamma + vv * kv.x; S[4 * j4 + 1] = S[4 * j4 + 1] * gamma + vv * kv.y; S[4 * j4 + 2] = S[4 * j4 + 2] * gamma + vv * kv.z; S[4 * j4 + 3] = S[4 * j4 + 3] * gamma + vv * kv.w;
                y += (S[4 * j4] * rv.x + S[4 * j4 + 1] * rv.y) + (S[4 * j4 + 2] * rv.z + S[4 * j4 + 3] * rv.w); }
            y = quad_sum(y);
            if (kq == 0) so[s * 64 + row] = y;
        }
        __syncthreads();
        { const int fs = lt >> 3, c8 = (lt & 7) * 8; float* dp2 = (float*)(A.ws + WS_YO) + (tok0 + sub * 32 + fs) * 256 + h * 64 + c8;
          *(f32x4*)dp2 = *(const LAS f32x4*)(so + fs * 64 + c8); *(f32x4*)(dp2 + 4) = *(const LAS f32x4*)(so + fs * 64 + c8 + 4); }
    }
    { float* ch = (float*)(A.ws + WS_CHR) + ((size_t)(bh * NCH + c) * 64 + row) * 64 + 16 * kq;
#pragma unroll
      for (int j4 = 0; j4 < 4; ++j4) *(f32x4*)(ch + 4 * j4) = (f32x4){S[4 * j4], S[4 * j4 + 1], S[4 * j4 + 2], S[4 * j4 + 3]}; }
    __syncthreads();
}
__device__ __forceinline__ void prefix_chain(ARef A, const WI& w, int bh) {
    LAS float* s0 = (LAS float*)w.lds;
    const int v = w.tid >> 3, k8 = (w.tid & 7) * 8;
    const float* CH = (const float*)(A.ws + WS_CH) + (size_t)bh * NCH * 128 * 64; float* SI = (float*)(A.ws + WS_SI) + (size_t)bh * NCH * 64 * 64;
    f32x4 c0 = {0.f, 0.f, 0.f, 0.f}, c1 = {0.f, 0.f, 0.f, 0.f};
    for (int c = 0; c < NCH; ++c) {
        *(f32x4*)(SI + ((size_t)c * 64 + v) * 64 + k8) = c0; *(f32x4*)(SI + ((size_t)c * 64 + v) * 64 + k8 + 4) = c1;
        if (c == NCH - 1) break;
        __syncthreads();
        *(LAS f32x4*)(s0 + v * 68 + k8) = c0; *(LAS f32x4*)(s0 + v * 68 + k8 + 4) = c1;
        __syncthreads();
        const float* ch = CH + (size_t)c * 128 * 64;
        f32x4 n0 = *(const f32x4*)(ch + (size_t)v * 64 + k8), n1 = *(const f32x4*)(ch + (size_t)v * 64 + k8 + 4);
#pragma unroll 8
        for (int kp = 0; kp < 64; ++kp) { const float s = s0[v * 68 + kp]; const float* pr = ch + (size_t)(64 + kp) * 64 + k8; n0 += s * *(const f32x4*)pr; n1 += s * *(const f32x4*)(pr + 4); }
        c0 = n0; c1 = n1;
    }
    const int h = bh & 3; const float gT = exp2f((float)TCH * log2f(1.0f - exp2f(-5.0f - (float)h)));
    const float* CHR = (const float*)(A.ws + WS_CHR) + (size_t)bh * NCH * 64 * 64; float* SIR = (float*)(A.ws + WS_SIR) + (size_t)bh * NCH * 64 * 64;
    c0 = (f32x4){0.f, 0.f, 0.f, 0.f}; c1 = c0;
    for (int c = 0; c < NCH; ++c) {
        *(f32x4*)(SIR + ((size_t)c * 64 + v) * 64 + k8) = c0; *(f32x4*)(SIR + ((size_t)c * 64 + v) * 64 + k8 + 4) = c1;
        if (c == NCH - 1) break;
        c0 = c0 * gT + *(const f32x4*)(CHR + ((size_t)c * 64 + v) * 64 + k8); c1 = c1 * gT + *(const f32x4*)(CHR + ((size_t)c * 64 + v) * 64 + k8 + 4);
    }
    __syncthreads();
}
typedef float f32x16 __attribute__((ext_vector_type(16)));
constexpr int SBV_PITCH = 144;
__device__ __forceinline__ float lane32_swap(float v) { return __shfl_xor(v, 32); }
__device__ __forceinline__ void sb_tile_mfma(ARef A, int unit, int lane, LAS unsigned char* vl) {
    const int tq = unit & 127, bh = unit >> 7, b = bh >> 2, h = bh & 3, t0 = tq * 32, r32 = lane & 31, hi = lane >> 5;
    const float* PS = (const float*)(A.ws + WS_P) + (size_t)b * SEQ * INCP + C_SB + h * 64;
    bf16x8v qf[4];
#pragma unroll
    for (int ks = 0; ks < 4; ++ks) { const float* qp = PS + (size_t)(t0 + r32) * INCP + 16 * ks + 8 * hi; const f32x4 x = *(const f32x4*)qp * 0.18033688011112042f, y = *(const f32x4*)(qp + 4) * 0.18033688011112042f;
        pg8::u32x4 wv; wv.x = pk2(x.x, x.y); wv.y = pk2(x.z, x.w); wv.z = pk2(y.x, y.y); wv.w = pk2(y.z, y.w); qf[ks] = __builtin_bit_cast(bf16x8v, wv); }
    f32x16 o0, o1;
#pragma unroll
    for (int r = 0; r < 16; ++r) { o0[r] = 0.0f; o1[r] = 0.0f; }
    float carry = 0.0f;
    const int g16 = lane >> 4, tj = (lane & 15) >> 2, tc = lane & 3;
    for (int kb0 = t0; kb0 >= 0; kb0 -= 32) {
#pragma unroll
        for (int i = 0; i < 4; ++i) { const int p = lane + 64 * i, row = p >> 3, ch = p & 7; const float* vp = PS + 512 + (size_t)(kb0 + row) * INCP + 8 * ch; const f32x4 x = *(const f32x4*)vp, y = *(const f32x4*)(vp + 4);
            v4u v; v.x = pk2(x.x, x.y); v.y = pk2(x.z, x.w); v.z = pk2(y.x, y.y); v.w = pk2(y.z, y.w); *(LAS v4u*)(vl + row * SBV_PITCH + 16 * ch) = v; }
        f32x16 st;
#pragma unroll
        for (int r = 0; r < 16; ++r) st[r] = 0.0f;
#pragma unroll
        for (int ks = 0; ks < 4; ++ks) { const float* kp = PS + 256 + (size_t)(kb0 + r32) * INCP + 16 * ks + 8 * hi; const f32x4 x = *(const f32x4*)kp, y = *(const f32x4*)(kp + 4);
            pg8::u32x4 wv; wv.x = pk2(x.x, x.y); wv.y = pk2(x.z, x.w); wv.z = pk2(y.x, y.y); wv.w = pk2(y.z, y.w); st = __builtin_amdgcn_mfma_f32_32x32x16_bf16(__builtin_bit_cast(bf16x8v, wv), qf[ks], st, 0, 0, 0); }
        float sp[16]; const bool diag = (kb0 == t0);
#pragma unroll
        for (int r = 0; r < 16; ++r) { const float zl = st[r]; float s = (zl > 30.0f) ? zl : __builtin_amdgcn_logf(1.0f + __builtin_amdgcn_exp2f(zl));
            if (diag && ((r & 3) + 8 * (r >> 2) + 4 * hi >= r32)) s = 0.0f;
            sp[r] = s; }
        float G[4], Gp[4], suf[4];
#pragma unroll
        for (int q = 0; q < 4; ++q) { G[q] = (sp[4 * q] + sp[4 * q + 1]) + (sp[4 * q + 2] + sp[4 * q + 3]); Gp[q] = lane32_swap(G[q]); }
        suf[3] = 0.0f; suf[2] = G[3] + Gp[3]; suf[1] = suf[2] + (G[2] + Gp[2]); suf[0] = suf[1] + (G[1] + Gp[1]);
        const float tot = suf[0] + (G[0] + Gp[0]);
        pg8::u32x4 pw0, pw1;
        float av[16];
#pragma unroll
        for (int q = 0; q < 4; ++q) { float run = carry + suf[q] + (hi == 0 ? Gp[q] : 0.0f);
#pragma unroll
            for (int i = 3; i >= 0; --i) { const int r = 4 * q + i; const float la = (st[r] - sp[r]) - run; float a = __builtin_amdgcn_exp2f(la);
                if (diag && ((r & 3) + 8 * (r >> 2) + 4 * hi >= r32)) a = 0.0f;
                av[r] = a; run += sp[r]; } }
        pw0.x = pg8::cvt_pk_bf16(av[0], av[1]); pw0.y = pg8::cvt_pk_bf16(av[2], av[3]); pw0.z = pg8::cvt_pk_bf16(av[4], av[5]); pw0.w = pg8::cvt_pk_bf16(av[6], av[7]);
        pw1.x = pg8::cvt_pk_bf16(av[8], av[9]); pw1.y = pg8::cvt_pk_bf16(av[10], av[11]); pw1.z = pg8::cvt_pk_bf16(av[12], av[13]); pw1.w = pg8::cvt_pk_bf16(av[14], av[15]);
        const bf16x8v pa0 = __builtin_bit_cast(bf16x8v, pw0), pa1 = __builtin_bit_cast(bf16x8v, pw1);
        LDS_WAIT();
#pragma unroll
        for (int s = 0; s < 2; ++s)
#pragma unroll
            for (int nb = 0; nb < 2; ++nb) {
                LAS unsigned char* a1 = vl + (16 * s + 4 * (g16 >> 1) + tj) * SBV_PITCH + (32 * nb + 16 * (g16 & 1) + 4 * tc) * 2;
                const s16x4v r1 = __builtin_bit_cast(s16x4v, __builtin_amdgcn_ds_read_tr16_b64_v4i16((LAS s16x4v*)a1));
                const s16x4v r2 = __builtin_bit_cast(s16x4v, __builtin_amdgcn_ds_read_tr16_b64_v4i16((LAS s16x4v*)(a1 + 8 * SBV_PITCH)));
                const bf16x8v bv = {r1[0], r1[1], r1[2], r1[3], r2[0], r2[1], r2[2], r2[3]};
                if (nb == 0) o0 = __builtin_amdgcn_mfma_f32_32x32x16_bf16(s ? pa1 : pa0, bv, o0, 0, 0, 0); else o1 = __builtin_amdgcn_mfma_f32_32x32x16_bf16(s ? pa1 : pa0, bv, o1, 0, 0, 0); }
        LDS_WAIT();
        carry += tot;
        if (__all(carry > 150.0f)) break;
    }
    float* YS = (float*)(A.ws + WS_YO) + 3 * YO_STRIDE + ((size_t)b * SEQ + t0) * 256 + h * 64 + r32;
#pragma unroll
    for (int r = 0; r < 16; ++r) { const int qo = (r & 3) + 8 * (r >> 2) + 4 * hi; YS[(size_t)qo * 256] = o0[r]; YS[(size_t)qo * 256 + 32] = o1[r]; }
}

typedef _Float16 f16x8 __attribute__((ext_vector_type(8)));
__device__ __forceinline__ void dsa_scores_mfma(ARef A, const WI& w) {
    const _Float16* QIH = (const _Float16*)(A.ws + WS_DQI); const _Float16* KIH = (const _Float16*)(A.ws + WS_DKI);
    const float* DW = (const float*)(A.ws + WS_DW); float* SC = (float*)(A.ws + WS_SC);
    const int col = w.lane & 15, q4 = w.lane >> 4;
    for (int u = w.gw; u < 2048; u += w.NGW) {
        const int pi = u >> 1, par = u & 1, b = pi >> 7, p = pi & 127;
#pragma unroll 1
        for (int side = 0; side < 2; ++side) {
            const int qb = side ? 255 - p : p; const size_t m0 = (size_t)b * SEQ + 16 * qb;
            f16x8 bq[8];
#pragma unroll
            for (int h = 0; h < 8; ++h) bq[h] = *(const f16x8*)(QIH + (m0 + col) * 256 + h * 32 + 8 * q4);
            const float* dw = DW + (m0 + col) * 8; const f32x4 wa = *(const f32x4*)dw, wb = *(const f32x4*)(dw + 4);
            float* srow = SC + (m0 + col) * SEQ + 4 * q4;
            const _Float16* kbase = KIH + ((size_t)b * SEQ + col) * 32 + 8 * q4;
            for (int kb = par; kb <= qb; kb += 2) {
                const f16x8 ak = *(const f16x8*)(kbase + (size_t)kb * 16 * 32);
                f32x4 acc = {0.f, 0.f, 0.f, 0.f};
#pragma unroll
                for (int h = 0; h < 8; ++h) { const f32x4 c = __builtin_amdgcn_mfma_f32_16x16x32_f16(ak, bq[h], (f32x4){0.f, 0.f, 0.f, 0.f}, 0, 0, 0); const float wv = (h < 4) ? wa[h] : wb[h - 4];
                    acc.x += wv * fmaxf(c.x, 0.f); acc.y += wv * fmaxf(c.y, 0.f); acc.z += wv * fmaxf(c.z, 0.f); acc.w += wv * fmaxf(c.w, 0.f); }
                *(f32x4*)(srow + 16 * kb) = acc + 0.0f;
            }
        }
    }
}

__device__ __forceinline__ int wave_total_i(int v) {
    v += __builtin_amdgcn_mov_dpp(v, 0xB1, 0xF, 0xF, true);
    v += __builtin_amdgcn_mov_dpp(v, 0x4E, 0xF, 0xF, true);
    v += __builtin_amdgcn_mov_dpp(v, 0x141, 0xF, 0xF, true);
    v += __builtin_amdgcn_mov_dpp(v, 0x140, 0xF, 0xF, true);
    return __builtin_amdgcn_readlane(v, 0) + __builtin_amdgcn_readlane(v, 16) + __builtin_amdgcn_readlane(v, 32) + __builtin_amdgcn_readlane(v, 48);
}
__device__ __forceinline__ unsigned score_key(float f) { const unsigned bits = __float_as_uint(f); return (bits & 0x80000000u) ? ~bits : (bits | 0x80000000u); }
constexpr int VST_PITCH = 144;
__device__ __forceinline__ void dsa_row_mfma(ARef A, int m, int lane, LAS unsigned char* wl) {
    LAS int* slist = (LAS int*)wl;
    LAS unsigned char* vst = wl + 1024;
    const int b = m >> 12, t = m & (SEQ - 1), n = t + 1, col = lane & 15, q4 = lane >> 4;
    const float* sc = (const float*)(A.ws + WS_SC) + (size_t)m * SEQ;
    int nsel;
    if (n <= 256) {
#pragma unroll
        for (int c = 0; c < 4; ++c) { const int idx = lane + 64 * c; slist[idx] = (idx < n) ? idx : 0; }
        nsel = n;
    } else {
        unsigned u[64];
        { f32x4 sv[16];
#pragma unroll
          for (int j4 = 0; j4 < 16; ++j4) sv[j4] = *(const f32x4*)(sc + ((256 * j4 < n) ? 256 * j4 : 0) + 4 * lane);
#pragma unroll
          for (int j4 = 0; j4 < 16; ++j4)
#pragma unroll
              for (int i = 0; i < 4; ++i) u[4 * j4 + i] = (256 * j4 + 4 * lane + i < n) ? score_key(sv[j4][i]) : 0u; }
        unsigned T = 0u;
        for (int bit = 31; bit >= 16; --bit) { const unsigned cand = T | (1u << bit); int cnt = 0;
#pragma unroll
            for (int j = 0; j < 64; ++j) cnt += (u[j] >= cand) ? 1 : 0;
            if (wave_total_i(cnt) >= 256) T = cand; }
        unsigned long long bkb = 0ull; int chi = 0;
#pragma unroll
        for (int j = 0; j < 64; ++j) { bkb |= (unsigned long long)(((u[j] >> 16) == (T >> 16)) ? 1u : 0u) << j; chi += ((u[j] >> 16) > (T >> 16)) ? 1 : 0; }
        const int cb = wave_total_i(__popcll(bkb)), need = 256 - wave_total_i(chi);
        if (cb <= 64) {
            int pos = __popcll(bkb);
            { const int mine_ = pos;
#pragma unroll
              for (int d = 1; d < 64; d <<= 1) { const int y = __shfl_up(pos, d); if (lane >= d) pos += y; }
              pos -= mine_; }
            LAS unsigned* bk = (LAS unsigned*)vst;
            { unsigned long long bb = bkb;
#pragma unroll
              for (int j = 0; j < 64; ++j) { if ((bb >> j) & 1ull) { bk[pos] = u[j]; ++pos; } } }
            LDS_WAIT();
            const unsigned kx = (lane < cb) ? bk[lane] : 0u;
            for (int bit = 15; bit >= 0; --bit) { const unsigned cand = T | (1u << bit); if (__popcll(__ballot(kx >= cand)) >= need) T = cand; }
            LDS_WAIT();
        } else {
            for (int bit = 15; bit >= 0; --bit) { const unsigned cand = T | (1u << bit); int cnt = 0;
#pragma unroll
                for (int j = 0; j < 64; ++j) cnt += (u[j] >= cand) ? 1 : 0;
                if (wave_total_i(cnt) >= 256) T = cand; }
        }
        unsigned long long gtb = 0ull, eqb = 0ull;
#pragma unroll
        for (int j = 0; j < 64; ++j) { gtb |= (unsigned long long)((u[j] > T) ? 1u : 0u) << j; eqb |= (unsigned long long)((u[j] == T) ? 1u : 0u) << j; }
        const int tgt = wave_total_i(__popcll(gtb)), teq = wave_total_i(__popcll(eqb));
        unsigned long long selb = gtb | eqb;
        if (tgt + teq > 256) {
            const int take = 256 - tgt; int lo = 0;
            for (int bit = 11; bit >= 0; --bit) { const int cand = lo | (1 << bit); const int J4 = cand >> 8; int ni = (cand & 255) - 4 * lane; ni = ni < 0 ? 0 : (ni > 4 ? 4 : ni);
                const int jc = 4 * J4 + ni; const unsigned long long msk = (jc >= 64) ? ~0ull : ((1ull << jc) - 1ull);
                if (wave_total_i(__popcll(eqb & msk)) < take) lo = cand; }
            { const int cand = lo + 1; const int J4 = cand >> 8; int ni = (cand & 255) - 4 * lane; ni = ni < 0 ? 0 : (ni > 4 ? 4 : ni);
              const int jc = (cand >= SEQ) ? 64 : 4 * J4 + ni; const unsigned long long msk = (jc >= 64) ? ~0ull : ((1ull << jc) - 1ull); selb = gtb | (eqb & msk); }
        }
        const int mine = __popcll(selb); int off = mine;
#pragma unroll
        for (int d = 1; d < 64; d <<= 1) { const int y = __shfl_up(off, d); if (lane >= d) off += y; }
        off -= mine;
        while (selb) { const int j = __builtin_ctzll(selb); selb &= selb - 1ull; slist[off] = 256 * (j >> 2) + 4 * lane + (j & 3); ++off; }
        nsel = 256;
    }
    LDS_WAIT();
    const bf16* DKB = (const bf16*)(A.ws + WS_DKB) + (size_t)b * SEQ * 64; const bf16* DVB = (const bf16*)(A.ws + WS_DVB) + (size_t)b * SEQ * 64;
    bf16x8v bq0 = {0, 0, 0, 0, 0, 0, 0, 0}, bq1 = {0, 0, 0, 0, 0, 0, 0, 0};
    if (col < 4) { const bf16* qp = (const bf16*)(A.ws + WS_DQ) + (size_t)m * 256 + col * 64 + 8 * q4; bq0 = *(const bf16x8v*)qp; bq1 = *(const bf16x8v*)(qp + 32); }
    f32x4 lg[16];
#pragma unroll
    for (int kb = 0; kb < 16; ++kb) { const int s = slist[16 * kb + col]; const bf16* kr = DKB + (size_t)s * 64 + 8 * q4;
        const bf16x8v a0 = *(const bf16x8v*)kr, a1 = *(const bf16x8v*)(kr + 32);
        f32x4 c = __builtin_amdgcn_mfma_f32_16x16x32_bf16(a0, bq0, (f32x4){0.f, 0.f, 0.f, 0.f}, 0, 0, 0);
        lg[kb] = __builtin_amdgcn_mfma_f32_16x16x32_bf16(a1, bq1, c, 0, 0, 0); }
    if (nsel < 256) {
#pragma unroll
        for (int kb = 0; kb < 16; ++kb)
#pragma unroll
            for (int r = 0; r < 4; ++r) if (16 * kb + 4 * q4 + r >= nsel) lg[kb][r] = -INFINITY; }
    float mx = -INFINITY;
#pragma unroll
    for (int kb = 0; kb < 16; ++kb) mx = fmaxf(fmaxf(mx, fmaxf(lg[kb].x, lg[kb].y)), fmaxf(lg[kb].z, lg[kb].w));
    mx = fmaxf(mx, __shfl_xor(mx, 16)); mx = fmaxf(mx, __shfl_xor(mx, 32));
    float sm = 0.f;
#pragma unroll
    for (int kb = 0; kb < 16; ++kb) { lg[kb].x = exp2f(lg[kb].x - mx); lg[kb].y = exp2f(lg[kb].y - mx); lg[kb].z = exp2f(lg[kb].z - mx); lg[kb].w = exp2f(lg[kb].w - mx); sm += (lg[kb].x + lg[kb].y) + (lg[kb].z + lg[kb].w); }
    sm += __shfl_xor(sm, 16); sm += __shfl_xor(sm, 32);
    const float inv = 1.0f / sm;
    bf16x8v pa[8];
#pragma unroll
    for (int i = 0; i < 8; ++i) { const f32x4 x = lg[2 * i] * inv, y = lg[2 * i + 1] * inv;
        pg8::u32x4 wv; wv.x = pg8::cvt_pk_bf16(x.x, x.y); wv.y = pg8::cvt_pk_bf16(x.z, x.w); wv.z = pg8::cvt_pk_bf16(y.x, y.y); wv.w = pg8::cvt_pk_bf16(y.z, y.w);
        pa[i] = __builtin_bit_cast(bf16x8v, wv); }
    f32x4 o[4];
#pragma unroll
    for (int nb = 0; nb < 4; ++nb) o[nb] = (f32x4){0.f, 0.f, 0.f, 0.f};
    const int srow = lane >> 3, spc = lane & 7, tj = col >> 2, tc = col & 3;
#pragma unroll
    for (int c = 0; c < 4; ++c) {
#pragma unroll
        for (int i = 0; i < 8; ++i) { const int s = slist[64 * c + srow + 8 * i]; const v4u v = *(const v4u*)(DVB + (size_t)s * 64 + 8 * spc); *(LAS v4u*)(vst + (srow + 8 * i) * VST_PITCH + 16 * spc) = v; }
        LDS_WAIT();
#pragma unroll
        for (int k2 = 0; k2 < 2; ++k2)
#pragma unroll
            for (int nb = 0; nb < 4; ++nb) {
                LAS unsigned char* a1 = vst + (32 * k2 + 4 * q4 + tj) * VST_PITCH + (16 * nb + 4 * tc) * 2;
                const s16x4v r1 = __builtin_bit_cast(s16x4v, __builtin_amdgcn_ds_read_tr16_b64_v4i16((LAS s16x4v*)a1));
                const s16x4v r2 = __builtin_bit_cast(s16x4v, __builtin_amdgcn_ds_read_tr16_b64_v4i16((LAS s16x4v*)(a1 + 16 * VST_PITCH)));
                const bf16x8v bv = {r1[0], r1[1], r1[2], r1[3], r2[0], r2[1], r2[2], r2[3]};
                o[nb] = __builtin_amdgcn_mfma_f32_16x16x32_bf16(pa[2 * c + k2], bv, o[nb], 0, 0, 0); }
        LDS_WAIT();
    }
    if (lane < 16) { float* YD = (float*)(A.ws + WS_YO) + 2 * YO_STRIDE + (size_t)m * 256;
#pragma unroll
        for (int nb = 0; nb < 4; ++nb) { YD[16 * nb + lane] = o[nb].x; YD[64 + 16 * nb + lane] = o[nb].y; YD[128 + 16 * nb + lane] = o[nb].z; YD[192 + 16 * nb + lane] = o[nb].w; } }
}

__device__ __forceinline__ f32x4 head_norm4(f32x4 y, float eps, f32x4 g) {
    const float mean = grp16_sum(sum4(y)) * (1.0f / 64.0f); const f32x4 yc = y - mean;
    const float var = grp16_sum(dot4(yc, yc)) * (1.0f / 64.0f); return yc * (1.0f / sqrtf(var + eps)) * g;
}
template <bool BF> __device__ __forceinline__ f32x4 state_corr(const LAS float* sl, int hh, int r16, const void* pv) {
    const LAS float* r0 = sl + (hh * 64 + 4 * r16) * 64; const int x0 = (4 * r16) & 15;
    f32x4 out = {0.f, 0.f, 0.f, 0.f};
#pragma unroll 2
    for (int k8 = 0; k8 < 8; ++k8) {
        f32x4 pa, pb;
        if (BF) { const v4u x = ((const v4u*)pv)[k8]; pa = (f32x4){bf_lo(x.x), bf_hi(x.x), bf_lo(x.y), bf_hi(x.y)}; pb = (f32x4){bf_lo(x.z), bf_hi(x.z), bf_lo(x.w), bf_hi(x.w)}; }
        else { pa = ((const f32x4*)pv)[2 * k8]; pb = ((const f32x4*)pv)[2 * k8 + 1]; }
#pragma unroll
        for (int i = 0; i < 4; ++i) { const LAS float* rowp = r0 + i * 64; const int xs = (x0 + i) & 15;
            out[i] += dot4(*(const LAS f32x4*)(rowp + 4 * ((2 * k8) ^ xs)), pa) + dot4(*(const LAS f32x4*)(rowp + 4 * ((2 * k8 + 1) ^ xs)), pb); }
    }
    return out;
}
__device__ __forceinline__ void post_row(ARef A, int l, int m, int lane, const LAS float* slw, const LAS float* slr) {
    const float* P = (const float*)(A.ws + WS_P); const float* YO = (const float*)(A.ws + WS_YO); const float* RWA = (const float*)(A.ws + WS_RWA);
    bf16* MX = (bf16*)(A.ws + WS_MIX) + (size_t)m * DM; const int c4 = 4 * lane, hh = lane >> 4, r16 = lane & 15; const size_t o = (size_t)m * 256 + c4;
    { f32x4 y = *(const f32x4*)(YO + o) + state_corr<true>(slr, hh, r16, (const bf16*)(A.ws + WS_PTR) + (size_t)m * 256 + hh * 64);
      y = head_norm4(y, 1e-5f, *(const f32x4*)(A.in[I_RETGN] + l * 256 + c4));
      const f32x4 g = *(const f32x4*)(P + (size_t)m * INCP + C_RET + 768 + c4);
#pragma unroll
      for (int i = 0; i < 4; ++i) y[i] *= g[i] * sigm(g[i]);
      v2u w; w.x = pk2(y.x, y.y); w.y = pk2(y.z, y.w); *(v2u*)(MX + c4) = w; }
    { f32x4 y = *(const f32x4*)(YO + YO_STRIDE + o) + state_corr<false>(slw, hh, r16, (const float*)(A.ws + WS_PT) + (size_t)m * 256 + hh * 64);
      y = head_norm4(y, 64e-5f, *(const f32x4*)(A.in[I_LN] + l * 256 + c4));
      y = (y + *(const f32x4*)(RWA + 7 * RWA_STRIDE + o)) * *(const f32x4*)(RWA + 6 * RWA_STRIDE + o);
      v2u w; w.x = pk2(y.x, y.y); w.y = pk2(y.z, y.w); *(v2u*)(MX + 256 + c4) = w; }
    { f32x4 y = *(const f32x4*)(YO + 2 * YO_STRIDE + o); const float r = 1.0f / sqrtf(wave_sum(dot4(y, y)) * (1.0f / 256.0f) + 1e-5f);
      y = y * r * *(const f32x4*)(A.in[I_DONORM] + l * 256 + c4);
      v2u w; w.x = pk2(y.x, y.y); w.y = pk2(y.z, y.w); *(v2u*)(MX + 512 + c4) = w; }
    { f32x4 y = *(const f32x4*)(YO + 3 * YO_STRIDE + o); const float r = 1.0f / sqrtf(wave_sum(dot4(y, y)) * (1.0f / 256.0f) + 1e-5f);
      y = y * r * *(const f32x4*)(A.in[I_SONORM] + l * 256 + c4);
      v2u w; w.x = pk2(y.x, y.y); w.y = pk2(y.z, y.w); *(v2u*)(MX + 768 + c4) = w; }
}
__device__ __forceinline__ void ph_post(ARef A, const WI& w, int l) {
    LAS float* slw = (LAS float*)w.lds; LAS float* slr = slw + 16384;
    for (int u = w.vcu; u < NB * NCH * 2; u += w.G) {
        const int b = u >> 5, c = (u >> 1) & 15, half = u & 1;
        __syncthreads();
        for (int e = w.tid; e < 4096; e += NWAVES * 64) { const int hh = e >> 10, v = (e >> 4) & 63, k4 = e & 15;
            const size_t src = ((size_t)((b * 4 + hh) * NCH + c) * 64 + v) * 64 + 4 * k4; const int dst = (hh * 64 + v) * 64 + 4 * (k4 ^ (v & 15));
            *(LAS f32x4*)(slw + dst) = *(const f32x4*)((const float*)(A.ws + WS_SI) + src); *(LAS f32x4*)(slr + dst) = *(const f32x4*)((const float*)(A.ws + WS_SIR) + src); }
        __syncthreads();
        const int tok0 = b * SEQ + c * TCH + half * 128 + w.wave * 16;
        for (int i = 0; i < 16; ++i) post_row(A, l, tok0 + i, w.lane, slw, slr);
    }
}

__device__ __forceinline__ void router_row(ARef A, int l, int m, int lane, LAS unsigned* hist, bool dry = false) {
    const float* XA = (const float*)(A.ws + WS_XA) + (size_t)m * DM; const float* MOD = (const float*)(A.ws + WS_MOD) + (size_t)(l * 8 + (m >> 12)) * 6144;
    f32x4 v[4]; float ss = 0.0f;
#pragma unroll
    for (int j = 0; j < 4; ++j) { v[j] = *(const f32x4*)(XA + 4 * (lane + 64 * j)); ss += dot4(v[j], v[j]); }
    ss = wave_sum(ss); const float rstd = 1.0f / sqrtf(ss * (1.0f / DM) + 1e-5f);
    const float* g = A.in[I_NFFN] + l * DM; const float* scp = MOD + 4 * 1024; const float* shp = MOD + 3 * 1024;
    emit_h_row(v, rstd, g, scp, shp, (bf16*)(A.ws + WS_H) + (size_t)m * DM, lane);
    float p[32];
#pragma unroll
    for (int e = 0; e < 32; ++e) p[e] = 0.0f;
    const float* rw = A.in[I_RW] + (size_t)l * DM * 32;
#pragma unroll 1
    for (int j = 0; j < 4; ++j) { const int k = 4 * (lane + 64 * j);
        const f32x4 h = *(const f32x4*)(XA + k) * rstd * *(const f32x4*)(g + k) * (1.0f + *(const f32x4*)(scp + k)) + *(const f32x4*)(shp + k);
        const float* row = rw + (size_t)k * 32;
#pragma unroll
        for (int i = 0; i < 4; ++i) {
#pragma unroll
            for (int q4 = 0; q4 < 8; ++q4) { const f32x4 r = *(const f32x4*)(row + i * 32 + 4 * q4); p[4 * q4] += h[i] * r.x; p[4 * q4 + 1] += h[i] * r.y; p[4 * q4 + 2] += h[i] * r.z; p[4 * q4 + 3] += h[i] * r.w; } } }
    const float* rb = A.in[I_RB] + l * 32;
#pragma unroll
    for (int e = 0; e < 32; ++e) p[e] = wave_sum(p[e]) + rb[e];
    unsigned used = 0u; float tv[4]; int ti[4];
#pragma unroll
    for (int kk = 0; kk < 4; ++kk) { float best = -INFINITY; int bi = 0;
#pragma unroll
        for (int e = 0; e < 32; ++e) { const bool c = !((used >> e) & 1u) && (p[e] > best); best = c ? p[e] : best; bi = c ? e : bi; }
        used |= 1u << bi; tv[kk] = best; ti[kk] = bi; }
    const float e1 = expf(tv[1] - tv[0]), e2 = expf(tv[2] - tv[0]), e3 = expf(tv[3] - tv[0]); const float inv = 1.0f / (1.0f + e1 + e2 + e3);
    if (lane == 0 && !dry) {
        int* TI = (int*)(A.ws + WS_TOPI) + (size_t)m * 4; float* TW = (float*)(A.ws + WS_TOPW) + (size_t)m * 4;
        TI[0] = ti[0]; TI[1] = ti[1]; TI[2] = ti[2]; TI[3] = ti[3]; TW[0] = inv; TW[1] = e1 * inv; TW[2] = e2 * inv; TW[3] = e3 * inv;
        { unsigned* hg = (unsigned*)hist; atomicAdd(hg + ti[0], 1u); atomicAdd(hg + ti[1], 1u); atomicAdd(hg + ti[2], 1u); atomicAdd(hg + ti[3], 1u); }
    }
}
__device__ __forceinline__ void build_expert_table(ARef A, const WI& w, int l) {
    LAS int* tst = (LAS int*)(w.lds + TST_OFF); LAS int* tab = (LAS int*)(w.lds + TAB_OFF); LAS int* base = (LAS int*)(w.lds + BASE_OFF); LAS int* part = (LAS int*)w.lds;
    const unsigned* bc = (const unsigned*)(A.ws + WS_CTL) + CW_BLKCNT + (size_t)l * 256 * 32;
    { const int e = w.tid & 31, pq = w.tid >> 5; int s = 0, sb = 0;
      for (int i = 0; i < 16; ++i) { const int g = pq * 16 + i; if (g < w.G) { const int c = (int)__hip_atomic_load(bc + g * 32 + e, RLX_AGENT); s += c; sb += (g < w.vcu) ? c : 0; } }
      part[pq * 32 + e] = s; part[512 + pq * 32 + e] = sb; }
    __syncthreads();
    if (w.tid < 32) { int s = 0, sb = 0; for (int pq = 0; pq < 16; ++pq) { s += part[pq * 32 + w.tid]; sb += part[512 + pq * 32 + w.tid]; } part[1024 + w.tid] = s; base[w.tid] = sb; }
    __syncthreads();
    if (w.tid == 0) { int acc = 0; for (int e = 0; e < 32; ++e) { tst[e] = acc; acc += (part[1024 + e] + 255) >> 8; } tst[32] = acc; tab[0] = acc; }
    __syncthreads();
    if (w.tid < 32) { const int e = w.tid; for (int pm = tst[e]; pm < tst[e + 1]; ++pm) tab[1 + pm] = e; }
    __syncthreads();
}
__device__ __forceinline__ void scatter_row(ARef A, const WI& w, int l, int m, bool dry = false) {
    const LAS int* tst = (const LAS int*)(w.lds + TST_OFF); const LAS int* base = (const LAS int*)(w.lds + BASE_OFF); LAS unsigned* cur = (LAS unsigned*)(w.lds + HIST_OFF);
    int pos = 0;
    if (dry) { if (w.lane < 4) pos = ((const int*)(A.ws + WS_POS))[(size_t)m * 4 + w.lane]; }
    else if (w.lane < 4) { const int e = ((const int*)(A.ws + WS_TOPI))[(size_t)m * 4 + w.lane];
        const unsigned slot = atomicAdd((unsigned*)cur + e, 1u);
        pos = tst[e] * 256 + base[e] + (int)slot; ((int*)(A.ws + WS_POS))[(size_t)m * 4 + w.lane] = pos; }
    const v4u* src = (const v4u*)((const bf16*)(A.ws + WS_H) + (size_t)m * DM);
    const v4u a = src[w.lane], b = src[64 + w.lane];
#pragma unroll
    for (int k = 0; k < 4; ++k) { const int pk = __shfl(pos, k); v4u* dst = (v4u*)((bf16*)(A.ws + WS_XS) + (size_t)pk * DM); dst[w.lane] = a; dst[64 + w.lane] = b; }
}
__device__ __forceinline__ void combine_row(ARef A, int l, int m, int lane, float gscale = 1.0f, float oscale = 1.0f) {
    float* XA = (float*)(A.ws + WS_XA) + (size_t)m * DM; const float* MOD = (const float*)(A.ws + WS_MOD) + (size_t)(l * 8 + (m >> 12)) * 6144;
    const int* PS = (const int*)(A.ws + WS_POS) + (size_t)m * 4; const float* TW = (const float*)(A.ws + WS_TOPW) + (size_t)m * 4;
    const bf16* YS = (const bf16*)(A.ws + WS_XS);
    f32x4 v[4], acc[4];
#pragma unroll
    for (int j = 0; j < 4; ++j) { v[j] = *(const f32x4*)(XA + 4 * (lane + 64 * j)); acc[j] = (f32x4){0.f, 0.f, 0.f, 0.f}; }
#pragma unroll
    for (int k = 0; k < 4; ++k) { const int pos = PS[k]; const float gt = TW[k] * gscale; const v2u* yr = (const v2u*)(YS + (size_t)pos * DM);
#pragma unroll
        for (int j = 0; j < 4; ++j) { const v2u y = yr[lane + 64 * j]; acc[j] += gt * (f32x4){bf_lo(y.x), bf_hi(y.x), bf_lo(y.y), bf_hi(y.y)}; } }
    float ss = 0.0f;
#pragma unroll
    for (int j = 0; j < 4; ++j) { const int kx = 4 * (lane + 64 * j); v[j] += *(const f32x4*)(MOD + 5 * 1024 + kx) * acc[j]; ss += dot4(v[j], v[j]); }
    ss = wave_sum(ss); const float rstd = 1.0f / sqrtf(ss * (1.0f / DM) + 1e-5f);
    if (l + 1 < NLAYER) {
#pragma unroll
        for (int j = 0; j < 4; ++j) *(f32x4*)(XA + 4 * (lane + 64 * j)) = v[j];
        const float* mb = MOD + 8 * 6144;
        emit_h_row(v, rstd, A.in[I_NMIX] + (l + 1) * DM, mb + 1024, mb, (bf16*)(A.ws + WS_H) + (size_t)m * DM, lane);
    } else {
        float* orow = A.out + (size_t)m * DM; const float* gf = A.in[I_NFINAL];
#pragma unroll
        for (int j = 0; j < 4; ++j) { const int kx = 4 * (lane + 64 * j); *(f32x4*)(orow + kx) = v[j] * (rstd * oscale) * *(const f32x4*)(gf + kx); }
    }
}

constexpr int N_LAUNCHES = MK_N_LAUNCHES;
template <int SEL> __global__ void __launch_bounds__(NWAVES * 64, 2) fwd(ArgsH Ah) {
    extern __shared__ __attribute__((aligned(16))) unsigned char lds[];
    (void)Ah;
    const int wave_s = __builtin_amdgcn_readfirstlane((int)threadIdx.x >> 6);
    auto tid_now = [&]() -> int { int ws_ = wave_s; unsigned z_ = 0u; asm volatile("" : "+s"(ws_), "+s"(z_)); return ws_ * 64 + (int)__builtin_amdgcn_mbcnt_hi(~0u, __builtin_amdgcn_mbcnt_lo(~0u, z_)); };
#define TID_NOW() tid_now()
#define MAKE_WI() WI w; { int tz = TID_NOW(); asm volatile("" : "+v"(tz)); int bz = blockIdx.x, gz = gridDim.x; asm volatile("" : "+s"(bz), "+s"(gz)); \
        w.lds = (LAS unsigned char*)lds; w.tid = tz; w.lane = tz & 63; w.wave = __builtin_amdgcn_readfirstlane(tz >> 6); w.G = gz; w.bx = bz; w.vcu = (gz % 8 == 0) ? (bz % 8) * (gz / 8) + bz / 8 : bz; \
        w.gw = w.vcu * NWAVES + w.wave; w.NGW = gz * NWAVES; }
    { const int t0 = threadIdx.x; for (int u = t0; u < (LDS_BYTES - RING_BYTES) / 4; u += NWAVES * 64) ((LAS unsigned*)((LAS unsigned char*)lds + RING_BYTES))[u] = 0u; }
    __syncthreads();
    int lo, hi; { ARef A0 = *kargs(); lo = A0.ph_lo; hi = A0.ph_hi; }
    if (N_LAUNCHES == 1) { ARef A0 = *kargs(); (void)xcd_barrier_post((unsigned*)((gu32*)(A0.ws + WS_CTL) + CW_BAR), (volatile LAS unsigned*)((LAS unsigned char*)lds + MISC_OFF) + 8, TID_NOW()); }
#define GRID_BAR() do { if (N_LAUNCHES == 1) { ARef Ab = *kargs(); XcdBarrier bar_; bar_.bar = (unsigned*)((gu32*)(Ab.ws + WS_CTL) + CW_BAR); bar_.x = xb_xcc_id(); bar_.st = (volatile LAS unsigned*)((LAS unsigned char*)lds + MISC_OFF) + 8; xcd_barrier(bar_, TID_NOW()); } } while (0)
#ifndef TPROBE
#define TPROBE 0
#endif
#if TPROBE
    unsigned long long tp_acc = 0ull;
#define TP_SCALE (1.0f + sqrtf((float)tp_acc * 1e-7f))
#define TP_BEGIN(kind) unsigned long long tp_t0 = 0ull; if ((kind) == TPROBE) tp_t0 = __builtin_amdgcn_s_memrealtime();
#define TP_END(kind) if ((kind) == TPROBE) { tp_acc += __builtin_amdgcn_s_memrealtime() - tp_t0; }
#else
#define TP_SCALE 1.0f
#define TP_BEGIN(kind)
#define TP_END(kind)
#endif
#define IN(k) (lo <= (k) && (k) < hi)
#ifndef PHMASK
#define PHMASK 0xffffffffu
#endif
#define KON(k) if constexpr ((SEL < 0 && ((PHMASK >> (k)) & 1u)) || SEL == (k))
#define BOTH(k) (IN(k) && IN((k) + 1))
#ifndef PROBE_REP
#define PROBE_REP 0
#endif
#if PROBE_REP
    int nrep_ = 2; asm volatile("" : "+s"(nrep_));
#define REP(bit) _Pragma("unroll 1") for (int rep_ = 0; rep_ < (((PROBE_REP >> (bit)) & 1) ? nrep_ : 1); ++rep_)
#else
#define REP(bit) for (int rep_ = 0; rep_ < 1; ++rep_)
#endif
#define ring ((PG8_LAS unsigned char*)lds)

    KON(0) if (IN(0)) { ARef A = *kargs(); MAKE_WI(); REP(0) ph_prologue(A, w); if (BOTH(0)) GRID_BAR(); }

#define LAYER_BODY(l) do {\
        const int pb = 1 + l * NPL; \
        KON(1) if (IN(pb + 0)) { ARef A = *kargs(); MAKE_WI(); TP_BEGIN(1) if (l == 0) ph_norm1(A, w); if (BOTH(pb + 0)) GRID_BAR(); TP_END(1) } \
        KON(2) if (IN(pb + 1)) { ARef A = *kargs(); MAKE_WI(); TP_BEGIN(2) \
            pg8::Gemm g{(const bf16*)(A.ws + WS_H), (const bf16*)(A.ws + WS_WIN) + (size_t)l * INCP * DM, MTOK, INCP, DM}; pg8::StaticOrder S; S.init(MTOK, INCP, w.G, w.bx); \
            pg8::EpiF32 E{(float*)(A.ws + WS_P), INCP}; \
            REP(1) pg8::gemm_phase<pg8::EpiF32, pg8::StaticOrder, true, true>(ring, g, S, E, w.tid); \
            if (BOTH(pb + 1)) GRID_BAR(); TP_END(2) \
        } \
        KON(3) if (IN(pb + 2)) { ARef A = *kargs(); MAKE_WI(); TP_BEGIN(3) \
            REP(2) for (int m = w.gw; m < MTOK; m += w.NGW) { rwkv_prep(A, l, m, w.lane); dsa_prep(A, l, m, w.lane); } \
            if (BOTH(pb + 2)) GRID_BAR(); TP_END(3) \
        } \
        KON(4) if (IN(pb + 3)) { ARef A = *kargs(); MAKE_WI(); TP_BEGIN(4) \
            REP(3) { for (int tk = w.vcu; tk < 32 * NCH; tk += w.G) scan_rwkv_task(A, w, tk); \
            for (int tk = w.vcu; tk < 32 * NCH / 2; tk += w.G) scan_ret_task(A, w, tk); } \
            REP(4) { LAS unsigned char* vl = w.lds + w.wave * 4608; for (int it = w.gw; it < 32 * 128; it += w.NGW) sb_tile_mfma(A, it, w.lane, vl); } \
            REP(5) dsa_scores_mfma(A, w); \
            if (BOTH(pb + 3)) GRID_BAR(); TP_END(4) \
        } \
        KON(5) if (IN(pb + 4)) { ARef A = *kargs(); MAKE_WI(); TP_BEGIN(5) \
            if (w.vcu < 32) prefix_chain(A, w, w.vcu); \
            LAS unsigned char* wl = w.lds + w.wave * 10240; \
            REP(6) for (int i = w.gw; i < MTOK; i += w.NGW) { const int m = (i & 1) ? (MTOK - 1 - (i >> 1)) : (i >> 1); dsa_row_mfma(A, m, w.lane, wl); } \
            if (BOTH(pb + 4)) GRID_BAR(); TP_END(5) \
        } \
        KON(6) if (IN(pb + 5)) { ARef A = *kargs(); MAKE_WI(); TP_BEGIN(6) \
            REP(7) ph_post(A, w, l); \
            if (BOTH(pb + 5)) GRID_BAR(); TP_END(6) \
        } \
        KON(7) if (IN(pb + 6)) { ARef A = *kargs(); MAKE_WI(); TP_BEGIN(7) \
            pg8::Gemm g{(const bf16*)(A.ws + WS_MIX), (const bf16*)(A.ws + WS_WOUT) + (size_t)l * DM * DM, MTOK, DM, DM}; pg8::StaticOrder S; S.init(MTOK, DM, w.G, w.bx); \
            pg8::EpiRes E{l == 0 ? A.in[I_X] : (const float*)(A.ws + WS_XA), (float*)(A.ws + WS_XA), (const float*)(A.ws + WS_MOD) + (size_t)l * 8 * 6144 + 2 * 1024}; \
            pg8::gemm_phase<pg8::EpiRes, pg8::StaticOrder, true, true>(ring, g, S, E, w.tid); \
            if (BOTH(pb + 6)) GRID_BAR(); TP_END(7) \
        } \
        KON(8) if (IN(pb + 7)) { ARef A = *kargs(); MAKE_WI(); TP_BEGIN(8) \
            { LAS unsigned* hist = (LAS unsigned*)(w.lds + HIST_OFF); if (w.tid < 32) hist[w.tid] = 0u; __syncthreads(); \
            REP(10) for (int m = w.gw; m < MTOK; m += w.NGW) router_row(A, l, m, w.lane, hist, rep_ != 0); \
            __syncthreads(); if (w.tid < 32) ((unsigned*)(A.ws + WS_CTL))[CW_BLKCNT + (l * 256 + w.vcu) * 32 + w.tid] = hist[w.tid]; } \
            if (BOTH(pb + 7)) GRID_BAR(); TP_END(8) \
        } \
        KON(9) if (IN(pb + 8)) { ARef A = *kargs(); MAKE_WI(); TP_BEGIN(9) \
            build_expert_table(A, w, l); { LAS unsigned* cur = (LAS unsigned*)(w.lds + HIST_OFF); if (w.tid < 32) cur[w.tid] = 0u; __syncthreads(); } \
            REP(11) for (int m = w.gw; m < MTOK; m += w.NGW) scatter_row(A, w, l, m, rep_ != 0); \
            if (BOTH(pb + 8)) GRID_BAR(); TP_END(9) \
        } \
        KON(10) if (IN(pb + 9)) { ARef A = *kargs(); MAKE_WI(); TP_BEGIN(10) \
            build_expert_table(A, w, l); \
            pg8::Gemm g{(const bf16*)(A.ws + WS_XS), (const bf16*)(A.ws + WS_W1) + (size_t)l * NEXP * 2048 * DM, MOE_ROWS, NEXP * 2048, DM}; \
            pg8::MoeOrder S{(const PG8_LAS int*)(w.lds + TAB_OFF), 8, w.G, w.vcu}; \
            pg8::EpiSwiglu E{(bf16*)(A.ws + WS_ACT), A.in[I_MB1] + (size_t)l * NEXP * 2048}; \
            REP(8) pg8::gemm_phase<pg8::EpiSwiglu, pg8::MoeOrder, true, true>(ring, g, S, E, w.tid); \
            if (BOTH(pb + 9)) GRID_BAR(); TP_END(10) \
        } \
        KON(11) if (IN(pb + 10)) { ARef A = *kargs(); MAKE_WI(); TP_BEGIN(11) \
            build_expert_table(A, w, l); \
            pg8::Gemm g{(const bf16*)(A.ws + WS_ACT), (const bf16*)(A.ws + WS_W2) + (size_t)l * NEXP * DM * DM, MOE_ROWS, NEXP * DM, DM}; \
            pg8::MoeOrder S{(const PG8_LAS int*)(w.lds + TAB_OFF), 4, w.G, w.vcu}; \
            pg8::EpiY E{(bf16*)(A.ws + WS_XS), A.in[I_MB2] + (size_t)l * NEXP * DM}; \
            REP(9) pg8::gemm_phase<pg8::EpiY, pg8::MoeOrder, true, true>(ring, g, S, E, w.tid); \
            if (BOTH(pb + 10)) GRID_BAR(); TP_END(11) \
        } \
        KON(12) if (IN(pb + 11)) { ARef A = *kargs(); MAKE_WI(); TP_BEGIN(12) \
            REP(12) for (int m = w.gw; m < MTOK; m += w.NGW) combine_row(A, l, m, w.lane, rep_ ? 0.0f : 1.0f, TP_SCALE); \
            if (BOTH(pb + 11)) GRID_BAR(); TP_END(12) \
        } \
    } while (0)
    LAYER_BODY(0);
    LAYER_BODY(1);
#undef LAYER_BODY
#undef IN
#undef ring
#undef MAKE_WI
#undef TID_NOW
#undef GRID_BAR
#undef KON
#undef BOTH
}


#if MK_N_LAUNCHES != 1
template <int K> static void launch_one(int grid, hipStream_t stream, const ArgsH& a) {
    static bool attr = false;
    if (!attr) { (void)hipFuncSetAttribute((const void*)fwd<K>, hipFuncAttributeMaxDynamicSharedMemorySize, LDS_BYTES); attr = true; }
    hipLaunchKernelGGL(fwd<K>, dim3(grid), dim3(NWAVES * 64), LDS_BYTES, stream, a);
}
static void launch_kind(int kind, int grid, hipStream_t stream, const ArgsH& a) {
    switch (kind) {
        case 0: launch_one<0>(grid, stream, a); break; case 1: launch_one<1>(grid, stream, a); break; case 2: launch_one<2>(grid, stream, a); break;
        case 3: launch_one<3>(grid, stream, a); break; case 4: launch_one<4>(grid, stream, a); break; case 5: launch_one<5>(grid, stream, a); break;
        case 6: launch_one<6>(grid, stream, a); break; case 7: launch_one<7>(grid, stream, a); break; case 8: launch_one<8>(grid, stream, a); break;
        case 9: launch_one<9>(grid, stream, a); break; case 10: launch_one<10>(grid, stream, a); break; case 11: launch_one<11>(grid, stream, a); break;
        default: launch_one<12>(grid, stream, a); break;
    }
}
#endif
extern "C" void kernel_launch(void* const* d_in, const int* in_sizes, int n_in, void* d_out, int out_size, void* d_ws, size_t ws_size, hipStream_t stream) {
    static int grid = 0;
    if (grid == 0) {
        if (n_in != N_IN || out_size != MTOK * DM || ws_size < WS_END) { fprintf(stderr, "kernel_launch: unexpected shapes (n_in %d, out %d, ws %zu)\n", n_in, out_size, ws_size); grid = -1; return; }
        int dev = 0, cus = 0;
        if (hipGetDevice(&dev) != hipSuccess || hipDeviceGetAttribute(&cus, hipDeviceAttributeMultiprocessorCount, dev) != hipSuccess) { grid = -1; return; }
#if MK_N_LAUNCHES == 1
        {
            if (hipFuncSetAttribute((const void*)fwd<-1>, hipFuncAttributeMaxDynamicSharedMemorySize, LDS_BYTES) != hipSuccess) { fprintf(stderr, "kernel_launch: hipFuncSetAttribute failed\n"); grid = -1; return; }
            int per_cu = 0;
            if (hipOccupancyMaxActiveBlocksPerMultiprocessor(&per_cu, (const void*)fwd<-1>, NWAVES * 64, LDS_BYTES) != hipSuccess || per_cu < 1) fprintf(stderr, "kernel_launch: occupancy query says %d\n", per_cu);
            (void)hipGetLastError();
        }
#endif
        grid = cus;
    }
    if (grid < 0) return;
    (void)in_sizes;
    if (hipMemsetAsync((char*)d_ws + WS_CTL, 0, CTL_ZERO_BYTES, stream) != hipSuccess) return;
    ArgsH a{};
    for (int i = 0; i < N_IN; ++i) a.in[i] = (const float*)d_in[i];
    a.out = (float*)d_out; a.ws = (unsigned char*)d_ws;
    for (int f = 0; f < 44; ++f) a.invf[f] = (f < 32) ? pow(10000.0, -(double)f / 32.0) : (f < 40) ? pow(500000.0, -(double)(f - 32) / 8.0) : pow(500000.0, -(double)(f - 40) / 4.0);
#if MK_N_LAUNCHES == 1
    a.ph_lo = 0; a.ph_hi = NPHASE; a.li = 0;
    hipLaunchKernelGGL(fwd<-1>, dim3(grid), dim3(NWAVES * 64), LDS_BYTES, stream, a);
#else
    {
        for (int p = 0; p < NPHASE; ++p) {
            if (p == 1 + NPL) continue;
            a.ph_lo = p; a.ph_hi = p + 1; a.li = p;
            const int kind = (p == 0) ? 0 : 1 + (p - 1) % NPL;
            launch_kind(kind, grid, stream, a);
        }
    }
#endif
}
```

```cpp
#include <hip/hip_runtime.h>
#include <cstdio>
#include <cstdint>
#include <cmath>

#ifndef MK_N_LAUNCHES
#define MK_N_LAUNCHES 1
#endif

namespace pg8 {
#define PG8_LAS __attribute__((address_space(3)))
typedef unsigned short bf16_t;
typedef short bf16x8 __attribute__((ext_vector_type(8)));
typedef float f32x4 __attribute__((ext_vector_type(4)));
typedef unsigned u32x4 __attribute__((ext_vector_type(4)));
typedef unsigned u32x2 __attribute__((ext_vector_type(2)));
constexpr int BM = 256, BK = 64, HALF = 128, HTB = HALF * BK * 2  , STAGE_BYTES = 8 * HTB, NXCD = 8, WGM = 8;

__host__ __device__ __forceinline__ int lds_byte(int r, int c) { const int st = (r >> 4) * 2 + (c >> 5), rr = r & 15, cc = c & 31, ob = rr * 64 + cc * 2; return st * 1024 + (ob ^ (((ob >> 9) & 1) << 5)); }
__host__ __device__ __forceinline__ void stage_rc(int b, int& R, int& C) { const int st = b / 1024, sb = b % 1024, swz = sb ^ (((sb >> 9) & 1) << 5); R = (st >> 1) * 16 + swz / 64; C = (st & 1) * 32 + (swz % 64) / 2; }
__host__ __device__ __forceinline__ int perm32(int rho) { const int n = rho >> 4, i = rho & 15; return 8 * (i >> 2) + 4 * n + (i & 3); }

struct Unit { int pm, pn; };
struct Gemm { const bf16_t* A; const bf16_t* Bt; int M, N, K; };

struct StaticOrder {
    int nM, nN, nwg, G, c;
    __host__ __device__ void init(int M, int N, int G_, int c_) { nM = M / BM; nN = N / BM; nwg = nM * nN; G = G_; c = c_; }
    __host__ __device__ bool next(int i, Unit& u) const {
        const long L = (long)i * G + c; if (L >= nwg) return false;
        int wgid = (int)L; { const int q = nwg / NXCD, r = nwg % NXCD, xcd = wgid % NXCD, off = wgid / NXCD; wgid = (xcd < r ? xcd * (q + 1) : r * (q + 1) + (xcd - r) * q) + off; }
        const int nig = WGM * nN, gid = wgid / nig, fm = gid * WGM, gsz = (nM - fm) < WGM ? (nM - fm) : WGM;
        u.pm = fm + ((wgid % nig) % gsz); u.pn = (wgid % nig) / gsz; return true;
    }
    __device__ __forceinline__ void a_ready(const Unit&) const {}
    __device__ __forceinline__ void done(const Unit&) const {}
};
__device__ __forceinline__ unsigned cvt_pk_bf16(float lo, float hi) { unsigned r; asm volatile("v_cvt_pk_bf16_f32 %0, %1, %2" : "=v"(r) : "v"(lo), "v"(hi)); return r; }
struct EpiF32 {
    static constexpr bool PERM = false, AFTER_DRAIN = false;
    float* C; int ldc;
    __device__ __forceinline__ void operator()(const f32x4 (&acc)[2][2][4][2], const Unit& u, int wr, int wc, int fr, int fq) const {
        const int row0 = u.pm * BM + wr * 64 + fr, col0 = u.pn * BM + wc * 32 + 4 * fq;
#pragma unroll
        for (int ai = 0; ai < 2; ++ai)
#pragma unroll
            for (int m = 0; m < 4; ++m) { float* rowp = C + (size_t)(row0 + ai * HALF + m * 16) * ldc + col0;
#pragma unroll
                for (int bj = 0; bj < 2; ++bj)
#pragma unroll
                    for (int n = 0; n < 2; ++n) *(f32x4*)(rowp + bj * HALF + n * 16) = acc[ai][bj][m][n]; }
    }
};
struct EpiRes {
    static constexpr bool PERM = false, AFTER_DRAIN = false;
    const float* xin; float* xout; const float* gate;
    __device__ __forceinline__ void operator()(const f32x4 (&acc)[2][2][4][2], const Unit& u, int wr, int wc, int fr, int fq) const {
        const int row0 = u.pm * BM + wr * 64 + fr, col0 = u.pn * BM + wc * 32 + 4 * fq;
        const float* gp = gate + (size_t)((u.pm * BM) >> 12) * 6144 + col0;
        f32x4 gv[2][2];
#pragma unroll
        for (int bj = 0; bj < 2; ++bj)
#pragma unroll
            for (int n = 0; n < 2; ++n) gv[bj][n] = *(const f32x4*)(gp + bj * HALF + n * 16);
#pragma unroll
        for (int ai = 0; ai < 2; ++ai)
#pragma unroll
            for (int m = 0; m < 4; ++m) { const size_t ro = (size_t)(row0 + ai * HALF + m * 16) * 1024 + col0;
#pragma unroll
                for (int bj = 0; bj < 2; ++bj)
#pragma unroll
                    for (int n = 0; n < 2; ++n) { const f32x4 xv = *(const f32x4*)(xin + ro + bj * HALF + n * 16); *(f32x4*)(xout + ro + bj * HALF + n * 16) = xv + gv[bj][n] * acc[ai][bj][m][n]; } }
    }
};
__device__ __forceinline__ float swiglu1(float glu, float lin) {
    glu = fminf(glu, 7.0f); lin = fminf(fmaxf(lin, -7.0f), 7.0f);
    return glu * (1.0f / (1.0f + __expf(-1.702f * glu))) * (lin + 1.0f);
}
struct EpiSwiglu {
    static constexpr bool PERM = true, AFTER_DRAIN = false;
    bf16_t* O; const float* b1;
    __device__ __forceinline__ void operator()(const f32x4 (&acc)[2][2][4][2], const Unit& u, int wr, int wc, int fr, int fq) const {
        const int e = u.pn >> 3, j = u.pn & 7, row0 = u.pm * BM + wr * 64 + fr, c0 = 128 * j + wc * 32 + 8 * fq;
        const float* bp = b1 + (size_t)e * 2048 + c0;
        f32x4 bg[2], bl[2];
#pragma unroll
        for (int n = 0; n < 2; ++n) { bg[n] = *(const f32x4*)(bp + 4 * n); bl[n] = *(const f32x4*)(bp + 1024 + 4 * n); }
#pragma unroll
        for (int ai = 0; ai < 2; ++ai)
#pragma unroll
            for (int m = 0; m < 4; ++m) { bf16_t* rowp = O + (size_t)(row0 + ai * HALF + m * 16) * 1024 + c0;
                const f32x4 g0 = acc[ai][0][m][0] + bg[0], g1 = acc[ai][0][m][1] + bg[1], l0 = acc[ai][1][m][0] + bl[0], l1 = acc[ai][1][m][1] + bl[1];
                u32x4 w;
                w.x = cvt_pk_bf16(swiglu1(g0[0], l0[0]), swiglu1(g0[1], l0[1])); w.y = cvt_pk_bf16(swiglu1(g0[2], l0[2]), swiglu1(g0[3], l0[3]));
                w.z = cvt_pk_bf16(swiglu1(g1[0], l1[0]), swiglu1(g1[1], l1[1])); w.w = cvt_pk_bf16(swiglu1(g1[2], l1[2]), swiglu1(g1[3], l1[3]));
                *(u32x4*)rowp = w; }
    }
};
struct EpiY {
    static constexpr bool PERM = true, AFTER_DRAIN = false;
    bf16_t* O; const float* b2;
    __device__ __forceinline__ void operator()(const f32x4 (&acc)[2][2][4][2], const Unit& u, int wr, int wc, int fr, int fq) const {
        const int e = u.pn >> 2, j = u.pn & 3, row0 = u.pm * BM + wr * 64 + fr, c0 = 256 * j + wc * 32 + 8 * fq;
        const float* bp = b2 + (size_t)e * 1024 + c0;
        f32x4 bv[2][2];
#pragma unroll
        for (int bj = 0; bj < 2; ++bj)
#pragma unroll
            for (int n = 0; n < 2; ++n) bv[bj][n] = *(const f32x4*)(bp + bj * HALF + 4 * n);
#pragma unroll
        for (int ai = 0; ai < 2; ++ai)
#pragma unroll
            for (int m = 0; m < 4; ++m) { bf16_t* rowp = O + (size_t)(row0 + ai * HALF + m * 16) * 1024 + c0;
#pragma unroll
                for (int bj = 0; bj < 2; ++bj) { const f32x4 v0 = acc[ai][bj][m][0] + bv[bj][0], v1 = acc[ai][bj][m][1] + bv[bj][1];
                    u32x4 w; w.x = cvt_pk_bf16(v0[0], v0[1]); w.y = cvt_pk_bf16(v0[2], v0[3]); w.z = cvt_pk_bf16(v1[0], v1[1]); w.w = cvt_pk_bf16(v1[2], v1[3]);
                    *(u32x4*)(rowp + bj * HALF) = w; } }
    }
};
struct MoeOrder {
    const PG8_LAS int* tab; int NJ, G, c;
    __device__ __forceinline__ bool next(int i, Unit& u) const {
        const int T = tab[0]; const long L = (long)i * G + c; if (L >= (long)T * NJ) return false;
        const int pm = (int)(L / NJ), j = (int)(L % NJ);
        u.pm = pm; u.pn = tab[1 + pm] * NJ + j; return true;
    }
    __device__ __forceinline__ void a_ready(const Unit&) const {}
    __device__ __forceinline__ void done(const Unit&) const {}
};

template <class Epi, class Sched, bool ALIGN_EPI = false, bool SP2 = false>
__device__ __forceinline__ void gemm_phase(PG8_LAS unsigned char* lds, const Gemm g, const Sched& S, const Epi& E, int tid_in) {
    int tid_ = tid_in; asm volatile("" : "+v"(tid_));
    const int tid = tid_, wid = __builtin_amdgcn_readfirstlane(tid >> 6), lane = tid & 63, wr = wid >> 2, wc = wid & 3, fr = lane & 15, fq = lane >> 4;
    const int K = g.K, nt = K / BK;
    unsigned voffA[2], voffB[2];
#pragma unroll
    for (int i = 0; i < 2; ++i) { int R, C; stage_rc(tid * 16 + i * 8192, R, C); const int Rb = Epi::PERM ? ((R & ~31) + perm32(R & 31)) : R;
        voffA[i] = (unsigned)(R * K + C) * 2u; voffB[i] = (unsigned)(Rb * K + C) * 2u; }
    const size_t kstep = (size_t)(BK * 2);
    const size_t hstep = (size_t)HALF * K * 2;
    const size_t tstep = 2 * hstep;
    const unsigned ldsw = (unsigned)wid * 1024u;
    const int aoff = lds_byte(wr * 64 + fr, fq * 8), boff = lds_byte(wc * 32 + fr, fq * 8);
#define PG8_SA(b, h) (((b) * 2 + (h)) * HTB)
#define PG8_SB(b, h) ((4 + (b) * 2 + (h)) * HTB)
#define PG8_STAGE(bufoff, gbase, voff) do { _Pragma("unroll") for (int _i = 0; _i < 2; ++_i) \
        __builtin_amdgcn_global_load_lds((const unsigned*)((const char*)(gbase) + (voff)[_i]), (PG8_LAS unsigned*)(lds + (bufoff) + ldsw + _i * 8192), 16, 0, 0); } while (0)
#define PG8_LDA(dst, b, h) do { _Pragma("unroll") for (int m = 0; m < 4; ++m) _Pragma("unroll") for (int k = 0; k < 2; ++k) dst[m][k] = *(const PG8_LAS bf16x8*)(lds + PG8_SA(b, h) + aoff + m * 2048 + k * 1024); } while (0)
#define PG8_LDB(dst, b, h) do { _Pragma("unroll") for (int n = 0; n < 2; ++n) _Pragma("unroll") for (int k = 0; k < 2; ++k) dst[n][k] = *(const PG8_LAS bf16x8*)(lds + PG8_SB(b, h) + boff + n * 2048 + k * 1024); } while (0)
#define PG8_MMA(ai, bj, At, Bt) do { __builtin_amdgcn_s_setprio(1); _Pragma("unroll") for (int m = 0; m < 4; ++m) _Pragma("unroll") for (int n = 0; n < 2; ++n) _Pragma("unroll") for (int k = 0; k < 2; ++k) \
        acc[ai][bj][m][n] = __builtin_amdgcn_mfma_f32_16x16x32_bf16(Bt[n][k], At[m][k], acc[ai][bj][m][n], 0, 0, 0); __builtin_amdgcn_s_setprio(0); } while (0)
#define PG8_WAIT_V(n) asm volatile("s_waitcnt vmcnt(" #n ")" ::: "memory")
#define PG8_WAIT_L(n) asm volatile("s_waitcnt lgkmcnt(" #n ")" ::: "memory")
#define PG8_BAR __builtin_amdgcn_s_barrier()
#define PG8_SCHED __builtin_amdgcn_sched_barrier(0)
    Unit cur, nxt; int ui = 0;
    if (!S.next(0, cur)) return;
    f32x4 acc[2][2][4][2];
#pragma unroll
    for (int a = 0; a < 2; ++a)
#pragma unroll
        for (int b = 0; b < 2; ++b)
#pragma unroll
            for (int m = 0; m < 4; ++m)
#pragma unroll
                for (int n = 0; n < 2; ++n) acc[a][b][m][n] = (f32x4){0.f, 0.f, 0.f, 0.f};
    bf16x8 At[4][2], B0[2][2], B1[2][2];
    const char* cA = (const char*)g.A + (size_t)cur.pm * tstep; const char* cB = (const char*)g.Bt + (size_t)cur.pn * tstep;
    S.a_ready(cur);
    if constexpr (SP2) {
        PG8_STAGE(PG8_SB(0, 0), cB, voffB); PG8_STAGE(PG8_SB(0, 1), cB + hstep, voffB); PG8_STAGE(PG8_SA(0, 0), cA, voffA); PG8_STAGE(PG8_SA(0, 1), cA + hstep, voffA);
        if (wr == 1) PG8_BAR;
        PG8_WAIT_V(2); PG8_BAR;
        PG8_STAGE(PG8_SB(1, 0), cB + kstep, voffB); PG8_STAGE(PG8_SA(1, 0), cA + kstep, voffA); PG8_STAGE(PG8_SB(1, 1), cB + hstep + kstep, voffB);
        PG8_WAIT_V(6); PG8_BAR;
    } else {
        PG8_STAGE(PG8_SB(0, 0), cB, voffB); PG8_STAGE(PG8_SA(0, 0), cA, voffA); PG8_STAGE(PG8_SB(0, 1), cB + hstep, voffB); PG8_STAGE(PG8_SA(0, 1), cA + hstep, voffA);
        if (wr == 1) PG8_BAR;
        PG8_WAIT_V(4); PG8_BAR;
        PG8_STAGE(PG8_SB(1, 0), cB + kstep, voffB); PG8_STAGE(PG8_SA(1, 0), cA + kstep, voffA); PG8_STAGE(PG8_SB(1, 1), cB + hstep + kstep, voffB);
        PG8_WAIT_V(6); PG8_BAR;
    }
    for (;;) {
        const bool has_next = S.next(ui + 1, nxt);
        const char* nA = has_next ? (const char*)g.A + (size_t)nxt.pm * tstep : cA; const char* nB = has_next ? (const char*)g.Bt + (size_t)nxt.pn * tstep : cB;
        for (int t = 0; t < nt; t += 2) {
            const bool last = (t == nt - 2);
            const char* a1 = cA + (size_t)(t + 1) * kstep;
            const char* a2 = last ? nA : cA + (size_t)(t + 2) * kstep; const char* b2 = last ? nB : cB + (size_t)(t + 2) * kstep;
            const char* a3 = a2 + kstep; const char* b3 = b2 + kstep;
            if (last && has_next) S.a_ready(nxt);
            if constexpr (SP2) {
            PG8_LDB(B0, 0, 0); PG8_LDB(B1, 0, 1); PG8_SCHED; PG8_LDA(At, 0, 0); PG8_STAGE(PG8_SA(1, 1), a1 + hstep, voffA);
            PG8_WAIT_V(8); PG8_WAIT_L(0); PG8_BAR; PG8_MMA(0, 0, At, B0); PG8_MMA(0, 1, At, B1); PG8_BAR; PG8_SCHED;
            PG8_LDA(At, 0, 1); PG8_STAGE(PG8_SB(0, 0), b2, voffB); PG8_STAGE(PG8_SB(0, 1), b2 + hstep, voffB); PG8_STAGE(PG8_SA(0, 0), a2, voffA);
            PG8_WAIT_V(8); PG8_WAIT_L(0); PG8_BAR; PG8_MMA(1, 0, At, B0); PG8_MMA(1, 1, At, B1); PG8_BAR; PG8_SCHED;
            PG8_LDB(B0, 1, 0); PG8_LDB(B1, 1, 1); PG8_SCHED; PG8_LDA(At, 1, 0); PG8_STAGE(PG8_SA(0, 1), a2 + hstep, voffA);
            PG8_WAIT_V(8); PG8_WAIT_L(0); PG8_BAR; PG8_MMA(0, 0, At, B0); PG8_MMA(0, 1, At, B1); PG8_BAR; PG8_SCHED;
            PG8_LDA(At, 1, 1); PG8_STAGE(PG8_SB(1, 0), b3, voffB); PG8_STAGE(PG8_SB(1, 1), b3 + hstep, voffB); PG8_STAGE(PG8_SA(1, 0), a3, voffA);
            PG8_WAIT_V(8); PG8_WAIT_L(0); PG8_BAR; PG8_MMA(1, 0, At, B0); PG8_MMA(1, 1, At, B1); PG8_BAR; PG8_SCHED;
            } else {
            PG8_LDB(B0, 0, 0); PG8_SCHED; PG8_LDA(At, 0, 0); PG8_STAGE(PG8_SA(1, 1), a1 + hstep, voffA);
            PG8_WAIT_L(8); PG8_BAR; PG8_WAIT_L(0); PG8_MMA(0, 0, At, B0); PG8_BAR; PG8_SCHED;
            PG8_LDB(B1, 0, 1); PG8_STAGE(PG8_SB(0, 0), b2, voffB);
            PG8_BAR; PG8_WAIT_L(0); PG8_MMA(0, 1, At, B1); PG8_BAR;
            PG8_LDA(At, 0, 1); PG8_STAGE(PG8_SA(0, 0), a2, voffA);
            PG8_BAR; PG8_WAIT_L(0); PG8_MMA(1, 0, At, B0); PG8_BAR; PG8_SCHED;
            PG8_STAGE(PG8_SB(0, 1), b2 + hstep, voffB);
            PG8_WAIT_V(6); PG8_BAR; PG8_MMA(1, 1, At, B1); PG8_BAR;
            PG8_LDB(B0, 1, 0); PG8_SCHED; PG8_LDA(At, 1, 0); PG8_STAGE(PG8_SA(0, 1), a2 + hstep, voffA);
            PG8_WAIT_L(8); PG8_BAR; PG8_WAIT_L(0); PG8_MMA(0, 0, At, B0); PG8_BAR; PG8_SCHED;
            PG8_LDB(B1, 1, 1); PG8_STAGE(PG8_SB(1, 0), b3, voffB);
            PG8_BAR; PG8_WAIT_L(0); PG8_MMA(0, 1, At, B1); PG8_BAR;
            PG8_LDA(At, 1, 1); PG8_STAGE(PG8_SA(1, 0), a3, voffA);
            PG8_BAR; PG8_WAIT_L(0); PG8_MMA(1, 0, At, B0); PG8_BAR; PG8_SCHED;
            PG8_STAGE(PG8_SB(1, 1), b3 + hstep, voffB);
            PG8_WAIT_V(6); PG8_BAR; PG8_MMA(1, 1, At, B1); PG8_BAR;
            }
        }
        if constexpr (ALIGN_EPI) { if (wr == 0) PG8_BAR; }
        if constexpr (!Epi::AFTER_DRAIN) { E(acc, cur, wr, wc, fr, fq); S.done(cur); }
        if (!has_next) break;
#pragma unroll
        for (int a = 0; a < 2; ++a)
#pragma unroll
            for (int b = 0; b < 2; ++b)
#pragma unroll
                for (int m = 0; m < 4; ++m)
#pragma unroll
                    for (int n = 0; n < 2; ++n) acc[a][b][m][n] = (f32x4){0.f, 0.f, 0.f, 0.f};
        cur = nxt; cA = nA; cB = nB; ++ui;
        if constexpr (ALIGN_EPI) { if (wr == 1) PG8_BAR; }
    }
    PG8_WAIT_V(0);
    if constexpr (!ALIGN_EPI) { if (wr == 0) PG8_BAR; }
    PG8_BAR;
    if constexpr (Epi::AFTER_DRAIN) { E.fused(acc, cur, wr, wc, fr, fq, lds, wid, lane); S.done(cur); }
#undef PG8_SA
#undef PG8_SB
#undef PG8_STAGE
#undef PG8_LDA
#undef PG8_LDB
#undef PG8_MMA
#undef PG8_WAIT_V
#undef PG8_WAIT_L
#undef PG8_BAR
#undef PG8_SCHED
}
}

constexpr int NWAVES = 8;
constexpr int NB = 8, SEQ = 4096, DM = 1024, MTOK = NB * SEQ, NLAYER = 2;
constexpr int INC = 2984, INCP = 3072;
constexpr int C_RET = 0, C_RW = 1024, C_DSA = 1920, C_SB = 2216;
constexpr int NEXP = 32, MOE_ROWS = MTOK * 4 + NEXP * 256;
constexpr int ROPE_W = 88;
constexpr int NCH = 16, TCH = SEQ / NCH;
constexpr int NPL = 12, NPHASE = 1 + NLAYER * NPL;
enum { I_X = 0, I_C, I_POS, I_ADAW, I_ADAB, I_NMIX, I_NFFN, I_WIN, I_RETGN, I_MU, I_W0, I_W2, I_A0, I_A2, I_G2, I_KK, I_KA, I_RK, I_LN, I_QNORM, I_WQ, I_WQI, I_DONORM, I_SONORM, I_WOUT, I_RW, I_RB, I_MW1, I_MB1, I_MW2, I_MB2, I_NFINAL, N_IN };

constexpr size_t MiB = 1u << 20;
constexpr size_t WS_CTL = 0, CTL_ZERO_BYTES = 1 * MiB;
constexpr size_t WS_MOD = 1 * MiB, WS_ROPE = 2 * MiB, WS_WIN = 14 * MiB, WS_WOUT = 26 * MiB, WS_W1 = 30 * MiB, WS_W2 = 286 * MiB;
constexpr size_t WS_XA = 414 * MiB, WS_H = 542 * MiB, WS_MIX = 606 * MiB, WS_TOPI = 670 * MiB, WS_TOPW = 671 * MiB, WS_POS = 672 * MiB;
constexpr size_t WS_R = 674 * MiB;
constexpr size_t WS_P = WS_R, WS_RWA = 1058 * MiB  , WS_DQ = 1314 * MiB  , WS_DKB = 1330 * MiB  , WS_DVB = 1334 * MiB  , WS_DQI = 1346 * MiB  , WS_DKI = 1394 * MiB  , WS_DW = 1398 * MiB;
constexpr size_t WS_PT = 1362 * MiB  ;
constexpr size_t WS_CH = WS_H  , WS_SI = WS_H + 16 * MiB  , WS_SIR = WS_H + 24 * MiB  ,
                 WS_CHR = WS_H + 32 * MiB  , WS_PTR = WS_H + 40 * MiB  ;
constexpr size_t WS_SQ = WS_MIX  , WS_SK = WS_MIX + 16 * MiB, WS_SV = WS_MIX + 32 * MiB;
constexpr size_t WS_YO = 1400 * MiB  , WS_SC = 1528 * MiB  ;
constexpr size_t WS_XS = WS_R  , WS_ACT = 946 * MiB  ;
constexpr size_t WS_END = 2040 * MiB;
static_assert((size_t)MOE_ROWS * 2048 <= 272 * MiB, "moe buffers");
constexpr int CW_TMO = 0, CW_CODE = 1, CW_DSAQ = 64  , CW_BAR = 4096, CW_BLKCNT = 16384  ;
constexpr int RING_BYTES = 131072, MISC_OFF = RING_BYTES + 320, TST_OFF = RING_BYTES + 1024  , TAB_OFF = RING_BYTES + 2048  , HIST_OFF = RING_BYTES + 5120  , BASE_OFF = RING_BYTES + 5376  , LDS_BYTES = 147456;

#if defined(__HIP_DEVICE_COMPILE__)
#define GAS __attribute__((address_space(1)))
#define CAS __attribute__((address_space(4)))
#else
#define GAS
#define CAS
#endif
#define LAS __attribute__((address_space(3)))
typedef unsigned short bf16;
typedef unsigned v4u __attribute__((ext_vector_type(4)));
typedef unsigned v2u __attribute__((ext_vector_type(2)));
typedef float f32x4 __attribute__((ext_vector_type(4)));
typedef GAS unsigned gu32;
typedef short bf16x8v __attribute__((ext_vector_type(8)));
typedef short s16x4v __attribute__((ext_vector_type(4)));
#define RLX_AGENT __ATOMIC_RELAXED, __HIP_MEMORY_SCOPE_AGENT
#define LDS_WAIT() asm volatile("s_waitcnt lgkmcnt(0)" ::: "memory")
#define VM_WAIT() asm volatile("s_waitcnt vmcnt(0)" ::: "memory")
__device__ __forceinline__ unsigned f2bf(float f) { unsigned u = __builtin_bit_cast(unsigned, f); return (u + 0x7fffu + ((u >> 16) & 1u)) >> 16; }
__device__ __forceinline__ unsigned pk2(float lo, float hi) { return f2bf(lo) | (f2bf(hi) << 16); }
__device__ __forceinline__ float bf_lo(unsigned w) { return __builtin_bit_cast(float, w << 16); }
__device__ __forceinline__ float bf_hi(unsigned w) { return __builtin_bit_cast(float, w & 0xffff0000u); }
__device__ __forceinline__ float wave_sum(float v) {
#pragma unroll
    for (int o = 1; o < 64; o <<= 1) v += __shfl_xor(v, o);
    return v;
}
__device__ __forceinline__ float wave_max(float v) {
#pragma unroll
    for (int o = 1; o < 64; o <<= 1) v = fmaxf(v, __shfl_xor(v, o));
    return v;
}
__device__ __forceinline__ float grp16_sum(float v) { v += __shfl_xor(v, 1); v += __shfl_xor(v, 2); v += __shfl_xor(v, 4); v += __shfl_xor(v, 8); return v; }
__device__ __forceinline__ float grp8_sum(float v) { v += __shfl_xor(v, 1); v += __shfl_xor(v, 2); v += __shfl_xor(v, 4); return v; }
__device__ __forceinline__ float sum4(f32x4 a) { return (a.x + a.y) + (a.z + a.w); }
__device__ __forceinline__ float dot4(f32x4 a, f32x4 b) { return (a.x * b.x + a.y * b.y) + (a.z * b.z + a.w * b.w); }
__device__ __forceinline__ float sigm(float x) { return 1.0f / (1.0f + expf(-x)); }
__device__ __forceinline__ float softplusf(float x) { return fmaxf(x, 0.0f) + log1pf(expf(-fabsf(x))); }
__device__ __forceinline__ f32x4 shx4(f32x4 v, int m) { f32x4 r; r.x = __shfl_xor(v.x, m); r.y = __shfl_xor(v.y, m); r.z = __shfl_xor(v.z, m); r.w = __shfl_xor(v.w, m); return r; }

#define XB_TMO      128
#define XB_XCNT(j)  (256  + 64 * (j))
#define XB_XSUB(j)  (1280 + 64 * (j))
#define XB_XGEN(j)  (2304 + 64 * (j))
#define XB_TOP      3328
#define XB_TOPGEN   3392
#define XCD_BAR_WORDS 3456
#define XB_SPIN_CAP (1u << 18)

__device__ __forceinline__ unsigned xb_ld(unsigned* p)              { return __hip_atomic_load(p, __ATOMIC_RELAXED, __HIP_MEMORY_SCOPE_AGENT); }
__device__ __forceinline__ unsigned xb_add(unsigned* p, unsigned v) { return __hip_atomic_fetch_add(p, v, __ATOMIC_RELAXED, __HIP_MEMORY_SCOPE_AGENT); }
__device__ __forceinline__ unsigned xb_xcc_id() { return (unsigned)__builtin_amdgcn_s_getreg((3 << 11) | 20) & 0xFu; }
#define XB_SPIN(cond, bar) do { unsigned _sp = 0; while (cond) { __builtin_amdgcn_s_sleep(1); \
    if ((++_sp & 255u) == 0u) { if (xb_ld(&(bar)[XB_TMO])) break; if (_sp > XB_SPIN_CAP) { atomicAdd(&(bar)[XB_TMO], 1u); break; } } } } while (0)

struct XcdBarrier {
    unsigned* bar; unsigned x;
    volatile LAS unsigned* st;
};

__device__ __forceinline__ XcdBarrier xcd_barrier_post(unsigned* bar, volatile LAS unsigned* st, int xb_tid) {
    XcdBarrier b; b.bar = bar; b.x = xb_xcc_id(); b.st = st;
    if (xb_tid == 0) (void)xb_add(&bar[XB_XCNT(b.x)], 1u);
    return b;
}
__device__ __forceinline__ void xcd_barrier_complete(unsigned* bar, unsigned x, unsigned& nloc, unsigned& nx) {
    const unsigned G = gridDim.x * gridDim.y * gridDim.z;
    unsigned sum, cnt, mine, sp = 0u;
    for (;;) {
        sum = 0u; cnt = 0u; mine = 0u;
#pragma unroll
        for (unsigned j = 0; j < 16; ++j) { const unsigned c = xb_ld(&bar[XB_XCNT(j)]); sum += c; cnt += (c > 0u) ? 1u : 0u; mine = (j == x) ? c : mine; }
        if (sum == G) break;
        __builtin_amdgcn_s_sleep(1);
        if ((++sp & 255u) == 0u) { if (xb_ld(&bar[XB_TMO])) break; if (sp > XB_SPIN_CAP) { atomicAdd(&bar[XB_TMO], 1u); break; } }
    }
    nloc = mine > 0u ? mine : 1u; nx = cnt > 0u ? cnt : 1u;
}

__device__ __forceinline__ void xcd_barrier(const XcdBarrier& b, int xb_tid) {
    asm volatile("s_waitcnt vmcnt(0)" ::: "memory");
    __syncthreads();
    if (xb_tid == 0) {
        unsigned* bar = b.bar;
        __builtin_amdgcn_s_waitcnt(0);
        unsigned nloc = b.st[0], nx = b.st[1];
        if (nloc == 0u) { xcd_barrier_complete(bar, b.x, nloc, nx); b.st[0] = nloc; b.st[1] = nx; }
        const unsigned old = xb_add(&bar[XB_XSUB(b.x)], 1u);
        const unsigned gen = old / nloc;
        if (old + 1u == (gen + 1u) * nloc) {
            __builtin_amdgcn_fence(__ATOMIC_RELEASE, "agent");
            asm volatile("s_waitcnt vmcnt(0)" ::: "memory");
            const unsigned og = xb_add(&bar[XB_TOP], 1u);
            const unsigned tg = og / nx;
            if (og + 1u == (tg + 1u) * nx) xb_add(&bar[XB_TOPGEN], 1u);
            else XB_SPIN(xb_ld(&bar[XB_TOPGEN]) == tg, bar);
            __builtin_amdgcn_fence(__ATOMIC_ACQUIRE, "agent");
            xb_add(&bar[XB_XGEN(b.x)], 1u);
            asm volatile("s_waitcnt vmcnt(0)" ::: "memory");
        } else {
            XB_SPIN(xb_ld(&bar[XB_XGEN(b.x)]) == gen, bar);
            __builtin_amdgcn_fence(__ATOMIC_ACQUIRE, "agent");
            asm volatile("s_waitcnt vmcnt(0)" ::: "memory");
        }
    }
    __syncthreads();
}
struct ArgsH { const float* in[N_IN]; float* out; unsigned char* ws; double invf[44]; int ph_lo, ph_hi, li, pad; };
struct ArgsD { const GAS float* in[N_IN]; GAS float* out; GAS unsigned char* ws; double invf[44]; int ph_lo, ph_hi, li, pad; };
static_assert(sizeof(ArgsH) == sizeof(ArgsD), "args layout");
typedef const CAS ArgsD& ARef;
__device__ __forceinline__ const CAS ArgsD* kargs() {
#if defined(__HIP_DEVICE_COMPILE__)
    const CAS ArgsD* p = (const CAS ArgsD*)__builtin_amdgcn_kernarg_segment_ptr(); asm volatile("" : "+s"(p)); return p;
#else
    return nullptr;
#endif
}
struct WI { LAS unsigned char* lds; int tid, lane, wave, vcu, G, gw, NGW, bx; };
constexpr size_t RWA_STRIDE = 32 * MiB / 4;
constexpr size_t YO_STRIDE = 32 * MiB / 4;

__device__ __forceinline__ int wave_sum_i(int v) {
#pragma unroll
    for (int o = 1; o < 64; o <<= 1) v += __shfl_xor(v, o);
    return v;
}
__device__ __forceinline__ void sincos_d(double ang, float& s, float& c) {
    const double q = __builtin_rint(ang * 0.63661977236758134308);
    double r = __builtin_fma(-q, 1.57079632679489661923, ang); r = __builtin_fma(-q, 6.123233995736766e-17, r);
    const double r2 = r * r;
    const double sp = r * (1.0 + r2 * (-1.0 / 6 + r2 * (1.0 / 120 + r2 * (-1.0 / 5040 + r2 * (1.0 / 362880 + r2 * (-1.0 / 39916800 + r2 * (1.0 / 6227020800.0)))))));
    const double cp = 1.0 + r2 * (-0.5 + r2 * (1.0 / 24 + r2 * (-1.0 / 720 + r2 * (1.0 / 40320 + r2 * (-1.0 / 3628800 + r2 * (1.0 / 479001600 + r2 * (-1.0 / 87178291200.0)))))));
    const int qi = ((int)q) & 3;
    const double ss = (qi == 0) ? sp : (qi == 1) ? cp : (qi == 2) ? -sp : -cp;
    const double cc = (qi == 0) ? cp : (qi == 1) ? -sp : (qi == 2) ? -cp : sp;
    s = (float)ss; c = (float)cc;
}

__device__ __forceinline__ void tr_item(const float* W, int ldw, int nvalid, int k0, int nsrc0, bf16* WT, size_t dstrow0, LAS float* scr, int lane) {
#pragma unroll 8
    for (int i = 0; i < 32; ++i) { const int kk = 2 * i + (lane >> 5), c = lane & 31, n = nsrc0 + c; scr[kk * 33 + c] = (n < nvalid) ? W[(size_t)(k0 + kk) * ldw + n] : 0.0f; }
    LDS_WAIT(); asm volatile("" ::: "memory");
    const int c8 = lane & 7;
#pragma unroll
    for (int j = 0; j < 4; ++j) { const int n = (lane >> 3) + 8 * j; const LAS float* s = scr + (8 * c8) * 33 + n;
        v4u o; o.x = pk2(s[0 * 33], s[1 * 33]); o.y = pk2(s[2 * 33], s[3 * 33]); o.z = pk2(s[4 * 33], s[5 * 33]); o.w = pk2(s[6 * 33], s[7 * 33]);
        *(v4u*)(WT + (dstrow0 + n) * 1024 + k0 + 8 * c8) = o; }
    LDS_WAIT(); asm volatile("" ::: "memory");
}
__device__ __forceinline__ void ph_prologue(ARef A, const WI& w) {
    LAS float* sc = (LAS float*)w.lds;
    { const float* cin = A.in[I_C]; for (int i = w.tid; i < NB * DM; i += NWAVES * 64) { const float v = cin[i]; sc[i] = v / (1.0f + expf(-v)); } }
    __syncthreads();
    float* MOD = (float*)(A.ws + WS_MOD);
    if (w.wave == 0 && w.vcu < 192) {
        const int l = w.vcu / 96, col = (w.vcu % 96) * 64 + w.lane;
        const float* wp = A.in[I_ADAW] + (size_t)l * DM * 6144 + col;
        float acc[8];
#pragma unroll
        for (int b = 0; b < 8; ++b) acc[b] = 0.0f;
        for (int k = 0; k < DM; ++k) { const float wv = wp[(size_t)k * 6144];
#pragma unroll
            for (int b = 0; b < 8; ++b) acc[b] += sc[b * DM + k] * wv; }
        const float bias = A.in[I_ADAB][l * 6144 + col];
#pragma unroll
        for (int b = 0; b < 8; ++b) MOD[(size_t)(l * 8 + b) * 6144 + col] = acc[b] + bias;
    }
    LAS float* scr = (LAS float*)(w.lds + 32768 + w.wave * 8448);
    constexpr int I_IN = NLAYER * 16 * 96, I_OUT = NLAYER * 16 * 32, I_W1 = NLAYER * NEXP * 16 * 64, I_W2 = NLAYER * NEXP * 16 * 32, NIT = I_IN + I_OUT + I_W1 + I_W2;
    for (int it = w.gw; it < NIT; it += w.NGW) {
        int r = it;
        if (r < I_IN) { const int l = r / 1536, rr = r % 1536, kb = rr / 96, nb = rr % 96;
            tr_item(A.in[I_WIN] + (size_t)l * DM * INC, INC, INC, kb * 64, nb * 32, (bf16*)(A.ws + WS_WIN) + (size_t)l * INCP * DM, (size_t)nb * 32, scr, w.lane); continue; }
        r -= I_IN;
        if (r < I_OUT) { const int l = r / 512, rr = r % 512, kb = rr / 32, nb = rr % 32;
            tr_item(A.in[I_WOUT] + (size_t)l * DM * DM, DM, DM, kb * 64, nb * 32, (bf16*)(A.ws + WS_WOUT) + (size_t)l * DM * DM, (size_t)nb * 32, scr, w.lane); continue; }
        r -= I_OUT;
        if (r < I_W1) { const int le = r / 1024, rr = r % 1024, kb = rr / 64, nb = rr % 64, j = nb >> 3, bj = (nb >> 2) & 1, cc0 = (nb & 3) * 32;
            tr_item(A.in[I_MW1] + (size_t)le * DM * 2048, 2048, 2048, kb * 64, bj * 1024 + 128 * j + cc0, (bf16*)(A.ws + WS_W1) + (size_t)le * 2048 * DM, (size_t)nb * 32, scr, w.lane); continue; }
        r -= I_W1;
        { const int le = r / 512, rr = r % 512, kb = rr / 32, nb = rr % 32;
            tr_item(A.in[I_MW2] + (size_t)le * DM * DM, DM, DM, kb * 64, nb * 32, (bf16*)(A.ws + WS_W2) + (size_t)le * DM * DM, (size_t)nb * 32, scr, w.lane); }
    }
    float* RT = (float*)(A.ws + WS_ROPE); const int* pos = (const int*)A.in[I_POS];
    for (int g = w.gw * 64 + w.lane; g < MTOK * 44; g += w.NGW * 64) {
        const int tok = g / 44, f = g % 44; int co, so;
        if (f < 32) { co = f; so = 32 + f; } else if (f < 40) { co = 64 + (f - 32); so = 72 + (f - 32); } else { co = 80 + (f - 40); so = 84 + (f - 40); }
        float s, c; sincos_d((double)pos[tok] * A.invf[f], s, c);
        RT[(size_t)tok * ROPE_W + co] = c; RT[(size_t)tok * ROPE_W + so] = s;
    }
}

__device__ __forceinline__ void emit_h_row(const f32x4 (&v)[4], float rstd, const float* g, const float* sc, const float* sh, bf16* hrow, int lane) {
#pragma unroll
    for (int j = 0; j < 4; ++j) { const int k = 4 * (lane + 64 * j);
        const f32x4 gv = *(const f32x4*)(g + k), scv = *(const f32x4*)(sc + k), shv = *(const f32x4*)(sh + k);
        const f32x4 h = v[j] * rstd * gv * (1.0f + scv) + shv;
        v2u o; o.x = pk2(h.x, h.y); o.y = pk2(h.z, h.w); *(v2u*)(hrow + k) = o; }
}
__device__ __forceinline__ void ph_norm1(ARef A, const WI& w) {
    const float* MOD = (const float*)(A.ws + WS_MOD); bf16* H = (bf16*)(A.ws + WS_H);
    for (int m = w.gw; m < MTOK; m += w.NGW) {
        const float* xr = A.in[I_X] + (size_t)m * DM; f32x4 v[4]; float ss = 0.0f;
#pragma unroll
        for (int j = 0; j < 4; ++j) { v[j] = *(const f32x4*)(xr + 4 * (w.lane + 64 * j)); ss += dot4(v[j], v[j]); }
        ss = wave_sum(ss); const float rstd = 1.0f / sqrtf(ss * (1.0f / DM) + 1e-5f);
        const float* mb = MOD + (size_t)(m >> 12) * 6144;
        emit_h_row(v, rstd, A.in[I_NMIX], mb + 1024, mb, H + (size_t)m * DM, w.lane);
    }
}

__device__ __forceinline__ void prep8(ARef A, int l, int m0, int lane, LAS float* xs, LAS float* cs) {
    const float* P = (const float*)(A.ws + WS_P); float* RWA = (float*)(A.ws + WS_RWA); const int c4 = 4 * lane;
    const float* mu = A.in[I_MU] + l * 896;
#pragma unroll
    for (int tk = 0; tk < 8; ++tk) { const int m = m0 + tk, t = m & (SEQ - 1); const float* pr = P + (size_t)m * INCP + C_RW; const float* pp = pr - INCP; const float* pd = P + (size_t)m * INCP + C_DSA;
        float x0, x1;
        { const float z = pr[768 + lane], p = t ? pp[768 + lane] : 0.0f; x0 = z + (p - z) * mu[768 + lane]; }
        { const float z = pr[832 + lane], p = t ? pp[832 + lane] : 0.0f; x1 = z + (p - z) * mu[832 + lane]; }
        xs[lane * 8 + tk] = (lane < 32) ? tanhf(x0) : x0; xs[(64 + lane) * 8 + tk] = sigm(x1);
        float c0 = pd[lane], c1 = pd[64 + lane];
        const float rstd = 1.0f / sqrtf(wave_sum(c0 * c0 + c1 * c1) * (1.0f / 128.0f) + 1e-5f);
        cs[lane * 8 + tk] = c0 * rstd * A.in[I_QNORM][l * 128 + lane]; cs[(64 + lane) * 8 + tk] = c1 * rstd * A.in[I_QNORM][l * 128 + 64 + lane]; }
    LDS_WAIT();
    { f32x4 acc[8]; const f32x4 w0 = *(const f32x4*)(A.in[I_W0] + l * 256 + c4); const float* w2 = A.in[I_W2] + l * 32 * 256 + c4;
#pragma unroll
      for (int tk = 0; tk < 8; ++tk) acc[tk] = w0;
#pragma unroll 4
      for (int i = 0; i < 32; ++i) { const f32x4 wv = *(const f32x4*)(w2 + i * 256); const f32x4 xa = *(const LAS f32x4*)(xs + i * 8), xb = *(const LAS f32x4*)(xs + i * 8 + 4);
          acc[0] += xa.x * wv; acc[1] += xa.y * wv; acc[2] += xa.z * wv; acc[3] += xa.w * wv; acc[4] += xb.x * wv; acc[5] += xb.y * wv; acc[6] += xb.z * wv; acc[7] += xb.w * wv; }
#pragma unroll
      for (int tk = 0; tk < 8; ++tk) { f32x4 dec;
#pragma unroll
          for (int i = 0; i < 4; ++i) dec[i] = expf(-expf(-softplusf(-acc[tk][i]) - 0.5f));
          *(f32x4*)(RWA + 1 * RWA_STRIDE + (size_t)(m0 + tk) * 256 + c4) = dec; } }
    { f32x4 acc[8]; const float* g2 = A.in[I_G2] + l * 64 * 256 + c4;
#pragma unroll
      for (int tk = 0; tk < 8; ++tk) acc[tk] = (f32x4){0.f, 0.f, 0.f, 0.f};
#pragma unroll 4
      for (int i = 0; i < 64; ++i) { const f32x4 wv = *(const f32x4*)(g2 + i * 256); const f32x4 xa = *(const LAS f32x4*)(xs + (64 + i) * 8), xb = *(const LAS f32x4*)(xs + (64 + i) * 8 + 4);
          acc[0] += xa.x * wv; acc[1] += xa.y * wv; acc[2] += xa.z * wv; acc[3] += xa.w * wv; acc[4] += xb.x * wv; acc[5] += xb.y * wv; acc[6] += xb.z * wv; acc[7] += xb.w * wv; }
#pragma unroll
      for (int tk = 0; tk < 8; ++tk) *(f32x4*)(RWA + 6 * RWA_STRIDE + (size_t)(m0 + tk) * 256 + c4) = acc[tk]; }
    { f32x4 acc[8]; const f32x4 a0 = *(const f32x4*)(A.in[I_A0] + l * 256 + c4); const float* a2 = A.in[I_A2] + l * 32 * 256 + c4;
#pragma unroll
      for (int tk = 0; tk < 8; ++tk) acc[tk] = a0;
#pragma unroll 4
      for (int i = 0; i < 32; ++i) { const f32x4 wv = *(const f32x4*)(a2 + i * 256); const f32x4 xa = *(const LAS f32x4*)(xs + (32 + i) * 8), xb = *(const LAS f32x4*)(xs + (32 + i) * 8 + 4);
          acc[0] += xa.x * wv; acc[1] += xa.y * wv; acc[2] += xa.z * wv; acc[3] += xa.w * wv; acc[4] += xb.x * wv; acc[5] += xb.y * wv; acc[6] += xb.z * wv; acc[7] += xb.w * wv; }
      const f32x4 kkw = *(const f32x4*)(A.in[I_KK] + l * 256 + c4), kaw = *(const f32x4*)(A.in[I_KA] + l * 256 + c4), rkw = *(const f32x4*)(A.in[I_RK] + l * 256 + c4);
      const f32x4 mur = *(const f32x4*)(mu + c4), muk = *(const f32x4*)(mu + 256 + c4), muv = *(const f32x4*)(mu + 512 + c4);
#pragma unroll
      for (int tk = 0; tk < 8; ++tk) { const int m = m0 + tk, t = m & (SEQ - 1); const float* pr = P + (size_t)m * INCP + C_RW; const float* pp = pr - INCP;
          f32x4 av;
#pragma unroll
          for (int i = 0; i < 4; ++i) av[i] = sigm(acc[tk][i]);
          f32x4 fr, fk, fv; const f32x4 zero4 = {0.f, 0.f, 0.f, 0.f};
          { const f32x4 z = *(const f32x4*)(pr + c4); const f32x4 p = t ? *(const f32x4*)(pp + c4) : zero4; fr = z + (p - z) * mur; }
          { const f32x4 z = *(const f32x4*)(pr + 256 + c4); const f32x4 p = t ? *(const f32x4*)(pp + 256 + c4) : zero4; fk = z + (p - z) * muk; }
          { const f32x4 z = *(const f32x4*)(pr + 512 + c4); const f32x4 p = t ? *(const f32x4*)(pp + 512 + c4) : zero4; fv = z + (p - z) * muv; }
          f32x4 kk = fk * kkw; const float nrm = fmaxf(sqrtf(grp16_sum(dot4(kk, kk))), 1e-12f); kk = kk / nrm;
          const f32x4 kmod = fk * (1.0f + (av - 1.0f) * kaw); const f32x4 bb = kk * av; const float bs = grp16_sum(dot4(fr * kmod, rkw));
          const size_t o = (size_t)m * 256 + c4;
          *(f32x4*)(RWA + 0 * RWA_STRIDE + o) = fr; *(f32x4*)(RWA + 2 * RWA_STRIDE + o) = kmod; *(f32x4*)(RWA + 3 * RWA_STRIDE + o) = fv;
          *(f32x4*)(RWA + 4 * RWA_STRIDE + o) = -kk; *(f32x4*)(RWA + 5 * RWA_STRIDE + o) = bb; *(f32x4*)(RWA + 7 * RWA_STRIDE + o) = bs * fv; } }
    { f32x4 aq[8], ai[8]; const float* wq = A.in[I_WQ] + (size_t)l * 128 * 256 + c4; const float* wqi = A.in[I_WQI] + (size_t)l * 128 * 256 + c4;
#pragma unroll
      for (int tk = 0; tk < 8; ++tk) { aq[tk] = (f32x4){0.f, 0.f, 0.f, 0.f}; ai[tk] = (f32x4){0.f, 0.f, 0.f, 0.f}; }
#pragma unroll 2
      for (int i = 0; i < 128; ++i) { const f32x4 w1 = *(const f32x4*)(wq + i * 256), w2v = *(const f32x4*)(wqi + i * 256); const f32x4 xa = *(const LAS f32x4*)(cs + i * 8), xb = *(const LAS f32x4*)(cs + i * 8 + 4);
          aq[0] += xa.x * w1; aq[1] += xa.y * w1; aq[2] += xa.z * w1; aq[3] += xa.w * w1; aq[4] += xb.x * w1; aq[5] += xb.y * w1; aq[6] += xb.z * w1; aq[7] += xb.w * w1;
          ai[0] += xa.x * w2v; ai[1] += xa.y * w2v; ai[2] += xa.z * w2v; ai[3] += xa.w * w2v; ai[4] += xb.x * w2v; ai[5] += xb.y * w2v; ai[6] += xb.z * w2v; ai[7] += xb.w * w2v; }
#pragma unroll
      for (int tk = 0; tk < 8; ++tk) { const int m = m0 + tk; const float* RT = (const float*)(A.ws + WS_ROPE) + (size_t)m * ROPE_W; const float* pd = P + (size_t)m * INCP + C_DSA;
          f32x4 q = aq[tk], qi = ai[tk];
          { const int r = lane & 15; const f32x4 ot = shx4(q, 2);
            if (r < 4) { const int fi = 4 * (r & 1); const f32x4 cs4 = *(const f32x4*)(RT + 64 + fi), sn = *(const f32x4*)(RT + 72 + fi); q = (r < 2) ? q * cs4 - ot * sn : ot * sn + q * cs4; } }
          { const int r = lane & 7; const f32x4 ot = shx4(qi, 1);
            if (r < 2) { const f32x4 cs4 = *(const f32x4*)(RT + 80), sn = *(const f32x4*)(RT + 84); qi = (r < 1) ? qi * cs4 - ot * sn : ot * sn + qi * cs4; } }
          { const f32x4 qs = q * 0.18033688011112042f; v2u o; o.x = pk2(qs.x, qs.y); o.y = pk2(qs.z, qs.w); *(v2u*)((bf16*)(A.ws + WS_DQ) + (size_t)m * 256 + c4) = o; }
          { typedef _Float16 h4 __attribute__((ext_vector_type(4))); h4 hq; hq.x = (_Float16)qi.x; hq.y = (_Float16)qi.y; hq.z = (_Float16)qi.z; hq.w = (_Float16)qi.w; *(h4*)((_Float16*)(A.ws + WS_DQI) + (size_t)m * 256 + c4) = hq; }
          { const int r = lane & 15; f32x4 kx = *(const f32x4*)(pd + 128 + 4 * r); const f32x4 ot = shx4(kx, 2);
            if (r < 4) { const int fi = 4 * (r & 1); const f32x4 cs4 = *(const f32x4*)(RT + 64 + fi), sn = *(const f32x4*)(RT + 72 + fi); kx = (r < 2) ? kx * cs4 - ot * sn : ot * sn + kx * cs4; }
            if (lane < 16) { v2u o; o.x = pk2(kx.x, kx.y); o.y = pk2(kx.z, kx.w); *(v2u*)((bf16*)(A.ws + WS_DKB) + (size_t)m * 64 + c4) = o;
                             const f32x4 vx = *(const f32x4*)(pd + 192 + c4); v2u ov; ov.x = pk2(vx.x, vx.y); ov.y = pk2(vx.z, vx.w); *(v2u*)((bf16*)(A.ws + WS_DVB) + (size_t)m * 64 + c4) = ov; } }
          { const int r = lane & 7; f32x4 ki = *(const f32x4*)(pd + 256 + 4 * r); const f32x4 ot = shx4(ki, 1);
            if (r < 2) { const f32x4 cs4 = *(const f32x4*)(RT + 80), sn = *(const f32x4*)(RT + 84); ki = (r < 1) ? ki * cs4 - ot * sn : ot * sn + ki * cs4; }
            if (lane < 8) { typedef _Float16 h4 __attribute__((ext_vector_type(4))); h4 hk; hk.x = (_Float16)ki.x; hk.y = (_Float16)ki.y; hk.z = (_Float16)ki.z; hk.w = (_Float16)ki.w; *(h4*)((_Float16*)(A.ws + WS_DKI) + (size_t)m * 32 + c4) = hk; }
            if (lane < 2) *(f32x4*)((float*)(A.ws + WS_DW) + (size_t)m * 8 + c4) = *(const f32x4*)(pd + 288 + c4) * 0.0625f; } } }
    LDS_WAIT();
}
__device__ __forceinline__ void sb_prep(ARef A, int m, int lane) {
    const float* ps = (const float*)(A.ws + WS_P) + (size_t)m * INCP + C_SB + 4 * lane;
    const f32x4 q = *(const f32x4*)ps * 0.18033688011112042f, k = *(const f32x4*)(ps + 256), v = *(const f32x4*)(ps + 512);
    v2u o; o.x = pk2(q.x, q.y); o.y = pk2(q.z, q.w); *(v2u*)((bf16*)(A.ws + WS_SQ) + (size_t)m * 256 + 4 * lane) = o;
    o.x = pk2(k.x, k.y); o.y = pk2(k.z, k.w); *(v2u*)((bf16*)(A.ws + WS_SK) + (size_t)m * 256 + 4 * lane) = o;
    o.x = pk2(v.x, v.y); o.y = pk2(v.z, v.w); *(v2u*)((bf16*)(A.ws + WS_SV) + (size_t)m * 256 + 4 * lane) = o;
}

__device__ __forceinline__ float quad_sum(float v) {
    v += __builtin_bit_cast(float, __builtin_amdgcn_mov_dpp(__builtin_bit_cast(int, v), 0xB1, 0xF, 0xF, true));
    v += __builtin_bit_cast(float, __builtin_amdgcn_mov_dpp(__builtin_bit_cast(int, v), 0x4E, 0xF, 0xF, true));
    return v;
}
__device__ __forceinline__ float oct_sum(float v) {
    v += __builtin_bit_cast(float, __builtin_amdgcn_mov_dpp(__builtin_bit_cast(int, v), 0xB1, 0xF, 0xF, true));
    v += __builtin_bit_cast(float, __builtin_amdgcn_mov_dpp(__builtin_bit_cast(int, v), 0x4E, 0xF, 0xF, true));
    v += __builtin_bit_cast(float, __builtin_amdgcn_mov_dpp(__builtin_bit_cast(int, v), 0x141, 0xF, 0xF, true));
    return v;
}
#define RW_LOAD(op, s_) do { const int lo_ = (s_) * 64 + kq * 8; \
    op[0] = *(const LAS f32x4*)(sn + lo_); op[1] = *(const LAS f32x4*)(sn + lo_ + 4); op[2] = *(const LAS f32x4*)(sw + lo_); op[3] = *(const LAS f32x4*)(sw + lo_ + 4); \
    op[4] = *(const LAS f32x4*)(sb + lo_); op[5] = *(const LAS f32x4*)(sb + lo_ + 4); op[6] = *(const LAS f32x4*)(sk + lo_); op[7] = *(const LAS f32x4*)(sk + lo_ + 4); \
    op[8] = *(const LAS f32x4*)(sr + lo_); op[9] = *(const LAS f32x4*)(sr + lo_ + 4); \
    _Pragma("unroll") for (int i_ = 0; i_ < 4; ++i_) vin[i_] = (ws < 2) ? sv[(s_) * 64 + rbase + 8 * i_] : 0.0f; } while (0)
#define RW_STEP(op, vv, s_) do { \
    _Pragma("unroll") for (int i_ = 0; i_ < 4; ++i_) { \
        float sa_ = (S[i_][0] * op[0].x + S[i_][1] * op[0].y) + (S[i_][2] * op[0].z + S[i_][3] * op[0].w) + ((S[i_][4] * op[1].x + S[i_][5] * op[1].y) + (S[i_][6] * op[1].z + S[i_][7] * op[1].w)); \
        sa_ = oct_sum(sa_); const float v_ = vv[i_]; \
        S[i_][0] = S[i_][0] * op[2].x + (sa_ * op[4].x + v_ * op[6].x); S[i_][1] = S[i_][1] * op[2].y + (sa_ * op[4].y + v_ * op[6].y); S[i_][2] = S[i_][2] * op[2].z + (sa_ * op[4].z + v_ * op[6].z); S[i_][3] = S[i_][3] * op[2].w + (sa_ * op[4].w + v_ * op[6].w); \
        S[i_][4] = S[i_][4] * op[3].x + (sa_ * op[5].x + v_ * op[7].x); S[i_][5] = S[i_][5] * op[3].y + (sa_ * op[5].y + v_ * op[7].y); S[i_][6] = S[i_][6] * op[3].z + (sa_ * op[5].z + v_ * op[7].z); S[i_][7] = S[i_][7] * op[3].w + (sa_ * op[5].w + v_ * op[7].w); \
        float y_ = (S[i_][0] * op[8].x + S[i_][1] * op[8].y) + (S[i_][2] * op[8].z + S[i_][3] * op[8].w) + ((S[i_][4] * op[9].x + S[i_][5] * op[9].y) + (S[i_][6] * op[9].z + S[i_][7] * op[9].w)); \
        y_ = oct_sum(y_); if (kq == 0) so[(s_) * 128 + rbase + 8 * i_] = y_; } } while (0)
__device__ __forceinline__ void scan_rwkv_task2(ARef A, const WI& w, int task0) {
    const int slot = w.wave >> 2, ws = w.wave & 3, lt = w.tid & 255, task = task0 + slot;
    const int bh = task >> 4, c = task & 15, b = bh >> 2, h = bh & 3;
    LAS float* sw = (LAS float*)w.lds + slot * 16384; LAS float* sn = sw + 2048; LAS float* sb = sn + 2048; LAS float* sk = sb + 2048; LAS float* sr = sk + 2048; LAS float* sv = sr + 2048; LAS float* so = sv + 2048;
    const float* RWA = (const float*)(A.ws + WS_RWA);
    const int rg = w.lane >> 3, kq = w.lane & 7, rbase = 32 * ws + rg;
    float S[4][8];
#pragma unroll
    for (int i = 0; i < 4; ++i)
#pragma unroll
        for (int j = 0; j < 8; ++j) { const int r = rbase + 8 * i; S[i][j] = (r >= 64 && 8 * kq + j == r - 64) ? 1.0f : 0.0f; }
    const size_t tok0 = (size_t)b * SEQ + (size_t)c * TCH;
    const int st = lt >> 3, sd = (lt & 7) * 8;
    for (int sub = 0; sub < TCH / 32; ++sub) {
        const size_t o = (tok0 + sub * 32 + st) * 256 + h * 64 + sd;
        f32x4 a[6][2];
#pragma unroll
        for (int q = 0; q < 2; ++q) { a[0][q] = *(const f32x4*)(RWA + 1 * RWA_STRIDE + o + 4 * q); a[1][q] = *(const f32x4*)(RWA + 4 * RWA_STRIDE + o + 4 * q); a[2][q] = *(const f32x4*)(RWA + 5 * RWA_STRIDE + o + 4 * q);
            a[3][q] = *(const f32x4*)(RWA + 2 * RWA_STRIDE + o + 4 * q); a[4][q] = *(const f32x4*)(RWA + 0 * RWA_STRIDE + o + 4 * q); a[5][q] = *(const f32x4*)(RWA + 3 * RWA_STRIDE + o + 4 * q); }
        __syncthreads();
        { const int lo = st * 64 + sd;
#pragma unroll
          for (int q = 0; q < 2; ++q) { *(LAS f32x4*)(sw + lo + 4 * q) = a[0][q]; *(LAS f32x4*)(sn + lo + 4 * q) = a[1][q]; *(LAS f32x4*)(sb + lo + 4 * q) = a[2][q]; *(LAS f32x4*)(sk + lo + 4 * q) = a[3][q]; *(LAS f32x4*)(sr + lo + 4 * q) = a[4][q]; *(LAS f32x4*)(sv + lo + 4 * q) = a[5][q]; } }
        __syncthreads();
        { f32x4 opA[10], opB[10]; float vin[4], vA[4], vB[4];
          RW_LOAD(opA, 0);
#pragma unroll
          for (int i = 0; i < 4; ++i) vA[i] = vin[i];
#pragma unroll 1
          for (int s = 0; s < 32; s += 2) {
              RW_LOAD(opB, s + 1);
#pragma unroll
              for (int i = 0; i < 4; ++i) vB[i] = vin[i];
              RW_STEP(opA, vA, s);
              if (s + 2 < 32) { RW_LOAD(opA, s + 2);
#pragma unroll
                  for (int i = 0; i < 4; ++i) vA[i] = vin[i]; }
              RW_STEP(opB, vB, s + 1);
          } }
        __syncthreads();
        { const int fs = lt >> 3, c16 = (lt & 7) * 16;
          float* dst = (c16 < 64) ? ((float*)(A.ws + WS_YO) + YO_STRIDE) : ((float*)(A.ws + WS_PT) - 64);
          float* dp = dst + (tok0 + sub * 32 + fs) * 256 + h * 64 + c16;
#pragma unroll
          for (int q = 0; q < 4; ++q) *(f32x4*)(dp + 4 * q) = *(const LAS f32x4*)(so + fs * 128 + c16 + 4 * q); }
    }
    { float* ch = (float*)(A.ws + WS_CH) + ((size_t)(bh * NCH + c) * 128) * 64 + 8 * kq;
#pragma unroll
      for (int i = 0; i < 4; ++i) { float* cr = ch + (size_t)(rbase + 8 * i) * 64; *(f32x4*)cr = (f32x4){S[i][0], S[i][1], S[i][2], S[i][3]}; *(f32x4*)(cr + 4) = (f32x4){S[i][4], S[i][5], S[i][6], S[i][7]}; } }
    __syncthreads();
}
#undef RW_LOAD
#undef RW_STEP
__device__ __forceinline__ void scan_ret_task(ARef A, const WI& w, int task) {
    const int bh = task >> 3, cp = task & 7, b = bh >> 2, h = bh & 3, un = w.tid >> 8, lt = w.tid & 255, c = 2 * cp + un;
    const float lg2g = log2f(1.0f - exp2f(-5.0f - (float)h)), gamma = exp2f(lg2g);
    LAS float* sk = (LAS float*)w.lds + un * 8192; LAS float* sq = sk + 2048; LAS float* sv = sq + 2048; LAS float* so = sv + 2048;
    const float* P = (const float*)(A.ws + WS_P); const float* RT = (const float*)(A.ws + WS_ROPE);
    const int row = lt >> 2, kq = lt & 3;
    float S[16];
#pragma unroll
    for (int j = 0; j < 16; ++j) S[j] = 0.0f;
    const size_t tok0 = (size_t)b * SEQ + (size_t)c * TCH;
    const int st = lt >> 3, sd = (lt & 7) * 8;
    for (int sub = 0; sub < TCH / 32; ++sub) {
        const size_t m = tok0 + sub * 32 + st; const float* pr = P + m * INCP + C_RET + h * 64; const float* rt = RT + m * ROPE_W; const int fi = sd & 31, dp = sd ^ 32;
        f32x4 qn[2], kn[2], vn[2];
#pragma unroll
        for (int u = 0; u < 2; ++u) { const f32x4 cs = *(const f32x4*)(rt + fi + 4 * u), sn = *(const f32x4*)(rt + 32 + fi + 4 * u);
            const f32x4 qm = *(const f32x4*)(pr + sd + 4 * u), qo = *(const f32x4*)(pr + dp + 4 * u), km = *(const f32x4*)(pr + 256 + sd + 4 * u), ko = *(const f32x4*)(pr + 256 + dp + 4 * u);
            qn[u] = (sd < 32) ? qm * cs - qo * sn : qo * sn + qm * cs; kn[u] = ((sd < 32) ? km * cs - ko * sn : ko * sn + km * cs) * 0.125f; vn[u] = *(const f32x4*)(pr + 512 + sd + 4 * u); }
        { const float gt = exp2f(lg2g * (float)(sub * 32 + st + 1)); const f32x4 p0 = qn[0] * gt, p1 = qn[1] * gt;
          v4u pw; pw.x = pk2(p0.x, p0.y); pw.y = pk2(p0.z, p0.w); pw.z = pk2(p1.x, p1.y); pw.w = pk2(p1.z, p1.w); *(v4u*)((bf16*)(A.ws + WS_PTR) + m * 256 + h * 64 + sd) = pw; }
        __syncthreads();
        { const int lo = st * 64 + sd; *(LAS f32x4*)(sq + lo) = qn[0]; *(LAS f32x4*)(sq + lo + 4) = qn[1]; *(LAS f32x4*)(sk + lo) = kn[0]; *(LAS f32x4*)(sk + lo + 4) = kn[1]; *(LAS f32x4*)(sv + lo) = vn[0]; *(LAS f32x4*)(sv + lo + 4) = vn[1]; }
        __syncthreads();
        for (int s = 0; s < 32; ++s) {
            const int lo = s * 64 + kq * 16; const float vv = sv[s * 64 + row]; float y = 0.0f;
#pragma unroll
            for (int j4 = 0; j4 < 4; ++j4) { const f32x4 kv = *(const LAS f32x4*)(sk + lo + 4 * j4), rv = *(const LAS f32x4*)(sq + lo + 4 * j4);
                S[4 * j4] = S[4 * j4] * gamma + vv * kv.x; S[4 * j4 + 1] = S[4 * j4 + 1] * gamma + vv * kv.y; S[4 * j4 + 2] = S[4 * j4 + 2] * gamma + vv * kv.z; S[4 * j4 + 3] = S[4 * j4 + 3] * gamma + vv * kv.w;
                y += (S[4 * j4] * rv.x + S[4 * j4 + 1] * rv.y) + (S[4 * j4 + 2] * rv.z + S[4 * j4 + 3] * rv.w); }
            y = quad_sum(y);
            if (kq == 0) so[s * 64 + row] = y;
        }
        __syncthreads();
        { const int fs = lt >> 3, c8 = (lt & 7) * 8; float* dp2 = (float*)(A.ws + WS_YO) + (tok0 + sub * 32 + fs) * 256 + h * 64 + c8;
          *(f32x4*)dp2 = *(const LAS f32x4*)(so + fs * 64 + c8); *(f32x4*)(dp2 + 4) = *(const LAS f32x4*)(so + fs * 64 + c8 + 4); }
    }
    { float* ch = (float*)(A.ws + WS_CHR) + ((size_t)(bh * NCH + c) * 64 + row) * 64 + 16 * kq;
#pragma unroll
      for (int j4 = 0; j4 < 4; ++j4) *(f32x4*)(ch + 4 * j4) = (f32x4){S[4 * j4], S[4 * j4 + 1], S[4 * j4 + 2], S[4 * j4 + 3]}; }
    __syncthreads();
}
__device__ __forceinline__ void prefix_chain(ARef A, const WI& w, int bh) {
    LAS float* s0 = (LAS float*)w.lds;
    const int v = w.tid >> 3, k8 = (w.tid & 7) * 8;
    const float* CH = (const float*)(A.ws + WS_CH) + (size_t)bh * NCH * 128 * 64; float* SI = (float*)(A.ws + WS_SI) + (size_t)bh * NCH * 64 * 64;
    f32x4 c0 = {0.f, 0.f, 0.f, 0.f}, c1 = {0.f, 0.f, 0.f, 0.f};
    for (int c = 0; c < NCH; ++c) {
        *(f32x4*)(SI + ((size_t)c * 64 + v) * 64 + k8) = c0; *(f32x4*)(SI + ((size_t)c * 64 + v) * 64 + k8 + 4) = c1;
        if (c == NCH - 1) break;
        __syncthreads();
        *(LAS f32x4*)(s0 + v * 68 + k8) = c0; *(LAS f32x4*)(s0 + v * 68 + k8 + 4) = c1;
        __syncthreads();
        const float* ch = CH + (size_t)c * 128 * 64;
        f32x4 n0 = *(const f32x4*)(ch + (size_t)v * 64 + k8), n1 = *(const f32x4*)(ch + (size_t)v * 64 + k8 + 4);
#pragma unroll 8
        for (int kp = 0; kp < 64; ++kp) { const float s = s0[v * 68 + kp]; const float* pr = ch + (size_t)(64 + kp) * 64 + k8; n0 += s * *(const f32x4*)pr; n1 += s * *(const f32x4*)(pr + 4); }
        c0 = n0; c1 = n1;
    }
    const int h = bh & 3; const float gT = exp2f((float)TCH * log2f(1.0f - exp2f(-5.0f - (float)h)));
    const float* CHR = (const float*)(A.ws + WS_CHR) + (size_t)bh * NCH * 64 * 64; float* SIR = (float*)(A.ws + WS_SIR) + (size_t)bh * NCH * 64 * 64;
    c0 = (f32x4){0.f, 0.f, 0.f, 0.f}; c1 = c0;
    for (int c = 0; c < NCH; ++c) {
        *(f32x4*)(SIR + ((size_t)c * 64 + v) * 64 + k8) = c0; *(f32x4*)(SIR + ((size_t)c * 64 + v) * 64 + k8 + 4) = c1;
        if (c == NCH - 1) break;
        c0 = c0 * gT + *(const f32x4*)(CHR + ((size_t)c * 64 + v) * 64 + k8); c1 = c1 * gT + *(const f32x4*)(CHR + ((size_t)c * 64 + v) * 64 + k8 + 4);
    }
    __syncthreads();
}
typedef float f32x16 __attribute__((ext_vector_type(16)));
constexpr int SBV_PITCH = 144;
__device__ __forceinline__ float lane32_swap(float v) { return __shfl_xor(v, 32); }
__device__ __forceinline__ void sb_tile_mfma(ARef A, int unit, int lane, LAS unsigned char* vl) {
    const int tq = unit & 127, bh = unit >> 7, b = bh >> 2, h = bh & 3, t0 = tq * 32, r32 = lane & 31, hi = lane >> 5;
    const float* PS = (const float*)(A.ws + WS_P) + (size_t)b * SEQ * INCP + C_SB + h * 64;
    bf16x8v qf[4];
#pragma unroll
    for (int ks = 0; ks < 4; ++ks) { const float* qp = PS + (size_t)(t0 + r32) * INCP + 16 * ks + 8 * hi; const f32x4 x = *(const f32x4*)qp * 0.18033688011112042f, y = *(const f32x4*)(qp + 4) * 0.18033688011112042f;
        pg8::u32x4 wv; wv.x = pk2(x.x, x.y); wv.y = pk2(x.z, x.w); wv.z = pk2(y.x, y.y); wv.w = pk2(y.z, y.w); qf[ks] = __builtin_bit_cast(bf16x8v, wv); }
    f32x16 o0, o1;
#pragma unroll
    for (int r = 0; r < 16; ++r) { o0[r] = 0.0f; o1[r] = 0.0f; }
    float carry = 0.0f;
    const int g16 = lane >> 4, tj = (lane & 15) >> 2, tc = lane & 3;
    for (int kb0 = t0; kb0 >= 0; kb0 -= 32) {
#pragma unroll
        for (int i = 0; i < 4; ++i) { const int p = lane + 64 * i, row = p >> 3, ch = p & 7; const float* vp = PS + 512 + (size_t)(kb0 + row) * INCP + 8 * ch; const f32x4 x = *(const f32x4*)vp, y = *(const f32x4*)(vp + 4);
            v4u v; v.x = pk2(x.x, x.y); v.y = pk2(x.z, x.w); v.z = pk2(y.x, y.y); v.w = pk2(y.z, y.w); *(LAS v4u*)(vl + row * SBV_PITCH + 16 * ch) = v; }
        f32x16 st;
#pragma unroll
        for (int r = 0; r < 16; ++r) st[r] = 0.0f;
#pragma unroll
        for (int ks = 0; ks < 4; ++ks) { const float* kp = PS + 256 + (size_t)(kb0 + r32) * INCP + 16 * ks + 8 * hi; const f32x4 x = *(const f32x4*)kp, y = *(const f32x4*)(kp + 4);
            pg8::u32x4 wv; wv.x = pk2(x.x, x.y); wv.y = pk2(x.z, x.w); wv.z = pk2(y.x, y.y); wv.w = pk2(y.z, y.w); st = __builtin_amdgcn_mfma_f32_32x32x16_bf16(__builtin_bit_cast(bf16x8v, wv), qf[ks], st, 0, 0, 0); }
        float sp[16]; const bool diag = (kb0 == t0);
#pragma unroll
        for (int r = 0; r < 16; ++r) { const float zl = st[r]; float s = (zl > 30.0f) ? zl : __builtin_amdgcn_logf(1.0f + __builtin_amdgcn_exp2f(zl));
            if (diag && ((r & 3) + 8 * (r >> 2) + 4 * hi >= r32)) s = 0.0f;
            sp[r] = s; }
        float G[4], Gp[4], suf[4];
#pragma unroll
        for (int q = 0; q < 4; ++q) { G[q] = (sp[4 * q] + sp[4 * q + 1]) + (sp[4 * q + 2] + sp[4 * q + 3]); Gp[q] = lane32_swap(G[q]); }
        suf[3] = 0.0f; suf[2] = G[3] + Gp[3]; suf[1] = suf[2] + (G[2] + Gp[2]); suf[0] = suf[1] + (G[1] + Gp[1]);
        const float tot = suf[0] + (G[0] + Gp[0]);
        pg8::u32x4 pw0, pw1;
        float av[16];
#pragma unroll
        for (int q = 0; q < 4; ++q) { float run = carry + suf[q] + (hi == 0 ? Gp[q] : 0.0f);
#pragma unroll
            for (int i = 3; i >= 0; --i) { const int r = 4 * q + i; const float la = (st[r] - sp[r]) - run; float a = __builtin_amdgcn_exp2f(la);
                if (diag && ((r & 3) + 8 * (r >> 2) + 4 * hi >= r32)) a = 0.0f;
                av[r] = a; run += sp[r]; } }
        pw0.x = pg8::cvt_pk_bf16(av[0], av[1]); pw0.y = pg8::cvt_pk_bf16(av[2], av[3]); pw0.z = pg8::cvt_pk_bf16(av[4], av[5]); pw0.w = pg8::cvt_pk_bf16(av[6], av[7]);
        pw1.x = pg8::cvt_pk_bf16(av[8], av[9]); pw1.y = pg8::cvt_pk_bf16(av[10], av[11]); pw1.z = pg8::cvt_pk_bf16(av[12], av[13]); pw1.w = pg8::cvt_pk_bf16(av[14], av[15]);
        const bf16x8v pa0 = __builtin_bit_cast(bf16x8v, pw0), pa1 = __builtin_bit_cast(bf16x8v, pw1);
        LDS_WAIT();
#pragma unroll
        for (int s = 0; s < 2; ++s)
#pragma unroll
            for (int nb = 0; nb < 2; ++nb) {
                LAS unsigned char* a1 = vl + (16 * s + 4 * (g16 >> 1) + tj) * SBV_PITCH + (32 * nb + 16 * (g16 & 1) + 4 * tc) * 2;
                const s16x4v r1 = __builtin_bit_cast(s16x4v, __builtin_amdgcn_ds_read_tr16_b64_v4i16((LAS s16x4v*)a1));
                const s16x4v r2 = __builtin_bit_cast(s16x4v, __builtin_amdgcn_ds_read_tr16_b64_v4i16((LAS s16x4v*)(a1 + 8 * SBV_PITCH)));
                const bf16x8v bv = {r1[0], r1[1], r1[2], r1[3], r2[0], r2[1], r2[2], r2[3]};
                if (nb == 0) o0 = __builtin_amdgcn_mfma_f32_32x32x16_bf16(s ? pa1 : pa0, bv, o0, 0, 0, 0); else o1 = __builtin_amdgcn_mfma_f32_32x32x16_bf16(s ? pa1 : pa0, bv, o1, 0, 0, 0); }
        LDS_WAIT();
        carry += tot;
        if (__all(carry > 150.0f)) break;
    }
    float* YS = (float*)(A.ws + WS_YO) + 3 * YO_STRIDE + ((size_t)b * SEQ + t0) * 256 + h * 64 + r32;
#pragma unroll
    for (int r = 0; r < 16; ++r) { const int qo = (r & 3) + 8 * (r >> 2) + 4 * hi; YS[(size_t)qo * 256] = o0[r]; YS[(size_t)qo * 256 + 32] = o1[r]; }
}

typedef _Float16 f16x8 __attribute__((ext_vector_type(8)));
__device__ __forceinline__ void dsa_scores_mfma(ARef A, const WI& w) {
    const _Float16* QIH = (const _Float16*)(A.ws + WS_DQI); const _Float16* KIH = (const _Float16*)(A.ws + WS_DKI);
    const float* DW = (const float*)(A.ws + WS_DW); float* SC = (float*)(A.ws + WS_SC);
    const int col = w.lane & 15, q4 = w.lane >> 4;
    for (int u = w.gw; u < 2048; u += w.NGW) {
        const int pi = u >> 1, par = u & 1, b = pi >> 7, p = pi & 127;
#pragma unroll 1
        for (int side = 0; side < 2; ++side) {
            const int qb = side ? 255 - p : p; const size_t m0 = (size_t)b * SEQ + 16 * qb;
            f16x8 bq[8];
#pragma unroll
            for (int h = 0; h < 8; ++h) bq[h] = *(const f16x8*)(QIH + (m0 + col) * 256 + h * 32 + 8 * q4);
            const float* dw = DW + (m0 + col) * 8; const f32x4 wa = *(const f32x4*)dw, wb = *(const f32x4*)(dw + 4);
            float* srow = SC + (m0 + col) * SEQ + 4 * q4;
            const _Float16* kbase = KIH + ((size_t)b * SEQ + col) * 32 + 8 * q4;
            for (int kb = par; kb <= qb; kb += 2) {
                const f16x8 ak = *(const f16x8*)(kbase + (size_t)kb * 16 * 32);
                f32x4 acc = {0.f, 0.f, 0.f, 0.f};
#pragma unroll
                for (int h = 0; h < 8; ++h) { const f32x4 c = __builtin_amdgcn_mfma_f32_16x16x32_f16(ak, bq[h], (f32x4){0.f, 0.f, 0.f, 0.f}, 0, 0, 0); const float wv = (h < 4) ? wa[h] : wb[h - 4];
                    acc.x += wv * fmaxf(c.x, 0.f); acc.y += wv * fmaxf(c.y, 0.f); acc.z += wv * fmaxf(c.z, 0.f); acc.w += wv * fmaxf(c.w, 0.f); }
                *(f32x4*)(srow + 16 * kb) = acc + 0.0f;
            }
        }
    }
}

__device__ __forceinline__ int wave_total_i(int v) {
    v += __builtin_amdgcn_mov_dpp(v, 0xB1, 0xF, 0xF, true);
    v += __builtin_amdgcn_mov_dpp(v, 0x4E, 0xF, 0xF, true);
    v += __builtin_amdgcn_mov_dpp(v, 0x141, 0xF, 0xF, true);
    v += __builtin_amdgcn_mov_dpp(v, 0x140, 0xF, 0xF, true);
    return __builtin_amdgcn_readlane(v, 0) + __builtin_amdgcn_readlane(v, 16) + __builtin_amdgcn_readlane(v, 32) + __builtin_amdgcn_readlane(v, 48);
}
__device__ __forceinline__ unsigned score_key(float f) { const unsigned bits = __float_as_uint(f); return (bits & 0x80000000u) ? ~bits : (bits | 0x80000000u); }
constexpr int VST_PITCH = 144;
typedef unsigned short u16;
__device__ __forceinline__ void dsa_load_scores(ARef A, int m, int lane, f32x4 (&sv)[16]) {
    const int n = (m & (SEQ - 1)) + 1; const float* sc = (const float*)(A.ws + WS_SC) + (size_t)m * SEQ;
#pragma unroll
    for (int j4 = 0; j4 < 16; ++j4) sv[j4] = *(const f32x4*)(sc + ((256 * j4 < n) ? 256 * j4 : 0) + 4 * lane);
}
__device__ __forceinline__ void dsa_select(ARef A, int m, int n, int lane_in, LAS u16* slist, LAS unsigned* bk) {
    int lane = lane_in; asm volatile("" : "+v"(lane));
    if (n <= 256) {
#pragma unroll
        for (int c = 0; c < 4; ++c) { const int idx = lane + 64 * c; slist[idx] = (u16)((idx < n) ? idx : 0); }
        return;
    }
    f32x4 sv[16]; dsa_load_scores(A, m, lane, sv);
    unsigned u[64];
#pragma unroll
    for (int j4 = 0; j4 < 16; ++j4)
#pragma unroll
        for (int i = 0; i < 4; ++i) u[4 * j4 + i] = (256 * j4 + 4 * lane + i < n) ? score_key(sv[j4][i]) : 0u;
    unsigned T = 0u;
    for (int bit = 31; bit >= 16; --bit) { const unsigned cand = T | (1u << bit); int cnt = 0;
#pragma unroll
        for (int j = 0; j < 64; ++j) cnt += (u[j] >= cand) ? 1 : 0;
        if (wave_total_i(cnt) >= 256) T = cand; }
    unsigned long long bkb = 0ull; int chi = 0;
#pragma unroll
    for (int j = 0; j < 64; ++j) { bkb |= (unsigned long long)(((u[j] >> 16) == (T >> 16)) ? 1u : 0u) << j; chi += ((u[j] >> 16) > (T >> 16)) ? 1 : 0; }
    const int cb = wave_total_i(__popcll(bkb)), need = 256 - wave_total_i(chi);
    if (cb <= 64) {
        int pos = __popcll(bkb);
        { const int mine_ = pos;
#pragma unroll
          for (int d = 1; d < 64; d <<= 1) { const int y = __shfl_up(pos, d); if (lane >= d) pos += y; }
          pos -= mine_; }
#pragma unroll
        for (int j = 0; j < 64; ++j) { if ((bkb >> j) & 1ull) { bk[pos] = u[j]; ++pos; } }
        LDS_WAIT();
        const unsigned kx = (lane < cb) ? bk[lane] : 0u;
        for (int bit = 15; bit >= 0; --bit) { const unsigned cand = T | (1u << bit); if (__popcll(__ballot(kx >= cand)) >= need) T = cand; }
        LDS_WAIT();
    } else {
        for (int bit = 15; bit >= 0; --bit) { const unsigned cand = T | (1u << bit); int cnt = 0;
#pragma unroll
            for (int j = 0; j < 64; ++j) cnt += (u[j] >= cand) ? 1 : 0;
            if (wave_total_i(cnt) >= 256) T = cand; }
    }
    unsigned long long gtb = 0ull, eqb = 0ull;
#pragma unroll
    for (int j = 0; j < 64; ++j) { gtb |= (unsigned long long)((u[j] > T) ? 1u : 0u) << j; eqb |= (unsigned long long)((u[j] == T) ? 1u : 0u) << j; }
    const int tgt = wave_total_i(__popcll(gtb)), teq = wave_total_i(__popcll(eqb));
    unsigned long long selb = gtb | eqb;
    if (tgt + teq > 256) {
        const int take = 256 - tgt; int lo = 0;
        for (int bit = 11; bit >= 0; --bit) { const int cand = lo | (1 << bit); const int J4 = cand >> 8; int ni = (cand & 255) - 4 * lane; ni = ni < 0 ? 0 : (ni > 4 ? 4 : ni);
            const int jc = 4 * J4 + ni; const unsigned long long msk = (jc >= 64) ? ~0ull : ((1ull << jc) - 1ull);
            if (wave_total_i(__popcll(eqb & msk)) < take) lo = cand; }
        { const int cand = lo + 1; const int J4 = cand >> 8; int ni = (cand & 255) - 4 * lane; ni = ni < 0 ? 0 : (ni > 4 ? 4 : ni);
          const int jc = (cand >= SEQ) ? 64 : 4 * J4 + ni; const unsigned long long msk = (jc >= 64) ? ~0ull : ((1ull << jc) - 1ull); selb = gtb | (eqb & msk); }
    }
    const int mine = __popcll(selb); int off = mine;
#pragma unroll
    for (int d = 1; d < 64; d <<= 1) { const int y = __shfl_up(off, d); if (lane >= d) off += y; }
    off -= mine;
    while (selb) { const int j = __builtin_ctzll(selb); selb &= selb - 1ull; slist[off] = (u16)(256 * (j >> 2) + 4 * lane + (j & 3)); ++off; }
}
__device__ __forceinline__ void dsa_attend(ARef A, int m, int lane_in, const LAS u16* slist, LAS unsigned char* vbuf) {
    int lane = lane_in; asm volatile("" : "+v"(lane));
    const int b = m >> 12, t = m & (SEQ - 1), n = t + 1, nsel = n < 256 ? n : 256, col = lane & 15, q4 = lane >> 4;
    const bf16* DKB = (const bf16*)(A.ws + WS_DKB) + (size_t)b * SEQ * 64; const bf16* DVB = (const bf16*)(A.ws + WS_DVB) + (size_t)b * SEQ * 64;
    const int vrow = lane >> 3, vpc = lane & 7;
    bf16x8v bq0 = {0, 0, 0, 0, 0, 0, 0, 0}, bq1 = {0, 0, 0, 0, 0, 0, 0, 0};
    if (col < 4) { const bf16* qp = (const bf16*)(A.ws + WS_DQ) + (size_t)m * 256 + col * 64 + 8 * q4; bq0 = *(const bf16x8v*)qp; bq1 = *(const bf16x8v*)(qp + 32); }
    f32x4 lg[16];
#pragma unroll
    for (int hb = 0; hb < 4; ++hb) {
        bf16x8v a0[4], a1[4];
#pragma unroll
        for (int k = 0; k < 4; ++k) { const int s = slist[16 * (4 * hb + k) + col]; const bf16* kr = DKB + (size_t)s * 64 + 8 * q4; a0[k] = *(const bf16x8v*)kr; a1[k] = *(const bf16x8v*)(kr + 32); }
#pragma unroll
        for (int k = 0; k < 4; ++k) { const f32x4 c = __builtin_amdgcn_mfma_f32_16x16x32_bf16(a0[k], bq0, (f32x4){0.f, 0.f, 0.f, 0.f}, 0, 0, 0); lg[4 * hb + k] = __builtin_amdgcn_mfma_f32_16x16x32_bf16(a1[k], bq1, c, 0, 0, 0); }
        __builtin_amdgcn_sched_barrier(0);
    }
    if (nsel < 256) {
#pragma unroll
        for (int kb = 0; kb < 16; ++kb)
#pragma unroll
            for (int r = 0; r < 4; ++r) if (16 * kb + 4 * q4 + r >= nsel) lg[kb][r] = -INFINITY; }
    v4u vr[4];
#pragma unroll
    for (int i = 0; i < 4; ++i) { const int s = slist[vrow + 8 * i]; vr[i] = *(const v4u*)(DVB + (size_t)s * 64 + 8 * vpc); }
    float mx = -INFINITY;
#pragma unroll
    for (int kb = 0; kb < 16; ++kb) mx = fmaxf(fmaxf(mx, fmaxf(lg[kb].x, lg[kb].y)), fmaxf(lg[kb].z, lg[kb].w));
    mx = fmaxf(mx, __shfl_xor(mx, 16)); mx = fmaxf(mx, __shfl_xor(mx, 32));
    float sm = 0.f;
#pragma unroll
    for (int kb = 0; kb < 16; ++kb) { lg[kb].x = __builtin_amdgcn_exp2f(lg[kb].x - mx); lg[kb].y = __builtin_amdgcn_exp2f(lg[kb].y - mx); lg[kb].z = __builtin_amdgcn_exp2f(lg[kb].z - mx); lg[kb].w = __builtin_amdgcn_exp2f(lg[kb].w - mx); sm += (lg[kb].x + lg[kb].y) + (lg[kb].z + lg[kb].w); }
    sm += __shfl_xor(sm, 16); sm += __shfl_xor(sm, 32);
    const float inv = 1.0f / sm;
    bf16x8v pa[8];
#pragma unroll
    for (int i = 0; i < 8; ++i) { const f32x4 x = lg[2 * i] * inv, y = lg[2 * i + 1] * inv;
        pg8::u32x4 wv; wv.x = pg8::cvt_pk_bf16(x.x, x.y); wv.y = pg8::cvt_pk_bf16(x.z, x.w); wv.z = pg8::cvt_pk_bf16(y.x, y.y); wv.w = pg8::cvt_pk_bf16(y.z, y.w);
        pa[i] = __builtin_bit_cast(bf16x8v, wv); }
    f32x4 o[4];
#pragma unroll
    for (int nb = 0; nb < 4; ++nb) o[nb] = (f32x4){0.f, 0.f, 0.f, 0.f};
    const int tj = col >> 2, tc = col & 3;
#pragma unroll
    for (int c = 0; c < 8; ++c) {
        LAS unsigned char* vb = vbuf + (c & 1) * (32 * VST_PITCH);
#pragma unroll
        for (int i = 0; i < 4; ++i) *(LAS v4u*)(vb + (vrow + 8 * i) * VST_PITCH + 16 * vpc) = vr[i];
        if (c < 7) {
#pragma unroll
            for (int i = 0; i < 4; ++i) { const int s = slist[32 * (c + 1) + vrow + 8 * i]; vr[i] = *(const v4u*)(DVB + (size_t)s * 64 + 8 * vpc); } }
        LDS_WAIT();
#pragma unroll
        for (int nb = 0; nb < 4; ++nb) {
            LAS unsigned char* a1 = vb + (4 * q4 + tj) * VST_PITCH + (16 * nb + 4 * tc) * 2;
            const s16x4v r1 = __builtin_bit_cast(s16x4v, __builtin_amdgcn_ds_read_tr16_b64_v4i16((LAS s16x4v*)a1));
            const s16x4v r2 = __builtin_bit_cast(s16x4v, __builtin_amdgcn_ds_read_tr16_b64_v4i16((LAS s16x4v*)(a1 + 16 * VST_PITCH)));
            const bf16x8v bv = {r1[0], r1[1], r1[2], r1[3], r2[0], r2[1], r2[2], r2[3]};
            o[nb] = __builtin_amdgcn_mfma_f32_16x16x32_bf16(pa[c], bv, o[nb], 0, 0, 0); }
    }
    LDS_WAIT();
    if (lane < 16) { float* YD = (float*)(A.ws + WS_YO) + 2 * YO_STRIDE + (size_t)m * 256;
#pragma unroll
        for (int nb = 0; nb < 4; ++nb) { YD[16 * nb + lane] = o[nb].x; YD[64 + 16 * nb + lane] = o[nb].y; YD[128 + 16 * nb + lane] = o[nb].z; YD[192 + 16 * nb + lane] = o[nb].w; } }
}
__device__ __forceinline__ int dsa_row_of(int i) { return (i & 1) ? (MTOK - 1 - (i >> 1)) : (i >> 1); }
__device__ __forceinline__ void dsa_wave(ARef A, const WI& w, LAS unsigned char* wl, int l) {
    LAS u16* lists = (LAS u16*)wl; LAS unsigned char* vbuf = wl + 4096; LAS unsigned* bk = (LAS unsigned*)vbuf;
    unsigned* head = (unsigned*)(A.ws + WS_CTL) + CW_DSAQ + 64 * l;
    for (;;) {
        int g = 0; if (w.lane == 0) g = (int)atomicAdd(head, 1u);
        g = __builtin_amdgcn_readfirstlane(g);
        if (g >= MTOK / 8) break;
#pragma unroll 1
        for (int r = 0; r < 8; ++r) { const int m = dsa_row_of(g + r * (MTOK / 8)), n = (m & (SEQ - 1)) + 1; dsa_select(A, m, n, w.lane, lists + r * 256, bk); }
        LDS_WAIT();
#pragma unroll 1
        for (int r = 0; r < 8; ++r) dsa_attend(A, dsa_row_of(g + r * (MTOK / 8)), w.lane, lists + r * 256, vbuf);
    }
}

__device__ __forceinline__ f32x4 head_norm4(f32x4 y, float eps, f32x4 g) {
    const float mean = grp16_sum(sum4(y)) * (1.0f / 64.0f); const f32x4 yc = y - mean;
    const float var = grp16_sum(dot4(yc, yc)) * (1.0f / 64.0f); return yc * (1.0f / sqrtf(var + eps)) * g;
}
template <bool BF> __device__ __forceinline__ f32x4 state_corr(const LAS float* sl, int hh, int r16, const void* pv) {
    const LAS float* r0 = sl + (hh * 64 + 4 * r16) * 64; const int x0 = (4 * r16) & 15;
    f32x4 out = {0.f, 0.f, 0.f, 0.f};
#pragma unroll 2
    for (int k8 = 0; k8 < 8; ++k8) {
        f32x4 pa, pb;
        if (BF) { const v4u x = ((const v4u*)pv)[k8]; pa = (f32x4){bf_lo(x.x), bf_hi(x.x), bf_lo(x.y), bf_hi(x.y)}; pb = (f32x4){bf_lo(x.z), bf_hi(x.z), bf_lo(x.w), bf_hi(x.w)}; }
        else { pa = ((const f32x4*)pv)[2 * k8]; pb = ((const f32x4*)pv)[2 * k8 + 1]; }
#pragma unroll
        for (int i = 0; i < 4; ++i) { const LAS float* rowp = r0 + i * 64; const int xs = (x0 + i) & 15;
            out[i] += dot4(*(const LAS f32x4*)(rowp + 4 * ((2 * k8) ^ xs)), pa) + dot4(*(const LAS f32x4*)(rowp + 4 * ((2 * k8 + 1) ^ xs)), pb); }
    }
    return out;
}
__device__ __forceinline__ void post_row(ARef A, int l, int m, int lane, const LAS float* slw, const LAS float* slr) {
    const float* P = (const float*)(A.ws + WS_P); const float* YO = (const float*)(A.ws + WS_YO); const float* RWA = (const float*)(A.ws + WS_RWA);
    bf16* MX = (bf16*)(A.ws + WS_MIX) + (size_t)m * DM; const int c4 = 4 * lane, hh = lane >> 4, r16 = lane & 15; const size_t o = (size_t)m * 256 + c4;
    { f32x4 y = *(const f32x4*)(YO + o) + state_corr<true>(slr, hh, r16, (const bf16*)(A.ws + WS_PTR) + (size_t)m * 256 + hh * 64);
      y = head_norm4(y, 1e-5f, *(const f32x4*)(A.in[I_RETGN] + l * 256 + c4));
      const f32x4 g = *(const f32x4*)(P + (size_t)m * INCP + C_RET + 768 + c4);
#pragma unroll
      for (int i = 0; i < 4; ++i) y[i] *= g[i] * sigm(g[i]);
      v2u w; w.x = pk2(y.x, y.y); w.y = pk2(y.z, y.w); *(v2u*)(MX + c4) = w; }
    { f32x4 y = *(const f32x4*)(YO + YO_STRIDE + o) + state_corr<false>(slw, hh, r16, (const float*)(A.ws + WS_PT) + (size_t)m * 256 + hh * 64);
      y = head_norm4(y, 64e-5f, *(const f32x4*)(A.in[I_LN] + l * 256 + c4));
      y = (y + *(const f32x4*)(RWA + 7 * RWA_STRIDE + o)) * *(const f32x4*)(RWA + 6 * RWA_STRIDE + o);
      v2u w; w.x = pk2(y.x, y.y); w.y = pk2(y.z, y.w); *(v2u*)(MX + 256 + c4) = w; }
    { f32x4 y = *(const f32x4*)(YO + 2 * YO_STRIDE + o); const float r = 1.0f / sqrtf(wave_sum(dot4(y, y)) * (1.0f / 256.0f) + 1e-5f);
      y = y * r * *(const f32x4*)(A.in[I_DONORM] + l * 256 + c4);
      v2u w; w.x = pk2(y.x, y.y); w.y = pk2(y.z, y.w); *(v2u*)(MX + 512 + c4) = w; }
    { f32x4 y = *(const f32x4*)(YO + 3 * YO_STRIDE + o); const float r = 1.0f / sqrtf(wave_sum(dot4(y, y)) * (1.0f / 256.0f) + 1e-5f);
      y = y * r * *(const f32x4*)(A.in[I_SONORM] + l * 256 + c4);
      v2u w; w.x = pk2(y.x, y.y); w.y = pk2(y.z, y.w); *(v2u*)(MX + 768 + c4) = w; }
}
__device__ __forceinline__ void ph_post(ARef A, const WI& w, int l) {
    LAS float* slw = (LAS float*)w.lds; LAS float* slr = slw + 16384;
    for (int u = w.vcu; u < NB * NCH * 2; u += w.G) {
        const int b = u >> 5, c = (u >> 1) & 15, half = u & 1;
        __syncthreads();
        for (int e = w.tid; e < 4096; e += NWAVES * 64) { const int hh = e >> 10, v = (e >> 4) & 63, k4 = e & 15;
            const size_t src = ((size_t)((b * 4 + hh) * NCH + c) * 64 + v) * 64 + 4 * k4; const int dst = (hh * 64 + v) * 64 + 4 * (k4 ^ (v & 15));
            *(LAS f32x4*)(slw + dst) = *(const f32x4*)((const float*)(A.ws + WS_SI) + src); *(LAS f32x4*)(slr + dst) = *(const f32x4*)((const float*)(A.ws + WS_SIR) + src); }
        __syncthreads();
        const int tok0 = b * SEQ + c * TCH + half * 128 + w.wave * 16;
        for (int i = 0; i < 16; ++i) post_row(A, l, tok0 + i, w.lane, slw, slr);
    }
}

__device__ __forceinline__ float wave_max_f(float v) {
    v = fmaxf(v, __builtin_bit_cast(float, __builtin_amdgcn_mov_dpp(__builtin_bit_cast(int, v), 0xB1, 0xF, 0xF, true)));
    v = fmaxf(v, __builtin_bit_cast(float, __builtin_amdgcn_mov_dpp(__builtin_bit_cast(int, v), 0x4E, 0xF, 0xF, true)));
    v = fmaxf(v, __builtin_bit_cast(float, __builtin_amdgcn_mov_dpp(__builtin_bit_cast(int, v), 0x141, 0xF, 0xF, true)));
    v = fmaxf(v, __builtin_bit_cast(float, __builtin_amdgcn_mov_dpp(__builtin_bit_cast(int, v), 0x140, 0xF, 0xF, true)));
    const int iv = __builtin_bit_cast(int, v);
    return fmaxf(fmaxf(__builtin_bit_cast(float, __builtin_amdgcn_readlane(iv, 0)), __builtin_bit_cast(float, __builtin_amdgcn_readlane(iv, 16))), fmaxf(__builtin_bit_cast(float, __builtin_amdgcn_readlane(iv, 32)), __builtin_bit_cast(float, __builtin_amdgcn_readlane(iv, 48))));
}
__device__ __forceinline__ void router_stage(ARef A, const WI& w, int l) {
    LAS float* rwl = (LAS float*)w.lds; const float* rw = A.in[I_RW] + (size_t)l * DM * 32;
    for (int e = w.tid; e < DM * 8; e += NWAVES * 64) { const int k = e >> 3, c = e & 7; *(LAS f32x4*)(rwl + k * 32 + 4 * (c ^ ((k >> 2) & 7))) = *(const f32x4*)(rw + (size_t)k * 32 + 4 * c); }
    __syncthreads();
}
__device__ __forceinline__ void router_row(ARef A, int l, int m, int lane, LAS unsigned* hist, const LAS float* rwl, bool dry = false) {
    const float* XA = (const float*)(A.ws + WS_XA) + (size_t)m * DM; const float* MOD = (const float*)(A.ws + WS_MOD) + (size_t)(l * 8 + (m >> 12)) * 6144;
    f32x4 v[4]; float ss = 0.0f;
#pragma unroll
    for (int j = 0; j < 4; ++j) { v[j] = *(const f32x4*)(XA + 4 * (lane + 64 * j)); ss += dot4(v[j], v[j]); }
    ss = wave_sum(ss); const float rstd = 1.0f / sqrtf(ss * (1.0f / DM) + 1e-5f);
    const float* g = A.in[I_NFFN] + l * DM; const float* scp = MOD + 4 * 1024; const float* shp = MOD + 3 * 1024;
    emit_h_row(v, rstd, g, scp, shp, (bf16*)(A.ws + WS_H) + (size_t)m * DM, lane);
    float p[32];
#pragma unroll
    for (int e = 0; e < 32; ++e) p[e] = 0.0f;
    const int sw = lane & 7;
#pragma unroll 1
    for (int j = 0; j < 4; ++j) { const int k = 4 * (lane + 64 * j);
        const f32x4 h = *(const f32x4*)(XA + k) * rstd * *(const f32x4*)(g + k) * (1.0f + *(const f32x4*)(scp + k)) + *(const f32x4*)(shp + k);
        const LAS float* row = rwl + k * 32;
#pragma unroll
        for (int i = 0; i < 4; ++i) {
#pragma unroll
            for (int q4 = 0; q4 < 8; ++q4) { const f32x4 r = *(const LAS f32x4*)(row + i * 32 + 4 * (q4 ^ sw)); p[4 * q4] += h[i] * r.x; p[4 * q4 + 1] += h[i] * r.y; p[4 * q4 + 2] += h[i] * r.z; p[4 * q4 + 3] += h[i] * r.w; } } }
    float q16[16], q8[8], q4v[4], q2[2], q1;
    { const bool hb = (lane & 32) != 0;
#pragma unroll
      for (int i = 0; i < 16; ++i) { const float mine = hb ? p[16 + i] : p[i], oth = hb ? p[i] : p[16 + i]; q16[i] = mine + __shfl_xor(oth, 32); } }
    { const bool hb = (lane & 16) != 0;
#pragma unroll
      for (int i = 0; i < 8; ++i) { const float mine = hb ? q16[8 + i] : q16[i], oth = hb ? q16[i] : q16[8 + i]; q8[i] = mine + __shfl_xor(oth, 16); } }
    { const bool hb = (lane & 8) != 0;
#pragma unroll
      for (int i = 0; i < 4; ++i) { const float mine = hb ? q8[4 + i] : q8[i], oth = hb ? q8[i] : q8[4 + i]; q4v[i] = mine + __shfl_xor(oth, 8); } }
    { const bool hb = (lane & 4) != 0;
#pragma unroll
      for (int i = 0; i < 2; ++i) { const float mine = hb ? q4v[2 + i] : q4v[i], oth = hb ? q4v[i] : q4v[2 + i]; q2[i] = mine + __shfl_xor(oth, 4); } }
    { const bool hb = (lane & 2) != 0; const float mine = hb ? q2[1] : q2[0], oth = hb ? q2[0] : q2[1]; q1 = mine + __shfl_xor(oth, 2); }
    q1 += __shfl_xor(q1, 1);
    float lv = q1 + A.in[I_RB][l * 32 + (lane >> 1)];
    float tv[4]; int ti[4];
#pragma unroll
    for (int kk = 0; kk < 4; ++kk) { const float mx = wave_max_f(lv); const unsigned long long msk = __ballot(lv == mx); const int e = (int)(__builtin_ctzll(msk) >> 1);
        tv[kk] = mx; ti[kk] = e; if ((lane >> 1) == e) lv = -INFINITY; }
    const float e1 = expf(tv[1] - tv[0]), e2 = expf(tv[2] - tv[0]), e3 = expf(tv[3] - tv[0]); const float inv = 1.0f / (1.0f + e1 + e2 + e3);
    if (lane == 0 && !dry) {
        int* TI = (int*)(A.ws + WS_TOPI) + (size_t)m * 4; float* TW = (float*)(A.ws + WS_TOPW) + (size_t)m * 4;
        TI[0] = ti[0]; TI[1] = ti[1]; TI[2] = ti[2]; TI[3] = ti[3]; TW[0] = inv; TW[1] = e1 * inv; TW[2] = e2 * inv; TW[3] = e3 * inv;
        { unsigned* hg = (unsigned*)hist; atomicAdd(hg + ti[0], 1u); atomicAdd(hg + ti[1], 1u); atomicAdd(hg + ti[2], 1u); atomicAdd(hg + ti[3], 1u); }
    }
}
__device__ __forceinline__ void build_expert_table(ARef A, const WI& w, int l) {
    LAS int* tst = (LAS int*)(w.lds + TST_OFF); LAS int* tab = (LAS int*)(w.lds + TAB_OFF); LAS int* base = (LAS int*)(w.lds + BASE_OFF); LAS int* part = (LAS int*)w.lds;
    const unsigned* bc = (const unsigned*)(A.ws + WS_CTL) + CW_BLKCNT + (size_t)l * 256 * 32;
    { const int e = w.tid & 31, pq = w.tid >> 5; int s = 0, sb = 0;
      for (int i = 0; i < 16; ++i) { const int g = pq * 16 + i; if (g < w.G) { const int c = (int)__hip_atomic_load(bc + g * 32 + e, RLX_AGENT); s += c; sb += (g < w.vcu) ? c : 0; } }
      part[pq * 32 + e] = s; part[512 + pq * 32 + e] = sb; }
    __syncthreads();
    if (w.tid < 32) { int s = 0, sb = 0; for (int pq = 0; pq < 16; ++pq) { s += part[pq * 32 + w.tid]; sb += part[512 + pq * 32 + w.tid]; } part[1024 + w.tid] = s; base[w.tid] = sb; }
    __syncthreads();
    if (w.tid == 0) { int acc = 0; for (int e = 0; e < 32; ++e) { tst[e] = acc; acc += (part[1024 + e] + 255) >> 8; } tst[32] = acc; tab[0] = acc; }
    __syncthreads();
    if (w.tid < 32) { const int e = w.tid; for (int pm = tst[e]; pm < tst[e + 1]; ++pm) tab[1 + pm] = e; }
    __syncthreads();
}
__device__ __forceinline__ void scatter_row(ARef A, const WI& w, int l, int m, bool dry = false) {
    const LAS int* tst = (const LAS int*)(w.lds + TST_OFF); const LAS int* base = (const LAS int*)(w.lds + BASE_OFF); LAS unsigned* cur = (LAS unsigned*)(w.lds + HIST_OFF);
    int pos = 0;
    if (dry) { if (w.lane < 4) pos = ((const int*)(A.ws + WS_POS))[(size_t)m * 4 + w.lane]; }
    else if (w.lane < 4) { const int e = ((const int*)(A.ws + WS_TOPI))[(size_t)m * 4 + w.lane];
        const unsigned slot = atomicAdd((unsigned*)cur + e, 1u);
        pos = tst[e] * 256 + base[e] + (int)slot; ((int*)(A.ws + WS_POS))[(size_t)m * 4 + w.lane] = pos; }
    const v4u* src = (const v4u*)((const bf16*)(A.ws + WS_H) + (size_t)m * DM);
    const v4u a = src[w.lane], b = src[64 + w.lane];
#pragma unroll
    for (int k = 0; k < 4; ++k) { const int pk = __shfl(pos, k); v4u* dst = (v4u*)((bf16*)(A.ws + WS_XS) + (size_t)pk * DM); dst[w.lane] = a; dst[64 + w.lane] = b; }
}
__device__ __forceinline__ void combine_row(ARef A, int l, int m, int lane, float gscale = 1.0f, float oscale = 1.0f) {
    float* XA = (float*)(A.ws + WS_XA) + (size_t)m * DM; const float* MOD = (const float*)(A.ws + WS_MOD) + (size_t)(l * 8 + (m >> 12)) * 6144;
    const int* PS = (const int*)(A.ws + WS_POS) + (size_t)m * 4; const float* TW = (const float*)(A.ws + WS_TOPW) + (size_t)m * 4;
    const bf16* YS = (const bf16*)(A.ws + WS_XS);
    f32x4 v[4], acc[4];
#pragma unroll
    for (int j = 0; j < 4; ++j) { v[j] = *(const f32x4*)(XA + 4 * (lane + 64 * j)); acc[j] = (f32x4){0.f, 0.f, 0.f, 0.f}; }
#pragma unroll
    for (int k = 0; k < 4; ++k) { const int pos = PS[k]; const float gt = TW[k] * gscale; const v2u* yr = (const v2u*)(YS + (size_t)pos * DM);
#pragma unroll
        for (int j = 0; j < 4; ++j) { const v2u y = yr[lane + 64 * j]; acc[j] += gt * (f32x4){bf_lo(y.x), bf_hi(y.x), bf_lo(y.y), bf_hi(y.y)}; } }
    float ss = 0.0f;
#pragma unroll
    for (int j = 0; j < 4; ++j) { const int kx = 4 * (lane + 64 * j); v[j] += *(const f32x4*)(MOD + 5 * 1024 + kx) * acc[j]; ss += dot4(v[j], v[j]); }
    ss = wave_sum(ss); const float rstd = 1.0f / sqrtf(ss * (1.0f / DM) + 1e-5f);
    if (l + 1 < NLAYER) {
#pragma unroll
        for (int j = 0; j < 4; ++j) *(f32x4*)(XA + 4 * (lane + 64 * j)) = v[j];
        const float* mb = MOD + 8 * 6144;
        emit_h_row(v, rstd, A.in[I_NMIX] + (l + 1) * DM, mb + 1024, mb, (bf16*)(A.ws + WS_H) + (size_t)m * DM, lane);
    } else {
        float* orow = A.out + (size_t)m * DM; const float* gf = A.in[I_NFINAL];
#pragma unroll
        for (int j = 0; j < 4; ++j) { const int kx = 4 * (lane + 64 * j); *(f32x4*)(orow + kx) = v[j] * (rstd * oscale) * *(const f32x4*)(gf + kx); }
    }
}

constexpr int N_LAUNCHES = MK_N_LAUNCHES;
template <int SEL> __global__ void __launch_bounds__(NWAVES * 64, 2) fwd(ArgsH Ah) {
    extern __shared__ __attribute__((aligned(16))) unsigned char lds[];
    (void)Ah;
    const int wave_s = __builtin_amdgcn_readfirstlane((int)threadIdx.x >> 6);
    auto tid_now = [&]() -> int { int ws_ = wave_s; unsigned z_ = 0u; asm volatile("" : "+s"(ws_), "+s"(z_)); return ws_ * 64 + (int)__builtin_amdgcn_mbcnt_hi(~0u, __builtin_amdgcn_mbcnt_lo(~0u, z_)); };
#define TID_NOW() tid_now()
#define MAKE_WI() WI w; { int tz = TID_NOW(); asm volatile("" : "+v"(tz)); int bz = blockIdx.x, gz = gridDim.x; asm volatile("" : "+s"(bz), "+s"(gz)); \
        w.lds = (LAS unsigned char*)lds; w.tid = tz; w.lane = tz & 63; w.wave = __builtin_amdgcn_readfirstlane(tz >> 6); w.G = gz; w.bx = bz; w.vcu = (gz % 8 == 0) ? (bz % 8) * (gz / 8) + bz / 8 : bz; \
        w.gw = w.vcu * NWAVES + w.wave; w.NGW = gz * NWAVES; }
    { const int t0 = threadIdx.x; for (int u = t0; u < (LDS_BYTES - RING_BYTES) / 4; u += NWAVES * 64) ((LAS unsigned*)((LAS unsigned char*)lds + RING_BYTES))[u] = 0u; }
    __syncthreads();
    int lo, hi; { ARef A0 = *kargs(); lo = A0.ph_lo; hi = A0.ph_hi; }
    if (N_LAUNCHES == 1) { ARef A0 = *kargs(); (void)xcd_barrier_post((unsigned*)((gu32*)(A0.ws + WS_CTL) + CW_BAR), (volatile LAS unsigned*)((LAS unsigned char*)lds + MISC_OFF) + 8, TID_NOW()); }
#define GRID_BAR() do { if (N_LAUNCHES == 1) { ARef Ab = *kargs(); XcdBarrier bar_; bar_.bar = (unsigned*)((gu32*)(Ab.ws + WS_CTL) + CW_BAR); bar_.x = xb_xcc_id(); bar_.st = (volatile LAS unsigned*)((LAS unsigned char*)lds + MISC_OFF) + 8; xcd_barrier(bar_, TID_NOW()); } } while (0)
#ifndef TPROBE
#define TPROBE 0
#endif
#if TPROBE
    unsigned long long tp_acc = 0ull;
#define TP_SCALE tp_scale_of(__hip_atomic_load((unsigned*)(A.ws + WS_CTL) + 3, RLX_AGENT))
    auto tp_scale_of = [](unsigned ticks) -> float { const float us = (float)ticks * 0.01f; if (us < 1.0f) return 1.0f; const float q = exp2f(rintf(log2f(us) * 8.0f) * 0.125f); return 1.0f + sqrtf(q * 1e-5f); };
#define TP_BEGIN(kind) unsigned long long tp_t0 = 0ull; if ((kind) == TPROBE) tp_t0 = __builtin_amdgcn_s_memrealtime();
#define TP_END(kind) if ((kind) == TPROBE) { tp_acc += __builtin_amdgcn_s_memrealtime() - tp_t0; }
#define TP_PUBLISH(l) if ((l) == 1 && w.vcu == 0 && w.tid == 0) __hip_atomic_store((unsigned*)(A.ws + WS_CTL) + 3, (unsigned)tp_acc, RLX_AGENT);
#else
#define TP_SCALE 1.0f
#define TP_PUBLISH(l)
#define TP_BEGIN(kind)
#define TP_END(kind)
#endif
#define IN(k) (lo <= (k) && (k) < hi)
#ifndef PHMASK
#define PHMASK 0xffffffffu
#endif
#define KON(k) if constexpr ((SEL < 0 && ((PHMASK >> (k)) & 1u)) || SEL == (k))
#define BOTH(k) (IN(k) && IN((k) + 1))
#ifndef PROBE_REP
#define PROBE_REP 0
#endif
#if PROBE_REP
    int nrep_ = 2; asm volatile("" : "+s"(nrep_));
#define REP(bit) _Pragma("unroll 1") for (int rep_ = 0; rep_ < (((PROBE_REP >> (bit)) & 1) ? nrep_ : 1); ++rep_)
#else
#define REP(bit) for (int rep_ = 0; rep_ < 1; ++rep_)
#endif
#define ring ((PG8_LAS unsigned char*)lds)

    KON(0) if (IN(0)) { ARef A = *kargs(); MAKE_WI(); REP(0) ph_prologue(A, w); if (BOTH(0)) GRID_BAR(); }

#define LAYER_BODY(l) do {\
        const int pb = 1 + l * NPL; \
        KON(1) if (IN(pb + 0)) { ARef A = *kargs(); MAKE_WI(); TP_BEGIN(1) if (l == 0) ph_norm1(A, w); if (BOTH(pb + 0)) GRID_BAR(); TP_END(1) } \
        KON(2) if (IN(pb + 1)) { ARef A = *kargs(); MAKE_WI(); TP_BEGIN(2) \
            pg8::Gemm g{(const bf16*)(A.ws + WS_H), (const bf16*)(A.ws + WS_WIN) + (size_t)l * INCP * DM, MTOK, INCP, DM}; pg8::StaticOrder S; S.init(MTOK, INCP, w.G, w.bx); \
            pg8::EpiF32 E{(float*)(A.ws + WS_P), INCP}; \
            REP(1) pg8::gemm_phase<pg8::EpiF32, pg8::StaticOrder, true, true>(ring, g, S, E, w.tid); \
            if (BOTH(pb + 1)) GRID_BAR(); TP_END(2) \
        } \
        KON(3) if (IN(pb + 2)) { ARef A = *kargs(); MAKE_WI(); TP_BEGIN(3) \
            REP(2) { LAS float* xs = (LAS float*)(w.lds + w.wave * 8192); for (int g = w.gw; g < MTOK / 8; g += w.NGW) prep8(A, l, 8 * g, w.lane, xs, xs + 1024); } \
            if (BOTH(pb + 2)) GRID_BAR(); TP_END(3) \
        } \
        KON(4) if (IN(pb + 3)) { ARef A = *kargs(); MAKE_WI(); TP_BEGIN(4) \
            REP(3) { for (int tk = 2 * w.vcu; tk < 32 * NCH; tk += 2 * w.G) scan_rwkv_task2(A, w, tk); \
            for (int tk = w.vcu; tk < 32 * NCH / 2; tk += w.G) scan_ret_task(A, w, tk); } \
            REP(4) { LAS unsigned char* vl = w.lds + w.wave * 4608; for (int it = w.gw; it < 32 * 128; it += w.NGW) sb_tile_mfma(A, it, w.lane, vl); } \
            REP(5) dsa_scores_mfma(A, w); \
            if (BOTH(pb + 3)) GRID_BAR(); TP_END(4) \
        } \
        KON(5) if (IN(pb + 4)) { ARef A = *kargs(); MAKE_WI(); TP_BEGIN(5) \
            if (w.vcu < 32) prefix_chain(A, w, w.vcu); \
            dsa_wave(A, w, w.lds + w.wave * 13312, l); \
            if (BOTH(pb + 4)) GRID_BAR(); TP_END(5) \
        } \
        KON(6) if (IN(pb + 5)) { ARef A = *kargs(); MAKE_WI(); TP_BEGIN(6) \
            REP(7) ph_post(A, w, l); \
            if (BOTH(pb + 5)) GRID_BAR(); TP_END(6) \
        } \
        KON(7) if (IN(pb + 6)) { ARef A = *kargs(); MAKE_WI(); TP_BEGIN(7) \
            pg8::Gemm g{(const bf16*)(A.ws + WS_MIX), (const bf16*)(A.ws + WS_WOUT) + (size_t)l * DM * DM, MTOK, DM, DM}; pg8::StaticOrder S; S.init(MTOK, DM, w.G, w.bx); \
            pg8::EpiRes E{l == 0 ? A.in[I_X] : (const float*)(A.ws + WS_XA), (float*)(A.ws + WS_XA), (const float*)(A.ws + WS_MOD) + (size_t)l * 8 * 6144 + 2 * 1024}; \
            pg8::gemm_phase<pg8::EpiRes, pg8::StaticOrder, true, true>(ring, g, S, E, w.tid); \
            if (BOTH(pb + 6)) GRID_BAR(); TP_END(7) \
        } \
        KON(8) if (IN(pb + 7)) { ARef A = *kargs(); MAKE_WI(); TP_BEGIN(8) \
            { LAS unsigned* hist = (LAS unsigned*)(w.lds + HIST_OFF); if (w.tid < 32) hist[w.tid] = 0u; router_stage(A, w, l); \
            REP(10) for (int m = w.gw; m < MTOK; m += w.NGW) router_row(A, l, m, w.lane, hist, (const LAS float*)w.lds, rep_ != 0); \
            __syncthreads(); if (w.tid < 32) ((unsigned*)(A.ws + WS_CTL))[CW_BLKCNT + (l * 256 + w.vcu) * 32 + w.tid] = hist[w.tid]; } \
            if (BOTH(pb + 7)) GRID_BAR(); TP_END(8) \
        } \
        KON(9) if (IN(pb + 8)) { ARef A = *kargs(); MAKE_WI(); TP_BEGIN(9) \
            build_expert_table(A, w, l); { LAS unsigned* cur = (LAS unsigned*)(w.lds + HIST_OFF); if (w.tid < 32) cur[w.tid] = 0u; __syncthreads(); } \
            REP(11) for (int m = w.gw; m < MTOK; m += w.NGW) scatter_row(A, w, l, m, rep_ != 0); \
            if (BOTH(pb + 8)) GRID_BAR(); TP_END(9) \
        } \
        KON(10) if (IN(pb + 9)) { ARef A = *kargs(); MAKE_WI(); TP_BEGIN(10) \
            build_expert_table(A, w, l); \
            pg8::Gemm g{(const bf16*)(A.ws + WS_XS), (const bf16*)(A.ws + WS_W1) + (size_t)l * NEXP * 2048 * DM, MOE_ROWS, NEXP * 2048, DM}; \
            pg8::MoeOrder S{(const PG8_LAS int*)(w.lds + TAB_OFF), 8, w.G, w.vcu}; \
            pg8::EpiSwiglu E{(bf16*)(A.ws + WS_ACT), A.in[I_MB1] + (size_t)l * NEXP * 2048}; \
            REP(8) pg8::gemm_phase<pg8::EpiSwiglu, pg8::MoeOrder, true, true>(ring, g, S, E, w.tid); \
            if (BOTH(pb + 9)) GRID_BAR(); TP_END(10) \
        } \
        KON(11) if (IN(pb + 10)) { ARef A = *kargs(); MAKE_WI(); TP_BEGIN(11) \
            build_expert_table(A, w, l); \
            pg8::Gemm g{(const bf16*)(A.ws + WS_ACT), (const bf16*)(A.ws + WS_W2) + (size_t)l * NEXP * DM * DM, MOE_ROWS, NEXP * DM, DM}; \
            pg8::MoeOrder S{(const PG8_LAS int*)(w.lds + TAB_OFF), 4, w.G, w.vcu}; \
            pg8::EpiY E{(bf16*)(A.ws + WS_XS), A.in[I_MB2] + (size_t)l * NEXP * DM}; \
            REP(9) pg8::gemm_phase<pg8::EpiY, pg8::MoeOrder, true, true>(ring, g, S, E, w.tid); \
            TP_PUBLISH(l) \
            if (BOTH(pb + 10)) GRID_BAR(); TP_END(11) \
        } \
        KON(12) if (IN(pb + 11)) { ARef A = *kargs(); MAKE_WI(); TP_BEGIN(12) \
            REP(12) for (int m = w.gw; m < MTOK; m += w.NGW) combine_row(A, l, m, w.lane, rep_ ? 0.0f : 1.0f, TP_SCALE); \
            if (BOTH(pb + 11)) GRID_BAR(); TP_END(12) \
        } \
    } while (0)
    LAYER_BODY(0);
    LAYER_BODY(1);
#undef LAYER_BODY
#undef IN
#undef ring
#undef MAKE_WI
#undef TID_NOW
#undef GRID_BAR
#undef KON
#undef BOTH
}


#if MK_N_LAUNCHES != 1
template <int K> static void launch_one(int grid, hipStream_t stream, const ArgsH& a) {
    static bool attr = false;
    if (!attr) { (void)hipFuncSetAttribute((const void*)fwd<K>, hipFuncAttributeMaxDynamicSharedMemorySize, LDS_BYTES); attr = true; }
    hipLaunchKernelGGL(fwd<K>, dim3(grid), dim3(NWAVES * 64), LDS_BYTES, stream, a);
}
static void launch_kind(int kind, int grid, hipStream_t stream, const ArgsH& a) {
    switch (kind) {
        case 0: launch_one<0>(grid, stream, a); break; case 1: launch_one<1>(grid, stream, a); break; case 2: launch_one<2>(grid, stream, a); break;
        case 3: launch_one<3>(grid, stream, a); break; case 4: launch_one<4>(grid, stream, a); break; case 5: launch_one<5>(grid, stream, a); break;
        case 6: launch_one<6>(grid, stream, a); break; case 7: launch_one<7>(grid, stream, a); break; case 8: launch_one<8>(grid, stream, a); break;
        case 9: launch_one<9>(grid, stream, a); break; case 10: launch_one<10>(grid, stream, a); break; case 11: launch_one<11>(grid, stream, a); break;
        default: launch_one<12>(grid, stream, a); break;
    }
}
#endif
extern "C" void kernel_launch(void* const* d_in, const int* in_sizes, int n_in, void* d_out, int out_size, void* d_ws, size_t ws_size, hipStream_t stream) {
    static int grid = 0;
    if (grid == 0) {
        if (n_in != N_IN || out_size != MTOK * DM || ws_size < WS_END) { fprintf(stderr, "kernel_launch: unexpected shapes (n_in %d, out %d, ws %zu)\n", n_in, out_size, ws_size); grid = -1; return; }
        int dev = 0, cus = 0;
        if (hipGetDevice(&dev) != hipSuccess || hipDeviceGetAttribute(&cus, hipDeviceAttributeMultiprocessorCount, dev) != hipSuccess) { grid = -1; return; }
#if MK_N_LAUNCHES == 1
        {
            if (hipFuncSetAttribute((const void*)fwd<-1>, hipFuncAttributeMaxDynamicSharedMemorySize, LDS_BYTES) != hipSuccess) { fprintf(stderr, "kernel_launch: hipFuncSetAttribute failed\n"); grid = -1; return; }
            int per_cu = 0;
            if (hipOccupancyMaxActiveBlocksPerMultiprocessor(&per_cu, (const void*)fwd<-1>, NWAVES * 64, LDS_BYTES) != hipSuccess || per_cu < 1) fprintf(stderr, "kernel_launch: occupancy query says %d\n", per_cu);
            (void)hipGetLastError();
        }
#endif
        grid = cus;
    }
    if (grid < 0) return;
    (void)in_sizes;
    if (hipMemsetAsync((char*)d_ws + WS_CTL, 0, CTL_ZERO_BYTES, stream) != hipSuccess) return;
    ArgsH a{};
    for (int i = 0; i < N_IN; ++i) a.in[i] = (const float*)d_in[i];
    a.out = (float*)d_out; a.ws = (unsigned char*)d_ws;
    for (int f = 0; f < 44; ++f) a.invf[f] = (f < 32) ? pow(10000.0, -(double)f / 32.0) : (f < 40) ? pow(500000.0, -(double)(f - 32) / 8.0) : pow(500000.0, -(double)(f - 40) / 4.0);
#if MK_N_LAUNCHES == 1
    a.ph_lo = 0; a.ph_hi = NPHASE; a.li = 0;
    hipLaunchKernelGGL(fwd<-1>, dim3(grid), dim3(NWAVES * 64), LDS_BYTES, stream, a);
#else
    {
        for (int p = 0; p < NPHASE; ++p) {
            if (p == 1 + NPL) continue;
            a.ph_lo = p; a.ph_hi = p + 1; a.li = p;
            const int kind = (p == 0) ? 0 : 1 + (p - 1) % NPL;
            launch_kind(kind, grid, stream, a);
        }
    }
#endif
}
```

```cpp
#include <hip/hip_runtime.h>
#include <cstdio>
#include <cstdint>
#include <cmath>

#ifndef MK_N_LAUNCHES
#define MK_N_LAUNCHES 1
#endif

namespace pg8 {
#define PG8_LAS __attribute__((address_space(3)))
typedef unsigned short bf16_t;
typedef short bf16x8 __attribute__((ext_vector_type(8)));
typedef float f32x4 __attribute__((ext_vector_type(4)));
typedef unsigned u32x4 __attribute__((ext_vector_type(4)));
typedef unsigned u32x2 __attribute__((ext_vector_type(2)));
constexpr int BM = 256, BK = 64, HALF = 128, HTB = HALF * BK * 2  , STAGE_BYTES = 8 * HTB, NXCD = 8, WGM = 8;

__host__ __device__ __forceinline__ int lds_byte(int r, int c) { const int st = (r >> 4) * 2 + (c >> 5), rr = r & 15, cc = c & 31, ob = rr * 64 + cc * 2; return st * 1024 + (ob ^ (((ob >> 9) & 1) << 5)); }
__host__ __device__ __forceinline__ void stage_rc(int b, int& R, int& C) { const int st = b / 1024, sb = b % 1024, swz = sb ^ (((sb >> 9) & 1) << 5); R = (st >> 1) * 16 + swz / 64; C = (st & 1) * 32 + (swz % 64) / 2; }
__host__ __device__ __forceinline__ int perm32(int rho) { const int n = rho >> 4, i = rho & 15; return 8 * (i >> 2) + 4 * n + (i & 3); }

struct Unit { int pm, pn; };
struct Gemm { const bf16_t* A; const bf16_t* Bt; int M, N, K; };

struct StaticOrder {
    int nM, nN, nwg, G, c;
    __host__ __device__ void init(int M, int N, int G_, int c_) { nM = M / BM; nN = N / BM; nwg = nM * nN; G = G_; c = c_; }
    __host__ __device__ bool next(int i, Unit& u) const {
        const long L = (long)i * G + c; if (L >= nwg) return false;
        int wgid = (int)L; { const int q = nwg / NXCD, r = nwg % NXCD, xcd = wgid % NXCD, off = wgid / NXCD; wgid = (xcd < r ? xcd * (q + 1) : r * (q + 1) + (xcd - r) * q) + off; }
        const int nig = WGM * nN, gid = wgid / nig, fm = gid * WGM, gsz = (nM - fm) < WGM ? (nM - fm) : WGM;
        u.pm = fm + ((wgid % nig) % gsz); u.pn = (wgid % nig) / gsz; return true;
    }
    __device__ __forceinline__ void a_ready(const Unit&) const {}
    __device__ __forceinline__ void done(const Unit&) const {}
};
__device__ __forceinline__ unsigned cvt_pk_bf16(float lo, float hi) { unsigned r; asm volatile("v_cvt_pk_bf16_f32 %0, %1, %2" : "=v"(r) : "v"(lo), "v"(hi)); return r; }
struct EpiF32 {
    static constexpr bool PERM = false, AFTER_DRAIN = false;
    float* C; int ldc;
    __device__ __forceinline__ void operator()(const f32x4 (&acc)[2][2][4][2], const Unit& u, int wr, int wc, int fr, int fq) const {
        const int row0 = u.pm * BM + wr * 64 + fr, col0 = u.pn * BM + wc * 32 + 4 * fq;
#pragma unroll
        for (int ai = 0; ai < 2; ++ai)
#pragma unroll
            for (int m = 0; m < 4; ++m) { float* rowp = C + (size_t)(row0 + ai * HALF + m * 16) * ldc + col0;
#pragma unroll
                for (int bj = 0; bj < 2; ++bj)
#pragma unroll
                    for (int n = 0; n < 2; ++n) *(f32x4*)(rowp + bj * HALF + n * 16) = acc[ai][bj][m][n]; }
    }
};
struct EpiRes {
    static constexpr bool PERM = false, AFTER_DRAIN = false;
    const float* xin; float* xout; const float* gate;
    __device__ __forceinline__ void operator()(const f32x4 (&acc)[2][2][4][2], const Unit& u, int wr, int wc, int fr, int fq) const {
        const int row0 = u.pm * BM + wr * 64 + fr, col0 = u.pn * BM + wc * 32 + 4 * fq;
        const float* gp = gate + (size_t)((u.pm * BM) >> 12) * 6144 + col0;
        f32x4 gv[2][2];
#pragma unroll
        for (int bj = 0; bj < 2; ++bj)
#pragma unroll
            for (int n = 0; n < 2; ++n) gv[bj][n] = *(const f32x4*)(gp + bj * HALF + n * 16);
#pragma unroll
        for (int ai = 0; ai < 2; ++ai)
#pragma unroll
            for (int m = 0; m < 4; ++m) { const size_t ro = (size_t)(row0 + ai * HALF + m * 16) * 1024 + col0;
#pragma unroll
                for (int bj = 0; bj < 2; ++bj)
#pragma unroll
                    for (int n = 0; n < 2; ++n) { const f32x4 xv = *(const f32x4*)(xin + ro + bj * HALF + n * 16); *(f32x4*)(xout + ro + bj * HALF + n * 16) = xv + gv[bj][n] * acc[ai][bj][m][n]; } }
    }
};
__device__ __forceinline__ float swiglu1(float glu, float lin) {
    glu = fminf(glu, 7.0f); lin = fminf(fmaxf(lin, -7.0f), 7.0f);
    return glu * (1.0f / (1.0f + __expf(-1.702f * glu))) * (lin + 1.0f);
}
struct EpiSwiglu {
    static constexpr bool PERM = true, AFTER_DRAIN = false;
    bf16_t* O; const float* b1;
    __device__ __forceinline__ void operator()(const f32x4 (&acc)[2][2][4][2], const Unit& u, int wr, int wc, int fr, int fq) const {
        const int e = u.pn >> 3, j = u.pn & 7, row0 = u.pm * BM + wr * 64 + fr, c0 = 128 * j + wc * 32 + 8 * fq;
        const float* bp = b1 + (size_t)e * 2048 + c0;
        f32x4 bg[2], bl[2];
#pragma unroll
        for (int n = 0; n < 2; ++n) { bg[n] = *(const f32x4*)(bp + 4 * n); bl[n] = *(const f32x4*)(bp + 1024 + 4 * n); }
#pragma unroll
        for (int ai = 0; ai < 2; ++ai)
#pragma unroll
            for (int m = 0; m < 4; ++m) { bf16_t* rowp = O + (size_t)(row0 + ai * HALF + m * 16) * 1024 + c0;
                const f32x4 g0 = acc[ai][0][m][0] + bg[0], g1 = acc[ai][0][m][1] + bg[1], l0 = acc[ai][1][m][0] + bl[0], l1 = acc[ai][1][m][1] + bl[1];
                u32x4 w;
                w.x = cvt_pk_bf16(swiglu1(g0[0], l0[0]), swiglu1(g0[1], l0[1])); w.y = cvt_pk_bf16(swiglu1(g0[2], l0[2]), swiglu1(g0[3], l0[3]));
                w.z = cvt_pk_bf16(swiglu1(g1[0], l1[0]), swiglu1(g1[1], l1[1])); w.w = cvt_pk_bf16(swiglu1(g1[2], l1[2]), swiglu1(g1[3], l1[3]));
                *(u32x4*)rowp = w; }
    }
};
struct EpiY {
    static constexpr bool PERM = true, AFTER_DRAIN = false;
    bf16_t* O; const float* b2;
    __device__ __forceinline__ void operator()(const f32x4 (&acc)[2][2][4][2], const Unit& u, int wr, int wc, int fr, int fq) const {
        const int e = u.pn >> 2, j = u.pn & 3, row0 = u.pm * BM + wr * 64 + fr, c0 = 256 * j + wc * 32 + 8 * fq;
        const float* bp = b2 + (size_t)e * 1024 + c0;
        f32x4 bv[2][2];
#pragma unroll
        for (int bj = 0; bj < 2; ++bj)
#pragma unroll
            for (int n = 0; n < 2; ++n) bv[bj][n] = *(const f32x4*)(bp + bj * HALF + 4 * n);
#pragma unroll
        for (int ai = 0; ai < 2; ++ai)
#pragma unroll
            for (int m = 0; m < 4; ++m) { bf16_t* rowp = O + (size_t)(row0 + ai * HALF + m * 16) * 1024 + c0;
#pragma unroll
                for (int bj = 0; bj < 2; ++bj) { const f32x4 v0 = acc[ai][bj][m][0] + bv[bj][0], v1 = acc[ai][bj][m][1] + bv[bj][1];
                    u32x4 w; w.x = cvt_pk_bf16(v0[0], v0[1]); w.y = cvt_pk_bf16(v0[2], v0[3]); w.z = cvt_pk_bf16(v1[0], v1[1]); w.w = cvt_pk_bf16(v1[2], v1[3]);
                    *(u32x4*)(rowp + bj * HALF) = w; } }
    }
};
struct MoeOrder {
    const PG8_LAS int* tab; int NJ, G, c;
    __device__ __forceinline__ bool next(int i, Unit& u) const {
        const int T = tab[0]; const long L = (long)i * G + c; if (L >= (long)T * NJ) return false;
        const int pm = (int)(L / NJ), j = (int)(L % NJ);
        u.pm = pm; u.pn = tab[1 + pm] * NJ + j; return true;
    }
    __device__ __forceinline__ void a_ready(const Unit&) const {}
    __device__ __forceinline__ void done(const Unit&) const {}
};

template <class Epi, class Sched, bool ALIGN_EPI = false, bool SP2 = false>
__device__ __forceinline__ void gemm_phase(PG8_LAS unsigned char* lds, const Gemm g, const Sched& S, const Epi& E, int tid_in) {
    int tid_ = tid_in; asm volatile("" : "+v"(tid_));
    const int tid = tid_, wid = __builtin_amdgcn_readfirstlane(tid >> 6), lane = tid & 63, wr = wid >> 2, wc = wid & 3, fr = lane & 15, fq = lane >> 4;
    const int K = g.K, nt = K / BK;
    unsigned voffA[2], voffB[2];
#pragma unroll
    for (int i = 0; i < 2; ++i) { int R, C; stage_rc(tid * 16 + i * 8192, R, C); const int Rb = Epi::PERM ? ((R & ~31) + perm32(R & 31)) : R;
        voffA[i] = (unsigned)(R * K + C) * 2u; voffB[i] = (unsigned)(Rb * K + C) * 2u; }
    const size_t kstep = (size_t)(BK * 2);
    const size_t hstep = (size_t)HALF * K * 2;
    const size_t tstep = 2 * hstep;
    const unsigned ldsw = (unsigned)wid * 1024u;
    const int aoff = lds_byte(wr * 64 + fr, fq * 8), boff = lds_byte(wc * 32 + fr, fq * 8);
#define PG8_SA(b, h) (((b) * 2 + (h)) * HTB)
#define PG8_SB(b, h) ((4 + (b) * 2 + (h)) * HTB)
#define PG8_STAGE(bufoff, gbase, voff) do { _Pragma("unroll") for (int _i = 0; _i < 2; ++_i) \
        __builtin_amdgcn_global_load_lds((const unsigned*)((const char*)(gbase) + (voff)[_i]), (PG8_LAS unsigned*)(lds + (bufoff) + ldsw + _i * 8192), 16, 0, 0); } while (0)
#define PG8_LDA(dst, b, h) do { _Pragma("unroll") for (int m = 0; m < 4; ++m) _Pragma("unroll") for (int k = 0; k < 2; ++k) dst[m][k] = *(const PG8_LAS bf16x8*)(lds + PG8_SA(b, h) + aoff + m * 2048 + k * 1024); } while (0)
#define PG8_LDB(dst, b, h) do { _Pragma("unroll") for (int n = 0; n < 2; ++n) _Pragma("unroll") for (int k = 0; k < 2; ++k) dst[n][k] = *(const PG8_LAS bf16x8*)(lds + PG8_SB(b, h) + boff + n * 2048 + k * 1024); } while (0)
#define PG8_MMA(ai, bj, At, Bt) do { __builtin_amdgcn_s_setprio(1); _Pragma("unroll") for (int m = 0; m < 4; ++m) _Pragma("unroll") for (int n = 0; n < 2; ++n) _Pragma("unroll") for (int k = 0; k < 2; ++k) \
        acc[ai][bj][m][n] = __builtin_amdgcn_mfma_f32_16x16x32_bf16(Bt[n][k], At[m][k], acc[ai][bj][m][n], 0, 0, 0); __builtin_amdgcn_s_setprio(0); } while (0)
#define PG8_WAIT_V(n) asm volatile("s_waitcnt vmcnt(" #n ")" ::: "memory")
#define PG8_WAIT_L(n) asm volatile("s_waitcnt lgkmcnt(" #n ")" ::: "memory")
#define PG8_BAR __builtin_amdgcn_s_barrier()
#define PG8_SCHED __builtin_amdgcn_sched_barrier(0)
    Unit cur, nxt; int ui = 0;
    if (!S.next(0, cur)) return;
    f32x4 acc[2][2][4][2];
#pragma unroll
    for (int a = 0; a < 2; ++a)
#pragma unroll
        for (int b = 0; b < 2; ++b)
#pragma unroll
            for (int m = 0; m < 4; ++m)
#pragma unroll
                for (int n = 0; n < 2; ++n) acc[a][b][m][n] = (f32x4){0.f, 0.f, 0.f, 0.f};
    bf16x8 At[4][2], B0[2][2], B1[2][2];
    const char* cA = (const char*)g.A + (size_t)cur.pm * tstep; const char* cB = (const char*)g.Bt + (size_t)cur.pn * tstep;
    S.a_ready(cur);
    if constexpr (SP2) {
        PG8_STAGE(PG8_SB(0, 0), cB, voffB); PG8_STAGE(PG8_SB(0, 1), cB + hstep, voffB); PG8_STAGE(PG8_SA(0, 0), cA, voffA); PG8_STAGE(PG8_SA(0, 1), cA + hstep, voffA);
        if (wr == 1) PG8_BAR;
        PG8_WAIT_V(2); PG8_BAR;
        PG8_STAGE(PG8_SB(1, 0), cB + kstep, voffB); PG8_STAGE(PG8_SA(1, 0), cA + kstep, voffA); PG8_STAGE(PG8_SB(1, 1), cB + hstep + kstep, voffB);
        PG8_WAIT_V(6); PG8_BAR;
    } else {
        PG8_STAGE(PG8_SB(0, 0), cB, voffB); PG8_STAGE(PG8_SA(0, 0), cA, voffA); PG8_STAGE(PG8_SB(0, 1), cB + hstep, voffB); PG8_STAGE(PG8_SA(0, 1), cA + hstep, voffA);
        if (wr == 1) PG8_BAR;
        PG8_WAIT_V(4); PG8_BAR;
        PG8_STAGE(PG8_SB(1, 0), cB + kstep, voffB); PG8_STAGE(PG8_SA(1, 0), cA + kstep, voffA); PG8_STAGE(PG8_SB(1, 1), cB + hstep + kstep, voffB);
        PG8_WAIT_V(6); PG8_BAR;
    }
    for (;;) {
        const bool has_next = S.next(ui + 1, nxt);
        const char* nA = has_next ? (const char*)g.A + (size_t)nxt.pm * tstep : cA; const char* nB = has_next ? (const char*)g.Bt + (size_t)nxt.pn * tstep : cB;
        for (int t = 0; t < nt; t += 2) {
            const bool last = (t == nt - 2);
            const char* a1 = cA + (size_t)(t + 1) * kstep;
            const char* a2 = last ? nA : cA + (size_t)(t + 2) * kstep; const char* b2 = last ? nB : cB + (size_t)(t + 2) * kstep;
            const char* a3 = a2 + kstep; const char* b3 = b2 + kstep;
            if (last && has_next) S.a_ready(nxt);
            if constexpr (SP2) {
            PG8_LDB(B0, 0, 0); PG8_LDB(B1, 0, 1); PG8_SCHED; PG8_LDA(At, 0, 0); PG8_STAGE(PG8_SA(1, 1), a1 + hstep, voffA);
            PG8_WAIT_V(8); PG8_WAIT_L(0); PG8_BAR; PG8_MMA(0, 0, At, B0); PG8_MMA(0, 1, At, B1); PG8_BAR; PG8_SCHED;
            PG8_LDA(At, 0, 1); PG8_STAGE(PG8_SB(0, 0), b2, voffB); PG8_STAGE(PG8_SB(0, 1), b2 + hstep, voffB); PG8_STAGE(PG8_SA(0, 0), a2, voffA);
            PG8_WAIT_V(8); PG8_WAIT_L(0); PG8_BAR; PG8_MMA(1, 0, At, B0); PG8_MMA(1, 1, At, B1); PG8_BAR; PG8_SCHED;
            PG8_LDB(B0, 1, 0); PG8_LDB(B1, 1, 1); PG8_SCHED; PG8_LDA(At, 1, 0); PG8_STAGE(PG8_SA(0, 1), a2 + hstep, voffA);
            PG8_WAIT_V(8); PG8_WAIT_L(0); PG8_BAR; PG8_MMA(0, 0, At, B0); PG8_MMA(0, 1, At, B1); PG8_BAR; PG8_SCHED;
            PG8_LDA(At, 1, 1); PG8_STAGE(PG8_SB(1, 0), b3, voffB); PG8_STAGE(PG8_SB(1, 1), b3 + hstep, voffB); PG8_STAGE(PG8_SA(1, 0), a3, voffA);
            PG8_WAIT_V(8); PG8_WAIT_L(0); PG8_BAR; PG8_MMA(1, 0, At, B0); PG8_MMA(1, 1, At, B1); PG8_BAR; PG8_SCHED;
            } else {
            PG8_LDB(B0, 0, 0); PG8_SCHED; PG8_LDA(At, 0, 0); PG8_STAGE(PG8_SA(1, 1), a1 + hstep, voffA);
            PG8_WAIT_L(8); PG8_BAR; PG8_WAIT_L(0); PG8_MMA(0, 0, At, B0); PG8_BAR; PG8_SCHED;
            PG8_LDB(B1, 0, 1); PG8_STAGE(PG8_SB(0, 0), b2, voffB);
            PG8_BAR; PG8_WAIT_L(0); PG8_MMA(0, 1, At, B1); PG8_BAR;
            PG8_LDA(At, 0, 1); PG8_STAGE(PG8_SA(0, 0), a2, voffA);
            PG8_BAR; PG8_WAIT_L(0); PG8_MMA(1, 0, At, B0); PG8_BAR; PG8_SCHED;
            PG8_STAGE(PG8_SB(0, 1), b2 + hstep, voffB);
            PG8_WAIT_V(6); PG8_BAR; PG8_MMA(1, 1, At, B1); PG8_BAR;
            PG8_LDB(B0, 1, 0); PG8_SCHED; PG8_LDA(At, 1, 0); PG8_STAGE(PG8_SA(0, 1), a2 + hstep, voffA);
            PG8_WAIT_L(8); PG8_BAR; PG8_WAIT_L(0); PG8_MMA(0, 0, At, B0); PG8_BAR; PG8_SCHED;
            PG8_LDB(B1, 1, 1); PG8_STAGE(PG8_SB(1, 0), b3, voffB);
            PG8_BAR; PG8_WAIT_L(0); PG8_MMA(0, 1, At, B1); PG8_BAR;
            PG8_LDA(At, 1, 1); PG8_STAGE(PG8_SA(1, 0), a3, voffA);
            PG8_BAR; PG8_WAIT_L(0); PG8_MMA(1, 0, At, B0); PG8_BAR; PG8_SCHED;
            PG8_STAGE(PG8_SB(1, 1), b3 + hstep, voffB);
            PG8_WAIT_V(6); PG8_BAR; PG8_MMA(1, 1, At, B1); PG8_BAR;
            }
        }
        if constexpr (ALIGN_EPI) { if (wr == 0) PG8_BAR; }
        if constexpr (!Epi::AFTER_DRAIN) { E(acc, cur, wr, wc, fr, fq); S.done(cur); }
        if (!has_next) break;
#pragma unroll
        for (int a = 0; a < 2; ++a)
#pragma unroll
            for (int b = 0; b < 2; ++b)
#pragma unroll
                for (int m = 0; m < 4; ++m)
#pragma unroll
                    for (int n = 0; n < 2; ++n) acc[a][b][m][n] = (f32x4){0.f, 0.f, 0.f, 0.f};
        cur = nxt; cA = nA; cB = nB; ++ui;
        if constexpr (ALIGN_EPI) { if (wr == 1) PG8_BAR; }
    }
    PG8_WAIT_V(0);
    if constexpr (!ALIGN_EPI) { if (wr == 0) PG8_BAR; }
    PG8_BAR;
    if constexpr (Epi::AFTER_DRAIN) { E.fused(acc, cur, wr, wc, fr, fq, lds, wid, lane); S.done(cur); }
#undef PG8_SA
#undef PG8_SB
#undef PG8_STAGE
#undef PG8_LDA
#undef PG8_LDB
#undef PG8_MMA
#undef PG8_WAIT_V
#undef PG8_WAIT_L
#undef PG8_BAR
#undef PG8_SCHED
}
}

constexpr int NWAVES = 8;
constexpr int NB = 8, SEQ = 4096, DM = 1024, MTOK = NB * SEQ, NLAYER = 2;
constexpr int INC = 2984, INCP = 3072;
constexpr int C_RET = 0, C_RW = 1024, C_DSA = 1920, C_SB = 2216;
constexpr int NEXP = 32, MOE_ROWS = MTOK * 4 + NEXP * 256;
constexpr int ROPE_W = 88;
constexpr int NCH = 16, TCH = SEQ / NCH;
constexpr int NPL = 12, NPHASE = 1 + NLAYER * NPL;
enum { I_X = 0, I_C, I_POS, I_ADAW, I_ADAB, I_NMIX, I_NFFN, I_WIN, I_RETGN, I_MU, I_W0, I_W2, I_A0, I_A2, I_G2, I_KK, I_KA, I_RK, I_LN, I_QNORM, I_WQ, I_WQI, I_DONORM, I_SONORM, I_WOUT, I_RW, I_RB, I_MW1, I_MB1, I_MW2, I_MB2, I_NFINAL, N_IN };

constexpr size_t MiB = 1u << 20;
constexpr size_t WS_CTL = 0, CTL_ZERO_BYTES = 1 * MiB;
constexpr size_t WS_MOD = 1 * MiB, WS_ROPE = 2 * MiB, WS_WIN = 14 * MiB, WS_WOUT = 26 * MiB, WS_W1 = 30 * MiB, WS_W2 = 286 * MiB;
constexpr size_t WS_XA = 414 * MiB, WS_H = 542 * MiB, WS_MIX = 606 * MiB, WS_TOPI = 670 * MiB, WS_TOPW = 671 * MiB, WS_POS = 672 * MiB;
constexpr size_t WS_R = 674 * MiB;
constexpr size_t WS_P = WS_R, WS_RWA = 1058 * MiB  , WS_DQ = 1314 * MiB  , WS_DKB = 1330 * MiB  , WS_DVB = 1334 * MiB  , WS_DQI = 1346 * MiB  , WS_DKI = 1394 * MiB  , WS_DW = 1398 * MiB;
constexpr size_t WS_SMALLW = 1338 * MiB  ;
constexpr int SMW_QI = 0, SMW_W2 = 512 * 128, SMW_A2 = SMW_W2 + 256 * 32, SMW_G2 = SMW_A2 + 256 * 32, SMW_LAYER = SMW_G2 + 256 * 64;
constexpr size_t WS_PT = 1362 * MiB  ;
constexpr size_t WS_CH = WS_H  , WS_SI = WS_H + 16 * MiB  , WS_SIR = WS_H + 24 * MiB  ,
                 WS_CHR = WS_H + 32 * MiB  , WS_PTR = WS_H + 40 * MiB  ;
constexpr size_t WS_SQ = WS_MIX  , WS_SK = WS_MIX + 16 * MiB, WS_SV = WS_MIX + 32 * MiB;
constexpr size_t WS_YO = 1400 * MiB  , WS_SC = 1528 * MiB  ;
constexpr size_t WS_XS = WS_R  , WS_ACT = 946 * MiB  ;
constexpr size_t WS_END = 2040 * MiB;
static_assert((size_t)MOE_ROWS * 2048 <= 272 * MiB, "moe buffers");
constexpr int CW_TMO = 0, CW_CODE = 1, CW_DSAQ = 64  , CW_BAR = 4096, CW_BLKCNT = 16384  ;
constexpr int RING_BYTES = 131072, MISC_OFF = RING_BYTES + 320, TST_OFF = RING_BYTES + 1024  , TAB_OFF = RING_BYTES + 2048  , HIST_OFF = RING_BYTES + 5120  , BASE_OFF = RING_BYTES + 5376  , LDS_BYTES = 147456;

#if defined(__HIP_DEVICE_COMPILE__)
#define GAS __attribute__((address_space(1)))
#define CAS __attribute__((address_space(4)))
#else
#define GAS
#define CAS
#endif
#define LAS __attribute__((address_space(3)))
typedef unsigned short bf16;
typedef unsigned v4u __attribute__((ext_vector_type(4)));
typedef unsigned v2u __attribute__((ext_vector_type(2)));
typedef float f32x4 __attribute__((ext_vector_type(4)));
typedef GAS unsigned gu32;
typedef short bf16x8v __attribute__((ext_vector_type(8)));
typedef short s16x4v __attribute__((ext_vector_type(4)));
typedef _Float16 f16x8 __attribute__((ext_vector_type(8)));
#define RLX_AGENT __ATOMIC_RELAXED, __HIP_MEMORY_SCOPE_AGENT
#define LDS_WAIT() asm volatile("s_waitcnt lgkmcnt(0)" ::: "memory")
#define VM_WAIT() asm volatile("s_waitcnt vmcnt(0)" ::: "memory")
__device__ __forceinline__ unsigned f2bf(float f) { unsigned u = __builtin_bit_cast(unsigned, f); return (u + 0x7fffu + ((u >> 16) & 1u)) >> 16; }
__device__ __forceinline__ unsigned pk2(float lo, float hi) { return f2bf(lo) | (f2bf(hi) << 16); }
__device__ __forceinline__ float bf_lo(unsigned w) { return __builtin_bit_cast(float, w << 16); }
__device__ __forceinline__ float bf_hi(unsigned w) { return __builtin_bit_cast(float, w & 0xffff0000u); }
__device__ __forceinline__ float wave_sum(float v) {
#pragma unroll
    for (int o = 1; o < 64; o <<= 1) v += __shfl_xor(v, o);
    return v;
}
__device__ __forceinline__ float wave_max(float v) {
#pragma unroll
    for (int o = 1; o < 64; o <<= 1) v = fmaxf(v, __shfl_xor(v, o));
    return v;
}
__device__ __forceinline__ float grp16_sum(float v) { v += __shfl_xor(v, 1); v += __shfl_xor(v, 2); v += __shfl_xor(v, 4); v += __shfl_xor(v, 8); return v; }
__device__ __forceinline__ float grp8_sum(float v) { v += __shfl_xor(v, 1); v += __shfl_xor(v, 2); v += __shfl_xor(v, 4); return v; }
__device__ __forceinline__ float sum4(f32x4 a) { return (a.x + a.y) + (a.z + a.w); }
__device__ __forceinline__ float dot4(f32x4 a, f32x4 b) { return (a.x * b.x + a.y * b.y) + (a.z * b.z + a.w * b.w); }
__device__ __forceinline__ float sigm(float x) { return 1.0f / (1.0f + expf(-x)); }
__device__ __forceinline__ float softplusf(float x) { return fmaxf(x, 0.0f) + log1pf(expf(-fabsf(x))); }
__device__ __forceinline__ f32x4 shx4(f32x4 v, int m) { f32x4 r; r.x = __shfl_xor(v.x, m); r.y = __shfl_xor(v.y, m); r.z = __shfl_xor(v.z, m); r.w = __shfl_xor(v.w, m); return r; }

#define XB_TMO      128
#define XB_XCNT(j)  (256  + 64 * (j))
#define XB_XSUB(j)  (1280 + 64 * (j))
#define XB_XGEN(j)  (2304 + 64 * (j))
#define XB_TOP      3328
#define XB_TOPGEN   3392
#define XCD_BAR_WORDS 3456
#define XB_SPIN_CAP (1u << 18)

__device__ __forceinline__ unsigned xb_ld(unsigned* p)              { return __hip_atomic_load(p, __ATOMIC_RELAXED, __HIP_MEMORY_SCOPE_AGENT); }
__device__ __forceinline__ unsigned xb_add(unsigned* p, unsigned v) { return __hip_atomic_fetch_add(p, v, __ATOMIC_RELAXED, __HIP_MEMORY_SCOPE_AGENT); }
__device__ __forceinline__ unsigned xb_xcc_id() { return (unsigned)__builtin_amdgcn_s_getreg((3 << 11) | 20) & 0xFu; }
#define XB_SPIN(cond, bar) do { unsigned _sp = 0; while (cond) { __builtin_amdgcn_s_sleep(1); \
    if ((++_sp & 255u) == 0u) { if (xb_ld(&(bar)[XB_TMO])) break; if (_sp > XB_SPIN_CAP) { atomicAdd(&(bar)[XB_TMO], 1u); break; } } } } while (0)

struct XcdBarrier {
    unsigned* bar; unsigned x;
    volatile LAS unsigned* st;
};

__device__ __forceinline__ XcdBarrier xcd_barrier_post(unsigned* bar, volatile LAS unsigned* st, int xb_tid) {
    XcdBarrier b; b.bar = bar; b.x = xb_xcc_id(); b.st = st;
    if (xb_tid == 0) (void)xb_add(&bar[XB_XCNT(b.x)], 1u);
    return b;
}
__device__ __forceinline__ void xcd_barrier_complete(unsigned* bar, unsigned x, unsigned& nloc, unsigned& nx) {
    const unsigned G = gridDim.x * gridDim.y * gridDim.z;
    unsigned sum, cnt, mine, sp = 0u;
    for (;;) {
        sum = 0u; cnt = 0u; mine = 0u;
#pragma unroll
        for (unsigned j = 0; j < 16; ++j) { const unsigned c = xb_ld(&bar[XB_XCNT(j)]); sum += c; cnt += (c > 0u) ? 1u : 0u; mine = (j == x) ? c : mine; }
        if (sum == G) break;
        __builtin_amdgcn_s_sleep(1);
        if ((++sp & 255u) == 0u) { if (xb_ld(&bar[XB_TMO])) break; if (sp > XB_SPIN_CAP) { atomicAdd(&bar[XB_TMO], 1u); break; } }
    }
    nloc = mine > 0u ? mine : 1u; nx = cnt > 0u ? cnt : 1u;
}

__device__ __forceinline__ void xcd_barrier(const XcdBarrier& b, int xb_tid) {
    asm volatile("s_waitcnt vmcnt(0)" ::: "memory");
    __syncthreads();
    if (xb_tid == 0) {
        unsigned* bar = b.bar;
        __builtin_amdgcn_s_waitcnt(0);
        unsigned nloc = b.st[0], nx = b.st[1];
        if (nloc == 0u) { xcd_barrier_complete(bar, b.x, nloc, nx); b.st[0] = nloc; b.st[1] = nx; }
        const unsigned old = xb_add(&bar[XB_XSUB(b.x)], 1u);
        const unsigned gen = old / nloc;
        if (old + 1u == (gen + 1u) * nloc) {
            __builtin_amdgcn_fence(__ATOMIC_RELEASE, "agent");
            asm volatile("s_waitcnt vmcnt(0)" ::: "memory");
            const unsigned og = xb_add(&bar[XB_TOP], 1u);
            const unsigned tg = og / nx;
            if (og + 1u == (tg + 1u) * nx) xb_add(&bar[XB_TOPGEN], 1u);
            else XB_SPIN(xb_ld(&bar[XB_TOPGEN]) == tg, bar);
            __builtin_amdgcn_fence(__ATOMIC_ACQUIRE, "agent");
            xb_add(&bar[XB_XGEN(b.x)], 1u);
            asm volatile("s_waitcnt vmcnt(0)" ::: "memory");
        } else {
            XB_SPIN(xb_ld(&bar[XB_XGEN(b.x)]) == gen, bar);
            __builtin_amdgcn_fence(__ATOMIC_ACQUIRE, "agent");
            asm volatile("s_waitcnt vmcnt(0)" ::: "memory");
        }
    }
    __syncthreads();
}
struct ArgsH { const float* in[N_IN]; float* out; unsigned char* ws; double invf[44]; int ph_lo, ph_hi, li, pad; };
struct ArgsD { const GAS float* in[N_IN]; GAS float* out; GAS unsigned char* ws; double invf[44]; int ph_lo, ph_hi, li, pad; };
static_assert(sizeof(ArgsH) == sizeof(ArgsD), "args layout");
typedef const CAS ArgsD& ARef;
__device__ __forceinline__ const CAS ArgsD* kargs() {
#if defined(__HIP_DEVICE_COMPILE__)
    const CAS ArgsD* p = (const CAS ArgsD*)__builtin_amdgcn_kernarg_segment_ptr(); asm volatile("" : "+s"(p)); return p;
#else
    return nullptr;
#endif
}
struct WI { LAS unsigned char* lds; int tid, lane, wave, vcu, G, gw, NGW, bx; };
constexpr size_t RWA_STRIDE = 32 * MiB / 4;
constexpr size_t YO_STRIDE = 32 * MiB / 4;

__device__ __forceinline__ int wave_sum_i(int v) {
#pragma unroll
    for (int o = 1; o < 64; o <<= 1) v += __shfl_xor(v, o);
    return v;
}
__device__ __forceinline__ void sincos_d(double ang, float& s, float& c) {
    const double q = __builtin_rint(ang * 0.63661977236758134308);
    double r = __builtin_fma(-q, 1.57079632679489661923, ang); r = __builtin_fma(-q, 6.123233995736766e-17, r);
    const double r2 = r * r;
    const double sp = r * (1.0 + r2 * (-1.0 / 6 + r2 * (1.0 / 120 + r2 * (-1.0 / 5040 + r2 * (1.0 / 362880 + r2 * (-1.0 / 39916800 + r2 * (1.0 / 6227020800.0)))))));
    const double cp = 1.0 + r2 * (-0.5 + r2 * (1.0 / 24 + r2 * (-1.0 / 720 + r2 * (1.0 / 40320 + r2 * (-1.0 / 3628800 + r2 * (1.0 / 479001600 + r2 * (-1.0 / 87178291200.0)))))));
    const int qi = ((int)q) & 3;
    const double ss = (qi == 0) ? sp : (qi == 1) ? cp : (qi == 2) ? -sp : -cp;
    const double cc = (qi == 0) ? cp : (qi == 1) ? -sp : (qi == 2) ? -cp : sp;
    s = (float)ss; c = (float)cc;
}

__device__ __forceinline__ void tr_item(const float* W, int ldw, int nvalid, int k0, int nsrc0, bf16* WT, size_t dstrow0, LAS float* scr, int lane) {
#pragma unroll 8
    for (int i = 0; i < 32; ++i) { const int kk = 2 * i + (lane >> 5), c = lane & 31, n = nsrc0 + c; scr[kk * 33 + c] = (n < nvalid) ? W[(size_t)(k0 + kk) * ldw + n] : 0.0f; }
    LDS_WAIT(); asm volatile("" ::: "memory");
    const int c8 = lane & 7;
#pragma unroll
    for (int j = 0; j < 4; ++j) { const int n = (lane >> 3) + 8 * j; const LAS float* s = scr + (8 * c8) * 33 + n;
        v4u o; o.x = pk2(s[0 * 33], s[1 * 33]); o.y = pk2(s[2 * 33], s[3 * 33]); o.z = pk2(s[4 * 33], s[5 * 33]); o.w = pk2(s[6 * 33], s[7 * 33]);
        *(v4u*)(WT + (dstrow0 + n) * 1024 + k0 + 8 * c8) = o; }
    LDS_WAIT(); asm volatile("" ::: "memory");
}
__device__ __forceinline__ void ph_prologue(ARef A, const WI& w) {
    LAS float* sc = (LAS float*)w.lds;
    { const float* cin = A.in[I_C]; for (int i = w.tid; i < NB * DM; i += NWAVES * 64) { const float v = cin[i]; sc[i] = v / (1.0f + expf(-v)); } }
    __syncthreads();
    float* MOD = (float*)(A.ws + WS_MOD);
    if (w.wave == 0 && w.vcu < 192) {
        const int l = w.vcu / 96, col = (w.vcu % 96) * 64 + w.lane;
        const float* wp = A.in[I_ADAW] + (size_t)l * DM * 6144 + col;
        float acc[8];
#pragma unroll
        for (int b = 0; b < 8; ++b) acc[b] = 0.0f;
        for (int k = 0; k < DM; ++k) { const float wv = wp[(size_t)k * 6144];
#pragma unroll
            for (int b = 0; b < 8; ++b) acc[b] += sc[b * DM + k] * wv; }
        const float bias = A.in[I_ADAB][l * 6144 + col];
#pragma unroll
        for (int b = 0; b < 8; ++b) MOD[(size_t)(l * 8 + b) * 6144 + col] = acc[b] + bias;
    }
    LAS float* scr = (LAS float*)(w.lds + 32768 + w.wave * 8448);
    constexpr int I_IN = NLAYER * 16 * 96, I_OUT = NLAYER * 16 * 32, I_W1 = NLAYER * NEXP * 16 * 64, I_W2 = NLAYER * NEXP * 16 * 32, NIT = I_IN + I_OUT + I_W1 + I_W2;
    for (int it = w.gw; it < NIT; it += w.NGW) {
        int r = it;
        if (r < I_IN) { const int l = r / 1536, rr = r % 1536, kb = rr / 96, nb = rr % 96;
            tr_item(A.in[I_WIN] + (size_t)l * DM * INC, INC, INC, kb * 64, nb * 32, (bf16*)(A.ws + WS_WIN) + (size_t)l * INCP * DM, (size_t)nb * 32, scr, w.lane); continue; }
        r -= I_IN;
        if (r < I_OUT) { const int l = r / 512, rr = r % 512, kb = rr / 32, nb = rr % 32;
            tr_item(A.in[I_WOUT] + (size_t)l * DM * DM, DM, DM, kb * 64, nb * 32, (bf16*)(A.ws + WS_WOUT) + (size_t)l * DM * DM, (size_t)nb * 32, scr, w.lane); continue; }
        r -= I_OUT;
        if (r < I_W1) { const int le = r / 1024, rr = r % 1024, kb = rr / 64, nb = rr % 64, j = nb >> 3, bj = (nb >> 2) & 1, cc0 = (nb & 3) * 32;
            tr_item(A.in[I_MW1] + (size_t)le * DM * 2048, 2048, 2048, kb * 64, bj * 1024 + 128 * j + cc0, (bf16*)(A.ws + WS_W1) + (size_t)le * 2048 * DM, (size_t)nb * 32, scr, w.lane); continue; }
        r -= I_W1;
        { const int le = r / 512, rr = r % 512, kb = rr / 32, nb = rr % 32;
            tr_item(A.in[I_MW2] + (size_t)le * DM * DM, DM, DM, kb * 64, nb * 32, (bf16*)(A.ws + WS_W2) + (size_t)le * DM * DM, (size_t)nb * 32, scr, w.lane); }
    }
    float* RT = (float*)(A.ws + WS_ROPE); const int* pos = (const int*)A.in[I_POS];
    for (int g = w.gw * 64 + w.lane; g < MTOK * 44; g += w.NGW * 64) {
        const int tok = g / 44, f = g % 44; int co, so;
        if (f < 32) { co = f; so = 32 + f; } else if (f < 40) { co = 64 + (f - 32); so = 72 + (f - 32); } else { co = 80 + (f - 40); so = 84 + (f - 40); }
        float s, c; sincos_d((double)pos[tok] * A.invf[f], s, c);
        RT[(size_t)tok * ROPE_W + co] = c; RT[(size_t)tok * ROPE_W + so] = s;
    }
}

__device__ __forceinline__ void emit_h_row(const f32x4 (&v)[4], float rstd, const float* g, const float* sc, const float* sh, bf16* hrow, int lane) {
#pragma unroll
    for (int j = 0; j < 4; ++j) { const int k = 4 * (lane + 64 * j);
        const f32x4 gv = *(const f32x4*)(g + k), scv = *(const f32x4*)(sc + k), shv = *(const f32x4*)(sh + k);
        const f32x4 h = v[j] * rstd * gv * (1.0f + scv) + shv;
        v2u o; o.x = pk2(h.x, h.y); o.y = pk2(h.z, h.w); *(v2u*)(hrow + k) = o; }
}
__device__ __forceinline__ void small_weights_to_f16(ARef A, const WI& w) {
    { _Float16* SW = (_Float16*)(A.ws + WS_SMALLW);
      const int g0 = w.gw * 64 + w.lane, gs = w.NGW * 64;
      for (int l = 0; l < NLAYER; ++l) { _Float16* S = SW + (size_t)l * SMW_LAYER;
          const float* wq = A.in[I_WQ] + (size_t)l * 128 * 256; const float* wqi = A.in[I_WQI] + (size_t)l * 128 * 256;
          for (int e = g0; e < 256 * 128; e += gs) { const int n = e >> 7, k = e & 127; S[SMW_QI + e] = (_Float16)wq[k * 256 + n]; S[SMW_QI + 256 * 128 + e] = (_Float16)wqi[k * 256 + n]; }
          const float* w2 = A.in[I_W2] + (size_t)l * 32 * 256; const float* a2 = A.in[I_A2] + (size_t)l * 32 * 256; const float* g2 = A.in[I_G2] + (size_t)l * 64 * 256;
          for (int e = g0; e < 256 * 32; e += gs) { const int n = e >> 5, k = e & 31; S[SMW_W2 + e] = (_Float16)w2[k * 256 + n]; S[SMW_A2 + e] = (_Float16)a2[k * 256 + n]; }
          for (int e = g0; e < 256 * 64; e += gs) { const int n = e >> 6, k = e & 63; S[SMW_G2 + e] = (_Float16)g2[k * 256 + n]; } } }
}
__device__ __forceinline__ void ph_norm1(ARef A, const WI& w) {
    const float* MOD = (const float*)(A.ws + WS_MOD); bf16* H = (bf16*)(A.ws + WS_H);
    for (int m = w.gw; m < MTOK; m += w.NGW) {
        const float* xr = A.in[I_X] + (size_t)m * DM; f32x4 v[4]; float ss = 0.0f;
#pragma unroll
        for (int j = 0; j < 4; ++j) { v[j] = *(const f32x4*)(xr + 4 * (w.lane + 64 * j)); ss += dot4(v[j], v[j]); }
        ss = wave_sum(ss); const float rstd = 1.0f / sqrtf(ss * (1.0f / DM) + 1e-5f);
        const float* mb = MOD + (size_t)(m >> 12) * 6144;
        emit_h_row(v, rstd, A.in[I_NMIX], mb + 1024, mb, H + (size_t)m * DM, w.lane);
    }
}

typedef _Float16 h4v __attribute__((ext_vector_type(4)));
__device__ __forceinline__ f16x8 pack_f16x8(f32x4 a, f32x4 b) { f16x8 r; r[0] = (_Float16)a.x; r[1] = (_Float16)a.y; r[2] = (_Float16)a.z; r[3] = (_Float16)a.w; r[4] = (_Float16)b.x; r[5] = (_Float16)b.y; r[6] = (_Float16)b.z; r[7] = (_Float16)b.w; return r; }
__device__ __forceinline__ void prep16(ARef A, int l, int m0, int lane_in) {
    int lane = lane_in; asm volatile("" : "+v"(lane));
    const int tk = lane & 15, q4 = lane >> 4, m = m0 + tk, t = m & (SEQ - 1);
    const float* P = (const float*)(A.ws + WS_P); float* RWA = (float*)(A.ws + WS_RWA); const _Float16* SW = (const _Float16*)(A.ws + WS_SMALLW) + (size_t)l * SMW_LAYER;
    const float* pr = P + (size_t)m * INCP + C_RW; const float* pp = pr - INCP; const float* pd = P + (size_t)m * INCP + C_DSA; const float* mu = A.in[I_MU] + l * 896;
    const float* RT = (const float*)(A.ws + WS_ROPE) + (size_t)m * ROPE_W; const f32x4 zero4 = {0.f, 0.f, 0.f, 0.f};
    f16x8 bx[4], bc[4];
    { float ss = 0.0f; f32x4 c[4][2];
#pragma unroll
      for (int ks = 0; ks < 4; ++ks) { const int f0 = 32 * ks + 8 * q4;
          f32x4 x[2];
#pragma unroll
          for (int u = 0; u < 2; ++u) { const f32x4 z = *(const f32x4*)(pr + 768 + f0 + 4 * u); const f32x4 p = t ? *(const f32x4*)(pp + 768 + f0 + 4 * u) : zero4; x[u] = z + (p - z) * *(const f32x4*)(mu + 768 + f0 + 4 * u);
#pragma unroll
              for (int i = 0; i < 4; ++i) x[u][i] = (ks == 0) ? tanhf(x[u][i]) : (ks == 1) ? x[u][i] : sigm(x[u][i]); }
          bx[ks] = pack_f16x8(x[0], x[1]);
          c[ks][0] = *(const f32x4*)(pd + f0); c[ks][1] = *(const f32x4*)(pd + f0 + 4); ss += dot4(c[ks][0], c[ks][0]) + dot4(c[ks][1], c[ks][1]); }
      ss += __shfl_xor(ss, 16); ss += __shfl_xor(ss, 32);
      const float rstd = 1.0f / sqrtf(ss * (1.0f / 128.0f) + 1e-5f); const float* qn = A.in[I_QNORM] + l * 128;
#pragma unroll
      for (int ks = 0; ks < 4; ++ks) { const int f0 = 32 * ks + 8 * q4; bc[ks] = pack_f16x8(c[ks][0] * rstd * *(const f32x4*)(qn + f0), c[ks][1] * rstd * *(const f32x4*)(qn + f0 + 4)); } }
    const _Float16* wrow = SW + (size_t)tk * 0;
    (void)wrow;
    const int arow = lane & 15;
#pragma unroll 1
    for (int hd = 0; hd < 4; ++hd) {
        f32x4 fk[4], av[4]; float ssk = 0.0f;
#pragma unroll
        for (int j = 0; j < 4; ++j) { const int nb = 4 * hd + j, ch = 16 * nb + 4 * q4; const size_t o = (size_t)m * 256 + ch;
            const f16x8 aw = *(const f16x8*)(SW + SMW_W2 + (16 * nb + arow) * 32 + 8 * q4), aa = *(const f16x8*)(SW + SMW_A2 + (16 * nb + arow) * 32 + 8 * q4);
            const f16x8 ag0 = *(const f16x8*)(SW + SMW_G2 + (16 * nb + arow) * 64 + 8 * q4), ag1 = *(const f16x8*)(SW + SMW_G2 + (16 * nb + arow) * 64 + 32 + 8 * q4);
            const f32x4 cw = __builtin_amdgcn_mfma_f32_16x16x32_f16(aw, bx[0], *(const f32x4*)(A.in[I_W0] + l * 256 + ch), 0, 0, 0);
            const f32x4 ca = __builtin_amdgcn_mfma_f32_16x16x32_f16(aa, bx[1], *(const f32x4*)(A.in[I_A0] + l * 256 + ch), 0, 0, 0);
            f32x4 cg = __builtin_amdgcn_mfma_f32_16x16x32_f16(ag0, bx[2], zero4, 0, 0, 0); cg = __builtin_amdgcn_mfma_f32_16x16x32_f16(ag1, bx[3], cg, 0, 0, 0);
            f32x4 dec;
#pragma unroll
            for (int i = 0; i < 4; ++i) { dec[i] = expf(-expf(-softplusf(-cw[i]) - 0.5f)); av[j][i] = sigm(ca[i]); }
            *(f32x4*)(RWA + 1 * RWA_STRIDE + o) = dec; *(f32x4*)(RWA + 6 * RWA_STRIDE + o) = cg;
            { const f32x4 z = *(const f32x4*)(pr + 256 + ch); const f32x4 p = t ? *(const f32x4*)(pp + 256 + ch) : zero4; fk[j] = z + (p - z) * *(const f32x4*)(mu + 256 + ch); }
            const f32x4 kk = fk[j] * *(const f32x4*)(A.in[I_KK] + l * 256 + ch); ssk += dot4(kk, kk); }
        ssk += __shfl_xor(ssk, 16); ssk += __shfl_xor(ssk, 32);
        const float inrm = 1.0f / fmaxf(sqrtf(ssk), 1e-12f);
        f32x4 fr[4], km[4]; float bs = 0.0f;
#pragma unroll
        for (int j = 0; j < 4; ++j) { const int ch = 16 * (4 * hd + j) + 4 * q4;
            { const f32x4 z = *(const f32x4*)(pr + ch); const f32x4 p = t ? *(const f32x4*)(pp + ch) : zero4; fr[j] = z + (p - z) * *(const f32x4*)(mu + ch); }
            km[j] = fk[j] * (1.0f + (av[j] - 1.0f) * *(const f32x4*)(A.in[I_KA] + l * 256 + ch)); bs += dot4(fr[j] * km[j], *(const f32x4*)(A.in[I_RK] + l * 256 + ch)); }
        bs += __shfl_xor(bs, 16); bs += __shfl_xor(bs, 32);
#pragma unroll
        for (int j = 0; j < 4; ++j) { const int ch = 16 * (4 * hd + j) + 4 * q4; const size_t o = (size_t)m * 256 + ch;
            f32x4 fv; { const f32x4 z = *(const f32x4*)(pr + 512 + ch); const f32x4 p = t ? *(const f32x4*)(pp + 512 + ch) : zero4; fv = z + (p - z) * *(const f32x4*)(mu + 512 + ch); }
            const f32x4 kk = fk[j] * *(const f32x4*)(A.in[I_KK] + l * 256 + ch) * inrm;
            *(f32x4*)(RWA + 0 * RWA_STRIDE + o) = fr[j]; *(f32x4*)(RWA + 2 * RWA_STRIDE + o) = km[j]; *(f32x4*)(RWA + 3 * RWA_STRIDE + o) = fv;
            *(f32x4*)(RWA + 4 * RWA_STRIDE + o) = -kk; *(f32x4*)(RWA + 5 * RWA_STRIDE + o) = kk * av[j]; *(f32x4*)(RWA + 7 * RWA_STRIDE + o) = bs * fv; }
    }
#pragma unroll 1
    for (int nb = 0; nb < 32; ++nb) {
        f32x4 cq = zero4;
#pragma unroll
        for (int ks = 0; ks < 4; ++ks) { const f16x8 aq = *(const f16x8*)(SW + SMW_QI + (16 * nb + arow) * 128 + 32 * ks + 8 * q4); cq = __builtin_amdgcn_mfma_f32_16x16x32_f16(aq, bc[ks], cq, 0, 0, 0); }
        const int ch = 16 * (nb & 15) + 4 * q4;
        if (nb < 16) {
            if ((nb & 3) == 0) { const f32x4 ot = shx4(cq, 32); const int fi = 4 * (q4 & 1); const f32x4 cs4 = *(const f32x4*)(RT + 64 + fi), sn = *(const f32x4*)(RT + 72 + fi); cq = (q4 < 2) ? cq * cs4 - ot * sn : ot * sn + cq * cs4; }
            const f32x4 qs = cq * 0.18033688011112042f; v2u o; o.x = pk2(qs.x, qs.y); o.y = pk2(qs.z, qs.w); *(v2u*)((bf16*)(A.ws + WS_DQ) + (size_t)m * 256 + ch) = o;
        } else {
            if ((nb & 1) == 0) { const f32x4 ot = shx4(cq, 16); const f32x4 cs4 = *(const f32x4*)(RT + 80), sn = *(const f32x4*)(RT + 84); if (q4 < 2) cq = (q4 < 1) ? cq * cs4 - ot * sn : ot * sn + cq * cs4; }
            h4v hq; hq.x = (_Float16)cq.x; hq.y = (_Float16)cq.y; hq.z = (_Float16)cq.z; hq.w = (_Float16)cq.w; *(h4v*)((_Float16*)(A.ws + WS_DQI) + (size_t)m * 256 + ch) = hq;
        }
    }
#pragma unroll
    for (int j = 0; j < 4; ++j) { const int d = 16 * j + 4 * q4; f32x4 kx = *(const f32x4*)(pd + 128 + d);
        if (j == 0) { const f32x4 ot = shx4(kx, 32); const int fi = 4 * (q4 & 1); const f32x4 cs4 = *(const f32x4*)(RT + 64 + fi), sn = *(const f32x4*)(RT + 72 + fi); kx = (q4 < 2) ? kx * cs4 - ot * sn : ot * sn + kx * cs4; }
        v2u o; o.x = pk2(kx.x, kx.y); o.y = pk2(kx.z, kx.w); *(v2u*)((bf16*)(A.ws + WS_DKB) + (size_t)m * 64 + d) = o;
        const f32x4 vx = *(const f32x4*)(pd + 192 + d); v2u ov; ov.x = pk2(vx.x, vx.y); ov.y = pk2(vx.z, vx.w); *(v2u*)((bf16*)(A.ws + WS_DVB) + (size_t)m * 64 + d) = ov; }
#pragma unroll
    for (int j = 0; j < 2; ++j) { const int d = 16 * j + 4 * q4; f32x4 ki = *(const f32x4*)(pd + 256 + d);
        if (j == 0) { const f32x4 ot = shx4(ki, 16); const f32x4 cs4 = *(const f32x4*)(RT + 80), sn = *(const f32x4*)(RT + 84); if (q4 < 2) ki = (q4 < 1) ? ki * cs4 - ot * sn : ot * sn + ki * cs4; }
        h4v hk; hk.x = (_Float16)ki.x; hk.y = (_Float16)ki.y; hk.z = (_Float16)ki.z; hk.w = (_Float16)ki.w; *(h4v*)((_Float16*)(A.ws + WS_DKI) + (size_t)m * 32 + d) = hk; }
    if (q4 < 2) *(f32x4*)((float*)(A.ws + WS_DW) + (size_t)m * 8 + 4 * q4) = *(const f32x4*)(pd + 288 + 4 * q4) * 0.0625f;
}
__device__ __forceinline__ void sb_prep(ARef A, int m, int lane) {
    const float* ps = (const float*)(A.ws + WS_P) + (size_t)m * INCP + C_SB + 4 * lane;
    const f32x4 q = *(const f32x4*)ps * 0.18033688011112042f, k = *(const f32x4*)(ps + 256), v = *(const f32x4*)(ps + 512);
    v2u o; o.x = pk2(q.x, q.y); o.y = pk2(q.z, q.w); *(v2u*)((bf16*)(A.ws + WS_SQ) + (size_t)m * 256 + 4 * lane) = o;
    o.x = pk2(k.x, k.y); o.y = pk2(k.z, k.w); *(v2u*)((bf16*)(A.ws + WS_SK) + (size_t)m * 256 + 4 * lane) = o;
    o.x = pk2(v.x, v.y); o.y = pk2(v.z, v.w); *(v2u*)((bf16*)(A.ws + WS_SV) + (size_t)m * 256 + 4 * lane) = o;
}

__device__ __forceinline__ float quad_sum(float v) {
    v += __builtin_bit_cast(float, __builtin_amdgcn_mov_dpp(__builtin_bit_cast(int, v), 0xB1, 0xF, 0xF, true));
    v += __builtin_bit_cast(float, __builtin_amdgcn_mov_dpp(__builtin_bit_cast(int, v), 0x4E, 0xF, 0xF, true));
    return v;
}
__device__ __forceinline__ float oct_sum(float v) {
    v += __builtin_bit_cast(float, __builtin_amdgcn_mov_dpp(__builtin_bit_cast(int, v), 0xB1, 0xF, 0xF, true));
    v += __builtin_bit_cast(float, __builtin_amdgcn_mov_dpp(__builtin_bit_cast(int, v), 0x4E, 0xF, 0xF, true));
    v += __builtin_bit_cast(float, __builtin_amdgcn_mov_dpp(__builtin_bit_cast(int, v), 0x141, 0xF, 0xF, true));
    return v;
}
#define RW_LOAD(op, s_) do { const int lo_ = (s_) * 64 + kq * 8; \
    op[0] = *(const LAS f32x4*)(sn + lo_); op[1] = *(const LAS f32x4*)(sn + lo_ + 4); op[2] = *(const LAS f32x4*)(sw + lo_); op[3] = *(const LAS f32x4*)(sw + lo_ + 4); \
    op[4] = *(const LAS f32x4*)(sb + lo_); op[5] = *(const LAS f32x4*)(sb + lo_ + 4); op[6] = *(const LAS f32x4*)(sk + lo_); op[7] = *(const LAS f32x4*)(sk + lo_ + 4); \
    op[8] = *(const LAS f32x4*)(sr + lo_); op[9] = *(const LAS f32x4*)(sr + lo_ + 4); \
    _Pragma("unroll") for (int i_ = 0; i_ < 4; ++i_) vin[i_] = (ws < 2) ? sv[(s_) * 64 + rbase + 8 * i_] : 0.0f; } while (0)
#define RW_STEP(op, vv, s_) do { float sa_[4], y_[4]; \
    _Pragma("unroll") for (int i_ = 0; i_ < 4; ++i_) sa_[i_] = (S[i_][0] * op[0].x + S[i_][1] * op[0].y) + (S[i_][2] * op[0].z + S[i_][3] * op[0].w) + ((S[i_][4] * op[1].x + S[i_][5] * op[1].y) + (S[i_][6] * op[1].z + S[i_][7] * op[1].w)); \
    _Pragma("unroll") for (int i_ = 0; i_ < 4; ++i_) sa_[i_] += __builtin_bit_cast(float, __builtin_amdgcn_mov_dpp(__builtin_bit_cast(int, sa_[i_]), 0xB1, 0xF, 0xF, true)); \
    _Pragma("unroll") for (int i_ = 0; i_ < 4; ++i_) sa_[i_] += __builtin_bit_cast(float, __builtin_amdgcn_mov_dpp(__builtin_bit_cast(int, sa_[i_]), 0x4E, 0xF, 0xF, true)); \
    _Pragma("unroll") for (int i_ = 0; i_ < 4; ++i_) sa_[i_] += __builtin_bit_cast(float, __builtin_amdgcn_mov_dpp(__builtin_bit_cast(int, sa_[i_]), 0x141, 0xF, 0xF, true)); \
    _Pragma("unroll") for (int i_ = 0; i_ < 4; ++i_) { const float v_ = vv[i_]; \
        S[i_][0] = S[i_][0] * op[2].x + (sa_[i_] * op[4].x + v_ * op[6].x); S[i_][1] = S[i_][1] * op[2].y + (sa_[i_] * op[4].y + v_ * op[6].y); S[i_][2] = S[i_][2] * op[2].z + (sa_[i_] * op[4].z + v_ * op[6].z); S[i_][3] = S[i_][3] * op[2].w + (sa_[i_] * op[4].w + v_ * op[6].w); \
        S[i_][4] = S[i_][4] * op[3].x + (sa_[i_] * op[5].x + v_ * op[7].x); S[i_][5] = S[i_][5] * op[3].y + (sa_[i_] * op[5].y + v_ * op[7].y); S[i_][6] = S[i_][6] * op[3].z + (sa_[i_] * op[5].z + v_ * op[7].z); S[i_][7] = S[i_][7] * op[3].w + (sa_[i_] * op[5].w + v_ * op[7].w); } \
    _Pragma("unroll") for (int i_ = 0; i_ < 4; ++i_) y_[i_] = (S[i_][0] * op[8].x + S[i_][1] * op[8].y) + (S[i_][2] * op[8].z + S[i_][3] * op[8].w) + ((S[i_][4] * op[9].x + S[i_][5] * op[9].y) + (S[i_][6] * op[9].z + S[i_][7] * op[9].w)); \
    _Pragma("unroll") for (int i_ = 0; i_ < 4; ++i_) y_[i_] += __builtin_bit_cast(float, __builtin_amdgcn_mov_dpp(__builtin_bit_cast(int, y_[i_]), 0xB1, 0xF, 0xF, true)); \
    _Pragma("unroll") for (int i_ = 0; i_ < 4; ++i_) y_[i_] += __builtin_bit_cast(float, __builtin_amdgcn_mov_dpp(__builtin_bit_cast(int, y_[i_]), 0x4E, 0xF, 0xF, true)); \
    _Pragma("unroll") for (int i_ = 0; i_ < 4; ++i_) y_[i_] += __builtin_bit_cast(float, __builtin_amdgcn_mov_dpp(__builtin_bit_cast(int, y_[i_]), 0x141, 0xF, 0xF, true)); \
    if (kq == 0) { _Pragma("unroll") for (int i_ = 0; i_ < 4; ++i_) so[(s_) * 128 + rbase + 8 * i_] = y_[i_]; } } while (0)
__device__ __forceinline__ void scan_rwkv_task2(ARef A, const WI& w, int task0) {
    const int slot = w.wave >> 2, ws = w.wave & 3, lt = w.tid & 255, task = task0 + slot;
    const int bh = task >> 4, c = task & 15, b = bh >> 2, h = bh & 3;
    LAS float* sw = (LAS float*)w.lds + slot * 16384; LAS float* sn = sw + 2048; LAS float* sb = sn + 2048; LAS float* sk = sb + 2048; LAS float* sr = sk + 2048; LAS float* sv = sr + 2048; LAS float* so = sv + 2048;
    const float* RWA = (const float*)(A.ws + WS_RWA);
    const int rg = w.lane >> 3, kq = w.lane & 7, rbase = 32 * ws + rg;
    float S[4][8];
#pragma unroll
    for (int i = 0; i < 4; ++i)
#pragma unroll
        for (int j = 0; j < 8; ++j) { const int r = rbase + 8 * i; S[i][j] = (r >= 64 && 8 * kq + j == r - 64) ? 1.0f : 0.0f; }
    const size_t tok0 = (size_t)b * SEQ + (size_t)c * TCH;
    const int st = lt >> 3, sd = (lt & 7) * 8;
    f32x4 a[6][2];
#define RW_GLOAD(sub_) do { const size_t o_ = (tok0 + (sub_) * 32 + st) * 256 + h * 64 + sd; \
        _Pragma("unroll") for (int q = 0; q < 2; ++q) { a[0][q] = *(const f32x4*)(RWA + 1 * RWA_STRIDE + o_ + 4 * q); a[1][q] = *(const f32x4*)(RWA + 4 * RWA_STRIDE + o_ + 4 * q); a[2][q] = *(const f32x4*)(RWA + 5 * RWA_STRIDE + o_ + 4 * q); \
            a[3][q] = *(const f32x4*)(RWA + 2 * RWA_STRIDE + o_ + 4 * q); a[4][q] = *(const f32x4*)(RWA + 0 * RWA_STRIDE + o_ + 4 * q); a[5][q] = *(const f32x4*)(RWA + 3 * RWA_STRIDE + o_ + 4 * q); } } while (0)
    RW_GLOAD(0);
    for (int sub = 0; sub < TCH / 32; ++sub) {
        __syncthreads();
        { const int lo = st * 64 + sd;
#pragma unroll
          for (int q = 0; q < 2; ++q) { *(LAS f32x4*)(sw + lo + 4 * q) = a[0][q]; *(LAS f32x4*)(sn + lo + 4 * q) = a[1][q]; *(LAS f32x4*)(sb + lo + 4 * q) = a[2][q]; *(LAS f32x4*)(sk + lo + 4 * q) = a[3][q]; *(LAS f32x4*)(sr + lo + 4 * q) = a[4][q]; *(LAS f32x4*)(sv + lo + 4 * q) = a[5][q]; } }
        __syncthreads();
        if (sub + 1 < TCH / 32) RW_GLOAD(sub + 1);
        { f32x4 opA[10], opB[10]; float vin[4], vA[4], vB[4];
          RW_LOAD(opA, 0);
#pragma unroll
          for (int i = 0; i < 4; ++i) vA[i] = vin[i];
#pragma unroll 1
          for (int s = 0; s < 32; s += 2) {
              RW_LOAD(opB, s + 1);
#pragma unroll
              for (int i = 0; i < 4; ++i) vB[i] = vin[i];
              RW_STEP(opA, vA, s);
              if (s + 2 < 32) { RW_LOAD(opA, s + 2);
#pragma unroll
                  for (int i = 0; i < 4; ++i) vA[i] = vin[i]; }
              RW_STEP(opB, vB, s + 1);
          } }
        __syncthreads();
        { const int fs = lt >> 3, c16 = (lt & 7) * 16;
          float* dst = (c16 < 64) ? ((float*)(A.ws + WS_YO) + YO_STRIDE) : ((float*)(A.ws + WS_PT) - 64);
          float* dp = dst + (tok0 + sub * 32 + fs) * 256 + h * 64 + c16;
#pragma unroll
          for (int q = 0; q < 4; ++q) *(f32x4*)(dp + 4 * q) = *(const LAS f32x4*)(so + fs * 128 + c16 + 4 * q); }
    }
    { float* ch = (float*)(A.ws + WS_CH) + ((size_t)(bh * NCH + c) * 128) * 64 + 8 * kq;
#pragma unroll
      for (int i = 0; i < 4; ++i) { float* cr = ch + (size_t)(rbase + 8 * i) * 64; *(f32x4*)cr = (f32x4){S[i][0], S[i][1], S[i][2], S[i][3]}; *(f32x4*)(cr + 4) = (f32x4){S[i][4], S[i][5], S[i][6], S[i][7]}; } }
    __syncthreads();
}
#undef RW_LOAD
#undef RW_STEP
#undef RW_GLOAD
__device__ __forceinline__ void scan_ret_task(ARef A, const WI& w, int task) {
    const int bh = task >> 3, cp = task & 7, b = bh >> 2, h = bh & 3, un = w.tid >> 8, lt = w.tid & 255, c = 2 * cp + un;
    const float lg2g = log2f(1.0f - exp2f(-5.0f - (float)h)), gamma = exp2f(lg2g);
    LAS float* sk = (LAS float*)w.lds + un * 8192; LAS float* sq = sk + 2048; LAS float* sv = sq + 2048; LAS float* so = sv + 2048;
    const float* P = (const float*)(A.ws + WS_P); const float* RT = (const float*)(A.ws + WS_ROPE);
    const int row = lt >> 2, kq = lt & 3;
    float S[16];
#pragma unroll
    for (int j = 0; j < 16; ++j) S[j] = 0.0f;
    const size_t tok0 = (size_t)b * SEQ + (size_t)c * TCH;
    const int st = lt >> 3, sd = (lt & 7) * 8;
    const int fi = sd & 31, dp = sd ^ 32;
    f32x4 gq[2], gqo[2], gk[2], gko[2], gv[2], gcs[2], gsn[2];
#define RT_GLOAD(sub_) do { const size_t m_ = tok0 + (sub_) * 32 + st; const float* pr_ = P + m_ * INCP + C_RET + h * 64; const float* rt_ = RT + m_ * ROPE_W; \
        _Pragma("unroll") for (int u = 0; u < 2; ++u) { gcs[u] = *(const f32x4*)(rt_ + fi + 4 * u); gsn[u] = *(const f32x4*)(rt_ + 32 + fi + 4 * u); gq[u] = *(const f32x4*)(pr_ + sd + 4 * u); gqo[u] = *(const f32x4*)(pr_ + dp + 4 * u); \
            gk[u] = *(const f32x4*)(pr_ + 256 + sd + 4 * u); gko[u] = *(const f32x4*)(pr_ + 256 + dp + 4 * u); gv[u] = *(const f32x4*)(pr_ + 512 + sd + 4 * u); } } while (0)
    RT_GLOAD(0);
    for (int sub = 0; sub < TCH / 32; ++sub) {
        const size_t m = tok0 + sub * 32 + st;
        f32x4 qn[2], kn[2], vn[2];
#pragma unroll
        for (int u = 0; u < 2; ++u) { qn[u] = (sd < 32) ? gq[u] * gcs[u] - gqo[u] * gsn[u] : gqo[u] * gsn[u] + gq[u] * gcs[u]; kn[u] = ((sd < 32) ? gk[u] * gcs[u] - gko[u] * gsn[u] : gko[u] * gsn[u] + gk[u] * gcs[u]) * 0.125f; vn[u] = gv[u]; }
        { const float gt = exp2f(lg2g * (float)(sub * 32 + st + 1)); const f32x4 p0 = qn[0] * gt, p1 = qn[1] * gt;
          v4u pw; pw.x = pk2(p0.x, p0.y); pw.y = pk2(p0.z, p0.w); pw.z = pk2(p1.x, p1.y); pw.w = pk2(p1.z, p1.w); *(v4u*)((bf16*)(A.ws + WS_PTR) + m * 256 + h * 64 + sd) = pw; }
        __syncthreads();
        { const int lo = st * 64 + sd; *(LAS f32x4*)(sq + lo) = qn[0]; *(LAS f32x4*)(sq + lo + 4) = qn[1]; *(LAS f32x4*)(sk + lo) = kn[0]; *(LAS f32x4*)(sk + lo + 4) = kn[1]; *(LAS f32x4*)(sv + lo) = vn[0]; *(LAS f32x4*)(sv + lo + 4) = vn[1]; }
        __syncthreads();
        if (sub + 1 < TCH / 32) RT_GLOAD(sub + 1);
        for (int s = 0; s < 32; ++s) {
            const int lo = s * 64 + kq * 16; const float vv = sv[s * 64 + row]; float y = 0.0f;
#pragma unroll
            for (int j4 = 0; j4 < 4; ++j4) { const f32x4 kv = *(const LAS f32x4*)(sk + lo + 4 * j4), rv = *(const LAS f32x4*)(sq + lo + 4 * j4);
                S[4 * j4] = S[4 * j4] * gamma + vv * kv.x; S[4 * j4 + 1] = S[4 * j4 + 1] * gamma + vv * kv.y; S[4 * j4 + 2] = S[4 * j4 + 2] * gamma + vv * kv.z; S[4 * j4 + 3] = S[4 * j4 + 3] * gamma + vv * kv.w;
                y += (S[4 * j4] * rv.x + S[4 * j4 + 1] * rv.y) + (S[4 * j4 + 2] * rv.z + S[4 * j4 + 3] * rv.w); }
            y = quad_sum(y);
            if (kq == 0) so[s * 64 + row] = y;
        }
        __syncthreads();
        { const int fs = lt >> 3, c8 = (lt & 7) * 8; float* dp2 = (float*)(A.ws + WS_YO) + (tok0 + sub * 32 + fs) * 256 + h * 64 + c8;
          *(f32x4*)dp2 = *(const LAS f32x4*)(so + fs * 64 + c8); *(f32x4*)(dp2 + 4) = *(const LAS f32x4*)(so + fs * 64 + c8 + 4); }
    }
    { float* ch = (float*)(A.ws + WS_CHR) + ((size_t)(bh * NCH + c) * 64 + row) * 64 + 16 * kq;
#pragma unroll
      for (int j4 = 0; j4 < 4; ++j4) *(f32x4*)(ch + 4 * j4) = (f32x4){S[4 * j4], S[4 * j4 + 1], S[4 * j4 + 2], S[4 * j4 + 3]}; }
    __syncthreads();
}
#undef RT_GLOAD
__device__ __forceinline__ void prefix_chain(ARef A, const WI& w, int bh) {
    LAS float* s0 = (LAS float*)w.lds;
    const int v = w.tid >> 3, k8 = (w.tid & 7) * 8;
    const float* CH = (const float*)(A.ws + WS_CH) + (size_t)bh * NCH * 128 * 64; float* SI = (float*)(A.ws + WS_SI) + (size_t)bh * NCH * 64 * 64;
    f32x4 c0 = {0.f, 0.f, 0.f, 0.f}, c1 = {0.f, 0.f, 0.f, 0.f};
    for (int c = 0; c < NCH; ++c) {
        *(f32x4*)(SI + ((size_t)c * 64 + v) * 64 + k8) = c0; *(f32x4*)(SI + ((size_t)c * 64 + v) * 64 + k8 + 4) = c1;
        if (c == NCH - 1) break;
        __syncthreads();
        *(LAS f32x4*)(s0 + v * 68 + k8) = c0; *(LAS f32x4*)(s0 + v * 68 + k8 + 4) = c1;
        __syncthreads();
        const float* ch = CH + (size_t)c * 128 * 64;
        f32x4 n0 = *(const f32x4*)(ch + (size_t)v * 64 + k8), n1 = *(const f32x4*)(ch + (size_t)v * 64 + k8 + 4);
#pragma unroll 8
        for (int kp = 0; kp < 64; ++kp) { const float s = s0[v * 68 + kp]; const float* pr = ch + (size_t)(64 + kp) * 64 + k8; n0 += s * *(const f32x4*)pr; n1 += s * *(const f32x4*)(pr + 4); }
        c0 = n0; c1 = n1;
    }
    const int h = bh & 3; const float gT = exp2f((float)TCH * log2f(1.0f - exp2f(-5.0f - (float)h)));
    const float* CHR = (const float*)(A.ws + WS_CHR) + (size_t)bh * NCH * 64 * 64; float* SIR = (float*)(A.ws + WS_SIR) + (size_t)bh * NCH * 64 * 64;
    c0 = (f32x4){0.f, 0.f, 0.f, 0.f}; c1 = c0;
    for (int c = 0; c < NCH; ++c) {
        *(f32x4*)(SIR + ((size_t)c * 64 + v) * 64 + k8) = c0; *(f32x4*)(SIR + ((size_t)c * 64 + v) * 64 + k8 + 4) = c1;
        if (c == NCH - 1) break;
        c0 = c0 * gT + *(const f32x4*)(CHR + ((size_t)c * 64 + v) * 64 + k8); c1 = c1 * gT + *(const f32x4*)(CHR + ((size_t)c * 64 + v) * 64 + k8 + 4);
    }
    __syncthreads();
}
typedef float f32x16 __attribute__((ext_vector_type(16)));
constexpr int SBV_PITCH = 144;
__device__ __forceinline__ float lane32_swap(float v) { return __shfl_xor(v, 32); }
__device__ __forceinline__ void sb_tile_mfma(ARef A, int unit, int lane, LAS unsigned char* vl) {
    const int tq = unit & 127, bh = unit >> 7, b = bh >> 2, h = bh & 3, t0 = tq * 32, r32 = lane & 31, hi = lane >> 5;
    const float* PS = (const float*)(A.ws + WS_P) + (size_t)b * SEQ * INCP + C_SB + h * 64;
    bf16x8v qf[4];
#pragma unroll
    for (int ks = 0; ks < 4; ++ks) { const float* qp = PS + (size_t)(t0 + r32) * INCP + 16 * ks + 8 * hi; const f32x4 x = *(const f32x4*)qp * 0.18033688011112042f, y = *(const f32x4*)(qp + 4) * 0.18033688011112042f;
        pg8::u32x4 wv; wv.x = pk2(x.x, x.y); wv.y = pk2(x.z, x.w); wv.z = pk2(y.x, y.y); wv.w = pk2(y.z, y.w); qf[ks] = __builtin_bit_cast(bf16x8v, wv); }
    f32x16 o0, o1;
#pragma unroll
    for (int r = 0; r < 16; ++r) { o0[r] = 0.0f; o1[r] = 0.0f; }
    float carry = 0.0f;
    const int g16 = lane >> 4, tj = (lane & 15) >> 2, tc = lane & 3;
    for (int kb0 = t0; kb0 >= 0; kb0 -= 32) {
#pragma unroll
        for (int i = 0; i < 4; ++i) { const int p = lane + 64 * i, row = p >> 3, ch = p & 7; const float* vp = PS + 512 + (size_t)(kb0 + row) * INCP + 8 * ch; const f32x4 x = *(const f32x4*)vp, y = *(const f32x4*)(vp + 4);
            v4u v; v.x = pk2(x.x, x.y); v.y = pk2(x.z, x.w); v.z = pk2(y.x, y.y); v.w = pk2(y.z, y.w); *(LAS v4u*)(vl + row * SBV_PITCH + 16 * ch) = v; }
        f32x16 st;
#pragma unroll
        for (int r = 0; r < 16; ++r) st[r] = 0.0f;
#pragma unroll
        for (int ks = 0; ks < 4; ++ks) { const float* kp = PS + 256 + (size_t)(kb0 + r32) * INCP + 16 * ks + 8 * hi; const f32x4 x = *(const f32x4*)kp, y = *(const f32x4*)(kp + 4);
            pg8::u32x4 wv; wv.x = pk2(x.x, x.y); wv.y = pk2(x.z, x.w); wv.z = pk2(y.x, y.y); wv.w = pk2(y.z, y.w); st = __builtin_amdgcn_mfma_f32_32x32x16_bf16(__builtin_bit_cast(bf16x8v, wv), qf[ks], st, 0, 0, 0); }
        float sp[16]; const bool diag = (kb0 == t0);
#pragma unroll
        for (int r = 0; r < 16; ++r) { const float zl = st[r]; float s = (zl > 30.0f) ? zl : __builtin_amdgcn_logf(1.0f + __builtin_amdgcn_exp2f(zl));
            if (diag && ((r & 3) + 8 * (r >> 2) + 4 * hi >= r32)) s = 0.0f;
            sp[r] = s; }
        float G[4], Gp[4], suf[4];
#pragma unroll
        for (int q = 0; q < 4; ++q) { G[q] = (sp[4 * q] + sp[4 * q + 1]) + (sp[4 * q + 2] + sp[4 * q + 3]); Gp[q] = lane32_swap(G[q]); }
        suf[3] = 0.0f; suf[2] = G[3] + Gp[3]; suf[1] = suf[2] + (G[2] + Gp[2]); suf[0] = suf[1] + (G[1] + Gp[1]);
        const float tot = suf[0] + (G[0] + Gp[0]);
        pg8::u32x4 pw0, pw1;
        float av[16];
#pragma unroll
        for (int q = 0; q < 4; ++q) { float run = carry + suf[q] + (hi == 0 ? Gp[q] : 0.0f);
#pragma unroll
            for (int i = 3; i >= 0; --i) { const int r = 4 * q + i; const float la = (st[r] - sp[r]) - run; float a = __builtin_amdgcn_exp2f(la);
                if (diag && ((r & 3) + 8 * (r >> 2) + 4 * hi >= r32)) a = 0.0f;
                av[r] = a; run += sp[r]; } }
        pw0.x = pg8::cvt_pk_bf16(av[0], av[1]); pw0.y = pg8::cvt_pk_bf16(av[2], av[3]); pw0.z = pg8::cvt_pk_bf16(av[4], av[5]); pw0.w = pg8::cvt_pk_bf16(av[6], av[7]);
        pw1.x = pg8::cvt_pk_bf16(av[8], av[9]); pw1.y = pg8::cvt_pk_bf16(av[10], av[11]); pw1.z = pg8::cvt_pk_bf16(av[12], av[13]); pw1.w = pg8::cvt_pk_bf16(av[14], av[15]);
        const bf16x8v pa0 = __builtin_bit_cast(bf16x8v, pw0), pa1 = __builtin_bit_cast(bf16x8v, pw1);
        LDS_WAIT();
#pragma unroll
        for (int s = 0; s < 2; ++s)
#pragma unroll
            for (int nb = 0; nb < 2; ++nb) {
                LAS unsigned char* a1 = vl + (16 * s + 4 * (g16 >> 1) + tj) * SBV_PITCH + (32 * nb + 16 * (g16 & 1) + 4 * tc) * 2;
                const s16x4v r1 = __builtin_bit_cast(s16x4v, __builtin_amdgcn_ds_read_tr16_b64_v4i16((LAS s16x4v*)a1));
                const s16x4v r2 = __builtin_bit_cast(s16x4v, __builtin_amdgcn_ds_read_tr16_b64_v4i16((LAS s16x4v*)(a1 + 8 * SBV_PITCH)));
                const bf16x8v bv = {r1[0], r1[1], r1[2], r1[3], r2[0], r2[1], r2[2], r2[3]};
                if (nb == 0) o0 = __builtin_amdgcn_mfma_f32_32x32x16_bf16(s ? pa1 : pa0, bv, o0, 0, 0, 0); else o1 = __builtin_amdgcn_mfma_f32_32x32x16_bf16(s ? pa1 : pa0, bv, o1, 0, 0, 0); }
        LDS_WAIT();
        carry += tot;
        if (__all(carry > 150.0f)) break;
    }
    float* YS = (float*)(A.ws + WS_YO) + 3 * YO_STRIDE + ((size_t)b * SEQ + t0) * 256 + h * 64 + r32;
#pragma unroll
    for (int r = 0; r < 16; ++r) { const int qo = (r & 3) + 8 * (r >> 2) + 4 * hi; YS[(size_t)qo * 256] = o0[r]; YS[(size_t)qo * 256 + 32] = o1[r]; }
}

__device__ __forceinline__ void dsa_scores_mfma(ARef A, const WI& w) {
    const _Float16* QIH = (const _Float16*)(A.ws + WS_DQI); const _Float16* KIH = (const _Float16*)(A.ws + WS_DKI);
    const float* DW = (const float*)(A.ws + WS_DW); float* SC = (float*)(A.ws + WS_SC);
    const int col = w.lane & 15, q4 = w.lane >> 4;
    for (int u = w.gw; u < 2048; u += w.NGW) {
        const int pi = u >> 1, par = u & 1, b = pi >> 7, p = pi & 127;
#pragma unroll 1
        for (int side = 0; side < 2; ++side) {
            const int qb = side ? 255 - p : p; const size_t m0 = (size_t)b * SEQ + 16 * qb;
            f16x8 bq[8];
#pragma unroll
            for (int h = 0; h < 8; ++h) bq[h] = *(const f16x8*)(QIH + (m0 + col) * 256 + h * 32 + 8 * q4);
            const float* dw = DW + (m0 + col) * 8; const f32x4 wa = *(const f32x4*)dw, wb = *(const f32x4*)(dw + 4);
            float* srow = SC + (m0 + col) * SEQ + 4 * q4;
            const _Float16* kbase = KIH + ((size_t)b * SEQ + col) * 32 + 8 * q4;
            for (int kb = par; kb <= qb; kb += 2) {
                const f16x8 ak = *(const f16x8*)(kbase + (size_t)kb * 16 * 32);
                f32x4 acc = {0.f, 0.f, 0.f, 0.f};
#pragma unroll
                for (int h = 0; h < 8; ++h) { const f32x4 c = __builtin_amdgcn_mfma_f32_16x16x32_f16(ak, bq[h], (f32x4){0.f, 0.f, 0.f, 0.f}, 0, 0, 0); const float wv = (h < 4) ? wa[h] : wb[h - 4];
                    acc.x += wv * fmaxf(c.x, 0.f); acc.y += wv * fmaxf(c.y, 0.f); acc.z += wv * fmaxf(c.z, 0.f); acc.w += wv * fmaxf(c.w, 0.f); }
                *(f32x4*)(srow + 16 * kb) = acc + 0.0f;
            }
        }
    }
}

__device__ __forceinline__ int wave_total_i(int v) {
    v += __builtin_amdgcn_mov_dpp(v, 0xB1, 0xF, 0xF, true);
    v += __builtin_amdgcn_mov_dpp(v, 0x4E, 0xF, 0xF, true);
    v += __builtin_amdgcn_mov_dpp(v, 0x141, 0xF, 0xF, true);
    v += __builtin_amdgcn_mov_dpp(v, 0x140, 0xF, 0xF, true);
    return __builtin_amdgcn_readlane(v, 0) + __builtin_amdgcn_readlane(v, 16) + __builtin_amdgcn_readlane(v, 32) + __builtin_amdgcn_readlane(v, 48);
}
__device__ __forceinline__ unsigned score_key(float f) { const unsigned bits = __float_as_uint(f); return (bits & 0x80000000u) ? ~bits : (bits | 0x80000000u); }
constexpr int VST_PITCH = 144;
typedef unsigned short u16;
__device__ __forceinline__ void dsa_load_scores(ARef A, int m, int lane, f32x4 (&sv)[16]) {
    const int n = (m & (SEQ - 1)) + 1; const float* sc = (const float*)(A.ws + WS_SC) + (size_t)m * SEQ;
#pragma unroll
    for (int j4 = 0; j4 < 16; ++j4) sv[j4] = *(const f32x4*)(sc + ((256 * j4 < n) ? 256 * j4 : 0) + 4 * lane);
}
__device__ __forceinline__ void dsa_select(ARef A, int m, int n, int lane_in, LAS u16* slist, LAS unsigned* bk) {
    int lane = lane_in; asm volatile("" : "+v"(lane));
    if (n <= 256) {
#pragma unroll
        for (int c = 0; c < 4; ++c) { const int idx = lane + 64 * c; slist[idx] = (u16)((idx < n) ? idx : 0); }
        return;
    }
    f32x4 sv[16]; dsa_load_scores(A, m, lane, sv);
    unsigned u[64];
#pragma unroll
    for (int j4 = 0; j4 < 16; ++j4)
#pragma unroll
        for (int i = 0; i < 4; ++i) u[4 * j4 + i] = (256 * j4 + 4 * lane + i < n) ? score_key(sv[j4][i]) : 0u;
    unsigned T = 0u;
    for (int bit = 31; bit >= 16; --bit) { const unsigned cand = T | (1u << bit); int cnt = 0;
#pragma unroll
        for (int j = 0; j < 64; ++j) cnt += (u[j] >= cand) ? 1 : 0;
        if (wave_total_i(cnt) >= 256) T = cand; }
    unsigned long long bkb = 0ull; int chi = 0;
#pragma unroll
    for (int j = 0; j < 64; ++j) { bkb |= (unsigned long long)(((u[j] >> 16) == (T >> 16)) ? 1u : 0u) << j; chi += ((u[j] >> 16) > (T >> 16)) ? 1 : 0; }
    const int cb = wave_total_i(__popcll(bkb)), need = 256 - wave_total_i(chi);
    if (cb <= 64) {
        int pos = __popcll(bkb);
        { const int mine_ = pos;
#pragma unroll
          for (int d = 1; d < 64; d <<= 1) { const int y = __shfl_up(pos, d); if (lane >= d) pos += y; }
          pos -= mine_; }
#pragma unroll
        for (int j = 0; j < 64; ++j) { if ((bkb >> j) & 1ull) { bk[pos] = u[j]; ++pos; } }
        LDS_WAIT();
        const unsigned kx = (lane < cb) ? bk[lane] : 0u;
        for (int bit = 15; bit >= 0; --bit) { const unsigned cand = T | (1u << bit); if (__popcll(__ballot(kx >= cand)) >= need) T = cand; }
        LDS_WAIT();
    } else {
        for (int bit = 15; bit >= 0; --bit) { const unsigned cand = T | (1u << bit); int cnt = 0;
#pragma unroll
            for (int j = 0; j < 64; ++j) cnt += (u[j] >= cand) ? 1 : 0;
            if (wave_total_i(cnt) >= 256) T = cand; }
    }
    unsigned long long gtb = 0ull, eqb = 0ull;
#pragma unroll
    for (int j = 0; j < 64; ++j) { gtb |= (unsigned long long)((u[j] > T) ? 1u : 0u) << j; eqb |= (unsigned long long)((u[j] == T) ? 1u : 0u) << j; }
    const int tgt = wave_total_i(__popcll(gtb)), teq = wave_total_i(__popcll(eqb));
    unsigned long long selb = gtb | eqb;
    if (tgt + teq > 256) {
        const int take = 256 - tgt; int lo = 0;
        for (int bit = 11; bit >= 0; --bit) { const int cand = lo | (1 << bit); const int J4 = cand >> 8; int ni = (cand & 255) - 4 * lane; ni = ni < 0 ? 0 : (ni > 4 ? 4 : ni);
            const int jc = 4 * J4 + ni; const unsigned long long msk = (jc >= 64) ? ~0ull : ((1ull << jc) - 1ull);
            if (wave_total_i(__popcll(eqb & msk)) < take) lo = cand; }
        { const int cand = lo + 1; const int J4 = cand >> 8; int ni = (cand & 255) - 4 * lane; ni = ni < 0 ? 0 : (ni > 4 ? 4 : ni);
          const int jc = (cand >= SEQ) ? 64 : 4 * J4 + ni; const unsigned long long msk = (jc >= 64) ? ~0ull : ((1ull << jc) - 1ull); selb = gtb | (eqb & msk); }
    }
    const int mine = __popcll(selb); int off = mine;
#pragma unroll
    for (int d = 1; d < 64; d <<= 1) { const int y = __shfl_up(off, d); if (lane >= d) off += y; }
    off -= mine;
    while (selb) { const int j = __builtin_ctzll(selb); selb &= selb - 1ull; slist[off] = (u16)(256 * (j >> 2) + 4 * lane + (j & 3)); ++off; }
}
__device__ __forceinline__ void dsa_attend(ARef A, int m, int lane_in, const LAS u16* slist, LAS unsigned char* vbuf) {
    int lane = lane_in; asm volatile("" : "+v"(lane));
    const int b = m >> 12, t = m & (SEQ - 1), n = t + 1, nsel = n < 256 ? n : 256, col = lane & 15, q4 = lane >> 4;
    const bf16* DKB = (const bf16*)(A.ws + WS_DKB) + (size_t)b * SEQ * 64; const bf16* DVB = (const bf16*)(A.ws + WS_DVB) + (size_t)b * SEQ * 64;
    const int vrow = lane >> 3, vpc = lane & 7;
    bf16x8v bq0 = {0, 0, 0, 0, 0, 0, 0, 0}, bq1 = {0, 0, 0, 0, 0, 0, 0, 0};
    if (col < 4) { const bf16* qp = (const bf16*)(A.ws + WS_DQ) + (size_t)m * 256 + col * 64 + 8 * q4; bq0 = *(const bf16x8v*)qp; bq1 = *(const bf16x8v*)(qp + 32); }
    f32x4 lg[16];
#pragma unroll
    for (int hb = 0; hb < 4; ++hb) {
        bf16x8v a0[4], a1[4];
#pragma unroll
        for (int k = 0; k < 4; ++k) { const int s = slist[16 * (4 * hb + k) + col]; const bf16* kr = DKB + (size_t)s * 64 + 8 * q4; a0[k] = *(const bf16x8v*)kr; a1[k] = *(const bf16x8v*)(kr + 32); }
#pragma unroll
        for (int k = 0; k < 4; ++k) { const f32x4 c = __builtin_amdgcn_mfma_f32_16x16x32_bf16(a0[k], bq0, (f32x4){0.f, 0.f, 0.f, 0.f}, 0, 0, 0); lg[4 * hb + k] = __builtin_amdgcn_mfma_f32_16x16x32_bf16(a1[k], bq1, c, 0, 0, 0); }
        __builtin_amdgcn_sched_barrier(0);
    }
    if (nsel < 256) {
#pragma unroll
        for (int kb = 0; kb < 16; ++kb)
#pragma unroll
            for (int r = 0; r < 4; ++r) if (16 * kb + 4 * q4 + r >= nsel) lg[kb][r] = -INFINITY; }
    v4u vr[4];
#pragma unroll
    for (int i = 0; i < 4; ++i) { const int s = slist[vrow + 8 * i]; vr[i] = *(const v4u*)(DVB + (size_t)s * 64 + 8 * vpc); }
    float mx = -INFINITY;
#pragma unroll
    for (int kb = 0; kb < 16; ++kb) mx = fmaxf(fmaxf(mx, fmaxf(lg[kb].x, lg[kb].y)), fmaxf(lg[kb].z, lg[kb].w));
    mx = fmaxf(mx, __shfl_xor(mx, 16)); mx = fmaxf(mx, __shfl_xor(mx, 32));
    float sm = 0.f;
#pragma unroll
    for (int kb = 0; kb < 16; ++kb) { lg[kb].x = __builtin_amdgcn_exp2f(lg[kb].x - mx); lg[kb].y = __builtin_amdgcn_exp2f(lg[kb].y - mx); lg[kb].z = __builtin_amdgcn_exp2f(lg[kb].z - mx); lg[kb].w = __builtin_amdgcn_exp2f(lg[kb].w - mx); sm += (lg[kb].x + lg[kb].y) + (lg[kb].z + lg[kb].w); }
    sm += __shfl_xor(sm, 16); sm += __shfl_xor(sm, 32);
    const float inv = 1.0f / sm;
    bf16x8v pa[8];
#pragma unroll
    for (int i = 0; i < 8; ++i) { const f32x4 x = lg[2 * i] * inv, y = lg[2 * i + 1] * inv;
        pg8::u32x4 wv; wv.x = pg8::cvt_pk_bf16(x.x, x.y); wv.y = pg8::cvt_pk_bf16(x.z, x.w); wv.z = pg8::cvt_pk_bf16(y.x, y.y); wv.w = pg8::cvt_pk_bf16(y.z, y.w);
        pa[i] = __builtin_bit_cast(bf16x8v, wv); }
    f32x4 o[4];
#pragma unroll
    for (int nb = 0; nb < 4; ++nb) o[nb] = (f32x4){0.f, 0.f, 0.f, 0.f};
    const int tj = col >> 2, tc = col & 3;
#pragma unroll
    for (int c = 0; c < 8; ++c) {
        LAS unsigned char* vb = vbuf + (c & 1) * (32 * VST_PITCH);
#pragma unroll
        for (int i = 0; i < 4; ++i) *(LAS v4u*)(vb + (vrow + 8 * i) * VST_PITCH + 16 * vpc) = vr[i];
        if (c < 7) {
#pragma unroll
            for (int i = 0; i < 4; ++i) { const int s = slist[32 * (c + 1) + vrow + 8 * i]; vr[i] = *(const v4u*)(DVB + (size_t)s * 64 + 8 * vpc); } }
        LDS_WAIT();
#pragma unroll
        for (int nb = 0; nb < 4; ++nb) {
            LAS unsigned char* a1 = vb + (4 * q4 + tj) * VST_PITCH + (16 * nb + 4 * tc) * 2;
            const s16x4v r1 = __builtin_bit_cast(s16x4v, __builtin_amdgcn_ds_read_tr16_b64_v4i16((LAS s16x4v*)a1));
            const s16x4v r2 = __builtin_bit_cast(s16x4v, __builtin_amdgcn_ds_read_tr16_b64_v4i16((LAS s16x4v*)(a1 + 16 * VST_PITCH)));
            const bf16x8v bv = {r1[0], r1[1], r1[2], r1[3], r2[0], r2[1], r2[2], r2[3]};
            o[nb] = __builtin_amdgcn_mfma_f32_16x16x32_bf16(pa[c], bv, o[nb], 0, 0, 0); }
    }
    LDS_WAIT();
    if (lane < 16) { float* YD = (float*)(A.ws + WS_YO) + 2 * YO_STRIDE + (size_t)m * 256;
#pragma unroll
        for (int nb = 0; nb < 4; ++nb) { YD[16 * nb + lane] = o[nb].x; YD[64 + 16 * nb + lane] = o[nb].y; YD[128 + 16 * nb + lane] = o[nb].z; YD[192 + 16 * nb + lane] = o[nb].w; } }
}
__device__ __forceinline__ int dsa_row_of(int i) { return (i & 1) ? (MTOK - 1 - (i >> 1)) : (i >> 1); }
__device__ __forceinline__ void dsa_wave(ARef A, const WI& w, LAS unsigned char* wl, int l) {
    LAS u16* lists = (LAS u16*)wl; LAS unsigned char* vbuf = wl + 4096; LAS unsigned* bk = (LAS unsigned*)vbuf;
    unsigned* head = (unsigned*)(A.ws + WS_CTL) + CW_DSAQ + 64 * l;
    for (;;) {
        int g = 0; if (w.lane == 0) g = (int)atomicAdd(head, 1u);
        g = __builtin_amdgcn_readfirstlane(g);
        if (g >= MTOK / 8) break;
#pragma unroll 1
        for (int r = 0; r < 8; ++r) { const int m = dsa_row_of(g + r * (MTOK / 8)), n = (m & (SEQ - 1)) + 1; dsa_select(A, m, n, w.lane, lists + r * 256, bk); }
        LDS_WAIT();
#pragma unroll 1
        for (int r = 0; r < 8; ++r) dsa_attend(A, dsa_row_of(g + r * (MTOK / 8)), w.lane, lists + r * 256, vbuf);
    }
}

__device__ __forceinline__ f32x4 head_norm4(f32x4 y, float eps, f32x4 g) {
    const float mean = grp16_sum(sum4(y)) * (1.0f / 64.0f); const f32x4 yc = y - mean;
    const float var = grp16_sum(dot4(yc, yc)) * (1.0f / 64.0f); return yc * (1.0f / sqrtf(var + eps)) * g;
}
template <bool BF> __device__ __forceinline__ f32x4 state_corr(const LAS float* sl, int hh, int r16, const void* pv) {
    const LAS float* r0 = sl + (hh * 64 + 4 * r16) * 64; const int x0 = (4 * r16) & 15;
    f32x4 out = {0.f, 0.f, 0.f, 0.f};
#pragma unroll 2
    for (int k8 = 0; k8 < 8; ++k8) {
        f32x4 pa, pb;
        if (BF) { const v4u x = ((const v4u*)pv)[k8]; pa = (f32x4){bf_lo(x.x), bf_hi(x.x), bf_lo(x.y), bf_hi(x.y)}; pb = (f32x4){bf_lo(x.z), bf_hi(x.z), bf_lo(x.w), bf_hi(x.w)}; }
        else { pa = ((const f32x4*)pv)[2 * k8]; pb = ((const f32x4*)pv)[2 * k8 + 1]; }
#pragma unroll
        for (int i = 0; i < 4; ++i) { const LAS float* rowp = r0 + i * 64; const int xs = (x0 + i) & 15;
            out[i] += dot4(*(const LAS f32x4*)(rowp + 4 * ((2 * k8) ^ xs)), pa) + dot4(*(const LAS f32x4*)(rowp + 4 * ((2 * k8 + 1) ^ xs)), pb); }
    }
    return out;
}
__device__ __forceinline__ void post_row(ARef A, int l, int m, int lane, const LAS float* slw, const LAS float* slr) {
    const float* P = (const float*)(A.ws + WS_P); const float* YO = (const float*)(A.ws + WS_YO); const float* RWA = (const float*)(A.ws + WS_RWA);
    bf16* MX = (bf16*)(A.ws + WS_MIX) + (size_t)m * DM; const int c4 = 4 * lane, hh = lane >> 4, r16 = lane & 15; const size_t o = (size_t)m * 256 + c4;
    { f32x4 y = *(const f32x4*)(YO + o) + state_corr<true>(slr, hh, r16, (const bf16*)(A.ws + WS_PTR) + (size_t)m * 256 + hh * 64);
      y = head_norm4(y, 1e-5f, *(const f32x4*)(A.in[I_RETGN] + l * 256 + c4));
      const f32x4 g = *(const f32x4*)(P + (size_t)m * INCP + C_RET + 768 + c4);
#pragma unroll
      for (int i = 0; i < 4; ++i) y[i] *= g[i] * sigm(g[i]);
      v2u w; w.x = pk2(y.x, y.y); w.y = pk2(y.z, y.w); *(v2u*)(MX + c4) = w; }
    { f32x4 y = *(const f32x4*)(YO + YO_STRIDE + o) + state_corr<false>(slw, hh, r16, (const float*)(A.ws + WS_PT) + (size_t)m * 256 + hh * 64);
      y = head_norm4(y, 64e-5f, *(const f32x4*)(A.in[I_LN] + l * 256 + c4));
      y = (y + *(const f32x4*)(RWA + 7 * RWA_STRIDE + o)) * *(const f32x4*)(RWA + 6 * RWA_STRIDE + o);
      v2u w; w.x = pk2(y.x, y.y); w.y = pk2(y.z, y.w); *(v2u*)(MX + 256 + c4) = w; }
    { f32x4 y = *(const f32x4*)(YO + 2 * YO_STRIDE + o); const float r = 1.0f / sqrtf(wave_sum(dot4(y, y)) * (1.0f / 256.0f) + 1e-5f);
      y = y * r * *(const f32x4*)(A.in[I_DONORM] + l * 256 + c4);
      v2u w; w.x = pk2(y.x, y.y); w.y = pk2(y.z, y.w); *(v2u*)(MX + 512 + c4) = w; }
    { f32x4 y = *(const f32x4*)(YO + 3 * YO_STRIDE + o); const float r = 1.0f / sqrtf(wave_sum(dot4(y, y)) * (1.0f / 256.0f) + 1e-5f);
      y = y * r * *(const f32x4*)(A.in[I_SONORM] + l * 256 + c4);
      v2u w; w.x = pk2(y.x, y.y); w.y = pk2(y.z, y.w); *(v2u*)(MX + 768 + c4) = w; }
}
__device__ __forceinline__ void ph_post(ARef A, const WI& w, int l) {
    LAS float* slw = (LAS float*)w.lds; LAS float* slr = slw + 16384;
    for (int u = w.vcu; u < NB * NCH * 2; u += w.G) {
        const int b = u >> 5, c = (u >> 1) & 15, half = u & 1;
        __syncthreads();
        for (int e = w.tid; e < 4096; e += NWAVES * 64) { const int hh = e >> 10, v = (e >> 4) & 63, k4 = e & 15;
            const size_t src = ((size_t)((b * 4 + hh) * NCH + c) * 64 + v) * 64 + 4 * k4; const int dst = (hh * 64 + v) * 64 + 4 * (k4 ^ (v & 15));
            *(LAS f32x4*)(slw + dst) = *(const f32x4*)((const float*)(A.ws + WS_SI) + src); *(LAS f32x4*)(slr + dst) = *(const f32x4*)((const float*)(A.ws + WS_SIR) + src); }
        __syncthreads();
        const int tok0 = b * SEQ + c * TCH + half * 128 + w.wave * 16;
        for (int i = 0; i < 16; ++i) post_row(A, l, tok0 + i, w.lane, slw, slr);
    }
}

__device__ __forceinline__ float wave_max_f(float v) {
    v = fmaxf(v, __builtin_bit_cast(float, __builtin_amdgcn_mov_dpp(__builtin_bit_cast(int, v), 0xB1, 0xF, 0xF, true)));
    v = fmaxf(v, __builtin_bit_cast(float, __builtin_amdgcn_mov_dpp(__builtin_bit_cast(int, v), 0x4E, 0xF, 0xF, true)));
    v = fmaxf(v, __builtin_bit_cast(float, __builtin_amdgcn_mov_dpp(__builtin_bit_cast(int, v), 0x141, 0xF, 0xF, true)));
    v = fmaxf(v, __builtin_bit_cast(float, __builtin_amdgcn_mov_dpp(__builtin_bit_cast(int, v), 0x140, 0xF, 0xF, true)));
    const int iv = __builtin_bit_cast(int, v);
    return fmaxf(fmaxf(__builtin_bit_cast(float, __builtin_amdgcn_readlane(iv, 0)), __builtin_bit_cast(float, __builtin_amdgcn_readlane(iv, 16))), fmaxf(__builtin_bit_cast(float, __builtin_amdgcn_readlane(iv, 32)), __builtin_bit_cast(float, __builtin_amdgcn_readlane(iv, 48))));
}
__device__ __forceinline__ void router_stage(ARef A, const WI& w, int l) {
    LAS float* rwl = (LAS float*)w.lds; const float* rw = A.in[I_RW] + (size_t)l * DM * 32;
    for (int e = w.tid; e < DM * 8; e += NWAVES * 64) { const int k = e >> 3, c = e & 7; *(LAS f32x4*)(rwl + k * 32 + 4 * (c ^ ((k >> 2) & 7))) = *(const f32x4*)(rw + (size_t)k * 32 + 4 * c); }
    __syncthreads();
}
__device__ __forceinline__ void router_row(ARef A, int l, int m, int lane, LAS unsigned* hist, const LAS float* rwl, bool dry = false) {
    const float* XA = (const float*)(A.ws + WS_XA) + (size_t)m * DM; const float* MOD = (const float*)(A.ws + WS_MOD) + (size_t)(l * 8 + (m >> 12)) * 6144;
    f32x4 v[4]; float ss = 0.0f;
#pragma unroll
    for (int j = 0; j < 4; ++j) { v[j] = *(const f32x4*)(XA + 4 * (lane + 64 * j)); ss += dot4(v[j], v[j]); }
    ss = wave_sum(ss); const float rstd = 1.0f / sqrtf(ss * (1.0f / DM) + 1e-5f);
    const float* g = A.in[I_NFFN] + l * DM; const float* scp = MOD + 4 * 1024; const float* shp = MOD + 3 * 1024;
    emit_h_row(v, rstd, g, scp, shp, (bf16*)(A.ws + WS_H) + (size_t)m * DM, lane);
    float p[32];
#pragma unroll
    for (int e = 0; e < 32; ++e) p[e] = 0.0f;
    const int sw = lane & 7;
#pragma unroll 1
    for (int j = 0; j < 4; ++j) { const int k = 4 * (lane + 64 * j);
        const f32x4 h = *(const f32x4*)(XA + k) * rstd * *(const f32x4*)(g + k) * (1.0f + *(const f32x4*)(scp + k)) + *(const f32x4*)(shp + k);
        const LAS float* row = rwl + k * 32;
#pragma unroll
        for (int i = 0; i < 4; ++i) {
#pragma unroll
            for (int q4 = 0; q4 < 8; ++q4) { const f32x4 r = *(const LAS f32x4*)(row + i * 32 + 4 * (q4 ^ sw)); p[4 * q4] += h[i] * r.x; p[4 * q4 + 1] += h[i] * r.y; p[4 * q4 + 2] += h[i] * r.z; p[4 * q4 + 3] += h[i] * r.w; } } }
    float q16[16], q8[8], q4v[4], q2[2], q1;
    { const bool hb = (lane & 32) != 0;
#pragma unroll
      for (int i = 0; i < 16; ++i) { const float mine = hb ? p[16 + i] : p[i], oth = hb ? p[i] : p[16 + i]; q16[i] = mine + __shfl_xor(oth, 32); } }
    { const bool hb = (lane & 16) != 0;
#pragma unroll
      for (int i = 0; i < 8; ++i) { const float mine = hb ? q16[8 + i] : q16[i], oth = hb ? q16[i] : q16[8 + i]; q8[i] = mine + __shfl_xor(oth, 16); } }
    { const bool hb = (lane & 8) != 0;
#pragma unroll
      for (int i = 0; i < 4; ++i) { const float mine = hb ? q8[4 + i] : q8[i], oth = hb ? q8[i] : q8[4 + i]; q4v[i] = mine + __shfl_xor(oth, 8); } }
    { const bool hb = (lane & 4) != 0;
#pragma unroll
      for (int i = 0; i < 2; ++i) { const float mine = hb ? q4v[2 + i] : q4v[i], oth = hb ? q4v[i] : q4v[2 + i]; q2[i] = mine + __shfl_xor(oth, 4); } }
    { const bool hb = (lane & 2) != 0; const float mine = hb ? q2[1] : q2[0], oth = hb ? q2[0] : q2[1]; q1 = mine + __shfl_xor(oth, 2); }
    q1 += __shfl_xor(q1, 1);
    float lv = q1 + A.in[I_RB][l * 32 + (lane >> 1)];
    float tv[4]; int ti[4];
#pragma unroll
    for (int kk = 0; kk < 4; ++kk) { const float mx = wave_max_f(lv); const unsigned long long msk = __ballot(lv == mx); const int e = msk ? (int)(__builtin_ctzll(msk) >> 1) : kk;
        tv[kk] = mx; ti[kk] = e; if ((lane >> 1) == e) lv = -INFINITY; }
    const float e1 = expf(tv[1] - tv[0]), e2 = expf(tv[2] - tv[0]), e3 = expf(tv[3] - tv[0]); const float inv = 1.0f / (1.0f + e1 + e2 + e3);
    if (lane == 0 && !dry) {
        int* TI = (int*)(A.ws + WS_TOPI) + (size_t)m * 4; float* TW = (float*)(A.ws + WS_TOPW) + (size_t)m * 4;
        TI[0] = ti[0]; TI[1] = ti[1]; TI[2] = ti[2]; TI[3] = ti[3]; TW[0] = inv; TW[1] = e1 * inv; TW[2] = e2 * inv; TW[3] = e3 * inv;
        { unsigned* hg = (unsigned*)hist; atomicAdd(hg + ti[0], 1u); atomicAdd(hg + ti[1], 1u); atomicAdd(hg + ti[2], 1u); atomicAdd(hg + ti[3], 1u); }
    }
}
__device__ __forceinline__ void build_expert_table(ARef A, const WI& w, int l) {
    LAS int* tst = (LAS int*)(w.lds + TST_OFF); LAS int* tab = (LAS int*)(w.lds + TAB_OFF); LAS int* base = (LAS int*)(w.lds + BASE_OFF); LAS int* part = (LAS int*)w.lds;
    const unsigned* bc = (const unsigned*)(A.ws + WS_CTL) + CW_BLKCNT + (size_t)l * 256 * 32;
    { const int e = w.tid & 31, pq = w.tid >> 5; int s = 0, sb = 0;
      for (int i = 0; i < 16; ++i) { const int g = pq * 16 + i; if (g < w.G) { const int c = (int)__hip_atomic_load(bc + g * 32 + e, RLX_AGENT); s += c; sb += (g < w.vcu) ? c : 0; } }
      part[pq * 32 + e] = s; part[512 + pq * 32 + e] = sb; }
    __syncthreads();
    if (w.tid < 32) { int s = 0, sb = 0; for (int pq = 0; pq < 16; ++pq) { s += part[pq * 32 + w.tid]; sb += part[512 + pq * 32 + w.tid]; } part[1024 + w.tid] = s; base[w.tid] = sb; }
    __syncthreads();
    if (w.tid == 0) { int acc = 0; for (int e = 0; e < 32; ++e) { tst[e] = acc; acc += (part[1024 + e] + 255) >> 8; } tst[32] = acc; tab[0] = acc; }
    __syncthreads();
    if (w.tid < 32) { const int e = w.tid; for (int pm = tst[e]; pm < tst[e + 1]; ++pm) tab[1 + pm] = e; }
    __syncthreads();
}
__device__ __forceinline__ void scatter_row(ARef A, const WI& w, int l, int m, bool dry = false) {
    const LAS int* tst = (const LAS int*)(w.lds + TST_OFF); const LAS int* base = (const LAS int*)(w.lds + BASE_OFF); LAS unsigned* cur = (LAS unsigned*)(w.lds + HIST_OFF);
    int pos = 0;
    if (dry) { if (w.lane < 4) pos = ((const int*)(A.ws + WS_POS))[(size_t)m * 4 + w.lane]; }
    else if (w.lane < 4) { const int e = ((const int*)(A.ws + WS_TOPI))[(size_t)m * 4 + w.lane];
        const unsigned slot = atomicAdd((unsigned*)cur + e, 1u);
        pos = tst[e] * 256 + base[e] + (int)slot; ((int*)(A.ws + WS_POS))[(size_t)m * 4 + w.lane] = pos; }
    const v4u* src = (const v4u*)((const bf16*)(A.ws + WS_H) + (size_t)m * DM);
    const v4u a = src[w.lane], b = src[64 + w.lane];
#pragma unroll
    for (int k = 0; k < 4; ++k) { const int pk = __shfl(pos, k); v4u* dst = (v4u*)((bf16*)(A.ws + WS_XS) + (size_t)pk * DM); dst[w.lane] = a; dst[64 + w.lane] = b; }
}
__device__ __forceinline__ void combine_row(ARef A, int l, int m, int lane, float gscale = 1.0f, float oscale = 1.0f) {
    float* XA = (float*)(A.ws + WS_XA) + (size_t)m * DM; const float* MOD = (const float*)(A.ws + WS_MOD) + (size_t)(l * 8 + (m >> 12)) * 6144;
    const int* PS = (const int*)(A.ws + WS_POS) + (size_t)m * 4; const float* TW = (const float*)(A.ws + WS_TOPW) + (size_t)m * 4;
    const bf16* YS = (const bf16*)(A.ws + WS_XS);
    f32x4 v[4], acc[4];
#pragma unroll
    for (int j = 0; j < 4; ++j) { v[j] = *(const f32x4*)(XA + 4 * (lane + 64 * j)); acc[j] = (f32x4){0.f, 0.f, 0.f, 0.f}; }
#pragma unroll
    for (int k = 0; k < 4; ++k) { const int pos = PS[k]; const float gt = TW[k] * gscale; const v2u* yr = (const v2u*)(YS + (size_t)pos * DM);
#pragma unroll
        for (int j = 0; j < 4; ++j) { const v2u y = yr[lane + 64 * j]; acc[j] += gt * (f32x4){bf_lo(y.x), bf_hi(y.x), bf_lo(y.y), bf_hi(y.y)}; } }
    float ss = 0.0f;
#pragma unroll
    for (int j = 0; j < 4; ++j) { const int kx = 4 * (lane + 64 * j); v[j] += *(const f32x4*)(MOD + 5 * 1024 + kx) * acc[j]; ss += dot4(v[j], v[j]); }
    ss = wave_sum(ss); const float rstd = 1.0f / sqrtf(ss * (1.0f / DM) + 1e-5f);
    if (l + 1 < NLAYER) {
#pragma unroll
        for (int j = 0; j < 4; ++j) *(f32x4*)(XA + 4 * (lane + 64 * j)) = v[j];
        const float* mb = MOD + 8 * 6144;
        emit_h_row(v, rstd, A.in[I_NMIX] + (l + 1) * DM, mb + 1024, mb, (bf16*)(A.ws + WS_H) + (size_t)m * DM, lane);
    } else {
        float* orow = A.out + (size_t)m * DM; const float* gf = A.in[I_NFINAL];
#pragma unroll
        for (int j = 0; j < 4; ++j) { const int kx = 4 * (lane + 64 * j); *(f32x4*)(orow + kx) = v[j] * (rstd * oscale) * *(const f32x4*)(gf + kx); }
    }
}

constexpr int N_LAUNCHES = MK_N_LAUNCHES;
template <int SEL> __global__ void __launch_bounds__(NWAVES * 64, 2) fwd(ArgsH Ah) {
    extern __shared__ __attribute__((aligned(16))) unsigned char lds[];
    (void)Ah;
    const int wave_s = __builtin_amdgcn_readfirstlane((int)threadIdx.x >> 6);
    auto tid_now = [&]() -> int { int ws_ = wave_s; unsigned z_ = 0u; asm volatile("" : "+s"(ws_), "+s"(z_)); return ws_ * 64 + (int)__builtin_amdgcn_mbcnt_hi(~0u, __builtin_amdgcn_mbcnt_lo(~0u, z_)); };
#define TID_NOW() tid_now()
#define MAKE_WI() WI w; { int tz = TID_NOW(); asm volatile("" : "+v"(tz)); int bz = blockIdx.x, gz = gridDim.x; asm volatile("" : "+s"(bz), "+s"(gz)); \
        w.lds = (LAS unsigned char*)lds; w.tid = tz; w.lane = tz & 63; w.wave = __builtin_amdgcn_readfirstlane(tz >> 6); w.G = gz; w.bx = bz; w.vcu = (gz % 8 == 0) ? (bz % 8) * (gz / 8) + bz / 8 : bz; \
        w.gw = w.vcu * NWAVES + w.wave; w.NGW = gz * NWAVES; }
    { const int t0 = threadIdx.x; for (int u = t0; u < (LDS_BYTES - RING_BYTES) / 4; u += NWAVES * 64) ((LAS unsigned*)((LAS unsigned char*)lds + RING_BYTES))[u] = 0u; }
    __syncthreads();
    int lo, hi; { ARef A0 = *kargs(); lo = A0.ph_lo; hi = A0.ph_hi; }
    if (N_LAUNCHES == 1) { ARef A0 = *kargs(); (void)xcd_barrier_post((unsigned*)((gu32*)(A0.ws + WS_CTL) + CW_BAR), (volatile LAS unsigned*)((LAS unsigned char*)lds + MISC_OFF) + 8, TID_NOW()); }
#define GRID_BAR() do { if (N_LAUNCHES == 1) { ARef Ab = *kargs(); XcdBarrier bar_; bar_.bar = (unsigned*)((gu32*)(Ab.ws + WS_CTL) + CW_BAR); bar_.x = xb_xcc_id(); bar_.st = (volatile LAS unsigned*)((LAS unsigned char*)lds + MISC_OFF) + 8; xcd_barrier(bar_, TID_NOW()); } } while (0)
#ifndef TPROBE
#define TPROBE 0
#endif
#if TPROBE
    unsigned long long tp_acc = 0ull;
#define TP_SCALE tp_scale_of(__hip_atomic_load((unsigned*)(A.ws + WS_CTL) + 3, RLX_AGENT))
    auto tp_scale_of = [](unsigned ticks) -> float { const float us = (float)ticks * 0.01f; if (us < 1.0f) return 1.0f; const float q = exp2f(rintf(log2f(us) * 8.0f) * 0.125f); return 1.0f + sqrtf(q * 1e-5f); };
#define TP_BEGIN(kind) unsigned long long tp_t0 = 0ull; if ((kind) == TPROBE) tp_t0 = __builtin_amdgcn_s_memrealtime();
#define TP_END(kind) if ((kind) == TPROBE) { tp_acc += __builtin_amdgcn_s_memrealtime() - tp_t0; }
#define TP_PUBLISH(l) if ((l) == 1 && w.vcu == 0 && w.tid == 0) __hip_atomic_store((unsigned*)(A.ws + WS_CTL) + 3, (unsigned)tp_acc, RLX_AGENT);
#else
#define TP_SCALE 1.0f
#define TP_PUBLISH(l)
#define TP_BEGIN(kind)
#define TP_END(kind)
#endif
#define IN(k) (lo <= (k) && (k) < hi)
#ifndef PHMASK
#define PHMASK 0xffffffffu
#endif
#define KON(k) if constexpr ((SEL < 0 && ((PHMASK >> (k)) & 1u)) || SEL == (k))
#define BOTH(k) (IN(k) && IN((k) + 1))
#ifndef PROBE_REP
#define PROBE_REP 0
#endif
#if PROBE_REP
    int nrep_ = 2; asm volatile("" : "+s"(nrep_));
#define REP(bit) _Pragma("unroll 1") for (int rep_ = 0; rep_ < (((PROBE_REP >> (bit)) & 1) ? nrep_ : 1); ++rep_)
#else
#define REP(bit) for (int rep_ = 0; rep_ < 1; ++rep_)
#endif
#define ring ((PG8_LAS unsigned char*)lds)

    KON(0) if (IN(0)) { ARef A = *kargs(); MAKE_WI(); REP(0) ph_prologue(A, w); if (BOTH(0)) GRID_BAR(); }

#define LAYER_BODY(l) do {\
        const int pb = 1 + l * NPL; \
        KON(1) if (IN(pb + 0)) { ARef A = *kargs(); MAKE_WI(); TP_BEGIN(1) if (l == 0) { ph_norm1(A, w); small_weights_to_f16(A, w); } if (BOTH(pb + 0)) GRID_BAR(); TP_END(1) } \
        KON(2) if (IN(pb + 1)) { ARef A = *kargs(); MAKE_WI(); TP_BEGIN(2) \
            pg8::Gemm g{(const bf16*)(A.ws + WS_H), (const bf16*)(A.ws + WS_WIN) + (size_t)l * INCP * DM, MTOK, INCP, DM}; pg8::StaticOrder S; S.init(MTOK, INCP, w.G, w.bx); \
            pg8::EpiF32 E{(float*)(A.ws + WS_P), INCP}; \
            REP(1) pg8::gemm_phase<pg8::EpiF32, pg8::StaticOrder, true, true>(ring, g, S, E, w.tid); \
            if (BOTH(pb + 1)) GRID_BAR(); TP_END(2) \
        } \
        KON(3) if (IN(pb + 2)) { ARef A = *kargs(); MAKE_WI(); TP_BEGIN(3) \
            REP(2) { for (int g = w.gw; g < MTOK / 16; g += w.NGW) prep16(A, l, 16 * g, w.lane); } \
            if (BOTH(pb + 2)) GRID_BAR(); TP_END(3) \
        } \
        KON(4) if (IN(pb + 3)) { ARef A = *kargs(); MAKE_WI(); TP_BEGIN(4) \
            REP(3) { for (int tk = 2 * w.vcu; tk < 32 * NCH; tk += 2 * w.G) scan_rwkv_task2(A, w, tk); } \
            REP(13) { for (int tk = w.vcu; tk < 32 * NCH / 2; tk += w.G) scan_ret_task(A, w, tk); } \
            REP(4) { LAS unsigned char* vl = w.lds + w.wave * 4608; for (int it = w.gw; it < 32 * 128; it += w.NGW) sb_tile_mfma(A, it, w.lane, vl); } \
            REP(5) dsa_scores_mfma(A, w); \
            if (BOTH(pb + 3)) GRID_BAR(); TP_END(4) \
        } \
        KON(5) if (IN(pb + 4)) { ARef A = *kargs(); MAKE_WI(); TP_BEGIN(5) \
            if (w.vcu < 32) prefix_chain(A, w, w.vcu); \
            dsa_wave(A, w, w.lds + w.wave * 13312, l); \
            if (BOTH(pb + 4)) GRID_BAR(); TP_END(5) \
        } \
        KON(6) if (IN(pb + 5)) { ARef A = *kargs(); MAKE_WI(); TP_BEGIN(6) \
            REP(7) ph_post(A, w, l); \
            if (BOTH(pb + 5)) GRID_BAR(); TP_END(6) \
        } \
        KON(7) if (IN(pb + 6)) { ARef A = *kargs(); MAKE_WI(); TP_BEGIN(7) \
            pg8::Gemm g{(const bf16*)(A.ws + WS_MIX), (const bf16*)(A.ws + WS_WOUT) + (size_t)l * DM * DM, MTOK, DM, DM}; pg8::StaticOrder S; S.init(MTOK, DM, w.G, w.bx); \
            pg8::EpiRes E{l == 0 ? A.in[I_X] : (const float*)(A.ws + WS_XA), (float*)(A.ws + WS_XA), (const float*)(A.ws + WS_MOD) + (size_t)l * 8 * 6144 + 2 * 1024}; \
            pg8::gemm_phase<pg8::EpiRes, pg8::StaticOrder, true, true>(ring, g, S, E, w.tid); \
            if (BOTH(pb + 6)) GRID_BAR(); TP_END(7) \
        } \
        KON(8) if (IN(pb + 7)) { ARef A = *kargs(); MAKE_WI(); TP_BEGIN(8) \
            { LAS unsigned* hist = (LAS unsigned*)(w.lds + HIST_OFF); if (w.tid < 32) hist[w.tid] = 0u; router_stage(A, w, l); \
            REP(10) for (int m = w.gw; m < MTOK; m += w.NGW) router_row(A, l, m, w.lane, hist, (const LAS float*)w.lds, rep_ != 0); \
            __syncthreads(); if (w.tid < 32) ((unsigned*)(A.ws + WS_CTL))[CW_BLKCNT + (l * 256 + w.vcu) * 32 + w.tid] = hist[w.tid]; } \
            if (BOTH(pb + 7)) GRID_BAR(); TP_END(8) \
        } \
        KON(9) if (IN(pb + 8)) { ARef A = *kargs(); MAKE_WI(); TP_BEGIN(9) \
            build_expert_table(A, w, l); { LAS unsigned* cur = (LAS unsigned*)(w.lds + HIST_OFF); if (w.tid < 32) cur[w.tid] = 0u; __syncthreads(); } \
            REP(11) for (int m = w.gw; m < MTOK; m += w.NGW) scatter_row(A, w, l, m, rep_ != 0); \
            if (BOTH(pb + 8)) GRID_BAR(); TP_END(9) \
        } \
        KON(10) if (IN(pb + 9)) { ARef A = *kargs(); MAKE_WI(); TP_BEGIN(10) \
            build_expert_table(A, w, l); \
            pg8::Gemm g{(const bf16*)(A.ws + WS_XS), (const bf16*)(A.ws + WS_W1) + (size_t)l * NEXP * 2048 * DM, MOE_ROWS, NEXP * 2048, DM}; \
            pg8::MoeOrder S{(const PG8_LAS int*)(w.lds + TAB_OFF), 8, w.G, w.vcu}; \
            pg8::EpiSwiglu E{(bf16*)(A.ws + WS_ACT), A.in[I_MB1] + (size_t)l * NEXP * 2048}; \
            REP(8) pg8::gemm_phase<pg8::EpiSwiglu, pg8::MoeOrder, true, true>(ring, g, S, E, w.tid); \
            if (BOTH(pb + 9)) GRID_BAR(); TP_END(10) \
        } \
        KON(11) if (IN(pb + 10)) { ARef A = *kargs(); MAKE_WI(); TP_BEGIN(11) \
            build_expert_table(A, w, l); \
            pg8::Gemm g{(const bf16*)(A.ws + WS_ACT), (const bf16*)(A.ws + WS_W2) + (size_t)l * NEXP * DM * DM, MOE_ROWS, NEXP * DM, DM}; \
            pg8::MoeOrder S{(const PG8_LAS int*)(w.lds + TAB_OFF), 4, w.G, w.vcu}; \
            pg8::EpiY E{(bf16*)(A.ws + WS_XS), A.in[I_MB2] + (size_t)l * NEXP * DM}; \
            REP(9) pg8::gemm_phase<pg8::EpiY, pg8::MoeOrder, true, true>(ring, g, S, E, w.tid); \
            TP_PUBLISH(l) \
            if (BOTH(pb + 10)) GRID_BAR(); TP_END(11) \
        } \
        KON(12) if (IN(pb + 11)) { ARef A = *kargs(); MAKE_WI(); TP_BEGIN(12) \
            REP(12) for (int m = w.gw; m < MTOK; m += w.NGW) combine_row(A, l, m, w.lane, rep_ ? 0.0f : 1.0f, TP_SCALE); \
            if (BOTH(pb + 11)) GRID_BAR(); TP_END(12) \
        } \
    } while (0)
    LAYER_BODY(0);
    LAYER_BODY(1);
#undef LAYER_BODY
#undef IN
#undef ring
#undef MAKE_WI
#undef TID_NOW
#undef GRID_BAR
#undef KON
#undef BOTH
}


#if MK_N_LAUNCHES != 1
template <int K> static void launch_one(int grid, hipStream_t stream, const ArgsH& a) {
    static bool attr = false;
    if (!attr) { (void)hipFuncSetAttribute((const void*)fwd<K>, hipFuncAttributeMaxDynamicSharedMemorySize, LDS_BYTES); attr = true; }
    hipLaunchKernelGGL(fwd<K>, dim3(grid), dim3(NWAVES * 64), LDS_BYTES, stream, a);
}
static void launch_kind(int kind, int grid, hipStream_t stream, const ArgsH& a) {
    switch (kind) {
        case 0: launch_one<0>(grid, stream, a); break; case 1: launch_one<1>(grid, stream, a); break; case 2: launch_one<2>(grid, stream, a); break;
        case 3: launch_one<3>(grid, stream, a); break; case 4: launch_one<4>(grid, stream, a); break; case 5: launch_one<5>(grid, stream, a); break;
        case 6: launch_one<6>(grid, stream, a); break; case 7: launch_one<7>(grid, stream, a); break; case 8: launch_one<8>(grid, stream, a); break;
        case 9: launch_one<9>(grid, stream, a); break; case 10: launch_one<10>(grid, stream, a); break; case 11: launch_one<11>(grid, stream, a); break;
        default: launch_one<12>(grid, stream, a); break;
    }
}
#endif
extern "C" void kernel_launch(void* const* d_in, const int* in_sizes, int n_in, void* d_out, int out_size, void* d_ws, size_t ws_size, hipStream_t stream) {
    static int grid = 0;
    if (grid == 0) {
        if (n_in != N_IN || out_size != MTOK * DM || ws_size < WS_END) { fprintf(stderr, "kernel_launch: unexpected shapes (n_in %d, out %d, ws %zu)\n", n_in, out_size, ws_size); grid = -1; return; }
        int dev = 0, cus = 0;
        if (hipGetDevice(&dev) != hipSuccess || hipDeviceGetAttribute(&cus, hipDeviceAttributeMultiprocessorCount, dev) != hipSuccess) { grid = -1; return; }
#if MK_N_LAUNCHES == 1
        {
            if (hipFuncSetAttribute((const void*)fwd<-1>, hipFuncAttributeMaxDynamicSharedMemorySize, LDS_BYTES) != hipSuccess) { fprintf(stderr, "kernel_launch: hipFuncSetAttribute failed\n"); grid = -1; return; }
            int per_cu = 0;
            if (hipOccupancyMaxActiveBlocksPerMultiprocessor(&per_cu, (const void*)fwd<-1>, NWAVES * 64, LDS_BYTES) != hipSuccess || per_cu < 1) fprintf(stderr, "kernel_launch: occupancy query says %d\n", per_cu);
            (void)hipGetLastError();
        }
#endif
        grid = cus;
    }
    if (grid < 0) return;
    (void)in_sizes;
    if (hipMemsetAsync((char*)d_ws + WS_CTL, 0, CTL_ZERO_BYTES, stream) != hipSuccess) return;
    ArgsH a{};
    for (int i = 0; i < N_IN; ++i) a.in[i] = (const float*)d_in[i];
    a.out = (float*)d_out; a.ws = (unsigned char*)d_ws;
    for (int f = 0; f < 44; ++f) a.invf[f] = (f < 32) ? pow(10000.0, -(double)f / 32.0) : (f < 40) ? pow(500000.0, -(double)(f - 32) / 8.0) : pow(500000.0, -(double)(f - 40) / 4.0);
#if MK_N_LAUNCHES == 1
    a.ph_lo = 0; a.ph_hi = NPHASE; a.li = 0;
    hipLaunchKernelGGL(fwd<-1>, dim3(grid), dim3(NWAVES * 64), LDS_BYTES, stream, a);
#else
    {
        for (int p = 0; p < NPHASE; ++p) {
            if (p == 1 + NPL) continue;
            a.ph_lo = p; a.ph_hi = p + 1; a.li = p;
            const int kind = (p == 0) ? 0 : 1 + (p - 1) % NPL;
            launch_kind(kind, grid, stream, a);
        }
    }
#endif
}
```

```cpp
#include <hip/hip_runtime.h>
#include <cstdio>
#include <cstdint>
#include <cmath>

#ifndef MK_N_LAUNCHES
#define MK_N_LAUNCHES 1
#endif

namespace pg8 {
#define PG8_LAS __attribute__((address_space(3)))
typedef unsigned short bf16_t;
typedef short bf16x8 __attribute__((ext_vector_type(8)));
typedef float f32x4 __attribute__((ext_vector_type(4)));
typedef unsigned u32x4 __attribute__((ext_vector_type(4)));
typedef unsigned u32x2 __attribute__((ext_vector_type(2)));
constexpr int BM = 256, BK = 64, HALF = 128, HTB = HALF * BK * 2  , STAGE_BYTES = 8 * HTB, NXCD = 8, WGM = 8;

__host__ __device__ __forceinline__ int lds_byte(int r, int c) { const int st = (r >> 4) * 2 + (c >> 5), rr = r & 15, cc = c & 31, ob = rr * 64 + cc * 2; return st * 1024 + (ob ^ (((ob >> 9) & 1) << 5)); }
__host__ __device__ __forceinline__ void stage_rc(int b, int& R, int& C) { const int st = b / 1024, sb = b % 1024, swz = sb ^ (((sb >> 9) & 1) << 5); R = (st >> 1) * 16 + swz / 64; C = (st & 1) * 32 + (swz % 64) / 2; }
__host__ __device__ __forceinline__ int perm32(int rho) { const int n = rho >> 4, i = rho & 15; return 8 * (i >> 2) + 4 * n + (i & 3); }

struct Unit { int pm, pn; };
struct Gemm { const bf16_t* A; const bf16_t* Bt; int M, N, K; };

struct StaticOrder {
    int nM, nN, nwg, G, c;
    __host__ __device__ void init(int M, int N, int G_, int c_) { nM = M / BM; nN = N / BM; nwg = nM * nN; G = G_; c = c_; }
    __host__ __device__ bool next(int i, Unit& u) const {
        const long L = (long)i * G + c; if (L >= nwg) return false;
        int wgid = (int)L; { const int q = nwg / NXCD, r = nwg % NXCD, xcd = wgid % NXCD, off = wgid / NXCD; wgid = (xcd < r ? xcd * (q + 1) : r * (q + 1) + (xcd - r) * q) + off; }
        const int nig = WGM * nN, gid = wgid / nig, fm = gid * WGM, gsz = (nM - fm) < WGM ? (nM - fm) : WGM;
        u.pm = fm + ((wgid % nig) % gsz); u.pn = (wgid % nig) / gsz; return true;
    }
    __device__ __forceinline__ void a_ready(const Unit&) const {}
    __device__ __forceinline__ void done(const Unit&) const {}
};
__device__ __forceinline__ unsigned cvt_pk_bf16(float lo, float hi) { unsigned r; asm volatile("v_cvt_pk_bf16_f32 %0, %1, %2" : "=v"(r) : "v"(lo), "v"(hi)); return r; }
struct EpiF32 {
    static constexpr bool PERM = false, AFTER_DRAIN = false;
    float* C; int ldc;
    __device__ __forceinline__ void operator()(const f32x4 (&acc)[2][2][4][2], const Unit& u, int wr, int wc, int fr, int fq) const {
        const int row0 = u.pm * BM + wr * 64 + fr, col0 = u.pn * BM + wc * 32 + 4 * fq;
#pragma unroll
        for (int ai = 0; ai < 2; ++ai)
#pragma unroll
            for (int m = 0; m < 4; ++m) { float* rowp = C + (size_t)(row0 + ai * HALF + m * 16) * ldc + col0;
#pragma unroll
                for (int bj = 0; bj < 2; ++bj)
#pragma unroll
                    for (int n = 0; n < 2; ++n) *(f32x4*)(rowp + bj * HALF + n * 16) = acc[ai][bj][m][n]; }
    }
};
struct EpiProj {
    static constexpr bool PERM = true, AFTER_DRAIN = false;
    bf16_t* PB; float* PF;
    __device__ __forceinline__ void operator()(const f32x4 (&acc)[2][2][4][2], const Unit& u, int wr, int wc, int fr, int fq) const {
        const int row0 = u.pm * BM + wr * 64 + fr;
        if (u.pn < 7) { const int c0 = u.pn * BM + wc * 32 + 8 * fq;
#pragma unroll
            for (int ai = 0; ai < 2; ++ai)
#pragma unroll
                for (int m = 0; m < 4; ++m) { bf16_t* rowp = PB + (size_t)(row0 + ai * HALF + m * 16) * 1792 + c0;
#pragma unroll
                    for (int bj = 0; bj < 2; ++bj) { const f32x4 v0 = acc[ai][bj][m][0], v1 = acc[ai][bj][m][1];
                        u32x4 w; w.x = cvt_pk_bf16(v0[0], v0[1]); w.y = cvt_pk_bf16(v0[2], v0[3]); w.z = cvt_pk_bf16(v1[0], v1[1]); w.w = cvt_pk_bf16(v1[2], v1[3]);
                        *(u32x4*)(rowp + bj * HALF) = w; } }
        } else { const int c0 = (u.pn - 7) * BM + wc * 32 + 8 * fq;
#pragma unroll
            for (int ai = 0; ai < 2; ++ai)
#pragma unroll
                for (int m = 0; m < 4; ++m) { float* rowp = PF + (size_t)(row0 + ai * HALF + m * 16) * 1280 + c0;
#pragma unroll
                    for (int bj = 0; bj < 2; ++bj) { *(f32x4*)(rowp + bj * HALF) = acc[ai][bj][m][0]; *(f32x4*)(rowp + bj * HALF + 4) = acc[ai][bj][m][1]; } }
        }
    }
};
struct EpiRes {
    static constexpr bool PERM = false, AFTER_DRAIN = false;
    const float* xin; float* xout; const float* gate;
    __device__ __forceinline__ void operator()(const f32x4 (&acc)[2][2][4][2], const Unit& u, int wr, int wc, int fr, int fq) const {
        const int row0 = u.pm * BM + wr * 64 + fr, col0 = u.pn * BM + wc * 32 + 4 * fq;
        const float* gp = gate + (size_t)((u.pm * BM) >> 12) * 6144 + col0;
        f32x4 gv[2][2];
#pragma unroll
        for (int bj = 0; bj < 2; ++bj)
#pragma unroll
            for (int n = 0; n < 2; ++n) gv[bj][n] = *(const f32x4*)(gp + bj * HALF + n * 16);
#pragma unroll
        for (int ai = 0; ai < 2; ++ai)
#pragma unroll
            for (int m = 0; m < 4; ++m) { const size_t ro = (size_t)(row0 + ai * HALF + m * 16) * 1024 + col0;
#pragma unroll
                for (int bj = 0; bj < 2; ++bj)
#pragma unroll
                    for (int n = 0; n < 2; ++n) { const f32x4 xv = *(const f32x4*)(xin + ro + bj * HALF + n * 16); *(f32x4*)(xout + ro + bj * HALF + n * 16) = xv + gv[bj][n] * acc[ai][bj][m][n]; } }
    }
};
__device__ __forceinline__ float swiglu1(float glu, float lin) {
    glu = fminf(glu, 7.0f); lin = fminf(fmaxf(lin, -7.0f), 7.0f);
    return glu * (1.0f / (1.0f + __expf(-1.702f * glu))) * (lin + 1.0f);
}
struct EpiSwiglu {
    static constexpr bool PERM = true, AFTER_DRAIN = false;
    bf16_t* O; const float* b1;
    __device__ __forceinline__ void operator()(const f32x4 (&acc)[2][2][4][2], const Unit& u, int wr, int wc, int fr, int fq) const {
        const int e = u.pn >> 3, j = u.pn & 7, row0 = u.pm * BM + wr * 64 + fr, c0 = 128 * j + wc * 32 + 8 * fq;
        const float* bp = b1 + (size_t)e * 2048 + c0;
        f32x4 bg[2], bl[2];
#pragma unroll
        for (int n = 0; n < 2; ++n) { bg[n] = *(const f32x4*)(bp + 4 * n); bl[n] = *(const f32x4*)(bp + 1024 + 4 * n); }
#pragma unroll
        for (int ai = 0; ai < 2; ++ai)
#pragma unroll
            for (int m = 0; m < 4; ++m) { bf16_t* rowp = O + (size_t)(row0 + ai * HALF + m * 16) * 1024 + c0;
                const f32x4 g0 = acc[ai][0][m][0] + bg[0], g1 = acc[ai][0][m][1] + bg[1], l0 = acc[ai][1][m][0] + bl[0], l1 = acc[ai][1][m][1] + bl[1];
                u32x4 w;
                w.x = cvt_pk_bf16(swiglu1(g0[0], l0[0]), swiglu1(g0[1], l0[1])); w.y = cvt_pk_bf16(swiglu1(g0[2], l0[2]), swiglu1(g0[3], l0[3]));
                w.z = cvt_pk_bf16(swiglu1(g1[0], l1[0]), swiglu1(g1[1], l1[1])); w.w = cvt_pk_bf16(swiglu1(g1[2], l1[2]), swiglu1(g1[3], l1[3]));
                *(u32x4*)rowp = w; }
    }
};
struct EpiY {
    static constexpr bool PERM = true, AFTER_DRAIN = false;
    bf16_t* O; const float* b2;
    __device__ __forceinline__ void operator()(const f32x4 (&acc)[2][2][4][2], const Unit& u, int wr, int wc, int fr, int fq) const {
        const int e = u.pn >> 2, j = u.pn & 3, row0 = u.pm * BM + wr * 64 + fr, c0 = 256 * j + wc * 32 + 8 * fq;
        const float* bp = b2 + (size_t)e * 1024 + c0;
        f32x4 bv[2][2];
#pragma unroll
        for (int bj = 0; bj < 2; ++bj)
#pragma unroll
            for (int n = 0; n < 2; ++n) bv[bj][n] = *(const f32x4*)(bp + bj * HALF + 4 * n);
#pragma unroll
        for (int ai = 0; ai < 2; ++ai)
#pragma unroll
            for (int m = 0; m < 4; ++m) { bf16_t* rowp = O + (size_t)(row0 + ai * HALF + m * 16) * 1024 + c0;
#pragma unroll
                for (int bj = 0; bj < 2; ++bj) { const f32x4 v0 = acc[ai][bj][m][0] + bv[bj][0], v1 = acc[ai][bj][m][1] + bv[bj][1];
                    u32x4 w; w.x = cvt_pk_bf16(v0[0], v0[1]); w.y = cvt_pk_bf16(v0[2], v0[3]); w.z = cvt_pk_bf16(v1[0], v1[1]); w.w = cvt_pk_bf16(v1[2], v1[3]);
                    *(u32x4*)(rowp + bj * HALF) = w; } }
    }
};
struct MoeOrder {
    const PG8_LAS int* tab; int NJ, G, c;
    __device__ __forceinline__ bool next(int i, Unit& u) const {
        const int T = tab[0]; const long L = (long)i * G + c; if (L >= (long)T * NJ) return false;
        const int pm = (int)(L / NJ), j = (int)(L % NJ);
        u.pm = pm; u.pn = tab[1 + pm] * NJ + j; return true;
    }
    __device__ __forceinline__ void a_ready(const Unit&) const {}
    __device__ __forceinline__ void done(const Unit&) const {}
};

template <class Epi, class Sched, bool ALIGN_EPI = false, bool SP2 = false>
__device__ __forceinline__ void gemm_phase(PG8_LAS unsigned char* lds, const Gemm g, const Sched& S, const Epi& E, int tid_in) {
    int tid_ = tid_in; asm volatile("" : "+v"(tid_));
    const int tid = tid_, wid = __builtin_amdgcn_readfirstlane(tid >> 6), lane = tid & 63, wr = wid >> 2, wc = wid & 3, fr = lane & 15, fq = lane >> 4;
    const int K = g.K, nt = K / BK;
    unsigned voffA[2], voffB[2];
#pragma unroll
    for (int i = 0; i < 2; ++i) { int R, C; stage_rc(tid * 16 + i * 8192, R, C); const int Rb = Epi::PERM ? ((R & ~31) + perm32(R & 31)) : R;
        voffA[i] = (unsigned)(R * K + C) * 2u; voffB[i] = (unsigned)(Rb * K + C) * 2u; }
    const size_t kstep = (size_t)(BK * 2);
    const size_t hstep = (size_t)HALF * K * 2;
    const size_t tstep = 2 * hstep;
    const unsigned ldsw = (unsigned)wid * 1024u;
    const int aoff = lds_byte(wr * 64 + fr, fq * 8), boff = lds_byte(wc * 32 + fr, fq * 8);
#define PG8_SA(b, h) (((b) * 2 + (h)) * HTB)
#define PG8_SB(b, h) ((4 + (b) * 2 + (h)) * HTB)
#define PG8_STAGE(bufoff, gbase, voff) do { _Pragma("unroll") for (int _i = 0; _i < 2; ++_i) \
        __builtin_amdgcn_global_load_lds((const unsigned*)((const char*)(gbase) + (voff)[_i]), (PG8_LAS unsigned*)(lds + (bufoff) + ldsw + _i * 8192), 16, 0, 0); } while (0)
#define PG8_LDA(dst, b, h) do { _Pragma("unroll") for (int m = 0; m < 4; ++m) _Pragma("unroll") for (int k = 0; k < 2; ++k) dst[m][k] = *(const PG8_LAS bf16x8*)(lds + PG8_SA(b, h) + aoff + m * 2048 + k * 1024); } while (0)
#define PG8_LDB(dst, b, h) do { _Pragma("unroll") for (int n = 0; n < 2; ++n) _Pragma("unroll") for (int k = 0; k < 2; ++k) dst[n][k] = *(const PG8_LAS bf16x8*)(lds + PG8_SB(b, h) + boff + n * 2048 + k * 1024); } while (0)
#define PG8_MMA(ai, bj, At, Bt) do { __builtin_amdgcn_s_setprio(1); _Pragma("unroll") for (int m = 0; m < 4; ++m) _Pragma("unroll") for (int n = 0; n < 2; ++n) _Pragma("unroll") for (int k = 0; k < 2; ++k) \
        acc[ai][bj][m][n] = __builtin_amdgcn_mfma_f32_16x16x32_bf16(Bt[n][k], At[m][k], acc[ai][bj][m][n], 0, 0, 0); __builtin_amdgcn_s_setprio(0); } while (0)
#define PG8_WAIT_V(n) asm volatile("s_waitcnt vmcnt(" #n ")" ::: "memory")
#define PG8_WAIT_L(n) asm volatile("s_waitcnt lgkmcnt(" #n ")" ::: "memory")
#define PG8_BAR __builtin_amdgcn_s_barrier()
#define PG8_SCHED __builtin_amdgcn_sched_barrier(0)
    Unit cur, nxt; int ui = 0;
    if (!S.next(0, cur)) return;
    f32x4 acc[2][2][4][2];
#pragma unroll
    for (int a = 0; a < 2; ++a)
#pragma unroll
        for (int b = 0; b < 2; ++b)
#pragma unroll
            for (int m = 0; m < 4; ++m)
#pragma unroll
                for (int n = 0; n < 2; ++n) acc[a][b][m][n] = (f32x4){0.f, 0.f, 0.f, 0.f};
    bf16x8 At[4][2], B0[2][2], B1[2][2];
    const char* cA = (const char*)g.A + (size_t)cur.pm * tstep; const char* cB = (const char*)g.Bt + (size_t)cur.pn * tstep;
    S.a_ready(cur);
    if constexpr (SP2) {
        PG8_STAGE(PG8_SB(0, 0), cB, voffB); PG8_STAGE(PG8_SB(0, 1), cB + hstep, voffB); PG8_STAGE(PG8_SA(0, 0), cA, voffA); PG8_STAGE(PG8_SA(0, 1), cA + hstep, voffA);
        if (wr == 1) PG8_BAR;
        PG8_WAIT_V(2); PG8_BAR;
        PG8_STAGE(PG8_SB(1, 0), cB + kstep, voffB); PG8_STAGE(PG8_SA(1, 0), cA + kstep, voffA); PG8_STAGE(PG8_SB(1, 1), cB + hstep + kstep, voffB);
        PG8_WAIT_V(6); PG8_BAR;
    } else {
        PG8_STAGE(PG8_SB(0, 0), cB, voffB); PG8_STAGE(PG8_SA(0, 0), cA, voffA); PG8_STAGE(PG8_SB(0, 1), cB + hstep, voffB); PG8_STAGE(PG8_SA(0, 1), cA + hstep, voffA);
        if (wr == 1) PG8_BAR;
        PG8_WAIT_V(4); PG8_BAR;
        PG8_STAGE(PG8_SB(1, 0), cB + kstep, voffB); PG8_STAGE(PG8_SA(1, 0), cA + kstep, voffA); PG8_STAGE(PG8_SB(1, 1), cB + hstep + kstep, voffB);
        PG8_WAIT_V(6); PG8_BAR;
    }
    for (;;) {
        const bool has_next = S.next(ui + 1, nxt);
        const char* nA = has_next ? (const char*)g.A + (size_t)nxt.pm * tstep : cA; const char* nB = has_next ? (const char*)g.Bt + (size_t)nxt.pn * tstep : cB;
        for (int t = 0; t < nt; t += 2) {
            const bool last = (t == nt - 2);
            const char* a1 = cA + (size_t)(t + 1) * kstep;
            const char* a2 = last ? nA : cA + (size_t)(t + 2) * kstep; const char* b2 = last ? nB : cB + (size_t)(t + 2) * kstep;
            const char* a3 = a2 + kstep; const char* b3 = b2 + kstep;
            if (last && has_next) S.a_ready(nxt);
            if constexpr (SP2) {
            PG8_LDB(B0, 0, 0); PG8_LDB(B1, 0, 1); PG8_SCHED; PG8_LDA(At, 0, 0); PG8_STAGE(PG8_SA(1, 1), a1 + hstep, voffA);
            PG8_WAIT_V(8); PG8_WAIT_L(0); PG8_BAR; PG8_MMA(0, 0, At, B0); PG8_MMA(0, 1, At, B1); PG8_BAR; PG8_SCHED;
            PG8_LDA(At, 0, 1); PG8_STAGE(PG8_SB(0, 0), b2, voffB); PG8_STAGE(PG8_SB(0, 1), b2 + hstep, voffB); PG8_STAGE(PG8_SA(0, 0), a2, voffA);
            PG8_WAIT_V(8); PG8_WAIT_L(0); PG8_BAR; PG8_MMA(1, 0, At, B0); PG8_MMA(1, 1, At, B1); PG8_BAR; PG8_SCHED;
            PG8_LDB(B0, 1, 0); PG8_LDB(B1, 1, 1); PG8_SCHED; PG8_LDA(At, 1, 0); PG8_STAGE(PG8_SA(0, 1), a2 + hstep, voffA);
            PG8_WAIT_V(8); PG8_WAIT_L(0); PG8_BAR; PG8_MMA(0, 0, At, B0); PG8_MMA(0, 1, At, B1); PG8_BAR; PG8_SCHED;
            PG8_LDA(At, 1, 1); PG8_STAGE(PG8_SB(1, 0), b3, voffB); PG8_STAGE(PG8_SB(1, 1), b3 + hstep, voffB); PG8_STAGE(PG8_SA(1, 0), a3, voffA);
            PG8_WAIT_V(8); PG8_WAIT_L(0); PG8_BAR; PG8_MMA(1, 0, At, B0); PG8_MMA(1, 1, At, B1); PG8_BAR; PG8_SCHED;
            } else {
            PG8_LDB(B0, 0, 0); PG8_SCHED; PG8_LDA(At, 0, 0); PG8_STAGE(PG8_SA(1, 1), a1 + hstep, voffA);
            PG8_WAIT_L(8); PG8_BAR; PG8_WAIT_L(0); PG8_MMA(0, 0, At, B0); PG8_BAR; PG8_SCHED;
            PG8_LDB(B1, 0, 1); PG8_STAGE(PG8_SB(0, 0), b2, voffB);
            PG8_BAR; PG8_WAIT_L(0); PG8_MMA(0, 1, At, B1); PG8_BAR;
            PG8_LDA(At, 0, 1); PG8_STAGE(PG8_SA(0, 0), a2, voffA);
            PG8_BAR; PG8_WAIT_L(0); PG8_MMA(1, 0, At, B0); PG8_BAR; PG8_SCHED;
            PG8_STAGE(PG8_SB(0, 1), b2 + hstep, voffB);
            PG8_WAIT_V(6); PG8_BAR; PG8_MMA(1, 1, At, B1); PG8_BAR;
            PG8_LDB(B0, 1, 0); PG8_SCHED; PG8_LDA(At, 1, 0); PG8_STAGE(PG8_SA(0, 1), a2 + hstep, voffA);
            PG8_WAIT_L(8); PG8_BAR; PG8_WAIT_L(0); PG8_MMA(0, 0, At, B0); PG8_BAR; PG8_SCHED;
            PG8_LDB(B1, 1, 1); PG8_STAGE(PG8_SB(1, 0), b3, voffB);
            PG8_BAR; PG8_WAIT_L(0); PG8_MMA(0, 1, At, B1); PG8_BAR;
            PG8_LDA(At, 1, 1); PG8_STAGE(PG8_SA(1, 0), a3, voffA);
            PG8_BAR; PG8_WAIT_L(0); PG8_MMA(1, 0, At, B0); PG8_BAR; PG8_SCHED;
            PG8_STAGE(PG8_SB(1, 1), b3 + hstep, voffB);
            PG8_WAIT_V(6); PG8_BAR; PG8_MMA(1, 1, At, B1); PG8_BAR;
            }
        }
        if constexpr (ALIGN_EPI) { if (wr == 0) PG8_BAR; }
        if constexpr (!Epi::AFTER_DRAIN) { E(acc, cur, wr, wc, fr, fq); S.done(cur); }
        if (!has_next) break;
#pragma unroll
        for (int a = 0; a < 2; ++a)
#pragma unroll
            for (int b = 0; b < 2; ++b)
#pragma unroll
                for (int m = 0; m < 4; ++m)
#pragma unroll
                    for (int n = 0; n < 2; ++n) acc[a][b][m][n] = (f32x4){0.f, 0.f, 0.f, 0.f};
        cur = nxt; cA = nA; cB = nB; ++ui;
        if constexpr (ALIGN_EPI) { if (wr == 1) PG8_BAR; }
    }
    PG8_WAIT_V(0);
    if constexpr (!ALIGN_EPI) { if (wr == 0) PG8_BAR; }
    PG8_BAR;
    if constexpr (Epi::AFTER_DRAIN) { E.fused(acc, cur, wr, wc, fr, fq, lds, wid, lane); S.done(cur); }
#undef PG8_SA
#undef PG8_SB
#undef PG8_STAGE
#undef PG8_LDA
#undef PG8_LDB
#undef PG8_MMA
#undef PG8_WAIT_V
#undef PG8_WAIT_L
#undef PG8_BAR
#undef PG8_SCHED
}
}

constexpr int NWAVES = 8;
constexpr int NB = 8, SEQ = 4096, DM = 1024, MTOK = NB * SEQ, NLAYER = 2;
constexpr int INC = 2984, INCP = 3072;
constexpr int C_RET = 0, C_RW = 1024, C_DSA = 1920, C_SB = 2216;
constexpr int PBW = 1792, PFW = 1280, PB_SB = 1024, PF_DSA = 896;
constexpr int NEXP = 32, MOE_ROWS = MTOK * 4 + NEXP * 256;
constexpr int ROPE_W = 88;
constexpr int NCH = 16, TCH = SEQ / NCH;
constexpr int NPL = 12, NPHASE = 1 + NLAYER * NPL;
enum { I_X = 0, I_C, I_POS, I_ADAW, I_ADAB, I_NMIX, I_NFFN, I_WIN, I_RETGN, I_MU, I_W0, I_W2, I_A0, I_A2, I_G2, I_KK, I_KA, I_RK, I_LN, I_QNORM, I_WQ, I_WQI, I_DONORM, I_SONORM, I_WOUT, I_RW, I_RB, I_MW1, I_MB1, I_MW2, I_MB2, I_NFINAL, N_IN };

constexpr size_t MiB = 1u << 20;
constexpr size_t WS_CTL = 0, CTL_ZERO_BYTES = 1 * MiB;
constexpr size_t WS_MOD = 1 * MiB, WS_ROPE = 2 * MiB, WS_WIN = 14 * MiB, WS_WOUT = 26 * MiB, WS_W1 = 30 * MiB, WS_W2 = 286 * MiB;
constexpr size_t WS_XA = 414 * MiB, WS_H = 542 * MiB, WS_MIX = 606 * MiB, WS_TOPI = 670 * MiB, WS_TOPW = 671 * MiB, WS_POS = 672 * MiB;
constexpr size_t WS_R = 674 * MiB;
constexpr size_t WS_PB = WS_R  , WS_PF = WS_R + 112 * MiB  , WS_RWA = 1058 * MiB  , WS_DQ = 1314 * MiB  , WS_DKB = 1330 * MiB  , WS_DVB = 1334 * MiB  , WS_DQI = 1346 * MiB  , WS_DKI = 1394 * MiB  , WS_DW = 1398 * MiB;
constexpr size_t WS_SMALLW = 1338 * MiB  ;
constexpr int SMW_QI = 0, SMW_W2 = 512 * 128, SMW_A2 = SMW_W2 + 256 * 32, SMW_G2 = SMW_A2 + 256 * 32, SMW_LAYER = SMW_G2 + 256 * 64;
constexpr size_t WS_PT = 1362 * MiB  ;
constexpr size_t WS_CH = WS_H  , WS_SI = WS_H + 16 * MiB  , WS_SIR = WS_H + 24 * MiB  ,
                 WS_CHR = WS_H + 32 * MiB  , WS_PTR = WS_H + 40 * MiB  ;
constexpr size_t WS_SQ = WS_MIX  , WS_SK = WS_MIX + 16 * MiB, WS_SV = WS_MIX + 32 * MiB;
constexpr size_t WS_YO = 1400 * MiB  , WS_SC = 1528 * MiB  ;
constexpr size_t WS_XS = WS_R  , WS_ACT = 946 * MiB  ;
constexpr size_t WS_END = 2040 * MiB;
static_assert((size_t)MOE_ROWS * 2048 <= 272 * MiB, "moe buffers");
constexpr int CW_TMO = 0, CW_CODE = 1, CW_DSAQ = 64  , CW_BAR = 4096, CW_BLKCNT = 16384  ;
constexpr int RING_BYTES = 131072, MISC_OFF = RING_BYTES + 320, TST_OFF = RING_BYTES + 1024  , TAB_OFF = RING_BYTES + 2048  , HIST_OFF = RING_BYTES + 5120  , BASE_OFF = RING_BYTES + 5376  , LDS_BYTES = 147456;

#if defined(__HIP_DEVICE_COMPILE__)
#define GAS __attribute__((address_space(1)))
#define CAS __attribute__((address_space(4)))
#else
#define GAS
#define CAS
#endif
#define LAS __attribute__((address_space(3)))
typedef unsigned short bf16;
typedef unsigned v4u __attribute__((ext_vector_type(4)));
typedef unsigned v2u __attribute__((ext_vector_type(2)));
typedef float f32x4 __attribute__((ext_vector_type(4)));
typedef GAS unsigned gu32;
typedef short bf16x8v __attribute__((ext_vector_type(8)));
typedef short s16x4v __attribute__((ext_vector_type(4)));
typedef _Float16 f16x8 __attribute__((ext_vector_type(8)));
#define RLX_AGENT __ATOMIC_RELAXED, __HIP_MEMORY_SCOPE_AGENT
#define LDS_WAIT() asm volatile("s_waitcnt lgkmcnt(0)" ::: "memory")
#define VM_WAIT() asm volatile("s_waitcnt vmcnt(0)" ::: "memory")
__device__ __forceinline__ unsigned f2bf(float f) { unsigned u = __builtin_bit_cast(unsigned, f); return (u + 0x7fffu + ((u >> 16) & 1u)) >> 16; }
__device__ __forceinline__ unsigned pk2(float lo, float hi) { return f2bf(lo) | (f2bf(hi) << 16); }
__device__ __forceinline__ float bf_lo(unsigned w) { return __builtin_bit_cast(float, w << 16); }
__device__ __forceinline__ float bf_hi(unsigned w) { return __builtin_bit_cast(float, w & 0xffff0000u); }
__device__ __forceinline__ float wave_sum(float v) {
#pragma unroll
    for (int o = 1; o < 64; o <<= 1) v += __shfl_xor(v, o);
    return v;
}
__device__ __forceinline__ float wave_max(float v) {
#pragma unroll
    for (int o = 1; o < 64; o <<= 1) v = fmaxf(v, __shfl_xor(v, o));
    return v;
}
__device__ __forceinline__ float grp16_sum(float v) { v += __shfl_xor(v, 1); v += __shfl_xor(v, 2); v += __shfl_xor(v, 4); v += __shfl_xor(v, 8); return v; }
__device__ __forceinline__ float grp8_sum(float v) { v += __shfl_xor(v, 1); v += __shfl_xor(v, 2); v += __shfl_xor(v, 4); return v; }
__device__ __forceinline__ float sum4(f32x4 a) { return (a.x + a.y) + (a.z + a.w); }
__device__ __forceinline__ float dot4(f32x4 a, f32x4 b) { return (a.x * b.x + a.y * b.y) + (a.z * b.z + a.w * b.w); }
__device__ __forceinline__ float sigm(float x) { return 1.0f / (1.0f + expf(-x)); }
__device__ __forceinline__ float softplusf(float x) { return fmaxf(x, 0.0f) + log1pf(expf(-fabsf(x))); }
__device__ __forceinline__ f32x4 shx4(f32x4 v, int m) { f32x4 r; r.x = __shfl_xor(v.x, m); r.y = __shfl_xor(v.y, m); r.z = __shfl_xor(v.z, m); r.w = __shfl_xor(v.w, m); return r; }

#define XB_TMO      128
#define XB_XCNT(j)  (256  + 64 * (j))
#define XB_XSUB(j)  (1280 + 64 * (j))
#define XB_XGEN(j)  (2304 + 64 * (j))
#define XB_TOP      3328
#define XB_TOPGEN   3392
#define XCD_BAR_WORDS 3456
#define XB_SPIN_CAP (1u << 18)

__device__ __forceinline__ unsigned xb_ld(unsigned* p)              { return __hip_atomic_load(p, __ATOMIC_RELAXED, __HIP_MEMORY_SCOPE_AGENT); }
__device__ __forceinline__ unsigned xb_add(unsigned* p, unsigned v) { return __hip_atomic_fetch_add(p, v, __ATOMIC_RELAXED, __HIP_MEMORY_SCOPE_AGENT); }
__device__ __forceinline__ unsigned xb_xcc_id() { return (unsigned)__builtin_amdgcn_s_getreg((3 << 11) | 20) & 0xFu; }
#define XB_SPIN(cond, bar) do { unsigned _sp = 0; while (cond) { __builtin_amdgcn_s_sleep(1); \
    if ((++_sp & 255u) == 0u) { if (xb_ld(&(bar)[XB_TMO])) break; if (_sp > XB_SPIN_CAP) { atomicAdd(&(bar)[XB_TMO], 1u); break; } } } } while (0)

struct XcdBarrier {
    unsigned* bar; unsigned x;
    volatile LAS unsigned* st;
};

__device__ __forceinline__ XcdBarrier xcd_barrier_post(unsigned* bar, volatile LAS unsigned* st, int xb_tid) {
    XcdBarrier b; b.bar = bar; b.x = xb_xcc_id(); b.st = st;
    if (xb_tid == 0) (void)xb_add(&bar[XB_XCNT(b.x)], 1u);
    return b;
}
__device__ __forceinline__ void xcd_barrier_complete(unsigned* bar, unsigned x, unsigned& nloc, unsigned& nx) {
    const unsigned G = gridDim.x * gridDim.y * gridDim.z;
    unsigned sum, cnt, mine, sp = 0u;
    for (;;) {
        sum = 0u; cnt = 0u; mine = 0u;
#pragma unroll
        for (unsigned j = 0; j < 16; ++j) { const unsigned c = xb_ld(&bar[XB_XCNT(j)]); sum += c; cnt += (c > 0u) ? 1u : 0u; mine = (j == x) ? c : mine; }
        if (sum == G) break;
        __builtin_amdgcn_s_sleep(1);
        if ((++sp & 255u) == 0u) { if (xb_ld(&bar[XB_TMO])) break; if (sp > XB_SPIN_CAP) { atomicAdd(&bar[XB_TMO], 1u); break; } }
    }
    nloc = mine > 0u ? mine : 1u; nx = cnt > 0u ? cnt : 1u;
}

__device__ __forceinline__ void xcd_barrier(const XcdBarrier& b, int xb_tid) {
    asm volatile("s_waitcnt vmcnt(0)" ::: "memory");
    __syncthreads();
    if (xb_tid == 0) {
        unsigned* bar = b.bar;
        __builtin_amdgcn_s_waitcnt(0);
        unsigned nloc = b.st[0], nx = b.st[1];
        if (nloc == 0u) { xcd_barrier_complete(bar, b.x, nloc, nx); b.st[0] = nloc; b.st[1] = nx; }
        const unsigned old = xb_add(&bar[XB_XSUB(b.x)], 1u);
        const unsigned gen = old / nloc;
        if (old + 1u == (gen + 1u) * nloc) {
            __builtin_amdgcn_fence(__ATOMIC_RELEASE, "agent");
            asm volatile("s_waitcnt vmcnt(0)" ::: "memory");
            const unsigned og = xb_add(&bar[XB_TOP], 1u);
            const unsigned tg = og / nx;
            if (og + 1u == (tg + 1u) * nx) xb_add(&bar[XB_TOPGEN], 1u);
            else XB_SPIN(xb_ld(&bar[XB_TOPGEN]) == tg, bar);
            __builtin_amdgcn_fence(__ATOMIC_ACQUIRE, "agent");
            xb_add(&bar[XB_XGEN(b.x)], 1u);
            asm volatile("s_waitcnt vmcnt(0)" ::: "memory");
        } else {
            XB_SPIN(xb_ld(&bar[XB_XGEN(b.x)]) == gen, bar);
            __builtin_amdgcn_fence(__ATOMIC_ACQUIRE, "agent");
            asm volatile("s_waitcnt vmcnt(0)" ::: "memory");
        }
    }
    __syncthreads();
}
struct ArgsH { const float* in[N_IN]; float* out; unsigned char* ws; double invf[44]; int ph_lo, ph_hi, li, pad; };
struct ArgsD { const GAS float* in[N_IN]; GAS float* out; GAS unsigned char* ws; double invf[44]; int ph_lo, ph_hi, li, pad; };
static_assert(sizeof(ArgsH) == sizeof(ArgsD), "args layout");
typedef const CAS ArgsD& ARef;
__device__ __forceinline__ const CAS ArgsD* kargs() {
#if defined(__HIP_DEVICE_COMPILE__)
    const CAS ArgsD* p = (const CAS ArgsD*)__builtin_amdgcn_kernarg_segment_ptr(); asm volatile("" : "+s"(p)); return p;
#else
    return nullptr;
#endif
}
struct WI { LAS unsigned char* lds; int tid, lane, wave, vcu, G, gw, NGW, bx; };
constexpr size_t RWA_STRIDE = 32 * MiB / 4;
constexpr size_t YO_STRIDE = 32 * MiB / 4;

__device__ __forceinline__ int wave_sum_i(int v) {
#pragma unroll
    for (int o = 1; o < 64; o <<= 1) v += __shfl_xor(v, o);
    return v;
}
__device__ __forceinline__ void sincos_d(double ang, float& s, float& c) {
    const double q = __builtin_rint(ang * 0.63661977236758134308);
    double r = __builtin_fma(-q, 1.57079632679489661923, ang); r = __builtin_fma(-q, 6.123233995736766e-17, r);
    const double r2 = r * r;
    const double sp = r * (1.0 + r2 * (-1.0 / 6 + r2 * (1.0 / 120 + r2 * (-1.0 / 5040 + r2 * (1.0 / 362880 + r2 * (-1.0 / 39916800 + r2 * (1.0 / 6227020800.0)))))));
    const double cp = 1.0 + r2 * (-0.5 + r2 * (1.0 / 24 + r2 * (-1.0 / 720 + r2 * (1.0 / 40320 + r2 * (-1.0 / 3628800 + r2 * (1.0 / 479001600 + r2 * (-1.0 / 87178291200.0)))))));
    const int qi = ((int)q) & 3;
    const double ss = (qi == 0) ? sp : (qi == 1) ? cp : (qi == 2) ? -sp : -cp;
    const double cc = (qi == 0) ? cp : (qi == 1) ? -sp : (qi == 2) ? -cp : sp;
    s = (float)ss; c = (float)cc;
}

__device__ __forceinline__ void tr_item(const float* W, int ldw, int nvalid, int k0, int nsrc0, bf16* WT, size_t dstrow0, LAS float* scr, int lane, float scale = 1.0f) {
#pragma unroll 8
    for (int i = 0; i < 32; ++i) { const int kk = 2 * i + (lane >> 5), c = lane & 31, n = nsrc0 + c; scr[kk * 33 + c] = (n < nvalid) ? W[(size_t)(k0 + kk) * ldw + n] * scale : 0.0f; }
    LDS_WAIT(); asm volatile("" ::: "memory");
    const int c8 = lane & 7;
#pragma unroll
    for (int j = 0; j < 4; ++j) { const int n = (lane >> 3) + 8 * j; const LAS float* s = scr + (8 * c8) * 33 + n;
        v4u o; o.x = pk2(s[0 * 33], s[1 * 33]); o.y = pk2(s[2 * 33], s[3 * 33]); o.z = pk2(s[4 * 33], s[5 * 33]); o.w = pk2(s[6 * 33], s[7 * 33]);
        *(v4u*)(WT + (dstrow0 + n) * 1024 + k0 + 8 * c8) = o; }
    LDS_WAIT(); asm volatile("" ::: "memory");
}
__device__ __forceinline__ void ph_prologue(ARef A, const WI& w) {
    LAS float* sc = (LAS float*)w.lds;
    { const float* cin = A.in[I_C]; for (int i = w.tid; i < NB * DM; i += NWAVES * 64) { const float v = cin[i]; sc[i] = v / (1.0f + expf(-v)); } }
    __syncthreads();
    float* MOD = (float*)(A.ws + WS_MOD);
    if (w.wave == 0 && w.vcu < 192) {
        const int l = w.vcu / 96, col = (w.vcu % 96) * 64 + w.lane;
        const float* wp = A.in[I_ADAW] + (size_t)l * DM * 6144 + col;
        float acc[8];
#pragma unroll
        for (int b = 0; b < 8; ++b) acc[b] = 0.0f;
        for (int k = 0; k < DM; ++k) { const float wv = wp[(size_t)k * 6144];
#pragma unroll
            for (int b = 0; b < 8; ++b) acc[b] += sc[b * DM + k] * wv; }
        const float bias = A.in[I_ADAB][l * 6144 + col];
#pragma unroll
        for (int b = 0; b < 8; ++b) MOD[(size_t)(l * 8 + b) * 6144 + col] = acc[b] + bias;
    }
    LAS float* scr = (LAS float*)(w.lds + 32768 + w.wave * 8448);
    constexpr int I_IN = NLAYER * 16 * 96, I_OUT = NLAYER * 16 * 32, I_W1 = NLAYER * NEXP * 16 * 64, I_W2 = NLAYER * NEXP * 16 * 32, NIT = I_IN + I_OUT + I_W1 + I_W2;
    for (int it = w.gw; it < NIT; it += w.NGW) {
        int r = it;
        if (r < I_IN) { const int l = r / 1536, rr = r % 1536, kb = rr / 96, nb = rr % 96;
            const int nd = nb * 32;
            const int ns = (nd < 1024) ? nd : (nd < 1792) ? C_SB + (nd - 1024) : (nd < 2688) ? C_RW + (nd - 1792) : C_DSA + (nd - 2688);
            const int nv = (nd < 1024) ? 1024 : (nd < 1792) ? INC : (nd < 2688) ? C_DSA : ((nd < INC) ? C_SB : 0);
            const float sc_ = (nd >= 256 && nd < 512) ? 0.125f : (nd >= 1024 && nd < 1280) ? 0.18033688011112042f : 1.0f;
            tr_item(A.in[I_WIN] + (size_t)l * DM * INC, INC, nv, kb * 64, ns, (bf16*)(A.ws + WS_WIN) + (size_t)l * INCP * DM, (size_t)nd, scr, w.lane, sc_); continue; }
        r -= I_IN;
        if (r < I_OUT) { const int l = r / 512, rr = r % 512, kb = rr / 32, nb = rr % 32;
            tr_item(A.in[I_WOUT] + (size_t)l * DM * DM, DM, DM, kb * 64, nb * 32, (bf16*)(A.ws + WS_WOUT) + (size_t)l * DM * DM, (size_t)nb * 32, scr, w.lane); continue; }
        r -= I_OUT;
        if (r < I_W1) { const int le = r / 1024, rr = r % 1024, kb = rr / 64, nb = rr % 64, j = nb >> 3, bj = (nb >> 2) & 1, cc0 = (nb & 3) * 32;
            tr_item(A.in[I_MW1] + (size_t)le * DM * 2048, 2048, 2048, kb * 64, bj * 1024 + 128 * j + cc0, (bf16*)(A.ws + WS_W1) + (size_t)le * 2048 * DM, (size_t)nb * 32, scr, w.lane); continue; }
        r -= I_W1;
        { const int le = r / 512, rr = r % 512, kb = rr / 32, nb = rr % 32;
            tr_item(A.in[I_MW2] + (size_t)le * DM * DM, DM, DM, kb * 64, nb * 32, (bf16*)(A.ws + WS_W2) + (size_t)le * DM * DM, (size_t)nb * 32, scr, w.lane); }
    }
    float* RT = (float*)(A.ws + WS_ROPE); const int* pos = (const int*)A.in[I_POS];
    for (int g = w.gw * 64 + w.lane; g < MTOK * 44; g += w.NGW * 64) {
        const int tok = g / 44, f = g % 44; int co, so;
        if (f < 32) { co = f; so = 32 + f; } else if (f < 40) { co = 64 + (f - 32); so = 72 + (f - 32); } else { co = 80 + (f - 40); so = 84 + (f - 40); }
        float s, c; sincos_d((double)pos[tok] * A.invf[f], s, c);
        RT[(size_t)tok * ROPE_W + co] = c; RT[(size_t)tok * ROPE_W + so] = s;
    }
}

__device__ __forceinline__ void emit_h_row(const f32x4 (&v)[4], float rstd, const float* g, const float* sc, const float* sh, bf16* hrow, int lane) {
#pragma unroll
    for (int j = 0; j < 4; ++j) { const int k = 4 * (lane + 64 * j);
        const f32x4 gv = *(const f32x4*)(g + k), scv = *(const f32x4*)(sc + k), shv = *(const f32x4*)(sh + k);
        const f32x4 h = v[j] * rstd * gv * (1.0f + scv) + shv;
        v2u o; o.x = pk2(h.x, h.y); o.y = pk2(h.z, h.w); *(v2u*)(hrow + k) = o; }
}
__device__ __forceinline__ void small_weights_to_f16(ARef A, const WI& w) {
    { _Float16* SW = (_Float16*)(A.ws + WS_SMALLW);
      const int g0 = w.gw * 64 + w.lane, gs = w.NGW * 64;
      for (int l = 0; l < NLAYER; ++l) { _Float16* S = SW + (size_t)l * SMW_LAYER;
          const float* wq = A.in[I_WQ] + (size_t)l * 128 * 256; const float* wqi = A.in[I_WQI] + (size_t)l * 128 * 256;
          for (int e = g0; e < 256 * 128; e += gs) { const int n = e >> 7, k = e & 127; S[SMW_QI + e] = (_Float16)wq[k * 256 + n]; S[SMW_QI + 256 * 128 + e] = (_Float16)wqi[k * 256 + n]; }
          const float* w2 = A.in[I_W2] + (size_t)l * 32 * 256; const float* a2 = A.in[I_A2] + (size_t)l * 32 * 256; const float* g2 = A.in[I_G2] + (size_t)l * 64 * 256;
          for (int e = g0; e < 256 * 32; e += gs) { const int n = e >> 5, k = e & 31; S[SMW_W2 + e] = (_Float16)w2[k * 256 + n]; S[SMW_A2 + e] = (_Float16)a2[k * 256 + n]; }
          for (int e = g0; e < 256 * 64; e += gs) { const int n = e >> 6, k = e & 63; S[SMW_G2 + e] = (_Float16)g2[k * 256 + n]; } } }
}
__device__ __forceinline__ void ph_norm1(ARef A, const WI& w) {
    const float* MOD = (const float*)(A.ws + WS_MOD); bf16* H = (bf16*)(A.ws + WS_H);
    for (int m = w.gw; m < MTOK; m += w.NGW) {
        const float* xr = A.in[I_X] + (size_t)m * DM; f32x4 v[4]; float ss = 0.0f;
#pragma unroll
        for (int j = 0; j < 4; ++j) { v[j] = *(const f32x4*)(xr + 4 * (w.lane + 64 * j)); ss += dot4(v[j], v[j]); }
        ss = wave_sum(ss); const float rstd = 1.0f / sqrtf(ss * (1.0f / DM) + 1e-5f);
        const float* mb = MOD + (size_t)(m >> 12) * 6144;
        emit_h_row(v, rstd, A.in[I_NMIX], mb + 1024, mb, H + (size_t)m * DM, w.lane);
    }
}

typedef _Float16 h4v __attribute__((ext_vector_type(4)));
__device__ __forceinline__ f16x8 pack_f16x8(f32x4 a, f32x4 b) { f16x8 r; r[0] = (_Float16)a.x; r[1] = (_Float16)a.y; r[2] = (_Float16)a.z; r[3] = (_Float16)a.w; r[4] = (_Float16)b.x; r[5] = (_Float16)b.y; r[6] = (_Float16)b.z; r[7] = (_Float16)b.w; return r; }
__device__ __forceinline__ void prep16(ARef A, int l, int m0, int lane_in) {
    int lane = lane_in; asm volatile("" : "+v"(lane));
    const int tk = lane & 15, q4 = lane >> 4, m = m0 + tk, t = m & (SEQ - 1);
    const float* P = (const float*)(A.ws + WS_PF); float* RWA = (float*)(A.ws + WS_RWA); const _Float16* SW = (const _Float16*)(A.ws + WS_SMALLW) + (size_t)l * SMW_LAYER;
    const float* pr = P + (size_t)m * PFW; const float* pp = pr - PFW; const float* pd = P + (size_t)m * PFW + PF_DSA; const float* mu = A.in[I_MU] + l * 896;
    const float* RT = (const float*)(A.ws + WS_ROPE) + (size_t)m * ROPE_W; const f32x4 zero4 = {0.f, 0.f, 0.f, 0.f};
    f16x8 bx[4], bc[4];
    { float ss = 0.0f; f32x4 c[4][2];
#pragma unroll
      for (int ks = 0; ks < 4; ++ks) { const int f0 = 32 * ks + 8 * q4;
          f32x4 x[2];
#pragma unroll
          for (int u = 0; u < 2; ++u) { const f32x4 z = *(const f32x4*)(pr + 768 + f0 + 4 * u); const f32x4 p = t ? *(const f32x4*)(pp + 768 + f0 + 4 * u) : zero4; x[u] = z + (p - z) * *(const f32x4*)(mu + 768 + f0 + 4 * u);
#pragma unroll
              for (int i = 0; i < 4; ++i) x[u][i] = (ks == 0) ? tanhf(x[u][i]) : (ks == 1) ? x[u][i] : sigm(x[u][i]); }
          bx[ks] = pack_f16x8(x[0], x[1]);
          c[ks][0] = *(const f32x4*)(pd + f0); c[ks][1] = *(const f32x4*)(pd + f0 + 4); ss += dot4(c[ks][0], c[ks][0]) + dot4(c[ks][1], c[ks][1]); }
      ss += __shfl_xor(ss, 16); ss += __shfl_xor(ss, 32);
      const float rstd = 1.0f / sqrtf(ss * (1.0f / 128.0f) + 1e-5f); const float* qn = A.in[I_QNORM] + l * 128;
#pragma unroll
      for (int ks = 0; ks < 4; ++ks) { const int f0 = 32 * ks + 8 * q4; bc[ks] = pack_f16x8(c[ks][0] * rstd * *(const f32x4*)(qn + f0), c[ks][1] * rstd * *(const f32x4*)(qn + f0 + 4)); } }
    const _Float16* wrow = SW + (size_t)tk * 0;
    (void)wrow;
    const int arow = lane & 15;
#pragma unroll 1
    for (int hd = 0; hd < 4; ++hd) {
        f32x4 fk[4], av[4]; float ssk = 0.0f;
#pragma unroll
        for (int j = 0; j < 4; ++j) { const int nb = 4 * hd + j, ch = 16 * nb + 4 * q4; const size_t o = (size_t)m * 256 + ch;
            const f16x8 aw = *(const f16x8*)(SW + SMW_W2 + (16 * nb + arow) * 32 + 8 * q4), aa = *(const f16x8*)(SW + SMW_A2 + (16 * nb + arow) * 32 + 8 * q4);
            const f16x8 ag0 = *(const f16x8*)(SW + SMW_G2 + (16 * nb + arow) * 64 + 8 * q4), ag1 = *(const f16x8*)(SW + SMW_G2 + (16 * nb + arow) * 64 + 32 + 8 * q4);
            const f32x4 cw = __builtin_amdgcn_mfma_f32_16x16x32_f16(aw, bx[0], *(const f32x4*)(A.in[I_W0] + l * 256 + ch), 0, 0, 0);
            const f32x4 ca = __builtin_amdgcn_mfma_f32_16x16x32_f16(aa, bx[1], *(const f32x4*)(A.in[I_A0] + l * 256 + ch), 0, 0, 0);
            f32x4 cg = __builtin_amdgcn_mfma_f32_16x16x32_f16(ag0, bx[2], zero4, 0, 0, 0); cg = __builtin_amdgcn_mfma_f32_16x16x32_f16(ag1, bx[3], cg, 0, 0, 0);
            f32x4 dec;
#pragma unroll
            for (int i = 0; i < 4; ++i) { dec[i] = expf(-expf(-softplusf(-cw[i]) - 0.5f)); av[j][i] = sigm(ca[i]); }
            *(f32x4*)(RWA + 1 * RWA_STRIDE + o) = dec; *(f32x4*)(RWA + 6 * RWA_STRIDE + o) = cg;
            { const f32x4 z = *(const f32x4*)(pr + 256 + ch); const f32x4 p = t ? *(const f32x4*)(pp + 256 + ch) : zero4; fk[j] = z + (p - z) * *(const f32x4*)(mu + 256 + ch); }
            const f32x4 kk = fk[j] * *(const f32x4*)(A.in[I_KK] + l * 256 + ch); ssk += dot4(kk, kk); }
        ssk += __shfl_xor(ssk, 16); ssk += __shfl_xor(ssk, 32);
        const float inrm = 1.0f / fmaxf(sqrtf(ssk), 1e-12f);
        f32x4 fr[4], km[4]; float bs = 0.0f;
#pragma unroll
        for (int j = 0; j < 4; ++j) { const int ch = 16 * (4 * hd + j) + 4 * q4;
            { const f32x4 z = *(const f32x4*)(pr + ch); const f32x4 p = t ? *(const f32x4*)(pp + ch) : zero4; fr[j] = z + (p - z) * *(const f32x4*)(mu + ch); }
            km[j] = fk[j] * (1.0f + (av[j] - 1.0f) * *(const f32x4*)(A.in[I_KA] + l * 256 + ch)); bs += dot4(fr[j] * km[j], *(const f32x4*)(A.in[I_RK] + l * 256 + ch)); }
        bs += __shfl_xor(bs, 16); bs += __shfl_xor(bs, 32);
#pragma unroll
        for (int j = 0; j < 4; ++j) { const int ch = 16 * (4 * hd + j) + 4 * q4; const size_t o = (size_t)m * 256 + ch;
            f32x4 fv; { const f32x4 z = *(const f32x4*)(pr + 512 + ch); const f32x4 p = t ? *(const f32x4*)(pp + 512 + ch) : zero4; fv = z + (p - z) * *(const f32x4*)(mu + 512 + ch); }
            const f32x4 kk = fk[j] * *(const f32x4*)(A.in[I_KK] + l * 256 + ch) * inrm;
            *(f32x4*)(RWA + 0 * RWA_STRIDE + o) = fr[j]; *(f32x4*)(RWA + 2 * RWA_STRIDE + o) = km[j]; *(f32x4*)(RWA + 3 * RWA_STRIDE + o) = fv;
            *(f32x4*)(RWA + 4 * RWA_STRIDE + o) = -kk; *(f32x4*)(RWA + 5 * RWA_STRIDE + o) = kk * av[j]; *(f32x4*)(RWA + 7 * RWA_STRIDE + o) = bs * fv; }
    }
#pragma unroll 1
    for (int nb = 0; nb < 32; ++nb) {
        f32x4 cq = zero4;
#pragma unroll
        for (int ks = 0; ks < 4; ++ks) { const f16x8 aq = *(const f16x8*)(SW + SMW_QI + (16 * nb + arow) * 128 + 32 * ks + 8 * q4); cq = __builtin_amdgcn_mfma_f32_16x16x32_f16(aq, bc[ks], cq, 0, 0, 0); }
        const int ch = 16 * (nb & 15) + 4 * q4;
        if (nb < 16) {
            if ((nb & 3) == 0) { const f32x4 ot = shx4(cq, 32); const int fi = 4 * (q4 & 1); const f32x4 cs4 = *(const f32x4*)(RT + 64 + fi), sn = *(const f32x4*)(RT + 72 + fi); cq = (q4 < 2) ? cq * cs4 - ot * sn : ot * sn + cq * cs4; }
            const f32x4 qs = cq * 0.18033688011112042f; v2u o; o.x = pk2(qs.x, qs.y); o.y = pk2(qs.z, qs.w); *(v2u*)((bf16*)(A.ws + WS_DQ) + (size_t)m * 256 + ch) = o;
        } else {
            if ((nb & 1) == 0) { const f32x4 ot = shx4(cq, 16); const f32x4 cs4 = *(const f32x4*)(RT + 80), sn = *(const f32x4*)(RT + 84); if (q4 < 2) cq = (q4 < 1) ? cq * cs4 - ot * sn : ot * sn + cq * cs4; }
            h4v hq; hq.x = (_Float16)cq.x; hq.y = (_Float16)cq.y; hq.z = (_Float16)cq.z; hq.w = (_Float16)cq.w; *(h4v*)((_Float16*)(A.ws + WS_DQI) + (size_t)m * 256 + ch) = hq;
        }
    }
#pragma unroll
    for (int j = 0; j < 4; ++j) { const int d = 16 * j + 4 * q4; f32x4 kx = *(const f32x4*)(pd + 128 + d);
        if (j == 0) { const f32x4 ot = shx4(kx, 32); const int fi = 4 * (q4 & 1); const f32x4 cs4 = *(const f32x4*)(RT + 64 + fi), sn = *(const f32x4*)(RT + 72 + fi); kx = (q4 < 2) ? kx * cs4 - ot * sn : ot * sn + kx * cs4; }
        v2u o; o.x = pk2(kx.x, kx.y); o.y = pk2(kx.z, kx.w); *(v2u*)((bf16*)(A.ws + WS_DKB) + (size_t)m * 64 + d) = o;
        const f32x4 vx = *(const f32x4*)(pd + 192 + d); v2u ov; ov.x = pk2(vx.x, vx.y); ov.y = pk2(vx.z, vx.w); *(v2u*)((bf16*)(A.ws + WS_DVB) + (size_t)m * 64 + d) = ov; }
#pragma unroll
    for (int j = 0; j < 2; ++j) { const int d = 16 * j + 4 * q4; f32x4 ki = *(const f32x4*)(pd + 256 + d);
        if (j == 0) { const f32x4 ot = shx4(ki, 16); const f32x4 cs4 = *(const f32x4*)(RT + 80), sn = *(const f32x4*)(RT + 84); if (q4 < 2) ki = (q4 < 1) ? ki * cs4 - ot * sn : ot * sn + ki * cs4; }
        h4v hk; hk.x = (_Float16)ki.x; hk.y = (_Float16)ki.y; hk.z = (_Float16)ki.z; hk.w = (_Float16)ki.w; *(h4v*)((_Float16*)(A.ws + WS_DKI) + (size_t)m * 32 + d) = hk; }
    if (q4 < 2) *(f32x4*)((float*)(A.ws + WS_DW) + (size_t)m * 8 + 4 * q4) = *(const f32x4*)(pd + 288 + 4 * q4) * 0.0625f;
}
__device__ __forceinline__ float quad_sum(float v) {
    v += __builtin_bit_cast(float, __builtin_amdgcn_mov_dpp(__builtin_bit_cast(int, v), 0xB1, 0xF, 0xF, true));
    v += __builtin_bit_cast(float, __builtin_amdgcn_mov_dpp(__builtin_bit_cast(int, v), 0x4E, 0xF, 0xF, true));
    return v;
}
__device__ __forceinline__ float oct_sum(float v) {
    v += __builtin_bit_cast(float, __builtin_amdgcn_mov_dpp(__builtin_bit_cast(int, v), 0xB1, 0xF, 0xF, true));
    v += __builtin_bit_cast(float, __builtin_amdgcn_mov_dpp(__builtin_bit_cast(int, v), 0x4E, 0xF, 0xF, true));
    v += __builtin_bit_cast(float, __builtin_amdgcn_mov_dpp(__builtin_bit_cast(int, v), 0x141, 0xF, 0xF, true));
    return v;
}
#define RW_LOAD(op, s_) do { const int lo_ = (s_) * 64 + kq * 8; \
    op[0] = *(const LAS f32x4*)(sn + lo_); op[1] = *(const LAS f32x4*)(sn + lo_ + 4); op[2] = *(const LAS f32x4*)(sw + lo_); op[3] = *(const LAS f32x4*)(sw + lo_ + 4); \
    op[4] = *(const LAS f32x4*)(sb + lo_); op[5] = *(const LAS f32x4*)(sb + lo_ + 4); op[6] = *(const LAS f32x4*)(sk + lo_); op[7] = *(const LAS f32x4*)(sk + lo_ + 4); \
    op[8] = *(const LAS f32x4*)(sr + lo_); op[9] = *(const LAS f32x4*)(sr + lo_ + 4); \
    _Pragma("unroll") for (int i_ = 0; i_ < 4; ++i_) vin[i_] = (ws < 2) ? sv[(s_) * 64 + rbase + 8 * i_] : 0.0f; } while (0)
#define RW_STEP(op, vv, s_) do { float sa_[4], y_[4]; \
    _Pragma("unroll") for (int i_ = 0; i_ < 4; ++i_) sa_[i_] = (S[i_][0] * op[0].x + S[i_][1] * op[0].y) + (S[i_][2] * op[0].z + S[i_][3] * op[0].w) + ((S[i_][4] * op[1].x + S[i_][5] * op[1].y) + (S[i_][6] * op[1].z + S[i_][7] * op[1].w)); \
    _Pragma("unroll") for (int i_ = 0; i_ < 4; ++i_) sa_[i_] += __builtin_bit_cast(float, __builtin_amdgcn_mov_dpp(__builtin_bit_cast(int, sa_[i_]), 0xB1, 0xF, 0xF, true)); \
    _Pragma("unroll") for (int i_ = 0; i_ < 4; ++i_) sa_[i_] += __builtin_bit_cast(float, __builtin_amdgcn_mov_dpp(__builtin_bit_cast(int, sa_[i_]), 0x4E, 0xF, 0xF, true)); \
    _Pragma("unroll") for (int i_ = 0; i_ < 4; ++i_) sa_[i_] += __builtin_bit_cast(float, __builtin_amdgcn_mov_dpp(__builtin_bit_cast(int, sa_[i_]), 0x141, 0xF, 0xF, true)); \
    _Pragma("unroll") for (int i_ = 0; i_ < 4; ++i_) { const float v_ = vv[i_]; \
        S[i_][0] = S[i_][0] * op[2].x + (sa_[i_] * op[4].x + v_ * op[6].x); S[i_][1] = S[i_][1] * op[2].y + (sa_[i_] * op[4].y + v_ * op[6].y); S[i_][2] = S[i_][2] * op[2].z + (sa_[i_] * op[4].z + v_ * op[6].z); S[i_][3] = S[i_][3] * op[2].w + (sa_[i_] * op[4].w + v_ * op[6].w); \
        S[i_][4] = S[i_][4] * op[3].x + (sa_[i_] * op[5].x + v_ * op[7].x); S[i_][5] = S[i_][5] * op[3].y + (sa_[i_] * op[5].y + v_ * op[7].y); S[i_][6] = S[i_][6] * op[3].z + (sa_[i_] * op[5].z + v_ * op[7].z); S[i_][7] = S[i_][7] * op[3].w + (sa_[i_] * op[5].w + v_ * op[7].w); } \
    _Pragma("unroll") for (int i_ = 0; i_ < 4; ++i_) y_[i_] = (S[i_][0] * op[8].x + S[i_][1] * op[8].y) + (S[i_][2] * op[8].z + S[i_][3] * op[8].w) + ((S[i_][4] * op[9].x + S[i_][5] * op[9].y) + (S[i_][6] * op[9].z + S[i_][7] * op[9].w)); \
    _Pragma("unroll") for (int i_ = 0; i_ < 4; ++i_) y_[i_] += __builtin_bit_cast(float, __builtin_amdgcn_mov_dpp(__builtin_bit_cast(int, y_[i_]), 0xB1, 0xF, 0xF, true)); \
    _Pragma("unroll") for (int i_ = 0; i_ < 4; ++i_) y_[i_] += __builtin_bit_cast(float, __builtin_amdgcn_mov_dpp(__builtin_bit_cast(int, y_[i_]), 0x4E, 0xF, 0xF, true)); \
    _Pragma("unroll") for (int i_ = 0; i_ < 4; ++i_) y_[i_] += __builtin_bit_cast(float, __builtin_amdgcn_mov_dpp(__builtin_bit_cast(int, y_[i_]), 0x141, 0xF, 0xF, true)); \
    if (kq == 0) { _Pragma("unroll") for (int i_ = 0; i_ < 4; ++i_) so[(s_) * 128 + rbase + 8 * i_] = y_[i_]; } } while (0)
__device__ __forceinline__ void scan_rwkv_task2(ARef A, const WI& w, int task0) {
    const int slot = w.wave >> 2, ws = w.wave & 3, lt = w.tid & 255, task = task0 + slot;
    const int bh = task >> 4, c = task & 15, b = bh >> 2, h = bh & 3;
    LAS float* sw = (LAS float*)w.lds + slot * 16384; LAS float* sn = sw + 2048; LAS float* sb = sn + 2048; LAS float* sk = sb + 2048; LAS float* sr = sk + 2048; LAS float* sv = sr + 2048; LAS float* so = sv + 2048;
    const float* RWA = (const float*)(A.ws + WS_RWA);
    const int rg = w.lane >> 3, kq = w.lane & 7, rbase = 32 * ws + rg;
    float S[4][8];
#pragma unroll
    for (int i = 0; i < 4; ++i)
#pragma unroll
        for (int j = 0; j < 8; ++j) { const int r = rbase + 8 * i; S[i][j] = (r >= 64 && 8 * kq + j == r - 64) ? 1.0f : 0.0f; }
    const size_t tok0 = (size_t)b * SEQ + (size_t)c * TCH;
    const int st = lt >> 3, sd = (lt & 7) * 8;
    f32x4 a[6][2];
#define RW_GLOAD(sub_) do { const size_t o_ = (tok0 + (sub_) * 32 + st) * 256 + h * 64 + sd; \
        _Pragma("unroll") for (int q = 0; q < 2; ++q) { a[0][q] = *(const f32x4*)(RWA + 1 * RWA_STRIDE + o_ + 4 * q); a[1][q] = *(const f32x4*)(RWA + 4 * RWA_STRIDE + o_ + 4 * q); a[2][q] = *(const f32x4*)(RWA + 5 * RWA_STRIDE + o_ + 4 * q); \
            a[3][q] = *(const f32x4*)(RWA + 2 * RWA_STRIDE + o_ + 4 * q); a[4][q] = *(const f32x4*)(RWA + 0 * RWA_STRIDE + o_ + 4 * q); a[5][q] = *(const f32x4*)(RWA + 3 * RWA_STRIDE + o_ + 4 * q); } } while (0)
    RW_GLOAD(0);
    for (int sub = 0; sub < TCH / 32; ++sub) {
        __syncthreads();
        { const int lo = st * 64 + sd;
#pragma unroll
          for (int q = 0; q < 2; ++q) { *(LAS f32x4*)(sw + lo + 4 * q) = a[0][q]; *(LAS f32x4*)(sn + lo + 4 * q) = a[1][q]; *(LAS f32x4*)(sb + lo + 4 * q) = a[2][q]; *(LAS f32x4*)(sk + lo + 4 * q) = a[3][q]; *(LAS f32x4*)(sr + lo + 4 * q) = a[4][q]; *(LAS f32x4*)(sv + lo + 4 * q) = a[5][q]; } }
        __syncthreads();
        if (sub + 1 < TCH / 32) RW_GLOAD(sub + 1);
        { f32x4 opA[10], opB[10]; float vin[4], vA[4], vB[4];
          RW_LOAD(opA, 0);
#pragma unroll
          for (int i = 0; i < 4; ++i) vA[i] = vin[i];
#pragma unroll 1
          for (int s = 0; s < 32; s += 2) {
              RW_LOAD(opB, s + 1);
#pragma unroll
              for (int i = 0; i < 4; ++i) vB[i] = vin[i];
              RW_STEP(opA, vA, s);
              if (s + 2 < 32) { RW_LOAD(opA, s + 2);
#pragma unroll
                  for (int i = 0; i < 4; ++i) vA[i] = vin[i]; }
              RW_STEP(opB, vB, s + 1);
          } }
        __syncthreads();
        { const int fs = lt >> 3, c16 = (lt & 7) * 16;
          float* dst = (c16 < 64) ? ((float*)(A.ws + WS_YO) + YO_STRIDE) : ((float*)(A.ws + WS_PT) - 64);
          float* dp = dst + (tok0 + sub * 32 + fs) * 256 + h * 64 + c16;
#pragma unroll
          for (int q = 0; q < 4; ++q) *(f32x4*)(dp + 4 * q) = *(const LAS f32x4*)(so + fs * 128 + c16 + 4 * q); }
    }
    { float* ch = (float*)(A.ws + WS_CH) + ((size_t)(bh * NCH + c) * 128) * 64 + 8 * kq;
#pragma unroll
      for (int i = 0; i < 4; ++i) { float* cr = ch + (size_t)(rbase + 8 * i) * 64; *(f32x4*)cr = (f32x4){S[i][0], S[i][1], S[i][2], S[i][3]}; *(f32x4*)(cr + 4) = (f32x4){S[i][4], S[i][5], S[i][6], S[i][7]}; } }
    __syncthreads();
}
#undef RW_LOAD
#undef RW_STEP
#undef RW_GLOAD
__device__ __forceinline__ void scan_ret_task(ARef A, const WI& w, int task) {
    const int bh = task >> 3, cp = task & 7, b = bh >> 2, h = bh & 3, un = w.tid >> 8, lt = w.tid & 255, c = 2 * cp + un;
    const float lg2g = log2f(1.0f - exp2f(-5.0f - (float)h)), gamma = exp2f(lg2g);
    LAS float* sk = (LAS float*)w.lds + un * 8192; LAS float* sq = sk + 2048; LAS float* sv = sq + 2048; LAS float* so = sv + 2048;
    const bf16* PB = (const bf16*)(A.ws + WS_PB); const float* RT = (const float*)(A.ws + WS_ROPE);
    const int row = lt >> 2, kq = lt & 3;
    float S[16];
#pragma unroll
    for (int j = 0; j < 16; ++j) S[j] = 0.0f;
    const size_t tok0 = (size_t)b * SEQ + (size_t)c * TCH;
    const int st = lt >> 3, sd = (lt & 7) * 8;
    const int fi = sd & 31, dp = sd ^ 32;
    f32x4 gq[2], gqo[2], gk[2], gko[2], gv[2], gcs[2], gsn[2];
#define BF8_TO_F32(dst, x_) do { dst[0] = (f32x4){bf_lo(x_.x), bf_hi(x_.x), bf_lo(x_.y), bf_hi(x_.y)}; dst[1] = (f32x4){bf_lo(x_.z), bf_hi(x_.z), bf_lo(x_.w), bf_hi(x_.w)}; } while (0)
#define RT_GLOAD(sub_) do { const size_t m_ = tok0 + (sub_) * 32 + st; const bf16* pr_ = PB + m_ * PBW + h * 64; const float* rt_ = RT + m_ * ROPE_W; \
        _Pragma("unroll") for (int u = 0; u < 2; ++u) { gcs[u] = *(const f32x4*)(rt_ + fi + 4 * u); gsn[u] = *(const f32x4*)(rt_ + 32 + fi + 4 * u); } \
        { const v4u x0 = *(const v4u*)(pr_ + sd), x1 = *(const v4u*)(pr_ + dp), x2 = *(const v4u*)(pr_ + 256 + sd), x3 = *(const v4u*)(pr_ + 256 + dp), x4 = *(const v4u*)(pr_ + 512 + sd); \
          BF8_TO_F32(gq, x0); BF8_TO_F32(gqo, x1); BF8_TO_F32(gk, x2); BF8_TO_F32(gko, x3); BF8_TO_F32(gv, x4); } } while (0)
    RT_GLOAD(0);
    for (int sub = 0; sub < TCH / 32; ++sub) {
        const size_t m = tok0 + sub * 32 + st;
        f32x4 qn[2], kn[2], vn[2];
#pragma unroll
        for (int u = 0; u < 2; ++u) { qn[u] = (sd < 32) ? gq[u] * gcs[u] - gqo[u] * gsn[u] : gqo[u] * gsn[u] + gq[u] * gcs[u]; kn[u] = (sd < 32) ? gk[u] * gcs[u] - gko[u] * gsn[u] : gko[u] * gsn[u] + gk[u] * gcs[u]; vn[u] = gv[u]; }
        { const float gt = exp2f(lg2g * (float)(sub * 32 + st + 1)); const f32x4 p0 = qn[0] * gt, p1 = qn[1] * gt;
          v4u pw; pw.x = pk2(p0.x, p0.y); pw.y = pk2(p0.z, p0.w); pw.z = pk2(p1.x, p1.y); pw.w = pk2(p1.z, p1.w); *(v4u*)((bf16*)(A.ws + WS_PTR) + m * 256 + h * 64 + sd) = pw; }
        __syncthreads();
        { const int lo = st * 64 + sd; *(LAS f32x4*)(sq + lo) = qn[0]; *(LAS f32x4*)(sq + lo + 4) = qn[1]; *(LAS f32x4*)(sk + lo) = kn[0]; *(LAS f32x4*)(sk + lo + 4) = kn[1]; *(LAS f32x4*)(sv + lo) = vn[0]; *(LAS f32x4*)(sv + lo + 4) = vn[1]; }
        __syncthreads();
        if (sub + 1 < TCH / 32) RT_GLOAD(sub + 1);
        for (int s = 0; s < 32; ++s) {
            const int lo = s * 64 + kq * 16; const float vv = sv[s * 64 + row]; float y = 0.0f;
#pragma unroll
            for (int j4 = 0; j4 < 4; ++j4) { const f32x4 kv = *(const LAS f32x4*)(sk + lo + 4 * j4), rv = *(const LAS f32x4*)(sq + lo + 4 * j4);
                S[4 * j4] = S[4 * j4] * gamma + vv * kv.x; S[4 * j4 + 1] = S[4 * j4 + 1] * gamma + vv * kv.y; S[4 * j4 + 2] = S[4 * j4 + 2] * gamma + vv * kv.z; S[4 * j4 + 3] = S[4 * j4 + 3] * gamma + vv * kv.w;
                y += (S[4 * j4] * rv.x + S[4 * j4 + 1] * rv.y) + (S[4 * j4 + 2] * rv.z + S[4 * j4 + 3] * rv.w); }
            y = quad_sum(y);
            if (kq == 0) so[s * 64 + row] = y;
        }
        __syncthreads();
        { const int fs = lt >> 3, c8 = (lt & 7) * 8; float* dp2 = (float*)(A.ws + WS_YO) + (tok0 + sub * 32 + fs) * 256 + h * 64 + c8;
          *(f32x4*)dp2 = *(const LAS f32x4*)(so + fs * 64 + c8); *(f32x4*)(dp2 + 4) = *(const LAS f32x4*)(so + fs * 64 + c8 + 4); }
    }
    { float* ch = (float*)(A.ws + WS_CHR) + ((size_t)(bh * NCH + c) * 64 + row) * 64 + 16 * kq;
#pragma unroll
      for (int j4 = 0; j4 < 4; ++j4) *(f32x4*)(ch + 4 * j4) = (f32x4){S[4 * j4], S[4 * j4 + 1], S[4 * j4 + 2], S[4 * j4 + 3]}; }
    __syncthreads();
}
#undef RT_GLOAD
#undef BF8_TO_F32
__device__ __forceinline__ void prefix_chain(ARef A, const WI& w, int bh) {
    LAS float* s0 = (LAS float*)w.lds;
    const int v = w.tid >> 3, k8 = (w.tid & 7) * 8;
    const float* CH = (const float*)(A.ws + WS_CH) + (size_t)bh * NCH * 128 * 64; float* SI = (float*)(A.ws + WS_SI) + (size_t)bh * NCH * 64 * 64;
    f32x4 c0 = {0.f, 0.f, 0.f, 0.f}, c1 = {0.f, 0.f, 0.f, 0.f};
    for (int c = 0; c < NCH; ++c) {
        *(f32x4*)(SI + ((size_t)c * 64 + v) * 64 + k8) = c0; *(f32x4*)(SI + ((size_t)c * 64 + v) * 64 + k8 + 4) = c1;
        if (c == NCH - 1) break;
        __syncthreads();
        *(LAS f32x4*)(s0 + v * 68 + k8) = c0; *(LAS f32x4*)(s0 + v * 68 + k8 + 4) = c1;
        __syncthreads();
        const float* ch = CH + (size_t)c * 128 * 64;
        f32x4 n0 = *(const f32x4*)(ch + (size_t)v * 64 + k8), n1 = *(const f32x4*)(ch + (size_t)v * 64 + k8 + 4);
#pragma unroll 8
        for (int kp = 0; kp < 64; ++kp) { const float s = s0[v * 68 + kp]; const float* pr = ch + (size_t)(64 + kp) * 64 + k8; n0 += s * *(const f32x4*)pr; n1 += s * *(const f32x4*)(pr + 4); }
        c0 = n0; c1 = n1;
    }
    const int h = bh & 3; const float gT = exp2f((float)TCH * log2f(1.0f - exp2f(-5.0f - (float)h)));
    const float* CHR = (const float*)(A.ws + WS_CHR) + (size_t)bh * NCH * 64 * 64; float* SIR = (float*)(A.ws + WS_SIR) + (size_t)bh * NCH * 64 * 64;
    c0 = (f32x4){0.f, 0.f, 0.f, 0.f}; c1 = c0;
    for (int c = 0; c < NCH; ++c) {
        *(f32x4*)(SIR + ((size_t)c * 64 + v) * 64 + k8) = c0; *(f32x4*)(SIR + ((size_t)c * 64 + v) * 64 + k8 + 4) = c1;
        if (c == NCH - 1) break;
        c0 = c0 * gT + *(const f32x4*)(CHR + ((size_t)c * 64 + v) * 64 + k8); c1 = c1 * gT + *(const f32x4*)(CHR + ((size_t)c * 64 + v) * 64 + k8 + 4);
    }
    __syncthreads();
}
typedef float f32x16 __attribute__((ext_vector_type(16)));
constexpr int SBV_PITCH = 144;
__device__ __forceinline__ float lane32_swap(float v) { return __shfl_xor(v, 32); }
__device__ __forceinline__ void sb_tile_mfma(ARef A, int unit, int lane, LAS unsigned char* vl) {
    const int tq = unit & 127, bh = unit >> 7, b = bh >> 2, h = bh & 3, t0 = tq * 32, r32 = lane & 31, hi = lane >> 5;
    const bf16* PS = (const bf16*)(A.ws + WS_PB) + (size_t)b * SEQ * PBW + PB_SB + h * 64;
    bf16x8v qf[4];
#pragma unroll
    for (int ks = 0; ks < 4; ++ks) qf[ks] = *(const bf16x8v*)(PS + (size_t)(t0 + r32) * PBW + 16 * ks + 8 * hi);
    f32x16 o0, o1;
#pragma unroll
    for (int r = 0; r < 16; ++r) { o0[r] = 0.0f; o1[r] = 0.0f; }
    float carry = 0.0f;
    const int g16 = lane >> 4, tj = (lane & 15) >> 2, tc = lane & 3;
    for (int kb0 = t0; kb0 >= 0; kb0 -= 32) {
#pragma unroll
        for (int i = 0; i < 4; ++i) { const int p = lane + 64 * i, row = p >> 3, ch = p & 7; const v4u v = *(const v4u*)(PS + 512 + (size_t)(kb0 + row) * PBW + 8 * ch); *(LAS v4u*)(vl + row * SBV_PITCH + 16 * ch) = v; }
        f32x16 st;
#pragma unroll
        for (int r = 0; r < 16; ++r) st[r] = 0.0f;
        { bf16x8v ka[4];
#pragma unroll
          for (int ks = 0; ks < 4; ++ks) ka[ks] = *(const bf16x8v*)(PS + 256 + (size_t)(kb0 + r32) * PBW + 16 * ks + 8 * hi);
#pragma unroll
          for (int ks = 0; ks < 4; ++ks) st = __builtin_amdgcn_mfma_f32_32x32x16_bf16(ka[ks], qf[ks], st, 0, 0, 0);
          asm volatile("" :: "v"(ka[0]), "v"(ka[1]), "v"(ka[2]), "v"(ka[3]), "v"(st)); }
        float sp[16]; const bool diag = (kb0 == t0);
#pragma unroll
        for (int r = 0; r < 16; ++r) { const float zl = st[r]; float s = (zl > 30.0f) ? zl : __builtin_amdgcn_logf(1.0f + __builtin_amdgcn_exp2f(zl));
            if (diag && ((r & 3) + 8 * (r >> 2) + 4 * hi >= r32)) s = 0.0f;
            sp[r] = s; }
        float G[4], Gp[4], suf[4];
#pragma unroll
        for (int q = 0; q < 4; ++q) { G[q] = (sp[4 * q] + sp[4 * q + 1]) + (sp[4 * q + 2] + sp[4 * q + 3]); Gp[q] = lane32_swap(G[q]); }
        suf[3] = 0.0f; suf[2] = G[3] + Gp[3]; suf[1] = suf[2] + (G[2] + Gp[2]); suf[0] = suf[1] + (G[1] + Gp[1]);
        const float tot = suf[0] + (G[0] + Gp[0]);
        pg8::u32x4 pw0, pw1;
        float av[16];
#pragma unroll
        for (int q = 0; q < 4; ++q) { float run = carry + suf[q] + (hi == 0 ? Gp[q] : 0.0f);
#pragma unroll
            for (int i = 3; i >= 0; --i) { const int r = 4 * q + i; const float la = (st[r] - sp[r]) - run; float a = __builtin_amdgcn_exp2f(la);
                if (diag && ((r & 3) + 8 * (r >> 2) + 4 * hi >= r32)) a = 0.0f;
                av[r] = a; run += sp[r]; } }
        pw0.x = pg8::cvt_pk_bf16(av[0], av[1]); pw0.y = pg8::cvt_pk_bf16(av[2], av[3]); pw0.z = pg8::cvt_pk_bf16(av[4], av[5]); pw0.w = pg8::cvt_pk_bf16(av[6], av[7]);
        pw1.x = pg8::cvt_pk_bf16(av[8], av[9]); pw1.y = pg8::cvt_pk_bf16(av[10], av[11]); pw1.z = pg8::cvt_pk_bf16(av[12], av[13]); pw1.w = pg8::cvt_pk_bf16(av[14], av[15]);
        const bf16x8v pa0 = __builtin_bit_cast(bf16x8v, pw0), pa1 = __builtin_bit_cast(bf16x8v, pw1);
        LDS_WAIT();
#pragma unroll
        for (int s = 0; s < 2; ++s)
#pragma unroll
            for (int nb = 0; nb < 2; ++nb) {
                LAS unsigned char* a1 = vl + (16 * s + 4 * (g16 >> 1) + tj) * SBV_PITCH + (32 * nb + 16 * (g16 & 1) + 4 * tc) * 2;
                const s16x4v r1 = __builtin_bit_cast(s16x4v, __builtin_amdgcn_ds_read_tr16_b64_v4i16((LAS s16x4v*)a1));
                const s16x4v r2 = __builtin_bit_cast(s16x4v, __builtin_amdgcn_ds_read_tr16_b64_v4i16((LAS s16x4v*)(a1 + 8 * SBV_PITCH)));
                const bf16x8v bv = {r1[0], r1[1], r1[2], r1[3], r2[0], r2[1], r2[2], r2[3]};
                if (nb == 0) o0 = __builtin_amdgcn_mfma_f32_32x32x16_bf16(s ? pa1 : pa0, bv, o0, 0, 0, 0); else o1 = __builtin_amdgcn_mfma_f32_32x32x16_bf16(s ? pa1 : pa0, bv, o1, 0, 0, 0);
                asm volatile("" :: "v"(bv), "v"(pa0), "v"(pa1), "v"(o0), "v"(o1)); }
        LDS_WAIT();
        carry += tot;
        if (__all(carry > 150.0f)) break;
    }
    float* YS = (float*)(A.ws + WS_YO) + 3 * YO_STRIDE + ((size_t)b * SEQ + t0) * 256 + h * 64 + r32;
#pragma unroll
    for (int r = 0; r < 16; ++r) { const int qo = (r & 3) + 8 * (r >> 2) + 4 * hi; YS[(size_t)qo * 256] = o0[r]; YS[(size_t)qo * 256 + 32] = o1[r]; }
}

__device__ __forceinline__ void dsa_scores_mfma(ARef A, const WI& w) {
    const _Float16* QIH = (const _Float16*)(A.ws + WS_DQI); const _Float16* KIH = (const _Float16*)(A.ws + WS_DKI);
    const float* DW = (const float*)(A.ws + WS_DW); float* SC = (float*)(A.ws + WS_SC);
    const int col = w.lane & 15, q4 = w.lane >> 4;
    for (int u = w.gw; u < 2048; u += w.NGW) {
        const int pi = u >> 1, par = u & 1, b = pi >> 7, p = pi & 127;
#pragma unroll 1
        for (int side = 0; side < 2; ++side) {
            const int qb = side ? 255 - p : p; const size_t m0 = (size_t)b * SEQ + 16 * qb;
            f16x8 bq[8];
#pragma unroll
            for (int h = 0; h < 8; ++h) bq[h] = *(const f16x8*)(QIH + (m0 + col) * 256 + h * 32 + 8 * q4);
            const float* dw = DW + (m0 + col) * 8; const f32x4 wa = *(const f32x4*)dw, wb = *(const f32x4*)(dw + 4);
            float* srow = SC + (m0 + col) * SEQ + 4 * q4;
            const _Float16* kbase = KIH + ((size_t)b * SEQ + col) * 32 + 8 * q4;
            for (int kb = par; kb <= qb; kb += 2) {
                const f16x8 ak = *(const f16x8*)(kbase + (size_t)kb * 16 * 32);
                f32x4 acc = {0.f, 0.f, 0.f, 0.f};
#pragma unroll
                for (int h = 0; h < 8; ++h) { const f32x4 c = __builtin_amdgcn_mfma_f32_16x16x32_f16(ak, bq[h], (f32x4){0.f, 0.f, 0.f, 0.f}, 0, 0, 0); const float wv = (h < 4) ? wa[h] : wb[h - 4];
                    acc.x += wv * fmaxf(c.x, 0.f); acc.y += wv * fmaxf(c.y, 0.f); acc.z += wv * fmaxf(c.z, 0.f); acc.w += wv * fmaxf(c.w, 0.f); }
                *(f32x4*)(srow + 16 * kb) = acc + 0.0f;
            }
        }
    }
}

__device__ __forceinline__ int wave_total_i(int v) {
    v += __builtin_amdgcn_mov_dpp(v, 0xB1, 0xF, 0xF, true);
    v += __builtin_amdgcn_mov_dpp(v, 0x4E, 0xF, 0xF, true);
    v += __builtin_amdgcn_mov_dpp(v, 0x141, 0xF, 0xF, true);
    v += __builtin_amdgcn_mov_dpp(v, 0x140, 0xF, 0xF, true);
    return __builtin_amdgcn_readlane(v, 0) + __builtin_amdgcn_readlane(v, 16) + __builtin_amdgcn_readlane(v, 32) + __builtin_amdgcn_readlane(v, 48);
}
__device__ __forceinline__ unsigned score_key(float f) { const unsigned bits = __float_as_uint(f); return (bits & 0x80000000u) ? ~bits : (bits | 0x80000000u); }
constexpr int VST_PITCH = 144;
typedef unsigned short u16;
__device__ __forceinline__ void dsa_load_scores(ARef A, int m, int lane, f32x4 (&sv)[16]) {
    const int n = (m & (SEQ - 1)) + 1; const float* sc = (const float*)(A.ws + WS_SC) + (size_t)m * SEQ;
#pragma unroll
    for (int j4 = 0; j4 < 16; ++j4) sv[j4] = *(const f32x4*)(sc + ((256 * j4 < n) ? 256 * j4 : 0) + 4 * lane);
}
__device__ __forceinline__ void dsa_select(ARef A, int m, int n, int lane_in, LAS u16* slist, LAS unsigned* bk) {
    int lane = lane_in; asm volatile("" : "+v"(lane));
    if (n <= 256) {
#pragma unroll
        for (int c = 0; c < 4; ++c) { const int idx = lane + 64 * c; slist[idx] = (u16)((idx < n) ? idx : 0); }
        return;
    }
    f32x4 sv[16]; dsa_load_scores(A, m, lane, sv);
    unsigned u[64];
#pragma unroll
    for (int j4 = 0; j4 < 16; ++j4)
#pragma unroll
        for (int i = 0; i < 4; ++i) u[4 * j4 + i] = (256 * j4 + 4 * lane + i < n) ? score_key(sv[j4][i]) : 0u;
    unsigned T = 0u;
    for (int bit = 31; bit >= 16; --bit) { const unsigned cand = T | (1u << bit); int cnt = 0;
#pragma unroll
        for (int j = 0; j < 64; ++j) cnt += (u[j] >= cand) ? 1 : 0;
        if (wave_total_i(cnt) >= 256) T = cand; }
    unsigned long long bkb = 0ull; int chi = 0;
#pragma unroll
    for (int j = 0; j < 64; ++j) { bkb |= (unsigned long long)(((u[j] >> 16) == (T >> 16)) ? 1u : 0u) << j; chi += ((u[j] >> 16) > (T >> 16)) ? 1 : 0; }
    const int cb = wave_total_i(__popcll(bkb)), need = 256 - wave_total_i(chi);
    if (cb <= 64) {
        int pos = __popcll(bkb);
        { const int mine_ = pos;
#pragma unroll
          for (int d = 1; d < 64; d <<= 1) { const int y = __shfl_up(pos, d); if (lane >= d) pos += y; }
          pos -= mine_; }
#pragma unroll
        for (int j = 0; j < 64; ++j) { if ((bkb >> j) & 1ull) { bk[pos] = u[j]; ++pos; } }
        LDS_WAIT();
        const unsigned kx = (lane < cb) ? bk[lane] : 0u;
        for (int bit = 15; bit >= 0; --bit) { const unsigned cand = T | (1u << bit); if (__popcll(__ballot(kx >= cand)) >= need) T = cand; }
        LDS_WAIT();
    } else {
        for (int bit = 15; bit >= 0; --bit) { const unsigned cand = T | (1u << bit); int cnt = 0;
#pragma unroll
            for (int j = 0; j < 64; ++j) cnt += (u[j] >= cand) ? 1 : 0;
            if (wave_total_i(cnt) >= 256) T = cand; }
    }
    unsigned long long gtb = 0ull, eqb = 0ull;
#pragma unroll
    for (int j = 0; j < 64; ++j) { gtb |= (unsigned long long)((u[j] > T) ? 1u : 0u) << j; eqb |= (unsigned long long)((u[j] == T) ? 1u : 0u) << j; }
    const int tgt = wave_total_i(__popcll(gtb)), teq = wave_total_i(__popcll(eqb));
    unsigned long long selb = gtb | eqb;
    if (tgt + teq > 256) {
        const int take = 256 - tgt; int lo = 0;
        for (int bit = 11; bit >= 0; --bit) { const int cand = lo | (1 << bit); const int J4 = cand >> 8; int ni = (cand & 255) - 4 * lane; ni = ni < 0 ? 0 : (ni > 4 ? 4 : ni);
            const int jc = 4 * J4 + ni; const unsigned long long msk = (jc >= 64) ? ~0ull : ((1ull << jc) - 1ull);
            if (wave_total_i(__popcll(eqb & msk)) < take) lo = cand; }
        { const int cand = lo + 1; const int J4 = cand >> 8; int ni = (cand & 255) - 4 * lane; ni = ni < 0 ? 0 : (ni > 4 ? 4 : ni);
          const int jc = (cand >= SEQ) ? 64 : 4 * J4 + ni; const unsigned long long msk = (jc >= 64) ? ~0ull : ((1ull << jc) - 1ull); selb = gtb | (eqb & msk); }
    }
    const int mine = __popcll(selb); int off = mine;
#pragma unroll
    for (int d = 1; d < 64; d <<= 1) { const int y = __shfl_up(off, d); if (lane >= d) off += y; }
    off -= mine;
    while (selb) { const int j = __builtin_ctzll(selb); selb &= selb - 1ull; slist[off] = (u16)(256 * (j >> 2) + 4 * lane + (j & 3)); ++off; }
}
__device__ __forceinline__ void dsa_attend(ARef A, int m, int lane_in, const LAS u16* slist, LAS unsigned char* vbuf) {
    int lane = lane_in; asm volatile("" : "+v"(lane));
    const int b = m >> 12, t = m & (SEQ - 1), n = t + 1, nsel = n < 256 ? n : 256, col = lane & 15, q4 = lane >> 4;
    const bf16* DKB = (const bf16*)(A.ws + WS_DKB) + (size_t)b * SEQ * 64; const bf16* DVB = (const bf16*)(A.ws + WS_DVB) + (size_t)b * SEQ * 64;
    const int vrow = lane >> 3, vpc = lane & 7;
    bf16x8v bq0 = {0, 0, 0, 0, 0, 0, 0, 0}, bq1 = {0, 0, 0, 0, 0, 0, 0, 0};
    if (col < 4) { const bf16* qp = (const bf16*)(A.ws + WS_DQ) + (size_t)m * 256 + col * 64 + 8 * q4; bq0 = *(const bf16x8v*)qp; bq1 = *(const bf16x8v*)(qp + 32); }
    f32x4 lg[16];
#pragma unroll
    for (int hb = 0; hb < 4; ++hb) {
        bf16x8v a0[4], a1[4];
#pragma unroll
        for (int k = 0; k < 4; ++k) { const int s = slist[16 * (4 * hb + k) + col]; const bf16* kr = DKB + (size_t)s * 64 + 8 * q4; a0[k] = *(const bf16x8v*)kr; a1[k] = *(const bf16x8v*)(kr + 32); }
#pragma unroll
        for (int k = 0; k < 4; ++k) { const f32x4 c = __builtin_amdgcn_mfma_f32_16x16x32_bf16(a0[k], bq0, (f32x4){0.f, 0.f, 0.f, 0.f}, 0, 0, 0); lg[4 * hb + k] = __builtin_amdgcn_mfma_f32_16x16x32_bf16(a1[k], bq1, c, 0, 0, 0); }
        __builtin_amdgcn_sched_barrier(0);
    }
    if (nsel < 256) {
#pragma unroll
        for (int kb = 0; kb < 16; ++kb)
#pragma unroll
            for (int r = 0; r < 4; ++r) if (16 * kb + 4 * q4 + r >= nsel) lg[kb][r] = -INFINITY; }
    v4u vr[4];
#pragma unroll
    for (int i = 0; i < 4; ++i) { const int s = slist[vrow + 8 * i]; vr[i] = *(const v4u*)(DVB + (size_t)s * 64 + 8 * vpc); }
    float mx = -INFINITY;
#pragma unroll
    for (int kb = 0; kb < 16; ++kb) mx = fmaxf(fmaxf(mx, fmaxf(lg[kb].x, lg[kb].y)), fmaxf(lg[kb].z, lg[kb].w));
    mx = fmaxf(mx, __shfl_xor(mx, 16)); mx = fmaxf(mx, __shfl_xor(mx, 32));
    float sm = 0.f;
#pragma unroll
    for (int kb = 0; kb < 16; ++kb) { lg[kb].x = __builtin_amdgcn_exp2f(lg[kb].x - mx); lg[kb].y = __builtin_amdgcn_exp2f(lg[kb].y - mx); lg[kb].z = __builtin_amdgcn_exp2f(lg[kb].z - mx); lg[kb].w = __builtin_amdgcn_exp2f(lg[kb].w - mx); sm += (lg[kb].x + lg[kb].y) + (lg[kb].z + lg[kb].w); }
    sm += __shfl_xor(sm, 16); sm += __shfl_xor(sm, 32);
    const float inv = 1.0f / sm;
    bf16x8v pa[8];
#pragma unroll
    for (int i = 0; i < 8; ++i) { const f32x4 x = lg[2 * i] * inv, y = lg[2 * i + 1] * inv;
        pg8::u32x4 wv; wv.x = pg8::cvt_pk_bf16(x.x, x.y); wv.y = pg8::cvt_pk_bf16(x.z, x.w); wv.z = pg8::cvt_pk_bf16(y.x, y.y); wv.w = pg8::cvt_pk_bf16(y.z, y.w);
        pa[i] = __builtin_bit_cast(bf16x8v, wv); }
    f32x4 o[4];
#pragma unroll
    for (int nb = 0; nb < 4; ++nb) o[nb] = (f32x4){0.f, 0.f, 0.f, 0.f};
    const int tj = col >> 2, tc = col & 3;
#pragma unroll
    for (int c = 0; c < 8; ++c) {
        LAS unsigned char* vb = vbuf + (c & 1) * (32 * VST_PITCH);
#pragma unroll
        for (int i = 0; i < 4; ++i) *(LAS v4u*)(vb + (vrow + 8 * i) * VST_PITCH + 16 * vpc) = vr[i];
        if (c < 7) {
#pragma unroll
            for (int i = 0; i < 4; ++i) { const int s = slist[32 * (c + 1) + vrow + 8 * i]; vr[i] = *(const v4u*)(DVB + (size_t)s * 64 + 8 * vpc); } }
        LDS_WAIT();
#pragma unroll
        for (int nb = 0; nb < 4; ++nb) {
            LAS unsigned char* a1 = vb + (4 * q4 + tj) * VST_PITCH + (16 * nb + 4 * tc) * 2;
            const s16x4v r1 = __builtin_bit_cast(s16x4v, __builtin_amdgcn_ds_read_tr16_b64_v4i16((LAS s16x4v*)a1));
            const s16x4v r2 = __builtin_bit_cast(s16x4v, __builtin_amdgcn_ds_read_tr16_b64_v4i16((LAS s16x4v*)(a1 + 16 * VST_PITCH)));
            const bf16x8v bv = {r1[0], r1[1], r1[2], r1[3], r2[0], r2[1], r2[2], r2[3]};
            o[nb] = __builtin_amdgcn_mfma_f32_16x16x32_bf16(pa[c], bv, o[nb], 0, 0, 0); }
    }
    LDS_WAIT();
    if (lane < 16) { float* YD = (float*)(A.ws + WS_YO) + 2 * YO_STRIDE + (size_t)m * 256;
#pragma unroll
        for (int nb = 0; nb < 4; ++nb) { YD[16 * nb + lane] = o[nb].x; YD[64 + 16 * nb + lane] = o[nb].y; YD[128 + 16 * nb + lane] = o[nb].z; YD[192 + 16 * nb + lane] = o[nb].w; } }
}
__device__ __forceinline__ int dsa_row_of(int i) { return (i & 1) ? (MTOK - 1 - (i >> 1)) : (i >> 1); }
__device__ __forceinline__ void dsa_wave(ARef A, const WI& w, LAS unsigned char* wl, int l) {
    LAS u16* lists = (LAS u16*)wl; LAS unsigned char* vbuf = wl + 4096; LAS unsigned* bk = (LAS unsigned*)vbuf;
    unsigned* head = (unsigned*)(A.ws + WS_CTL) + CW_DSAQ + 64 * l;
    for (;;) {
        int g = 0; if (w.lane == 0) g = (int)atomicAdd(head, 1u);
        g = __builtin_amdgcn_readfirstlane(g);
        if (g >= MTOK / 8) break;
#pragma unroll 1
        for (int r = 0; r < 8; ++r) { const int m = dsa_row_of(g + r * (MTOK / 8)), n = (m & (SEQ - 1)) + 1; dsa_select(A, m, n, w.lane, lists + r * 256, bk); }
        LDS_WAIT();
#pragma unroll 1
        for (int r = 0; r < 8; ++r) dsa_attend(A, dsa_row_of(g + r * (MTOK / 8)), w.lane, lists + r * 256, vbuf);
    }
}

__device__ __forceinline__ f32x4 head_norm4(f32x4 y, float eps, f32x4 g) {
    const float mean = grp16_sum(sum4(y)) * (1.0f / 64.0f); const f32x4 yc = y - mean;
    const float var = grp16_sum(dot4(yc, yc)) * (1.0f / 64.0f); return yc * (1.0f / sqrtf(var + eps)) * g;
}
template <bool BF> __device__ __forceinline__ f32x4 state_corr(const LAS float* sl, int hh, int r16, const void* pv) {
    const LAS float* r0 = sl + (hh * 64 + 4 * r16) * 64; const int x0 = (4 * r16) & 15;
    f32x4 out = {0.f, 0.f, 0.f, 0.f};
#pragma unroll 2
    for (int k8 = 0; k8 < 8; ++k8) {
        f32x4 pa, pb;
        if (BF) { const v4u x = ((const v4u*)pv)[k8]; pa = (f32x4){bf_lo(x.x), bf_hi(x.x), bf_lo(x.y), bf_hi(x.y)}; pb = (f32x4){bf_lo(x.z), bf_hi(x.z), bf_lo(x.w), bf_hi(x.w)}; }
        else { pa = ((const f32x4*)pv)[2 * k8]; pb = ((const f32x4*)pv)[2 * k8 + 1]; }
#pragma unroll
        for (int i = 0; i < 4; ++i) { const LAS float* rowp = r0 + i * 64; const int xs = (x0 + i) & 15;
            out[i] += dot4(*(const LAS f32x4*)(rowp + 4 * ((2 * k8) ^ xs)), pa) + dot4(*(const LAS f32x4*)(rowp + 4 * ((2 * k8 + 1) ^ xs)), pb); }
    }
    return out;
}
__device__ __forceinline__ void post_row(ARef A, int l, int m, int lane, const LAS float* slw, const LAS float* slr) {
    const float* YO = (const float*)(A.ws + WS_YO); const float* RWA = (const float*)(A.ws + WS_RWA);
    bf16* MX = (bf16*)(A.ws + WS_MIX) + (size_t)m * DM; const int c4 = 4 * lane, hh = lane >> 4, r16 = lane & 15; const size_t o = (size_t)m * 256 + c4;
    { f32x4 y = *(const f32x4*)(YO + o) + state_corr<true>(slr, hh, r16, (const bf16*)(A.ws + WS_PTR) + (size_t)m * 256 + hh * 64);
      y = head_norm4(y, 1e-5f, *(const f32x4*)(A.in[I_RETGN] + l * 256 + c4));
      const v2u gw_ = *(const v2u*)((const bf16*)(A.ws + WS_PB) + (size_t)m * PBW + 768 + c4); const f32x4 g = {bf_lo(gw_.x), bf_hi(gw_.x), bf_lo(gw_.y), bf_hi(gw_.y)};
#pragma unroll
      for (int i = 0; i < 4; ++i) y[i] *= g[i] * sigm(g[i]);
      v2u w; w.x = pk2(y.x, y.y); w.y = pk2(y.z, y.w); *(v2u*)(MX + c4) = w; }
    { f32x4 y = *(const f32x4*)(YO + YO_STRIDE + o) + state_corr<false>(slw, hh, r16, (const float*)(A.ws + WS_PT) + (size_t)m * 256 + hh * 64);
      y = head_norm4(y, 64e-5f, *(const f32x4*)(A.in[I_LN] + l * 256 + c4));
      y = (y + *(const f32x4*)(RWA + 7 * RWA_STRIDE + o)) * *(const f32x4*)(RWA + 6 * RWA_STRIDE + o);
      v2u w; w.x = pk2(y.x, y.y); w.y = pk2(y.z, y.w); *(v2u*)(MX + 256 + c4) = w; }
    { f32x4 y = *(const f32x4*)(YO + 2 * YO_STRIDE + o); const float r = 1.0f / sqrtf(wave_sum(dot4(y, y)) * (1.0f / 256.0f) + 1e-5f);
      y = y * r * *(const f32x4*)(A.in[I_DONORM] + l * 256 + c4);
      v2u w; w.x = pk2(y.x, y.y); w.y = pk2(y.z, y.w); *(v2u*)(MX + 512 + c4) = w; }
    { f32x4 y = *(const f32x4*)(YO + 3 * YO_STRIDE + o); const float r = 1.0f / sqrtf(wave_sum(dot4(y, y)) * (1.0f / 256.0f) + 1e-5f);
      y = y * r * *(const f32x4*)(A.in[I_SONORM] + l * 256 + c4);
      v2u w; w.x = pk2(y.x, y.y); w.y = pk2(y.z, y.w); *(v2u*)(MX + 768 + c4) = w; }
}
__device__ __forceinline__ void ph_post(ARef A, const WI& w, int l) {
    LAS float* slw = (LAS float*)w.lds; LAS float* slr = slw + 16384;
    for (int u = w.vcu; u < NB * NCH * 2; u += w.G) {
        const int b = u >> 5, c = (u >> 1) & 15, half = u & 1;
        __syncthreads();
        for (int e = w.tid; e < 4096; e += NWAVES * 64) { const int hh = e >> 10, v = (e >> 4) & 63, k4 = e & 15;
            const size_t src = ((size_t)((b * 4 + hh) * NCH + c) * 64 + v) * 64 + 4 * k4; const int dst = (hh * 64 + v) * 64 + 4 * (k4 ^ (v & 15));
            *(LAS f32x4*)(slw + dst) = *(const f32x4*)((const float*)(A.ws + WS_SI) + src); *(LAS f32x4*)(slr + dst) = *(const f32x4*)((const float*)(A.ws + WS_SIR) + src); }
        __syncthreads();
        const int tok0 = b * SEQ + c * TCH + half * 128 + w.wave * 16;
        for (int i = 0; i < 16; ++i) post_row(A, l, tok0 + i, w.lane, slw, slr);
    }
}

__device__ __forceinline__ float wave_max_f(float v) {
    v = fmaxf(v, __builtin_bit_cast(float, __builtin_amdgcn_mov_dpp(__builtin_bit_cast(int, v), 0xB1, 0xF, 0xF, true)));
    v = fmaxf(v, __builtin_bit_cast(float, __builtin_amdgcn_mov_dpp(__builtin_bit_cast(int, v), 0x4E, 0xF, 0xF, true)));
    v = fmaxf(v, __builtin_bit_cast(float, __builtin_amdgcn_mov_dpp(__builtin_bit_cast(int, v), 0x141, 0xF, 0xF, true)));
    v = fmaxf(v, __builtin_bit_cast(float, __builtin_amdgcn_mov_dpp(__builtin_bit_cast(int, v), 0x140, 0xF, 0xF, true)));
    const int iv = __builtin_bit_cast(int, v);
    return fmaxf(fmaxf(__builtin_bit_cast(float, __builtin_amdgcn_readlane(iv, 0)), __builtin_bit_cast(float, __builtin_amdgcn_readlane(iv, 16))), fmaxf(__builtin_bit_cast(float, __builtin_amdgcn_readlane(iv, 32)), __builtin_bit_cast(float, __builtin_amdgcn_readlane(iv, 48))));
}
__device__ __forceinline__ void router_stage(ARef A, const WI& w, int l) {
    LAS float* rwl = (LAS float*)w.lds; const float* rw = A.in[I_RW] + (size_t)l * DM * 32;
    for (int e = w.tid; e < DM * 8; e += NWAVES * 64) { const int k = e >> 3, c = e & 7; *(LAS f32x4*)(rwl + k * 32 + 4 * (c ^ ((k >> 2) & 7))) = *(const f32x4*)(rw + (size_t)k * 32 + 4 * c); }
    __syncthreads();
}
__device__ __forceinline__ void router_row(ARef A, int l, int m, int lane, LAS unsigned* hist, const LAS float* rwl, bool dry = false) {
    const float* XA = (const float*)(A.ws + WS_XA) + (size_t)m * DM; const float* MOD = (const float*)(A.ws + WS_MOD) + (size_t)(l * 8 + (m >> 12)) * 6144;
    f32x4 v[4]; float ss = 0.0f;
#pragma unroll
    for (int j = 0; j < 4; ++j) { v[j] = *(const f32x4*)(XA + 4 * (lane + 64 * j)); ss += dot4(v[j], v[j]); }
    ss = wave_sum(ss); const float rstd = 1.0f / sqrtf(ss * (1.0f / DM) + 1e-5f);
    const float* g = A.in[I_NFFN] + l * DM; const float* scp = MOD + 4 * 1024; const float* shp = MOD + 3 * 1024;
    emit_h_row(v, rstd, g, scp, shp, (bf16*)(A.ws + WS_H) + (size_t)m * DM, lane);
    float p[32];
#pragma unroll
    for (int e = 0; e < 32; ++e) p[e] = 0.0f;
    const int sw = lane & 7;
#pragma unroll 1
    for (int j = 0; j < 4; ++j) { const int k = 4 * (lane + 64 * j);
        const f32x4 h = *(const f32x4*)(XA + k) * rstd * *(const f32x4*)(g + k) * (1.0f + *(const f32x4*)(scp + k)) + *(const f32x4*)(shp + k);
        const LAS float* row = rwl + k * 32;
#pragma unroll
        for (int i = 0; i < 4; ++i) {
#pragma unroll
            for (int q4 = 0; q4 < 8; ++q4) { const f32x4 r = *(const LAS f32x4*)(row + i * 32 + 4 * (q4 ^ sw)); p[4 * q4] += h[i] * r.x; p[4 * q4 + 1] += h[i] * r.y; p[4 * q4 + 2] += h[i] * r.z; p[4 * q4 + 3] += h[i] * r.w; } } }
    float q16[16], q8[8], q4v[4], q2[2], q1;
    { const bool hb = (lane & 32) != 0;
#pragma unroll
      for (int i = 0; i < 16; ++i) { const float mine = hb ? p[16 + i] : p[i], oth = hb ? p[i] : p[16 + i]; q16[i] = mine + __shfl_xor(oth, 32); } }
    { const bool hb = (lane & 16) != 0;
#pragma unroll
      for (int i = 0; i < 8; ++i) { const float mine = hb ? q16[8 + i] : q16[i], oth = hb ? q16[i] : q16[8 + i]; q8[i] = mine + __shfl_xor(oth, 16); } }
    { const bool hb = (lane & 8) != 0;
#pragma unroll
      for (int i = 0; i < 4; ++i) { const float mine = hb ? q8[4 + i] : q8[i], oth = hb ? q8[i] : q8[4 + i]; q4v[i] = mine + __shfl_xor(oth, 8); } }
    { const bool hb = (lane & 4) != 0;
#pragma unroll
      for (int i = 0; i < 2; ++i) { const float mine = hb ? q4v[2 + i] : q4v[i], oth = hb ? q4v[i] : q4v[2 + i]; q2[i] = mine + __shfl_xor(oth, 4); } }
    { const bool hb = (lane & 2) != 0; const float mine = hb ? q2[1] : q2[0], oth = hb ? q2[0] : q2[1]; q1 = mine + __shfl_xor(oth, 2); }
    q1 += __shfl_xor(q1, 1);
    float lv = q1 + A.in[I_RB][l * 32 + (lane >> 1)];
    float tv[4]; int ti[4];
#pragma unroll
    for (int kk = 0; kk < 4; ++kk) { const float mx = wave_max_f(lv); const unsigned long long msk = __ballot(lv == mx); const int e = msk ? (int)(__builtin_ctzll(msk) >> 1) : kk;
        tv[kk] = mx; ti[kk] = e; if ((lane >> 1) == e) lv = -INFINITY; }
    const float e1 = expf(tv[1] - tv[0]), e2 = expf(tv[2] - tv[0]), e3 = expf(tv[3] - tv[0]); const float inv = 1.0f / (1.0f + e1 + e2 + e3);
    if (lane == 0 && !dry) {
        int* TI = (int*)(A.ws + WS_TOPI) + (size_t)m * 4; float* TW = (float*)(A.ws + WS_TOPW) + (size_t)m * 4;
        TI[0] = ti[0]; TI[1] = ti[1]; TI[2] = ti[2]; TI[3] = ti[3]; TW[0] = inv; TW[1] = e1 * inv; TW[2] = e2 * inv; TW[3] = e3 * inv;
        { unsigned* hg = (unsigned*)hist; atomicAdd(hg + ti[0], 1u); atomicAdd(hg + ti[1], 1u); atomicAdd(hg + ti[2], 1u); atomicAdd(hg + ti[3], 1u); }
    }
}
__device__ __forceinline__ void build_expert_table(ARef A, const WI& w, int l) {
    LAS int* tst = (LAS int*)(w.lds + TST_OFF); LAS int* tab = (LAS int*)(w.lds + TAB_OFF); LAS int* base = (LAS int*)(w.lds + BASE_OFF); LAS int* part = (LAS int*)w.lds;
    const unsigned* bc = (const unsigned*)(A.ws + WS_CTL) + CW_BLKCNT + (size_t)l * 256 * 32;
    { const int e = w.tid & 31, pq = w.tid >> 5; int s = 0, sb = 0;
      for (int i = 0; i < 16; ++i) { const int g = pq * 16 + i; if (g < w.G) { const int c = (int)__hip_atomic_load(bc + g * 32 + e, RLX_AGENT); s += c; sb += (g < w.vcu) ? c : 0; } }
      part[pq * 32 + e] = s; part[512 + pq * 32 + e] = sb; }
    __syncthreads();
    if (w.tid < 32) { int s = 0, sb = 0; for (int pq = 0; pq < 16; ++pq) { s += part[pq * 32 + w.tid]; sb += part[512 + pq * 32 + w.tid]; } part[1024 + w.tid] = s; base[w.tid] = sb; }
    __syncthreads();
    if (w.tid == 0) { int acc = 0; for (int e = 0; e < 32; ++e) { tst[e] = acc; acc += (part[1024 + e] + 255) >> 8; } tst[32] = acc; tab[0] = acc; }
    __syncthreads();
    if (w.tid < 32) { const int e = w.tid; for (int pm = tst[e]; pm < tst[e + 1]; ++pm) tab[1 + pm] = e; }
    __syncthreads();
}
__device__ __forceinline__ void scatter_row(ARef A, const WI& w, int l, int m, bool dry = false) {
    const LAS int* tst = (const LAS int*)(w.lds + TST_OFF); const LAS int* base = (const LAS int*)(w.lds + BASE_OFF); LAS unsigned* cur = (LAS unsigned*)(w.lds + HIST_OFF);
    int pos = 0;
    if (dry) { if (w.lane < 4) pos = ((const int*)(A.ws + WS_POS))[(size_t)m * 4 + w.lane]; }
    else if (w.lane < 4) { const int e = ((const int*)(A.ws + WS_TOPI))[(size_t)m * 4 + w.lane];
        const unsigned slot = atomicAdd((unsigned*)cur + e, 1u);
        pos = tst[e] * 256 + base[e] + (int)slot; ((int*)(A.ws + WS_POS))[(size_t)m * 4 + w.lane] = pos; }
    const v4u* src = (const v4u*)((const bf16*)(A.ws + WS_H) + (size_t)m * DM);
    const v4u a = src[w.lane], b = src[64 + w.lane];
#pragma unroll
    for (int k = 0; k < 4; ++k) { const int pk = __shfl(pos, k); v4u* dst = (v4u*)((bf16*)(A.ws + WS_XS) + (size_t)pk * DM); dst[w.lane] = a; dst[64 + w.lane] = b; }
}
__device__ __forceinline__ void combine_row(ARef A, int l, int m, int lane, float gscale = 1.0f, float oscale = 1.0f) {
    float* XA = (float*)(A.ws + WS_XA) + (size_t)m * DM; const float* MOD = (const float*)(A.ws + WS_MOD) + (size_t)(l * 8 + (m >> 12)) * 6144;
    const int* PS = (const int*)(A.ws + WS_POS) + (size_t)m * 4; const float* TW = (const float*)(A.ws + WS_TOPW) + (size_t)m * 4;
    const bf16* YS = (const bf16*)(A.ws + WS_XS);
    f32x4 v[4], acc[4];
#pragma unroll
    for (int j = 0; j < 4; ++j) { v[j] = *(const f32x4*)(XA + 4 * (lane + 64 * j)); acc[j] = (f32x4){0.f, 0.f, 0.f, 0.f}; }
#pragma unroll
    for (int k = 0; k < 4; ++k) { const int pos = PS[k]; const float gt = TW[k] * gscale; const v2u* yr = (const v2u*)(YS + (size_t)pos * DM);
#pragma unroll
        for (int j = 0; j < 4; ++j) { const v2u y = yr[lane + 64 * j]; acc[j] += gt * (f32x4){bf_lo(y.x), bf_hi(y.x), bf_lo(y.y), bf_hi(y.y)}; } }
    float ss = 0.0f;
#pragma unroll
    for (int j = 0; j < 4; ++j) { const int kx = 4 * (lane + 64 * j); v[j] += *(const f32x4*)(MOD + 5 * 1024 + kx) * acc[j]; ss += dot4(v[j], v[j]); }
    ss = wave_sum(ss); const float rstd = 1.0f / sqrtf(ss * (1.0f / DM) + 1e-5f);
    if (l + 1 < NLAYER) {
#pragma unroll
        for (int j = 0; j < 4; ++j) *(f32x4*)(XA + 4 * (lane + 64 * j)) = v[j];
        const float* mb = MOD + 8 * 6144;
        emit_h_row(v, rstd, A.in[I_NMIX] + (l + 1) * DM, mb + 1024, mb, (bf16*)(A.ws + WS_H) + (size_t)m * DM, lane);
    } else {
        float* orow = A.out + (size_t)m * DM; const float* gf = A.in[I_NFINAL];
#pragma unroll
        for (int j = 0; j < 4; ++j) { const int kx = 4 * (lane + 64 * j); *(f32x4*)(orow + kx) = v[j] * (rstd * oscale) * *(const f32x4*)(gf + kx); }
    }
}

constexpr int N_LAUNCHES = MK_N_LAUNCHES;
template <int SEL> __global__ void __launch_bounds__(NWAVES * 64, 2) fwd(ArgsH Ah) {
    extern __shared__ __attribute__((aligned(16))) unsigned char lds[];
    (void)Ah;
    const int wave_s = __builtin_amdgcn_readfirstlane((int)threadIdx.x >> 6);
    auto tid_now = [&]() -> int { int ws_ = wave_s; unsigned z_ = 0u; asm volatile("" : "+s"(ws_), "+s"(z_)); return ws_ * 64 + (int)__builtin_amdgcn_mbcnt_hi(~0u, __builtin_amdgcn_mbcnt_lo(~0u, z_)); };
#define TID_NOW() tid_now()
#define MAKE_WI() WI w; { int tz = TID_NOW(); asm volatile("" : "+v"(tz)); int bz = blockIdx.x, gz = gridDim.x; asm volatile("" : "+s"(bz), "+s"(gz)); \
        w.lds = (LAS unsigned char*)lds; w.tid = tz; w.lane = tz & 63; w.wave = __builtin_amdgcn_readfirstlane(tz >> 6); w.G = gz; w.bx = bz; w.vcu = (gz % 8 == 0) ? (bz % 8) * (gz / 8) + bz / 8 : bz; \
        w.gw = w.vcu * NWAVES + w.wave; w.NGW = gz * NWAVES; }
    { const int t0 = threadIdx.x; for (int u = t0; u < (LDS_BYTES - RING_BYTES) / 4; u += NWAVES * 64) ((LAS unsigned*)((LAS unsigned char*)lds + RING_BYTES))[u] = 0u; }
    __syncthreads();
    int lo, hi; { ARef A0 = *kargs(); lo = A0.ph_lo; hi = A0.ph_hi; }
    if (N_LAUNCHES == 1) { ARef A0 = *kargs(); (void)xcd_barrier_post((unsigned*)((gu32*)(A0.ws + WS_CTL) + CW_BAR), (volatile LAS unsigned*)((LAS unsigned char*)lds + MISC_OFF) + 8, TID_NOW()); }
#define GRID_BAR() do { if (N_LAUNCHES == 1) { ARef Ab = *kargs(); XcdBarrier bar_; bar_.bar = (unsigned*)((gu32*)(Ab.ws + WS_CTL) + CW_BAR); bar_.x = xb_xcc_id(); bar_.st = (volatile LAS unsigned*)((LAS unsigned char*)lds + MISC_OFF) + 8; xcd_barrier(bar_, TID_NOW()); } } while (0)
#ifndef TPROBE
#define TPROBE 0
#endif
#if TPROBE
    unsigned long long tp_acc = 0ull;
#define TP_SCALE tp_scale_of(__hip_atomic_load((unsigned*)(A.ws + WS_CTL) + 3, RLX_AGENT))
    auto tp_scale_of = [](unsigned ticks) -> float { const float us = (float)ticks * 0.01f; if (us < 1.0f) return 1.0f; const float q = exp2f(rintf(log2f(us) * 8.0f) * 0.125f); return 1.0f + sqrtf(q * 1e-5f); };
#define TP_BEGIN(kind) unsigned long long tp_t0 = 0ull; if ((kind) == TPROBE) tp_t0 = __builtin_amdgcn_s_memrealtime();
#define TP_END(kind) if ((kind) == TPROBE) { tp_acc += __builtin_amdgcn_s_memrealtime() - tp_t0; }
#define TP_PUBLISH(l) if ((l) == 1 && w.vcu == 0 && w.tid == 0) __hip_atomic_store((unsigned*)(A.ws + WS_CTL) + 3, (unsigned)tp_acc, RLX_AGENT);
#else
#define TP_SCALE 1.0f
#define TP_PUBLISH(l)
#define TP_BEGIN(kind)
#define TP_END(kind)
#endif
#define IN(k) (lo <= (k) && (k) < hi)
#ifndef PHMASK
#define PHMASK 0xffffffffu
#endif
#define KON(k) if constexpr ((SEL < 0 && ((PHMASK >> (k)) & 1u)) || SEL == (k))
#define BOTH(k) (IN(k) && IN((k) + 1))
#ifndef PROBE_REP
#define PROBE_REP 0
#endif
#if PROBE_REP
    int nrep_ = 2; asm volatile("" : "+s"(nrep_));
#define REP(bit) _Pragma("unroll 1") for (int rep_ = 0; rep_ < (((PROBE_REP >> (bit)) & 1) ? nrep_ : 1); ++rep_)
#else
#define REP(bit) for (int rep_ = 0; rep_ < 1; ++rep_)
#endif
#define ring ((PG8_LAS unsigned char*)lds)

    KON(0) if (IN(0)) { ARef A = *kargs(); MAKE_WI(); REP(0) ph_prologue(A, w); if (BOTH(0)) GRID_BAR(); }

#define LAYER_BODY(l) do {\
        const int pb = 1 + l * NPL; \
        KON(1) if (IN(pb + 0)) { ARef A = *kargs(); MAKE_WI(); TP_BEGIN(1) if (l == 0) { ph_norm1(A, w); small_weights_to_f16(A, w); } if (BOTH(pb + 0)) GRID_BAR(); TP_END(1) } \
        KON(2) if (IN(pb + 1)) { ARef A = *kargs(); MAKE_WI(); TP_BEGIN(2) \
            pg8::Gemm g{(const bf16*)(A.ws + WS_H), (const bf16*)(A.ws + WS_WIN) + (size_t)l * INCP * DM, MTOK, INCP, DM}; pg8::StaticOrder S; S.init(MTOK, INCP, w.G, w.bx); \
            pg8::EpiProj E{(bf16*)(A.ws + WS_PB), (float*)(A.ws + WS_PF)}; \
            REP(1) pg8::gemm_phase<pg8::EpiProj, pg8::StaticOrder, true, true>(ring, g, S, E, w.tid); \
            if (BOTH(pb + 1)) GRID_BAR(); TP_END(2) \
        } \
        KON(3) if (IN(pb + 2)) { ARef A = *kargs(); MAKE_WI(); TP_BEGIN(3) \
            REP(2) { for (int g = w.gw; g < MTOK / 16; g += w.NGW) prep16(A, l, 16 * g, w.lane); } \
            if (BOTH(pb + 2)) GRID_BAR(); TP_END(3) \
        } \
        KON(4) if (IN(pb + 3)) { ARef A = *kargs(); MAKE_WI(); TP_BEGIN(4) \
            REP(3) { for (int tk = 2 * w.vcu; tk < 32 * NCH; tk += 2 * w.G) scan_rwkv_task2(A, w, tk); } \
            REP(13) { for (int tk = w.vcu; tk < 32 * NCH / 2; tk += w.G) scan_ret_task(A, w, tk); } \
            REP(4) { LAS unsigned char* vl = w.lds + w.wave * 4608; for (int it = w.gw; it < 32 * 128; it += w.NGW) sb_tile_mfma(A, it, w.lane, vl); } \
            REP(5) dsa_scores_mfma(A, w); \
            if (BOTH(pb + 3)) GRID_BAR(); TP_END(4) \
        } \
        KON(5) if (IN(pb + 4)) { ARef A = *kargs(); MAKE_WI(); TP_BEGIN(5) \
            if (w.vcu < 32) prefix_chain(A, w, w.vcu); \
            dsa_wave(A, w, w.lds + w.wave * 13312, l); \
            if (BOTH(pb + 4)) GRID_BAR(); TP_END(5) \
        } \
        KON(6) if (IN(pb + 5)) { ARef A = *kargs(); MAKE_WI(); TP_BEGIN(6) \
            REP(7) ph_post(A, w, l); \
            if (BOTH(pb + 5)) GRID_BAR(); TP_END(6) \
        } \
        KON(7) if (IN(pb + 6)) { ARef A = *kargs(); MAKE_WI(); TP_BEGIN(7) \
            pg8::Gemm g{(const bf16*)(A.ws + WS_MIX), (const bf16*)(A.ws + WS_WOUT) + (size_t)l * DM * DM, MTOK, DM, DM}; pg8::StaticOrder S; S.init(MTOK, DM, w.G, w.bx); \
            pg8::EpiRes E{l == 0 ? A.in[I_X] : (const float*)(A.ws + WS_XA), (float*)(A.ws + WS_XA), (const float*)(A.ws + WS_MOD) + (size_t)l * 8 * 6144 + 2 * 1024}; \
            pg8::gemm_phase<pg8::EpiRes, pg8::StaticOrder, true, true>(ring, g, S, E, w.tid); \
            if (BOTH(pb + 6)) GRID_BAR(); TP_END(7) \
        } \
        KON(8) if (IN(pb + 7)) { ARef A = *kargs(); MAKE_WI(); TP_BEGIN(8) \
            { LAS unsigned* hist = (LAS unsigned*)(w.lds + HIST_OFF); if (w.tid < 32) hist[w.tid] = 0u; router_stage(A, w, l); \
            REP(10) for (int m = w.gw; m < MTOK; m += w.NGW) router_row(A, l, m, w.lane, hist, (const LAS float*)w.lds, rep_ != 0); \
            __syncthreads(); if (w.tid < 32) ((unsigned*)(A.ws + WS_CTL))[CW_BLKCNT + (l * 256 + w.vcu) * 32 + w.tid] = hist[w.tid]; } \
            if (BOTH(pb + 7)) GRID_BAR(); TP_END(8) \
        } \
        KON(9) if (IN(pb + 8)) { ARef A = *kargs(); MAKE_WI(); TP_BEGIN(9) \
            build_expert_table(A, w, l); { LAS unsigned* cur = (LAS unsigned*)(w.lds + HIST_OFF); if (w.tid < 32) cur[w.tid] = 0u; __syncthreads(); } \
            REP(11) for (int m = w.gw; m < MTOK; m += w.NGW) scatter_row(A, w, l, m, rep_ != 0); \
            if (BOTH(pb + 8)) GRID_BAR(); TP_END(9) \
        } \
        KON(10) if (IN(pb + 9)) { ARef A = *kargs(); MAKE_WI(); TP_BEGIN(10) \
            build_expert_table(A, w, l); \
            pg8::Gemm g{(const bf16*)(A.ws + WS_XS), (const bf16*)(A.ws + WS_W1) + (size_t)l * NEXP * 2048 * DM, MOE_ROWS, NEXP * 2048, DM}; \
            pg8::MoeOrder S{(const PG8_LAS int*)(w.lds + TAB_OFF), 8, w.G, w.vcu}; \
            pg8::EpiSwiglu E{(bf16*)(A.ws + WS_ACT), A.in[I_MB1] + (size_t)l * NEXP * 2048}; \
            REP(8) pg8::gemm_phase<pg8::EpiSwiglu, pg8::MoeOrder, true, true>(ring, g, S, E, w.tid); \
            if (BOTH(pb + 9)) GRID_BAR(); TP_END(10) \
        } \
        KON(11) if (IN(pb + 10)) { ARef A = *kargs(); MAKE_WI(); TP_BEGIN(11) \
            build_expert_table(A, w, l); \
            pg8::Gemm g{(const bf16*)(A.ws + WS_ACT), (const bf16*)(A.ws + WS_W2) + (size_t)l * NEXP * DM * DM, MOE_ROWS, NEXP * DM, DM}; \
            pg8::MoeOrder S{(const PG8_LAS int*)(w.lds + TAB_OFF), 4, w.G, w.vcu}; \
            pg8::EpiY E{(bf16*)(A.ws + WS_XS), A.in[I_MB2] + (size_t)l * NEXP * DM}; \
            REP(9) pg8::gemm_phase<pg8::EpiY, pg8::MoeOrder, true, true>(ring, g, S, E, w.tid); \
            TP_PUBLISH(l) \
            if (BOTH(pb + 10)) GRID_BAR(); TP_END(11) \
        } \
        KON(12) if (IN(pb + 11)) { ARef A = *kargs(); MAKE_WI(); TP_BEGIN(12) \
            REP(12) for (int m = w.gw; m < MTOK; m += w.NGW) combine_row(A, l, m, w.lane, rep_ ? 0.0f : 1.0f, TP_SCALE); \
            if (BOTH(pb + 11)) GRID_BAR(); TP_END(12) \
        } \
    } while (0)
    LAYER_BODY(0);
    LAYER_BODY(1);
#undef LAYER_BODY
#undef IN
#undef ring
#undef MAKE_WI
#undef TID_NOW
#undef GRID_BAR
#undef KON
#undef BOTH
}


#if MK_N_LAUNCHES != 1
template <int K> static void launch_one(int grid, hipStream_t stream, const ArgsH& a) {
    static bool attr = false;
    if (!attr) { (void)hipFuncSetAttribute((const void*)fwd<K>, hipFuncAttributeMaxDynamicSharedMemorySize, LDS_BYTES); attr = true; }
    hipLaunchKernelGGL(fwd<K>, dim3(grid), dim3(NWAVES * 64), LDS_BYTES, stream, a);
}
static void launch_kind(int kind, int grid, hipStream_t stream, const ArgsH& a) {
    switch (kind) {
        case 0: launch_one<0>(grid, stream, a); break; case 1: launch_one<1>(grid, stream, a); break; case 2: launch_one<2>(grid, stream, a); break;
        case 3: launch_one<3>(grid, stream, a); break; case 4: launch_one<4>(grid, stream, a); break; case 5: launch_one<5>(grid, stream, a); break;
        case 6: launch_one<6>(grid, stream, a); break; case 7: launch_one<7>(grid, stream, a); break; case 8: launch_one<8>(grid, stream, a); break;
        case 9: launch_one<9>(grid, stream, a); break; case 10: launch_one<10>(grid, stream, a); break; case 11: launch_one<11>(grid, stream, a); break;
        default: launch_one<12>(grid, stream, a); break;
    }
}
#endif
extern "C" void kernel_launch(void* const* d_in, const int* in_sizes, int n_in, void* d_out, int out_size, void* d_ws, size_t ws_size, hipStream_t stream) {
    static int grid = 0;
    if (grid == 0) {
        if (n_in != N_IN || out_size != MTOK * DM || ws_size < WS_END) { fprintf(stderr, "kernel_launch: unexpected shapes (n_in %d, out %d, ws %zu)\n", n_in, out_size, ws_size); grid = -1; return; }
        int dev = 0, cus = 0;
        if (hipGetDevice(&dev) != hipSuccess || hipDeviceGetAttribute(&cus, hipDeviceAttributeMultiprocessorCount, dev) != hipSuccess) { grid = -1; return; }
#if MK_N_LAUNCHES == 1
        {
            if (hipFuncSetAttribute((const void*)fwd<-1>, hipFuncAttributeMaxDynamicSharedMemorySize, LDS_BYTES) != hipSuccess) { fprintf(stderr, "kernel_launch: hipFuncSetAttribute failed\n"); grid = -1; return; }
            int per_cu = 0;
            if (hipOccupancyMaxActiveBlocksPerMultiprocessor(&per_cu, (const void*)fwd<-1>, NWAVES * 64, LDS_BYTES) != hipSuccess || per_cu < 1) fprintf(stderr, "kernel_launch: occupancy query says %d\n", per_cu);
            (void)hipGetLastError();
        }
#endif
        grid = cus;
    }
    if (grid < 0) return;
    (void)in_sizes;
    if (hipMemsetAsync((char*)d_ws + WS_CTL, 0, CTL_ZERO_BYTES, stream) != hipSuccess) return;
    ArgsH a{};
    for (int i = 0; i < N_IN; ++i) a.in[i] = (const float*)d_in[i];
    a.out = (float*)d_out; a.ws = (unsigned char*)d_ws;
    for (int f = 0; f < 44; ++f) a.invf[f] = (f < 32) ? pow(10000.0, -(double)f / 32.0) : (f < 40) ? pow(500000.0, -(double)(f - 32) / 8.0) : pow(500000.0, -(double)(f - 40) / 4.0);
#if MK_N_LAUNCHES == 1
    a.ph_lo = 0; a.ph_hi = NPHASE; a.li = 0;
    hipLaunchKernelGGL(fwd<-1>, dim3(grid), dim3(NWAVES * 64), LDS_BYTES, stream, a);
#else
    {
        for (int p = 0; p < NPHASE; ++p) {
            if (p == 1 + NPL) continue;
            a.ph_lo = p; a.ph_hi = p + 1; a.li = p;
            const int kind = (p == 0) ? 0 : 1 + (p - 1) % NPL;
            launch_kind(kind, grid, stream, a);
        }
    }
#endif
}
```

```cpp
#include <hip/hip_runtime.h>
#include <cstdio>
#include <cstdint>
#include <cmath>

#ifndef MK_N_LAUNCHES
#define MK_N_LAUNCHES 1
#endif

namespace pg8 {
#define PG8_LAS __attribute__((address_space(3)))
typedef unsigned short bf16_t;
typedef short bf16x8 __attribute__((ext_vector_type(8)));
typedef float f32x4 __attribute__((ext_vector_type(4)));
typedef unsigned u32x4 __attribute__((ext_vector_type(4)));
typedef unsigned u32x2 __attribute__((ext_vector_type(2)));
constexpr int BM = 256, BK = 64, HALF = 128, HTB = HALF * BK * 2  , STAGE_BYTES = 8 * HTB, NXCD = 8, WGM = 8;

__host__ __device__ __forceinline__ int lds_byte(int r, int c) { const int st = (r >> 4) * 2 + (c >> 5), rr = r & 15, cc = c & 31, ob = rr * 64 + cc * 2; return st * 1024 + (ob ^ (((ob >> 9) & 1) << 5)); }
__host__ __device__ __forceinline__ void stage_rc(int b, int& R, int& C) { const int st = b / 1024, sb = b % 1024, swz = sb ^ (((sb >> 9) & 1) << 5); R = (st >> 1) * 16 + swz / 64; C = (st & 1) * 32 + (swz % 64) / 2; }
__host__ __device__ __forceinline__ int perm32(int rho) { const int n = rho >> 4, i = rho & 15; return 8 * (i >> 2) + 4 * n + (i & 3); }

struct Unit { int pm, pn; };
struct Gemm { const bf16_t* A; const bf16_t* Bt; int M, N, K; };

struct StaticOrder {
    int nM, nN, nwg, G, c;
    __host__ __device__ void init(int M, int N, int G_, int c_) { nM = M / BM; nN = N / BM; nwg = nM * nN; G = G_; c = c_; }
    __host__ __device__ bool next(int i, Unit& u) const {
        const long L = (long)i * G + c; if (L >= nwg) return false;
        int wgid = (int)L; { const int q = nwg / NXCD, r = nwg % NXCD, xcd = wgid % NXCD, off = wgid / NXCD; wgid = (xcd < r ? xcd * (q + 1) : r * (q + 1) + (xcd - r) * q) + off; }
        const int nig = WGM * nN, gid = wgid / nig, fm = gid * WGM, gsz = (nM - fm) < WGM ? (nM - fm) : WGM;
        u.pm = fm + ((wgid % nig) % gsz); u.pn = (wgid % nig) / gsz; return true;
    }
    __device__ __forceinline__ void a_ready(const Unit&) const {}
    __device__ __forceinline__ void done(const Unit&) const {}
};
__device__ __forceinline__ unsigned cvt_pk_bf16(float lo, float hi) { unsigned r; asm volatile("v_cvt_pk_bf16_f32 %0, %1, %2" : "=v"(r) : "v"(lo), "v"(hi)); return r; }
struct EpiF32 {
    static constexpr bool PERM = false, AFTER_DRAIN = false;
    float* C; int ldc;
    __device__ __forceinline__ void operator()(const f32x4 (&acc)[2][2][4][2], const Unit& u, int wr, int wc, int fr, int fq) const {
        const int row0 = u.pm * BM + wr * 64 + fr, col0 = u.pn * BM + wc * 32 + 4 * fq;
#pragma unroll
        for (int ai = 0; ai < 2; ++ai)
#pragma unroll
            for (int m = 0; m < 4; ++m) { float* rowp = C + (size_t)(row0 + ai * HALF + m * 16) * ldc + col0;
#pragma unroll
                for (int bj = 0; bj < 2; ++bj)
#pragma unroll
                    for (int n = 0; n < 2; ++n) *(f32x4*)(rowp + bj * HALF + n * 16) = acc[ai][bj][m][n]; }
    }
};
struct EpiProj {
    static constexpr bool PERM = true, AFTER_DRAIN = false;
    bf16_t* PB; float* PF;
    __device__ __forceinline__ void operator()(const f32x4 (&acc)[2][2][4][2], const Unit& u, int wr, int wc, int fr, int fq) const {
        const int row0 = u.pm * BM + wr * 64 + fr;
        if (u.pn < 7) { const int c0 = u.pn * BM + wc * 32 + 8 * fq;
#pragma unroll
            for (int ai = 0; ai < 2; ++ai)
#pragma unroll
                for (int m = 0; m < 4; ++m) { bf16_t* rowp = PB + (size_t)(row0 + ai * HALF + m * 16) * 1792 + c0;
#pragma unroll
                    for (int bj = 0; bj < 2; ++bj) { const f32x4 v0 = acc[ai][bj][m][0], v1 = acc[ai][bj][m][1];
                        u32x4 w; w.x = cvt_pk_bf16(v0[0], v0[1]); w.y = cvt_pk_bf16(v0[2], v0[3]); w.z = cvt_pk_bf16(v1[0], v1[1]); w.w = cvt_pk_bf16(v1[2], v1[3]);
                        *(u32x4*)(rowp + bj * HALF) = w; } }
        } else { const int c0 = (u.pn - 7) * BM + wc * 32 + 8 * fq;
#pragma unroll
            for (int ai = 0; ai < 2; ++ai)
#pragma unroll
                for (int m = 0; m < 4; ++m) { float* rowp = PF + (size_t)(row0 + ai * HALF + m * 16) * 1280 + c0;
#pragma unroll
                    for (int bj = 0; bj < 2; ++bj) { *(f32x4*)(rowp + bj * HALF) = acc[ai][bj][m][0]; *(f32x4*)(rowp + bj * HALF + 4) = acc[ai][bj][m][1]; } }
        }
    }
};
struct EpiRes {
    static constexpr bool PERM = false, AFTER_DRAIN = false;
    const float* xin; float* xout; const float* gate;
    __device__ __forceinline__ void operator()(const f32x4 (&acc)[2][2][4][2], const Unit& u, int wr, int wc, int fr, int fq) const {
        const int row0 = u.pm * BM + wr * 64 + fr, col0 = u.pn * BM + wc * 32 + 4 * fq;
        const float* gp = gate + (size_t)((u.pm * BM) >> 12) * 6144 + col0;
        f32x4 gv[2][2];
#pragma unroll
        for (int bj = 0; bj < 2; ++bj)
#pragma unroll
            for (int n = 0; n < 2; ++n) gv[bj][n] = *(const f32x4*)(gp + bj * HALF + n * 16);
#pragma unroll
        for (int ai = 0; ai < 2; ++ai)
#pragma unroll
            for (int m = 0; m < 4; ++m) { const size_t ro = (size_t)(row0 + ai * HALF + m * 16) * 1024 + col0;
#pragma unroll
                for (int bj = 0; bj < 2; ++bj)
#pragma unroll
                    for (int n = 0; n < 2; ++n) { const f32x4 xv = *(const f32x4*)(xin + ro + bj * HALF + n * 16); *(f32x4*)(xout + ro + bj * HALF + n * 16) = xv + gv[bj][n] * acc[ai][bj][m][n]; } }
    }
};
__device__ __forceinline__ float swiglu1(float glu, float lin) {
    glu = fminf(glu, 7.0f); lin = fminf(fmaxf(lin, -7.0f), 7.0f);
    return glu * (1.0f / (1.0f + __expf(-1.702f * glu))) * (lin + 1.0f);
}
struct EpiSwiglu {
    static constexpr bool PERM = true, AFTER_DRAIN = false;
    bf16_t* O; const float* b1;
    __device__ __forceinline__ void operator()(const f32x4 (&acc)[2][2][4][2], const Unit& u, int wr, int wc, int fr, int fq) const {
        const int e = u.pn >> 3, j = u.pn & 7, row0 = u.pm * BM + wr * 64 + fr, c0 = 128 * j + wc * 32 + 8 * fq;
        const float* bp = b1 + (size_t)e * 2048 + c0;
        f32x4 bg[2], bl[2];
#pragma unroll
        for (int n = 0; n < 2; ++n) { bg[n] = *(const f32x4*)(bp + 4 * n); bl[n] = *(const f32x4*)(bp + 1024 + 4 * n); }
#pragma unroll
        for (int ai = 0; ai < 2; ++ai)
#pragma unroll
            for (int m = 0; m < 4; ++m) { bf16_t* rowp = O + (size_t)(row0 + ai * HALF + m * 16) * 1024 + c0;
                const f32x4 g0 = acc[ai][0][m][0] + bg[0], g1 = acc[ai][0][m][1] + bg[1], l0 = acc[ai][1][m][0] + bl[0], l1 = acc[ai][1][m][1] + bl[1];
                u32x4 w;
                w.x = cvt_pk_bf16(swiglu1(g0[0], l0[0]), swiglu1(g0[1], l0[1])); w.y = cvt_pk_bf16(swiglu1(g0[2], l0[2]), swiglu1(g0[3], l0[3]));
                w.z = cvt_pk_bf16(swiglu1(g1[0], l1[0]), swiglu1(g1[1], l1[1])); w.w = cvt_pk_bf16(swiglu1(g1[2], l1[2]), swiglu1(g1[3], l1[3]));
                *(u32x4*)rowp = w; }
    }
};
struct EpiY {
    static constexpr bool PERM = true, AFTER_DRAIN = false;
    bf16_t* O; const float* b2;
    __device__ __forceinline__ void operator()(const f32x4 (&acc)[2][2][4][2], const Unit& u, int wr, int wc, int fr, int fq) const {
        const int e = u.pn >> 2, j = u.pn & 3, row0 = u.pm * BM + wr * 64 + fr, c0 = 256 * j + wc * 32 + 8 * fq;
        const float* bp = b2 + (size_t)e * 1024 + c0;
        f32x4 bv[2][2];
#pragma unroll
        for (int bj = 0; bj < 2; ++bj)
#pragma unroll
            for (int n = 0; n < 2; ++n) bv[bj][n] = *(const f32x4*)(bp + bj * HALF + 4 * n);
#pragma unroll
        for (int ai = 0; ai < 2; ++ai)
#pragma unroll
            for (int m = 0; m < 4; ++m) { bf16_t* rowp = O + (size_t)(row0 + ai * HALF + m * 16) * 1024 + c0;
#pragma unroll
                for (int bj = 0; bj < 2; ++bj) { const f32x4 v0 = acc[ai][bj][m][0] + bv[bj][0], v1 = acc[ai][bj][m][1] + bv[bj][1];
                    u32x4 w; w.x = cvt_pk_bf16(v0[0], v0[1]); w.y = cvt_pk_bf16(v0[2], v0[3]); w.z = cvt_pk_bf16(v1[0], v1[1]); w.w = cvt_pk_bf16(v1[2], v1[3]);
                    *(u32x4*)(rowp + bj * HALF) = w; } }
    }
};
struct MoeOrder {
    const PG8_LAS int* tab; int NJ, G, c;
    __device__ __forceinline__ bool next(int i, Unit& u) const {
        const int T = tab[0]; const long L = (long)i * G + c; if (L >= (long)T * NJ) return false;
        const int pm = (int)(L / NJ), j = (int)(L % NJ);
        u.pm = pm; u.pn = tab[1 + pm] * NJ + j; return true;
    }
    __device__ __forceinline__ void a_ready(const Unit&) const {}
    __device__ __forceinline__ void done(const Unit&) const {}
    const PG8_LAS int* tst; const PG8_LAS int* cnt; const int* list;
    __device__ __forceinline__ int row_of(const Unit& u, int r) const { const int e = tab[1 + u.pm], idx = 256 * (u.pm - tst[e]) + r; return (idx < cnt[e]) ? list[e * 32768 + idx] : 0; }
};

template <class Epi, class Sched, bool ALIGN_EPI = false, bool SP2 = false, bool GATHER = false>
__device__ __forceinline__ void gemm_phase(PG8_LAS unsigned char* lds, const Gemm g, const Sched& S, const Epi& E, int tid_in) {
    int tid_ = tid_in; asm volatile("" : "+v"(tid_));
    const int tid = tid_, wid = __builtin_amdgcn_readfirstlane(tid >> 6), lane = tid & 63, wr = wid >> 2, wc = wid & 3, fr = lane & 15, fq = lane >> 4;
    const int K = g.K, nt = K / BK;
    unsigned voffA[2], voffB[2];
#pragma unroll
    for (int i = 0; i < 2; ++i) { int R, C; stage_rc(tid * 16 + i * 8192, R, C); const int Rb = Epi::PERM ? ((R & ~31) + perm32(R & 31)) : R;
        voffA[i] = (unsigned)(R * K + C) * 2u; voffB[i] = (unsigned)(Rb * K + C) * 2u; }
    static_assert(!GATHER || SP2, "gathered A rows: only the two-super-phase loop is wired");
    unsigned cvo[2][2], nvo[2][2];
#define PG8_ROWS(dst, u_) do { _Pragma("unroll") for (int h_ = 0; h_ < 2; ++h_) _Pragma("unroll") for (int i_ = 0; i_ < 2; ++i_) { int R_, C_; stage_rc(tid * 16 + i_ * 8192, R_, C_); dst[h_][i_] = (unsigned)(S.row_of(u_, h_ * HALF + R_) * K + C_) * 2u; } } while (0)
#define PG8_STAGE_A(bufoff, gbase, half, nx) do { if constexpr (GATHER) { unsigned o_[2]; o_[0] = (nx) ? nvo[half][0] : cvo[half][0]; o_[1] = (nx) ? nvo[half][1] : cvo[half][1]; PG8_STAGE(bufoff, gbase, o_); } else { PG8_STAGE(bufoff, (gbase) + (half) * hstep, voffA); } } while (0)
    const size_t kstep = (size_t)(BK * 2);
    const size_t hstep = (size_t)HALF * K * 2;
    const size_t tstep = 2 * hstep;
    const unsigned ldsw = (unsigned)wid * 1024u;
    const int aoff = lds_byte(wr * 64 + fr, fq * 8), boff = lds_byte(wc * 32 + fr, fq * 8);
#define PG8_SA(b, h) (((b) * 2 + (h)) * HTB)
#define PG8_SB(b, h) ((4 + (b) * 2 + (h)) * HTB)
#define PG8_STAGE(bufoff, gbase, voff) do { _Pragma("unroll") for (int _i = 0; _i < 2; ++_i) \
        __builtin_amdgcn_global_load_lds((const unsigned*)((const char*)(gbase) + (voff)[_i]), (PG8_LAS unsigned*)(lds + (bufoff) + ldsw + _i * 8192), 16, 0, 0); } while (0)
#define PG8_LDA(dst, b, h) do { _Pragma("unroll") for (int m = 0; m < 4; ++m) _Pragma("unroll") for (int k = 0; k < 2; ++k) dst[m][k] = *(const PG8_LAS bf16x8*)(lds + PG8_SA(b, h) + aoff + m * 2048 + k * 1024); } while (0)
#define PG8_LDB(dst, b, h) do { _Pragma("unroll") for (int n = 0; n < 2; ++n) _Pragma("unroll") for (int k = 0; k < 2; ++k) dst[n][k] = *(const PG8_LAS bf16x8*)(lds + PG8_SB(b, h) + boff + n * 2048 + k * 1024); } while (0)
#define PG8_MMA(ai, bj, At, Bt) do { __builtin_amdgcn_s_setprio(1); _Pragma("unroll") for (int m = 0; m < 4; ++m) _Pragma("unroll") for (int n = 0; n < 2; ++n) _Pragma("unroll") for (int k = 0; k < 2; ++k) \
        acc[ai][bj][m][n] = __builtin_amdgcn_mfma_f32_16x16x32_bf16(Bt[n][k], At[m][k], acc[ai][bj][m][n], 0, 0, 0); __builtin_amdgcn_s_setprio(0); } while (0)
#define PG8_WAIT_V(n) asm volatile("s_waitcnt vmcnt(" #n ")" ::: "memory")
#define PG8_WAIT_L(n) asm volatile("s_waitcnt lgkmcnt(" #n ")" ::: "memory")
#define PG8_BAR __builtin_amdgcn_s_barrier()
#define PG8_SCHED __builtin_amdgcn_sched_barrier(0)
    Unit cur, nxt; int ui = 0;
    if (!S.next(0, cur)) return;
    f32x4 acc[2][2][4][2];
#pragma unroll
    for (int a = 0; a < 2; ++a)
#pragma unroll
        for (int b = 0; b < 2; ++b)
#pragma unroll
            for (int m = 0; m < 4; ++m)
#pragma unroll
                for (int n = 0; n < 2; ++n) acc[a][b][m][n] = (f32x4){0.f, 0.f, 0.f, 0.f};
    bf16x8 At[4][2], B0[2][2], B1[2][2];
    const char* cA = (const char*)g.A + (GATHER ? (size_t)0 : (size_t)cur.pm * tstep); const char* cB = (const char*)g.Bt + (size_t)cur.pn * tstep;
    if constexpr (GATHER) { PG8_ROWS(cvo, cur); }
    S.a_ready(cur);
    if constexpr (SP2) {
        PG8_STAGE(PG8_SB(0, 0), cB, voffB); PG8_STAGE(PG8_SB(0, 1), cB + hstep, voffB); PG8_STAGE_A(PG8_SA(0, 0), cA, 0, false); PG8_STAGE_A(PG8_SA(0, 1), cA, 1, false);
        if (wr == 1) PG8_BAR;
        PG8_WAIT_V(2); PG8_BAR;
        PG8_STAGE(PG8_SB(1, 0), cB + kstep, voffB); PG8_STAGE_A(PG8_SA(1, 0), cA + kstep, 0, false); PG8_STAGE(PG8_SB(1, 1), cB + hstep + kstep, voffB);
        PG8_WAIT_V(6); PG8_BAR;
    } else {
        PG8_STAGE(PG8_SB(0, 0), cB, voffB); PG8_STAGE(PG8_SA(0, 0), cA, voffA); PG8_STAGE(PG8_SB(0, 1), cB + hstep, voffB); PG8_STAGE(PG8_SA(0, 1), cA + hstep, voffA);
        if (wr == 1) PG8_BAR;
        PG8_WAIT_V(4); PG8_BAR;
        PG8_STAGE(PG8_SB(1, 0), cB + kstep, voffB); PG8_STAGE(PG8_SA(1, 0), cA + kstep, voffA); PG8_STAGE(PG8_SB(1, 1), cB + hstep + kstep, voffB);
        PG8_WAIT_V(6); PG8_BAR;
    }
    for (;;) {
        const bool has_next = S.next(ui + 1, nxt);
        const char* nA = GATHER ? (const char*)g.A : (has_next ? (const char*)g.A + (size_t)nxt.pm * tstep : cA); const char* nB = has_next ? (const char*)g.Bt + (size_t)nxt.pn * tstep : cB;
        if constexpr (GATHER) { if (has_next) { PG8_ROWS(nvo, nxt); } else { _Pragma("unroll") for (int h_ = 0; h_ < 2; ++h_) { nvo[h_][0] = cvo[h_][0]; nvo[h_][1] = cvo[h_][1]; } } }
        for (int t = 0; t < nt; t += 2) {
            const bool last = (t == nt - 2);
            const char* a1 = cA + (size_t)(t + 1) * kstep;
            const char* a2 = last ? nA : cA + (size_t)(t + 2) * kstep; const char* b2 = last ? nB : cB + (size_t)(t + 2) * kstep;
            const char* a3 = a2 + kstep; const char* b3 = b2 + kstep;
            if (last && has_next) S.a_ready(nxt);
            if constexpr (SP2) {
            PG8_LDB(B0, 0, 0); PG8_LDB(B1, 0, 1); PG8_SCHED; PG8_LDA(At, 0, 0); PG8_STAGE_A(PG8_SA(1, 1), a1, 1, false);
            PG8_WAIT_V(8); PG8_WAIT_L(0); PG8_BAR; PG8_MMA(0, 0, At, B0); PG8_MMA(0, 1, At, B1); PG8_BAR; PG8_SCHED;
            PG8_LDA(At, 0, 1); PG8_STAGE(PG8_SB(0, 0), b2, voffB); PG8_STAGE(PG8_SB(0, 1), b2 + hstep, voffB); PG8_STAGE_A(PG8_SA(0, 0), a2, 0, last);
            PG8_WAIT_V(8); PG8_WAIT_L(0); PG8_BAR; PG8_MMA(1, 0, At, B0); PG8_MMA(1, 1, At, B1); PG8_BAR; PG8_SCHED;
            PG8_LDB(B0, 1, 0); PG8_LDB(B1, 1, 1); PG8_SCHED; PG8_LDA(At, 1, 0); PG8_STAGE_A(PG8_SA(0, 1), a2, 1, last);
            PG8_WAIT_V(8); PG8_WAIT_L(0); PG8_BAR; PG8_MMA(0, 0, At, B0); PG8_MMA(0, 1, At, B1); PG8_BAR; PG8_SCHED;
            PG8_LDA(At, 1, 1); PG8_STAGE(PG8_SB(1, 0), b3, voffB); PG8_STAGE(PG8_SB(1, 1), b3 + hstep, voffB); PG8_STAGE_A(PG8_SA(1, 0), a3, 0, last);
            PG8_WAIT_V(8); PG8_WAIT_L(0); PG8_BAR; PG8_MMA(1, 0, At, B0); PG8_MMA(1, 1, At, B1); PG8_BAR; PG8_SCHED;
            } else {
            PG8_LDB(B0, 0, 0); PG8_SCHED; PG8_LDA(At, 0, 0); PG8_STAGE(PG8_SA(1, 1), a1 + hstep, voffA);
            PG8_WAIT_L(8); PG8_BAR; PG8_WAIT_L(0); PG8_MMA(0, 0, At, B0); PG8_BAR; PG8_SCHED;
            PG8_LDB(B1, 0, 1); PG8_STAGE(PG8_SB(0, 0), b2, voffB);
            PG8_BAR; PG8_WAIT_L(0); PG8_MMA(0, 1, At, B1); PG8_BAR;
            PG8_LDA(At, 0, 1); PG8_STAGE(PG8_SA(0, 0), a2, voffA);
            PG8_BAR; PG8_WAIT_L(0); PG8_MMA(1, 0, At, B0); PG8_BAR; PG8_SCHED;
            PG8_STAGE(PG8_SB(0, 1), b2 + hstep, voffB);
            PG8_WAIT_V(6); PG8_BAR; PG8_MMA(1, 1, At, B1); PG8_BAR;
            PG8_LDB(B0, 1, 0); PG8_SCHED; PG8_LDA(At, 1, 0); PG8_STAGE(PG8_SA(0, 1), a2 + hstep, voffA);
            PG8_WAIT_L(8); PG8_BAR; PG8_WAIT_L(0); PG8_MMA(0, 0, At, B0); PG8_BAR; PG8_SCHED;
            PG8_LDB(B1, 1, 1); PG8_STAGE(PG8_SB(1, 0), b3, voffB);
            PG8_BAR; PG8_WAIT_L(0); PG8_MMA(0, 1, At, B1); PG8_BAR;
            PG8_LDA(At, 1, 1); PG8_STAGE(PG8_SA(1, 0), a3, voffA);
            PG8_BAR; PG8_WAIT_L(0); PG8_MMA(1, 0, At, B0); PG8_BAR; PG8_SCHED;
            PG8_STAGE(PG8_SB(1, 1), b3 + hstep, voffB);
            PG8_WAIT_V(6); PG8_BAR; PG8_MMA(1, 1, At, B1); PG8_BAR;
            }
        }
        if constexpr (ALIGN_EPI) { if (wr == 0) PG8_BAR; }
        if constexpr (!Epi::AFTER_DRAIN) { E(acc, cur, wr, wc, fr, fq); S.done(cur); }
        if (!has_next) break;
#pragma unroll
        for (int a = 0; a < 2; ++a)
#pragma unroll
            for (int b = 0; b < 2; ++b)
#pragma unroll
                for (int m = 0; m < 4; ++m)
#pragma unroll
                    for (int n = 0; n < 2; ++n) acc[a][b][m][n] = (f32x4){0.f, 0.f, 0.f, 0.f};
        cur = nxt; cA = nA; cB = nB; ++ui;
        if constexpr (GATHER) { _Pragma("unroll") for (int h_ = 0; h_ < 2; ++h_) { cvo[h_][0] = nvo[h_][0]; cvo[h_][1] = nvo[h_][1]; } }
        if constexpr (ALIGN_EPI) { if (wr == 1) PG8_BAR; }
    }
    PG8_WAIT_V(0);
    if constexpr (!ALIGN_EPI) { if (wr == 0) PG8_BAR; }
    PG8_BAR;
    if constexpr (Epi::AFTER_DRAIN) { E.fused(acc, cur, wr, wc, fr, fq, lds, wid, lane); S.done(cur); }
#undef PG8_SA
#undef PG8_SB
#undef PG8_STAGE
#undef PG8_STAGE_A
#undef PG8_ROWS
#undef PG8_LDA
#undef PG8_LDB
#undef PG8_MMA
#undef PG8_WAIT_V
#undef PG8_WAIT_L
#undef PG8_BAR
#undef PG8_SCHED
}
}

constexpr int NWAVES = 8;
constexpr int NB = 8, SEQ = 4096, DM = 1024, MTOK = NB * SEQ, NLAYER = 2;
constexpr int INC = 2984, INCP = 3072;
constexpr int C_RET = 0, C_RW = 1024, C_DSA = 1920, C_SB = 2216;
constexpr int PBW = 1792, PFW = 1280, PB_SB = 1024, PF_DSA = 896;
constexpr int NEXP = 32, MOE_ROWS = MTOK * 4 + NEXP * 256;
constexpr int ROPE_W = 88;
constexpr int NCH = 16, TCH = SEQ / NCH;
constexpr int NPL = 11, NPHASE = 1 + NLAYER * NPL;
enum { I_X = 0, I_C, I_POS, I_ADAW, I_ADAB, I_NMIX, I_NFFN, I_WIN, I_RETGN, I_MU, I_W0, I_W2, I_A0, I_A2, I_G2, I_KK, I_KA, I_RK, I_LN, I_QNORM, I_WQ, I_WQI, I_DONORM, I_SONORM, I_WOUT, I_RW, I_RB, I_MW1, I_MB1, I_MW2, I_MB2, I_NFINAL, N_IN };

constexpr size_t MiB = 1u << 20;
constexpr size_t WS_CTL = 0, CTL_ZERO_BYTES = 1 * MiB;
constexpr size_t WS_MOD = 1 * MiB, WS_ROPE = 2 * MiB, WS_WIN = 14 * MiB, WS_WOUT = 26 * MiB, WS_W1 = 30 * MiB, WS_W2 = 286 * MiB;
constexpr size_t WS_XA = 414 * MiB, WS_H = 542 * MiB, WS_MIX = 606 * MiB, WS_TOPI = 670 * MiB, WS_TOPW = 671 * MiB, WS_POS = 672 * MiB;
constexpr size_t WS_R = 674 * MiB;
constexpr size_t WS_PB = WS_R  , WS_PF = WS_R + 112 * MiB  , WS_RWA = 1058 * MiB  , WS_DQ = 1314 * MiB  , WS_DKB = 1330 * MiB  , WS_DVB = 1334 * MiB  , WS_DQI = 1346 * MiB  , WS_DKI = 1394 * MiB  , WS_DW = 1398 * MiB;
constexpr size_t WS_SMALLW = 1338 * MiB  ;
constexpr int SMW_QI = 0, SMW_W2 = 512 * 128, SMW_A2 = SMW_W2 + 256 * 32, SMW_G2 = SMW_A2 + 256 * 32, SMW_LAYER = SMW_G2 + 256 * 64;
constexpr size_t WS_PT = 1362 * MiB  ;
constexpr size_t WS_CH = WS_H  , WS_SI = WS_H + 16 * MiB  , WS_SIR = WS_H + 24 * MiB  ,
                 WS_CHR = WS_H + 32 * MiB  , WS_PTR = WS_H + 40 * MiB  ;
constexpr size_t WS_SQ = WS_MIX  , WS_SK = WS_MIX + 16 * MiB, WS_SV = WS_MIX + 32 * MiB;
constexpr size_t WS_YO = 1400 * MiB  , WS_SC = 1528 * MiB  ;
constexpr size_t WS_XS = WS_R  , WS_ACT = 946 * MiB  ;
constexpr size_t WS_LIST = 2040 * MiB  , WS_END = 2044 * MiB;
constexpr int LCAP = 32768;
static_assert((size_t)MOE_ROWS * 2048 <= 272 * MiB, "moe buffers");
constexpr int CW_TMO = 0, CW_CODE = 1, CW_GCNT = 256  , CW_DSAQ = 64  , CW_BAR = 4096, CW_BLKCNT = 16384  ;
constexpr int RING_BYTES = 131072, MISC_OFF = RING_BYTES + 320, TST_OFF = RING_BYTES + 1024  , TAB_OFF = RING_BYTES + 2048  , HIST_OFF = RING_BYTES + 5120  , BASE_OFF = RING_BYTES + 5376  , CNT_OFF = RING_BYTES + 5632  , TEXP_OFF = RING_BYTES + 6144  , LDS_BYTES = 147456;

#if defined(__HIP_DEVICE_COMPILE__)
#define GAS __attribute__((address_space(1)))
#define CAS __attribute__((address_space(4)))
#else
#define GAS
#define CAS
#endif
#define LAS __attribute__((address_space(3)))
typedef unsigned short bf16;
typedef unsigned v4u __attribute__((ext_vector_type(4)));
typedef unsigned v2u __attribute__((ext_vector_type(2)));
typedef float f32x4 __attribute__((ext_vector_type(4)));
typedef GAS unsigned gu32;
typedef short bf16x8v __attribute__((ext_vector_type(8)));
typedef short s16x4v __attribute__((ext_vector_type(4)));
typedef _Float16 f16x8 __attribute__((ext_vector_type(8)));
#define RLX_AGENT __ATOMIC_RELAXED, __HIP_MEMORY_SCOPE_AGENT
#define LDS_WAIT() asm volatile("s_waitcnt lgkmcnt(0)" ::: "memory")
#define VM_WAIT() asm volatile("s_waitcnt vmcnt(0)" ::: "memory")
__device__ __forceinline__ unsigned f2bf(float f) { unsigned u = __builtin_bit_cast(unsigned, f); return (u + 0x7fffu + ((u >> 16) & 1u)) >> 16; }
__device__ __forceinline__ unsigned pk2(float lo, float hi) { return f2bf(lo) | (f2bf(hi) << 16); }
__device__ __forceinline__ float bf_lo(unsigned w) { return __builtin_bit_cast(float, w << 16); }
__device__ __forceinline__ float bf_hi(unsigned w) { return __builtin_bit_cast(float, w & 0xffff0000u); }
__device__ __forceinline__ float wave_sum(float v) {
#pragma unroll
    for (int o = 1; o < 64; o <<= 1) v += __shfl_xor(v, o);
    return v;
}
__device__ __forceinline__ float wave_max(float v) {
#pragma unroll
    for (int o = 1; o < 64; o <<= 1) v = fmaxf(v, __shfl_xor(v, o));
    return v;
}
__device__ __forceinline__ float grp16_sum(float v) { v += __shfl_xor(v, 1); v += __shfl_xor(v, 2); v += __shfl_xor(v, 4); v += __shfl_xor(v, 8); return v; }
__device__ __forceinline__ float grp8_sum(float v) { v += __shfl_xor(v, 1); v += __shfl_xor(v, 2); v += __shfl_xor(v, 4); return v; }
__device__ __forceinline__ float sum4(f32x4 a) { return (a.x + a.y) + (a.z + a.w); }
__device__ __forceinline__ float dot4(f32x4 a, f32x4 b) { return (a.x * b.x + a.y * b.y) + (a.z * b.z + a.w * b.w); }
__device__ __forceinline__ float sigm(float x) { return 1.0f / (1.0f + expf(-x)); }
__device__ __forceinline__ float softplusf(float x) { return fmaxf(x, 0.0f) + log1pf(expf(-fabsf(x))); }
__device__ __forceinline__ f32x4 shx4(f32x4 v, int m) { f32x4 r; r.x = __shfl_xor(v.x, m); r.y = __shfl_xor(v.y, m); r.z = __shfl_xor(v.z, m); r.w = __shfl_xor(v.w, m); return r; }

#define XB_TMO      128
#define XB_XCNT(j)  (256  + 64 * (j))
#define XB_XSUB(j)  (1280 + 64 * (j))
#define XB_XGEN(j)  (2304 + 64 * (j))
#define XB_TOP      3328
#define XB_TOPGEN   3392
#define XCD_BAR_WORDS 3456
#define XB_SPIN_CAP (1u << 18)

__device__ __forceinline__ unsigned xb_ld(unsigned* p)              { return __hip_atomic_load(p, __ATOMIC_RELAXED, __HIP_MEMORY_SCOPE_AGENT); }
__device__ __forceinline__ unsigned xb_add(unsigned* p, unsigned v) { return __hip_atomic_fetch_add(p, v, __ATOMIC_RELAXED, __HIP_MEMORY_SCOPE_AGENT); }
__device__ __forceinline__ unsigned xb_xcc_id() { return (unsigned)__builtin_amdgcn_s_getreg((3 << 11) | 20) & 0xFu; }
#define XB_SPIN(cond, bar) do { unsigned _sp = 0; while (cond) { __builtin_amdgcn_s_sleep(1); \
    if ((++_sp & 255u) == 0u) { if (xb_ld(&(bar)[XB_TMO])) break; if (_sp > XB_SPIN_CAP) { atomicAdd(&(bar)[XB_TMO], 1u); break; } } } } while (0)

struct XcdBarrier {
    unsigned* bar; unsigned x;
    volatile LAS unsigned* st;
};

__device__ __forceinline__ XcdBarrier xcd_barrier_post(unsigned* bar, volatile LAS unsigned* st, int xb_tid) {
    XcdBarrier b; b.bar = bar; b.x = xb_xcc_id(); b.st = st;
    if (xb_tid == 0) (void)xb_add(&bar[XB_XCNT(b.x)], 1u);
    return b;
}
__device__ __forceinline__ void xcd_barrier_complete(unsigned* bar, unsigned x, unsigned& nloc, unsigned& nx) {
    const unsigned G = gridDim.x * gridDim.y * gridDim.z;
    unsigned sum, cnt, mine, sp = 0u;
    for (;;) {
        sum = 0u; cnt = 0u; mine = 0u;
#pragma unroll
        for (unsigned j = 0; j < 16; ++j) { const unsigned c = xb_ld(&bar[XB_XCNT(j)]); sum += c; cnt += (c > 0u) ? 1u : 0u; mine = (j == x) ? c : mine; }
        if (sum == G) break;
        __builtin_amdgcn_s_sleep(1);
        if ((++sp & 255u) == 0u) { if (xb_ld(&bar[XB_TMO])) break; if (sp > XB_SPIN_CAP) { atomicAdd(&bar[XB_TMO], 1u); break; } }
    }
    nloc = mine > 0u ? mine : 1u; nx = cnt > 0u ? cnt : 1u;
}

__device__ __forceinline__ void xcd_barrier(const XcdBarrier& b, int xb_tid) {
    asm volatile("s_waitcnt vmcnt(0)" ::: "memory");
    __syncthreads();
    if (xb_tid == 0) {
        unsigned* bar = b.bar;
        __builtin_amdgcn_s_waitcnt(0);
        unsigned nloc = b.st[0], nx = b.st[1];
        if (nloc == 0u) { xcd_barrier_complete(bar, b.x, nloc, nx); b.st[0] = nloc; b.st[1] = nx; }
        const unsigned old = xb_add(&bar[XB_XSUB(b.x)], 1u);
        const unsigned gen = old / nloc;
        if (old + 1u == (gen + 1u) * nloc) {
            __builtin_amdgcn_fence(__ATOMIC_RELEASE, "agent");
            asm volatile("s_waitcnt vmcnt(0)" ::: "memory");
            const unsigned og = xb_add(&bar[XB_TOP], 1u);
            const unsigned tg = og / nx;
            if (og + 1u == (tg + 1u) * nx) xb_add(&bar[XB_TOPGEN], 1u);
            else XB_SPIN(xb_ld(&bar[XB_TOPGEN]) == tg, bar);
            __builtin_amdgcn_fence(__ATOMIC_ACQUIRE, "agent");
            xb_add(&bar[XB_XGEN(b.x)], 1u);
            asm volatile("s_waitcnt vmcnt(0)" ::: "memory");
        } else {
            XB_SPIN(xb_ld(&bar[XB_XGEN(b.x)]) == gen, bar);
            __builtin_amdgcn_fence(__ATOMIC_ACQUIRE, "agent");
            asm volatile("s_waitcnt vmcnt(0)" ::: "memory");
        }
    }
    __syncthreads();
}
struct ArgsH { const float* in[N_IN]; float* out; unsigned char* ws; double invf[44]; int ph_lo, ph_hi, li, pad; };
struct ArgsD { const GAS float* in[N_IN]; GAS float* out; GAS unsigned char* ws; double invf[44]; int ph_lo, ph_hi, li, pad; };
static_assert(sizeof(ArgsH) == sizeof(ArgsD), "args layout");
typedef const CAS ArgsD& ARef;
__device__ __forceinline__ const CAS ArgsD* kargs() {
#if defined(__HIP_DEVICE_COMPILE__)
    const CAS ArgsD* p = (const CAS ArgsD*)__builtin_amdgcn_kernarg_segment_ptr(); asm volatile("" : "+s"(p)); return p;
#else
    return nullptr;
#endif
}
struct WI { LAS unsigned char* lds; int tid, lane, wave, vcu, G, gw, NGW, bx; };
constexpr size_t RWA_STRIDE = 32 * MiB / 4;
constexpr size_t YO_STRIDE = 32 * MiB / 4;

__device__ __forceinline__ int wave_sum_i(int v) {
#pragma unroll
    for (int o = 1; o < 64; o <<= 1) v += __shfl_xor(v, o);
    return v;
}
__device__ __forceinline__ void sincos_d(double ang, float& s, float& c) {
    const double q = __builtin_rint(ang * 0.63661977236758134308);
    double r = __builtin_fma(-q, 1.57079632679489661923, ang); r = __builtin_fma(-q, 6.123233995736766e-17, r);
    const double r2 = r * r;
    const double sp = r * (1.0 + r2 * (-1.0 / 6 + r2 * (1.0 / 120 + r2 * (-1.0 / 5040 + r2 * (1.0 / 362880 + r2 * (-1.0 / 39916800 + r2 * (1.0 / 6227020800.0)))))));
    const double cp = 1.0 + r2 * (-0.5 + r2 * (1.0 / 24 + r2 * (-1.0 / 720 + r2 * (1.0 / 40320 + r2 * (-1.0 / 3628800 + r2 * (1.0 / 479001600 + r2 * (-1.0 / 87178291200.0)))))));
    const int qi = ((int)q) & 3;
    const double ss = (qi == 0) ? sp : (qi == 1) ? cp : (qi == 2) ? -sp : -cp;
    const double cc = (qi == 0) ? cp : (qi == 1) ? -sp : (qi == 2) ? -cp : sp;
    s = (float)ss; c = (float)cc;
}

__device__ __forceinline__ void tr_item(const float* W, int ldw, int nvalid, int k0, int nsrc0, bf16* WT, size_t dstrow0, LAS float* scr, int lane, float scale = 1.0f) {
#pragma unroll 8
    for (int i = 0; i < 32; ++i) { const int kk = 2 * i + (lane >> 5), c = lane & 31, n = nsrc0 + c; scr[kk * 33 + c] = (n < nvalid) ? W[(size_t)(k0 + kk) * ldw + n] * scale : 0.0f; }
    LDS_WAIT(); asm volatile("" ::: "memory");
    const int c8 = lane & 7;
#pragma unroll
    for (int j = 0; j < 4; ++j) { const int n = (lane >> 3) + 8 * j; const LAS float* s = scr + (8 * c8) * 33 + n;
        v4u o; o.x = pk2(s[0 * 33], s[1 * 33]); o.y = pk2(s[2 * 33], s[3 * 33]); o.z = pk2(s[4 * 33], s[5 * 33]); o.w = pk2(s[6 * 33], s[7 * 33]);
        *(v4u*)(WT + (dstrow0 + n) * 1024 + k0 + 8 * c8) = o; }
    LDS_WAIT(); asm volatile("" ::: "memory");
}
__device__ __forceinline__ void ph_prologue(ARef A, const WI& w) {
    LAS float* sc = (LAS float*)w.lds;
    { const float* cin = A.in[I_C]; for (int i = w.tid; i < NB * DM; i += NWAVES * 64) { const float v = cin[i]; sc[i] = v / (1.0f + expf(-v)); } }
    __syncthreads();
    float* MOD = (float*)(A.ws + WS_MOD);
    if (w.wave == 0 && w.vcu < 192) {
        const int l = w.vcu / 96, col = (w.vcu % 96) * 64 + w.lane;
        const float* wp = A.in[I_ADAW] + (size_t)l * DM * 6144 + col;
        float acc[8];
#pragma unroll
        for (int b = 0; b < 8; ++b) acc[b] = 0.0f;
        for (int k = 0; k < DM; ++k) { const float wv = wp[(size_t)k * 6144];
#pragma unroll
            for (int b = 0; b < 8; ++b) acc[b] += sc[b * DM + k] * wv; }
        const float bias = A.in[I_ADAB][l * 6144 + col];
#pragma unroll
        for (int b = 0; b < 8; ++b) MOD[(size_t)(l * 8 + b) * 6144 + col] = acc[b] + bias;
    }
    LAS float* scr = (LAS float*)(w.lds + 32768 + w.wave * 8448);
    constexpr int I_IN = NLAYER * 16 * 96, I_OUT = NLAYER * 16 * 32, I_W1 = NLAYER * NEXP * 16 * 64, I_W2 = NLAYER * NEXP * 16 * 32, NIT = I_IN + I_OUT + I_W1 + I_W2;
    for (int it = w.gw; it < NIT; it += w.NGW) {
        int r = it;
        if (r < I_IN) { const int l = r / 1536, rr = r % 1536, kb = rr / 96, nb = rr % 96;
            const int nd = nb * 32;
            const int ns = (nd < 1024) ? nd : (nd < 1792) ? C_SB + (nd - 1024) : (nd < 2688) ? C_RW + (nd - 1792) : C_DSA + (nd - 2688);
            const int nv = (nd < 1024) ? 1024 : (nd < 1792) ? INC : (nd < 2688) ? C_DSA : ((nd < INC) ? C_SB : 0);
            const float sc_ = (nd >= 256 && nd < 512) ? 0.125f : (nd >= 1024 && nd < 1280) ? 0.18033688011112042f : 1.0f;
            tr_item(A.in[I_WIN] + (size_t)l * DM * INC, INC, nv, kb * 64, ns, (bf16*)(A.ws + WS_WIN) + (size_t)l * INCP * DM, (size_t)nd, scr, w.lane, sc_); continue; }
        r -= I_IN;
        if (r < I_OUT) { const int l = r / 512, rr = r % 512, kb = rr / 32, nb = rr % 32;
            tr_item(A.in[I_WOUT] + (size_t)l * DM * DM, DM, DM, kb * 64, nb * 32, (bf16*)(A.ws + WS_WOUT) + (size_t)l * DM * DM, (size_t)nb * 32, scr, w.lane); continue; }
        r -= I_OUT;
        if (r < I_W1) { const int le = r / 1024, rr = r % 1024, kb = rr / 64, nb = rr % 64, j = nb >> 3, bj = (nb >> 2) & 1, cc0 = (nb & 3) * 32;
            tr_item(A.in[I_MW1] + (size_t)le * DM * 2048, 2048, 2048, kb * 64, bj * 1024 + 128 * j + cc0, (bf16*)(A.ws + WS_W1) + (size_t)le * 2048 * DM, (size_t)nb * 32, scr, w.lane); continue; }
        r -= I_W1;
        { const int le = r / 512, rr = r % 512, kb = rr / 32, nb = rr % 32;
            tr_item(A.in[I_MW2] + (size_t)le * DM * DM, DM, DM, kb * 64, nb * 32, (bf16*)(A.ws + WS_W2) + (size_t)le * DM * DM, (size_t)nb * 32, scr, w.lane); }
    }
    float* RT = (float*)(A.ws + WS_ROPE); const int* pos = (const int*)A.in[I_POS];
    for (int g = w.gw * 64 + w.lane; g < MTOK * 44; g += w.NGW * 64) {
        const int tok = g / 44, f = g % 44; int co, so;
        if (f < 32) { co = f; so = 32 + f; } else if (f < 40) { co = 64 + (f - 32); so = 72 + (f - 32); } else { co = 80 + (f - 40); so = 84 + (f - 40); }
        float s, c; sincos_d((double)pos[tok] * A.invf[f], s, c);
        RT[(size_t)tok * ROPE_W + co] = c; RT[(size_t)tok * ROPE_W + so] = s;
    }
}

__device__ __forceinline__ void emit_h_row(const f32x4 (&v)[4], float rstd, const float* g, const float* sc, const float* sh, bf16* hrow, int lane) {
#pragma unroll
    for (int j = 0; j < 4; ++j) { const int k = 4 * (lane + 64 * j);
        const f32x4 gv = *(const f32x4*)(g + k), scv = *(const f32x4*)(sc + k), shv = *(const f32x4*)(sh + k);
        const f32x4 h = v[j] * rstd * gv * (1.0f + scv) + shv;
        v2u o; o.x = pk2(h.x, h.y); o.y = pk2(h.z, h.w); *(v2u*)(hrow + k) = o; }
}
__device__ __forceinline__ void small_weights_to_f16(ARef A, const WI& w) {
    { _Float16* SW = (_Float16*)(A.ws + WS_SMALLW);
      const int g0 = w.gw * 64 + w.lane, gs = w.NGW * 64;
      for (int l = 0; l < NLAYER; ++l) { _Float16* S = SW + (size_t)l * SMW_LAYER;
          const float* wq = A.in[I_WQ] + (size_t)l * 128 * 256; const float* wqi = A.in[I_WQI] + (size_t)l * 128 * 256;
          for (int e = g0; e < 256 * 128; e += gs) { const int n = e >> 7, k = e & 127; S[SMW_QI + e] = (_Float16)wq[k * 256 + n]; S[SMW_QI + 256 * 128 + e] = (_Float16)wqi[k * 256 + n]; }
          const float* w2 = A.in[I_W2] + (size_t)l * 32 * 256; const float* a2 = A.in[I_A2] + (size_t)l * 32 * 256; const float* g2 = A.in[I_G2] + (size_t)l * 64 * 256;
          for (int e = g0; e < 256 * 32; e += gs) { const int n = e >> 5, k = e & 31; S[SMW_W2 + e] = (_Float16)w2[k * 256 + n]; S[SMW_A2 + e] = (_Float16)a2[k * 256 + n]; }
          for (int e = g0; e < 256 * 64; e += gs) { const int n = e >> 6, k = e & 63; S[SMW_G2 + e] = (_Float16)g2[k * 256 + n]; } } }
}
__device__ __forceinline__ void ph_norm1(ARef A, const WI& w) {
    const float* MOD = (const float*)(A.ws + WS_MOD); bf16* H = (bf16*)(A.ws + WS_H);
    for (int m = w.gw; m < MTOK; m += w.NGW) {
        const float* xr = A.in[I_X] + (size_t)m * DM; f32x4 v[4]; float ss = 0.0f;
#pragma unroll
        for (int j = 0; j < 4; ++j) { v[j] = *(const f32x4*)(xr + 4 * (w.lane + 64 * j)); ss += dot4(v[j], v[j]); }
        ss = wave_sum(ss); const float rstd = 1.0f / sqrtf(ss * (1.0f / DM) + 1e-5f);
        const float* mb = MOD + (size_t)(m >> 12) * 6144;
        emit_h_row(v, rstd, A.in[I_NMIX], mb + 1024, mb, H + (size_t)m * DM, w.lane);
    }
}

typedef _Float16 h4v __attribute__((ext_vector_type(4)));
__device__ __forceinline__ f16x8 pack_f16x8(f32x4 a, f32x4 b) { f16x8 r; r[0] = (_Float16)a.x; r[1] = (_Float16)a.y; r[2] = (_Float16)a.z; r[3] = (_Float16)a.w; r[4] = (_Float16)b.x; r[5] = (_Float16)b.y; r[6] = (_Float16)b.z; r[7] = (_Float16)b.w; return r; }
__device__ __forceinline__ void prep16(ARef A, int l, int m0, int lane_in) {
    int lane = lane_in; asm volatile("" : "+v"(lane));
    const int tk = lane & 15, q4 = lane >> 4, m = m0 + tk, t = m & (SEQ - 1);
    const float* P = (const float*)(A.ws + WS_PF); float* RWA = (float*)(A.ws + WS_RWA); const _Float16* SW = (const _Float16*)(A.ws + WS_SMALLW) + (size_t)l * SMW_LAYER;
    const float* pr = P + (size_t)m * PFW; const float* pp = pr - PFW; const float* pd = P + (size_t)m * PFW + PF_DSA; const float* mu = A.in[I_MU] + l * 896;
    const float* RT = (const float*)(A.ws + WS_ROPE) + (size_t)m * ROPE_W; const f32x4 zero4 = {0.f, 0.f, 0.f, 0.f};
    f16x8 bx[4], bc[4];
    { float ss = 0.0f; f32x4 c[4][2];
#pragma unroll
      for (int ks = 0; ks < 4; ++ks) { const int f0 = 32 * ks + 8 * q4;
          f32x4 x[2];
#pragma unroll
          for (int u = 0; u < 2; ++u) { const f32x4 z = *(const f32x4*)(pr + 768 + f0 + 4 * u); const f32x4 p = t ? *(const f32x4*)(pp + 768 + f0 + 4 * u) : zero4; x[u] = z + (p - z) * *(const f32x4*)(mu + 768 + f0 + 4 * u);
#pragma unroll
              for (int i = 0; i < 4; ++i) x[u][i] = (ks == 0) ? tanhf(x[u][i]) : (ks == 1) ? x[u][i] : sigm(x[u][i]); }
          bx[ks] = pack_f16x8(x[0], x[1]);
          c[ks][0] = *(const f32x4*)(pd + f0); c[ks][1] = *(const f32x4*)(pd + f0 + 4); ss += dot4(c[ks][0], c[ks][0]) + dot4(c[ks][1], c[ks][1]); }
      ss += __shfl_xor(ss, 16); ss += __shfl_xor(ss, 32);
      const float rstd = 1.0f / sqrtf(ss * (1.0f / 128.0f) + 1e-5f); const float* qn = A.in[I_QNORM] + l * 128;
#pragma unroll
      for (int ks = 0; ks < 4; ++ks) { const int f0 = 32 * ks + 8 * q4; bc[ks] = pack_f16x8(c[ks][0] * rstd * *(const f32x4*)(qn + f0), c[ks][1] * rstd * *(const f32x4*)(qn + f0 + 4)); } }
    const _Float16* wrow = SW + (size_t)tk * 0;
    (void)wrow;
    const int arow = lane & 15;
#pragma unroll 1
    for (int hd = 0; hd < 4; ++hd) {
        f32x4 fk[4], av[4]; float ssk = 0.0f;
#pragma unroll
        for (int j = 0; j < 4; ++j) { const int nb = 4 * hd + j, ch = 16 * nb + 4 * q4; const size_t o = (size_t)m * 256 + ch;
            const f16x8 aw = *(const f16x8*)(SW + SMW_W2 + (16 * nb + arow) * 32 + 8 * q4), aa = *(const f16x8*)(SW + SMW_A2 + (16 * nb + arow) * 32 + 8 * q4);
            const f16x8 ag0 = *(const f16x8*)(SW + SMW_G2 + (16 * nb + arow) * 64 + 8 * q4), ag1 = *(const f16x8*)(SW + SMW_G2 + (16 * nb + arow) * 64 + 32 + 8 * q4);
            const f32x4 cw = __builtin_amdgcn_mfma_f32_16x16x32_f16(aw, bx[0], *(const f32x4*)(A.in[I_W0] + l * 256 + ch), 0, 0, 0);
            const f32x4 ca = __builtin_amdgcn_mfma_f32_16x16x32_f16(aa, bx[1], *(const f32x4*)(A.in[I_A0] + l * 256 + ch), 0, 0, 0);
            f32x4 cg = __builtin_amdgcn_mfma_f32_16x16x32_f16(ag0, bx[2], zero4, 0, 0, 0); cg = __builtin_amdgcn_mfma_f32_16x16x32_f16(ag1, bx[3], cg, 0, 0, 0);
            f32x4 dec;
#pragma unroll
            for (int i = 0; i < 4; ++i) { dec[i] = expf(-expf(-softplusf(-cw[i]) - 0.5f)); av[j][i] = sigm(ca[i]); }
            *(f32x4*)(RWA + 1 * RWA_STRIDE + o) = dec; *(f32x4*)(RWA + 6 * RWA_STRIDE + o) = cg;
            { const f32x4 z = *(const f32x4*)(pr + 256 + ch); const f32x4 p = t ? *(const f32x4*)(pp + 256 + ch) : zero4; fk[j] = z + (p - z) * *(const f32x4*)(mu + 256 + ch); }
            const f32x4 kk = fk[j] * *(const f32x4*)(A.in[I_KK] + l * 256 + ch); ssk += dot4(kk, kk); }
        ssk += __shfl_xor(ssk, 16); ssk += __shfl_xor(ssk, 32);
        const float inrm = 1.0f / fmaxf(sqrtf(ssk), 1e-12f);
        f32x4 fr[4], km[4]; float bs = 0.0f;
#pragma unroll
        for (int j = 0; j < 4; ++j) { const int ch = 16 * (4 * hd + j) + 4 * q4;
            { const f32x4 z = *(const f32x4*)(pr + ch); const f32x4 p = t ? *(const f32x4*)(pp + ch) : zero4; fr[j] = z + (p - z) * *(const f32x4*)(mu + ch); }
            km[j] = fk[j] * (1.0f + (av[j] - 1.0f) * *(const f32x4*)(A.in[I_KA] + l * 256 + ch)); bs += dot4(fr[j] * km[j], *(const f32x4*)(A.in[I_RK] + l * 256 + ch)); }
        bs += __shfl_xor(bs, 16); bs += __shfl_xor(bs, 32);
#pragma unroll
        for (int j = 0; j < 4; ++j) { const int ch = 16 * (4 * hd + j) + 4 * q4; const size_t o = (size_t)m * 256 + ch;
            f32x4 fv; { const f32x4 z = *(const f32x4*)(pr + 512 + ch); const f32x4 p = t ? *(const f32x4*)(pp + 512 + ch) : zero4; fv = z + (p - z) * *(const f32x4*)(mu + 512 + ch); }
            const f32x4 kk = fk[j] * *(const f32x4*)(A.in[I_KK] + l * 256 + ch) * inrm;
            *(f32x4*)(RWA + 0 * RWA_STRIDE + o) = fr[j]; *(f32x4*)(RWA + 2 * RWA_STRIDE + o) = km[j]; *(f32x4*)(RWA + 3 * RWA_STRIDE + o) = fv;
            *(f32x4*)(RWA + 4 * RWA_STRIDE + o) = -kk; *(f32x4*)(RWA + 5 * RWA_STRIDE + o) = kk * av[j]; *(f32x4*)(RWA + 7 * RWA_STRIDE + o) = bs * fv; }
    }
#pragma unroll 1
    for (int nb = 0; nb < 32; ++nb) {
        f32x4 cq = zero4;
#pragma unroll
        for (int ks = 0; ks < 4; ++ks) { const f16x8 aq = *(const f16x8*)(SW + SMW_QI + (16 * nb + arow) * 128 + 32 * ks + 8 * q4); cq = __builtin_amdgcn_mfma_f32_16x16x32_f16(aq, bc[ks], cq, 0, 0, 0); }
        const int ch = 16 * (nb & 15) + 4 * q4;
        if (nb < 16) {
            if ((nb & 3) == 0) { const f32x4 ot = shx4(cq, 32); const int fi = 4 * (q4 & 1); const f32x4 cs4 = *(const f32x4*)(RT + 64 + fi), sn = *(const f32x4*)(RT + 72 + fi); cq = (q4 < 2) ? cq * cs4 - ot * sn : ot * sn + cq * cs4; }
            const f32x4 qs = cq * 0.18033688011112042f; v2u o; o.x = pk2(qs.x, qs.y); o.y = pk2(qs.z, qs.w); *(v2u*)((bf16*)(A.ws + WS_DQ) + (size_t)m * 256 + ch) = o;
        } else {
            if ((nb & 1) == 0) { const f32x4 ot = shx4(cq, 16); const f32x4 cs4 = *(const f32x4*)(RT + 80), sn = *(const f32x4*)(RT + 84); if (q4 < 2) cq = (q4 < 1) ? cq * cs4 - ot * sn : ot * sn + cq * cs4; }
            h4v hq; hq.x = (_Float16)cq.x; hq.y = (_Float16)cq.y; hq.z = (_Float16)cq.z; hq.w = (_Float16)cq.w; *(h4v*)((_Float16*)(A.ws + WS_DQI) + (size_t)m * 256 + ch) = hq;
        }
    }
#pragma unroll
    for (int j = 0; j < 4; ++j) { const int d = 16 * j + 4 * q4; f32x4 kx = *(const f32x4*)(pd + 128 + d);
        if (j == 0) { const f32x4 ot = shx4(kx, 32); const int fi = 4 * (q4 & 1); const f32x4 cs4 = *(const f32x4*)(RT + 64 + fi), sn = *(const f32x4*)(RT + 72 + fi); kx = (q4 < 2) ? kx * cs4 - ot * sn : ot * sn + kx * cs4; }
        v2u o; o.x = pk2(kx.x, kx.y); o.y = pk2(kx.z, kx.w); *(v2u*)((bf16*)(A.ws + WS_DKB) + (size_t)m * 64 + d) = o;
        const f32x4 vx = *(const f32x4*)(pd + 192 + d); v2u ov; ov.x = pk2(vx.x, vx.y); ov.y = pk2(vx.z, vx.w); *(v2u*)((bf16*)(A.ws + WS_DVB) + (size_t)m * 64 + d) = ov; }
#pragma unroll
    for (int j = 0; j < 2; ++j) { const int d = 16 * j + 4 * q4; f32x4 ki = *(const f32x4*)(pd + 256 + d);
        if (j == 0) { const f32x4 ot = shx4(ki, 16); const f32x4 cs4 = *(const f32x4*)(RT + 80), sn = *(const f32x4*)(RT + 84); if (q4 < 2) ki = (q4 < 1) ? ki * cs4 - ot * sn : ot * sn + ki * cs4; }
        h4v hk; hk.x = (_Float16)ki.x; hk.y = (_Float16)ki.y; hk.z = (_Float16)ki.z; hk.w = (_Float16)ki.w; *(h4v*)((_Float16*)(A.ws + WS_DKI) + (size_t)m * 32 + d) = hk; }
    if (q4 < 2) *(f32x4*)((float*)(A.ws + WS_DW) + (size_t)m * 8 + 4 * q4) = *(const f32x4*)(pd + 288 + 4 * q4) * 0.0625f;
}
__device__ __forceinline__ float quad_sum(float v) {
    v += __builtin_bit_cast(float, __builtin_amdgcn_mov_dpp(__builtin_bit_cast(int, v), 0xB1, 0xF, 0xF, true));
    v += __builtin_bit_cast(float, __builtin_amdgcn_mov_dpp(__builtin_bit_cast(int, v), 0x4E, 0xF, 0xF, true));
    return v;
}
__device__ __forceinline__ float oct_sum(float v) {
    v += __builtin_bit_cast(float, __builtin_amdgcn_mov_dpp(__builtin_bit_cast(int, v), 0xB1, 0xF, 0xF, true));
    v += __builtin_bit_cast(float, __builtin_amdgcn_mov_dpp(__builtin_bit_cast(int, v), 0x4E, 0xF, 0xF, true));
    v += __builtin_bit_cast(float, __builtin_amdgcn_mov_dpp(__builtin_bit_cast(int, v), 0x141, 0xF, 0xF, true));
    return v;
}
#define RW_LOAD(op, s_) do { const int lo_ = (s_) * 64 + kq * 8; \
    op[0] = *(const LAS f32x4*)(sn + lo_); op[1] = *(const LAS f32x4*)(sn + lo_ + 4); op[2] = *(const LAS f32x4*)(sw + lo_); op[3] = *(const LAS f32x4*)(sw + lo_ + 4); \
    op[4] = *(const LAS f32x4*)(sb + lo_); op[5] = *(const LAS f32x4*)(sb + lo_ + 4); op[6] = *(const LAS f32x4*)(sk + lo_); op[7] = *(const LAS f32x4*)(sk + lo_ + 4); \
    op[8] = *(const LAS f32x4*)(sr + lo_); op[9] = *(const LAS f32x4*)(sr + lo_ + 4); \
    _Pragma("unroll") for (int i_ = 0; i_ < 4; ++i_) vin[i_] = (ws < 2) ? sv[(s_) * 64 + rbase + 8 * i_] : 0.0f; } while (0)
#define RW_STEP(op, vv, s_) do { float sa_[4], y_[4]; \
    _Pragma("unroll") for (int i_ = 0; i_ < 4; ++i_) sa_[i_] = (S[i_][0] * op[0].x + S[i_][1] * op[0].y) + (S[i_][2] * op[0].z + S[i_][3] * op[0].w) + ((S[i_][4] * op[1].x + S[i_][5] * op[1].y) + (S[i_][6] * op[1].z + S[i_][7] * op[1].w)); \
    _Pragma("unroll") for (int i_ = 0; i_ < 4; ++i_) sa_[i_] += __builtin_bit_cast(float, __builtin_amdgcn_mov_dpp(__builtin_bit_cast(int, sa_[i_]), 0xB1, 0xF, 0xF, true)); \
    _Pragma("unroll") for (int i_ = 0; i_ < 4; ++i_) sa_[i_] += __builtin_bit_cast(float, __builtin_amdgcn_mov_dpp(__builtin_bit_cast(int, sa_[i_]), 0x4E, 0xF, 0xF, true)); \
    _Pragma("unroll") for (int i_ = 0; i_ < 4; ++i_) sa_[i_] += __builtin_bit_cast(float, __builtin_amdgcn_mov_dpp(__builtin_bit_cast(int, sa_[i_]), 0x141, 0xF, 0xF, true)); \
    _Pragma("unroll") for (int i_ = 0; i_ < 4; ++i_) { const float v_ = vv[i_]; \
        S[i_][0] = S[i_][0] * op[2].x + (sa_[i_] * op[4].x + v_ * op[6].x); S[i_][1] = S[i_][1] * op[2].y + (sa_[i_] * op[4].y + v_ * op[6].y); S[i_][2] = S[i_][2] * op[2].z + (sa_[i_] * op[4].z + v_ * op[6].z); S[i_][3] = S[i_][3] * op[2].w + (sa_[i_] * op[4].w + v_ * op[6].w); \
        S[i_][4] = S[i_][4] * op[3].x + (sa_[i_] * op[5].x + v_ * op[7].x); S[i_][5] = S[i_][5] * op[3].y + (sa_[i_] * op[5].y + v_ * op[7].y); S[i_][6] = S[i_][6] * op[3].z + (sa_[i_] * op[5].z + v_ * op[7].z); S[i_][7] = S[i_][7] * op[3].w + (sa_[i_] * op[5].w + v_ * op[7].w); } \
    _Pragma("unroll") for (int i_ = 0; i_ < 4; ++i_) y_[i_] = (S[i_][0] * op[8].x + S[i_][1] * op[8].y) + (S[i_][2] * op[8].z + S[i_][3] * op[8].w) + ((S[i_][4] * op[9].x + S[i_][5] * op[9].y) + (S[i_][6] * op[9].z + S[i_][7] * op[9].w)); \
    _Pragma("unroll") for (int i_ = 0; i_ < 4; ++i_) y_[i_] += __builtin_bit_cast(float, __builtin_amdgcn_mov_dpp(__builtin_bit_cast(int, y_[i_]), 0xB1, 0xF, 0xF, true)); \
    _Pragma("unroll") for (int i_ = 0; i_ < 4; ++i_) y_[i_] += __builtin_bit_cast(float, __builtin_amdgcn_mov_dpp(__builtin_bit_cast(int, y_[i_]), 0x4E, 0xF, 0xF, true)); \
    _Pragma("unroll") for (int i_ = 0; i_ < 4; ++i_) y_[i_] += __builtin_bit_cast(float, __builtin_amdgcn_mov_dpp(__builtin_bit_cast(int, y_[i_]), 0x141, 0xF, 0xF, true)); \
    if (kq == 0) { _Pragma("unroll") for (int i_ = 0; i_ < 4; ++i_) so[(s_) * 128 + rbase + 8 * i_] = y_[i_]; } } while (0)
__device__ __forceinline__ void scan_rwkv_task2(ARef A, const WI& w, int task0) {
    const int slot = w.wave >> 2, ws = w.wave & 3, lt = w.tid & 255, task = task0 + slot;
    const int bh = task >> 4, c = task & 15, b = bh >> 2, h = bh & 3;
    LAS float* sw = (LAS float*)w.lds + slot * 16384; LAS float* sn = sw + 2048; LAS float* sb = sn + 2048; LAS float* sk = sb + 2048; LAS float* sr = sk + 2048; LAS float* sv = sr + 2048; LAS float* so = sv + 2048;
    const float* RWA = (const float*)(A.ws + WS_RWA);
    const int rg = w.lane >> 3, kq = w.lane & 7, rbase = 32 * ws + rg;
    float S[4][8];
#pragma unroll
    for (int i = 0; i < 4; ++i)
#pragma unroll
        for (int j = 0; j < 8; ++j) { const int r = rbase + 8 * i; S[i][j] = (r >= 64 && 8 * kq + j == r - 64) ? 1.0f : 0.0f; }
    const size_t tok0 = (size_t)b * SEQ + (size_t)c * TCH;
    const int st = lt >> 3, sd = (lt & 7) * 8;
    f32x4 a[6][2];
#define RW_GLOAD(sub_) do { const size_t o_ = (tok0 + (sub_) * 32 + st) * 256 + h * 64 + sd; \
        _Pragma("unroll") for (int q = 0; q < 2; ++q) { a[0][q] = *(const f32x4*)(RWA + 1 * RWA_STRIDE + o_ + 4 * q); a[1][q] = *(const f32x4*)(RWA + 4 * RWA_STRIDE + o_ + 4 * q); a[2][q] = *(const f32x4*)(RWA + 5 * RWA_STRIDE + o_ + 4 * q); \
            a[3][q] = *(const f32x4*)(RWA + 2 * RWA_STRIDE + o_ + 4 * q); a[4][q] = *(const f32x4*)(RWA + 0 * RWA_STRIDE + o_ + 4 * q); a[5][q] = *(const f32x4*)(RWA + 3 * RWA_STRIDE + o_ + 4 * q); } } while (0)
    RW_GLOAD(0);
    for (int sub = 0; sub < TCH / 32; ++sub) {
        __syncthreads();
        { const int lo = st * 64 + sd;
#pragma unroll
          for (int q = 0; q < 2; ++q) { *(LAS f32x4*)(sw + lo + 4 * q) = a[0][q]; *(LAS f32x4*)(sn + lo + 4 * q) = a[1][q]; *(LAS f32x4*)(sb + lo + 4 * q) = a[2][q]; *(LAS f32x4*)(sk + lo + 4 * q) = a[3][q]; *(LAS f32x4*)(sr + lo + 4 * q) = a[4][q]; *(LAS f32x4*)(sv + lo + 4 * q) = a[5][q]; } }
        __syncthreads();
        if (sub + 1 < TCH / 32) RW_GLOAD(sub + 1);
        { f32x4 opA[10], opB[10]; float vin[4], vA[4], vB[4];
          RW_LOAD(opA, 0);
#pragma unroll
          for (int i = 0; i < 4; ++i) vA[i] = vin[i];
#pragma unroll 1
          for (int s = 0; s < 32; s += 2) {
              RW_LOAD(opB, s + 1);
#pragma unroll
              for (int i = 0; i < 4; ++i) vB[i] = vin[i];
              RW_STEP(opA, vA, s);
              if (s + 2 < 32) { RW_LOAD(opA, s + 2);
#pragma unroll
                  for (int i = 0; i < 4; ++i) vA[i] = vin[i]; }
              RW_STEP(opB, vB, s + 1);
          } }
        __syncthreads();
        { const int fs = lt >> 3, c16 = (lt & 7) * 16;
          float* dst = (c16 < 64) ? ((float*)(A.ws + WS_YO) + YO_STRIDE) : ((float*)(A.ws + WS_PT) - 64);
          float* dp = dst + (tok0 + sub * 32 + fs) * 256 + h * 64 + c16;
#pragma unroll
          for (int q = 0; q < 4; ++q) *(f32x4*)(dp + 4 * q) = *(const LAS f32x4*)(so + fs * 128 + c16 + 4 * q); }
    }
    { float* ch = (float*)(A.ws + WS_CH) + ((size_t)(bh * NCH + c) * 128) * 64 + 8 * kq;
#pragma unroll
      for (int i = 0; i < 4; ++i) { float* cr = ch + (size_t)(rbase + 8 * i) * 64; *(f32x4*)cr = (f32x4){S[i][0], S[i][1], S[i][2], S[i][3]}; *(f32x4*)(cr + 4) = (f32x4){S[i][4], S[i][5], S[i][6], S[i][7]}; } }
    __syncthreads();
}
#undef RW_LOAD
#undef RW_STEP
#undef RW_GLOAD
__device__ __forceinline__ void scan_ret_task(ARef A, const WI& w, int task) {
    const int bh = task >> 3, cp = task & 7, b = bh >> 2, h = bh & 3, un = w.tid >> 8, lt = w.tid & 255, c = 2 * cp + un;
    const float lg2g = log2f(1.0f - exp2f(-5.0f - (float)h)), gamma = exp2f(lg2g);
    LAS float* sk = (LAS float*)w.lds + un * 8192; LAS float* sq = sk + 2048; LAS float* sv = sq + 2048; LAS float* so = sv + 2048;
    const bf16* PB = (const bf16*)(A.ws + WS_PB); const float* RT = (const float*)(A.ws + WS_ROPE);
    const int row = lt >> 2, kq = lt & 3;
    float S[16];
#pragma unroll
    for (int j = 0; j < 16; ++j) S[j] = 0.0f;
    const size_t tok0 = (size_t)b * SEQ + (size_t)c * TCH;
    const int st = lt >> 3, sd = (lt & 7) * 8;
    const int fi = sd & 31, dp = sd ^ 32;
    f32x4 gq[2], gqo[2], gk[2], gko[2], gv[2], gcs[2], gsn[2];
#define BF8_TO_F32(dst, x_) do { dst[0] = (f32x4){bf_lo(x_.x), bf_hi(x_.x), bf_lo(x_.y), bf_hi(x_.y)}; dst[1] = (f32x4){bf_lo(x_.z), bf_hi(x_.z), bf_lo(x_.w), bf_hi(x_.w)}; } while (0)
#define RT_GLOAD(sub_) do { const size_t m_ = tok0 + (sub_) * 32 + st; const bf16* pr_ = PB + m_ * PBW + h * 64; const float* rt_ = RT + m_ * ROPE_W; \
        _Pragma("unroll") for (int u = 0; u < 2; ++u) { gcs[u] = *(const f32x4*)(rt_ + fi + 4 * u); gsn[u] = *(const f32x4*)(rt_ + 32 + fi + 4 * u); } \
        { const v4u x0 = *(const v4u*)(pr_ + sd), x1 = *(const v4u*)(pr_ + dp), x2 = *(const v4u*)(pr_ + 256 + sd), x3 = *(const v4u*)(pr_ + 256 + dp), x4 = *(const v4u*)(pr_ + 512 + sd); \
          BF8_TO_F32(gq, x0); BF8_TO_F32(gqo, x1); BF8_TO_F32(gk, x2); BF8_TO_F32(gko, x3); BF8_TO_F32(gv, x4); } } while (0)
    RT_GLOAD(0);
    for (int sub = 0; sub < TCH / 32; ++sub) {
        const size_t m = tok0 + sub * 32 + st;
        f32x4 qn[2], kn[2], vn[2];
#pragma unroll
        for (int u = 0; u < 2; ++u) { qn[u] = (sd < 32) ? gq[u] * gcs[u] - gqo[u] * gsn[u] : gqo[u] * gsn[u] + gq[u] * gcs[u]; kn[u] = (sd < 32) ? gk[u] * gcs[u] - gko[u] * gsn[u] : gko[u] * gsn[u] + gk[u] * gcs[u]; vn[u] = gv[u]; }
        { const float gt = exp2f(lg2g * (float)(sub * 32 + st + 1)); const f32x4 p0 = qn[0] * gt, p1 = qn[1] * gt;
          v4u pw; pw.x = pk2(p0.x, p0.y); pw.y = pk2(p0.z, p0.w); pw.z = pk2(p1.x, p1.y); pw.w = pk2(p1.z, p1.w); *(v4u*)((bf16*)(A.ws + WS_PTR) + m * 256 + h * 64 + sd) = pw; }
        __syncthreads();
        { const int lo = st * 64 + sd; *(LAS f32x4*)(sq + lo) = qn[0]; *(LAS f32x4*)(sq + lo + 4) = qn[1]; *(LAS f32x4*)(sk + lo) = kn[0]; *(LAS f32x4*)(sk + lo + 4) = kn[1]; *(LAS f32x4*)(sv + lo) = vn[0]; *(LAS f32x4*)(sv + lo + 4) = vn[1]; }
        __syncthreads();
        if (sub + 1 < TCH / 32) RT_GLOAD(sub + 1);
        for (int s = 0; s < 32; ++s) {
            const int lo = s * 64 + kq * 16; const float vv = sv[s * 64 + row]; float y = 0.0f;
#pragma unroll
            for (int j4 = 0; j4 < 4; ++j4) { const f32x4 kv = *(const LAS f32x4*)(sk + lo + 4 * j4), rv = *(const LAS f32x4*)(sq + lo + 4 * j4);
                S[4 * j4] = S[4 * j4] * gamma + vv * kv.x; S[4 * j4 + 1] = S[4 * j4 + 1] * gamma + vv * kv.y; S[4 * j4 + 2] = S[4 * j4 + 2] * gamma + vv * kv.z; S[4 * j4 + 3] = S[4 * j4 + 3] * gamma + vv * kv.w;
                y += (S[4 * j4] * rv.x + S[4 * j4 + 1] * rv.y) + (S[4 * j4 + 2] * rv.z + S[4 * j4 + 3] * rv.w); }
            y = quad_sum(y);
            if (kq == 0) so[s * 64 + row] = y;
        }
        __syncthreads();
        { const int fs = lt >> 3, c8 = (lt & 7) * 8; float* dp2 = (float*)(A.ws + WS_YO) + (tok0 + sub * 32 + fs) * 256 + h * 64 + c8;
          *(f32x4*)dp2 = *(const LAS f32x4*)(so + fs * 64 + c8); *(f32x4*)(dp2 + 4) = *(const LAS f32x4*)(so + fs * 64 + c8 + 4); }
    }
    { float* ch = (float*)(A.ws + WS_CHR) + ((size_t)(bh * NCH + c) * 64 + row) * 64 + 16 * kq;
#pragma unroll
      for (int j4 = 0; j4 < 4; ++j4) *(f32x4*)(ch + 4 * j4) = (f32x4){S[4 * j4], S[4 * j4 + 1], S[4 * j4 + 2], S[4 * j4 + 3]}; }
    __syncthreads();
}
#undef RT_GLOAD
#undef BF8_TO_F32
__device__ __forceinline__ void prefix_chain(ARef A, const WI& w, int bh) {
    LAS float* s0 = (LAS float*)w.lds;
    const int v = w.tid >> 3, k8 = (w.tid & 7) * 8;
    const float* CH = (const float*)(A.ws + WS_CH) + (size_t)bh * NCH * 128 * 64; float* SI = (float*)(A.ws + WS_SI) + (size_t)bh * NCH * 64 * 64;
    f32x4 c0 = {0.f, 0.f, 0.f, 0.f}, c1 = {0.f, 0.f, 0.f, 0.f};
    for (int c = 0; c < NCH; ++c) {
        *(f32x4*)(SI + ((size_t)c * 64 + v) * 64 + k8) = c0; *(f32x4*)(SI + ((size_t)c * 64 + v) * 64 + k8 + 4) = c1;
        if (c == NCH - 1) break;
        __syncthreads();
        *(LAS f32x4*)(s0 + v * 68 + k8) = c0; *(LAS f32x4*)(s0 + v * 68 + k8 + 4) = c1;
        __syncthreads();
        const float* ch = CH + (size_t)c * 128 * 64;
        f32x4 n0 = *(const f32x4*)(ch + (size_t)v * 64 + k8), n1 = *(const f32x4*)(ch + (size_t)v * 64 + k8 + 4);
#pragma unroll 8
        for (int kp = 0; kp < 64; ++kp) { const float s = s0[v * 68 + kp]; const float* pr = ch + (size_t)(64 + kp) * 64 + k8; n0 += s * *(const f32x4*)pr; n1 += s * *(const f32x4*)(pr + 4); }
        c0 = n0; c1 = n1;
    }
    const int h = bh & 3; const float gT = exp2f((float)TCH * log2f(1.0f - exp2f(-5.0f - (float)h)));
    const float* CHR = (const float*)(A.ws + WS_CHR) + (size_t)bh * NCH * 64 * 64; float* SIR = (float*)(A.ws + WS_SIR) + (size_t)bh * NCH * 64 * 64;
    c0 = (f32x4){0.f, 0.f, 0.f, 0.f}; c1 = c0;
    for (int c = 0; c < NCH; ++c) {
        *(f32x4*)(SIR + ((size_t)c * 64 + v) * 64 + k8) = c0; *(f32x4*)(SIR + ((size_t)c * 64 + v) * 64 + k8 + 4) = c1;
        if (c == NCH - 1) break;
        c0 = c0 * gT + *(const f32x4*)(CHR + ((size_t)c * 64 + v) * 64 + k8); c1 = c1 * gT + *(const f32x4*)(CHR + ((size_t)c * 64 + v) * 64 + k8 + 4);
    }
    __syncthreads();
}
typedef float f32x16 __attribute__((ext_vector_type(16)));
constexpr int SBV_PITCH = 144;
__device__ __forceinline__ float lane32_swap(float v) { return __shfl_xor(v, 32); }
__device__ __forceinline__ void sb_tile_mfma(ARef A, int unit, int lane, LAS unsigned char* vl) {
    const int tq = unit & 127, bh = unit >> 7, b = bh >> 2, h = bh & 3, t0 = tq * 32, r32 = lane & 31, hi = lane >> 5;
    const bf16* PS = (const bf16*)(A.ws + WS_PB) + (size_t)b * SEQ * PBW + PB_SB + h * 64;
    bf16x8v qf[4];
#pragma unroll
    for (int ks = 0; ks < 4; ++ks) qf[ks] = *(const bf16x8v*)(PS + (size_t)(t0 + r32) * PBW + 16 * ks + 8 * hi);
    f32x16 o0, o1;
#pragma unroll
    for (int r = 0; r < 16; ++r) { o0[r] = 0.0f; o1[r] = 0.0f; }
    float carry = 0.0f;
    const int g16 = lane >> 4, tj = (lane & 15) >> 2, tc = lane & 3;
    for (int kb0 = t0; kb0 >= 0; kb0 -= 32) {
#pragma unroll
        for (int i = 0; i < 4; ++i) { const int p = lane + 64 * i, row = p >> 3, ch = p & 7; const v4u v = *(const v4u*)(PS + 512 + (size_t)(kb0 + row) * PBW + 8 * ch); *(LAS v4u*)(vl + row * SBV_PITCH + 16 * ch) = v; }
        f32x16 st;
#pragma unroll
        for (int r = 0; r < 16; ++r) st[r] = 0.0f;
        { bf16x8v ka[4];
#pragma unroll
          for (int ks = 0; ks < 4; ++ks) ka[ks] = *(const bf16x8v*)(PS + 256 + (size_t)(kb0 + r32) * PBW + 16 * ks + 8 * hi);
#pragma unroll
          for (int ks = 0; ks < 4; ++ks) st = __builtin_amdgcn_mfma_f32_32x32x16_bf16(ka[ks], qf[ks], st, 0, 0, 0);
          asm volatile("" :: "v"(ka[0]), "v"(ka[1]), "v"(ka[2]), "v"(ka[3]), "v"(st)); }
        float sp[16]; const bool diag = (kb0 == t0);
#pragma unroll
        for (int r = 0; r < 16; ++r) { const float zl = st[r]; float s = (zl > 30.0f) ? zl : __builtin_amdgcn_logf(1.0f + __builtin_amdgcn_exp2f(zl));
            if (diag && ((r & 3) + 8 * (r >> 2) + 4 * hi >= r32)) s = 0.0f;
            sp[r] = s; }
        float G[4], Gp[4], suf[4];
#pragma unroll
        for (int q = 0; q < 4; ++q) { G[q] = (sp[4 * q] + sp[4 * q + 1]) + (sp[4 * q + 2] + sp[4 * q + 3]); Gp[q] = lane32_swap(G[q]); }
        suf[3] = 0.0f; suf[2] = G[3] + Gp[3]; suf[1] = suf[2] + (G[2] + Gp[2]); suf[0] = suf[1] + (G[1] + Gp[1]);
        const float tot = suf[0] + (G[0] + Gp[0]);
        pg8::u32x4 pw0, pw1;
        float av[16];
#pragma unroll
        for (int q = 0; q < 4; ++q) { float run = carry + suf[q] + (hi == 0 ? Gp[q] : 0.0f);
#pragma unroll
            for (int i = 3; i >= 0; --i) { const int r = 4 * q + i; const float la = (st[r] - sp[r]) - run; float a = __builtin_amdgcn_exp2f(la);
                if (diag && ((r & 3) + 8 * (r >> 2) + 4 * hi >= r32)) a = 0.0f;
                av[r] = a; run += sp[r]; } }
        pw0.x = pg8::cvt_pk_bf16(av[0], av[1]); pw0.y = pg8::cvt_pk_bf16(av[2], av[3]); pw0.z = pg8::cvt_pk_bf16(av[4], av[5]); pw0.w = pg8::cvt_pk_bf16(av[6], av[7]);
        pw1.x = pg8::cvt_pk_bf16(av[8], av[9]); pw1.y = pg8::cvt_pk_bf16(av[10], av[11]); pw1.z = pg8::cvt_pk_bf16(av[12], av[13]); pw1.w = pg8::cvt_pk_bf16(av[14], av[15]);
        const bf16x8v pa0 = __builtin_bit_cast(bf16x8v, pw0), pa1 = __builtin_bit_cast(bf16x8v, pw1);
        LDS_WAIT();
#pragma unroll
        for (int s = 0; s < 2; ++s)
#pragma unroll
            for (int nb = 0; nb < 2; ++nb) {
                LAS unsigned char* a1 = vl + (16 * s + 4 * (g16 >> 1) + tj) * SBV_PITCH + (32 * nb + 16 * (g16 & 1) + 4 * tc) * 2;
                const s16x4v r1 = __builtin_bit_cast(s16x4v, __builtin_amdgcn_ds_read_tr16_b64_v4i16((LAS s16x4v*)a1));
                const s16x4v r2 = __builtin_bit_cast(s16x4v, __builtin_amdgcn_ds_read_tr16_b64_v4i16((LAS s16x4v*)(a1 + 8 * SBV_PITCH)));
                const bf16x8v bv = {r1[0], r1[1], r1[2], r1[3], r2[0], r2[1], r2[2], r2[3]};
                if (nb == 0) o0 = __builtin_amdgcn_mfma_f32_32x32x16_bf16(s ? pa1 : pa0, bv, o0, 0, 0, 0); else o1 = __builtin_amdgcn_mfma_f32_32x32x16_bf16(s ? pa1 : pa0, bv, o1, 0, 0, 0);
                asm volatile("" :: "v"(bv), "v"(pa0), "v"(pa1), "v"(o0), "v"(o1)); }
        LDS_WAIT();
        carry += tot;
        if (__all(carry > 150.0f)) break;
    }
    float* YS = (float*)(A.ws + WS_YO) + 3 * YO_STRIDE + ((size_t)b * SEQ + t0) * 256 + h * 64 + r32;
#pragma unroll
    for (int r = 0; r < 16; ++r) { const int qo = (r & 3) + 8 * (r >> 2) + 4 * hi; YS[(size_t)qo * 256] = o0[r]; YS[(size_t)qo * 256 + 32] = o1[r]; }
}

__device__ __forceinline__ void dsa_scores_mfma(ARef A, const WI& w) {
    const _Float16* QIH = (const _Float16*)(A.ws + WS_DQI); const _Float16* KIH = (const _Float16*)(A.ws + WS_DKI);
    const float* DW = (const float*)(A.ws + WS_DW); float* SC = (float*)(A.ws + WS_SC);
    const int col = w.lane & 15, q4 = w.lane >> 4;
    for (int u = w.gw; u < 2048; u += w.NGW) {
        const int pi = u >> 1, par = u & 1, b = pi >> 7, p = pi & 127;
#pragma unroll 1
        for (int side = 0; side < 2; ++side) {
            const int qb = side ? 255 - p : p; const size_t m0 = (size_t)b * SEQ + 16 * qb;
            f16x8 bq[8];
#pragma unroll
            for (int h = 0; h < 8; ++h) bq[h] = *(const f16x8*)(QIH + (m0 + col) * 256 + h * 32 + 8 * q4);
            const float* dw = DW + (m0 + col) * 8; const f32x4 wa = *(const f32x4*)dw, wb = *(const f32x4*)(dw + 4);
            float* srow = SC + (m0 + col) * SEQ + 4 * q4;
            const _Float16* kbase = KIH + ((size_t)b * SEQ + col) * 32 + 8 * q4;
            for (int kb = par; kb <= qb; kb += 2) {
                const f16x8 ak = *(const f16x8*)(kbase + (size_t)kb * 16 * 32);
                f32x4 acc = {0.f, 0.f, 0.f, 0.f};
#pragma unroll
                for (int h = 0; h < 8; ++h) { const f32x4 c = __builtin_amdgcn_mfma_f32_16x16x32_f16(ak, bq[h], (f32x4){0.f, 0.f, 0.f, 0.f}, 0, 0, 0); const float wv = (h < 4) ? wa[h] : wb[h - 4];
                    acc.x += wv * fmaxf(c.x, 0.f); acc.y += wv * fmaxf(c.y, 0.f); acc.z += wv * fmaxf(c.z, 0.f); acc.w += wv * fmaxf(c.w, 0.f); }
                *(f32x4*)(srow + 16 * kb) = acc + 0.0f;
            }
        }
    }
}

__device__ __forceinline__ int wave_total_i(int v) {
    v += __builtin_amdgcn_mov_dpp(v, 0xB1, 0xF, 0xF, true);
    v += __builtin_amdgcn_mov_dpp(v, 0x4E, 0xF, 0xF, true);
    v += __builtin_amdgcn_mov_dpp(v, 0x141, 0xF, 0xF, true);
    v += __builtin_amdgcn_mov_dpp(v, 0x140, 0xF, 0xF, true);
    return __builtin_amdgcn_readlane(v, 0) + __builtin_amdgcn_readlane(v, 16) + __builtin_amdgcn_readlane(v, 32) + __builtin_amdgcn_readlane(v, 48);
}
__device__ __forceinline__ unsigned score_key(float f) { const unsigned bits = __float_as_uint(f); return (bits & 0x80000000u) ? ~bits : (bits | 0x80000000u); }
constexpr int VST_PITCH = 144;
typedef unsigned short u16;
__device__ __forceinline__ void dsa_load_scores(ARef A, int m, int lane, f32x4 (&sv)[16]) {
    const int n = (m & (SEQ - 1)) + 1; const float* sc = (const float*)(A.ws + WS_SC) + (size_t)m * SEQ;
#pragma unroll
    for (int j4 = 0; j4 < 16; ++j4) sv[j4] = *(const f32x4*)(sc + ((256 * j4 < n) ? 256 * j4 : 0) + 4 * lane);
}
__device__ __forceinline__ void dsa_select(ARef A, int m, int n, int lane_in, LAS u16* slist, LAS unsigned* bk) {
    int lane = lane_in; asm volatile("" : "+v"(lane));
    if (n <= 256) {
#pragma unroll
        for (int c = 0; c < 4; ++c) { const int idx = lane + 64 * c; slist[idx] = (u16)((idx < n) ? idx : 0); }
        return;
    }
    f32x4 sv[16]; dsa_load_scores(A, m, lane, sv);
    unsigned u[64];
#pragma unroll
    for (int j4 = 0; j4 < 16; ++j4)
#pragma unroll
        for (int i = 0; i < 4; ++i) u[4 * j4 + i] = (256 * j4 + 4 * lane + i < n) ? score_key(sv[j4][i]) : 0u;
    unsigned T = 0u;
    for (int bit = 31; bit >= 16; --bit) { const unsigned cand = T | (1u << bit); int cnt = 0;
#pragma unroll
        for (int j = 0; j < 64; ++j) cnt += (u[j] >= cand) ? 1 : 0;
        if (wave_total_i(cnt) >= 256) T = cand; }
    unsigned long long bkb = 0ull; int chi = 0;
#pragma unroll
    for (int j = 0; j < 64; ++j) { bkb |= (unsigned long long)(((u[j] >> 16) == (T >> 16)) ? 1u : 0u) << j; chi += ((u[j] >> 16) > (T >> 16)) ? 1 : 0; }
    const int cb = wave_total_i(__popcll(bkb)), need = 256 - wave_total_i(chi);
    if (cb <= 64) {
        int pos = __popcll(bkb);
        { const int mine_ = pos;
#pragma unroll
          for (int d = 1; d < 64; d <<= 1) { const int y = __shfl_up(pos, d); if (lane >= d) pos += y; }
          pos -= mine_; }
#pragma unroll
        for (int j = 0; j < 64; ++j) { if ((bkb >> j) & 1ull) { bk[pos] = u[j]; ++pos; } }
        LDS_WAIT();
        const unsigned kx = (lane < cb) ? bk[lane] : 0u;
        for (int bit = 15; bit >= 0; --bit) { const unsigned cand = T | (1u << bit); if (__popcll(__ballot(kx >= cand)) >= need) T = cand; }
        LDS_WAIT();
    } else {
        for (int bit = 15; bit >= 0; --bit) { const unsigned cand = T | (1u << bit); int cnt = 0;
#pragma unroll
            for (int j = 0; j < 64; ++j) cnt += (u[j] >= cand) ? 1 : 0;
            if (wave_total_i(cnt) >= 256) T = cand; }
    }
    unsigned long long gtb = 0ull, eqb = 0ull;
#pragma unroll
    for (int j = 0; j < 64; ++j) { gtb |= (unsigned long long)((u[j] > T) ? 1u : 0u) << j; eqb |= (unsigned long long)((u[j] == T) ? 1u : 0u) << j; }
    const int tgt = wave_total_i(__popcll(gtb)), teq = wave_total_i(__popcll(eqb));
    unsigned long long selb = gtb | eqb;
    if (tgt + teq > 256) {
        const int take = 256 - tgt; int lo = 0;
        for (int bit = 11; bit >= 0; --bit) { const int cand = lo | (1 << bit); const int J4 = cand >> 8; int ni = (cand & 255) - 4 * lane; ni = ni < 0 ? 0 : (ni > 4 ? 4 : ni);
            const int jc = 4 * J4 + ni; const unsigned long long msk = (jc >= 64) ? ~0ull : ((1ull << jc) - 1ull);
            if (wave_total_i(__popcll(eqb & msk)) < take) lo = cand; }
        { const int cand = lo + 1; const int J4 = cand >> 8; int ni = (cand & 255) - 4 * lane; ni = ni < 0 ? 0 : (ni > 4 ? 4 : ni);
          const int jc = (cand >= SEQ) ? 64 : 4 * J4 + ni; const unsigned long long msk = (jc >= 64) ? ~0ull : ((1ull << jc) - 1ull); selb = gtb | (eqb & msk); }
    }
    const int mine = __popcll(selb); int off = mine;
#pragma unroll
    for (int d = 1; d < 64; d <<= 1) { const int y = __shfl_up(off, d); if (lane >= d) off += y; }
    off -= mine;
    while (selb) { const int j = __builtin_ctzll(selb); selb &= selb - 1ull; slist[off] = (u16)(256 * (j >> 2) + 4 * lane + (j & 3)); ++off; }
}
__device__ __forceinline__ void dsa_attend(ARef A, int m, int lane_in, const LAS u16* slist, LAS unsigned char* vbuf) {
    int lane = lane_in; asm volatile("" : "+v"(lane));
    const int b = m >> 12, t = m & (SEQ - 1), n = t + 1, nsel = n < 256 ? n : 256, col = lane & 15, q4 = lane >> 4;
    const bf16* DKB = (const bf16*)(A.ws + WS_DKB) + (size_t)b * SEQ * 64; const bf16* DVB = (const bf16*)(A.ws + WS_DVB) + (size_t)b * SEQ * 64;
    const int vrow = lane >> 3, vpc = lane & 7;
    bf16x8v bq0 = {0, 0, 0, 0, 0, 0, 0, 0}, bq1 = {0, 0, 0, 0, 0, 0, 0, 0};
    if (col < 4) { const bf16* qp = (const bf16*)(A.ws + WS_DQ) + (size_t)m * 256 + col * 64 + 8 * q4; bq0 = *(const bf16x8v*)qp; bq1 = *(const bf16x8v*)(qp + 32); }
    f32x4 lg[16];
#pragma unroll
    for (int hb = 0; hb < 4; ++hb) {
        bf16x8v a0[4], a1[4];
#pragma unroll
        for (int k = 0; k < 4; ++k) { const int s = slist[16 * (4 * hb + k) + col]; const bf16* kr = DKB + (size_t)s * 64 + 8 * q4; a0[k] = *(const bf16x8v*)kr; a1[k] = *(const bf16x8v*)(kr + 32); }
#pragma unroll
        for (int k = 0; k < 4; ++k) { const f32x4 c = __builtin_amdgcn_mfma_f32_16x16x32_bf16(a0[k], bq0, (f32x4){0.f, 0.f, 0.f, 0.f}, 0, 0, 0); lg[4 * hb + k] = __builtin_amdgcn_mfma_f32_16x16x32_bf16(a1[k], bq1, c, 0, 0, 0); }
        __builtin_amdgcn_sched_barrier(0);
    }
    if (nsel < 256) {
#pragma unroll
        for (int kb = 0; kb < 16; ++kb)
#pragma unroll
            for (int r = 0; r < 4; ++r) if (16 * kb + 4 * q4 + r >= nsel) lg[kb][r] = -INFINITY; }
    v4u vr[4];
#pragma unroll
    for (int i = 0; i < 4; ++i) { const int s = slist[vrow + 8 * i]; vr[i] = *(const v4u*)(DVB + (size_t)s * 64 + 8 * vpc); }
    float mx = -INFINITY;
#pragma unroll
    for (int kb = 0; kb < 16; ++kb) mx = fmaxf(fmaxf(mx, fmaxf(lg[kb].x, lg[kb].y)), fmaxf(lg[kb].z, lg[kb].w));
    mx = fmaxf(mx, __shfl_xor(mx, 16)); mx = fmaxf(mx, __shfl_xor(mx, 32));
    float sm = 0.f;
#pragma unroll
    for (int kb = 0; kb < 16; ++kb) { lg[kb].x = __builtin_amdgcn_exp2f(lg[kb].x - mx); lg[kb].y = __builtin_amdgcn_exp2f(lg[kb].y - mx); lg[kb].z = __builtin_amdgcn_exp2f(lg[kb].z - mx); lg[kb].w = __builtin_amdgcn_exp2f(lg[kb].w - mx); sm += (lg[kb].x + lg[kb].y) + (lg[kb].z + lg[kb].w); }
    sm += __shfl_xor(sm, 16); sm += __shfl_xor(sm, 32);
    const float inv = 1.0f / sm;
    bf16x8v pa[8];
#pragma unroll
    for (int i = 0; i < 8; ++i) { const f32x4 x = lg[2 * i] * inv, y = lg[2 * i + 1] * inv;
        pg8::u32x4 wv; wv.x = pg8::cvt_pk_bf16(x.x, x.y); wv.y = pg8::cvt_pk_bf16(x.z, x.w); wv.z = pg8::cvt_pk_bf16(y.x, y.y); wv.w = pg8::cvt_pk_bf16(y.z, y.w);
        pa[i] = __builtin_bit_cast(bf16x8v, wv); }
    f32x4 o[4];
#pragma unroll
    for (int nb = 0; nb < 4; ++nb) o[nb] = (f32x4){0.f, 0.f, 0.f, 0.f};
    const int tj = col >> 2, tc = col & 3;
#pragma unroll
    for (int c = 0; c < 8; ++c) {
        LAS unsigned char* vb = vbuf + (c & 1) * (32 * VST_PITCH);
#pragma unroll
        for (int i = 0; i < 4; ++i) *(LAS v4u*)(vb + (vrow + 8 * i) * VST_PITCH + 16 * vpc) = vr[i];
        if (c < 7) {
#pragma unroll
            for (int i = 0; i < 4; ++i) { const int s = slist[32 * (c + 1) + vrow + 8 * i]; vr[i] = *(const v4u*)(DVB + (size_t)s * 64 + 8 * vpc); } }
        LDS_WAIT();
#pragma unroll
        for (int nb = 0; nb < 4; ++nb) {
            LAS unsigned char* a1 = vb + (4 * q4 + tj) * VST_PITCH + (16 * nb + 4 * tc) * 2;
            const s16x4v r1 = __builtin_bit_cast(s16x4v, __builtin_amdgcn_ds_read_tr16_b64_v4i16((LAS s16x4v*)a1));
            const s16x4v r2 = __builtin_bit_cast(s16x4v, __builtin_amdgcn_ds_read_tr16_b64_v4i16((LAS s16x4v*)(a1 + 16 * VST_PITCH)));
            const bf16x8v bv = {r1[0], r1[1], r1[2], r1[3], r2[0], r2[1], r2[2], r2[3]};
            o[nb] = __builtin_amdgcn_mfma_f32_16x16x32_bf16(pa[c], bv, o[nb], 0, 0, 0); }
    }
    LDS_WAIT();
    if (lane < 16) { float* YD = (float*)(A.ws + WS_YO) + 2 * YO_STRIDE + (size_t)m * 256;
#pragma unroll
        for (int nb = 0; nb < 4; ++nb) { YD[16 * nb + lane] = o[nb].x; YD[64 + 16 * nb + lane] = o[nb].y; YD[128 + 16 * nb + lane] = o[nb].z; YD[192 + 16 * nb + lane] = o[nb].w; } }
}
__device__ __forceinline__ int dsa_row_of(int i) { return (i & 1) ? (MTOK - 1 - (i >> 1)) : (i >> 1); }
__device__ __forceinline__ void dsa_wave(ARef A, const WI& w, LAS unsigned char* wl, int l) {
    LAS u16* lists = (LAS u16*)wl; LAS unsigned char* vbuf = wl + 4096; LAS unsigned* bk = (LAS unsigned*)vbuf;
    unsigned* head = (unsigned*)(A.ws + WS_CTL) + CW_DSAQ + 64 * l;
    for (;;) {
        int g = 0; if (w.lane == 0) g = (int)atomicAdd(head, 1u);
        g = __builtin_amdgcn_readfirstlane(g);
        if (g >= MTOK / 8) break;
#pragma unroll 1
        for (int r = 0; r < 8; ++r) { const int m = dsa_row_of(g + r * (MTOK / 8)), n = (m & (SEQ - 1)) + 1; dsa_select(A, m, n, w.lane, lists + r * 256, bk); }
        LDS_WAIT();
#pragma unroll 1
        for (int r = 0; r < 8; ++r) dsa_attend(A, dsa_row_of(g + r * (MTOK / 8)), w.lane, lists + r * 256, vbuf);
    }
}

__device__ __forceinline__ f32x4 head_norm4(f32x4 y, float eps, f32x4 g) {
    const float mean = grp16_sum(sum4(y)) * (1.0f / 64.0f); const f32x4 yc = y - mean;
    const float var = grp16_sum(dot4(yc, yc)) * (1.0f / 64.0f); return yc * (1.0f / sqrtf(var + eps)) * g;
}
template <bool BF> __device__ __forceinline__ f32x4 state_corr(const LAS float* sl, int hh, int r16, const void* pv) {
    const LAS float* r0 = sl + (hh * 64 + 4 * r16) * 64; const int x0 = (4 * r16) & 15;
    f32x4 out = {0.f, 0.f, 0.f, 0.f};
#pragma unroll 2
    for (int k8 = 0; k8 < 8; ++k8) {
        f32x4 pa, pb;
        if (BF) { const v4u x = ((const v4u*)pv)[k8]; pa = (f32x4){bf_lo(x.x), bf_hi(x.x), bf_lo(x.y), bf_hi(x.y)}; pb = (f32x4){bf_lo(x.z), bf_hi(x.z), bf_lo(x.w), bf_hi(x.w)}; }
        else { pa = ((const f32x4*)pv)[2 * k8]; pb = ((const f32x4*)pv)[2 * k8 + 1]; }
#pragma unroll
        for (int i = 0; i < 4; ++i) { const LAS float* rowp = r0 + i * 64; const int xs = (x0 + i) & 15;
            out[i] += dot4(*(const LAS f32x4*)(rowp + 4 * ((2 * k8) ^ xs)), pa) + dot4(*(const LAS f32x4*)(rowp + 4 * ((2 * k8 + 1) ^ xs)), pb); }
    }
    return out;
}
__device__ __forceinline__ void post_row(ARef A, int l, int m, int lane, const LAS float* slw, const LAS float* slr) {
    const float* YO = (const float*)(A.ws + WS_YO); const float* RWA = (const float*)(A.ws + WS_RWA);
    bf16* MX = (bf16*)(A.ws + WS_MIX) + (size_t)m * DM; const int c4 = 4 * lane, hh = lane >> 4, r16 = lane & 15; const size_t o = (size_t)m * 256 + c4;
    { f32x4 y = *(const f32x4*)(YO + o) + state_corr<true>(slr, hh, r16, (const bf16*)(A.ws + WS_PTR) + (size_t)m * 256 + hh * 64);
      y = head_norm4(y, 1e-5f, *(const f32x4*)(A.in[I_RETGN] + l * 256 + c4));
      const v2u gw_ = *(const v2u*)((const bf16*)(A.ws + WS_PB) + (size_t)m * PBW + 768 + c4); const f32x4 g = {bf_lo(gw_.x), bf_hi(gw_.x), bf_lo(gw_.y), bf_hi(gw_.y)};
#pragma unroll
      for (int i = 0; i < 4; ++i) y[i] *= g[i] * sigm(g[i]);
      v2u w; w.x = pk2(y.x, y.y); w.y = pk2(y.z, y.w); *(v2u*)(MX + c4) = w; }
    { f32x4 y = *(const f32x4*)(YO + YO_STRIDE + o) + state_corr<false>(slw, hh, r16, (const float*)(A.ws + WS_PT) + (size_t)m * 256 + hh * 64);
      y = head_norm4(y, 64e-5f, *(const f32x4*)(A.in[I_LN] + l * 256 + c4));
      y = (y + *(const f32x4*)(RWA + 7 * RWA_STRIDE + o)) * *(const f32x4*)(RWA + 6 * RWA_STRIDE + o);
      v2u w; w.x = pk2(y.x, y.y); w.y = pk2(y.z, y.w); *(v2u*)(MX + 256 + c4) = w; }
    { f32x4 y = *(const f32x4*)(YO + 2 * YO_STRIDE + o); const float r = 1.0f / sqrtf(wave_sum(dot4(y, y)) * (1.0f / 256.0f) + 1e-5f);
      y = y * r * *(const f32x4*)(A.in[I_DONORM] + l * 256 + c4);
      v2u w; w.x = pk2(y.x, y.y); w.y = pk2(y.z, y.w); *(v2u*)(MX + 512 + c4) = w; }
    { f32x4 y = *(const f32x4*)(YO + 3 * YO_STRIDE + o); const float r = 1.0f / sqrtf(wave_sum(dot4(y, y)) * (1.0f / 256.0f) + 1e-5f);
      y = y * r * *(const f32x4*)(A.in[I_SONORM] + l * 256 + c4);
      v2u w; w.x = pk2(y.x, y.y); w.y = pk2(y.z, y.w); *(v2u*)(MX + 768 + c4) = w; }
}
__device__ __forceinline__ void ph_post(ARef A, const WI& w, int l) {
    LAS float* slw = (LAS float*)w.lds; LAS float* slr = slw + 16384;
    for (int u = w.vcu; u < NB * NCH * 2; u += w.G) {
        const int b = u >> 5, c = (u >> 1) & 15, half = u & 1;
        __syncthreads();
        for (int e = w.tid; e < 4096; e += NWAVES * 64) { const int hh = e >> 10, v = (e >> 4) & 63, k4 = e & 15;
            const size_t src = ((size_t)((b * 4 + hh) * NCH + c) * 64 + v) * 64 + 4 * k4; const int dst = (hh * 64 + v) * 64 + 4 * (k4 ^ (v & 15));
            *(LAS f32x4*)(slw + dst) = *(const f32x4*)((const float*)(A.ws + WS_SI) + src); *(LAS f32x4*)(slr + dst) = *(const f32x4*)((const float*)(A.ws + WS_SIR) + src); }
        __syncthreads();
        const int tok0 = b * SEQ + c * TCH + half * 128 + w.wave * 16;
        for (int i = 0; i < 16; ++i) post_row(A, l, tok0 + i, w.lane, slw, slr);
    }
}

__device__ __forceinline__ float wave_max_f(float v) {
    v = fmaxf(v, __builtin_bit_cast(float, __builtin_amdgcn_mov_dpp(__builtin_bit_cast(int, v), 0xB1, 0xF, 0xF, true)));
    v = fmaxf(v, __builtin_bit_cast(float, __builtin_amdgcn_mov_dpp(__builtin_bit_cast(int, v), 0x4E, 0xF, 0xF, true)));
    v = fmaxf(v, __builtin_bit_cast(float, __builtin_amdgcn_mov_dpp(__builtin_bit_cast(int, v), 0x141, 0xF, 0xF, true)));
    v = fmaxf(v, __builtin_bit_cast(float, __builtin_amdgcn_mov_dpp(__builtin_bit_cast(int, v), 0x140, 0xF, 0xF, true)));
    const int iv = __builtin_bit_cast(int, v);
    return fmaxf(fmaxf(__builtin_bit_cast(float, __builtin_amdgcn_readlane(iv, 0)), __builtin_bit_cast(float, __builtin_amdgcn_readlane(iv, 16))), fmaxf(__builtin_bit_cast(float, __builtin_amdgcn_readlane(iv, 32)), __builtin_bit_cast(float, __builtin_amdgcn_readlane(iv, 48))));
}
__device__ __forceinline__ void router_stage(ARef A, const WI& w, int l) {
    LAS float* rwl = (LAS float*)w.lds; const float* rw = A.in[I_RW] + (size_t)l * DM * 32;
    for (int e = w.tid; e < DM * 8; e += NWAVES * 64) { const int k = e >> 3, c = e & 7; *(LAS f32x4*)(rwl + k * 32 + 4 * (c ^ ((k >> 2) & 7))) = *(const f32x4*)(rw + (size_t)k * 32 + 4 * c); }
    __syncthreads();
}
__device__ __forceinline__ void router_row(ARef A, int l, int m, int lane, LAS unsigned* hist, const LAS float* rwl, LAS int* texp, bool dry = false) {
    const float* XA = (const float*)(A.ws + WS_XA) + (size_t)m * DM; const float* MOD = (const float*)(A.ws + WS_MOD) + (size_t)(l * 8 + (m >> 12)) * 6144;
    f32x4 v[4]; float ss = 0.0f;
#pragma unroll
    for (int j = 0; j < 4; ++j) { v[j] = *(const f32x4*)(XA + 4 * (lane + 64 * j)); ss += dot4(v[j], v[j]); }
    ss = wave_sum(ss); const float rstd = 1.0f / sqrtf(ss * (1.0f / DM) + 1e-5f);
    const float* g = A.in[I_NFFN] + l * DM; const float* scp = MOD + 4 * 1024; const float* shp = MOD + 3 * 1024;
    emit_h_row(v, rstd, g, scp, shp, (bf16*)(A.ws + WS_H) + (size_t)m * DM, lane);
    float p[32];
#pragma unroll
    for (int e = 0; e < 32; ++e) p[e] = 0.0f;
    const int sw = lane & 7;
#pragma unroll 1
    for (int j = 0; j < 4; ++j) { const int k = 4 * (lane + 64 * j);
        const f32x4 h = *(const f32x4*)(XA + k) * rstd * *(const f32x4*)(g + k) * (1.0f + *(const f32x4*)(scp + k)) + *(const f32x4*)(shp + k);
        const LAS float* row = rwl + k * 32;
#pragma unroll
        for (int i = 0; i < 4; ++i) {
#pragma unroll
            for (int q4 = 0; q4 < 8; ++q4) { const f32x4 r = *(const LAS f32x4*)(row + i * 32 + 4 * (q4 ^ sw)); p[4 * q4] += h[i] * r.x; p[4 * q4 + 1] += h[i] * r.y; p[4 * q4 + 2] += h[i] * r.z; p[4 * q4 + 3] += h[i] * r.w; } } }
    float q16[16], q8[8], q4v[4], q2[2], q1;
    { const bool hb = (lane & 32) != 0;
#pragma unroll
      for (int i = 0; i < 16; ++i) { const float mine = hb ? p[16 + i] : p[i], oth = hb ? p[i] : p[16 + i]; q16[i] = mine + __shfl_xor(oth, 32); } }
    { const bool hb = (lane & 16) != 0;
#pragma unroll
      for (int i = 0; i < 8; ++i) { const float mine = hb ? q16[8 + i] : q16[i], oth = hb ? q16[i] : q16[8 + i]; q8[i] = mine + __shfl_xor(oth, 16); } }
    { const bool hb = (lane & 8) != 0;
#pragma unroll
      for (int i = 0; i < 4; ++i) { const float mine = hb ? q8[4 + i] : q8[i], oth = hb ? q8[i] : q8[4 + i]; q4v[i] = mine + __shfl_xor(oth, 8); } }
    { const bool hb = (lane & 4) != 0;
#pragma unroll
      for (int i = 0; i < 2; ++i) { const float mine = hb ? q4v[2 + i] : q4v[i], oth = hb ? q4v[i] : q4v[2 + i]; q2[i] = mine + __shfl_xor(oth, 4); } }
    { const bool hb = (lane & 2) != 0; const float mine = hb ? q2[1] : q2[0], oth = hb ? q2[0] : q2[1]; q1 = mine + __shfl_xor(oth, 2); }
    q1 += __shfl_xor(q1, 1);
    float lv = q1 + A.in[I_RB][l * 32 + (lane >> 1)];
    float tv[4]; int ti[4];
#pragma unroll
    for (int kk = 0; kk < 4; ++kk) { const float mx = wave_max_f(lv); const unsigned long long msk = __ballot(lv == mx); const int e = msk ? (int)(__builtin_ctzll(msk) >> 1) : kk;
        tv[kk] = mx; ti[kk] = e; if ((lane >> 1) == e) lv = -INFINITY; }
    const float e1 = expf(tv[1] - tv[0]), e2 = expf(tv[2] - tv[0]), e3 = expf(tv[3] - tv[0]); const float inv = 1.0f / (1.0f + e1 + e2 + e3);
    if (lane == 0 && !dry) {
        int* TI = (int*)(A.ws + WS_TOPI) + (size_t)m * 4; float* TW = (float*)(A.ws + WS_TOPW) + (size_t)m * 4;
        TI[0] = ti[0]; TI[1] = ti[1]; TI[2] = ti[2]; TI[3] = ti[3]; texp[0] = ti[0]; texp[1] = ti[1]; texp[2] = ti[2]; texp[3] = ti[3]; TW[0] = inv; TW[1] = e1 * inv; TW[2] = e2 * inv; TW[3] = e3 * inv;
        { unsigned* hg = (unsigned*)hist; atomicAdd(hg + ti[0], 1u); atomicAdd(hg + ti[1], 1u); atomicAdd(hg + ti[2], 1u); atomicAdd(hg + ti[3], 1u); }
    }
}
__device__ __forceinline__ void build_expert_table(ARef A, const WI& w, int l) {
    LAS int* tst = (LAS int*)(w.lds + TST_OFF); LAS int* tab = (LAS int*)(w.lds + TAB_OFF); LAS int* cnt = (LAS int*)(w.lds + CNT_OFF);
    if (w.tid == 0) { const unsigned* gc = (const unsigned*)(A.ws + WS_CTL) + CW_GCNT + 64 * l; int acc = 0;
        for (int e = 0; e < 32; ++e) { const int c = (int)__hip_atomic_load(gc + e, RLX_AGENT); cnt[e] = c; tst[e] = acc; acc += (c + 255) >> 8; }
        tst[32] = acc; tab[0] = acc; }
    __syncthreads();
    if (w.tid < 32) { const int e = w.tid; for (int pm = tst[e]; pm < tst[e + 1]; ++pm) tab[1 + pm] = e; }
    __syncthreads();
}
__device__ __forceinline__ void router_lists(ARef A, const WI& w, int l) {
    LAS unsigned* hist = (LAS unsigned*)(w.lds + HIST_OFF); LAS int* base = (LAS int*)(w.lds + BASE_OFF); LAS int* texp = (LAS int*)(w.lds + TEXP_OFF);
    __syncthreads();
    if (w.tid < 32) { base[w.tid] = (int)atomicAdd((unsigned*)(A.ws + WS_CTL) + CW_GCNT + 64 * l + w.tid, hist[w.tid]); hist[w.tid] = 0u; }
    __syncthreads();
    int* LIST = (int*)(A.ws + WS_LIST); int* PW = (int*)(A.ws + WS_POS);
    int j = 0;
    for (int m = w.gw; m < MTOK; m += w.NGW, ++j) {
        if (w.lane < 4) { const int e = texp[(w.wave * 16 + j) * 4 + w.lane]; const int idx = base[e] + (int)atomicAdd((unsigned*)hist + e, 1u);
            LIST[e * LCAP + idx] = m; PW[(size_t)m * 4 + w.lane] = (e << 20) | idx; } }
}
__device__ __forceinline__ void combine_row(ARef A, int l, int m, int lane, const LAS int* tst, float gscale = 1.0f, float oscale = 1.0f) {
    float* XA = (float*)(A.ws + WS_XA) + (size_t)m * DM; const float* MOD = (const float*)(A.ws + WS_MOD) + (size_t)(l * 8 + (m >> 12)) * 6144;
    const int* PS = (const int*)(A.ws + WS_POS) + (size_t)m * 4; const float* TW = (const float*)(A.ws + WS_TOPW) + (size_t)m * 4;
    const bf16* YS = (const bf16*)(A.ws + WS_XS);
    f32x4 v[4], acc[4];
#pragma unroll
    for (int j = 0; j < 4; ++j) { v[j] = *(const f32x4*)(XA + 4 * (lane + 64 * j)); acc[j] = (f32x4){0.f, 0.f, 0.f, 0.f}; }
#pragma unroll
    for (int k = 0; k < 4; ++k) { const int pe = PS[k]; const int pos = tst[pe >> 20] * 256 + (pe & 0xFFFFF); const float gt = TW[k] * gscale; const v2u* yr = (const v2u*)(YS + (size_t)pos * DM);
#pragma unroll
        for (int j = 0; j < 4; ++j) { const v2u y = yr[lane + 64 * j]; acc[j] += gt * (f32x4){bf_lo(y.x), bf_hi(y.x), bf_lo(y.y), bf_hi(y.y)}; } }
    float ss = 0.0f;
#pragma unroll
    for (int j = 0; j < 4; ++j) { const int kx = 4 * (lane + 64 * j); v[j] += *(const f32x4*)(MOD + 5 * 1024 + kx) * acc[j]; ss += dot4(v[j], v[j]); }
    ss = wave_sum(ss); const float rstd = 1.0f / sqrtf(ss * (1.0f / DM) + 1e-5f);
    if (l + 1 < NLAYER) {
#pragma unroll
        for (int j = 0; j < 4; ++j) *(f32x4*)(XA + 4 * (lane + 64 * j)) = v[j];
        const float* mb = MOD + 8 * 6144;
        emit_h_row(v, rstd, A.in[I_NMIX] + (l + 1) * DM, mb + 1024, mb, (bf16*)(A.ws + WS_H) + (size_t)m * DM, lane);
    } else {
        float* orow = A.out + (size_t)m * DM; const float* gf = A.in[I_NFINAL];
#pragma unroll
        for (int j = 0; j < 4; ++j) { const int kx = 4 * (lane + 64 * j); *(f32x4*)(orow + kx) = v[j] * (rstd * oscale) * *(const f32x4*)(gf + kx); }
    }
}

constexpr int N_LAUNCHES = MK_N_LAUNCHES;
template <int SEL> __global__ void __launch_bounds__(NWAVES * 64, 2) fwd(ArgsH Ah) {
    extern __shared__ __attribute__((aligned(16))) unsigned char lds[];
    (void)Ah;
    const int wave_s = __builtin_amdgcn_readfirstlane((int)threadIdx.x >> 6);
    auto tid_now = [&]() -> int { int ws_ = wave_s; unsigned z_ = 0u; asm volatile("" : "+s"(ws_), "+s"(z_)); return ws_ * 64 + (int)__builtin_amdgcn_mbcnt_hi(~0u, __builtin_amdgcn_mbcnt_lo(~0u, z_)); };
#define TID_NOW() tid_now()
#define MAKE_WI() WI w; { int tz = TID_NOW(); asm volatile("" : "+v"(tz)); int bz = blockIdx.x, gz = gridDim.x; asm volatile("" : "+s"(bz), "+s"(gz)); \
        w.lds = (LAS unsigned char*)lds; w.tid = tz; w.lane = tz & 63; w.wave = __builtin_amdgcn_readfirstlane(tz >> 6); w.G = gz; w.bx = bz; w.vcu = (gz % 8 == 0) ? (bz % 8) * (gz / 8) + bz / 8 : bz; \
        w.gw = w.vcu * NWAVES + w.wave; w.NGW = gz * NWAVES; }
    { const int t0 = threadIdx.x; for (int u = t0; u < (LDS_BYTES - RING_BYTES) / 4; u += NWAVES * 64) ((LAS unsigned*)((LAS unsigned char*)lds + RING_BYTES))[u] = 0u; }
    __syncthreads();
    int lo, hi; { ARef A0 = *kargs(); lo = A0.ph_lo; hi = A0.ph_hi; }
    if (N_LAUNCHES == 1) { ARef A0 = *kargs(); (void)xcd_barrier_post((unsigned*)((gu32*)(A0.ws + WS_CTL) + CW_BAR), (volatile LAS unsigned*)((LAS unsigned char*)lds + MISC_OFF) + 8, TID_NOW()); }
#define GRID_BAR() do { if (N_LAUNCHES == 1) { ARef Ab = *kargs(); XcdBarrier bar_; bar_.bar = (unsigned*)((gu32*)(Ab.ws + WS_CTL) + CW_BAR); bar_.x = xb_xcc_id(); bar_.st = (volatile LAS unsigned*)((LAS unsigned char*)lds + MISC_OFF) + 8; xcd_barrier(bar_, TID_NOW()); } } while (0)
#ifndef TPROBE
#define TPROBE 0
#endif
#if TPROBE
    unsigned long long tp_acc = 0ull;
#define TP_SCALE tp_scale_of(__hip_atomic_load((unsigned*)(A.ws + WS_CTL) + 3, RLX_AGENT))
    auto tp_scale_of = [](unsigned ticks) -> float { const float us = (float)ticks * 0.01f; if (us < 1.0f) return 1.0f; const float q = exp2f(rintf(log2f(us) * 8.0f) * 0.125f); return 1.0f + sqrtf(q * 1e-5f); };
#define TP_BEGIN(kind) unsigned long long tp_t0 = 0ull; if ((kind) == TPROBE) tp_t0 = __builtin_amdgcn_s_memrealtime();
#define TP_END(kind) if ((kind) == TPROBE) { tp_acc += __builtin_amdgcn_s_memrealtime() - tp_t0; }
#define TP_PUBLISH(l) if ((l) == 1 && w.vcu == 0 && w.tid == 0) __hip_atomic_store((unsigned*)(A.ws + WS_CTL) + 3, (unsigned)tp_acc, RLX_AGENT);
#else
#define TP_SCALE 1.0f
#define TP_PUBLISH(l)
#define TP_BEGIN(kind)
#define TP_END(kind)
#endif
#define IN(k) (lo <= (k) && (k) < hi)
#ifndef PHMASK
#define PHMASK 0xffffffffu
#endif
#define KON(k) if constexpr ((SEL < 0 && ((PHMASK >> (k)) & 1u)) || SEL == (k))
#define BOTH(k) (IN(k) && IN((k) + 1))
#ifndef PROBE_REP
#define PROBE_REP 0
#endif
#if PROBE_REP
    int nrep_ = 2; asm volatile("" : "+s"(nrep_));
#define REP(bit) _Pragma("unroll 1") for (int rep_ = 0; rep_ < (((PROBE_REP >> (bit)) & 1) ? nrep_ : 1); ++rep_)
#else
#define REP(bit) for (int rep_ = 0; rep_ < 1; ++rep_)
#endif
#define ring ((PG8_LAS unsigned char*)lds)

    KON(0) if (IN(0)) { ARef A = *kargs(); MAKE_WI(); REP(0) ph_prologue(A, w); if (BOTH(0)) GRID_BAR(); }

#define LAYER_BODY(l) do {\
        const int pb = 1 + l * NPL; \
        KON(1) if (IN(pb + 0)) { ARef A = *kargs(); MAKE_WI(); TP_BEGIN(1) if (l == 0) { ph_norm1(A, w); small_weights_to_f16(A, w); } if (BOTH(pb + 0)) GRID_BAR(); TP_END(1) } \
        KON(2) if (IN(pb + 1)) { ARef A = *kargs(); MAKE_WI(); TP_BEGIN(2) \
            pg8::Gemm g{(const bf16*)(A.ws + WS_H), (const bf16*)(A.ws + WS_WIN) + (size_t)l * INCP * DM, MTOK, INCP, DM}; pg8::StaticOrder S; S.init(MTOK, INCP, w.G, w.bx); \
            pg8::EpiProj E{(bf16*)(A.ws + WS_PB), (float*)(A.ws + WS_PF)}; \
            REP(1) pg8::gemm_phase<pg8::EpiProj, pg8::StaticOrder, true, true>(ring, g, S, E, w.tid); \
            if (BOTH(pb + 1)) GRID_BAR(); TP_END(2) \
        } \
        KON(3) if (IN(pb + 2)) { ARef A = *kargs(); MAKE_WI(); TP_BEGIN(3) \
            REP(2) { for (int g = w.gw; g < MTOK / 16; g += w.NGW) prep16(A, l, 16 * g, w.lane); } \
            if (BOTH(pb + 2)) GRID_BAR(); TP_END(3) \
        } \
        KON(4) if (IN(pb + 3)) { ARef A = *kargs(); MAKE_WI(); TP_BEGIN(4) \
            REP(3) { for (int tk = 2 * w.vcu; tk < 32 * NCH; tk += 2 * w.G) scan_rwkv_task2(A, w, tk); } \
            REP(13) { for (int tk = w.vcu; tk < 32 * NCH / 2; tk += w.G) scan_ret_task(A, w, tk); } \
            REP(4) { LAS unsigned char* vl = w.lds + w.wave * 4608; for (int it = w.gw; it < 32 * 128; it += w.NGW) sb_tile_mfma(A, it, w.lane, vl); } \
            REP(5) dsa_scores_mfma(A, w); \
            if (BOTH(pb + 3)) GRID_BAR(); TP_END(4) \
        } \
        KON(5) if (IN(pb + 4)) { ARef A = *kargs(); MAKE_WI(); TP_BEGIN(5) \
            if (w.vcu < 32) prefix_chain(A, w, w.vcu); \
            dsa_wave(A, w, w.lds + w.wave * 13312, l); \
            if (BOTH(pb + 4)) GRID_BAR(); TP_END(5) \
        } \
        KON(6) if (IN(pb + 5)) { ARef A = *kargs(); MAKE_WI(); TP_BEGIN(6) \
            REP(7) ph_post(A, w, l); \
            if (BOTH(pb + 5)) GRID_BAR(); TP_END(6) \
        } \
        KON(7) if (IN(pb + 6)) { ARef A = *kargs(); MAKE_WI(); TP_BEGIN(7) \
            pg8::Gemm g{(const bf16*)(A.ws + WS_MIX), (const bf16*)(A.ws + WS_WOUT) + (size_t)l * DM * DM, MTOK, DM, DM}; pg8::StaticOrder S; S.init(MTOK, DM, w.G, w.bx); \
            pg8::EpiRes E{l == 0 ? A.in[I_X] : (const float*)(A.ws + WS_XA), (float*)(A.ws + WS_XA), (const float*)(A.ws + WS_MOD) + (size_t)l * 8 * 6144 + 2 * 1024}; \
            pg8::gemm_phase<pg8::EpiRes, pg8::StaticOrder, true, true>(ring, g, S, E, w.tid); \
            if (BOTH(pb + 6)) GRID_BAR(); TP_END(7) \
        } \
        KON(8) if (IN(pb + 7)) { ARef A = *kargs(); MAKE_WI(); TP_BEGIN(8) \
            { LAS unsigned* hist = (LAS unsigned*)(w.lds + HIST_OFF); LAS int* texp = (LAS int*)(w.lds + TEXP_OFF); if (w.tid < 32) hist[w.tid] = 0u; router_stage(A, w, l); \
            int j_ = 0; for (int m = w.gw; m < MTOK; m += w.NGW, ++j_) router_row(A, l, m, w.lane, hist, (const LAS float*)w.lds, texp + (w.wave * 16 + j_) * 4); \
            router_lists(A, w, l); } \
            if (BOTH(pb + 7)) GRID_BAR(); TP_END(8) \
        } \
        KON(10) if (IN(pb + 8)) { ARef A = *kargs(); MAKE_WI(); TP_BEGIN(10) \
            build_expert_table(A, w, l); \
            pg8::Gemm g{(const bf16*)(A.ws + WS_H), (const bf16*)(A.ws + WS_W1) + (size_t)l * NEXP * 2048 * DM, MOE_ROWS, NEXP * 2048, DM}; \
            pg8::MoeOrder S{(const PG8_LAS int*)(w.lds + TAB_OFF), 8, w.G, w.vcu, (const PG8_LAS int*)(w.lds + TST_OFF), (const PG8_LAS int*)(w.lds + CNT_OFF), (const int*)(A.ws + WS_LIST)}; \
            pg8::EpiSwiglu E{(bf16*)(A.ws + WS_ACT), A.in[I_MB1] + (size_t)l * NEXP * 2048}; \
            REP(8) pg8::gemm_phase<pg8::EpiSwiglu, pg8::MoeOrder, true, true, true>(ring, g, S, E, w.tid); \
            if (BOTH(pb + 8)) GRID_BAR(); TP_END(10) \
        } \
        KON(11) if (IN(pb + 9)) { ARef A = *kargs(); MAKE_WI(); TP_BEGIN(11) \
            build_expert_table(A, w, l); \
            pg8::Gemm g{(const bf16*)(A.ws + WS_ACT), (const bf16*)(A.ws + WS_W2) + (size_t)l * NEXP * DM * DM, MOE_ROWS, NEXP * DM, DM}; \
            pg8::MoeOrder S{(const PG8_LAS int*)(w.lds + TAB_OFF), 4, w.G, w.vcu, (const PG8_LAS int*)(w.lds + TST_OFF), (const PG8_LAS int*)(w.lds + CNT_OFF), (const int*)(A.ws + WS_LIST)}; \
            pg8::EpiY E{(bf16*)(A.ws + WS_XS), A.in[I_MB2] + (size_t)l * NEXP * DM}; \
            REP(9) pg8::gemm_phase<pg8::EpiY, pg8::MoeOrder, true, true>(ring, g, S, E, w.tid); \
            TP_PUBLISH(l) \
            if (BOTH(pb + 9)) GRID_BAR(); TP_END(11) \
        } \
        KON(12) if (IN(pb + 10)) { ARef A = *kargs(); MAKE_WI(); TP_BEGIN(12) \
            build_expert_table(A, w, l); \
            REP(12) for (int m = w.gw; m < MTOK; m += w.NGW) combine_row(A, l, m, w.lane, (const LAS int*)(w.lds + TST_OFF), rep_ ? 0.0f : 1.0f, TP_SCALE); \
            if (BOTH(pb + 10)) GRID_BAR(); TP_END(12) \
        } \
    } while (0)
    LAYER_BODY(0);
    LAYER_BODY(1);
#undef LAYER_BODY
#undef IN
#undef ring
#undef MAKE_WI
#undef TID_NOW
#undef GRID_BAR
#undef KON
#undef BOTH
}


#if MK_N_LAUNCHES != 1
template <int K> static void launch_one(int grid, hipStream_t stream, const ArgsH& a) {
    static bool attr = false;
    if (!attr) { (void)hipFuncSetAttribute((const void*)fwd<K>, hipFuncAttributeMaxDynamicSharedMemorySize, LDS_BYTES); attr = true; }
    hipLaunchKernelGGL(fwd<K>, dim3(grid), dim3(NWAVES * 64), LDS_BYTES, stream, a);
}
static void launch_kind(int kind, int grid, hipStream_t stream, const ArgsH& a) {
    switch (kind) {
        case 0: launch_one<0>(grid, stream, a); break; case 1: launch_one<1>(grid, stream, a); break; case 2: launch_one<2>(grid, stream, a); break;
        case 3: launch_one<3>(grid, stream, a); break; case 4: launch_one<4>(grid, stream, a); break; case 5: launch_one<5>(grid, stream, a); break;
        case 6: launch_one<6>(grid, stream, a); break; case 7: launch_one<7>(grid, stream, a); break; case 8: launch_one<8>(grid, stream, a); break;
        case 9: launch_one<9>(grid, stream, a); break; case 10: launch_one<10>(grid, stream, a); break; case 11: launch_one<11>(grid, stream, a); break;
        default: launch_one<12>(grid, stream, a); break;
    }
}
#endif
extern "C" void kernel_launch(void* const* d_in, const int* in_sizes, int n_in, void* d_out, int out_size, void* d_ws, size_t ws_size, hipStream_t stream) {
    static int grid = 0;
    if (grid == 0) {
        if (n_in != N_IN || out_size != MTOK * DM || ws_size < WS_END) { fprintf(stderr, "kernel_launch: unexpected shapes (n_in %d, out %d, ws %zu)\n", n_in, out_size, ws_size); grid = -1; return; }
        int dev = 0, cus = 0;
        if (hipGetDevice(&dev) != hipSuccess || hipDeviceGetAttribute(&cus, hipDeviceAttributeMultiprocessorCount, dev) != hipSuccess) { grid = -1; return; }
#if MK_N_LAUNCHES == 1
        {
            if (hipFuncSetAttribute((const void*)fwd<-1>, hipFuncAttributeMaxDynamicSharedMemorySize, LDS_BYTES) != hipSuccess) { fprintf(stderr, "kernel_launch: hipFuncSetAttribute failed\n"); grid = -1; return; }
            int per_cu = 0;
            if (hipOccupancyMaxActiveBlocksPerMultiprocessor(&per_cu, (const void*)fwd<-1>, NWAVES * 64, LDS_BYTES) != hipSuccess || per_cu < 1) fprintf(stderr, "kernel_launch: occupancy query says %d\n", per_cu);
            (void)hipGetLastError();
        }
#endif
        grid = cus;
    }
    if (grid < 0) return;
    (void)in_sizes;
    if (hipMemsetAsync((char*)d_ws + WS_CTL, 0, CTL_ZERO_BYTES, stream) != hipSuccess) return;
    ArgsH a{};
    for (int i = 0; i < N_IN; ++i) a.in[i] = (const float*)d_in[i];
    a.out = (float*)d_out; a.ws = (unsigned char*)d_ws;
    for (int f = 0; f < 44; ++f) a.invf[f] = (f < 32) ? pow(10000.0, -(double)f / 32.0) : (f < 40) ? pow(500000.0, -(double)(f - 32) / 8.0) : pow(500000.0, -(double)(f - 40) / 4.0);
#if MK_N_LAUNCHES == 1
    a.ph_lo = 0; a.ph_hi = NPHASE; a.li = 0;
    hipLaunchKernelGGL(fwd<-1>, dim3(grid), dim3(NWAVES * 64), LDS_BYTES, stream, a);
#else
    {
        for (int p = 0; p < NPHASE; ++p) {
            if (p == 1 + NPL) continue;
            a.ph_lo = p; a.ph_hi = p + 1; a.li = p;
            static const int kinds_[NPL] = {1, 2, 3, 4, 5, 6, 7, 8, 10, 11, 12};
            const int kind = (p == 0) ? 0 : kinds_[(p - 1) % NPL];
            launch_kind(kind, grid, stream, a);
        }
    }
#endif
}
```

```cpp
#include <hip/hip_runtime.h>
#include <cstdio>
#include <cstdint>
#include <cmath>

#ifndef MK_N_LAUNCHES
#define MK_N_LAUNCHES 1
#endif

namespace pg8 {
#define PG8_LAS __attribute__((address_space(3)))
typedef unsigned short bf16_t;
typedef short bf16x8 __attribute__((ext_vector_type(8)));
typedef float f32x4 __attribute__((ext_vector_type(4)));
typedef unsigned u32x4 __attribute__((ext_vector_type(4)));
typedef unsigned u32x2 __attribute__((ext_vector_type(2)));
constexpr int BM = 256, BK = 64, HALF = 128, HTB = HALF * BK * 2  , STAGE_BYTES = 8 * HTB, NXCD = 8, WGM = 8;

__host__ __device__ __forceinline__ int lds_byte(int r, int c) { const int st = (r >> 4) * 2 + (c >> 5), rr = r & 15, cc = c & 31, ob = rr * 64 + cc * 2; return st * 1024 + (ob ^ (((ob >> 9) & 1) << 5)); }
__host__ __device__ __forceinline__ void stage_rc(int b, int& R, int& C) { const int st = b / 1024, sb = b % 1024, swz = sb ^ (((sb >> 9) & 1) << 5); R = (st >> 1) * 16 + swz / 64; C = (st & 1) * 32 + (swz % 64) / 2; }
__host__ __device__ __forceinline__ int perm32(int rho) { const int n = rho >> 4, i = rho & 15; return 8 * (i >> 2) + 4 * n + (i & 3); }

struct Unit { int pm, pn; };
struct Gemm { const bf16_t* A; const bf16_t* Bt; int M, N, K; };

struct StaticOrder {
    int nM, nN, nwg, G, c;
    __host__ __device__ void init(int M, int N, int G_, int c_) { nM = M / BM; nN = N / BM; nwg = nM * nN; G = G_; c = c_; }
    __host__ __device__ bool next(int i, Unit& u) const {
        const long L = (long)i * G + c; if (L >= nwg) return false;
        int wgid = (int)L; { const int q = nwg / NXCD, r = nwg % NXCD, xcd = wgid % NXCD, off = wgid / NXCD; wgid = (xcd < r ? xcd * (q + 1) : r * (q + 1) + (xcd - r) * q) + off; }
        const int nig = WGM * nN, gid = wgid / nig, fm = gid * WGM, gsz = (nM - fm) < WGM ? (nM - fm) : WGM;
        u.pm = fm + ((wgid % nig) % gsz); u.pn = (wgid % nig) / gsz; return true;
    }
    __device__ __forceinline__ void a_ready(const Unit&) const {}
    __device__ __forceinline__ void done(const Unit&) const {}
};
__device__ __forceinline__ unsigned cvt_pk_bf16(float lo, float hi) { unsigned r; asm volatile("v_cvt_pk_bf16_f32 %0, %1, %2" : "=v"(r) : "v"(lo), "v"(hi)); return r; }
struct EpiF32 {
    static constexpr bool PERM = false, AFTER_DRAIN = false;
    float* C; int ldc;
    __device__ __forceinline__ void operator()(const f32x4 (&acc)[2][2][4][2], const Unit& u, int wr, int wc, int fr, int fq) const {
        const int row0 = u.pm * BM + wr * 64 + fr, col0 = u.pn * BM + wc * 32 + 4 * fq;
#pragma unroll
        for (int ai = 0; ai < 2; ++ai)
#pragma unroll
            for (int m = 0; m < 4; ++m) { float* rowp = C + (size_t)(row0 + ai * HALF + m * 16) * ldc + col0;
#pragma unroll
                for (int bj = 0; bj < 2; ++bj)
#pragma unroll
                    for (int n = 0; n < 2; ++n) *(f32x4*)(rowp + bj * HALF + n * 16) = acc[ai][bj][m][n]; }
    }
};
struct EpiProj {
    static constexpr bool PERM = true, AFTER_DRAIN = false;
    bf16_t* PB; float* PF;
    __device__ __forceinline__ void operator()(const f32x4 (&acc)[2][2][4][2], const Unit& u, int wr, int wc, int fr, int fq) const {
        const int row0 = u.pm * BM + wr * 64 + fr;
        if (u.pn < 7) { const int c0 = u.pn * BM + wc * 32 + 8 * fq;
#pragma unroll
            for (int ai = 0; ai < 2; ++ai)
#pragma unroll
                for (int m = 0; m < 4; ++m) { bf16_t* rowp = PB + (size_t)(row0 + ai * HALF + m * 16) * 1792 + c0;
#pragma unroll
                    for (int bj = 0; bj < 2; ++bj) { const f32x4 v0 = acc[ai][bj][m][0], v1 = acc[ai][bj][m][1];
                        u32x4 w; w.x = cvt_pk_bf16(v0[0], v0[1]); w.y = cvt_pk_bf16(v0[2], v0[3]); w.z = cvt_pk_bf16(v1[0], v1[1]); w.w = cvt_pk_bf16(v1[2], v1[3]);
                        *(u32x4*)(rowp + bj * HALF) = w; } }
        } else { const int c0 = (u.pn - 7) * BM + wc * 32 + 8 * fq;
#pragma unroll
            for (int ai = 0; ai < 2; ++ai)
#pragma unroll
                for (int m = 0; m < 4; ++m) { float* rowp = PF + (size_t)(row0 + ai * HALF + m * 16) * 1280 + c0;
#pragma unroll
                    for (int bj = 0; bj < 2; ++bj) { *(f32x4*)(rowp + bj * HALF) = acc[ai][bj][m][0]; *(f32x4*)(rowp + bj * HALF + 4) = acc[ai][bj][m][1]; } }
        }
    }
};
struct EpiRes {
    static constexpr bool PERM = false, AFTER_DRAIN = false;
    const float* xin; float* xout; const float* gate;
    __device__ __forceinline__ void operator()(const f32x4 (&acc)[2][2][4][2], const Unit& u, int wr, int wc, int fr, int fq) const {
        const int row0 = u.pm * BM + wr * 64 + fr, col0 = u.pn * BM + wc * 32 + 4 * fq;
        const float* gp = gate + (size_t)((u.pm * BM) >> 12) * 6144 + col0;
        f32x4 gv[2][2];
#pragma unroll
        for (int bj = 0; bj < 2; ++bj)
#pragma unroll
            for (int n = 0; n < 2; ++n) gv[bj][n] = *(const f32x4*)(gp + bj * HALF + n * 16);
#pragma unroll
        for (int ai = 0; ai < 2; ++ai)
#pragma unroll
            for (int m = 0; m < 4; ++m) { const size_t ro = (size_t)(row0 + ai * HALF + m * 16) * 1024 + col0;
#pragma unroll
                for (int bj = 0; bj < 2; ++bj)
#pragma unroll
                    for (int n = 0; n < 2; ++n) { const f32x4 xv = *(const f32x4*)(xin + ro + bj * HALF + n * 16); *(f32x4*)(xout + ro + bj * HALF + n * 16) = xv + gv[bj][n] * acc[ai][bj][m][n]; } }
    }
};
__device__ __forceinline__ float swiglu1(float glu, float lin) {
    glu = fminf(glu, 7.0f); lin = fminf(fmaxf(lin, -7.0f), 7.0f);
    return glu * (1.0f / (1.0f + __expf(-1.702f * glu))) * (lin + 1.0f);
}
struct EpiSwiglu {
    static constexpr bool PERM = true, AFTER_DRAIN = false;
    bf16_t* O; const float* b1;
    __device__ __forceinline__ void operator()(const f32x4 (&acc)[2][2][4][2], const Unit& u, int wr, int wc, int fr, int fq) const {
        const int e = u.pn >> 3, j = u.pn & 7, row0 = u.pm * BM + wr * 64 + fr, c0 = 128 * j + wc * 32 + 8 * fq;
        const float* bp = b1 + (size_t)e * 2048 + c0;
        f32x4 bg[2], bl[2];
#pragma unroll
        for (int n = 0; n < 2; ++n) { bg[n] = *(const f32x4*)(bp + 4 * n); bl[n] = *(const f32x4*)(bp + 1024 + 4 * n); }
#pragma unroll
        for (int ai = 0; ai < 2; ++ai)
#pragma unroll
            for (int m = 0; m < 4; ++m) { bf16_t* rowp = O + (size_t)(row0 + ai * HALF + m * 16) * 1024 + c0;
                const f32x4 g0 = acc[ai][0][m][0] + bg[0], g1 = acc[ai][0][m][1] + bg[1], l0 = acc[ai][1][m][0] + bl[0], l1 = acc[ai][1][m][1] + bl[1];
                u32x4 w;
                w.x = cvt_pk_bf16(swiglu1(g0[0], l0[0]), swiglu1(g0[1], l0[1])); w.y = cvt_pk_bf16(swiglu1(g0[2], l0[2]), swiglu1(g0[3], l0[3]));
                w.z = cvt_pk_bf16(swiglu1(g1[0], l1[0]), swiglu1(g1[1], l1[1])); w.w = cvt_pk_bf16(swiglu1(g1[2], l1[2]), swiglu1(g1[3], l1[3]));
                *(u32x4*)rowp = w; }
    }
};
struct EpiY {
    static constexpr bool PERM = true, AFTER_DRAIN = false;
    bf16_t* O; const float* b2;
    __device__ __forceinline__ void operator()(const f32x4 (&acc)[2][2][4][2], const Unit& u, int wr, int wc, int fr, int fq) const {
        const int e = u.pn >> 2, j = u.pn & 3, row0 = u.pm * BM + wr * 64 + fr, c0 = 256 * j + wc * 32 + 8 * fq;
        const float* bp = b2 + (size_t)e * 1024 + c0;
        f32x4 bv[2][2];
#pragma unroll
        for (int bj = 0; bj < 2; ++bj)
#pragma unroll
            for (int n = 0; n < 2; ++n) bv[bj][n] = *(const f32x4*)(bp + bj * HALF + 4 * n);
#pragma unroll
        for (int ai = 0; ai < 2; ++ai)
#pragma unroll
            for (int m = 0; m < 4; ++m) { bf16_t* rowp = O + (size_t)(row0 + ai * HALF + m * 16) * 1024 + c0;
#pragma unroll
                for (int bj = 0; bj < 2; ++bj) { const f32x4 v0 = acc[ai][bj][m][0] + bv[bj][0], v1 = acc[ai][bj][m][1] + bv[bj][1];
                    u32x4 w; w.x = cvt_pk_bf16(v0[0], v0[1]); w.y = cvt_pk_bf16(v0[2], v0[3]); w.z = cvt_pk_bf16(v1[0], v1[1]); w.w = cvt_pk_bf16(v1[2], v1[3]);
                    *(u32x4*)(rowp + bj * HALF) = w; } }
    }
};
struct MoeOrder {
    const PG8_LAS int* tab; int NJ, G, c;
    __device__ __forceinline__ bool next(int i, Unit& u) const {
        const int T = tab[0]; const long L = (long)i * G + c; if (L >= (long)T * NJ) return false;
        const int pm = (int)(L / NJ), j = (int)(L % NJ);
        u.pm = pm; u.pn = tab[1 + pm] * NJ + j; return true;
    }
    __device__ __forceinline__ void a_ready(const Unit&) const {}
    __device__ __forceinline__ void done(const Unit&) const {}
    const PG8_LAS int* tst; const PG8_LAS int* cnt; const int* list;
    __device__ __forceinline__ int row_of(const Unit& u, int r) const { const int e = tab[1 + u.pm], idx = 256 * (u.pm - tst[e]) + r; return (idx < cnt[e]) ? list[e * 32768 + idx] : 0; }
};

template <class Epi, class Sched, bool ALIGN_EPI = false, bool SP2 = false, bool GATHER = false>
__device__ __forceinline__ void gemm_phase(PG8_LAS unsigned char* lds, const Gemm g, const Sched& S, const Epi& E, int tid_in) {
    int tid_ = tid_in; asm volatile("" : "+v"(tid_));
    const int tid = tid_, wid = __builtin_amdgcn_readfirstlane(tid >> 6), lane = tid & 63, wr = wid >> 2, wc = wid & 3, fr = lane & 15, fq = lane >> 4;
    const int K = g.K, nt = K / BK;
    unsigned voffA[2], voffB[2];
#pragma unroll
    for (int i = 0; i < 2; ++i) { int R, C; stage_rc(tid * 16 + i * 8192, R, C); const int Rb = Epi::PERM ? ((R & ~31) + perm32(R & 31)) : R;
        voffA[i] = (unsigned)(R * K + C) * 2u; voffB[i] = (unsigned)(Rb * K + C) * 2u; }
    static_assert(!GATHER || SP2, "gathered A rows: only the two-super-phase loop is wired");
    unsigned cvo[2][2], nvo[2][2];
#define PG8_ROWS(dst, u_) do { _Pragma("unroll") for (int h_ = 0; h_ < 2; ++h_) _Pragma("unroll") for (int i_ = 0; i_ < 2; ++i_) { int R_, C_; stage_rc(tid * 16 + i_ * 8192, R_, C_); dst[h_][i_] = (unsigned)(S.row_of(u_, h_ * HALF + R_) * K + C_) * 2u; } } while (0)
#define PG8_STAGE_A(bufoff, gbase, half, nx) do { if constexpr (GATHER) { unsigned o_[2]; o_[0] = (nx) ? nvo[half][0] : cvo[half][0]; o_[1] = (nx) ? nvo[half][1] : cvo[half][1]; PG8_STAGE(bufoff, gbase, o_); } else { PG8_STAGE(bufoff, (gbase) + (half) * hstep, voffA); } } while (0)
    const size_t kstep = (size_t)(BK * 2);
    const size_t hstep = (size_t)HALF * K * 2;
    const size_t tstep = 2 * hstep;
    const unsigned ldsw = (unsigned)wid * 1024u;
    const int aoff = lds_byte(wr * 64 + fr, fq * 8), boff = lds_byte(wc * 32 + fr, fq * 8);
#define PG8_SA(b, h) (((b) * 2 + (h)) * HTB)
#define PG8_SB(b, h) ((4 + (b) * 2 + (h)) * HTB)
#define PG8_STAGE(bufoff, gbase, voff) do { _Pragma("unroll") for (int _i = 0; _i < 2; ++_i) \
        __builtin_amdgcn_global_load_lds((const unsigned*)((const char*)(gbase) + (voff)[_i]), (PG8_LAS unsigned*)(lds + (bufoff) + ldsw + _i * 8192), 16, 0, 0); } while (0)
#define PG8_LDA(dst, b, h) do { _Pragma("unroll") for (int m = 0; m < 4; ++m) _Pragma("unroll") for (int k = 0; k < 2; ++k) dst[m][k] = *(const PG8_LAS bf16x8*)(lds + PG8_SA(b, h) + aoff + m * 2048 + k * 1024); } while (0)
#define PG8_LDB(dst, b, h) do { _Pragma("unroll") for (int n = 0; n < 2; ++n) _Pragma("unroll") for (int k = 0; k < 2; ++k) dst[n][k] = *(const PG8_LAS bf16x8*)(lds + PG8_SB(b, h) + boff + n * 2048 + k * 1024); } while (0)
#define PG8_MMA(ai, bj, At, Bt) do { __builtin_amdgcn_s_setprio(1); _Pragma("unroll") for (int m = 0; m < 4; ++m) _Pragma("unroll") for (int n = 0; n < 2; ++n) _Pragma("unroll") for (int k = 0; k < 2; ++k) \
        acc[ai][bj][m][n] = __builtin_amdgcn_mfma_f32_16x16x32_bf16(Bt[n][k], At[m][k], acc[ai][bj][m][n], 0, 0, 0); __builtin_amdgcn_s_setprio(0); } while (0)
#define PG8_WAIT_V(n) asm volatile("s_waitcnt vmcnt(" #n ")" ::: "memory")
#define PG8_WAIT_L(n) asm volatile("s_waitcnt lgkmcnt(" #n ")" ::: "memory")
#define PG8_BAR __builtin_amdgcn_s_barrier()
#define PG8_SCHED __builtin_amdgcn_sched_barrier(0)
    Unit cur, nxt; int ui = 0;
    if (!S.next(0, cur)) return;
    f32x4 acc[2][2][4][2];
#pragma unroll
    for (int a = 0; a < 2; ++a)
#pragma unroll
        for (int b = 0; b < 2; ++b)
#pragma unroll
            for (int m = 0; m < 4; ++m)
#pragma unroll
                for (int n = 0; n < 2; ++n) acc[a][b][m][n] = (f32x4){0.f, 0.f, 0.f, 0.f};
    bf16x8 At[4][2], B0[2][2], B1[2][2];
    const char* cA = (const char*)g.A + (GATHER ? (size_t)0 : (size_t)cur.pm * tstep); const char* cB = (const char*)g.Bt + (size_t)cur.pn * tstep;
    if constexpr (GATHER) { PG8_ROWS(cvo, cur); }
    S.a_ready(cur);
    if constexpr (SP2) {
        PG8_STAGE(PG8_SB(0, 0), cB, voffB); PG8_STAGE(PG8_SB(0, 1), cB + hstep, voffB); PG8_STAGE_A(PG8_SA(0, 0), cA, 0, false); PG8_STAGE_A(PG8_SA(0, 1), cA, 1, false);
        if (wr == 1) PG8_BAR;
        PG8_WAIT_V(2); PG8_BAR;
        PG8_STAGE(PG8_SB(1, 0), cB + kstep, voffB); PG8_STAGE_A(PG8_SA(1, 0), cA + kstep, 0, false); PG8_STAGE(PG8_SB(1, 1), cB + hstep + kstep, voffB);
        PG8_WAIT_V(6); PG8_BAR;
    } else {
        PG8_STAGE(PG8_SB(0, 0), cB, voffB); PG8_STAGE(PG8_SA(0, 0), cA, voffA); PG8_STAGE(PG8_SB(0, 1), cB + hstep, voffB); PG8_STAGE(PG8_SA(0, 1), cA + hstep, voffA);
        if (wr == 1) PG8_BAR;
        PG8_WAIT_V(4); PG8_BAR;
        PG8_STAGE(PG8_SB(1, 0), cB + kstep, voffB); PG8_STAGE(PG8_SA(1, 0), cA + kstep, voffA); PG8_STAGE(PG8_SB(1, 1), cB + hstep + kstep, voffB);
        PG8_WAIT_V(6); PG8_BAR;
    }
    for (;;) {
        const bool has_next = S.next(ui + 1, nxt);
        const char* nA = GATHER ? (const char*)g.A : (has_next ? (const char*)g.A + (size_t)nxt.pm * tstep : cA); const char* nB = has_next ? (const char*)g.Bt + (size_t)nxt.pn * tstep : cB;
        if constexpr (GATHER) { if (has_next) { PG8_ROWS(nvo, nxt); } else { _Pragma("unroll") for (int h_ = 0; h_ < 2; ++h_) { nvo[h_][0] = cvo[h_][0]; nvo[h_][1] = cvo[h_][1]; } } }
        for (int t = 0; t < nt; t += 2) {
            const bool last = (t == nt - 2);
            const char* a1 = cA + (size_t)(t + 1) * kstep;
            const char* a2 = last ? nA : cA + (size_t)(t + 2) * kstep; const char* b2 = last ? nB : cB + (size_t)(t + 2) * kstep;
            const char* a3 = a2 + kstep; const char* b3 = b2 + kstep;
            if (last && has_next) S.a_ready(nxt);
            if constexpr (SP2) {
            PG8_LDB(B0, 0, 0); PG8_LDB(B1, 0, 1); PG8_SCHED; PG8_LDA(At, 0, 0); PG8_STAGE_A(PG8_SA(1, 1), a1, 1, false);
            PG8_WAIT_V(8); PG8_WAIT_L(0); PG8_BAR; PG8_MMA(0, 0, At, B0); PG8_MMA(0, 1, At, B1); PG8_BAR; PG8_SCHED;
            PG8_LDA(At, 0, 1); PG8_STAGE(PG8_SB(0, 0), b2, voffB); PG8_STAGE(PG8_SB(0, 1), b2 + hstep, voffB); PG8_STAGE_A(PG8_SA(0, 0), a2, 0, last);
            PG8_WAIT_V(8); PG8_WAIT_L(0); PG8_BAR; PG8_MMA(1, 0, At, B0); PG8_MMA(1, 1, At, B1); PG8_BAR; PG8_SCHED;
            PG8_LDB(B0, 1, 0); PG8_LDB(B1, 1, 1); PG8_SCHED; PG8_LDA(At, 1, 0); PG8_STAGE_A(PG8_SA(0, 1), a2, 1, last);
            PG8_WAIT_V(8); PG8_WAIT_L(0); PG8_BAR; PG8_MMA(0, 0, At, B0); PG8_MMA(0, 1, At, B1); PG8_BAR; PG8_SCHED;
            PG8_LDA(At, 1, 1); PG8_STAGE(PG8_SB(1, 0), b3, voffB); PG8_STAGE(PG8_SB(1, 1), b3 + hstep, voffB); PG8_STAGE_A(PG8_SA(1, 0), a3, 0, last);
            PG8_WAIT_V(8); PG8_WAIT_L(0); PG8_BAR; PG8_MMA(1, 0, At, B0); PG8_MMA(1, 1, At, B1); PG8_BAR; PG8_SCHED;
            } else {
            PG8_LDB(B0, 0, 0); PG8_SCHED; PG8_LDA(At, 0, 0); PG8_STAGE(PG8_SA(1, 1), a1 + hstep, voffA);
            PG8_WAIT_L(8); PG8_BAR; PG8_WAIT_L(0); PG8_MMA(0, 0, At, B0); PG8_BAR; PG8_SCHED;
            PG8_LDB(B1, 0, 1); PG8_STAGE(PG8_SB(0, 0), b2, voffB);
            PG8_BAR; PG8_WAIT_L(0); PG8_MMA(0, 1, At, B1); PG8_BAR;
            PG8_LDA(At, 0, 1); PG8_STAGE(PG8_SA(0, 0), a2, voffA);
            PG8_BAR; PG8_WAIT_L(0); PG8_MMA(1, 0, At, B0); PG8_BAR; PG8_SCHED;
            PG8_STAGE(PG8_SB(0, 1), b2 + hstep, voffB);
            PG8_WAIT_V(6); PG8_BAR; PG8_MMA(1, 1, At, B1); PG8_BAR;
            PG8_LDB(B0, 1, 0); PG8_SCHED; PG8_LDA(At, 1, 0); PG8_STAGE(PG8_SA(0, 1), a2 + hstep, voffA);
            PG8_WAIT_L(8); PG8_BAR; PG8_WAIT_L(0); PG8_MMA(0, 0, At, B0); PG8_BAR; PG8_SCHED;
            PG8_LDB(B1, 1, 1); PG8_STAGE(PG8_SB(1, 0), b3, voffB);
            PG8_BAR; PG8_WAIT_L(0); PG8_MMA(0, 1, At, B1); PG8_BAR;
            PG8_LDA(At, 1, 1); PG8_STAGE(PG8_SA(1, 0), a3, voffA);
            PG8_BAR; PG8_WAIT_L(0); PG8_MMA(1, 0, At, B0); PG8_BAR; PG8_SCHED;
            PG8_STAGE(PG8_SB(1, 1), b3 + hstep, voffB);
            PG8_WAIT_V(6); PG8_BAR; PG8_MMA(1, 1, At, B1); PG8_BAR;
            }
        }
        if constexpr (ALIGN_EPI) { if (wr == 0) PG8_BAR; }
        if constexpr (!Epi::AFTER_DRAIN) { E(acc, cur, wr, wc, fr, fq); S.done(cur); }
        if (!has_next) break;
#pragma unroll
        for (int a = 0; a < 2; ++a)
#pragma unroll
            for (int b = 0; b < 2; ++b)
#pragma unroll
                for (int m = 0; m < 4; ++m)
#pragma unroll
                    for (int n = 0; n < 2; ++n) acc[a][b][m][n] = (f32x4){0.f, 0.f, 0.f, 0.f};
        cur = nxt; cA = nA; cB = nB; ++ui;
        if constexpr (GATHER) { _Pragma("unroll") for (int h_ = 0; h_ < 2; ++h_) { cvo[h_][0] = nvo[h_][0]; cvo[h_][1] = nvo[h_][1]; } }
        if constexpr (ALIGN_EPI) { if (wr == 1) PG8_BAR; }
    }
    PG8_WAIT_V(0);
    if constexpr (!ALIGN_EPI) { if (wr == 0) PG8_BAR; }
    PG8_BAR;
    if constexpr (Epi::AFTER_DRAIN) { E.fused(acc, cur, wr, wc, fr, fq, lds, wid, lane); S.done(cur); }
#undef PG8_SA
#undef PG8_SB
#undef PG8_STAGE
#undef PG8_STAGE_A
#undef PG8_ROWS
#undef PG8_LDA
#undef PG8_LDB
#undef PG8_MMA
#undef PG8_WAIT_V
#undef PG8_WAIT_L
#undef PG8_BAR
#undef PG8_SCHED
}
}

constexpr int NWAVES = 8;
constexpr int NB = 8, SEQ = 4096, DM = 1024, MTOK = NB * SEQ, NLAYER = 2;
constexpr int INC = 2984, INCP = 3072;
constexpr int C_RET = 0, C_RW = 1024, C_DSA = 1920, C_SB = 2216;
constexpr int PBW = 1792, PFW = 1280, PB_SB = 1024, PF_DSA = 896;
constexpr int NEXP = 32, MOE_ROWS = MTOK * 4 + NEXP * 256;
constexpr int ROPE_W = 88;
constexpr int NCH = 16, TCH = SEQ / NCH;
constexpr int NPL = 11, NPHASE = 1 + NLAYER * NPL;
enum { I_X = 0, I_C, I_POS, I_ADAW, I_ADAB, I_NMIX, I_NFFN, I_WIN, I_RETGN, I_MU, I_W0, I_W2, I_A0, I_A2, I_G2, I_KK, I_KA, I_RK, I_LN, I_QNORM, I_WQ, I_WQI, I_DONORM, I_SONORM, I_WOUT, I_RW, I_RB, I_MW1, I_MB1, I_MW2, I_MB2, I_NFINAL, N_IN };

constexpr size_t MiB = 1u << 20;
constexpr size_t WS_CTL = 0, CTL_ZERO_BYTES = 1 * MiB;
constexpr size_t WS_MOD = 1 * MiB, WS_ROPE = 2 * MiB, WS_WIN = 14 * MiB, WS_WOUT = 26 * MiB, WS_W1 = 30 * MiB, WS_W2 = 286 * MiB;
constexpr size_t WS_XA = 414 * MiB, WS_H = 542 * MiB, WS_MIX = 606 * MiB, WS_TOPI = 670 * MiB, WS_TOPW = 671 * MiB, WS_POS = 672 * MiB;
constexpr size_t WS_R = 674 * MiB;
constexpr size_t WS_PB = WS_R  , WS_PF = WS_R + 112 * MiB  , WS_RWA = 1058 * MiB  , WS_DQ = 1314 * MiB  , WS_DKB = 1330 * MiB  , WS_DVB = 1334 * MiB  , WS_DQI = 1346 * MiB  , WS_DKI = 1394 * MiB  , WS_DW = 1398 * MiB;
constexpr size_t WS_SMALLW = 1338 * MiB  ;
constexpr int SMW_QI = 0, SMW_W2 = 512 * 128, SMW_A2 = SMW_W2 + 256 * 32, SMW_G2 = SMW_A2 + 256 * 32, SMW_LAYER = SMW_G2 + 256 * 64;
constexpr size_t WS_PT = 1362 * MiB  ;
constexpr size_t WS_CH = WS_H  , WS_SI = WS_H + 16 * MiB  , WS_SIR = WS_H + 24 * MiB  ,
                 WS_CHR = WS_H + 32 * MiB  , WS_PTR = WS_H + 40 * MiB  ;
constexpr size_t WS_SQ = WS_MIX  , WS_SK = WS_MIX + 16 * MiB, WS_SV = WS_MIX + 32 * MiB;
constexpr size_t WS_YO = 1400 * MiB  , WS_SC = 1528 * MiB  ;
constexpr size_t WS_XS = WS_R  , WS_ACT = 946 * MiB  ;
constexpr size_t WS_LIST = 2040 * MiB  , WS_END = 2044 * MiB;
constexpr int LCAP = 32768;
static_assert((size_t)MOE_ROWS * 2048 <= 272 * MiB, "moe buffers");
constexpr int CW_TMO = 0, CW_CODE = 1, CW_GCNT = 256  , CW_DSAQ = 64  , CW_BAR = 4096, CW_BLKCNT = 16384  ;
constexpr int RING_BYTES = 131072, MISC_OFF = RING_BYTES + 320, TST_OFF = RING_BYTES + 1024  , TAB_OFF = RING_BYTES + 2048  , HIST_OFF = RING_BYTES + 5120  , BASE_OFF = RING_BYTES + 5376  , CNT_OFF = RING_BYTES + 5632  , TEXP_OFF = RING_BYTES + 6144  , LDS_BYTES = 147456;

#if defined(__HIP_DEVICE_COMPILE__)
#define GAS __attribute__((address_space(1)))
#define CAS __attribute__((address_space(4)))
#else
#define GAS
#define CAS
#endif
#define LAS __attribute__((address_space(3)))
typedef unsigned short bf16;
typedef unsigned v4u __attribute__((ext_vector_type(4)));
typedef unsigned v2u __attribute__((ext_vector_type(2)));
typedef float f32x4 __attribute__((ext_vector_type(4)));
typedef GAS unsigned gu32;
typedef short bf16x8v __attribute__((ext_vector_type(8)));
typedef short s16x4v __attribute__((ext_vector_type(4)));
typedef _Float16 f16x8 __attribute__((ext_vector_type(8)));
#define RLX_AGENT __ATOMIC_RELAXED, __HIP_MEMORY_SCOPE_AGENT
#define LDS_WAIT() asm volatile("s_waitcnt lgkmcnt(0)" ::: "memory")
#define VM_WAIT() asm volatile("s_waitcnt vmcnt(0)" ::: "memory")
__device__ __forceinline__ unsigned f2bf(float f) { unsigned u = __builtin_bit_cast(unsigned, f); return (u + 0x7fffu + ((u >> 16) & 1u)) >> 16; }
__device__ __forceinline__ unsigned pk2(float lo, float hi) { return f2bf(lo) | (f2bf(hi) << 16); }
__device__ __forceinline__ float bf_lo(unsigned w) { return __builtin_bit_cast(float, w << 16); }
__device__ __forceinline__ float bf_hi(unsigned w) { return __builtin_bit_cast(float, w & 0xffff0000u); }
__device__ __forceinline__ float wave_sum(float v) {
#pragma unroll
    for (int o = 1; o < 64; o <<= 1) v += __shfl_xor(v, o);
    return v;
}
__device__ __forceinline__ float wave_max(float v) {
#pragma unroll
    for (int o = 1; o < 64; o <<= 1) v = fmaxf(v, __shfl_xor(v, o));
    return v;
}
__device__ __forceinline__ float grp16_sum(float v) { v += __shfl_xor(v, 1); v += __shfl_xor(v, 2); v += __shfl_xor(v, 4); v += __shfl_xor(v, 8); return v; }
__device__ __forceinline__ float grp8_sum(float v) { v += __shfl_xor(v, 1); v += __shfl_xor(v, 2); v += __shfl_xor(v, 4); return v; }
__device__ __forceinline__ float sum4(f32x4 a) { return (a.x + a.y) + (a.z + a.w); }
__device__ __forceinline__ float dot4(f32x4 a, f32x4 b) { return (a.x * b.x + a.y * b.y) + (a.z * b.z + a.w * b.w); }
__device__ __forceinline__ float fexp(float x) { return __builtin_amdgcn_exp2f(x * 1.4426950408889634f); }
__device__ __forceinline__ float sigm(float x) { return __builtin_amdgcn_rcpf(1.0f + fexp(-x)); }
__device__ __forceinline__ float softplusf(float x) { return fmaxf(x, 0.0f) + 0.6931471805599453f * __builtin_amdgcn_logf(1.0f + fexp(-fabsf(x))); }
__device__ __forceinline__ float ftanh(float x) { const float e = fexp(-2.0f * fabsf(x)); const float t = (1.0f - e) * __builtin_amdgcn_rcpf(1.0f + e); return x < 0.0f ? -t : t; }
__device__ __forceinline__ f32x4 shx4(f32x4 v, int m) { f32x4 r; r.x = __shfl_xor(v.x, m); r.y = __shfl_xor(v.y, m); r.z = __shfl_xor(v.z, m); r.w = __shfl_xor(v.w, m); return r; }

#define XB_TMO      128
#define XB_XCNT(j)  (256  + 64 * (j))
#define XB_XSUB(j)  (1280 + 64 * (j))
#define XB_XGEN(j)  (2304 + 64 * (j))
#define XB_TOP      3328
#define XB_TOPGEN   3392
#define XCD_BAR_WORDS 3456
#define XB_SPIN_CAP (1u << 18)

__device__ __forceinline__ unsigned xb_ld(unsigned* p)              { return __hip_atomic_load(p, __ATOMIC_RELAXED, __HIP_MEMORY_SCOPE_AGENT); }
__device__ __forceinline__ unsigned xb_add(unsigned* p, unsigned v) { return __hip_atomic_fetch_add(p, v, __ATOMIC_RELAXED, __HIP_MEMORY_SCOPE_AGENT); }
__device__ __forceinline__ unsigned xb_xcc_id() { return (unsigned)__builtin_amdgcn_s_getreg((3 << 11) | 20) & 0xFu; }
#define XB_SPIN(cond, bar) do { unsigned _sp = 0; while (cond) { __builtin_amdgcn_s_sleep(1); \
    if ((++_sp & 255u) == 0u) { if (xb_ld(&(bar)[XB_TMO])) break; if (_sp > XB_SPIN_CAP) { atomicAdd(&(bar)[XB_TMO], 1u); break; } } } } while (0)

struct XcdBarrier {
    unsigned* bar; unsigned x;
    volatile LAS unsigned* st;
};

__device__ __forceinline__ XcdBarrier xcd_barrier_post(unsigned* bar, volatile LAS unsigned* st, int xb_tid) {
    XcdBarrier b; b.bar = bar; b.x = xb_xcc_id(); b.st = st;
    if (xb_tid == 0) (void)xb_add(&bar[XB_XCNT(b.x)], 1u);
    return b;
}
__device__ __forceinline__ void xcd_barrier_complete(unsigned* bar, unsigned x, unsigned& nloc, unsigned& nx) {
    const unsigned G = gridDim.x * gridDim.y * gridDim.z;
    unsigned sum, cnt, mine, sp = 0u;
    for (;;) {
        sum = 0u; cnt = 0u; mine = 0u;
#pragma unroll
        for (unsigned j = 0; j < 16; ++j) { const unsigned c = xb_ld(&bar[XB_XCNT(j)]); sum += c; cnt += (c > 0u) ? 1u : 0u; mine = (j == x) ? c : mine; }
        if (sum == G) break;
        __builtin_amdgcn_s_sleep(1);
        if ((++sp & 255u) == 0u) { if (xb_ld(&bar[XB_TMO])) break; if (sp > XB_SPIN_CAP) { atomicAdd(&bar[XB_TMO], 1u); break; } }
    }
    nloc = mine > 0u ? mine : 1u; nx = cnt > 0u ? cnt : 1u;
}

__device__ __forceinline__ void xcd_barrier(const XcdBarrier& b, int xb_tid) {
    asm volatile("s_waitcnt vmcnt(0)" ::: "memory");
    __syncthreads();
    if (xb_tid == 0) {
        unsigned* bar = b.bar;
        __builtin_amdgcn_s_waitcnt(0);
        unsigned nloc = b.st[0], nx = b.st[1];
        if (nloc == 0u) { xcd_barrier_complete(bar, b.x, nloc, nx); b.st[0] = nloc; b.st[1] = nx; }
        const unsigned old = xb_add(&bar[XB_XSUB(b.x)], 1u);
        const unsigned gen = old / nloc;
        if (old + 1u == (gen + 1u) * nloc) {
            __builtin_amdgcn_fence(__ATOMIC_RELEASE, "agent");
            asm volatile("s_waitcnt vmcnt(0)" ::: "memory");
            const unsigned og = xb_add(&bar[XB_TOP], 1u);
            const unsigned tg = og / nx;
            if (og + 1u == (tg + 1u) * nx) xb_add(&bar[XB_TOPGEN], 1u);
            else XB_SPIN(xb_ld(&bar[XB_TOPGEN]) == tg, bar);
            __builtin_amdgcn_fence(__ATOMIC_ACQUIRE, "agent");
            xb_add(&bar[XB_XGEN(b.x)], 1u);
            asm volatile("s_waitcnt vmcnt(0)" ::: "memory");
        } else {
            XB_SPIN(xb_ld(&bar[XB_XGEN(b.x)]) == gen, bar);
            __builtin_amdgcn_fence(__ATOMIC_ACQUIRE, "agent");
            asm volatile("s_waitcnt vmcnt(0)" ::: "memory");
        }
    }
    __syncthreads();
}
struct ArgsH { const float* in[N_IN]; float* out; unsigned char* ws; double invf[44]; int ph_lo, ph_hi, li, pad; };
struct ArgsD { const GAS float* in[N_IN]; GAS float* out; GAS unsigned char* ws; double invf[44]; int ph_lo, ph_hi, li, pad; };
static_assert(sizeof(ArgsH) == sizeof(ArgsD), "args layout");
typedef const CAS ArgsD& ARef;
__device__ __forceinline__ const CAS ArgsD* kargs() {
#if defined(__HIP_DEVICE_COMPILE__)
    const CAS ArgsD* p = (const CAS ArgsD*)__builtin_amdgcn_kernarg_segment_ptr(); asm volatile("" : "+s"(p)); return p;
#else
    return nullptr;
#endif
}
struct WI { LAS unsigned char* lds; int tid, lane, wave, vcu, G, gw, NGW, bx; };
constexpr size_t RWA_STRIDE = 32 * MiB / 4;
constexpr size_t YO_STRIDE = 32 * MiB / 4;

__device__ __forceinline__ int wave_sum_i(int v) {
#pragma unroll
    for (int o = 1; o < 64; o <<= 1) v += __shfl_xor(v, o);
    return v;
}
__device__ __forceinline__ void sincos_d(double ang, float& s, float& c) {
    const double q = __builtin_rint(ang * 0.63661977236758134308);
    double r = __builtin_fma(-q, 1.57079632679489661923, ang); r = __builtin_fma(-q, 6.123233995736766e-17, r);
    const double r2 = r * r;
    const double sp = r * (1.0 + r2 * (-1.0 / 6 + r2 * (1.0 / 120 + r2 * (-1.0 / 5040 + r2 * (1.0 / 362880 + r2 * (-1.0 / 39916800 + r2 * (1.0 / 6227020800.0)))))));
    const double cp = 1.0 + r2 * (-0.5 + r2 * (1.0 / 24 + r2 * (-1.0 / 720 + r2 * (1.0 / 40320 + r2 * (-1.0 / 3628800 + r2 * (1.0 / 479001600 + r2 * (-1.0 / 87178291200.0)))))));
    const int qi = ((int)q) & 3;
    const double ss = (qi == 0) ? sp : (qi == 1) ? cp : (qi == 2) ? -sp : -cp;
    const double cc = (qi == 0) ? cp : (qi == 1) ? -sp : (qi == 2) ? -cp : sp;
    s = (float)ss; c = (float)cc;
}

__device__ __forceinline__ void tr_item(const float* W, int ldw, int nvalid, int k0, int nsrc0, bf16* WT, size_t dstrow0, LAS float* scr, int lane, float scale = 1.0f) {
#pragma unroll 8
    for (int i = 0; i < 32; ++i) { const int kk = 2 * i + (lane >> 5), c = lane & 31, n = nsrc0 + c; scr[kk * 33 + c] = (n < nvalid) ? W[(size_t)(k0 + kk) * ldw + n] * scale : 0.0f; }
    LDS_WAIT(); asm volatile("" ::: "memory");
    const int c8 = lane & 7;
#pragma unroll
    for (int j = 0; j < 4; ++j) { const int n = (lane >> 3) + 8 * j; const LAS float* s = scr + (8 * c8) * 33 + n;
        v4u o; o.x = pk2(s[0 * 33], s[1 * 33]); o.y = pk2(s[2 * 33], s[3 * 33]); o.z = pk2(s[4 * 33], s[5 * 33]); o.w = pk2(s[6 * 33], s[7 * 33]);
        *(v4u*)(WT + (dstrow0 + n) * 1024 + k0 + 8 * c8) = o; }
    LDS_WAIT(); asm volatile("" ::: "memory");
}
__device__ __forceinline__ void ph_prologue(ARef A, const WI& w) {
    LAS float* sc = (LAS float*)w.lds;
    { const float* cin = A.in[I_C]; for (int i = w.tid; i < NB * DM; i += NWAVES * 64) { const float v = cin[i]; sc[i] = v / (1.0f + expf(-v)); } }
    __syncthreads();
    float* MOD = (float*)(A.ws + WS_MOD);
    if (w.wave == 0 && w.vcu < 192) {
        const int l = w.vcu / 96, col = (w.vcu % 96) * 64 + w.lane;
        const float* wp = A.in[I_ADAW] + (size_t)l * DM * 6144 + col;
        float acc[8];
#pragma unroll
        for (int b = 0; b < 8; ++b) acc[b] = 0.0f;
        for (int k = 0; k < DM; ++k) { const float wv = wp[(size_t)k * 6144];
#pragma unroll
            for (int b = 0; b < 8; ++b) acc[b] += sc[b * DM + k] * wv; }
        const float bias = A.in[I_ADAB][l * 6144 + col];
#pragma unroll
        for (int b = 0; b < 8; ++b) MOD[(size_t)(l * 8 + b) * 6144 + col] = acc[b] + bias;
    }
    LAS float* scr = (LAS float*)(w.lds + 32768 + w.wave * 8448);
    constexpr int I_IN = NLAYER * 16 * 96, I_OUT = NLAYER * 16 * 32, I_W1 = NLAYER * NEXP * 16 * 64, I_W2 = NLAYER * NEXP * 16 * 32, NIT = I_IN + I_OUT + I_W1 + I_W2;
    for (int it = w.gw; it < NIT; it += w.NGW) {
        int r = it;
        if (r < I_IN) { const int l = r / 1536, rr = r % 1536, kb = rr / 96, nb = rr % 96;
            const int nd = nb * 32;
            const int ns = (nd < 1024) ? nd : (nd < 1792) ? C_SB + (nd - 1024) : (nd < 2688) ? C_RW + (nd - 1792) : C_DSA + (nd - 2688);
            const int nv = (nd < 1024) ? 1024 : (nd < 1792) ? INC : (nd < 2688) ? C_DSA : ((nd < INC) ? C_SB : 0);
            const float sc_ = (nd >= 256 && nd < 512) ? 0.125f : (nd >= 1024 && nd < 1280) ? 0.18033688011112042f : 1.0f;
            tr_item(A.in[I_WIN] + (size_t)l * DM * INC, INC, nv, kb * 64, ns, (bf16*)(A.ws + WS_WIN) + (size_t)l * INCP * DM, (size_t)nd, scr, w.lane, sc_); continue; }
        r -= I_IN;
        if (r < I_OUT) { const int l = r / 512, rr = r % 512, kb = rr / 32, nb = rr % 32;
            tr_item(A.in[I_WOUT] + (size_t)l * DM * DM, DM, DM, kb * 64, nb * 32, (bf16*)(A.ws + WS_WOUT) + (size_t)l * DM * DM, (size_t)nb * 32, scr, w.lane); continue; }
        r -= I_OUT;
        if (r < I_W1) { const int le = r / 1024, rr = r % 1024, kb = rr / 64, nb = rr % 64, j = nb >> 3, bj = (nb >> 2) & 1, cc0 = (nb & 3) * 32;
            tr_item(A.in[I_MW1] + (size_t)le * DM * 2048, 2048, 2048, kb * 64, bj * 1024 + 128 * j + cc0, (bf16*)(A.ws + WS_W1) + (size_t)le * 2048 * DM, (size_t)nb * 32, scr, w.lane); continue; }
        r -= I_W1;
        { const int le = r / 512, rr = r % 512, kb = rr / 32, nb = rr % 32;
            tr_item(A.in[I_MW2] + (size_t)le * DM * DM, DM, DM, kb * 64, nb * 32, (bf16*)(A.ws + WS_W2) + (size_t)le * DM * DM, (size_t)nb * 32, scr, w.lane); }
    }
    float* RT = (float*)(A.ws + WS_ROPE); const int* pos = (const int*)A.in[I_POS];
    for (int g = w.gw * 64 + w.lane; g < MTOK * 44; g += w.NGW * 64) {
        const int tok = g / 44, f = g % 44; int co, so;
        if (f < 32) { co = f; so = 32 + f; } else if (f < 40) { co = 64 + (f - 32); so = 72 + (f - 32); } else { co = 80 + (f - 40); so = 84 + (f - 40); }
        float s, c; sincos_d((double)pos[tok] * A.invf[f], s, c);
        RT[(size_t)tok * ROPE_W + co] = c; RT[(size_t)tok * ROPE_W + so] = s;
    }
}

__device__ __forceinline__ void emit_h_row(const f32x4 (&v)[4], float rstd, const float* g, const float* sc, const float* sh, bf16* hrow, int lane) {
#pragma unroll
    for (int j = 0; j < 4; ++j) { const int k = 4 * (lane + 64 * j);
        const f32x4 gv = *(const f32x4*)(g + k), scv = *(const f32x4*)(sc + k), shv = *(const f32x4*)(sh + k);
        const f32x4 h = v[j] * rstd * gv * (1.0f + scv) + shv;
        v2u o; o.x = pk2(h.x, h.y); o.y = pk2(h.z, h.w); *(v2u*)(hrow + k) = o; }
}
__device__ __forceinline__ void small_weights_to_f16(ARef A, const WI& w) {
    { _Float16* SW = (_Float16*)(A.ws + WS_SMALLW);
      const int g0 = w.gw * 64 + w.lane, gs = w.NGW * 64;
      for (int l = 0; l < NLAYER; ++l) { _Float16* S = SW + (size_t)l * SMW_LAYER;
          const float* wq = A.in[I_WQ] + (size_t)l * 128 * 256; const float* wqi = A.in[I_WQI] + (size_t)l * 128 * 256;
          for (int e = g0; e < 256 * 128; e += gs) { const int n = e >> 7, k = e & 127; S[SMW_QI + e] = (_Float16)wq[k * 256 + n]; S[SMW_QI + 256 * 128 + e] = (_Float16)wqi[k * 256 + n]; }
          const float* w2 = A.in[I_W2] + (size_t)l * 32 * 256; const float* a2 = A.in[I_A2] + (size_t)l * 32 * 256; const float* g2 = A.in[I_G2] + (size_t)l * 64 * 256;
          for (int e = g0; e < 256 * 32; e += gs) { const int n = e >> 5, k = e & 31; S[SMW_W2 + e] = (_Float16)w2[k * 256 + n]; S[SMW_A2 + e] = (_Float16)a2[k * 256 + n]; }
          for (int e = g0; e < 256 * 64; e += gs) { const int n = e >> 6, k = e & 63; S[SMW_G2 + e] = (_Float16)g2[k * 256 + n]; } } }
}
__device__ __forceinline__ void ph_norm1(ARef A, const WI& w) {
    const float* MOD = (const float*)(A.ws + WS_MOD); bf16* H = (bf16*)(A.ws + WS_H);
    for (int m = w.gw; m < MTOK; m += w.NGW) {
        const float* xr = A.in[I_X] + (size_t)m * DM; f32x4 v[4]; float ss = 0.0f;
#pragma unroll
        for (int j = 0; j < 4; ++j) { v[j] = *(const f32x4*)(xr + 4 * (w.lane + 64 * j)); ss += dot4(v[j], v[j]); }
        ss = wave_sum(ss); const float rstd = 1.0f / sqrtf(ss * (1.0f / DM) + 1e-5f);
        const float* mb = MOD + (size_t)(m >> 12) * 6144;
        emit_h_row(v, rstd, A.in[I_NMIX], mb + 1024, mb, H + (size_t)m * DM, w.lane);
    }
}

typedef _Float16 h4v __attribute__((ext_vector_type(4)));
__device__ __forceinline__ f16x8 pack_f16x8(f32x4 a, f32x4 b) { f16x8 r; r[0] = (_Float16)a.x; r[1] = (_Float16)a.y; r[2] = (_Float16)a.z; r[3] = (_Float16)a.w; r[4] = (_Float16)b.x; r[5] = (_Float16)b.y; r[6] = (_Float16)b.z; r[7] = (_Float16)b.w; return r; }
__device__ __forceinline__ void prep16(ARef A, int l, int m0, int lane_in) {
    int lane = lane_in; asm volatile("" : "+v"(lane));
    const int tk = lane & 15, q4 = lane >> 4, m = m0 + tk, t = m & (SEQ - 1);
    const float* P = (const float*)(A.ws + WS_PF); float* RWA = (float*)(A.ws + WS_RWA); const _Float16* SW = (const _Float16*)(A.ws + WS_SMALLW) + (size_t)l * SMW_LAYER;
    const float* pr = P + (size_t)m * PFW; const float* pp = pr - PFW; const float* pd = P + (size_t)m * PFW + PF_DSA; const float* mu = A.in[I_MU] + l * 896;
    const float* RT = (const float*)(A.ws + WS_ROPE) + (size_t)m * ROPE_W; const f32x4 zero4 = {0.f, 0.f, 0.f, 0.f};
    f16x8 bx[4], bc[4];
    { float ss = 0.0f; f32x4 c[4][2];
#pragma unroll
      for (int ks = 0; ks < 4; ++ks) { const int f0 = 32 * ks + 8 * q4;
          f32x4 x[2];
#pragma unroll
          for (int u = 0; u < 2; ++u) { const f32x4 z = *(const f32x4*)(pr + 768 + f0 + 4 * u); const f32x4 p = t ? *(const f32x4*)(pp + 768 + f0 + 4 * u) : zero4; x[u] = z + (p - z) * *(const f32x4*)(mu + 768 + f0 + 4 * u);
#pragma unroll
              for (int i = 0; i < 4; ++i) x[u][i] = (ks == 0) ? ftanh(x[u][i]) : (ks == 1) ? x[u][i] : sigm(x[u][i]); }
          bx[ks] = pack_f16x8(x[0], x[1]);
          c[ks][0] = *(const f32x4*)(pd + f0); c[ks][1] = *(const f32x4*)(pd + f0 + 4); ss += dot4(c[ks][0], c[ks][0]) + dot4(c[ks][1], c[ks][1]); }
      ss += __shfl_xor(ss, 16); ss += __shfl_xor(ss, 32);
      const float rstd = 1.0f / sqrtf(ss * (1.0f / 128.0f) + 1e-5f); const float* qn = A.in[I_QNORM] + l * 128;
#pragma unroll
      for (int ks = 0; ks < 4; ++ks) { const int f0 = 32 * ks + 8 * q4; bc[ks] = pack_f16x8(c[ks][0] * rstd * *(const f32x4*)(qn + f0), c[ks][1] * rstd * *(const f32x4*)(qn + f0 + 4)); } }
    const _Float16* wrow = SW + (size_t)tk * 0;
    (void)wrow;
    const int arow = lane & 15;
#pragma unroll 1
    for (int hd = 0; hd < 4; ++hd) {
        f32x4 fk[4], av[4]; float ssk = 0.0f;
#pragma unroll
        for (int j = 0; j < 4; ++j) { const int nb = 4 * hd + j, ch = 16 * nb + 4 * q4; const size_t o = (size_t)m * 256 + ch;
            const f16x8 aw = *(const f16x8*)(SW + SMW_W2 + (16 * nb + arow) * 32 + 8 * q4), aa = *(const f16x8*)(SW + SMW_A2 + (16 * nb + arow) * 32 + 8 * q4);
            const f16x8 ag0 = *(const f16x8*)(SW + SMW_G2 + (16 * nb + arow) * 64 + 8 * q4), ag1 = *(const f16x8*)(SW + SMW_G2 + (16 * nb + arow) * 64 + 32 + 8 * q4);
            const f32x4 cw = __builtin_amdgcn_mfma_f32_16x16x32_f16(aw, bx[0], *(const f32x4*)(A.in[I_W0] + l * 256 + ch), 0, 0, 0);
            const f32x4 ca = __builtin_amdgcn_mfma_f32_16x16x32_f16(aa, bx[1], *(const f32x4*)(A.in[I_A0] + l * 256 + ch), 0, 0, 0);
            f32x4 cg = __builtin_amdgcn_mfma_f32_16x16x32_f16(ag0, bx[2], zero4, 0, 0, 0); cg = __builtin_amdgcn_mfma_f32_16x16x32_f16(ag1, bx[3], cg, 0, 0, 0);
            f32x4 dec;
#pragma unroll
            for (int i = 0; i < 4; ++i) { dec[i] = fexp(-fexp(-softplusf(-cw[i]) - 0.5f)); av[j][i] = sigm(ca[i]); }
            *(f32x4*)(RWA + 1 * RWA_STRIDE + o) = dec; *(f32x4*)(RWA + 6 * RWA_STRIDE + o) = cg;
            { const f32x4 z = *(const f32x4*)(pr + 256 + ch); const f32x4 p = t ? *(const f32x4*)(pp + 256 + ch) : zero4; fk[j] = z + (p - z) * *(const f32x4*)(mu + 256 + ch); }
            const f32x4 kk = fk[j] * *(const f32x4*)(A.in[I_KK] + l * 256 + ch); ssk += dot4(kk, kk); }
        ssk += __shfl_xor(ssk, 16); ssk += __shfl_xor(ssk, 32);
        const float inrm = 1.0f / fmaxf(sqrtf(ssk), 1e-12f);
        f32x4 fr[4], km[4]; float bs = 0.0f;
#pragma unroll
        for (int j = 0; j < 4; ++j) { const int ch = 16 * (4 * hd + j) + 4 * q4;
            { const f32x4 z = *(const f32x4*)(pr + ch); const f32x4 p = t ? *(const f32x4*)(pp + ch) : zero4; fr[j] = z + (p - z) * *(const f32x4*)(mu + ch); }
            km[j] = fk[j] * (1.0f + (av[j] - 1.0f) * *(const f32x4*)(A.in[I_KA] + l * 256 + ch)); bs += dot4(fr[j] * km[j], *(const f32x4*)(A.in[I_RK] + l * 256 + ch)); }
        bs += __shfl_xor(bs, 16); bs += __shfl_xor(bs, 32);
#pragma unroll
        for (int j = 0; j < 4; ++j) { const int ch = 16 * (4 * hd + j) + 4 * q4; const size_t o = (size_t)m * 256 + ch;
            f32x4 fv; { const f32x4 z = *(const f32x4*)(pr + 512 + ch); const f32x4 p = t ? *(const f32x4*)(pp + 512 + ch) : zero4; fv = z + (p - z) * *(const f32x4*)(mu + 512 + ch); }
            const f32x4 kk = fk[j] * *(const f32x4*)(A.in[I_KK] + l * 256 + ch) * inrm;
            *(f32x4*)(RWA + 0 * RWA_STRIDE + o) = fr[j]; *(f32x4*)(RWA + 2 * RWA_STRIDE + o) = km[j]; *(f32x4*)(RWA + 3 * RWA_STRIDE + o) = fv;
            *(f32x4*)(RWA + 4 * RWA_STRIDE + o) = -kk; *(f32x4*)(RWA + 5 * RWA_STRIDE + o) = kk * av[j]; *(f32x4*)(RWA + 7 * RWA_STRIDE + o) = bs * fv; }
    }
#pragma unroll 1
    for (int nb = 0; nb < 32; ++nb) {
        f32x4 cq = zero4;
#pragma unroll
        for (int ks = 0; ks < 4; ++ks) { const f16x8 aq = *(const f16x8*)(SW + SMW_QI + (16 * nb + arow) * 128 + 32 * ks + 8 * q4); cq = __builtin_amdgcn_mfma_f32_16x16x32_f16(aq, bc[ks], cq, 0, 0, 0); }
        const int ch = 16 * (nb & 15) + 4 * q4;
        if (nb < 16) {
            if ((nb & 3) == 0) { const f32x4 ot = shx4(cq, 32); const int fi = 4 * (q4 & 1); const f32x4 cs4 = *(const f32x4*)(RT + 64 + fi), sn = *(const f32x4*)(RT + 72 + fi); cq = (q4 < 2) ? cq * cs4 - ot * sn : ot * sn + cq * cs4; }
            const f32x4 qs = cq * 0.18033688011112042f; v2u o; o.x = pk2(qs.x, qs.y); o.y = pk2(qs.z, qs.w); *(v2u*)((bf16*)(A.ws + WS_DQ) + (size_t)m * 256 + ch) = o;
        } else {
            if ((nb & 1) == 0) { const f32x4 ot = shx4(cq, 16); const f32x4 cs4 = *(const f32x4*)(RT + 80), sn = *(const f32x4*)(RT + 84); if (q4 < 2) cq = (q4 < 1) ? cq * cs4 - ot * sn : ot * sn + cq * cs4; }
            h4v hq; hq.x = (_Float16)cq.x; hq.y = (_Float16)cq.y; hq.z = (_Float16)cq.z; hq.w = (_Float16)cq.w; *(h4v*)((_Float16*)(A.ws + WS_DQI) + (size_t)m * 256 + ch) = hq;
        }
    }
#pragma unroll
    for (int j = 0; j < 4; ++j) { const int d = 16 * j + 4 * q4; f32x4 kx = *(const f32x4*)(pd + 128 + d);
        if (j == 0) { const f32x4 ot = shx4(kx, 32); const int fi = 4 * (q4 & 1); const f32x4 cs4 = *(const f32x4*)(RT + 64 + fi), sn = *(const f32x4*)(RT + 72 + fi); kx = (q4 < 2) ? kx * cs4 - ot * sn : ot * sn + kx * cs4; }
        v2u o; o.x = pk2(kx.x, kx.y); o.y = pk2(kx.z, kx.w); *(v2u*)((bf16*)(A.ws + WS_DKB) + (size_t)m * 64 + d) = o;
        const f32x4 vx = *(const f32x4*)(pd + 192 + d); v2u ov; ov.x = pk2(vx.x, vx.y); ov.y = pk2(vx.z, vx.w); *(v2u*)((bf16*)(A.ws + WS_DVB) + (size_t)m * 64 + d) = ov; }
#pragma unroll
    for (int j = 0; j < 2; ++j) { const int d = 16 * j + 4 * q4; f32x4 ki = *(const f32x4*)(pd + 256 + d);
        if (j == 0) { const f32x4 ot = shx4(ki, 16); const f32x4 cs4 = *(const f32x4*)(RT + 80), sn = *(const f32x4*)(RT + 84); if (q4 < 2) ki = (q4 < 1) ? ki * cs4 - ot * sn : ot * sn + ki * cs4; }
        h4v hk; hk.x = (_Float16)ki.x; hk.y = (_Float16)ki.y; hk.z = (_Float16)ki.z; hk.w = (_Float16)ki.w; *(h4v*)((_Float16*)(A.ws + WS_DKI) + (size_t)m * 32 + d) = hk; }
    if (q4 < 2) *(f32x4*)((float*)(A.ws + WS_DW) + (size_t)m * 8 + 4 * q4) = *(const f32x4*)(pd + 288 + 4 * q4) * 0.0625f;
}
__device__ __forceinline__ float quad_sum(float v) {
    v += __builtin_bit_cast(float, __builtin_amdgcn_mov_dpp(__builtin_bit_cast(int, v), 0xB1, 0xF, 0xF, true));
    v += __builtin_bit_cast(float, __builtin_amdgcn_mov_dpp(__builtin_bit_cast(int, v), 0x4E, 0xF, 0xF, true));
    return v;
}
__device__ __forceinline__ float oct_sum(float v) {
    v += __builtin_bit_cast(float, __builtin_amdgcn_mov_dpp(__builtin_bit_cast(int, v), 0xB1, 0xF, 0xF, true));
    v += __builtin_bit_cast(float, __builtin_amdgcn_mov_dpp(__builtin_bit_cast(int, v), 0x4E, 0xF, 0xF, true));
    v += __builtin_bit_cast(float, __builtin_amdgcn_mov_dpp(__builtin_bit_cast(int, v), 0x141, 0xF, 0xF, true));
    return v;
}
#define RW_LOAD(op, s_) do { const int lo_ = (s_) * 64 + kq * 8; \
    op[0] = *(const LAS f32x4*)(sn + lo_); op[1] = *(const LAS f32x4*)(sn + lo_ + 4); op[2] = *(const LAS f32x4*)(sw + lo_); op[3] = *(const LAS f32x4*)(sw + lo_ + 4); \
    op[4] = *(const LAS f32x4*)(sb + lo_); op[5] = *(const LAS f32x4*)(sb + lo_ + 4); op[6] = *(const LAS f32x4*)(sk + lo_); op[7] = *(const LAS f32x4*)(sk + lo_ + 4); \
    op[8] = *(const LAS f32x4*)(sr + lo_); op[9] = *(const LAS f32x4*)(sr + lo_ + 4); \
    _Pragma("unroll") for (int i_ = 0; i_ < 4; ++i_) vin[i_] = (ws < 2) ? sv[(s_) * 64 + rbase + 8 * i_] : 0.0f; } while (0)
#define RW_STEP(op, vv, s_) do { float sa_[4], y_[4]; \
    _Pragma("unroll") for (int i_ = 0; i_ < 4; ++i_) sa_[i_] = (S[i_][0] * op[0].x + S[i_][1] * op[0].y) + (S[i_][2] * op[0].z + S[i_][3] * op[0].w) + ((S[i_][4] * op[1].x + S[i_][5] * op[1].y) + (S[i_][6] * op[1].z + S[i_][7] * op[1].w)); \
    _Pragma("unroll") for (int i_ = 0; i_ < 4; ++i_) sa_[i_] += __builtin_bit_cast(float, __builtin_amdgcn_mov_dpp(__builtin_bit_cast(int, sa_[i_]), 0xB1, 0xF, 0xF, true)); \
    _Pragma("unroll") for (int i_ = 0; i_ < 4; ++i_) sa_[i_] += __builtin_bit_cast(float, __builtin_amdgcn_mov_dpp(__builtin_bit_cast(int, sa_[i_]), 0x4E, 0xF, 0xF, true)); \
    _Pragma("unroll") for (int i_ = 0; i_ < 4; ++i_) sa_[i_] += __builtin_bit_cast(float, __builtin_amdgcn_mov_dpp(__builtin_bit_cast(int, sa_[i_]), 0x141, 0xF, 0xF, true)); \
    _Pragma("unroll") for (int i_ = 0; i_ < 4; ++i_) { const float v_ = vv[i_]; \
        S[i_][0] = S[i_][0] * op[2].x + (sa_[i_] * op[4].x + v_ * op[6].x); S[i_][1] = S[i_][1] * op[2].y + (sa_[i_] * op[4].y + v_ * op[6].y); S[i_][2] = S[i_][2] * op[2].z + (sa_[i_] * op[4].z + v_ * op[6].z); S[i_][3] = S[i_][3] * op[2].w + (sa_[i_] * op[4].w + v_ * op[6].w); \
        S[i_][4] = S[i_][4] * op[3].x + (sa_[i_] * op[5].x + v_ * op[7].x); S[i_][5] = S[i_][5] * op[3].y + (sa_[i_] * op[5].y + v_ * op[7].y); S[i_][6] = S[i_][6] * op[3].z + (sa_[i_] * op[5].z + v_ * op[7].z); S[i_][7] = S[i_][7] * op[3].w + (sa_[i_] * op[5].w + v_ * op[7].w); } \
    _Pragma("unroll") for (int i_ = 0; i_ < 4; ++i_) y_[i_] = (S[i_][0] * op[8].x + S[i_][1] * op[8].y) + (S[i_][2] * op[8].z + S[i_][3] * op[8].w) + ((S[i_][4] * op[9].x + S[i_][5] * op[9].y) + (S[i_][6] * op[9].z + S[i_][7] * op[9].w)); \
    _Pragma("unroll") for (int i_ = 0; i_ < 4; ++i_) y_[i_] += __builtin_bit_cast(float, __builtin_amdgcn_mov_dpp(__builtin_bit_cast(int, y_[i_]), 0xB1, 0xF, 0xF, true)); \
    _Pragma("unroll") for (int i_ = 0; i_ < 4; ++i_) y_[i_] += __builtin_bit_cast(float, __builtin_amdgcn_mov_dpp(__builtin_bit_cast(int, y_[i_]), 0x4E, 0xF, 0xF, true)); \
    _Pragma("unroll") for (int i_ = 0; i_ < 4; ++i_) y_[i_] += __builtin_bit_cast(float, __builtin_amdgcn_mov_dpp(__builtin_bit_cast(int, y_[i_]), 0x141, 0xF, 0xF, true)); \
    if (kq == 0) { _Pragma("unroll") for (int i_ = 0; i_ < 4; ++i_) so[(s_) * 128 + rbase + 8 * i_] = y_[i_]; } } while (0)
__device__ __forceinline__ void scan_rwkv_task2(ARef A, const WI& w, int task0) {
    const int slot = w.wave >> 2, ws = w.wave & 3, lt = w.tid & 255, task = task0 + slot;
    const int bh = task >> 4, c = task & 15, b = bh >> 2, h = bh & 3;
    LAS float* sw = (LAS float*)w.lds + slot * 16384; LAS float* sn = sw + 2048; LAS float* sb = sn + 2048; LAS float* sk = sb + 2048; LAS float* sr = sk + 2048; LAS float* sv = sr + 2048; LAS float* so = sv + 2048;
    const float* RWA = (const float*)(A.ws + WS_RWA);
    const int rg = w.lane >> 3, kq = w.lane & 7, rbase = 32 * ws + rg;
    float S[4][8];
#pragma unroll
    for (int i = 0; i < 4; ++i)
#pragma unroll
        for (int j = 0; j < 8; ++j) { const int r = rbase + 8 * i; S[i][j] = (r >= 64 && 8 * kq + j == r - 64) ? 1.0f : 0.0f; }
    const size_t tok0 = (size_t)b * SEQ + (size_t)c * TCH;
    const int st = lt >> 3, sd = (lt & 7) * 8;
    f32x4 a[6][2];
#define RW_GLOAD(sub_) do { const size_t o_ = (tok0 + (sub_) * 32 + st) * 256 + h * 64 + sd; \
        _Pragma("unroll") for (int q = 0; q < 2; ++q) { a[0][q] = *(const f32x4*)(RWA + 1 * RWA_STRIDE + o_ + 4 * q); a[1][q] = *(const f32x4*)(RWA + 4 * RWA_STRIDE + o_ + 4 * q); a[2][q] = *(const f32x4*)(RWA + 5 * RWA_STRIDE + o_ + 4 * q); \
            a[3][q] = *(const f32x4*)(RWA + 2 * RWA_STRIDE + o_ + 4 * q); a[4][q] = *(const f32x4*)(RWA + 0 * RWA_STRIDE + o_ + 4 * q); a[5][q] = *(const f32x4*)(RWA + 3 * RWA_STRIDE + o_ + 4 * q); } } while (0)
    RW_GLOAD(0);
    for (int sub = 0; sub < TCH / 32; ++sub) {
        __syncthreads();
        { const int lo = st * 64 + sd;
#pragma unroll
          for (int q = 0; q < 2; ++q) { *(LAS f32x4*)(sw + lo + 4 * q) = a[0][q]; *(LAS f32x4*)(sn + lo + 4 * q) = a[1][q]; *(LAS f32x4*)(sb + lo + 4 * q) = a[2][q]; *(LAS f32x4*)(sk + lo + 4 * q) = a[3][q]; *(LAS f32x4*)(sr + lo + 4 * q) = a[4][q]; *(LAS f32x4*)(sv + lo + 4 * q) = a[5][q]; } }
        __syncthreads();
        if (sub + 1 < TCH / 32) RW_GLOAD(sub + 1);
        { f32x4 opA[10], opB[10]; float vin[4], vA[4], vB[4];
          RW_LOAD(opA, 0);
#pragma unroll
          for (int i = 0; i < 4; ++i) vA[i] = vin[i];
#pragma unroll 1
          for (int s = 0; s < 32; s += 2) {
              RW_LOAD(opB, s + 1);
#pragma unroll
              for (int i = 0; i < 4; ++i) vB[i] = vin[i];
              RW_STEP(opA, vA, s);
              if (s + 2 < 32) { RW_LOAD(opA, s + 2);
#pragma unroll
                  for (int i = 0; i < 4; ++i) vA[i] = vin[i]; }
              RW_STEP(opB, vB, s + 1);
          } }
        __syncthreads();
        { const int fs = lt >> 3, c16 = (lt & 7) * 16;
          float* dst = (c16 < 64) ? ((float*)(A.ws + WS_YO) + YO_STRIDE) : ((float*)(A.ws + WS_PT) - 64);
          float* dp = dst + (tok0 + sub * 32 + fs) * 256 + h * 64 + c16;
#pragma unroll
          for (int q = 0; q < 4; ++q) *(f32x4*)(dp + 4 * q) = *(const LAS f32x4*)(so + fs * 128 + c16 + 4 * q); }
    }
    { float* ch = (float*)(A.ws + WS_CH) + ((size_t)(bh * NCH + c) * 128) * 64 + 8 * kq;
#pragma unroll
      for (int i = 0; i < 4; ++i) { float* cr = ch + (size_t)(rbase + 8 * i) * 64; *(f32x4*)cr = (f32x4){S[i][0], S[i][1], S[i][2], S[i][3]}; *(f32x4*)(cr + 4) = (f32x4){S[i][4], S[i][5], S[i][6], S[i][7]}; } }
    __syncthreads();
}
#undef RW_LOAD
#undef RW_STEP
#undef RW_GLOAD
__device__ __forceinline__ void scan_ret_task(ARef A, const WI& w, int task) {
    const int bh = task >> 3, cp = task & 7, b = bh >> 2, h = bh & 3, un = w.tid >> 8, lt = w.tid & 255, c = 2 * cp + un;
    const float lg2g = log2f(1.0f - exp2f(-5.0f - (float)h)), gamma = exp2f(lg2g);
    LAS float* sk = (LAS float*)w.lds + un * 8192; LAS float* sq = sk + 2048; LAS float* sv = sq + 2048; LAS float* so = sv + 2048;
    const bf16* PB = (const bf16*)(A.ws + WS_PB); const float* RT = (const float*)(A.ws + WS_ROPE);
    const int row = lt >> 2, kq = lt & 3;
    float S[16];
#pragma unroll
    for (int j = 0; j < 16; ++j) S[j] = 0.0f;
    const size_t tok0 = (size_t)b * SEQ + (size_t)c * TCH;
    const int st = lt >> 3, sd = (lt & 7) * 8;
    const int fi = sd & 31, dp = sd ^ 32;
    f32x4 gq[2], gqo[2], gk[2], gko[2], gv[2], gcs[2], gsn[2];
#define BF8_TO_F32(dst, x_) do { dst[0] = (f32x4){bf_lo(x_.x), bf_hi(x_.x), bf_lo(x_.y), bf_hi(x_.y)}; dst[1] = (f32x4){bf_lo(x_.z), bf_hi(x_.z), bf_lo(x_.w), bf_hi(x_.w)}; } while (0)
#define RT_GLOAD(sub_) do { const size_t m_ = tok0 + (sub_) * 32 + st; const bf16* pr_ = PB + m_ * PBW + h * 64; const float* rt_ = RT + m_ * ROPE_W; \
        _Pragma("unroll") for (int u = 0; u < 2; ++u) { gcs[u] = *(const f32x4*)(rt_ + fi + 4 * u); gsn[u] = *(const f32x4*)(rt_ + 32 + fi + 4 * u); } \
        { const v4u x0 = *(const v4u*)(pr_ + sd), x1 = *(const v4u*)(pr_ + dp), x2 = *(const v4u*)(pr_ + 256 + sd), x3 = *(const v4u*)(pr_ + 256 + dp), x4 = *(const v4u*)(pr_ + 512 + sd); \
          BF8_TO_F32(gq, x0); BF8_TO_F32(gqo, x1); BF8_TO_F32(gk, x2); BF8_TO_F32(gko, x3); BF8_TO_F32(gv, x4); } } while (0)
    RT_GLOAD(0);
    for (int sub = 0; sub < TCH / 32; ++sub) {
        const size_t m = tok0 + sub * 32 + st;
        f32x4 qn[2], kn[2], vn[2];
#pragma unroll
        for (int u = 0; u < 2; ++u) { qn[u] = (sd < 32) ? gq[u] * gcs[u] - gqo[u] * gsn[u] : gqo[u] * gsn[u] + gq[u] * gcs[u]; kn[u] = (sd < 32) ? gk[u] * gcs[u] - gko[u] * gsn[u] : gko[u] * gsn[u] + gk[u] * gcs[u]; vn[u] = gv[u]; }
        { const float gt = exp2f(lg2g * (float)(sub * 32 + st + 1)); const f32x4 p0 = qn[0] * gt, p1 = qn[1] * gt;
          v4u pw; pw.x = pk2(p0.x, p0.y); pw.y = pk2(p0.z, p0.w); pw.z = pk2(p1.x, p1.y); pw.w = pk2(p1.z, p1.w); *(v4u*)((bf16*)(A.ws + WS_PTR) + m * 256 + h * 64 + sd) = pw; }
        __syncthreads();
        { const int lo = st * 64 + sd; *(LAS f32x4*)(sq + lo) = qn[0]; *(LAS f32x4*)(sq + lo + 4) = qn[1]; *(LAS f32x4*)(sk + lo) = kn[0]; *(LAS f32x4*)(sk + lo + 4) = kn[1]; *(LAS f32x4*)(sv + lo) = vn[0]; *(LAS f32x4*)(sv + lo + 4) = vn[1]; }
        __syncthreads();
        if (sub + 1 < TCH / 32) RT_GLOAD(sub + 1);
        for (int s = 0; s < 32; ++s) {
            const int lo = s * 64 + kq * 16; const float vv = sv[s * 64 + row]; float y = 0.0f;
#pragma unroll
            for (int j4 = 0; j4 < 4; ++j4) { const f32x4 kv = *(const LAS f32x4*)(sk + lo + 4 * j4), rv = *(const LAS f32x4*)(sq + lo + 4 * j4);
                S[4 * j4] = S[4 * j4] * gamma + vv * kv.x; S[4 * j4 + 1] = S[4 * j4 + 1] * gamma + vv * kv.y; S[4 * j4 + 2] = S[4 * j4 + 2] * gamma + vv * kv.z; S[4 * j4 + 3] = S[4 * j4 + 3] * gamma + vv * kv.w;
                y += (S[4 * j4] * rv.x + S[4 * j4 + 1] * rv.y) + (S[4 * j4 + 2] * rv.z + S[4 * j4 + 3] * rv.w); }
            y = quad_sum(y);
            if (kq == 0) so[s * 64 + row] = y;
        }
        __syncthreads();
        { const int fs = lt >> 3, c8 = (lt & 7) * 8; float* dp2 = (float*)(A.ws + WS_YO) + (tok0 + sub * 32 + fs) * 256 + h * 64 + c8;
          *(f32x4*)dp2 = *(const LAS f32x4*)(so + fs * 64 + c8); *(f32x4*)(dp2 + 4) = *(const LAS f32x4*)(so + fs * 64 + c8 + 4); }
    }
    { float* ch = (float*)(A.ws + WS_CHR) + ((size_t)(bh * NCH + c) * 64 + row) * 64 + 16 * kq;
#pragma unroll
      for (int j4 = 0; j4 < 4; ++j4) *(f32x4*)(ch + 4 * j4) = (f32x4){S[4 * j4], S[4 * j4 + 1], S[4 * j4 + 2], S[4 * j4 + 3]}; }
    __syncthreads();
}
#undef RT_GLOAD
#undef BF8_TO_F32
__device__ __forceinline__ void prefix_chain(ARef A, const WI& w, int bh) {
    LAS float* s0 = (LAS float*)w.lds;
    const int v = w.tid >> 3, k8 = (w.tid & 7) * 8;
    const float* CH = (const float*)(A.ws + WS_CH) + (size_t)bh * NCH * 128 * 64; float* SI = (float*)(A.ws + WS_SI) + (size_t)bh * NCH * 64 * 64;
    f32x4 c0 = {0.f, 0.f, 0.f, 0.f}, c1 = {0.f, 0.f, 0.f, 0.f};
    for (int c = 0; c < NCH; ++c) {
        *(f32x4*)(SI + ((size_t)c * 64 + v) * 64 + k8) = c0; *(f32x4*)(SI + ((size_t)c * 64 + v) * 64 + k8 + 4) = c1;
        if (c == NCH - 1) break;
        __syncthreads();
        *(LAS f32x4*)(s0 + v * 68 + k8) = c0; *(LAS f32x4*)(s0 + v * 68 + k8 + 4) = c1;
        __syncthreads();
        const float* ch = CH + (size_t)c * 128 * 64;
        f32x4 n0 = *(const f32x4*)(ch + (size_t)v * 64 + k8), n1 = *(const f32x4*)(ch + (size_t)v * 64 + k8 + 4);
#pragma unroll 8
        for (int kp = 0; kp < 64; ++kp) { const float s = s0[v * 68 + kp]; const float* pr = ch + (size_t)(64 + kp) * 64 + k8; n0 += s * *(const f32x4*)pr; n1 += s * *(const f32x4*)(pr + 4); }
        c0 = n0; c1 = n1;
    }
    const int h = bh & 3; const float gT = exp2f((float)TCH * log2f(1.0f - exp2f(-5.0f - (float)h)));
    const float* CHR = (const float*)(A.ws + WS_CHR) + (size_t)bh * NCH * 64 * 64; float* SIR = (float*)(A.ws + WS_SIR) + (size_t)bh * NCH * 64 * 64;
    c0 = (f32x4){0.f, 0.f, 0.f, 0.f}; c1 = c0;
    for (int c = 0; c < NCH; ++c) {
        *(f32x4*)(SIR + ((size_t)c * 64 + v) * 64 + k8) = c0; *(f32x4*)(SIR + ((size_t)c * 64 + v) * 64 + k8 + 4) = c1;
        if (c == NCH - 1) break;
        c0 = c0 * gT + *(const f32x4*)(CHR + ((size_t)c * 64 + v) * 64 + k8); c1 = c1 * gT + *(const f32x4*)(CHR + ((size_t)c * 64 + v) * 64 + k8 + 4);
    }
    __syncthreads();
}
typedef float f32x16 __attribute__((ext_vector_type(16)));
constexpr int SBV_PITCH = 144;
__device__ __forceinline__ float lane32_swap(float v) { return __shfl_xor(v, 32); }
__device__ __forceinline__ void sb_tile_mfma(ARef A, int unit, int lane, LAS unsigned char* vl) {
    const int tq = unit & 127, bh = unit >> 7, b = bh >> 2, h = bh & 3, t0 = tq * 32, r32 = lane & 31, hi = lane >> 5;
    const bf16* PS = (const bf16*)(A.ws + WS_PB) + (size_t)b * SEQ * PBW + PB_SB + h * 64;
    bf16x8v qf[4];
#pragma unroll
    for (int ks = 0; ks < 4; ++ks) qf[ks] = *(const bf16x8v*)(PS + (size_t)(t0 + r32) * PBW + 16 * ks + 8 * hi);
    f32x16 o0, o1;
#pragma unroll
    for (int r = 0; r < 16; ++r) { o0[r] = 0.0f; o1[r] = 0.0f; }
    float carry = 0.0f;
    const int g16 = lane >> 4, tj = (lane & 15) >> 2, tc = lane & 3;
    for (int kb0 = t0; kb0 >= 0; kb0 -= 32) {
#pragma unroll
        for (int i = 0; i < 4; ++i) { const int p = lane + 64 * i, row = p >> 3, ch = p & 7; const v4u v = *(const v4u*)(PS + 512 + (size_t)(kb0 + row) * PBW + 8 * ch); *(LAS v4u*)(vl + row * SBV_PITCH + 16 * ch) = v; }
        f32x16 st;
#pragma unroll
        for (int r = 0; r < 16; ++r) st[r] = 0.0f;
        { bf16x8v ka[4];
#pragma unroll
          for (int ks = 0; ks < 4; ++ks) ka[ks] = *(const bf16x8v*)(PS + 256 + (size_t)(kb0 + r32) * PBW + 16 * ks + 8 * hi);
#pragma unroll
          for (int ks = 0; ks < 4; ++ks) st = __builtin_amdgcn_mfma_f32_32x32x16_bf16(ka[ks], qf[ks], st, 0, 0, 0);
          asm volatile("" :: "v"(ka[0]), "v"(ka[1]), "v"(ka[2]), "v"(ka[3]), "v"(st)); }
        float sp[16]; const bool diag = (kb0 == t0);
#pragma unroll
        for (int r = 0; r < 16; ++r) { const float zl = st[r]; float s = (zl > 30.0f) ? zl : __builtin_amdgcn_logf(1.0f + __builtin_amdgcn_exp2f(zl));
            if (diag && ((r & 3) + 8 * (r >> 2) + 4 * hi >= r32)) s = 0.0f;
            sp[r] = s; }
        float G[4], Gp[4], suf[4];
#pragma unroll
        for (int q = 0; q < 4; ++q) { G[q] = (sp[4 * q] + sp[4 * q + 1]) + (sp[4 * q + 2] + sp[4 * q + 3]); Gp[q] = lane32_swap(G[q]); }
        suf[3] = 0.0f; suf[2] = G[3] + Gp[3]; suf[1] = suf[2] + (G[2] + Gp[2]); suf[0] = suf[1] + (G[1] + Gp[1]);
        const float tot = suf[0] + (G[0] + Gp[0]);
        pg8::u32x4 pw0, pw1;
        float av[16];
#pragma unroll
        for (int q = 0; q < 4; ++q) { float run = carry + suf[q] + (hi == 0 ? Gp[q] : 0.0f);
#pragma unroll
            for (int i = 3; i >= 0; --i) { const int r = 4 * q + i; const float la = (st[r] - sp[r]) - run; float a = __builtin_amdgcn_exp2f(la);
                if (diag && ((r & 3) + 8 * (r >> 2) + 4 * hi >= r32)) a = 0.0f;
                av[r] = a; run += sp[r]; } }
        pw0.x = pg8::cvt_pk_bf16(av[0], av[1]); pw0.y = pg8::cvt_pk_bf16(av[2], av[3]); pw0.z = pg8::cvt_pk_bf16(av[4], av[5]); pw0.w = pg8::cvt_pk_bf16(av[6], av[7]);
        pw1.x = pg8::cvt_pk_bf16(av[8], av[9]); pw1.y = pg8::cvt_pk_bf16(av[10], av[11]); pw1.z = pg8::cvt_pk_bf16(av[12], av[13]); pw1.w = pg8::cvt_pk_bf16(av[14], av[15]);
        const bf16x8v pa0 = __builtin_bit_cast(bf16x8v, pw0), pa1 = __builtin_bit_cast(bf16x8v, pw1);
        LDS_WAIT();
#pragma unroll
        for (int s = 0; s < 2; ++s)
#pragma unroll
            for (int nb = 0; nb < 2; ++nb) {
                LAS unsigned char* a1 = vl + (16 * s + 4 * (g16 >> 1) + tj) * SBV_PITCH + (32 * nb + 16 * (g16 & 1) + 4 * tc) * 2;
                const s16x4v r1 = __builtin_bit_cast(s16x4v, __builtin_amdgcn_ds_read_tr16_b64_v4i16((LAS s16x4v*)a1));
                const s16x4v r2 = __builtin_bit_cast(s16x4v, __builtin_amdgcn_ds_read_tr16_b64_v4i16((LAS s16x4v*)(a1 + 8 * SBV_PITCH)));
                const bf16x8v bv = {r1[0], r1[1], r1[2], r1[3], r2[0], r2[1], r2[2], r2[3]};
                if (nb == 0) o0 = __builtin_amdgcn_mfma_f32_32x32x16_bf16(s ? pa1 : pa0, bv, o0, 0, 0, 0); else o1 = __builtin_amdgcn_mfma_f32_32x32x16_bf16(s ? pa1 : pa0, bv, o1, 0, 0, 0);
                asm volatile("" :: "v"(bv), "v"(pa0), "v"(pa1), "v"(o0), "v"(o1)); }
        LDS_WAIT();
        carry += tot;
        if (__all(carry > 150.0f)) break;
    }
    float* YS = (float*)(A.ws + WS_YO) + 3 * YO_STRIDE + ((size_t)b * SEQ + t0) * 256 + h * 64 + r32;
#pragma unroll
    for (int r = 0; r < 16; ++r) { const int qo = (r & 3) + 8 * (r >> 2) + 4 * hi; YS[(size_t)qo * 256] = o0[r]; YS[(size_t)qo * 256 + 32] = o1[r]; }
}

__device__ __forceinline__ void dsa_scores_mfma(ARef A, const WI& w) {
    const _Float16* QIH = (const _Float16*)(A.ws + WS_DQI); const _Float16* KIH = (const _Float16*)(A.ws + WS_DKI);
    const float* DW = (const float*)(A.ws + WS_DW); float* SC = (float*)(A.ws + WS_SC);
    const int col = w.lane & 15, q4 = w.lane >> 4;
    for (int u = w.gw; u < 2048; u += w.NGW) {
        const int pi = u >> 1, par = u & 1, b = pi >> 7, p = pi & 127;
#pragma unroll 1
        for (int side = 0; side < 2; ++side) {
            const int qb = side ? 255 - p : p; const size_t m0 = (size_t)b * SEQ + 16 * qb;
            f16x8 bq[8];
#pragma unroll
            for (int h = 0; h < 8; ++h) bq[h] = *(const f16x8*)(QIH + (m0 + col) * 256 + h * 32 + 8 * q4);
            const float* dw = DW + (m0 + col) * 8; const f32x4 wa = *(const f32x4*)dw, wb = *(const f32x4*)(dw + 4);
            float* srow = SC + (m0 + col) * SEQ + 4 * q4;
            const _Float16* kbase = KIH + ((size_t)b * SEQ + col) * 32 + 8 * q4;
            for (int kp = par; 2 * kp <= qb; kp += 2) {
#pragma unroll
                for (int sub = 0; sub < 2; ++sub) { const int kb = 2 * kp + sub; if (kb > qb) break;
                    const f16x8 ak = *(const f16x8*)(kbase + (size_t)kb * 16 * 32);
                    f32x4 acc = {0.f, 0.f, 0.f, 0.f};
#pragma unroll
                    for (int h = 0; h < 8; ++h) { const f32x4 c = __builtin_amdgcn_mfma_f32_16x16x32_f16(ak, bq[h], (f32x4){0.f, 0.f, 0.f, 0.f}, 0, 0, 0); const float wv = (h < 4) ? wa[h] : wb[h - 4];
                        acc.x += wv * fmaxf(c.x, 0.f); acc.y += wv * fmaxf(c.y, 0.f); acc.z += wv * fmaxf(c.z, 0.f); acc.w += wv * fmaxf(c.w, 0.f); }
                    *(f32x4*)(srow + 16 * kb) = acc + 0.0f; }
            }
        }
    }
}

__device__ __forceinline__ int wave_total_i(int v) {
    v += __builtin_amdgcn_mov_dpp(v, 0xB1, 0xF, 0xF, true);
    v += __builtin_amdgcn_mov_dpp(v, 0x4E, 0xF, 0xF, true);
    v += __builtin_amdgcn_mov_dpp(v, 0x141, 0xF, 0xF, true);
    v += __builtin_amdgcn_mov_dpp(v, 0x140, 0xF, 0xF, true);
    return __builtin_amdgcn_readlane(v, 0) + __builtin_amdgcn_readlane(v, 16) + __builtin_amdgcn_readlane(v, 32) + __builtin_amdgcn_readlane(v, 48);
}
__device__ __forceinline__ unsigned score_key(float f) { const unsigned bits = __float_as_uint(f); return (bits & 0x80000000u) ? ~bits : (bits | 0x80000000u); }
constexpr int VST_PITCH = 144;
typedef unsigned short u16;
__device__ __forceinline__ void dsa_load_scores(ARef A, int m, int lane, f32x4 (&sv)[16]) {
    const int n = (m & (SEQ - 1)) + 1; const float* sc = (const float*)(A.ws + WS_SC) + (size_t)m * SEQ;
#pragma unroll
    for (int j4 = 0; j4 < 16; ++j4) sv[j4] = *(const f32x4*)(sc + ((256 * j4 < n) ? 256 * j4 : 0) + 4 * lane);
}
__device__ __forceinline__ void dsa_select(ARef A, int m, int n, int lane_in, LAS u16* slist, LAS unsigned* bk) {
    int lane = lane_in; asm volatile("" : "+v"(lane));
    if (n <= 256) {
#pragma unroll
        for (int c = 0; c < 4; ++c) { const int idx = lane + 64 * c; slist[idx] = (u16)((idx < n) ? idx : 0); }
        return;
    }
    f32x4 sv[16]; dsa_load_scores(A, m, lane, sv);
    unsigned u[64];
#pragma unroll
    for (int j4 = 0; j4 < 16; ++j4)
#pragma unroll
        for (int i = 0; i < 4; ++i) u[4 * j4 + i] = (256 * j4 + 4 * lane + i < n) ? score_key(sv[j4][i]) : 0u;
    unsigned T = 0u;
    for (int bit = 31; bit >= 16; --bit) { const unsigned cand = T | (1u << bit); int cnt = 0;
#pragma unroll
        for (int j = 0; j < 64; ++j) cnt += (u[j] >= cand) ? 1 : 0;
        if (wave_total_i(cnt) >= 256) T = cand; }
    unsigned long long bkb = 0ull; int chi = 0;
#pragma unroll
    for (int j = 0; j < 64; ++j) { bkb |= (unsigned long long)(((u[j] >> 16) == (T >> 16)) ? 1u : 0u) << j; chi += ((u[j] >> 16) > (T >> 16)) ? 1 : 0; }
    const int cb = wave_total_i(__popcll(bkb)), need = 256 - wave_total_i(chi);
    if (cb <= 64) {
        int pos = __popcll(bkb);
        { const int mine_ = pos;
#pragma unroll
          for (int d = 1; d < 64; d <<= 1) { const int y = __shfl_up(pos, d); if (lane >= d) pos += y; }
          pos -= mine_; }
#pragma unroll
        for (int j = 0; j < 64; ++j) { if ((bkb >> j) & 1ull) { bk[pos] = u[j]; ++pos; } }
        LDS_WAIT();
        const unsigned kx = (lane < cb) ? bk[lane] : 0u;
        for (int bit = 15; bit >= 0; --bit) { const unsigned cand = T | (1u << bit); if (__popcll(__ballot(kx >= cand)) >= need) T = cand; }
        LDS_WAIT();
    } else {
        for (int bit = 15; bit >= 0; --bit) { const unsigned cand = T | (1u << bit); int cnt = 0;
#pragma unroll
            for (int j = 0; j < 64; ++j) cnt += (u[j] >= cand) ? 1 : 0;
            if (wave_total_i(cnt) >= 256) T = cand; }
    }
    unsigned long long gtb = 0ull, eqb = 0ull;
#pragma unroll
    for (int j = 0; j < 64; ++j) { gtb |= (unsigned long long)((u[j] > T) ? 1u : 0u) << j; eqb |= (unsigned long long)((u[j] == T) ? 1u : 0u) << j; }
    const int tgt = wave_total_i(__popcll(gtb)), teq = wave_total_i(__popcll(eqb));
    unsigned long long selb = gtb | eqb;
    if (tgt + teq > 256) {
        const int take = 256 - tgt; int lo = 0;
        for (int bit = 11; bit >= 0; --bit) { const int cand = lo | (1 << bit); const int J4 = cand >> 8; int ni = (cand & 255) - 4 * lane; ni = ni < 0 ? 0 : (ni > 4 ? 4 : ni);
            const int jc = 4 * J4 + ni; const unsigned long long msk = (jc >= 64) ? ~0ull : ((1ull << jc) - 1ull);
            if (wave_total_i(__popcll(eqb & msk)) < take) lo = cand; }
        { const int cand = lo + 1; const int J4 = cand >> 8; int ni = (cand & 255) - 4 * lane; ni = ni < 0 ? 0 : (ni > 4 ? 4 : ni);
          const int jc = (cand >= SEQ) ? 64 : 4 * J4 + ni; const unsigned long long msk = (jc >= 64) ? ~0ull : ((1ull << jc) - 1ull); selb = gtb | (eqb & msk); }
    }
    const int mine = __popcll(selb); int off = mine;
#pragma unroll
    for (int d = 1; d < 64; d <<= 1) { const int y = __shfl_up(off, d); if (lane >= d) off += y; }
    off -= mine;
    while (selb) { const int j = __builtin_ctzll(selb); selb &= selb - 1ull; slist[off] = (u16)(256 * (j >> 2) + 4 * lane + (j & 3)); ++off; }
}
__device__ __forceinline__ void dsa_attend(ARef A, int m, int lane_in, const LAS u16* slist, LAS unsigned char* vbuf) {
    int lane = lane_in; asm volatile("" : "+v"(lane));
    const int b = m >> 12, t = m & (SEQ - 1), n = t + 1, nsel = n < 256 ? n : 256, col = lane & 15, q4 = lane >> 4;
    const bf16* DKB = (const bf16*)(A.ws + WS_DKB) + (size_t)b * SEQ * 64; const bf16* DVB = (const bf16*)(A.ws + WS_DVB) + (size_t)b * SEQ * 64;
    const int vrow = lane >> 3, vpc = lane & 7;
    bf16x8v bq0 = {0, 0, 0, 0, 0, 0, 0, 0}, bq1 = {0, 0, 0, 0, 0, 0, 0, 0};
    if (col < 4) { const bf16* qp = (const bf16*)(A.ws + WS_DQ) + (size_t)m * 256 + col * 64 + 8 * q4; bq0 = *(const bf16x8v*)qp; bq1 = *(const bf16x8v*)(qp + 32); }
    f32x4 lg[16];
#pragma unroll
    for (int hb = 0; hb < 2; ++hb) {
        bf16x8v a0[8], a1[8];
#pragma unroll
        for (int k = 0; k < 8; ++k) { const int s = slist[16 * (8 * hb + k) + col]; const bf16* kr = DKB + (size_t)s * 64 + 8 * q4; a0[k] = *(const bf16x8v*)kr; a1[k] = *(const bf16x8v*)(kr + 32); }
#pragma unroll
        for (int k = 0; k < 8; ++k) { const f32x4 c = __builtin_amdgcn_mfma_f32_16x16x32_bf16(a0[k], bq0, (f32x4){0.f, 0.f, 0.f, 0.f}, 0, 0, 0); lg[8 * hb + k] = __builtin_amdgcn_mfma_f32_16x16x32_bf16(a1[k], bq1, c, 0, 0, 0); }
        __builtin_amdgcn_sched_barrier(0);
    }
    if (nsel < 256) {
#pragma unroll
        for (int kb = 0; kb < 16; ++kb)
#pragma unroll
            for (int r = 0; r < 4; ++r) if (16 * kb + 4 * q4 + r >= nsel) lg[kb][r] = -INFINITY; }
    v4u vr[4];
#pragma unroll
    for (int i = 0; i < 4; ++i) { const int s = slist[vrow + 8 * i]; vr[i] = *(const v4u*)(DVB + (size_t)s * 64 + 8 * vpc); }
    float mx = -INFINITY;
#pragma unroll
    for (int kb = 0; kb < 16; ++kb) mx = fmaxf(fmaxf(mx, fmaxf(lg[kb].x, lg[kb].y)), fmaxf(lg[kb].z, lg[kb].w));
    mx = fmaxf(mx, __shfl_xor(mx, 16)); mx = fmaxf(mx, __shfl_xor(mx, 32));
    float sm = 0.f;
#pragma unroll
    for (int kb = 0; kb < 16; ++kb) { lg[kb].x = __builtin_amdgcn_exp2f(lg[kb].x - mx); lg[kb].y = __builtin_amdgcn_exp2f(lg[kb].y - mx); lg[kb].z = __builtin_amdgcn_exp2f(lg[kb].z - mx); lg[kb].w = __builtin_amdgcn_exp2f(lg[kb].w - mx); sm += (lg[kb].x + lg[kb].y) + (lg[kb].z + lg[kb].w); }
    sm += __shfl_xor(sm, 16); sm += __shfl_xor(sm, 32);
    const float inv = 1.0f / sm;
    bf16x8v pa[8];
#pragma unroll
    for (int i = 0; i < 8; ++i) { const f32x4 x = lg[2 * i] * inv, y = lg[2 * i + 1] * inv;
        pg8::u32x4 wv; wv.x = pg8::cvt_pk_bf16(x.x, x.y); wv.y = pg8::cvt_pk_bf16(x.z, x.w); wv.z = pg8::cvt_pk_bf16(y.x, y.y); wv.w = pg8::cvt_pk_bf16(y.z, y.w);
        pa[i] = __builtin_bit_cast(bf16x8v, wv); }
    f32x4 o[4];
#pragma unroll
    for (int nb = 0; nb < 4; ++nb) o[nb] = (f32x4){0.f, 0.f, 0.f, 0.f};
    const int tj = col >> 2, tc = col & 3;
#pragma unroll
    for (int c = 0; c < 8; ++c) {
        LAS unsigned char* vb = vbuf + (c & 1) * (32 * VST_PITCH);
#pragma unroll
        for (int i = 0; i < 4; ++i) *(LAS v4u*)(vb + (vrow + 8 * i) * VST_PITCH + 16 * vpc) = vr[i];
        if (c < 7) {
#pragma unroll
            for (int i = 0; i < 4; ++i) { const int s = slist[32 * (c + 1) + vrow + 8 * i]; vr[i] = *(const v4u*)(DVB + (size_t)s * 64 + 8 * vpc); } }
        LDS_WAIT();
#pragma unroll
        for (int nb = 0; nb < 4; ++nb) {
            LAS unsigned char* a1 = vb + (4 * q4 + tj) * VST_PITCH + (16 * nb + 4 * tc) * 2;
            const s16x4v r1 = __builtin_bit_cast(s16x4v, __builtin_amdgcn_ds_read_tr16_b64_v4i16((LAS s16x4v*)a1));
            const s16x4v r2 = __builtin_bit_cast(s16x4v, __builtin_amdgcn_ds_read_tr16_b64_v4i16((LAS s16x4v*)(a1 + 16 * VST_PITCH)));
            const bf16x8v bv = {r1[0], r1[1], r1[2], r1[3], r2[0], r2[1], r2[2], r2[3]};
            o[nb] = __builtin_amdgcn_mfma_f32_16x16x32_bf16(pa[c], bv, o[nb], 0, 0, 0); }
    }
    LDS_WAIT();
    if (lane < 16) { float* YD = (float*)(A.ws + WS_YO) + 2 * YO_STRIDE + (size_t)m * 256;
#pragma unroll
        for (int nb = 0; nb < 4; ++nb) { YD[16 * nb + lane] = o[nb].x; YD[64 + 16 * nb + lane] = o[nb].y; YD[128 + 16 * nb + lane] = o[nb].z; YD[192 + 16 * nb + lane] = o[nb].w; } }
}
__device__ __forceinline__ int dsa_row_of(int i) { return (i & 1) ? (MTOK - 1 - (i >> 1)) : (i >> 1); }
__device__ __forceinline__ void dsa_wave(ARef A, const WI& w, LAS unsigned char* wl, int qi) {
    LAS u16* lists = (LAS u16*)wl; LAS unsigned char* vbuf = wl + 4096; LAS unsigned* bk = (LAS unsigned*)vbuf;
    unsigned* head = (unsigned*)(A.ws + WS_CTL) + CW_DSAQ + 16 * qi;
    for (;;) {
        int g = 0; if (w.lane == 0) g = (int)atomicAdd(head, 1u);
        g = __builtin_amdgcn_readfirstlane(g);
        if (g >= MTOK / 8) break;
#pragma unroll 1
        for (int r = 0; r < 8; ++r) { const int m = dsa_row_of(g + r * (MTOK / 8)), n = (m & (SEQ - 1)) + 1; dsa_select(A, m, n, w.lane, lists + r * 256, bk); }
        LDS_WAIT();
#pragma unroll 1
        for (int r = 0; r < 8; ++r) dsa_attend(A, dsa_row_of(g + r * (MTOK / 8)), w.lane, lists + r * 256, vbuf);
    }
}

__device__ __forceinline__ f32x4 head_norm4(f32x4 y, float eps, f32x4 g) {
    const float mean = grp16_sum(sum4(y)) * (1.0f / 64.0f); const f32x4 yc = y - mean;
    const float var = grp16_sum(dot4(yc, yc)) * (1.0f / 64.0f); return yc * (1.0f / sqrtf(var + eps)) * g;
}
template <bool BF> __device__ __forceinline__ f32x4 state_corr(const LAS float* sl, int hh, int r16, const void* pv) {
    const LAS float* r0 = sl + (hh * 64 + 4 * r16) * 64; const int x0 = (4 * r16) & 15;
    f32x4 out = {0.f, 0.f, 0.f, 0.f};
#pragma unroll 2
    for (int k8 = 0; k8 < 8; ++k8) {
        f32x4 pa, pb;
        if (BF) { const v4u x = ((const v4u*)pv)[k8]; pa = (f32x4){bf_lo(x.x), bf_hi(x.x), bf_lo(x.y), bf_hi(x.y)}; pb = (f32x4){bf_lo(x.z), bf_hi(x.z), bf_lo(x.w), bf_hi(x.w)}; }
        else { pa = ((const f32x4*)pv)[2 * k8]; pb = ((const f32x4*)pv)[2 * k8 + 1]; }
#pragma unroll
        for (int i = 0; i < 4; ++i) { const LAS float* rowp = r0 + i * 64; const int xs = (x0 + i) & 15;
            out[i] += dot4(*(const LAS f32x4*)(rowp + 4 * ((2 * k8) ^ xs)), pa) + dot4(*(const LAS f32x4*)(rowp + 4 * ((2 * k8 + 1) ^ xs)), pb); }
    }
    return out;
}
__device__ __forceinline__ void post_row(ARef A, int l, int m, int lane, const LAS float* slw, const LAS float* slr) {
    const float* YO = (const float*)(A.ws + WS_YO); const float* RWA = (const float*)(A.ws + WS_RWA);
    bf16* MX = (bf16*)(A.ws + WS_MIX) + (size_t)m * DM; const int c4 = 4 * lane, hh = lane >> 4, r16 = lane & 15; const size_t o = (size_t)m * 256 + c4;
    { f32x4 y = *(const f32x4*)(YO + o) + state_corr<true>(slr, hh, r16, (const bf16*)(A.ws + WS_PTR) + (size_t)m * 256 + hh * 64);
      y = head_norm4(y, 1e-5f, *(const f32x4*)(A.in[I_RETGN] + l * 256 + c4));
      const v2u gw_ = *(const v2u*)((const bf16*)(A.ws + WS_PB) + (size_t)m * PBW + 768 + c4); const f32x4 g = {bf_lo(gw_.x), bf_hi(gw_.x), bf_lo(gw_.y), bf_hi(gw_.y)};
#pragma unroll
      for (int i = 0; i < 4; ++i) y[i] *= g[i] * sigm(g[i]);
      v2u w; w.x = pk2(y.x, y.y); w.y = pk2(y.z, y.w); *(v2u*)(MX + c4) = w; }
    { f32x4 y = *(const f32x4*)(YO + YO_STRIDE + o) + state_corr<false>(slw, hh, r16, (const float*)(A.ws + WS_PT) + (size_t)m * 256 + hh * 64);
      y = head_norm4(y, 64e-5f, *(const f32x4*)(A.in[I_LN] + l * 256 + c4));
      y = (y + *(const f32x4*)(RWA + 7 * RWA_STRIDE + o)) * *(const f32x4*)(RWA + 6 * RWA_STRIDE + o);
      v2u w; w.x = pk2(y.x, y.y); w.y = pk2(y.z, y.w); *(v2u*)(MX + 256 + c4) = w; }
    { f32x4 y = *(const f32x4*)(YO + 2 * YO_STRIDE + o); const float r = 1.0f / sqrtf(wave_sum(dot4(y, y)) * (1.0f / 256.0f) + 1e-5f);
      y = y * r * *(const f32x4*)(A.in[I_DONORM] + l * 256 + c4);
      v2u w; w.x = pk2(y.x, y.y); w.y = pk2(y.z, y.w); *(v2u*)(MX + 512 + c4) = w; }
    { f32x4 y = *(const f32x4*)(YO + 3 * YO_STRIDE + o); const float r = 1.0f / sqrtf(wave_sum(dot4(y, y)) * (1.0f / 256.0f) + 1e-5f);
      y = y * r * *(const f32x4*)(A.in[I_SONORM] + l * 256 + c4);
      v2u w; w.x = pk2(y.x, y.y); w.y = pk2(y.z, y.w); *(v2u*)(MX + 768 + c4) = w; }
}
__device__ __forceinline__ void ph_post(ARef A, const WI& w, int l) {
    LAS float* slw = (LAS float*)w.lds; LAS float* slr = slw + 16384;
    for (int u = w.vcu; u < NB * NCH * 2; u += w.G) {
        const int b = u >> 5, c = (u >> 1) & 15, half = u & 1;
        __syncthreads();
        for (int e = w.tid; e < 4096; e += NWAVES * 64) { const int hh = e >> 10, v = (e >> 4) & 63, k4 = e & 15;
            const size_t src = ((size_t)((b * 4 + hh) * NCH + c) * 64 + v) * 64 + 4 * k4; const int dst = (hh * 64 + v) * 64 + 4 * (k4 ^ (v & 15));
            *(LAS f32x4*)(slw + dst) = *(const f32x4*)((const float*)(A.ws + WS_SI) + src); *(LAS f32x4*)(slr + dst) = *(const f32x4*)((const float*)(A.ws + WS_SIR) + src); }
        __syncthreads();
        const int tok0 = b * SEQ + c * TCH + half * 128 + w.wave * 16;
        for (int i = 0; i < 16; ++i) post_row(A, l, tok0 + i, w.lane, slw, slr);
    }
}

__device__ __forceinline__ float wave_max_f(float v) {
    v = fmaxf(v, __builtin_bit_cast(float, __builtin_amdgcn_mov_dpp(__builtin_bit_cast(int, v), 0xB1, 0xF, 0xF, true)));
    v = fmaxf(v, __builtin_bit_cast(float, __builtin_amdgcn_mov_dpp(__builtin_bit_cast(int, v), 0x4E, 0xF, 0xF, true)));
    v = fmaxf(v, __builtin_bit_cast(float, __builtin_amdgcn_mov_dpp(__builtin_bit_cast(int, v), 0x141, 0xF, 0xF, true)));
    v = fmaxf(v, __builtin_bit_cast(float, __builtin_amdgcn_mov_dpp(__builtin_bit_cast(int, v), 0x140, 0xF, 0xF, true)));
    const int iv = __builtin_bit_cast(int, v);
    return fmaxf(fmaxf(__builtin_bit_cast(float, __builtin_amdgcn_readlane(iv, 0)), __builtin_bit_cast(float, __builtin_amdgcn_readlane(iv, 16))), fmaxf(__builtin_bit_cast(float, __builtin_amdgcn_readlane(iv, 32)), __builtin_bit_cast(float, __builtin_amdgcn_readlane(iv, 48))));
}
__device__ __forceinline__ void router_stage(ARef A, const WI& w, int l) {
    LAS float* rwl = (LAS float*)w.lds; const float* rw = A.in[I_RW] + (size_t)l * DM * 32;
    for (int e = w.tid; e < DM * 8; e += NWAVES * 64) { const int k = e >> 3, c = e & 7; *(LAS f32x4*)(rwl + k * 32 + 4 * (c ^ ((k >> 2) & 7))) = *(const f32x4*)(rw + (size_t)k * 32 + 4 * c); }
    __syncthreads();
}
__device__ __forceinline__ void router_row(ARef A, int l, int m, int lane, LAS unsigned* hist, const LAS float* rwl, LAS int* texp, bool dry = false) {
    const float* XA = (const float*)(A.ws + WS_XA) + (size_t)m * DM; const float* MOD = (const float*)(A.ws + WS_MOD) + (size_t)(l * 8 + (m >> 12)) * 6144;
    f32x4 v[4]; float ss = 0.0f;
#pragma unroll
    for (int j = 0; j < 4; ++j) { v[j] = *(const f32x4*)(XA + 4 * (lane + 64 * j)); ss += dot4(v[j], v[j]); }
    ss = wave_sum(ss); const float rstd = 1.0f / sqrtf(ss * (1.0f / DM) + 1e-5f);
    const float* g = A.in[I_NFFN] + l * DM; const float* scp = MOD + 4 * 1024; const float* shp = MOD + 3 * 1024;
    emit_h_row(v, rstd, g, scp, shp, (bf16*)(A.ws + WS_H) + (size_t)m * DM, lane);
    float p[32];
#pragma unroll
    for (int e = 0; e < 32; ++e) p[e] = 0.0f;
    const int sw = lane & 7;
#pragma unroll 1
    for (int j = 0; j < 4; ++j) { const int k = 4 * (lane + 64 * j);
        const f32x4 h = *(const f32x4*)(XA + k) * rstd * *(const f32x4*)(g + k) * (1.0f + *(const f32x4*)(scp + k)) + *(const f32x4*)(shp + k);
        const LAS float* row = rwl + k * 32;
#pragma unroll
        for (int i = 0; i < 4; ++i) {
#pragma unroll
            for (int q4 = 0; q4 < 8; ++q4) { const f32x4 r = *(const LAS f32x4*)(row + i * 32 + 4 * (q4 ^ sw)); p[4 * q4] += h[i] * r.x; p[4 * q4 + 1] += h[i] * r.y; p[4 * q4 + 2] += h[i] * r.z; p[4 * q4 + 3] += h[i] * r.w; } } }
    float q16[16], q8[8], q4v[4], q2[2], q1;
    { const bool hb = (lane & 32) != 0;
#pragma unroll
      for (int i = 0; i < 16; ++i) { const float mine = hb ? p[16 + i] : p[i], oth = hb ? p[i] : p[16 + i]; q16[i] = mine + __shfl_xor(oth, 32); } }
    { const bool hb = (lane & 16) != 0;
#pragma unroll
      for (int i = 0; i < 8; ++i) { const float mine = hb ? q16[8 + i] : q16[i], oth = hb ? q16[i] : q16[8 + i]; q8[i] = mine + __shfl_xor(oth, 16); } }
    { const bool hb = (lane & 8) != 0;
#pragma unroll
      for (int i = 0; i < 4; ++i) { const float mine = hb ? q8[4 + i] : q8[i], oth = hb ? q8[i] : q8[4 + i]; q4v[i] = mine + __shfl_xor(oth, 8); } }
    { const bool hb = (lane & 4) != 0;
#pragma unroll
      for (int i = 0; i < 2; ++i) { const float mine = hb ? q4v[2 + i] : q4v[i], oth = hb ? q4v[i] : q4v[2 + i]; q2[i] = mine + __shfl_xor(oth, 4); } }
    { const bool hb = (lane & 2) != 0; const float mine = hb ? q2[1] : q2[0], oth = hb ? q2[0] : q2[1]; q1 = mine + __shfl_xor(oth, 2); }
    q1 += __shfl_xor(q1, 1);
    float lv = q1 + A.in[I_RB][l * 32 + (lane >> 1)];
    float tv[4]; int ti[4];
#pragma unroll
    for (int kk = 0; kk < 4; ++kk) { const float mx = wave_max_f(lv); const unsigned long long msk = __ballot(lv == mx); const int e = msk ? (int)(__builtin_ctzll(msk) >> 1) : kk;
        tv[kk] = mx; ti[kk] = e; if ((lane >> 1) == e) lv = -INFINITY; }
    const float e1 = expf(tv[1] - tv[0]), e2 = expf(tv[2] - tv[0]), e3 = expf(tv[3] - tv[0]); const float inv = 1.0f / (1.0f + e1 + e2 + e3);
    if (lane == 0 && !dry) {
        int* TI = (int*)(A.ws + WS_TOPI) + (size_t)m * 4; float* TW = (float*)(A.ws + WS_TOPW) + (size_t)m * 4;
        TI[0] = ti[0]; TI[1] = ti[1]; TI[2] = ti[2]; TI[3] = ti[3]; texp[0] = ti[0]; texp[1] = ti[1]; texp[2] = ti[2]; texp[3] = ti[3]; TW[0] = inv; TW[1] = e1 * inv; TW[2] = e2 * inv; TW[3] = e3 * inv;
        { unsigned* hg = (unsigned*)hist; atomicAdd(hg + ti[0], 1u); atomicAdd(hg + ti[1], 1u); atomicAdd(hg + ti[2], 1u); atomicAdd(hg + ti[3], 1u); }
    }
}
__device__ __forceinline__ void build_expert_table(ARef A, const WI& w, int l) {
    LAS int* tst = (LAS int*)(w.lds + TST_OFF); LAS int* tab = (LAS int*)(w.lds + TAB_OFF); LAS int* cnt = (LAS int*)(w.lds + CNT_OFF);
    if (w.tid == 0) { const unsigned* gc = (const unsigned*)(A.ws + WS_CTL) + CW_GCNT + 64 * l; int acc = 0;
        for (int e = 0; e < 32; ++e) { const int c = (int)__hip_atomic_load(gc + e, RLX_AGENT); cnt[e] = c; tst[e] = acc; acc += (c + 255) >> 8; }
        tst[32] = acc; tab[0] = acc; }
    __syncthreads();
    if (w.tid < 32) { const int e = w.tid; for (int pm = tst[e]; pm < tst[e + 1]; ++pm) tab[1 + pm] = e; }
    __syncthreads();
}
__device__ __forceinline__ void router_lists(ARef A, const WI& w, int l) {
    LAS unsigned* hist = (LAS unsigned*)(w.lds + HIST_OFF); LAS int* base = (LAS int*)(w.lds + BASE_OFF); LAS int* texp = (LAS int*)(w.lds + TEXP_OFF);
    __syncthreads();
    if (w.tid < 32) { base[w.tid] = (int)atomicAdd((unsigned*)(A.ws + WS_CTL) + CW_GCNT + 64 * l + w.tid, hist[w.tid]); hist[w.tid] = 0u; }
    __syncthreads();
    int* LIST = (int*)(A.ws + WS_LIST); int* PW = (int*)(A.ws + WS_POS);
    int j = 0;
    for (int m = w.gw; m < MTOK; m += w.NGW, ++j) {
        if (w.lane < 4) { const int e = texp[(w.wave * 16 + j) * 4 + w.lane]; const int idx = base[e] + (int)atomicAdd((unsigned*)hist + e, 1u);
            LIST[e * LCAP + idx] = m; PW[(size_t)m * 4 + w.lane] = (e << 20) | idx; } }
}
__device__ __forceinline__ void combine_row(ARef A, int l, int m, int lane, const LAS int* tst, float gscale = 1.0f, float oscale = 1.0f) {
    float* XA = (float*)(A.ws + WS_XA) + (size_t)m * DM; const float* MOD = (const float*)(A.ws + WS_MOD) + (size_t)(l * 8 + (m >> 12)) * 6144;
    const int* PS = (const int*)(A.ws + WS_POS) + (size_t)m * 4; const float* TW = (const float*)(A.ws + WS_TOPW) + (size_t)m * 4;
    const bf16* YS = (const bf16*)(A.ws + WS_XS);
    f32x4 v[4], acc[4];
#pragma unroll
    for (int j = 0; j < 4; ++j) { v[j] = *(const f32x4*)(XA + 4 * (lane + 64 * j)); acc[j] = (f32x4){0.f, 0.f, 0.f, 0.f}; }
#pragma unroll
    for (int k = 0; k < 4; ++k) { const int pe = PS[k]; const int pos = tst[pe >> 20] * 256 + (pe & 0xFFFFF); const float gt = TW[k] * gscale; const v2u* yr = (const v2u*)(YS + (size_t)pos * DM);
#pragma unroll
        for (int j = 0; j < 4; ++j) { const v2u y = yr[lane + 64 * j]; acc[j] += gt * (f32x4){bf_lo(y.x), bf_hi(y.x), bf_lo(y.y), bf_hi(y.y)}; } }
    float ss = 0.0f;
#pragma unroll
    for (int j = 0; j < 4; ++j) { const int kx = 4 * (lane + 64 * j); v[j] += *(const f32x4*)(MOD + 5 * 1024 + kx) * acc[j]; ss += dot4(v[j], v[j]); }
    ss = wave_sum(ss); const float rstd = 1.0f / sqrtf(ss * (1.0f / DM) + 1e-5f);
    if (l + 1 < NLAYER) {
#pragma unroll
        for (int j = 0; j < 4; ++j) *(f32x4*)(XA + 4 * (lane + 64 * j)) = v[j];
        const float* mb = MOD + 8 * 6144;
        emit_h_row(v, rstd, A.in[I_NMIX] + (l + 1) * DM, mb + 1024, mb, (bf16*)(A.ws + WS_H) + (size_t)m * DM, lane);
    } else {
        float* orow = A.out + (size_t)m * DM; const float* gf = A.in[I_NFINAL];
#pragma unroll
        for (int j = 0; j < 4; ++j) { const int kx = 4 * (lane + 64 * j); *(f32x4*)(orow + kx) = v[j] * (rstd * oscale) * *(const f32x4*)(gf + kx); }
    }
}

constexpr int N_LAUNCHES = MK_N_LAUNCHES;
template <int SEL> __global__ void __launch_bounds__(NWAVES * 64, 2) fwd(ArgsH Ah) {
    extern __shared__ __attribute__((aligned(16))) unsigned char lds[];
    (void)Ah;
    const int wave_s = __builtin_amdgcn_readfirstlane((int)threadIdx.x >> 6);
    auto tid_now = [&]() -> int { int ws_ = wave_s; unsigned z_ = 0u; asm volatile("" : "+s"(ws_), "+s"(z_)); return ws_ * 64 + (int)__builtin_amdgcn_mbcnt_hi(~0u, __builtin_amdgcn_mbcnt_lo(~0u, z_)); };
#define TID_NOW() tid_now()
#define MAKE_WI() WI w; { int tz = TID_NOW(); asm volatile("" : "+v"(tz)); int bz = blockIdx.x, gz = gridDim.x; asm volatile("" : "+s"(bz), "+s"(gz)); \
        w.lds = (LAS unsigned char*)lds; w.tid = tz; w.lane = tz & 63; w.wave = __builtin_amdgcn_readfirstlane(tz >> 6); w.G = gz; w.bx = bz; w.vcu = (gz % 8 == 0) ? (bz % 8) * (gz / 8) + bz / 8 : bz; \
        w.gw = w.vcu * NWAVES + w.wave; w.NGW = gz * NWAVES; }
    { const int t0 = threadIdx.x; for (int u = t0; u < (LDS_BYTES - RING_BYTES) / 4; u += NWAVES * 64) ((LAS unsigned*)((LAS unsigned char*)lds + RING_BYTES))[u] = 0u; }
    __syncthreads();
    int lo, hi; { ARef A0 = *kargs(); lo = A0.ph_lo; hi = A0.ph_hi; }
    if (N_LAUNCHES == 1) { ARef A0 = *kargs(); (void)xcd_barrier_post((unsigned*)((gu32*)(A0.ws + WS_CTL) + CW_BAR), (volatile LAS unsigned*)((LAS unsigned char*)lds + MISC_OFF) + 8, TID_NOW()); }
#define GRID_BAR() do { if (N_LAUNCHES == 1) { ARef Ab = *kargs(); XcdBarrier bar_; bar_.bar = (unsigned*)((gu32*)(Ab.ws + WS_CTL) + CW_BAR); bar_.x = xb_xcc_id(); bar_.st = (volatile LAS unsigned*)((LAS unsigned char*)lds + MISC_OFF) + 8; xcd_barrier(bar_, TID_NOW()); } } while (0)
#ifndef TPROBE
#define TPROBE 0
#endif
#if TPROBE
    unsigned long long tp_acc = 0ull;
#define TP_SCALE tp_scale_of(__hip_atomic_load((unsigned*)(A.ws + WS_CTL) + 3, RLX_AGENT))
    auto tp_scale_of = [](unsigned ticks) -> float { const float us = (float)ticks * 0.01f; if (us < 1.0f) return 1.0f; const float q = exp2f(rintf(log2f(us) * 8.0f) * 0.125f); return 1.0f + sqrtf(q * 1e-5f); };
#define TP_BEGIN(kind) unsigned long long tp_t0 = 0ull; if ((kind) == TPROBE) tp_t0 = __builtin_amdgcn_s_memrealtime();
#define TP_END(kind) if ((kind) == TPROBE) { tp_acc += __builtin_amdgcn_s_memrealtime() - tp_t0; }
#define TP_PUBLISH(l) if ((l) == 1 && w.vcu == 0 && w.tid == 0) __hip_atomic_store((unsigned*)(A.ws + WS_CTL) + 3, (unsigned)tp_acc, RLX_AGENT);
#else
#define TP_SCALE 1.0f
#define TP_PUBLISH(l)
#define TP_BEGIN(kind)
#define TP_END(kind)
#endif
#define IN(k) (lo <= (k) && (k) < hi)
#ifndef PHMASK
#define PHMASK 0xffffffffu
#endif
#define KON(k) if constexpr ((SEL < 0 && ((PHMASK >> (k)) & 1u)) || SEL == (k))
#define BOTH(k) (IN(k) && IN((k) + 1))
#ifndef PROBE_REP
#define PROBE_REP 0
#endif
#if PROBE_REP
    int nrep_ = 2; asm volatile("" : "+s"(nrep_));
#define REP(bit) _Pragma("unroll 1") for (int rep_ = 0; rep_ < (((PROBE_REP >> (bit)) & 1) ? nrep_ : 1); ++rep_)
#else
#define REP(bit) for (int rep_ = 0; rep_ < 1; ++rep_)
#endif
#define ring ((PG8_LAS unsigned char*)lds)

    KON(0) if (IN(0)) { ARef A = *kargs(); MAKE_WI(); REP(0) ph_prologue(A, w); if (BOTH(0)) GRID_BAR(); }

#define LAYER_BODY(l) do {\
        const int pb = 1 + l * NPL; \
        KON(1) if (IN(pb + 0)) { ARef A = *kargs(); MAKE_WI(); TP_BEGIN(1) if (l == 0) { ph_norm1(A, w); small_weights_to_f16(A, w); if (BOTH(pb + 0)) GRID_BAR(); } TP_END(1) } \
        KON(2) if (IN(pb + 1)) { ARef A = *kargs(); MAKE_WI(); TP_BEGIN(2) \
            pg8::Gemm g{(const bf16*)(A.ws + WS_H), (const bf16*)(A.ws + WS_WIN) + (size_t)l * INCP * DM, MTOK, INCP, DM}; pg8::StaticOrder S; S.init(MTOK, INCP, w.G, w.bx); \
            pg8::EpiProj E{(bf16*)(A.ws + WS_PB), (float*)(A.ws + WS_PF)}; \
            REP(1) pg8::gemm_phase<pg8::EpiProj, pg8::StaticOrder, true, true>(ring, g, S, E, w.tid); \
            if (BOTH(pb + 1)) GRID_BAR(); TP_END(2) \
        } \
        KON(3) if (IN(pb + 2)) { ARef A = *kargs(); MAKE_WI(); TP_BEGIN(3) \
            REP(2) { for (int g = w.gw; g < MTOK / 16; g += w.NGW) prep16(A, l, 16 * g, w.lane); } \
            if (BOTH(pb + 2)) GRID_BAR(); TP_END(3) \
        } \
        KON(4) if (IN(pb + 3)) { ARef A = *kargs(); MAKE_WI(); TP_BEGIN(4) \
            REP(3) { for (int tk = 2 * w.vcu; tk < 32 * NCH; tk += 2 * w.G) scan_rwkv_task2(A, w, tk); } \
            REP(13) { for (int tk = w.vcu; tk < 32 * NCH / 2; tk += w.G) scan_ret_task(A, w, tk); } \
            REP(4) { LAS unsigned char* vl = w.lds + w.wave * 4608; for (int it = w.gw; it < 32 * 128; it += w.NGW) sb_tile_mfma(A, it, w.lane, vl); } \
            REP(5) dsa_scores_mfma(A, w); \
            if (BOTH(pb + 3)) GRID_BAR(); TP_END(4) \
        } \
        KON(5) if (IN(pb + 4)) { ARef A = *kargs(); MAKE_WI(); TP_BEGIN(5) \
            if (w.vcu < 32) prefix_chain(A, w, w.vcu); \
            REP(6) dsa_wave(A, w, w.lds + w.wave * 13312, l + 2 * rep_); \
            REP(14) { if (rep_ && w.vcu < 32) prefix_chain(A, w, w.vcu); } \
            if (BOTH(pb + 4)) GRID_BAR(); TP_END(5) \
        } \
        KON(6) if (IN(pb + 5)) { ARef A = *kargs(); MAKE_WI(); TP_BEGIN(6) \
            REP(7) ph_post(A, w, l); \
            if (BOTH(pb + 5)) GRID_BAR(); TP_END(6) \
        } \
        KON(7) if (IN(pb + 6)) { ARef A = *kargs(); MAKE_WI(); TP_BEGIN(7) \
            pg8::Gemm g{(const bf16*)(A.ws + WS_MIX), (const bf16*)(A.ws + WS_WOUT) + (size_t)l * DM * DM, MTOK, DM, DM}; pg8::StaticOrder S; S.init(MTOK, DM, w.G, w.bx); \
            pg8::EpiRes E{l == 0 ? A.in[I_X] : (const float*)(A.ws + WS_XA), (float*)(A.ws + WS_XA), (const float*)(A.ws + WS_MOD) + (size_t)l * 8 * 6144 + 2 * 1024}; \
            pg8::gemm_phase<pg8::EpiRes, pg8::StaticOrder, true, true>(ring, g, S, E, w.tid); \
            if (BOTH(pb + 6)) GRID_BAR(); TP_END(7) \
        } \
        KON(8) if (IN(pb + 7)) { ARef A = *kargs(); MAKE_WI(); TP_BEGIN(8) \
            { LAS unsigned* hist = (LAS unsigned*)(w.lds + HIST_OFF); LAS int* texp = (LAS int*)(w.lds + TEXP_OFF); if (w.tid < 32) hist[w.tid] = 0u; router_stage(A, w, l); \
            REP(10) { int j_ = 0; for (int m = w.gw; m < MTOK; m += w.NGW, ++j_) router_row(A, l, m, w.lane, hist, (const LAS float*)w.lds, texp + (w.wave * 16 + j_) * 4, rep_ != 0); } \
            router_lists(A, w, l); } \
            if (BOTH(pb + 7)) GRID_BAR(); TP_END(8) \
        } \
        KON(10) if (IN(pb + 8)) { ARef A = *kargs(); MAKE_WI(); TP_BEGIN(10) \
            build_expert_table(A, w, l); \
            pg8::Gemm g{(const bf16*)(A.ws + WS_H), (const bf16*)(A.ws + WS_W1) + (size_t)l * NEXP * 2048 * DM, MOE_ROWS, NEXP * 2048, DM}; \
            pg8::MoeOrder S{(const PG8_LAS int*)(w.lds + TAB_OFF), 8, w.G, w.vcu, (const PG8_LAS int*)(w.lds + TST_OFF), (const PG8_LAS int*)(w.lds + CNT_OFF), (const int*)(A.ws + WS_LIST)}; \
            pg8::EpiSwiglu E{(bf16*)(A.ws + WS_ACT), A.in[I_MB1] + (size_t)l * NEXP * 2048}; \
            REP(8) pg8::gemm_phase<pg8::EpiSwiglu, pg8::MoeOrder, true, true, true>(ring, g, S, E, w.tid); \
            if (BOTH(pb + 8)) GRID_BAR(); TP_END(10) \
        } \
        KON(11) if (IN(pb + 9)) { ARef A = *kargs(); MAKE_WI(); TP_BEGIN(11) \
            build_expert_table(A, w, l); \
            pg8::Gemm g{(const bf16*)(A.ws + WS_ACT), (const bf16*)(A.ws + WS_W2) + (size_t)l * NEXP * DM * DM, MOE_ROWS, NEXP * DM, DM}; \
            pg8::MoeOrder S{(const PG8_LAS int*)(w.lds + TAB_OFF), 4, w.G, w.vcu, (const PG8_LAS int*)(w.lds + TST_OFF), (const PG8_LAS int*)(w.lds + CNT_OFF), (const int*)(A.ws + WS_LIST)}; \
            pg8::EpiY E{(bf16*)(A.ws + WS_XS), A.in[I_MB2] + (size_t)l * NEXP * DM}; \
            REP(9) pg8::gemm_phase<pg8::EpiY, pg8::MoeOrder, true, true>(ring, g, S, E, w.tid); \
            TP_PUBLISH(l) \
            if (BOTH(pb + 9)) GRID_BAR(); TP_END(11) \
        } \
        KON(12) if (IN(pb + 10)) { ARef A = *kargs(); MAKE_WI(); TP_BEGIN(12) \
            build_expert_table(A, w, l); \
            REP(12) for (int m = w.gw; m < MTOK; m += w.NGW) combine_row(A, l, m, w.lane, (const LAS int*)(w.lds + TST_OFF), rep_ ? 0.0f : 1.0f, TP_SCALE); \
            if (BOTH(pb + 10)) GRID_BAR(); TP_END(12) \
        } \
    } while (0)
    LAYER_BODY(0);
    LAYER_BODY(1);
#undef LAYER_BODY
#undef IN
#undef ring
#undef MAKE_WI
#undef TID_NOW
#undef GRID_BAR
#undef KON
#undef BOTH
}


#if MK_N_LAUNCHES != 1
template <int K> static void launch_one(int grid, hipStream_t stream, const ArgsH& a) {
    static bool attr = false;
    if (!attr) { (void)hipFuncSetAttribute((const void*)fwd<K>, hipFuncAttributeMaxDynamicSharedMemorySize, LDS_BYTES); attr = true; }
    hipLaunchKernelGGL(fwd<K>, dim3(grid), dim3(NWAVES * 64), LDS_BYTES, stream, a);
}
static void launch_kind(int kind, int grid, hipStream_t stream, const ArgsH& a) {
    switch (kind) {
        case 0: launch_one<0>(grid, stream, a); break; case 1: launch_one<1>(grid, stream, a); break; case 2: launch_one<2>(grid, stream, a); break;
        case 3: launch_one<3>(grid, stream, a); break; case 4: launch_one<4>(grid, stream, a); break; case 5: launch_one<5>(grid, stream, a); break;
        case 6: launch_one<6>(grid, stream, a); break; case 7: launch_one<7>(grid, stream, a); break; case 8: launch_one<8>(grid, stream, a); break;
        case 9: launch_one<9>(grid, stream, a); break; case 10: launch_one<10>(grid, stream, a); break; case 11: launch_one<11>(grid, stream, a); break;
        default: launch_one<12>(grid, stream, a); break;
    }
}
#endif
extern "C" void kernel_launch(void* const* d_in, const int* in_sizes, int n_in, void* d_out, int out_size, void* d_ws, size_t ws_size, hipStream_t stream) {
    static int grid = 0;
    if (grid == 0) {
        if (n_in != N_IN || out_size != MTOK * DM || ws_size < WS_END) { fprintf(stderr, "kernel_launch: unexpected shapes (n_in %d, out %d, ws %zu)\n", n_in, out_size, ws_size); grid = -1; return; }
        int dev = 0, cus = 0;
        if (hipGetDevice(&dev) != hipSuccess || hipDeviceGetAttribute(&cus, hipDeviceAttributeMultiprocessorCount, dev) != hipSuccess) { grid = -1; return; }
#if MK_N_LAUNCHES == 1
        {
            if (hipFuncSetAttribute((const void*)fwd<-1>, hipFuncAttributeMaxDynamicSharedMemorySize, LDS_BYTES) != hipSuccess) { fprintf(stderr, "kernel_launch: hipFuncSetAttribute failed\n"); grid = -1; return; }
            int per_cu = 0;
            if (hipOccupancyMaxActiveBlocksPerMultiprocessor(&per_cu, (const void*)fwd<-1>, NWAVES * 64, LDS_BYTES) != hipSuccess || per_cu < 1) fprintf(stderr, "kernel_launch: occupancy query says %d\n", per_cu);
            (void)hipGetLastError();
        }
#endif
        grid = cus;
    }
    if (grid < 0) return;
    (void)in_sizes;
    if (hipMemsetAsync((char*)d_ws + WS_CTL, 0, CTL_ZERO_BYTES, stream) != hipSuccess) return;
    ArgsH a{};
    for (int i = 0; i < N_IN; ++i) a.in[i] = (const float*)d_in[i];
    a.out = (float*)d_out; a.ws = (unsigned char*)d_ws;
    for (int f = 0; f < 44; ++f) a.invf[f] = (f < 32) ? pow(10000.0, -(double)f / 32.0) : (f < 40) ? pow(500000.0, -(double)(f - 32) / 8.0) : pow(500000.0, -(double)(f - 40) / 4.0);
#if MK_N_LAUNCHES == 1
    a.ph_lo = 0; a.ph_hi = NPHASE; a.li = 0;
    hipLaunchKernelGGL(fwd<-1>, dim3(grid), dim3(NWAVES * 64), LDS_BYTES, stream, a);
#else
    {
        for (int p = 0; p < NPHASE; ++p) {
            if (p == 1 + NPL) continue;
            a.ph_lo = p; a.ph_hi = p + 1; a.li = p;
            static const int kinds_[NPL] = {1, 2, 3, 4, 5, 6, 7, 8, 10, 11, 12};
            const int kind = (p == 0) ? 0 : kinds_[(p - 1) % NPL];
            launch_kind(kind, grid, stream, a);
        }
    }
#endif
}
```

```cpp
#include <hip/hip_runtime.h>
#include <cstdio>
#include <cstdint>
#include <cmath>

#ifndef MK_N_LAUNCHES
#define MK_N_LAUNCHES 1
#endif

namespace pg8 {
#define PG8_LAS __attribute__((address_space(3)))
typedef unsigned short bf16_t;
typedef short bf16x8 __attribute__((ext_vector_type(8)));
typedef float f32x4 __attribute__((ext_vector_type(4)));
typedef unsigned u32x4 __attribute__((ext_vector_type(4)));
typedef unsigned u32x2 __attribute__((ext_vector_type(2)));
constexpr int BM = 256, BK = 64, HALF = 128, HTB = HALF * BK * 2  , STAGE_BYTES = 8 * HTB, NXCD = 8, WGM = 8;

__host__ __device__ __forceinline__ int lds_byte(int r, int c) { const int st = (r >> 4) * 2 + (c >> 5), rr = r & 15, cc = c & 31, ob = rr * 64 + cc * 2; return st * 1024 + (ob ^ (((ob >> 9) & 1) << 5)); }
__host__ __device__ __forceinline__ void stage_rc(int b, int& R, int& C) { const int st = b / 1024, sb = b % 1024, swz = sb ^ (((sb >> 9) & 1) << 5); R = (st >> 1) * 16 + swz / 64; C = (st & 1) * 32 + (swz % 64) / 2; }
__host__ __device__ __forceinline__ int perm32(int rho) { const int n = rho >> 4, i = rho & 15; return 8 * (i >> 2) + 4 * n + (i & 3); }

struct Unit { int pm, pn; };
struct Gemm { const bf16_t* A; const bf16_t* Bt; int M, N, K; };

struct StaticOrder {
    int nM, nN, nwg, G, c;
    __host__ __device__ void init(int M, int N, int G_, int c_) { nM = M / BM; nN = N / BM; nwg = nM * nN; G = G_; c = c_; }
    __host__ __device__ bool next(int i, Unit& u) const {
        const long L = (long)i * G + c; if (L >= nwg) return false;
        int wgid = (int)L; { const int q = nwg / NXCD, r = nwg % NXCD, xcd = wgid % NXCD, off = wgid / NXCD; wgid = (xcd < r ? xcd * (q + 1) : r * (q + 1) + (xcd - r) * q) + off; }
        const int nig = WGM * nN, gid = wgid / nig, fm = gid * WGM, gsz = (nM - fm) < WGM ? (nM - fm) : WGM;
        u.pm = fm + ((wgid % nig) % gsz); u.pn = (wgid % nig) / gsz; return true;
    }
    __device__ __forceinline__ void a_ready(const Unit&) const {}
    __device__ __forceinline__ void done(const Unit&) const {}
};
__device__ __forceinline__ unsigned cvt_pk_bf16(float lo, float hi) { unsigned r; asm volatile("v_cvt_pk_bf16_f32 %0, %1, %2" : "=v"(r) : "v"(lo), "v"(hi)); return r; }
struct EpiF32 {
    static constexpr bool PERM = false, AFTER_DRAIN = false;
    float* C; int ldc;
    __device__ __forceinline__ void operator()(const f32x4 (&acc)[2][2][4][2], const Unit& u, int wr, int wc, int fr, int fq) const {
        const int row0 = u.pm * BM + wr * 64 + fr, col0 = u.pn * BM + wc * 32 + 4 * fq;
#pragma unroll
        for (int ai = 0; ai < 2; ++ai)
#pragma unroll
            for (int m = 0; m < 4; ++m) { float* rowp = C + (size_t)(row0 + ai * HALF + m * 16) * ldc + col0;
#pragma unroll
                for (int bj = 0; bj < 2; ++bj)
#pragma unroll
                    for (int n = 0; n < 2; ++n) *(f32x4*)(rowp + bj * HALF + n * 16) = acc[ai][bj][m][n]; }
    }
};
struct EpiProj {
    static constexpr bool PERM = true, AFTER_DRAIN = false;
    bf16_t* PB; float* PF;
    __device__ __forceinline__ void operator()(const f32x4 (&acc)[2][2][4][2], const Unit& u, int wr, int wc, int fr, int fq) const {
        const int row0 = u.pm * BM + wr * 64 + fr;
        if (u.pn < 7) { const int c0 = u.pn * BM + wc * 32 + 8 * fq;
#pragma unroll
            for (int ai = 0; ai < 2; ++ai)
#pragma unroll
                for (int m = 0; m < 4; ++m) { bf16_t* rowp = PB + (size_t)(row0 + ai * HALF + m * 16) * 1792 + c0;
#pragma unroll
                    for (int bj = 0; bj < 2; ++bj) { const f32x4 v0 = acc[ai][bj][m][0], v1 = acc[ai][bj][m][1];
                        u32x4 w; w.x = cvt_pk_bf16(v0[0], v0[1]); w.y = cvt_pk_bf16(v0[2], v0[3]); w.z = cvt_pk_bf16(v1[0], v1[1]); w.w = cvt_pk_bf16(v1[2], v1[3]);
                        *(u32x4*)(rowp + bj * HALF) = w; } }
        } else { const int c0 = (u.pn - 7) * BM + wc * 32 + 8 * fq;
#pragma unroll
            for (int ai = 0; ai < 2; ++ai)
#pragma unroll
                for (int m = 0; m < 4; ++m) { float* rowp = PF + (size_t)(row0 + ai * HALF + m * 16) * 1280 + c0;
#pragma unroll
                    for (int bj = 0; bj < 2; ++bj) { *(f32x4*)(rowp + bj * HALF) = acc[ai][bj][m][0]; *(f32x4*)(rowp + bj * HALF + 4) = acc[ai][bj][m][1]; } }
        }
    }
};
struct EpiRes {
    static constexpr bool PERM = false, AFTER_DRAIN = false;
    const float* xin; float* xout; const float* gate;
    __device__ __forceinline__ void operator()(const f32x4 (&acc)[2][2][4][2], const Unit& u, int wr, int wc, int fr, int fq) const {
        const int row0 = u.pm * BM + wr * 64 + fr, col0 = u.pn * BM + wc * 32 + 4 * fq;
        const float* gp = gate + (size_t)((u.pm * BM) >> 12) * 6144 + col0;
        f32x4 gv[2][2];
#pragma unroll
        for (int bj = 0; bj < 2; ++bj)
#pragma unroll
            for (int n = 0; n < 2; ++n) gv[bj][n] = *(const f32x4*)(gp + bj * HALF + n * 16);
#pragma unroll
        for (int ai = 0; ai < 2; ++ai)
#pragma unroll
            for (int m = 0; m < 4; ++m) { const size_t ro = (size_t)(row0 + ai * HALF + m * 16) * 1024 + col0;
#pragma unroll
                for (int bj = 0; bj < 2; ++bj)
#pragma unroll
                    for (int n = 0; n < 2; ++n) { const f32x4 xv = *(const f32x4*)(xin + ro + bj * HALF + n * 16); *(f32x4*)(xout + ro + bj * HALF + n * 16) = xv + gv[bj][n] * acc[ai][bj][m][n]; } }
    }
};
__device__ __forceinline__ float swiglu1(float glu, float lin) {
    glu = fminf(glu, 7.0f); lin = fminf(fmaxf(lin, -7.0f), 7.0f);
    return glu * (1.0f / (1.0f + __expf(-1.702f * glu))) * (lin + 1.0f);
}
struct EpiSwiglu {
    static constexpr bool PERM = true, AFTER_DRAIN = false;
    bf16_t* O; const float* b1;
    __device__ __forceinline__ void operator()(const f32x4 (&acc)[2][2][4][2], const Unit& u, int wr, int wc, int fr, int fq) const {
        const int e = u.pn >> 3, j = u.pn & 7, row0 = u.pm * BM + wr * 64 + fr, c0 = 128 * j + wc * 32 + 8 * fq;
        const float* bp = b1 + (size_t)e * 2048 + c0;
        f32x4 bg[2], bl[2];
#pragma unroll
        for (int n = 0; n < 2; ++n) { bg[n] = *(const f32x4*)(bp + 4 * n); bl[n] = *(const f32x4*)(bp + 1024 + 4 * n); }
#pragma unroll
        for (int ai = 0; ai < 2; ++ai)
#pragma unroll
            for (int m = 0; m < 4; ++m) { bf16_t* rowp = O + (size_t)(row0 + ai * HALF + m * 16) * 1024 + c0;
                const f32x4 g0 = acc[ai][0][m][0] + bg[0], g1 = acc[ai][0][m][1] + bg[1], l0 = acc[ai][1][m][0] + bl[0], l1 = acc[ai][1][m][1] + bl[1];
                u32x4 w;
                w.x = cvt_pk_bf16(swiglu1(g0[0], l0[0]), swiglu1(g0[1], l0[1])); w.y = cvt_pk_bf16(swiglu1(g0[2], l0[2]), swiglu1(g0[3], l0[3]));
                w.z = cvt_pk_bf16(swiglu1(g1[0], l1[0]), swiglu1(g1[1], l1[1])); w.w = cvt_pk_bf16(swiglu1(g1[2], l1[2]), swiglu1(g1[3], l1[3]));
                *(u32x4*)rowp = w; }
    }
};
struct EpiY {
    static constexpr bool PERM = true, AFTER_DRAIN = false;
    bf16_t* O; const float* b2;
    __device__ __forceinline__ void operator()(const f32x4 (&acc)[2][2][4][2], const Unit& u, int wr, int wc, int fr, int fq) const {
        const int e = u.pn >> 2, j = u.pn & 3, row0 = u.pm * BM + wr * 64 + fr, c0 = 256 * j + wc * 32 + 8 * fq;
        const float* bp = b2 + (size_t)e * 1024 + c0;
        f32x4 bv[2][2];
#pragma unroll
        for (int bj = 0; bj < 2; ++bj)
#pragma unroll
            for (int n = 0; n < 2; ++n) bv[bj][n] = *(const f32x4*)(bp + bj * HALF + 4 * n);
#pragma unroll
        for (int ai = 0; ai < 2; ++ai)
#pragma unroll
            for (int m = 0; m < 4; ++m) { bf16_t* rowp = O + (size_t)(row0 + ai * HALF + m * 16) * 1024 + c0;
#pragma unroll
                for (int bj = 0; bj < 2; ++bj) { const f32x4 v0 = acc[ai][bj][m][0] + bv[bj][0], v1 = acc[ai][bj][m][1] + bv[bj][1];
                    u32x4 w; w.x = cvt_pk_bf16(v0[0], v0[1]); w.y = cvt_pk_bf16(v0[2], v0[3]); w.z = cvt_pk_bf16(v1[0], v1[1]); w.w = cvt_pk_bf16(v1[2], v1[3]);
                    *(u32x4*)(rowp + bj * HALF) = w; } }
    }
};
struct MoeOrder {
    const PG8_LAS int* tab; int NJ, G, c;
    __device__ __forceinline__ bool next(int i, Unit& u) const {
        const int T = tab[0]; const long L = (long)i * G + c; if (L >= (long)T * NJ) return false;
        const int pm = (int)(L / NJ), j = (int)(L % NJ);
        u.pm = pm; u.pn = tab[1 + pm] * NJ + j; return true;
    }
    __device__ __forceinline__ void a_ready(const Unit&) const {}
    __device__ __forceinline__ void done(const Unit&) const {}
    const PG8_LAS int* tst; const PG8_LAS int* cnt; const int* list;
    __device__ __forceinline__ int row_of(const Unit& u, int r) const { const int e = tab[1 + u.pm], idx = 256 * (u.pm - tst[e]) + r; return (idx < cnt[e]) ? list[e * 32768 + idx] : 0; }
};

template <class Epi, class Sched, bool ALIGN_EPI = false, bool SP2 = false, bool GATHER = false>
__device__ __forceinline__ void gemm_phase(PG8_LAS unsigned char* lds, const Gemm g, const Sched& S, const Epi& E, int tid_in) {
    int tid_ = tid_in; asm volatile("" : "+v"(tid_));
    const int tid = tid_, wid = __builtin_amdgcn_readfirstlane(tid >> 6), lane = tid & 63, wr = wid >> 2, wc = wid & 3, fr = lane & 15, fq = lane >> 4;
    const int K = g.K, nt = K / BK;
    unsigned voffA[2], voffB[2];
#pragma unroll
    for (int i = 0; i < 2; ++i) { int R, C; stage_rc(tid * 16 + i * 8192, R, C); const int Rb = Epi::PERM ? ((R & ~31) + perm32(R & 31)) : R;
        voffA[i] = (unsigned)(R * K + C) * 2u; voffB[i] = (unsigned)(Rb * K + C) * 2u; }
    static_assert(!GATHER || SP2, "gathered A rows: only the two-super-phase loop is wired");
    unsigned cvo[2][2], nvo[2][2];
#define PG8_ROWS(dst, u_) do { _Pragma("unroll") for (int h_ = 0; h_ < 2; ++h_) _Pragma("unroll") for (int i_ = 0; i_ < 2; ++i_) { int R_, C_; stage_rc(tid * 16 + i_ * 8192, R_, C_); dst[h_][i_] = (unsigned)(S.row_of(u_, h_ * HALF + R_) * K + C_) * 2u; } } while (0)
#define PG8_STAGE_A(bufoff, gbase, half, nx) do { if constexpr (GATHER) { unsigned o_[2]; o_[0] = (nx) ? nvo[half][0] : cvo[half][0]; o_[1] = (nx) ? nvo[half][1] : cvo[half][1]; PG8_STAGE(bufoff, gbase, o_); } else { PG8_STAGE(bufoff, (gbase) + (half) * hstep, voffA); } } while (0)
    const size_t kstep = (size_t)(BK * 2);
    const size_t hstep = (size_t)HALF * K * 2;
    const size_t tstep = 2 * hstep;
    const unsigned ldsw = (unsigned)wid * 1024u;
    const int aoff = lds_byte(wr * 64 + fr, fq * 8), boff = lds_byte(wc * 32 + fr, fq * 8);
#define PG8_SA(b, h) (((b) * 2 + (h)) * HTB)
#define PG8_SB(b, h) ((4 + (b) * 2 + (h)) * HTB)
#define PG8_STAGE(bufoff, gbase, voff) do { _Pragma("unroll") for (int _i = 0; _i < 2; ++_i) \
        __builtin_amdgcn_global_load_lds((const unsigned*)((const char*)(gbase) + (voff)[_i]), (PG8_LAS unsigned*)(lds + (bufoff) + ldsw + _i * 8192), 16, 0, 0); } while (0)
#define PG8_LDA(dst, b, h) do { _Pragma("unroll") for (int m = 0; m < 4; ++m) _Pragma("unroll") for (int k = 0; k < 2; ++k) dst[m][k] = *(const PG8_LAS bf16x8*)(lds + PG8_SA(b, h) + aoff + m * 2048 + k * 1024); } while (0)
#define PG8_LDB(dst, b, h) do { _Pragma("unroll") for (int n = 0; n < 2; ++n) _Pragma("unroll") for (int k = 0; k < 2; ++k) dst[n][k] = *(const PG8_LAS bf16x8*)(lds + PG8_SB(b, h) + boff + n * 2048 + k * 1024); } while (0)
#define PG8_MMA(ai, bj, At, Bt) do { __builtin_amdgcn_s_setprio(1); _Pragma("unroll") for (int m = 0; m < 4; ++m) _Pragma("unroll") for (int n = 0; n < 2; ++n) _Pragma("unroll") for (int k = 0; k < 2; ++k) \
        acc[ai][bj][m][n] = __builtin_amdgcn_mfma_f32_16x16x32_bf16(Bt[n][k], At[m][k], acc[ai][bj][m][n], 0, 0, 0); __builtin_amdgcn_s_setprio(0); } while (0)
#define PG8_WAIT_V(n) asm volatile("s_waitcnt vmcnt(" #n ")" ::: "memory")
#define PG8_WAIT_L(n) asm volatile("s_waitcnt lgkmcnt(" #n ")" ::: "memory")
#define PG8_BAR __builtin_amdgcn_s_barrier()
#define PG8_SCHED __builtin_amdgcn_sched_barrier(0)
    Unit cur, nxt; int ui = 0;
    if (!S.next(0, cur)) return;
    f32x4 acc[2][2][4][2];
#pragma unroll
    for (int a = 0; a < 2; ++a)
#pragma unroll
        for (int b = 0; b < 2; ++b)
#pragma unroll
            for (int m = 0; m < 4; ++m)
#pragma unroll
                for (int n = 0; n < 2; ++n) acc[a][b][m][n] = (f32x4){0.f, 0.f, 0.f, 0.f};
    bf16x8 At[4][2], B0[2][2], B1[2][2];
    const char* cA = (const char*)g.A + (GATHER ? (size_t)0 : (size_t)cur.pm * tstep); const char* cB = (const char*)g.Bt + (size_t)cur.pn * tstep;
    if constexpr (GATHER) { PG8_ROWS(cvo, cur); }
    S.a_ready(cur);
    if constexpr (SP2) {
        PG8_STAGE(PG8_SB(0, 0), cB, voffB); PG8_STAGE(PG8_SB(0, 1), cB + hstep, voffB); PG8_STAGE_A(PG8_SA(0, 0), cA, 0, false); PG8_STAGE_A(PG8_SA(0, 1), cA, 1, false);
        if (wr == 1) PG8_BAR;
        PG8_WAIT_V(2); PG8_BAR;
        PG8_STAGE(PG8_SB(1, 0), cB + kstep, voffB); PG8_STAGE_A(PG8_SA(1, 0), cA + kstep, 0, false); PG8_STAGE(PG8_SB(1, 1), cB + hstep + kstep, voffB);
        PG8_WAIT_V(6); PG8_BAR;
    } else {
        PG8_STAGE(PG8_SB(0, 0), cB, voffB); PG8_STAGE(PG8_SA(0, 0), cA, voffA); PG8_STAGE(PG8_SB(0, 1), cB + hstep, voffB); PG8_STAGE(PG8_SA(0, 1), cA + hstep, voffA);
        if (wr == 1) PG8_BAR;
        PG8_WAIT_V(4); PG8_BAR;
        PG8_STAGE(PG8_SB(1, 0), cB + kstep, voffB); PG8_STAGE(PG8_SA(1, 0), cA + kstep, voffA); PG8_STAGE(PG8_SB(1, 1), cB + hstep + kstep, voffB);
        PG8_WAIT_V(6); PG8_BAR;
    }
    for (;;) {
        const bool has_next = S.next(ui + 1, nxt);
        const char* nA = GATHER ? (const char*)g.A : (has_next ? (const char*)g.A + (size_t)nxt.pm * tstep : cA); const char* nB = has_next ? (const char*)g.Bt + (size_t)nxt.pn * tstep : cB;
        if constexpr (GATHER) { if (has_next) { PG8_ROWS(nvo, nxt); } else { _Pragma("unroll") for (int h_ = 0; h_ < 2; ++h_) { nvo[h_][0] = cvo[h_][0]; nvo[h_][1] = cvo[h_][1]; } } }
        for (int t = 0; t < nt; t += 2) {
            const bool last = (t == nt - 2);
            const char* a1 = cA + (size_t)(t + 1) * kstep;
            const char* a2 = last ? nA : cA + (size_t)(t + 2) * kstep; const char* b2 = last ? nB : cB + (size_t)(t + 2) * kstep;
            const char* a3 = a2 + kstep; const char* b3 = b2 + kstep;
            if (last && has_next) S.a_ready(nxt);
            if constexpr (SP2) {
            PG8_LDB(B0, 0, 0); PG8_LDB(B1, 0, 1); PG8_SCHED; PG8_LDA(At, 0, 0); PG8_STAGE_A(PG8_SA(1, 1), a1, 1, false);
            PG8_WAIT_V(8); PG8_WAIT_L(0); PG8_BAR; PG8_MMA(0, 0, At, B0); PG8_MMA(0, 1, At, B1); PG8_BAR; PG8_SCHED;
            PG8_LDA(At, 0, 1); PG8_STAGE(PG8_SB(0, 0), b2, voffB); PG8_STAGE(PG8_SB(0, 1), b2 + hstep, voffB); PG8_STAGE_A(PG8_SA(0, 0), a2, 0, last);
            PG8_WAIT_V(8); PG8_WAIT_L(0); PG8_BAR; PG8_MMA(1, 0, At, B0); PG8_MMA(1, 1, At, B1); PG8_BAR; PG8_SCHED;
            PG8_LDB(B0, 1, 0); PG8_LDB(B1, 1, 1); PG8_SCHED; PG8_LDA(At, 1, 0); PG8_STAGE_A(PG8_SA(0, 1), a2, 1, last);
            PG8_WAIT_V(8); PG8_WAIT_L(0); PG8_BAR; PG8_MMA(0, 0, At, B0); PG8_MMA(0, 1, At, B1); PG8_BAR; PG8_SCHED;
            PG8_LDA(At, 1, 1); PG8_STAGE(PG8_SB(1, 0), b3, voffB); PG8_STAGE(PG8_SB(1, 1), b3 + hstep, voffB); PG8_STAGE_A(PG8_SA(1, 0), a3, 0, last);
            PG8_WAIT_V(8); PG8_WAIT_L(0); PG8_BAR; PG8_MMA(1, 0, At, B0); PG8_MMA(1, 1, At, B1); PG8_BAR; PG8_SCHED;
            } else {
            PG8_LDB(B0, 0, 0); PG8_SCHED; PG8_LDA(At, 0, 0); PG8_STAGE(PG8_SA(1, 1), a1 + hstep, voffA);
            PG8_WAIT_L(8); PG8_BAR; PG8_WAIT_L(0); PG8_MMA(0, 0, At, B0); PG8_BAR; PG8_SCHED;
            PG8_LDB(B1, 0, 1); PG8_STAGE(PG8_SB(0, 0), b2, voffB);
            PG8_BAR; PG8_WAIT_L(0); PG8_MMA(0, 1, At, B1); PG8_BAR;
            PG8_LDA(At, 0, 1); PG8_STAGE(PG8_SA(0, 0), a2, voffA);
            PG8_BAR; PG8_WAIT_L(0); PG8_MMA(1, 0, At, B0); PG8_BAR; PG8_SCHED;
            PG8_STAGE(PG8_SB(0, 1), b2 + hstep, voffB);
            PG8_WAIT_V(6); PG8_BAR; PG8_MMA(1, 1, At, B1); PG8_BAR;
            PG8_LDB(B0, 1, 0); PG8_SCHED; PG8_LDA(At, 1, 0); PG8_STAGE(PG8_SA(0, 1), a2 + hstep, voffA);
            PG8_WAIT_L(8); PG8_BAR; PG8_WAIT_L(0); PG8_MMA(0, 0, At, B0); PG8_BAR; PG8_SCHED;
            PG8_LDB(B1, 1, 1); PG8_STAGE(PG8_SB(1, 0), b3, voffB);
            PG8_BAR; PG8_WAIT_L(0); PG8_MMA(0, 1, At, B1); PG8_BAR;
            PG8_LDA(At, 1, 1); PG8_STAGE(PG8_SA(1, 0), a3, voffA);
            PG8_BAR; PG8_WAIT_L(0); PG8_MMA(1, 0, At, B0); PG8_BAR; PG8_SCHED;
            PG8_STAGE(PG8_SB(1, 1), b3 + hstep, voffB);
            PG8_WAIT_V(6); PG8_BAR; PG8_MMA(1, 1, At, B1); PG8_BAR;
            }
        }
        if constexpr (ALIGN_EPI) { if (wr == 0) PG8_BAR; }
        if constexpr (!Epi::AFTER_DRAIN) { E(acc, cur, wr, wc, fr, fq); S.done(cur); }
        if (!has_next) break;
#pragma unroll
        for (int a = 0; a < 2; ++a)
#pragma unroll
            for (int b = 0; b < 2; ++b)
#pragma unroll
                for (int m = 0; m < 4; ++m)
#pragma unroll
                    for (int n = 0; n < 2; ++n) acc[a][b][m][n] = (f32x4){0.f, 0.f, 0.f, 0.f};
        cur = nxt; cA = nA; cB = nB; ++ui;
        if constexpr (GATHER) { _Pragma("unroll") for (int h_ = 0; h_ < 2; ++h_) { cvo[h_][0] = nvo[h_][0]; cvo[h_][1] = nvo[h_][1]; } }
        if constexpr (ALIGN_EPI) { if (wr == 1) PG8_BAR; }
    }
    PG8_WAIT_V(0);
    if constexpr (!ALIGN_EPI) { if (wr == 0) PG8_BAR; }
    PG8_BAR;
    if constexpr (Epi::AFTER_DRAIN) { E.fused(acc, cur, wr, wc, fr, fq, lds, wid, lane); S.done(cur); }
#undef PG8_SA
#undef PG8_SB
#undef PG8_STAGE
#undef PG8_STAGE_A
#undef PG8_ROWS
#undef PG8_LDA
#undef PG8_LDB
#undef PG8_MMA
#undef PG8_WAIT_V
#undef PG8_WAIT_L
#undef PG8_BAR
#undef PG8_SCHED
}
}

constexpr int NWAVES = 8;
constexpr int NB = 8, SEQ = 4096, DM = 1024, MTOK = NB * SEQ, NLAYER = 2;
constexpr int INC = 2984, INCP = 3072;
constexpr int C_RET = 0, C_RW = 1024, C_DSA = 1920, C_SB = 2216;
constexpr int PBW = 1792, PFW = 1280, PB_SB = 1024, PF_DSA = 896;
constexpr int NEXP = 32, MOE_ROWS = MTOK * 4 + NEXP * 256;
constexpr int ROPE_W = 88;
constexpr int NCH = 16, TCH = SEQ / NCH;
constexpr int NPL = 11, NPHASE = 1 + NLAYER * NPL;
enum { I_X = 0, I_C, I_POS, I_ADAW, I_ADAB, I_NMIX, I_NFFN, I_WIN, I_RETGN, I_MU, I_W0, I_W2, I_A0, I_A2, I_G2, I_KK, I_KA, I_RK, I_LN, I_QNORM, I_WQ, I_WQI, I_DONORM, I_SONORM, I_WOUT, I_RW, I_RB, I_MW1, I_MB1, I_MW2, I_MB2, I_NFINAL, N_IN };

constexpr size_t MiB = 1u << 20;
constexpr size_t WS_CTL = 0, CTL_ZERO_BYTES = 1 * MiB;
constexpr size_t WS_MOD = 1 * MiB, WS_ROPE = 2 * MiB, WS_WIN = 14 * MiB, WS_WOUT = 26 * MiB, WS_W1 = 30 * MiB, WS_W2 = 286 * MiB;
constexpr size_t WS_XA = 414 * MiB, WS_H = 542 * MiB, WS_MIX = 606 * MiB, WS_TOPI = 670 * MiB, WS_TOPW = 671 * MiB, WS_POS = 672 * MiB;
constexpr size_t WS_R = 674 * MiB;
constexpr size_t WS_PB = WS_R  , WS_PF = WS_R + 112 * MiB  , WS_RWA = 1058 * MiB  , WS_DQ = 1314 * MiB  , WS_DKB = 1330 * MiB  , WS_DVB = 1334 * MiB  , WS_DQI = 1346 * MiB  , WS_DKI = 1394 * MiB  , WS_DW = 1398 * MiB;
constexpr size_t WS_SMALLW = 1338 * MiB  ;
constexpr int SMW_QI = 0, SMW_W2 = 512 * 128, SMW_A2 = SMW_W2 + 256 * 32, SMW_G2 = SMW_A2 + 256 * 32, SMW_LAYER = SMW_G2 + 256 * 64;
constexpr size_t WS_PT = 1362 * MiB  ;
constexpr size_t WS_CH = WS_H  , WS_SI = WS_H + 16 * MiB  , WS_SIR = WS_H + 24 * MiB  ,
                 WS_CHR = WS_H + 32 * MiB  , WS_PTR = WS_H + 40 * MiB  ;
constexpr size_t WS_SQ = WS_MIX  , WS_SK = WS_MIX + 16 * MiB, WS_SV = WS_MIX + 32 * MiB;
constexpr size_t WS_YO = 1400 * MiB  , WS_SC = 1528 * MiB  ;
constexpr size_t WS_XS = WS_R  , WS_ACT = 946 * MiB  ;
constexpr size_t WS_LIST = 2040 * MiB  , WS_END = 2044 * MiB;
constexpr int LCAP = 32768;
static_assert((size_t)MOE_ROWS * 2048 <= 272 * MiB, "moe buffers");
constexpr int CW_TMO = 0, CW_CODE = 1, CW_GCNT = 256  , CW_DSAQ = 1024  , CW_BAR = 4096, CW_BLKCNT = 16384  ;
constexpr int RING_BYTES = 131072, MISC_OFF = RING_BYTES + 320, TST_OFF = RING_BYTES + 1024  , TAB_OFF = RING_BYTES + 2048  , HIST_OFF = RING_BYTES + 5120  , BASE_OFF = RING_BYTES + 5376  , CNT_OFF = RING_BYTES + 5632  , TEXP_OFF = RING_BYTES + 6144  , LDS_BYTES = 147456;

#if defined(__HIP_DEVICE_COMPILE__)
#define GAS __attribute__((address_space(1)))
#define CAS __attribute__((address_space(4)))
#else
#define GAS
#define CAS
#endif
#define LAS __attribute__((address_space(3)))
typedef unsigned short bf16;
typedef unsigned v4u __attribute__((ext_vector_type(4)));
typedef unsigned v2u __attribute__((ext_vector_type(2)));
typedef float f32x4 __attribute__((ext_vector_type(4)));
typedef GAS unsigned gu32;
typedef short bf16x8v __attribute__((ext_vector_type(8)));
typedef short s16x4v __attribute__((ext_vector_type(4)));
typedef _Float16 f16x8 __attribute__((ext_vector_type(8)));
#define RLX_AGENT __ATOMIC_RELAXED, __HIP_MEMORY_SCOPE_AGENT
#define LDS_WAIT() asm volatile("s_waitcnt lgkmcnt(0)" ::: "memory")
#define VM_WAIT() asm volatile("s_waitcnt vmcnt(0)" ::: "memory")
__device__ __forceinline__ unsigned f2bf(float f) { unsigned u = __builtin_bit_cast(unsigned, f); return (u + 0x7fffu + ((u >> 16) & 1u)) >> 16; }
__device__ __forceinline__ unsigned pk2(float lo, float hi) { return f2bf(lo) | (f2bf(hi) << 16); }
__device__ __forceinline__ float bf_lo(unsigned w) { return __builtin_bit_cast(float, w << 16); }
__device__ __forceinline__ float bf_hi(unsigned w) { return __builtin_bit_cast(float, w & 0xffff0000u); }
__device__ __forceinline__ float wave_sum(float v) {
#pragma unroll
    for (int o = 1; o < 64; o <<= 1) v += __shfl_xor(v, o);
    return v;
}
__device__ __forceinline__ float wave_max(float v) {
#pragma unroll
    for (int o = 1; o < 64; o <<= 1) v = fmaxf(v, __shfl_xor(v, o));
    return v;
}
__device__ __forceinline__ float grp16_sum(float v) { v += __shfl_xor(v, 1); v += __shfl_xor(v, 2); v += __shfl_xor(v, 4); v += __shfl_xor(v, 8); return v; }
__device__ __forceinline__ float grp8_sum(float v) { v += __shfl_xor(v, 1); v += __shfl_xor(v, 2); v += __shfl_xor(v, 4); return v; }
__device__ __forceinline__ float sum4(f32x4 a) { return (a.x + a.y) + (a.z + a.w); }
__device__ __forceinline__ float dot4(f32x4 a, f32x4 b) { return (a.x * b.x + a.y * b.y) + (a.z * b.z + a.w * b.w); }
__device__ __forceinline__ float fexp(float x) { return __builtin_amdgcn_exp2f(x * 1.4426950408889634f); }
__device__ __forceinline__ float sigm(float x) { return __builtin_amdgcn_rcpf(1.0f + fexp(-x)); }
__device__ __forceinline__ float softplusf(float x) { return fmaxf(x, 0.0f) + 0.6931471805599453f * __builtin_amdgcn_logf(1.0f + fexp(-fabsf(x))); }
__device__ __forceinline__ float ftanh(float x) { const float e = fexp(-2.0f * fabsf(x)); const float t = (1.0f - e) * __builtin_amdgcn_rcpf(1.0f + e); return x < 0.0f ? -t : t; }
__device__ __forceinline__ f32x4 shx4(f32x4 v, int m) { f32x4 r; r.x = __shfl_xor(v.x, m); r.y = __shfl_xor(v.y, m); r.z = __shfl_xor(v.z, m); r.w = __shfl_xor(v.w, m); return r; }

#define XB_TMO      128
#define XB_XCNT(j)  (256  + 64 * (j))
#define XB_XSUB(j)  (1280 + 64 * (j))
#define XB_XGEN(j)  (2304 + 64 * (j))
#define XB_TOP      3328
#define XB_TOPGEN   3392
#define XCD_BAR_WORDS 3456
#define XB_SPIN_CAP (1u << 18)

__device__ __forceinline__ unsigned xb_ld(unsigned* p)              { return __hip_atomic_load(p, __ATOMIC_RELAXED, __HIP_MEMORY_SCOPE_AGENT); }
__device__ __forceinline__ unsigned xb_add(unsigned* p, unsigned v) { return __hip_atomic_fetch_add(p, v, __ATOMIC_RELAXED, __HIP_MEMORY_SCOPE_AGENT); }
__device__ __forceinline__ unsigned xb_xcc_id() { return (unsigned)__builtin_amdgcn_s_getreg((3 << 11) | 20) & 0xFu; }
#define XB_SPIN(cond, bar) do { unsigned _sp = 0; while (cond) { __builtin_amdgcn_s_sleep(1); \
    if ((++_sp & 255u) == 0u) { if (xb_ld(&(bar)[XB_TMO])) break; if (_sp > XB_SPIN_CAP) { atomicAdd(&(bar)[XB_TMO], 1u); break; } } } } while (0)

struct XcdBarrier {
    unsigned* bar; unsigned x;
    volatile LAS unsigned* st;
};

__device__ __forceinline__ XcdBarrier xcd_barrier_post(unsigned* bar, volatile LAS unsigned* st, int xb_tid) {
    XcdBarrier b; b.bar = bar; b.x = xb_xcc_id(); b.st = st;
    if (xb_tid == 0) (void)xb_add(&bar[XB_XCNT(b.x)], 1u);
    return b;
}
__device__ __forceinline__ void xcd_barrier_complete(unsigned* bar, unsigned x, unsigned& nloc, unsigned& nx) {
    const unsigned G = gridDim.x * gridDim.y * gridDim.z;
    unsigned sum, cnt, mine, sp = 0u;
    for (;;) {
        sum = 0u; cnt = 0u; mine = 0u;
#pragma unroll
        for (unsigned j = 0; j < 16; ++j) { const unsigned c = xb_ld(&bar[XB_XCNT(j)]); sum += c; cnt += (c > 0u) ? 1u : 0u; mine = (j == x) ? c : mine; }
        if (sum == G) break;
        __builtin_amdgcn_s_sleep(1);
        if ((++sp & 255u) == 0u) { if (xb_ld(&bar[XB_TMO])) break; if (sp > XB_SPIN_CAP) { atomicAdd(&bar[XB_TMO], 1u); break; } }
    }
    nloc = mine > 0u ? mine : 1u; nx = cnt > 0u ? cnt : 1u;
}

__device__ __forceinline__ void xcd_barrier(const XcdBarrier& b, int xb_tid) {
    asm volatile("s_waitcnt vmcnt(0)" ::: "memory");
    __syncthreads();
    if (xb_tid == 0) {
        unsigned* bar = b.bar;
        __builtin_amdgcn_s_waitcnt(0);
        unsigned nloc = b.st[0], nx = b.st[1];
        if (nloc == 0u) { xcd_barrier_complete(bar, b.x, nloc, nx); b.st[0] = nloc; b.st[1] = nx; }
        const unsigned old = xb_add(&bar[XB_XSUB(b.x)], 1u);
        const unsigned gen = old / nloc;
        if (old + 1u == (gen + 1u) * nloc) {
            __builtin_amdgcn_fence(__ATOMIC_RELEASE, "agent");
            asm volatile("s_waitcnt vmcnt(0)" ::: "memory");
            const unsigned og = xb_add(&bar[XB_TOP], 1u);
            const unsigned tg = og / nx;
            if (og + 1u == (tg + 1u) * nx) xb_add(&bar[XB_TOPGEN], 1u);
            else XB_SPIN(xb_ld(&bar[XB_TOPGEN]) == tg, bar);
            __builtin_amdgcn_fence(__ATOMIC_ACQUIRE, "agent");
            xb_add(&bar[XB_XGEN(b.x)], 1u);
            asm volatile("s_waitcnt vmcnt(0)" ::: "memory");
        } else {
            XB_SPIN(xb_ld(&bar[XB_XGEN(b.x)]) == gen, bar);
            __builtin_amdgcn_fence(__ATOMIC_ACQUIRE, "agent");
            asm volatile("s_waitcnt vmcnt(0)" ::: "memory");
        }
    }
    __syncthreads();
}
struct ArgsH { const float* in[N_IN]; float* out; unsigned char* ws; double invf[44]; int ph_lo, ph_hi, li, pad; };
struct ArgsD { const GAS float* in[N_IN]; GAS float* out; GAS unsigned char* ws; double invf[44]; int ph_lo, ph_hi, li, pad; };
static_assert(sizeof(ArgsH) == sizeof(ArgsD), "args layout");
typedef const CAS ArgsD& ARef;
__device__ __forceinline__ const CAS ArgsD* kargs() {
#if defined(__HIP_DEVICE_COMPILE__)
    const CAS ArgsD* p = (const CAS ArgsD*)__builtin_amdgcn_kernarg_segment_ptr(); asm volatile("" : "+s"(p)); return p;
#else
    return nullptr;
#endif
}
struct WI { LAS unsigned char* lds; int tid, lane, wave, vcu, G, gw, NGW, bx; };
constexpr size_t RWA_STRIDE = 32 * MiB / 4;
constexpr size_t YO_STRIDE = 32 * MiB / 4;

__device__ __forceinline__ int wave_sum_i(int v) {
#pragma unroll
    for (int o = 1; o < 64; o <<= 1) v += __shfl_xor(v, o);
    return v;
}
__device__ __forceinline__ void sincos_d(double ang, float& s, float& c) {
    const double q = __builtin_rint(ang * 0.63661977236758134308);
    double r = __builtin_fma(-q, 1.57079632679489661923, ang); r = __builtin_fma(-q, 6.123233995736766e-17, r);
    const double r2 = r * r;
    const double sp = r * (1.0 + r2 * (-1.0 / 6 + r2 * (1.0 / 120 + r2 * (-1.0 / 5040 + r2 * (1.0 / 362880 + r2 * (-1.0 / 39916800 + r2 * (1.0 / 6227020800.0)))))));
    const double cp = 1.0 + r2 * (-0.5 + r2 * (1.0 / 24 + r2 * (-1.0 / 720 + r2 * (1.0 / 40320 + r2 * (-1.0 / 3628800 + r2 * (1.0 / 479001600 + r2 * (-1.0 / 87178291200.0)))))));
    const int qi = ((int)q) & 3;
    const double ss = (qi == 0) ? sp : (qi == 1) ? cp : (qi == 2) ? -sp : -cp;
    const double cc = (qi == 0) ? cp : (qi == 1) ? -sp : (qi == 2) ? -cp : sp;
    s = (float)ss; c = (float)cc;
}

__device__ __forceinline__ void tr_item(const float* W, int ldw, int nvalid, int k0, int nsrc0, bf16* WT, size_t dstrow0, LAS float* scr, int lane, float scale = 1.0f) {
#pragma unroll 8
    for (int i = 0; i < 32; ++i) { const int kk = 2 * i + (lane >> 5), c = lane & 31, n = nsrc0 + c; scr[kk * 33 + c] = (n < nvalid) ? W[(size_t)(k0 + kk) * ldw + n] * scale : 0.0f; }
    LDS_WAIT(); asm volatile("" ::: "memory");
    const int c8 = lane & 7;
#pragma unroll
    for (int j = 0; j < 4; ++j) { const int n = (lane >> 3) + 8 * j; const LAS float* s = scr + (8 * c8) * 33 + n;
        v4u o; o.x = pk2(s[0 * 33], s[1 * 33]); o.y = pk2(s[2 * 33], s[3 * 33]); o.z = pk2(s[4 * 33], s[5 * 33]); o.w = pk2(s[6 * 33], s[7 * 33]);
        *(v4u*)(WT + (dstrow0 + n) * 1024 + k0 + 8 * c8) = o; }
    LDS_WAIT(); asm volatile("" ::: "memory");
}
__device__ __forceinline__ void ph_prologue(ARef A, const WI& w) {
    LAS float* sc = (LAS float*)w.lds;
    { const float* cin = A.in[I_C]; for (int i = w.tid; i < NB * DM; i += NWAVES * 64) { const float v = cin[i]; sc[i] = v / (1.0f + expf(-v)); } }
    __syncthreads();
    float* MOD = (float*)(A.ws + WS_MOD);
    if (w.wave == 0 && w.vcu < 192) {
        const int l = w.vcu / 96, col = (w.vcu % 96) * 64 + w.lane;
        const float* wp = A.in[I_ADAW] + (size_t)l * DM * 6144 + col;
        float acc[8];
#pragma unroll
        for (int b = 0; b < 8; ++b) acc[b] = 0.0f;
        for (int k = 0; k < DM; ++k) { const float wv = wp[(size_t)k * 6144];
#pragma unroll
            for (int b = 0; b < 8; ++b) acc[b] += sc[b * DM + k] * wv; }
        const float bias = A.in[I_ADAB][l * 6144 + col];
#pragma unroll
        for (int b = 0; b < 8; ++b) MOD[(size_t)(l * 8 + b) * 6144 + col] = acc[b] + bias;
    }
    LAS float* scr = (LAS float*)(w.lds + 32768 + w.wave * 8448);
    constexpr int I_IN = NLAYER * 16 * 96, I_OUT = NLAYER * 16 * 32, I_W1 = NLAYER * NEXP * 16 * 64, I_W2 = NLAYER * NEXP * 16 * 32, NIT = I_IN + I_OUT + I_W1 + I_W2;
    for (int it = w.gw; it < NIT; it += w.NGW) {
        int r = it;
        if (r < I_IN) { const int l = r / 1536, rr = r % 1536, kb = rr / 96, nb = rr % 96;
            const int nd = nb * 32;
            const int ns = (nd < 1024) ? nd : (nd < 1792) ? C_SB + (nd - 1024) : (nd < 2688) ? C_RW + (nd - 1792) : C_DSA + (nd - 2688);
            const int nv = (nd < 1024) ? 1024 : (nd < 1792) ? INC : (nd < 2688) ? C_DSA : ((nd < INC) ? C_SB : 0);
            const float sc_ = (nd >= 256 && nd < 512) ? 0.125f : (nd >= 1024 && nd < 1280) ? 0.18033688011112042f : 1.0f;
            tr_item(A.in[I_WIN] + (size_t)l * DM * INC, INC, nv, kb * 64, ns, (bf16*)(A.ws + WS_WIN) + (size_t)l * INCP * DM, (size_t)nd, scr, w.lane, sc_); continue; }
        r -= I_IN;
        if (r < I_OUT) { const int l = r / 512, rr = r % 512, kb = rr / 32, nb = rr % 32;
            tr_item(A.in[I_WOUT] + (size_t)l * DM * DM, DM, DM, kb * 64, nb * 32, (bf16*)(A.ws + WS_WOUT) + (size_t)l * DM * DM, (size_t)nb * 32, scr, w.lane); continue; }
        r -= I_OUT;
        if (r < I_W1) { const int le = r / 1024, rr = r % 1024, kb = rr / 64, nb = rr % 64, j = nb >> 3, bj = (nb >> 2) & 1, cc0 = (nb & 3) * 32;
            tr_item(A.in[I_MW1] + (size_t)le * DM * 2048, 2048, 2048, kb * 64, bj * 1024 + 128 * j + cc0, (bf16*)(A.ws + WS_W1) + (size_t)le * 2048 * DM, (size_t)nb * 32, scr, w.lane); continue; }
        r -= I_W1;
        { const int le = r / 512, rr = r % 512, kb = rr / 32, nb = rr % 32;
            tr_item(A.in[I_MW2] + (size_t)le * DM * DM, DM, DM, kb * 64, nb * 32, (bf16*)(A.ws + WS_W2) + (size_t)le * DM * DM, (size_t)nb * 32, scr, w.lane); }
    }
    float* RT = (float*)(A.ws + WS_ROPE); const int* pos = (const int*)A.in[I_POS];
    for (int g = w.gw * 64 + w.lane; g < MTOK * 44; g += w.NGW * 64) {
        const int tok = g / 44, f = g % 44; int co, so;
        if (f < 32) { co = f; so = 32 + f; } else if (f < 40) { co = 64 + (f - 32); so = 72 + (f - 32); } else { co = 80 + (f - 40); so = 84 + (f - 40); }
        float s, c; sincos_d((double)pos[tok] * A.invf[f], s, c);
        RT[(size_t)tok * ROPE_W + co] = c; RT[(size_t)tok * ROPE_W + so] = s;
    }
}

__device__ __forceinline__ void emit_h_row(const f32x4 (&v)[4], float rstd, const float* g, const float* sc, const float* sh, bf16* hrow, int lane) {
#pragma unroll
    for (int j = 0; j < 4; ++j) { const int k = 4 * (lane + 64 * j);
        const f32x4 gv = *(const f32x4*)(g + k), scv = *(const f32x4*)(sc + k), shv = *(const f32x4*)(sh + k);
        const f32x4 h = v[j] * rstd * gv * (1.0f + scv) + shv;
        v2u o; o.x = pk2(h.x, h.y); o.y = pk2(h.z, h.w); *(v2u*)(hrow + k) = o; }
}
__device__ __forceinline__ void small_weights_to_f16(ARef A, const WI& w) {
    { _Float16* SW = (_Float16*)(A.ws + WS_SMALLW);
      const int g0 = w.gw * 64 + w.lane, gs = w.NGW * 64;
      for (int l = 0; l < NLAYER; ++l) { _Float16* S = SW + (size_t)l * SMW_LAYER;
          const float* wq = A.in[I_WQ] + (size_t)l * 128 * 256; const float* wqi = A.in[I_WQI] + (size_t)l * 128 * 256;
          for (int e = g0; e < 256 * 128; e += gs) { const int n = e >> 7, k = e & 127; S[SMW_QI + e] = (_Float16)wq[k * 256 + n]; S[SMW_QI + 256 * 128 + e] = (_Float16)wqi[k * 256 + n]; }
          const float* w2 = A.in[I_W2] + (size_t)l * 32 * 256; const float* a2 = A.in[I_A2] + (size_t)l * 32 * 256; const float* g2 = A.in[I_G2] + (size_t)l * 64 * 256;
          for (int e = g0; e < 256 * 32; e += gs) { const int n = e >> 5, k = e & 31; S[SMW_W2 + e] = (_Float16)w2[k * 256 + n]; S[SMW_A2 + e] = (_Float16)a2[k * 256 + n]; }
          for (int e = g0; e < 256 * 64; e += gs) { const int n = e >> 6, k = e & 63; S[SMW_G2 + e] = (_Float16)g2[k * 256 + n]; } } }
}
__device__ __forceinline__ void ph_norm1(ARef A, const WI& w) {
    const float* MOD = (const float*)(A.ws + WS_MOD); bf16* H = (bf16*)(A.ws + WS_H);
    for (int m = w.gw; m < MTOK; m += w.NGW) {
        const float* xr = A.in[I_X] + (size_t)m * DM; f32x4 v[4]; float ss = 0.0f;
#pragma unroll
        for (int j = 0; j < 4; ++j) { v[j] = *(const f32x4*)(xr + 4 * (w.lane + 64 * j)); ss += dot4(v[j], v[j]); }
        ss = wave_sum(ss); const float rstd = 1.0f / sqrtf(ss * (1.0f / DM) + 1e-5f);
        const float* mb = MOD + (size_t)(m >> 12) * 6144;
        emit_h_row(v, rstd, A.in[I_NMIX], mb + 1024, mb, H + (size_t)m * DM, w.lane);
    }
}

typedef _Float16 h4v __attribute__((ext_vector_type(4)));
__device__ __forceinline__ f16x8 pack_f16x8(f32x4 a, f32x4 b) { f16x8 r; r[0] = (_Float16)a.x; r[1] = (_Float16)a.y; r[2] = (_Float16)a.z; r[3] = (_Float16)a.w; r[4] = (_Float16)b.x; r[5] = (_Float16)b.y; r[6] = (_Float16)b.z; r[7] = (_Float16)b.w; return r; }
__device__ __forceinline__ void prep16(ARef A, int l, int m0, int lane_in) {
    int lane = lane_in; asm volatile("" : "+v"(lane));
    const int tk = lane & 15, q4 = lane >> 4, m = m0 + tk, t = m & (SEQ - 1);
    const float* P = (const float*)(A.ws + WS_PF); float* RWA = (float*)(A.ws + WS_RWA); const _Float16* SW = (const _Float16*)(A.ws + WS_SMALLW) + (size_t)l * SMW_LAYER;
    const float* pr = P + (size_t)m * PFW; const float* pp = pr - PFW; const float* pd = P + (size_t)m * PFW + PF_DSA; const float* mu = A.in[I_MU] + l * 896;
    const float* RT = (const float*)(A.ws + WS_ROPE) + (size_t)m * ROPE_W; const f32x4 zero4 = {0.f, 0.f, 0.f, 0.f};
    f16x8 bx[4], bc[4];
    { float ss = 0.0f; f32x4 c[4][2];
#pragma unroll
      for (int ks = 0; ks < 4; ++ks) { const int f0 = 32 * ks + 8 * q4;
          f32x4 x[2];
#pragma unroll
          for (int u = 0; u < 2; ++u) { const f32x4 z = *(const f32x4*)(pr + 768 + f0 + 4 * u); const f32x4 p = t ? *(const f32x4*)(pp + 768 + f0 + 4 * u) : zero4; x[u] = z + (p - z) * *(const f32x4*)(mu + 768 + f0 + 4 * u);
#pragma unroll
              for (int i = 0; i < 4; ++i) x[u][i] = (ks == 0) ? ftanh(x[u][i]) : (ks == 1) ? x[u][i] : sigm(x[u][i]); }
          bx[ks] = pack_f16x8(x[0], x[1]);
          c[ks][0] = *(const f32x4*)(pd + f0); c[ks][1] = *(const f32x4*)(pd + f0 + 4); ss += dot4(c[ks][0], c[ks][0]) + dot4(c[ks][1], c[ks][1]); }
      ss += __shfl_xor(ss, 16); ss += __shfl_xor(ss, 32);
      const float rstd = 1.0f / sqrtf(ss * (1.0f / 128.0f) + 1e-5f); const float* qn = A.in[I_QNORM] + l * 128;
#pragma unroll
      for (int ks = 0; ks < 4; ++ks) { const int f0 = 32 * ks + 8 * q4; bc[ks] = pack_f16x8(c[ks][0] * rstd * *(const f32x4*)(qn + f0), c[ks][1] * rstd * *(const f32x4*)(qn + f0 + 4)); } }
    const _Float16* wrow = SW + (size_t)tk * 0;
    (void)wrow;
    const int arow = lane & 15;
#pragma unroll 1
    for (int hd = 0; hd < 4; ++hd) {
        f32x4 fk[4], av[4]; float ssk = 0.0f;
#pragma unroll
        for (int j = 0; j < 4; ++j) { const int nb = 4 * hd + j, ch = 16 * nb + 4 * q4; const size_t o = (size_t)m * 256 + ch;
            const f16x8 aw = *(const f16x8*)(SW + SMW_W2 + (16 * nb + arow) * 32 + 8 * q4), aa = *(const f16x8*)(SW + SMW_A2 + (16 * nb + arow) * 32 + 8 * q4);
            const f16x8 ag0 = *(const f16x8*)(SW + SMW_G2 + (16 * nb + arow) * 64 + 8 * q4), ag1 = *(const f16x8*)(SW + SMW_G2 + (16 * nb + arow) * 64 + 32 + 8 * q4);
            const f32x4 cw = __builtin_amdgcn_mfma_f32_16x16x32_f16(aw, bx[0], *(const f32x4*)(A.in[I_W0] + l * 256 + ch), 0, 0, 0);
            const f32x4 ca = __builtin_amdgcn_mfma_f32_16x16x32_f16(aa, bx[1], *(const f32x4*)(A.in[I_A0] + l * 256 + ch), 0, 0, 0);
            f32x4 cg = __builtin_amdgcn_mfma_f32_16x16x32_f16(ag0, bx[2], zero4, 0, 0, 0); cg = __builtin_amdgcn_mfma_f32_16x16x32_f16(ag1, bx[3], cg, 0, 0, 0);
            f32x4 dec;
#pragma unroll
            for (int i = 0; i < 4; ++i) { dec[i] = fexp(-fexp(-softplusf(-cw[i]) - 0.5f)); av[j][i] = sigm(ca[i]); }
            *(f32x4*)(RWA + 1 * RWA_STRIDE + o) = dec; *(f32x4*)(RWA + 6 * RWA_STRIDE + o) = cg;
            { const f32x4 z = *(const f32x4*)(pr + 256 + ch); const f32x4 p = t ? *(const f32x4*)(pp + 256 + ch) : zero4; fk[j] = z + (p - z) * *(const f32x4*)(mu + 256 + ch); }
            const f32x4 kk = fk[j] * *(const f32x4*)(A.in[I_KK] + l * 256 + ch); ssk += dot4(kk, kk); }
        ssk += __shfl_xor(ssk, 16); ssk += __shfl_xor(ssk, 32);
        const float inrm = 1.0f / fmaxf(sqrtf(ssk), 1e-12f);
        f32x4 fr[4], km[4]; float bs = 0.0f;
#pragma unroll
        for (int j = 0; j < 4; ++j) { const int ch = 16 * (4 * hd + j) + 4 * q4;
            { const f32x4 z = *(const f32x4*)(pr + ch); const f32x4 p = t ? *(const f32x4*)(pp + ch) : zero4; fr[j] = z + (p - z) * *(const f32x4*)(mu + ch); }
            km[j] = fk[j] * (1.0f + (av[j] - 1.0f) * *(const f32x4*)(A.in[I_KA] + l * 256 + ch)); bs += dot4(fr[j] * km[j], *(const f32x4*)(A.in[I_RK] + l * 256 + ch)); }
        bs += __shfl_xor(bs, 16); bs += __shfl_xor(bs, 32);
#pragma unroll
        for (int j = 0; j < 4; ++j) { const int ch = 16 * (4 * hd + j) + 4 * q4; const size_t o = (size_t)m * 256 + ch;
            f32x4 fv; { const f32x4 z = *(const f32x4*)(pr + 512 + ch); const f32x4 p = t ? *(const f32x4*)(pp + 512 + ch) : zero4; fv = z + (p - z) * *(const f32x4*)(mu + 512 + ch); }
            const f32x4 kk = fk[j] * *(const f32x4*)(A.in[I_KK] + l * 256 + ch) * inrm;
            *(f32x4*)(RWA + 0 * RWA_STRIDE + o) = fr[j]; *(f32x4*)(RWA + 2 * RWA_STRIDE + o) = km[j]; *(f32x4*)(RWA + 3 * RWA_STRIDE + o) = fv;
            *(f32x4*)(RWA + 4 * RWA_STRIDE + o) = -kk; *(f32x4*)(RWA + 5 * RWA_STRIDE + o) = kk * av[j]; *(f32x4*)(RWA + 7 * RWA_STRIDE + o) = bs * fv; }
    }
#pragma unroll 1
    for (int nb = 0; nb < 32; ++nb) {
        f32x4 cq = zero4;
#pragma unroll
        for (int ks = 0; ks < 4; ++ks) { const f16x8 aq = *(const f16x8*)(SW + SMW_QI + (16 * nb + arow) * 128 + 32 * ks + 8 * q4); cq = __builtin_amdgcn_mfma_f32_16x16x32_f16(aq, bc[ks], cq, 0, 0, 0); }
        const int ch = 16 * (nb & 15) + 4 * q4;
        if (nb < 16) {
            if ((nb & 3) == 0) { const f32x4 ot = shx4(cq, 32); const int fi = 4 * (q4 & 1); const f32x4 cs4 = *(const f32x4*)(RT + 64 + fi), sn = *(const f32x4*)(RT + 72 + fi); cq = (q4 < 2) ? cq * cs4 - ot * sn : ot * sn + cq * cs4; }
            const f32x4 qs = cq * 0.18033688011112042f; v2u o; o.x = pk2(qs.x, qs.y); o.y = pk2(qs.z, qs.w); *(v2u*)((bf16*)(A.ws + WS_DQ) + (size_t)m * 256 + ch) = o;
        } else {
            if ((nb & 1) == 0) { const f32x4 ot = shx4(cq, 16); const f32x4 cs4 = *(const f32x4*)(RT + 80), sn = *(const f32x4*)(RT + 84); if (q4 < 2) cq = (q4 < 1) ? cq * cs4 - ot * sn : ot * sn + cq * cs4; }
            h4v hq; hq.x = (_Float16)cq.x; hq.y = (_Float16)cq.y; hq.z = (_Float16)cq.z; hq.w = (_Float16)cq.w; *(h4v*)((_Float16*)(A.ws + WS_DQI) + (size_t)m * 256 + ch) = hq;
        }
    }
#pragma unroll
    for (int j = 0; j < 4; ++j) { const int d = 16 * j + 4 * q4; f32x4 kx = *(const f32x4*)(pd + 128 + d);
        if (j == 0) { const f32x4 ot = shx4(kx, 32); const int fi = 4 * (q4 & 1); const f32x4 cs4 = *(const f32x4*)(RT + 64 + fi), sn = *(const f32x4*)(RT + 72 + fi); kx = (q4 < 2) ? kx * cs4 - ot * sn : ot * sn + kx * cs4; }
        v2u o; o.x = pk2(kx.x, kx.y); o.y = pk2(kx.z, kx.w); *(v2u*)((bf16*)(A.ws + WS_DKB) + (size_t)m * 64 + d) = o;
        const f32x4 vx = *(const f32x4*)(pd + 192 + d); v2u ov; ov.x = pk2(vx.x, vx.y); ov.y = pk2(vx.z, vx.w); *(v2u*)((bf16*)(A.ws + WS_DVB) + (size_t)m * 64 + d) = ov; }
#pragma unroll
    for (int j = 0; j < 2; ++j) { const int d = 16 * j + 4 * q4; f32x4 ki = *(const f32x4*)(pd + 256 + d);
        if (j == 0) { const f32x4 ot = shx4(ki, 16); const f32x4 cs4 = *(const f32x4*)(RT + 80), sn = *(const f32x4*)(RT + 84); if (q4 < 2) ki = (q4 < 1) ? ki * cs4 - ot * sn : ot * sn + ki * cs4; }
        h4v hk; hk.x = (_Float16)ki.x; hk.y = (_Float16)ki.y; hk.z = (_Float16)ki.z; hk.w = (_Float16)ki.w; *(h4v*)((_Float16*)(A.ws + WS_DKI) + (size_t)m * 32 + d) = hk; }
    if (q4 < 2) *(f32x4*)((float*)(A.ws + WS_DW) + (size_t)m * 8 + 4 * q4) = *(const f32x4*)(pd + 288 + 4 * q4) * 0.0625f;
}
__device__ __forceinline__ float quad_sum(float v) {
    v += __builtin_bit_cast(float, __builtin_amdgcn_mov_dpp(__builtin_bit_cast(int, v), 0xB1, 0xF, 0xF, true));
    v += __builtin_bit_cast(float, __builtin_amdgcn_mov_dpp(__builtin_bit_cast(int, v), 0x4E, 0xF, 0xF, true));
    return v;
}
__device__ __forceinline__ float oct_sum(float v) {
    v += __builtin_bit_cast(float, __builtin_amdgcn_mov_dpp(__builtin_bit_cast(int, v), 0xB1, 0xF, 0xF, true));
    v += __builtin_bit_cast(float, __builtin_amdgcn_mov_dpp(__builtin_bit_cast(int, v), 0x4E, 0xF, 0xF, true));
    v += __builtin_bit_cast(float, __builtin_amdgcn_mov_dpp(__builtin_bit_cast(int, v), 0x141, 0xF, 0xF, true));
    return v;
}
typedef float f32x2 __attribute__((ext_vector_type(2)));
#define LO2(v_) __builtin_shufflevector(v_, v_, 0, 1)
#define HI2(v_) __builtin_shufflevector(v_, v_, 2, 3)
#define RW_ROW(i_) (((i_) < 2) ? (16 * ws + rg + 8 * (i_)) : (64 + 16 * ws + rg + 8 * ((i_) - 2)))
#define RW_LOAD(op, s_) do { const int lo_ = (s_) * 64 + kq * 8; \
    op[0] = *(const LAS f32x4*)(sn + lo_); op[1] = *(const LAS f32x4*)(sn + lo_ + 4); op[2] = *(const LAS f32x4*)(sw + lo_); op[3] = *(const LAS f32x4*)(sw + lo_ + 4); \
    op[4] = *(const LAS f32x4*)(sb + lo_); op[5] = *(const LAS f32x4*)(sb + lo_ + 4); op[6] = *(const LAS f32x4*)(sk + lo_); op[7] = *(const LAS f32x4*)(sk + lo_ + 4); \
    op[8] = *(const LAS f32x4*)(sr + lo_); op[9] = *(const LAS f32x4*)(sr + lo_ + 4); \
    vin[0] = sv[(s_) * 64 + 16 * ws + rg]; vin[1] = sv[(s_) * 64 + 16 * ws + rg + 8]; } while (0)
#define RW_DOT(i_, oa, ob) ({ f32x2 d_ = S[i_][0] * LO2(oa); d_ = S[i_][1] * HI2(oa) + d_; d_ = S[i_][2] * LO2(ob) + d_; d_ = S[i_][3] * HI2(ob) + d_; d_.x + d_.y; })
#define RW_STEP(op, vv, s_) do { float sa_[4], y_[4]; \
    _Pragma("unroll") for (int i_ = 0; i_ < 4; ++i_) sa_[i_] = RW_DOT(i_, op[0], op[1]); \
    _Pragma("unroll") for (int i_ = 0; i_ < 4; ++i_) sa_[i_] += __builtin_bit_cast(float, __builtin_amdgcn_mov_dpp(__builtin_bit_cast(int, sa_[i_]), 0xB1, 0xF, 0xF, true)); \
    _Pragma("unroll") for (int i_ = 0; i_ < 4; ++i_) sa_[i_] += __builtin_bit_cast(float, __builtin_amdgcn_mov_dpp(__builtin_bit_cast(int, sa_[i_]), 0x4E, 0xF, 0xF, true)); \
    _Pragma("unroll") for (int i_ = 0; i_ < 4; ++i_) sa_[i_] += __builtin_bit_cast(float, __builtin_amdgcn_mov_dpp(__builtin_bit_cast(int, sa_[i_]), 0x141, 0xF, 0xF, true)); \
    _Pragma("unroll") for (int i_ = 0; i_ < 2; ++i_) { const f32x2 a2_ = {sa_[i_], sa_[i_]}, v2_ = {vv[i_], vv[i_]}; \
        S[i_][0] = S[i_][0] * LO2(op[2]) + (a2_ * LO2(op[4]) + v2_ * LO2(op[6])); S[i_][1] = S[i_][1] * HI2(op[2]) + (a2_ * HI2(op[4]) + v2_ * HI2(op[6])); \
        S[i_][2] = S[i_][2] * LO2(op[3]) + (a2_ * LO2(op[5]) + v2_ * LO2(op[7])); S[i_][3] = S[i_][3] * HI2(op[3]) + (a2_ * HI2(op[5]) + v2_ * HI2(op[7])); } \
    _Pragma("unroll") for (int i_ = 2; i_ < 4; ++i_) { const f32x2 a2_ = {sa_[i_], sa_[i_]}; \
        S[i_][0] = S[i_][0] * LO2(op[2]) + a2_ * LO2(op[4]); S[i_][1] = S[i_][1] * HI2(op[2]) + a2_ * HI2(op[4]); S[i_][2] = S[i_][2] * LO2(op[3]) + a2_ * LO2(op[5]); S[i_][3] = S[i_][3] * HI2(op[3]) + a2_ * HI2(op[5]); } \
    _Pragma("unroll") for (int i_ = 0; i_ < 4; ++i_) y_[i_] = RW_DOT(i_, op[8], op[9]); \
    _Pragma("unroll") for (int i_ = 0; i_ < 4; ++i_) y_[i_] += __builtin_bit_cast(float, __builtin_amdgcn_mov_dpp(__builtin_bit_cast(int, y_[i_]), 0xB1, 0xF, 0xF, true)); \
    _Pragma("unroll") for (int i_ = 0; i_ < 4; ++i_) y_[i_] += __builtin_bit_cast(float, __builtin_amdgcn_mov_dpp(__builtin_bit_cast(int, y_[i_]), 0x4E, 0xF, 0xF, true)); \
    _Pragma("unroll") for (int i_ = 0; i_ < 4; ++i_) y_[i_] += __builtin_bit_cast(float, __builtin_amdgcn_mov_dpp(__builtin_bit_cast(int, y_[i_]), 0x141, 0xF, 0xF, true)); \
    if (kq == 0) { _Pragma("unroll") for (int i_ = 0; i_ < 4; ++i_) so[(s_) * 128 + RW_ROW(i_)] = y_[i_]; } } while (0)
__device__ __forceinline__ void scan_rwkv_task2(ARef A, const WI& w, int task0) {
    const int slot = w.wave >> 2, ws = w.wave & 3, lt = w.tid & 255, task = task0 + slot;
    const int bh = task >> 4, c = task & 15, b = bh >> 2, h = bh & 3;
    LAS float* sw = (LAS float*)w.lds + slot * 16384; LAS float* sn = sw + 2048; LAS float* sb = sn + 2048; LAS float* sk = sb + 2048; LAS float* sr = sk + 2048; LAS float* sv = sr + 2048; LAS float* so = sv + 2048;
    const float* RWA = (const float*)(A.ws + WS_RWA);
    const int rg = w.lane >> 3, kq = w.lane & 7;
    f32x2 S[4][4];
#pragma unroll
    for (int i = 0; i < 4; ++i)
#pragma unroll
        for (int j = 0; j < 4; ++j) { const int r = RW_ROW(i); S[i][j].x = (r >= 64 && 8 * kq + 2 * j == r - 64) ? 1.0f : 0.0f; S[i][j].y = (r >= 64 && 8 * kq + 2 * j + 1 == r - 64) ? 1.0f : 0.0f; }
    const size_t tok0 = (size_t)b * SEQ + (size_t)c * TCH;
    const int st = lt >> 3, sd = (lt & 7) * 8;
    f32x4 a[6][2];
#define RW_GLOAD(sub_) do { const size_t o_ = (tok0 + (sub_) * 32 + st) * 256 + h * 64 + sd; \
        _Pragma("unroll") for (int q = 0; q < 2; ++q) { a[0][q] = *(const f32x4*)(RWA + 1 * RWA_STRIDE + o_ + 4 * q); a[1][q] = *(const f32x4*)(RWA + 4 * RWA_STRIDE + o_ + 4 * q); a[2][q] = *(const f32x4*)(RWA + 5 * RWA_STRIDE + o_ + 4 * q); \
            a[3][q] = *(const f32x4*)(RWA + 2 * RWA_STRIDE + o_ + 4 * q); a[4][q] = *(const f32x4*)(RWA + 0 * RWA_STRIDE + o_ + 4 * q); a[5][q] = *(const f32x4*)(RWA + 3 * RWA_STRIDE + o_ + 4 * q); } } while (0)
    RW_GLOAD(0);
    for (int sub = 0; sub < TCH / 32; ++sub) {
        __syncthreads();
        { const int lo = st * 64 + sd;
#pragma unroll
          for (int q = 0; q < 2; ++q) { *(LAS f32x4*)(sw + lo + 4 * q) = a[0][q]; *(LAS f32x4*)(sn + lo + 4 * q) = a[1][q]; *(LAS f32x4*)(sb + lo + 4 * q) = a[2][q]; *(LAS f32x4*)(sk + lo + 4 * q) = a[3][q]; *(LAS f32x4*)(sr + lo + 4 * q) = a[4][q]; *(LAS f32x4*)(sv + lo + 4 * q) = a[5][q]; } }
        __syncthreads();
        if (sub + 1 < TCH / 32) RW_GLOAD(sub + 1);
        { f32x4 opA[10], opB[10]; float vin[2], vA[2], vB[2];
          RW_LOAD(opA, 0);
          vA[0] = vin[0]; vA[1] = vin[1];
#pragma unroll 1
          for (int s = 0; s < 32; s += 2) {
              RW_LOAD(opB, s + 1);
              vB[0] = vin[0]; vB[1] = vin[1];
              RW_STEP(opA, vA, s);
              if (s + 2 < 32) { RW_LOAD(opA, s + 2); vA[0] = vin[0]; vA[1] = vin[1]; }
              RW_STEP(opB, vB, s + 1);
          } }
        __syncthreads();
        { const int fs = lt >> 3, c16 = (lt & 7) * 16;
          float* dst = (c16 < 64) ? ((float*)(A.ws + WS_YO) + YO_STRIDE) : ((float*)(A.ws + WS_PT) - 64);
          float* dp = dst + (tok0 + sub * 32 + fs) * 256 + h * 64 + c16;
#pragma unroll
          for (int q = 0; q < 4; ++q) *(f32x4*)(dp + 4 * q) = *(const LAS f32x4*)(so + fs * 128 + c16 + 4 * q); }
    }
    { float* ch = (float*)(A.ws + WS_CH) + ((size_t)(bh * NCH + c) * 128) * 64 + 8 * kq;
#pragma unroll
      for (int i = 0; i < 4; ++i) { float* cr = ch + (size_t)RW_ROW(i) * 64; *(f32x4*)cr = (f32x4){S[i][0].x, S[i][0].y, S[i][1].x, S[i][1].y}; *(f32x4*)(cr + 4) = (f32x4){S[i][2].x, S[i][2].y, S[i][3].x, S[i][3].y}; } }
    __syncthreads();
}
#undef RW_LOAD
#undef RW_STEP
#undef RW_GLOAD
#undef RW_DOT
#undef RW_ROW
__device__ __forceinline__ void scan_ret_task(ARef A, const WI& w, int task) {
    const int bh = task >> 3, cp = task & 7, b = bh >> 2, h = bh & 3, un = w.tid >> 8, lt = w.tid & 255, c = 2 * cp + un;
    const float lg2g = log2f(1.0f - exp2f(-5.0f - (float)h)), gamma = exp2f(lg2g);
    LAS float* sk = (LAS float*)w.lds + un * 8192; LAS float* sq = sk + 2048; LAS float* sv = sq + 2048; LAS float* so = sv + 2048;
    const bf16* PB = (const bf16*)(A.ws + WS_PB); const float* RT = (const float*)(A.ws + WS_ROPE);
    const int row = lt >> 2, kq = lt & 3;
    f32x2 S[8];
#pragma unroll
    for (int j = 0; j < 8; ++j) S[j] = (f32x2){0.0f, 0.0f};
    const f32x2 gam2 = {gamma, gamma};
    const size_t tok0 = (size_t)b * SEQ + (size_t)c * TCH;
    const int st = lt >> 3, sd = (lt & 7) * 8;
    const int fi = sd & 31, dp = sd ^ 32;
    f32x4 gq[2], gqo[2], gk[2], gko[2], gv[2], gcs[2], gsn[2];
#define BF8_TO_F32(dst, x_) do { dst[0] = (f32x4){bf_lo(x_.x), bf_hi(x_.x), bf_lo(x_.y), bf_hi(x_.y)}; dst[1] = (f32x4){bf_lo(x_.z), bf_hi(x_.z), bf_lo(x_.w), bf_hi(x_.w)}; } while (0)
#define RT_GLOAD(sub_) do { const size_t m_ = tok0 + (sub_) * 32 + st; const bf16* pr_ = PB + m_ * PBW + h * 64; const float* rt_ = RT + m_ * ROPE_W; \
        _Pragma("unroll") for (int u = 0; u < 2; ++u) { gcs[u] = *(const f32x4*)(rt_ + fi + 4 * u); gsn[u] = *(const f32x4*)(rt_ + 32 + fi + 4 * u); } \
        { const v4u x0 = *(const v4u*)(pr_ + sd), x1 = *(const v4u*)(pr_ + dp), x2 = *(const v4u*)(pr_ + 256 + sd), x3 = *(const v4u*)(pr_ + 256 + dp), x4 = *(const v4u*)(pr_ + 512 + sd); \
          BF8_TO_F32(gq, x0); BF8_TO_F32(gqo, x1); BF8_TO_F32(gk, x2); BF8_TO_F32(gko, x3); BF8_TO_F32(gv, x4); } } while (0)
    RT_GLOAD(0);
    for (int sub = 0; sub < TCH / 32; ++sub) {
        const size_t m = tok0 + sub * 32 + st;
        f32x4 qn[2], kn[2], vn[2];
#pragma unroll
        for (int u = 0; u < 2; ++u) { qn[u] = (sd < 32) ? gq[u] * gcs[u] - gqo[u] * gsn[u] : gqo[u] * gsn[u] + gq[u] * gcs[u]; kn[u] = (sd < 32) ? gk[u] * gcs[u] - gko[u] * gsn[u] : gko[u] * gsn[u] + gk[u] * gcs[u]; vn[u] = gv[u]; }
        { const float gt = exp2f(lg2g * (float)(sub * 32 + st + 1)); const f32x4 p0 = qn[0] * gt, p1 = qn[1] * gt;
          v4u pw; pw.x = pk2(p0.x, p0.y); pw.y = pk2(p0.z, p0.w); pw.z = pk2(p1.x, p1.y); pw.w = pk2(p1.z, p1.w); *(v4u*)((bf16*)(A.ws + WS_PTR) + m * 256 + h * 64 + sd) = pw; }
        __syncthreads();
        { const int lo = st * 64 + sd; *(LAS f32x4*)(sq + lo) = qn[0]; *(LAS f32x4*)(sq + lo + 4) = qn[1]; *(LAS f32x4*)(sk + lo) = kn[0]; *(LAS f32x4*)(sk + lo + 4) = kn[1]; *(LAS f32x4*)(sv + lo) = vn[0]; *(LAS f32x4*)(sv + lo + 4) = vn[1]; }
        __syncthreads();
        if (sub + 1 < TCH / 32) RT_GLOAD(sub + 1);
        for (int s = 0; s < 32; ++s) {
            const int lo = s * 64 + kq * 16; const float vv = sv[s * 64 + row]; const f32x2 v2 = {vv, vv}; f32x2 y2 = {0.0f, 0.0f};
#pragma unroll
            for (int j4 = 0; j4 < 4; ++j4) { const f32x4 kv = *(const LAS f32x4*)(sk + lo + 4 * j4), rv = *(const LAS f32x4*)(sq + lo + 4 * j4);
                S[2 * j4] = S[2 * j4] * gam2 + v2 * LO2(kv); S[2 * j4 + 1] = S[2 * j4 + 1] * gam2 + v2 * HI2(kv);
                y2 = S[2 * j4] * LO2(rv) + y2; y2 = S[2 * j4 + 1] * HI2(rv) + y2; }
            float y = quad_sum(y2.x + y2.y);
            if (kq == 0) so[s * 64 + row] = y;
        }
        __syncthreads();
        { const int fs = lt >> 3, c8 = (lt & 7) * 8; float* dp2 = (float*)(A.ws + WS_YO) + (tok0 + sub * 32 + fs) * 256 + h * 64 + c8;
          *(f32x4*)dp2 = *(const LAS f32x4*)(so + fs * 64 + c8); *(f32x4*)(dp2 + 4) = *(const LAS f32x4*)(so + fs * 64 + c8 + 4); }
    }
    { float* ch = (float*)(A.ws + WS_CHR) + ((size_t)(bh * NCH + c) * 64 + row) * 64 + 16 * kq;
#pragma unroll
      for (int j4 = 0; j4 < 4; ++j4) *(f32x4*)(ch + 4 * j4) = (f32x4){S[2 * j4].x, S[2 * j4].y, S[2 * j4 + 1].x, S[2 * j4 + 1].y}; }
    __syncthreads();
}
#undef RT_GLOAD
#undef BF8_TO_F32
__device__ __forceinline__ void prefix_chain(ARef A, const WI& w, int bh) {
    LAS float* s0 = (LAS float*)w.lds;
    const int v = w.tid >> 3, k8 = (w.tid & 7) * 8;
    const float* CH = (const float*)(A.ws + WS_CH) + (size_t)bh * NCH * 128 * 64; float* SI = (float*)(A.ws + WS_SI) + (size_t)bh * NCH * 64 * 64;
    f32x4 c0 = {0.f, 0.f, 0.f, 0.f}, c1 = {0.f, 0.f, 0.f, 0.f};
    for (int c = 0; c < NCH; ++c) {
        *(f32x4*)(SI + ((size_t)c * 64 + v) * 64 + k8) = c0; *(f32x4*)(SI + ((size_t)c * 64 + v) * 64 + k8 + 4) = c1;
        if (c == NCH - 1) break;
        __syncthreads();
        *(LAS f32x4*)(s0 + v * 68 + k8) = c0; *(LAS f32x4*)(s0 + v * 68 + k8 + 4) = c1;
        __syncthreads();
        const float* ch = CH + (size_t)c * 128 * 64;
        f32x4 n0 = *(const f32x4*)(ch + (size_t)v * 64 + k8), n1 = *(const f32x4*)(ch + (size_t)v * 64 + k8 + 4);
#pragma unroll 8
        for (int kp = 0; kp < 64; ++kp) { const float s = s0[v * 68 + kp]; const float* pr = ch + (size_t)(64 + kp) * 64 + k8; n0 += s * *(const f32x4*)pr; n1 += s * *(const f32x4*)(pr + 4); }
        c0 = n0; c1 = n1;
    }
    const int h = bh & 3; const float gT = exp2f((float)TCH * log2f(1.0f - exp2f(-5.0f - (float)h)));
    const float* CHR = (const float*)(A.ws + WS_CHR) + (size_t)bh * NCH * 64 * 64; float* SIR = (float*)(A.ws + WS_SIR) + (size_t)bh * NCH * 64 * 64;
    c0 = (f32x4){0.f, 0.f, 0.f, 0.f}; c1 = c0;
    for (int c = 0; c < NCH; ++c) {
        *(f32x4*)(SIR + ((size_t)c * 64 + v) * 64 + k8) = c0; *(f32x4*)(SIR + ((size_t)c * 64 + v) * 64 + k8 + 4) = c1;
        if (c == NCH - 1) break;
        c0 = c0 * gT + *(const f32x4*)(CHR + ((size_t)c * 64 + v) * 64 + k8); c1 = c1 * gT + *(const f32x4*)(CHR + ((size_t)c * 64 + v) * 64 + k8 + 4);
    }
    __syncthreads();
}
typedef float f32x16 __attribute__((ext_vector_type(16)));
constexpr int SBV_PITCH = 144;
__device__ __forceinline__ float lane32_swap(float v) { return __shfl_xor(v, 32); }
__device__ __forceinline__ void sb_tile_mfma(ARef A, int unit, int lane, LAS unsigned char* vl) {
    const int tq = unit & 127, bh = unit >> 7, b = bh >> 2, h = bh & 3, t0 = tq * 32, r32 = lane & 31, hi = lane >> 5;
    const bf16* PS = (const bf16*)(A.ws + WS_PB) + (size_t)b * SEQ * PBW + PB_SB + h * 64;
    bf16x8v qf[4];
#pragma unroll
    for (int ks = 0; ks < 4; ++ks) qf[ks] = *(const bf16x8v*)(PS + (size_t)(t0 + r32) * PBW + 16 * ks + 8 * hi);
    f32x16 o0, o1;
#pragma unroll
    for (int r = 0; r < 16; ++r) { o0[r] = 0.0f; o1[r] = 0.0f; }
    float carry = 0.0f;
    const int g16 = lane >> 4, tj = (lane & 15) >> 2, tc = lane & 3;
    for (int kb0 = t0; kb0 >= 0; kb0 -= 32) {
#pragma unroll
        for (int i = 0; i < 4; ++i) { const int p = lane + 64 * i, row = p >> 3, ch = p & 7; const v4u v = *(const v4u*)(PS + 512 + (size_t)(kb0 + row) * PBW + 8 * ch); *(LAS v4u*)(vl + row * SBV_PITCH + 16 * ch) = v; }
        f32x16 st;
#pragma unroll
        for (int r = 0; r < 16; ++r) st[r] = 0.0f;
        { bf16x8v ka[4];
#pragma unroll
          for (int ks = 0; ks < 4; ++ks) ka[ks] = *(const bf16x8v*)(PS + 256 + (size_t)(kb0 + r32) * PBW + 16 * ks + 8 * hi);
#pragma unroll
          for (int ks = 0; ks < 4; ++ks) st = __builtin_amdgcn_mfma_f32_32x32x16_bf16(ka[ks], qf[ks], st, 0, 0, 0);
          asm volatile("" :: "v"(ka[0]), "v"(ka[1]), "v"(ka[2]), "v"(ka[3]), "v"(st)); }
        float sp[16]; const bool diag = (kb0 == t0);
#pragma unroll
        for (int r = 0; r < 16; ++r) { const float zl = st[r]; float s = (zl > 30.0f) ? zl : __builtin_amdgcn_logf(1.0f + __builtin_amdgcn_exp2f(zl));
            if (diag && ((r & 3) + 8 * (r >> 2) + 4 * hi >= r32)) s = 0.0f;
            sp[r] = s; }
        float G[4], Gp[4], suf[4];
#pragma unroll
        for (int q = 0; q < 4; ++q) { G[q] = (sp[4 * q] + sp[4 * q + 1]) + (sp[4 * q + 2] + sp[4 * q + 3]); Gp[q] = lane32_swap(G[q]); }
        suf[3] = 0.0f; suf[2] = G[3] + Gp[3]; suf[1] = suf[2] + (G[2] + Gp[2]); suf[0] = suf[1] + (G[1] + Gp[1]);
        const float tot = suf[0] + (G[0] + Gp[0]);
        pg8::u32x4 pw0, pw1;
        float av[16];
#pragma unroll
        for (int q = 0; q < 4; ++q) { float run = carry + suf[q] + (hi == 0 ? Gp[q] : 0.0f);
#pragma unroll
            for (int i = 3; i >= 0; --i) { const int r = 4 * q + i; const float la = (st[r] - sp[r]) - run; float a = __builtin_amdgcn_exp2f(la);
                if (diag && ((r & 3) + 8 * (r >> 2) + 4 * hi >= r32)) a = 0.0f;
                av[r] = a; run += sp[r]; } }
        pw0.x = pg8::cvt_pk_bf16(av[0], av[1]); pw0.y = pg8::cvt_pk_bf16(av[2], av[3]); pw0.z = pg8::cvt_pk_bf16(av[4], av[5]); pw0.w = pg8::cvt_pk_bf16(av[6], av[7]);
        pw1.x = pg8::cvt_pk_bf16(av[8], av[9]); pw1.y = pg8::cvt_pk_bf16(av[10], av[11]); pw1.z = pg8::cvt_pk_bf16(av[12], av[13]); pw1.w = pg8::cvt_pk_bf16(av[14], av[15]);
        const bf16x8v pa0 = __builtin_bit_cast(bf16x8v, pw0), pa1 = __builtin_bit_cast(bf16x8v, pw1);
        LDS_WAIT();
#pragma unroll
        for (int s = 0; s < 2; ++s)
#pragma unroll
            for (int nb = 0; nb < 2; ++nb) {
                LAS unsigned char* a1 = vl + (16 * s + 4 * (g16 >> 1) + tj) * SBV_PITCH + (32 * nb + 16 * (g16 & 1) + 4 * tc) * 2;
                const s16x4v r1 = __builtin_bit_cast(s16x4v, __builtin_amdgcn_ds_read_tr16_b64_v4i16((LAS s16x4v*)a1));
                const s16x4v r2 = __builtin_bit_cast(s16x4v, __builtin_amdgcn_ds_read_tr16_b64_v4i16((LAS s16x4v*)(a1 + 8 * SBV_PITCH)));
                const bf16x8v bv = {r1[0], r1[1], r1[2], r1[3], r2[0], r2[1], r2[2], r2[3]};
                if (nb == 0) o0 = __builtin_amdgcn_mfma_f32_32x32x16_bf16(s ? pa1 : pa0, bv, o0, 0, 0, 0); else o1 = __builtin_amdgcn_mfma_f32_32x32x16_bf16(s ? pa1 : pa0, bv, o1, 0, 0, 0);
                asm volatile("" :: "v"(bv), "v"(pa0), "v"(pa1), "v"(o0), "v"(o1)); }
        LDS_WAIT();
        carry += tot;
        if (__all(carry > 150.0f)) break;
    }
    float* YS = (float*)(A.ws + WS_YO) + 3 * YO_STRIDE + ((size_t)b * SEQ + t0) * 256 + h * 64 + r32;
#pragma unroll
    for (int r = 0; r < 16; ++r) { const int qo = (r & 3) + 8 * (r >> 2) + 4 * hi; YS[(size_t)qo * 256] = o0[r]; YS[(size_t)qo * 256 + 32] = o1[r]; }
}

__device__ __forceinline__ void dsa_scores_mfma(ARef A, const WI& w) {
    const _Float16* QIH = (const _Float16*)(A.ws + WS_DQI); const _Float16* KIH = (const _Float16*)(A.ws + WS_DKI);
    const float* DW = (const float*)(A.ws + WS_DW); float* SC = (float*)(A.ws + WS_SC);
    const int col = w.lane & 15, q4 = w.lane >> 4;
    for (int u = w.gw; u < 2048; u += w.NGW) {
        const int pi = u >> 1, par = u & 1, b = pi >> 7, p = pi & 127;
#pragma unroll 1
        for (int side = 0; side < 2; ++side) {
            const int qb = side ? 255 - p : p; const size_t m0 = (size_t)b * SEQ + 16 * qb;
            f16x8 bq[8];
#pragma unroll
            for (int h = 0; h < 8; ++h) bq[h] = *(const f16x8*)(QIH + (m0 + col) * 256 + h * 32 + 8 * q4);
            const float* dw = DW + (m0 + col) * 8; const f32x4 wa = *(const f32x4*)dw, wb = *(const f32x4*)(dw + 4);
            float* srow = SC + (m0 + col) * SEQ + 4 * q4;
            const _Float16* kbase = KIH + ((size_t)b * SEQ + col) * 32 + 8 * q4;
            for (int kp = par; 2 * kp <= qb; kp += 2) {
#pragma unroll
                for (int sub = 0; sub < 2; ++sub) { const int kb = 2 * kp + sub; if (kb > qb) break;
                    const f16x8 ak = *(const f16x8*)(kbase + (size_t)kb * 16 * 32);
                    f32x4 acc = {0.f, 0.f, 0.f, 0.f};
#pragma unroll
                    for (int h = 0; h < 8; ++h) { const f32x4 c = __builtin_amdgcn_mfma_f32_16x16x32_f16(ak, bq[h], (f32x4){0.f, 0.f, 0.f, 0.f}, 0, 0, 0); const float wv = (h < 4) ? wa[h] : wb[h - 4];
                        acc.x += wv * fmaxf(c.x, 0.f); acc.y += wv * fmaxf(c.y, 0.f); acc.z += wv * fmaxf(c.z, 0.f); acc.w += wv * fmaxf(c.w, 0.f); }
                    *(f32x4*)(srow + 16 * kb) = acc + 0.0f; }
            }
        }
    }
}

__device__ __forceinline__ int wave_total_i(int v) {
    v += __builtin_amdgcn_mov_dpp(v, 0xB1, 0xF, 0xF, true);
    v += __builtin_amdgcn_mov_dpp(v, 0x4E, 0xF, 0xF, true);
    v += __builtin_amdgcn_mov_dpp(v, 0x141, 0xF, 0xF, true);
    v += __builtin_amdgcn_mov_dpp(v, 0x140, 0xF, 0xF, true);
    return __builtin_amdgcn_readlane(v, 0) + __builtin_amdgcn_readlane(v, 16) + __builtin_amdgcn_readlane(v, 32) + __builtin_amdgcn_readlane(v, 48);
}
__device__ __forceinline__ unsigned score_key(float f) { const unsigned bits = __float_as_uint(f); return (bits & 0x80000000u) ? ~bits : (bits | 0x80000000u); }
constexpr int VST_PITCH = 144;
typedef unsigned short u16;
__device__ __forceinline__ void dsa_load_scores(ARef A, int m, int lane, f32x4 (&sv)[16]) {
    const int n = (m & (SEQ - 1)) + 1; const float* sc = (const float*)(A.ws + WS_SC) + (size_t)m * SEQ;
#pragma unroll
    for (int j4 = 0; j4 < 16; ++j4) sv[j4] = *(const f32x4*)(sc + ((256 * j4 < n) ? 256 * j4 : 0) + 4 * lane);
}
__device__ __forceinline__ void dsa_select(ARef A, int m, int n, int lane_in, LAS u16* slist, LAS unsigned* bk) {
    int lane = lane_in; asm volatile("" : "+v"(lane));
    if (n <= 256) {
#pragma unroll
        for (int c = 0; c < 4; ++c) { const int idx = lane + 64 * c; slist[idx] = (u16)((idx < n) ? idx : 0); }
        return;
    }
    f32x4 sv[16]; dsa_load_scores(A, m, lane, sv);
    unsigned u[64];
#pragma unroll
    for (int j4 = 0; j4 < 16; ++j4)
#pragma unroll
        for (int i = 0; i < 4; ++i) u[4 * j4 + i] = (256 * j4 + 4 * lane + i < n) ? score_key(sv[j4][i]) : 0u;
    unsigned T = 0u;
    for (int bit = 31; bit >= 16; --bit) { const unsigned cand = T | (1u << bit); int cnt = 0;
#pragma unroll
        for (int j = 0; j < 64; ++j) cnt += (u[j] >= cand) ? 1 : 0;
        if (wave_total_i(cnt) >= 256) T = cand; }
    unsigned long long bkb = 0ull; int chi = 0;
#pragma unroll
    for (int j = 0; j < 64; ++j) { bkb |= (unsigned long long)(((u[j] >> 16) == (T >> 16)) ? 1u : 0u) << j; chi += ((u[j] >> 16) > (T >> 16)) ? 1 : 0; }
    const int cb = wave_total_i(__popcll(bkb)), need = 256 - wave_total_i(chi);
    if (cb <= 64) {
        int pos = __popcll(bkb);
        { const int mine_ = pos;
#pragma unroll
          for (int d = 1; d < 64; d <<= 1) { const int y = __shfl_up(pos, d); if (lane >= d) pos += y; }
          pos -= mine_; }
#pragma unroll
        for (int j = 0; j < 64; ++j) { if ((bkb >> j) & 1ull) { bk[pos] = u[j]; ++pos; } }
        LDS_WAIT();
        const unsigned kx = (lane < cb) ? bk[lane] : 0u;
        for (int bit = 15; bit >= 0; --bit) { const unsigned cand = T | (1u << bit); if (__popcll(__ballot(kx >= cand)) >= need) T = cand; }
        LDS_WAIT();
    } else {
        for (int bit = 15; bit >= 0; --bit) { const unsigned cand = T | (1u << bit); int cnt = 0;
#pragma unroll
            for (int j = 0; j < 64; ++j) cnt += (u[j] >= cand) ? 1 : 0;
            if (wave_total_i(cnt) >= 256) T = cand; }
    }
    unsigned long long gtb = 0ull, eqb = 0ull;
#pragma unroll
    for (int j = 0; j < 64; ++j) { gtb |= (unsigned long long)((u[j] > T) ? 1u : 0u) << j; eqb |= (unsigned long long)((u[j] == T) ? 1u : 0u) << j; }
    const int tgt = wave_total_i(__popcll(gtb)), teq = wave_total_i(__popcll(eqb));
    unsigned long long selb = gtb | eqb;
    if (tgt + teq > 256) {
        const int take = 256 - tgt; int lo = 0;
        for (int bit = 11; bit >= 0; --bit) { const int cand = lo | (1 << bit); const int J4 = cand >> 8; int ni = (cand & 255) - 4 * lane; ni = ni < 0 ? 0 : (ni > 4 ? 4 : ni);
            const int jc = 4 * J4 + ni; const unsigned long long msk = (jc >= 64) ? ~0ull : ((1ull << jc) - 1ull);
            if (wave_total_i(__popcll(eqb & msk)) < take) lo = cand; }
        { const int cand = lo + 1; const int J4 = cand >> 8; int ni = (cand & 255) - 4 * lane; ni = ni < 0 ? 0 : (ni > 4 ? 4 : ni);
          const int jc = (cand >= SEQ) ? 64 : 4 * J4 + ni; const unsigned long long msk = (jc >= 64) ? ~0ull : ((1ull << jc) - 1ull); selb = gtb | (eqb & msk); }
    }
    const int mine = __popcll(selb); int off = mine;
#pragma unroll
    for (int d = 1; d < 64; d <<= 1) { const int y = __shfl_up(off, d); if (lane >= d) off += y; }
    off -= mine;
    while (selb) { const int j = __builtin_ctzll(selb); selb &= selb - 1ull; slist[off] = (u16)(256 * (j >> 2) + 4 * lane + (j & 3)); ++off; }
}
__device__ __forceinline__ void dsa_attend(ARef A, int m, int lane_in, const LAS u16* slist, LAS unsigned char* vbuf) {
    int lane = lane_in; asm volatile("" : "+v"(lane));
    const int b = m >> 12, t = m & (SEQ - 1), n = t + 1, nsel = n < 256 ? n : 256, col = lane & 15, q4 = lane >> 4;
    const bf16* DKB = (const bf16*)(A.ws + WS_DKB) + (size_t)b * SEQ * 64; const bf16* DVB = (const bf16*)(A.ws + WS_DVB) + (size_t)b * SEQ * 64;
    const int vrow = lane >> 3, vpc = lane & 7;
    bf16x8v bq0 = {0, 0, 0, 0, 0, 0, 0, 0}, bq1 = {0, 0, 0, 0, 0, 0, 0, 0};
    if (col < 4) { const bf16* qp = (const bf16*)(A.ws + WS_DQ) + (size_t)m * 256 + col * 64 + 8 * q4; bq0 = *(const bf16x8v*)qp; bq1 = *(const bf16x8v*)(qp + 32); }
    f32x4 lg[16];
#pragma unroll
    for (int hb = 0; hb < 2; ++hb) {
        bf16x8v a0[8], a1[8];
#pragma unroll
        for (int k = 0; k < 8; ++k) { const int s = slist[16 * (8 * hb + k) + col]; const bf16* kr = DKB + (size_t)s * 64 + 8 * q4; a0[k] = *(const bf16x8v*)kr; a1[k] = *(const bf16x8v*)(kr + 32); }
#pragma unroll
        for (int k = 0; k < 8; ++k) { const f32x4 c = __builtin_amdgcn_mfma_f32_16x16x32_bf16(a0[k], bq0, (f32x4){0.f, 0.f, 0.f, 0.f}, 0, 0, 0); lg[8 * hb + k] = __builtin_amdgcn_mfma_f32_16x16x32_bf16(a1[k], bq1, c, 0, 0, 0); }
        __builtin_amdgcn_sched_barrier(0);
    }
    if (nsel < 256) {
#pragma unroll
        for (int kb = 0; kb < 16; ++kb)
#pragma unroll
            for (int r = 0; r < 4; ++r) if (16 * kb + 4 * q4 + r >= nsel) lg[kb][r] = -INFINITY; }
    v4u vr[4];
#pragma unroll
    for (int i = 0; i < 4; ++i) { const int s = slist[vrow + 8 * i]; vr[i] = *(const v4u*)(DVB + (size_t)s * 64 + 8 * vpc); }
    float mx = -INFINITY;
#pragma unroll
    for (int kb = 0; kb < 16; ++kb) mx = fmaxf(fmaxf(mx, fmaxf(lg[kb].x, lg[kb].y)), fmaxf(lg[kb].z, lg[kb].w));
    mx = fmaxf(mx, __shfl_xor(mx, 16)); mx = fmaxf(mx, __shfl_xor(mx, 32));
    float sm = 0.f;
#pragma unroll
    for (int kb = 0; kb < 16; ++kb) { lg[kb].x = __builtin_amdgcn_exp2f(lg[kb].x - mx); lg[kb].y = __builtin_amdgcn_exp2f(lg[kb].y - mx); lg[kb].z = __builtin_amdgcn_exp2f(lg[kb].z - mx); lg[kb].w = __builtin_amdgcn_exp2f(lg[kb].w - mx); sm += (lg[kb].x + lg[kb].y) + (lg[kb].z + lg[kb].w); }
    sm += __shfl_xor(sm, 16); sm += __shfl_xor(sm, 32);
    const float inv = 1.0f / sm;
    bf16x8v pa[8];
#pragma unroll
    for (int i = 0; i < 8; ++i) { const f32x4 x = lg[2 * i] * inv, y = lg[2 * i + 1] * inv;
        pg8::u32x4 wv; wv.x = pg8::cvt_pk_bf16(x.x, x.y); wv.y = pg8::cvt_pk_bf16(x.z, x.w); wv.z = pg8::cvt_pk_bf16(y.x, y.y); wv.w = pg8::cvt_pk_bf16(y.z, y.w);
        pa[i] = __builtin_bit_cast(bf16x8v, wv); }
    f32x4 o[4];
#pragma unroll
    for (int nb = 0; nb < 4; ++nb) o[nb] = (f32x4){0.f, 0.f, 0.f, 0.f};
    const int tj = col >> 2, tc = col & 3;
#pragma unroll
    for (int c = 0; c < 8; ++c) {
        LAS unsigned char* vb = vbuf + (c & 1) * (32 * VST_PITCH);
#pragma unroll
        for (int i = 0; i < 4; ++i) *(LAS v4u*)(vb + (vrow + 8 * i) * VST_PITCH + 16 * vpc) = vr[i];
        if (c < 7) {
#pragma unroll
            for (int i = 0; i < 4; ++i) { const int s = slist[32 * (c + 1) + vrow + 8 * i]; vr[i] = *(const v4u*)(DVB + (size_t)s * 64 + 8 * vpc); } }
        LDS_WAIT();
#pragma unroll
        for (int nb = 0; nb < 4; ++nb) {
            LAS unsigned char* a1 = vb + (4 * q4 + tj) * VST_PITCH + (16 * nb + 4 * tc) * 2;
            const s16x4v r1 = __builtin_bit_cast(s16x4v, __builtin_amdgcn_ds_read_tr16_b64_v4i16((LAS s16x4v*)a1));
            const s16x4v r2 = __builtin_bit_cast(s16x4v, __builtin_amdgcn_ds_read_tr16_b64_v4i16((LAS s16x4v*)(a1 + 16 * VST_PITCH)));
            const bf16x8v bv = {r1[0], r1[1], r1[2], r1[3], r2[0], r2[1], r2[2], r2[3]};
            o[nb] = __builtin_amdgcn_mfma_f32_16x16x32_bf16(pa[c], bv, o[nb], 0, 0, 0); }
    }
    LDS_WAIT();
    if (lane < 16) { float* YD = (float*)(A.ws + WS_YO) + 2 * YO_STRIDE + (size_t)m * 256;
#pragma unroll
        for (int nb = 0; nb < 4; ++nb) { YD[16 * nb + lane] = o[nb].x; YD[64 + 16 * nb + lane] = o[nb].y; YD[128 + 16 * nb + lane] = o[nb].z; YD[192 + 16 * nb + lane] = o[nb].w; } }
}
__device__ __forceinline__ int dsa_row_of(int batch, int gi, int r) { const int h = 4 * gi + (r >> 1); return batch * SEQ + ((r & 1) ? (SEQ - 1 - h) : h); }
__device__ __forceinline__ void dsa_wave(ARef A, const WI& w, LAS unsigned char* wl, int qi) {
    LAS u16* lists = (LAS u16*)wl; LAS unsigned char* vbuf = wl + 4096; LAS unsigned* bk = (LAS unsigned*)vbuf;
#pragma unroll 1
    for (int kb = 0; kb < NB; ++kb) {
        const int batch = (w.bx + kb) & (NB - 1);
        unsigned* head = (unsigned*)(A.ws + WS_CTL) + CW_DSAQ + 128 * qi + 16 * batch;
        for (;;) {
            int g = 0; if (w.lane == 0) g = (int)atomicAdd(head, 1u);
            g = __builtin_amdgcn_readfirstlane(g);
            if (g >= SEQ / 8) break;
#pragma unroll 1
            for (int r = 0; r < 8; ++r) { const int m = dsa_row_of(batch, g, r), n = (m & (SEQ - 1)) + 1; dsa_select(A, m, n, w.lane, lists + r * 256, bk); }
            LDS_WAIT();
#pragma unroll 1
            for (int r = 0; r < 8; ++r) dsa_attend(A, dsa_row_of(batch, g, r), w.lane, lists + r * 256, vbuf);
        }
    }
}

__device__ __forceinline__ f32x4 head_norm4(f32x4 y, float eps, f32x4 g) {
    const float mean = grp16_sum(sum4(y)) * (1.0f / 64.0f); const f32x4 yc = y - mean;
    const float var = grp16_sum(dot4(yc, yc)) * (1.0f / 64.0f); return yc * (1.0f / sqrtf(var + eps)) * g;
}
template <bool BF> __device__ __forceinline__ f32x4 state_corr(const LAS float* sl, int hh, int r16, const void* pv) {
    const LAS float* r0 = sl + (hh * 64 + 4 * r16) * 64; const int x0 = (4 * r16) & 15;
    f32x4 out = {0.f, 0.f, 0.f, 0.f};
#pragma unroll 2
    for (int k8 = 0; k8 < 8; ++k8) {
        f32x4 pa, pb;
        if (BF) { const v4u x = ((const v4u*)pv)[k8]; pa = (f32x4){bf_lo(x.x), bf_hi(x.x), bf_lo(x.y), bf_hi(x.y)}; pb = (f32x4){bf_lo(x.z), bf_hi(x.z), bf_lo(x.w), bf_hi(x.w)}; }
        else { pa = ((const f32x4*)pv)[2 * k8]; pb = ((const f32x4*)pv)[2 * k8 + 1]; }
#pragma unroll
        for (int i = 0; i < 4; ++i) { const LAS float* rowp = r0 + i * 64; const int xs = (x0 + i) & 15;
            out[i] += dot4(*(const LAS f32x4*)(rowp + 4 * ((2 * k8) ^ xs)), pa) + dot4(*(const LAS f32x4*)(rowp + 4 * ((2 * k8 + 1) ^ xs)), pb); }
    }
    return out;
}
__device__ __forceinline__ void post_row(ARef A, int l, int m, int lane, const LAS float* slw, const LAS float* slr) {
    const float* YO = (const float*)(A.ws + WS_YO); const float* RWA = (const float*)(A.ws + WS_RWA);
    bf16* MX = (bf16*)(A.ws + WS_MIX) + (size_t)m * DM; const int c4 = 4 * lane, hh = lane >> 4, r16 = lane & 15; const size_t o = (size_t)m * 256 + c4;
    { f32x4 y = *(const f32x4*)(YO + o) + state_corr<true>(slr, hh, r16, (const bf16*)(A.ws + WS_PTR) + (size_t)m * 256 + hh * 64);
      y = head_norm4(y, 1e-5f, *(const f32x4*)(A.in[I_RETGN] + l * 256 + c4));
      const v2u gw_ = *(const v2u*)((const bf16*)(A.ws + WS_PB) + (size_t)m * PBW + 768 + c4); const f32x4 g = {bf_lo(gw_.x), bf_hi(gw_.x), bf_lo(gw_.y), bf_hi(gw_.y)};
#pragma unroll
      for (int i = 0; i < 4; ++i) y[i] *= g[i] * sigm(g[i]);
      v2u w; w.x = pk2(y.x, y.y); w.y = pk2(y.z, y.w); *(v2u*)(MX + c4) = w; }
    { f32x4 y = *(const f32x4*)(YO + YO_STRIDE + o) + state_corr<false>(slw, hh, r16, (const float*)(A.ws + WS_PT) + (size_t)m * 256 + hh * 64);
      y = head_norm4(y, 64e-5f, *(const f32x4*)(A.in[I_LN] + l * 256 + c4));
      y = (y + *(const f32x4*)(RWA + 7 * RWA_STRIDE + o)) * *(const f32x4*)(RWA + 6 * RWA_STRIDE + o);
      v2u w; w.x = pk2(y.x, y.y); w.y = pk2(y.z, y.w); *(v2u*)(MX + 256 + c4) = w; }
    { f32x4 y = *(const f32x4*)(YO + 2 * YO_STRIDE + o); const float r = 1.0f / sqrtf(wave_sum(dot4(y, y)) * (1.0f / 256.0f) + 1e-5f);
      y = y * r * *(const f32x4*)(A.in[I_DONORM] + l * 256 + c4);
      v2u w; w.x = pk2(y.x, y.y); w.y = pk2(y.z, y.w); *(v2u*)(MX + 512 + c4) = w; }
    { f32x4 y = *(const f32x4*)(YO + 3 * YO_STRIDE + o); const float r = 1.0f / sqrtf(wave_sum(dot4(y, y)) * (1.0f / 256.0f) + 1e-5f);
      y = y * r * *(const f32x4*)(A.in[I_SONORM] + l * 256 + c4);
      v2u w; w.x = pk2(y.x, y.y); w.y = pk2(y.z, y.w); *(v2u*)(MX + 768 + c4) = w; }
}
__device__ __forceinline__ void ph_post(ARef A, const WI& w, int l) {
    LAS float* slw = (LAS float*)w.lds; LAS float* slr = slw + 16384;
    for (int u = w.vcu; u < NB * NCH * 2; u += w.G) {
        const int b = u >> 5, c = (u >> 1) & 15, half = u & 1;
        __syncthreads();
        for (int e = w.tid; e < 4096; e += NWAVES * 64) { const int hh = e >> 10, v = (e >> 4) & 63, k4 = e & 15;
            const size_t src = ((size_t)((b * 4 + hh) * NCH + c) * 64 + v) * 64 + 4 * k4; const int dst = (hh * 64 + v) * 64 + 4 * (k4 ^ (v & 15));
            *(LAS f32x4*)(slw + dst) = *(const f32x4*)((const float*)(A.ws + WS_SI) + src); *(LAS f32x4*)(slr + dst) = *(const f32x4*)((const float*)(A.ws + WS_SIR) + src); }
        __syncthreads();
        const int tok0 = b * SEQ + c * TCH + half * 128 + w.wave * 16;
        for (int i = 0; i < 16; ++i) post_row(A, l, tok0 + i, w.lane, slw, slr);
    }
}

__device__ __forceinline__ float wave_max_f(float v) {
    v = fmaxf(v, __builtin_bit_cast(float, __builtin_amdgcn_mov_dpp(__builtin_bit_cast(int, v), 0xB1, 0xF, 0xF, true)));
    v = fmaxf(v, __builtin_bit_cast(float, __builtin_amdgcn_mov_dpp(__builtin_bit_cast(int, v), 0x4E, 0xF, 0xF, true)));
    v = fmaxf(v, __builtin_bit_cast(float, __builtin_amdgcn_mov_dpp(__builtin_bit_cast(int, v), 0x141, 0xF, 0xF, true)));
    v = fmaxf(v, __builtin_bit_cast(float, __builtin_amdgcn_mov_dpp(__builtin_bit_cast(int, v), 0x140, 0xF, 0xF, true)));
    const int iv = __builtin_bit_cast(int, v);
    return fmaxf(fmaxf(__builtin_bit_cast(float, __builtin_amdgcn_readlane(iv, 0)), __builtin_bit_cast(float, __builtin_amdgcn_readlane(iv, 16))), fmaxf(__builtin_bit_cast(float, __builtin_amdgcn_readlane(iv, 32)), __builtin_bit_cast(float, __builtin_amdgcn_readlane(iv, 48))));
}
__device__ __forceinline__ void router_stage(ARef A, const WI& w, int l) {
    LAS float* rwl = (LAS float*)w.lds; const float* rw = A.in[I_RW] + (size_t)l * DM * 32;
    for (int e = w.tid; e < DM * 8; e += NWAVES * 64) { const int k = e >> 3, c = e & 7; *(LAS f32x4*)(rwl + k * 32 + 4 * (c ^ ((k >> 2) & 7))) = *(const f32x4*)(rw + (size_t)k * 32 + 4 * c); }
    __syncthreads();
}
__device__ __forceinline__ void router_row(ARef A, int l, int m, int lane, LAS unsigned* hist, const LAS float* rwl, LAS int* texp, bool dry = false) {
    const float* XA = (const float*)(A.ws + WS_XA) + (size_t)m * DM; const float* MOD = (const float*)(A.ws + WS_MOD) + (size_t)(l * 8 + (m >> 12)) * 6144;
    f32x4 v[4]; float ss = 0.0f;
#pragma unroll
    for (int j = 0; j < 4; ++j) { v[j] = *(const f32x4*)(XA + 4 * (lane + 64 * j)); ss += dot4(v[j], v[j]); }
    ss = wave_sum(ss); const float rstd = 1.0f / sqrtf(ss * (1.0f / DM) + 1e-5f);
    const float* g = A.in[I_NFFN] + l * DM; const float* scp = MOD + 4 * 1024; const float* shp = MOD + 3 * 1024;
    emit_h_row(v, rstd, g, scp, shp, (bf16*)(A.ws + WS_H) + (size_t)m * DM, lane);
    float p[32];
#pragma unroll
    for (int e = 0; e < 32; ++e) p[e] = 0.0f;
    const int sw = lane & 7;
#pragma unroll 1
    for (int j = 0; j < 4; ++j) { const int k = 4 * (lane + 64 * j);
        const f32x4 h = *(const f32x4*)(XA + k) * rstd * *(const f32x4*)(g + k) * (1.0f + *(const f32x4*)(scp + k)) + *(const f32x4*)(shp + k);
        const LAS float* row = rwl + k * 32;
#pragma unroll
        for (int i = 0; i < 4; ++i) {
#pragma unroll
            for (int q4 = 0; q4 < 8; ++q4) { const f32x4 r = *(const LAS f32x4*)(row + i * 32 + 4 * (q4 ^ sw)); p[4 * q4] += h[i] * r.x; p[4 * q4 + 1] += h[i] * r.y; p[4 * q4 + 2] += h[i] * r.z; p[4 * q4 + 3] += h[i] * r.w; } } }
    float q16[16], q8[8], q4v[4], q2[2], q1;
    { const bool hb = (lane & 32) != 0;
#pragma unroll
      for (int i = 0; i < 16; ++i) { const float mine = hb ? p[16 + i] : p[i], oth = hb ? p[i] : p[16 + i]; q16[i] = mine + __shfl_xor(oth, 32); } }
    { const bool hb = (lane & 16) != 0;
#pragma unroll
      for (int i = 0; i < 8; ++i) { const float mine = hb ? q16[8 + i] : q16[i], oth = hb ? q16[i] : q16[8 + i]; q8[i] = mine + __shfl_xor(oth, 16); } }
    { const bool hb = (lane & 8) != 0;
#pragma unroll
      for (int i = 0; i < 4; ++i) { const float mine = hb ? q8[4 + i] : q8[i], oth = hb ? q8[i] : q8[4 + i]; q4v[i] = mine + __shfl_xor(oth, 8); } }
    { const bool hb = (lane & 4) != 0;
#pragma unroll
      for (int i = 0; i < 2; ++i) { const float mine = hb ? q4v[2 + i] : q4v[i], oth = hb ? q4v[i] : q4v[2 + i]; q2[i] = mine + __shfl_xor(oth, 4); } }
    { const bool hb = (lane & 2) != 0; const float mine = hb ? q2[1] : q2[0], oth = hb ? q2[0] : q2[1]; q1 = mine + __shfl_xor(oth, 2); }
    q1 += __shfl_xor(q1, 1);
    float lv = q1 + A.in[I_RB][l * 32 + (lane >> 1)];
    float tv[4]; int ti[4];
#pragma unroll
    for (int kk = 0; kk < 4; ++kk) { const float mx = wave_max_f(lv); const unsigned long long msk = __ballot(lv == mx); const int e = msk ? (int)(__builtin_ctzll(msk) >> 1) : kk;
        tv[kk] = mx; ti[kk] = e; if ((lane >> 1) == e) lv = -INFINITY; }
    const float e1 = expf(tv[1] - tv[0]), e2 = expf(tv[2] - tv[0]), e3 = expf(tv[3] - tv[0]); const float inv = 1.0f / (1.0f + e1 + e2 + e3);
    if (lane == 0 && !dry) {
        int* TI = (int*)(A.ws + WS_TOPI) + (size_t)m * 4; float* TW = (float*)(A.ws + WS_TOPW) + (size_t)m * 4;
        TI[0] = ti[0]; TI[1] = ti[1]; TI[2] = ti[2]; TI[3] = ti[3]; texp[0] = ti[0]; texp[1] = ti[1]; texp[2] = ti[2]; texp[3] = ti[3]; TW[0] = inv; TW[1] = e1 * inv; TW[2] = e2 * inv; TW[3] = e3 * inv;
        { unsigned* hg = (unsigned*)hist; atomicAdd(hg + ti[0], 1u); atomicAdd(hg + ti[1], 1u); atomicAdd(hg + ti[2], 1u); atomicAdd(hg + ti[3], 1u); }
    }
}
__device__ __forceinline__ void build_expert_table(ARef A, const WI& w, int l) {
    LAS int* tst = (LAS int*)(w.lds + TST_OFF); LAS int* tab = (LAS int*)(w.lds + TAB_OFF); LAS int* cnt = (LAS int*)(w.lds + CNT_OFF);
    if (w.tid == 0) { const unsigned* gc = (const unsigned*)(A.ws + WS_CTL) + CW_GCNT + 64 * l; int acc = 0;
        for (int e = 0; e < 32; ++e) { const int c = (int)__hip_atomic_load(gc + e, RLX_AGENT); cnt[e] = c; tst[e] = acc; acc += (c + 255) >> 8; }
        tst[32] = acc; tab[0] = acc; }
    __syncthreads();
    if (w.tid < 32) { const int e = w.tid; for (int pm = tst[e]; pm < tst[e + 1]; ++pm) tab[1 + pm] = e; }
    __syncthreads();
}
__device__ __forceinline__ void router_lists(ARef A, const WI& w, int l) {
    LAS unsigned* hist = (LAS unsigned*)(w.lds + HIST_OFF); LAS int* base = (LAS int*)(w.lds + BASE_OFF); LAS int* texp = (LAS int*)(w.lds + TEXP_OFF);
    __syncthreads();
    if (w.tid < 32) { base[w.tid] = (int)atomicAdd((unsigned*)(A.ws + WS_CTL) + CW_GCNT + 64 * l + w.tid, hist[w.tid]); hist[w.tid] = 0u; }
    __syncthreads();
    int* LIST = (int*)(A.ws + WS_LIST); int* PW = (int*)(A.ws + WS_POS);
    int j = 0;
    for (int m = w.gw; m < MTOK; m += w.NGW, ++j) {
        if (w.lane < 4) { const int e = texp[(w.wave * 16 + j) * 4 + w.lane]; const int idx = base[e] + (int)atomicAdd((unsigned*)hist + e, 1u);
            LIST[e * LCAP + idx] = m; PW[(size_t)m * 4 + w.lane] = (e << 20) | idx; } }
}
__device__ __forceinline__ void combine_row(ARef A, int l, int m, int lane, const LAS int* tst, float gscale = 1.0f, float oscale = 1.0f) {
    float* XA = (float*)(A.ws + WS_XA) + (size_t)m * DM; const float* MOD = (const float*)(A.ws + WS_MOD) + (size_t)(l * 8 + (m >> 12)) * 6144;
    const int* PS = (const int*)(A.ws + WS_POS) + (size_t)m * 4; const float* TW = (const float*)(A.ws + WS_TOPW) + (size_t)m * 4;
    const bf16* YS = (const bf16*)(A.ws + WS_XS);
    f32x4 v[4], acc[4];
#pragma unroll
    for (int j = 0; j < 4; ++j) { v[j] = *(const f32x4*)(XA + 4 * (lane + 64 * j)); acc[j] = (f32x4){0.f, 0.f, 0.f, 0.f}; }
#pragma unroll
    for (int k = 0; k < 4; ++k) { const int pe = PS[k]; const int pos = tst[pe >> 20] * 256 + (pe & 0xFFFFF); const float gt = TW[k] * gscale; const v2u* yr = (const v2u*)(YS + (size_t)pos * DM);
#pragma unroll
        for (int j = 0; j < 4; ++j) { const v2u y = yr[lane + 64 * j]; acc[j] += gt * (f32x4){bf_lo(y.x), bf_hi(y.x), bf_lo(y.y), bf_hi(y.y)}; } }
    float ss = 0.0f;
#pragma unroll
    for (int j = 0; j < 4; ++j) { const int kx = 4 * (lane + 64 * j); v[j] += *(const f32x4*)(MOD + 5 * 1024 + kx) * acc[j]; ss += dot4(v[j], v[j]); }
    ss = wave_sum(ss); const float rstd = 1.0f / sqrtf(ss * (1.0f / DM) + 1e-5f);
    if (l + 1 < NLAYER) {
#pragma unroll
        for (int j = 0; j < 4; ++j) *(f32x4*)(XA + 4 * (lane + 64 * j)) = v[j];
        const float* mb = MOD + 8 * 6144;
        emit_h_row(v, rstd, A.in[I_NMIX] + (l + 1) * DM, mb + 1024, mb, (bf16*)(A.ws + WS_H) + (size_t)m * DM, lane);
    } else {
        float* orow = A.out + (size_t)m * DM; const float* gf = A.in[I_NFINAL];
#pragma unroll
        for (int j = 0; j < 4; ++j) { const int kx = 4 * (lane + 64 * j); *(f32x4*)(orow + kx) = v[j] * (rstd * oscale) * *(const f32x4*)(gf + kx); }
    }
}

constexpr int N_LAUNCHES = MK_N_LAUNCHES;
template <int SEL> __global__ void __launch_bounds__(NWAVES * 64, 2) fwd(ArgsH Ah) {
    extern __shared__ __attribute__((aligned(16))) unsigned char lds[];
    (void)Ah;
    const int wave_s = __builtin_amdgcn_readfirstlane((int)threadIdx.x >> 6);
    auto tid_now = [&]() -> int { int ws_ = wave_s; unsigned z_ = 0u; asm volatile("" : "+s"(ws_), "+s"(z_)); return ws_ * 64 + (int)__builtin_amdgcn_mbcnt_hi(~0u, __builtin_amdgcn_mbcnt_lo(~0u, z_)); };
#define TID_NOW() tid_now()
#define MAKE_WI() WI w; { int tz = TID_NOW(); asm volatile("" : "+v"(tz)); int bz = blockIdx.x, gz = gridDim.x; asm volatile("" : "+s"(bz), "+s"(gz)); \
        w.lds = (LAS unsigned char*)lds; w.tid = tz; w.lane = tz & 63; w.wave = __builtin_amdgcn_readfirstlane(tz >> 6); w.G = gz; w.bx = bz; w.vcu = (gz % 8 == 0) ? (bz % 8) * (gz / 8) + bz / 8 : bz; \
        w.gw = w.vcu * NWAVES + w.wave; w.NGW = gz * NWAVES; }
    { const int t0 = threadIdx.x; for (int u = t0; u < (LDS_BYTES - RING_BYTES) / 4; u += NWAVES * 64) ((LAS unsigned*)((LAS unsigned char*)lds + RING_BYTES))[u] = 0u; }
    __syncthreads();
    int lo, hi; { ARef A0 = *kargs(); lo = A0.ph_lo; hi = A0.ph_hi; }
    if (N_LAUNCHES == 1) { ARef A0 = *kargs(); (void)xcd_barrier_post((unsigned*)((gu32*)(A0.ws + WS_CTL) + CW_BAR), (volatile LAS unsigned*)((LAS unsigned char*)lds + MISC_OFF) + 8, TID_NOW()); }
#define GRID_BAR() do { if (N_LAUNCHES == 1) { ARef Ab = *kargs(); XcdBarrier bar_; bar_.bar = (unsigned*)((gu32*)(Ab.ws + WS_CTL) + CW_BAR); bar_.x = xb_xcc_id(); bar_.st = (volatile LAS unsigned*)((LAS unsigned char*)lds + MISC_OFF) + 8; xcd_barrier(bar_, TID_NOW()); } } while (0)
#ifndef TPROBE
#define TPROBE 0
#endif
#if TPROBE
    unsigned long long tp_acc = 0ull;
#define TP_SCALE tp_scale_of(__hip_atomic_load((unsigned*)(A.ws + WS_CTL) + 3, RLX_AGENT))
    auto tp_scale_of = [](unsigned ticks) -> float { const float us = (float)ticks * 0.01f; if (us < 1.0f) return 1.0f; const float q = exp2f(rintf(log2f(us) * 8.0f) * 0.125f); return 1.0f + sqrtf(q * 1e-5f); };
#define TP_BEGIN(kind) unsigned long long tp_t0 = 0ull; if ((kind) == TPROBE) tp_t0 = __builtin_amdgcn_s_memrealtime();
#define TP_END(kind) if ((kind) == TPROBE) { tp_acc += __builtin_amdgcn_s_memrealtime() - tp_t0; }
#define TP_PUBLISH(l) if ((l) == 1 && w.vcu == 0 && w.tid == 0) __hip_atomic_store((unsigned*)(A.ws + WS_CTL) + 3, (unsigned)tp_acc, RLX_AGENT);
#else
#define TP_SCALE 1.0f
#define TP_PUBLISH(l)
#define TP_BEGIN(kind)
#define TP_END(kind)
#endif
#define IN(k) (lo <= (k) && (k) < hi)
#ifndef PHMASK
#define PHMASK 0xffffffffu
#endif
#define KON(k) if constexpr ((SEL < 0 && ((PHMASK >> (k)) & 1u)) || SEL == (k))
#define BOTH(k) (IN(k) && IN((k) + 1))
#ifndef PROBE_REP
#define PROBE_REP 0
#endif
#if PROBE_REP
    int nrep_ = 2; asm volatile("" : "+s"(nrep_));
#define REP(bit) _Pragma("unroll 1") for (int rep_ = 0; rep_ < (((PROBE_REP >> (bit)) & 1) ? nrep_ : 1); ++rep_)
#else
#define REP(bit) for (int rep_ = 0; rep_ < 1; ++rep_)
#endif
#define ring ((PG8_LAS unsigned char*)lds)

    KON(0) if (IN(0)) { ARef A = *kargs(); MAKE_WI(); REP(0) ph_prologue(A, w); if (BOTH(0)) GRID_BAR(); }

#define LAYER_BODY(l) do {\
        const int pb = 1 + l * NPL; \
        KON(1) if (IN(pb + 0)) { ARef A = *kargs(); MAKE_WI(); TP_BEGIN(1) if (l == 0) { ph_norm1(A, w); small_weights_to_f16(A, w); if (BOTH(pb + 0)) GRID_BAR(); } TP_END(1) } \
        KON(2) if (IN(pb + 1)) { ARef A = *kargs(); MAKE_WI(); TP_BEGIN(2) \
            pg8::Gemm g{(const bf16*)(A.ws + WS_H), (const bf16*)(A.ws + WS_WIN) + (size_t)l * INCP * DM, MTOK, INCP, DM}; pg8::StaticOrder S; S.init(MTOK, INCP, w.G, w.bx); \
            pg8::EpiProj E{(bf16*)(A.ws + WS_PB), (float*)(A.ws + WS_PF)}; \
            REP(1) pg8::gemm_phase<pg8::EpiProj, pg8::StaticOrder, true, true>(ring, g, S, E, w.tid); \
            if (BOTH(pb + 1)) GRID_BAR(); TP_END(2) \
        } \
        KON(3) if (IN(pb + 2)) { ARef A = *kargs(); MAKE_WI(); TP_BEGIN(3) \
            REP(2) { for (int g = w.gw; g < MTOK / 16; g += w.NGW) prep16(A, l, 16 * g, w.lane); } \
            if (BOTH(pb + 2)) GRID_BAR(); TP_END(3) \
        } \
        KON(4) if (IN(pb + 3)) { ARef A = *kargs(); MAKE_WI(); TP_BEGIN(4) \
            REP(3) { for (int tk = 2 * w.vcu; tk < 32 * NCH; tk += 2 * w.G) scan_rwkv_task2(A, w, tk); } \
            REP(13) { for (int tk = w.vcu; tk < 32 * NCH / 2; tk += w.G) scan_ret_task(A, w, tk); } \
            REP(4) { LAS unsigned char* vl = w.lds + w.wave * 4608; for (int it = w.gw; it < 32 * 128; it += w.NGW) sb_tile_mfma(A, it, w.lane, vl); } \
            REP(5) dsa_scores_mfma(A, w); \
            if (BOTH(pb + 3)) GRID_BAR(); TP_END(4) \
        } \
        KON(5) if (IN(pb + 4)) { ARef A = *kargs(); MAKE_WI(); TP_BEGIN(5) \
            if (w.bx < 32) prefix_chain(A, w, w.bx); \
            REP(6) dsa_wave(A, w, w.lds + w.wave * 13312, l + 2 * rep_); \
            REP(14) { if (rep_ && w.bx < 32) prefix_chain(A, w, w.bx); } \
            if (BOTH(pb + 4)) GRID_BAR(); TP_END(5) \
        } \
        KON(6) if (IN(pb + 5)) { ARef A = *kargs(); MAKE_WI(); TP_BEGIN(6) \
            REP(7) ph_post(A, w, l); \
            if (BOTH(pb + 5)) GRID_BAR(); TP_END(6) \
        } \
        KON(7) if (IN(pb + 6)) { ARef A = *kargs(); MAKE_WI(); TP_BEGIN(7) \
            pg8::Gemm g{(const bf16*)(A.ws + WS_MIX), (const bf16*)(A.ws + WS_WOUT) + (size_t)l * DM * DM, MTOK, DM, DM}; pg8::StaticOrder S; S.init(MTOK, DM, w.G, w.bx); \
            pg8::EpiRes E{l == 0 ? A.in[I_X] : (const float*)(A.ws + WS_XA), (float*)(A.ws + WS_XA), (const float*)(A.ws + WS_MOD) + (size_t)l * 8 * 6144 + 2 * 1024}; \
            pg8::gemm_phase<pg8::EpiRes, pg8::StaticOrder, true, true>(ring, g, S, E, w.tid); \
            if (BOTH(pb + 6)) GRID_BAR(); TP_END(7) \
        } \
        KON(8) if (IN(pb + 7)) { ARef A = *kargs(); MAKE_WI(); TP_BEGIN(8) \
            { LAS unsigned* hist = (LAS unsigned*)(w.lds + HIST_OFF); LAS int* texp = (LAS int*)(w.lds + TEXP_OFF); if (w.tid < 32) hist[w.tid] = 0u; router_stage(A, w, l); \
            REP(10) { int j_ = 0; for (int m = w.gw; m < MTOK; m += w.NGW, ++j_) router_row(A, l, m, w.lane, hist, (const LAS float*)w.lds, texp + (w.wave * 16 + j_) * 4, rep_ != 0); } \
            router_lists(A, w, l); } \
            if (BOTH(pb + 7)) GRID_BAR(); TP_END(8) \
        } \
        KON(10) if (IN(pb + 8)) { ARef A = *kargs(); MAKE_WI(); TP_BEGIN(10) \
            build_expert_table(A, w, l); \
            pg8::Gemm g{(const bf16*)(A.ws + WS_H), (const bf16*)(A.ws + WS_W1) + (size_t)l * NEXP * 2048 * DM, MOE_ROWS, NEXP * 2048, DM}; \
            pg8::MoeOrder S{(const PG8_LAS int*)(w.lds + TAB_OFF), 8, w.G, w.vcu, (const PG8_LAS int*)(w.lds + TST_OFF), (const PG8_LAS int*)(w.lds + CNT_OFF), (const int*)(A.ws + WS_LIST)}; \
            pg8::EpiSwiglu E{(bf16*)(A.ws + WS_ACT), A.in[I_MB1] + (size_t)l * NEXP * 2048}; \
            REP(8) pg8::gemm_phase<pg8::EpiSwiglu, pg8::MoeOrder, true, true, true>(ring, g, S, E, w.tid); \
            if (BOTH(pb + 8)) GRID_BAR(); TP_END(10) \
        } \
        KON(11) if (IN(pb + 9)) { ARef A = *kargs(); MAKE_WI(); TP_BEGIN(11) \
            build_expert_table(A, w, l); \
            pg8::Gemm g{(const bf16*)(A.ws + WS_ACT), (const bf16*)(A.ws + WS_W2) + (size_t)l * NEXP * DM * DM, MOE_ROWS, NEXP * DM, DM}; \
            pg8::MoeOrder S{(const PG8_LAS int*)(w.lds + TAB_OFF), 4, w.G, w.vcu, (const PG8_LAS int*)(w.lds + TST_OFF), (const PG8_LAS int*)(w.lds + CNT_OFF), (const int*)(A.ws + WS_LIST)}; \
            pg8::EpiY E{(bf16*)(A.ws + WS_XS), A.in[I_MB2] + (size_t)l * NEXP * DM}; \
            REP(9) pg8::gemm_phase<pg8::EpiY, pg8::MoeOrder, true, true>(ring, g, S, E, w.tid); \
            TP_PUBLISH(l) \
            if (BOTH(pb + 9)) GRID_BAR(); TP_END(11) \
        } \
        KON(12) if (IN(pb + 10)) { ARef A = *kargs(); MAKE_WI(); TP_BEGIN(12) \
            build_expert_table(A, w, l); \
            REP(12) for (int m = w.gw; m < MTOK; m += w.NGW) combine_row(A, l, m, w.lane, (const LAS int*)(w.lds + TST_OFF), rep_ ? 0.0f : 1.0f, TP_SCALE); \
            if (BOTH(pb + 10)) GRID_BAR(); TP_END(12) \
        } \
    } while (0)
    LAYER_BODY(0);
    LAYER_BODY(1);
#undef LAYER_BODY
#undef IN
#undef ring
#undef MAKE_WI
#undef TID_NOW
#undef GRID_BAR
#undef KON
#undef BOTH
}


#if MK_N_LAUNCHES != 1
template <int K> static void launch_one(int grid, hipStream_t stream, const ArgsH& a) {
    static bool attr = false;
    if (!attr) { (void)hipFuncSetAttribute((const void*)fwd<K>, hipFuncAttributeMaxDynamicSharedMemorySize, LDS_BYTES); attr = true; }
    hipLaunchKernelGGL(fwd<K>, dim3(grid), dim3(NWAVES * 64), LDS_BYTES, stream, a);
}
static void launch_kind(int kind, int grid, hipStream_t stream, const ArgsH& a) {
    switch (kind) {
        case 0: launch_one<0>(grid, stream, a); break; case 1: launch_one<1>(grid, stream, a); break; case 2: launch_one<2>(grid, stream, a); break;
        case 3: launch_one<3>(grid, stream, a); break; case 4: launch_one<4>(grid, stream, a); break; case 5: launch_one<5>(grid, stream, a); break;
        case 6: launch_one<6>(grid, stream, a); break; case 7: launch_one<7>(grid, stream, a); break; case 8: launch_one<8>(grid, stream, a); break;
        case 9: launch_one<9>(grid, stream, a); break; case 10: launch_one<10>(grid, stream, a); break; case 11: launch_one<11>(grid, stream, a); break;
        default: launch_one<12>(grid, stream, a); break;
    }
}
#endif
extern "C" void kernel_launch(void* const* d_in, const int* in_sizes, int n_in, void* d_out, int out_size, void* d_ws, size_t ws_size, hipStream_t stream) {
    static int grid = 0;
    if (grid == 0) {
        if (n_in != N_IN || out_size != MTOK * DM || ws_size < WS_END) { fprintf(stderr, "kernel_launch: unexpected shapes (n_in %d, out %d, ws %zu)\n", n_in, out_size, ws_size); grid = -1; return; }
        int dev = 0, cus = 0;
        if (hipGetDevice(&dev) != hipSuccess || hipDeviceGetAttribute(&cus, hipDeviceAttributeMultiprocessorCount, dev) != hipSuccess) { grid = -1; return; }
#if MK_N_LAUNCHES == 1
        {
            if (hipFuncSetAttribute((const void*)fwd<-1>, hipFuncAttributeMaxDynamicSharedMemorySize, LDS_BYTES) != hipSuccess) { fprintf(stderr, "kernel_launch: hipFuncSetAttribute failed\n"); grid = -1; return; }
            int per_cu = 0;
            if (hipOccupancyMaxActiveBlocksPerMultiprocessor(&per_cu, (const void*)fwd<-1>, NWAVES * 64, LDS_BYTES) != hipSuccess || per_cu < 1) fprintf(stderr, "kernel_launch: occupancy query says %d\n", per_cu);
            (void)hipGetLastError();
        }
#endif
        grid = cus;
    }
    if (grid < 0) return;
    (void)in_sizes;
    if (hipMemsetAsync((char*)d_ws + WS_CTL, 0, CTL_ZERO_BYTES, stream) != hipSuccess) return;
    ArgsH a{};
    for (int i = 0; i < N_IN; ++i) a.in[i] = (const float*)d_in[i];
    a.out = (float*)d_out; a.ws = (unsigned char*)d_ws;
    for (int f = 0; f < 44; ++f) a.invf[f] = (f < 32) ? pow(10000.0, -(double)f / 32.0) : (f < 40) ? pow(500000.0, -(double)(f - 32) / 8.0) : pow(500000.0, -(double)(f - 40) / 4.0);
#if MK_N_LAUNCHES == 1
    a.ph_lo = 0; a.ph_hi = NPHASE; a.li = 0;
    hipLaunchKernelGGL(fwd<-1>, dim3(grid), dim3(NWAVES * 64), LDS_BYTES, stream, a);
#else
    {
        for (int p = 0; p < NPHASE; ++p) {
            if (p == 1 + NPL) continue;
            a.ph_lo = p; a.ph_hi = p + 1; a.li = p;
            static const int kinds_[NPL] = {1, 2, 3, 4, 5, 6, 7, 8, 10, 11, 12};
            const int kind = (p == 0) ? 0 : kinds_[(p - 1) % NPL];
            launch_kind(kind, grid, stream, a);
        }
    }
#endif
}
```

```cpp
#include <hip/hip_runtime.h>
#include <cstdio>
#include <cstdint>
#include <cmath>

#ifndef MK_N_LAUNCHES
#define MK_N_LAUNCHES 1
#endif

namespace pg8 {
#define PG8_LAS __attribute__((address_space(3)))
typedef unsigned short bf16_t;
typedef short bf16x8 __attribute__((ext_vector_type(8)));
typedef float f32x4 __attribute__((ext_vector_type(4)));
typedef unsigned u32x4 __attribute__((ext_vector_type(4)));
typedef unsigned u32x2 __attribute__((ext_vector_type(2)));
constexpr int BM = 256, BK = 64, HALF = 128, HTB = HALF * BK * 2  , STAGE_BYTES = 8 * HTB, NXCD = 8, WGM = 8;

__host__ __device__ __forceinline__ int lds_byte(int r, int c) { const int st = (r >> 4) * 2 + (c >> 5), rr = r & 15, cc = c & 31, ob = rr * 64 + cc * 2; return st * 1024 + (ob ^ (((ob >> 9) & 1) << 5)); }
__host__ __device__ __forceinline__ void stage_rc(int b, int& R, int& C) { const int st = b / 1024, sb = b % 1024, swz = sb ^ (((sb >> 9) & 1) << 5); R = (st >> 1) * 16 + swz / 64; C = (st & 1) * 32 + (swz % 64) / 2; }
__host__ __device__ __forceinline__ int perm32(int rho) { const int n = rho >> 4, i = rho & 15; return 8 * (i >> 2) + 4 * n + (i & 3); }

struct Unit { int pm, pn; };
struct Gemm { const bf16_t* A; const bf16_t* Bt; int M, N, K; };

struct StaticOrder {
    int nM, nN, nwg, G, c;
    __host__ __device__ void init(int M, int N, int G_, int c_) { nM = M / BM; nN = N / BM; nwg = nM * nN; G = G_; c = c_; }
    __host__ __device__ bool next(int i, Unit& u) const {
        const long L = (long)i * G + c; if (L >= nwg) return false;
        int wgid = (int)L; { const int q = nwg / NXCD, r = nwg % NXCD, xcd = wgid % NXCD, off = wgid / NXCD; wgid = (xcd < r ? xcd * (q + 1) : r * (q + 1) + (xcd - r) * q) + off; }
        const int nig = WGM * nN, gid = wgid / nig, fm = gid * WGM, gsz = (nM - fm) < WGM ? (nM - fm) : WGM;
        u.pm = fm + ((wgid % nig) % gsz); u.pn = (wgid % nig) / gsz; return true;
    }
    __device__ __forceinline__ void a_ready(const Unit&) const {}
    __device__ __forceinline__ void done(const Unit&) const {}
};
__device__ __forceinline__ unsigned cvt_pk_bf16(float lo, float hi) { unsigned r; asm volatile("v_cvt_pk_bf16_f32 %0, %1, %2" : "=v"(r) : "v"(lo), "v"(hi)); return r; }
struct EpiF32 {
    static constexpr bool PERM = false, AFTER_DRAIN = false;
    float* C; int ldc;
    __device__ __forceinline__ void operator()(const f32x4 (&acc)[2][2][4][2], const Unit& u, int wr, int wc, int fr, int fq) const {
        const int row0 = u.pm * BM + wr * 64 + fr, col0 = u.pn * BM + wc * 32 + 4 * fq;
#pragma unroll
        for (int ai = 0; ai < 2; ++ai)
#pragma unroll
            for (int m = 0; m < 4; ++m) { float* rowp = C + (size_t)(row0 + ai * HALF + m * 16) * ldc + col0;
#pragma unroll
                for (int bj = 0; bj < 2; ++bj)
#pragma unroll
                    for (int n = 0; n < 2; ++n) *(f32x4*)(rowp + bj * HALF + n * 16) = acc[ai][bj][m][n]; }
    }
};
struct EpiProj {
    static constexpr bool PERM = true, AFTER_DRAIN = false;
    bf16_t* PB; float* PF;
    __device__ __forceinline__ void operator()(const f32x4 (&acc)[2][2][4][2], const Unit& u, int wr, int wc, int fr, int fq) const {
        const int row0 = u.pm * BM + wr * 64 + fr;
        if (u.pn < 7) { const int c0 = u.pn * BM + wc * 32 + 8 * fq;
#pragma unroll
            for (int ai = 0; ai < 2; ++ai)
#pragma unroll
                for (int m = 0; m < 4; ++m) { bf16_t* rowp = PB + (size_t)(row0 + ai * HALF + m * 16) * 1792 + c0;
#pragma unroll
                    for (int bj = 0; bj < 2; ++bj) { const f32x4 v0 = acc[ai][bj][m][0], v1 = acc[ai][bj][m][1];
                        u32x4 w; w.x = cvt_pk_bf16(v0[0], v0[1]); w.y = cvt_pk_bf16(v0[2], v0[3]); w.z = cvt_pk_bf16(v1[0], v1[1]); w.w = cvt_pk_bf16(v1[2], v1[3]);
                        *(u32x4*)(rowp + bj * HALF) = w; } }
        } else { const int c0 = (u.pn - 7) * BM + wc * 32 + 8 * fq;
#pragma unroll
            for (int ai = 0; ai < 2; ++ai)
#pragma unroll
                for (int m = 0; m < 4; ++m) { float* rowp = PF + (size_t)(row0 + ai * HALF + m * 16) * 1280 + c0;
#pragma unroll
                    for (int bj = 0; bj < 2; ++bj) { *(f32x4*)(rowp + bj * HALF) = acc[ai][bj][m][0]; *(f32x4*)(rowp + bj * HALF + 4) = acc[ai][bj][m][1]; } }
        }
    }
};
struct EpiRes {
    static constexpr bool PERM = false, AFTER_DRAIN = false;
    const float* xin; float* xout; const float* gate;
    __device__ __forceinline__ void operator()(const f32x4 (&acc)[2][2][4][2], const Unit& u, int wr, int wc, int fr, int fq) const {
        const int row0 = u.pm * BM + wr * 64 + fr, col0 = u.pn * BM + wc * 32 + 4 * fq;
        const float* gp = gate + (size_t)((u.pm * BM) >> 12) * 6144 + col0;
        f32x4 gv[2][2];
#pragma unroll
        for (int bj = 0; bj < 2; ++bj)
#pragma unroll
            for (int n = 0; n < 2; ++n) gv[bj][n] = *(const f32x4*)(gp + bj * HALF + n * 16);
#pragma unroll
        for (int ai = 0; ai < 2; ++ai)
#pragma unroll
            for (int m = 0; m < 4; ++m) { const size_t ro = (size_t)(row0 + ai * HALF + m * 16) * 1024 + col0;
#pragma unroll
                for (int bj = 0; bj < 2; ++bj)
#pragma unroll
                    for (int n = 0; n < 2; ++n) { const f32x4 xv = *(const f32x4*)(xin + ro + bj * HALF + n * 16); *(f32x4*)(xout + ro + bj * HALF + n * 16) = xv + gv[bj][n] * acc[ai][bj][m][n]; } }
    }
};
__device__ __forceinline__ float swiglu1(float glu, float lin) {
    glu = fminf(glu, 7.0f); lin = fminf(fmaxf(lin, -7.0f), 7.0f);
    return glu * (1.0f / (1.0f + __expf(-1.702f * glu))) * (lin + 1.0f);
}
struct EpiSwiglu {
    static constexpr bool PERM = true, AFTER_DRAIN = false;
    bf16_t* O; const float* b1;
    __device__ __forceinline__ void operator()(const f32x4 (&acc)[2][2][4][2], const Unit& u, int wr, int wc, int fr, int fq) const {
        const int e = u.pn >> 3, j = u.pn & 7, row0 = u.pm * BM + wr * 64 + fr, c0 = 128 * j + wc * 32 + 8 * fq;
        const float* bp = b1 + (size_t)e * 2048 + c0;
        f32x4 bg[2], bl[2];
#pragma unroll
        for (int n = 0; n < 2; ++n) { bg[n] = *(const f32x4*)(bp + 4 * n); bl[n] = *(const f32x4*)(bp + 1024 + 4 * n); }
#pragma unroll
        for (int ai = 0; ai < 2; ++ai)
#pragma unroll
            for (int m = 0; m < 4; ++m) { bf16_t* rowp = O + (size_t)(row0 + ai * HALF + m * 16) * 1024 + c0;
                const f32x4 g0 = acc[ai][0][m][0] + bg[0], g1 = acc[ai][0][m][1] + bg[1], l0 = acc[ai][1][m][0] + bl[0], l1 = acc[ai][1][m][1] + bl[1];
                u32x4 w;
                w.x = cvt_pk_bf16(swiglu1(g0[0], l0[0]), swiglu1(g0[1], l0[1])); w.y = cvt_pk_bf16(swiglu1(g0[2], l0[2]), swiglu1(g0[3], l0[3]));
                w.z = cvt_pk_bf16(swiglu1(g1[0], l1[0]), swiglu1(g1[1], l1[1])); w.w = cvt_pk_bf16(swiglu1(g1[2], l1[2]), swiglu1(g1[3], l1[3]));
                *(u32x4*)rowp = w; }
    }
};
struct EpiY {
    static constexpr bool PERM = true, AFTER_DRAIN = false;
    bf16_t* O; const float* b2;
    __device__ __forceinline__ void operator()(const f32x4 (&acc)[2][2][4][2], const Unit& u, int wr, int wc, int fr, int fq) const {
        const int e = u.pn >> 2, j = u.pn & 3, row0 = u.pm * BM + wr * 64 + fr, c0 = 256 * j + wc * 32 + 8 * fq;
        const float* bp = b2 + (size_t)e * 1024 + c0;
        f32x4 bv[2][2];
#pragma unroll
        for (int bj = 0; bj < 2; ++bj)
#pragma unroll
            for (int n = 0; n < 2; ++n) bv[bj][n] = *(const f32x4*)(bp + bj * HALF + 4 * n);
#pragma unroll
        for (int ai = 0; ai < 2; ++ai)
#pragma unroll
            for (int m = 0; m < 4; ++m) { bf16_t* rowp = O + (size_t)(row0 + ai * HALF + m * 16) * 1024 + c0;
#pragma unroll
                for (int bj = 0; bj < 2; ++bj) { const f32x4 v0 = acc[ai][bj][m][0] + bv[bj][0], v1 = acc[ai][bj][m][1] + bv[bj][1];
                    u32x4 w; w.x = cvt_pk_bf16(v0[0], v0[1]); w.y = cvt_pk_bf16(v0[2], v0[3]); w.z = cvt_pk_bf16(v1[0], v1[1]); w.w = cvt_pk_bf16(v1[2], v1[3]);
                    *(u32x4*)(rowp + bj * HALF) = w; } }
    }
};
struct MoeOrder {
    const PG8_LAS int* tab; int NJ, G, c;
    __device__ __forceinline__ bool next(int i, Unit& u) const {
        const int T = tab[0]; const long L = (long)i * G + c; if (L >= (long)T * NJ) return false;
        const int pm = (int)(L / NJ), j = (int)(L % NJ);
        u.pm = pm; u.pn = tab[1 + pm] * NJ + j; return true;
    }
    __device__ __forceinline__ void a_ready(const Unit&) const {}
    __device__ __forceinline__ void done(const Unit&) const {}
    const PG8_LAS int* tst; const PG8_LAS int* cnt; const int* list;
    __device__ __forceinline__ int row_of(const Unit& u, int r) const { const int e = tab[1 + u.pm], idx = 256 * (u.pm - tst[e]) + r; return (idx < cnt[e]) ? list[e * 32768 + idx] : 0; }
};

template <class Epi, class Sched, bool ALIGN_EPI = false, bool SP2 = false, bool GATHER = false>
__device__ __forceinline__ void gemm_phase(PG8_LAS unsigned char* lds, const Gemm g, const Sched& S, const Epi& E, int tid_in) {
    int tid_ = tid_in; asm volatile("" : "+v"(tid_));
    const int tid = tid_, wid = __builtin_amdgcn_readfirstlane(tid >> 6), lane = tid & 63, wr = wid >> 2, wc = wid & 3, fr = lane & 15, fq = lane >> 4;
    const int K = g.K, nt = K / BK;
    unsigned voffA[2], voffB[2];
#pragma unroll
    for (int i = 0; i < 2; ++i) { int R, C; stage_rc(tid * 16 + i * 8192, R, C); const int Rb = Epi::PERM ? ((R & ~31) + perm32(R & 31)) : R;
        voffA[i] = (unsigned)(R * K + C) * 2u; voffB[i] = (unsigned)(Rb * K + C) * 2u; }
    static_assert(!GATHER || SP2, "gathered A rows: only the two-super-phase loop is wired");
    unsigned cvo[2][2], nvo[2][2];
#define PG8_ROWS(dst, u_) do { _Pragma("unroll") for (int h_ = 0; h_ < 2; ++h_) _Pragma("unroll") for (int i_ = 0; i_ < 2; ++i_) { int R_, C_; stage_rc(tid * 16 + i_ * 8192, R_, C_); dst[h_][i_] = (unsigned)(S.row_of(u_, h_ * HALF + R_) * K + C_) * 2u; } } while (0)
#define PG8_STAGE_A(bufoff, gbase, half, nx) do { if constexpr (GATHER) { unsigned o_[2]; o_[0] = (nx) ? nvo[half][0] : cvo[half][0]; o_[1] = (nx) ? nvo[half][1] : cvo[half][1]; PG8_STAGE(bufoff, gbase, o_); } else { PG8_STAGE(bufoff, (gbase) + (half) * hstep, voffA); } } while (0)
    const size_t kstep = (size_t)(BK * 2);
    const size_t hstep = (size_t)HALF * K * 2;
    const size_t tstep = 2 * hstep;
    const unsigned ldsw = (unsigned)wid * 1024u;
    const int aoff = lds_byte(wr * 64 + fr, fq * 8), boff = lds_byte(wc * 32 + fr, fq * 8);
#define PG8_SA(b, h) (((b) * 2 + (h)) * HTB)
#define PG8_SB(b, h) ((4 + (b) * 2 + (h)) * HTB)
#define PG8_STAGE(bufoff, gbase, voff) do { _Pragma("unroll") for (int _i = 0; _i < 2; ++_i) \
        __builtin_amdgcn_global_load_lds((const unsigned*)((const char*)(gbase) + (voff)[_i]), (PG8_LAS unsigned*)(lds + (bufoff) + ldsw + _i * 8192), 16, 0, 0); } while (0)
#define PG8_LDA(dst, b, h) do { _Pragma("unroll") for (int m = 0; m < 4; ++m) _Pragma("unroll") for (int k = 0; k < 2; ++k) dst[m][k] = *(const PG8_LAS bf16x8*)(lds + PG8_SA(b, h) + aoff + m * 2048 + k * 1024); } while (0)
#define PG8_LDB(dst, b, h) do { _Pragma("unroll") for (int n = 0; n < 2; ++n) _Pragma("unroll") for (int k = 0; k < 2; ++k) dst[n][k] = *(const PG8_LAS bf16x8*)(lds + PG8_SB(b, h) + boff + n * 2048 + k * 1024); } while (0)
#define PG8_MMA(ai, bj, At, Bt) do { __builtin_amdgcn_s_setprio(1); _Pragma("unroll") for (int m = 0; m < 4; ++m) _Pragma("unroll") for (int n = 0; n < 2; ++n) _Pragma("unroll") for (int k = 0; k < 2; ++k) \
        acc[ai][bj][m][n] = __builtin_amdgcn_mfma_f32_16x16x32_bf16(Bt[n][k], At[m][k], acc[ai][bj][m][n], 0, 0, 0); __builtin_amdgcn_s_setprio(0); } while (0)
#define PG8_WAIT_V(n) asm volatile("s_waitcnt vmcnt(" #n ")" ::: "memory")
#define PG8_WAIT_L(n) asm volatile("s_waitcnt lgkmcnt(" #n ")" ::: "memory")
#define PG8_BAR __builtin_amdgcn_s_barrier()
#define PG8_SCHED __builtin_amdgcn_sched_barrier(0)
    Unit cur, nxt; int ui = 0;
    if (!S.next(0, cur)) return;
    f32x4 acc[2][2][4][2];
#pragma unroll
    for (int a = 0; a < 2; ++a)
#pragma unroll
        for (int b = 0; b < 2; ++b)
#pragma unroll
            for (int m = 0; m < 4; ++m)
#pragma unroll
                for (int n = 0; n < 2; ++n) acc[a][b][m][n] = (f32x4){0.f, 0.f, 0.f, 0.f};
    bf16x8 At[4][2], B0[2][2], B1[2][2];
    const char* cA = (const char*)g.A + (GATHER ? (size_t)0 : (size_t)cur.pm * tstep); const char* cB = (const char*)g.Bt + (size_t)cur.pn * tstep;
    if constexpr (GATHER) { PG8_ROWS(cvo, cur); }
    S.a_ready(cur);
    if constexpr (SP2) {
        PG8_STAGE(PG8_SB(0, 0), cB, voffB); PG8_STAGE(PG8_SB(0, 1), cB + hstep, voffB); PG8_STAGE_A(PG8_SA(0, 0), cA, 0, false); PG8_STAGE_A(PG8_SA(0, 1), cA, 1, false);
        if (wr == 1) PG8_BAR;
        PG8_WAIT_V(2); PG8_BAR;
        PG8_STAGE(PG8_SB(1, 0), cB + kstep, voffB); PG8_STAGE_A(PG8_SA(1, 0), cA + kstep, 0, false); PG8_STAGE(PG8_SB(1, 1), cB + hstep + kstep, voffB);
        PG8_WAIT_V(6); PG8_BAR;
    } else {
        PG8_STAGE(PG8_SB(0, 0), cB, voffB); PG8_STAGE(PG8_SA(0, 0), cA, voffA); PG8_STAGE(PG8_SB(0, 1), cB + hstep, voffB); PG8_STAGE(PG8_SA(0, 1), cA + hstep, voffA);
        if (wr == 1) PG8_BAR;
        PG8_WAIT_V(4); PG8_BAR;
        PG8_STAGE(PG8_SB(1, 0), cB + kstep, voffB); PG8_STAGE(PG8_SA(1, 0), cA + kstep, voffA); PG8_STAGE(PG8_SB(1, 1), cB + hstep + kstep, voffB);
        PG8_WAIT_V(6); PG8_BAR;
    }
    for (;;) {
        const bool has_next = S.next(ui + 1, nxt);
        const char* nA = GATHER ? (const char*)g.A : (has_next ? (const char*)g.A + (size_t)nxt.pm * tstep : cA); const char* nB = has_next ? (const char*)g.Bt + (size_t)nxt.pn * tstep : cB;
        if constexpr (GATHER) { if (has_next) { PG8_ROWS(nvo, nxt); } else { _Pragma("unroll") for (int h_ = 0; h_ < 2; ++h_) { nvo[h_][0] = cvo[h_][0]; nvo[h_][1] = cvo[h_][1]; } } }
        for (int t = 0; t < nt; t += 2) {
            const bool last = (t == nt - 2);
            const char* a1 = cA + (size_t)(t + 1) * kstep;
            const char* a2 = last ? nA : cA + (size_t)(t + 2) * kstep; const char* b2 = last ? nB : cB + (size_t)(t + 2) * kstep;
            const char* a3 = a2 + kstep; const char* b3 = b2 + kstep;
            if (last && has_next) S.a_ready(nxt);
            if constexpr (SP2) {
            PG8_LDB(B0, 0, 0); PG8_LDB(B1, 0, 1); PG8_SCHED; PG8_LDA(At, 0, 0); PG8_STAGE_A(PG8_SA(1, 1), a1, 1, false);
            PG8_WAIT_V(8); PG8_WAIT_L(0); PG8_BAR; PG8_MMA(0, 0, At, B0); PG8_MMA(0, 1, At, B1); PG8_BAR; PG8_SCHED;
            PG8_LDA(At, 0, 1); PG8_STAGE(PG8_SB(0, 0), b2, voffB); PG8_STAGE(PG8_SB(0, 1), b2 + hstep, voffB); PG8_STAGE_A(PG8_SA(0, 0), a2, 0, last);
            PG8_WAIT_V(8); PG8_WAIT_L(0); PG8_BAR; PG8_MMA(1, 0, At, B0); PG8_MMA(1, 1, At, B1); PG8_BAR; PG8_SCHED;
            PG8_LDB(B0, 1, 0); PG8_LDB(B1, 1, 1); PG8_SCHED; PG8_LDA(At, 1, 0); PG8_STAGE_A(PG8_SA(0, 1), a2, 1, last);
            PG8_WAIT_V(8); PG8_WAIT_L(0); PG8_BAR; PG8_MMA(0, 0, At, B0); PG8_MMA(0, 1, At, B1); PG8_BAR; PG8_SCHED;
            PG8_LDA(At, 1, 1); PG8_STAGE(PG8_SB(1, 0), b3, voffB); PG8_STAGE(PG8_SB(1, 1), b3 + hstep, voffB); PG8_STAGE_A(PG8_SA(1, 0), a3, 0, last);
            PG8_WAIT_V(8); PG8_WAIT_L(0); PG8_BAR; PG8_MMA(1, 0, At, B0); PG8_MMA(1, 1, At, B1); PG8_BAR; PG8_SCHED;
            } else {
            PG8_LDB(B0, 0, 0); PG8_SCHED; PG8_LDA(At, 0, 0); PG8_STAGE(PG8_SA(1, 1), a1 + hstep, voffA);
            PG8_WAIT_L(8); PG8_BAR; PG8_WAIT_L(0); PG8_MMA(0, 0, At, B0); PG8_BAR; PG8_SCHED;
            PG8_LDB(B1, 0, 1); PG8_STAGE(PG8_SB(0, 0), b2, voffB);
            PG8_BAR; PG8_WAIT_L(0); PG8_MMA(0, 1, At, B1); PG8_BAR;
            PG8_LDA(At, 0, 1); PG8_STAGE(PG8_SA(0, 0), a2, voffA);
            PG8_BAR; PG8_WAIT_L(0); PG8_MMA(1, 0, At, B0); PG8_BAR; PG8_SCHED;
            PG8_STAGE(PG8_SB(0, 1), b2 + hstep, voffB);
            PG8_WAIT_V(6); PG8_BAR; PG8_MMA(1, 1, At, B1); PG8_BAR;
            PG8_LDB(B0, 1, 0); PG8_SCHED; PG8_LDA(At, 1, 0); PG8_STAGE(PG8_SA(0, 1), a2 + hstep, voffA);
            PG8_WAIT_L(8); PG8_BAR; PG8_WAIT_L(0); PG8_MMA(0, 0, At, B0); PG8_BAR; PG8_SCHED;
            PG8_LDB(B1, 1, 1); PG8_STAGE(PG8_SB(1, 0), b3, voffB);
            PG8_BAR; PG8_WAIT_L(0); PG8_MMA(0, 1, At, B1); PG8_BAR;
            PG8_LDA(At, 1, 1); PG8_STAGE(PG8_SA(1, 0), a3, voffA);
            PG8_BAR; PG8_WAIT_L(0); PG8_MMA(1, 0, At, B0); PG8_BAR; PG8_SCHED;
            PG8_STAGE(PG8_SB(1, 1), b3 + hstep, voffB);
            PG8_WAIT_V(6); PG8_BAR; PG8_MMA(1, 1, At, B1); PG8_BAR;
            }
        }
        if constexpr (ALIGN_EPI) { if (wr == 0) PG8_BAR; }
        if constexpr (!Epi::AFTER_DRAIN) { E(acc, cur, wr, wc, fr, fq); S.done(cur); }
        if (!has_next) break;
#pragma unroll
        for (int a = 0; a < 2; ++a)
#pragma unroll
            for (int b = 0; b < 2; ++b)
#pragma unroll
                for (int m = 0; m < 4; ++m)
#pragma unroll
                    for (int n = 0; n < 2; ++n) acc[a][b][m][n] = (f32x4){0.f, 0.f, 0.f, 0.f};
        cur = nxt; cA = nA; cB = nB; ++ui;
        if constexpr (GATHER) { _Pragma("unroll") for (int h_ = 0; h_ < 2; ++h_) { cvo[h_][0] = nvo[h_][0]; cvo[h_][1] = nvo[h_][1]; } }
        if constexpr (ALIGN_EPI) { if (wr == 1) PG8_BAR; }
    }
    PG8_WAIT_V(0);
    if constexpr (!ALIGN_EPI) { if (wr == 0) PG8_BAR; }
    PG8_BAR;
    if constexpr (Epi::AFTER_DRAIN) { E.fused(acc, cur, wr, wc, fr, fq, lds, wid, lane); S.done(cur); }
#undef PG8_SA
#undef PG8_SB
#undef PG8_STAGE
#undef PG8_STAGE_A
#undef PG8_ROWS
#undef PG8_LDA
#undef PG8_LDB
#undef PG8_MMA
#undef PG8_WAIT_V
#undef PG8_WAIT_L
#undef PG8_BAR
#undef PG8_SCHED
}
}

constexpr int NWAVES = 8;
constexpr int NB = 8, SEQ = 4096, DM = 1024, MTOK = NB * SEQ, NLAYER = 2;
constexpr int INC = 2984, INCP = 3072;
constexpr int C_RET = 0, C_RW = 1024, C_DSA = 1920, C_SB = 2216;
constexpr int PBW = 1792, PFW = 1280, PB_SB = 1024, PF_DSA = 896;
constexpr int NEXP = 32, MOE_ROWS = MTOK * 4 + NEXP * 256;
constexpr int ROPE_W = 88;
constexpr int NCH = 16, TCH = SEQ / NCH;
constexpr int NPL = 11, NPHASE = 1 + NLAYER * NPL;
enum { I_X = 0, I_C, I_POS, I_ADAW, I_ADAB, I_NMIX, I_NFFN, I_WIN, I_RETGN, I_MU, I_W0, I_W2, I_A0, I_A2, I_G2, I_KK, I_KA, I_RK, I_LN, I_QNORM, I_WQ, I_WQI, I_DONORM, I_SONORM, I_WOUT, I_RW, I_RB, I_MW1, I_MB1, I_MW2, I_MB2, I_NFINAL, N_IN };

constexpr size_t MiB = 1u << 20;
constexpr size_t WS_CTL = 0, CTL_ZERO_BYTES = 1 * MiB;
constexpr size_t WS_MOD = 1 * MiB, WS_ROPE = 2 * MiB, WS_WIN = 14 * MiB, WS_WOUT = 26 * MiB, WS_W1 = 30 * MiB, WS_W2 = 286 * MiB;
constexpr size_t WS_XA = 414 * MiB, WS_H = 542 * MiB, WS_MIX = 606 * MiB, WS_TOPI = 670 * MiB, WS_TOPW = 671 * MiB, WS_POS = 672 * MiB;
constexpr size_t WS_R = 674 * MiB;
constexpr size_t WS_PB = WS_R  , WS_PF = WS_R + 112 * MiB  , WS_RWA = 1058 * MiB  , WS_DQ = 1314 * MiB  , WS_DKB = 1330 * MiB  , WS_DVB = 1334 * MiB  , WS_DQI = 1346 * MiB  , WS_DKI = 1394 * MiB  , WS_DW = 1398 * MiB;
constexpr size_t WS_SMALLW = 1338 * MiB  ;
constexpr int SMW_QI = 0, SMW_W2 = 512 * 128, SMW_A2 = SMW_W2 + 256 * 32, SMW_G2 = SMW_A2 + 256 * 32, SMW_LAYER = SMW_G2 + 256 * 64;
constexpr size_t WS_PT = 1362 * MiB  ;
constexpr size_t WS_CH = WS_H  , WS_SI = WS_H + 16 * MiB  , WS_SIR = WS_H + 24 * MiB  ,
                 WS_CHR = WS_H + 32 * MiB  , WS_PTR = WS_H + 40 * MiB  ;
constexpr size_t WS_SQ = WS_MIX  , WS_SK = WS_MIX + 16 * MiB, WS_SV = WS_MIX + 32 * MiB;
constexpr size_t WS_YO = 1400 * MiB  , WS_SC = 1528 * MiB  ;
constexpr size_t WS_XS = WS_R  , WS_ACT = 946 * MiB  ;
constexpr size_t WS_LIST = 2040 * MiB  , WS_END = 2044 * MiB;
constexpr int LCAP = 32768;
static_assert((size_t)MOE_ROWS * 2048 <= 272 * MiB, "moe buffers");
constexpr int CW_TMO = 0, CW_CODE = 1, CW_GCNT = 256  , CW_DSAQ = 1024  , CW_BAR = 4096, CW_BLKCNT = 16384  ;
constexpr int RING_BYTES = 131072, MISC_OFF = RING_BYTES + 320, TST_OFF = RING_BYTES + 1024  , TAB_OFF = RING_BYTES + 2048  , HIST_OFF = RING_BYTES + 5120  , BASE_OFF = RING_BYTES + 5376  , CNT_OFF = RING_BYTES + 5632  , TEXP_OFF = RING_BYTES + 6144  , LDS_BYTES = 147456;

#if defined(__HIP_DEVICE_COMPILE__)
#define GAS __attribute__((address_space(1)))
#define CAS __attribute__((address_space(4)))
#else
#define GAS
#define CAS
#endif
#define LAS __attribute__((address_space(3)))
typedef unsigned short bf16;
typedef unsigned v4u __attribute__((ext_vector_type(4)));
typedef unsigned v2u __attribute__((ext_vector_type(2)));
typedef float f32x4 __attribute__((ext_vector_type(4)));
typedef GAS unsigned gu32;
typedef short bf16x8v __attribute__((ext_vector_type(8)));
typedef short s16x4v __attribute__((ext_vector_type(4)));
typedef _Float16 f16x8 __attribute__((ext_vector_type(8)));
#define RLX_AGENT __ATOMIC_RELAXED, __HIP_MEMORY_SCOPE_AGENT
#define LDS_WAIT() asm volatile("s_waitcnt lgkmcnt(0)" ::: "memory")
#define VM_WAIT() asm volatile("s_waitcnt vmcnt(0)" ::: "memory")
__device__ __forceinline__ unsigned f2bf(float f) { unsigned u = __builtin_bit_cast(unsigned, f); return (u + 0x7fffu + ((u >> 16) & 1u)) >> 16; }
__device__ __forceinline__ unsigned pk2(float lo, float hi) { return f2bf(lo) | (f2bf(hi) << 16); }
__device__ __forceinline__ float bf_lo(unsigned w) { return __builtin_bit_cast(float, w << 16); }
__device__ __forceinline__ float bf_hi(unsigned w) { return __builtin_bit_cast(float, w & 0xffff0000u); }
__device__ __forceinline__ float wave_sum(float v) {
#pragma unroll
    for (int o = 1; o < 64; o <<= 1) v += __shfl_xor(v, o);
    return v;
}
__device__ __forceinline__ float wave_max(float v) {
#pragma unroll
    for (int o = 1; o < 64; o <<= 1) v = fmaxf(v, __shfl_xor(v, o));
    return v;
}
__device__ __forceinline__ float grp16_sum(float v) { v += __shfl_xor(v, 1); v += __shfl_xor(v, 2); v += __shfl_xor(v, 4); v += __shfl_xor(v, 8); return v; }
__device__ __forceinline__ float grp8_sum(float v) { v += __shfl_xor(v, 1); v += __shfl_xor(v, 2); v += __shfl_xor(v, 4); return v; }
__device__ __forceinline__ float sum4(f32x4 a) { return (a.x + a.y) + (a.z + a.w); }
__device__ __forceinline__ float dot4(f32x4 a, f32x4 b) { return (a.x * b.x + a.y * b.y) + (a.z * b.z + a.w * b.w); }
__device__ __forceinline__ float fexp(float x) { return __builtin_amdgcn_exp2f(x * 1.4426950408889634f); }
__device__ __forceinline__ float sigm(float x) { return __builtin_amdgcn_rcpf(1.0f + fexp(-x)); }
__device__ __forceinline__ float softplusf(float x) { return fmaxf(x, 0.0f) + 0.6931471805599453f * __builtin_amdgcn_logf(1.0f + fexp(-fabsf(x))); }
__device__ __forceinline__ float ftanh(float x) { const float e = fexp(-2.0f * fabsf(x)); const float t = (1.0f - e) * __builtin_amdgcn_rcpf(1.0f + e); return x < 0.0f ? -t : t; }
__device__ __forceinline__ f32x4 shx4(f32x4 v, int m) { f32x4 r; r.x = __shfl_xor(v.x, m); r.y = __shfl_xor(v.y, m); r.z = __shfl_xor(v.z, m); r.w = __shfl_xor(v.w, m); return r; }

#define XB_TMO      128
#define XB_XCNT(j)  (256  + 64 * (j))
#define XB_XSUB(j)  (1280 + 64 * (j))
#define XB_XGEN(j)  (2304 + 64 * (j))
#define XB_TOP      3328
#define XB_TOPGEN   3392
#define XCD_BAR_WORDS 3456
#define XB_SPIN_CAP (1u << 18)

__device__ __forceinline__ unsigned xb_ld(unsigned* p)              { return __hip_atomic_load(p, __ATOMIC_RELAXED, __HIP_MEMORY_SCOPE_AGENT); }
__device__ __forceinline__ unsigned xb_add(unsigned* p, unsigned v) { return __hip_atomic_fetch_add(p, v, __ATOMIC_RELAXED, __HIP_MEMORY_SCOPE_AGENT); }
__device__ __forceinline__ unsigned xb_xcc_id() { return (unsigned)__builtin_amdgcn_s_getreg((3 << 11) | 20) & 0xFu; }
#define XB_SPIN(cond, bar) do { unsigned _sp = 0; while (cond) { __builtin_amdgcn_s_sleep(1); \
    if ((++_sp & 255u) == 0u) { if (xb_ld(&(bar)[XB_TMO])) break; if (_sp > XB_SPIN_CAP) { atomicAdd(&(bar)[XB_TMO], 1u); break; } } } } while (0)

struct XcdBarrier {
    unsigned* bar; unsigned x;
    volatile LAS unsigned* st;
};

__device__ __forceinline__ XcdBarrier xcd_barrier_post(unsigned* bar, volatile LAS unsigned* st, int xb_tid) {
    XcdBarrier b; b.bar = bar; b.x = xb_xcc_id(); b.st = st;
    if (xb_tid == 0) (void)xb_add(&bar[XB_XCNT(b.x)], 1u);
    return b;
}
__device__ __forceinline__ void xcd_barrier_complete(unsigned* bar, unsigned x, unsigned& nloc, unsigned& nx) {
    const unsigned G = gridDim.x * gridDim.y * gridDim.z;
    unsigned sum, cnt, mine, sp = 0u;
    for (;;) {
        sum = 0u; cnt = 0u; mine = 0u;
#pragma unroll
        for (unsigned j = 0; j < 16; ++j) { const unsigned c = xb_ld(&bar[XB_XCNT(j)]); sum += c; cnt += (c > 0u) ? 1u : 0u; mine = (j == x) ? c : mine; }
        if (sum == G) break;
        __builtin_amdgcn_s_sleep(1);
        if ((++sp & 255u) == 0u) { if (xb_ld(&bar[XB_TMO])) break; if (sp > XB_SPIN_CAP) { atomicAdd(&bar[XB_TMO], 1u); break; } }
    }
    nloc = mine > 0u ? mine : 1u; nx = cnt > 0u ? cnt : 1u;
}

__device__ __forceinline__ void xcd_barrier(const XcdBarrier& b, int xb_tid) {
    asm volatile("s_waitcnt vmcnt(0)" ::: "memory");
    __syncthreads();
    if (xb_tid == 0) {
        unsigned* bar = b.bar;
        __builtin_amdgcn_s_waitcnt(0);
        unsigned nloc = b.st[0], nx = b.st[1];
        if (nloc == 0u) { xcd_barrier_complete(bar, b.x, nloc, nx); b.st[0] = nloc; b.st[1] = nx; }
        const unsigned old = xb_add(&bar[XB_XSUB(b.x)], 1u);
        const unsigned gen = old / nloc;
        if (old + 1u == (gen + 1u) * nloc) {
            __builtin_amdgcn_fence(__ATOMIC_RELEASE, "agent");
            asm volatile("s_waitcnt vmcnt(0)" ::: "memory");
            const unsigned og = xb_add(&bar[XB_TOP], 1u);
            const unsigned tg = og / nx;
            if (og + 1u == (tg + 1u) * nx) xb_add(&bar[XB_TOPGEN], 1u);
            else XB_SPIN(xb_ld(&bar[XB_TOPGEN]) == tg, bar);
            __builtin_amdgcn_fence(__ATOMIC_ACQUIRE, "agent");
            xb_add(&bar[XB_XGEN(b.x)], 1u);
            asm volatile("s_waitcnt vmcnt(0)" ::: "memory");
        } else {
            XB_SPIN(xb_ld(&bar[XB_XGEN(b.x)]) == gen, bar);
            __builtin_amdgcn_fence(__ATOMIC_ACQUIRE, "agent");
            asm volatile("s_waitcnt vmcnt(0)" ::: "memory");
        }
    }
    __syncthreads();
}
struct ArgsH { const float* in[N_IN]; float* out; unsigned char* ws; double invf[44]; int ph_lo, ph_hi, li, pad; };
struct ArgsD { const GAS float* in[N_IN]; GAS float* out; GAS unsigned char* ws; double invf[44]; int ph_lo, ph_hi, li, pad; };
static_assert(sizeof(ArgsH) == sizeof(ArgsD), "args layout");
typedef const CAS ArgsD& ARef;
__device__ __forceinline__ const CAS ArgsD* kargs() {
#if defined(__HIP_DEVICE_COMPILE__)
    const CAS ArgsD* p = (const CAS ArgsD*)__builtin_amdgcn_kernarg_segment_ptr(); asm volatile("" : "+s"(p)); return p;
#else
    return nullptr;
#endif
}
struct WI { LAS unsigned char* lds; int tid, lane, wave, vcu, G, gw, NGW, bx; };
constexpr size_t RWA_STRIDE = 32 * MiB / 4;
constexpr size_t YO_STRIDE = 32 * MiB / 4;

__device__ __forceinline__ int wave_sum_i(int v) {
#pragma unroll
    for (int o = 1; o < 64; o <<= 1) v += __shfl_xor(v, o);
    return v;
}
__device__ __forceinline__ void sincos_d(double ang, float& s, float& c) {
    const double q = __builtin_rint(ang * 0.63661977236758134308);
    double r = __builtin_fma(-q, 1.57079632679489661923, ang); r = __builtin_fma(-q, 6.123233995736766e-17, r);
    const double r2 = r * r;
    const double sp = r * (1.0 + r2 * (-1.0 / 6 + r2 * (1.0 / 120 + r2 * (-1.0 / 5040 + r2 * (1.0 / 362880 + r2 * (-1.0 / 39916800 + r2 * (1.0 / 6227020800.0)))))));
    const double cp = 1.0 + r2 * (-0.5 + r2 * (1.0 / 24 + r2 * (-1.0 / 720 + r2 * (1.0 / 40320 + r2 * (-1.0 / 3628800 + r2 * (1.0 / 479001600 + r2 * (-1.0 / 87178291200.0)))))));
    const int qi = ((int)q) & 3;
    const double ss = (qi == 0) ? sp : (qi == 1) ? cp : (qi == 2) ? -sp : -cp;
    const double cc = (qi == 0) ? cp : (qi == 1) ? -sp : (qi == 2) ? -cp : sp;
    s = (float)ss; c = (float)cc;
}

__device__ __forceinline__ void tr_item(const float* W, int ldw, int nvalid, int k0, int nsrc0, bf16* WT, size_t dstrow0, LAS float* scr, int lane, float scale = 1.0f) {
#pragma unroll 8
    for (int i = 0; i < 32; ++i) { const int kk = 2 * i + (lane >> 5), c = lane & 31, n = nsrc0 + c; scr[kk * 33 + c] = (n < nvalid) ? W[(size_t)(k0 + kk) * ldw + n] * scale : 0.0f; }
    LDS_WAIT(); asm volatile("" ::: "memory");
    const int c8 = lane & 7;
#pragma unroll
    for (int j = 0; j < 4; ++j) { const int n = (lane >> 3) + 8 * j; const LAS float* s = scr + (8 * c8) * 33 + n;
        v4u o; o.x = pk2(s[0 * 33], s[1 * 33]); o.y = pk2(s[2 * 33], s[3 * 33]); o.z = pk2(s[4 * 33], s[5 * 33]); o.w = pk2(s[6 * 33], s[7 * 33]);
        *(v4u*)(WT + (dstrow0 + n) * 1024 + k0 + 8 * c8) = o; }
    LDS_WAIT(); asm volatile("" ::: "memory");
}
__device__ __forceinline__ void ph_prologue(ARef A, const WI& w) {
    LAS float* sc = (LAS float*)w.lds;
    { const float* cin = A.in[I_C]; for (int i = w.tid; i < NB * DM; i += NWAVES * 64) { const float v = cin[i]; sc[i] = v / (1.0f + expf(-v)); } }
    __syncthreads();
    float* MOD = (float*)(A.ws + WS_MOD);
    if (w.wave == 0 && w.vcu < 192) {
        const int l = w.vcu / 96, col = (w.vcu % 96) * 64 + w.lane;
        const float* wp = A.in[I_ADAW] + (size_t)l * DM * 6144 + col;
        float acc[8];
#pragma unroll
        for (int b = 0; b < 8; ++b) acc[b] = 0.0f;
        for (int k = 0; k < DM; ++k) { const float wv = wp[(size_t)k * 6144];
#pragma unroll
            for (int b = 0; b < 8; ++b) acc[b] += sc[b * DM + k] * wv; }
        const float bias = A.in[I_ADAB][l * 6144 + col];
#pragma unroll
        for (int b = 0; b < 8; ++b) MOD[(size_t)(l * 8 + b) * 6144 + col] = acc[b] + bias;
    }
    LAS float* scr = (LAS float*)(w.lds + 32768 + w.wave * 8448);
    constexpr int I_IN = NLAYER * 16 * 96, I_OUT = NLAYER * 16 * 32, I_W1 = NLAYER * NEXP * 16 * 64, I_W2 = NLAYER * NEXP * 16 * 32, NIT = I_IN + I_OUT + I_W1 + I_W2;
    for (int it = w.gw; it < NIT; it += w.NGW) {
        int r = it;
        if (r < I_IN) { const int l = r / 1536, rr = r % 1536, kb = rr / 96, nb = rr % 96;
            const int nd = nb * 32;
            const int ns = (nd < 1024) ? nd : (nd < 1792) ? C_SB + (nd - 1024) : (nd < 2688) ? C_RW + (nd - 1792) : C_DSA + (nd - 2688);
            const int nv = (nd < 1024) ? 1024 : (nd < 1792) ? INC : (nd < 2688) ? C_DSA : ((nd < INC) ? C_SB : 0);
            const float sc_ = (nd >= 256 && nd < 512) ? 0.125f : (nd >= 1024 && nd < 1280) ? 0.18033688011112042f : 1.0f;
            tr_item(A.in[I_WIN] + (size_t)l * DM * INC, INC, nv, kb * 64, ns, (bf16*)(A.ws + WS_WIN) + (size_t)l * INCP * DM, (size_t)nd, scr, w.lane, sc_); continue; }
        r -= I_IN;
        if (r < I_OUT) { const int l = r / 512, rr = r % 512, kb = rr / 32, nb = rr % 32;
            tr_item(A.in[I_WOUT] + (size_t)l * DM * DM, DM, DM, kb * 64, nb * 32, (bf16*)(A.ws + WS_WOUT) + (size_t)l * DM * DM, (size_t)nb * 32, scr, w.lane); continue; }
        r -= I_OUT;
        if (r < I_W1) { const int le = r / 1024, rr = r % 1024, kb = rr / 64, nb = rr % 64, j = nb >> 3, bj = (nb >> 2) & 1, cc0 = (nb & 3) * 32;
            tr_item(A.in[I_MW1] + (size_t)le * DM * 2048, 2048, 2048, kb * 64, bj * 1024 + 128 * j + cc0, (bf16*)(A.ws + WS_W1) + (size_t)le * 2048 * DM, (size_t)nb * 32, scr, w.lane); continue; }
        r -= I_W1;
        { const int le = r / 512, rr = r % 512, kb = rr / 32, nb = rr % 32;
            tr_item(A.in[I_MW2] + (size_t)le * DM * DM, DM, DM, kb * 64, nb * 32, (bf16*)(A.ws + WS_W2) + (size_t)le * DM * DM, (size_t)nb * 32, scr, w.lane); }
    }
    float* RT = (float*)(A.ws + WS_ROPE); const int* pos = (const int*)A.in[I_POS];
    for (int g = w.gw * 64 + w.lane; g < MTOK * 44; g += w.NGW * 64) {
        const int tok = g / 44, f = g % 44; int co, so;
        if (f < 32) { co = f; so = 32 + f; } else if (f < 40) { co = 64 + (f - 32); so = 72 + (f - 32); } else { co = 80 + (f - 40); so = 84 + (f - 40); }
        float s, c; sincos_d((double)pos[tok] * A.invf[f], s, c);
        RT[(size_t)tok * ROPE_W + co] = c; RT[(size_t)tok * ROPE_W + so] = s;
    }
}

__device__ __forceinline__ void emit_h_row(const f32x4 (&v)[4], float rstd, const float* g, const float* sc, const float* sh, bf16* hrow, int lane) {
#pragma unroll
    for (int j = 0; j < 4; ++j) { const int k = 4 * (lane + 64 * j);
        const f32x4 gv = *(const f32x4*)(g + k), scv = *(const f32x4*)(sc + k), shv = *(const f32x4*)(sh + k);
        const f32x4 h = v[j] * rstd * gv * (1.0f + scv) + shv;
        v2u o; o.x = pk2(h.x, h.y); o.y = pk2(h.z, h.w); *(v2u*)(hrow + k) = o; }
}
__device__ __forceinline__ void small_weights_to_f16(ARef A, const WI& w) {
    { _Float16* SW = (_Float16*)(A.ws + WS_SMALLW);
      const int g0 = w.gw * 64 + w.lane, gs = w.NGW * 64;
      for (int l = 0; l < NLAYER; ++l) { _Float16* S = SW + (size_t)l * SMW_LAYER;
          const float* wq = A.in[I_WQ] + (size_t)l * 128 * 256; const float* wqi = A.in[I_WQI] + (size_t)l * 128 * 256;
          for (int e = g0; e < 256 * 128; e += gs) { const int n = e >> 7, k = e & 127; S[SMW_QI + e] = (_Float16)wq[k * 256 + n]; S[SMW_QI + 256 * 128 + e] = (_Float16)wqi[k * 256 + n]; }
          const float* w2 = A.in[I_W2] + (size_t)l * 32 * 256; const float* a2 = A.in[I_A2] + (size_t)l * 32 * 256; const float* g2 = A.in[I_G2] + (size_t)l * 64 * 256;
          for (int e = g0; e < 256 * 32; e += gs) { const int n = e >> 5, k = e & 31; S[SMW_W2 + e] = (_Float16)w2[k * 256 + n]; S[SMW_A2 + e] = (_Float16)a2[k * 256 + n]; }
          for (int e = g0; e < 256 * 64; e += gs) { const int n = e >> 6, k = e & 63; S[SMW_G2 + e] = (_Float16)g2[k * 256 + n]; } } }
}
__device__ __forceinline__ void ph_norm1(ARef A, const WI& w) {
    const float* MOD = (const float*)(A.ws + WS_MOD); bf16* H = (bf16*)(A.ws + WS_H);
    for (int m = w.gw; m < MTOK; m += w.NGW) {
        const float* xr = A.in[I_X] + (size_t)m * DM; f32x4 v[4]; float ss = 0.0f;
#pragma unroll
        for (int j = 0; j < 4; ++j) { v[j] = *(const f32x4*)(xr + 4 * (w.lane + 64 * j)); ss += dot4(v[j], v[j]); }
        ss = wave_sum(ss); const float rstd = 1.0f / sqrtf(ss * (1.0f / DM) + 1e-5f);
        const float* mb = MOD + (size_t)(m >> 12) * 6144;
        emit_h_row(v, rstd, A.in[I_NMIX], mb + 1024, mb, H + (size_t)m * DM, w.lane);
    }
}

typedef _Float16 h4v __attribute__((ext_vector_type(4)));
__device__ __forceinline__ f16x8 pack_f16x8(f32x4 a, f32x4 b) { f16x8 r; r[0] = (_Float16)a.x; r[1] = (_Float16)a.y; r[2] = (_Float16)a.z; r[3] = (_Float16)a.w; r[4] = (_Float16)b.x; r[5] = (_Float16)b.y; r[6] = (_Float16)b.z; r[7] = (_Float16)b.w; return r; }
__device__ __forceinline__ void prep16(ARef A, int l, int m0, int lane_in) {
    int lane = lane_in; asm volatile("" : "+v"(lane));
    const int tk = lane & 15, q4 = lane >> 4, m = m0 + tk, t = m & (SEQ - 1);
    const float* P = (const float*)(A.ws + WS_PF); float* RWA = (float*)(A.ws + WS_RWA); const _Float16* SW = (const _Float16*)(A.ws + WS_SMALLW) + (size_t)l * SMW_LAYER;
    const float* pr = P + (size_t)m * PFW; const float* pp = pr - PFW; const float* pd = P + (size_t)m * PFW + PF_DSA; const float* mu = A.in[I_MU] + l * 896;
    const float* RT = (const float*)(A.ws + WS_ROPE) + (size_t)m * ROPE_W; const f32x4 zero4 = {0.f, 0.f, 0.f, 0.f};
    f16x8 bx[4], bc[4];
    { float ss = 0.0f; f32x4 c[4][2];
#pragma unroll
      for (int ks = 0; ks < 4; ++ks) { const int f0 = 32 * ks + 8 * q4;
          f32x4 x[2];
#pragma unroll
          for (int u = 0; u < 2; ++u) { const f32x4 z = *(const f32x4*)(pr + 768 + f0 + 4 * u); const f32x4 p = t ? *(const f32x4*)(pp + 768 + f0 + 4 * u) : zero4; x[u] = z + (p - z) * *(const f32x4*)(mu + 768 + f0 + 4 * u);
#pragma unroll
              for (int i = 0; i < 4; ++i) x[u][i] = (ks == 0) ? ftanh(x[u][i]) : (ks == 1) ? x[u][i] : sigm(x[u][i]); }
          bx[ks] = pack_f16x8(x[0], x[1]);
          c[ks][0] = *(const f32x4*)(pd + f0); c[ks][1] = *(const f32x4*)(pd + f0 + 4); ss += dot4(c[ks][0], c[ks][0]) + dot4(c[ks][1], c[ks][1]); }
      ss += __shfl_xor(ss, 16); ss += __shfl_xor(ss, 32);
      const float rstd = 1.0f / sqrtf(ss * (1.0f / 128.0f) + 1e-5f); const float* qn = A.in[I_QNORM] + l * 128;
#pragma unroll
      for (int ks = 0; ks < 4; ++ks) { const int f0 = 32 * ks + 8 * q4; bc[ks] = pack_f16x8(c[ks][0] * rstd * *(const f32x4*)(qn + f0), c[ks][1] * rstd * *(const f32x4*)(qn + f0 + 4)); } }
    const _Float16* wrow = SW + (size_t)tk * 0;
    (void)wrow;
    const int arow = lane & 15;
#pragma unroll 1
    for (int hd = 0; hd < 4; ++hd) {
        f32x4 fk[4], av[4]; float ssk = 0.0f;
#pragma unroll
        for (int j = 0; j < 4; ++j) { const int nb = 4 * hd + j, ch = 16 * nb + 4 * q4; const size_t o = (size_t)m * 256 + ch;
            const f16x8 aw = *(const f16x8*)(SW + SMW_W2 + (16 * nb + arow) * 32 + 8 * q4), aa = *(const f16x8*)(SW + SMW_A2 + (16 * nb + arow) * 32 + 8 * q4);
            const f16x8 ag0 = *(const f16x8*)(SW + SMW_G2 + (16 * nb + arow) * 64 + 8 * q4), ag1 = *(const f16x8*)(SW + SMW_G2 + (16 * nb + arow) * 64 + 32 + 8 * q4);
            const f32x4 cw = __builtin_amdgcn_mfma_f32_16x16x32_f16(aw, bx[0], *(const f32x4*)(A.in[I_W0] + l * 256 + ch), 0, 0, 0);
            const f32x4 ca = __builtin_amdgcn_mfma_f32_16x16x32_f16(aa, bx[1], *(const f32x4*)(A.in[I_A0] + l * 256 + ch), 0, 0, 0);
            f32x4 cg = __builtin_amdgcn_mfma_f32_16x16x32_f16(ag0, bx[2], zero4, 0, 0, 0); cg = __builtin_amdgcn_mfma_f32_16x16x32_f16(ag1, bx[3], cg, 0, 0, 0);
            f32x4 dec;
#pragma unroll
            for (int i = 0; i < 4; ++i) { dec[i] = fexp(-fexp(-softplusf(-cw[i]) - 0.5f)); av[j][i] = sigm(ca[i]); }
            *(f32x4*)(RWA + 1 * RWA_STRIDE + o) = dec; *(f32x4*)(RWA + 6 * RWA_STRIDE + o) = cg;
            { const f32x4 z = *(const f32x4*)(pr + 256 + ch); const f32x4 p = t ? *(const f32x4*)(pp + 256 + ch) : zero4; fk[j] = z + (p - z) * *(const f32x4*)(mu + 256 + ch); }
            const f32x4 kk = fk[j] * *(const f32x4*)(A.in[I_KK] + l * 256 + ch); ssk += dot4(kk, kk); }
        ssk += __shfl_xor(ssk, 16); ssk += __shfl_xor(ssk, 32);
        const float inrm = 1.0f / fmaxf(sqrtf(ssk), 1e-12f);
        f32x4 fr[4], km[4]; float bs = 0.0f;
#pragma unroll
        for (int j = 0; j < 4; ++j) { const int ch = 16 * (4 * hd + j) + 4 * q4;
            { const f32x4 z = *(const f32x4*)(pr + ch); const f32x4 p = t ? *(const f32x4*)(pp + ch) : zero4; fr[j] = z + (p - z) * *(const f32x4*)(mu + ch); }
            km[j] = fk[j] * (1.0f + (av[j] - 1.0f) * *(const f32x4*)(A.in[I_KA] + l * 256 + ch)); bs += dot4(fr[j] * km[j], *(const f32x4*)(A.in[I_RK] + l * 256 + ch)); }
        bs += __shfl_xor(bs, 16); bs += __shfl_xor(bs, 32);
#pragma unroll
        for (int j = 0; j < 4; ++j) { const int ch = 16 * (4 * hd + j) + 4 * q4; const size_t o = (size_t)m * 256 + ch;
            f32x4 fv; { const f32x4 z = *(const f32x4*)(pr + 512 + ch); const f32x4 p = t ? *(const f32x4*)(pp + 512 + ch) : zero4; fv = z + (p - z) * *(const f32x4*)(mu + 512 + ch); }
            const f32x4 kk = fk[j] * *(const f32x4*)(A.in[I_KK] + l * 256 + ch) * inrm;
            *(f32x4*)(RWA + 0 * RWA_STRIDE + o) = fr[j]; *(f32x4*)(RWA + 2 * RWA_STRIDE + o) = km[j]; *(f32x4*)(RWA + 3 * RWA_STRIDE + o) = fv;
            *(f32x4*)(RWA + 4 * RWA_STRIDE + o) = -kk; *(f32x4*)(RWA + 5 * RWA_STRIDE + o) = kk * av[j]; *(f32x4*)(RWA + 7 * RWA_STRIDE + o) = bs * fv; }
    }
#pragma unroll 1
    for (int nb = 0; nb < 32; ++nb) {
        f32x4 cq = zero4;
#pragma unroll
        for (int ks = 0; ks < 4; ++ks) { const f16x8 aq = *(const f16x8*)(SW + SMW_QI + (16 * nb + arow) * 128 + 32 * ks + 8 * q4); cq = __builtin_amdgcn_mfma_f32_16x16x32_f16(aq, bc[ks], cq, 0, 0, 0); }
        const int ch = 16 * (nb & 15) + 4 * q4;
        if (nb < 16) {
            if ((nb & 3) == 0) { const f32x4 ot = shx4(cq, 32); const int fi = 4 * (q4 & 1); const f32x4 cs4 = *(const f32x4*)(RT + 64 + fi), sn = *(const f32x4*)(RT + 72 + fi); cq = (q4 < 2) ? cq * cs4 - ot * sn : ot * sn + cq * cs4; }
            const f32x4 qs = cq * 0.18033688011112042f; v2u o; o.x = pk2(qs.x, qs.y); o.y = pk2(qs.z, qs.w); *(v2u*)((bf16*)(A.ws + WS_DQ) + (size_t)m * 256 + ch) = o;
        } else {
            if ((nb & 1) == 0) { const f32x4 ot = shx4(cq, 16); const f32x4 cs4 = *(const f32x4*)(RT + 80), sn = *(const f32x4*)(RT + 84); if (q4 < 2) cq = (q4 < 1) ? cq * cs4 - ot * sn : ot * sn + cq * cs4; }
            h4v hq; hq.x = (_Float16)cq.x; hq.y = (_Float16)cq.y; hq.z = (_Float16)cq.z; hq.w = (_Float16)cq.w; *(h4v*)((_Float16*)(A.ws + WS_DQI) + (size_t)m * 256 + ch) = hq;
        }
    }
#pragma unroll
    for (int j = 0; j < 4; ++j) { const int d = 16 * j + 4 * q4; f32x4 kx = *(const f32x4*)(pd + 128 + d);
        if (j == 0) { const f32x4 ot = shx4(kx, 32); const int fi = 4 * (q4 & 1); const f32x4 cs4 = *(const f32x4*)(RT + 64 + fi), sn = *(const f32x4*)(RT + 72 + fi); kx = (q4 < 2) ? kx * cs4 - ot * sn : ot * sn + kx * cs4; }
        v2u o; o.x = pk2(kx.x, kx.y); o.y = pk2(kx.z, kx.w); *(v2u*)((bf16*)(A.ws + WS_DKB) + (size_t)m * 64 + d) = o;
        const f32x4 vx = *(const f32x4*)(pd + 192 + d); v2u ov; ov.x = pk2(vx.x, vx.y); ov.y = pk2(vx.z, vx.w); *(v2u*)((bf16*)(A.ws + WS_DVB) + (size_t)m * 64 + d) = ov; }
#pragma unroll
    for (int j = 0; j < 2; ++j) { const int d = 16 * j + 4 * q4; f32x4 ki = *(const f32x4*)(pd + 256 + d);
        if (j == 0) { const f32x4 ot = shx4(ki, 16); const f32x4 cs4 = *(const f32x4*)(RT + 80), sn = *(const f32x4*)(RT + 84); if (q4 < 2) ki = (q4 < 1) ? ki * cs4 - ot * sn : ot * sn + ki * cs4; }
        h4v hk; hk.x = (_Float16)ki.x; hk.y = (_Float16)ki.y; hk.z = (_Float16)ki.z; hk.w = (_Float16)ki.w; *(h4v*)((_Float16*)(A.ws + WS_DKI) + (size_t)m * 32 + d) = hk; }
    if (q4 < 2) *(f32x4*)((float*)(A.ws + WS_DW) + (size_t)m * 8 + 4 * q4) = *(const f32x4*)(pd + 288 + 4 * q4) * 0.0625f;
}
__device__ __forceinline__ float quad_sum(float v) {
    v += __builtin_bit_cast(float, __builtin_amdgcn_mov_dpp(__builtin_bit_cast(int, v), 0xB1, 0xF, 0xF, true));
    v += __builtin_bit_cast(float, __builtin_amdgcn_mov_dpp(__builtin_bit_cast(int, v), 0x4E, 0xF, 0xF, true));
    return v;
}
__device__ __forceinline__ float oct_sum(float v) {
    v += __builtin_bit_cast(float, __builtin_amdgcn_mov_dpp(__builtin_bit_cast(int, v), 0xB1, 0xF, 0xF, true));
    v += __builtin_bit_cast(float, __builtin_amdgcn_mov_dpp(__builtin_bit_cast(int, v), 0x4E, 0xF, 0xF, true));
    v += __builtin_bit_cast(float, __builtin_amdgcn_mov_dpp(__builtin_bit_cast(int, v), 0x141, 0xF, 0xF, true));
    return v;
}
typedef float f32x2 __attribute__((ext_vector_type(2)));
#define LO2(v_) __builtin_shufflevector(v_, v_, 0, 1)
#define HI2(v_) __builtin_shufflevector(v_, v_, 2, 3)
#define RW_ROW(i_) (((i_) < 2) ? (16 * ws + rg + 8 * (i_)) : (64 + 16 * ws + rg + 8 * ((i_) - 2)))
#define RW_LOAD(op, s_) do { const int lo_ = (s_) * 64 + kq * 8; \
    op[0] = *(const LAS f32x4*)(sn + lo_); op[1] = *(const LAS f32x4*)(sn + lo_ + 4); op[2] = *(const LAS f32x4*)(sw + lo_); op[3] = *(const LAS f32x4*)(sw + lo_ + 4); \
    op[4] = *(const LAS f32x4*)(sb + lo_); op[5] = *(const LAS f32x4*)(sb + lo_ + 4); op[6] = *(const LAS f32x4*)(sk + lo_); op[7] = *(const LAS f32x4*)(sk + lo_ + 4); \
    op[8] = *(const LAS f32x4*)(sr + lo_); op[9] = *(const LAS f32x4*)(sr + lo_ + 4); \
    vin[0] = sv[(s_) * 64 + 16 * ws + rg]; vin[1] = sv[(s_) * 64 + 16 * ws + rg + 8]; } while (0)
#define RW_DOT(i_, oa, ob) ({ f32x2 d_ = S[i_][0] * LO2(oa); d_ = S[i_][1] * HI2(oa) + d_; d_ = S[i_][2] * LO2(ob) + d_; d_ = S[i_][3] * HI2(ob) + d_; d_.x + d_.y; })
#define RW_STEP(op, vv, s_) do { float sa_[4], y_[4]; \
    _Pragma("unroll") for (int i_ = 0; i_ < 4; ++i_) sa_[i_] = RW_DOT(i_, op[0], op[1]); \
    _Pragma("unroll") for (int i_ = 0; i_ < 4; ++i_) sa_[i_] += __builtin_bit_cast(float, __builtin_amdgcn_mov_dpp(__builtin_bit_cast(int, sa_[i_]), 0xB1, 0xF, 0xF, true)); \
    _Pragma("unroll") for (int i_ = 0; i_ < 4; ++i_) sa_[i_] += __builtin_bit_cast(float, __builtin_amdgcn_mov_dpp(__builtin_bit_cast(int, sa_[i_]), 0x4E, 0xF, 0xF, true)); \
    _Pragma("unroll") for (int i_ = 0; i_ < 4; ++i_) sa_[i_] += __builtin_bit_cast(float, __builtin_amdgcn_mov_dpp(__builtin_bit_cast(int, sa_[i_]), 0x141, 0xF, 0xF, true)); \
    _Pragma("unroll") for (int i_ = 0; i_ < 2; ++i_) { const f32x2 a2_ = {sa_[i_], sa_[i_]}, v2_ = {vv[i_], vv[i_]}; \
        S[i_][0] = S[i_][0] * LO2(op[2]) + (a2_ * LO2(op[4]) + v2_ * LO2(op[6])); S[i_][1] = S[i_][1] * HI2(op[2]) + (a2_ * HI2(op[4]) + v2_ * HI2(op[6])); \
        S[i_][2] = S[i_][2] * LO2(op[3]) + (a2_ * LO2(op[5]) + v2_ * LO2(op[7])); S[i_][3] = S[i_][3] * HI2(op[3]) + (a2_ * HI2(op[5]) + v2_ * HI2(op[7])); } \
    _Pragma("unroll") for (int i_ = 2; i_ < 4; ++i_) { const f32x2 a2_ = {sa_[i_], sa_[i_]}; \
        S[i_][0] = S[i_][0] * LO2(op[2]) + a2_ * LO2(op[4]); S[i_][1] = S[i_][1] * HI2(op[2]) + a2_ * HI2(op[4]); S[i_][2] = S[i_][2] * LO2(op[3]) + a2_ * LO2(op[5]); S[i_][3] = S[i_][3] * HI2(op[3]) + a2_ * HI2(op[5]); } \
    _Pragma("unroll") for (int i_ = 0; i_ < 4; ++i_) y_[i_] = RW_DOT(i_, op[8], op[9]); \
    _Pragma("unroll") for (int i_ = 0; i_ < 4; ++i_) y_[i_] += __builtin_bit_cast(float, __builtin_amdgcn_mov_dpp(__builtin_bit_cast(int, y_[i_]), 0xB1, 0xF, 0xF, true)); \
    _Pragma("unroll") for (int i_ = 0; i_ < 4; ++i_) y_[i_] += __builtin_bit_cast(float, __builtin_amdgcn_mov_dpp(__builtin_bit_cast(int, y_[i_]), 0x4E, 0xF, 0xF, true)); \
    _Pragma("unroll") for (int i_ = 0; i_ < 4; ++i_) y_[i_] += __builtin_bit_cast(float, __builtin_amdgcn_mov_dpp(__builtin_bit_cast(int, y_[i_]), 0x141, 0xF, 0xF, true)); \
    if (kq == 0) { _Pragma("unroll") for (int i_ = 0; i_ < 4; ++i_) so[(s_) * 128 + RW_ROW(i_)] = y_[i_]; } } while (0)
__device__ __forceinline__ void scan_rwkv_task2(ARef A, const WI& w, int task0) {
    const int slot = w.wave >> 2, ws = w.wave & 3, lt = w.tid & 255, task = task0 + slot;
    const int bh = task >> 4, c = task & 15, b = bh >> 2, h = bh & 3;
    LAS float* sw = (LAS float*)w.lds + slot * 16384; LAS float* sn = sw + 2048; LAS float* sb = sn + 2048; LAS float* sk = sb + 2048; LAS float* sr = sk + 2048; LAS float* sv = sr + 2048; LAS float* so = sv + 2048;
    const float* RWA = (const float*)(A.ws + WS_RWA);
    const int rg = w.lane >> 3, kq = w.lane & 7;
    f32x2 S[4][4];
#pragma unroll
    for (int i = 0; i < 4; ++i)
#pragma unroll
        for (int j = 0; j < 4; ++j) { const int r = RW_ROW(i); S[i][j].x = (r >= 64 && 8 * kq + 2 * j == r - 64) ? 1.0f : 0.0f; S[i][j].y = (r >= 64 && 8 * kq + 2 * j + 1 == r - 64) ? 1.0f : 0.0f; }
    const size_t tok0 = (size_t)b * SEQ + (size_t)c * TCH;
    const int st = lt >> 3, sd = (lt & 7) * 8;
    f32x4 a[6][2];
#define RW_GLOAD(sub_) do { const size_t o_ = (tok0 + (sub_) * 32 + st) * 256 + h * 64 + sd; \
        _Pragma("unroll") for (int q = 0; q < 2; ++q) { a[0][q] = *(const f32x4*)(RWA + 1 * RWA_STRIDE + o_ + 4 * q); a[1][q] = *(const f32x4*)(RWA + 4 * RWA_STRIDE + o_ + 4 * q); a[2][q] = *(const f32x4*)(RWA + 5 * RWA_STRIDE + o_ + 4 * q); \
            a[3][q] = *(const f32x4*)(RWA + 2 * RWA_STRIDE + o_ + 4 * q); a[4][q] = *(const f32x4*)(RWA + 0 * RWA_STRIDE + o_ + 4 * q); a[5][q] = *(const f32x4*)(RWA + 3 * RWA_STRIDE + o_ + 4 * q); } } while (0)
    RW_GLOAD(0);
    for (int sub = 0; sub < TCH / 32; ++sub) {
        __syncthreads();
        { const int lo = st * 64 + sd;
#pragma unroll
          for (int q = 0; q < 2; ++q) { *(LAS f32x4*)(sw + lo + 4 * q) = a[0][q]; *(LAS f32x4*)(sn + lo + 4 * q) = a[1][q]; *(LAS f32x4*)(sb + lo + 4 * q) = a[2][q]; *(LAS f32x4*)(sk + lo + 4 * q) = a[3][q]; *(LAS f32x4*)(sr + lo + 4 * q) = a[4][q]; *(LAS f32x4*)(sv + lo + 4 * q) = a[5][q]; } }
        __syncthreads();
        if (sub + 1 < TCH / 32) RW_GLOAD(sub + 1);
        { f32x4 opA[10], opB[10]; float vin[2], vA[2], vB[2];
          RW_LOAD(opA, 0);
          vA[0] = vin[0]; vA[1] = vin[1];
#pragma unroll 1
          for (int s = 0; s < 32; s += 2) {
              RW_LOAD(opB, s + 1);
              vB[0] = vin[0]; vB[1] = vin[1];
              RW_STEP(opA, vA, s);
              if (s + 2 < 32) { RW_LOAD(opA, s + 2); vA[0] = vin[0]; vA[1] = vin[1]; }
              RW_STEP(opB, vB, s + 1);
          } }
        __syncthreads();
        { const int fs = lt >> 3, c16 = (lt & 7) * 16;
          float* dst = (c16 < 64) ? ((float*)(A.ws + WS_YO) + YO_STRIDE) : ((float*)(A.ws + WS_PT) - 64);
          float* dp = dst + (tok0 + sub * 32 + fs) * 256 + h * 64 + c16;
#pragma unroll
          for (int q = 0; q < 4; ++q) *(f32x4*)(dp + 4 * q) = *(const LAS f32x4*)(so + fs * 128 + c16 + 4 * q); }
    }
    { float* ch = (float*)(A.ws + WS_CH) + ((size_t)(bh * NCH + c) * 128) * 64 + 8 * kq;
#pragma unroll
      for (int i = 0; i < 4; ++i) { float* cr = ch + (size_t)RW_ROW(i) * 64; *(f32x4*)cr = (f32x4){S[i][0].x, S[i][0].y, S[i][1].x, S[i][1].y}; *(f32x4*)(cr + 4) = (f32x4){S[i][2].x, S[i][2].y, S[i][3].x, S[i][3].y}; } }
    __syncthreads();
}
#undef RW_LOAD
#undef RW_STEP
#undef RW_GLOAD
#undef RW_DOT
#undef RW_ROW
__device__ __forceinline__ void scan_ret_task(ARef A, const WI& w, int task) {
    const int bh = task >> 3, cp = task & 7, b = bh >> 2, h = bh & 3, un = w.tid >> 8, lt = w.tid & 255, c = 2 * cp + un;
    const float lg2g = log2f(1.0f - exp2f(-5.0f - (float)h)), gamma = exp2f(lg2g);
    LAS float* sk = (LAS float*)w.lds + un * 8192; LAS float* sq = sk + 2048; LAS float* sv = sq + 2048; LAS float* so = sv + 2048;
    const bf16* PB = (const bf16*)(A.ws + WS_PB); const float* RT = (const float*)(A.ws + WS_ROPE);
    const int row = lt >> 2, kq = lt & 3;
    f32x2 S[8];
#pragma unroll
    for (int j = 0; j < 8; ++j) S[j] = (f32x2){0.0f, 0.0f};
    const f32x2 gam2 = {gamma, gamma};
    const size_t tok0 = (size_t)b * SEQ + (size_t)c * TCH;
    const int st = lt >> 3, sd = (lt & 7) * 8;
    const int fi = sd & 31, dp = sd ^ 32;
    f32x4 gq[2], gqo[2], gk[2], gko[2], gv[2], gcs[2], gsn[2];
#define BF8_TO_F32(dst, x_) do { dst[0] = (f32x4){bf_lo(x_.x), bf_hi(x_.x), bf_lo(x_.y), bf_hi(x_.y)}; dst[1] = (f32x4){bf_lo(x_.z), bf_hi(x_.z), bf_lo(x_.w), bf_hi(x_.w)}; } while (0)
#define RT_GLOAD(sub_) do { const size_t m_ = tok0 + (sub_) * 32 + st; const bf16* pr_ = PB + m_ * PBW + h * 64; const float* rt_ = RT + m_ * ROPE_W; \
        _Pragma("unroll") for (int u = 0; u < 2; ++u) { gcs[u] = *(const f32x4*)(rt_ + fi + 4 * u); gsn[u] = *(const f32x4*)(rt_ + 32 + fi + 4 * u); } \
        { const v4u x0 = *(const v4u*)(pr_ + sd), x1 = *(const v4u*)(pr_ + dp), x2 = *(const v4u*)(pr_ + 256 + sd), x3 = *(const v4u*)(pr_ + 256 + dp), x4 = *(const v4u*)(pr_ + 512 + sd); \
          BF8_TO_F32(gq, x0); BF8_TO_F32(gqo, x1); BF8_TO_F32(gk, x2); BF8_TO_F32(gko, x3); BF8_TO_F32(gv, x4); } } while (0)
    RT_GLOAD(0);
    for (int sub = 0; sub < TCH / 32; ++sub) {
        const size_t m = tok0 + sub * 32 + st;
        f32x4 qn[2], kn[2], vn[2];
#pragma unroll
        for (int u = 0; u < 2; ++u) { qn[u] = (sd < 32) ? gq[u] * gcs[u] - gqo[u] * gsn[u] : gqo[u] * gsn[u] + gq[u] * gcs[u]; kn[u] = (sd < 32) ? gk[u] * gcs[u] - gko[u] * gsn[u] : gko[u] * gsn[u] + gk[u] * gcs[u]; vn[u] = gv[u]; }
        { const float gt = exp2f(lg2g * (float)(sub * 32 + st + 1)); const f32x4 p0 = qn[0] * gt, p1 = qn[1] * gt;
          v4u pw; pw.x = pk2(p0.x, p0.y); pw.y = pk2(p0.z, p0.w); pw.z = pk2(p1.x, p1.y); pw.w = pk2(p1.z, p1.w); *(v4u*)((bf16*)(A.ws + WS_PTR) + m * 256 + h * 64 + sd) = pw; }
        __syncthreads();
        { const int lo = st * 64 + sd; *(LAS f32x4*)(sq + lo) = qn[0]; *(LAS f32x4*)(sq + lo + 4) = qn[1]; *(LAS f32x4*)(sk + lo) = kn[0]; *(LAS f32x4*)(sk + lo + 4) = kn[1]; *(LAS f32x4*)(sv + lo) = vn[0]; *(LAS f32x4*)(sv + lo + 4) = vn[1]; }
        __syncthreads();
        if (sub + 1 < TCH / 32) RT_GLOAD(sub + 1);
        for (int s = 0; s < 32; ++s) {
            const int lo = s * 64 + kq * 16; const float vv = sv[s * 64 + row]; const f32x2 v2 = {vv, vv}; f32x2 y2 = {0.0f, 0.0f};
#pragma unroll
            for (int j4 = 0; j4 < 4; ++j4) { const f32x4 kv = *(const LAS f32x4*)(sk + lo + 4 * j4), rv = *(const LAS f32x4*)(sq + lo + 4 * j4);
                S[2 * j4] = S[2 * j4] * gam2 + v2 * LO2(kv); S[2 * j4 + 1] = S[2 * j4 + 1] * gam2 + v2 * HI2(kv);
                y2 = S[2 * j4] * LO2(rv) + y2; y2 = S[2 * j4 + 1] * HI2(rv) + y2; }
            float y = quad_sum(y2.x + y2.y);
            if (kq == 0) so[s * 64 + row] = y;
        }
        __syncthreads();
        { const int fs = lt >> 3, c8 = (lt & 7) * 8; float* dp2 = (float*)(A.ws + WS_YO) + (tok0 + sub * 32 + fs) * 256 + h * 64 + c8;
          *(f32x4*)dp2 = *(const LAS f32x4*)(so + fs * 64 + c8); *(f32x4*)(dp2 + 4) = *(const LAS f32x4*)(so + fs * 64 + c8 + 4); }
    }
    { float* ch = (float*)(A.ws + WS_CHR) + ((size_t)(bh * NCH + c) * 64 + row) * 64 + 16 * kq;
#pragma unroll
      for (int j4 = 0; j4 < 4; ++j4) *(f32x4*)(ch + 4 * j4) = (f32x4){S[2 * j4].x, S[2 * j4].y, S[2 * j4 + 1].x, S[2 * j4 + 1].y}; }
    __syncthreads();
}
#undef RT_GLOAD
#undef BF8_TO_F32
__device__ __forceinline__ void prefix_chain(ARef A, const WI& w, int bh) {
    LAS float* s0 = (LAS float*)w.lds;
    const int v = w.tid >> 3, k8 = (w.tid & 7) * 8;
    const float* CH = (const float*)(A.ws + WS_CH) + (size_t)bh * NCH * 128 * 64; float* SI = (float*)(A.ws + WS_SI) + (size_t)bh * NCH * 64 * 64;
    f32x4 c0 = {0.f, 0.f, 0.f, 0.f}, c1 = {0.f, 0.f, 0.f, 0.f};
    for (int c = 0; c < NCH; ++c) {
        *(f32x4*)(SI + ((size_t)c * 64 + v) * 64 + k8) = c0; *(f32x4*)(SI + ((size_t)c * 64 + v) * 64 + k8 + 4) = c1;
        if (c == NCH - 1) break;
        __syncthreads();
        *(LAS f32x4*)(s0 + v * 68 + k8) = c0; *(LAS f32x4*)(s0 + v * 68 + k8 + 4) = c1;
        __syncthreads();
        const float* ch = CH + (size_t)c * 128 * 64;
        f32x4 n0 = *(const f32x4*)(ch + (size_t)v * 64 + k8), n1 = *(const f32x4*)(ch + (size_t)v * 64 + k8 + 4);
#pragma unroll 8
        for (int kp = 0; kp < 64; ++kp) { const float s = s0[v * 68 + kp]; const float* pr = ch + (size_t)(64 + kp) * 64 + k8; n0 += s * *(const f32x4*)pr; n1 += s * *(const f32x4*)(pr + 4); }
        c0 = n0; c1 = n1;
    }
    const int h = bh & 3; const float gT = exp2f((float)TCH * log2f(1.0f - exp2f(-5.0f - (float)h)));
    const float* CHR = (const float*)(A.ws + WS_CHR) + (size_t)bh * NCH * 64 * 64; float* SIR = (float*)(A.ws + WS_SIR) + (size_t)bh * NCH * 64 * 64;
    c0 = (f32x4){0.f, 0.f, 0.f, 0.f}; c1 = c0;
    for (int c = 0; c < NCH; ++c) {
        *(f32x4*)(SIR + ((size_t)c * 64 + v) * 64 + k8) = c0; *(f32x4*)(SIR + ((size_t)c * 64 + v) * 64 + k8 + 4) = c1;
        if (c == NCH - 1) break;
        c0 = c0 * gT + *(const f32x4*)(CHR + ((size_t)c * 64 + v) * 64 + k8); c1 = c1 * gT + *(const f32x4*)(CHR + ((size_t)c * 64 + v) * 64 + k8 + 4);
    }
    __syncthreads();
}
typedef float f32x16 __attribute__((ext_vector_type(16)));
constexpr int SBV_PITCH = 144;
__device__ __forceinline__ float lane32_swap(float v) { return __shfl_xor(v, 32); }
__device__ __forceinline__ void sb_tile_mfma(ARef A, int unit, int lane, LAS unsigned char* vl) {
    const int tq = unit & 127, bh = unit >> 7, b = bh >> 2, h = bh & 3, t0 = tq * 32, r32 = lane & 31, hi = lane >> 5;
    const bf16* PS = (const bf16*)(A.ws + WS_PB) + (size_t)b * SEQ * PBW + PB_SB + h * 64;
    bf16x8v qf[4];
#pragma unroll
    for (int ks = 0; ks < 4; ++ks) qf[ks] = *(const bf16x8v*)(PS + (size_t)(t0 + r32) * PBW + 16 * ks + 8 * hi);
    f32x16 o0, o1;
#pragma unroll
    for (int r = 0; r < 16; ++r) { o0[r] = 0.0f; o1[r] = 0.0f; }
    float carry = 0.0f;
    const int g16 = lane >> 4, tj = (lane & 15) >> 2, tc = lane & 3;
    for (int kb0 = t0; kb0 >= 0; kb0 -= 32) {
#pragma unroll
        for (int i = 0; i < 4; ++i) { const int p = lane + 64 * i, row = p >> 3, ch = p & 7; const v4u v = *(const v4u*)(PS + 512 + (size_t)(kb0 + row) * PBW + 8 * ch); *(LAS v4u*)(vl + row * SBV_PITCH + 16 * ch) = v; }
        f32x16 st;
#pragma unroll
        for (int r = 0; r < 16; ++r) st[r] = 0.0f;
        { bf16x8v ka[4];
#pragma unroll
          for (int ks = 0; ks < 4; ++ks) ka[ks] = *(const bf16x8v*)(PS + 256 + (size_t)(kb0 + r32) * PBW + 16 * ks + 8 * hi);
#pragma unroll
          for (int ks = 0; ks < 4; ++ks) st = __builtin_amdgcn_mfma_f32_32x32x16_bf16(ka[ks], qf[ks], st, 0, 0, 0);
          asm volatile("" :: "v"(ka[0]), "v"(ka[1]), "v"(ka[2]), "v"(ka[3]), "v"(st)); }
        float sp[16]; const bool diag = (kb0 == t0);
#pragma unroll
        for (int r = 0; r < 16; ++r) { const float zl = st[r]; float s = (zl > 30.0f) ? zl : __builtin_amdgcn_logf(1.0f + __builtin_amdgcn_exp2f(zl));
            if (diag && ((r & 3) + 8 * (r >> 2) + 4 * hi >= r32)) s = 0.0f;
            sp[r] = s; }
        float G[4], Gp[4], suf[4];
#pragma unroll
        for (int q = 0; q < 4; ++q) { G[q] = (sp[4 * q] + sp[4 * q + 1]) + (sp[4 * q + 2] + sp[4 * q + 3]); Gp[q] = lane32_swap(G[q]); }
        suf[3] = 0.0f; suf[2] = G[3] + Gp[3]; suf[1] = suf[2] + (G[2] + Gp[2]); suf[0] = suf[1] + (G[1] + Gp[1]);
        const float tot = suf[0] + (G[0] + Gp[0]);
        pg8::u32x4 pw0, pw1;
        float av[16];
#pragma unroll
        for (int q = 0; q < 4; ++q) { float run = carry + suf[q] + (hi == 0 ? Gp[q] : 0.0f);
#pragma unroll
            for (int i = 3; i >= 0; --i) { const int r = 4 * q + i; const float la = (st[r] - sp[r]) - run; float a = __builtin_amdgcn_exp2f(la);
                if (diag && ((r & 3) + 8 * (r >> 2) + 4 * hi >= r32)) a = 0.0f;
                av[r] = a; run += sp[r]; } }
        pw0.x = pg8::cvt_pk_bf16(av[0], av[1]); pw0.y = pg8::cvt_pk_bf16(av[2], av[3]); pw0.z = pg8::cvt_pk_bf16(av[4], av[5]); pw0.w = pg8::cvt_pk_bf16(av[6], av[7]);
        pw1.x = pg8::cvt_pk_bf16(av[8], av[9]); pw1.y = pg8::cvt_pk_bf16(av[10], av[11]); pw1.z = pg8::cvt_pk_bf16(av[12], av[13]); pw1.w = pg8::cvt_pk_bf16(av[14], av[15]);
        const bf16x8v pa0 = __builtin_bit_cast(bf16x8v, pw0), pa1 = __builtin_bit_cast(bf16x8v, pw1);
        LDS_WAIT();
#pragma unroll
        for (int s = 0; s < 2; ++s)
#pragma unroll
            for (int nb = 0; nb < 2; ++nb) {
                LAS unsigned char* a1 = vl + (16 * s + 4 * (g16 >> 1) + tj) * SBV_PITCH + (32 * nb + 16 * (g16 & 1) + 4 * tc) * 2;
                const s16x4v r1 = __builtin_bit_cast(s16x4v, __builtin_amdgcn_ds_read_tr16_b64_v4i16((LAS s16x4v*)a1));
                const s16x4v r2 = __builtin_bit_cast(s16x4v, __builtin_amdgcn_ds_read_tr16_b64_v4i16((LAS s16x4v*)(a1 + 8 * SBV_PITCH)));
                const bf16x8v bv = {r1[0], r1[1], r1[2], r1[3], r2[0], r2[1], r2[2], r2[3]};
                if (nb == 0) o0 = __builtin_amdgcn_mfma_f32_32x32x16_bf16(s ? pa1 : pa0, bv, o0, 0, 0, 0); else o1 = __builtin_amdgcn_mfma_f32_32x32x16_bf16(s ? pa1 : pa0, bv, o1, 0, 0, 0);
                asm volatile("" :: "v"(bv), "v"(pa0), "v"(pa1), "v"(o0), "v"(o1)); }
        LDS_WAIT();
        carry += tot;
        if (__all(carry > 150.0f)) break;
    }
    float* YS = (float*)(A.ws + WS_YO) + 3 * YO_STRIDE + ((size_t)b * SEQ + t0) * 256 + h * 64 + r32;
#pragma unroll
    for (int r = 0; r < 16; ++r) { const int qo = (r & 3) + 8 * (r >> 2) + 4 * hi; YS[(size_t)qo * 256] = o0[r]; YS[(size_t)qo * 256 + 32] = o1[r]; }
}

__device__ __forceinline__ void dsa_scores_mfma(ARef A, const WI& w) {
    const _Float16* QIH = (const _Float16*)(A.ws + WS_DQI); const _Float16* KIH = (const _Float16*)(A.ws + WS_DKI);
    const float* DW = (const float*)(A.ws + WS_DW); float* SC = (float*)(A.ws + WS_SC);
    const int col = w.lane & 15, q4 = w.lane >> 4;
    for (int u = w.gw; u < 2048; u += w.NGW) {
        const int pi = u >> 1, par = u & 1, b = pi >> 7, p = pi & 127;
#pragma unroll 1
        for (int side = 0; side < 2; ++side) {
            const int qb = side ? 255 - p : p; const size_t m0 = (size_t)b * SEQ + 16 * qb;
            f16x8 bq[8];
#pragma unroll
            for (int h = 0; h < 8; ++h) bq[h] = *(const f16x8*)(QIH + (m0 + col) * 256 + h * 32 + 8 * q4);
            const float* dw = DW + (m0 + col) * 8; const f32x4 wa = *(const f32x4*)dw, wb = *(const f32x4*)(dw + 4);
            float* srow = SC + (m0 + col) * SEQ + 4 * q4;
            const _Float16* kbase = KIH + ((size_t)b * SEQ + col) * 32 + 8 * q4;
            for (int kp = par; 2 * kp <= qb; kp += 2) {
#pragma unroll
                for (int sub = 0; sub < 2; ++sub) { const int kb = 2 * kp + sub; if (kb > qb) break;
                    const f16x8 ak = *(const f16x8*)(kbase + (size_t)kb * 16 * 32);
                    f32x4 acc = {0.f, 0.f, 0.f, 0.f};
#pragma unroll
                    for (int h = 0; h < 8; ++h) { const f32x4 c = __builtin_amdgcn_mfma_f32_16x16x32_f16(ak, bq[h], (f32x4){0.f, 0.f, 0.f, 0.f}, 0, 0, 0); const float wv = (h < 4) ? wa[h] : wb[h - 4];
                        acc.x += wv * fmaxf(c.x, 0.f); acc.y += wv * fmaxf(c.y, 0.f); acc.z += wv * fmaxf(c.z, 0.f); acc.w += wv * fmaxf(c.w, 0.f); }
                    *(f32x4*)(srow + 16 * kb) = acc + 0.0f; }
            }
        }
    }
}

__device__ __forceinline__ int wave_total_i(int v) {
    v += __builtin_amdgcn_mov_dpp(v, 0xB1, 0xF, 0xF, true);
    v += __builtin_amdgcn_mov_dpp(v, 0x4E, 0xF, 0xF, true);
    v += __builtin_amdgcn_mov_dpp(v, 0x141, 0xF, 0xF, true);
    v += __builtin_amdgcn_mov_dpp(v, 0x140, 0xF, 0xF, true);
    return __builtin_amdgcn_readlane(v, 0) + __builtin_amdgcn_readlane(v, 16) + __builtin_amdgcn_readlane(v, 32) + __builtin_amdgcn_readlane(v, 48);
}
__device__ __forceinline__ unsigned score_key(float f) { const unsigned bits = __float_as_uint(f); return (bits & 0x80000000u) ? ~bits : (bits | 0x80000000u); }
constexpr int VST_PITCH = 144;
typedef unsigned short u16;
__device__ __forceinline__ void dsa_load_scores(ARef A, int m, int lane, f32x4 (&sv)[16]) {
    const int n = (m & (SEQ - 1)) + 1; const float* sc = (const float*)(A.ws + WS_SC) + (size_t)m * SEQ;
#pragma unroll
    for (int j4 = 0; j4 < 16; ++j4) sv[j4] = *(const f32x4*)(sc + ((256 * j4 < n) ? 256 * j4 : 0) + 4 * lane);
}
__device__ __forceinline__ void dsa_select(ARef A, int m, int n, int lane_in, LAS u16* slist, LAS unsigned* bk) {
    int lane = lane_in; asm volatile("" : "+v"(lane));
    if (n <= 256) {
#pragma unroll
        for (int c = 0; c < 4; ++c) { const int idx = lane + 64 * c; slist[idx] = (u16)((idx < n) ? idx : 0); }
        return;
    }
    f32x4 sv[16]; dsa_load_scores(A, m, lane, sv);
    unsigned u[64];
#pragma unroll
    for (int j4 = 0; j4 < 16; ++j4)
#pragma unroll
        for (int i = 0; i < 4; ++i) u[4 * j4 + i] = (256 * j4 + 4 * lane + i < n) ? score_key(sv[j4][i]) : 0u;
    unsigned T = 0u;
    for (int bit = 31; bit >= 16; --bit) { const unsigned cand = T | (1u << bit); int cnt = 0;
#pragma unroll
        for (int j = 0; j < 64; ++j) cnt += (u[j] >= cand) ? 1 : 0;
        if (wave_total_i(cnt) >= 256) T = cand; }
    unsigned long long bkb = 0ull; int chi = 0;
#pragma unroll
    for (int j = 0; j < 64; ++j) { bkb |= (unsigned long long)(((u[j] >> 16) == (T >> 16)) ? 1u : 0u) << j; chi += ((u[j] >> 16) > (T >> 16)) ? 1 : 0; }
    const int cb = wave_total_i(__popcll(bkb)), need = 256 - wave_total_i(chi);
    if (cb <= 64) {
        int pos = __popcll(bkb);
        { const int mine_ = pos;
#pragma unroll
          for (int d = 1; d < 64; d <<= 1) { const int y = __shfl_up(pos, d); if (lane >= d) pos += y; }
          pos -= mine_; }
#pragma unroll
        for (int j = 0; j < 64; ++j) { if ((bkb >> j) & 1ull) { bk[pos] = u[j]; ++pos; } }
        LDS_WAIT();
        const unsigned kx = (lane < cb) ? bk[lane] : 0u;
        for (int bit = 15; bit >= 0; --bit) { const unsigned cand = T | (1u << bit); if (__popcll(__ballot(kx >= cand)) >= need) T = cand; }
        LDS_WAIT();
    } else {
        for (int bit = 15; bit >= 0; --bit) { const unsigned cand = T | (1u << bit); int cnt = 0;
#pragma unroll
            for (int j = 0; j < 64; ++j) cnt += (u[j] >= cand) ? 1 : 0;
            if (wave_total_i(cnt) >= 256) T = cand; }
    }
    unsigned long long gtb = 0ull, eqb = 0ull;
#pragma unroll
    for (int j = 0; j < 64; ++j) { gtb |= (unsigned long long)((u[j] > T) ? 1u : 0u) << j; eqb |= (unsigned long long)((u[j] == T) ? 1u : 0u) << j; }
    const int tgt = wave_total_i(__popcll(gtb)), teq = wave_total_i(__popcll(eqb));
    unsigned long long selb = gtb | eqb;
    if (tgt + teq > 256) {
        const int take = 256 - tgt; int lo = 0;
        for (int bit = 11; bit >= 0; --bit) { const int cand = lo | (1 << bit); const int J4 = cand >> 8; int ni = (cand & 255) - 4 * lane; ni = ni < 0 ? 0 : (ni > 4 ? 4 : ni);
            const int jc = 4 * J4 + ni; const unsigned long long msk = (jc >= 64) ? ~0ull : ((1ull << jc) - 1ull);
            if (wave_total_i(__popcll(eqb & msk)) < take) lo = cand; }
        { const int cand = lo + 1; const int J4 = cand >> 8; int ni = (cand & 255) - 4 * lane; ni = ni < 0 ? 0 : (ni > 4 ? 4 : ni);
          const int jc = (cand >= SEQ) ? 64 : 4 * J4 + ni; const unsigned long long msk = (jc >= 64) ? ~0ull : ((1ull << jc) - 1ull); selb = gtb | (eqb & msk); }
    }
    const int mine = __popcll(selb); int off = mine;
#pragma unroll
    for (int d = 1; d < 64; d <<= 1) { const int y = __shfl_up(off, d); if (lane >= d) off += y; }
    off -= mine;
    while (selb) { const int j = __builtin_ctzll(selb); selb &= selb - 1ull; slist[off] = (u16)(256 * (j >> 2) + 4 * lane + (j & 3)); ++off; }
}
__device__ __forceinline__ void dsa_attend(ARef A, int m, int lane_in, const LAS u16* slist, LAS unsigned char* vbuf) {
    int lane = lane_in; asm volatile("" : "+v"(lane));
    const int b = m >> 12, t = m & (SEQ - 1), n = t + 1, nsel = n < 256 ? n : 256, col = lane & 15, q4 = lane >> 4;
    const bf16* DKB = (const bf16*)(A.ws + WS_DKB) + (size_t)b * SEQ * 64; const bf16* DVB = (const bf16*)(A.ws + WS_DVB) + (size_t)b * SEQ * 64;
    const int vrow = lane >> 3, vpc = lane & 7;
    bf16x8v bq0 = {0, 0, 0, 0, 0, 0, 0, 0}, bq1 = {0, 0, 0, 0, 0, 0, 0, 0};
    if (col < 4) { const bf16* qp = (const bf16*)(A.ws + WS_DQ) + (size_t)m * 256 + col * 64 + 8 * q4; bq0 = *(const bf16x8v*)qp; bq1 = *(const bf16x8v*)(qp + 32); }
    f32x4 lg[16];
#pragma unroll
    for (int hb = 0; hb < 2; ++hb) {
        bf16x8v a0[8], a1[8];
#pragma unroll
        for (int k = 0; k < 8; ++k) { const int s = slist[16 * (8 * hb + k) + col]; const bf16* kr = DKB + (size_t)s * 64 + 8 * q4; a0[k] = *(const bf16x8v*)kr; a1[k] = *(const bf16x8v*)(kr + 32); }
#pragma unroll
        for (int k = 0; k < 8; ++k) { const f32x4 c = __builtin_amdgcn_mfma_f32_16x16x32_bf16(a0[k], bq0, (f32x4){0.f, 0.f, 0.f, 0.f}, 0, 0, 0); lg[8 * hb + k] = __builtin_amdgcn_mfma_f32_16x16x32_bf16(a1[k], bq1, c, 0, 0, 0); }
        __builtin_amdgcn_sched_barrier(0);
    }
    if (nsel < 256) {
#pragma unroll
        for (int kb = 0; kb < 16; ++kb)
#pragma unroll
            for (int r = 0; r < 4; ++r) if (16 * kb + 4 * q4 + r >= nsel) lg[kb][r] = -INFINITY; }
    v4u vr[4];
#pragma unroll
    for (int i = 0; i < 4; ++i) { const int s = slist[vrow + 8 * i]; vr[i] = *(const v4u*)(DVB + (size_t)s * 64 + 8 * vpc); }
    float mx = -INFINITY;
#pragma unroll
    for (int kb = 0; kb < 16; ++kb) mx = fmaxf(fmaxf(mx, fmaxf(lg[kb].x, lg[kb].y)), fmaxf(lg[kb].z, lg[kb].w));
    mx = fmaxf(mx, __shfl_xor(mx, 16)); mx = fmaxf(mx, __shfl_xor(mx, 32));
    float sm = 0.f;
#pragma unroll
    for (int kb = 0; kb < 16; ++kb) { lg[kb].x = __builtin_amdgcn_exp2f(lg[kb].x - mx); lg[kb].y = __builtin_amdgcn_exp2f(lg[kb].y - mx); lg[kb].z = __builtin_amdgcn_exp2f(lg[kb].z - mx); lg[kb].w = __builtin_amdgcn_exp2f(lg[kb].w - mx); sm += (lg[kb].x + lg[kb].y) + (lg[kb].z + lg[kb].w); }
    sm += __shfl_xor(sm, 16); sm += __shfl_xor(sm, 32);
    const float inv = 1.0f / sm;
    bf16x8v pa[8];
#pragma unroll
    for (int i = 0; i < 8; ++i) { const f32x4 x = lg[2 * i] * inv, y = lg[2 * i + 1] * inv;
        pg8::u32x4 wv; wv.x = pg8::cvt_pk_bf16(x.x, x.y); wv.y = pg8::cvt_pk_bf16(x.z, x.w); wv.z = pg8::cvt_pk_bf16(y.x, y.y); wv.w = pg8::cvt_pk_bf16(y.z, y.w);
        pa[i] = __builtin_bit_cast(bf16x8v, wv); }
    f32x4 o[4];
#pragma unroll
    for (int nb = 0; nb < 4; ++nb) o[nb] = (f32x4){0.f, 0.f, 0.f, 0.f};
    const int tj = col >> 2, tc = col & 3;
#pragma unroll
    for (int c = 0; c < 8; ++c) {
        LAS unsigned char* vb = vbuf + (c & 1) * (32 * VST_PITCH);
#pragma unroll
        for (int i = 0; i < 4; ++i) *(LAS v4u*)(vb + (vrow + 8 * i) * VST_PITCH + 16 * vpc) = vr[i];
        if (c < 7) {
#pragma unroll
            for (int i = 0; i < 4; ++i) { const int s = slist[32 * (c + 1) + vrow + 8 * i]; vr[i] = *(const v4u*)(DVB + (size_t)s * 64 + 8 * vpc); } }
        LDS_WAIT();
#pragma unroll
        for (int nb = 0; nb < 4; ++nb) {
            LAS unsigned char* a1 = vb + (4 * q4 + tj) * VST_PITCH + (16 * nb + 4 * tc) * 2;
            const s16x4v r1 = __builtin_bit_cast(s16x4v, __builtin_amdgcn_ds_read_tr16_b64_v4i16((LAS s16x4v*)a1));
            const s16x4v r2 = __builtin_bit_cast(s16x4v, __builtin_amdgcn_ds_read_tr16_b64_v4i16((LAS s16x4v*)(a1 + 16 * VST_PITCH)));
            const bf16x8v bv = {r1[0], r1[1], r1[2], r1[3], r2[0], r2[1], r2[2], r2[3]};
            o[nb] = __builtin_amdgcn_mfma_f32_16x16x32_bf16(pa[c], bv, o[nb], 0, 0, 0); }
    }
    LDS_WAIT();
    if (lane < 16) { float* YD = (float*)(A.ws + WS_YO) + 2 * YO_STRIDE + (size_t)m * 256;
#pragma unroll
        for (int nb = 0; nb < 4; ++nb) { YD[16 * nb + lane] = o[nb].x; YD[64 + 16 * nb + lane] = o[nb].y; YD[128 + 16 * nb + lane] = o[nb].z; YD[192 + 16 * nb + lane] = o[nb].w; } }
}
__device__ __forceinline__ int dsa_row_of(int batch, int gi, int r) { const int h = 4 * gi + (r >> 1); return batch * SEQ + ((r & 1) ? (SEQ - 1 - h) : h); }
__device__ __forceinline__ void dsa_wave(ARef A, const WI& w, LAS unsigned char* wl, int qi) {
    LAS u16* lists = (LAS u16*)wl; LAS unsigned char* vbuf = wl + 4096; LAS unsigned* bk = (LAS unsigned*)vbuf;
#pragma unroll 1
    for (int kb = 0; kb < NB; ++kb) {
        const int batch = (w.bx + kb) & (NB - 1);
        unsigned* head = (unsigned*)(A.ws + WS_CTL) + CW_DSAQ + 128 * qi + 16 * batch;
        for (;;) {
            int g = 0; if (w.lane == 0) g = (int)atomicAdd(head, 1u);
            g = __builtin_amdgcn_readfirstlane(g);
            if (g >= SEQ / 8) break;
#pragma unroll 1
            for (int r = 0; r < 8; ++r) { const int m = dsa_row_of(batch, g, r), n = (m & (SEQ - 1)) + 1; dsa_select(A, m, n, w.lane, lists + r * 256, bk); }
            LDS_WAIT();
#pragma unroll 1
            for (int r = 0; r < 8; ++r) dsa_attend(A, dsa_row_of(batch, g, r), w.lane, lists + r * 256, vbuf);
        }
    }
}

__device__ __forceinline__ f32x4 head_norm4(f32x4 y, float eps, f32x4 g) {
    const float mean = grp16_sum(sum4(y)) * (1.0f / 64.0f); const f32x4 yc = y - mean;
    const float var = grp16_sum(dot4(yc, yc)) * (1.0f / 64.0f); return yc * (1.0f / sqrtf(var + eps)) * g;
}
template <bool BF> __device__ __forceinline__ f32x4 state_corr(const LAS float* sl, int hh, int r16, const void* pv) {
    const LAS float* r0 = sl + (hh * 64 + 4 * r16) * 64; const int x0 = (4 * r16) & 15;
    f32x4 out = {0.f, 0.f, 0.f, 0.f};
#pragma unroll 2
    for (int k8 = 0; k8 < 8; ++k8) {
        f32x4 pa, pb;
        if (BF) { const v4u x = ((const v4u*)pv)[k8]; pa = (f32x4){bf_lo(x.x), bf_hi(x.x), bf_lo(x.y), bf_hi(x.y)}; pb = (f32x4){bf_lo(x.z), bf_hi(x.z), bf_lo(x.w), bf_hi(x.w)}; }
        else { pa = ((const f32x4*)pv)[2 * k8]; pb = ((const f32x4*)pv)[2 * k8 + 1]; }
#pragma unroll
        for (int i = 0; i < 4; ++i) { const LAS float* rowp = r0 + i * 64; const int xs = (x0 + i) & 15;
            out[i] += dot4(*(const LAS f32x4*)(rowp + 4 * ((2 * k8) ^ xs)), pa) + dot4(*(const LAS f32x4*)(rowp + 4 * ((2 * k8 + 1) ^ xs)), pb); }
    }
    return out;
}
__device__ __forceinline__ void post_row(ARef A, int l, int m, int lane, const LAS float* slw, const LAS float* slr) {
    const float* YO = (const float*)(A.ws + WS_YO); const float* RWA = (const float*)(A.ws + WS_RWA);
    bf16* MX = (bf16*)(A.ws + WS_MIX) + (size_t)m * DM; const int c4 = 4 * lane, hh = lane >> 4, r16 = lane & 15; const size_t o = (size_t)m * 256 + c4;
    { f32x4 y = *(const f32x4*)(YO + o) + state_corr<true>(slr, hh, r16, (const bf16*)(A.ws + WS_PTR) + (size_t)m * 256 + hh * 64);
      y = head_norm4(y, 1e-5f, *(const f32x4*)(A.in[I_RETGN] + l * 256 + c4));
      const v2u gw_ = *(const v2u*)((const bf16*)(A.ws + WS_PB) + (size_t)m * PBW + 768 + c4); const f32x4 g = {bf_lo(gw_.x), bf_hi(gw_.x), bf_lo(gw_.y), bf_hi(gw_.y)};
#pragma unroll
      for (int i = 0; i < 4; ++i) y[i] *= g[i] * sigm(g[i]);
      v2u w; w.x = pk2(y.x, y.y); w.y = pk2(y.z, y.w); *(v2u*)(MX + c4) = w; }
    { f32x4 y = *(const f32x4*)(YO + YO_STRIDE + o) + state_corr<false>(slw, hh, r16, (const float*)(A.ws + WS_PT) + (size_t)m * 256 + hh * 64);
      y = head_norm4(y, 64e-5f, *(const f32x4*)(A.in[I_LN] + l * 256 + c4));
      y = (y + *(const f32x4*)(RWA + 7 * RWA_STRIDE + o)) * *(const f32x4*)(RWA + 6 * RWA_STRIDE + o);
      v2u w; w.x = pk2(y.x, y.y); w.y = pk2(y.z, y.w); *(v2u*)(MX + 256 + c4) = w; }
    { f32x4 y = *(const f32x4*)(YO + 2 * YO_STRIDE + o); const float r = 1.0f / sqrtf(wave_sum(dot4(y, y)) * (1.0f / 256.0f) + 1e-5f);
      y = y * r * *(const f32x4*)(A.in[I_DONORM] + l * 256 + c4);
      v2u w; w.x = pk2(y.x, y.y); w.y = pk2(y.z, y.w); *(v2u*)(MX + 512 + c4) = w; }
    { f32x4 y = *(const f32x4*)(YO + 3 * YO_STRIDE + o); const float r = 1.0f / sqrtf(wave_sum(dot4(y, y)) * (1.0f / 256.0f) + 1e-5f);
      y = y * r * *(const f32x4*)(A.in[I_SONORM] + l * 256 + c4);
      v2u w; w.x = pk2(y.x, y.y); w.y = pk2(y.z, y.w); *(v2u*)(MX + 768 + c4) = w; }
}
__device__ __forceinline__ void ph_post(ARef A, const WI& w, int l) {
    LAS float* slw = (LAS float*)w.lds; LAS float* slr = slw + 16384;
    for (int u = w.vcu; u < NB * NCH * 2; u += w.G) {
        const int b = u >> 5, c = (u >> 1) & 15, half = u & 1;
        __syncthreads();
        for (int e = w.tid; e < 4096; e += NWAVES * 64) { const int hh = e >> 10, v = (e >> 4) & 63, k4 = e & 15;
            const size_t src = ((size_t)((b * 4 + hh) * NCH + c) * 64 + v) * 64 + 4 * k4; const int dst = (hh * 64 + v) * 64 + 4 * (k4 ^ (v & 15));
            *(LAS f32x4*)(slw + dst) = *(const f32x4*)((const float*)(A.ws + WS_SI) + src); *(LAS f32x4*)(slr + dst) = *(const f32x4*)((const float*)(A.ws + WS_SIR) + src); }
        __syncthreads();
        const int tok0 = b * SEQ + c * TCH + half * 128 + w.wave * 16;
        for (int i = 0; i < 16; ++i) post_row(A, l, tok0 + i, w.lane, slw, slr);
    }
}

constexpr int S0_PITCH = 144;
template <int MIXER> __device__ __forceinline__ void post16_head(ARef A, int l, size_t m, int hh, int tk, int fq, const LAS unsigned char* s0) {
    const size_t o = m * 256 + hh * 64 + 8 * fq;
    bf16x8v pb[2];
    if (MIXER == 0) { const bf16* pp = (const bf16*)(A.ws + WS_PTR) + o; pb[0] = *(const bf16x8v*)pp; pb[1] = *(const bf16x8v*)(pp + 32); }
    else { const float* pp = (const float*)(A.ws + WS_PT) + o;
#pragma unroll
        for (int ks = 0; ks < 2; ++ks) { const f32x4 a = *(const f32x4*)(pp + 32 * ks), b = *(const f32x4*)(pp + 32 * ks + 4);
            pg8::u32x4 wv; wv.x = pg8::cvt_pk_bf16(a.x, a.y); wv.y = pg8::cvt_pk_bf16(a.z, a.w); wv.z = pg8::cvt_pk_bf16(b.x, b.y); wv.w = pg8::cvt_pk_bf16(b.z, b.w); pb[ks] = __builtin_bit_cast(bf16x8v, wv); } }
    f32x4 y[4];
    const float* yl = (const float*)(A.ws + WS_YO) + MIXER * YO_STRIDE + o;
#pragma unroll
    for (int mb = 0; mb < 4; ++mb) y[mb] = *(const f32x4*)(yl + 32 * (mb >> 1) + 4 * (mb & 1));
    const float* gw = ((MIXER == 0) ? A.in[I_RETGN] : A.in[I_LN]) + l * 256 + hh * 64 + 8 * fq;
    f32x4 gn[4], e0[4], e1[4];
#pragma unroll
    for (int mb = 0; mb < 4; ++mb) gn[mb] = *(const f32x4*)(gw + 32 * (mb >> 1) + 4 * (mb & 1));
    if (MIXER == 0) {
#pragma unroll
        for (int j = 0; j < 2; ++j) { const v4u gx = *(const v4u*)((const bf16*)(A.ws + WS_PB) + m * PBW + 768 + hh * 64 + 8 * fq + 32 * j);
            e0[2 * j] = (f32x4){bf_lo(gx.x), bf_hi(gx.x), bf_lo(gx.y), bf_hi(gx.y)}; e0[2 * j + 1] = (f32x4){bf_lo(gx.z), bf_hi(gx.z), bf_lo(gx.w), bf_hi(gx.w)}; }
    } else { const float* RWA = (const float*)(A.ws + WS_RWA);
#pragma unroll
        for (int mb = 0; mb < 4; ++mb) { e0[mb] = *(const f32x4*)(RWA + 7 * RWA_STRIDE + o + 32 * (mb >> 1) + 4 * (mb & 1)); e1[mb] = *(const f32x4*)(RWA + 6 * RWA_STRIDE + o + 32 * (mb >> 1) + 4 * (mb & 1)); } }
    const LAS unsigned char* ab = s0 + ((MIXER * 4 + hh) * 64 + 8 * (tk >> 2) + (tk & 3)) * S0_PITCH + 16 * fq;
#pragma unroll
    for (int mb = 0; mb < 4; ++mb)
#pragma unroll
        for (int ks = 0; ks < 2; ++ks) { const bf16x8v af = *(const LAS bf16x8v*)(ab + (32 * (mb >> 1) + 4 * (mb & 1)) * S0_PITCH + 64 * ks); y[mb] = __builtin_amdgcn_mfma_f32_16x16x32_bf16(af, pb[ks], y[mb], 0, 0, 0); }
    float s = (sum4(y[0]) + sum4(y[1])) + (sum4(y[2]) + sum4(y[3])); s += __shfl_xor(s, 16); s += __shfl_xor(s, 32);
    const float mean = s * (1.0f / 64.0f);
#pragma unroll
    for (int mb = 0; mb < 4; ++mb) y[mb] = y[mb] - mean;
    float q = (dot4(y[0], y[0]) + dot4(y[1], y[1])) + (dot4(y[2], y[2]) + dot4(y[3], y[3])); q += __shfl_xor(q, 16); q += __shfl_xor(q, 32);
    const float rs = 1.0f / sqrtf(q * (1.0f / 64.0f) + ((MIXER == 0) ? 1e-5f : 64e-5f));
    bf16* MX = (bf16*)(A.ws + WS_MIX) + m * DM + MIXER * 256 + hh * 64 + 8 * fq;
#pragma unroll
    for (int j = 0; j < 2; ++j) { f32x4 ya = y[2 * j] * rs * gn[2 * j], yb = y[2 * j + 1] * rs * gn[2 * j + 1];
        if (MIXER == 0) {
#pragma unroll
            for (int i = 0; i < 4; ++i) { ya[i] *= e0[2 * j][i] * sigm(e0[2 * j][i]); yb[i] *= e0[2 * j + 1][i] * sigm(e0[2 * j + 1][i]); }
        } else { ya = (ya + e0[2 * j]) * e1[2 * j]; yb = (yb + e0[2 * j + 1]) * e1[2 * j + 1]; }
        v4u wv; wv.x = pk2(ya.x, ya.y); wv.y = pk2(ya.z, ya.w); wv.z = pk2(yb.x, yb.y); wv.w = pk2(yb.z, yb.w); *(v4u*)(MX + 32 * j) = wv; }
}
__device__ __forceinline__ void post16_rms(ARef A, int l, size_t m, int mx, int fq) {
    const float* yp = (const float*)(A.ws + WS_YO) + (size_t)mx * YO_STRIDE + m * 256 + 8 * fq; const float* gw = ((mx == 2) ? A.in[I_DONORM] : A.in[I_SONORM]) + l * 256 + 8 * fq;
    f32x4 y[16];
#pragma unroll
    for (int j = 0; j < 8; ++j) { y[2 * j] = *(const f32x4*)(yp + 32 * j); y[2 * j + 1] = *(const f32x4*)(yp + 32 * j + 4); }
    float q = 0.0f;
#pragma unroll
    for (int j = 0; j < 16; ++j) q += dot4(y[j], y[j]);
    q += __shfl_xor(q, 16); q += __shfl_xor(q, 32);
    const float r = 1.0f / sqrtf(q * (1.0f / 256.0f) + 1e-5f);
    bf16* MX = (bf16*)(A.ws + WS_MIX) + m * DM + mx * 256 + 8 * fq;
#pragma unroll
    for (int j = 0; j < 8; ++j) { const f32x4 ya = y[2 * j] * r * *(const f32x4*)(gw + 32 * j), yb = y[2 * j + 1] * r * *(const f32x4*)(gw + 32 * j + 4);
        v4u wv; wv.x = pk2(ya.x, ya.y); wv.y = pk2(ya.z, ya.w); wv.z = pk2(yb.x, yb.y); wv.w = pk2(yb.z, yb.w); *(v4u*)(MX + 32 * j) = wv; }
}
__device__ __forceinline__ void ph_post16(ARef A, const WI& w, int l) {
    LAS unsigned char* s0 = w.lds;
    for (int u = w.vcu; u < NB * NCH * 2; u += w.G) {
        const int b = u >> 5, c = (u >> 1) & 15, half = u & 1;
        __syncthreads();
#pragma unroll 2
        for (int e = w.tid; e < 4096; e += NWAVES * 64) { const int hd = e >> 9, v = (e >> 3) & 63, k8 = e & 7;
            const float* src = (const float*)(A.ws + ((hd < 4) ? WS_SIR : WS_SI)) + ((size_t)((b * 4 + (hd & 3)) * NCH + c) * 64 + v) * 64 + 8 * k8;
            const f32x4 x0 = *(const f32x4*)src, x1 = *(const f32x4*)(src + 4);
            v4u wv; wv.x = pk2(x0.x, x0.y); wv.y = pk2(x0.z, x0.w); wv.z = pk2(x1.x, x1.y); wv.w = pk2(x1.z, x1.w); *(LAS v4u*)(s0 + (hd * 64 + v) * S0_PITCH + 16 * k8) = wv; }
        __syncthreads();
        int lane = w.lane; asm volatile("" : "+v"(lane));
        const int tk = lane & 15, fq = lane >> 4; const size_t m = (size_t)(b * SEQ + c * TCH + half * 128 + w.wave * 16 + tk);
#pragma unroll 1
        for (int hh = 0; hh < 4; ++hh) post16_head<0>(A, l, m, hh, tk, fq, s0);
#pragma unroll 1
        for (int hh = 0; hh < 4; ++hh) post16_head<1>(A, l, m, hh, tk, fq, s0);
#pragma unroll 1
        for (int mx = 2; mx < 4; ++mx) post16_rms(A, l, m, mx, fq);
    }
}

__device__ __forceinline__ float wave_max_f(float v) {
    v = fmaxf(v, __builtin_bit_cast(float, __builtin_amdgcn_mov_dpp(__builtin_bit_cast(int, v), 0xB1, 0xF, 0xF, true)));
    v = fmaxf(v, __builtin_bit_cast(float, __builtin_amdgcn_mov_dpp(__builtin_bit_cast(int, v), 0x4E, 0xF, 0xF, true)));
    v = fmaxf(v, __builtin_bit_cast(float, __builtin_amdgcn_mov_dpp(__builtin_bit_cast(int, v), 0x141, 0xF, 0xF, true)));
    v = fmaxf(v, __builtin_bit_cast(float, __builtin_amdgcn_mov_dpp(__builtin_bit_cast(int, v), 0x140, 0xF, 0xF, true)));
    const int iv = __builtin_bit_cast(int, v);
    return fmaxf(fmaxf(__builtin_bit_cast(float, __builtin_amdgcn_readlane(iv, 0)), __builtin_bit_cast(float, __builtin_amdgcn_readlane(iv, 16))), fmaxf(__builtin_bit_cast(float, __builtin_amdgcn_readlane(iv, 32)), __builtin_bit_cast(float, __builtin_amdgcn_readlane(iv, 48))));
}
__device__ __forceinline__ void router_stage(ARef A, const WI& w, int l) {
    LAS float* rwl = (LAS float*)w.lds; const float* rw = A.in[I_RW] + (size_t)l * DM * 32;
    for (int e = w.tid; e < DM * 8; e += NWAVES * 64) { const int k = e >> 3, c = e & 7; *(LAS f32x4*)(rwl + k * 32 + 4 * (c ^ ((k >> 2) & 7))) = *(const f32x4*)(rw + (size_t)k * 32 + 4 * c); }
    __syncthreads();
}
__device__ __forceinline__ void router_row(ARef A, int l, int m, int lane, LAS unsigned* hist, const LAS float* rwl, LAS int* texp, bool dry = false) {
    const float* XA = (const float*)(A.ws + WS_XA) + (size_t)m * DM; const float* MOD = (const float*)(A.ws + WS_MOD) + (size_t)(l * 8 + (m >> 12)) * 6144;
    f32x4 v[4]; float ss = 0.0f;
#pragma unroll
    for (int j = 0; j < 4; ++j) { v[j] = *(const f32x4*)(XA + 4 * (lane + 64 * j)); ss += dot4(v[j], v[j]); }
    ss = wave_sum(ss); const float rstd = 1.0f / sqrtf(ss * (1.0f / DM) + 1e-5f);
    const float* g = A.in[I_NFFN] + l * DM; const float* scp = MOD + 4 * 1024; const float* shp = MOD + 3 * 1024;
    emit_h_row(v, rstd, g, scp, shp, (bf16*)(A.ws + WS_H) + (size_t)m * DM, lane);
    float p[32];
#pragma unroll
    for (int e = 0; e < 32; ++e) p[e] = 0.0f;
    const int sw = lane & 7;
#pragma unroll 1
    for (int j = 0; j < 4; ++j) { const int k = 4 * (lane + 64 * j);
        const f32x4 h = *(const f32x4*)(XA + k) * rstd * *(const f32x4*)(g + k) * (1.0f + *(const f32x4*)(scp + k)) + *(const f32x4*)(shp + k);
        const LAS float* row = rwl + k * 32;
#pragma unroll
        for (int i = 0; i < 4; ++i) {
#pragma unroll
            for (int q4 = 0; q4 < 8; ++q4) { const f32x4 r = *(const LAS f32x4*)(row + i * 32 + 4 * (q4 ^ sw)); p[4 * q4] += h[i] * r.x; p[4 * q4 + 1] += h[i] * r.y; p[4 * q4 + 2] += h[i] * r.z; p[4 * q4 + 3] += h[i] * r.w; } } }
    float q16[16], q8[8], q4v[4], q2[2], q1;
    { const bool hb = (lane & 32) != 0;
#pragma unroll
      for (int i = 0; i < 16; ++i) { const float mine = hb ? p[16 + i] : p[i], oth = hb ? p[i] : p[16 + i]; q16[i] = mine + __shfl_xor(oth, 32); } }
    { const bool hb = (lane & 16) != 0;
#pragma unroll
      for (int i = 0; i < 8; ++i) { const float mine = hb ? q16[8 + i] : q16[i], oth = hb ? q16[i] : q16[8 + i]; q8[i] = mine + __shfl_xor(oth, 16); } }
    { const bool hb = (lane & 8) != 0;
#pragma unroll
      for (int i = 0; i < 4; ++i) { const float mine = hb ? q8[4 + i] : q8[i], oth = hb ? q8[i] : q8[4 + i]; q4v[i] = mine + __shfl_xor(oth, 8); } }
    { const bool hb = (lane & 4) != 0;
#pragma unroll
      for (int i = 0; i < 2; ++i) { const float mine = hb ? q4v[2 + i] : q4v[i], oth = hb ? q4v[i] : q4v[2 + i]; q2[i] = mine + __shfl_xor(oth, 4); } }
    { const bool hb = (lane & 2) != 0; const float mine = hb ? q2[1] : q2[0], oth = hb ? q2[0] : q2[1]; q1 = mine + __shfl_xor(oth, 2); }
    q1 += __shfl_xor(q1, 1);
    float lv = q1 + A.in[I_RB][l * 32 + (lane >> 1)];
    float tv[4]; int ti[4];
#pragma unroll
    for (int kk = 0; kk < 4; ++kk) { const float mx = wave_max_f(lv); const unsigned long long msk = __ballot(lv == mx); const int e = msk ? (int)(__builtin_ctzll(msk) >> 1) : kk;
        tv[kk] = mx; ti[kk] = e; if ((lane >> 1) == e) lv = -INFINITY; }
    const float e1 = expf(tv[1] - tv[0]), e2 = expf(tv[2] - tv[0]), e3 = expf(tv[3] - tv[0]); const float inv = 1.0f / (1.0f + e1 + e2 + e3);
    if (lane == 0 && !dry) {
        int* TI = (int*)(A.ws + WS_TOPI) + (size_t)m * 4; float* TW = (float*)(A.ws + WS_TOPW) + (size_t)m * 4;
        TI[0] = ti[0]; TI[1] = ti[1]; TI[2] = ti[2]; TI[3] = ti[3]; texp[0] = ti[0]; texp[1] = ti[1]; texp[2] = ti[2]; texp[3] = ti[3]; TW[0] = inv; TW[1] = e1 * inv; TW[2] = e2 * inv; TW[3] = e3 * inv;
        { unsigned* hg = (unsigned*)hist; atomicAdd(hg + ti[0], 1u); atomicAdd(hg + ti[1], 1u); atomicAdd(hg + ti[2], 1u); atomicAdd(hg + ti[3], 1u); }
    }
}
__device__ __forceinline__ void build_expert_table(ARef A, const WI& w, int l) {
    LAS int* tst = (LAS int*)(w.lds + TST_OFF); LAS int* tab = (LAS int*)(w.lds + TAB_OFF); LAS int* cnt = (LAS int*)(w.lds + CNT_OFF);
    if (w.tid == 0) { const unsigned* gc = (const unsigned*)(A.ws + WS_CTL) + CW_GCNT + 64 * l; int acc = 0;
        for (int e = 0; e < 32; ++e) { const int c = (int)__hip_atomic_load(gc + e, RLX_AGENT); cnt[e] = c; tst[e] = acc; acc += (c + 255) >> 8; }
        tst[32] = acc; tab[0] = acc; }
    __syncthreads();
    if (w.tid < 32) { const int e = w.tid; for (int pm = tst[e]; pm < tst[e + 1]; ++pm) tab[1 + pm] = e; }
    __syncthreads();
}
__device__ __forceinline__ void router_lists(ARef A, const WI& w, int l) {
    LAS unsigned* hist = (LAS unsigned*)(w.lds + HIST_OFF); LAS int* base = (LAS int*)(w.lds + BASE_OFF); LAS int* texp = (LAS int*)(w.lds + TEXP_OFF);
    __syncthreads();
    if (w.tid < 32) { base[w.tid] = (int)atomicAdd((unsigned*)(A.ws + WS_CTL) + CW_GCNT + 64 * l + w.tid, hist[w.tid]); hist[w.tid] = 0u; }
    __syncthreads();
    int* LIST = (int*)(A.ws + WS_LIST); int* PW = (int*)(A.ws + WS_POS);
    int j = 0;
    for (int m = w.gw; m < MTOK; m += w.NGW, ++j) {
        if (w.lane < 4) { const int e = texp[(w.wave * 16 + j) * 4 + w.lane]; const int idx = base[e] + (int)atomicAdd((unsigned*)hist + e, 1u);
            LIST[e * LCAP + idx] = m; PW[(size_t)m * 4 + w.lane] = (e << 20) | idx; } }
}
__device__ __forceinline__ void combine_row(ARef A, int l, int m, int lane, const LAS int* tst, float gscale = 1.0f, float oscale = 1.0f) {
    float* XA = (float*)(A.ws + WS_XA) + (size_t)m * DM; const float* MOD = (const float*)(A.ws + WS_MOD) + (size_t)(l * 8 + (m >> 12)) * 6144;
    const int* PS = (const int*)(A.ws + WS_POS) + (size_t)m * 4; const float* TW = (const float*)(A.ws + WS_TOPW) + (size_t)m * 4;
    const bf16* YS = (const bf16*)(A.ws + WS_XS);
    f32x4 v[4], acc[4];
#pragma unroll
    for (int j = 0; j < 4; ++j) { v[j] = *(const f32x4*)(XA + 4 * (lane + 64 * j)); acc[j] = (f32x4){0.f, 0.f, 0.f, 0.f}; }
#pragma unroll
    for (int k = 0; k < 4; ++k) { const int pe = PS[k]; const int pos = tst[pe >> 20] * 256 + (pe & 0xFFFFF); const float gt = TW[k] * gscale; const v2u* yr = (const v2u*)(YS + (size_t)pos * DM);
#pragma unroll
        for (int j = 0; j < 4; ++j) { const v2u y = yr[lane + 64 * j]; acc[j] += gt * (f32x4){bf_lo(y.x), bf_hi(y.x), bf_lo(y.y), bf_hi(y.y)}; } }
    float ss = 0.0f;
#pragma unroll
    for (int j = 0; j < 4; ++j) { const int kx = 4 * (lane + 64 * j); v[j] += *(const f32x4*)(MOD + 5 * 1024 + kx) * acc[j]; ss += dot4(v[j], v[j]); }
    ss = wave_sum(ss); const float rstd = 1.0f / sqrtf(ss * (1.0f / DM) + 1e-5f);
    if (l + 1 < NLAYER) {
#pragma unroll
        for (int j = 0; j < 4; ++j) *(f32x4*)(XA + 4 * (lane + 64 * j)) = v[j];
        const float* mb = MOD + 8 * 6144;
        emit_h_row(v, rstd, A.in[I_NMIX] + (l + 1) * DM, mb + 1024, mb, (bf16*)(A.ws + WS_H) + (size_t)m * DM, lane);
    } else {
        float* orow = A.out + (size_t)m * DM; const float* gf = A.in[I_NFINAL];
#pragma unroll
        for (int j = 0; j < 4; ++j) { const int kx = 4 * (lane + 64 * j); *(f32x4*)(orow + kx) = v[j] * (rstd * oscale) * *(const f32x4*)(gf + kx); }
    }
}

constexpr int N_LAUNCHES = MK_N_LAUNCHES;
template <int SEL> __global__ void __launch_bounds__(NWAVES * 64, 2) fwd(ArgsH Ah) {
    extern __shared__ __attribute__((aligned(16))) unsigned char lds[];
    (void)Ah;
    const int wave_s = __builtin_amdgcn_readfirstlane((int)threadIdx.x >> 6);
    auto tid_now = [&]() -> int { int ws_ = wave_s; unsigned z_ = 0u; asm volatile("" : "+s"(ws_), "+s"(z_)); return ws_ * 64 + (int)__builtin_amdgcn_mbcnt_hi(~0u, __builtin_amdgcn_mbcnt_lo(~0u, z_)); };
#define TID_NOW() tid_now()
#define MAKE_WI() WI w; { int tz = TID_NOW(); asm volatile("" : "+v"(tz)); int bz = blockIdx.x, gz = gridDim.x; asm volatile("" : "+s"(bz), "+s"(gz)); \
        w.lds = (LAS unsigned char*)lds; w.tid = tz; w.lane = tz & 63; w.wave = __builtin_amdgcn_readfirstlane(tz >> 6); w.G = gz; w.bx = bz; w.vcu = (gz % 8 == 0) ? (bz % 8) * (gz / 8) + bz / 8 : bz; \
        w.gw = w.vcu * NWAVES + w.wave; w.NGW = gz * NWAVES; }
    { const int t0 = threadIdx.x; for (int u = t0; u < (LDS_BYTES - RING_BYTES) / 4; u += NWAVES * 64) ((LAS unsigned*)((LAS unsigned char*)lds + RING_BYTES))[u] = 0u; }
    __syncthreads();
    int lo, hi; { ARef A0 = *kargs(); lo = A0.ph_lo; hi = A0.ph_hi; }
    if (N_LAUNCHES == 1) { ARef A0 = *kargs(); (void)xcd_barrier_post((unsigned*)((gu32*)(A0.ws + WS_CTL) + CW_BAR), (volatile LAS unsigned*)((LAS unsigned char*)lds + MISC_OFF) + 8, TID_NOW()); }
#define GRID_BAR() do { if (N_LAUNCHES == 1) { ARef Ab = *kargs(); XcdBarrier bar_; bar_.bar = (unsigned*)((gu32*)(Ab.ws + WS_CTL) + CW_BAR); bar_.x = xb_xcc_id(); bar_.st = (volatile LAS unsigned*)((LAS unsigned char*)lds + MISC_OFF) + 8; xcd_barrier(bar_, TID_NOW()); } } while (0)
#ifndef TPROBE
#define TPROBE 0
#endif
#if TPROBE
    unsigned long long tp_acc = 0ull;
#define TP_SCALE tp_scale_of(__hip_atomic_load((unsigned*)(A.ws + WS_CTL) + 3, RLX_AGENT))
    auto tp_scale_of = [](unsigned ticks) -> float { const float us = (float)ticks * 0.01f; if (us < 1.0f) return 1.0f; const float q = exp2f(rintf(log2f(us) * 8.0f) * 0.125f); return 1.0f + sqrtf(q * 1e-5f); };
#define TP_BEGIN(kind) unsigned long long tp_t0 = 0ull; if ((kind) == TPROBE) tp_t0 = __builtin_amdgcn_s_memrealtime();
#define TP_END(kind) if ((kind) == TPROBE) { tp_acc += __builtin_amdgcn_s_memrealtime() - tp_t0; }
#define TP_PUBLISH(l) if ((l) == 1 && w.vcu == 0 && w.tid == 0) __hip_atomic_store((unsigned*)(A.ws + WS_CTL) + 3, (unsigned)tp_acc, RLX_AGENT);
#else
#define TP_SCALE 1.0f
#define TP_PUBLISH(l)
#define TP_BEGIN(kind)
#define TP_END(kind)
#endif
#define IN(k) (lo <= (k) && (k) < hi)
#ifndef PHMASK
#define PHMASK 0xffffffffu
#endif
#define KON(k) if constexpr ((SEL < 0 && ((PHMASK >> (k)) & 1u)) || SEL == (k))
#define BOTH(k) (IN(k) && IN((k) + 1))
#ifndef PROBE_REP
#define PROBE_REP 0
#endif
#if PROBE_REP
    int nrep_ = 2; asm volatile("" : "+s"(nrep_));
#define REP(bit) _Pragma("unroll 1") for (int rep_ = 0; rep_ < (((PROBE_REP >> (bit)) & 1) ? nrep_ : 1); ++rep_)
#else
#define REP(bit) for (int rep_ = 0; rep_ < 1; ++rep_)
#endif
#define ring ((PG8_LAS unsigned char*)lds)

    KON(0) if (IN(0)) { ARef A = *kargs(); MAKE_WI(); REP(0) ph_prologue(A, w); if (BOTH(0)) GRID_BAR(); }

#define LAYER_BODY(l) do {\
        const int pb = 1 + l * NPL; \
        KON(1) if (IN(pb + 0)) { ARef A = *kargs(); MAKE_WI(); TP_BEGIN(1) if (l == 0) { ph_norm1(A, w); small_weights_to_f16(A, w); if (BOTH(pb + 0)) GRID_BAR(); } TP_END(1) } \
        KON(2) if (IN(pb + 1)) { ARef A = *kargs(); MAKE_WI(); TP_BEGIN(2) \
            pg8::Gemm g{(const bf16*)(A.ws + WS_H), (const bf16*)(A.ws + WS_WIN) + (size_t)l * INCP * DM, MTOK, INCP, DM}; pg8::StaticOrder S; S.init(MTOK, INCP, w.G, w.bx); \
            pg8::EpiProj E{(bf16*)(A.ws + WS_PB), (float*)(A.ws + WS_PF)}; \
            REP(1) pg8::gemm_phase<pg8::EpiProj, pg8::StaticOrder, true, true>(ring, g, S, E, w.tid); \
            if (BOTH(pb + 1)) GRID_BAR(); TP_END(2) \
        } \
        KON(3) if (IN(pb + 2)) { ARef A = *kargs(); MAKE_WI(); TP_BEGIN(3) \
            REP(2) { for (int g = w.gw; g < MTOK / 16; g += w.NGW) prep16(A, l, 16 * g, w.lane); } \
            if (BOTH(pb + 2)) GRID_BAR(); TP_END(3) \
        } \
        KON(4) if (IN(pb + 3)) { ARef A = *kargs(); MAKE_WI(); TP_BEGIN(4) \
            REP(3) { for (int tk = 2 * w.vcu; tk < 32 * NCH; tk += 2 * w.G) scan_rwkv_task2(A, w, tk); } \
            REP(13) { for (int tk = w.vcu; tk < 32 * NCH / 2; tk += w.G) scan_ret_task(A, w, tk); } \
            REP(4) { LAS unsigned char* vl = w.lds + w.wave * 4608; for (int it = w.gw; it < 32 * 128; it += w.NGW) sb_tile_mfma(A, it, w.lane, vl); } \
            REP(5) dsa_scores_mfma(A, w); \
            if (BOTH(pb + 3)) GRID_BAR(); TP_END(4) \
        } \
        KON(5) if (IN(pb + 4)) { ARef A = *kargs(); MAKE_WI(); TP_BEGIN(5) \
            if (w.bx < 32) prefix_chain(A, w, w.bx); \
            REP(6) dsa_wave(A, w, w.lds + w.wave * 13312, l + 2 * rep_); \
            REP(14) { if (rep_ && w.bx < 32) prefix_chain(A, w, w.bx); } \
            if (BOTH(pb + 4)) GRID_BAR(); TP_END(5) \
        } \
        KON(6) if (IN(pb + 5)) { ARef A = *kargs(); MAKE_WI(); TP_BEGIN(6) \
            REP(7) ph_post16(A, w, l); \
            if (BOTH(pb + 5)) GRID_BAR(); TP_END(6) \
        } \
        KON(7) if (IN(pb + 6)) { ARef A = *kargs(); MAKE_WI(); TP_BEGIN(7) \
            pg8::Gemm g{(const bf16*)(A.ws + WS_MIX), (const bf16*)(A.ws + WS_WOUT) + (size_t)l * DM * DM, MTOK, DM, DM}; pg8::StaticOrder S; S.init(MTOK, DM, w.G, w.bx); \
            pg8::EpiRes E{l == 0 ? A.in[I_X] : (const float*)(A.ws + WS_XA), (float*)(A.ws + WS_XA), (const float*)(A.ws + WS_MOD) + (size_t)l * 8 * 6144 + 2 * 1024}; \
            pg8::gemm_phase<pg8::EpiRes, pg8::StaticOrder, true, true>(ring, g, S, E, w.tid); \
            if (BOTH(pb + 6)) GRID_BAR(); TP_END(7) \
        } \
        KON(8) if (IN(pb + 7)) { ARef A = *kargs(); MAKE_WI(); TP_BEGIN(8) \
            { LAS unsigned* hist = (LAS unsigned*)(w.lds + HIST_OFF); LAS int* texp = (LAS int*)(w.lds + TEXP_OFF); if (w.tid < 32) hist[w.tid] = 0u; router_stage(A, w, l); \
            REP(10) { int j_ = 0; for (int m = w.gw; m < MTOK; m += w.NGW, ++j_) router_row(A, l, m, w.lane, hist, (const LAS float*)w.lds, texp + (w.wave * 16 + j_) * 4, rep_ != 0); } \
            router_lists(A, w, l); } \
            if (BOTH(pb + 7)) GRID_BAR(); TP_END(8) \
        } \
        KON(10) if (IN(pb + 8)) { ARef A = *kargs(); MAKE_WI(); TP_BEGIN(10) \
            build_expert_table(A, w, l); \
            pg8::Gemm g{(const bf16*)(A.ws + WS_H), (const bf16*)(A.ws + WS_W1) + (size_t)l * NEXP * 2048 * DM, MOE_ROWS, NEXP * 2048, DM}; \
            pg8::MoeOrder S{(const PG8_LAS int*)(w.lds + TAB_OFF), 8, w.G, w.vcu, (const PG8_LAS int*)(w.lds + TST_OFF), (const PG8_LAS int*)(w.lds + CNT_OFF), (const int*)(A.ws + WS_LIST)}; \
            pg8::EpiSwiglu E{(bf16*)(A.ws + WS_ACT), A.in[I_MB1] + (size_t)l * NEXP * 2048}; \
            REP(8) pg8::gemm_phase<pg8::EpiSwiglu, pg8::MoeOrder, true, true, true>(ring, g, S, E, w.tid); \
            if (BOTH(pb + 8)) GRID_BAR(); TP_END(10) \
        } \
        KON(11) if (IN(pb + 9)) { ARef A = *kargs(); MAKE_WI(); TP_BEGIN(11) \
            build_expert_table(A, w, l); \
            pg8::Gemm g{(const bf16*)(A.ws + WS_ACT), (const bf16*)(A.ws + WS_W2) + (size_t)l * NEXP * DM * DM, MOE_ROWS, NEXP * DM, DM}; \
            pg8::MoeOrder S{(const PG8_LAS int*)(w.lds + TAB_OFF), 4, w.G, w.vcu, (const PG8_LAS int*)(w.lds + TST_OFF), (const PG8_LAS int*)(w.lds + CNT_OFF), (const int*)(A.ws + WS_LIST)}; \
            pg8::EpiY E{(bf16*)(A.ws + WS_XS), A.in[I_MB2] + (size_t)l * NEXP * DM}; \
            REP(9) pg8::gemm_phase<pg8::EpiY, pg8::MoeOrder, true, true>(ring, g, S, E, w.tid); \
            TP_PUBLISH(l) \
            if (BOTH(pb + 9)) GRID_BAR(); TP_END(11) \
        } \
        KON(12) if (IN(pb + 10)) { ARef A = *kargs(); MAKE_WI(); TP_BEGIN(12) \
            build_expert_table(A, w, l); \
            REP(12) for (int m = w.gw; m < MTOK; m += w.NGW) combine_row(A, l, m, w.lane, (const LAS int*)(w.lds + TST_OFF), rep_ ? 0.0f : 1.0f, TP_SCALE); \
            if (BOTH(pb + 10)) GRID_BAR(); TP_END(12) \
        } \
    } while (0)
    LAYER_BODY(0);
    LAYER_BODY(1);
#undef LAYER_BODY
#undef IN
#undef ring
#undef MAKE_WI
#undef TID_NOW
#undef GRID_BAR
#undef KON
#undef BOTH
}


#if MK_N_LAUNCHES != 1
template <int K> static void launch_one(int grid, hipStream_t stream, const ArgsH& a) {
    static bool attr = false;
    if (!attr) { (void)hipFuncSetAttribute((const void*)fwd<K>, hipFuncAttributeMaxDynamicSharedMemorySize, LDS_BYTES); attr = true; }
    hipLaunchKernelGGL(fwd<K>, dim3(grid), dim3(NWAVES * 64), LDS_BYTES, stream, a);
}
static void launch_kind(int kind, int grid, hipStream_t stream, const ArgsH& a) {
    switch (kind) {
        case 0: launch_one<0>(grid, stream, a); break; case 1: launch_one<1>(grid, stream, a); break; case 2: launch_one<2>(grid, stream, a); break;
        case 3: launch_one<3>(grid, stream, a); break; case 4: launch_one<4>(grid, stream, a); break; case 5: launch_one<5>(grid, stream, a); break;
        case 6: launch_one<6>(grid, stream, a); break; case 7: launch_one<7>(grid, stream, a); break; case 8: launch_one<8>(grid, stream, a); break;
        case 9: launch_one<9>(grid, stream, a); break; case 10: launch_one<10>(grid, stream, a); break; case 11: launch_one<11>(grid, stream, a); break;
        default: launch_one<12>(grid, stream, a); break;
    }
}
#endif
extern "C" void kernel_launch(void* const* d_in, const int* in_sizes, int n_in, void* d_out, int out_size, void* d_ws, size_t ws_size, hipStream_t stream) {
    static int grid = 0;
    if (grid == 0) {
        if (n_in != N_IN || out_size != MTOK * DM || ws_size < WS_END) { fprintf(stderr, "kernel_launch: unexpected shapes (n_in %d, out %d, ws %zu)\n", n_in, out_size, ws_size); grid = -1; return; }
        int dev = 0, cus = 0;
        if (hipGetDevice(&dev) != hipSuccess || hipDeviceGetAttribute(&cus, hipDeviceAttributeMultiprocessorCount, dev) != hipSuccess) { grid = -1; return; }
#if MK_N_LAUNCHES == 1
        {
            if (hipFuncSetAttribute((const void*)fwd<-1>, hipFuncAttributeMaxDynamicSharedMemorySize, LDS_BYTES) != hipSuccess) { fprintf(stderr, "kernel_launch: hipFuncSetAttribute failed\n"); grid = -1; return; }
            int per_cu = 0;
            if (hipOccupancyMaxActiveBlocksPerMultiprocessor(&per_cu, (const void*)fwd<-1>, NWAVES * 64, LDS_BYTES) != hipSuccess || per_cu < 1) fprintf(stderr, "kernel_launch: occupancy query says %d\n", per_cu);
            (void)hipGetLastError();
        }
#endif
        grid = cus;
    }
    if (grid < 0) return;
    (void)in_sizes;
    if (hipMemsetAsync((char*)d_ws + WS_CTL, 0, CTL_ZERO_BYTES, stream) != hipSuccess) return;
    ArgsH a{};
    for (int i = 0; i < N_IN; ++i) a.in[i] = (const float*)d_in[i];
    a.out = (float*)d_out; a.ws = (unsigned char*)d_ws;
    for (int f = 0; f < 44; ++f) a.invf[f] = (f < 32) ? pow(10000.0, -(double)f / 32.0) : (f < 40) ? pow(500000.0, -(double)(f - 32) / 8.0) : pow(500000.0, -(double)(f - 40) / 4.0);
#if MK_N_LAUNCHES == 1
    a.ph_lo = 0; a.ph_hi = NPHASE; a.li = 0;
    hipLaunchKernelGGL(fwd<-1>, dim3(grid), dim3(NWAVES * 64), LDS_BYTES, stream, a);
#else
    {
        for (int p = 0; p < NPHASE; ++p) {
            if (p == 1 + NPL) continue;
            a.ph_lo = p; a.ph_hi = p + 1; a.li = p;
            static const int kinds_[NPL] = {1, 2, 3, 4, 5, 6, 7, 8, 10, 11, 12};
            const int kind = (p == 0) ? 0 : kinds_[(p - 1) % NPL];
            launch_kind(kind, grid, stream, a);
        }
    }
#endif
}
```

```cpp
#include <hip/hip_runtime.h>
#include <cstdio>
#include <cstdint>
#include <cmath>

#ifndef MK_N_LAUNCHES
#define MK_N_LAUNCHES 1
#endif

namespace pg8 {
#define PG8_LAS __attribute__((address_space(3)))
typedef unsigned short bf16_t;
typedef short bf16x8 __attribute__((ext_vector_type(8)));
typedef float f32x4 __attribute__((ext_vector_type(4)));
typedef unsigned u32x4 __attribute__((ext_vector_type(4)));
typedef unsigned u32x2 __attribute__((ext_vector_type(2)));
constexpr int BM = 256, BK = 64, HALF = 128, HTB = HALF * BK * 2  , STAGE_BYTES = 8 * HTB, NXCD = 8, WGM = 8;

__host__ __device__ __forceinline__ int lds_byte(int r, int c) { const int st = (r >> 4) * 2 + (c >> 5), rr = r & 15, cc = c & 31, ob = rr * 64 + cc * 2; return st * 1024 + (ob ^ (((ob >> 9) & 1) << 5)); }
__host__ __device__ __forceinline__ void stage_rc(int b, int& R, int& C) { const int st = b / 1024, sb = b % 1024, swz = sb ^ (((sb >> 9) & 1) << 5); R = (st >> 1) * 16 + swz / 64; C = (st & 1) * 32 + (swz % 64) / 2; }
__host__ __device__ __forceinline__ int perm32(int rho) { const int n = rho >> 4, i = rho & 15; return 8 * (i >> 2) + 4 * n + (i & 3); }

struct Unit { int pm, pn; };
struct Gemm { const bf16_t* A; const bf16_t* Bt; int M, N, K; };

struct StaticOrder {
    int nM, nN, nwg, G, c;
    __host__ __device__ void init(int M, int N, int G_, int c_) { nM = M / BM; nN = N / BM; nwg = nM * nN; G = G_; c = c_; }
    __host__ __device__ bool next(int i, Unit& u) const {
        const long L = (long)i * G + c; if (L >= nwg) return false;
        int wgid = (int)L; { const int q = nwg / NXCD, r = nwg % NXCD, xcd = wgid % NXCD, off = wgid / NXCD; wgid = (xcd < r ? xcd * (q + 1) : r * (q + 1) + (xcd - r) * q) + off; }
        const int nig = WGM * nN, gid = wgid / nig, fm = gid * WGM, gsz = (nM - fm) < WGM ? (nM - fm) : WGM;
        u.pm = fm + ((wgid % nig) % gsz); u.pn = (wgid % nig) / gsz; return true;
    }
    __device__ __forceinline__ void a_ready(const Unit&) const {}
    __device__ __forceinline__ void done(const Unit&) const {}
};
__device__ __forceinline__ unsigned cvt_pk_bf16(float lo, float hi) { unsigned r; asm volatile("v_cvt_pk_bf16_f32 %0, %1, %2" : "=v"(r) : "v"(lo), "v"(hi)); return r; }
struct EpiF32 {
    static constexpr bool PERM = false, AFTER_DRAIN = false;
    float* C; int ldc;
    __device__ __forceinline__ void operator()(const f32x4 (&acc)[2][2][4][2], const Unit& u, int wr, int wc, int fr, int fq) const {
        const int row0 = u.pm * BM + wr * 64 + fr, col0 = u.pn * BM + wc * 32 + 4 * fq;
#pragma unroll
        for (int ai = 0; ai < 2; ++ai)
#pragma unroll
            for (int m = 0; m < 4; ++m) { float* rowp = C + (size_t)(row0 + ai * HALF + m * 16) * ldc + col0;
#pragma unroll
                for (int bj = 0; bj < 2; ++bj)
#pragma unroll
                    for (int n = 0; n < 2; ++n) *(f32x4*)(rowp + bj * HALF + n * 16) = acc[ai][bj][m][n]; }
    }
};
struct EpiProj {
    static constexpr bool PERM = true, AFTER_DRAIN = false;
    bf16_t* PB; float* PF;
    __device__ __forceinline__ void operator()(const f32x4 (&acc)[2][2][4][2], const Unit& u, int wr, int wc, int fr, int fq) const {
        const int row0 = u.pm * BM + wr * 64 + fr;
        if (u.pn < 7) { const int c0 = u.pn * BM + wc * 32 + 8 * fq;
#pragma unroll
            for (int ai = 0; ai < 2; ++ai)
#pragma unroll
                for (int m = 0; m < 4; ++m) { bf16_t* rowp = PB + (size_t)(row0 + ai * HALF + m * 16) * 1792 + c0;
#pragma unroll
                    for (int bj = 0; bj < 2; ++bj) { const f32x4 v0 = acc[ai][bj][m][0], v1 = acc[ai][bj][m][1];
                        u32x4 w; w.x = cvt_pk_bf16(v0[0], v0[1]); w.y = cvt_pk_bf16(v0[2], v0[3]); w.z = cvt_pk_bf16(v1[0], v1[1]); w.w = cvt_pk_bf16(v1[2], v1[3]);
                        *(u32x4*)(rowp + bj * HALF) = w; } }
        } else { const int c0 = (u.pn - 7) * BM + wc * 32 + 8 * fq;
#pragma unroll
            for (int ai = 0; ai < 2; ++ai)
#pragma unroll
                for (int m = 0; m < 4; ++m) { float* rowp = PF + (size_t)(row0 + ai * HALF + m * 16) * 1280 + c0;
#pragma unroll
                    for (int bj = 0; bj < 2; ++bj) { *(f32x4*)(rowp + bj * HALF) = acc[ai][bj][m][0]; *(f32x4*)(rowp + bj * HALF + 4) = acc[ai][bj][m][1]; } }
        }
    }
};
struct EpiRes {
    static constexpr bool PERM = false, AFTER_DRAIN = false;
    const float* xin; float* xout; const float* gate;
    __device__ __forceinline__ void operator()(const f32x4 (&acc)[2][2][4][2], const Unit& u, int wr, int wc, int fr, int fq) const {
        const int row0 = u.pm * BM + wr * 64 + fr, col0 = u.pn * BM + wc * 32 + 4 * fq;
        const float* gp = gate + (size_t)((u.pm * BM) >> 12) * 6144 + col0;
        f32x4 gv[2][2];
#pragma unroll
        for (int bj = 0; bj < 2; ++bj)
#pragma unroll
            for (int n = 0; n < 2; ++n) gv[bj][n] = *(const f32x4*)(gp + bj * HALF + n * 16);
#pragma unroll
        for (int ai = 0; ai < 2; ++ai)
#pragma unroll
            for (int m = 0; m < 4; ++m) { const size_t ro = (size_t)(row0 + ai * HALF + m * 16) * 1024 + col0;
#pragma unroll
                for (int bj = 0; bj < 2; ++bj)
#pragma unroll
                    for (int n = 0; n < 2; ++n) { const f32x4 xv = *(const f32x4*)(xin + ro + bj * HALF + n * 16); *(f32x4*)(xout + ro + bj * HALF + n * 16) = xv + gv[bj][n] * acc[ai][bj][m][n]; } }
    }
};
__device__ __forceinline__ float swiglu1(float glu, float lin) {
    glu = fminf(glu, 7.0f); lin = fminf(fmaxf(lin, -7.0f), 7.0f);
    return glu * (1.0f / (1.0f + __expf(-1.702f * glu))) * (lin + 1.0f);
}
struct EpiSwiglu {
    static constexpr bool PERM = true, AFTER_DRAIN = false;
    bf16_t* O; const float* b1;
    __device__ __forceinline__ void operator()(const f32x4 (&acc)[2][2][4][2], const Unit& u, int wr, int wc, int fr, int fq) const {
        const int e = u.pn >> 3, j = u.pn & 7, row0 = u.pm * BM + wr * 64 + fr, c0 = 128 * j + wc * 32 + 8 * fq;
        const float* bp = b1 + (size_t)e * 2048 + c0;
        f32x4 bg[2], bl[2];
#pragma unroll
        for (int n = 0; n < 2; ++n) { bg[n] = *(const f32x4*)(bp + 4 * n); bl[n] = *(const f32x4*)(bp + 1024 + 4 * n); }
#pragma unroll
        for (int ai = 0; ai < 2; ++ai)
#pragma unroll
            for (int m = 0; m < 4; ++m) { bf16_t* rowp = O + (size_t)(row0 + ai * HALF + m * 16) * 1024 + c0;
                const f32x4 g0 = acc[ai][0][m][0] + bg[0], g1 = acc[ai][0][m][1] + bg[1], l0 = acc[ai][1][m][0] + bl[0], l1 = acc[ai][1][m][1] + bl[1];
                u32x4 w;
                w.x = cvt_pk_bf16(swiglu1(g0[0], l0[0]), swiglu1(g0[1], l0[1])); w.y = cvt_pk_bf16(swiglu1(g0[2], l0[2]), swiglu1(g0[3], l0[3]));
                w.z = cvt_pk_bf16(swiglu1(g1[0], l1[0]), swiglu1(g1[1], l1[1])); w.w = cvt_pk_bf16(swiglu1(g1[2], l1[2]), swiglu1(g1[3], l1[3]));
                *(u32x4*)rowp = w; }
    }
};
struct EpiY {
    static constexpr bool PERM = true, AFTER_DRAIN = false;
    bf16_t* O; const float* b2;
    __device__ __forceinline__ void operator()(const f32x4 (&acc)[2][2][4][2], const Unit& u, int wr, int wc, int fr, int fq) const {
        const int e = u.pn >> 2, j = u.pn & 3, row0 = u.pm * BM + wr * 64 + fr, c0 = 256 * j + wc * 32 + 8 * fq;
        const float* bp = b2 + (size_t)e * 1024 + c0;
        f32x4 bv[2][2];
#pragma unroll
        for (int bj = 0; bj < 2; ++bj)
#pragma unroll
            for (int n = 0; n < 2; ++n) bv[bj][n] = *(const f32x4*)(bp + bj * HALF + 4 * n);
#pragma unroll
        for (int ai = 0; ai < 2; ++ai)
#pragma unroll
            for (int m = 0; m < 4; ++m) { bf16_t* rowp = O + (size_t)(row0 + ai * HALF + m * 16) * 1024 + c0;
#pragma unroll
                for (int bj = 0; bj < 2; ++bj) { const f32x4 v0 = acc[ai][bj][m][0] + bv[bj][0], v1 = acc[ai][bj][m][1] + bv[bj][1];
                    u32x4 w; w.x = cvt_pk_bf16(v0[0], v0[1]); w.y = cvt_pk_bf16(v0[2], v0[3]); w.z = cvt_pk_bf16(v1[0], v1[1]); w.w = cvt_pk_bf16(v1[2], v1[3]);
                    *(u32x4*)(rowp + bj * HALF) = w; } }
    }
};
struct MoeOrder {
    const PG8_LAS int* tab; int NJ, G, c;
    __device__ __forceinline__ bool next(int i, Unit& u) const {
        const int T = tab[0]; const long L = (long)i * G + c; if (L >= (long)T * NJ) return false;
        const int pm = (int)(L / NJ), j = (int)(L % NJ);
        u.pm = pm; u.pn = tab[1 + pm] * NJ + j; return true;
    }
    __device__ __forceinline__ void a_ready(const Unit&) const {}
    __device__ __forceinline__ void done(const Unit&) const {}
    const PG8_LAS int* tst; const PG8_LAS int* cnt; const int* list;
    __device__ __forceinline__ int row_of(const Unit& u, int r) const { const int e = tab[1 + u.pm], idx = 256 * (u.pm - tst[e]) + r; return (idx < cnt[e]) ? list[e * 32768 + idx] : 0; }
};

template <class Epi, class Sched, bool ALIGN_EPI = false, bool SP2 = false, bool GATHER = false>
__device__ __forceinline__ void gemm_phase(PG8_LAS unsigned char* lds, const Gemm g, const Sched& S, const Epi& E, int tid_in) {
    int tid_ = tid_in; asm volatile("" : "+v"(tid_));
    const int tid = tid_, wid = __builtin_amdgcn_readfirstlane(tid >> 6), lane = tid & 63, wr = wid >> 2, wc = wid & 3, fr = lane & 15, fq = lane >> 4;
    const int K = g.K, nt = K / BK;
    unsigned voffA[2], voffB[2];
#pragma unroll
    for (int i = 0; i < 2; ++i) { int R, C; stage_rc(tid * 16 + i * 8192, R, C); const int Rb = Epi::PERM ? ((R & ~31) + perm32(R & 31)) : R;
        voffA[i] = (unsigned)(R * K + C) * 2u; voffB[i] = (unsigned)(Rb * K + C) * 2u; }
    static_assert(!GATHER || SP2, "gathered A rows: only the two-super-phase loop is wired");
    unsigned cvo[2][2], nvo[2][2];
#define PG8_ROWS(dst, u_) do { _Pragma("unroll") for (int h_ = 0; h_ < 2; ++h_) _Pragma("unroll") for (int i_ = 0; i_ < 2; ++i_) { int R_, C_; stage_rc(tid * 16 + i_ * 8192, R_, C_); dst[h_][i_] = (unsigned)(S.row_of(u_, h_ * HALF + R_) * K + C_) * 2u; } } while (0)
#define PG8_STAGE_A(bufoff, gbase, half, nx) do { if constexpr (GATHER) { unsigned o_[2]; o_[0] = (nx) ? nvo[half][0] : cvo[half][0]; o_[1] = (nx) ? nvo[half][1] : cvo[half][1]; PG8_STAGE(bufoff, gbase, o_); } else { PG8_STAGE(bufoff, (gbase) + (half) * hstep, voffA); } } while (0)
    const size_t kstep = (size_t)(BK * 2);
    const size_t hstep = (size_t)HALF * K * 2;
    const size_t tstep = 2 * hstep;
    const unsigned ldsw = (unsigned)wid * 1024u;
    const int aoff = lds_byte(wr * 64 + fr, fq * 8), boff = lds_byte(wc * 32 + fr, fq * 8);
#define PG8_SA(b, h) (((b) * 2 + (h)) * HTB)
#define PG8_SB(b, h) ((4 + (b) * 2 + (h)) * HTB)
#define PG8_STAGE(bufoff, gbase, voff) do { _Pragma("unroll") for (int _i = 0; _i < 2; ++_i) \
        __builtin_amdgcn_global_load_lds((const unsigned*)((const char*)(gbase) + (voff)[_i]), (PG8_LAS unsigned*)(lds + (bufoff) + ldsw + _i * 8192), 16, 0, 0); } while (0)
#define PG8_LDA(dst, b, h) do { _Pragma("unroll") for (int m = 0; m < 4; ++m) _Pragma("unroll") for (int k = 0; k < 2; ++k) dst[m][k] = *(const PG8_LAS bf16x8*)(lds + PG8_SA(b, h) + aoff + m * 2048 + k * 1024); } while (0)
#define PG8_LDB(dst, b, h) do { _Pragma("unroll") for (int n = 0; n < 2; ++n) _Pragma("unroll") for (int k = 0; k < 2; ++k) dst[n][k] = *(const PG8_LAS bf16x8*)(lds + PG8_SB(b, h) + boff + n * 2048 + k * 1024); } while (0)
#define PG8_MMA(ai, bj, At, Bt) do { __builtin_amdgcn_s_setprio(1); _Pragma("unroll") for (int m = 0; m < 4; ++m) _Pragma("unroll") for (int n = 0; n < 2; ++n) _Pragma("unroll") for (int k = 0; k < 2; ++k) \
        acc[ai][bj][m][n] = __builtin_amdgcn_mfma_f32_16x16x32_bf16(Bt[n][k], At[m][k], acc[ai][bj][m][n], 0, 0, 0); __builtin_amdgcn_s_setprio(0); } while (0)
#define PG8_WAIT_V(n) asm volatile("s_waitcnt vmcnt(" #n ")" ::: "memory")
#define PG8_WAIT_L(n) asm volatile("s_waitcnt lgkmcnt(" #n ")" ::: "memory")
#define PG8_BAR __builtin_amdgcn_s_barrier()
#define PG8_SCHED __builtin_amdgcn_sched_barrier(0)
    Unit cur, nxt; int ui = 0;
    if (!S.next(0, cur)) return;
    f32x4 acc[2][2][4][2];
#pragma unroll
    for (int a = 0; a < 2; ++a)
#pragma unroll
        for (int b = 0; b < 2; ++b)
#pragma unroll
            for (int m = 0; m < 4; ++m)
#pragma unroll
                for (int n = 0; n < 2; ++n) acc[a][b][m][n] = (f32x4){0.f, 0.f, 0.f, 0.f};
    bf16x8 At[4][2], B0[2][2], B1[2][2];
    const char* cA = (const char*)g.A + (GATHER ? (size_t)0 : (size_t)cur.pm * tstep); const char* cB = (const char*)g.Bt + (size_t)cur.pn * tstep;
    if constexpr (GATHER) { PG8_ROWS(cvo, cur); }
    S.a_ready(cur);
    if constexpr (SP2) {
        PG8_STAGE(PG8_SB(0, 0), cB, voffB); PG8_STAGE(PG8_SB(0, 1), cB + hstep, voffB); PG8_STAGE_A(PG8_SA(0, 0), cA, 0, false); PG8_STAGE_A(PG8_SA(0, 1), cA, 1, false);
        if (wr == 1) PG8_BAR;
        PG8_WAIT_V(2); PG8_BAR;
        PG8_STAGE(PG8_SB(1, 0), cB + kstep, voffB); PG8_STAGE_A(PG8_SA(1, 0), cA + kstep, 0, false); PG8_STAGE(PG8_SB(1, 1), cB + hstep + kstep, voffB);
        PG8_WAIT_V(6); PG8_BAR;
    } else {
        PG8_STAGE(PG8_SB(0, 0), cB, voffB); PG8_STAGE(PG8_SA(0, 0), cA, voffA); PG8_STAGE(PG8_SB(0, 1), cB + hstep, voffB); PG8_STAGE(PG8_SA(0, 1), cA + hstep, voffA);
        if (wr == 1) PG8_BAR;
        PG8_WAIT_V(4); PG8_BAR;
        PG8_STAGE(PG8_SB(1, 0), cB + kstep, voffB); PG8_STAGE(PG8_SA(1, 0), cA + kstep, voffA); PG8_STAGE(PG8_SB(1, 1), cB + hstep + kstep, voffB);
        PG8_WAIT_V(6); PG8_BAR;
    }
    for (;;) {
        const bool has_next = S.next(ui + 1, nxt);
        const char* nA = GATHER ? (const char*)g.A : (has_next ? (const char*)g.A + (size_t)nxt.pm * tstep : cA); const char* nB = has_next ? (const char*)g.Bt + (size_t)nxt.pn * tstep : cB;
        if constexpr (GATHER) { if (has_next) { PG8_ROWS(nvo, nxt); } else { _Pragma("unroll") for (int h_ = 0; h_ < 2; ++h_) { nvo[h_][0] = cvo[h_][0]; nvo[h_][1] = cvo[h_][1]; } } }
        for (int t = 0; t < nt; t += 2) {
            const bool last = (t == nt - 2);
            const char* a1 = cA + (size_t)(t + 1) * kstep;
            const char* a2 = last ? nA : cA + (size_t)(t + 2) * kstep; const char* b2 = last ? nB : cB + (size_t)(t + 2) * kstep;
            const char* a3 = a2 + kstep; const char* b3 = b2 + kstep;
            if (last && has_next) S.a_ready(nxt);
            if constexpr (SP2) {
            PG8_LDB(B0, 0, 0); PG8_LDB(B1, 0, 1); PG8_SCHED; PG8_LDA(At, 0, 0); PG8_STAGE_A(PG8_SA(1, 1), a1, 1, false);
            PG8_WAIT_V(8); PG8_WAIT_L(0); PG8_BAR; PG8_MMA(0, 0, At, B0); PG8_MMA(0, 1, At, B1); PG8_BAR; PG8_SCHED;
            PG8_LDA(At, 0, 1); PG8_STAGE(PG8_SB(0, 0), b2, voffB); PG8_STAGE(PG8_SB(0, 1), b2 + hstep, voffB); PG8_STAGE_A(PG8_SA(0, 0), a2, 0, last);
            PG8_WAIT_V(8); PG8_WAIT_L(0); PG8_BAR; PG8_MMA(1, 0, At, B0); PG8_MMA(1, 1, At, B1); PG8_BAR; PG8_SCHED;
            PG8_LDB(B0, 1, 0); PG8_LDB(B1, 1, 1); PG8_SCHED; PG8_LDA(At, 1, 0); PG8_STAGE_A(PG8_SA(0, 1), a2, 1, last);
            PG8_WAIT_V(8); PG8_WAIT_L(0); PG8_BAR; PG8_MMA(0, 0, At, B0); PG8_MMA(0, 1, At, B1); PG8_BAR; PG8_SCHED;
            PG8_LDA(At, 1, 1); PG8_STAGE(PG8_SB(1, 0), b3, voffB); PG8_STAGE(PG8_SB(1, 1), b3 + hstep, voffB); PG8_STAGE_A(PG8_SA(1, 0), a3, 0, last);
            PG8_WAIT_V(8); PG8_WAIT_L(0); PG8_BAR; PG8_MMA(1, 0, At, B0); PG8_MMA(1, 1, At, B1); PG8_BAR; PG8_SCHED;
            } else {
            PG8_LDB(B0, 0, 0); PG8_SCHED; PG8_LDA(At, 0, 0); PG8_STAGE(PG8_SA(1, 1), a1 + hstep, voffA);
            PG8_WAIT_L(8); PG8_BAR; PG8_WAIT_L(0); PG8_MMA(0, 0, At, B0); PG8_BAR; PG8_SCHED;
            PG8_LDB(B1, 0, 1); PG8_STAGE(PG8_SB(0, 0), b2, voffB);
            PG8_BAR; PG8_WAIT_L(0); PG8_MMA(0, 1, At, B1); PG8_BAR;
            PG8_LDA(At, 0, 1); PG8_STAGE(PG8_SA(0, 0), a2, voffA);
            PG8_BAR; PG8_WAIT_L(0); PG8_MMA(1, 0, At, B0); PG8_BAR; PG8_SCHED;
            PG8_STAGE(PG8_SB(0, 1), b2 + hstep, voffB);
            PG8_WAIT_V(6); PG8_BAR; PG8_MMA(1, 1, At, B1); PG8_BAR;
            PG8_LDB(B0, 1, 0); PG8_SCHED; PG8_LDA(At, 1, 0); PG8_STAGE(PG8_SA(0, 1), a2 + hstep, voffA);
            PG8_WAIT_L(8); PG8_BAR; PG8_WAIT_L(0); PG8_MMA(0, 0, At, B0); PG8_BAR; PG8_SCHED;
            PG8_LDB(B1, 1, 1); PG8_STAGE(PG8_SB(1, 0), b3, voffB);
            PG8_BAR; PG8_WAIT_L(0); PG8_MMA(0, 1, At, B1); PG8_BAR;
            PG8_LDA(At, 1, 1); PG8_STAGE(PG8_SA(1, 0), a3, voffA);
            PG8_BAR; PG8_WAIT_L(0); PG8_MMA(1, 0, At, B0); PG8_BAR; PG8_SCHED;
            PG8_STAGE(PG8_SB(1, 1), b3 + hstep, voffB);
            PG8_WAIT_V(6); PG8_BAR; PG8_MMA(1, 1, At, B1); PG8_BAR;
            }
        }
        if constexpr (ALIGN_EPI) { if (wr == 0) PG8_BAR; }
        if constexpr (!Epi::AFTER_DRAIN) { E(acc, cur, wr, wc, fr, fq); S.done(cur); }
        if (!has_next) break;
#pragma unroll
        for (int a = 0; a < 2; ++a)
#pragma unroll
            for (int b = 0; b < 2; ++b)
#pragma unroll
                for (int m = 0; m < 4; ++m)
#pragma unroll
                    for (int n = 0; n < 2; ++n) acc[a][b][m][n] = (f32x4){0.f, 0.f, 0.f, 0.f};
        cur = nxt; cA = nA; cB = nB; ++ui;
        if constexpr (GATHER) { _Pragma("unroll") for (int h_ = 0; h_ < 2; ++h_) { cvo[h_][0] = nvo[h_][0]; cvo[h_][1] = nvo[h_][1]; } }
        if constexpr (ALIGN_EPI) { if (wr == 1) PG8_BAR; }
    }
    PG8_WAIT_V(0);
    if constexpr (!ALIGN_EPI) { if (wr == 0) PG8_BAR; }
    PG8_BAR;
    if constexpr (Epi::AFTER_DRAIN) { E.fused(acc, cur, wr, wc, fr, fq, lds, wid, lane); S.done(cur); }
#undef PG8_SA
#undef PG8_SB
#undef PG8_STAGE
#undef PG8_STAGE_A
#undef PG8_ROWS
#undef PG8_LDA
#undef PG8_LDB
#undef PG8_MMA
#undef PG8_WAIT_V
#undef PG8_WAIT_L
#undef PG8_BAR
#undef PG8_SCHED
}
}

constexpr int NWAVES = 8;
constexpr int NB = 8, SEQ = 4096, DM = 1024, MTOK = NB * SEQ, NLAYER = 2;
constexpr int INC = 2984, INCP = 3072;
constexpr int C_RET = 0, C_RW = 1024, C_DSA = 1920, C_SB = 2216;
constexpr int PBW = 1792, PFW = 1280, PB_SB = 1024, PF_DSA = 896;
constexpr int NEXP = 32, MOE_ROWS = MTOK * 4 + NEXP * 256;
constexpr int ROPE_W = 88;
constexpr int NCH = 16, TCH = SEQ / NCH;
constexpr int NPL = 11, NPHASE = 1 + NLAYER * NPL;
enum { I_X = 0, I_C, I_POS, I_ADAW, I_ADAB, I_NMIX, I_NFFN, I_WIN, I_RETGN, I_MU, I_W0, I_W2, I_A0, I_A2, I_G2, I_KK, I_KA, I_RK, I_LN, I_QNORM, I_WQ, I_WQI, I_DONORM, I_SONORM, I_WOUT, I_RW, I_RB, I_MW1, I_MB1, I_MW2, I_MB2, I_NFINAL, N_IN };

constexpr size_t MiB = 1u << 20;
constexpr size_t WS_CTL = 0, CTL_ZERO_BYTES = 1 * MiB;
constexpr size_t WS_MOD = 1 * MiB, WS_ROPE = 2 * MiB, WS_WIN = 14 * MiB, WS_WOUT = 26 * MiB, WS_W1 = 30 * MiB, WS_W2 = 286 * MiB;
constexpr size_t WS_XA = 414 * MiB, WS_H = 542 * MiB, WS_MIX = 606 * MiB, WS_TOPI = 670 * MiB, WS_TOPW = 671 * MiB, WS_POS = 672 * MiB;
constexpr size_t WS_R = 674 * MiB;
constexpr size_t WS_PB = WS_R  , WS_PF = WS_R + 112 * MiB  , WS_RWA = 1058 * MiB  , WS_DQ = 1314 * MiB  , WS_DKB = 1330 * MiB  , WS_DVB = 1334 * MiB  , WS_DQI = 1346 * MiB  , WS_DKI = 1394 * MiB  , WS_DW = 1398 * MiB;
constexpr size_t WS_SMALLW = 1338 * MiB  ;
constexpr int SMW_QI = 0, SMW_W2 = 512 * 128, SMW_A2 = SMW_W2 + 256 * 32, SMW_G2 = SMW_A2 + 256 * 32, SMW_LAYER = SMW_G2 + 256 * 64;
constexpr size_t WS_PT = 1362 * MiB  ;
constexpr size_t WS_CH = WS_H  , WS_SI = WS_H + 16 * MiB  , WS_SIR = WS_H + 24 * MiB  ,
                 WS_CHR = WS_H + 32 * MiB  , WS_PTR = WS_H + 40 * MiB  ;
constexpr size_t WS_SQ = WS_MIX  , WS_SK = WS_MIX + 16 * MiB, WS_SV = WS_MIX + 32 * MiB;
constexpr size_t WS_YO = 1400 * MiB  , WS_SC = 1528 * MiB  ;
constexpr size_t WS_XS = WS_R  , WS_ACT = 946 * MiB  ;
constexpr size_t WS_LIST = 2040 * MiB  , WS_END = 2044 * MiB;
constexpr int LCAP = 32768;
static_assert((size_t)MOE_ROWS * 2048 <= 272 * MiB, "moe buffers");
constexpr int CW_TMO = 0, CW_CODE = 1, CW_GCNT = 256  , CW_DSAQ = 1024  , CW_BAR = 4096, CW_BLKCNT = 16384  ;
constexpr int RING_BYTES = 131072, MISC_OFF = RING_BYTES + 320, TST_OFF = RING_BYTES + 1024  , TAB_OFF = RING_BYTES + 2048  , HIST_OFF = RING_BYTES + 5120  , BASE_OFF = RING_BYTES + 5376  , CNT_OFF = RING_BYTES + 5632  , TEXP_OFF = RING_BYTES + 6144  , LDS_BYTES = 147456;

#if defined(__HIP_DEVICE_COMPILE__)
#define GAS __attribute__((address_space(1)))
#define CAS __attribute__((address_space(4)))
#else
#define GAS
#define CAS
#endif
#define LAS __attribute__((address_space(3)))
typedef unsigned short bf16;
typedef unsigned v4u __attribute__((ext_vector_type(4)));
typedef unsigned v2u __attribute__((ext_vector_type(2)));
typedef float f32x4 __attribute__((ext_vector_type(4)));
typedef GAS unsigned gu32;
typedef short bf16x8v __attribute__((ext_vector_type(8)));
typedef short s16x4v __attribute__((ext_vector_type(4)));
typedef _Float16 f16x8 __attribute__((ext_vector_type(8)));
#define RLX_AGENT __ATOMIC_RELAXED, __HIP_MEMORY_SCOPE_AGENT
#define LDS_WAIT() asm volatile("s_waitcnt lgkmcnt(0)" ::: "memory")
#define VM_WAIT() asm volatile("s_waitcnt vmcnt(0)" ::: "memory")
__device__ __forceinline__ unsigned f2bf(float f) { unsigned u = __builtin_bit_cast(unsigned, f); return (u + 0x7fffu + ((u >> 16) & 1u)) >> 16; }
__device__ __forceinline__ unsigned pk2(float lo, float hi) { return f2bf(lo) | (f2bf(hi) << 16); }
__device__ __forceinline__ float bf_lo(unsigned w) { return __builtin_bit_cast(float, w << 16); }
__device__ __forceinline__ float bf_hi(unsigned w) { return __builtin_bit_cast(float, w & 0xffff0000u); }
__device__ __forceinline__ float wave_sum(float v) {
#pragma unroll
    for (int o = 1; o < 64; o <<= 1) v += __shfl_xor(v, o);
    return v;
}
__device__ __forceinline__ float wave_max(float v) {
#pragma unroll
    for (int o = 1; o < 64; o <<= 1) v = fmaxf(v, __shfl_xor(v, o));
    return v;
}
__device__ __forceinline__ float grp16_sum(float v) { v += __shfl_xor(v, 1); v += __shfl_xor(v, 2); v += __shfl_xor(v, 4); v += __shfl_xor(v, 8); return v; }
__device__ __forceinline__ float grp8_sum(float v) { v += __shfl_xor(v, 1); v += __shfl_xor(v, 2); v += __shfl_xor(v, 4); return v; }
__device__ __forceinline__ float sum4(f32x4 a) { return (a.x + a.y) + (a.z + a.w); }
__device__ __forceinline__ float dot4(f32x4 a, f32x4 b) { return (a.x * b.x + a.y * b.y) + (a.z * b.z + a.w * b.w); }
__device__ __forceinline__ float fexp(float x) { return __builtin_amdgcn_exp2f(x * 1.4426950408889634f); }
__device__ __forceinline__ float sigm(float x) { return __builtin_amdgcn_rcpf(1.0f + fexp(-x)); }
__device__ __forceinline__ float softplusf(float x) { return fmaxf(x, 0.0f) + 0.6931471805599453f * __builtin_amdgcn_logf(1.0f + fexp(-fabsf(x))); }
__device__ __forceinline__ float ftanh(float x) { const float e = fexp(-2.0f * fabsf(x)); const float t = (1.0f - e) * __builtin_amdgcn_rcpf(1.0f + e); return x < 0.0f ? -t : t; }
__device__ __forceinline__ f32x4 shx4(f32x4 v, int m) { f32x4 r; r.x = __shfl_xor(v.x, m); r.y = __shfl_xor(v.y, m); r.z = __shfl_xor(v.z, m); r.w = __shfl_xor(v.w, m); return r; }

#define XB_TMO      128
#define XB_XCNT(j)  (256  + 64 * (j))
#define XB_XSUB(j)  (1280 + 64 * (j))
#define XB_XGEN(j)  (2304 + 64 * (j))
#define XB_TOP      3328
#define XB_TOPGEN   3392
#define XCD_BAR_WORDS 3456
#define XB_SPIN_CAP (1u << 18)

__device__ __forceinline__ unsigned xb_ld(unsigned* p)              { return __hip_atomic_load(p, __ATOMIC_RELAXED, __HIP_MEMORY_SCOPE_AGENT); }
__device__ __forceinline__ unsigned xb_add(unsigned* p, unsigned v) { return __hip_atomic_fetch_add(p, v, __ATOMIC_RELAXED, __HIP_MEMORY_SCOPE_AGENT); }
__device__ __forceinline__ unsigned xb_xcc_id() { return (unsigned)__builtin_amdgcn_s_getreg((3 << 11) | 20) & 0xFu; }
#define XB_SPIN(cond, bar) do { unsigned _sp = 0; while (cond) { __builtin_amdgcn_s_sleep(1); \
    if ((++_sp & 255u) == 0u) { if (xb_ld(&(bar)[XB_TMO])) break; if (_sp > XB_SPIN_CAP) { atomicAdd(&(bar)[XB_TMO], 1u); break; } } } } while (0)

struct XcdBarrier {
    unsigned* bar; unsigned x;
    volatile LAS unsigned* st;
};

__device__ __forceinline__ XcdBarrier xcd_barrier_post(unsigned* bar, volatile LAS unsigned* st, int xb_tid) {
    XcdBarrier b; b.bar = bar; b.x = xb_xcc_id(); b.st = st;
    if (xb_tid == 0) (void)xb_add(&bar[XB_XCNT(b.x)], 1u);
    return b;
}
__device__ __forceinline__ void xcd_barrier_complete(unsigned* bar, unsigned x, unsigned& nloc, unsigned& nx) {
    const unsigned G = gridDim.x * gridDim.y * gridDim.z;
    unsigned sum, cnt, mine, sp = 0u;
    for (;;) {
        sum = 0u; cnt = 0u; mine = 0u;
#pragma unroll
        for (unsigned j = 0; j < 16; ++j) { const unsigned c = xb_ld(&bar[XB_XCNT(j)]); sum += c; cnt += (c > 0u) ? 1u : 0u; mine = (j == x) ? c : mine; }
        if (sum == G) break;
        __builtin_amdgcn_s_sleep(1);
        if ((++sp & 255u) == 0u) { if (xb_ld(&bar[XB_TMO])) break; if (sp > XB_SPIN_CAP) { atomicAdd(&bar[XB_TMO], 1u); break; } }
    }
    nloc = mine > 0u ? mine : 1u; nx = cnt > 0u ? cnt : 1u;
}

__device__ __forceinline__ void xcd_barrier(const XcdBarrier& b, int xb_tid) {
    asm volatile("s_waitcnt vmcnt(0)" ::: "memory");
    __syncthreads();
    if (xb_tid == 0) {
        unsigned* bar = b.bar;
        __builtin_amdgcn_s_waitcnt(0);
        unsigned nloc = b.st[0], nx = b.st[1];
        if (nloc == 0u) { xcd_barrier_complete(bar, b.x, nloc, nx); b.st[0] = nloc; b.st[1] = nx; }
        const unsigned old = xb_add(&bar[XB_XSUB(b.x)], 1u);
        const unsigned gen = old / nloc;
        if (old + 1u == (gen + 1u) * nloc) {
            __builtin_amdgcn_fence(__ATOMIC_RELEASE, "agent");
            asm volatile("s_waitcnt vmcnt(0)" ::: "memory");
            const unsigned og = xb_add(&bar[XB_TOP], 1u);
            const unsigned tg = og / nx;
            if (og + 1u == (tg + 1u) * nx) xb_add(&bar[XB_TOPGEN], 1u);
            else XB_SPIN(xb_ld(&bar[XB_TOPGEN]) == tg, bar);
            __builtin_amdgcn_fence(__ATOMIC_ACQUIRE, "agent");
            xb_add(&bar[XB_XGEN(b.x)], 1u);
            asm volatile("s_waitcnt vmcnt(0)" ::: "memory");
        } else {
            XB_SPIN(xb_ld(&bar[XB_XGEN(b.x)]) == gen, bar);
            __builtin_amdgcn_fence(__ATOMIC_ACQUIRE, "agent");
            asm volatile("s_waitcnt vmcnt(0)" ::: "memory");
        }
    }
    __syncthreads();
}
struct ArgsH { const float* in[N_IN]; float* out; unsigned char* ws; double invf[44]; int ph_lo, ph_hi, li, pad; };
struct ArgsD { const GAS float* in[N_IN]; GAS float* out; GAS unsigned char* ws; double invf[44]; int ph_lo, ph_hi, li, pad; };
static_assert(sizeof(ArgsH) == sizeof(ArgsD), "args layout");
typedef const CAS ArgsD& ARef;
__device__ __forceinline__ const CAS ArgsD* kargs() {
#if defined(__HIP_DEVICE_COMPILE__)
    const CAS ArgsD* p = (const CAS ArgsD*)__builtin_amdgcn_kernarg_segment_ptr(); asm volatile("" : "+s"(p)); return p;
#else
    return nullptr;
#endif
}
struct WI { LAS unsigned char* lds; int tid, lane, wave, vcu, G, gw, NGW, bx; };
constexpr size_t RWA_STRIDE = 32 * MiB / 4;
constexpr size_t YO_STRIDE = 32 * MiB / 4;

__device__ __forceinline__ int wave_sum_i(int v) {
#pragma unroll
    for (int o = 1; o < 64; o <<= 1) v += __shfl_xor(v, o);
    return v;
}
__device__ __forceinline__ void sincos_d(double ang, float& s, float& c) {
    const double q = __builtin_rint(ang * 0.63661977236758134308);
    double r = __builtin_fma(-q, 1.57079632679489661923, ang); r = __builtin_fma(-q, 6.123233995736766e-17, r);
    const double r2 = r * r;
    const double sp = r * (1.0 + r2 * (-1.0 / 6 + r2 * (1.0 / 120 + r2 * (-1.0 / 5040 + r2 * (1.0 / 362880 + r2 * (-1.0 / 39916800 + r2 * (1.0 / 6227020800.0)))))));
    const double cp = 1.0 + r2 * (-0.5 + r2 * (1.0 / 24 + r2 * (-1.0 / 720 + r2 * (1.0 / 40320 + r2 * (-1.0 / 3628800 + r2 * (1.0 / 479001600 + r2 * (-1.0 / 87178291200.0)))))));
    const int qi = ((int)q) & 3;
    const double ss = (qi == 0) ? sp : (qi == 1) ? cp : (qi == 2) ? -sp : -cp;
    const double cc = (qi == 0) ? cp : (qi == 1) ? -sp : (qi == 2) ? -cp : sp;
    s = (float)ss; c = (float)cc;
}

struct TrItem { const float* src; bf16* dst; int ldw; float scale; bool ok; };
__device__ __forceinline__ void tr_decode(ARef A, int it, int lane, TrItem& d) {
    constexpr int I_IN = NLAYER * 16 * 96, I_OUT = NLAYER * 16 * 32, I_W1 = NLAYER * NEXP * 16 * 64;
    const float* W; int ldw, nvalid, k0, nsrc0; bf16* WT; size_t dstrow0; float scale = 1.0f;
    int r = it;
    if (r < I_IN) { const int l = r / 1536, rr = r % 1536, kb = rr / 96, nb = rr % 96;
        const int nd = nb * 32;
        nsrc0 = (nd < 1024) ? nd : (nd < 1792) ? C_SB + (nd - 1024) : (nd < 2688) ? C_RW + (nd - 1792) : C_DSA + (nd - 2688);
        nvalid = (nd < 1024) ? 1024 : (nd < 1792) ? INC : (nd < 2688) ? C_DSA : ((nd < INC) ? C_SB : 0);
        scale = (nd >= 256 && nd < 512) ? 0.125f : (nd >= 1024 && nd < 1280) ? 0.18033688011112042f : 1.0f;
        W = A.in[I_WIN] + (size_t)l * DM * INC; ldw = INC; k0 = kb * 64; WT = (bf16*)(A.ws + WS_WIN) + (size_t)l * INCP * DM; dstrow0 = (size_t)nd; }
    else if (r < I_IN + I_OUT) { r -= I_IN; const int l = r / 512, rr = r % 512, kb = rr / 32, nb = rr % 32;
        W = A.in[I_WOUT] + (size_t)l * DM * DM; ldw = DM; nvalid = DM; k0 = kb * 64; nsrc0 = nb * 32; WT = (bf16*)(A.ws + WS_WOUT) + (size_t)l * DM * DM; dstrow0 = (size_t)nb * 32; }
    else if (r < I_IN + I_OUT + I_W1) { r -= I_IN + I_OUT; const int le = r / 1024, rr = r % 1024, kb = rr / 64, nb = rr % 64, j = nb >> 3, bj = (nb >> 2) & 1, cc0 = (nb & 3) * 32;
        W = A.in[I_MW1] + (size_t)le * DM * 2048; ldw = 2048; nvalid = 2048; k0 = kb * 64; nsrc0 = bj * 1024 + 128 * j + cc0; WT = (bf16*)(A.ws + WS_W1) + (size_t)le * 2048 * DM; dstrow0 = (size_t)nb * 32; }
    else { r -= I_IN + I_OUT + I_W1; const int le = r / 512, rr = r % 512, kb = rr / 32, nb = rr % 32;
        W = A.in[I_MW2] + (size_t)le * DM * DM; ldw = DM; nvalid = DM; k0 = kb * 64; nsrc0 = nb * 32; WT = (bf16*)(A.ws + WS_W2) + (size_t)le * DM * DM; dstrow0 = (size_t)nb * 32; }
    const int n = nsrc0 + 4 * (lane & 7);
    d.ok = n < nvalid; d.src = W + (size_t)(k0 + (lane >> 3)) * ldw + (d.ok ? n : 0); d.ldw = ldw; d.scale = scale;
    d.dst = WT + (dstrow0 + (lane >> 3)) * 1024 + k0 + 8 * (lane & 7);
}
__device__ __forceinline__ void tr_load(const TrItem& d, f32x4 (&v)[8]) {
#pragma unroll
    for (int i = 0; i < 8; ++i) v[i] = *(const f32x4*)(d.src + (size_t)(8 * i) * d.ldw);
}
__device__ __forceinline__ void tr_store(const TrItem& d, const f32x4 (&v)[8], LAS float* scr, int lane) {
    const float sc_ = d.ok ? d.scale : 0.0f;
#pragma unroll
    for (int i = 0; i < 8; ++i) { LAS float* s = scr + (8 * i + (lane >> 3)) * 33 + 4 * (lane & 7); s[0] = v[i].x * sc_; s[1] = v[i].y * sc_; s[2] = v[i].z * sc_; s[3] = v[i].w * sc_; }
    LDS_WAIT(); asm volatile("" ::: "memory");
    const int c8 = lane & 7;
#pragma unroll
    for (int j = 0; j < 4; ++j) { const int n = (lane >> 3) + 8 * j; const LAS float* s = scr + (8 * c8) * 33 + n;
        v4u o; o.x = pk2(s[0 * 33], s[1 * 33]); o.y = pk2(s[2 * 33], s[3 * 33]); o.z = pk2(s[4 * 33], s[5 * 33]); o.w = pk2(s[6 * 33], s[7 * 33]);
        *(v4u*)(d.dst + (size_t)(8 * j) * 1024) = o; }
    LDS_WAIT(); asm volatile("" ::: "memory");
}
__device__ __forceinline__ void ph_prologue(ARef A, const WI& w) {
    LAS float* sc = (LAS float*)w.lds;
    { const float* cin = A.in[I_C]; for (int i = w.tid; i < NB * DM; i += NWAVES * 64) { const float v = cin[i]; sc[i] = v / (1.0f + expf(-v)); } }
    __syncthreads();
    float* MOD = (float*)(A.ws + WS_MOD);
    LAS float* red = (LAS float*)(w.lds + 32768);
    if (w.vcu < 192) {
        const int l = w.vcu / 96, col = (w.vcu % 96) * 64 + w.lane, kw = 128 * w.wave;
        const float* wp = A.in[I_ADAW] + (size_t)l * DM * 6144 + (size_t)kw * 6144 + col;
        float acc[8];
#pragma unroll
        for (int b = 0; b < 8; ++b) acc[b] = 0.0f;
#pragma unroll 16
        for (int k = 0; k < 128; ++k) { const float wv = wp[(size_t)k * 6144];
#pragma unroll
            for (int b = 0; b < 8; ++b) acc[b] += sc[b * DM + kw + k] * wv; }
#pragma unroll
        for (int b = 0; b < 8; ++b) red[(w.wave * 8 + b) * 64 + w.lane] = acc[b];
    }
    __syncthreads();
    if (w.vcu < 192) { const int l = w.vcu / 96, b = w.wave, col = (w.vcu % 96) * 64 + w.lane;
        float s = A.in[I_ADAB][l * 6144 + col];
#pragma unroll
        for (int q = 0; q < 8; ++q) s += red[(q * 8 + b) * 64 + w.lane];
        MOD[(size_t)(l * 8 + b) * 6144 + col] = s; }
    __syncthreads();
    LAS float* scr = (LAS float*)(w.lds + 32768 + w.wave * 8448);
    constexpr int NIT = NLAYER * 16 * 96 + NLAYER * 16 * 32 + NLAYER * NEXP * 16 * 64 + NLAYER * NEXP * 16 * 32;
    { TrItem d0, d1; f32x4 va[8], vb[8];
      int it = w.gw; bool h0 = it < NIT;
      if (h0) { tr_decode(A, it, w.lane, d0); tr_load(d0, va); }
      while (h0) {
          it += w.NGW; const bool h1 = it < NIT;
          if (h1) { tr_decode(A, it, w.lane, d1); tr_load(d1, vb); }
          tr_store(d0, va, scr, w.lane);
          if (!h1) break;
          it += w.NGW; h0 = it < NIT;
          if (h0) { tr_decode(A, it, w.lane, d0); tr_load(d0, va); }
          tr_store(d1, vb, scr, w.lane);
      } }
    float* RT = (float*)(A.ws + WS_ROPE); const int* pos = (const int*)A.in[I_POS];
    for (int g = w.gw * 64 + w.lane; g < MTOK * 44; g += w.NGW * 64) {
        const int tok = g / 44, f = g % 44; int co, so;
        if (f < 32) { co = f; so = 32 + f; } else if (f < 40) { co = 64 + (f - 32); so = 72 + (f - 32); } else { co = 80 + (f - 40); so = 84 + (f - 40); }
        float s, c; sincos_d((double)pos[tok] * A.invf[f], s, c);
        RT[(size_t)tok * ROPE_W + co] = c; RT[(size_t)tok * ROPE_W + so] = s;
    }
}

__device__ __forceinline__ void emit_h_row(const f32x4 (&v)[4], float rstd, const float* g, const float* sc, const float* sh, bf16* hrow, int lane) {
#pragma unroll
    for (int j = 0; j < 4; ++j) { const int k = 4 * (lane + 64 * j);
        const f32x4 gv = *(const f32x4*)(g + k), scv = *(const f32x4*)(sc + k), shv = *(const f32x4*)(sh + k);
        const f32x4 h = v[j] * rstd * gv * (1.0f + scv) + shv;
        v2u o; o.x = pk2(h.x, h.y); o.y = pk2(h.z, h.w); *(v2u*)(hrow + k) = o; }
}
__device__ __forceinline__ void small_weights_to_f16(ARef A, const WI& w) {
    { _Float16* SW = (_Float16*)(A.ws + WS_SMALLW);
      const int g0 = w.gw * 64 + w.lane, gs = w.NGW * 64;
      for (int l = 0; l < NLAYER; ++l) { _Float16* S = SW + (size_t)l * SMW_LAYER;
          const float* wq = A.in[I_WQ] + (size_t)l * 128 * 256; const float* wqi = A.in[I_WQI] + (size_t)l * 128 * 256;
          for (int e = g0; e < 256 * 128; e += gs) { const int n = e >> 7, k = e & 127; S[SMW_QI + e] = (_Float16)wq[k * 256 + n]; S[SMW_QI + 256 * 128 + e] = (_Float16)wqi[k * 256 + n]; }
          const float* w2 = A.in[I_W2] + (size_t)l * 32 * 256; const float* a2 = A.in[I_A2] + (size_t)l * 32 * 256; const float* g2 = A.in[I_G2] + (size_t)l * 64 * 256;
          for (int e = g0; e < 256 * 32; e += gs) { const int n = e >> 5, k = e & 31; S[SMW_W2 + e] = (_Float16)w2[k * 256 + n]; S[SMW_A2 + e] = (_Float16)a2[k * 256 + n]; }
          for (int e = g0; e < 256 * 64; e += gs) { const int n = e >> 6, k = e & 63; S[SMW_G2 + e] = (_Float16)g2[k * 256 + n]; } } }
}
__device__ __forceinline__ void ph_norm1(ARef A, const WI& w) {
    const float* MOD = (const float*)(A.ws + WS_MOD); bf16* H = (bf16*)(A.ws + WS_H);
    for (int m = w.gw; m < MTOK; m += w.NGW) {
        const float* xr = A.in[I_X] + (size_t)m * DM; f32x4 v[4]; float ss = 0.0f;
#pragma unroll
        for (int j = 0; j < 4; ++j) { v[j] = *(const f32x4*)(xr + 4 * (w.lane + 64 * j)); ss += dot4(v[j], v[j]); }
        ss = wave_sum(ss); const float rstd = 1.0f / sqrtf(ss * (1.0f / DM) + 1e-5f);
        const float* mb = MOD + (size_t)(m >> 12) * 6144;
        emit_h_row(v, rstd, A.in[I_NMIX], mb + 1024, mb, H + (size_t)m * DM, w.lane);
    }
}

typedef _Float16 h4v __attribute__((ext_vector_type(4)));
__device__ __forceinline__ f16x8 pack_f16x8(f32x4 a, f32x4 b) { f16x8 r; r[0] = (_Float16)a.x; r[1] = (_Float16)a.y; r[2] = (_Float16)a.z; r[3] = (_Float16)a.w; r[4] = (_Float16)b.x; r[5] = (_Float16)b.y; r[6] = (_Float16)b.z; r[7] = (_Float16)b.w; return r; }
__device__ __forceinline__ void prep16(ARef A, int l, int m0, int lane_in) {
    int lane = lane_in; asm volatile("" : "+v"(lane));
    const int tk = lane & 15, q4 = lane >> 4, m = m0 + tk, t = m & (SEQ - 1);
    const float* P = (const float*)(A.ws + WS_PF); float* RWA = (float*)(A.ws + WS_RWA); const _Float16* SW = (const _Float16*)(A.ws + WS_SMALLW) + (size_t)l * SMW_LAYER;
    const float* pr = P + (size_t)m * PFW; const float* pp = pr - PFW; const float* pd = P + (size_t)m * PFW + PF_DSA; const float* mu = A.in[I_MU] + l * 896;
    const float* RT = (const float*)(A.ws + WS_ROPE) + (size_t)m * ROPE_W; const f32x4 zero4 = {0.f, 0.f, 0.f, 0.f};
    f16x8 bx[4], bc[4];
    { float ss = 0.0f; f32x4 c[4][2];
#pragma unroll
      for (int ks = 0; ks < 4; ++ks) { const int f0 = 32 * ks + 8 * q4;
          f32x4 x[2];
#pragma unroll
          for (int u = 0; u < 2; ++u) { const f32x4 z = *(const f32x4*)(pr + 768 + f0 + 4 * u); const f32x4 p = t ? *(const f32x4*)(pp + 768 + f0 + 4 * u) : zero4; x[u] = z + (p - z) * *(const f32x4*)(mu + 768 + f0 + 4 * u);
#pragma unroll
              for (int i = 0; i < 4; ++i) x[u][i] = (ks == 0) ? ftanh(x[u][i]) : (ks == 1) ? x[u][i] : sigm(x[u][i]); }
          bx[ks] = pack_f16x8(x[0], x[1]);
          c[ks][0] = *(const f32x4*)(pd + f0); c[ks][1] = *(const f32x4*)(pd + f0 + 4); ss += dot4(c[ks][0], c[ks][0]) + dot4(c[ks][1], c[ks][1]); }
      ss += __shfl_xor(ss, 16); ss += __shfl_xor(ss, 32);
      const float rstd = 1.0f / sqrtf(ss * (1.0f / 128.0f) + 1e-5f); const float* qn = A.in[I_QNORM] + l * 128;
#pragma unroll
      for (int ks = 0; ks < 4; ++ks) { const int f0 = 32 * ks + 8 * q4; bc[ks] = pack_f16x8(c[ks][0] * rstd * *(const f32x4*)(qn + f0), c[ks][1] * rstd * *(const f32x4*)(qn + f0 + 4)); } }
    const _Float16* wrow = SW + (size_t)tk * 0;
    (void)wrow;
    const int arow = lane & 15;
#pragma unroll 1
    for (int hd = 0; hd < 4; ++hd) {
        f32x4 fk[4], av[4]; float ssk = 0.0f;
#pragma unroll
        for (int j = 0; j < 4; ++j) { const int nb = 4 * hd + j, ch = 16 * nb + 4 * q4; const size_t o = (size_t)m * 256 + ch;
            const f16x8 aw = *(const f16x8*)(SW + SMW_W2 + (16 * nb + arow) * 32 + 8 * q4), aa = *(const f16x8*)(SW + SMW_A2 + (16 * nb + arow) * 32 + 8 * q4);
            const f16x8 ag0 = *(const f16x8*)(SW + SMW_G2 + (16 * nb + arow) * 64 + 8 * q4), ag1 = *(const f16x8*)(SW + SMW_G2 + (16 * nb + arow) * 64 + 32 + 8 * q4);
            const f32x4 cw = __builtin_amdgcn_mfma_f32_16x16x32_f16(aw, bx[0], *(const f32x4*)(A.in[I_W0] + l * 256 + ch), 0, 0, 0);
            const f32x4 ca = __builtin_amdgcn_mfma_f32_16x16x32_f16(aa, bx[1], *(const f32x4*)(A.in[I_A0] + l * 256 + ch), 0, 0, 0);
            f32x4 cg = __builtin_amdgcn_mfma_f32_16x16x32_f16(ag0, bx[2], zero4, 0, 0, 0); cg = __builtin_amdgcn_mfma_f32_16x16x32_f16(ag1, bx[3], cg, 0, 0, 0);
            f32x4 dec;
#pragma unroll
            for (int i = 0; i < 4; ++i) { dec[i] = fexp(-fexp(-softplusf(-cw[i]) - 0.5f)); av[j][i] = sigm(ca[i]); }
            *(f32x4*)(RWA + 1 * RWA_STRIDE + o) = dec; *(f32x4*)(RWA + 6 * RWA_STRIDE + o) = cg;
            { const f32x4 z = *(const f32x4*)(pr + 256 + ch); const f32x4 p = t ? *(const f32x4*)(pp + 256 + ch) : zero4; fk[j] = z + (p - z) * *(const f32x4*)(mu + 256 + ch); }
            const f32x4 kk = fk[j] * *(const f32x4*)(A.in[I_KK] + l * 256 + ch); ssk += dot4(kk, kk); }
        ssk += __shfl_xor(ssk, 16); ssk += __shfl_xor(ssk, 32);
        const float inrm = 1.0f / fmaxf(sqrtf(ssk), 1e-12f);
        f32x4 fr[4], km[4]; float bs = 0.0f;
#pragma unroll
        for (int j = 0; j < 4; ++j) { const int ch = 16 * (4 * hd + j) + 4 * q4;
            { const f32x4 z = *(const f32x4*)(pr + ch); const f32x4 p = t ? *(const f32x4*)(pp + ch) : zero4; fr[j] = z + (p - z) * *(const f32x4*)(mu + ch); }
            km[j] = fk[j] * (1.0f + (av[j] - 1.0f) * *(const f32x4*)(A.in[I_KA] + l * 256 + ch)); bs += dot4(fr[j] * km[j], *(const f32x4*)(A.in[I_RK] + l * 256 + ch)); }
        bs += __shfl_xor(bs, 16); bs += __shfl_xor(bs, 32);
#pragma unroll
        for (int j = 0; j < 4; ++j) { const int ch = 16 * (4 * hd + j) + 4 * q4; const size_t o = (size_t)m * 256 + ch;
            f32x4 fv; { const f32x4 z = *(const f32x4*)(pr + 512 + ch); const f32x4 p = t ? *(const f32x4*)(pp + 512 + ch) : zero4; fv = z + (p - z) * *(const f32x4*)(mu + 512 + ch); }
            const f32x4 kk = fk[j] * *(const f32x4*)(A.in[I_KK] + l * 256 + ch) * inrm;
            *(f32x4*)(RWA + 0 * RWA_STRIDE + o) = fr[j]; *(f32x4*)(RWA + 2 * RWA_STRIDE + o) = km[j]; *(f32x4*)(RWA + 3 * RWA_STRIDE + o) = fv;
            *(f32x4*)(RWA + 4 * RWA_STRIDE + o) = -kk; *(f32x4*)(RWA + 5 * RWA_STRIDE + o) = kk * av[j]; *(f32x4*)(RWA + 7 * RWA_STRIDE + o) = bs * fv; }
    }
#pragma unroll 1
    for (int nb = 0; nb < 32; ++nb) {
        f32x4 cq = zero4;
#pragma unroll
        for (int ks = 0; ks < 4; ++ks) { const f16x8 aq = *(const f16x8*)(SW + SMW_QI + (16 * nb + arow) * 128 + 32 * ks + 8 * q4); cq = __builtin_amdgcn_mfma_f32_16x16x32_f16(aq, bc[ks], cq, 0, 0, 0); }
        const int ch = 16 * (nb & 15) + 4 * q4;
        if (nb < 16) {
            if ((nb & 3) == 0) { const f32x4 ot = shx4(cq, 32); const int fi = 4 * (q4 & 1); const f32x4 cs4 = *(const f32x4*)(RT + 64 + fi), sn = *(const f32x4*)(RT + 72 + fi); cq = (q4 < 2) ? cq * cs4 - ot * sn : ot * sn + cq * cs4; }
            const f32x4 qs = cq * 0.18033688011112042f; v2u o; o.x = pk2(qs.x, qs.y); o.y = pk2(qs.z, qs.w); *(v2u*)((bf16*)(A.ws + WS_DQ) + (size_t)m * 256 + ch) = o;
        } else {
            if ((nb & 1) == 0) { const f32x4 ot = shx4(cq, 16); const f32x4 cs4 = *(const f32x4*)(RT + 80), sn = *(const f32x4*)(RT + 84); if (q4 < 2) cq = (q4 < 1) ? cq * cs4 - ot * sn : ot * sn + cq * cs4; }
            h4v hq; hq.x = (_Float16)cq.x; hq.y = (_Float16)cq.y; hq.z = (_Float16)cq.z; hq.w = (_Float16)cq.w; *(h4v*)((_Float16*)(A.ws + WS_DQI) + (size_t)m * 256 + ch) = hq;
        }
    }
#pragma unroll
    for (int j = 0; j < 4; ++j) { const int d = 16 * j + 4 * q4; f32x4 kx = *(const f32x4*)(pd + 128 + d);
        if (j == 0) { const f32x4 ot = shx4(kx, 32); const int fi = 4 * (q4 & 1); const f32x4 cs4 = *(const f32x4*)(RT + 64 + fi), sn = *(const f32x4*)(RT + 72 + fi); kx = (q4 < 2) ? kx * cs4 - ot * sn : ot * sn + kx * cs4; }
        v2u o; o.x = pk2(kx.x, kx.y); o.y = pk2(kx.z, kx.w); *(v2u*)((bf16*)(A.ws + WS_DKB) + (size_t)m * 64 + d) = o;
        const f32x4 vx = *(const f32x4*)(pd + 192 + d); v2u ov; ov.x = pk2(vx.x, vx.y); ov.y = pk2(vx.z, vx.w); *(v2u*)((bf16*)(A.ws + WS_DVB) + (size_t)m * 64 + d) = ov; }
#pragma unroll
    for (int j = 0; j < 2; ++j) { const int d = 16 * j + 4 * q4; f32x4 ki = *(const f32x4*)(pd + 256 + d);
        if (j == 0) { const f32x4 ot = shx4(ki, 16); const f32x4 cs4 = *(const f32x4*)(RT + 80), sn = *(const f32x4*)(RT + 84); if (q4 < 2) ki = (q4 < 1) ? ki * cs4 - ot * sn : ot * sn + ki * cs4; }
        h4v hk; hk.x = (_Float16)ki.x; hk.y = (_Float16)ki.y; hk.z = (_Float16)ki.z; hk.w = (_Float16)ki.w; *(h4v*)((_Float16*)(A.ws + WS_DKI) + (size_t)m * 32 + d) = hk; }
    if (q4 < 2) *(f32x4*)((float*)(A.ws + WS_DW) + (size_t)m * 8 + 4 * q4) = *(const f32x4*)(pd + 288 + 4 * q4) * 0.0625f;
}
__device__ __forceinline__ float quad_sum(float v) {
    v += __builtin_bit_cast(float, __builtin_amdgcn_mov_dpp(__builtin_bit_cast(int, v), 0xB1, 0xF, 0xF, true));
    v += __builtin_bit_cast(float, __builtin_amdgcn_mov_dpp(__builtin_bit_cast(int, v), 0x4E, 0xF, 0xF, true));
    return v;
}
__device__ __forceinline__ float oct_sum(float v) {
    v += __builtin_bit_cast(float, __builtin_amdgcn_mov_dpp(__builtin_bit_cast(int, v), 0xB1, 0xF, 0xF, true));
    v += __builtin_bit_cast(float, __builtin_amdgcn_mov_dpp(__builtin_bit_cast(int, v), 0x4E, 0xF, 0xF, true));
    v += __builtin_bit_cast(float, __builtin_amdgcn_mov_dpp(__builtin_bit_cast(int, v), 0x141, 0xF, 0xF, true));
    return v;
}
typedef float f32x2 __attribute__((ext_vector_type(2)));
#define LO2(v_) __builtin_shufflevector(v_, v_, 0, 1)
#define HI2(v_) __builtin_shufflevector(v_, v_, 2, 3)
#define RW_ROW(i_) (((i_) < 2) ? (16 * ws + rg + 8 * (i_)) : (64 + 16 * ws + rg + 8 * ((i_) - 2)))
#define RW_LOAD(op, s_) do { const int lo_ = (s_) * 64 + kq * 8; \
    op[0] = *(const LAS f32x4*)(sn + lo_); op[1] = *(const LAS f32x4*)(sn + lo_ + 4); op[2] = *(const LAS f32x4*)(sw + lo_); op[3] = *(const LAS f32x4*)(sw + lo_ + 4); \
    op[4] = *(const LAS f32x4*)(sb + lo_); op[5] = *(const LAS f32x4*)(sb + lo_ + 4); op[6] = *(const LAS f32x4*)(sk + lo_); op[7] = *(const LAS f32x4*)(sk + lo_ + 4); \
    op[8] = *(const LAS f32x4*)(sr + lo_); op[9] = *(const LAS f32x4*)(sr + lo_ + 4); \
    vin[0] = sv[(s_) * 64 + 16 * ws + rg]; vin[1] = sv[(s_) * 64 + 16 * ws + rg + 8]; } while (0)
#define RW_DOT(i_, oa, ob) ({ f32x2 d_ = S[i_][0] * LO2(oa); d_ = S[i_][1] * HI2(oa) + d_; d_ = S[i_][2] * LO2(ob) + d_; d_ = S[i_][3] * HI2(ob) + d_; d_.x + d_.y; })
#define RW_STEP(op, vv, s_) do { float sa_[4], y_[4]; \
    _Pragma("unroll") for (int i_ = 0; i_ < 4; ++i_) sa_[i_] = RW_DOT(i_, op[0], op[1]); \
    _Pragma("unroll") for (int i_ = 0; i_ < 4; ++i_) sa_[i_] += __builtin_bit_cast(float, __builtin_amdgcn_mov_dpp(__builtin_bit_cast(int, sa_[i_]), 0xB1, 0xF, 0xF, true)); \
    _Pragma("unroll") for (int i_ = 0; i_ < 4; ++i_) sa_[i_] += __builtin_bit_cast(float, __builtin_amdgcn_mov_dpp(__builtin_bit_cast(int, sa_[i_]), 0x4E, 0xF, 0xF, true)); \
    _Pragma("unroll") for (int i_ = 0; i_ < 4; ++i_) sa_[i_] += __builtin_bit_cast(float, __builtin_amdgcn_mov_dpp(__builtin_bit_cast(int, sa_[i_]), 0x141, 0xF, 0xF, true)); \
    _Pragma("unroll") for (int i_ = 0; i_ < 2; ++i_) { const f32x2 a2_ = {sa_[i_], sa_[i_]}, v2_ = {vv[i_], vv[i_]}; \
        S[i_][0] = S[i_][0] * LO2(op[2]) + (a2_ * LO2(op[4]) + v2_ * LO2(op[6])); S[i_][1] = S[i_][1] * HI2(op[2]) + (a2_ * HI2(op[4]) + v2_ * HI2(op[6])); \
        S[i_][2] = S[i_][2] * LO2(op[3]) + (a2_ * LO2(op[5]) + v2_ * LO2(op[7])); S[i_][3] = S[i_][3] * HI2(op[3]) + (a2_ * HI2(op[5]) + v2_ * HI2(op[7])); } \
    _Pragma("unroll") for (int i_ = 2; i_ < 4; ++i_) { const f32x2 a2_ = {sa_[i_], sa_[i_]}; \
        S[i_][0] = S[i_][0] * LO2(op[2]) + a2_ * LO2(op[4]); S[i_][1] = S[i_][1] * HI2(op[2]) + a2_ * HI2(op[4]); S[i_][2] = S[i_][2] * LO2(op[3]) + a2_ * LO2(op[5]); S[i_][3] = S[i_][3] * HI2(op[3]) + a2_ * HI2(op[5]); } \
    _Pragma("unroll") for (int i_ = 0; i_ < 4; ++i_) y_[i_] = RW_DOT(i_, op[8], op[9]); \
    _Pragma("unroll") for (int i_ = 0; i_ < 4; ++i_) y_[i_] += __builtin_bit_cast(float, __builtin_amdgcn_mov_dpp(__builtin_bit_cast(int, y_[i_]), 0xB1, 0xF, 0xF, true)); \
    _Pragma("unroll") for (int i_ = 0; i_ < 4; ++i_) y_[i_] += __builtin_bit_cast(float, __builtin_amdgcn_mov_dpp(__builtin_bit_cast(int, y_[i_]), 0x4E, 0xF, 0xF, true)); \
    _Pragma("unroll") for (int i_ = 0; i_ < 4; ++i_) y_[i_] += __builtin_bit_cast(float, __builtin_amdgcn_mov_dpp(__builtin_bit_cast(int, y_[i_]), 0x141, 0xF, 0xF, true)); \
    if (kq == 0) { _Pragma("unroll") for (int i_ = 0; i_ < 4; ++i_) so[(s_) * 128 + RW_ROW(i_)] = y_[i_]; } } while (0)
__device__ __forceinline__ void scan_rwkv_task2(ARef A, const WI& w, int task0) {
    const int slot = w.wave >> 2, ws = w.wave & 3, lt = w.tid & 255, task = task0 + slot;
    const int bh = task >> 4, c = task & 15, b = bh >> 2, h = bh & 3;
    LAS float* sw = (LAS float*)w.lds + slot * 16384; LAS float* sn = sw + 2048; LAS float* sb = sn + 2048; LAS float* sk = sb + 2048; LAS float* sr = sk + 2048; LAS float* sv = sr + 2048; LAS float* so = sv + 2048;
    const float* RWA = (const float*)(A.ws + WS_RWA);
    const int rg = w.lane >> 3, kq = w.lane & 7;
    f32x2 S[4][4];
#pragma unroll
    for (int i = 0; i < 4; ++i)
#pragma unroll
        for (int j = 0; j < 4; ++j) { const int r = RW_ROW(i); S[i][j].x = (r >= 64 && 8 * kq + 2 * j == r - 64) ? 1.0f : 0.0f; S[i][j].y = (r >= 64 && 8 * kq + 2 * j + 1 == r - 64) ? 1.0f : 0.0f; }
    const size_t tok0 = (size_t)b * SEQ + (size_t)c * TCH;
    const int st = lt >> 3, sd = (lt & 7) * 8;
    f32x4 a[6][2];
#define RW_GLOAD(sub_) do { const size_t o_ = (tok0 + (sub_) * 32 + st) * 256 + h * 64 + sd; \
        _Pragma("unroll") for (int q = 0; q < 2; ++q) { a[0][q] = *(const f32x4*)(RWA + 1 * RWA_STRIDE + o_ + 4 * q); a[1][q] = *(const f32x4*)(RWA + 4 * RWA_STRIDE + o_ + 4 * q); a[2][q] = *(const f32x4*)(RWA + 5 * RWA_STRIDE + o_ + 4 * q); \
            a[3][q] = *(const f32x4*)(RWA + 2 * RWA_STRIDE + o_ + 4 * q); a[4][q] = *(const f32x4*)(RWA + 0 * RWA_STRIDE + o_ + 4 * q); a[5][q] = *(const f32x4*)(RWA + 3 * RWA_STRIDE + o_ + 4 * q); } } while (0)
    RW_GLOAD(0);
    for (int sub = 0; sub < TCH / 32; ++sub) {
        __syncthreads();
        { const int lo = st * 64 + sd;
#pragma unroll
          for (int q = 0; q < 2; ++q) { *(LAS f32x4*)(sw + lo + 4 * q) = a[0][q]; *(LAS f32x4*)(sn + lo + 4 * q) = a[1][q]; *(LAS f32x4*)(sb + lo + 4 * q) = a[2][q]; *(LAS f32x4*)(sk + lo + 4 * q) = a[3][q]; *(LAS f32x4*)(sr + lo + 4 * q) = a[4][q]; *(LAS f32x4*)(sv + lo + 4 * q) = a[5][q]; } }
        __syncthreads();
        if (sub + 1 < TCH / 32) RW_GLOAD(sub + 1);
        { f32x4 opA[10], opB[10]; float vin[2], vA[2], vB[2];
          RW_LOAD(opA, 0);
          vA[0] = vin[0]; vA[1] = vin[1];
#pragma unroll 1
          for (int s = 0; s < 32; s += 2) {
              RW_LOAD(opB, s + 1);
              vB[0] = vin[0]; vB[1] = vin[1];
              RW_STEP(opA, vA, s);
              if (s + 2 < 32) { RW_LOAD(opA, s + 2); vA[0] = vin[0]; vA[1] = vin[1]; }
              RW_STEP(opB, vB, s + 1);
          } }
        __syncthreads();
        { const int fs = lt >> 3, c16 = (lt & 7) * 16;
          float* dst = (c16 < 64) ? ((float*)(A.ws + WS_YO) + YO_STRIDE) : ((float*)(A.ws + WS_PT) - 64);
          float* dp = dst + (tok0 + sub * 32 + fs) * 256 + h * 64 + c16;
#pragma unroll
          for (int q = 0; q < 4; ++q) *(f32x4*)(dp + 4 * q) = *(const LAS f32x4*)(so + fs * 128 + c16 + 4 * q); }
    }
    { float* ch = (float*)(A.ws + WS_CH) + ((size_t)(bh * NCH + c) * 128) * 64 + 8 * kq;
#pragma unroll
      for (int i = 0; i < 4; ++i) { float* cr = ch + (size_t)RW_ROW(i) * 64; *(f32x4*)cr = (f32x4){S[i][0].x, S[i][0].y, S[i][1].x, S[i][1].y}; *(f32x4*)(cr + 4) = (f32x4){S[i][2].x, S[i][2].y, S[i][3].x, S[i][3].y}; } }
    __syncthreads();
}
#undef RW_LOAD
#undef RW_STEP
#undef RW_GLOAD
#undef RW_DOT
#undef RW_ROW
__device__ __forceinline__ void scan_ret_task(ARef A, const WI& w, int task) {
    const int bh = task >> 3, cp = task & 7, b = bh >> 2, h = bh & 3, un = w.tid >> 8, lt = w.tid & 255, c = 2 * cp + un;
    const float lg2g = log2f(1.0f - exp2f(-5.0f - (float)h)), gamma = exp2f(lg2g);
    LAS float* sk = (LAS float*)w.lds + un * 8192; LAS float* sq = sk + 2048; LAS float* sv = sq + 2048; LAS float* so = sv + 2048;
    const bf16* PB = (const bf16*)(A.ws + WS_PB); const float* RT = (const float*)(A.ws + WS_ROPE);
    const int row = lt >> 2, kq = lt & 3;
    f32x2 S[8];
#pragma unroll
    for (int j = 0; j < 8; ++j) S[j] = (f32x2){0.0f, 0.0f};
    const f32x2 gam2 = {gamma, gamma};
    const size_t tok0 = (size_t)b * SEQ + (size_t)c * TCH;
    const int st = lt >> 3, sd = (lt & 7) * 8;
    const int fi = sd & 31, dp = sd ^ 32;
    f32x4 gq[2], gqo[2], gk[2], gko[2], gv[2], gcs[2], gsn[2];
#define BF8_TO_F32(dst, x_) do { dst[0] = (f32x4){bf_lo(x_.x), bf_hi(x_.x), bf_lo(x_.y), bf_hi(x_.y)}; dst[1] = (f32x4){bf_lo(x_.z), bf_hi(x_.z), bf_lo(x_.w), bf_hi(x_.w)}; } while (0)
#define RT_GLOAD(sub_) do { const size_t m_ = tok0 + (sub_) * 32 + st; const bf16* pr_ = PB + m_ * PBW + h * 64; const float* rt_ = RT + m_ * ROPE_W; \
        _Pragma("unroll") for (int u = 0; u < 2; ++u) { gcs[u] = *(const f32x4*)(rt_ + fi + 4 * u); gsn[u] = *(const f32x4*)(rt_ + 32 + fi + 4 * u); } \
        { const v4u x0 = *(const v4u*)(pr_ + sd), x1 = *(const v4u*)(pr_ + dp), x2 = *(const v4u*)(pr_ + 256 + sd), x3 = *(const v4u*)(pr_ + 256 + dp), x4 = *(const v4u*)(pr_ + 512 + sd); \
          BF8_TO_F32(gq, x0); BF8_TO_F32(gqo, x1); BF8_TO_F32(gk, x2); BF8_TO_F32(gko, x3); BF8_TO_F32(gv, x4); } } while (0)
    RT_GLOAD(0);
    for (int sub = 0; sub < TCH / 32; ++sub) {
        const size_t m = tok0 + sub * 32 + st;
        f32x4 qn[2], kn[2], vn[2];
#pragma unroll
        for (int u = 0; u < 2; ++u) { qn[u] = (sd < 32) ? gq[u] * gcs[u] - gqo[u] * gsn[u] : gqo[u] * gsn[u] + gq[u] * gcs[u]; kn[u] = (sd < 32) ? gk[u] * gcs[u] - gko[u] * gsn[u] : gko[u] * gsn[u] + gk[u] * gcs[u]; vn[u] = gv[u]; }
        { const float gt = exp2f(lg2g * (float)(sub * 32 + st + 1)); const f32x4 p0 = qn[0] * gt, p1 = qn[1] * gt;
          v4u pw; pw.x = pk2(p0.x, p0.y); pw.y = pk2(p0.z, p0.w); pw.z = pk2(p1.x, p1.y); pw.w = pk2(p1.z, p1.w); *(v4u*)((bf16*)(A.ws + WS_PTR) + m * 256 + h * 64 + sd) = pw; }
        __syncthreads();
        { const int lo = st * 64 + sd; *(LAS f32x4*)(sq + lo) = qn[0]; *(LAS f32x4*)(sq + lo + 4) = qn[1]; *(LAS f32x4*)(sk + lo) = kn[0]; *(LAS f32x4*)(sk + lo + 4) = kn[1]; *(LAS f32x4*)(sv + lo) = vn[0]; *(LAS f32x4*)(sv + lo + 4) = vn[1]; }
        __syncthreads();
        if (sub + 1 < TCH / 32) RT_GLOAD(sub + 1);
        for (int s = 0; s < 32; ++s) {
            const int lo = s * 64 + kq * 16; const float vv = sv[s * 64 + row]; const f32x2 v2 = {vv, vv}; f32x2 y2 = {0.0f, 0.0f};
#pragma unroll
            for (int j4 = 0; j4 < 4; ++j4) { const f32x4 kv = *(const LAS f32x4*)(sk + lo + 4 * j4), rv = *(const LAS f32x4*)(sq + lo + 4 * j4);
                S[2 * j4] = S[2 * j4] * gam2 + v2 * LO2(kv); S[2 * j4 + 1] = S[2 * j4 + 1] * gam2 + v2 * HI2(kv);
                y2 = S[2 * j4] * LO2(rv) + y2; y2 = S[2 * j4 + 1] * HI2(rv) + y2; }
            float y = quad_sum(y2.x + y2.y);
            if (kq == 0) so[s * 64 + row] = y;
        }
        __syncthreads();
        { const int fs = lt >> 3, c8 = (lt & 7) * 8; float* dp2 = (float*)(A.ws + WS_YO) + (tok0 + sub * 32 + fs) * 256 + h * 64 + c8;
          *(f32x4*)dp2 = *(const LAS f32x4*)(so + fs * 64 + c8); *(f32x4*)(dp2 + 4) = *(const LAS f32x4*)(so + fs * 64 + c8 + 4); }
    }
    { float* ch = (float*)(A.ws + WS_CHR) + ((size_t)(bh * NCH + c) * 64 + row) * 64 + 16 * kq;
#pragma unroll
      for (int j4 = 0; j4 < 4; ++j4) *(f32x4*)(ch + 4 * j4) = (f32x4){S[2 * j4].x, S[2 * j4].y, S[2 * j4 + 1].x, S[2 * j4 + 1].y}; }
    __syncthreads();
}
#undef RT_GLOAD
#undef BF8_TO_F32
__device__ __forceinline__ void prefix_chain(ARef A, const WI& w, int bh) {
    LAS float* s0 = (LAS float*)w.lds;
    const int v = w.tid >> 3, k8 = (w.tid & 7) * 8;
    const float* CH = (const float*)(A.ws + WS_CH) + (size_t)bh * NCH * 128 * 64; float* SI = (float*)(A.ws + WS_SI) + (size_t)bh * NCH * 64 * 64;
    f32x4 c0 = {0.f, 0.f, 0.f, 0.f}, c1 = {0.f, 0.f, 0.f, 0.f};
    for (int c = 0; c < NCH; ++c) {
        *(f32x4*)(SI + ((size_t)c * 64 + v) * 64 + k8) = c0; *(f32x4*)(SI + ((size_t)c * 64 + v) * 64 + k8 + 4) = c1;
        if (c == NCH - 1) break;
        __syncthreads();
        *(LAS f32x4*)(s0 + v * 68 + k8) = c0; *(LAS f32x4*)(s0 + v * 68 + k8 + 4) = c1;
        __syncthreads();
        const float* ch = CH + (size_t)c * 128 * 64;
        f32x4 n0 = *(const f32x4*)(ch + (size_t)v * 64 + k8), n1 = *(const f32x4*)(ch + (size_t)v * 64 + k8 + 4);
#pragma unroll 8
        for (int kp = 0; kp < 64; ++kp) { const float s = s0[v * 68 + kp]; const float* pr = ch + (size_t)(64 + kp) * 64 + k8; n0 += s * *(const f32x4*)pr; n1 += s * *(const f32x4*)(pr + 4); }
        c0 = n0; c1 = n1;
    }
    const int h = bh & 3; const float gT = exp2f((float)TCH * log2f(1.0f - exp2f(-5.0f - (float)h)));
    const float* CHR = (const float*)(A.ws + WS_CHR) + (size_t)bh * NCH * 64 * 64; float* SIR = (float*)(A.ws + WS_SIR) + (size_t)bh * NCH * 64 * 64;
    c0 = (f32x4){0.f, 0.f, 0.f, 0.f}; c1 = c0;
    for (int c = 0; c < NCH; ++c) {
        *(f32x4*)(SIR + ((size_t)c * 64 + v) * 64 + k8) = c0; *(f32x4*)(SIR + ((size_t)c * 64 + v) * 64 + k8 + 4) = c1;
        if (c == NCH - 1) break;
        c0 = c0 * gT + *(const f32x4*)(CHR + ((size_t)c * 64 + v) * 64 + k8); c1 = c1 * gT + *(const f32x4*)(CHR + ((size_t)c * 64 + v) * 64 + k8 + 4);
    }
    __syncthreads();
}
typedef float f32x16 __attribute__((ext_vector_type(16)));
constexpr int SBV_PITCH = 144;
__device__ __forceinline__ float lane32_swap(float v) { return __shfl_xor(v, 32); }
__device__ __forceinline__ void sb_tile_mfma(ARef A, int unit, int lane, LAS unsigned char* vl) {
    const int tq = unit & 127, bh = unit >> 7, b = bh >> 2, h = bh & 3, t0 = tq * 32, r32 = lane & 31, hi = lane >> 5;
    const bf16* PS = (const bf16*)(A.ws + WS_PB) + (size_t)b * SEQ * PBW + PB_SB + h * 64;
    bf16x8v qf[4];
#pragma unroll
    for (int ks = 0; ks < 4; ++ks) qf[ks] = *(const bf16x8v*)(PS + (size_t)(t0 + r32) * PBW + 16 * ks + 8 * hi);
    f32x16 o0, o1;
#pragma unroll
    for (int r = 0; r < 16; ++r) { o0[r] = 0.0f; o1[r] = 0.0f; }
    float carry = 0.0f;
    const int g16 = lane >> 4, tj = (lane & 15) >> 2, tc = lane & 3;
    for (int kb0 = t0; kb0 >= 0; kb0 -= 32) {
#pragma unroll
        for (int i = 0; i < 4; ++i) { const int p = lane + 64 * i, row = p >> 3, ch = p & 7; const v4u v = *(const v4u*)(PS + 512 + (size_t)(kb0 + row) * PBW + 8 * ch); *(LAS v4u*)(vl + row * SBV_PITCH + 16 * ch) = v; }
        f32x16 st;
#pragma unroll
        for (int r = 0; r < 16; ++r) st[r] = 0.0f;
        { bf16x8v ka[4];
#pragma unroll
          for (int ks = 0; ks < 4; ++ks) ka[ks] = *(const bf16x8v*)(PS + 256 + (size_t)(kb0 + r32) * PBW + 16 * ks + 8 * hi);
#pragma unroll
          for (int ks = 0; ks < 4; ++ks) st = __builtin_amdgcn_mfma_f32_32x32x16_bf16(ka[ks], qf[ks], st, 0, 0, 0);
          asm volatile("" :: "v"(ka[0]), "v"(ka[1]), "v"(ka[2]), "v"(ka[3]), "v"(st)); }
        float sp[16]; const bool diag = (kb0 == t0);
#pragma unroll
        for (int r = 0; r < 16; ++r) { const float zl = st[r]; float s = (zl > 30.0f) ? zl : __builtin_amdgcn_logf(1.0f + __builtin_amdgcn_exp2f(zl));
            if (diag && ((r & 3) + 8 * (r >> 2) + 4 * hi >= r32)) s = 0.0f;
            sp[r] = s; }
        float G[4], Gp[4], suf[4];
#pragma unroll
        for (int q = 0; q < 4; ++q) { G[q] = (sp[4 * q] + sp[4 * q + 1]) + (sp[4 * q + 2] + sp[4 * q + 3]); Gp[q] = lane32_swap(G[q]); }
        suf[3] = 0.0f; suf[2] = G[3] + Gp[3]; suf[1] = suf[2] + (G[2] + Gp[2]); suf[0] = suf[1] + (G[1] + Gp[1]);
        const float tot = suf[0] + (G[0] + Gp[0]);
        pg8::u32x4 pw0, pw1;
        float av[16];
#pragma unroll
        for (int q = 0; q < 4; ++q) { float run = carry + suf[q] + (hi == 0 ? Gp[q] : 0.0f);
#pragma unroll
            for (int i = 3; i >= 0; --i) { const int r = 4 * q + i; const float la = (st[r] - sp[r]) - run; float a = __builtin_amdgcn_exp2f(la);
                if (diag && ((r & 3) + 8 * (r >> 2) + 4 * hi >= r32)) a = 0.0f;
                av[r] = a; run += sp[r]; } }
        pw0.x = pg8::cvt_pk_bf16(av[0], av[1]); pw0.y = pg8::cvt_pk_bf16(av[2], av[3]); pw0.z = pg8::cvt_pk_bf16(av[4], av[5]); pw0.w = pg8::cvt_pk_bf16(av[6], av[7]);
        pw1.x = pg8::cvt_pk_bf16(av[8], av[9]); pw1.y = pg8::cvt_pk_bf16(av[10], av[11]); pw1.z = pg8::cvt_pk_bf16(av[12], av[13]); pw1.w = pg8::cvt_pk_bf16(av[14], av[15]);
        const bf16x8v pa0 = __builtin_bit_cast(bf16x8v, pw0), pa1 = __builtin_bit_cast(bf16x8v, pw1);
        LDS_WAIT();
#pragma unroll
        for (int s = 0; s < 2; ++s)
#pragma unroll
            for (int nb = 0; nb < 2; ++nb) {
                LAS unsigned char* a1 = vl + (16 * s + 4 * (g16 >> 1) + tj) * SBV_PITCH + (32 * nb + 16 * (g16 & 1) + 4 * tc) * 2;
                const s16x4v r1 = __builtin_bit_cast(s16x4v, __builtin_amdgcn_ds_read_tr16_b64_v4i16((LAS s16x4v*)a1));
                const s16x4v r2 = __builtin_bit_cast(s16x4v, __builtin_amdgcn_ds_read_tr16_b64_v4i16((LAS s16x4v*)(a1 + 8 * SBV_PITCH)));
                const bf16x8v bv = {r1[0], r1[1], r1[2], r1[3], r2[0], r2[1], r2[2], r2[3]};
                if (nb == 0) o0 = __builtin_amdgcn_mfma_f32_32x32x16_bf16(s ? pa1 : pa0, bv, o0, 0, 0, 0); else o1 = __builtin_amdgcn_mfma_f32_32x32x16_bf16(s ? pa1 : pa0, bv, o1, 0, 0, 0);
                asm volatile("" :: "v"(bv), "v"(pa0), "v"(pa1), "v"(o0), "v"(o1)); }
        LDS_WAIT();
        carry += tot;
        if (__all(carry > 150.0f)) break;
    }
    float* YS = (float*)(A.ws + WS_YO) + 3 * YO_STRIDE + ((size_t)b * SEQ + t0) * 256 + h * 64 + r32;
#pragma unroll
    for (int r = 0; r < 16; ++r) { const int qo = (r & 3) + 8 * (r >> 2) + 4 * hi; YS[(size_t)qo * 256] = o0[r]; YS[(size_t)qo * 256 + 32] = o1[r]; }
}

__device__ __forceinline__ void dsa_scores_mfma(ARef A, const WI& w) {
    const _Float16* QIH = (const _Float16*)(A.ws + WS_DQI); const _Float16* KIH = (const _Float16*)(A.ws + WS_DKI);
    const float* DW = (const float*)(A.ws + WS_DW); float* SC = (float*)(A.ws + WS_SC);
    const int col = w.lane & 15, q4 = w.lane >> 4;
    for (int u = w.gw; u < 2048; u += w.NGW) {
        const int pi = u >> 1, par = u & 1, b = pi >> 7, p = pi & 127;
#pragma unroll 1
        for (int side = 0; side < 2; ++side) {
            const int qb = side ? 255 - p : p; const size_t m0 = (size_t)b * SEQ + 16 * qb;
            f16x8 bq[8];
#pragma unroll
            for (int h = 0; h < 8; ++h) bq[h] = *(const f16x8*)(QIH + (m0 + col) * 256 + h * 32 + 8 * q4);
            const float* dw = DW + (m0 + col) * 8; const f32x4 wa = *(const f32x4*)dw, wb = *(const f32x4*)(dw + 4);
            float* srow = SC + (m0 + col) * SEQ + 4 * q4;
            const _Float16* kbase = KIH + ((size_t)b * SEQ + col) * 32 + 8 * q4;
            for (int kp = par; 2 * kp <= qb; kp += 2) {
#pragma unroll
                for (int sub = 0; sub < 2; ++sub) { const int kb = 2 * kp + sub; if (kb > qb) break;
                    const f16x8 ak = *(const f16x8*)(kbase + (size_t)kb * 16 * 32);
                    f32x4 acc = {0.f, 0.f, 0.f, 0.f};
#pragma unroll
                    for (int h = 0; h < 8; ++h) { const f32x4 c = __builtin_amdgcn_mfma_f32_16x16x32_f16(ak, bq[h], (f32x4){0.f, 0.f, 0.f, 0.f}, 0, 0, 0); const float wv = (h < 4) ? wa[h] : wb[h - 4];
                        acc.x += wv * fmaxf(c.x, 0.f); acc.y += wv * fmaxf(c.y, 0.f); acc.z += wv * fmaxf(c.z, 0.f); acc.w += wv * fmaxf(c.w, 0.f); }
                    *(f32x4*)(srow + 16 * kb) = acc + 0.0f; }
            }
        }
    }
}

__device__ __forceinline__ int wave_total_i(int v) {
    v += __builtin_amdgcn_mov_dpp(v, 0xB1, 0xF, 0xF, true);
    v += __builtin_amdgcn_mov_dpp(v, 0x4E, 0xF, 0xF, true);
    v += __builtin_amdgcn_mov_dpp(v, 0x141, 0xF, 0xF, true);
    v += __builtin_amdgcn_mov_dpp(v, 0x140, 0xF, 0xF, true);
    return __builtin_amdgcn_readlane(v, 0) + __builtin_amdgcn_readlane(v, 16) + __builtin_amdgcn_readlane(v, 32) + __builtin_amdgcn_readlane(v, 48);
}
__device__ __forceinline__ unsigned score_key(float f) { const unsigned bits = __float_as_uint(f); return (bits & 0x80000000u) ? ~bits : (bits | 0x80000000u); }
constexpr int VST_PITCH = 144;
typedef unsigned short u16;
__device__ __forceinline__ void dsa_load_scores(ARef A, int m, int lane, f32x4 (&sv)[16]) {
    const int n = (m & (SEQ - 1)) + 1; const float* sc = (const float*)(A.ws + WS_SC) + (size_t)m * SEQ;
#pragma unroll
    for (int j4 = 0; j4 < 16; ++j4) sv[j4] = *(const f32x4*)(sc + ((256 * j4 < n) ? 256 * j4 : 0) + 4 * lane);
}
__device__ __forceinline__ void dsa_select(ARef A, int m, int n, int lane_in, LAS u16* slist, LAS unsigned* bk) {
    int lane = lane_in; asm volatile("" : "+v"(lane));
    if (n <= 256) {
#pragma unroll
        for (int c = 0; c < 4; ++c) { const int idx = lane + 64 * c; slist[idx] = (u16)((idx < n) ? idx : 0); }
        return;
    }
    f32x4 sv[16]; dsa_load_scores(A, m, lane, sv);
    unsigned u[64];
#pragma unroll
    for (int j4 = 0; j4 < 16; ++j4)
#pragma unroll
        for (int i = 0; i < 4; ++i) u[4 * j4 + i] = (256 * j4 + 4 * lane + i < n) ? score_key(sv[j4][i]) : 0u;
    unsigned T = 0u;
    for (int bit = 31; bit >= 16; --bit) { const unsigned cand = T | (1u << bit); int cnt = 0;
#pragma unroll
        for (int j = 0; j < 64; ++j) cnt += (u[j] >= cand) ? 1 : 0;
        if (wave_total_i(cnt) >= 256) T = cand; }
    unsigned long long bkb = 0ull; int chi = 0;
#pragma unroll
    for (int j = 0; j < 64; ++j) { bkb |= (unsigned long long)(((u[j] >> 16) == (T >> 16)) ? 1u : 0u) << j; chi += ((u[j] >> 16) > (T >> 16)) ? 1 : 0; }
    const int cb = wave_total_i(__popcll(bkb)), need = 256 - wave_total_i(chi);
    if (cb <= 64) {
        int pos = __popcll(bkb);
        { const int mine_ = pos;
#pragma unroll
          for (int d = 1; d < 64; d <<= 1) { const int y = __shfl_up(pos, d); if (lane >= d) pos += y; }
          pos -= mine_; }
#pragma unroll
        for (int j = 0; j < 64; ++j) { if ((bkb >> j) & 1ull) { bk[pos] = u[j]; ++pos; } }
        LDS_WAIT();
        const unsigned kx = (lane < cb) ? bk[lane] : 0u;
        for (int bit = 15; bit >= 0; --bit) { const unsigned cand = T | (1u << bit); if (__popcll(__ballot(kx >= cand)) >= need) T = cand; }
        LDS_WAIT();
    } else {
        for (int bit = 15; bit >= 0; --bit) { const unsigned cand = T | (1u << bit); int cnt = 0;
#pragma unroll
            for (int j = 0; j < 64; ++j) cnt += (u[j] >= cand) ? 1 : 0;
            if (wave_total_i(cnt) >= 256) T = cand; }
    }
    unsigned long long gtb = 0ull, eqb = 0ull;
#pragma unroll
    for (int j = 0; j < 64; ++j) { gtb |= (unsigned long long)((u[j] > T) ? 1u : 0u) << j; eqb |= (unsigned long long)((u[j] == T) ? 1u : 0u) << j; }
    const int tgt = wave_total_i(__popcll(gtb)), teq = wave_total_i(__popcll(eqb));
    unsigned long long selb = gtb | eqb;
    if (tgt + teq > 256) {
        const int take = 256 - tgt; int lo = 0;
        for (int bit = 11; bit >= 0; --bit) { const int cand = lo | (1 << bit); const int J4 = cand >> 8; int ni = (cand & 255) - 4 * lane; ni = ni < 0 ? 0 : (ni > 4 ? 4 : ni);
            const int jc = 4 * J4 + ni; const unsigned long long msk = (jc >= 64) ? ~0ull : ((1ull << jc) - 1ull);
            if (wave_total_i(__popcll(eqb & msk)) < take) lo = cand; }
        { const int cand = lo + 1; const int J4 = cand >> 8; int ni = (cand & 255) - 4 * lane; ni = ni < 0 ? 0 : (ni > 4 ? 4 : ni);
          const int jc = (cand >= SEQ) ? 64 : 4 * J4 + ni; const unsigned long long msk = (jc >= 64) ? ~0ull : ((1ull << jc) - 1ull); selb = gtb | (eqb & msk); }
    }
    const int mine = __popcll(selb); int off = mine;
#pragma unroll
    for (int d = 1; d < 64; d <<= 1) { const int y = __shfl_up(off, d); if (lane >= d) off += y; }
    off -= mine;
    while (selb) { const int j = __builtin_ctzll(selb); selb &= selb - 1ull; slist[off] = (u16)(256 * (j >> 2) + 4 * lane + (j & 3)); ++off; }
}
__device__ __forceinline__ void dsa_attend(ARef A, int m, int lane_in, const LAS u16* slist, LAS unsigned char* vbuf) {
    int lane = lane_in; asm volatile("" : "+v"(lane));
    const int b = m >> 12, t = m & (SEQ - 1), n = t + 1, nsel = n < 256 ? n : 256, col = lane & 15, q4 = lane >> 4;
    const bf16* DKB = (const bf16*)(A.ws + WS_DKB) + (size_t)b * SEQ * 64; const bf16* DVB = (const bf16*)(A.ws + WS_DVB) + (size_t)b * SEQ * 64;
    const int vrow = lane >> 3, vpc = lane & 7;
    bf16x8v bq0 = {0, 0, 0, 0, 0, 0, 0, 0}, bq1 = {0, 0, 0, 0, 0, 0, 0, 0};
    if (col < 4) { const bf16* qp = (const bf16*)(A.ws + WS_DQ) + (size_t)m * 256 + col * 64 + 8 * q4; bq0 = *(const bf16x8v*)qp; bq1 = *(const bf16x8v*)(qp + 32); }
    f32x4 lg[16];
#pragma unroll
    for (int hb = 0; hb < 2; ++hb) {
        bf16x8v a0[8], a1[8];
#pragma unroll
        for (int k = 0; k < 8; ++k) { const int s = slist[16 * (8 * hb + k) + col]; const bf16* kr = DKB + (size_t)s * 64 + 8 * q4; a0[k] = *(const bf16x8v*)kr; a1[k] = *(const bf16x8v*)(kr + 32); }
#pragma unroll
        for (int k = 0; k < 8; ++k) { const f32x4 c = __builtin_amdgcn_mfma_f32_16x16x32_bf16(a0[k], bq0, (f32x4){0.f, 0.f, 0.f, 0.f}, 0, 0, 0); lg[8 * hb + k] = __builtin_amdgcn_mfma_f32_16x16x32_bf16(a1[k], bq1, c, 0, 0, 0); }
        __builtin_amdgcn_sched_barrier(0);
    }
    if (nsel < 256) {
#pragma unroll
        for (int kb = 0; kb < 16; ++kb)
#pragma unroll
            for (int r = 0; r < 4; ++r) if (16 * kb + 4 * q4 + r >= nsel) lg[kb][r] = -INFINITY; }
    v4u vr[4];
#pragma unroll
    for (int i = 0; i < 4; ++i) { const int s = slist[vrow + 8 * i]; vr[i] = *(const v4u*)(DVB + (size_t)s * 64 + 8 * vpc); }
    float mx = -INFINITY;
#pragma unroll
    for (int kb = 0; kb < 16; ++kb) mx = fmaxf(fmaxf(mx, fmaxf(lg[kb].x, lg[kb].y)), fmaxf(lg[kb].z, lg[kb].w));
    mx = fmaxf(mx, __shfl_xor(mx, 16)); mx = fmaxf(mx, __shfl_xor(mx, 32));
    float sm = 0.f;
#pragma unroll
    for (int kb = 0; kb < 16; ++kb) { lg[kb].x = __builtin_amdgcn_exp2f(lg[kb].x - mx); lg[kb].y = __builtin_amdgcn_exp2f(lg[kb].y - mx); lg[kb].z = __builtin_amdgcn_exp2f(lg[kb].z - mx); lg[kb].w = __builtin_amdgcn_exp2f(lg[kb].w - mx); sm += (lg[kb].x + lg[kb].y) + (lg[kb].z + lg[kb].w); }
    sm += __shfl_xor(sm, 16); sm += __shfl_xor(sm, 32);
    const float inv = 1.0f / sm;
    bf16x8v pa[8];
#pragma unroll
    for (int i = 0; i < 8; ++i) { const f32x4 x = lg[2 * i] * inv, y = lg[2 * i + 1] * inv;
        pg8::u32x4 wv; wv.x = pg8::cvt_pk_bf16(x.x, x.y); wv.y = pg8::cvt_pk_bf16(x.z, x.w); wv.z = pg8::cvt_pk_bf16(y.x, y.y); wv.w = pg8::cvt_pk_bf16(y.z, y.w);
        pa[i] = __builtin_bit_cast(bf16x8v, wv); }
    f32x4 o[4];
#pragma unroll
    for (int nb = 0; nb < 4; ++nb) o[nb] = (f32x4){0.f, 0.f, 0.f, 0.f};
    const int tj = col >> 2, tc = col & 3;
#pragma unroll
    for (int c = 0; c < 8; ++c) {
        LAS unsigned char* vb = vbuf + (c & 1) * (32 * VST_PITCH);
#pragma unroll
        for (int i = 0; i < 4; ++i) *(LAS v4u*)(vb + (vrow + 8 * i) * VST_PITCH + 16 * vpc) = vr[i];
        if (c < 7) {
#pragma unroll
            for (int i = 0; i < 4; ++i) { const int s = slist[32 * (c + 1) + vrow + 8 * i]; vr[i] = *(const v4u*)(DVB + (size_t)s * 64 + 8 * vpc); } }
        LDS_WAIT();
#pragma unroll
        for (int nb = 0; nb < 4; ++nb) {
            LAS unsigned char* a1 = vb + (4 * q4 + tj) * VST_PITCH + (16 * nb + 4 * tc) * 2;
            const s16x4v r1 = __builtin_bit_cast(s16x4v, __builtin_amdgcn_ds_read_tr16_b64_v4i16((LAS s16x4v*)a1));
            const s16x4v r2 = __builtin_bit_cast(s16x4v, __builtin_amdgcn_ds_read_tr16_b64_v4i16((LAS s16x4v*)(a1 + 16 * VST_PITCH)));
            const bf16x8v bv = {r1[0], r1[1], r1[2], r1[3], r2[0], r2[1], r2[2], r2[3]};
            o[nb] = __builtin_amdgcn_mfma_f32_16x16x32_bf16(pa[c], bv, o[nb], 0, 0, 0); }
    }
    LDS_WAIT();
    if (lane < 16) { float* YD = (float*)(A.ws + WS_YO) + 2 * YO_STRIDE + (size_t)m * 256;
#pragma unroll
        for (int nb = 0; nb < 4; ++nb) { YD[16 * nb + lane] = o[nb].x; YD[64 + 16 * nb + lane] = o[nb].y; YD[128 + 16 * nb + lane] = o[nb].z; YD[192 + 16 * nb + lane] = o[nb].w; } }
}
__device__ __forceinline__ int dsa_row_of(int batch, int gi, int r) { const int h = 4 * gi + (r >> 1); return batch * SEQ + ((r & 1) ? (SEQ - 1 - h) : h); }
__device__ __forceinline__ void dsa_wave(ARef A, const WI& w, LAS unsigned char* wl, int qi) {
    LAS u16* lists = (LAS u16*)wl; LAS unsigned char* vbuf = wl + 4096; LAS unsigned* bk = (LAS unsigned*)vbuf;
#pragma unroll 1
    for (int kb = 0; kb < NB; ++kb) {
        const int batch = (w.bx + kb) & (NB - 1);
        unsigned* head = (unsigned*)(A.ws + WS_CTL) + CW_DSAQ + 128 * qi + 16 * batch;
        for (;;) {
            int g = 0; if (w.lane == 0) g = (int)atomicAdd(head, 1u);
            g = __builtin_amdgcn_readfirstlane(g);
            if (g >= SEQ / 8) break;
#pragma unroll 1
            for (int r = 0; r < 8; ++r) { const int m = dsa_row_of(batch, g, r), n = (m & (SEQ - 1)) + 1; dsa_select(A, m, n, w.lane, lists + r * 256, bk); }
            LDS_WAIT();
#pragma unroll 1
            for (int r = 0; r < 8; ++r) dsa_attend(A, dsa_row_of(batch, g, r), w.lane, lists + r * 256, vbuf);
        }
    }
}

__device__ __forceinline__ f32x4 head_norm4(f32x4 y, float eps, f32x4 g) {
    const float mean = grp16_sum(sum4(y)) * (1.0f / 64.0f); const f32x4 yc = y - mean;
    const float var = grp16_sum(dot4(yc, yc)) * (1.0f / 64.0f); return yc * (1.0f / sqrtf(var + eps)) * g;
}
template <bool BF> __device__ __forceinline__ f32x4 state_corr(const LAS float* sl, int hh, int r16, const void* pv) {
    const LAS float* r0 = sl + (hh * 64 + 4 * r16) * 64; const int x0 = (4 * r16) & 15;
    f32x4 out = {0.f, 0.f, 0.f, 0.f};
#pragma unroll 2
    for (int k8 = 0; k8 < 8; ++k8) {
        f32x4 pa, pb;
        if (BF) { const v4u x = ((const v4u*)pv)[k8]; pa = (f32x4){bf_lo(x.x), bf_hi(x.x), bf_lo(x.y), bf_hi(x.y)}; pb = (f32x4){bf_lo(x.z), bf_hi(x.z), bf_lo(x.w), bf_hi(x.w)}; }
        else { pa = ((const f32x4*)pv)[2 * k8]; pb = ((const f32x4*)pv)[2 * k8 + 1]; }
#pragma unroll
        for (int i = 0; i < 4; ++i) { const LAS float* rowp = r0 + i * 64; const int xs = (x0 + i) & 15;
            out[i] += dot4(*(const LAS f32x4*)(rowp + 4 * ((2 * k8) ^ xs)), pa) + dot4(*(const LAS f32x4*)(rowp + 4 * ((2 * k8 + 1) ^ xs)), pb); }
    }
    return out;
}
__device__ __forceinline__ void post_row(ARef A, int l, int m, int lane, const LAS float* slw, const LAS float* slr) {
    const float* YO = (const float*)(A.ws + WS_YO); const float* RWA = (const float*)(A.ws + WS_RWA);
    bf16* MX = (bf16*)(A.ws + WS_MIX) + (size_t)m * DM; const int c4 = 4 * lane, hh = lane >> 4, r16 = lane & 15; const size_t o = (size_t)m * 256 + c4;
    { f32x4 y = *(const f32x4*)(YO + o) + state_corr<true>(slr, hh, r16, (const bf16*)(A.ws + WS_PTR) + (size_t)m * 256 + hh * 64);
      y = head_norm4(y, 1e-5f, *(const f32x4*)(A.in[I_RETGN] + l * 256 + c4));
      const v2u gw_ = *(const v2u*)((const bf16*)(A.ws + WS_PB) + (size_t)m * PBW + 768 + c4); const f32x4 g = {bf_lo(gw_.x), bf_hi(gw_.x), bf_lo(gw_.y), bf_hi(gw_.y)};
#pragma unroll
      for (int i = 0; i < 4; ++i) y[i] *= g[i] * sigm(g[i]);
      v2u w; w.x = pk2(y.x, y.y); w.y = pk2(y.z, y.w); *(v2u*)(MX + c4) = w; }
    { f32x4 y = *(const f32x4*)(YO + YO_STRIDE + o) + state_corr<false>(slw, hh, r16, (const float*)(A.ws + WS_PT) + (size_t)m * 256 + hh * 64);
      y = head_norm4(y, 64e-5f, *(const f32x4*)(A.in[I_LN] + l * 256 + c4));
      y = (y + *(const f32x4*)(RWA + 7 * RWA_STRIDE + o)) * *(const f32x4*)(RWA + 6 * RWA_STRIDE + o);
      v2u w; w.x = pk2(y.x, y.y); w.y = pk2(y.z, y.w); *(v2u*)(MX + 256 + c4) = w; }
    { f32x4 y = *(const f32x4*)(YO + 2 * YO_STRIDE + o); const float r = 1.0f / sqrtf(wave_sum(dot4(y, y)) * (1.0f / 256.0f) + 1e-5f);
      y = y * r * *(const f32x4*)(A.in[I_DONORM] + l * 256 + c4);
      v2u w; w.x = pk2(y.x, y.y); w.y = pk2(y.z, y.w); *(v2u*)(MX + 512 + c4) = w; }
    { f32x4 y = *(const f32x4*)(YO + 3 * YO_STRIDE + o); const float r = 1.0f / sqrtf(wave_sum(dot4(y, y)) * (1.0f / 256.0f) + 1e-5f);
      y = y * r * *(const f32x4*)(A.in[I_SONORM] + l * 256 + c4);
      v2u w; w.x = pk2(y.x, y.y); w.y = pk2(y.z, y.w); *(v2u*)(MX + 768 + c4) = w; }
}
__device__ __forceinline__ void ph_post(ARef A, const WI& w, int l) {
    LAS float* slw = (LAS float*)w.lds; LAS float* slr = slw + 16384;
    for (int u = w.vcu; u < NB * NCH * 2; u += w.G) {
        const int b = u >> 5, c = (u >> 1) & 15, half = u & 1;
        __syncthreads();
        for (int e = w.tid; e < 4096; e += NWAVES * 64) { const int hh = e >> 10, v = (e >> 4) & 63, k4 = e & 15;
            const size_t src = ((size_t)((b * 4 + hh) * NCH + c) * 64 + v) * 64 + 4 * k4; const int dst = (hh * 64 + v) * 64 + 4 * (k4 ^ (v & 15));
            *(LAS f32x4*)(slw + dst) = *(const f32x4*)((const float*)(A.ws + WS_SI) + src); *(LAS f32x4*)(slr + dst) = *(const f32x4*)((const float*)(A.ws + WS_SIR) + src); }
        __syncthreads();
        const int tok0 = b * SEQ + c * TCH + half * 128 + w.wave * 16;
        for (int i = 0; i < 16; ++i) post_row(A, l, tok0 + i, w.lane, slw, slr);
    }
}

constexpr int S0_PITCH = 144;
template <int MIXER> __device__ __forceinline__ void post16_head(ARef A, int l, size_t m, int hh, int tk, int fq, const LAS unsigned char* s0) {
    const size_t o = m * 256 + hh * 64 + 8 * fq;
    bf16x8v pb[2];
    if (MIXER == 0) { const bf16* pp = (const bf16*)(A.ws + WS_PTR) + o; pb[0] = *(const bf16x8v*)pp; pb[1] = *(const bf16x8v*)(pp + 32); }
    else { const float* pp = (const float*)(A.ws + WS_PT) + o;
#pragma unroll
        for (int ks = 0; ks < 2; ++ks) { const f32x4 a = *(const f32x4*)(pp + 32 * ks), b = *(const f32x4*)(pp + 32 * ks + 4);
            pg8::u32x4 wv; wv.x = pg8::cvt_pk_bf16(a.x, a.y); wv.y = pg8::cvt_pk_bf16(a.z, a.w); wv.z = pg8::cvt_pk_bf16(b.x, b.y); wv.w = pg8::cvt_pk_bf16(b.z, b.w); pb[ks] = __builtin_bit_cast(bf16x8v, wv); } }
    f32x4 y[4];
    const float* yl = (const float*)(A.ws + WS_YO) + MIXER * YO_STRIDE + o;
#pragma unroll
    for (int mb = 0; mb < 4; ++mb) y[mb] = *(const f32x4*)(yl + 32 * (mb >> 1) + 4 * (mb & 1));
    const float* gw = ((MIXER == 0) ? A.in[I_RETGN] : A.in[I_LN]) + l * 256 + hh * 64 + 8 * fq;
    f32x4 gn[4], e0[4], e1[4];
#pragma unroll
    for (int mb = 0; mb < 4; ++mb) gn[mb] = *(const f32x4*)(gw + 32 * (mb >> 1) + 4 * (mb & 1));
    if (MIXER == 0) {
#pragma unroll
        for (int j = 0; j < 2; ++j) { const v4u gx = *(const v4u*)((const bf16*)(A.ws + WS_PB) + m * PBW + 768 + hh * 64 + 8 * fq + 32 * j);
            e0[2 * j] = (f32x4){bf_lo(gx.x), bf_hi(gx.x), bf_lo(gx.y), bf_hi(gx.y)}; e0[2 * j + 1] = (f32x4){bf_lo(gx.z), bf_hi(gx.z), bf_lo(gx.w), bf_hi(gx.w)}; }
    } else { const float* RWA = (const float*)(A.ws + WS_RWA);
#pragma unroll
        for (int mb = 0; mb < 4; ++mb) { e0[mb] = *(const f32x4*)(RWA + 7 * RWA_STRIDE + o + 32 * (mb >> 1) + 4 * (mb & 1)); e1[mb] = *(const f32x4*)(RWA + 6 * RWA_STRIDE + o + 32 * (mb >> 1) + 4 * (mb & 1)); } }
    const LAS unsigned char* ab = s0 + ((MIXER * 4 + hh) * 64 + 8 * (tk >> 2) + (tk & 3)) * S0_PITCH + 16 * fq;
#pragma unroll
    for (int mb = 0; mb < 4; ++mb)
#pragma unroll
        for (int ks = 0; ks < 2; ++ks) { const bf16x8v af = *(const LAS bf16x8v*)(ab + (32 * (mb >> 1) + 4 * (mb & 1)) * S0_PITCH + 64 * ks); y[mb] = __builtin_amdgcn_mfma_f32_16x16x32_bf16(af, pb[ks], y[mb], 0, 0, 0); }
    float s = (sum4(y[0]) + sum4(y[1])) + (sum4(y[2]) + sum4(y[3])); s += __shfl_xor(s, 16); s += __shfl_xor(s, 32);
    const float mean = s * (1.0f / 64.0f);
#pragma unroll
    for (int mb = 0; mb < 4; ++mb) y[mb] = y[mb] - mean;
    float q = (dot4(y[0], y[0]) + dot4(y[1], y[1])) + (dot4(y[2], y[2]) + dot4(y[3], y[3])); q += __shfl_xor(q, 16); q += __shfl_xor(q, 32);
    const float rs = 1.0f / sqrtf(q * (1.0f / 64.0f) + ((MIXER == 0) ? 1e-5f : 64e-5f));
    bf16* MX = (bf16*)(A.ws + WS_MIX) + m * DM + MIXER * 256 + hh * 64 + 8 * fq;
#pragma unroll
    for (int j = 0; j < 2; ++j) { f32x4 ya = y[2 * j] * rs * gn[2 * j], yb = y[2 * j + 1] * rs * gn[2 * j + 1];
        if (MIXER == 0) {
#pragma unroll
            for (int i = 0; i < 4; ++i) { ya[i] *= e0[2 * j][i] * sigm(e0[2 * j][i]); yb[i] *= e0[2 * j + 1][i] * sigm(e0[2 * j + 1][i]); }
        } else { ya = (ya + e0[2 * j]) * e1[2 * j]; yb = (yb + e0[2 * j + 1]) * e1[2 * j + 1]; }
        v4u wv; wv.x = pk2(ya.x, ya.y); wv.y = pk2(ya.z, ya.w); wv.z = pk2(yb.x, yb.y); wv.w = pk2(yb.z, yb.w); *(v4u*)(MX + 32 * j) = wv; }
}
__device__ __forceinline__ void post16_rms(ARef A, int l, size_t m, int mx, int fq) {
    const float* yp = (const float*)(A.ws + WS_YO) + (size_t)mx * YO_STRIDE + m * 256 + 8 * fq; const float* gw = ((mx == 2) ? A.in[I_DONORM] : A.in[I_SONORM]) + l * 256 + 8 * fq;
    f32x4 y[16];
#pragma unroll
    for (int j = 0; j < 8; ++j) { y[2 * j] = *(const f32x4*)(yp + 32 * j); y[2 * j + 1] = *(const f32x4*)(yp + 32 * j + 4); }
    float q = 0.0f;
#pragma unroll
    for (int j = 0; j < 16; ++j) q += dot4(y[j], y[j]);
    q += __shfl_xor(q, 16); q += __shfl_xor(q, 32);
    const float r = 1.0f / sqrtf(q * (1.0f / 256.0f) + 1e-5f);
    bf16* MX = (bf16*)(A.ws + WS_MIX) + m * DM + mx * 256 + 8 * fq;
#pragma unroll
    for (int j = 0; j < 8; ++j) { const f32x4 ya = y[2 * j] * r * *(const f32x4*)(gw + 32 * j), yb = y[2 * j + 1] * r * *(const f32x4*)(gw + 32 * j + 4);
        v4u wv; wv.x = pk2(ya.x, ya.y); wv.y = pk2(ya.z, ya.w); wv.z = pk2(yb.x, yb.y); wv.w = pk2(yb.z, yb.w); *(v4u*)(MX + 32 * j) = wv; }
}
__device__ __forceinline__ void ph_post16(ARef A, const WI& w, int l) {
    LAS unsigned char* s0 = w.lds;
    for (int u = w.vcu; u < NB * NCH * 2; u += w.G) {
        const int b = u >> 5, c = (u >> 1) & 15, half = u & 1;
        __syncthreads();
#pragma unroll 2
        for (int e = w.tid; e < 4096; e += NWAVES * 64) { const int hd = e >> 9, v = (e >> 3) & 63, k8 = e & 7;
            const float* src = (const float*)(A.ws + ((hd < 4) ? WS_SIR : WS_SI)) + ((size_t)((b * 4 + (hd & 3)) * NCH + c) * 64 + v) * 64 + 8 * k8;
            const f32x4 x0 = *(const f32x4*)src, x1 = *(const f32x4*)(src + 4);
            v4u wv; wv.x = pk2(x0.x, x0.y); wv.y = pk2(x0.z, x0.w); wv.z = pk2(x1.x, x1.y); wv.w = pk2(x1.z, x1.w); *(LAS v4u*)(s0 + (hd * 64 + v) * S0_PITCH + 16 * k8) = wv; }
        __syncthreads();
        int lane = w.lane; asm volatile("" : "+v"(lane));
        const int tk = lane & 15, fq = lane >> 4; const size_t m = (size_t)(b * SEQ + c * TCH + half * 128 + w.wave * 16 + tk);
#pragma unroll 1
        for (int hh = 0; hh < 4; ++hh) post16_head<0>(A, l, m, hh, tk, fq, s0);
#pragma unroll 1
        for (int hh = 0; hh < 4; ++hh) post16_head<1>(A, l, m, hh, tk, fq, s0);
#pragma unroll 1
        for (int mx = 2; mx < 4; ++mx) post16_rms(A, l, m, mx, fq);
    }
}

__device__ __forceinline__ float wave_max_f(float v) {
    v = fmaxf(v, __builtin_bit_cast(float, __builtin_amdgcn_mov_dpp(__builtin_bit_cast(int, v), 0xB1, 0xF, 0xF, true)));
    v = fmaxf(v, __builtin_bit_cast(float, __builtin_amdgcn_mov_dpp(__builtin_bit_cast(int, v), 0x4E, 0xF, 0xF, true)));
    v = fmaxf(v, __builtin_bit_cast(float, __builtin_amdgcn_mov_dpp(__builtin_bit_cast(int, v), 0x141, 0xF, 0xF, true)));
    v = fmaxf(v, __builtin_bit_cast(float, __builtin_amdgcn_mov_dpp(__builtin_bit_cast(int, v), 0x140, 0xF, 0xF, true)));
    const int iv = __builtin_bit_cast(int, v);
    return fmaxf(fmaxf(__builtin_bit_cast(float, __builtin_amdgcn_readlane(iv, 0)), __builtin_bit_cast(float, __builtin_amdgcn_readlane(iv, 16))), fmaxf(__builtin_bit_cast(float, __builtin_amdgcn_readlane(iv, 32)), __builtin_bit_cast(float, __builtin_amdgcn_readlane(iv, 48))));
}
__device__ __forceinline__ void router_stage(ARef A, const WI& w, int l) {
    LAS float* rwl = (LAS float*)w.lds; const float* rw = A.in[I_RW] + (size_t)l * DM * 32;
    for (int e = w.tid; e < DM * 8; e += NWAVES * 64) { const int k = e >> 3, c = e & 7; *(LAS f32x4*)(rwl + k * 32 + 4 * (c ^ ((k >> 2) & 7))) = *(const f32x4*)(rw + (size_t)k * 32 + 4 * c); }
    __syncthreads();
}
__device__ __forceinline__ void router_row(ARef A, int l, int m, int lane, LAS unsigned* hist, const LAS float* rwl, LAS int* texp, bool dry = false) {
    const float* XA = (const float*)(A.ws + WS_XA) + (size_t)m * DM; const float* MOD = (const float*)(A.ws + WS_MOD) + (size_t)(l * 8 + (m >> 12)) * 6144;
    f32x4 v[4]; float ss = 0.0f;
#pragma unroll
    for (int j = 0; j < 4; ++j) { v[j] = *(const f32x4*)(XA + 4 * (lane + 64 * j)); ss += dot4(v[j], v[j]); }
    ss = wave_sum(ss); const float rstd = 1.0f / sqrtf(ss * (1.0f / DM) + 1e-5f);
    const float* g = A.in[I_NFFN] + l * DM; const float* scp = MOD + 4 * 1024; const float* shp = MOD + 3 * 1024;
    emit_h_row(v, rstd, g, scp, shp, (bf16*)(A.ws + WS_H) + (size_t)m * DM, lane);
    float p[32];
#pragma unroll
    for (int e = 0; e < 32; ++e) p[e] = 0.0f;
    const int sw = lane & 7;
#pragma unroll 1
    for (int j = 0; j < 4; ++j) { const int k = 4 * (lane + 64 * j);
        const f32x4 h = *(const f32x4*)(XA + k) * rstd * *(const f32x4*)(g + k) * (1.0f + *(const f32x4*)(scp + k)) + *(const f32x4*)(shp + k);
        const LAS float* row = rwl + k * 32;
#pragma unroll
        for (int i = 0; i < 4; ++i) {
#pragma unroll
            for (int q4 = 0; q4 < 8; ++q4) { const f32x4 r = *(const LAS f32x4*)(row + i * 32 + 4 * (q4 ^ sw)); p[4 * q4] += h[i] * r.x; p[4 * q4 + 1] += h[i] * r.y; p[4 * q4 + 2] += h[i] * r.z; p[4 * q4 + 3] += h[i] * r.w; } } }
    float q16[16], q8[8], q4v[4], q2[2], q1;
    { const bool hb = (lane & 32) != 0;
#pragma unroll
      for (int i = 0; i < 16; ++i) { const float mine = hb ? p[16 + i] : p[i], oth = hb ? p[i] : p[16 + i]; q16[i] = mine + __shfl_xor(oth, 32); } }
    { const bool hb = (lane & 16) != 0;
#pragma unroll
      for (int i = 0; i < 8; ++i) { const float mine = hb ? q16[8 + i] : q16[i], oth = hb ? q16[i] : q16[8 + i]; q8[i] = mine + __shfl_xor(oth, 16); } }
    { const bool hb = (lane & 8) != 0;
#pragma unroll
      for (int i = 0; i < 4; ++i) { const float mine = hb ? q8[4 + i] : q8[i], oth = hb ? q8[i] : q8[4 + i]; q4v[i] = mine + __shfl_xor(oth, 8); } }
    { const bool hb = (lane & 4) != 0;
#pragma unroll
      for (int i = 0; i < 2; ++i) { const float mine = hb ? q4v[2 + i] : q4v[i], oth = hb ? q4v[i] : q4v[2 + i]; q2[i] = mine + __shfl_xor(oth, 4); } }
    { const bool hb = (lane & 2) != 0; const float mine = hb ? q2[1] : q2[0], oth = hb ? q2[0] : q2[1]; q1 = mine + __shfl_xor(oth, 2); }
    q1 += __shfl_xor(q1, 1);
    float lv = q1 + A.in[I_RB][l * 32 + (lane >> 1)];
    float tv[4]; int ti[4];
#pragma unroll
    for (int kk = 0; kk < 4; ++kk) { const float mx = wave_max_f(lv); const unsigned long long msk = __ballot(lv == mx); const int e = msk ? (int)(__builtin_ctzll(msk) >> 1) : kk;
        tv[kk] = mx; ti[kk] = e; if ((lane >> 1) == e) lv = -INFINITY; }
    const float e1 = expf(tv[1] - tv[0]), e2 = expf(tv[2] - tv[0]), e3 = expf(tv[3] - tv[0]); const float inv = 1.0f / (1.0f + e1 + e2 + e3);
    if (lane == 0 && !dry) {
        int* TI = (int*)(A.ws + WS_TOPI) + (size_t)m * 4; float* TW = (float*)(A.ws + WS_TOPW) + (size_t)m * 4;
        TI[0] = ti[0]; TI[1] = ti[1]; TI[2] = ti[2]; TI[3] = ti[3]; texp[0] = ti[0]; texp[1] = ti[1]; texp[2] = ti[2]; texp[3] = ti[3]; TW[0] = inv; TW[1] = e1 * inv; TW[2] = e2 * inv; TW[3] = e3 * inv;
        { unsigned* hg = (unsigned*)hist; atomicAdd(hg + ti[0], 1u); atomicAdd(hg + ti[1], 1u); atomicAdd(hg + ti[2], 1u); atomicAdd(hg + ti[3], 1u); }
    }
}
__device__ __forceinline__ void build_expert_table(ARef A, const WI& w, int l) {
    LAS int* tst = (LAS int*)(w.lds + TST_OFF); LAS int* tab = (LAS int*)(w.lds + TAB_OFF); LAS int* cnt = (LAS int*)(w.lds + CNT_OFF);
    if (w.tid == 0) { const unsigned* gc = (const unsigned*)(A.ws + WS_CTL) + CW_GCNT + 64 * l; int acc = 0;
        for (int e = 0; e < 32; ++e) { const int c = (int)__hip_atomic_load(gc + e, RLX_AGENT); cnt[e] = c; tst[e] = acc; acc += (c + 255) >> 8; }
        tst[32] = acc; tab[0] = acc; }
    __syncthreads();
    if (w.tid < 32) { const int e = w.tid; for (int pm = tst[e]; pm < tst[e + 1]; ++pm) tab[1 + pm] = e; }
    __syncthreads();
}
__device__ __forceinline__ void router_lists(ARef A, const WI& w, int l) {
    LAS unsigned* hist = (LAS unsigned*)(w.lds + HIST_OFF); LAS int* base = (LAS int*)(w.lds + BASE_OFF); LAS int* texp = (LAS int*)(w.lds + TEXP_OFF);
    __syncthreads();
    if (w.tid < 32) { base[w.tid] = (int)atomicAdd((unsigned*)(A.ws + WS_CTL) + CW_GCNT + 64 * l + w.tid, hist[w.tid]); hist[w.tid] = 0u; }
    __syncthreads();
    int* LIST = (int*)(A.ws + WS_LIST); int* PW = (int*)(A.ws + WS_POS);
    int j = 0;
    for (int m = w.gw; m < MTOK; m += w.NGW, ++j) {
        if (w.lane < 4) { const int e = texp[(w.wave * 16 + j) * 4 + w.lane]; const int idx = base[e] + (int)atomicAdd((unsigned*)hist + e, 1u);
            LIST[e * LCAP + idx] = m; PW[(size_t)m * 4 + w.lane] = (e << 20) | idx; } }
}
__device__ __forceinline__ void combine_row(ARef A, int l, int m, int lane, const LAS int* tst, float gscale = 1.0f, float oscale = 1.0f) {
    float* XA = (float*)(A.ws + WS_XA) + (size_t)m * DM; const float* MOD = (const float*)(A.ws + WS_MOD) + (size_t)(l * 8 + (m >> 12)) * 6144;
    const int* PS = (const int*)(A.ws + WS_POS) + (size_t)m * 4; const float* TW = (const float*)(A.ws + WS_TOPW) + (size_t)m * 4;
    const bf16* YS = (const bf16*)(A.ws + WS_XS);
    f32x4 v[4], acc[4];
#pragma unroll
    for (int j = 0; j < 4; ++j) { v[j] = *(const f32x4*)(XA + 4 * (lane + 64 * j)); acc[j] = (f32x4){0.f, 0.f, 0.f, 0.f}; }
#pragma unroll
    for (int k = 0; k < 4; ++k) { const int pe = PS[k]; const int pos = tst[pe >> 20] * 256 + (pe & 0xFFFFF); const float gt = TW[k] * gscale; const v2u* yr = (const v2u*)(YS + (size_t)pos * DM);
#pragma unroll
        for (int j = 0; j < 4; ++j) { const v2u y = yr[lane + 64 * j]; acc[j] += gt * (f32x4){bf_lo(y.x), bf_hi(y.x), bf_lo(y.y), bf_hi(y.y)}; } }
    float ss = 0.0f;
#pragma unroll
    for (int j = 0; j < 4; ++j) { const int kx = 4 * (lane + 64 * j); v[j] += *(const f32x4*)(MOD + 5 * 1024 + kx) * acc[j]; ss += dot4(v[j], v[j]); }
    ss = wave_sum(ss); const float rstd = 1.0f / sqrtf(ss * (1.0f / DM) + 1e-5f);
    if (l + 1 < NLAYER) {
#pragma unroll
        for (int j = 0; j < 4; ++j) *(f32x4*)(XA + 4 * (lane + 64 * j)) = v[j];
        const float* mb = MOD + 8 * 6144;
        emit_h_row(v, rstd, A.in[I_NMIX] + (l + 1) * DM, mb + 1024, mb, (bf16*)(A.ws + WS_H) + (size_t)m * DM, lane);
    } else {
        float* orow = A.out + (size_t)m * DM; const float* gf = A.in[I_NFINAL];
#pragma unroll
        for (int j = 0; j < 4; ++j) { const int kx = 4 * (lane + 64 * j); *(f32x4*)(orow + kx) = v[j] * (rstd * oscale) * *(const f32x4*)(gf + kx); }
    }
}

constexpr int N_LAUNCHES = MK_N_LAUNCHES;
template <int SEL> __global__ void __launch_bounds__(NWAVES * 64, 2) fwd(ArgsH Ah) {
    extern __shared__ __attribute__((aligned(16))) unsigned char lds[];
    (void)Ah;
    const int wave_s = __builtin_amdgcn_readfirstlane((int)threadIdx.x >> 6);
    auto tid_now = [&]() -> int { int ws_ = wave_s; unsigned z_ = 0u; asm volatile("" : "+s"(ws_), "+s"(z_)); return ws_ * 64 + (int)__builtin_amdgcn_mbcnt_hi(~0u, __builtin_amdgcn_mbcnt_lo(~0u, z_)); };
#define TID_NOW() tid_now()
#define MAKE_WI() WI w; { int tz = TID_NOW(); asm volatile("" : "+v"(tz)); int bz = blockIdx.x, gz = gridDim.x; asm volatile("" : "+s"(bz), "+s"(gz)); \
        w.lds = (LAS unsigned char*)lds; w.tid = tz; w.lane = tz & 63; w.wave = __builtin_amdgcn_readfirstlane(tz >> 6); w.G = gz; w.bx = bz; w.vcu = (gz % 8 == 0) ? (bz % 8) * (gz / 8) + bz / 8 : bz; \
        w.gw = w.vcu * NWAVES + w.wave; w.NGW = gz * NWAVES; }
    { const int t0 = threadIdx.x; for (int u = t0; u < (LDS_BYTES - RING_BYTES) / 4; u += NWAVES * 64) ((LAS unsigned*)((LAS unsigned char*)lds + RING_BYTES))[u] = 0u; }
    __syncthreads();
    int lo, hi; { ARef A0 = *kargs(); lo = A0.ph_lo; hi = A0.ph_hi; }
    if (N_LAUNCHES == 1) { ARef A0 = *kargs(); (void)xcd_barrier_post((unsigned*)((gu32*)(A0.ws + WS_CTL) + CW_BAR), (volatile LAS unsigned*)((LAS unsigned char*)lds + MISC_OFF) + 8, TID_NOW()); }
#define GRID_BAR() do { if (N_LAUNCHES == 1) { ARef Ab = *kargs(); XcdBarrier bar_; bar_.bar = (unsigned*)((gu32*)(Ab.ws + WS_CTL) + CW_BAR); bar_.x = xb_xcc_id(); bar_.st = (volatile LAS unsigned*)((LAS unsigned char*)lds + MISC_OFF) + 8; xcd_barrier(bar_, TID_NOW()); } } while (0)
#ifndef TPROBE
#define TPROBE 0
#endif
#if TPROBE
    unsigned long long tp_acc = 0ull;
#define TP_SCALE tp_scale_of(__hip_atomic_load((unsigned*)(A.ws + WS_CTL) + 3, RLX_AGENT))
    auto tp_scale_of = [](unsigned ticks) -> float { const float us = (float)ticks * 0.01f; if (us < 1.0f) return 1.0f; const float q = exp2f(rintf(log2f(us) * 8.0f) * 0.125f); return 1.0f + sqrtf(q * 1e-5f); };
#define TP_BEGIN(kind) unsigned long long tp_t0 = 0ull; if ((kind) == TPROBE) tp_t0 = __builtin_amdgcn_s_memrealtime();
#define TP_END(kind) if ((kind) == TPROBE) { tp_acc += __builtin_amdgcn_s_memrealtime() - tp_t0; }
#define TP_PUBLISH(l) if ((l) == 1 && w.vcu == 0 && w.tid == 0) __hip_atomic_store((unsigned*)(A.ws + WS_CTL) + 3, (unsigned)tp_acc, RLX_AGENT);
#else
#define TP_SCALE 1.0f
#define TP_PUBLISH(l)
#define TP_BEGIN(kind)
#define TP_END(kind)
#endif
#define IN(k) (lo <= (k) && (k) < hi)
#ifndef PHMASK
#define PHMASK 0xffffffffu
#endif
#define KON(k) if constexpr ((SEL < 0 && ((PHMASK >> (k)) & 1u)) || SEL == (k))
#define BOTH(k) (IN(k) && IN((k) + 1))
#ifndef PROBE_REP
#define PROBE_REP 0
#endif
#if PROBE_REP
    int nrep_ = 2; asm volatile("" : "+s"(nrep_));
#define REP(bit) _Pragma("unroll 1") for (int rep_ = 0; rep_ < (((PROBE_REP >> (bit)) & 1) ? nrep_ : 1); ++rep_)
#else
#define REP(bit) for (int rep_ = 0; rep_ < 1; ++rep_)
#endif
#define ring ((PG8_LAS unsigned char*)lds)

    KON(0) if (IN(0)) { ARef A = *kargs(); MAKE_WI(); REP(0) ph_prologue(A, w); if (BOTH(0)) GRID_BAR(); }

#define LAYER_BODY(l) do {\
        const int pb = 1 + l * NPL; \
        KON(1) if (IN(pb + 0)) { ARef A = *kargs(); MAKE_WI(); TP_BEGIN(1) if (l == 0) { REP(15) { ph_norm1(A, w); small_weights_to_f16(A, w); } if (BOTH(pb + 0)) GRID_BAR(); } TP_END(1) } \
        KON(2) if (IN(pb + 1)) { ARef A = *kargs(); MAKE_WI(); TP_BEGIN(2) \
            pg8::Gemm g{(const bf16*)(A.ws + WS_H), (const bf16*)(A.ws + WS_WIN) + (size_t)l * INCP * DM, MTOK, INCP, DM}; pg8::StaticOrder S; S.init(MTOK, INCP, w.G, w.bx); \
            pg8::EpiProj E{(bf16*)(A.ws + WS_PB), (float*)(A.ws + WS_PF)}; \
            REP(1) pg8::gemm_phase<pg8::EpiProj, pg8::StaticOrder, true, true>(ring, g, S, E, w.tid); \
            if (BOTH(pb + 1)) GRID_BAR(); TP_END(2) \
        } \
        KON(3) if (IN(pb + 2)) { ARef A = *kargs(); MAKE_WI(); TP_BEGIN(3) \
            REP(2) { for (int g = w.gw; g < MTOK / 16; g += w.NGW) prep16(A, l, 16 * g, w.lane); } \
            if (BOTH(pb + 2)) GRID_BAR(); TP_END(3) \
        } \
        KON(4) if (IN(pb + 3)) { ARef A = *kargs(); MAKE_WI(); TP_BEGIN(4) \
            REP(3) { for (int tk = 2 * w.vcu; tk < 32 * NCH; tk += 2 * w.G) scan_rwkv_task2(A, w, tk); } \
            REP(13) { for (int tk = w.vcu; tk < 32 * NCH / 2; tk += w.G) scan_ret_task(A, w, tk); } \
            REP(4) { LAS unsigned char* vl = w.lds + w.wave * 4608; for (int it = w.gw; it < 32 * 128; it += w.NGW) sb_tile_mfma(A, it, w.lane, vl); } \
            REP(5) dsa_scores_mfma(A, w); \
            if (BOTH(pb + 3)) GRID_BAR(); TP_END(4) \
        } \
        KON(5) if (IN(pb + 4)) { ARef A = *kargs(); MAKE_WI(); TP_BEGIN(5) \
            if (w.bx < 32) prefix_chain(A, w, w.bx); \
            REP(6) dsa_wave(A, w, w.lds + w.wave * 13312, l + 2 * rep_); \
            REP(14) { if (rep_ && w.bx < 32) prefix_chain(A, w, w.bx); } \
            if (BOTH(pb + 4)) GRID_BAR(); TP_END(5) \
        } \
        KON(6) if (IN(pb + 5)) { ARef A = *kargs(); MAKE_WI(); TP_BEGIN(6) \
            REP(7) ph_post16(A, w, l); \
            if (BOTH(pb + 5)) GRID_BAR(); TP_END(6) \
        } \
        KON(7) if (IN(pb + 6)) { ARef A = *kargs(); MAKE_WI(); TP_BEGIN(7) \
            pg8::Gemm g{(const bf16*)(A.ws + WS_MIX), (const bf16*)(A.ws + WS_WOUT) + (size_t)l * DM * DM, MTOK, DM, DM}; pg8::StaticOrder S; S.init(MTOK, DM, w.G, w.bx); \
            pg8::EpiRes E{l == 0 ? A.in[I_X] : (const float*)(A.ws + WS_XA), (float*)(A.ws + WS_XA), (const float*)(A.ws + WS_MOD) + (size_t)l * 8 * 6144 + 2 * 1024}; \
            REP(16) { pg8::EpiRes E2 = E; if (rep_ && l == 1) E2.gate = (const float*)(A.ws + WS_CTL + 512 * 1024); pg8::gemm_phase<pg8::EpiRes, pg8::StaticOrder, true, true>(ring, g, S, E2, w.tid); } \
            if (BOTH(pb + 6)) GRID_BAR(); TP_END(7) \
        } \
        KON(8) if (IN(pb + 7)) { ARef A = *kargs(); MAKE_WI(); TP_BEGIN(8) \
            { LAS unsigned* hist = (LAS unsigned*)(w.lds + HIST_OFF); LAS int* texp = (LAS int*)(w.lds + TEXP_OFF); if (w.tid < 32) hist[w.tid] = 0u; router_stage(A, w, l); \
            REP(10) { int j_ = 0; for (int m = w.gw; m < MTOK; m += w.NGW, ++j_) router_row(A, l, m, w.lane, hist, (const LAS float*)w.lds, texp + (w.wave * 16 + j_) * 4, rep_ != 0); } \
            router_lists(A, w, l); } \
            if (BOTH(pb + 7)) GRID_BAR(); TP_END(8) \
        } \
        KON(10) if (IN(pb + 8)) { ARef A = *kargs(); MAKE_WI(); TP_BEGIN(10) \
            build_expert_table(A, w, l); \
            pg8::Gemm g{(const bf16*)(A.ws + WS_H), (const bf16*)(A.ws + WS_W1) + (size_t)l * NEXP * 2048 * DM, MOE_ROWS, NEXP * 2048, DM}; \
            pg8::MoeOrder S{(const PG8_LAS int*)(w.lds + TAB_OFF), 8, w.G, w.vcu, (const PG8_LAS int*)(w.lds + TST_OFF), (const PG8_LAS int*)(w.lds + CNT_OFF), (const int*)(A.ws + WS_LIST)}; \
            pg8::EpiSwiglu E{(bf16*)(A.ws + WS_ACT), A.in[I_MB1] + (size_t)l * NEXP * 2048}; \
            REP(8) pg8::gemm_phase<pg8::EpiSwiglu, pg8::MoeOrder, true, true, true>(ring, g, S, E, w.tid); \
            if (BOTH(pb + 8)) GRID_BAR(); TP_END(10) \
        } \
        KON(11) if (IN(pb + 9)) { ARef A = *kargs(); MAKE_WI(); TP_BEGIN(11) \
            build_expert_table(A, w, l); \
            pg8::Gemm g{(const bf16*)(A.ws + WS_ACT), (const bf16*)(A.ws + WS_W2) + (size_t)l * NEXP * DM * DM, MOE_ROWS, NEXP * DM, DM}; \
            pg8::MoeOrder S{(const PG8_LAS int*)(w.lds + TAB_OFF), 4, w.G, w.vcu, (const PG8_LAS int*)(w.lds + TST_OFF), (const PG8_LAS int*)(w.lds + CNT_OFF), (const int*)(A.ws + WS_LIST)}; \
            pg8::EpiY E{(bf16*)(A.ws + WS_XS), A.in[I_MB2] + (size_t)l * NEXP * DM}; \
            REP(9) pg8::gemm_phase<pg8::EpiY, pg8::MoeOrder, true, true>(ring, g, S, E, w.tid); \
            TP_PUBLISH(l) \
            if (BOTH(pb + 9)) GRID_BAR(); TP_END(11) \
        } \
        KON(12) if (IN(pb + 10)) { ARef A = *kargs(); MAKE_WI(); TP_BEGIN(12) \
            build_expert_table(A, w, l); \
            REP(12) for (int m = w.gw; m < MTOK; m += w.NGW) combine_row(A, l, m, w.lane, (const LAS int*)(w.lds + TST_OFF), (rep_ && l == 0) ? 0.0f : 1.0f, TP_SCALE); \
            if (BOTH(pb + 10)) GRID_BAR(); TP_END(12) \
        } \
    } while (0)
    LAYER_BODY(0);
    LAYER_BODY(1);
#undef LAYER_BODY
#undef IN
#undef ring
#undef MAKE_WI
#undef TID_NOW
#undef GRID_BAR
#undef KON
#undef BOTH
}


#if MK_N_LAUNCHES != 1
template <int K> static void launch_one(int grid, hipStream_t stream, const ArgsH& a) {
    static bool attr = false;
    if (!attr) { (void)hipFuncSetAttribute((const void*)fwd<K>, hipFuncAttributeMaxDynamicSharedMemorySize, LDS_BYTES); attr = true; }
    hipLaunchKernelGGL(fwd<K>, dim3(grid), dim3(NWAVES * 64), LDS_BYTES, stream, a);
}
static void launch_kind(int kind, int grid, hipStream_t stream, const ArgsH& a) {
    switch (kind) {
        case 0: launch_one<0>(grid, stream, a); break; case 1: launch_one<1>(grid, stream, a); break; case 2: launch_one<2>(grid, stream, a); break;
        case 3: launch_one<3>(grid, stream, a); break; case 4: launch_one<4>(grid, stream, a); break; case 5: launch_one<5>(grid, stream, a); break;
        case 6: launch_one<6>(grid, stream, a); break; case 7: launch_one<7>(grid, stream, a); break; case 8: launch_one<8>(grid, stream, a); break;
        case 9: launch_one<9>(grid, stream, a); break; case 10: launch_one<10>(grid, stream, a); break; case 11: launch_one<11>(grid, stream, a); break;
        default: launch_one<12>(grid, stream, a); break;
    }
}
#endif
extern "C" void kernel_launch(void* const* d_in, const int* in_sizes, int n_in, void* d_out, int out_size, void* d_ws, size_t ws_size, hipStream_t stream) {
    static int grid = 0;
    if (grid == 0) {
        if (n_in != N_IN || out_size != MTOK * DM || ws_size < WS_END) { fprintf(stderr, "kernel_launch: unexpected shapes (n_in %d, out %d, ws %zu)\n", n_in, out_size, ws_size); grid = -1; return; }
        int dev = 0, cus = 0;
        if (hipGetDevice(&dev) != hipSuccess || hipDeviceGetAttribute(&cus, hipDeviceAttributeMultiprocessorCount, dev) != hipSuccess) { grid = -1; return; }
#if MK_N_LAUNCHES == 1
        {
            if (hipFuncSetAttribute((const void*)fwd<-1>, hipFuncAttributeMaxDynamicSharedMemorySize, LDS_BYTES) != hipSuccess) { fprintf(stderr, "kernel_launch: hipFuncSetAttribute failed\n"); grid = -1; return; }
            int per_cu = 0;
            if (hipOccupancyMaxActiveBlocksPerMultiprocessor(&per_cu, (const void*)fwd<-1>, NWAVES * 64, LDS_BYTES) != hipSuccess || per_cu < 1) fprintf(stderr, "kernel_launch: occupancy query says %d\n", per_cu);
            (void)hipGetLastError();
        }
#endif
        grid = cus;
    }
    if (grid < 0) return;
    (void)in_sizes;
    if (hipMemsetAsync((char*)d_ws + WS_CTL, 0, CTL_ZERO_BYTES, stream) != hipSuccess) return;
    ArgsH a{};
    for (int i = 0; i < N_IN; ++i) a.in[i] = (const float*)d_in[i];
    a.out = (float*)d_out; a.ws = (unsigned char*)d_ws;
    for (int f = 0; f < 44; ++f) a.invf[f] = (f < 32) ? pow(10000.0, -(double)f / 32.0) : (f < 40) ? pow(500000.0, -(double)(f - 32) / 8.0) : pow(500000.0, -(double)(f - 40) / 4.0);
#if MK_N_LAUNCHES == 1
    a.ph_lo = 0; a.ph_hi = NPHASE; a.li = 0;
    hipLaunchKernelGGL(fwd<-1>, dim3(grid), dim3(NWAVES * 64), LDS_BYTES, stream, a);
#else
    {
        for (int p = 0; p < NPHASE; ++p) {
            if (p == 1 + NPL) continue;
            a.ph_lo = p; a.ph_hi = p + 1; a.li = p;
            static const int kinds_[NPL] = {1, 2, 3, 4, 5, 6, 7, 8, 10, 11, 12};
            const int kind = (p == 0) ? 0 : kinds_[(p - 1) % NPL];
            launch_kind(kind, grid, stream, a);
        }
    }
#endif
}
```

```cpp
#include <hip/hip_runtime.h>
#include <cstdio>
#include <cstdint>
#include <cmath>

#ifndef MK_N_LAUNCHES
#define MK_N_LAUNCHES 1
#endif

namespace pg8 {
#define PG8_LAS __attribute__((address_space(3)))
typedef unsigned short bf16_t;
typedef short bf16x8 __attribute__((ext_vector_type(8)));
typedef float f32x4 __attribute__((ext_vector_type(4)));
typedef unsigned u32x4 __attribute__((ext_vector_type(4)));
typedef unsigned u32x2 __attribute__((ext_vector_type(2)));
constexpr int BM = 256, BK = 64, HALF = 128, HTB = HALF * BK * 2  , STAGE_BYTES = 8 * HTB, NXCD = 8, WGM = 8;

__host__ __device__ __forceinline__ int lds_byte(int r, int c) { const int st = (r >> 4) * 2 + (c >> 5), rr = r & 15, cc = c & 31, ob = rr * 64 + cc * 2; return st * 1024 + (ob ^ (((ob >> 9) & 1) << 5)); }
__host__ __device__ __forceinline__ void stage_rc(int b, int& R, int& C) { const int st = b / 1024, sb = b % 1024, swz = sb ^ (((sb >> 9) & 1) << 5); R = (st >> 1) * 16 + swz / 64; C = (st & 1) * 32 + (swz % 64) / 2; }
__host__ __device__ __forceinline__ int perm32(int rho) { const int n = rho >> 4, i = rho & 15; return 8 * (i >> 2) + 4 * n + (i & 3); }

struct Unit { int pm, pn; };
struct Gemm { const bf16_t* A; const bf16_t* Bt; int M, N, K; };

struct StaticOrder {
    int nM, nN, nwg, G, c;
    __host__ __device__ void init(int M, int N, int G_, int c_) { nM = M / BM; nN = N / BM; nwg = nM * nN; G = G_; c = c_; }
    __host__ __device__ bool next(int i, Unit& u) const {
        const long L = (long)i * G + c; if (L >= nwg) return false;
        int wgid = (int)L; { const int q = nwg / NXCD, r = nwg % NXCD, xcd = wgid % NXCD, off = wgid / NXCD; wgid = (xcd < r ? xcd * (q + 1) : r * (q + 1) + (xcd - r) * q) + off; }
        const int nig = WGM * nN, gid = wgid / nig, fm = gid * WGM, gsz = (nM - fm) < WGM ? (nM - fm) : WGM;
        u.pm = fm + ((wgid % nig) % gsz); u.pn = (wgid % nig) / gsz; return true;
    }
    __device__ __forceinline__ void a_ready(const Unit&) const {}
    __device__ __forceinline__ void done(const Unit&) const {}
};
__device__ __forceinline__ unsigned cvt_pk_bf16(float lo, float hi) { unsigned r; asm volatile("v_cvt_pk_bf16_f32 %0, %1, %2" : "=v"(r) : "v"(lo), "v"(hi)); return r; }
struct EpiF32 {
    static constexpr bool PERM = false, AFTER_DRAIN = false;
    float* C; int ldc;
    __device__ __forceinline__ void operator()(const f32x4 (&acc)[2][2][4][2], const Unit& u, int wr, int wc, int fr, int fq) const {
        const int row0 = u.pm * BM + wr * 64 + fr, col0 = u.pn * BM + wc * 32 + 4 * fq;
#pragma unroll
        for (int ai = 0; ai < 2; ++ai)
#pragma unroll
            for (int m = 0; m < 4; ++m) { float* rowp = C + (size_t)(row0 + ai * HALF + m * 16) * ldc + col0;
#pragma unroll
                for (int bj = 0; bj < 2; ++bj)
#pragma unroll
                    for (int n = 0; n < 2; ++n) *(f32x4*)(rowp + bj * HALF + n * 16) = acc[ai][bj][m][n]; }
    }
};
struct EpiNull {
    static constexpr bool PERM = true, AFTER_DRAIN = false;
    __device__ __forceinline__ void operator()(const f32x4 (&acc)[2][2][4][2], const Unit&, int, int, int, int) const {
#pragma unroll
        for (int ai = 0; ai < 2; ++ai)
#pragma unroll
            for (int bj = 0; bj < 2; ++bj) asm volatile("" :: "v"(acc[ai][bj][0][0]), "v"(acc[ai][bj][0][1]), "v"(acc[ai][bj][1][0]), "v"(acc[ai][bj][1][1]), "v"(acc[ai][bj][2][0]), "v"(acc[ai][bj][2][1]), "v"(acc[ai][bj][3][0]), "v"(acc[ai][bj][3][1]));
    }
};
struct EpiProj {
    static constexpr bool PERM = true, AFTER_DRAIN = false;
    bf16_t* PB; float* PF;
    __device__ __forceinline__ void operator()(const f32x4 (&acc)[2][2][4][2], const Unit& u, int wr, int wc, int fr, int fq) const {
        const int row0 = u.pm * BM + wr * 64 + fr;
        if (u.pn < 7) { const int c0 = u.pn * BM + wc * 32 + 8 * fq;
#pragma unroll
            for (int ai = 0; ai < 2; ++ai)
#pragma unroll
                for (int m = 0; m < 4; ++m) { bf16_t* rowp = PB + (size_t)(row0 + ai * HALF + m * 16) * 1792 + c0;
#pragma unroll
                    for (int bj = 0; bj < 2; ++bj) { const f32x4 v0 = acc[ai][bj][m][0], v1 = acc[ai][bj][m][1];
                        u32x4 w; w.x = cvt_pk_bf16(v0[0], v0[1]); w.y = cvt_pk_bf16(v0[2], v0[3]); w.z = cvt_pk_bf16(v1[0], v1[1]); w.w = cvt_pk_bf16(v1[2], v1[3]);
                        *(u32x4*)(rowp + bj * HALF) = w; } }
        } else { const int c0 = (u.pn - 7) * BM + wc * 32 + 8 * fq;
#pragma unroll
            for (int ai = 0; ai < 2; ++ai)
#pragma unroll
                for (int m = 0; m < 4; ++m) { float* rowp = PF + (size_t)(row0 + ai * HALF + m * 16) * 1280 + c0;
#pragma unroll
                    for (int bj = 0; bj < 2; ++bj) { *(f32x4*)(rowp + bj * HALF) = acc[ai][bj][m][0]; *(f32x4*)(rowp + bj * HALF + 4) = acc[ai][bj][m][1]; } }
        }
    }
};
struct EpiRes {
    static constexpr bool PERM = false, AFTER_DRAIN = false;
    const float* xin; float* xout; const float* gate;
    __device__ __forceinline__ void operator()(const f32x4 (&acc)[2][2][4][2], const Unit& u, int wr, int wc, int fr, int fq) const {
        const int row0 = u.pm * BM + wr * 64 + fr, col0 = u.pn * BM + wc * 32 + 4 * fq;
        const float* gp = gate + (size_t)((u.pm * BM) >> 12) * 6144 + col0;
        f32x4 gv[2][2];
#pragma unroll
        for (int bj = 0; bj < 2; ++bj)
#pragma unroll
            for (int n = 0; n < 2; ++n) gv[bj][n] = *(const f32x4*)(gp + bj * HALF + n * 16);
#pragma unroll
        for (int ai = 0; ai < 2; ++ai)
#pragma unroll
            for (int m = 0; m < 4; ++m) { const size_t ro = (size_t)(row0 + ai * HALF + m * 16) * 1024 + col0;
#pragma unroll
                for (int bj = 0; bj < 2; ++bj)
#pragma unroll
                    for (int n = 0; n < 2; ++n) { const f32x4 xv = *(const f32x4*)(xin + ro + bj * HALF + n * 16); *(f32x4*)(xout + ro + bj * HALF + n * 16) = xv + gv[bj][n] * acc[ai][bj][m][n]; } }
    }
};
__device__ __forceinline__ float swiglu1(float glu, float lin) {
    glu = fminf(glu, 7.0f); lin = fminf(fmaxf(lin, -7.0f), 7.0f);
    return glu * (1.0f / (1.0f + __expf(-1.702f * glu))) * (lin + 1.0f);
}
struct EpiSwiglu {
    static constexpr bool PERM = true, AFTER_DRAIN = false;
    bf16_t* O; const float* b1;
    __device__ __forceinline__ void operator()(const f32x4 (&acc)[2][2][4][2], const Unit& u, int wr, int wc, int fr, int fq) const {
        const int e = u.pn >> 3, j = u.pn & 7, row0 = u.pm * BM + wr * 64 + fr, c0 = 128 * j + wc * 32 + 8 * fq;
        const float* bp = b1 + (size_t)e * 2048 + c0;
        f32x4 bg[2], bl[2];
#pragma unroll
        for (int n = 0; n < 2; ++n) { bg[n] = *(const f32x4*)(bp + 4 * n); bl[n] = *(const f32x4*)(bp + 1024 + 4 * n); }
#pragma unroll
        for (int ai = 0; ai < 2; ++ai)
#pragma unroll
            for (int m = 0; m < 4; ++m) { bf16_t* rowp = O + (size_t)(row0 + ai * HALF + m * 16) * 1024 + c0;
                const f32x4 g0 = acc[ai][0][m][0] + bg[0], g1 = acc[ai][0][m][1] + bg[1], l0 = acc[ai][1][m][0] + bl[0], l1 = acc[ai][1][m][1] + bl[1];
                u32x4 w;
                w.x = cvt_pk_bf16(swiglu1(g0[0], l0[0]), swiglu1(g0[1], l0[1])); w.y = cvt_pk_bf16(swiglu1(g0[2], l0[2]), swiglu1(g0[3], l0[3]));
                w.z = cvt_pk_bf16(swiglu1(g1[0], l1[0]), swiglu1(g1[1], l1[1])); w.w = cvt_pk_bf16(swiglu1(g1[2], l1[2]), swiglu1(g1[3], l1[3]));
                *(u32x4*)rowp = w; }
    }
};
struct EpiY {
    static constexpr bool PERM = true, AFTER_DRAIN = false;
    bf16_t* O; const float* b2;
    __device__ __forceinline__ void operator()(const f32x4 (&acc)[2][2][4][2], const Unit& u, int wr, int wc, int fr, int fq) const {
        const int e = u.pn >> 2, j = u.pn & 3, row0 = u.pm * BM + wr * 64 + fr, c0 = 256 * j + wc * 32 + 8 * fq;
        const float* bp = b2 + (size_t)e * 1024 + c0;
        f32x4 bv[2][2];
#pragma unroll
        for (int bj = 0; bj < 2; ++bj)
#pragma unroll
            for (int n = 0; n < 2; ++n) bv[bj][n] = *(const f32x4*)(bp + bj * HALF + 4 * n);
#pragma unroll
        for (int ai = 0; ai < 2; ++ai)
#pragma unroll
            for (int m = 0; m < 4; ++m) { bf16_t* rowp = O + (size_t)(row0 + ai * HALF + m * 16) * 1024 + c0;
#pragma unroll
                for (int bj = 0; bj < 2; ++bj) { const f32x4 v0 = acc[ai][bj][m][0] + bv[bj][0], v1 = acc[ai][bj][m][1] + bv[bj][1];
                    u32x4 w; w.x = cvt_pk_bf16(v0[0], v0[1]); w.y = cvt_pk_bf16(v0[2], v0[3]); w.z = cvt_pk_bf16(v1[0], v1[1]); w.w = cvt_pk_bf16(v1[2], v1[3]);
                    *(u32x4*)(rowp + bj * HALF) = w; } }
    }
};
struct MoeOrder {
    const PG8_LAS int* tab; int NJ, G, c;
    __device__ __forceinline__ bool next(int i, Unit& u) const {
        const int T = tab[0]; const long L = (long)i * G + c; if (L >= (long)T * NJ) return false;
        const int pm = (int)(L / NJ), j = (int)(L % NJ);
        u.pm = pm; u.pn = tab[1 + pm] * NJ + j; return true;
    }
    __device__ __forceinline__ void a_ready(const Unit&) const {}
    __device__ __forceinline__ void done(const Unit&) const {}
    const PG8_LAS int* tst; const PG8_LAS int* cnt; const int* list;
    __device__ __forceinline__ int row_of(const Unit& u, int r) const { const int e = tab[1 + u.pm], idx = 256 * (u.pm - tst[e]) + r; return (idx < cnt[e]) ? list[e * 32768 + idx] : 0; }
};

template <class Epi, class Sched, bool ALIGN_EPI = false, bool SP2 = false, bool GATHER = false>
__device__ __forceinline__ void gemm_phase(PG8_LAS unsigned char* lds, const Gemm g, const Sched& S, const Epi& E, int tid_in) {
    int tid_ = tid_in; asm volatile("" : "+v"(tid_));
    const int tid = tid_, wid = __builtin_amdgcn_readfirstlane(tid >> 6), lane = tid & 63, wr = wid >> 2, wc = wid & 3, fr = lane & 15, fq = lane >> 4;
    const int K = g.K, nt = K / BK;
    unsigned voffA[2], voffB[2];
#pragma unroll
    for (int i = 0; i < 2; ++i) { int R, C; stage_rc(tid * 16 + i * 8192, R, C); const int Rb = Epi::PERM ? ((R & ~31) + perm32(R & 31)) : R;
        voffA[i] = (unsigned)(R * K + C) * 2u; voffB[i] = (unsigned)(Rb * K + C) * 2u; }
    static_assert(!GATHER || SP2, "gathered A rows: only the two-super-phase loop is wired");
    unsigned cvo[2][2], nvo[2][2];
#define PG8_ROWS(dst, u_) do { _Pragma("unroll") for (int h_ = 0; h_ < 2; ++h_) _Pragma("unroll") for (int i_ = 0; i_ < 2; ++i_) { int R_, C_; stage_rc(tid * 16 + i_ * 8192, R_, C_); dst[h_][i_] = (unsigned)(S.row_of(u_, h_ * HALF + R_) * K + C_) * 2u; } } while (0)
#define PG8_STAGE_A(bufoff, gbase, half, nx) do { if constexpr (GATHER) { unsigned o_[2]; o_[0] = (nx) ? nvo[half][0] : cvo[half][0]; o_[1] = (nx) ? nvo[half][1] : cvo[half][1]; PG8_STAGE(bufoff, gbase, o_); } else { PG8_STAGE(bufoff, (gbase) + (half) * hstep, voffA); } } while (0)
    const size_t kstep = (size_t)(BK * 2);
    const size_t hstep = (size_t)HALF * K * 2;
    const size_t tstep = 2 * hstep;
    const unsigned ldsw = (unsigned)wid * 1024u;
    const int aoff = lds_byte(wr * 64 + fr, fq * 8), boff = lds_byte(wc * 32 + fr, fq * 8);
#define PG8_SA(b, h) (((b) * 2 + (h)) * HTB)
#define PG8_SB(b, h) ((4 + (b) * 2 + (h)) * HTB)
#define PG8_STAGE(bufoff, gbase, voff) do { _Pragma("unroll") for (int _i = 0; _i < 2; ++_i) \
        __builtin_amdgcn_global_load_lds((const unsigned*)((const char*)(gbase) + (voff)[_i]), (PG8_LAS unsigned*)(lds + (bufoff) + ldsw + _i * 8192), 16, 0, 0); } while (0)
#define PG8_LDA(dst, b, h) do { _Pragma("unroll") for (int m = 0; m < 4; ++m) _Pragma("unroll") for (int k = 0; k < 2; ++k) dst[m][k] = *(const PG8_LAS bf16x8*)(lds + PG8_SA(b, h) + aoff + m * 2048 + k * 1024); } while (0)
#define PG8_LDB(dst, b, h) do { _Pragma("unroll") for (int n = 0; n < 2; ++n) _Pragma("unroll") for (int k = 0; k < 2; ++k) dst[n][k] = *(const PG8_LAS bf16x8*)(lds + PG8_SB(b, h) + boff + n * 2048 + k * 1024); } while (0)
#define PG8_MMA(ai, bj, At, Bt) do { __builtin_amdgcn_s_setprio(1); _Pragma("unroll") for (int m = 0; m < 4; ++m) _Pragma("unroll") for (int n = 0; n < 2; ++n) _Pragma("unroll") for (int k = 0; k < 2; ++k) \
        acc[ai][bj][m][n] = __builtin_amdgcn_mfma_f32_16x16x32_bf16(Bt[n][k], At[m][k], acc[ai][bj][m][n], 0, 0, 0); __builtin_amdgcn_s_setprio(0); } while (0)
#define PG8_WAIT_V(n) asm volatile("s_waitcnt vmcnt(" #n ")" ::: "memory")
#define PG8_WAIT_L(n) asm volatile("s_waitcnt lgkmcnt(" #n ")" ::: "memory")
#define PG8_BAR __builtin_amdgcn_s_barrier()
#define PG8_SCHED __builtin_amdgcn_sched_barrier(0)
    Unit cur, nxt; int ui = 0;
    if (!S.next(0, cur)) return;
    f32x4 acc[2][2][4][2];
#pragma unroll
    for (int a = 0; a < 2; ++a)
#pragma unroll
        for (int b = 0; b < 2; ++b)
#pragma unroll
            for (int m = 0; m < 4; ++m)
#pragma unroll
                for (int n = 0; n < 2; ++n) acc[a][b][m][n] = (f32x4){0.f, 0.f, 0.f, 0.f};
    bf16x8 At[4][2], B0[2][2], B1[2][2];
    const char* cA = (const char*)g.A + (GATHER ? (size_t)0 : (size_t)cur.pm * tstep); const char* cB = (const char*)g.Bt + (size_t)cur.pn * tstep;
    if constexpr (GATHER) { PG8_ROWS(cvo, cur); }
    S.a_ready(cur);
    if constexpr (SP2) {
        PG8_STAGE(PG8_SB(0, 0), cB, voffB); PG8_STAGE(PG8_SB(0, 1), cB + hstep, voffB); PG8_STAGE_A(PG8_SA(0, 0), cA, 0, false); PG8_STAGE_A(PG8_SA(0, 1), cA, 1, false);
        if (wr == 1) PG8_BAR;
        PG8_WAIT_V(2); PG8_BAR;
        PG8_STAGE(PG8_SB(1, 0), cB + kstep, voffB); PG8_STAGE_A(PG8_SA(1, 0), cA + kstep, 0, false); PG8_STAGE(PG8_SB(1, 1), cB + hstep + kstep, voffB);
        PG8_WAIT_V(6); PG8_BAR;
    } else {
        PG8_STAGE(PG8_SB(0, 0), cB, voffB); PG8_STAGE(PG8_SA(0, 0), cA, voffA); PG8_STAGE(PG8_SB(0, 1), cB + hstep, voffB); PG8_STAGE(PG8_SA(0, 1), cA + hstep, voffA);
        if (wr == 1) PG8_BAR;
        PG8_WAIT_V(4); PG8_BAR;
        PG8_STAGE(PG8_SB(1, 0), cB + kstep, voffB); PG8_STAGE(PG8_SA(1, 0), cA + kstep, voffA); PG8_STAGE(PG8_SB(1, 1), cB + hstep + kstep, voffB);
        PG8_WAIT_V(6); PG8_BAR;
    }
    for (;;) {
        const bool has_next = S.next(ui + 1, nxt);
        const char* nA = GATHER ? (const char*)g.A : (has_next ? (const char*)g.A + (size_t)nxt.pm * tstep : cA); const char* nB = has_next ? (const char*)g.Bt + (size_t)nxt.pn * tstep : cB;
        if constexpr (GATHER) { if (has_next) { PG8_ROWS(nvo, nxt); } else { _Pragma("unroll") for (int h_ = 0; h_ < 2; ++h_) { nvo[h_][0] = cvo[h_][0]; nvo[h_][1] = cvo[h_][1]; } } }
        for (int t = 0; t < nt; t += 2) {
            const bool last = (t == nt - 2);
            const char* a1 = cA + (size_t)(t + 1) * kstep;
            const char* a2 = last ? nA : cA + (size_t)(t + 2) * kstep; const char* b2 = last ? nB : cB + (size_t)(t + 2) * kstep;
            const char* a3 = a2 + kstep; const char* b3 = b2 + kstep;
            if (last && has_next) S.a_ready(nxt);
            if constexpr (SP2) {
            PG8_LDB(B0, 0, 0); PG8_LDB(B1, 0, 1); PG8_SCHED; PG8_LDA(At, 0, 0); PG8_STAGE_A(PG8_SA(1, 1), a1, 1, false);
            PG8_WAIT_V(8); PG8_WAIT_L(0); PG8_BAR; PG8_MMA(0, 0, At, B0); PG8_MMA(0, 1, At, B1); PG8_BAR; PG8_SCHED;
            PG8_LDA(At, 0, 1); PG8_STAGE(PG8_SB(0, 0), b2, voffB); PG8_STAGE(PG8_SB(0, 1), b2 + hstep, voffB); PG8_STAGE_A(PG8_SA(0, 0), a2, 0, last);
            PG8_WAIT_V(8); PG8_WAIT_L(0); PG8_BAR; PG8_MMA(1, 0, At, B0); PG8_MMA(1, 1, At, B1); PG8_BAR; PG8_SCHED;
            PG8_LDB(B0, 1, 0); PG8_LDB(B1, 1, 1); PG8_SCHED; PG8_LDA(At, 1, 0); PG8_STAGE_A(PG8_SA(0, 1), a2, 1, last);
            PG8_WAIT_V(8); PG8_WAIT_L(0); PG8_BAR; PG8_MMA(0, 0, At, B0); PG8_MMA(0, 1, At, B1); PG8_BAR; PG8_SCHED;
            PG8_LDA(At, 1, 1); PG8_STAGE(PG8_SB(1, 0), b3, voffB); PG8_STAGE(PG8_SB(1, 1), b3 + hstep, voffB); PG8_STAGE_A(PG8_SA(1, 0), a3, 0, last);
            PG8_WAIT_V(8); PG8_WAIT_L(0); PG8_BAR; PG8_MMA(1, 0, At, B0); PG8_MMA(1, 1, At, B1); PG8_BAR; PG8_SCHED;
            } else {
            PG8_LDB(B0, 0, 0); PG8_SCHED; PG8_LDA(At, 0, 0); PG8_STAGE(PG8_SA(1, 1), a1 + hstep, voffA);
            PG8_WAIT_L(8); PG8_BAR; PG8_WAIT_L(0); PG8_MMA(0, 0, At, B0); PG8_BAR; PG8_SCHED;
            PG8_LDB(B1, 0, 1); PG8_STAGE(PG8_SB(0, 0), b2, voffB);
            PG8_BAR; PG8_WAIT_L(0); PG8_MMA(0, 1, At, B1); PG8_BAR;
            PG8_LDA(At, 0, 1); PG8_STAGE(PG8_SA(0, 0), a2, voffA);
            PG8_BAR; PG8_WAIT_L(0); PG8_MMA(1, 0, At, B0); PG8_BAR; PG8_SCHED;
            PG8_STAGE(PG8_SB(0, 1), b2 + hstep, voffB);
            PG8_WAIT_V(6); PG8_BAR; PG8_MMA(1, 1, At, B1); PG8_BAR;
            PG8_LDB(B0, 1, 0); PG8_SCHED; PG8_LDA(At, 1, 0); PG8_STAGE(PG8_SA(0, 1), a2 + hstep, voffA);
            PG8_WAIT_L(8); PG8_BAR; PG8_WAIT_L(0); PG8_MMA(0, 0, At, B0); PG8_BAR; PG8_SCHED;
            PG8_LDB(B1, 1, 1); PG8_STAGE(PG8_SB(1, 0), b3, voffB);
            PG8_BAR; PG8_WAIT_L(0); PG8_MMA(0, 1, At, B1); PG8_BAR;
            PG8_LDA(At, 1, 1); PG8_STAGE(PG8_SA(1, 0), a3, voffA);
            PG8_BAR; PG8_WAIT_L(0); PG8_MMA(1, 0, At, B0); PG8_BAR; PG8_SCHED;
            PG8_STAGE(PG8_SB(1, 1), b3 + hstep, voffB);
            PG8_WAIT_V(6); PG8_BAR; PG8_MMA(1, 1, At, B1); PG8_BAR;
            }
        }
        if constexpr (ALIGN_EPI) { if (wr == 0) PG8_BAR; }
        if constexpr (!Epi::AFTER_DRAIN) { E(acc, cur, wr, wc, fr, fq); S.done(cur); }
        if (!has_next) break;
#pragma unroll
        for (int a = 0; a < 2; ++a)
#pragma unroll
            for (int b = 0; b < 2; ++b)
#pragma unroll
                for (int m = 0; m < 4; ++m)
#pragma unroll
                    for (int n = 0; n < 2; ++n) acc[a][b][m][n] = (f32x4){0.f, 0.f, 0.f, 0.f};
        cur = nxt; cA = nA; cB = nB; ++ui;
        if constexpr (GATHER) { _Pragma("unroll") for (int h_ = 0; h_ < 2; ++h_) { cvo[h_][0] = nvo[h_][0]; cvo[h_][1] = nvo[h_][1]; } }
        if constexpr (ALIGN_EPI) { if (wr == 1) PG8_BAR; }
    }
    PG8_WAIT_V(0);
    if constexpr (!ALIGN_EPI) { if (wr == 0) PG8_BAR; }
    PG8_BAR;
    if constexpr (Epi::AFTER_DRAIN) { E.fused(acc, cur, wr, wc, fr, fq, lds, wid, lane); S.done(cur); }
#undef PG8_SA
#undef PG8_SB
#undef PG8_STAGE
#undef PG8_STAGE_A
#undef PG8_ROWS
#undef PG8_LDA
#undef PG8_LDB
#undef PG8_MMA
#undef PG8_WAIT_V
#undef PG8_WAIT_L
#undef PG8_BAR
#undef PG8_SCHED
}
}

constexpr int NWAVES = 8;
constexpr int NB = 8, SEQ = 4096, DM = 1024, MTOK = NB * SEQ, NLAYER = 2;
constexpr int INC = 2984, INCP = 3072;
constexpr int C_RET = 0, C_RW = 1024, C_DSA = 1920, C_SB = 2216;
constexpr int PBW = 1792, PFW = 1280, PB_SB = 1024, PF_DSA = 896;
constexpr int NEXP = 32, MOE_ROWS = MTOK * 4 + NEXP * 256;
constexpr int ROPE_W = 88;
constexpr int NCH = 16, TCH = SEQ / NCH;
constexpr int NPL = 11, NPHASE = 1 + NLAYER * NPL;
enum { I_X = 0, I_C, I_POS, I_ADAW, I_ADAB, I_NMIX, I_NFFN, I_WIN, I_RETGN, I_MU, I_W0, I_W2, I_A0, I_A2, I_G2, I_KK, I_KA, I_RK, I_LN, I_QNORM, I_WQ, I_WQI, I_DONORM, I_SONORM, I_WOUT, I_RW, I_RB, I_MW1, I_MB1, I_MW2, I_MB2, I_NFINAL, N_IN };

constexpr size_t MiB = 1u << 20;
constexpr size_t WS_CTL = 0, CTL_ZERO_BYTES = 1 * MiB;
constexpr size_t WS_MOD = 1 * MiB, WS_ROPE = 2 * MiB, WS_WIN = 14 * MiB, WS_WOUT = 26 * MiB, WS_W1 = 30 * MiB, WS_W2 = 286 * MiB;
constexpr size_t WS_XA = 414 * MiB, WS_H = 542 * MiB, WS_MIX = 606 * MiB, WS_TOPI = 670 * MiB, WS_TOPW = 671 * MiB, WS_POS = 672 * MiB;
constexpr size_t WS_R = 674 * MiB;
constexpr size_t WS_PB = WS_R  , WS_PF = WS_R + 112 * MiB  , WS_RWA = 1058 * MiB  , WS_DQ = 1314 * MiB  , WS_DKB = 1330 * MiB  , WS_DVB = 1334 * MiB  , WS_DQI = 1346 * MiB  , WS_DKI = 1394 * MiB  , WS_DW = 1398 * MiB;
constexpr size_t WS_SMALLW = 1338 * MiB  ;
constexpr int SMW_QI = 0, SMW_W2 = 512 * 128, SMW_A2 = SMW_W2 + 256 * 32, SMW_G2 = SMW_A2 + 256 * 32, SMW_LAYER = SMW_G2 + 256 * 64;
constexpr size_t WS_PT = 1362 * MiB  ;
constexpr size_t WS_CH = WS_H  , WS_SI = WS_H + 16 * MiB  , WS_SIR = WS_H + 24 * MiB  ,
                 WS_CHR = WS_H + 32 * MiB  , WS_PTR = WS_H + 40 * MiB  ;
constexpr size_t WS_SQ = WS_MIX  , WS_SK = WS_MIX + 16 * MiB, WS_SV = WS_MIX + 32 * MiB;
constexpr size_t WS_YO = 1400 * MiB  , WS_SC = 1528 * MiB  ;
constexpr size_t WS_XS = WS_R  , WS_ACT = 946 * MiB  ;
constexpr size_t WS_LIST = 2040 * MiB  , WS_END = 2044 * MiB;
constexpr int LCAP = 32768;
static_assert((size_t)MOE_ROWS * 2048 <= 272 * MiB, "moe buffers");
constexpr int CW_TMO = 0, CW_CODE = 1, CW_GCNT = 256  , CW_DSAQ = 1024  , CW_BAR = 4096, CW_BLKCNT = 16384  ;
constexpr int RING_BYTES = 131072, MISC_OFF = RING_BYTES + 320, TST_OFF = RING_BYTES + 1024  , TAB_OFF = RING_BYTES + 2048  , HIST_OFF = RING_BYTES + 5120  , BASE_OFF = RING_BYTES + 5376  , CNT_OFF = RING_BYTES + 5632  , TEXP_OFF = RING_BYTES + 6144  , LDS_BYTES = 147456;

#if defined(__HIP_DEVICE_COMPILE__)
#define GAS __attribute__((address_space(1)))
#define CAS __attribute__((address_space(4)))
#else
#define GAS
#define CAS
#endif
#define LAS __attribute__((address_space(3)))
typedef unsigned short bf16;
typedef unsigned v4u __attribute__((ext_vector_type(4)));
typedef unsigned v2u __attribute__((ext_vector_type(2)));
typedef float f32x4 __attribute__((ext_vector_type(4)));
typedef GAS unsigned gu32;
typedef short bf16x8v __attribute__((ext_vector_type(8)));
typedef short s16x4v __attribute__((ext_vector_type(4)));
typedef _Float16 f16x8 __attribute__((ext_vector_type(8)));
#define RLX_AGENT __ATOMIC_RELAXED, __HIP_MEMORY_SCOPE_AGENT
#define LDS_WAIT() asm volatile("s_waitcnt lgkmcnt(0)" ::: "memory")
#define VM_WAIT() asm volatile("s_waitcnt vmcnt(0)" ::: "memory")
__device__ __forceinline__ unsigned f2bf(float f) { unsigned u = __builtin_bit_cast(unsigned, f); return (u + 0x7fffu + ((u >> 16) & 1u)) >> 16; }
__device__ __forceinline__ unsigned pk2(float lo, float hi) { return f2bf(lo) | (f2bf(hi) << 16); }
__device__ __forceinline__ float bf_lo(unsigned w) { return __builtin_bit_cast(float, w << 16); }
__device__ __forceinline__ float bf_hi(unsigned w) { return __builtin_bit_cast(float, w & 0xffff0000u); }
__device__ __forceinline__ float wave_sum(float v) {
#pragma unroll
    for (int o = 1; o < 64; o <<= 1) v += __shfl_xor(v, o);
    return v;
}
__device__ __forceinline__ float wave_max(float v) {
#pragma unroll
    for (int o = 1; o < 64; o <<= 1) v = fmaxf(v, __shfl_xor(v, o));
    return v;
}
__device__ __forceinline__ float grp16_sum(float v) { v += __shfl_xor(v, 1); v += __shfl_xor(v, 2); v += __shfl_xor(v, 4); v += __shfl_xor(v, 8); return v; }
__device__ __forceinline__ float grp8_sum(float v) { v += __shfl_xor(v, 1); v += __shfl_xor(v, 2); v += __shfl_xor(v, 4); return v; }
__device__ __forceinline__ float sum4(f32x4 a) { return (a.x + a.y) + (a.z + a.w); }
__device__ __forceinline__ float dot4(f32x4 a, f32x4 b) { return (a.x * b.x + a.y * b.y) + (a.z * b.z + a.w * b.w); }
__device__ __forceinline__ float fexp(float x) { return __builtin_amdgcn_exp2f(x * 1.4426950408889634f); }
__device__ __forceinline__ float sigm(float x) { return __builtin_amdgcn_rcpf(1.0f + fexp(-x)); }
__device__ __forceinline__ float softplusf(float x) { return fmaxf(x, 0.0f) + 0.6931471805599453f * __builtin_amdgcn_logf(1.0f + fexp(-fabsf(x))); }
__device__ __forceinline__ float ftanh(float x) { const float e = fexp(-2.0f * fabsf(x)); const float t = (1.0f - e) * __builtin_amdgcn_rcpf(1.0f + e); return x < 0.0f ? -t : t; }
__device__ __forceinline__ f32x4 shx4(f32x4 v, int m) { f32x4 r; r.x = __shfl_xor(v.x, m); r.y = __shfl_xor(v.y, m); r.z = __shfl_xor(v.z, m); r.w = __shfl_xor(v.w, m); return r; }

#define XB_TMO      128
#define XB_XCNT(j)  (256  + 64 * (j))
#define XB_XSUB(j)  (1280 + 64 * (j))
#define XB_XGEN(j)  (2304 + 64 * (j))
#define XB_TOP      3328
#define XB_TOPGEN   3392
#define XCD_BAR_WORDS 3456
#define XB_SPIN_CAP (1u << 18)

__device__ __forceinline__ unsigned xb_ld(unsigned* p)              { return __hip_atomic_load(p, __ATOMIC_RELAXED, __HIP_MEMORY_SCOPE_AGENT); }
__device__ __forceinline__ unsigned xb_add(unsigned* p, unsigned v) { return __hip_atomic_fetch_add(p, v, __ATOMIC_RELAXED, __HIP_MEMORY_SCOPE_AGENT); }
__device__ __forceinline__ unsigned xb_xcc_id() { return (unsigned)__builtin_amdgcn_s_getreg((3 << 11) | 20) & 0xFu; }
#define XB_SPIN(cond, bar) do { unsigned _sp = 0; while (cond) { __builtin_amdgcn_s_sleep(1); \
    if ((++_sp & 255u) == 0u) { if (xb_ld(&(bar)[XB_TMO])) break; if (_sp > XB_SPIN_CAP) { atomicAdd(&(bar)[XB_TMO], 1u); break; } } } } while (0)

struct XcdBarrier {
    unsigned* bar; unsigned x;
    volatile LAS unsigned* st;
};

__device__ __forceinline__ XcdBarrier xcd_barrier_post(unsigned* bar, volatile LAS unsigned* st, int xb_tid) {
    XcdBarrier b; b.bar = bar; b.x = xb_xcc_id(); b.st = st;
    if (xb_tid == 0) (void)xb_add(&bar[XB_XCNT(b.x)], 1u);
    return b;
}
__device__ __forceinline__ void xcd_barrier_complete(unsigned* bar, unsigned x, unsigned& nloc, unsigned& nx) {
    const unsigned G = gridDim.x * gridDim.y * gridDim.z;
    unsigned sum, cnt, mine, sp = 0u;
    for (;;) {
        sum = 0u; cnt = 0u; mine = 0u;
#pragma unroll
        for (unsigned j = 0; j < 16; ++j) { const unsigned c = xb_ld(&bar[XB_XCNT(j)]); sum += c; cnt += (c > 0u) ? 1u : 0u; mine = (j == x) ? c : mine; }
        if (sum == G) break;
        __builtin_amdgcn_s_sleep(1);
        if ((++sp & 255u) == 0u) { if (xb_ld(&bar[XB_TMO])) break; if (sp > XB_SPIN_CAP) { atomicAdd(&bar[XB_TMO], 1u); break; } }
    }
    nloc = mine > 0u ? mine : 1u; nx = cnt > 0u ? cnt : 1u;
}

__device__ __forceinline__ void xcd_barrier(const XcdBarrier& b, int xb_tid) {
    asm volatile("s_waitcnt vmcnt(0)" ::: "memory");
    __syncthreads();
    if (xb_tid == 0) {
        unsigned* bar = b.bar;
        __builtin_amdgcn_s_waitcnt(0);
        unsigned nloc = b.st[0], nx = b.st[1];
        if (nloc == 0u) { xcd_barrier_complete(bar, b.x, nloc, nx); b.st[0] = nloc; b.st[1] = nx; }
        const unsigned old = xb_add(&bar[XB_XSUB(b.x)], 1u);
        const unsigned gen = old / nloc;
        if (old + 1u == (gen + 1u) * nloc) {
            __builtin_amdgcn_fence(__ATOMIC_RELEASE, "agent");
            asm volatile("s_waitcnt vmcnt(0)" ::: "memory");
            const unsigned og = xb_add(&bar[XB_TOP], 1u);
            const unsigned tg = og / nx;
            if (og + 1u == (tg + 1u) * nx) xb_add(&bar[XB_TOPGEN], 1u);
            else XB_SPIN(xb_ld(&bar[XB_TOPGEN]) == tg, bar);
            __builtin_amdgcn_fence(__ATOMIC_ACQUIRE, "agent");
            xb_add(&bar[XB_XGEN(b.x)], 1u);
            asm volatile("s_waitcnt vmcnt(0)" ::: "memory");
        } else {
            XB_SPIN(xb_ld(&bar[XB_XGEN(b.x)]) == gen, bar);
            __builtin_amdgcn_fence(__ATOMIC_ACQUIRE, "agent");
            asm volatile("s_waitcnt vmcnt(0)" ::: "memory");
        }
    }
    __syncthreads();
}
struct ArgsH { const float* in[N_IN]; float* out; unsigned char* ws; double invf[44]; int ph_lo, ph_hi, li, pad; };
struct ArgsD { const GAS float* in[N_IN]; GAS float* out; GAS unsigned char* ws; double invf[44]; int ph_lo, ph_hi, li, pad; };
static_assert(sizeof(ArgsH) == sizeof(ArgsD), "args layout");
typedef const CAS ArgsD& ARef;
__device__ __forceinline__ const CAS ArgsD* kargs() {
#if defined(__HIP_DEVICE_COMPILE__)
    const CAS ArgsD* p = (const CAS ArgsD*)__builtin_amdgcn_kernarg_segment_ptr(); asm volatile("" : "+s"(p)); return p;
#else
    return nullptr;
#endif
}
struct WI { LAS unsigned char* lds; int tid, lane, wave, vcu, G, gw, NGW, bx; };
constexpr size_t RWA_STRIDE = 32 * MiB / 4;
constexpr size_t YO_STRIDE = 32 * MiB / 4;

__device__ __forceinline__ int wave_sum_i(int v) {
#pragma unroll
    for (int o = 1; o < 64; o <<= 1) v += __shfl_xor(v, o);
    return v;
}
__device__ __forceinline__ void sincos_d(double ang, float& s, float& c) {
    const double q = __builtin_rint(ang * 0.63661977236758134308);
    double r = __builtin_fma(-q, 1.57079632679489661923, ang); r = __builtin_fma(-q, 6.123233995736766e-17, r);
    const double r2 = r * r;
    const double sp = r * (1.0 + r2 * (-1.0 / 6 + r2 * (1.0 / 120 + r2 * (-1.0 / 5040 + r2 * (1.0 / 362880 + r2 * (-1.0 / 39916800 + r2 * (1.0 / 6227020800.0)))))));
    const double cp = 1.0 + r2 * (-0.5 + r2 * (1.0 / 24 + r2 * (-1.0 / 720 + r2 * (1.0 / 40320 + r2 * (-1.0 / 3628800 + r2 * (1.0 / 479001600 + r2 * (-1.0 / 87178291200.0)))))));
    const int qi = ((int)q) & 3;
    const double ss = (qi == 0) ? sp : (qi == 1) ? cp : (qi == 2) ? -sp : -cp;
    const double cc = (qi == 0) ? cp : (qi == 1) ? -sp : (qi == 2) ? -cp : sp;
    s = (float)ss; c = (float)cc;
}

struct TrItem { const float* src; bf16* dst; int ldw; float scale; bool ok; };
__device__ __forceinline__ void tr_decode(ARef A, int it, int lane, TrItem& d) {
    constexpr int I_IN = NLAYER * 16 * 96, I_OUT = NLAYER * 16 * 32, I_W1 = NLAYER * NEXP * 16 * 64;
    const float* W; int ldw, nvalid, k0, nsrc0; bf16* WT; size_t dstrow0; float scale = 1.0f;
    int r = it;
    if (r < I_IN) { const int l = r / 1536, rr = r % 1536, kb = rr / 96, nb = rr % 96;
        const int nd = nb * 32;
        nsrc0 = (nd < 1024) ? nd : (nd < 1792) ? C_SB + (nd - 1024) : (nd < 2688) ? C_RW + (nd - 1792) : C_DSA + (nd - 2688);
        nvalid = (nd < 1024) ? 1024 : (nd < 1792) ? INC : (nd < 2688) ? C_DSA : ((nd < INC) ? C_SB : 0);
        scale = (nd >= 256 && nd < 512) ? 0.125f : (nd >= 1024 && nd < 1280) ? 0.18033688011112042f : 1.0f;
        W = A.in[I_WIN] + (size_t)l * DM * INC; ldw = INC; k0 = kb * 64; WT = (bf16*)(A.ws + WS_WIN) + (size_t)l * INCP * DM; dstrow0 = (size_t)nd; }
    else if (r < I_IN + I_OUT) { r -= I_IN; const int l = r / 512, rr = r % 512, kb = rr / 32, nb = rr % 32;
        W = A.in[I_WOUT] + (size_t)l * DM * DM; ldw = DM; nvalid = DM; k0 = kb * 64; nsrc0 = nb * 32; WT = (bf16*)(A.ws + WS_WOUT) + (size_t)l * DM * DM; dstrow0 = (size_t)nb * 32; }
    else if (r < I_IN + I_OUT + I_W1) { r -= I_IN + I_OUT; const int le = r / 1024, rr = r % 1024, kb = rr / 64, nb = rr % 64, j = nb >> 3, bj = (nb >> 2) & 1, cc0 = (nb & 3) * 32;
        W = A.in[I_MW1] + (size_t)le * DM * 2048; ldw = 2048; nvalid = 2048; k0 = kb * 64; nsrc0 = bj * 1024 + 128 * j + cc0; WT = (bf16*)(A.ws + WS_W1) + (size_t)le * 2048 * DM; dstrow0 = (size_t)nb * 32; }
    else { r -= I_IN + I_OUT + I_W1; const int le = r / 512, rr = r % 512, kb = rr / 32, nb = rr % 32;
        W = A.in[I_MW2] + (size_t)le * DM * DM; ldw = DM; nvalid = DM; k0 = kb * 64; nsrc0 = nb * 32; WT = (bf16*)(A.ws + WS_W2) + (size_t)le * DM * DM; dstrow0 = (size_t)nb * 32; }
    const int n = nsrc0 + 4 * (lane & 7);
    d.ok = n < nvalid; d.src = W + (size_t)(k0 + (lane >> 3)) * ldw + (d.ok ? n : 0); d.ldw = ldw; d.scale = scale;
    d.dst = WT + (dstrow0 + (lane >> 3)) * 1024 + k0 + 8 * (lane & 7);
}
__device__ __forceinline__ void tr_load(const TrItem& d, f32x4 (&v)[8]) {
#pragma unroll
    for (int i = 0; i < 8; ++i) v[i] = *(const f32x4*)(d.src + (size_t)(8 * i) * d.ldw);
}
__device__ __forceinline__ void tr_store(const TrItem& d, const f32x4 (&v)[8], LAS float* scr, int lane) {
    const float sc_ = d.ok ? d.scale : 0.0f;
#pragma unroll
    for (int i = 0; i < 8; ++i) { LAS float* s = scr + (8 * i + (lane >> 3)) * 33 + 4 * (lane & 7); s[0] = v[i].x * sc_; s[1] = v[i].y * sc_; s[2] = v[i].z * sc_; s[3] = v[i].w * sc_; }
    LDS_WAIT(); asm volatile("" ::: "memory");
    const int c8 = lane & 7;
#pragma unroll
    for (int j = 0; j < 4; ++j) { const int n = (lane >> 3) + 8 * j; const LAS float* s = scr + (8 * c8) * 33 + n;
        v4u o; o.x = pk2(s[0 * 33], s[1 * 33]); o.y = pk2(s[2 * 33], s[3 * 33]); o.z = pk2(s[4 * 33], s[5 * 33]); o.w = pk2(s[6 * 33], s[7 * 33]);
        *(v4u*)(d.dst + (size_t)(8 * j) * 1024) = o; }
    LDS_WAIT(); asm volatile("" ::: "memory");
}
__device__ __forceinline__ void ph_prologue(ARef A, const WI& w) {
    LAS float* sc = (LAS float*)w.lds;
    { const float* cin = A.in[I_C]; for (int i = w.tid; i < NB * DM; i += NWAVES * 64) { const float v = cin[i]; sc[i] = v / (1.0f + expf(-v)); } }
    __syncthreads();
    float* MOD = (float*)(A.ws + WS_MOD);
    LAS float* red = (LAS float*)(w.lds + 32768);
    if (w.vcu < 192) {
        const int l = w.vcu / 96, col = (w.vcu % 96) * 64 + w.lane, kw = 128 * w.wave;
        const float* wp = A.in[I_ADAW] + (size_t)l * DM * 6144 + (size_t)kw * 6144 + col;
        float acc[8];
#pragma unroll
        for (int b = 0; b < 8; ++b) acc[b] = 0.0f;
#pragma unroll 16
        for (int k = 0; k < 128; ++k) { const float wv = wp[(size_t)k * 6144];
#pragma unroll
            for (int b = 0; b < 8; ++b) acc[b] += sc[b * DM + kw + k] * wv; }
#pragma unroll
        for (int b = 0; b < 8; ++b) red[(w.wave * 8 + b) * 64 + w.lane] = acc[b];
    }
    __syncthreads();
    if (w.vcu < 192) { const int l = w.vcu / 96, b = w.wave, col = (w.vcu % 96) * 64 + w.lane;
        float s = A.in[I_ADAB][l * 6144 + col];
#pragma unroll
        for (int q = 0; q < 8; ++q) s += red[(q * 8 + b) * 64 + w.lane];
        MOD[(size_t)(l * 8 + b) * 6144 + col] = s; }
    __syncthreads();
    LAS float* scr = (LAS float*)(w.lds + 32768 + w.wave * 8448);
    constexpr int NIT = NLAYER * 16 * 96 + NLAYER * 16 * 32 + NLAYER * NEXP * 16 * 64 + NLAYER * NEXP * 16 * 32;
    { TrItem d0, d1; f32x4 va[8], vb[8];
      int it = w.gw; bool h0 = it < NIT;
      if (h0) { tr_decode(A, it, w.lane, d0); tr_load(d0, va); }
      while (h0) {
          it += w.NGW; const bool h1 = it < NIT;
          if (h1) { tr_decode(A, it, w.lane, d1); tr_load(d1, vb); }
          tr_store(d0, va, scr, w.lane);
          if (!h1) break;
          it += w.NGW; h0 = it < NIT;
          if (h0) { tr_decode(A, it, w.lane, d0); tr_load(d0, va); }
          tr_store(d1, vb, scr, w.lane);
      } }
    float* RT = (float*)(A.ws + WS_ROPE); const int* pos = (const int*)A.in[I_POS];
    for (int g = w.gw * 64 + w.lane; g < MTOK * 44; g += w.NGW * 64) {
        const int tok = g / 44, f = g % 44; int co, so;
        if (f < 32) { co = f; so = 32 + f; } else if (f < 40) { co = 64 + (f - 32); so = 72 + (f - 32); } else { co = 80 + (f - 40); so = 84 + (f - 40); }
        float s, c; sincos_d((double)pos[tok] * A.invf[f], s, c);
        RT[(size_t)tok * ROPE_W + co] = c; RT[(size_t)tok * ROPE_W + so] = s;
    }
}

__device__ __forceinline__ void emit_h_row(const f32x4 (&v)[4], float rstd, const float* g, const float* sc, const float* sh, bf16* hrow, int lane) {
#pragma unroll
    for (int j = 0; j < 4; ++j) { const int k = 4 * (lane + 64 * j);
        const f32x4 gv = *(const f32x4*)(g + k), scv = *(const f32x4*)(sc + k), shv = *(const f32x4*)(sh + k);
        const f32x4 h = v[j] * rstd * gv * (1.0f + scv) + shv;
        v2u o; o.x = pk2(h.x, h.y); o.y = pk2(h.z, h.w); *(v2u*)(hrow + k) = o; }
}
__device__ __forceinline__ void small_weights_to_f16(ARef A, const WI& w) {
    { _Float16* SW = (_Float16*)(A.ws + WS_SMALLW);
      const int g0 = w.gw * 64 + w.lane, gs = w.NGW * 64;
      for (int l = 0; l < NLAYER; ++l) { _Float16* S = SW + (size_t)l * SMW_LAYER;
          const float* wq = A.in[I_WQ] + (size_t)l * 128 * 256; const float* wqi = A.in[I_WQI] + (size_t)l * 128 * 256;
          for (int e = g0; e < 256 * 128; e += gs) { const int n = e >> 7, k = e & 127; S[SMW_QI + e] = (_Float16)wq[k * 256 + n]; S[SMW_QI + 256 * 128 + e] = (_Float16)wqi[k * 256 + n]; }
          const float* w2 = A.in[I_W2] + (size_t)l * 32 * 256; const float* a2 = A.in[I_A2] + (size_t)l * 32 * 256; const float* g2 = A.in[I_G2] + (size_t)l * 64 * 256;
          for (int e = g0; e < 256 * 32; e += gs) { const int n = e >> 5, k = e & 31; S[SMW_W2 + e] = (_Float16)w2[k * 256 + n]; S[SMW_A2 + e] = (_Float16)a2[k * 256 + n]; }
          for (int e = g0; e < 256 * 64; e += gs) { const int n = e >> 6, k = e & 63; S[SMW_G2 + e] = (_Float16)g2[k * 256 + n]; } } }
}
__device__ __forceinline__ void ph_norm1(ARef A, const WI& w) {
    const float* MOD = (const float*)(A.ws + WS_MOD); bf16* H = (bf16*)(A.ws + WS_H);
    for (int m = w.gw; m < MTOK; m += w.NGW) {
        const float* xr = A.in[I_X] + (size_t)m * DM; f32x4 v[4]; float ss = 0.0f;
#pragma unroll
        for (int j = 0; j < 4; ++j) { v[j] = *(const f32x4*)(xr + 4 * (w.lane + 64 * j)); ss += dot4(v[j], v[j]); }
        ss = wave_sum(ss); const float rstd = 1.0f / sqrtf(ss * (1.0f / DM) + 1e-5f);
        const float* mb = MOD + (size_t)(m >> 12) * 6144;
        emit_h_row(v, rstd, A.in[I_NMIX], mb + 1024, mb, H + (size_t)m * DM, w.lane);
    }
}

typedef _Float16 h4v __attribute__((ext_vector_type(4)));
__device__ __forceinline__ f16x8 pack_f16x8(f32x4 a, f32x4 b) { f16x8 r; r[0] = (_Float16)a.x; r[1] = (_Float16)a.y; r[2] = (_Float16)a.z; r[3] = (_Float16)a.w; r[4] = (_Float16)b.x; r[5] = (_Float16)b.y; r[6] = (_Float16)b.z; r[7] = (_Float16)b.w; return r; }
__device__ __forceinline__ void prep16(ARef A, int l, int m0, int lane_in) {
    int lane = lane_in; asm volatile("" : "+v"(lane));
    const int tk = lane & 15, q4 = lane >> 4, m = m0 + tk, t = m & (SEQ - 1);
    const float* P = (const float*)(A.ws + WS_PF); float* RWA = (float*)(A.ws + WS_RWA); const _Float16* SW = (const _Float16*)(A.ws + WS_SMALLW) + (size_t)l * SMW_LAYER;
    const float* pr = P + (size_t)m * PFW; const float* pp = pr - PFW; const float* pd = P + (size_t)m * PFW + PF_DSA; const float* mu = A.in[I_MU] + l * 896;
    const float* RT = (const float*)(A.ws + WS_ROPE) + (size_t)m * ROPE_W; const f32x4 zero4 = {0.f, 0.f, 0.f, 0.f};
    f16x8 bx[4], bc[4];
    { float ss = 0.0f; f32x4 c[4][2];
#pragma unroll
      for (int ks = 0; ks < 4; ++ks) { const int f0 = 32 * ks + 8 * q4;
          f32x4 x[2];
#pragma unroll
          for (int u = 0; u < 2; ++u) { const f32x4 z = *(const f32x4*)(pr + 768 + f0 + 4 * u); const f32x4 p = t ? *(const f32x4*)(pp + 768 + f0 + 4 * u) : zero4; x[u] = z + (p - z) * *(const f32x4*)(mu + 768 + f0 + 4 * u);
#pragma unroll
              for (int i = 0; i < 4; ++i) x[u][i] = (ks == 0) ? ftanh(x[u][i]) : (ks == 1) ? x[u][i] : sigm(x[u][i]); }
          bx[ks] = pack_f16x8(x[0], x[1]);
          c[ks][0] = *(const f32x4*)(pd + f0); c[ks][1] = *(const f32x4*)(pd + f0 + 4); ss += dot4(c[ks][0], c[ks][0]) + dot4(c[ks][1], c[ks][1]); }
      ss += __shfl_xor(ss, 16); ss += __shfl_xor(ss, 32);
      const float rstd = 1.0f / sqrtf(ss * (1.0f / 128.0f) + 1e-5f); const float* qn = A.in[I_QNORM] + l * 128;
#pragma unroll
      for (int ks = 0; ks < 4; ++ks) { const int f0 = 32 * ks + 8 * q4; bc[ks] = pack_f16x8(c[ks][0] * rstd * *(const f32x4*)(qn + f0), c[ks][1] * rstd * *(const f32x4*)(qn + f0 + 4)); } }
    const _Float16* wrow = SW + (size_t)tk * 0;
    (void)wrow;
    const int arow = lane & 15;
#pragma unroll 1
    for (int hd = 0; hd < 4; ++hd) {
        f32x4 fk[4], av[4]; float ssk = 0.0f;
#pragma unroll
        for (int j = 0; j < 4; ++j) { const int nb = 4 * hd + j, ch = 16 * nb + 4 * q4; const size_t o = (size_t)m * 256 + ch;
            const f16x8 aw = *(const f16x8*)(SW + SMW_W2 + (16 * nb + arow) * 32 + 8 * q4), aa = *(const f16x8*)(SW + SMW_A2 + (16 * nb + arow) * 32 + 8 * q4);
            const f16x8 ag0 = *(const f16x8*)(SW + SMW_G2 + (16 * nb + arow) * 64 + 8 * q4), ag1 = *(const f16x8*)(SW + SMW_G2 + (16 * nb + arow) * 64 + 32 + 8 * q4);
            const f32x4 cw = __builtin_amdgcn_mfma_f32_16x16x32_f16(aw, bx[0], *(const f32x4*)(A.in[I_W0] + l * 256 + ch), 0, 0, 0);
            const f32x4 ca = __builtin_amdgcn_mfma_f32_16x16x32_f16(aa, bx[1], *(const f32x4*)(A.in[I_A0] + l * 256 + ch), 0, 0, 0);
            f32x4 cg = __builtin_amdgcn_mfma_f32_16x16x32_f16(ag0, bx[2], zero4, 0, 0, 0); cg = __builtin_amdgcn_mfma_f32_16x16x32_f16(ag1, bx[3], cg, 0, 0, 0);
            f32x4 dec;
#pragma unroll
            for (int i = 0; i < 4; ++i) { dec[i] = fexp(-fexp(-softplusf(-cw[i]) - 0.5f)); av[j][i] = sigm(ca[i]); }
            *(f32x4*)(RWA + 1 * RWA_STRIDE + o) = dec; *(f32x4*)(RWA + 6 * RWA_STRIDE + o) = cg;
            { const f32x4 z = *(const f32x4*)(pr + 256 + ch); const f32x4 p = t ? *(const f32x4*)(pp + 256 + ch) : zero4; fk[j] = z + (p - z) * *(const f32x4*)(mu + 256 + ch); }
            const f32x4 kk = fk[j] * *(const f32x4*)(A.in[I_KK] + l * 256 + ch); ssk += dot4(kk, kk); }
        ssk += __shfl_xor(ssk, 16); ssk += __shfl_xor(ssk, 32);
        const float inrm = 1.0f / fmaxf(sqrtf(ssk), 1e-12f);
        f32x4 fr[4], km[4]; float bs = 0.0f;
#pragma unroll
        for (int j = 0; j < 4; ++j) { const int ch = 16 * (4 * hd + j) + 4 * q4;
            { const f32x4 z = *(const f32x4*)(pr + ch); const f32x4 p = t ? *(const f32x4*)(pp + ch) : zero4; fr[j] = z + (p - z) * *(const f32x4*)(mu + ch); }
            km[j] = fk[j] * (1.0f + (av[j] - 1.0f) * *(const f32x4*)(A.in[I_KA] + l * 256 + ch)); bs += dot4(fr[j] * km[j], *(const f32x4*)(A.in[I_RK] + l * 256 + ch)); }
        bs += __shfl_xor(bs, 16); bs += __shfl_xor(bs, 32);
#pragma unroll
        for (int j = 0; j < 4; ++j) { const int ch = 16 * (4 * hd + j) + 4 * q4; const size_t o = (size_t)m * 256 + ch;
            f32x4 fv; { const f32x4 z = *(const f32x4*)(pr + 512 + ch); const f32x4 p = t ? *(const f32x4*)(pp + 512 + ch) : zero4; fv = z + (p - z) * *(const f32x4*)(mu + 512 + ch); }
            const f32x4 kk = fk[j] * *(const f32x4*)(A.in[I_KK] + l * 256 + ch) * inrm;
            *(f32x4*)(RWA + 0 * RWA_STRIDE + o) = fr[j]; *(f32x4*)(RWA + 2 * RWA_STRIDE + o) = km[j]; *(f32x4*)(RWA + 3 * RWA_STRIDE + o) = fv;
            *(f32x4*)(RWA + 4 * RWA_STRIDE + o) = -kk; *(f32x4*)(RWA + 5 * RWA_STRIDE + o) = kk * av[j]; *(f32x4*)(RWA + 7 * RWA_STRIDE + o) = bs * fv; }
    }
#pragma unroll 1
    for (int nb = 0; nb < 32; ++nb) {
        f32x4 cq = zero4;
#pragma unroll
        for (int ks = 0; ks < 4; ++ks) { const f16x8 aq = *(const f16x8*)(SW + SMW_QI + (16 * nb + arow) * 128 + 32 * ks + 8 * q4); cq = __builtin_amdgcn_mfma_f32_16x16x32_f16(aq, bc[ks], cq, 0, 0, 0); }
        const int ch = 16 * (nb & 15) + 4 * q4;
        if (nb < 16) {
            if ((nb & 3) == 0) { const f32x4 ot = shx4(cq, 32); const int fi = 4 * (q4 & 1); const f32x4 cs4 = *(const f32x4*)(RT + 64 + fi), sn = *(const f32x4*)(RT + 72 + fi); cq = (q4 < 2) ? cq * cs4 - ot * sn : ot * sn + cq * cs4; }
            const f32x4 qs = cq * 0.18033688011112042f; v2u o; o.x = pk2(qs.x, qs.y); o.y = pk2(qs.z, qs.w); *(v2u*)((bf16*)(A.ws + WS_DQ) + (size_t)m * 256 + ch) = o;
        } else {
            if ((nb & 1) == 0) { const f32x4 ot = shx4(cq, 16); const f32x4 cs4 = *(const f32x4*)(RT + 80), sn = *(const f32x4*)(RT + 84); if (q4 < 2) cq = (q4 < 1) ? cq * cs4 - ot * sn : ot * sn + cq * cs4; }
            h4v hq; hq.x = (_Float16)cq.x; hq.y = (_Float16)cq.y; hq.z = (_Float16)cq.z; hq.w = (_Float16)cq.w; *(h4v*)((_Float16*)(A.ws + WS_DQI) + (size_t)m * 256 + ch) = hq;
        }
    }
#pragma unroll
    for (int j = 0; j < 4; ++j) { const int d = 16 * j + 4 * q4; f32x4 kx = *(const f32x4*)(pd + 128 + d);
        if (j == 0) { const f32x4 ot = shx4(kx, 32); const int fi = 4 * (q4 & 1); const f32x4 cs4 = *(const f32x4*)(RT + 64 + fi), sn = *(const f32x4*)(RT + 72 + fi); kx = (q4 < 2) ? kx * cs4 - ot * sn : ot * sn + kx * cs4; }
        v2u o; o.x = pk2(kx.x, kx.y); o.y = pk2(kx.z, kx.w); *(v2u*)((bf16*)(A.ws + WS_DKB) + (size_t)m * 64 + d) = o;
        const f32x4 vx = *(const f32x4*)(pd + 192 + d); v2u ov; ov.x = pk2(vx.x, vx.y); ov.y = pk2(vx.z, vx.w); *(v2u*)((bf16*)(A.ws + WS_DVB) + (size_t)m * 64 + d) = ov; }
#pragma unroll
    for (int j = 0; j < 2; ++j) { const int d = 16 * j + 4 * q4; f32x4 ki = *(const f32x4*)(pd + 256 + d);
        if (j == 0) { const f32x4 ot = shx4(ki, 16); const f32x4 cs4 = *(const f32x4*)(RT + 80), sn = *(const f32x4*)(RT + 84); if (q4 < 2) ki = (q4 < 1) ? ki * cs4 - ot * sn : ot * sn + ki * cs4; }
        h4v hk; hk.x = (_Float16)ki.x; hk.y = (_Float16)ki.y; hk.z = (_Float16)ki.z; hk.w = (_Float16)ki.w; *(h4v*)((_Float16*)(A.ws + WS_DKI) + (size_t)m * 32 + d) = hk; }
    if (q4 < 2) *(f32x4*)((float*)(A.ws + WS_DW) + (size_t)m * 8 + 4 * q4) = *(const f32x4*)(pd + 288 + 4 * q4) * 0.0625f;
}
__device__ __forceinline__ float quad_sum(float v) {
    v += __builtin_bit_cast(float, __builtin_amdgcn_mov_dpp(__builtin_bit_cast(int, v), 0xB1, 0xF, 0xF, true));
    v += __builtin_bit_cast(float, __builtin_amdgcn_mov_dpp(__builtin_bit_cast(int, v), 0x4E, 0xF, 0xF, true));
    return v;
}
__device__ __forceinline__ float oct_sum(float v) {
    v += __builtin_bit_cast(float, __builtin_amdgcn_mov_dpp(__builtin_bit_cast(int, v), 0xB1, 0xF, 0xF, true));
    v += __builtin_bit_cast(float, __builtin_amdgcn_mov_dpp(__builtin_bit_cast(int, v), 0x4E, 0xF, 0xF, true));
    v += __builtin_bit_cast(float, __builtin_amdgcn_mov_dpp(__builtin_bit_cast(int, v), 0x141, 0xF, 0xF, true));
    return v;
}
typedef float f32x2 __attribute__((ext_vector_type(2)));
#define LO2(v_) __builtin_shufflevector(v_, v_, 0, 1)
#define HI2(v_) __builtin_shufflevector(v_, v_, 2, 3)
#define RW_ROW(i_) (((i_) < 2) ? (16 * ws + rg + 8 * (i_)) : (64 + 16 * ws + rg + 8 * ((i_) - 2)))
#define RW_LOAD(op, s_) do { const int lo_ = (s_) * 64 + kq * 8; \
    op[0] = *(const LAS f32x4*)(sn + lo_); op[1] = *(const LAS f32x4*)(sn + lo_ + 4); op[2] = *(const LAS f32x4*)(sw + lo_); op[3] = *(const LAS f32x4*)(sw + lo_ + 4); \
    op[4] = *(const LAS f32x4*)(sb + lo_); op[5] = *(const LAS f32x4*)(sb + lo_ + 4); op[6] = *(const LAS f32x4*)(sk + lo_); op[7] = *(const LAS f32x4*)(sk + lo_ + 4); \
    op[8] = *(const LAS f32x4*)(sr + lo_); op[9] = *(const LAS f32x4*)(sr + lo_ + 4); \
    vin[0] = sv[(s_) * 64 + 16 * ws + rg]; vin[1] = sv[(s_) * 64 + 16 * ws + rg + 8]; } while (0)
#define RW_DOT(i_, oa, ob) ({ f32x2 d_ = S[i_][0] * LO2(oa); d_ = S[i_][1] * HI2(oa) + d_; d_ = S[i_][2] * LO2(ob) + d_; d_ = S[i_][3] * HI2(ob) + d_; d_.x + d_.y; })
#define RW_STEP(op, vv, s_) do { float sa_[4], y_[4]; \
    _Pragma("unroll") for (int i_ = 0; i_ < 4; ++i_) sa_[i_] = RW_DOT(i_, op[0], op[1]); \
    _Pragma("unroll") for (int i_ = 0; i_ < 4; ++i_) sa_[i_] += __builtin_bit_cast(float, __builtin_amdgcn_mov_dpp(__builtin_bit_cast(int, sa_[i_]), 0xB1, 0xF, 0xF, true)); \
    _Pragma("unroll") for (int i_ = 0; i_ < 4; ++i_) sa_[i_] += __builtin_bit_cast(float, __builtin_amdgcn_mov_dpp(__builtin_bit_cast(int, sa_[i_]), 0x4E, 0xF, 0xF, true)); \
    _Pragma("unroll") for (int i_ = 0; i_ < 4; ++i_) sa_[i_] += __builtin_bit_cast(float, __builtin_amdgcn_mov_dpp(__builtin_bit_cast(int, sa_[i_]), 0x141, 0xF, 0xF, true)); \
    _Pragma("unroll") for (int i_ = 0; i_ < 2; ++i_) { const f32x2 a2_ = {sa_[i_], sa_[i_]}, v2_ = {vv[i_], vv[i_]}; \
        S[i_][0] = S[i_][0] * LO2(op[2]) + (a2_ * LO2(op[4]) + v2_ * LO2(op[6])); S[i_][1] = S[i_][1] * HI2(op[2]) + (a2_ * HI2(op[4]) + v2_ * HI2(op[6])); \
        S[i_][2] = S[i_][2] * LO2(op[3]) + (a2_ * LO2(op[5]) + v2_ * LO2(op[7])); S[i_][3] = S[i_][3] * HI2(op[3]) + (a2_ * HI2(op[5]) + v2_ * HI2(op[7])); } \
    _Pragma("unroll") for (int i_ = 2; i_ < 4; ++i_) { const f32x2 a2_ = {sa_[i_], sa_[i_]}; \
        S[i_][0] = S[i_][0] * LO2(op[2]) + a2_ * LO2(op[4]); S[i_][1] = S[i_][1] * HI2(op[2]) + a2_ * HI2(op[4]); S[i_][2] = S[i_][2] * LO2(op[3]) + a2_ * LO2(op[5]); S[i_][3] = S[i_][3] * HI2(op[3]) + a2_ * HI2(op[5]); } \
    _Pragma("unroll") for (int i_ = 0; i_ < 4; ++i_) y_[i_] = RW_DOT(i_, op[8], op[9]); \
    _Pragma("unroll") for (int i_ = 0; i_ < 4; ++i_) y_[i_] += __builtin_bit_cast(float, __builtin_amdgcn_mov_dpp(__builtin_bit_cast(int, y_[i_]), 0xB1, 0xF, 0xF, true)); \
    _Pragma("unroll") for (int i_ = 0; i_ < 4; ++i_) y_[i_] += __builtin_bit_cast(float, __builtin_amdgcn_mov_dpp(__builtin_bit_cast(int, y_[i_]), 0x4E, 0xF, 0xF, true)); \
    _Pragma("unroll") for (int i_ = 0; i_ < 4; ++i_) y_[i_] += __builtin_bit_cast(float, __builtin_amdgcn_mov_dpp(__builtin_bit_cast(int, y_[i_]), 0x141, 0xF, 0xF, true)); \
    if (kq == 0) { _Pragma("unroll") for (int i_ = 0; i_ < 4; ++i_) so[(s_) * 128 + RW_ROW(i_)] = y_[i_]; } } while (0)
__device__ __forceinline__ void scan_rwkv_task2(ARef A, const WI& w, int task0) {
    const int slot = w.wave >> 2, ws = w.wave & 3, lt = w.tid & 255, task = task0 + slot;
    const int bh = task >> 4, c = task & 15, b = bh >> 2, h = bh & 3;
    LAS float* sw = (LAS float*)w.lds + slot * 16384; LAS float* sn = sw + 2048; LAS float* sb = sn + 2048; LAS float* sk = sb + 2048; LAS float* sr = sk + 2048; LAS float* sv = sr + 2048; LAS float* so = sv + 2048;
    const float* RWA = (const float*)(A.ws + WS_RWA);
    const int rg = w.lane >> 3, kq = w.lane & 7;
    f32x2 S[4][4];
#pragma unroll
    for (int i = 0; i < 4; ++i)
#pragma unroll
        for (int j = 0; j < 4; ++j) { const int r = RW_ROW(i); S[i][j].x = (r >= 64 && 8 * kq + 2 * j == r - 64) ? 1.0f : 0.0f; S[i][j].y = (r >= 64 && 8 * kq + 2 * j + 1 == r - 64) ? 1.0f : 0.0f; }
    const size_t tok0 = (size_t)b * SEQ + (size_t)c * TCH;
    const int st = lt >> 3, sd = (lt & 7) * 8;
    f32x4 a[6][2];
#define RW_GLOAD(sub_) do { const size_t o_ = (tok0 + (sub_) * 32 + st) * 256 + h * 64 + sd; \
        _Pragma("unroll") for (int q = 0; q < 2; ++q) { a[0][q] = *(const f32x4*)(RWA + 1 * RWA_STRIDE + o_ + 4 * q); a[1][q] = *(const f32x4*)(RWA + 4 * RWA_STRIDE + o_ + 4 * q); a[2][q] = *(const f32x4*)(RWA + 5 * RWA_STRIDE + o_ + 4 * q); \
            a[3][q] = *(const f32x4*)(RWA + 2 * RWA_STRIDE + o_ + 4 * q); a[4][q] = *(const f32x4*)(RWA + 0 * RWA_STRIDE + o_ + 4 * q); a[5][q] = *(const f32x4*)(RWA + 3 * RWA_STRIDE + o_ + 4 * q); } } while (0)
    RW_GLOAD(0);
    for (int sub = 0; sub < TCH / 32; ++sub) {
        __syncthreads();
        { const int lo = st * 64 + sd;
#pragma unroll
          for (int q = 0; q < 2; ++q) { *(LAS f32x4*)(sw + lo + 4 * q) = a[0][q]; *(LAS f32x4*)(sn + lo + 4 * q) = a[1][q]; *(LAS f32x4*)(sb + lo + 4 * q) = a[2][q]; *(LAS f32x4*)(sk + lo + 4 * q) = a[3][q]; *(LAS f32x4*)(sr + lo + 4 * q) = a[4][q]; *(LAS f32x4*)(sv + lo + 4 * q) = a[5][q]; } }
        __syncthreads();
        if (sub + 1 < TCH / 32) RW_GLOAD(sub + 1);
        { f32x4 opA[10], opB[10]; float vin[2], vA[2], vB[2];
          RW_LOAD(opA, 0);
          vA[0] = vin[0]; vA[1] = vin[1];
#pragma unroll 1
          for (int s = 0; s < 32; s += 2) {
              RW_LOAD(opB, s + 1);
              vB[0] = vin[0]; vB[1] = vin[1];
              RW_STEP(opA, vA, s);
              if (s + 2 < 32) { RW_LOAD(opA, s + 2); vA[0] = vin[0]; vA[1] = vin[1]; }
              RW_STEP(opB, vB, s + 1);
          } }
        __syncthreads();
        { const int fs = lt >> 3, c16 = (lt & 7) * 16;
          float* dst = (c16 < 64) ? ((float*)(A.ws + WS_YO) + YO_STRIDE) : ((float*)(A.ws + WS_PT) - 64);
          float* dp = dst + (tok0 + sub * 32 + fs) * 256 + h * 64 + c16;
#pragma unroll
          for (int q = 0; q < 4; ++q) *(f32x4*)(dp + 4 * q) = *(const LAS f32x4*)(so + fs * 128 + c16 + 4 * q); }
    }
    { float* ch = (float*)(A.ws + WS_CH) + ((size_t)(bh * NCH + c) * 128) * 64 + 8 * kq;
#pragma unroll
      for (int i = 0; i < 4; ++i) { float* cr = ch + (size_t)RW_ROW(i) * 64; *(f32x4*)cr = (f32x4){S[i][0].x, S[i][0].y, S[i][1].x, S[i][1].y}; *(f32x4*)(cr + 4) = (f32x4){S[i][2].x, S[i][2].y, S[i][3].x, S[i][3].y}; } }
    __syncthreads();
}
#undef RW_LOAD
#undef RW_STEP
#undef RW_GLOAD
#undef RW_DOT
#undef RW_ROW
__device__ __forceinline__ void scan_ret_task(ARef A, const WI& w, int task) {
    const int bh = task >> 3, cp = task & 7, b = bh >> 2, h = bh & 3, un = w.tid >> 8, lt = w.tid & 255, c = 2 * cp + un;
    const float lg2g = log2f(1.0f - exp2f(-5.0f - (float)h)), gamma = exp2f(lg2g);
    LAS float* sk = (LAS float*)w.lds + un * 8192; LAS float* sq = sk + 2048; LAS float* sv = sq + 2048; LAS float* so = sv + 2048;
    const bf16* PB = (const bf16*)(A.ws + WS_PB); const float* RT = (const float*)(A.ws + WS_ROPE);
    const int row = lt >> 2, kq = lt & 3;
    f32x2 S[8];
#pragma unroll
    for (int j = 0; j < 8; ++j) S[j] = (f32x2){0.0f, 0.0f};
    const f32x2 gam2 = {gamma, gamma};
    const size_t tok0 = (size_t)b * SEQ + (size_t)c * TCH;
    const int st = lt >> 3, sd = (lt & 7) * 8;
    const int fi = sd & 31, dp = sd ^ 32;
    f32x4 gq[2], gqo[2], gk[2], gko[2], gv[2], gcs[2], gsn[2];
#define BF8_TO_F32(dst, x_) do { dst[0] = (f32x4){bf_lo(x_.x), bf_hi(x_.x), bf_lo(x_.y), bf_hi(x_.y)}; dst[1] = (f32x4){bf_lo(x_.z), bf_hi(x_.z), bf_lo(x_.w), bf_hi(x_.w)}; } while (0)
#define RT_GLOAD(sub_) do { const size_t m_ = tok0 + (sub_) * 32 + st; const bf16* pr_ = PB + m_ * PBW + h * 64; const float* rt_ = RT + m_ * ROPE_W; \
        _Pragma("unroll") for (int u = 0; u < 2; ++u) { gcs[u] = *(const f32x4*)(rt_ + fi + 4 * u); gsn[u] = *(const f32x4*)(rt_ + 32 + fi + 4 * u); } \
        { const v4u x0 = *(const v4u*)(pr_ + sd), x1 = *(const v4u*)(pr_ + dp), x2 = *(const v4u*)(pr_ + 256 + sd), x3 = *(const v4u*)(pr_ + 256 + dp), x4 = *(const v4u*)(pr_ + 512 + sd); \
          BF8_TO_F32(gq, x0); BF8_TO_F32(gqo, x1); BF8_TO_F32(gk, x2); BF8_TO_F32(gko, x3); BF8_TO_F32(gv, x4); } } while (0)
    RT_GLOAD(0);
    for (int sub = 0; sub < TCH / 32; ++sub) {
        const size_t m = tok0 + sub * 32 + st;
        f32x4 qn[2], kn[2], vn[2];
#pragma unroll
        for (int u = 0; u < 2; ++u) { qn[u] = (sd < 32) ? gq[u] * gcs[u] - gqo[u] * gsn[u] : gqo[u] * gsn[u] + gq[u] * gcs[u]; kn[u] = (sd < 32) ? gk[u] * gcs[u] - gko[u] * gsn[u] : gko[u] * gsn[u] + gk[u] * gcs[u]; vn[u] = gv[u]; }
        { const float gt = exp2f(lg2g * (float)(sub * 32 + st + 1)); const f32x4 p0 = qn[0] * gt, p1 = qn[1] * gt;
          v4u pw; pw.x = pk2(p0.x, p0.y); pw.y = pk2(p0.z, p0.w); pw.z = pk2(p1.x, p1.y); pw.w = pk2(p1.z, p1.w); *(v4u*)((bf16*)(A.ws + WS_PTR) + m * 256 + h * 64 + sd) = pw; }
        __syncthreads();
        { const int lo = st * 64 + sd; *(LAS f32x4*)(sq + lo) = qn[0]; *(LAS f32x4*)(sq + lo + 4) = qn[1]; *(LAS f32x4*)(sk + lo) = kn[0]; *(LAS f32x4*)(sk + lo + 4) = kn[1]; *(LAS f32x4*)(sv + lo) = vn[0]; *(LAS f32x4*)(sv + lo + 4) = vn[1]; }
        __syncthreads();
        if (sub + 1 < TCH / 32) RT_GLOAD(sub + 1);
        for (int s = 0; s < 32; ++s) {
            const int lo = s * 64 + kq * 16; const float vv = sv[s * 64 + row]; const f32x2 v2 = {vv, vv}; f32x2 y2 = {0.0f, 0.0f};
#pragma unroll
            for (int j4 = 0; j4 < 4; ++j4) { const f32x4 kv = *(const LAS f32x4*)(sk + lo + 4 * j4), rv = *(const LAS f32x4*)(sq + lo + 4 * j4);
                S[2 * j4] = S[2 * j4] * gam2 + v2 * LO2(kv); S[2 * j4 + 1] = S[2 * j4 + 1] * gam2 + v2 * HI2(kv);
                y2 = S[2 * j4] * LO2(rv) + y2; y2 = S[2 * j4 + 1] * HI2(rv) + y2; }
            float y = quad_sum(y2.x + y2.y);
            if (kq == 0) so[s * 64 + row] = y;
        }
        __syncthreads();
        { const int fs = lt >> 3, c8 = (lt & 7) * 8; float* dp2 = (float*)(A.ws + WS_YO) + (tok0 + sub * 32 + fs) * 256 + h * 64 + c8;
          *(f32x4*)dp2 = *(const LAS f32x4*)(so + fs * 64 + c8); *(f32x4*)(dp2 + 4) = *(const LAS f32x4*)(so + fs * 64 + c8 + 4); }
    }
    { float* ch = (float*)(A.ws + WS_CHR) + ((size_t)(bh * NCH + c) * 64 + row) * 64 + 16 * kq;
#pragma unroll
      for (int j4 = 0; j4 < 4; ++j4) *(f32x4*)(ch + 4 * j4) = (f32x4){S[2 * j4].x, S[2 * j4].y, S[2 * j4 + 1].x, S[2 * j4 + 1].y}; }
    __syncthreads();
}
#undef RT_GLOAD
#undef BF8_TO_F32
__device__ __forceinline__ void prefix_chain(ARef A, const WI& w, int bh) {
    LAS float* s0 = (LAS float*)w.lds;
    const int v = w.tid >> 3, k8 = (w.tid & 7) * 8;
    const float* CH = (const float*)(A.ws + WS_CH) + (size_t)bh * NCH * 128 * 64; float* SI = (float*)(A.ws + WS_SI) + (size_t)bh * NCH * 64 * 64;
    f32x4 c0 = {0.f, 0.f, 0.f, 0.f}, c1 = {0.f, 0.f, 0.f, 0.f};
    for (int c = 0; c < NCH; ++c) {
        *(f32x4*)(SI + ((size_t)c * 64 + v) * 64 + k8) = c0; *(f32x4*)(SI + ((size_t)c * 64 + v) * 64 + k8 + 4) = c1;
        if (c == NCH - 1) break;
        __syncthreads();
        *(LAS f32x4*)(s0 + v * 68 + k8) = c0; *(LAS f32x4*)(s0 + v * 68 + k8 + 4) = c1;
        __syncthreads();
        const float* ch = CH + (size_t)c * 128 * 64;
        f32x4 n0 = *(const f32x4*)(ch + (size_t)v * 64 + k8), n1 = *(const f32x4*)(ch + (size_t)v * 64 + k8 + 4);
#pragma unroll 8
        for (int kp = 0; kp < 64; ++kp) { const float s = s0[v * 68 + kp]; const float* pr = ch + (size_t)(64 + kp) * 64 + k8; n0 += s * *(const f32x4*)pr; n1 += s * *(const f32x4*)(pr + 4); }
        c0 = n0; c1 = n1;
    }
    const int h = bh & 3; const float gT = exp2f((float)TCH * log2f(1.0f - exp2f(-5.0f - (float)h)));
    const float* CHR = (const float*)(A.ws + WS_CHR) + (size_t)bh * NCH * 64 * 64; float* SIR = (float*)(A.ws + WS_SIR) + (size_t)bh * NCH * 64 * 64;
    c0 = (f32x4){0.f, 0.f, 0.f, 0.f}; c1 = c0;
    for (int c = 0; c < NCH; ++c) {
        *(f32x4*)(SIR + ((size_t)c * 64 + v) * 64 + k8) = c0; *(f32x4*)(SIR + ((size_t)c * 64 + v) * 64 + k8 + 4) = c1;
        if (c == NCH - 1) break;
        c0 = c0 * gT + *(const f32x4*)(CHR + ((size_t)c * 64 + v) * 64 + k8); c1 = c1 * gT + *(const f32x4*)(CHR + ((size_t)c * 64 + v) * 64 + k8 + 4);
    }
    __syncthreads();
}
typedef float f32x16 __attribute__((ext_vector_type(16)));
constexpr int SBV_PITCH = 144;
__device__ __forceinline__ float lane32_swap(float v) { return __shfl_xor(v, 32); }
__device__ __forceinline__ void sb_tile_mfma(ARef A, int unit, int lane, LAS unsigned char* vl) {
    const int tq = unit & 127, bh = unit >> 7, b = bh >> 2, h = bh & 3, t0 = tq * 32, r32 = lane & 31, hi = lane >> 5;
    const bf16* PS = (const bf16*)(A.ws + WS_PB) + (size_t)b * SEQ * PBW + PB_SB + h * 64;
    bf16x8v qf[4];
#pragma unroll
    for (int ks = 0; ks < 4; ++ks) qf[ks] = *(const bf16x8v*)(PS + (size_t)(t0 + r32) * PBW + 16 * ks + 8 * hi);
    f32x16 o0, o1;
#pragma unroll
    for (int r = 0; r < 16; ++r) { o0[r] = 0.0f; o1[r] = 0.0f; }
    float carry = 0.0f;
    const int g16 = lane >> 4, tj = (lane & 15) >> 2, tc = lane & 3;
    for (int kb0 = t0; kb0 >= 0; kb0 -= 32) {
#pragma unroll
        for (int i = 0; i < 4; ++i) { const int p = lane + 64 * i, row = p >> 3, ch = p & 7; const v4u v = *(const v4u*)(PS + 512 + (size_t)(kb0 + row) * PBW + 8 * ch); *(LAS v4u*)(vl + row * SBV_PITCH + 16 * ch) = v; }
        f32x16 st;
#pragma unroll
        for (int r = 0; r < 16; ++r) st[r] = 0.0f;
        { bf16x8v ka[4];
#pragma unroll
          for (int ks = 0; ks < 4; ++ks) ka[ks] = *(const bf16x8v*)(PS + 256 + (size_t)(kb0 + r32) * PBW + 16 * ks + 8 * hi);
#pragma unroll
          for (int ks = 0; ks < 4; ++ks) st = __builtin_amdgcn_mfma_f32_32x32x16_bf16(ka[ks], qf[ks], st, 0, 0, 0);
          asm volatile("" :: "v"(ka[0]), "v"(ka[1]), "v"(ka[2]), "v"(ka[3]), "v"(st)); }
        float sp[16]; const bool diag = (kb0 == t0);
#pragma unroll
        for (int r = 0; r < 16; ++r) { const float zl = st[r]; float s = (zl > 30.0f) ? zl : __builtin_amdgcn_logf(1.0f + __builtin_amdgcn_exp2f(zl));
            if (diag && ((r & 3) + 8 * (r >> 2) + 4 * hi >= r32)) s = 0.0f;
            sp[r] = s; }
        float G[4], Gp[4], suf[4];
#pragma unroll
        for (int q = 0; q < 4; ++q) { G[q] = (sp[4 * q] + sp[4 * q + 1]) + (sp[4 * q + 2] + sp[4 * q + 3]); Gp[q] = lane32_swap(G[q]); }
        suf[3] = 0.0f; suf[2] = G[3] + Gp[3]; suf[1] = suf[2] + (G[2] + Gp[2]); suf[0] = suf[1] + (G[1] + Gp[1]);
        const float tot = suf[0] + (G[0] + Gp[0]);
        pg8::u32x4 pw0, pw1;
        float av[16];
#pragma unroll
        for (int q = 0; q < 4; ++q) { float run = carry + suf[q] + (hi == 0 ? Gp[q] : 0.0f);
#pragma unroll
            for (int i = 3; i >= 0; --i) { const int r = 4 * q + i; const float la = (st[r] - sp[r]) - run; float a = __builtin_amdgcn_exp2f(la);
                if (diag && ((r & 3) + 8 * (r >> 2) + 4 * hi >= r32)) a = 0.0f;
                av[r] = a; run += sp[r]; } }
        pw0.x = pg8::cvt_pk_bf16(av[0], av[1]); pw0.y = pg8::cvt_pk_bf16(av[2], av[3]); pw0.z = pg8::cvt_pk_bf16(av[4], av[5]); pw0.w = pg8::cvt_pk_bf16(av[6], av[7]);
        pw1.x = pg8::cvt_pk_bf16(av[8], av[9]); pw1.y = pg8::cvt_pk_bf16(av[10], av[11]); pw1.z = pg8::cvt_pk_bf16(av[12], av[13]); pw1.w = pg8::cvt_pk_bf16(av[14], av[15]);
        const bf16x8v pa0 = __builtin_bit_cast(bf16x8v, pw0), pa1 = __builtin_bit_cast(bf16x8v, pw1);
        LDS_WAIT();
#pragma unroll
        for (int s = 0; s < 2; ++s)
#pragma unroll
            for (int nb = 0; nb < 2; ++nb) {
                LAS unsigned char* a1 = vl + (16 * s + 4 * (g16 >> 1) + tj) * SBV_PITCH + (32 * nb + 16 * (g16 & 1) + 4 * tc) * 2;
                const s16x4v r1 = __builtin_bit_cast(s16x4v, __builtin_amdgcn_ds_read_tr16_b64_v4i16((LAS s16x4v*)a1));
                const s16x4v r2 = __builtin_bit_cast(s16x4v, __builtin_amdgcn_ds_read_tr16_b64_v4i16((LAS s16x4v*)(a1 + 8 * SBV_PITCH)));
                const bf16x8v bv = {r1[0], r1[1], r1[2], r1[3], r2[0], r2[1], r2[2], r2[3]};
                if (nb == 0) o0 = __builtin_amdgcn_mfma_f32_32x32x16_bf16(s ? pa1 : pa0, bv, o0, 0, 0, 0); else o1 = __builtin_amdgcn_mfma_f32_32x32x16_bf16(s ? pa1 : pa0, bv, o1, 0, 0, 0);
                asm volatile("" :: "v"(bv), "v"(pa0), "v"(pa1), "v"(o0), "v"(o1)); }
        LDS_WAIT();
        carry += tot;
        if (__all(carry > 150.0f)) break;
    }
    float* YS = (float*)(A.ws + WS_YO) + 3 * YO_STRIDE + ((size_t)b * SEQ + t0) * 256 + h * 64 + r32;
#pragma unroll
    for (int r = 0; r < 16; ++r) { const int qo = (r & 3) + 8 * (r >> 2) + 4 * hi; YS[(size_t)qo * 256] = o0[r]; YS[(size_t)qo * 256 + 32] = o1[r]; }
}

__device__ __forceinline__ void dsa_scores_mfma(ARef A, const WI& w) {
    const _Float16* QIH = (const _Float16*)(A.ws + WS_DQI); const _Float16* KIH = (const _Float16*)(A.ws + WS_DKI);
    const float* DW = (const float*)(A.ws + WS_DW); float* SC = (float*)(A.ws + WS_SC);
    const int col = w.lane & 15, q4 = w.lane >> 4;
    for (int u = w.gw; u < 2048; u += w.NGW) {
        const int pi = u >> 1, par = u & 1, b = pi >> 7, p = pi & 127;
#pragma unroll 1
        for (int side = 0; side < 2; ++side) {
            const int qb = side ? 255 - p : p; const size_t m0 = (size_t)b * SEQ + 16 * qb;
            f16x8 bq[8];
#pragma unroll
            for (int h = 0; h < 8; ++h) bq[h] = *(const f16x8*)(QIH + (m0 + col) * 256 + h * 32 + 8 * q4);
            const float* dw = DW + (m0 + col) * 8; const f32x4 wa = *(const f32x4*)dw, wb = *(const f32x4*)(dw + 4);
            float* srow = SC + (m0 + col) * SEQ + 4 * q4;
            const _Float16* kbase = KIH + ((size_t)b * SEQ + col) * 32 + 8 * q4;
            for (int kp = par; 2 * kp <= qb; kp += 2) {
#pragma unroll
                for (int sub = 0; sub < 2; ++sub) { const int kb = 2 * kp + sub; if (kb > qb) break;
                    const f16x8 ak = *(const f16x8*)(kbase + (size_t)kb * 16 * 32);
                    f32x4 acc = {0.f, 0.f, 0.f, 0.f};
#pragma unroll
                    for (int h = 0; h < 8; ++h) { const f32x4 c = __builtin_amdgcn_mfma_f32_16x16x32_f16(ak, bq[h], (f32x4){0.f, 0.f, 0.f, 0.f}, 0, 0, 0); const float wv = (h < 4) ? wa[h] : wb[h - 4];
                        acc.x += wv * fmaxf(c.x, 0.f); acc.y += wv * fmaxf(c.y, 0.f); acc.z += wv * fmaxf(c.z, 0.f); acc.w += wv * fmaxf(c.w, 0.f); }
                    *(f32x4*)(srow + 16 * kb) = acc + 0.0f; }
            }
        }
    }
}

__device__ __forceinline__ int wave_total_i(int v) {
    v += __builtin_amdgcn_mov_dpp(v, 0xB1, 0xF, 0xF, true);
    v += __builtin_amdgcn_mov_dpp(v, 0x4E, 0xF, 0xF, true);
    v += __builtin_amdgcn_mov_dpp(v, 0x141, 0xF, 0xF, true);
    v += __builtin_amdgcn_mov_dpp(v, 0x140, 0xF, 0xF, true);
    return __builtin_amdgcn_readlane(v, 0) + __builtin_amdgcn_readlane(v, 16) + __builtin_amdgcn_readlane(v, 32) + __builtin_amdgcn_readlane(v, 48);
}
__device__ __forceinline__ unsigned score_key(float f) { const unsigned bits = __float_as_uint(f); return (bits & 0x80000000u) ? ~bits : (bits | 0x80000000u); }
constexpr int VST_PITCH = 144;
typedef unsigned short u16;
__device__ __forceinline__ void dsa_load_scores(ARef A, int m, int lane, f32x4 (&sv)[16]) {
    const int n = (m & (SEQ - 1)) + 1; const float* sc = (const float*)(A.ws + WS_SC) + (size_t)m * SEQ;
#pragma unroll
    for (int j4 = 0; j4 < 16; ++j4) sv[j4] = *(const f32x4*)(sc + ((256 * j4 < n) ? 256 * j4 : 0) + 4 * lane);
}
__device__ __forceinline__ void dsa_select(ARef A, int m, int n, int lane_in, LAS u16* slist, LAS unsigned* bk) {
    int lane = lane_in; asm volatile("" : "+v"(lane));
    if (n <= 256) {
#pragma unroll
        for (int c = 0; c < 4; ++c) { const int idx = lane + 64 * c; slist[idx] = (u16)((idx < n) ? idx : 0); }
        return;
    }
    f32x4 sv[16]; dsa_load_scores(A, m, lane, sv);
    unsigned u[64];
#pragma unroll
    for (int j4 = 0; j4 < 16; ++j4)
#pragma unroll
        for (int i = 0; i < 4; ++i) u[4 * j4 + i] = (256 * j4 + 4 * lane + i < n) ? score_key(sv[j4][i]) : 0u;
    unsigned T = 0u;
    for (int bit = 31; bit >= 16; --bit) { const unsigned cand = T | (1u << bit); int cnt = 0;
#pragma unroll
        for (int j = 0; j < 64; ++j) cnt += (u[j] >= cand) ? 1 : 0;
        if (wave_total_i(cnt) >= 256) T = cand; }
    unsigned long long bkb = 0ull; int chi = 0;
#pragma unroll
    for (int j = 0; j < 64; ++j) { bkb |= (unsigned long long)(((u[j] >> 16) == (T >> 16)) ? 1u : 0u) << j; chi += ((u[j] >> 16) > (T >> 16)) ? 1 : 0; }
    const int cb = wave_total_i(__popcll(bkb)), need = 256 - wave_total_i(chi);
    if (cb <= 64) {
        int pos = __popcll(bkb);
        { const int mine_ = pos;
#pragma unroll
          for (int d = 1; d < 64; d <<= 1) { const int y = __shfl_up(pos, d); if (lane >= d) pos += y; }
          pos -= mine_; }
#pragma unroll
        for (int j = 0; j < 64; ++j) { if ((bkb >> j) & 1ull) { bk[pos] = u[j]; ++pos; } }
        LDS_WAIT();
        const unsigned kx = (lane < cb) ? bk[lane] : 0u;
        for (int bit = 15; bit >= 0; --bit) { const unsigned cand = T | (1u << bit); if (__popcll(__ballot(kx >= cand)) >= need) T = cand; }
        LDS_WAIT();
    } else {
        for (int bit = 15; bit >= 0; --bit) { const unsigned cand = T | (1u << bit); int cnt = 0;
#pragma unroll
            for (int j = 0; j < 64; ++j) cnt += (u[j] >= cand) ? 1 : 0;
            if (wave_total_i(cnt) >= 256) T = cand; }
    }
    unsigned long long gtb = 0ull, eqb = 0ull;
#pragma unroll
    for (int j = 0; j < 64; ++j) { gtb |= (unsigned long long)((u[j] > T) ? 1u : 0u) << j; eqb |= (unsigned long long)((u[j] == T) ? 1u : 0u) << j; }
    const int tgt = wave_total_i(__popcll(gtb)), teq = wave_total_i(__popcll(eqb));
    unsigned long long selb = gtb | eqb;
    if (tgt + teq > 256) {
        const int take = 256 - tgt; int lo = 0;
        for (int bit = 11; bit >= 0; --bit) { const int cand = lo | (1 << bit); const int J4 = cand >> 8; int ni = (cand & 255) - 4 * lane; ni = ni < 0 ? 0 : (ni > 4 ? 4 : ni);
            const int jc = 4 * J4 + ni; const unsigned long long msk = (jc >= 64) ? ~0ull : ((1ull << jc) - 1ull);
            if (wave_total_i(__popcll(eqb & msk)) < take) lo = cand; }
        { const int cand = lo + 1; const int J4 = cand >> 8; int ni = (cand & 255) - 4 * lane; ni = ni < 0 ? 0 : (ni > 4 ? 4 : ni);
          const int jc = (cand >= SEQ) ? 64 : 4 * J4 + ni; const unsigned long long msk = (jc >= 64) ? ~0ull : ((1ull << jc) - 1ull); selb = gtb | (eqb & msk); }
    }
    const int mine = __popcll(selb); int off = mine;
#pragma unroll
    for (int d = 1; d < 64; d <<= 1) { const int y = __shfl_up(off, d); if (lane >= d) off += y; }
    off -= mine;
    while (selb) { const int j = __builtin_ctzll(selb); selb &= selb - 1ull; slist[off] = (u16)(256 * (j >> 2) + 4 * lane + (j & 3)); ++off; }
}
__device__ __forceinline__ void dsa_attend(ARef A, int m, int lane_in, const LAS u16* slist, LAS unsigned char* vbuf) {
    int lane = lane_in; asm volatile("" : "+v"(lane));
    const int b = m >> 12, t = m & (SEQ - 1), n = t + 1, nsel = n < 256 ? n : 256, col = lane & 15, q4 = lane >> 4;
    const bf16* DKB = (const bf16*)(A.ws + WS_DKB) + (size_t)b * SEQ * 64; const bf16* DVB = (const bf16*)(A.ws + WS_DVB) + (size_t)b * SEQ * 64;
    const int vrow = lane >> 3, vpc = lane & 7;
    bf16x8v bq0 = {0, 0, 0, 0, 0, 0, 0, 0}, bq1 = {0, 0, 0, 0, 0, 0, 0, 0};
    if (col < 4) { const bf16* qp = (const bf16*)(A.ws + WS_DQ) + (size_t)m * 256 + col * 64 + 8 * q4; bq0 = *(const bf16x8v*)qp; bq1 = *(const bf16x8v*)(qp + 32); }
    f32x4 lg[16];
#pragma unroll
    for (int hb = 0; hb < 2; ++hb) {
        bf16x8v a0[8], a1[8];
#pragma unroll
        for (int k = 0; k < 8; ++k) { const int s = slist[16 * (8 * hb + k) + col]; const bf16* kr = DKB + (size_t)s * 64 + 8 * q4; a0[k] = *(const bf16x8v*)kr; a1[k] = *(const bf16x8v*)(kr + 32); }
#pragma unroll
        for (int k = 0; k < 8; ++k) { const f32x4 c = __builtin_amdgcn_mfma_f32_16x16x32_bf16(a0[k], bq0, (f32x4){0.f, 0.f, 0.f, 0.f}, 0, 0, 0); lg[8 * hb + k] = __builtin_amdgcn_mfma_f32_16x16x32_bf16(a1[k], bq1, c, 0, 0, 0); }
        __builtin_amdgcn_sched_barrier(0);
    }
    if (nsel < 256) {
#pragma unroll
        for (int kb = 0; kb < 16; ++kb)
#pragma unroll
            for (int r = 0; r < 4; ++r) if (16 * kb + 4 * q4 + r >= nsel) lg[kb][r] = -INFINITY; }
    v4u vr[4];
#pragma unroll
    for (int i = 0; i < 4; ++i) { const int s = slist[vrow + 8 * i]; vr[i] = *(const v4u*)(DVB + (size_t)s * 64 + 8 * vpc); }
    float mx = -INFINITY;
#pragma unroll
    for (int kb = 0; kb < 16; ++kb) mx = fmaxf(fmaxf(mx, fmaxf(lg[kb].x, lg[kb].y)), fmaxf(lg[kb].z, lg[kb].w));
    mx = fmaxf(mx, __shfl_xor(mx, 16)); mx = fmaxf(mx, __shfl_xor(mx, 32));
    float sm = 0.f;
#pragma unroll
    for (int kb = 0; kb < 16; ++kb) { lg[kb].x = __builtin_amdgcn_exp2f(lg[kb].x - mx); lg[kb].y = __builtin_amdgcn_exp2f(lg[kb].y - mx); lg[kb].z = __builtin_amdgcn_exp2f(lg[kb].z - mx); lg[kb].w = __builtin_amdgcn_exp2f(lg[kb].w - mx); sm += (lg[kb].x + lg[kb].y) + (lg[kb].z + lg[kb].w); }
    sm += __shfl_xor(sm, 16); sm += __shfl_xor(sm, 32);
    const float inv = 1.0f / sm;
    bf16x8v pa[8];
#pragma unroll
    for (int i = 0; i < 8; ++i) { const f32x4 x = lg[2 * i] * inv, y = lg[2 * i + 1] * inv;
        pg8::u32x4 wv; wv.x = pg8::cvt_pk_bf16(x.x, x.y); wv.y = pg8::cvt_pk_bf16(x.z, x.w); wv.z = pg8::cvt_pk_bf16(y.x, y.y); wv.w = pg8::cvt_pk_bf16(y.z, y.w);
        pa[i] = __builtin_bit_cast(bf16x8v, wv); }
    f32x4 o[4];
#pragma unroll
    for (int nb = 0; nb < 4; ++nb) o[nb] = (f32x4){0.f, 0.f, 0.f, 0.f};
    const int tj = col >> 2, tc = col & 3;
#pragma unroll
    for (int c = 0; c < 8; ++c) {
        LAS unsigned char* vb = vbuf + (c & 1) * (32 * VST_PITCH);
#pragma unroll
        for (int i = 0; i < 4; ++i) *(LAS v4u*)(vb + (vrow + 8 * i) * VST_PITCH + 16 * vpc) = vr[i];
        if (c < 7) {
#pragma unroll
            for (int i = 0; i < 4; ++i) { const int s = slist[32 * (c + 1) + vrow + 8 * i]; vr[i] = *(const v4u*)(DVB + (size_t)s * 64 + 8 * vpc); } }
        LDS_WAIT();
#pragma unroll
        for (int nb = 0; nb < 4; ++nb) {
            LAS unsigned char* a1 = vb + (4 * q4 + tj) * VST_PITCH + (16 * nb + 4 * tc) * 2;
            const s16x4v r1 = __builtin_bit_cast(s16x4v, __builtin_amdgcn_ds_read_tr16_b64_v4i16((LAS s16x4v*)a1));
            const s16x4v r2 = __builtin_bit_cast(s16x4v, __builtin_amdgcn_ds_read_tr16_b64_v4i16((LAS s16x4v*)(a1 + 16 * VST_PITCH)));
            const bf16x8v bv = {r1[0], r1[1], r1[2], r1[3], r2[0], r2[1], r2[2], r2[3]};
            o[nb] = __builtin_amdgcn_mfma_f32_16x16x32_bf16(pa[c], bv, o[nb], 0, 0, 0); }
    }
    LDS_WAIT();
    if (lane < 16) { float* YD = (float*)(A.ws + WS_YO) + 2 * YO_STRIDE + (size_t)m * 256;
#pragma unroll
        for (int nb = 0; nb < 4; ++nb) { YD[16 * nb + lane] = o[nb].x; YD[64 + 16 * nb + lane] = o[nb].y; YD[128 + 16 * nb + lane] = o[nb].z; YD[192 + 16 * nb + lane] = o[nb].w; } }
}
constexpr int DSA_GR = 1;
__device__ __forceinline__ int dsa_row_of(int batch, int gi, int r) { const int idx = DSA_GR * gi + r, h = idx >> 1; return batch * SEQ + ((idx & 1) ? (SEQ - 1 - h) : h); }
__device__ __forceinline__ void dsa_wave(ARef A, const WI& w, LAS unsigned char* wl, int qi) {
    LAS u16* lists = (LAS u16*)wl; LAS unsigned char* vbuf = wl + 4096; LAS unsigned* bk = (LAS unsigned*)vbuf;
#pragma unroll 1
    for (int kb = 0; kb < NB; ++kb) {
        const int batch = (w.bx + kb) & (NB - 1);
        unsigned* head = (unsigned*)(A.ws + WS_CTL) + CW_DSAQ + 128 * qi + 16 * batch;
        for (;;) {
            int g = 0; if (w.lane == 0) g = (int)atomicAdd(head, 1u);
            g = __builtin_amdgcn_readfirstlane(g);
            if (g >= SEQ / DSA_GR) break;
#pragma unroll 1
            for (int r = 0; r < DSA_GR; ++r) { const int m = dsa_row_of(batch, g, r), n = (m & (SEQ - 1)) + 1; dsa_select(A, m, n, w.lane, lists + r * 256, bk); }
            LDS_WAIT();
#pragma unroll 1
            for (int r = 0; r < DSA_GR; ++r) dsa_attend(A, dsa_row_of(batch, g, r), w.lane, lists + r * 256, vbuf);
        }
    }
}

__device__ __forceinline__ f32x4 head_norm4(f32x4 y, float eps, f32x4 g) {
    const float mean = grp16_sum(sum4(y)) * (1.0f / 64.0f); const f32x4 yc = y - mean;
    const float var = grp16_sum(dot4(yc, yc)) * (1.0f / 64.0f); return yc * (1.0f / sqrtf(var + eps)) * g;
}
template <bool BF> __device__ __forceinline__ f32x4 state_corr(const LAS float* sl, int hh, int r16, const void* pv) {
    const LAS float* r0 = sl + (hh * 64 + 4 * r16) * 64; const int x0 = (4 * r16) & 15;
    f32x4 out = {0.f, 0.f, 0.f, 0.f};
#pragma unroll 2
    for (int k8 = 0; k8 < 8; ++k8) {
        f32x4 pa, pb;
        if (BF) { const v4u x = ((const v4u*)pv)[k8]; pa = (f32x4){bf_lo(x.x), bf_hi(x.x), bf_lo(x.y), bf_hi(x.y)}; pb = (f32x4){bf_lo(x.z), bf_hi(x.z), bf_lo(x.w), bf_hi(x.w)}; }
        else { pa = ((const f32x4*)pv)[2 * k8]; pb = ((const f32x4*)pv)[2 * k8 + 1]; }
#pragma unroll
        for (int i = 0; i < 4; ++i) { const LAS float* rowp = r0 + i * 64; const int xs = (x0 + i) & 15;
            out[i] += dot4(*(const LAS f32x4*)(rowp + 4 * ((2 * k8) ^ xs)), pa) + dot4(*(const LAS f32x4*)(rowp + 4 * ((2 * k8 + 1) ^ xs)), pb); }
    }
    return out;
}
__device__ __forceinline__ void post_row(ARef A, int l, int m, int lane, const LAS float* slw, const LAS float* slr) {
    const float* YO = (const float*)(A.ws + WS_YO); const float* RWA = (const float*)(A.ws + WS_RWA);
    bf16* MX = (bf16*)(A.ws + WS_MIX) + (size_t)m * DM; const int c4 = 4 * lane, hh = lane >> 4, r16 = lane & 15; const size_t o = (size_t)m * 256 + c4;
    { f32x4 y = *(const f32x4*)(YO + o) + state_corr<true>(slr, hh, r16, (const bf16*)(A.ws + WS_PTR) + (size_t)m * 256 + hh * 64);
      y = head_norm4(y, 1e-5f, *(const f32x4*)(A.in[I_RETGN] + l * 256 + c4));
      const v2u gw_ = *(const v2u*)((const bf16*)(A.ws + WS_PB) + (size_t)m * PBW + 768 + c4); const f32x4 g = {bf_lo(gw_.x), bf_hi(gw_.x), bf_lo(gw_.y), bf_hi(gw_.y)};
#pragma unroll
      for (int i = 0; i < 4; ++i) y[i] *= g[i] * sigm(g[i]);
      v2u w; w.x = pk2(y.x, y.y); w.y = pk2(y.z, y.w); *(v2u*)(MX + c4) = w; }
    { f32x4 y = *(const f32x4*)(YO + YO_STRIDE + o) + state_corr<false>(slw, hh, r16, (const float*)(A.ws + WS_PT) + (size_t)m * 256 + hh * 64);
      y = head_norm4(y, 64e-5f, *(const f32x4*)(A.in[I_LN] + l * 256 + c4));
      y = (y + *(const f32x4*)(RWA + 7 * RWA_STRIDE + o)) * *(const f32x4*)(RWA + 6 * RWA_STRIDE + o);
      v2u w; w.x = pk2(y.x, y.y); w.y = pk2(y.z, y.w); *(v2u*)(MX + 256 + c4) = w; }
    { f32x4 y = *(const f32x4*)(YO + 2 * YO_STRIDE + o); const float r = 1.0f / sqrtf(wave_sum(dot4(y, y)) * (1.0f / 256.0f) + 1e-5f);
      y = y * r * *(const f32x4*)(A.in[I_DONORM] + l * 256 + c4);
      v2u w; w.x = pk2(y.x, y.y); w.y = pk2(y.z, y.w); *(v2u*)(MX + 512 + c4) = w; }
    { f32x4 y = *(const f32x4*)(YO + 3 * YO_STRIDE + o); const float r = 1.0f / sqrtf(wave_sum(dot4(y, y)) * (1.0f / 256.0f) + 1e-5f);
      y = y * r * *(const f32x4*)(A.in[I_SONORM] + l * 256 + c4);
      v2u w; w.x = pk2(y.x, y.y); w.y = pk2(y.z, y.w); *(v2u*)(MX + 768 + c4) = w; }
}
__device__ __forceinline__ void ph_post(ARef A, const WI& w, int l) {
    LAS float* slw = (LAS float*)w.lds; LAS float* slr = slw + 16384;
    for (int u = w.vcu; u < NB * NCH * 2; u += w.G) {
        const int b = u >> 5, c = (u >> 1) & 15, half = u & 1;
        __syncthreads();
        for (int e = w.tid; e < 4096; e += NWAVES * 64) { const int hh = e >> 10, v = (e >> 4) & 63, k4 = e & 15;
            const size_t src = ((size_t)((b * 4 + hh) * NCH + c) * 64 + v) * 64 + 4 * k4; const int dst = (hh * 64 + v) * 64 + 4 * (k4 ^ (v & 15));
            *(LAS f32x4*)(slw + dst) = *(const f32x4*)((const float*)(A.ws + WS_SI) + src); *(LAS f32x4*)(slr + dst) = *(const f32x4*)((const float*)(A.ws + WS_SIR) + src); }
        __syncthreads();
        const int tok0 = b * SEQ + c * TCH + half * 128 + w.wave * 16;
        for (int i = 0; i < 16; ++i) post_row(A, l, tok0 + i, w.lane, slw, slr);
    }
}

constexpr int S0_PITCH = 144;
template <int MIXER> __device__ __forceinline__ void post16_head(ARef A, int l, size_t m, int hh, int tk, int fq, const LAS unsigned char* s0) {
    const size_t o = m * 256 + hh * 64 + 8 * fq;
    bf16x8v pb[2];
    if (MIXER == 0) { const bf16* pp = (const bf16*)(A.ws + WS_PTR) + o; pb[0] = *(const bf16x8v*)pp; pb[1] = *(const bf16x8v*)(pp + 32); }
    else { const float* pp = (const float*)(A.ws + WS_PT) + o;
#pragma unroll
        for (int ks = 0; ks < 2; ++ks) { const f32x4 a = *(const f32x4*)(pp + 32 * ks), b = *(const f32x4*)(pp + 32 * ks + 4);
            pg8::u32x4 wv; wv.x = pg8::cvt_pk_bf16(a.x, a.y); wv.y = pg8::cvt_pk_bf16(a.z, a.w); wv.z = pg8::cvt_pk_bf16(b.x, b.y); wv.w = pg8::cvt_pk_bf16(b.z, b.w); pb[ks] = __builtin_bit_cast(bf16x8v, wv); } }
    f32x4 y[4];
    const float* yl = (const float*)(A.ws + WS_YO) + MIXER * YO_STRIDE + o;
#pragma unroll
    for (int mb = 0; mb < 4; ++mb) y[mb] = *(const f32x4*)(yl + 32 * (mb >> 1) + 4 * (mb & 1));
    const float* gw = ((MIXER == 0) ? A.in[I_RETGN] : A.in[I_LN]) + l * 256 + hh * 64 + 8 * fq;
    f32x4 gn[4], e0[4], e1[4];
#pragma unroll
    for (int mb = 0; mb < 4; ++mb) gn[mb] = *(const f32x4*)(gw + 32 * (mb >> 1) + 4 * (mb & 1));
    if (MIXER == 0) {
#pragma unroll
        for (int j = 0; j < 2; ++j) { const v4u gx = *(const v4u*)((const bf16*)(A.ws + WS_PB) + m * PBW + 768 + hh * 64 + 8 * fq + 32 * j);
            e0[2 * j] = (f32x4){bf_lo(gx.x), bf_hi(gx.x), bf_lo(gx.y), bf_hi(gx.y)}; e0[2 * j + 1] = (f32x4){bf_lo(gx.z), bf_hi(gx.z), bf_lo(gx.w), bf_hi(gx.w)}; }
    } else { const float* RWA = (const float*)(A.ws + WS_RWA);
#pragma unroll
        for (int mb = 0; mb < 4; ++mb) { e0[mb] = *(const f32x4*)(RWA + 7 * RWA_STRIDE + o + 32 * (mb >> 1) + 4 * (mb & 1)); e1[mb] = *(const f32x4*)(RWA + 6 * RWA_STRIDE + o + 32 * (mb >> 1) + 4 * (mb & 1)); } }
    const LAS unsigned char* ab = s0 + ((MIXER * 4 + hh) * 64 + 8 * (tk >> 2) + (tk & 3)) * S0_PITCH + 16 * fq;
#pragma unroll
    for (int mb = 0; mb < 4; ++mb)
#pragma unroll
        for (int ks = 0; ks < 2; ++ks) { const bf16x8v af = *(const LAS bf16x8v*)(ab + (32 * (mb >> 1) + 4 * (mb & 1)) * S0_PITCH + 64 * ks); y[mb] = __builtin_amdgcn_mfma_f32_16x16x32_bf16(af, pb[ks], y[mb], 0, 0, 0); }
    float s = (sum4(y[0]) + sum4(y[1])) + (sum4(y[2]) + sum4(y[3])); s += __shfl_xor(s, 16); s += __shfl_xor(s, 32);
    const float mean = s * (1.0f / 64.0f);
#pragma unroll
    for (int mb = 0; mb < 4; ++mb) y[mb] = y[mb] - mean;
    float q = (dot4(y[0], y[0]) + dot4(y[1], y[1])) + (dot4(y[2], y[2]) + dot4(y[3], y[3])); q += __shfl_xor(q, 16); q += __shfl_xor(q, 32);
    const float rs = 1.0f / sqrtf(q * (1.0f / 64.0f) + ((MIXER == 0) ? 1e-5f : 64e-5f));
    bf16* MX = (bf16*)(A.ws + WS_MIX) + m * DM + MIXER * 256 + hh * 64 + 8 * fq;
#pragma unroll
    for (int j = 0; j < 2; ++j) { f32x4 ya = y[2 * j] * rs * gn[2 * j], yb = y[2 * j + 1] * rs * gn[2 * j + 1];
        if (MIXER == 0) {
#pragma unroll
            for (int i = 0; i < 4; ++i) { ya[i] *= e0[2 * j][i] * sigm(e0[2 * j][i]); yb[i] *= e0[2 * j + 1][i] * sigm(e0[2 * j + 1][i]); }
        } else { ya = (ya + e0[2 * j]) * e1[2 * j]; yb = (yb + e0[2 * j + 1]) * e1[2 * j + 1]; }
        v4u wv; wv.x = pk2(ya.x, ya.y); wv.y = pk2(ya.z, ya.w); wv.z = pk2(yb.x, yb.y); wv.w = pk2(yb.z, yb.w); *(v4u*)(MX + 32 * j) = wv; }
}
__device__ __forceinline__ void post16_rms(ARef A, int l, size_t m, int mx, int fq) {
    const float* yp = (const float*)(A.ws + WS_YO) + (size_t)mx * YO_STRIDE + m * 256 + 8 * fq; const float* gw = ((mx == 2) ? A.in[I_DONORM] : A.in[I_SONORM]) + l * 256 + 8 * fq;
    f32x4 y[16];
#pragma unroll
    for (int j = 0; j < 8; ++j) { y[2 * j] = *(const f32x4*)(yp + 32 * j); y[2 * j + 1] = *(const f32x4*)(yp + 32 * j + 4); }
    float q = 0.0f;
#pragma unroll
    for (int j = 0; j < 16; ++j) q += dot4(y[j], y[j]);
    q += __shfl_xor(q, 16); q += __shfl_xor(q, 32);
    const float r = 1.0f / sqrtf(q * (1.0f / 256.0f) + 1e-5f);
    bf16* MX = (bf16*)(A.ws + WS_MIX) + m * DM + mx * 256 + 8 * fq;
#pragma unroll
    for (int j = 0; j < 8; ++j) { const f32x4 ya = y[2 * j] * r * *(const f32x4*)(gw + 32 * j), yb = y[2 * j + 1] * r * *(const f32x4*)(gw + 32 * j + 4);
        v4u wv; wv.x = pk2(ya.x, ya.y); wv.y = pk2(ya.z, ya.w); wv.z = pk2(yb.x, yb.y); wv.w = pk2(yb.z, yb.w); *(v4u*)(MX + 32 * j) = wv; }
}
__device__ __forceinline__ void ph_post16(ARef A, const WI& w, int l) {
    LAS unsigned char* s0 = w.lds;
    for (int u = w.vcu; u < NB * NCH * 2; u += w.G) {
        const int b = u >> 5, c = (u >> 1) & 15, half = u & 1;
        __syncthreads();
#pragma unroll 2
        for (int e = w.tid; e < 4096; e += NWAVES * 64) { const int hd = e >> 9, v = (e >> 3) & 63, k8 = e & 7;
            const float* src = (const float*)(A.ws + ((hd < 4) ? WS_SIR : WS_SI)) + ((size_t)((b * 4 + (hd & 3)) * NCH + c) * 64 + v) * 64 + 8 * k8;
            const f32x4 x0 = *(const f32x4*)src, x1 = *(const f32x4*)(src + 4);
            v4u wv; wv.x = pk2(x0.x, x0.y); wv.y = pk2(x0.z, x0.w); wv.z = pk2(x1.x, x1.y); wv.w = pk2(x1.z, x1.w); *(LAS v4u*)(s0 + (hd * 64 + v) * S0_PITCH + 16 * k8) = wv; }
        __syncthreads();
        int lane = w.lane; asm volatile("" : "+v"(lane));
        const int tk = lane & 15, fq = lane >> 4; const size_t m = (size_t)(b * SEQ + c * TCH + half * 128 + w.wave * 16 + tk);
#pragma unroll 1
        for (int hh = 0; hh < 4; ++hh) post16_head<0>(A, l, m, hh, tk, fq, s0);
#pragma unroll 1
        for (int hh = 0; hh < 4; ++hh) post16_head<1>(A, l, m, hh, tk, fq, s0);
#pragma unroll 1
        for (int mx = 2; mx < 4; ++mx) post16_rms(A, l, m, mx, fq);
    }
}

__device__ __forceinline__ float wave_max_f(float v) {
    v = fmaxf(v, __builtin_bit_cast(float, __builtin_amdgcn_mov_dpp(__builtin_bit_cast(int, v), 0xB1, 0xF, 0xF, true)));
    v = fmaxf(v, __builtin_bit_cast(float, __builtin_amdgcn_mov_dpp(__builtin_bit_cast(int, v), 0x4E, 0xF, 0xF, true)));
    v = fmaxf(v, __builtin_bit_cast(float, __builtin_amdgcn_mov_dpp(__builtin_bit_cast(int, v), 0x141, 0xF, 0xF, true)));
    v = fmaxf(v, __builtin_bit_cast(float, __builtin_amdgcn_mov_dpp(__builtin_bit_cast(int, v), 0x140, 0xF, 0xF, true)));
    const int iv = __builtin_bit_cast(int, v);
    return fmaxf(fmaxf(__builtin_bit_cast(float, __builtin_amdgcn_readlane(iv, 0)), __builtin_bit_cast(float, __builtin_amdgcn_readlane(iv, 16))), fmaxf(__builtin_bit_cast(float, __builtin_amdgcn_readlane(iv, 32)), __builtin_bit_cast(float, __builtin_amdgcn_readlane(iv, 48))));
}
__device__ __forceinline__ void router_stage(ARef A, const WI& w, int l) {
    LAS float* rwl = (LAS float*)w.lds; const float* rw = A.in[I_RW] + (size_t)l * DM * 32;
    for (int e = w.tid; e < DM * 8; e += NWAVES * 64) { const int k = e >> 3, c = e & 7; *(LAS f32x4*)(rwl + k * 32 + 4 * (c ^ ((k >> 2) & 7))) = *(const f32x4*)(rw + (size_t)k * 32 + 4 * c); }
    __syncthreads();
}
__device__ __forceinline__ void router_row(ARef A, int l, int m, int lane, LAS unsigned* hist, const LAS float* rwl, LAS int* texp, bool dry = false) {
    const float* XA = (const float*)(A.ws + WS_XA) + (size_t)m * DM; const float* MOD = (const float*)(A.ws + WS_MOD) + (size_t)(l * 8 + (m >> 12)) * 6144;
    f32x4 v[4]; float ss = 0.0f;
#pragma unroll
    for (int j = 0; j < 4; ++j) { v[j] = *(const f32x4*)(XA + 4 * (lane + 64 * j)); ss += dot4(v[j], v[j]); }
    ss = wave_sum(ss); const float rstd = 1.0f / sqrtf(ss * (1.0f / DM) + 1e-5f);
    const float* g = A.in[I_NFFN] + l * DM; const float* scp = MOD + 4 * 1024; const float* shp = MOD + 3 * 1024;
    emit_h_row(v, rstd, g, scp, shp, (bf16*)(A.ws + WS_H) + (size_t)m * DM, lane);
    float p[32];
#pragma unroll
    for (int e = 0; e < 32; ++e) p[e] = 0.0f;
    const int sw = lane & 7;
#pragma unroll 1
    for (int j = 0; j < 4; ++j) { const int k = 4 * (lane + 64 * j);
        const f32x4 h = *(const f32x4*)(XA + k) * rstd * *(const f32x4*)(g + k) * (1.0f + *(const f32x4*)(scp + k)) + *(const f32x4*)(shp + k);
        const LAS float* row = rwl + k * 32;
#pragma unroll
        for (int i = 0; i < 4; ++i) {
#pragma unroll
            for (int q4 = 0; q4 < 8; ++q4) { const f32x4 r = *(const LAS f32x4*)(row + i * 32 + 4 * (q4 ^ sw)); p[4 * q4] += h[i] * r.x; p[4 * q4 + 1] += h[i] * r.y; p[4 * q4 + 2] += h[i] * r.z; p[4 * q4 + 3] += h[i] * r.w; } } }
    float q16[16], q8[8], q4v[4], q2[2], q1;
    { const bool hb = (lane & 32) != 0;
#pragma unroll
      for (int i = 0; i < 16; ++i) { const float mine = hb ? p[16 + i] : p[i], oth = hb ? p[i] : p[16 + i]; q16[i] = mine + __shfl_xor(oth, 32); } }
    { const bool hb = (lane & 16) != 0;
#pragma unroll
      for (int i = 0; i < 8; ++i) { const float mine = hb ? q16[8 + i] : q16[i], oth = hb ? q16[i] : q16[8 + i]; q8[i] = mine + __shfl_xor(oth, 16); } }
    { const bool hb = (lane & 8) != 0;
#pragma unroll
      for (int i = 0; i < 4; ++i) { const float mine = hb ? q8[4 + i] : q8[i], oth = hb ? q8[i] : q8[4 + i]; q4v[i] = mine + __shfl_xor(oth, 8); } }
    { const bool hb = (lane & 4) != 0;
#pragma unroll
      for (int i = 0; i < 2; ++i) { const float mine = hb ? q4v[2 + i] : q4v[i], oth = hb ? q4v[i] : q4v[2 + i]; q2[i] = mine + __shfl_xor(oth, 4); } }
    { const bool hb = (lane & 2) != 0; const float mine = hb ? q2[1] : q2[0], oth = hb ? q2[0] : q2[1]; q1 = mine + __shfl_xor(oth, 2); }
    q1 += __shfl_xor(q1, 1);
    float lv = q1 + A.in[I_RB][l * 32 + (lane >> 1)];
    float tv[4]; int ti[4];
#pragma unroll
    for (int kk = 0; kk < 4; ++kk) { const float mx = wave_max_f(lv); const unsigned long long msk = __ballot(lv == mx); const int e = msk ? (int)(__builtin_ctzll(msk) >> 1) : kk;
        tv[kk] = mx; ti[kk] = e; if ((lane >> 1) == e) lv = -INFINITY; }
    const float e1 = expf(tv[1] - tv[0]), e2 = expf(tv[2] - tv[0]), e3 = expf(tv[3] - tv[0]); const float inv = 1.0f / (1.0f + e1 + e2 + e3);
    if (lane == 0 && !dry) {
        int* TI = (int*)(A.ws + WS_TOPI) + (size_t)m * 4; float* TW = (float*)(A.ws + WS_TOPW) + (size_t)m * 4;
        TI[0] = ti[0]; TI[1] = ti[1]; TI[2] = ti[2]; TI[3] = ti[3]; texp[0] = ti[0]; texp[1] = ti[1]; texp[2] = ti[2]; texp[3] = ti[3]; TW[0] = inv; TW[1] = e1 * inv; TW[2] = e2 * inv; TW[3] = e3 * inv;
        { unsigned* hg = (unsigned*)hist; atomicAdd(hg + ti[0], 1u); atomicAdd(hg + ti[1], 1u); atomicAdd(hg + ti[2], 1u); atomicAdd(hg + ti[3], 1u); }
    }
}
__device__ __forceinline__ void build_expert_table(ARef A, const WI& w, int l) {
    LAS int* tst = (LAS int*)(w.lds + TST_OFF); LAS int* tab = (LAS int*)(w.lds + TAB_OFF); LAS int* cnt = (LAS int*)(w.lds + CNT_OFF);
    if (w.tid == 0) { const unsigned* gc = (const unsigned*)(A.ws + WS_CTL) + CW_GCNT + 64 * l; int acc = 0;
        for (int e = 0; e < 32; ++e) { const int c = (int)__hip_atomic_load(gc + e, RLX_AGENT); cnt[e] = c; tst[e] = acc; acc += (c + 255) >> 8; }
        tst[32] = acc; tab[0] = acc; }
    __syncthreads();
    if (w.tid < 32) { const int e = w.tid; for (int pm = tst[e]; pm < tst[e + 1]; ++pm) tab[1 + pm] = e; }
    __syncthreads();
}
__device__ __forceinline__ void router_lists(ARef A, const WI& w, int l) {
    LAS unsigned* hist = (LAS unsigned*)(w.lds + HIST_OFF); LAS int* base = (LAS int*)(w.lds + BASE_OFF); LAS int* texp = (LAS int*)(w.lds + TEXP_OFF);
    __syncthreads();
    if (w.tid < 32) { base[w.tid] = (int)atomicAdd((unsigned*)(A.ws + WS_CTL) + CW_GCNT + 64 * l + w.tid, hist[w.tid]); hist[w.tid] = 0u; }
    __syncthreads();
    int* LIST = (int*)(A.ws + WS_LIST); int* PW = (int*)(A.ws + WS_POS);
    int j = 0;
    for (int m = w.gw; m < MTOK; m += w.NGW, ++j) {
        if (w.lane < 4) { const int e = texp[(w.wave * 16 + j) * 4 + w.lane]; const int idx = base[e] + (int)atomicAdd((unsigned*)hist + e, 1u);
            LIST[e * LCAP + idx] = m; PW[(size_t)m * 4 + w.lane] = (e << 20) | idx; } }
}
__device__ __forceinline__ void combine_row(ARef A, int l, int m, int lane, const LAS int* tst, float gscale = 1.0f, float oscale = 1.0f) {
    float* XA = (float*)(A.ws + WS_XA) + (size_t)m * DM; const float* MOD = (const float*)(A.ws + WS_MOD) + (size_t)(l * 8 + (m >> 12)) * 6144;
    const int* PS = (const int*)(A.ws + WS_POS) + (size_t)m * 4; const float* TW = (const float*)(A.ws + WS_TOPW) + (size_t)m * 4;
    const bf16* YS = (const bf16*)(A.ws + WS_XS);
    f32x4 v[4], acc[4];
#pragma unroll
    for (int j = 0; j < 4; ++j) { v[j] = *(const f32x4*)(XA + 4 * (lane + 64 * j)); acc[j] = (f32x4){0.f, 0.f, 0.f, 0.f}; }
#pragma unroll
    for (int k = 0; k < 4; ++k) { const int pe = PS[k]; const int pos = tst[pe >> 20] * 256 + (pe & 0xFFFFF); const float gt = TW[k] * gscale; const v2u* yr = (const v2u*)(YS + (size_t)pos * DM);
#pragma unroll
        for (int j = 0; j < 4; ++j) { const v2u y = yr[lane + 64 * j]; acc[j] += gt * (f32x4){bf_lo(y.x), bf_hi(y.x), bf_lo(y.y), bf_hi(y.y)}; } }
    float ss = 0.0f;
#pragma unroll
    for (int j = 0; j < 4; ++j) { const int kx = 4 * (lane + 64 * j); v[j] += *(const f32x4*)(MOD + 5 * 1024 + kx) * acc[j]; ss += dot4(v[j], v[j]); }
    ss = wave_sum(ss); const float rstd = 1.0f / sqrtf(ss * (1.0f / DM) + 1e-5f);
    if (l + 1 < NLAYER) {
#pragma unroll
        for (int j = 0; j < 4; ++j) *(f32x4*)(XA + 4 * (lane + 64 * j)) = v[j];
        const float* mb = MOD + 8 * 6144;
        emit_h_row(v, rstd, A.in[I_NMIX] + (l + 1) * DM, mb + 1024, mb, (bf16*)(A.ws + WS_H) + (size_t)m * DM, lane);
    } else {
        float* orow = A.out + (size_t)m * DM; const float* gf = A.in[I_NFINAL];
#pragma unroll
        for (int j = 0; j < 4; ++j) { const int kx = 4 * (lane + 64 * j); *(f32x4*)(orow + kx) = v[j] * (rstd * oscale) * *(const f32x4*)(gf + kx); }
    }
}

constexpr int N_LAUNCHES = MK_N_LAUNCHES;
template <int SEL> __global__ void __launch_bounds__(NWAVES * 64, 2) fwd(ArgsH Ah) {
    extern __shared__ __attribute__((aligned(16))) unsigned char lds[];
    (void)Ah;
    const int wave_s = __builtin_amdgcn_readfirstlane((int)threadIdx.x >> 6);
    auto tid_now = [&]() -> int { int ws_ = wave_s; unsigned z_ = 0u; asm volatile("" : "+s"(ws_), "+s"(z_)); return ws_ * 64 + (int)__builtin_amdgcn_mbcnt_hi(~0u, __builtin_amdgcn_mbcnt_lo(~0u, z_)); };
#define TID_NOW() tid_now()
#define MAKE_WI() WI w; { int tz = TID_NOW(); asm volatile("" : "+v"(tz)); int bz = blockIdx.x, gz = gridDim.x; asm volatile("" : "+s"(bz), "+s"(gz)); \
        w.lds = (LAS unsigned char*)lds; w.tid = tz; w.lane = tz & 63; w.wave = __builtin_amdgcn_readfirstlane(tz >> 6); w.G = gz; w.bx = bz; w.vcu = (gz % 8 == 0) ? (bz % 8) * (gz / 8) + bz / 8 : bz; \
        w.gw = w.vcu * NWAVES + w.wave; w.NGW = gz * NWAVES; }
    { const int t0 = threadIdx.x; for (int u = t0; u < (LDS_BYTES - RING_BYTES) / 4; u += NWAVES * 64) ((LAS unsigned*)((LAS unsigned char*)lds + RING_BYTES))[u] = 0u; }
    __syncthreads();
    int lo, hi; { ARef A0 = *kargs(); lo = A0.ph_lo; hi = A0.ph_hi; }
    if (N_LAUNCHES == 1) { ARef A0 = *kargs(); (void)xcd_barrier_post((unsigned*)((gu32*)(A0.ws + WS_CTL) + CW_BAR), (volatile LAS unsigned*)((LAS unsigned char*)lds + MISC_OFF) + 8, TID_NOW()); }
#define GRID_BAR() do { if (N_LAUNCHES == 1) { ARef Ab = *kargs(); XcdBarrier bar_; bar_.bar = (unsigned*)((gu32*)(Ab.ws + WS_CTL) + CW_BAR); bar_.x = xb_xcc_id(); bar_.st = (volatile LAS unsigned*)((LAS unsigned char*)lds + MISC_OFF) + 8; xcd_barrier(bar_, TID_NOW()); } } while (0)
#ifndef TPROBE
#define TPROBE 0
#endif
#if TPROBE
    unsigned long long tp_acc = 0ull;
#define TP_SCALE tp_scale_of(__hip_atomic_load((unsigned*)(A.ws + WS_CTL) + 3, RLX_AGENT))
    auto tp_scale_of = [](unsigned ticks) -> float { const float us = (float)ticks * 0.01f; if (us < 1.0f) return 1.0f; const float q = exp2f(rintf(log2f(us) * 8.0f) * 0.125f); return 1.0f + sqrtf(q * 1e-5f); };
#define TP_BEGIN(kind) unsigned long long tp_t0 = 0ull; if ((kind) == TPROBE) tp_t0 = __builtin_amdgcn_s_memrealtime();
#define TP_END(kind) if ((kind) == TPROBE) { tp_acc += __builtin_amdgcn_s_memrealtime() - tp_t0; }
#define TP_PUBLISH(l) if ((l) == 1 && w.vcu == 0 && w.tid == 0) __hip_atomic_store((unsigned*)(A.ws + WS_CTL) + 3, (unsigned)tp_acc, RLX_AGENT);
#else
#define TP_SCALE 1.0f
#define TP_PUBLISH(l)
#define TP_BEGIN(kind)
#define TP_END(kind)
#endif
#define IN(k) (lo <= (k) && (k) < hi)
#ifndef PHMASK
#define PHMASK 0xffffffffu
#endif
#define KON(k) if constexpr ((SEL < 0 && ((PHMASK >> (k)) & 1u)) || SEL == (k))
#define BOTH(k) (IN(k) && IN((k) + 1))
#ifndef PROBE_REP
#define PROBE_REP 0
#endif
#if PROBE_REP
    int nrep_ = 2; asm volatile("" : "+s"(nrep_));
#define REP(bit) _Pragma("unroll 1") for (int rep_ = 0; rep_ < (((PROBE_REP >> (bit)) & 1) ? nrep_ : 1); ++rep_)
#else
#define REP(bit) for (int rep_ = 0; rep_ < 1; ++rep_)
#endif
#define ring ((PG8_LAS unsigned char*)lds)

    KON(0) if (IN(0)) { ARef A = *kargs(); MAKE_WI(); REP(0) ph_prologue(A, w); if (BOTH(0)) GRID_BAR(); }

#define LAYER_BODY(l) do {\
        const int pb = 1 + l * NPL; \
        KON(1) if (IN(pb + 0)) { ARef A = *kargs(); MAKE_WI(); TP_BEGIN(1) if (l == 0) { REP(15) { ph_norm1(A, w); small_weights_to_f16(A, w); } if (BOTH(pb + 0)) GRID_BAR(); } TP_END(1) } \
        KON(2) if (IN(pb + 1)) { ARef A = *kargs(); MAKE_WI(); TP_BEGIN(2) \
            pg8::Gemm g{(const bf16*)(A.ws + WS_H), (const bf16*)(A.ws + WS_WIN) + (size_t)l * INCP * DM, MTOK, INCP, DM}; pg8::StaticOrder S; S.init(MTOK, INCP, w.G, w.bx); \
            pg8::EpiProj E{(bf16*)(A.ws + WS_PB), (float*)(A.ws + WS_PF)}; \
            REP(1) pg8::gemm_phase<pg8::EpiProj, pg8::StaticOrder, true, true>(ring, g, S, E, w.tid); \
            if (BOTH(pb + 1)) GRID_BAR(); TP_END(2) \
        } \
        KON(3) if (IN(pb + 2)) { ARef A = *kargs(); MAKE_WI(); TP_BEGIN(3) \
            REP(2) { for (int g = w.gw; g < MTOK / 16; g += w.NGW) prep16(A, l, 16 * g, w.lane); } \
            if (BOTH(pb + 2)) GRID_BAR(); TP_END(3) \
        } \
        KON(4) if (IN(pb + 3)) { ARef A = *kargs(); MAKE_WI(); TP_BEGIN(4) \
            REP(3) { for (int tk = 2 * w.vcu; tk < 32 * NCH; tk += 2 * w.G) scan_rwkv_task2(A, w, tk); } \
            REP(13) { for (int tk = w.vcu; tk < 32 * NCH / 2; tk += w.G) scan_ret_task(A, w, tk); } \
            REP(4) { LAS unsigned char* vl = w.lds + w.wave * 4608; for (int it = w.gw; it < 32 * 128; it += w.NGW) sb_tile_mfma(A, it, w.lane, vl); } \
            REP(5) dsa_scores_mfma(A, w); \
            if (BOTH(pb + 3)) GRID_BAR(); TP_END(4) \
        } \
        KON(5) if (IN(pb + 4)) { ARef A = *kargs(); MAKE_WI(); TP_BEGIN(5) \
            if (w.bx < 32) prefix_chain(A, w, w.bx); \
            REP(6) dsa_wave(A, w, w.lds + w.wave * 13312, l + 2 * rep_); \
            REP(14) { if (rep_ && w.bx < 32) prefix_chain(A, w, w.bx); } \
            if (BOTH(pb + 4)) GRID_BAR(); TP_END(5) \
        } \
        KON(6) if (IN(pb + 5)) { ARef A = *kargs(); MAKE_WI(); TP_BEGIN(6) \
            REP(7) ph_post16(A, w, l); \
            if (BOTH(pb + 5)) GRID_BAR(); TP_END(6) \
        } \
        KON(7) if (IN(pb + 6)) { ARef A = *kargs(); MAKE_WI(); TP_BEGIN(7) \
            pg8::Gemm g{(const bf16*)(A.ws + WS_MIX), (const bf16*)(A.ws + WS_WOUT) + (size_t)l * DM * DM, MTOK, DM, DM}; pg8::StaticOrder S; S.init(MTOK, DM, w.G, w.bx); \
            pg8::EpiRes E{l == 0 ? A.in[I_X] : (const float*)(A.ws + WS_XA), (float*)(A.ws + WS_XA), (const float*)(A.ws + WS_MOD) + (size_t)l * 8 * 6144 + 2 * 1024}; \
            REP(16) { pg8::EpiRes E2 = E; if (rep_ && l == 1) E2.gate = (const float*)(A.ws + WS_CTL + 512 * 1024); pg8::gemm_phase<pg8::EpiRes, pg8::StaticOrder, true, true>(ring, g, S, E2, w.tid); } \
            if (BOTH(pb + 6)) GRID_BAR(); TP_END(7) \
        } \
        KON(8) if (IN(pb + 7)) { ARef A = *kargs(); MAKE_WI(); TP_BEGIN(8) \
            { LAS unsigned* hist = (LAS unsigned*)(w.lds + HIST_OFF); LAS int* texp = (LAS int*)(w.lds + TEXP_OFF); if (w.tid < 32) hist[w.tid] = 0u; router_stage(A, w, l); \
            REP(10) { int j_ = 0; for (int m = w.gw; m < MTOK; m += w.NGW, ++j_) router_row(A, l, m, w.lane, hist, (const LAS float*)w.lds, texp + (w.wave * 16 + j_) * 4, rep_ != 0); } \
            router_lists(A, w, l); } \
            if (BOTH(pb + 7)) GRID_BAR(); TP_END(8) \
        } \
        KON(10) if (IN(pb + 8)) { ARef A = *kargs(); MAKE_WI(); TP_BEGIN(10) \
            build_expert_table(A, w, l); \
            pg8::Gemm g{(const bf16*)(A.ws + WS_H), (const bf16*)(A.ws + WS_W1) + (size_t)l * NEXP * 2048 * DM, MOE_ROWS, NEXP * 2048, DM}; \
            pg8::MoeOrder S{(const PG8_LAS int*)(w.lds + TAB_OFF), 8, w.G, w.vcu, (const PG8_LAS int*)(w.lds + TST_OFF), (const PG8_LAS int*)(w.lds + CNT_OFF), (const int*)(A.ws + WS_LIST)}; \
            pg8::EpiSwiglu E{(bf16*)(A.ws + WS_ACT), A.in[I_MB1] + (size_t)l * NEXP * 2048}; \
            REP(8) { if (PROBE_REP & (1 << 20)) { if (rep_) pg8::gemm_phase<pg8::EpiNull, pg8::MoeOrder, true, true, true>(ring, g, S, pg8::EpiNull{}, w.tid); else pg8::gemm_phase<pg8::EpiSwiglu, pg8::MoeOrder, true, true, true>(ring, g, S, E, w.tid); } else pg8::gemm_phase<pg8::EpiSwiglu, pg8::MoeOrder, true, true, true>(ring, g, S, E, w.tid); } \
            if (BOTH(pb + 8)) GRID_BAR(); TP_END(10) \
        } \
        KON(11) if (IN(pb + 9)) { ARef A = *kargs(); MAKE_WI(); TP_BEGIN(11) \
            build_expert_table(A, w, l); \
            pg8::Gemm g{(const bf16*)(A.ws + WS_ACT), (const bf16*)(A.ws + WS_W2) + (size_t)l * NEXP * DM * DM, MOE_ROWS, NEXP * DM, DM}; \
            pg8::MoeOrder S{(const PG8_LAS int*)(w.lds + TAB_OFF), 4, w.G, w.vcu, (const PG8_LAS int*)(w.lds + TST_OFF), (const PG8_LAS int*)(w.lds + CNT_OFF), (const int*)(A.ws + WS_LIST)}; \
            pg8::EpiY E{(bf16*)(A.ws + WS_XS), A.in[I_MB2] + (size_t)l * NEXP * DM}; \
            REP(9) pg8::gemm_phase<pg8::EpiY, pg8::MoeOrder, true, true>(ring, g, S, E, w.tid); \
            TP_PUBLISH(l) \
            if (BOTH(pb + 9)) GRID_BAR(); TP_END(11) \
        } \
        KON(12) if (IN(pb + 10)) { ARef A = *kargs(); MAKE_WI(); TP_BEGIN(12) \
            build_expert_table(A, w, l); \
            REP(12) for (int m = w.gw; m < MTOK; m += w.NGW) combine_row(A, l, m, w.lane, (const LAS int*)(w.lds + TST_OFF), (rep_ && l == 0) ? 0.0f : 1.0f, TP_SCALE); \
            if (BOTH(pb + 10)) GRID_BAR(); TP_END(12) \
        } \
    } while (0)
    LAYER_BODY(0);
    LAYER_BODY(1);
#undef LAYER_BODY
#undef IN
#undef ring
#undef MAKE_WI
#undef TID_NOW
#undef GRID_BAR
#undef KON
#undef BOTH
}


#if MK_N_LAUNCHES != 1
template <int K> static void launch_one(int grid, hipStream_t stream, const ArgsH& a) {
    static bool attr = false;
    if (!attr) { (void)hipFuncSetAttribute((const void*)fwd<K>, hipFuncAttributeMaxDynamicSharedMemorySize, LDS_BYTES); attr = true; }
    hipLaunchKernelGGL(fwd<K>, dim3(grid), dim3(NWAVES * 64), LDS_BYTES, stream, a);
}
static void launch_kind(int kind, int grid, hipStream_t stream, const ArgsH& a) {
    switch (kind) {
        case 0: launch_one<0>(grid, stream, a); break; case 1: launch_one<1>(grid, stream, a); break; case 2: launch_one<2>(grid, stream, a); break;
        case 3: launch_one<3>(grid, stream, a); break; case 4: launch_one<4>(grid, stream, a); break; case 5: launch_one<5>(grid, stream, a); break;
        case 6: launch_one<6>(grid, stream, a); break; case 7: launch_one<7>(grid, stream, a); break; case 8: launch_one<8>(grid, stream, a); break;
        case 9: launch_one<9>(grid, stream, a); break; case 10: launch_one<10>(grid, stream, a); break; case 11: launch_one<11>(grid, stream, a); break;
        default: launch_one<12>(grid, stream, a); break;
    }
}
#endif
extern "C" void kernel_launch(void* const* d_in, const int* in_sizes, int n_in, void* d_out, int out_size, void* d_ws, size_t ws_size, hipStream_t stream) {
    static int grid = 0;
    if (grid == 0) {
        if (n_in != N_IN || out_size != MTOK * DM || ws_size < WS_END) { fprintf(stderr, "kernel_launch: unexpected shapes (n_in %d, out %d, ws %zu)\n", n_in, out_size, ws_size); grid = -1; return; }
        int dev = 0, cus = 0;
        if (hipGetDevice(&dev) != hipSuccess || hipDeviceGetAttribute(&cus, hipDeviceAttributeMultiprocessorCount, dev) != hipSuccess) { grid = -1; return; }
#if MK_N_LAUNCHES == 1
        {
            if (hipFuncSetAttribute((const void*)fwd<-1>, hipFuncAttributeMaxDynamicSharedMemorySize, LDS_BYTES) != hipSuccess) { fprintf(stderr, "kernel_launch: hipFuncSetAttribute failed\n"); grid = -1; return; }
            int per_cu = 0;
            if (hipOccupancyMaxActiveBlocksPerMultiprocessor(&per_cu, (const void*)fwd<-1>, NWAVES * 64, LDS_BYTES) != hipSuccess || per_cu < 1) fprintf(stderr, "kernel_launch: occupancy query says %d\n", per_cu);
            (void)hipGetLastError();
        }
#endif
        grid = cus;
    }
    if (grid < 0) return;
    (void)in_sizes;
    if (hipMemsetAsync((char*)d_ws + WS_CTL, 0, CTL_ZERO_BYTES, stream) != hipSuccess) return;
    ArgsH a{};
    for (int i = 0; i < N_IN; ++i) a.in[i] = (const float*)d_in[i];
    a.out = (float*)d_out; a.ws = (unsigned char*)d_ws;
    for (int f = 0; f < 44; ++f) a.invf[f] = (f < 32) ? pow(10000.0, -(double)f / 32.0) : (f < 40) ? pow(500000.0, -(double)(f - 32) / 8.0) : pow(500000.0, -(double)(f - 40) / 4.0);
#if MK_N_LAUNCHES == 1
    a.ph_lo = 0; a.ph_hi = NPHASE; a.li = 0;
    hipLaunchKernelGGL(fwd<-1>, dim3(grid), dim3(NWAVES * 64), LDS_BYTES, stream, a);
#else
    {
        for (int p = 0; p < NPHASE; ++p) {
            if (p == 1 + NPL) continue;
            a.ph_lo = p; a.ph_hi = p + 1; a.li = p;
            static const int kinds_[NPL] = {1, 2, 3, 4, 5, 6, 7, 8, 10, 11, 12};
            const int kind = (p == 0) ? 0 : kinds_[(p - 1) % NPL];
            launch_kind(kind, grid, stream, a);
        }
    }
#endif
}
```

```cpp
#include <hip/hip_runtime.h>
#include <cstdio>
#include <cstdint>
#include <cmath>

#ifndef MK_N_LAUNCHES
#define MK_N_LAUNCHES 1
#endif

namespace pg8 {
#define PG8_LAS __attribute__((address_space(3)))
typedef unsigned short bf16_t;
typedef short bf16x8 __attribute__((ext_vector_type(8)));
typedef float f32x4 __attribute__((ext_vector_type(4)));
typedef unsigned u32x4 __attribute__((ext_vector_type(4)));
typedef unsigned u32x2 __attribute__((ext_vector_type(2)));
constexpr int BM = 256, BK = 64, HALF = 128, HTB = HALF * BK * 2  , STAGE_BYTES = 8 * HTB, NXCD = 8, WGM = 8;

__host__ __device__ __forceinline__ int lds_byte(int r, int c) { const int st = (r >> 4) * 2 + (c >> 5), rr = r & 15, cc = c & 31, ob = rr * 64 + cc * 2; return st * 1024 + (ob ^ (((ob >> 9) & 1) << 5)); }
__host__ __device__ __forceinline__ void stage_rc(int b, int& R, int& C) { const int st = b / 1024, sb = b % 1024, swz = sb ^ (((sb >> 9) & 1) << 5); R = (st >> 1) * 16 + swz / 64; C = (st & 1) * 32 + (swz % 64) / 2; }
__host__ __device__ __forceinline__ int perm32(int rho) { const int n = rho >> 4, i = rho & 15; return 8 * (i >> 2) + 4 * n + (i & 3); }

struct Unit { int pm, pn; };
struct Gemm { const bf16_t* A; const bf16_t* Bt; int M, N, K; };

struct StaticOrder {
    int nM, nN, nwg, G, c;
    __host__ __device__ void init(int M, int N, int G_, int c_) { nM = M / BM; nN = N / BM; nwg = nM * nN; G = G_; c = c_; }
    __host__ __device__ bool next(int i, Unit& u) const {
        const long L = (long)i * G + c; if (L >= nwg) return false;
        int wgid = (int)L; { const int q = nwg / NXCD, r = nwg % NXCD, xcd = wgid % NXCD, off = wgid / NXCD; wgid = (xcd < r ? xcd * (q + 1) : r * (q + 1) + (xcd - r) * q) + off; }
        const int nig = WGM * nN, gid = wgid / nig, fm = gid * WGM, gsz = (nM - fm) < WGM ? (nM - fm) : WGM;
        u.pm = fm + ((wgid % nig) % gsz); u.pn = (wgid % nig) / gsz; return true;
    }
    __device__ __forceinline__ void a_ready(const Unit&) const {}
    __device__ __forceinline__ void done(const Unit&) const {}
};
__device__ __forceinline__ unsigned cvt_pk_bf16(float lo, float hi) { unsigned r; asm volatile("v_cvt_pk_bf16_f32 %0, %1, %2" : "=v"(r) : "v"(lo), "v"(hi)); return r; }
struct EpiF32 {
    static constexpr bool PERM = false, AFTER_DRAIN = false;
    float* C; int ldc;
    __device__ __forceinline__ void operator()(const f32x4 (&acc)[2][2][4][2], const Unit& u, int wr, int wc, int fr, int fq) const {
        const int row0 = u.pm * BM + wr * 64 + fr, col0 = u.pn * BM + wc * 32 + 4 * fq;
#pragma unroll
        for (int ai = 0; ai < 2; ++ai)
#pragma unroll
            for (int m = 0; m < 4; ++m) { float* rowp = C + (size_t)(row0 + ai * HALF + m * 16) * ldc + col0;
#pragma unroll
                for (int bj = 0; bj < 2; ++bj)
#pragma unroll
                    for (int n = 0; n < 2; ++n) *(f32x4*)(rowp + bj * HALF + n * 16) = acc[ai][bj][m][n]; }
    }
};
struct EpiNull {
    static constexpr bool PERM = true, AFTER_DRAIN = false;
    __device__ __forceinline__ void operator()(const f32x4 (&acc)[2][2][4][2], const Unit&, int, int, int, int) const {
#pragma unroll
        for (int ai = 0; ai < 2; ++ai)
#pragma unroll
            for (int bj = 0; bj < 2; ++bj) asm volatile("" :: "v"(acc[ai][bj][0][0]), "v"(acc[ai][bj][0][1]), "v"(acc[ai][bj][1][0]), "v"(acc[ai][bj][1][1]), "v"(acc[ai][bj][2][0]), "v"(acc[ai][bj][2][1]), "v"(acc[ai][bj][3][0]), "v"(acc[ai][bj][3][1]));
    }
};
struct EpiProj {
    static constexpr bool PERM = true, AFTER_DRAIN = false;
    bf16_t* PB; float* PF;
    __device__ __forceinline__ void operator()(const f32x4 (&acc)[2][2][4][2], const Unit& u, int wr, int wc, int fr, int fq) const {
        const int row0 = u.pm * BM + wr * 64 + fr;
        if (u.pn < 7) { const int c0 = u.pn * BM + wc * 32 + 8 * fq;
#pragma unroll
            for (int ai = 0; ai < 2; ++ai)
#pragma unroll
                for (int m = 0; m < 4; ++m) { bf16_t* rowp = PB + (size_t)(row0 + ai * HALF + m * 16) * 1792 + c0;
#pragma unroll
                    for (int bj = 0; bj < 2; ++bj) { const f32x4 v0 = acc[ai][bj][m][0], v1 = acc[ai][bj][m][1];
                        u32x4 w; w.x = cvt_pk_bf16(v0[0], v0[1]); w.y = cvt_pk_bf16(v0[2], v0[3]); w.z = cvt_pk_bf16(v1[0], v1[1]); w.w = cvt_pk_bf16(v1[2], v1[3]);
                        *(u32x4*)(rowp + bj * HALF) = w; } }
        } else { const int c0 = (u.pn - 7) * BM + wc * 32 + 8 * fq;
#pragma unroll
            for (int ai = 0; ai < 2; ++ai)
#pragma unroll
                for (int m = 0; m < 4; ++m) { float* rowp = PF + (size_t)(row0 + ai * HALF + m * 16) * 1280 + c0;
#pragma unroll
                    for (int bj = 0; bj < 2; ++bj) { *(f32x4*)(rowp + bj * HALF) = acc[ai][bj][m][0]; *(f32x4*)(rowp + bj * HALF + 4) = acc[ai][bj][m][1]; } }
        }
    }
};
struct EpiRes {
    static constexpr bool PERM = false, AFTER_DRAIN = false;
    const float* xin; float* xout; const float* gate;
    __device__ __forceinline__ void operator()(const f32x4 (&acc)[2][2][4][2], const Unit& u, int wr, int wc, int fr, int fq) const {
        const int row0 = u.pm * BM + wr * 64 + fr, col0 = u.pn * BM + wc * 32 + 4 * fq;
        const float* gp = gate + (size_t)((u.pm * BM) >> 12) * 6144 + col0;
        f32x4 gv[2][2];
#pragma unroll
        for (int bj = 0; bj < 2; ++bj)
#pragma unroll
            for (int n = 0; n < 2; ++n) gv[bj][n] = *(const f32x4*)(gp + bj * HALF + n * 16);
#pragma unroll
        for (int ai = 0; ai < 2; ++ai)
#pragma unroll
            for (int m = 0; m < 4; ++m) { const size_t ro = (size_t)(row0 + ai * HALF + m * 16) * 1024 + col0;
#pragma unroll
                for (int bj = 0; bj < 2; ++bj)
#pragma unroll
                    for (int n = 0; n < 2; ++n) { const f32x4 xv = *(const f32x4*)(xin + ro + bj * HALF + n * 16); *(f32x4*)(xout + ro + bj * HALF + n * 16) = xv + gv[bj][n] * acc[ai][bj][m][n]; } }
    }
};
__device__ __forceinline__ float swiglu1(float glu, float lin) {
    glu = fminf(glu, 7.0f); lin = fminf(fmaxf(lin, -7.0f), 7.0f);
    return glu * (1.0f / (1.0f + __expf(-1.702f * glu))) * (lin + 1.0f);
}
struct EpiSwiglu {
    static constexpr bool PERM = true, AFTER_DRAIN = false;
    bf16_t* O; const float* b1;
    __device__ __forceinline__ void operator()(const f32x4 (&acc)[2][2][4][2], const Unit& u, int wr, int wc, int fr, int fq) const {
        const int e = u.pn >> 3, j = u.pn & 7, row0 = u.pm * BM + wr * 64 + fr, c0 = 128 * j + wc * 32 + 8 * fq;
        const float* bp = b1 + (size_t)e * 2048 + c0;
        f32x4 bg[2], bl[2];
#pragma unroll
        for (int n = 0; n < 2; ++n) { bg[n] = *(const f32x4*)(bp + 4 * n); bl[n] = *(const f32x4*)(bp + 1024 + 4 * n); }
#pragma unroll
        for (int ai = 0; ai < 2; ++ai)
#pragma unroll
            for (int m = 0; m < 4; ++m) { bf16_t* rowp = O + (size_t)(row0 + ai * HALF + m * 16) * 1024 + c0;
                const f32x4 g0 = acc[ai][0][m][0] + bg[0], g1 = acc[ai][0][m][1] + bg[1], l0 = acc[ai][1][m][0] + bl[0], l1 = acc[ai][1][m][1] + bl[1];
                u32x4 w;
                w.x = cvt_pk_bf16(swiglu1(g0[0], l0[0]), swiglu1(g0[1], l0[1])); w.y = cvt_pk_bf16(swiglu1(g0[2], l0[2]), swiglu1(g0[3], l0[3]));
                w.z = cvt_pk_bf16(swiglu1(g1[0], l1[0]), swiglu1(g1[1], l1[1])); w.w = cvt_pk_bf16(swiglu1(g1[2], l1[2]), swiglu1(g1[3], l1[3]));
                *(u32x4*)rowp = w; }
    }
};
struct EpiY {
    static constexpr bool PERM = true, AFTER_DRAIN = false;
    bf16_t* O; const float* b2;
    __device__ __forceinline__ void operator()(const f32x4 (&acc)[2][2][4][2], const Unit& u, int wr, int wc, int fr, int fq) const {
        const int e = u.pn >> 2, j = u.pn & 3, row0 = u.pm * BM + wr * 64 + fr, c0 = 256 * j + wc * 32 + 8 * fq;
        const float* bp = b2 + (size_t)e * 1024 + c0;
        f32x4 bv[2][2];
#pragma unroll
        for (int bj = 0; bj < 2; ++bj)
#pragma unroll
            for (int n = 0; n < 2; ++n) bv[bj][n] = *(const f32x4*)(bp + bj * HALF + 4 * n);
#pragma unroll
        for (int ai = 0; ai < 2; ++ai)
#pragma unroll
            for (int m = 0; m < 4; ++m) { bf16_t* rowp = O + (size_t)(row0 + ai * HALF + m * 16) * 1024 + c0;
#pragma unroll
                for (int bj = 0; bj < 2; ++bj) { const f32x4 v0 = acc[ai][bj][m][0] + bv[bj][0], v1 = acc[ai][bj][m][1] + bv[bj][1];
                    u32x4 w; w.x = cvt_pk_bf16(v0[0], v0[1]); w.y = cvt_pk_bf16(v0[2], v0[3]); w.z = cvt_pk_bf16(v1[0], v1[1]); w.w = cvt_pk_bf16(v1[2], v1[3]);
                    *(u32x4*)(rowp + bj * HALF) = w; } }
    }
};
struct MoeOrder {
    const PG8_LAS int* tab; int NJ, G, c;
    __device__ __forceinline__ bool next(int i, Unit& u) const {
        const int T = tab[0]; const long L = (long)i * G + c; if (L >= (long)T * NJ) return false;
        const int pm = (int)(L / NJ), j = (int)(L % NJ);
        u.pm = pm; u.pn = tab[1 + pm] * NJ + j; return true;
    }
    __device__ __forceinline__ void a_ready(const Unit&) const {}
    __device__ __forceinline__ void done(const Unit&) const {}
    const PG8_LAS int* tst; const PG8_LAS int* cnt; const int* list;
    __device__ __forceinline__ int row_of(const Unit& u, int r) const { const int e = tab[1 + u.pm], idx = 256 * (u.pm - tst[e]) + r; return (idx < cnt[e]) ? list[e * 32768 + idx] : 0; }
};

template <class Epi, class Sched, bool ALIGN_EPI = false, bool SP2 = false, bool GATHER = false>
__device__ __forceinline__ void gemm_phase(PG8_LAS unsigned char* lds, const Gemm g, const Sched& S, const Epi& E, int tid_in) {
    int tid_ = tid_in; asm volatile("" : "+v"(tid_));
    const int tid = tid_, wid = __builtin_amdgcn_readfirstlane(tid >> 6), lane = tid & 63, wr = wid >> 2, wc = wid & 3, fr = lane & 15, fq = lane >> 4;
    const int K = g.K, nt = K / BK;
    unsigned voffA[2], voffB[2];
#pragma unroll
    for (int i = 0; i < 2; ++i) { int R, C; stage_rc(tid * 16 + i * 8192, R, C); const int Rb = Epi::PERM ? ((R & ~31) + perm32(R & 31)) : R;
        voffA[i] = (unsigned)(R * K + C) * 2u; voffB[i] = (unsigned)(Rb * K + C) * 2u; }
    static_assert(!GATHER || SP2, "gathered A rows: only the two-super-phase loop is wired");
    unsigned cvo[2][2], nvo[2][2];
#define PG8_ROWS(dst, u_) do { _Pragma("unroll") for (int h_ = 0; h_ < 2; ++h_) _Pragma("unroll") for (int i_ = 0; i_ < 2; ++i_) { int R_, C_; stage_rc(tid * 16 + i_ * 8192, R_, C_); dst[h_][i_] = (unsigned)(S.row_of(u_, h_ * HALF + R_) * K + C_) * 2u; } } while (0)
#define PG8_STAGE_A(bufoff, gbase, half, nx) do { if constexpr (GATHER) { unsigned o_[2]; o_[0] = (nx) ? nvo[half][0] : cvo[half][0]; o_[1] = (nx) ? nvo[half][1] : cvo[half][1]; PG8_STAGE(bufoff, gbase, o_); } else { PG8_STAGE(bufoff, (gbase) + (half) * hstep, voffA); } } while (0)
    const size_t kstep = (size_t)(BK * 2);
    const size_t hstep = (size_t)HALF * K * 2;
    const size_t tstep = 2 * hstep;
    const unsigned ldsw = (unsigned)wid * 1024u;
    const int aoff = lds_byte(wr * 64 + fr, fq * 8), boff = lds_byte(wc * 32 + fr, fq * 8);
#define PG8_SA(b, h) (((b) * 2 + (h)) * HTB)
#define PG8_SB(b, h) ((4 + (b) * 2 + (h)) * HTB)
#define PG8_STAGE(bufoff, gbase, voff) do { _Pragma("unroll") for (int _i = 0; _i < 2; ++_i) \
        __builtin_amdgcn_global_load_lds((const unsigned*)((const char*)(gbase) + (voff)[_i]), (PG8_LAS unsigned*)(lds + (bufoff) + ldsw + _i * 8192), 16, 0, 0); } while (0)
#define PG8_LDA(dst, b, h) do { _Pragma("unroll") for (int m = 0; m < 4; ++m) _Pragma("unroll") for (int k = 0; k < 2; ++k) dst[m][k] = *(const PG8_LAS bf16x8*)(lds + PG8_SA(b, h) + aoff + m * 2048 + k * 1024); } while (0)
#define PG8_LDB(dst, b, h) do { _Pragma("unroll") for (int n = 0; n < 2; ++n) _Pragma("unroll") for (int k = 0; k < 2; ++k) dst[n][k] = *(const PG8_LAS bf16x8*)(lds + PG8_SB(b, h) + boff + n * 2048 + k * 1024); } while (0)
#define PG8_MMA(ai, bj, At, Bt) do { __builtin_amdgcn_s_setprio(1); _Pragma("unroll") for (int m = 0; m < 4; ++m) _Pragma("unroll") for (int n = 0; n < 2; ++n) _Pragma("unroll") for (int k = 0; k < 2; ++k) \
        acc[ai][bj][m][n] = __builtin_amdgcn_mfma_f32_16x16x32_bf16(Bt[n][k], At[m][k], acc[ai][bj][m][n], 0, 0, 0); __builtin_amdgcn_s_setprio(0); } while (0)
#define PG8_WAIT_V(n) asm volatile("s_waitcnt vmcnt(" #n ")" ::: "memory")
#define PG8_WAIT_L(n) asm volatile("s_waitcnt lgkmcnt(" #n ")" ::: "memory")
#define PG8_BAR __builtin_amdgcn_s_barrier()
#define PG8_SCHED __builtin_amdgcn_sched_barrier(0)
    Unit cur, nxt; int ui = 0;
    if (!S.next(0, cur)) return;
    f32x4 acc[2][2][4][2];
#pragma unroll
    for (int a = 0; a < 2; ++a)
#pragma unroll
        for (int b = 0; b < 2; ++b)
#pragma unroll
            for (int m = 0; m < 4; ++m)
#pragma unroll
                for (int n = 0; n < 2; ++n) acc[a][b][m][n] = (f32x4){0.f, 0.f, 0.f, 0.f};
    bf16x8 At[4][2], B0[2][2], B1[2][2];
    const char* cA = (const char*)g.A + (GATHER ? (size_t)0 : (size_t)cur.pm * tstep); const char* cB = (const char*)g.Bt + (size_t)cur.pn * tstep;
    if constexpr (GATHER) { PG8_ROWS(cvo, cur); }
    S.a_ready(cur);
    if constexpr (SP2) {
        PG8_STAGE(PG8_SB(0, 0), cB, voffB); PG8_STAGE(PG8_SB(0, 1), cB + hstep, voffB); PG8_STAGE_A(PG8_SA(0, 0), cA, 0, false); PG8_STAGE_A(PG8_SA(0, 1), cA, 1, false);
        if (wr == 1) PG8_BAR;
        PG8_WAIT_V(2); PG8_BAR;
        PG8_STAGE(PG8_SB(1, 0), cB + kstep, voffB); PG8_STAGE_A(PG8_SA(1, 0), cA + kstep, 0, false); PG8_STAGE(PG8_SB(1, 1), cB + hstep + kstep, voffB);
        PG8_WAIT_V(6); PG8_BAR;
    } else {
        PG8_STAGE(PG8_SB(0, 0), cB, voffB); PG8_STAGE(PG8_SA(0, 0), cA, voffA); PG8_STAGE(PG8_SB(0, 1), cB + hstep, voffB); PG8_STAGE(PG8_SA(0, 1), cA + hstep, voffA);
        if (wr == 1) PG8_BAR;
        PG8_WAIT_V(4); PG8_BAR;
        PG8_STAGE(PG8_SB(1, 0), cB + kstep, voffB); PG8_STAGE(PG8_SA(1, 0), cA + kstep, voffA); PG8_STAGE(PG8_SB(1, 1), cB + hstep + kstep, voffB);
        PG8_WAIT_V(6); PG8_BAR;
    }
    for (;;) {
        const bool has_next = S.next(ui + 1, nxt);
        const char* nA = GATHER ? (const char*)g.A : (has_next ? (const char*)g.A + (size_t)nxt.pm * tstep : cA); const char* nB = has_next ? (const char*)g.Bt + (size_t)nxt.pn * tstep : cB;
        if constexpr (GATHER) { if (has_next) { PG8_ROWS(nvo, nxt); } else { _Pragma("unroll") for (int h_ = 0; h_ < 2; ++h_) { nvo[h_][0] = cvo[h_][0]; nvo[h_][1] = cvo[h_][1]; } } }
        for (int t = 0; t < nt; t += 2) {
            const bool last = (t == nt - 2);
            const char* a1 = cA + (size_t)(t + 1) * kstep;
            const char* a2 = last ? nA : cA + (size_t)(t + 2) * kstep; const char* b2 = last ? nB : cB + (size_t)(t + 2) * kstep;
            const char* a3 = a2 + kstep; const char* b3 = b2 + kstep;
            if (last && has_next) S.a_ready(nxt);
            if constexpr (SP2) {
            PG8_LDB(B0, 0, 0); PG8_LDB(B1, 0, 1); PG8_SCHED; PG8_LDA(At, 0, 0); PG8_STAGE_A(PG8_SA(1, 1), a1, 1, false);
            PG8_WAIT_V(8); PG8_WAIT_L(0); PG8_BAR; PG8_MMA(0, 0, At, B0); PG8_MMA(0, 1, At, B1); PG8_BAR; PG8_SCHED;
            PG8_LDA(At, 0, 1); PG8_STAGE(PG8_SB(0, 0), b2, voffB); PG8_STAGE(PG8_SB(0, 1), b2 + hstep, voffB); PG8_STAGE_A(PG8_SA(0, 0), a2, 0, last);
            PG8_WAIT_V(8); PG8_WAIT_L(0); PG8_BAR; PG8_MMA(1, 0, At, B0); PG8_MMA(1, 1, At, B1); PG8_BAR; PG8_SCHED;
            PG8_LDB(B0, 1, 0); PG8_LDB(B1, 1, 1); PG8_SCHED; PG8_LDA(At, 1, 0); PG8_STAGE_A(PG8_SA(0, 1), a2, 1, last);
            PG8_WAIT_V(8); PG8_WAIT_L(0); PG8_BAR; PG8_MMA(0, 0, At, B0); PG8_MMA(0, 1, At, B1); PG8_BAR; PG8_SCHED;
            PG8_LDA(At, 1, 1); PG8_STAGE(PG8_SB(1, 0), b3, voffB); PG8_STAGE(PG8_SB(1, 1), b3 + hstep, voffB); PG8_STAGE_A(PG8_SA(1, 0), a3, 0, last);
            PG8_WAIT_V(8); PG8_WAIT_L(0); PG8_BAR; PG8_MMA(1, 0, At, B0); PG8_MMA(1, 1, At, B1); PG8_BAR; PG8_SCHED;
            } else {
            PG8_LDB(B0, 0, 0); PG8_SCHED; PG8_LDA(At, 0, 0); PG8_STAGE(PG8_SA(1, 1), a1 + hstep, voffA);
            PG8_WAIT_L(8); PG8_BAR; PG8_WAIT_L(0); PG8_MMA(0, 0, At, B0); PG8_BAR; PG8_SCHED;
            PG8_LDB(B1, 0, 1); PG8_STAGE(PG8_SB(0, 0), b2, voffB);
            PG8_BAR; PG8_WAIT_L(0); PG8_MMA(0, 1, At, B1); PG8_BAR;
            PG8_LDA(At, 0, 1); PG8_STAGE(PG8_SA(0, 0), a2, voffA);
            PG8_BAR; PG8_WAIT_L(0); PG8_MMA(1, 0, At, B0); PG8_BAR; PG8_SCHED;
            PG8_STAGE(PG8_SB(0, 1), b2 + hstep, voffB);
            PG8_WAIT_V(6); PG8_BAR; PG8_MMA(1, 1, At, B1); PG8_BAR;
            PG8_LDB(B0, 1, 0); PG8_SCHED; PG8_LDA(At, 1, 0); PG8_STAGE(PG8_SA(0, 1), a2 + hstep, voffA);
            PG8_WAIT_L(8); PG8_BAR; PG8_WAIT_L(0); PG8_MMA(0, 0, At, B0); PG8_BAR; PG8_SCHED;
            PG8_LDB(B1, 1, 1); PG8_STAGE(PG8_SB(1, 0), b3, voffB);
            PG8_BAR; PG8_WAIT_L(0); PG8_MMA(0, 1, At, B1); PG8_BAR;
            PG8_LDA(At, 1, 1); PG8_STAGE(PG8_SA(1, 0), a3, voffA);
            PG8_BAR; PG8_WAIT_L(0); PG8_MMA(1, 0, At, B0); PG8_BAR; PG8_SCHED;
            PG8_STAGE(PG8_SB(1, 1), b3 + hstep, voffB);
            PG8_WAIT_V(6); PG8_BAR; PG8_MMA(1, 1, At, B1); PG8_BAR;
            }
        }
        if constexpr (ALIGN_EPI) { if (wr == 0) PG8_BAR; }
        if constexpr (!Epi::AFTER_DRAIN) { E(acc, cur, wr, wc, fr, fq); S.done(cur); }
        if (!has_next) break;
#pragma unroll
        for (int a = 0; a < 2; ++a)
#pragma unroll
            for (int b = 0; b < 2; ++b)
#pragma unroll
                for (int m = 0; m < 4; ++m)
#pragma unroll
                    for (int n = 0; n < 2; ++n) acc[a][b][m][n] = (f32x4){0.f, 0.f, 0.f, 0.f};
        cur = nxt; cA = nA; cB = nB; ++ui;
        if constexpr (GATHER) { _Pragma("unroll") for (int h_ = 0; h_ < 2; ++h_) { cvo[h_][0] = nvo[h_][0]; cvo[h_][1] = nvo[h_][1]; } }
        if constexpr (ALIGN_EPI) { if (wr == 1) PG8_BAR; }
    }
    PG8_WAIT_V(0);
    if constexpr (!ALIGN_EPI) { if (wr == 0) PG8_BAR; }
    PG8_BAR;
    if constexpr (Epi::AFTER_DRAIN) { E.fused(acc, cur, wr, wc, fr, fq, lds, wid, lane); S.done(cur); }
#undef PG8_SA
#undef PG8_SB
#undef PG8_STAGE
#undef PG8_STAGE_A
#undef PG8_ROWS
#undef PG8_LDA
#undef PG8_LDB
#undef PG8_MMA
#undef PG8_WAIT_V
#undef PG8_WAIT_L
#undef PG8_BAR
#undef PG8_SCHED
}
}

constexpr int NWAVES = 8;
constexpr int NB = 8, SEQ = 4096, DM = 1024, MTOK = NB * SEQ, NLAYER = 2;
constexpr int INC = 2984, INCP = 3072;
constexpr int C_RET = 0, C_RW = 1024, C_DSA = 1920, C_SB = 2216;
constexpr int PBW = 1792, PFW = 1280, PB_SB = 1024, PF_DSA = 896;
constexpr int NEXP = 32, MOE_ROWS = MTOK * 4 + NEXP * 256;
constexpr int ROPE_W = 88;
constexpr int NCH = 16, TCH = SEQ / NCH;
constexpr int NPL = 11, NPHASE = 1 + NLAYER * NPL;
enum { I_X = 0, I_C, I_POS, I_ADAW, I_ADAB, I_NMIX, I_NFFN, I_WIN, I_RETGN, I_MU, I_W0, I_W2, I_A0, I_A2, I_G2, I_KK, I_KA, I_RK, I_LN, I_QNORM, I_WQ, I_WQI, I_DONORM, I_SONORM, I_WOUT, I_RW, I_RB, I_MW1, I_MB1, I_MW2, I_MB2, I_NFINAL, N_IN };

constexpr size_t MiB = 1u << 20;
constexpr size_t WS_CTL = 0, CTL_ZERO_BYTES = 1 * MiB;
constexpr size_t WS_MOD = 1 * MiB, WS_ROPE = 2 * MiB, WS_WIN = 14 * MiB, WS_WOUT = 26 * MiB, WS_W1 = 30 * MiB, WS_W2 = 286 * MiB;
constexpr size_t WS_XA = 414 * MiB, WS_H = 542 * MiB, WS_MIX = 606 * MiB, WS_TOPI = 670 * MiB, WS_TOPW = 671 * MiB, WS_POS = 672 * MiB;
constexpr size_t WS_R = 674 * MiB;
constexpr size_t WS_PB = WS_R  , WS_PF = WS_R + 112 * MiB  , WS_RWA = 1058 * MiB  , WS_DQ = 1314 * MiB  , WS_DKB = 1330 * MiB  , WS_DVB = 1334 * MiB  , WS_DQI = 1346 * MiB  , WS_DKI = 1394 * MiB  , WS_DW = 1398 * MiB;
constexpr size_t WS_SMALLW = 1338 * MiB  ;
constexpr int SMW_QI = 0, SMW_W2 = 512 * 128, SMW_A2 = SMW_W2 + 256 * 32, SMW_G2 = SMW_A2 + 256 * 32, SMW_LAYER = SMW_G2 + 256 * 64;
constexpr size_t WS_PT = 1362 * MiB  ;
constexpr size_t WS_CH = WS_H  , WS_SI = WS_H + 16 * MiB  , WS_SIR = WS_H + 24 * MiB  ,
                 WS_CHR = WS_H + 32 * MiB  , WS_PTR = WS_H + 40 * MiB  ;
constexpr size_t WS_SQ = WS_MIX  , WS_SK = WS_MIX + 16 * MiB, WS_SV = WS_MIX + 32 * MiB;
constexpr size_t WS_YO = 1400 * MiB  , WS_SC = 1528 * MiB  ;
constexpr size_t WS_XS = WS_R  , WS_ACT = 946 * MiB  ;
constexpr size_t WS_LIST = 2040 * MiB  , WS_END = 2044 * MiB;
constexpr int LCAP = 32768;
static_assert((size_t)MOE_ROWS * 2048 <= 272 * MiB, "moe buffers");
constexpr int CW_TMO = 0, CW_CODE = 1, CW_GCNT = 256  , CW_DSAQ = 1024  , CW_BAR = 4096, CW_BLKCNT = 16384  ;
constexpr int RING_BYTES = 131072, MISC_OFF = RING_BYTES + 320, TST_OFF = RING_BYTES + 1024  , TAB_OFF = RING_BYTES + 2048  , HIST_OFF = RING_BYTES + 5120  , BASE_OFF = RING_BYTES + 5376  , CNT_OFF = RING_BYTES + 5632  , TEXP_OFF = RING_BYTES + 6144  , LDS_BYTES = 147456;

#if defined(__HIP_DEVICE_COMPILE__)
#define GAS __attribute__((address_space(1)))
#define CAS __attribute__((address_space(4)))
#else
#define GAS
#define CAS
#endif
#define LAS __attribute__((address_space(3)))
typedef unsigned short bf16;
typedef unsigned v4u __attribute__((ext_vector_type(4)));
typedef unsigned v2u __attribute__((ext_vector_type(2)));
typedef float f32x4 __attribute__((ext_vector_type(4)));
typedef GAS unsigned gu32;
typedef short bf16x8v __attribute__((ext_vector_type(8)));
typedef short s16x4v __attribute__((ext_vector_type(4)));
typedef _Float16 f16x8 __attribute__((ext_vector_type(8)));
#define RLX_AGENT __ATOMIC_RELAXED, __HIP_MEMORY_SCOPE_AGENT
#define LDS_WAIT() asm volatile("s_waitcnt lgkmcnt(0)" ::: "memory")
#define VM_WAIT() asm volatile("s_waitcnt vmcnt(0)" ::: "memory")
__device__ __forceinline__ unsigned f2bf(float f) { unsigned u = __builtin_bit_cast(unsigned, f); return (u + 0x7fffu + ((u >> 16) & 1u)) >> 16; }
__device__ __forceinline__ unsigned pk2(float lo, float hi) { return f2bf(lo) | (f2bf(hi) << 16); }
__device__ __forceinline__ float bf_lo(unsigned w) { return __builtin_bit_cast(float, w << 16); }
__device__ __forceinline__ float bf_hi(unsigned w) { return __builtin_bit_cast(float, w & 0xffff0000u); }
__device__ __forceinline__ float wave_sum(float v) {
#pragma unroll
    for (int o = 1; o < 64; o <<= 1) v += __shfl_xor(v, o);
    return v;
}
__device__ __forceinline__ float wave_max(float v) {
#pragma unroll
    for (int o = 1; o < 64; o <<= 1) v = fmaxf(v, __shfl_xor(v, o));
    return v;
}
__device__ __forceinline__ float grp16_sum(float v) { v += __shfl_xor(v, 1); v += __shfl_xor(v, 2); v += __shfl_xor(v, 4); v += __shfl_xor(v, 8); return v; }
__device__ __forceinline__ float grp8_sum(float v) { v += __shfl_xor(v, 1); v += __shfl_xor(v, 2); v += __shfl_xor(v, 4); return v; }
__device__ __forceinline__ float sum4(f32x4 a) { return (a.x + a.y) + (a.z + a.w); }
__device__ __forceinline__ float dot4(f32x4 a, f32x4 b) { return (a.x * b.x + a.y * b.y) + (a.z * b.z + a.w * b.w); }
__device__ __forceinline__ float fexp(float x) { return __builtin_amdgcn_exp2f(x * 1.4426950408889634f); }
__device__ __forceinline__ float sigm(float x) { return __builtin_amdgcn_rcpf(1.0f + fexp(-x)); }
__device__ __forceinline__ float softplusf(float x) { return fmaxf(x, 0.0f) + 0.6931471805599453f * __builtin_amdgcn_logf(1.0f + fexp(-fabsf(x))); }
__device__ __forceinline__ float ftanh(float x) { const float e = fexp(-2.0f * fabsf(x)); const float t = (1.0f - e) * __builtin_amdgcn_rcpf(1.0f + e); return x < 0.0f ? -t : t; }
__device__ __forceinline__ f32x4 shx4(f32x4 v, int m) { f32x4 r; r.x = __shfl_xor(v.x, m); r.y = __shfl_xor(v.y, m); r.z = __shfl_xor(v.z, m); r.w = __shfl_xor(v.w, m); return r; }

#define XB_TMO      128
#define XB_XCNT(j)  (256  + 64 * (j))
#define XB_XSUB(j)  (1280 + 64 * (j))
#define XB_XGEN(j)  (2304 + 64 * (j))
#define XB_TOP      3328
#define XB_TOPGEN   3392
#define XCD_BAR_WORDS 3456
#define XB_SPIN_CAP (1u << 18)

__device__ __forceinline__ unsigned xb_ld(unsigned* p)              { return __hip_atomic_load(p, __ATOMIC_RELAXED, __HIP_MEMORY_SCOPE_AGENT); }
__device__ __forceinline__ unsigned xb_add(unsigned* p, unsigned v) { return __hip_atomic_fetch_add(p, v, __ATOMIC_RELAXED, __HIP_MEMORY_SCOPE_AGENT); }
__device__ __forceinline__ unsigned xb_xcc_id() { return (unsigned)__builtin_amdgcn_s_getreg((3 << 11) | 20) & 0xFu; }
#define XB_SPIN(cond, bar) do { unsigned _sp = 0; while (cond) { __builtin_amdgcn_s_sleep(1); \
    if ((++_sp & 255u) == 0u) { if (xb_ld(&(bar)[XB_TMO])) break; if (_sp > XB_SPIN_CAP) { atomicAdd(&(bar)[XB_TMO], 1u); break; } } } } while (0)

struct XcdBarrier {
    unsigned* bar; unsigned x;
    volatile LAS unsigned* st;
};

__device__ __forceinline__ XcdBarrier xcd_barrier_post(unsigned* bar, volatile LAS unsigned* st, int xb_tid) {
    XcdBarrier b; b.bar = bar; b.x = xb_xcc_id(); b.st = st;
    if (xb_tid == 0) (void)xb_add(&bar[XB_XCNT(b.x)], 1u);
    return b;
}
__device__ __forceinline__ void xcd_barrier_complete(unsigned* bar, unsigned x, unsigned& nloc, unsigned& nx) {
    const unsigned G = gridDim.x * gridDim.y * gridDim.z;
    unsigned sum, cnt, mine, sp = 0u;
    for (;;) {
        sum = 0u; cnt = 0u; mine = 0u;
#pragma unroll
        for (unsigned j = 0; j < 16; ++j) { const unsigned c = xb_ld(&bar[XB_XCNT(j)]); sum += c; cnt += (c > 0u) ? 1u : 0u; mine = (j == x) ? c : mine; }
        if (sum == G) break;
        __builtin_amdgcn_s_sleep(1);
        if ((++sp & 255u) == 0u) { if (xb_ld(&bar[XB_TMO])) break; if (sp > XB_SPIN_CAP) { atomicAdd(&bar[XB_TMO], 1u); break; } }
    }
    nloc = mine > 0u ? mine : 1u; nx = cnt > 0u ? cnt : 1u;
}

__device__ __forceinline__ void xcd_barrier(const XcdBarrier& b, int xb_tid) {
    asm volatile("s_waitcnt vmcnt(0)" ::: "memory");
    __syncthreads();
    if (xb_tid == 0) {
        unsigned* bar = b.bar;
        __builtin_amdgcn_s_waitcnt(0);
        unsigned nloc = b.st[0], nx = b.st[1];
        if (nloc == 0u) { xcd_barrier_complete(bar, b.x, nloc, nx); b.st[0] = nloc; b.st[1] = nx; }
        const unsigned old = xb_add(&bar[XB_XSUB(b.x)], 1u);
        const unsigned gen = old / nloc;
        if (old + 1u == (gen + 1u) * nloc) {
            __builtin_amdgcn_fence(__ATOMIC_RELEASE, "agent");
            asm volatile("s_waitcnt vmcnt(0)" ::: "memory");
            const unsigned og = xb_add(&bar[XB_TOP], 1u);
            const unsigned tg = og / nx;
            if (og + 1u == (tg + 1u) * nx) xb_add(&bar[XB_TOPGEN], 1u);
            else XB_SPIN(xb_ld(&bar[XB_TOPGEN]) == tg, bar);
            __builtin_amdgcn_fence(__ATOMIC_ACQUIRE, "agent");
            xb_add(&bar[XB_XGEN(b.x)], 1u);
            asm volatile("s_waitcnt vmcnt(0)" ::: "memory");
        } else {
            XB_SPIN(xb_ld(&bar[XB_XGEN(b.x)]) == gen, bar);
            __builtin_amdgcn_fence(__ATOMIC_ACQUIRE, "agent");
            asm volatile("s_waitcnt vmcnt(0)" ::: "memory");
        }
    }
    __syncthreads();
}
struct ArgsH { const float* in[N_IN]; float* out; unsigned char* ws; double invf[44]; int ph_lo, ph_hi, li, pad; };
struct ArgsD { const GAS float* in[N_IN]; GAS float* out; GAS unsigned char* ws; double invf[44]; int ph_lo, ph_hi, li, pad; };
static_assert(sizeof(ArgsH) == sizeof(ArgsD), "args layout");
typedef const CAS ArgsD& ARef;
__device__ __forceinline__ const CAS ArgsD* kargs() {
#if defined(__HIP_DEVICE_COMPILE__)
    const CAS ArgsD* p = (const CAS ArgsD*)__builtin_amdgcn_kernarg_segment_ptr(); asm volatile("" : "+s"(p)); return p;
#else
    return nullptr;
#endif
}
struct WI { LAS unsigned char* lds; int tid, lane, wave, vcu, G, gw, NGW, bx; };
constexpr size_t RWA_STRIDE = 32 * MiB / 4;
constexpr size_t YO_STRIDE = 32 * MiB / 4;

__device__ __forceinline__ int wave_sum_i(int v) {
#pragma unroll
    for (int o = 1; o < 64; o <<= 1) v += __shfl_xor(v, o);
    return v;
}
__device__ __forceinline__ void sincos_d(double ang, float& s, float& c) {
    const double q = __builtin_rint(ang * 0.63661977236758134308);
    double r = __builtin_fma(-q, 1.57079632679489661923, ang); r = __builtin_fma(-q, 6.123233995736766e-17, r);
    const double r2 = r * r;
    const double sp = r * (1.0 + r2 * (-1.0 / 6 + r2 * (1.0 / 120 + r2 * (-1.0 / 5040 + r2 * (1.0 / 362880 + r2 * (-1.0 / 39916800 + r2 * (1.0 / 6227020800.0)))))));
    const double cp = 1.0 + r2 * (-0.5 + r2 * (1.0 / 24 + r2 * (-1.0 / 720 + r2 * (1.0 / 40320 + r2 * (-1.0 / 3628800 + r2 * (1.0 / 479001600 + r2 * (-1.0 / 87178291200.0)))))));
    const int qi = ((int)q) & 3;
    const double ss = (qi == 0) ? sp : (qi == 1) ? cp : (qi == 2) ? -sp : -cp;
    const double cc = (qi == 0) ? cp : (qi == 1) ? -sp : (qi == 2) ? -cp : sp;
    s = (float)ss; c = (float)cc;
}

struct TrItem { const float* src; bf16* dst; int ldw; float scale; bool ok; };
__device__ __forceinline__ void tr_decode(ARef A, int it, int lane, TrItem& d) {
    constexpr int I_IN = NLAYER * 16 * 96, I_OUT = NLAYER * 16 * 32, I_W1 = NLAYER * NEXP * 16 * 64;
    const float* W; int ldw, nvalid, k0, nsrc0; bf16* WT; size_t dstrow0; float scale = 1.0f;
    int r = it;
    if (r < I_IN) { const int l = r / 1536, rr = r % 1536, kb = rr / 96, nb = rr % 96;
        const int nd = nb * 32;
        nsrc0 = (nd < 1024) ? nd : (nd < 1792) ? C_SB + (nd - 1024) : (nd < 2688) ? C_RW + (nd - 1792) : C_DSA + (nd - 2688);
        nvalid = (nd < 1024) ? 1024 : (nd < 1792) ? INC : (nd < 2688) ? C_DSA : ((nd < INC) ? C_SB : 0);
        scale = (nd >= 256 && nd < 512) ? 0.125f : (nd >= 1024 && nd < 1280) ? 0.18033688011112042f : 1.0f;
        W = A.in[I_WIN] + (size_t)l * DM * INC; ldw = INC; k0 = kb * 64; WT = (bf16*)(A.ws + WS_WIN) + (size_t)l * INCP * DM; dstrow0 = (size_t)nd; }
    else if (r < I_IN + I_OUT) { r -= I_IN; const int l = r / 512, rr = r % 512, kb = rr / 32, nb = rr % 32;
        W = A.in[I_WOUT] + (size_t)l * DM * DM; ldw = DM; nvalid = DM; k0 = kb * 64; nsrc0 = nb * 32; WT = (bf16*)(A.ws + WS_WOUT) + (size_t)l * DM * DM; dstrow0 = (size_t)nb * 32; }
    else if (r < I_IN + I_OUT + I_W1) { r -= I_IN + I_OUT; const int le = r / 1024, rr = r % 1024, kb = rr / 64, nb = rr % 64, j = nb >> 3, bj = (nb >> 2) & 1, cc0 = (nb & 3) * 32;
        W = A.in[I_MW1] + (size_t)le * DM * 2048; ldw = 2048; nvalid = 2048; k0 = kb * 64; nsrc0 = bj * 1024 + 128 * j + cc0; WT = (bf16*)(A.ws + WS_W1) + (size_t)le * 2048 * DM; dstrow0 = (size_t)nb * 32; }
    else { r -= I_IN + I_OUT + I_W1; const int le = r / 512, rr = r % 512, kb = rr / 32, nb = rr % 32;
        W = A.in[I_MW2] + (size_t)le * DM * DM; ldw = DM; nvalid = DM; k0 = kb * 64; nsrc0 = nb * 32; WT = (bf16*)(A.ws + WS_W2) + (size_t)le * DM * DM; dstrow0 = (size_t)nb * 32; }
    const int n = nsrc0 + 4 * (lane & 7);
    d.ok = n < nvalid; d.src = W + (size_t)(k0 + (lane >> 3)) * ldw + (d.ok ? n : 0); d.ldw = ldw; d.scale = scale;
    d.dst = WT + (dstrow0 + (lane >> 3)) * 1024 + k0 + 8 * (lane & 7);
}
__device__ __forceinline__ void tr_load(const TrItem& d, f32x4 (&v)[8]) {
#pragma unroll
    for (int i = 0; i < 8; ++i) v[i] = *(const f32x4*)(d.src + (size_t)(8 * i) * d.ldw);
}
__device__ __forceinline__ void tr_store(const TrItem& d, const f32x4 (&v)[8], LAS float* scr, int lane) {
    const float sc_ = d.ok ? d.scale : 0.0f;
#pragma unroll
    for (int i = 0; i < 8; ++i) { LAS float* s = scr + (8 * i + (lane >> 3)) * 33 + 4 * (lane & 7); s[0] = v[i].x * sc_; s[1] = v[i].y * sc_; s[2] = v[i].z * sc_; s[3] = v[i].w * sc_; }
    LDS_WAIT(); asm volatile("" ::: "memory");
    const int c8 = lane & 7;
#pragma unroll
    for (int j = 0; j < 4; ++j) { const int n = (lane >> 3) + 8 * j; const LAS float* s = scr + (8 * c8) * 33 + n;
        v4u o; o.x = pk2(s[0 * 33], s[1 * 33]); o.y = pk2(s[2 * 33], s[3 * 33]); o.z = pk2(s[4 * 33], s[5 * 33]); o.w = pk2(s[6 * 33], s[7 * 33]);
        *(v4u*)(d.dst + (size_t)(8 * j) * 1024) = o; }
    LDS_WAIT(); asm volatile("" ::: "memory");
}
__device__ __forceinline__ void ph_prologue(ARef A, const WI& w) {
    LAS float* sc = (LAS float*)w.lds;
    { const float* cin = A.in[I_C]; for (int i = w.tid; i < NB * DM; i += NWAVES * 64) { const float v = cin[i]; sc[i] = v / (1.0f + expf(-v)); } }
    __syncthreads();
    float* MOD = (float*)(A.ws + WS_MOD);
    LAS float* red = (LAS float*)(w.lds + 32768);
    if (w.vcu < 192) {
        const int l = w.vcu / 96, col = (w.vcu % 96) * 64 + w.lane, kw = 128 * w.wave;
        const float* wp = A.in[I_ADAW] + (size_t)l * DM * 6144 + (size_t)kw * 6144 + col;
        float acc[8];
#pragma unroll
        for (int b = 0; b < 8; ++b) acc[b] = 0.0f;
#pragma unroll 16
        for (int k = 0; k < 128; ++k) { const float wv = wp[(size_t)k * 6144];
#pragma unroll
            for (int b = 0; b < 8; ++b) acc[b] += sc[b * DM + kw + k] * wv; }
#pragma unroll
        for (int b = 0; b < 8; ++b) red[(w.wave * 8 + b) * 64 + w.lane] = acc[b];
    }
    __syncthreads();
    if (w.vcu < 192) { const int l = w.vcu / 96, b = w.wave, col = (w.vcu % 96) * 64 + w.lane;
        float s = A.in[I_ADAB][l * 6144 + col];
#pragma unroll
        for (int q = 0; q < 8; ++q) s += red[(q * 8 + b) * 64 + w.lane];
        MOD[(size_t)(l * 8 + b) * 6144 + col] = s; }
    __syncthreads();
    LAS float* scr = (LAS float*)(w.lds + 32768 + w.wave * 8448);
    constexpr int NIT = NLAYER * 16 * 96 + NLAYER * 16 * 32 + NLAYER * NEXP * 16 * 64 + NLAYER * NEXP * 16 * 32;
    { TrItem d0, d1; f32x4 va[8], vb[8];
      int it = w.gw; bool h0 = it < NIT;
      if (h0) { tr_decode(A, it, w.lane, d0); tr_load(d0, va); }
      while (h0) {
          it += w.NGW; const bool h1 = it < NIT;
          if (h1) { tr_decode(A, it, w.lane, d1); tr_load(d1, vb); }
          tr_store(d0, va, scr, w.lane);
          if (!h1) break;
          it += w.NGW; h0 = it < NIT;
          if (h0) { tr_decode(A, it, w.lane, d0); tr_load(d0, va); }
          tr_store(d1, vb, scr, w.lane);
      } }
    float* RT = (float*)(A.ws + WS_ROPE); const int* pos = (const int*)A.in[I_POS];
    for (int g = w.gw * 64 + w.lane; g < MTOK * 44; g += w.NGW * 64) {
        const int tok = g / 44, f = g % 44; int co, so;
        if (f < 32) { co = f; so = 32 + f; } else if (f < 40) { co = 64 + (f - 32); so = 72 + (f - 32); } else { co = 80 + (f - 40); so = 84 + (f - 40); }
        float s, c; sincos_d((double)pos[tok] * A.invf[f], s, c);
        RT[(size_t)tok * ROPE_W + co] = c; RT[(size_t)tok * ROPE_W + so] = s;
    }
}

__device__ __forceinline__ void emit_h_row(const f32x4 (&v)[4], float rstd, const float* g, const float* sc, const float* sh, bf16* hrow, int lane) {
#pragma unroll
    for (int j = 0; j < 4; ++j) { const int k = 4 * (lane + 64 * j);
        const f32x4 gv = *(const f32x4*)(g + k), scv = *(const f32x4*)(sc + k), shv = *(const f32x4*)(sh + k);
        const f32x4 h = v[j] * rstd * gv * (1.0f + scv) + shv;
        v2u o; o.x = pk2(h.x, h.y); o.y = pk2(h.z, h.w); *(v2u*)(hrow + k) = o; }
}
__device__ __forceinline__ void small_weights_to_f16(ARef A, const WI& w) {
    { _Float16* SW = (_Float16*)(A.ws + WS_SMALLW);
      const int g0 = w.gw * 64 + w.lane, gs = w.NGW * 64;
      for (int l = 0; l < NLAYER; ++l) { _Float16* S = SW + (size_t)l * SMW_LAYER;
          const float* wq = A.in[I_WQ] + (size_t)l * 128 * 256; const float* wqi = A.in[I_WQI] + (size_t)l * 128 * 256;
          for (int e = g0; e < 256 * 128; e += gs) { const int n = e >> 7, k = e & 127; S[SMW_QI + e] = (_Float16)wq[k * 256 + n]; S[SMW_QI + 256 * 128 + e] = (_Float16)wqi[k * 256 + n]; }
          const float* w2 = A.in[I_W2] + (size_t)l * 32 * 256; const float* a2 = A.in[I_A2] + (size_t)l * 32 * 256; const float* g2 = A.in[I_G2] + (size_t)l * 64 * 256;
          for (int e = g0; e < 256 * 32; e += gs) { const int n = e >> 5, k = e & 31; S[SMW_W2 + e] = (_Float16)w2[k * 256 + n]; S[SMW_A2 + e] = (_Float16)a2[k * 256 + n]; }
          for (int e = g0; e < 256 * 64; e += gs) { const int n = e >> 6, k = e & 63; S[SMW_G2 + e] = (_Float16)g2[k * 256 + n]; } } }
}
__device__ __forceinline__ void ph_norm1(ARef A, const WI& w) {
    const float* MOD = (const float*)(A.ws + WS_MOD); bf16* H = (bf16*)(A.ws + WS_H);
    for (int m = w.gw; m < MTOK; m += w.NGW) {
        const float* xr = A.in[I_X] + (size_t)m * DM; f32x4 v[4]; float ss = 0.0f;
#pragma unroll
        for (int j = 0; j < 4; ++j) { v[j] = *(const f32x4*)(xr + 4 * (w.lane + 64 * j)); ss += dot4(v[j], v[j]); }
        ss = wave_sum(ss); const float rstd = 1.0f / sqrtf(ss * (1.0f / DM) + 1e-5f);
        const float* mb = MOD + (size_t)(m >> 12) * 6144;
        emit_h_row(v, rstd, A.in[I_NMIX], mb + 1024, mb, H + (size_t)m * DM, w.lane);
    }
}

typedef _Float16 h4v __attribute__((ext_vector_type(4)));
__device__ __forceinline__ f16x8 pack_f16x8(f32x4 a, f32x4 b) { f16x8 r; r[0] = (_Float16)a.x; r[1] = (_Float16)a.y; r[2] = (_Float16)a.z; r[3] = (_Float16)a.w; r[4] = (_Float16)b.x; r[5] = (_Float16)b.y; r[6] = (_Float16)b.z; r[7] = (_Float16)b.w; return r; }
__device__ __forceinline__ void prep16(ARef A, int l, int m0, int lane_in) {
    int lane = lane_in; asm volatile("" : "+v"(lane));
    const int tk = lane & 15, q4 = lane >> 4, m = m0 + tk, t = m & (SEQ - 1);
    const float* P = (const float*)(A.ws + WS_PF); float* RWA = (float*)(A.ws + WS_RWA); const _Float16* SW = (const _Float16*)(A.ws + WS_SMALLW) + (size_t)l * SMW_LAYER;
    const float* pr = P + (size_t)m * PFW; const float* pp = pr - PFW; const float* pd = P + (size_t)m * PFW + PF_DSA; const float* mu = A.in[I_MU] + l * 896;
    const float* RT = (const float*)(A.ws + WS_ROPE) + (size_t)m * ROPE_W; const f32x4 zero4 = {0.f, 0.f, 0.f, 0.f};
    f16x8 bx[4], bc[4];
    { float ss = 0.0f; f32x4 c[4][2];
#pragma unroll
      for (int ks = 0; ks < 4; ++ks) { const int f0 = 32 * ks + 8 * q4;
          f32x4 x[2];
#pragma unroll
          for (int u = 0; u < 2; ++u) { const f32x4 z = *(const f32x4*)(pr + 768 + f0 + 4 * u); const f32x4 p = t ? *(const f32x4*)(pp + 768 + f0 + 4 * u) : zero4; x[u] = z + (p - z) * *(const f32x4*)(mu + 768 + f0 + 4 * u);
#pragma unroll
              for (int i = 0; i < 4; ++i) x[u][i] = (ks == 0) ? ftanh(x[u][i]) : (ks == 1) ? x[u][i] : sigm(x[u][i]); }
          bx[ks] = pack_f16x8(x[0], x[1]);
          c[ks][0] = *(const f32x4*)(pd + f0); c[ks][1] = *(const f32x4*)(pd + f0 + 4); ss += dot4(c[ks][0], c[ks][0]) + dot4(c[ks][1], c[ks][1]); }
      ss += __shfl_xor(ss, 16); ss += __shfl_xor(ss, 32);
      const float rstd = 1.0f / sqrtf(ss * (1.0f / 128.0f) + 1e-5f); const float* qn = A.in[I_QNORM] + l * 128;
#pragma unroll
      for (int ks = 0; ks < 4; ++ks) { const int f0 = 32 * ks + 8 * q4; bc[ks] = pack_f16x8(c[ks][0] * rstd * *(const f32x4*)(qn + f0), c[ks][1] * rstd * *(const f32x4*)(qn + f0 + 4)); } }
    const _Float16* wrow = SW + (size_t)tk * 0;
    (void)wrow;
    const int arow = lane & 15;
#pragma unroll 1
    for (int hd = 0; hd < 4; ++hd) {
        f32x4 fk[4], av[4]; float ssk = 0.0f;
#pragma unroll
        for (int j = 0; j < 4; ++j) { const int nb = 4 * hd + j, ch = 16 * nb + 4 * q4; const size_t o = (size_t)m * 256 + ch;
            const f16x8 aw = *(const f16x8*)(SW + SMW_W2 + (16 * nb + arow) * 32 + 8 * q4), aa = *(const f16x8*)(SW + SMW_A2 + (16 * nb + arow) * 32 + 8 * q4);
            const f16x8 ag0 = *(const f16x8*)(SW + SMW_G2 + (16 * nb + arow) * 64 + 8 * q4), ag1 = *(const f16x8*)(SW + SMW_G2 + (16 * nb + arow) * 64 + 32 + 8 * q4);
            const f32x4 cw = __builtin_amdgcn_mfma_f32_16x16x32_f16(aw, bx[0], *(const f32x4*)(A.in[I_W0] + l * 256 + ch), 0, 0, 0);
            const f32x4 ca = __builtin_amdgcn_mfma_f32_16x16x32_f16(aa, bx[1], *(const f32x4*)(A.in[I_A0] + l * 256 + ch), 0, 0, 0);
            f32x4 cg = __builtin_amdgcn_mfma_f32_16x16x32_f16(ag0, bx[2], zero4, 0, 0, 0); cg = __builtin_amdgcn_mfma_f32_16x16x32_f16(ag1, bx[3], cg, 0, 0, 0);
            f32x4 dec;
#pragma unroll
            for (int i = 0; i < 4; ++i) { dec[i] = fexp(-fexp(-softplusf(-cw[i]) - 0.5f)); av[j][i] = sigm(ca[i]); }
            *(f32x4*)(RWA + 1 * RWA_STRIDE + o) = dec; *(f32x4*)(RWA + 6 * RWA_STRIDE + o) = cg;
            { const f32x4 z = *(const f32x4*)(pr + 256 + ch); const f32x4 p = t ? *(const f32x4*)(pp + 256 + ch) : zero4; fk[j] = z + (p - z) * *(const f32x4*)(mu + 256 + ch); }
            const f32x4 kk = fk[j] * *(const f32x4*)(A.in[I_KK] + l * 256 + ch); ssk += dot4(kk, kk); }
        ssk += __shfl_xor(ssk, 16); ssk += __shfl_xor(ssk, 32);
        const float inrm = 1.0f / fmaxf(sqrtf(ssk), 1e-12f);
        f32x4 fr[4], km[4]; float bs = 0.0f;
#pragma unroll
        for (int j = 0; j < 4; ++j) { const int ch = 16 * (4 * hd + j) + 4 * q4;
            { const f32x4 z = *(const f32x4*)(pr + ch); const f32x4 p = t ? *(const f32x4*)(pp + ch) : zero4; fr[j] = z + (p - z) * *(const f32x4*)(mu + ch); }
            km[j] = fk[j] * (1.0f + (av[j] - 1.0f) * *(const f32x4*)(A.in[I_KA] + l * 256 + ch)); bs += dot4(fr[j] * km[j], *(const f32x4*)(A.in[I_RK] + l * 256 + ch)); }
        bs += __shfl_xor(bs, 16); bs += __shfl_xor(bs, 32);
#pragma unroll
        for (int j = 0; j < 4; ++j) { const int ch = 16 * (4 * hd + j) + 4 * q4; const size_t o = (size_t)m * 256 + ch;
            f32x4 fv; { const f32x4 z = *(const f32x4*)(pr + 512 + ch); const f32x4 p = t ? *(const f32x4*)(pp + 512 + ch) : zero4; fv = z + (p - z) * *(const f32x4*)(mu + 512 + ch); }
            const f32x4 kk = fk[j] * *(const f32x4*)(A.in[I_KK] + l * 256 + ch) * inrm;
            *(f32x4*)(RWA + 0 * RWA_STRIDE + o) = fr[j]; *(f32x4*)(RWA + 2 * RWA_STRIDE + o) = km[j]; *(f32x4*)(RWA + 3 * RWA_STRIDE + o) = fv;
            *(f32x4*)(RWA + 4 * RWA_STRIDE + o) = -kk; *(f32x4*)(RWA + 5 * RWA_STRIDE + o) = kk * av[j]; *(f32x4*)(RWA + 7 * RWA_STRIDE + o) = bs * fv; }
    }
#pragma unroll 1
    for (int nb = 0; nb < 32; ++nb) {
        f32x4 cq = zero4;
#pragma unroll
        for (int ks = 0; ks < 4; ++ks) { const f16x8 aq = *(const f16x8*)(SW + SMW_QI + (16 * nb + arow) * 128 + 32 * ks + 8 * q4); cq = __builtin_amdgcn_mfma_f32_16x16x32_f16(aq, bc[ks], cq, 0, 0, 0); }
        const int ch = 16 * (nb & 15) + 4 * q4;
        if (nb < 16) {
            if ((nb & 3) == 0) { const f32x4 ot = shx4(cq, 32); const int fi = 4 * (q4 & 1); const f32x4 cs4 = *(const f32x4*)(RT + 64 + fi), sn = *(const f32x4*)(RT + 72 + fi); cq = (q4 < 2) ? cq * cs4 - ot * sn : ot * sn + cq * cs4; }
            const f32x4 qs = cq * 0.18033688011112042f; v2u o; o.x = pk2(qs.x, qs.y); o.y = pk2(qs.z, qs.w); *(v2u*)((bf16*)(A.ws + WS_DQ) + (size_t)m * 256 + ch) = o;
        } else {
            if ((nb & 1) == 0) { const f32x4 ot = shx4(cq, 16); const f32x4 cs4 = *(const f32x4*)(RT + 80), sn = *(const f32x4*)(RT + 84); if (q4 < 2) cq = (q4 < 1) ? cq * cs4 - ot * sn : ot * sn + cq * cs4; }
            h4v hq; hq.x = (_Float16)cq.x; hq.y = (_Float16)cq.y; hq.z = (_Float16)cq.z; hq.w = (_Float16)cq.w; *(h4v*)((_Float16*)(A.ws + WS_DQI) + (size_t)m * 256 + ch) = hq;
        }
    }
#pragma unroll
    for (int j = 0; j < 4; ++j) { const int d = 16 * j + 4 * q4; f32x4 kx = *(const f32x4*)(pd + 128 + d);
        if (j == 0) { const f32x4 ot = shx4(kx, 32); const int fi = 4 * (q4 & 1); const f32x4 cs4 = *(const f32x4*)(RT + 64 + fi), sn = *(const f32x4*)(RT + 72 + fi); kx = (q4 < 2) ? kx * cs4 - ot * sn : ot * sn + kx * cs4; }
        v2u o; o.x = pk2(kx.x, kx.y); o.y = pk2(kx.z, kx.w); *(v2u*)((bf16*)(A.ws + WS_DKB) + (size_t)m * 64 + d) = o;
        const f32x4 vx = *(const f32x4*)(pd + 192 + d); v2u ov; ov.x = pk2(vx.x, vx.y); ov.y = pk2(vx.z, vx.w); *(v2u*)((bf16*)(A.ws + WS_DVB) + (size_t)m * 64 + d) = ov; }
#pragma unroll
    for (int j = 0; j < 2; ++j) { const int d = 16 * j + 4 * q4; f32x4 ki = *(const f32x4*)(pd + 256 + d);
        if (j == 0) { const f32x4 ot = shx4(ki, 16); const f32x4 cs4 = *(const f32x4*)(RT + 80), sn = *(const f32x4*)(RT + 84); if (q4 < 2) ki = (q4 < 1) ? ki * cs4 - ot * sn : ot * sn + ki * cs4; }
        h4v hk; hk.x = (_Float16)ki.x; hk.y = (_Float16)ki.y; hk.z = (_Float16)ki.z; hk.w = (_Float16)ki.w; *(h4v*)((_Float16*)(A.ws + WS_DKI) + (size_t)m * 32 + d) = hk; }
    if (q4 < 2) *(f32x4*)((float*)(A.ws + WS_DW) + (size_t)m * 8 + 4 * q4) = *(const f32x4*)(pd + 288 + 4 * q4) * 0.0625f;
}
__device__ __forceinline__ float quad_sum(float v) {
    v += __builtin_bit_cast(float, __builtin_amdgcn_mov_dpp(__builtin_bit_cast(int, v), 0xB1, 0xF, 0xF, true));
    v += __builtin_bit_cast(float, __builtin_amdgcn_mov_dpp(__builtin_bit_cast(int, v), 0x4E, 0xF, 0xF, true));
    return v;
}
__device__ __forceinline__ float oct_sum(float v) {
    v += __builtin_bit_cast(float, __builtin_amdgcn_mov_dpp(__builtin_bit_cast(int, v), 0xB1, 0xF, 0xF, true));
    v += __builtin_bit_cast(float, __builtin_amdgcn_mov_dpp(__builtin_bit_cast(int, v), 0x4E, 0xF, 0xF, true));
    v += __builtin_bit_cast(float, __builtin_amdgcn_mov_dpp(__builtin_bit_cast(int, v), 0x141, 0xF, 0xF, true));
    return v;
}
typedef float f32x2 __attribute__((ext_vector_type(2)));
#define LO2(v_) __builtin_shufflevector(v_, v_, 0, 1)
#define HI2(v_) __builtin_shufflevector(v_, v_, 2, 3)
#define RW_ROW(i_) (((i_) < 2) ? (16 * ws + rg + 8 * (i_)) : (64 + 16 * ws + rg + 8 * ((i_) - 2)))
#define RW_LOAD(op, s_) do { const int lo_ = (s_) * 64 + kq * 8; \
    op[0] = *(const LAS f32x4*)(sn + lo_); op[1] = *(const LAS f32x4*)(sn + lo_ + 4); op[2] = *(const LAS f32x4*)(sw + lo_); op[3] = *(const LAS f32x4*)(sw + lo_ + 4); \
    op[4] = *(const LAS f32x4*)(sb + lo_); op[5] = *(const LAS f32x4*)(sb + lo_ + 4); op[6] = *(const LAS f32x4*)(sk + lo_); op[7] = *(const LAS f32x4*)(sk + lo_ + 4); \
    op[8] = *(const LAS f32x4*)(sr + lo_); op[9] = *(const LAS f32x4*)(sr + lo_ + 4); \
    vin[0] = sv[(s_) * 64 + 16 * ws + rg]; vin[1] = sv[(s_) * 64 + 16 * ws + rg + 8]; } while (0)
#define RW_DOT(i_, oa, ob) ({ f32x2 d_ = S[i_][0] * LO2(oa); d_ = S[i_][1] * HI2(oa) + d_; d_ = S[i_][2] * LO2(ob) + d_; d_ = S[i_][3] * HI2(ob) + d_; d_.x + d_.y; })
#define RW_STEP(op, vv, s_) do { float sa_[4], y_[4]; \
    _Pragma("unroll") for (int i_ = 0; i_ < 4; ++i_) sa_[i_] = RW_DOT(i_, op[0], op[1]); \
    _Pragma("unroll") for (int i_ = 0; i_ < 4; ++i_) sa_[i_] += __builtin_bit_cast(float, __builtin_amdgcn_mov_dpp(__builtin_bit_cast(int, sa_[i_]), 0xB1, 0xF, 0xF, true)); \
    _Pragma("unroll") for (int i_ = 0; i_ < 4; ++i_) sa_[i_] += __builtin_bit_cast(float, __builtin_amdgcn_mov_dpp(__builtin_bit_cast(int, sa_[i_]), 0x4E, 0xF, 0xF, true)); \
    _Pragma("unroll") for (int i_ = 0; i_ < 4; ++i_) sa_[i_] += __builtin_bit_cast(float, __builtin_amdgcn_mov_dpp(__builtin_bit_cast(int, sa_[i_]), 0x141, 0xF, 0xF, true)); \
    _Pragma("unroll") for (int i_ = 0; i_ < 2; ++i_) { const f32x2 a2_ = {sa_[i_], sa_[i_]}, v2_ = {vv[i_], vv[i_]}; \
        S[i_][0] = S[i_][0] * LO2(op[2]) + (a2_ * LO2(op[4]) + v2_ * LO2(op[6])); S[i_][1] = S[i_][1] * HI2(op[2]) + (a2_ * HI2(op[4]) + v2_ * HI2(op[6])); \
        S[i_][2] = S[i_][2] * LO2(op[3]) + (a2_ * LO2(op[5]) + v2_ * LO2(op[7])); S[i_][3] = S[i_][3] * HI2(op[3]) + (a2_ * HI2(op[5]) + v2_ * HI2(op[7])); } \
    _Pragma("unroll") for (int i_ = 2; i_ < 4; ++i_) { const f32x2 a2_ = {sa_[i_], sa_[i_]}; \
        S[i_][0] = S[i_][0] * LO2(op[2]) + a2_ * LO2(op[4]); S[i_][1] = S[i_][1] * HI2(op[2]) + a2_ * HI2(op[4]); S[i_][2] = S[i_][2] * LO2(op[3]) + a2_ * LO2(op[5]); S[i_][3] = S[i_][3] * HI2(op[3]) + a2_ * HI2(op[5]); } \
    _Pragma("unroll") for (int i_ = 0; i_ < 4; ++i_) y_[i_] = RW_DOT(i_, op[8], op[9]); \
    _Pragma("unroll") for (int i_ = 0; i_ < 4; ++i_) y_[i_] += __builtin_bit_cast(float, __builtin_amdgcn_mov_dpp(__builtin_bit_cast(int, y_[i_]), 0xB1, 0xF, 0xF, true)); \
    _Pragma("unroll") for (int i_ = 0; i_ < 4; ++i_) y_[i_] += __builtin_bit_cast(float, __builtin_amdgcn_mov_dpp(__builtin_bit_cast(int, y_[i_]), 0x4E, 0xF, 0xF, true)); \
    _Pragma("unroll") for (int i_ = 0; i_ < 4; ++i_) y_[i_] += __builtin_bit_cast(float, __builtin_amdgcn_mov_dpp(__builtin_bit_cast(int, y_[i_]), 0x141, 0xF, 0xF, true)); \
    if (kq == 0) { _Pragma("unroll") for (int i_ = 0; i_ < 4; ++i_) so[(s_) * 128 + RW_ROW(i_)] = y_[i_]; } } while (0)
__device__ __forceinline__ void scan_rwkv_task2(ARef A, const WI& w, int task0) {
    const int slot = w.wave >> 2, ws = w.wave & 3, lt = w.tid & 255, task = task0 + slot;
    const int bh = task >> 4, c = task & 15, b = bh >> 2, h = bh & 3;
    LAS float* sw = (LAS float*)w.lds + slot * 16384; LAS float* sn = sw + 2048; LAS float* sb = sn + 2048; LAS float* sk = sb + 2048; LAS float* sr = sk + 2048; LAS float* sv = sr + 2048; LAS float* so = sv + 2048;
    const float* RWA = (const float*)(A.ws + WS_RWA);
    const int rg = w.lane >> 3, kq = w.lane & 7;
    f32x2 S[4][4];
#pragma unroll
    for (int i = 0; i < 4; ++i)
#pragma unroll
        for (int j = 0; j < 4; ++j) { const int r = RW_ROW(i); S[i][j].x = (r >= 64 && 8 * kq + 2 * j == r - 64) ? 1.0f : 0.0f; S[i][j].y = (r >= 64 && 8 * kq + 2 * j + 1 == r - 64) ? 1.0f : 0.0f; }
    const size_t tok0 = (size_t)b * SEQ + (size_t)c * TCH;
    const int st = lt >> 3, sd = (lt & 7) * 8;
    f32x4 a[6][2];
#define RW_GLOAD(sub_) do { const size_t o_ = (tok0 + (sub_) * 32 + st) * 256 + h * 64 + sd; \
        _Pragma("unroll") for (int q = 0; q < 2; ++q) { a[0][q] = *(const f32x4*)(RWA + 1 * RWA_STRIDE + o_ + 4 * q); a[1][q] = *(const f32x4*)(RWA + 4 * RWA_STRIDE + o_ + 4 * q); a[2][q] = *(const f32x4*)(RWA + 5 * RWA_STRIDE + o_ + 4 * q); \
            a[3][q] = *(const f32x4*)(RWA + 2 * RWA_STRIDE + o_ + 4 * q); a[4][q] = *(const f32x4*)(RWA + 0 * RWA_STRIDE + o_ + 4 * q); a[5][q] = *(const f32x4*)(RWA + 3 * RWA_STRIDE + o_ + 4 * q); } } while (0)
    RW_GLOAD(0);
    for (int sub = 0; sub < TCH / 32; ++sub) {
        __syncthreads();
        { const int lo = st * 64 + sd;
#pragma unroll
          for (int q = 0; q < 2; ++q) { *(LAS f32x4*)(sw + lo + 4 * q) = a[0][q]; *(LAS f32x4*)(sn + lo + 4 * q) = a[1][q]; *(LAS f32x4*)(sb + lo + 4 * q) = a[2][q]; *(LAS f32x4*)(sk + lo + 4 * q) = a[3][q]; *(LAS f32x4*)(sr + lo + 4 * q) = a[4][q]; *(LAS f32x4*)(sv + lo + 4 * q) = a[5][q]; } }
        __syncthreads();
        if (sub + 1 < TCH / 32) RW_GLOAD(sub + 1);
        { f32x4 opA[10], opB[10]; float vin[2], vA[2], vB[2];
          RW_LOAD(opA, 0);
          vA[0] = vin[0]; vA[1] = vin[1];
#pragma unroll 1
          for (int s = 0; s < 32; s += 2) {
              RW_LOAD(opB, s + 1);
              vB[0] = vin[0]; vB[1] = vin[1];
              RW_STEP(opA, vA, s);
              if (s + 2 < 32) { RW_LOAD(opA, s + 2); vA[0] = vin[0]; vA[1] = vin[1]; }
              RW_STEP(opB, vB, s + 1);
          } }
        __syncthreads();
        { const int fs = lt >> 3, c16 = (lt & 7) * 16;
          float* dst = (c16 < 64) ? ((float*)(A.ws + WS_YO) + YO_STRIDE) : ((float*)(A.ws + WS_PT) - 64);
          float* dp = dst + (tok0 + sub * 32 + fs) * 256 + h * 64 + c16;
#pragma unroll
          for (int q = 0; q < 4; ++q) *(f32x4*)(dp + 4 * q) = *(const LAS f32x4*)(so + fs * 128 + c16 + 4 * q); }
    }
    { float* ch = (float*)(A.ws + WS_CH) + ((size_t)(bh * NCH + c) * 128) * 64 + 8 * kq;
#pragma unroll
      for (int i = 0; i < 4; ++i) { float* cr = ch + (size_t)RW_ROW(i) * 64; *(f32x4*)cr = (f32x4){S[i][0].x, S[i][0].y, S[i][1].x, S[i][1].y}; *(f32x4*)(cr + 4) = (f32x4){S[i][2].x, S[i][2].y, S[i][3].x, S[i][3].y}; } }
    __syncthreads();
}
#undef RW_LOAD
#undef RW_STEP
#undef RW_GLOAD
#undef RW_DOT
#undef RW_ROW
__device__ __forceinline__ void scan_ret_task(ARef A, const WI& w, int task) {
    const int bh = task >> 3, cp = task & 7, b = bh >> 2, h = bh & 3, un = w.tid >> 8, lt = w.tid & 255, c = 2 * cp + un;
    const float lg2g = log2f(1.0f - exp2f(-5.0f - (float)h)), gamma = exp2f(lg2g);
    LAS float* sk = (LAS float*)w.lds + un * 8192; LAS float* sq = sk + 2048; LAS float* sv = sq + 2048; LAS float* so = sv + 2048;
    const bf16* PB = (const bf16*)(A.ws + WS_PB); const float* RT = (const float*)(A.ws + WS_ROPE);
    const int row = lt >> 2, kq = lt & 3;
    f32x2 S[8];
#pragma unroll
    for (int j = 0; j < 8; ++j) S[j] = (f32x2){0.0f, 0.0f};
    const f32x2 gam2 = {gamma, gamma};
    const size_t tok0 = (size_t)b * SEQ + (size_t)c * TCH;
    const int st = lt >> 3, sd = (lt & 7) * 8;
    const int fi = sd & 31, dp = sd ^ 32;
    f32x4 gq[2], gqo[2], gk[2], gko[2], gv[2], gcs[2], gsn[2];
#define BF8_TO_F32(dst, x_) do { dst[0] = (f32x4){bf_lo(x_.x), bf_hi(x_.x), bf_lo(x_.y), bf_hi(x_.y)}; dst[1] = (f32x4){bf_lo(x_.z), bf_hi(x_.z), bf_lo(x_.w), bf_hi(x_.w)}; } while (0)
#define RT_GLOAD(sub_) do { const size_t m_ = tok0 + (sub_) * 32 + st; const bf16* pr_ = PB + m_ * PBW + h * 64; const float* rt_ = RT + m_ * ROPE_W; \
        _Pragma("unroll") for (int u = 0; u < 2; ++u) { gcs[u] = *(const f32x4*)(rt_ + fi + 4 * u); gsn[u] = *(const f32x4*)(rt_ + 32 + fi + 4 * u); } \
        { const v4u x0 = *(const v4u*)(pr_ + sd), x1 = *(const v4u*)(pr_ + dp), x2 = *(const v4u*)(pr_ + 256 + sd), x3 = *(const v4u*)(pr_ + 256 + dp), x4 = *(const v4u*)(pr_ + 512 + sd); \
          BF8_TO_F32(gq, x0); BF8_TO_F32(gqo, x1); BF8_TO_F32(gk, x2); BF8_TO_F32(gko, x3); BF8_TO_F32(gv, x4); } } while (0)
    RT_GLOAD(0);
    for (int sub = 0; sub < TCH / 32; ++sub) {
        const size_t m = tok0 + sub * 32 + st;
        f32x4 qn[2], kn[2], vn[2];
#pragma unroll
        for (int u = 0; u < 2; ++u) { qn[u] = (sd < 32) ? gq[u] * gcs[u] - gqo[u] * gsn[u] : gqo[u] * gsn[u] + gq[u] * gcs[u]; kn[u] = (sd < 32) ? gk[u] * gcs[u] - gko[u] * gsn[u] : gko[u] * gsn[u] + gk[u] * gcs[u]; vn[u] = gv[u]; }
        { const float gt = exp2f(lg2g * (float)(sub * 32 + st + 1)); const f32x4 p0 = qn[0] * gt, p1 = qn[1] * gt;
          v4u pw; pw.x = pk2(p0.x, p0.y); pw.y = pk2(p0.z, p0.w); pw.z = pk2(p1.x, p1.y); pw.w = pk2(p1.z, p1.w); *(v4u*)((bf16*)(A.ws + WS_PTR) + m * 256 + h * 64 + sd) = pw; }
        __syncthreads();
        { const int lo = st * 64 + sd; *(LAS f32x4*)(sq + lo) = qn[0]; *(LAS f32x4*)(sq + lo + 4) = qn[1]; *(LAS f32x4*)(sk + lo) = kn[0]; *(LAS f32x4*)(sk + lo + 4) = kn[1]; *(LAS f32x4*)(sv + lo) = vn[0]; *(LAS f32x4*)(sv + lo + 4) = vn[1]; }
        __syncthreads();
        if (sub + 1 < TCH / 32) RT_GLOAD(sub + 1);
        for (int s = 0; s < 32; ++s) {
            const int lo = s * 64 + kq * 16; const float vv = sv[s * 64 + row]; const f32x2 v2 = {vv, vv}; f32x2 y2 = {0.0f, 0.0f};
#pragma unroll
            for (int j4 = 0; j4 < 4; ++j4) { const f32x4 kv = *(const LAS f32x4*)(sk + lo + 4 * j4), rv = *(const LAS f32x4*)(sq + lo + 4 * j4);
                S[2 * j4] = S[2 * j4] * gam2 + v2 * LO2(kv); S[2 * j4 + 1] = S[2 * j4 + 1] * gam2 + v2 * HI2(kv);
                y2 = S[2 * j4] * LO2(rv) + y2; y2 = S[2 * j4 + 1] * HI2(rv) + y2; }
            float y = quad_sum(y2.x + y2.y);
            if (kq == 0) so[s * 64 + row] = y;
        }
        __syncthreads();
        { const int fs = lt >> 3, c8 = (lt & 7) * 8; float* dp2 = (float*)(A.ws + WS_YO) + (tok0 + sub * 32 + fs) * 256 + h * 64 + c8;
          *(f32x4*)dp2 = *(const LAS f32x4*)(so + fs * 64 + c8); *(f32x4*)(dp2 + 4) = *(const LAS f32x4*)(so + fs * 64 + c8 + 4); }
    }
    { float* ch = (float*)(A.ws + WS_CHR) + ((size_t)(bh * NCH + c) * 64 + row) * 64 + 16 * kq;
#pragma unroll
      for (int j4 = 0; j4 < 4; ++j4) *(f32x4*)(ch + 4 * j4) = (f32x4){S[2 * j4].x, S[2 * j4].y, S[2 * j4 + 1].x, S[2 * j4 + 1].y}; }
    __syncthreads();
}
#undef RT_GLOAD
#undef BF8_TO_F32
__device__ __forceinline__ void prefix_chain(ARef A, const WI& w, int bh) {
    LAS float* s0 = (LAS float*)w.lds;
    const int v = w.tid >> 3, k8 = (w.tid & 7) * 8;
    const float* CH = (const float*)(A.ws + WS_CH) + (size_t)bh * NCH * 128 * 64; float* SI = (float*)(A.ws + WS_SI) + (size_t)bh * NCH * 64 * 64;
    f32x4 c0 = {0.f, 0.f, 0.f, 0.f}, c1 = {0.f, 0.f, 0.f, 0.f};
    for (int c = 0; c < NCH; ++c) {
        *(f32x4*)(SI + ((size_t)c * 64 + v) * 64 + k8) = c0; *(f32x4*)(SI + ((size_t)c * 64 + v) * 64 + k8 + 4) = c1;
        if (c == NCH - 1) break;
        __syncthreads();
        *(LAS f32x4*)(s0 + v * 68 + k8) = c0; *(LAS f32x4*)(s0 + v * 68 + k8 + 4) = c1;
        __syncthreads();
        const float* ch = CH + (size_t)c * 128 * 64;
        f32x4 n0 = *(const f32x4*)(ch + (size_t)v * 64 + k8), n1 = *(const f32x4*)(ch + (size_t)v * 64 + k8 + 4);
#pragma unroll 8
        for (int kp = 0; kp < 64; ++kp) { const float s = s0[v * 68 + kp]; const float* pr = ch + (size_t)(64 + kp) * 64 + k8; n0 += s * *(const f32x4*)pr; n1 += s * *(const f32x4*)(pr + 4); }
        c0 = n0; c1 = n1;
    }
    const int h = bh & 3; const float gT = exp2f((float)TCH * log2f(1.0f - exp2f(-5.0f - (float)h)));
    const float* CHR = (const float*)(A.ws + WS_CHR) + (size_t)bh * NCH * 64 * 64; float* SIR = (float*)(A.ws + WS_SIR) + (size_t)bh * NCH * 64 * 64;
    c0 = (f32x4){0.f, 0.f, 0.f, 0.f}; c1 = c0;
    for (int c = 0; c < NCH; ++c) {
        *(f32x4*)(SIR + ((size_t)c * 64 + v) * 64 + k8) = c0; *(f32x4*)(SIR + ((size_t)c * 64 + v) * 64 + k8 + 4) = c1;
        if (c == NCH - 1) break;
        c0 = c0 * gT + *(const f32x4*)(CHR + ((size_t)c * 64 + v) * 64 + k8); c1 = c1 * gT + *(const f32x4*)(CHR + ((size_t)c * 64 + v) * 64 + k8 + 4);
    }
    __syncthreads();
}
typedef float f32x16 __attribute__((ext_vector_type(16)));
constexpr int SBV_PITCH = 144;
__device__ __forceinline__ float lane32_swap(float v) { return __shfl_xor(v, 32); }
__device__ __forceinline__ void sb_tile_mfma(ARef A, int unit, int lane, LAS unsigned char* vl) {
    const int tq = unit & 127, bh = unit >> 7, b = bh >> 2, h = bh & 3, t0 = tq * 32, r32 = lane & 31, hi = lane >> 5;
    const bf16* PS = (const bf16*)(A.ws + WS_PB) + (size_t)b * SEQ * PBW + PB_SB + h * 64;
    bf16x8v qf[4];
#pragma unroll
    for (int ks = 0; ks < 4; ++ks) qf[ks] = *(const bf16x8v*)(PS + (size_t)(t0 + r32) * PBW + 16 * ks + 8 * hi);
    f32x16 o0, o1;
#pragma unroll
    for (int r = 0; r < 16; ++r) { o0[r] = 0.0f; o1[r] = 0.0f; }
    float carry = 0.0f;
    const int g16 = lane >> 4, tj = (lane & 15) >> 2, tc = lane & 3;
    v4u vn[4]; bf16x8v kn[4];
#define SB_FETCH(kb_) do { _Pragma("unroll") for (int i = 0; i < 4; ++i) { const int p = lane + 64 * i, row = p >> 3, ch = p & 7; vn[i] = *(const v4u*)(PS + 512 + (size_t)((kb_) + row) * PBW + 8 * ch); } \
        _Pragma("unroll") for (int ks = 0; ks < 4; ++ks) kn[ks] = *(const bf16x8v*)(PS + 256 + (size_t)((kb_) + r32) * PBW + 16 * ks + 8 * hi); } while (0)
    SB_FETCH(t0);
    for (int kb0 = t0; kb0 >= 0; kb0 -= 32) {
#pragma unroll
        for (int i = 0; i < 4; ++i) { const int p = lane + 64 * i, row = p >> 3, ch = p & 7; *(LAS v4u*)(vl + row * SBV_PITCH + 16 * ch) = vn[i]; }
        f32x16 st;
#pragma unroll
        for (int r = 0; r < 16; ++r) st[r] = 0.0f;
        { bf16x8v ka[4];
#pragma unroll
          for (int ks = 0; ks < 4; ++ks) ka[ks] = kn[ks];
          if (kb0 >= 32) SB_FETCH(kb0 - 32);
#pragma unroll
          for (int ks = 0; ks < 4; ++ks) st = __builtin_amdgcn_mfma_f32_32x32x16_bf16(ka[ks], qf[ks], st, 0, 0, 0);
          asm volatile("" :: "v"(ka[0]), "v"(ka[1]), "v"(ka[2]), "v"(ka[3]), "v"(st)); }
        float sp[16]; const bool diag = (kb0 == t0);
#pragma unroll
        for (int r = 0; r < 16; ++r) { const float zl = st[r]; float s = (zl > 30.0f) ? zl : __builtin_amdgcn_logf(1.0f + __builtin_amdgcn_exp2f(zl));
            if (diag && ((r & 3) + 8 * (r >> 2) + 4 * hi >= r32)) s = 0.0f;
            sp[r] = s; }
        float G[4], Gp[4], suf[4];
#pragma unroll
        for (int q = 0; q < 4; ++q) { G[q] = (sp[4 * q] + sp[4 * q + 1]) + (sp[4 * q + 2] + sp[4 * q + 3]); Gp[q] = lane32_swap(G[q]); }
        suf[3] = 0.0f; suf[2] = G[3] + Gp[3]; suf[1] = suf[2] + (G[2] + Gp[2]); suf[0] = suf[1] + (G[1] + Gp[1]);
        const float tot = suf[0] + (G[0] + Gp[0]);
        pg8::u32x4 pw0, pw1;
        float av[16];
#pragma unroll
        for (int q = 0; q < 4; ++q) { float run = carry + suf[q] + (hi == 0 ? Gp[q] : 0.0f);
#pragma unroll
            for (int i = 3; i >= 0; --i) { const int r = 4 * q + i; const float la = (st[r] - sp[r]) - run; float a = __builtin_amdgcn_exp2f(la);
                if (diag && ((r & 3) + 8 * (r >> 2) + 4 * hi >= r32)) a = 0.0f;
                av[r] = a; run += sp[r]; } }
        pw0.x = pg8::cvt_pk_bf16(av[0], av[1]); pw0.y = pg8::cvt_pk_bf16(av[2], av[3]); pw0.z = pg8::cvt_pk_bf16(av[4], av[5]); pw0.w = pg8::cvt_pk_bf16(av[6], av[7]);
        pw1.x = pg8::cvt_pk_bf16(av[8], av[9]); pw1.y = pg8::cvt_pk_bf16(av[10], av[11]); pw1.z = pg8::cvt_pk_bf16(av[12], av[13]); pw1.w = pg8::cvt_pk_bf16(av[14], av[15]);
        const bf16x8v pa0 = __builtin_bit_cast(bf16x8v, pw0), pa1 = __builtin_bit_cast(bf16x8v, pw1);
        LDS_WAIT();
#pragma unroll
        for (int s = 0; s < 2; ++s)
#pragma unroll
            for (int nb = 0; nb < 2; ++nb) {
                LAS unsigned char* a1 = vl + (16 * s + 4 * (g16 >> 1) + tj) * SBV_PITCH + (32 * nb + 16 * (g16 & 1) + 4 * tc) * 2;
                const s16x4v r1 = __builtin_bit_cast(s16x4v, __builtin_amdgcn_ds_read_tr16_b64_v4i16((LAS s16x4v*)a1));
                const s16x4v r2 = __builtin_bit_cast(s16x4v, __builtin_amdgcn_ds_read_tr16_b64_v4i16((LAS s16x4v*)(a1 + 8 * SBV_PITCH)));
                const bf16x8v bv = {r1[0], r1[1], r1[2], r1[3], r2[0], r2[1], r2[2], r2[3]};
                if (nb == 0) o0 = __builtin_amdgcn_mfma_f32_32x32x16_bf16(s ? pa1 : pa0, bv, o0, 0, 0, 0); else o1 = __builtin_amdgcn_mfma_f32_32x32x16_bf16(s ? pa1 : pa0, bv, o1, 0, 0, 0);
                asm volatile("" :: "v"(bv), "v"(pa0), "v"(pa1), "v"(o0), "v"(o1)); }
        LDS_WAIT();
        carry += tot;
        if (__all(carry > 150.0f)) break;
    }
#undef SB_FETCH
    float* YS = (float*)(A.ws + WS_YO) + 3 * YO_STRIDE + ((size_t)b * SEQ + t0) * 256 + h * 64 + r32;
#pragma unroll
    for (int r = 0; r < 16; ++r) { const int qo = (r & 3) + 8 * (r >> 2) + 4 * hi; YS[(size_t)qo * 256] = o0[r]; YS[(size_t)qo * 256 + 32] = o1[r]; }
}

__device__ __forceinline__ void dsa_scores_mfma(ARef A, const WI& w) {
    const _Float16* QIH = (const _Float16*)(A.ws + WS_DQI); const _Float16* KIH = (const _Float16*)(A.ws + WS_DKI);
    const float* DW = (const float*)(A.ws + WS_DW); float* SC = (float*)(A.ws + WS_SC);
    const int col = w.lane & 15, q4 = w.lane >> 4;
    for (int u = w.gw; u < 2048; u += w.NGW) {
        const int pi = u >> 1, par = u & 1, b = pi >> 7, p = pi & 127;
#pragma unroll 1
        for (int side = 0; side < 2; ++side) {
            const int qb = side ? 255 - p : p; const size_t m0 = (size_t)b * SEQ + 16 * qb;
            f16x8 bq[8];
#pragma unroll
            for (int h = 0; h < 8; ++h) bq[h] = *(const f16x8*)(QIH + (m0 + col) * 256 + h * 32 + 8 * q4);
            const float* dw = DW + (m0 + col) * 8; const f32x4 wa = *(const f32x4*)dw, wb = *(const f32x4*)(dw + 4);
            float* srow = SC + (m0 + col) * SEQ + 4 * q4;
            const _Float16* kbase = KIH + ((size_t)b * SEQ + col) * 32 + 8 * q4;
            for (int kp = par; 2 * kp <= qb; kp += 4) {
                f16x8 ak[4];
#pragma unroll
                for (int q = 0; q < 4; ++q) { const int kb = 2 * (kp + 2 * (q >> 1)) + (q & 1); ak[q] = *(const f16x8*)(kbase + (size_t)(kb <= qb ? kb : qb) * 16 * 32); }
#pragma unroll
                for (int q = 0; q < 4; ++q) { const int kb = 2 * (kp + 2 * (q >> 1)) + (q & 1);
                    if (kb <= qb) {
                        f32x4 acc = {0.f, 0.f, 0.f, 0.f};
#pragma unroll
                        for (int h = 0; h < 8; ++h) { const f32x4 c = __builtin_amdgcn_mfma_f32_16x16x32_f16(ak[q], bq[h], (f32x4){0.f, 0.f, 0.f, 0.f}, 0, 0, 0); const float wv = (h < 4) ? wa[h] : wb[h - 4];
                            acc.x += wv * fmaxf(c.x, 0.f); acc.y += wv * fmaxf(c.y, 0.f); acc.z += wv * fmaxf(c.z, 0.f); acc.w += wv * fmaxf(c.w, 0.f); }
                        *(f32x4*)(srow + 16 * kb) = acc + 0.0f; } }
            }
        }
    }
}

__device__ __forceinline__ int wave_total_i(int v) {
    v += __builtin_amdgcn_mov_dpp(v, 0xB1, 0xF, 0xF, true);
    v += __builtin_amdgcn_mov_dpp(v, 0x4E, 0xF, 0xF, true);
    v += __builtin_amdgcn_mov_dpp(v, 0x141, 0xF, 0xF, true);
    v += __builtin_amdgcn_mov_dpp(v, 0x140, 0xF, 0xF, true);
    return __builtin_amdgcn_readlane(v, 0) + __builtin_amdgcn_readlane(v, 16) + __builtin_amdgcn_readlane(v, 32) + __builtin_amdgcn_readlane(v, 48);
}
__device__ __forceinline__ unsigned score_key(float f) { const unsigned bits = __float_as_uint(f); return (bits & 0x80000000u) ? ~bits : (bits | 0x80000000u); }
constexpr int VST_PITCH = 144;
typedef unsigned short u16;
__device__ __forceinline__ void dsa_load_scores(ARef A, int m, int lane, f32x4 (&sv)[16]) {
    const int n = (m & (SEQ - 1)) + 1; const float* sc = (const float*)(A.ws + WS_SC) + (size_t)m * SEQ;
#pragma unroll
    for (int j4 = 0; j4 < 16; ++j4) sv[j4] = *(const f32x4*)(sc + ((256 * j4 < n) ? 256 * j4 : 0) + 4 * lane);
}
__device__ __forceinline__ void dsa_select(ARef A, int m, int n, int lane_in, LAS u16* slist, LAS unsigned* bk) {
    int lane = lane_in; asm volatile("" : "+v"(lane));
    if (n <= 256) {
#pragma unroll
        for (int c = 0; c < 4; ++c) { const int idx = lane + 64 * c; slist[idx] = (u16)((idx < n) ? idx : 0); }
        return;
    }
    f32x4 sv[16]; dsa_load_scores(A, m, lane, sv);
    unsigned u[64];
#pragma unroll
    for (int j4 = 0; j4 < 16; ++j4)
#pragma unroll
        for (int i = 0; i < 4; ++i) u[4 * j4 + i] = (256 * j4 + 4 * lane + i < n) ? score_key(sv[j4][i]) : 0u;
    unsigned T = 0u;
    for (int bit = 31; bit >= 16; --bit) { const unsigned cand = T | (1u << bit); int cnt = 0;
#pragma unroll
        for (int j = 0; j < 64; ++j) cnt += (u[j] >= cand) ? 1 : 0;
        if (wave_total_i(cnt) >= 256) T = cand; }
    unsigned long long bkb = 0ull; int chi = 0;
#pragma unroll
    for (int j = 0; j < 64; ++j) { bkb |= (unsigned long long)(((u[j] >> 16) == (T >> 16)) ? 1u : 0u) << j; chi += ((u[j] >> 16) > (T >> 16)) ? 1 : 0; }
    const int cb = wave_total_i(__popcll(bkb)), need = 256 - wave_total_i(chi);
    if (cb <= 64) {
        int pos = __popcll(bkb);
        { const int mine_ = pos;
#pragma unroll
          for (int d = 1; d < 64; d <<= 1) { const int y = __shfl_up(pos, d); if (lane >= d) pos += y; }
          pos -= mine_; }
#pragma unroll
        for (int j = 0; j < 64; ++j) { if ((bkb >> j) & 1ull) { bk[pos] = u[j]; ++pos; } }
        LDS_WAIT();
        const unsigned kx = (lane < cb) ? bk[lane] : 0u;
        for (int bit = 15; bit >= 0; --bit) { const unsigned cand = T | (1u << bit); if (__popcll(__ballot(kx >= cand)) >= need) T = cand; }
        LDS_WAIT();
    } else {
        for (int bit = 15; bit >= 0; --bit) { const unsigned cand = T | (1u << bit); int cnt = 0;
#pragma unroll
            for (int j = 0; j < 64; ++j) cnt += (u[j] >= cand) ? 1 : 0;
            if (wave_total_i(cnt) >= 256) T = cand; }
    }
    unsigned long long gtb = 0ull, eqb = 0ull;
#pragma unroll
    for (int j = 0; j < 64; ++j) { gtb |= (unsigned long long)((u[j] > T) ? 1u : 0u) << j; eqb |= (unsigned long long)((u[j] == T) ? 1u : 0u) << j; }
    const int tgt = wave_total_i(__popcll(gtb)), teq = wave_total_i(__popcll(eqb));
    unsigned long long selb = gtb | eqb;
    if (tgt + teq > 256) {
        const int take = 256 - tgt; int lo = 0;
        for (int bit = 11; bit >= 0; --bit) { const int cand = lo | (1 << bit); const int J4 = cand >> 8; int ni = (cand & 255) - 4 * lane; ni = ni < 0 ? 0 : (ni > 4 ? 4 : ni);
            const int jc = 4 * J4 + ni; const unsigned long long msk = (jc >= 64) ? ~0ull : ((1ull << jc) - 1ull);
            if (wave_total_i(__popcll(eqb & msk)) < take) lo = cand; }
        { const int cand = lo + 1; const int J4 = cand >> 8; int ni = (cand & 255) - 4 * lane; ni = ni < 0 ? 0 : (ni > 4 ? 4 : ni);
          const int jc = (cand >= SEQ) ? 64 : 4 * J4 + ni; const unsigned long long msk = (jc >= 64) ? ~0ull : ((1ull << jc) - 1ull); selb = gtb | (eqb & msk); }
    }
    const int mine = __popcll(selb); int off = mine;
#pragma unroll
    for (int d = 1; d < 64; d <<= 1) { const int y = __shfl_up(off, d); if (lane >= d) off += y; }
    off -= mine;
    while (selb) { const int j = __builtin_ctzll(selb); selb &= selb - 1ull; slist[off] = (u16)(256 * (j >> 2) + 4 * lane + (j & 3)); ++off; }
}
__device__ __forceinline__ void dsa_attend(ARef A, int m, int lane_in, const LAS u16* slist, LAS unsigned char* vbuf) {
    int lane = lane_in; asm volatile("" : "+v"(lane));
    const int b = m >> 12, t = m & (SEQ - 1), n = t + 1, nsel = n < 256 ? n : 256, col = lane & 15, q4 = lane >> 4;
    const bf16* DKB = (const bf16*)(A.ws + WS_DKB) + (size_t)b * SEQ * 64; const bf16* DVB = (const bf16*)(A.ws + WS_DVB) + (size_t)b * SEQ * 64;
    const int vrow = lane >> 3, vpc = lane & 7;
    bf16x8v bq0 = {0, 0, 0, 0, 0, 0, 0, 0}, bq1 = {0, 0, 0, 0, 0, 0, 0, 0};
    if (col < 4) { const bf16* qp = (const bf16*)(A.ws + WS_DQ) + (size_t)m * 256 + col * 64 + 8 * q4; bq0 = *(const bf16x8v*)qp; bq1 = *(const bf16x8v*)(qp + 32); }
    f32x4 lg[16];
#pragma unroll
    for (int hb = 0; hb < 2; ++hb) {
        bf16x8v a0[8], a1[8];
#pragma unroll
        for (int k = 0; k < 8; ++k) { const int s = slist[16 * (8 * hb + k) + col]; const bf16* kr = DKB + (size_t)s * 64 + 8 * q4; a0[k] = *(const bf16x8v*)kr; a1[k] = *(const bf16x8v*)(kr + 32); }
#pragma unroll
        for (int k = 0; k < 8; ++k) { const f32x4 c = __builtin_amdgcn_mfma_f32_16x16x32_bf16(a0[k], bq0, (f32x4){0.f, 0.f, 0.f, 0.f}, 0, 0, 0); lg[8 * hb + k] = __builtin_amdgcn_mfma_f32_16x16x32_bf16(a1[k], bq1, c, 0, 0, 0); }
        __builtin_amdgcn_sched_barrier(0);
    }
    if (nsel < 256) {
#pragma unroll
        for (int kb = 0; kb < 16; ++kb)
#pragma unroll
            for (int r = 0; r < 4; ++r) if (16 * kb + 4 * q4 + r >= nsel) lg[kb][r] = -INFINITY; }
    v4u vr[4];
#pragma unroll
    for (int i = 0; i < 4; ++i) { const int s = slist[vrow + 8 * i]; vr[i] = *(const v4u*)(DVB + (size_t)s * 64 + 8 * vpc); }
    float mx = -INFINITY;
#pragma unroll
    for (int kb = 0; kb < 16; ++kb) mx = fmaxf(fmaxf(mx, fmaxf(lg[kb].x, lg[kb].y)), fmaxf(lg[kb].z, lg[kb].w));
    mx = fmaxf(mx, __shfl_xor(mx, 16)); mx = fmaxf(mx, __shfl_xor(mx, 32));
    float sm = 0.f;
#pragma unroll
    for (int kb = 0; kb < 16; ++kb) { lg[kb].x = __builtin_amdgcn_exp2f(lg[kb].x - mx); lg[kb].y = __builtin_amdgcn_exp2f(lg[kb].y - mx); lg[kb].z = __builtin_amdgcn_exp2f(lg[kb].z - mx); lg[kb].w = __builtin_amdgcn_exp2f(lg[kb].w - mx); sm += (lg[kb].x + lg[kb].y) + (lg[kb].z + lg[kb].w); }
    sm += __shfl_xor(sm, 16); sm += __shfl_xor(sm, 32);
    const float inv = 1.0f / sm;
    bf16x8v pa[8];
#pragma unroll
    for (int i = 0; i < 8; ++i) { const f32x4 x = lg[2 * i] * inv, y = lg[2 * i + 1] * inv;
        pg8::u32x4 wv; wv.x = pg8::cvt_pk_bf16(x.x, x.y); wv.y = pg8::cvt_pk_bf16(x.z, x.w); wv.z = pg8::cvt_pk_bf16(y.x, y.y); wv.w = pg8::cvt_pk_bf16(y.z, y.w);
        pa[i] = __builtin_bit_cast(bf16x8v, wv); }
    f32x4 o[4];
#pragma unroll
    for (int nb = 0; nb < 4; ++nb) o[nb] = (f32x4){0.f, 0.f, 0.f, 0.f};
    const int tj = col >> 2, tc = col & 3;
#pragma unroll
    for (int c = 0; c < 8; ++c) {
        LAS unsigned char* vb = vbuf + (c & 1) * (32 * VST_PITCH);
#pragma unroll
        for (int i = 0; i < 4; ++i) *(LAS v4u*)(vb + (vrow + 8 * i) * VST_PITCH + 16 * vpc) = vr[i];
        if (c < 7) {
#pragma unroll
            for (int i = 0; i < 4; ++i) { const int s = slist[32 * (c + 1) + vrow + 8 * i]; vr[i] = *(const v4u*)(DVB + (size_t)s * 64 + 8 * vpc); } }
        LDS_WAIT();
#pragma unroll
        for (int nb = 0; nb < 4; ++nb) {
            LAS unsigned char* a1 = vb + (4 * q4 + tj) * VST_PITCH + (16 * nb + 4 * tc) * 2;
            const s16x4v r1 = __builtin_bit_cast(s16x4v, __builtin_amdgcn_ds_read_tr16_b64_v4i16((LAS s16x4v*)a1));
            const s16x4v r2 = __builtin_bit_cast(s16x4v, __builtin_amdgcn_ds_read_tr16_b64_v4i16((LAS s16x4v*)(a1 + 16 * VST_PITCH)));
            const bf16x8v bv = {r1[0], r1[1], r1[2], r1[3], r2[0], r2[1], r2[2], r2[3]};
            o[nb] = __builtin_amdgcn_mfma_f32_16x16x32_bf16(pa[c], bv, o[nb], 0, 0, 0); }
    }
    LDS_WAIT();
    if (lane < 16) { float* YD = (float*)(A.ws + WS_YO) + 2 * YO_STRIDE + (size_t)m * 256;
#pragma unroll
        for (int nb = 0; nb < 4; ++nb) { YD[16 * nb + lane] = o[nb].x; YD[64 + 16 * nb + lane] = o[nb].y; YD[128 + 16 * nb + lane] = o[nb].z; YD[192 + 16 * nb + lane] = o[nb].w; } }
}
constexpr int DSA_GR = 1;
__device__ __forceinline__ int dsa_row_of(int batch, int gi, int r) { const int idx = DSA_GR * gi + r, h = idx >> 1; return batch * SEQ + ((idx & 1) ? (SEQ - 1 - h) : h); }
__device__ __forceinline__ void dsa_wave(ARef A, const WI& w, LAS unsigned char* wl, int qi) {
    LAS u16* lists = (LAS u16*)wl; LAS unsigned char* vbuf = wl + 4096; LAS unsigned* bk = (LAS unsigned*)vbuf;
#pragma unroll 1
    for (int kb = 0; kb < NB; ++kb) {
        const int batch = (w.bx + kb) & (NB - 1);
        unsigned* head = (unsigned*)(A.ws + WS_CTL) + CW_DSAQ + 128 * qi + 16 * batch;
        for (;;) {
            int g = 0; if (w.lane == 0) g = (int)atomicAdd(head, 1u);
            g = __builtin_amdgcn_readfirstlane(g);
            if (g >= SEQ / DSA_GR) break;
#pragma unroll 1
            for (int r = 0; r < DSA_GR; ++r) { const int m = dsa_row_of(batch, g, r), n = (m & (SEQ - 1)) + 1; dsa_select(A, m, n, w.lane, lists + r * 256, bk); }
            LDS_WAIT();
#pragma unroll 1
            for (int r = 0; r < DSA_GR; ++r) dsa_attend(A, dsa_row_of(batch, g, r), w.lane, lists + r * 256, vbuf);
        }
    }
}

__device__ __forceinline__ f32x4 head_norm4(f32x4 y, float eps, f32x4 g) {
    const float mean = grp16_sum(sum4(y)) * (1.0f / 64.0f); const f32x4 yc = y - mean;
    const float var = grp16_sum(dot4(yc, yc)) * (1.0f / 64.0f); return yc * (1.0f / sqrtf(var + eps)) * g;
}
template <bool BF> __device__ __forceinline__ f32x4 state_corr(const LAS float* sl, int hh, int r16, const void* pv) {
    const LAS float* r0 = sl + (hh * 64 + 4 * r16) * 64; const int x0 = (4 * r16) & 15;
    f32x4 out = {0.f, 0.f, 0.f, 0.f};
#pragma unroll 2
    for (int k8 = 0; k8 < 8; ++k8) {
        f32x4 pa, pb;
        if (BF) { const v4u x = ((const v4u*)pv)[k8]; pa = (f32x4){bf_lo(x.x), bf_hi(x.x), bf_lo(x.y), bf_hi(x.y)}; pb = (f32x4){bf_lo(x.z), bf_hi(x.z), bf_lo(x.w), bf_hi(x.w)}; }
        else { pa = ((const f32x4*)pv)[2 * k8]; pb = ((const f32x4*)pv)[2 * k8 + 1]; }
#pragma unroll
        for (int i = 0; i < 4; ++i) { const LAS float* rowp = r0 + i * 64; const int xs = (x0 + i) & 15;
            out[i] += dot4(*(const LAS f32x4*)(rowp + 4 * ((2 * k8) ^ xs)), pa) + dot4(*(const LAS f32x4*)(rowp + 4 * ((2 * k8 + 1) ^ xs)), pb); }
    }
    return out;
}
__device__ __forceinline__ void post_row(ARef A, int l, int m, int lane, const LAS float* slw, const LAS float* slr) {
    const float* YO = (const float*)(A.ws + WS_YO); const float* RWA = (const float*)(A.ws + WS_RWA);
    bf16* MX = (bf16*)(A.ws + WS_MIX) + (size_t)m * DM; const int c4 = 4 * lane, hh = lane >> 4, r16 = lane & 15; const size_t o = (size_t)m * 256 + c4;
    { f32x4 y = *(const f32x4*)(YO + o) + state_corr<true>(slr, hh, r16, (const bf16*)(A.ws + WS_PTR) + (size_t)m * 256 + hh * 64);
      y = head_norm4(y, 1e-5f, *(const f32x4*)(A.in[I_RETGN] + l * 256 + c4));
      const v2u gw_ = *(const v2u*)((const bf16*)(A.ws + WS_PB) + (size_t)m * PBW + 768 + c4); const f32x4 g = {bf_lo(gw_.x), bf_hi(gw_.x), bf_lo(gw_.y), bf_hi(gw_.y)};
#pragma unroll
      for (int i = 0; i < 4; ++i) y[i] *= g[i] * sigm(g[i]);
      v2u w; w.x = pk2(y.x, y.y); w.y = pk2(y.z, y.w); *(v2u*)(MX + c4) = w; }
    { f32x4 y = *(const f32x4*)(YO + YO_STRIDE + o) + state_corr<false>(slw, hh, r16, (const float*)(A.ws + WS_PT) + (size_t)m * 256 + hh * 64);
      y = head_norm4(y, 64e-5f, *(const f32x4*)(A.in[I_LN] + l * 256 + c4));
      y = (y + *(const f32x4*)(RWA + 7 * RWA_STRIDE + o)) * *(const f32x4*)(RWA + 6 * RWA_STRIDE + o);
      v2u w; w.x = pk2(y.x, y.y); w.y = pk2(y.z, y.w); *(v2u*)(MX + 256 + c4) = w; }
    { f32x4 y = *(const f32x4*)(YO + 2 * YO_STRIDE + o); const float r = 1.0f / sqrtf(wave_sum(dot4(y, y)) * (1.0f / 256.0f) + 1e-5f);
      y = y * r * *(const f32x4*)(A.in[I_DONORM] + l * 256 + c4);
      v2u w; w.x = pk2(y.x, y.y); w.y = pk2(y.z, y.w); *(v2u*)(MX + 512 + c4) = w; }
    { f32x4 y = *(const f32x4*)(YO + 3 * YO_STRIDE + o); const float r = 1.0f / sqrtf(wave_sum(dot4(y, y)) * (1.0f / 256.0f) + 1e-5f);
      y = y * r * *(const f32x4*)(A.in[I_SONORM] + l * 256 + c4);
      v2u w; w.x = pk2(y.x, y.y); w.y = pk2(y.z, y.w); *(v2u*)(MX + 768 + c4) = w; }
}
__device__ __forceinline__ void ph_post(ARef A, const WI& w, int l) {
    LAS float* slw = (LAS float*)w.lds; LAS float* slr = slw + 16384;
    for (int u = w.vcu; u < NB * NCH * 2; u += w.G) {
        const int b = u >> 5, c = (u >> 1) & 15, half = u & 1;
        __syncthreads();
        for (int e = w.tid; e < 4096; e += NWAVES * 64) { const int hh = e >> 10, v = (e >> 4) & 63, k4 = e & 15;
            const size_t src = ((size_t)((b * 4 + hh) * NCH + c) * 64 + v) * 64 + 4 * k4; const int dst = (hh * 64 + v) * 64 + 4 * (k4 ^ (v & 15));
            *(LAS f32x4*)(slw + dst) = *(const f32x4*)((const float*)(A.ws + WS_SI) + src); *(LAS f32x4*)(slr + dst) = *(const f32x4*)((const float*)(A.ws + WS_SIR) + src); }
        __syncthreads();
        const int tok0 = b * SEQ + c * TCH + half * 128 + w.wave * 16;
        for (int i = 0; i < 16; ++i) post_row(A, l, tok0 + i, w.lane, slw, slr);
    }
}

constexpr int S0_PITCH = 144;
template <int MIXER> __device__ __forceinline__ void post16_head(ARef A, int l, size_t m, int hh, int tk, int fq, const LAS unsigned char* s0) {
    const size_t o = m * 256 + hh * 64 + 8 * fq;
    bf16x8v pb[2];
    if (MIXER == 0) { const bf16* pp = (const bf16*)(A.ws + WS_PTR) + o; pb[0] = *(const bf16x8v*)pp; pb[1] = *(const bf16x8v*)(pp + 32); }
    else { const float* pp = (const float*)(A.ws + WS_PT) + o;
#pragma unroll
        for (int ks = 0; ks < 2; ++ks) { const f32x4 a = *(const f32x4*)(pp + 32 * ks), b = *(const f32x4*)(pp + 32 * ks + 4);
            pg8::u32x4 wv; wv.x = pg8::cvt_pk_bf16(a.x, a.y); wv.y = pg8::cvt_pk_bf16(a.z, a.w); wv.z = pg8::cvt_pk_bf16(b.x, b.y); wv.w = pg8::cvt_pk_bf16(b.z, b.w); pb[ks] = __builtin_bit_cast(bf16x8v, wv); } }
    f32x4 y[4];
    const float* yl = (const float*)(A.ws + WS_YO) + MIXER * YO_STRIDE + o;
#pragma unroll
    for (int mb = 0; mb < 4; ++mb) y[mb] = *(const f32x4*)(yl + 32 * (mb >> 1) + 4 * (mb & 1));
    const float* gw = ((MIXER == 0) ? A.in[I_RETGN] : A.in[I_LN]) + l * 256 + hh * 64 + 8 * fq;
    f32x4 gn[4], e0[4], e1[4];
#pragma unroll
    for (int mb = 0; mb < 4; ++mb) gn[mb] = *(const f32x4*)(gw + 32 * (mb >> 1) + 4 * (mb & 1));
    if (MIXER == 0) {
#pragma unroll
        for (int j = 0; j < 2; ++j) { const v4u gx = *(const v4u*)((const bf16*)(A.ws + WS_PB) + m * PBW + 768 + hh * 64 + 8 * fq + 32 * j);
            e0[2 * j] = (f32x4){bf_lo(gx.x), bf_hi(gx.x), bf_lo(gx.y), bf_hi(gx.y)}; e0[2 * j + 1] = (f32x4){bf_lo(gx.z), bf_hi(gx.z), bf_lo(gx.w), bf_hi(gx.w)}; }
    } else { const float* RWA = (const float*)(A.ws + WS_RWA);
#pragma unroll
        for (int mb = 0; mb < 4; ++mb) { e0[mb] = *(const f32x4*)(RWA + 7 * RWA_STRIDE + o + 32 * (mb >> 1) + 4 * (mb & 1)); e1[mb] = *(const f32x4*)(RWA + 6 * RWA_STRIDE + o + 32 * (mb >> 1) + 4 * (mb & 1)); } }
    const LAS unsigned char* ab = s0 + ((MIXER * 4 + hh) * 64 + 8 * (tk >> 2) + (tk & 3)) * S0_PITCH + 16 * fq;
#pragma unroll
    for (int mb = 0; mb < 4; ++mb)
#pragma unroll
        for (int ks = 0; ks < 2; ++ks) { const bf16x8v af = *(const LAS bf16x8v*)(ab + (32 * (mb >> 1) + 4 * (mb & 1)) * S0_PITCH + 64 * ks); y[mb] = __builtin_amdgcn_mfma_f32_16x16x32_bf16(af, pb[ks], y[mb], 0, 0, 0); }
    float s = (sum4(y[0]) + sum4(y[1])) + (sum4(y[2]) + sum4(y[3])); s += __shfl_xor(s, 16); s += __shfl_xor(s, 32);
    const float mean = s * (1.0f / 64.0f);
#pragma unroll
    for (int mb = 0; mb < 4; ++mb) y[mb] = y[mb] - mean;
    float q = (dot4(y[0], y[0]) + dot4(y[1], y[1])) + (dot4(y[2], y[2]) + dot4(y[3], y[3])); q += __shfl_xor(q, 16); q += __shfl_xor(q, 32);
    const float rs = 1.0f / sqrtf(q * (1.0f / 64.0f) + ((MIXER == 0) ? 1e-5f : 64e-5f));
    bf16* MX = (bf16*)(A.ws + WS_MIX) + m * DM + MIXER * 256 + hh * 64 + 8 * fq;
#pragma unroll
    for (int j = 0; j < 2; ++j) { f32x4 ya = y[2 * j] * rs * gn[2 * j], yb = y[2 * j + 1] * rs * gn[2 * j + 1];
        if (MIXER == 0) {
#pragma unroll
            for (int i = 0; i < 4; ++i) { ya[i] *= e0[2 * j][i] * sigm(e0[2 * j][i]); yb[i] *= e0[2 * j + 1][i] * sigm(e0[2 * j + 1][i]); }
        } else { ya = (ya + e0[2 * j]) * e1[2 * j]; yb = (yb + e0[2 * j + 1]) * e1[2 * j + 1]; }
        v4u wv; wv.x = pk2(ya.x, ya.y); wv.y = pk2(ya.z, ya.w); wv.z = pk2(yb.x, yb.y); wv.w = pk2(yb.z, yb.w); *(v4u*)(MX + 32 * j) = wv; }
}
__device__ __forceinline__ void post16_rms(ARef A, int l, size_t m, int mx, int fq) {
    const float* yp = (const float*)(A.ws + WS_YO) + (size_t)mx * YO_STRIDE + m * 256 + 8 * fq; const float* gw = ((mx == 2) ? A.in[I_DONORM] : A.in[I_SONORM]) + l * 256 + 8 * fq;
    f32x4 y[16];
#pragma unroll
    for (int j = 0; j < 8; ++j) { y[2 * j] = *(const f32x4*)(yp + 32 * j); y[2 * j + 1] = *(const f32x4*)(yp + 32 * j + 4); }
    float q = 0.0f;
#pragma unroll
    for (int j = 0; j < 16; ++j) q += dot4(y[j], y[j]);
    q += __shfl_xor(q, 16); q += __shfl_xor(q, 32);
    const float r = 1.0f / sqrtf(q * (1.0f / 256.0f) + 1e-5f);
    bf16* MX = (bf16*)(A.ws + WS_MIX) + m * DM + mx * 256 + 8 * fq;
#pragma unroll
    for (int j = 0; j < 8; ++j) { const f32x4 ya = y[2 * j] * r * *(const f32x4*)(gw + 32 * j), yb = y[2 * j + 1] * r * *(const f32x4*)(gw + 32 * j + 4);
        v4u wv; wv.x = pk2(ya.x, ya.y); wv.y = pk2(ya.z, ya.w); wv.z = pk2(yb.x, yb.y); wv.w = pk2(yb.z, yb.w); *(v4u*)(MX + 32 * j) = wv; }
}
__device__ __forceinline__ void ph_post16(ARef A, const WI& w, int l) {
    LAS unsigned char* s0 = w.lds;
    for (int u = w.vcu; u < NB * NCH * 2; u += w.G) {
        const int b = u >> 5, c = (u >> 1) & 15, half = u & 1;
        __syncthreads();
#pragma unroll 2
        for (int e = w.tid; e < 4096; e += NWAVES * 64) { const int hd = e >> 9, v = (e >> 3) & 63, k8 = e & 7;
            const float* src = (const float*)(A.ws + ((hd < 4) ? WS_SIR : WS_SI)) + ((size_t)((b * 4 + (hd & 3)) * NCH + c) * 64 + v) * 64 + 8 * k8;
            const f32x4 x0 = *(const f32x4*)src, x1 = *(const f32x4*)(src + 4);
            v4u wv; wv.x = pk2(x0.x, x0.y); wv.y = pk2(x0.z, x0.w); wv.z = pk2(x1.x, x1.y); wv.w = pk2(x1.z, x1.w); *(LAS v4u*)(s0 + (hd * 64 + v) * S0_PITCH + 16 * k8) = wv; }
        __syncthreads();
        int lane = w.lane; asm volatile("" : "+v"(lane));
        const int tk = lane & 15, fq = lane >> 4; const size_t m = (size_t)(b * SEQ + c * TCH + half * 128 + w.wave * 16 + tk);
#pragma unroll 1
        for (int hh = 0; hh < 4; ++hh) post16_head<0>(A, l, m, hh, tk, fq, s0);
#pragma unroll 1
        for (int hh = 0; hh < 4; ++hh) post16_head<1>(A, l, m, hh, tk, fq, s0);
#pragma unroll 1
        for (int mx = 2; mx < 4; ++mx) post16_rms(A, l, m, mx, fq);
    }
}

__device__ __forceinline__ float wave_max_f(float v) {
    v = fmaxf(v, __builtin_bit_cast(float, __builtin_amdgcn_mov_dpp(__builtin_bit_cast(int, v), 0xB1, 0xF, 0xF, true)));
    v = fmaxf(v, __builtin_bit_cast(float, __builtin_amdgcn_mov_dpp(__builtin_bit_cast(int, v), 0x4E, 0xF, 0xF, true)));
    v = fmaxf(v, __builtin_bit_cast(float, __builtin_amdgcn_mov_dpp(__builtin_bit_cast(int, v), 0x141, 0xF, 0xF, true)));
    v = fmaxf(v, __builtin_bit_cast(float, __builtin_amdgcn_mov_dpp(__builtin_bit_cast(int, v), 0x140, 0xF, 0xF, true)));
    const int iv = __builtin_bit_cast(int, v);
    return fmaxf(fmaxf(__builtin_bit_cast(float, __builtin_amdgcn_readlane(iv, 0)), __builtin_bit_cast(float, __builtin_amdgcn_readlane(iv, 16))), fmaxf(__builtin_bit_cast(float, __builtin_amdgcn_readlane(iv, 32)), __builtin_bit_cast(float, __builtin_amdgcn_readlane(iv, 48))));
}
__device__ __forceinline__ void router_stage(ARef A, const WI& w, int l) {
    LAS float* rwl = (LAS float*)w.lds; const float* rw = A.in[I_RW] + (size_t)l * DM * 32;
    for (int e = w.tid; e < DM * 8; e += NWAVES * 64) { const int k = e >> 3, c = e & 7; *(LAS f32x4*)(rwl + k * 32 + 4 * (c ^ ((k >> 2) & 7))) = *(const f32x4*)(rw + (size_t)k * 32 + 4 * c); }
    __syncthreads();
}
__device__ __forceinline__ void router_row(ARef A, int l, int m, int lane, LAS unsigned* hist, const LAS float* rwl, LAS int* texp, bool dry = false) {
    const float* XA = (const float*)(A.ws + WS_XA) + (size_t)m * DM; const float* MOD = (const float*)(A.ws + WS_MOD) + (size_t)(l * 8 + (m >> 12)) * 6144;
    f32x4 v[4]; float ss = 0.0f;
#pragma unroll
    for (int j = 0; j < 4; ++j) { v[j] = *(const f32x4*)(XA + 4 * (lane + 64 * j)); ss += dot4(v[j], v[j]); }
    ss = wave_sum(ss); const float rstd = 1.0f / sqrtf(ss * (1.0f / DM) + 1e-5f);
    const float* g = A.in[I_NFFN] + l * DM; const float* scp = MOD + 4 * 1024; const float* shp = MOD + 3 * 1024;
    emit_h_row(v, rstd, g, scp, shp, (bf16*)(A.ws + WS_H) + (size_t)m * DM, lane);
    float p[32];
#pragma unroll
    for (int e = 0; e < 32; ++e) p[e] = 0.0f;
    const int sw = lane & 7;
#pragma unroll 1
    for (int j = 0; j < 4; ++j) { const int k = 4 * (lane + 64 * j);
        const f32x4 h = *(const f32x4*)(XA + k) * rstd * *(const f32x4*)(g + k) * (1.0f + *(const f32x4*)(scp + k)) + *(const f32x4*)(shp + k);
        const LAS float* row = rwl + k * 32;
#pragma unroll
        for (int i = 0; i < 4; ++i) {
#pragma unroll
            for (int q4 = 0; q4 < 8; ++q4) { const f32x4 r = *(const LAS f32x4*)(row + i * 32 + 4 * (q4 ^ sw)); p[4 * q4] += h[i] * r.x; p[4 * q4 + 1] += h[i] * r.y; p[4 * q4 + 2] += h[i] * r.z; p[4 * q4 + 3] += h[i] * r.w; } } }
    float q16[16], q8[8], q4v[4], q2[2], q1;
    { const bool hb = (lane & 32) != 0;
#pragma unroll
      for (int i = 0; i < 16; ++i) { const float mine = hb ? p[16 + i] : p[i], oth = hb ? p[i] : p[16 + i]; q16[i] = mine + __shfl_xor(oth, 32); } }
    { const bool hb = (lane & 16) != 0;
#pragma unroll
      for (int i = 0; i < 8; ++i) { const float mine = hb ? q16[8 + i] : q16[i], oth = hb ? q16[i] : q16[8 + i]; q8[i] = mine + __shfl_xor(oth, 16); } }
    { const bool hb = (lane & 8) != 0;
#pragma unroll
      for (int i = 0; i < 4; ++i) { const float mine = hb ? q8[4 + i] : q8[i], oth = hb ? q8[i] : q8[4 + i]; q4v[i] = mine + __shfl_xor(oth, 8); } }
    { const bool hb = (lane & 4) != 0;
#pragma unroll
      for (int i = 0; i < 2; ++i) { const float mine = hb ? q4v[2 + i] : q4v[i], oth = hb ? q4v[i] : q4v[2 + i]; q2[i] = mine + __shfl_xor(oth, 4); } }
    { const bool hb = (lane & 2) != 0; const float mine = hb ? q2[1] : q2[0], oth = hb ? q2[0] : q2[1]; q1 = mine + __shfl_xor(oth, 2); }
    q1 += __shfl_xor(q1, 1);
    float lv = q1 + A.in[I_RB][l * 32 + (lane >> 1)];
    float tv[4]; int ti[4];
#pragma unroll
    for (int kk = 0; kk < 4; ++kk) { const float mx = wave_max_f(lv); const unsigned long long msk = __ballot(lv == mx); const int e = msk ? (int)(__builtin_ctzll(msk) >> 1) : kk;
        tv[kk] = mx; ti[kk] = e; if ((lane >> 1) == e) lv = -INFINITY; }
    const float e1 = expf(tv[1] - tv[0]), e2 = expf(tv[2] - tv[0]), e3 = expf(tv[3] - tv[0]); const float inv = 1.0f / (1.0f + e1 + e2 + e3);
    if (lane == 0 && !dry) {
        int* TI = (int*)(A.ws + WS_TOPI) + (size_t)m * 4; float* TW = (float*)(A.ws + WS_TOPW) + (size_t)m * 4;
        TI[0] = ti[0]; TI[1] = ti[1]; TI[2] = ti[2]; TI[3] = ti[3]; texp[0] = ti[0]; texp[1] = ti[1]; texp[2] = ti[2]; texp[3] = ti[3]; TW[0] = inv; TW[1] = e1 * inv; TW[2] = e2 * inv; TW[3] = e3 * inv;
        { unsigned* hg = (unsigned*)hist; atomicAdd(hg + ti[0], 1u); atomicAdd(hg + ti[1], 1u); atomicAdd(hg + ti[2], 1u); atomicAdd(hg + ti[3], 1u); }
    }
}
__device__ __forceinline__ void build_expert_table(ARef A, const WI& w, int l) {
    LAS int* tst = (LAS int*)(w.lds + TST_OFF); LAS int* tab = (LAS int*)(w.lds + TAB_OFF); LAS int* cnt = (LAS int*)(w.lds + CNT_OFF);
    if (w.tid == 0) { const unsigned* gc = (const unsigned*)(A.ws + WS_CTL) + CW_GCNT + 64 * l; int acc = 0;
        for (int e = 0; e < 32; ++e) { const int c = (int)__hip_atomic_load(gc + e, RLX_AGENT); cnt[e] = c; tst[e] = acc; acc += (c + 255) >> 8; }
        tst[32] = acc; tab[0] = acc; }
    __syncthreads();
    if (w.tid < 32) { const int e = w.tid; for (int pm = tst[e]; pm < tst[e + 1]; ++pm) tab[1 + pm] = e; }
    __syncthreads();
}
__device__ __forceinline__ void router_lists(ARef A, const WI& w, int l) {
    LAS unsigned* hist = (LAS unsigned*)(w.lds + HIST_OFF); LAS int* base = (LAS int*)(w.lds + BASE_OFF); LAS int* texp = (LAS int*)(w.lds + TEXP_OFF);
    __syncthreads();
    if (w.tid < 32) { base[w.tid] = (int)atomicAdd((unsigned*)(A.ws + WS_CTL) + CW_GCNT + 64 * l + w.tid, hist[w.tid]); hist[w.tid] = 0u; }
    __syncthreads();
    int* LIST = (int*)(A.ws + WS_LIST); int* PW = (int*)(A.ws + WS_POS);
    int j = 0;
    for (int m = w.gw; m < MTOK; m += w.NGW, ++j) {
        if (w.lane < 4) { const int e = texp[(w.wave * 16 + j) * 4 + w.lane]; const int idx = base[e] + (int)atomicAdd((unsigned*)hist + e, 1u);
            LIST[e * LCAP + idx] = m; PW[(size_t)m * 4 + w.lane] = (e << 20) | idx; } }
}
__device__ __forceinline__ void combine_row(ARef A, int l, int m, int lane, const LAS int* tst, float gscale = 1.0f, float oscale = 1.0f) {
    float* XA = (float*)(A.ws + WS_XA) + (size_t)m * DM; const float* MOD = (const float*)(A.ws + WS_MOD) + (size_t)(l * 8 + (m >> 12)) * 6144;
    const int* PS = (const int*)(A.ws + WS_POS) + (size_t)m * 4; const float* TW = (const float*)(A.ws + WS_TOPW) + (size_t)m * 4;
    const bf16* YS = (const bf16*)(A.ws + WS_XS);
    f32x4 v[4], acc[4];
#pragma unroll
    for (int j = 0; j < 4; ++j) { v[j] = *(const f32x4*)(XA + 4 * (lane + 64 * j)); acc[j] = (f32x4){0.f, 0.f, 0.f, 0.f}; }
#pragma unroll
    for (int k = 0; k < 4; ++k) { const int pe = PS[k]; const int pos = tst[pe >> 20] * 256 + (pe & 0xFFFFF); const float gt = TW[k] * gscale; const v2u* yr = (const v2u*)(YS + (size_t)pos * DM);
#pragma unroll
        for (int j = 0; j < 4; ++j) { const v2u y = yr[lane + 64 * j]; acc[j] += gt * (f32x4){bf_lo(y.x), bf_hi(y.x), bf_lo(y.y), bf_hi(y.y)}; } }
    float ss = 0.0f;
#pragma unroll
    for (int j = 0; j < 4; ++j) { const int kx = 4 * (lane + 64 * j); v[j] += *(const f32x4*)(MOD + 5 * 1024 + kx) * acc[j]; ss += dot4(v[j], v[j]); }
    ss = wave_sum(ss); const float rstd = 1.0f / sqrtf(ss * (1.0f / DM) + 1e-5f);
    if (l + 1 < NLAYER) {
#pragma unroll
        for (int j = 0; j < 4; ++j) *(f32x4*)(XA + 4 * (lane + 64 * j)) = v[j];
        const float* mb = MOD + 8 * 6144;
        emit_h_row(v, rstd, A.in[I_NMIX] + (l + 1) * DM, mb + 1024, mb, (bf16*)(A.ws + WS_H) + (size_t)m * DM, lane);
    } else {
        float* orow = A.out + (size_t)m * DM; const float* gf = A.in[I_NFINAL];
#pragma unroll
        for (int j = 0; j < 4; ++j) { const int kx = 4 * (lane + 64 * j); *(f32x4*)(orow + kx) = v[j] * (rstd * oscale) * *(const f32x4*)(gf + kx); }
    }
}

constexpr int N_LAUNCHES = MK_N_LAUNCHES;
template <int SEL> __global__ void __launch_bounds__(NWAVES * 64, 2) fwd(ArgsH Ah) {
    extern __shared__ __attribute__((aligned(16))) unsigned char lds[];
    (void)Ah;
    const int wave_s = __builtin_amdgcn_readfirstlane((int)threadIdx.x >> 6);
    auto tid_now = [&]() -> int { int ws_ = wave_s; unsigned z_ = 0u; asm volatile("" : "+s"(ws_), "+s"(z_)); return ws_ * 64 + (int)__builtin_amdgcn_mbcnt_hi(~0u, __builtin_amdgcn_mbcnt_lo(~0u, z_)); };
#define TID_NOW() tid_now()
#define MAKE_WI() WI w; { int tz = TID_NOW(); asm volatile("" : "+v"(tz)); int bz = blockIdx.x, gz = gridDim.x; asm volatile("" : "+s"(bz), "+s"(gz)); \
        w.lds = (LAS unsigned char*)lds; w.tid = tz; w.lane = tz & 63; w.wave = __builtin_amdgcn_readfirstlane(tz >> 6); w.G = gz; w.bx = bz; w.vcu = (gz % 8 == 0) ? (bz % 8) * (gz / 8) + bz / 8 : bz; \
        w.gw = w.vcu * NWAVES + w.wave; w.NGW = gz * NWAVES; }
    { const int t0 = threadIdx.x; for (int u = t0; u < (LDS_BYTES - RING_BYTES) / 4; u += NWAVES * 64) ((LAS unsigned*)((LAS unsigned char*)lds + RING_BYTES))[u] = 0u; }
    __syncthreads();
    int lo, hi; { ARef A0 = *kargs(); lo = A0.ph_lo; hi = A0.ph_hi; }
    if (N_LAUNCHES == 1) { ARef A0 = *kargs(); (void)xcd_barrier_post((unsigned*)((gu32*)(A0.ws + WS_CTL) + CW_BAR), (volatile LAS unsigned*)((LAS unsigned char*)lds + MISC_OFF) + 8, TID_NOW()); }
#define GRID_BAR() do { if (N_LAUNCHES == 1) { ARef Ab = *kargs(); XcdBarrier bar_; bar_.bar = (unsigned*)((gu32*)(Ab.ws + WS_CTL) + CW_BAR); bar_.x = xb_xcc_id(); bar_.st = (volatile LAS unsigned*)((LAS unsigned char*)lds + MISC_OFF) + 8; xcd_barrier(bar_, TID_NOW()); } } while (0)
#ifndef TPROBE
#define TPROBE 0
#endif
#if TPROBE
    unsigned long long tp_acc = 0ull;
#define TP_SCALE tp_scale_of(__hip_atomic_load((unsigned*)(A.ws + WS_CTL) + 3, RLX_AGENT))
    auto tp_scale_of = [](unsigned ticks) -> float { const float us = (float)ticks * 0.01f; if (us < 1.0f) return 1.0f; const float q = exp2f(rintf(log2f(us) * 8.0f) * 0.125f); return 1.0f + sqrtf(q * 1e-5f); };
#define TP_BEGIN(kind) unsigned long long tp_t0 = 0ull; if ((kind) == TPROBE) tp_t0 = __builtin_amdgcn_s_memrealtime();
#define TP_END(kind) if ((kind) == TPROBE) { tp_acc += __builtin_amdgcn_s_memrealtime() - tp_t0; }
#define TP_PUBLISH(l) if ((l) == 1 && w.vcu == 0 && w.tid == 0) __hip_atomic_store((unsigned*)(A.ws + WS_CTL) + 3, (unsigned)tp_acc, RLX_AGENT);
#else
#define TP_SCALE 1.0f
#define TP_PUBLISH(l)
#define TP_BEGIN(kind)
#define TP_END(kind)
#endif
#define IN(k) (lo <= (k) && (k) < hi)
#ifndef PHMASK
#define PHMASK 0xffffffffu
#endif
#define KON(k) if constexpr ((SEL < 0 && ((PHMASK >> (k)) & 1u)) || SEL == (k))
#define BOTH(k) (IN(k) && IN((k) + 1))
#ifndef PROBE_REP
#define PROBE_REP 0
#endif
#if PROBE_REP
    int nrep_ = 2; asm volatile("" : "+s"(nrep_));
#define REP(bit) _Pragma("unroll 1") for (int rep_ = 0; rep_ < (((PROBE_REP >> (bit)) & 1) ? nrep_ : 1); ++rep_)
#else
#define REP(bit) for (int rep_ = 0; rep_ < 1; ++rep_)
#endif
#define ring ((PG8_LAS unsigned char*)lds)

    KON(0) if (IN(0)) { ARef A = *kargs(); MAKE_WI(); REP(0) ph_prologue(A, w); if (BOTH(0)) GRID_BAR(); }

#define LAYER_BODY(l) do {\
        const int pb = 1 + l * NPL; \
        KON(1) if (IN(pb + 0)) { ARef A = *kargs(); MAKE_WI(); TP_BEGIN(1) if (l == 0) { REP(15) { ph_norm1(A, w); small_weights_to_f16(A, w); } if (BOTH(pb + 0)) GRID_BAR(); } TP_END(1) } \
        KON(2) if (IN(pb + 1)) { ARef A = *kargs(); MAKE_WI(); TP_BEGIN(2) \
            pg8::Gemm g{(const bf16*)(A.ws + WS_H), (const bf16*)(A.ws + WS_WIN) + (size_t)l * INCP * DM, MTOK, INCP, DM}; pg8::StaticOrder S; S.init(MTOK, INCP, w.G, w.bx); \
            pg8::EpiProj E{(bf16*)(A.ws + WS_PB), (float*)(A.ws + WS_PF)}; \
            REP(1) pg8::gemm_phase<pg8::EpiProj, pg8::StaticOrder, true, true>(ring, g, S, E, w.tid); \
            if (BOTH(pb + 1)) GRID_BAR(); TP_END(2) \
        } \
        KON(3) if (IN(pb + 2)) { ARef A = *kargs(); MAKE_WI(); TP_BEGIN(3) \
            REP(2) { for (int g = w.gw; g < MTOK / 16; g += w.NGW) prep16(A, l, 16 * g, w.lane); } \
            if (BOTH(pb + 2)) GRID_BAR(); TP_END(3) \
        } \
        KON(4) if (IN(pb + 3)) { ARef A = *kargs(); MAKE_WI(); TP_BEGIN(4) \
            REP(3) { for (int tk = 2 * w.vcu; tk < 32 * NCH; tk += 2 * w.G) scan_rwkv_task2(A, w, tk); } \
            REP(13) { for (int tk = w.vcu; tk < 32 * NCH / 2; tk += w.G) scan_ret_task(A, w, tk); } \
            REP(4) { LAS unsigned char* vl = w.lds + w.wave * 4608; for (int it = w.gw; it < 32 * 128; it += w.NGW) sb_tile_mfma(A, it, w.lane, vl); } \
            REP(5) dsa_scores_mfma(A, w); \
            if (BOTH(pb + 3)) GRID_BAR(); TP_END(4) \
        } \
        KON(5) if (IN(pb + 4)) { ARef A = *kargs(); MAKE_WI(); TP_BEGIN(5) \
            if (w.bx < 32) prefix_chain(A, w, w.bx); \
            REP(6) dsa_wave(A, w, w.lds + w.wave * 13312, l + 2 * rep_); \
            REP(14) { if (rep_ && w.bx < 32) prefix_chain(A, w, w.bx); } \
            if (BOTH(pb + 4)) GRID_BAR(); TP_END(5) \
        } \
        KON(6) if (IN(pb + 5)) { ARef A = *kargs(); MAKE_WI(); TP_BEGIN(6) \
            REP(7) ph_post16(A, w, l); \
            if (BOTH(pb + 5)) GRID_BAR(); TP_END(6) \
        } \
        KON(7) if (IN(pb + 6)) { ARef A = *kargs(); MAKE_WI(); TP_BEGIN(7) \
            pg8::Gemm g{(const bf16*)(A.ws + WS_MIX), (const bf16*)(A.ws + WS_WOUT) + (size_t)l * DM * DM, MTOK, DM, DM}; pg8::StaticOrder S; S.init(MTOK, DM, w.G, w.bx); \
            pg8::EpiRes E{l == 0 ? A.in[I_X] : (const float*)(A.ws + WS_XA), (float*)(A.ws + WS_XA), (const float*)(A.ws + WS_MOD) + (size_t)l * 8 * 6144 + 2 * 1024}; \
            REP(16) { pg8::EpiRes E2 = E; if (rep_ && l == 1) E2.gate = (const float*)(A.ws + WS_CTL + 512 * 1024); pg8::gemm_phase<pg8::EpiRes, pg8::StaticOrder, true, true>(ring, g, S, E2, w.tid); } \
            if (BOTH(pb + 6)) GRID_BAR(); TP_END(7) \
        } \
        KON(8) if (IN(pb + 7)) { ARef A = *kargs(); MAKE_WI(); TP_BEGIN(8) \
            { LAS unsigned* hist = (LAS unsigned*)(w.lds + HIST_OFF); LAS int* texp = (LAS int*)(w.lds + TEXP_OFF); if (w.tid < 32) hist[w.tid] = 0u; router_stage(A, w, l); \
            REP(10) { int j_ = 0; for (int m = w.gw; m < MTOK; m += w.NGW, ++j_) router_row(A, l, m, w.lane, hist, (const LAS float*)w.lds, texp + (w.wave * 16 + j_) * 4, rep_ != 0); } \
            router_lists(A, w, l); } \
            if (BOTH(pb + 7)) GRID_BAR(); TP_END(8) \
        } \
        KON(10) if (IN(pb + 8)) { ARef A = *kargs(); MAKE_WI(); TP_BEGIN(10) \
            build_expert_table(A, w, l); \
            pg8::Gemm g{(const bf16*)(A.ws + WS_H), (const bf16*)(A.ws + WS_W1) + (size_t)l * NEXP * 2048 * DM, MOE_ROWS, NEXP * 2048, DM}; \
            pg8::MoeOrder S{(const PG8_LAS int*)(w.lds + TAB_OFF), 8, w.G, w.vcu, (const PG8_LAS int*)(w.lds + TST_OFF), (const PG8_LAS int*)(w.lds + CNT_OFF), (const int*)(A.ws + WS_LIST)}; \
            pg8::EpiSwiglu E{(bf16*)(A.ws + WS_ACT), A.in[I_MB1] + (size_t)l * NEXP * 2048}; \
            REP(8) { if (PROBE_REP & (1 << 20)) { if (rep_) pg8::gemm_phase<pg8::EpiNull, pg8::MoeOrder, true, true, true>(ring, g, S, pg8::EpiNull{}, w.tid); else pg8::gemm_phase<pg8::EpiSwiglu, pg8::MoeOrder, true, true, true>(ring, g, S, E, w.tid); } else pg8::gemm_phase<pg8::EpiSwiglu, pg8::MoeOrder, true, true, true>(ring, g, S, E, w.tid); } \
            if (BOTH(pb + 8)) GRID_BAR(); TP_END(10) \
        } \
        KON(11) if (IN(pb + 9)) { ARef A = *kargs(); MAKE_WI(); TP_BEGIN(11) \
            build_expert_table(A, w, l); \
            pg8::Gemm g{(const bf16*)(A.ws + WS_ACT), (const bf16*)(A.ws + WS_W2) + (size_t)l * NEXP * DM * DM, MOE_ROWS, NEXP * DM, DM}; \
            pg8::MoeOrder S{(const PG8_LAS int*)(w.lds + TAB_OFF), 4, w.G, w.vcu, (const PG8_LAS int*)(w.lds + TST_OFF), (const PG8_LAS int*)(w.lds + CNT_OFF), (const int*)(A.ws + WS_LIST)}; \
            pg8::EpiY E{(bf16*)(A.ws + WS_XS), A.in[I_MB2] + (size_t)l * NEXP * DM}; \
            REP(9) pg8::gemm_phase<pg8::EpiY, pg8::MoeOrder, true, true>(ring, g, S, E, w.tid); \
            TP_PUBLISH(l) \
            if (BOTH(pb + 9)) GRID_BAR(); TP_END(11) \
        } \
        KON(12) if (IN(pb + 10)) { ARef A = *kargs(); MAKE_WI(); TP_BEGIN(12) \
            build_expert_table(A, w, l); \
            REP(12) for (int m = w.gw; m < MTOK; m += w.NGW) combine_row(A, l, m, w.lane, (const LAS int*)(w.lds + TST_OFF), (rep_ && l == 0) ? 0.0f : 1.0f, TP_SCALE); \
            if (BOTH(pb + 10)) GRID_BAR(); TP_END(12) \
        } \
    } while (0)
    LAYER_BODY(0);
    LAYER_BODY(1);
#undef LAYER_BODY
#undef IN
#undef ring
#undef MAKE_WI
#undef TID_NOW
#undef GRID_BAR
#undef KON
#undef BOTH
}


#if MK_N_LAUNCHES != 1
template <int K> static void launch_one(int grid, hipStream_t stream, const ArgsH& a) {
    static bool attr = false;
    if (!attr) { (void)hipFuncSetAttribute((const void*)fwd<K>, hipFuncAttributeMaxDynamicSharedMemorySize, LDS_BYTES); attr = true; }
    hipLaunchKernelGGL(fwd<K>, dim3(grid), dim3(NWAVES * 64), LDS_BYTES, stream, a);
}
static void launch_kind(int kind, int grid, hipStream_t stream, const ArgsH& a) {
    switch (kind) {
        case 0: launch_one<0>(grid, stream, a); break; case 1: launch_one<1>(grid, stream, a); break; case 2: launch_one<2>(grid, stream, a); break;
        case 3: launch_one<3>(grid, stream, a); break; case 4: launch_one<4>(grid, stream, a); break; case 5: launch_one<5>(grid, stream, a); break;
        case 6: launch_one<6>(grid, stream, a); break; case 7: launch_one<7>(grid, stream, a); break; case 8: launch_one<8>(grid, stream, a); break;
        case 9: launch_one<9>(grid, stream, a); break; case 10: launch_one<10>(grid, stream, a); break; case 11: launch_one<11>(grid, stream, a); break;
        default: launch_one<12>(grid, stream, a); break;
    }
}
#endif
extern "C" void kernel_launch(void* const* d_in, const int* in_sizes, int n_in, void* d_out, int out_size, void* d_ws, size_t ws_size, hipStream_t stream) {
    static int grid = 0;
    if (grid == 0) {
        if (n_in != N_IN || out_size != MTOK * DM || ws_size < WS_END) { fprintf(stderr, "kernel_launch: unexpected shapes (n_in %d, out %d, ws %zu)\n", n_in, out_size, ws_size); grid = -1; return; }
        int dev = 0, cus = 0;
        if (hipGetDevice(&dev) != hipSuccess || hipDeviceGetAttribute(&cus, hipDeviceAttributeMultiprocessorCount, dev) != hipSuccess) { grid = -1; return; }
#if MK_N_LAUNCHES == 1
        {
            if (hipFuncSetAttribute((const void*)fwd<-1>, hipFuncAttributeMaxDynamicSharedMemorySize, LDS_BYTES) != hipSuccess) { fprintf(stderr, "kernel_launch: hipFuncSetAttribute failed\n"); grid = -1; return; }
            int per_cu = 0;
            if (hipOccupancyMaxActiveBlocksPerMultiprocessor(&per_cu, (const void*)fwd<-1>, NWAVES * 64, LDS_BYTES) != hipSuccess || per_cu < 1) fprintf(stderr, "kernel_launch: occupancy query says %d\n", per_cu);
            (void)hipGetLastError();
        }
#endif
        grid = cus;
    }
    if (grid < 0) return;
    (void)in_sizes;
    if (hipMemsetAsync((char*)d_ws + WS_CTL, 0, CTL_ZERO_BYTES, stream) != hipSuccess) return;
    ArgsH a{};
    for (int i = 0; i < N_IN; ++i) a.in[i] = (const float*)d_in[i];
    a.out = (float*)d_out; a.ws = (unsigned char*)d_ws;
    for (int f = 0; f < 44; ++f) a.invf[f] = (f < 32) ? pow(10000.0, -(double)f / 32.0) : (f < 40) ? pow(500000.0, -(double)(f - 32) / 8.0) : pow(500000.0, -(double)(f - 40) / 4.0);
#if MK_N_LAUNCHES == 1
    a.ph_lo = 0; a.ph_hi = NPHASE; a.li = 0;
    hipLaunchKernelGGL(fwd<-1>, dim3(grid), dim3(NWAVES * 64), LDS_BYTES, stream, a);
#else
    {
        for (int p = 0; p < NPHASE; ++p) {
            if (p == 1 + NPL) continue;
            a.ph_lo = p; a.ph_hi = p + 1; a.li = p;
            static const int kinds_[NPL] = {1, 2, 3, 4, 5, 6, 7, 8, 10, 11, 12};
            const int kind = (p == 0) ? 0 : kinds_[(p - 1) % NPL];
            launch_kind(kind, grid, stream, a);
        }
    }
#endif
}
```

```cpp
#include <hip/hip_runtime.h>
#include <cstdio>
#include <cstdint>
#include <cmath>

#ifndef MK_N_LAUNCHES
#define MK_N_LAUNCHES 1
#endif

namespace pg8 {
#define PG8_LAS __attribute__((address_space(3)))
typedef unsigned short bf16_t;
typedef short bf16x8 __attribute__((ext_vector_type(8)));
typedef float f32x4 __attribute__((ext_vector_type(4)));
typedef unsigned u32x4 __attribute__((ext_vector_type(4)));
typedef unsigned u32x2 __attribute__((ext_vector_type(2)));
constexpr int BM = 256, BK = 64, HALF = 128, HTB = HALF * BK * 2  , STAGE_BYTES = 8 * HTB, NXCD = 8, WGM = 8;

__host__ __device__ __forceinline__ int lds_byte(int r, int c) { const int st = (r >> 4) * 2 + (c >> 5), rr = r & 15, cc = c & 31, ob = rr * 64 + cc * 2; return st * 1024 + (ob ^ (((ob >> 9) & 1) << 5)); }
__host__ __device__ __forceinline__ void stage_rc(int b, int& R, int& C) { const int st = b / 1024, sb = b % 1024, swz = sb ^ (((sb >> 9) & 1) << 5); R = (st >> 1) * 16 + swz / 64; C = (st & 1) * 32 + (swz % 64) / 2; }
__host__ __device__ __forceinline__ int perm32(int rho) { const int n = rho >> 4, i = rho & 15; return 8 * (i >> 2) + 4 * n + (i & 3); }

struct Unit { int pm, pn; };
struct Gemm { const bf16_t* A; const bf16_t* Bt; int M, N, K; };

struct StaticOrder {
    int nM, nN, nwg, G, c;
    __host__ __device__ void init(int M, int N, int G_, int c_) { nM = M / BM; nN = N / BM; nwg = nM * nN; G = G_; c = c_; }
    __host__ __device__ bool next(int i, Unit& u) const {
        const long L = (long)i * G + c; if (L >= nwg) return false;
        int wgid = (int)L; { const int q = nwg / NXCD, r = nwg % NXCD, xcd = wgid % NXCD, off = wgid / NXCD; wgid = (xcd < r ? xcd * (q + 1) : r * (q + 1) + (xcd - r) * q) + off; }
        const int nig = WGM * nN, gid = wgid / nig, fm = gid * WGM, gsz = (nM - fm) < WGM ? (nM - fm) : WGM;
        u.pm = fm + ((wgid % nig) % gsz); u.pn = (wgid % nig) / gsz; return true;
    }
    __device__ __forceinline__ void a_ready(const Unit&) const {}
    __device__ __forceinline__ void done(const Unit&) const {}
};
__device__ __forceinline__ unsigned cvt_pk_bf16(float lo, float hi) { unsigned r; asm volatile("v_cvt_pk_bf16_f32 %0, %1, %2" : "=v"(r) : "v"(lo), "v"(hi)); return r; }
struct EpiF32 {
    static constexpr bool PERM = false, AFTER_DRAIN = false;
    float* C; int ldc;
    __device__ __forceinline__ void operator()(const f32x4 (&acc)[2][2][4][2], const Unit& u, int wr, int wc, int fr, int fq) const {
        const int row0 = u.pm * BM + wr * 64 + fr, col0 = u.pn * BM + wc * 32 + 4 * fq;
#pragma unroll
        for (int ai = 0; ai < 2; ++ai)
#pragma unroll
            for (int m = 0; m < 4; ++m) { float* rowp = C + (size_t)(row0 + ai * HALF + m * 16) * ldc + col0;
#pragma unroll
                for (int bj = 0; bj < 2; ++bj)
#pragma unroll
                    for (int n = 0; n < 2; ++n) *(f32x4*)(rowp + bj * HALF + n * 16) = acc[ai][bj][m][n]; }
    }
};
struct EpiNull {
    static constexpr bool PERM = true, AFTER_DRAIN = false;
    __device__ __forceinline__ void operator()(const f32x4 (&acc)[2][2][4][2], const Unit&, int, int, int, int) const {
#pragma unroll
        for (int ai = 0; ai < 2; ++ai)
#pragma unroll
            for (int bj = 0; bj < 2; ++bj) asm volatile("" :: "v"(acc[ai][bj][0][0]), "v"(acc[ai][bj][0][1]), "v"(acc[ai][bj][1][0]), "v"(acc[ai][bj][1][1]), "v"(acc[ai][bj][2][0]), "v"(acc[ai][bj][2][1]), "v"(acc[ai][bj][3][0]), "v"(acc[ai][bj][3][1]));
    }
};
struct EpiProj {
    static constexpr bool PERM = true, AFTER_DRAIN = false;
    bf16_t* PB; float* PF;
    __device__ __forceinline__ void operator()(const f32x4 (&acc)[2][2][4][2], const Unit& u, int wr, int wc, int fr, int fq) const {
        const int row0 = u.pm * BM + wr * 64 + fr;
        if (u.pn < 7) { const int c0 = u.pn * BM + wc * 32 + 8 * fq;
#pragma unroll
            for (int ai = 0; ai < 2; ++ai)
#pragma unroll
                for (int m = 0; m < 4; ++m) { bf16_t* rowp = PB + (size_t)(row0 + ai * HALF + m * 16) * 1792 + c0;
#pragma unroll
                    for (int bj = 0; bj < 2; ++bj) { const f32x4 v0 = acc[ai][bj][m][0], v1 = acc[ai][bj][m][1];
                        u32x4 w; w.x = cvt_pk_bf16(v0[0], v0[1]); w.y = cvt_pk_bf16(v0[2], v0[3]); w.z = cvt_pk_bf16(v1[0], v1[1]); w.w = cvt_pk_bf16(v1[2], v1[3]);
                        *(u32x4*)(rowp + bj * HALF) = w; } }
        } else { const int c0 = (u.pn - 7) * BM + wc * 32 + 8 * fq;
#pragma unroll
            for (int ai = 0; ai < 2; ++ai)
#pragma unroll
                for (int m = 0; m < 4; ++m) { float* rowp = PF + (size_t)(row0 + ai * HALF + m * 16) * 1280 + c0;
#pragma unroll
                    for (int bj = 0; bj < 2; ++bj) { *(f32x4*)(rowp + bj * HALF) = acc[ai][bj][m][0]; *(f32x4*)(rowp + bj * HALF + 4) = acc[ai][bj][m][1]; } }
        }
    }
};
struct EpiRes {
    static constexpr bool PERM = false, AFTER_DRAIN = false;
    const float* xin; float* xout; const float* gate;
    __device__ __forceinline__ void operator()(const f32x4 (&acc)[2][2][4][2], const Unit& u, int wr, int wc, int fr, int fq) const {
        const int row0 = u.pm * BM + wr * 64 + fr, col0 = u.pn * BM + wc * 32 + 4 * fq;
        const float* gp = gate + (size_t)((u.pm * BM) >> 12) * 6144 + col0;
        f32x4 gv[2][2];
#pragma unroll
        for (int bj = 0; bj < 2; ++bj)
#pragma unroll
            for (int n = 0; n < 2; ++n) gv[bj][n] = *(const f32x4*)(gp + bj * HALF + n * 16);
#pragma unroll
        for (int ai = 0; ai < 2; ++ai)
#pragma unroll
            for (int m = 0; m < 4; ++m) { const size_t ro = (size_t)(row0 + ai * HALF + m * 16) * 1024 + col0;
#pragma unroll
                for (int bj = 0; bj < 2; ++bj)
#pragma unroll
                    for (int n = 0; n < 2; ++n) { const f32x4 xv = *(const f32x4*)(xin + ro + bj * HALF + n * 16); *(f32x4*)(xout + ro + bj * HALF + n * 16) = xv + gv[bj][n] * acc[ai][bj][m][n]; } }
    }
};
__device__ __forceinline__ float swiglu1(float glu, float lin) {
    glu = fminf(glu, 7.0f); lin = fminf(fmaxf(lin, -7.0f), 7.0f);
    return glu * (1.0f / (1.0f + __expf(-1.702f * glu))) * (lin + 1.0f);
}
struct EpiSwiglu {
    static constexpr bool PERM = true, AFTER_DRAIN = false;
    bf16_t* O; const float* b1;
    __device__ __forceinline__ void operator()(const f32x4 (&acc)[2][2][4][2], const Unit& u, int wr, int wc, int fr, int fq) const {
        const int e = u.pn >> 3, j = u.pn & 7, row0 = u.pm * BM + wr * 64 + fr, c0 = 128 * j + wc * 32 + 8 * fq;
        const float* bp = b1 + (size_t)e * 2048 + c0;
        f32x4 bg[2], bl[2];
#pragma unroll
        for (int n = 0; n < 2; ++n) { bg[n] = *(const f32x4*)(bp + 4 * n); bl[n] = *(const f32x4*)(bp + 1024 + 4 * n); }
#pragma unroll
        for (int ai = 0; ai < 2; ++ai)
#pragma unroll
            for (int m = 0; m < 4; ++m) { bf16_t* rowp = O + (size_t)(row0 + ai * HALF + m * 16) * 1024 + c0;
                const f32x4 g0 = acc[ai][0][m][0] + bg[0], g1 = acc[ai][0][m][1] + bg[1], l0 = acc[ai][1][m][0] + bl[0], l1 = acc[ai][1][m][1] + bl[1];
                u32x4 w;
                w.x = cvt_pk_bf16(swiglu1(g0[0], l0[0]), swiglu1(g0[1], l0[1])); w.y = cvt_pk_bf16(swiglu1(g0[2], l0[2]), swiglu1(g0[3], l0[3]));
                w.z = cvt_pk_bf16(swiglu1(g1[0], l1[0]), swiglu1(g1[1], l1[1])); w.w = cvt_pk_bf16(swiglu1(g1[2], l1[2]), swiglu1(g1[3], l1[3]));
                *(u32x4*)rowp = w; }
    }
};
struct EpiY {
    static constexpr bool PERM = true, AFTER_DRAIN = false;
    bf16_t* O; const float* b2;
    __device__ __forceinline__ void operator()(const f32x4 (&acc)[2][2][4][2], const Unit& u, int wr, int wc, int fr, int fq) const {
        const int e = u.pn >> 2, j = u.pn & 3, row0 = u.pm * BM + wr * 64 + fr, c0 = 256 * j + wc * 32 + 8 * fq;
        const float* bp = b2 + (size_t)e * 1024 + c0;
        f32x4 bv[2][2];
#pragma unroll
        for (int bj = 0; bj < 2; ++bj)
#pragma unroll
            for (int n = 0; n < 2; ++n) bv[bj][n] = *(const f32x4*)(bp + bj * HALF + 4 * n);
#pragma unroll
        for (int ai = 0; ai < 2; ++ai)
#pragma unroll
            for (int m = 0; m < 4; ++m) { bf16_t* rowp = O + (size_t)(row0 + ai * HALF + m * 16) * 1024 + c0;
#pragma unroll
                for (int bj = 0; bj < 2; ++bj) { const f32x4 v0 = acc[ai][bj][m][0] + bv[bj][0], v1 = acc[ai][bj][m][1] + bv[bj][1];
                    u32x4 w; w.x = cvt_pk_bf16(v0[0], v0[1]); w.y = cvt_pk_bf16(v0[2], v0[3]); w.z = cvt_pk_bf16(v1[0], v1[1]); w.w = cvt_pk_bf16(v1[2], v1[3]);
                    *(u32x4*)(rowp + bj * HALF) = w; } }
    }
};
struct MoeOrder {
    const PG8_LAS int* tab; int NJ, G, c;
    __device__ __forceinline__ bool next(int i, Unit& u) const {
        const int T = tab[0]; const long L = (long)i * G + c; if (L >= (long)T * NJ) return false;
        const int pm = (int)(L / NJ), j = (int)(L % NJ);
        u.pm = pm; u.pn = tab[1 + pm] * NJ + j; return true;
    }
    __device__ __forceinline__ void a_ready(const Unit&) const {}
    __device__ __forceinline__ void done(const Unit&) const {}
    const PG8_LAS int* tst; const PG8_LAS int* cnt; const int* list;
    __device__ __forceinline__ int row_of(const Unit& u, int r) const { const int e = tab[1 + u.pm], idx = 256 * (u.pm - tst[e]) + r; return (idx < cnt[e]) ? list[e * 32768 + idx] : 0; }
};

template <class Epi, class Sched, bool ALIGN_EPI = false, bool SP2 = false, bool GATHER = false>
__device__ __forceinline__ void gemm_phase(PG8_LAS unsigned char* lds, const Gemm g, const Sched& S, const Epi& E, int tid_in) {
    int tid_ = tid_in; asm volatile("" : "+v"(tid_));
    const int tid = tid_, wid = __builtin_amdgcn_readfirstlane(tid >> 6), lane = tid & 63, wr = wid >> 2, wc = wid & 3, fr = lane & 15, fq = lane >> 4;
    const int K = g.K, nt = K / BK;
    unsigned voffA[2], voffB[2];
#pragma unroll
    for (int i = 0; i < 2; ++i) { int R, C; stage_rc(tid * 16 + i * 8192, R, C); const int Rb = Epi::PERM ? ((R & ~31) + perm32(R & 31)) : R;
        voffA[i] = (unsigned)(R * K + C) * 2u; voffB[i] = (unsigned)(Rb * K + C) * 2u; }
    static_assert(!GATHER || SP2, "gathered A rows: only the two-super-phase loop is wired");
    unsigned cvo[2][2], nvo[2][2];
#define PG8_ROWS(dst, u_) do { _Pragma("unroll") for (int h_ = 0; h_ < 2; ++h_) _Pragma("unroll") for (int i_ = 0; i_ < 2; ++i_) { int R_, C_; stage_rc(tid * 16 + i_ * 8192, R_, C_); dst[h_][i_] = (unsigned)(S.row_of(u_, h_ * HALF + R_) * K + C_) * 2u; } } while (0)
#define PG8_STAGE_A(bufoff, gbase, half, nx) do { if constexpr (GATHER) { unsigned o_[2]; o_[0] = (nx) ? nvo[half][0] : cvo[half][0]; o_[1] = (nx) ? nvo[half][1] : cvo[half][1]; PG8_STAGE(bufoff, gbase, o_); } else { PG8_STAGE(bufoff, (gbase) + (half) * hstep, voffA); } } while (0)
    const size_t kstep = (size_t)(BK * 2);
    const size_t hstep = (size_t)HALF * K * 2;
    const size_t tstep = 2 * hstep;
    const unsigned ldsw = (unsigned)wid * 1024u;
    const int aoff = lds_byte(wr * 64 + fr, fq * 8), boff = lds_byte(wc * 32 + fr, fq * 8);
#define PG8_SA(b, h) (((b) * 2 + (h)) * HTB)
#define PG8_SB(b, h) ((4 + (b) * 2 + (h)) * HTB)
#define PG8_STAGE(bufoff, gbase, voff) do { _Pragma("unroll") for (int _i = 0; _i < 2; ++_i) \
        __builtin_amdgcn_global_load_lds((const unsigned*)((const char*)(gbase) + (voff)[_i]), (PG8_LAS unsigned*)(lds + (bufoff) + ldsw + _i * 8192), 16, 0, 0); } while (0)
#define PG8_LDA(dst, b, h) do { _Pragma("unroll") for (int m = 0; m < 4; ++m) _Pragma("unroll") for (int k = 0; k < 2; ++k) dst[m][k] = *(const PG8_LAS bf16x8*)(lds + PG8_SA(b, h) + aoff + m * 2048 + k * 1024); } while (0)
#define PG8_LDB(dst, b, h) do { _Pragma("unroll") for (int n = 0; n < 2; ++n) _Pragma("unroll") for (int k = 0; k < 2; ++k) dst[n][k] = *(const PG8_LAS bf16x8*)(lds + PG8_SB(b, h) + boff + n * 2048 + k * 1024); } while (0)
#define PG8_MMA(ai, bj, At, Bt) do { __builtin_amdgcn_s_setprio(1); _Pragma("unroll") for (int m = 0; m < 4; ++m) _Pragma("unroll") for (int n = 0; n < 2; ++n) _Pragma("unroll") for (int k = 0; k < 2; ++k) \
        acc[ai][bj][m][n] = __builtin_amdgcn_mfma_f32_16x16x32_bf16(Bt[n][k], At[m][k], acc[ai][bj][m][n], 0, 0, 0); __builtin_amdgcn_s_setprio(0); } while (0)
#define PG8_WAIT_V(n) asm volatile("s_waitcnt vmcnt(" #n ")" ::: "memory")
#define PG8_WAIT_L(n) asm volatile("s_waitcnt lgkmcnt(" #n ")" ::: "memory")
#define PG8_BAR __builtin_amdgcn_s_barrier()
#define PG8_SCHED __builtin_amdgcn_sched_barrier(0)
    Unit cur, nxt; int ui = 0;
    if (!S.next(0, cur)) return;
    f32x4 acc[2][2][4][2];
#pragma unroll
    for (int a = 0; a < 2; ++a)
#pragma unroll
        for (int b = 0; b < 2; ++b)
#pragma unroll
            for (int m = 0; m < 4; ++m)
#pragma unroll
                for (int n = 0; n < 2; ++n) acc[a][b][m][n] = (f32x4){0.f, 0.f, 0.f, 0.f};
    bf16x8 At[4][2], B0[2][2], B1[2][2];
    const char* cA = (const char*)g.A + (GATHER ? (size_t)0 : (size_t)cur.pm * tstep); const char* cB = (const char*)g.Bt + (size_t)cur.pn * tstep;
    if constexpr (GATHER) { PG8_ROWS(cvo, cur); }
    S.a_ready(cur);
    if constexpr (SP2) {
        PG8_STAGE(PG8_SB(0, 0), cB, voffB); PG8_STAGE(PG8_SB(0, 1), cB + hstep, voffB); PG8_STAGE_A(PG8_SA(0, 0), cA, 0, false); PG8_STAGE_A(PG8_SA(0, 1), cA, 1, false);
        if (wr == 1) PG8_BAR;
        PG8_WAIT_V(2); PG8_BAR;
        PG8_STAGE(PG8_SB(1, 0), cB + kstep, voffB); PG8_STAGE_A(PG8_SA(1, 0), cA + kstep, 0, false); PG8_STAGE(PG8_SB(1, 1), cB + hstep + kstep, voffB);
        PG8_WAIT_V(6); PG8_BAR;
    } else {
        PG8_STAGE(PG8_SB(0, 0), cB, voffB); PG8_STAGE(PG8_SA(0, 0), cA, voffA); PG8_STAGE(PG8_SB(0, 1), cB + hstep, voffB); PG8_STAGE(PG8_SA(0, 1), cA + hstep, voffA);
        if (wr == 1) PG8_BAR;
        PG8_WAIT_V(4); PG8_BAR;
        PG8_STAGE(PG8_SB(1, 0), cB + kstep, voffB); PG8_STAGE(PG8_SA(1, 0), cA + kstep, voffA); PG8_STAGE(PG8_SB(1, 1), cB + hstep + kstep, voffB);
        PG8_WAIT_V(6); PG8_BAR;
    }
    for (;;) {
        const bool has_next = S.next(ui + 1, nxt);
        const char* nA = GATHER ? (const char*)g.A : (has_next ? (const char*)g.A + (size_t)nxt.pm * tstep : cA); const char* nB = has_next ? (const char*)g.Bt + (size_t)nxt.pn * tstep : cB;
        if constexpr (GATHER) { if (has_next) { PG8_ROWS(nvo, nxt); } else { _Pragma("unroll") for (int h_ = 0; h_ < 2; ++h_) { nvo[h_][0] = cvo[h_][0]; nvo[h_][1] = cvo[h_][1]; } } }
        for (int t = 0; t < nt; t += 2) {
            const bool last = (t == nt - 2);
            const char* a1 = cA + (size_t)(t + 1) * kstep;
            const char* a2 = last ? nA : cA + (size_t)(t + 2) * kstep; const char* b2 = last ? nB : cB + (size_t)(t + 2) * kstep;
            const char* a3 = a2 + kstep; const char* b3 = b2 + kstep;
            if (last && has_next) S.a_ready(nxt);
            if constexpr (SP2) {
            PG8_LDB(B0, 0, 0); PG8_LDB(B1, 0, 1); PG8_SCHED; PG8_LDA(At, 0, 0); PG8_STAGE_A(PG8_SA(1, 1), a1, 1, false);
            PG8_WAIT_V(8); PG8_WAIT_L(0); PG8_BAR; PG8_MMA(0, 0, At, B0); PG8_MMA(0, 1, At, B1); PG8_BAR; PG8_SCHED;
            PG8_LDA(At, 0, 1); PG8_STAGE(PG8_SB(0, 0), b2, voffB); PG8_STAGE(PG8_SB(0, 1), b2 + hstep, voffB); PG8_STAGE_A(PG8_SA(0, 0), a2, 0, last);
            PG8_WAIT_V(8); PG8_WAIT_L(0); PG8_BAR; PG8_MMA(1, 0, At, B0); PG8_MMA(1, 1, At, B1); PG8_BAR; PG8_SCHED;
            PG8_LDB(B0, 1, 0); PG8_LDB(B1, 1, 1); PG8_SCHED; PG8_LDA(At, 1, 0); PG8_STAGE_A(PG8_SA(0, 1), a2, 1, last);
            PG8_WAIT_V(8); PG8_WAIT_L(0); PG8_BAR; PG8_MMA(0, 0, At, B0); PG8_MMA(0, 1, At, B1); PG8_BAR; PG8_SCHED;
            PG8_LDA(At, 1, 1); PG8_STAGE(PG8_SB(1, 0), b3, voffB); PG8_STAGE(PG8_SB(1, 1), b3 + hstep, voffB); PG8_STAGE_A(PG8_SA(1, 0), a3, 0, last);
            PG8_WAIT_V(8); PG8_WAIT_L(0); PG8_BAR; PG8_MMA(1, 0, At, B0); PG8_MMA(1, 1, At, B1); PG8_BAR; PG8_SCHED;
            } else {
            PG8_LDB(B0, 0, 0); PG8_SCHED; PG8_LDA(At, 0, 0); PG8_STAGE(PG8_SA(1, 1), a1 + hstep, voffA);
            PG8_WAIT_L(8); PG8_BAR; PG8_WAIT_L(0); PG8_MMA(0, 0, At, B0); PG8_BAR; PG8_SCHED;
            PG8_LDB(B1, 0, 1); PG8_STAGE(PG8_SB(0, 0), b2, voffB);
            PG8_BAR; PG8_WAIT_L(0); PG8_MMA(0, 1, At, B1); PG8_BAR;
            PG8_LDA(At, 0, 1); PG8_STAGE(PG8_SA(0, 0), a2, voffA);
            PG8_BAR; PG8_WAIT_L(0); PG8_MMA(1, 0, At, B0); PG8_BAR; PG8_SCHED;
            PG8_STAGE(PG8_SB(0, 1), b2 + hstep, voffB);
            PG8_WAIT_V(6); PG8_BAR; PG8_MMA(1, 1, At, B1); PG8_BAR;
            PG8_LDB(B0, 1, 0); PG8_SCHED; PG8_LDA(At, 1, 0); PG8_STAGE(PG8_SA(0, 1), a2 + hstep, voffA);
            PG8_WAIT_L(8); PG8_BAR; PG8_WAIT_L(0); PG8_MMA(0, 0, At, B0); PG8_BAR; PG8_SCHED;
            PG8_LDB(B1, 1, 1); PG8_STAGE(PG8_SB(1, 0), b3, voffB);
            PG8_BAR; PG8_WAIT_L(0); PG8_MMA(0, 1, At, B1); PG8_BAR;
            PG8_LDA(At, 1, 1); PG8_STAGE(PG8_SA(1, 0), a3, voffA);
            PG8_BAR; PG8_WAIT_L(0); PG8_MMA(1, 0, At, B0); PG8_BAR; PG8_SCHED;
            PG8_STAGE(PG8_SB(1, 1), b3 + hstep, voffB);
            PG8_WAIT_V(6); PG8_BAR; PG8_MMA(1, 1, At, B1); PG8_BAR;
            }
        }
        if constexpr (ALIGN_EPI) { if (wr == 0) PG8_BAR; }
        if constexpr (!Epi::AFTER_DRAIN) { E(acc, cur, wr, wc, fr, fq); S.done(cur); }
        if (!has_next) break;
#pragma unroll
        for (int a = 0; a < 2; ++a)
#pragma unroll
            for (int b = 0; b < 2; ++b)
#pragma unroll
                for (int m = 0; m < 4; ++m)
#pragma unroll
                    for (int n = 0; n < 2; ++n) acc[a][b][m][n] = (f32x4){0.f, 0.f, 0.f, 0.f};
        cur = nxt; cA = nA; cB = nB; ++ui;
        if constexpr (GATHER) { _Pragma("unroll") for (int h_ = 0; h_ < 2; ++h_) { cvo[h_][0] = nvo[h_][0]; cvo[h_][1] = nvo[h_][1]; } }
        if constexpr (ALIGN_EPI) { if (wr == 1) PG8_BAR; }
    }
    PG8_WAIT_V(0);
    if constexpr (!ALIGN_EPI) { if (wr == 0) PG8_BAR; }
    PG8_BAR;
    if constexpr (Epi::AFTER_DRAIN) { E.fused(acc, cur, wr, wc, fr, fq, lds, wid, lane); S.done(cur); }
#undef PG8_SA
#undef PG8_SB
#undef PG8_STAGE
#undef PG8_STAGE_A
#undef PG8_ROWS
#undef PG8_LDA
#undef PG8_LDB
#undef PG8_MMA
#undef PG8_WAIT_V
#undef PG8_WAIT_L
#undef PG8_BAR
#undef PG8_SCHED
}
}

constexpr int NWAVES = 8;
constexpr int NB = 8, SEQ = 4096, DM = 1024, MTOK = NB * SEQ, NLAYER = 2;
constexpr int INC = 2984, INCP = 3072;
constexpr int C_RET = 0, C_RW = 1024, C_DSA = 1920, C_SB = 2216;
constexpr int PBW = 1792, PFW = 1280, PB_SB = 1024, PF_DSA = 896;
constexpr int NEXP = 32, MOE_ROWS = MTOK * 4 + NEXP * 256;
constexpr int ROPE_W = 88;
constexpr int NCH = 16, TCH = SEQ / NCH;
constexpr int NPL = 11, NPHASE = 1 + NLAYER * NPL;
enum { I_X = 0, I_C, I_POS, I_ADAW, I_ADAB, I_NMIX, I_NFFN, I_WIN, I_RETGN, I_MU, I_W0, I_W2, I_A0, I_A2, I_G2, I_KK, I_KA, I_RK, I_LN, I_QNORM, I_WQ, I_WQI, I_DONORM, I_SONORM, I_WOUT, I_RW, I_RB, I_MW1, I_MB1, I_MW2, I_MB2, I_NFINAL, N_IN };

constexpr size_t MiB = 1u << 20;
constexpr size_t WS_CTL = 0, CTL_ZERO_BYTES = 1 * MiB;
constexpr size_t WS_MOD = 1 * MiB, WS_ROPE = 2 * MiB, WS_WIN = 14 * MiB, WS_WOUT = 26 * MiB, WS_W1 = 30 * MiB, WS_W2 = 286 * MiB;
constexpr size_t WS_XA = 414 * MiB, WS_H = 542 * MiB, WS_MIX = 606 * MiB, WS_TOPI = 670 * MiB, WS_TOPW = 671 * MiB, WS_POS = 672 * MiB;
constexpr size_t WS_R = 674 * MiB;
constexpr size_t WS_PB = WS_R  , WS_PF = WS_R + 112 * MiB  , WS_RWA = 946 * MiB  , WS_DQ = 1314 * MiB  , WS_DKB = 1330 * MiB  , WS_DVB = 1334 * MiB  , WS_DQI = 1346 * MiB  , WS_DKI = 1394 * MiB  , WS_DW = 1398 * MiB;
constexpr size_t WS_SMALLW = 1338 * MiB  ;
constexpr int SMW_QI = 0, SMW_W2 = 512 * 128, SMW_A2 = SMW_W2 + 256 * 32, SMW_G2 = SMW_A2 + 256 * 32, SMW_LAYER = SMW_G2 + 256 * 64;
constexpr size_t WS_PT = 1362 * MiB  ;
constexpr size_t WS_CH = WS_H  , WS_SI = WS_H + 16 * MiB  , WS_SIR = WS_H + 24 * MiB  ,
                 WS_CHR = WS_H + 32 * MiB  , WS_PTR = WS_H + 40 * MiB  ;
constexpr size_t WS_SQ = WS_MIX  , WS_SK = WS_MIX + 16 * MiB, WS_SV = WS_MIX + 32 * MiB;
constexpr size_t WS_YO = 1400 * MiB  , WS_SC = 1528 * MiB  ;
constexpr size_t WS_XS = WS_R  , WS_ACT = 946 * MiB  ;
constexpr size_t WS_LIST = 2040 * MiB  , WS_END = 2044 * MiB;
constexpr int LCAP = 32768;
static_assert((size_t)MOE_ROWS * 2048 <= 272 * MiB, "moe buffers");
constexpr int CW_TMO = 0, CW_CODE = 1, CW_GCNT = 256  , CW_DSAQ = 1024  , CW_BAR = 4096, CW_BLKCNT = 16384  ;
constexpr int RING_BYTES = 131072, MISC_OFF = RING_BYTES + 320, TST_OFF = RING_BYTES + 1024  , TAB_OFF = RING_BYTES + 2048  , HIST_OFF = RING_BYTES + 5120  , BASE_OFF = RING_BYTES + 5376  , CNT_OFF = RING_BYTES + 5632  , TEXP_OFF = RING_BYTES + 6144  , LDS_BYTES = 147456;

#if defined(__HIP_DEVICE_COMPILE__)
#define GAS __attribute__((address_space(1)))
#define CAS __attribute__((address_space(4)))
#else
#define GAS
#define CAS
#endif
#define LAS __attribute__((address_space(3)))
typedef unsigned short bf16;
typedef unsigned v4u __attribute__((ext_vector_type(4)));
typedef unsigned v2u __attribute__((ext_vector_type(2)));
typedef float f32x4 __attribute__((ext_vector_type(4)));
typedef GAS unsigned gu32;
typedef short bf16x8v __attribute__((ext_vector_type(8)));
typedef short s16x4v __attribute__((ext_vector_type(4)));
typedef _Float16 f16x8 __attribute__((ext_vector_type(8)));
#define RLX_AGENT __ATOMIC_RELAXED, __HIP_MEMORY_SCOPE_AGENT
#define LDS_WAIT() asm volatile("s_waitcnt lgkmcnt(0)" ::: "memory")
#define VM_WAIT() asm volatile("s_waitcnt vmcnt(0)" ::: "memory")
__device__ __forceinline__ unsigned f2bf(float f) { unsigned u = __builtin_bit_cast(unsigned, f); return (u + 0x7fffu + ((u >> 16) & 1u)) >> 16; }
__device__ __forceinline__ unsigned pk2(float lo, float hi) { return f2bf(lo) | (f2bf(hi) << 16); }
__device__ __forceinline__ float bf_lo(unsigned w) { return __builtin_bit_cast(float, w << 16); }
__device__ __forceinline__ float bf_hi(unsigned w) { return __builtin_bit_cast(float, w & 0xffff0000u); }
__device__ __forceinline__ float wave_sum(float v) {
#pragma unroll
    for (int o = 1; o < 64; o <<= 1) v += __shfl_xor(v, o);
    return v;
}
__device__ __forceinline__ float wave_max(float v) {
#pragma unroll
    for (int o = 1; o < 64; o <<= 1) v = fmaxf(v, __shfl_xor(v, o));
    return v;
}
__device__ __forceinline__ float grp16_sum(float v) { v += __shfl_xor(v, 1); v += __shfl_xor(v, 2); v += __shfl_xor(v, 4); v += __shfl_xor(v, 8); return v; }
__device__ __forceinline__ float grp8_sum(float v) { v += __shfl_xor(v, 1); v += __shfl_xor(v, 2); v += __shfl_xor(v, 4); return v; }
__device__ __forceinline__ float sum4(f32x4 a) { return (a.x + a.y) + (a.z + a.w); }
__device__ __forceinline__ float dot4(f32x4 a, f32x4 b) { return (a.x * b.x + a.y * b.y) + (a.z * b.z + a.w * b.w); }
__device__ __forceinline__ float fexp(float x) { return __builtin_amdgcn_exp2f(x * 1.4426950408889634f); }
__device__ __forceinline__ float sigm(float x) { return __builtin_amdgcn_rcpf(1.0f + fexp(-x)); }
__device__ __forceinline__ float softplusf(float x) { return fmaxf(x, 0.0f) + 0.6931471805599453f * __builtin_amdgcn_logf(1.0f + fexp(-fabsf(x))); }
__device__ __forceinline__ float ftanh(float x) { const float e = fexp(-2.0f * fabsf(x)); const float t = (1.0f - e) * __builtin_amdgcn_rcpf(1.0f + e); return x < 0.0f ? -t : t; }
__device__ __forceinline__ f32x4 shx4(f32x4 v, int m) { f32x4 r; r.x = __shfl_xor(v.x, m); r.y = __shfl_xor(v.y, m); r.z = __shfl_xor(v.z, m); r.w = __shfl_xor(v.w, m); return r; }

#define XB_TMO      128
#define XB_XCNT(j)  (256  + 64 * (j))
#define XB_XSUB(j)  (1280 + 64 * (j))
#define XB_XGEN(j)  (2304 + 64 * (j))
#define XB_TOP      3328
#define XB_TOPGEN   3392
#define XCD_BAR_WORDS 3456
#define XB_SPIN_CAP (1u << 18)

__device__ __forceinline__ unsigned xb_ld(unsigned* p)              { return __hip_atomic_load(p, __ATOMIC_RELAXED, __HIP_MEMORY_SCOPE_AGENT); }
__device__ __forceinline__ unsigned xb_add(unsigned* p, unsigned v) { return __hip_atomic_fetch_add(p, v, __ATOMIC_RELAXED, __HIP_MEMORY_SCOPE_AGENT); }
__device__ __forceinline__ unsigned xb_xcc_id() { return (unsigned)__builtin_amdgcn_s_getreg((3 << 11) | 20) & 0xFu; }
#define XB_SPIN(cond, bar) do { unsigned _sp = 0; while (cond) { __builtin_amdgcn_s_sleep(1); \
    if ((++_sp & 255u) == 0u) { if (xb_ld(&(bar)[XB_TMO])) break; if (_sp > XB_SPIN_CAP) { atomicAdd(&(bar)[XB_TMO], 1u); break; } } } } while (0)

struct XcdBarrier {
    unsigned* bar; unsigned x;
    volatile LAS unsigned* st;
};

__device__ __forceinline__ XcdBarrier xcd_barrier_post(unsigned* bar, volatile LAS unsigned* st, int xb_tid) {
    XcdBarrier b; b.bar = bar; b.x = xb_xcc_id(); b.st = st;
    if (xb_tid == 0) (void)xb_add(&bar[XB_XCNT(b.x)], 1u);
    return b;
}
__device__ __forceinline__ void xcd_barrier_complete(unsigned* bar, unsigned x, unsigned& nloc, unsigned& nx) {
    const unsigned G = gridDim.x * gridDim.y * gridDim.z;
    unsigned sum, cnt, mine, sp = 0u;
    for (;;) {
        sum = 0u; cnt = 0u; mine = 0u;
#pragma unroll
        for (unsigned j = 0; j < 16; ++j) { const unsigned c = xb_ld(&bar[XB_XCNT(j)]); sum += c; cnt += (c > 0u) ? 1u : 0u; mine = (j == x) ? c : mine; }
        if (sum == G) break;
        __builtin_amdgcn_s_sleep(1);
        if ((++sp & 255u) == 0u) { if (xb_ld(&bar[XB_TMO])) break; if (sp > XB_SPIN_CAP) { atomicAdd(&bar[XB_TMO], 1u); break; } }
    }
    nloc = mine > 0u ? mine : 1u; nx = cnt > 0u ? cnt : 1u;
}

__device__ __forceinline__ void xcd_barrier(const XcdBarrier& b, int xb_tid) {
    asm volatile("s_waitcnt vmcnt(0)" ::: "memory");
    __syncthreads();
    if (xb_tid == 0) {
        unsigned* bar = b.bar;
        __builtin_amdgcn_s_waitcnt(0);
        unsigned nloc = b.st[0], nx = b.st[1];
        if (nloc == 0u) { xcd_barrier_complete(bar, b.x, nloc, nx); b.st[0] = nloc; b.st[1] = nx; }
        const unsigned old = xb_add(&bar[XB_XSUB(b.x)], 1u);
        const unsigned gen = old / nloc;
        if (old + 1u == (gen + 1u) * nloc) {
            __builtin_amdgcn_fence(__ATOMIC_RELEASE, "agent");
            asm volatile("s_waitcnt vmcnt(0)" ::: "memory");
            const unsigned og = xb_add(&bar[XB_TOP], 1u);
            const unsigned tg = og / nx;
            if (og + 1u == (tg + 1u) * nx) xb_add(&bar[XB_TOPGEN], 1u);
            else XB_SPIN(xb_ld(&bar[XB_TOPGEN]) == tg, bar);
            __builtin_amdgcn_fence(__ATOMIC_ACQUIRE, "agent");
            xb_add(&bar[XB_XGEN(b.x)], 1u);
            asm volatile("s_waitcnt vmcnt(0)" ::: "memory");
        } else {
            XB_SPIN(xb_ld(&bar[XB_XGEN(b.x)]) == gen, bar);
            __builtin_amdgcn_fence(__ATOMIC_ACQUIRE, "agent");
            asm volatile("s_waitcnt vmcnt(0)" ::: "memory");
        }
    }
    __syncthreads();
}
struct ArgsH { const float* in[N_IN]; float* out; unsigned char* ws; double invf[44]; int ph_lo, ph_hi, li, pad; };
struct ArgsD { const GAS float* in[N_IN]; GAS float* out; GAS unsigned char* ws; double invf[44]; int ph_lo, ph_hi, li, pad; };
static_assert(sizeof(ArgsH) == sizeof(ArgsD), "args layout");
typedef const CAS ArgsD& ARef;
__device__ __forceinline__ const CAS ArgsD* kargs() {
#if defined(__HIP_DEVICE_COMPILE__)
    const CAS ArgsD* p = (const CAS ArgsD*)__builtin_amdgcn_kernarg_segment_ptr(); asm volatile("" : "+s"(p)); return p;
#else
    return nullptr;
#endif
}
struct WI { LAS unsigned char* lds; int tid, lane, wave, vcu, G, gw, NGW, bx; };
constexpr size_t RWA_STRIDE = (33 * MiB + 68 * 1024) / 4;
constexpr size_t YO_STRIDE = 32 * MiB / 4;

__device__ __forceinline__ int wave_sum_i(int v) {
#pragma unroll
    for (int o = 1; o < 64; o <<= 1) v += __shfl_xor(v, o);
    return v;
}
__device__ __forceinline__ void sincos_d(double ang, float& s, float& c) {
    const double q = __builtin_rint(ang * 0.63661977236758134308);
    double r = __builtin_fma(-q, 1.57079632679489661923, ang); r = __builtin_fma(-q, 6.123233995736766e-17, r);
    const double r2 = r * r;
    const double sp = r * (1.0 + r2 * (-1.0 / 6 + r2 * (1.0 / 120 + r2 * (-1.0 / 5040 + r2 * (1.0 / 362880 + r2 * (-1.0 / 39916800 + r2 * (1.0 / 6227020800.0)))))));
    const double cp = 1.0 + r2 * (-0.5 + r2 * (1.0 / 24 + r2 * (-1.0 / 720 + r2 * (1.0 / 40320 + r2 * (-1.0 / 3628800 + r2 * (1.0 / 479001600 + r2 * (-1.0 / 87178291200.0)))))));
    const int qi = ((int)q) & 3;
    const double ss = (qi == 0) ? sp : (qi == 1) ? cp : (qi == 2) ? -sp : -cp;
    const double cc = (qi == 0) ? cp : (qi == 1) ? -sp : (qi == 2) ? -cp : sp;
    s = (float)ss; c = (float)cc;
}

struct TrItem { const float* src; bf16* dst; int ldw; float scale; bool ok; };
__device__ __forceinline__ void tr_decode(ARef A, int it, int lane, TrItem& d) {
    constexpr int I_IN = NLAYER * 16 * 96, I_OUT = NLAYER * 16 * 32, I_W1 = NLAYER * NEXP * 16 * 64;
    const float* W; int ldw, nvalid, k0, nsrc0; bf16* WT; size_t dstrow0; float scale = 1.0f;
    int r = it;
    if (r < I_IN) { const int l = r / 1536, rr = r % 1536, kb = rr / 96, nb = rr % 96;
        const int nd = nb * 32;
        nsrc0 = (nd < 1024) ? nd : (nd < 1792) ? C_SB + (nd - 1024) : (nd < 2688) ? C_RW + (nd - 1792) : C_DSA + (nd - 2688);
        nvalid = (nd < 1024) ? 1024 : (nd < 1792) ? INC : (nd < 2688) ? C_DSA : ((nd < INC) ? C_SB : 0);
        scale = (nd >= 256 && nd < 512) ? 0.125f : (nd >= 1024 && nd < 1280) ? 0.18033688011112042f : 1.0f;
        W = A.in[I_WIN] + (size_t)l * DM * INC; ldw = INC; k0 = kb * 64; WT = (bf16*)(A.ws + WS_WIN) + (size_t)l * INCP * DM; dstrow0 = (size_t)nd; }
    else if (r < I_IN + I_OUT) { r -= I_IN; const int l = r / 512, rr = r % 512, kb = rr / 32, nb = rr % 32;
        W = A.in[I_WOUT] + (size_t)l * DM * DM; ldw = DM; nvalid = DM; k0 = kb * 64; nsrc0 = nb * 32; WT = (bf16*)(A.ws + WS_WOUT) + (size_t)l * DM * DM; dstrow0 = (size_t)nb * 32; }
    else if (r < I_IN + I_OUT + I_W1) { r -= I_IN + I_OUT; const int le = r / 1024, rr = r % 1024, kb = rr / 64, nb = rr % 64, j = nb >> 3, bj = (nb >> 2) & 1, cc0 = (nb & 3) * 32;
        W = A.in[I_MW1] + (size_t)le * DM * 2048; ldw = 2048; nvalid = 2048; k0 = kb * 64; nsrc0 = bj * 1024 + 128 * j + cc0; WT = (bf16*)(A.ws + WS_W1) + (size_t)le * 2048 * DM; dstrow0 = (size_t)nb * 32; }
    else { r -= I_IN + I_OUT + I_W1; const int le = r / 512, rr = r % 512, kb = rr / 32, nb = rr % 32;
        W = A.in[I_MW2] + (size_t)le * DM * DM; ldw = DM; nvalid = DM; k0 = kb * 64; nsrc0 = nb * 32; WT = (bf16*)(A.ws + WS_W2) + (size_t)le * DM * DM; dstrow0 = (size_t)nb * 32; }
    const int n = nsrc0 + 4 * (lane & 7);
    d.ok = n < nvalid; d.src = W + (size_t)(k0 + (lane >> 3)) * ldw + (d.ok ? n : 0); d.ldw = ldw; d.scale = scale;
    d.dst = WT + (dstrow0 + (lane >> 3)) * 1024 + k0 + 8 * (lane & 7);
}
__device__ __forceinline__ void tr_load(const TrItem& d, f32x4 (&v)[8]) {
#pragma unroll
    for (int i = 0; i < 8; ++i) v[i] = *(const f32x4*)(d.src + (size_t)(8 * i) * d.ldw);
}
__device__ __forceinline__ void tr_store(const TrItem& d, const f32x4 (&v)[8], LAS float* scr, int lane) {
    const float sc_ = d.ok ? d.scale : 0.0f;
#pragma unroll
    for (int i = 0; i < 8; ++i) { LAS float* s = scr + (8 * i + (lane >> 3)) * 33 + 4 * (lane & 7); s[0] = v[i].x * sc_; s[1] = v[i].y * sc_; s[2] = v[i].z * sc_; s[3] = v[i].w * sc_; }
    LDS_WAIT(); asm volatile("" ::: "memory");
    const int c8 = lane & 7;
#pragma unroll
    for (int j = 0; j < 4; ++j) { const int n = (lane >> 3) + 8 * j; const LAS float* s = scr + (8 * c8) * 33 + n;
        v4u o; o.x = pk2(s[0 * 33], s[1 * 33]); o.y = pk2(s[2 * 33], s[3 * 33]); o.z = pk2(s[4 * 33], s[5 * 33]); o.w = pk2(s[6 * 33], s[7 * 33]);
        *(v4u*)(d.dst + (size_t)(8 * j) * 1024) = o; }
    LDS_WAIT(); asm volatile("" ::: "memory");
}
__device__ __forceinline__ void ph_prologue(ARef A, const WI& w) {
    LAS float* sc = (LAS float*)w.lds;
    { const float* cin = A.in[I_C]; for (int i = w.tid; i < NB * DM; i += NWAVES * 64) { const float v = cin[i]; sc[i] = v / (1.0f + expf(-v)); } }
    __syncthreads();
    float* MOD = (float*)(A.ws + WS_MOD);
    LAS float* red = (LAS float*)(w.lds + 32768);
    if (w.vcu < 192) {
        const int l = w.vcu / 96, col = (w.vcu % 96) * 64 + w.lane, kw = 128 * w.wave;
        const float* wp = A.in[I_ADAW] + (size_t)l * DM * 6144 + (size_t)kw * 6144 + col;
        float acc[8];
#pragma unroll
        for (int b = 0; b < 8; ++b) acc[b] = 0.0f;
#pragma unroll 16
        for (int k = 0; k < 128; ++k) { const float wv = wp[(size_t)k * 6144];
#pragma unroll
            for (int b = 0; b < 8; ++b) acc[b] += sc[b * DM + kw + k] * wv; }
#pragma unroll
        for (int b = 0; b < 8; ++b) red[(w.wave * 8 + b) * 64 + w.lane] = acc[b];
    }
    __syncthreads();
    if (w.vcu < 192) { const int l = w.vcu / 96, b = w.wave, col = (w.vcu % 96) * 64 + w.lane;
        float s = A.in[I_ADAB][l * 6144 + col];
#pragma unroll
        for (int q = 0; q < 8; ++q) s += red[(q * 8 + b) * 64 + w.lane];
        MOD[(size_t)(l * 8 + b) * 6144 + col] = s; }
    __syncthreads();
    LAS float* scr = (LAS float*)(w.lds + 32768 + w.wave * 8448);
    constexpr int NIT = NLAYER * 16 * 96 + NLAYER * 16 * 32;
    { TrItem d0, d1; f32x4 va[8], vb[8];
      int it = w.gw; bool h0 = it < NIT;
      if (h0) { tr_decode(A, it, w.lane, d0); tr_load(d0, va); }
      while (h0) {
          it += w.NGW; const bool h1 = it < NIT;
          if (h1) { tr_decode(A, it, w.lane, d1); tr_load(d1, vb); }
          tr_store(d0, va, scr, w.lane);
          if (!h1) break;
          it += w.NGW; h0 = it < NIT;
          if (h0) { tr_decode(A, it, w.lane, d0); tr_load(d0, va); }
          tr_store(d1, vb, scr, w.lane);
      } }
    float* RT = (float*)(A.ws + WS_ROPE); const int* pos = (const int*)A.in[I_POS];
    for (int g = w.gw * 64 + w.lane; g < MTOK * 44; g += w.NGW * 64) {
        const int tok = g / 44, f = g % 44; int co, so;
        if (f < 32) { co = f; so = 32 + f; } else if (f < 40) { co = 64 + (f - 32); so = 72 + (f - 32); } else { co = 80 + (f - 40); so = 84 + (f - 40); }
        float s, c; sincos_d((double)pos[tok] * A.invf[f], s, c);
        RT[(size_t)tok * ROPE_W + co] = c; RT[(size_t)tok * ROPE_W + so] = s;
    }
}

__device__ __forceinline__ void moe_convert_chunk(ARef A, int l, int c, int lane, LAS float* scr) {
    constexpr int I0 = NLAYER * 16 * 96 + NLAYER * 16 * 32, I_W1 = NLAYER * NEXP * 16 * 64;
    const int it0 = (c < 8192) ? I0 + l * 32768 + 4 * c : I0 + I_W1 + l * 16384 + 4 * (c - 8192);
    TrItem d0, d1; f32x4 va[8], vb[8];
    tr_decode(A, it0, lane, d0); tr_load(d0, va);
    tr_decode(A, it0 + 1, lane, d1); tr_load(d1, vb);
    tr_store(d0, va, scr, lane);
    tr_decode(A, it0 + 2, lane, d0); tr_load(d0, va);
    tr_store(d1, vb, scr, lane);
    tr_decode(A, it0 + 3, lane, d1); tr_load(d1, vb);
    tr_store(d0, va, scr, lane);
    tr_store(d1, vb, scr, lane);
}

__device__ __forceinline__ void emit_h_row(const f32x4 (&v)[4], float rstd, const float* g, const float* sc, const float* sh, bf16* hrow, int lane) {
#pragma unroll
    for (int j = 0; j < 4; ++j) { const int k = 4 * (lane + 64 * j);
        const f32x4 gv = *(const f32x4*)(g + k), scv = *(const f32x4*)(sc + k), shv = *(const f32x4*)(sh + k);
        const f32x4 h = v[j] * rstd * gv * (1.0f + scv) + shv;
        v2u o; o.x = pk2(h.x, h.y); o.y = pk2(h.z, h.w); *(v2u*)(hrow + k) = o; }
}
__device__ __forceinline__ void small_weights_to_f16(ARef A, const WI& w) {
    { _Float16* SW = (_Float16*)(A.ws + WS_SMALLW);
      const int g0 = w.gw * 64 + w.lane, gs = w.NGW * 64;
      for (int l = 0; l < NLAYER; ++l) { _Float16* S = SW + (size_t)l * SMW_LAYER;
          const float* wq = A.in[I_WQ] + (size_t)l * 128 * 256; const float* wqi = A.in[I_WQI] + (size_t)l * 128 * 256;
          for (int e = g0; e < 256 * 128; e += gs) { const int n = e >> 7, k = e & 127; S[SMW_QI + e] = (_Float16)wq[k * 256 + n]; S[SMW_QI + 256 * 128 + e] = (_Float16)wqi[k * 256 + n]; }
          const float* w2 = A.in[I_W2] + (size_t)l * 32 * 256; const float* a2 = A.in[I_A2] + (size_t)l * 32 * 256; const float* g2 = A.in[I_G2] + (size_t)l * 64 * 256;
          for (int e = g0; e < 256 * 32; e += gs) { const int n = e >> 5, k = e & 31; S[SMW_W2 + e] = (_Float16)w2[k * 256 + n]; S[SMW_A2 + e] = (_Float16)a2[k * 256 + n]; }
          for (int e = g0; e < 256 * 64; e += gs) { const int n = e >> 6, k = e & 63; S[SMW_G2 + e] = (_Float16)g2[k * 256 + n]; } } }
}
__device__ __forceinline__ void ph_norm1(ARef A, const WI& w) {
    const float* MOD = (const float*)(A.ws + WS_MOD); bf16* H = (bf16*)(A.ws + WS_H);
    for (int m = w.gw; m < MTOK; m += w.NGW) {
        const float* xr = A.in[I_X] + (size_t)m * DM; f32x4 v[4]; float ss = 0.0f;
#pragma unroll
        for (int j = 0; j < 4; ++j) { v[j] = *(const f32x4*)(xr + 4 * (w.lane + 64 * j)); ss += dot4(v[j], v[j]); }
        ss = wave_sum(ss); const float rstd = 1.0f / sqrtf(ss * (1.0f / DM) + 1e-5f);
        const float* mb = MOD + (size_t)(m >> 12) * 6144;
        emit_h_row(v, rstd, A.in[I_NMIX], mb + 1024, mb, H + (size_t)m * DM, w.lane);
    }
}

typedef _Float16 h4v __attribute__((ext_vector_type(4)));
__device__ __forceinline__ f16x8 pack_f16x8(f32x4 a, f32x4 b) { f16x8 r; r[0] = (_Float16)a.x; r[1] = (_Float16)a.y; r[2] = (_Float16)a.z; r[3] = (_Float16)a.w; r[4] = (_Float16)b.x; r[5] = (_Float16)b.y; r[6] = (_Float16)b.z; r[7] = (_Float16)b.w; return r; }
__device__ __forceinline__ void prep16_body(const float* __restrict__ P, float* __restrict__ RWA, const _Float16* __restrict__ SW, const float* __restrict__ RT, bf16* __restrict__ DQ, _Float16* __restrict__ DQI,
                                            bf16* __restrict__ DKB, bf16* __restrict__ DVB, _Float16* __restrict__ DKI, float* __restrict__ DW, const float* __restrict__ mu, const float* __restrict__ qn,
                                            const float* __restrict__ w0p, const float* __restrict__ a0p, const float* __restrict__ kkp, const float* __restrict__ kap, const float* __restrict__ rkp, int m0, int lane_in, int part = 7) {
    int lane = lane_in; asm volatile("" : "+v"(lane));
    const int tk = lane & 15, q4 = lane >> 4, m = m0 + tk, t = m & (SEQ - 1);
    const float* pr = P + (size_t)m * PFW; const float* pp = pr - PFW; const float* pd = P + (size_t)m * PFW + PF_DSA;
    RT += (size_t)m * ROPE_W; const f32x4 zero4 = {0.f, 0.f, 0.f, 0.f};
    f16x8 bx[4], bc[4];
    { float ss = 0.0f; f32x4 c[4][2];
#pragma unroll
      for (int ks = 0; ks < 4; ++ks) { const int f0 = 32 * ks + 8 * q4;
          f32x4 x[2];
#pragma unroll
          for (int u = 0; u < 2; ++u) { const f32x4 z = *(const f32x4*)(pr + 768 + f0 + 4 * u); const f32x4 p = t ? *(const f32x4*)(pp + 768 + f0 + 4 * u) : zero4; x[u] = z + (p - z) * *(const f32x4*)(mu + 768 + f0 + 4 * u);
#pragma unroll
              for (int i = 0; i < 4; ++i) x[u][i] = (ks == 0) ? ftanh(x[u][i]) : (ks == 1) ? x[u][i] : sigm(x[u][i]); }
          bx[ks] = pack_f16x8(x[0], x[1]);
          c[ks][0] = *(const f32x4*)(pd + f0); c[ks][1] = *(const f32x4*)(pd + f0 + 4); ss += dot4(c[ks][0], c[ks][0]) + dot4(c[ks][1], c[ks][1]); }
      ss += __shfl_xor(ss, 16); ss += __shfl_xor(ss, 32);
      const float rstd = 1.0f / sqrtf(ss * (1.0f / 128.0f) + 1e-5f);
#pragma unroll
      for (int ks = 0; ks < 4; ++ks) { const int f0 = 32 * ks + 8 * q4; bc[ks] = pack_f16x8(c[ks][0] * rstd * *(const f32x4*)(qn + f0), c[ks][1] * rstd * *(const f32x4*)(qn + f0 + 4)); } }
    const _Float16* wrow = SW + (size_t)tk * 0;
    (void)wrow;
    const int arow = lane & 15;
    if (part & 1)
#pragma unroll 2
    for (int hd = 0; hd < 4; ++hd) {
        f32x4 fk[4], av[4]; float ssk = 0.0f;
#pragma unroll
        for (int j = 0; j < 4; ++j) { const int nb = 4 * hd + j, ch = 16 * nb + 4 * q4; const size_t o = (size_t)m * 256 + ch;
            const f16x8 aw = *(const f16x8*)(SW + SMW_W2 + (16 * nb + arow) * 32 + 8 * q4), aa = *(const f16x8*)(SW + SMW_A2 + (16 * nb + arow) * 32 + 8 * q4);
            const f16x8 ag0 = *(const f16x8*)(SW + SMW_G2 + (16 * nb + arow) * 64 + 8 * q4), ag1 = *(const f16x8*)(SW + SMW_G2 + (16 * nb + arow) * 64 + 32 + 8 * q4);
            const f32x4 cw = __builtin_amdgcn_mfma_f32_16x16x32_f16(aw, bx[0], *(const f32x4*)(w0p + ch), 0, 0, 0);
            const f32x4 ca = __builtin_amdgcn_mfma_f32_16x16x32_f16(aa, bx[1], *(const f32x4*)(a0p + ch), 0, 0, 0);
            f32x4 cg = __builtin_amdgcn_mfma_f32_16x16x32_f16(ag0, bx[2], zero4, 0, 0, 0); cg = __builtin_amdgcn_mfma_f32_16x16x32_f16(ag1, bx[3], cg, 0, 0, 0);
            f32x4 dec;
#pragma unroll
            for (int i = 0; i < 4; ++i) { dec[i] = fexp(-fexp(-softplusf(-cw[i]) - 0.5f)); av[j][i] = sigm(ca[i]); }
            *(f32x4*)(RWA + 1 * RWA_STRIDE + o) = dec; *(f32x4*)(RWA + 6 * RWA_STRIDE + o) = cg;
            { const f32x4 z = *(const f32x4*)(pr + 256 + ch); const f32x4 p = t ? *(const f32x4*)(pp + 256 + ch) : zero4; fk[j] = z + (p - z) * *(const f32x4*)(mu + 256 + ch); }
            const f32x4 kk = fk[j] * *(const f32x4*)(kkp + ch); ssk += dot4(kk, kk); }
        ssk += __shfl_xor(ssk, 16); ssk += __shfl_xor(ssk, 32);
        const float inrm = 1.0f / fmaxf(sqrtf(ssk), 1e-12f);
        f32x4 fr[4], km[4]; float bs = 0.0f;
#pragma unroll
        for (int j = 0; j < 4; ++j) { const int ch = 16 * (4 * hd + j) + 4 * q4;
            { const f32x4 z = *(const f32x4*)(pr + ch); const f32x4 p = t ? *(const f32x4*)(pp + ch) : zero4; fr[j] = z + (p - z) * *(const f32x4*)(mu + ch); }
            km[j] = fk[j] * (1.0f + (av[j] - 1.0f) * *(const f32x4*)(kap + ch)); bs += dot4(fr[j] * km[j], *(const f32x4*)(rkp + ch)); }
        bs += __shfl_xor(bs, 16); bs += __shfl_xor(bs, 32);
#pragma unroll
        for (int j = 0; j < 4; ++j) { const int ch = 16 * (4 * hd + j) + 4 * q4; const size_t o = (size_t)m * 256 + ch;
            f32x4 fv; { const f32x4 z = *(const f32x4*)(pr + 512 + ch); const f32x4 p = t ? *(const f32x4*)(pp + 512 + ch) : zero4; fv = z + (p - z) * *(const f32x4*)(mu + 512 + ch); }
            const f32x4 kk = fk[j] * *(const f32x4*)(kkp + ch) * inrm;
            *(f32x4*)(RWA + 0 * RWA_STRIDE + o) = fr[j]; *(f32x4*)(RWA + 2 * RWA_STRIDE + o) = km[j]; *(f32x4*)(RWA + 3 * RWA_STRIDE + o) = fv;
            *(f32x4*)(RWA + 4 * RWA_STRIDE + o) = -kk; *(f32x4*)(RWA + 5 * RWA_STRIDE + o) = kk * av[j]; *(f32x4*)(RWA + 7 * RWA_STRIDE + o) = bs * fv; }
    }
    if (part & 2)
#pragma unroll 4
    for (int nb = 0; nb < 32; ++nb) {
        f32x4 cq = zero4;
#pragma unroll
        for (int ks = 0; ks < 4; ++ks) { const f16x8 aq = *(const f16x8*)(SW + SMW_QI + (16 * nb + arow) * 128 + 32 * ks + 8 * q4); cq = __builtin_amdgcn_mfma_f32_16x16x32_f16(aq, bc[ks], cq, 0, 0, 0); }
        const int ch = 16 * (nb & 15) + 4 * q4;
        if (nb < 16) {
            if ((nb & 3) == 0) { const f32x4 ot = shx4(cq, 32); const int fi = 4 * (q4 & 1); const f32x4 cs4 = *(const f32x4*)(RT + 64 + fi), sn = *(const f32x4*)(RT + 72 + fi); cq = (q4 < 2) ? cq * cs4 - ot * sn : ot * sn + cq * cs4; }
            const f32x4 qs = cq * 0.18033688011112042f; v2u o; o.x = pk2(qs.x, qs.y); o.y = pk2(qs.z, qs.w); *(v2u*)(DQ + (size_t)m * 256 + ch) = o;
        } else {
            if ((nb & 1) == 0) { const f32x4 ot = shx4(cq, 16); const f32x4 cs4 = *(const f32x4*)(RT + 80), sn = *(const f32x4*)(RT + 84); if (q4 < 2) cq = (q4 < 1) ? cq * cs4 - ot * sn : ot * sn + cq * cs4; }
            h4v hq; hq.x = (_Float16)cq.x; hq.y = (_Float16)cq.y; hq.z = (_Float16)cq.z; hq.w = (_Float16)cq.w; *(h4v*)(DQI + (size_t)m * 256 + ch) = hq;
        }
    }
#pragma unroll
    for (int j = 0; j < 4; ++j) { const int d = 16 * j + 4 * q4; f32x4 kx = *(const f32x4*)(pd + 128 + d);
        if (j == 0) { const f32x4 ot = shx4(kx, 32); const int fi = 4 * (q4 & 1); const f32x4 cs4 = *(const f32x4*)(RT + 64 + fi), sn = *(const f32x4*)(RT + 72 + fi); kx = (q4 < 2) ? kx * cs4 - ot * sn : ot * sn + kx * cs4; }
        v2u o; o.x = pk2(kx.x, kx.y); o.y = pk2(kx.z, kx.w); *(v2u*)(DKB + (size_t)m * 64 + d) = o;
        const f32x4 vx = *(const f32x4*)(pd + 192 + d); v2u ov; ov.x = pk2(vx.x, vx.y); ov.y = pk2(vx.z, vx.w); *(v2u*)(DVB + (size_t)m * 64 + d) = ov; }
#pragma unroll
    for (int j = 0; j < 2; ++j) { const int d = 16 * j + 4 * q4; f32x4 ki = *(const f32x4*)(pd + 256 + d);
        if (j == 0) { const f32x4 ot = shx4(ki, 16); const f32x4 cs4 = *(const f32x4*)(RT + 80), sn = *(const f32x4*)(RT + 84); if (q4 < 2) ki = (q4 < 1) ? ki * cs4 - ot * sn : ot * sn + ki * cs4; }
        h4v hk; hk.x = (_Float16)ki.x; hk.y = (_Float16)ki.y; hk.z = (_Float16)ki.z; hk.w = (_Float16)ki.w; *(h4v*)(DKI + (size_t)m * 32 + d) = hk; }
    if (q4 < 2) *(f32x4*)(DW + (size_t)m * 8 + 4 * q4) = *(const f32x4*)(pd + 288 + 4 * q4) * 0.0625f;
}

__device__ __forceinline__ void prep16(ARef A, int l, int m0, int lane_in, int part = 7) {
    prep16_body((const float*)(A.ws + WS_PF), (float*)(A.ws + WS_RWA), (const _Float16*)(A.ws + WS_SMALLW) + (size_t)l * SMW_LAYER, (const float*)(A.ws + WS_ROPE), (bf16*)(A.ws + WS_DQ), (_Float16*)(A.ws + WS_DQI),
                (bf16*)(A.ws + WS_DKB), (bf16*)(A.ws + WS_DVB), (_Float16*)(A.ws + WS_DKI), (float*)(A.ws + WS_DW), A.in[I_MU] + l * 896, A.in[I_QNORM] + l * 128,
                A.in[I_W0] + l * 256, A.in[I_A0] + l * 256, A.in[I_KK] + l * 256, A.in[I_KA] + l * 256, A.in[I_RK] + l * 256, m0, lane_in, part);
}
__device__ __forceinline__ float quad_sum(float v) {
    v += __builtin_bit_cast(float, __builtin_amdgcn_mov_dpp(__builtin_bit_cast(int, v), 0xB1, 0xF, 0xF, true));
    v += __builtin_bit_cast(float, __builtin_amdgcn_mov_dpp(__builtin_bit_cast(int, v), 0x4E, 0xF, 0xF, true));
    return v;
}
__device__ __forceinline__ float oct_sum(float v) {
    v += __builtin_bit_cast(float, __builtin_amdgcn_mov_dpp(__builtin_bit_cast(int, v), 0xB1, 0xF, 0xF, true));
    v += __builtin_bit_cast(float, __builtin_amdgcn_mov_dpp(__builtin_bit_cast(int, v), 0x4E, 0xF, 0xF, true));
    v += __builtin_bit_cast(float, __builtin_amdgcn_mov_dpp(__builtin_bit_cast(int, v), 0x141, 0xF, 0xF, true));
    return v;
}
typedef float f32x2 __attribute__((ext_vector_type(2)));
#define LO2(v_) __builtin_shufflevector(v_, v_, 0, 1)
#define HI2(v_) __builtin_shufflevector(v_, v_, 2, 3)
#define RW_ROW(i_) (((i_) < 2) ? (16 * ws + rg + 8 * (i_)) : (64 + 16 * ws + rg + 8 * ((i_) - 2)))
#define RW_LOAD(op, s_) do { const int lo_ = (s_) * 64 + kq * 8; \
    op[0] = *(const LAS f32x4*)(sn + lo_); op[1] = *(const LAS f32x4*)(sn + lo_ + 4); op[2] = *(const LAS f32x4*)(sw + lo_); op[3] = *(const LAS f32x4*)(sw + lo_ + 4); \
    op[4] = *(const LAS f32x4*)(sb + lo_); op[5] = *(const LAS f32x4*)(sb + lo_ + 4); op[6] = *(const LAS f32x4*)(sk + lo_); op[7] = *(const LAS f32x4*)(sk + lo_ + 4); \
    op[8] = *(const LAS f32x4*)(sr + lo_); op[9] = *(const LAS f32x4*)(sr + lo_ + 4); \
    vin[0] = sv[(s_) * 64 + 16 * ws + rg]; vin[1] = sv[(s_) * 64 + 16 * ws + rg + 8]; } while (0)
#define RW_DOT(i_, oa, ob) ({ f32x2 d_ = S[i_][0] * LO2(oa); d_ = S[i_][1] * HI2(oa) + d_; d_ = S[i_][2] * LO2(ob) + d_; d_ = S[i_][3] * HI2(ob) + d_; d_.x + d_.y; })
#define RW_STEP(op, vv, s_) do { float sa_[4], y_[4]; \
    _Pragma("unroll") for (int i_ = 0; i_ < 4; ++i_) sa_[i_] = RW_DOT(i_, op[0], op[1]); \
    _Pragma("unroll") for (int i_ = 0; i_ < 4; ++i_) sa_[i_] += __builtin_bit_cast(float, __builtin_amdgcn_mov_dpp(__builtin_bit_cast(int, sa_[i_]), 0xB1, 0xF, 0xF, true)); \
    _Pragma("unroll") for (int i_ = 0; i_ < 4; ++i_) sa_[i_] += __builtin_bit_cast(float, __builtin_amdgcn_mov_dpp(__builtin_bit_cast(int, sa_[i_]), 0x4E, 0xF, 0xF, true)); \
    _Pragma("unroll") for (int i_ = 0; i_ < 4; ++i_) sa_[i_] += __builtin_bit_cast(float, __builtin_amdgcn_mov_dpp(__builtin_bit_cast(int, sa_[i_]), 0x141, 0xF, 0xF, true)); \
    _Pragma("unroll") for (int i_ = 0; i_ < 2; ++i_) { const f32x2 a2_ = {sa_[i_], sa_[i_]}, v2_ = {vv[i_], vv[i_]}; \
        S[i_][0] = S[i_][0] * LO2(op[2]) + (a2_ * LO2(op[4]) + v2_ * LO2(op[6])); S[i_][1] = S[i_][1] * HI2(op[2]) + (a2_ * HI2(op[4]) + v2_ * HI2(op[6])); \
        S[i_][2] = S[i_][2] * LO2(op[3]) + (a2_ * LO2(op[5]) + v2_ * LO2(op[7])); S[i_][3] = S[i_][3] * HI2(op[3]) + (a2_ * HI2(op[5]) + v2_ * HI2(op[7])); } \
    _Pragma("unroll") for (int i_ = 2; i_ < 4; ++i_) { const f32x2 a2_ = {sa_[i_], sa_[i_]}; \
        S[i_][0] = S[i_][0] * LO2(op[2]) + a2_ * LO2(op[4]); S[i_][1] = S[i_][1] * HI2(op[2]) + a2_ * HI2(op[4]); S[i_][2] = S[i_][2] * LO2(op[3]) + a2_ * LO2(op[5]); S[i_][3] = S[i_][3] * HI2(op[3]) + a2_ * HI2(op[5]); } \
    _Pragma("unroll") for (int i_ = 0; i_ < 4; ++i_) y_[i_] = RW_DOT(i_, op[8], op[9]); \
    _Pragma("unroll") for (int i_ = 0; i_ < 4; ++i_) y_[i_] += __builtin_bit_cast(float, __builtin_amdgcn_mov_dpp(__builtin_bit_cast(int, y_[i_]), 0xB1, 0xF, 0xF, true)); \
    _Pragma("unroll") for (int i_ = 0; i_ < 4; ++i_) y_[i_] += __builtin_bit_cast(float, __builtin_amdgcn_mov_dpp(__builtin_bit_cast(int, y_[i_]), 0x4E, 0xF, 0xF, true)); \
    _Pragma("unroll") for (int i_ = 0; i_ < 4; ++i_) y_[i_] += __builtin_bit_cast(float, __builtin_amdgcn_mov_dpp(__builtin_bit_cast(int, y_[i_]), 0x141, 0xF, 0xF, true)); \
    if (kq == 0) { _Pragma("unroll") for (int i_ = 0; i_ < 4; ++i_) so[(s_) * 128 + RW_ROW(i_)] = y_[i_]; } } while (0)
__device__ __forceinline__ void scan_rwkv_task2(ARef A, const WI& w, int task0) {
    const int slot = w.wave >> 2, ws = w.wave & 3, lt = w.tid & 255, task = task0 + slot;
    const int bh = task >> 4, c = task & 15, b = bh >> 2, h = bh & 3;
    LAS float* sw = (LAS float*)w.lds + slot * 16384; LAS float* sn = sw + 2048; LAS float* sb = sn + 2048; LAS float* sk = sb + 2048; LAS float* sr = sk + 2048; LAS float* sv = sr + 2048; LAS float* so = sv + 2048;
    const float* RWA = (const float*)(A.ws + WS_RWA);
    const int rg = w.lane >> 3, kq = w.lane & 7;
    f32x2 S[4][4];
#pragma unroll
    for (int i = 0; i < 4; ++i)
#pragma unroll
        for (int j = 0; j < 4; ++j) { const int r = RW_ROW(i); S[i][j].x = (r >= 64 && 8 * kq + 2 * j == r - 64) ? 1.0f : 0.0f; S[i][j].y = (r >= 64 && 8 * kq + 2 * j + 1 == r - 64) ? 1.0f : 0.0f; }
    const size_t tok0 = (size_t)b * SEQ + (size_t)c * TCH;
    const int st = lt >> 3, sd = (lt & 7) * 8;
    f32x4 a[6][2];
#define RW_GLOAD(sub_) do { const size_t o_ = (tok0 + (sub_) * 32 + st) * 256 + h * 64 + sd; \
        _Pragma("unroll") for (int q = 0; q < 2; ++q) { a[0][q] = *(const f32x4*)(RWA + 1 * RWA_STRIDE + o_ + 4 * q); a[1][q] = *(const f32x4*)(RWA + 4 * RWA_STRIDE + o_ + 4 * q); a[2][q] = *(const f32x4*)(RWA + 5 * RWA_STRIDE + o_ + 4 * q); \
            a[3][q] = *(const f32x4*)(RWA + 2 * RWA_STRIDE + o_ + 4 * q); a[4][q] = *(const f32x4*)(RWA + 0 * RWA_STRIDE + o_ + 4 * q); a[5][q] = *(const f32x4*)(RWA + 3 * RWA_STRIDE + o_ + 4 * q); } } while (0)
    RW_GLOAD(0);
    for (int sub = 0; sub < TCH / 32; ++sub) {
        __syncthreads();
        { const int lo = st * 64 + sd;
#pragma unroll
          for (int q = 0; q < 2; ++q) { *(LAS f32x4*)(sw + lo + 4 * q) = a[0][q]; *(LAS f32x4*)(sn + lo + 4 * q) = a[1][q]; *(LAS f32x4*)(sb + lo + 4 * q) = a[2][q]; *(LAS f32x4*)(sk + lo + 4 * q) = a[3][q]; *(LAS f32x4*)(sr + lo + 4 * q) = a[4][q]; *(LAS f32x4*)(sv + lo + 4 * q) = a[5][q]; } }
        __syncthreads();
        if (sub + 1 < TCH / 32) RW_GLOAD(sub + 1);
        { f32x4 opA[10], opB[10]; float vin[2], vA[2], vB[2];
          RW_LOAD(opA, 0);
          vA[0] = vin[0]; vA[1] = vin[1];
#pragma unroll 1
          for (int s = 0; s < 32; s += 2) {
              RW_LOAD(opB, s + 1);
              vB[0] = vin[0]; vB[1] = vin[1];
              RW_STEP(opA, vA, s);
              if (s + 2 < 32) { RW_LOAD(opA, s + 2); vA[0] = vin[0]; vA[1] = vin[1]; }
              RW_STEP(opB, vB, s + 1);
          } }
        __syncthreads();
        { const int fs = lt >> 3, c16 = (lt & 7) * 16;
          float* dst = (c16 < 64) ? ((float*)(A.ws + WS_YO) + YO_STRIDE) : ((float*)(A.ws + WS_PT) - 64);
          float* dp = dst + (tok0 + sub * 32 + fs) * 256 + h * 64 + c16;
#pragma unroll
          for (int q = 0; q < 4; ++q) *(f32x4*)(dp + 4 * q) = *(const LAS f32x4*)(so + fs * 128 + c16 + 4 * q); }
    }
    { float* ch = (float*)(A.ws + WS_CH) + ((size_t)(bh * NCH + c) * 128) * 64 + 8 * kq;
#pragma unroll
      for (int i = 0; i < 4; ++i) { float* cr = ch + (size_t)RW_ROW(i) * 64; *(f32x4*)cr = (f32x4){S[i][0].x, S[i][0].y, S[i][1].x, S[i][1].y}; *(f32x4*)(cr + 4) = (f32x4){S[i][2].x, S[i][2].y, S[i][3].x, S[i][3].y}; } }
    __syncthreads();
}
#undef RW_LOAD
#undef RW_STEP
#undef RW_GLOAD
#undef RW_DOT
#undef RW_ROW
__device__ __forceinline__ void scan_ret_task(ARef A, const WI& w, int task) {
    const int bh = task >> 3, cp = task & 7, b = bh >> 2, h = bh & 3, un = w.tid >> 8, lt = w.tid & 255, c = 2 * cp + un;
    const float lg2g = log2f(1.0f - exp2f(-5.0f - (float)h)), gamma = exp2f(lg2g);
    LAS float* sk = (LAS float*)w.lds + un * 8192; LAS float* sq = sk + 2048; LAS float* sv = sq + 2048; LAS float* so = sv + 2048;
    const bf16* PB = (const bf16*)(A.ws + WS_PB); const float* RT = (const float*)(A.ws + WS_ROPE);
    const int row = lt >> 2, kq = lt & 3;
    f32x2 S[8];
#pragma unroll
    for (int j = 0; j < 8; ++j) S[j] = (f32x2){0.0f, 0.0f};
    const f32x2 gam2 = {gamma, gamma};
    const size_t tok0 = (size_t)b * SEQ + (size_t)c * TCH;
    const int st = lt >> 3, sd = (lt & 7) * 8;
    const int fi = sd & 31, dp = sd ^ 32;
    f32x4 gq[2], gqo[2], gk[2], gko[2], gv[2], gcs[2], gsn[2];
#define BF8_TO_F32(dst, x_) do { dst[0] = (f32x4){bf_lo(x_.x), bf_hi(x_.x), bf_lo(x_.y), bf_hi(x_.y)}; dst[1] = (f32x4){bf_lo(x_.z), bf_hi(x_.z), bf_lo(x_.w), bf_hi(x_.w)}; } while (0)
#define RT_GLOAD(sub_) do { const size_t m_ = tok0 + (sub_) * 32 + st; const bf16* pr_ = PB + m_ * PBW + h * 64; const float* rt_ = RT + m_ * ROPE_W; \
        _Pragma("unroll") for (int u = 0; u < 2; ++u) { gcs[u] = *(const f32x4*)(rt_ + fi + 4 * u); gsn[u] = *(const f32x4*)(rt_ + 32 + fi + 4 * u); } \
        { const v4u x0 = *(const v4u*)(pr_ + sd), x1 = *(const v4u*)(pr_ + dp), x2 = *(const v4u*)(pr_ + 256 + sd), x3 = *(const v4u*)(pr_ + 256 + dp), x4 = *(const v4u*)(pr_ + 512 + sd); \
          BF8_TO_F32(gq, x0); BF8_TO_F32(gqo, x1); BF8_TO_F32(gk, x2); BF8_TO_F32(gko, x3); BF8_TO_F32(gv, x4); } } while (0)
    RT_GLOAD(0);
    for (int sub = 0; sub < TCH / 32; ++sub) {
        const size_t m = tok0 + sub * 32 + st;
        f32x4 qn[2], kn[2], vn[2];
#pragma unroll
        for (int u = 0; u < 2; ++u) { qn[u] = (sd < 32) ? gq[u] * gcs[u] - gqo[u] * gsn[u] : gqo[u] * gsn[u] + gq[u] * gcs[u]; kn[u] = (sd < 32) ? gk[u] * gcs[u] - gko[u] * gsn[u] : gko[u] * gsn[u] + gk[u] * gcs[u]; vn[u] = gv[u]; }
        { const float gt = exp2f(lg2g * (float)(sub * 32 + st + 1)); const f32x4 p0 = qn[0] * gt, p1 = qn[1] * gt;
          v4u pw; pw.x = pk2(p0.x, p0.y); pw.y = pk2(p0.z, p0.w); pw.z = pk2(p1.x, p1.y); pw.w = pk2(p1.z, p1.w); *(v4u*)((bf16*)(A.ws + WS_PTR) + m * 256 + h * 64 + sd) = pw; }
        __syncthreads();
        { const int lo = st * 64 + sd; *(LAS f32x4*)(sq + lo) = qn[0]; *(LAS f32x4*)(sq + lo + 4) = qn[1]; *(LAS f32x4*)(sk + lo) = kn[0]; *(LAS f32x4*)(sk + lo + 4) = kn[1]; *(LAS f32x4*)(sv + lo) = vn[0]; *(LAS f32x4*)(sv + lo + 4) = vn[1]; }
        __syncthreads();
        if (sub + 1 < TCH / 32) RT_GLOAD(sub + 1);
        for (int s = 0; s < 32; ++s) {
            const int lo = s * 64 + kq * 16; const float vv = sv[s * 64 + row]; const f32x2 v2 = {vv, vv}; f32x2 y2 = {0.0f, 0.0f};
#pragma unroll
            for (int j4 = 0; j4 < 4; ++j4) { const f32x4 kv = *(const LAS f32x4*)(sk + lo + 4 * j4), rv = *(const LAS f32x4*)(sq + lo + 4 * j4);
                S[2 * j4] = S[2 * j4] * gam2 + v2 * LO2(kv); S[2 * j4 + 1] = S[2 * j4 + 1] * gam2 + v2 * HI2(kv);
                y2 = S[2 * j4] * LO2(rv) + y2; y2 = S[2 * j4 + 1] * HI2(rv) + y2; }
            float y = quad_sum(y2.x + y2.y);
            if (kq == 0) so[s * 64 + row] = y;
        }
        __syncthreads();
        { const int fs = lt >> 3, c8 = (lt & 7) * 8; float* dp2 = (float*)(A.ws + WS_YO) + (tok0 + sub * 32 + fs) * 256 + h * 64 + c8;
          *(f32x4*)dp2 = *(const LAS f32x4*)(so + fs * 64 + c8); *(f32x4*)(dp2 + 4) = *(const LAS f32x4*)(so + fs * 64 + c8 + 4); }
    }
    { float* ch = (float*)(A.ws + WS_CHR) + ((size_t)(bh * NCH + c) * 64 + row) * 64 + 16 * kq;
#pragma unroll
      for (int j4 = 0; j4 < 4; ++j4) *(f32x4*)(ch + 4 * j4) = (f32x4){S[2 * j4].x, S[2 * j4].y, S[2 * j4 + 1].x, S[2 * j4 + 1].y}; }
    __syncthreads();
}
#undef RT_GLOAD
#undef BF8_TO_F32
__device__ __forceinline__ void prefix_chain(ARef A, const WI& w, int bh) {
    LAS float* s0 = (LAS float*)w.lds;
    const int v = w.tid >> 3, k8 = (w.tid & 7) * 8;
    const float* CH = (const float*)(A.ws + WS_CH) + (size_t)bh * NCH * 128 * 64; float* SI = (float*)(A.ws + WS_SI) + (size_t)bh * NCH * 64 * 64;
    f32x4 c0 = {0.f, 0.f, 0.f, 0.f}, c1 = {0.f, 0.f, 0.f, 0.f};
    for (int c = 0; c < NCH; ++c) {
        *(f32x4*)(SI + ((size_t)c * 64 + v) * 64 + k8) = c0; *(f32x4*)(SI + ((size_t)c * 64 + v) * 64 + k8 + 4) = c1;
        if (c == NCH - 1) break;
        __syncthreads();
        *(LAS f32x4*)(s0 + v * 68 + k8) = c0; *(LAS f32x4*)(s0 + v * 68 + k8 + 4) = c1;
        __syncthreads();
        const float* ch = CH + (size_t)c * 128 * 64;
        f32x4 n0 = *(const f32x4*)(ch + (size_t)v * 64 + k8), n1 = *(const f32x4*)(ch + (size_t)v * 64 + k8 + 4);
#pragma unroll 8
        for (int kp = 0; kp < 64; ++kp) { const float s = s0[v * 68 + kp]; const float* pr = ch + (size_t)(64 + kp) * 64 + k8; n0 += s * *(const f32x4*)pr; n1 += s * *(const f32x4*)(pr + 4); }
        c0 = n0; c1 = n1;
    }
    const int h = bh & 3; const float gT = exp2f((float)TCH * log2f(1.0f - exp2f(-5.0f - (float)h)));
    const float* CHR = (const float*)(A.ws + WS_CHR) + (size_t)bh * NCH * 64 * 64; float* SIR = (float*)(A.ws + WS_SIR) + (size_t)bh * NCH * 64 * 64;
    c0 = (f32x4){0.f, 0.f, 0.f, 0.f}; c1 = c0;
    for (int c = 0; c < NCH; ++c) {
        *(f32x4*)(SIR + ((size_t)c * 64 + v) * 64 + k8) = c0; *(f32x4*)(SIR + ((size_t)c * 64 + v) * 64 + k8 + 4) = c1;
        if (c == NCH - 1) break;
        c0 = c0 * gT + *(const f32x4*)(CHR + ((size_t)c * 64 + v) * 64 + k8); c1 = c1 * gT + *(const f32x4*)(CHR + ((size_t)c * 64 + v) * 64 + k8 + 4);
    }
    __syncthreads();
}
typedef float f32x16 __attribute__((ext_vector_type(16)));
constexpr int SBV_PITCH = 144;
__device__ __forceinline__ float lane32_swap(float v) { return __shfl_xor(v, 32); }
__device__ __forceinline__ void sb_tile_mfma(ARef A, int unit, int lane, LAS unsigned char* vl) {
    const int tq = unit & 127, bh = unit >> 7, b = bh >> 2, h = bh & 3, t0 = tq * 32, r32 = lane & 31, hi = lane >> 5;
    const bf16* PS = (const bf16*)(A.ws + WS_PB) + (size_t)b * SEQ * PBW + PB_SB + h * 64;
    bf16x8v qf[4];
#pragma unroll
    for (int ks = 0; ks < 4; ++ks) qf[ks] = *(const bf16x8v*)(PS + (size_t)(t0 + r32) * PBW + 16 * ks + 8 * hi);
    f32x16 o0, o1;
#pragma unroll
    for (int r = 0; r < 16; ++r) { o0[r] = 0.0f; o1[r] = 0.0f; }
    float carry = 0.0f;
    const int g16 = lane >> 4, tj = (lane & 15) >> 2, tc = lane & 3;
    v4u vn[4]; bf16x8v kn[4];
#define SB_FETCH(kb_) do { _Pragma("unroll") for (int i = 0; i < 4; ++i) { const int p = lane + 64 * i, row = p >> 3, ch = p & 7; vn[i] = *(const v4u*)(PS + 512 + (size_t)((kb_) + row) * PBW + 8 * ch); } \
        _Pragma("unroll") for (int ks = 0; ks < 4; ++ks) kn[ks] = *(const bf16x8v*)(PS + 256 + (size_t)((kb_) + r32) * PBW + 16 * ks + 8 * hi); } while (0)
    SB_FETCH(t0);
    for (int kb0 = t0; kb0 >= 0; kb0 -= 32) {
#pragma unroll
        for (int i = 0; i < 4; ++i) { const int p = lane + 64 * i, row = p >> 3, ch = p & 7; *(LAS v4u*)(vl + row * SBV_PITCH + 16 * ch) = vn[i]; }
        f32x16 st;
#pragma unroll
        for (int r = 0; r < 16; ++r) st[r] = 0.0f;
        { bf16x8v ka[4];
#pragma unroll
          for (int ks = 0; ks < 4; ++ks) ka[ks] = kn[ks];
          if (kb0 >= 32) SB_FETCH(kb0 - 32);
#pragma unroll
          for (int ks = 0; ks < 4; ++ks) st = __builtin_amdgcn_mfma_f32_32x32x16_bf16(ka[ks], qf[ks], st, 0, 0, 0);
          asm volatile("" :: "v"(ka[0]), "v"(ka[1]), "v"(ka[2]), "v"(ka[3]), "v"(st)); }
        float sp[16]; const bool diag = (kb0 == t0);
#pragma unroll
        for (int r = 0; r < 16; ++r) { const float zl = st[r]; float s = (zl > 30.0f) ? zl : __builtin_amdgcn_logf(1.0f + __builtin_amdgcn_exp2f(zl));
            if (diag && ((r & 3) + 8 * (r >> 2) + 4 * hi >= r32)) s = 0.0f;
            sp[r] = s; }
        float G[4], Gp[4], suf[4];
#pragma unroll
        for (int q = 0; q < 4; ++q) { G[q] = (sp[4 * q] + sp[4 * q + 1]) + (sp[4 * q + 2] + sp[4 * q + 3]); Gp[q] = lane32_swap(G[q]); }
        suf[3] = 0.0f; suf[2] = G[3] + Gp[3]; suf[1] = suf[2] + (G[2] + Gp[2]); suf[0] = suf[1] + (G[1] + Gp[1]);
        const float tot = suf[0] + (G[0] + Gp[0]);
        pg8::u32x4 pw0, pw1;
        float av[16];
#pragma unroll
        for (int q = 0; q < 4; ++q) { float run = carry + suf[q] + (hi == 0 ? Gp[q] : 0.0f);
#pragma unroll
            for (int i = 3; i >= 0; --i) { const int r = 4 * q + i; const float la = (st[r] - sp[r]) - run; float a = __builtin_amdgcn_exp2f(la);
                if (diag && ((r & 3) + 8 * (r >> 2) + 4 * hi >= r32)) a = 0.0f;
                av[r] = a; run += sp[r]; } }
        pw0.x = pg8::cvt_pk_bf16(av[0], av[1]); pw0.y = pg8::cvt_pk_bf16(av[2], av[3]); pw0.z = pg8::cvt_pk_bf16(av[4], av[5]); pw0.w = pg8::cvt_pk_bf16(av[6], av[7]);
        pw1.x = pg8::cvt_pk_bf16(av[8], av[9]); pw1.y = pg8::cvt_pk_bf16(av[10], av[11]); pw1.z = pg8::cvt_pk_bf16(av[12], av[13]); pw1.w = pg8::cvt_pk_bf16(av[14], av[15]);
        const bf16x8v pa0 = __builtin_bit_cast(bf16x8v, pw0), pa1 = __builtin_bit_cast(bf16x8v, pw1);
        LDS_WAIT();
#pragma unroll
        for (int s = 0; s < 2; ++s)
#pragma unroll
            for (int nb = 0; nb < 2; ++nb) {
                LAS unsigned char* a1 = vl + (16 * s + 4 * (g16 >> 1) + tj) * SBV_PITCH + (32 * nb + 16 * (g16 & 1) + 4 * tc) * 2;
                const s16x4v r1 = __builtin_bit_cast(s16x4v, __builtin_amdgcn_ds_read_tr16_b64_v4i16((LAS s16x4v*)a1));
                const s16x4v r2 = __builtin_bit_cast(s16x4v, __builtin_amdgcn_ds_read_tr16_b64_v4i16((LAS s16x4v*)(a1 + 8 * SBV_PITCH)));
                const bf16x8v bv = {r1[0], r1[1], r1[2], r1[3], r2[0], r2[1], r2[2], r2[3]};
                if (nb == 0) o0 = __builtin_amdgcn_mfma_f32_32x32x16_bf16(s ? pa1 : pa0, bv, o0, 0, 0, 0); else o1 = __builtin_amdgcn_mfma_f32_32x32x16_bf16(s ? pa1 : pa0, bv, o1, 0, 0, 0);
                asm volatile("" :: "v"(bv), "v"(pa0), "v"(pa1), "v"(o0), "v"(o1)); }
        LDS_WAIT();
        carry += tot;
        if (__all(carry > 150.0f)) break;
    }
#undef SB_FETCH
    float* YS = (float*)(A.ws + WS_YO) + 3 * YO_STRIDE + ((size_t)b * SEQ + t0) * 256 + h * 64 + r32;
#pragma unroll
    for (int r = 0; r < 16; ++r) { const int qo = (r & 3) + 8 * (r >> 2) + 4 * hi; YS[(size_t)qo * 256] = o0[r]; YS[(size_t)qo * 256 + 32] = o1[r]; }
}

__device__ __forceinline__ void dsa_scores_mfma(ARef A, const WI& w) {
    const _Float16* QIH = (const _Float16*)(A.ws + WS_DQI); const _Float16* KIH = (const _Float16*)(A.ws + WS_DKI);
    const float* DW = (const float*)(A.ws + WS_DW); float* SC = (float*)(A.ws + WS_SC);
    const int col = w.lane & 15, q4 = w.lane >> 4;
    for (int u = w.gw; u < 2048; u += w.NGW) {
        const int pi = u >> 1, par = u & 1, b = pi >> 7, p = pi & 127;
#pragma unroll 1
        for (int side = 0; side < 2; ++side) {
            const int qb = side ? 255 - p : p; const size_t m0 = (size_t)b * SEQ + 16 * qb;
            f16x8 bq[8];
#pragma unroll
            for (int h = 0; h < 8; ++h) bq[h] = *(const f16x8*)(QIH + (m0 + col) * 256 + h * 32 + 8 * q4);
            const float* dw = DW + (m0 + col) * 8; const f32x4 wa = *(const f32x4*)dw, wb = *(const f32x4*)(dw + 4);
            float* srow = SC + (m0 + col) * SEQ + 4 * q4;
            const _Float16* kbase = KIH + ((size_t)b * SEQ + col) * 32 + 8 * q4;
            for (int kp = par; 2 * kp <= qb; kp += 4) {
                f16x8 ak[4];
#pragma unroll
                for (int q = 0; q < 4; ++q) { const int kb = 2 * (kp + 2 * (q >> 1)) + (q & 1); ak[q] = *(const f16x8*)(kbase + (size_t)(kb <= qb ? kb : qb) * 16 * 32); }
#pragma unroll
                for (int q = 0; q < 4; ++q) { const int kb = 2 * (kp + 2 * (q >> 1)) + (q & 1);
                    if (kb <= qb) {
                        f32x4 acc = {0.f, 0.f, 0.f, 0.f};
#pragma unroll
                        for (int h = 0; h < 8; ++h) { const f32x4 c = __builtin_amdgcn_mfma_f32_16x16x32_f16(ak[q], bq[h], (f32x4){0.f, 0.f, 0.f, 0.f}, 0, 0, 0); const float wv = (h < 4) ? wa[h] : wb[h - 4];
                            acc.x += wv * fmaxf(c.x, 0.f); acc.y += wv * fmaxf(c.y, 0.f); acc.z += wv * fmaxf(c.z, 0.f); acc.w += wv * fmaxf(c.w, 0.f); }
                        *(f32x4*)(srow + 16 * kb) = acc + 0.0f; } }
            }
        }
    }
}

__device__ __forceinline__ int wave_total_i(int v) {
    v += __builtin_amdgcn_mov_dpp(v, 0xB1, 0xF, 0xF, true);
    v += __builtin_amdgcn_mov_dpp(v, 0x4E, 0xF, 0xF, true);
    v += __builtin_amdgcn_mov_dpp(v, 0x141, 0xF, 0xF, true);
    v += __builtin_amdgcn_mov_dpp(v, 0x140, 0xF, 0xF, true);
    return __builtin_amdgcn_readlane(v, 0) + __builtin_amdgcn_readlane(v, 16) + __builtin_amdgcn_readlane(v, 32) + __builtin_amdgcn_readlane(v, 48);
}
__device__ __forceinline__ unsigned score_key(float f) { const unsigned bits = __float_as_uint(f); return (bits & 0x80000000u) ? ~bits : (bits | 0x80000000u); }
constexpr int VST_PITCH = 144;
typedef unsigned short u16;
__device__ __forceinline__ void dsa_load_scores(ARef A, int m, int lane, f32x4 (&sv)[16]) {
    const int n = (m & (SEQ - 1)) + 1; const float* sc = (const float*)(A.ws + WS_SC) + (size_t)m * SEQ;
#pragma unroll
    for (int j4 = 0; j4 < 16; ++j4) sv[j4] = *(const f32x4*)(sc + ((256 * j4 < n) ? 256 * j4 : 0) + 4 * lane);
}
__device__ __forceinline__ void dsa_select(ARef A, int m, int n, int lane_in, LAS u16* slist, LAS unsigned* bk) {
    int lane = lane_in; asm volatile("" : "+v"(lane));
    if (n <= 256) {
#pragma unroll
        for (int c = 0; c < 4; ++c) { const int idx = lane + 64 * c; slist[idx] = (u16)((idx < n) ? idx : 0); }
        return;
    }
    f32x4 sv[16]; dsa_load_scores(A, m, lane, sv);
    unsigned u[64];
#pragma unroll
    for (int j4 = 0; j4 < 16; ++j4)
#pragma unroll
        for (int i = 0; i < 4; ++i) u[4 * j4 + i] = (256 * j4 + 4 * lane + i < n) ? score_key(sv[j4][i]) : 0u;
    unsigned T = 0u;
    for (int bit = 31; bit >= 16; --bit) { const unsigned cand = T | (1u << bit); int cnt = 0;
#pragma unroll
        for (int j = 0; j < 64; ++j) cnt += (u[j] >= cand) ? 1 : 0;
        if (wave_total_i(cnt) >= 256) T = cand; }
    unsigned long long bkb = 0ull; int chi = 0;
#pragma unroll
    for (int j = 0; j < 64; ++j) { bkb |= (unsigned long long)(((u[j] >> 16) == (T >> 16)) ? 1u : 0u) << j; chi += ((u[j] >> 16) > (T >> 16)) ? 1 : 0; }
    const int cb = wave_total_i(__popcll(bkb)), need = 256 - wave_total_i(chi);
    if (cb <= 64) {
        int pos = __popcll(bkb);
        { const int mine_ = pos;
#pragma unroll
          for (int d = 1; d < 64; d <<= 1) { const int y = __shfl_up(pos, d); if (lane >= d) pos += y; }
          pos -= mine_; }
#pragma unroll
        for (int j = 0; j < 64; ++j) { if ((bkb >> j) & 1ull) { bk[pos] = u[j]; ++pos; } }
        LDS_WAIT();
        const unsigned kx = (lane < cb) ? bk[lane] : 0u;
        for (int bit = 15; bit >= 0; --bit) { const unsigned cand = T | (1u << bit); if (__popcll(__ballot(kx >= cand)) >= need) T = cand; }
        LDS_WAIT();
    } else {
        for (int bit = 15; bit >= 0; --bit) { const unsigned cand = T | (1u << bit); int cnt = 0;
#pragma unroll
            for (int j = 0; j < 64; ++j) cnt += (u[j] >= cand) ? 1 : 0;
            if (wave_total_i(cnt) >= 256) T = cand; }
    }
    unsigned long long gtb = 0ull, eqb = 0ull;
#pragma unroll
    for (int j = 0; j < 64; ++j) { gtb |= (unsigned long long)((u[j] > T) ? 1u : 0u) << j; eqb |= (unsigned long long)((u[j] == T) ? 1u : 0u) << j; }
    const int tgt = wave_total_i(__popcll(gtb)), teq = wave_total_i(__popcll(eqb));
    unsigned long long selb = gtb | eqb;
    if (tgt + teq > 256) {
        const int take = 256 - tgt; int lo = 0;
        for (int bit = 11; bit >= 0; --bit) { const int cand = lo | (1 << bit); const int J4 = cand >> 8; int ni = (cand & 255) - 4 * lane; ni = ni < 0 ? 0 : (ni > 4 ? 4 : ni);
            const int jc = 4 * J4 + ni; const unsigned long long msk = (jc >= 64) ? ~0ull : ((1ull << jc) - 1ull);
            if (wave_total_i(__popcll(eqb & msk)) < take) lo = cand; }
        { const int cand = lo + 1; const int J4 = cand >> 8; int ni = (cand & 255) - 4 * lane; ni = ni < 0 ? 0 : (ni > 4 ? 4 : ni);
          const int jc = (cand >= SEQ) ? 64 : 4 * J4 + ni; const unsigned long long msk = (jc >= 64) ? ~0ull : ((1ull << jc) - 1ull); selb = gtb | (eqb & msk); }
    }
    const int mine = __popcll(selb); int off = mine;
#pragma unroll
    for (int d = 1; d < 64; d <<= 1) { const int y = __shfl_up(off, d); if (lane >= d) off += y; }
    off -= mine;
    while (selb) { const int j = __builtin_ctzll(selb); selb &= selb - 1ull; slist[off] = (u16)(256 * (j >> 2) + 4 * lane + (j & 3)); ++off; }
}
__device__ __forceinline__ void dsa_attend(ARef A, int m, int lane_in, const LAS u16* slist, LAS unsigned char* vbuf) {
    int lane = lane_in; asm volatile("" : "+v"(lane));
    const int b = m >> 12, t = m & (SEQ - 1), n = t + 1, nsel = n < 256 ? n : 256, col = lane & 15, q4 = lane >> 4;
    const bf16* DKB = (const bf16*)(A.ws + WS_DKB) + (size_t)b * SEQ * 64; const bf16* DVB = (const bf16*)(A.ws + WS_DVB) + (size_t)b * SEQ * 64;
    const int vrow = lane >> 3, vpc = lane & 7;
    bf16x8v bq0 = {0, 0, 0, 0, 0, 0, 0, 0}, bq1 = {0, 0, 0, 0, 0, 0, 0, 0};
    if (col < 4) { const bf16* qp = (const bf16*)(A.ws + WS_DQ) + (size_t)m * 256 + col * 64 + 8 * q4; bq0 = *(const bf16x8v*)qp; bq1 = *(const bf16x8v*)(qp + 32); }
    f32x4 lg[16];
#pragma unroll
    for (int hb = 0; hb < 2; ++hb) {
        bf16x8v a0[8], a1[8];
#pragma unroll
        for (int k = 0; k < 8; ++k) { const int s = slist[16 * (8 * hb + k) + col]; const bf16* kr = DKB + (size_t)s * 64 + 8 * q4; a0[k] = *(const bf16x8v*)kr; a1[k] = *(const bf16x8v*)(kr + 32); }
#pragma unroll
        for (int k = 0; k < 8; ++k) { const f32x4 c = __builtin_amdgcn_mfma_f32_16x16x32_bf16(a0[k], bq0, (f32x4){0.f, 0.f, 0.f, 0.f}, 0, 0, 0); lg[8 * hb + k] = __builtin_amdgcn_mfma_f32_16x16x32_bf16(a1[k], bq1, c, 0, 0, 0); }
        __builtin_amdgcn_sched_barrier(0);
    }
    if (nsel < 256) {
#pragma unroll
        for (int kb = 0; kb < 16; ++kb)
#pragma unroll
            for (int r = 0; r < 4; ++r) if (16 * kb + 4 * q4 + r >= nsel) lg[kb][r] = -INFINITY; }
    v4u vr[4];
#pragma unroll
    for (int i = 0; i < 4; ++i) { const int s = slist[vrow + 8 * i]; vr[i] = *(const v4u*)(DVB + (size_t)s * 64 + 8 * vpc); }
    float mx = -INFINITY;
#pragma unroll
    for (int kb = 0; kb < 16; ++kb) mx = fmaxf(fmaxf(mx, fmaxf(lg[kb].x, lg[kb].y)), fmaxf(lg[kb].z, lg[kb].w));
    mx = fmaxf(mx, __shfl_xor(mx, 16)); mx = fmaxf(mx, __shfl_xor(mx, 32));
    float sm = 0.f;
#pragma unroll
    for (int kb = 0; kb < 16; ++kb) { lg[kb].x = __builtin_amdgcn_exp2f(lg[kb].x - mx); lg[kb].y = __builtin_amdgcn_exp2f(lg[kb].y - mx); lg[kb].z = __builtin_amdgcn_exp2f(lg[kb].z - mx); lg[kb].w = __builtin_amdgcn_exp2f(lg[kb].w - mx); sm += (lg[kb].x + lg[kb].y) + (lg[kb].z + lg[kb].w); }
    sm += __shfl_xor(sm, 16); sm += __shfl_xor(sm, 32);
    const float inv = 1.0f / sm;
    bf16x8v pa[8];
#pragma unroll
    for (int i = 0; i < 8; ++i) { const f32x4 x = lg[2 * i] * inv, y = lg[2 * i + 1] * inv;
        pg8::u32x4 wv; wv.x = pg8::cvt_pk_bf16(x.x, x.y); wv.y = pg8::cvt_pk_bf16(x.z, x.w); wv.z = pg8::cvt_pk_bf16(y.x, y.y); wv.w = pg8::cvt_pk_bf16(y.z, y.w);
        pa[i] = __builtin_bit_cast(bf16x8v, wv); }
    f32x4 o[4];
#pragma unroll
    for (int nb = 0; nb < 4; ++nb) o[nb] = (f32x4){0.f, 0.f, 0.f, 0.f};
    const int tj = col >> 2, tc = col & 3;
#pragma unroll
    for (int c = 0; c < 8; ++c) {
        LAS unsigned char* vb = vbuf + (c & 1) * (32 * VST_PITCH);
#pragma unroll
        for (int i = 0; i < 4; ++i) *(LAS v4u*)(vb + (vrow + 8 * i) * VST_PITCH + 16 * vpc) = vr[i];
        if (c < 7) {
#pragma unroll
            for (int i = 0; i < 4; ++i) { const int s = slist[32 * (c + 1) + vrow + 8 * i]; vr[i] = *(const v4u*)(DVB + (size_t)s * 64 + 8 * vpc); } }
        LDS_WAIT();
#pragma unroll
        for (int nb = 0; nb < 4; ++nb) {
            LAS unsigned char* a1 = vb + (4 * q4 + tj) * VST_PITCH + (16 * nb + 4 * tc) * 2;
            const s16x4v r1 = __builtin_bit_cast(s16x4v, __builtin_amdgcn_ds_read_tr16_b64_v4i16((LAS s16x4v*)a1));
            const s16x4v r2 = __builtin_bit_cast(s16x4v, __builtin_amdgcn_ds_read_tr16_b64_v4i16((LAS s16x4v*)(a1 + 16 * VST_PITCH)));
            const bf16x8v bv = {r1[0], r1[1], r1[2], r1[3], r2[0], r2[1], r2[2], r2[3]};
            o[nb] = __builtin_amdgcn_mfma_f32_16x16x32_bf16(pa[c], bv, o[nb], 0, 0, 0); }
    }
    LDS_WAIT();
    if (lane < 16) { float* YD = (float*)(A.ws + WS_YO) + 2 * YO_STRIDE + (size_t)m * 256;
#pragma unroll
        for (int nb = 0; nb < 4; ++nb) { YD[16 * nb + lane] = o[nb].x; YD[64 + 16 * nb + lane] = o[nb].y; YD[128 + 16 * nb + lane] = o[nb].z; YD[192 + 16 * nb + lane] = o[nb].w; } }
}
constexpr int DSA_GR = 1;
__device__ __forceinline__ int dsa_row_of(int batch, int gi, int r) { const int idx = DSA_GR * gi + r, h = idx >> 1; return batch * SEQ + ((idx & 1) ? (SEQ - 1 - h) : h); }
__device__ __forceinline__ void dsa_wave(ARef A, const WI& w, LAS unsigned char* wl, int qi, int l) {
    LAS u16* lists = (LAS u16*)wl; LAS unsigned char* vbuf = wl + 4096; LAS unsigned* bk = (LAS unsigned*)vbuf;
#pragma unroll 1
    for (int kb = 0; kb < NB; ++kb) {
        const int batch = (w.bx + kb) & (NB - 1);
        unsigned* head = (unsigned*)(A.ws + WS_CTL) + CW_DSAQ + 128 * qi + 16 * batch;
        for (;;) {
            int g = 0; if (w.lane == 0) g = (int)atomicAdd(head, 1u);
            g = __builtin_amdgcn_readfirstlane(g);
            if (g >= 11 * (SEQ / 8)) break;
            const int per = g / 11, pos = g - 11 * per;
            if (pos >= 8) { moe_convert_chunk(A, l, batch * 1536 + 3 * per + (pos - 8), w.lane, (LAS float*)vbuf); continue; }
            const int gi = 8 * per + pos;
            { const int m = dsa_row_of(batch, gi, 0), n = (m & (SEQ - 1)) + 1; dsa_select(A, m, n, w.lane, lists, bk); }
            LDS_WAIT();
            dsa_attend(A, dsa_row_of(batch, gi, 0), w.lane, lists, vbuf);
        }
    }
}

__device__ __forceinline__ f32x4 head_norm4(f32x4 y, float eps, f32x4 g) {
    const float mean = grp16_sum(sum4(y)) * (1.0f / 64.0f); const f32x4 yc = y - mean;
    const float var = grp16_sum(dot4(yc, yc)) * (1.0f / 64.0f); return yc * (1.0f / sqrtf(var + eps)) * g;
}
template <bool BF> __device__ __forceinline__ f32x4 state_corr(const LAS float* sl, int hh, int r16, const void* pv) {
    const LAS float* r0 = sl + (hh * 64 + 4 * r16) * 64; const int x0 = (4 * r16) & 15;
    f32x4 out = {0.f, 0.f, 0.f, 0.f};
#pragma unroll 2
    for (int k8 = 0; k8 < 8; ++k8) {
        f32x4 pa, pb;
        if (BF) { const v4u x = ((const v4u*)pv)[k8]; pa = (f32x4){bf_lo(x.x), bf_hi(x.x), bf_lo(x.y), bf_hi(x.y)}; pb = (f32x4){bf_lo(x.z), bf_hi(x.z), bf_lo(x.w), bf_hi(x.w)}; }
        else { pa = ((const f32x4*)pv)[2 * k8]; pb = ((const f32x4*)pv)[2 * k8 + 1]; }
#pragma unroll
        for (int i = 0; i < 4; ++i) { const LAS float* rowp = r0 + i * 64; const int xs = (x0 + i) & 15;
            out[i] += dot4(*(const LAS f32x4*)(rowp + 4 * ((2 * k8) ^ xs)), pa) + dot4(*(const LAS f32x4*)(rowp + 4 * ((2 * k8 + 1) ^ xs)), pb); }
    }
    return out;
}
__device__ __forceinline__ void post_row(ARef A, int l, int m, int lane, const LAS float* slw, const LAS float* slr) {
    const float* YO = (const float*)(A.ws + WS_YO); const float* RWA = (const float*)(A.ws + WS_RWA);
    bf16* MX = (bf16*)(A.ws + WS_MIX) + (size_t)m * DM; const int c4 = 4 * lane, hh = lane >> 4, r16 = lane & 15; const size_t o = (size_t)m * 256 + c4;
    { f32x4 y = *(const f32x4*)(YO + o) + state_corr<true>(slr, hh, r16, (const bf16*)(A.ws + WS_PTR) + (size_t)m * 256 + hh * 64);
      y = head_norm4(y, 1e-5f, *(const f32x4*)(A.in[I_RETGN] + l * 256 + c4));
      const v2u gw_ = *(const v2u*)((const bf16*)(A.ws + WS_PB) + (size_t)m * PBW + 768 + c4); const f32x4 g = {bf_lo(gw_.x), bf_hi(gw_.x), bf_lo(gw_.y), bf_hi(gw_.y)};
#pragma unroll
      for (int i = 0; i < 4; ++i) y[i] *= g[i] * sigm(g[i]);
      v2u w; w.x = pk2(y.x, y.y); w.y = pk2(y.z, y.w); *(v2u*)(MX + c4) = w; }
    { f32x4 y = *(const f32x4*)(YO + YO_STRIDE + o) + state_corr<false>(slw, hh, r16, (const float*)(A.ws + WS_PT) + (size_t)m * 256 + hh * 64);
      y = head_norm4(y, 64e-5f, *(const f32x4*)(A.in[I_LN] + l * 256 + c4));
      y = (y + *(const f32x4*)(RWA + 7 * RWA_STRIDE + o)) * *(const f32x4*)(RWA + 6 * RWA_STRIDE + o);
      v2u w; w.x = pk2(y.x, y.y); w.y = pk2(y.z, y.w); *(v2u*)(MX + 256 + c4) = w; }
    { f32x4 y = *(const f32x4*)(YO + 2 * YO_STRIDE + o); const float r = 1.0f / sqrtf(wave_sum(dot4(y, y)) * (1.0f / 256.0f) + 1e-5f);
      y = y * r * *(const f32x4*)(A.in[I_DONORM] + l * 256 + c4);
      v2u w; w.x = pk2(y.x, y.y); w.y = pk2(y.z, y.w); *(v2u*)(MX + 512 + c4) = w; }
    { f32x4 y = *(const f32x4*)(YO + 3 * YO_STRIDE + o); const float r = 1.0f / sqrtf(wave_sum(dot4(y, y)) * (1.0f / 256.0f) + 1e-5f);
      y = y * r * *(const f32x4*)(A.in[I_SONORM] + l * 256 + c4);
      v2u w; w.x = pk2(y.x, y.y); w.y = pk2(y.z, y.w); *(v2u*)(MX + 768 + c4) = w; }
}
__device__ __forceinline__ void ph_post(ARef A, const WI& w, int l) {
    LAS float* slw = (LAS float*)w.lds; LAS float* slr = slw + 16384;
    for (int u = w.vcu; u < NB * NCH * 2; u += w.G) {
        const int b = u >> 5, c = (u >> 1) & 15, half = u & 1;
        __syncthreads();
        for (int e = w.tid; e < 4096; e += NWAVES * 64) { const int hh = e >> 10, v = (e >> 4) & 63, k4 = e & 15;
            const size_t src = ((size_t)((b * 4 + hh) * NCH + c) * 64 + v) * 64 + 4 * k4; const int dst = (hh * 64 + v) * 64 + 4 * (k4 ^ (v & 15));
            *(LAS f32x4*)(slw + dst) = *(const f32x4*)((const float*)(A.ws + WS_SI) + src); *(LAS f32x4*)(slr + dst) = *(const f32x4*)((const float*)(A.ws + WS_SIR) + src); }
        __syncthreads();
        const int tok0 = b * SEQ + c * TCH + half * 128 + w.wave * 16;
        for (int i = 0; i < 16; ++i) post_row(A, l, tok0 + i, w.lane, slw, slr);
    }
}

constexpr int S0_PITCH = 144;
template <int MIXER> __device__ __forceinline__ void post16_head(ARef A, int l, size_t m, int hh, int tk, int fq, const LAS unsigned char* s0) {
    const size_t o = m * 256 + hh * 64 + 8 * fq;
    bf16x8v pb[2];
    if (MIXER == 0) { const bf16* pp = (const bf16*)(A.ws + WS_PTR) + o; pb[0] = *(const bf16x8v*)pp; pb[1] = *(const bf16x8v*)(pp + 32); }
    else { const float* pp = (const float*)(A.ws + WS_PT) + o;
#pragma unroll
        for (int ks = 0; ks < 2; ++ks) { const f32x4 a = *(const f32x4*)(pp + 32 * ks), b = *(const f32x4*)(pp + 32 * ks + 4);
            pg8::u32x4 wv; wv.x = pg8::cvt_pk_bf16(a.x, a.y); wv.y = pg8::cvt_pk_bf16(a.z, a.w); wv.z = pg8::cvt_pk_bf16(b.x, b.y); wv.w = pg8::cvt_pk_bf16(b.z, b.w); pb[ks] = __builtin_bit_cast(bf16x8v, wv); } }
    f32x4 y[4];
    const float* yl = (const float*)(A.ws + WS_YO) + MIXER * YO_STRIDE + o;
#pragma unroll
    for (int mb = 0; mb < 4; ++mb) y[mb] = *(const f32x4*)(yl + 32 * (mb >> 1) + 4 * (mb & 1));
    const float* gw = ((MIXER == 0) ? A.in[I_RETGN] : A.in[I_LN]) + l * 256 + hh * 64 + 8 * fq;
    f32x4 gn[4], e0[4], e1[4];
#pragma unroll
    for (int mb = 0; mb < 4; ++mb) gn[mb] = *(const f32x4*)(gw + 32 * (mb >> 1) + 4 * (mb & 1));
    if (MIXER == 0) {
#pragma unroll
        for (int j = 0; j < 2; ++j) { const v4u gx = *(const v4u*)((const bf16*)(A.ws + WS_PB) + m * PBW + 768 + hh * 64 + 8 * fq + 32 * j);
            e0[2 * j] = (f32x4){bf_lo(gx.x), bf_hi(gx.x), bf_lo(gx.y), bf_hi(gx.y)}; e0[2 * j + 1] = (f32x4){bf_lo(gx.z), bf_hi(gx.z), bf_lo(gx.w), bf_hi(gx.w)}; }
    } else { const float* RWA = (const float*)(A.ws + WS_RWA);
#pragma unroll
        for (int mb = 0; mb < 4; ++mb) { e0[mb] = *(const f32x4*)(RWA + 7 * RWA_STRIDE + o + 32 * (mb >> 1) + 4 * (mb & 1)); e1[mb] = *(const f32x4*)(RWA + 6 * RWA_STRIDE + o + 32 * (mb >> 1) + 4 * (mb & 1)); } }
    const LAS unsigned char* ab = s0 + ((MIXER * 4 + hh) * 64 + 8 * (tk >> 2) + (tk & 3)) * S0_PITCH + 16 * fq;
#pragma unroll
    for (int mb = 0; mb < 4; ++mb)
#pragma unroll
        for (int ks = 0; ks < 2; ++ks) { const bf16x8v af = *(const LAS bf16x8v*)(ab + (32 * (mb >> 1) + 4 * (mb & 1)) * S0_PITCH + 64 * ks); y[mb] = __builtin_amdgcn_mfma_f32_16x16x32_bf16(af, pb[ks], y[mb], 0, 0, 0); }
    float s = (sum4(y[0]) + sum4(y[1])) + (sum4(y[2]) + sum4(y[3])); s += __shfl_xor(s, 16); s += __shfl_xor(s, 32);
    const float mean = s * (1.0f / 64.0f);
#pragma unroll
    for (int mb = 0; mb < 4; ++mb) y[mb] = y[mb] - mean;
    float q = (dot4(y[0], y[0]) + dot4(y[1], y[1])) + (dot4(y[2], y[2]) + dot4(y[3], y[3])); q += __shfl_xor(q, 16); q += __shfl_xor(q, 32);
    const float rs = 1.0f / sqrtf(q * (1.0f / 64.0f) + ((MIXER == 0) ? 1e-5f : 64e-5f));
    bf16* MX = (bf16*)(A.ws + WS_MIX) + m * DM + MIXER * 256 + hh * 64 + 8 * fq;
#pragma unroll
    for (int j = 0; j < 2; ++j) { f32x4 ya = y[2 * j] * rs * gn[2 * j], yb = y[2 * j + 1] * rs * gn[2 * j + 1];
        if (MIXER == 0) {
#pragma unroll
            for (int i = 0; i < 4; ++i) { ya[i] *= e0[2 * j][i] * sigm(e0[2 * j][i]); yb[i] *= e0[2 * j + 1][i] * sigm(e0[2 * j + 1][i]); }
        } else { ya = (ya + e0[2 * j]) * e1[2 * j]; yb = (yb + e0[2 * j + 1]) * e1[2 * j + 1]; }
        v4u wv; wv.x = pk2(ya.x, ya.y); wv.y = pk2(ya.z, ya.w); wv.z = pk2(yb.x, yb.y); wv.w = pk2(yb.z, yb.w); *(v4u*)(MX + 32 * j) = wv; }
}
__device__ __forceinline__ void post16_rms(ARef A, int l, size_t m, int mx, int fq) {
    const float* yp = (const float*)(A.ws + WS_YO) + (size_t)mx * YO_STRIDE + m * 256 + 8 * fq; const float* gw = ((mx == 2) ? A.in[I_DONORM] : A.in[I_SONORM]) + l * 256 + 8 * fq;
    f32x4 y[16];
#pragma unroll
    for (int j = 0; j < 8; ++j) { y[2 * j] = *(const f32x4*)(yp + 32 * j); y[2 * j + 1] = *(const f32x4*)(yp + 32 * j + 4); }
    float q = 0.0f;
#pragma unroll
    for (int j = 0; j < 16; ++j) q += dot4(y[j], y[j]);
    q += __shfl_xor(q, 16); q += __shfl_xor(q, 32);
    const float r = 1.0f / sqrtf(q * (1.0f / 256.0f) + 1e-5f);
    bf16* MX = (bf16*)(A.ws + WS_MIX) + m * DM + mx * 256 + 8 * fq;
#pragma unroll
    for (int j = 0; j < 8; ++j) { const f32x4 ya = y[2 * j] * r * *(const f32x4*)(gw + 32 * j), yb = y[2 * j + 1] * r * *(const f32x4*)(gw + 32 * j + 4);
        v4u wv; wv.x = pk2(ya.x, ya.y); wv.y = pk2(ya.z, ya.w); wv.z = pk2(yb.x, yb.y); wv.w = pk2(yb.z, yb.w); *(v4u*)(MX + 32 * j) = wv; }
}
__device__ __forceinline__ void ph_post16(ARef A, const WI& w, int l) {
    LAS unsigned char* s0 = w.lds;
    for (int u = w.vcu; u < NB * NCH * 2; u += w.G) {
        const int b = u >> 5, c = (u >> 1) & 15, half = u & 1;
        __syncthreads();
#pragma unroll 2
        for (int e = w.tid; e < 4096; e += NWAVES * 64) { const int hd = e >> 9, v = (e >> 3) & 63, k8 = e & 7;
            const float* src = (const float*)(A.ws + ((hd < 4) ? WS_SIR : WS_SI)) + ((size_t)((b * 4 + (hd & 3)) * NCH + c) * 64 + v) * 64 + 8 * k8;
            const f32x4 x0 = *(const f32x4*)src, x1 = *(const f32x4*)(src + 4);
            v4u wv; wv.x = pk2(x0.x, x0.y); wv.y = pk2(x0.z, x0.w); wv.z = pk2(x1.x, x1.y); wv.w = pk2(x1.z, x1.w); *(LAS v4u*)(s0 + (hd * 64 + v) * S0_PITCH + 16 * k8) = wv; }
        __syncthreads();
        int lane = w.lane; asm volatile("" : "+v"(lane));
        const int tk = lane & 15, fq = lane >> 4; const size_t m = (size_t)(b * SEQ + c * TCH + half * 128 + w.wave * 16 + tk);
#pragma unroll 1
        for (int hh = 0; hh < 4; ++hh) post16_head<0>(A, l, m, hh, tk, fq, s0);
#pragma unroll 1
        for (int hh = 0; hh < 4; ++hh) post16_head<1>(A, l, m, hh, tk, fq, s0);
#pragma unroll 1
        for (int mx = 2; mx < 4; ++mx) post16_rms(A, l, m, mx, fq);
    }
}

__device__ __forceinline__ float wave_max_f(float v) {
    v = fmaxf(v, __builtin_bit_cast(float, __builtin_amdgcn_mov_dpp(__builtin_bit_cast(int, v), 0xB1, 0xF, 0xF, true)));
    v = fmaxf(v, __builtin_bit_cast(float, __builtin_amdgcn_mov_dpp(__builtin_bit_cast(int, v), 0x4E, 0xF, 0xF, true)));
    v = fmaxf(v, __builtin_bit_cast(float, __builtin_amdgcn_mov_dpp(__builtin_bit_cast(int, v), 0x141, 0xF, 0xF, true)));
    v = fmaxf(v, __builtin_bit_cast(float, __builtin_amdgcn_mov_dpp(__builtin_bit_cast(int, v), 0x140, 0xF, 0xF, true)));
    const int iv = __builtin_bit_cast(int, v);
    return fmaxf(fmaxf(__builtin_bit_cast(float, __builtin_amdgcn_readlane(iv, 0)), __builtin_bit_cast(float, __builtin_amdgcn_readlane(iv, 16))), fmaxf(__builtin_bit_cast(float, __builtin_amdgcn_readlane(iv, 32)), __builtin_bit_cast(float, __builtin_amdgcn_readlane(iv, 48))));
}
__device__ __forceinline__ void router_stage(ARef A, const WI& w, int l) {
    LAS float* rwl = (LAS float*)w.lds; const float* rw = A.in[I_RW] + (size_t)l * DM * 32;
    for (int e = w.tid; e < DM * 8; e += NWAVES * 64) { const int k = e >> 3, c = e & 7; *(LAS f32x4*)(rwl + k * 32 + 4 * (c ^ ((k >> 2) & 7))) = *(const f32x4*)(rw + (size_t)k * 32 + 4 * c); }
    __syncthreads();
}
__device__ __forceinline__ void router_row(ARef A, int l, int m, int lane, LAS unsigned* hist, const LAS float* rwl, LAS int* texp, bool dry = false) {
    const float* XA = (const float*)(A.ws + WS_XA) + (size_t)m * DM; const float* MOD = (const float*)(A.ws + WS_MOD) + (size_t)(l * 8 + (m >> 12)) * 6144;
    f32x4 v[4]; float ss = 0.0f;
#pragma unroll
    for (int j = 0; j < 4; ++j) { v[j] = *(const f32x4*)(XA + 4 * (lane + 64 * j)); ss += dot4(v[j], v[j]); }
    ss = wave_sum(ss); const float rstd = 1.0f / sqrtf(ss * (1.0f / DM) + 1e-5f);
    const float* g = A.in[I_NFFN] + l * DM; const float* scp = MOD + 4 * 1024; const float* shp = MOD + 3 * 1024;
    emit_h_row(v, rstd, g, scp, shp, (bf16*)(A.ws + WS_H) + (size_t)m * DM, lane);
    float p[32];
#pragma unroll
    for (int e = 0; e < 32; ++e) p[e] = 0.0f;
    const int sw = lane & 7;
#pragma unroll 1
    for (int j = 0; j < 4; ++j) { const int k = 4 * (lane + 64 * j);
        const f32x4 h = *(const f32x4*)(XA + k) * rstd * *(const f32x4*)(g + k) * (1.0f + *(const f32x4*)(scp + k)) + *(const f32x4*)(shp + k);
        const LAS float* row = rwl + k * 32;
#pragma unroll
        for (int i = 0; i < 4; ++i) {
#pragma unroll
            for (int q4 = 0; q4 < 8; ++q4) { const f32x4 r = *(const LAS f32x4*)(row + i * 32 + 4 * (q4 ^ sw)); p[4 * q4] += h[i] * r.x; p[4 * q4 + 1] += h[i] * r.y; p[4 * q4 + 2] += h[i] * r.z; p[4 * q4 + 3] += h[i] * r.w; } } }
    float q16[16], q8[8], q4v[4], q2[2], q1;
    { const bool hb = (lane & 32) != 0;
#pragma unroll
      for (int i = 0; i < 16; ++i) { const float mine = hb ? p[16 + i] : p[i], oth = hb ? p[i] : p[16 + i]; q16[i] = mine + __shfl_xor(oth, 32); } }
    { const bool hb = (lane & 16) != 0;
#pragma unroll
      for (int i = 0; i < 8; ++i) { const float mine = hb ? q16[8 + i] : q16[i], oth = hb ? q16[i] : q16[8 + i]; q8[i] = mine + __shfl_xor(oth, 16); } }
    { const bool hb = (lane & 8) != 0;
#pragma unroll
      for (int i = 0; i < 4; ++i) { const float mine = hb ? q8[4 + i] : q8[i], oth = hb ? q8[i] : q8[4 + i]; q4v[i] = mine + __shfl_xor(oth, 8); } }
    { const bool hb = (lane & 4) != 0;
#pragma unroll
      for (int i = 0; i < 2; ++i) { const float mine = hb ? q4v[2 + i] : q4v[i], oth = hb ? q4v[i] : q4v[2 + i]; q2[i] = mine + __shfl_xor(oth, 4); } }
    { const bool hb = (lane & 2) != 0; const float mine = hb ? q2[1] : q2[0], oth = hb ? q2[0] : q2[1]; q1 = mine + __shfl_xor(oth, 2); }
    q1 += __shfl_xor(q1, 1);
    float lv = q1 + A.in[I_RB][l * 32 + (lane >> 1)];
    float tv[4]; int ti[4];
#pragma unroll
    for (int kk = 0; kk < 4; ++kk) { const float mx = wave_max_f(lv); const unsigned long long msk = __ballot(lv == mx); const int e = msk ? (int)(__builtin_ctzll(msk) >> 1) : kk;
        tv[kk] = mx; ti[kk] = e; if ((lane >> 1) == e) lv = -INFINITY; }
    const float e1 = expf(tv[1] - tv[0]), e2 = expf(tv[2] - tv[0]), e3 = expf(tv[3] - tv[0]); const float inv = 1.0f / (1.0f + e1 + e2 + e3);
    if (lane == 0 && !dry) {
        int* TI = (int*)(A.ws + WS_TOPI) + (size_t)m * 4; float* TW = (float*)(A.ws + WS_TOPW) + (size_t)m * 4;
        TI[0] = ti[0]; TI[1] = ti[1]; TI[2] = ti[2]; TI[3] = ti[3]; texp[0] = ti[0]; texp[1] = ti[1]; texp[2] = ti[2]; texp[3] = ti[3]; TW[0] = inv; TW[1] = e1 * inv; TW[2] = e2 * inv; TW[3] = e3 * inv;
        { unsigned* hg = (unsigned*)hist; atomicAdd(hg + ti[0], 1u); atomicAdd(hg + ti[1], 1u); atomicAdd(hg + ti[2], 1u); atomicAdd(hg + ti[3], 1u); }
    }
}
__device__ __forceinline__ void build_expert_table(ARef A, const WI& w, int l) {
    LAS int* tst = (LAS int*)(w.lds + TST_OFF); LAS int* tab = (LAS int*)(w.lds + TAB_OFF); LAS int* cnt = (LAS int*)(w.lds + CNT_OFF);
    if (w.tid == 0) { const unsigned* gc = (const unsigned*)(A.ws + WS_CTL) + CW_GCNT + 64 * l; int acc = 0;
        for (int e = 0; e < 32; ++e) { const int c = (int)__hip_atomic_load(gc + e, RLX_AGENT); cnt[e] = c; tst[e] = acc; acc += (c + 255) >> 8; }
        tst[32] = acc; tab[0] = acc; }
    __syncthreads();
    if (w.tid < 32) { const int e = w.tid; for (int pm = tst[e]; pm < tst[e + 1]; ++pm) tab[1 + pm] = e; }
    __syncthreads();
}
__device__ __forceinline__ void router_lists(ARef A, const WI& w, int l) {
    LAS unsigned* hist = (LAS unsigned*)(w.lds + HIST_OFF); LAS int* base = (LAS int*)(w.lds + BASE_OFF); LAS int* texp = (LAS int*)(w.lds + TEXP_OFF);
    __syncthreads();
    if (w.tid < 32) { base[w.tid] = (int)atomicAdd((unsigned*)(A.ws + WS_CTL) + CW_GCNT + 64 * l + w.tid, hist[w.tid]); hist[w.tid] = 0u; }
    __syncthreads();
    int* LIST = (int*)(A.ws + WS_LIST); int* PW = (int*)(A.ws + WS_POS);
    int j = 0;
    for (int m = w.gw; m < MTOK; m += w.NGW, ++j) {
        if (w.lane < 4) { const int e = texp[(w.wave * 16 + j) * 4 + w.lane]; const int idx = base[e] + (int)atomicAdd((unsigned*)hist + e, 1u);
            LIST[e * LCAP + idx] = m; PW[(size_t)m * 4 + w.lane] = (e << 20) | idx; } }
}
__device__ __forceinline__ void combine_row(ARef A, int l, int m, int lane, const LAS int* tst, float gscale = 1.0f, float oscale = 1.0f) {
    float* XA = (float*)(A.ws + WS_XA) + (size_t)m * DM; const float* MOD = (const float*)(A.ws + WS_MOD) + (size_t)(l * 8 + (m >> 12)) * 6144;
    const int* PS = (const int*)(A.ws + WS_POS) + (size_t)m * 4; const float* TW = (const float*)(A.ws + WS_TOPW) + (size_t)m * 4;
    const bf16* YS = (const bf16*)(A.ws + WS_XS);
    f32x4 v[4], acc[4];
#pragma unroll
    for (int j = 0; j < 4; ++j) { v[j] = *(const f32x4*)(XA + 4 * (lane + 64 * j)); acc[j] = (f32x4){0.f, 0.f, 0.f, 0.f}; }
#pragma unroll
    for (int k = 0; k < 4; ++k) { const int pe = PS[k]; const int pos = tst[pe >> 20] * 256 + (pe & 0xFFFFF); const float gt = TW[k] * gscale; const v2u* yr = (const v2u*)(YS + (size_t)pos * DM);
#pragma unroll
        for (int j = 0; j < 4; ++j) { const v2u y = yr[lane + 64 * j]; acc[j] += gt * (f32x4){bf_lo(y.x), bf_hi(y.x), bf_lo(y.y), bf_hi(y.y)}; } }
    float ss = 0.0f;
#pragma unroll
    for (int j = 0; j < 4; ++j) { const int kx = 4 * (lane + 64 * j); v[j] += *(const f32x4*)(MOD + 5 * 1024 + kx) * acc[j]; ss += dot4(v[j], v[j]); }
    ss = wave_sum(ss); const float rstd = 1.0f / sqrtf(ss * (1.0f / DM) + 1e-5f);
    if (l + 1 < NLAYER) {
#pragma unroll
        for (int j = 0; j < 4; ++j) *(f32x4*)(XA + 4 * (lane + 64 * j)) = v[j];
        const float* mb = MOD + 8 * 6144;
        emit_h_row(v, rstd, A.in[I_NMIX] + (l + 1) * DM, mb + 1024, mb, (bf16*)(A.ws + WS_H) + (size_t)m * DM, lane);
    } else {
        float* orow = A.out + (size_t)m * DM; const float* gf = A.in[I_NFINAL];
#pragma unroll
        for (int j = 0; j < 4; ++j) { const int kx = 4 * (lane + 64 * j); *(f32x4*)(orow + kx) = v[j] * (rstd * oscale) * *(const f32x4*)(gf + kx); }
    }
}

constexpr int N_LAUNCHES = MK_N_LAUNCHES;
template <int SEL> __global__ void __launch_bounds__(NWAVES * 64, 2) fwd(ArgsH Ah) {
    extern __shared__ __attribute__((aligned(16))) unsigned char lds[];
    (void)Ah;
    const int wave_s = __builtin_amdgcn_readfirstlane((int)threadIdx.x >> 6);
    auto tid_now = [&]() -> int { int ws_ = wave_s; unsigned z_ = 0u; asm volatile("" : "+s"(ws_), "+s"(z_)); return ws_ * 64 + (int)__builtin_amdgcn_mbcnt_hi(~0u, __builtin_amdgcn_mbcnt_lo(~0u, z_)); };
#define TID_NOW() tid_now()
#define MAKE_WI() WI w; { int tz = TID_NOW(); asm volatile("" : "+v"(tz)); int bz = blockIdx.x, gz = gridDim.x; asm volatile("" : "+s"(bz), "+s"(gz)); \
        w.lds = (LAS unsigned char*)lds; w.tid = tz; w.lane = tz & 63; w.wave = __builtin_amdgcn_readfirstlane(tz >> 6); w.G = gz; w.bx = bz; w.vcu = (gz % 8 == 0) ? (bz % 8) * (gz / 8) + bz / 8 : bz; \
        w.gw = w.vcu * NWAVES + w.wave; w.NGW = gz * NWAVES; }
    { const int t0 = threadIdx.x; for (int u = t0; u < (LDS_BYTES - RING_BYTES) / 4; u += NWAVES * 64) ((LAS unsigned*)((LAS unsigned char*)lds + RING_BYTES))[u] = 0u; }
    __syncthreads();
    int lo, hi; { ARef A0 = *kargs(); lo = A0.ph_lo; hi = A0.ph_hi; }
    if (N_LAUNCHES == 1) { ARef A0 = *kargs(); (void)xcd_barrier_post((unsigned*)((gu32*)(A0.ws + WS_CTL) + CW_BAR), (volatile LAS unsigned*)((LAS unsigned char*)lds + MISC_OFF) + 8, TID_NOW()); }
#define GRID_BAR() do { if (N_LAUNCHES == 1) { ARef Ab = *kargs(); XcdBarrier bar_; bar_.bar = (unsigned*)((gu32*)(Ab.ws + WS_CTL) + CW_BAR); bar_.x = xb_xcc_id(); bar_.st = (volatile LAS unsigned*)((LAS unsigned char*)lds + MISC_OFF) + 8; xcd_barrier(bar_, TID_NOW()); } } while (0)
#ifndef TPROBE
#define TPROBE 0
#endif
#if TPROBE
    unsigned long long tp_acc = 0ull;
#define TP_SCALE tp_scale_of(__hip_atomic_load((unsigned*)(A.ws + WS_CTL) + 3, RLX_AGENT))
    auto tp_scale_of = [](unsigned ticks) -> float { const float us = (float)ticks * 0.01f; if (us < 1.0f) return 1.0f; const float q = exp2f(rintf(log2f(us) * 8.0f) * 0.125f); return 1.0f + sqrtf(q * 1e-5f); };
#define TP_BEGIN(kind) unsigned long long tp_t0 = 0ull; if ((kind) == TPROBE) tp_t0 = __builtin_amdgcn_s_memrealtime();
#define TP_END(kind) if ((kind) == TPROBE) { tp_acc += __builtin_amdgcn_s_memrealtime() - tp_t0; }
#define TP_PUBLISH(l) if ((l) == 1 && w.vcu == 0 && w.tid == 0) __hip_atomic_store((unsigned*)(A.ws + WS_CTL) + 3, (unsigned)tp_acc, RLX_AGENT);
#else
#define TP_SCALE 1.0f
#define TP_PUBLISH(l)
#define TP_BEGIN(kind)
#define TP_END(kind)
#endif
#define IN(k) (lo <= (k) && (k) < hi)
#ifndef PHMASK
#define PHMASK 0xffffffffu
#endif
#define KON(k) if constexpr ((SEL < 0 && ((PHMASK >> (k)) & 1u)) || SEL == (k))
#define BOTH(k) (IN(k) && IN((k) + 1))
#ifndef PROBE_REP
#define PROBE_REP 0
#endif
#if PROBE_REP
    int nrep_ = 2; asm volatile("" : "+s"(nrep_));
#define REP(bit) _Pragma("unroll 1") for (int rep_ = 0; rep_ < (((PROBE_REP >> (bit)) & 1) ? nrep_ : 1); ++rep_)
#else
#define REP(bit) for (int rep_ = 0; rep_ < 1; ++rep_)
#endif
#define ring ((PG8_LAS unsigned char*)lds)

    KON(0) if (IN(0)) { ARef A = *kargs(); MAKE_WI(); REP(0) ph_prologue(A, w); if (BOTH(0)) GRID_BAR(); }

#define LAYER_BODY(l) do {\
        const int pb = 1 + l * NPL; \
        KON(1) if (IN(pb + 0)) { ARef A = *kargs(); MAKE_WI(); TP_BEGIN(1) if (l == 0) { REP(15) { ph_norm1(A, w); small_weights_to_f16(A, w); } if (BOTH(pb + 0)) GRID_BAR(); } TP_END(1) } \
        KON(2) if (IN(pb + 1)) { ARef A = *kargs(); MAKE_WI(); TP_BEGIN(2) \
            pg8::Gemm g{(const bf16*)(A.ws + WS_H), (const bf16*)(A.ws + WS_WIN) + (size_t)l * INCP * DM, MTOK, INCP, DM}; pg8::StaticOrder S; S.init(MTOK, INCP, w.G, w.bx); \
            pg8::EpiProj E{(bf16*)(A.ws + WS_PB), (float*)(A.ws + WS_PF)}; \
            REP(1) pg8::gemm_phase<pg8::EpiProj, pg8::StaticOrder, true, true>(ring, g, S, E, w.tid); \
            if (BOTH(pb + 1)) GRID_BAR(); TP_END(2) \
        } \
        KON(3) if (IN(pb + 2)) { ARef A = *kargs(); MAKE_WI(); TP_BEGIN(3) \
            REP(2) { int part_ = rep_ ? ((PROBE_REP >> 21) & 7) : 7; asm volatile("" : "+s"(part_)); for (int g = w.gw; g < MTOK / 16; g += w.NGW) prep16(A, l, 16 * g, w.lane, part_); } \
            if (BOTH(pb + 2)) GRID_BAR(); TP_END(3) \
        } \
        KON(4) if (IN(pb + 3)) { ARef A = *kargs(); MAKE_WI(); TP_BEGIN(4) \
            REP(3) { for (int tk = 2 * w.vcu; tk < 32 * NCH; tk += 2 * w.G) scan_rwkv_task2(A, w, tk); } \
            REP(13) { for (int tk = w.vcu; tk < 32 * NCH / 2; tk += w.G) scan_ret_task(A, w, tk); } \
            REP(4) { LAS unsigned char* vl = w.lds + w.wave * 4608; for (int it = w.gw; it < 32 * 128; it += w.NGW) sb_tile_mfma(A, it, w.lane, vl); } \
            REP(5) dsa_scores_mfma(A, w); \
            if (BOTH(pb + 3)) GRID_BAR(); TP_END(4) \
        } \
        KON(5) if (IN(pb + 4)) { ARef A = *kargs(); MAKE_WI(); TP_BEGIN(5) \
            if (w.bx < 32) prefix_chain(A, w, w.bx); \
            REP(6) dsa_wave(A, w, w.lds + w.wave * 13312, l + 2 * rep_, l); \
            REP(14) { if (rep_ && w.bx < 32) prefix_chain(A, w, w.bx); } \
            if (BOTH(pb + 4)) GRID_BAR(); TP_END(5) \
        } \
        KON(6) if (IN(pb + 5)) { ARef A = *kargs(); MAKE_WI(); TP_BEGIN(6) \
            REP(7) ph_post16(A, w, l); \
            if (BOTH(pb + 5)) GRID_BAR(); TP_END(6) \
        } \
        KON(7) if (IN(pb + 6)) { ARef A = *kargs(); MAKE_WI(); TP_BEGIN(7) \
            pg8::Gemm g{(const bf16*)(A.ws + WS_MIX), (const bf16*)(A.ws + WS_WOUT) + (size_t)l * DM * DM, MTOK, DM, DM}; pg8::StaticOrder S; S.init(MTOK, DM, w.G, w.bx); \
            pg8::EpiRes E{l == 0 ? A.in[I_X] : (const float*)(A.ws + WS_XA), (float*)(A.ws + WS_XA), (const float*)(A.ws + WS_MOD) + (size_t)l * 8 * 6144 + 2 * 1024}; \
            REP(16) { pg8::EpiRes E2 = E; if (rep_ && l == 1) E2.gate = (const float*)(A.ws + WS_CTL + 512 * 1024); pg8::gemm_phase<pg8::EpiRes, pg8::StaticOrder, true, true>(ring, g, S, E2, w.tid); } \
            if (BOTH(pb + 6)) GRID_BAR(); TP_END(7) \
        } \
        KON(8) if (IN(pb + 7)) { ARef A = *kargs(); MAKE_WI(); TP_BEGIN(8) \
            { LAS unsigned* hist = (LAS unsigned*)(w.lds + HIST_OFF); LAS int* texp = (LAS int*)(w.lds + TEXP_OFF); if (w.tid < 32) hist[w.tid] = 0u; router_stage(A, w, l); \
            REP(10) { int j_ = 0; for (int m = w.gw; m < MTOK; m += w.NGW, ++j_) router_row(A, l, m, w.lane, hist, (const LAS float*)w.lds, texp + (w.wave * 16 + j_) * 4, rep_ != 0); } \
            router_lists(A, w, l); } \
            if (BOTH(pb + 7)) GRID_BAR(); TP_END(8) \
        } \
        KON(10) if (IN(pb + 8)) { ARef A = *kargs(); MAKE_WI(); TP_BEGIN(10) \
            build_expert_table(A, w, l); \
            pg8::Gemm g{(const bf16*)(A.ws + WS_H), (const bf16*)(A.ws + WS_W1) + (size_t)l * NEXP * 2048 * DM, MOE_ROWS, NEXP * 2048, DM}; \
            pg8::MoeOrder S{(const PG8_LAS int*)(w.lds + TAB_OFF), 8, w.G, w.vcu, (const PG8_LAS int*)(w.lds + TST_OFF), (const PG8_LAS int*)(w.lds + CNT_OFF), (const int*)(A.ws + WS_LIST)}; \
            pg8::EpiSwiglu E{(bf16*)(A.ws + WS_ACT), A.in[I_MB1] + (size_t)l * NEXP * 2048}; \
            REP(8) { if (PROBE_REP & (1 << 20)) { if (rep_) pg8::gemm_phase<pg8::EpiNull, pg8::MoeOrder, true, true, true>(ring, g, S, pg8::EpiNull{}, w.tid); else pg8::gemm_phase<pg8::EpiSwiglu, pg8::MoeOrder, true, true, true>(ring, g, S, E, w.tid); } else pg8::gemm_phase<pg8::EpiSwiglu, pg8::MoeOrder, true, true, true>(ring, g, S, E, w.tid); } \
            if (BOTH(pb + 8)) GRID_BAR(); TP_END(10) \
        } \
        KON(11) if (IN(pb + 9)) { ARef A = *kargs(); MAKE_WI(); TP_BEGIN(11) \
            build_expert_table(A, w, l); \
            pg8::Gemm g{(const bf16*)(A.ws + WS_ACT), (const bf16*)(A.ws + WS_W2) + (size_t)l * NEXP * DM * DM, MOE_ROWS, NEXP * DM, DM}; \
            pg8::MoeOrder S{(const PG8_LAS int*)(w.lds + TAB_OFF), 4, w.G, w.vcu, (const PG8_LAS int*)(w.lds + TST_OFF), (const PG8_LAS int*)(w.lds + CNT_OFF), (const int*)(A.ws + WS_LIST)}; \
            pg8::EpiY E{(bf16*)(A.ws + WS_XS), A.in[I_MB2] + (size_t)l * NEXP * DM}; \
            REP(9) pg8::gemm_phase<pg8::EpiY, pg8::MoeOrder, true, true>(ring, g, S, E, w.tid); \
            TP_PUBLISH(l) \
            if (BOTH(pb + 9)) GRID_BAR(); TP_END(11) \
        } \
        KON(12) if (IN(pb + 10)) { ARef A = *kargs(); MAKE_WI(); TP_BEGIN(12) \
            build_expert_table(A, w, l); \
            REP(12) for (int m = w.gw; m < MTOK; m += w.NGW) combine_row(A, l, m, w.lane, (const LAS int*)(w.lds + TST_OFF), (rep_ && l == 0) ? 0.0f : 1.0f, TP_SCALE); \
            if (BOTH(pb + 10)) GRID_BAR(); TP_END(12) \
        } \
    } while (0)
    LAYER_BODY(0);
    LAYER_BODY(1);
#undef LAYER_BODY
#undef IN
#undef ring
#undef MAKE_WI
#undef TID_NOW
#undef GRID_BAR
#undef KON
#undef BOTH
}


#if MK_N_LAUNCHES != 1
template <int K> static void launch_one(int grid, hipStream_t stream, const ArgsH& a) {
    static bool attr = false;
    if (!attr) { (void)hipFuncSetAttribute((const void*)fwd<K>, hipFuncAttributeMaxDynamicSharedMemorySize, LDS_BYTES); attr = true; }
    hipLaunchKernelGGL(fwd<K>, dim3(grid), dim3(NWAVES * 64), LDS_BYTES, stream, a);
}
static void launch_kind(int kind, int grid, hipStream_t stream, const ArgsH& a) {
    switch (kind) {
        case 0: launch_one<0>(grid, stream, a); break; case 1: launch_one<1>(grid, stream, a); break; case 2: launch_one<2>(grid, stream, a); break;
        case 3: launch_one<3>(grid, stream, a); break; case 4: launch_one<4>(grid, stream, a); break; case 5: launch_one<5>(grid, stream, a); break;
        case 6: launch_one<6>(grid, stream, a); break; case 7: launch_one<7>(grid, stream, a); break; case 8: launch_one<8>(grid, stream, a); break;
        case 9: launch_one<9>(grid, stream, a); break; case 10: launch_one<10>(grid, stream, a); break; case 11: launch_one<11>(grid, stream, a); break;
        default: launch_one<12>(grid, stream, a); break;
    }
}
#endif
extern "C" void kernel_launch(void* const* d_in, const int* in_sizes, int n_in, void* d_out, int out_size, void* d_ws, size_t ws_size, hipStream_t stream) {
    static int grid = 0;
    if (grid == 0) {
        if (n_in != N_IN || out_size != MTOK * DM || ws_size < WS_END) { fprintf(stderr, "kernel_launch: unexpected shapes (n_in %d, out %d, ws %zu)\n", n_in, out_size, ws_size); grid = -1; return; }
        int dev = 0, cus = 0;
        if (hipGetDevice(&dev) != hipSuccess || hipDeviceGetAttribute(&cus, hipDeviceAttributeMultiprocessorCount, dev) != hipSuccess) { grid = -1; return; }
#if MK_N_LAUNCHES == 1
        {
            if (hipFuncSetAttribute((const void*)fwd<-1>, hipFuncAttributeMaxDynamicSharedMemorySize, LDS_BYTES) != hipSuccess) { fprintf(stderr, "kernel_launch: hipFuncSetAttribute failed\n"); grid = -1; return; }
            int per_cu = 0;
            if (hipOccupancyMaxActiveBlocksPerMultiprocessor(&per_cu, (const void*)fwd<-1>, NWAVES * 64, LDS_BYTES) != hipSuccess || per_cu < 1) fprintf(stderr, "kernel_launch: occupancy query says %d\n", per_cu);
            (void)hipGetLastError();
        }
#endif
        grid = cus;
    }
    if (grid < 0) return;
    (void)in_sizes;
    if (hipMemsetAsync((char*)d_ws + WS_CTL, 0, CTL_ZERO_BYTES, stream) != hipSuccess) return;
    ArgsH a{};
    for (int i = 0; i < N_IN; ++i) a.in[i] = (const float*)d_in[i];
    a.out = (float*)d_out; a.ws = (unsigned char*)d_ws;
    for (int f = 0; f < 44; ++f) a.invf[f] = (f < 32) ? pow(10000.0, -(double)f / 32.0) : (f < 40) ? pow(500000.0, -(double)(f - 32) / 8.0) : pow(500000.0, -(double)(f - 40) / 4.0);
#if MK_N_LAUNCHES == 1
    a.ph_lo = 0; a.ph_hi = NPHASE; a.li = 0;
    hipLaunchKernelGGL(fwd<-1>, dim3(grid), dim3(NWAVES * 64), LDS_BYTES, stream, a);
#else
    {
        for (int p = 0; p < NPHASE; ++p) {
            if (p == 1 + NPL) continue;
            a.ph_lo = p; a.ph_hi = p + 1; a.li = p;
            static const int kinds_[NPL] = {1, 2, 3, 4, 5, 6, 7, 8, 10, 11, 12};
            const int kind = (p == 0) ? 0 : kinds_[(p - 1) % NPL];
            launch_kind(kind, grid, stream, a);
        }
    }
#endif
}
```

```cpp
#include <hip/hip_runtime.h>
#include <cstdio>
#include <cstdint>
#include <cmath>

#ifndef MK_N_LAUNCHES
#define MK_N_LAUNCHES 1
#endif

namespace pg8 {
#define PG8_LAS __attribute__((address_space(3)))
typedef unsigned short bf16_t;
typedef short bf16x8 __attribute__((ext_vector_type(8)));
typedef float f32x4 __attribute__((ext_vector_type(4)));
typedef unsigned u32x4 __attribute__((ext_vector_type(4)));
typedef unsigned u32x2 __attribute__((ext_vector_type(2)));
constexpr int BM = 256, BK = 64, HALF = 128, HTB = HALF * BK * 2  , STAGE_BYTES = 8 * HTB, NXCD = 8, WGM = 8;

__host__ __device__ __forceinline__ int lds_byte(int r, int c) { const int st = (r >> 4) * 2 + (c >> 5), rr = r & 15, cc = c & 31, ob = rr * 64 + cc * 2; return st * 1024 + (ob ^ (((ob >> 9) & 1) << 5)); }
__host__ __device__ __forceinline__ void stage_rc(int b, int& R, int& C) { const int st = b / 1024, sb = b % 1024, swz = sb ^ (((sb >> 9) & 1) << 5); R = (st >> 1) * 16 + swz / 64; C = (st & 1) * 32 + (swz % 64) / 2; }
__host__ __device__ __forceinline__ int perm32(int rho) { const int n = rho >> 4, i = rho & 15; return 8 * (i >> 2) + 4 * n + (i & 3); }

struct Unit { int pm, pn; };
struct Gemm { const bf16_t* A; const bf16_t* Bt; int M, N, K; };

struct StaticOrder {
    int nM, nN, nwg, G, c;
    __host__ __device__ void init(int M, int N, int G_, int c_) { nM = M / BM; nN = N / BM; nwg = nM * nN; G = G_; c = c_; }
    __host__ __device__ bool next(int i, Unit& u) const {
        const long L = (long)i * G + c; if (L >= nwg) return false;
        int wgid = (int)L; { const int q = nwg / NXCD, r = nwg % NXCD, xcd = wgid % NXCD, off = wgid / NXCD; wgid = (xcd < r ? xcd * (q + 1) : r * (q + 1) + (xcd - r) * q) + off; }
        const int nig = WGM * nN, gid = wgid / nig, fm = gid * WGM, gsz = (nM - fm) < WGM ? (nM - fm) : WGM;
        u.pm = fm + ((wgid % nig) % gsz); u.pn = (wgid % nig) / gsz; return true;
    }
    __device__ __forceinline__ void a_ready(const Unit&) const {}
    __device__ __forceinline__ void done(const Unit&) const {}
};
__device__ __forceinline__ unsigned cvt_pk_bf16(float lo, float hi) { unsigned r; asm volatile("v_cvt_pk_bf16_f32 %0, %1, %2" : "=v"(r) : "v"(lo), "v"(hi)); return r; }
struct EpiF32 {
    static constexpr bool PERM = false, AFTER_DRAIN = false;
    float* C; int ldc;
    __device__ __forceinline__ void operator()(const f32x4 (&acc)[2][2][4][2], const Unit& u, int wr, int wc, int fr, int fq) const {
        const int row0 = u.pm * BM + wr * 64 + fr, col0 = u.pn * BM + wc * 32 + 4 * fq;
#pragma unroll
        for (int ai = 0; ai < 2; ++ai)
#pragma unroll
            for (int m = 0; m < 4; ++m) { float* rowp = C + (size_t)(row0 + ai * HALF + m * 16) * ldc + col0;
#pragma unroll
                for (int bj = 0; bj < 2; ++bj)
#pragma unroll
                    for (int n = 0; n < 2; ++n) *(f32x4*)(rowp + bj * HALF + n * 16) = acc[ai][bj][m][n]; }
    }
};
struct EpiNull {
    static constexpr bool PERM = true, AFTER_DRAIN = false;
    __device__ __forceinline__ void operator()(const f32x4 (&acc)[2][2][4][2], const Unit&, int, int, int, int) const {
#pragma unroll
        for (int ai = 0; ai < 2; ++ai)
#pragma unroll
            for (int bj = 0; bj < 2; ++bj) asm volatile("" :: "v"(acc[ai][bj][0][0]), "v"(acc[ai][bj][0][1]), "v"(acc[ai][bj][1][0]), "v"(acc[ai][bj][1][1]), "v"(acc[ai][bj][2][0]), "v"(acc[ai][bj][2][1]), "v"(acc[ai][bj][3][0]), "v"(acc[ai][bj][3][1]));
    }
};
struct EpiProj {
    static constexpr bool PERM = true, AFTER_DRAIN = false;
    bf16_t* PB; float* PF;
    __device__ __forceinline__ void operator()(const f32x4 (&acc)[2][2][4][2], const Unit& u, int wr, int wc, int fr, int fq) const {
        const int row0 = u.pm * BM + wr * 64 + fr;
        if (u.pn < 7) { const int c0 = u.pn * BM + wc * 32 + 8 * fq;
#pragma unroll
            for (int ai = 0; ai < 2; ++ai)
#pragma unroll
                for (int m = 0; m < 4; ++m) { bf16_t* rowp = PB + (size_t)(row0 + ai * HALF + m * 16) * 1792 + c0;
#pragma unroll
                    for (int bj = 0; bj < 2; ++bj) { const f32x4 v0 = acc[ai][bj][m][0], v1 = acc[ai][bj][m][1];
                        u32x4 w; w.x = cvt_pk_bf16(v0[0], v0[1]); w.y = cvt_pk_bf16(v0[2], v0[3]); w.z = cvt_pk_bf16(v1[0], v1[1]); w.w = cvt_pk_bf16(v1[2], v1[3]);
                        *(u32x4*)(rowp + bj * HALF) = w; } }
        } else { const int c0 = (u.pn - 7) * BM + wc * 32 + 8 * fq;
#pragma unroll
            for (int ai = 0; ai < 2; ++ai)
#pragma unroll
                for (int m = 0; m < 4; ++m) { float* rowp = PF + (size_t)(row0 + ai * HALF + m * 16) * 1280 + c0;
#pragma unroll
                    for (int bj = 0; bj < 2; ++bj) { *(f32x4*)(rowp + bj * HALF) = acc[ai][bj][m][0]; *(f32x4*)(rowp + bj * HALF + 4) = acc[ai][bj][m][1]; } }
        }
    }
};
struct EpiRes {
    static constexpr bool PERM = false, AFTER_DRAIN = false;
    const float* xin; float* xout; const float* gate;
    __device__ __forceinline__ void operator()(const f32x4 (&acc)[2][2][4][2], const Unit& u, int wr, int wc, int fr, int fq) const {
        const int row0 = u.pm * BM + wr * 64 + fr, col0 = u.pn * BM + wc * 32 + 4 * fq;
        const float* gp = gate + (size_t)((u.pm * BM) >> 12) * 6144 + col0;
        f32x4 gv[2][2];
#pragma unroll
        for (int bj = 0; bj < 2; ++bj)
#pragma unroll
            for (int n = 0; n < 2; ++n) gv[bj][n] = *(const f32x4*)(gp + bj * HALF + n * 16);
#pragma unroll
        for (int ai = 0; ai < 2; ++ai)
#pragma unroll
            for (int m = 0; m < 4; ++m) { const size_t ro = (size_t)(row0 + ai * HALF + m * 16) * 1024 + col0;
#pragma unroll
                for (int bj = 0; bj < 2; ++bj)
#pragma unroll
                    for (int n = 0; n < 2; ++n) { const f32x4 xv = *(const f32x4*)(xin + ro + bj * HALF + n * 16); *(f32x4*)(xout + ro + bj * HALF + n * 16) = xv + gv[bj][n] * acc[ai][bj][m][n]; } }
    }
};
__device__ __forceinline__ float swiglu1(float glu, float lin) {
    glu = fminf(glu, 7.0f); lin = fminf(fmaxf(lin, -7.0f), 7.0f);
    return glu * (1.0f / (1.0f + __expf(-1.702f * glu))) * (lin + 1.0f);
}
struct EpiSwiglu {
    static constexpr bool PERM = true, AFTER_DRAIN = false;
    bf16_t* O; const float* b1;
    __device__ __forceinline__ void operator()(const f32x4 (&acc)[2][2][4][2], const Unit& u, int wr, int wc, int fr, int fq) const {
        const int e = u.pn >> 3, j = u.pn & 7, row0 = u.pm * BM + wr * 64 + fr, c0 = 128 * j + wc * 32 + 8 * fq;
        const float* bp = b1 + (size_t)e * 2048 + c0;
        f32x4 bg[2], bl[2];
#pragma unroll
        for (int n = 0; n < 2; ++n) { bg[n] = *(const f32x4*)(bp + 4 * n); bl[n] = *(const f32x4*)(bp + 1024 + 4 * n); }
#pragma unroll
        for (int ai = 0; ai < 2; ++ai)
#pragma unroll
            for (int m = 0; m < 4; ++m) { bf16_t* rowp = O + (size_t)(row0 + ai * HALF + m * 16) * 1024 + c0;
                const f32x4 g0 = acc[ai][0][m][0] + bg[0], g1 = acc[ai][0][m][1] + bg[1], l0 = acc[ai][1][m][0] + bl[0], l1 = acc[ai][1][m][1] + bl[1];
                u32x4 w;
                w.x = cvt_pk_bf16(swiglu1(g0[0], l0[0]), swiglu1(g0[1], l0[1])); w.y = cvt_pk_bf16(swiglu1(g0[2], l0[2]), swiglu1(g0[3], l0[3]));
                w.z = cvt_pk_bf16(swiglu1(g1[0], l1[0]), swiglu1(g1[1], l1[1])); w.w = cvt_pk_bf16(swiglu1(g1[2], l1[2]), swiglu1(g1[3], l1[3]));
                *(u32x4*)rowp = w; }
    }
};
struct EpiY {
    static constexpr bool PERM = true, AFTER_DRAIN = false;
    bf16_t* O; const float* b2;
    __device__ __forceinline__ void operator()(const f32x4 (&acc)[2][2][4][2], const Unit& u, int wr, int wc, int fr, int fq) const {
        const int e = u.pn >> 2, j = u.pn & 3, row0 = u.pm * BM + wr * 64 + fr, c0 = 256 * j + wc * 32 + 8 * fq;
        const float* bp = b2 + (size_t)e * 1024 + c0;
        f32x4 bv[2][2];
#pragma unroll
        for (int bj = 0; bj < 2; ++bj)
#pragma unroll
            for (int n = 0; n < 2; ++n) bv[bj][n] = *(const f32x4*)(bp + bj * HALF + 4 * n);
#pragma unroll
        for (int ai = 0; ai < 2; ++ai)
#pragma unroll
            for (int m = 0; m < 4; ++m) { bf16_t* rowp = O + (size_t)(row0 + ai * HALF + m * 16) * 1024 + c0;
#pragma unroll
                for (int bj = 0; bj < 2; ++bj) { const f32x4 v0 = acc[ai][bj][m][0] + bv[bj][0], v1 = acc[ai][bj][m][1] + bv[bj][1];
                    u32x4 w; w.x = cvt_pk_bf16(v0[0], v0[1]); w.y = cvt_pk_bf16(v0[2], v0[3]); w.z = cvt_pk_bf16(v1[0], v1[1]); w.w = cvt_pk_bf16(v1[2], v1[3]);
                    *(u32x4*)(rowp + bj * HALF) = w; } }
    }
};
struct MoeOrder {
    const PG8_LAS int* tab; int NJ, G, c;
    __device__ __forceinline__ bool next(int i, Unit& u) const {
        const int T = tab[0]; const long L = (long)i * G + c; if (L >= (long)T * NJ) return false;
        const int pm = (int)(L / NJ), j = (int)(L % NJ);
        u.pm = pm; u.pn = tab[1 + pm] * NJ + j; return true;
    }
    __device__ __forceinline__ void a_ready(const Unit&) const {}
    __device__ __forceinline__ void done(const Unit&) const {}
    const PG8_LAS int* tst; const PG8_LAS int* cnt; const int* list;
    __device__ __forceinline__ int row_of(const Unit& u, int r) const { const int e = tab[1 + u.pm], idx = 256 * (u.pm - tst[e]) + r; return (idx < cnt[e]) ? list[e * 32768 + idx] : 0; }
};

template <class Epi, class Sched, bool ALIGN_EPI = false, bool SP2 = false, bool GATHER = false>
__device__ __forceinline__ void gemm_phase(PG8_LAS unsigned char* lds, const Gemm g, const Sched& S, const Epi& E, int tid_in) {
    int tid_ = tid_in; asm volatile("" : "+v"(tid_));
    const int tid = tid_, wid = __builtin_amdgcn_readfirstlane(tid >> 6), lane = tid & 63, wr = wid >> 2, wc = wid & 3, fr = lane & 15, fq = lane >> 4;
    const int K = g.K, nt = K / BK;
    unsigned voffA[2], voffB[2];
#pragma unroll
    for (int i = 0; i < 2; ++i) { int R, C; stage_rc(tid * 16 + i * 8192, R, C); const int Rb = Epi::PERM ? ((R & ~31) + perm32(R & 31)) : R;
        voffA[i] = (unsigned)(R * K + C) * 2u; voffB[i] = (unsigned)(Rb * K + C) * 2u; }
    static_assert(!GATHER || SP2, "gathered A rows: only the two-super-phase loop is wired");
    unsigned cvo[2][2], nvo[2][2];
#define PG8_ROWS(dst, u_) do { _Pragma("unroll") for (int h_ = 0; h_ < 2; ++h_) _Pragma("unroll") for (int i_ = 0; i_ < 2; ++i_) { int R_, C_; stage_rc(tid * 16 + i_ * 8192, R_, C_); dst[h_][i_] = (unsigned)(S.row_of(u_, h_ * HALF + R_) * K + C_) * 2u; } } while (0)
#define PG8_STAGE_A(bufoff, gbase, half, nx) do { if constexpr (GATHER) { unsigned o_[2]; o_[0] = (nx) ? nvo[half][0] : cvo[half][0]; o_[1] = (nx) ? nvo[half][1] : cvo[half][1]; PG8_STAGE(bufoff, gbase, o_); } else { PG8_STAGE(bufoff, (gbase) + (half) * hstep, voffA); } } while (0)
    const size_t kstep = (size_t)(BK * 2);
    const size_t hstep = (size_t)HALF * K * 2;
    const size_t tstep = 2 * hstep;
    const unsigned ldsw = (unsigned)wid * 1024u;
    const int aoff = lds_byte(wr * 64 + fr, fq * 8), boff = lds_byte(wc * 32 + fr, fq * 8);
#define PG8_SA(b, h) (((b) * 2 + (h)) * HTB)
#define PG8_SB(b, h) ((4 + (b) * 2 + (h)) * HTB)
#define PG8_STAGE(bufoff, gbase, voff) do { _Pragma("unroll") for (int _i = 0; _i < 2; ++_i) \
        __builtin_amdgcn_global_load_lds((const unsigned*)((const char*)(gbase) + (voff)[_i]), (PG8_LAS unsigned*)(lds + (bufoff) + ldsw + _i * 8192), 16, 0, 0); } while (0)
#define PG8_LDA(dst, b, h) do { _Pragma("unroll") for (int m = 0; m < 4; ++m) _Pragma("unroll") for (int k = 0; k < 2; ++k) dst[m][k] = *(const PG8_LAS bf16x8*)(lds + PG8_SA(b, h) + aoff + m * 2048 + k * 1024); } while (0)
#define PG8_LDB(dst, b, h) do { _Pragma("unroll") for (int n = 0; n < 2; ++n) _Pragma("unroll") for (int k = 0; k < 2; ++k) dst[n][k] = *(const PG8_LAS bf16x8*)(lds + PG8_SB(b, h) + boff + n * 2048 + k * 1024); } while (0)
#define PG8_MMA(ai, bj, At, Bt) do { __builtin_amdgcn_s_setprio(1); _Pragma("unroll") for (int m = 0; m < 4; ++m) _Pragma("unroll") for (int n = 0; n < 2; ++n) _Pragma("unroll") for (int k = 0; k < 2; ++k) \
        acc[ai][bj][m][n] = __builtin_amdgcn_mfma_f32_16x16x32_bf16(Bt[n][k], At[m][k], acc[ai][bj][m][n], 0, 0, 0); __builtin_amdgcn_s_setprio(0); } while (0)
#define PG8_WAIT_V(n) asm volatile("s_waitcnt vmcnt(" #n ")" ::: "memory")
#define PG8_WAIT_L(n) asm volatile("s_waitcnt lgkmcnt(" #n ")" ::: "memory")
#define PG8_BAR __builtin_amdgcn_s_barrier()
#define PG8_SCHED __builtin_amdgcn_sched_barrier(0)
    Unit cur, nxt; int ui = 0;
    if (!S.next(0, cur)) return;
    f32x4 acc[2][2][4][2];
#pragma unroll
    for (int a = 0; a < 2; ++a)
#pragma unroll
        for (int b = 0; b < 2; ++b)
#pragma unroll
            for (int m = 0; m < 4; ++m)
#pragma unroll
                for (int n = 0; n < 2; ++n) acc[a][b][m][n] = (f32x4){0.f, 0.f, 0.f, 0.f};
    bf16x8 At[4][2], B0[2][2], B1[2][2];
    const char* cA = (const char*)g.A + (GATHER ? (size_t)0 : (size_t)cur.pm * tstep); const char* cB = (const char*)g.Bt + (size_t)cur.pn * tstep;
    if constexpr (GATHER) { PG8_ROWS(cvo, cur); }
    S.a_ready(cur);
    if constexpr (SP2) {
        PG8_STAGE(PG8_SB(0, 0), cB, voffB); PG8_STAGE(PG8_SB(0, 1), cB + hstep, voffB); PG8_STAGE_A(PG8_SA(0, 0), cA, 0, false); PG8_STAGE_A(PG8_SA(0, 1), cA, 1, false);
        if (wr == 1) PG8_BAR;
        PG8_WAIT_V(2); PG8_BAR;
        PG8_STAGE(PG8_SB(1, 0), cB + kstep, voffB); PG8_STAGE_A(PG8_SA(1, 0), cA + kstep, 0, false); PG8_STAGE(PG8_SB(1, 1), cB + hstep + kstep, voffB);
        PG8_WAIT_V(6); PG8_BAR;
    } else {
        PG8_STAGE(PG8_SB(0, 0), cB, voffB); PG8_STAGE(PG8_SA(0, 0), cA, voffA); PG8_STAGE(PG8_SB(0, 1), cB + hstep, voffB); PG8_STAGE(PG8_SA(0, 1), cA + hstep, voffA);
        if (wr == 1) PG8_BAR;
        PG8_WAIT_V(4); PG8_BAR;
        PG8_STAGE(PG8_SB(1, 0), cB + kstep, voffB); PG8_STAGE(PG8_SA(1, 0), cA + kstep, voffA); PG8_STAGE(PG8_SB(1, 1), cB + hstep + kstep, voffB);
        PG8_WAIT_V(6); PG8_BAR;
    }
    for (;;) {
        const bool has_next = S.next(ui + 1, nxt);
        const char* nA = GATHER ? (const char*)g.A : (has_next ? (const char*)g.A + (size_t)nxt.pm * tstep : cA); const char* nB = has_next ? (const char*)g.Bt + (size_t)nxt.pn * tstep : cB;
        if constexpr (GATHER) { if (has_next) { PG8_ROWS(nvo, nxt); } else { _Pragma("unroll") for (int h_ = 0; h_ < 2; ++h_) { nvo[h_][0] = cvo[h_][0]; nvo[h_][1] = cvo[h_][1]; } } }
        for (int t = 0; t < nt; t += 2) {
            const bool last = (t == nt - 2);
            const char* a1 = cA + (size_t)(t + 1) * kstep;
            const char* a2 = last ? nA : cA + (size_t)(t + 2) * kstep; const char* b2 = last ? nB : cB + (size_t)(t + 2) * kstep;
            const char* a3 = a2 + kstep; const char* b3 = b2 + kstep;
            if (last && has_next) S.a_ready(nxt);
            if constexpr (SP2) {
            PG8_LDB(B0, 0, 0); PG8_LDB(B1, 0, 1); PG8_SCHED; PG8_LDA(At, 0, 0); PG8_STAGE_A(PG8_SA(1, 1), a1, 1, false);
            PG8_WAIT_V(8); PG8_WAIT_L(0); PG8_BAR; PG8_MMA(0, 0, At, B0); PG8_MMA(0, 1, At, B1); PG8_BAR; PG8_SCHED;
            PG8_LDA(At, 0, 1); PG8_STAGE(PG8_SB(0, 0), b2, voffB); PG8_STAGE(PG8_SB(0, 1), b2 + hstep, voffB); PG8_STAGE_A(PG8_SA(0, 0), a2, 0, last);
            PG8_WAIT_V(8); PG8_WAIT_L(0); PG8_BAR; PG8_MMA(1, 0, At, B0); PG8_MMA(1, 1, At, B1); PG8_BAR; PG8_SCHED;
            PG8_LDB(B0, 1, 0); PG8_LDB(B1, 1, 1); PG8_SCHED; PG8_LDA(At, 1, 0); PG8_STAGE_A(PG8_SA(0, 1), a2, 1, last);
            PG8_WAIT_V(8); PG8_WAIT_L(0); PG8_BAR; PG8_MMA(0, 0, At, B0); PG8_MMA(0, 1, At, B1); PG8_BAR; PG8_SCHED;
            PG8_LDA(At, 1, 1); PG8_STAGE(PG8_SB(1, 0), b3, voffB); PG8_STAGE(PG8_SB(1, 1), b3 + hstep, voffB); PG8_STAGE_A(PG8_SA(1, 0), a3, 0, last);
            PG8_WAIT_V(8); PG8_WAIT_L(0); PG8_BAR; PG8_MMA(1, 0, At, B0); PG8_MMA(1, 1, At, B1); PG8_BAR; PG8_SCHED;
            } else {
            PG8_LDB(B0, 0, 0); PG8_SCHED; PG8_LDA(At, 0, 0); PG8_STAGE(PG8_SA(1, 1), a1 + hstep, voffA);
            PG8_WAIT_L(8); PG8_BAR; PG8_WAIT_L(0); PG8_MMA(0, 0, At, B0); PG8_BAR; PG8_SCHED;
            PG8_LDB(B1, 0, 1); PG8_STAGE(PG8_SB(0, 0), b2, voffB);
            PG8_BAR; PG8_WAIT_L(0); PG8_MMA(0, 1, At, B1); PG8_BAR;
            PG8_LDA(At, 0, 1); PG8_STAGE(PG8_SA(0, 0), a2, voffA);
            PG8_BAR; PG8_WAIT_L(0); PG8_MMA(1, 0, At, B0); PG8_BAR; PG8_SCHED;
            PG8_STAGE(PG8_SB(0, 1), b2 + hstep, voffB);
            PG8_WAIT_V(6); PG8_BAR; PG8_MMA(1, 1, At, B1); PG8_BAR;
            PG8_LDB(B0, 1, 0); PG8_SCHED; PG8_LDA(At, 1, 0); PG8_STAGE(PG8_SA(0, 1), a2 + hstep, voffA);
            PG8_WAIT_L(8); PG8_BAR; PG8_WAIT_L(0); PG8_MMA(0, 0, At, B0); PG8_BAR; PG8_SCHED;
            PG8_LDB(B1, 1, 1); PG8_STAGE(PG8_SB(1, 0), b3, voffB);
            PG8_BAR; PG8_WAIT_L(0); PG8_MMA(0, 1, At, B1); PG8_BAR;
            PG8_LDA(At, 1, 1); PG8_STAGE(PG8_SA(1, 0), a3, voffA);
            PG8_BAR; PG8_WAIT_L(0); PG8_MMA(1, 0, At, B0); PG8_BAR; PG8_SCHED;
            PG8_STAGE(PG8_SB(1, 1), b3 + hstep, voffB);
            PG8_WAIT_V(6); PG8_BAR; PG8_MMA(1, 1, At, B1); PG8_BAR;
            }
        }
        if constexpr (ALIGN_EPI) { if (wr == 0) PG8_BAR; }
        if constexpr (!Epi::AFTER_DRAIN) { E(acc, cur, wr, wc, fr, fq); S.done(cur); }
        if (!has_next) break;
#pragma unroll
        for (int a = 0; a < 2; ++a)
#pragma unroll
            for (int b = 0; b < 2; ++b)
#pragma unroll
                for (int m = 0; m < 4; ++m)
#pragma unroll
                    for (int n = 0; n < 2; ++n) acc[a][b][m][n] = (f32x4){0.f, 0.f, 0.f, 0.f};
        cur = nxt; cA = nA; cB = nB; ++ui;
        if constexpr (GATHER) { _Pragma("unroll") for (int h_ = 0; h_ < 2; ++h_) { cvo[h_][0] = nvo[h_][0]; cvo[h_][1] = nvo[h_][1]; } }
        if constexpr (ALIGN_EPI) { if (wr == 1) PG8_BAR; }
    }
    PG8_WAIT_V(0);
    if constexpr (!ALIGN_EPI) { if (wr == 0) PG8_BAR; }
    PG8_BAR;
    if constexpr (Epi::AFTER_DRAIN) { E.fused(acc, cur, wr, wc, fr, fq, lds, wid, lane); S.done(cur); }
#undef PG8_SA
#undef PG8_SB
#undef PG8_STAGE
#undef PG8_STAGE_A
#undef PG8_ROWS
#undef PG8_LDA
#undef PG8_LDB
#undef PG8_MMA
#undef PG8_WAIT_V
#undef PG8_WAIT_L
#undef PG8_BAR
#undef PG8_SCHED
}
}

constexpr int NWAVES = 8;
constexpr int NB = 8, SEQ = 4096, DM = 1024, MTOK = NB * SEQ, NLAYER = 2;
constexpr int INC = 2984, INCP = 3072;
constexpr int C_RET = 0, C_RW = 1024, C_DSA = 1920, C_SB = 2216;
constexpr int PBW = 1792, PFW = 1280, PB_SB = 1024, PF_DSA = 896;
constexpr int NEXP = 32, MOE_ROWS = MTOK * 4 + NEXP * 256;
constexpr int ROPE_W = 88;
constexpr int NCH = 16, TCH = SEQ / NCH;
constexpr int NPL = 11, NPHASE = 1 + NLAYER * NPL;
enum { I_X = 0, I_C, I_POS, I_ADAW, I_ADAB, I_NMIX, I_NFFN, I_WIN, I_RETGN, I_MU, I_W0, I_W2, I_A0, I_A2, I_G2, I_KK, I_KA, I_RK, I_LN, I_QNORM, I_WQ, I_WQI, I_DONORM, I_SONORM, I_WOUT, I_RW, I_RB, I_MW1, I_MB1, I_MW2, I_MB2, I_NFINAL, N_IN };

constexpr size_t MiB = 1u << 20;
constexpr size_t WS_CTL = 0, CTL_ZERO_BYTES = 1 * MiB;
constexpr size_t WS_MOD = 1 * MiB, WS_ROPE = 2 * MiB, WS_WIN = 14 * MiB, WS_WOUT = 26 * MiB, WS_W1 = 30 * MiB, WS_W2 = 286 * MiB;
constexpr size_t WS_XA = 414 * MiB, WS_H = 542 * MiB, WS_MIX = 606 * MiB, WS_TOPI = 670 * MiB, WS_TOPW = 671 * MiB, WS_POS = 672 * MiB;
constexpr size_t WS_R = 674 * MiB;
constexpr size_t WS_PB = WS_R  , WS_PF = WS_R + 112 * MiB  , WS_RWA = 946 * MiB  , WS_DQ = 1314 * MiB  , WS_DKB = 1330 * MiB  , WS_DVB = 1334 * MiB  , WS_DQI = 1346 * MiB  , WS_DKI = 1394 * MiB  , WS_DW = 1398 * MiB;
constexpr size_t WS_SMALLW = 1338 * MiB  ;
constexpr int SMW_QI = 0, SMW_W2 = 512 * 128, SMW_A2 = SMW_W2 + 256 * 32, SMW_G2 = SMW_A2 + 256 * 32, SMW_LAYER = SMW_G2 + 256 * 64;
constexpr size_t WS_PT = 1362 * MiB  ;
constexpr size_t WS_CH = WS_H  , WS_SI = WS_H + 16 * MiB  , WS_SIR = WS_H + 24 * MiB  ,
                 WS_CHR = WS_H + 32 * MiB  , WS_PTR = WS_H + 40 * MiB  ;
constexpr size_t WS_SQ = WS_MIX  , WS_SK = WS_MIX + 16 * MiB, WS_SV = WS_MIX + 32 * MiB;
constexpr size_t WS_YO = 1400 * MiB  , WS_SC = 1528 * MiB  ;
constexpr size_t WS_XS = WS_R  , WS_ACT = 946 * MiB  ;
constexpr size_t WS_LIST = 2040 * MiB  , WS_END = 2044 * MiB;
constexpr int LCAP = 32768;
static_assert((size_t)MOE_ROWS * 2048 <= 272 * MiB, "moe buffers");
constexpr int CW_TMO = 0, CW_CODE = 1, CW_GCNT = 256  , CW_DSAQ = 1024  , CW_BAR = 4096, CW_BLKCNT = 16384  ;
constexpr int RING_BYTES = 131072, MISC_OFF = RING_BYTES + 320, TST_OFF = RING_BYTES + 1024  , TAB_OFF = RING_BYTES + 2048  , HIST_OFF = RING_BYTES + 5120  , BASE_OFF = RING_BYTES + 5376  , CNT_OFF = RING_BYTES + 5632  , TEXP_OFF = RING_BYTES + 6144  , LDS_BYTES = 147456;

#if defined(__HIP_DEVICE_COMPILE__)
#define GAS __attribute__((address_space(1)))
#define CAS __attribute__((address_space(4)))
#else
#define GAS
#define CAS
#endif
#define LAS __attribute__((address_space(3)))
typedef unsigned short bf16;
typedef unsigned v4u __attribute__((ext_vector_type(4)));
typedef unsigned v2u __attribute__((ext_vector_type(2)));
typedef float f32x4 __attribute__((ext_vector_type(4)));
typedef GAS unsigned gu32;
typedef short bf16x8v __attribute__((ext_vector_type(8)));
typedef short s16x4v __attribute__((ext_vector_type(4)));
typedef _Float16 f16x8 __attribute__((ext_vector_type(8)));
#define RLX_AGENT __ATOMIC_RELAXED, __HIP_MEMORY_SCOPE_AGENT
#define LDS_WAIT() asm volatile("s_waitcnt lgkmcnt(0)" ::: "memory")
#define VM_WAIT() asm volatile("s_waitcnt vmcnt(0)" ::: "memory")
__device__ __forceinline__ unsigned f2bf(float f) { unsigned u = __builtin_bit_cast(unsigned, f); return (u + 0x7fffu + ((u >> 16) & 1u)) >> 16; }
__device__ __forceinline__ unsigned pk2(float lo, float hi) { return f2bf(lo) | (f2bf(hi) << 16); }
__device__ __forceinline__ float bf_lo(unsigned w) { return __builtin_bit_cast(float, w << 16); }
__device__ __forceinline__ float bf_hi(unsigned w) { return __builtin_bit_cast(float, w & 0xffff0000u); }
__device__ __forceinline__ float wave_sum(float v) {
#pragma unroll
    for (int o = 1; o < 64; o <<= 1) v += __shfl_xor(v, o);
    return v;
}
__device__ __forceinline__ float wave_max(float v) {
#pragma unroll
    for (int o = 1; o < 64; o <<= 1) v = fmaxf(v, __shfl_xor(v, o));
    return v;
}
__device__ __forceinline__ float grp16_sum(float v) { v += __shfl_xor(v, 1); v += __shfl_xor(v, 2); v += __shfl_xor(v, 4); v += __shfl_xor(v, 8); return v; }
__device__ __forceinline__ float grp8_sum(float v) { v += __shfl_xor(v, 1); v += __shfl_xor(v, 2); v += __shfl_xor(v, 4); return v; }
__device__ __forceinline__ float sum4(f32x4 a) { return (a.x + a.y) + (a.z + a.w); }
__device__ __forceinline__ float dot4(f32x4 a, f32x4 b) { return (a.x * b.x + a.y * b.y) + (a.z * b.z + a.w * b.w); }
__device__ __forceinline__ float fexp(float x) { return __builtin_amdgcn_exp2f(x * 1.4426950408889634f); }
__device__ __forceinline__ float sigm(float x) { return __builtin_amdgcn_rcpf(1.0f + fexp(-x)); }
__device__ __forceinline__ float softplusf(float x) { return fmaxf(x, 0.0f) + 0.6931471805599453f * __builtin_amdgcn_logf(1.0f + fexp(-fabsf(x))); }
__device__ __forceinline__ float ftanh(float x) { const float e = fexp(-2.0f * fabsf(x)); const float t = (1.0f - e) * __builtin_amdgcn_rcpf(1.0f + e); return x < 0.0f ? -t : t; }
__device__ __forceinline__ f32x4 shx4(f32x4 v, int m) { f32x4 r; r.x = __shfl_xor(v.x, m); r.y = __shfl_xor(v.y, m); r.z = __shfl_xor(v.z, m); r.w = __shfl_xor(v.w, m); return r; }

#define XB_TMO      128
#define XB_XCNT(j)  (256  + 64 * (j))
#define XB_XSUB(j)  (1280 + 64 * (j))
#define XB_XGEN(j)  (2304 + 64 * (j))
#define XB_TOP      3328
#define XB_TOPGEN   3392
#define XCD_BAR_WORDS 3456
#define XB_SPIN_CAP (1u << 18)

__device__ __forceinline__ unsigned xb_ld(unsigned* p)              { return __hip_atomic_load(p, __ATOMIC_RELAXED, __HIP_MEMORY_SCOPE_AGENT); }
__device__ __forceinline__ unsigned xb_add(unsigned* p, unsigned v) { return __hip_atomic_fetch_add(p, v, __ATOMIC_RELAXED, __HIP_MEMORY_SCOPE_AGENT); }
__device__ __forceinline__ unsigned xb_xcc_id() { return (unsigned)__builtin_amdgcn_s_getreg((3 << 11) | 20) & 0xFu; }
#define XB_SPIN(cond, bar) do { unsigned _sp = 0; while (cond) { __builtin_amdgcn_s_sleep(1); \
    if ((++_sp & 255u) == 0u) { if (xb_ld(&(bar)[XB_TMO])) break; if (_sp > XB_SPIN_CAP) { atomicAdd(&(bar)[XB_TMO], 1u); break; } } } } while (0)

struct XcdBarrier {
    unsigned* bar; unsigned x;
    volatile LAS unsigned* st;
};

__device__ __forceinline__ XcdBarrier xcd_barrier_post(unsigned* bar, volatile LAS unsigned* st, int xb_tid) {
    XcdBarrier b; b.bar = bar; b.x = xb_xcc_id(); b.st = st;
    if (xb_tid == 0) (void)xb_add(&bar[XB_XCNT(b.x)], 1u);
    return b;
}
__device__ __forceinline__ void xcd_barrier_complete(unsigned* bar, unsigned x, unsigned& nloc, unsigned& nx) {
    const unsigned G = gridDim.x * gridDim.y * gridDim.z;
    unsigned sum, cnt, mine, sp = 0u;
    for (;;) {
        sum = 0u; cnt = 0u; mine = 0u;
#pragma unroll
        for (unsigned j = 0; j < 16; ++j) { const unsigned c = xb_ld(&bar[XB_XCNT(j)]); sum += c; cnt += (c > 0u) ? 1u : 0u; mine = (j == x) ? c : mine; }
        if (sum == G) break;
        __builtin_amdgcn_s_sleep(1);
        if ((++sp & 255u) == 0u) { if (xb_ld(&bar[XB_TMO])) break; if (sp > XB_SPIN_CAP) { atomicAdd(&bar[XB_TMO], 1u); break; } }
    }
    nloc = mine > 0u ? mine : 1u; nx = cnt > 0u ? cnt : 1u;
}

__device__ __forceinline__ void xcd_barrier(const XcdBarrier& b, int xb_tid) {
    asm volatile("s_waitcnt vmcnt(0)" ::: "memory");
    __syncthreads();
    if (xb_tid == 0) {
        unsigned* bar = b.bar;
        __builtin_amdgcn_s_waitcnt(0);
        unsigned nloc = b.st[0], nx = b.st[1];
        if (nloc == 0u) { xcd_barrier_complete(bar, b.x, nloc, nx); b.st[0] = nloc; b.st[1] = nx; }
        const unsigned old = xb_add(&bar[XB_XSUB(b.x)], 1u);
        const unsigned gen = old / nloc;
        if (old + 1u == (gen + 1u) * nloc) {
            __builtin_amdgcn_fence(__ATOMIC_RELEASE, "agent");
            asm volatile("s_waitcnt vmcnt(0)" ::: "memory");
            const unsigned og = xb_add(&bar[XB_TOP], 1u);
            const unsigned tg = og / nx;
            if (og + 1u == (tg + 1u) * nx) xb_add(&bar[XB_TOPGEN], 1u);
            else XB_SPIN(xb_ld(&bar[XB_TOPGEN]) == tg, bar);
            __builtin_amdgcn_fence(__ATOMIC_ACQUIRE, "agent");
            xb_add(&bar[XB_XGEN(b.x)], 1u);
            asm volatile("s_waitcnt vmcnt(0)" ::: "memory");
        } else {
            XB_SPIN(xb_ld(&bar[XB_XGEN(b.x)]) == gen, bar);
            __builtin_amdgcn_fence(__ATOMIC_ACQUIRE, "agent");
            asm volatile("s_waitcnt vmcnt(0)" ::: "memory");
        }
    }
    __syncthreads();
}
struct ArgsH { const float* in[N_IN]; float* out; unsigned char* ws; double invf[44]; int ph_lo, ph_hi, li, pad; };
struct ArgsD { const GAS float* in[N_IN]; GAS float* out; GAS unsigned char* ws; double invf[44]; int ph_lo, ph_hi, li, pad; };
static_assert(sizeof(ArgsH) == sizeof(ArgsD), "args layout");
typedef const CAS ArgsD& ARef;
__device__ __forceinline__ const CAS ArgsD* kargs() {
#if defined(__HIP_DEVICE_COMPILE__)
    const CAS ArgsD* p = (const CAS ArgsD*)__builtin_amdgcn_kernarg_segment_ptr(); asm volatile("" : "+s"(p)); return p;
#else
    return nullptr;
#endif
}
struct WI { LAS unsigned char* lds; int tid, lane, wave, vcu, G, gw, NGW, bx; };
constexpr size_t RWA_STRIDE = (33 * MiB + 68 * 1024) / 4;
constexpr size_t YO_STRIDE = 32 * MiB / 4;

__device__ __forceinline__ int wave_sum_i(int v) {
#pragma unroll
    for (int o = 1; o < 64; o <<= 1) v += __shfl_xor(v, o);
    return v;
}
__device__ __forceinline__ void sincos_d(double ang, float& s, float& c) {
    const double q = __builtin_rint(ang * 0.63661977236758134308);
    double r = __builtin_fma(-q, 1.57079632679489661923, ang); r = __builtin_fma(-q, 6.123233995736766e-17, r);
    const double r2 = r * r;
    const double sp = r * (1.0 + r2 * (-1.0 / 6 + r2 * (1.0 / 120 + r2 * (-1.0 / 5040 + r2 * (1.0 / 362880 + r2 * (-1.0 / 39916800 + r2 * (1.0 / 6227020800.0)))))));
    const double cp = 1.0 + r2 * (-0.5 + r2 * (1.0 / 24 + r2 * (-1.0 / 720 + r2 * (1.0 / 40320 + r2 * (-1.0 / 3628800 + r2 * (1.0 / 479001600 + r2 * (-1.0 / 87178291200.0)))))));
    const int qi = ((int)q) & 3;
    const double ss = (qi == 0) ? sp : (qi == 1) ? cp : (qi == 2) ? -sp : -cp;
    const double cc = (qi == 0) ? cp : (qi == 1) ? -sp : (qi == 2) ? -cp : sp;
    s = (float)ss; c = (float)cc;
}

struct TrItem { const float* src; bf16* dst; int ldw; float scale; bool ok; };
__device__ __forceinline__ void tr_decode(ARef A, int it, int lane, TrItem& d) {
    constexpr int I_IN = NLAYER * 16 * 96, I_OUT = NLAYER * 16 * 32, I_W1 = NLAYER * NEXP * 16 * 64;
    const float* W; int ldw, nvalid, k0, nsrc0; bf16* WT; size_t dstrow0; float scale = 1.0f;
    int r = it;
    if (r < I_IN) { const int l = r / 1536, rr = r % 1536, kb = rr / 96, nb = rr % 96;
        const int nd = nb * 32;
        nsrc0 = (nd < 1024) ? nd : (nd < 1792) ? C_SB + (nd - 1024) : (nd < 2688) ? C_RW + (nd - 1792) : C_DSA + (nd - 2688);
        nvalid = (nd < 1024) ? 1024 : (nd < 1792) ? INC : (nd < 2688) ? C_DSA : ((nd < INC) ? C_SB : 0);
        scale = (nd >= 256 && nd < 512) ? 0.125f : (nd >= 1024 && nd < 1280) ? 0.18033688011112042f : 1.0f;
        W = A.in[I_WIN] + (size_t)l * DM * INC; ldw = INC; k0 = kb * 64; WT = (bf16*)(A.ws + WS_WIN) + (size_t)l * INCP * DM; dstrow0 = (size_t)nd; }
    else if (r < I_IN + I_OUT) { r -= I_IN; const int l = r / 512, rr = r % 512, kb = rr / 32, nb = rr % 32;
        W = A.in[I_WOUT] + (size_t)l * DM * DM; ldw = DM; nvalid = DM; k0 = kb * 64; nsrc0 = nb * 32; WT = (bf16*)(A.ws + WS_WOUT) + (size_t)l * DM * DM; dstrow0 = (size_t)nb * 32; }
    else if (r < I_IN + I_OUT + I_W1) { r -= I_IN + I_OUT; const int le = r / 1024, rr = r % 1024, kb = rr / 64, nb = rr % 64, j = nb >> 3, bj = (nb >> 2) & 1, cc0 = (nb & 3) * 32;
        W = A.in[I_MW1] + (size_t)le * DM * 2048; ldw = 2048; nvalid = 2048; k0 = kb * 64; nsrc0 = bj * 1024 + 128 * j + cc0; WT = (bf16*)(A.ws + WS_W1) + (size_t)le * 2048 * DM; dstrow0 = (size_t)nb * 32; }
    else { r -= I_IN + I_OUT + I_W1; const int le = r / 512, rr = r % 512, kb = rr / 32, nb = rr % 32;
        W = A.in[I_MW2] + (size_t)le * DM * DM; ldw = DM; nvalid = DM; k0 = kb * 64; nsrc0 = nb * 32; WT = (bf16*)(A.ws + WS_W2) + (size_t)le * DM * DM; dstrow0 = (size_t)nb * 32; }
    const int n = nsrc0 + 4 * (lane & 7);
    d.ok = n < nvalid; d.src = W + (size_t)(k0 + (lane >> 3)) * ldw + (d.ok ? n : 0); d.ldw = ldw; d.scale = scale;
    d.dst = WT + (dstrow0 + (lane >> 3)) * 1024 + k0 + 8 * (lane & 7);
}
__device__ __forceinline__ void tr_load(const TrItem& d, f32x4 (&v)[8]) {
#pragma unroll
    for (int i = 0; i < 8; ++i) v[i] = *(const f32x4*)(d.src + (size_t)(8 * i) * d.ldw);
}
__device__ __forceinline__ void tr_store(const TrItem& d, const f32x4 (&v)[8], LAS float* scr, int lane) {
    const float sc_ = d.ok ? d.scale : 0.0f;
#pragma unroll
    for (int i = 0; i < 8; ++i) { LAS float* s = scr + (8 * i + (lane >> 3)) * 33 + 4 * (lane & 7); s[0] = v[i].x * sc_; s[1] = v[i].y * sc_; s[2] = v[i].z * sc_; s[3] = v[i].w * sc_; }
    LDS_WAIT(); asm volatile("" ::: "memory");
    const int c8 = lane & 7;
#pragma unroll
    for (int j = 0; j < 4; ++j) { const int n = (lane >> 3) + 8 * j; const LAS float* s = scr + (8 * c8) * 33 + n;
        v4u o; o.x = pk2(s[0 * 33], s[1 * 33]); o.y = pk2(s[2 * 33], s[3 * 33]); o.z = pk2(s[4 * 33], s[5 * 33]); o.w = pk2(s[6 * 33], s[7 * 33]);
        *(v4u*)(d.dst + (size_t)(8 * j) * 1024) = o; }
    LDS_WAIT(); asm volatile("" ::: "memory");
}
__device__ __forceinline__ void ph_prologue(ARef A, const WI& w) {
    LAS float* sc = (LAS float*)w.lds;
    { const float* cin = A.in[I_C]; for (int i = w.tid; i < NB * DM; i += NWAVES * 64) { const float v = cin[i]; sc[i] = v / (1.0f + expf(-v)); } }
    __syncthreads();
    float* MOD = (float*)(A.ws + WS_MOD);
    LAS float* red = (LAS float*)(w.lds + 32768);
    if (w.vcu < 192) {
        const int l = w.vcu / 96, col = (w.vcu % 96) * 64 + w.lane, kw = 128 * w.wave;
        const float* wp = A.in[I_ADAW] + (size_t)l * DM * 6144 + (size_t)kw * 6144 + col;
        float acc[8];
#pragma unroll
        for (int b = 0; b < 8; ++b) acc[b] = 0.0f;
#pragma unroll 16
        for (int k = 0; k < 128; ++k) { const float wv = wp[(size_t)k * 6144];
#pragma unroll
            for (int b = 0; b < 8; ++b) acc[b] += sc[b * DM + kw + k] * wv; }
#pragma unroll
        for (int b = 0; b < 8; ++b) red[(w.wave * 8 + b) * 64 + w.lane] = acc[b];
    }
    __syncthreads();
    if (w.vcu < 192) { const int l = w.vcu / 96, b = w.wave, col = (w.vcu % 96) * 64 + w.lane;
        float s = A.in[I_ADAB][l * 6144 + col];
#pragma unroll
        for (int q = 0; q < 8; ++q) s += red[(q * 8 + b) * 64 + w.lane];
        MOD[(size_t)(l * 8 + b) * 6144 + col] = s; }
    __syncthreads();
    LAS float* scr = (LAS float*)(w.lds + 32768 + w.wave * 8448);
    constexpr int NIT = NLAYER * 16 * 96 + NLAYER * 16 * 32;
    { TrItem d0, d1; f32x4 va[8], vb[8];
      int it = w.gw; bool h0 = it < NIT;
      if (h0) { tr_decode(A, it, w.lane, d0); tr_load(d0, va); }
      while (h0) {
          it += w.NGW; const bool h1 = it < NIT;
          if (h1) { tr_decode(A, it, w.lane, d1); tr_load(d1, vb); }
          tr_store(d0, va, scr, w.lane);
          if (!h1) break;
          it += w.NGW; h0 = it < NIT;
          if (h0) { tr_decode(A, it, w.lane, d0); tr_load(d0, va); }
          tr_store(d1, vb, scr, w.lane);
      } }
    float* RT = (float*)(A.ws + WS_ROPE); const int* pos = (const int*)A.in[I_POS];
    for (int g = w.gw * 64 + w.lane; g < MTOK * 44; g += w.NGW * 64) {
        const int tok = g / 44, f = g % 44; int co, so;
        if (f < 32) { co = f; so = 32 + f; } else if (f < 40) { co = 64 + (f - 32); so = 72 + (f - 32); } else { co = 80 + (f - 40); so = 84 + (f - 40); }
        float s, c; sincos_d((double)pos[tok] * A.invf[f], s, c);
        RT[(size_t)tok * ROPE_W + co] = c; RT[(size_t)tok * ROPE_W + so] = s;
    }
}

__device__ __forceinline__ void moe_convert_chunk(ARef A, int l, int c, int lane, LAS float* scr) {
    constexpr int I0 = NLAYER * 16 * 96 + NLAYER * 16 * 32, I_W1 = NLAYER * NEXP * 16 * 64;
    const int it0 = (c < 8192) ? I0 + l * 32768 + 4 * c : I0 + I_W1 + l * 16384 + 4 * (c - 8192);
    TrItem d0, d1; f32x4 va[8], vb[8];
    tr_decode(A, it0, lane, d0); tr_load(d0, va);
    tr_decode(A, it0 + 1, lane, d1); tr_load(d1, vb);
    tr_store(d0, va, scr, lane);
    tr_decode(A, it0 + 2, lane, d0); tr_load(d0, va);
    tr_store(d1, vb, scr, lane);
    tr_decode(A, it0 + 3, lane, d1); tr_load(d1, vb);
    tr_store(d0, va, scr, lane);
    tr_store(d1, vb, scr, lane);
}

__device__ __forceinline__ void emit_h_row(const f32x4 (&v)[4], float rstd, const float* g, const float* sc, const float* sh, bf16* hrow, int lane) {
#pragma unroll
    for (int j = 0; j < 4; ++j) { const int k = 4 * (lane + 64 * j);
        const f32x4 gv = *(const f32x4*)(g + k), scv = *(const f32x4*)(sc + k), shv = *(const f32x4*)(sh + k);
        const f32x4 h = v[j] * rstd * gv * (1.0f + scv) + shv;
        v2u o; o.x = pk2(h.x, h.y); o.y = pk2(h.z, h.w); *(v2u*)(hrow + k) = o; }
}
__device__ __forceinline__ void small_weights_to_f16(ARef A, const WI& w) {
    { _Float16* SW = (_Float16*)(A.ws + WS_SMALLW);
      const int g0 = w.gw * 64 + w.lane, gs = w.NGW * 64;
      for (int l = 0; l < NLAYER; ++l) { _Float16* S = SW + (size_t)l * SMW_LAYER;
          const float* wq = A.in[I_WQ] + (size_t)l * 128 * 256; const float* wqi = A.in[I_WQI] + (size_t)l * 128 * 256;
          for (int e = g0; e < 256 * 128; e += gs) { const int n = e >> 7, k = e & 127; S[SMW_QI + e] = (_Float16)wq[k * 256 + n]; S[SMW_QI + 256 * 128 + e] = (_Float16)wqi[k * 256 + n]; }
          const float* w2 = A.in[I_W2] + (size_t)l * 32 * 256; const float* a2 = A.in[I_A2] + (size_t)l * 32 * 256; const float* g2 = A.in[I_G2] + (size_t)l * 64 * 256;
          for (int e = g0; e < 256 * 32; e += gs) { const int n = e >> 5, k = e & 31; S[SMW_W2 + e] = (_Float16)w2[k * 256 + n]; S[SMW_A2 + e] = (_Float16)a2[k * 256 + n]; }
          for (int e = g0; e < 256 * 64; e += gs) { const int n = e >> 6, k = e & 63; S[SMW_G2 + e] = (_Float16)g2[k * 256 + n]; } } }
}
__device__ __forceinline__ void ph_norm1(ARef A, const WI& w) {
    const float* MOD = (const float*)(A.ws + WS_MOD); bf16* H = (bf16*)(A.ws + WS_H);
    for (int m = w.gw; m < MTOK; m += w.NGW) {
        const float* xr = A.in[I_X] + (size_t)m * DM; f32x4 v[4]; float ss = 0.0f;
#pragma unroll
        for (int j = 0; j < 4; ++j) { v[j] = *(const f32x4*)(xr + 4 * (w.lane + 64 * j)); ss += dot4(v[j], v[j]); }
        ss = wave_sum(ss); const float rstd = 1.0f / sqrtf(ss * (1.0f / DM) + 1e-5f);
        const float* mb = MOD + (size_t)(m >> 12) * 6144;
        emit_h_row(v, rstd, A.in[I_NMIX], mb + 1024, mb, H + (size_t)m * DM, w.lane);
    }
}

typedef _Float16 h4v __attribute__((ext_vector_type(4)));
__device__ __forceinline__ f16x8 pack_f16x8(f32x4 a, f32x4 b) { f16x8 r; r[0] = (_Float16)a.x; r[1] = (_Float16)a.y; r[2] = (_Float16)a.z; r[3] = (_Float16)a.w; r[4] = (_Float16)b.x; r[5] = (_Float16)b.y; r[6] = (_Float16)b.z; r[7] = (_Float16)b.w; return r; }
__device__ __forceinline__ void prep16_body(const float* __restrict__ P, float* __restrict__ RWA, const _Float16* __restrict__ SW, const float* __restrict__ RT, bf16* __restrict__ DQ, _Float16* __restrict__ DQI,
                                            bf16* __restrict__ DKB, bf16* __restrict__ DVB, _Float16* __restrict__ DKI, float* __restrict__ DW, const float* __restrict__ mu, const float* __restrict__ qn,
                                            const float* __restrict__ w0p, const float* __restrict__ a0p, const float* __restrict__ kkp, const float* __restrict__ kap, const float* __restrict__ rkp, int m0, int lane_in, int part = 7) {
    int lane = lane_in; asm volatile("" : "+v"(lane));
    const int tk = lane & 15, q4 = lane >> 4, m = m0 + tk, t = m & (SEQ - 1);
    const float* pr = P + (size_t)m * PFW; const float* pp = pr - PFW; const float* pd = P + (size_t)m * PFW + PF_DSA;
    RT += (size_t)m * ROPE_W; const f32x4 zero4 = {0.f, 0.f, 0.f, 0.f};
    f16x8 bx[4], bc[4];
    { float ss = 0.0f; f32x4 c[4][2];
#pragma unroll
      for (int ks = 0; ks < 4; ++ks) { const int f0 = 32 * ks + 8 * q4;
          f32x4 x[2];
#pragma unroll
          for (int u = 0; u < 2; ++u) { const f32x4 z = *(const f32x4*)(pr + 768 + f0 + 4 * u); const f32x4 p = t ? *(const f32x4*)(pp + 768 + f0 + 4 * u) : zero4; x[u] = z + (p - z) * *(const f32x4*)(mu + 768 + f0 + 4 * u);
#pragma unroll
              for (int i = 0; i < 4; ++i) x[u][i] = (ks == 0) ? ftanh(x[u][i]) : (ks == 1) ? x[u][i] : sigm(x[u][i]); }
          bx[ks] = pack_f16x8(x[0], x[1]);
          c[ks][0] = *(const f32x4*)(pd + f0); c[ks][1] = *(const f32x4*)(pd + f0 + 4); ss += dot4(c[ks][0], c[ks][0]) + dot4(c[ks][1], c[ks][1]); }
      ss += __shfl_xor(ss, 16); ss += __shfl_xor(ss, 32);
      const float rstd = 1.0f / sqrtf(ss * (1.0f / 128.0f) + 1e-5f);
#pragma unroll
      for (int ks = 0; ks < 4; ++ks) { const int f0 = 32 * ks + 8 * q4; bc[ks] = pack_f16x8(c[ks][0] * rstd * *(const f32x4*)(qn + f0), c[ks][1] * rstd * *(const f32x4*)(qn + f0 + 4)); } }
    const _Float16* wrow = SW + (size_t)tk * 0;
    (void)wrow;
    const int arow = lane & 15;
    if (part & 1)
#pragma unroll 2
    for (int hd = 0; hd < 4; ++hd) {
        f32x4 fk[4], av[4]; float ssk = 0.0f;
#pragma unroll
        for (int j = 0; j < 4; ++j) { const int nb = 4 * hd + j, ch = 16 * nb + 4 * q4; const size_t o = (size_t)m * 256 + ch;
            const f16x8 aw = *(const f16x8*)(SW + SMW_W2 + (16 * nb + arow) * 32 + 8 * q4), aa = *(const f16x8*)(SW + SMW_A2 + (16 * nb + arow) * 32 + 8 * q4);
            const f16x8 ag0 = *(const f16x8*)(SW + SMW_G2 + (16 * nb + arow) * 64 + 8 * q4), ag1 = *(const f16x8*)(SW + SMW_G2 + (16 * nb + arow) * 64 + 32 + 8 * q4);
            const f32x4 cw = __builtin_amdgcn_mfma_f32_16x16x32_f16(aw, bx[0], *(const f32x4*)(w0p + ch), 0, 0, 0);
            const f32x4 ca = __builtin_amdgcn_mfma_f32_16x16x32_f16(aa, bx[1], *(const f32x4*)(a0p + ch), 0, 0, 0);
            f32x4 cg = __builtin_amdgcn_mfma_f32_16x16x32_f16(ag0, bx[2], zero4, 0, 0, 0); cg = __builtin_amdgcn_mfma_f32_16x16x32_f16(ag1, bx[3], cg, 0, 0, 0);
            f32x4 dec;
#pragma unroll
            for (int i = 0; i < 4; ++i) { dec[i] = fexp(-fexp(-softplusf(-cw[i]) - 0.5f)); av[j][i] = sigm(ca[i]); }
            *(f32x4*)(RWA + 1 * RWA_STRIDE + o) = dec; *(f32x4*)(RWA + 6 * RWA_STRIDE + o) = cg;
            { const f32x4 z = *(const f32x4*)(pr + 256 + ch); const f32x4 p = t ? *(const f32x4*)(pp + 256 + ch) : zero4; fk[j] = z + (p - z) * *(const f32x4*)(mu + 256 + ch); }
            const f32x4 kk = fk[j] * *(const f32x4*)(kkp + ch); ssk += dot4(kk, kk); }
        ssk += __shfl_xor(ssk, 16); ssk += __shfl_xor(ssk, 32);
        const float inrm = 1.0f / fmaxf(sqrtf(ssk), 1e-12f);
        f32x4 fr[4], km[4]; float bs = 0.0f;
#pragma unroll
        for (int j = 0; j < 4; ++j) { const int ch = 16 * (4 * hd + j) + 4 * q4;
            { const f32x4 z = *(const f32x4*)(pr + ch); const f32x4 p = t ? *(const f32x4*)(pp + ch) : zero4; fr[j] = z + (p - z) * *(const f32x4*)(mu + ch); }
            km[j] = fk[j] * (1.0f + (av[j] - 1.0f) * *(const f32x4*)(kap + ch)); bs += dot4(fr[j] * km[j], *(const f32x4*)(rkp + ch)); }
        bs += __shfl_xor(bs, 16); bs += __shfl_xor(bs, 32);
#pragma unroll
        for (int j = 0; j < 4; ++j) { const int ch = 16 * (4 * hd + j) + 4 * q4; const size_t o = (size_t)m * 256 + ch;
            f32x4 fv; { const f32x4 z = *(const f32x4*)(pr + 512 + ch); const f32x4 p = t ? *(const f32x4*)(pp + 512 + ch) : zero4; fv = z + (p - z) * *(const f32x4*)(mu + 512 + ch); }
            const f32x4 kk = fk[j] * *(const f32x4*)(kkp + ch) * inrm;
            *(f32x4*)(RWA + 0 * RWA_STRIDE + o) = fr[j]; *(f32x4*)(RWA + 2 * RWA_STRIDE + o) = km[j]; *(f32x4*)(RWA + 3 * RWA_STRIDE + o) = fv;
            *(f32x4*)(RWA + 4 * RWA_STRIDE + o) = -kk; *(f32x4*)(RWA + 5 * RWA_STRIDE + o) = kk * av[j]; *(f32x4*)(RWA + 7 * RWA_STRIDE + o) = bs * fv; }
    }
    if (part & 2)
#pragma unroll 4
    for (int nb = 0; nb < 32; ++nb) {
        f32x4 cq = zero4;
#pragma unroll
        for (int ks = 0; ks < 4; ++ks) { const f16x8 aq = *(const f16x8*)(SW + SMW_QI + (16 * nb + arow) * 128 + 32 * ks + 8 * q4); cq = __builtin_amdgcn_mfma_f32_16x16x32_f16(aq, bc[ks], cq, 0, 0, 0); }
        const int ch = 16 * (nb & 15) + 4 * q4;
        if (nb < 16) {
            if ((nb & 3) == 0) { const f32x4 ot = shx4(cq, 32); const int fi = 4 * (q4 & 1); const f32x4 cs4 = *(const f32x4*)(RT + 64 + fi), sn = *(const f32x4*)(RT + 72 + fi); cq = (q4 < 2) ? cq * cs4 - ot * sn : ot * sn + cq * cs4; }
            const f32x4 qs = cq * 0.18033688011112042f; v2u o; o.x = pk2(qs.x, qs.y); o.y = pk2(qs.z, qs.w); *(v2u*)(DQ + (size_t)m * 256 + ch) = o;
        } else {
            if ((nb & 1) == 0) { const f32x4 ot = shx4(cq, 16); const f32x4 cs4 = *(const f32x4*)(RT + 80), sn = *(const f32x4*)(RT + 84); if (q4 < 2) cq = (q4 < 1) ? cq * cs4 - ot * sn : ot * sn + cq * cs4; }
            h4v hq; hq.x = (_Float16)cq.x; hq.y = (_Float16)cq.y; hq.z = (_Float16)cq.z; hq.w = (_Float16)cq.w; *(h4v*)(DQI + (size_t)m * 256 + ch) = hq;
        }
    }
#pragma unroll
    for (int j = 0; j < 4; ++j) { const int d = 16 * j + 4 * q4; f32x4 kx = *(const f32x4*)(pd + 128 + d);
        if (j == 0) { const f32x4 ot = shx4(kx, 32); const int fi = 4 * (q4 & 1); const f32x4 cs4 = *(const f32x4*)(RT + 64 + fi), sn = *(const f32x4*)(RT + 72 + fi); kx = (q4 < 2) ? kx * cs4 - ot * sn : ot * sn + kx * cs4; }
        v2u o; o.x = pk2(kx.x, kx.y); o.y = pk2(kx.z, kx.w); *(v2u*)(DKB + (size_t)m * 64 + d) = o;
        const f32x4 vx = *(const f32x4*)(pd + 192 + d); v2u ov; ov.x = pk2(vx.x, vx.y); ov.y = pk2(vx.z, vx.w); *(v2u*)(DVB + (size_t)m * 64 + d) = ov; }
#pragma unroll
    for (int j = 0; j < 2; ++j) { const int d = 16 * j + 4 * q4; f32x4 ki = *(const f32x4*)(pd + 256 + d);
        if (j == 0) { const f32x4 ot = shx4(ki, 16); const f32x4 cs4 = *(const f32x4*)(RT + 80), sn = *(const f32x4*)(RT + 84); if (q4 < 2) ki = (q4 < 1) ? ki * cs4 - ot * sn : ot * sn + ki * cs4; }
        h4v hk; hk.x = (_Float16)ki.x; hk.y = (_Float16)ki.y; hk.z = (_Float16)ki.z; hk.w = (_Float16)ki.w; *(h4v*)(DKI + (size_t)m * 32 + d) = hk; }
    if (q4 < 2) *(f32x4*)(DW + (size_t)m * 8 + 4 * q4) = *(const f32x4*)(pd + 288 + 4 * q4) * 0.0625f;
}

__device__ __forceinline__ void prep16(ARef A, int l, int m0, int lane_in, int part = 7) {
    prep16_body((const float*)(A.ws + WS_PF), (float*)(A.ws + WS_RWA), (const _Float16*)(A.ws + WS_SMALLW) + (size_t)l * SMW_LAYER, (const float*)(A.ws + WS_ROPE), (bf16*)(A.ws + WS_DQ), (_Float16*)(A.ws + WS_DQI),
                (bf16*)(A.ws + WS_DKB), (bf16*)(A.ws + WS_DVB), (_Float16*)(A.ws + WS_DKI), (float*)(A.ws + WS_DW), A.in[I_MU] + l * 896, A.in[I_QNORM] + l * 128,
                A.in[I_W0] + l * 256, A.in[I_A0] + l * 256, A.in[I_KK] + l * 256, A.in[I_KA] + l * 256, A.in[I_RK] + l * 256, m0, lane_in, part);
}
__device__ __forceinline__ float quad_sum(float v) {
    v += __builtin_bit_cast(float, __builtin_amdgcn_mov_dpp(__builtin_bit_cast(int, v), 0xB1, 0xF, 0xF, true));
    v += __builtin_bit_cast(float, __builtin_amdgcn_mov_dpp(__builtin_bit_cast(int, v), 0x4E, 0xF, 0xF, true));
    return v;
}
__device__ __forceinline__ float oct_sum(float v) {
    v += __builtin_bit_cast(float, __builtin_amdgcn_mov_dpp(__builtin_bit_cast(int, v), 0xB1, 0xF, 0xF, true));
    v += __builtin_bit_cast(float, __builtin_amdgcn_mov_dpp(__builtin_bit_cast(int, v), 0x4E, 0xF, 0xF, true));
    v += __builtin_bit_cast(float, __builtin_amdgcn_mov_dpp(__builtin_bit_cast(int, v), 0x141, 0xF, 0xF, true));
    return v;
}
typedef float f32x2 __attribute__((ext_vector_type(2)));
#define LO2(v_) __builtin_shufflevector(v_, v_, 0, 1)
#define HI2(v_) __builtin_shufflevector(v_, v_, 2, 3)
#define RW_ROW(i_) (((i_) < 2) ? (16 * ws + rg + 8 * (i_)) : (64 + 16 * ws + rg + 8 * ((i_) - 2)))
#define RW_LOAD(op, s_) do { const int lo_ = (s_) * 64 + kq * 8; \
    op[0] = *(const LAS f32x4*)(sn + lo_); op[1] = *(const LAS f32x4*)(sn + lo_ + 4); op[2] = *(const LAS f32x4*)(sw + lo_); op[3] = *(const LAS f32x4*)(sw + lo_ + 4); \
    op[4] = *(const LAS f32x4*)(sb + lo_); op[5] = *(const LAS f32x4*)(sb + lo_ + 4); op[6] = *(const LAS f32x4*)(sk + lo_); op[7] = *(const LAS f32x4*)(sk + lo_ + 4); \
    op[8] = *(const LAS f32x4*)(sr + lo_); op[9] = *(const LAS f32x4*)(sr + lo_ + 4); \
    vin[0] = sv[(s_) * 64 + 16 * ws + rg]; vin[1] = sv[(s_) * 64 + 16 * ws + rg + 8]; } while (0)
#define RW_DOT(i_, oa, ob) ({ f32x2 d_ = S[i_][0] * LO2(oa); d_ = S[i_][1] * HI2(oa) + d_; d_ = S[i_][2] * LO2(ob) + d_; d_ = S[i_][3] * HI2(ob) + d_; d_.x + d_.y; })
#define RW_STEP(op, vv, s_) do { float sa_[4], y_[4]; \
    _Pragma("unroll") for (int i_ = 0; i_ < 4; ++i_) sa_[i_] = RW_DOT(i_, op[0], op[1]); \
    _Pragma("unroll") for (int i_ = 0; i_ < 4; ++i_) sa_[i_] += __builtin_bit_cast(float, __builtin_amdgcn_mov_dpp(__builtin_bit_cast(int, sa_[i_]), 0xB1, 0xF, 0xF, true)); \
    _Pragma("unroll") for (int i_ = 0; i_ < 4; ++i_) sa_[i_] += __builtin_bit_cast(float, __builtin_amdgcn_mov_dpp(__builtin_bit_cast(int, sa_[i_]), 0x4E, 0xF, 0xF, true)); \
    _Pragma("unroll") for (int i_ = 0; i_ < 4; ++i_) sa_[i_] += __builtin_bit_cast(float, __builtin_amdgcn_mov_dpp(__builtin_bit_cast(int, sa_[i_]), 0x141, 0xF, 0xF, true)); \
    _Pragma("unroll") for (int i_ = 0; i_ < 2; ++i_) { const f32x2 a2_ = {sa_[i_], sa_[i_]}, v2_ = {vv[i_], vv[i_]}; \
        S[i_][0] = S[i_][0] * LO2(op[2]) + (a2_ * LO2(op[4]) + v2_ * LO2(op[6])); S[i_][1] = S[i_][1] * HI2(op[2]) + (a2_ * HI2(op[4]) + v2_ * HI2(op[6])); \
        S[i_][2] = S[i_][2] * LO2(op[3]) + (a2_ * LO2(op[5]) + v2_ * LO2(op[7])); S[i_][3] = S[i_][3] * HI2(op[3]) + (a2_ * HI2(op[5]) + v2_ * HI2(op[7])); } \
    _Pragma("unroll") for (int i_ = 2; i_ < 4; ++i_) { const f32x2 a2_ = {sa_[i_], sa_[i_]}; \
        S[i_][0] = S[i_][0] * LO2(op[2]) + a2_ * LO2(op[4]); S[i_][1] = S[i_][1] * HI2(op[2]) + a2_ * HI2(op[4]); S[i_][2] = S[i_][2] * LO2(op[3]) + a2_ * LO2(op[5]); S[i_][3] = S[i_][3] * HI2(op[3]) + a2_ * HI2(op[5]); } \
    _Pragma("unroll") for (int i_ = 0; i_ < 4; ++i_) y_[i_] = RW_DOT(i_, op[8], op[9]); \
    _Pragma("unroll") for (int i_ = 0; i_ < 4; ++i_) y_[i_] += __builtin_bit_cast(float, __builtin_amdgcn_mov_dpp(__builtin_bit_cast(int, y_[i_]), 0xB1, 0xF, 0xF, true)); \
    _Pragma("unroll") for (int i_ = 0; i_ < 4; ++i_) y_[i_] += __builtin_bit_cast(float, __builtin_amdgcn_mov_dpp(__builtin_bit_cast(int, y_[i_]), 0x4E, 0xF, 0xF, true)); \
    _Pragma("unroll") for (int i_ = 0; i_ < 4; ++i_) y_[i_] += __builtin_bit_cast(float, __builtin_amdgcn_mov_dpp(__builtin_bit_cast(int, y_[i_]), 0x141, 0xF, 0xF, true)); \
    if (kq == 0) { _Pragma("unroll") for (int i_ = 0; i_ < 4; ++i_) so[(s_) * 128 + RW_ROW(i_)] = y_[i_]; } } while (0)
__device__ __forceinline__ void scan_rwkv_task2(ARef A, const WI& w, int task0) {
    const int slot = w.wave >> 2, ws = w.wave & 3, lt = w.tid & 255, task = task0 + slot;
    const int bh = task >> 4, c = task & 15, b = bh >> 2, h = bh & 3;
    LAS float* sw = (LAS float*)w.lds + slot * 16384; LAS float* sn = sw + 2048; LAS float* sb = sn + 2048; LAS float* sk = sb + 2048; LAS float* sr = sk + 2048; LAS float* sv = sr + 2048; LAS float* so = sv + 2048;
    const float* RWA = (const float*)(A.ws + WS_RWA);
    const int rg = w.lane >> 3, kq = w.lane & 7;
    f32x2 S[4][4];
#pragma unroll
    for (int i = 0; i < 4; ++i)
#pragma unroll
        for (int j = 0; j < 4; ++j) { const int r = RW_ROW(i); S[i][j].x = (r >= 64 && 8 * kq + 2 * j == r - 64) ? 1.0f : 0.0f; S[i][j].y = (r >= 64 && 8 * kq + 2 * j + 1 == r - 64) ? 1.0f : 0.0f; }
    const size_t tok0 = (size_t)b * SEQ + (size_t)c * TCH;
    const int st = lt >> 3, sd = (lt & 7) * 8;
    f32x4 a[6][2];
#define RW_GLOAD(sub_) do { const size_t o_ = (tok0 + (sub_) * 32 + st) * 256 + h * 64 + sd; \
        _Pragma("unroll") for (int q = 0; q < 2; ++q) { a[0][q] = *(const f32x4*)(RWA + 1 * RWA_STRIDE + o_ + 4 * q); a[1][q] = *(const f32x4*)(RWA + 4 * RWA_STRIDE + o_ + 4 * q); a[2][q] = *(const f32x4*)(RWA + 5 * RWA_STRIDE + o_ + 4 * q); \
            a[3][q] = *(const f32x4*)(RWA + 2 * RWA_STRIDE + o_ + 4 * q); a[4][q] = *(const f32x4*)(RWA + 0 * RWA_STRIDE + o_ + 4 * q); a[5][q] = *(const f32x4*)(RWA + 3 * RWA_STRIDE + o_ + 4 * q); } } while (0)
    RW_GLOAD(0);
    for (int sub = 0; sub < TCH / 32; ++sub) {
        __syncthreads();
        { const int lo = st * 64 + sd;
#pragma unroll
          for (int q = 0; q < 2; ++q) { *(LAS f32x4*)(sw + lo + 4 * q) = a[0][q]; *(LAS f32x4*)(sn + lo + 4 * q) = a[1][q]; *(LAS f32x4*)(sb + lo + 4 * q) = a[2][q]; *(LAS f32x4*)(sk + lo + 4 * q) = a[3][q]; *(LAS f32x4*)(sr + lo + 4 * q) = a[4][q]; *(LAS f32x4*)(sv + lo + 4 * q) = a[5][q]; } }
        __syncthreads();
        if (sub + 1 < TCH / 32) RW_GLOAD(sub + 1);
        { f32x4 opA[10], opB[10]; float vin[2], vA[2], vB[2];
          RW_LOAD(opA, 0);
          vA[0] = vin[0]; vA[1] = vin[1];
#pragma unroll 1
          for (int s = 0; s < 32; s += 2) {
              RW_LOAD(opB, s + 1);
              vB[0] = vin[0]; vB[1] = vin[1];
              RW_STEP(opA, vA, s);
              if (s + 2 < 32) { RW_LOAD(opA, s + 2); vA[0] = vin[0]; vA[1] = vin[1]; }
              RW_STEP(opB, vB, s + 1);
          } }
        __syncthreads();
        { const int fs = lt >> 3, c16 = (lt & 7) * 16;
          float* dst = (c16 < 64) ? ((float*)(A.ws + WS_YO) + YO_STRIDE) : ((float*)(A.ws + WS_PT) - 64);
          float* dp = dst + (tok0 + sub * 32 + fs) * 256 + h * 64 + c16;
#pragma unroll
          for (int q = 0; q < 4; ++q) *(f32x4*)(dp + 4 * q) = *(const LAS f32x4*)(so + fs * 128 + c16 + 4 * q); }
    }
    { float* ch = (float*)(A.ws + WS_CH) + ((size_t)(bh * NCH + c) * 128) * 64 + 8 * kq;
#pragma unroll
      for (int i = 0; i < 4; ++i) { float* cr = ch + (size_t)RW_ROW(i) * 64; *(f32x4*)cr = (f32x4){S[i][0].x, S[i][0].y, S[i][1].x, S[i][1].y}; *(f32x4*)(cr + 4) = (f32x4){S[i][2].x, S[i][2].y, S[i][3].x, S[i][3].y}; } }
    __syncthreads();
}
#undef RW_LOAD
#undef RW_STEP
#undef RW_GLOAD
#undef RW_DOT
#undef RW_ROW
__device__ __forceinline__ void scan_ret_task(ARef A, const WI& w, int task) {
    const int bh = task >> 3, cp = task & 7, b = bh >> 2, h = bh & 3, un = w.tid >> 8, lt = w.tid & 255, c = 2 * cp + un;
    const float lg2g = log2f(1.0f - exp2f(-5.0f - (float)h)), gamma = exp2f(lg2g);
    LAS float* sk = (LAS float*)w.lds + un * 8192; LAS float* sq = sk + 2048; LAS float* sv = sq + 2048; LAS float* so = sv + 2048;
    const bf16* PB = (const bf16*)(A.ws + WS_PB); const float* RT = (const float*)(A.ws + WS_ROPE);
    const int row = lt >> 2, kq = lt & 3;
    f32x2 S[8];
#pragma unroll
    for (int j = 0; j < 8; ++j) S[j] = (f32x2){0.0f, 0.0f};
    const f32x2 gam2 = {gamma, gamma};
    const size_t tok0 = (size_t)b * SEQ + (size_t)c * TCH;
    const int st = lt >> 3, sd = (lt & 7) * 8;
    const int fi = sd & 31, dp = sd ^ 32;
    f32x4 gq[2], gqo[2], gk[2], gko[2], gv[2], gcs[2], gsn[2];
#define BF8_TO_F32(dst, x_) do { dst[0] = (f32x4){bf_lo(x_.x), bf_hi(x_.x), bf_lo(x_.y), bf_hi(x_.y)}; dst[1] = (f32x4){bf_lo(x_.z), bf_hi(x_.z), bf_lo(x_.w), bf_hi(x_.w)}; } while (0)
#define RT_GLOAD(sub_) do { const size_t m_ = tok0 + (sub_) * 32 + st; const bf16* pr_ = PB + m_ * PBW + h * 64; const float* rt_ = RT + m_ * ROPE_W; \
        _Pragma("unroll") for (int u = 0; u < 2; ++u) { gcs[u] = *(const f32x4*)(rt_ + fi + 4 * u); gsn[u] = *(const f32x4*)(rt_ + 32 + fi + 4 * u); } \
        { const v4u x0 = *(const v4u*)(pr_ + sd), x1 = *(const v4u*)(pr_ + dp), x2 = *(const v4u*)(pr_ + 256 + sd), x3 = *(const v4u*)(pr_ + 256 + dp), x4 = *(const v4u*)(pr_ + 512 + sd); \
          BF8_TO_F32(gq, x0); BF8_TO_F32(gqo, x1); BF8_TO_F32(gk, x2); BF8_TO_F32(gko, x3); BF8_TO_F32(gv, x4); } } while (0)
    RT_GLOAD(0);
    for (int sub = 0; sub < TCH / 32; ++sub) {
        const size_t m = tok0 + sub * 32 + st;
        f32x4 qn[2], kn[2], vn[2];
#pragma unroll
        for (int u = 0; u < 2; ++u) { qn[u] = (sd < 32) ? gq[u] * gcs[u] - gqo[u] * gsn[u] : gqo[u] * gsn[u] + gq[u] * gcs[u]; kn[u] = (sd < 32) ? gk[u] * gcs[u] - gko[u] * gsn[u] : gko[u] * gsn[u] + gk[u] * gcs[u]; vn[u] = gv[u]; }
        { const float gt = exp2f(lg2g * (float)(sub * 32 + st + 1)); const f32x4 p0 = qn[0] * gt, p1 = qn[1] * gt;
          v4u pw; pw.x = pk2(p0.x, p0.y); pw.y = pk2(p0.z, p0.w); pw.z = pk2(p1.x, p1.y); pw.w = pk2(p1.z, p1.w); *(v4u*)((bf16*)(A.ws + WS_PTR) + m * 256 + h * 64 + sd) = pw; }
        __syncthreads();
        { const int lo = st * 64 + sd; *(LAS f32x4*)(sq + lo) = qn[0]; *(LAS f32x4*)(sq + lo + 4) = qn[1]; *(LAS f32x4*)(sk + lo) = kn[0]; *(LAS f32x4*)(sk + lo + 4) = kn[1]; *(LAS f32x4*)(sv + lo) = vn[0]; *(LAS f32x4*)(sv + lo + 4) = vn[1]; }
        __syncthreads();
        if (sub + 1 < TCH / 32) RT_GLOAD(sub + 1);
        for (int s = 0; s < 32; ++s) {
            const int lo = s * 64 + kq * 16; const float vv = sv[s * 64 + row]; const f32x2 v2 = {vv, vv}; f32x2 y2 = {0.0f, 0.0f};
#pragma unroll
            for (int j4 = 0; j4 < 4; ++j4) { const f32x4 kv = *(const LAS f32x4*)(sk + lo + 4 * j4), rv = *(const LAS f32x4*)(sq + lo + 4 * j4);
                S[2 * j4] = S[2 * j4] * gam2 + v2 * LO2(kv); S[2 * j4 + 1] = S[2 * j4 + 1] * gam2 + v2 * HI2(kv);
                y2 = S[2 * j4] * LO2(rv) + y2; y2 = S[2 * j4 + 1] * HI2(rv) + y2; }
            float y = quad_sum(y2.x + y2.y);
            if (kq == 0) so[s * 64 + row] = y;
        }
        __syncthreads();
        { const int fs = lt >> 3, c8 = (lt & 7) * 8; float* dp2 = (float*)(A.ws + WS_YO) + (tok0 + sub * 32 + fs) * 256 + h * 64 + c8;
          *(f32x4*)dp2 = *(const LAS f32x4*)(so + fs * 64 + c8); *(f32x4*)(dp2 + 4) = *(const LAS f32x4*)(so + fs * 64 + c8 + 4); }
    }
    { float* ch = (float*)(A.ws + WS_CHR) + ((size_t)(bh * NCH + c) * 64 + row) * 64 + 16 * kq;
#pragma unroll
      for (int j4 = 0; j4 < 4; ++j4) *(f32x4*)(ch + 4 * j4) = (f32x4){S[2 * j4].x, S[2 * j4].y, S[2 * j4 + 1].x, S[2 * j4 + 1].y}; }
    __syncthreads();
}
#undef RT_GLOAD
#undef BF8_TO_F32
__device__ __forceinline__ void prefix_chain(ARef A, const WI& w, int bh) {
    LAS float* s0 = (LAS float*)w.lds;
    const int v = w.tid >> 3, k8 = (w.tid & 7) * 8;
    const float* CH = (const float*)(A.ws + WS_CH) + (size_t)bh * NCH * 128 * 64; float* SI = (float*)(A.ws + WS_SI) + (size_t)bh * NCH * 64 * 64;
    f32x4 c0 = {0.f, 0.f, 0.f, 0.f}, c1 = {0.f, 0.f, 0.f, 0.f};
    for (int c = 0; c < NCH; ++c) {
        *(f32x4*)(SI + ((size_t)c * 64 + v) * 64 + k8) = c0; *(f32x4*)(SI + ((size_t)c * 64 + v) * 64 + k8 + 4) = c1;
        if (c == NCH - 1) break;
        __syncthreads();
        *(LAS f32x4*)(s0 + v * 68 + k8) = c0; *(LAS f32x4*)(s0 + v * 68 + k8 + 4) = c1;
        __syncthreads();
        const float* ch = CH + (size_t)c * 128 * 64;
        f32x4 n0 = *(const f32x4*)(ch + (size_t)v * 64 + k8), n1 = *(const f32x4*)(ch + (size_t)v * 64 + k8 + 4);
#pragma unroll 8
        for (int kp = 0; kp < 64; ++kp) { const float s = s0[v * 68 + kp]; const float* pr = ch + (size_t)(64 + kp) * 64 + k8; n0 += s * *(const f32x4*)pr; n1 += s * *(const f32x4*)(pr + 4); }
        c0 = n0; c1 = n1;
    }
    const int h = bh & 3; const float gT = exp2f((float)TCH * log2f(1.0f - exp2f(-5.0f - (float)h)));
    const float* CHR = (const float*)(A.ws + WS_CHR) + (size_t)bh * NCH * 64 * 64; float* SIR = (float*)(A.ws + WS_SIR) + (size_t)bh * NCH * 64 * 64;
    c0 = (f32x4){0.f, 0.f, 0.f, 0.f}; c1 = c0;
    for (int c = 0; c < NCH; ++c) {
        *(f32x4*)(SIR + ((size_t)c * 64 + v) * 64 + k8) = c0; *(f32x4*)(SIR + ((size_t)c * 64 + v) * 64 + k8 + 4) = c1;
        if (c == NCH - 1) break;
        c0 = c0 * gT + *(const f32x4*)(CHR + ((size_t)c * 64 + v) * 64 + k8); c1 = c1 * gT + *(const f32x4*)(CHR + ((size_t)c * 64 + v) * 64 + k8 + 4);
    }
    __syncthreads();
}
typedef float f32x16 __attribute__((ext_vector_type(16)));
constexpr int SBV_PITCH = 144;
__device__ __forceinline__ float lane32_swap(float v) { return __shfl_xor(v, 32); }
__device__ __forceinline__ void sb_tile_mfma(ARef A, int unit, int lane, LAS unsigned char* vl) {
    const int tq = unit & 127, bh = unit >> 7, b = bh >> 2, h = bh & 3, t0 = tq * 32, r32 = lane & 31, hi = lane >> 5;
    const bf16* PS = (const bf16*)(A.ws + WS_PB) + (size_t)b * SEQ * PBW + PB_SB + h * 64;
    bf16x8v qf[4];
#pragma unroll
    for (int ks = 0; ks < 4; ++ks) qf[ks] = *(const bf16x8v*)(PS + (size_t)(t0 + r32) * PBW + 16 * ks + 8 * hi);
    f32x16 o0, o1;
#pragma unroll
    for (int r = 0; r < 16; ++r) { o0[r] = 0.0f; o1[r] = 0.0f; }
    float carry = 0.0f;
    const int g16 = lane >> 4, tj = (lane & 15) >> 2, tc = lane & 3;
    v4u vn[4]; bf16x8v kn[4];
#define SB_FETCH(kb_) do { _Pragma("unroll") for (int i = 0; i < 4; ++i) { const int p = lane + 64 * i, row = p >> 3, ch = p & 7; vn[i] = *(const v4u*)(PS + 512 + (size_t)((kb_) + row) * PBW + 8 * ch); } \
        _Pragma("unroll") for (int ks = 0; ks < 4; ++ks) kn[ks] = *(const bf16x8v*)(PS + 256 + (size_t)((kb_) + r32) * PBW + 16 * ks + 8 * hi); } while (0)
    SB_FETCH(t0);
    for (int kb0 = t0; kb0 >= 0; kb0 -= 32) {
#pragma unroll
        for (int i = 0; i < 4; ++i) { const int p = lane + 64 * i, row = p >> 3, ch = p & 7; *(LAS v4u*)(vl + row * SBV_PITCH + 16 * ch) = vn[i]; }
        f32x16 st;
#pragma unroll
        for (int r = 0; r < 16; ++r) st[r] = 0.0f;
        { bf16x8v ka[4];
#pragma unroll
          for (int ks = 0; ks < 4; ++ks) ka[ks] = kn[ks];
          if (kb0 >= 32) SB_FETCH(kb0 - 32);
#pragma unroll
          for (int ks = 0; ks < 4; ++ks) st = __builtin_amdgcn_mfma_f32_32x32x16_bf16(ka[ks], qf[ks], st, 0, 0, 0);
          asm volatile("" :: "v"(ka[0]), "v"(ka[1]), "v"(ka[2]), "v"(ka[3]), "v"(st)); }
        float sp[16]; const bool diag = (kb0 == t0);
#pragma unroll
        for (int r = 0; r < 16; ++r) { const float zl = st[r]; float s = (zl > 30.0f) ? zl : __builtin_amdgcn_logf(1.0f + __builtin_amdgcn_exp2f(zl));
            if (diag && ((r & 3) + 8 * (r >> 2) + 4 * hi >= r32)) s = 0.0f;
            sp[r] = s; }
        float G[4], Gp[4], suf[4];
#pragma unroll
        for (int q = 0; q < 4; ++q) { G[q] = (sp[4 * q] + sp[4 * q + 1]) + (sp[4 * q + 2] + sp[4 * q + 3]); Gp[q] = lane32_swap(G[q]); }
        suf[3] = 0.0f; suf[2] = G[3] + Gp[3]; suf[1] = suf[2] + (G[2] + Gp[2]); suf[0] = suf[1] + (G[1] + Gp[1]);
        const float tot = suf[0] + (G[0] + Gp[0]);
        pg8::u32x4 pw0, pw1;
        float av[16];
#pragma unroll
        for (int q = 0; q < 4; ++q) { float run = carry + suf[q] + (hi == 0 ? Gp[q] : 0.0f);
#pragma unroll
            for (int i = 3; i >= 0; --i) { const int r = 4 * q + i; const float la = (st[r] - sp[r]) - run; float a = __builtin_amdgcn_exp2f(la);
                if (diag && ((r & 3) + 8 * (r >> 2) + 4 * hi >= r32)) a = 0.0f;
                av[r] = a; run += sp[r]; } }
        pw0.x = pg8::cvt_pk_bf16(av[0], av[1]); pw0.y = pg8::cvt_pk_bf16(av[2], av[3]); pw0.z = pg8::cvt_pk_bf16(av[4], av[5]); pw0.w = pg8::cvt_pk_bf16(av[6], av[7]);
        pw1.x = pg8::cvt_pk_bf16(av[8], av[9]); pw1.y = pg8::cvt_pk_bf16(av[10], av[11]); pw1.z = pg8::cvt_pk_bf16(av[12], av[13]); pw1.w = pg8::cvt_pk_bf16(av[14], av[15]);
        const bf16x8v pa0 = __builtin_bit_cast(bf16x8v, pw0), pa1 = __builtin_bit_cast(bf16x8v, pw1);
        LDS_WAIT();
#pragma unroll
        for (int s = 0; s < 2; ++s)
#pragma unroll
            for (int nb = 0; nb < 2; ++nb) {
                LAS unsigned char* a1 = vl + (16 * s + 4 * (g16 >> 1) + tj) * SBV_PITCH + (32 * nb + 16 * (g16 & 1) + 4 * tc) * 2;
                const s16x4v r1 = __builtin_bit_cast(s16x4v, __builtin_amdgcn_ds_read_tr16_b64_v4i16((LAS s16x4v*)a1));
                const s16x4v r2 = __builtin_bit_cast(s16x4v, __builtin_amdgcn_ds_read_tr16_b64_v4i16((LAS s16x4v*)(a1 + 8 * SBV_PITCH)));
                const bf16x8v bv = {r1[0], r1[1], r1[2], r1[3], r2[0], r2[1], r2[2], r2[3]};
                if (nb == 0) o0 = __builtin_amdgcn_mfma_f32_32x32x16_bf16(s ? pa1 : pa0, bv, o0, 0, 0, 0); else o1 = __builtin_amdgcn_mfma_f32_32x32x16_bf16(s ? pa1 : pa0, bv, o1, 0, 0, 0);
                asm volatile("" :: "v"(bv), "v"(pa0), "v"(pa1), "v"(o0), "v"(o1)); }
        LDS_WAIT();
        carry += tot;
        if (__all(carry > 150.0f)) break;
    }
#undef SB_FETCH
    float* YS = (float*)(A.ws + WS_YO) + 3 * YO_STRIDE + ((size_t)b * SEQ + t0) * 256 + h * 64 + r32;
#pragma unroll
    for (int r = 0; r < 16; ++r) { const int qo = (r & 3) + 8 * (r >> 2) + 4 * hi; YS[(size_t)qo * 256] = o0[r]; YS[(size_t)qo * 256 + 32] = o1[r]; }
}

__device__ __forceinline__ void dsa_scores_mfma(ARef A, const WI& w) {
    const _Float16* QIH = (const _Float16*)(A.ws + WS_DQI); const _Float16* KIH = (const _Float16*)(A.ws + WS_DKI);
    const float* DW = (const float*)(A.ws + WS_DW); float* SC = (float*)(A.ws + WS_SC);
    const int col = w.lane & 15, q4 = w.lane >> 4;
    for (int u = w.gw; u < 2048; u += w.NGW) {
        const int pi = u >> 1, par = u & 1, b = pi >> 7, p = pi & 127;
#pragma unroll 1
        for (int side = 0; side < 2; ++side) {
            const int qb = side ? 255 - p : p; const size_t m0 = (size_t)b * SEQ + 16 * qb;
            f16x8 bq[8];
#pragma unroll
            for (int h = 0; h < 8; ++h) bq[h] = *(const f16x8*)(QIH + (m0 + col) * 256 + h * 32 + 8 * q4);
            const float* dw = DW + (m0 + col) * 8; const f32x4 wa = *(const f32x4*)dw, wb = *(const f32x4*)(dw + 4);
            float* srow = SC + (m0 + col) * SEQ + 4 * q4;
            const _Float16* kbase = KIH + ((size_t)b * SEQ + col) * 32 + 8 * q4;
            for (int kp = par; 2 * kp <= qb; kp += 4) {
                f16x8 ak[4];
#pragma unroll
                for (int q = 0; q < 4; ++q) { const int kb = 2 * (kp + 2 * (q >> 1)) + (q & 1); ak[q] = *(const f16x8*)(kbase + (size_t)(kb <= qb ? kb : qb) * 16 * 32); }
#pragma unroll
                for (int q = 0; q < 4; ++q) { const int kb = 2 * (kp + 2 * (q >> 1)) + (q & 1);
                    if (kb <= qb) {
                        f32x4 acc = {0.f, 0.f, 0.f, 0.f};
#pragma unroll
                        for (int h = 0; h < 8; ++h) { const f32x4 c = __builtin_amdgcn_mfma_f32_16x16x32_f16(ak[q], bq[h], (f32x4){0.f, 0.f, 0.f, 0.f}, 0, 0, 0); const float wv = (h < 4) ? wa[h] : wb[h - 4];
                            acc.x += wv * fmaxf(c.x, 0.f); acc.y += wv * fmaxf(c.y, 0.f); acc.z += wv * fmaxf(c.z, 0.f); acc.w += wv * fmaxf(c.w, 0.f); }
                        *(f32x4*)(srow + 16 * kb) = acc + 0.0f; } }
            }
        }
    }
}

__device__ __forceinline__ int wave_total_i(int v) {
    v += __builtin_amdgcn_mov_dpp(v, 0xB1, 0xF, 0xF, true);
    v += __builtin_amdgcn_mov_dpp(v, 0x4E, 0xF, 0xF, true);
    v += __builtin_amdgcn_mov_dpp(v, 0x141, 0xF, 0xF, true);
    v += __builtin_amdgcn_mov_dpp(v, 0x140, 0xF, 0xF, true);
    return __builtin_amdgcn_readlane(v, 0) + __builtin_amdgcn_readlane(v, 16) + __builtin_amdgcn_readlane(v, 32) + __builtin_amdgcn_readlane(v, 48);
}
__device__ __forceinline__ unsigned score_key(float f) { const unsigned bits = __float_as_uint(f); return (bits & 0x80000000u) ? ~bits : (bits | 0x80000000u); }
constexpr int VST_PITCH = 144;
typedef unsigned short u16;
__device__ __forceinline__ void dsa_load_scores(ARef A, int m, int lane, f32x4 (&sv)[16]) {
    const int n = (m & (SEQ - 1)) + 1; const float* sc = (const float*)(A.ws + WS_SC) + (size_t)m * SEQ;
#pragma unroll
    for (int j4 = 0; j4 < 16; ++j4) sv[j4] = *(const f32x4*)(sc + ((256 * j4 < n) ? 256 * j4 : 0) + 4 * lane);
}
__device__ __forceinline__ void dsa_select(ARef A, int m, int n, int lane_in, LAS u16* slist, LAS unsigned* bk) {
    int lane = lane_in; asm volatile("" : "+v"(lane));
    if (n <= 256) {
#pragma unroll
        for (int c = 0; c < 4; ++c) { const int idx = lane + 64 * c; slist[idx] = (u16)((idx < n) ? idx : 0); }
        return;
    }
    f32x4 sv[16]; dsa_load_scores(A, m, lane, sv);
    unsigned u[64];
#pragma unroll
    for (int j4 = 0; j4 < 16; ++j4)
#pragma unroll
        for (int i = 0; i < 4; ++i) u[4 * j4 + i] = (256 * j4 + 4 * lane + i < n) ? score_key(sv[j4][i]) : 0u;
    unsigned T = 0u;
    for (int bit = 31; bit >= 16; --bit) { const unsigned cand = T | (1u << bit); int cnt = 0;
#pragma unroll
        for (int j = 0; j < 64; ++j) cnt += (u[j] >= cand) ? 1 : 0;
        if (wave_total_i(cnt) >= 256) T = cand; }
    unsigned long long bkb = 0ull; int chi = 0;
#pragma unroll
    for (int j = 0; j < 64; ++j) { bkb |= (unsigned long long)(((u[j] >> 16) == (T >> 16)) ? 1u : 0u) << j; chi += ((u[j] >> 16) > (T >> 16)) ? 1 : 0; }
    const int cb = wave_total_i(__popcll(bkb)), need = 256 - wave_total_i(chi);
    if (cb <= 64) {
        int pos = __popcll(bkb);
        { const int mine_ = pos;
#pragma unroll
          for (int d = 1; d < 64; d <<= 1) { const int y = __shfl_up(pos, d); if (lane >= d) pos += y; }
          pos -= mine_; }
#pragma unroll
        for (int j = 0; j < 64; ++j) { if ((bkb >> j) & 1ull) { bk[pos] = u[j]; ++pos; } }
        LDS_WAIT();
        const unsigned kx = (lane < cb) ? bk[lane] : 0u;
        for (int bit = 15; bit >= 0; --bit) { const unsigned cand = T | (1u << bit); if (__popcll(__ballot(kx >= cand)) >= need) T = cand; }
        LDS_WAIT();
    } else {
        for (int bit = 15; bit >= 0; --bit) { const unsigned cand = T | (1u << bit); int cnt = 0;
#pragma unroll
            for (int j = 0; j < 64; ++j) cnt += (u[j] >= cand) ? 1 : 0;
            if (wave_total_i(cnt) >= 256) T = cand; }
    }
    unsigned long long gtb = 0ull, eqb = 0ull;
#pragma unroll
    for (int j = 0; j < 64; ++j) { gtb |= (unsigned long long)((u[j] > T) ? 1u : 0u) << j; eqb |= (unsigned long long)((u[j] == T) ? 1u : 0u) << j; }
    const int tgt = wave_total_i(__popcll(gtb)), teq = wave_total_i(__popcll(eqb));
    unsigned long long selb = gtb | eqb;
    if (tgt + teq > 256) {
        const int take = 256 - tgt; int lo = 0;
        for (int bit = 11; bit >= 0; --bit) { const int cand = lo | (1 << bit); const int J4 = cand >> 8; int ni = (cand & 255) - 4 * lane; ni = ni < 0 ? 0 : (ni > 4 ? 4 : ni);
            const int jc = 4 * J4 + ni; const unsigned long long msk = (jc >= 64) ? ~0ull : ((1ull << jc) - 1ull);
            if (wave_total_i(__popcll(eqb & msk)) < take) lo = cand; }
        { const int cand = lo + 1; const int J4 = cand >> 8; int ni = (cand & 255) - 4 * lane; ni = ni < 0 ? 0 : (ni > 4 ? 4 : ni);
          const int jc = (cand >= SEQ) ? 64 : 4 * J4 + ni; const unsigned long long msk = (jc >= 64) ? ~0ull : ((1ull << jc) - 1ull); selb = gtb | (eqb & msk); }
    }
    const int mine = __popcll(selb); int off = mine;
#pragma unroll
    for (int d = 1; d < 64; d <<= 1) { const int y = __shfl_up(off, d); if (lane >= d) off += y; }
    off -= mine;
    while (selb) { const int j = __builtin_ctzll(selb); selb &= selb - 1ull; slist[off] = (u16)(256 * (j >> 2) + 4 * lane + (j & 3)); ++off; }
}
__device__ __forceinline__ void dsa_attend(ARef A, int m, int lane_in, const LAS u16* slist, LAS unsigned char* vbuf) {
    int lane = lane_in; asm volatile("" : "+v"(lane));
    const int b = m >> 12, t = m & (SEQ - 1), n = t + 1, nsel = n < 256 ? n : 256, col = lane & 15, q4 = lane >> 4;
    const bf16* DKB = (const bf16*)(A.ws + WS_DKB) + (size_t)b * SEQ * 64; const bf16* DVB = (const bf16*)(A.ws + WS_DVB) + (size_t)b * SEQ * 64;
    const int vrow = lane >> 3, vpc = lane & 7;
    bf16x8v bq0 = {0, 0, 0, 0, 0, 0, 0, 0}, bq1 = {0, 0, 0, 0, 0, 0, 0, 0};
    if (col < 4) { const bf16* qp = (const bf16*)(A.ws + WS_DQ) + (size_t)m * 256 + col * 64 + 8 * q4; bq0 = *(const bf16x8v*)qp; bq1 = *(const bf16x8v*)(qp + 32); }
    f32x4 lg[16];
#pragma unroll
    for (int hb = 0; hb < 2; ++hb) {
        bf16x8v a0[8], a1[8];
#pragma unroll
        for (int k = 0; k < 8; ++k) { const int s = slist[16 * (8 * hb + k) + col]; const bf16* kr = DKB + (size_t)s * 64 + 8 * q4; a0[k] = *(const bf16x8v*)kr; a1[k] = *(const bf16x8v*)(kr + 32); }
#pragma unroll
        for (int k = 0; k < 8; ++k) { const f32x4 c = __builtin_amdgcn_mfma_f32_16x16x32_bf16(a0[k], bq0, (f32x4){0.f, 0.f, 0.f, 0.f}, 0, 0, 0); lg[8 * hb + k] = __builtin_amdgcn_mfma_f32_16x16x32_bf16(a1[k], bq1, c, 0, 0, 0); }
        __builtin_amdgcn_sched_barrier(0);
    }
    if (nsel < 256) {
#pragma unroll
        for (int kb = 0; kb < 16; ++kb)
#pragma unroll
            for (int r = 0; r < 4; ++r) if (16 * kb + 4 * q4 + r >= nsel) lg[kb][r] = -INFINITY; }
    v4u vr[4];
#pragma unroll
    for (int i = 0; i < 4; ++i) { const int s = slist[vrow + 8 * i]; vr[i] = *(const v4u*)(DVB + (size_t)s * 64 + 8 * vpc); }
    float mx = -INFINITY;
#pragma unroll
    for (int kb = 0; kb < 16; ++kb) mx = fmaxf(fmaxf(mx, fmaxf(lg[kb].x, lg[kb].y)), fmaxf(lg[kb].z, lg[kb].w));
    mx = fmaxf(mx, __shfl_xor(mx, 16)); mx = fmaxf(mx, __shfl_xor(mx, 32));
    float sm = 0.f;
#pragma unroll
    for (int kb = 0; kb < 16; ++kb) { lg[kb].x = __builtin_amdgcn_exp2f(lg[kb].x - mx); lg[kb].y = __builtin_amdgcn_exp2f(lg[kb].y - mx); lg[kb].z = __builtin_amdgcn_exp2f(lg[kb].z - mx); lg[kb].w = __builtin_amdgcn_exp2f(lg[kb].w - mx); sm += (lg[kb].x + lg[kb].y) + (lg[kb].z + lg[kb].w); }
    sm += __shfl_xor(sm, 16); sm += __shfl_xor(sm, 32);
    const float inv = 1.0f / sm;
    bf16x8v pa[8];
#pragma unroll
    for (int i = 0; i < 8; ++i) { const f32x4 x = lg[2 * i] * inv, y = lg[2 * i + 1] * inv;
        pg8::u32x4 wv; wv.x = pg8::cvt_pk_bf16(x.x, x.y); wv.y = pg8::cvt_pk_bf16(x.z, x.w); wv.z = pg8::cvt_pk_bf16(y.x, y.y); wv.w = pg8::cvt_pk_bf16(y.z, y.w);
        pa[i] = __builtin_bit_cast(bf16x8v, wv); }
    f32x4 o[4];
#pragma unroll
    for (int nb = 0; nb < 4; ++nb) o[nb] = (f32x4){0.f, 0.f, 0.f, 0.f};
    const int tj = col >> 2, tc = col & 3;
#pragma unroll
    for (int c = 0; c < 8; ++c) {
        LAS unsigned char* vb = vbuf + (c & 1) * (32 * VST_PITCH);
#pragma unroll
        for (int i = 0; i < 4; ++i) *(LAS v4u*)(vb + (vrow + 8 * i) * VST_PITCH + 16 * vpc) = vr[i];
        if (c < 7) {
#pragma unroll
            for (int i = 0; i < 4; ++i) { const int s = slist[32 * (c + 1) + vrow + 8 * i]; vr[i] = *(const v4u*)(DVB + (size_t)s * 64 + 8 * vpc); } }
        LDS_WAIT();
#pragma unroll
        for (int nb = 0; nb < 4; ++nb) {
            LAS unsigned char* a1 = vb + (4 * q4 + tj) * VST_PITCH + (16 * nb + 4 * tc) * 2;
            const s16x4v r1 = __builtin_bit_cast(s16x4v, __builtin_amdgcn_ds_read_tr16_b64_v4i16((LAS s16x4v*)a1));
            const s16x4v r2 = __builtin_bit_cast(s16x4v, __builtin_amdgcn_ds_read_tr16_b64_v4i16((LAS s16x4v*)(a1 + 16 * VST_PITCH)));
            const bf16x8v bv = {r1[0], r1[1], r1[2], r1[3], r2[0], r2[1], r2[2], r2[3]};
            o[nb] = __builtin_amdgcn_mfma_f32_16x16x32_bf16(pa[c], bv, o[nb], 0, 0, 0); }
    }
    LDS_WAIT();
    if (lane < 16) { float* YD = (float*)(A.ws + WS_YO) + 2 * YO_STRIDE + (size_t)m * 256;
#pragma unroll
        for (int nb = 0; nb < 4; ++nb) { YD[16 * nb + lane] = o[nb].x; YD[64 + 16 * nb + lane] = o[nb].y; YD[128 + 16 * nb + lane] = o[nb].z; YD[192 + 16 * nb + lane] = o[nb].w; } }
}
constexpr int DSA_GR = 1;
__device__ __forceinline__ int dsa_row_of(int batch, int gi, int r) { const int idx = DSA_GR * gi + r, h = idx >> 1; return batch * SEQ + ((idx & 1) ? (SEQ - 1 - h) : h); }
__device__ __forceinline__ void dsa_wave(ARef A, const WI& w, LAS unsigned char* wl, int qi, int l) {
    LAS u16* lists = (LAS u16*)wl; LAS unsigned char* vbuf = wl + 4096; LAS unsigned* bk = (LAS unsigned*)vbuf;
#pragma unroll 1
    for (int kb = 0; kb < NB; ++kb) {
        const int batch = (w.bx + kb) & (NB - 1);
        unsigned* head = (unsigned*)(A.ws + WS_CTL) + CW_DSAQ + 128 * qi + 16 * batch;
        for (;;) {
            int g = 0; if (w.lane == 0) g = (int)atomicAdd(head, 1u);
            g = __builtin_amdgcn_readfirstlane(g);
            if (g >= 11 * (SEQ / 8)) break;
            const int per = g / 11, pos = g - 11 * per;
            if (pos >= 8) { moe_convert_chunk(A, l, batch * 1536 + 3 * per + (pos - 8), w.lane, (LAS float*)vbuf); continue; }
            const int gi = 8 * per + pos;
            { const int m = dsa_row_of(batch, gi, 0), n = (m & (SEQ - 1)) + 1; dsa_select(A, m, n, w.lane, lists, bk); }
            LDS_WAIT();
            dsa_attend(A, dsa_row_of(batch, gi, 0), w.lane, lists, vbuf);
        }
    }
}

__device__ __forceinline__ f32x4 head_norm4(f32x4 y, float eps, f32x4 g) {
    const float mean = grp16_sum(sum4(y)) * (1.0f / 64.0f); const f32x4 yc = y - mean;
    const float var = grp16_sum(dot4(yc, yc)) * (1.0f / 64.0f); return yc * (1.0f / sqrtf(var + eps)) * g;
}
template <bool BF> __device__ __forceinline__ f32x4 state_corr(const LAS float* sl, int hh, int r16, const void* pv) {
    const LAS float* r0 = sl + (hh * 64 + 4 * r16) * 64; const int x0 = (4 * r16) & 15;
    f32x4 out = {0.f, 0.f, 0.f, 0.f};
#pragma unroll 2
    for (int k8 = 0; k8 < 8; ++k8) {
        f32x4 pa, pb;
        if (BF) { const v4u x = ((const v4u*)pv)[k8]; pa = (f32x4){bf_lo(x.x), bf_hi(x.x), bf_lo(x.y), bf_hi(x.y)}; pb = (f32x4){bf_lo(x.z), bf_hi(x.z), bf_lo(x.w), bf_hi(x.w)}; }
        else { pa = ((const f32x4*)pv)[2 * k8]; pb = ((const f32x4*)pv)[2 * k8 + 1]; }
#pragma unroll
        for (int i = 0; i < 4; ++i) { const LAS float* rowp = r0 + i * 64; const int xs = (x0 + i) & 15;
            out[i] += dot4(*(const LAS f32x4*)(rowp + 4 * ((2 * k8) ^ xs)), pa) + dot4(*(const LAS f32x4*)(rowp + 4 * ((2 * k8 + 1) ^ xs)), pb); }
    }
    return out;
}
__device__ __forceinline__ void post_row(ARef A, int l, int m, int lane, const LAS float* slw, const LAS float* slr) {
    const float* YO = (const float*)(A.ws + WS_YO); const float* RWA = (const float*)(A.ws + WS_RWA);
    bf16* MX = (bf16*)(A.ws + WS_MIX) + (size_t)m * DM; const int c4 = 4 * lane, hh = lane >> 4, r16 = lane & 15; const size_t o = (size_t)m * 256 + c4;
    { f32x4 y = *(const f32x4*)(YO + o) + state_corr<true>(slr, hh, r16, (const bf16*)(A.ws + WS_PTR) + (size_t)m * 256 + hh * 64);
      y = head_norm4(y, 1e-5f, *(const f32x4*)(A.in[I_RETGN] + l * 256 + c4));
      const v2u gw_ = *(const v2u*)((const bf16*)(A.ws + WS_PB) + (size_t)m * PBW + 768 + c4); const f32x4 g = {bf_lo(gw_.x), bf_hi(gw_.x), bf_lo(gw_.y), bf_hi(gw_.y)};
#pragma unroll
      for (int i = 0; i < 4; ++i) y[i] *= g[i] * sigm(g[i]);
      v2u w; w.x = pk2(y.x, y.y); w.y = pk2(y.z, y.w); *(v2u*)(MX + c4) = w; }
    { f32x4 y = *(const f32x4*)(YO + YO_STRIDE + o) + state_corr<false>(slw, hh, r16, (const float*)(A.ws + WS_PT) + (size_t)m * 256 + hh * 64);
      y = head_norm4(y, 64e-5f, *(const f32x4*)(A.in[I_LN] + l * 256 + c4));
      y = (y + *(const f32x4*)(RWA + 7 * RWA_STRIDE + o)) * *(const f32x4*)(RWA + 6 * RWA_STRIDE + o);
      v2u w; w.x = pk2(y.x, y.y); w.y = pk2(y.z, y.w); *(v2u*)(MX + 256 + c4) = w; }
    { f32x4 y = *(const f32x4*)(YO + 2 * YO_STRIDE + o); const float r = 1.0f / sqrtf(wave_sum(dot4(y, y)) * (1.0f / 256.0f) + 1e-5f);
      y = y * r * *(const f32x4*)(A.in[I_DONORM] + l * 256 + c4);
      v2u w; w.x = pk2(y.x, y.y); w.y = pk2(y.z, y.w); *(v2u*)(MX + 512 + c4) = w; }
    { f32x4 y = *(const f32x4*)(YO + 3 * YO_STRIDE + o); const float r = 1.0f / sqrtf(wave_sum(dot4(y, y)) * (1.0f / 256.0f) + 1e-5f);
      y = y * r * *(const f32x4*)(A.in[I_SONORM] + l * 256 + c4);
      v2u w; w.x = pk2(y.x, y.y); w.y = pk2(y.z, y.w); *(v2u*)(MX + 768 + c4) = w; }
}
__device__ __forceinline__ void ph_post(ARef A, const WI& w, int l) {
    LAS float* slw = (LAS float*)w.lds; LAS float* slr = slw + 16384;
    for (int u = w.vcu; u < NB * NCH * 2; u += w.G) {
        const int b = u >> 5, c = (u >> 1) & 15, half = u & 1;
        __syncthreads();
        for (int e = w.tid; e < 4096; e += NWAVES * 64) { const int hh = e >> 10, v = (e >> 4) & 63, k4 = e & 15;
            const size_t src = ((size_t)((b * 4 + hh) * NCH + c) * 64 + v) * 64 + 4 * k4; const int dst = (hh * 64 + v) * 64 + 4 * (k4 ^ (v & 15));
            *(LAS f32x4*)(slw + dst) = *(const f32x4*)((const float*)(A.ws + WS_SI) + src); *(LAS f32x4*)(slr + dst) = *(const f32x4*)((const float*)(A.ws + WS_SIR) + src); }
        __syncthreads();
        const int tok0 = b * SEQ + c * TCH + half * 128 + w.wave * 16;
        for (int i = 0; i < 16; ++i) post_row(A, l, tok0 + i, w.lane, slw, slr);
    }
}

constexpr int S0_PITCH = 144;
template <int MIXER> __device__ __forceinline__ void post16_head(ARef A, int l, size_t m, int hh, int tk, int fq, const LAS unsigned char* s0) {
    const size_t o = m * 256 + hh * 64 + 8 * fq;
    bf16x8v pb[2];
    if (MIXER == 0) { const bf16* pp = (const bf16*)(A.ws + WS_PTR) + o; pb[0] = *(const bf16x8v*)pp; pb[1] = *(const bf16x8v*)(pp + 32); }
    else { const float* pp = (const float*)(A.ws + WS_PT) + o;
#pragma unroll
        for (int ks = 0; ks < 2; ++ks) { const f32x4 a = *(const f32x4*)(pp + 32 * ks), b = *(const f32x4*)(pp + 32 * ks + 4);
            pg8::u32x4 wv; wv.x = pg8::cvt_pk_bf16(a.x, a.y); wv.y = pg8::cvt_pk_bf16(a.z, a.w); wv.z = pg8::cvt_pk_bf16(b.x, b.y); wv.w = pg8::cvt_pk_bf16(b.z, b.w); pb[ks] = __builtin_bit_cast(bf16x8v, wv); } }
    f32x4 y[4];
    const float* yl = (const float*)(A.ws + WS_YO) + MIXER * YO_STRIDE + o;
#pragma unroll
    for (int mb = 0; mb < 4; ++mb) y[mb] = *(const f32x4*)(yl + 32 * (mb >> 1) + 4 * (mb & 1));
    const float* gw = ((MIXER == 0) ? A.in[I_RETGN] : A.in[I_LN]) + l * 256 + hh * 64 + 8 * fq;
    f32x4 gn[4], e0[4], e1[4];
#pragma unroll
    for (int mb = 0; mb < 4; ++mb) gn[mb] = *(const f32x4*)(gw + 32 * (mb >> 1) + 4 * (mb & 1));
    if (MIXER == 0) {
#pragma unroll
        for (int j = 0; j < 2; ++j) { const v4u gx = *(const v4u*)((const bf16*)(A.ws + WS_PB) + m * PBW + 768 + hh * 64 + 8 * fq + 32 * j);
            e0[2 * j] = (f32x4){bf_lo(gx.x), bf_hi(gx.x), bf_lo(gx.y), bf_hi(gx.y)}; e0[2 * j + 1] = (f32x4){bf_lo(gx.z), bf_hi(gx.z), bf_lo(gx.w), bf_hi(gx.w)}; }
    } else { const float* RWA = (const float*)(A.ws + WS_RWA);
#pragma unroll
        for (int mb = 0; mb < 4; ++mb) { e0[mb] = *(const f32x4*)(RWA + 7 * RWA_STRIDE + o + 32 * (mb >> 1) + 4 * (mb & 1)); e1[mb] = *(const f32x4*)(RWA + 6 * RWA_STRIDE + o + 32 * (mb >> 1) + 4 * (mb & 1)); } }
    const LAS unsigned char* ab = s0 + ((MIXER * 4 + hh) * 64 + 8 * (tk >> 2) + (tk & 3)) * S0_PITCH + 16 * fq;
#pragma unroll
    for (int mb = 0; mb < 4; ++mb)
#pragma unroll
        for (int ks = 0; ks < 2; ++ks) { const bf16x8v af = *(const LAS bf16x8v*)(ab + (32 * (mb >> 1) + 4 * (mb & 1)) * S0_PITCH + 64 * ks); y[mb] = __builtin_amdgcn_mfma_f32_16x16x32_bf16(af, pb[ks], y[mb], 0, 0, 0); }
    float s = (sum4(y[0]) + sum4(y[1])) + (sum4(y[2]) + sum4(y[3])); s += __shfl_xor(s, 16); s += __shfl_xor(s, 32);
    const float mean = s * (1.0f / 64.0f);
#pragma unroll
    for (int mb = 0; mb < 4; ++mb) y[mb] = y[mb] - mean;
    float q = (dot4(y[0], y[0]) + dot4(y[1], y[1])) + (dot4(y[2], y[2]) + dot4(y[3], y[3])); q += __shfl_xor(q, 16); q += __shfl_xor(q, 32);
    const float rs = 1.0f / sqrtf(q * (1.0f / 64.0f) + ((MIXER == 0) ? 1e-5f : 64e-5f));
    bf16* MX = (bf16*)(A.ws + WS_MIX) + m * DM + MIXER * 256 + hh * 64 + 8 * fq;
#pragma unroll
    for (int j = 0; j < 2; ++j) { f32x4 ya = y[2 * j] * rs * gn[2 * j], yb = y[2 * j + 1] * rs * gn[2 * j + 1];
        if (MIXER == 0) {
#pragma unroll
            for (int i = 0; i < 4; ++i) { ya[i] *= e0[2 * j][i] * sigm(e0[2 * j][i]); yb[i] *= e0[2 * j + 1][i] * sigm(e0[2 * j + 1][i]); }
        } else { ya = (ya + e0[2 * j]) * e1[2 * j]; yb = (yb + e0[2 * j + 1]) * e1[2 * j + 1]; }
        v4u wv; wv.x = pk2(ya.x, ya.y); wv.y = pk2(ya.z, ya.w); wv.z = pk2(yb.x, yb.y); wv.w = pk2(yb.z, yb.w); *(v4u*)(MX + 32 * j) = wv; }
}
__device__ __forceinline__ void post16_rms(ARef A, int l, size_t m, int mx, int fq) {
    const float* yp = (const float*)(A.ws + WS_YO) + (size_t)mx * YO_STRIDE + m * 256 + 8 * fq; const float* gw = ((mx == 2) ? A.in[I_DONORM] : A.in[I_SONORM]) + l * 256 + 8 * fq;
    f32x4 y[16];
#pragma unroll
    for (int j = 0; j < 8; ++j) { y[2 * j] = *(const f32x4*)(yp + 32 * j); y[2 * j + 1] = *(const f32x4*)(yp + 32 * j + 4); }
    float q = 0.0f;
#pragma unroll
    for (int j = 0; j < 16; ++j) q += dot4(y[j], y[j]);
    q += __shfl_xor(q, 16); q += __shfl_xor(q, 32);
    const float r = 1.0f / sqrtf(q * (1.0f / 256.0f) + 1e-5f);
    bf16* MX = (bf16*)(A.ws + WS_MIX) + m * DM + mx * 256 + 8 * fq;
#pragma unroll
    for (int j = 0; j < 8; ++j) { const f32x4 ya = y[2 * j] * r * *(const f32x4*)(gw + 32 * j), yb = y[2 * j + 1] * r * *(const f32x4*)(gw + 32 * j + 4);
        v4u wv; wv.x = pk2(ya.x, ya.y); wv.y = pk2(ya.z, ya.w); wv.z = pk2(yb.x, yb.y); wv.w = pk2(yb.z, yb.w); *(v4u*)(MX + 32 * j) = wv; }
}
__device__ __forceinline__ void ph_post16(ARef A, const WI& w, int l) {
    LAS unsigned char* s0 = w.lds;
    for (int u = w.vcu; u < NB * NCH * 2; u += w.G) {
        const int b = u >> 5, c = (u >> 1) & 15, half = u & 1;
        __syncthreads();
#pragma unroll 2
        for (int e = w.tid; e < 4096; e += NWAVES * 64) { const int hd = e >> 9, v = (e >> 3) & 63, k8 = e & 7;
            const float* src = (const float*)(A.ws + ((hd < 4) ? WS_SIR : WS_SI)) + ((size_t)((b * 4 + (hd & 3)) * NCH + c) * 64 + v) * 64 + 8 * k8;
            const f32x4 x0 = *(const f32x4*)src, x1 = *(const f32x4*)(src + 4);
            v4u wv; wv.x = pk2(x0.x, x0.y); wv.y = pk2(x0.z, x0.w); wv.z = pk2(x1.x, x1.y); wv.w = pk2(x1.z, x1.w); *(LAS v4u*)(s0 + (hd * 64 + v) * S0_PITCH + 16 * k8) = wv; }
        __syncthreads();
        int lane = w.lane; asm volatile("" : "+v"(lane));
        const int tk = lane & 15, fq = lane >> 4; const size_t m = (size_t)(b * SEQ + c * TCH + half * 128 + w.wave * 16 + tk);
#pragma unroll 1
        for (int hh = 0; hh < 4; ++hh) post16_head<0>(A, l, m, hh, tk, fq, s0);
#pragma unroll 1
        for (int hh = 0; hh < 4; ++hh) post16_head<1>(A, l, m, hh, tk, fq, s0);
#pragma unroll 1
        for (int mx = 2; mx < 4; ++mx) post16_rms(A, l, m, mx, fq);
    }
}

__device__ __forceinline__ float wave_max_f(float v) {
    v = fmaxf(v, __builtin_bit_cast(float, __builtin_amdgcn_mov_dpp(__builtin_bit_cast(int, v), 0xB1, 0xF, 0xF, true)));
    v = fmaxf(v, __builtin_bit_cast(float, __builtin_amdgcn_mov_dpp(__builtin_bit_cast(int, v), 0x4E, 0xF, 0xF, true)));
    v = fmaxf(v, __builtin_bit_cast(float, __builtin_amdgcn_mov_dpp(__builtin_bit_cast(int, v), 0x141, 0xF, 0xF, true)));
    v = fmaxf(v, __builtin_bit_cast(float, __builtin_amdgcn_mov_dpp(__builtin_bit_cast(int, v), 0x140, 0xF, 0xF, true)));
    const int iv = __builtin_bit_cast(int, v);
    return fmaxf(fmaxf(__builtin_bit_cast(float, __builtin_amdgcn_readlane(iv, 0)), __builtin_bit_cast(float, __builtin_amdgcn_readlane(iv, 16))), fmaxf(__builtin_bit_cast(float, __builtin_amdgcn_readlane(iv, 32)), __builtin_bit_cast(float, __builtin_amdgcn_readlane(iv, 48))));
}
__device__ __forceinline__ void router_stage(ARef A, const WI& w, int l) {
    LAS float* rwl = (LAS float*)w.lds; const float* rw = A.in[I_RW] + (size_t)l * DM * 32;
    for (int e = w.tid; e < DM * 8; e += NWAVES * 64) { const int k = e >> 3, c = e & 7; *(LAS f32x4*)(rwl + k * 32 + 4 * (c ^ ((k >> 2) & 7))) = *(const f32x4*)(rw + (size_t)k * 32 + 4 * c); }
    __syncthreads();
}
__device__ __forceinline__ void router_row(ARef A, int l, int m, int lane, LAS unsigned* hist, const LAS float* rwl, LAS int* texp, bool dry = false) {
    const float* XA = (const float*)(A.ws + WS_XA) + (size_t)m * DM; const float* MOD = (const float*)(A.ws + WS_MOD) + (size_t)(l * 8 + (m >> 12)) * 6144;
    f32x4 v[4]; float ss = 0.0f;
#pragma unroll
    for (int j = 0; j < 4; ++j) { v[j] = *(const f32x4*)(XA + 4 * (lane + 64 * j)); ss += dot4(v[j], v[j]); }
    ss = wave_sum(ss); const float rstd = 1.0f / sqrtf(ss * (1.0f / DM) + 1e-5f);
    const float* g = A.in[I_NFFN] + l * DM; const float* scp = MOD + 4 * 1024; const float* shp = MOD + 3 * 1024;
    emit_h_row(v, rstd, g, scp, shp, (bf16*)(A.ws + WS_H) + (size_t)m * DM, lane);
    float p[32];
#pragma unroll
    for (int e = 0; e < 32; ++e) p[e] = 0.0f;
    const int sw = lane & 7;
#pragma unroll 1
    for (int j = 0; j < 4; ++j) { const int k = 4 * (lane + 64 * j);
        const f32x4 h = *(const f32x4*)(XA + k) * rstd * *(const f32x4*)(g + k) * (1.0f + *(const f32x4*)(scp + k)) + *(const f32x4*)(shp + k);
        const LAS float* row = rwl + k * 32;
#pragma unroll
        for (int i = 0; i < 4; ++i) {
#pragma unroll
            for (int q4 = 0; q4 < 8; ++q4) { const f32x4 r = *(const LAS f32x4*)(row + i * 32 + 4 * (q4 ^ sw)); p[4 * q4] += h[i] * r.x; p[4 * q4 + 1] += h[i] * r.y; p[4 * q4 + 2] += h[i] * r.z; p[4 * q4 + 3] += h[i] * r.w; } } }
    float q16[16], q8[8], q4v[4], q2[2], q1;
    { const bool hb = (lane & 32) != 0;
#pragma unroll
      for (int i = 0; i < 16; ++i) { const float mine = hb ? p[16 + i] : p[i], oth = hb ? p[i] : p[16 + i]; q16[i] = mine + __shfl_xor(oth, 32); } }
    { const bool hb = (lane & 16) != 0;
#pragma unroll
      for (int i = 0; i < 8; ++i) { const float mine = hb ? q16[8 + i] : q16[i], oth = hb ? q16[i] : q16[8 + i]; q8[i] = mine + __shfl_xor(oth, 16); } }
    { const bool hb = (lane & 8) != 0;
#pragma unroll
      for (int i = 0; i < 4; ++i) { const float mine = hb ? q8[4 + i] : q8[i], oth = hb ? q8[i] : q8[4 + i]; q4v[i] = mine + __shfl_xor(oth, 8); } }
    { const bool hb = (lane & 4) != 0;
#pragma unroll
      for (int i = 0; i < 2; ++i) { const float mine = hb ? q4v[2 + i] : q4v[i], oth = hb ? q4v[i] : q4v[2 + i]; q2[i] = mine + __shfl_xor(oth, 4); } }
    { const bool hb = (lane & 2) != 0; const float mine = hb ? q2[1] : q2[0], oth = hb ? q2[0] : q2[1]; q1 = mine + __shfl_xor(oth, 2); }
    q1 += __shfl_xor(q1, 1);
    float lv = q1 + A.in[I_RB][l * 32 + (lane >> 1)];
    float tv[4]; int ti[4];
#pragma unroll
    for (int kk = 0; kk < 4; ++kk) { const float mx = wave_max_f(lv); const unsigned long long msk = __ballot(lv == mx); const int e = msk ? (int)(__builtin_ctzll(msk) >> 1) : kk;
        tv[kk] = mx; ti[kk] = e; if ((lane >> 1) == e) lv = -INFINITY; }
    const float e1 = expf(tv[1] - tv[0]), e2 = expf(tv[2] - tv[0]), e3 = expf(tv[3] - tv[0]); const float inv = 1.0f / (1.0f + e1 + e2 + e3);
    if (lane == 0 && !dry) {
        int* TI = (int*)(A.ws + WS_TOPI) + (size_t)m * 4; float* TW = (float*)(A.ws + WS_TOPW) + (size_t)m * 4;
        TI[0] = ti[0]; TI[1] = ti[1]; TI[2] = ti[2]; TI[3] = ti[3]; texp[0] = ti[0]; texp[1] = ti[1]; texp[2] = ti[2]; texp[3] = ti[3]; TW[0] = inv; TW[1] = e1 * inv; TW[2] = e2 * inv; TW[3] = e3 * inv;
        { unsigned* hg = (unsigned*)hist; atomicAdd(hg + ti[0], 1u); atomicAdd(hg + ti[1], 1u); atomicAdd(hg + ti[2], 1u); atomicAdd(hg + ti[3], 1u); }
    }
}
__device__ __forceinline__ void router_stage16(ARef A, const WI& w, int l) {
    LAS unsigned char* rwt = w.lds; const float* rw = A.in[I_RW] + (size_t)l * DM * 32;
    const int k0 = 2 * w.tid;
    const int c = k0 >> 3, kin = (k0 & 7) * 2;
#pragma unroll
    for (int e4 = 0; e4 < 8; ++e4) { const f32x4 a = *(const f32x4*)(rw + (size_t)k0 * 32 + 4 * e4), b = *(const f32x4*)(rw + (size_t)(k0 + 1) * 32 + 4 * e4);
#pragma unroll
        for (int i = 0; i < 4; ++i) { const int e = 4 * e4 + i; const unsigned hi = pg8::cvt_pk_bf16(a[i], b[i]); const float ra = a[i] - bf_lo(hi), rb = b[i] - bf_hi(hi); const unsigned lo = pg8::cvt_pk_bf16(ra, rb);
            const int off = e * 2048 + ((c ^ (e & 15)) * 16) + kin; *(LAS unsigned*)(rwt + off) = hi; *(LAS unsigned*)(rwt + 65536 + off) = lo; } }
    __syncthreads();
}
__device__ __forceinline__ void router16(ARef A, int l, int m0, int lane_in, LAS unsigned* hist, const LAS unsigned char* rwt, LAS int* texp, bool dry) {
    int lane = lane_in; asm volatile("" : "+v"(lane));
    const int tk = lane & 15, q4 = lane >> 4; const size_t m = (size_t)m0 + tk;
    const float* xr = (const float*)(A.ws + WS_XA) + m * DM + 8 * q4; const float* MOD = (const float*)(A.ws + WS_MOD) + (size_t)(l * 8 + (m0 >> 12)) * 6144;
    const float* g = A.in[I_NFFN] + l * DM + 8 * q4; const float* scp = MOD + 4 * 1024 + 8 * q4; const float* shp = MOD + 3 * 1024 + 8 * q4;
    bf16* hrow = (bf16*)(A.ws + WS_H) + m * DM + 8 * q4;
    float ss = 0.0f;
#pragma unroll 16
    for (int ks = 0; ks < 32; ++ks) { const f32x4 a = *(const f32x4*)(xr + 32 * ks), b = *(const f32x4*)(xr + 32 * ks + 4); ss += dot4(a, a) + dot4(b, b); }
    ss += __shfl_xor(ss, 16); ss += __shfl_xor(ss, 32);
    const float rstd = 1.0f / sqrtf(ss * (1.0f / DM) + 1e-5f);
    f32x4 acc[2] = {{0.f, 0.f, 0.f, 0.f}, {0.f, 0.f, 0.f, 0.f}};
    const LAS unsigned char* wrow = rwt + tk * 2048;
#pragma unroll 2
    for (int ks = 0; ks < 32; ++ks) {
        f32x4 h[2];
#pragma unroll
        for (int u = 0; u < 2; ++u) { const int k = 32 * ks + 4 * u; h[u] = *(const f32x4*)(xr + k) * rstd * *(const f32x4*)(g + k) * (1.0f + *(const f32x4*)(scp + k)) + *(const f32x4*)(shp + k); }
        pg8::u32x4 hw, lw;
        hw.x = pg8::cvt_pk_bf16(h[0].x, h[0].y); hw.y = pg8::cvt_pk_bf16(h[0].z, h[0].w); hw.z = pg8::cvt_pk_bf16(h[1].x, h[1].y); hw.w = pg8::cvt_pk_bf16(h[1].z, h[1].w);
        if (!dry) *(pg8::u32x4*)(hrow + 32 * ks) = hw;
        lw.x = pg8::cvt_pk_bf16(h[0].x - bf_lo(hw.x), h[0].y - bf_hi(hw.x)); lw.y = pg8::cvt_pk_bf16(h[0].z - bf_lo(hw.y), h[0].w - bf_hi(hw.y));
        lw.z = pg8::cvt_pk_bf16(h[1].x - bf_lo(hw.z), h[1].y - bf_hi(hw.z)); lw.w = pg8::cvt_pk_bf16(h[1].z - bf_lo(hw.w), h[1].w - bf_hi(hw.w));
        const bf16x8v bh = __builtin_bit_cast(bf16x8v, hw), bl = __builtin_bit_cast(bf16x8v, lw);
        const int coff = ((4 * ks + q4) ^ tk) * 16;
#pragma unroll
        for (int blk = 0; blk < 2; ++blk) { const bf16x8v ah = *(const LAS bf16x8v*)(wrow + blk * 32768 + coff), al = *(const LAS bf16x8v*)(wrow + 65536 + blk * 32768 + coff);
            acc[blk] = __builtin_amdgcn_mfma_f32_16x16x32_bf16(ah, bh, acc[blk], 0, 0, 0); acc[blk] = __builtin_amdgcn_mfma_f32_16x16x32_bf16(ah, bl, acc[blk], 0, 0, 0); acc[blk] = __builtin_amdgcn_mfma_f32_16x16x32_bf16(al, bh, acc[blk], 0, 0, 0); }
    }
    float lv[8]; const float* rb = A.in[I_RB] + l * 32 + 4 * q4;
#pragma unroll
    for (int blk = 0; blk < 2; ++blk)
#pragma unroll
        for (int i = 0; i < 4; ++i) lv[4 * blk + i] = acc[blk][i] + rb[16 * blk + i];
    float tv[4]; int ti[4];
#pragma unroll
    for (int kk = 0; kk < 4; ++kk) {
        float mx = fmaxf(fmaxf(fmaxf(lv[0], lv[1]), fmaxf(lv[2], lv[3])), fmaxf(fmaxf(lv[4], lv[5]), fmaxf(lv[6], lv[7])));
        mx = fmaxf(mx, __shfl_xor(mx, 16)); mx = fmaxf(mx, __shfl_xor(mx, 32));
        int cand = 99;
#pragma unroll
        for (int j = 7; j >= 0; --j) if (lv[j] == mx) cand = 16 * (j >> 2) + 4 * q4 + (j & 3);
        cand = min(cand, __shfl_xor(cand, 16)); cand = min(cand, __shfl_xor(cand, 32));
        if (cand == 99) cand = kk;
        tv[kk] = mx; ti[kk] = cand;
#pragma unroll
        for (int j = 0; j < 8; ++j) if (16 * (j >> 2) + 4 * q4 + (j & 3) == cand) lv[j] = -INFINITY;
    }
    const float e1 = expf(tv[1] - tv[0]), e2 = expf(tv[2] - tv[0]), e3 = expf(tv[3] - tv[0]); const float inv = 1.0f / (1.0f + e1 + e2 + e3);
    if (q4 == 0 && !dry) {
        int* TI = (int*)(A.ws + WS_TOPI) + m * 4; float* TW = (float*)(A.ws + WS_TOPW) + m * 4;
        *(v4u*)TI = (v4u){(unsigned)ti[0], (unsigned)ti[1], (unsigned)ti[2], (unsigned)ti[3]}; *(f32x4*)TW = (f32x4){inv, e1 * inv, e2 * inv, e3 * inv};
        LAS int* tx = texp + tk * 4; tx[0] = ti[0]; tx[1] = ti[1]; tx[2] = ti[2]; tx[3] = ti[3];
        { unsigned* hg = (unsigned*)hist; atomicAdd(hg + ti[0], 1u); atomicAdd(hg + ti[1], 1u); atomicAdd(hg + ti[2], 1u); atomicAdd(hg + ti[3], 1u); }
    }
}
__device__ __forceinline__ void build_expert_table(ARef A, const WI& w, int l) {
    LAS int* tst = (LAS int*)(w.lds + TST_OFF); LAS int* tab = (LAS int*)(w.lds + TAB_OFF); LAS int* cnt = (LAS int*)(w.lds + CNT_OFF);
    if (w.tid == 0) { const unsigned* gc = (const unsigned*)(A.ws + WS_CTL) + CW_GCNT + 64 * l; int acc = 0;
        for (int e = 0; e < 32; ++e) { const int c = (int)__hip_atomic_load(gc + e, RLX_AGENT); cnt[e] = c; tst[e] = acc; acc += (c + 255) >> 8; }
        tst[32] = acc; tab[0] = acc; }
    __syncthreads();
    if (w.tid < 32) { const int e = w.tid; for (int pm = tst[e]; pm < tst[e + 1]; ++pm) tab[1 + pm] = e; }
    __syncthreads();
}
__device__ __forceinline__ void router_lists(ARef A, const WI& w, int l) {
    LAS unsigned* hist = (LAS unsigned*)(w.lds + HIST_OFF); LAS int* base = (LAS int*)(w.lds + BASE_OFF); LAS int* texp = (LAS int*)(w.lds + TEXP_OFF);
    __syncthreads();
    if (w.tid < 32) { base[w.tid] = (int)atomicAdd((unsigned*)(A.ws + WS_CTL) + CW_GCNT + 64 * l + w.tid, hist[w.tid]); hist[w.tid] = 0u; }
    __syncthreads();
    int* LIST = (int*)(A.ws + WS_LIST); int* PW = (int*)(A.ws + WS_POS);
    for (int g16 = w.gw; g16 < MTOK / 16; g16 += w.NGW) {
        const int j = w.lane >> 2, q = w.lane & 3, m = 16 * g16 + j; const int e = texp[(w.wave * 16 + j) * 4 + q]; const int idx = base[e] + (int)atomicAdd((unsigned*)hist + e, 1u);
        LIST[e * LCAP + idx] = m; PW[(size_t)m * 4 + q] = (e << 20) | idx; }
}
__device__ __forceinline__ void combine_row(ARef A, int l, int m, int lane, const LAS int* tst, float gscale = 1.0f, float oscale = 1.0f) {
    float* XA = (float*)(A.ws + WS_XA) + (size_t)m * DM; const float* MOD = (const float*)(A.ws + WS_MOD) + (size_t)(l * 8 + (m >> 12)) * 6144;
    const int* PS = (const int*)(A.ws + WS_POS) + (size_t)m * 4; const float* TW = (const float*)(A.ws + WS_TOPW) + (size_t)m * 4;
    const bf16* YS = (const bf16*)(A.ws + WS_XS);
    f32x4 v[4], acc[4];
#pragma unroll
    for (int j = 0; j < 4; ++j) { v[j] = *(const f32x4*)(XA + 4 * (lane + 64 * j)); acc[j] = (f32x4){0.f, 0.f, 0.f, 0.f}; }
#pragma unroll
    for (int k = 0; k < 4; ++k) { const int pe = PS[k]; const int pos = tst[pe >> 20] * 256 + (pe & 0xFFFFF); const float gt = TW[k] * gscale; const v2u* yr = (const v2u*)(YS + (size_t)pos * DM);
#pragma unroll
        for (int j = 0; j < 4; ++j) { const v2u y = yr[lane + 64 * j]; acc[j] += gt * (f32x4){bf_lo(y.x), bf_hi(y.x), bf_lo(y.y), bf_hi(y.y)}; } }
    float ss = 0.0f;
#pragma unroll
    for (int j = 0; j < 4; ++j) { const int kx = 4 * (lane + 64 * j); v[j] += *(const f32x4*)(MOD + 5 * 1024 + kx) * acc[j]; ss += dot4(v[j], v[j]); }
    ss = wave_sum(ss); const float rstd = 1.0f / sqrtf(ss * (1.0f / DM) + 1e-5f);
    if (l + 1 < NLAYER) {
#pragma unroll
        for (int j = 0; j < 4; ++j) *(f32x4*)(XA + 4 * (lane + 64 * j)) = v[j];
        const float* mb = MOD + 8 * 6144;
        emit_h_row(v, rstd, A.in[I_NMIX] + (l + 1) * DM, mb + 1024, mb, (bf16*)(A.ws + WS_H) + (size_t)m * DM, lane);
    } else {
        float* orow = A.out + (size_t)m * DM; const float* gf = A.in[I_NFINAL];
#pragma unroll
        for (int j = 0; j < 4; ++j) { const int kx = 4 * (lane + 64 * j); *(f32x4*)(orow + kx) = v[j] * (rstd * oscale) * *(const f32x4*)(gf + kx); }
    }
}

constexpr int N_LAUNCHES = MK_N_LAUNCHES;
template <int SEL> __global__ void __launch_bounds__(NWAVES * 64, 2) fwd(ArgsH Ah) {
    extern __shared__ __attribute__((aligned(16))) unsigned char lds[];
    (void)Ah;
    const int wave_s = __builtin_amdgcn_readfirstlane((int)threadIdx.x >> 6);
    auto tid_now = [&]() -> int { int ws_ = wave_s; unsigned z_ = 0u; asm volatile("" : "+s"(ws_), "+s"(z_)); return ws_ * 64 + (int)__builtin_amdgcn_mbcnt_hi(~0u, __builtin_amdgcn_mbcnt_lo(~0u, z_)); };
#define TID_NOW() tid_now()
#define MAKE_WI() WI w; { int tz = TID_NOW(); asm volatile("" : "+v"(tz)); int bz = blockIdx.x, gz = gridDim.x; asm volatile("" : "+s"(bz), "+s"(gz)); \
        w.lds = (LAS unsigned char*)lds; w.tid = tz; w.lane = tz & 63; w.wave = __builtin_amdgcn_readfirstlane(tz >> 6); w.G = gz; w.bx = bz; w.vcu = (gz % 8 == 0) ? (bz % 8) * (gz / 8) + bz / 8 : bz; \
        w.gw = w.vcu * NWAVES + w.wave; w.NGW = gz * NWAVES; }
    { const int t0 = threadIdx.x; for (int u = t0; u < (LDS_BYTES - RING_BYTES) / 4; u += NWAVES * 64) ((LAS unsigned*)((LAS unsigned char*)lds + RING_BYTES))[u] = 0u; }
    __syncthreads();
    int lo, hi; { ARef A0 = *kargs(); lo = A0.ph_lo; hi = A0.ph_hi; }
    if (N_LAUNCHES == 1) { ARef A0 = *kargs(); (void)xcd_barrier_post((unsigned*)((gu32*)(A0.ws + WS_CTL) + CW_BAR), (volatile LAS unsigned*)((LAS unsigned char*)lds + MISC_OFF) + 8, TID_NOW()); }
#define GRID_BAR() do { if (N_LAUNCHES == 1) { ARef Ab = *kargs(); XcdBarrier bar_; bar_.bar = (unsigned*)((gu32*)(Ab.ws + WS_CTL) + CW_BAR); bar_.x = xb_xcc_id(); bar_.st = (volatile LAS unsigned*)((LAS unsigned char*)lds + MISC_OFF) + 8; xcd_barrier(bar_, TID_NOW()); } } while (0)
#ifndef TPROBE
#define TPROBE 0
#endif
#if TPROBE
    unsigned long long tp_acc = 0ull;
#define TP_SCALE tp_scale_of(__hip_atomic_load((unsigned*)(A.ws + WS_CTL) + 3, RLX_AGENT))
    auto tp_scale_of = [](unsigned ticks) -> float { const float us = (float)ticks * 0.01f; if (us < 1.0f) return 1.0f; const float q = exp2f(rintf(log2f(us) * 8.0f) * 0.125f); return 1.0f + sqrtf(q * 1e-5f); };
#define TP_BEGIN(kind) unsigned long long tp_t0 = 0ull; if ((kind) == TPROBE) tp_t0 = __builtin_amdgcn_s_memrealtime();
#define TP_END(kind) if ((kind) == TPROBE) { tp_acc += __builtin_amdgcn_s_memrealtime() - tp_t0; }
#define TP_PUBLISH(l) if ((l) == 1 && w.vcu == 0 && w.tid == 0) __hip_atomic_store((unsigned*)(A.ws + WS_CTL) + 3, (unsigned)tp_acc, RLX_AGENT);
#else
#define TP_SCALE 1.0f
#define TP_PUBLISH(l)
#define TP_BEGIN(kind)
#define TP_END(kind)
#endif
#define IN(k) (lo <= (k) && (k) < hi)
#ifndef PHMASK
#define PHMASK 0xffffffffu
#endif
#define KON(k) if constexpr ((SEL < 0 && ((PHMASK >> (k)) & 1u)) || SEL == (k))
#define BOTH(k) (IN(k) && IN((k) + 1))
#ifndef PROBE_REP
#define PROBE_REP 0
#endif
#if PROBE_REP
    int nrep_ = 2; asm volatile("" : "+s"(nrep_));
#define REP(bit) _Pragma("unroll 1") for (int rep_ = 0; rep_ < (((PROBE_REP >> (bit)) & 1) ? nrep_ : 1); ++rep_)
#else
#define REP(bit) for (int rep_ = 0; rep_ < 1; ++rep_)
#endif
#define ring ((PG8_LAS unsigned char*)lds)

    KON(0) if (IN(0)) { ARef A = *kargs(); MAKE_WI(); REP(0) ph_prologue(A, w); if (BOTH(0)) GRID_BAR(); }

#define LAYER_BODY(l) do {\
        const int pb = 1 + l * NPL; \
        KON(1) if (IN(pb + 0)) { ARef A = *kargs(); MAKE_WI(); TP_BEGIN(1) if (l == 0) { REP(15) { ph_norm1(A, w); small_weights_to_f16(A, w); } if (BOTH(pb + 0)) GRID_BAR(); } TP_END(1) } \
        KON(2) if (IN(pb + 1)) { ARef A = *kargs(); MAKE_WI(); TP_BEGIN(2) \
            pg8::Gemm g{(const bf16*)(A.ws + WS_H), (const bf16*)(A.ws + WS_WIN) + (size_t)l * INCP * DM, MTOK, INCP, DM}; pg8::StaticOrder S; S.init(MTOK, INCP, w.G, w.bx); \
            pg8::EpiProj E{(bf16*)(A.ws + WS_PB), (float*)(A.ws + WS_PF)}; \
            REP(1) pg8::gemm_phase<pg8::EpiProj, pg8::StaticOrder, true, true>(ring, g, S, E, w.tid); \
            if (BOTH(pb + 1)) GRID_BAR(); TP_END(2) \
        } \
        KON(3) if (IN(pb + 2)) { ARef A = *kargs(); MAKE_WI(); TP_BEGIN(3) \
            REP(2) { int part_ = rep_ ? ((PROBE_REP >> 21) & 7) : 7; asm volatile("" : "+s"(part_)); for (int g = w.gw; g < MTOK / 16; g += w.NGW) prep16(A, l, 16 * g, w.lane, part_); } \
            if (BOTH(pb + 2)) GRID_BAR(); TP_END(3) \
        } \
        KON(4) if (IN(pb + 3)) { ARef A = *kargs(); MAKE_WI(); TP_BEGIN(4) \
            REP(3) { for (int tk = 2 * w.vcu; tk < 32 * NCH; tk += 2 * w.G) scan_rwkv_task2(A, w, tk); } \
            REP(13) { for (int tk = w.vcu; tk < 32 * NCH / 2; tk += w.G) scan_ret_task(A, w, tk); } \
            REP(4) { LAS unsigned char* vl = w.lds + w.wave * 4608; for (int it = w.gw; it < 32 * 128; it += w.NGW) sb_tile_mfma(A, it, w.lane, vl); } \
            REP(5) dsa_scores_mfma(A, w); \
            if (BOTH(pb + 3)) GRID_BAR(); TP_END(4) \
        } \
        KON(5) if (IN(pb + 4)) { ARef A = *kargs(); MAKE_WI(); TP_BEGIN(5) \
            if (w.bx < 32) prefix_chain(A, w, w.bx); \
            REP(6) dsa_wave(A, w, w.lds + w.wave * 13312, l + 2 * rep_, l); \
            REP(14) { if (rep_ && w.bx < 32) prefix_chain(A, w, w.bx); } \
            if (BOTH(pb + 4)) GRID_BAR(); TP_END(5) \
        } \
        KON(6) if (IN(pb + 5)) { ARef A = *kargs(); MAKE_WI(); TP_BEGIN(6) \
            REP(7) ph_post16(A, w, l); \
            if (BOTH(pb + 5)) GRID_BAR(); TP_END(6) \
        } \
        KON(7) if (IN(pb + 6)) { ARef A = *kargs(); MAKE_WI(); TP_BEGIN(7) \
            pg8::Gemm g{(const bf16*)(A.ws + WS_MIX), (const bf16*)(A.ws + WS_WOUT) + (size_t)l * DM * DM, MTOK, DM, DM}; pg8::StaticOrder S; S.init(MTOK, DM, w.G, w.bx); \
            pg8::EpiRes E{l == 0 ? A.in[I_X] : (const float*)(A.ws + WS_XA), (float*)(A.ws + WS_XA), (const float*)(A.ws + WS_MOD) + (size_t)l * 8 * 6144 + 2 * 1024}; \
            REP(16) { pg8::EpiRes E2 = E; if (rep_ && l == 1) E2.gate = (const float*)(A.ws + WS_CTL + 512 * 1024); pg8::gemm_phase<pg8::EpiRes, pg8::StaticOrder, true, true>(ring, g, S, E2, w.tid); } \
            if (BOTH(pb + 6)) GRID_BAR(); TP_END(7) \
        } \
        KON(8) if (IN(pb + 7)) { ARef A = *kargs(); MAKE_WI(); TP_BEGIN(8) \
            { LAS unsigned* hist = (LAS unsigned*)(w.lds + HIST_OFF); LAS int* texp = (LAS int*)(w.lds + TEXP_OFF); if (w.tid < 32) hist[w.tid] = 0u; router_stage16(A, w, l); \
            REP(10) { for (int g16 = w.gw; g16 < MTOK / 16; g16 += w.NGW) router16(A, l, 16 * g16, w.lane, hist, (const LAS unsigned char*)w.lds, texp + w.wave * 64, rep_ != 0); } \
            router_lists(A, w, l); } \
            if (BOTH(pb + 7)) GRID_BAR(); TP_END(8) \
        } \
        KON(10) if (IN(pb + 8)) { ARef A = *kargs(); MAKE_WI(); TP_BEGIN(10) \
            build_expert_table(A, w, l); \
            pg8::Gemm g{(const bf16*)(A.ws + WS_H), (const bf16*)(A.ws + WS_W1) + (size_t)l * NEXP * 2048 * DM, MOE_ROWS, NEXP * 2048, DM}; \
            pg8::MoeOrder S{(const PG8_LAS int*)(w.lds + TAB_OFF), 8, w.G, w.vcu, (const PG8_LAS int*)(w.lds + TST_OFF), (const PG8_LAS int*)(w.lds + CNT_OFF), (const int*)(A.ws + WS_LIST)}; \
            pg8::EpiSwiglu E{(bf16*)(A.ws + WS_ACT), A.in[I_MB1] + (size_t)l * NEXP * 2048}; \
            REP(8) { if (PROBE_REP & (1 << 20)) { if (rep_) pg8::gemm_phase<pg8::EpiNull, pg8::MoeOrder, true, true, true>(ring, g, S, pg8::EpiNull{}, w.tid); else pg8::gemm_phase<pg8::EpiSwiglu, pg8::MoeOrder, true, true, true>(ring, g, S, E, w.tid); } else pg8::gemm_phase<pg8::EpiSwiglu, pg8::MoeOrder, true, true, true>(ring, g, S, E, w.tid); } \
            if (BOTH(pb + 8)) GRID_BAR(); TP_END(10) \
        } \
        KON(11) if (IN(pb + 9)) { ARef A = *kargs(); MAKE_WI(); TP_BEGIN(11) \
            build_expert_table(A, w, l); \
            pg8::Gemm g{(const bf16*)(A.ws + WS_ACT), (const bf16*)(A.ws + WS_W2) + (size_t)l * NEXP * DM * DM, MOE_ROWS, NEXP * DM, DM}; \
            pg8::MoeOrder S{(const PG8_LAS int*)(w.lds + TAB_OFF), 4, w.G, w.vcu, (const PG8_LAS int*)(w.lds + TST_OFF), (const PG8_LAS int*)(w.lds + CNT_OFF), (const int*)(A.ws + WS_LIST)}; \
            pg8::EpiY E{(bf16*)(A.ws + WS_XS), A.in[I_MB2] + (size_t)l * NEXP * DM}; \
            REP(9) pg8::gemm_phase<pg8::EpiY, pg8::MoeOrder, true, true>(ring, g, S, E, w.tid); \
            TP_PUBLISH(l) \
            if (BOTH(pb + 9)) GRID_BAR(); TP_END(11) \
        } \
        KON(12) if (IN(pb + 10)) { ARef A = *kargs(); MAKE_WI(); TP_BEGIN(12) \
            build_expert_table(A, w, l); \
            REP(12) for (int m = w.gw; m < MTOK; m += w.NGW) combine_row(A, l, m, w.lane, (const LAS int*)(w.lds + TST_OFF), (rep_ && l == 0) ? 0.0f : 1.0f, TP_SCALE); \
            if (BOTH(pb + 10)) GRID_BAR(); TP_END(12) \
        } \
    } while (0)
    LAYER_BODY(0);
    LAYER_BODY(1);
#undef LAYER_BODY
#undef IN
#undef ring
#undef MAKE_WI
#undef TID_NOW
#undef GRID_BAR
#undef KON
#undef BOTH
}


#if MK_N_LAUNCHES != 1
template <int K> static void launch_one(int grid, hipStream_t stream, const ArgsH& a) {
    static bool attr = false;
    if (!attr) { (void)hipFuncSetAttribute((const void*)fwd<K>, hipFuncAttributeMaxDynamicSharedMemorySize, LDS_BYTES); attr = true; }
    hipLaunchKernelGGL(fwd<K>, dim3(grid), dim3(NWAVES * 64), LDS_BYTES, stream, a);
}
static void launch_kind(int kind, int grid, hipStream_t stream, const ArgsH& a) {
    switch (kind) {
        case 0: launch_one<0>(grid, stream, a); break; case 1: launch_one<1>(grid, stream, a); break; case 2: launch_one<2>(grid, stream, a); break;
        case 3: launch_one<3>(grid, stream, a); break; case 4: launch_one<4>(grid, stream, a); break; case 5: launch_one<5>(grid, stream, a); break;
        case 6: launch_one<6>(grid, stream, a); break; case 7: launch_one<7>(grid, stream, a); break; case 8: launch_one<8>(grid, stream, a); break;
        case 9: launch_one<9>(grid, stream, a); break; case 10: launch_one<10>(grid, stream, a); break; case 11: launch_one<11>(grid, stream, a); break;
        default: launch_one<12>(grid, stream, a); break;
    }
}
#endif
extern "C" void kernel_launch(void* const* d_in, const int* in_sizes, int n_in, void* d_out, int out_size, void* d_ws, size_t ws_size, hipStream_t stream) {
    static int grid = 0;
    if (grid == 0) {
        if (n_in != N_IN || out_size != MTOK * DM || ws_size < WS_END) { fprintf(stderr, "kernel_launch: unexpected shapes (n_in %d, out %d, ws %zu)\n", n_in, out_size, ws_size); grid = -1; return; }
        int dev = 0, cus = 0;
        if (hipGetDevice(&dev) != hipSuccess || hipDeviceGetAttribute(&cus, hipDeviceAttributeMultiprocessorCount, dev) != hipSuccess) { grid = -1; return; }
#if MK_N_LAUNCHES == 1
        {
            if (hipFuncSetAttribute((const void*)fwd<-1>, hipFuncAttributeMaxDynamicSharedMemorySize, LDS_BYTES) != hipSuccess) { fprintf(stderr, "kernel_launch: hipFuncSetAttribute failed\n"); grid = -1; return; }
            int per_cu = 0;
            if (hipOccupancyMaxActiveBlocksPerMultiprocessor(&per_cu, (const void*)fwd<-1>, NWAVES * 64, LDS_BYTES) != hipSuccess || per_cu < 1) fprintf(stderr, "kernel_launch: occupancy query says %d\n", per_cu);
            (void)hipGetLastError();
        }
#endif
        grid = cus;
    }
    if (grid < 0) return;
    (void)in_sizes;
    if (hipMemsetAsync((char*)d_ws + WS_CTL, 0, CTL_ZERO_BYTES, stream) != hipSuccess) return;
    ArgsH a{};
    for (int i = 0; i < N_IN; ++i) a.in[i] = (const float*)d_in[i];
    a.out = (float*)d_out; a.ws = (unsigned char*)d_ws;
    for (int f = 0; f < 44; ++f) a.invf[f] = (f < 32) ? pow(10000.0, -(double)f / 32.0) : (f < 40) ? pow(500000.0, -(double)(f - 32) / 8.0) : pow(500000.0, -(double)(f - 40) / 4.0);
#if MK_N_LAUNCHES == 1
    a.ph_lo = 0; a.ph_hi = NPHASE; a.li = 0;
    hipLaunchKernelGGL(fwd<-1>, dim3(grid), dim3(NWAVES * 64), LDS_BYTES, stream, a);
#else
    {
        for (int p = 0; p < NPHASE; ++p) {
            if (p == 1 + NPL) continue;
            a.ph_lo = p; a.ph_hi = p + 1; a.li = p;
            static const int kinds_[NPL] = {1, 2, 3, 4, 5, 6, 7, 8, 10, 11, 12};
            const int kind = (p == 0) ? 0 : kinds_[(p - 1) % NPL];
            launch_kind(kind, grid, stream, a);
        }
    }
#endif
}
```

```cpp
#include <hip/hip_runtime.h>
#include <cstdio>
#include <cstdint>
#include <cmath>

#ifndef MK_N_LAUNCHES
#define MK_N_LAUNCHES 1
#endif

namespace pg8 {
#define PG8_LAS __attribute__((address_space(3)))
typedef unsigned short bf16_t;
typedef short bf16x8 __attribute__((ext_vector_type(8)));
typedef float f32x4 __attribute__((ext_vector_type(4)));
typedef unsigned u32x4 __attribute__((ext_vector_type(4)));
typedef unsigned u32x2 __attribute__((ext_vector_type(2)));
constexpr int BM = 256, BK = 64, HALF = 128, HTB = HALF * BK * 2  , STAGE_BYTES = 8 * HTB, NXCD = 8, WGM = 8;

__host__ __device__ __forceinline__ int lds_byte(int r, int c) { const int st = (r >> 4) * 2 + (c >> 5), rr = r & 15, cc = c & 31, ob = rr * 64 + cc * 2; return st * 1024 + (ob ^ (((ob >> 9) & 1) << 5)); }
__host__ __device__ __forceinline__ void stage_rc(int b, int& R, int& C) { const int st = b / 1024, sb = b % 1024, swz = sb ^ (((sb >> 9) & 1) << 5); R = (st >> 1) * 16 + swz / 64; C = (st & 1) * 32 + (swz % 64) / 2; }
__host__ __device__ __forceinline__ int perm32(int rho) { const int n = rho >> 4, i = rho & 15; return 8 * (i >> 2) + 4 * n + (i & 3); }

struct Unit { int pm, pn; };
struct Gemm { const bf16_t* A; const bf16_t* Bt; int M, N, K; };

struct StaticOrder {
    int nM, nN, nwg, G, c;
    __host__ __device__ void init(int M, int N, int G_, int c_) { nM = M / BM; nN = N / BM; nwg = nM * nN; G = G_; c = c_; }
    __host__ __device__ bool next(int i, Unit& u) const {
        const long L = (long)i * G + c; if (L >= nwg) return false;
        int wgid = (int)L; { const int q = nwg / NXCD, r = nwg % NXCD, xcd = wgid % NXCD, off = wgid / NXCD; wgid = (xcd < r ? xcd * (q + 1) : r * (q + 1) + (xcd - r) * q) + off; }
        const int nig = WGM * nN, gid = wgid / nig, fm = gid * WGM, gsz = (nM - fm) < WGM ? (nM - fm) : WGM;
        u.pm = fm + ((wgid % nig) % gsz); u.pn = (wgid % nig) / gsz; return true;
    }
    __device__ __forceinline__ void a_ready(const Unit&) const {}
    __device__ __forceinline__ void done(const Unit&) const {}
};
__device__ __forceinline__ unsigned cvt_pk_bf16(float lo, float hi) { unsigned r; asm volatile("v_cvt_pk_bf16_f32 %0, %1, %2" : "=v"(r) : "v"(lo), "v"(hi)); return r; }
struct EpiF32 {
    static constexpr bool PERM = false, AFTER_DRAIN = false;
    float* C; int ldc;
    __device__ __forceinline__ void operator()(const f32x4 (&acc)[2][2][4][2], const Unit& u, int wr, int wc, int fr, int fq) const {
        const int row0 = u.pm * BM + wr * 64 + fr, col0 = u.pn * BM + wc * 32 + 4 * fq;
#pragma unroll
        for (int ai = 0; ai < 2; ++ai)
#pragma unroll
            for (int m = 0; m < 4; ++m) { float* rowp = C + (size_t)(row0 + ai * HALF + m * 16) * ldc + col0;
#pragma unroll
                for (int bj = 0; bj < 2; ++bj)
#pragma unroll
                    for (int n = 0; n < 2; ++n) *(f32x4*)(rowp + bj * HALF + n * 16) = acc[ai][bj][m][n]; }
    }
};
struct EpiNull {
    static constexpr bool PERM = true, AFTER_DRAIN = false;
    __device__ __forceinline__ void operator()(const f32x4 (&acc)[2][2][4][2], const Unit&, int, int, int, int) const {
#pragma unroll
        for (int ai = 0; ai < 2; ++ai)
#pragma unroll
            for (int bj = 0; bj < 2; ++bj) asm volatile("" :: "v"(acc[ai][bj][0][0]), "v"(acc[ai][bj][0][1]), "v"(acc[ai][bj][1][0]), "v"(acc[ai][bj][1][1]), "v"(acc[ai][bj][2][0]), "v"(acc[ai][bj][2][1]), "v"(acc[ai][bj][3][0]), "v"(acc[ai][bj][3][1]));
    }
};
struct EpiProj {
    static constexpr bool PERM = true, AFTER_DRAIN = false;
    bf16_t* PB; bf16_t* PF;
    __device__ __forceinline__ void operator()(const f32x4 (&acc)[2][2][4][2], const Unit& u, int wr, int wc, int fr, int fq) const {
        const int row0 = u.pm * BM + wr * 64 + fr;
        if (u.pn < 7) { const int c0 = u.pn * BM + wc * 32 + 8 * fq;
#pragma unroll
            for (int ai = 0; ai < 2; ++ai)
#pragma unroll
                for (int m = 0; m < 4; ++m) { bf16_t* rowp = PB + (size_t)(row0 + ai * HALF + m * 16) * 1792 + c0;
#pragma unroll
                    for (int bj = 0; bj < 2; ++bj) { const f32x4 v0 = acc[ai][bj][m][0], v1 = acc[ai][bj][m][1];
                        u32x4 w; w.x = cvt_pk_bf16(v0[0], v0[1]); w.y = cvt_pk_bf16(v0[2], v0[3]); w.z = cvt_pk_bf16(v1[0], v1[1]); w.w = cvt_pk_bf16(v1[2], v1[3]);
                        *(u32x4*)(rowp + bj * HALF) = w; } }
        } else { const int c0 = (u.pn - 7) * BM + wc * 32 + 8 * fq;
#pragma unroll
            for (int ai = 0; ai < 2; ++ai)
#pragma unroll
                for (int m = 0; m < 4; ++m) { bf16_t* rowp = PF + (size_t)(row0 + ai * HALF + m * 16) * 1280 + c0;
#pragma unroll
                    for (int bj = 0; bj < 2; ++bj) { const f32x4 v0 = acc[ai][bj][m][0], v1 = acc[ai][bj][m][1];
                        u32x4 w; w.x = cvt_pk_bf16(v0[0], v0[1]); w.y = cvt_pk_bf16(v0[2], v0[3]); w.z = cvt_pk_bf16(v1[0], v1[1]); w.w = cvt_pk_bf16(v1[2], v1[3]);
                        *(u32x4*)(rowp + bj * HALF) = w; } }
        }
    }
};
struct EpiRes {
    static constexpr bool PERM = false, AFTER_DRAIN = false;
    const float* xin; float* xout; const float* gate;
    __device__ __forceinline__ void operator()(const f32x4 (&acc)[2][2][4][2], const Unit& u, int wr, int wc, int fr, int fq) const {
        const int row0 = u.pm * BM + wr * 64 + fr, col0 = u.pn * BM + wc * 32 + 4 * fq;
        const float* gp = gate + (size_t)((u.pm * BM) >> 12) * 6144 + col0;
        f32x4 gv[2][2];
#pragma unroll
        for (int bj = 0; bj < 2; ++bj)
#pragma unroll
            for (int n = 0; n < 2; ++n) gv[bj][n] = *(const f32x4*)(gp + bj * HALF + n * 16);
#pragma unroll
        for (int ai = 0; ai < 2; ++ai)
#pragma unroll
            for (int m = 0; m < 4; ++m) { const size_t ro = (size_t)(row0 + ai * HALF + m * 16) * 1024 + col0;
#pragma unroll
                for (int bj = 0; bj < 2; ++bj)
#pragma unroll
                    for (int n = 0; n < 2; ++n) { const f32x4 xv = *(const f32x4*)(xin + ro + bj * HALF + n * 16); *(f32x4*)(xout + ro + bj * HALF + n * 16) = xv + gv[bj][n] * acc[ai][bj][m][n]; } }
    }
};
__device__ __forceinline__ float swiglu1(float glu, float lin) {
    glu = fminf(glu, 7.0f); lin = fminf(fmaxf(lin, -7.0f), 7.0f);
    return glu * (1.0f / (1.0f + __expf(-1.702f * glu))) * (lin + 1.0f);
}
struct EpiSwiglu {
    static constexpr bool PERM = true, AFTER_DRAIN = false;
    bf16_t* O; const float* b1;
    __device__ __forceinline__ void operator()(const f32x4 (&acc)[2][2][4][2], const Unit& u, int wr, int wc, int fr, int fq) const {
        const int e = u.pn >> 3, j = u.pn & 7, row0 = u.pm * BM + wr * 64 + fr, c0 = 128 * j + wc * 32 + 8 * fq;
        const float* bp = b1 + (size_t)e * 2048 + c0;
        f32x4 bg[2], bl[2];
#pragma unroll
        for (int n = 0; n < 2; ++n) { bg[n] = *(const f32x4*)(bp + 4 * n); bl[n] = *(const f32x4*)(bp + 1024 + 4 * n); }
#pragma unroll
        for (int ai = 0; ai < 2; ++ai)
#pragma unroll
            for (int m = 0; m < 4; ++m) { bf16_t* rowp = O + (size_t)(row0 + ai * HALF + m * 16) * 1024 + c0;
                const f32x4 g0 = acc[ai][0][m][0] + bg[0], g1 = acc[ai][0][m][1] + bg[1], l0 = acc[ai][1][m][0] + bl[0], l1 = acc[ai][1][m][1] + bl[1];
                u32x4 w;
                w.x = cvt_pk_bf16(swiglu1(g0[0], l0[0]), swiglu1(g0[1], l0[1])); w.y = cvt_pk_bf16(swiglu1(g0[2], l0[2]), swiglu1(g0[3], l0[3]));
                w.z = cvt_pk_bf16(swiglu1(g1[0], l1[0]), swiglu1(g1[1], l1[1])); w.w = cvt_pk_bf16(swiglu1(g1[2], l1[2]), swiglu1(g1[3], l1[3]));
                *(u32x4*)rowp = w; }
    }
};
struct EpiY {
    static constexpr bool PERM = true, AFTER_DRAIN = false;
    bf16_t* O; const float* b2;
    __device__ __forceinline__ void operator()(const f32x4 (&acc)[2][2][4][2], const Unit& u, int wr, int wc, int fr, int fq) const {
        const int e = u.pn >> 2, j = u.pn & 3, row0 = u.pm * BM + wr * 64 + fr, c0 = 256 * j + wc * 32 + 8 * fq;
        const float* bp = b2 + (size_t)e * 1024 + c0;
        f32x4 bv[2][2];
#pragma unroll
        for (int bj = 0; bj < 2; ++bj)
#pragma unroll
            for (int n = 0; n < 2; ++n) bv[bj][n] = *(const f32x4*)(bp + bj * HALF + 4 * n);
#pragma unroll
        for (int ai = 0; ai < 2; ++ai)
#pragma unroll
            for (int m = 0; m < 4; ++m) { bf16_t* rowp = O + (size_t)(row0 + ai * HALF + m * 16) * 1024 + c0;
#pragma unroll
                for (int bj = 0; bj < 2; ++bj) { const f32x4 v0 = acc[ai][bj][m][0] + bv[bj][0], v1 = acc[ai][bj][m][1] + bv[bj][1];
                    u32x4 w; w.x = cvt_pk_bf16(v0[0], v0[1]); w.y = cvt_pk_bf16(v0[2], v0[3]); w.z = cvt_pk_bf16(v1[0], v1[1]); w.w = cvt_pk_bf16(v1[2], v1[3]);
                    *(u32x4*)(rowp + bj * HALF) = w; } }
    }
};
struct MoeOrder {
    const PG8_LAS int* tab; int NJ, G, c;
    __device__ __forceinline__ bool next(int i, Unit& u) const {
        const int T = tab[0]; const long L = (long)i * G + c; if (L >= (long)T * NJ) return false;
        const int pm = (int)(L / NJ), j = (int)(L % NJ);
        u.pm = pm; u.pn = tab[1 + pm] * NJ + j; return true;
    }
    __device__ __forceinline__ void a_ready(const Unit&) const {}
    __device__ __forceinline__ void done(const Unit&) const {}
    const PG8_LAS int* tst; const PG8_LAS int* cnt; const int* list;
    __device__ __forceinline__ int row_of(const Unit& u, int r) const { const int e = tab[1 + u.pm], idx = 256 * (u.pm - tst[e]) + r; return (idx < cnt[e]) ? list[e * 32768 + idx] : 0; }
};

template <class Epi, class Sched, bool ALIGN_EPI = false, bool SP2 = false, bool GATHER = false>
__device__ __forceinline__ void gemm_phase(PG8_LAS unsigned char* lds, const Gemm g, const Sched& S, const Epi& E, int tid_in) {
    int tid_ = tid_in; asm volatile("" : "+v"(tid_));
    const int tid = tid_, wid = __builtin_amdgcn_readfirstlane(tid >> 6), lane = tid & 63, wr = wid >> 2, wc = wid & 3, fr = lane & 15, fq = lane >> 4;
    const int K = g.K, nt = K / BK;
    unsigned voffA[2], voffB[2];
#pragma unroll
    for (int i = 0; i < 2; ++i) { int R, C; stage_rc(tid * 16 + i * 8192, R, C); const int Rb = Epi::PERM ? ((R & ~31) + perm32(R & 31)) : R;
        voffA[i] = (unsigned)(R * K + C) * 2u; voffB[i] = (unsigned)(Rb * K + C) * 2u; }
    static_assert(!GATHER || SP2, "gathered A rows: only the two-super-phase loop is wired");
    unsigned cvo[2][2], nvo[2][2];
#define PG8_ROWS(dst, u_) do { _Pragma("unroll") for (int h_ = 0; h_ < 2; ++h_) _Pragma("unroll") for (int i_ = 0; i_ < 2; ++i_) { int R_, C_; stage_rc(tid * 16 + i_ * 8192, R_, C_); dst[h_][i_] = (unsigned)(S.row_of(u_, h_ * HALF + R_) * K + C_) * 2u; } } while (0)
#define PG8_STAGE_A(bufoff, gbase, half, nx) do { if constexpr (GATHER) { unsigned o_[2]; o_[0] = (nx) ? nvo[half][0] : cvo[half][0]; o_[1] = (nx) ? nvo[half][1] : cvo[half][1]; PG8_STAGE(bufoff, gbase, o_); } else { PG8_STAGE(bufoff, (gbase) + (half) * hstep, voffA); } } while (0)
    const size_t kstep = (size_t)(BK * 2);
    const size_t hstep = (size_t)HALF * K * 2;
    const size_t tstep = 2 * hstep;
    const unsigned ldsw = (unsigned)wid * 1024u;
    const int aoff = lds_byte(wr * 64 + fr, fq * 8), boff = lds_byte(wc * 32 + fr, fq * 8);
#define PG8_SA(b, h) (((b) * 2 + (h)) * HTB)
#define PG8_SB(b, h) ((4 + (b) * 2 + (h)) * HTB)
#define PG8_STAGE(bufoff, gbase, voff) do { _Pragma("unroll") for (int _i = 0; _i < 2; ++_i) \
        __builtin_amdgcn_global_load_lds((const unsigned*)((const char*)(gbase) + (voff)[_i]), (PG8_LAS unsigned*)(lds + (bufoff) + ldsw + _i * 8192), 16, 0, 0); } while (0)
#define PG8_LDA(dst, b, h) do { _Pragma("unroll") for (int m = 0; m < 4; ++m) _Pragma("unroll") for (int k = 0; k < 2; ++k) dst[m][k] = *(const PG8_LAS bf16x8*)(lds + PG8_SA(b, h) + aoff + m * 2048 + k * 1024); } while (0)
#define PG8_LDB(dst, b, h) do { _Pragma("unroll") for (int n = 0; n < 2; ++n) _Pragma("unroll") for (int k = 0; k < 2; ++k) dst[n][k] = *(const PG8_LAS bf16x8*)(lds + PG8_SB(b, h) + boff + n * 2048 + k * 1024); } while (0)
#define PG8_MMA(ai, bj, At, Bt) do { __builtin_amdgcn_s_setprio(1); _Pragma("unroll") for (int m = 0; m < 4; ++m) _Pragma("unroll") for (int n = 0; n < 2; ++n) _Pragma("unroll") for (int k = 0; k < 2; ++k) \
        acc[ai][bj][m][n] = __builtin_amdgcn_mfma_f32_16x16x32_bf16(Bt[n][k], At[m][k], acc[ai][bj][m][n], 0, 0, 0); __builtin_amdgcn_s_setprio(0); } while (0)
#define PG8_WAIT_V(n) asm volatile("s_waitcnt vmcnt(" #n ")" ::: "memory")
#define PG8_WAIT_L(n) asm volatile("s_waitcnt lgkmcnt(" #n ")" ::: "memory")
#define PG8_BAR __builtin_amdgcn_s_barrier()
#define PG8_SCHED __builtin_amdgcn_sched_barrier(0)
    Unit cur, nxt; int ui = 0;
    if (!S.next(0, cur)) return;
    f32x4 acc[2][2][4][2];
#pragma unroll
    for (int a = 0; a < 2; ++a)
#pragma unroll
        for (int b = 0; b < 2; ++b)
#pragma unroll
            for (int m = 0; m < 4; ++m)
#pragma unroll
                for (int n = 0; n < 2; ++n) acc[a][b][m][n] = (f32x4){0.f, 0.f, 0.f, 0.f};
    bf16x8 At[4][2], B0[2][2], B1[2][2];
    const char* cA = (const char*)g.A + (GATHER ? (size_t)0 : (size_t)cur.pm * tstep); const char* cB = (const char*)g.Bt + (size_t)cur.pn * tstep;
    if constexpr (GATHER) { PG8_ROWS(cvo, cur); }
    S.a_ready(cur);
    if constexpr (SP2) {
        PG8_STAGE(PG8_SB(0, 0), cB, voffB); PG8_STAGE(PG8_SB(0, 1), cB + hstep, voffB); PG8_STAGE_A(PG8_SA(0, 0), cA, 0, false); PG8_STAGE_A(PG8_SA(0, 1), cA, 1, false);
        if (wr == 1) PG8_BAR;
        PG8_WAIT_V(2); PG8_BAR;
        PG8_STAGE(PG8_SB(1, 0), cB + kstep, voffB); PG8_STAGE_A(PG8_SA(1, 0), cA + kstep, 0, false); PG8_STAGE(PG8_SB(1, 1), cB + hstep + kstep, voffB);
        PG8_WAIT_V(6); PG8_BAR;
    } else {
        PG8_STAGE(PG8_SB(0, 0), cB, voffB); PG8_STAGE(PG8_SA(0, 0), cA, voffA); PG8_STAGE(PG8_SB(0, 1), cB + hstep, voffB); PG8_STAGE(PG8_SA(0, 1), cA + hstep, voffA);
        if (wr == 1) PG8_BAR;
        PG8_WAIT_V(4); PG8_BAR;
        PG8_STAGE(PG8_SB(1, 0), cB + kstep, voffB); PG8_STAGE(PG8_SA(1, 0), cA + kstep, voffA); PG8_STAGE(PG8_SB(1, 1), cB + hstep + kstep, voffB);
        PG8_WAIT_V(6); PG8_BAR;
    }
    for (;;) {
        const bool has_next = S.next(ui + 1, nxt);
        const char* nA = GATHER ? (const char*)g.A : (has_next ? (const char*)g.A + (size_t)nxt.pm * tstep : cA); const char* nB = has_next ? (const char*)g.Bt + (size_t)nxt.pn * tstep : cB;
        if constexpr (GATHER) { if (has_next) { PG8_ROWS(nvo, nxt); } else { _Pragma("unroll") for (int h_ = 0; h_ < 2; ++h_) { nvo[h_][0] = cvo[h_][0]; nvo[h_][1] = cvo[h_][1]; } } }
        for (int t = 0; t < nt; t += 2) {
            const bool last = (t == nt - 2);
            const char* a1 = cA + (size_t)(t + 1) * kstep;
            const char* a2 = last ? nA : cA + (size_t)(t + 2) * kstep; const char* b2 = last ? nB : cB + (size_t)(t + 2) * kstep;
            const char* a3 = a2 + kstep; const char* b3 = b2 + kstep;
            if (last && has_next) S.a_ready(nxt);
            if constexpr (SP2) {
            PG8_LDB(B0, 0, 0); PG8_LDB(B1, 0, 1); PG8_SCHED; PG8_LDA(At, 0, 0); PG8_STAGE_A(PG8_SA(1, 1), a1, 1, false);
            PG8_WAIT_V(8); PG8_WAIT_L(0); PG8_BAR; PG8_MMA(0, 0, At, B0); PG8_MMA(0, 1, At, B1); PG8_BAR; PG8_SCHED;
            PG8_LDA(At, 0, 1); PG8_STAGE(PG8_SB(0, 0), b2, voffB); PG8_STAGE(PG8_SB(0, 1), b2 + hstep, voffB); PG8_STAGE_A(PG8_SA(0, 0), a2, 0, last);
            PG8_WAIT_V(8); PG8_WAIT_L(0); PG8_BAR; PG8_MMA(1, 0, At, B0); PG8_MMA(1, 1, At, B1); PG8_BAR; PG8_SCHED;
            PG8_LDB(B0, 1, 0); PG8_LDB(B1, 1, 1); PG8_SCHED; PG8_LDA(At, 1, 0); PG8_STAGE_A(PG8_SA(0, 1), a2, 1, last);
            PG8_WAIT_V(8); PG8_WAIT_L(0); PG8_BAR; PG8_MMA(0, 0, At, B0); PG8_MMA(0, 1, At, B1); PG8_BAR; PG8_SCHED;
            PG8_LDA(At, 1, 1); PG8_STAGE(PG8_SB(1, 0), b3, voffB); PG8_STAGE(PG8_SB(1, 1), b3 + hstep, voffB); PG8_STAGE_A(PG8_SA(1, 0), a3, 0, last);
            PG8_WAIT_V(8); PG8_WAIT_L(0); PG8_BAR; PG8_MMA(1, 0, At, B0); PG8_MMA(1, 1, At, B1); PG8_BAR; PG8_SCHED;
            } else {
            PG8_LDB(B0, 0, 0); PG8_SCHED; PG8_LDA(At, 0, 0); PG8_STAGE(PG8_SA(1, 1), a1 + hstep, voffA);
            PG8_WAIT_L(8); PG8_BAR; PG8_WAIT_L(0); PG8_MMA(0, 0, At, B0); PG8_BAR; PG8_SCHED;
            PG8_LDB(B1, 0, 1); PG8_STAGE(PG8_SB(0, 0), b2, voffB);
            PG8_BAR; PG8_WAIT_L(0); PG8_MMA(0, 1, At, B1); PG8_BAR;
            PG8_LDA(At, 0, 1); PG8_STAGE(PG8_SA(0, 0), a2, voffA);
            PG8_BAR; PG8_WAIT_L(0); PG8_MMA(1, 0, At, B0); PG8_BAR; PG8_SCHED;
            PG8_STAGE(PG8_SB(0, 1), b2 + hstep, voffB);
            PG8_WAIT_V(6); PG8_BAR; PG8_MMA(1, 1, At, B1); PG8_BAR;
            PG8_LDB(B0, 1, 0); PG8_SCHED; PG8_LDA(At, 1, 0); PG8_STAGE(PG8_SA(0, 1), a2 + hstep, voffA);
            PG8_WAIT_L(8); PG8_BAR; PG8_WAIT_L(0); PG8_MMA(0, 0, At, B0); PG8_BAR; PG8_SCHED;
            PG8_LDB(B1, 1, 1); PG8_STAGE(PG8_SB(1, 0), b3, voffB);
            PG8_BAR; PG8_WAIT_L(0); PG8_MMA(0, 1, At, B1); PG8_BAR;
            PG8_LDA(At, 1, 1); PG8_STAGE(PG8_SA(1, 0), a3, voffA);
            PG8_BAR; PG8_WAIT_L(0); PG8_MMA(1, 0, At, B0); PG8_BAR; PG8_SCHED;
            PG8_STAGE(PG8_SB(1, 1), b3 + hstep, voffB);
            PG8_WAIT_V(6); PG8_BAR; PG8_MMA(1, 1, At, B1); PG8_BAR;
            }
        }
        if constexpr (ALIGN_EPI) { if (wr == 0) PG8_BAR; }
        if constexpr (!Epi::AFTER_DRAIN) { E(acc, cur, wr, wc, fr, fq); S.done(cur); }
        if (!has_next) break;
#pragma unroll
        for (int a = 0; a < 2; ++a)
#pragma unroll
            for (int b = 0; b < 2; ++b)
#pragma unroll
                for (int m = 0; m < 4; ++m)
#pragma unroll
                    for (int n = 0; n < 2; ++n) acc[a][b][m][n] = (f32x4){0.f, 0.f, 0.f, 0.f};
        cur = nxt; cA = nA; cB = nB; ++ui;
        if constexpr (GATHER) { _Pragma("unroll") for (int h_ = 0; h_ < 2; ++h_) { cvo[h_][0] = nvo[h_][0]; cvo[h_][1] = nvo[h_][1]; } }
        if constexpr (ALIGN_EPI) { if (wr == 1) PG8_BAR; }
    }
    PG8_WAIT_V(0);
    if constexpr (!ALIGN_EPI) { if (wr == 0) PG8_BAR; }
    PG8_BAR;
    if constexpr (Epi::AFTER_DRAIN) { E.fused(acc, cur, wr, wc, fr, fq, lds, wid, lane); S.done(cur); }
#undef PG8_SA
#undef PG8_SB
#undef PG8_STAGE
#undef PG8_STAGE_A
#undef PG8_ROWS
#undef PG8_LDA
#undef PG8_LDB
#undef PG8_MMA
#undef PG8_WAIT_V
#undef PG8_WAIT_L
#undef PG8_BAR
#undef PG8_SCHED
}
}

constexpr int NWAVES = 8;
constexpr int NB = 8, SEQ = 4096, DM = 1024, MTOK = NB * SEQ, NLAYER = 2;
constexpr int INC = 2984, INCP = 3072;
constexpr int C_RET = 0, C_RW = 1024, C_DSA = 1920, C_SB = 2216;
constexpr int PBW = 1792, PFW = 1280, PB_SB = 1024, PF_DSA = 896;
constexpr int NEXP = 32, MOE_ROWS = MTOK * 4 + NEXP * 256;
constexpr int ROPE_W = 88;
constexpr int NCH = 16, TCH = SEQ / NCH;
constexpr int NPL = 11, NPHASE = 1 + NLAYER * NPL;
enum { I_X = 0, I_C, I_POS, I_ADAW, I_ADAB, I_NMIX, I_NFFN, I_WIN, I_RETGN, I_MU, I_W0, I_W2, I_A0, I_A2, I_G2, I_KK, I_KA, I_RK, I_LN, I_QNORM, I_WQ, I_WQI, I_DONORM, I_SONORM, I_WOUT, I_RW, I_RB, I_MW1, I_MB1, I_MW2, I_MB2, I_NFINAL, N_IN };

constexpr size_t MiB = 1u << 20;
constexpr size_t WS_CTL = 0, CTL_ZERO_BYTES = 1 * MiB;
constexpr size_t WS_MOD = 1 * MiB, WS_ROPE = 2 * MiB, WS_WIN = 14 * MiB, WS_WOUT = 26 * MiB, WS_W1 = 30 * MiB, WS_W2 = 286 * MiB;
constexpr size_t WS_XA = 414 * MiB, WS_H = 542 * MiB, WS_MIX = 606 * MiB, WS_TOPI = 670 * MiB, WS_TOPW = 671 * MiB, WS_POS = 672 * MiB;
constexpr size_t WS_R = 674 * MiB;
constexpr size_t WS_PB = WS_R  , WS_PF = WS_R + 112 * MiB  , WS_RWA = 946 * MiB  , WS_DQ = 1314 * MiB  , WS_DKB = 1330 * MiB  , WS_DVB = 1334 * MiB  , WS_DQI = 1346 * MiB  , WS_DKI = 1394 * MiB  , WS_DW = 1398 * MiB;
constexpr size_t WS_SMALLW = 1338 * MiB  ;
constexpr int SMW_QI = 0, SMW_W2 = 512 * 128, SMW_A2 = SMW_W2 + 256 * 32, SMW_G2 = SMW_A2 + 256 * 32, SMW_LAYER = SMW_G2 + 256 * 64;
constexpr size_t WS_PT = 1362 * MiB  ;
constexpr size_t WS_CH = WS_H  , WS_SI = WS_H + 16 * MiB  , WS_SIR = WS_H + 24 * MiB  ,
                 WS_CHR = WS_H + 32 * MiB  , WS_PTR = WS_H + 40 * MiB  ;
constexpr size_t WS_SQ = WS_MIX  , WS_SK = WS_MIX + 16 * MiB, WS_SV = WS_MIX + 32 * MiB;
constexpr size_t WS_YO = 1400 * MiB  , WS_SC = 1528 * MiB  ;
constexpr size_t WS_XS = WS_R  , WS_ACT = 946 * MiB  ;
constexpr size_t WS_LIST = 2040 * MiB  , WS_END = 2044 * MiB;
constexpr int LCAP = 32768;
static_assert((size_t)MOE_ROWS * 2048 <= 272 * MiB, "moe buffers");
constexpr int CW_TMO = 0, CW_CODE = 1, CW_GCNT = 256  , CW_DSAQ = 1024  , CW_BAR = 4096, CW_BLKCNT = 16384  ;
constexpr int RING_BYTES = 131072, MISC_OFF = RING_BYTES + 320, TST_OFF = RING_BYTES + 1024  , TAB_OFF = RING_BYTES + 2048  , HIST_OFF = RING_BYTES + 5120  , BASE_OFF = RING_BYTES + 5376  , CNT_OFF = RING_BYTES + 5632  , TEXP_OFF = RING_BYTES + 6144  , LDS_BYTES = 147456;

#if defined(__HIP_DEVICE_COMPILE__)
#define GAS __attribute__((address_space(1)))
#define CAS __attribute__((address_space(4)))
#else
#define GAS
#define CAS
#endif
#define LAS __attribute__((address_space(3)))
typedef unsigned short bf16;
typedef unsigned v4u __attribute__((ext_vector_type(4)));
typedef unsigned v2u __attribute__((ext_vector_type(2)));
typedef float f32x4 __attribute__((ext_vector_type(4)));
typedef GAS unsigned gu32;
typedef short bf16x8v __attribute__((ext_vector_type(8)));
typedef short s16x4v __attribute__((ext_vector_type(4)));
typedef _Float16 f16x8 __attribute__((ext_vector_type(8)));
#define RLX_AGENT __ATOMIC_RELAXED, __HIP_MEMORY_SCOPE_AGENT
#define LDS_WAIT() asm volatile("s_waitcnt lgkmcnt(0)" ::: "memory")
#define VM_WAIT() asm volatile("s_waitcnt vmcnt(0)" ::: "memory")
__device__ __forceinline__ unsigned f2bf(float f) { unsigned u = __builtin_bit_cast(unsigned, f); return (u + 0x7fffu + ((u >> 16) & 1u)) >> 16; }
__device__ __forceinline__ unsigned pk2(float lo, float hi) { return f2bf(lo) | (f2bf(hi) << 16); }
__device__ __forceinline__ float bf_lo(unsigned w) { return __builtin_bit_cast(float, w << 16); }
__device__ __forceinline__ float bf_hi(unsigned w) { return __builtin_bit_cast(float, w & 0xffff0000u); }
__device__ __forceinline__ float wave_sum(float v) {
#pragma unroll
    for (int o = 1; o < 64; o <<= 1) v += __shfl_xor(v, o);
    return v;
}
__device__ __forceinline__ float wave_max(float v) {
#pragma unroll
    for (int o = 1; o < 64; o <<= 1) v = fmaxf(v, __shfl_xor(v, o));
    return v;
}
__device__ __forceinline__ float grp16_sum(float v) { v += __shfl_xor(v, 1); v += __shfl_xor(v, 2); v += __shfl_xor(v, 4); v += __shfl_xor(v, 8); return v; }
__device__ __forceinline__ float grp8_sum(float v) { v += __shfl_xor(v, 1); v += __shfl_xor(v, 2); v += __shfl_xor(v, 4); return v; }
__device__ __forceinline__ float sum4(f32x4 a) { return (a.x + a.y) + (a.z + a.w); }
__device__ __forceinline__ float dot4(f32x4 a, f32x4 b) { return (a.x * b.x + a.y * b.y) + (a.z * b.z + a.w * b.w); }
__device__ __forceinline__ float fexp(float x) { return __builtin_amdgcn_exp2f(x * 1.4426950408889634f); }
__device__ __forceinline__ float sigm(float x) { return __builtin_amdgcn_rcpf(1.0f + fexp(-x)); }
__device__ __forceinline__ float softplusf(float x) { return fmaxf(x, 0.0f) + 0.6931471805599453f * __builtin_amdgcn_logf(1.0f + fexp(-fabsf(x))); }
__device__ __forceinline__ float ftanh(float x) { const float e = fexp(-2.0f * fabsf(x)); const float t = (1.0f - e) * __builtin_amdgcn_rcpf(1.0f + e); return x < 0.0f ? -t : t; }
__device__ __forceinline__ f32x4 shx4(f32x4 v, int m) { f32x4 r; r.x = __shfl_xor(v.x, m); r.y = __shfl_xor(v.y, m); r.z = __shfl_xor(v.z, m); r.w = __shfl_xor(v.w, m); return r; }

#define XB_TMO      128
#define XB_XCNT(j)  (256  + 64 * (j))
#define XB_XSUB(j)  (1280 + 64 * (j))
#define XB_XGEN(j)  (2304 + 64 * (j))
#define XB_TOP      3328
#define XB_TOPGEN   3392
#define XCD_BAR_WORDS 3456
#define XB_SPIN_CAP (1u << 18)

__device__ __forceinline__ unsigned xb_ld(unsigned* p)              { return __hip_atomic_load(p, __ATOMIC_RELAXED, __HIP_MEMORY_SCOPE_AGENT); }
__device__ __forceinline__ unsigned xb_add(unsigned* p, unsigned v) { return __hip_atomic_fetch_add(p, v, __ATOMIC_RELAXED, __HIP_MEMORY_SCOPE_AGENT); }
__device__ __forceinline__ unsigned xb_xcc_id() { return (unsigned)__builtin_amdgcn_s_getreg((3 << 11) | 20) & 0xFu; }
#define XB_SPIN(cond, bar) do { unsigned _sp = 0; while (cond) { __builtin_amdgcn_s_sleep(1); \
    if ((++_sp & 255u) == 0u) { if (xb_ld(&(bar)[XB_TMO])) break; if (_sp > XB_SPIN_CAP) { atomicAdd(&(bar)[XB_TMO], 1u); break; } } } } while (0)

struct XcdBarrier {
    unsigned* bar; unsigned x;
    volatile LAS unsigned* st;
};

__device__ __forceinline__ XcdBarrier xcd_barrier_post(unsigned* bar, volatile LAS unsigned* st, int xb_tid) {
    XcdBarrier b; b.bar = bar; b.x = xb_xcc_id(); b.st = st;
    if (xb_tid == 0) (void)xb_add(&bar[XB_XCNT(b.x)], 1u);
    return b;
}
__device__ __forceinline__ void xcd_barrier_complete(unsigned* bar, unsigned x, unsigned& nloc, unsigned& nx) {
    const unsigned G = gridDim.x * gridDim.y * gridDim.z;
    unsigned sum, cnt, mine, sp = 0u;
    for (;;) {
        sum = 0u; cnt = 0u; mine = 0u;
#pragma unroll
        for (unsigned j = 0; j < 16; ++j) { const unsigned c = xb_ld(&bar[XB_XCNT(j)]); sum += c; cnt += (c > 0u) ? 1u : 0u; mine = (j == x) ? c : mine; }
        if (sum == G) break;
        __builtin_amdgcn_s_sleep(1);
        if ((++sp & 255u) == 0u) { if (xb_ld(&bar[XB_TMO])) break; if (sp > XB_SPIN_CAP) { atomicAdd(&bar[XB_TMO], 1u); break; } }
    }
    nloc = mine > 0u ? mine : 1u; nx = cnt > 0u ? cnt : 1u;
}

__device__ __forceinline__ void xcd_barrier(const XcdBarrier& b, int xb_tid) {
    asm volatile("s_waitcnt vmcnt(0)" ::: "memory");
    __syncthreads();
    if (xb_tid == 0) {
        unsigned* bar = b.bar;
        __builtin_amdgcn_s_waitcnt(0);
        unsigned nloc = b.st[0], nx = b.st[1];
        if (nloc == 0u) { xcd_barrier_complete(bar, b.x, nloc, nx); b.st[0] = nloc; b.st[1] = nx; }
        const unsigned old = xb_add(&bar[XB_XSUB(b.x)], 1u);
        const unsigned gen = old / nloc;
        if (old + 1u == (gen + 1u) * nloc) {
            __builtin_amdgcn_fence(__ATOMIC_RELEASE, "agent");
            asm volatile("s_waitcnt vmcnt(0)" ::: "memory");
            const unsigned og = xb_add(&bar[XB_TOP], 1u);
            const unsigned tg = og / nx;
            if (og + 1u == (tg + 1u) * nx) xb_add(&bar[XB_TOPGEN], 1u);
            else XB_SPIN(xb_ld(&bar[XB_TOPGEN]) == tg, bar);
            __builtin_amdgcn_fence(__ATOMIC_ACQUIRE, "agent");
            xb_add(&bar[XB_XGEN(b.x)], 1u);
            asm volatile("s_waitcnt vmcnt(0)" ::: "memory");
        } else {
            XB_SPIN(xb_ld(&bar[XB_XGEN(b.x)]) == gen, bar);
            __builtin_amdgcn_fence(__ATOMIC_ACQUIRE, "agent");
            asm volatile("s_waitcnt vmcnt(0)" ::: "memory");
        }
    }
    __syncthreads();
}
struct ArgsH { const float* in[N_IN]; float* out; unsigned char* ws; double invf[44]; int ph_lo, ph_hi, li, pad; };
struct ArgsD { const GAS float* in[N_IN]; GAS float* out; GAS unsigned char* ws; double invf[44]; int ph_lo, ph_hi, li, pad; };
static_assert(sizeof(ArgsH) == sizeof(ArgsD), "args layout");
typedef const CAS ArgsD& ARef;
__device__ __forceinline__ const CAS ArgsD* kargs() {
#if defined(__HIP_DEVICE_COMPILE__)
    const CAS ArgsD* p = (const CAS ArgsD*)__builtin_amdgcn_kernarg_segment_ptr(); asm volatile("" : "+s"(p)); return p;
#else
    return nullptr;
#endif
}
struct WI { LAS unsigned char* lds; int tid, lane, wave, vcu, G, gw, NGW, bx; };
constexpr size_t RWA_STRIDE = (33 * MiB + 68 * 1024) / 4;
constexpr size_t YO_STRIDE = 32 * MiB / 4;

__device__ __forceinline__ int wave_sum_i(int v) {
#pragma unroll
    for (int o = 1; o < 64; o <<= 1) v += __shfl_xor(v, o);
    return v;
}
__device__ __forceinline__ void sincos_d(double ang, float& s, float& c) {
    const double q = __builtin_rint(ang * 0.63661977236758134308);
    double r = __builtin_fma(-q, 1.57079632679489661923, ang); r = __builtin_fma(-q, 6.123233995736766e-17, r);
    const double r2 = r * r;
    const double sp = r * (1.0 + r2 * (-1.0 / 6 + r2 * (1.0 / 120 + r2 * (-1.0 / 5040 + r2 * (1.0 / 362880 + r2 * (-1.0 / 39916800 + r2 * (1.0 / 6227020800.0)))))));
    const double cp = 1.0 + r2 * (-0.5 + r2 * (1.0 / 24 + r2 * (-1.0 / 720 + r2 * (1.0 / 40320 + r2 * (-1.0 / 3628800 + r2 * (1.0 / 479001600 + r2 * (-1.0 / 87178291200.0)))))));
    const int qi = ((int)q) & 3;
    const double ss = (qi == 0) ? sp : (qi == 1) ? cp : (qi == 2) ? -sp : -cp;
    const double cc = (qi == 0) ? cp : (qi == 1) ? -sp : (qi == 2) ? -cp : sp;
    s = (float)ss; c = (float)cc;
}

struct TrItem { const float* src; bf16* dst; int ldw; float scale; bool ok; };
__device__ __forceinline__ void tr_decode(ARef A, int it, int lane, TrItem& d) {
    constexpr int I_IN = NLAYER * 16 * 96, I_OUT = NLAYER * 16 * 32, I_W1 = NLAYER * NEXP * 16 * 64;
    const float* W; int ldw, nvalid, k0, nsrc0; bf16* WT; size_t dstrow0; float scale = 1.0f;
    int r = it;
    if (r < I_IN) { const int l = r / 1536, rr = r % 1536, kb = rr / 96, nb = rr % 96;
        const int nd = nb * 32;
        nsrc0 = (nd < 1024) ? nd : (nd < 1792) ? C_SB + (nd - 1024) : (nd < 2688) ? C_RW + (nd - 1792) : C_DSA + (nd - 2688);
        nvalid = (nd < 1024) ? 1024 : (nd < 1792) ? INC : (nd < 2688) ? C_DSA : ((nd < INC) ? C_SB : 0);
        scale = (nd >= 256 && nd < 512) ? 0.125f : (nd >= 1024 && nd < 1280) ? 0.18033688011112042f : 1.0f;
        W = A.in[I_WIN] + (size_t)l * DM * INC; ldw = INC; k0 = kb * 64; WT = (bf16*)(A.ws + WS_WIN) + (size_t)l * INCP * DM; dstrow0 = (size_t)nd; }
    else if (r < I_IN + I_OUT) { r -= I_IN; const int l = r / 512, rr = r % 512, kb = rr / 32, nb = rr % 32;
        W = A.in[I_WOUT] + (size_t)l * DM * DM; ldw = DM; nvalid = DM; k0 = kb * 64; nsrc0 = nb * 32; WT = (bf16*)(A.ws + WS_WOUT) + (size_t)l * DM * DM; dstrow0 = (size_t)nb * 32; }
    else if (r < I_IN + I_OUT + I_W1) { r -= I_IN + I_OUT; const int le = r / 1024, rr = r % 1024, kb = rr / 64, nb = rr % 64, j = nb >> 3, bj = (nb >> 2) & 1, cc0 = (nb & 3) * 32;
        W = A.in[I_MW1] + (size_t)le * DM * 2048; ldw = 2048; nvalid = 2048; k0 = kb * 64; nsrc0 = bj * 1024 + 128 * j + cc0; WT = (bf16*)(A.ws + WS_W1) + (size_t)le * 2048 * DM; dstrow0 = (size_t)nb * 32; }
    else { r -= I_IN + I_OUT + I_W1; const int le = r / 512, rr = r % 512, kb = rr / 32, nb = rr % 32;
        W = A.in[I_MW2] + (size_t)le * DM * DM; ldw = DM; nvalid = DM; k0 = kb * 64; nsrc0 = nb * 32; WT = (bf16*)(A.ws + WS_W2) + (size_t)le * DM * DM; dstrow0 = (size_t)nb * 32; }
    const int n = nsrc0 + 4 * (lane & 7);
    d.ok = n < nvalid; d.src = W + (size_t)(k0 + (lane >> 3)) * ldw + (d.ok ? n : 0); d.ldw = ldw; d.scale = scale;
    d.dst = WT + (dstrow0 + (lane >> 3)) * 1024 + k0 + 8 * (lane & 7);
}
__device__ __forceinline__ void tr_load(const TrItem& d, f32x4 (&v)[8]) {
#pragma unroll
    for (int i = 0; i < 8; ++i) v[i] = *(const f32x4*)(d.src + (size_t)(8 * i) * d.ldw);
}
__device__ __forceinline__ void tr_store(const TrItem& d, const f32x4 (&v)[8], LAS float* scr, int lane) {
    const float sc_ = d.ok ? d.scale : 0.0f;
#pragma unroll
    for (int i = 0; i < 8; ++i) { LAS float* s = scr + (8 * i + (lane >> 3)) * 33 + 4 * (lane & 7); s[0] = v[i].x * sc_; s[1] = v[i].y * sc_; s[2] = v[i].z * sc_; s[3] = v[i].w * sc_; }
    LDS_WAIT(); asm volatile("" ::: "memory");
    const int c8 = lane & 7;
#pragma unroll
    for (int j = 0; j < 4; ++j) { const int n = (lane >> 3) + 8 * j; const LAS float* s = scr + (8 * c8) * 33 + n;
        v4u o; o.x = pk2(s[0 * 33], s[1 * 33]); o.y = pk2(s[2 * 33], s[3 * 33]); o.z = pk2(s[4 * 33], s[5 * 33]); o.w = pk2(s[6 * 33], s[7 * 33]);
        *(v4u*)(d.dst + (size_t)(8 * j) * 1024) = o; }
    LDS_WAIT(); asm volatile("" ::: "memory");
}
__device__ __forceinline__ void ph_prologue(ARef A, const WI& w) {
    LAS float* sc = (LAS float*)w.lds;
    { const float* cin = A.in[I_C]; for (int i = w.tid; i < NB * DM; i += NWAVES * 64) { const float v = cin[i]; sc[i] = v / (1.0f + expf(-v)); } }
    __syncthreads();
    float* MOD = (float*)(A.ws + WS_MOD);
    LAS float* red = (LAS float*)(w.lds + 32768);
    if (w.vcu < 192) {
        const int l = w.vcu / 96, col = (w.vcu % 96) * 64 + w.lane, kw = 128 * w.wave;
        const float* wp = A.in[I_ADAW] + (size_t)l * DM * 6144 + (size_t)kw * 6144 + col;
        float acc[8];
#pragma unroll
        for (int b = 0; b < 8; ++b) acc[b] = 0.0f;
#pragma unroll 16
        for (int k = 0; k < 128; ++k) { const float wv = wp[(size_t)k * 6144];
#pragma unroll
            for (int b = 0; b < 8; ++b) acc[b] += sc[b * DM + kw + k] * wv; }
#pragma unroll
        for (int b = 0; b < 8; ++b) red[(w.wave * 8 + b) * 64 + w.lane] = acc[b];
    }
    __syncthreads();
    if (w.vcu < 192) { const int l = w.vcu / 96, b = w.wave, col = (w.vcu % 96) * 64 + w.lane;
        float s = A.in[I_ADAB][l * 6144 + col];
#pragma unroll
        for (int q = 0; q < 8; ++q) s += red[(q * 8 + b) * 64 + w.lane];
        MOD[(size_t)(l * 8 + b) * 6144 + col] = s; }
    __syncthreads();
    LAS float* scr = (LAS float*)(w.lds + 32768 + w.wave * 8448);
    constexpr int NIT = NLAYER * 16 * 96 + NLAYER * 16 * 32;
    { TrItem d0, d1; f32x4 va[8], vb[8];
      int it = w.gw; bool h0 = it < NIT;
      if (h0) { tr_decode(A, it, w.lane, d0); tr_load(d0, va); }
      while (h0) {
          it += w.NGW; const bool h1 = it < NIT;
          if (h1) { tr_decode(A, it, w.lane, d1); tr_load(d1, vb); }
          tr_store(d0, va, scr, w.lane);
          if (!h1) break;
          it += w.NGW; h0 = it < NIT;
          if (h0) { tr_decode(A, it, w.lane, d0); tr_load(d0, va); }
          tr_store(d1, vb, scr, w.lane);
      } }
    float* RT = (float*)(A.ws + WS_ROPE); const int* pos = (const int*)A.in[I_POS];
    for (int g = w.gw * 64 + w.lane; g < MTOK * 44; g += w.NGW * 64) {
        const int tok = g / 44, f = g % 44; int co, so;
        if (f < 32) { co = f; so = 32 + f; } else if (f < 40) { co = 64 + (f - 32); so = 72 + (f - 32); } else { co = 80 + (f - 40); so = 84 + (f - 40); }
        float s, c; sincos_d((double)pos[tok] * A.invf[f], s, c);
        RT[(size_t)tok * ROPE_W + co] = c; RT[(size_t)tok * ROPE_W + so] = s;
    }
}

__device__ __forceinline__ void moe_convert_chunk(ARef A, int l, int c, int lane, LAS float* scr) {
    constexpr int I0 = NLAYER * 16 * 96 + NLAYER * 16 * 32, I_W1 = NLAYER * NEXP * 16 * 64;
    const int it0 = (c < 8192) ? I0 + l * 32768 + 4 * c : I0 + I_W1 + l * 16384 + 4 * (c - 8192);
    TrItem d0, d1; f32x4 va[8], vb[8];
    tr_decode(A, it0, lane, d0); tr_load(d0, va);
    tr_decode(A, it0 + 1, lane, d1); tr_load(d1, vb);
    tr_store(d0, va, scr, lane);
    tr_decode(A, it0 + 2, lane, d0); tr_load(d0, va);
    tr_store(d1, vb, scr, lane);
    tr_decode(A, it0 + 3, lane, d1); tr_load(d1, vb);
    tr_store(d0, va, scr, lane);
    tr_store(d1, vb, scr, lane);
}

__device__ __forceinline__ void emit_h_row(const f32x4 (&v)[4], float rstd, const float* g, const float* sc, const float* sh, bf16* hrow, int lane) {
#pragma unroll
    for (int j = 0; j < 4; ++j) { const int k = 4 * (lane + 64 * j);
        const f32x4 gv = *(const f32x4*)(g + k), scv = *(const f32x4*)(sc + k), shv = *(const f32x4*)(sh + k);
        const f32x4 h = v[j] * rstd * gv * (1.0f + scv) + shv;
        v2u o; o.x = pk2(h.x, h.y); o.y = pk2(h.z, h.w); *(v2u*)(hrow + k) = o; }
}
__device__ __forceinline__ void small_weights_to_f16(ARef A, const WI& w) {
    { _Float16* SW = (_Float16*)(A.ws + WS_SMALLW);
      const int g0 = w.gw * 64 + w.lane, gs = w.NGW * 64;
      for (int l = 0; l < NLAYER; ++l) { _Float16* S = SW + (size_t)l * SMW_LAYER;
          const float* wq = A.in[I_WQ] + (size_t)l * 128 * 256; const float* wqi = A.in[I_WQI] + (size_t)l * 128 * 256;
          for (int e = g0; e < 256 * 128; e += gs) { const int n = e >> 7, k = e & 127; S[SMW_QI + e] = (_Float16)wq[k * 256 + n]; S[SMW_QI + 256 * 128 + e] = (_Float16)wqi[k * 256 + n]; }
          const float* w2 = A.in[I_W2] + (size_t)l * 32 * 256; const float* a2 = A.in[I_A2] + (size_t)l * 32 * 256; const float* g2 = A.in[I_G2] + (size_t)l * 64 * 256;
          for (int e = g0; e < 256 * 32; e += gs) { const int n = e >> 5, k = e & 31; S[SMW_W2 + e] = (_Float16)w2[k * 256 + n]; S[SMW_A2 + e] = (_Float16)a2[k * 256 + n]; }
          for (int e = g0; e < 256 * 64; e += gs) { const int n = e >> 6, k = e & 63; S[SMW_G2 + e] = (_Float16)g2[k * 256 + n]; } } }
}
__device__ __forceinline__ void ph_norm1(ARef A, const WI& w) {
    const float* MOD = (const float*)(A.ws + WS_MOD); bf16* H = (bf16*)(A.ws + WS_H);
    for (int m = w.gw; m < MTOK; m += w.NGW) {
        const float* xr = A.in[I_X] + (size_t)m * DM; f32x4 v[4]; float ss = 0.0f;
#pragma unroll
        for (int j = 0; j < 4; ++j) { v[j] = *(const f32x4*)(xr + 4 * (w.lane + 64 * j)); ss += dot4(v[j], v[j]); }
        ss = wave_sum(ss); const float rstd = 1.0f / sqrtf(ss * (1.0f / DM) + 1e-5f);
        const float* mb = MOD + (size_t)(m >> 12) * 6144;
        emit_h_row(v, rstd, A.in[I_NMIX], mb + 1024, mb, H + (size_t)m * DM, w.lane);
    }
}

typedef _Float16 h4v __attribute__((ext_vector_type(4)));
__device__ __forceinline__ f16x8 pack_f16x8(f32x4 a, f32x4 b) { f16x8 r; r[0] = (_Float16)a.x; r[1] = (_Float16)a.y; r[2] = (_Float16)a.z; r[3] = (_Float16)a.w; r[4] = (_Float16)b.x; r[5] = (_Float16)b.y; r[6] = (_Float16)b.z; r[7] = (_Float16)b.w; return r; }
__device__ __forceinline__ f32x4 ldb4(const bf16* q) { const v2u x = *(const v2u*)q; return (f32x4){bf_lo(x.x), bf_hi(x.x), bf_lo(x.y), bf_hi(x.y)}; }
__device__ __forceinline__ void prep16_body(const bf16* __restrict__ P, float* __restrict__ RWA, const _Float16* __restrict__ SW, const float* __restrict__ RT, bf16* __restrict__ DQ, _Float16* __restrict__ DQI,
                                            bf16* __restrict__ DKB, bf16* __restrict__ DVB, _Float16* __restrict__ DKI, float* __restrict__ DW, const float* __restrict__ mu, const float* __restrict__ qn,
                                            const float* __restrict__ w0p, const float* __restrict__ a0p, const float* __restrict__ kkp, const float* __restrict__ kap, const float* __restrict__ rkp, int m0, int lane_in, int part = 7) {
    int lane = lane_in; asm volatile("" : "+v"(lane));
    const int tk = lane & 15, q4 = lane >> 4, m = m0 + tk, t = m & (SEQ - 1);
    const bf16* pr = P + (size_t)m * PFW; const bf16* pp = pr - PFW; const bf16* pd = P + (size_t)m * PFW + PF_DSA;
    RT += (size_t)m * ROPE_W; const f32x4 zero4 = {0.f, 0.f, 0.f, 0.f};
    f16x8 bx[4], bc[4];
    { float ss = 0.0f; f32x4 c[4][2];
#pragma unroll
      for (int ks = 0; ks < 4; ++ks) { const int f0 = 32 * ks + 8 * q4;
          f32x4 x[2];
#pragma unroll
          for (int u = 0; u < 2; ++u) { const f32x4 z = ldb4(pr + 768 + f0 + 4 * u); const f32x4 p = t ? ldb4(pp + 768 + f0 + 4 * u) : zero4; x[u] = z + (p - z) * *(const f32x4*)(mu + 768 + f0 + 4 * u);
#pragma unroll
              for (int i = 0; i < 4; ++i) x[u][i] = (ks == 0) ? ftanh(x[u][i]) : (ks == 1) ? x[u][i] : sigm(x[u][i]); }
          bx[ks] = pack_f16x8(x[0], x[1]);
          c[ks][0] = ldb4(pd + f0); c[ks][1] = ldb4(pd + f0 + 4); ss += dot4(c[ks][0], c[ks][0]) + dot4(c[ks][1], c[ks][1]); }
      ss += __shfl_xor(ss, 16); ss += __shfl_xor(ss, 32);
      const float rstd = 1.0f / sqrtf(ss * (1.0f / 128.0f) + 1e-5f);
#pragma unroll
      for (int ks = 0; ks < 4; ++ks) { const int f0 = 32 * ks + 8 * q4; bc[ks] = pack_f16x8(c[ks][0] * rstd * *(const f32x4*)(qn + f0), c[ks][1] * rstd * *(const f32x4*)(qn + f0 + 4)); } }
    const _Float16* wrow = SW + (size_t)tk * 0;
    (void)wrow;
    const int arow = lane & 15;
    if (part & 1)
#pragma unroll 2
    for (int hd = 0; hd < 4; ++hd) {
        f32x4 fk[4], av[4]; float ssk = 0.0f;
#pragma unroll
        for (int j = 0; j < 4; ++j) { const int nb = 4 * hd + j, ch = 16 * nb + 4 * q4; const size_t o = (size_t)m * 256 + ch;
            const f16x8 aw = *(const f16x8*)(SW + SMW_W2 + (16 * nb + arow) * 32 + 8 * q4), aa = *(const f16x8*)(SW + SMW_A2 + (16 * nb + arow) * 32 + 8 * q4);
            const f16x8 ag0 = *(const f16x8*)(SW + SMW_G2 + (16 * nb + arow) * 64 + 8 * q4), ag1 = *(const f16x8*)(SW + SMW_G2 + (16 * nb + arow) * 64 + 32 + 8 * q4);
            const f32x4 cw = __builtin_amdgcn_mfma_f32_16x16x32_f16(aw, bx[0], *(const f32x4*)(w0p + ch), 0, 0, 0);
            const f32x4 ca = __builtin_amdgcn_mfma_f32_16x16x32_f16(aa, bx[1], *(const f32x4*)(a0p + ch), 0, 0, 0);
            f32x4 cg = __builtin_amdgcn_mfma_f32_16x16x32_f16(ag0, bx[2], zero4, 0, 0, 0); cg = __builtin_amdgcn_mfma_f32_16x16x32_f16(ag1, bx[3], cg, 0, 0, 0);
            f32x4 dec;
#pragma unroll
            for (int i = 0; i < 4; ++i) { dec[i] = fexp(-fexp(-softplusf(-cw[i]) - 0.5f)); av[j][i] = sigm(ca[i]); }
            *(f32x4*)(RWA + 1 * RWA_STRIDE + o) = dec; *(f32x4*)(RWA + 6 * RWA_STRIDE + o) = cg;
            { const f32x4 z = ldb4(pr + 256 + ch); const f32x4 p = t ? ldb4(pp + 256 + ch) : zero4; fk[j] = z + (p - z) * *(const f32x4*)(mu + 256 + ch); }
            const f32x4 kk = fk[j] * *(const f32x4*)(kkp + ch); ssk += dot4(kk, kk); }
        ssk += __shfl_xor(ssk, 16); ssk += __shfl_xor(ssk, 32);
        const float inrm = 1.0f / fmaxf(sqrtf(ssk), 1e-12f);
        f32x4 fr[4], km[4]; float bs = 0.0f;
#pragma unroll
        for (int j = 0; j < 4; ++j) { const int ch = 16 * (4 * hd + j) + 4 * q4;
            { const f32x4 z = ldb4(pr + ch); const f32x4 p = t ? ldb4(pp + ch) : zero4; fr[j] = z + (p - z) * *(const f32x4*)(mu + ch); }
            km[j] = fk[j] * (1.0f + (av[j] - 1.0f) * *(const f32x4*)(kap + ch)); bs += dot4(fr[j] * km[j], *(const f32x4*)(rkp + ch)); }
        bs += __shfl_xor(bs, 16); bs += __shfl_xor(bs, 32);
#pragma unroll
        for (int j = 0; j < 4; ++j) { const int ch = 16 * (4 * hd + j) + 4 * q4; const size_t o = (size_t)m * 256 + ch;
            f32x4 fv; { const f32x4 z = ldb4(pr + 512 + ch); const f32x4 p = t ? ldb4(pp + 512 + ch) : zero4; fv = z + (p - z) * *(const f32x4*)(mu + 512 + ch); }
            const f32x4 kk = fk[j] * *(const f32x4*)(kkp + ch) * inrm;
            *(f32x4*)(RWA + 0 * RWA_STRIDE + o) = fr[j]; *(f32x4*)(RWA + 2 * RWA_STRIDE + o) = km[j]; *(f32x4*)(RWA + 3 * RWA_STRIDE + o) = fv;
            *(f32x4*)(RWA + 4 * RWA_STRIDE + o) = -kk; *(f32x4*)(RWA + 5 * RWA_STRIDE + o) = kk * av[j]; *(f32x4*)(RWA + 7 * RWA_STRIDE + o) = bs * fv; }
    }
    if (part & 2)
#pragma unroll 4
    for (int nb = 0; nb < 32; ++nb) {
        f32x4 cq = zero4;
#pragma unroll
        for (int ks = 0; ks < 4; ++ks) { const f16x8 aq = *(const f16x8*)(SW + SMW_QI + (16 * nb + arow) * 128 + 32 * ks + 8 * q4); cq = __builtin_amdgcn_mfma_f32_16x16x32_f16(aq, bc[ks], cq, 0, 0, 0); }
        const int ch = 16 * (nb & 15) + 4 * q4;
        if (nb < 16) {
            if ((nb & 3) == 0) { const f32x4 ot = shx4(cq, 32); const int fi = 4 * (q4 & 1); const f32x4 cs4 = *(const f32x4*)(RT + 64 + fi), sn = *(const f32x4*)(RT + 72 + fi); cq = (q4 < 2) ? cq * cs4 - ot * sn : ot * sn + cq * cs4; }
            const f32x4 qs = cq * 0.18033688011112042f; v2u o; o.x = pk2(qs.x, qs.y); o.y = pk2(qs.z, qs.w); *(v2u*)(DQ + (size_t)m * 256 + ch) = o;
        } else {
            if ((nb & 1) == 0) { const f32x4 ot = shx4(cq, 16); const f32x4 cs4 = *(const f32x4*)(RT + 80), sn = *(const f32x4*)(RT + 84); if (q4 < 2) cq = (q4 < 1) ? cq * cs4 - ot * sn : ot * sn + cq * cs4; }
            h4v hq; hq.x = (_Float16)cq.x; hq.y = (_Float16)cq.y; hq.z = (_Float16)cq.z; hq.w = (_Float16)cq.w; *(h4v*)(DQI + (size_t)m * 256 + ch) = hq;
        }
    }
#pragma unroll
    for (int j = 0; j < 4; ++j) { const int d = 16 * j + 4 * q4; f32x4 kx = ldb4(pd + 128 + d);
        if (j == 0) { const f32x4 ot = shx4(kx, 32); const int fi = 4 * (q4 & 1); const f32x4 cs4 = *(const f32x4*)(RT + 64 + fi), sn = *(const f32x4*)(RT + 72 + fi); kx = (q4 < 2) ? kx * cs4 - ot * sn : ot * sn + kx * cs4; }
        v2u o; o.x = pk2(kx.x, kx.y); o.y = pk2(kx.z, kx.w); *(v2u*)(DKB + (size_t)m * 64 + d) = o;
        const f32x4 vx = ldb4(pd + 192 + d); v2u ov; ov.x = pk2(vx.x, vx.y); ov.y = pk2(vx.z, vx.w); *(v2u*)(DVB + (size_t)m * 64 + d) = ov; }
#pragma unroll
    for (int j = 0; j < 2; ++j) { const int d = 16 * j + 4 * q4; f32x4 ki = ldb4(pd + 256 + d);
        if (j == 0) { const f32x4 ot = shx4(ki, 16); const f32x4 cs4 = *(const f32x4*)(RT + 80), sn = *(const f32x4*)(RT + 84); if (q4 < 2) ki = (q4 < 1) ? ki * cs4 - ot * sn : ot * sn + ki * cs4; }
        h4v hk; hk.x = (_Float16)ki.x; hk.y = (_Float16)ki.y; hk.z = (_Float16)ki.z; hk.w = (_Float16)ki.w; *(h4v*)(DKI + (size_t)m * 32 + d) = hk; }
    if (q4 < 2) *(f32x4*)(DW + (size_t)m * 8 + 4 * q4) = ldb4(pd + 288 + 4 * q4) * 0.0625f;
}

__device__ __forceinline__ void prep16(ARef A, int l, int m0, int lane_in, int part = 7) {
    prep16_body((const bf16*)(A.ws + WS_PF), (float*)(A.ws + WS_RWA), (const _Float16*)(A.ws + WS_SMALLW) + (size_t)l * SMW_LAYER, (const float*)(A.ws + WS_ROPE), (bf16*)(A.ws + WS_DQ), (_Float16*)(A.ws + WS_DQI),
                (bf16*)(A.ws + WS_DKB), (bf16*)(A.ws + WS_DVB), (_Float16*)(A.ws + WS_DKI), (float*)(A.ws + WS_DW), A.in[I_MU] + l * 896, A.in[I_QNORM] + l * 128,
                A.in[I_W0] + l * 256, A.in[I_A0] + l * 256, A.in[I_KK] + l * 256, A.in[I_KA] + l * 256, A.in[I_RK] + l * 256, m0, lane_in, part);
}
__device__ __forceinline__ float quad_sum(float v) {
    v += __builtin_bit_cast(float, __builtin_amdgcn_mov_dpp(__builtin_bit_cast(int, v), 0xB1, 0xF, 0xF, true));
    v += __builtin_bit_cast(float, __builtin_amdgcn_mov_dpp(__builtin_bit_cast(int, v), 0x4E, 0xF, 0xF, true));
    return v;
}
__device__ __forceinline__ float oct_sum(float v) {
    v += __builtin_bit_cast(float, __builtin_amdgcn_mov_dpp(__builtin_bit_cast(int, v), 0xB1, 0xF, 0xF, true));
    v += __builtin_bit_cast(float, __builtin_amdgcn_mov_dpp(__builtin_bit_cast(int, v), 0x4E, 0xF, 0xF, true));
    v += __builtin_bit_cast(float, __builtin_amdgcn_mov_dpp(__builtin_bit_cast(int, v), 0x141, 0xF, 0xF, true));
    return v;
}
typedef float f32x2 __attribute__((ext_vector_type(2)));
#define LO2(v_) __builtin_shufflevector(v_, v_, 0, 1)
#define HI2(v_) __builtin_shufflevector(v_, v_, 2, 3)
#define RW_ROW(i_) (((i_) < 2) ? (16 * ws + rg + 8 * (i_)) : (64 + 16 * ws + rg + 8 * ((i_) - 2)))
#define RW_LOAD(op, s_) do { const int lo_ = (s_) * 64 + kq * 8; \
    op[0] = *(const LAS f32x4*)(sn + lo_); op[1] = *(const LAS f32x4*)(sn + lo_ + 4); op[2] = *(const LAS f32x4*)(sw + lo_); op[3] = *(const LAS f32x4*)(sw + lo_ + 4); \
    op[4] = *(const LAS f32x4*)(sb + lo_); op[5] = *(const LAS f32x4*)(sb + lo_ + 4); op[6] = *(const LAS f32x4*)(sk + lo_); op[7] = *(const LAS f32x4*)(sk + lo_ + 4); \
    op[8] = *(const LAS f32x4*)(sr + lo_); op[9] = *(const LAS f32x4*)(sr + lo_ + 4); \
    vin[0] = sv[(s_) * 64 + 16 * ws + rg]; vin[1] = sv[(s_) * 64 + 16 * ws + rg + 8]; } while (0)
#define RW_DOT(i_, oa, ob) ({ f32x2 d_ = S[i_][0] * LO2(oa); d_ = S[i_][1] * HI2(oa) + d_; d_ = S[i_][2] * LO2(ob) + d_; d_ = S[i_][3] * HI2(ob) + d_; d_.x + d_.y; })
#define RW_STEP(op, vv, s_) do { float sa_[4], y_[4]; \
    _Pragma("unroll") for (int i_ = 0; i_ < 4; ++i_) sa_[i_] = RW_DOT(i_, op[0], op[1]); \
    _Pragma("unroll") for (int i_ = 0; i_ < 4; ++i_) sa_[i_] += __builtin_bit_cast(float, __builtin_amdgcn_mov_dpp(__builtin_bit_cast(int, sa_[i_]), 0xB1, 0xF, 0xF, true)); \
    _Pragma("unroll") for (int i_ = 0; i_ < 4; ++i_) sa_[i_] += __builtin_bit_cast(float, __builtin_amdgcn_mov_dpp(__builtin_bit_cast(int, sa_[i_]), 0x4E, 0xF, 0xF, true)); \
    _Pragma("unroll") for (int i_ = 0; i_ < 4; ++i_) sa_[i_] += __builtin_bit_cast(float, __builtin_amdgcn_mov_dpp(__builtin_bit_cast(int, sa_[i_]), 0x141, 0xF, 0xF, true)); \
    _Pragma("unroll") for (int i_ = 0; i_ < 2; ++i_) { const f32x2 a2_ = {sa_[i_], sa_[i_]}, v2_ = {vv[i_], vv[i_]}; \
        S[i_][0] = S[i_][0] * LO2(op[2]) + (a2_ * LO2(op[4]) + v2_ * LO2(op[6])); S[i_][1] = S[i_][1] * HI2(op[2]) + (a2_ * HI2(op[4]) + v2_ * HI2(op[6])); \
        S[i_][2] = S[i_][2] * LO2(op[3]) + (a2_ * LO2(op[5]) + v2_ * LO2(op[7])); S[i_][3] = S[i_][3] * HI2(op[3]) + (a2_ * HI2(op[5]) + v2_ * HI2(op[7])); } \
    _Pragma("unroll") for (int i_ = 2; i_ < 4; ++i_) { const f32x2 a2_ = {sa_[i_], sa_[i_]}; \
        S[i_][0] = S[i_][0] * LO2(op[2]) + a2_ * LO2(op[4]); S[i_][1] = S[i_][1] * HI2(op[2]) + a2_ * HI2(op[4]); S[i_][2] = S[i_][2] * LO2(op[3]) + a2_ * LO2(op[5]); S[i_][3] = S[i_][3] * HI2(op[3]) + a2_ * HI2(op[5]); } \
    _Pragma("unroll") for (int i_ = 0; i_ < 4; ++i_) y_[i_] = RW_DOT(i_, op[8], op[9]); \
    _Pragma("unroll") for (int i_ = 0; i_ < 4; ++i_) y_[i_] += __builtin_bit_cast(float, __builtin_amdgcn_mov_dpp(__builtin_bit_cast(int, y_[i_]), 0xB1, 0xF, 0xF, true)); \
    _Pragma("unroll") for (int i_ = 0; i_ < 4; ++i_) y_[i_] += __builtin_bit_cast(float, __builtin_amdgcn_mov_dpp(__builtin_bit_cast(int, y_[i_]), 0x4E, 0xF, 0xF, true)); \
    _Pragma("unroll") for (int i_ = 0; i_ < 4; ++i_) y_[i_] += __builtin_bit_cast(float, __builtin_amdgcn_mov_dpp(__builtin_bit_cast(int, y_[i_]), 0x141, 0xF, 0xF, true)); \
    if (kq == 0) { _Pragma("unroll") for (int i_ = 0; i_ < 4; ++i_) so[(s_) * 128 + RW_ROW(i_)] = y_[i_]; } } while (0)
__device__ __forceinline__ void scan_rwkv_task2(ARef A, const WI& w, int task0) {
    const int slot = w.wave >> 2, ws = w.wave & 3, lt = w.tid & 255, task = task0 + slot;
    const int bh = task >> 4, c = task & 15, b = bh >> 2, h = bh & 3;
    LAS float* sw = (LAS float*)w.lds + slot * 16384; LAS float* sn = sw + 2048; LAS float* sb = sn + 2048; LAS float* sk = sb + 2048; LAS float* sr = sk + 2048; LAS float* sv = sr + 2048; LAS float* so = sv + 2048;
    const float* RWA = (const float*)(A.ws + WS_RWA);
    const int rg = w.lane >> 3, kq = w.lane & 7;
    f32x2 S[4][4];
#pragma unroll
    for (int i = 0; i < 4; ++i)
#pragma unroll
        for (int j = 0; j < 4; ++j) { const int r = RW_ROW(i); S[i][j].x = (r >= 64 && 8 * kq + 2 * j == r - 64) ? 1.0f : 0.0f; S[i][j].y = (r >= 64 && 8 * kq + 2 * j + 1 == r - 64) ? 1.0f : 0.0f; }
    const size_t tok0 = (size_t)b * SEQ + (size_t)c * TCH;
    const int st = lt >> 3, sd = (lt & 7) * 8;
    f32x4 a[6][2];
#define RW_GLOAD(sub_) do { const size_t o_ = (tok0 + (sub_) * 32 + st) * 256 + h * 64 + sd; \
        _Pragma("unroll") for (int q = 0; q < 2; ++q) { a[0][q] = *(const f32x4*)(RWA + 1 * RWA_STRIDE + o_ + 4 * q); a[1][q] = *(const f32x4*)(RWA + 4 * RWA_STRIDE + o_ + 4 * q); a[2][q] = *(const f32x4*)(RWA + 5 * RWA_STRIDE + o_ + 4 * q); \
            a[3][q] = *(const f32x4*)(RWA + 2 * RWA_STRIDE + o_ + 4 * q); a[4][q] = *(const f32x4*)(RWA + 0 * RWA_STRIDE + o_ + 4 * q); a[5][q] = *(const f32x4*)(RWA + 3 * RWA_STRIDE + o_ + 4 * q); } } while (0)
    RW_GLOAD(0);
    for (int sub = 0; sub < TCH / 32; ++sub) {
        __syncthreads();
        { const int lo = st * 64 + sd;
#pragma unroll
          for (int q = 0; q < 2; ++q) { *(LAS f32x4*)(sw + lo + 4 * q) = a[0][q]; *(LAS f32x4*)(sn + lo + 4 * q) = a[1][q]; *(LAS f32x4*)(sb + lo + 4 * q) = a[2][q]; *(LAS f32x4*)(sk + lo + 4 * q) = a[3][q]; *(LAS f32x4*)(sr + lo + 4 * q) = a[4][q]; *(LAS f32x4*)(sv + lo + 4 * q) = a[5][q]; } }
        __syncthreads();
        if (sub + 1 < TCH / 32) RW_GLOAD(sub + 1);
        { f32x4 opA[10], opB[10]; float vin[2], vA[2], vB[2];
          RW_LOAD(opA, 0);
          vA[0] = vin[0]; vA[1] = vin[1];
#pragma unroll 1
          for (int s = 0; s < 32; s += 2) {
              RW_LOAD(opB, s + 1);
              vB[0] = vin[0]; vB[1] = vin[1];
              RW_STEP(opA, vA, s);
              if (s + 2 < 32) { RW_LOAD(opA, s + 2); vA[0] = vin[0]; vA[1] = vin[1]; }
              RW_STEP(opB, vB, s + 1);
          } }
        __syncthreads();
        { const int fs = lt >> 3, c16 = (lt & 7) * 16;
          float* dst = (c16 < 64) ? ((float*)(A.ws + WS_YO) + YO_STRIDE) : ((float*)(A.ws + WS_PT) - 64);
          float* dp = dst + (tok0 + sub * 32 + fs) * 256 + h * 64 + c16;
#pragma unroll
          for (int q = 0; q < 4; ++q) *(f32x4*)(dp + 4 * q) = *(const LAS f32x4*)(so + fs * 128 + c16 + 4 * q); }
    }
    { float* ch = (float*)(A.ws + WS_CH) + ((size_t)(bh * NCH + c) * 128) * 64 + 8 * kq;
#pragma unroll
      for (int i = 0; i < 4; ++i) { float* cr = ch + (size_t)RW_ROW(i) * 64; *(f32x4*)cr = (f32x4){S[i][0].x, S[i][0].y, S[i][1].x, S[i][1].y}; *(f32x4*)(cr + 4) = (f32x4){S[i][2].x, S[i][2].y, S[i][3].x, S[i][3].y}; } }
    __syncthreads();
}
#undef RW_LOAD
#undef RW_STEP
#undef RW_GLOAD
#undef RW_DOT
#undef RW_ROW
__device__ __forceinline__ void scan_ret_task(ARef A, const WI& w, int task) {
    const int bh = task >> 3, cp = task & 7, b = bh >> 2, h = bh & 3, un = w.tid >> 8, lt = w.tid & 255, c = 2 * cp + un;
    const float lg2g = log2f(1.0f - exp2f(-5.0f - (float)h)), gamma = exp2f(lg2g);
    LAS float* sk = (LAS float*)w.lds + un * 8192; LAS float* sq = sk + 2048; LAS float* sv = sq + 2048; LAS float* so = sv + 2048;
    const bf16* PB = (const bf16*)(A.ws + WS_PB); const float* RT = (const float*)(A.ws + WS_ROPE);
    const int row = lt >> 2, kq = lt & 3;
    f32x2 S[8];
#pragma unroll
    for (int j = 0; j < 8; ++j) S[j] = (f32x2){0.0f, 0.0f};
    const f32x2 gam2 = {gamma, gamma};
    const size_t tok0 = (size_t)b * SEQ + (size_t)c * TCH;
    const int st = lt >> 3, sd = (lt & 7) * 8;
    const int fi = sd & 31, dp = sd ^ 32;
    f32x4 gq[2], gqo[2], gk[2], gko[2], gv[2], gcs[2], gsn[2];
#define BF8_TO_F32(dst, x_) do { dst[0] = (f32x4){bf_lo(x_.x), bf_hi(x_.x), bf_lo(x_.y), bf_hi(x_.y)}; dst[1] = (f32x4){bf_lo(x_.z), bf_hi(x_.z), bf_lo(x_.w), bf_hi(x_.w)}; } while (0)
#define RT_GLOAD(sub_) do { const size_t m_ = tok0 + (sub_) * 32 + st; const bf16* pr_ = PB + m_ * PBW + h * 64; const float* rt_ = RT + m_ * ROPE_W; \
        _Pragma("unroll") for (int u = 0; u < 2; ++u) { gcs[u] = *(const f32x4*)(rt_ + fi + 4 * u); gsn[u] = *(const f32x4*)(rt_ + 32 + fi + 4 * u); } \
        { const v4u x0 = *(const v4u*)(pr_ + sd), x1 = *(const v4u*)(pr_ + dp), x2 = *(const v4u*)(pr_ + 256 + sd), x3 = *(const v4u*)(pr_ + 256 + dp), x4 = *(const v4u*)(pr_ + 512 + sd); \
          BF8_TO_F32(gq, x0); BF8_TO_F32(gqo, x1); BF8_TO_F32(gk, x2); BF8_TO_F32(gko, x3); BF8_TO_F32(gv, x4); } } while (0)
    RT_GLOAD(0);
    for (int sub = 0; sub < TCH / 32; ++sub) {
        const size_t m = tok0 + sub * 32 + st;
        f32x4 qn[2], kn[2], vn[2];
#pragma unroll
        for (int u = 0; u < 2; ++u) { qn[u] = (sd < 32) ? gq[u] * gcs[u] - gqo[u] * gsn[u] : gqo[u] * gsn[u] + gq[u] * gcs[u]; kn[u] = (sd < 32) ? gk[u] * gcs[u] - gko[u] * gsn[u] : gko[u] * gsn[u] + gk[u] * gcs[u]; vn[u] = gv[u]; }
        { const float gt = exp2f(lg2g * (float)(sub * 32 + st + 1)); const f32x4 p0 = qn[0] * gt, p1 = qn[1] * gt;
          v4u pw; pw.x = pk2(p0.x, p0.y); pw.y = pk2(p0.z, p0.w); pw.z = pk2(p1.x, p1.y); pw.w = pk2(p1.z, p1.w); *(v4u*)((bf16*)(A.ws + WS_PTR) + m * 256 + h * 64 + sd) = pw; }
        __syncthreads();
        { const int lo = st * 64 + sd; *(LAS f32x4*)(sq + lo) = qn[0]; *(LAS f32x4*)(sq + lo + 4) = qn[1]; *(LAS f32x4*)(sk + lo) = kn[0]; *(LAS f32x4*)(sk + lo + 4) = kn[1]; *(LAS f32x4*)(sv + lo) = vn[0]; *(LAS f32x4*)(sv + lo + 4) = vn[1]; }
        __syncthreads();
        if (sub + 1 < TCH / 32) RT_GLOAD(sub + 1);
        for (int s = 0; s < 32; ++s) {
            const int lo = s * 64 + kq * 16; const float vv = sv[s * 64 + row]; const f32x2 v2 = {vv, vv}; f32x2 y2 = {0.0f, 0.0f};
#pragma unroll
            for (int j4 = 0; j4 < 4; ++j4) { const f32x4 kv = *(const LAS f32x4*)(sk + lo + 4 * j4), rv = *(const LAS f32x4*)(sq + lo + 4 * j4);
                S[2 * j4] = S[2 * j4] * gam2 + v2 * LO2(kv); S[2 * j4 + 1] = S[2 * j4 + 1] * gam2 + v2 * HI2(kv);
                y2 = S[2 * j4] * LO2(rv) + y2; y2 = S[2 * j4 + 1] * HI2(rv) + y2; }
            float y = quad_sum(y2.x + y2.y);
            if (kq == 0) so[s * 64 + row] = y;
        }
        __syncthreads();
        { const int fs = lt >> 3, c8 = (lt & 7) * 8; float* dp2 = (float*)(A.ws + WS_YO) + (tok0 + sub * 32 + fs) * 256 + h * 64 + c8;
          *(f32x4*)dp2 = *(const LAS f32x4*)(so + fs * 64 + c8); *(f32x4*)(dp2 + 4) = *(const LAS f32x4*)(so + fs * 64 + c8 + 4); }
    }
    { float* ch = (float*)(A.ws + WS_CHR) + ((size_t)(bh * NCH + c) * 64 + row) * 64 + 16 * kq;
#pragma unroll
      for (int j4 = 0; j4 < 4; ++j4) *(f32x4*)(ch + 4 * j4) = (f32x4){S[2 * j4].x, S[2 * j4].y, S[2 * j4 + 1].x, S[2 * j4 + 1].y}; }
    __syncthreads();
}
#undef RT_GLOAD
#undef BF8_TO_F32
__device__ __forceinline__ void prefix_chain(ARef A, const WI& w, int bh) {
    LAS float* s0 = (LAS float*)w.lds;
    const int v = w.tid >> 3, k8 = (w.tid & 7) * 8;
    const float* CH = (const float*)(A.ws + WS_CH) + (size_t)bh * NCH * 128 * 64; float* SI = (float*)(A.ws + WS_SI) + (size_t)bh * NCH * 64 * 64;
    f32x4 c0 = {0.f, 0.f, 0.f, 0.f}, c1 = {0.f, 0.f, 0.f, 0.f};
    for (int c = 0; c < NCH; ++c) {
        *(f32x4*)(SI + ((size_t)c * 64 + v) * 64 + k8) = c0; *(f32x4*)(SI + ((size_t)c * 64 + v) * 64 + k8 + 4) = c1;
        if (c == NCH - 1) break;
        __syncthreads();
        *(LAS f32x4*)(s0 + v * 68 + k8) = c0; *(LAS f32x4*)(s0 + v * 68 + k8 + 4) = c1;
        __syncthreads();
        const float* ch = CH + (size_t)c * 128 * 64;
        f32x4 n0 = *(const f32x4*)(ch + (size_t)v * 64 + k8), n1 = *(const f32x4*)(ch + (size_t)v * 64 + k8 + 4);
#pragma unroll 8
        for (int kp = 0; kp < 64; ++kp) { const float s = s0[v * 68 + kp]; const float* pr = ch + (size_t)(64 + kp) * 64 + k8; n0 += s * *(const f32x4*)pr; n1 += s * *(const f32x4*)(pr + 4); }
        c0 = n0; c1 = n1;
    }
    const int h = bh & 3; const float gT = exp2f((float)TCH * log2f(1.0f - exp2f(-5.0f - (float)h)));
    const float* CHR = (const float*)(A.ws + WS_CHR) + (size_t)bh * NCH * 64 * 64; float* SIR = (float*)(A.ws + WS_SIR) + (size_t)bh * NCH * 64 * 64;
    c0 = (f32x4){0.f, 0.f, 0.f, 0.f}; c1 = c0;
    for (int c = 0; c < NCH; ++c) {
        *(f32x4*)(SIR + ((size_t)c * 64 + v) * 64 + k8) = c0; *(f32x4*)(SIR + ((size_t)c * 64 + v) * 64 + k8 + 4) = c1;
        if (c == NCH - 1) break;
        c0 = c0 * gT + *(const f32x4*)(CHR + ((size_t)c * 64 + v) * 64 + k8); c1 = c1 * gT + *(const f32x4*)(CHR + ((size_t)c * 64 + v) * 64 + k8 + 4);
    }
    __syncthreads();
}
typedef float f32x16 __attribute__((ext_vector_type(16)));
constexpr int SBV_PITCH = 144;
__device__ __forceinline__ float lane32_swap(float v) { return __shfl_xor(v, 32); }
__device__ __forceinline__ void sb_tile_mfma(ARef A, int unit, int lane, LAS unsigned char* vl) {
    const int tq = unit & 127, bh = unit >> 7, b = bh >> 2, h = bh & 3, t0 = tq * 32, r32 = lane & 31, hi = lane >> 5;
    const bf16* PS = (const bf16*)(A.ws + WS_PB) + (size_t)b * SEQ * PBW + PB_SB + h * 64;
    bf16x8v qf[4];
#pragma unroll
    for (int ks = 0; ks < 4; ++ks) qf[ks] = *(const bf16x8v*)(PS + (size_t)(t0 + r32) * PBW + 16 * ks + 8 * hi);
    f32x16 o0, o1;
#pragma unroll
    for (int r = 0; r < 16; ++r) { o0[r] = 0.0f; o1[r] = 0.0f; }
    float carry = 0.0f;
    const int g16 = lane >> 4, tj = (lane & 15) >> 2, tc = lane & 3;
    v4u vn[4]; bf16x8v kn[4];
#define SB_FETCH(kb_) do { _Pragma("unroll") for (int i = 0; i < 4; ++i) { const int p = lane + 64 * i, row = p >> 3, ch = p & 7; vn[i] = *(const v4u*)(PS + 512 + (size_t)((kb_) + row) * PBW + 8 * ch); } \
        _Pragma("unroll") for (int ks = 0; ks < 4; ++ks) kn[ks] = *(const bf16x8v*)(PS + 256 + (size_t)((kb_) + r32) * PBW + 16 * ks + 8 * hi); } while (0)
    SB_FETCH(t0);
    for (int kb0 = t0; kb0 >= 0; kb0 -= 32) {
#pragma unroll
        for (int i = 0; i < 4; ++i) { const int p = lane + 64 * i, row = p >> 3, ch = p & 7; *(LAS v4u*)(vl + row * SBV_PITCH + 16 * ch) = vn[i]; }
        f32x16 st;
#pragma unroll
        for (int r = 0; r < 16; ++r) st[r] = 0.0f;
        { bf16x8v ka[4];
#pragma unroll
          for (int ks = 0; ks < 4; ++ks) ka[ks] = kn[ks];
          if (kb0 >= 32) SB_FETCH(kb0 - 32);
#pragma unroll
          for (int ks = 0; ks < 4; ++ks) st = __builtin_amdgcn_mfma_f32_32x32x16_bf16(ka[ks], qf[ks], st, 0, 0, 0);
          asm volatile("" :: "v"(ka[0]), "v"(ka[1]), "v"(ka[2]), "v"(ka[3]), "v"(st)); }
        float sp[16]; const bool diag = (kb0 == t0);
#pragma unroll
        for (int r = 0; r < 16; ++r) { const float zl = st[r]; float s = (zl > 30.0f) ? zl : __builtin_amdgcn_logf(1.0f + __builtin_amdgcn_exp2f(zl));
            if (diag && ((r & 3) + 8 * (r >> 2) + 4 * hi >= r32)) s = 0.0f;
            sp[r] = s; }
        float G[4], Gp[4], suf[4];
#pragma unroll
        for (int q = 0; q < 4; ++q) { G[q] = (sp[4 * q] + sp[4 * q + 1]) + (sp[4 * q + 2] + sp[4 * q + 3]); Gp[q] = lane32_swap(G[q]); }
        suf[3] = 0.0f; suf[2] = G[3] + Gp[3]; suf[1] = suf[2] + (G[2] + Gp[2]); suf[0] = suf[1] + (G[1] + Gp[1]);
        const float tot = suf[0] + (G[0] + Gp[0]);
        pg8::u32x4 pw0, pw1;
        float av[16];
#pragma unroll
        for (int q = 0; q < 4; ++q) { float run = carry + suf[q] + (hi == 0 ? Gp[q] : 0.0f);
#pragma unroll
            for (int i = 3; i >= 0; --i) { const int r = 4 * q + i; const float la = (st[r] - sp[r]) - run; float a = __builtin_amdgcn_exp2f(la);
                if (diag && ((r & 3) + 8 * (r >> 2) + 4 * hi >= r32)) a = 0.0f;
                av[r] = a; run += sp[r]; } }
        pw0.x = pg8::cvt_pk_bf16(av[0], av[1]); pw0.y = pg8::cvt_pk_bf16(av[2], av[3]); pw0.z = pg8::cvt_pk_bf16(av[4], av[5]); pw0.w = pg8::cvt_pk_bf16(av[6], av[7]);
        pw1.x = pg8::cvt_pk_bf16(av[8], av[9]); pw1.y = pg8::cvt_pk_bf16(av[10], av[11]); pw1.z = pg8::cvt_pk_bf16(av[12], av[13]); pw1.w = pg8::cvt_pk_bf16(av[14], av[15]);
        const bf16x8v pa0 = __builtin_bit_cast(bf16x8v, pw0), pa1 = __builtin_bit_cast(bf16x8v, pw1);
        LDS_WAIT();
#pragma unroll
        for (int s = 0; s < 2; ++s)
#pragma unroll
            for (int nb = 0; nb < 2; ++nb) {
                LAS unsigned char* a1 = vl + (16 * s + 4 * (g16 >> 1) + tj) * SBV_PITCH + (32 * nb + 16 * (g16 & 1) + 4 * tc) * 2;
                const s16x4v r1 = __builtin_bit_cast(s16x4v, __builtin_amdgcn_ds_read_tr16_b64_v4i16((LAS s16x4v*)a1));
                const s16x4v r2 = __builtin_bit_cast(s16x4v, __builtin_amdgcn_ds_read_tr16_b64_v4i16((LAS s16x4v*)(a1 + 8 * SBV_PITCH)));
                const bf16x8v bv = {r1[0], r1[1], r1[2], r1[3], r2[0], r2[1], r2[2], r2[3]};
                if (nb == 0) o0 = __builtin_amdgcn_mfma_f32_32x32x16_bf16(s ? pa1 : pa0, bv, o0, 0, 0, 0); else o1 = __builtin_amdgcn_mfma_f32_32x32x16_bf16(s ? pa1 : pa0, bv, o1, 0, 0, 0);
                asm volatile("" :: "v"(bv), "v"(pa0), "v"(pa1), "v"(o0), "v"(o1)); }
        LDS_WAIT();
        carry += tot;
        if (__all(carry > 150.0f)) break;
    }
#undef SB_FETCH
    float* YS = (float*)(A.ws + WS_YO) + 3 * YO_STRIDE + ((size_t)b * SEQ + t0) * 256 + h * 64 + r32;
#pragma unroll
    for (int r = 0; r < 16; ++r) { const int qo = (r & 3) + 8 * (r >> 2) + 4 * hi; YS[(size_t)qo * 256] = o0[r]; YS[(size_t)qo * 256 + 32] = o1[r]; }
}

__device__ __forceinline__ void dsa_scores_mfma(ARef A, const WI& w) {
    const _Float16* QIH = (const _Float16*)(A.ws + WS_DQI); const _Float16* KIH = (const _Float16*)(A.ws + WS_DKI);
    const float* DW = (const float*)(A.ws + WS_DW); float* SC = (float*)(A.ws + WS_SC);
    const int col = w.lane & 15, q4 = w.lane >> 4;
    for (int u = w.gw; u < 2048; u += w.NGW) {
        const int pi = u >> 1, par = u & 1, b = pi >> 7, p = pi & 127;
#pragma unroll 1
        for (int side = 0; side < 2; ++side) {
            const int qb = side ? 255 - p : p; const size_t m0 = (size_t)b * SEQ + 16 * qb;
            f16x8 bq[8];
#pragma unroll
            for (int h = 0; h < 8; ++h) bq[h] = *(const f16x8*)(QIH + (m0 + col) * 256 + h * 32 + 8 * q4);
            const float* dw = DW + (m0 + col) * 8; const f32x4 wa = *(const f32x4*)dw, wb = *(const f32x4*)(dw + 4);
            float* srow = SC + (m0 + col) * SEQ + 4 * q4;
            const _Float16* kbase = KIH + ((size_t)b * SEQ + col) * 32 + 8 * q4;
            for (int kp = par; 2 * kp <= qb; kp += 4) {
                f16x8 ak[4];
#pragma unroll
                for (int q = 0; q < 4; ++q) { const int kb = 2 * (kp + 2 * (q >> 1)) + (q & 1); ak[q] = *(const f16x8*)(kbase + (size_t)(kb <= qb ? kb : qb) * 16 * 32); }
#pragma unroll
                for (int q = 0; q < 4; ++q) { const int kb = 2 * (kp + 2 * (q >> 1)) + (q & 1);
                    if (kb <= qb) {
                        f32x4 acc = {0.f, 0.f, 0.f, 0.f};
#pragma unroll
                        for (int h = 0; h < 8; ++h) { const f32x4 c = __builtin_amdgcn_mfma_f32_16x16x32_f16(ak[q], bq[h], (f32x4){0.f, 0.f, 0.f, 0.f}, 0, 0, 0); const float wv = (h < 4) ? wa[h] : wb[h - 4];
                            acc.x += wv * fmaxf(c.x, 0.f); acc.y += wv * fmaxf(c.y, 0.f); acc.z += wv * fmaxf(c.z, 0.f); acc.w += wv * fmaxf(c.w, 0.f); }
                        *(f32x4*)(srow + 16 * kb) = acc + 0.0f; } }
            }
        }
    }
}

__device__ __forceinline__ int wave_total_i(int v) {
    v += __builtin_amdgcn_mov_dpp(v, 0xB1, 0xF, 0xF, true);
    v += __builtin_amdgcn_mov_dpp(v, 0x4E, 0xF, 0xF, true);
    v += __builtin_amdgcn_mov_dpp(v, 0x141, 0xF, 0xF, true);
    v += __builtin_amdgcn_mov_dpp(v, 0x140, 0xF, 0xF, true);
    return __builtin_amdgcn_readlane(v, 0) + __builtin_amdgcn_readlane(v, 16) + __builtin_amdgcn_readlane(v, 32) + __builtin_amdgcn_readlane(v, 48);
}
__device__ __forceinline__ unsigned score_key(float f) { const unsigned bits = __float_as_uint(f); return (bits & 0x80000000u) ? ~bits : (bits | 0x80000000u); }
constexpr int VST_PITCH = 144;
typedef unsigned short u16;
__device__ __forceinline__ void dsa_load_scores(ARef A, int m, int lane, f32x4 (&sv)[16]) {
    const int n = (m & (SEQ - 1)) + 1; const float* sc = (const float*)(A.ws + WS_SC) + (size_t)m * SEQ;
#pragma unroll
    for (int j4 = 0; j4 < 16; ++j4) sv[j4] = *(const f32x4*)(sc + ((256 * j4 < n) ? 256 * j4 : 0) + 4 * lane);
}
__device__ __forceinline__ void dsa_select(ARef A, int m, int n, int lane_in, LAS u16* slist, LAS unsigned* bk) {
    int lane = lane_in; asm volatile("" : "+v"(lane));
    if (n <= 256) {
#pragma unroll
        for (int c = 0; c < 4; ++c) { const int idx = lane + 64 * c; slist[idx] = (u16)((idx < n) ? idx : 0); }
        return;
    }
    f32x4 sv[16]; dsa_load_scores(A, m, lane, sv);
    unsigned u[64];
#pragma unroll
    for (int j4 = 0; j4 < 16; ++j4)
#pragma unroll
        for (int i = 0; i < 4; ++i) u[4 * j4 + i] = (256 * j4 + 4 * lane + i < n) ? score_key(sv[j4][i]) : 0u;
    unsigned T = 0u;
    for (int bit = 31; bit >= 16; --bit) { const unsigned cand = T | (1u << bit); int cnt = 0;
#pragma unroll
        for (int j = 0; j < 64; ++j) cnt += (u[j] >= cand) ? 1 : 0;
        if (wave_total_i(cnt) >= 256) T = cand; }
    unsigned long long bkb = 0ull; int chi = 0;
#pragma unroll
    for (int j = 0; j < 64; ++j) { bkb |= (unsigned long long)(((u[j] >> 16) == (T >> 16)) ? 1u : 0u) << j; chi += ((u[j] >> 16) > (T >> 16)) ? 1 : 0; }
    const int cb = wave_total_i(__popcll(bkb)), need = 256 - wave_total_i(chi);
    if (cb <= 64) {
        int pos = __popcll(bkb);
        { const int mine_ = pos;
#pragma unroll
          for (int d = 1; d < 64; d <<= 1) { const int y = __shfl_up(pos, d); if (lane >= d) pos += y; }
          pos -= mine_; }
#pragma unroll
        for (int j = 0; j < 64; ++j) { if ((bkb >> j) & 1ull) { bk[pos] = u[j]; ++pos; } }
        LDS_WAIT();
        const unsigned kx = (lane < cb) ? bk[lane] : 0u;
        for (int bit = 15; bit >= 0; --bit) { const unsigned cand = T | (1u << bit); if (__popcll(__ballot(kx >= cand)) >= need) T = cand; }
        LDS_WAIT();
    } else {
        for (int bit = 15; bit >= 0; --bit) { const unsigned cand = T | (1u << bit); int cnt = 0;
#pragma unroll
            for (int j = 0; j < 64; ++j) cnt += (u[j] >= cand) ? 1 : 0;
            if (wave_total_i(cnt) >= 256) T = cand; }
    }
    unsigned long long gtb = 0ull, eqb = 0ull;
#pragma unroll
    for (int j = 0; j < 64; ++j) { gtb |= (unsigned long long)((u[j] > T) ? 1u : 0u) << j; eqb |= (unsigned long long)((u[j] == T) ? 1u : 0u) << j; }
    const int tgt = wave_total_i(__popcll(gtb)), teq = wave_total_i(__popcll(eqb));
    unsigned long long selb = gtb | eqb;
    if (tgt + teq > 256) {
        const int take = 256 - tgt; int lo = 0;
        for (int bit = 11; bit >= 0; --bit) { const int cand = lo | (1 << bit); const int J4 = cand >> 8; int ni = (cand & 255) - 4 * lane; ni = ni < 0 ? 0 : (ni > 4 ? 4 : ni);
            const int jc = 4 * J4 + ni; const unsigned long long msk = (jc >= 64) ? ~0ull : ((1ull << jc) - 1ull);
            if (wave_total_i(__popcll(eqb & msk)) < take) lo = cand; }
        { const int cand = lo + 1; const int J4 = cand >> 8; int ni = (cand & 255) - 4 * lane; ni = ni < 0 ? 0 : (ni > 4 ? 4 : ni);
          const int jc = (cand >= SEQ) ? 64 : 4 * J4 + ni; const unsigned long long msk = (jc >= 64) ? ~0ull : ((1ull << jc) - 1ull); selb = gtb | (eqb & msk); }
    }
    const int mine = __popcll(selb); int off = mine;
#pragma unroll
    for (int d = 1; d < 64; d <<= 1) { const int y = __shfl_up(off, d); if (lane >= d) off += y; }
    off -= mine;
    while (selb) { const int j = __builtin_ctzll(selb); selb &= selb - 1ull; slist[off] = (u16)(256 * (j >> 2) + 4 * lane + (j & 3)); ++off; }
}
__device__ __forceinline__ void dsa_attend(ARef A, int m, int lane_in, const LAS u16* slist, LAS unsigned char* vbuf) {
    int lane = lane_in; asm volatile("" : "+v"(lane));
    const int b = m >> 12, t = m & (SEQ - 1), n = t + 1, nsel = n < 256 ? n : 256, col = lane & 15, q4 = lane >> 4;
    const bf16* DKB = (const bf16*)(A.ws + WS_DKB) + (size_t)b * SEQ * 64; const bf16* DVB = (const bf16*)(A.ws + WS_DVB) + (size_t)b * SEQ * 64;
    const int vrow = lane >> 3, vpc = lane & 7;
    bf16x8v bq0 = {0, 0, 0, 0, 0, 0, 0, 0}, bq1 = {0, 0, 0, 0, 0, 0, 0, 0};
    if (col < 4) { const bf16* qp = (const bf16*)(A.ws + WS_DQ) + (size_t)m * 256 + col * 64 + 8 * q4; bq0 = *(const bf16x8v*)qp; bq1 = *(const bf16x8v*)(qp + 32); }
    f32x4 lg[16];
#pragma unroll
    for (int hb = 0; hb < 2; ++hb) {
        bf16x8v a0[8], a1[8];
#pragma unroll
        for (int k = 0; k < 8; ++k) { const int s = slist[16 * (8 * hb + k) + col]; const bf16* kr = DKB + (size_t)s * 64 + 8 * q4; a0[k] = *(const bf16x8v*)kr; a1[k] = *(const bf16x8v*)(kr + 32); }
#pragma unroll
        for (int k = 0; k < 8; ++k) { const f32x4 c = __builtin_amdgcn_mfma_f32_16x16x32_bf16(a0[k], bq0, (f32x4){0.f, 0.f, 0.f, 0.f}, 0, 0, 0); lg[8 * hb + k] = __builtin_amdgcn_mfma_f32_16x16x32_bf16(a1[k], bq1, c, 0, 0, 0); }
        __builtin_amdgcn_sched_barrier(0);
    }
    if (nsel < 256) {
#pragma unroll
        for (int kb = 0; kb < 16; ++kb)
#pragma unroll
            for (int r = 0; r < 4; ++r) if (16 * kb + 4 * q4 + r >= nsel) lg[kb][r] = -INFINITY; }
    v4u vr[4];
#pragma unroll
    for (int i = 0; i < 4; ++i) { const int s = slist[vrow + 8 * i]; vr[i] = *(const v4u*)(DVB + (size_t)s * 64 + 8 * vpc); }
    float mx = -INFINITY;
#pragma unroll
    for (int kb = 0; kb < 16; ++kb) mx = fmaxf(fmaxf(mx, fmaxf(lg[kb].x, lg[kb].y)), fmaxf(lg[kb].z, lg[kb].w));
    mx = fmaxf(mx, __shfl_xor(mx, 16)); mx = fmaxf(mx, __shfl_xor(mx, 32));
    float sm = 0.f;
#pragma unroll
    for (int kb = 0; kb < 16; ++kb) { lg[kb].x = __builtin_amdgcn_exp2f(lg[kb].x - mx); lg[kb].y = __builtin_amdgcn_exp2f(lg[kb].y - mx); lg[kb].z = __builtin_amdgcn_exp2f(lg[kb].z - mx); lg[kb].w = __builtin_amdgcn_exp2f(lg[kb].w - mx); sm += (lg[kb].x + lg[kb].y) + (lg[kb].z + lg[kb].w); }
    sm += __shfl_xor(sm, 16); sm += __shfl_xor(sm, 32);
    const float inv = 1.0f / sm;
    bf16x8v pa[8];
#pragma unroll
    for (int i = 0; i < 8; ++i) { const f32x4 x = lg[2 * i] * inv, y = lg[2 * i + 1] * inv;
        pg8::u32x4 wv; wv.x = pg8::cvt_pk_bf16(x.x, x.y); wv.y = pg8::cvt_pk_bf16(x.z, x.w); wv.z = pg8::cvt_pk_bf16(y.x, y.y); wv.w = pg8::cvt_pk_bf16(y.z, y.w);
        pa[i] = __builtin_bit_cast(bf16x8v, wv); }
    f32x4 o[4];
#pragma unroll
    for (int nb = 0; nb < 4; ++nb) o[nb] = (f32x4){0.f, 0.f, 0.f, 0.f};
    const int tj = col >> 2, tc = col & 3;
#pragma unroll
    for (int c = 0; c < 8; ++c) {
        LAS unsigned char* vb = vbuf + (c & 1) * (32 * VST_PITCH);
#pragma unroll
        for (int i = 0; i < 4; ++i) *(LAS v4u*)(vb + (vrow + 8 * i) * VST_PITCH + 16 * vpc) = vr[i];
        if (c < 7) {
#pragma unroll
            for (int i = 0; i < 4; ++i) { const int s = slist[32 * (c + 1) + vrow + 8 * i]; vr[i] = *(const v4u*)(DVB + (size_t)s * 64 + 8 * vpc); } }
        LDS_WAIT();
#pragma unroll
        for (int nb = 0; nb < 4; ++nb) {
            LAS unsigned char* a1 = vb + (4 * q4 + tj) * VST_PITCH + (16 * nb + 4 * tc) * 2;
            const s16x4v r1 = __builtin_bit_cast(s16x4v, __builtin_amdgcn_ds_read_tr16_b64_v4i16((LAS s16x4v*)a1));
            const s16x4v r2 = __builtin_bit_cast(s16x4v, __builtin_amdgcn_ds_read_tr16_b64_v4i16((LAS s16x4v*)(a1 + 16 * VST_PITCH)));
            const bf16x8v bv = {r1[0], r1[1], r1[2], r1[3], r2[0], r2[1], r2[2], r2[3]};
            o[nb] = __builtin_amdgcn_mfma_f32_16x16x32_bf16(pa[c], bv, o[nb], 0, 0, 0); }
    }
    LDS_WAIT();
    if (lane < 16) { float* YD = (float*)(A.ws + WS_YO) + 2 * YO_STRIDE + (size_t)m * 256;
#pragma unroll
        for (int nb = 0; nb < 4; ++nb) { YD[16 * nb + lane] = o[nb].x; YD[64 + 16 * nb + lane] = o[nb].y; YD[128 + 16 * nb + lane] = o[nb].z; YD[192 + 16 * nb + lane] = o[nb].w; } }
}
constexpr int DSA_GR = 1;
__device__ __forceinline__ int dsa_row_of(int batch, int gi, int r) { const int idx = DSA_GR * gi + r, h = idx >> 1; return batch * SEQ + ((idx & 1) ? (SEQ - 1 - h) : h); }
__device__ __forceinline__ void dsa_wave(ARef A, const WI& w, LAS unsigned char* wl, int qi, int l) {
    LAS u16* lists = (LAS u16*)wl; LAS unsigned char* vbuf = wl + 4096; LAS unsigned* bk = (LAS unsigned*)vbuf;
#pragma unroll 1
    for (int kb = 0; kb < NB; ++kb) {
        const int batch = (w.bx + kb) & (NB - 1);
        unsigned* head = (unsigned*)(A.ws + WS_CTL) + CW_DSAQ + 128 * qi + 16 * batch;
        for (;;) {
            int g = 0; if (w.lane == 0) g = (int)atomicAdd(head, 1u);
            g = __builtin_amdgcn_readfirstlane(g);
            if (g >= 11 * (SEQ / 8)) break;
            const int per = g / 11, pos = g - 11 * per;
            if (pos >= 8) { moe_convert_chunk(A, l, batch * 1536 + 3 * per + (pos - 8), w.lane, (LAS float*)vbuf); continue; }
            const int gi = 8 * per + pos;
            { const int m = dsa_row_of(batch, gi, 0), n = (m & (SEQ - 1)) + 1; dsa_select(A, m, n, w.lane, lists, bk); }
            LDS_WAIT();
            dsa_attend(A, dsa_row_of(batch, gi, 0), w.lane, lists, vbuf);
        }
    }
}

__device__ __forceinline__ f32x4 head_norm4(f32x4 y, float eps, f32x4 g) {
    const float mean = grp16_sum(sum4(y)) * (1.0f / 64.0f); const f32x4 yc = y - mean;
    const float var = grp16_sum(dot4(yc, yc)) * (1.0f / 64.0f); return yc * (1.0f / sqrtf(var + eps)) * g;
}
template <bool BF> __device__ __forceinline__ f32x4 state_corr(const LAS float* sl, int hh, int r16, const void* pv) {
    const LAS float* r0 = sl + (hh * 64 + 4 * r16) * 64; const int x0 = (4 * r16) & 15;
    f32x4 out = {0.f, 0.f, 0.f, 0.f};
#pragma unroll 2
    for (int k8 = 0; k8 < 8; ++k8) {
        f32x4 pa, pb;
        if (BF) { const v4u x = ((const v4u*)pv)[k8]; pa = (f32x4){bf_lo(x.x), bf_hi(x.x), bf_lo(x.y), bf_hi(x.y)}; pb = (f32x4){bf_lo(x.z), bf_hi(x.z), bf_lo(x.w), bf_hi(x.w)}; }
        else { pa = ((const f32x4*)pv)[2 * k8]; pb = ((const f32x4*)pv)[2 * k8 + 1]; }
#pragma unroll
        for (int i = 0; i < 4; ++i) { const LAS float* rowp = r0 + i * 64; const int xs = (x0 + i) & 15;
            out[i] += dot4(*(const LAS f32x4*)(rowp + 4 * ((2 * k8) ^ xs)), pa) + dot4(*(const LAS f32x4*)(rowp + 4 * ((2 * k8 + 1) ^ xs)), pb); }
    }
    return out;
}
__device__ __forceinline__ void post_row(ARef A, int l, int m, int lane, const LAS float* slw, const LAS float* slr) {
    const float* YO = (const float*)(A.ws + WS_YO); const float* RWA = (const float*)(A.ws + WS_RWA);
    bf16* MX = (bf16*)(A.ws + WS_MIX) + (size_t)m * DM; const int c4 = 4 * lane, hh = lane >> 4, r16 = lane & 15; const size_t o = (size_t)m * 256 + c4;
    { f32x4 y = *(const f32x4*)(YO + o) + state_corr<true>(slr, hh, r16, (const bf16*)(A.ws + WS_PTR) + (size_t)m * 256 + hh * 64);
      y = head_norm4(y, 1e-5f, *(const f32x4*)(A.in[I_RETGN] + l * 256 + c4));
      const v2u gw_ = *(const v2u*)((const bf16*)(A.ws + WS_PB) + (size_t)m * PBW + 768 + c4); const f32x4 g = {bf_lo(gw_.x), bf_hi(gw_.x), bf_lo(gw_.y), bf_hi(gw_.y)};
#pragma unroll
      for (int i = 0; i < 4; ++i) y[i] *= g[i] * sigm(g[i]);
      v2u w; w.x = pk2(y.x, y.y); w.y = pk2(y.z, y.w); *(v2u*)(MX + c4) = w; }
    { f32x4 y = *(const f32x4*)(YO + YO_STRIDE + o) + state_corr<false>(slw, hh, r16, (const float*)(A.ws + WS_PT) + (size_t)m * 256 + hh * 64);
      y = head_norm4(y, 64e-5f, *(const f32x4*)(A.in[I_LN] + l * 256 + c4));
      y = (y + *(const f32x4*)(RWA + 7 * RWA_STRIDE + o)) * *(const f32x4*)(RWA + 6 * RWA_STRIDE + o);
      v2u w; w.x = pk2(y.x, y.y); w.y = pk2(y.z, y.w); *(v2u*)(MX + 256 + c4) = w; }
    { f32x4 y = *(const f32x4*)(YO + 2 * YO_STRIDE + o); const float r = 1.0f / sqrtf(wave_sum(dot4(y, y)) * (1.0f / 256.0f) + 1e-5f);
      y = y * r * *(const f32x4*)(A.in[I_DONORM] + l * 256 + c4);
      v2u w; w.x = pk2(y.x, y.y); w.y = pk2(y.z, y.w); *(v2u*)(MX + 512 + c4) = w; }
    { f32x4 y = *(const f32x4*)(YO + 3 * YO_STRIDE + o); const float r = 1.0f / sqrtf(wave_sum(dot4(y, y)) * (1.0f / 256.0f) + 1e-5f);
      y = y * r * *(const f32x4*)(A.in[I_SONORM] + l * 256 + c4);
      v2u w; w.x = pk2(y.x, y.y); w.y = pk2(y.z, y.w); *(v2u*)(MX + 768 + c4) = w; }
}
__device__ __forceinline__ void ph_post(ARef A, const WI& w, int l) {
    LAS float* slw = (LAS float*)w.lds; LAS float* slr = slw + 16384;
    for (int u = w.vcu; u < NB * NCH * 2; u += w.G) {
        const int b = u >> 5, c = (u >> 1) & 15, half = u & 1;
        __syncthreads();
        for (int e = w.tid; e < 4096; e += NWAVES * 64) { const int hh = e >> 10, v = (e >> 4) & 63, k4 = e & 15;
            const size_t src = ((size_t)((b * 4 + hh) * NCH + c) * 64 + v) * 64 + 4 * k4; const int dst = (hh * 64 + v) * 64 + 4 * (k4 ^ (v & 15));
            *(LAS f32x4*)(slw + dst) = *(const f32x4*)((const float*)(A.ws + WS_SI) + src); *(LAS f32x4*)(slr + dst) = *(const f32x4*)((const float*)(A.ws + WS_SIR) + src); }
        __syncthreads();
        const int tok0 = b * SEQ + c * TCH + half * 128 + w.wave * 16;
        for (int i = 0; i < 16; ++i) post_row(A, l, tok0 + i, w.lane, slw, slr);
    }
}

constexpr int S0_PITCH = 144;
template <int MIXER> __device__ __forceinline__ void post16_head(ARef A, int l, size_t m, int hh, int tk, int fq, const LAS unsigned char* s0) {
    const size_t o = m * 256 + hh * 64 + 8 * fq;
    bf16x8v pb[2];
    if (MIXER == 0) { const bf16* pp = (const bf16*)(A.ws + WS_PTR) + o; pb[0] = *(const bf16x8v*)pp; pb[1] = *(const bf16x8v*)(pp + 32); }
    else { const float* pp = (const float*)(A.ws + WS_PT) + o;
#pragma unroll
        for (int ks = 0; ks < 2; ++ks) { const f32x4 a = *(const f32x4*)(pp + 32 * ks), b = *(const f32x4*)(pp + 32 * ks + 4);
            pg8::u32x4 wv; wv.x = pg8::cvt_pk_bf16(a.x, a.y); wv.y = pg8::cvt_pk_bf16(a.z, a.w); wv.z = pg8::cvt_pk_bf16(b.x, b.y); wv.w = pg8::cvt_pk_bf16(b.z, b.w); pb[ks] = __builtin_bit_cast(bf16x8v, wv); } }
    f32x4 y[4];
    const float* yl = (const float*)(A.ws + WS_YO) + MIXER * YO_STRIDE + o;
#pragma unroll
    for (int mb = 0; mb < 4; ++mb) y[mb] = *(const f32x4*)(yl + 32 * (mb >> 1) + 4 * (mb & 1));
    const float* gw = ((MIXER == 0) ? A.in[I_RETGN] : A.in[I_LN]) + l * 256 + hh * 64 + 8 * fq;
    f32x4 gn[4], e0[4], e1[4];
#pragma unroll
    for (int mb = 0; mb < 4; ++mb) gn[mb] = *(const f32x4*)(gw + 32 * (mb >> 1) + 4 * (mb & 1));
    if (MIXER == 0) {
#pragma unroll
        for (int j = 0; j < 2; ++j) { const v4u gx = *(const v4u*)((const bf16*)(A.ws + WS_PB) + m * PBW + 768 + hh * 64 + 8 * fq + 32 * j);
            e0[2 * j] = (f32x4){bf_lo(gx.x), bf_hi(gx.x), bf_lo(gx.y), bf_hi(gx.y)}; e0[2 * j + 1] = (f32x4){bf_lo(gx.z), bf_hi(gx.z), bf_lo(gx.w), bf_hi(gx.w)}; }
    } else { const float* RWA = (const float*)(A.ws + WS_RWA);
#pragma unroll
        for (int mb = 0; mb < 4; ++mb) { e0[mb] = *(const f32x4*)(RWA + 7 * RWA_STRIDE + o + 32 * (mb >> 1) + 4 * (mb & 1)); e1[mb] = *(const f32x4*)(RWA + 6 * RWA_STRIDE + o + 32 * (mb >> 1) + 4 * (mb & 1)); } }
    const LAS unsigned char* ab = s0 + ((MIXER * 4 + hh) * 64 + 8 * (tk >> 2) + (tk & 3)) * S0_PITCH + 16 * fq;
#pragma unroll
    for (int mb = 0; mb < 4; ++mb)
#pragma unroll
        for (int ks = 0; ks < 2; ++ks) { const bf16x8v af = *(const LAS bf16x8v*)(ab + (32 * (mb >> 1) + 4 * (mb & 1)) * S0_PITCH + 64 * ks); y[mb] = __builtin_amdgcn_mfma_f32_16x16x32_bf16(af, pb[ks], y[mb], 0, 0, 0); }
    float s = (sum4(y[0]) + sum4(y[1])) + (sum4(y[2]) + sum4(y[3])); s += __shfl_xor(s, 16); s += __shfl_xor(s, 32);
    const float mean = s * (1.0f / 64.0f);
#pragma unroll
    for (int mb = 0; mb < 4; ++mb) y[mb] = y[mb] - mean;
    float q = (dot4(y[0], y[0]) + dot4(y[1], y[1])) + (dot4(y[2], y[2]) + dot4(y[3], y[3])); q += __shfl_xor(q, 16); q += __shfl_xor(q, 32);
    const float rs = 1.0f / sqrtf(q * (1.0f / 64.0f) + ((MIXER == 0) ? 1e-5f : 64e-5f));
    bf16* MX = (bf16*)(A.ws + WS_MIX) + m * DM + MIXER * 256 + hh * 64 + 8 * fq;
#pragma unroll
    for (int j = 0; j < 2; ++j) { f32x4 ya = y[2 * j] * rs * gn[2 * j], yb = y[2 * j + 1] * rs * gn[2 * j + 1];
        if (MIXER == 0) {
#pragma unroll
            for (int i = 0; i < 4; ++i) { ya[i] *= e0[2 * j][i] * sigm(e0[2 * j][i]); yb[i] *= e0[2 * j + 1][i] * sigm(e0[2 * j + 1][i]); }
        } else { ya = (ya + e0[2 * j]) * e1[2 * j]; yb = (yb + e0[2 * j + 1]) * e1[2 * j + 1]; }
        v4u wv; wv.x = pk2(ya.x, ya.y); wv.y = pk2(ya.z, ya.w); wv.z = pk2(yb.x, yb.y); wv.w = pk2(yb.z, yb.w); *(v4u*)(MX + 32 * j) = wv; }
}
__device__ __forceinline__ void post16_rms(ARef A, int l, size_t m, int mx, int fq) {
    const float* yp = (const float*)(A.ws + WS_YO) + (size_t)mx * YO_STRIDE + m * 256 + 8 * fq; const float* gw = ((mx == 2) ? A.in[I_DONORM] : A.in[I_SONORM]) + l * 256 + 8 * fq;
    f32x4 y[16];
#pragma unroll
    for (int j = 0; j < 8; ++j) { y[2 * j] = *(const f32x4*)(yp + 32 * j); y[2 * j + 1] = *(const f32x4*)(yp + 32 * j + 4); }
    float q = 0.0f;
#pragma unroll
    for (int j = 0; j < 16; ++j) q += dot4(y[j], y[j]);
    q += __shfl_xor(q, 16); q += __shfl_xor(q, 32);
    const float r = 1.0f / sqrtf(q * (1.0f / 256.0f) + 1e-5f);
    bf16* MX = (bf16*)(A.ws + WS_MIX) + m * DM + mx * 256 + 8 * fq;
#pragma unroll
    for (int j = 0; j < 8; ++j) { const f32x4 ya = y[2 * j] * r * *(const f32x4*)(gw + 32 * j), yb = y[2 * j + 1] * r * *(const f32x4*)(gw + 32 * j + 4);
        v4u wv; wv.x = pk2(ya.x, ya.y); wv.y = pk2(ya.z, ya.w); wv.z = pk2(yb.x, yb.y); wv.w = pk2(yb.z, yb.w); *(v4u*)(MX + 32 * j) = wv; }
}
__device__ __forceinline__ void ph_post16(ARef A, const WI& w, int l) {
    LAS unsigned char* s0 = w.lds;
    for (int u = w.vcu; u < NB * NCH * 2; u += w.G) {
        const int b = u >> 5, c = (u >> 1) & 15, half = u & 1;
        __syncthreads();
#pragma unroll 2
        for (int e = w.tid; e < 4096; e += NWAVES * 64) { const int hd = e >> 9, v = (e >> 3) & 63, k8 = e & 7;
            const float* src = (const float*)(A.ws + ((hd < 4) ? WS_SIR : WS_SI)) + ((size_t)((b * 4 + (hd & 3)) * NCH + c) * 64 + v) * 64 + 8 * k8;
            const f32x4 x0 = *(const f32x4*)src, x1 = *(const f32x4*)(src + 4);
            v4u wv; wv.x = pk2(x0.x, x0.y); wv.y = pk2(x0.z, x0.w); wv.z = pk2(x1.x, x1.y); wv.w = pk2(x1.z, x1.w); *(LAS v4u*)(s0 + (hd * 64 + v) * S0_PITCH + 16 * k8) = wv; }
        __syncthreads();
        int lane = w.lane; asm volatile("" : "+v"(lane));
        const int tk = lane & 15, fq = lane >> 4; const size_t m = (size_t)(b * SEQ + c * TCH + half * 128 + w.wave * 16 + tk);
#pragma unroll 1
        for (int hh = 0; hh < 4; ++hh) post16_head<0>(A, l, m, hh, tk, fq, s0);
#pragma unroll 1
        for (int hh = 0; hh < 4; ++hh) post16_head<1>(A, l, m, hh, tk, fq, s0);
#pragma unroll 1
        for (int mx = 2; mx < 4; ++mx) post16_rms(A, l, m, mx, fq);
    }
}

__device__ __forceinline__ float wave_max_f(float v) {
    v = fmaxf(v, __builtin_bit_cast(float, __builtin_amdgcn_mov_dpp(__builtin_bit_cast(int, v), 0xB1, 0xF, 0xF, true)));
    v = fmaxf(v, __builtin_bit_cast(float, __builtin_amdgcn_mov_dpp(__builtin_bit_cast(int, v), 0x4E, 0xF, 0xF, true)));
    v = fmaxf(v, __builtin_bit_cast(float, __builtin_amdgcn_mov_dpp(__builtin_bit_cast(int, v), 0x141, 0xF, 0xF, true)));
    v = fmaxf(v, __builtin_bit_cast(float, __builtin_amdgcn_mov_dpp(__builtin_bit_cast(int, v), 0x140, 0xF, 0xF, true)));
    const int iv = __builtin_bit_cast(int, v);
    return fmaxf(fmaxf(__builtin_bit_cast(float, __builtin_amdgcn_readlane(iv, 0)), __builtin_bit_cast(float, __builtin_amdgcn_readlane(iv, 16))), fmaxf(__builtin_bit_cast(float, __builtin_amdgcn_readlane(iv, 32)), __builtin_bit_cast(float, __builtin_amdgcn_readlane(iv, 48))));
}
__device__ __forceinline__ void router_stage(ARef A, const WI& w, int l) {
    LAS float* rwl = (LAS float*)w.lds; const float* rw = A.in[I_RW] + (size_t)l * DM * 32;
    for (int e = w.tid; e < DM * 8; e += NWAVES * 64) { const int k = e >> 3, c = e & 7; *(LAS f32x4*)(rwl + k * 32 + 4 * (c ^ ((k >> 2) & 7))) = *(const f32x4*)(rw + (size_t)k * 32 + 4 * c); }
    __syncthreads();
}
__device__ __forceinline__ void router_row(ARef A, int l, int m, int lane, LAS unsigned* hist, const LAS float* rwl, LAS int* texp, bool dry = false) {
    const float* XA = (const float*)(A.ws + WS_XA) + (size_t)m * DM; const float* MOD = (const float*)(A.ws + WS_MOD) + (size_t)(l * 8 + (m >> 12)) * 6144;
    f32x4 v[4]; float ss = 0.0f;
#pragma unroll
    for (int j = 0; j < 4; ++j) { v[j] = *(const f32x4*)(XA + 4 * (lane + 64 * j)); ss += dot4(v[j], v[j]); }
    ss = wave_sum(ss); const float rstd = 1.0f / sqrtf(ss * (1.0f / DM) + 1e-5f);
    const float* g = A.in[I_NFFN] + l * DM; const float* scp = MOD + 4 * 1024; const float* shp = MOD + 3 * 1024;
    emit_h_row(v, rstd, g, scp, shp, (bf16*)(A.ws + WS_H) + (size_t)m * DM, lane);
    float p[32];
#pragma unroll
    for (int e = 0; e < 32; ++e) p[e] = 0.0f;
    const int sw = lane & 7;
#pragma unroll 1
    for (int j = 0; j < 4; ++j) { const int k = 4 * (lane + 64 * j);
        const f32x4 h = *(const f32x4*)(XA + k) * rstd * *(const f32x4*)(g + k) * (1.0f + *(const f32x4*)(scp + k)) + *(const f32x4*)(shp + k);
        const LAS float* row = rwl + k * 32;
#pragma unroll
        for (int i = 0; i < 4; ++i) {
#pragma unroll
            for (int q4 = 0; q4 < 8; ++q4) { const f32x4 r = *(const LAS f32x4*)(row + i * 32 + 4 * (q4 ^ sw)); p[4 * q4] += h[i] * r.x; p[4 * q4 + 1] += h[i] * r.y; p[4 * q4 + 2] += h[i] * r.z; p[4 * q4 + 3] += h[i] * r.w; } } }
    float q16[16], q8[8], q4v[4], q2[2], q1;
    { const bool hb = (lane & 32) != 0;
#pragma unroll
      for (int i = 0; i < 16; ++i) { const float mine = hb ? p[16 + i] : p[i], oth = hb ? p[i] : p[16 + i]; q16[i] = mine + __shfl_xor(oth, 32); } }
    { const bool hb = (lane & 16) != 0;
#pragma unroll
      for (int i = 0; i < 8; ++i) { const float mine = hb ? q16[8 + i] : q16[i], oth = hb ? q16[i] : q16[8 + i]; q8[i] = mine + __shfl_xor(oth, 16); } }
    { const bool hb = (lane & 8) != 0;
#pragma unroll
      for (int i = 0; i < 4; ++i) { const float mine = hb ? q8[4 + i] : q8[i], oth = hb ? q8[i] : q8[4 + i]; q4v[i] = mine + __shfl_xor(oth, 8); } }
    { const bool hb = (lane & 4) != 0;
#pragma unroll
      for (int i = 0; i < 2; ++i) { const float mine = hb ? q4v[2 + i] : q4v[i], oth = hb ? q4v[i] : q4v[2 + i]; q2[i] = mine + __shfl_xor(oth, 4); } }
    { const bool hb = (lane & 2) != 0; const float mine = hb ? q2[1] : q2[0], oth = hb ? q2[0] : q2[1]; q1 = mine + __shfl_xor(oth, 2); }
    q1 += __shfl_xor(q1, 1);
    float lv = q1 + A.in[I_RB][l * 32 + (lane >> 1)];
    float tv[4]; int ti[4];
#pragma unroll
    for (int kk = 0; kk < 4; ++kk) { const float mx = wave_max_f(lv); const unsigned long long msk = __ballot(lv == mx); const int e = msk ? (int)(__builtin_ctzll(msk) >> 1) : kk;
        tv[kk] = mx; ti[kk] = e; if ((lane >> 1) == e) lv = -INFINITY; }
    const float e1 = expf(tv[1] - tv[0]), e2 = expf(tv[2] - tv[0]), e3 = expf(tv[3] - tv[0]); const float inv = 1.0f / (1.0f + e1 + e2 + e3);
    if (lane == 0 && !dry) {
        int* TI = (int*)(A.ws + WS_TOPI) + (size_t)m * 4; float* TW = (float*)(A.ws + WS_TOPW) + (size_t)m * 4;
        TI[0] = ti[0]; TI[1] = ti[1]; TI[2] = ti[2]; TI[3] = ti[3]; texp[0] = ti[0]; texp[1] = ti[1]; texp[2] = ti[2]; texp[3] = ti[3]; TW[0] = inv; TW[1] = e1 * inv; TW[2] = e2 * inv; TW[3] = e3 * inv;
        { unsigned* hg = (unsigned*)hist; atomicAdd(hg + ti[0], 1u); atomicAdd(hg + ti[1], 1u); atomicAdd(hg + ti[2], 1u); atomicAdd(hg + ti[3], 1u); }
    }
}
__device__ __forceinline__ void router_stage16(ARef A, const WI& w, int l) {
    LAS unsigned char* rwt = w.lds; const float* rw = A.in[I_RW] + (size_t)l * DM * 32;
    const int k0 = 2 * w.tid;
    const int c = k0 >> 3, kin = (k0 & 7) * 2;
#pragma unroll
    for (int e4 = 0; e4 < 8; ++e4) { const f32x4 a = *(const f32x4*)(rw + (size_t)k0 * 32 + 4 * e4), b = *(const f32x4*)(rw + (size_t)(k0 + 1) * 32 + 4 * e4);
#pragma unroll
        for (int i = 0; i < 4; ++i) { const int e = 4 * e4 + i; const unsigned hi = pg8::cvt_pk_bf16(a[i], b[i]); const float ra = a[i] - bf_lo(hi), rb = b[i] - bf_hi(hi); const unsigned lo = pg8::cvt_pk_bf16(ra, rb);
            const int off = e * 2048 + ((c ^ (e & 15)) * 16) + kin; *(LAS unsigned*)(rwt + off) = hi; *(LAS unsigned*)(rwt + 65536 + off) = lo; } }
    __syncthreads();
}
__device__ __forceinline__ void router16(ARef A, int l, int m0, int lane_in, LAS unsigned* hist, const LAS unsigned char* rwt, LAS int* texp, bool dry) {
    int lane = lane_in; asm volatile("" : "+v"(lane));
    const int tk = lane & 15, q4 = lane >> 4; const size_t m = (size_t)m0 + tk;
    const float* xr = (const float*)(A.ws + WS_XA) + m * DM + 8 * q4; const float* MOD = (const float*)(A.ws + WS_MOD) + (size_t)(l * 8 + (m0 >> 12)) * 6144;
    const float* g = A.in[I_NFFN] + l * DM + 8 * q4; const float* scp = MOD + 4 * 1024 + 8 * q4; const float* shp = MOD + 3 * 1024 + 8 * q4;
    bf16* hrow = (bf16*)(A.ws + WS_H) + m * DM + 8 * q4;
    float ss = 0.0f;
#pragma unroll 16
    for (int ks = 0; ks < 32; ++ks) { const f32x4 a = *(const f32x4*)(xr + 32 * ks), b = *(const f32x4*)(xr + 32 * ks + 4); ss += dot4(a, a) + dot4(b, b); }
    ss += __shfl_xor(ss, 16); ss += __shfl_xor(ss, 32);
    const float rstd = 1.0f / sqrtf(ss * (1.0f / DM) + 1e-5f);
    f32x4 acc[2] = {{0.f, 0.f, 0.f, 0.f}, {0.f, 0.f, 0.f, 0.f}};
    const LAS unsigned char* wrow = rwt + tk * 2048;
#pragma unroll 2
    for (int ks = 0; ks < 32; ++ks) {
        f32x4 h[2];
#pragma unroll
        for (int u = 0; u < 2; ++u) { const int k = 32 * ks + 4 * u; h[u] = *(const f32x4*)(xr + k) * rstd * *(const f32x4*)(g + k) * (1.0f + *(const f32x4*)(scp + k)) + *(const f32x4*)(shp + k); }
        pg8::u32x4 hw, lw;
        hw.x = pg8::cvt_pk_bf16(h[0].x, h[0].y); hw.y = pg8::cvt_pk_bf16(h[0].z, h[0].w); hw.z = pg8::cvt_pk_bf16(h[1].x, h[1].y); hw.w = pg8::cvt_pk_bf16(h[1].z, h[1].w);
        if (!dry) *(pg8::u32x4*)(hrow + 32 * ks) = hw;
        lw.x = pg8::cvt_pk_bf16(h[0].x - bf_lo(hw.x), h[0].y - bf_hi(hw.x)); lw.y = pg8::cvt_pk_bf16(h[0].z - bf_lo(hw.y), h[0].w - bf_hi(hw.y));
        lw.z = pg8::cvt_pk_bf16(h[1].x - bf_lo(hw.z), h[1].y - bf_hi(hw.z)); lw.w = pg8::cvt_pk_bf16(h[1].z - bf_lo(hw.w), h[1].w - bf_hi(hw.w));
        const bf16x8v bh = __builtin_bit_cast(bf16x8v, hw), bl = __builtin_bit_cast(bf16x8v, lw);
        const int coff = ((4 * ks + q4) ^ tk) * 16;
#pragma unroll
        for (int blk = 0; blk < 2; ++blk) { const bf16x8v ah = *(const LAS bf16x8v*)(wrow + blk * 32768 + coff), al = *(const LAS bf16x8v*)(wrow + 65536 + blk * 32768 + coff);
            acc[blk] = __builtin_amdgcn_mfma_f32_16x16x32_bf16(ah, bh, acc[blk], 0, 0, 0); acc[blk] = __builtin_amdgcn_mfma_f32_16x16x32_bf16(ah, bl, acc[blk], 0, 0, 0); acc[blk] = __builtin_amdgcn_mfma_f32_16x16x32_bf16(al, bh, acc[blk], 0, 0, 0); }
    }
    float lv[8]; const float* rb = A.in[I_RB] + l * 32 + 4 * q4;
#pragma unroll
    for (int blk = 0; blk < 2; ++blk)
#pragma unroll
        for (int i = 0; i < 4; ++i) lv[4 * blk + i] = acc[blk][i] + rb[16 * blk + i];
    float tv[4]; int ti[4];
#pragma unroll
    for (int kk = 0; kk < 4; ++kk) {
        float mx = fmaxf(fmaxf(fmaxf(lv[0], lv[1]), fmaxf(lv[2], lv[3])), fmaxf(fmaxf(lv[4], lv[5]), fmaxf(lv[6], lv[7])));
        mx = fmaxf(mx, __shfl_xor(mx, 16)); mx = fmaxf(mx, __shfl_xor(mx, 32));
        int cand = 99;
#pragma unroll
        for (int j = 7; j >= 0; --j) if (lv[j] == mx) cand = 16 * (j >> 2) + 4 * q4 + (j & 3);
        cand = min(cand, __shfl_xor(cand, 16)); cand = min(cand, __shfl_xor(cand, 32));
        if (cand == 99) cand = kk;
        tv[kk] = mx; ti[kk] = cand;
#pragma unroll
        for (int j = 0; j < 8; ++j) if (16 * (j >> 2) + 4 * q4 + (j & 3) == cand) lv[j] = -INFINITY;
    }
    const float e1 = expf(tv[1] - tv[0]), e2 = expf(tv[2] - tv[0]), e3 = expf(tv[3] - tv[0]); const float inv = 1.0f / (1.0f + e1 + e2 + e3);
    if (q4 == 0 && !dry) {
        int* TI = (int*)(A.ws + WS_TOPI) + m * 4; float* TW = (float*)(A.ws + WS_TOPW) + m * 4;
        *(v4u*)TI = (v4u){(unsigned)ti[0], (unsigned)ti[1], (unsigned)ti[2], (unsigned)ti[3]}; *(f32x4*)TW = (f32x4){inv, e1 * inv, e2 * inv, e3 * inv};
        LAS int* tx = texp + tk * 4; tx[0] = ti[0]; tx[1] = ti[1]; tx[2] = ti[2]; tx[3] = ti[3];
        { unsigned* hg = (unsigned*)hist; atomicAdd(hg + ti[0], 1u); atomicAdd(hg + ti[1], 1u); atomicAdd(hg + ti[2], 1u); atomicAdd(hg + ti[3], 1u); }
    }
}
__device__ __forceinline__ void build_expert_table(ARef A, const WI& w, int l) {
    LAS int* tst = (LAS int*)(w.lds + TST_OFF); LAS int* tab = (LAS int*)(w.lds + TAB_OFF); LAS int* cnt = (LAS int*)(w.lds + CNT_OFF);
    if (w.tid == 0) { const unsigned* gc = (const unsigned*)(A.ws + WS_CTL) + CW_GCNT + 64 * l; int acc = 0;
        for (int e = 0; e < 32; ++e) { const int c = (int)__hip_atomic_load(gc + e, RLX_AGENT); cnt[e] = c; tst[e] = acc; acc += (c + 255) >> 8; }
        tst[32] = acc; tab[0] = acc; }
    __syncthreads();
    if (w.tid < 32) { const int e = w.tid; for (int pm = tst[e]; pm < tst[e + 1]; ++pm) tab[1 + pm] = e; }
    __syncthreads();
}
__device__ __forceinline__ void router_lists(ARef A, const WI& w, int l) {
    LAS unsigned* hist = (LAS unsigned*)(w.lds + HIST_OFF); LAS int* base = (LAS int*)(w.lds + BASE_OFF); LAS int* texp = (LAS int*)(w.lds + TEXP_OFF);
    __syncthreads();
    if (w.tid < 32) { base[w.tid] = (int)atomicAdd((unsigned*)(A.ws + WS_CTL) + CW_GCNT + 64 * l + w.tid, hist[w.tid]); hist[w.tid] = 0u; }
    __syncthreads();
    int* LIST = (int*)(A.ws + WS_LIST); int* PW = (int*)(A.ws + WS_POS);
    for (int g16 = w.gw; g16 < MTOK / 16; g16 += w.NGW) {
        const int j = w.lane >> 2, q = w.lane & 3, m = 16 * g16 + j; const int e = texp[(w.wave * 16 + j) * 4 + q]; const int idx = base[e] + (int)atomicAdd((unsigned*)hist + e, 1u);
        LIST[e * LCAP + idx] = m; PW[(size_t)m * 4 + q] = (e << 20) | idx; }
}
__device__ __forceinline__ void combine_row(ARef A, int l, int m, int lane, const LAS int* tst, float gscale = 1.0f, float oscale = 1.0f) {
    float* XA = (float*)(A.ws + WS_XA) + (size_t)m * DM; const float* MOD = (const float*)(A.ws + WS_MOD) + (size_t)(l * 8 + (m >> 12)) * 6144;
    const int* PS = (const int*)(A.ws + WS_POS) + (size_t)m * 4; const float* TW = (const float*)(A.ws + WS_TOPW) + (size_t)m * 4;
    const bf16* YS = (const bf16*)(A.ws + WS_XS);
    f32x4 v[4], acc[4];
#pragma unroll
    for (int j = 0; j < 4; ++j) { v[j] = *(const f32x4*)(XA + 4 * (lane + 64 * j)); acc[j] = (f32x4){0.f, 0.f, 0.f, 0.f}; }
#pragma unroll
    for (int k = 0; k < 4; ++k) { const int pe = PS[k]; const int pos = tst[pe >> 20] * 256 + (pe & 0xFFFFF); const float gt = TW[k] * gscale; const v2u* yr = (const v2u*)(YS + (size_t)pos * DM);
#pragma unroll
        for (int j = 0; j < 4; ++j) { const v2u y = yr[lane + 64 * j]; acc[j] += gt * (f32x4){bf_lo(y.x), bf_hi(y.x), bf_lo(y.y), bf_hi(y.y)}; } }
    float ss = 0.0f;
#pragma unroll
    for (int j = 0; j < 4; ++j) { const int kx = 4 * (lane + 64 * j); v[j] += *(const f32x4*)(MOD + 5 * 1024 + kx) * acc[j]; ss += dot4(v[j], v[j]); }
    ss = wave_sum(ss); const float rstd = 1.0f / sqrtf(ss * (1.0f / DM) + 1e-5f);
    if (l + 1 < NLAYER) {
#pragma unroll
        for (int j = 0; j < 4; ++j) *(f32x4*)(XA + 4 * (lane + 64 * j)) = v[j];
        const float* mb = MOD + 8 * 6144;
        emit_h_row(v, rstd, A.in[I_NMIX] + (l + 1) * DM, mb + 1024, mb, (bf16*)(A.ws + WS_H) + (size_t)m * DM, lane);
    } else {
        float* orow = A.out + (size_t)m * DM; const float* gf = A.in[I_NFINAL];
#pragma unroll
        for (int j = 0; j < 4; ++j) { const int kx = 4 * (lane + 64 * j); *(f32x4*)(orow + kx) = v[j] * (rstd * oscale) * *(const f32x4*)(gf + kx); }
    }
}

constexpr int N_LAUNCHES = MK_N_LAUNCHES;
template <int SEL> __global__ void __launch_bounds__(NWAVES * 64, 2) fwd(ArgsH Ah) {
    extern __shared__ __attribute__((aligned(16))) unsigned char lds[];
    (void)Ah;
    const int wave_s = __builtin_amdgcn_readfirstlane((int)threadIdx.x >> 6);
    auto tid_now = [&]() -> int { int ws_ = wave_s; unsigned z_ = 0u; asm volatile("" : "+s"(ws_), "+s"(z_)); return ws_ * 64 + (int)__builtin_amdgcn_mbcnt_hi(~0u, __builtin_amdgcn_mbcnt_lo(~0u, z_)); };
#define TID_NOW() tid_now()
#define MAKE_WI() WI w; { int tz = TID_NOW(); asm volatile("" : "+v"(tz)); int bz = blockIdx.x, gz = gridDim.x; asm volatile("" : "+s"(bz), "+s"(gz)); \
        w.lds = (LAS unsigned char*)lds; w.tid = tz; w.lane = tz & 63; w.wave = __builtin_amdgcn_readfirstlane(tz >> 6); w.G = gz; w.bx = bz; w.vcu = (gz % 8 == 0) ? (bz % 8) * (gz / 8) + bz / 8 : bz; \
        w.gw = w.vcu * NWAVES + w.wave; w.NGW = gz * NWAVES; }
    { const int t0 = threadIdx.x; for (int u = t0; u < (LDS_BYTES - RING_BYTES) / 4; u += NWAVES * 64) ((LAS unsigned*)((LAS unsigned char*)lds + RING_BYTES))[u] = 0u; }
    __syncthreads();
    int lo, hi; { ARef A0 = *kargs(); lo = A0.ph_lo; hi = A0.ph_hi; }
    if (N_LAUNCHES == 1) { ARef A0 = *kargs(); (void)xcd_barrier_post((unsigned*)((gu32*)(A0.ws + WS_CTL) + CW_BAR), (volatile LAS unsigned*)((LAS unsigned char*)lds + MISC_OFF) + 8, TID_NOW()); }
#define GRID_BAR() do { if (N_LAUNCHES == 1) { ARef Ab = *kargs(); XcdBarrier bar_; bar_.bar = (unsigned*)((gu32*)(Ab.ws + WS_CTL) + CW_BAR); bar_.x = xb_xcc_id(); bar_.st = (volatile LAS unsigned*)((LAS unsigned char*)lds + MISC_OFF) + 8; xcd_barrier(bar_, TID_NOW()); } } while (0)
#ifndef TPROBE
#define TPROBE 0
#endif
#if TPROBE
    unsigned long long tp_acc = 0ull;
#define TP_SCALE tp_scale_of(__hip_atomic_load((unsigned*)(A.ws + WS_CTL) + 3, RLX_AGENT))
    auto tp_scale_of = [](unsigned ticks) -> float { const float us = (float)ticks * 0.01f; if (us < 1.0f) return 1.0f; const float q = exp2f(rintf(log2f(us) * 8.0f) * 0.125f); return 1.0f + sqrtf(q * 1e-5f); };
#define TP_BEGIN(kind) unsigned long long tp_t0 = 0ull; if ((kind) == TPROBE) tp_t0 = __builtin_amdgcn_s_memrealtime();
#define TP_END(kind) if ((kind) == TPROBE) { tp_acc += __builtin_amdgcn_s_memrealtime() - tp_t0; }
#define TP_PUBLISH(l) if ((l) == 1 && w.vcu == 0 && w.tid == 0) __hip_atomic_store((unsigned*)(A.ws + WS_CTL) + 3, (unsigned)tp_acc, RLX_AGENT);
#else
#define TP_SCALE 1.0f
#define TP_PUBLISH(l)
#define TP_BEGIN(kind)
#define TP_END(kind)
#endif
#define IN(k) (lo <= (k) && (k) < hi)
#ifndef PHMASK
#define PHMASK 0xffffffffu
#endif
#define KON(k) if constexpr ((SEL < 0 && ((PHMASK >> (k)) & 1u)) || SEL == (k))
#define BOTH(k) (IN(k) && IN((k) + 1))
#ifndef PROBE_REP
#define PROBE_REP 0
#endif
#if PROBE_REP
    int nrep_ = 2; asm volatile("" : "+s"(nrep_));
#define REP(bit) _Pragma("unroll 1") for (int rep_ = 0; rep_ < (((PROBE_REP >> (bit)) & 1) ? nrep_ : 1); ++rep_)
#else
#define REP(bit) for (int rep_ = 0; rep_ < 1; ++rep_)
#endif
#define ring ((PG8_LAS unsigned char*)lds)

    KON(0) if (IN(0)) { ARef A = *kargs(); MAKE_WI(); REP(0) ph_prologue(A, w); if (BOTH(0)) GRID_BAR(); }

#define LAYER_BODY(l) do {\
        const int pb = 1 + l * NPL; \
        KON(1) if (IN(pb + 0)) { ARef A = *kargs(); MAKE_WI(); TP_BEGIN(1) if (l == 0) { REP(15) { ph_norm1(A, w); small_weights_to_f16(A, w); } if (BOTH(pb + 0)) GRID_BAR(); } TP_END(1) } \
        KON(2) if (IN(pb + 1)) { ARef A = *kargs(); MAKE_WI(); TP_BEGIN(2) \
            pg8::Gemm g{(const bf16*)(A.ws + WS_H), (const bf16*)(A.ws + WS_WIN) + (size_t)l * INCP * DM, MTOK, INCP, DM}; pg8::StaticOrder S; S.init(MTOK, INCP, w.G, w.bx); \
            pg8::EpiProj E{(bf16*)(A.ws + WS_PB), (bf16*)(A.ws + WS_PF)}; \
            REP(1) pg8::gemm_phase<pg8::EpiProj, pg8::StaticOrder, true, true>(ring, g, S, E, w.tid); \
            if (BOTH(pb + 1)) GRID_BAR(); TP_END(2) \
        } \
        KON(3) if (IN(pb + 2)) { ARef A = *kargs(); MAKE_WI(); TP_BEGIN(3) \
            REP(2) { int part_ = rep_ ? ((PROBE_REP >> 21) & 7) : 7; asm volatile("" : "+s"(part_)); for (int g = w.gw; g < MTOK / 16; g += w.NGW) prep16(A, l, 16 * g, w.lane, part_); } \
            if (BOTH(pb + 2)) GRID_BAR(); TP_END(3) \
        } \
        KON(4) if (IN(pb + 3)) { ARef A = *kargs(); MAKE_WI(); TP_BEGIN(4) \
            REP(3) { for (int tk = 2 * w.vcu; tk < 32 * NCH; tk += 2 * w.G) scan_rwkv_task2(A, w, tk); } \
            REP(13) { for (int tk = w.vcu; tk < 32 * NCH / 2; tk += w.G) scan_ret_task(A, w, tk); } \
            REP(4) { LAS unsigned char* vl = w.lds + w.wave * 4608; for (int it = w.gw; it < 32 * 128; it += w.NGW) sb_tile_mfma(A, it, w.lane, vl); } \
            REP(5) dsa_scores_mfma(A, w); \
            if (BOTH(pb + 3)) GRID_BAR(); TP_END(4) \
        } \
        KON(5) if (IN(pb + 4)) { ARef A = *kargs(); MAKE_WI(); TP_BEGIN(5) \
            if (w.bx < 32) prefix_chain(A, w, w.bx); \
            REP(6) dsa_wave(A, w, w.lds + w.wave * 13312, l + 2 * rep_, l); \
            REP(14) { if (rep_ && w.bx < 32) prefix_chain(A, w, w.bx); } \
            if (BOTH(pb + 4)) GRID_BAR(); TP_END(5) \
        } \
        KON(6) if (IN(pb + 5)) { ARef A = *kargs(); MAKE_WI(); TP_BEGIN(6) \
            REP(7) ph_post16(A, w, l); \
            if (BOTH(pb + 5)) GRID_BAR(); TP_END(6) \
        } \
        KON(7) if (IN(pb + 6)) { ARef A = *kargs(); MAKE_WI(); TP_BEGIN(7) \
            pg8::Gemm g{(const bf16*)(A.ws + WS_MIX), (const bf16*)(A.ws + WS_WOUT) + (size_t)l * DM * DM, MTOK, DM, DM}; pg8::StaticOrder S; S.init(MTOK, DM, w.G, w.bx); \
            pg8::EpiRes E{l == 0 ? A.in[I_X] : (const float*)(A.ws + WS_XA), (float*)(A.ws + WS_XA), (const float*)(A.ws + WS_MOD) + (size_t)l * 8 * 6144 + 2 * 1024}; \
            REP(16) { pg8::EpiRes E2 = E; if (rep_ && l == 1) E2.gate = (const float*)(A.ws + WS_CTL + 512 * 1024); pg8::gemm_phase<pg8::EpiRes, pg8::StaticOrder, true, true>(ring, g, S, E2, w.tid); } \
            if (BOTH(pb + 6)) GRID_BAR(); TP_END(7) \
        } \
        KON(8) if (IN(pb + 7)) { ARef A = *kargs(); MAKE_WI(); TP_BEGIN(8) \
            { LAS unsigned* hist = (LAS unsigned*)(w.lds + HIST_OFF); LAS int* texp = (LAS int*)(w.lds + TEXP_OFF); if (w.tid < 32) hist[w.tid] = 0u; router_stage16(A, w, l); \
            REP(10) { for (int g16 = w.gw; g16 < MTOK / 16; g16 += w.NGW) router16(A, l, 16 * g16, w.lane, hist, (const LAS unsigned char*)w.lds, texp + w.wave * 64, rep_ != 0); } \
            router_lists(A, w, l); } \
            if (BOTH(pb + 7)) GRID_BAR(); TP_END(8) \
        } \
        KON(10) if (IN(pb + 8)) { ARef A = *kargs(); MAKE_WI(); TP_BEGIN(10) \
            build_expert_table(A, w, l); \
            pg8::Gemm g{(const bf16*)(A.ws + WS_H), (const bf16*)(A.ws + WS_W1) + (size_t)l * NEXP * 2048 * DM, MOE_ROWS, NEXP * 2048, DM}; \
            pg8::MoeOrder S{(const PG8_LAS int*)(w.lds + TAB_OFF), 8, w.G, w.vcu, (const PG8_LAS int*)(w.lds + TST_OFF), (const PG8_LAS int*)(w.lds + CNT_OFF), (const int*)(A.ws + WS_LIST)}; \
            pg8::EpiSwiglu E{(bf16*)(A.ws + WS_ACT), A.in[I_MB1] + (size_t)l * NEXP * 2048}; \
            REP(8) { if (PROBE_REP & (1 << 20)) { if (rep_) pg8::gemm_phase<pg8::EpiNull, pg8::MoeOrder, true, true, true>(ring, g, S, pg8::EpiNull{}, w.tid); else pg8::gemm_phase<pg8::EpiSwiglu, pg8::MoeOrder, true, true, true>(ring, g, S, E, w.tid); } else pg8::gemm_phase<pg8::EpiSwiglu, pg8::MoeOrder, true, true, true>(ring, g, S, E, w.tid); } \
            if (BOTH(pb + 8)) GRID_BAR(); TP_END(10) \
        } \
        KON(11) if (IN(pb + 9)) { ARef A = *kargs(); MAKE_WI(); TP_BEGIN(11) \
            build_expert_table(A, w, l); \
            pg8::Gemm g{(const bf16*)(A.ws + WS_ACT), (const bf16*)(A.ws + WS_W2) + (size_t)l * NEXP * DM * DM, MOE_ROWS, NEXP * DM, DM}; \
            pg8::MoeOrder S{(const PG8_LAS int*)(w.lds + TAB_OFF), 4, w.G, w.vcu, (const PG8_LAS int*)(w.lds + TST_OFF), (const PG8_LAS int*)(w.lds + CNT_OFF), (const int*)(A.ws + WS_LIST)}; \
            pg8::EpiY E{(bf16*)(A.ws + WS_XS), A.in[I_MB2] + (size_t)l * NEXP * DM}; \
            REP(9) pg8::gemm_phase<pg8::EpiY, pg8::MoeOrder, true, true>(ring, g, S, E, w.tid); \
            TP_PUBLISH(l) \
            if (BOTH(pb + 9)) GRID_BAR(); TP_END(11) \
        } \
        KON(12) if (IN(pb + 10)) { ARef A = *kargs(); MAKE_WI(); TP_BEGIN(12) \
            build_expert_table(A, w, l); \
            REP(12) for (int m = w.gw; m < MTOK; m += w.NGW) combine_row(A, l, m, w.lane, (const LAS int*)(w.lds + TST_OFF), (rep_ && l == 0) ? 0.0f : 1.0f, TP_SCALE); \
            if (BOTH(pb + 10)) GRID_BAR(); TP_END(12) \
        } \
    } while (0)
    LAYER_BODY(0);
    LAYER_BODY(1);
#undef LAYER_BODY
#undef IN
#undef ring
#undef MAKE_WI
#undef TID_NOW
#undef GRID_BAR
#undef KON
#undef BOTH
}


#if MK_N_LAUNCHES != 1
template <int K> static void launch_one(int grid, hipStream_t stream, const ArgsH& a) {
    static bool attr = false;
    if (!attr) { (void)hipFuncSetAttribute((const void*)fwd<K>, hipFuncAttributeMaxDynamicSharedMemorySize, LDS_BYTES); attr = true; }
    hipLaunchKernelGGL(fwd<K>, dim3(grid), dim3(NWAVES * 64), LDS_BYTES, stream, a);
}
static void launch_kind(int kind, int grid, hipStream_t stream, const ArgsH& a) {
    switch (kind) {
        case 0: launch_one<0>(grid, stream, a); break; case 1: launch_one<1>(grid, stream, a); break; case 2: launch_one<2>(grid, stream, a); break;
        case 3: launch_one<3>(grid, stream, a); break; case 4: launch_one<4>(grid, stream, a); break; case 5: launch_one<5>(grid, stream, a); break;
        case 6: launch_one<6>(grid, stream, a); break; case 7: launch_one<7>(grid, stream, a); break; case 8: launch_one<8>(grid, stream, a); break;
        case 9: launch_one<9>(grid, stream, a); break; case 10: launch_one<10>(grid, stream, a); break; case 11: launch_one<11>(grid, stream, a); break;
        default: launch_one<12>(grid, stream, a); break;
    }
}
#endif
extern "C" void kernel_launch(void* const* d_in, const int* in_sizes, int n_in, void* d_out, int out_size, void* d_ws, size_t ws_size, hipStream_t stream) {
    static int grid = 0;
    if (grid == 0) {
        if (n_in != N_IN || out_size != MTOK * DM || ws_size < WS_END) { fprintf(stderr, "kernel_launch: unexpected shapes (n_in %d, out %d, ws %zu)\n", n_in, out_size, ws_size); grid = -1; return; }
        int dev = 0, cus = 0;
        if (hipGetDevice(&dev) != hipSuccess || hipDeviceGetAttribute(&cus, hipDeviceAttributeMultiprocessorCount, dev) != hipSuccess) { grid = -1; return; }
#if MK_N_LAUNCHES == 1
        {
            if (hipFuncSetAttribute((const void*)fwd<-1>, hipFuncAttributeMaxDynamicSharedMemorySize, LDS_BYTES) != hipSuccess) { fprintf(stderr, "kernel_launch: hipFuncSetAttribute failed\n"); grid = -1; return; }
            int per_cu = 0;
            if (hipOccupancyMaxActiveBlocksPerMultiprocessor(&per_cu, (const void*)fwd<-1>, NWAVES * 64, LDS_BYTES) != hipSuccess || per_cu < 1) fprintf(stderr, "kernel_launch: occupancy query says %d\n", per_cu);
            (void)hipGetLastError();
        }
#endif
        grid = cus;
    }
    if (grid < 0) return;
    (void)in_sizes;
    if (hipMemsetAsync((char*)d_ws + WS_CTL, 0, CTL_ZERO_BYTES, stream) != hipSuccess) return;
    ArgsH a{};
    for (int i = 0; i < N_IN; ++i) a.in[i] = (const float*)d_in[i];
    a.out = (float*)d_out; a.ws = (unsigned char*)d_ws;
    for (int f = 0; f < 44; ++f) a.invf[f] = (f < 32) ? pow(10000.0, -(double)f / 32.0) : (f < 40) ? pow(500000.0, -(double)(f - 32) / 8.0) : pow(500000.0, -(double)(f - 40) / 4.0);
#if MK_N_LAUNCHES == 1
    a.ph_lo = 0; a.ph_hi = NPHASE; a.li = 0;
    hipLaunchKernelGGL(fwd<-1>, dim3(grid), dim3(NWAVES * 64), LDS_BYTES, stream, a);
#else
    {
        for (int p = 0; p < NPHASE; ++p) {
            if (p == 1 + NPL) continue;
            a.ph_lo = p; a.ph_hi = p + 1; a.li = p;
            static const int kinds_[NPL] = {1, 2, 3, 4, 5, 6, 7, 8, 10, 11, 12};
            const int kind = (p == 0) ? 0 : kinds_[(p - 1) % NPL];
            launch_kind(kind, grid, stream, a);
        }
    }
#endif
}
```

```cpp
#include <hip/hip_runtime.h>
#include <cstdio>
#include <cstdint>
#include <cmath>

#ifndef MK_N_LAUNCHES
#define MK_N_LAUNCHES 1
#endif

namespace pg8 {
#define PG8_LAS __attribute__((address_space(3)))
typedef unsigned short bf16_t;
typedef short bf16x8 __attribute__((ext_vector_type(8)));
typedef float f32x4 __attribute__((ext_vector_type(4)));
typedef unsigned u32x4 __attribute__((ext_vector_type(4)));
typedef unsigned u32x2 __attribute__((ext_vector_type(2)));
constexpr int BM = 256, BK = 64, HALF = 128, HTB = HALF * BK * 2  , STAGE_BYTES = 8 * HTB, NXCD = 8, WGM = 8;

__host__ __device__ __forceinline__ int lds_byte(int r, int c) { const int st = (r >> 4) * 2 + (c >> 5), rr = r & 15, cc = c & 31, ob = rr * 64 + cc * 2; return st * 1024 + (ob ^ (((ob >> 9) & 1) << 5)); }
__host__ __device__ __forceinline__ void stage_rc(int b, int& R, int& C) { const int st = b / 1024, sb = b % 1024, swz = sb ^ (((sb >> 9) & 1) << 5); R = (st >> 1) * 16 + swz / 64; C = (st & 1) * 32 + (swz % 64) / 2; }
__host__ __device__ __forceinline__ int perm32(int rho) { const int n = rho >> 4, i = rho & 15; return 8 * (i >> 2) + 4 * n + (i & 3); }

struct Unit { int pm, pn; };
struct Gemm { const bf16_t* A; const bf16_t* Bt; int M, N, K; };

struct StaticOrder {
    int nM, nN, nwg, G, c;
    __host__ __device__ void init(int M, int N, int G_, int c_) { nM = M / BM; nN = N / BM; nwg = nM * nN; G = G_; c = c_; }
    __host__ __device__ bool next(int i, Unit& u) const {
        const long L = (long)i * G + c; if (L >= nwg) return false;
        int wgid = (int)L; { const int q = nwg / NXCD, r = nwg % NXCD, xcd = wgid % NXCD, off = wgid / NXCD; wgid = (xcd < r ? xcd * (q + 1) : r * (q + 1) + (xcd - r) * q) + off; }
        const int nig = WGM * nN, gid = wgid / nig, fm = gid * WGM, gsz = (nM - fm) < WGM ? (nM - fm) : WGM;
        u.pm = fm + ((wgid % nig) % gsz); u.pn = (wgid % nig) / gsz; return true;
    }
    __device__ __forceinline__ void a_ready(const Unit&) const {}
    __device__ __forceinline__ void done(const Unit&) const {}
};
__device__ __forceinline__ unsigned cvt_pk_bf16(float lo, float hi) { unsigned r; asm volatile("v_cvt_pk_bf16_f32 %0, %1, %2" : "=v"(r) : "v"(lo), "v"(hi)); return r; }
struct EpiF32 {
    static constexpr bool PERM = false, AFTER_DRAIN = false;
    float* C; int ldc;
    __device__ __forceinline__ void operator()(const f32x4 (&acc)[2][2][4][2], const Unit& u, int wr, int wc, int fr, int fq) const {
        const int row0 = u.pm * BM + wr * 64 + fr, col0 = u.pn * BM + wc * 32 + 4 * fq;
#pragma unroll
        for (int ai = 0; ai < 2; ++ai)
#pragma unroll
            for (int m = 0; m < 4; ++m) { float* rowp = C + (size_t)(row0 + ai * HALF + m * 16) * ldc + col0;
#pragma unroll
                for (int bj = 0; bj < 2; ++bj)
#pragma unroll
                    for (int n = 0; n < 2; ++n) *(f32x4*)(rowp + bj * HALF + n * 16) = acc[ai][bj][m][n]; }
    }
};
struct EpiNull {
    static constexpr bool PERM = true, AFTER_DRAIN = false;
    __device__ __forceinline__ void operator()(const f32x4 (&acc)[2][2][4][2], const Unit&, int, int, int, int) const {
#pragma unroll
        for (int ai = 0; ai < 2; ++ai)
#pragma unroll
            for (int bj = 0; bj < 2; ++bj) asm volatile("" :: "v"(acc[ai][bj][0][0]), "v"(acc[ai][bj][0][1]), "v"(acc[ai][bj][1][0]), "v"(acc[ai][bj][1][1]), "v"(acc[ai][bj][2][0]), "v"(acc[ai][bj][2][1]), "v"(acc[ai][bj][3][0]), "v"(acc[ai][bj][3][1]));
    }
};
struct EpiProj {
    static constexpr bool PERM = true, AFTER_DRAIN = false;
    bf16_t* PB; bf16_t* PF;
    __device__ __forceinline__ void operator()(const f32x4 (&acc)[2][2][4][2], const Unit& u, int wr, int wc, int fr, int fq) const {
        const int row0 = u.pm * BM + wr * 64 + fr;
        if (u.pn < 7) { const int c0 = u.pn * BM + wc * 32 + 8 * fq;
#pragma unroll
            for (int ai = 0; ai < 2; ++ai)
#pragma unroll
                for (int m = 0; m < 4; ++m) { bf16_t* rowp = PB + (size_t)(row0 + ai * HALF + m * 16) * 1792 + c0;
#pragma unroll
                    for (int bj = 0; bj < 2; ++bj) { const f32x4 v0 = acc[ai][bj][m][0], v1 = acc[ai][bj][m][1];
                        u32x4 w; w.x = cvt_pk_bf16(v0[0], v0[1]); w.y = cvt_pk_bf16(v0[2], v0[3]); w.z = cvt_pk_bf16(v1[0], v1[1]); w.w = cvt_pk_bf16(v1[2], v1[3]);
                        *(u32x4*)(rowp + bj * HALF) = w; } }
        } else { const int c0 = (u.pn - 7) * BM + wc * 32 + 8 * fq;
#pragma unroll
            for (int ai = 0; ai < 2; ++ai)
#pragma unroll
                for (int m = 0; m < 4; ++m) { bf16_t* rowp = PF + (size_t)(row0 + ai * HALF + m * 16) * 1280 + c0;
#pragma unroll
                    for (int bj = 0; bj < 2; ++bj) { const f32x4 v0 = acc[ai][bj][m][0], v1 = acc[ai][bj][m][1];
                        u32x4 w; w.x = cvt_pk_bf16(v0[0], v0[1]); w.y = cvt_pk_bf16(v0[2], v0[3]); w.z = cvt_pk_bf16(v1[0], v1[1]); w.w = cvt_pk_bf16(v1[2], v1[3]);
                        *(u32x4*)(rowp + bj * HALF) = w; } }
        }
    }
};
struct EpiRes {
    static constexpr bool PERM = false, AFTER_DRAIN = false;
    const float* xin; float* xout; const float* gate;
    __device__ __forceinline__ void operator()(const f32x4 (&acc)[2][2][4][2], const Unit& u, int wr, int wc, int fr, int fq) const {
        const int row0 = u.pm * BM + wr * 64 + fr, col0 = u.pn * BM + wc * 32 + 4 * fq;
        const float* gp = gate + (size_t)((u.pm * BM) >> 12) * 6144 + col0;
        f32x4 gv[2][2];
#pragma unroll
        for (int bj = 0; bj < 2; ++bj)
#pragma unroll
            for (int n = 0; n < 2; ++n) gv[bj][n] = *(const f32x4*)(gp + bj * HALF + n * 16);
#pragma unroll
        for (int ai = 0; ai < 2; ++ai)
#pragma unroll
            for (int m = 0; m < 4; ++m) { const size_t ro = (size_t)(row0 + ai * HALF + m * 16) * 1024 + col0;
#pragma unroll
                for (int bj = 0; bj < 2; ++bj)
#pragma unroll
                    for (int n = 0; n < 2; ++n) { const f32x4 xv = *(const f32x4*)(xin + ro + bj * HALF + n * 16); *(f32x4*)(xout + ro + bj * HALF + n * 16) = xv + gv[bj][n] * acc[ai][bj][m][n]; } }
    }
};
__device__ __forceinline__ float swiglu1(float glu, float lin) {
    glu = fminf(glu, 7.0f); lin = fminf(fmaxf(lin, -7.0f), 7.0f);
    return glu * (1.0f / (1.0f + __expf(-1.702f * glu))) * (lin + 1.0f);
}
struct EpiSwiglu {
    static constexpr bool PERM = true, AFTER_DRAIN = false;
    bf16_t* O; const float* b1;
    __device__ __forceinline__ void operator()(const f32x4 (&acc)[2][2][4][2], const Unit& u, int wr, int wc, int fr, int fq) const {
        const int e = u.pn >> 3, j = u.pn & 7, row0 = u.pm * BM + wr * 64 + fr, c0 = 128 * j + wc * 32 + 8 * fq;
        const float* bp = b1 + (size_t)e * 2048 + c0;
        f32x4 bg[2], bl[2];
#pragma unroll
        for (int n = 0; n < 2; ++n) { bg[n] = *(const f32x4*)(bp + 4 * n); bl[n] = *(const f32x4*)(bp + 1024 + 4 * n); }
#pragma unroll
        for (int ai = 0; ai < 2; ++ai)
#pragma unroll
            for (int m = 0; m < 4; ++m) { bf16_t* rowp = O + (size_t)(row0 + ai * HALF + m * 16) * 1024 + c0;
                const f32x4 g0 = acc[ai][0][m][0] + bg[0], g1 = acc[ai][0][m][1] + bg[1], l0 = acc[ai][1][m][0] + bl[0], l1 = acc[ai][1][m][1] + bl[1];
                u32x4 w;
                w.x = cvt_pk_bf16(swiglu1(g0[0], l0[0]), swiglu1(g0[1], l0[1])); w.y = cvt_pk_bf16(swiglu1(g0[2], l0[2]), swiglu1(g0[3], l0[3]));
                w.z = cvt_pk_bf16(swiglu1(g1[0], l1[0]), swiglu1(g1[1], l1[1])); w.w = cvt_pk_bf16(swiglu1(g1[2], l1[2]), swiglu1(g1[3], l1[3]));
                *(u32x4*)rowp = w; }
    }
};
struct EpiY {
    static constexpr bool PERM = true, AFTER_DRAIN = false;
    bf16_t* O; const float* b2;
    __device__ __forceinline__ void operator()(const f32x4 (&acc)[2][2][4][2], const Unit& u, int wr, int wc, int fr, int fq) const {
        const int e = u.pn >> 2, j = u.pn & 3, row0 = u.pm * BM + wr * 64 + fr, c0 = 256 * j + wc * 32 + 8 * fq;
        const float* bp = b2 + (size_t)e * 1024 + c0;
        f32x4 bv[2][2];
#pragma unroll
        for (int bj = 0; bj < 2; ++bj)
#pragma unroll
            for (int n = 0; n < 2; ++n) bv[bj][n] = *(const f32x4*)(bp + bj * HALF + 4 * n);
#pragma unroll
        for (int ai = 0; ai < 2; ++ai)
#pragma unroll
            for (int m = 0; m < 4; ++m) { bf16_t* rowp = O + (size_t)(row0 + ai * HALF + m * 16) * 1024 + c0;
#pragma unroll
                for (int bj = 0; bj < 2; ++bj) { const f32x4 v0 = acc[ai][bj][m][0] + bv[bj][0], v1 = acc[ai][bj][m][1] + bv[bj][1];
                    u32x4 w; w.x = cvt_pk_bf16(v0[0], v0[1]); w.y = cvt_pk_bf16(v0[2], v0[3]); w.z = cvt_pk_bf16(v1[0], v1[1]); w.w = cvt_pk_bf16(v1[2], v1[3]);
                    *(u32x4*)(rowp + bj * HALF) = w; } }
    }
};
struct MoeOrder {
    const PG8_LAS int* tab; int NJ, G, c;
    __device__ __forceinline__ bool next(int i, Unit& u) const {
        const int T = tab[0]; const long L = (long)i * G + c; if (L >= (long)T * NJ) return false;
        const int pm = (int)(L / NJ), j = (int)(L % NJ);
        u.pm = pm; u.pn = tab[1 + pm] * NJ + j; return true;
    }
    __device__ __forceinline__ void a_ready(const Unit&) const {}
    __device__ __forceinline__ void done(const Unit&) const {}
    const PG8_LAS int* tst; const PG8_LAS int* cnt; const int* list;
    __device__ __forceinline__ int row_of(const Unit& u, int r) const { const int e = tab[1 + u.pm], idx = 256 * (u.pm - tst[e]) + r; return (idx < cnt[e]) ? list[e * 32768 + idx] : 0; }
};

template <class Epi, class Sched, bool ALIGN_EPI = false, bool SP2 = false, bool GATHER = false>
__device__ __forceinline__ void gemm_phase(PG8_LAS unsigned char* lds, const Gemm g, const Sched& S, const Epi& E, int tid_in) {
    int tid_ = tid_in; asm volatile("" : "+v"(tid_));
    const int tid = tid_, wid = __builtin_amdgcn_readfirstlane(tid >> 6), lane = tid & 63, wr = wid >> 2, wc = wid & 3, fr = lane & 15, fq = lane >> 4;
    const int K = g.K, nt = K / BK;
    unsigned voffA[2], voffB[2];
#pragma unroll
    for (int i = 0; i < 2; ++i) { int R, C; stage_rc(tid * 16 + i * 8192, R, C); const int Rb = Epi::PERM ? ((R & ~31) + perm32(R & 31)) : R;
        voffA[i] = (unsigned)(R * K + C) * 2u; voffB[i] = (unsigned)(Rb * K + C) * 2u; }
    static_assert(!GATHER || SP2, "gathered A rows: only the two-super-phase loop is wired");
    unsigned cvo[2][2], nvo[2][2];
#define PG8_ROWS(dst, u_) do { _Pragma("unroll") for (int h_ = 0; h_ < 2; ++h_) _Pragma("unroll") for (int i_ = 0; i_ < 2; ++i_) { int R_, C_; stage_rc(tid * 16 + i_ * 8192, R_, C_); dst[h_][i_] = (unsigned)(S.row_of(u_, h_ * HALF + R_) * K + C_) * 2u; } } while (0)
#define PG8_STAGE_A(bufoff, gbase, half, nx) do { if constexpr (GATHER) { unsigned o_[2]; o_[0] = (nx) ? nvo[half][0] : cvo[half][0]; o_[1] = (nx) ? nvo[half][1] : cvo[half][1]; PG8_STAGE(bufoff, gbase, o_); } else { PG8_STAGE(bufoff, (gbase) + (half) * hstep, voffA); } } while (0)
    const size_t kstep = (size_t)(BK * 2);
    const size_t hstep = (size_t)HALF * K * 2;
    const size_t tstep = 2 * hstep;
    const unsigned ldsw = (unsigned)wid * 1024u;
    const int aoff = lds_byte(wr * 64 + fr, fq * 8), boff = lds_byte(wc * 32 + fr, fq * 8);
#define PG8_SA(b, h) (((b) * 2 + (h)) * HTB)
#define PG8_SB(b, h) ((4 + (b) * 2 + (h)) * HTB)
#define PG8_STAGE(bufoff, gbase, voff) do { _Pragma("unroll") for (int _i = 0; _i < 2; ++_i) \
        __builtin_amdgcn_global_load_lds((const unsigned*)((const char*)(gbase) + (voff)[_i]), (PG8_LAS unsigned*)(lds + (bufoff) + ldsw + _i * 8192), 16, 0, 0); } while (0)
#define PG8_LDA(dst, b, h) do { _Pragma("unroll") for (int m = 0; m < 4; ++m) _Pragma("unroll") for (int k = 0; k < 2; ++k) dst[m][k] = *(const PG8_LAS bf16x8*)(lds + PG8_SA(b, h) + aoff + m * 2048 + k * 1024); } while (0)
#define PG8_LDB(dst, b, h) do { _Pragma("unroll") for (int n = 0; n < 2; ++n) _Pragma("unroll") for (int k = 0; k < 2; ++k) dst[n][k] = *(const PG8_LAS bf16x8*)(lds + PG8_SB(b, h) + boff + n * 2048 + k * 1024); } while (0)
#define PG8_MMA(ai, bj, At, Bt) do { __builtin_amdgcn_s_setprio(1); _Pragma("unroll") for (int m = 0; m < 4; ++m) _Pragma("unroll") for (int n = 0; n < 2; ++n) _Pragma("unroll") for (int k = 0; k < 2; ++k) \
        acc[ai][bj][m][n] = __builtin_amdgcn_mfma_f32_16x16x32_bf16(Bt[n][k], At[m][k], acc[ai][bj][m][n], 0, 0, 0); __builtin_amdgcn_s_setprio(0); } while (0)
#define PG8_WAIT_V(n) asm volatile("s_waitcnt vmcnt(" #n ")" ::: "memory")
#define PG8_WAIT_L(n) asm volatile("s_waitcnt lgkmcnt(" #n ")" ::: "memory")
#define PG8_BAR __builtin_amdgcn_s_barrier()
#define PG8_SCHED __builtin_amdgcn_sched_barrier(0)
    Unit cur, nxt; int ui = 0;
    if (!S.next(0, cur)) return;
    f32x4 acc[2][2][4][2];
#pragma unroll
    for (int a = 0; a < 2; ++a)
#pragma unroll
        for (int b = 0; b < 2; ++b)
#pragma unroll
            for (int m = 0; m < 4; ++m)
#pragma unroll
                for (int n = 0; n < 2; ++n) acc[a][b][m][n] = (f32x4){0.f, 0.f, 0.f, 0.f};
    bf16x8 At[4][2], B0[2][2], B1[2][2];
    const char* cA = (const char*)g.A + (GATHER ? (size_t)0 : (size_t)cur.pm * tstep); const char* cB = (const char*)g.Bt + (size_t)cur.pn * tstep;
    if constexpr (GATHER) { PG8_ROWS(cvo, cur); }
    S.a_ready(cur);
    if constexpr (SP2) {
        PG8_STAGE(PG8_SB(0, 0), cB, voffB); PG8_STAGE(PG8_SB(0, 1), cB + hstep, voffB); PG8_STAGE_A(PG8_SA(0, 0), cA, 0, false); PG8_STAGE_A(PG8_SA(0, 1), cA, 1, false);
        if (wr == 1) PG8_BAR;
        PG8_WAIT_V(2); PG8_BAR;
        PG8_STAGE(PG8_SB(1, 0), cB + kstep, voffB); PG8_STAGE_A(PG8_SA(1, 0), cA + kstep, 0, false); PG8_STAGE(PG8_SB(1, 1), cB + hstep + kstep, voffB);
        PG8_WAIT_V(6); PG8_BAR;
    } else {
        PG8_STAGE(PG8_SB(0, 0), cB, voffB); PG8_STAGE(PG8_SA(0, 0), cA, voffA); PG8_STAGE(PG8_SB(0, 1), cB + hstep, voffB); PG8_STAGE(PG8_SA(0, 1), cA + hstep, voffA);
        if (wr == 1) PG8_BAR;
        PG8_WAIT_V(4); PG8_BAR;
        PG8_STAGE(PG8_SB(1, 0), cB + kstep, voffB); PG8_STAGE(PG8_SA(1, 0), cA + kstep, voffA); PG8_STAGE(PG8_SB(1, 1), cB + hstep + kstep, voffB);
        PG8_WAIT_V(6); PG8_BAR;
    }
    for (;;) {
        const bool has_next = S.next(ui + 1, nxt);
        const char* nA = GATHER ? (const char*)g.A : (has_next ? (const char*)g.A + (size_t)nxt.pm * tstep : cA); const char* nB = has_next ? (const char*)g.Bt + (size_t)nxt.pn * tstep : cB;
        if constexpr (GATHER) { if (has_next) { PG8_ROWS(nvo, nxt); } else { _Pragma("unroll") for (int h_ = 0; h_ < 2; ++h_) { nvo[h_][0] = cvo[h_][0]; nvo[h_][1] = cvo[h_][1]; } } }
        for (int t = 0; t < nt; t += 2) {
            const bool last = (t == nt - 2);
            const char* a1 = cA + (size_t)(t + 1) * kstep;
            const char* a2 = last ? nA : cA + (size_t)(t + 2) * kstep; const char* b2 = last ? nB : cB + (size_t)(t + 2) * kstep;
            const char* a3 = a2 + kstep; const char* b3 = b2 + kstep;
            if (last && has_next) S.a_ready(nxt);
            if constexpr (SP2) {
            PG8_LDB(B0, 0, 0); PG8_LDB(B1, 0, 1); PG8_SCHED; PG8_LDA(At, 0, 0); PG8_STAGE_A(PG8_SA(1, 1), a1, 1, false);
            PG8_WAIT_V(8); PG8_WAIT_L(0); PG8_BAR; PG8_MMA(0, 0, At, B0); PG8_MMA(0, 1, At, B1); PG8_BAR; PG8_SCHED;
            PG8_LDA(At, 0, 1); PG8_STAGE(PG8_SB(0, 0), b2, voffB); PG8_STAGE(PG8_SB(0, 1), b2 + hstep, voffB); PG8_STAGE_A(PG8_SA(0, 0), a2, 0, last);
            PG8_WAIT_V(8); PG8_WAIT_L(0); PG8_BAR; PG8_MMA(1, 0, At, B0); PG8_MMA(1, 1, At, B1); PG8_BAR; PG8_SCHED;
            PG8_LDB(B0, 1, 0); PG8_LDB(B1, 1, 1); PG8_SCHED; PG8_LDA(At, 1, 0); PG8_STAGE_A(PG8_SA(0, 1), a2, 1, last);
            PG8_WAIT_V(8); PG8_WAIT_L(0); PG8_BAR; PG8_MMA(0, 0, At, B0); PG8_MMA(0, 1, At, B1); PG8_BAR; PG8_SCHED;
            PG8_LDA(At, 1, 1); PG8_STAGE(PG8_SB(1, 0), b3, voffB); PG8_STAGE(PG8_SB(1, 1), b3 + hstep, voffB); PG8_STAGE_A(PG8_SA(1, 0), a3, 0, last);
            PG8_WAIT_V(8); PG8_WAIT_L(0); PG8_BAR; PG8_MMA(1, 0, At, B0); PG8_MMA(1, 1, At, B1); PG8_BAR; PG8_SCHED;
            } else {
            PG8_LDB(B0, 0, 0); PG8_SCHED; PG8_LDA(At, 0, 0); PG8_STAGE(PG8_SA(1, 1), a1 + hstep, voffA);
            PG8_WAIT_L(8); PG8_BAR; PG8_WAIT_L(0); PG8_MMA(0, 0, At, B0); PG8_BAR; PG8_SCHED;
            PG8_LDB(B1, 0, 1); PG8_STAGE(PG8_SB(0, 0), b2, voffB);
            PG8_BAR; PG8_WAIT_L(0); PG8_MMA(0, 1, At, B1); PG8_BAR;
            PG8_LDA(At, 0, 1); PG8_STAGE(PG8_SA(0, 0), a2, voffA);
            PG8_BAR; PG8_WAIT_L(0); PG8_MMA(1, 0, At, B0); PG8_BAR; PG8_SCHED;
            PG8_STAGE(PG8_SB(0, 1), b2 + hstep, voffB);
            PG8_WAIT_V(6); PG8_BAR; PG8_MMA(1, 1, At, B1); PG8_BAR;
            PG8_LDB(B0, 1, 0); PG8_SCHED; PG8_LDA(At, 1, 0); PG8_STAGE(PG8_SA(0, 1), a2 + hstep, voffA);
            PG8_WAIT_L(8); PG8_BAR; PG8_WAIT_L(0); PG8_MMA(0, 0, At, B0); PG8_BAR; PG8_SCHED;
            PG8_LDB(B1, 1, 1); PG8_STAGE(PG8_SB(1, 0), b3, voffB);
            PG8_BAR; PG8_WAIT_L(0); PG8_MMA(0, 1, At, B1); PG8_BAR;
            PG8_LDA(At, 1, 1); PG8_STAGE(PG8_SA(1, 0), a3, voffA);
            PG8_BAR; PG8_WAIT_L(0); PG8_MMA(1, 0, At, B0); PG8_BAR; PG8_SCHED;
            PG8_STAGE(PG8_SB(1, 1), b3 + hstep, voffB);
            PG8_WAIT_V(6); PG8_BAR; PG8_MMA(1, 1, At, B1); PG8_BAR;
            }
        }
        if constexpr (ALIGN_EPI) { if (wr == 0) PG8_BAR; }
        if constexpr (!Epi::AFTER_DRAIN) { E(acc, cur, wr, wc, fr, fq); S.done(cur); }
        if (!has_next) break;
#pragma unroll
        for (int a = 0; a < 2; ++a)
#pragma unroll
            for (int b = 0; b < 2; ++b)
#pragma unroll
                for (int m = 0; m < 4; ++m)
#pragma unroll
                    for (int n = 0; n < 2; ++n) acc[a][b][m][n] = (f32x4){0.f, 0.f, 0.f, 0.f};
        cur = nxt; cA = nA; cB = nB; ++ui;
        if constexpr (GATHER) { _Pragma("unroll") for (int h_ = 0; h_ < 2; ++h_) { cvo[h_][0] = nvo[h_][0]; cvo[h_][1] = nvo[h_][1]; } }
        if constexpr (ALIGN_EPI) { if (wr == 1) PG8_BAR; }
    }
    PG8_WAIT_V(0);
    if constexpr (!ALIGN_EPI) { if (wr == 0) PG8_BAR; }
    PG8_BAR;
    if constexpr (Epi::AFTER_DRAIN) { E.fused(acc, cur, wr, wc, fr, fq, lds, wid, lane); S.done(cur); }
#undef PG8_SA
#undef PG8_SB
#undef PG8_STAGE
#undef PG8_STAGE_A
#undef PG8_ROWS
#undef PG8_LDA
#undef PG8_LDB
#undef PG8_MMA
#undef PG8_WAIT_V
#undef PG8_WAIT_L
#undef PG8_BAR
#undef PG8_SCHED
}
}

constexpr int NWAVES = 8;
constexpr int NB = 8, SEQ = 4096, DM = 1024, MTOK = NB * SEQ, NLAYER = 2;
constexpr int INC = 2984, INCP = 3072;
constexpr int C_RET = 0, C_RW = 1024, C_DSA = 1920, C_SB = 2216;
constexpr int PBW = 1792, PFW = 1280, PB_SB = 1024, PF_DSA = 896;
constexpr int NEXP = 32, MOE_ROWS = MTOK * 4 + NEXP * 256;
constexpr int ROPE_W = 88;
constexpr int NCH = 16, TCH = SEQ / NCH;
constexpr int NPL = 11, NPHASE = 1 + NLAYER * NPL;
enum { I_X = 0, I_C, I_POS, I_ADAW, I_ADAB, I_NMIX, I_NFFN, I_WIN, I_RETGN, I_MU, I_W0, I_W2, I_A0, I_A2, I_G2, I_KK, I_KA, I_RK, I_LN, I_QNORM, I_WQ, I_WQI, I_DONORM, I_SONORM, I_WOUT, I_RW, I_RB, I_MW1, I_MB1, I_MW2, I_MB2, I_NFINAL, N_IN };

constexpr size_t MiB = 1u << 20;
constexpr size_t WS_CTL = 0, CTL_ZERO_BYTES = 1 * MiB;
constexpr size_t WS_MOD = 1 * MiB, WS_ROPE = 2 * MiB, WS_WIN = 14 * MiB, WS_WOUT = 26 * MiB, WS_W1 = 30 * MiB, WS_W2 = 286 * MiB;
constexpr size_t WS_XA = 414 * MiB, WS_H = 542 * MiB, WS_MIX = 606 * MiB, WS_TOPI = 670 * MiB, WS_TOPW = 671 * MiB, WS_POS = 672 * MiB;
constexpr size_t WS_R = 674 * MiB;
constexpr size_t WS_PB = WS_R  , WS_PF = WS_R + 112 * MiB  , WS_RWA = 946 * MiB  , WS_DQ = 1314 * MiB  , WS_DKB = 1330 * MiB  , WS_DVB = 1334 * MiB  , WS_DQI = 1346 * MiB  , WS_DKI = 1394 * MiB  , WS_DW = 1398 * MiB;
constexpr size_t WS_SMALLW = 1338 * MiB  ;
constexpr int SMW_QI = 0, SMW_W2 = 512 * 128, SMW_A2 = SMW_W2 + 256 * 32, SMW_G2 = SMW_A2 + 256 * 32, SMW_LAYER = SMW_G2 + 256 * 64;
constexpr size_t WS_PT = 1362 * MiB  ;
constexpr size_t WS_CH = WS_H  , WS_SI = WS_H + 16 * MiB  , WS_SIR = WS_H + 24 * MiB  ,
                 WS_CHR = WS_H + 32 * MiB  , WS_PTR = WS_H + 40 * MiB  ;
constexpr size_t WS_SQ = WS_MIX  , WS_SK = WS_MIX + 16 * MiB, WS_SV = WS_MIX + 32 * MiB;
constexpr size_t WS_YO = 1400 * MiB  , WS_SC = 1528 * MiB  ;
constexpr size_t WS_XS = WS_R  , WS_ACT = 946 * MiB  ;
constexpr size_t WS_LIST = 2040 * MiB  , WS_END = 2044 * MiB;
constexpr int LCAP = 32768;
static_assert((size_t)MOE_ROWS * 2048 <= 272 * MiB, "moe buffers");
constexpr int CW_TMO = 0, CW_CODE = 1, CW_GCNT = 256  , CW_DSAQ = 1024  , CW_BAR = 4096, CW_BLKCNT = 16384  ;
constexpr int RING_BYTES = 131072, MISC_OFF = RING_BYTES + 320, TST_OFF = RING_BYTES + 1024  , TAB_OFF = RING_BYTES + 2048  , HIST_OFF = RING_BYTES + 5120  , BASE_OFF = RING_BYTES + 5376  , CNT_OFF = RING_BYTES + 5632  , TEXP_OFF = RING_BYTES + 6144  , LDS_BYTES = 147456;

#if defined(__HIP_DEVICE_COMPILE__)
#define GAS __attribute__((address_space(1)))
#define CAS __attribute__((address_space(4)))
#else
#define GAS
#define CAS
#endif
#define LAS __attribute__((address_space(3)))
typedef unsigned short bf16;
typedef unsigned v4u __attribute__((ext_vector_type(4)));
typedef unsigned v2u __attribute__((ext_vector_type(2)));
typedef float f32x4 __attribute__((ext_vector_type(4)));
typedef GAS unsigned gu32;
typedef short bf16x8v __attribute__((ext_vector_type(8)));
typedef short s16x4v __attribute__((ext_vector_type(4)));
typedef _Float16 f16x8 __attribute__((ext_vector_type(8)));
#define RLX_AGENT __ATOMIC_RELAXED, __HIP_MEMORY_SCOPE_AGENT
#define LDS_WAIT() asm volatile("s_waitcnt lgkmcnt(0)" ::: "memory")
#define VM_WAIT() asm volatile("s_waitcnt vmcnt(0)" ::: "memory")
__device__ __forceinline__ unsigned f2bf(float f) { unsigned u = __builtin_bit_cast(unsigned, f); return (u + 0x7fffu + ((u >> 16) & 1u)) >> 16; }
__device__ __forceinline__ unsigned pk2(float lo, float hi) { return f2bf(lo) | (f2bf(hi) << 16); }
__device__ __forceinline__ float bf_lo(unsigned w) { return __builtin_bit_cast(float, w << 16); }
__device__ __forceinline__ float bf_hi(unsigned w) { return __builtin_bit_cast(float, w & 0xffff0000u); }
__device__ __forceinline__ float wave_sum(float v) {
#pragma unroll
    for (int o = 1; o < 64; o <<= 1) v += __shfl_xor(v, o);
    return v;
}
__device__ __forceinline__ float wave_max(float v) {
#pragma unroll
    for (int o = 1; o < 64; o <<= 1) v = fmaxf(v, __shfl_xor(v, o));
    return v;
}
__device__ __forceinline__ float grp16_sum(float v) { v += __shfl_xor(v, 1); v += __shfl_xor(v, 2); v += __shfl_xor(v, 4); v += __shfl_xor(v, 8); return v; }
__device__ __forceinline__ float grp8_sum(float v) { v += __shfl_xor(v, 1); v += __shfl_xor(v, 2); v += __shfl_xor(v, 4); return v; }
__device__ __forceinline__ float sum4(f32x4 a) { return (a.x + a.y) + (a.z + a.w); }
__device__ __forceinline__ float dot4(f32x4 a, f32x4 b) { return (a.x * b.x + a.y * b.y) + (a.z * b.z + a.w * b.w); }
__device__ __forceinline__ float fexp(float x) { return __builtin_amdgcn_exp2f(x * 1.4426950408889634f); }
__device__ __forceinline__ float sigm(float x) { return __builtin_amdgcn_rcpf(1.0f + fexp(-x)); }
__device__ __forceinline__ float softplusf(float x) { return fmaxf(x, 0.0f) + 0.6931471805599453f * __builtin_amdgcn_logf(1.0f + fexp(-fabsf(x))); }
__device__ __forceinline__ float ftanh(float x) { const float e = fexp(-2.0f * fabsf(x)); const float t = (1.0f - e) * __builtin_amdgcn_rcpf(1.0f + e); return x < 0.0f ? -t : t; }
__device__ __forceinline__ f32x4 shx4(f32x4 v, int m) { f32x4 r; r.x = __shfl_xor(v.x, m); r.y = __shfl_xor(v.y, m); r.z = __shfl_xor(v.z, m); r.w = __shfl_xor(v.w, m); return r; }

#define XB_TMO      128
#define XB_XCNT(j)  (256  + 64 * (j))
#define XB_XSUB(j)  (1280 + 64 * (j))
#define XB_XGEN(j)  (2304 + 64 * (j))
#define XB_TOP      3328
#define XB_TOPGEN   3392
#define XCD_BAR_WORDS 3456
#define XB_SPIN_CAP (1u << 18)

__device__ __forceinline__ unsigned xb_ld(unsigned* p)              { return __hip_atomic_load(p, __ATOMIC_RELAXED, __HIP_MEMORY_SCOPE_AGENT); }
__device__ __forceinline__ unsigned xb_add(unsigned* p, unsigned v) { return __hip_atomic_fetch_add(p, v, __ATOMIC_RELAXED, __HIP_MEMORY_SCOPE_AGENT); }
__device__ __forceinline__ unsigned xb_xcc_id() { return (unsigned)__builtin_amdgcn_s_getreg((3 << 11) | 20) & 0xFu; }
#define XB_SPIN(cond, bar) do { unsigned _sp = 0; while (cond) { __builtin_amdgcn_s_sleep(1); \
    if ((++_sp & 255u) == 0u) { if (xb_ld(&(bar)[XB_TMO])) break; if (_sp > XB_SPIN_CAP) { atomicAdd(&(bar)[XB_TMO], 1u); break; } } } } while (0)

struct XcdBarrier {
    unsigned* bar; unsigned x;
    volatile LAS unsigned* st;
};

__device__ __forceinline__ XcdBarrier xcd_barrier_post(unsigned* bar, volatile LAS unsigned* st, int xb_tid) {
    XcdBarrier b; b.bar = bar; b.x = xb_xcc_id(); b.st = st;
    if (xb_tid == 0) (void)xb_add(&bar[XB_XCNT(b.x)], 1u);
    return b;
}
__device__ __forceinline__ void xcd_barrier_complete(unsigned* bar, unsigned x, unsigned& nloc, unsigned& nx) {
    const unsigned G = gridDim.x * gridDim.y * gridDim.z;
    unsigned sum, cnt, mine, sp = 0u;
    for (;;) {
        sum = 0u; cnt = 0u; mine = 0u;
#pragma unroll
        for (unsigned j = 0; j < 16; ++j) { const unsigned c = xb_ld(&bar[XB_XCNT(j)]); sum += c; cnt += (c > 0u) ? 1u : 0u; mine = (j == x) ? c : mine; }
        if (sum == G) break;
        __builtin_amdgcn_s_sleep(1);
        if ((++sp & 255u) == 0u) { if (xb_ld(&bar[XB_TMO])) break; if (sp > XB_SPIN_CAP) { atomicAdd(&bar[XB_TMO], 1u); break; } }
    }
    nloc = mine > 0u ? mine : 1u; nx = cnt > 0u ? cnt : 1u;
}

__device__ __forceinline__ void xcd_barrier(const XcdBarrier& b, int xb_tid) {
    asm volatile("s_waitcnt vmcnt(0)" ::: "memory");
    __syncthreads();
    if (xb_tid == 0) {
        unsigned* bar = b.bar;
        __builtin_amdgcn_s_waitcnt(0);
        unsigned nloc = b.st[0], nx = b.st[1];
        if (nloc == 0u) { xcd_barrier_complete(bar, b.x, nloc, nx); b.st[0] = nloc; b.st[1] = nx; }
        const unsigned old = xb_add(&bar[XB_XSUB(b.x)], 1u);
        const unsigned gen = old / nloc;
        if (old + 1u == (gen + 1u) * nloc) {
            __builtin_amdgcn_fence(__ATOMIC_RELEASE, "agent");
            asm volatile("s_waitcnt vmcnt(0)" ::: "memory");
            const unsigned og = xb_add(&bar[XB_TOP], 1u);
            const unsigned tg = og / nx;
            if (og + 1u == (tg + 1u) * nx) xb_add(&bar[XB_TOPGEN], 1u);
            else XB_SPIN(xb_ld(&bar[XB_TOPGEN]) == tg, bar);
            __builtin_amdgcn_fence(__ATOMIC_ACQUIRE, "agent");
            xb_add(&bar[XB_XGEN(b.x)], 1u);
            asm volatile("s_waitcnt vmcnt(0)" ::: "memory");
        } else {
            XB_SPIN(xb_ld(&bar[XB_XGEN(b.x)]) == gen, bar);
            __builtin_amdgcn_fence(__ATOMIC_ACQUIRE, "agent");
            asm volatile("s_waitcnt vmcnt(0)" ::: "memory");
        }
    }
    __syncthreads();
}
struct ArgsH { const float* in[N_IN]; float* out; unsigned char* ws; double invf[44]; int ph_lo, ph_hi, li, pad; };
struct ArgsD { const GAS float* in[N_IN]; GAS float* out; GAS unsigned char* ws; double invf[44]; int ph_lo, ph_hi, li, pad; };
static_assert(sizeof(ArgsH) == sizeof(ArgsD), "args layout");
typedef const CAS ArgsD& ARef;
__device__ __forceinline__ const CAS ArgsD* kargs() {
#if defined(__HIP_DEVICE_COMPILE__)
    const CAS ArgsD* p = (const CAS ArgsD*)__builtin_amdgcn_kernarg_segment_ptr(); asm volatile("" : "+s"(p)); return p;
#else
    return nullptr;
#endif
}
struct WI { LAS unsigned char* lds; int tid, lane, wave, vcu, G, gw, NGW, bx; };
constexpr size_t RWA_STRIDE = (33 * MiB + 68 * 1024) / 4;
constexpr size_t YO_STRIDE = 32 * MiB / 4;

__device__ __forceinline__ int wave_sum_i(int v) {
#pragma unroll
    for (int o = 1; o < 64; o <<= 1) v += __shfl_xor(v, o);
    return v;
}
__device__ __forceinline__ void sincos_d(double ang, float& s, float& c) {
    const double q = __builtin_rint(ang * 0.63661977236758134308);
    double r = __builtin_fma(-q, 1.57079632679489661923, ang); r = __builtin_fma(-q, 6.123233995736766e-17, r);
    const double r2 = r * r;
    const double sp = r * (1.0 + r2 * (-1.0 / 6 + r2 * (1.0 / 120 + r2 * (-1.0 / 5040 + r2 * (1.0 / 362880 + r2 * (-1.0 / 39916800 + r2 * (1.0 / 6227020800.0)))))));
    const double cp = 1.0 + r2 * (-0.5 + r2 * (1.0 / 24 + r2 * (-1.0 / 720 + r2 * (1.0 / 40320 + r2 * (-1.0 / 3628800 + r2 * (1.0 / 479001600 + r2 * (-1.0 / 87178291200.0)))))));
    const int qi = ((int)q) & 3;
    const double ss = (qi == 0) ? sp : (qi == 1) ? cp : (qi == 2) ? -sp : -cp;
    const double cc = (qi == 0) ? cp : (qi == 1) ? -sp : (qi == 2) ? -cp : sp;
    s = (float)ss; c = (float)cc;
}

struct TrItem { const float* src; bf16* dst; int ldw; float scale; bool ok; };
__device__ __forceinline__ void tr_decode(ARef A, int it, int lane, TrItem& d) {
    constexpr int I_IN = NLAYER * 16 * 96, I_OUT = NLAYER * 16 * 32, I_W1 = NLAYER * NEXP * 16 * 64;
    const float* W; int ldw, nvalid, k0, nsrc0; bf16* WT; size_t dstrow0; float scale = 1.0f;
    int r = it;
    if (r < I_IN) { const int l = r / 1536, rr = r % 1536, kb = rr / 96, nb = rr % 96;
        const int nd = nb * 32;
        nsrc0 = (nd < 1024) ? nd : (nd < 1792) ? C_SB + (nd - 1024) : (nd < 2688) ? C_RW + (nd - 1792) : C_DSA + (nd - 2688);
        nvalid = (nd < 1024) ? 1024 : (nd < 1792) ? INC : (nd < 2688) ? C_DSA : ((nd < INC) ? C_SB : 0);
        scale = (nd >= 256 && nd < 512) ? 0.125f : (nd >= 1024 && nd < 1280) ? 0.18033688011112042f : 1.0f;
        W = A.in[I_WIN] + (size_t)l * DM * INC; ldw = INC; k0 = kb * 64; WT = (bf16*)(A.ws + WS_WIN) + (size_t)l * INCP * DM; dstrow0 = (size_t)nd; }
    else if (r < I_IN + I_OUT) { r -= I_IN; const int l = r / 512, rr = r % 512, kb = rr / 32, nb = rr % 32;
        W = A.in[I_WOUT] + (size_t)l * DM * DM; ldw = DM; nvalid = DM; k0 = kb * 64; nsrc0 = nb * 32; WT = (bf16*)(A.ws + WS_WOUT) + (size_t)l * DM * DM; dstrow0 = (size_t)nb * 32; }
    else if (r < I_IN + I_OUT + I_W1) { r -= I_IN + I_OUT; const int le = r / 1024, rr = r % 1024, kb = rr / 64, nb = rr % 64, j = nb >> 3, bj = (nb >> 2) & 1, cc0 = (nb & 3) * 32;
        W = A.in[I_MW1] + (size_t)le * DM * 2048; ldw = 2048; nvalid = 2048; k0 = kb * 64; nsrc0 = bj * 1024 + 128 * j + cc0; WT = (bf16*)(A.ws + WS_W1) + (size_t)le * 2048 * DM; dstrow0 = (size_t)nb * 32; }
    else { r -= I_IN + I_OUT + I_W1; const int le = r / 512, rr = r % 512, kb = rr / 32, nb = rr % 32;
        W = A.in[I_MW2] + (size_t)le * DM * DM; ldw = DM; nvalid = DM; k0 = kb * 64; nsrc0 = nb * 32; WT = (bf16*)(A.ws + WS_W2) + (size_t)le * DM * DM; dstrow0 = (size_t)nb * 32; }
    const int n = nsrc0 + 4 * (lane & 7);
    d.ok = n < nvalid; d.src = W + (size_t)(k0 + (lane >> 3)) * ldw + (d.ok ? n : 0); d.ldw = ldw; d.scale = scale;
    d.dst = WT + (dstrow0 + (lane >> 3)) * 1024 + k0 + 8 * (lane & 7);
}
__device__ __forceinline__ void tr_load(const TrItem& d, f32x4 (&v)[8]) {
#pragma unroll
    for (int i = 0; i < 8; ++i) v[i] = *(const f32x4*)(d.src + (size_t)(8 * i) * d.ldw);
}
__device__ __forceinline__ void tr_store(const TrItem& d, const f32x4 (&v)[8], LAS float* scr, int lane) {
    const float sc_ = d.ok ? d.scale : 0.0f;
#pragma unroll
    for (int i = 0; i < 8; ++i) { LAS float* s = scr + (8 * i + (lane >> 3)) * 33 + 4 * (lane & 7); s[0] = v[i].x * sc_; s[1] = v[i].y * sc_; s[2] = v[i].z * sc_; s[3] = v[i].w * sc_; }
    LDS_WAIT(); asm volatile("" ::: "memory");
    const int c8 = lane & 7;
#pragma unroll
    for (int j = 0; j < 4; ++j) { const int n = (lane >> 3) + 8 * j; const LAS float* s = scr + (8 * c8) * 33 + n;
        v4u o; o.x = pk2(s[0 * 33], s[1 * 33]); o.y = pk2(s[2 * 33], s[3 * 33]); o.z = pk2(s[4 * 33], s[5 * 33]); o.w = pk2(s[6 * 33], s[7 * 33]);
        *(v4u*)(d.dst + (size_t)(8 * j) * 1024) = o; }
    LDS_WAIT(); asm volatile("" ::: "memory");
}
__device__ __forceinline__ void ph_prologue(ARef A, const WI& w) {
    LAS float* sc = (LAS float*)w.lds;
    { const float* cin = A.in[I_C]; for (int i = w.tid; i < NB * DM; i += NWAVES * 64) { const float v = cin[i]; sc[i] = v / (1.0f + expf(-v)); } }
    __syncthreads();
    float* MOD = (float*)(A.ws + WS_MOD);
    LAS float* red = (LAS float*)(w.lds + 32768);
    if (w.vcu < 192) {
        const int l = w.vcu / 96, col = (w.vcu % 96) * 64 + w.lane, kw = 128 * w.wave;
        const float* wp = A.in[I_ADAW] + (size_t)l * DM * 6144 + (size_t)kw * 6144 + col;
        float acc[8];
#pragma unroll
        for (int b = 0; b < 8; ++b) acc[b] = 0.0f;
#pragma unroll 16
        for (int k = 0; k < 128; ++k) { const float wv = wp[(size_t)k * 6144];
#pragma unroll
            for (int b = 0; b < 8; ++b) acc[b] += sc[b * DM + kw + k] * wv; }
#pragma unroll
        for (int b = 0; b < 8; ++b) red[(w.wave * 8 + b) * 64 + w.lane] = acc[b];
    }
    __syncthreads();
    if (w.vcu < 192) { const int l = w.vcu / 96, b = w.wave, col = (w.vcu % 96) * 64 + w.lane;
        float s = A.in[I_ADAB][l * 6144 + col];
#pragma unroll
        for (int q = 0; q < 8; ++q) s += red[(q * 8 + b) * 64 + w.lane];
        MOD[(size_t)(l * 8 + b) * 6144 + col] = s; }
    __syncthreads();
    LAS float* scr = (LAS float*)(w.lds + 32768 + w.wave * 8448);
    constexpr int NIT = NLAYER * 16 * 96 + NLAYER * 16 * 32;
    { TrItem d0, d1; f32x4 va[8], vb[8];
      int it = w.gw; bool h0 = it < NIT;
      if (h0) { tr_decode(A, it, w.lane, d0); tr_load(d0, va); }
      while (h0) {
          it += w.NGW; const bool h1 = it < NIT;
          if (h1) { tr_decode(A, it, w.lane, d1); tr_load(d1, vb); }
          tr_store(d0, va, scr, w.lane);
          if (!h1) break;
          it += w.NGW; h0 = it < NIT;
          if (h0) { tr_decode(A, it, w.lane, d0); tr_load(d0, va); }
          tr_store(d1, vb, scr, w.lane);
      } }
    float* RT = (float*)(A.ws + WS_ROPE); const int* pos = (const int*)A.in[I_POS];
    for (int g = w.gw * 64 + w.lane; g < MTOK * 44; g += w.NGW * 64) {
        const int tok = g / 44, f = g % 44; int co, so;
        if (f < 32) { co = f; so = 32 + f; } else if (f < 40) { co = 64 + (f - 32); so = 72 + (f - 32); } else { co = 80 + (f - 40); so = 84 + (f - 40); }
        float s, c; sincos_d((double)pos[tok] * A.invf[f], s, c);
        RT[(size_t)tok * ROPE_W + co] = c; RT[(size_t)tok * ROPE_W + so] = s;
    }
}

__device__ __forceinline__ void moe_convert_chunk(ARef A, int l, int c, int lane, LAS float* scr) {
    constexpr int I0 = NLAYER * 16 * 96 + NLAYER * 16 * 32, I_W1 = NLAYER * NEXP * 16 * 64;
    const int it0 = (c < 8192) ? I0 + l * 32768 + 4 * c : I0 + I_W1 + l * 16384 + 4 * (c - 8192);
    TrItem d0, d1; f32x4 va[8], vb[8];
    tr_decode(A, it0, lane, d0); tr_load(d0, va);
    tr_decode(A, it0 + 1, lane, d1); tr_load(d1, vb);
    tr_store(d0, va, scr, lane);
    tr_decode(A, it0 + 2, lane, d0); tr_load(d0, va);
    tr_store(d1, vb, scr, lane);
    tr_decode(A, it0 + 3, lane, d1); tr_load(d1, vb);
    tr_store(d0, va, scr, lane);
    tr_store(d1, vb, scr, lane);
}

__device__ __forceinline__ void emit_h_row(const f32x4 (&v)[4], float rstd, const float* g, const float* sc, const float* sh, bf16* hrow, int lane) {
#pragma unroll
    for (int j = 0; j < 4; ++j) { const int k = 4 * (lane + 64 * j);
        const f32x4 gv = *(const f32x4*)(g + k), scv = *(const f32x4*)(sc + k), shv = *(const f32x4*)(sh + k);
        const f32x4 h = v[j] * rstd * gv * (1.0f + scv) + shv;
        v2u o; o.x = pk2(h.x, h.y); o.y = pk2(h.z, h.w); *(v2u*)(hrow + k) = o; }
}
__device__ __forceinline__ void small_weights_to_f16(ARef A, const WI& w) {
    { _Float16* SW = (_Float16*)(A.ws + WS_SMALLW);
      const int g0 = w.gw * 64 + w.lane, gs = w.NGW * 64;
      for (int l = 0; l < NLAYER; ++l) { _Float16* S = SW + (size_t)l * SMW_LAYER;
          const float* wq = A.in[I_WQ] + (size_t)l * 128 * 256; const float* wqi = A.in[I_WQI] + (size_t)l * 128 * 256;
          for (int e = g0; e < 256 * 128; e += gs) { const int n = e >> 7, k = e & 127; S[SMW_QI + e] = (_Float16)wq[k * 256 + n]; S[SMW_QI + 256 * 128 + e] = (_Float16)wqi[k * 256 + n]; }
          const float* w2 = A.in[I_W2] + (size_t)l * 32 * 256; const float* a2 = A.in[I_A2] + (size_t)l * 32 * 256; const float* g2 = A.in[I_G2] + (size_t)l * 64 * 256;
          for (int e = g0; e < 256 * 32; e += gs) { const int n = e >> 5, k = e & 31; S[SMW_W2 + e] = (_Float16)w2[k * 256 + n]; S[SMW_A2 + e] = (_Float16)a2[k * 256 + n]; }
          for (int e = g0; e < 256 * 64; e += gs) { const int n = e >> 6, k = e & 63; S[SMW_G2 + e] = (_Float16)g2[k * 256 + n]; } } }
}
__device__ __forceinline__ void ph_norm1(ARef A, const WI& w) {
    const float* MOD = (const float*)(A.ws + WS_MOD); bf16* H = (bf16*)(A.ws + WS_H);
    for (int m = w.gw; m < MTOK; m += w.NGW) {
        const float* xr = A.in[I_X] + (size_t)m * DM; f32x4 v[4]; float ss = 0.0f;
#pragma unroll
        for (int j = 0; j < 4; ++j) { v[j] = *(const f32x4*)(xr + 4 * (w.lane + 64 * j)); ss += dot4(v[j], v[j]); }
        ss = wave_sum(ss); const float rstd = 1.0f / sqrtf(ss * (1.0f / DM) + 1e-5f);
        const float* mb = MOD + (size_t)(m >> 12) * 6144;
        emit_h_row(v, rstd, A.in[I_NMIX], mb + 1024, mb, H + (size_t)m * DM, w.lane);
    }
}

typedef _Float16 h4v __attribute__((ext_vector_type(4)));
__device__ __forceinline__ f16x8 pack_f16x8(f32x4 a, f32x4 b) { f16x8 r; r[0] = (_Float16)a.x; r[1] = (_Float16)a.y; r[2] = (_Float16)a.z; r[3] = (_Float16)a.w; r[4] = (_Float16)b.x; r[5] = (_Float16)b.y; r[6] = (_Float16)b.z; r[7] = (_Float16)b.w; return r; }
#define RW_STB4(k_, val_) do { v2u w_; w_.x = pk2((val_).x, (val_).y); w_.y = pk2((val_).z, (val_).w); *(v2u*)((bf16*)(RWA + (k_) * RWA_STRIDE) + o) = w_; } while (0)
#ifndef RWKV_RKV_BF16
#define RWKV_RKV_BF16 1
#endif
#if RWKV_RKV_BF16
#define RW_ST_RKV(k_, val_) RW_STB4(k_, val_)
#else
#define RW_ST_RKV(k_, val_) (*(f32x4*)(RWA + (k_) * RWA_STRIDE + o) = (val_))
#endif
__device__ __forceinline__ f32x4 ldb4(const bf16* q) { const v2u x = *(const v2u*)q; return (f32x4){bf_lo(x.x), bf_hi(x.x), bf_lo(x.y), bf_hi(x.y)}; }
__device__ __forceinline__ void prep16_body(const bf16* __restrict__ P, float* __restrict__ RWA, const _Float16* __restrict__ SW, const float* __restrict__ RT, bf16* __restrict__ DQ, _Float16* __restrict__ DQI,
                                            bf16* __restrict__ DKB, bf16* __restrict__ DVB, _Float16* __restrict__ DKI, float* __restrict__ DW, const float* __restrict__ mu, const float* __restrict__ qn,
                                            const float* __restrict__ w0p, const float* __restrict__ a0p, const float* __restrict__ kkp, const float* __restrict__ kap, const float* __restrict__ rkp, int m0, int lane_in, int part = 7) {
    int lane = lane_in; asm volatile("" : "+v"(lane));
    const int tk = lane & 15, q4 = lane >> 4, m = m0 + tk, t = m & (SEQ - 1);
    const bf16* pr = P + (size_t)m * PFW; const bf16* pp = pr - PFW; const bf16* pd = P + (size_t)m * PFW + PF_DSA;
    RT += (size_t)m * ROPE_W; const f32x4 zero4 = {0.f, 0.f, 0.f, 0.f};
    f16x8 bx[4], bc[4];
    { float ss = 0.0f; f32x4 c[4][2];
#pragma unroll
      for (int ks = 0; ks < 4; ++ks) { const int f0 = 32 * ks + 8 * q4;
          f32x4 x[2];
#pragma unroll
          for (int u = 0; u < 2; ++u) { const f32x4 z = ldb4(pr + 768 + f0 + 4 * u); const f32x4 p = t ? ldb4(pp + 768 + f0 + 4 * u) : zero4; x[u] = z + (p - z) * *(const f32x4*)(mu + 768 + f0 + 4 * u);
#pragma unroll
              for (int i = 0; i < 4; ++i) x[u][i] = (ks == 0) ? ftanh(x[u][i]) : (ks == 1) ? x[u][i] : sigm(x[u][i]); }
          bx[ks] = pack_f16x8(x[0], x[1]);
          c[ks][0] = ldb4(pd + f0); c[ks][1] = ldb4(pd + f0 + 4); ss += dot4(c[ks][0], c[ks][0]) + dot4(c[ks][1], c[ks][1]); }
      ss += __shfl_xor(ss, 16); ss += __shfl_xor(ss, 32);
      const float rstd = 1.0f / sqrtf(ss * (1.0f / 128.0f) + 1e-5f);
#pragma unroll
      for (int ks = 0; ks < 4; ++ks) { const int f0 = 32 * ks + 8 * q4; bc[ks] = pack_f16x8(c[ks][0] * rstd * *(const f32x4*)(qn + f0), c[ks][1] * rstd * *(const f32x4*)(qn + f0 + 4)); } }
    const _Float16* wrow = SW + (size_t)tk * 0;
    (void)wrow;
    const int arow = lane & 15;
    if (part & 1)
#pragma unroll 2
    for (int hd = 0; hd < 4; ++hd) {
        f32x4 fk[4], av[4]; float ssk = 0.0f;
#pragma unroll
        for (int j = 0; j < 4; ++j) { const int nb = 4 * hd + j, ch = 16 * nb + 4 * q4; const size_t o = (size_t)m * 256 + ch;
            const f16x8 aw = *(const f16x8*)(SW + SMW_W2 + (16 * nb + arow) * 32 + 8 * q4), aa = *(const f16x8*)(SW + SMW_A2 + (16 * nb + arow) * 32 + 8 * q4);
            const f16x8 ag0 = *(const f16x8*)(SW + SMW_G2 + (16 * nb + arow) * 64 + 8 * q4), ag1 = *(const f16x8*)(SW + SMW_G2 + (16 * nb + arow) * 64 + 32 + 8 * q4);
            const f32x4 cw = __builtin_amdgcn_mfma_f32_16x16x32_f16(aw, bx[0], *(const f32x4*)(w0p + ch), 0, 0, 0);
            const f32x4 ca = __builtin_amdgcn_mfma_f32_16x16x32_f16(aa, bx[1], *(const f32x4*)(a0p + ch), 0, 0, 0);
            f32x4 cg = __builtin_amdgcn_mfma_f32_16x16x32_f16(ag0, bx[2], zero4, 0, 0, 0); cg = __builtin_amdgcn_mfma_f32_16x16x32_f16(ag1, bx[3], cg, 0, 0, 0);
            f32x4 dec;
#pragma unroll
            for (int i = 0; i < 4; ++i) { dec[i] = fexp(-fexp(-softplusf(-cw[i]) - 0.5f)); av[j][i] = sigm(ca[i]); }
            *(f32x4*)(RWA + 1 * RWA_STRIDE + o) = dec; RW_STB4(6, cg);
            { const f32x4 z = ldb4(pr + 256 + ch); const f32x4 p = t ? ldb4(pp + 256 + ch) : zero4; fk[j] = z + (p - z) * *(const f32x4*)(mu + 256 + ch); }
            const f32x4 kk = fk[j] * *(const f32x4*)(kkp + ch); ssk += dot4(kk, kk); }
        ssk += __shfl_xor(ssk, 16); ssk += __shfl_xor(ssk, 32);
        const float inrm = 1.0f / fmaxf(sqrtf(ssk), 1e-12f);
        f32x4 fr[4], km[4]; float bs = 0.0f;
#pragma unroll
        for (int j = 0; j < 4; ++j) { const int ch = 16 * (4 * hd + j) + 4 * q4;
            { const f32x4 z = ldb4(pr + ch); const f32x4 p = t ? ldb4(pp + ch) : zero4; fr[j] = z + (p - z) * *(const f32x4*)(mu + ch); }
            km[j] = fk[j] * (1.0f + (av[j] - 1.0f) * *(const f32x4*)(kap + ch)); bs += dot4(fr[j] * km[j], *(const f32x4*)(rkp + ch)); }
        bs += __shfl_xor(bs, 16); bs += __shfl_xor(bs, 32);
#pragma unroll
        for (int j = 0; j < 4; ++j) { const int ch = 16 * (4 * hd + j) + 4 * q4; const size_t o = (size_t)m * 256 + ch;
            f32x4 fv; { const f32x4 z = ldb4(pr + 512 + ch); const f32x4 p = t ? ldb4(pp + 512 + ch) : zero4; fv = z + (p - z) * *(const f32x4*)(mu + 512 + ch); }
            const f32x4 kk = fk[j] * *(const f32x4*)(kkp + ch) * inrm;
            RW_ST_RKV(0, fr[j]); RW_ST_RKV(2, km[j]); RW_ST_RKV(3, fv);
            *(f32x4*)(RWA + 4 * RWA_STRIDE + o) = -kk; *(f32x4*)(RWA + 5 * RWA_STRIDE + o) = kk * av[j]; { const f32x4 bo_ = bs * fv; RW_STB4(7, bo_); } }
    }
    if (part & 2)
#pragma unroll 4
    for (int nb = 0; nb < 32; ++nb) {
        f32x4 cq = zero4;
#pragma unroll
        for (int ks = 0; ks < 4; ++ks) { const f16x8 aq = *(const f16x8*)(SW + SMW_QI + (16 * nb + arow) * 128 + 32 * ks + 8 * q4); cq = __builtin_amdgcn_mfma_f32_16x16x32_f16(aq, bc[ks], cq, 0, 0, 0); }
        const int ch = 16 * (nb & 15) + 4 * q4;
        if (nb < 16) {
            if ((nb & 3) == 0) { const f32x4 ot = shx4(cq, 32); const int fi = 4 * (q4 & 1); const f32x4 cs4 = *(const f32x4*)(RT + 64 + fi), sn = *(const f32x4*)(RT + 72 + fi); cq = (q4 < 2) ? cq * cs4 - ot * sn : ot * sn + cq * cs4; }
            const f32x4 qs = cq * 0.18033688011112042f; v2u o; o.x = pk2(qs.x, qs.y); o.y = pk2(qs.z, qs.w); *(v2u*)(DQ + (size_t)m * 256 + ch) = o;
        } else {
            if ((nb & 1) == 0) { const f32x4 ot = shx4(cq, 16); const f32x4 cs4 = *(const f32x4*)(RT + 80), sn = *(const f32x4*)(RT + 84); if (q4 < 2) cq = (q4 < 1) ? cq * cs4 - ot * sn : ot * sn + cq * cs4; }
            h4v hq; hq.x = (_Float16)cq.x; hq.y = (_Float16)cq.y; hq.z = (_Float16)cq.z; hq.w = (_Float16)cq.w; *(h4v*)(DQI + (size_t)m * 256 + ch) = hq;
        }
    }
#pragma unroll
    for (int j = 0; j < 4; ++j) { const int d = 16 * j + 4 * q4; f32x4 kx = ldb4(pd + 128 + d);
        if (j == 0) { const f32x4 ot = shx4(kx, 32); const int fi = 4 * (q4 & 1); const f32x4 cs4 = *(const f32x4*)(RT + 64 + fi), sn = *(const f32x4*)(RT + 72 + fi); kx = (q4 < 2) ? kx * cs4 - ot * sn : ot * sn + kx * cs4; }
        v2u o; o.x = pk2(kx.x, kx.y); o.y = pk2(kx.z, kx.w); *(v2u*)(DKB + (size_t)m * 64 + d) = o;
        const f32x4 vx = ldb4(pd + 192 + d); v2u ov; ov.x = pk2(vx.x, vx.y); ov.y = pk2(vx.z, vx.w); *(v2u*)(DVB + (size_t)m * 64 + d) = ov; }
#pragma unroll
    for (int j = 0; j < 2; ++j) { const int d = 16 * j + 4 * q4; f32x4 ki = ldb4(pd + 256 + d);
        if (j == 0) { const f32x4 ot = shx4(ki, 16); const f32x4 cs4 = *(const f32x4*)(RT + 80), sn = *(const f32x4*)(RT + 84); if (q4 < 2) ki = (q4 < 1) ? ki * cs4 - ot * sn : ot * sn + ki * cs4; }
        h4v hk; hk.x = (_Float16)ki.x; hk.y = (_Float16)ki.y; hk.z = (_Float16)ki.z; hk.w = (_Float16)ki.w; *(h4v*)(DKI + (size_t)m * 32 + d) = hk; }
    if (q4 < 2) *(f32x4*)(DW + (size_t)m * 8 + 4 * q4) = ldb4(pd + 288 + 4 * q4) * 0.0625f;
}

__device__ __forceinline__ void prep16(ARef A, int l, int m0, int lane_in, int part = 7) {
    prep16_body((const bf16*)(A.ws + WS_PF), (float*)(A.ws + WS_RWA), (const _Float16*)(A.ws + WS_SMALLW) + (size_t)l * SMW_LAYER, (const float*)(A.ws + WS_ROPE), (bf16*)(A.ws + WS_DQ), (_Float16*)(A.ws + WS_DQI),
                (bf16*)(A.ws + WS_DKB), (bf16*)(A.ws + WS_DVB), (_Float16*)(A.ws + WS_DKI), (float*)(A.ws + WS_DW), A.in[I_MU] + l * 896, A.in[I_QNORM] + l * 128,
                A.in[I_W0] + l * 256, A.in[I_A0] + l * 256, A.in[I_KK] + l * 256, A.in[I_KA] + l * 256, A.in[I_RK] + l * 256, m0, lane_in, part);
}
__device__ __forceinline__ float quad_sum(float v) {
    v += __builtin_bit_cast(float, __builtin_amdgcn_mov_dpp(__builtin_bit_cast(int, v), 0xB1, 0xF, 0xF, true));
    v += __builtin_bit_cast(float, __builtin_amdgcn_mov_dpp(__builtin_bit_cast(int, v), 0x4E, 0xF, 0xF, true));
    return v;
}
__device__ __forceinline__ float oct_sum(float v) {
    v += __builtin_bit_cast(float, __builtin_amdgcn_mov_dpp(__builtin_bit_cast(int, v), 0xB1, 0xF, 0xF, true));
    v += __builtin_bit_cast(float, __builtin_amdgcn_mov_dpp(__builtin_bit_cast(int, v), 0x4E, 0xF, 0xF, true));
    v += __builtin_bit_cast(float, __builtin_amdgcn_mov_dpp(__builtin_bit_cast(int, v), 0x141, 0xF, 0xF, true));
    return v;
}
typedef float f32x2 __attribute__((ext_vector_type(2)));
#define LO2(v_) __builtin_shufflevector(v_, v_, 0, 1)
#define HI2(v_) __builtin_shufflevector(v_, v_, 2, 3)
#define RW_ROW(i_) (((i_) < 2) ? (16 * ws + rg + 8 * (i_)) : (64 + 16 * ws + rg + 8 * ((i_) - 2)))
#define RW_LOAD(op, s_) do { const int lo_ = (s_) * 64 + kq * 8; \
    op[0] = *(const LAS f32x4*)(sn + lo_); op[1] = *(const LAS f32x4*)(sn + lo_ + 4); op[2] = *(const LAS f32x4*)(sw + lo_); op[3] = *(const LAS f32x4*)(sw + lo_ + 4); \
    op[4] = *(const LAS f32x4*)(sb + lo_); op[5] = *(const LAS f32x4*)(sb + lo_ + 4); op[6] = *(const LAS f32x4*)(sk + lo_); op[7] = *(const LAS f32x4*)(sk + lo_ + 4); \
    op[8] = *(const LAS f32x4*)(sr + lo_); op[9] = *(const LAS f32x4*)(sr + lo_ + 4); \
    vin[0] = sv[(s_) * 64 + 16 * ws + rg]; vin[1] = sv[(s_) * 64 + 16 * ws + rg + 8]; } while (0)
#define RW_DOT(i_, oa, ob) ({ f32x2 d_ = S[i_][0] * LO2(oa); d_ = S[i_][1] * HI2(oa) + d_; d_ = S[i_][2] * LO2(ob) + d_; d_ = S[i_][3] * HI2(ob) + d_; d_.x + d_.y; })
#define RW_STEP(op, vv, s_) do { float sa_[4], y_[4]; \
    _Pragma("unroll") for (int i_ = 0; i_ < 4; ++i_) sa_[i_] = RW_DOT(i_, op[0], op[1]); \
    _Pragma("unroll") for (int i_ = 0; i_ < 4; ++i_) sa_[i_] += __builtin_bit_cast(float, __builtin_amdgcn_mov_dpp(__builtin_bit_cast(int, sa_[i_]), 0xB1, 0xF, 0xF, true)); \
    _Pragma("unroll") for (int i_ = 0; i_ < 4; ++i_) sa_[i_] += __builtin_bit_cast(float, __builtin_amdgcn_mov_dpp(__builtin_bit_cast(int, sa_[i_]), 0x4E, 0xF, 0xF, true)); \
    _Pragma("unroll") for (int i_ = 0; i_ < 4; ++i_) sa_[i_] += __builtin_bit_cast(float, __builtin_amdgcn_mov_dpp(__builtin_bit_cast(int, sa_[i_]), 0x141, 0xF, 0xF, true)); \
    _Pragma("unroll") for (int i_ = 0; i_ < 2; ++i_) { const f32x2 a2_ = {sa_[i_], sa_[i_]}, v2_ = {vv[i_], vv[i_]}; \
        S[i_][0] = S[i_][0] * LO2(op[2]) + (a2_ * LO2(op[4]) + v2_ * LO2(op[6])); S[i_][1] = S[i_][1] * HI2(op[2]) + (a2_ * HI2(op[4]) + v2_ * HI2(op[6])); \
        S[i_][2] = S[i_][2] * LO2(op[3]) + (a2_ * LO2(op[5]) + v2_ * LO2(op[7])); S[i_][3] = S[i_][3] * HI2(op[3]) + (a2_ * HI2(op[5]) + v2_ * HI2(op[7])); } \
    _Pragma("unroll") for (int i_ = 2; i_ < 4; ++i_) { const f32x2 a2_ = {sa_[i_], sa_[i_]}; \
        S[i_][0] = S[i_][0] * LO2(op[2]) + a2_ * LO2(op[4]); S[i_][1] = S[i_][1] * HI2(op[2]) + a2_ * HI2(op[4]); S[i_][2] = S[i_][2] * LO2(op[3]) + a2_ * LO2(op[5]); S[i_][3] = S[i_][3] * HI2(op[3]) + a2_ * HI2(op[5]); } \
    _Pragma("unroll") for (int i_ = 0; i_ < 4; ++i_) y_[i_] = RW_DOT(i_, op[8], op[9]); \
    _Pragma("unroll") for (int i_ = 0; i_ < 4; ++i_) y_[i_] += __builtin_bit_cast(float, __builtin_amdgcn_mov_dpp(__builtin_bit_cast(int, y_[i_]), 0xB1, 0xF, 0xF, true)); \
    _Pragma("unroll") for (int i_ = 0; i_ < 4; ++i_) y_[i_] += __builtin_bit_cast(float, __builtin_amdgcn_mov_dpp(__builtin_bit_cast(int, y_[i_]), 0x4E, 0xF, 0xF, true)); \
    _Pragma("unroll") for (int i_ = 0; i_ < 4; ++i_) y_[i_] += __builtin_bit_cast(float, __builtin_amdgcn_mov_dpp(__builtin_bit_cast(int, y_[i_]), 0x141, 0xF, 0xF, true)); \
    if (kq == 0) { _Pragma("unroll") for (int i_ = 0; i_ < 4; ++i_) so[(s_) * 128 + RW_ROW(i_)] = y_[i_]; } } while (0)
__device__ __forceinline__ void scan_rwkv_task2(ARef A, const WI& w, int task0) {
    const int slot = w.wave >> 2, ws = w.wave & 3, lt = w.tid & 255, task = task0 + slot;
    const int bh = task >> 4, c = task & 15, b = bh >> 2, h = bh & 3;
    LAS float* sw = (LAS float*)w.lds + slot * 16384; LAS float* sn = sw + 2048; LAS float* sb = sn + 2048; LAS float* sk = sb + 2048; LAS float* sr = sk + 2048; LAS float* sv = sr + 2048; LAS float* so = sv + 2048;
    const float* RWA = (const float*)(A.ws + WS_RWA);
    const int rg = w.lane >> 3, kq = w.lane & 7;
    f32x2 S[4][4];
#pragma unroll
    for (int i = 0; i < 4; ++i)
#pragma unroll
        for (int j = 0; j < 4; ++j) { const int r = RW_ROW(i); S[i][j].x = (r >= 64 && 8 * kq + 2 * j == r - 64) ? 1.0f : 0.0f; S[i][j].y = (r >= 64 && 8 * kq + 2 * j + 1 == r - 64) ? 1.0f : 0.0f; }
    const size_t tok0 = (size_t)b * SEQ + (size_t)c * TCH;
    const int st = lt >> 3, sd = (lt & 7) * 8;
#if RWKV_RKV_BF16
    f32x4 a[3][2]; v4u ab[3];
#define RW_LD_RKV(i_, k_) ab[i_] = *(const v4u*)((const bf16*)(RWA + (k_) * RWA_STRIDE) + o_)
#define RW_GET_RKV(i_, q_) RW_UNPK(ab[i_], q_)
#else
    f32x4 a[3][2]; f32x4 af[3][2];
#define RW_LD_RKV(i_, k_) do { af[i_][0] = *(const f32x4*)(RWA + (k_) * RWA_STRIDE + o_); af[i_][1] = *(const f32x4*)(RWA + (k_) * RWA_STRIDE + o_ + 4); } while (0)
#define RW_GET_RKV(i_, q_) af[i_][q_]
#endif
#define RW_GLOAD(sub_) do { const size_t o_ = (tok0 + (sub_) * 32 + st) * 256 + h * 64 + sd; \
        _Pragma("unroll") for (int q = 0; q < 2; ++q) { a[0][q] = *(const f32x4*)(RWA + 1 * RWA_STRIDE + o_ + 4 * q); a[1][q] = *(const f32x4*)(RWA + 4 * RWA_STRIDE + o_ + 4 * q); a[2][q] = *(const f32x4*)(RWA + 5 * RWA_STRIDE + o_ + 4 * q); } \
        RW_LD_RKV(0, 2); RW_LD_RKV(1, 0); RW_LD_RKV(2, 3); } while (0)
#define RW_UNPK(x_, q_) ((q_) == 0 ? (f32x4){bf_lo((x_).x), bf_hi((x_).x), bf_lo((x_).y), bf_hi((x_).y)} : (f32x4){bf_lo((x_).z), bf_hi((x_).z), bf_lo((x_).w), bf_hi((x_).w)})
    RW_GLOAD(0);
    for (int sub = 0; sub < TCH / 32; ++sub) {
        __syncthreads();
        { const int lo = st * 64 + sd;
#pragma unroll
          for (int q = 0; q < 2; ++q) { *(LAS f32x4*)(sw + lo + 4 * q) = a[0][q]; *(LAS f32x4*)(sn + lo + 4 * q) = a[1][q]; *(LAS f32x4*)(sb + lo + 4 * q) = a[2][q]; *(LAS f32x4*)(sk + lo + 4 * q) = RW_GET_RKV(0, q); *(LAS f32x4*)(sr + lo + 4 * q) = RW_GET_RKV(1, q); *(LAS f32x4*)(sv + lo + 4 * q) = RW_GET_RKV(2, q); } }
        __syncthreads();
        if (sub + 1 < TCH / 32) RW_GLOAD(sub + 1);
        { f32x4 opA[10], opB[10]; float vin[2], vA[2], vB[2];
          RW_LOAD(opA, 0);
          vA[0] = vin[0]; vA[1] = vin[1];
#pragma unroll 1
          for (int s = 0; s < 32; s += 2) {
              RW_LOAD(opB, s + 1);
              vB[0] = vin[0]; vB[1] = vin[1];
              RW_STEP(opA, vA, s);
              if (s + 2 < 32) { RW_LOAD(opA, s + 2); vA[0] = vin[0]; vA[1] = vin[1]; }
              RW_STEP(opB, vB, s + 1);
          } }
        __syncthreads();
        { const int fs = lt >> 3, c16 = (lt & 7) * 16;
          float* dst = (c16 < 64) ? ((float*)(A.ws + WS_YO) + YO_STRIDE) : ((float*)(A.ws + WS_PT) - 64);
          float* dp = dst + (tok0 + sub * 32 + fs) * 256 + h * 64 + c16;
#pragma unroll
          for (int q = 0; q < 4; ++q) *(f32x4*)(dp + 4 * q) = *(const LAS f32x4*)(so + fs * 128 + c16 + 4 * q); }
    }
    { float* ch = (float*)(A.ws + WS_CH) + ((size_t)(bh * NCH + c) * 128) * 64 + 8 * kq;
#pragma unroll
      for (int i = 0; i < 4; ++i) { float* cr = ch + (size_t)RW_ROW(i) * 64; *(f32x4*)cr = (f32x4){S[i][0].x, S[i][0].y, S[i][1].x, S[i][1].y}; *(f32x4*)(cr + 4) = (f32x4){S[i][2].x, S[i][2].y, S[i][3].x, S[i][3].y}; } }
    __syncthreads();
}
#undef RW_LOAD
#undef RW_STEP
#undef RW_GLOAD
#undef RW_UNPK
#undef RW_LD_RKV
#undef RW_GET_RKV
#undef RW_DOT
#undef RW_ROW
__device__ __forceinline__ void scan_ret_task(ARef A, const WI& w, int task) {
    const int bh = task >> 3, cp = task & 7, b = bh >> 2, h = bh & 3, un = w.tid >> 8, lt = w.tid & 255, c = 2 * cp + un;
    const float lg2g = log2f(1.0f - exp2f(-5.0f - (float)h)), gamma = exp2f(lg2g);
    LAS float* sk = (LAS float*)w.lds + un * 8192; LAS float* sq = sk + 2048; LAS float* sv = sq + 2048; LAS float* so = sv + 2048;
    const bf16* PB = (const bf16*)(A.ws + WS_PB); const float* RT = (const float*)(A.ws + WS_ROPE);
    const int row = lt >> 2, kq = lt & 3;
    f32x2 S[8];
#pragma unroll
    for (int j = 0; j < 8; ++j) S[j] = (f32x2){0.0f, 0.0f};
    const f32x2 gam2 = {gamma, gamma};
    const size_t tok0 = (size_t)b * SEQ + (size_t)c * TCH;
    const int st = lt >> 3, sd = (lt & 7) * 8;
    const int fi = sd & 31, dp = sd ^ 32;
    f32x4 gq[2], gqo[2], gk[2], gko[2], gv[2], gcs[2], gsn[2];
#define BF8_TO_F32(dst, x_) do { dst[0] = (f32x4){bf_lo(x_.x), bf_hi(x_.x), bf_lo(x_.y), bf_hi(x_.y)}; dst[1] = (f32x4){bf_lo(x_.z), bf_hi(x_.z), bf_lo(x_.w), bf_hi(x_.w)}; } while (0)
#define RT_GLOAD(sub_) do { const size_t m_ = tok0 + (sub_) * 32 + st; const bf16* pr_ = PB + m_ * PBW + h * 64; const float* rt_ = RT + m_ * ROPE_W; \
        _Pragma("unroll") for (int u = 0; u < 2; ++u) { gcs[u] = *(const f32x4*)(rt_ + fi + 4 * u); gsn[u] = *(const f32x4*)(rt_ + 32 + fi + 4 * u); } \
        { const v4u x0 = *(const v4u*)(pr_ + sd), x1 = *(const v4u*)(pr_ + dp), x2 = *(const v4u*)(pr_ + 256 + sd), x3 = *(const v4u*)(pr_ + 256 + dp), x4 = *(const v4u*)(pr_ + 512 + sd); \
          BF8_TO_F32(gq, x0); BF8_TO_F32(gqo, x1); BF8_TO_F32(gk, x2); BF8_TO_F32(gko, x3); BF8_TO_F32(gv, x4); } } while (0)
    RT_GLOAD(0);
    for (int sub = 0; sub < TCH / 32; ++sub) {
        const size_t m = tok0 + sub * 32 + st;
        f32x4 qn[2], kn[2], vn[2];
#pragma unroll
        for (int u = 0; u < 2; ++u) { qn[u] = (sd < 32) ? gq[u] * gcs[u] - gqo[u] * gsn[u] : gqo[u] * gsn[u] + gq[u] * gcs[u]; kn[u] = (sd < 32) ? gk[u] * gcs[u] - gko[u] * gsn[u] : gko[u] * gsn[u] + gk[u] * gcs[u]; vn[u] = gv[u]; }
        { const float gt = exp2f(lg2g * (float)(sub * 32 + st + 1)); const f32x4 p0 = qn[0] * gt, p1 = qn[1] * gt;
          v4u pw; pw.x = pk2(p0.x, p0.y); pw.y = pk2(p0.z, p0.w); pw.z = pk2(p1.x, p1.y); pw.w = pk2(p1.z, p1.w); *(v4u*)((bf16*)(A.ws + WS_PTR) + m * 256 + h * 64 + sd) = pw; }
        __syncthreads();
        { const int lo = st * 64 + sd; *(LAS f32x4*)(sq + lo) = qn[0]; *(LAS f32x4*)(sq + lo + 4) = qn[1]; *(LAS f32x4*)(sk + lo) = kn[0]; *(LAS f32x4*)(sk + lo + 4) = kn[1]; *(LAS f32x4*)(sv + lo) = vn[0]; *(LAS f32x4*)(sv + lo + 4) = vn[1]; }
        __syncthreads();
        if (sub + 1 < TCH / 32) RT_GLOAD(sub + 1);
        for (int s = 0; s < 32; ++s) {
            const int lo = s * 64 + kq * 16; const float vv = sv[s * 64 + row]; const f32x2 v2 = {vv, vv}; f32x2 y2 = {0.0f, 0.0f};
#pragma unroll
            for (int j4 = 0; j4 < 4; ++j4) { const f32x4 kv = *(const LAS f32x4*)(sk + lo + 4 * j4), rv = *(const LAS f32x4*)(sq + lo + 4 * j4);
                S[2 * j4] = S[2 * j4] * gam2 + v2 * LO2(kv); S[2 * j4 + 1] = S[2 * j4 + 1] * gam2 + v2 * HI2(kv);
                y2 = S[2 * j4] * LO2(rv) + y2; y2 = S[2 * j4 + 1] * HI2(rv) + y2; }
            float y = quad_sum(y2.x + y2.y);
            if (kq == 0) so[s * 64 + row] = y;
        }
        __syncthreads();
        { const int fs = lt >> 3, c8 = (lt & 7) * 8; float* dp2 = (float*)(A.ws + WS_YO) + (tok0 + sub * 32 + fs) * 256 + h * 64 + c8;
          *(f32x4*)dp2 = *(const LAS f32x4*)(so + fs * 64 + c8); *(f32x4*)(dp2 + 4) = *(const LAS f32x4*)(so + fs * 64 + c8 + 4); }
    }
    { float* ch = (float*)(A.ws + WS_CHR) + ((size_t)(bh * NCH + c) * 64 + row) * 64 + 16 * kq;
#pragma unroll
      for (int j4 = 0; j4 < 4; ++j4) *(f32x4*)(ch + 4 * j4) = (f32x4){S[2 * j4].x, S[2 * j4].y, S[2 * j4 + 1].x, S[2 * j4 + 1].y}; }
    __syncthreads();
}
#undef RT_GLOAD
#undef BF8_TO_F32
__device__ __forceinline__ void prefix_chain(ARef A, const WI& w, int bh) {
    LAS float* s0 = (LAS float*)w.lds;
    const int v = w.tid >> 3, k8 = (w.tid & 7) * 8;
    const float* CH = (const float*)(A.ws + WS_CH) + (size_t)bh * NCH * 128 * 64; float* SI = (float*)(A.ws + WS_SI) + (size_t)bh * NCH * 64 * 64;
    f32x4 c0 = {0.f, 0.f, 0.f, 0.f}, c1 = {0.f, 0.f, 0.f, 0.f};
    for (int c = 0; c < NCH; ++c) {
        *(f32x4*)(SI + ((size_t)c * 64 + v) * 64 + k8) = c0; *(f32x4*)(SI + ((size_t)c * 64 + v) * 64 + k8 + 4) = c1;
        if (c == NCH - 1) break;
        __syncthreads();
        *(LAS f32x4*)(s0 + v * 68 + k8) = c0; *(LAS f32x4*)(s0 + v * 68 + k8 + 4) = c1;
        __syncthreads();
        const float* ch = CH + (size_t)c * 128 * 64;
        f32x4 n0 = *(const f32x4*)(ch + (size_t)v * 64 + k8), n1 = *(const f32x4*)(ch + (size_t)v * 64 + k8 + 4);
#pragma unroll 8
        for (int kp = 0; kp < 64; ++kp) { const float s = s0[v * 68 + kp]; const float* pr = ch + (size_t)(64 + kp) * 64 + k8; n0 += s * *(const f32x4*)pr; n1 += s * *(const f32x4*)(pr + 4); }
        c0 = n0; c1 = n1;
    }
    const int h = bh & 3; const float gT = exp2f((float)TCH * log2f(1.0f - exp2f(-5.0f - (float)h)));
    const float* CHR = (const float*)(A.ws + WS_CHR) + (size_t)bh * NCH * 64 * 64; float* SIR = (float*)(A.ws + WS_SIR) + (size_t)bh * NCH * 64 * 64;
    c0 = (f32x4){0.f, 0.f, 0.f, 0.f}; c1 = c0;
    for (int c = 0; c < NCH; ++c) {
        *(f32x4*)(SIR + ((size_t)c * 64 + v) * 64 + k8) = c0; *(f32x4*)(SIR + ((size_t)c * 64 + v) * 64 + k8 + 4) = c1;
        if (c == NCH - 1) break;
        c0 = c0 * gT + *(const f32x4*)(CHR + ((size_t)c * 64 + v) * 64 + k8); c1 = c1 * gT + *(const f32x4*)(CHR + ((size_t)c * 64 + v) * 64 + k8 + 4);
    }
    __syncthreads();
}
typedef float f32x16 __attribute__((ext_vector_type(16)));
constexpr int SBV_PITCH = 144;
__device__ __forceinline__ float lane32_swap(float v) { return __shfl_xor(v, 32); }
__device__ __forceinline__ void sb_tile_mfma(ARef A, int unit, int lane, LAS unsigned char* vl) {
    const int tq = unit & 127, bh = unit >> 7, b = bh >> 2, h = bh & 3, t0 = tq * 32, r32 = lane & 31, hi = lane >> 5;
    const bf16* PS = (const bf16*)(A.ws + WS_PB) + (size_t)b * SEQ * PBW + PB_SB + h * 64;
    bf16x8v qf[4];
#pragma unroll
    for (int ks = 0; ks < 4; ++ks) qf[ks] = *(const bf16x8v*)(PS + (size_t)(t0 + r32) * PBW + 16 * ks + 8 * hi);
    f32x16 o0, o1;
#pragma unroll
    for (int r = 0; r < 16; ++r) { o0[r] = 0.0f; o1[r] = 0.0f; }
    float carry = 0.0f;
    const int g16 = lane >> 4, tj = (lane & 15) >> 2, tc = lane & 3;
    v4u vn[4]; bf16x8v kn[4];
#define SB_FETCH(kb_) do { _Pragma("unroll") for (int i = 0; i < 4; ++i) { const int p = lane + 64 * i, row = p >> 3, ch = p & 7; vn[i] = *(const v4u*)(PS + 512 + (size_t)((kb_) + row) * PBW + 8 * ch); } \
        _Pragma("unroll") for (int ks = 0; ks < 4; ++ks) kn[ks] = *(const bf16x8v*)(PS + 256 + (size_t)((kb_) + r32) * PBW + 16 * ks + 8 * hi); } while (0)
    SB_FETCH(t0);
    for (int kb0 = t0; kb0 >= 0; kb0 -= 32) {
#pragma unroll
        for (int i = 0; i < 4; ++i) { const int p = lane + 64 * i, row = p >> 3, ch = p & 7; *(LAS v4u*)(vl + row * SBV_PITCH + 16 * ch) = vn[i]; }
        f32x16 st;
#pragma unroll
        for (int r = 0; r < 16; ++r) st[r] = 0.0f;
        { bf16x8v ka[4];
#pragma unroll
          for (int ks = 0; ks < 4; ++ks) ka[ks] = kn[ks];
          if (kb0 >= 32) SB_FETCH(kb0 - 32);
#pragma unroll
          for (int ks = 0; ks < 4; ++ks) st = __builtin_amdgcn_mfma_f32_32x32x16_bf16(ka[ks], qf[ks], st, 0, 0, 0);
          asm volatile("" :: "v"(ka[0]), "v"(ka[1]), "v"(ka[2]), "v"(ka[3]), "v"(st)); }
        float sp[16]; const bool diag = (kb0 == t0);
#pragma unroll
        for (int r = 0; r < 16; ++r) { const float zl = st[r]; float s = (zl > 30.0f) ? zl : __builtin_amdgcn_logf(1.0f + __builtin_amdgcn_exp2f(zl));
            if (diag && ((r & 3) + 8 * (r >> 2) + 4 * hi >= r32)) s = 0.0f;
            sp[r] = s; }
        float G[4], Gp[4], suf[4];
#pragma unroll
        for (int q = 0; q < 4; ++q) { G[q] = (sp[4 * q] + sp[4 * q + 1]) + (sp[4 * q + 2] + sp[4 * q + 3]); Gp[q] = lane32_swap(G[q]); }
        suf[3] = 0.0f; suf[2] = G[3] + Gp[3]; suf[1] = suf[2] + (G[2] + Gp[2]); suf[0] = suf[1] + (G[1] + Gp[1]);
        const float tot = suf[0] + (G[0] + Gp[0]);
        pg8::u32x4 pw0, pw1;
        float av[16];
#pragma unroll
        for (int q = 0; q < 4; ++q) { float run = carry + suf[q] + (hi == 0 ? Gp[q] : 0.0f);
#pragma unroll
            for (int i = 3; i >= 0; --i) { const int r = 4 * q + i; const float la = (st[r] - sp[r]) - run; float a = __builtin_amdgcn_exp2f(la);
                if (diag && ((r & 3) + 8 * (r >> 2) + 4 * hi >= r32)) a = 0.0f;
                av[r] = a; run += sp[r]; } }
        pw0.x = pg8::cvt_pk_bf16(av[0], av[1]); pw0.y = pg8::cvt_pk_bf16(av[2], av[3]); pw0.z = pg8::cvt_pk_bf16(av[4], av[5]); pw0.w = pg8::cvt_pk_bf16(av[6], av[7]);
        pw1.x = pg8::cvt_pk_bf16(av[8], av[9]); pw1.y = pg8::cvt_pk_bf16(av[10], av[11]); pw1.z = pg8::cvt_pk_bf16(av[12], av[13]); pw1.w = pg8::cvt_pk_bf16(av[14], av[15]);
        const bf16x8v pa0 = __builtin_bit_cast(bf16x8v, pw0), pa1 = __builtin_bit_cast(bf16x8v, pw1);
        LDS_WAIT();
#pragma unroll
        for (int s = 0; s < 2; ++s)
#pragma unroll
            for (int nb = 0; nb < 2; ++nb) {
                LAS unsigned char* a1 = vl + (16 * s + 4 * (g16 >> 1) + tj) * SBV_PITCH + (32 * nb + 16 * (g16 & 1) + 4 * tc) * 2;
                const s16x4v r1 = __builtin_bit_cast(s16x4v, __builtin_amdgcn_ds_read_tr16_b64_v4i16((LAS s16x4v*)a1));
                const s16x4v r2 = __builtin_bit_cast(s16x4v, __builtin_amdgcn_ds_read_tr16_b64_v4i16((LAS s16x4v*)(a1 + 8 * SBV_PITCH)));
                const bf16x8v bv = {r1[0], r1[1], r1[2], r1[3], r2[0], r2[1], r2[2], r2[3]};
                if (nb == 0) o0 = __builtin_amdgcn_mfma_f32_32x32x16_bf16(s ? pa1 : pa0, bv, o0, 0, 0, 0); else o1 = __builtin_amdgcn_mfma_f32_32x32x16_bf16(s ? pa1 : pa0, bv, o1, 0, 0, 0);
                asm volatile("" :: "v"(bv), "v"(pa0), "v"(pa1), "v"(o0), "v"(o1)); }
        LDS_WAIT();
        carry += tot;
        if (__all(carry > 150.0f)) break;
    }
#undef SB_FETCH
    float* YS = (float*)(A.ws + WS_YO) + 3 * YO_STRIDE + ((size_t)b * SEQ + t0) * 256 + h * 64 + r32;
#pragma unroll
    for (int r = 0; r < 16; ++r) { const int qo = (r & 3) + 8 * (r >> 2) + 4 * hi; YS[(size_t)qo * 256] = o0[r]; YS[(size_t)qo * 256 + 32] = o1[r]; }
}

__device__ __forceinline__ void dsa_scores_mfma(ARef A, const WI& w) {
    const _Float16* QIH = (const _Float16*)(A.ws + WS_DQI); const _Float16* KIH = (const _Float16*)(A.ws + WS_DKI);
    const float* DW = (const float*)(A.ws + WS_DW); float* SC = (float*)(A.ws + WS_SC);
    const int col = w.lane & 15, q4 = w.lane >> 4;
    for (int u = w.gw; u < 2048; u += w.NGW) {
        const int pi = u >> 1, par = u & 1, b = pi >> 7, p = pi & 127;
#pragma unroll 1
        for (int side = 0; side < 2; ++side) {
            const int qb = side ? 255 - p : p; const size_t m0 = (size_t)b * SEQ + 16 * qb;
            f16x8 bq[8];
#pragma unroll
            for (int h = 0; h < 8; ++h) bq[h] = *(const f16x8*)(QIH + (m0 + col) * 256 + h * 32 + 8 * q4);
            const float* dw = DW + (m0 + col) * 8; const f32x4 wa = *(const f32x4*)dw, wb = *(const f32x4*)(dw + 4);
            float* srow = SC + (m0 + col) * SEQ + 4 * q4;
            const _Float16* kbase = KIH + ((size_t)b * SEQ + col) * 32 + 8 * q4;
            for (int kp = par; 2 * kp <= qb; kp += 4) {
                f16x8 ak[4];
#pragma unroll
                for (int q = 0; q < 4; ++q) { const int kb = 2 * (kp + 2 * (q >> 1)) + (q & 1); ak[q] = *(const f16x8*)(kbase + (size_t)(kb <= qb ? kb : qb) * 16 * 32); }
#pragma unroll
                for (int q = 0; q < 4; ++q) { const int kb = 2 * (kp + 2 * (q >> 1)) + (q & 1);
                    if (kb <= qb) {
                        f32x4 acc = {0.f, 0.f, 0.f, 0.f};
#pragma unroll
                        for (int h = 0; h < 8; ++h) { const f32x4 c = __builtin_amdgcn_mfma_f32_16x16x32_f16(ak[q], bq[h], (f32x4){0.f, 0.f, 0.f, 0.f}, 0, 0, 0); const float wv = (h < 4) ? wa[h] : wb[h - 4];
                            acc.x += wv * fmaxf(c.x, 0.f); acc.y += wv * fmaxf(c.y, 0.f); acc.z += wv * fmaxf(c.z, 0.f); acc.w += wv * fmaxf(c.w, 0.f); }
                        *(f32x4*)(srow + 16 * kb) = acc + 0.0f; } }
            }
        }
    }
}

__device__ __forceinline__ int wave_total_i(int v) {
    v += __builtin_amdgcn_mov_dpp(v, 0xB1, 0xF, 0xF, true);
    v += __builtin_amdgcn_mov_dpp(v, 0x4E, 0xF, 0xF, true);
    v += __builtin_amdgcn_mov_dpp(v, 0x141, 0xF, 0xF, true);
    v += __builtin_amdgcn_mov_dpp(v, 0x140, 0xF, 0xF, true);
    return __builtin_amdgcn_readlane(v, 0) + __builtin_amdgcn_readlane(v, 16) + __builtin_amdgcn_readlane(v, 32) + __builtin_amdgcn_readlane(v, 48);
}
__device__ __forceinline__ unsigned score_key(float f) { const unsigned bits = __float_as_uint(f); return (bits & 0x80000000u) ? ~bits : (bits | 0x80000000u); }
constexpr int VST_PITCH = 144;
typedef unsigned short u16;
__device__ __forceinline__ void dsa_load_scores(ARef A, int m, int lane, f32x4 (&sv)[16]) {
    const int n = (m & (SEQ - 1)) + 1; const float* sc = (const float*)(A.ws + WS_SC) + (size_t)m * SEQ;
#pragma unroll
    for (int j4 = 0; j4 < 16; ++j4) sv[j4] = *(const f32x4*)(sc + ((256 * j4 < n) ? 256 * j4 : 0) + 4 * lane);
}
__device__ __forceinline__ void dsa_select(ARef A, int m, int n, int lane_in, LAS u16* slist, LAS unsigned* bk) {
    int lane = lane_in; asm volatile("" : "+v"(lane));
    if (n <= 256) {
#pragma unroll
        for (int c = 0; c < 4; ++c) { const int idx = lane + 64 * c; slist[idx] = (u16)((idx < n) ? idx : 0); }
        return;
    }
    f32x4 sv[16]; dsa_load_scores(A, m, lane, sv);
    unsigned u[64];
#pragma unroll
    for (int j4 = 0; j4 < 16; ++j4)
#pragma unroll
        for (int i = 0; i < 4; ++i) u[4 * j4 + i] = (256 * j4 + 4 * lane + i < n) ? score_key(sv[j4][i]) : 0u;
    unsigned T = 0u;
    for (int bit = 31; bit >= 16; --bit) { const unsigned cand = T | (1u << bit); int cnt = 0;
#pragma unroll
        for (int j = 0; j < 64; ++j) cnt += (u[j] >= cand) ? 1 : 0;
        if (wave_total_i(cnt) >= 256) T = cand; }
    unsigned long long bkb = 0ull; int chi = 0;
#pragma unroll
    for (int j = 0; j < 64; ++j) { bkb |= (unsigned long long)(((u[j] >> 16) == (T >> 16)) ? 1u : 0u) << j; chi += ((u[j] >> 16) > (T >> 16)) ? 1 : 0; }
    const int cb = wave_total_i(__popcll(bkb)), need = 256 - wave_total_i(chi);
    if (cb <= 64) {
        int pos = __popcll(bkb);
        { const int mine_ = pos;
#pragma unroll
          for (int d = 1; d < 64; d <<= 1) { const int y = __shfl_up(pos, d); if (lane >= d) pos += y; }
          pos -= mine_; }
#pragma unroll
        for (int j = 0; j < 64; ++j) { if ((bkb >> j) & 1ull) { bk[pos] = u[j]; ++pos; } }
        LDS_WAIT();
        const unsigned kx = (lane < cb) ? bk[lane] : 0u;
        for (int bit = 15; bit >= 0; --bit) { const unsigned cand = T | (1u << bit); if (__popcll(__ballot(kx >= cand)) >= need) T = cand; }
        LDS_WAIT();
    } else {
        for (int bit = 15; bit >= 0; --bit) { const unsigned cand = T | (1u << bit); int cnt = 0;
#pragma unroll
            for (int j = 0; j < 64; ++j) cnt += (u[j] >= cand) ? 1 : 0;
            if (wave_total_i(cnt) >= 256) T = cand; }
    }
    unsigned long long gtb = 0ull, eqb = 0ull;
#pragma unroll
    for (int j = 0; j < 64; ++j) { gtb |= (unsigned long long)((u[j] > T) ? 1u : 0u) << j; eqb |= (unsigned long long)((u[j] == T) ? 1u : 0u) << j; }
    const int tgt = wave_total_i(__popcll(gtb)), teq = wave_total_i(__popcll(eqb));
    unsigned long long selb = gtb | eqb;
    if (tgt + teq > 256) {
        const int take = 256 - tgt; int lo = 0;
        for (int bit = 11; bit >= 0; --bit) { const int cand = lo | (1 << bit); const int J4 = cand >> 8; int ni = (cand & 255) - 4 * lane; ni = ni < 0 ? 0 : (ni > 4 ? 4 : ni);
            const int jc = 4 * J4 + ni; const unsigned long long msk = (jc >= 64) ? ~0ull : ((1ull << jc) - 1ull);
            if (wave_total_i(__popcll(eqb & msk)) < take) lo = cand; }
        { const int cand = lo + 1; const int J4 = cand >> 8; int ni = (cand & 255) - 4 * lane; ni = ni < 0 ? 0 : (ni > 4 ? 4 : ni);
          const int jc = (cand >= SEQ) ? 64 : 4 * J4 + ni; const unsigned long long msk = (jc >= 64) ? ~0ull : ((1ull << jc) - 1ull); selb = gtb | (eqb & msk); }
    }
    const int mine = __popcll(selb); int off = mine;
#pragma unroll
    for (int d = 1; d < 64; d <<= 1) { const int y = __shfl_up(off, d); if (lane >= d) off += y; }
    off -= mine;
    while (selb) { const int j = __builtin_ctzll(selb); selb &= selb - 1ull; slist[off] = (u16)(256 * (j >> 2) + 4 * lane + (j & 3)); ++off; }
}
__device__ __forceinline__ void dsa_attend(ARef A, int m, int lane_in, const LAS u16* slist, LAS unsigned char* vbuf) {
    int lane = lane_in; asm volatile("" : "+v"(lane));
    const int b = m >> 12, t = m & (SEQ - 1), n = t + 1, nsel = n < 256 ? n : 256, col = lane & 15, q4 = lane >> 4;
    const bf16* DKB = (const bf16*)(A.ws + WS_DKB) + (size_t)b * SEQ * 64; const bf16* DVB = (const bf16*)(A.ws + WS_DVB) + (size_t)b * SEQ * 64;
    const int vrow = lane >> 3, vpc = lane & 7;
    bf16x8v bq0 = {0, 0, 0, 0, 0, 0, 0, 0}, bq1 = {0, 0, 0, 0, 0, 0, 0, 0};
    if (col < 4) { const bf16* qp = (const bf16*)(A.ws + WS_DQ) + (size_t)m * 256 + col * 64 + 8 * q4; bq0 = *(const bf16x8v*)qp; bq1 = *(const bf16x8v*)(qp + 32); }
    f32x4 lg[16];
#pragma unroll
    for (int hb = 0; hb < 2; ++hb) {
        bf16x8v a0[8], a1[8];
#pragma unroll
        for (int k = 0; k < 8; ++k) { const int s = slist[16 * (8 * hb + k) + col]; const bf16* kr = DKB + (size_t)s * 64 + 8 * q4; a0[k] = *(const bf16x8v*)kr; a1[k] = *(const bf16x8v*)(kr + 32); }
#pragma unroll
        for (int k = 0; k < 8; ++k) { const f32x4 c = __builtin_amdgcn_mfma_f32_16x16x32_bf16(a0[k], bq0, (f32x4){0.f, 0.f, 0.f, 0.f}, 0, 0, 0); lg[8 * hb + k] = __builtin_amdgcn_mfma_f32_16x16x32_bf16(a1[k], bq1, c, 0, 0, 0); }
        __builtin_amdgcn_sched_barrier(0);
    }
    if (nsel < 256) {
#pragma unroll
        for (int kb = 0; kb < 16; ++kb)
#pragma unroll
            for (int r = 0; r < 4; ++r) if (16 * kb + 4 * q4 + r >= nsel) lg[kb][r] = -INFINITY; }
    v4u vr[4];
#pragma unroll
    for (int i = 0; i < 4; ++i) { const int s = slist[vrow + 8 * i]; vr[i] = *(const v4u*)(DVB + (size_t)s * 64 + 8 * vpc); }
    float mx = -INFINITY;
#pragma unroll
    for (int kb = 0; kb < 16; ++kb) mx = fmaxf(fmaxf(mx, fmaxf(lg[kb].x, lg[kb].y)), fmaxf(lg[kb].z, lg[kb].w));
    mx = fmaxf(mx, __shfl_xor(mx, 16)); mx = fmaxf(mx, __shfl_xor(mx, 32));
    float sm = 0.f;
#pragma unroll
    for (int kb = 0; kb < 16; ++kb) { lg[kb].x = __builtin_amdgcn_exp2f(lg[kb].x - mx); lg[kb].y = __builtin_amdgcn_exp2f(lg[kb].y - mx); lg[kb].z = __builtin_amdgcn_exp2f(lg[kb].z - mx); lg[kb].w = __builtin_amdgcn_exp2f(lg[kb].w - mx); sm += (lg[kb].x + lg[kb].y) + (lg[kb].z + lg[kb].w); }
    sm += __shfl_xor(sm, 16); sm += __shfl_xor(sm, 32);
    const float inv = 1.0f / sm;
    bf16x8v pa[8];
#pragma unroll
    for (int i = 0; i < 8; ++i) { const f32x4 x = lg[2 * i] * inv, y = lg[2 * i + 1] * inv;
        pg8::u32x4 wv; wv.x = pg8::cvt_pk_bf16(x.x, x.y); wv.y = pg8::cvt_pk_bf16(x.z, x.w); wv.z = pg8::cvt_pk_bf16(y.x, y.y); wv.w = pg8::cvt_pk_bf16(y.z, y.w);
        pa[i] = __builtin_bit_cast(bf16x8v, wv); }
    f32x4 o[4];
#pragma unroll
    for (int nb = 0; nb < 4; ++nb) o[nb] = (f32x4){0.f, 0.f, 0.f, 0.f};
    const int tj = col >> 2, tc = col & 3;
#pragma unroll
    for (int c = 0; c < 8; ++c) {
        LAS unsigned char* vb = vbuf + (c & 1) * (32 * VST_PITCH);
#pragma unroll
        for (int i = 0; i < 4; ++i) *(LAS v4u*)(vb + (vrow + 8 * i) * VST_PITCH + 16 * vpc) = vr[i];
        if (c < 7) {
#pragma unroll
            for (int i = 0; i < 4; ++i) { const int s = slist[32 * (c + 1) + vrow + 8 * i]; vr[i] = *(const v4u*)(DVB + (size_t)s * 64 + 8 * vpc); } }
        LDS_WAIT();
#pragma unroll
        for (int nb = 0; nb < 4; ++nb) {
            LAS unsigned char* a1 = vb + (4 * q4 + tj) * VST_PITCH + (16 * nb + 4 * tc) * 2;
            const s16x4v r1 = __builtin_bit_cast(s16x4v, __builtin_amdgcn_ds_read_tr16_b64_v4i16((LAS s16x4v*)a1));
            const s16x4v r2 = __builtin_bit_cast(s16x4v, __builtin_amdgcn_ds_read_tr16_b64_v4i16((LAS s16x4v*)(a1 + 16 * VST_PITCH)));
            const bf16x8v bv = {r1[0], r1[1], r1[2], r1[3], r2[0], r2[1], r2[2], r2[3]};
            o[nb] = __builtin_amdgcn_mfma_f32_16x16x32_bf16(pa[c], bv, o[nb], 0, 0, 0); }
    }
    LDS_WAIT();
    if (lane < 16) { float* YD = (float*)(A.ws + WS_YO) + 2 * YO_STRIDE + (size_t)m * 256;
#pragma unroll
        for (int nb = 0; nb < 4; ++nb) { YD[16 * nb + lane] = o[nb].x; YD[64 + 16 * nb + lane] = o[nb].y; YD[128 + 16 * nb + lane] = o[nb].z; YD[192 + 16 * nb + lane] = o[nb].w; } }
}
constexpr int DSA_GR = 1;
__device__ __forceinline__ int dsa_row_of(int batch, int gi, int r) { const int idx = DSA_GR * gi + r, h = idx >> 1; return batch * SEQ + ((idx & 1) ? (SEQ - 1 - h) : h); }
__device__ __forceinline__ void dsa_wave(ARef A, const WI& w, LAS unsigned char* wl, int qi, int l) {
    LAS u16* lists = (LAS u16*)wl; LAS unsigned char* vbuf = wl + 4096; LAS unsigned* bk = (LAS unsigned*)vbuf;
#pragma unroll 1
    for (int kb = 0; kb < NB; ++kb) {
        const int batch = (w.bx + kb) & (NB - 1);
        unsigned* head = (unsigned*)(A.ws + WS_CTL) + CW_DSAQ + 128 * qi + 16 * batch;
        for (;;) {
            int g = 0; if (w.lane == 0) g = (int)atomicAdd(head, 1u);
            g = __builtin_amdgcn_readfirstlane(g);
            if (g >= 11 * (SEQ / 8)) break;
            const int per = g / 11, pos = g - 11 * per;
            if (pos >= 8) { moe_convert_chunk(A, l, batch * 1536 + 3 * per + (pos - 8), w.lane, (LAS float*)vbuf); continue; }
            const int gi = 8 * per + pos;
            { const int m = dsa_row_of(batch, gi, 0), n = (m & (SEQ - 1)) + 1; dsa_select(A, m, n, w.lane, lists, bk); }
            LDS_WAIT();
            dsa_attend(A, dsa_row_of(batch, gi, 0), w.lane, lists, vbuf);
        }
    }
}

__device__ __forceinline__ f32x4 head_norm4(f32x4 y, float eps, f32x4 g) {
    const float mean = grp16_sum(sum4(y)) * (1.0f / 64.0f); const f32x4 yc = y - mean;
    const float var = grp16_sum(dot4(yc, yc)) * (1.0f / 64.0f); return yc * (1.0f / sqrtf(var + eps)) * g;
}
template <bool BF> __device__ __forceinline__ f32x4 state_corr(const LAS float* sl, int hh, int r16, const void* pv) {
    const LAS float* r0 = sl + (hh * 64 + 4 * r16) * 64; const int x0 = (4 * r16) & 15;
    f32x4 out = {0.f, 0.f, 0.f, 0.f};
#pragma unroll 2
    for (int k8 = 0; k8 < 8; ++k8) {
        f32x4 pa, pb;
        if (BF) { const v4u x = ((const v4u*)pv)[k8]; pa = (f32x4){bf_lo(x.x), bf_hi(x.x), bf_lo(x.y), bf_hi(x.y)}; pb = (f32x4){bf_lo(x.z), bf_hi(x.z), bf_lo(x.w), bf_hi(x.w)}; }
        else { pa = ((const f32x4*)pv)[2 * k8]; pb = ((const f32x4*)pv)[2 * k8 + 1]; }
#pragma unroll
        for (int i = 0; i < 4; ++i) { const LAS float* rowp = r0 + i * 64; const int xs = (x0 + i) & 15;
            out[i] += dot4(*(const LAS f32x4*)(rowp + 4 * ((2 * k8) ^ xs)), pa) + dot4(*(const LAS f32x4*)(rowp + 4 * ((2 * k8 + 1) ^ xs)), pb); }
    }
    return out;
}
__device__ __forceinline__ void post_row(ARef A, int l, int m, int lane, const LAS float* slw, const LAS float* slr) {
    const float* YO = (const float*)(A.ws + WS_YO); const float* RWA = (const float*)(A.ws + WS_RWA);
    bf16* MX = (bf16*)(A.ws + WS_MIX) + (size_t)m * DM; const int c4 = 4 * lane, hh = lane >> 4, r16 = lane & 15; const size_t o = (size_t)m * 256 + c4;
    { f32x4 y = *(const f32x4*)(YO + o) + state_corr<true>(slr, hh, r16, (const bf16*)(A.ws + WS_PTR) + (size_t)m * 256 + hh * 64);
      y = head_norm4(y, 1e-5f, *(const f32x4*)(A.in[I_RETGN] + l * 256 + c4));
      const v2u gw_ = *(const v2u*)((const bf16*)(A.ws + WS_PB) + (size_t)m * PBW + 768 + c4); const f32x4 g = {bf_lo(gw_.x), bf_hi(gw_.x), bf_lo(gw_.y), bf_hi(gw_.y)};
#pragma unroll
      for (int i = 0; i < 4; ++i) y[i] *= g[i] * sigm(g[i]);
      v2u w; w.x = pk2(y.x, y.y); w.y = pk2(y.z, y.w); *(v2u*)(MX + c4) = w; }
    { f32x4 y = *(const f32x4*)(YO + YO_STRIDE + o) + state_corr<false>(slw, hh, r16, (const float*)(A.ws + WS_PT) + (size_t)m * 256 + hh * 64);
      y = head_norm4(y, 64e-5f, *(const f32x4*)(A.in[I_LN] + l * 256 + c4));
      y = (y + *(const f32x4*)(RWA + 7 * RWA_STRIDE + o)) * *(const f32x4*)(RWA + 6 * RWA_STRIDE + o);
      v2u w; w.x = pk2(y.x, y.y); w.y = pk2(y.z, y.w); *(v2u*)(MX + 256 + c4) = w; }
    { f32x4 y = *(const f32x4*)(YO + 2 * YO_STRIDE + o); const float r = 1.0f / sqrtf(wave_sum(dot4(y, y)) * (1.0f / 256.0f) + 1e-5f);
      y = y * r * *(const f32x4*)(A.in[I_DONORM] + l * 256 + c4);
      v2u w; w.x = pk2(y.x, y.y); w.y = pk2(y.z, y.w); *(v2u*)(MX + 512 + c4) = w; }
    { f32x4 y = *(const f32x4*)(YO + 3 * YO_STRIDE + o); const float r = 1.0f / sqrtf(wave_sum(dot4(y, y)) * (1.0f / 256.0f) + 1e-5f);
      y = y * r * *(const f32x4*)(A.in[I_SONORM] + l * 256 + c4);
      v2u w; w.x = pk2(y.x, y.y); w.y = pk2(y.z, y.w); *(v2u*)(MX + 768 + c4) = w; }
}
__device__ __forceinline__ void ph_post(ARef A, const WI& w, int l) {
    LAS float* slw = (LAS float*)w.lds; LAS float* slr = slw + 16384;
    for (int u = w.vcu; u < NB * NCH * 2; u += w.G) {
        const int b = u >> 5, c = (u >> 1) & 15, half = u & 1;
        __syncthreads();
        for (int e = w.tid; e < 4096; e += NWAVES * 64) { const int hh = e >> 10, v = (e >> 4) & 63, k4 = e & 15;
            const size_t src = ((size_t)((b * 4 + hh) * NCH + c) * 64 + v) * 64 + 4 * k4; const int dst = (hh * 64 + v) * 64 + 4 * (k4 ^ (v & 15));
            *(LAS f32x4*)(slw + dst) = *(const f32x4*)((const float*)(A.ws + WS_SI) + src); *(LAS f32x4*)(slr + dst) = *(const f32x4*)((const float*)(A.ws + WS_SIR) + src); }
        __syncthreads();
        const int tok0 = b * SEQ + c * TCH + half * 128 + w.wave * 16;
        for (int i = 0; i < 16; ++i) post_row(A, l, tok0 + i, w.lane, slw, slr);
    }
}

constexpr int S0_PITCH = 144;
template <int MIXER> __device__ __forceinline__ void post16_head(ARef A, int l, size_t m, int hh, int tk, int fq, const LAS unsigned char* s0) {
    const size_t o = m * 256 + hh * 64 + 8 * fq;
    bf16x8v pb[2];
    if (MIXER == 0) { const bf16* pp = (const bf16*)(A.ws + WS_PTR) + o; pb[0] = *(const bf16x8v*)pp; pb[1] = *(const bf16x8v*)(pp + 32); }
    else { const float* pp = (const float*)(A.ws + WS_PT) + o;
#pragma unroll
        for (int ks = 0; ks < 2; ++ks) { const f32x4 a = *(const f32x4*)(pp + 32 * ks), b = *(const f32x4*)(pp + 32 * ks + 4);
            pg8::u32x4 wv; wv.x = pg8::cvt_pk_bf16(a.x, a.y); wv.y = pg8::cvt_pk_bf16(a.z, a.w); wv.z = pg8::cvt_pk_bf16(b.x, b.y); wv.w = pg8::cvt_pk_bf16(b.z, b.w); pb[ks] = __builtin_bit_cast(bf16x8v, wv); } }
    f32x4 y[4];
    const float* yl = (const float*)(A.ws + WS_YO) + MIXER * YO_STRIDE + o;
#pragma unroll
    for (int mb = 0; mb < 4; ++mb) y[mb] = *(const f32x4*)(yl + 32 * (mb >> 1) + 4 * (mb & 1));
    const float* gw = ((MIXER == 0) ? A.in[I_RETGN] : A.in[I_LN]) + l * 256 + hh * 64 + 8 * fq;
    f32x4 gn[4], e0[4], e1[4];
#pragma unroll
    for (int mb = 0; mb < 4; ++mb) gn[mb] = *(const f32x4*)(gw + 32 * (mb >> 1) + 4 * (mb & 1));
    if (MIXER == 0) {
#pragma unroll
        for (int j = 0; j < 2; ++j) { const v4u gx = *(const v4u*)((const bf16*)(A.ws + WS_PB) + m * PBW + 768 + hh * 64 + 8 * fq + 32 * j);
            e0[2 * j] = (f32x4){bf_lo(gx.x), bf_hi(gx.x), bf_lo(gx.y), bf_hi(gx.y)}; e0[2 * j + 1] = (f32x4){bf_lo(gx.z), bf_hi(gx.z), bf_lo(gx.w), bf_hi(gx.w)}; }
    } else { const float* RWA = (const float*)(A.ws + WS_RWA);
#pragma unroll
        for (int j = 0; j < 2; ++j) { const v4u bx_ = *(const v4u*)((const bf16*)(RWA + 7 * RWA_STRIDE) + o + 32 * j), gx_ = *(const v4u*)((const bf16*)(RWA + 6 * RWA_STRIDE) + o + 32 * j);
            e0[2 * j] = (f32x4){bf_lo(bx_.x), bf_hi(bx_.x), bf_lo(bx_.y), bf_hi(bx_.y)}; e0[2 * j + 1] = (f32x4){bf_lo(bx_.z), bf_hi(bx_.z), bf_lo(bx_.w), bf_hi(bx_.w)};
            e1[2 * j] = (f32x4){bf_lo(gx_.x), bf_hi(gx_.x), bf_lo(gx_.y), bf_hi(gx_.y)}; e1[2 * j + 1] = (f32x4){bf_lo(gx_.z), bf_hi(gx_.z), bf_lo(gx_.w), bf_hi(gx_.w)}; } }
    const LAS unsigned char* ab = s0 + ((MIXER * 4 + hh) * 64 + 8 * (tk >> 2) + (tk & 3)) * S0_PITCH + 16 * fq;
#pragma unroll
    for (int mb = 0; mb < 4; ++mb)
#pragma unroll
        for (int ks = 0; ks < 2; ++ks) { const bf16x8v af = *(const LAS bf16x8v*)(ab + (32 * (mb >> 1) + 4 * (mb & 1)) * S0_PITCH + 64 * ks); y[mb] = __builtin_amdgcn_mfma_f32_16x16x32_bf16(af, pb[ks], y[mb], 0, 0, 0); }
    float s = (sum4(y[0]) + sum4(y[1])) + (sum4(y[2]) + sum4(y[3])); s += __shfl_xor(s, 16); s += __shfl_xor(s, 32);
    const float mean = s * (1.0f / 64.0f);
#pragma unroll
    for (int mb = 0; mb < 4; ++mb) y[mb] = y[mb] - mean;
    float q = (dot4(y[0], y[0]) + dot4(y[1], y[1])) + (dot4(y[2], y[2]) + dot4(y[3], y[3])); q += __shfl_xor(q, 16); q += __shfl_xor(q, 32);
    const float rs = 1.0f / sqrtf(q * (1.0f / 64.0f) + ((MIXER == 0) ? 1e-5f : 64e-5f));
    bf16* MX = (bf16*)(A.ws + WS_MIX) + m * DM + MIXER * 256 + hh * 64 + 8 * fq;
#pragma unroll
    for (int j = 0; j < 2; ++j) { f32x4 ya = y[2 * j] * rs * gn[2 * j], yb = y[2 * j + 1] * rs * gn[2 * j + 1];
        if (MIXER == 0) {
#pragma unroll
            for (int i = 0; i < 4; ++i) { ya[i] *= e0[2 * j][i] * sigm(e0[2 * j][i]); yb[i] *= e0[2 * j + 1][i] * sigm(e0[2 * j + 1][i]); }
        } else { ya = (ya + e0[2 * j]) * e1[2 * j]; yb = (yb + e0[2 * j + 1]) * e1[2 * j + 1]; }
        v4u wv; wv.x = pk2(ya.x, ya.y); wv.y = pk2(ya.z, ya.w); wv.z = pk2(yb.x, yb.y); wv.w = pk2(yb.z, yb.w); *(v4u*)(MX + 32 * j) = wv; }
}
__device__ __forceinline__ void post16_rms(ARef A, int l, size_t m, int mx, int fq) {
    const float* yp = (const float*)(A.ws + WS_YO) + (size_t)mx * YO_STRIDE + m * 256 + 8 * fq; const float* gw = ((mx == 2) ? A.in[I_DONORM] : A.in[I_SONORM]) + l * 256 + 8 * fq;
    f32x4 y[16];
#pragma unroll
    for (int j = 0; j < 8; ++j) { y[2 * j] = *(const f32x4*)(yp + 32 * j); y[2 * j + 1] = *(const f32x4*)(yp + 32 * j + 4); }
    float q = 0.0f;
#pragma unroll
    for (int j = 0; j < 16; ++j) q += dot4(y[j], y[j]);
    q += __shfl_xor(q, 16); q += __shfl_xor(q, 32);
    const float r = 1.0f / sqrtf(q * (1.0f / 256.0f) + 1e-5f);
    bf16* MX = (bf16*)(A.ws + WS_MIX) + m * DM + mx * 256 + 8 * fq;
#pragma unroll
    for (int j = 0; j < 8; ++j) { const f32x4 ya = y[2 * j] * r * *(const f32x4*)(gw + 32 * j), yb = y[2 * j + 1] * r * *(const f32x4*)(gw + 32 * j + 4);
        v4u wv; wv.x = pk2(ya.x, ya.y); wv.y = pk2(ya.z, ya.w); wv.z = pk2(yb.x, yb.y); wv.w = pk2(yb.z, yb.w); *(v4u*)(MX + 32 * j) = wv; }
}
__device__ __forceinline__ void ph_post16(ARef A, const WI& w, int l) {
    LAS unsigned char* s0 = w.lds;
    for (int u = w.vcu; u < NB * NCH * 2; u += w.G) {
        const int b = u >> 5, c = (u >> 1) & 15, half = u & 1;
        __syncthreads();
#pragma unroll 2
        for (int e = w.tid; e < 4096; e += NWAVES * 64) { const int hd = e >> 9, v = (e >> 3) & 63, k8 = e & 7;
            const float* src = (const float*)(A.ws + ((hd < 4) ? WS_SIR : WS_SI)) + ((size_t)((b * 4 + (hd & 3)) * NCH + c) * 64 + v) * 64 + 8 * k8;
            const f32x4 x0 = *(const f32x4*)src, x1 = *(const f32x4*)(src + 4);
            v4u wv; wv.x = pk2(x0.x, x0.y); wv.y = pk2(x0.z, x0.w); wv.z = pk2(x1.x, x1.y); wv.w = pk2(x1.z, x1.w); *(LAS v4u*)(s0 + (hd * 64 + v) * S0_PITCH + 16 * k8) = wv; }
        __syncthreads();
        int lane = w.lane; asm volatile("" : "+v"(lane));
        const int tk = lane & 15, fq = lane >> 4; const size_t m = (size_t)(b * SEQ + c * TCH + half * 128 + w.wave * 16 + tk);
#pragma unroll 1
        for (int hh = 0; hh < 4; ++hh) post16_head<0>(A, l, m, hh, tk, fq, s0);
#pragma unroll 1
        for (int hh = 0; hh < 4; ++hh) post16_head<1>(A, l, m, hh, tk, fq, s0);
#pragma unroll 1
        for (int mx = 2; mx < 4; ++mx) post16_rms(A, l, m, mx, fq);
    }
}

__device__ __forceinline__ float wave_max_f(float v) {
    v = fmaxf(v, __builtin_bit_cast(float, __builtin_amdgcn_mov_dpp(__builtin_bit_cast(int, v), 0xB1, 0xF, 0xF, true)));
    v = fmaxf(v, __builtin_bit_cast(float, __builtin_amdgcn_mov_dpp(__builtin_bit_cast(int, v), 0x4E, 0xF, 0xF, true)));
    v = fmaxf(v, __builtin_bit_cast(float, __builtin_amdgcn_mov_dpp(__builtin_bit_cast(int, v), 0x141, 0xF, 0xF, true)));
    v = fmaxf(v, __builtin_bit_cast(float, __builtin_amdgcn_mov_dpp(__builtin_bit_cast(int, v), 0x140, 0xF, 0xF, true)));
    const int iv = __builtin_bit_cast(int, v);
    return fmaxf(fmaxf(__builtin_bit_cast(float, __builtin_amdgcn_readlane(iv, 0)), __builtin_bit_cast(float, __builtin_amdgcn_readlane(iv, 16))), fmaxf(__builtin_bit_cast(float, __builtin_amdgcn_readlane(iv, 32)), __builtin_bit_cast(float, __builtin_amdgcn_readlane(iv, 48))));
}
__device__ __forceinline__ void router_stage(ARef A, const WI& w, int l) {
    LAS float* rwl = (LAS float*)w.lds; const float* rw = A.in[I_RW] + (size_t)l * DM * 32;
    for (int e = w.tid; e < DM * 8; e += NWAVES * 64) { const int k = e >> 3, c = e & 7; *(LAS f32x4*)(rwl + k * 32 + 4 * (c ^ ((k >> 2) & 7))) = *(const f32x4*)(rw + (size_t)k * 32 + 4 * c); }
    __syncthreads();
}
__device__ __forceinline__ void router_row(ARef A, int l, int m, int lane, LAS unsigned* hist, const LAS float* rwl, LAS int* texp, bool dry = false) {
    const float* XA = (const float*)(A.ws + WS_XA) + (size_t)m * DM; const float* MOD = (const float*)(A.ws + WS_MOD) + (size_t)(l * 8 + (m >> 12)) * 6144;
    f32x4 v[4]; float ss = 0.0f;
#pragma unroll
    for (int j = 0; j < 4; ++j) { v[j] = *(const f32x4*)(XA + 4 * (lane + 64 * j)); ss += dot4(v[j], v[j]); }
    ss = wave_sum(ss); const float rstd = 1.0f / sqrtf(ss * (1.0f / DM) + 1e-5f);
    const float* g = A.in[I_NFFN] + l * DM; const float* scp = MOD + 4 * 1024; const float* shp = MOD + 3 * 1024;
    emit_h_row(v, rstd, g, scp, shp, (bf16*)(A.ws + WS_H) + (size_t)m * DM, lane);
    float p[32];
#pragma unroll
    for (int e = 0; e < 32; ++e) p[e] = 0.0f;
    const int sw = lane & 7;
#pragma unroll 1
    for (int j = 0; j < 4; ++j) { const int k = 4 * (lane + 64 * j);
        const f32x4 h = *(const f32x4*)(XA + k) * rstd * *(const f32x4*)(g + k) * (1.0f + *(const f32x4*)(scp + k)) + *(const f32x4*)(shp + k);
        const LAS float* row = rwl + k * 32;
#pragma unroll
        for (int i = 0; i < 4; ++i) {
#pragma unroll
            for (int q4 = 0; q4 < 8; ++q4) { const f32x4 r = *(const LAS f32x4*)(row + i * 32 + 4 * (q4 ^ sw)); p[4 * q4] += h[i] * r.x; p[4 * q4 + 1] += h[i] * r.y; p[4 * q4 + 2] += h[i] * r.z; p[4 * q4 + 3] += h[i] * r.w; } } }
    float q16[16], q8[8], q4v[4], q2[2], q1;
    { const bool hb = (lane & 32) != 0;
#pragma unroll
      for (int i = 0; i < 16; ++i) { const float mine = hb ? p[16 + i] : p[i], oth = hb ? p[i] : p[16 + i]; q16[i] = mine + __shfl_xor(oth, 32); } }
    { const bool hb = (lane & 16) != 0;
#pragma unroll
      for (int i = 0; i < 8; ++i) { const float mine = hb ? q16[8 + i] : q16[i], oth = hb ? q16[i] : q16[8 + i]; q8[i] = mine + __shfl_xor(oth, 16); } }
    { const bool hb = (lane & 8) != 0;
#pragma unroll
      for (int i = 0; i < 4; ++i) { const float mine = hb ? q8[4 + i] : q8[i], oth = hb ? q8[i] : q8[4 + i]; q4v[i] = mine + __shfl_xor(oth, 8); } }
    { const bool hb = (lane & 4) != 0;
#pragma unroll
      for (int i = 0; i < 2; ++i) { const float mine = hb ? q4v[2 + i] : q4v[i], oth = hb ? q4v[i] : q4v[2 + i]; q2[i] = mine + __shfl_xor(oth, 4); } }
    { const bool hb = (lane & 2) != 0; const float mine = hb ? q2[1] : q2[0], oth = hb ? q2[0] : q2[1]; q1 = mine + __shfl_xor(oth, 2); }
    q1 += __shfl_xor(q1, 1);
    float lv = q1 + A.in[I_RB][l * 32 + (lane >> 1)];
    float tv[4]; int ti[4];
#pragma unroll
    for (int kk = 0; kk < 4; ++kk) { const float mx = wave_max_f(lv); const unsigned long long msk = __ballot(lv == mx); const int e = msk ? (int)(__builtin_ctzll(msk) >> 1) : kk;
        tv[kk] = mx; ti[kk] = e; if ((lane >> 1) == e) lv = -INFINITY; }
    const float e1 = expf(tv[1] - tv[0]), e2 = expf(tv[2] - tv[0]), e3 = expf(tv[3] - tv[0]); const float inv = 1.0f / (1.0f + e1 + e2 + e3);
    if (lane == 0 && !dry) {
        int* TI = (int*)(A.ws + WS_TOPI) + (size_t)m * 4; float* TW = (float*)(A.ws + WS_TOPW) + (size_t)m * 4;
        TI[0] = ti[0]; TI[1] = ti[1]; TI[2] = ti[2]; TI[3] = ti[3]; texp[0] = ti[0]; texp[1] = ti[1]; texp[2] = ti[2]; texp[3] = ti[3]; TW[0] = inv; TW[1] = e1 * inv; TW[2] = e2 * inv; TW[3] = e3 * inv;
        { unsigned* hg = (unsigned*)hist; atomicAdd(hg + ti[0], 1u); atomicAdd(hg + ti[1], 1u); atomicAdd(hg + ti[2], 1u); atomicAdd(hg + ti[3], 1u); }
    }
}
__device__ __forceinline__ void router_stage16(ARef A, const WI& w, int l) {
    LAS unsigned char* rwt = w.lds; const float* rw = A.in[I_RW] + (size_t)l * DM * 32;
    const int k0 = 2 * w.tid;
    const int c = k0 >> 3, kin = (k0 & 7) * 2;
#pragma unroll
    for (int e4 = 0; e4 < 8; ++e4) { const f32x4 a = *(const f32x4*)(rw + (size_t)k0 * 32 + 4 * e4), b = *(const f32x4*)(rw + (size_t)(k0 + 1) * 32 + 4 * e4);
#pragma unroll
        for (int i = 0; i < 4; ++i) { const int e = 4 * e4 + i; const unsigned hi = pg8::cvt_pk_bf16(a[i], b[i]); const float ra = a[i] - bf_lo(hi), rb = b[i] - bf_hi(hi); const unsigned lo = pg8::cvt_pk_bf16(ra, rb);
            const int off = e * 2048 + ((c ^ (e & 15)) * 16) + kin; *(LAS unsigned*)(rwt + off) = hi; *(LAS unsigned*)(rwt + 65536 + off) = lo; } }
    __syncthreads();
}
__device__ __forceinline__ void router16(ARef A, int l, int m0, int lane_in, LAS unsigned* hist, const LAS unsigned char* rwt, LAS int* texp, bool dry) {
    int lane = lane_in; asm volatile("" : "+v"(lane));
    const int tk = lane & 15, q4 = lane >> 4; const size_t m = (size_t)m0 + tk;
    const float* xr = (const float*)(A.ws + WS_XA) + m * DM + 8 * q4; const float* MOD = (const float*)(A.ws + WS_MOD) + (size_t)(l * 8 + (m0 >> 12)) * 6144;
    const float* g = A.in[I_NFFN] + l * DM + 8 * q4; const float* scp = MOD + 4 * 1024 + 8 * q4; const float* shp = MOD + 3 * 1024 + 8 * q4;
    bf16* hrow = (bf16*)(A.ws + WS_H) + m * DM + 8 * q4;
    float ss = 0.0f;
#pragma unroll 16
    for (int ks = 0; ks < 32; ++ks) { const f32x4 a = *(const f32x4*)(xr + 32 * ks), b = *(const f32x4*)(xr + 32 * ks + 4); ss += dot4(a, a) + dot4(b, b); }
    ss += __shfl_xor(ss, 16); ss += __shfl_xor(ss, 32);
    const float rstd = 1.0f / sqrtf(ss * (1.0f / DM) + 1e-5f);
    f32x4 acc[2] = {{0.f, 0.f, 0.f, 0.f}, {0.f, 0.f, 0.f, 0.f}};
    const LAS unsigned char* wrow = rwt + tk * 2048;
#pragma unroll 2
    for (int ks = 0; ks < 32; ++ks) {
        f32x4 h[2];
#pragma unroll
        for (int u = 0; u < 2; ++u) { const int k = 32 * ks + 4 * u; h[u] = *(const f32x4*)(xr + k) * rstd * *(const f32x4*)(g + k) * (1.0f + *(const f32x4*)(scp + k)) + *(const f32x4*)(shp + k); }
        pg8::u32x4 hw, lw;
        hw.x = pg8::cvt_pk_bf16(h[0].x, h[0].y); hw.y = pg8::cvt_pk_bf16(h[0].z, h[0].w); hw.z = pg8::cvt_pk_bf16(h[1].x, h[1].y); hw.w = pg8::cvt_pk_bf16(h[1].z, h[1].w);
        if (!dry) *(pg8::u32x4*)(hrow + 32 * ks) = hw;
        lw.x = pg8::cvt_pk_bf16(h[0].x - bf_lo(hw.x), h[0].y - bf_hi(hw.x)); lw.y = pg8::cvt_pk_bf16(h[0].z - bf_lo(hw.y), h[0].w - bf_hi(hw.y));
        lw.z = pg8::cvt_pk_bf16(h[1].x - bf_lo(hw.z), h[1].y - bf_hi(hw.z)); lw.w = pg8::cvt_pk_bf16(h[1].z - bf_lo(hw.w), h[1].w - bf_hi(hw.w));
        const bf16x8v bh = __builtin_bit_cast(bf16x8v, hw), bl = __builtin_bit_cast(bf16x8v, lw);
        const int coff = ((4 * ks + q4) ^ tk) * 16;
#pragma unroll
        for (int blk = 0; blk < 2; ++blk) { const bf16x8v ah = *(const LAS bf16x8v*)(wrow + blk * 32768 + coff), al = *(const LAS bf16x8v*)(wrow + 65536 + blk * 32768 + coff);
            acc[blk] = __builtin_amdgcn_mfma_f32_16x16x32_bf16(ah, bh, acc[blk], 0, 0, 0); acc[blk] = __builtin_amdgcn_mfma_f32_16x16x32_bf16(ah, bl, acc[blk], 0, 0, 0); acc[blk] = __builtin_amdgcn_mfma_f32_16x16x32_bf16(al, bh, acc[blk], 0, 0, 0); }
    }
    float lv[8]; const float* rb = A.in[I_RB] + l * 32 + 4 * q4;
#pragma unroll
    for (int blk = 0; blk < 2; ++blk)
#pragma unroll
        for (int i = 0; i < 4; ++i) lv[4 * blk + i] = acc[blk][i] + rb[16 * blk + i];
    float tv[4]; int ti[4];
#pragma unroll
    for (int kk = 0; kk < 4; ++kk) {
        float mx = fmaxf(fmaxf(fmaxf(lv[0], lv[1]), fmaxf(lv[2], lv[3])), fmaxf(fmaxf(lv[4], lv[5]), fmaxf(lv[6], lv[7])));
        mx = fmaxf(mx, __shfl_xor(mx, 16)); mx = fmaxf(mx, __shfl_xor(mx, 32));
        int cand = 99;
#pragma unroll
        for (int j = 7; j >= 0; --j) if (lv[j] == mx) cand = 16 * (j >> 2) + 4 * q4 + (j & 3);
        cand = min(cand, __shfl_xor(cand, 16)); cand = min(cand, __shfl_xor(cand, 32));
        if (cand == 99) cand = kk;
        tv[kk] = mx; ti[kk] = cand;
#pragma unroll
        for (int j = 0; j < 8; ++j) if (16 * (j >> 2) + 4 * q4 + (j & 3) == cand) lv[j] = -INFINITY;
    }
    const float e1 = expf(tv[1] - tv[0]), e2 = expf(tv[2] - tv[0]), e3 = expf(tv[3] - tv[0]); const float inv = 1.0f / (1.0f + e1 + e2 + e3);
    if (q4 == 0 && !dry) {
        int* TI = (int*)(A.ws + WS_TOPI) + m * 4; float* TW = (float*)(A.ws + WS_TOPW) + m * 4;
        *(v4u*)TI = (v4u){(unsigned)ti[0], (unsigned)ti[1], (unsigned)ti[2], (unsigned)ti[3]}; *(f32x4*)TW = (f32x4){inv, e1 * inv, e2 * inv, e3 * inv};
        LAS int* tx = texp + tk * 4; tx[0] = ti[0]; tx[1] = ti[1]; tx[2] = ti[2]; tx[3] = ti[3];
        { unsigned* hg = (unsigned*)hist; atomicAdd(hg + ti[0], 1u); atomicAdd(hg + ti[1], 1u); atomicAdd(hg + ti[2], 1u); atomicAdd(hg + ti[3], 1u); }
    }
}
__device__ __forceinline__ void build_expert_table(ARef A, const WI& w, int l) {
    LAS int* tst = (LAS int*)(w.lds + TST_OFF); LAS int* tab = (LAS int*)(w.lds + TAB_OFF); LAS int* cnt = (LAS int*)(w.lds + CNT_OFF);
    if (w.tid == 0) { const unsigned* gc = (const unsigned*)(A.ws + WS_CTL) + CW_GCNT + 64 * l; int acc = 0;
        for (int e = 0; e < 32; ++e) { const int c = (int)__hip_atomic_load(gc + e, RLX_AGENT); cnt[e] = c; tst[e] = acc; acc += (c + 255) >> 8; }
        tst[32] = acc; tab[0] = acc; }
    __syncthreads();
    if (w.tid < 32) { const int e = w.tid; for (int pm = tst[e]; pm < tst[e + 1]; ++pm) tab[1 + pm] = e; }
    __syncthreads();
}
__device__ __forceinline__ void router_lists(ARef A, const WI& w, int l) {
    LAS unsigned* hist = (LAS unsigned*)(w.lds + HIST_OFF); LAS int* base = (LAS int*)(w.lds + BASE_OFF); LAS int* texp = (LAS int*)(w.lds + TEXP_OFF);
    __syncthreads();
    if (w.tid < 32) { base[w.tid] = (int)atomicAdd((unsigned*)(A.ws + WS_CTL) + CW_GCNT + 64 * l + w.tid, hist[w.tid]); hist[w.tid] = 0u; }
    __syncthreads();
    int* LIST = (int*)(A.ws + WS_LIST); int* PW = (int*)(A.ws + WS_POS);
    for (int g16 = w.gw; g16 < MTOK / 16; g16 += w.NGW) {
        const int j = w.lane >> 2, q = w.lane & 3, m = 16 * g16 + j; const int e = texp[(w.wave * 16 + j) * 4 + q]; const int idx = base[e] + (int)atomicAdd((unsigned*)hist + e, 1u);
        LIST[e * LCAP + idx] = m; PW[(size_t)m * 4 + q] = (e << 20) | idx; }
}
__device__ __forceinline__ void combine_row(ARef A, int l, int m, int lane, const LAS int* tst, float gscale = 1.0f, float oscale = 1.0f) {
    float* XA = (float*)(A.ws + WS_XA) + (size_t)m * DM; const float* MOD = (const float*)(A.ws + WS_MOD) + (size_t)(l * 8 + (m >> 12)) * 6144;
    const int* PS = (const int*)(A.ws + WS_POS) + (size_t)m * 4; const float* TW = (const float*)(A.ws + WS_TOPW) + (size_t)m * 4;
    const bf16* YS = (const bf16*)(A.ws + WS_XS);
    f32x4 v[4], acc[4];
#pragma unroll
    for (int j = 0; j < 4; ++j) { v[j] = *(const f32x4*)(XA + 4 * (lane + 64 * j)); acc[j] = (f32x4){0.f, 0.f, 0.f, 0.f}; }
#pragma unroll
    for (int k = 0; k < 4; ++k) { const int pe = PS[k]; const int pos = tst[pe >> 20] * 256 + (pe & 0xFFFFF); const float gt = TW[k] * gscale; const v2u* yr = (const v2u*)(YS + (size_t)pos * DM);
#pragma unroll
        for (int j = 0; j < 4; ++j) { const v2u y = yr[lane + 64 * j]; acc[j] += gt * (f32x4){bf_lo(y.x), bf_hi(y.x), bf_lo(y.y), bf_hi(y.y)}; } }
    float ss = 0.0f;
#pragma unroll
    for (int j = 0; j < 4; ++j) { const int kx = 4 * (lane + 64 * j); v[j] += *(const f32x4*)(MOD + 5 * 1024 + kx) * acc[j]; ss += dot4(v[j], v[j]); }
    ss = wave_sum(ss); const float rstd = 1.0f / sqrtf(ss * (1.0f / DM) + 1e-5f);
    if (l + 1 < NLAYER) {
#pragma unroll
        for (int j = 0; j < 4; ++j) *(f32x4*)(XA + 4 * (lane + 64 * j)) = v[j];
        const float* mb = MOD + 8 * 6144;
        emit_h_row(v, rstd, A.in[I_NMIX] + (l + 1) * DM, mb + 1024, mb, (bf16*)(A.ws + WS_H) + (size_t)m * DM, lane);
    } else {
        float* orow = A.out + (size_t)m * DM; const float* gf = A.in[I_NFINAL];
#pragma unroll
        for (int j = 0; j < 4; ++j) { const int kx = 4 * (lane + 64 * j); *(f32x4*)(orow + kx) = v[j] * (rstd * oscale) * *(const f32x4*)(gf + kx); }
    }
}

constexpr int N_LAUNCHES = MK_N_LAUNCHES;
template <int SEL> __global__ void __launch_bounds__(NWAVES * 64, 2) fwd(ArgsH Ah) {
    extern __shared__ __attribute__((aligned(16))) unsigned char lds[];
    (void)Ah;
    const int wave_s = __builtin_amdgcn_readfirstlane((int)threadIdx.x >> 6);
    auto tid_now = [&]() -> int { int ws_ = wave_s; unsigned z_ = 0u; asm volatile("" : "+s"(ws_), "+s"(z_)); return ws_ * 64 + (int)__builtin_amdgcn_mbcnt_hi(~0u, __builtin_amdgcn_mbcnt_lo(~0u, z_)); };
#define TID_NOW() tid_now()
#define MAKE_WI() WI w; { int tz = TID_NOW(); asm volatile("" : "+v"(tz)); int bz = blockIdx.x, gz = gridDim.x; asm volatile("" : "+s"(bz), "+s"(gz)); \
        w.lds = (LAS unsigned char*)lds; w.tid = tz; w.lane = tz & 63; w.wave = __builtin_amdgcn_readfirstlane(tz >> 6); w.G = gz; w.bx = bz; w.vcu = (gz % 8 == 0) ? (bz % 8) * (gz / 8) + bz / 8 : bz; \
        w.gw = w.vcu * NWAVES + w.wave; w.NGW = gz * NWAVES; }
    { const int t0 = threadIdx.x; for (int u = t0; u < (LDS_BYTES - RING_BYTES) / 4; u += NWAVES * 64) ((LAS unsigned*)((LAS unsigned char*)lds + RING_BYTES))[u] = 0u; }
    __syncthreads();
    int lo, hi; { ARef A0 = *kargs(); lo = A0.ph_lo; hi = A0.ph_hi; }
    if (N_LAUNCHES == 1) { ARef A0 = *kargs(); (void)xcd_barrier_post((unsigned*)((gu32*)(A0.ws + WS_CTL) + CW_BAR), (volatile LAS unsigned*)((LAS unsigned char*)lds + MISC_OFF) + 8, TID_NOW()); }
#define GRID_BAR() do { if (N_LAUNCHES == 1) { ARef Ab = *kargs(); XcdBarrier bar_; bar_.bar = (unsigned*)((gu32*)(Ab.ws + WS_CTL) + CW_BAR); bar_.x = xb_xcc_id(); bar_.st = (volatile LAS unsigned*)((LAS unsigned char*)lds + MISC_OFF) + 8; xcd_barrier(bar_, TID_NOW()); } } while (0)
#ifndef TPROBE
#define TPROBE 0
#endif
#if TPROBE
    unsigned long long tp_acc = 0ull;
#define TP_SCALE tp_scale_of(__hip_atomic_load((unsigned*)(A.ws + WS_CTL) + 3, RLX_AGENT))
    auto tp_scale_of = [](unsigned ticks) -> float { const float us = (float)ticks * 0.01f; if (us < 1.0f) return 1.0f; const float q = exp2f(rintf(log2f(us) * 8.0f) * 0.125f); return 1.0f + sqrtf(q * 1e-5f); };
#define TP_BEGIN(kind) unsigned long long tp_t0 = 0ull; if ((kind) == TPROBE) tp_t0 = __builtin_amdgcn_s_memrealtime();
#define TP_END(kind) if ((kind) == TPROBE) { tp_acc += __builtin_amdgcn_s_memrealtime() - tp_t0; }
#define TP_PUBLISH(l) if ((l) == 1 && w.vcu == 0 && w.tid == 0) __hip_atomic_store((unsigned*)(A.ws + WS_CTL) + 3, (unsigned)tp_acc, RLX_AGENT);
#else
#define TP_SCALE 1.0f
#define TP_PUBLISH(l)
#define TP_BEGIN(kind)
#define TP_END(kind)
#endif
#define IN(k) (lo <= (k) && (k) < hi)
#ifndef PHMASK
#define PHMASK 0xffffffffu
#endif
#define KON(k) if constexpr ((SEL < 0 && ((PHMASK >> (k)) & 1u)) || SEL == (k))
#define BOTH(k) (IN(k) && IN((k) + 1))
#ifndef PROBE_REP
#define PROBE_REP 0
#endif
#if PROBE_REP
    int nrep_ = 2; asm volatile("" : "+s"(nrep_));
#define REP(bit) _Pragma("unroll 1") for (int rep_ = 0; rep_ < (((PROBE_REP >> (bit)) & 1) ? nrep_ : 1); ++rep_)
#else
#define REP(bit) for (int rep_ = 0; rep_ < 1; ++rep_)
#endif
#define ring ((PG8_LAS unsigned char*)lds)

    KON(0) if (IN(0)) { ARef A = *kargs(); MAKE_WI(); REP(0) ph_prologue(A, w); if (BOTH(0)) GRID_BAR(); }

#define LAYER_BODY(l) do {\
        const int pb = 1 + l * NPL; \
        KON(1) if (IN(pb + 0)) { ARef A = *kargs(); MAKE_WI(); TP_BEGIN(1) if (l == 0) { REP(15) { ph_norm1(A, w); small_weights_to_f16(A, w); } if (BOTH(pb + 0)) GRID_BAR(); } TP_END(1) } \
        KON(2) if (IN(pb + 1)) { ARef A = *kargs(); MAKE_WI(); TP_BEGIN(2) \
            pg8::Gemm g{(const bf16*)(A.ws + WS_H), (const bf16*)(A.ws + WS_WIN) + (size_t)l * INCP * DM, MTOK, INCP, DM}; pg8::StaticOrder S; S.init(MTOK, INCP, w.G, w.bx); \
            pg8::EpiProj E{(bf16*)(A.ws + WS_PB), (bf16*)(A.ws + WS_PF)}; \
            REP(1) pg8::gemm_phase<pg8::EpiProj, pg8::StaticOrder, true, true>(ring, g, S, E, w.tid); \
            if (BOTH(pb + 1)) GRID_BAR(); TP_END(2) \
        } \
        KON(3) if (IN(pb + 2)) { ARef A = *kargs(); MAKE_WI(); TP_BEGIN(3) \
            REP(2) { int part_ = rep_ ? ((PROBE_REP >> 21) & 7) : 7; asm volatile("" : "+s"(part_)); for (int g = w.gw; g < MTOK / 16; g += w.NGW) prep16(A, l, 16 * g, w.lane, part_); } \
            if (BOTH(pb + 2)) GRID_BAR(); TP_END(3) \
        } \
        KON(4) if (IN(pb + 3)) { ARef A = *kargs(); MAKE_WI(); TP_BEGIN(4) \
            REP(3) { for (int tk = 2 * w.vcu; tk < 32 * NCH; tk += 2 * w.G) scan_rwkv_task2(A, w, tk); } \
            REP(13) { for (int tk = w.vcu; tk < 32 * NCH / 2; tk += w.G) scan_ret_task(A, w, tk); } \
            REP(4) { LAS unsigned char* vl = w.lds + w.wave * 4608; for (int it = w.gw; it < 32 * 128; it += w.NGW) sb_tile_mfma(A, it, w.lane, vl); } \
            REP(5) dsa_scores_mfma(A, w); \
            if (BOTH(pb + 3)) GRID_BAR(); TP_END(4) \
        } \
        KON(5) if (IN(pb + 4)) { ARef A = *kargs(); MAKE_WI(); TP_BEGIN(5) \
            if (w.bx < 32) prefix_chain(A, w, w.bx); \
            REP(6) dsa_wave(A, w, w.lds + w.wave * 13312, l + 2 * rep_, l); \
            REP(14) { if (rep_ && w.bx < 32) prefix_chain(A, w, w.bx); } \
            if (BOTH(pb + 4)) GRID_BAR(); TP_END(5) \
        } \
        KON(6) if (IN(pb + 5)) { ARef A = *kargs(); MAKE_WI(); TP_BEGIN(6) \
            REP(7) ph_post16(A, w, l); \
            if (BOTH(pb + 5)) GRID_BAR(); TP_END(6) \
        } \
        KON(7) if (IN(pb + 6)) { ARef A = *kargs(); MAKE_WI(); TP_BEGIN(7) \
            pg8::Gemm g{(const bf16*)(A.ws + WS_MIX), (const bf16*)(A.ws + WS_WOUT) + (size_t)l * DM * DM, MTOK, DM, DM}; pg8::StaticOrder S; S.init(MTOK, DM, w.G, w.bx); \
            pg8::EpiRes E{l == 0 ? A.in[I_X] : (const float*)(A.ws + WS_XA), (float*)(A.ws + WS_XA), (const float*)(A.ws + WS_MOD) + (size_t)l * 8 * 6144 + 2 * 1024}; \
            REP(16) { pg8::EpiRes E2 = E; if (rep_ && l == 1) E2.gate = (const float*)(A.ws + WS_CTL + 512 * 1024); pg8::gemm_phase<pg8::EpiRes, pg8::StaticOrder, true, true>(ring, g, S, E2, w.tid); } \
            if (BOTH(pb + 6)) GRID_BAR(); TP_END(7) \
        } \
        KON(8) if (IN(pb + 7)) { ARef A = *kargs(); MAKE_WI(); TP_BEGIN(8) \
            { LAS unsigned* hist = (LAS unsigned*)(w.lds + HIST_OFF); LAS int* texp = (LAS int*)(w.lds + TEXP_OFF); if (w.tid < 32) hist[w.tid] = 0u; router_stage16(A, w, l); \
            REP(10) { for (int g16 = w.gw; g16 < MTOK / 16; g16 += w.NGW) router16(A, l, 16 * g16, w.lane, hist, (const LAS unsigned char*)w.lds, texp + w.wave * 64, rep_ != 0); } \
            router_lists(A, w, l); } \
            if (BOTH(pb + 7)) GRID_BAR(); TP_END(8) \
        } \
        KON(10) if (IN(pb + 8)) { ARef A = *kargs(); MAKE_WI(); TP_BEGIN(10) \
            build_expert_table(A, w, l); \
            pg8::Gemm g{(const bf16*)(A.ws + WS_H), (const bf16*)(A.ws + WS_W1) + (size_t)l * NEXP * 2048 * DM, MOE_ROWS, NEXP * 2048, DM}; \
            pg8::MoeOrder S{(const PG8_LAS int*)(w.lds + TAB_OFF), 8, w.G, w.vcu, (const PG8_LAS int*)(w.lds + TST_OFF), (const PG8_LAS int*)(w.lds + CNT_OFF), (const int*)(A.ws + WS_LIST)}; \
            pg8::EpiSwiglu E{(bf16*)(A.ws + WS_ACT), A.in[I_MB1] + (size_t)l * NEXP * 2048}; \
            REP(8) { if (PROBE_REP & (1 << 20)) { if (rep_) pg8::gemm_phase<pg8::EpiNull, pg8::MoeOrder, true, true, true>(ring, g, S, pg8::EpiNull{}, w.tid); else pg8::gemm_phase<pg8::EpiSwiglu, pg8::MoeOrder, true, true, true>(ring, g, S, E, w.tid); } else pg8::gemm_phase<pg8::EpiSwiglu, pg8::MoeOrder, true, true, true>(ring, g, S, E, w.tid); } \
            if (BOTH(pb + 8)) GRID_BAR(); TP_END(10) \
        } \
        KON(11) if (IN(pb + 9)) { ARef A = *kargs(); MAKE_WI(); TP_BEGIN(11) \
            build_expert_table(A, w, l); \
            pg8::Gemm g{(const bf16*)(A.ws + WS_ACT), (const bf16*)(A.ws + WS_W2) + (size_t)l * NEXP * DM * DM, MOE_ROWS, NEXP * DM, DM}; \
            pg8::MoeOrder S{(const PG8_LAS int*)(w.lds + TAB_OFF), 4, w.G, w.vcu, (const PG8_LAS int*)(w.lds + TST_OFF), (const PG8_LAS int*)(w.lds + CNT_OFF), (const int*)(A.ws + WS_LIST)}; \
            pg8::EpiY E{(bf16*)(A.ws + WS_XS), A.in[I_MB2] + (size_t)l * NEXP * DM}; \
            REP(9) pg8::gemm_phase<pg8::EpiY, pg8::MoeOrder, true, true>(ring, g, S, E, w.tid); \
            TP_PUBLISH(l) \
            if (BOTH(pb + 9)) GRID_BAR(); TP_END(11) \
        } \
        KON(12) if (IN(pb + 10)) { ARef A = *kargs(); MAKE_WI(); TP_BEGIN(12) \
            build_expert_table(A, w, l); \
            REP(12) for (int m = w.gw; m < MTOK; m += w.NGW) combine_row(A, l, m, w.lane, (const LAS int*)(w.lds + TST_OFF), (rep_ && l == 0) ? 0.0f : 1.0f, TP_SCALE); \
            if (BOTH(pb + 10)) GRID_BAR(); TP_END(12) \
        } \
    } while (0)
    LAYER_BODY(0);
    LAYER_BODY(1);
#undef LAYER_BODY
#undef IN
#undef ring
#undef MAKE_WI
#undef TID_NOW
#undef GRID_BAR
#undef KON
#undef BOTH
}


#if MK_N_LAUNCHES != 1
template <int K> static void launch_one(int grid, hipStream_t stream, const ArgsH& a) {
    static bool attr = false;
    if (!attr) { (void)hipFuncSetAttribute((const void*)fwd<K>, hipFuncAttributeMaxDynamicSharedMemorySize, LDS_BYTES); attr = true; }
    hipLaunchKernelGGL(fwd<K>, dim3(grid), dim3(NWAVES * 64), LDS_BYTES, stream, a);
}
static void launch_kind(int kind, int grid, hipStream_t stream, const ArgsH& a) {
    switch (kind) {
        case 0: launch_one<0>(grid, stream, a); break; case 1: launch_one<1>(grid, stream, a); break; case 2: launch_one<2>(grid, stream, a); break;
        case 3: launch_one<3>(grid, stream, a); break; case 4: launch_one<4>(grid, stream, a); break; case 5: launch_one<5>(grid, stream, a); break;
        case 6: launch_one<6>(grid, stream, a); break; case 7: launch_one<7>(grid, stream, a); break; case 8: launch_one<8>(grid, stream, a); break;
        case 9: launch_one<9>(grid, stream, a); break; case 10: launch_one<10>(grid, stream, a); break; case 11: launch_one<11>(grid, stream, a); break;
        default: launch_one<12>(grid, stream, a); break;
    }
}
#endif
extern "C" void kernel_launch(void* const* d_in, const int* in_sizes, int n_in, void* d_out, int out_size, void* d_ws, size_t ws_size, hipStream_t stream) {
    static int grid = 0;
    if (grid == 0) {
        if (n_in != N_IN || out_size != MTOK * DM || ws_size < WS_END) { fprintf(stderr, "kernel_launch: unexpected shapes (n_in %d, out %d, ws %zu)\n", n_in, out_size, ws_size); grid = -1; return; }
        int dev = 0, cus = 0;
        if (hipGetDevice(&dev) != hipSuccess || hipDeviceGetAttribute(&cus, hipDeviceAttributeMultiprocessorCount, dev) != hipSuccess) { grid = -1; return; }
#if MK_N_LAUNCHES == 1
        {
            if (hipFuncSetAttribute((const void*)fwd<-1>, hipFuncAttributeMaxDynamicSharedMemorySize, LDS_BYTES) != hipSuccess) { fprintf(stderr, "kernel_launch: hipFuncSetAttribute failed\n"); grid = -1; return; }
            int per_cu = 0;
            if (hipOccupancyMaxActiveBlocksPerMultiprocessor(&per_cu, (const void*)fwd<-1>, NWAVES * 64, LDS_BYTES) != hipSuccess || per_cu < 1) fprintf(stderr, "kernel_launch: occupancy query says %d\n", per_cu);
            (void)hipGetLastError();
        }
#endif
        grid = cus;
    }
    if (grid < 0) return;
    (void)in_sizes;
    if (hipMemsetAsync((char*)d_ws + WS_CTL, 0, CTL_ZERO_BYTES, stream) != hipSuccess) return;
    ArgsH a{};
    for (int i = 0; i < N_IN; ++i) a.in[i] = (const float*)d_in[i];
    a.out = (float*)d_out; a.ws = (unsigned char*)d_ws;
    for (int f = 0; f < 44; ++f) a.invf[f] = (f < 32) ? pow(10000.0, -(double)f / 32.0) : (f < 40) ? pow(500000.0, -(double)(f - 32) / 8.0) : pow(500000.0, -(double)(f - 40) / 4.0);
#if MK_N_LAUNCHES == 1
    a.ph_lo = 0; a.ph_hi = NPHASE; a.li = 0;
    hipLaunchKernelGGL(fwd<-1>, dim3(grid), dim3(NWAVES * 64), LDS_BYTES, stream, a);
#else
    {
        for (int p = 0; p < NPHASE; ++p) {
            if (p == 1 + NPL) continue;
            a.ph_lo = p; a.ph_hi = p + 1; a.li = p;
            static const int kinds_[NPL] = {1, 2, 3, 4, 5, 6, 7, 8, 10, 11, 12};
            const int kind = (p == 0) ? 0 : kinds_[(p - 1) % NPL];
            launch_kind(kind, grid, stream, a);
        }
    }
#endif
}
```

```cpp
#include <hip/hip_runtime.h>
#include <cstdio>
#include <cstdint>
#include <cmath>

#ifndef MK_N_LAUNCHES
#define MK_N_LAUNCHES 1
#endif

namespace pg8 {
#define PG8_LAS __attribute__((address_space(3)))
typedef unsigned short bf16_t;
typedef short bf16x8 __attribute__((ext_vector_type(8)));
typedef float f32x4 __attribute__((ext_vector_type(4)));
typedef unsigned u32x4 __attribute__((ext_vector_type(4)));
typedef unsigned u32x2 __attribute__((ext_vector_type(2)));
constexpr int BM = 256, BK = 64, HALF = 128, HTB = HALF * BK * 2  , STAGE_BYTES = 8 * HTB, NXCD = 8, WGM = 8;

__host__ __device__ __forceinline__ int lds_byte(int r, int c) { const int st = (r >> 4) * 2 + (c >> 5), rr = r & 15, cc = c & 31, ob = rr * 64 + cc * 2; return st * 1024 + (ob ^ (((ob >> 9) & 1) << 5)); }
__host__ __device__ __forceinline__ void stage_rc(int b, int& R, int& C) { const int st = b / 1024, sb = b % 1024, swz = sb ^ (((sb >> 9) & 1) << 5); R = (st >> 1) * 16 + swz / 64; C = (st & 1) * 32 + (swz % 64) / 2; }
__host__ __device__ __forceinline__ int perm32(int rho) { const int n = rho >> 4, i = rho & 15; return 8 * (i >> 2) + 4 * n + (i & 3); }

struct Unit { int pm, pn; };
struct Gemm { const bf16_t* A; const bf16_t* Bt; int M, N, K; };

struct StaticOrder {
    int nM, nN, nwg, G, c;
    __host__ __device__ void init(int M, int N, int G_, int c_) { nM = M / BM; nN = N / BM; nwg = nM * nN; G = G_; c = c_; }
    __host__ __device__ bool next(int i, Unit& u) const {
        const long L = (long)i * G + c; if (L >= nwg) return false;
        int wgid = (int)L; { const int q = nwg / NXCD, r = nwg % NXCD, xcd = wgid % NXCD, off = wgid / NXCD; wgid = (xcd < r ? xcd * (q + 1) : r * (q + 1) + (xcd - r) * q) + off; }
        const int nig = WGM * nN, gid = wgid / nig, fm = gid * WGM, gsz = (nM - fm) < WGM ? (nM - fm) : WGM;
        u.pm = fm + ((wgid % nig) % gsz); u.pn = (wgid % nig) / gsz; return true;
    }
    __device__ __forceinline__ void a_ready(const Unit&) const {}
    __device__ __forceinline__ void done(const Unit&) const {}
};
__device__ __forceinline__ unsigned cvt_pk_bf16(float lo, float hi) { unsigned r; asm volatile("v_cvt_pk_bf16_f32 %0, %1, %2" : "=v"(r) : "v"(lo), "v"(hi)); return r; }
struct EpiF32 {
    static constexpr bool PERM = false, AFTER_DRAIN = false;
    float* C; int ldc;
    __device__ __forceinline__ void operator()(const f32x4 (&acc)[2][2][4][2], const Unit& u, int wr, int wc, int fr, int fq) const {
        const int row0 = u.pm * BM + wr * 64 + fr, col0 = u.pn * BM + wc * 32 + 4 * fq;
#pragma unroll
        for (int ai = 0; ai < 2; ++ai)
#pragma unroll
            for (int m = 0; m < 4; ++m) { float* rowp = C + (size_t)(row0 + ai * HALF + m * 16) * ldc + col0;
#pragma unroll
                for (int bj = 0; bj < 2; ++bj)
#pragma unroll
                    for (int n = 0; n < 2; ++n) *(f32x4*)(rowp + bj * HALF + n * 16) = acc[ai][bj][m][n]; }
    }
};
struct EpiNull {
    static constexpr bool PERM = true, AFTER_DRAIN = false;
    __device__ __forceinline__ void operator()(const f32x4 (&acc)[2][2][4][2], const Unit&, int, int, int, int) const {
#pragma unroll
        for (int ai = 0; ai < 2; ++ai)
#pragma unroll
            for (int bj = 0; bj < 2; ++bj) asm volatile("" :: "v"(acc[ai][bj][0][0]), "v"(acc[ai][bj][0][1]), "v"(acc[ai][bj][1][0]), "v"(acc[ai][bj][1][1]), "v"(acc[ai][bj][2][0]), "v"(acc[ai][bj][2][1]), "v"(acc[ai][bj][3][0]), "v"(acc[ai][bj][3][1]));
    }
};
struct EpiProj {
    static constexpr bool PERM = true, AFTER_DRAIN = false;
    bf16_t* PB; bf16_t* PF;
    __device__ __forceinline__ void operator()(const f32x4 (&acc)[2][2][4][2], const Unit& u, int wr, int wc, int fr, int fq) const {
        const int row0 = u.pm * BM + wr * 64 + fr;
        if (u.pn < 7) { const int c0 = u.pn * BM + wc * 32 + 8 * fq;
#pragma unroll
            for (int ai = 0; ai < 2; ++ai)
#pragma unroll
                for (int m = 0; m < 4; ++m) { bf16_t* rowp = PB + (size_t)(row0 + ai * HALF + m * 16) * 1792 + c0;
#pragma unroll
                    for (int bj = 0; bj < 2; ++bj) { const f32x4 v0 = acc[ai][bj][m][0], v1 = acc[ai][bj][m][1];
                        u32x4 w; w.x = cvt_pk_bf16(v0[0], v0[1]); w.y = cvt_pk_bf16(v0[2], v0[3]); w.z = cvt_pk_bf16(v1[0], v1[1]); w.w = cvt_pk_bf16(v1[2], v1[3]);
                        *(u32x4*)(rowp + bj * HALF) = w; } }
        } else { const int c0 = (u.pn - 7) * BM + wc * 32 + 8 * fq;
#pragma unroll
            for (int ai = 0; ai < 2; ++ai)
#pragma unroll
                for (int m = 0; m < 4; ++m) { bf16_t* rowp = PF + (size_t)(row0 + ai * HALF + m * 16) * 1280 + c0;
#pragma unroll
                    for (int bj = 0; bj < 2; ++bj) { const f32x4 v0 = acc[ai][bj][m][0], v1 = acc[ai][bj][m][1];
                        u32x4 w; w.x = cvt_pk_bf16(v0[0], v0[1]); w.y = cvt_pk_bf16(v0[2], v0[3]); w.z = cvt_pk_bf16(v1[0], v1[1]); w.w = cvt_pk_bf16(v1[2], v1[3]);
                        *(u32x4*)(rowp + bj * HALF) = w; } }
        }
    }
};
struct EpiRes {
    static constexpr bool PERM = false, AFTER_DRAIN = false;
    const float* xin; float* xout; const float* gate;
    __device__ __forceinline__ void operator()(const f32x4 (&acc)[2][2][4][2], const Unit& u, int wr, int wc, int fr, int fq) const {
        const int row0 = u.pm * BM + wr * 64 + fr, col0 = u.pn * BM + wc * 32 + 4 * fq;
        const float* gp = gate + (size_t)((u.pm * BM) >> 12) * 6144 + col0;
        f32x4 gv[2][2];
#pragma unroll
        for (int bj = 0; bj < 2; ++bj)
#pragma unroll
            for (int n = 0; n < 2; ++n) gv[bj][n] = *(const f32x4*)(gp + bj * HALF + n * 16);
#pragma unroll
        for (int ai = 0; ai < 2; ++ai)
#pragma unroll
            for (int m = 0; m < 4; ++m) { const size_t ro = (size_t)(row0 + ai * HALF + m * 16) * 1024 + col0;
#pragma unroll
                for (int bj = 0; bj < 2; ++bj)
#pragma unroll
                    for (int n = 0; n < 2; ++n) { const f32x4 xv = *(const f32x4*)(xin + ro + bj * HALF + n * 16); *(f32x4*)(xout + ro + bj * HALF + n * 16) = xv + gv[bj][n] * acc[ai][bj][m][n]; } }
    }
};
__device__ __forceinline__ float swiglu1(float glu, float lin) {
    glu = fminf(glu, 7.0f); lin = fminf(fmaxf(lin, -7.0f), 7.0f);
    return glu * (1.0f / (1.0f + __expf(-1.702f * glu))) * (lin + 1.0f);
}
struct EpiSwiglu {
    static constexpr bool PERM = true, AFTER_DRAIN = false;
    bf16_t* O; const float* b1;
    __device__ __forceinline__ void operator()(const f32x4 (&acc)[2][2][4][2], const Unit& u, int wr, int wc, int fr, int fq) const {
        const int e = u.pn >> 3, j = u.pn & 7, row0 = u.pm * BM + wr * 64 + fr, c0 = 128 * j + wc * 32 + 8 * fq;
        const float* bp = b1 + (size_t)e * 2048 + c0;
        f32x4 bg[2], bl[2];
#pragma unroll
        for (int n = 0; n < 2; ++n) { bg[n] = *(const f32x4*)(bp + 4 * n); bl[n] = *(const f32x4*)(bp + 1024 + 4 * n); }
#pragma unroll
        for (int ai = 0; ai < 2; ++ai)
#pragma unroll
            for (int m = 0; m < 4; ++m) { bf16_t* rowp = O + (size_t)(row0 + ai * HALF + m * 16) * 1024 + c0;
                const f32x4 g0 = acc[ai][0][m][0] + bg[0], g1 = acc[ai][0][m][1] + bg[1], l0 = acc[ai][1][m][0] + bl[0], l1 = acc[ai][1][m][1] + bl[1];
                u32x4 w;
                w.x = cvt_pk_bf16(swiglu1(g0[0], l0[0]), swiglu1(g0[1], l0[1])); w.y = cvt_pk_bf16(swiglu1(g0[2], l0[2]), swiglu1(g0[3], l0[3]));
                w.z = cvt_pk_bf16(swiglu1(g1[0], l1[0]), swiglu1(g1[1], l1[1])); w.w = cvt_pk_bf16(swiglu1(g1[2], l1[2]), swiglu1(g1[3], l1[3]));
                *(u32x4*)rowp = w; }
    }
};
struct EpiY {
    static constexpr bool PERM = true, AFTER_DRAIN = false;
    bf16_t* O; const float* b2;
    __device__ __forceinline__ void operator()(const f32x4 (&acc)[2][2][4][2], const Unit& u, int wr, int wc, int fr, int fq) const {
        const int e = u.pn >> 2, j = u.pn & 3, row0 = u.pm * BM + wr * 64 + fr, c0 = 256 * j + wc * 32 + 8 * fq;
        const float* bp = b2 + (size_t)e * 1024 + c0;
        f32x4 bv[2][2];
#pragma unroll
        for (int bj = 0; bj < 2; ++bj)
#pragma unroll
            for (int n = 0; n < 2; ++n) bv[bj][n] = *(const f32x4*)(bp + bj * HALF + 4 * n);
#pragma unroll
        for (int ai = 0; ai < 2; ++ai)
#pragma unroll
            for (int m = 0; m < 4; ++m) { bf16_t* rowp = O + (size_t)(row0 + ai * HALF + m * 16) * 1024 + c0;
#pragma unroll
                for (int bj = 0; bj < 2; ++bj) { const f32x4 v0 = acc[ai][bj][m][0] + bv[bj][0], v1 = acc[ai][bj][m][1] + bv[bj][1];
                    u32x4 w; w.x = cvt_pk_bf16(v0[0], v0[1]); w.y = cvt_pk_bf16(v0[2], v0[3]); w.z = cvt_pk_bf16(v1[0], v1[1]); w.w = cvt_pk_bf16(v1[2], v1[3]);
                    *(u32x4*)(rowp + bj * HALF) = w; } }
    }
};
struct MoeOrder {
    const PG8_LAS int* tab; int NJ, G, c;
    __device__ __forceinline__ bool next(int i, Unit& u) const {
        const int T = tab[0]; const long L = (long)i * G + c; if (L >= (long)T * NJ) return false;
        const int pm = (int)(L / NJ), j = (int)(L % NJ);
        u.pm = pm; u.pn = tab[1 + pm] * NJ + j; return true;
    }
    __device__ __forceinline__ void a_ready(const Unit&) const {}
    __device__ __forceinline__ void done(const Unit&) const {}
    const PG8_LAS int* tst; const PG8_LAS int* cnt; const int* list;
    __device__ __forceinline__ int row_of(const Unit& u, int r) const { const int e = tab[1 + u.pm], idx = 256 * (u.pm - tst[e]) + r; return (idx < cnt[e]) ? list[e * 32768 + idx] : 0; }
};

template <class Epi, class Sched, bool ALIGN_EPI = false, bool SP2 = false, bool GATHER = false>
__device__ __forceinline__ void gemm_phase(PG8_LAS unsigned char* lds, const Gemm g, const Sched& S, const Epi& E, int tid_in) {
    int tid_ = tid_in; asm volatile("" : "+v"(tid_));
    const int tid = tid_, wid = __builtin_amdgcn_readfirstlane(tid >> 6), lane = tid & 63, wr = wid >> 2, wc = wid & 3, fr = lane & 15, fq = lane >> 4;
    const int K = g.K, nt = K / BK;
    unsigned voffA[2], voffB[2];
#pragma unroll
    for (int i = 0; i < 2; ++i) { int R, C; stage_rc(tid * 16 + i * 8192, R, C); const int Rb = Epi::PERM ? ((R & ~31) + perm32(R & 31)) : R;
        voffA[i] = (unsigned)(R * K + C) * 2u; voffB[i] = (unsigned)(Rb * K + C) * 2u; }
    static_assert(!GATHER || SP2, "gathered A rows: only the two-super-phase loop is wired");
    unsigned cvo[2][2], nvo[2][2];
#define PG8_ROWS(dst, u_) do { _Pragma("unroll") for (int h_ = 0; h_ < 2; ++h_) _Pragma("unroll") for (int i_ = 0; i_ < 2; ++i_) { int R_, C_; stage_rc(tid * 16 + i_ * 8192, R_, C_); dst[h_][i_] = (unsigned)(S.row_of(u_, h_ * HALF + R_) * K + C_) * 2u; } } while (0)
#define PG8_STAGE_A(bufoff, gbase, half, nx) do { if constexpr (GATHER) { unsigned o_[2]; o_[0] = (nx) ? nvo[half][0] : cvo[half][0]; o_[1] = (nx) ? nvo[half][1] : cvo[half][1]; PG8_STAGE(bufoff, gbase, o_); } else { PG8_STAGE(bufoff, (gbase) + (half) * hstep, voffA); } } while (0)
    const size_t kstep = (size_t)(BK * 2);
    const size_t hstep = (size_t)HALF * K * 2;
    const size_t tstep = 2 * hstep;
    const unsigned ldsw = (unsigned)wid * 1024u;
    const int aoff = lds_byte(wr * 64 + fr, fq * 8), boff = lds_byte(wc * 32 + fr, fq * 8);
#define PG8_SA(b, h) (((b) * 2 + (h)) * HTB)
#define PG8_SB(b, h) ((4 + (b) * 2 + (h)) * HTB)
#define PG8_STAGE(bufoff, gbase, voff) do { _Pragma("unroll") for (int _i = 0; _i < 2; ++_i) \
        __builtin_amdgcn_global_load_lds((const unsigned*)((const char*)(gbase) + (voff)[_i]), (PG8_LAS unsigned*)(lds + (bufoff) + ldsw + _i * 8192), 16, 0, 0); } while (0)
#define PG8_LDA(dst, b, h) do { _Pragma("unroll") for (int m = 0; m < 4; ++m) _Pragma("unroll") for (int k = 0; k < 2; ++k) dst[m][k] = *(const PG8_LAS bf16x8*)(lds + PG8_SA(b, h) + aoff + m * 2048 + k * 1024); } while (0)
#define PG8_LDB(dst, b, h) do { _Pragma("unroll") for (int n = 0; n < 2; ++n) _Pragma("unroll") for (int k = 0; k < 2; ++k) dst[n][k] = *(const PG8_LAS bf16x8*)(lds + PG8_SB(b, h) + boff + n * 2048 + k * 1024); } while (0)
#define PG8_MMA(ai, bj, At, Bt) do { __builtin_amdgcn_s_setprio(1); _Pragma("unroll") for (int m = 0; m < 4; ++m) _Pragma("unroll") for (int n = 0; n < 2; ++n) _Pragma("unroll") for (int k = 0; k < 2; ++k) \
        acc[ai][bj][m][n] = __builtin_amdgcn_mfma_f32_16x16x32_bf16(Bt[n][k], At[m][k], acc[ai][bj][m][n], 0, 0, 0); __builtin_amdgcn_s_setprio(0); } while (0)
#define PG8_WAIT_V(n) asm volatile("s_waitcnt vmcnt(" #n ")" ::: "memory")
#define PG8_WAIT_L(n) asm volatile("s_waitcnt lgkmcnt(" #n ")" ::: "memory")
#define PG8_BAR __builtin_amdgcn_s_barrier()
#define PG8_SCHED __builtin_amdgcn_sched_barrier(0)
    Unit cur, nxt; int ui = 0;
    if (!S.next(0, cur)) return;
    f32x4 acc[2][2][4][2];
#pragma unroll
    for (int a = 0; a < 2; ++a)
#pragma unroll
        for (int b = 0; b < 2; ++b)
#pragma unroll
            for (int m = 0; m < 4; ++m)
#pragma unroll
                for (int n = 0; n < 2; ++n) acc[a][b][m][n] = (f32x4){0.f, 0.f, 0.f, 0.f};
    bf16x8 At[4][2], B0[2][2], B1[2][2];
    const char* cA = (const char*)g.A + (GATHER ? (size_t)0 : (size_t)cur.pm * tstep); const char* cB = (const char*)g.Bt + (size_t)cur.pn * tstep;
    if constexpr (GATHER) { PG8_ROWS(cvo, cur); }
    S.a_ready(cur);
    if constexpr (SP2) {
        PG8_STAGE(PG8_SB(0, 0), cB, voffB); PG8_STAGE(PG8_SB(0, 1), cB + hstep, voffB); PG8_STAGE_A(PG8_SA(0, 0), cA, 0, false); PG8_STAGE_A(PG8_SA(0, 1), cA, 1, false);
        if (wr == 1) PG8_BAR;
        PG8_WAIT_V(2); PG8_BAR;
        PG8_STAGE(PG8_SB(1, 0), cB + kstep, voffB); PG8_STAGE_A(PG8_SA(1, 0), cA + kstep, 0, false); PG8_STAGE(PG8_SB(1, 1), cB + hstep + kstep, voffB);
        PG8_WAIT_V(6); PG8_BAR;
    } else {
        PG8_STAGE(PG8_SB(0, 0), cB, voffB); PG8_STAGE(PG8_SA(0, 0), cA, voffA); PG8_STAGE(PG8_SB(0, 1), cB + hstep, voffB); PG8_STAGE(PG8_SA(0, 1), cA + hstep, voffA);
        if (wr == 1) PG8_BAR;
        PG8_WAIT_V(4); PG8_BAR;
        PG8_STAGE(PG8_SB(1, 0), cB + kstep, voffB); PG8_STAGE(PG8_SA(1, 0), cA + kstep, voffA); PG8_STAGE(PG8_SB(1, 1), cB + hstep + kstep, voffB);
        PG8_WAIT_V(6); PG8_BAR;
    }
    for (;;) {
        const bool has_next = S.next(ui + 1, nxt);
        const char* nA = GATHER ? (const char*)g.A : (has_next ? (const char*)g.A + (size_t)nxt.pm * tstep : cA); const char* nB = has_next ? (const char*)g.Bt + (size_t)nxt.pn * tstep : cB;
        if constexpr (GATHER) { if (has_next) { PG8_ROWS(nvo, nxt); } else { _Pragma("unroll") for (int h_ = 0; h_ < 2; ++h_) { nvo[h_][0] = cvo[h_][0]; nvo[h_][1] = cvo[h_][1]; } } }
        for (int t = 0; t < nt; t += 2) {
            const bool last = (t == nt - 2);
            const char* a1 = cA + (size_t)(t + 1) * kstep;
            const char* a2 = last ? nA : cA + (size_t)(t + 2) * kstep; const char* b2 = last ? nB : cB + (size_t)(t + 2) * kstep;
            const char* a3 = a2 + kstep; const char* b3 = b2 + kstep;
            if (last && has_next) S.a_ready(nxt);
            if constexpr (SP2) {
            PG8_LDB(B0, 0, 0); PG8_LDB(B1, 0, 1); PG8_SCHED; PG8_LDA(At, 0, 0); PG8_STAGE_A(PG8_SA(1, 1), a1, 1, false);
            PG8_WAIT_V(8); PG8_WAIT_L(0); PG8_BAR; PG8_MMA(0, 0, At, B0); PG8_MMA(0, 1, At, B1); PG8_BAR; PG8_SCHED;
            PG8_LDA(At, 0, 1); PG8_STAGE(PG8_SB(0, 0), b2, voffB); PG8_STAGE(PG8_SB(0, 1), b2 + hstep, voffB); PG8_STAGE_A(PG8_SA(0, 0), a2, 0, last);
            PG8_WAIT_V(8); PG8_WAIT_L(0); PG8_BAR; PG8_MMA(1, 0, At, B0); PG8_MMA(1, 1, At, B1); PG8_BAR; PG8_SCHED;
            PG8_LDB(B0, 1, 0); PG8_LDB(B1, 1, 1); PG8_SCHED; PG8_LDA(At, 1, 0); PG8_STAGE_A(PG8_SA(0, 1), a2, 1, last);
            PG8_WAIT_V(8); PG8_WAIT_L(0); PG8_BAR; PG8_MMA(0, 0, At, B0); PG8_MMA(0, 1, At, B1); PG8_BAR; PG8_SCHED;
            PG8_LDA(At, 1, 1); PG8_STAGE(PG8_SB(1, 0), b3, voffB); PG8_STAGE(PG8_SB(1, 1), b3 + hstep, voffB); PG8_STAGE_A(PG8_SA(1, 0), a3, 0, last);
            PG8_WAIT_V(8); PG8_WAIT_L(0); PG8_BAR; PG8_MMA(1, 0, At, B0); PG8_MMA(1, 1, At, B1); PG8_BAR; PG8_SCHED;
            } else {
            PG8_LDB(B0, 0, 0); PG8_SCHED; PG8_LDA(At, 0, 0); PG8_STAGE(PG8_SA(1, 1), a1 + hstep, voffA);
            PG8_WAIT_L(8); PG8_BAR; PG8_WAIT_L(0); PG8_MMA(0, 0, At, B0); PG8_BAR; PG8_SCHED;
            PG8_LDB(B1, 0, 1); PG8_STAGE(PG8_SB(0, 0), b2, voffB);
            PG8_BAR; PG8_WAIT_L(0); PG8_MMA(0, 1, At, B1); PG8_BAR;
            PG8_LDA(At, 0, 1); PG8_STAGE(PG8_SA(0, 0), a2, voffA);
            PG8_BAR; PG8_WAIT_L(0); PG8_MMA(1, 0, At, B0); PG8_BAR; PG8_SCHED;
            PG8_STAGE(PG8_SB(0, 1), b2 + hstep, voffB);
            PG8_WAIT_V(6); PG8_BAR; PG8_MMA(1, 1, At, B1); PG8_BAR;
            PG8_LDB(B0, 1, 0); PG8_SCHED; PG8_LDA(At, 1, 0); PG8_STAGE(PG8_SA(0, 1), a2 + hstep, voffA);
            PG8_WAIT_L(8); PG8_BAR; PG8_WAIT_L(0); PG8_MMA(0, 0, At, B0); PG8_BAR; PG8_SCHED;
            PG8_LDB(B1, 1, 1); PG8_STAGE(PG8_SB(1, 0), b3, voffB);
            PG8_BAR; PG8_WAIT_L(0); PG8_MMA(0, 1, At, B1); PG8_BAR;
            PG8_LDA(At, 1, 1); PG8_STAGE(PG8_SA(1, 0), a3, voffA);
            PG8_BAR; PG8_WAIT_L(0); PG8_MMA(1, 0, At, B0); PG8_BAR; PG8_SCHED;
            PG8_STAGE(PG8_SB(1, 1), b3 + hstep, voffB);
            PG8_WAIT_V(6); PG8_BAR; PG8_MMA(1, 1, At, B1); PG8_BAR;
            }
        }
        if constexpr (ALIGN_EPI) { if (wr == 0) PG8_BAR; }
        if constexpr (!Epi::AFTER_DRAIN) { E(acc, cur, wr, wc, fr, fq); S.done(cur); }
        if (!has_next) break;
#pragma unroll
        for (int a = 0; a < 2; ++a)
#pragma unroll
            for (int b = 0; b < 2; ++b)
#pragma unroll
                for (int m = 0; m < 4; ++m)
#pragma unroll
                    for (int n = 0; n < 2; ++n) acc[a][b][m][n] = (f32x4){0.f, 0.f, 0.f, 0.f};
        cur = nxt; cA = nA; cB = nB; ++ui;
        if constexpr (GATHER) { _Pragma("unroll") for (int h_ = 0; h_ < 2; ++h_) { cvo[h_][0] = nvo[h_][0]; cvo[h_][1] = nvo[h_][1]; } }
        if constexpr (ALIGN_EPI) { if (wr == 1) PG8_BAR; }
    }
    PG8_WAIT_V(0);
    if constexpr (!ALIGN_EPI) { if (wr == 0) PG8_BAR; }
    PG8_BAR;
    if constexpr (Epi::AFTER_DRAIN) { E.fused(acc, cur, wr, wc, fr, fq, lds, wid, lane); S.done(cur); }
#undef PG8_SA
#undef PG8_SB
#undef PG8_STAGE
#undef PG8_STAGE_A
#undef PG8_ROWS
#undef PG8_LDA
#undef PG8_LDB
#undef PG8_MMA
#undef PG8_WAIT_V
#undef PG8_WAIT_L
#undef PG8_BAR
#undef PG8_SCHED
}
}

constexpr int NWAVES = 8;
constexpr int NB = 8, SEQ = 4096, DM = 1024, MTOK = NB * SEQ, NLAYER = 2;
constexpr int INC = 2984, INCP = 3072;
constexpr int C_RET = 0, C_RW = 1024, C_DSA = 1920, C_SB = 2216;
constexpr int PBW = 1792, PFW = 1280, PB_SB = 1024, PF_DSA = 896;
constexpr int NEXP = 32, MOE_ROWS = MTOK * 4 + NEXP * 256;
constexpr int ROPE_W = 88;
constexpr int NCH = 16, TCH = SEQ / NCH;
constexpr int NPL = 11, NPHASE = 1 + NLAYER * NPL;
enum { I_X = 0, I_C, I_POS, I_ADAW, I_ADAB, I_NMIX, I_NFFN, I_WIN, I_RETGN, I_MU, I_W0, I_W2, I_A0, I_A2, I_G2, I_KK, I_KA, I_RK, I_LN, I_QNORM, I_WQ, I_WQI, I_DONORM, I_SONORM, I_WOUT, I_RW, I_RB, I_MW1, I_MB1, I_MW2, I_MB2, I_NFINAL, N_IN };

constexpr size_t MiB = 1u << 20;
constexpr size_t WS_CTL = 0, CTL_ZERO_BYTES = 1 * MiB;
constexpr size_t WS_MOD = 1 * MiB, WS_ROPE = 2 * MiB, WS_WIN = 14 * MiB, WS_WOUT = 26 * MiB, WS_W1 = 30 * MiB, WS_W2 = 286 * MiB;
constexpr size_t WS_XA = 414 * MiB, WS_H = 542 * MiB, WS_MIX = 606 * MiB, WS_TOPI = 670 * MiB, WS_TOPW = 671 * MiB, WS_POS = 672 * MiB;
constexpr size_t WS_R = 674 * MiB;
constexpr size_t WS_PB = WS_R  , WS_PF = WS_R + 112 * MiB  , WS_RWA = 946 * MiB  , WS_DQ = 1314 * MiB  , WS_DKB = 1330 * MiB  , WS_DVB = 1334 * MiB  , WS_DQI = 1346 * MiB  , WS_DKI = 1394 * MiB  , WS_DW = 1398 * MiB;
constexpr size_t WS_SMALLW = 1338 * MiB  ;
constexpr int SMW_QI = 0, SMW_W2 = 512 * 128, SMW_A2 = SMW_W2 + 256 * 32, SMW_G2 = SMW_A2 + 256 * 32, SMW_LAYER = SMW_G2 + 256 * 64;
constexpr size_t WS_PT = 1362 * MiB  ;
constexpr size_t WS_CH = WS_H  , WS_SI = WS_H + 16 * MiB  , WS_SIR = WS_H + 24 * MiB  ,
                 WS_CHR = WS_H + 32 * MiB  , WS_PTR = WS_H + 40 * MiB  ;
constexpr size_t WS_SQ = WS_MIX  , WS_SK = WS_MIX + 16 * MiB, WS_SV = WS_MIX + 32 * MiB;
constexpr size_t WS_YO = 1400 * MiB  , WS_SC = 1528 * MiB  ;
constexpr size_t WS_XS = WS_R  , WS_ACT = 946 * MiB  ;
constexpr size_t WS_LIST = 2040 * MiB  , WS_END = 2044 * MiB;
constexpr int LCAP = 32768;
static_assert((size_t)MOE_ROWS * 2048 <= 272 * MiB, "moe buffers");
constexpr int CW_TMO = 0, CW_CODE = 1, CW_GCNT = 256  , CW_DSAQ = 1024  , CW_BAR = 4096, CW_BLKCNT = 16384  ;
constexpr int RING_BYTES = 131072, MISC_OFF = RING_BYTES + 320, TST_OFF = RING_BYTES + 1024  , TAB_OFF = RING_BYTES + 2048  , HIST_OFF = RING_BYTES + 5120  , BASE_OFF = RING_BYTES + 5376  , CNT_OFF = RING_BYTES + 5632  , TEXP_OFF = RING_BYTES + 6144  , LDS_BYTES = 147456;

#if defined(__HIP_DEVICE_COMPILE__)
#define GAS __attribute__((address_space(1)))
#define CAS __attribute__((address_space(4)))
#else
#define GAS
#define CAS
#endif
#define LAS __attribute__((address_space(3)))
typedef unsigned short bf16;
typedef unsigned v4u __attribute__((ext_vector_type(4)));
typedef unsigned v2u __attribute__((ext_vector_type(2)));
typedef float f32x4 __attribute__((ext_vector_type(4)));
typedef GAS unsigned gu32;
typedef short bf16x8v __attribute__((ext_vector_type(8)));
typedef short s16x4v __attribute__((ext_vector_type(4)));
typedef _Float16 f16x8 __attribute__((ext_vector_type(8)));
#define RLX_AGENT __ATOMIC_RELAXED, __HIP_MEMORY_SCOPE_AGENT
#define LDS_WAIT() asm volatile("s_waitcnt lgkmcnt(0)" ::: "memory")
#define VM_WAIT() asm volatile("s_waitcnt vmcnt(0)" ::: "memory")
__device__ __forceinline__ unsigned f2bf(float f) { unsigned u = __builtin_bit_cast(unsigned, f); return (u + 0x7fffu + ((u >> 16) & 1u)) >> 16; }
__device__ __forceinline__ unsigned pk2(float lo, float hi) { return f2bf(lo) | (f2bf(hi) << 16); }
__device__ __forceinline__ float bf_lo(unsigned w) { return __builtin_bit_cast(float, w << 16); }
__device__ __forceinline__ float bf_hi(unsigned w) { return __builtin_bit_cast(float, w & 0xffff0000u); }
__device__ __forceinline__ float wave_sum(float v) {
#pragma unroll
    for (int o = 1; o < 64; o <<= 1) v += __shfl_xor(v, o);
    return v;
}
__device__ __forceinline__ float wave_max(float v) {
#pragma unroll
    for (int o = 1; o < 64; o <<= 1) v = fmaxf(v, __shfl_xor(v, o));
    return v;
}
__device__ __forceinline__ float grp16_sum(float v) { v += __shfl_xor(v, 1); v += __shfl_xor(v, 2); v += __shfl_xor(v, 4); v += __shfl_xor(v, 8); return v; }
__device__ __forceinline__ float grp8_sum(float v) { v += __shfl_xor(v, 1); v += __shfl_xor(v, 2); v += __shfl_xor(v, 4); return v; }
__device__ __forceinline__ float sum4(f32x4 a) { return (a.x + a.y) + (a.z + a.w); }
__device__ __forceinline__ float dot4(f32x4 a, f32x4 b) { return (a.x * b.x + a.y * b.y) + (a.z * b.z + a.w * b.w); }
__device__ __forceinline__ float fexp(float x) { return __builtin_amdgcn_exp2f(x * 1.4426950408889634f); }
__device__ __forceinline__ float sigm(float x) { return __builtin_amdgcn_rcpf(1.0f + fexp(-x)); }
__device__ __forceinline__ float softplusf(float x) { return fmaxf(x, 0.0f) + 0.6931471805599453f * __builtin_amdgcn_logf(1.0f + fexp(-fabsf(x))); }
__device__ __forceinline__ float ftanh(float x) { const float e = fexp(-2.0f * fabsf(x)); const float t = (1.0f - e) * __builtin_amdgcn_rcpf(1.0f + e); return x < 0.0f ? -t : t; }
__device__ __forceinline__ f32x4 shx4(f32x4 v, int m) { f32x4 r; r.x = __shfl_xor(v.x, m); r.y = __shfl_xor(v.y, m); r.z = __shfl_xor(v.z, m); r.w = __shfl_xor(v.w, m); return r; }

#define XB_TMO      128
#define XB_XCNT(j)  (256  + 64 * (j))
#define XB_XSUB(j)  (1280 + 64 * (j))
#define XB_XGEN(j)  (2304 + 64 * (j))
#define XB_TOP      3328
#define XB_TOPGEN   3392
#define XCD_BAR_WORDS 3456
#define XB_SPIN_CAP (1u << 18)

__device__ __forceinline__ unsigned xb_ld(unsigned* p)              { return __hip_atomic_load(p, __ATOMIC_RELAXED, __HIP_MEMORY_SCOPE_AGENT); }
__device__ __forceinline__ unsigned xb_add(unsigned* p, unsigned v) { return __hip_atomic_fetch_add(p, v, __ATOMIC_RELAXED, __HIP_MEMORY_SCOPE_AGENT); }
__device__ __forceinline__ unsigned xb_xcc_id() { return (unsigned)__builtin_amdgcn_s_getreg((3 << 11) | 20) & 0xFu; }
#define XB_SPIN(cond, bar) do { unsigned _sp = 0; while (cond) { __builtin_amdgcn_s_sleep(1); \
    if ((++_sp & 255u) == 0u) { if (xb_ld(&(bar)[XB_TMO])) break; if (_sp > XB_SPIN_CAP) { atomicAdd(&(bar)[XB_TMO], 1u); break; } } } } while (0)

struct XcdBarrier {
    unsigned* bar; unsigned x;
    volatile LAS unsigned* st;
};

__device__ __forceinline__ XcdBarrier xcd_barrier_post(unsigned* bar, volatile LAS unsigned* st, int xb_tid) {
    XcdBarrier b; b.bar = bar; b.x = xb_xcc_id(); b.st = st;
    if (xb_tid == 0) (void)xb_add(&bar[XB_XCNT(b.x)], 1u);
    return b;
}
__device__ __forceinline__ void xcd_barrier_complete(unsigned* bar, unsigned x, unsigned& nloc, unsigned& nx) {
    const unsigned G = gridDim.x * gridDim.y * gridDim.z;
    unsigned sum, cnt, mine, sp = 0u;
    for (;;) {
        sum = 0u; cnt = 0u; mine = 0u;
#pragma unroll
        for (unsigned j = 0; j < 16; ++j) { const unsigned c = xb_ld(&bar[XB_XCNT(j)]); sum += c; cnt += (c > 0u) ? 1u : 0u; mine = (j == x) ? c : mine; }
        if (sum == G) break;
        __builtin_amdgcn_s_sleep(1);
        if ((++sp & 255u) == 0u) { if (xb_ld(&bar[XB_TMO])) break; if (sp > XB_SPIN_CAP) { atomicAdd(&bar[XB_TMO], 1u); break; } }
    }
    nloc = mine > 0u ? mine : 1u; nx = cnt > 0u ? cnt : 1u;
}

__device__ __forceinline__ void xcd_barrier(const XcdBarrier& b, int xb_tid) {
    asm volatile("s_waitcnt vmcnt(0)" ::: "memory");
    __syncthreads();
    if (xb_tid == 0) {
        unsigned* bar = b.bar;
        __builtin_amdgcn_s_waitcnt(0);
        unsigned nloc = b.st[0], nx = b.st[1];
        if (nloc == 0u) { xcd_barrier_complete(bar, b.x, nloc, nx); b.st[0] = nloc; b.st[1] = nx; }
        const unsigned old = xb_add(&bar[XB_XSUB(b.x)], 1u);
        const unsigned gen = old / nloc;
        if (old + 1u == (gen + 1u) * nloc) {
            __builtin_amdgcn_fence(__ATOMIC_RELEASE, "agent");
            asm volatile("s_waitcnt vmcnt(0)" ::: "memory");
            const unsigned og = xb_add(&bar[XB_TOP], 1u);
            const unsigned tg = og / nx;
            if (og + 1u == (tg + 1u) * nx) xb_add(&bar[XB_TOPGEN], 1u);
            else XB_SPIN(xb_ld(&bar[XB_TOPGEN]) == tg, bar);
            __builtin_amdgcn_fence(__ATOMIC_ACQUIRE, "agent");
            xb_add(&bar[XB_XGEN(b.x)], 1u);
            asm volatile("s_waitcnt vmcnt(0)" ::: "memory");
        } else {
            XB_SPIN(xb_ld(&bar[XB_XGEN(b.x)]) == gen, bar);
            __builtin_amdgcn_fence(__ATOMIC_ACQUIRE, "agent");
            asm volatile("s_waitcnt vmcnt(0)" ::: "memory");
        }
    }
    __syncthreads();
}
struct ArgsH { const float* in[N_IN]; float* out; unsigned char* ws; double invf[44]; int ph_lo, ph_hi, li, pad; };
struct ArgsD { const GAS float* in[N_IN]; GAS float* out; GAS unsigned char* ws; double invf[44]; int ph_lo, ph_hi, li, pad; };
static_assert(sizeof(ArgsH) == sizeof(ArgsD), "args layout");
typedef const CAS ArgsD& ARef;
__device__ __forceinline__ const CAS ArgsD* kargs() {
#if defined(__HIP_DEVICE_COMPILE__)
    const CAS ArgsD* p = (const CAS ArgsD*)__builtin_amdgcn_kernarg_segment_ptr(); asm volatile("" : "+s"(p)); return p;
#else
    return nullptr;
#endif
}
struct WI { LAS unsigned char* lds; int tid, lane, wave, vcu, G, gw, NGW, bx; };
constexpr size_t RWA_STRIDE = (33 * MiB + 68 * 1024) / 4;
constexpr size_t YO_STRIDE = 32 * MiB / 4;

__device__ __forceinline__ int wave_sum_i(int v) {
#pragma unroll
    for (int o = 1; o < 64; o <<= 1) v += __shfl_xor(v, o);
    return v;
}
__device__ __forceinline__ void sincos_d(double ang, float& s, float& c) {
    const double q = __builtin_rint(ang * 0.63661977236758134308);
    double r = __builtin_fma(-q, 1.57079632679489661923, ang); r = __builtin_fma(-q, 6.123233995736766e-17, r);
    const double r2 = r * r;
    const double sp = r * (1.0 + r2 * (-1.0 / 6 + r2 * (1.0 / 120 + r2 * (-1.0 / 5040 + r2 * (1.0 / 362880 + r2 * (-1.0 / 39916800 + r2 * (1.0 / 6227020800.0)))))));
    const double cp = 1.0 + r2 * (-0.5 + r2 * (1.0 / 24 + r2 * (-1.0 / 720 + r2 * (1.0 / 40320 + r2 * (-1.0 / 3628800 + r2 * (1.0 / 479001600 + r2 * (-1.0 / 87178291200.0)))))));
    const int qi = ((int)q) & 3;
    const double ss = (qi == 0) ? sp : (qi == 1) ? cp : (qi == 2) ? -sp : -cp;
    const double cc = (qi == 0) ? cp : (qi == 1) ? -sp : (qi == 2) ? -cp : sp;
    s = (float)ss; c = (float)cc;
}

struct TrItem { const float* src; bf16* dst; int ldw; float scale; bool ok; };
__device__ __forceinline__ void tr_decode(ARef A, int it, int lane, TrItem& d) {
    constexpr int I_IN = NLAYER * 16 * 96, I_OUT = NLAYER * 16 * 32, I_W1 = NLAYER * NEXP * 16 * 64;
    const float* W; int ldw, nvalid, k0, nsrc0; bf16* WT; size_t dstrow0; float scale = 1.0f;
    int r = it;
    if (r < I_IN) { const int l = r / 1536, rr = r % 1536, kb = rr / 96, nb = rr % 96;
        const int nd = nb * 32;
        nsrc0 = (nd < 1024) ? nd : (nd < 1792) ? C_SB + (nd - 1024) : (nd < 2688) ? C_RW + (nd - 1792) : C_DSA + (nd - 2688);
        nvalid = (nd < 1024) ? 1024 : (nd < 1792) ? INC : (nd < 2688) ? C_DSA : ((nd < INC) ? C_SB : 0);
        scale = (nd >= 256 && nd < 512) ? 0.125f : (nd >= 1024 && nd < 1280) ? 0.18033688011112042f : 1.0f;
        W = A.in[I_WIN] + (size_t)l * DM * INC; ldw = INC; k0 = kb * 64; WT = (bf16*)(A.ws + WS_WIN) + (size_t)l * INCP * DM; dstrow0 = (size_t)nd; }
    else if (r < I_IN + I_OUT) { r -= I_IN; const int l = r / 512, rr = r % 512, kb = rr / 32, nb = rr % 32;
        W = A.in[I_WOUT] + (size_t)l * DM * DM; ldw = DM; nvalid = DM; k0 = kb * 64; nsrc0 = nb * 32; WT = (bf16*)(A.ws + WS_WOUT) + (size_t)l * DM * DM; dstrow0 = (size_t)nb * 32; }
    else if (r < I_IN + I_OUT + I_W1) { r -= I_IN + I_OUT; const int le = r / 1024, rr = r % 1024, kb = rr / 64, nb = rr % 64, j = nb >> 3, bj = (nb >> 2) & 1, cc0 = (nb & 3) * 32;
        W = A.in[I_MW1] + (size_t)le * DM * 2048; ldw = 2048; nvalid = 2048; k0 = kb * 64; nsrc0 = bj * 1024 + 128 * j + cc0; WT = (bf16*)(A.ws + WS_W1) + (size_t)le * 2048 * DM; dstrow0 = (size_t)nb * 32; }
    else { r -= I_IN + I_OUT + I_W1; const int le = r / 512, rr = r % 512, kb = rr / 32, nb = rr % 32;
        W = A.in[I_MW2] + (size_t)le * DM * DM; ldw = DM; nvalid = DM; k0 = kb * 64; nsrc0 = nb * 32; WT = (bf16*)(A.ws + WS_W2) + (size_t)le * DM * DM; dstrow0 = (size_t)nb * 32; }
    const int n = nsrc0 + 4 * (lane & 7);
    d.ok = n < nvalid; d.src = W + (size_t)(k0 + (lane >> 3)) * ldw + (d.ok ? n : 0); d.ldw = ldw; d.scale = scale;
    d.dst = WT + (dstrow0 + (lane >> 3)) * 1024 + k0 + 8 * (lane & 7);
}
__device__ __forceinline__ void tr_load(const TrItem& d, f32x4 (&v)[8]) {
#pragma unroll
    for (int i = 0; i < 8; ++i) v[i] = *(const f32x4*)(d.src + (size_t)(8 * i) * d.ldw);
}
__device__ __forceinline__ void tr_store(const TrItem& d, const f32x4 (&v)[8], LAS float* scr, int lane) {
    const float sc_ = d.ok ? d.scale : 0.0f;
#pragma unroll
    for (int i = 0; i < 8; ++i) { LAS float* s = scr + (8 * i + (lane >> 3)) * 33 + 4 * (lane & 7); s[0] = v[i].x * sc_; s[1] = v[i].y * sc_; s[2] = v[i].z * sc_; s[3] = v[i].w * sc_; }
    LDS_WAIT(); asm volatile("" ::: "memory");
    const int c8 = lane & 7;
#pragma unroll
    for (int j = 0; j < 4; ++j) { const int n = (lane >> 3) + 8 * j; const LAS float* s = scr + (8 * c8) * 33 + n;
        v4u o; o.x = pk2(s[0 * 33], s[1 * 33]); o.y = pk2(s[2 * 33], s[3 * 33]); o.z = pk2(s[4 * 33], s[5 * 33]); o.w = pk2(s[6 * 33], s[7 * 33]);
        *(v4u*)(d.dst + (size_t)(8 * j) * 1024) = o; }
    LDS_WAIT(); asm volatile("" ::: "memory");
}
__device__ __forceinline__ void ph_prologue(ARef A, const WI& w) {
    LAS float* sc = (LAS float*)w.lds;
    { const float* cin = A.in[I_C]; for (int i = w.tid; i < NB * DM; i += NWAVES * 64) { const float v = cin[i]; sc[i] = v / (1.0f + expf(-v)); } }
    __syncthreads();
    float* MOD = (float*)(A.ws + WS_MOD);
    LAS float* red = (LAS float*)(w.lds + 32768);
    if (w.vcu < 192) {
        const int l = w.vcu / 96, col = (w.vcu % 96) * 64 + w.lane, kw = 128 * w.wave;
        const float* wp = A.in[I_ADAW] + (size_t)l * DM * 6144 + (size_t)kw * 6144 + col;
        float acc[8];
#pragma unroll
        for (int b = 0; b < 8; ++b) acc[b] = 0.0f;
#pragma unroll 16
        for (int k = 0; k < 128; ++k) { const float wv = wp[(size_t)k * 6144];
#pragma unroll
            for (int b = 0; b < 8; ++b) acc[b] += sc[b * DM + kw + k] * wv; }
#pragma unroll
        for (int b = 0; b < 8; ++b) red[(w.wave * 8 + b) * 64 + w.lane] = acc[b];
    }
    __syncthreads();
    if (w.vcu < 192) { const int l = w.vcu / 96, b = w.wave, col = (w.vcu % 96) * 64 + w.lane;
        float s = A.in[I_ADAB][l * 6144 + col];
#pragma unroll
        for (int q = 0; q < 8; ++q) s += red[(q * 8 + b) * 64 + w.lane];
        MOD[(size_t)(l * 8 + b) * 6144 + col] = s; }
    __syncthreads();
    LAS float* scr = (LAS float*)(w.lds + 32768 + w.wave * 8448);
    constexpr int NIT = NLAYER * 16 * 96 + NLAYER * 16 * 32;
    { TrItem d0, d1; f32x4 va[8], vb[8];
      int it = w.gw; bool h0 = it < NIT;
      if (h0) { tr_decode(A, it, w.lane, d0); tr_load(d0, va); }
      while (h0) {
          it += w.NGW; const bool h1 = it < NIT;
          if (h1) { tr_decode(A, it, w.lane, d1); tr_load(d1, vb); }
          tr_store(d0, va, scr, w.lane);
          if (!h1) break;
          it += w.NGW; h0 = it < NIT;
          if (h0) { tr_decode(A, it, w.lane, d0); tr_load(d0, va); }
          tr_store(d1, vb, scr, w.lane);
      } }
    float* RT = (float*)(A.ws + WS_ROPE); const int* pos = (const int*)A.in[I_POS];
    for (int g = w.gw * 64 + w.lane; g < MTOK * 44; g += w.NGW * 64) {
        const int tok = g / 44, f = g % 44; int co, so;
        if (f < 32) { co = f; so = 32 + f; } else if (f < 40) { co = 64 + (f - 32); so = 72 + (f - 32); } else { co = 80 + (f - 40); so = 84 + (f - 40); }
        float s, c; sincos_d((double)pos[tok] * A.invf[f], s, c);
        RT[(size_t)tok * ROPE_W + co] = c; RT[(size_t)tok * ROPE_W + so] = s;
    }
}

__device__ __forceinline__ void moe_convert_chunk(ARef A, int l, int c, int lane, LAS float* scr) {
    constexpr int I0 = NLAYER * 16 * 96 + NLAYER * 16 * 32, I_W1 = NLAYER * NEXP * 16 * 64;
    const int it0 = (c < 8192) ? I0 + l * 32768 + 4 * c : I0 + I_W1 + l * 16384 + 4 * (c - 8192);
    TrItem d0, d1; f32x4 va[8], vb[8];
    tr_decode(A, it0, lane, d0); tr_load(d0, va);
    tr_decode(A, it0 + 1, lane, d1); tr_load(d1, vb);
    tr_store(d0, va, scr, lane);
    tr_decode(A, it0 + 2, lane, d0); tr_load(d0, va);
    tr_store(d1, vb, scr, lane);
    tr_decode(A, it0 + 3, lane, d1); tr_load(d1, vb);
    tr_store(d0, va, scr, lane);
    tr_store(d1, vb, scr, lane);
}

__device__ __forceinline__ void emit_h_row(const f32x4 (&v)[4], float rstd, const float* g, const float* sc, const float* sh, bf16* hrow, int lane) {
#pragma unroll
    for (int j = 0; j < 4; ++j) { const int k = 4 * (lane + 64 * j);
        const f32x4 gv = *(const f32x4*)(g + k), scv = *(const f32x4*)(sc + k), shv = *(const f32x4*)(sh + k);
        const f32x4 h = v[j] * rstd * gv * (1.0f + scv) + shv;
        v2u o; o.x = pk2(h.x, h.y); o.y = pk2(h.z, h.w); *(v2u*)(hrow + k) = o; }
}
__device__ __forceinline__ void small_weights_to_f16(ARef A, const WI& w) {
    { _Float16* SW = (_Float16*)(A.ws + WS_SMALLW);
      const int g0 = w.gw * 64 + w.lane, gs = w.NGW * 64;
      for (int l = 0; l < NLAYER; ++l) { _Float16* S = SW + (size_t)l * SMW_LAYER;
          const float* wq = A.in[I_WQ] + (size_t)l * 128 * 256; const float* wqi = A.in[I_WQI] + (size_t)l * 128 * 256;
          for (int e = g0; e < 256 * 128; e += gs) { const int n = e >> 7, k = e & 127; S[SMW_QI + e] = (_Float16)wq[k * 256 + n]; S[SMW_QI + 256 * 128 + e] = (_Float16)wqi[k * 256 + n]; }
          const float* w2 = A.in[I_W2] + (size_t)l * 32 * 256; const float* a2 = A.in[I_A2] + (size_t)l * 32 * 256; const float* g2 = A.in[I_G2] + (size_t)l * 64 * 256;
          for (int e = g0; e < 256 * 32; e += gs) { const int n = e >> 5, k = e & 31; S[SMW_W2 + e] = (_Float16)w2[k * 256 + n]; S[SMW_A2 + e] = (_Float16)a2[k * 256 + n]; }
          for (int e = g0; e < 256 * 64; e += gs) { const int n = e >> 6, k = e & 63; S[SMW_G2 + e] = (_Float16)g2[k * 256 + n]; } } }
}
__device__ __forceinline__ void ph_norm1(ARef A, const WI& w) {
    const float* MOD = (const float*)(A.ws + WS_MOD); bf16* H = (bf16*)(A.ws + WS_H);
    for (int m = w.gw; m < MTOK; m += w.NGW) {
        const float* xr = A.in[I_X] + (size_t)m * DM; f32x4 v[4]; float ss = 0.0f;
#pragma unroll
        for (int j = 0; j < 4; ++j) { v[j] = *(const f32x4*)(xr + 4 * (w.lane + 64 * j)); ss += dot4(v[j], v[j]); }
        ss = wave_sum(ss); const float rstd = 1.0f / sqrtf(ss * (1.0f / DM) + 1e-5f);
        const float* mb = MOD + (size_t)(m >> 12) * 6144;
        emit_h_row(v, rstd, A.in[I_NMIX], mb + 1024, mb, H + (size_t)m * DM, w.lane);
    }
}

typedef _Float16 h4v __attribute__((ext_vector_type(4)));
__device__ __forceinline__ f16x8 pack_f16x8(f32x4 a, f32x4 b) { f16x8 r; r[0] = (_Float16)a.x; r[1] = (_Float16)a.y; r[2] = (_Float16)a.z; r[3] = (_Float16)a.w; r[4] = (_Float16)b.x; r[5] = (_Float16)b.y; r[6] = (_Float16)b.z; r[7] = (_Float16)b.w; return r; }
#define RW_STB4(k_, val_) do { v2u w_; w_.x = pk2((val_).x, (val_).y); w_.y = pk2((val_).z, (val_).w); *(v2u*)((bf16*)(RWA + (k_) * RWA_STRIDE) + o) = w_; } while (0)
#ifndef RWKV_RKV_BF16
#define RWKV_RKV_BF16 1
#endif
#if RWKV_RKV_BF16
#define RW_ST_RKV(k_, val_) RW_STB4(k_, val_)
#else
#define RW_ST_RKV(k_, val_) (*(f32x4*)(RWA + (k_) * RWA_STRIDE + o) = (val_))
#endif
__device__ __forceinline__ f32x4 ldb4(const bf16* q) { const v2u x = *(const v2u*)q; return (f32x4){bf_lo(x.x), bf_hi(x.x), bf_lo(x.y), bf_hi(x.y)}; }
__device__ __forceinline__ void prep16_body(const bf16* __restrict__ P, float* __restrict__ RWA, const _Float16* __restrict__ SW, const float* __restrict__ RT, bf16* __restrict__ DQ, _Float16* __restrict__ DQI,
                                            bf16* __restrict__ DKB, bf16* __restrict__ DVB, _Float16* __restrict__ DKI, float* __restrict__ DW, const float* __restrict__ mu, const float* __restrict__ qn,
                                            const float* __restrict__ w0p, const float* __restrict__ a0p, const float* __restrict__ kkp, const float* __restrict__ kap, const float* __restrict__ rkp, int m0, int lane_in, int part = 7) {
    int lane = lane_in; asm volatile("" : "+v"(lane));
    const int tk = lane & 15, q4 = lane >> 4, m = m0 + tk, t = m & (SEQ - 1);
    const bf16* pr = P + (size_t)m * PFW; const bf16* pp = pr - PFW; const bf16* pd = P + (size_t)m * PFW + PF_DSA;
    RT += (size_t)m * ROPE_W; const f32x4 zero4 = {0.f, 0.f, 0.f, 0.f};
    f16x8 bx[4], bc[4];
    { float ss = 0.0f; f32x4 c[4][2];
#pragma unroll
      for (int ks = 0; ks < 4; ++ks) { const int f0 = 32 * ks + 8 * q4;
          f32x4 x[2];
#pragma unroll
          for (int u = 0; u < 2; ++u) { const f32x4 z = ldb4(pr + 768 + f0 + 4 * u); const f32x4 p = t ? ldb4(pp + 768 + f0 + 4 * u) : zero4; x[u] = z + (p - z) * *(const f32x4*)(mu + 768 + f0 + 4 * u);
#pragma unroll
              for (int i = 0; i < 4; ++i) x[u][i] = (ks == 0) ? ftanh(x[u][i]) : (ks == 1) ? x[u][i] : sigm(x[u][i]); }
          bx[ks] = pack_f16x8(x[0], x[1]);
          c[ks][0] = ldb4(pd + f0); c[ks][1] = ldb4(pd + f0 + 4); ss += dot4(c[ks][0], c[ks][0]) + dot4(c[ks][1], c[ks][1]); }
      ss += __shfl_xor(ss, 16); ss += __shfl_xor(ss, 32);
      const float rstd = 1.0f / sqrtf(ss * (1.0f / 128.0f) + 1e-5f);
#pragma unroll
      for (int ks = 0; ks < 4; ++ks) { const int f0 = 32 * ks + 8 * q4; bc[ks] = pack_f16x8(c[ks][0] * rstd * *(const f32x4*)(qn + f0), c[ks][1] * rstd * *(const f32x4*)(qn + f0 + 4)); } }
    const _Float16* wrow = SW + (size_t)tk * 0;
    (void)wrow;
    const int arow = lane & 15;
    if (part & 1)
#pragma unroll 2
    for (int hd = 0; hd < 4; ++hd) {
        f32x4 fk[4], av[4]; float ssk = 0.0f;
#pragma unroll
        for (int j = 0; j < 4; ++j) { const int nb = 4 * hd + j, ch = 16 * nb + 4 * q4; const size_t o = (size_t)m * 256 + ch;
            const f16x8 aw = *(const f16x8*)(SW + SMW_W2 + (16 * nb + arow) * 32 + 8 * q4), aa = *(const f16x8*)(SW + SMW_A2 + (16 * nb + arow) * 32 + 8 * q4);
            const f16x8 ag0 = *(const f16x8*)(SW + SMW_G2 + (16 * nb + arow) * 64 + 8 * q4), ag1 = *(const f16x8*)(SW + SMW_G2 + (16 * nb + arow) * 64 + 32 + 8 * q4);
            const f32x4 cw = __builtin_amdgcn_mfma_f32_16x16x32_f16(aw, bx[0], *(const f32x4*)(w0p + ch), 0, 0, 0);
            const f32x4 ca = __builtin_amdgcn_mfma_f32_16x16x32_f16(aa, bx[1], *(const f32x4*)(a0p + ch), 0, 0, 0);
            f32x4 cg = __builtin_amdgcn_mfma_f32_16x16x32_f16(ag0, bx[2], zero4, 0, 0, 0); cg = __builtin_amdgcn_mfma_f32_16x16x32_f16(ag1, bx[3], cg, 0, 0, 0);
            f32x4 dec;
#pragma unroll
            for (int i = 0; i < 4; ++i) { dec[i] = fexp(-fexp(-softplusf(-cw[i]) - 0.5f)); av[j][i] = sigm(ca[i]); }
            *(f32x4*)(RWA + 1 * RWA_STRIDE + o) = dec; RW_STB4(6, cg);
            { const f32x4 z = ldb4(pr + 256 + ch); const f32x4 p = t ? ldb4(pp + 256 + ch) : zero4; fk[j] = z + (p - z) * *(const f32x4*)(mu + 256 + ch); }
            const f32x4 kk = fk[j] * *(const f32x4*)(kkp + ch); ssk += dot4(kk, kk); }
        ssk += __shfl_xor(ssk, 16); ssk += __shfl_xor(ssk, 32);
        const float inrm = 1.0f / fmaxf(sqrtf(ssk), 1e-12f);
        f32x4 fr[4], km[4]; float bs = 0.0f;
#pragma unroll
        for (int j = 0; j < 4; ++j) { const int ch = 16 * (4 * hd + j) + 4 * q4;
            { const f32x4 z = ldb4(pr + ch); const f32x4 p = t ? ldb4(pp + ch) : zero4; fr[j] = z + (p - z) * *(const f32x4*)(mu + ch); }
            km[j] = fk[j] * (1.0f + (av[j] - 1.0f) * *(const f32x4*)(kap + ch)); bs += dot4(fr[j] * km[j], *(const f32x4*)(rkp + ch)); }
        bs += __shfl_xor(bs, 16); bs += __shfl_xor(bs, 32);
#pragma unroll
        for (int j = 0; j < 4; ++j) { const int ch = 16 * (4 * hd + j) + 4 * q4; const size_t o = (size_t)m * 256 + ch;
            f32x4 fv; { const f32x4 z = ldb4(pr + 512 + ch); const f32x4 p = t ? ldb4(pp + 512 + ch) : zero4; fv = z + (p - z) * *(const f32x4*)(mu + 512 + ch); }
            const f32x4 kk = fk[j] * *(const f32x4*)(kkp + ch) * inrm;
            RW_ST_RKV(0, fr[j]); RW_ST_RKV(2, km[j]); RW_ST_RKV(3, fv);
            *(f32x4*)(RWA + 4 * RWA_STRIDE + o) = -kk; *(f32x4*)(RWA + 5 * RWA_STRIDE + o) = kk * av[j]; { const f32x4 bo_ = bs * fv; RW_STB4(7, bo_); } }
    }
    if (part & 2)
#pragma unroll 4
    for (int nb = 0; nb < 32; ++nb) {
        f32x4 cq = zero4;
#pragma unroll
        for (int ks = 0; ks < 4; ++ks) { const f16x8 aq = *(const f16x8*)(SW + SMW_QI + (16 * nb + arow) * 128 + 32 * ks + 8 * q4); cq = __builtin_amdgcn_mfma_f32_16x16x32_f16(aq, bc[ks], cq, 0, 0, 0); }
        const int ch = 16 * (nb & 15) + 4 * q4;
        if (nb < 16) {
            if ((nb & 3) == 0) { const f32x4 ot = shx4(cq, 32); const int fi = 4 * (q4 & 1); const f32x4 cs4 = *(const f32x4*)(RT + 64 + fi), sn = *(const f32x4*)(RT + 72 + fi); cq = (q4 < 2) ? cq * cs4 - ot * sn : ot * sn + cq * cs4; }
            const f32x4 qs = cq * 0.18033688011112042f; v2u o; o.x = pk2(qs.x, qs.y); o.y = pk2(qs.z, qs.w); *(v2u*)(DQ + (size_t)m * 256 + ch) = o;
        } else {
            if ((nb & 1) == 0) { const f32x4 ot = shx4(cq, 16); const f32x4 cs4 = *(const f32x4*)(RT + 80), sn = *(const f32x4*)(RT + 84); if (q4 < 2) cq = (q4 < 1) ? cq * cs4 - ot * sn : ot * sn + cq * cs4; }
            h4v hq; hq.x = (_Float16)cq.x; hq.y = (_Float16)cq.y; hq.z = (_Float16)cq.z; hq.w = (_Float16)cq.w; *(h4v*)(DQI + (size_t)m * 256 + ch) = hq;
        }
    }
#pragma unroll
    for (int j = 0; j < 4; ++j) { const int d = 16 * j + 4 * q4; f32x4 kx = ldb4(pd + 128 + d);
        if (j == 0) { const f32x4 ot = shx4(kx, 32); const int fi = 4 * (q4 & 1); const f32x4 cs4 = *(const f32x4*)(RT + 64 + fi), sn = *(const f32x4*)(RT + 72 + fi); kx = (q4 < 2) ? kx * cs4 - ot * sn : ot * sn + kx * cs4; }
        v2u o; o.x = pk2(kx.x, kx.y); o.y = pk2(kx.z, kx.w); *(v2u*)(DKB + (size_t)m * 64 + d) = o;
        const f32x4 vx = ldb4(pd + 192 + d); v2u ov; ov.x = pk2(vx.x, vx.y); ov.y = pk2(vx.z, vx.w); *(v2u*)(DVB + (size_t)m * 64 + d) = ov; }
#pragma unroll
    for (int j = 0; j < 2; ++j) { const int d = 16 * j + 4 * q4; f32x4 ki = ldb4(pd + 256 + d);
        if (j == 0) { const f32x4 ot = shx4(ki, 16); const f32x4 cs4 = *(const f32x4*)(RT + 80), sn = *(const f32x4*)(RT + 84); if (q4 < 2) ki = (q4 < 1) ? ki * cs4 - ot * sn : ot * sn + ki * cs4; }
        h4v hk; hk.x = (_Float16)ki.x; hk.y = (_Float16)ki.y; hk.z = (_Float16)ki.z; hk.w = (_Float16)ki.w; *(h4v*)(DKI + (size_t)m * 32 + d) = hk; }
    if (q4 < 2) *(f32x4*)(DW + (size_t)m * 8 + 4 * q4) = ldb4(pd + 288 + 4 * q4) * 0.0625f;
}

__device__ __forceinline__ void prep16(ARef A, int l, int m0, int lane_in, int part = 7) {
    prep16_body((const bf16*)(A.ws + WS_PF), (float*)(A.ws + WS_RWA), (const _Float16*)(A.ws + WS_SMALLW) + (size_t)l * SMW_LAYER, (const float*)(A.ws + WS_ROPE), (bf16*)(A.ws + WS_DQ), (_Float16*)(A.ws + WS_DQI),
                (bf16*)(A.ws + WS_DKB), (bf16*)(A.ws + WS_DVB), (_Float16*)(A.ws + WS_DKI), (float*)(A.ws + WS_DW), A.in[I_MU] + l * 896, A.in[I_QNORM] + l * 128,
                A.in[I_W0] + l * 256, A.in[I_A0] + l * 256, A.in[I_KK] + l * 256, A.in[I_KA] + l * 256, A.in[I_RK] + l * 256, m0, lane_in, part);
}
__device__ __forceinline__ float quad_sum(float v) {
    v += __builtin_bit_cast(float, __builtin_amdgcn_mov_dpp(__builtin_bit_cast(int, v), 0xB1, 0xF, 0xF, true));
    v += __builtin_bit_cast(float, __builtin_amdgcn_mov_dpp(__builtin_bit_cast(int, v), 0x4E, 0xF, 0xF, true));
    return v;
}
__device__ __forceinline__ float oct_sum(float v) {
    v += __builtin_bit_cast(float, __builtin_amdgcn_mov_dpp(__builtin_bit_cast(int, v), 0xB1, 0xF, 0xF, true));
    v += __builtin_bit_cast(float, __builtin_amdgcn_mov_dpp(__builtin_bit_cast(int, v), 0x4E, 0xF, 0xF, true));
    v += __builtin_bit_cast(float, __builtin_amdgcn_mov_dpp(__builtin_bit_cast(int, v), 0x141, 0xF, 0xF, true));
    return v;
}
typedef float f32x2 __attribute__((ext_vector_type(2)));
#define LO2(v_) __builtin_shufflevector(v_, v_, 0, 1)
#define HI2(v_) __builtin_shufflevector(v_, v_, 2, 3)
#define RW_ROW(i_) (((i_) < 2) ? (16 * ws + rg + 8 * (i_)) : (64 + 16 * ws + rg + 8 * ((i_) - 2)))
#define RW_LOAD(op, s_) do { const int lo_ = (s_) * 64 + kq * 8; \
    op[0] = *(const LAS f32x4*)(sn + lo_); op[1] = *(const LAS f32x4*)(sn + lo_ + 4); op[2] = *(const LAS f32x4*)(sw + lo_); op[3] = *(const LAS f32x4*)(sw + lo_ + 4); \
    op[4] = *(const LAS f32x4*)(sb + lo_); op[5] = *(const LAS f32x4*)(sb + lo_ + 4); op[6] = *(const LAS f32x4*)(sk + lo_); op[7] = *(const LAS f32x4*)(sk + lo_ + 4); \
    op[8] = *(const LAS f32x4*)(sr + lo_); op[9] = *(const LAS f32x4*)(sr + lo_ + 4); \
    vin[0] = sv[(s_) * 64 + 16 * ws + rg]; vin[1] = sv[(s_) * 64 + 16 * ws + rg + 8]; } while (0)
#define RW_DOT(i_, oa, ob) ({ f32x2 d_ = S[i_][0] * LO2(oa); d_ = S[i_][1] * HI2(oa) + d_; d_ = S[i_][2] * LO2(ob) + d_; d_ = S[i_][3] * HI2(ob) + d_; d_.x + d_.y; })
#define RW_STEP(op, vv, s_) do { float sa_[4], y_[4]; \
    _Pragma("unroll") for (int i_ = 0; i_ < 4; ++i_) sa_[i_] = RW_DOT(i_, op[0], op[1]); \
    _Pragma("unroll") for (int i_ = 0; i_ < 4; ++i_) sa_[i_] += __builtin_bit_cast(float, __builtin_amdgcn_mov_dpp(__builtin_bit_cast(int, sa_[i_]), 0xB1, 0xF, 0xF, true)); \
    _Pragma("unroll") for (int i_ = 0; i_ < 4; ++i_) sa_[i_] += __builtin_bit_cast(float, __builtin_amdgcn_mov_dpp(__builtin_bit_cast(int, sa_[i_]), 0x4E, 0xF, 0xF, true)); \
    _Pragma("unroll") for (int i_ = 0; i_ < 4; ++i_) sa_[i_] += __builtin_bit_cast(float, __builtin_amdgcn_mov_dpp(__builtin_bit_cast(int, sa_[i_]), 0x141, 0xF, 0xF, true)); \
    _Pragma("unroll") for (int i_ = 0; i_ < 2; ++i_) { const f32x2 a2_ = {sa_[i_], sa_[i_]}, v2_ = {vv[i_], vv[i_]}; \
        S[i_][0] = S[i_][0] * LO2(op[2]) + (a2_ * LO2(op[4]) + v2_ * LO2(op[6])); S[i_][1] = S[i_][1] * HI2(op[2]) + (a2_ * HI2(op[4]) + v2_ * HI2(op[6])); \
        S[i_][2] = S[i_][2] * LO2(op[3]) + (a2_ * LO2(op[5]) + v2_ * LO2(op[7])); S[i_][3] = S[i_][3] * HI2(op[3]) + (a2_ * HI2(op[5]) + v2_ * HI2(op[7])); } \
    _Pragma("unroll") for (int i_ = 2; i_ < 4; ++i_) { const f32x2 a2_ = {sa_[i_], sa_[i_]}; \
        S[i_][0] = S[i_][0] * LO2(op[2]) + a2_ * LO2(op[4]); S[i_][1] = S[i_][1] * HI2(op[2]) + a2_ * HI2(op[4]); S[i_][2] = S[i_][2] * LO2(op[3]) + a2_ * LO2(op[5]); S[i_][3] = S[i_][3] * HI2(op[3]) + a2_ * HI2(op[5]); } \
    _Pragma("unroll") for (int i_ = 0; i_ < 4; ++i_) y_[i_] = RW_DOT(i_, op[8], op[9]); \
    _Pragma("unroll") for (int i_ = 0; i_ < 4; ++i_) y_[i_] += __builtin_bit_cast(float, __builtin_amdgcn_mov_dpp(__builtin_bit_cast(int, y_[i_]), 0xB1, 0xF, 0xF, true)); \
    _Pragma("unroll") for (int i_ = 0; i_ < 4; ++i_) y_[i_] += __builtin_bit_cast(float, __builtin_amdgcn_mov_dpp(__builtin_bit_cast(int, y_[i_]), 0x4E, 0xF, 0xF, true)); \
    _Pragma("unroll") for (int i_ = 0; i_ < 4; ++i_) y_[i_] += __builtin_bit_cast(float, __builtin_amdgcn_mov_dpp(__builtin_bit_cast(int, y_[i_]), 0x141, 0xF, 0xF, true)); \
    if (kq == 0) { _Pragma("unroll") for (int i_ = 0; i_ < 4; ++i_) so[(s_) * 128 + RW_ROW(i_)] = y_[i_]; } } while (0)
__device__ __forceinline__ void scan_rwkv_task2(ARef A, const WI& w, int task0) {
    const int slot = w.wave >> 2, ws = w.wave & 3, lt = w.tid & 255, task = task0 + slot;
    const int bh = task >> 4, c = task & 15, b = bh >> 2, h = bh & 3;
    LAS float* sw = (LAS float*)w.lds + slot * 16384; LAS float* sn = sw + 2048; LAS float* sb = sn + 2048; LAS float* sk = sb + 2048; LAS float* sr = sk + 2048; LAS float* sv = sr + 2048; LAS float* so = sv + 2048;
    const float* RWA = (const float*)(A.ws + WS_RWA);
    const int rg = w.lane >> 3, kq = w.lane & 7;
    f32x2 S[4][4];
#pragma unroll
    for (int i = 0; i < 4; ++i)
#pragma unroll
        for (int j = 0; j < 4; ++j) { const int r = RW_ROW(i); S[i][j].x = (r >= 64 && 8 * kq + 2 * j == r - 64) ? 1.0f : 0.0f; S[i][j].y = (r >= 64 && 8 * kq + 2 * j + 1 == r - 64) ? 1.0f : 0.0f; }
    const size_t tok0 = (size_t)b * SEQ + (size_t)c * TCH;
    const int st = lt >> 3, sd = (lt & 7) * 8;
#if RWKV_RKV_BF16
    f32x4 a[3][2]; v4u ab[3];
#define RW_LD_RKV(i_, k_) ab[i_] = *(const v4u*)((const bf16*)(RWA + (k_) * RWA_STRIDE) + o_)
#define RW_GET_RKV(i_, q_) RW_UNPK(ab[i_], q_)
#else
    f32x4 a[3][2]; f32x4 af[3][2];
#define RW_LD_RKV(i_, k_) do { af[i_][0] = *(const f32x4*)(RWA + (k_) * RWA_STRIDE + o_); af[i_][1] = *(const f32x4*)(RWA + (k_) * RWA_STRIDE + o_ + 4); } while (0)
#define RW_GET_RKV(i_, q_) af[i_][q_]
#endif
#define RW_GLOAD(sub_) do { const size_t o_ = (tok0 + (sub_) * 32 + st) * 256 + h * 64 + sd; \
        _Pragma("unroll") for (int q = 0; q < 2; ++q) { a[0][q] = *(const f32x4*)(RWA + 1 * RWA_STRIDE + o_ + 4 * q); a[1][q] = *(const f32x4*)(RWA + 4 * RWA_STRIDE + o_ + 4 * q); a[2][q] = *(const f32x4*)(RWA + 5 * RWA_STRIDE + o_ + 4 * q); } \
        RW_LD_RKV(0, 2); RW_LD_RKV(1, 0); RW_LD_RKV(2, 3); } while (0)
#define RW_UNPK(x_, q_) ((q_) == 0 ? (f32x4){bf_lo((x_).x), bf_hi((x_).x), bf_lo((x_).y), bf_hi((x_).y)} : (f32x4){bf_lo((x_).z), bf_hi((x_).z), bf_lo((x_).w), bf_hi((x_).w)})
    RW_GLOAD(0);
    for (int sub = 0; sub < TCH / 32; ++sub) {
        __syncthreads();
        { const int lo = st * 64 + sd;
#pragma unroll
          for (int q = 0; q < 2; ++q) { *(LAS f32x4*)(sw + lo + 4 * q) = a[0][q]; *(LAS f32x4*)(sn + lo + 4 * q) = a[1][q]; *(LAS f32x4*)(sb + lo + 4 * q) = a[2][q]; *(LAS f32x4*)(sk + lo + 4 * q) = RW_GET_RKV(0, q); *(LAS f32x4*)(sr + lo + 4 * q) = RW_GET_RKV(1, q); *(LAS f32x4*)(sv + lo + 4 * q) = RW_GET_RKV(2, q); } }
        __syncthreads();
        if (sub + 1 < TCH / 32) RW_GLOAD(sub + 1);
        { f32x4 opA[10], opB[10]; float vin[2], vA[2], vB[2];
          RW_LOAD(opA, 0);
          vA[0] = vin[0]; vA[1] = vin[1];
#pragma unroll 1
          for (int s = 0; s < 32; s += 2) {
              RW_LOAD(opB, s + 1);
              vB[0] = vin[0]; vB[1] = vin[1];
              RW_STEP(opA, vA, s);
              if (s + 2 < 32) { RW_LOAD(opA, s + 2); vA[0] = vin[0]; vA[1] = vin[1]; }
              RW_STEP(opB, vB, s + 1);
          } }
        __syncthreads();
        { const int fs = lt >> 3, c16 = (lt & 7) * 16;
          bf16* dst = (c16 < 64) ? (bf16*)((float*)(A.ws + WS_YO) + YO_STRIDE) : ((bf16*)(A.ws + WS_PT) - 64);
          bf16* dp = dst + (tok0 + sub * 32 + fs) * 256 + h * 64 + c16;
#pragma unroll
          for (int q = 0; q < 2; ++q) { const f32x4 x0 = *(const LAS f32x4*)(so + fs * 128 + c16 + 8 * q), x1 = *(const LAS f32x4*)(so + fs * 128 + c16 + 8 * q + 4);
              v4u wv; wv.x = pk2(x0.x, x0.y); wv.y = pk2(x0.z, x0.w); wv.z = pk2(x1.x, x1.y); wv.w = pk2(x1.z, x1.w); *(v4u*)(dp + 8 * q) = wv; } }
    }
    { float* ch = (float*)(A.ws + WS_CH) + ((size_t)(bh * NCH + c) * 128) * 64 + 8 * kq;
#pragma unroll
      for (int i = 0; i < 4; ++i) { float* cr = ch + (size_t)RW_ROW(i) * 64; *(f32x4*)cr = (f32x4){S[i][0].x, S[i][0].y, S[i][1].x, S[i][1].y}; *(f32x4*)(cr + 4) = (f32x4){S[i][2].x, S[i][2].y, S[i][3].x, S[i][3].y}; } }
    __syncthreads();
}
#undef RW_LOAD
#undef RW_STEP
#undef RW_GLOAD
#undef RW_UNPK
#undef RW_LD_RKV
#undef RW_GET_RKV
#undef RW_DOT
#undef RW_ROW
__device__ __forceinline__ void scan_ret_task(ARef A, const WI& w, int task) {
    const int bh = task >> 3, cp = task & 7, b = bh >> 2, h = bh & 3, un = w.tid >> 8, lt = w.tid & 255, c = 2 * cp + un;
    const float lg2g = log2f(1.0f - exp2f(-5.0f - (float)h)), gamma = exp2f(lg2g);
    LAS float* sk = (LAS float*)w.lds + un * 8192; LAS float* sq = sk + 2048; LAS float* sv = sq + 2048; LAS float* so = sv + 2048;
    const bf16* PB = (const bf16*)(A.ws + WS_PB); const float* RT = (const float*)(A.ws + WS_ROPE);
    const int row = lt >> 2, kq = lt & 3;
    f32x2 S[8];
#pragma unroll
    for (int j = 0; j < 8; ++j) S[j] = (f32x2){0.0f, 0.0f};
    const f32x2 gam2 = {gamma, gamma};
    const size_t tok0 = (size_t)b * SEQ + (size_t)c * TCH;
    const int st = lt >> 3, sd = (lt & 7) * 8;
    const int fi = sd & 31, dp = sd ^ 32;
    f32x4 gq[2], gqo[2], gk[2], gko[2], gv[2], gcs[2], gsn[2];
#define BF8_TO_F32(dst, x_) do { dst[0] = (f32x4){bf_lo(x_.x), bf_hi(x_.x), bf_lo(x_.y), bf_hi(x_.y)}; dst[1] = (f32x4){bf_lo(x_.z), bf_hi(x_.z), bf_lo(x_.w), bf_hi(x_.w)}; } while (0)
#define RT_GLOAD(sub_) do { const size_t m_ = tok0 + (sub_) * 32 + st; const bf16* pr_ = PB + m_ * PBW + h * 64; const float* rt_ = RT + m_ * ROPE_W; \
        _Pragma("unroll") for (int u = 0; u < 2; ++u) { gcs[u] = *(const f32x4*)(rt_ + fi + 4 * u); gsn[u] = *(const f32x4*)(rt_ + 32 + fi + 4 * u); } \
        { const v4u x0 = *(const v4u*)(pr_ + sd), x1 = *(const v4u*)(pr_ + dp), x2 = *(const v4u*)(pr_ + 256 + sd), x3 = *(const v4u*)(pr_ + 256 + dp), x4 = *(const v4u*)(pr_ + 512 + sd); \
          BF8_TO_F32(gq, x0); BF8_TO_F32(gqo, x1); BF8_TO_F32(gk, x2); BF8_TO_F32(gko, x3); BF8_TO_F32(gv, x4); } } while (0)
    RT_GLOAD(0);
    for (int sub = 0; sub < TCH / 32; ++sub) {
        const size_t m = tok0 + sub * 32 + st;
        f32x4 qn[2], kn[2], vn[2];
#pragma unroll
        for (int u = 0; u < 2; ++u) { qn[u] = (sd < 32) ? gq[u] * gcs[u] - gqo[u] * gsn[u] : gqo[u] * gsn[u] + gq[u] * gcs[u]; kn[u] = (sd < 32) ? gk[u] * gcs[u] - gko[u] * gsn[u] : gko[u] * gsn[u] + gk[u] * gcs[u]; vn[u] = gv[u]; }
        { const float gt = exp2f(lg2g * (float)(sub * 32 + st + 1)); const f32x4 p0 = qn[0] * gt, p1 = qn[1] * gt;
          v4u pw; pw.x = pk2(p0.x, p0.y); pw.y = pk2(p0.z, p0.w); pw.z = pk2(p1.x, p1.y); pw.w = pk2(p1.z, p1.w); *(v4u*)((bf16*)(A.ws + WS_PTR) + m * 256 + h * 64 + sd) = pw; }
        __syncthreads();
        { const int lo = st * 64 + sd; *(LAS f32x4*)(sq + lo) = qn[0]; *(LAS f32x4*)(sq + lo + 4) = qn[1]; *(LAS f32x4*)(sk + lo) = kn[0]; *(LAS f32x4*)(sk + lo + 4) = kn[1]; *(LAS f32x4*)(sv + lo) = vn[0]; *(LAS f32x4*)(sv + lo + 4) = vn[1]; }
        __syncthreads();
        if (sub + 1 < TCH / 32) RT_GLOAD(sub + 1);
#define RT_LOAD(kvA, rvA, vA, s_) do { const int lo_ = (s_) * 64 + kq * 16; _Pragma("unroll") for (int j4 = 0; j4 < 4; ++j4) { kvA[j4] = *(const LAS f32x4*)(sk + lo_ + 4 * j4); rvA[j4] = *(const LAS f32x4*)(sq + lo_ + 4 * j4); } vA = sv[(s_) * 64 + row]; } while (0)
#define RT_STEP(kvA, rvA, vA, s_) do { const f32x2 v2 = {vA, vA}; f32x2 y2 = {0.0f, 0.0f}; \
            _Pragma("unroll") for (int j4 = 0; j4 < 4; ++j4) { S[2 * j4] = S[2 * j4] * gam2 + v2 * LO2(kvA[j4]); S[2 * j4 + 1] = S[2 * j4 + 1] * gam2 + v2 * HI2(kvA[j4]); \
                y2 = S[2 * j4] * LO2(rvA[j4]) + y2; y2 = S[2 * j4 + 1] * HI2(rvA[j4]) + y2; } \
            const float y = quad_sum(y2.x + y2.y); if (kq == 0) so[(s_) * 64 + row] = y; } while (0)
        { f32x4 kA[4], rA[4], kB[4], rB[4]; float vA, vB;
          RT_LOAD(kA, rA, vA, 0);
#pragma unroll 1
          for (int s = 0; s < 32; s += 2) {
              RT_LOAD(kB, rB, vB, s + 1);
              RT_STEP(kA, rA, vA, s);
              if (s + 2 < 32) RT_LOAD(kA, rA, vA, s + 2);
              RT_STEP(kB, rB, vB, s + 1);
          } }
#undef RT_LOAD
#undef RT_STEP
        __syncthreads();
        { const int fs = lt >> 3, c8 = (lt & 7) * 8; bf16* dp2 = (bf16*)(A.ws + WS_YO) + (tok0 + sub * 32 + fs) * 256 + h * 64 + c8;
          const f32x4 x0 = *(const LAS f32x4*)(so + fs * 64 + c8), x1 = *(const LAS f32x4*)(so + fs * 64 + c8 + 4);
          v4u wv; wv.x = pk2(x0.x, x0.y); wv.y = pk2(x0.z, x0.w); wv.z = pk2(x1.x, x1.y); wv.w = pk2(x1.z, x1.w); *(v4u*)dp2 = wv; }
    }
    { float* ch = (float*)(A.ws + WS_CHR) + ((size_t)(bh * NCH + c) * 64 + row) * 64 + 16 * kq;
#pragma unroll
      for (int j4 = 0; j4 < 4; ++j4) *(f32x4*)(ch + 4 * j4) = (f32x4){S[2 * j4].x, S[2 * j4].y, S[2 * j4 + 1].x, S[2 * j4 + 1].y}; }
    __syncthreads();
}
#undef RT_GLOAD
#undef BF8_TO_F32
__device__ __forceinline__ void prefix_chain(ARef A, const WI& w, int bh) {
    LAS float* s0 = (LAS float*)w.lds;
    const int v = w.tid >> 3, k8 = (w.tid & 7) * 8;
    const float* CH = (const float*)(A.ws + WS_CH) + (size_t)bh * NCH * 128 * 64; float* SI = (float*)(A.ws + WS_SI) + (size_t)bh * NCH * 64 * 64;
    f32x4 c0 = {0.f, 0.f, 0.f, 0.f}, c1 = {0.f, 0.f, 0.f, 0.f};
    for (int c = 0; c < NCH; ++c) {
        *(f32x4*)(SI + ((size_t)c * 64 + v) * 64 + k8) = c0; *(f32x4*)(SI + ((size_t)c * 64 + v) * 64 + k8 + 4) = c1;
        if (c == NCH - 1) break;
        __syncthreads();
        *(LAS f32x4*)(s0 + v * 68 + k8) = c0; *(LAS f32x4*)(s0 + v * 68 + k8 + 4) = c1;
        __syncthreads();
        const float* ch = CH + (size_t)c * 128 * 64;
        f32x4 n0 = *(const f32x4*)(ch + (size_t)v * 64 + k8), n1 = *(const f32x4*)(ch + (size_t)v * 64 + k8 + 4);
#pragma unroll 8
        for (int kp = 0; kp < 64; ++kp) { const float s = s0[v * 68 + kp]; const float* pr = ch + (size_t)(64 + kp) * 64 + k8; n0 += s * *(const f32x4*)pr; n1 += s * *(const f32x4*)(pr + 4); }
        c0 = n0; c1 = n1;
    }
    const int h = bh & 3; const float gT = exp2f((float)TCH * log2f(1.0f - exp2f(-5.0f - (float)h)));
    const float* CHR = (const float*)(A.ws + WS_CHR) + (size_t)bh * NCH * 64 * 64; float* SIR = (float*)(A.ws + WS_SIR) + (size_t)bh * NCH * 64 * 64;
    c0 = (f32x4){0.f, 0.f, 0.f, 0.f}; c1 = c0;
    for (int c = 0; c < NCH; ++c) {
        *(f32x4*)(SIR + ((size_t)c * 64 + v) * 64 + k8) = c0; *(f32x4*)(SIR + ((size_t)c * 64 + v) * 64 + k8 + 4) = c1;
        if (c == NCH - 1) break;
        c0 = c0 * gT + *(const f32x4*)(CHR + ((size_t)c * 64 + v) * 64 + k8); c1 = c1 * gT + *(const f32x4*)(CHR + ((size_t)c * 64 + v) * 64 + k8 + 4);
    }
    __syncthreads();
}
typedef float f32x16 __attribute__((ext_vector_type(16)));
constexpr int SBV_PITCH = 144;
__device__ __forceinline__ float lane32_swap(float v) { return __shfl_xor(v, 32); }
__device__ __forceinline__ void sb_tile_mfma(ARef A, int unit, int lane, LAS unsigned char* vl) {
    const int tq = unit & 127, bh = unit >> 7, b = bh >> 2, h = bh & 3, t0 = tq * 32, r32 = lane & 31, hi = lane >> 5;
    const bf16* PS = (const bf16*)(A.ws + WS_PB) + (size_t)b * SEQ * PBW + PB_SB + h * 64;
    bf16x8v qf[4];
#pragma unroll
    for (int ks = 0; ks < 4; ++ks) qf[ks] = *(const bf16x8v*)(PS + (size_t)(t0 + r32) * PBW + 16 * ks + 8 * hi);
    f32x16 o0, o1;
#pragma unroll
    for (int r = 0; r < 16; ++r) { o0[r] = 0.0f; o1[r] = 0.0f; }
    float carry = 0.0f;
    const int g16 = lane >> 4, tj = (lane & 15) >> 2, tc = lane & 3;
    v4u vn[4]; bf16x8v kn[4];
#define SB_FETCH(kb_) do { _Pragma("unroll") for (int i = 0; i < 4; ++i) { const int p = lane + 64 * i, row = p >> 3, ch = p & 7; vn[i] = *(const v4u*)(PS + 512 + (size_t)((kb_) + row) * PBW + 8 * ch); } \
        _Pragma("unroll") for (int ks = 0; ks < 4; ++ks) kn[ks] = *(const bf16x8v*)(PS + 256 + (size_t)((kb_) + r32) * PBW + 16 * ks + 8 * hi); } while (0)
    SB_FETCH(t0);
    for (int kb0 = t0; kb0 >= 0; kb0 -= 32) {
#pragma unroll
        for (int i = 0; i < 4; ++i) { const int p = lane + 64 * i, row = p >> 3, ch = p & 7; *(LAS v4u*)(vl + row * SBV_PITCH + 16 * ch) = vn[i]; }
        f32x16 st;
#pragma unroll
        for (int r = 0; r < 16; ++r) st[r] = 0.0f;
        { bf16x8v ka[4];
#pragma unroll
          for (int ks = 0; ks < 4; ++ks) ka[ks] = kn[ks];
          if (kb0 >= 32) SB_FETCH(kb0 - 32);
#pragma unroll
          for (int ks = 0; ks < 4; ++ks) st = __builtin_amdgcn_mfma_f32_32x32x16_bf16(ka[ks], qf[ks], st, 0, 0, 0);
          asm volatile("" :: "v"(ka[0]), "v"(ka[1]), "v"(ka[2]), "v"(ka[3]), "v"(st)); }
        float sp[16]; const bool diag = (kb0 == t0);
#pragma unroll
        for (int r = 0; r < 16; ++r) { const float zl = st[r]; float s = (zl > 30.0f) ? zl : __builtin_amdgcn_logf(1.0f + __builtin_amdgcn_exp2f(zl));
            if (diag && ((r & 3) + 8 * (r >> 2) + 4 * hi >= r32)) s = 0.0f;
            sp[r] = s; }
        float G[4], Gp[4], suf[4];
#pragma unroll
        for (int q = 0; q < 4; ++q) { G[q] = (sp[4 * q] + sp[4 * q + 1]) + (sp[4 * q + 2] + sp[4 * q + 3]); Gp[q] = lane32_swap(G[q]); }
        suf[3] = 0.0f; suf[2] = G[3] + Gp[3]; suf[1] = suf[2] + (G[2] + Gp[2]); suf[0] = suf[1] + (G[1] + Gp[1]);
        const float tot = suf[0] + (G[0] + Gp[0]);
        pg8::u32x4 pw0, pw1;
        float av[16];
#pragma unroll
        for (int q = 0; q < 4; ++q) { float run = carry + suf[q] + (hi == 0 ? Gp[q] : 0.0f);
#pragma unroll
            for (int i = 3; i >= 0; --i) { const int r = 4 * q + i; const float la = (st[r] - sp[r]) - run; float a = __builtin_amdgcn_exp2f(la);
                if (diag && ((r & 3) + 8 * (r >> 2) + 4 * hi >= r32)) a = 0.0f;
                av[r] = a; run += sp[r]; } }
        pw0.x = pg8::cvt_pk_bf16(av[0], av[1]); pw0.y = pg8::cvt_pk_bf16(av[2], av[3]); pw0.z = pg8::cvt_pk_bf16(av[4], av[5]); pw0.w = pg8::cvt_pk_bf16(av[6], av[7]);
        pw1.x = pg8::cvt_pk_bf16(av[8], av[9]); pw1.y = pg8::cvt_pk_bf16(av[10], av[11]); pw1.z = pg8::cvt_pk_bf16(av[12], av[13]); pw1.w = pg8::cvt_pk_bf16(av[14], av[15]);
        const bf16x8v pa0 = __builtin_bit_cast(bf16x8v, pw0), pa1 = __builtin_bit_cast(bf16x8v, pw1);
        LDS_WAIT();
#pragma unroll
        for (int s = 0; s < 2; ++s)
#pragma unroll
            for (int nb = 0; nb < 2; ++nb) {
                LAS unsigned char* a1 = vl + (16 * s + 4 * (g16 >> 1) + tj) * SBV_PITCH + (32 * nb + 16 * (g16 & 1) + 4 * tc) * 2;
                const s16x4v r1 = __builtin_bit_cast(s16x4v, __builtin_amdgcn_ds_read_tr16_b64_v4i16((LAS s16x4v*)a1));
                const s16x4v r2 = __builtin_bit_cast(s16x4v, __builtin_amdgcn_ds_read_tr16_b64_v4i16((LAS s16x4v*)(a1 + 8 * SBV_PITCH)));
                const bf16x8v bv = {r1[0], r1[1], r1[2], r1[3], r2[0], r2[1], r2[2], r2[3]};
                if (nb == 0) o0 = __builtin_amdgcn_mfma_f32_32x32x16_bf16(s ? pa1 : pa0, bv, o0, 0, 0, 0); else o1 = __builtin_amdgcn_mfma_f32_32x32x16_bf16(s ? pa1 : pa0, bv, o1, 0, 0, 0);
                asm volatile("" :: "v"(bv), "v"(pa0), "v"(pa1), "v"(o0), "v"(o1)); }
        LDS_WAIT();
        carry += tot;
        if (__all(carry > 150.0f)) break;
    }
#undef SB_FETCH
    bf16* YS = (bf16*)((float*)(A.ws + WS_YO) + 3 * YO_STRIDE) + ((size_t)b * SEQ + t0) * 256 + h * 64 + r32;
#pragma unroll
    for (int r = 0; r < 16; ++r) { const int qo = (r & 3) + 8 * (r >> 2) + 4 * hi; YS[(size_t)qo * 256] = (bf16)f2bf(o0[r]); YS[(size_t)qo * 256 + 32] = (bf16)f2bf(o1[r]); }
}

__device__ __forceinline__ void dsa_scores_mfma(ARef A, const WI& w) {
    const _Float16* QIH = (const _Float16*)(A.ws + WS_DQI); const _Float16* KIH = (const _Float16*)(A.ws + WS_DKI);
    const float* DW = (const float*)(A.ws + WS_DW); float* SC = (float*)(A.ws + WS_SC);
    const int col = w.lane & 15, q4 = w.lane >> 4;
    for (int u = w.gw; u < 2048; u += w.NGW) {
        const int pi = u >> 1, par = u & 1, b = pi >> 7, p = pi & 127;
#pragma unroll 1
        for (int side = 0; side < 2; ++side) {
            const int qb = side ? 255 - p : p; const size_t m0 = (size_t)b * SEQ + 16 * qb;
            f16x8 bq[8];
#pragma unroll
            for (int h = 0; h < 8; ++h) bq[h] = *(const f16x8*)(QIH + (m0 + col) * 256 + h * 32 + 8 * q4);
            const float* dw = DW + (m0 + col) * 8; const f32x4 wa = *(const f32x4*)dw, wb = *(const f32x4*)(dw + 4);
            float* srow = SC + (m0 + col) * SEQ + 4 * q4;
            const _Float16* kbase = KIH + ((size_t)b * SEQ + col) * 32 + 8 * q4;
            for (int kp = par; 2 * kp <= qb; kp += 4) {
                f16x8 ak[4];
#pragma unroll
                for (int q = 0; q < 4; ++q) { const int kb = 2 * (kp + 2 * (q >> 1)) + (q & 1); ak[q] = *(const f16x8*)(kbase + (size_t)(kb <= qb ? kb : qb) * 16 * 32); }
#pragma unroll
                for (int q = 0; q < 4; ++q) { const int kb = 2 * (kp + 2 * (q >> 1)) + (q & 1);
                    if (kb <= qb) {
                        f32x4 acc = {0.f, 0.f, 0.f, 0.f};
#pragma unroll
                        for (int h = 0; h < 8; ++h) { const f32x4 c = __builtin_amdgcn_mfma_f32_16x16x32_f16(ak[q], bq[h], (f32x4){0.f, 0.f, 0.f, 0.f}, 0, 0, 0); const float wv = (h < 4) ? wa[h] : wb[h - 4];
                            acc.x += wv * fmaxf(c.x, 0.f); acc.y += wv * fmaxf(c.y, 0.f); acc.z += wv * fmaxf(c.z, 0.f); acc.w += wv * fmaxf(c.w, 0.f); }
                        *(f32x4*)(srow + 16 * kb) = acc + 0.0f; } }
            }
        }
    }
}

__device__ __forceinline__ int wave_total_i(int v) {
    v += __builtin_amdgcn_mov_dpp(v, 0xB1, 0xF, 0xF, true);
    v += __builtin_amdgcn_mov_dpp(v, 0x4E, 0xF, 0xF, true);
    v += __builtin_amdgcn_mov_dpp(v, 0x141, 0xF, 0xF, true);
    v += __builtin_amdgcn_mov_dpp(v, 0x140, 0xF, 0xF, true);
    return __builtin_amdgcn_readlane(v, 0) + __builtin_amdgcn_readlane(v, 16) + __builtin_amdgcn_readlane(v, 32) + __builtin_amdgcn_readlane(v, 48);
}
__device__ __forceinline__ unsigned score_key(float f) { const unsigned bits = __float_as_uint(f); return (bits & 0x80000000u) ? ~bits : (bits | 0x80000000u); }
constexpr int VST_PITCH = 144;
typedef unsigned short u16;
__device__ __forceinline__ void dsa_load_scores(ARef A, int m, int lane, f32x4 (&sv)[16]) {
    const int n = (m & (SEQ - 1)) + 1; const float* sc = (const float*)(A.ws + WS_SC) + (size_t)m * SEQ;
#pragma unroll
    for (int j4 = 0; j4 < 16; ++j4) sv[j4] = *(const f32x4*)(sc + ((256 * j4 < n) ? 256 * j4 : 0) + 4 * lane);
}
__device__ __forceinline__ void dsa_select(ARef A, int m, int n, int lane_in, LAS u16* slist, LAS unsigned* bk) {
    int lane = lane_in; asm volatile("" : "+v"(lane));
    if (n <= 256) {
#pragma unroll
        for (int c = 0; c < 4; ++c) { const int idx = lane + 64 * c; slist[idx] = (u16)((idx < n) ? idx : 0); }
        return;
    }
    f32x4 sv[16]; dsa_load_scores(A, m, lane, sv);
    unsigned u[64];
#pragma unroll
    for (int j4 = 0; j4 < 16; ++j4)
#pragma unroll
        for (int i = 0; i < 4; ++i) u[4 * j4 + i] = (256 * j4 + 4 * lane + i < n) ? score_key(sv[j4][i]) : 0u;
    unsigned T = 0u;
    for (int bit = 31; bit >= 16; --bit) { const unsigned cand = T | (1u << bit); int cnt = 0;
#pragma unroll
        for (int j = 0; j < 64; ++j) cnt += (u[j] >= cand) ? 1 : 0;
        if (wave_total_i(cnt) >= 256) T = cand; }
    unsigned long long bkb = 0ull; int chi = 0;
#pragma unroll
    for (int j = 0; j < 64; ++j) { bkb |= (unsigned long long)(((u[j] >> 16) == (T >> 16)) ? 1u : 0u) << j; chi += ((u[j] >> 16) > (T >> 16)) ? 1 : 0; }
    const int cb = wave_total_i(__popcll(bkb)), need = 256 - wave_total_i(chi);
    if (cb <= 64) {
        int pos = __popcll(bkb);
        { const int mine_ = pos;
#pragma unroll
          for (int d = 1; d < 64; d <<= 1) { const int y = __shfl_up(pos, d); if (lane >= d) pos += y; }
          pos -= mine_; }
#pragma unroll
        for (int j = 0; j < 64; ++j) { if ((bkb >> j) & 1ull) { bk[pos] = u[j]; ++pos; } }
        LDS_WAIT();
        const unsigned kx = (lane < cb) ? bk[lane] : 0u;
        for (int bit = 15; bit >= 0; --bit) { const unsigned cand = T | (1u << bit); if (__popcll(__ballot(kx >= cand)) >= need) T = cand; }
        LDS_WAIT();
    } else {
        for (int bit = 15; bit >= 0; --bit) { const unsigned cand = T | (1u << bit); int cnt = 0;
#pragma unroll
            for (int j = 0; j < 64; ++j) cnt += (u[j] >= cand) ? 1 : 0;
            if (wave_total_i(cnt) >= 256) T = cand; }
    }
    unsigned long long gtb = 0ull, eqb = 0ull;
#pragma unroll
    for (int j = 0; j < 64; ++j) { gtb |= (unsigned long long)((u[j] > T) ? 1u : 0u) << j; eqb |= (unsigned long long)((u[j] == T) ? 1u : 0u) << j; }
    const int tgt = wave_total_i(__popcll(gtb)), teq = wave_total_i(__popcll(eqb));
    unsigned long long selb = gtb | eqb;
    if (tgt + teq > 256) {
        const int take = 256 - tgt; int lo = 0;
        for (int bit = 11; bit >= 0; --bit) { const int cand = lo | (1 << bit); const int J4 = cand >> 8; int ni = (cand & 255) - 4 * lane; ni = ni < 0 ? 0 : (ni > 4 ? 4 : ni);
            const int jc = 4 * J4 + ni; const unsigned long long msk = (jc >= 64) ? ~0ull : ((1ull << jc) - 1ull);
            if (wave_total_i(__popcll(eqb & msk)) < take) lo = cand; }
        { const int cand = lo + 1; const int J4 = cand >> 8; int ni = (cand & 255) - 4 * lane; ni = ni < 0 ? 0 : (ni > 4 ? 4 : ni);
          const int jc = (cand >= SEQ) ? 64 : 4 * J4 + ni; const unsigned long long msk = (jc >= 64) ? ~0ull : ((1ull << jc) - 1ull); selb = gtb | (eqb & msk); }
    }
    const int mine = __popcll(selb); int off = mine;
#pragma unroll
    for (int d = 1; d < 64; d <<= 1) { const int y = __shfl_up(off, d); if (lane >= d) off += y; }
    off -= mine;
    while (selb) { const int j = __builtin_ctzll(selb); selb &= selb - 1ull; slist[off] = (u16)(256 * (j >> 2) + 4 * lane + (j & 3)); ++off; }
}
__device__ __forceinline__ void dsa_attend(ARef A, int m, int lane_in, const LAS u16* slist, LAS unsigned char* vbuf) {
    int lane = lane_in; asm volatile("" : "+v"(lane));
    const int b = m >> 12, t = m & (SEQ - 1), n = t + 1, nsel = n < 256 ? n : 256, col = lane & 15, q4 = lane >> 4;
    const bf16* DKB = (const bf16*)(A.ws + WS_DKB) + (size_t)b * SEQ * 64; const bf16* DVB = (const bf16*)(A.ws + WS_DVB) + (size_t)b * SEQ * 64;
    const int vrow = lane >> 3, vpc = lane & 7;
    bf16x8v bq0 = {0, 0, 0, 0, 0, 0, 0, 0}, bq1 = {0, 0, 0, 0, 0, 0, 0, 0};
    if (col < 4) { const bf16* qp = (const bf16*)(A.ws + WS_DQ) + (size_t)m * 256 + col * 64 + 8 * q4; bq0 = *(const bf16x8v*)qp; bq1 = *(const bf16x8v*)(qp + 32); }
    f32x4 lg[16];
#pragma unroll
    for (int hb = 0; hb < 2; ++hb) {
        bf16x8v a0[8], a1[8];
#pragma unroll
        for (int k = 0; k < 8; ++k) { const int s = slist[16 * (8 * hb + k) + col]; const bf16* kr = DKB + (size_t)s * 64 + 8 * q4; a0[k] = *(const bf16x8v*)kr; a1[k] = *(const bf16x8v*)(kr + 32); }
#pragma unroll
        for (int k = 0; k < 8; ++k) { const f32x4 c = __builtin_amdgcn_mfma_f32_16x16x32_bf16(a0[k], bq0, (f32x4){0.f, 0.f, 0.f, 0.f}, 0, 0, 0); lg[8 * hb + k] = __builtin_amdgcn_mfma_f32_16x16x32_bf16(a1[k], bq1, c, 0, 0, 0); }
        __builtin_amdgcn_sched_barrier(0);
    }
    if (nsel < 256) {
#pragma unroll
        for (int kb = 0; kb < 16; ++kb)
#pragma unroll
            for (int r = 0; r < 4; ++r) if (16 * kb + 4 * q4 + r >= nsel) lg[kb][r] = -INFINITY; }
    v4u vr[4];
#pragma unroll
    for (int i = 0; i < 4; ++i) { const int s = slist[vrow + 8 * i]; vr[i] = *(const v4u*)(DVB + (size_t)s * 64 + 8 * vpc); }
    float mx = -INFINITY;
#pragma unroll
    for (int kb = 0; kb < 16; ++kb) mx = fmaxf(fmaxf(mx, fmaxf(lg[kb].x, lg[kb].y)), fmaxf(lg[kb].z, lg[kb].w));
    mx = fmaxf(mx, __shfl_xor(mx, 16)); mx = fmaxf(mx, __shfl_xor(mx, 32));
    float sm = 0.f;
#pragma unroll
    for (int kb = 0; kb < 16; ++kb) { lg[kb].x = __builtin_amdgcn_exp2f(lg[kb].x - mx); lg[kb].y = __builtin_amdgcn_exp2f(lg[kb].y - mx); lg[kb].z = __builtin_amdgcn_exp2f(lg[kb].z - mx); lg[kb].w = __builtin_amdgcn_exp2f(lg[kb].w - mx); sm += (lg[kb].x + lg[kb].y) + (lg[kb].z + lg[kb].w); }
    sm += __shfl_xor(sm, 16); sm += __shfl_xor(sm, 32);
    const float inv = 1.0f / sm;
    bf16x8v pa[8];
#pragma unroll
    for (int i = 0; i < 8; ++i) { const f32x4 x = lg[2 * i] * inv, y = lg[2 * i + 1] * inv;
        pg8::u32x4 wv; wv.x = pg8::cvt_pk_bf16(x.x, x.y); wv.y = pg8::cvt_pk_bf16(x.z, x.w); wv.z = pg8::cvt_pk_bf16(y.x, y.y); wv.w = pg8::cvt_pk_bf16(y.z, y.w);
        pa[i] = __builtin_bit_cast(bf16x8v, wv); }
    f32x4 o[4];
#pragma unroll
    for (int nb = 0; nb < 4; ++nb) o[nb] = (f32x4){0.f, 0.f, 0.f, 0.f};
    const int tj = col >> 2, tc = col & 3;
#pragma unroll
    for (int c = 0; c < 8; ++c) {
        LAS unsigned char* vb = vbuf + (c & 1) * (32 * VST_PITCH);
#pragma unroll
        for (int i = 0; i < 4; ++i) *(LAS v4u*)(vb + (vrow + 8 * i) * VST_PITCH + 16 * vpc) = vr[i];
        if (c < 7) {
#pragma unroll
            for (int i = 0; i < 4; ++i) { const int s = slist[32 * (c + 1) + vrow + 8 * i]; vr[i] = *(const v4u*)(DVB + (size_t)s * 64 + 8 * vpc); } }
        LDS_WAIT();
#pragma unroll
        for (int nb = 0; nb < 4; ++nb) {
            LAS unsigned char* a1 = vb + (4 * q4 + tj) * VST_PITCH + (16 * nb + 4 * tc) * 2;
            const s16x4v r1 = __builtin_bit_cast(s16x4v, __builtin_amdgcn_ds_read_tr16_b64_v4i16((LAS s16x4v*)a1));
            const s16x4v r2 = __builtin_bit_cast(s16x4v, __builtin_amdgcn_ds_read_tr16_b64_v4i16((LAS s16x4v*)(a1 + 16 * VST_PITCH)));
            const bf16x8v bv = {r1[0], r1[1], r1[2], r1[3], r2[0], r2[1], r2[2], r2[3]};
            o[nb] = __builtin_amdgcn_mfma_f32_16x16x32_bf16(pa[c], bv, o[nb], 0, 0, 0); }
    }
    LDS_WAIT();
    if (lane < 16) { bf16* YD = (bf16*)((float*)(A.ws + WS_YO) + 2 * YO_STRIDE) + (size_t)m * 256;
#pragma unroll
        for (int nb = 0; nb < 4; ++nb) { YD[16 * nb + lane] = (bf16)f2bf(o[nb].x); YD[64 + 16 * nb + lane] = (bf16)f2bf(o[nb].y); YD[128 + 16 * nb + lane] = (bf16)f2bf(o[nb].z); YD[192 + 16 * nb + lane] = (bf16)f2bf(o[nb].w); } }
}
constexpr int DSA_GR = 1;
__device__ __forceinline__ int dsa_row_of(int batch, int gi, int r) { const int idx = DSA_GR * gi + r, h = idx >> 1; return batch * SEQ + ((idx & 1) ? (SEQ - 1 - h) : h); }
__device__ __forceinline__ void dsa_wave(ARef A, const WI& w, LAS unsigned char* wl, int qi, int l) {
    LAS u16* lists = (LAS u16*)wl; LAS unsigned char* vbuf = wl + 4096; LAS unsigned* bk = (LAS unsigned*)vbuf;
#pragma unroll 1
    for (int kb = 0; kb < NB; ++kb) {
        const int batch = (w.bx + kb) & (NB - 1);
        unsigned* head = (unsigned*)(A.ws + WS_CTL) + CW_DSAQ + 128 * qi + 16 * batch;
        for (;;) {
            int g = 0; if (w.lane == 0) g = (int)atomicAdd(head, 1u);
            g = __builtin_amdgcn_readfirstlane(g);
            if (g >= 11 * (SEQ / 8)) break;
            const int per = g / 11, pos = g - 11 * per;
            if (pos >= 8) { moe_convert_chunk(A, l, batch * 1536 + 3 * per + (pos - 8), w.lane, (LAS float*)vbuf); continue; }
            const int gi = 8 * per + pos;
            { const int m = dsa_row_of(batch, gi, 0), n = (m & (SEQ - 1)) + 1; dsa_select(A, m, n, w.lane, lists, bk); }
            LDS_WAIT();
            dsa_attend(A, dsa_row_of(batch, gi, 0), w.lane, lists, vbuf);
        }
    }
}

__device__ __forceinline__ f32x4 head_norm4(f32x4 y, float eps, f32x4 g) {
    const float mean = grp16_sum(sum4(y)) * (1.0f / 64.0f); const f32x4 yc = y - mean;
    const float var = grp16_sum(dot4(yc, yc)) * (1.0f / 64.0f); return yc * (1.0f / sqrtf(var + eps)) * g;
}
template <bool BF> __device__ __forceinline__ f32x4 state_corr(const LAS float* sl, int hh, int r16, const void* pv) {
    const LAS float* r0 = sl + (hh * 64 + 4 * r16) * 64; const int x0 = (4 * r16) & 15;
    f32x4 out = {0.f, 0.f, 0.f, 0.f};
#pragma unroll 2
    for (int k8 = 0; k8 < 8; ++k8) {
        f32x4 pa, pb;
        if (BF) { const v4u x = ((const v4u*)pv)[k8]; pa = (f32x4){bf_lo(x.x), bf_hi(x.x), bf_lo(x.y), bf_hi(x.y)}; pb = (f32x4){bf_lo(x.z), bf_hi(x.z), bf_lo(x.w), bf_hi(x.w)}; }
        else { pa = ((const f32x4*)pv)[2 * k8]; pb = ((const f32x4*)pv)[2 * k8 + 1]; }
#pragma unroll
        for (int i = 0; i < 4; ++i) { const LAS float* rowp = r0 + i * 64; const int xs = (x0 + i) & 15;
            out[i] += dot4(*(const LAS f32x4*)(rowp + 4 * ((2 * k8) ^ xs)), pa) + dot4(*(const LAS f32x4*)(rowp + 4 * ((2 * k8 + 1) ^ xs)), pb); }
    }
    return out;
}
__device__ __forceinline__ void post_row(ARef A, int l, int m, int lane, const LAS float* slw, const LAS float* slr) {
    const float* YO = (const float*)(A.ws + WS_YO); const float* RWA = (const float*)(A.ws + WS_RWA);
    bf16* MX = (bf16*)(A.ws + WS_MIX) + (size_t)m * DM; const int c4 = 4 * lane, hh = lane >> 4, r16 = lane & 15; const size_t o = (size_t)m * 256 + c4;
    { f32x4 y = *(const f32x4*)(YO + o) + state_corr<true>(slr, hh, r16, (const bf16*)(A.ws + WS_PTR) + (size_t)m * 256 + hh * 64);
      y = head_norm4(y, 1e-5f, *(const f32x4*)(A.in[I_RETGN] + l * 256 + c4));
      const v2u gw_ = *(const v2u*)((const bf16*)(A.ws + WS_PB) + (size_t)m * PBW + 768 + c4); const f32x4 g = {bf_lo(gw_.x), bf_hi(gw_.x), bf_lo(gw_.y), bf_hi(gw_.y)};
#pragma unroll
      for (int i = 0; i < 4; ++i) y[i] *= g[i] * sigm(g[i]);
      v2u w; w.x = pk2(y.x, y.y); w.y = pk2(y.z, y.w); *(v2u*)(MX + c4) = w; }
    { f32x4 y = *(const f32x4*)(YO + YO_STRIDE + o) + state_corr<false>(slw, hh, r16, (const float*)(A.ws + WS_PT) + (size_t)m * 256 + hh * 64);
      y = head_norm4(y, 64e-5f, *(const f32x4*)(A.in[I_LN] + l * 256 + c4));
      y = (y + *(const f32x4*)(RWA + 7 * RWA_STRIDE + o)) * *(const f32x4*)(RWA + 6 * RWA_STRIDE + o);
      v2u w; w.x = pk2(y.x, y.y); w.y = pk2(y.z, y.w); *(v2u*)(MX + 256 + c4) = w; }
    { f32x4 y = *(const f32x4*)(YO + 2 * YO_STRIDE + o); const float r = 1.0f / sqrtf(wave_sum(dot4(y, y)) * (1.0f / 256.0f) + 1e-5f);
      y = y * r * *(const f32x4*)(A.in[I_DONORM] + l * 256 + c4);
      v2u w; w.x = pk2(y.x, y.y); w.y = pk2(y.z, y.w); *(v2u*)(MX + 512 + c4) = w; }
    { f32x4 y = *(const f32x4*)(YO + 3 * YO_STRIDE + o); const float r = 1.0f / sqrtf(wave_sum(dot4(y, y)) * (1.0f / 256.0f) + 1e-5f);
      y = y * r * *(const f32x4*)(A.in[I_SONORM] + l * 256 + c4);
      v2u w; w.x = pk2(y.x, y.y); w.y = pk2(y.z, y.w); *(v2u*)(MX + 768 + c4) = w; }
}
__device__ __forceinline__ void ph_post(ARef A, const WI& w, int l) {
    LAS float* slw = (LAS float*)w.lds; LAS float* slr = slw + 16384;
    for (int u = w.vcu; u < NB * NCH * 2; u += w.G) {
        const int b = u >> 5, c = (u >> 1) & 15, half = u & 1;
        __syncthreads();
        for (int e = w.tid; e < 4096; e += NWAVES * 64) { const int hh = e >> 10, v = (e >> 4) & 63, k4 = e & 15;
            const size_t src = ((size_t)((b * 4 + hh) * NCH + c) * 64 + v) * 64 + 4 * k4; const int dst = (hh * 64 + v) * 64 + 4 * (k4 ^ (v & 15));
            *(LAS f32x4*)(slw + dst) = *(const f32x4*)((const float*)(A.ws + WS_SI) + src); *(LAS f32x4*)(slr + dst) = *(const f32x4*)((const float*)(A.ws + WS_SIR) + src); }
        __syncthreads();
        const int tok0 = b * SEQ + c * TCH + half * 128 + w.wave * 16;
        for (int i = 0; i < 16; ++i) post_row(A, l, tok0 + i, w.lane, slw, slr);
    }
}

constexpr int S0_PITCH = 144;
template <int MIXER> __device__ __forceinline__ void post16_head(ARef A, int l, size_t m, int hh, int tk, int fq, const LAS unsigned char* s0) {
    const size_t o = m * 256 + hh * 64 + 8 * fq;
    bf16x8v pb[2];
    if (MIXER == 0) { const bf16* pp = (const bf16*)(A.ws + WS_PTR) + o; pb[0] = *(const bf16x8v*)pp; pb[1] = *(const bf16x8v*)(pp + 32); }
    else { const bf16* pp = (const bf16*)(A.ws + WS_PT) + o; pb[0] = *(const bf16x8v*)pp; pb[1] = *(const bf16x8v*)(pp + 32); }
    f32x4 y[4];
    const bf16* yl = (const bf16*)((const float*)(A.ws + WS_YO) + MIXER * YO_STRIDE) + o;
#pragma unroll
    for (int j = 0; j < 2; ++j) { const v4u x = *(const v4u*)(yl + 32 * j); y[2 * j] = (f32x4){bf_lo(x.x), bf_hi(x.x), bf_lo(x.y), bf_hi(x.y)}; y[2 * j + 1] = (f32x4){bf_lo(x.z), bf_hi(x.z), bf_lo(x.w), bf_hi(x.w)}; }
    const float* gw = ((MIXER == 0) ? A.in[I_RETGN] : A.in[I_LN]) + l * 256 + hh * 64 + 8 * fq;
    f32x4 gn[4], e0[4], e1[4];
#pragma unroll
    for (int mb = 0; mb < 4; ++mb) gn[mb] = *(const f32x4*)(gw + 32 * (mb >> 1) + 4 * (mb & 1));
    if (MIXER == 0) {
#pragma unroll
        for (int j = 0; j < 2; ++j) { const v4u gx = *(const v4u*)((const bf16*)(A.ws + WS_PB) + m * PBW + 768 + hh * 64 + 8 * fq + 32 * j);
            e0[2 * j] = (f32x4){bf_lo(gx.x), bf_hi(gx.x), bf_lo(gx.y), bf_hi(gx.y)}; e0[2 * j + 1] = (f32x4){bf_lo(gx.z), bf_hi(gx.z), bf_lo(gx.w), bf_hi(gx.w)}; }
    } else { const float* RWA = (const float*)(A.ws + WS_RWA);
#pragma unroll
        for (int j = 0; j < 2; ++j) { const v4u bx_ = *(const v4u*)((const bf16*)(RWA + 7 * RWA_STRIDE) + o + 32 * j), gx_ = *(const v4u*)((const bf16*)(RWA + 6 * RWA_STRIDE) + o + 32 * j);
            e0[2 * j] = (f32x4){bf_lo(bx_.x), bf_hi(bx_.x), bf_lo(bx_.y), bf_hi(bx_.y)}; e0[2 * j + 1] = (f32x4){bf_lo(bx_.z), bf_hi(bx_.z), bf_lo(bx_.w), bf_hi(bx_.w)};
            e1[2 * j] = (f32x4){bf_lo(gx_.x), bf_hi(gx_.x), bf_lo(gx_.y), bf_hi(gx_.y)}; e1[2 * j + 1] = (f32x4){bf_lo(gx_.z), bf_hi(gx_.z), bf_lo(gx_.w), bf_hi(gx_.w)}; } }
    const LAS unsigned char* ab = s0 + ((MIXER * 4 + hh) * 64 + 8 * (tk >> 2) + (tk & 3)) * S0_PITCH + 16 * fq;
#pragma unroll
    for (int mb = 0; mb < 4; ++mb)
#pragma unroll
        for (int ks = 0; ks < 2; ++ks) { const bf16x8v af = *(const LAS bf16x8v*)(ab + (32 * (mb >> 1) + 4 * (mb & 1)) * S0_PITCH + 64 * ks); y[mb] = __builtin_amdgcn_mfma_f32_16x16x32_bf16(af, pb[ks], y[mb], 0, 0, 0); }
    float s = (sum4(y[0]) + sum4(y[1])) + (sum4(y[2]) + sum4(y[3])); s += __shfl_xor(s, 16); s += __shfl_xor(s, 32);
    const float mean = s * (1.0f / 64.0f);
#pragma unroll
    for (int mb = 0; mb < 4; ++mb) y[mb] = y[mb] - mean;
    float q = (dot4(y[0], y[0]) + dot4(y[1], y[1])) + (dot4(y[2], y[2]) + dot4(y[3], y[3])); q += __shfl_xor(q, 16); q += __shfl_xor(q, 32);
    const float rs = 1.0f / sqrtf(q * (1.0f / 64.0f) + ((MIXER == 0) ? 1e-5f : 64e-5f));
    bf16* MX = (bf16*)(A.ws + WS_MIX) + m * DM + MIXER * 256 + hh * 64 + 8 * fq;
#pragma unroll
    for (int j = 0; j < 2; ++j) { f32x4 ya = y[2 * j] * rs * gn[2 * j], yb = y[2 * j + 1] * rs * gn[2 * j + 1];
        if (MIXER == 0) {
#pragma unroll
            for (int i = 0; i < 4; ++i) { ya[i] *= e0[2 * j][i] * sigm(e0[2 * j][i]); yb[i] *= e0[2 * j + 1][i] * sigm(e0[2 * j + 1][i]); }
        } else { ya = (ya + e0[2 * j]) * e1[2 * j]; yb = (yb + e0[2 * j + 1]) * e1[2 * j + 1]; }
        v4u wv; wv.x = pk2(ya.x, ya.y); wv.y = pk2(ya.z, ya.w); wv.z = pk2(yb.x, yb.y); wv.w = pk2(yb.z, yb.w); *(v4u*)(MX + 32 * j) = wv; }
}
__device__ __forceinline__ void post16_rms(ARef A, int l, size_t m, int mx, int fq) {
    const bf16* yp = (const bf16*)((const float*)(A.ws + WS_YO) + (size_t)mx * YO_STRIDE) + m * 256 + 8 * fq; const float* gw = ((mx == 2) ? A.in[I_DONORM] : A.in[I_SONORM]) + l * 256 + 8 * fq;
    f32x4 y[16];
#pragma unroll
    for (int j = 0; j < 8; ++j) { const v4u x = *(const v4u*)(yp + 32 * j); y[2 * j] = (f32x4){bf_lo(x.x), bf_hi(x.x), bf_lo(x.y), bf_hi(x.y)}; y[2 * j + 1] = (f32x4){bf_lo(x.z), bf_hi(x.z), bf_lo(x.w), bf_hi(x.w)}; }
    float q = 0.0f;
#pragma unroll
    for (int j = 0; j < 16; ++j) q += dot4(y[j], y[j]);
    q += __shfl_xor(q, 16); q += __shfl_xor(q, 32);
    const float r = 1.0f / sqrtf(q * (1.0f / 256.0f) + 1e-5f);
    bf16* MX = (bf16*)(A.ws + WS_MIX) + m * DM + mx * 256 + 8 * fq;
#pragma unroll
    for (int j = 0; j < 8; ++j) { const f32x4 ya = y[2 * j] * r * *(const f32x4*)(gw + 32 * j), yb = y[2 * j + 1] * r * *(const f32x4*)(gw + 32 * j + 4);
        v4u wv; wv.x = pk2(ya.x, ya.y); wv.y = pk2(ya.z, ya.w); wv.z = pk2(yb.x, yb.y); wv.w = pk2(yb.z, yb.w); *(v4u*)(MX + 32 * j) = wv; }
}
__device__ __forceinline__ void ph_post16(ARef A, const WI& w, int l) {
    LAS unsigned char* s0 = w.lds;
    for (int u = w.vcu; u < NB * NCH * 2; u += w.G) {
        const int b = u >> 5, c = (u >> 1) & 15, half = u & 1;
        __syncthreads();
#pragma unroll 2
        for (int e = w.tid; e < 4096; e += NWAVES * 64) { const int hd = e >> 9, v = (e >> 3) & 63, k8 = e & 7;
            const float* src = (const float*)(A.ws + ((hd < 4) ? WS_SIR : WS_SI)) + ((size_t)((b * 4 + (hd & 3)) * NCH + c) * 64 + v) * 64 + 8 * k8;
            const f32x4 x0 = *(const f32x4*)src, x1 = *(const f32x4*)(src + 4);
            v4u wv; wv.x = pk2(x0.x, x0.y); wv.y = pk2(x0.z, x0.w); wv.z = pk2(x1.x, x1.y); wv.w = pk2(x1.z, x1.w); *(LAS v4u*)(s0 + (hd * 64 + v) * S0_PITCH + 16 * k8) = wv; }
        __syncthreads();
        int lane = w.lane; asm volatile("" : "+v"(lane));
        const int tk = lane & 15, fq = lane >> 4; const size_t m = (size_t)(b * SEQ + c * TCH + half * 128 + w.wave * 16 + tk);
#pragma unroll 1
        for (int hh = 0; hh < 4; ++hh) post16_head<0>(A, l, m, hh, tk, fq, s0);
#pragma unroll 1
        for (int hh = 0; hh < 4; ++hh) post16_head<1>(A, l, m, hh, tk, fq, s0);
#pragma unroll 1
        for (int mx = 2; mx < 4; ++mx) post16_rms(A, l, m, mx, fq);
    }
}

__device__ __forceinline__ float wave_max_f(float v) {
    v = fmaxf(v, __builtin_bit_cast(float, __builtin_amdgcn_mov_dpp(__builtin_bit_cast(int, v), 0xB1, 0xF, 0xF, true)));
    v = fmaxf(v, __builtin_bit_cast(float, __builtin_amdgcn_mov_dpp(__builtin_bit_cast(int, v), 0x4E, 0xF, 0xF, true)));
    v = fmaxf(v, __builtin_bit_cast(float, __builtin_amdgcn_mov_dpp(__builtin_bit_cast(int, v), 0x141, 0xF, 0xF, true)));
    v = fmaxf(v, __builtin_bit_cast(float, __builtin_amdgcn_mov_dpp(__builtin_bit_cast(int, v), 0x140, 0xF, 0xF, true)));
    const int iv = __builtin_bit_cast(int, v);
    return fmaxf(fmaxf(__builtin_bit_cast(float, __builtin_amdgcn_readlane(iv, 0)), __builtin_bit_cast(float, __builtin_amdgcn_readlane(iv, 16))), fmaxf(__builtin_bit_cast(float, __builtin_amdgcn_readlane(iv, 32)), __builtin_bit_cast(float, __builtin_amdgcn_readlane(iv, 48))));
}
__device__ __forceinline__ void router_stage(ARef A, const WI& w, int l) {
    LAS float* rwl = (LAS float*)w.lds; const float* rw = A.in[I_RW] + (size_t)l * DM * 32;
    for (int e = w.tid; e < DM * 8; e += NWAVES * 64) { const int k = e >> 3, c = e & 7; *(LAS f32x4*)(rwl + k * 32 + 4 * (c ^ ((k >> 2) & 7))) = *(const f32x4*)(rw + (size_t)k * 32 + 4 * c); }
    __syncthreads();
}
__device__ __forceinline__ void router_row(ARef A, int l, int m, int lane, LAS unsigned* hist, const LAS float* rwl, LAS int* texp, bool dry = false) {
    const float* XA = (const float*)(A.ws + WS_XA) + (size_t)m * DM; const float* MOD = (const float*)(A.ws + WS_MOD) + (size_t)(l * 8 + (m >> 12)) * 6144;
    f32x4 v[4]; float ss = 0.0f;
#pragma unroll
    for (int j = 0; j < 4; ++j) { v[j] = *(const f32x4*)(XA + 4 * (lane + 64 * j)); ss += dot4(v[j], v[j]); }
    ss = wave_sum(ss); const float rstd = 1.0f / sqrtf(ss * (1.0f / DM) + 1e-5f);
    const float* g = A.in[I_NFFN] + l * DM; const float* scp = MOD + 4 * 1024; const float* shp = MOD + 3 * 1024;
    emit_h_row(v, rstd, g, scp, shp, (bf16*)(A.ws + WS_H) + (size_t)m * DM, lane);
    float p[32];
#pragma unroll
    for (int e = 0; e < 32; ++e) p[e] = 0.0f;
    const int sw = lane & 7;
#pragma unroll 1
    for (int j = 0; j < 4; ++j) { const int k = 4 * (lane + 64 * j);
        const f32x4 h = *(const f32x4*)(XA + k) * rstd * *(const f32x4*)(g + k) * (1.0f + *(const f32x4*)(scp + k)) + *(const f32x4*)(shp + k);
        const LAS float* row = rwl + k * 32;
#pragma unroll
        for (int i = 0; i < 4; ++i) {
#pragma unroll
            for (int q4 = 0; q4 < 8; ++q4) { const f32x4 r = *(const LAS f32x4*)(row + i * 32 + 4 * (q4 ^ sw)); p[4 * q4] += h[i] * r.x; p[4 * q4 + 1] += h[i] * r.y; p[4 * q4 + 2] += h[i] * r.z; p[4 * q4 + 3] += h[i] * r.w; } } }
    float q16[16], q8[8], q4v[4], q2[2], q1;
    { const bool hb = (lane & 32) != 0;
#pragma unroll
      for (int i = 0; i < 16; ++i) { const float mine = hb ? p[16 + i] : p[i], oth = hb ? p[i] : p[16 + i]; q16[i] = mine + __shfl_xor(oth, 32); } }
    { const bool hb = (lane & 16) != 0;
#pragma unroll
      for (int i = 0; i < 8; ++i) { const float mine = hb ? q16[8 + i] : q16[i], oth = hb ? q16[i] : q16[8 + i]; q8[i] = mine + __shfl_xor(oth, 16); } }
    { const bool hb = (lane & 8) != 0;
#pragma unroll
      for (int i = 0; i < 4; ++i) { const float mine = hb ? q8[4 + i] : q8[i], oth = hb ? q8[i] : q8[4 + i]; q4v[i] = mine + __shfl_xor(oth, 8); } }
    { const bool hb = (lane & 4) != 0;
#pragma unroll
      for (int i = 0; i < 2; ++i) { const float mine = hb ? q4v[2 + i] : q4v[i], oth = hb ? q4v[i] : q4v[2 + i]; q2[i] = mine + __shfl_xor(oth, 4); } }
    { const bool hb = (lane & 2) != 0; const float mine = hb ? q2[1] : q2[0], oth = hb ? q2[0] : q2[1]; q1 = mine + __shfl_xor(oth, 2); }
    q1 += __shfl_xor(q1, 1);
    float lv = q1 + A.in[I_RB][l * 32 + (lane >> 1)];
    float tv[4]; int ti[4];
#pragma unroll
    for (int kk = 0; kk < 4; ++kk) { const float mx = wave_max_f(lv); const unsigned long long msk = __ballot(lv == mx); const int e = msk ? (int)(__builtin_ctzll(msk) >> 1) : kk;
        tv[kk] = mx; ti[kk] = e; if ((lane >> 1) == e) lv = -INFINITY; }
    const float e1 = expf(tv[1] - tv[0]), e2 = expf(tv[2] - tv[0]), e3 = expf(tv[3] - tv[0]); const float inv = 1.0f / (1.0f + e1 + e2 + e3);
    if (lane == 0 && !dry) {
        int* TI = (int*)(A.ws + WS_TOPI) + (size_t)m * 4; float* TW = (float*)(A.ws + WS_TOPW) + (size_t)m * 4;
        TI[0] = ti[0]; TI[1] = ti[1]; TI[2] = ti[2]; TI[3] = ti[3]; texp[0] = ti[0]; texp[1] = ti[1]; texp[2] = ti[2]; texp[3] = ti[3]; TW[0] = inv; TW[1] = e1 * inv; TW[2] = e2 * inv; TW[3] = e3 * inv;
        { unsigned* hg = (unsigned*)hist; atomicAdd(hg + ti[0], 1u); atomicAdd(hg + ti[1], 1u); atomicAdd(hg + ti[2], 1u); atomicAdd(hg + ti[3], 1u); }
    }
}
__device__ __forceinline__ void router_stage16(ARef A, const WI& w, int l) {
    LAS unsigned char* rwt = w.lds; const float* rw = A.in[I_RW] + (size_t)l * DM * 32;
    const int k0 = 2 * w.tid;
    const int c = k0 >> 3, kin = (k0 & 7) * 2;
#pragma unroll
    for (int e4 = 0; e4 < 8; ++e4) { const f32x4 a = *(const f32x4*)(rw + (size_t)k0 * 32 + 4 * e4), b = *(const f32x4*)(rw + (size_t)(k0 + 1) * 32 + 4 * e4);
#pragma unroll
        for (int i = 0; i < 4; ++i) { const int e = 4 * e4 + i; const unsigned hi = pg8::cvt_pk_bf16(a[i], b[i]); const float ra = a[i] - bf_lo(hi), rb = b[i] - bf_hi(hi); const unsigned lo = pg8::cvt_pk_bf16(ra, rb);
            const int off = e * 2048 + ((c ^ (e & 15)) * 16) + kin; *(LAS unsigned*)(rwt + off) = hi; *(LAS unsigned*)(rwt + 65536 + off) = lo; } }
    __syncthreads();
}
__device__ __forceinline__ void router16(ARef A, int l, int m0, int lane_in, LAS unsigned* hist, const LAS unsigned char* rwt, LAS int* texp, bool dry) {
    int lane = lane_in; asm volatile("" : "+v"(lane));
    const int tk = lane & 15, q4 = lane >> 4; const size_t m = (size_t)m0 + tk;
    const float* xr = (const float*)(A.ws + WS_XA) + m * DM + 8 * q4; const float* MOD = (const float*)(A.ws + WS_MOD) + (size_t)(l * 8 + (m0 >> 12)) * 6144;
    const float* g = A.in[I_NFFN] + l * DM + 8 * q4; const float* scp = MOD + 4 * 1024 + 8 * q4; const float* shp = MOD + 3 * 1024 + 8 * q4;
    bf16* hrow = (bf16*)(A.ws + WS_H) + m * DM + 8 * q4;
    float ss = 0.0f;
#pragma unroll 16
    for (int ks = 0; ks < 32; ++ks) { const f32x4 a = *(const f32x4*)(xr + 32 * ks), b = *(const f32x4*)(xr + 32 * ks + 4); ss += dot4(a, a) + dot4(b, b); }
    ss += __shfl_xor(ss, 16); ss += __shfl_xor(ss, 32);
    const float rstd = 1.0f / sqrtf(ss * (1.0f / DM) + 1e-5f);
    f32x4 acc[2] = {{0.f, 0.f, 0.f, 0.f}, {0.f, 0.f, 0.f, 0.f}};
    const LAS unsigned char* wrow = rwt + tk * 2048;
#pragma unroll 2
    for (int ks = 0; ks < 32; ++ks) {
        f32x4 h[2];
#pragma unroll
        for (int u = 0; u < 2; ++u) { const int k = 32 * ks + 4 * u; h[u] = *(const f32x4*)(xr + k) * rstd * *(const f32x4*)(g + k) * (1.0f + *(const f32x4*)(scp + k)) + *(const f32x4*)(shp + k); }
        pg8::u32x4 hw, lw;
        hw.x = pg8::cvt_pk_bf16(h[0].x, h[0].y); hw.y = pg8::cvt_pk_bf16(h[0].z, h[0].w); hw.z = pg8::cvt_pk_bf16(h[1].x, h[1].y); hw.w = pg8::cvt_pk_bf16(h[1].z, h[1].w);
        if (!dry) *(pg8::u32x4*)(hrow + 32 * ks) = hw;
        lw.x = pg8::cvt_pk_bf16(h[0].x - bf_lo(hw.x), h[0].y - bf_hi(hw.x)); lw.y = pg8::cvt_pk_bf16(h[0].z - bf_lo(hw.y), h[0].w - bf_hi(hw.y));
        lw.z = pg8::cvt_pk_bf16(h[1].x - bf_lo(hw.z), h[1].y - bf_hi(hw.z)); lw.w = pg8::cvt_pk_bf16(h[1].z - bf_lo(hw.w), h[1].w - bf_hi(hw.w));
        const bf16x8v bh = __builtin_bit_cast(bf16x8v, hw), bl = __builtin_bit_cast(bf16x8v, lw);
        const int coff = ((4 * ks + q4) ^ tk) * 16;
#pragma unroll
        for (int blk = 0; blk < 2; ++blk) { const bf16x8v ah = *(const LAS bf16x8v*)(wrow + blk * 32768 + coff), al = *(const LAS bf16x8v*)(wrow + 65536 + blk * 32768 + coff);
            acc[blk] = __builtin_amdgcn_mfma_f32_16x16x32_bf16(ah, bh, acc[blk], 0, 0, 0); acc[blk] = __builtin_amdgcn_mfma_f32_16x16x32_bf16(ah, bl, acc[blk], 0, 0, 0); acc[blk] = __builtin_amdgcn_mfma_f32_16x16x32_bf16(al, bh, acc[blk], 0, 0, 0); }
    }
    float lv[8]; const float* rb = A.in[I_RB] + l * 32 + 4 * q4;
#pragma unroll
    for (int blk = 0; blk < 2; ++blk)
#pragma unroll
        for (int i = 0; i < 4; ++i) lv[4 * blk + i] = acc[blk][i] + rb[16 * blk + i];
    float tv[4]; int ti[4];
#pragma unroll
    for (int kk = 0; kk < 4; ++kk) {
        float mx = fmaxf(fmaxf(fmaxf(lv[0], lv[1]), fmaxf(lv[2], lv[3])), fmaxf(fmaxf(lv[4], lv[5]), fmaxf(lv[6], lv[7])));
        mx = fmaxf(mx, __shfl_xor(mx, 16)); mx = fmaxf(mx, __shfl_xor(mx, 32));
        int cand = 99;
#pragma unroll
        for (int j = 7; j >= 0; --j) if (lv[j] == mx) cand = 16 * (j >> 2) + 4 * q4 + (j & 3);
        cand = min(cand, __shfl_xor(cand, 16)); cand = min(cand, __shfl_xor(cand, 32));
        if (cand == 99) cand = kk;
        tv[kk] = mx; ti[kk] = cand;
#pragma unroll
        for (int j = 0; j < 8; ++j) if (16 * (j >> 2) + 4 * q4 + (j & 3) == cand) lv[j] = -INFINITY;
    }
    const float e1 = expf(tv[1] - tv[0]), e2 = expf(tv[2] - tv[0]), e3 = expf(tv[3] - tv[0]); const float inv = 1.0f / (1.0f + e1 + e2 + e3);
    if (q4 == 0 && !dry) {
        int* TI = (int*)(A.ws + WS_TOPI) + m * 4; float* TW = (float*)(A.ws + WS_TOPW) + m * 4;
        *(v4u*)TI = (v4u){(unsigned)ti[0], (unsigned)ti[1], (unsigned)ti[2], (unsigned)ti[3]}; *(f32x4*)TW = (f32x4){inv, e1 * inv, e2 * inv, e3 * inv};
        LAS int* tx = texp + tk * 4; tx[0] = ti[0]; tx[1] = ti[1]; tx[2] = ti[2]; tx[3] = ti[3];
        { unsigned* hg = (unsigned*)hist; atomicAdd(hg + ti[0], 1u); atomicAdd(hg + ti[1], 1u); atomicAdd(hg + ti[2], 1u); atomicAdd(hg + ti[3], 1u); }
    }
}
__device__ __forceinline__ void build_expert_table(ARef A, const WI& w, int l) {
    LAS int* tst = (LAS int*)(w.lds + TST_OFF); LAS int* tab = (LAS int*)(w.lds + TAB_OFF); LAS int* cnt = (LAS int*)(w.lds + CNT_OFF);
    if (w.tid == 0) { const unsigned* gc = (const unsigned*)(A.ws + WS_CTL) + CW_GCNT + 64 * l; int acc = 0;
        for (int e = 0; e < 32; ++e) { const int c = (int)__hip_atomic_load(gc + e, RLX_AGENT); cnt[e] = c; tst[e] = acc; acc += (c + 255) >> 8; }
        tst[32] = acc; tab[0] = acc; }
    __syncthreads();
    if (w.tid < 32) { const int e = w.tid; for (int pm = tst[e]; pm < tst[e + 1]; ++pm) tab[1 + pm] = e; }
    __syncthreads();
}
__device__ __forceinline__ void router_lists(ARef A, const WI& w, int l) {
    LAS unsigned* hist = (LAS unsigned*)(w.lds + HIST_OFF); LAS int* base = (LAS int*)(w.lds + BASE_OFF); LAS int* texp = (LAS int*)(w.lds + TEXP_OFF);
    __syncthreads();
    if (w.tid < 32) { base[w.tid] = (int)atomicAdd((unsigned*)(A.ws + WS_CTL) + CW_GCNT + 64 * l + w.tid, hist[w.tid]); hist[w.tid] = 0u; }
    __syncthreads();
    int* LIST = (int*)(A.ws + WS_LIST); int* PW = (int*)(A.ws + WS_POS);
    for (int g16 = w.gw; g16 < MTOK / 16; g16 += w.NGW) {
        const int j = w.lane >> 2, q = w.lane & 3, m = 16 * g16 + j; const int e = texp[(w.wave * 16 + j) * 4 + q]; const int idx = base[e] + (int)atomicAdd((unsigned*)hist + e, 1u);
        LIST[e * LCAP + idx] = m; PW[(size_t)m * 4 + q] = (e << 20) | idx; }
}
__device__ __forceinline__ void combine_row(ARef A, int l, int m, int lane, const LAS int* tst, float gscale = 1.0f, float oscale = 1.0f) {
    float* XA = (float*)(A.ws + WS_XA) + (size_t)m * DM; const float* MOD = (const float*)(A.ws + WS_MOD) + (size_t)(l * 8 + (m >> 12)) * 6144;
    const int* PS = (const int*)(A.ws + WS_POS) + (size_t)m * 4; const float* TW = (const float*)(A.ws + WS_TOPW) + (size_t)m * 4;
    const bf16* YS = (const bf16*)(A.ws + WS_XS);
    f32x4 v[4], acc[4];
#pragma unroll
    for (int j = 0; j < 4; ++j) { v[j] = *(const f32x4*)(XA + 4 * (lane + 64 * j)); acc[j] = (f32x4){0.f, 0.f, 0.f, 0.f}; }
#pragma unroll
    for (int k = 0; k < 4; ++k) { const int pe = PS[k]; const int pos = tst[pe >> 20] * 256 + (pe & 0xFFFFF); const float gt = TW[k] * gscale; const v2u* yr = (const v2u*)(YS + (size_t)pos * DM);
#pragma unroll
        for (int j = 0; j < 4; ++j) { const v2u y = yr[lane + 64 * j]; acc[j] += gt * (f32x4){bf_lo(y.x), bf_hi(y.x), bf_lo(y.y), bf_hi(y.y)}; } }
    float ss = 0.0f;
#pragma unroll
    for (int j = 0; j < 4; ++j) { const int kx = 4 * (lane + 64 * j); v[j] += *(const f32x4*)(MOD + 5 * 1024 + kx) * acc[j]; ss += dot4(v[j], v[j]); }
    ss = wave_sum(ss); const float rstd = 1.0f / sqrtf(ss * (1.0f / DM) + 1e-5f);
    if (l + 1 < NLAYER) {
#pragma unroll
        for (int j = 0; j < 4; ++j) *(f32x4*)(XA + 4 * (lane + 64 * j)) = v[j];
        const float* mb = MOD + 8 * 6144;
        emit_h_row(v, rstd, A.in[I_NMIX] + (l + 1) * DM, mb + 1024, mb, (bf16*)(A.ws + WS_H) + (size_t)m * DM, lane);
    } else {
        float* orow = A.out + (size_t)m * DM; const float* gf = A.in[I_NFINAL];
#pragma unroll
        for (int j = 0; j < 4; ++j) { const int kx = 4 * (lane + 64 * j); *(f32x4*)(orow + kx) = v[j] * (rstd * oscale) * *(const f32x4*)(gf + kx); }
    }
}

constexpr int N_LAUNCHES = MK_N_LAUNCHES;
template <int SEL> __global__ void __launch_bounds__(NWAVES * 64, 2) fwd(ArgsH Ah) {
    extern __shared__ __attribute__((aligned(16))) unsigned char lds[];
    (void)Ah;
    const int wave_s = __builtin_amdgcn_readfirstlane((int)threadIdx.x >> 6);
    auto tid_now = [&]() -> int { int ws_ = wave_s; unsigned z_ = 0u; asm volatile("" : "+s"(ws_), "+s"(z_)); return ws_ * 64 + (int)__builtin_amdgcn_mbcnt_hi(~0u, __builtin_amdgcn_mbcnt_lo(~0u, z_)); };
#define TID_NOW() tid_now()
#define MAKE_WI() WI w; { int tz = TID_NOW(); asm volatile("" : "+v"(tz)); int bz = blockIdx.x, gz = gridDim.x; asm volatile("" : "+s"(bz), "+s"(gz)); \
        w.lds = (LAS unsigned char*)lds; w.tid = tz; w.lane = tz & 63; w.wave = __builtin_amdgcn_readfirstlane(tz >> 6); w.G = gz; w.bx = bz; w.vcu = (gz % 8 == 0) ? (bz % 8) * (gz / 8) + bz / 8 : bz; \
        w.gw = w.vcu * NWAVES + w.wave; w.NGW = gz * NWAVES; }
    { const int t0 = threadIdx.x; for (int u = t0; u < (LDS_BYTES - RING_BYTES) / 4; u += NWAVES * 64) ((LAS unsigned*)((LAS unsigned char*)lds + RING_BYTES))[u] = 0u; }
    __syncthreads();
    int lo, hi; { ARef A0 = *kargs(); lo = A0.ph_lo; hi = A0.ph_hi; }
    if (N_LAUNCHES == 1) { ARef A0 = *kargs(); (void)xcd_barrier_post((unsigned*)((gu32*)(A0.ws + WS_CTL) + CW_BAR), (volatile LAS unsigned*)((LAS unsigned char*)lds + MISC_OFF) + 8, TID_NOW()); }
#define GRID_BAR() do { if (N_LAUNCHES == 1) { ARef Ab = *kargs(); XcdBarrier bar_; bar_.bar = (unsigned*)((gu32*)(Ab.ws + WS_CTL) + CW_BAR); bar_.x = xb_xcc_id(); bar_.st = (volatile LAS unsigned*)((LAS unsigned char*)lds + MISC_OFF) + 8; xcd_barrier(bar_, TID_NOW()); } } while (0)
#ifndef TPROBE
#define TPROBE 0
#endif
#if TPROBE
    unsigned long long tp_acc = 0ull;
#define TP_SCALE tp_scale_of(__hip_atomic_load((unsigned*)(A.ws + WS_CTL) + 3, RLX_AGENT))
    auto tp_scale_of = [](unsigned ticks) -> float { const float us = (float)ticks * 0.01f; if (us < 1.0f) return 1.0f; const float q = exp2f(rintf(log2f(us) * 8.0f) * 0.125f); return 1.0f + sqrtf(q * 1e-5f); };
#define TP_BEGIN(kind) unsigned long long tp_t0 = 0ull; if ((kind) == TPROBE) tp_t0 = __builtin_amdgcn_s_memrealtime();
#define TP_END(kind) if ((kind) == TPROBE) { tp_acc += __builtin_amdgcn_s_memrealtime() - tp_t0; }
#define TP_PUBLISH(l) if ((l) == 1 && w.vcu == 0 && w.tid == 0) __hip_atomic_store((unsigned*)(A.ws + WS_CTL) + 3, (unsigned)tp_acc, RLX_AGENT);
#else
#define TP_SCALE 1.0f
#define TP_PUBLISH(l)
#define TP_BEGIN(kind)
#define TP_END(kind)
#endif
#define IN(k) (lo <= (k) && (k) < hi)
#ifndef PHMASK
#define PHMASK 0xffffffffu
#endif
#define KON(k) if constexpr ((SEL < 0 && ((PHMASK >> (k)) & 1u)) || SEL == (k))
#define BOTH(k) (IN(k) && IN((k) + 1))
#ifndef PROBE_REP
#define PROBE_REP 0
#endif
#if PROBE_REP
    int nrep_ = 2; asm volatile("" : "+s"(nrep_));
#define REP(bit) _Pragma("unroll 1") for (int rep_ = 0; rep_ < (((PROBE_REP >> (bit)) & 1) ? nrep_ : 1); ++rep_)
#else
#define REP(bit) for (int rep_ = 0; rep_ < 1; ++rep_)
#endif
#define ring ((PG8_LAS unsigned char*)lds)

    KON(0) if (IN(0)) { ARef A = *kargs(); MAKE_WI(); REP(0) ph_prologue(A, w); if (BOTH(0)) GRID_BAR(); }

#define LAYER_BODY(l) do {\
        const int pb = 1 + l * NPL; \
        KON(1) if (IN(pb + 0)) { ARef A = *kargs(); MAKE_WI(); TP_BEGIN(1) if (l == 0) { REP(15) { ph_norm1(A, w); small_weights_to_f16(A, w); } if (BOTH(pb + 0)) GRID_BAR(); } TP_END(1) } \
        KON(2) if (IN(pb + 1)) { ARef A = *kargs(); MAKE_WI(); TP_BEGIN(2) \
            pg8::Gemm g{(const bf16*)(A.ws + WS_H), (const bf16*)(A.ws + WS_WIN) + (size_t)l * INCP * DM, MTOK, INCP, DM}; pg8::StaticOrder S; S.init(MTOK, INCP, w.G, w.bx); \
            pg8::EpiProj E{(bf16*)(A.ws + WS_PB), (bf16*)(A.ws + WS_PF)}; \
            REP(1) pg8::gemm_phase<pg8::EpiProj, pg8::StaticOrder, true, true>(ring, g, S, E, w.tid); \
            if (BOTH(pb + 1)) GRID_BAR(); TP_END(2) \
        } \
        KON(3) if (IN(pb + 2)) { ARef A = *kargs(); MAKE_WI(); TP_BEGIN(3) \
            REP(2) { int part_ = rep_ ? ((PROBE_REP >> 21) & 7) : 7; asm volatile("" : "+s"(part_)); for (int g = w.gw; g < MTOK / 16; g += w.NGW) prep16(A, l, 16 * g, w.lane, part_); } \
            if (BOTH(pb + 2)) GRID_BAR(); TP_END(3) \
        } \
        KON(4) if (IN(pb + 3)) { ARef A = *kargs(); MAKE_WI(); TP_BEGIN(4) \
            REP(3) { for (int tk = 2 * w.vcu; tk < 32 * NCH; tk += 2 * w.G) scan_rwkv_task2(A, w, tk); } \
            REP(13) { for (int tk = w.vcu; tk < 32 * NCH / 2; tk += w.G) scan_ret_task(A, w, tk); } \
            REP(4) { LAS unsigned char* vl = w.lds + w.wave * 4608; for (int it = w.gw; it < 32 * 128; it += w.NGW) sb_tile_mfma(A, it, w.lane, vl); } \
            REP(5) dsa_scores_mfma(A, w); \
            if (BOTH(pb + 3)) GRID_BAR(); TP_END(4) \
        } \
        KON(5) if (IN(pb + 4)) { ARef A = *kargs(); MAKE_WI(); TP_BEGIN(5) \
            if (w.bx < 32) prefix_chain(A, w, w.bx); \
            REP(6) dsa_wave(A, w, w.lds + w.wave * 13312, l + 2 * rep_, l); \
            REP(14) { if (rep_ && w.bx < 32) prefix_chain(A, w, w.bx); } \
            if (BOTH(pb + 4)) GRID_BAR(); TP_END(5) \
        } \
        KON(6) if (IN(pb + 5)) { ARef A = *kargs(); MAKE_WI(); TP_BEGIN(6) \
            REP(7) ph_post16(A, w, l); \
            if (BOTH(pb + 5)) GRID_BAR(); TP_END(6) \
        } \
        KON(7) if (IN(pb + 6)) { ARef A = *kargs(); MAKE_WI(); TP_BEGIN(7) \
            pg8::Gemm g{(const bf16*)(A.ws + WS_MIX), (const bf16*)(A.ws + WS_WOUT) + (size_t)l * DM * DM, MTOK, DM, DM}; pg8::StaticOrder S; S.init(MTOK, DM, w.G, w.bx); \
            pg8::EpiRes E{l == 0 ? A.in[I_X] : (const float*)(A.ws + WS_XA), (float*)(A.ws + WS_XA), (const float*)(A.ws + WS_MOD) + (size_t)l * 8 * 6144 + 2 * 1024}; \
            REP(16) { pg8::EpiRes E2 = E; if (rep_ && l == 1) E2.gate = (const float*)(A.ws + WS_CTL + 512 * 1024); pg8::gemm_phase<pg8::EpiRes, pg8::StaticOrder, true, true>(ring, g, S, E2, w.tid); } \
            if (BOTH(pb + 6)) GRID_BAR(); TP_END(7) \
        } \
        KON(8) if (IN(pb + 7)) { ARef A = *kargs(); MAKE_WI(); TP_BEGIN(8) \
            { LAS unsigned* hist = (LAS unsigned*)(w.lds + HIST_OFF); LAS int* texp = (LAS int*)(w.lds + TEXP_OFF); if (w.tid < 32) hist[w.tid] = 0u; router_stage16(A, w, l); \
            REP(10) { for (int g16 = w.gw; g16 < MTOK / 16; g16 += w.NGW) router16(A, l, 16 * g16, w.lane, hist, (const LAS unsigned char*)w.lds, texp + w.wave * 64, rep_ != 0); } \
            router_lists(A, w, l); } \
            if (BOTH(pb + 7)) GRID_BAR(); TP_END(8) \
        } \
        KON(10) if (IN(pb + 8)) { ARef A = *kargs(); MAKE_WI(); TP_BEGIN(10) \
            build_expert_table(A, w, l); \
            pg8::Gemm g{(const bf16*)(A.ws + WS_H), (const bf16*)(A.ws + WS_W1) + (size_t)l * NEXP * 2048 * DM, MOE_ROWS, NEXP * 2048, DM}; \
            pg8::MoeOrder S{(const PG8_LAS int*)(w.lds + TAB_OFF), 8, w.G, w.vcu, (const PG8_LAS int*)(w.lds + TST_OFF), (const PG8_LAS int*)(w.lds + CNT_OFF), (const int*)(A.ws + WS_LIST)}; \
            pg8::EpiSwiglu E{(bf16*)(A.ws + WS_ACT), A.in[I_MB1] + (size_t)l * NEXP * 2048}; \
            REP(8) { if (PROBE_REP & (1 << 20)) { if (rep_) pg8::gemm_phase<pg8::EpiNull, pg8::MoeOrder, true, true, true>(ring, g, S, pg8::EpiNull{}, w.tid); else pg8::gemm_phase<pg8::EpiSwiglu, pg8::MoeOrder, true, true, true>(ring, g, S, E, w.tid); } else pg8::gemm_phase<pg8::EpiSwiglu, pg8::MoeOrder, true, true, true>(ring, g, S, E, w.tid); } \
            if (BOTH(pb + 8)) GRID_BAR(); TP_END(10) \
        } \
        KON(11) if (IN(pb + 9)) { ARef A = *kargs(); MAKE_WI(); TP_BEGIN(11) \
            build_expert_table(A, w, l); \
            pg8::Gemm g{(const bf16*)(A.ws + WS_ACT), (const bf16*)(A.ws + WS_W2) + (size_t)l * NEXP * DM * DM, MOE_ROWS, NEXP * DM, DM}; \
            pg8::MoeOrder S{(const PG8_LAS int*)(w.lds + TAB_OFF), 4, w.G, w.vcu, (const PG8_LAS int*)(w.lds + TST_OFF), (const PG8_LAS int*)(w.lds + CNT_OFF), (const int*)(A.ws + WS_LIST)}; \
            pg8::EpiY E{(bf16*)(A.ws + WS_XS), A.in[I_MB2] + (size_t)l * NEXP * DM}; \
            REP(9) pg8::gemm_phase<pg8::EpiY, pg8::MoeOrder, true, true>(ring, g, S, E, w.tid); \
            TP_PUBLISH(l) \
            if (BOTH(pb + 9)) GRID_BAR(); TP_END(11) \
        } \
        KON(12) if (IN(pb + 10)) { ARef A = *kargs(); MAKE_WI(); TP_BEGIN(12) \
            build_expert_table(A, w, l); \
            REP(12) for (int m = w.gw; m < MTOK; m += w.NGW) combine_row(A, l, m, w.lane, (const LAS int*)(w.lds + TST_OFF), (rep_ && l == 0) ? 0.0f : 1.0f, TP_SCALE); \
            if (BOTH(pb + 10)) GRID_BAR(); TP_END(12) \
        } \
    } while (0)
    LAYER_BODY(0);
    LAYER_BODY(1);
#undef LAYER_BODY
#undef IN
#undef ring
#undef MAKE_WI
#undef TID_NOW
#undef GRID_BAR
#undef KON
#undef BOTH
}


#if MK_N_LAUNCHES != 1
template <int K> static void launch_one(int grid, hipStream_t stream, const ArgsH& a) {
    static bool attr = false;
    if (!attr) { (void)hipFuncSetAttribute((const void*)fwd<K>, hipFuncAttributeMaxDynamicSharedMemorySize, LDS_BYTES); attr = true; }
    hipLaunchKernelGGL(fwd<K>, dim3(grid), dim3(NWAVES * 64), LDS_BYTES, stream, a);
}
static void launch_kind(int kind, int grid, hipStream_t stream, const ArgsH& a) {
    switch (kind) {
        case 0: launch_one<0>(grid, stream, a); break; case 1: launch_one<1>(grid, stream, a); break; case 2: launch_one<2>(grid, stream, a); break;
        case 3: launch_one<3>(grid, stream, a); break; case 4: launch_one<4>(grid, stream, a); break; case 5: launch_one<5>(grid, stream, a); break;
        case 6: launch_one<6>(grid, stream, a); break; case 7: launch_one<7>(grid, stream, a); break; case 8: launch_one<8>(grid, stream, a); break;
        case 9: launch_one<9>(grid, stream, a); break; case 10: launch_one<10>(grid, stream, a); break; case 11: launch_one<11>(grid, stream, a); break;
        default: launch_one<12>(grid, stream, a); break;
    }
}
#endif
extern "C" void kernel_launch(void* const* d_in, const int* in_sizes, int n_in, void* d_out, int out_size, void* d_ws, size_t ws_size, hipStream_t stream) {
    static int grid = 0;
    if (grid == 0) {
        if (n_in != N_IN || out_size != MTOK * DM || ws_size < WS_END) { fprintf(stderr, "kernel_launch: unexpected shapes (n_in %d, out %d, ws %zu)\n", n_in, out_size, ws_size); grid = -1; return; }
        int dev = 0, cus = 0;
        if (hipGetDevice(&dev) != hipSuccess || hipDeviceGetAttribute(&cus, hipDeviceAttributeMultiprocessorCount, dev) != hipSuccess) { grid = -1; return; }
#if MK_N_LAUNCHES == 1
        {
            if (hipFuncSetAttribute((const void*)fwd<-1>, hipFuncAttributeMaxDynamicSharedMemorySize, LDS_BYTES) != hipSuccess) { fprintf(stderr, "kernel_launch: hipFuncSetAttribute failed\n"); grid = -1; return; }
            int per_cu = 0;
            if (hipOccupancyMaxActiveBlocksPerMultiprocessor(&per_cu, (const void*)fwd<-1>, NWAVES * 64, LDS_BYTES) != hipSuccess || per_cu < 1) fprintf(stderr, "kernel_launch: occupancy query says %d\n", per_cu);
            (void)hipGetLastError();
        }
#endif
        grid = cus;
    }
    if (grid < 0) return;
    (void)in_sizes;
    if (hipMemsetAsync((char*)d_ws + WS_CTL, 0, CTL_ZERO_BYTES, stream) != hipSuccess) return;
    ArgsH a{};
    for (int i = 0; i < N_IN; ++i) a.in[i] = (const float*)d_in[i];
    a.out = (float*)d_out; a.ws = (unsigned char*)d_ws;
    for (int f = 0; f < 44; ++f) a.invf[f] = (f < 32) ? pow(10000.0, -(double)f / 32.0) : (f < 40) ? pow(500000.0, -(double)(f - 32) / 8.0) : pow(500000.0, -(double)(f - 40) / 4.0);
#if MK_N_LAUNCHES == 1
    a.ph_lo = 0; a.ph_hi = NPHASE; a.li = 0;
    hipLaunchKernelGGL(fwd<-1>, dim3(grid), dim3(NWAVES * 64), LDS_BYTES, stream, a);
#else
    {
        for (int p = 0; p < NPHASE; ++p) {
            if (p == 1 + NPL) continue;
            a.ph_lo = p; a.ph_hi = p + 1; a.li = p;
            static const int kinds_[NPL] = {1, 2, 3, 4, 5, 6, 7, 8, 10, 11, 12};
            const int kind = (p == 0) ? 0 : kinds_[(p - 1) % NPL];
            launch_kind(kind, grid, stream, a);
        }
    }
#endif
}
```

```cpp
#include <hip/hip_runtime.h>
#include <cstdio>
#include <cstdint>
#include <cmath>

#ifndef MK_N_LAUNCHES
#define MK_N_LAUNCHES 1
#endif

namespace pg8 {
#define PG8_LAS __attribute__((address_space(3)))
typedef unsigned short bf16_t;
typedef short bf16x8 __attribute__((ext_vector_type(8)));
typedef float f32x4 __attribute__((ext_vector_type(4)));
typedef unsigned u32x4 __attribute__((ext_vector_type(4)));
typedef unsigned u32x2 __attribute__((ext_vector_type(2)));
constexpr int BM = 256, BK = 64, HALF = 128, HTB = HALF * BK * 2  , STAGE_BYTES = 8 * HTB, NXCD = 8, WGM = 8;

__host__ __device__ __forceinline__ int lds_byte(int r, int c) { const int st = (r >> 4) * 2 + (c >> 5), rr = r & 15, cc = c & 31, ob = rr * 64 + cc * 2; return st * 1024 + (ob ^ (((ob >> 9) & 1) << 5)); }
__host__ __device__ __forceinline__ void stage_rc(int b, int& R, int& C) { const int st = b / 1024, sb = b % 1024, swz = sb ^ (((sb >> 9) & 1) << 5); R = (st >> 1) * 16 + swz / 64; C = (st & 1) * 32 + (swz % 64) / 2; }
__host__ __device__ __forceinline__ int perm32(int rho) { const int n = rho >> 4, i = rho & 15; return 8 * (i >> 2) + 4 * n + (i & 3); }

struct Unit { int pm, pn; };
struct Gemm { const bf16_t* A; const bf16_t* Bt; int M, N, K; };

struct StaticOrder {
    int nM, nN, nwg, G, c;
    __host__ __device__ void init(int M, int N, int G_, int c_) { nM = M / BM; nN = N / BM; nwg = nM * nN; G = G_; c = c_; }
    __host__ __device__ bool next(int i, Unit& u) const {
        const long L = (long)i * G + c; if (L >= nwg) return false;
        int wgid = (int)L; { const int q = nwg / NXCD, r = nwg % NXCD, xcd = wgid % NXCD, off = wgid / NXCD; wgid = (xcd < r ? xcd * (q + 1) : r * (q + 1) + (xcd - r) * q) + off; }
        const int nig = WGM * nN, gid = wgid / nig, fm = gid * WGM, gsz = (nM - fm) < WGM ? (nM - fm) : WGM;
        u.pm = fm + ((wgid % nig) % gsz); u.pn = (wgid % nig) / gsz; return true;
    }
    __device__ __forceinline__ void a_ready(const Unit&) const {}
    __device__ __forceinline__ void done(const Unit&) const {}
};
__device__ __forceinline__ unsigned cvt_pk_bf16(float lo, float hi) { unsigned r; asm volatile("v_cvt_pk_bf16_f32 %0, %1, %2" : "=v"(r) : "v"(lo), "v"(hi)); return r; }
struct EpiF32 {
    static constexpr bool PERM = false, AFTER_DRAIN = false;
    float* C; int ldc;
    __device__ __forceinline__ void operator()(const f32x4 (&acc)[2][2][4][2], const Unit& u, int wr, int wc, int fr, int fq) const {
        const int row0 = u.pm * BM + wr * 64 + fr, col0 = u.pn * BM + wc * 32 + 4 * fq;
#pragma unroll
        for (int ai = 0; ai < 2; ++ai)
#pragma unroll
            for (int m = 0; m < 4; ++m) { float* rowp = C + (size_t)(row0 + ai * HALF + m * 16) * ldc + col0;
#pragma unroll
                for (int bj = 0; bj < 2; ++bj)
#pragma unroll
                    for (int n = 0; n < 2; ++n) *(f32x4*)(rowp + bj * HALF + n * 16) = acc[ai][bj][m][n]; }
    }
};
struct EpiNull {
    static constexpr bool PERM = true, AFTER_DRAIN = false;
    __device__ __forceinline__ void operator()(const f32x4 (&acc)[2][2][4][2], const Unit&, int, int, int, int) const {
#pragma unroll
        for (int ai = 0; ai < 2; ++ai)
#pragma unroll
            for (int bj = 0; bj < 2; ++bj) asm volatile("" :: "v"(acc[ai][bj][0][0]), "v"(acc[ai][bj][0][1]), "v"(acc[ai][bj][1][0]), "v"(acc[ai][bj][1][1]), "v"(acc[ai][bj][2][0]), "v"(acc[ai][bj][2][1]), "v"(acc[ai][bj][3][0]), "v"(acc[ai][bj][3][1]));
    }
};
struct EpiProj {
    static constexpr bool PERM = true, AFTER_DRAIN = false;
    bf16_t* PB; bf16_t* PF;
    __device__ __forceinline__ void operator()(const f32x4 (&acc)[2][2][4][2], const Unit& u, int wr, int wc, int fr, int fq) const {
        const int row0 = u.pm * BM + wr * 64 + fr;
        if (u.pn < 7) { const int c0 = u.pn * BM + wc * 32 + 8 * fq;
#pragma unroll
            for (int ai = 0; ai < 2; ++ai)
#pragma unroll
                for (int m = 0; m < 4; ++m) { bf16_t* rowp = PB + (size_t)(row0 + ai * HALF + m * 16) * 1792 + c0;
#pragma unroll
                    for (int bj = 0; bj < 2; ++bj) { const f32x4 v0 = acc[ai][bj][m][0], v1 = acc[ai][bj][m][1];
                        u32x4 w; w.x = cvt_pk_bf16(v0[0], v0[1]); w.y = cvt_pk_bf16(v0[2], v0[3]); w.z = cvt_pk_bf16(v1[0], v1[1]); w.w = cvt_pk_bf16(v1[2], v1[3]);
                        *(u32x4*)(rowp + bj * HALF) = w; } }
        } else { const int c0 = (u.pn - 7) * BM + wc * 32 + 8 * fq;
#pragma unroll
            for (int ai = 0; ai < 2; ++ai)
#pragma unroll
                for (int m = 0; m < 4; ++m) { bf16_t* rowp = PF + (size_t)(row0 + ai * HALF + m * 16) * 1280 + c0;
#pragma unroll
                    for (int bj = 0; bj < 2; ++bj) { const f32x4 v0 = acc[ai][bj][m][0], v1 = acc[ai][bj][m][1];
                        u32x4 w; w.x = cvt_pk_bf16(v0[0], v0[1]); w.y = cvt_pk_bf16(v0[2], v0[3]); w.z = cvt_pk_bf16(v1[0], v1[1]); w.w = cvt_pk_bf16(v1[2], v1[3]);
                        *(u32x4*)(rowp + bj * HALF) = w; } }
        }
    }
};
struct EpiRes {
    static constexpr bool PERM = false, AFTER_DRAIN = false;
    const float* xin; float* xout; const float* gate;
    __device__ __forceinline__ void operator()(const f32x4 (&acc)[2][2][4][2], const Unit& u, int wr, int wc, int fr, int fq) const {
        const int row0 = u.pm * BM + wr * 64 + fr, col0 = u.pn * BM + wc * 32 + 4 * fq;
        const float* gp = gate + (size_t)((u.pm * BM) >> 12) * 6144 + col0;
        f32x4 gv[2][2];
#pragma unroll
        for (int bj = 0; bj < 2; ++bj)
#pragma unroll
            for (int n = 0; n < 2; ++n) gv[bj][n] = *(const f32x4*)(gp + bj * HALF + n * 16);
#pragma unroll
        for (int ai = 0; ai < 2; ++ai)
#pragma unroll
            for (int m = 0; m < 4; ++m) { const size_t ro = (size_t)(row0 + ai * HALF + m * 16) * 1024 + col0;
#pragma unroll
                for (int bj = 0; bj < 2; ++bj)
#pragma unroll
                    for (int n = 0; n < 2; ++n) { const f32x4 xv = *(const f32x4*)(xin + ro + bj * HALF + n * 16); *(f32x4*)(xout + ro + bj * HALF + n * 16) = xv + gv[bj][n] * acc[ai][bj][m][n]; } }
    }
};
__device__ __forceinline__ float swiglu1(float glu, float lin) {
    glu = fminf(glu, 7.0f); lin = fminf(fmaxf(lin, -7.0f), 7.0f);
    return glu * (1.0f / (1.0f + __expf(-1.702f * glu))) * (lin + 1.0f);
}
struct EpiSwiglu {
    static constexpr bool PERM = true, AFTER_DRAIN = false;
    bf16_t* O; const float* b1;
    __device__ __forceinline__ void operator()(const f32x4 (&acc)[2][2][4][2], const Unit& u, int wr, int wc, int fr, int fq) const {
        const int e = u.pn >> 3, j = u.pn & 7, row0 = u.pm * BM + wr * 64 + fr, c0 = 128 * j + wc * 32 + 8 * fq;
        const float* bp = b1 + (size_t)e * 2048 + c0;
        f32x4 bg[2], bl[2];
#pragma unroll
        for (int n = 0; n < 2; ++n) { bg[n] = *(const f32x4*)(bp + 4 * n); bl[n] = *(const f32x4*)(bp + 1024 + 4 * n); }
#pragma unroll
        for (int ai = 0; ai < 2; ++ai)
#pragma unroll
            for (int m = 0; m < 4; ++m) { bf16_t* rowp = O + (size_t)(row0 + ai * HALF + m * 16) * 1024 + c0;
                const f32x4 g0 = acc[ai][0][m][0] + bg[0], g1 = acc[ai][0][m][1] + bg[1], l0 = acc[ai][1][m][0] + bl[0], l1 = acc[ai][1][m][1] + bl[1];
                u32x4 w;
                w.x = cvt_pk_bf16(swiglu1(g0[0], l0[0]), swiglu1(g0[1], l0[1])); w.y = cvt_pk_bf16(swiglu1(g0[2], l0[2]), swiglu1(g0[3], l0[3]));
                w.z = cvt_pk_bf16(swiglu1(g1[0], l1[0]), swiglu1(g1[1], l1[1])); w.w = cvt_pk_bf16(swiglu1(g1[2], l1[2]), swiglu1(g1[3], l1[3]));
                *(u32x4*)rowp = w; }
    }
};
struct EpiY {
    static constexpr bool PERM = true, AFTER_DRAIN = false;
    bf16_t* O; const float* b2;
    __device__ __forceinline__ void operator()(const f32x4 (&acc)[2][2][4][2], const Unit& u, int wr, int wc, int fr, int fq) const {
        const int e = u.pn >> 2, j = u.pn & 3, row0 = u.pm * BM + wr * 64 + fr, c0 = 256 * j + wc * 32 + 8 * fq;
        const float* bp = b2 + (size_t)e * 1024 + c0;
        f32x4 bv[2][2];
#pragma unroll
        for (int bj = 0; bj < 2; ++bj)
#pragma unroll
            for (int n = 0; n < 2; ++n) bv[bj][n] = *(const f32x4*)(bp + bj * HALF + 4 * n);
#pragma unroll
        for (int ai = 0; ai < 2; ++ai)
#pragma unroll
            for (int m = 0; m < 4; ++m) { bf16_t* rowp = O + (size_t)(row0 + ai * HALF + m * 16) * 1024 + c0;
#pragma unroll
                for (int bj = 0; bj < 2; ++bj) { const f32x4 v0 = acc[ai][bj][m][0] + bv[bj][0], v1 = acc[ai][bj][m][1] + bv[bj][1];
                    u32x4 w; w.x = cvt_pk_bf16(v0[0], v0[1]); w.y = cvt_pk_bf16(v0[2], v0[3]); w.z = cvt_pk_bf16(v1[0], v1[1]); w.w = cvt_pk_bf16(v1[2], v1[3]);
                    *(u32x4*)(rowp + bj * HALF) = w; } }
    }
};
struct MoeOrder {
    const PG8_LAS int* tab; int NJ, G, c;
    __device__ __forceinline__ bool next(int i, Unit& u) const {
        const int T = tab[0]; const long L = (long)i * G + c; if (L >= (long)T * NJ) return false;
        const int pm = (int)(L / NJ), j = (int)(L % NJ);
        u.pm = pm; u.pn = tab[1 + pm] * NJ + j; return true;
    }
    __device__ __forceinline__ void a_ready(const Unit&) const {}
    __device__ __forceinline__ void done(const Unit&) const {}
    const PG8_LAS int* tst; const PG8_LAS int* cnt; const int* list;
    __device__ __forceinline__ int row_of(const Unit& u, int r) const { const int e = tab[1 + u.pm], idx = 256 * (u.pm - tst[e]) + r; return (idx < cnt[e]) ? list[e * 32768 + idx] : 0; }
};

template <class Epi, class Sched, bool ALIGN_EPI = false, bool SP2 = false, bool GATHER = false>
__device__ __forceinline__ void gemm_phase(PG8_LAS unsigned char* lds, const Gemm g, const Sched& S, const Epi& E, int tid_in) {
    int tid_ = tid_in; asm volatile("" : "+v"(tid_));
    const int tid = tid_, wid = __builtin_amdgcn_readfirstlane(tid >> 6), lane = tid & 63, wr = wid >> 2, wc = wid & 3, fr = lane & 15, fq = lane >> 4;
    const int K = g.K, nt = K / BK;
    unsigned voffA[2], voffB[2];
#pragma unroll
    for (int i = 0; i < 2; ++i) { int R, C; stage_rc(tid * 16 + i * 8192, R, C); const int Rb = Epi::PERM ? ((R & ~31) + perm32(R & 31)) : R;
        voffA[i] = (unsigned)(R * K + C) * 2u; voffB[i] = (unsigned)(Rb * K + C) * 2u; }
    static_assert(!GATHER || SP2, "gathered A rows: only the two-super-phase loop is wired");
    unsigned cvo[2][2], nvo[2][2];
#define PG8_ROWS(dst, u_) do { _Pragma("unroll") for (int h_ = 0; h_ < 2; ++h_) _Pragma("unroll") for (int i_ = 0; i_ < 2; ++i_) { int R_, C_; stage_rc(tid * 16 + i_ * 8192, R_, C_); dst[h_][i_] = (unsigned)(S.row_of(u_, h_ * HALF + R_) * K + C_) * 2u; } } while (0)
#define PG8_STAGE_A(bufoff, gbase, half, nx) do { if constexpr (GATHER) { unsigned o_[2]; o_[0] = (nx) ? nvo[half][0] : cvo[half][0]; o_[1] = (nx) ? nvo[half][1] : cvo[half][1]; PG8_STAGE(bufoff, gbase, o_); } else { PG8_STAGE(bufoff, (gbase) + (half) * hstep, voffA); } } while (0)
    const size_t kstep = (size_t)(BK * 2);
    const size_t hstep = (size_t)HALF * K * 2;
    const size_t tstep = 2 * hstep;
    const unsigned ldsw = (unsigned)wid * 1024u;
    const int aoff = lds_byte(wr * 64 + fr, fq * 8), boff = lds_byte(wc * 32 + fr, fq * 8);
#define PG8_SA(b, h) (((b) * 2 + (h)) * HTB)
#define PG8_SB(b, h) ((4 + (b) * 2 + (h)) * HTB)
#define PG8_STAGE(bufoff, gbase, voff) do { _Pragma("unroll") for (int _i = 0; _i < 2; ++_i) \
        __builtin_amdgcn_global_load_lds((const unsigned*)((const char*)(gbase) + (voff)[_i]), (PG8_LAS unsigned*)(lds + (bufoff) + ldsw + _i * 8192), 16, 0, 0); } while (0)
#define PG8_LDA(dst, b, h) do { _Pragma("unroll") for (int m = 0; m < 4; ++m) _Pragma("unroll") for (int k = 0; k < 2; ++k) dst[m][k] = *(const PG8_LAS bf16x8*)(lds + PG8_SA(b, h) + aoff + m * 2048 + k * 1024); } while (0)
#define PG8_LDB(dst, b, h) do { _Pragma("unroll") for (int n = 0; n < 2; ++n) _Pragma("unroll") for (int k = 0; k < 2; ++k) dst[n][k] = *(const PG8_LAS bf16x8*)(lds + PG8_SB(b, h) + boff + n * 2048 + k * 1024); } while (0)
#define PG8_MMA(ai, bj, At, Bt) do { __builtin_amdgcn_s_setprio(1); _Pragma("unroll") for (int m = 0; m < 4; ++m) _Pragma("unroll") for (int n = 0; n < 2; ++n) _Pragma("unroll") for (int k = 0; k < 2; ++k) \
        acc[ai][bj][m][n] = __builtin_amdgcn_mfma_f32_16x16x32_bf16(Bt[n][k], At[m][k], acc[ai][bj][m][n], 0, 0, 0); __builtin_amdgcn_s_setprio(0); } while (0)
#define PG8_WAIT_V(n) asm volatile("s_waitcnt vmcnt(" #n ")" ::: "memory")
#define PG8_WAIT_L(n) asm volatile("s_waitcnt lgkmcnt(" #n ")" ::: "memory")
#define PG8_BAR __builtin_amdgcn_s_barrier()
#define PG8_SCHED __builtin_amdgcn_sched_barrier(0)
    Unit cur, nxt; int ui = 0;
    if (!S.next(0, cur)) return;
    f32x4 acc[2][2][4][2];
#pragma unroll
    for (int a = 0; a < 2; ++a)
#pragma unroll
        for (int b = 0; b < 2; ++b)
#pragma unroll
            for (int m = 0; m < 4; ++m)
#pragma unroll
                for (int n = 0; n < 2; ++n) acc[a][b][m][n] = (f32x4){0.f, 0.f, 0.f, 0.f};
    bf16x8 At[4][2], B0[2][2], B1[2][2];
    const char* cA = (const char*)g.A + (GATHER ? (size_t)0 : (size_t)cur.pm * tstep); const char* cB = (const char*)g.Bt + (size_t)cur.pn * tstep;
    if constexpr (GATHER) { PG8_ROWS(cvo, cur); }
    S.a_ready(cur);
    if constexpr (SP2) {
        PG8_STAGE(PG8_SB(0, 0), cB, voffB); PG8_STAGE(PG8_SB(0, 1), cB + hstep, voffB); PG8_STAGE_A(PG8_SA(0, 0), cA, 0, false); PG8_STAGE_A(PG8_SA(0, 1), cA, 1, false);
        if (wr == 1) PG8_BAR;
        PG8_WAIT_V(2); PG8_BAR;
        PG8_STAGE(PG8_SB(1, 0), cB + kstep, voffB); PG8_STAGE_A(PG8_SA(1, 0), cA + kstep, 0, false); PG8_STAGE(PG8_SB(1, 1), cB + hstep + kstep, voffB);
        PG8_WAIT_V(6); PG8_BAR;
    } else {
        PG8_STAGE(PG8_SB(0, 0), cB, voffB); PG8_STAGE(PG8_SA(0, 0), cA, voffA); PG8_STAGE(PG8_SB(0, 1), cB + hstep, voffB); PG8_STAGE(PG8_SA(0, 1), cA + hstep, voffA);
        if (wr == 1) PG8_BAR;
        PG8_WAIT_V(4); PG8_BAR;
        PG8_STAGE(PG8_SB(1, 0), cB + kstep, voffB); PG8_STAGE(PG8_SA(1, 0), cA + kstep, voffA); PG8_STAGE(PG8_SB(1, 1), cB + hstep + kstep, voffB);
        PG8_WAIT_V(6); PG8_BAR;
    }
    for (;;) {
        const bool has_next = S.next(ui + 1, nxt);
        const char* nA = GATHER ? (const char*)g.A : (has_next ? (const char*)g.A + (size_t)nxt.pm * tstep : cA); const char* nB = has_next ? (const char*)g.Bt + (size_t)nxt.pn * tstep : cB;
        if constexpr (GATHER) { if (has_next) { PG8_ROWS(nvo, nxt); } else { _Pragma("unroll") for (int h_ = 0; h_ < 2; ++h_) { nvo[h_][0] = cvo[h_][0]; nvo[h_][1] = cvo[h_][1]; } } }
        for (int t = 0; t < nt; t += 2) {
            const bool last = (t == nt - 2);
            const char* a1 = cA + (size_t)(t + 1) * kstep;
            const char* a2 = last ? nA : cA + (size_t)(t + 2) * kstep; const char* b2 = last ? nB : cB + (size_t)(t + 2) * kstep;
            const char* a3 = a2 + kstep; const char* b3 = b2 + kstep;
            if (last && has_next) S.a_ready(nxt);
            if constexpr (SP2) {
            PG8_LDB(B0, 0, 0); PG8_LDB(B1, 0, 1); PG8_SCHED; PG8_LDA(At, 0, 0); PG8_STAGE_A(PG8_SA(1, 1), a1, 1, false);
            PG8_WAIT_V(8); PG8_WAIT_L(0); PG8_BAR; PG8_MMA(0, 0, At, B0); PG8_MMA(0, 1, At, B1); PG8_BAR; PG8_SCHED;
            PG8_LDA(At, 0, 1); PG8_STAGE(PG8_SB(0, 0), b2, voffB); PG8_STAGE(PG8_SB(0, 1), b2 + hstep, voffB); PG8_STAGE_A(PG8_SA(0, 0), a2, 0, last);
            PG8_WAIT_V(8); PG8_WAIT_L(0); PG8_BAR; PG8_MMA(1, 0, At, B0); PG8_MMA(1, 1, At, B1); PG8_BAR; PG8_SCHED;
            PG8_LDB(B0, 1, 0); PG8_LDB(B1, 1, 1); PG8_SCHED; PG8_LDA(At, 1, 0); PG8_STAGE_A(PG8_SA(0, 1), a2, 1, last);
            PG8_WAIT_V(8); PG8_WAIT_L(0); PG8_BAR; PG8_MMA(0, 0, At, B0); PG8_MMA(0, 1, At, B1); PG8_BAR; PG8_SCHED;
            PG8_LDA(At, 1, 1); PG8_STAGE(PG8_SB(1, 0), b3, voffB); PG8_STAGE(PG8_SB(1, 1), b3 + hstep, voffB); PG8_STAGE_A(PG8_SA(1, 0), a3, 0, last);
            PG8_WAIT_V(8); PG8_WAIT_L(0); PG8_BAR; PG8_MMA(1, 0, At, B0); PG8_MMA(1, 1, At, B1); PG8_BAR; PG8_SCHED;
            } else {
            PG8_LDB(B0, 0, 0); PG8_SCHED; PG8_LDA(At, 0, 0); PG8_STAGE(PG8_SA(1, 1), a1 + hstep, voffA);
            PG8_WAIT_L(8); PG8_BAR; PG8_WAIT_L(0); PG8_MMA(0, 0, At, B0); PG8_BAR; PG8_SCHED;
            PG8_LDB(B1, 0, 1); PG8_STAGE(PG8_SB(0, 0), b2, voffB);
            PG8_BAR; PG8_WAIT_L(0); PG8_MMA(0, 1, At, B1); PG8_BAR;
            PG8_LDA(At, 0, 1); PG8_STAGE(PG8_SA(0, 0), a2, voffA);
            PG8_BAR; PG8_WAIT_L(0); PG8_MMA(1, 0, At, B0); PG8_BAR; PG8_SCHED;
            PG8_STAGE(PG8_SB(0, 1), b2 + hstep, voffB);
            PG8_WAIT_V(6); PG8_BAR; PG8_MMA(1, 1, At, B1); PG8_BAR;
            PG8_LDB(B0, 1, 0); PG8_SCHED; PG8_LDA(At, 1, 0); PG8_STAGE(PG8_SA(0, 1), a2 + hstep, voffA);
            PG8_WAIT_L(8); PG8_BAR; PG8_WAIT_L(0); PG8_MMA(0, 0, At, B0); PG8_BAR; PG8_SCHED;
            PG8_LDB(B1, 1, 1); PG8_STAGE(PG8_SB(1, 0), b3, voffB);
            PG8_BAR; PG8_WAIT_L(0); PG8_MMA(0, 1, At, B1); PG8_BAR;
            PG8_LDA(At, 1, 1); PG8_STAGE(PG8_SA(1, 0), a3, voffA);
            PG8_BAR; PG8_WAIT_L(0); PG8_MMA(1, 0, At, B0); PG8_BAR; PG8_SCHED;
            PG8_STAGE(PG8_SB(1, 1), b3 + hstep, voffB);
            PG8_WAIT_V(6); PG8_BAR; PG8_MMA(1, 1, At, B1); PG8_BAR;
            }
        }
        if constexpr (ALIGN_EPI) { if (wr == 0) PG8_BAR; }
        if constexpr (!Epi::AFTER_DRAIN) { E(acc, cur, wr, wc, fr, fq); S.done(cur); }
        if (!has_next) break;
#pragma unroll
        for (int a = 0; a < 2; ++a)
#pragma unroll
            for (int b = 0; b < 2; ++b)
#pragma unroll
                for (int m = 0; m < 4; ++m)
#pragma unroll
                    for (int n = 0; n < 2; ++n) acc[a][b][m][n] = (f32x4){0.f, 0.f, 0.f, 0.f};
        cur = nxt; cA = nA; cB = nB; ++ui;
        if constexpr (GATHER) { _Pragma("unroll") for (int h_ = 0; h_ < 2; ++h_) { cvo[h_][0] = nvo[h_][0]; cvo[h_][1] = nvo[h_][1]; } }
        if constexpr (ALIGN_EPI) { if (wr == 1) PG8_BAR; }
    }
    PG8_WAIT_V(0);
    if constexpr (!ALIGN_EPI) { if (wr == 0) PG8_BAR; }
    PG8_BAR;
    if constexpr (Epi::AFTER_DRAIN) { E.fused(acc, cur, wr, wc, fr, fq, lds, wid, lane); S.done(cur); }
#undef PG8_SA
#undef PG8_SB
#undef PG8_STAGE
#undef PG8_STAGE_A
#undef PG8_ROWS
#undef PG8_LDA
#undef PG8_LDB
#undef PG8_MMA
#undef PG8_WAIT_V
#undef PG8_WAIT_L
#undef PG8_BAR
#undef PG8_SCHED
}
}

constexpr int NWAVES = 8;
constexpr int NB = 8, SEQ = 4096, DM = 1024, MTOK = NB * SEQ, NLAYER = 2;
constexpr int INC = 2984, INCP = 3072;
constexpr int C_RET = 0, C_RW = 1024, C_DSA = 1920, C_SB = 2216;
constexpr int PBW = 1792, PFW = 1280, PB_SB = 1024, PF_DSA = 896;
constexpr int NEXP = 32, MOE_ROWS = MTOK * 4 + NEXP * 256;
constexpr int ROPE_W = 88;
constexpr int NCH = 16, TCH = SEQ / NCH;
constexpr int NPL = 11, NPHASE = 1 + NLAYER * NPL;
enum { I_X = 0, I_C, I_POS, I_ADAW, I_ADAB, I_NMIX, I_NFFN, I_WIN, I_RETGN, I_MU, I_W0, I_W2, I_A0, I_A2, I_G2, I_KK, I_KA, I_RK, I_LN, I_QNORM, I_WQ, I_WQI, I_DONORM, I_SONORM, I_WOUT, I_RW, I_RB, I_MW1, I_MB1, I_MW2, I_MB2, I_NFINAL, N_IN };

constexpr size_t MiB = 1u << 20;
constexpr size_t WS_CTL = 0, CTL_ZERO_BYTES = 1 * MiB;
constexpr size_t WS_MOD = 1 * MiB, WS_ROPE = 2 * MiB, WS_WIN = 14 * MiB, WS_WOUT = 26 * MiB, WS_W1 = 30 * MiB, WS_W2 = 286 * MiB;
constexpr size_t WS_XA = 414 * MiB, WS_H = 542 * MiB, WS_MIX = 606 * MiB, WS_TOPI = 670 * MiB, WS_TOPW = 671 * MiB, WS_POS = 672 * MiB;
constexpr size_t WS_R = 674 * MiB;
constexpr size_t WS_PB = WS_R  , WS_PF = WS_R + 112 * MiB  , WS_RWA = 946 * MiB  , WS_DQ = 1314 * MiB  , WS_DKB = 1330 * MiB  , WS_DVB = 1334 * MiB  , WS_DQI = 1346 * MiB  , WS_DKI = 1394 * MiB  , WS_DW = 1398 * MiB;
constexpr size_t WS_SMALLW = 1338 * MiB  ;
constexpr int SMW_QI = 0, SMW_W2 = 512 * 128, SMW_A2 = SMW_W2 + 256 * 32, SMW_G2 = SMW_A2 + 256 * 32, SMW_LAYER = SMW_G2 + 256 * 64;
constexpr size_t WS_PT = 1362 * MiB  ;
constexpr size_t WS_CH = WS_H  , WS_SI = WS_H + 16 * MiB  , WS_SIR = WS_H + 24 * MiB  ,
                 WS_CHR = WS_H + 32 * MiB  , WS_PTR = WS_H + 40 * MiB  ;
constexpr size_t WS_SQ = WS_MIX  , WS_SK = WS_MIX + 16 * MiB, WS_SV = WS_MIX + 32 * MiB;
constexpr size_t WS_YO = 1400 * MiB  , WS_SC = 1528 * MiB  ;
constexpr size_t WS_XS = WS_R  , WS_ACT = 946 * MiB  ;
constexpr size_t WS_LIST = 2040 * MiB  , WS_END = 2044 * MiB;
constexpr int LCAP = 32768;
static_assert((size_t)MOE_ROWS * 2048 <= 272 * MiB, "moe buffers");
constexpr int CW_TMO = 0, CW_CODE = 1, CW_GCNT = 256  , CW_DSAQ = 1024  , CW_BAR = 4096, CW_BLKCNT = 16384  ;
constexpr int RING_BYTES = 131072, MISC_OFF = RING_BYTES + 320, TST_OFF = RING_BYTES + 1024  , TAB_OFF = RING_BYTES + 2048  , HIST_OFF = RING_BYTES + 5120  , BASE_OFF = RING_BYTES + 5376  , CNT_OFF = RING_BYTES + 5632  , TEXP_OFF = RING_BYTES + 6144  , LDS_BYTES = 147456;

#if defined(__HIP_DEVICE_COMPILE__)
#define GAS __attribute__((address_space(1)))
#define CAS __attribute__((address_space(4)))
#else
#define GAS
#define CAS
#endif
#define LAS __attribute__((address_space(3)))
typedef unsigned short bf16;
typedef unsigned v4u __attribute__((ext_vector_type(4)));
typedef unsigned v2u __attribute__((ext_vector_type(2)));
typedef float f32x4 __attribute__((ext_vector_type(4)));
typedef GAS unsigned gu32;
typedef short bf16x8v __attribute__((ext_vector_type(8)));
typedef short s16x4v __attribute__((ext_vector_type(4)));
typedef _Float16 f16x8 __attribute__((ext_vector_type(8)));
#define RLX_AGENT __ATOMIC_RELAXED, __HIP_MEMORY_SCOPE_AGENT
#define LDS_WAIT() asm volatile("s_waitcnt lgkmcnt(0)" ::: "memory")
#define VM_WAIT() asm volatile("s_waitcnt vmcnt(0)" ::: "memory")
__device__ __forceinline__ unsigned f2bf(float f) { unsigned u = __builtin_bit_cast(unsigned, f); return (u + 0x7fffu + ((u >> 16) & 1u)) >> 16; }
__device__ __forceinline__ unsigned pk2(float lo, float hi) { return f2bf(lo) | (f2bf(hi) << 16); }
__device__ __forceinline__ float bf_lo(unsigned w) { return __builtin_bit_cast(float, w << 16); }
__device__ __forceinline__ float bf_hi(unsigned w) { return __builtin_bit_cast(float, w & 0xffff0000u); }
__device__ __forceinline__ float wave_sum(float v) {
#pragma unroll
    for (int o = 1; o < 64; o <<= 1) v += __shfl_xor(v, o);
    return v;
}
__device__ __forceinline__ float wave_max(float v) {
#pragma unroll
    for (int o = 1; o < 64; o <<= 1) v = fmaxf(v, __shfl_xor(v, o));
    return v;
}
__device__ __forceinline__ float grp16_sum(float v) { v += __shfl_xor(v, 1); v += __shfl_xor(v, 2); v += __shfl_xor(v, 4); v += __shfl_xor(v, 8); return v; }
__device__ __forceinline__ float grp8_sum(float v) { v += __shfl_xor(v, 1); v += __shfl_xor(v, 2); v += __shfl_xor(v, 4); return v; }
__device__ __forceinline__ float sum4(f32x4 a) { return (a.x + a.y) + (a.z + a.w); }
__device__ __forceinline__ float dot4(f32x4 a, f32x4 b) { return (a.x * b.x + a.y * b.y) + (a.z * b.z + a.w * b.w); }
__device__ __forceinline__ float fexp(float x) { return __builtin_amdgcn_exp2f(x * 1.4426950408889634f); }
__device__ __forceinline__ float sigm(float x) { return __builtin_amdgcn_rcpf(1.0f + fexp(-x)); }
__device__ __forceinline__ float softplusf(float x) { return fmaxf(x, 0.0f) + 0.6931471805599453f * __builtin_amdgcn_logf(1.0f + fexp(-fabsf(x))); }
__device__ __forceinline__ float ftanh(float x) { const float e = fexp(-2.0f * fabsf(x)); const float t = (1.0f - e) * __builtin_amdgcn_rcpf(1.0f + e); return x < 0.0f ? -t : t; }
__device__ __forceinline__ f32x4 shx4(f32x4 v, int m) { f32x4 r; r.x = __shfl_xor(v.x, m); r.y = __shfl_xor(v.y, m); r.z = __shfl_xor(v.z, m); r.w = __shfl_xor(v.w, m); return r; }

#define XB_TMO      128
#define XB_XCNT(j)  (256  + 64 * (j))
#define XB_XSUB(j)  (1280 + 64 * (j))
#define XB_XGEN(j)  (2304 + 64 * (j))
#define XB_TOP      3328
#define XB_TOPGEN   3392
#define XCD_BAR_WORDS 3456
#define XB_SPIN_CAP (1u << 18)

__device__ __forceinline__ unsigned xb_ld(unsigned* p)              { return __hip_atomic_load(p, __ATOMIC_RELAXED, __HIP_MEMORY_SCOPE_AGENT); }
__device__ __forceinline__ unsigned xb_add(unsigned* p, unsigned v) { return __hip_atomic_fetch_add(p, v, __ATOMIC_RELAXED, __HIP_MEMORY_SCOPE_AGENT); }
__device__ __forceinline__ unsigned xb_xcc_id() { return (unsigned)__builtin_amdgcn_s_getreg((3 << 11) | 20) & 0xFu; }
#define XB_SPIN(cond, bar) do { unsigned _sp = 0; while (cond) { __builtin_amdgcn_s_sleep(1); \
    if ((++_sp & 255u) == 0u) { if (xb_ld(&(bar)[XB_TMO])) break; if (_sp > XB_SPIN_CAP) { atomicAdd(&(bar)[XB_TMO], 1u); break; } } } } while (0)

struct XcdBarrier {
    unsigned* bar; unsigned x;
    volatile LAS unsigned* st;
};

__device__ __forceinline__ XcdBarrier xcd_barrier_post(unsigned* bar, volatile LAS unsigned* st, int xb_tid) {
    XcdBarrier b; b.bar = bar; b.x = xb_xcc_id(); b.st = st;
    if (xb_tid == 0) (void)xb_add(&bar[XB_XCNT(b.x)], 1u);
    return b;
}
__device__ __forceinline__ void xcd_barrier_complete(unsigned* bar, unsigned x, unsigned& nloc, unsigned& nx) {
    const unsigned G = gridDim.x * gridDim.y * gridDim.z;
    unsigned sum, cnt, mine, sp = 0u;
    for (;;) {
        sum = 0u; cnt = 0u; mine = 0u;
#pragma unroll
        for (unsigned j = 0; j < 16; ++j) { const unsigned c = xb_ld(&bar[XB_XCNT(j)]); sum += c; cnt += (c > 0u) ? 1u : 0u; mine = (j == x) ? c : mine; }
        if (sum == G) break;
        __builtin_amdgcn_s_sleep(1);
        if ((++sp & 255u) == 0u) { if (xb_ld(&bar[XB_TMO])) break; if (sp > XB_SPIN_CAP) { atomicAdd(&bar[XB_TMO], 1u); break; } }
    }
    nloc = mine > 0u ? mine : 1u; nx = cnt > 0u ? cnt : 1u;
}

__device__ __forceinline__ void xcd_barrier(const XcdBarrier& b, int xb_tid) {
    asm volatile("s_waitcnt vmcnt(0)" ::: "memory");
    __syncthreads();
    if (xb_tid == 0) {
        unsigned* bar = b.bar;
        __builtin_amdgcn_s_waitcnt(0);
        unsigned nloc = b.st[0], nx = b.st[1];
        if (nloc == 0u) { xcd_barrier_complete(bar, b.x, nloc, nx); b.st[0] = nloc; b.st[1] = nx; }
        const unsigned old = xb_add(&bar[XB_XSUB(b.x)], 1u);
        const unsigned gen = old / nloc;
        if (old + 1u == (gen + 1u) * nloc) {
            __builtin_amdgcn_fence(__ATOMIC_RELEASE, "agent");
            asm volatile("s_waitcnt vmcnt(0)" ::: "memory");
            const unsigned og = xb_add(&bar[XB_TOP], 1u);
            const unsigned tg = og / nx;
            if (og + 1u == (tg + 1u) * nx) xb_add(&bar[XB_TOPGEN], 1u);
            else XB_SPIN(xb_ld(&bar[XB_TOPGEN]) == tg, bar);
            __builtin_amdgcn_fence(__ATOMIC_ACQUIRE, "agent");
            xb_add(&bar[XB_XGEN(b.x)], 1u);
            asm volatile("s_waitcnt vmcnt(0)" ::: "memory");
        } else {
            XB_SPIN(xb_ld(&bar[XB_XGEN(b.x)]) == gen, bar);
            __builtin_amdgcn_fence(__ATOMIC_ACQUIRE, "agent");
            asm volatile("s_waitcnt vmcnt(0)" ::: "memory");
        }
    }
    __syncthreads();
}
struct ArgsH { const float* in[N_IN]; float* out; unsigned char* ws; double invf[44]; int ph_lo, ph_hi, li, pad; };
struct ArgsD { const GAS float* in[N_IN]; GAS float* out; GAS unsigned char* ws; double invf[44]; int ph_lo, ph_hi, li, pad; };
static_assert(sizeof(ArgsH) == sizeof(ArgsD), "args layout");
typedef const CAS ArgsD& ARef;
__device__ __forceinline__ const CAS ArgsD* kargs() {
#if defined(__HIP_DEVICE_COMPILE__)
    const CAS ArgsD* p = (const CAS ArgsD*)__builtin_amdgcn_kernarg_segment_ptr(); asm volatile("" : "+s"(p)); return p;
#else
    return nullptr;
#endif
}
struct WI { LAS unsigned char* lds; int tid, lane, wave, vcu, G, gw, NGW, bx; };
constexpr size_t RWA_STRIDE = (33 * MiB + 68 * 1024) / 4;
constexpr size_t YO_STRIDE = 32 * MiB / 4;

__device__ __forceinline__ int wave_sum_i(int v) {
#pragma unroll
    for (int o = 1; o < 64; o <<= 1) v += __shfl_xor(v, o);
    return v;
}
__device__ __forceinline__ void sincos_d(double ang, float& s, float& c) {
    const double q = __builtin_rint(ang * 0.63661977236758134308);
    double r = __builtin_fma(-q, 1.57079632679489661923, ang); r = __builtin_fma(-q, 6.123233995736766e-17, r);
    const double r2 = r * r;
    const double sp = r * (1.0 + r2 * (-1.0 / 6 + r2 * (1.0 / 120 + r2 * (-1.0 / 5040 + r2 * (1.0 / 362880 + r2 * (-1.0 / 39916800 + r2 * (1.0 / 6227020800.0)))))));
    const double cp = 1.0 + r2 * (-0.5 + r2 * (1.0 / 24 + r2 * (-1.0 / 720 + r2 * (1.0 / 40320 + r2 * (-1.0 / 3628800 + r2 * (1.0 / 479001600 + r2 * (-1.0 / 87178291200.0)))))));
    const int qi = ((int)q) & 3;
    const double ss = (qi == 0) ? sp : (qi == 1) ? cp : (qi == 2) ? -sp : -cp;
    const double cc = (qi == 0) ? cp : (qi == 1) ? -sp : (qi == 2) ? -cp : sp;
    s = (float)ss; c = (float)cc;
}

struct TrItem { const float* src; bf16* dst; int ldw; float scale; bool ok; };
__device__ __forceinline__ void tr_decode(ARef A, int it, int lane, TrItem& d) {
    constexpr int I_IN = NLAYER * 16 * 96, I_OUT = NLAYER * 16 * 32, I_W1 = NLAYER * NEXP * 16 * 64;
    const float* W; int ldw, nvalid, k0, nsrc0; bf16* WT; size_t dstrow0; float scale = 1.0f;
    int r = it;
    if (r < I_IN) { const int l = r / 1536, rr = r % 1536, kb = rr / 96, nb = rr % 96;
        const int nd = nb * 32;
        nsrc0 = (nd < 1024) ? nd : (nd < 1792) ? C_SB + (nd - 1024) : (nd < 2688) ? C_RW + (nd - 1792) : C_DSA + (nd - 2688);
        nvalid = (nd < 1024) ? 1024 : (nd < 1792) ? INC : (nd < 2688) ? C_DSA : ((nd < INC) ? C_SB : 0);
        scale = (nd >= 256 && nd < 512) ? 0.125f : (nd >= 1024 && nd < 1280) ? 0.18033688011112042f : 1.0f;
        W = A.in[I_WIN] + (size_t)l * DM * INC; ldw = INC; k0 = kb * 64; WT = (bf16*)(A.ws + WS_WIN) + (size_t)l * INCP * DM; dstrow0 = (size_t)nd; }
    else if (r < I_IN + I_OUT) { r -= I_IN; const int l = r / 512, rr = r % 512, kb = rr / 32, nb = rr % 32;
        W = A.in[I_WOUT] + (size_t)l * DM * DM; ldw = DM; nvalid = DM; k0 = kb * 64; nsrc0 = nb * 32; WT = (bf16*)(A.ws + WS_WOUT) + (size_t)l * DM * DM; dstrow0 = (size_t)nb * 32; }
    else if (r < I_IN + I_OUT + I_W1) { r -= I_IN + I_OUT; const int le = r / 1024, rr = r % 1024, kb = rr / 64, nb = rr % 64, j = nb >> 3, bj = (nb >> 2) & 1, cc0 = (nb & 3) * 32;
        W = A.in[I_MW1] + (size_t)le * DM * 2048; ldw = 2048; nvalid = 2048; k0 = kb * 64; nsrc0 = bj * 1024 + 128 * j + cc0; WT = (bf16*)(A.ws + WS_W1) + (size_t)le * 2048 * DM; dstrow0 = (size_t)nb * 32; }
    else { r -= I_IN + I_OUT + I_W1; const int le = r / 512, rr = r % 512, kb = rr / 32, nb = rr % 32;
        W = A.in[I_MW2] + (size_t)le * DM * DM; ldw = DM; nvalid = DM; k0 = kb * 64; nsrc0 = nb * 32; WT = (bf16*)(A.ws + WS_W2) + (size_t)le * DM * DM; dstrow0 = (size_t)nb * 32; }
    const int n = nsrc0 + 4 * (lane & 7);
    d.ok = n < nvalid; d.src = W + (size_t)(k0 + (lane >> 3)) * ldw + (d.ok ? n : 0); d.ldw = ldw; d.scale = scale;
    d.dst = WT + (dstrow0 + (lane >> 3)) * 1024 + k0 + 8 * (lane & 7);
}
__device__ __forceinline__ void tr_load(const TrItem& d, f32x4 (&v)[8]) {
#pragma unroll
    for (int i = 0; i < 8; ++i) v[i] = *(const f32x4*)(d.src + (size_t)(8 * i) * d.ldw);
}
__device__ __forceinline__ void tr_store(const TrItem& d, const f32x4 (&v)[8], LAS float* scr, int lane) {
    const float sc_ = d.ok ? d.scale : 0.0f;
#pragma unroll
    for (int i = 0; i < 8; ++i) { LAS float* s = scr + (8 * i + (lane >> 3)) * 33 + 4 * (lane & 7); s[0] = v[i].x * sc_; s[1] = v[i].y * sc_; s[2] = v[i].z * sc_; s[3] = v[i].w * sc_; }
    LDS_WAIT(); asm volatile("" ::: "memory");
    const int c8 = lane & 7;
#pragma unroll
    for (int j = 0; j < 4; ++j) { const int n = (lane >> 3) + 8 * j; const LAS float* s = scr + (8 * c8) * 33 + n;
        v4u o; o.x = pk2(s[0 * 33], s[1 * 33]); o.y = pk2(s[2 * 33], s[3 * 33]); o.z = pk2(s[4 * 33], s[5 * 33]); o.w = pk2(s[6 * 33], s[7 * 33]);
        *(v4u*)(d.dst + (size_t)(8 * j) * 1024) = o; }
    LDS_WAIT(); asm volatile("" ::: "memory");
}
__device__ __forceinline__ void ph_prologue(ARef A, const WI& w) {
    LAS float* sc = (LAS float*)w.lds;
    { const float* cin = A.in[I_C]; for (int i = w.tid; i < NB * DM; i += NWAVES * 64) { const float v = cin[i]; sc[i] = v / (1.0f + expf(-v)); } }
    __syncthreads();
    float* MOD = (float*)(A.ws + WS_MOD);
    LAS float* red = (LAS float*)(w.lds + 32768);
    if (w.vcu < 192) {
        const int l = w.vcu / 96, col = (w.vcu % 96) * 64 + w.lane, kw = 128 * w.wave;
        const float* wp = A.in[I_ADAW] + (size_t)l * DM * 6144 + (size_t)kw * 6144 + col;
        float acc[8];
#pragma unroll
        for (int b = 0; b < 8; ++b) acc[b] = 0.0f;
#pragma unroll 16
        for (int k = 0; k < 128; ++k) { const float wv = wp[(size_t)k * 6144];
#pragma unroll
            for (int b = 0; b < 8; ++b) acc[b] += sc[b * DM + kw + k] * wv; }
#pragma unroll
        for (int b = 0; b < 8; ++b) red[(w.wave * 8 + b) * 64 + w.lane] = acc[b];
    }
    __syncthreads();
    if (w.vcu < 192) { const int l = w.vcu / 96, b = w.wave, col = (w.vcu % 96) * 64 + w.lane;
        float s = A.in[I_ADAB][l * 6144 + col];
#pragma unroll
        for (int q = 0; q < 8; ++q) s += red[(q * 8 + b) * 64 + w.lane];
        MOD[(size_t)(l * 8 + b) * 6144 + col] = s; }
    __syncthreads();
    LAS float* scr = (LAS float*)(w.lds + 32768 + w.wave * 8448);
    constexpr int NIT = NLAYER * 16 * 96 + NLAYER * 16 * 32;
    { TrItem d0, d1; f32x4 va[8], vb[8];
      int it = w.gw; bool h0 = it < NIT;
      if (h0) { tr_decode(A, it, w.lane, d0); tr_load(d0, va); }
      while (h0) {
          it += w.NGW; const bool h1 = it < NIT;
          if (h1) { tr_decode(A, it, w.lane, d1); tr_load(d1, vb); }
          tr_store(d0, va, scr, w.lane);
          if (!h1) break;
          it += w.NGW; h0 = it < NIT;
          if (h0) { tr_decode(A, it, w.lane, d0); tr_load(d0, va); }
          tr_store(d1, vb, scr, w.lane);
      } }
    float* RT = (float*)(A.ws + WS_ROPE); const int* pos = (const int*)A.in[I_POS];
    for (int g = w.gw * 64 + w.lane; g < MTOK * 44; g += w.NGW * 64) {
        const int tok = g / 44, f = g % 44; int co, so;
        if (f < 32) { co = f; so = 32 + f; } else if (f < 40) { co = 64 + (f - 32); so = 72 + (f - 32); } else { co = 80 + (f - 40); so = 84 + (f - 40); }
        float s, c; sincos_d((double)pos[tok] * A.invf[f], s, c);
        RT[(size_t)tok * ROPE_W + co] = c; RT[(size_t)tok * ROPE_W + so] = s;
    }
}

__device__ __forceinline__ void moe_convert_chunk(ARef A, int l, int c, int lane, LAS float* scr) {
    constexpr int I0 = NLAYER * 16 * 96 + NLAYER * 16 * 32, I_W1 = NLAYER * NEXP * 16 * 64;
    const int it0 = (c < 8192) ? I0 + l * 32768 + 4 * c : I0 + I_W1 + l * 16384 + 4 * (c - 8192);
    TrItem d0, d1; f32x4 va[8], vb[8];
    tr_decode(A, it0, lane, d0); tr_load(d0, va);
    tr_decode(A, it0 + 1, lane, d1); tr_load(d1, vb);
    tr_store(d0, va, scr, lane);
    tr_decode(A, it0 + 2, lane, d0); tr_load(d0, va);
    tr_store(d1, vb, scr, lane);
    tr_decode(A, it0 + 3, lane, d1); tr_load(d1, vb);
    tr_store(d0, va, scr, lane);
    tr_store(d1, vb, scr, lane);
}

__device__ __forceinline__ void emit_h_row(const f32x4 (&v)[4], float rstd, const float* g, const float* sc, const float* sh, bf16* hrow, int lane) {
#pragma unroll
    for (int j = 0; j < 4; ++j) { const int k = 4 * (lane + 64 * j);
        const f32x4 gv = *(const f32x4*)(g + k), scv = *(const f32x4*)(sc + k), shv = *(const f32x4*)(sh + k);
        const f32x4 h = v[j] * rstd * gv * (1.0f + scv) + shv;
        v2u o; o.x = pk2(h.x, h.y); o.y = pk2(h.z, h.w); *(v2u*)(hrow + k) = o; }
}
__device__ __forceinline__ void small_weights_to_f16(ARef A, const WI& w) {
    { _Float16* SW = (_Float16*)(A.ws + WS_SMALLW);
      const int g0 = w.gw * 64 + w.lane, gs = w.NGW * 64;
      for (int l = 0; l < NLAYER; ++l) { _Float16* S = SW + (size_t)l * SMW_LAYER;
          const float* wq = A.in[I_WQ] + (size_t)l * 128 * 256; const float* wqi = A.in[I_WQI] + (size_t)l * 128 * 256;
          for (int e = g0; e < 256 * 128; e += gs) { const int n = e >> 7, k = e & 127; S[SMW_QI + e] = (_Float16)wq[k * 256 + n]; S[SMW_QI + 256 * 128 + e] = (_Float16)wqi[k * 256 + n]; }
          const float* w2 = A.in[I_W2] + (size_t)l * 32 * 256; const float* a2 = A.in[I_A2] + (size_t)l * 32 * 256; const float* g2 = A.in[I_G2] + (size_t)l * 64 * 256;
          for (int e = g0; e < 256 * 32; e += gs) { const int n = e >> 5, k = e & 31; S[SMW_W2 + e] = (_Float16)w2[k * 256 + n]; S[SMW_A2 + e] = (_Float16)a2[k * 256 + n]; }
          for (int e = g0; e < 256 * 64; e += gs) { const int n = e >> 6, k = e & 63; S[SMW_G2 + e] = (_Float16)g2[k * 256 + n]; } } }
}
__device__ __forceinline__ void ph_norm1(ARef A, const WI& w) {
    const float* MOD = (const float*)(A.ws + WS_MOD); bf16* H = (bf16*)(A.ws + WS_H);
    for (int m = w.gw; m < MTOK; m += w.NGW) {
        const float* xr = A.in[I_X] + (size_t)m * DM; f32x4 v[4]; float ss = 0.0f;
#pragma unroll
        for (int j = 0; j < 4; ++j) { v[j] = *(const f32x4*)(xr + 4 * (w.lane + 64 * j)); ss += dot4(v[j], v[j]); }
        ss = wave_sum(ss); const float rstd = 1.0f / sqrtf(ss * (1.0f / DM) + 1e-5f);
        const float* mb = MOD + (size_t)(m >> 12) * 6144;
        emit_h_row(v, rstd, A.in[I_NMIX], mb + 1024, mb, H + (size_t)m * DM, w.lane);
    }
}

typedef _Float16 h4v __attribute__((ext_vector_type(4)));
__device__ __forceinline__ f16x8 pack_f16x8(f32x4 a, f32x4 b) { f16x8 r; r[0] = (_Float16)a.x; r[1] = (_Float16)a.y; r[2] = (_Float16)a.z; r[3] = (_Float16)a.w; r[4] = (_Float16)b.x; r[5] = (_Float16)b.y; r[6] = (_Float16)b.z; r[7] = (_Float16)b.w; return r; }
#define RW_STB4(k_, val_) do { v2u w_; w_.x = pk2((val_).x, (val_).y); w_.y = pk2((val_).z, (val_).w); *(v2u*)((bf16*)(RWA + (k_) * RWA_STRIDE) + o) = w_; } while (0)
#ifndef RWKV_RKV_BF16
#define RWKV_RKV_BF16 1
#endif
#if RWKV_RKV_BF16
#define RW_ST_RKV(k_, val_) RW_STB4(k_, val_)
#else
#define RW_ST_RKV(k_, val_) (*(f32x4*)(RWA + (k_) * RWA_STRIDE + o) = (val_))
#endif
__device__ __forceinline__ f32x4 ldb4(const bf16* q) { const v2u x = *(const v2u*)q; return (f32x4){bf_lo(x.x), bf_hi(x.x), bf_lo(x.y), bf_hi(x.y)}; }
__device__ __forceinline__ void prep16_body(const bf16* __restrict__ P, float* __restrict__ RWA, const _Float16* __restrict__ SW, const float* __restrict__ RT, bf16* __restrict__ DQ, _Float16* __restrict__ DQI,
                                            bf16* __restrict__ DKB, bf16* __restrict__ DVB, _Float16* __restrict__ DKI, float* __restrict__ DW, const float* __restrict__ mu, const float* __restrict__ qn,
                                            const float* __restrict__ w0p, const float* __restrict__ a0p, const float* __restrict__ kkp, const float* __restrict__ kap, const float* __restrict__ rkp, int m0, int lane_in, int part = 7) {
    int lane = lane_in; asm volatile("" : "+v"(lane));
    const int tk = lane & 15, q4 = lane >> 4, m = m0 + tk, t = m & (SEQ - 1);
    const bf16* pr = P + (size_t)m * PFW; const bf16* pp = pr - PFW; const bf16* pd = P + (size_t)m * PFW + PF_DSA;
    RT += (size_t)m * ROPE_W; const f32x4 zero4 = {0.f, 0.f, 0.f, 0.f};
    f16x8 bx[4], bc[4];
    { float ss = 0.0f; f32x4 c[4][2];
#pragma unroll
      for (int ks = 0; ks < 4; ++ks) { const int f0 = 32 * ks + 8 * q4;
          f32x4 x[2];
#pragma unroll
          for (int u = 0; u < 2; ++u) { const f32x4 z = ldb4(pr + 768 + f0 + 4 * u); const f32x4 p = t ? ldb4(pp + 768 + f0 + 4 * u) : zero4; x[u] = z + (p - z) * *(const f32x4*)(mu + 768 + f0 + 4 * u);
#pragma unroll
              for (int i = 0; i < 4; ++i) x[u][i] = (ks == 0) ? ftanh(x[u][i]) : (ks == 1) ? x[u][i] : sigm(x[u][i]); }
          bx[ks] = pack_f16x8(x[0], x[1]);
          c[ks][0] = ldb4(pd + f0); c[ks][1] = ldb4(pd + f0 + 4); ss += dot4(c[ks][0], c[ks][0]) + dot4(c[ks][1], c[ks][1]); }
      ss += __shfl_xor(ss, 16); ss += __shfl_xor(ss, 32);
      const float rstd = 1.0f / sqrtf(ss * (1.0f / 128.0f) + 1e-5f);
#pragma unroll
      for (int ks = 0; ks < 4; ++ks) { const int f0 = 32 * ks + 8 * q4; bc[ks] = pack_f16x8(c[ks][0] * rstd * *(const f32x4*)(qn + f0), c[ks][1] * rstd * *(const f32x4*)(qn + f0 + 4)); } }
    const _Float16* wrow = SW + (size_t)tk * 0;
    (void)wrow;
    const int arow = lane & 15;
    if (part & 1)
#pragma unroll 2
    for (int hd = 0; hd < 4; ++hd) {
        f32x4 fk[4], av[4]; float ssk = 0.0f;
#pragma unroll
        for (int j = 0; j < 4; ++j) { const int nb = 4 * hd + j, ch = 16 * nb + 4 * q4; const size_t o = (size_t)m * 256 + ch;
            const f16x8 aw = *(const f16x8*)(SW + SMW_W2 + (16 * nb + arow) * 32 + 8 * q4), aa = *(const f16x8*)(SW + SMW_A2 + (16 * nb + arow) * 32 + 8 * q4);
            const f16x8 ag0 = *(const f16x8*)(SW + SMW_G2 + (16 * nb + arow) * 64 + 8 * q4), ag1 = *(const f16x8*)(SW + SMW_G2 + (16 * nb + arow) * 64 + 32 + 8 * q4);
            const f32x4 cw = __builtin_amdgcn_mfma_f32_16x16x32_f16(aw, bx[0], *(const f32x4*)(w0p + ch), 0, 0, 0);
            const f32x4 ca = __builtin_amdgcn_mfma_f32_16x16x32_f16(aa, bx[1], *(const f32x4*)(a0p + ch), 0, 0, 0);
            f32x4 cg = __builtin_amdgcn_mfma_f32_16x16x32_f16(ag0, bx[2], zero4, 0, 0, 0); cg = __builtin_amdgcn_mfma_f32_16x16x32_f16(ag1, bx[3], cg, 0, 0, 0);
            f32x4 dec;
#pragma unroll
            for (int i = 0; i < 4; ++i) { dec[i] = fexp(-fexp(-softplusf(-cw[i]) - 0.5f)); av[j][i] = sigm(ca[i]); }
            *(f32x4*)(RWA + 1 * RWA_STRIDE + o) = dec; RW_STB4(6, cg);
            { const f32x4 z = ldb4(pr + 256 + ch); const f32x4 p = t ? ldb4(pp + 256 + ch) : zero4; fk[j] = z + (p - z) * *(const f32x4*)(mu + 256 + ch); }
            const f32x4 kk = fk[j] * *(const f32x4*)(kkp + ch); ssk += dot4(kk, kk); }
        ssk += __shfl_xor(ssk, 16); ssk += __shfl_xor(ssk, 32);
        const float inrm = 1.0f / fmaxf(sqrtf(ssk), 1e-12f);
        f32x4 fr[4], km[4]; float bs = 0.0f;
#pragma unroll
        for (int j = 0; j < 4; ++j) { const int ch = 16 * (4 * hd + j) + 4 * q4;
            { const f32x4 z = ldb4(pr + ch); const f32x4 p = t ? ldb4(pp + ch) : zero4; fr[j] = z + (p - z) * *(const f32x4*)(mu + ch); }
            km[j] = fk[j] * (1.0f + (av[j] - 1.0f) * *(const f32x4*)(kap + ch)); bs += dot4(fr[j] * km[j], *(const f32x4*)(rkp + ch)); }
        bs += __shfl_xor(bs, 16); bs += __shfl_xor(bs, 32);
#pragma unroll
        for (int j = 0; j < 4; ++j) { const int ch = 16 * (4 * hd + j) + 4 * q4; const size_t o = (size_t)m * 256 + ch;
            f32x4 fv; { const f32x4 z = ldb4(pr + 512 + ch); const f32x4 p = t ? ldb4(pp + 512 + ch) : zero4; fv = z + (p - z) * *(const f32x4*)(mu + 512 + ch); }
            const f32x4 kk = fk[j] * *(const f32x4*)(kkp + ch) * inrm;
            RW_ST_RKV(0, fr[j]); RW_ST_RKV(2, km[j]); RW_ST_RKV(3, fv);
            *(f32x4*)(RWA + 4 * RWA_STRIDE + o) = -kk; *(f32x4*)(RWA + 5 * RWA_STRIDE + o) = kk * av[j]; { const f32x4 bo_ = bs * fv; RW_STB4(7, bo_); } }
    }
    if (part & 2)
#pragma unroll 4
    for (int nb = 0; nb < 32; ++nb) {
        f32x4 cq = zero4;
#pragma unroll
        for (int ks = 0; ks < 4; ++ks) { const f16x8 aq = *(const f16x8*)(SW + SMW_QI + (16 * nb + arow) * 128 + 32 * ks + 8 * q4); cq = __builtin_amdgcn_mfma_f32_16x16x32_f16(aq, bc[ks], cq, 0, 0, 0); }
        const int ch = 16 * (nb & 15) + 4 * q4;
        if (nb < 16) {
            if ((nb & 3) == 0) { const f32x4 ot = shx4(cq, 32); const int fi = 4 * (q4 & 1); const f32x4 cs4 = *(const f32x4*)(RT + 64 + fi), sn = *(const f32x4*)(RT + 72 + fi); cq = (q4 < 2) ? cq * cs4 - ot * sn : ot * sn + cq * cs4; }
            const f32x4 qs = cq * 0.18033688011112042f; v2u o; o.x = pk2(qs.x, qs.y); o.y = pk2(qs.z, qs.w); *(v2u*)(DQ + (size_t)m * 256 + ch) = o;
        } else {
            if ((nb & 1) == 0) { const f32x4 ot = shx4(cq, 16); const f32x4 cs4 = *(const f32x4*)(RT + 80), sn = *(const f32x4*)(RT + 84); if (q4 < 2) cq = (q4 < 1) ? cq * cs4 - ot * sn : ot * sn + cq * cs4; }
            h4v hq; hq.x = (_Float16)cq.x; hq.y = (_Float16)cq.y; hq.z = (_Float16)cq.z; hq.w = (_Float16)cq.w; *(h4v*)(DQI + (size_t)m * 256 + ch) = hq;
        }
    }
#pragma unroll
    for (int j = 0; j < 4; ++j) { const int d = 16 * j + 4 * q4; f32x4 kx = ldb4(pd + 128 + d);
        if (j == 0) { const f32x4 ot = shx4(kx, 32); const int fi = 4 * (q4 & 1); const f32x4 cs4 = *(const f32x4*)(RT + 64 + fi), sn = *(const f32x4*)(RT + 72 + fi); kx = (q4 < 2) ? kx * cs4 - ot * sn : ot * sn + kx * cs4; }
        v2u o; o.x = pk2(kx.x, kx.y); o.y = pk2(kx.z, kx.w); *(v2u*)(DKB + (size_t)m * 64 + d) = o;
        const f32x4 vx = ldb4(pd + 192 + d); v2u ov; ov.x = pk2(vx.x, vx.y); ov.y = pk2(vx.z, vx.w); *(v2u*)(DVB + (size_t)m * 64 + d) = ov; }
#pragma unroll
    for (int j = 0; j < 2; ++j) { const int d = 16 * j + 4 * q4; f32x4 ki = ldb4(pd + 256 + d);
        if (j == 0) { const f32x4 ot = shx4(ki, 16); const f32x4 cs4 = *(const f32x4*)(RT + 80), sn = *(const f32x4*)(RT + 84); if (q4 < 2) ki = (q4 < 1) ? ki * cs4 - ot * sn : ot * sn + ki * cs4; }
        h4v hk; hk.x = (_Float16)ki.x; hk.y = (_Float16)ki.y; hk.z = (_Float16)ki.z; hk.w = (_Float16)ki.w; *(h4v*)(DKI + (size_t)m * 32 + d) = hk; }
    if (q4 < 2) *(f32x4*)(DW + (size_t)m * 8 + 4 * q4) = ldb4(pd + 288 + 4 * q4) * 0.0625f;
}

__device__ __forceinline__ void prep16(ARef A, int l, int m0, int lane_in, int part = 7) {
    prep16_body((const bf16*)(A.ws + WS_PF), (float*)(A.ws + WS_RWA), (const _Float16*)(A.ws + WS_SMALLW) + (size_t)l * SMW_LAYER, (const float*)(A.ws + WS_ROPE), (bf16*)(A.ws + WS_DQ), (_Float16*)(A.ws + WS_DQI),
                (bf16*)(A.ws + WS_DKB), (bf16*)(A.ws + WS_DVB), (_Float16*)(A.ws + WS_DKI), (float*)(A.ws + WS_DW), A.in[I_MU] + l * 896, A.in[I_QNORM] + l * 128,
                A.in[I_W0] + l * 256, A.in[I_A0] + l * 256, A.in[I_KK] + l * 256, A.in[I_KA] + l * 256, A.in[I_RK] + l * 256, m0, lane_in, part);
}
__device__ __forceinline__ float quad_sum(float v) {
    v += __builtin_bit_cast(float, __builtin_amdgcn_mov_dpp(__builtin_bit_cast(int, v), 0xB1, 0xF, 0xF, true));
    v += __builtin_bit_cast(float, __builtin_amdgcn_mov_dpp(__builtin_bit_cast(int, v), 0x4E, 0xF, 0xF, true));
    return v;
}
__device__ __forceinline__ float oct_sum(float v) {
    v += __builtin_bit_cast(float, __builtin_amdgcn_mov_dpp(__builtin_bit_cast(int, v), 0xB1, 0xF, 0xF, true));
    v += __builtin_bit_cast(float, __builtin_amdgcn_mov_dpp(__builtin_bit_cast(int, v), 0x4E, 0xF, 0xF, true));
    v += __builtin_bit_cast(float, __builtin_amdgcn_mov_dpp(__builtin_bit_cast(int, v), 0x141, 0xF, 0xF, true));
    return v;
}
typedef float f32x2 __attribute__((ext_vector_type(2)));
#define LO2(v_) __builtin_shufflevector(v_, v_, 0, 1)
#define HI2(v_) __builtin_shufflevector(v_, v_, 2, 3)
#define RW_ROW(i_) (((i_) < 2) ? (16 * ws + rg + 8 * (i_)) : (64 + 16 * ws + rg + 8 * ((i_) - 2)))
#define RW_LOAD(op, s_) do { const int lo_ = (s_) * 64 + kq * 8; \
    op[0] = *(const LAS f32x4*)(sn + lo_); op[1] = *(const LAS f32x4*)(sn + lo_ + 4); op[2] = *(const LAS f32x4*)(sw + lo_); op[3] = *(const LAS f32x4*)(sw + lo_ + 4); \
    op[4] = *(const LAS f32x4*)(sb + lo_); op[5] = *(const LAS f32x4*)(sb + lo_ + 4); op[6] = *(const LAS f32x4*)(sk + lo_); op[7] = *(const LAS f32x4*)(sk + lo_ + 4); \
    op[8] = *(const LAS f32x4*)(sr + lo_); op[9] = *(const LAS f32x4*)(sr + lo_ + 4); \
    vin[0] = sv[(s_) * 64 + 16 * ws + rg]; vin[1] = sv[(s_) * 64 + 16 * ws + rg + 8]; } while (0)
#define RW_DOT(i_, oa, ob) ({ f32x2 d_ = S[i_][0] * LO2(oa); d_ = S[i_][1] * HI2(oa) + d_; d_ = S[i_][2] * LO2(ob) + d_; d_ = S[i_][3] * HI2(ob) + d_; d_.x + d_.y; })
#define RW_STEP(op, vv, s_) do { float sa_[4], y_[4]; \
    _Pragma("unroll") for (int i_ = 0; i_ < 4; ++i_) sa_[i_] = RW_DOT(i_, op[0], op[1]); \
    _Pragma("unroll") for (int i_ = 0; i_ < 4; ++i_) sa_[i_] += __builtin_bit_cast(float, __builtin_amdgcn_mov_dpp(__builtin_bit_cast(int, sa_[i_]), 0xB1, 0xF, 0xF, true)); \
    _Pragma("unroll") for (int i_ = 0; i_ < 4; ++i_) sa_[i_] += __builtin_bit_cast(float, __builtin_amdgcn_mov_dpp(__builtin_bit_cast(int, sa_[i_]), 0x4E, 0xF, 0xF, true)); \
    _Pragma("unroll") for (int i_ = 0; i_ < 4; ++i_) sa_[i_] += __builtin_bit_cast(float, __builtin_amdgcn_mov_dpp(__builtin_bit_cast(int, sa_[i_]), 0x141, 0xF, 0xF, true)); \
    _Pragma("unroll") for (int i_ = 0; i_ < 2; ++i_) { const f32x2 a2_ = {sa_[i_], sa_[i_]}, v2_ = {vv[i_], vv[i_]}; \
        S[i_][0] = S[i_][0] * LO2(op[2]) + (a2_ * LO2(op[4]) + v2_ * LO2(op[6])); S[i_][1] = S[i_][1] * HI2(op[2]) + (a2_ * HI2(op[4]) + v2_ * HI2(op[6])); \
        S[i_][2] = S[i_][2] * LO2(op[3]) + (a2_ * LO2(op[5]) + v2_ * LO2(op[7])); S[i_][3] = S[i_][3] * HI2(op[3]) + (a2_ * HI2(op[5]) + v2_ * HI2(op[7])); } \
    _Pragma("unroll") for (int i_ = 2; i_ < 4; ++i_) { const f32x2 a2_ = {sa_[i_], sa_[i_]}; \
        S[i_][0] = S[i_][0] * LO2(op[2]) + a2_ * LO2(op[4]); S[i_][1] = S[i_][1] * HI2(op[2]) + a2_ * HI2(op[4]); S[i_][2] = S[i_][2] * LO2(op[3]) + a2_ * LO2(op[5]); S[i_][3] = S[i_][3] * HI2(op[3]) + a2_ * HI2(op[5]); } \
    _Pragma("unroll") for (int i_ = 0; i_ < 4; ++i_) y_[i_] = RW_DOT(i_, op[8], op[9]); \
    _Pragma("unroll") for (int i_ = 0; i_ < 4; ++i_) y_[i_] += __builtin_bit_cast(float, __builtin_amdgcn_mov_dpp(__builtin_bit_cast(int, y_[i_]), 0xB1, 0xF, 0xF, true)); \
    _Pragma("unroll") for (int i_ = 0; i_ < 4; ++i_) y_[i_] += __builtin_bit_cast(float, __builtin_amdgcn_mov_dpp(__builtin_bit_cast(int, y_[i_]), 0x4E, 0xF, 0xF, true)); \
    _Pragma("unroll") for (int i_ = 0; i_ < 4; ++i_) y_[i_] += __builtin_bit_cast(float, __builtin_amdgcn_mov_dpp(__builtin_bit_cast(int, y_[i_]), 0x141, 0xF, 0xF, true)); \
    if (kq == 0) { _Pragma("unroll") for (int i_ = 0; i_ < 4; ++i_) so[(s_) * 128 + RW_ROW(i_)] = y_[i_]; } } while (0)
__device__ __forceinline__ void scan_rwkv_task2(ARef A, const WI& w, int task0) {
    const int slot = w.wave >> 2, ws = w.wave & 3, lt = w.tid & 255, task = task0 + slot;
    const int bh = task >> 4, c = task & 15, b = bh >> 2, h = bh & 3;
    LAS float* sw = (LAS float*)w.lds + slot * 16384; LAS float* sn = sw + 2048; LAS float* sb = sn + 2048; LAS float* sk = sb + 2048; LAS float* sr = sk + 2048; LAS float* sv = sr + 2048; LAS float* so = sv + 2048;
    const float* RWA = (const float*)(A.ws + WS_RWA);
    const int rg = w.lane >> 3, kq = w.lane & 7;
    f32x2 S[4][4];
#pragma unroll
    for (int i = 0; i < 4; ++i)
#pragma unroll
        for (int j = 0; j < 4; ++j) { const int r = RW_ROW(i); S[i][j].x = (r >= 64 && 8 * kq + 2 * j == r - 64) ? 1.0f : 0.0f; S[i][j].y = (r >= 64 && 8 * kq + 2 * j + 1 == r - 64) ? 1.0f : 0.0f; }
    const size_t tok0 = (size_t)b * SEQ + (size_t)c * TCH;
    const int st = lt >> 3, sd = (lt & 7) * 8;
#if RWKV_RKV_BF16
    f32x4 a[3][2]; v4u ab[3];
#define RW_LD_RKV(i_, k_) ab[i_] = *(const v4u*)((const bf16*)(RWA + (k_) * RWA_STRIDE) + o_)
#define RW_GET_RKV(i_, q_) RW_UNPK(ab[i_], q_)
#else
    f32x4 a[3][2]; f32x4 af[3][2];
#define RW_LD_RKV(i_, k_) do { af[i_][0] = *(const f32x4*)(RWA + (k_) * RWA_STRIDE + o_); af[i_][1] = *(const f32x4*)(RWA + (k_) * RWA_STRIDE + o_ + 4); } while (0)
#define RW_GET_RKV(i_, q_) af[i_][q_]
#endif
#define RW_GLOAD(sub_) do { const size_t o_ = (tok0 + (sub_) * 32 + st) * 256 + h * 64 + sd; \
        _Pragma("unroll") for (int q = 0; q < 2; ++q) { a[0][q] = *(const f32x4*)(RWA + 1 * RWA_STRIDE + o_ + 4 * q); a[1][q] = *(const f32x4*)(RWA + 4 * RWA_STRIDE + o_ + 4 * q); a[2][q] = *(const f32x4*)(RWA + 5 * RWA_STRIDE + o_ + 4 * q); } \
        RW_LD_RKV(0, 2); RW_LD_RKV(1, 0); RW_LD_RKV(2, 3); } while (0)
#define RW_UNPK(x_, q_) ((q_) == 0 ? (f32x4){bf_lo((x_).x), bf_hi((x_).x), bf_lo((x_).y), bf_hi((x_).y)} : (f32x4){bf_lo((x_).z), bf_hi((x_).z), bf_lo((x_).w), bf_hi((x_).w)})
    RW_GLOAD(0);
    for (int sub = 0; sub < TCH / 32; ++sub) {
        __syncthreads();
        { const int lo = st * 64 + sd;
#pragma unroll
          for (int q = 0; q < 2; ++q) { *(LAS f32x4*)(sw + lo + 4 * q) = a[0][q]; *(LAS f32x4*)(sn + lo + 4 * q) = a[1][q]; *(LAS f32x4*)(sb + lo + 4 * q) = a[2][q]; *(LAS f32x4*)(sk + lo + 4 * q) = RW_GET_RKV(0, q); *(LAS f32x4*)(sr + lo + 4 * q) = RW_GET_RKV(1, q); *(LAS f32x4*)(sv + lo + 4 * q) = RW_GET_RKV(2, q); } }
        __syncthreads();
        if (sub + 1 < TCH / 32) RW_GLOAD(sub + 1);
        { f32x4 opA[10], opB[10]; float vin[2], vA[2], vB[2];
          RW_LOAD(opA, 0);
          vA[0] = vin[0]; vA[1] = vin[1];
#pragma unroll 1
          for (int s = 0; s < 32; s += 2) {
              RW_LOAD(opB, s + 1);
              vB[0] = vin[0]; vB[1] = vin[1];
              RW_STEP(opA, vA, s);
              if (s + 2 < 32) { RW_LOAD(opA, s + 2); vA[0] = vin[0]; vA[1] = vin[1]; }
              RW_STEP(opB, vB, s + 1);
          } }
        __syncthreads();
        { const int fs = lt >> 3, c16 = (lt & 7) * 16;
          bf16* dst = (c16 < 64) ? (bf16*)((float*)(A.ws + WS_YO) + YO_STRIDE) : ((bf16*)(A.ws + WS_PT) - 64);
          bf16* dp = dst + (tok0 + sub * 32 + fs) * 256 + h * 64 + c16;
#pragma unroll
          for (int q = 0; q < 2; ++q) { const f32x4 x0 = *(const LAS f32x4*)(so + fs * 128 + c16 + 8 * q), x1 = *(const LAS f32x4*)(so + fs * 128 + c16 + 8 * q + 4);
              v4u wv; wv.x = pk2(x0.x, x0.y); wv.y = pk2(x0.z, x0.w); wv.z = pk2(x1.x, x1.y); wv.w = pk2(x1.z, x1.w); *(v4u*)(dp + 8 * q) = wv; } }
    }
    { float* ch = (float*)(A.ws + WS_CH) + ((size_t)(bh * NCH + c) * 128) * 64 + 8 * kq;
#pragma unroll
      for (int i = 0; i < 4; ++i) { float* cr = ch + (size_t)RW_ROW(i) * 64; *(f32x4*)cr = (f32x4){S[i][0].x, S[i][0].y, S[i][1].x, S[i][1].y}; *(f32x4*)(cr + 4) = (f32x4){S[i][2].x, S[i][2].y, S[i][3].x, S[i][3].y}; } }
    __syncthreads();
}
#undef RW_LOAD
#undef RW_STEP
#undef RW_GLOAD
#undef RW_UNPK
#undef RW_LD_RKV
#undef RW_GET_RKV
#undef RW_DOT
#undef RW_ROW
__device__ __forceinline__ void scan_ret_task(ARef A, const WI& w, int task) {
    const int bh = task >> 3, cp = task & 7, b = bh >> 2, h = bh & 3, un = w.tid >> 8, lt = w.tid & 255, c = 2 * cp + un;
    const float lg2g = log2f(1.0f - exp2f(-5.0f - (float)h)), gamma = exp2f(lg2g);
    LAS float* sk = (LAS float*)w.lds + un * 8192; LAS float* sq = sk + 2048; LAS float* sv = sq + 2048; LAS float* so = sv + 2048;
    const bf16* PB = (const bf16*)(A.ws + WS_PB); const float* RT = (const float*)(A.ws + WS_ROPE);
    const int row = lt >> 2, kq = lt & 3;
    f32x2 S[8];
#pragma unroll
    for (int j = 0; j < 8; ++j) S[j] = (f32x2){0.0f, 0.0f};
    const f32x2 gam2 = {gamma, gamma};
    const size_t tok0 = (size_t)b * SEQ + (size_t)c * TCH;
    const int st = lt >> 3, sd = (lt & 7) * 8;
    const int fi = sd & 31, dp = sd ^ 32;
    f32x4 gq[2], gqo[2], gk[2], gko[2], gv[2], gcs[2], gsn[2];
#define BF8_TO_F32(dst, x_) do { dst[0] = (f32x4){bf_lo(x_.x), bf_hi(x_.x), bf_lo(x_.y), bf_hi(x_.y)}; dst[1] = (f32x4){bf_lo(x_.z), bf_hi(x_.z), bf_lo(x_.w), bf_hi(x_.w)}; } while (0)
#define RT_GLOAD(sub_) do { const size_t m_ = tok0 + (sub_) * 32 + st; const bf16* pr_ = PB + m_ * PBW + h * 64; const float* rt_ = RT + m_ * ROPE_W; \
        _Pragma("unroll") for (int u = 0; u < 2; ++u) { gcs[u] = *(const f32x4*)(rt_ + fi + 4 * u); gsn[u] = *(const f32x4*)(rt_ + 32 + fi + 4 * u); } \
        { const v4u x0 = *(const v4u*)(pr_ + sd), x1 = *(const v4u*)(pr_ + dp), x2 = *(const v4u*)(pr_ + 256 + sd), x3 = *(const v4u*)(pr_ + 256 + dp), x4 = *(const v4u*)(pr_ + 512 + sd); \
          BF8_TO_F32(gq, x0); BF8_TO_F32(gqo, x1); BF8_TO_F32(gk, x2); BF8_TO_F32(gko, x3); BF8_TO_F32(gv, x4); } } while (0)
    RT_GLOAD(0);
    for (int sub = 0; sub < TCH / 32; ++sub) {
        const size_t m = tok0 + sub * 32 + st;
        f32x4 qn[2], kn[2], vn[2];
#pragma unroll
        for (int u = 0; u < 2; ++u) { qn[u] = (sd < 32) ? gq[u] * gcs[u] - gqo[u] * gsn[u] : gqo[u] * gsn[u] + gq[u] * gcs[u]; kn[u] = (sd < 32) ? gk[u] * gcs[u] - gko[u] * gsn[u] : gko[u] * gsn[u] + gk[u] * gcs[u]; vn[u] = gv[u]; }
        { const float gt = exp2f(lg2g * (float)(sub * 32 + st + 1)); const f32x4 p0 = qn[0] * gt, p1 = qn[1] * gt;
          v4u pw; pw.x = pk2(p0.x, p0.y); pw.y = pk2(p0.z, p0.w); pw.z = pk2(p1.x, p1.y); pw.w = pk2(p1.z, p1.w); *(v4u*)((bf16*)(A.ws + WS_PTR) + m * 256 + h * 64 + sd) = pw; }
        __syncthreads();
        { const int lo = st * 64 + sd; *(LAS f32x4*)(sq + lo) = qn[0]; *(LAS f32x4*)(sq + lo + 4) = qn[1]; *(LAS f32x4*)(sk + lo) = kn[0]; *(LAS f32x4*)(sk + lo + 4) = kn[1]; *(LAS f32x4*)(sv + lo) = vn[0]; *(LAS f32x4*)(sv + lo + 4) = vn[1]; }
        __syncthreads();
        if (sub + 1 < TCH / 32) RT_GLOAD(sub + 1);
#define RT_LOAD(kvA, rvA, vA, s_) do { const int lo_ = (s_) * 64 + kq * 16; _Pragma("unroll") for (int j4 = 0; j4 < 4; ++j4) { kvA[j4] = *(const LAS f32x4*)(sk + lo_ + 4 * j4); rvA[j4] = *(const LAS f32x4*)(sq + lo_ + 4 * j4); } vA = sv[(s_) * 64 + row]; } while (0)
#define RT_STEP(kvA, rvA, vA, s_) do { const f32x2 v2 = {vA, vA}; f32x2 y2 = {0.0f, 0.0f}; \
            _Pragma("unroll") for (int j4 = 0; j4 < 4; ++j4) { S[2 * j4] = S[2 * j4] * gam2 + v2 * LO2(kvA[j4]); S[2 * j4 + 1] = S[2 * j4 + 1] * gam2 + v2 * HI2(kvA[j4]); \
                y2 = S[2 * j4] * LO2(rvA[j4]) + y2; y2 = S[2 * j4 + 1] * HI2(rvA[j4]) + y2; } \
            const float y = quad_sum(y2.x + y2.y); if (kq == 0) so[(s_) * 64 + row] = y; } while (0)
        { f32x4 kA[4], rA[4], kB[4], rB[4]; float vA, vB;
          RT_LOAD(kA, rA, vA, 0);
#pragma unroll 1
          for (int s = 0; s < 32; s += 2) {
              RT_LOAD(kB, rB, vB, s + 1);
              RT_STEP(kA, rA, vA, s);
              if (s + 2 < 32) RT_LOAD(kA, rA, vA, s + 2);
              RT_STEP(kB, rB, vB, s + 1);
          } }
#undef RT_LOAD
#undef RT_STEP
        __syncthreads();
        { const int fs = lt >> 3, c8 = (lt & 7) * 8; bf16* dp2 = (bf16*)(A.ws + WS_YO) + (tok0 + sub * 32 + fs) * 256 + h * 64 + c8;
          const f32x4 x0 = *(const LAS f32x4*)(so + fs * 64 + c8), x1 = *(const LAS f32x4*)(so + fs * 64 + c8 + 4);
          v4u wv; wv.x = pk2(x0.x, x0.y); wv.y = pk2(x0.z, x0.w); wv.z = pk2(x1.x, x1.y); wv.w = pk2(x1.z, x1.w); *(v4u*)dp2 = wv; }
    }
    { float* ch = (float*)(A.ws + WS_CHR) + ((size_t)(bh * NCH + c) * 64 + row) * 64 + 16 * kq;
#pragma unroll
      for (int j4 = 0; j4 < 4; ++j4) *(f32x4*)(ch + 4 * j4) = (f32x4){S[2 * j4].x, S[2 * j4].y, S[2 * j4 + 1].x, S[2 * j4 + 1].y}; }
    __syncthreads();
}
#undef RT_GLOAD
#undef BF8_TO_F32
__device__ __forceinline__ void prefix_chain(ARef A, const WI& w, int bh) {
    LAS float* s0 = (LAS float*)w.lds;
    const int v = w.tid >> 3, k8 = (w.tid & 7) * 8;
    const float* CH = (const float*)(A.ws + WS_CH) + (size_t)bh * NCH * 128 * 64; float* SI = (float*)(A.ws + WS_SI) + (size_t)bh * NCH * 64 * 64;
    f32x4 c0 = {0.f, 0.f, 0.f, 0.f}, c1 = {0.f, 0.f, 0.f, 0.f};
    for (int c = 0; c < NCH; ++c) {
        *(f32x4*)(SI + ((size_t)c * 64 + v) * 64 + k8) = c0; *(f32x4*)(SI + ((size_t)c * 64 + v) * 64 + k8 + 4) = c1;
        if (c == NCH - 1) break;
        __syncthreads();
        *(LAS f32x4*)(s0 + v * 68 + k8) = c0; *(LAS f32x4*)(s0 + v * 68 + k8 + 4) = c1;
        __syncthreads();
        const float* ch = CH + (size_t)c * 128 * 64;
        f32x4 n0 = *(const f32x4*)(ch + (size_t)v * 64 + k8), n1 = *(const f32x4*)(ch + (size_t)v * 64 + k8 + 4);
#pragma unroll 8
        for (int kp = 0; kp < 64; ++kp) { const float s = s0[v * 68 + kp]; const float* pr = ch + (size_t)(64 + kp) * 64 + k8; n0 += s * *(const f32x4*)pr; n1 += s * *(const f32x4*)(pr + 4); }
        c0 = n0; c1 = n1;
    }
    const int h = bh & 3; const float gT = exp2f((float)TCH * log2f(1.0f - exp2f(-5.0f - (float)h)));
    const float* CHR = (const float*)(A.ws + WS_CHR) + (size_t)bh * NCH * 64 * 64; float* SIR = (float*)(A.ws + WS_SIR) + (size_t)bh * NCH * 64 * 64;
    c0 = (f32x4){0.f, 0.f, 0.f, 0.f}; c1 = c0;
    for (int c = 0; c < NCH; ++c) {
        *(f32x4*)(SIR + ((size_t)c * 64 + v) * 64 + k8) = c0; *(f32x4*)(SIR + ((size_t)c * 64 + v) * 64 + k8 + 4) = c1;
        if (c == NCH - 1) break;
        c0 = c0 * gT + *(const f32x4*)(CHR + ((size_t)c * 64 + v) * 64 + k8); c1 = c1 * gT + *(const f32x4*)(CHR + ((size_t)c * 64 + v) * 64 + k8 + 4);
    }
    __syncthreads();
}
typedef float f32x16 __attribute__((ext_vector_type(16)));
constexpr int SBV_PITCH = 144;
__device__ __forceinline__ float lane32_swap(float v) { return __shfl_xor(v, 32); }
__device__ __forceinline__ void sb_tile_mfma(ARef A, int unit, int lane, LAS unsigned char* vl) {
    const int tq = unit & 127, bh = unit >> 7, b = bh >> 2, h = bh & 3, t0 = tq * 32, r32 = lane & 31, hi = lane >> 5;
    const bf16* PS = (const bf16*)(A.ws + WS_PB) + (size_t)b * SEQ * PBW + PB_SB + h * 64;
    bf16x8v qf[4];
#pragma unroll
    for (int ks = 0; ks < 4; ++ks) qf[ks] = *(const bf16x8v*)(PS + (size_t)(t0 + r32) * PBW + 16 * ks + 8 * hi);
    f32x16 o0, o1;
#pragma unroll
    for (int r = 0; r < 16; ++r) { o0[r] = 0.0f; o1[r] = 0.0f; }
    float carry = 0.0f;
    const int g16 = lane >> 4, tj = (lane & 15) >> 2, tc = lane & 3;
    v4u vn[4]; bf16x8v kn[4];
#define SB_FETCH(kb_) do { _Pragma("unroll") for (int i = 0; i < 4; ++i) { const int p = lane + 64 * i, row = p >> 3, ch = p & 7; vn[i] = *(const v4u*)(PS + 512 + (size_t)((kb_) + row) * PBW + 8 * ch); } \
        _Pragma("unroll") for (int ks = 0; ks < 4; ++ks) kn[ks] = *(const bf16x8v*)(PS + 256 + (size_t)((kb_) + r32) * PBW + 16 * ks + 8 * hi); } while (0)
    SB_FETCH(t0);
    for (int kb0 = t0; kb0 >= 0; kb0 -= 32) {
#pragma unroll
        for (int i = 0; i < 4; ++i) { const int p = lane + 64 * i, row = p >> 3, ch = p & 7; *(LAS v4u*)(vl + row * SBV_PITCH + 16 * ch) = vn[i]; }
        f32x16 st;
#pragma unroll
        for (int r = 0; r < 16; ++r) st[r] = 0.0f;
        { bf16x8v ka[4];
#pragma unroll
          for (int ks = 0; ks < 4; ++ks) ka[ks] = kn[ks];
          if (kb0 >= 32) SB_FETCH(kb0 - 32);
#pragma unroll
          for (int ks = 0; ks < 4; ++ks) st = __builtin_amdgcn_mfma_f32_32x32x16_bf16(ka[ks], qf[ks], st, 0, 0, 0);
          asm volatile("" :: "v"(ka[0]), "v"(ka[1]), "v"(ka[2]), "v"(ka[3]), "v"(st)); }
        float sp[16]; const bool diag = (kb0 == t0);
#pragma unroll
        for (int r = 0; r < 16; ++r) { const float zl = st[r]; float s = (zl > 30.0f) ? zl : __builtin_amdgcn_logf(1.0f + __builtin_amdgcn_exp2f(zl));
            if (diag && ((r & 3) + 8 * (r >> 2) + 4 * hi >= r32)) s = 0.0f;
            sp[r] = s; }
        float G[4], Gp[4], suf[4];
#pragma unroll
        for (int q = 0; q < 4; ++q) { G[q] = (sp[4 * q] + sp[4 * q + 1]) + (sp[4 * q + 2] + sp[4 * q + 3]); Gp[q] = lane32_swap(G[q]); }
        suf[3] = 0.0f; suf[2] = G[3] + Gp[3]; suf[1] = suf[2] + (G[2] + Gp[2]); suf[0] = suf[1] + (G[1] + Gp[1]);
        const float tot = suf[0] + (G[0] + Gp[0]);
        pg8::u32x4 pw0, pw1;
        float av[16];
#pragma unroll
        for (int q = 0; q < 4; ++q) { float run = carry + suf[q] + (hi == 0 ? Gp[q] : 0.0f);
#pragma unroll
            for (int i = 3; i >= 0; --i) { const int r = 4 * q + i; const float la = (st[r] - sp[r]) - run; float a = __builtin_amdgcn_exp2f(la);
                if (diag && ((r & 3) + 8 * (r >> 2) + 4 * hi >= r32)) a = 0.0f;
                av[r] = a; run += sp[r]; } }
        pw0.x = pg8::cvt_pk_bf16(av[0], av[1]); pw0.y = pg8::cvt_pk_bf16(av[2], av[3]); pw0.z = pg8::cvt_pk_bf16(av[4], av[5]); pw0.w = pg8::cvt_pk_bf16(av[6], av[7]);
        pw1.x = pg8::cvt_pk_bf16(av[8], av[9]); pw1.y = pg8::cvt_pk_bf16(av[10], av[11]); pw1.z = pg8::cvt_pk_bf16(av[12], av[13]); pw1.w = pg8::cvt_pk_bf16(av[14], av[15]);
        const bf16x8v pa0 = __builtin_bit_cast(bf16x8v, pw0), pa1 = __builtin_bit_cast(bf16x8v, pw1);
        LDS_WAIT();
#pragma unroll
        for (int s = 0; s < 2; ++s)
#pragma unroll
            for (int nb = 0; nb < 2; ++nb) {
                LAS unsigned char* a1 = vl + (16 * s + 4 * (g16 >> 1) + tj) * SBV_PITCH + (32 * nb + 16 * (g16 & 1) + 4 * tc) * 2;
                const s16x4v r1 = __builtin_bit_cast(s16x4v, __builtin_amdgcn_ds_read_tr16_b64_v4i16((LAS s16x4v*)a1));
                const s16x4v r2 = __builtin_bit_cast(s16x4v, __builtin_amdgcn_ds_read_tr16_b64_v4i16((LAS s16x4v*)(a1 + 8 * SBV_PITCH)));
                const bf16x8v bv = {r1[0], r1[1], r1[2], r1[3], r2[0], r2[1], r2[2], r2[3]};
                if (nb == 0) o0 = __builtin_amdgcn_mfma_f32_32x32x16_bf16(s ? pa1 : pa0, bv, o0, 0, 0, 0); else o1 = __builtin_amdgcn_mfma_f32_32x32x16_bf16(s ? pa1 : pa0, bv, o1, 0, 0, 0);
                asm volatile("" :: "v"(bv), "v"(pa0), "v"(pa1), "v"(o0), "v"(o1)); }
        LDS_WAIT();
        carry += tot;
        if (__all(carry > 150.0f)) break;
    }
#undef SB_FETCH
    bf16* YS = (bf16*)((float*)(A.ws + WS_YO) + 3 * YO_STRIDE) + ((size_t)b * SEQ + t0) * 256 + h * 64 + r32;
#pragma unroll
    for (int r = 0; r < 16; ++r) { const int qo = (r & 3) + 8 * (r >> 2) + 4 * hi; YS[(size_t)qo * 256] = (bf16)f2bf(o0[r]); YS[(size_t)qo * 256 + 32] = (bf16)f2bf(o1[r]); }
}

__device__ __forceinline__ void dsa_scores_mfma(ARef A, const WI& w) {
    const _Float16* QIH = (const _Float16*)(A.ws + WS_DQI); const _Float16* KIH = (const _Float16*)(A.ws + WS_DKI);
    const float* DW = (const float*)(A.ws + WS_DW); float* SC = (float*)(A.ws + WS_SC);
    const int col = w.lane & 15, q4 = w.lane >> 4;
    for (int u = w.gw; u < 2048; u += w.NGW) {
        const int pi = u >> 1, par = u & 1, b = pi >> 7, p = pi & 127;
#pragma unroll 1
        for (int side = 0; side < 2; ++side) {
            const int qb = side ? 255 - p : p; const size_t m0 = (size_t)b * SEQ + 16 * qb;
            f16x8 bq[8];
#pragma unroll
            for (int h = 0; h < 8; ++h) bq[h] = *(const f16x8*)(QIH + (m0 + col) * 256 + h * 32 + 8 * q4);
            const float* dw = DW + (m0 + col) * 8; const f32x4 wa = *(const f32x4*)dw, wb = *(const f32x4*)(dw + 4);
            float* srow = SC + (m0 + col) * SEQ + 4 * q4;
            const _Float16* kbase = KIH + ((size_t)b * SEQ + col) * 32 + 8 * q4;
            for (int kp = par; 2 * kp <= qb; kp += 4) {
                f16x8 ak[4];
#pragma unroll
                for (int q = 0; q < 4; ++q) { const int kb = 2 * (kp + 2 * (q >> 1)) + (q & 1); ak[q] = *(const f16x8*)(kbase + (size_t)(kb <= qb ? kb : qb) * 16 * 32); }
#pragma unroll
                for (int q = 0; q < 4; ++q) { const int kb = 2 * (kp + 2 * (q >> 1)) + (q & 1);
                    if (kb <= qb) {
                        f32x4 acc = {0.f, 0.f, 0.f, 0.f};
#pragma unroll
                        for (int h = 0; h < 8; ++h) { const f32x4 c = __builtin_amdgcn_mfma_f32_16x16x32_f16(ak[q], bq[h], (f32x4){0.f, 0.f, 0.f, 0.f}, 0, 0, 0); const float wv = (h < 4) ? wa[h] : wb[h - 4];
                            acc.x += wv * fmaxf(c.x, 0.f); acc.y += wv * fmaxf(c.y, 0.f); acc.z += wv * fmaxf(c.z, 0.f); acc.w += wv * fmaxf(c.w, 0.f); }
                        *(f32x4*)(srow + 16 * kb) = acc + 0.0f; } }
            }
        }
    }
}

__device__ __forceinline__ int wave_total_i(int v) {
    v += __builtin_amdgcn_mov_dpp(v, 0xB1, 0xF, 0xF, true);
    v += __builtin_amdgcn_mov_dpp(v, 0x4E, 0xF, 0xF, true);
    v += __builtin_amdgcn_mov_dpp(v, 0x141, 0xF, 0xF, true);
    v += __builtin_amdgcn_mov_dpp(v, 0x140, 0xF, 0xF, true);
    return __builtin_amdgcn_readlane(v, 0) + __builtin_amdgcn_readlane(v, 16) + __builtin_amdgcn_readlane(v, 32) + __builtin_amdgcn_readlane(v, 48);
}
__device__ __forceinline__ unsigned score_key(float f) { const unsigned bits = __float_as_uint(f); return (bits & 0x80000000u) ? ~bits : (bits | 0x80000000u); }
constexpr int VST_PITCH = 144;
typedef unsigned short u16;
__device__ __forceinline__ void dsa_load_scores(ARef A, int m, int lane, f32x4 (&sv)[16]) {
    const int n = (m & (SEQ - 1)) + 1; const float* sc = (const float*)(A.ws + WS_SC) + (size_t)m * SEQ;
#pragma unroll
    for (int c = 0; c < 8; ++c) { if (512 * c < n) { sv[2 * c] = *(const f32x4*)(sc + 512 * c + 4 * lane); sv[2 * c + 1] = *(const f32x4*)(sc + ((512 * c + 256 < n) ? 512 * c + 256 : 0) + 4 * lane); } else { sv[2 * c] = (f32x4){0.f, 0.f, 0.f, 0.f}; sv[2 * c + 1] = sv[2 * c]; } }
}
__device__ __forceinline__ void dsa_select(ARef A, int m, int n, int lane_in, LAS u16* slist, LAS unsigned* bk) {
    int lane = lane_in; asm volatile("" : "+v"(lane));
    if (n <= 256) {
#pragma unroll
        for (int c = 0; c < 4; ++c) { const int idx = lane + 64 * c; slist[idx] = (u16)((idx < n) ? idx : 0); }
        return;
    }
    f32x4 sv[16]; dsa_load_scores(A, m, lane, sv);
    unsigned u[64];
#pragma unroll
    for (int j4 = 0; j4 < 16; ++j4)
#pragma unroll
        for (int i = 0; i < 4; ++i) u[4 * j4 + i] = (256 * j4 + 4 * lane + i < n) ? score_key(sv[j4][i]) : 0u;
    unsigned T = 0u;
    for (int bit = 31; bit >= 16; --bit) { const unsigned cand = T | (1u << bit); int cnt = 0;
#pragma unroll
        for (int c = 0; c < 8; ++c) { if (512 * c < n) {
#pragma unroll
            for (int j = 8 * c; j < 8 * c + 8; ++j) cnt += (u[j] >= cand) ? 1 : 0; } }
        if (wave_total_i(cnt) >= 256) T = cand; }
    unsigned long long bkb = 0ull; int chi = 0;
#pragma unroll
    for (int c = 0; c < 8; ++c) { if (512 * c < n) {
#pragma unroll
        for (int j = 8 * c; j < 8 * c + 8; ++j) { bkb |= (unsigned long long)(((u[j] >> 16) == (T >> 16)) ? 1u : 0u) << j; chi += ((u[j] >> 16) > (T >> 16)) ? 1 : 0; } } }
    const int cb = wave_total_i(__popcll(bkb)), need = 256 - wave_total_i(chi);
    if (cb <= 64) {
        int pos = __popcll(bkb);
        { const int mine_ = pos;
#pragma unroll
          for (int d = 1; d < 64; d <<= 1) { const int y = __shfl_up(pos, d); if (lane >= d) pos += y; }
          pos -= mine_; }
#pragma unroll
        for (int j = 0; j < 64; ++j) { if ((bkb >> j) & 1ull) { bk[pos] = u[j]; ++pos; } }
        LDS_WAIT();
        const unsigned kx = (lane < cb) ? bk[lane] : 0u;
        for (int bit = 15; bit >= 0; --bit) { const unsigned cand = T | (1u << bit); if (__popcll(__ballot(kx >= cand)) >= need) T = cand; }
        LDS_WAIT();
    } else {
        for (int bit = 15; bit >= 0; --bit) { const unsigned cand = T | (1u << bit); int cnt = 0;
#pragma unroll
            for (int c = 0; c < 8; ++c) { if (512 * c < n) {
#pragma unroll
                for (int j = 8 * c; j < 8 * c + 8; ++j) cnt += (u[j] >= cand) ? 1 : 0; } }
            if (wave_total_i(cnt) >= 256) T = cand; }
    }
    unsigned long long gtb = 0ull, eqb = 0ull;
#pragma unroll
    for (int c = 0; c < 8; ++c) { if (512 * c < n) {
#pragma unroll
        for (int j = 8 * c; j < 8 * c + 8; ++j) { gtb |= (unsigned long long)((u[j] > T) ? 1u : 0u) << j; eqb |= (unsigned long long)((u[j] == T) ? 1u : 0u) << j; } } }
    const int tgt = wave_total_i(__popcll(gtb)), teq = wave_total_i(__popcll(eqb));
    unsigned long long selb = gtb | eqb;
    if (tgt + teq > 256) {
        const int take = 256 - tgt; int lo = 0;
        for (int bit = 11; bit >= 0; --bit) { const int cand = lo | (1 << bit); const int J4 = cand >> 8; int ni = (cand & 255) - 4 * lane; ni = ni < 0 ? 0 : (ni > 4 ? 4 : ni);
            const int jc = 4 * J4 + ni; const unsigned long long msk = (jc >= 64) ? ~0ull : ((1ull << jc) - 1ull);
            if (wave_total_i(__popcll(eqb & msk)) < take) lo = cand; }
        { const int cand = lo + 1; const int J4 = cand >> 8; int ni = (cand & 255) - 4 * lane; ni = ni < 0 ? 0 : (ni > 4 ? 4 : ni);
          const int jc = (cand >= SEQ) ? 64 : 4 * J4 + ni; const unsigned long long msk = (jc >= 64) ? ~0ull : ((1ull << jc) - 1ull); selb = gtb | (eqb & msk); }
    }
    const int mine = __popcll(selb); int off = mine;
#pragma unroll
    for (int d = 1; d < 64; d <<= 1) { const int y = __shfl_up(off, d); if (lane >= d) off += y; }
    off -= mine;
    while (selb) { const int j = __builtin_ctzll(selb); selb &= selb - 1ull; slist[off] = (u16)(256 * (j >> 2) + 4 * lane + (j & 3)); ++off; }
}
__device__ __forceinline__ void dsa_attend(ARef A, int m, int lane_in, const LAS u16* slist, LAS unsigned char* vbuf) {
    int lane = lane_in; asm volatile("" : "+v"(lane));
    const int b = m >> 12, t = m & (SEQ - 1), n = t + 1, nsel = n < 256 ? n : 256, col = lane & 15, q4 = lane >> 4;
    const bf16* DKB = (const bf16*)(A.ws + WS_DKB) + (size_t)b * SEQ * 64; const bf16* DVB = (const bf16*)(A.ws + WS_DVB) + (size_t)b * SEQ * 64;
    const int vrow = lane >> 3, vpc = lane & 7;
    bf16x8v bq0 = {0, 0, 0, 0, 0, 0, 0, 0}, bq1 = {0, 0, 0, 0, 0, 0, 0, 0};
    if (col < 4) { const bf16* qp = (const bf16*)(A.ws + WS_DQ) + (size_t)m * 256 + col * 64 + 8 * q4; bq0 = *(const bf16x8v*)qp; bq1 = *(const bf16x8v*)(qp + 32); }
    f32x4 lg[16];
#pragma unroll
    for (int hb = 0; hb < 2; ++hb) {
        bf16x8v a0[8], a1[8];
#pragma unroll
        for (int k = 0; k < 8; ++k) { const int s = slist[16 * (8 * hb + k) + col]; const bf16* kr = DKB + (size_t)s * 64 + 8 * q4; a0[k] = *(const bf16x8v*)kr; a1[k] = *(const bf16x8v*)(kr + 32); }
#pragma unroll
        for (int k = 0; k < 8; ++k) { const f32x4 c = __builtin_amdgcn_mfma_f32_16x16x32_bf16(a0[k], bq0, (f32x4){0.f, 0.f, 0.f, 0.f}, 0, 0, 0); lg[8 * hb + k] = __builtin_amdgcn_mfma_f32_16x16x32_bf16(a1[k], bq1, c, 0, 0, 0); }
        __builtin_amdgcn_sched_barrier(0);
    }
    if (nsel < 256) {
#pragma unroll
        for (int kb = 0; kb < 16; ++kb)
#pragma unroll
            for (int r = 0; r < 4; ++r) if (16 * kb + 4 * q4 + r >= nsel) lg[kb][r] = -INFINITY; }
    v4u vr[4];
#pragma unroll
    for (int i = 0; i < 4; ++i) { const int s = slist[vrow + 8 * i]; vr[i] = *(const v4u*)(DVB + (size_t)s * 64 + 8 * vpc); }
    float mx = -INFINITY;
#pragma unroll
    for (int kb = 0; kb < 16; ++kb) mx = fmaxf(fmaxf(mx, fmaxf(lg[kb].x, lg[kb].y)), fmaxf(lg[kb].z, lg[kb].w));
    mx = fmaxf(mx, __shfl_xor(mx, 16)); mx = fmaxf(mx, __shfl_xor(mx, 32));
    float sm = 0.f;
#pragma unroll
    for (int kb = 0; kb < 16; ++kb) { lg[kb].x = __builtin_amdgcn_exp2f(lg[kb].x - mx); lg[kb].y = __builtin_amdgcn_exp2f(lg[kb].y - mx); lg[kb].z = __builtin_amdgcn_exp2f(lg[kb].z - mx); lg[kb].w = __builtin_amdgcn_exp2f(lg[kb].w - mx); sm += (lg[kb].x + lg[kb].y) + (lg[kb].z + lg[kb].w); }
    sm += __shfl_xor(sm, 16); sm += __shfl_xor(sm, 32);
    const float inv = 1.0f / sm;
    bf16x8v pa[8];
#pragma unroll
    for (int i = 0; i < 8; ++i) { const f32x4 x = lg[2 * i] * inv, y = lg[2 * i + 1] * inv;
        pg8::u32x4 wv; wv.x = pg8::cvt_pk_bf16(x.x, x.y); wv.y = pg8::cvt_pk_bf16(x.z, x.w); wv.z = pg8::cvt_pk_bf16(y.x, y.y); wv.w = pg8::cvt_pk_bf16(y.z, y.w);
        pa[i] = __builtin_bit_cast(bf16x8v, wv); }
    f32x4 o[4];
#pragma unroll
    for (int nb = 0; nb < 4; ++nb) o[nb] = (f32x4){0.f, 0.f, 0.f, 0.f};
    const int tj = col >> 2, tc = col & 3;
#pragma unroll
    for (int c = 0; c < 8; ++c) {
        LAS unsigned char* vb = vbuf + (c & 1) * (32 * VST_PITCH);
#pragma unroll
        for (int i = 0; i < 4; ++i) *(LAS v4u*)(vb + (vrow + 8 * i) * VST_PITCH + 16 * vpc) = vr[i];
        if (c < 7) {
#pragma unroll
            for (int i = 0; i < 4; ++i) { const int s = slist[32 * (c + 1) + vrow + 8 * i]; vr[i] = *(const v4u*)(DVB + (size_t)s * 64 + 8 * vpc); } }
        LDS_WAIT();
#pragma unroll
        for (int nb = 0; nb < 4; ++nb) {
            LAS unsigned char* a1 = vb + (4 * q4 + tj) * VST_PITCH + (16 * nb + 4 * tc) * 2;
            const s16x4v r1 = __builtin_bit_cast(s16x4v, __builtin_amdgcn_ds_read_tr16_b64_v4i16((LAS s16x4v*)a1));
            const s16x4v r2 = __builtin_bit_cast(s16x4v, __builtin_amdgcn_ds_read_tr16_b64_v4i16((LAS s16x4v*)(a1 + 16 * VST_PITCH)));
            const bf16x8v bv = {r1[0], r1[1], r1[2], r1[3], r2[0], r2[1], r2[2], r2[3]};
            o[nb] = __builtin_amdgcn_mfma_f32_16x16x32_bf16(pa[c], bv, o[nb], 0, 0, 0); }
    }
    LDS_WAIT();
    if (lane < 16) { bf16* YD = (bf16*)((float*)(A.ws + WS_YO) + 2 * YO_STRIDE) + (size_t)m * 256;
#pragma unroll
        for (int nb = 0; nb < 4; ++nb) { YD[16 * nb + lane] = (bf16)f2bf(o[nb].x); YD[64 + 16 * nb + lane] = (bf16)f2bf(o[nb].y); YD[128 + 16 * nb + lane] = (bf16)f2bf(o[nb].z); YD[192 + 16 * nb + lane] = (bf16)f2bf(o[nb].w); } }
}
constexpr int DSA_GR = 1;
__device__ __forceinline__ int dsa_row_of(int batch, int gi, int r) { const int idx = DSA_GR * gi + r, h = idx >> 1; return batch * SEQ + ((idx & 1) ? (SEQ - 1 - h) : h); }
__device__ __forceinline__ void dsa_wave(ARef A, const WI& w, LAS unsigned char* wl, int qi, int l, int skip = 0) {
    LAS u16* lists = (LAS u16*)wl; LAS unsigned char* vbuf = wl + 4096; LAS unsigned* bk = (LAS unsigned*)vbuf;
#pragma unroll 1
    for (int kb = 0; kb < NB; ++kb) {
        const int batch = (w.bx + kb) & (NB - 1);
        unsigned* head = (unsigned*)(A.ws + WS_CTL) + CW_DSAQ + 128 * qi + 16 * batch;
        for (;;) {
            int g = 0; if (w.lane == 0) g = (int)atomicAdd(head, 1u);
            g = __builtin_amdgcn_readfirstlane(g);
            if (g >= 11 * (SEQ / 8)) break;
            const int per = g / 11, pos = g - 11 * per;
            if (pos >= 8) { if (!(skip & 4)) moe_convert_chunk(A, l, batch * 1536 + 3 * per + (pos - 8), w.lane, (LAS float*)vbuf); continue; }
            if (skip & 2) continue;
            const int gi = 8 * per + pos;
            { const int m = dsa_row_of(batch, gi, 0), n = (m & (SEQ - 1)) + 1; dsa_select(A, m, n, w.lane, lists, bk); }
            LDS_WAIT();
            if (!(skip & 1)) dsa_attend(A, dsa_row_of(batch, gi, 0), w.lane, lists, vbuf);
        }
    }
}

__device__ __forceinline__ f32x4 head_norm4(f32x4 y, float eps, f32x4 g) {
    const float mean = grp16_sum(sum4(y)) * (1.0f / 64.0f); const f32x4 yc = y - mean;
    const float var = grp16_sum(dot4(yc, yc)) * (1.0f / 64.0f); return yc * (1.0f / sqrtf(var + eps)) * g;
}
template <bool BF> __device__ __forceinline__ f32x4 state_corr(const LAS float* sl, int hh, int r16, const void* pv) {
    const LAS float* r0 = sl + (hh * 64 + 4 * r16) * 64; const int x0 = (4 * r16) & 15;
    f32x4 out = {0.f, 0.f, 0.f, 0.f};
#pragma unroll 2
    for (int k8 = 0; k8 < 8; ++k8) {
        f32x4 pa, pb;
        if (BF) { const v4u x = ((const v4u*)pv)[k8]; pa = (f32x4){bf_lo(x.x), bf_hi(x.x), bf_lo(x.y), bf_hi(x.y)}; pb = (f32x4){bf_lo(x.z), bf_hi(x.z), bf_lo(x.w), bf_hi(x.w)}; }
        else { pa = ((const f32x4*)pv)[2 * k8]; pb = ((const f32x4*)pv)[2 * k8 + 1]; }
#pragma unroll
        for (int i = 0; i < 4; ++i) { const LAS float* rowp = r0 + i * 64; const int xs = (x0 + i) & 15;
            out[i] += dot4(*(const LAS f32x4*)(rowp + 4 * ((2 * k8) ^ xs)), pa) + dot4(*(const LAS f32x4*)(rowp + 4 * ((2 * k8 + 1) ^ xs)), pb); }
    }
    return out;
}
__device__ __forceinline__ void post_row(ARef A, int l, int m, int lane, const LAS float* slw, const LAS float* slr) {
    const float* YO = (const float*)(A.ws + WS_YO); const float* RWA = (const float*)(A.ws + WS_RWA);
    bf16* MX = (bf16*)(A.ws + WS_MIX) + (size_t)m * DM; const int c4 = 4 * lane, hh = lane >> 4, r16 = lane & 15; const size_t o = (size_t)m * 256 + c4;
    { f32x4 y = *(const f32x4*)(YO + o) + state_corr<true>(slr, hh, r16, (const bf16*)(A.ws + WS_PTR) + (size_t)m * 256 + hh * 64);
      y = head_norm4(y, 1e-5f, *(const f32x4*)(A.in[I_RETGN] + l * 256 + c4));
      const v2u gw_ = *(const v2u*)((const bf16*)(A.ws + WS_PB) + (size_t)m * PBW + 768 + c4); const f32x4 g = {bf_lo(gw_.x), bf_hi(gw_.x), bf_lo(gw_.y), bf_hi(gw_.y)};
#pragma unroll
      for (int i = 0; i < 4; ++i) y[i] *= g[i] * sigm(g[i]);
      v2u w; w.x = pk2(y.x, y.y); w.y = pk2(y.z, y.w); *(v2u*)(MX + c4) = w; }
    { f32x4 y = *(const f32x4*)(YO + YO_STRIDE + o) + state_corr<false>(slw, hh, r16, (const float*)(A.ws + WS_PT) + (size_t)m * 256 + hh * 64);
      y = head_norm4(y, 64e-5f, *(const f32x4*)(A.in[I_LN] + l * 256 + c4));
      y = (y + *(const f32x4*)(RWA + 7 * RWA_STRIDE + o)) * *(const f32x4*)(RWA + 6 * RWA_STRIDE + o);
      v2u w; w.x = pk2(y.x, y.y); w.y = pk2(y.z, y.w); *(v2u*)(MX + 256 + c4) = w; }
    { f32x4 y = *(const f32x4*)(YO + 2 * YO_STRIDE + o); const float r = 1.0f / sqrtf(wave_sum(dot4(y, y)) * (1.0f / 256.0f) + 1e-5f);
      y = y * r * *(const f32x4*)(A.in[I_DONORM] + l * 256 + c4);
      v2u w; w.x = pk2(y.x, y.y); w.y = pk2(y.z, y.w); *(v2u*)(MX + 512 + c4) = w; }
    { f32x4 y = *(const f32x4*)(YO + 3 * YO_STRIDE + o); const float r = 1.0f / sqrtf(wave_sum(dot4(y, y)) * (1.0f / 256.0f) + 1e-5f);
      y = y * r * *(const f32x4*)(A.in[I_SONORM] + l * 256 + c4);
      v2u w; w.x = pk2(y.x, y.y); w.y = pk2(y.z, y.w); *(v2u*)(MX + 768 + c4) = w; }
}
__device__ __forceinline__ void ph_post(ARef A, const WI& w, int l) {
    LAS float* slw = (LAS float*)w.lds; LAS float* slr = slw + 16384;
    for (int u = w.vcu; u < NB * NCH * 2; u += w.G) {
        const int b = u >> 5, c = (u >> 1) & 15, half = u & 1;
        __syncthreads();
        for (int e = w.tid; e < 4096; e += NWAVES * 64) { const int hh = e >> 10, v = (e >> 4) & 63, k4 = e & 15;
            const size_t src = ((size_t)((b * 4 + hh) * NCH + c) * 64 + v) * 64 + 4 * k4; const int dst = (hh * 64 + v) * 64 + 4 * (k4 ^ (v & 15));
            *(LAS f32x4*)(slw + dst) = *(const f32x4*)((const float*)(A.ws + WS_SI) + src); *(LAS f32x4*)(slr + dst) = *(const f32x4*)((const float*)(A.ws + WS_SIR) + src); }
        __syncthreads();
        const int tok0 = b * SEQ + c * TCH + half * 128 + w.wave * 16;
        for (int i = 0; i < 16; ++i) post_row(A, l, tok0 + i, w.lane, slw, slr);
    }
}

constexpr int S0_PITCH = 144;
template <int MIXER> __device__ __forceinline__ void post16_head(ARef A, int l, size_t m, int hh, int tk, int fq, const LAS unsigned char* s0) {
    const size_t o = m * 256 + hh * 64 + 8 * fq;
    bf16x8v pb[2];
    if (MIXER == 0) { const bf16* pp = (const bf16*)(A.ws + WS_PTR) + o; pb[0] = *(const bf16x8v*)pp; pb[1] = *(const bf16x8v*)(pp + 32); }
    else { const bf16* pp = (const bf16*)(A.ws + WS_PT) + o; pb[0] = *(const bf16x8v*)pp; pb[1] = *(const bf16x8v*)(pp + 32); }
    f32x4 y[4];
    const bf16* yl = (const bf16*)((const float*)(A.ws + WS_YO) + MIXER * YO_STRIDE) + o;
#pragma unroll
    for (int j = 0; j < 2; ++j) { const v4u x = *(const v4u*)(yl + 32 * j); y[2 * j] = (f32x4){bf_lo(x.x), bf_hi(x.x), bf_lo(x.y), bf_hi(x.y)}; y[2 * j + 1] = (f32x4){bf_lo(x.z), bf_hi(x.z), bf_lo(x.w), bf_hi(x.w)}; }
    const float* gw = ((MIXER == 0) ? A.in[I_RETGN] : A.in[I_LN]) + l * 256 + hh * 64 + 8 * fq;
    f32x4 gn[4], e0[4], e1[4];
#pragma unroll
    for (int mb = 0; mb < 4; ++mb) gn[mb] = *(const f32x4*)(gw + 32 * (mb >> 1) + 4 * (mb & 1));
    if (MIXER == 0) {
#pragma unroll
        for (int j = 0; j < 2; ++j) { const v4u gx = *(const v4u*)((const bf16*)(A.ws + WS_PB) + m * PBW + 768 + hh * 64 + 8 * fq + 32 * j);
            e0[2 * j] = (f32x4){bf_lo(gx.x), bf_hi(gx.x), bf_lo(gx.y), bf_hi(gx.y)}; e0[2 * j + 1] = (f32x4){bf_lo(gx.z), bf_hi(gx.z), bf_lo(gx.w), bf_hi(gx.w)}; }
    } else { const float* RWA = (const float*)(A.ws + WS_RWA);
#pragma unroll
        for (int j = 0; j < 2; ++j) { const v4u bx_ = *(const v4u*)((const bf16*)(RWA + 7 * RWA_STRIDE) + o + 32 * j), gx_ = *(const v4u*)((const bf16*)(RWA + 6 * RWA_STRIDE) + o + 32 * j);
            e0[2 * j] = (f32x4){bf_lo(bx_.x), bf_hi(bx_.x), bf_lo(bx_.y), bf_hi(bx_.y)}; e0[2 * j + 1] = (f32x4){bf_lo(bx_.z), bf_hi(bx_.z), bf_lo(bx_.w), bf_hi(bx_.w)};
            e1[2 * j] = (f32x4){bf_lo(gx_.x), bf_hi(gx_.x), bf_lo(gx_.y), bf_hi(gx_.y)}; e1[2 * j + 1] = (f32x4){bf_lo(gx_.z), bf_hi(gx_.z), bf_lo(gx_.w), bf_hi(gx_.w)}; } }
    const LAS unsigned char* ab = s0 + ((MIXER * 4 + hh) * 64 + 8 * (tk >> 2) + (tk & 3)) * S0_PITCH + 16 * fq;
#pragma unroll
    for (int mb = 0; mb < 4; ++mb)
#pragma unroll
        for (int ks = 0; ks < 2; ++ks) { const bf16x8v af = *(const LAS bf16x8v*)(ab + (32 * (mb >> 1) + 4 * (mb & 1)) * S0_PITCH + 64 * ks); y[mb] = __builtin_amdgcn_mfma_f32_16x16x32_bf16(af, pb[ks], y[mb], 0, 0, 0); }
    float s = (sum4(y[0]) + sum4(y[1])) + (sum4(y[2]) + sum4(y[3])); s += __shfl_xor(s, 16); s += __shfl_xor(s, 32);
    const float mean = s * (1.0f / 64.0f);
#pragma unroll
    for (int mb = 0; mb < 4; ++mb) y[mb] = y[mb] - mean;
    float q = (dot4(y[0], y[0]) + dot4(y[1], y[1])) + (dot4(y[2], y[2]) + dot4(y[3], y[3])); q += __shfl_xor(q, 16); q += __shfl_xor(q, 32);
    const float rs = 1.0f / sqrtf(q * (1.0f / 64.0f) + ((MIXER == 0) ? 1e-5f : 64e-5f));
    bf16* MX = (bf16*)(A.ws + WS_MIX) + m * DM + MIXER * 256 + hh * 64 + 8 * fq;
#pragma unroll
    for (int j = 0; j < 2; ++j) { f32x4 ya = y[2 * j] * rs * gn[2 * j], yb = y[2 * j + 1] * rs * gn[2 * j + 1];
        if (MIXER == 0) {
#pragma unroll
            for (int i = 0; i < 4; ++i) { ya[i] *= e0[2 * j][i] * sigm(e0[2 * j][i]); yb[i] *= e0[2 * j + 1][i] * sigm(e0[2 * j + 1][i]); }
        } else { ya = (ya + e0[2 * j]) * e1[2 * j]; yb = (yb + e0[2 * j + 1]) * e1[2 * j + 1]; }
        v4u wv; wv.x = pk2(ya.x, ya.y); wv.y = pk2(ya.z, ya.w); wv.z = pk2(yb.x, yb.y); wv.w = pk2(yb.z, yb.w); *(v4u*)(MX + 32 * j) = wv; }
}
__device__ __forceinline__ void post16_rms(ARef A, int l, size_t m, int mx, int fq) {
    const bf16* yp = (const bf16*)((const float*)(A.ws + WS_YO) + (size_t)mx * YO_STRIDE) + m * 256 + 8 * fq; const float* gw = ((mx == 2) ? A.in[I_DONORM] : A.in[I_SONORM]) + l * 256 + 8 * fq;
    f32x4 y[16];
#pragma unroll
    for (int j = 0; j < 8; ++j) { const v4u x = *(const v4u*)(yp + 32 * j); y[2 * j] = (f32x4){bf_lo(x.x), bf_hi(x.x), bf_lo(x.y), bf_hi(x.y)}; y[2 * j + 1] = (f32x4){bf_lo(x.z), bf_hi(x.z), bf_lo(x.w), bf_hi(x.w)}; }
    float q = 0.0f;
#pragma unroll
    for (int j = 0; j < 16; ++j) q += dot4(y[j], y[j]);
    q += __shfl_xor(q, 16); q += __shfl_xor(q, 32);
    const float r = 1.0f / sqrtf(q * (1.0f / 256.0f) + 1e-5f);
    bf16* MX = (bf16*)(A.ws + WS_MIX) + m * DM + mx * 256 + 8 * fq;
#pragma unroll
    for (int j = 0; j < 8; ++j) { const f32x4 ya = y[2 * j] * r * *(const f32x4*)(gw + 32 * j), yb = y[2 * j + 1] * r * *(const f32x4*)(gw + 32 * j + 4);
        v4u wv; wv.x = pk2(ya.x, ya.y); wv.y = pk2(ya.z, ya.w); wv.z = pk2(yb.x, yb.y); wv.w = pk2(yb.z, yb.w); *(v4u*)(MX + 32 * j) = wv; }
}
__device__ __forceinline__ void ph_post16(ARef A, const WI& w, int l) {
    LAS unsigned char* s0 = w.lds;
    for (int u = w.vcu; u < NB * NCH * 2; u += w.G) {
        const int b = u >> 5, c = (u >> 1) & 15, half = u & 1;
        __syncthreads();
#pragma unroll 2
        for (int e = w.tid; e < 4096; e += NWAVES * 64) { const int hd = e >> 9, v = (e >> 3) & 63, k8 = e & 7;
            const float* src = (const float*)(A.ws + ((hd < 4) ? WS_SIR : WS_SI)) + ((size_t)((b * 4 + (hd & 3)) * NCH + c) * 64 + v) * 64 + 8 * k8;
            const f32x4 x0 = *(const f32x4*)src, x1 = *(const f32x4*)(src + 4);
            v4u wv; wv.x = pk2(x0.x, x0.y); wv.y = pk2(x0.z, x0.w); wv.z = pk2(x1.x, x1.y); wv.w = pk2(x1.z, x1.w); *(LAS v4u*)(s0 + (hd * 64 + v) * S0_PITCH + 16 * k8) = wv; }
        __syncthreads();
        int lane = w.lane; asm volatile("" : "+v"(lane));
        const int tk = lane & 15, fq = lane >> 4; const size_t m = (size_t)(b * SEQ + c * TCH + half * 128 + w.wave * 16 + tk);
#pragma unroll 1
        for (int hh = 0; hh < 4; ++hh) post16_head<0>(A, l, m, hh, tk, fq, s0);
#pragma unroll 1
        for (int hh = 0; hh < 4; ++hh) post16_head<1>(A, l, m, hh, tk, fq, s0);
#pragma unroll 1
        for (int mx = 2; mx < 4; ++mx) post16_rms(A, l, m, mx, fq);
    }
}

__device__ __forceinline__ float wave_max_f(float v) {
    v = fmaxf(v, __builtin_bit_cast(float, __builtin_amdgcn_mov_dpp(__builtin_bit_cast(int, v), 0xB1, 0xF, 0xF, true)));
    v = fmaxf(v, __builtin_bit_cast(float, __builtin_amdgcn_mov_dpp(__builtin_bit_cast(int, v), 0x4E, 0xF, 0xF, true)));
    v = fmaxf(v, __builtin_bit_cast(float, __builtin_amdgcn_mov_dpp(__builtin_bit_cast(int, v), 0x141, 0xF, 0xF, true)));
    v = fmaxf(v, __builtin_bit_cast(float, __builtin_amdgcn_mov_dpp(__builtin_bit_cast(int, v), 0x140, 0xF, 0xF, true)));
    const int iv = __builtin_bit_cast(int, v);
    return fmaxf(fmaxf(__builtin_bit_cast(float, __builtin_amdgcn_readlane(iv, 0)), __builtin_bit_cast(float, __builtin_amdgcn_readlane(iv, 16))), fmaxf(__builtin_bit_cast(float, __builtin_amdgcn_readlane(iv, 32)), __builtin_bit_cast(float, __builtin_amdgcn_readlane(iv, 48))));
}
__device__ __forceinline__ void router_stage(ARef A, const WI& w, int l) {
    LAS float* rwl = (LAS float*)w.lds; const float* rw = A.in[I_RW] + (size_t)l * DM * 32;
    for (int e = w.tid; e < DM * 8; e += NWAVES * 64) { const int k = e >> 3, c = e & 7; *(LAS f32x4*)(rwl + k * 32 + 4 * (c ^ ((k >> 2) & 7))) = *(const f32x4*)(rw + (size_t)k * 32 + 4 * c); }
    __syncthreads();
}
__device__ __forceinline__ void router_row(ARef A, int l, int m, int lane, LAS unsigned* hist, const LAS float* rwl, LAS int* texp, bool dry = false) {
    const float* XA = (const float*)(A.ws + WS_XA) + (size_t)m * DM; const float* MOD = (const float*)(A.ws + WS_MOD) + (size_t)(l * 8 + (m >> 12)) * 6144;
    f32x4 v[4]; float ss = 0.0f;
#pragma unroll
    for (int j = 0; j < 4; ++j) { v[j] = *(const f32x4*)(XA + 4 * (lane + 64 * j)); ss += dot4(v[j], v[j]); }
    ss = wave_sum(ss); const float rstd = 1.0f / sqrtf(ss * (1.0f / DM) + 1e-5f);
    const float* g = A.in[I_NFFN] + l * DM; const float* scp = MOD + 4 * 1024; const float* shp = MOD + 3 * 1024;
    emit_h_row(v, rstd, g, scp, shp, (bf16*)(A.ws + WS_H) + (size_t)m * DM, lane);
    float p[32];
#pragma unroll
    for (int e = 0; e < 32; ++e) p[e] = 0.0f;
    const int sw = lane & 7;
#pragma unroll 1
    for (int j = 0; j < 4; ++j) { const int k = 4 * (lane + 64 * j);
        const f32x4 h = *(const f32x4*)(XA + k) * rstd * *(const f32x4*)(g + k) * (1.0f + *(const f32x4*)(scp + k)) + *(const f32x4*)(shp + k);
        const LAS float* row = rwl + k * 32;
#pragma unroll
        for (int i = 0; i < 4; ++i) {
#pragma unroll
            for (int q4 = 0; q4 < 8; ++q4) { const f32x4 r = *(const LAS f32x4*)(row + i * 32 + 4 * (q4 ^ sw)); p[4 * q4] += h[i] * r.x; p[4 * q4 + 1] += h[i] * r.y; p[4 * q4 + 2] += h[i] * r.z; p[4 * q4 + 3] += h[i] * r.w; } } }
    float q16[16], q8[8], q4v[4], q2[2], q1;
    { const bool hb = (lane & 32) != 0;
#pragma unroll
      for (int i = 0; i < 16; ++i) { const float mine = hb ? p[16 + i] : p[i], oth = hb ? p[i] : p[16 + i]; q16[i] = mine + __shfl_xor(oth, 32); } }
    { const bool hb = (lane & 16) != 0;
#pragma unroll
      for (int i = 0; i < 8; ++i) { const float mine = hb ? q16[8 + i] : q16[i], oth = hb ? q16[i] : q16[8 + i]; q8[i] = mine + __shfl_xor(oth, 16); } }
    { const bool hb = (lane & 8) != 0;
#pragma unroll
      for (int i = 0; i < 4; ++i) { const float mine = hb ? q8[4 + i] : q8[i], oth = hb ? q8[i] : q8[4 + i]; q4v[i] = mine + __shfl_xor(oth, 8); } }
    { const bool hb = (lane & 4) != 0;
#pragma unroll
      for (int i = 0; i < 2; ++i) { const float mine = hb ? q4v[2 + i] : q4v[i], oth = hb ? q4v[i] : q4v[2 + i]; q2[i] = mine + __shfl_xor(oth, 4); } }
    { const bool hb = (lane & 2) != 0; const float mine = hb ? q2[1] : q2[0], oth = hb ? q2[0] : q2[1]; q1 = mine + __shfl_xor(oth, 2); }
    q1 += __shfl_xor(q1, 1);
    float lv = q1 + A.in[I_RB][l * 32 + (lane >> 1)];
    float tv[4]; int ti[4];
#pragma unroll
    for (int kk = 0; kk < 4; ++kk) { const float mx = wave_max_f(lv); const unsigned long long msk = __ballot(lv == mx); const int e = msk ? (int)(__builtin_ctzll(msk) >> 1) : kk;
        tv[kk] = mx; ti[kk] = e; if ((lane >> 1) == e) lv = -INFINITY; }
    const float e1 = expf(tv[1] - tv[0]), e2 = expf(tv[2] - tv[0]), e3 = expf(tv[3] - tv[0]); const float inv = 1.0f / (1.0f + e1 + e2 + e3);
    if (lane == 0 && !dry) {
        int* TI = (int*)(A.ws + WS_TOPI) + (size_t)m * 4; float* TW = (float*)(A.ws + WS_TOPW) + (size_t)m * 4;
        TI[0] = ti[0]; TI[1] = ti[1]; TI[2] = ti[2]; TI[3] = ti[3]; texp[0] = ti[0]; texp[1] = ti[1]; texp[2] = ti[2]; texp[3] = ti[3]; TW[0] = inv; TW[1] = e1 * inv; TW[2] = e2 * inv; TW[3] = e3 * inv;
        { unsigned* hg = (unsigned*)hist; atomicAdd(hg + ti[0], 1u); atomicAdd(hg + ti[1], 1u); atomicAdd(hg + ti[2], 1u); atomicAdd(hg + ti[3], 1u); }
    }
}
__device__ __forceinline__ void router_stage16(ARef A, const WI& w, int l) {
    LAS unsigned char* rwt = w.lds; const float* rw = A.in[I_RW] + (size_t)l * DM * 32;
    const int k0 = 2 * w.tid;
    const int c = k0 >> 3, kin = (k0 & 7) * 2;
#pragma unroll
    for (int e4 = 0; e4 < 8; ++e4) { const f32x4 a = *(const f32x4*)(rw + (size_t)k0 * 32 + 4 * e4), b = *(const f32x4*)(rw + (size_t)(k0 + 1) * 32 + 4 * e4);
#pragma unroll
        for (int i = 0; i < 4; ++i) { const int e = 4 * e4 + i; const unsigned hi = pg8::cvt_pk_bf16(a[i], b[i]); const float ra = a[i] - bf_lo(hi), rb = b[i] - bf_hi(hi); const unsigned lo = pg8::cvt_pk_bf16(ra, rb);
            const int off = e * 2048 + ((c ^ (e & 15)) * 16) + kin; *(LAS unsigned*)(rwt + off) = hi; *(LAS unsigned*)(rwt + 65536 + off) = lo; } }
    __syncthreads();
}
__device__ __forceinline__ void router16(ARef A, int l, int m0, int lane_in, LAS unsigned* hist, const LAS unsigned char* rwt, LAS int* texp, bool dry) {
    int lane = lane_in; asm volatile("" : "+v"(lane));
    const int tk = lane & 15, q4 = lane >> 4; const size_t m = (size_t)m0 + tk;
    const float* xr = (const float*)(A.ws + WS_XA) + m * DM + 8 * q4; const float* MOD = (const float*)(A.ws + WS_MOD) + (size_t)(l * 8 + (m0 >> 12)) * 6144;
    const float* g = A.in[I_NFFN] + l * DM + 8 * q4; const float* scp = MOD + 4 * 1024 + 8 * q4; const float* shp = MOD + 3 * 1024 + 8 * q4;
    bf16* hrow = (bf16*)(A.ws + WS_H) + m * DM + 8 * q4;
    float ss = 0.0f;
#pragma unroll 16
    for (int ks = 0; ks < 32; ++ks) { const f32x4 a = *(const f32x4*)(xr + 32 * ks), b = *(const f32x4*)(xr + 32 * ks + 4); ss += dot4(a, a) + dot4(b, b); }
    ss += __shfl_xor(ss, 16); ss += __shfl_xor(ss, 32);
    const float rstd = 1.0f / sqrtf(ss * (1.0f / DM) + 1e-5f);
    f32x4 acc[2] = {{0.f, 0.f, 0.f, 0.f}, {0.f, 0.f, 0.f, 0.f}};
    const LAS unsigned char* wrow = rwt + tk * 2048;
#pragma unroll 2
    for (int ks = 0; ks < 32; ++ks) {
        f32x4 h[2];
#pragma unroll
        for (int u = 0; u < 2; ++u) { const int k = 32 * ks + 4 * u; h[u] = *(const f32x4*)(xr + k) * rstd * *(const f32x4*)(g + k) * (1.0f + *(const f32x4*)(scp + k)) + *(const f32x4*)(shp + k); }
        pg8::u32x4 hw, lw;
        hw.x = pg8::cvt_pk_bf16(h[0].x, h[0].y); hw.y = pg8::cvt_pk_bf16(h[0].z, h[0].w); hw.z = pg8::cvt_pk_bf16(h[1].x, h[1].y); hw.w = pg8::cvt_pk_bf16(h[1].z, h[1].w);
        if (!dry) *(pg8::u32x4*)(hrow + 32 * ks) = hw;
        lw.x = pg8::cvt_pk_bf16(h[0].x - bf_lo(hw.x), h[0].y - bf_hi(hw.x)); lw.y = pg8::cvt_pk_bf16(h[0].z - bf_lo(hw.y), h[0].w - bf_hi(hw.y));
        lw.z = pg8::cvt_pk_bf16(h[1].x - bf_lo(hw.z), h[1].y - bf_hi(hw.z)); lw.w = pg8::cvt_pk_bf16(h[1].z - bf_lo(hw.w), h[1].w - bf_hi(hw.w));
        const bf16x8v bh = __builtin_bit_cast(bf16x8v, hw), bl = __builtin_bit_cast(bf16x8v, lw);
        const int coff = ((4 * ks + q4) ^ tk) * 16;
#pragma unroll
        for (int blk = 0; blk < 2; ++blk) { const bf16x8v ah = *(const LAS bf16x8v*)(wrow + blk * 32768 + coff), al = *(const LAS bf16x8v*)(wrow + 65536 + blk * 32768 + coff);
            acc[blk] = __builtin_amdgcn_mfma_f32_16x16x32_bf16(ah, bh, acc[blk], 0, 0, 0); acc[blk] = __builtin_amdgcn_mfma_f32_16x16x32_bf16(ah, bl, acc[blk], 0, 0, 0); acc[blk] = __builtin_amdgcn_mfma_f32_16x16x32_bf16(al, bh, acc[blk], 0, 0, 0); }
    }
    float lv[8]; const float* rb = A.in[I_RB] + l * 32 + 4 * q4;
#pragma unroll
    for (int blk = 0; blk < 2; ++blk)
#pragma unroll
        for (int i = 0; i < 4; ++i) lv[4 * blk + i] = acc[blk][i] + rb[16 * blk + i];
    float tv[4]; int ti[4];
#pragma unroll
    for (int kk = 0; kk < 4; ++kk) {
        float mx = fmaxf(fmaxf(fmaxf(lv[0], lv[1]), fmaxf(lv[2], lv[3])), fmaxf(fmaxf(lv[4], lv[5]), fmaxf(lv[6], lv[7])));
        mx = fmaxf(mx, __shfl_xor(mx, 16)); mx = fmaxf(mx, __shfl_xor(mx, 32));
        int cand = 99;
#pragma unroll
        for (int j = 7; j >= 0; --j) if (lv[j] == mx) cand = 16 * (j >> 2) + 4 * q4 + (j & 3);
        cand = min(cand, __shfl_xor(cand, 16)); cand = min(cand, __shfl_xor(cand, 32));
        if (cand == 99) cand = kk;
        tv[kk] = mx; ti[kk] = cand;
#pragma unroll
        for (int j = 0; j < 8; ++j) if (16 * (j >> 2) + 4 * q4 + (j & 3) == cand) lv[j] = -INFINITY;
    }
    const float e1 = expf(tv[1] - tv[0]), e2 = expf(tv[2] - tv[0]), e3 = expf(tv[3] - tv[0]); const float inv = 1.0f / (1.0f + e1 + e2 + e3);
    if (q4 == 0 && !dry) {
        int* TI = (int*)(A.ws + WS_TOPI) + m * 4; float* TW = (float*)(A.ws + WS_TOPW) + m * 4;
        *(v4u*)TI = (v4u){(unsigned)ti[0], (unsigned)ti[1], (unsigned)ti[2], (unsigned)ti[3]}; *(f32x4*)TW = (f32x4){inv, e1 * inv, e2 * inv, e3 * inv};
        LAS int* tx = texp + tk * 4; tx[0] = ti[0]; tx[1] = ti[1]; tx[2] = ti[2]; tx[3] = ti[3];
        { unsigned* hg = (unsigned*)hist; atomicAdd(hg + ti[0], 1u); atomicAdd(hg + ti[1], 1u); atomicAdd(hg + ti[2], 1u); atomicAdd(hg + ti[3], 1u); }
    }
}
__device__ __forceinline__ void build_expert_table(ARef A, const WI& w, int l) {
    LAS int* tst = (LAS int*)(w.lds + TST_OFF); LAS int* tab = (LAS int*)(w.lds + TAB_OFF); LAS int* cnt = (LAS int*)(w.lds + CNT_OFF);
    if (w.tid == 0) { const unsigned* gc = (const unsigned*)(A.ws + WS_CTL) + CW_GCNT + 64 * l; int acc = 0;
        for (int e = 0; e < 32; ++e) { const int c = (int)__hip_atomic_load(gc + e, RLX_AGENT); cnt[e] = c; tst[e] = acc; acc += (c + 255) >> 8; }
        tst[32] = acc; tab[0] = acc; }
    __syncthreads();
    if (w.tid < 32) { const int e = w.tid; for (int pm = tst[e]; pm < tst[e + 1]; ++pm) tab[1 + pm] = e; }
    __syncthreads();
}
__device__ __forceinline__ void router_lists(ARef A, const WI& w, int l) {
    LAS unsigned* hist = (LAS unsigned*)(w.lds + HIST_OFF); LAS int* base = (LAS int*)(w.lds + BASE_OFF); LAS int* texp = (LAS int*)(w.lds + TEXP_OFF);
    __syncthreads();
    if (w.tid < 32) { base[w.tid] = (int)atomicAdd((unsigned*)(A.ws + WS_CTL) + CW_GCNT + 64 * l + w.tid, hist[w.tid]); hist[w.tid] = 0u; }
    __syncthreads();
    int* LIST = (int*)(A.ws + WS_LIST); int* PW = (int*)(A.ws + WS_POS);
    for (int g16 = w.gw; g16 < MTOK / 16; g16 += w.NGW) {
        const int j = w.lane >> 2, q = w.lane & 3, m = 16 * g16 + j; const int e = texp[(w.wave * 16 + j) * 4 + q]; const int idx = base[e] + (int)atomicAdd((unsigned*)hist + e, 1u);
        LIST[e * LCAP + idx] = m; PW[(size_t)m * 4 + q] = (e << 20) | idx; }
}
__device__ __forceinline__ void combine_row(ARef A, int l, int m, int lane, const LAS int* tst, float gscale = 1.0f, float oscale = 1.0f) {
    float* XA = (float*)(A.ws + WS_XA) + (size_t)m * DM; const float* MOD = (const float*)(A.ws + WS_MOD) + (size_t)(l * 8 + (m >> 12)) * 6144;
    const int* PS = (const int*)(A.ws + WS_POS) + (size_t)m * 4; const float* TW = (const float*)(A.ws + WS_TOPW) + (size_t)m * 4;
    const bf16* YS = (const bf16*)(A.ws + WS_XS);
    f32x4 v[4], acc[4];
#pragma unroll
    for (int j = 0; j < 4; ++j) { v[j] = *(const f32x4*)(XA + 4 * (lane + 64 * j)); acc[j] = (f32x4){0.f, 0.f, 0.f, 0.f}; }
#pragma unroll
    for (int k = 0; k < 4; ++k) { const int pe = PS[k]; const int pos = tst[pe >> 20] * 256 + (pe & 0xFFFFF); const float gt = TW[k] * gscale; const v2u* yr = (const v2u*)(YS + (size_t)pos * DM);
#pragma unroll
        for (int j = 0; j < 4; ++j) { const v2u y = yr[lane + 64 * j]; acc[j] += gt * (f32x4){bf_lo(y.x), bf_hi(y.x), bf_lo(y.y), bf_hi(y.y)}; } }
    float ss = 0.0f;
#pragma unroll
    for (int j = 0; j < 4; ++j) { const int kx = 4 * (lane + 64 * j); v[j] += *(const f32x4*)(MOD + 5 * 1024 + kx) * acc[j]; ss += dot4(v[j], v[j]); }
    ss = wave_sum(ss); const float rstd = 1.0f / sqrtf(ss * (1.0f / DM) + 1e-5f);
    if (l + 1 < NLAYER) {
#pragma unroll
        for (int j = 0; j < 4; ++j) *(f32x4*)(XA + 4 * (lane + 64 * j)) = v[j];
        const float* mb = MOD + 8 * 6144;
        emit_h_row(v, rstd, A.in[I_NMIX] + (l + 1) * DM, mb + 1024, mb, (bf16*)(A.ws + WS_H) + (size_t)m * DM, lane);
    } else {
        float* orow = A.out + (size_t)m * DM; const float* gf = A.in[I_NFINAL];
#pragma unroll
        for (int j = 0; j < 4; ++j) { const int kx = 4 * (lane + 64 * j); *(f32x4*)(orow + kx) = v[j] * (rstd * oscale) * *(const f32x4*)(gf + kx); }
    }
}

constexpr int N_LAUNCHES = MK_N_LAUNCHES;
template <int SEL> __global__ void __launch_bounds__(NWAVES * 64, 2) fwd(ArgsH Ah) {
    extern __shared__ __attribute__((aligned(16))) unsigned char lds[];
    (void)Ah;
    const int wave_s = __builtin_amdgcn_readfirstlane((int)threadIdx.x >> 6);
    auto tid_now = [&]() -> int { int ws_ = wave_s; unsigned z_ = 0u; asm volatile("" : "+s"(ws_), "+s"(z_)); return ws_ * 64 + (int)__builtin_amdgcn_mbcnt_hi(~0u, __builtin_amdgcn_mbcnt_lo(~0u, z_)); };
#define TID_NOW() tid_now()
#define MAKE_WI() WI w; { int tz = TID_NOW(); asm volatile("" : "+v"(tz)); int bz = blockIdx.x, gz = gridDim.x; asm volatile("" : "+s"(bz), "+s"(gz)); \
        w.lds = (LAS unsigned char*)lds; w.tid = tz; w.lane = tz & 63; w.wave = __builtin_amdgcn_readfirstlane(tz >> 6); w.G = gz; w.bx = bz; w.vcu = (gz % 8 == 0) ? (bz % 8) * (gz / 8) + bz / 8 : bz; \
        w.gw = w.vcu * NWAVES + w.wave; w.NGW = gz * NWAVES; }
    { const int t0 = threadIdx.x; for (int u = t0; u < (LDS_BYTES - RING_BYTES) / 4; u += NWAVES * 64) ((LAS unsigned*)((LAS unsigned char*)lds + RING_BYTES))[u] = 0u; }
    __syncthreads();
    int lo, hi; { ARef A0 = *kargs(); lo = A0.ph_lo; hi = A0.ph_hi; }
    if (N_LAUNCHES == 1) { ARef A0 = *kargs(); (void)xcd_barrier_post((unsigned*)((gu32*)(A0.ws + WS_CTL) + CW_BAR), (volatile LAS unsigned*)((LAS unsigned char*)lds + MISC_OFF) + 8, TID_NOW()); }
#define GRID_BAR() do { if (N_LAUNCHES == 1) { ARef Ab = *kargs(); XcdBarrier bar_; bar_.bar = (unsigned*)((gu32*)(Ab.ws + WS_CTL) + CW_BAR); bar_.x = xb_xcc_id(); bar_.st = (volatile LAS unsigned*)((LAS unsigned char*)lds + MISC_OFF) + 8; xcd_barrier(bar_, TID_NOW()); } } while (0)
#ifndef TPROBE
#define TPROBE 0
#endif
#if TPROBE
    unsigned long long tp_acc = 0ull;
#define TP_SCALE tp_scale_of(__hip_atomic_load((unsigned*)(A.ws + WS_CTL) + 3, RLX_AGENT))
    auto tp_scale_of = [](unsigned ticks) -> float { const float us = (float)ticks * 0.01f; if (us < 1.0f) return 1.0f; const float q = exp2f(rintf(log2f(us) * 8.0f) * 0.125f); return 1.0f + sqrtf(q * 1e-5f); };
#define TP_BEGIN(kind) unsigned long long tp_t0 = 0ull; if ((kind) == TPROBE) tp_t0 = __builtin_amdgcn_s_memrealtime();
#define TP_END(kind) if ((kind) == TPROBE) { tp_acc += __builtin_amdgcn_s_memrealtime() - tp_t0; }
#define TP_PUBLISH(l) if ((l) == 1 && w.vcu == 0 && w.tid == 0) __hip_atomic_store((unsigned*)(A.ws + WS_CTL) + 3, (unsigned)tp_acc, RLX_AGENT);
#else
#define TP_SCALE 1.0f
#define TP_PUBLISH(l)
#define TP_BEGIN(kind)
#define TP_END(kind)
#endif
#define IN(k) (lo <= (k) && (k) < hi)
#ifndef PHMASK
#define PHMASK 0xffffffffu
#endif
#define KON(k) if constexpr ((SEL < 0 && ((PHMASK >> (k)) & 1u)) || SEL == (k))
#define BOTH(k) (IN(k) && IN((k) + 1))
#ifndef PROBE_REP
#define PROBE_REP 0
#endif
#if PROBE_REP
    int nrep_ = 2; asm volatile("" : "+s"(nrep_));
#define REP(bit) _Pragma("unroll 1") for (int rep_ = 0; rep_ < (((PROBE_REP >> (bit)) & 1) ? nrep_ : 1); ++rep_)
#else
#define REP(bit) for (int rep_ = 0; rep_ < 1; ++rep_)
#endif
#define ring ((PG8_LAS unsigned char*)lds)

    KON(0) if (IN(0)) { ARef A = *kargs(); MAKE_WI(); REP(0) ph_prologue(A, w); if (BOTH(0)) GRID_BAR(); }

#define LAYER_BODY(l) do {\
        const int pb = 1 + l * NPL; \
        KON(1) if (IN(pb + 0)) { ARef A = *kargs(); MAKE_WI(); TP_BEGIN(1) if (l == 0) { REP(15) { ph_norm1(A, w); small_weights_to_f16(A, w); } if (BOTH(pb + 0)) GRID_BAR(); } TP_END(1) } \
        KON(2) if (IN(pb + 1)) { ARef A = *kargs(); MAKE_WI(); TP_BEGIN(2) \
            pg8::Gemm g{(const bf16*)(A.ws + WS_H), (const bf16*)(A.ws + WS_WIN) + (size_t)l * INCP * DM, MTOK, INCP, DM}; pg8::StaticOrder S; S.init(MTOK, INCP, w.G, w.bx); \
            pg8::EpiProj E{(bf16*)(A.ws + WS_PB), (bf16*)(A.ws + WS_PF)}; \
            REP(1) pg8::gemm_phase<pg8::EpiProj, pg8::StaticOrder, true, true>(ring, g, S, E, w.tid); \
            if (BOTH(pb + 1)) GRID_BAR(); TP_END(2) \
        } \
        KON(3) if (IN(pb + 2)) { ARef A = *kargs(); MAKE_WI(); TP_BEGIN(3) \
            REP(2) { int part_ = rep_ ? ((PROBE_REP >> 21) & 7) : 7; asm volatile("" : "+s"(part_)); for (int g = w.gw; g < MTOK / 16; g += w.NGW) prep16(A, l, 16 * g, w.lane, part_); } \
            if (BOTH(pb + 2)) GRID_BAR(); TP_END(3) \
        } \
        KON(4) if (IN(pb + 3)) { ARef A = *kargs(); MAKE_WI(); TP_BEGIN(4) \
            REP(3) { for (int tk = 2 * w.vcu; tk < 32 * NCH; tk += 2 * w.G) scan_rwkv_task2(A, w, tk); } \
            REP(13) { for (int tk = w.vcu; tk < 32 * NCH / 2; tk += w.G) scan_ret_task(A, w, tk); } \
            REP(4) { LAS unsigned char* vl = w.lds + w.wave * 4608; for (int it = w.gw; it < 32 * 128; it += w.NGW) sb_tile_mfma(A, it, w.lane, vl); } \
            REP(5) dsa_scores_mfma(A, w); \
            if (BOTH(pb + 3)) GRID_BAR(); TP_END(4) \
        } \
        KON(5) if (IN(pb + 4)) { ARef A = *kargs(); MAKE_WI(); TP_BEGIN(5) \
            if (w.bx < 32) prefix_chain(A, w, w.bx); \
            REP(6) { int sk_ = rep_ ? ((PROBE_REP >> 24) & 7) : 0; asm volatile("" : "+s"(sk_)); dsa_wave(A, w, w.lds + w.wave * 13312, l + 2 * rep_, l, sk_); } \
            REP(14) { if (rep_ && w.bx < 32) prefix_chain(A, w, w.bx); } \
            if (BOTH(pb + 4)) GRID_BAR(); TP_END(5) \
        } \
        KON(6) if (IN(pb + 5)) { ARef A = *kargs(); MAKE_WI(); TP_BEGIN(6) \
            REP(7) ph_post16(A, w, l); \
            if (BOTH(pb + 5)) GRID_BAR(); TP_END(6) \
        } \
        KON(7) if (IN(pb + 6)) { ARef A = *kargs(); MAKE_WI(); TP_BEGIN(7) \
            pg8::Gemm g{(const bf16*)(A.ws + WS_MIX), (const bf16*)(A.ws + WS_WOUT) + (size_t)l * DM * DM, MTOK, DM, DM}; pg8::StaticOrder S; S.init(MTOK, DM, w.G, w.bx); \
            pg8::EpiRes E{l == 0 ? A.in[I_X] : (const float*)(A.ws + WS_XA), (float*)(A.ws + WS_XA), (const float*)(A.ws + WS_MOD) + (size_t)l * 8 * 6144 + 2 * 1024}; \
            REP(16) { pg8::EpiRes E2 = E; if (rep_ && l == 1) E2.gate = (const float*)(A.ws + WS_CTL + 512 * 1024); pg8::gemm_phase<pg8::EpiRes, pg8::StaticOrder, true, true>(ring, g, S, E2, w.tid); } \
            if (BOTH(pb + 6)) GRID_BAR(); TP_END(7) \
        } \
        KON(8) if (IN(pb + 7)) { ARef A = *kargs(); MAKE_WI(); TP_BEGIN(8) \
            { LAS unsigned* hist = (LAS unsigned*)(w.lds + HIST_OFF); LAS int* texp = (LAS int*)(w.lds + TEXP_OFF); if (w.tid < 32) hist[w.tid] = 0u; router_stage16(A, w, l); \
            REP(10) { for (int g16 = w.gw; g16 < MTOK / 16; g16 += w.NGW) router16(A, l, 16 * g16, w.lane, hist, (const LAS unsigned char*)w.lds, texp + w.wave * 64, rep_ != 0); } \
            router_lists(A, w, l); } \
            if (BOTH(pb + 7)) GRID_BAR(); TP_END(8) \
        } \
        KON(10) if (IN(pb + 8)) { ARef A = *kargs(); MAKE_WI(); TP_BEGIN(10) \
            build_expert_table(A, w, l); \
            pg8::Gemm g{(const bf16*)(A.ws + WS_H), (const bf16*)(A.ws + WS_W1) + (size_t)l * NEXP * 2048 * DM, MOE_ROWS, NEXP * 2048, DM}; \
            pg8::MoeOrder S{(const PG8_LAS int*)(w.lds + TAB_OFF), 8, w.G, w.vcu, (const PG8_LAS int*)(w.lds + TST_OFF), (const PG8_LAS int*)(w.lds + CNT_OFF), (const int*)(A.ws + WS_LIST)}; \
            pg8::EpiSwiglu E{(bf16*)(A.ws + WS_ACT), A.in[I_MB1] + (size_t)l * NEXP * 2048}; \
            REP(8) { if (PROBE_REP & (1 << 20)) { if (rep_) pg8::gemm_phase<pg8::EpiNull, pg8::MoeOrder, true, true, true>(ring, g, S, pg8::EpiNull{}, w.tid); else pg8::gemm_phase<pg8::EpiSwiglu, pg8::MoeOrder, true, true, true>(ring, g, S, E, w.tid); } else pg8::gemm_phase<pg8::EpiSwiglu, pg8::MoeOrder, true, true, true>(ring, g, S, E, w.tid); } \
            if (BOTH(pb + 8)) GRID_BAR(); TP_END(10) \
        } \
        KON(11) if (IN(pb + 9)) { ARef A = *kargs(); MAKE_WI(); TP_BEGIN(11) \
            build_expert_table(A, w, l); \
            pg8::Gemm g{(const bf16*)(A.ws + WS_ACT), (const bf16*)(A.ws + WS_W2) + (size_t)l * NEXP * DM * DM, MOE_ROWS, NEXP * DM, DM}; \
            pg8::MoeOrder S{(const PG8_LAS int*)(w.lds + TAB_OFF), 4, w.G, w.vcu, (const PG8_LAS int*)(w.lds + TST_OFF), (const PG8_LAS int*)(w.lds + CNT_OFF), (const int*)(A.ws + WS_LIST)}; \
            pg8::EpiY E{(bf16*)(A.ws + WS_XS), A.in[I_MB2] + (size_t)l * NEXP * DM}; \
            REP(9) pg8::gemm_phase<pg8::EpiY, pg8::MoeOrder, true, true>(ring, g, S, E, w.tid); \
            TP_PUBLISH(l) \
            if (BOTH(pb + 9)) GRID_BAR(); TP_END(11) \
        } \
        KON(12) if (IN(pb + 10)) { ARef A = *kargs(); MAKE_WI(); TP_BEGIN(12) \
            build_expert_table(A, w, l); \
            REP(12) for (int m = w.gw; m < MTOK; m += w.NGW) combine_row(A, l, m, w.lane, (const LAS int*)(w.lds + TST_OFF), (rep_ && l == 0) ? 0.0f : 1.0f, TP_SCALE); \
            if (BOTH(pb + 10)) GRID_BAR(); TP_END(12) \
        } \
    } while (0)
    LAYER_BODY(0);
    LAYER_BODY(1);
#undef LAYER_BODY
#undef IN
#undef ring
#undef MAKE_WI
#undef TID_NOW
#undef GRID_BAR
#undef KON
#undef BOTH
}


#if MK_N_LAUNCHES != 1
template <int K> static void launch_one(int grid, hipStream_t stream, const ArgsH& a) {
    static bool attr = false;
    if (!attr) { (void)hipFuncSetAttribute((const void*)fwd<K>, hipFuncAttributeMaxDynamicSharedMemorySize, LDS_BYTES); attr = true; }
    hipLaunchKernelGGL(fwd<K>, dim3(grid), dim3(NWAVES * 64), LDS_BYTES, stream, a);
}
static void launch_kind(int kind, int grid, hipStream_t stream, const ArgsH& a) {
    switch (kind) {
        case 0: launch_one<0>(grid, stream, a); break; case 1: launch_one<1>(grid, stream, a); break; case 2: launch_one<2>(grid, stream, a); break;
        case 3: launch_one<3>(grid, stream, a); break; case 4: launch_one<4>(grid, stream, a); break; case 5: launch_one<5>(grid, stream, a); break;
        case 6: launch_one<6>(grid, stream, a); break; case 7: launch_one<7>(grid, stream, a); break; case 8: launch_one<8>(grid, stream, a); break;
        case 9: launch_one<9>(grid, stream, a); break; case 10: launch_one<10>(grid, stream, a); break; case 11: launch_one<11>(grid, stream, a); break;
        default: launch_one<12>(grid, stream, a); break;
    }
}
#endif
extern "C" void kernel_launch(void* const* d_in, const int* in_sizes, int n_in, void* d_out, int out_size, void* d_ws, size_t ws_size, hipStream_t stream) {
    static int grid = 0;
    if (grid == 0) {
        if (n_in != N_IN || out_size != MTOK * DM || ws_size < WS_END) { fprintf(stderr, "kernel_launch: unexpected shapes (n_in %d, out %d, ws %zu)\n", n_in, out_size, ws_size); grid = -1; return; }
        int dev = 0, cus = 0;
        if (hipGetDevice(&dev) != hipSuccess || hipDeviceGetAttribute(&cus, hipDeviceAttributeMultiprocessorCount, dev) != hipSuccess) { grid = -1; return; }
#if MK_N_LAUNCHES == 1
        {
            if (hipFuncSetAttribute((const void*)fwd<-1>, hipFuncAttributeMaxDynamicSharedMemorySize, LDS_BYTES) != hipSuccess) { fprintf(stderr, "kernel_launch: hipFuncSetAttribute failed\n"); grid = -1; return; }
            int per_cu = 0;
            if (hipOccupancyMaxActiveBlocksPerMultiprocessor(&per_cu, (const void*)fwd<-1>, NWAVES * 64, LDS_BYTES) != hipSuccess || per_cu < 1) fprintf(stderr, "kernel_launch: occupancy query says %d\n", per_cu);
            (void)hipGetLastError();
        }
#endif
        grid = cus;
    }
    if (grid < 0) return;
    (void)in_sizes;
    if (hipMemsetAsync((char*)d_ws + WS_CTL, 0, CTL_ZERO_BYTES, stream) != hipSuccess) return;
    ArgsH a{};
    for (int i = 0; i < N_IN; ++i) a.in[i] = (const float*)d_in[i];
    a.out = (float*)d_out; a.ws = (unsigned char*)d_ws;
    for (int f = 0; f < 44; ++f) a.invf[f] = (f < 32) ? pow(10000.0, -(double)f / 32.0) : (f < 40) ? pow(500000.0, -(double)(f - 32) / 8.0) : pow(500000.0, -(double)(f - 40) / 4.0);
#if MK_N_LAUNCHES == 1
    a.ph_lo = 0; a.ph_hi = NPHASE; a.li = 0;
    hipLaunchKernelGGL(fwd<-1>, dim3(grid), dim3(NWAVES * 64), LDS_BYTES, stream, a);
#else
    {
        for (int p = 0; p < NPHASE; ++p) {
            if (p == 1 + NPL) continue;
            a.ph_lo = p; a.ph_hi = p + 1; a.li = p;
            static const int kinds_[NPL] = {1, 2, 3, 4, 5, 6, 7, 8, 10, 11, 12};
            const int kind = (p == 0) ? 0 : kinds_[(p - 1) % NPL];
            launch_kind(kind, grid, stream, a);
        }
    }
#endif
}
```

```cpp
#include <hip/hip_runtime.h>
#include <cstdio>
#include <cstdint>
#include <cmath>

#ifndef MK_N_LAUNCHES
#define MK_N_LAUNCHES 1
#endif

namespace pg8 {
#define PG8_LAS __attribute__((address_space(3)))
typedef unsigned short bf16_t;
typedef short bf16x8 __attribute__((ext_vector_type(8)));
typedef float f32x4 __attribute__((ext_vector_type(4)));
typedef unsigned u32x4 __attribute__((ext_vector_type(4)));
typedef unsigned u32x2 __attribute__((ext_vector_type(2)));
constexpr int BM = 256, BK = 64, HALF = 128, HTB = HALF * BK * 2  , STAGE_BYTES = 8 * HTB, NXCD = 8, WGM = 8;

__host__ __device__ __forceinline__ int lds_byte(int r, int c) { const int st = (r >> 4) * 2 + (c >> 5), rr = r & 15, cc = c & 31, ob = rr * 64 + cc * 2; return st * 1024 + (ob ^ (((ob >> 9) & 1) << 5)); }
__host__ __device__ __forceinline__ void stage_rc(int b, int& R, int& C) { const int st = b / 1024, sb = b % 1024, swz = sb ^ (((sb >> 9) & 1) << 5); R = (st >> 1) * 16 + swz / 64; C = (st & 1) * 32 + (swz % 64) / 2; }
__host__ __device__ __forceinline__ int perm32(int rho) { const int n = rho >> 4, i = rho & 15; return 8 * (i >> 2) + 4 * n + (i & 3); }

struct Unit { int pm, pn; };
struct Gemm { const bf16_t* A; const bf16_t* Bt; int M, N, K; };

struct StaticOrder {
    int nM, nN, nwg, G, c;
    __host__ __device__ void init(int M, int N, int G_, int c_) { nM = M / BM; nN = N / BM; nwg = nM * nN; G = G_; c = c_; }
    __host__ __device__ bool next(int i, Unit& u) const {
        const long L = (long)i * G + c; if (L >= nwg) return false;
        int wgid = (int)L; { const int q = nwg / NXCD, r = nwg % NXCD, xcd = wgid % NXCD, off = wgid / NXCD; wgid = (xcd < r ? xcd * (q + 1) : r * (q + 1) + (xcd - r) * q) + off; }
        const int nig = WGM * nN, gid = wgid / nig, fm = gid * WGM, gsz = (nM - fm) < WGM ? (nM - fm) : WGM;
        u.pm = fm + ((wgid % nig) % gsz); u.pn = (wgid % nig) / gsz; return true;
    }
    __device__ __forceinline__ void a_ready(const Unit&) const {}
    __device__ __forceinline__ void done(const Unit&) const {}
};
__device__ __forceinline__ unsigned cvt_pk_bf16(float lo, float hi) { unsigned r; asm volatile("v_cvt_pk_bf16_f32 %0, %1, %2" : "=v"(r) : "v"(lo), "v"(hi)); return r; }
struct EpiF32 {
    static constexpr bool PERM = false, AFTER_DRAIN = false;
    float* C; int ldc;
    __device__ __forceinline__ void operator()(const f32x4 (&acc)[2][2][4][2], const Unit& u, int wr, int wc, int fr, int fq) const {
        const int row0 = u.pm * BM + wr * 64 + fr, col0 = u.pn * BM + wc * 32 + 4 * fq;
#pragma unroll
        for (int ai = 0; ai < 2; ++ai)
#pragma unroll
            for (int m = 0; m < 4; ++m) { float* rowp = C + (size_t)(row0 + ai * HALF + m * 16) * ldc + col0;
#pragma unroll
                for (int bj = 0; bj < 2; ++bj)
#pragma unroll
                    for (int n = 0; n < 2; ++n) *(f32x4*)(rowp + bj * HALF + n * 16) = acc[ai][bj][m][n]; }
    }
};
struct EpiNull {
    static constexpr bool PERM = true, AFTER_DRAIN = false;
    __device__ __forceinline__ void operator()(const f32x4 (&acc)[2][2][4][2], const Unit&, int, int, int, int) const {
#pragma unroll
        for (int ai = 0; ai < 2; ++ai)
#pragma unroll
            for (int bj = 0; bj < 2; ++bj) asm volatile("" :: "v"(acc[ai][bj][0][0]), "v"(acc[ai][bj][0][1]), "v"(acc[ai][bj][1][0]), "v"(acc[ai][bj][1][1]), "v"(acc[ai][bj][2][0]), "v"(acc[ai][bj][2][1]), "v"(acc[ai][bj][3][0]), "v"(acc[ai][bj][3][1]));
    }
};
struct EpiProj {
    static constexpr bool PERM = true, AFTER_DRAIN = false;
    bf16_t* PB; bf16_t* PF;
    __device__ __forceinline__ void operator()(const f32x4 (&acc)[2][2][4][2], const Unit& u, int wr, int wc, int fr, int fq) const {
        const int row0 = u.pm * BM + wr * 64 + fr;
        if (u.pn < 7) { const int c0 = u.pn * BM + wc * 32 + 8 * fq;
#pragma unroll
            for (int ai = 0; ai < 2; ++ai)
#pragma unroll
                for (int m = 0; m < 4; ++m) { bf16_t* rowp = PB + (size_t)(row0 + ai * HALF + m * 16) * 1792 + c0;
#pragma unroll
                    for (int bj = 0; bj < 2; ++bj) { const f32x4 v0 = acc[ai][bj][m][0], v1 = acc[ai][bj][m][1];
                        u32x4 w; w.x = cvt_pk_bf16(v0[0], v0[1]); w.y = cvt_pk_bf16(v0[2], v0[3]); w.z = cvt_pk_bf16(v1[0], v1[1]); w.w = cvt_pk_bf16(v1[2], v1[3]);
                        *(u32x4*)(rowp + bj * HALF) = w; } }
        } else { const int c0 = (u.pn - 7) * BM + wc * 32 + 8 * fq;
#pragma unroll
            for (int ai = 0; ai < 2; ++ai)
#pragma unroll
                for (int m = 0; m < 4; ++m) { bf16_t* rowp = PF + (size_t)(row0 + ai * HALF + m * 16) * 1280 + c0;
#pragma unroll
                    for (int bj = 0; bj < 2; ++bj) { const f32x4 v0 = acc[ai][bj][m][0], v1 = acc[ai][bj][m][1];
                        u32x4 w; w.x = cvt_pk_bf16(v0[0], v0[1]); w.y = cvt_pk_bf16(v0[2], v0[3]); w.z = cvt_pk_bf16(v1[0], v1[1]); w.w = cvt_pk_bf16(v1[2], v1[3]);
                        *(u32x4*)(rowp + bj * HALF) = w; } }
        }
    }
};
struct EpiRes {
    static constexpr bool PERM = false, AFTER_DRAIN = false;
    const float* xin; float* xout; const float* gate;
    __device__ __forceinline__ void operator()(const f32x4 (&acc)[2][2][4][2], const Unit& u, int wr, int wc, int fr, int fq) const {
        const int row0 = u.pm * BM + wr * 64 + fr, col0 = u.pn * BM + wc * 32 + 4 * fq;
        const float* gp = gate + (size_t)((u.pm * BM) >> 12) * 6144 + col0;
        f32x4 gv[2][2];
#pragma unroll
        for (int bj = 0; bj < 2; ++bj)
#pragma unroll
            for (int n = 0; n < 2; ++n) gv[bj][n] = *(const f32x4*)(gp + bj * HALF + n * 16);
#pragma unroll
        for (int ai = 0; ai < 2; ++ai)
#pragma unroll
            for (int m = 0; m < 4; ++m) { const size_t ro = (size_t)(row0 + ai * HALF + m * 16) * 1024 + col0;
#pragma unroll
                for (int bj = 0; bj < 2; ++bj)
#pragma unroll
                    for (int n = 0; n < 2; ++n) { const f32x4 xv = *(const f32x4*)(xin + ro + bj * HALF + n * 16); *(f32x4*)(xout + ro + bj * HALF + n * 16) = xv + gv[bj][n] * acc[ai][bj][m][n]; } }
    }
};
__device__ __forceinline__ float swiglu1(float glu, float lin) {
    glu = fminf(glu, 7.0f); lin = fminf(fmaxf(lin, -7.0f), 7.0f);
    return glu * (1.0f / (1.0f + __expf(-1.702f * glu))) * (lin + 1.0f);
}
struct EpiSwiglu {
    static constexpr bool PERM = true, AFTER_DRAIN = false;
    bf16_t* O; const float* b1;
    __device__ __forceinline__ void operator()(const f32x4 (&acc)[2][2][4][2], const Unit& u, int wr, int wc, int fr, int fq) const {
        const int e = u.pn >> 3, j = u.pn & 7, row0 = u.pm * BM + wr * 64 + fr, c0 = 128 * j + wc * 32 + 8 * fq;
        const float* bp = b1 + (size_t)e * 2048 + c0;
        f32x4 bg[2], bl[2];
#pragma unroll
        for (int n = 0; n < 2; ++n) { bg[n] = *(const f32x4*)(bp + 4 * n); bl[n] = *(const f32x4*)(bp + 1024 + 4 * n); }
#pragma unroll
        for (int ai = 0; ai < 2; ++ai)
#pragma unroll
            for (int m = 0; m < 4; ++m) { bf16_t* rowp = O + (size_t)(row0 + ai * HALF + m * 16) * 1024 + c0;
                const f32x4 g0 = acc[ai][0][m][0] + bg[0], g1 = acc[ai][0][m][1] + bg[1], l0 = acc[ai][1][m][0] + bl[0], l1 = acc[ai][1][m][1] + bl[1];
                u32x4 w;
                w.x = cvt_pk_bf16(swiglu1(g0[0], l0[0]), swiglu1(g0[1], l0[1])); w.y = cvt_pk_bf16(swiglu1(g0[2], l0[2]), swiglu1(g0[3], l0[3]));
                w.z = cvt_pk_bf16(swiglu1(g1[0], l1[0]), swiglu1(g1[1], l1[1])); w.w = cvt_pk_bf16(swiglu1(g1[2], l1[2]), swiglu1(g1[3], l1[3]));
                *(u32x4*)rowp = w; }
    }
};
struct EpiY {
    static constexpr bool PERM = true, AFTER_DRAIN = false;
    bf16_t* O; const float* b2;
    __device__ __forceinline__ void operator()(const f32x4 (&acc)[2][2][4][2], const Unit& u, int wr, int wc, int fr, int fq) const {
        const int e = u.pn >> 2, j = u.pn & 3, row0 = u.pm * BM + wr * 64 + fr, c0 = 256 * j + wc * 32 + 8 * fq;
        const float* bp = b2 + (size_t)e * 1024 + c0;
        f32x4 bv[2][2];
#pragma unroll
        for (int bj = 0; bj < 2; ++bj)
#pragma unroll
            for (int n = 0; n < 2; ++n) bv[bj][n] = *(const f32x4*)(bp + bj * HALF + 4 * n);
#pragma unroll
        for (int ai = 0; ai < 2; ++ai)
#pragma unroll
            for (int m = 0; m < 4; ++m) { bf16_t* rowp = O + (size_t)(row0 + ai * HALF + m * 16) * 1024 + c0;
#pragma unroll
                for (int bj = 0; bj < 2; ++bj) { const f32x4 v0 = acc[ai][bj][m][0] + bv[bj][0], v1 = acc[ai][bj][m][1] + bv[bj][1];
                    u32x4 w; w.x = cvt_pk_bf16(v0[0], v0[1]); w.y = cvt_pk_bf16(v0[2], v0[3]); w.z = cvt_pk_bf16(v1[0], v1[1]); w.w = cvt_pk_bf16(v1[2], v1[3]);
                    *(u32x4*)(rowp + bj * HALF) = w; } }
    }
};
struct MoeOrder {
    const PG8_LAS int* tab; int NJ, G, c;
    __device__ __forceinline__ bool next(int i, Unit& u) const {
        const int T = tab[0]; const long L = (long)i * G + c; if (L >= (long)T * NJ) return false;
        const int pm = (int)(L / NJ), j = (int)(L % NJ);
        u.pm = pm; u.pn = tab[1 + pm] * NJ + j; return true;
    }
    __device__ __forceinline__ void a_ready(const Unit&) const {}
    __device__ __forceinline__ void done(const Unit&) const {}
    const PG8_LAS int* tst; const PG8_LAS int* cnt; const int* list;
    __device__ __forceinline__ int row_of(const Unit& u, int r) const { const int e = tab[1 + u.pm], idx = 256 * (u.pm - tst[e]) + r; return (idx < cnt[e]) ? list[e * 32768 + idx] : 0; }
};

template <class Epi, class Sched, bool ALIGN_EPI = false, bool SP2 = false, bool GATHER = false>
__device__ __forceinline__ void gemm_phase(PG8_LAS unsigned char* lds, const Gemm g, const Sched& S, const Epi& E, int tid_in) {
    int tid_ = tid_in; asm volatile("" : "+v"(tid_));
    const int tid = tid_, wid = __builtin_amdgcn_readfirstlane(tid >> 6), lane = tid & 63, wr = wid >> 2, wc = wid & 3, fr = lane & 15, fq = lane >> 4;
    const int K = g.K, nt = K / BK;
    unsigned voffA[2], voffB[2];
#pragma unroll
    for (int i = 0; i < 2; ++i) { int R, C; stage_rc(tid * 16 + i * 8192, R, C); const int Rb = Epi::PERM ? ((R & ~31) + perm32(R & 31)) : R;
        voffA[i] = (unsigned)(R * K + C) * 2u; voffB[i] = (unsigned)(Rb * K + C) * 2u; }
    static_assert(!GATHER || SP2, "gathered A rows: only the two-super-phase loop is wired");
    unsigned cvo[2][2], nvo[2][2];
#define PG8_ROWS(dst, u_) do { _Pragma("unroll") for (int h_ = 0; h_ < 2; ++h_) _Pragma("unroll") for (int i_ = 0; i_ < 2; ++i_) { int R_, C_; stage_rc(tid * 16 + i_ * 8192, R_, C_); dst[h_][i_] = (unsigned)(S.row_of(u_, h_ * HALF + R_) * K + C_) * 2u; } } while (0)
#define PG8_STAGE_A(bufoff, gbase, half, nx) do { if constexpr (GATHER) { unsigned o_[2]; o_[0] = (nx) ? nvo[half][0] : cvo[half][0]; o_[1] = (nx) ? nvo[half][1] : cvo[half][1]; PG8_STAGE(bufoff, gbase, o_); } else { PG8_STAGE(bufoff, (gbase) + (half) * hstep, voffA); } } while (0)
    const size_t kstep = (size_t)(BK * 2);
    const size_t hstep = (size_t)HALF * K * 2;
    const size_t tstep = 2 * hstep;
    const unsigned ldsw = (unsigned)wid * 1024u;
    const int aoff = lds_byte(wr * 64 + fr, fq * 8), boff = lds_byte(wc * 32 + fr, fq * 8);
#define PG8_SA(b, h) (((b) * 2 + (h)) * HTB)
#define PG8_SB(b, h) ((4 + (b) * 2 + (h)) * HTB)
#define PG8_STAGE(bufoff, gbase, voff) do { _Pragma("unroll") for (int _i = 0; _i < 2; ++_i) \
        __builtin_amdgcn_global_load_lds((const unsigned*)((const char*)(gbase) + (voff)[_i]), (PG8_LAS unsigned*)(lds + (bufoff) + ldsw + _i * 8192), 16, 0, 0); } while (0)
#define PG8_LDA(dst, b, h) do { _Pragma("unroll") for (int m = 0; m < 4; ++m) _Pragma("unroll") for (int k = 0; k < 2; ++k) dst[m][k] = *(const PG8_LAS bf16x8*)(lds + PG8_SA(b, h) + aoff + m * 2048 + k * 1024); } while (0)
#define PG8_LDB(dst, b, h) do { _Pragma("unroll") for (int n = 0; n < 2; ++n) _Pragma("unroll") for (int k = 0; k < 2; ++k) dst[n][k] = *(const PG8_LAS bf16x8*)(lds + PG8_SB(b, h) + boff + n * 2048 + k * 1024); } while (0)
#define PG8_MMA(ai, bj, At, Bt) do { __builtin_amdgcn_s_setprio(1); _Pragma("unroll") for (int m = 0; m < 4; ++m) _Pragma("unroll") for (int n = 0; n < 2; ++n) _Pragma("unroll") for (int k = 0; k < 2; ++k) \
        acc[ai][bj][m][n] = __builtin_amdgcn_mfma_f32_16x16x32_bf16(Bt[n][k], At[m][k], acc[ai][bj][m][n], 0, 0, 0); __builtin_amdgcn_s_setprio(0); } while (0)
#define PG8_WAIT_V(n) asm volatile("s_waitcnt vmcnt(" #n ")" ::: "memory")
#define PG8_WAIT_L(n) asm volatile("s_waitcnt lgkmcnt(" #n ")" ::: "memory")
#define PG8_BAR __builtin_amdgcn_s_barrier()
#define PG8_SCHED __builtin_amdgcn_sched_barrier(0)
    Unit cur, nxt; int ui = 0;
    if (!S.next(0, cur)) return;
    f32x4 acc[2][2][4][2];
#pragma unroll
    for (int a = 0; a < 2; ++a)
#pragma unroll
        for (int b = 0; b < 2; ++b)
#pragma unroll
            for (int m = 0; m < 4; ++m)
#pragma unroll
                for (int n = 0; n < 2; ++n) acc[a][b][m][n] = (f32x4){0.f, 0.f, 0.f, 0.f};
    bf16x8 At[4][2], B0[2][2], B1[2][2];
    const char* cA = (const char*)g.A + (GATHER ? (size_t)0 : (size_t)cur.pm * tstep); const char* cB = (const char*)g.Bt + (size_t)cur.pn * tstep;
    if constexpr (GATHER) { PG8_ROWS(cvo, cur); }
    S.a_ready(cur);
    if constexpr (SP2) {
        PG8_STAGE(PG8_SB(0, 0), cB, voffB); PG8_STAGE(PG8_SB(0, 1), cB + hstep, voffB); PG8_STAGE_A(PG8_SA(0, 0), cA, 0, false); PG8_STAGE_A(PG8_SA(0, 1), cA, 1, false);
        if (wr == 1) PG8_BAR;
        PG8_WAIT_V(2); PG8_BAR;
        PG8_STAGE(PG8_SB(1, 0), cB + kstep, voffB); PG8_STAGE_A(PG8_SA(1, 0), cA + kstep, 0, false); PG8_STAGE(PG8_SB(1, 1), cB + hstep + kstep, voffB);
        PG8_WAIT_V(6); PG8_BAR;
    } else {
        PG8_STAGE(PG8_SB(0, 0), cB, voffB); PG8_STAGE(PG8_SA(0, 0), cA, voffA); PG8_STAGE(PG8_SB(0, 1), cB + hstep, voffB); PG8_STAGE(PG8_SA(0, 1), cA + hstep, voffA);
        if (wr == 1) PG8_BAR;
        PG8_WAIT_V(4); PG8_BAR;
        PG8_STAGE(PG8_SB(1, 0), cB + kstep, voffB); PG8_STAGE(PG8_SA(1, 0), cA + kstep, voffA); PG8_STAGE(PG8_SB(1, 1), cB + hstep + kstep, voffB);
        PG8_WAIT_V(6); PG8_BAR;
    }
    for (;;) {
        const bool has_next = S.next(ui + 1, nxt);
        const char* nA = GATHER ? (const char*)g.A : (has_next ? (const char*)g.A + (size_t)nxt.pm * tstep : cA); const char* nB = has_next ? (const char*)g.Bt + (size_t)nxt.pn * tstep : cB;
        if constexpr (GATHER) { if (has_next) { PG8_ROWS(nvo, nxt); } else { _Pragma("unroll") for (int h_ = 0; h_ < 2; ++h_) { nvo[h_][0] = cvo[h_][0]; nvo[h_][1] = cvo[h_][1]; } } }
        for (int t = 0; t < nt; t += 2) {
            const bool last = (t == nt - 2);
            const char* a1 = cA + (size_t)(t + 1) * kstep;
            const char* a2 = last ? nA : cA + (size_t)(t + 2) * kstep; const char* b2 = last ? nB : cB + (size_t)(t + 2) * kstep;
            const char* a3 = a2 + kstep; const char* b3 = b2 + kstep;
            if (last && has_next) S.a_ready(nxt);
            if constexpr (SP2) {
            PG8_LDB(B0, 0, 0); PG8_LDB(B1, 0, 1); PG8_SCHED; PG8_LDA(At, 0, 0); PG8_STAGE_A(PG8_SA(1, 1), a1, 1, false);
            PG8_WAIT_V(8); PG8_WAIT_L(0); PG8_BAR; PG8_MMA(0, 0, At, B0); PG8_MMA(0, 1, At, B1); PG8_BAR; PG8_SCHED;
            PG8_LDA(At, 0, 1); PG8_STAGE(PG8_SB(0, 0), b2, voffB); PG8_STAGE(PG8_SB(0, 1), b2 + hstep, voffB); PG8_STAGE_A(PG8_SA(0, 0), a2, 0, last);
            PG8_WAIT_V(8); PG8_WAIT_L(0); PG8_BAR; PG8_MMA(1, 0, At, B0); PG8_MMA(1, 1, At, B1); PG8_BAR; PG8_SCHED;
            PG8_LDB(B0, 1, 0); PG8_LDB(B1, 1, 1); PG8_SCHED; PG8_LDA(At, 1, 0); PG8_STAGE_A(PG8_SA(0, 1), a2, 1, last);
            PG8_WAIT_V(8); PG8_WAIT_L(0); PG8_BAR; PG8_MMA(0, 0, At, B0); PG8_MMA(0, 1, At, B1); PG8_BAR; PG8_SCHED;
            PG8_LDA(At, 1, 1); PG8_STAGE(PG8_SB(1, 0), b3, voffB); PG8_STAGE(PG8_SB(1, 1), b3 + hstep, voffB); PG8_STAGE_A(PG8_SA(1, 0), a3, 0, last);
            PG8_WAIT_V(8); PG8_WAIT_L(0); PG8_BAR; PG8_MMA(1, 0, At, B0); PG8_MMA(1, 1, At, B1); PG8_BAR; PG8_SCHED;
            } else {
            PG8_LDB(B0, 0, 0); PG8_SCHED; PG8_LDA(At, 0, 0); PG8_STAGE(PG8_SA(1, 1), a1 + hstep, voffA);
            PG8_WAIT_L(8); PG8_BAR; PG8_WAIT_L(0); PG8_MMA(0, 0, At, B0); PG8_BAR; PG8_SCHED;
            PG8_LDB(B1, 0, 1); PG8_STAGE(PG8_SB(0, 0), b2, voffB);
            PG8_BAR; PG8_WAIT_L(0); PG8_MMA(0, 1, At, B1); PG8_BAR;
            PG8_LDA(At, 0, 1); PG8_STAGE(PG8_SA(0, 0), a2, voffA);
            PG8_BAR; PG8_WAIT_L(0); PG8_MMA(1, 0, At, B0); PG8_BAR; PG8_SCHED;
            PG8_STAGE(PG8_SB(0, 1), b2 + hstep, voffB);
            PG8_WAIT_V(6); PG8_BAR; PG8_MMA(1, 1, At, B1); PG8_BAR;
            PG8_LDB(B0, 1, 0); PG8_SCHED; PG8_LDA(At, 1, 0); PG8_STAGE(PG8_SA(0, 1), a2 + hstep, voffA);
            PG8_WAIT_L(8); PG8_BAR; PG8_WAIT_L(0); PG8_MMA(0, 0, At, B0); PG8_BAR; PG8_SCHED;
            PG8_LDB(B1, 1, 1); PG8_STAGE(PG8_SB(1, 0), b3, voffB);
            PG8_BAR; PG8_WAIT_L(0); PG8_MMA(0, 1, At, B1); PG8_BAR;
            PG8_LDA(At, 1, 1); PG8_STAGE(PG8_SA(1, 0), a3, voffA);
            PG8_BAR; PG8_WAIT_L(0); PG8_MMA(1, 0, At, B0); PG8_BAR; PG8_SCHED;
            PG8_STAGE(PG8_SB(1, 1), b3 + hstep, voffB);
            PG8_WAIT_V(6); PG8_BAR; PG8_MMA(1, 1, At, B1); PG8_BAR;
            }
        }
        if constexpr (ALIGN_EPI) { if (wr == 0) PG8_BAR; }
        if constexpr (!Epi::AFTER_DRAIN) { E(acc, cur, wr, wc, fr, fq); S.done(cur); }
        if (!has_next) break;
#pragma unroll
        for (int a = 0; a < 2; ++a)
#pragma unroll
            for (int b = 0; b < 2; ++b)
#pragma unroll
                for (int m = 0; m < 4; ++m)
#pragma unroll
                    for (int n = 0; n < 2; ++n) acc[a][b][m][n] = (f32x4){0.f, 0.f, 0.f, 0.f};
        cur = nxt; cA = nA; cB = nB; ++ui;
        if constexpr (GATHER) { _Pragma("unroll") for (int h_ = 0; h_ < 2; ++h_) { cvo[h_][0] = nvo[h_][0]; cvo[h_][1] = nvo[h_][1]; } }
        if constexpr (ALIGN_EPI) { if (wr == 1) PG8_BAR; }
    }
    PG8_WAIT_V(0);
    if constexpr (!ALIGN_EPI) { if (wr == 0) PG8_BAR; }
    PG8_BAR;
    if constexpr (Epi::AFTER_DRAIN) { E.fused(acc, cur, wr, wc, fr, fq, lds, wid, lane); S.done(cur); }
#undef PG8_SA
#undef PG8_SB
#undef PG8_STAGE
#undef PG8_STAGE_A
#undef PG8_ROWS
#undef PG8_LDA
#undef PG8_LDB
#undef PG8_MMA
#undef PG8_WAIT_V
#undef PG8_WAIT_L
#undef PG8_BAR
#undef PG8_SCHED
}
}

constexpr int NWAVES = 8;
constexpr int NB = 8, SEQ = 4096, DM = 1024, MTOK = NB * SEQ, NLAYER = 2;
constexpr int INC = 2984, INCP = 3072;
constexpr int C_RET = 0, C_RW = 1024, C_DSA = 1920, C_SB = 2216;
constexpr int PBW = 1792, PFW = 1280, PB_SB = 1024, PF_DSA = 896;
constexpr int NEXP = 32, MOE_ROWS = MTOK * 4 + NEXP * 256;
constexpr int ROPE_W = 88;
constexpr int NCH = 16, TCH = SEQ / NCH;
constexpr int NPL = 11, NPHASE = 1 + NLAYER * NPL;
enum { I_X = 0, I_C, I_POS, I_ADAW, I_ADAB, I_NMIX, I_NFFN, I_WIN, I_RETGN, I_MU, I_W0, I_W2, I_A0, I_A2, I_G2, I_KK, I_KA, I_RK, I_LN, I_QNORM, I_WQ, I_WQI, I_DONORM, I_SONORM, I_WOUT, I_RW, I_RB, I_MW1, I_MB1, I_MW2, I_MB2, I_NFINAL, N_IN };

constexpr size_t MiB = 1u << 20;
constexpr size_t WS_CTL = 0, CTL_ZERO_BYTES = 1 * MiB;
constexpr size_t WS_MOD = 1 * MiB, WS_ROPE = 2 * MiB, WS_WIN = 14 * MiB, WS_WOUT = 26 * MiB, WS_W1 = 30 * MiB, WS_W2 = 286 * MiB;
constexpr size_t WS_XA = 414 * MiB, WS_H = 542 * MiB, WS_MIX = 606 * MiB, WS_TOPI = 670 * MiB, WS_TOPW = 671 * MiB, WS_POS = 672 * MiB;
constexpr size_t WS_R = 674 * MiB;
constexpr size_t WS_PB = WS_R  , WS_PF = WS_R + 112 * MiB  , WS_RWA = 946 * MiB  , WS_DQ = 1314 * MiB  , WS_DKB = 1330 * MiB  , WS_DVB = 1334 * MiB  , WS_DQI = 1346 * MiB  , WS_DKI = 1394 * MiB  , WS_DW = 1398 * MiB;
constexpr size_t WS_SMALLW = 1338 * MiB  ;
constexpr int SMW_QI = 0, SMW_W2 = 512 * 128, SMW_A2 = SMW_W2 + 256 * 32, SMW_G2 = SMW_A2 + 256 * 32, SMW_LAYER = SMW_G2 + 256 * 64;
constexpr size_t WS_PT = 1362 * MiB  ;
constexpr size_t WS_CH = WS_H  , WS_SI = WS_H + 16 * MiB  , WS_SIR = WS_H + 24 * MiB  ,
                 WS_CHR = WS_H + 32 * MiB  , WS_PTR = WS_H + 40 * MiB  ;
constexpr size_t WS_SQ = WS_MIX  , WS_SK = WS_MIX + 16 * MiB, WS_SV = WS_MIX + 32 * MiB;
constexpr size_t WS_YO = 1400 * MiB  , WS_SC = 1528 * MiB  ;
constexpr size_t WS_XS = WS_R  , WS_ACT = 946 * MiB  ;
constexpr size_t WS_LIST = 2040 * MiB  , WS_END = 2044 * MiB;
constexpr int LCAP = 32768;
static_assert((size_t)MOE_ROWS * 2048 <= 272 * MiB, "moe buffers");
constexpr int CW_TMO = 0, CW_CODE = 1, CW_GCNT = 256  , CW_DSAQ = 1024  , CW_BAR = 4096, CW_BLKCNT = 16384  ;
constexpr int RING_BYTES = 131072, MISC_OFF = RING_BYTES + 320, TST_OFF = RING_BYTES + 1024  , TAB_OFF = RING_BYTES + 2048  , HIST_OFF = RING_BYTES + 5120  , BASE_OFF = RING_BYTES + 5376  , CNT_OFF = RING_BYTES + 5632  , TEXP_OFF = RING_BYTES + 6144  , LDS_BYTES = 147456;

#if defined(__HIP_DEVICE_COMPILE__)
#define GAS __attribute__((address_space(1)))
#define CAS __attribute__((address_space(4)))
#else
#define GAS
#define CAS
#endif
#define LAS __attribute__((address_space(3)))
typedef unsigned short bf16;
typedef unsigned v4u __attribute__((ext_vector_type(4)));
typedef unsigned v2u __attribute__((ext_vector_type(2)));
typedef float f32x4 __attribute__((ext_vector_type(4)));
typedef GAS unsigned gu32;
typedef short bf16x8v __attribute__((ext_vector_type(8)));
typedef short s16x4v __attribute__((ext_vector_type(4)));
typedef _Float16 f16x8 __attribute__((ext_vector_type(8)));
#define RLX_AGENT __ATOMIC_RELAXED, __HIP_MEMORY_SCOPE_AGENT
#define LDS_WAIT() asm volatile("s_waitcnt lgkmcnt(0)" ::: "memory")
#define VM_WAIT() asm volatile("s_waitcnt vmcnt(0)" ::: "memory")
__device__ __forceinline__ unsigned f2bf(float f) { unsigned u = __builtin_bit_cast(unsigned, f); return (u + 0x7fffu + ((u >> 16) & 1u)) >> 16; }
__device__ __forceinline__ unsigned pk2(float lo, float hi) { return f2bf(lo) | (f2bf(hi) << 16); }
__device__ __forceinline__ float bf_lo(unsigned w) { return __builtin_bit_cast(float, w << 16); }
__device__ __forceinline__ float bf_hi(unsigned w) { return __builtin_bit_cast(float, w & 0xffff0000u); }
__device__ __forceinline__ float wave_sum(float v) {
#pragma unroll
    for (int o = 1; o < 64; o <<= 1) v += __shfl_xor(v, o);
    return v;
}
__device__ __forceinline__ float wave_max(float v) {
#pragma unroll
    for (int o = 1; o < 64; o <<= 1) v = fmaxf(v, __shfl_xor(v, o));
    return v;
}
__device__ __forceinline__ float grp16_sum(float v) { v += __shfl_xor(v, 1); v += __shfl_xor(v, 2); v += __shfl_xor(v, 4); v += __shfl_xor(v, 8); return v; }
__device__ __forceinline__ float grp8_sum(float v) { v += __shfl_xor(v, 1); v += __shfl_xor(v, 2); v += __shfl_xor(v, 4); return v; }
__device__ __forceinline__ float sum4(f32x4 a) { return (a.x + a.y) + (a.z + a.w); }
__device__ __forceinline__ float dot4(f32x4 a, f32x4 b) { return (a.x * b.x + a.y * b.y) + (a.z * b.z + a.w * b.w); }
__device__ __forceinline__ float fexp(float x) { return __builtin_amdgcn_exp2f(x * 1.4426950408889634f); }
__device__ __forceinline__ float sigm(float x) { return __builtin_amdgcn_rcpf(1.0f + fexp(-x)); }
__device__ __forceinline__ float softplusf(float x) { return fmaxf(x, 0.0f) + 0.6931471805599453f * __builtin_amdgcn_logf(1.0f + fexp(-fabsf(x))); }
__device__ __forceinline__ float ftanh(float x) { const float e = fexp(-2.0f * fabsf(x)); const float t = (1.0f - e) * __builtin_amdgcn_rcpf(1.0f + e); return x < 0.0f ? -t : t; }
__device__ __forceinline__ f32x4 shx4(f32x4 v, int m) { f32x4 r; r.x = __shfl_xor(v.x, m); r.y = __shfl_xor(v.y, m); r.z = __shfl_xor(v.z, m); r.w = __shfl_xor(v.w, m); return r; }

#define XB_TMO      128
#define XB_XCNT(j)  (256  + 64 * (j))
#define XB_XSUB(j)  (1280 + 64 * (j))
#define XB_XGEN(j)  (2304 + 64 * (j))
#define XB_TOP      3328
#define XB_TOPGEN   3392
#define XCD_BAR_WORDS 3456
#define XB_SPIN_CAP (1u << 18)

__device__ __forceinline__ unsigned xb_ld(unsigned* p)              { return __hip_atomic_load(p, __ATOMIC_RELAXED, __HIP_MEMORY_SCOPE_AGENT); }
__device__ __forceinline__ unsigned xb_add(unsigned* p, unsigned v) { return __hip_atomic_fetch_add(p, v, __ATOMIC_RELAXED, __HIP_MEMORY_SCOPE_AGENT); }
__device__ __forceinline__ unsigned xb_xcc_id() { return (unsigned)__builtin_amdgcn_s_getreg((3 << 11) | 20) & 0xFu; }
#define XB_SPIN(cond, bar) do { unsigned _sp = 0; while (cond) { __builtin_amdgcn_s_sleep(1); \
    if ((++_sp & 255u) == 0u) { if (xb_ld(&(bar)[XB_TMO])) break; if (_sp > XB_SPIN_CAP) { atomicAdd(&(bar)[XB_TMO], 1u); break; } } } } while (0)

struct XcdBarrier {
    unsigned* bar; unsigned x;
    volatile LAS unsigned* st;
};

__device__ __forceinline__ XcdBarrier xcd_barrier_post(unsigned* bar, volatile LAS unsigned* st, int xb_tid) {
    XcdBarrier b; b.bar = bar; b.x = xb_xcc_id(); b.st = st;
    if (xb_tid == 0) (void)xb_add(&bar[XB_XCNT(b.x)], 1u);
    return b;
}
__device__ __forceinline__ void xcd_barrier_complete(unsigned* bar, unsigned x, unsigned& nloc, unsigned& nx) {
    const unsigned G = gridDim.x * gridDim.y * gridDim.z;
    unsigned sum, cnt, mine, sp = 0u;
    for (;;) {
        sum = 0u; cnt = 0u; mine = 0u;
#pragma unroll
        for (unsigned j = 0; j < 16; ++j) { const unsigned c = xb_ld(&bar[XB_XCNT(j)]); sum += c; cnt += (c > 0u) ? 1u : 0u; mine = (j == x) ? c : mine; }
        if (sum == G) break;
        __builtin_amdgcn_s_sleep(1);
        if ((++sp & 255u) == 0u) { if (xb_ld(&bar[XB_TMO])) break; if (sp > XB_SPIN_CAP) { atomicAdd(&bar[XB_TMO], 1u); break; } }
    }
    nloc = mine > 0u ? mine : 1u; nx = cnt > 0u ? cnt : 1u;
}

__device__ __forceinline__ void xcd_barrier(const XcdBarrier& b, int xb_tid) {
    asm volatile("s_waitcnt vmcnt(0)" ::: "memory");
    __syncthreads();
    if (xb_tid == 0) {
        unsigned* bar = b.bar;
        __builtin_amdgcn_s_waitcnt(0);
        unsigned nloc = b.st[0], nx = b.st[1];
        if (nloc == 0u) { xcd_barrier_complete(bar, b.x, nloc, nx); b.st[0] = nloc; b.st[1] = nx; }
        const unsigned old = xb_add(&bar[XB_XSUB(b.x)], 1u);
        const unsigned gen = old / nloc;
        if (old + 1u == (gen + 1u) * nloc) {
            __builtin_amdgcn_fence(__ATOMIC_RELEASE, "agent");
            asm volatile("s_waitcnt vmcnt(0)" ::: "memory");
            const unsigned og = xb_add(&bar[XB_TOP], 1u);
            const unsigned tg = og / nx;
            if (og + 1u == (tg + 1u) * nx) xb_add(&bar[XB_TOPGEN], 1u);
            else XB_SPIN(xb_ld(&bar[XB_TOPGEN]) == tg, bar);
            __builtin_amdgcn_fence(__ATOMIC_ACQUIRE, "agent");
            xb_add(&bar[XB_XGEN(b.x)], 1u);
            asm volatile("s_waitcnt vmcnt(0)" ::: "memory");
        } else {
            XB_SPIN(xb_ld(&bar[XB_XGEN(b.x)]) == gen, bar);
            __builtin_amdgcn_fence(__ATOMIC_ACQUIRE, "agent");
            asm volatile("s_waitcnt vmcnt(0)" ::: "memory");
        }
    }
    __syncthreads();
}
struct ArgsH { const float* in[N_IN]; float* out; unsigned char* ws; double invf[44]; int ph_lo, ph_hi, li, pad; };
struct ArgsD { const GAS float* in[N_IN]; GAS float* out; GAS unsigned char* ws; double invf[44]; int ph_lo, ph_hi, li, pad; };
static_assert(sizeof(ArgsH) == sizeof(ArgsD), "args layout");
typedef const CAS ArgsD& ARef;
__device__ __forceinline__ const CAS ArgsD* kargs() {
#if defined(__HIP_DEVICE_COMPILE__)
    const CAS ArgsD* p = (const CAS ArgsD*)__builtin_amdgcn_kernarg_segment_ptr(); asm volatile("" : "+s"(p)); return p;
#else
    return nullptr;
#endif
}
struct WI { LAS unsigned char* lds; int tid, lane, wave, vcu, G, gw, NGW, bx; };
constexpr size_t RWA_STRIDE = (33 * MiB + 68 * 1024) / 4;
constexpr size_t YO_STRIDE = 32 * MiB / 4;

__device__ __forceinline__ int wave_sum_i(int v) {
#pragma unroll
    for (int o = 1; o < 64; o <<= 1) v += __shfl_xor(v, o);
    return v;
}
__device__ __forceinline__ void sincos_d(double ang, float& s, float& c) {
    const double q = __builtin_rint(ang * 0.63661977236758134308);
    double r = __builtin_fma(-q, 1.57079632679489661923, ang); r = __builtin_fma(-q, 6.123233995736766e-17, r);
    const double r2 = r * r;
    const double sp = r * (1.0 + r2 * (-1.0 / 6 + r2 * (1.0 / 120 + r2 * (-1.0 / 5040 + r2 * (1.0 / 362880 + r2 * (-1.0 / 39916800 + r2 * (1.0 / 6227020800.0)))))));
    const double cp = 1.0 + r2 * (-0.5 + r2 * (1.0 / 24 + r2 * (-1.0 / 720 + r2 * (1.0 / 40320 + r2 * (-1.0 / 3628800 + r2 * (1.0 / 479001600 + r2 * (-1.0 / 87178291200.0)))))));
    const int qi = ((int)q) & 3;
    const double ss = (qi == 0) ? sp : (qi == 1) ? cp : (qi == 2) ? -sp : -cp;
    const double cc = (qi == 0) ? cp : (qi == 1) ? -sp : (qi == 2) ? -cp : sp;
    s = (float)ss; c = (float)cc;
}

struct TrItem { const float* src; bf16* dst; int ldw; float scale; bool ok; };
__device__ __forceinline__ void tr_decode(ARef A, int it, int lane, TrItem& d) {
    constexpr int I_IN = NLAYER * 16 * 96, I_OUT = NLAYER * 16 * 32, I_W1 = NLAYER * NEXP * 16 * 64;
    const float* W; int ldw, nvalid, k0, nsrc0; bf16* WT; size_t dstrow0; float scale = 1.0f;
    int r = it;
    if (r < I_IN) { const int l = r / 1536, rr = r % 1536, kb = rr / 96, nb = rr % 96;
        const int nd = nb * 32;
        nsrc0 = (nd < 1024) ? nd : (nd < 1792) ? C_SB + (nd - 1024) : (nd < 2688) ? C_RW + (nd - 1792) : C_DSA + (nd - 2688);
        nvalid = (nd < 1024) ? 1024 : (nd < 1792) ? INC : (nd < 2688) ? C_DSA : ((nd < INC) ? C_SB : 0);
        scale = (nd >= 256 && nd < 512) ? 0.125f : (nd >= 1024 && nd < 1280) ? 0.18033688011112042f : 1.0f;
        W = A.in[I_WIN] + (size_t)l * DM * INC; ldw = INC; k0 = kb * 64; WT = (bf16*)(A.ws + WS_WIN) + (size_t)l * INCP * DM; dstrow0 = (size_t)nd; }
    else if (r < I_IN + I_OUT) { r -= I_IN; const int l = r / 512, rr = r % 512, kb = rr / 32, nb = rr % 32;
        W = A.in[I_WOUT] + (size_t)l * DM * DM; ldw = DM; nvalid = DM; k0 = kb * 64; nsrc0 = nb * 32; WT = (bf16*)(A.ws + WS_WOUT) + (size_t)l * DM * DM; dstrow0 = (size_t)nb * 32; }
    else if (r < I_IN + I_OUT + I_W1) { r -= I_IN + I_OUT; const int le = r / 1024, rr = r % 1024, kb = rr / 64, nb = rr % 64, j = nb >> 3, bj = (nb >> 2) & 1, cc0 = (nb & 3) * 32;
        W = A.in[I_MW1] + (size_t)le * DM * 2048; ldw = 2048; nvalid = 2048; k0 = kb * 64; nsrc0 = bj * 1024 + 128 * j + cc0; WT = (bf16*)(A.ws + WS_W1) + (size_t)le * 2048 * DM; dstrow0 = (size_t)nb * 32; }
    else { r -= I_IN + I_OUT + I_W1; const int le = r / 512, rr = r % 512, kb = rr / 32, nb = rr % 32;
        W = A.in[I_MW2] + (size_t)le * DM * DM; ldw = DM; nvalid = DM; k0 = kb * 64; nsrc0 = nb * 32; WT = (bf16*)(A.ws + WS_W2) + (size_t)le * DM * DM; dstrow0 = (size_t)nb * 32; }
    const int n = nsrc0 + 4 * (lane & 7);
    d.ok = n < nvalid; d.src = W + (size_t)(k0 + (lane >> 3)) * ldw + (d.ok ? n : 0); d.ldw = ldw; d.scale = scale;
    d.dst = WT + (dstrow0 + (lane >> 3)) * 1024 + k0 + 8 * (lane & 7);
}
__device__ __forceinline__ void tr_load(const TrItem& d, f32x4 (&v)[8]) {
#pragma unroll
    for (int i = 0; i < 8; ++i) v[i] = *(const f32x4*)(d.src + (size_t)(8 * i) * d.ldw);
}
__device__ __forceinline__ void tr_store(const TrItem& d, const f32x4 (&v)[8], LAS float* scr, int lane) {
    const float sc_ = d.ok ? d.scale : 0.0f;
#pragma unroll
    for (int i = 0; i < 8; ++i) { LAS float* s = scr + (8 * i + (lane >> 3)) * 33 + 4 * (lane & 7); s[0] = v[i].x * sc_; s[1] = v[i].y * sc_; s[2] = v[i].z * sc_; s[3] = v[i].w * sc_; }
    LDS_WAIT(); asm volatile("" ::: "memory");
    const int c8 = lane & 7;
#pragma unroll
    for (int j = 0; j < 4; ++j) { const int n = (lane >> 3) + 8 * j; const LAS float* s = scr + (8 * c8) * 33 + n;
        v4u o; o.x = pk2(s[0 * 33], s[1 * 33]); o.y = pk2(s[2 * 33], s[3 * 33]); o.z = pk2(s[4 * 33], s[5 * 33]); o.w = pk2(s[6 * 33], s[7 * 33]);
        *(v4u*)(d.dst + (size_t)(8 * j) * 1024) = o; }
    LDS_WAIT(); asm volatile("" ::: "memory");
}
__device__ __forceinline__ void ph_prologue(ARef A, const WI& w) {
    LAS float* sc = (LAS float*)w.lds;
    { const float* cin = A.in[I_C]; for (int i = w.tid; i < NB * DM; i += NWAVES * 64) { const float v = cin[i]; sc[i] = v / (1.0f + expf(-v)); } }
    __syncthreads();
    float* MOD = (float*)(A.ws + WS_MOD);
    LAS float* red = (LAS float*)(w.lds + 32768);
    if (w.vcu < 192) {
        const int l = w.vcu / 96, col = (w.vcu % 96) * 64 + w.lane, kw = 128 * w.wave;
        const float* wp = A.in[I_ADAW] + (size_t)l * DM * 6144 + (size_t)kw * 6144 + col;
        float acc[8];
#pragma unroll
        for (int b = 0; b < 8; ++b) acc[b] = 0.0f;
#pragma unroll 16
        for (int k = 0; k < 128; ++k) { const float wv = wp[(size_t)k * 6144];
#pragma unroll
            for (int b = 0; b < 8; ++b) acc[b] += sc[b * DM + kw + k] * wv; }
#pragma unroll
        for (int b = 0; b < 8; ++b) red[(w.wave * 8 + b) * 64 + w.lane] = acc[b];
    }
    __syncthreads();
    if (w.vcu < 192) { const int l = w.vcu / 96, b = w.wave, col = (w.vcu % 96) * 64 + w.lane;
        float s = A.in[I_ADAB][l * 6144 + col];
#pragma unroll
        for (int q = 0; q < 8; ++q) s += red[(q * 8 + b) * 64 + w.lane];
        MOD[(size_t)(l * 8 + b) * 6144 + col] = s; }
    __syncthreads();
    LAS float* scr = (LAS float*)(w.lds + 32768 + w.wave * 8448);
    constexpr int NIT = NLAYER * 16 * 96 + NLAYER * 16 * 32;
    { TrItem d0, d1; f32x4 va[8], vb[8];
      int it = w.gw; bool h0 = it < NIT;
      if (h0) { tr_decode(A, it, w.lane, d0); tr_load(d0, va); }
      while (h0) {
          it += w.NGW; const bool h1 = it < NIT;
          if (h1) { tr_decode(A, it, w.lane, d1); tr_load(d1, vb); }
          tr_store(d0, va, scr, w.lane);
          if (!h1) break;
          it += w.NGW; h0 = it < NIT;
          if (h0) { tr_decode(A, it, w.lane, d0); tr_load(d0, va); }
          tr_store(d1, vb, scr, w.lane);
      } }
    float* RT = (float*)(A.ws + WS_ROPE); const int* pos = (const int*)A.in[I_POS];
    for (int g = w.gw * 64 + w.lane; g < MTOK * 44; g += w.NGW * 64) {
        const int tok = g / 44, f = g % 44; int co, so;
        if (f < 32) { co = f; so = 32 + f; } else if (f < 40) { co = 64 + (f - 32); so = 72 + (f - 32); } else { co = 80 + (f - 40); so = 84 + (f - 40); }
        float s, c; sincos_d((double)pos[tok] * A.invf[f], s, c);
        RT[(size_t)tok * ROPE_W + co] = c; RT[(size_t)tok * ROPE_W + so] = s;
    }
}

__device__ __forceinline__ void moe_convert_chunk(ARef A, int l, int c, int lane, LAS float* scr) {
    constexpr int I0 = NLAYER * 16 * 96 + NLAYER * 16 * 32, I_W1 = NLAYER * NEXP * 16 * 64;
    const int it0 = (c < 8192) ? I0 + l * 32768 + 4 * c : I0 + I_W1 + l * 16384 + 4 * (c - 8192);
    TrItem d0, d1; f32x4 va[8], vb[8];
    tr_decode(A, it0, lane, d0); tr_load(d0, va);
    tr_decode(A, it0 + 1, lane, d1); tr_load(d1, vb);
    tr_store(d0, va, scr, lane);
    tr_decode(A, it0 + 2, lane, d0); tr_load(d0, va);
    tr_store(d1, vb, scr, lane);
    tr_decode(A, it0 + 3, lane, d1); tr_load(d1, vb);
    tr_store(d0, va, scr, lane);
    tr_store(d1, vb, scr, lane);
}

__device__ __forceinline__ void emit_h_row(const f32x4 (&v)[4], float rstd, const float* g, const float* sc, const float* sh, bf16* hrow, int lane) {
#pragma unroll
    for (int j = 0; j < 4; ++j) { const int k = 4 * (lane + 64 * j);
        const f32x4 gv = *(const f32x4*)(g + k), scv = *(const f32x4*)(sc + k), shv = *(const f32x4*)(sh + k);
        const f32x4 h = v[j] * rstd * gv * (1.0f + scv) + shv;
        v2u o; o.x = pk2(h.x, h.y); o.y = pk2(h.z, h.w); *(v2u*)(hrow + k) = o; }
}
__device__ __forceinline__ void small_weights_to_f16(ARef A, const WI& w) {
    { _Float16* SW = (_Float16*)(A.ws + WS_SMALLW);
      const int g0 = w.gw * 64 + w.lane, gs = w.NGW * 64;
      for (int l = 0; l < NLAYER; ++l) { _Float16* S = SW + (size_t)l * SMW_LAYER;
          const float* wq = A.in[I_WQ] + (size_t)l * 128 * 256; const float* wqi = A.in[I_WQI] + (size_t)l * 128 * 256;
          for (int e = g0; e < 256 * 128; e += gs) { const int n = e >> 7, k = e & 127; S[SMW_QI + e] = (_Float16)wq[k * 256 + n]; S[SMW_QI + 256 * 128 + e] = (_Float16)wqi[k * 256 + n]; }
          const float* w2 = A.in[I_W2] + (size_t)l * 32 * 256; const float* a2 = A.in[I_A2] + (size_t)l * 32 * 256; const float* g2 = A.in[I_G2] + (size_t)l * 64 * 256;
          for (int e = g0; e < 256 * 32; e += gs) { const int n = e >> 5, k = e & 31; S[SMW_W2 + e] = (_Float16)w2[k * 256 + n]; S[SMW_A2 + e] = (_Float16)a2[k * 256 + n]; }
          for (int e = g0; e < 256 * 64; e += gs) { const int n = e >> 6, k = e & 63; S[SMW_G2 + e] = (_Float16)g2[k * 256 + n]; } } }
}
__device__ __forceinline__ void ph_norm1(ARef A, const WI& w) {
    const float* MOD = (const float*)(A.ws + WS_MOD); bf16* H = (bf16*)(A.ws + WS_H);
    for (int m = w.gw; m < MTOK; m += w.NGW) {
        const float* xr = A.in[I_X] + (size_t)m * DM; f32x4 v[4]; float ss = 0.0f;
#pragma unroll
        for (int j = 0; j < 4; ++j) { v[j] = *(const f32x4*)(xr + 4 * (w.lane + 64 * j)); ss += dot4(v[j], v[j]); }
        ss = wave_sum(ss); const float rstd = 1.0f / sqrtf(ss * (1.0f / DM) + 1e-5f);
        const float* mb = MOD + (size_t)(m >> 12) * 6144;
        emit_h_row(v, rstd, A.in[I_NMIX], mb + 1024, mb, H + (size_t)m * DM, w.lane);
    }
}

typedef _Float16 h4v __attribute__((ext_vector_type(4)));
__device__ __forceinline__ f16x8 pack_f16x8(f32x4 a, f32x4 b) { f16x8 r; r[0] = (_Float16)a.x; r[1] = (_Float16)a.y; r[2] = (_Float16)a.z; r[3] = (_Float16)a.w; r[4] = (_Float16)b.x; r[5] = (_Float16)b.y; r[6] = (_Float16)b.z; r[7] = (_Float16)b.w; return r; }
#define RW_STB4(k_, val_) do { v2u w_; w_.x = pk2((val_).x, (val_).y); w_.y = pk2((val_).z, (val_).w); *(v2u*)((bf16*)(RWA + (k_) * RWA_STRIDE) + o) = w_; } while (0)
#ifndef RWKV_RKV_BF16
#define RWKV_RKV_BF16 1
#endif
#if RWKV_RKV_BF16
#define RW_ST_RKV(k_, val_) RW_STB4(k_, val_)
#else
#define RW_ST_RKV(k_, val_) (*(f32x4*)(RWA + (k_) * RWA_STRIDE + o) = (val_))
#endif
__device__ __forceinline__ f32x4 ldb4(const bf16* q) { const v2u x = *(const v2u*)q; return (f32x4){bf_lo(x.x), bf_hi(x.x), bf_lo(x.y), bf_hi(x.y)}; }
__device__ __forceinline__ void prep16_body(const bf16* __restrict__ P, float* __restrict__ RWA, const _Float16* __restrict__ SW, const float* __restrict__ RT, bf16* __restrict__ DQ, _Float16* __restrict__ DQI,
                                            bf16* __restrict__ DKB, bf16* __restrict__ DVB, _Float16* __restrict__ DKI, float* __restrict__ DW, const float* __restrict__ mu, const float* __restrict__ qn,
                                            const float* __restrict__ w0p, const float* __restrict__ a0p, const float* __restrict__ kkp, const float* __restrict__ kap, const float* __restrict__ rkp, int m0, int lane_in, int part = 7) {
    int lane = lane_in; asm volatile("" : "+v"(lane));
    const int tk = lane & 15, q4 = lane >> 4, m = m0 + tk, t = m & (SEQ - 1);
    const bf16* pr = P + (size_t)m * PFW; const bf16* pp = pr - PFW; const bf16* pd = P + (size_t)m * PFW + PF_DSA;
    RT += (size_t)m * ROPE_W; const f32x4 zero4 = {0.f, 0.f, 0.f, 0.f};
    f16x8 bx[4], bc[4];
    { float ss = 0.0f; f32x4 c[4][2];
#pragma unroll
      for (int ks = 0; ks < 4; ++ks) { const int f0 = 32 * ks + 8 * q4;
          f32x4 x[2];
#pragma unroll
          for (int u = 0; u < 2; ++u) { const f32x4 z = ldb4(pr + 768 + f0 + 4 * u); const f32x4 p = t ? ldb4(pp + 768 + f0 + 4 * u) : zero4; x[u] = z + (p - z) * *(const f32x4*)(mu + 768 + f0 + 4 * u);
#pragma unroll
              for (int i = 0; i < 4; ++i) x[u][i] = (ks == 0) ? ftanh(x[u][i]) : (ks == 1) ? x[u][i] : sigm(x[u][i]); }
          bx[ks] = pack_f16x8(x[0], x[1]);
          c[ks][0] = ldb4(pd + f0); c[ks][1] = ldb4(pd + f0 + 4); ss += dot4(c[ks][0], c[ks][0]) + dot4(c[ks][1], c[ks][1]); }
      ss += __shfl_xor(ss, 16); ss += __shfl_xor(ss, 32);
      const float rstd = 1.0f / sqrtf(ss * (1.0f / 128.0f) + 1e-5f);
#pragma unroll
      for (int ks = 0; ks < 4; ++ks) { const int f0 = 32 * ks + 8 * q4; bc[ks] = pack_f16x8(c[ks][0] * rstd * *(const f32x4*)(qn + f0), c[ks][1] * rstd * *(const f32x4*)(qn + f0 + 4)); } }
    const _Float16* wrow = SW + (size_t)tk * 0;
    (void)wrow;
    const int arow = lane & 15;
    if (part & 1)
#pragma unroll 2
    for (int hd = 0; hd < 4; ++hd) {
        f32x4 fk[4], av[4]; float ssk = 0.0f;
#pragma unroll
        for (int j = 0; j < 4; ++j) { const int nb = 4 * hd + j, ch = 16 * nb + 4 * q4; const size_t o = (size_t)m * 256 + ch;
            const f16x8 aw = *(const f16x8*)(SW + SMW_W2 + (16 * nb + arow) * 32 + 8 * q4), aa = *(const f16x8*)(SW + SMW_A2 + (16 * nb + arow) * 32 + 8 * q4);
            const f16x8 ag0 = *(const f16x8*)(SW + SMW_G2 + (16 * nb + arow) * 64 + 8 * q4), ag1 = *(const f16x8*)(SW + SMW_G2 + (16 * nb + arow) * 64 + 32 + 8 * q4);
            const f32x4 cw = __builtin_amdgcn_mfma_f32_16x16x32_f16(aw, bx[0], *(const f32x4*)(w0p + ch), 0, 0, 0);
            const f32x4 ca = __builtin_amdgcn_mfma_f32_16x16x32_f16(aa, bx[1], *(const f32x4*)(a0p + ch), 0, 0, 0);
            f32x4 cg = __builtin_amdgcn_mfma_f32_16x16x32_f16(ag0, bx[2], zero4, 0, 0, 0); cg = __builtin_amdgcn_mfma_f32_16x16x32_f16(ag1, bx[3], cg, 0, 0, 0);
            f32x4 dec;
#pragma unroll
            for (int i = 0; i < 4; ++i) { dec[i] = fexp(-fexp(-softplusf(-cw[i]) - 0.5f)); av[j][i] = sigm(ca[i]); }
            *(f32x4*)(RWA + 1 * RWA_STRIDE + o) = dec; RW_STB4(6, cg);
            { const f32x4 z = ldb4(pr + 256 + ch); const f32x4 p = t ? ldb4(pp + 256 + ch) : zero4; fk[j] = z + (p - z) * *(const f32x4*)(mu + 256 + ch); }
            const f32x4 kk = fk[j] * *(const f32x4*)(kkp + ch); ssk += dot4(kk, kk); }
        ssk += __shfl_xor(ssk, 16); ssk += __shfl_xor(ssk, 32);
        const float inrm = 1.0f / fmaxf(sqrtf(ssk), 1e-12f);
        f32x4 fr[4], km[4]; float bs = 0.0f;
#pragma unroll
        for (int j = 0; j < 4; ++j) { const int ch = 16 * (4 * hd + j) + 4 * q4;
            { const f32x4 z = ldb4(pr + ch); const f32x4 p = t ? ldb4(pp + ch) : zero4; fr[j] = z + (p - z) * *(const f32x4*)(mu + ch); }
            km[j] = fk[j] * (1.0f + (av[j] - 1.0f) * *(const f32x4*)(kap + ch)); bs += dot4(fr[j] * km[j], *(const f32x4*)(rkp + ch)); }
        bs += __shfl_xor(bs, 16); bs += __shfl_xor(bs, 32);
#pragma unroll
        for (int j = 0; j < 4; ++j) { const int ch = 16 * (4 * hd + j) + 4 * q4; const size_t o = (size_t)m * 256 + ch;
            f32x4 fv; { const f32x4 z = ldb4(pr + 512 + ch); const f32x4 p = t ? ldb4(pp + 512 + ch) : zero4; fv = z + (p - z) * *(const f32x4*)(mu + 512 + ch); }
            const f32x4 kk = fk[j] * *(const f32x4*)(kkp + ch) * inrm;
            RW_ST_RKV(0, fr[j]); RW_ST_RKV(2, km[j]); RW_ST_RKV(3, fv);
            *(f32x4*)(RWA + 4 * RWA_STRIDE + o) = -kk; *(f32x4*)(RWA + 5 * RWA_STRIDE + o) = kk * av[j]; { const f32x4 bo_ = bs * fv; RW_STB4(7, bo_); } }
    }
    if (part & 2)
#pragma unroll 4
    for (int nb = 0; nb < 32; ++nb) {
        f32x4 cq = zero4;
#pragma unroll
        for (int ks = 0; ks < 4; ++ks) { const f16x8 aq = *(const f16x8*)(SW + SMW_QI + (16 * nb + arow) * 128 + 32 * ks + 8 * q4); cq = __builtin_amdgcn_mfma_f32_16x16x32_f16(aq, bc[ks], cq, 0, 0, 0); }
        const int ch = 16 * (nb & 15) + 4 * q4;
        if (nb < 16) {
            if ((nb & 3) == 0) { const f32x4 ot = shx4(cq, 32); const int fi = 4 * (q4 & 1); const f32x4 cs4 = *(const f32x4*)(RT + 64 + fi), sn = *(const f32x4*)(RT + 72 + fi); cq = (q4 < 2) ? cq * cs4 - ot * sn : ot * sn + cq * cs4; }
            const f32x4 qs = cq * 0.18033688011112042f; v2u o; o.x = pk2(qs.x, qs.y); o.y = pk2(qs.z, qs.w); *(v2u*)(DQ + (size_t)m * 256 + ch) = o;
        } else {
            if ((nb & 1) == 0) { const f32x4 ot = shx4(cq, 16); const f32x4 cs4 = *(const f32x4*)(RT + 80), sn = *(const f32x4*)(RT + 84); if (q4 < 2) cq = (q4 < 1) ? cq * cs4 - ot * sn : ot * sn + cq * cs4; }
            h4v hq; hq.x = (_Float16)cq.x; hq.y = (_Float16)cq.y; hq.z = (_Float16)cq.z; hq.w = (_Float16)cq.w; *(h4v*)(DQI + (size_t)m * 256 + ch) = hq;
        }
    }
#pragma unroll
    for (int j = 0; j < 4; ++j) { const int d = 16 * j + 4 * q4; f32x4 kx = ldb4(pd + 128 + d);
        if (j == 0) { const f32x4 ot = shx4(kx, 32); const int fi = 4 * (q4 & 1); const f32x4 cs4 = *(const f32x4*)(RT + 64 + fi), sn = *(const f32x4*)(RT + 72 + fi); kx = (q4 < 2) ? kx * cs4 - ot * sn : ot * sn + kx * cs4; }
        v2u o; o.x = pk2(kx.x, kx.y); o.y = pk2(kx.z, kx.w); *(v2u*)(DKB + (size_t)m * 64 + d) = o;
        const f32x4 vx = ldb4(pd + 192 + d); v2u ov; ov.x = pk2(vx.x, vx.y); ov.y = pk2(vx.z, vx.w); *(v2u*)(DVB + (size_t)m * 64 + d) = ov; }
#pragma unroll
    for (int j = 0; j < 2; ++j) { const int d = 16 * j + 4 * q4; f32x4 ki = ldb4(pd + 256 + d);
        if (j == 0) { const f32x4 ot = shx4(ki, 16); const f32x4 cs4 = *(const f32x4*)(RT + 80), sn = *(const f32x4*)(RT + 84); if (q4 < 2) ki = (q4 < 1) ? ki * cs4 - ot * sn : ot * sn + ki * cs4; }
        h4v hk; hk.x = (_Float16)ki.x; hk.y = (_Float16)ki.y; hk.z = (_Float16)ki.z; hk.w = (_Float16)ki.w; *(h4v*)(DKI + (size_t)m * 32 + d) = hk; }
    if (q4 < 2) *(f32x4*)(DW + (size_t)m * 8 + 4 * q4) = ldb4(pd + 288 + 4 * q4) * 0.0625f;
}

__device__ __forceinline__ void prep16(ARef A, int l, int m0, int lane_in, int part = 7) {
    prep16_body((const bf16*)(A.ws + WS_PF), (float*)(A.ws + WS_RWA), (const _Float16*)(A.ws + WS_SMALLW) + (size_t)l * SMW_LAYER, (const float*)(A.ws + WS_ROPE), (bf16*)(A.ws + WS_DQ), (_Float16*)(A.ws + WS_DQI),
                (bf16*)(A.ws + WS_DKB), (bf16*)(A.ws + WS_DVB), (_Float16*)(A.ws + WS_DKI), (float*)(A.ws + WS_DW), A.in[I_MU] + l * 896, A.in[I_QNORM] + l * 128,
                A.in[I_W0] + l * 256, A.in[I_A0] + l * 256, A.in[I_KK] + l * 256, A.in[I_KA] + l * 256, A.in[I_RK] + l * 256, m0, lane_in, part);
}
__device__ __forceinline__ float quad_sum(float v) {
    v += __builtin_bit_cast(float, __builtin_amdgcn_mov_dpp(__builtin_bit_cast(int, v), 0xB1, 0xF, 0xF, true));
    v += __builtin_bit_cast(float, __builtin_amdgcn_mov_dpp(__builtin_bit_cast(int, v), 0x4E, 0xF, 0xF, true));
    return v;
}
__device__ __forceinline__ float oct_sum(float v) {
    v += __builtin_bit_cast(float, __builtin_amdgcn_mov_dpp(__builtin_bit_cast(int, v), 0xB1, 0xF, 0xF, true));
    v += __builtin_bit_cast(float, __builtin_amdgcn_mov_dpp(__builtin_bit_cast(int, v), 0x4E, 0xF, 0xF, true));
    v += __builtin_bit_cast(float, __builtin_amdgcn_mov_dpp(__builtin_bit_cast(int, v), 0x141, 0xF, 0xF, true));
    return v;
}
typedef float f32x2 __attribute__((ext_vector_type(2)));
#define LO2(v_) __builtin_shufflevector(v_, v_, 0, 1)
#define HI2(v_) __builtin_shufflevector(v_, v_, 2, 3)
#define RW_ROW(i_) (((i_) < 2) ? (16 * ws + rg + 8 * (i_)) : (64 + 16 * ws + rg + 8 * ((i_) - 2)))
#define RW_LOAD(op, s_) do { const int lo_ = (s_) * 64 + kq * 8; \
    op[0] = *(const LAS f32x4*)(sn + lo_); op[1] = *(const LAS f32x4*)(sn + lo_ + 4); op[2] = *(const LAS f32x4*)(sw + lo_); op[3] = *(const LAS f32x4*)(sw + lo_ + 4); \
    op[4] = *(const LAS f32x4*)(sb + lo_); op[5] = *(const LAS f32x4*)(sb + lo_ + 4); op[6] = *(const LAS f32x4*)(sk + lo_); op[7] = *(const LAS f32x4*)(sk + lo_ + 4); \
    op[8] = *(const LAS f32x4*)(sr + lo_); op[9] = *(const LAS f32x4*)(sr + lo_ + 4); \
    vin[0] = sv[(s_) * 64 + 16 * ws + rg]; vin[1] = sv[(s_) * 64 + 16 * ws + rg + 8]; } while (0)
#define RW_DOT(i_, oa, ob) ({ f32x2 d_ = S[i_][0] * LO2(oa); d_ = S[i_][1] * HI2(oa) + d_; d_ = S[i_][2] * LO2(ob) + d_; d_ = S[i_][3] * HI2(ob) + d_; d_.x + d_.y; })
#define RW_STEP(op, vv, s_) do { float sa_[4], y_[4]; \
    _Pragma("unroll") for (int i_ = 0; i_ < 4; ++i_) sa_[i_] = RW_DOT(i_, op[0], op[1]); \
    _Pragma("unroll") for (int i_ = 0; i_ < 4; ++i_) sa_[i_] += __builtin_bit_cast(float, __builtin_amdgcn_mov_dpp(__builtin_bit_cast(int, sa_[i_]), 0xB1, 0xF, 0xF, true)); \
    _Pragma("unroll") for (int i_ = 0; i_ < 4; ++i_) sa_[i_] += __builtin_bit_cast(float, __builtin_amdgcn_mov_dpp(__builtin_bit_cast(int, sa_[i_]), 0x4E, 0xF, 0xF, true)); \
    _Pragma("unroll") for (int i_ = 0; i_ < 4; ++i_) sa_[i_] += __builtin_bit_cast(float, __builtin_amdgcn_mov_dpp(__builtin_bit_cast(int, sa_[i_]), 0x141, 0xF, 0xF, true)); \
    _Pragma("unroll") for (int i_ = 0; i_ < 2; ++i_) { const f32x2 a2_ = {sa_[i_], sa_[i_]}, v2_ = {vv[i_], vv[i_]}; \
        S[i_][0] = S[i_][0] * LO2(op[2]) + (a2_ * LO2(op[4]) + v2_ * LO2(op[6])); S[i_][1] = S[i_][1] * HI2(op[2]) + (a2_ * HI2(op[4]) + v2_ * HI2(op[6])); \
        S[i_][2] = S[i_][2] * LO2(op[3]) + (a2_ * LO2(op[5]) + v2_ * LO2(op[7])); S[i_][3] = S[i_][3] * HI2(op[3]) + (a2_ * HI2(op[5]) + v2_ * HI2(op[7])); } \
    _Pragma("unroll") for (int i_ = 2; i_ < 4; ++i_) { const f32x2 a2_ = {sa_[i_], sa_[i_]}; \
        S[i_][0] = S[i_][0] * LO2(op[2]) + a2_ * LO2(op[4]); S[i_][1] = S[i_][1] * HI2(op[2]) + a2_ * HI2(op[4]); S[i_][2] = S[i_][2] * LO2(op[3]) + a2_ * LO2(op[5]); S[i_][3] = S[i_][3] * HI2(op[3]) + a2_ * HI2(op[5]); } \
    _Pragma("unroll") for (int i_ = 0; i_ < 4; ++i_) y_[i_] = RW_DOT(i_, op[8], op[9]); \
    _Pragma("unroll") for (int i_ = 0; i_ < 4; ++i_) y_[i_] += __builtin_bit_cast(float, __builtin_amdgcn_mov_dpp(__builtin_bit_cast(int, y_[i_]), 0xB1, 0xF, 0xF, true)); \
    _Pragma("unroll") for (int i_ = 0; i_ < 4; ++i_) y_[i_] += __builtin_bit_cast(float, __builtin_amdgcn_mov_dpp(__builtin_bit_cast(int, y_[i_]), 0x4E, 0xF, 0xF, true)); \
    _Pragma("unroll") for (int i_ = 0; i_ < 4; ++i_) y_[i_] += __builtin_bit_cast(float, __builtin_amdgcn_mov_dpp(__builtin_bit_cast(int, y_[i_]), 0x141, 0xF, 0xF, true)); \
    if (kq == 0) { _Pragma("unroll") for (int i_ = 0; i_ < 4; ++i_) so[(s_) * 128 + RW_ROW(i_)] = y_[i_]; } } while (0)
__device__ __forceinline__ void scan_rwkv_task2(ARef A, const WI& w, int task0) {
    const int slot = w.wave >> 2, ws = w.wave & 3, lt = w.tid & 255, task = task0 + slot;
    const int bh = task >> 4, c = task & 15, b = bh >> 2, h = bh & 3;
    LAS float* sw = (LAS float*)w.lds + slot * 16384; LAS float* sn = sw + 2048; LAS float* sb = sn + 2048; LAS float* sk = sb + 2048; LAS float* sr = sk + 2048; LAS float* sv = sr + 2048; LAS float* so = sv + 2048;
    const float* RWA = (const float*)(A.ws + WS_RWA);
    const int rg = w.lane >> 3, kq = w.lane & 7;
    f32x2 S[4][4];
#pragma unroll
    for (int i = 0; i < 4; ++i)
#pragma unroll
        for (int j = 0; j < 4; ++j) { const int r = RW_ROW(i); S[i][j].x = (r >= 64 && 8 * kq + 2 * j == r - 64) ? 1.0f : 0.0f; S[i][j].y = (r >= 64 && 8 * kq + 2 * j + 1 == r - 64) ? 1.0f : 0.0f; }
    const size_t tok0 = (size_t)b * SEQ + (size_t)c * TCH;
    const int st = lt >> 3, sd = (lt & 7) * 8;
#if RWKV_RKV_BF16
    f32x4 a[3][2]; v4u ab[3];
#define RW_LD_RKV(i_, k_) ab[i_] = *(const v4u*)((const bf16*)(RWA + (k_) * RWA_STRIDE) + o_)
#define RW_GET_RKV(i_, q_) RW_UNPK(ab[i_], q_)
#else
    f32x4 a[3][2]; f32x4 af[3][2];
#define RW_LD_RKV(i_, k_) do { af[i_][0] = *(const f32x4*)(RWA + (k_) * RWA_STRIDE + o_); af[i_][1] = *(const f32x4*)(RWA + (k_) * RWA_STRIDE + o_ + 4); } while (0)
#define RW_GET_RKV(i_, q_) af[i_][q_]
#endif
#define RW_GLOAD(sub_) do { const size_t o_ = (tok0 + (sub_) * 32 + st) * 256 + h * 64 + sd; \
        _Pragma("unroll") for (int q = 0; q < 2; ++q) { a[0][q] = *(const f32x4*)(RWA + 1 * RWA_STRIDE + o_ + 4 * q); a[1][q] = *(const f32x4*)(RWA + 4 * RWA_STRIDE + o_ + 4 * q); a[2][q] = *(const f32x4*)(RWA + 5 * RWA_STRIDE + o_ + 4 * q); } \
        RW_LD_RKV(0, 2); RW_LD_RKV(1, 0); RW_LD_RKV(2, 3); } while (0)
#define RW_UNPK(x_, q_) ((q_) == 0 ? (f32x4){bf_lo((x_).x), bf_hi((x_).x), bf_lo((x_).y), bf_hi((x_).y)} : (f32x4){bf_lo((x_).z), bf_hi((x_).z), bf_lo((x_).w), bf_hi((x_).w)})
    RW_GLOAD(0);
    for (int sub = 0; sub < TCH / 32; ++sub) {
        __syncthreads();
        { const int lo = st * 64 + sd;
#pragma unroll
          for (int q = 0; q < 2; ++q) { *(LAS f32x4*)(sw + lo + 4 * q) = a[0][q]; *(LAS f32x4*)(sn + lo + 4 * q) = a[1][q]; *(LAS f32x4*)(sb + lo + 4 * q) = a[2][q]; *(LAS f32x4*)(sk + lo + 4 * q) = RW_GET_RKV(0, q); *(LAS f32x4*)(sr + lo + 4 * q) = RW_GET_RKV(1, q); *(LAS f32x4*)(sv + lo + 4 * q) = RW_GET_RKV(2, q); } }
        __syncthreads();
        if (sub + 1 < TCH / 32) RW_GLOAD(sub + 1);
        { f32x4 opA[10], opB[10]; float vin[2], vA[2], vB[2];
          RW_LOAD(opA, 0);
          vA[0] = vin[0]; vA[1] = vin[1];
#pragma unroll 1
          for (int s = 0; s < 32; s += 2) {
              RW_LOAD(opB, s + 1);
              vB[0] = vin[0]; vB[1] = vin[1];
              RW_STEP(opA, vA, s);
              if (s + 2 < 32) { RW_LOAD(opA, s + 2); vA[0] = vin[0]; vA[1] = vin[1]; }
              RW_STEP(opB, vB, s + 1);
          } }
        __syncthreads();
        { const int fs = lt >> 3, c16 = (lt & 7) * 16;
          bf16* dst = (c16 < 64) ? (bf16*)((float*)(A.ws + WS_YO) + YO_STRIDE) : ((bf16*)(A.ws + WS_PT) - 64);
          bf16* dp = dst + (tok0 + sub * 32 + fs) * 256 + h * 64 + c16;
#pragma unroll
          for (int q = 0; q < 2; ++q) { const f32x4 x0 = *(const LAS f32x4*)(so + fs * 128 + c16 + 8 * q), x1 = *(const LAS f32x4*)(so + fs * 128 + c16 + 8 * q + 4);
              v4u wv; wv.x = pk2(x0.x, x0.y); wv.y = pk2(x0.z, x0.w); wv.z = pk2(x1.x, x1.y); wv.w = pk2(x1.z, x1.w); *(v4u*)(dp + 8 * q) = wv; } }
    }
    { float* ch = (float*)(A.ws + WS_CH) + ((size_t)(bh * NCH + c) * 128) * 64 + 8 * kq;
#pragma unroll
      for (int i = 0; i < 4; ++i) { float* cr = ch + (size_t)RW_ROW(i) * 64; *(f32x4*)cr = (f32x4){S[i][0].x, S[i][0].y, S[i][1].x, S[i][1].y}; *(f32x4*)(cr + 4) = (f32x4){S[i][2].x, S[i][2].y, S[i][3].x, S[i][3].y}; } }
    __syncthreads();
}
#undef RW_LOAD
#undef RW_STEP
#undef RW_GLOAD
#undef RW_UNPK
#undef RW_LD_RKV
#undef RW_GET_RKV
#undef RW_DOT
#undef RW_ROW
__device__ __forceinline__ void scan_ret_task(ARef A, const WI& w, int task) {
    const int bh = task >> 3, cp = task & 7, b = bh >> 2, h = bh & 3, un = w.tid >> 8, lt = w.tid & 255, c = 2 * cp + un;
    const float lg2g = log2f(1.0f - exp2f(-5.0f - (float)h)), gamma = exp2f(lg2g);
    LAS float* sk = (LAS float*)w.lds + un * 8192; LAS float* sq = sk + 2048; LAS float* sv = sq + 2048; LAS float* so = sv + 2048;
    const bf16* PB = (const bf16*)(A.ws + WS_PB); const float* RT = (const float*)(A.ws + WS_ROPE);
    const int row = lt >> 2, kq = lt & 3;
    f32x2 S[8];
#pragma unroll
    for (int j = 0; j < 8; ++j) S[j] = (f32x2){0.0f, 0.0f};
    const f32x2 gam2 = {gamma, gamma};
    const size_t tok0 = (size_t)b * SEQ + (size_t)c * TCH;
    const int st = lt >> 3, sd = (lt & 7) * 8;
    const int fi = sd & 31, dp = sd ^ 32;
    f32x4 gq[2], gqo[2], gk[2], gko[2], gv[2], gcs[2], gsn[2];
#define BF8_TO_F32(dst, x_) do { dst[0] = (f32x4){bf_lo(x_.x), bf_hi(x_.x), bf_lo(x_.y), bf_hi(x_.y)}; dst[1] = (f32x4){bf_lo(x_.z), bf_hi(x_.z), bf_lo(x_.w), bf_hi(x_.w)}; } while (0)
#define RT_GLOAD(sub_) do { const size_t m_ = tok0 + (sub_) * 32 + st; const bf16* pr_ = PB + m_ * PBW + h * 64; const float* rt_ = RT + m_ * ROPE_W; \
        _Pragma("unroll") for (int u = 0; u < 2; ++u) { gcs[u] = *(const f32x4*)(rt_ + fi + 4 * u); gsn[u] = *(const f32x4*)(rt_ + 32 + fi + 4 * u); } \
        { const v4u x0 = *(const v4u*)(pr_ + sd), x1 = *(const v4u*)(pr_ + dp), x2 = *(const v4u*)(pr_ + 256 + sd), x3 = *(const v4u*)(pr_ + 256 + dp), x4 = *(const v4u*)(pr_ + 512 + sd); \
          BF8_TO_F32(gq, x0); BF8_TO_F32(gqo, x1); BF8_TO_F32(gk, x2); BF8_TO_F32(gko, x3); BF8_TO_F32(gv, x4); } } while (0)
    RT_GLOAD(0);
    for (int sub = 0; sub < TCH / 32; ++sub) {
        const size_t m = tok0 + sub * 32 + st;
        f32x4 qn[2], kn[2], vn[2];
#pragma unroll
        for (int u = 0; u < 2; ++u) { qn[u] = (sd < 32) ? gq[u] * gcs[u] - gqo[u] * gsn[u] : gqo[u] * gsn[u] + gq[u] * gcs[u]; kn[u] = (sd < 32) ? gk[u] * gcs[u] - gko[u] * gsn[u] : gko[u] * gsn[u] + gk[u] * gcs[u]; vn[u] = gv[u]; }
        { const float gt = exp2f(lg2g * (float)(sub * 32 + st + 1)); const f32x4 p0 = qn[0] * gt, p1 = qn[1] * gt;
          v4u pw; pw.x = pk2(p0.x, p0.y); pw.y = pk2(p0.z, p0.w); pw.z = pk2(p1.x, p1.y); pw.w = pk2(p1.z, p1.w); *(v4u*)((bf16*)(A.ws + WS_PTR) + m * 256 + h * 64 + sd) = pw; }
        __syncthreads();
        { const int lo = st * 64 + sd; *(LAS f32x4*)(sq + lo) = qn[0]; *(LAS f32x4*)(sq + lo + 4) = qn[1]; *(LAS f32x4*)(sk + lo) = kn[0]; *(LAS f32x4*)(sk + lo + 4) = kn[1]; *(LAS f32x4*)(sv + lo) = vn[0]; *(LAS f32x4*)(sv + lo + 4) = vn[1]; }
        __syncthreads();
        if (sub + 1 < TCH / 32) RT_GLOAD(sub + 1);
#define RT_LOAD(kvA, rvA, vA, s_) do { const int lo_ = (s_) * 64 + kq * 16; _Pragma("unroll") for (int j4 = 0; j4 < 4; ++j4) { kvA[j4] = *(const LAS f32x4*)(sk + lo_ + 4 * j4); rvA[j4] = *(const LAS f32x4*)(sq + lo_ + 4 * j4); } vA = sv[(s_) * 64 + row]; } while (0)
#define RT_STEP(kvA, rvA, vA, s_) do { const f32x2 v2 = {vA, vA}; f32x2 y2 = {0.0f, 0.0f}; \
            _Pragma("unroll") for (int j4 = 0; j4 < 4; ++j4) { S[2 * j4] = S[2 * j4] * gam2 + v2 * LO2(kvA[j4]); S[2 * j4 + 1] = S[2 * j4 + 1] * gam2 + v2 * HI2(kvA[j4]); \
                y2 = S[2 * j4] * LO2(rvA[j4]) + y2; y2 = S[2 * j4 + 1] * HI2(rvA[j4]) + y2; } \
            const float y = quad_sum(y2.x + y2.y); if (kq == 0) so[(s_) * 64 + row] = y; } while (0)
        { f32x4 kA[4], rA[4], kB[4], rB[4]; float vA, vB;
          RT_LOAD(kA, rA, vA, 0);
#pragma unroll 1
          for (int s = 0; s < 32; s += 2) {
              RT_LOAD(kB, rB, vB, s + 1);
              RT_STEP(kA, rA, vA, s);
              if (s + 2 < 32) RT_LOAD(kA, rA, vA, s + 2);
              RT_STEP(kB, rB, vB, s + 1);
          } }
#undef RT_LOAD
#undef RT_STEP
        __syncthreads();
        { const int fs = lt >> 3, c8 = (lt & 7) * 8; bf16* dp2 = (bf16*)(A.ws + WS_YO) + (tok0 + sub * 32 + fs) * 256 + h * 64 + c8;
          const f32x4 x0 = *(const LAS f32x4*)(so + fs * 64 + c8), x1 = *(const LAS f32x4*)(so + fs * 64 + c8 + 4);
          v4u wv; wv.x = pk2(x0.x, x0.y); wv.y = pk2(x0.z, x0.w); wv.z = pk2(x1.x, x1.y); wv.w = pk2(x1.z, x1.w); *(v4u*)dp2 = wv; }
    }
    { float* ch = (float*)(A.ws + WS_CHR) + ((size_t)(bh * NCH + c) * 64 + row) * 64 + 16 * kq;
#pragma unroll
      for (int j4 = 0; j4 < 4; ++j4) *(f32x4*)(ch + 4 * j4) = (f32x4){S[2 * j4].x, S[2 * j4].y, S[2 * j4 + 1].x, S[2 * j4 + 1].y}; }
    __syncthreads();
}
#undef RT_GLOAD
#undef BF8_TO_F32
__device__ __forceinline__ void prefix_chain(ARef A, const WI& w, int bh) {
    LAS float* s0 = (LAS float*)w.lds;
    const int v = w.tid >> 3, k8 = (w.tid & 7) * 8;
    const float* CH = (const float*)(A.ws + WS_CH) + (size_t)bh * NCH * 128 * 64; float* SI = (float*)(A.ws + WS_SI) + (size_t)bh * NCH * 64 * 64;
    f32x4 c0 = {0.f, 0.f, 0.f, 0.f}, c1 = {0.f, 0.f, 0.f, 0.f};
    for (int c = 0; c < NCH; ++c) {
        *(f32x4*)(SI + ((size_t)c * 64 + v) * 64 + k8) = c0; *(f32x4*)(SI + ((size_t)c * 64 + v) * 64 + k8 + 4) = c1;
        if (c == NCH - 1) break;
        __syncthreads();
        *(LAS f32x4*)(s0 + v * 68 + k8) = c0; *(LAS f32x4*)(s0 + v * 68 + k8 + 4) = c1;
        __syncthreads();
        const float* ch = CH + (size_t)c * 128 * 64;
        f32x4 n0 = *(const f32x4*)(ch + (size_t)v * 64 + k8), n1 = *(const f32x4*)(ch + (size_t)v * 64 + k8 + 4);
#pragma unroll 8
        for (int kp = 0; kp < 64; ++kp) { const float s = s0[v * 68 + kp]; const float* pr = ch + (size_t)(64 + kp) * 64 + k8; n0 += s * *(const f32x4*)pr; n1 += s * *(const f32x4*)(pr + 4); }
        c0 = n0; c1 = n1;
    }
    const int h = bh & 3; const float gT = exp2f((float)TCH * log2f(1.0f - exp2f(-5.0f - (float)h)));
    const float* CHR = (const float*)(A.ws + WS_CHR) + (size_t)bh * NCH * 64 * 64; float* SIR = (float*)(A.ws + WS_SIR) + (size_t)bh * NCH * 64 * 64;
    c0 = (f32x4){0.f, 0.f, 0.f, 0.f}; c1 = c0;
    for (int c = 0; c < NCH; ++c) {
        *(f32x4*)(SIR + ((size_t)c * 64 + v) * 64 + k8) = c0; *(f32x4*)(SIR + ((size_t)c * 64 + v) * 64 + k8 + 4) = c1;
        if (c == NCH - 1) break;
        c0 = c0 * gT + *(const f32x4*)(CHR + ((size_t)c * 64 + v) * 64 + k8); c1 = c1 * gT + *(const f32x4*)(CHR + ((size_t)c * 64 + v) * 64 + k8 + 4);
    }
    __syncthreads();
}
typedef float f32x16 __attribute__((ext_vector_type(16)));
constexpr int SBV_PITCH = 144;
__device__ __forceinline__ float lane32_swap(float v) { return __shfl_xor(v, 32); }
__device__ __forceinline__ void sb_tile_mfma(ARef A, int unit, int lane, LAS unsigned char* vl) {
    const int tq = unit & 127, bh = unit >> 7, b = bh >> 2, h = bh & 3, t0 = tq * 32, r32 = lane & 31, hi = lane >> 5;
    const bf16* PS = (const bf16*)(A.ws + WS_PB) + (size_t)b * SEQ * PBW + PB_SB + h * 64;
    bf16x8v qf[4];
#pragma unroll
    for (int ks = 0; ks < 4; ++ks) qf[ks] = *(const bf16x8v*)(PS + (size_t)(t0 + r32) * PBW + 16 * ks + 8 * hi);
    f32x16 o0, o1;
#pragma unroll
    for (int r = 0; r < 16; ++r) { o0[r] = 0.0f; o1[r] = 0.0f; }
    float carry = 0.0f;
    const int g16 = lane >> 4, tj = (lane & 15) >> 2, tc = lane & 3;
    v4u vn[4]; bf16x8v kn[4];
#define SB_FETCH(kb_) do { _Pragma("unroll") for (int i = 0; i < 4; ++i) { const int p = lane + 64 * i, row = p >> 3, ch = p & 7; vn[i] = *(const v4u*)(PS + 512 + (size_t)((kb_) + row) * PBW + 8 * ch); } \
        _Pragma("unroll") for (int ks = 0; ks < 4; ++ks) kn[ks] = *(const bf16x8v*)(PS + 256 + (size_t)((kb_) + r32) * PBW + 16 * ks + 8 * hi); } while (0)
    SB_FETCH(t0);
    for (int kb0 = t0; kb0 >= 0; kb0 -= 32) {
#pragma unroll
        for (int i = 0; i < 4; ++i) { const int p = lane + 64 * i, row = p >> 3, ch = p & 7; *(LAS v4u*)(vl + row * SBV_PITCH + 16 * ch) = vn[i]; }
        f32x16 st;
#pragma unroll
        for (int r = 0; r < 16; ++r) st[r] = 0.0f;
        { bf16x8v ka[4];
#pragma unroll
          for (int ks = 0; ks < 4; ++ks) ka[ks] = kn[ks];
          if (kb0 >= 32) SB_FETCH(kb0 - 32);
#pragma unroll
          for (int ks = 0; ks < 4; ++ks) st = __builtin_amdgcn_mfma_f32_32x32x16_bf16(ka[ks], qf[ks], st, 0, 0, 0);
          asm volatile("" :: "v"(ka[0]), "v"(ka[1]), "v"(ka[2]), "v"(ka[3]), "v"(st)); }
        float sp[16]; const bool diag = (kb0 == t0);
#pragma unroll
        for (int r = 0; r < 16; ++r) { const float zl = st[r]; float s = (zl > 30.0f) ? zl : __builtin_amdgcn_logf(1.0f + __builtin_amdgcn_exp2f(zl));
            if (diag && ((r & 3) + 8 * (r >> 2) + 4 * hi >= r32)) s = 0.0f;
            sp[r] = s; }
        float G[4], Gp[4], suf[4];
#pragma unroll
        for (int q = 0; q < 4; ++q) { G[q] = (sp[4 * q] + sp[4 * q + 1]) + (sp[4 * q + 2] + sp[4 * q + 3]); Gp[q] = lane32_swap(G[q]); }
        suf[3] = 0.0f; suf[2] = G[3] + Gp[3]; suf[1] = suf[2] + (G[2] + Gp[2]); suf[0] = suf[1] + (G[1] + Gp[1]);
        const float tot = suf[0] + (G[0] + Gp[0]);
        pg8::u32x4 pw0, pw1;
        float av[16];
#pragma unroll
        for (int q = 0; q < 4; ++q) { float run = carry + suf[q] + (hi == 0 ? Gp[q] : 0.0f);
#pragma unroll
            for (int i = 3; i >= 0; --i) { const int r = 4 * q + i; const float la = (st[r] - sp[r]) - run; float a = __builtin_amdgcn_exp2f(la);
                if (diag && ((r & 3) + 8 * (r >> 2) + 4 * hi >= r32)) a = 0.0f;
                av[r] = a; run += sp[r]; } }
        pw0.x = pg8::cvt_pk_bf16(av[0], av[1]); pw0.y = pg8::cvt_pk_bf16(av[2], av[3]); pw0.z = pg8::cvt_pk_bf16(av[4], av[5]); pw0.w = pg8::cvt_pk_bf16(av[6], av[7]);
        pw1.x = pg8::cvt_pk_bf16(av[8], av[9]); pw1.y = pg8::cvt_pk_bf16(av[10], av[11]); pw1.z = pg8::cvt_pk_bf16(av[12], av[13]); pw1.w = pg8::cvt_pk_bf16(av[14], av[15]);
        const bf16x8v pa0 = __builtin_bit_cast(bf16x8v, pw0), pa1 = __builtin_bit_cast(bf16x8v, pw1);
        LDS_WAIT();
#pragma unroll
        for (int s = 0; s < 2; ++s)
#pragma unroll
            for (int nb = 0; nb < 2; ++nb) {
                LAS unsigned char* a1 = vl + (16 * s + 4 * (g16 >> 1) + tj) * SBV_PITCH + (32 * nb + 16 * (g16 & 1) + 4 * tc) * 2;
                const s16x4v r1 = __builtin_bit_cast(s16x4v, __builtin_amdgcn_ds_read_tr16_b64_v4i16((LAS s16x4v*)a1));
                const s16x4v r2 = __builtin_bit_cast(s16x4v, __builtin_amdgcn_ds_read_tr16_b64_v4i16((LAS s16x4v*)(a1 + 8 * SBV_PITCH)));
                const bf16x8v bv = {r1[0], r1[1], r1[2], r1[3], r2[0], r2[1], r2[2], r2[3]};
                if (nb == 0) o0 = __builtin_amdgcn_mfma_f32_32x32x16_bf16(s ? pa1 : pa0, bv, o0, 0, 0, 0); else o1 = __builtin_amdgcn_mfma_f32_32x32x16_bf16(s ? pa1 : pa0, bv, o1, 0, 0, 0);
                asm volatile("" :: "v"(bv), "v"(pa0), "v"(pa1), "v"(o0), "v"(o1)); }
        LDS_WAIT();
        carry += tot;
        if (__all(carry > 150.0f)) break;
    }
#undef SB_FETCH
    bf16* YS = (bf16*)((float*)(A.ws + WS_YO) + 3 * YO_STRIDE) + ((size_t)b * SEQ + t0) * 256 + h * 64 + r32;
#pragma unroll
    for (int r = 0; r < 16; ++r) { const int qo = (r & 3) + 8 * (r >> 2) + 4 * hi; YS[(size_t)qo * 256] = (bf16)f2bf(o0[r]); YS[(size_t)qo * 256 + 32] = (bf16)f2bf(o1[r]); }
}

__device__ __forceinline__ void dsa_scores_mfma(ARef A, const WI& w) {
    const _Float16* QIH = (const _Float16*)(A.ws + WS_DQI); const _Float16* KIH = (const _Float16*)(A.ws + WS_DKI);
    const float* DW = (const float*)(A.ws + WS_DW); _Float16* SC = (_Float16*)(A.ws + WS_SC);
    const int col = w.lane & 15, q4 = w.lane >> 4;
    for (int u = w.gw; u < 2048; u += w.NGW) {
        const int pi = u >> 1, par = u & 1, b = pi >> 7, p = pi & 127;
#pragma unroll 1
        for (int side = 0; side < 2; ++side) {
            const int qb = side ? 255 - p : p; const size_t m0 = (size_t)b * SEQ + 16 * qb;
            f16x8 bq[8];
#pragma unroll
            for (int h = 0; h < 8; ++h) bq[h] = *(const f16x8*)(QIH + (m0 + col) * 256 + h * 32 + 8 * q4);
            const float* dw = DW + (m0 + col) * 8; const f32x4 wa = *(const f32x4*)dw, wb = *(const f32x4*)(dw + 4);
            _Float16* srow = SC + (m0 + col) * SEQ + 4 * q4;
            const _Float16* kbase = KIH + ((size_t)b * SEQ + col) * 32 + 8 * q4;
            for (int kq = par; 4 * kq <= qb; kq += 2) {
                f16x8 ak[4];
#pragma unroll
                for (int q = 0; q < 4; ++q) { const int kb = 4 * kq + q; ak[q] = *(const f16x8*)(kbase + (size_t)(kb <= qb ? kb : qb) * 16 * 32); }
#pragma unroll
                for (int q = 0; q < 4; ++q) { const int kb = 4 * kq + q;
                    if (kb <= qb) {
                        f32x4 acc = {0.f, 0.f, 0.f, 0.f};
#pragma unroll
                        for (int h = 0; h < 8; ++h) { const f32x4 c = __builtin_amdgcn_mfma_f32_16x16x32_f16(ak[q], bq[h], (f32x4){0.f, 0.f, 0.f, 0.f}, 0, 0, 0); const float wv = (h < 4) ? wa[h] : wb[h - 4];
                            acc.x += wv * fmaxf(c.x, 0.f); acc.y += wv * fmaxf(c.y, 0.f); acc.z += wv * fmaxf(c.z, 0.f); acc.w += wv * fmaxf(c.w, 0.f); }
                        h4v hs; hs.x = (_Float16)acc.x; hs.y = (_Float16)acc.y; hs.z = (_Float16)acc.z; hs.w = (_Float16)acc.w; *(h4v*)(srow + 16 * kb) = hs; } }
            }
        }
    }
}

__device__ __forceinline__ int wave_total_i(int v) {
    v += __builtin_amdgcn_mov_dpp(v, 0xB1, 0xF, 0xF, true);
    v += __builtin_amdgcn_mov_dpp(v, 0x4E, 0xF, 0xF, true);
    v += __builtin_amdgcn_mov_dpp(v, 0x141, 0xF, 0xF, true);
    v += __builtin_amdgcn_mov_dpp(v, 0x140, 0xF, 0xF, true);
    return __builtin_amdgcn_readlane(v, 0) + __builtin_amdgcn_readlane(v, 16) + __builtin_amdgcn_readlane(v, 32) + __builtin_amdgcn_readlane(v, 48);
}
__device__ __forceinline__ unsigned score_key(float f) { const unsigned bits = __float_as_uint(f); return (bits & 0x80000000u) ? ~bits : (bits | 0x80000000u); }
constexpr int VST_PITCH = 144;
typedef unsigned short u16;
__device__ __forceinline__ void dsa_load_scores(ARef A, int m, int lane, v4u (&sv)[8]) {
    const int n = (m & (SEQ - 1)) + 1; const _Float16* sc = (const _Float16*)(A.ws + WS_SC) + (size_t)m * SEQ + 8 * lane;
#pragma unroll
    for (int c = 0; c < 8; ++c) { if (512 * c < n) sv[c] = *(const v4u*)(sc + 512 * c); else sv[c] = (v4u){0u, 0u, 0u, 0u}; }
}
__device__ __forceinline__ unsigned score_key16(unsigned x) { return ((x & 0x80000000u) ? ~x : (x | 0x80000000u)) & 0xffff0000u; }
__device__ __forceinline__ void dsa_select(ARef A, int m, int n, int lane_in, LAS u16* slist, LAS unsigned* bk) {
    int lane = lane_in; asm volatile("" : "+v"(lane));
    (void)bk;
    if (n <= 256) {
#pragma unroll
        for (int c = 0; c < 4; ++c) { const int idx = lane + 64 * c; slist[idx] = (u16)((idx < n) ? idx : 0); }
        return;
    }
    v4u sv[8]; dsa_load_scores(A, m, lane, sv);
    unsigned u[64];
#pragma unroll
    for (int c = 0; c < 8; ++c)
#pragma unroll
        for (int i = 0; i < 8; ++i) { const unsigned wd = sv[c][i >> 1]; u[8 * c + i] = (512 * c + 8 * lane + i < n) ? score_key16((i & 1) ? wd : (wd << 16)) : 0u; }
    unsigned T = 0u;
    for (int bit = 31; bit >= 16; --bit) { const unsigned cand = T | (1u << bit); int cnt = 0;
#pragma unroll
        for (int c = 0; c < 8; ++c) { if (512 * c < n) {
#pragma unroll
            for (int j = 8 * c; j < 8 * c + 8; ++j) cnt += (u[j] >= cand) ? 1 : 0; } }
        if (wave_total_i(cnt) >= 256) T = cand; }
    unsigned long long gtb = 0ull, eqb = 0ull;
#pragma unroll
    for (int c = 0; c < 8; ++c) { if (512 * c < n) {
#pragma unroll
        for (int j = 8 * c; j < 8 * c + 8; ++j) { gtb |= (unsigned long long)((u[j] > T) ? 1u : 0u) << j; eqb |= (unsigned long long)((u[j] == T) ? 1u : 0u) << j; } } }
    const int tgt = wave_total_i(__popcll(gtb)), teq = wave_total_i(__popcll(eqb));
    unsigned long long selb = gtb | eqb;
    if (tgt + teq > 256) {
        const int take = 256 - tgt; int lo = 0;
        for (int bit = 11; bit >= 0; --bit) { const int cand = lo | (1 << bit); const int J8 = cand >> 9; int ni = (cand & 511) - 8 * lane; ni = ni < 0 ? 0 : (ni > 8 ? 8 : ni);
            const int jc = 8 * J8 + ni; const unsigned long long msk = (jc >= 64) ? ~0ull : ((1ull << jc) - 1ull);
            if (wave_total_i(__popcll(eqb & msk)) < take) lo = cand; }
        { const int cand = lo + 1; const int J8 = cand >> 9; int ni = (cand & 511) - 8 * lane; ni = ni < 0 ? 0 : (ni > 8 ? 8 : ni);
          const int jc = (cand >= SEQ) ? 64 : 8 * J8 + ni; const unsigned long long msk = (jc >= 64) ? ~0ull : ((1ull << jc) - 1ull); selb = gtb | (eqb & msk); }
    }
    const int mine = __popcll(selb); int off = mine;
#pragma unroll
    for (int d = 1; d < 64; d <<= 1) { const int y = __shfl_up(off, d); if (lane >= d) off += y; }
    off -= mine;
    while (selb) { const int j = __builtin_ctzll(selb); selb &= selb - 1ull; slist[off] = (u16)(512 * (j >> 3) + 8 * lane + (j & 7)); ++off; }
}
__device__ __forceinline__ void dsa_attend(ARef A, int m, int lane_in, const LAS u16* slist, LAS unsigned char* vbuf) {
    int lane = lane_in; asm volatile("" : "+v"(lane));
    const int b = m >> 12, t = m & (SEQ - 1), n = t + 1, nsel = n < 256 ? n : 256, col = lane & 15, q4 = lane >> 4;
    const bf16* DKB = (const bf16*)(A.ws + WS_DKB) + (size_t)b * SEQ * 64; const bf16* DVB = (const bf16*)(A.ws + WS_DVB) + (size_t)b * SEQ * 64;
    const int vrow = lane >> 3, vpc = lane & 7;
    bf16x8v bq0 = {0, 0, 0, 0, 0, 0, 0, 0}, bq1 = {0, 0, 0, 0, 0, 0, 0, 0};
    if (col < 4) { const bf16* qp = (const bf16*)(A.ws + WS_DQ) + (size_t)m * 256 + col * 64 + 8 * q4; bq0 = *(const bf16x8v*)qp; bq1 = *(const bf16x8v*)(qp + 32); }
    f32x4 lg[16];
#pragma unroll
    for (int hb = 0; hb < 2; ++hb) {
        bf16x8v a0[8], a1[8];
#pragma unroll
        for (int k = 0; k < 8; ++k) { const int s = slist[16 * (8 * hb + k) + col]; const bf16* kr = DKB + (size_t)s * 64 + 8 * q4; a0[k] = *(const bf16x8v*)kr; a1[k] = *(const bf16x8v*)(kr + 32); }
#pragma unroll
        for (int k = 0; k < 8; ++k) { const f32x4 c = __builtin_amdgcn_mfma_f32_16x16x32_bf16(a0[k], bq0, (f32x4){0.f, 0.f, 0.f, 0.f}, 0, 0, 0); lg[8 * hb + k] = __builtin_amdgcn_mfma_f32_16x16x32_bf16(a1[k], bq1, c, 0, 0, 0); }
        __builtin_amdgcn_sched_barrier(0);
    }
    if (nsel < 256) {
#pragma unroll
        for (int kb = 0; kb < 16; ++kb)
#pragma unroll
            for (int r = 0; r < 4; ++r) if (16 * kb + 4 * q4 + r >= nsel) lg[kb][r] = -INFINITY; }
    v4u vr[4];
#pragma unroll
    for (int i = 0; i < 4; ++i) { const int s = slist[vrow + 8 * i]; vr[i] = *(const v4u*)(DVB + (size_t)s * 64 + 8 * vpc); }
    float mx = -INFINITY;
#pragma unroll
    for (int kb = 0; kb < 16; ++kb) mx = fmaxf(fmaxf(mx, fmaxf(lg[kb].x, lg[kb].y)), fmaxf(lg[kb].z, lg[kb].w));
    mx = fmaxf(mx, __shfl_xor(mx, 16)); mx = fmaxf(mx, __shfl_xor(mx, 32));
    float sm = 0.f;
#pragma unroll
    for (int kb = 0; kb < 16; ++kb) { lg[kb].x = __builtin_amdgcn_exp2f(lg[kb].x - mx); lg[kb].y = __builtin_amdgcn_exp2f(lg[kb].y - mx); lg[kb].z = __builtin_amdgcn_exp2f(lg[kb].z - mx); lg[kb].w = __builtin_amdgcn_exp2f(lg[kb].w - mx); sm += (lg[kb].x + lg[kb].y) + (lg[kb].z + lg[kb].w); }
    sm += __shfl_xor(sm, 16); sm += __shfl_xor(sm, 32);
    const float inv = 1.0f / sm;
    bf16x8v pa[8];
#pragma unroll
    for (int i = 0; i < 8; ++i) { const f32x4 x = lg[2 * i] * inv, y = lg[2 * i + 1] * inv;
        pg8::u32x4 wv; wv.x = pg8::cvt_pk_bf16(x.x, x.y); wv.y = pg8::cvt_pk_bf16(x.z, x.w); wv.z = pg8::cvt_pk_bf16(y.x, y.y); wv.w = pg8::cvt_pk_bf16(y.z, y.w);
        pa[i] = __builtin_bit_cast(bf16x8v, wv); }
    f32x4 o[4];
#pragma unroll
    for (int nb = 0; nb < 4; ++nb) o[nb] = (f32x4){0.f, 0.f, 0.f, 0.f};
    const int tj = col >> 2, tc = col & 3;
#pragma unroll
    for (int c = 0; c < 8; ++c) {
        LAS unsigned char* vb = vbuf + (c & 1) * (32 * VST_PITCH);
#pragma unroll
        for (int i = 0; i < 4; ++i) *(LAS v4u*)(vb + (vrow + 8 * i) * VST_PITCH + 16 * vpc) = vr[i];
        if (c < 7) {
#pragma unroll
            for (int i = 0; i < 4; ++i) { const int s = slist[32 * (c + 1) + vrow + 8 * i]; vr[i] = *(const v4u*)(DVB + (size_t)s * 64 + 8 * vpc); } }
        LDS_WAIT();
#pragma unroll
        for (int nb = 0; nb < 4; ++nb) {
            LAS unsigned char* a1 = vb + (4 * q4 + tj) * VST_PITCH + (16 * nb + 4 * tc) * 2;
            const s16x4v r1 = __builtin_bit_cast(s16x4v, __builtin_amdgcn_ds_read_tr16_b64_v4i16((LAS s16x4v*)a1));
            const s16x4v r2 = __builtin_bit_cast(s16x4v, __builtin_amdgcn_ds_read_tr16_b64_v4i16((LAS s16x4v*)(a1 + 16 * VST_PITCH)));
            const bf16x8v bv = {r1[0], r1[1], r1[2], r1[3], r2[0], r2[1], r2[2], r2[3]};
            o[nb] = __builtin_amdgcn_mfma_f32_16x16x32_bf16(pa[c], bv, o[nb], 0, 0, 0); }
    }
    LDS_WAIT();
    if (lane < 16) { bf16* YD = (bf16*)((float*)(A.ws + WS_YO) + 2 * YO_STRIDE) + (size_t)m * 256;
#pragma unroll
        for (int nb = 0; nb < 4; ++nb) { YD[16 * nb + lane] = (bf16)f2bf(o[nb].x); YD[64 + 16 * nb + lane] = (bf16)f2bf(o[nb].y); YD[128 + 16 * nb + lane] = (bf16)f2bf(o[nb].z); YD[192 + 16 * nb + lane] = (bf16)f2bf(o[nb].w); } }
}
constexpr int DSA_GR = 1;
__device__ __forceinline__ int dsa_row_of(int batch, int gi, int r) { const int idx = DSA_GR * gi + r, h = idx >> 1; return batch * SEQ + ((idx & 1) ? (SEQ - 1 - h) : h); }
__device__ __forceinline__ void dsa_wave(ARef A, const WI& w, LAS unsigned char* wl, int qi, int l, int skip = 0) {
    LAS u16* lists = (LAS u16*)wl; LAS unsigned char* vbuf = wl + 4096; LAS unsigned* bk = (LAS unsigned*)vbuf;
#pragma unroll 1
    for (int kb = 0; kb < NB; ++kb) {
        const int batch = (w.bx + kb) & (NB - 1);
        unsigned* head = (unsigned*)(A.ws + WS_CTL) + CW_DSAQ + 128 * qi + 16 * batch;
        int graw = 0; if (w.lane == 0) graw = (int)atomicAdd(head, 1u);
        for (;;) {
            const int g = __builtin_amdgcn_readfirstlane(graw);
            if (g >= 11 * (SEQ / 8)) break;
            graw = 0; if (w.lane == 0) graw = (int)atomicAdd(head, 1u);
            const int per = g / 11, pos = g - 11 * per;
            if (pos >= 8) { if (!(skip & 4)) moe_convert_chunk(A, l, batch * 1536 + 3 * per + (pos - 8), w.lane, (LAS float*)vbuf); continue; }
            if (skip & 2) continue;
            const int gi = 8 * per + pos;
            { const int m = dsa_row_of(batch, gi, 0), n = (m & (SEQ - 1)) + 1; dsa_select(A, m, n, w.lane, lists, bk); }
            LDS_WAIT();
            if (!(skip & 1)) dsa_attend(A, dsa_row_of(batch, gi, 0), w.lane, lists, vbuf);
        }
    }
}

__device__ __forceinline__ f32x4 head_norm4(f32x4 y, float eps, f32x4 g) {
    const float mean = grp16_sum(sum4(y)) * (1.0f / 64.0f); const f32x4 yc = y - mean;
    const float var = grp16_sum(dot4(yc, yc)) * (1.0f / 64.0f); return yc * (1.0f / sqrtf(var + eps)) * g;
}
template <bool BF> __device__ __forceinline__ f32x4 state_corr(const LAS float* sl, int hh, int r16, const void* pv) {
    const LAS float* r0 = sl + (hh * 64 + 4 * r16) * 64; const int x0 = (4 * r16) & 15;
    f32x4 out = {0.f, 0.f, 0.f, 0.f};
#pragma unroll 2
    for (int k8 = 0; k8 < 8; ++k8) {
        f32x4 pa, pb;
        if (BF) { const v4u x = ((const v4u*)pv)[k8]; pa = (f32x4){bf_lo(x.x), bf_hi(x.x), bf_lo(x.y), bf_hi(x.y)}; pb = (f32x4){bf_lo(x.z), bf_hi(x.z), bf_lo(x.w), bf_hi(x.w)}; }
        else { pa = ((const f32x4*)pv)[2 * k8]; pb = ((const f32x4*)pv)[2 * k8 + 1]; }
#pragma unroll
        for (int i = 0; i < 4; ++i) { const LAS float* rowp = r0 + i * 64; const int xs = (x0 + i) & 15;
            out[i] += dot4(*(const LAS f32x4*)(rowp + 4 * ((2 * k8) ^ xs)), pa) + dot4(*(const LAS f32x4*)(rowp + 4 * ((2 * k8 + 1) ^ xs)), pb); }
    }
    return out;
}
__device__ __forceinline__ void post_row(ARef A, int l, int m, int lane, const LAS float* slw, const LAS float* slr) {
    const float* YO = (const float*)(A.ws + WS_YO); const float* RWA = (const float*)(A.ws + WS_RWA);
    bf16* MX = (bf16*)(A.ws + WS_MIX) + (size_t)m * DM; const int c4 = 4 * lane, hh = lane >> 4, r16 = lane & 15; const size_t o = (size_t)m * 256 + c4;
    { f32x4 y = *(const f32x4*)(YO + o) + state_corr<true>(slr, hh, r16, (const bf16*)(A.ws + WS_PTR) + (size_t)m * 256 + hh * 64);
      y = head_norm4(y, 1e-5f, *(const f32x4*)(A.in[I_RETGN] + l * 256 + c4));
      const v2u gw_ = *(const v2u*)((const bf16*)(A.ws + WS_PB) + (size_t)m * PBW + 768 + c4); const f32x4 g = {bf_lo(gw_.x), bf_hi(gw_.x), bf_lo(gw_.y), bf_hi(gw_.y)};
#pragma unroll
      for (int i = 0; i < 4; ++i) y[i] *= g[i] * sigm(g[i]);
      v2u w; w.x = pk2(y.x, y.y); w.y = pk2(y.z, y.w); *(v2u*)(MX + c4) = w; }
    { f32x4 y = *(const f32x4*)(YO + YO_STRIDE + o) + state_corr<false>(slw, hh, r16, (const float*)(A.ws + WS_PT) + (size_t)m * 256 + hh * 64);
      y = head_norm4(y, 64e-5f, *(const f32x4*)(A.in[I_LN] + l * 256 + c4));
      y = (y + *(const f32x4*)(RWA + 7 * RWA_STRIDE + o)) * *(const f32x4*)(RWA + 6 * RWA_STRIDE + o);
      v2u w; w.x = pk2(y.x, y.y); w.y = pk2(y.z, y.w); *(v2u*)(MX + 256 + c4) = w; }
    { f32x4 y = *(const f32x4*)(YO + 2 * YO_STRIDE + o); const float r = 1.0f / sqrtf(wave_sum(dot4(y, y)) * (1.0f / 256.0f) + 1e-5f);
      y = y * r * *(const f32x4*)(A.in[I_DONORM] + l * 256 + c4);
      v2u w; w.x = pk2(y.x, y.y); w.y = pk2(y.z, y.w); *(v2u*)(MX + 512 + c4) = w; }
    { f32x4 y = *(const f32x4*)(YO + 3 * YO_STRIDE + o); const float r = 1.0f / sqrtf(wave_sum(dot4(y, y)) * (1.0f / 256.0f) + 1e-5f);
      y = y * r * *(const f32x4*)(A.in[I_SONORM] + l * 256 + c4);
      v2u w; w.x = pk2(y.x, y.y); w.y = pk2(y.z, y.w); *(v2u*)(MX + 768 + c4) = w; }
}
__device__ __forceinline__ void ph_post(ARef A, const WI& w, int l) {
    LAS float* slw = (LAS float*)w.lds; LAS float* slr = slw + 16384;
    for (int u = w.vcu; u < NB * NCH * 2; u += w.G) {
        const int b = u >> 5, c = (u >> 1) & 15, half = u & 1;
        __syncthreads();
        for (int e = w.tid; e < 4096; e += NWAVES * 64) { const int hh = e >> 10, v = (e >> 4) & 63, k4 = e & 15;
            const size_t src = ((size_t)((b * 4 + hh) * NCH + c) * 64 + v) * 64 + 4 * k4; const int dst = (hh * 64 + v) * 64 + 4 * (k4 ^ (v & 15));
            *(LAS f32x4*)(slw + dst) = *(const f32x4*)((const float*)(A.ws + WS_SI) + src); *(LAS f32x4*)(slr + dst) = *(const f32x4*)((const float*)(A.ws + WS_SIR) + src); }
        __syncthreads();
        const int tok0 = b * SEQ + c * TCH + half * 128 + w.wave * 16;
        for (int i = 0; i < 16; ++i) post_row(A, l, tok0 + i, w.lane, slw, slr);
    }
}

constexpr int S0_PITCH = 144;
template <int MIXER> __device__ __forceinline__ void post16_head(ARef A, int l, size_t m, int hh, int tk, int fq, const LAS unsigned char* s0) {
    const size_t o = m * 256 + hh * 64 + 8 * fq;
    bf16x8v pb[2];
    if (MIXER == 0) { const bf16* pp = (const bf16*)(A.ws + WS_PTR) + o; pb[0] = *(const bf16x8v*)pp; pb[1] = *(const bf16x8v*)(pp + 32); }
    else { const bf16* pp = (const bf16*)(A.ws + WS_PT) + o; pb[0] = *(const bf16x8v*)pp; pb[1] = *(const bf16x8v*)(pp + 32); }
    f32x4 y[4];
    const bf16* yl = (const bf16*)((const float*)(A.ws + WS_YO) + MIXER * YO_STRIDE) + o;
#pragma unroll
    for (int j = 0; j < 2; ++j) { const v4u x = *(const v4u*)(yl + 32 * j); y[2 * j] = (f32x4){bf_lo(x.x), bf_hi(x.x), bf_lo(x.y), bf_hi(x.y)}; y[2 * j + 1] = (f32x4){bf_lo(x.z), bf_hi(x.z), bf_lo(x.w), bf_hi(x.w)}; }
    const float* gw = ((MIXER == 0) ? A.in[I_RETGN] : A.in[I_LN]) + l * 256 + hh * 64 + 8 * fq;
    f32x4 gn[4], e0[4], e1[4];
#pragma unroll
    for (int mb = 0; mb < 4; ++mb) gn[mb] = *(const f32x4*)(gw + 32 * (mb >> 1) + 4 * (mb & 1));
    if (MIXER == 0) {
#pragma unroll
        for (int j = 0; j < 2; ++j) { const v4u gx = *(const v4u*)((const bf16*)(A.ws + WS_PB) + m * PBW + 768 + hh * 64 + 8 * fq + 32 * j);
            e0[2 * j] = (f32x4){bf_lo(gx.x), bf_hi(gx.x), bf_lo(gx.y), bf_hi(gx.y)}; e0[2 * j + 1] = (f32x4){bf_lo(gx.z), bf_hi(gx.z), bf_lo(gx.w), bf_hi(gx.w)}; }
    } else { const float* RWA = (const float*)(A.ws + WS_RWA);
#pragma unroll
        for (int j = 0; j < 2; ++j) { const v4u bx_ = *(const v4u*)((const bf16*)(RWA + 7 * RWA_STRIDE) + o + 32 * j), gx_ = *(const v4u*)((const bf16*)(RWA + 6 * RWA_STRIDE) + o + 32 * j);
            e0[2 * j] = (f32x4){bf_lo(bx_.x), bf_hi(bx_.x), bf_lo(bx_.y), bf_hi(bx_.y)}; e0[2 * j + 1] = (f32x4){bf_lo(bx_.z), bf_hi(bx_.z), bf_lo(bx_.w), bf_hi(bx_.w)};
            e1[2 * j] = (f32x4){bf_lo(gx_.x), bf_hi(gx_.x), bf_lo(gx_.y), bf_hi(gx_.y)}; e1[2 * j + 1] = (f32x4){bf_lo(gx_.z), bf_hi(gx_.z), bf_lo(gx_.w), bf_hi(gx_.w)}; } }
    const LAS unsigned char* ab = s0 + ((MIXER * 4 + hh) * 64 + 8 * (tk >> 2) + (tk & 3)) * S0_PITCH + 16 * fq;
#pragma unroll
    for (int mb = 0; mb < 4; ++mb)
#pragma unroll
        for (int ks = 0; ks < 2; ++ks) { const bf16x8v af = *(const LAS bf16x8v*)(ab + (32 * (mb >> 1) + 4 * (mb & 1)) * S0_PITCH + 64 * ks); y[mb] = __builtin_amdgcn_mfma_f32_16x16x32_bf16(af, pb[ks], y[mb], 0, 0, 0); }
    float s = (sum4(y[0]) + sum4(y[1])) + (sum4(y[2]) + sum4(y[3])); s += __shfl_xor(s, 16); s += __shfl_xor(s, 32);
    const float mean = s * (1.0f / 64.0f);
#pragma unroll
    for (int mb = 0; mb < 4; ++mb) y[mb] = y[mb] - mean;
    float q = (dot4(y[0], y[0]) + dot4(y[1], y[1])) + (dot4(y[2], y[2]) + dot4(y[3], y[3])); q += __shfl_xor(q, 16); q += __shfl_xor(q, 32);
    const float rs = 1.0f / sqrtf(q * (1.0f / 64.0f) + ((MIXER == 0) ? 1e-5f : 64e-5f));
    bf16* MX = (bf16*)(A.ws + WS_MIX) + m * DM + MIXER * 256 + hh * 64 + 8 * fq;
#pragma unroll
    for (int j = 0; j < 2; ++j) { f32x4 ya = y[2 * j] * rs * gn[2 * j], yb = y[2 * j + 1] * rs * gn[2 * j + 1];
        if (MIXER == 0) {
#pragma unroll
            for (int i = 0; i < 4; ++i) { ya[i] *= e0[2 * j][i] * sigm(e0[2 * j][i]); yb[i] *= e0[2 * j + 1][i] * sigm(e0[2 * j + 1][i]); }
        } else { ya = (ya + e0[2 * j]) * e1[2 * j]; yb = (yb + e0[2 * j + 1]) * e1[2 * j + 1]; }
        v4u wv; wv.x = pk2(ya.x, ya.y); wv.y = pk2(ya.z, ya.w); wv.z = pk2(yb.x, yb.y); wv.w = pk2(yb.z, yb.w); *(v4u*)(MX + 32 * j) = wv; }
}
__device__ __forceinline__ void post16_rms(ARef A, int l, size_t m, int mx, int fq) {
    const bf16* yp = (const bf16*)((const float*)(A.ws + WS_YO) + (size_t)mx * YO_STRIDE) + m * 256 + 8 * fq; const float* gw = ((mx == 2) ? A.in[I_DONORM] : A.in[I_SONORM]) + l * 256 + 8 * fq;
    f32x4 y[16];
#pragma unroll
    for (int j = 0; j < 8; ++j) { const v4u x = *(const v4u*)(yp + 32 * j); y[2 * j] = (f32x4){bf_lo(x.x), bf_hi(x.x), bf_lo(x.y), bf_hi(x.y)}; y[2 * j + 1] = (f32x4){bf_lo(x.z), bf_hi(x.z), bf_lo(x.w), bf_hi(x.w)}; }
    float q = 0.0f;
#pragma unroll
    for (int j = 0; j < 16; ++j) q += dot4(y[j], y[j]);
    q += __shfl_xor(q, 16); q += __shfl_xor(q, 32);
    const float r = 1.0f / sqrtf(q * (1.0f / 256.0f) + 1e-5f);
    bf16* MX = (bf16*)(A.ws + WS_MIX) + m * DM + mx * 256 + 8 * fq;
#pragma unroll
    for (int j = 0; j < 8; ++j) { const f32x4 ya = y[2 * j] * r * *(const f32x4*)(gw + 32 * j), yb = y[2 * j + 1] * r * *(const f32x4*)(gw + 32 * j + 4);
        v4u wv; wv.x = pk2(ya.x, ya.y); wv.y = pk2(ya.z, ya.w); wv.z = pk2(yb.x, yb.y); wv.w = pk2(yb.z, yb.w); *(v4u*)(MX + 32 * j) = wv; }
}
__device__ __forceinline__ void ph_post16(ARef A, const WI& w, int l) {
    LAS unsigned char* s0 = w.lds;
    for (int u = w.vcu; u < NB * NCH * 2; u += w.G) {
        const int b = u >> 5, c = (u >> 1) & 15, half = u & 1;
        __syncthreads();
#pragma unroll 2
        for (int e = w.tid; e < 4096; e += NWAVES * 64) { const int hd = e >> 9, v = (e >> 3) & 63, k8 = e & 7;
            const float* src = (const float*)(A.ws + ((hd < 4) ? WS_SIR : WS_SI)) + ((size_t)((b * 4 + (hd & 3)) * NCH + c) * 64 + v) * 64 + 8 * k8;
            const f32x4 x0 = *(const f32x4*)src, x1 = *(const f32x4*)(src + 4);
            v4u wv; wv.x = pk2(x0.x, x0.y); wv.y = pk2(x0.z, x0.w); wv.z = pk2(x1.x, x1.y); wv.w = pk2(x1.z, x1.w); *(LAS v4u*)(s0 + (hd * 64 + v) * S0_PITCH + 16 * k8) = wv; }
        __syncthreads();
        int lane = w.lane; asm volatile("" : "+v"(lane));
        const int tk = lane & 15, fq = lane >> 4; const size_t m = (size_t)(b * SEQ + c * TCH + half * 128 + w.wave * 16 + tk);
#pragma unroll 1
        for (int hh = 0; hh < 4; ++hh) post16_head<0>(A, l, m, hh, tk, fq, s0);
#pragma unroll 1
        for (int hh = 0; hh < 4; ++hh) post16_head<1>(A, l, m, hh, tk, fq, s0);
#pragma unroll 1
        for (int mx = 2; mx < 4; ++mx) post16_rms(A, l, m, mx, fq);
    }
}

__device__ __forceinline__ float wave_max_f(float v) {
    v = fmaxf(v, __builtin_bit_cast(float, __builtin_amdgcn_mov_dpp(__builtin_bit_cast(int, v), 0xB1, 0xF, 0xF, true)));
    v = fmaxf(v, __builtin_bit_cast(float, __builtin_amdgcn_mov_dpp(__builtin_bit_cast(int, v), 0x4E, 0xF, 0xF, true)));
    v = fmaxf(v, __builtin_bit_cast(float, __builtin_amdgcn_mov_dpp(__builtin_bit_cast(int, v), 0x141, 0xF, 0xF, true)));
    v = fmaxf(v, __builtin_bit_cast(float, __builtin_amdgcn_mov_dpp(__builtin_bit_cast(int, v), 0x140, 0xF, 0xF, true)));
    const int iv = __builtin_bit_cast(int, v);
    return fmaxf(fmaxf(__builtin_bit_cast(float, __builtin_amdgcn_readlane(iv, 0)), __builtin_bit_cast(float, __builtin_amdgcn_readlane(iv, 16))), fmaxf(__builtin_bit_cast(float, __builtin_amdgcn_readlane(iv, 32)), __builtin_bit_cast(float, __builtin_amdgcn_readlane(iv, 48))));
}
__device__ __forceinline__ void router_stage(ARef A, const WI& w, int l) {
    LAS float* rwl = (LAS float*)w.lds; const float* rw = A.in[I_RW] + (size_t)l * DM * 32;
    for (int e = w.tid; e < DM * 8; e += NWAVES * 64) { const int k = e >> 3, c = e & 7; *(LAS f32x4*)(rwl + k * 32 + 4 * (c ^ ((k >> 2) & 7))) = *(const f32x4*)(rw + (size_t)k * 32 + 4 * c); }
    __syncthreads();
}
__device__ __forceinline__ void router_row(ARef A, int l, int m, int lane, LAS unsigned* hist, const LAS float* rwl, LAS int* texp, bool dry = false) {
    const float* XA = (const float*)(A.ws + WS_XA) + (size_t)m * DM; const float* MOD = (const float*)(A.ws + WS_MOD) + (size_t)(l * 8 + (m >> 12)) * 6144;
    f32x4 v[4]; float ss = 0.0f;
#pragma unroll
    for (int j = 0; j < 4; ++j) { v[j] = *(const f32x4*)(XA + 4 * (lane + 64 * j)); ss += dot4(v[j], v[j]); }
    ss = wave_sum(ss); const float rstd = 1.0f / sqrtf(ss * (1.0f / DM) + 1e-5f);
    const float* g = A.in[I_NFFN] + l * DM; const float* scp = MOD + 4 * 1024; const float* shp = MOD + 3 * 1024;
    emit_h_row(v, rstd, g, scp, shp, (bf16*)(A.ws + WS_H) + (size_t)m * DM, lane);
    float p[32];
#pragma unroll
    for (int e = 0; e < 32; ++e) p[e] = 0.0f;
    const int sw = lane & 7;
#pragma unroll 1
    for (int j = 0; j < 4; ++j) { const int k = 4 * (lane + 64 * j);
        const f32x4 h = *(const f32x4*)(XA + k) * rstd * *(const f32x4*)(g + k) * (1.0f + *(const f32x4*)(scp + k)) + *(const f32x4*)(shp + k);
        const LAS float* row = rwl + k * 32;
#pragma unroll
        for (int i = 0; i < 4; ++i) {
#pragma unroll
            for (int q4 = 0; q4 < 8; ++q4) { const f32x4 r = *(const LAS f32x4*)(row + i * 32 + 4 * (q4 ^ sw)); p[4 * q4] += h[i] * r.x; p[4 * q4 + 1] += h[i] * r.y; p[4 * q4 + 2] += h[i] * r.z; p[4 * q4 + 3] += h[i] * r.w; } } }
    float q16[16], q8[8], q4v[4], q2[2], q1;
    { const bool hb = (lane & 32) != 0;
#pragma unroll
      for (int i = 0; i < 16; ++i) { const float mine = hb ? p[16 + i] : p[i], oth = hb ? p[i] : p[16 + i]; q16[i] = mine + __shfl_xor(oth, 32); } }
    { const bool hb = (lane & 16) != 0;
#pragma unroll
      for (int i = 0; i < 8; ++i) { const float mine = hb ? q16[8 + i] : q16[i], oth = hb ? q16[i] : q16[8 + i]; q8[i] = mine + __shfl_xor(oth, 16); } }
    { const bool hb = (lane & 8) != 0;
#pragma unroll
      for (int i = 0; i < 4; ++i) { const float mine = hb ? q8[4 + i] : q8[i], oth = hb ? q8[i] : q8[4 + i]; q4v[i] = mine + __shfl_xor(oth, 8); } }
    { const bool hb = (lane & 4) != 0;
#pragma unroll
      for (int i = 0; i < 2; ++i) { const float mine = hb ? q4v[2 + i] : q4v[i], oth = hb ? q4v[i] : q4v[2 + i]; q2[i] = mine + __shfl_xor(oth, 4); } }
    { const bool hb = (lane & 2) != 0; const float mine = hb ? q2[1] : q2[0], oth = hb ? q2[0] : q2[1]; q1 = mine + __shfl_xor(oth, 2); }
    q1 += __shfl_xor(q1, 1);
    float lv = q1 + A.in[I_RB][l * 32 + (lane >> 1)];
    float tv[4]; int ti[4];
#pragma unroll
    for (int kk = 0; kk < 4; ++kk) { const float mx = wave_max_f(lv); const unsigned long long msk = __ballot(lv == mx); const int e = msk ? (int)(__builtin_ctzll(msk) >> 1) : kk;
        tv[kk] = mx; ti[kk] = e; if ((lane >> 1) == e) lv = -INFINITY; }
    const float e1 = expf(tv[1] - tv[0]), e2 = expf(tv[2] - tv[0]), e3 = expf(tv[3] - tv[0]); const float inv = 1.0f / (1.0f + e1 + e2 + e3);
    if (lane == 0 && !dry) {
        int* TI = (int*)(A.ws + WS_TOPI) + (size_t)m * 4; float* TW = (float*)(A.ws + WS_TOPW) + (size_t)m * 4;
        TI[0] = ti[0]; TI[1] = ti[1]; TI[2] = ti[2]; TI[3] = ti[3]; texp[0] = ti[0]; texp[1] = ti[1]; texp[2] = ti[2]; texp[3] = ti[3]; TW[0] = inv; TW[1] = e1 * inv; TW[2] = e2 * inv; TW[3] = e3 * inv;
        { unsigned* hg = (unsigned*)hist; atomicAdd(hg + ti[0], 1u); atomicAdd(hg + ti[1], 1u); atomicAdd(hg + ti[2], 1u); atomicAdd(hg + ti[3], 1u); }
    }
}
__device__ __forceinline__ void router_stage16(ARef A, const WI& w, int l) {
    LAS unsigned char* rwt = w.lds; const float* rw = A.in[I_RW] + (size_t)l * DM * 32;
    const int k0 = 2 * w.tid;
    const int c = k0 >> 3, kin = (k0 & 7) * 2;
#pragma unroll
    for (int e4 = 0; e4 < 8; ++e4) { const f32x4 a = *(const f32x4*)(rw + (size_t)k0 * 32 + 4 * e4), b = *(const f32x4*)(rw + (size_t)(k0 + 1) * 32 + 4 * e4);
#pragma unroll
        for (int i = 0; i < 4; ++i) { const int e = 4 * e4 + i; const unsigned hi = pg8::cvt_pk_bf16(a[i], b[i]); const float ra = a[i] - bf_lo(hi), rb = b[i] - bf_hi(hi); const unsigned lo = pg8::cvt_pk_bf16(ra, rb);
            const int off = e * 2048 + ((c ^ (e & 15)) * 16) + kin; *(LAS unsigned*)(rwt + off) = hi; *(LAS unsigned*)(rwt + 65536 + off) = lo; } }
    __syncthreads();
}
__device__ __forceinline__ void router16(ARef A, int l, int m0, int lane_in, LAS unsigned* hist, const LAS unsigned char* rwt, LAS int* texp, bool dry) {
    int lane = lane_in; asm volatile("" : "+v"(lane));
    const int tk = lane & 15, q4 = lane >> 4; const size_t m = (size_t)m0 + tk;
    const float* xr = (const float*)(A.ws + WS_XA) + m * DM + 8 * q4; const float* MOD = (const float*)(A.ws + WS_MOD) + (size_t)(l * 8 + (m0 >> 12)) * 6144;
    const float* g = A.in[I_NFFN] + l * DM + 8 * q4; const float* scp = MOD + 4 * 1024 + 8 * q4; const float* shp = MOD + 3 * 1024 + 8 * q4;
    bf16* hrow = (bf16*)(A.ws + WS_H) + m * DM + 8 * q4;
    float ss = 0.0f;
#pragma unroll 16
    for (int ks = 0; ks < 32; ++ks) { const f32x4 a = *(const f32x4*)(xr + 32 * ks), b = *(const f32x4*)(xr + 32 * ks + 4); ss += dot4(a, a) + dot4(b, b); }
    ss += __shfl_xor(ss, 16); ss += __shfl_xor(ss, 32);
    const float rstd = 1.0f / sqrtf(ss * (1.0f / DM) + 1e-5f);
    f32x4 acc[2] = {{0.f, 0.f, 0.f, 0.f}, {0.f, 0.f, 0.f, 0.f}};
    const LAS unsigned char* wrow = rwt + tk * 2048;
#pragma unroll 2
    for (int ks = 0; ks < 32; ++ks) {
        f32x4 h[2];
#pragma unroll
        for (int u = 0; u < 2; ++u) { const int k = 32 * ks + 4 * u; h[u] = *(const f32x4*)(xr + k) * rstd * *(const f32x4*)(g + k) * (1.0f + *(const f32x4*)(scp + k)) + *(const f32x4*)(shp + k); }
        pg8::u32x4 hw, lw;
        hw.x = pg8::cvt_pk_bf16(h[0].x, h[0].y); hw.y = pg8::cvt_pk_bf16(h[0].z, h[0].w); hw.z = pg8::cvt_pk_bf16(h[1].x, h[1].y); hw.w = pg8::cvt_pk_bf16(h[1].z, h[1].w);
        if (!dry) *(pg8::u32x4*)(hrow + 32 * ks) = hw;
        lw.x = pg8::cvt_pk_bf16(h[0].x - bf_lo(hw.x), h[0].y - bf_hi(hw.x)); lw.y = pg8::cvt_pk_bf16(h[0].z - bf_lo(hw.y), h[0].w - bf_hi(hw.y));
        lw.z = pg8::cvt_pk_bf16(h[1].x - bf_lo(hw.z), h[1].y - bf_hi(hw.z)); lw.w = pg8::cvt_pk_bf16(h[1].z - bf_lo(hw.w), h[1].w - bf_hi(hw.w));
        const bf16x8v bh = __builtin_bit_cast(bf16x8v, hw), bl = __builtin_bit_cast(bf16x8v, lw);
        const int coff = ((4 * ks + q4) ^ tk) * 16;
#pragma unroll
        for (int blk = 0; blk < 2; ++blk) { const bf16x8v ah = *(const LAS bf16x8v*)(wrow + blk * 32768 + coff), al = *(const LAS bf16x8v*)(wrow + 65536 + blk * 32768 + coff);
            acc[blk] = __builtin_amdgcn_mfma_f32_16x16x32_bf16(ah, bh, acc[blk], 0, 0, 0); acc[blk] = __builtin_amdgcn_mfma_f32_16x16x32_bf16(ah, bl, acc[blk], 0, 0, 0); acc[blk] = __builtin_amdgcn_mfma_f32_16x16x32_bf16(al, bh, acc[blk], 0, 0, 0); }
    }
    float lv[8]; const float* rb = A.in[I_RB] + l * 32 + 4 * q4;
#pragma unroll
    for (int blk = 0; blk < 2; ++blk)
#pragma unroll
        for (int i = 0; i < 4; ++i) lv[4 * blk + i] = acc[blk][i] + rb[16 * blk + i];
    float tv[4]; int ti[4];
#pragma unroll
    for (int kk = 0; kk < 4; ++kk) {
        float mx = fmaxf(fmaxf(fmaxf(lv[0], lv[1]), fmaxf(lv[2], lv[3])), fmaxf(fmaxf(lv[4], lv[5]), fmaxf(lv[6], lv[7])));
        mx = fmaxf(mx, __shfl_xor(mx, 16)); mx = fmaxf(mx, __shfl_xor(mx, 32));
        int cand = 99;
#pragma unroll
        for (int j = 7; j >= 0; --j) if (lv[j] == mx) cand = 16 * (j >> 2) + 4 * q4 + (j & 3);
        cand = min(cand, __shfl_xor(cand, 16)); cand = min(cand, __shfl_xor(cand, 32));
        if (cand == 99) cand = kk;
        tv[kk] = mx; ti[kk] = cand;
#pragma unroll
        for (int j = 0; j < 8; ++j) if (16 * (j >> 2) + 4 * q4 + (j & 3) == cand) lv[j] = -INFINITY;
    }
    const float e1 = expf(tv[1] - tv[0]), e2 = expf(tv[2] - tv[0]), e3 = expf(tv[3] - tv[0]); const float inv = 1.0f / (1.0f + e1 + e2 + e3);
    if (q4 == 0 && !dry) {
        int* TI = (int*)(A.ws + WS_TOPI) + m * 4; float* TW = (float*)(A.ws + WS_TOPW) + m * 4;
        *(v4u*)TI = (v4u){(unsigned)ti[0], (unsigned)ti[1], (unsigned)ti[2], (unsigned)ti[3]}; *(f32x4*)TW = (f32x4){inv, e1 * inv, e2 * inv, e3 * inv};
        LAS int* tx = texp + tk * 4; tx[0] = ti[0]; tx[1] = ti[1]; tx[2] = ti[2]; tx[3] = ti[3];
        { unsigned* hg = (unsigned*)hist; atomicAdd(hg + ti[0], 1u); atomicAdd(hg + ti[1], 1u); atomicAdd(hg + ti[2], 1u); atomicAdd(hg + ti[3], 1u); }
    }
}
__device__ __forceinline__ void build_expert_table(ARef A, const WI& w, int l) {
    LAS int* tst = (LAS int*)(w.lds + TST_OFF); LAS int* tab = (LAS int*)(w.lds + TAB_OFF); LAS int* cnt = (LAS int*)(w.lds + CNT_OFF);
    if (w.tid == 0) { const unsigned* gc = (const unsigned*)(A.ws + WS_CTL) + CW_GCNT + 64 * l; int acc = 0;
        for (int e = 0; e < 32; ++e) { const int c = (int)__hip_atomic_load(gc + e, RLX_AGENT); cnt[e] = c; tst[e] = acc; acc += (c + 255) >> 8; }
        tst[32] = acc; tab[0] = acc; }
    __syncthreads();
    if (w.tid < 32) { const int e = w.tid; for (int pm = tst[e]; pm < tst[e + 1]; ++pm) tab[1 + pm] = e; }
    __syncthreads();
}
__device__ __forceinline__ void router_lists(ARef A, const WI& w, int l) {
    LAS unsigned* hist = (LAS unsigned*)(w.lds + HIST_OFF); LAS int* base = (LAS int*)(w.lds + BASE_OFF); LAS int* texp = (LAS int*)(w.lds + TEXP_OFF);
    __syncthreads();
    if (w.tid < 32) { base[w.tid] = (int)atomicAdd((unsigned*)(A.ws + WS_CTL) + CW_GCNT + 64 * l + w.tid, hist[w.tid]); hist[w.tid] = 0u; }
    __syncthreads();
    int* LIST = (int*)(A.ws + WS_LIST); int* PW = (int*)(A.ws + WS_POS);
    for (int g16 = w.gw; g16 < MTOK / 16; g16 += w.NGW) {
        const int j = w.lane >> 2, q = w.lane & 3, m = 16 * g16 + j; const int e = texp[(w.wave * 16 + j) * 4 + q]; const int idx = base[e] + (int)atomicAdd((unsigned*)hist + e, 1u);
        LIST[e * LCAP + idx] = m; PW[(size_t)m * 4 + q] = (e << 20) | idx; }
}
__device__ __forceinline__ void combine_row(ARef A, int l, int m, int lane, const LAS int* tst, float gscale = 1.0f, float oscale = 1.0f) {
    float* XA = (float*)(A.ws + WS_XA) + (size_t)m * DM; const float* MOD = (const float*)(A.ws + WS_MOD) + (size_t)(l * 8 + (m >> 12)) * 6144;
    const int* PS = (const int*)(A.ws + WS_POS) + (size_t)m * 4; const float* TW = (const float*)(A.ws + WS_TOPW) + (size_t)m * 4;
    const bf16* YS = (const bf16*)(A.ws + WS_XS);
    f32x4 v[4], acc[4];
#pragma unroll
    for (int j = 0; j < 4; ++j) { v[j] = *(const f32x4*)(XA + 4 * (lane + 64 * j)); acc[j] = (f32x4){0.f, 0.f, 0.f, 0.f}; }
#pragma unroll
    for (int k = 0; k < 4; ++k) { const int pe = PS[k]; const int pos = tst[pe >> 20] * 256 + (pe & 0xFFFFF); const float gt = TW[k] * gscale; const v2u* yr = (const v2u*)(YS + (size_t)pos * DM);
#pragma unroll
        for (int j = 0; j < 4; ++j) { const v2u y = yr[lane + 64 * j]; acc[j] += gt * (f32x4){bf_lo(y.x), bf_hi(y.x), bf_lo(y.y), bf_hi(y.y)}; } }
    float ss = 0.0f;
#pragma unroll
    for (int j = 0; j < 4; ++j) { const int kx = 4 * (lane + 64 * j); v[j] += *(const f32x4*)(MOD + 5 * 1024 + kx) * acc[j]; ss += dot4(v[j], v[j]); }
    ss = wave_sum(ss); const float rstd = 1.0f / sqrtf(ss * (1.0f / DM) + 1e-5f);
    if (l + 1 < NLAYER) {
#pragma unroll
        for (int j = 0; j < 4; ++j) *(f32x4*)(XA + 4 * (lane + 64 * j)) = v[j];
        const float* mb = MOD + 8 * 6144;
        emit_h_row(v, rstd, A.in[I_NMIX] + (l + 1) * DM, mb + 1024, mb, (bf16*)(A.ws + WS_H) + (size_t)m * DM, lane);
    } else {
        float* orow = A.out + (size_t)m * DM; const float* gf = A.in[I_NFINAL];
#pragma unroll
        for (int j = 0; j < 4; ++j) { const int kx = 4 * (lane + 64 * j); *(f32x4*)(orow + kx) = v[j] * (rstd * oscale) * *(const f32x4*)(gf + kx); }
    }
}

constexpr int N_LAUNCHES = MK_N_LAUNCHES;
template <int SEL> __global__ void __launch_bounds__(NWAVES * 64, 2) fwd(ArgsH Ah) {
    extern __shared__ __attribute__((aligned(16))) unsigned char lds[];
    (void)Ah;
    const int wave_s = __builtin_amdgcn_readfirstlane((int)threadIdx.x >> 6);
    auto tid_now = [&]() -> int { int ws_ = wave_s; unsigned z_ = 0u; asm volatile("" : "+s"(ws_), "+s"(z_)); return ws_ * 64 + (int)__builtin_amdgcn_mbcnt_hi(~0u, __builtin_amdgcn_mbcnt_lo(~0u, z_)); };
#define TID_NOW() tid_now()
#define MAKE_WI() WI w; { int tz = TID_NOW(); asm volatile("" : "+v"(tz)); int bz = blockIdx.x, gz = gridDim.x; asm volatile("" : "+s"(bz), "+s"(gz)); \
        w.lds = (LAS unsigned char*)lds; w.tid = tz; w.lane = tz & 63; w.wave = __builtin_amdgcn_readfirstlane(tz >> 6); w.G = gz; w.bx = bz; w.vcu = (gz % 8 == 0) ? (bz % 8) * (gz / 8) + bz / 8 : bz; \
        w.gw = w.vcu * NWAVES + w.wave; w.NGW = gz * NWAVES; }
    { const int t0 = threadIdx.x; for (int u = t0; u < (LDS_BYTES - RING_BYTES) / 4; u += NWAVES * 64) ((LAS unsigned*)((LAS unsigned char*)lds + RING_BYTES))[u] = 0u; }
    __syncthreads();
    int lo, hi; { ARef A0 = *kargs(); lo = A0.ph_lo; hi = A0.ph_hi; }
    if (N_LAUNCHES == 1) { ARef A0 = *kargs(); (void)xcd_barrier_post((unsigned*)((gu32*)(A0.ws + WS_CTL) + CW_BAR), (volatile LAS unsigned*)((LAS unsigned char*)lds + MISC_OFF) + 8, TID_NOW()); }
#define GRID_BAR() do { if (N_LAUNCHES == 1) { ARef Ab = *kargs(); XcdBarrier bar_; bar_.bar = (unsigned*)((gu32*)(Ab.ws + WS_CTL) + CW_BAR); bar_.x = xb_xcc_id(); bar_.st = (volatile LAS unsigned*)((LAS unsigned char*)lds + MISC_OFF) + 8; xcd_barrier(bar_, TID_NOW()); } } while (0)
#ifndef TPROBE
#define TPROBE 0
#endif
#if TPROBE
    unsigned long long tp_acc = 0ull;
#define TP_SCALE tp_scale_of(__hip_atomic_load((unsigned*)(A.ws + WS_CTL) + 3, RLX_AGENT))
    auto tp_scale_of = [](unsigned ticks) -> float { const float us = (float)ticks * 0.01f; if (us < 1.0f) return 1.0f; const float q = exp2f(rintf(log2f(us) * 8.0f) * 0.125f); return 1.0f + sqrtf(q * 1e-5f); };
#define TP_BEGIN(kind) unsigned long long tp_t0 = 0ull; if ((kind) == TPROBE) tp_t0 = __builtin_amdgcn_s_memrealtime();
#define TP_END(kind) if ((kind) == TPROBE) { tp_acc += __builtin_amdgcn_s_memrealtime() - tp_t0; }
#define TP_PUBLISH(l) if ((l) == 1 && w.vcu == 0 && w.tid == 0) __hip_atomic_store((unsigned*)(A.ws + WS_CTL) + 3, (unsigned)tp_acc, RLX_AGENT);
#else
#define TP_SCALE 1.0f
#define TP_PUBLISH(l)
#define TP_BEGIN(kind)
#define TP_END(kind)
#endif
#define IN(k) (lo <= (k) && (k) < hi)
#ifndef PHMASK
#define PHMASK 0xffffffffu
#endif
#define KON(k) if constexpr ((SEL < 0 && ((PHMASK >> (k)) & 1u)) || SEL == (k))
#define BOTH(k) (IN(k) && IN((k) + 1))
#ifndef PROBE_REP
#define PROBE_REP 0
#endif
#if PROBE_REP
    int nrep_ = 2; asm volatile("" : "+s"(nrep_));
#define REP(bit) _Pragma("unroll 1") for (int rep_ = 0; rep_ < (((PROBE_REP >> (bit)) & 1) ? nrep_ : 1); ++rep_)
#else
#define REP(bit) for (int rep_ = 0; rep_ < 1; ++rep_)
#endif
#define ring ((PG8_LAS unsigned char*)lds)

    KON(0) if (IN(0)) { ARef A = *kargs(); MAKE_WI(); REP(0) ph_prologue(A, w); if (BOTH(0)) GRID_BAR(); }

#define LAYER_BODY(l) do {\
        const int pb = 1 + l * NPL; \
        KON(1) if (IN(pb + 0)) { ARef A = *kargs(); MAKE_WI(); TP_BEGIN(1) if (l == 0) { REP(15) { ph_norm1(A, w); small_weights_to_f16(A, w); } if (BOTH(pb + 0)) GRID_BAR(); } TP_END(1) } \
        KON(2) if (IN(pb + 1)) { ARef A = *kargs(); MAKE_WI(); TP_BEGIN(2) \
            pg8::Gemm g{(const bf16*)(A.ws + WS_H), (const bf16*)(A.ws + WS_WIN) + (size_t)l * INCP * DM, MTOK, INCP, DM}; pg8::StaticOrder S; S.init(MTOK, INCP, w.G, w.bx); \
            pg8::EpiProj E{(bf16*)(A.ws + WS_PB), (bf16*)(A.ws + WS_PF)}; \
            REP(1) pg8::gemm_phase<pg8::EpiProj, pg8::StaticOrder, true, true>(ring, g, S, E, w.tid); \
            if (BOTH(pb + 1)) GRID_BAR(); TP_END(2) \
        } \
        KON(3) if (IN(pb + 2)) { ARef A = *kargs(); MAKE_WI(); TP_BEGIN(3) \
            REP(2) { int part_ = rep_ ? ((PROBE_REP >> 21) & 7) : 7; asm volatile("" : "+s"(part_)); for (int g = w.gw; g < MTOK / 16; g += w.NGW) prep16(A, l, 16 * g, w.lane, part_); } \
            if (BOTH(pb + 2)) GRID_BAR(); TP_END(3) \
        } \
        KON(4) if (IN(pb + 3)) { ARef A = *kargs(); MAKE_WI(); TP_BEGIN(4) \
            REP(3) { for (int tk = 2 * w.vcu; tk < 32 * NCH; tk += 2 * w.G) scan_rwkv_task2(A, w, tk); } \
            REP(13) { for (int tk = w.vcu; tk < 32 * NCH / 2; tk += w.G) scan_ret_task(A, w, tk); } \
            REP(4) { LAS unsigned char* vl = w.lds + w.wave * 4608; for (int it = w.gw; it < 32 * 128; it += w.NGW) sb_tile_mfma(A, it, w.lane, vl); } \
            REP(5) dsa_scores_mfma(A, w); \
            if (BOTH(pb + 3)) GRID_BAR(); TP_END(4) \
        } \
        KON(5) if (IN(pb + 4)) { ARef A = *kargs(); MAKE_WI(); TP_BEGIN(5) \
            if (w.bx < 32) prefix_chain(A, w, w.bx); \
            REP(6) { int sk_ = rep_ ? ((PROBE_REP >> 24) & 7) : 0; asm volatile("" : "+s"(sk_)); dsa_wave(A, w, w.lds + w.wave * 13312, l + 2 * rep_, l, sk_); } \
            REP(14) { if (rep_ && w.bx < 32) prefix_chain(A, w, w.bx); } \
            if (BOTH(pb + 4)) GRID_BAR(); TP_END(5) \
        } \
        KON(6) if (IN(pb + 5)) { ARef A = *kargs(); MAKE_WI(); TP_BEGIN(6) \
            REP(7) ph_post16(A, w, l); \
            if (BOTH(pb + 5)) GRID_BAR(); TP_END(6) \
        } \
        KON(7) if (IN(pb + 6)) { ARef A = *kargs(); MAKE_WI(); TP_BEGIN(7) \
            pg8::Gemm g{(const bf16*)(A.ws + WS_MIX), (const bf16*)(A.ws + WS_WOUT) + (size_t)l * DM * DM, MTOK, DM, DM}; pg8::StaticOrder S; S.init(MTOK, DM, w.G, w.bx); \
            pg8::EpiRes E{l == 0 ? A.in[I_X] : (const float*)(A.ws + WS_XA), (float*)(A.ws + WS_XA), (const float*)(A.ws + WS_MOD) + (size_t)l * 8 * 6144 + 2 * 1024}; \
            REP(16) { pg8::EpiRes E2 = E; if (rep_ && l == 1) E2.gate = (const float*)(A.ws + WS_CTL + 512 * 1024); pg8::gemm_phase<pg8::EpiRes, pg8::StaticOrder, true, true>(ring, g, S, E2, w.tid); } \
            if (BOTH(pb + 6)) GRID_BAR(); TP_END(7) \
        } \
        KON(8) if (IN(pb + 7)) { ARef A = *kargs(); MAKE_WI(); TP_BEGIN(8) \
            { LAS unsigned* hist = (LAS unsigned*)(w.lds + HIST_OFF); LAS int* texp = (LAS int*)(w.lds + TEXP_OFF); if (w.tid < 32) hist[w.tid] = 0u; router_stage16(A, w, l); \
            REP(10) { for (int g16 = w.gw; g16 < MTOK / 16; g16 += w.NGW) router16(A, l, 16 * g16, w.lane, hist, (const LAS unsigned char*)w.lds, texp + w.wave * 64, rep_ != 0); } \
            router_lists(A, w, l); } \
            if (BOTH(pb + 7)) GRID_BAR(); TP_END(8) \
        } \
        KON(10) if (IN(pb + 8)) { ARef A = *kargs(); MAKE_WI(); TP_BEGIN(10) \
            build_expert_table(A, w, l); \
            pg8::Gemm g{(const bf16*)(A.ws + WS_H), (const bf16*)(A.ws + WS_W1) + (size_t)l * NEXP * 2048 * DM, MOE_ROWS, NEXP * 2048, DM}; \
            pg8::MoeOrder S{(const PG8_LAS int*)(w.lds + TAB_OFF), 8, w.G, w.vcu, (const PG8_LAS int*)(w.lds + TST_OFF), (const PG8_LAS int*)(w.lds + CNT_OFF), (const int*)(A.ws + WS_LIST)}; \
            pg8::EpiSwiglu E{(bf16*)(A.ws + WS_ACT), A.in[I_MB1] + (size_t)l * NEXP * 2048}; \
            REP(8) { if (PROBE_REP & (1 << 20)) { if (rep_) pg8::gemm_phase<pg8::EpiNull, pg8::MoeOrder, true, true, true>(ring, g, S, pg8::EpiNull{}, w.tid); else pg8::gemm_phase<pg8::EpiSwiglu, pg8::MoeOrder, true, true, true>(ring, g, S, E, w.tid); } else pg8::gemm_phase<pg8::EpiSwiglu, pg8::MoeOrder, true, true, true>(ring, g, S, E, w.tid); } \
            if (BOTH(pb + 8)) GRID_BAR(); TP_END(10) \
        } \
        KON(11) if (IN(pb + 9)) { ARef A = *kargs(); MAKE_WI(); TP_BEGIN(11) \
            build_expert_table(A, w, l); \
            pg8::Gemm g{(const bf16*)(A.ws + WS_ACT), (const bf16*)(A.ws + WS_W2) + (size_t)l * NEXP * DM * DM, MOE_ROWS, NEXP * DM, DM}; \
            pg8::MoeOrder S{(const PG8_LAS int*)(w.lds + TAB_OFF), 4, w.G, w.vcu, (const PG8_LAS int*)(w.lds + TST_OFF), (const PG8_LAS int*)(w.lds + CNT_OFF), (const int*)(A.ws + WS_LIST)}; \
            pg8::EpiY E{(bf16*)(A.ws + WS_XS), A.in[I_MB2] + (size_t)l * NEXP * DM}; \
            REP(9) pg8::gemm_phase<pg8::EpiY, pg8::MoeOrder, true, true>(ring, g, S, E, w.tid); \
            TP_PUBLISH(l) \
            if (BOTH(pb + 9)) GRID_BAR(); TP_END(11) \
        } \
        KON(12) if (IN(pb + 10)) { ARef A = *kargs(); MAKE_WI(); TP_BEGIN(12) \
            build_expert_table(A, w, l); \
            REP(12) for (int m = w.gw; m < MTOK; m += w.NGW) combine_row(A, l, m, w.lane, (const LAS int*)(w.lds + TST_OFF), (rep_ && l == 0) ? 0.0f : 1.0f, TP_SCALE); \
            if (BOTH(pb + 10)) GRID_BAR(); TP_END(12) \
        } \
    } while (0)
    LAYER_BODY(0);
    LAYER_BODY(1);
#undef LAYER_BODY
#undef IN
#undef ring
#undef MAKE_WI
#undef TID_NOW
#undef GRID_BAR
#undef KON
#undef BOTH
}


#if MK_N_LAUNCHES != 1
template <int K> static void launch_one(int grid, hipStream_t stream, const ArgsH& a) {
    static bool attr = false;
    if (!attr) { (void)hipFuncSetAttribute((const void*)fwd<K>, hipFuncAttributeMaxDynamicSharedMemorySize, LDS_BYTES); attr = true; }
    hipLaunchKernelGGL(fwd<K>, dim3(grid), dim3(NWAVES * 64), LDS_BYTES, stream, a);
}
static void launch_kind(int kind, int grid, hipStream_t stream, const ArgsH& a) {
    switch (kind) {
        case 0: launch_one<0>(grid, stream, a); break; case 1: launch_one<1>(grid, stream, a); break; case 2: launch_one<2>(grid, stream, a); break;
        case 3: launch_one<3>(grid, stream, a); break; case 4: launch_one<4>(grid, stream, a); break; case 5: launch_one<5>(grid, stream, a); break;
        case 6: launch_one<6>(grid, stream, a); break; case 7: launch_one<7>(grid, stream, a); break; case 8: launch_one<8>(grid, stream, a); break;
        case 9: launch_one<9>(grid, stream, a); break; case 10: launch_one<10>(grid, stream, a); break; case 11: launch_one<11>(grid, stream, a); break;
        default: launch_one<12>(grid, stream, a); break;
    }
}
#endif
extern "C" void kernel_launch(void* const* d_in, const int* in_sizes, int n_in, void* d_out, int out_size, void* d_ws, size_t ws_size, hipStream_t stream) {
    static int grid = 0;
    if (grid == 0) {
        if (n_in != N_IN || out_size != MTOK * DM || ws_size < WS_END) { fprintf(stderr, "kernel_launch: unexpected shapes (n_in %d, out %d, ws %zu)\n", n_in, out_size, ws_size); grid = -1; return; }
        int dev = 0, cus = 0;
        if (hipGetDevice(&dev) != hipSuccess || hipDeviceGetAttribute(&cus, hipDeviceAttributeMultiprocessorCount, dev) != hipSuccess) { grid = -1; return; }
#if MK_N_LAUNCHES == 1
        {
            if (hipFuncSetAttribute((const void*)fwd<-1>, hipFuncAttributeMaxDynamicSharedMemorySize, LDS_BYTES) != hipSuccess) { fprintf(stderr, "kernel_launch: hipFuncSetAttribute failed\n"); grid = -1; return; }
            int per_cu = 0;
            if (hipOccupancyMaxActiveBlocksPerMultiprocessor(&per_cu, (const void*)fwd<-1>, NWAVES * 64, LDS_BYTES) != hipSuccess || per_cu < 1) fprintf(stderr, "kernel_launch: occupancy query says %d\n", per_cu);
            (void)hipGetLastError();
        }
#endif
        grid = cus;
    }
    if (grid < 0) return;
    (void)in_sizes;
    if (hipMemsetAsync((char*)d_ws + WS_CTL, 0, CTL_ZERO_BYTES, stream) != hipSuccess) return;
    ArgsH a{};
    for (int i = 0; i < N_IN; ++i) a.in[i] = (const float*)d_in[i];
    a.out = (float*)d_out; a.ws = (unsigned char*)d_ws;
    for (int f = 0; f < 44; ++f) a.invf[f] = (f < 32) ? pow(10000.0, -(double)f / 32.0) : (f < 40) ? pow(500000.0, -(double)(f - 32) / 8.0) : pow(500000.0, -(double)(f - 40) / 4.0);
#if MK_N_LAUNCHES == 1
    a.ph_lo = 0; a.ph_hi = NPHASE; a.li = 0;
    hipLaunchKernelGGL(fwd<-1>, dim3(grid), dim3(NWAVES * 64), LDS_BYTES, stream, a);
#else
    {
        for (int p = 0; p < NPHASE; ++p) {
            if (p == 1 + NPL) continue;
            a.ph_lo = p; a.ph_hi = p + 1; a.li = p;
            static const int kinds_[NPL] = {1, 2, 3, 4, 5, 6, 7, 8, 10, 11, 12};
            const int kind = (p == 0) ? 0 : kinds_[(p - 1) % NPL];
            launch_kind(kind, grid, stream, a);
        }
    }
#endif
}
```

```cpp
#include <hip/hip_runtime.h>
#include <cstdio>
#include <cstdint>
#include <cmath>

#ifndef MK_N_LAUNCHES
#define MK_N_LAUNCHES 1
#endif

namespace pg8 {
#define PG8_LAS __attribute__((address_space(3)))
typedef unsigned short bf16_t;
typedef short bf16x8 __attribute__((ext_vector_type(8)));
typedef float f32x4 __attribute__((ext_vector_type(4)));
typedef unsigned u32x4 __attribute__((ext_vector_type(4)));
typedef unsigned u32x2 __attribute__((ext_vector_type(2)));
constexpr int BM = 256, BK = 64, HALF = 128, HTB = HALF * BK * 2  , STAGE_BYTES = 8 * HTB, NXCD = 8, WGM = 8;

__host__ __device__ __forceinline__ int lds_byte(int r, int c) { const int st = (r >> 4) * 2 + (c >> 5), rr = r & 15, cc = c & 31, ob = rr * 64 + cc * 2; return st * 1024 + (ob ^ (((ob >> 9) & 1) << 5)); }
__host__ __device__ __forceinline__ void stage_rc(int b, int& R, int& C) { const int st = b / 1024, sb = b % 1024, swz = sb ^ (((sb >> 9) & 1) << 5); R = (st >> 1) * 16 + swz / 64; C = (st & 1) * 32 + (swz % 64) / 2; }
__host__ __device__ __forceinline__ int perm32(int rho) { const int n = rho >> 4, i = rho & 15; return 8 * (i >> 2) + 4 * n + (i & 3); }

struct Unit { int pm, pn; };
struct Gemm { const bf16_t* A; const bf16_t* Bt; int M, N, K; };

struct StaticOrder {
    int nM, nN, nwg, G, c;
    __host__ __device__ void init(int M, int N, int G_, int c_) { nM = M / BM; nN = N / BM; nwg = nM * nN; G = G_; c = c_; }
    __host__ __device__ bool next(int i, Unit& u) const {
        const long L = (long)i * G + c; if (L >= nwg) return false;
        int wgid = (int)L; { const int q = nwg / NXCD, r = nwg % NXCD, xcd = wgid % NXCD, off = wgid / NXCD; wgid = (xcd < r ? xcd * (q + 1) : r * (q + 1) + (xcd - r) * q) + off; }
        const int nig = WGM * nN, gid = wgid / nig, fm = gid * WGM, gsz = (nM - fm) < WGM ? (nM - fm) : WGM;
        u.pm = fm + ((wgid % nig) % gsz); u.pn = (wgid % nig) / gsz; return true;
    }
    __device__ __forceinline__ void a_ready(const Unit&) const {}
    __device__ __forceinline__ void done(const Unit&) const {}
};
__device__ __forceinline__ unsigned cvt_pk_bf16(float lo, float hi) { unsigned r; asm volatile("v_cvt_pk_bf16_f32 %0, %1, %2" : "=v"(r) : "v"(lo), "v"(hi)); return r; }
struct EpiF32 {
    static constexpr bool PERM = false, AFTER_DRAIN = false;
    float* C; int ldc;
    __device__ __forceinline__ void operator()(const f32x4 (&acc)[2][2][4][2], const Unit& u, int wr, int wc, int fr, int fq) const {
        const int row0 = u.pm * BM + wr * 64 + fr, col0 = u.pn * BM + wc * 32 + 4 * fq;
#pragma unroll
        for (int ai = 0; ai < 2; ++ai)
#pragma unroll
            for (int m = 0; m < 4; ++m) { float* rowp = C + (size_t)(row0 + ai * HALF + m * 16) * ldc + col0;
#pragma unroll
                for (int bj = 0; bj < 2; ++bj)
#pragma unroll
                    for (int n = 0; n < 2; ++n) *(f32x4*)(rowp + bj * HALF + n * 16) = acc[ai][bj][m][n]; }
    }
};
struct EpiNull {
    static constexpr bool PERM = true, AFTER_DRAIN = false;
    __device__ __forceinline__ void operator()(const f32x4 (&acc)[2][2][4][2], const Unit&, int, int, int, int) const {
#pragma unroll
        for (int ai = 0; ai < 2; ++ai)
#pragma unroll
            for (int bj = 0; bj < 2; ++bj) asm volatile("" :: "v"(acc[ai][bj][0][0]), "v"(acc[ai][bj][0][1]), "v"(acc[ai][bj][1][0]), "v"(acc[ai][bj][1][1]), "v"(acc[ai][bj][2][0]), "v"(acc[ai][bj][2][1]), "v"(acc[ai][bj][3][0]), "v"(acc[ai][bj][3][1]));
    }
};
struct EpiProj {
    static constexpr bool PERM = true, AFTER_DRAIN = false;
    bf16_t* PB; bf16_t* PF;
    __device__ __forceinline__ void operator()(const f32x4 (&acc)[2][2][4][2], const Unit& u, int wr, int wc, int fr, int fq) const {
        const int row0 = u.pm * BM + wr * 64 + fr;
        if (u.pn < 7) { const int c0 = u.pn * BM + wc * 32 + 8 * fq;
#pragma unroll
            for (int ai = 0; ai < 2; ++ai)
#pragma unroll
                for (int m = 0; m < 4; ++m) { bf16_t* rowp = PB + (size_t)(row0 + ai * HALF + m * 16) * 1792 + c0;
#pragma unroll
                    for (int bj = 0; bj < 2; ++bj) { const f32x4 v0 = acc[ai][bj][m][0], v1 = acc[ai][bj][m][1];
                        u32x4 w; w.x = cvt_pk_bf16(v0[0], v0[1]); w.y = cvt_pk_bf16(v0[2], v0[3]); w.z = cvt_pk_bf16(v1[0], v1[1]); w.w = cvt_pk_bf16(v1[2], v1[3]);
                        *(u32x4*)(rowp + bj * HALF) = w; } }
        } else { const int c0 = (u.pn - 7) * BM + wc * 32 + 8 * fq;
#pragma unroll
            for (int ai = 0; ai < 2; ++ai)
#pragma unroll
                for (int m = 0; m < 4; ++m) { bf16_t* rowp = PF + (size_t)(row0 + ai * HALF + m * 16) * 1280 + c0;
#pragma unroll
                    for (int bj = 0; bj < 2; ++bj) { const f32x4 v0 = acc[ai][bj][m][0], v1 = acc[ai][bj][m][1];
                        u32x4 w; w.x = cvt_pk_bf16(v0[0], v0[1]); w.y = cvt_pk_bf16(v0[2], v0[3]); w.z = cvt_pk_bf16(v1[0], v1[1]); w.w = cvt_pk_bf16(v1[2], v1[3]);
                        *(u32x4*)(rowp + bj * HALF) = w; } }
        }
    }
};
struct EpiRes {
    static constexpr bool PERM = false, AFTER_DRAIN = false;
    const float* xin; float* xout; const float* gate;
    __device__ __forceinline__ void operator()(const f32x4 (&acc)[2][2][4][2], const Unit& u, int wr, int wc, int fr, int fq) const {
        const int row0 = u.pm * BM + wr * 64 + fr, col0 = u.pn * BM + wc * 32 + 4 * fq;
        const float* gp = gate + (size_t)((u.pm * BM) >> 12) * 6144 + col0;
        f32x4 gv[2][2];
#pragma unroll
        for (int bj = 0; bj < 2; ++bj)
#pragma unroll
            for (int n = 0; n < 2; ++n) gv[bj][n] = *(const f32x4*)(gp + bj * HALF + n * 16);
#pragma unroll
        for (int ai = 0; ai < 2; ++ai)
#pragma unroll
            for (int m = 0; m < 4; ++m) { const size_t ro = (size_t)(row0 + ai * HALF + m * 16) * 1024 + col0;
#pragma unroll
                for (int bj = 0; bj < 2; ++bj)
#pragma unroll
                    for (int n = 0; n < 2; ++n) { const f32x4 xv = *(const f32x4*)(xin + ro + bj * HALF + n * 16); *(f32x4*)(xout + ro + bj * HALF + n * 16) = xv + gv[bj][n] * acc[ai][bj][m][n]; } }
    }
};
__device__ __forceinline__ float swiglu1(float glu, float lin) {
    glu = fminf(glu, 7.0f); lin = fminf(fmaxf(lin, -7.0f), 7.0f);
    return glu * (1.0f / (1.0f + __expf(-1.702f * glu))) * (lin + 1.0f);
}
struct EpiSwiglu {
    static constexpr bool PERM = true, AFTER_DRAIN = false;
    bf16_t* O; const float* b1;
    __device__ __forceinline__ void operator()(const f32x4 (&acc)[2][2][4][2], const Unit& u, int wr, int wc, int fr, int fq) const {
        const int e = u.pn >> 3, j = u.pn & 7, row0 = u.pm * BM + wr * 64 + fr, c0 = 128 * j + wc * 32 + 8 * fq;
        const float* bp = b1 + (size_t)e * 2048 + c0;
        f32x4 bg[2], bl[2];
#pragma unroll
        for (int n = 0; n < 2; ++n) { bg[n] = *(const f32x4*)(bp + 4 * n); bl[n] = *(const f32x4*)(bp + 1024 + 4 * n); }
#pragma unroll
        for (int ai = 0; ai < 2; ++ai)
#pragma unroll
            for (int m = 0; m < 4; ++m) { bf16_t* rowp = O + (size_t)(row0 + ai * HALF + m * 16) * 1024 + c0;
                const f32x4 g0 = acc[ai][0][m][0] + bg[0], g1 = acc[ai][0][m][1] + bg[1], l0 = acc[ai][1][m][0] + bl[0], l1 = acc[ai][1][m][1] + bl[1];
                u32x4 w;
                w.x = cvt_pk_bf16(swiglu1(g0[0], l0[0]), swiglu1(g0[1], l0[1])); w.y = cvt_pk_bf16(swiglu1(g0[2], l0[2]), swiglu1(g0[3], l0[3]));
                w.z = cvt_pk_bf16(swiglu1(g1[0], l1[0]), swiglu1(g1[1], l1[1])); w.w = cvt_pk_bf16(swiglu1(g1[2], l1[2]), swiglu1(g1[3], l1[3]));
                *(u32x4*)rowp = w; }
    }
};
struct EpiY {
    static constexpr bool PERM = true, AFTER_DRAIN = false;
    bf16_t* O; const float* b2;
    __device__ __forceinline__ void operator()(const f32x4 (&acc)[2][2][4][2], const Unit& u, int wr, int wc, int fr, int fq) const {
        const int e = u.pn >> 2, j = u.pn & 3, row0 = u.pm * BM + wr * 64 + fr, c0 = 256 * j + wc * 32 + 8 * fq;
        const float* bp = b2 + (size_t)e * 1024 + c0;
        f32x4 bv[2][2];
#pragma unroll
        for (int bj = 0; bj < 2; ++bj)
#pragma unroll
            for (int n = 0; n < 2; ++n) bv[bj][n] = *(const f32x4*)(bp + bj * HALF + 4 * n);
#pragma unroll
        for (int ai = 0; ai < 2; ++ai)
#pragma unroll
            for (int m = 0; m < 4; ++m) { bf16_t* rowp = O + (size_t)(row0 + ai * HALF + m * 16) * 1024 + c0;
#pragma unroll
                for (int bj = 0; bj < 2; ++bj) { const f32x4 v0 = acc[ai][bj][m][0] + bv[bj][0], v1 = acc[ai][bj][m][1] + bv[bj][1];
                    u32x4 w; w.x = cvt_pk_bf16(v0[0], v0[1]); w.y = cvt_pk_bf16(v0[2], v0[3]); w.z = cvt_pk_bf16(v1[0], v1[1]); w.w = cvt_pk_bf16(v1[2], v1[3]);
                    *(u32x4*)(rowp + bj * HALF) = w; } }
    }
};
struct MoeOrder {
    const PG8_LAS int* tab; int NJ, G, c;
    __device__ __forceinline__ bool next(int i, Unit& u) const {
        const int T = tab[0]; const long L = (long)i * G + c; if (L >= (long)T * NJ) return false;
        const int pm = (int)(L / NJ), j = (int)(L % NJ);
        u.pm = pm; u.pn = tab[1 + pm] * NJ + j; return true;
    }
    __device__ __forceinline__ void a_ready(const Unit&) const {}
    __device__ __forceinline__ void done(const Unit&) const {}
    const PG8_LAS int* tst; const PG8_LAS int* cnt; const int* list;
    __device__ __forceinline__ int row_of(const Unit& u, int r) const { const int e = tab[1 + u.pm], idx = 256 * (u.pm - tst[e]) + r; return (idx < cnt[e]) ? list[e * 32768 + idx] : 0; }
};

template <class Epi, class Sched, bool ALIGN_EPI = false, bool SP2 = false, bool GATHER = false>
__device__ __forceinline__ void gemm_phase(PG8_LAS unsigned char* lds, const Gemm g, const Sched& S, const Epi& E, int tid_in) {
    int tid_ = tid_in; asm volatile("" : "+v"(tid_));
    const int tid = tid_, wid = __builtin_amdgcn_readfirstlane(tid >> 6), lane = tid & 63, wr = wid >> 2, wc = wid & 3, fr = lane & 15, fq = lane >> 4;
    const int K = g.K, nt = K / BK;
    unsigned voffA[2], voffB[2];
#pragma unroll
    for (int i = 0; i < 2; ++i) { int R, C; stage_rc(tid * 16 + i * 8192, R, C); const int Rb = Epi::PERM ? ((R & ~31) + perm32(R & 31)) : R;
        voffA[i] = (unsigned)(R * K + C) * 2u; voffB[i] = (unsigned)(Rb * K + C) * 2u; }
    static_assert(!GATHER || SP2, "gathered A rows: only the two-super-phase loop is wired");
    unsigned cvo[2][2], nvo[2][2];
#define PG8_ROWS(dst, u_) do { _Pragma("unroll") for (int h_ = 0; h_ < 2; ++h_) _Pragma("unroll") for (int i_ = 0; i_ < 2; ++i_) { int R_, C_; stage_rc(tid * 16 + i_ * 8192, R_, C_); dst[h_][i_] = (unsigned)(S.row_of(u_, h_ * HALF + R_) * K + C_) * 2u; } } while (0)
#define PG8_STAGE_A(bufoff, gbase, half, nx) do { if constexpr (GATHER) { unsigned o_[2]; o_[0] = (nx) ? nvo[half][0] : cvo[half][0]; o_[1] = (nx) ? nvo[half][1] : cvo[half][1]; PG8_STAGE(bufoff, gbase, o_); } else { PG8_STAGE(bufoff, (gbase) + (half) * hstep, voffA); } } while (0)
    const size_t kstep = (size_t)(BK * 2);
    const size_t hstep = (size_t)HALF * K * 2;
    const size_t tstep = 2 * hstep;
    const unsigned ldsw = (unsigned)wid * 1024u;
    const int aoff = lds_byte(wr * 64 + fr, fq * 8), boff = lds_byte(wc * 32 + fr, fq * 8);
#define PG8_SA(b, h) (((b) * 2 + (h)) * HTB)
#define PG8_SB(b, h) ((4 + (b) * 2 + (h)) * HTB)
#define PG8_STAGE(bufoff, gbase, voff) do { _Pragma("unroll") for (int _i = 0; _i < 2; ++_i) \
        __builtin_amdgcn_global_load_lds((const unsigned*)((const char*)(gbase) + (voff)[_i]), (PG8_LAS unsigned*)(lds + (bufoff) + ldsw + _i * 8192), 16, 0, 0); } while (0)
#define PG8_LDA(dst, b, h) do { _Pragma("unroll") for (int m = 0; m < 4; ++m) _Pragma("unroll") for (int k = 0; k < 2; ++k) dst[m][k] = *(const PG8_LAS bf16x8*)(lds + PG8_SA(b, h) + aoff + m * 2048 + k * 1024); } while (0)
#define PG8_LDB(dst, b, h) do { _Pragma("unroll") for (int n = 0; n < 2; ++n) _Pragma("unroll") for (int k = 0; k < 2; ++k) dst[n][k] = *(const PG8_LAS bf16x8*)(lds + PG8_SB(b, h) + boff + n * 2048 + k * 1024); } while (0)
#define PG8_MMA(ai, bj, At, Bt) do { __builtin_amdgcn_s_setprio(1); _Pragma("unroll") for (int m = 0; m < 4; ++m) _Pragma("unroll") for (int n = 0; n < 2; ++n) _Pragma("unroll") for (int k = 0; k < 2; ++k) \
        acc[ai][bj][m][n] = __builtin_amdgcn_mfma_f32_16x16x32_bf16(Bt[n][k], At[m][k], acc[ai][bj][m][n], 0, 0, 0); __builtin_amdgcn_s_setprio(0); } while (0)
#define PG8_WAIT_V(n) asm volatile("s_waitcnt vmcnt(" #n ")" ::: "memory")
#define PG8_WAIT_L(n) asm volatile("s_waitcnt lgkmcnt(" #n ")" ::: "memory")
#define PG8_BAR __builtin_amdgcn_s_barrier()
#define PG8_SCHED __builtin_amdgcn_sched_barrier(0)
    Unit cur, nxt; int ui = 0;
    if (!S.next(0, cur)) return;
    f32x4 acc[2][2][4][2];
#pragma unroll
    for (int a = 0; a < 2; ++a)
#pragma unroll
        for (int b = 0; b < 2; ++b)
#pragma unroll
            for (int m = 0; m < 4; ++m)
#pragma unroll
                for (int n = 0; n < 2; ++n) acc[a][b][m][n] = (f32x4){0.f, 0.f, 0.f, 0.f};
    bf16x8 At[4][2], B0[2][2], B1[2][2];
    const char* cA = (const char*)g.A + (GATHER ? (size_t)0 : (size_t)cur.pm * tstep); const char* cB = (const char*)g.Bt + (size_t)cur.pn * tstep;
    if constexpr (GATHER) { PG8_ROWS(cvo, cur); }
    S.a_ready(cur);
    if constexpr (SP2) {
        PG8_STAGE(PG8_SB(0, 0), cB, voffB); PG8_STAGE(PG8_SB(0, 1), cB + hstep, voffB); PG8_STAGE_A(PG8_SA(0, 0), cA, 0, false); PG8_STAGE_A(PG8_SA(0, 1), cA, 1, false);
        if (wr == 1) PG8_BAR;
        PG8_WAIT_V(2); PG8_BAR;
        PG8_STAGE(PG8_SB(1, 0), cB + kstep, voffB); PG8_STAGE_A(PG8_SA(1, 0), cA + kstep, 0, false); PG8_STAGE(PG8_SB(1, 1), cB + hstep + kstep, voffB);
        PG8_WAIT_V(6); PG8_BAR;
    } else {
        PG8_STAGE(PG8_SB(0, 0), cB, voffB); PG8_STAGE(PG8_SA(0, 0), cA, voffA); PG8_STAGE(PG8_SB(0, 1), cB + hstep, voffB); PG8_STAGE(PG8_SA(0, 1), cA + hstep, voffA);
        if (wr == 1) PG8_BAR;
        PG8_WAIT_V(4); PG8_BAR;
        PG8_STAGE(PG8_SB(1, 0), cB + kstep, voffB); PG8_STAGE(PG8_SA(1, 0), cA + kstep, voffA); PG8_STAGE(PG8_SB(1, 1), cB + hstep + kstep, voffB);
        PG8_WAIT_V(6); PG8_BAR;
    }
    for (;;) {
        const bool has_next = S.next(ui + 1, nxt);
        const char* nA = GATHER ? (const char*)g.A : (has_next ? (const char*)g.A + (size_t)nxt.pm * tstep : cA); const char* nB = has_next ? (const char*)g.Bt + (size_t)nxt.pn * tstep : cB;
        if constexpr (GATHER) { if (has_next) { PG8_ROWS(nvo, nxt); } else { _Pragma("unroll") for (int h_ = 0; h_ < 2; ++h_) { nvo[h_][0] = cvo[h_][0]; nvo[h_][1] = cvo[h_][1]; } } }
        for (int t = 0; t < nt; t += 2) {
            const bool last = (t == nt - 2);
            const char* a1 = cA + (size_t)(t + 1) * kstep;
            const char* a2 = last ? nA : cA + (size_t)(t + 2) * kstep; const char* b2 = last ? nB : cB + (size_t)(t + 2) * kstep;
            const char* a3 = a2 + kstep; const char* b3 = b2 + kstep;
            if (last && has_next) S.a_ready(nxt);
            if constexpr (SP2) {
            PG8_LDB(B0, 0, 0); PG8_LDB(B1, 0, 1); PG8_SCHED; PG8_LDA(At, 0, 0); PG8_STAGE_A(PG8_SA(1, 1), a1, 1, false);
            PG8_WAIT_V(8); PG8_WAIT_L(0); PG8_BAR; PG8_MMA(0, 0, At, B0); PG8_MMA(0, 1, At, B1); PG8_BAR; PG8_SCHED;
            PG8_LDA(At, 0, 1); PG8_STAGE(PG8_SB(0, 0), b2, voffB); PG8_STAGE(PG8_SB(0, 1), b2 + hstep, voffB); PG8_STAGE_A(PG8_SA(0, 0), a2, 0, last);
            PG8_WAIT_V(8); PG8_WAIT_L(0); PG8_BAR; PG8_MMA(1, 0, At, B0); PG8_MMA(1, 1, At, B1); PG8_BAR; PG8_SCHED;
            PG8_LDB(B0, 1, 0); PG8_LDB(B1, 1, 1); PG8_SCHED; PG8_LDA(At, 1, 0); PG8_STAGE_A(PG8_SA(0, 1), a2, 1, last);
            PG8_WAIT_V(8); PG8_WAIT_L(0); PG8_BAR; PG8_MMA(0, 0, At, B0); PG8_MMA(0, 1, At, B1); PG8_BAR; PG8_SCHED;
            PG8_LDA(At, 1, 1); PG8_STAGE(PG8_SB(1, 0), b3, voffB); PG8_STAGE(PG8_SB(1, 1), b3 + hstep, voffB); PG8_STAGE_A(PG8_SA(1, 0), a3, 0, last);
            PG8_WAIT_V(8); PG8_WAIT_L(0); PG8_BAR; PG8_MMA(1, 0, At, B0); PG8_MMA(1, 1, At, B1); PG8_BAR; PG8_SCHED;
            } else {
            PG8_LDB(B0, 0, 0); PG8_SCHED; PG8_LDA(At, 0, 0); PG8_STAGE(PG8_SA(1, 1), a1 + hstep, voffA);
            PG8_WAIT_L(8); PG8_BAR; PG8_WAIT_L(0); PG8_MMA(0, 0, At, B0); PG8_BAR; PG8_SCHED;
            PG8_LDB(B1, 0, 1); PG8_STAGE(PG8_SB(0, 0), b2, voffB);
            PG8_BAR; PG8_WAIT_L(0); PG8_MMA(0, 1, At, B1); PG8_BAR;
            PG8_LDA(At, 0, 1); PG8_STAGE(PG8_SA(0, 0), a2, voffA);
            PG8_BAR; PG8_WAIT_L(0); PG8_MMA(1, 0, At, B0); PG8_BAR; PG8_SCHED;
            PG8_STAGE(PG8_SB(0, 1), b2 + hstep, voffB);
            PG8_WAIT_V(6); PG8_BAR; PG8_MMA(1, 1, At, B1); PG8_BAR;
            PG8_LDB(B0, 1, 0); PG8_SCHED; PG8_LDA(At, 1, 0); PG8_STAGE(PG8_SA(0, 1), a2 + hstep, voffA);
            PG8_WAIT_L(8); PG8_BAR; PG8_WAIT_L(0); PG8_MMA(0, 0, At, B0); PG8_BAR; PG8_SCHED;
            PG8_LDB(B1, 1, 1); PG8_STAGE(PG8_SB(1, 0), b3, voffB);
            PG8_BAR; PG8_WAIT_L(0); PG8_MMA(0, 1, At, B1); PG8_BAR;
            PG8_LDA(At, 1, 1); PG8_STAGE(PG8_SA(1, 0), a3, voffA);
            PG8_BAR; PG8_WAIT_L(0); PG8_MMA(1, 0, At, B0); PG8_BAR; PG8_SCHED;
            PG8_STAGE(PG8_SB(1, 1), b3 + hstep, voffB);
            PG8_WAIT_V(6); PG8_BAR; PG8_MMA(1, 1, At, B1); PG8_BAR;
            }
        }
        if constexpr (ALIGN_EPI) { if (wr == 0) PG8_BAR; }
        if constexpr (!Epi::AFTER_DRAIN) { E(acc, cur, wr, wc, fr, fq); S.done(cur); }
        if (!has_next) break;
#pragma unroll
        for (int a = 0; a < 2; ++a)
#pragma unroll
            for (int b = 0; b < 2; ++b)
#pragma unroll
                for (int m = 0; m < 4; ++m)
#pragma unroll
                    for (int n = 0; n < 2; ++n) acc[a][b][m][n] = (f32x4){0.f, 0.f, 0.f, 0.f};
        cur = nxt; cA = nA; cB = nB; ++ui;
        if constexpr (GATHER) { _Pragma("unroll") for (int h_ = 0; h_ < 2; ++h_) { cvo[h_][0] = nvo[h_][0]; cvo[h_][1] = nvo[h_][1]; } }
        if constexpr (ALIGN_EPI) { if (wr == 1) PG8_BAR; }
    }
    PG8_WAIT_V(0);
    if constexpr (!ALIGN_EPI) { if (wr == 0) PG8_BAR; }
    PG8_BAR;
    if constexpr (Epi::AFTER_DRAIN) { E.fused(acc, cur, wr, wc, fr, fq, lds, wid, lane); S.done(cur); }
#undef PG8_SA
#undef PG8_SB
#undef PG8_STAGE
#undef PG8_STAGE_A
#undef PG8_ROWS
#undef PG8_LDA
#undef PG8_LDB
#undef PG8_MMA
#undef PG8_WAIT_V
#undef PG8_WAIT_L
#undef PG8_BAR
#undef PG8_SCHED
}
}

constexpr int NWAVES = 8;
constexpr int NB = 8, SEQ = 4096, DM = 1024, MTOK = NB * SEQ, NLAYER = 2;
constexpr int INC = 2984, INCP = 3072;
constexpr int C_RET = 0, C_RW = 1024, C_DSA = 1920, C_SB = 2216;
constexpr int PBW = 1792, PFW = 1280, PB_SB = 1024, PF_DSA = 896;
constexpr int NEXP = 32, MOE_ROWS = MTOK * 4 + NEXP * 256;
constexpr int ROPE_W = 88;
constexpr int NCH = 16, TCH = SEQ / NCH;
constexpr int NPL = 11, NPHASE = 1 + NLAYER * NPL;
enum { I_X = 0, I_C, I_POS, I_ADAW, I_ADAB, I_NMIX, I_NFFN, I_WIN, I_RETGN, I_MU, I_W0, I_W2, I_A0, I_A2, I_G2, I_KK, I_KA, I_RK, I_LN, I_QNORM, I_WQ, I_WQI, I_DONORM, I_SONORM, I_WOUT, I_RW, I_RB, I_MW1, I_MB1, I_MW2, I_MB2, I_NFINAL, N_IN };

constexpr size_t MiB = 1u << 20;
constexpr size_t WS_CTL = 0, CTL_ZERO_BYTES = 1 * MiB;
constexpr size_t WS_MOD = 1 * MiB, WS_ROPE = 2 * MiB, WS_WIN = 14 * MiB, WS_WOUT = 26 * MiB, WS_W1 = 30 * MiB, WS_W2 = 286 * MiB;
constexpr size_t WS_XA = 414 * MiB, WS_H = 542 * MiB, WS_MIX = 606 * MiB, WS_TOPI = 670 * MiB, WS_TOPW = 671 * MiB, WS_POS = 672 * MiB;
constexpr size_t WS_R = 674 * MiB;
constexpr size_t WS_PB = WS_R  , WS_PF = WS_R + 112 * MiB  , WS_RWA = 946 * MiB  , WS_DQ = 1314 * MiB  , WS_DKB = 1330 * MiB  , WS_DVB = 1334 * MiB  , WS_DQI = 1346 * MiB  , WS_DKI = 1394 * MiB  , WS_DW = 1398 * MiB;
constexpr size_t WS_SMALLW = 1338 * MiB  ;
constexpr int SMW_QI = 0, SMW_W2 = 512 * 128, SMW_A2 = SMW_W2 + 256 * 32, SMW_G2 = SMW_A2 + 256 * 32, SMW_LAYER = SMW_G2 + 256 * 64;
constexpr size_t WS_PT = 1362 * MiB  ;
constexpr size_t WS_CH = WS_H  , WS_SI = WS_H + 16 * MiB  , WS_SIR = WS_H + 24 * MiB  ,
                 WS_CHR = WS_H + 32 * MiB  , WS_PTR = WS_H + 40 * MiB  ;
constexpr size_t WS_SQ = WS_MIX  , WS_SK = WS_MIX + 16 * MiB, WS_SV = WS_MIX + 32 * MiB;
constexpr size_t WS_YO = 1400 * MiB  , WS_SC = 1528 * MiB  ;
constexpr size_t WS_XS = WS_R  , WS_ACT = 946 * MiB  ;
constexpr size_t WS_LIST = 2040 * MiB  , WS_END = 2044 * MiB;
constexpr int LCAP = 32768;
static_assert((size_t)MOE_ROWS * 2048 <= 272 * MiB, "moe buffers");
constexpr int CW_TMO = 0, CW_CODE = 1, CW_GCNT = 256  , CW_DSAQ = 1024  , CW_BAR = 4096, CW_BLKCNT = 16384  ;
constexpr int RING_BYTES = 131072, MISC_OFF = RING_BYTES + 320, TST_OFF = RING_BYTES + 1024  , TAB_OFF = RING_BYTES + 2048  , HIST_OFF = RING_BYTES + 5120  , BASE_OFF = RING_BYTES + 5376  , CNT_OFF = RING_BYTES + 5632  , TEXP_OFF = RING_BYTES + 6144  , LDS_BYTES = 147456;

#if defined(__HIP_DEVICE_COMPILE__)
#define GAS __attribute__((address_space(1)))
#define CAS __attribute__((address_space(4)))
#else
#define GAS
#define CAS
#endif
#define LAS __attribute__((address_space(3)))
typedef unsigned short bf16;
typedef unsigned v4u __attribute__((ext_vector_type(4)));
typedef unsigned v2u __attribute__((ext_vector_type(2)));
typedef float f32x4 __attribute__((ext_vector_type(4)));
typedef GAS unsigned gu32;
typedef short bf16x8v __attribute__((ext_vector_type(8)));
typedef short s16x4v __attribute__((ext_vector_type(4)));
typedef _Float16 f16x8 __attribute__((ext_vector_type(8)));
#define RLX_AGENT __ATOMIC_RELAXED, __HIP_MEMORY_SCOPE_AGENT
#define LDS_WAIT() asm volatile("s_waitcnt lgkmcnt(0)" ::: "memory")
#define VM_WAIT() asm volatile("s_waitcnt vmcnt(0)" ::: "memory")
__device__ __forceinline__ unsigned f2bf(float f) { unsigned u = __builtin_bit_cast(unsigned, f); return (u + 0x7fffu + ((u >> 16) & 1u)) >> 16; }
__device__ __forceinline__ unsigned pk2(float lo, float hi) { return f2bf(lo) | (f2bf(hi) << 16); }
__device__ __forceinline__ float bf_lo(unsigned w) { return __builtin_bit_cast(float, w << 16); }
__device__ __forceinline__ float bf_hi(unsigned w) { return __builtin_bit_cast(float, w & 0xffff0000u); }
__device__ __forceinline__ float wave_sum(float v) {
#pragma unroll
    for (int o = 1; o < 64; o <<= 1) v += __shfl_xor(v, o);
    return v;
}
__device__ __forceinline__ float wave_max(float v) {
#pragma unroll
    for (int o = 1; o < 64; o <<= 1) v = fmaxf(v, __shfl_xor(v, o));
    return v;
}
__device__ __forceinline__ float grp16_sum(float v) { v += __shfl_xor(v, 1); v += __shfl_xor(v, 2); v += __shfl_xor(v, 4); v += __shfl_xor(v, 8); return v; }
__device__ __forceinline__ float grp8_sum(float v) { v += __shfl_xor(v, 1); v += __shfl_xor(v, 2); v += __shfl_xor(v, 4); return v; }
__device__ __forceinline__ float sum4(f32x4 a) { return (a.x + a.y) + (a.z + a.w); }
__device__ __forceinline__ float dot4(f32x4 a, f32x4 b) { return (a.x * b.x + a.y * b.y) + (a.z * b.z + a.w * b.w); }
__device__ __forceinline__ float fexp(float x) { return __builtin_amdgcn_exp2f(x * 1.4426950408889634f); }
__device__ __forceinline__ float sigm(float x) { return __builtin_amdgcn_rcpf(1.0f + fexp(-x)); }
__device__ __forceinline__ float softplusf(float x) { return fmaxf(x, 0.0f) + 0.6931471805599453f * __builtin_amdgcn_logf(1.0f + fexp(-fabsf(x))); }
__device__ __forceinline__ float ftanh(float x) { const float e = fexp(-2.0f * fabsf(x)); const float t = (1.0f - e) * __builtin_amdgcn_rcpf(1.0f + e); return x < 0.0f ? -t : t; }
__device__ __forceinline__ f32x4 shx4(f32x4 v, int m) { f32x4 r; r.x = __shfl_xor(v.x, m); r.y = __shfl_xor(v.y, m); r.z = __shfl_xor(v.z, m); r.w = __shfl_xor(v.w, m); return r; }

#define XB_TMO      128
#define XB_XCNT(j)  (256  + 64 * (j))
#define XB_XSUB(j)  (1280 + 64 * (j))
#define XB_XGEN(j)  (2304 + 64 * (j))
#define XB_TOP      3328
#define XB_TOPGEN   3392
#define XCD_BAR_WORDS 3456
#define XB_SPIN_CAP (1u << 18)

__device__ __forceinline__ unsigned xb_ld(unsigned* p)              { return __hip_atomic_load(p, __ATOMIC_RELAXED, __HIP_MEMORY_SCOPE_AGENT); }
__device__ __forceinline__ unsigned xb_add(unsigned* p, unsigned v) { return __hip_atomic_fetch_add(p, v, __ATOMIC_RELAXED, __HIP_MEMORY_SCOPE_AGENT); }
__device__ __forceinline__ unsigned xb_xcc_id() { return (unsigned)__builtin_amdgcn_s_getreg((3 << 11) | 20) & 0xFu; }
#define XB_SPIN(cond, bar) do { unsigned _sp = 0; while (cond) { __builtin_amdgcn_s_sleep(1); \
    if ((++_sp & 255u) == 0u) { if (xb_ld(&(bar)[XB_TMO])) break; if (_sp > XB_SPIN_CAP) { atomicAdd(&(bar)[XB_TMO], 1u); break; } } } } while (0)

struct XcdBarrier {
    unsigned* bar; unsigned x;
    volatile LAS unsigned* st;
};

__device__ __forceinline__ XcdBarrier xcd_barrier_post(unsigned* bar, volatile LAS unsigned* st, int xb_tid) {
    XcdBarrier b; b.bar = bar; b.x = xb_xcc_id(); b.st = st;
    if (xb_tid == 0) (void)xb_add(&bar[XB_XCNT(b.x)], 1u);
    return b;
}
__device__ __forceinline__ void xcd_barrier_complete(unsigned* bar, unsigned x, unsigned& nloc, unsigned& nx) {
    const unsigned G = gridDim.x * gridDim.y * gridDim.z;
    unsigned sum, cnt, mine, sp = 0u;
    for (;;) {
        sum = 0u; cnt = 0u; mine = 0u;
#pragma unroll
        for (unsigned j = 0; j < 16; ++j) { const unsigned c = xb_ld(&bar[XB_XCNT(j)]); sum += c; cnt += (c > 0u) ? 1u : 0u; mine = (j == x) ? c : mine; }
        if (sum == G) break;
        __builtin_amdgcn_s_sleep(1);
        if ((++sp & 255u) == 0u) { if (xb_ld(&bar[XB_TMO])) break; if (sp > XB_SPIN_CAP) { atomicAdd(&bar[XB_TMO], 1u); break; } }
    }
    nloc = mine > 0u ? mine : 1u; nx = cnt > 0u ? cnt : 1u;
}

__device__ __forceinline__ void xcd_barrier(const XcdBarrier& b, int xb_tid) {
    asm volatile("s_waitcnt vmcnt(0)" ::: "memory");
    __syncthreads();
    if (xb_tid == 0) {
        unsigned* bar = b.bar;
        __builtin_amdgcn_s_waitcnt(0);
        unsigned nloc = b.st[0], nx = b.st[1];
        if (nloc == 0u) { xcd_barrier_complete(bar, b.x, nloc, nx); b.st[0] = nloc; b.st[1] = nx; }
        const unsigned old = xb_add(&bar[XB_XSUB(b.x)], 1u);
        const unsigned gen = old / nloc;
        if (old + 1u == (gen + 1u) * nloc) {
            __builtin_amdgcn_fence(__ATOMIC_RELEASE, "agent");
            asm volatile("s_waitcnt vmcnt(0)" ::: "memory");
            const unsigned og = xb_add(&bar[XB_TOP], 1u);
            const unsigned tg = og / nx;
            if (og + 1u == (tg + 1u) * nx) xb_add(&bar[XB_TOPGEN], 1u);
            else XB_SPIN(xb_ld(&bar[XB_TOPGEN]) == tg, bar);
            __builtin_amdgcn_fence(__ATOMIC_ACQUIRE, "agent");
            xb_add(&bar[XB_XGEN(b.x)], 1u);
            asm volatile("s_waitcnt vmcnt(0)" ::: "memory");
        } else {
            XB_SPIN(xb_ld(&bar[XB_XGEN(b.x)]) == gen, bar);
            __builtin_amdgcn_fence(__ATOMIC_ACQUIRE, "agent");
            asm volatile("s_waitcnt vmcnt(0)" ::: "memory");
        }
    }
    __syncthreads();
}
struct ArgsH { const float* in[N_IN]; float* out; unsigned char* ws; double invf[44]; int ph_lo, ph_hi, li, pad; };
struct ArgsD { const GAS float* in[N_IN]; GAS float* out; GAS unsigned char* ws; double invf[44]; int ph_lo, ph_hi, li, pad; };
static_assert(sizeof(ArgsH) == sizeof(ArgsD), "args layout");
typedef const CAS ArgsD& ARef;
__device__ __forceinline__ const CAS ArgsD* kargs() {
#if defined(__HIP_DEVICE_COMPILE__)
    const CAS ArgsD* p = (const CAS ArgsD*)__builtin_amdgcn_kernarg_segment_ptr(); asm volatile("" : "+s"(p)); return p;
#else
    return nullptr;
#endif
}
struct WI { LAS unsigned char* lds; int tid, lane, wave, vcu, G, gw, NGW, bx; };
constexpr size_t RWA_STRIDE = (33 * MiB + 68 * 1024) / 4;
constexpr size_t YO_STRIDE = 32 * MiB / 4;

__device__ __forceinline__ int wave_sum_i(int v) {
#pragma unroll
    for (int o = 1; o < 64; o <<= 1) v += __shfl_xor(v, o);
    return v;
}
__device__ __forceinline__ void sincos_d(double ang, float& s, float& c) {
    const double q = __builtin_rint(ang * 0.63661977236758134308);
    double r = __builtin_fma(-q, 1.57079632679489661923, ang); r = __builtin_fma(-q, 6.123233995736766e-17, r);
    const double r2 = r * r;
    const double sp = r * (1.0 + r2 * (-1.0 / 6 + r2 * (1.0 / 120 + r2 * (-1.0 / 5040 + r2 * (1.0 / 362880 + r2 * (-1.0 / 39916800 + r2 * (1.0 / 6227020800.0)))))));
    const double cp = 1.0 + r2 * (-0.5 + r2 * (1.0 / 24 + r2 * (-1.0 / 720 + r2 * (1.0 / 40320 + r2 * (-1.0 / 3628800 + r2 * (1.0 / 479001600 + r2 * (-1.0 / 87178291200.0)))))));
    const int qi = ((int)q) & 3;
    const double ss = (qi == 0) ? sp : (qi == 1) ? cp : (qi == 2) ? -sp : -cp;
    const double cc = (qi == 0) ? cp : (qi == 1) ? -sp : (qi == 2) ? -cp : sp;
    s = (float)ss; c = (float)cc;
}

struct TrItem { const float* src; bf16* dst; int ldw; float scale; bool ok; };
__device__ __forceinline__ void tr_decode(ARef A, int it, int lane, TrItem& d) {
    constexpr int I_IN = NLAYER * 16 * 96, I_OUT = NLAYER * 16 * 32, I_W1 = NLAYER * NEXP * 16 * 64;
    const float* W; int ldw, nvalid, k0, nsrc0; bf16* WT; size_t dstrow0; float scale = 1.0f;
    int r = it;
    if (r < I_IN) { const int l = r / 1536, rr = r % 1536, kb = rr / 96, nb = rr % 96;
        const int nd = nb * 32;
        nsrc0 = (nd < 1024) ? nd : (nd < 1792) ? C_SB + (nd - 1024) : (nd < 2688) ? C_RW + (nd - 1792) : C_DSA + (nd - 2688);
        nvalid = (nd < 1024) ? 1024 : (nd < 1792) ? INC : (nd < 2688) ? C_DSA : ((nd < INC) ? C_SB : 0);
        scale = (nd >= 256 && nd < 512) ? 0.125f : (nd >= 1024 && nd < 1280) ? 0.18033688011112042f : 1.0f;
        W = A.in[I_WIN] + (size_t)l * DM * INC; ldw = INC; k0 = kb * 64; WT = (bf16*)(A.ws + WS_WIN) + (size_t)l * INCP * DM; dstrow0 = (size_t)nd; }
    else if (r < I_IN + I_OUT) { r -= I_IN; const int l = r / 512, rr = r % 512, kb = rr / 32, nb = rr % 32;
        W = A.in[I_WOUT] + (size_t)l * DM * DM; ldw = DM; nvalid = DM; k0 = kb * 64; nsrc0 = nb * 32; WT = (bf16*)(A.ws + WS_WOUT) + (size_t)l * DM * DM; dstrow0 = (size_t)nb * 32; }
    else if (r < I_IN + I_OUT + I_W1) { r -= I_IN + I_OUT; const int le = r / 1024, rr = r % 1024, kb = rr / 64, nb = rr % 64, j = nb >> 3, bj = (nb >> 2) & 1, cc0 = (nb & 3) * 32;
        W = A.in[I_MW1] + (size_t)le * DM * 2048; ldw = 2048; nvalid = 2048; k0 = kb * 64; nsrc0 = bj * 1024 + 128 * j + cc0; WT = (bf16*)(A.ws + WS_W1) + (size_t)le * 2048 * DM; dstrow0 = (size_t)nb * 32; }
    else { r -= I_IN + I_OUT + I_W1; const int le = r / 512, rr = r % 512, kb = rr / 32, nb = rr % 32;
        W = A.in[I_MW2] + (size_t)le * DM * DM; ldw = DM; nvalid = DM; k0 = kb * 64; nsrc0 = nb * 32; WT = (bf16*)(A.ws + WS_W2) + (size_t)le * DM * DM; dstrow0 = (size_t)nb * 32; }
    const int n = nsrc0 + 4 * (lane & 7);
    d.ok = n < nvalid; d.src = W + (size_t)(k0 + (lane >> 3)) * ldw + (d.ok ? n : 0); d.ldw = ldw; d.scale = scale;
    d.dst = WT + (dstrow0 + (lane >> 3)) * 1024 + k0 + 8 * (lane & 7);
}
__device__ __forceinline__ void tr_load(const TrItem& d, f32x4 (&v)[8]) {
#pragma unroll
    for (int i = 0; i < 8; ++i) v[i] = *(const f32x4*)(d.src + (size_t)(8 * i) * d.ldw);
}
__device__ __forceinline__ void tr_store(const TrItem& d, const f32x4 (&v)[8], LAS float* scr, int lane) {
    const float sc_ = d.ok ? d.scale : 0.0f;
#pragma unroll
    for (int i = 0; i < 8; ++i) { LAS float* s = scr + (8 * i + (lane >> 3)) * 33 + 4 * (lane & 7); s[0] = v[i].x * sc_; s[1] = v[i].y * sc_; s[2] = v[i].z * sc_; s[3] = v[i].w * sc_; }
    LDS_WAIT(); asm volatile("" ::: "memory");
    const int c8 = lane & 7;
#pragma unroll
    for (int j = 0; j < 4; ++j) { const int n = (lane >> 3) + 8 * j; const LAS float* s = scr + (8 * c8) * 33 + n;
        v4u o; o.x = pk2(s[0 * 33], s[1 * 33]); o.y = pk2(s[2 * 33], s[3 * 33]); o.z = pk2(s[4 * 33], s[5 * 33]); o.w = pk2(s[6 * 33], s[7 * 33]);
        *(v4u*)(d.dst + (size_t)(8 * j) * 1024) = o; }
    LDS_WAIT(); asm volatile("" ::: "memory");
}
__device__ __forceinline__ void ph_prologue(ARef A, const WI& w) {
    LAS float* sc = (LAS float*)w.lds;
    { const float* cin = A.in[I_C]; for (int i = w.tid; i < NB * DM; i += NWAVES * 64) { const float v = cin[i]; sc[i] = v / (1.0f + expf(-v)); } }
    __syncthreads();
    float* MOD = (float*)(A.ws + WS_MOD);
    LAS float* red = (LAS float*)(w.lds + 32768);
    if (w.vcu < 192) {
        const int l = w.vcu / 96, col = (w.vcu % 96) * 64 + w.lane, kw = 128 * w.wave;
        const float* wp = A.in[I_ADAW] + (size_t)l * DM * 6144 + (size_t)kw * 6144 + col;
        float acc[8];
#pragma unroll
        for (int b = 0; b < 8; ++b) acc[b] = 0.0f;
#pragma unroll 16
        for (int k = 0; k < 128; ++k) { const float wv = wp[(size_t)k * 6144];
#pragma unroll
            for (int b = 0; b < 8; ++b) acc[b] += sc[b * DM + kw + k] * wv; }
#pragma unroll
        for (int b = 0; b < 8; ++b) red[(w.wave * 8 + b) * 64 + w.lane] = acc[b];
    }
    __syncthreads();
    if (w.vcu < 192) { const int l = w.vcu / 96, b = w.wave, col = (w.vcu % 96) * 64 + w.lane;
        float s = A.in[I_ADAB][l * 6144 + col];
#pragma unroll
        for (int q = 0; q < 8; ++q) s += red[(q * 8 + b) * 64 + w.lane];
        MOD[(size_t)(l * 8 + b) * 6144 + col] = s; }
    __syncthreads();
    LAS float* scr = (LAS float*)(w.lds + 32768 + w.wave * 8448);
    constexpr int NIT = NLAYER * 16 * 96 + NLAYER * 16 * 32;
    { TrItem d0, d1; f32x4 va[8], vb[8];
      int it = w.gw; bool h0 = it < NIT;
      if (h0) { tr_decode(A, it, w.lane, d0); tr_load(d0, va); }
      while (h0) {
          it += w.NGW; const bool h1 = it < NIT;
          if (h1) { tr_decode(A, it, w.lane, d1); tr_load(d1, vb); }
          tr_store(d0, va, scr, w.lane);
          if (!h1) break;
          it += w.NGW; h0 = it < NIT;
          if (h0) { tr_decode(A, it, w.lane, d0); tr_load(d0, va); }
          tr_store(d1, vb, scr, w.lane);
      } }
    float* RT = (float*)(A.ws + WS_ROPE); const int* pos = (const int*)A.in[I_POS];
    for (int g = w.gw * 64 + w.lane; g < MTOK * 44; g += w.NGW * 64) {
        const int tok = g / 44, f = g % 44; int co, so;
        if (f < 32) { co = f; so = 32 + f; } else if (f < 40) { co = 64 + (f - 32); so = 72 + (f - 32); } else { co = 80 + (f - 40); so = 84 + (f - 40); }
        float s, c; sincos_d((double)pos[tok] * A.invf[f], s, c);
        RT[(size_t)tok * ROPE_W + co] = c; RT[(size_t)tok * ROPE_W + so] = s;
    }
}

__device__ __forceinline__ void moe_convert_chunk(ARef A, int l, int c, int lane, LAS float* scr) {
    constexpr int I0 = NLAYER * 16 * 96 + NLAYER * 16 * 32, I_W1 = NLAYER * NEXP * 16 * 64;
    const int it0 = (c < 8192) ? I0 + l * 32768 + 4 * c : I0 + I_W1 + l * 16384 + 4 * (c - 8192);
    TrItem d0, d1; f32x4 va[8], vb[8];
    tr_decode(A, it0, lane, d0); tr_load(d0, va);
    tr_decode(A, it0 + 1, lane, d1); tr_load(d1, vb);
    tr_store(d0, va, scr, lane);
    tr_decode(A, it0 + 2, lane, d0); tr_load(d0, va);
    tr_store(d1, vb, scr, lane);
    tr_decode(A, it0 + 3, lane, d1); tr_load(d1, vb);
    tr_store(d0, va, scr, lane);
    tr_store(d1, vb, scr, lane);
}

__device__ __forceinline__ void emit_h_row(const f32x4 (&v)[4], float rstd, const float* g, const float* sc, const float* sh, bf16* hrow, int lane) {
#pragma unroll
    for (int j = 0; j < 4; ++j) { const int k = 4 * (lane + 64 * j);
        const f32x4 gv = *(const f32x4*)(g + k), scv = *(const f32x4*)(sc + k), shv = *(const f32x4*)(sh + k);
        const f32x4 h = v[j] * rstd * gv * (1.0f + scv) + shv;
        v2u o; o.x = pk2(h.x, h.y); o.y = pk2(h.z, h.w); *(v2u*)(hrow + k) = o; }
}
__device__ __forceinline__ void small_weights_to_f16(ARef A, const WI& w) {
    { _Float16* SW = (_Float16*)(A.ws + WS_SMALLW);
      const int g0 = w.gw * 64 + w.lane, gs = w.NGW * 64;
      for (int l = 0; l < NLAYER; ++l) { _Float16* S = SW + (size_t)l * SMW_LAYER;
          const float* wq = A.in[I_WQ] + (size_t)l * 128 * 256; const float* wqi = A.in[I_WQI] + (size_t)l * 128 * 256;
          for (int e = g0; e < 256 * 128; e += gs) { const int n = e >> 7, k = e & 127; S[SMW_QI + e] = (_Float16)wq[k * 256 + n]; S[SMW_QI + 256 * 128 + e] = (_Float16)wqi[k * 256 + n]; }
          const float* w2 = A.in[I_W2] + (size_t)l * 32 * 256; const float* a2 = A.in[I_A2] + (size_t)l * 32 * 256; const float* g2 = A.in[I_G2] + (size_t)l * 64 * 256;
          for (int e = g0; e < 256 * 32; e += gs) { const int n = e >> 5, k = e & 31; S[SMW_W2 + e] = (_Float16)w2[k * 256 + n]; S[SMW_A2 + e] = (_Float16)a2[k * 256 + n]; }
          for (int e = g0; e < 256 * 64; e += gs) { const int n = e >> 6, k = e & 63; S[SMW_G2 + e] = (_Float16)g2[k * 256 + n]; } } }
}
__device__ __forceinline__ void ph_norm1(ARef A, const WI& w) {
    const float* MOD = (const float*)(A.ws + WS_MOD); bf16* H = (bf16*)(A.ws + WS_H);
    for (int m = w.gw; m < MTOK; m += w.NGW) {
        const float* xr = A.in[I_X] + (size_t)m * DM; f32x4 v[4]; float ss = 0.0f;
#pragma unroll
        for (int j = 0; j < 4; ++j) { v[j] = *(const f32x4*)(xr + 4 * (w.lane + 64 * j)); ss += dot4(v[j], v[j]); }
        ss = wave_sum(ss); const float rstd = 1.0f / sqrtf(ss * (1.0f / DM) + 1e-5f);
        const float* mb = MOD + (size_t)(m >> 12) * 6144;
        emit_h_row(v, rstd, A.in[I_NMIX], mb + 1024, mb, H + (size_t)m * DM, w.lane);
    }
}

typedef _Float16 h4v __attribute__((ext_vector_type(4)));
__device__ __forceinline__ f16x8 pack_f16x8(f32x4 a, f32x4 b) { f16x8 r; r[0] = (_Float16)a.x; r[1] = (_Float16)a.y; r[2] = (_Float16)a.z; r[3] = (_Float16)a.w; r[4] = (_Float16)b.x; r[5] = (_Float16)b.y; r[6] = (_Float16)b.z; r[7] = (_Float16)b.w; return r; }
#define RW_STB4(k_, val_) do { v2u w_; w_.x = pk2((val_).x, (val_).y); w_.y = pk2((val_).z, (val_).w); *(v2u*)((bf16*)(RWA + (k_) * RWA_STRIDE) + o) = w_; } while (0)
#ifndef RWKV_RKV_BF16
#define RWKV_RKV_BF16 1
#endif
#if RWKV_RKV_BF16
#define RW_ST_RKV(k_, val_) RW_STB4(k_, val_)
#else
#define RW_ST_RKV(k_, val_) (*(f32x4*)(RWA + (k_) * RWA_STRIDE + o) = (val_))
#endif
__device__ __forceinline__ f32x4 ldb4(const bf16* q) { const v2u x = *(const v2u*)q; return (f32x4){bf_lo(x.x), bf_hi(x.x), bf_lo(x.y), bf_hi(x.y)}; }
__device__ __forceinline__ void prep16_body(const bf16* __restrict__ P, float* __restrict__ RWA, const _Float16* __restrict__ SW, const float* __restrict__ RT, bf16* __restrict__ DQ, _Float16* __restrict__ DQI,
                                            bf16* __restrict__ DKB, bf16* __restrict__ DVB, _Float16* __restrict__ DKI, float* __restrict__ DW, const float* __restrict__ mu, const float* __restrict__ qn,
                                            const float* __restrict__ w0p, const float* __restrict__ a0p, const float* __restrict__ kkp, const float* __restrict__ kap, const float* __restrict__ rkp, int m0, int lane_in, int part = 7) {
    int lane = lane_in; asm volatile("" : "+v"(lane));
    const int tk = lane & 15, q4 = lane >> 4, m = m0 + tk, t = m & (SEQ - 1);
    const bf16* pr = P + (size_t)m * PFW; const bf16* pp = pr - PFW; const bf16* pd = P + (size_t)m * PFW + PF_DSA;
    RT += (size_t)m * ROPE_W; const f32x4 zero4 = {0.f, 0.f, 0.f, 0.f};
    f16x8 bx[4], bc[4];
    { float ss = 0.0f; f32x4 c[4][2];
#pragma unroll
      for (int ks = 0; ks < 4; ++ks) { const int f0 = 32 * ks + 8 * q4;
          f32x4 x[2];
#pragma unroll
          for (int u = 0; u < 2; ++u) { const f32x4 z = ldb4(pr + 768 + f0 + 4 * u); const f32x4 p = t ? ldb4(pp + 768 + f0 + 4 * u) : zero4; x[u] = z + (p - z) * *(const f32x4*)(mu + 768 + f0 + 4 * u);
#pragma unroll
              for (int i = 0; i < 4; ++i) x[u][i] = (ks == 0) ? ftanh(x[u][i]) : (ks == 1) ? x[u][i] : sigm(x[u][i]); }
          bx[ks] = pack_f16x8(x[0], x[1]);
          c[ks][0] = ldb4(pd + f0); c[ks][1] = ldb4(pd + f0 + 4); ss += dot4(c[ks][0], c[ks][0]) + dot4(c[ks][1], c[ks][1]); }
      ss += __shfl_xor(ss, 16); ss += __shfl_xor(ss, 32);
      const float rstd = 1.0f / sqrtf(ss * (1.0f / 128.0f) + 1e-5f);
#pragma unroll
      for (int ks = 0; ks < 4; ++ks) { const int f0 = 32 * ks + 8 * q4; bc[ks] = pack_f16x8(c[ks][0] * rstd * *(const f32x4*)(qn + f0), c[ks][1] * rstd * *(const f32x4*)(qn + f0 + 4)); } }
    const _Float16* wrow = SW + (size_t)tk * 0;
    (void)wrow;
    const int arow = lane & 15;
    if (part & 1)
#pragma unroll 2
    for (int hd = 0; hd < 4; ++hd) {
        f32x4 fk[4], av[4]; float ssk = 0.0f;
#pragma unroll
        for (int j = 0; j < 4; ++j) { const int nb = 4 * hd + j, ch = 16 * nb + 4 * q4; const size_t o = (size_t)m * 256 + ch;
            const f16x8 aw = *(const f16x8*)(SW + SMW_W2 + (16 * nb + arow) * 32 + 8 * q4), aa = *(const f16x8*)(SW + SMW_A2 + (16 * nb + arow) * 32 + 8 * q4);
            const f16x8 ag0 = *(const f16x8*)(SW + SMW_G2 + (16 * nb + arow) * 64 + 8 * q4), ag1 = *(const f16x8*)(SW + SMW_G2 + (16 * nb + arow) * 64 + 32 + 8 * q4);
            const f32x4 cw = __builtin_amdgcn_mfma_f32_16x16x32_f16(aw, bx[0], *(const f32x4*)(w0p + ch), 0, 0, 0);
            const f32x4 ca = __builtin_amdgcn_mfma_f32_16x16x32_f16(aa, bx[1], *(const f32x4*)(a0p + ch), 0, 0, 0);
            f32x4 cg = __builtin_amdgcn_mfma_f32_16x16x32_f16(ag0, bx[2], zero4, 0, 0, 0); cg = __builtin_amdgcn_mfma_f32_16x16x32_f16(ag1, bx[3], cg, 0, 0, 0);
            f32x4 dec;
#pragma unroll
            for (int i = 0; i < 4; ++i) { dec[i] = fexp(-fexp(-softplusf(-cw[i]) - 0.5f)); av[j][i] = sigm(ca[i]); }
            *(f32x4*)(RWA + 1 * RWA_STRIDE + o) = dec; RW_STB4(6, cg);
            { const f32x4 z = ldb4(pr + 256 + ch); const f32x4 p = t ? ldb4(pp + 256 + ch) : zero4; fk[j] = z + (p - z) * *(const f32x4*)(mu + 256 + ch); }
            const f32x4 kk = fk[j] * *(const f32x4*)(kkp + ch); ssk += dot4(kk, kk); }
        ssk += __shfl_xor(ssk, 16); ssk += __shfl_xor(ssk, 32);
        const float inrm = 1.0f / fmaxf(sqrtf(ssk), 1e-12f);
        f32x4 fr[4], km[4]; float bs = 0.0f;
#pragma unroll
        for (int j = 0; j < 4; ++j) { const int ch = 16 * (4 * hd + j) + 4 * q4;
            { const f32x4 z = ldb4(pr + ch); const f32x4 p = t ? ldb4(pp + ch) : zero4; fr[j] = z + (p - z) * *(const f32x4*)(mu + ch); }
            km[j] = fk[j] * (1.0f + (av[j] - 1.0f) * *(const f32x4*)(kap + ch)); bs += dot4(fr[j] * km[j], *(const f32x4*)(rkp + ch)); }
        bs += __shfl_xor(bs, 16); bs += __shfl_xor(bs, 32);
#pragma unroll
        for (int j = 0; j < 4; ++j) { const int ch = 16 * (4 * hd + j) + 4 * q4; const size_t o = (size_t)m * 256 + ch;
            f32x4 fv; { const f32x4 z = ldb4(pr + 512 + ch); const f32x4 p = t ? ldb4(pp + 512 + ch) : zero4; fv = z + (p - z) * *(const f32x4*)(mu + 512 + ch); }
            const f32x4 kk = fk[j] * *(const f32x4*)(kkp + ch) * inrm;
            RW_ST_RKV(0, fr[j]); RW_ST_RKV(2, km[j]); RW_ST_RKV(3, fv);
            *(f32x4*)(RWA + 4 * RWA_STRIDE + o) = -kk; *(f32x4*)(RWA + 5 * RWA_STRIDE + o) = kk * av[j]; { const f32x4 bo_ = bs * fv; RW_STB4(7, bo_); } }
    }
    if (part & 2)
#pragma unroll 4
    for (int nb = 0; nb < 32; ++nb) {
        f32x4 cq = zero4;
#pragma unroll
        for (int ks = 0; ks < 4; ++ks) { const f16x8 aq = *(const f16x8*)(SW + SMW_QI + (16 * nb + arow) * 128 + 32 * ks + 8 * q4); cq = __builtin_amdgcn_mfma_f32_16x16x32_f16(aq, bc[ks], cq, 0, 0, 0); }
        const int ch = 16 * (nb & 15) + 4 * q4;
        if (nb < 16) {
            if ((nb & 3) == 0) { const f32x4 ot = shx4(cq, 32); const int fi = 4 * (q4 & 1); const f32x4 cs4 = *(const f32x4*)(RT + 64 + fi), sn = *(const f32x4*)(RT + 72 + fi); cq = (q4 < 2) ? cq * cs4 - ot * sn : ot * sn + cq * cs4; }
            const f32x4 qs = cq * 0.18033688011112042f; v2u o; o.x = pk2(qs.x, qs.y); o.y = pk2(qs.z, qs.w); *(v2u*)(DQ + (size_t)m * 256 + ch) = o;
        } else {
            if ((nb & 1) == 0) { const f32x4 ot = shx4(cq, 16); const f32x4 cs4 = *(const f32x4*)(RT + 80), sn = *(const f32x4*)(RT + 84); if (q4 < 2) cq = (q4 < 1) ? cq * cs4 - ot * sn : ot * sn + cq * cs4; }
            h4v hq; hq.x = (_Float16)cq.x; hq.y = (_Float16)cq.y; hq.z = (_Float16)cq.z; hq.w = (_Float16)cq.w; *(h4v*)(DQI + (size_t)m * 256 + ch) = hq;
        }
    }
#pragma unroll
    for (int j = 0; j < 4; ++j) { const int d = 16 * j + 4 * q4; f32x4 kx = ldb4(pd + 128 + d);
        if (j == 0) { const f32x4 ot = shx4(kx, 32); const int fi = 4 * (q4 & 1); const f32x4 cs4 = *(const f32x4*)(RT + 64 + fi), sn = *(const f32x4*)(RT + 72 + fi); kx = (q4 < 2) ? kx * cs4 - ot * sn : ot * sn + kx * cs4; }
        v2u o; o.x = pk2(kx.x, kx.y); o.y = pk2(kx.z, kx.w); *(v2u*)(DKB + (size_t)m * 64 + d) = o;
        const f32x4 vx = ldb4(pd + 192 + d); v2u ov; ov.x = pk2(vx.x, vx.y); ov.y = pk2(vx.z, vx.w); *(v2u*)(DVB + (size_t)m * 64 + d) = ov; }
#pragma unroll
    for (int j = 0; j < 2; ++j) { const int d = 16 * j + 4 * q4; f32x4 ki = ldb4(pd + 256 + d);
        if (j == 0) { const f32x4 ot = shx4(ki, 16); const f32x4 cs4 = *(const f32x4*)(RT + 80), sn = *(const f32x4*)(RT + 84); if (q4 < 2) ki = (q4 < 1) ? ki * cs4 - ot * sn : ot * sn + ki * cs4; }
        h4v hk; hk.x = (_Float16)ki.x; hk.y = (_Float16)ki.y; hk.z = (_Float16)ki.z; hk.w = (_Float16)ki.w; *(h4v*)(DKI + (size_t)m * 32 + d) = hk; }
    if (q4 < 2) *(f32x4*)(DW + (size_t)m * 8 + 4 * q4) = ldb4(pd + 288 + 4 * q4) * 0.0625f;
}

__device__ __forceinline__ void prep16(ARef A, int l, int m0, int lane_in, int part = 7) {
    prep16_body((const bf16*)(A.ws + WS_PF), (float*)(A.ws + WS_RWA), (const _Float16*)(A.ws + WS_SMALLW) + (size_t)l * SMW_LAYER, (const float*)(A.ws + WS_ROPE), (bf16*)(A.ws + WS_DQ), (_Float16*)(A.ws + WS_DQI),
                (bf16*)(A.ws + WS_DKB), (bf16*)(A.ws + WS_DVB), (_Float16*)(A.ws + WS_DKI), (float*)(A.ws + WS_DW), A.in[I_MU] + l * 896, A.in[I_QNORM] + l * 128,
                A.in[I_W0] + l * 256, A.in[I_A0] + l * 256, A.in[I_KK] + l * 256, A.in[I_KA] + l * 256, A.in[I_RK] + l * 256, m0, lane_in, part);
}
__device__ __forceinline__ float quad_sum(float v) {
    v += __builtin_bit_cast(float, __builtin_amdgcn_mov_dpp(__builtin_bit_cast(int, v), 0xB1, 0xF, 0xF, true));
    v += __builtin_bit_cast(float, __builtin_amdgcn_mov_dpp(__builtin_bit_cast(int, v), 0x4E, 0xF, 0xF, true));
    return v;
}
__device__ __forceinline__ float oct_sum(float v) {
    v += __builtin_bit_cast(float, __builtin_amdgcn_mov_dpp(__builtin_bit_cast(int, v), 0xB1, 0xF, 0xF, true));
    v += __builtin_bit_cast(float, __builtin_amdgcn_mov_dpp(__builtin_bit_cast(int, v), 0x4E, 0xF, 0xF, true));
    v += __builtin_bit_cast(float, __builtin_amdgcn_mov_dpp(__builtin_bit_cast(int, v), 0x141, 0xF, 0xF, true));
    return v;
}
typedef float f32x2 __attribute__((ext_vector_type(2)));
#define LO2(v_) __builtin_shufflevector(v_, v_, 0, 1)
#define HI2(v_) __builtin_shufflevector(v_, v_, 2, 3)
#define RW_ROW(i_) (((i_) < 2) ? (16 * ws + rg + 8 * (i_)) : (64 + 16 * ws + rg + 8 * ((i_) - 2)))
#define RW_LOAD(op, s_) do { const int lo_ = (s_) * 64 + kq * 8; \
    op[0] = *(const LAS f32x4*)(sn + lo_); op[1] = *(const LAS f32x4*)(sn + lo_ + 4); op[2] = *(const LAS f32x4*)(sw + lo_); op[3] = *(const LAS f32x4*)(sw + lo_ + 4); \
    op[4] = *(const LAS f32x4*)(sb + lo_); op[5] = *(const LAS f32x4*)(sb + lo_ + 4); op[6] = *(const LAS f32x4*)(sk + lo_); op[7] = *(const LAS f32x4*)(sk + lo_ + 4); \
    op[8] = *(const LAS f32x4*)(sr + lo_); op[9] = *(const LAS f32x4*)(sr + lo_ + 4); \
    vin[0] = sv[(s_) * 64 + 16 * ws + rg]; vin[1] = sv[(s_) * 64 + 16 * ws + rg + 8]; } while (0)
#define RW_DOT(i_, oa, ob) ({ f32x2 d_ = S[i_][0] * LO2(oa); d_ = S[i_][1] * HI2(oa) + d_; d_ = S[i_][2] * LO2(ob) + d_; d_ = S[i_][3] * HI2(ob) + d_; d_.x + d_.y; })
#define RW_STEP(op, vv, s_) do { float sa_[4], y_[4]; \
    _Pragma("unroll") for (int i_ = 0; i_ < 4; ++i_) sa_[i_] = RW_DOT(i_, op[0], op[1]); \
    _Pragma("unroll") for (int i_ = 0; i_ < 4; ++i_) sa_[i_] += __builtin_bit_cast(float, __builtin_amdgcn_mov_dpp(__builtin_bit_cast(int, sa_[i_]), 0xB1, 0xF, 0xF, true)); \
    _Pragma("unroll") for (int i_ = 0; i_ < 4; ++i_) sa_[i_] += __builtin_bit_cast(float, __builtin_amdgcn_mov_dpp(__builtin_bit_cast(int, sa_[i_]), 0x4E, 0xF, 0xF, true)); \
    _Pragma("unroll") for (int i_ = 0; i_ < 4; ++i_) sa_[i_] += __builtin_bit_cast(float, __builtin_amdgcn_mov_dpp(__builtin_bit_cast(int, sa_[i_]), 0x141, 0xF, 0xF, true)); \
    _Pragma("unroll") for (int i_ = 0; i_ < 2; ++i_) { const f32x2 a2_ = {sa_[i_], sa_[i_]}, v2_ = {vv[i_], vv[i_]}; \
        S[i_][0] = S[i_][0] * LO2(op[2]) + (a2_ * LO2(op[4]) + v2_ * LO2(op[6])); S[i_][1] = S[i_][1] * HI2(op[2]) + (a2_ * HI2(op[4]) + v2_ * HI2(op[6])); \
        S[i_][2] = S[i_][2] * LO2(op[3]) + (a2_ * LO2(op[5]) + v2_ * LO2(op[7])); S[i_][3] = S[i_][3] * HI2(op[3]) + (a2_ * HI2(op[5]) + v2_ * HI2(op[7])); } \
    _Pragma("unroll") for (int i_ = 2; i_ < 4; ++i_) { const f32x2 a2_ = {sa_[i_], sa_[i_]}; \
        S[i_][0] = S[i_][0] * LO2(op[2]) + a2_ * LO2(op[4]); S[i_][1] = S[i_][1] * HI2(op[2]) + a2_ * HI2(op[4]); S[i_][2] = S[i_][2] * LO2(op[3]) + a2_ * LO2(op[5]); S[i_][3] = S[i_][3] * HI2(op[3]) + a2_ * HI2(op[5]); } \
    _Pragma("unroll") for (int i_ = 0; i_ < 4; ++i_) y_[i_] = RW_DOT(i_, op[8], op[9]); \
    _Pragma("unroll") for (int i_ = 0; i_ < 4; ++i_) y_[i_] += __builtin_bit_cast(float, __builtin_amdgcn_mov_dpp(__builtin_bit_cast(int, y_[i_]), 0xB1, 0xF, 0xF, true)); \
    _Pragma("unroll") for (int i_ = 0; i_ < 4; ++i_) y_[i_] += __builtin_bit_cast(float, __builtin_amdgcn_mov_dpp(__builtin_bit_cast(int, y_[i_]), 0x4E, 0xF, 0xF, true)); \
    _Pragma("unroll") for (int i_ = 0; i_ < 4; ++i_) y_[i_] += __builtin_bit_cast(float, __builtin_amdgcn_mov_dpp(__builtin_bit_cast(int, y_[i_]), 0x141, 0xF, 0xF, true)); \
    if (kq == 0) { _Pragma("unroll") for (int i_ = 0; i_ < 4; ++i_) so[(s_) * 128 + RW_ROW(i_)] = y_[i_]; } } while (0)
__device__ __forceinline__ void scan_rwkv_task2(ARef A, const WI& w, int task0) {
    const int slot = w.wave >> 2, ws = w.wave & 3, lt = w.tid & 255, task = task0 + slot;
    const int bh = task >> 4, c = task & 15, b = bh >> 2, h = bh & 3;
    LAS float* sw = (LAS float*)w.lds + slot * 16384; LAS float* sn = sw + 2048; LAS float* sb = sn + 2048; LAS float* sk = sb + 2048; LAS float* sr = sk + 2048; LAS float* sv = sr + 2048; LAS float* so = sv + 2048;
    const float* RWA = (const float*)(A.ws + WS_RWA);
    const int rg = w.lane >> 3, kq = w.lane & 7;
    f32x2 S[4][4];
#pragma unroll
    for (int i = 0; i < 4; ++i)
#pragma unroll
        for (int j = 0; j < 4; ++j) { const int r = RW_ROW(i); S[i][j].x = (r >= 64 && 8 * kq + 2 * j == r - 64) ? 1.0f : 0.0f; S[i][j].y = (r >= 64 && 8 * kq + 2 * j + 1 == r - 64) ? 1.0f : 0.0f; }
    const size_t tok0 = (size_t)b * SEQ + (size_t)c * TCH;
    const int st = lt >> 3, sd = (lt & 7) * 8;
#if RWKV_RKV_BF16
    f32x4 a[3][2]; v4u ab[3];
#define RW_LD_RKV(i_, k_) ab[i_] = *(const v4u*)((const bf16*)(RWA + (k_) * RWA_STRIDE) + o_)
#define RW_GET_RKV(i_, q_) RW_UNPK(ab[i_], q_)
#else
    f32x4 a[3][2]; f32x4 af[3][2];
#define RW_LD_RKV(i_, k_) do { af[i_][0] = *(const f32x4*)(RWA + (k_) * RWA_STRIDE + o_); af[i_][1] = *(const f32x4*)(RWA + (k_) * RWA_STRIDE + o_ + 4); } while (0)
#define RW_GET_RKV(i_, q_) af[i_][q_]
#endif
#define RW_GLOAD(sub_) do { const size_t o_ = (tok0 + (sub_) * 32 + st) * 256 + h * 64 + sd; \
        _Pragma("unroll") for (int q = 0; q < 2; ++q) { a[0][q] = *(const f32x4*)(RWA + 1 * RWA_STRIDE + o_ + 4 * q); a[1][q] = *(const f32x4*)(RWA + 4 * RWA_STRIDE + o_ + 4 * q); a[2][q] = *(const f32x4*)(RWA + 5 * RWA_STRIDE + o_ + 4 * q); } \
        RW_LD_RKV(0, 2); RW_LD_RKV(1, 0); RW_LD_RKV(2, 3); } while (0)
#define RW_UNPK(x_, q_) ((q_) == 0 ? (f32x4){bf_lo((x_).x), bf_hi((x_).x), bf_lo((x_).y), bf_hi((x_).y)} : (f32x4){bf_lo((x_).z), bf_hi((x_).z), bf_lo((x_).w), bf_hi((x_).w)})
    RW_GLOAD(0);
    for (int sub = 0; sub < TCH / 32; ++sub) {
        __syncthreads();
        { const int lo = st * 64 + sd;
#pragma unroll
          for (int q = 0; q < 2; ++q) { *(LAS f32x4*)(sw + lo + 4 * q) = a[0][q]; *(LAS f32x4*)(sn + lo + 4 * q) = a[1][q]; *(LAS f32x4*)(sb + lo + 4 * q) = a[2][q]; *(LAS f32x4*)(sk + lo + 4 * q) = RW_GET_RKV(0, q); *(LAS f32x4*)(sr + lo + 4 * q) = RW_GET_RKV(1, q); *(LAS f32x4*)(sv + lo + 4 * q) = RW_GET_RKV(2, q); } }
        __syncthreads();
        if (sub + 1 < TCH / 32) RW_GLOAD(sub + 1);
        { f32x4 opA[10], opB[10]; float vin[2], vA[2], vB[2];
          RW_LOAD(opA, 0);
          vA[0] = vin[0]; vA[1] = vin[1];
#pragma unroll 1
          for (int s = 0; s < 32; s += 2) {
              RW_LOAD(opB, s + 1);
              vB[0] = vin[0]; vB[1] = vin[1];
              RW_STEP(opA, vA, s);
              if (s + 2 < 32) { RW_LOAD(opA, s + 2); vA[0] = vin[0]; vA[1] = vin[1]; }
              RW_STEP(opB, vB, s + 1);
          } }
        __syncthreads();
        { const int fs = lt >> 3, c16 = (lt & 7) * 16;
          bf16* dst = (c16 < 64) ? (bf16*)((float*)(A.ws + WS_YO) + YO_STRIDE) : ((bf16*)(A.ws + WS_PT) - 64);
          bf16* dp = dst + (tok0 + sub * 32 + fs) * 256 + h * 64 + c16;
#pragma unroll
          for (int q = 0; q < 2; ++q) { const f32x4 x0 = *(const LAS f32x4*)(so + fs * 128 + c16 + 8 * q), x1 = *(const LAS f32x4*)(so + fs * 128 + c16 + 8 * q + 4);
              v4u wv; wv.x = pk2(x0.x, x0.y); wv.y = pk2(x0.z, x0.w); wv.z = pk2(x1.x, x1.y); wv.w = pk2(x1.z, x1.w); *(v4u*)(dp + 8 * q) = wv; } }
    }
    { float* ch = (float*)(A.ws + WS_CH) + ((size_t)(bh * NCH + c) * 128) * 64 + 8 * kq;
#pragma unroll
      for (int i = 0; i < 4; ++i) { float* cr = ch + (size_t)RW_ROW(i) * 64; *(f32x4*)cr = (f32x4){S[i][0].x, S[i][0].y, S[i][1].x, S[i][1].y}; *(f32x4*)(cr + 4) = (f32x4){S[i][2].x, S[i][2].y, S[i][3].x, S[i][3].y}; } }
    __syncthreads();
}
#undef RW_LOAD
#undef RW_STEP
#undef RW_GLOAD
#undef RW_UNPK
#undef RW_LD_RKV
#undef RW_GET_RKV
#undef RW_DOT
#undef RW_ROW
__device__ __forceinline__ void scan_ret_task(ARef A, const WI& w, int task) {
    const int bh = task >> 3, cp = task & 7, b = bh >> 2, h = bh & 3, un = w.tid >> 8, lt = w.tid & 255, c = 2 * cp + un;
    const float lg2g = log2f(1.0f - exp2f(-5.0f - (float)h)), gamma = exp2f(lg2g);
    LAS float* sk = (LAS float*)w.lds + un * 8192; LAS float* sq = sk + 2048; LAS float* sv = sq + 2048; LAS float* so = sv + 2048;
    const bf16* PB = (const bf16*)(A.ws + WS_PB); const float* RT = (const float*)(A.ws + WS_ROPE);
    const int row = lt >> 2, kq = lt & 3;
    f32x2 S[8];
#pragma unroll
    for (int j = 0; j < 8; ++j) S[j] = (f32x2){0.0f, 0.0f};
    const f32x2 gam2 = {gamma, gamma};
    const size_t tok0 = (size_t)b * SEQ + (size_t)c * TCH;
    const int st = lt >> 3, sd = (lt & 7) * 8;
    const int fi = sd & 31, dp = sd ^ 32;
    f32x4 gq[2], gqo[2], gk[2], gko[2], gv[2], gcs[2], gsn[2];
#define BF8_TO_F32(dst, x_) do { dst[0] = (f32x4){bf_lo(x_.x), bf_hi(x_.x), bf_lo(x_.y), bf_hi(x_.y)}; dst[1] = (f32x4){bf_lo(x_.z), bf_hi(x_.z), bf_lo(x_.w), bf_hi(x_.w)}; } while (0)
#define RT_GLOAD(sub_) do { const size_t m_ = tok0 + (sub_) * 32 + st; const bf16* pr_ = PB + m_ * PBW + h * 64; const float* rt_ = RT + m_ * ROPE_W; \
        _Pragma("unroll") for (int u = 0; u < 2; ++u) { gcs[u] = *(const f32x4*)(rt_ + fi + 4 * u); gsn[u] = *(const f32x4*)(rt_ + 32 + fi + 4 * u); } \
        { const v4u x0 = *(const v4u*)(pr_ + sd), x1 = *(const v4u*)(pr_ + dp), x2 = *(const v4u*)(pr_ + 256 + sd), x3 = *(const v4u*)(pr_ + 256 + dp), x4 = *(const v4u*)(pr_ + 512 + sd); \
          BF8_TO_F32(gq, x0); BF8_TO_F32(gqo, x1); BF8_TO_F32(gk, x2); BF8_TO_F32(gko, x3); BF8_TO_F32(gv, x4); } } while (0)
    RT_GLOAD(0);
    for (int sub = 0; sub < TCH / 32; ++sub) {
        const size_t m = tok0 + sub * 32 + st;
        f32x4 qn[2], kn[2], vn[2];
#pragma unroll
        for (int u = 0; u < 2; ++u) { qn[u] = (sd < 32) ? gq[u] * gcs[u] - gqo[u] * gsn[u] : gqo[u] * gsn[u] + gq[u] * gcs[u]; kn[u] = (sd < 32) ? gk[u] * gcs[u] - gko[u] * gsn[u] : gko[u] * gsn[u] + gk[u] * gcs[u]; vn[u] = gv[u]; }
        { const float gt = exp2f(lg2g * (float)(sub * 32 + st + 1)); const f32x4 p0 = qn[0] * gt, p1 = qn[1] * gt;
          v4u pw; pw.x = pk2(p0.x, p0.y); pw.y = pk2(p0.z, p0.w); pw.z = pk2(p1.x, p1.y); pw.w = pk2(p1.z, p1.w); *(v4u*)((bf16*)(A.ws + WS_PTR) + m * 256 + h * 64 + sd) = pw; }
        __syncthreads();
        { const int lo = st * 64 + sd; *(LAS f32x4*)(sq + lo) = qn[0]; *(LAS f32x4*)(sq + lo + 4) = qn[1]; *(LAS f32x4*)(sk + lo) = kn[0]; *(LAS f32x4*)(sk + lo + 4) = kn[1]; *(LAS f32x4*)(sv + lo) = vn[0]; *(LAS f32x4*)(sv + lo + 4) = vn[1]; }
        __syncthreads();
        if (sub + 1 < TCH / 32) RT_GLOAD(sub + 1);
#define RT_LOAD(kvA, rvA, vA, s_) do { const int lo_ = (s_) * 64 + kq * 16; _Pragma("unroll") for (int j4 = 0; j4 < 4; ++j4) { kvA[j4] = *(const LAS f32x4*)(sk + lo_ + 4 * j4); rvA[j4] = *(const LAS f32x4*)(sq + lo_ + 4 * j4); } vA = sv[(s_) * 64 + row]; } while (0)
#define RT_STEP(kvA, rvA, vA, s_) do { const f32x2 v2 = {vA, vA}; f32x2 y2 = {0.0f, 0.0f}; \
            _Pragma("unroll") for (int j4 = 0; j4 < 4; ++j4) { S[2 * j4] = S[2 * j4] * gam2 + v2 * LO2(kvA[j4]); S[2 * j4 + 1] = S[2 * j4 + 1] * gam2 + v2 * HI2(kvA[j4]); \
                y2 = S[2 * j4] * LO2(rvA[j4]) + y2; y2 = S[2 * j4 + 1] * HI2(rvA[j4]) + y2; } \
            const float y = quad_sum(y2.x + y2.y); if (kq == 0) so[(s_) * 64 + row] = y; } while (0)
        { f32x4 kA[4], rA[4], kB[4], rB[4]; float vA, vB;
          RT_LOAD(kA, rA, vA, 0);
#pragma unroll 1
          for (int s = 0; s < 32; s += 2) {
              RT_LOAD(kB, rB, vB, s + 1);
              RT_STEP(kA, rA, vA, s);
              if (s + 2 < 32) RT_LOAD(kA, rA, vA, s + 2);
              RT_STEP(kB, rB, vB, s + 1);
          } }
#undef RT_LOAD
#undef RT_STEP
        __syncthreads();
        { const int fs = lt >> 3, c8 = (lt & 7) * 8; bf16* dp2 = (bf16*)(A.ws + WS_YO) + (tok0 + sub * 32 + fs) * 256 + h * 64 + c8;
          const f32x4 x0 = *(const LAS f32x4*)(so + fs * 64 + c8), x1 = *(const LAS f32x4*)(so + fs * 64 + c8 + 4);
          v4u wv; wv.x = pk2(x0.x, x0.y); wv.y = pk2(x0.z, x0.w); wv.z = pk2(x1.x, x1.y); wv.w = pk2(x1.z, x1.w); *(v4u*)dp2 = wv; }
    }
    { float* ch = (float*)(A.ws + WS_CHR) + ((size_t)(bh * NCH + c) * 64 + row) * 64 + 16 * kq;
#pragma unroll
      for (int j4 = 0; j4 < 4; ++j4) *(f32x4*)(ch + 4 * j4) = (f32x4){S[2 * j4].x, S[2 * j4].y, S[2 * j4 + 1].x, S[2 * j4 + 1].y}; }
    __syncthreads();
}
#undef RT_GLOAD
#undef BF8_TO_F32
__device__ __forceinline__ void prefix_chain(ARef A, const WI& w, int bh) {
    LAS float* s0 = (LAS float*)w.lds;
    const int v = w.tid >> 3, k8 = (w.tid & 7) * 8;
    const float* CH = (const float*)(A.ws + WS_CH) + (size_t)bh * NCH * 128 * 64; float* SI = (float*)(A.ws + WS_SI) + (size_t)bh * NCH * 64 * 64;
    f32x4 c0 = {0.f, 0.f, 0.f, 0.f}, c1 = {0.f, 0.f, 0.f, 0.f};
    for (int c = 0; c < NCH; ++c) {
        *(f32x4*)(SI + ((size_t)c * 64 + v) * 64 + k8) = c0; *(f32x4*)(SI + ((size_t)c * 64 + v) * 64 + k8 + 4) = c1;
        if (c == NCH - 1) break;
        __syncthreads();
        *(LAS f32x4*)(s0 + v * 68 + k8) = c0; *(LAS f32x4*)(s0 + v * 68 + k8 + 4) = c1;
        __syncthreads();
        const float* ch = CH + (size_t)c * 128 * 64;
        f32x4 n0 = *(const f32x4*)(ch + (size_t)v * 64 + k8), n1 = *(const f32x4*)(ch + (size_t)v * 64 + k8 + 4);
#pragma unroll 8
        for (int kp = 0; kp < 64; ++kp) { const float s = s0[v * 68 + kp]; const float* pr = ch + (size_t)(64 + kp) * 64 + k8; n0 += s * *(const f32x4*)pr; n1 += s * *(const f32x4*)(pr + 4); }
        c0 = n0; c1 = n1;
    }
    const int h = bh & 3; const float gT = exp2f((float)TCH * log2f(1.0f - exp2f(-5.0f - (float)h)));
    const float* CHR = (const float*)(A.ws + WS_CHR) + (size_t)bh * NCH * 64 * 64; float* SIR = (float*)(A.ws + WS_SIR) + (size_t)bh * NCH * 64 * 64;
    c0 = (f32x4){0.f, 0.f, 0.f, 0.f}; c1 = c0;
    for (int c = 0; c < NCH; ++c) {
        *(f32x4*)(SIR + ((size_t)c * 64 + v) * 64 + k8) = c0; *(f32x4*)(SIR + ((size_t)c * 64 + v) * 64 + k8 + 4) = c1;
        if (c == NCH - 1) break;
        c0 = c0 * gT + *(const f32x4*)(CHR + ((size_t)c * 64 + v) * 64 + k8); c1 = c1 * gT + *(const f32x4*)(CHR + ((size_t)c * 64 + v) * 64 + k8 + 4);
    }
    __syncthreads();
}
typedef float f32x16 __attribute__((ext_vector_type(16)));
constexpr int SBV_PITCH = 144;
__device__ __forceinline__ float lane32_swap(float v) { return __shfl_xor(v, 32); }
__device__ __forceinline__ void sb_tile_mfma(ARef A, int unit, int lane, LAS unsigned char* vl) {
    const int tq = unit & 127, bh = unit >> 7, b = bh >> 2, h = bh & 3, t0 = tq * 32, r32 = lane & 31, hi = lane >> 5;
    const bf16* PS = (const bf16*)(A.ws + WS_PB) + (size_t)b * SEQ * PBW + PB_SB + h * 64;
    bf16x8v qf[4];
#pragma unroll
    for (int ks = 0; ks < 4; ++ks) qf[ks] = *(const bf16x8v*)(PS + (size_t)(t0 + r32) * PBW + 16 * ks + 8 * hi);
    f32x16 o0, o1;
#pragma unroll
    for (int r = 0; r < 16; ++r) { o0[r] = 0.0f; o1[r] = 0.0f; }
    float carry = 0.0f;
    const int g16 = lane >> 4, tj = (lane & 15) >> 2, tc = lane & 3;
    v4u vn[4]; bf16x8v kn[4];
#define SB_FETCH(kb_) do { _Pragma("unroll") for (int i = 0; i < 4; ++i) { const int p = lane + 64 * i, row = p >> 3, ch = p & 7; vn[i] = *(const v4u*)(PS + 512 + (size_t)((kb_) + row) * PBW + 8 * ch); } \
        _Pragma("unroll") for (int ks = 0; ks < 4; ++ks) kn[ks] = *(const bf16x8v*)(PS + 256 + (size_t)((kb_) + r32) * PBW + 16 * ks + 8 * hi); } while (0)
    SB_FETCH(t0);
    for (int kb0 = t0; kb0 >= 0; kb0 -= 32) {
#pragma unroll
        for (int i = 0; i < 4; ++i) { const int p = lane + 64 * i, row = p >> 3, ch = p & 7; *(LAS v4u*)(vl + row * SBV_PITCH + 16 * ch) = vn[i]; }
        f32x16 st;
#pragma unroll
        for (int r = 0; r < 16; ++r) st[r] = 0.0f;
        { bf16x8v ka[4];
#pragma unroll
          for (int ks = 0; ks < 4; ++ks) ka[ks] = kn[ks];
          if (kb0 >= 32) SB_FETCH(kb0 - 32);
#pragma unroll
          for (int ks = 0; ks < 4; ++ks) st = __builtin_amdgcn_mfma_f32_32x32x16_bf16(ka[ks], qf[ks], st, 0, 0, 0);
          asm volatile("" :: "v"(ka[0]), "v"(ka[1]), "v"(ka[2]), "v"(ka[3]), "v"(st)); }
        float sp[16]; const bool diag = (kb0 == t0);
#pragma unroll
        for (int r = 0; r < 16; ++r) { const float zl = st[r]; float s = (zl > 30.0f) ? zl : __builtin_amdgcn_logf(1.0f + __builtin_amdgcn_exp2f(zl));
            if (diag && ((r & 3) + 8 * (r >> 2) + 4 * hi >= r32)) s = 0.0f;
            sp[r] = s; }
        float G[4], Gp[4], suf[4];
#pragma unroll
        for (int q = 0; q < 4; ++q) { G[q] = (sp[4 * q] + sp[4 * q + 1]) + (sp[4 * q + 2] + sp[4 * q + 3]); Gp[q] = lane32_swap(G[q]); }
        suf[3] = 0.0f; suf[2] = G[3] + Gp[3]; suf[1] = suf[2] + (G[2] + Gp[2]); suf[0] = suf[1] + (G[1] + Gp[1]);
        const float tot = suf[0] + (G[0] + Gp[0]);
        pg8::u32x4 pw0, pw1;
        float av[16];
#pragma unroll
        for (int q = 0; q < 4; ++q) { float run = carry + suf[q] + (hi == 0 ? Gp[q] : 0.0f);
#pragma unroll
            for (int i = 3; i >= 0; --i) { const int r = 4 * q + i; const float la = (st[r] - sp[r]) - run; float a = __builtin_amdgcn_exp2f(la);
                if (diag && ((r & 3) + 8 * (r >> 2) + 4 * hi >= r32)) a = 0.0f;
                av[r] = a; run += sp[r]; } }
        pw0.x = pg8::cvt_pk_bf16(av[0], av[1]); pw0.y = pg8::cvt_pk_bf16(av[2], av[3]); pw0.z = pg8::cvt_pk_bf16(av[4], av[5]); pw0.w = pg8::cvt_pk_bf16(av[6], av[7]);
        pw1.x = pg8::cvt_pk_bf16(av[8], av[9]); pw1.y = pg8::cvt_pk_bf16(av[10], av[11]); pw1.z = pg8::cvt_pk_bf16(av[12], av[13]); pw1.w = pg8::cvt_pk_bf16(av[14], av[15]);
        const bf16x8v pa0 = __builtin_bit_cast(bf16x8v, pw0), pa1 = __builtin_bit_cast(bf16x8v, pw1);
        LDS_WAIT();
#pragma unroll
        for (int s = 0; s < 2; ++s)
#pragma unroll
            for (int nb = 0; nb < 2; ++nb) {
                LAS unsigned char* a1 = vl + (16 * s + 4 * (g16 >> 1) + tj) * SBV_PITCH + (32 * nb + 16 * (g16 & 1) + 4 * tc) * 2;
                const s16x4v r1 = __builtin_bit_cast(s16x4v, __builtin_amdgcn_ds_read_tr16_b64_v4i16((LAS s16x4v*)a1));
                const s16x4v r2 = __builtin_bit_cast(s16x4v, __builtin_amdgcn_ds_read_tr16_b64_v4i16((LAS s16x4v*)(a1 + 8 * SBV_PITCH)));
                const bf16x8v bv = {r1[0], r1[1], r1[2], r1[3], r2[0], r2[1], r2[2], r2[3]};
                if (nb == 0) o0 = __builtin_amdgcn_mfma_f32_32x32x16_bf16(s ? pa1 : pa0, bv, o0, 0, 0, 0); else o1 = __builtin_amdgcn_mfma_f32_32x32x16_bf16(s ? pa1 : pa0, bv, o1, 0, 0, 0);
                asm volatile("" :: "v"(bv), "v"(pa0), "v"(pa1), "v"(o0), "v"(o1)); }
        LDS_WAIT();
        carry += tot;
        if (__all(carry > 150.0f)) break;
    }
#undef SB_FETCH
    bf16* YS = (bf16*)((float*)(A.ws + WS_YO) + 3 * YO_STRIDE) + ((size_t)b * SEQ + t0) * 256 + h * 64 + r32;
#pragma unroll
    for (int r = 0; r < 16; ++r) { const int qo = (r & 3) + 8 * (r >> 2) + 4 * hi; YS[(size_t)qo * 256] = (bf16)f2bf(o0[r]); YS[(size_t)qo * 256 + 32] = (bf16)f2bf(o1[r]); }
}

__device__ __forceinline__ void dsa_scores_mfma(ARef A, const WI& w) {
    const _Float16* QIH = (const _Float16*)(A.ws + WS_DQI); const _Float16* KIH = (const _Float16*)(A.ws + WS_DKI);
    const float* DW = (const float*)(A.ws + WS_DW); _Float16* SC = (_Float16*)(A.ws + WS_SC);
    const int col = w.lane & 15, q4 = w.lane >> 4;
    for (int u = w.gw; u < 2048; u += w.NGW) {
        const int pi = u >> 1, par = u & 1, b = pi >> 7, p = pi & 127;
#pragma unroll 1
        for (int side = 0; side < 2; ++side) {
            const int qb = side ? 255 - p : p; const size_t m0 = (size_t)b * SEQ + 16 * qb;
            f16x8 bq[8];
#pragma unroll
            for (int h = 0; h < 8; ++h) bq[h] = *(const f16x8*)(QIH + (m0 + col) * 256 + h * 32 + 8 * q4);
            const float* dw = DW + (m0 + col) * 8; const f32x4 wa = *(const f32x4*)dw, wb = *(const f32x4*)(dw + 4);
            _Float16* srow = SC + (m0 + col) * SEQ + 4 * q4;
            const _Float16* kbase = KIH + ((size_t)b * SEQ + col) * 32 + 8 * q4;
            for (int kq = par; 4 * kq <= qb; kq += 2) {
                f16x8 ak[4];
#pragma unroll
                for (int q = 0; q < 4; ++q) { const int kb = 4 * kq + q; ak[q] = *(const f16x8*)(kbase + (size_t)(kb <= qb ? kb : qb) * 16 * 32); }
#pragma unroll
                for (int q = 0; q < 4; ++q) { const int kb = 4 * kq + q;
                    if (kb <= qb) {
                        f32x4 acc = {0.f, 0.f, 0.f, 0.f};
#pragma unroll
                        for (int h = 0; h < 8; ++h) { const f32x4 c = __builtin_amdgcn_mfma_f32_16x16x32_f16(ak[q], bq[h], (f32x4){0.f, 0.f, 0.f, 0.f}, 0, 0, 0); const float wv = (h < 4) ? wa[h] : wb[h - 4];
                            acc.x += wv * fmaxf(c.x, 0.f); acc.y += wv * fmaxf(c.y, 0.f); acc.z += wv * fmaxf(c.z, 0.f); acc.w += wv * fmaxf(c.w, 0.f); }
                        h4v hs; hs.x = (_Float16)acc.x; hs.y = (_Float16)acc.y; hs.z = (_Float16)acc.z; hs.w = (_Float16)acc.w; *(h4v*)(srow + 16 * kb) = hs; } }
            }
        }
    }
}

__device__ __forceinline__ int wave_total_i(int v) {
    v += __builtin_amdgcn_mov_dpp(v, 0xB1, 0xF, 0xF, true);
    v += __builtin_amdgcn_mov_dpp(v, 0x4E, 0xF, 0xF, true);
    v += __builtin_amdgcn_mov_dpp(v, 0x141, 0xF, 0xF, true);
    v += __builtin_amdgcn_mov_dpp(v, 0x140, 0xF, 0xF, true);
    return __builtin_amdgcn_readlane(v, 0) + __builtin_amdgcn_readlane(v, 16) + __builtin_amdgcn_readlane(v, 32) + __builtin_amdgcn_readlane(v, 48);
}
__device__ __forceinline__ unsigned score_key(float f) { const unsigned bits = __float_as_uint(f); return (bits & 0x80000000u) ? ~bits : (bits | 0x80000000u); }
constexpr int VST_PITCH = 144;
typedef unsigned short u16;
__device__ __forceinline__ void dsa_load_scores(ARef A, int m, int lane, v4u (&sv)[8]) {
    const int n = (m & (SEQ - 1)) + 1; const _Float16* sc = (const _Float16*)(A.ws + WS_SC) + (size_t)m * SEQ + 8 * lane;
#pragma unroll
    for (int c = 0; c < 8; ++c) { if (512 * c < n) sv[c] = *(const v4u*)(sc + 512 * c); else sv[c] = (v4u){0u, 0u, 0u, 0u}; }
}
__device__ __forceinline__ unsigned score_key16(unsigned x) { return ((x & 0x80000000u) ? ~x : (x | 0x80000000u)) & 0xffff0000u; }
__device__ __forceinline__ void dsa_select(ARef A, int m, int n, int lane_in, LAS u16* slist, LAS unsigned* bk) {
    int lane = lane_in; asm volatile("" : "+v"(lane));
    (void)bk;
    if (n <= 256) {
#pragma unroll
        for (int c = 0; c < 4; ++c) { const int idx = lane + 64 * c; slist[idx] = (u16)((idx < n) ? idx : 0); }
        return;
    }
    v4u sv[8]; dsa_load_scores(A, m, lane, sv);
    unsigned u[64];
#pragma unroll
    for (int c = 0; c < 8; ++c)
#pragma unroll
        for (int i = 0; i < 8; ++i) { const unsigned wd = sv[c][i >> 1]; u[8 * c + i] = (512 * c + 8 * lane + i < n) ? score_key16((i & 1) ? wd : (wd << 16)) : 0u; }
    unsigned T = 0u;
    for (int bit = 31; bit >= 16; --bit) { const unsigned cand = T | (1u << bit); int cnt = 0;
#pragma unroll
        for (int c = 0; c < 8; ++c) { if (512 * c < n) {
#pragma unroll
            for (int j = 8 * c; j < 8 * c + 8; ++j) cnt += (u[j] >= cand) ? 1 : 0; } }
        if (wave_total_i(cnt) >= 256) T = cand; }
    unsigned long long gtb = 0ull, eqb = 0ull;
#pragma unroll
    for (int c = 0; c < 8; ++c) { if (512 * c < n) {
#pragma unroll
        for (int j = 8 * c; j < 8 * c + 8; ++j) { gtb |= (unsigned long long)((u[j] > T) ? 1u : 0u) << j; eqb |= (unsigned long long)((u[j] == T) ? 1u : 0u) << j; } } }
    const int tgt = wave_total_i(__popcll(gtb)), teq = wave_total_i(__popcll(eqb));
    unsigned long long selb = gtb | eqb;
    if (tgt + teq > 256) {
        const int take = 256 - tgt; int lo = 0;
        for (int bit = 11; bit >= 0; --bit) { const int cand = lo | (1 << bit); const int J8 = cand >> 9; int ni = (cand & 511) - 8 * lane; ni = ni < 0 ? 0 : (ni > 8 ? 8 : ni);
            const int jc = 8 * J8 + ni; const unsigned long long msk = (jc >= 64) ? ~0ull : ((1ull << jc) - 1ull);
            if (wave_total_i(__popcll(eqb & msk)) < take) lo = cand; }
        { const int cand = lo + 1; const int J8 = cand >> 9; int ni = (cand & 511) - 8 * lane; ni = ni < 0 ? 0 : (ni > 8 ? 8 : ni);
          const int jc = (cand >= SEQ) ? 64 : 8 * J8 + ni; const unsigned long long msk = (jc >= 64) ? ~0ull : ((1ull << jc) - 1ull); selb = gtb | (eqb & msk); }
    }
    const int mine = __popcll(selb); int off = mine;
#pragma unroll
    for (int d = 1; d < 64; d <<= 1) { const int y = __shfl_up(off, d); if (lane >= d) off += y; }
    off -= mine;
    while (selb) { const int j = __builtin_ctzll(selb); selb &= selb - 1ull; slist[off] = (u16)(512 * (j >> 3) + 8 * lane + (j & 7)); ++off; }
}
__device__ __forceinline__ void dsa_attend(ARef A, int m, int lane_in, const LAS u16* slist, LAS unsigned char* vbuf) {
    int lane = lane_in; asm volatile("" : "+v"(lane));
    const int b = m >> 12, t = m & (SEQ - 1), n = t + 1, nsel = n < 256 ? n : 256, col = lane & 15, q4 = lane >> 4;
    const bf16* DKB = (const bf16*)(A.ws + WS_DKB) + (size_t)b * SEQ * 64; const bf16* DVB = (const bf16*)(A.ws + WS_DVB) + (size_t)b * SEQ * 64;
    const int vrow = lane >> 3, vpc = lane & 7;
    bf16x8v bq0 = {0, 0, 0, 0, 0, 0, 0, 0}, bq1 = {0, 0, 0, 0, 0, 0, 0, 0};
    if (col < 4) { const bf16* qp = (const bf16*)(A.ws + WS_DQ) + (size_t)m * 256 + col * 64 + 8 * q4; bq0 = *(const bf16x8v*)qp; bq1 = *(const bf16x8v*)(qp + 32); }
    f32x4 lg[16];
#pragma unroll
    for (int hb = 0; hb < 1; ++hb) {
        bf16x8v a0[16], a1[16];
#pragma unroll
        for (int k = 0; k < 16; ++k) { const int s = slist[16 * k + col]; const bf16* kr = DKB + (size_t)s * 64 + 8 * q4; a0[k] = *(const bf16x8v*)kr; a1[k] = *(const bf16x8v*)(kr + 32); }
#pragma unroll
        for (int k = 0; k < 16; ++k) { const f32x4 c = __builtin_amdgcn_mfma_f32_16x16x32_bf16(a0[k], bq0, (f32x4){0.f, 0.f, 0.f, 0.f}, 0, 0, 0); lg[k] = __builtin_amdgcn_mfma_f32_16x16x32_bf16(a1[k], bq1, c, 0, 0, 0); }
        __builtin_amdgcn_sched_barrier(0);
    }
    if (nsel < 256) {
#pragma unroll
        for (int kb = 0; kb < 16; ++kb)
#pragma unroll
            for (int r = 0; r < 4; ++r) if (16 * kb + 4 * q4 + r >= nsel) lg[kb][r] = -INFINITY; }
    v4u vr[4][4];
#pragma unroll
    for (int c = 0; c < 4; ++c)
#pragma unroll
        for (int i = 0; i < 4; ++i) { const int s = slist[32 * c + vrow + 8 * i]; vr[c][i] = *(const v4u*)(DVB + (size_t)s * 64 + 8 * vpc); }
    float mx = -INFINITY;
#pragma unroll
    for (int kb = 0; kb < 16; ++kb) mx = fmaxf(fmaxf(mx, fmaxf(lg[kb].x, lg[kb].y)), fmaxf(lg[kb].z, lg[kb].w));
    mx = fmaxf(mx, __shfl_xor(mx, 16)); mx = fmaxf(mx, __shfl_xor(mx, 32));
    float sm = 0.f;
#pragma unroll
    for (int kb = 0; kb < 16; ++kb) { lg[kb].x = __builtin_amdgcn_exp2f(lg[kb].x - mx); lg[kb].y = __builtin_amdgcn_exp2f(lg[kb].y - mx); lg[kb].z = __builtin_amdgcn_exp2f(lg[kb].z - mx); lg[kb].w = __builtin_amdgcn_exp2f(lg[kb].w - mx); sm += (lg[kb].x + lg[kb].y) + (lg[kb].z + lg[kb].w); }
    sm += __shfl_xor(sm, 16); sm += __shfl_xor(sm, 32);
    const float inv = 1.0f / sm;
    bf16x8v pa[8];
#pragma unroll
    for (int i = 0; i < 8; ++i) { const f32x4 x = lg[2 * i] * inv, y = lg[2 * i + 1] * inv;
        pg8::u32x4 wv; wv.x = pg8::cvt_pk_bf16(x.x, x.y); wv.y = pg8::cvt_pk_bf16(x.z, x.w); wv.z = pg8::cvt_pk_bf16(y.x, y.y); wv.w = pg8::cvt_pk_bf16(y.z, y.w);
        pa[i] = __builtin_bit_cast(bf16x8v, wv); }
    f32x4 o[4];
#pragma unroll
    for (int nb = 0; nb < 4; ++nb) o[nb] = (f32x4){0.f, 0.f, 0.f, 0.f};
    const int tj = col >> 2, tc = col & 3;
#pragma unroll
    for (int c = 0; c < 8; ++c) {
        LAS unsigned char* vb = vbuf + (c & 1) * (32 * VST_PITCH);
#pragma unroll
        for (int i = 0; i < 4; ++i) *(LAS v4u*)(vb + (vrow + 8 * i) * VST_PITCH + 16 * vpc) = vr[c & 3][i];
        if (c < 4) {
#pragma unroll
            for (int i = 0; i < 4; ++i) { const int s = slist[32 * (c + 4) + vrow + 8 * i]; vr[c & 3][i] = *(const v4u*)(DVB + (size_t)s * 64 + 8 * vpc); } }
        LDS_WAIT();
#pragma unroll
        for (int nb = 0; nb < 4; ++nb) {
            LAS unsigned char* a1 = vb + (4 * q4 + tj) * VST_PITCH + (16 * nb + 4 * tc) * 2;
            const s16x4v r1 = __builtin_bit_cast(s16x4v, __builtin_amdgcn_ds_read_tr16_b64_v4i16((LAS s16x4v*)a1));
            const s16x4v r2 = __builtin_bit_cast(s16x4v, __builtin_amdgcn_ds_read_tr16_b64_v4i16((LAS s16x4v*)(a1 + 16 * VST_PITCH)));
            const bf16x8v bv = {r1[0], r1[1], r1[2], r1[3], r2[0], r2[1], r2[2], r2[3]};
            o[nb] = __builtin_amdgcn_mfma_f32_16x16x32_bf16(pa[c], bv, o[nb], 0, 0, 0); }
    }
    LDS_WAIT();
    if (lane < 16) { bf16* YD = (bf16*)((float*)(A.ws + WS_YO) + 2 * YO_STRIDE) + (size_t)m * 256;
#pragma unroll
        for (int nb = 0; nb < 4; ++nb) { YD[16 * nb + lane] = (bf16)f2bf(o[nb].x); YD[64 + 16 * nb + lane] = (bf16)f2bf(o[nb].y); YD[128 + 16 * nb + lane] = (bf16)f2bf(o[nb].z); YD[192 + 16 * nb + lane] = (bf16)f2bf(o[nb].w); } }
}
constexpr int DSA_GR = 1;
__device__ __forceinline__ int dsa_row_of(int batch, int gi, int r) { const int idx = DSA_GR * gi + r, h = idx >> 1; return batch * SEQ + ((idx & 1) ? (SEQ - 1 - h) : h); }
__device__ __forceinline__ void dsa_wave(ARef A, const WI& w, LAS unsigned char* wl, int qi, int l, int skip = 0) {
    LAS u16* lists = (LAS u16*)wl; LAS unsigned char* vbuf = wl + 4096; LAS unsigned* bk = (LAS unsigned*)vbuf;
#pragma unroll 1
    for (int kb = 0; kb < NB; ++kb) {
        const int batch = (w.bx + kb) & (NB - 1);
        unsigned* head = (unsigned*)(A.ws + WS_CTL) + CW_DSAQ + 128 * qi + 16 * batch;
        int graw = 0; if (w.lane == 0) graw = (int)atomicAdd(head, 1u);
        for (;;) {
            const int g = __builtin_amdgcn_readfirstlane(graw);
            if (g >= 11 * (SEQ / 8)) break;
            graw = 0; if (w.lane == 0) graw = (int)atomicAdd(head, 1u);
            const int per = g / 11, pos = g - 11 * per;
            if (pos >= 8) { if (!(skip & 4)) moe_convert_chunk(A, l, batch * 1536 + 3 * per + (pos - 8), w.lane, (LAS float*)vbuf); continue; }
            if (skip & 2) continue;
            const int gi = 8 * per + pos;
            { const int m = dsa_row_of(batch, gi, 0), n = (m & (SEQ - 1)) + 1; dsa_select(A, m, n, w.lane, lists, bk); }
            LDS_WAIT();
            if (!(skip & 1)) dsa_attend(A, dsa_row_of(batch, gi, 0), w.lane, lists, vbuf);
        }
    }
}

__device__ __forceinline__ f32x4 head_norm4(f32x4 y, float eps, f32x4 g) {
    const float mean = grp16_sum(sum4(y)) * (1.0f / 64.0f); const f32x4 yc = y - mean;
    const float var = grp16_sum(dot4(yc, yc)) * (1.0f / 64.0f); return yc * (1.0f / sqrtf(var + eps)) * g;
}
template <bool BF> __device__ __forceinline__ f32x4 state_corr(const LAS float* sl, int hh, int r16, const void* pv) {
    const LAS float* r0 = sl + (hh * 64 + 4 * r16) * 64; const int x0 = (4 * r16) & 15;
    f32x4 out = {0.f, 0.f, 0.f, 0.f};
#pragma unroll 2
    for (int k8 = 0; k8 < 8; ++k8) {
        f32x4 pa, pb;
        if (BF) { const v4u x = ((const v4u*)pv)[k8]; pa = (f32x4){bf_lo(x.x), bf_hi(x.x), bf_lo(x.y), bf_hi(x.y)}; pb = (f32x4){bf_lo(x.z), bf_hi(x.z), bf_lo(x.w), bf_hi(x.w)}; }
        else { pa = ((const f32x4*)pv)[2 * k8]; pb = ((const f32x4*)pv)[2 * k8 + 1]; }
#pragma unroll
        for (int i = 0; i < 4; ++i) { const LAS float* rowp = r0 + i * 64; const int xs = (x0 + i) & 15;
            out[i] += dot4(*(const LAS f32x4*)(rowp + 4 * ((2 * k8) ^ xs)), pa) + dot4(*(const LAS f32x4*)(rowp + 4 * ((2 * k8 + 1) ^ xs)), pb); }
    }
    return out;
}
__device__ __forceinline__ void post_row(ARef A, int l, int m, int lane, const LAS float* slw, const LAS float* slr) {
    const float* YO = (const float*)(A.ws + WS_YO); const float* RWA = (const float*)(A.ws + WS_RWA);
    bf16* MX = (bf16*)(A.ws + WS_MIX) + (size_t)m * DM; const int c4 = 4 * lane, hh = lane >> 4, r16 = lane & 15; const size_t o = (size_t)m * 256 + c4;
    { f32x4 y = *(const f32x4*)(YO + o) + state_corr<true>(slr, hh, r16, (const bf16*)(A.ws + WS_PTR) + (size_t)m * 256 + hh * 64);
      y = head_norm4(y, 1e-5f, *(const f32x4*)(A.in[I_RETGN] + l * 256 + c4));
      const v2u gw_ = *(const v2u*)((const bf16*)(A.ws + WS_PB) + (size_t)m * PBW + 768 + c4); const f32x4 g = {bf_lo(gw_.x), bf_hi(gw_.x), bf_lo(gw_.y), bf_hi(gw_.y)};
#pragma unroll
      for (int i = 0; i < 4; ++i) y[i] *= g[i] * sigm(g[i]);
      v2u w; w.x = pk2(y.x, y.y); w.y = pk2(y.z, y.w); *(v2u*)(MX + c4) = w; }
    { f32x4 y = *(const f32x4*)(YO + YO_STRIDE + o) + state_corr<false>(slw, hh, r16, (const float*)(A.ws + WS_PT) + (size_t)m * 256 + hh * 64);
      y = head_norm4(y, 64e-5f, *(const f32x4*)(A.in[I_LN] + l * 256 + c4));
      y = (y + *(const f32x4*)(RWA + 7 * RWA_STRIDE + o)) * *(const f32x4*)(RWA + 6 * RWA_STRIDE + o);
      v2u w; w.x = pk2(y.x, y.y); w.y = pk2(y.z, y.w); *(v2u*)(MX + 256 + c4) = w; }
    { f32x4 y = *(const f32x4*)(YO + 2 * YO_STRIDE + o); const float r = 1.0f / sqrtf(wave_sum(dot4(y, y)) * (1.0f / 256.0f) + 1e-5f);
      y = y * r * *(const f32x4*)(A.in[I_DONORM] + l * 256 + c4);
      v2u w; w.x = pk2(y.x, y.y); w.y = pk2(y.z, y.w); *(v2u*)(MX + 512 + c4) = w; }
    { f32x4 y = *(const f32x4*)(YO + 3 * YO_STRIDE + o); const float r = 1.0f / sqrtf(wave_sum(dot4(y, y)) * (1.0f / 256.0f) + 1e-5f);
      y = y * r * *(const f32x4*)(A.in[I_SONORM] + l * 256 + c4);
      v2u w; w.x = pk2(y.x, y.y); w.y = pk2(y.z, y.w); *(v2u*)(MX + 768 + c4) = w; }
}
__device__ __forceinline__ void ph_post(ARef A, const WI& w, int l) {
    LAS float* slw = (LAS float*)w.lds; LAS float* slr = slw + 16384;
    for (int u = w.vcu; u < NB * NCH * 2; u += w.G) {
        const int b = u >> 5, c = (u >> 1) & 15, half = u & 1;
        __syncthreads();
        for (int e = w.tid; e < 4096; e += NWAVES * 64) { const int hh = e >> 10, v = (e >> 4) & 63, k4 = e & 15;
            const size_t src = ((size_t)((b * 4 + hh) * NCH + c) * 64 + v) * 64 + 4 * k4; const int dst = (hh * 64 + v) * 64 + 4 * (k4 ^ (v & 15));
            *(LAS f32x4*)(slw + dst) = *(const f32x4*)((const float*)(A.ws + WS_SI) + src); *(LAS f32x4*)(slr + dst) = *(const f32x4*)((const float*)(A.ws + WS_SIR) + src); }
        __syncthreads();
        const int tok0 = b * SEQ + c * TCH + half * 128 + w.wave * 16;
        for (int i = 0; i < 16; ++i) post_row(A, l, tok0 + i, w.lane, slw, slr);
    }
}

constexpr int S0_PITCH = 144;
template <int MIXER> __device__ __forceinline__ void post16_head(ARef A, int l, size_t m, int hh, int tk, int fq, const LAS unsigned char* s0) {
    const size_t o = m * 256 + hh * 64 + 8 * fq;
    bf16x8v pb[2];
    if (MIXER == 0) { const bf16* pp = (const bf16*)(A.ws + WS_PTR) + o; pb[0] = *(const bf16x8v*)pp; pb[1] = *(const bf16x8v*)(pp + 32); }
    else { const bf16* pp = (const bf16*)(A.ws + WS_PT) + o; pb[0] = *(const bf16x8v*)pp; pb[1] = *(const bf16x8v*)(pp + 32); }
    f32x4 y[4];
    const bf16* yl = (const bf16*)((const float*)(A.ws + WS_YO) + MIXER * YO_STRIDE) + o;
#pragma unroll
    for (int j = 0; j < 2; ++j) { const v4u x = *(const v4u*)(yl + 32 * j); y[2 * j] = (f32x4){bf_lo(x.x), bf_hi(x.x), bf_lo(x.y), bf_hi(x.y)}; y[2 * j + 1] = (f32x4){bf_lo(x.z), bf_hi(x.z), bf_lo(x.w), bf_hi(x.w)}; }
    const float* gw = ((MIXER == 0) ? A.in[I_RETGN] : A.in[I_LN]) + l * 256 + hh * 64 + 8 * fq;
    f32x4 gn[4], e0[4], e1[4];
#pragma unroll
    for (int mb = 0; mb < 4; ++mb) gn[mb] = *(const f32x4*)(gw + 32 * (mb >> 1) + 4 * (mb & 1));
    if (MIXER == 0) {
#pragma unroll
        for (int j = 0; j < 2; ++j) { const v4u gx = *(const v4u*)((const bf16*)(A.ws + WS_PB) + m * PBW + 768 + hh * 64 + 8 * fq + 32 * j);
            e0[2 * j] = (f32x4){bf_lo(gx.x), bf_hi(gx.x), bf_lo(gx.y), bf_hi(gx.y)}; e0[2 * j + 1] = (f32x4){bf_lo(gx.z), bf_hi(gx.z), bf_lo(gx.w), bf_hi(gx.w)}; }
    } else { const float* RWA = (const float*)(A.ws + WS_RWA);
#pragma unroll
        for (int j = 0; j < 2; ++j) { const v4u bx_ = *(const v4u*)((const bf16*)(RWA + 7 * RWA_STRIDE) + o + 32 * j), gx_ = *(const v4u*)((const bf16*)(RWA + 6 * RWA_STRIDE) + o + 32 * j);
            e0[2 * j] = (f32x4){bf_lo(bx_.x), bf_hi(bx_.x), bf_lo(bx_.y), bf_hi(bx_.y)}; e0[2 * j + 1] = (f32x4){bf_lo(bx_.z), bf_hi(bx_.z), bf_lo(bx_.w), bf_hi(bx_.w)};
            e1[2 * j] = (f32x4){bf_lo(gx_.x), bf_hi(gx_.x), bf_lo(gx_.y), bf_hi(gx_.y)}; e1[2 * j + 1] = (f32x4){bf_lo(gx_.z), bf_hi(gx_.z), bf_lo(gx_.w), bf_hi(gx_.w)}; } }
    const LAS unsigned char* ab = s0 + ((MIXER * 4 + hh) * 64 + 8 * (tk >> 2) + (tk & 3)) * S0_PITCH + 16 * fq;
#pragma unroll
    for (int mb = 0; mb < 4; ++mb)
#pragma unroll
        for (int ks = 0; ks < 2; ++ks) { const bf16x8v af = *(const LAS bf16x8v*)(ab + (32 * (mb >> 1) + 4 * (mb & 1)) * S0_PITCH + 64 * ks); y[mb] = __builtin_amdgcn_mfma_f32_16x16x32_bf16(af, pb[ks], y[mb], 0, 0, 0); }
    float s = (sum4(y[0]) + sum4(y[1])) + (sum4(y[2]) + sum4(y[3])); s += __shfl_xor(s, 16); s += __shfl_xor(s, 32);
    const float mean = s * (1.0f / 64.0f);
#pragma unroll
    for (int mb = 0; mb < 4; ++mb) y[mb] = y[mb] - mean;
    float q = (dot4(y[0], y[0]) + dot4(y[1], y[1])) + (dot4(y[2], y[2]) + dot4(y[3], y[3])); q += __shfl_xor(q, 16); q += __shfl_xor(q, 32);
    const float rs = 1.0f / sqrtf(q * (1.0f / 64.0f) + ((MIXER == 0) ? 1e-5f : 64e-5f));
    bf16* MX = (bf16*)(A.ws + WS_MIX) + m * DM + MIXER * 256 + hh * 64 + 8 * fq;
#pragma unroll
    for (int j = 0; j < 2; ++j) { f32x4 ya = y[2 * j] * rs * gn[2 * j], yb = y[2 * j + 1] * rs * gn[2 * j + 1];
        if (MIXER == 0) {
#pragma unroll
            for (int i = 0; i < 4; ++i) { ya[i] *= e0[2 * j][i] * sigm(e0[2 * j][i]); yb[i] *= e0[2 * j + 1][i] * sigm(e0[2 * j + 1][i]); }
        } else { ya = (ya + e0[2 * j]) * e1[2 * j]; yb = (yb + e0[2 * j + 1]) * e1[2 * j + 1]; }
        v4u wv; wv.x = pk2(ya.x, ya.y); wv.y = pk2(ya.z, ya.w); wv.z = pk2(yb.x, yb.y); wv.w = pk2(yb.z, yb.w); *(v4u*)(MX + 32 * j) = wv; }
}
__device__ __forceinline__ void post16_rms(ARef A, int l, size_t m, int mx, int fq) {
    const bf16* yp = (const bf16*)((const float*)(A.ws + WS_YO) + (size_t)mx * YO_STRIDE) + m * 256 + 8 * fq; const float* gw = ((mx == 2) ? A.in[I_DONORM] : A.in[I_SONORM]) + l * 256 + 8 * fq;
    f32x4 y[16];
#pragma unroll
    for (int j = 0; j < 8; ++j) { const v4u x = *(const v4u*)(yp + 32 * j); y[2 * j] = (f32x4){bf_lo(x.x), bf_hi(x.x), bf_lo(x.y), bf_hi(x.y)}; y[2 * j + 1] = (f32x4){bf_lo(x.z), bf_hi(x.z), bf_lo(x.w), bf_hi(x.w)}; }
    float q = 0.0f;
#pragma unroll
    for (int j = 0; j < 16; ++j) q += dot4(y[j], y[j]);
    q += __shfl_xor(q, 16); q += __shfl_xor(q, 32);
    const float r = 1.0f / sqrtf(q * (1.0f / 256.0f) + 1e-5f);
    bf16* MX = (bf16*)(A.ws + WS_MIX) + m * DM + mx * 256 + 8 * fq;
#pragma unroll
    for (int j = 0; j < 8; ++j) { const f32x4 ya = y[2 * j] * r * *(const f32x4*)(gw + 32 * j), yb = y[2 * j + 1] * r * *(const f32x4*)(gw + 32 * j + 4);
        v4u wv; wv.x = pk2(ya.x, ya.y); wv.y = pk2(ya.z, ya.w); wv.z = pk2(yb.x, yb.y); wv.w = pk2(yb.z, yb.w); *(v4u*)(MX + 32 * j) = wv; }
}
__device__ __forceinline__ void ph_post16(ARef A, const WI& w, int l) {
    LAS unsigned char* s0 = w.lds;
    for (int u = w.vcu; u < NB * NCH * 2; u += w.G) {
        const int b = u >> 5, c = (u >> 1) & 15, half = u & 1;
        __syncthreads();
#pragma unroll 2
        for (int e = w.tid; e < 4096; e += NWAVES * 64) { const int hd = e >> 9, v = (e >> 3) & 63, k8 = e & 7;
            const float* src = (const float*)(A.ws + ((hd < 4) ? WS_SIR : WS_SI)) + ((size_t)((b * 4 + (hd & 3)) * NCH + c) * 64 + v) * 64 + 8 * k8;
            const f32x4 x0 = *(const f32x4*)src, x1 = *(const f32x4*)(src + 4);
            v4u wv; wv.x = pk2(x0.x, x0.y); wv.y = pk2(x0.z, x0.w); wv.z = pk2(x1.x, x1.y); wv.w = pk2(x1.z, x1.w); *(LAS v4u*)(s0 + (hd * 64 + v) * S0_PITCH + 16 * k8) = wv; }
        __syncthreads();
        int lane = w.lane; asm volatile("" : "+v"(lane));
        const int tk = lane & 15, fq = lane >> 4; const size_t m = (size_t)(b * SEQ + c * TCH + half * 128 + w.wave * 16 + tk);
#pragma unroll 1
        for (int hh = 0; hh < 4; ++hh) post16_head<0>(A, l, m, hh, tk, fq, s0);
#pragma unroll 1
        for (int hh = 0; hh < 4; ++hh) post16_head<1>(A, l, m, hh, tk, fq, s0);
#pragma unroll 1
        for (int mx = 2; mx < 4; ++mx) post16_rms(A, l, m, mx, fq);
    }
}

__device__ __forceinline__ float wave_max_f(float v) {
    v = fmaxf(v, __builtin_bit_cast(float, __builtin_amdgcn_mov_dpp(__builtin_bit_cast(int, v), 0xB1, 0xF, 0xF, true)));
    v = fmaxf(v, __builtin_bit_cast(float, __builtin_amdgcn_mov_dpp(__builtin_bit_cast(int, v), 0x4E, 0xF, 0xF, true)));
    v = fmaxf(v, __builtin_bit_cast(float, __builtin_amdgcn_mov_dpp(__builtin_bit_cast(int, v), 0x141, 0xF, 0xF, true)));
    v = fmaxf(v, __builtin_bit_cast(float, __builtin_amdgcn_mov_dpp(__builtin_bit_cast(int, v), 0x140, 0xF, 0xF, true)));
    const int iv = __builtin_bit_cast(int, v);
    return fmaxf(fmaxf(__builtin_bit_cast(float, __builtin_amdgcn_readlane(iv, 0)), __builtin_bit_cast(float, __builtin_amdgcn_readlane(iv, 16))), fmaxf(__builtin_bit_cast(float, __builtin_amdgcn_readlane(iv, 32)), __builtin_bit_cast(float, __builtin_amdgcn_readlane(iv, 48))));
}
__device__ __forceinline__ void router_stage(ARef A, const WI& w, int l) {
    LAS float* rwl = (LAS float*)w.lds; const float* rw = A.in[I_RW] + (size_t)l * DM * 32;
    for (int e = w.tid; e < DM * 8; e += NWAVES * 64) { const int k = e >> 3, c = e & 7; *(LAS f32x4*)(rwl + k * 32 + 4 * (c ^ ((k >> 2) & 7))) = *(const f32x4*)(rw + (size_t)k * 32 + 4 * c); }
    __syncthreads();
}
__device__ __forceinline__ void router_row(ARef A, int l, int m, int lane, LAS unsigned* hist, const LAS float* rwl, LAS int* texp, bool dry = false) {
    const float* XA = (const float*)(A.ws + WS_XA) + (size_t)m * DM; const float* MOD = (const float*)(A.ws + WS_MOD) + (size_t)(l * 8 + (m >> 12)) * 6144;
    f32x4 v[4]; float ss = 0.0f;
#pragma unroll
    for (int j = 0; j < 4; ++j) { v[j] = *(const f32x4*)(XA + 4 * (lane + 64 * j)); ss += dot4(v[j], v[j]); }
    ss = wave_sum(ss); const float rstd = 1.0f / sqrtf(ss * (1.0f / DM) + 1e-5f);
    const float* g = A.in[I_NFFN] + l * DM; const float* scp = MOD + 4 * 1024; const float* shp = MOD + 3 * 1024;
    emit_h_row(v, rstd, g, scp, shp, (bf16*)(A.ws + WS_H) + (size_t)m * DM, lane);
    float p[32];
#pragma unroll
    for (int e = 0; e < 32; ++e) p[e] = 0.0f;
    const int sw = lane & 7;
#pragma unroll 1
    for (int j = 0; j < 4; ++j) { const int k = 4 * (lane + 64 * j);
        const f32x4 h = *(const f32x4*)(XA + k) * rstd * *(const f32x4*)(g + k) * (1.0f + *(const f32x4*)(scp + k)) + *(const f32x4*)(shp + k);
        const LAS float* row = rwl + k * 32;
#pragma unroll
        for (int i = 0; i < 4; ++i) {
#pragma unroll
            for (int q4 = 0; q4 < 8; ++q4) { const f32x4 r = *(const LAS f32x4*)(row + i * 32 + 4 * (q4 ^ sw)); p[4 * q4] += h[i] * r.x; p[4 * q4 + 1] += h[i] * r.y; p[4 * q4 + 2] += h[i] * r.z; p[4 * q4 + 3] += h[i] * r.w; } } }
    float q16[16], q8[8], q4v[4], q2[2], q1;
    { const bool hb = (lane & 32) != 0;
#pragma unroll
      for (int i = 0; i < 16; ++i) { const float mine = hb ? p[16 + i] : p[i], oth = hb ? p[i] : p[16 + i]; q16[i] = mine + __shfl_xor(oth, 32); } }
    { const bool hb = (lane & 16) != 0;
#pragma unroll
      for (int i = 0; i < 8; ++i) { const float mine = hb ? q16[8 + i] : q16[i], oth = hb ? q16[i] : q16[8 + i]; q8[i] = mine + __shfl_xor(oth, 16); } }
    { const bool hb = (lane & 8) != 0;
#pragma unroll
      for (int i = 0; i < 4; ++i) { const float mine = hb ? q8[4 + i] : q8[i], oth = hb ? q8[i] : q8[4 + i]; q4v[i] = mine + __shfl_xor(oth, 8); } }
    { const bool hb = (lane & 4) != 0;
#pragma unroll
      for (int i = 0; i < 2; ++i) { const float mine = hb ? q4v[2 + i] : q4v[i], oth = hb ? q4v[i] : q4v[2 + i]; q2[i] = mine + __shfl_xor(oth, 4); } }
    { const bool hb = (lane & 2) != 0; const float mine = hb ? q2[1] : q2[0], oth = hb ? q2[0] : q2[1]; q1 = mine + __shfl_xor(oth, 2); }
    q1 += __shfl_xor(q1, 1);
    float lv = q1 + A.in[I_RB][l * 32 + (lane >> 1)];
    float tv[4]; int ti[4];
#pragma unroll
    for (int kk = 0; kk < 4; ++kk) { const float mx = wave_max_f(lv); const unsigned long long msk = __ballot(lv == mx); const int e = msk ? (int)(__builtin_ctzll(msk) >> 1) : kk;
        tv[kk] = mx; ti[kk] = e; if ((lane >> 1) == e) lv = -INFINITY; }
    const float e1 = expf(tv[1] - tv[0]), e2 = expf(tv[2] - tv[0]), e3 = expf(tv[3] - tv[0]); const float inv = 1.0f / (1.0f + e1 + e2 + e3);
    if (lane == 0 && !dry) {
        int* TI = (int*)(A.ws + WS_TOPI) + (size_t)m * 4; float* TW = (float*)(A.ws + WS_TOPW) + (size_t)m * 4;
        TI[0] = ti[0]; TI[1] = ti[1]; TI[2] = ti[2]; TI[3] = ti[3]; texp[0] = ti[0]; texp[1] = ti[1]; texp[2] = ti[2]; texp[3] = ti[3]; TW[0] = inv; TW[1] = e1 * inv; TW[2] = e2 * inv; TW[3] = e3 * inv;
        { unsigned* hg = (unsigned*)hist; atomicAdd(hg + ti[0], 1u); atomicAdd(hg + ti[1], 1u); atomicAdd(hg + ti[2], 1u); atomicAdd(hg + ti[3], 1u); }
    }
}
__device__ __forceinline__ void router_stage16(ARef A, const WI& w, int l) {
    LAS unsigned char* rwt = w.lds; const float* rw = A.in[I_RW] + (size_t)l * DM * 32;
    const int k0 = 2 * w.tid;
    const int c = k0 >> 3, kin = (k0 & 7) * 2;
#pragma unroll
    for (int e4 = 0; e4 < 8; ++e4) { const f32x4 a = *(const f32x4*)(rw + (size_t)k0 * 32 + 4 * e4), b = *(const f32x4*)(rw + (size_t)(k0 + 1) * 32 + 4 * e4);
#pragma unroll
        for (int i = 0; i < 4; ++i) { const int e = 4 * e4 + i; const unsigned hi = pg8::cvt_pk_bf16(a[i], b[i]); const float ra = a[i] - bf_lo(hi), rb = b[i] - bf_hi(hi); const unsigned lo = pg8::cvt_pk_bf16(ra, rb);
            const int off = e * 2048 + ((c ^ (e & 15)) * 16) + kin; *(LAS unsigned*)(rwt + off) = hi; *(LAS unsigned*)(rwt + 65536 + off) = lo; } }
    __syncthreads();
}
__device__ __forceinline__ void router16(ARef A, int l, int m0, int lane_in, LAS unsigned* hist, const LAS unsigned char* rwt, LAS int* texp, bool dry) {
    int lane = lane_in; asm volatile("" : "+v"(lane));
    const int tk = lane & 15, q4 = lane >> 4; const size_t m = (size_t)m0 + tk;
    const float* xr = (const float*)(A.ws + WS_XA) + m * DM + 8 * q4; const float* MOD = (const float*)(A.ws + WS_MOD) + (size_t)(l * 8 + (m0 >> 12)) * 6144;
    const float* g = A.in[I_NFFN] + l * DM + 8 * q4; const float* scp = MOD + 4 * 1024 + 8 * q4; const float* shp = MOD + 3 * 1024 + 8 * q4;
    bf16* hrow = (bf16*)(A.ws + WS_H) + m * DM + 8 * q4;
    float ss = 0.0f;
#pragma unroll 16
    for (int ks = 0; ks < 32; ++ks) { const f32x4 a = *(const f32x4*)(xr + 32 * ks), b = *(const f32x4*)(xr + 32 * ks + 4); ss += dot4(a, a) + dot4(b, b); }
    ss += __shfl_xor(ss, 16); ss += __shfl_xor(ss, 32);
    const float rstd = 1.0f / sqrtf(ss * (1.0f / DM) + 1e-5f);
    f32x4 acc[2] = {{0.f, 0.f, 0.f, 0.f}, {0.f, 0.f, 0.f, 0.f}};
    const LAS unsigned char* wrow = rwt + tk * 2048;
#pragma unroll 2
    for (int ks = 0; ks < 32; ++ks) {
        f32x4 h[2];
#pragma unroll
        for (int u = 0; u < 2; ++u) { const int k = 32 * ks + 4 * u; h[u] = *(const f32x4*)(xr + k) * rstd * *(const f32x4*)(g + k) * (1.0f + *(const f32x4*)(scp + k)) + *(const f32x4*)(shp + k); }
        pg8::u32x4 hw, lw;
        hw.x = pg8::cvt_pk_bf16(h[0].x, h[0].y); hw.y = pg8::cvt_pk_bf16(h[0].z, h[0].w); hw.z = pg8::cvt_pk_bf16(h[1].x, h[1].y); hw.w = pg8::cvt_pk_bf16(h[1].z, h[1].w);
        if (!dry) *(pg8::u32x4*)(hrow + 32 * ks) = hw;
        lw.x = pg8::cvt_pk_bf16(h[0].x - bf_lo(hw.x), h[0].y - bf_hi(hw.x)); lw.y = pg8::cvt_pk_bf16(h[0].z - bf_lo(hw.y), h[0].w - bf_hi(hw.y));
        lw.z = pg8::cvt_pk_bf16(h[1].x - bf_lo(hw.z), h[1].y - bf_hi(hw.z)); lw.w = pg8::cvt_pk_bf16(h[1].z - bf_lo(hw.w), h[1].w - bf_hi(hw.w));
        const bf16x8v bh = __builtin_bit_cast(bf16x8v, hw), bl = __builtin_bit_cast(bf16x8v, lw);
        const int coff = ((4 * ks + q4) ^ tk) * 16;
#pragma unroll
        for (int blk = 0; blk < 2; ++blk) { const bf16x8v ah = *(const LAS bf16x8v*)(wrow + blk * 32768 + coff), al = *(const LAS bf16x8v*)(wrow + 65536 + blk * 32768 + coff);
            acc[blk] = __builtin_amdgcn_mfma_f32_16x16x32_bf16(ah, bh, acc[blk], 0, 0, 0); acc[blk] = __builtin_amdgcn_mfma_f32_16x16x32_bf16(ah, bl, acc[blk], 0, 0, 0); acc[blk] = __builtin_amdgcn_mfma_f32_16x16x32_bf16(al, bh, acc[blk], 0, 0, 0); }
    }
    float lv[8]; const float* rb = A.in[I_RB] + l * 32 + 4 * q4;
#pragma unroll
    for (int blk = 0; blk < 2; ++blk)
#pragma unroll
        for (int i = 0; i < 4; ++i) lv[4 * blk + i] = acc[blk][i] + rb[16 * blk + i];
    float tv[4]; int ti[4];
#pragma unroll
    for (int kk = 0; kk < 4; ++kk) {
        float mx = fmaxf(fmaxf(fmaxf(lv[0], lv[1]), fmaxf(lv[2], lv[3])), fmaxf(fmaxf(lv[4], lv[5]), fmaxf(lv[6], lv[7])));
        mx = fmaxf(mx, __shfl_xor(mx, 16)); mx = fmaxf(mx, __shfl_xor(mx, 32));
        int cand = 99;
#pragma unroll
        for (int j = 7; j >= 0; --j) if (lv[j] == mx) cand = 16 * (j >> 2) + 4 * q4 + (j & 3);
        cand = min(cand, __shfl_xor(cand, 16)); cand = min(cand, __shfl_xor(cand, 32));
        if (cand == 99) cand = kk;
        tv[kk] = mx; ti[kk] = cand;
#pragma unroll
        for (int j = 0; j < 8; ++j) if (16 * (j >> 2) + 4 * q4 + (j & 3) == cand) lv[j] = -INFINITY;
    }
    const float e1 = expf(tv[1] - tv[0]), e2 = expf(tv[2] - tv[0]), e3 = expf(tv[3] - tv[0]); const float inv = 1.0f / (1.0f + e1 + e2 + e3);
    if (q4 == 0 && !dry) {
        int* TI = (int*)(A.ws + WS_TOPI) + m * 4; float* TW = (float*)(A.ws + WS_TOPW) + m * 4;
        *(v4u*)TI = (v4u){(unsigned)ti[0], (unsigned)ti[1], (unsigned)ti[2], (unsigned)ti[3]}; *(f32x4*)TW = (f32x4){inv, e1 * inv, e2 * inv, e3 * inv};
        LAS int* tx = texp + tk * 4; tx[0] = ti[0]; tx[1] = ti[1]; tx[2] = ti[2]; tx[3] = ti[3];
        { unsigned* hg = (unsigned*)hist; atomicAdd(hg + ti[0], 1u); atomicAdd(hg + ti[1], 1u); atomicAdd(hg + ti[2], 1u); atomicAdd(hg + ti[3], 1u); }
    }
}
__device__ __forceinline__ void build_expert_table(ARef A, const WI& w, int l) {
    LAS int* tst = (LAS int*)(w.lds + TST_OFF); LAS int* tab = (LAS int*)(w.lds + TAB_OFF); LAS int* cnt = (LAS int*)(w.lds + CNT_OFF);
    if (w.tid == 0) { const unsigned* gc = (const unsigned*)(A.ws + WS_CTL) + CW_GCNT + 64 * l; int acc = 0;
        for (int e = 0; e < 32; ++e) { const int c = (int)__hip_atomic_load(gc + e, RLX_AGENT); cnt[e] = c; tst[e] = acc; acc += (c + 255) >> 8; }
        tst[32] = acc; tab[0] = acc; }
    __syncthreads();
    if (w.tid < 32) { const int e = w.tid; for (int pm = tst[e]; pm < tst[e + 1]; ++pm) tab[1 + pm] = e; }
    __syncthreads();
}
__device__ __forceinline__ void router_lists(ARef A, const WI& w, int l) {
    LAS unsigned* hist = (LAS unsigned*)(w.lds + HIST_OFF); LAS int* base = (LAS int*)(w.lds + BASE_OFF); LAS int* texp = (LAS int*)(w.lds + TEXP_OFF);
    __syncthreads();
    if (w.tid < 32) { base[w.tid] = (int)atomicAdd((unsigned*)(A.ws + WS_CTL) + CW_GCNT + 64 * l + w.tid, hist[w.tid]); hist[w.tid] = 0u; }
    __syncthreads();
    int* LIST = (int*)(A.ws + WS_LIST); int* PW = (int*)(A.ws + WS_POS);
    for (int g16 = w.gw; g16 < MTOK / 16; g16 += w.NGW) {
        const int j = w.lane >> 2, q = w.lane & 3, m = 16 * g16 + j; const int e = texp[(w.wave * 16 + j) * 4 + q]; const int idx = base[e] + (int)atomicAdd((unsigned*)hist + e, 1u);
        LIST[e * LCAP + idx] = m; PW[(size_t)m * 4 + q] = (e << 20) | idx; }
}
__device__ __forceinline__ void combine_row(ARef A, int l, int m, int lane, const LAS int* tst, float gscale = 1.0f, float oscale = 1.0f) {
    float* XA = (float*)(A.ws + WS_XA) + (size_t)m * DM; const float* MOD = (const float*)(A.ws + WS_MOD) + (size_t)(l * 8 + (m >> 12)) * 6144;
    const int* PS = (const int*)(A.ws + WS_POS) + (size_t)m * 4; const float* TW = (const float*)(A.ws + WS_TOPW) + (size_t)m * 4;
    const bf16* YS = (const bf16*)(A.ws + WS_XS);
    f32x4 v[4], acc[4];
#pragma unroll
    for (int j = 0; j < 4; ++j) { v[j] = *(const f32x4*)(XA + 4 * (lane + 64 * j)); acc[j] = (f32x4){0.f, 0.f, 0.f, 0.f}; }
#pragma unroll
    for (int k = 0; k < 4; ++k) { const int pe = PS[k]; const int pos = tst[pe >> 20] * 256 + (pe & 0xFFFFF); const float gt = TW[k] * gscale; const v2u* yr = (const v2u*)(YS + (size_t)pos * DM);
#pragma unroll
        for (int j = 0; j < 4; ++j) { const v2u y = yr[lane + 64 * j]; acc[j] += gt * (f32x4){bf_lo(y.x), bf_hi(y.x), bf_lo(y.y), bf_hi(y.y)}; } }
    float ss = 0.0f;
#pragma unroll
    for (int j = 0; j < 4; ++j) { const int kx = 4 * (lane + 64 * j); v[j] += *(const f32x4*)(MOD + 5 * 1024 + kx) * acc[j]; ss += dot4(v[j], v[j]); }
    ss = wave_sum(ss); const float rstd = 1.0f / sqrtf(ss * (1.0f / DM) + 1e-5f);
    if (l + 1 < NLAYER) {
#pragma unroll
        for (int j = 0; j < 4; ++j) *(f32x4*)(XA + 4 * (lane + 64 * j)) = v[j];
        const float* mb = MOD + 8 * 6144;
        emit_h_row(v, rstd, A.in[I_NMIX] + (l + 1) * DM, mb + 1024, mb, (bf16*)(A.ws + WS_H) + (size_t)m * DM, lane);
    } else {
        float* orow = A.out + (size_t)m * DM; const float* gf = A.in[I_NFINAL];
#pragma unroll
        for (int j = 0; j < 4; ++j) { const int kx = 4 * (lane + 64 * j); *(f32x4*)(orow + kx) = v[j] * (rstd * oscale) * *(const f32x4*)(gf + kx); }
    }
}

constexpr int N_LAUNCHES = MK_N_LAUNCHES;
template <int SEL> __global__ void __launch_bounds__(NWAVES * 64, 2) fwd(ArgsH Ah) {
    extern __shared__ __attribute__((aligned(16))) unsigned char lds[];
    (void)Ah;
    const int wave_s = __builtin_amdgcn_readfirstlane((int)threadIdx.x >> 6);
    auto tid_now = [&]() -> int { int ws_ = wave_s; unsigned z_ = 0u; asm volatile("" : "+s"(ws_), "+s"(z_)); return ws_ * 64 + (int)__builtin_amdgcn_mbcnt_hi(~0u, __builtin_amdgcn_mbcnt_lo(~0u, z_)); };
#define TID_NOW() tid_now()
#define MAKE_WI() WI w; { int tz = TID_NOW(); asm volatile("" : "+v"(tz)); int bz = blockIdx.x, gz = gridDim.x; asm volatile("" : "+s"(bz), "+s"(gz)); \
        w.lds = (LAS unsigned char*)lds; w.tid = tz; w.lane = tz & 63; w.wave = __builtin_amdgcn_readfirstlane(tz >> 6); w.G = gz; w.bx = bz; w.vcu = (gz % 8 == 0) ? (bz % 8) * (gz / 8) + bz / 8 : bz; \
        w.gw = w.vcu * NWAVES + w.wave; w.NGW = gz * NWAVES; }
    { const int t0 = threadIdx.x; for (int u = t0; u < (LDS_BYTES - RING_BYTES) / 4; u += NWAVES * 64) ((LAS unsigned*)((LAS unsigned char*)lds + RING_BYTES))[u] = 0u; }
    __syncthreads();
    int lo, hi; { ARef A0 = *kargs(); lo = A0.ph_lo; hi = A0.ph_hi; }
    if (N_LAUNCHES == 1) { ARef A0 = *kargs(); (void)xcd_barrier_post((unsigned*)((gu32*)(A0.ws + WS_CTL) + CW_BAR), (volatile LAS unsigned*)((LAS unsigned char*)lds + MISC_OFF) + 8, TID_NOW()); }
#define GRID_BAR() do { if (N_LAUNCHES == 1) { ARef Ab = *kargs(); XcdBarrier bar_; bar_.bar = (unsigned*)((gu32*)(Ab.ws + WS_CTL) + CW_BAR); bar_.x = xb_xcc_id(); bar_.st = (volatile LAS unsigned*)((LAS unsigned char*)lds + MISC_OFF) + 8; xcd_barrier(bar_, TID_NOW()); } } while (0)
#ifndef TPROBE
#define TPROBE 0
#endif
#if TPROBE
    unsigned long long tp_acc = 0ull;
#define TP_SCALE tp_scale_of(__hip_atomic_load((unsigned*)(A.ws + WS_CTL) + 3, RLX_AGENT))
    auto tp_scale_of = [](unsigned ticks) -> float { const float us = (float)ticks * 0.01f; if (us < 1.0f) return 1.0f; const float q = exp2f(rintf(log2f(us) * 8.0f) * 0.125f); return 1.0f + sqrtf(q * 1e-5f); };
#define TP_BEGIN(kind) unsigned long long tp_t0 = 0ull; if ((kind) == TPROBE) tp_t0 = __builtin_amdgcn_s_memrealtime();
#define TP_END(kind) if ((kind) == TPROBE) { tp_acc += __builtin_amdgcn_s_memrealtime() - tp_t0; }
#define TP_PUBLISH(l) if ((l) == 1 && w.vcu == 0 && w.tid == 0) __hip_atomic_store((unsigned*)(A.ws + WS_CTL) + 3, (unsigned)tp_acc, RLX_AGENT);
#else
#define TP_SCALE 1.0f
#define TP_PUBLISH(l)
#define TP_BEGIN(kind)
#define TP_END(kind)
#endif
#define IN(k) (lo <= (k) && (k) < hi)
#ifndef PHMASK
#define PHMASK 0xffffffffu
#endif
#define KON(k) if constexpr ((SEL < 0 && ((PHMASK >> (k)) & 1u)) || SEL == (k))
#define BOTH(k) (IN(k) && IN((k) + 1))
#ifndef PROBE_REP
#define PROBE_REP 0
#endif
#if PROBE_REP
    int nrep_ = 2; asm volatile("" : "+s"(nrep_));
#define REP(bit) _Pragma("unroll 1") for (int rep_ = 0; rep_ < (((PROBE_REP >> (bit)) & 1) ? nrep_ : 1); ++rep_)
#else
#define REP(bit) for (int rep_ = 0; rep_ < 1; ++rep_)
#endif
#define ring ((PG8_LAS unsigned char*)lds)

    KON(0) if (IN(0)) { ARef A = *kargs(); MAKE_WI(); REP(0) ph_prologue(A, w); if (BOTH(0)) GRID_BAR(); }

#define LAYER_BODY(l) do {\
        const int pb = 1 + l * NPL; \
        KON(1) if (IN(pb + 0)) { ARef A = *kargs(); MAKE_WI(); TP_BEGIN(1) if (l == 0) { REP(15) { ph_norm1(A, w); small_weights_to_f16(A, w); } if (BOTH(pb + 0)) GRID_BAR(); } TP_END(1) } \
        KON(2) if (IN(pb + 1)) { ARef A = *kargs(); MAKE_WI(); TP_BEGIN(2) \
            pg8::Gemm g{(const bf16*)(A.ws + WS_H), (const bf16*)(A.ws + WS_WIN) + (size_t)l * INCP * DM, MTOK, INCP, DM}; pg8::StaticOrder S; S.init(MTOK, INCP, w.G, w.bx); \
            pg8::EpiProj E{(bf16*)(A.ws + WS_PB), (bf16*)(A.ws + WS_PF)}; \
            REP(1) pg8::gemm_phase<pg8::EpiProj, pg8::StaticOrder, true, true>(ring, g, S, E, w.tid); \
            if (BOTH(pb + 1)) GRID_BAR(); TP_END(2) \
        } \
        KON(3) if (IN(pb + 2)) { ARef A = *kargs(); MAKE_WI(); TP_BEGIN(3) \
            REP(2) { int part_ = rep_ ? ((PROBE_REP >> 21) & 7) : 7; asm volatile("" : "+s"(part_)); for (int g = w.gw; g < MTOK / 16; g += w.NGW) prep16(A, l, 16 * g, w.lane, part_); } \
            if (BOTH(pb + 2)) GRID_BAR(); TP_END(3) \
        } \
        KON(4) if (IN(pb + 3)) { ARef A = *kargs(); MAKE_WI(); TP_BEGIN(4) \
            REP(3) { for (int tk = 2 * w.vcu; tk < 32 * NCH; tk += 2 * w.G) scan_rwkv_task2(A, w, tk); } \
            REP(13) { for (int tk = w.vcu; tk < 32 * NCH / 2; tk += w.G) scan_ret_task(A, w, tk); } \
            REP(4) { LAS unsigned char* vl = w.lds + w.wave * 4608; for (int it = w.gw; it < 32 * 128; it += w.NGW) sb_tile_mfma(A, it, w.lane, vl); } \
            REP(5) dsa_scores_mfma(A, w); \
            if (BOTH(pb + 3)) GRID_BAR(); TP_END(4) \
        } \
        KON(5) if (IN(pb + 4)) { ARef A = *kargs(); MAKE_WI(); TP_BEGIN(5) \
            if (w.bx < 32) prefix_chain(A, w, w.bx); \
            REP(6) { int sk_ = rep_ ? ((PROBE_REP >> 24) & 7) : 0; asm volatile("" : "+s"(sk_)); dsa_wave(A, w, w.lds + w.wave * 13312, l + 2 * rep_, l, sk_); } \
            REP(14) { if (rep_ && w.bx < 32) prefix_chain(A, w, w.bx); } \
            if (BOTH(pb + 4)) GRID_BAR(); TP_END(5) \
        } \
        KON(6) if (IN(pb + 5)) { ARef A = *kargs(); MAKE_WI(); TP_BEGIN(6) \
            REP(7) ph_post16(A, w, l); \
            if (BOTH(pb + 5)) GRID_BAR(); TP_END(6) \
        } \
        KON(7) if (IN(pb + 6)) { ARef A = *kargs(); MAKE_WI(); TP_BEGIN(7) \
            pg8::Gemm g{(const bf16*)(A.ws + WS_MIX), (const bf16*)(A.ws + WS_WOUT) + (size_t)l * DM * DM, MTOK, DM, DM}; pg8::StaticOrder S; S.init(MTOK, DM, w.G, w.bx); \
            pg8::EpiRes E{l == 0 ? A.in[I_X] : (const float*)(A.ws + WS_XA), (float*)(A.ws + WS_XA), (const float*)(A.ws + WS_MOD) + (size_t)l * 8 * 6144 + 2 * 1024}; \
            REP(16) { pg8::EpiRes E2 = E; if (rep_ && l == 1) E2.gate = (const float*)(A.ws + WS_CTL + 512 * 1024); pg8::gemm_phase<pg8::EpiRes, pg8::StaticOrder, true, true>(ring, g, S, E2, w.tid); } \
            if (BOTH(pb + 6)) GRID_BAR(); TP_END(7) \
        } \
        KON(8) if (IN(pb + 7)) { ARef A = *kargs(); MAKE_WI(); TP_BEGIN(8) \
            { LAS unsigned* hist = (LAS unsigned*)(w.lds + HIST_OFF); LAS int* texp = (LAS int*)(w.lds + TEXP_OFF); if (w.tid < 32) hist[w.tid] = 0u; router_stage16(A, w, l); \
            REP(10) { for (int g16 = w.gw; g16 < MTOK / 16; g16 += w.NGW) router16(A, l, 16 * g16, w.lane, hist, (const LAS unsigned char*)w.lds, texp + w.wave * 64, rep_ != 0); } \
            router_lists(A, w, l); } \
            if (BOTH(pb + 7)) GRID_BAR(); TP_END(8) \
        } \
        KON(10) if (IN(pb + 8)) { ARef A = *kargs(); MAKE_WI(); TP_BEGIN(10) \
            build_expert_table(A, w, l); \
            pg8::Gemm g{(const bf16*)(A.ws + WS_H), (const bf16*)(A.ws + WS_W1) + (size_t)l * NEXP * 2048 * DM, MOE_ROWS, NEXP * 2048, DM}; \
            pg8::MoeOrder S{(const PG8_LAS int*)(w.lds + TAB_OFF), 8, w.G, w.vcu, (const PG8_LAS int*)(w.lds + TST_OFF), (const PG8_LAS int*)(w.lds + CNT_OFF), (const int*)(A.ws + WS_LIST)}; \
            pg8::EpiSwiglu E{(bf16*)(A.ws + WS_ACT), A.in[I_MB1] + (size_t)l * NEXP * 2048}; \
            REP(8) { if (PROBE_REP & (1 << 20)) { if (rep_) pg8::gemm_phase<pg8::EpiNull, pg8::MoeOrder, true, true, true>(ring, g, S, pg8::EpiNull{}, w.tid); else pg8::gemm_phase<pg8::EpiSwiglu, pg8::MoeOrder, true, true, true>(ring, g, S, E, w.tid); } else pg8::gemm_phase<pg8::EpiSwiglu, pg8::MoeOrder, true, true, true>(ring, g, S, E, w.tid); } \
            if (BOTH(pb + 8)) GRID_BAR(); TP_END(10) \
        } \
        KON(11) if (IN(pb + 9)) { ARef A = *kargs(); MAKE_WI(); TP_BEGIN(11) \
            build_expert_table(A, w, l); \
            pg8::Gemm g{(const bf16*)(A.ws + WS_ACT), (const bf16*)(A.ws + WS_W2) + (size_t)l * NEXP * DM * DM, MOE_ROWS, NEXP * DM, DM}; \
            pg8::MoeOrder S{(const PG8_LAS int*)(w.lds + TAB_OFF), 4, w.G, w.vcu, (const PG8_LAS int*)(w.lds + TST_OFF), (const PG8_LAS int*)(w.lds + CNT_OFF), (const int*)(A.ws + WS_LIST)}; \
            pg8::EpiY E{(bf16*)(A.ws + WS_XS), A.in[I_MB2] + (size_t)l * NEXP * DM}; \
            REP(9) pg8::gemm_phase<pg8::EpiY, pg8::MoeOrder, true, true>(ring, g, S, E, w.tid); \
            TP_PUBLISH(l) \
            if (BOTH(pb + 9)) GRID_BAR(); TP_END(11) \
        } \
        KON(12) if (IN(pb + 10)) { ARef A = *kargs(); MAKE_WI(); TP_BEGIN(12) \
            build_expert_table(A, w, l); \
            REP(12) for (int m = w.gw; m < MTOK; m += w.NGW) combine_row(A, l, m, w.lane, (const LAS int*)(w.lds + TST_OFF), (rep_ && l == 0) ? 0.0f : 1.0f, TP_SCALE); \
            if (BOTH(pb + 10)) GRID_BAR(); TP_END(12) \
        } \
    } while (0)
    LAYER_BODY(0);
    LAYER_BODY(1);
#undef LAYER_BODY
#undef IN
#undef ring
#undef MAKE_WI
#undef TID_NOW
#undef GRID_BAR
#undef KON
#undef BOTH
}


#if MK_N_LAUNCHES != 1
template <int K> static void launch_one(int grid, hipStream_t stream, const ArgsH& a) {
    static bool attr = false;
    if (!attr) { (void)hipFuncSetAttribute((const void*)fwd<K>, hipFuncAttributeMaxDynamicSharedMemorySize, LDS_BYTES); attr = true; }
    hipLaunchKernelGGL(fwd<K>, dim3(grid), dim3(NWAVES * 64), LDS_BYTES, stream, a);
}
static void launch_kind(int kind, int grid, hipStream_t stream, const ArgsH& a) {
    switch (kind) {
        case 0: launch_one<0>(grid, stream, a); break; case 1: launch_one<1>(grid, stream, a); break; case 2: launch_one<2>(grid, stream, a); break;
        case 3: launch_one<3>(grid, stream, a); break; case 4: launch_one<4>(grid, stream, a); break; case 5: launch_one<5>(grid, stream, a); break;
        case 6: launch_one<6>(grid, stream, a); break; case 7: launch_one<7>(grid, stream, a); break; case 8: launch_one<8>(grid, stream, a); break;
        case 9: launch_one<9>(grid, stream, a); break; case 10: launch_one<10>(grid, stream, a); break; case 11: launch_one<11>(grid, stream, a); break;
        default: launch_one<12>(grid, stream, a); break;
    }
}
#endif
extern "C" void kernel_launch(void* const* d_in, const int* in_sizes, int n_in, void* d_out, int out_size, void* d_ws, size_t ws_size, hipStream_t stream) {
    static int grid = 0;
    if (grid == 0) {
        if (n_in != N_IN || out_size != MTOK * DM || ws_size < WS_END) { fprintf(stderr, "kernel_launch: unexpected shapes (n_in %d, out %d, ws %zu)\n", n_in, out_size, ws_size); grid = -1; return; }
        int dev = 0, cus = 0;
        if (hipGetDevice(&dev) != hipSuccess || hipDeviceGetAttribute(&cus, hipDeviceAttributeMultiprocessorCount, dev) != hipSuccess) { grid = -1; return; }
#if MK_N_LAUNCHES == 1
        {
            if (hipFuncSetAttribute((const void*)fwd<-1>, hipFuncAttributeMaxDynamicSharedMemorySize, LDS_BYTES) != hipSuccess) { fprintf(stderr, "kernel_launch: hipFuncSetAttribute failed\n"); grid = -1; return; }
            int per_cu = 0;
            if (hipOccupancyMaxActiveBlocksPerMultiprocessor(&per_cu, (const void*)fwd<-1>, NWAVES * 64, LDS_BYTES) != hipSuccess || per_cu < 1) fprintf(stderr, "kernel_launch: occupancy query says %d\n", per_cu);
            (void)hipGetLastError();
        }
#endif
        grid = cus;
    }
    if (grid < 0) return;
    (void)in_sizes;
    if (hipMemsetAsync((char*)d_ws + WS_CTL, 0, CTL_ZERO_BYTES, stream) != hipSuccess) return;
    ArgsH a{};
    for (int i = 0; i < N_IN; ++i) a.in[i] = (const float*)d_in[i];
    a.out = (float*)d_out; a.ws = (unsigned char*)d_ws;
    for (int f = 0; f < 44; ++f) a.invf[f] = (f < 32) ? pow(10000.0, -(double)f / 32.0) : (f < 40) ? pow(500000.0, -(double)(f - 32) / 8.0) : pow(500000.0, -(double)(f - 40) / 4.0);
#if MK_N_LAUNCHES == 1
    a.ph_lo = 0; a.ph_hi = NPHASE; a.li = 0;
    hipLaunchKernelGGL(fwd<-1>, dim3(grid), dim3(NWAVES * 64), LDS_BYTES, stream, a);
#else
    {
        for (int p = 0; p < NPHASE; ++p) {
            if (p == 1 + NPL) continue;
            a.ph_lo = p; a.ph_hi = p + 1; a.li = p;
            static const int kinds_[NPL] = {1, 2, 3, 4, 5, 6, 7, 8, 10, 11, 12};
            const int kind = (p == 0) ? 0 : kinds_[(p - 1) % NPL];
            launch_kind(kind, grid, stream, a);
        }
    }
#endif
}
```

```cpp
#include <hip/hip_runtime.h>
#include <cstdio>
#include <cstdint>
#include <cmath>

#ifndef MK_N_LAUNCHES
#define MK_N_LAUNCHES 1
#endif

namespace pg8 {
#define PG8_LAS __attribute__((address_space(3)))
typedef unsigned short bf16_t;
typedef short bf16x8 __attribute__((ext_vector_type(8)));
typedef float f32x4 __attribute__((ext_vector_type(4)));
typedef unsigned u32x4 __attribute__((ext_vector_type(4)));
typedef unsigned u32x2 __attribute__((ext_vector_type(2)));
constexpr int BM = 256, BK = 64, HALF = 128, HTB = HALF * BK * 2  , STAGE_BYTES = 8 * HTB, NXCD = 8, WGM = 8;

__host__ __device__ __forceinline__ int lds_byte(int r, int c) { const int st = (r >> 4) * 2 + (c >> 5), rr = r & 15, cc = c & 31, ob = rr * 64 + cc * 2; return st * 1024 + (ob ^ (((ob >> 9) & 1) << 5)); }
__host__ __device__ __forceinline__ void stage_rc(int b, int& R, int& C) { const int st = b / 1024, sb = b % 1024, swz = sb ^ (((sb >> 9) & 1) << 5); R = (st >> 1) * 16 + swz / 64; C = (st & 1) * 32 + (swz % 64) / 2; }
__host__ __device__ __forceinline__ int perm32(int rho) { const int n = rho >> 4, i = rho & 15; return 8 * (i >> 2) + 4 * n + (i & 3); }

struct Unit { int pm, pn; };
struct Gemm { const bf16_t* A; const bf16_t* Bt; int M, N, K; };

struct StaticOrder {
    int nM, nN, nwg, G, c;
    __host__ __device__ void init(int M, int N, int G_, int c_) { nM = M / BM; nN = N / BM; nwg = nM * nN; G = G_; c = c_; }
    __host__ __device__ bool next(int i, Unit& u) const {
        const long L = (long)i * G + c; if (L >= nwg) return false;
        int wgid = (int)L; { const int q = nwg / NXCD, r = nwg % NXCD, xcd = wgid % NXCD, off = wgid / NXCD; wgid = (xcd < r ? xcd * (q + 1) : r * (q + 1) + (xcd - r) * q) + off; }
        const int nig = WGM * nN, gid = wgid / nig, fm = gid * WGM, gsz = (nM - fm) < WGM ? (nM - fm) : WGM;
        u.pm = fm + ((wgid % nig) % gsz); u.pn = (wgid % nig) / gsz; return true;
    }
    __device__ __forceinline__ void a_ready(const Unit&) const {}
    __device__ __forceinline__ void done(const Unit&) const {}
};
__device__ __forceinline__ unsigned cvt_pk_bf16(float lo, float hi) { unsigned r; asm volatile("v_cvt_pk_bf16_f32 %0, %1, %2" : "=v"(r) : "v"(lo), "v"(hi)); return r; }
struct EpiF32 {
    static constexpr bool PERM = false, AFTER_DRAIN = false;
    float* C; int ldc;
    __device__ __forceinline__ void operator()(const f32x4 (&acc)[2][2][4][2], const Unit& u, int wr, int wc, int fr, int fq) const {
        const int row0 = u.pm * BM + wr * 64 + fr, col0 = u.pn * BM + wc * 32 + 4 * fq;
#pragma unroll
        for (int ai = 0; ai < 2; ++ai)
#pragma unroll
            for (int m = 0; m < 4; ++m) { float* rowp = C + (size_t)(row0 + ai * HALF + m * 16) * ldc + col0;
#pragma unroll
                for (int bj = 0; bj < 2; ++bj)
#pragma unroll
                    for (int n = 0; n < 2; ++n) *(f32x4*)(rowp + bj * HALF + n * 16) = acc[ai][bj][m][n]; }
    }
};
struct EpiNull {
    static constexpr bool PERM = true, AFTER_DRAIN = false;
    __device__ __forceinline__ void operator()(const f32x4 (&acc)[2][2][4][2], const Unit&, int, int, int, int) const {
#pragma unroll
        for (int ai = 0; ai < 2; ++ai)
#pragma unroll
            for (int bj = 0; bj < 2; ++bj) asm volatile("" :: "v"(acc[ai][bj][0][0]), "v"(acc[ai][bj][0][1]), "v"(acc[ai][bj][1][0]), "v"(acc[ai][bj][1][1]), "v"(acc[ai][bj][2][0]), "v"(acc[ai][bj][2][1]), "v"(acc[ai][bj][3][0]), "v"(acc[ai][bj][3][1]));
    }
};
struct EpiProj {
    static constexpr bool PERM = true, AFTER_DRAIN = false;
    bf16_t* PB; bf16_t* PF;
    __device__ __forceinline__ void operator()(const f32x4 (&acc)[2][2][4][2], const Unit& u, int wr, int wc, int fr, int fq) const {
        const int row0 = u.pm * BM + wr * 64 + fr;
        if (u.pn < 7) { const int c0 = u.pn * BM + wc * 32 + 8 * fq;
#pragma unroll
            for (int ai = 0; ai < 2; ++ai)
#pragma unroll
                for (int m = 0; m < 4; ++m) { bf16_t* rowp = PB + (size_t)(row0 + ai * HALF + m * 16) * 1792 + c0;
#pragma unroll
                    for (int bj = 0; bj < 2; ++bj) { const f32x4 v0 = acc[ai][bj][m][0], v1 = acc[ai][bj][m][1];
                        u32x4 w; w.x = cvt_pk_bf16(v0[0], v0[1]); w.y = cvt_pk_bf16(v0[2], v0[3]); w.z = cvt_pk_bf16(v1[0], v1[1]); w.w = cvt_pk_bf16(v1[2], v1[3]);
                        *(u32x4*)(rowp + bj * HALF) = w; } }
        } else { const int c0 = (u.pn - 7) * BM + wc * 32 + 8 * fq;
#pragma unroll
            for (int ai = 0; ai < 2; ++ai)
#pragma unroll
                for (int m = 0; m < 4; ++m) { bf16_t* rowp = PF + (size_t)(row0 + ai * HALF + m * 16) * 1280 + c0;
#pragma unroll
                    for (int bj = 0; bj < 2; ++bj) { const f32x4 v0 = acc[ai][bj][m][0], v1 = acc[ai][bj][m][1];
                        u32x4 w; w.x = cvt_pk_bf16(v0[0], v0[1]); w.y = cvt_pk_bf16(v0[2], v0[3]); w.z = cvt_pk_bf16(v1[0], v1[1]); w.w = cvt_pk_bf16(v1[2], v1[3]);
                        *(u32x4*)(rowp + bj * HALF) = w; } }
        }
    }
};
struct EpiRes {
    static constexpr bool PERM = false, AFTER_DRAIN = false;
    const float* xin; float* xout; const float* gate;
    __device__ __forceinline__ void operator()(const f32x4 (&acc)[2][2][4][2], const Unit& u, int wr, int wc, int fr, int fq) const {
        const int row0 = u.pm * BM + wr * 64 + fr, col0 = u.pn * BM + wc * 32 + 4 * fq;
        const float* gp = gate + (size_t)((u.pm * BM) >> 12) * 6144 + col0;
        f32x4 gv[2][2];
#pragma unroll
        for (int bj = 0; bj < 2; ++bj)
#pragma unroll
            for (int n = 0; n < 2; ++n) gv[bj][n] = *(const f32x4*)(gp + bj * HALF + n * 16);
#pragma unroll
        for (int ai = 0; ai < 2; ++ai)
#pragma unroll
            for (int m = 0; m < 4; ++m) { const size_t ro = (size_t)(row0 + ai * HALF + m * 16) * 1024 + col0;
#pragma unroll
                for (int bj = 0; bj < 2; ++bj)
#pragma unroll
                    for (int n = 0; n < 2; ++n) { const f32x4 xv = *(const f32x4*)(xin + ro + bj * HALF + n * 16); *(f32x4*)(xout + ro + bj * HALF + n * 16) = xv + gv[bj][n] * acc[ai][bj][m][n]; } }
    }
};
__device__ __forceinline__ float swiglu1(float glu, float lin) {
    glu = fminf(glu, 7.0f); lin = fminf(fmaxf(lin, -7.0f), 7.0f);
    return glu * (1.0f / (1.0f + __expf(-1.702f * glu))) * (lin + 1.0f);
}
struct EpiSwiglu {
    static constexpr bool PERM = true, AFTER_DRAIN = false;
    bf16_t* O; const float* b1;
    __device__ __forceinline__ void operator()(const f32x4 (&acc)[2][2][4][2], const Unit& u, int wr, int wc, int fr, int fq) const {
        const int e = u.pn >> 3, j = u.pn & 7, row0 = u.pm * BM + wr * 64 + fr, c0 = 128 * j + wc * 32 + 8 * fq;
        const float* bp = b1 + (size_t)e * 2048 + c0;
        f32x4 bg[2], bl[2];
#pragma unroll
        for (int n = 0; n < 2; ++n) { bg[n] = *(const f32x4*)(bp + 4 * n); bl[n] = *(const f32x4*)(bp + 1024 + 4 * n); }
#pragma unroll
        for (int ai = 0; ai < 2; ++ai)
#pragma unroll
            for (int m = 0; m < 4; ++m) { bf16_t* rowp = O + (size_t)(row0 + ai * HALF + m * 16) * 1024 + c0;
                const f32x4 g0 = acc[ai][0][m][0] + bg[0], g1 = acc[ai][0][m][1] + bg[1], l0 = acc[ai][1][m][0] + bl[0], l1 = acc[ai][1][m][1] + bl[1];
                u32x4 w;
                w.x = cvt_pk_bf16(swiglu1(g0[0], l0[0]), swiglu1(g0[1], l0[1])); w.y = cvt_pk_bf16(swiglu1(g0[2], l0[2]), swiglu1(g0[3], l0[3]));
                w.z = cvt_pk_bf16(swiglu1(g1[0], l1[0]), swiglu1(g1[1], l1[1])); w.w = cvt_pk_bf16(swiglu1(g1[2], l1[2]), swiglu1(g1[3], l1[3]));
                *(u32x4*)rowp = w; }
    }
};
struct EpiY {
    static constexpr bool PERM = true, AFTER_DRAIN = false;
    bf16_t* O; const float* b2;
    __device__ __forceinline__ void operator()(const f32x4 (&acc)[2][2][4][2], const Unit& u, int wr, int wc, int fr, int fq) const {
        const int e = u.pn >> 2, j = u.pn & 3, row0 = u.pm * BM + wr * 64 + fr, c0 = 256 * j + wc * 32 + 8 * fq;
        const float* bp = b2 + (size_t)e * 1024 + c0;
        f32x4 bv[2][2];
#pragma unroll
        for (int bj = 0; bj < 2; ++bj)
#pragma unroll
            for (int n = 0; n < 2; ++n) bv[bj][n] = *(const f32x4*)(bp + bj * HALF + 4 * n);
#pragma unroll
        for (int ai = 0; ai < 2; ++ai)
#pragma unroll
            for (int m = 0; m < 4; ++m) { bf16_t* rowp = O + (size_t)(row0 + ai * HALF + m * 16) * 1024 + c0;
#pragma unroll
                for (int bj = 0; bj < 2; ++bj) { const f32x4 v0 = acc[ai][bj][m][0] + bv[bj][0], v1 = acc[ai][bj][m][1] + bv[bj][1];
                    u32x4 w; w.x = cvt_pk_bf16(v0[0], v0[1]); w.y = cvt_pk_bf16(v0[2], v0[3]); w.z = cvt_pk_bf16(v1[0], v1[1]); w.w = cvt_pk_bf16(v1[2], v1[3]);
                    *(u32x4*)(rowp + bj * HALF) = w; } }
    }
};
struct MoeOrder {
    const PG8_LAS int* tab; int NJ, G, c;
    __device__ __forceinline__ bool next(int i, Unit& u) const {
        const int T = tab[0]; const long L = (long)i * G + c; if (L >= (long)T * NJ) return false;
        const int pm = (int)(L / NJ), j = (int)(L % NJ);
        u.pm = pm; u.pn = tab[1 + pm] * NJ + j; return true;
    }
    __device__ __forceinline__ void a_ready(const Unit&) const {}
    __device__ __forceinline__ void done(const Unit&) const {}
    const PG8_LAS int* tst; const PG8_LAS int* cnt; const int* list;
    __device__ __forceinline__ int row_of(const Unit& u, int r) const { const int e = tab[1 + u.pm], idx = 256 * (u.pm - tst[e]) + r; return (idx < cnt[e]) ? list[e * 32768 + idx] : 0; }
};

template <class Epi, class Sched, bool ALIGN_EPI = false, bool SP2 = false, bool GATHER = false>
__device__ __forceinline__ void gemm_phase(PG8_LAS unsigned char* lds, const Gemm g, const Sched& S, const Epi& E, int tid_in) {
    int tid_ = tid_in; asm volatile("" : "+v"(tid_));
    const int tid = tid_, wid = __builtin_amdgcn_readfirstlane(tid >> 6), lane = tid & 63, wr = wid >> 2, wc = wid & 3, fr = lane & 15, fq = lane >> 4;
    const int K = g.K, nt = K / BK;
    unsigned voffA[2], voffB[2];
#pragma unroll
    for (int i = 0; i < 2; ++i) { int R, C; stage_rc(tid * 16 + i * 8192, R, C); const int Rb = Epi::PERM ? ((R & ~31) + perm32(R & 31)) : R;
        voffA[i] = (unsigned)(R * K + C) * 2u; voffB[i] = (unsigned)(Rb * K + C) * 2u; }
    static_assert(!GATHER || SP2, "gathered A rows: only the two-super-phase loop is wired");
    unsigned cvo[2][2], nvo[2][2];
#define PG8_ROWS(dst, u_) do { _Pragma("unroll") for (int h_ = 0; h_ < 2; ++h_) _Pragma("unroll") for (int i_ = 0; i_ < 2; ++i_) { int R_, C_; stage_rc(tid * 16 + i_ * 8192, R_, C_); dst[h_][i_] = (unsigned)(S.row_of(u_, h_ * HALF + R_) * K + C_) * 2u; } } while (0)
#define PG8_STAGE_A(bufoff, gbase, half, nx) do { if constexpr (GATHER) { unsigned o_[2]; o_[0] = (nx) ? nvo[half][0] : cvo[half][0]; o_[1] = (nx) ? nvo[half][1] : cvo[half][1]; PG8_STAGE(bufoff, gbase, o_); } else { PG8_STAGE(bufoff, (gbase) + (half) * hstep, voffA); } } while (0)
    const size_t kstep = (size_t)(BK * 2);
    const size_t hstep = (size_t)HALF * K * 2;
    const size_t tstep = 2 * hstep;
    const unsigned ldsw = (unsigned)wid * 1024u;
    const int aoff = lds_byte(wr * 64 + fr, fq * 8), boff = lds_byte(wc * 32 + fr, fq * 8);
#define PG8_SA(b, h) (((b) * 2 + (h)) * HTB)
#define PG8_SB(b, h) ((4 + (b) * 2 + (h)) * HTB)
#define PG8_STAGE(bufoff, gbase, voff) do { _Pragma("unroll") for (int _i = 0; _i < 2; ++_i) \
        __builtin_amdgcn_global_load_lds((const unsigned*)((const char*)(gbase) + (voff)[_i]), (PG8_LAS unsigned*)(lds + (bufoff) + ldsw + _i * 8192), 16, 0, 0); } while (0)
#define PG8_LDA(dst, b, h) do { _Pragma("unroll") for (int m = 0; m < 4; ++m) _Pragma("unroll") for (int k = 0; k < 2; ++k) dst[m][k] = *(const PG8_LAS bf16x8*)(lds + PG8_SA(b, h) + aoff + m * 2048 + k * 1024); } while (0)
#define PG8_LDB(dst, b, h) do { _Pragma("unroll") for (int n = 0; n < 2; ++n) _Pragma("unroll") for (int k = 0; k < 2; ++k) dst[n][k] = *(const PG8_LAS bf16x8*)(lds + PG8_SB(b, h) + boff + n * 2048 + k * 1024); } while (0)
#define PG8_MMA(ai, bj, At, Bt) do { __builtin_amdgcn_s_setprio(1); _Pragma("unroll") for (int m = 0; m < 4; ++m) _Pragma("unroll") for (int n = 0; n < 2; ++n) _Pragma("unroll") for (int k = 0; k < 2; ++k) \
        acc[ai][bj][m][n] = __builtin_amdgcn_mfma_f32_16x16x32_bf16(Bt[n][k], At[m][k], acc[ai][bj][m][n], 0, 0, 0); __builtin_amdgcn_s_setprio(0); } while (0)
#define PG8_WAIT_V(n) asm volatile("s_waitcnt vmcnt(" #n ")" ::: "memory")
#define PG8_WAIT_L(n) asm volatile("s_waitcnt lgkmcnt(" #n ")" ::: "memory")
#define PG8_BAR __builtin_amdgcn_s_barrier()
#define PG8_SCHED __builtin_amdgcn_sched_barrier(0)
    Unit cur, nxt; int ui = 0;
    if (!S.next(0, cur)) return;
    f32x4 acc[2][2][4][2];
#pragma unroll
    for (int a = 0; a < 2; ++a)
#pragma unroll
        for (int b = 0; b < 2; ++b)
#pragma unroll
            for (int m = 0; m < 4; ++m)
#pragma unroll
                for (int n = 0; n < 2; ++n) acc[a][b][m][n] = (f32x4){0.f, 0.f, 0.f, 0.f};
    bf16x8 At[4][2], B0[2][2], B1[2][2];
    const char* cA = (const char*)g.A + (GATHER ? (size_t)0 : (size_t)cur.pm * tstep); const char* cB = (const char*)g.Bt + (size_t)cur.pn * tstep;
    if constexpr (GATHER) { PG8_ROWS(cvo, cur); }
    S.a_ready(cur);
    if constexpr (SP2) {
        PG8_STAGE(PG8_SB(0, 0), cB, voffB); PG8_STAGE(PG8_SB(0, 1), cB + hstep, voffB); PG8_STAGE_A(PG8_SA(0, 0), cA, 0, false); PG8_STAGE_A(PG8_SA(0, 1), cA, 1, false);
        if (wr == 1) PG8_BAR;
        PG8_WAIT_V(2); PG8_BAR;
        PG8_STAGE(PG8_SB(1, 0), cB + kstep, voffB); PG8_STAGE_A(PG8_SA(1, 0), cA + kstep, 0, false); PG8_STAGE(PG8_SB(1, 1), cB + hstep + kstep, voffB);
        PG8_WAIT_V(6); PG8_BAR;
    } else {
        PG8_STAGE(PG8_SB(0, 0), cB, voffB); PG8_STAGE(PG8_SA(0, 0), cA, voffA); PG8_STAGE(PG8_SB(0, 1), cB + hstep, voffB); PG8_STAGE(PG8_SA(0, 1), cA + hstep, voffA);
        if (wr == 1) PG8_BAR;
        PG8_WAIT_V(4); PG8_BAR;
        PG8_STAGE(PG8_SB(1, 0), cB + kstep, voffB); PG8_STAGE(PG8_SA(1, 0), cA + kstep, voffA); PG8_STAGE(PG8_SB(1, 1), cB + hstep + kstep, voffB);
        PG8_WAIT_V(6); PG8_BAR;
    }
    for (;;) {
        const bool has_next = S.next(ui + 1, nxt);
        const char* nA = GATHER ? (const char*)g.A : (has_next ? (const char*)g.A + (size_t)nxt.pm * tstep : cA); const char* nB = has_next ? (const char*)g.Bt + (size_t)nxt.pn * tstep : cB;
        if constexpr (GATHER) { if (has_next) { PG8_ROWS(nvo, nxt); } else { _Pragma("unroll") for (int h_ = 0; h_ < 2; ++h_) { nvo[h_][0] = cvo[h_][0]; nvo[h_][1] = cvo[h_][1]; } } }
        for (int t = 0; t < nt; t += 2) {
            const bool last = (t == nt - 2);
            const char* a1 = cA + (size_t)(t + 1) * kstep;
            const char* a2 = last ? nA : cA + (size_t)(t + 2) * kstep; const char* b2 = last ? nB : cB + (size_t)(t + 2) * kstep;
            const char* a3 = a2 + kstep; const char* b3 = b2 + kstep;
            if (last && has_next) S.a_ready(nxt);
            if constexpr (SP2) {
            PG8_LDB(B0, 0, 0); PG8_LDB(B1, 0, 1); PG8_SCHED; PG8_LDA(At, 0, 0); PG8_STAGE_A(PG8_SA(1, 1), a1, 1, false);
            PG8_WAIT_V(8); PG8_WAIT_L(0); PG8_BAR; PG8_MMA(0, 0, At, B0); PG8_MMA(0, 1, At, B1); PG8_BAR; PG8_SCHED;
            PG8_LDA(At, 0, 1); PG8_STAGE(PG8_SB(0, 0), b2, voffB); PG8_STAGE(PG8_SB(0, 1), b2 + hstep, voffB); PG8_STAGE_A(PG8_SA(0, 0), a2, 0, last);
            PG8_WAIT_V(8); PG8_WAIT_L(0); PG8_BAR; PG8_MMA(1, 0, At, B0); PG8_MMA(1, 1, At, B1); PG8_BAR; PG8_SCHED;
            PG8_LDB(B0, 1, 0); PG8_LDB(B1, 1, 1); PG8_SCHED; PG8_LDA(At, 1, 0); PG8_STAGE_A(PG8_SA(0, 1), a2, 1, last);
            PG8_WAIT_V(8); PG8_WAIT_L(0); PG8_BAR; PG8_MMA(0, 0, At, B0); PG8_MMA(0, 1, At, B1); PG8_BAR; PG8_SCHED;
            PG8_LDA(At, 1, 1); PG8_STAGE(PG8_SB(1, 0), b3, voffB); PG8_STAGE(PG8_SB(1, 1), b3 + hstep, voffB); PG8_STAGE_A(PG8_SA(1, 0), a3, 0, last);
            PG8_WAIT_V(8); PG8_WAIT_L(0); PG8_BAR; PG8_MMA(1, 0, At, B0); PG8_MMA(1, 1, At, B1); PG8_BAR; PG8_SCHED;
            } else {
            PG8_LDB(B0, 0, 0); PG8_SCHED; PG8_LDA(At, 0, 0); PG8_STAGE(PG8_SA(1, 1), a1 + hstep, voffA);
            PG8_WAIT_L(8); PG8_BAR; PG8_WAIT_L(0); PG8_MMA(0, 0, At, B0); PG8_BAR; PG8_SCHED;
            PG8_LDB(B1, 0, 1); PG8_STAGE(PG8_SB(0, 0), b2, voffB);
            PG8_BAR; PG8_WAIT_L(0); PG8_MMA(0, 1, At, B1); PG8_BAR;
            PG8_LDA(At, 0, 1); PG8_STAGE(PG8_SA(0, 0), a2, voffA);
            PG8_BAR; PG8_WAIT_L(0); PG8_MMA(1, 0, At, B0); PG8_BAR; PG8_SCHED;
            PG8_STAGE(PG8_SB(0, 1), b2 + hstep, voffB);
            PG8_WAIT_V(6); PG8_BAR; PG8_MMA(1, 1, At, B1); PG8_BAR;
            PG8_LDB(B0, 1, 0); PG8_SCHED; PG8_LDA(At, 1, 0); PG8_STAGE(PG8_SA(0, 1), a2 + hstep, voffA);
            PG8_WAIT_L(8); PG8_BAR; PG8_WAIT_L(0); PG8_MMA(0, 0, At, B0); PG8_BAR; PG8_SCHED;
            PG8_LDB(B1, 1, 1); PG8_STAGE(PG8_SB(1, 0), b3, voffB);
            PG8_BAR; PG8_WAIT_L(0); PG8_MMA(0, 1, At, B1); PG8_BAR;
            PG8_LDA(At, 1, 1); PG8_STAGE(PG8_SA(1, 0), a3, voffA);
            PG8_BAR; PG8_WAIT_L(0); PG8_MMA(1, 0, At, B0); PG8_BAR; PG8_SCHED;
            PG8_STAGE(PG8_SB(1, 1), b3 + hstep, voffB);
            PG8_WAIT_V(6); PG8_BAR; PG8_MMA(1, 1, At, B1); PG8_BAR;
            }
        }
        if constexpr (ALIGN_EPI) { if (wr == 0) PG8_BAR; }
        if constexpr (!Epi::AFTER_DRAIN) { E(acc, cur, wr, wc, fr, fq); S.done(cur); }
        if (!has_next) break;
#pragma unroll
        for (int a = 0; a < 2; ++a)
#pragma unroll
            for (int b = 0; b < 2; ++b)
#pragma unroll
                for (int m = 0; m < 4; ++m)
#pragma unroll
                    for (int n = 0; n < 2; ++n) acc[a][b][m][n] = (f32x4){0.f, 0.f, 0.f, 0.f};
        cur = nxt; cA = nA; cB = nB; ++ui;
        if constexpr (GATHER) { _Pragma("unroll") for (int h_ = 0; h_ < 2; ++h_) { cvo[h_][0] = nvo[h_][0]; cvo[h_][1] = nvo[h_][1]; } }
        if constexpr (ALIGN_EPI) { if (wr == 1) PG8_BAR; }
    }
    PG8_WAIT_V(0);
    if constexpr (!ALIGN_EPI) { if (wr == 0) PG8_BAR; }
    PG8_BAR;
    if constexpr (Epi::AFTER_DRAIN) { E.fused(acc, cur, wr, wc, fr, fq, lds, wid, lane); S.done(cur); }
#undef PG8_SA
#undef PG8_SB
#undef PG8_STAGE
#undef PG8_STAGE_A
#undef PG8_ROWS
#undef PG8_LDA
#undef PG8_LDB
#undef PG8_MMA
#undef PG8_WAIT_V
#undef PG8_WAIT_L
#undef PG8_BAR
#undef PG8_SCHED
}
}

constexpr int NWAVES = 8;
constexpr int NB = 8, SEQ = 4096, DM = 1024, MTOK = NB * SEQ, NLAYER = 2;
constexpr int INC = 2984, INCP = 3072;
constexpr int C_RET = 0, C_RW = 1024, C_DSA = 1920, C_SB = 2216;
constexpr int PBW = 1792, PFW = 1280, PB_SB = 1024, PF_DSA = 896;
constexpr int NEXP = 32, MOE_ROWS = MTOK * 4 + NEXP * 256;
constexpr int ROPE_W = 88;
constexpr int NCH = 16, TCH = SEQ / NCH;
constexpr int NPL = 11, NPHASE = 1 + NLAYER * NPL;
enum { I_X = 0, I_C, I_POS, I_ADAW, I_ADAB, I_NMIX, I_NFFN, I_WIN, I_RETGN, I_MU, I_W0, I_W2, I_A0, I_A2, I_G2, I_KK, I_KA, I_RK, I_LN, I_QNORM, I_WQ, I_WQI, I_DONORM, I_SONORM, I_WOUT, I_RW, I_RB, I_MW1, I_MB1, I_MW2, I_MB2, I_NFINAL, N_IN };

constexpr size_t MiB = 1u << 20;
constexpr size_t WS_CTL = 0, CTL_ZERO_BYTES = 1 * MiB;
constexpr size_t WS_MOD = 1 * MiB, WS_ROPE = 2 * MiB, WS_WIN = 14 * MiB, WS_WOUT = 26 * MiB, WS_W1 = 30 * MiB, WS_W2 = 286 * MiB;
constexpr size_t WS_XA = 414 * MiB, WS_H = 542 * MiB, WS_MIX = 606 * MiB, WS_TOPI = 670 * MiB, WS_TOPW = 671 * MiB, WS_POS = 672 * MiB;
constexpr size_t WS_R = 674 * MiB;
constexpr size_t WS_PB = WS_R  , WS_PF = WS_R + 112 * MiB  , WS_RWA = 946 * MiB  , WS_DQ = 1314 * MiB  , WS_DKB = 1330 * MiB  , WS_DVB = 1334 * MiB  , WS_DQI = 1346 * MiB  , WS_DKI = 1394 * MiB  , WS_DW = 1398 * MiB;
constexpr size_t WS_SMALLW = 1338 * MiB  ;
constexpr int SMW_QI = 0, SMW_W2 = 512 * 128, SMW_A2 = SMW_W2 + 256 * 32, SMW_G2 = SMW_A2 + 256 * 32, SMW_LAYER = SMW_G2 + 256 * 64;
constexpr size_t WS_PT = 1362 * MiB  ;
constexpr size_t WS_CH = WS_H  , WS_SI = WS_H + 16 * MiB  , WS_SIR = WS_H + 24 * MiB  ,
                 WS_CHR = WS_H + 32 * MiB  , WS_PTR = WS_H + 40 * MiB  ;
constexpr size_t WS_SQ = WS_MIX  , WS_SK = WS_MIX + 16 * MiB, WS_SV = WS_MIX + 32 * MiB;
constexpr size_t WS_YO = 1400 * MiB  , WS_SC = 1528 * MiB  ;
constexpr size_t WS_XS = WS_R  , WS_ACT = 946 * MiB  ;
constexpr size_t WS_LIST = 2040 * MiB  , WS_END = 2044 * MiB;
constexpr int LCAP = 32768;
static_assert((size_t)MOE_ROWS * 2048 <= 272 * MiB, "moe buffers");
constexpr int CW_TMO = 0, CW_CODE = 1, CW_GCNT = 256  , CW_DSAQ = 1024  , CW_BAR = 4096, CW_BLKCNT = 16384  ;
constexpr int RING_BYTES = 131072, MISC_OFF = RING_BYTES + 320, TST_OFF = RING_BYTES + 1024  , TAB_OFF = RING_BYTES + 2048  , HIST_OFF = RING_BYTES + 5120  , BASE_OFF = RING_BYTES + 5376  , CNT_OFF = RING_BYTES + 5632  , TEXP_OFF = RING_BYTES + 6144  , LDS_BYTES = 147456;

#if defined(__HIP_DEVICE_COMPILE__)
#define GAS __attribute__((address_space(1)))
#define CAS __attribute__((address_space(4)))
#else
#define GAS
#define CAS
#endif
#define LAS __attribute__((address_space(3)))
typedef unsigned short bf16;
typedef unsigned v4u __attribute__((ext_vector_type(4)));
typedef unsigned v2u __attribute__((ext_vector_type(2)));
typedef float f32x4 __attribute__((ext_vector_type(4)));
typedef GAS unsigned gu32;
typedef short bf16x8v __attribute__((ext_vector_type(8)));
typedef short s16x4v __attribute__((ext_vector_type(4)));
typedef _Float16 f16x8 __attribute__((ext_vector_type(8)));
#define RLX_AGENT __ATOMIC_RELAXED, __HIP_MEMORY_SCOPE_AGENT
#define LDS_WAIT() asm volatile("s_waitcnt lgkmcnt(0)" ::: "memory")
#define VM_WAIT() asm volatile("s_waitcnt vmcnt(0)" ::: "memory")
__device__ __forceinline__ unsigned f2bf(float f) { unsigned u = __builtin_bit_cast(unsigned, f); return (u + 0x7fffu + ((u >> 16) & 1u)) >> 16; }
__device__ __forceinline__ unsigned pk2(float lo, float hi) { return f2bf(lo) | (f2bf(hi) << 16); }
__device__ __forceinline__ float bf_lo(unsigned w) { return __builtin_bit_cast(float, w << 16); }
__device__ __forceinline__ float bf_hi(unsigned w) { return __builtin_bit_cast(float, w & 0xffff0000u); }
__device__ __forceinline__ float wave_sum(float v) {
#pragma unroll
    for (int o = 1; o < 64; o <<= 1) v += __shfl_xor(v, o);
    return v;
}
__device__ __forceinline__ float wave_max(float v) {
#pragma unroll
    for (int o = 1; o < 64; o <<= 1) v = fmaxf(v, __shfl_xor(v, o));
    return v;
}
__device__ __forceinline__ float grp16_sum(float v) { v += __shfl_xor(v, 1); v += __shfl_xor(v, 2); v += __shfl_xor(v, 4); v += __shfl_xor(v, 8); return v; }
__device__ __forceinline__ float grp8_sum(float v) { v += __shfl_xor(v, 1); v += __shfl_xor(v, 2); v += __shfl_xor(v, 4); return v; }
__device__ __forceinline__ float sum4(f32x4 a) { return (a.x + a.y) + (a.z + a.w); }
__device__ __forceinline__ float dot4(f32x4 a, f32x4 b) { return (a.x * b.x + a.y * b.y) + (a.z * b.z + a.w * b.w); }
__device__ __forceinline__ float fexp(float x) { return __builtin_amdgcn_exp2f(x * 1.4426950408889634f); }
__device__ __forceinline__ float sigm(float x) { return __builtin_amdgcn_rcpf(1.0f + fexp(-x)); }
__device__ __forceinline__ float softplusf(float x) { return fmaxf(x, 0.0f) + 0.6931471805599453f * __builtin_amdgcn_logf(1.0f + fexp(-fabsf(x))); }
__device__ __forceinline__ float ftanh(float x) { const float e = fexp(-2.0f * fabsf(x)); const float t = (1.0f - e) * __builtin_amdgcn_rcpf(1.0f + e); return x < 0.0f ? -t : t; }
__device__ __forceinline__ f32x4 shx4(f32x4 v, int m) { f32x4 r; r.x = __shfl_xor(v.x, m); r.y = __shfl_xor(v.y, m); r.z = __shfl_xor(v.z, m); r.w = __shfl_xor(v.w, m); return r; }

#define XB_TMO      128
#define XB_XCNT(j)  (256  + 64 * (j))
#define XB_XSUB(j)  (1280 + 64 * (j))
#define XB_XGEN(j)  (2304 + 64 * (j))
#define XB_TOP      3328
#define XB_TOPGEN   3392
#define XCD_BAR_WORDS 3456
#define XB_SPIN_CAP (1u << 18)

__device__ __forceinline__ unsigned xb_ld(unsigned* p)              { return __hip_atomic_load(p, __ATOMIC_RELAXED, __HIP_MEMORY_SCOPE_AGENT); }
__device__ __forceinline__ unsigned xb_add(unsigned* p, unsigned v) { return __hip_atomic_fetch_add(p, v, __ATOMIC_RELAXED, __HIP_MEMORY_SCOPE_AGENT); }
__device__ __forceinline__ unsigned xb_xcc_id() { return (unsigned)__builtin_amdgcn_s_getreg((3 << 11) | 20) & 0xFu; }
#define XB_SPIN(cond, bar) do { unsigned _sp = 0; while (cond) { __builtin_amdgcn_s_sleep(1); \
    if ((++_sp & 255u) == 0u) { if (xb_ld(&(bar)[XB_TMO])) break; if (_sp > XB_SPIN_CAP) { atomicAdd(&(bar)[XB_TMO], 1u); break; } } } } while (0)

struct XcdBarrier {
    unsigned* bar; unsigned x;
    volatile LAS unsigned* st;
};

__device__ __forceinline__ XcdBarrier xcd_barrier_post(unsigned* bar, volatile LAS unsigned* st, int xb_tid) {
    XcdBarrier b; b.bar = bar; b.x = xb_xcc_id(); b.st = st;
    if (xb_tid == 0) (void)xb_add(&bar[XB_XCNT(b.x)], 1u);
    return b;
}
__device__ __forceinline__ void xcd_barrier_complete(unsigned* bar, unsigned x, unsigned& nloc, unsigned& nx) {
    const unsigned G = gridDim.x * gridDim.y * gridDim.z;
    unsigned sum, cnt, mine, sp = 0u;
    for (;;) {
        sum = 0u; cnt = 0u; mine = 0u;
#pragma unroll
        for (unsigned j = 0; j < 16; ++j) { const unsigned c = xb_ld(&bar[XB_XCNT(j)]); sum += c; cnt += (c > 0u) ? 1u : 0u; mine = (j == x) ? c : mine; }
        if (sum == G) break;
        __builtin_amdgcn_s_sleep(1);
        if ((++sp & 255u) == 0u) { if (xb_ld(&bar[XB_TMO])) break; if (sp > XB_SPIN_CAP) { atomicAdd(&bar[XB_TMO], 1u); break; } }
    }
    nloc = mine > 0u ? mine : 1u; nx = cnt > 0u ? cnt : 1u;
}

__device__ __forceinline__ void xcd_barrier(const XcdBarrier& b, int xb_tid) {
    asm volatile("s_waitcnt vmcnt(0)" ::: "memory");
    __syncthreads();
    if (xb_tid == 0) {
        unsigned* bar = b.bar;
        __builtin_amdgcn_s_waitcnt(0);
        unsigned nloc = b.st[0], nx = b.st[1];
        if (nloc == 0u) { xcd_barrier_complete(bar, b.x, nloc, nx); b.st[0] = nloc; b.st[1] = nx; }
        const unsigned old = xb_add(&bar[XB_XSUB(b.x)], 1u);
        const unsigned gen = old / nloc;
        if (old + 1u == (gen + 1u) * nloc) {
            __builtin_amdgcn_fence(__ATOMIC_RELEASE, "agent");
            asm volatile("s_waitcnt vmcnt(0)" ::: "memory");
            const unsigned og = xb_add(&bar[XB_TOP], 1u);
            const unsigned tg = og / nx;
            if (og + 1u == (tg + 1u) * nx) xb_add(&bar[XB_TOPGEN], 1u);
            else XB_SPIN(xb_ld(&bar[XB_TOPGEN]) == tg, bar);
            __builtin_amdgcn_fence(__ATOMIC_ACQUIRE, "agent");
            xb_add(&bar[XB_XGEN(b.x)], 1u);
            asm volatile("s_waitcnt vmcnt(0)" ::: "memory");
        } else {
            XB_SPIN(xb_ld(&bar[XB_XGEN(b.x)]) == gen, bar);
            __builtin_amdgcn_fence(__ATOMIC_ACQUIRE, "agent");
            asm volatile("s_waitcnt vmcnt(0)" ::: "memory");
        }
    }
    __syncthreads();
}
struct ArgsH { const float* in[N_IN]; float* out; unsigned char* ws; double invf[44]; int ph_lo, ph_hi, li, pad; };
struct ArgsD { const GAS float* in[N_IN]; GAS float* out; GAS unsigned char* ws; double invf[44]; int ph_lo, ph_hi, li, pad; };
static_assert(sizeof(ArgsH) == sizeof(ArgsD), "args layout");
typedef const CAS ArgsD& ARef;
__device__ __forceinline__ const CAS ArgsD* kargs() {
#if defined(__HIP_DEVICE_COMPILE__)
    const CAS ArgsD* p = (const CAS ArgsD*)__builtin_amdgcn_kernarg_segment_ptr(); asm volatile("" : "+s"(p)); return p;
#else
    return nullptr;
#endif
}
struct WI { LAS unsigned char* lds; int tid, lane, wave, vcu, G, gw, NGW, bx; };
constexpr size_t RWA_STRIDE = (33 * MiB + 68 * 1024) / 4;
constexpr size_t YO_STRIDE = 32 * MiB / 4;

__device__ __forceinline__ int wave_sum_i(int v) {
#pragma unroll
    for (int o = 1; o < 64; o <<= 1) v += __shfl_xor(v, o);
    return v;
}
__device__ __forceinline__ void sincos_d(double ang, float& s, float& c) {
    const double q = __builtin_rint(ang * 0.63661977236758134308);
    double r = __builtin_fma(-q, 1.57079632679489661923, ang); r = __builtin_fma(-q, 6.123233995736766e-17, r);
    const double r2 = r * r;
    const double sp = r * (1.0 + r2 * (-1.0 / 6 + r2 * (1.0 / 120 + r2 * (-1.0 / 5040 + r2 * (1.0 / 362880 + r2 * (-1.0 / 39916800 + r2 * (1.0 / 6227020800.0)))))));
    const double cp = 1.0 + r2 * (-0.5 + r2 * (1.0 / 24 + r2 * (-1.0 / 720 + r2 * (1.0 / 40320 + r2 * (-1.0 / 3628800 + r2 * (1.0 / 479001600 + r2 * (-1.0 / 87178291200.0)))))));
    const int qi = ((int)q) & 3;
    const double ss = (qi == 0) ? sp : (qi == 1) ? cp : (qi == 2) ? -sp : -cp;
    const double cc = (qi == 0) ? cp : (qi == 1) ? -sp : (qi == 2) ? -cp : sp;
    s = (float)ss; c = (float)cc;
}

struct TrItem { const float* src; bf16* dst; int ldw; float scale; bool ok; };
__device__ __forceinline__ void tr_decode(ARef A, int it, int lane, TrItem& d) {
    constexpr int I_IN = NLAYER * 16 * 96, I_OUT = NLAYER * 16 * 32, I_W1 = NLAYER * NEXP * 16 * 64;
    const float* W; int ldw, nvalid, k0, nsrc0; bf16* WT; size_t dstrow0; float scale = 1.0f;
    int r = it;
    if (r < I_IN) { const int l = r / 1536, rr = r % 1536, kb = rr / 96, nb = rr % 96;
        const int nd = nb * 32;
        nsrc0 = (nd < 1024) ? nd : (nd < 1792) ? C_SB + (nd - 1024) : (nd < 2688) ? C_RW + (nd - 1792) : C_DSA + (nd - 2688);
        nvalid = (nd < 1024) ? 1024 : (nd < 1792) ? INC : (nd < 2688) ? C_DSA : ((nd < INC) ? C_SB : 0);
        scale = (nd >= 256 && nd < 512) ? 0.125f : (nd >= 1024 && nd < 1280) ? 0.18033688011112042f : 1.0f;
        W = A.in[I_WIN] + (size_t)l * DM * INC; ldw = INC; k0 = kb * 64; WT = (bf16*)(A.ws + WS_WIN) + (size_t)l * INCP * DM; dstrow0 = (size_t)nd; }
    else if (r < I_IN + I_OUT) { r -= I_IN; const int l = r / 512, rr = r % 512, kb = rr / 32, nb = rr % 32;
        W = A.in[I_WOUT] + (size_t)l * DM * DM; ldw = DM; nvalid = DM; k0 = kb * 64; nsrc0 = nb * 32; WT = (bf16*)(A.ws + WS_WOUT) + (size_t)l * DM * DM; dstrow0 = (size_t)nb * 32; }
    else if (r < I_IN + I_OUT + I_W1) { r -= I_IN + I_OUT; const int le = r / 1024, rr = r % 1024, kb = rr / 64, nb = rr % 64, j = nb >> 3, bj = (nb >> 2) & 1, cc0 = (nb & 3) * 32;
        W = A.in[I_MW1] + (size_t)le * DM * 2048; ldw = 2048; nvalid = 2048; k0 = kb * 64; nsrc0 = bj * 1024 + 128 * j + cc0; WT = (bf16*)(A.ws + WS_W1) + (size_t)le * 2048 * DM; dstrow0 = (size_t)nb * 32; }
    else { r -= I_IN + I_OUT + I_W1; const int le = r / 512, rr = r % 512, kb = rr / 32, nb = rr % 32;
        W = A.in[I_MW2] + (size_t)le * DM * DM; ldw = DM; nvalid = DM; k0 = kb * 64; nsrc0 = nb * 32; WT = (bf16*)(A.ws + WS_W2) + (size_t)le * DM * DM; dstrow0 = (size_t)nb * 32; }
    const int n = nsrc0 + 4 * (lane & 7);
    d.ok = n < nvalid; d.src = W + (size_t)(k0 + (lane >> 3)) * ldw + (d.ok ? n : 0); d.ldw = ldw; d.scale = scale;
    d.dst = WT + (dstrow0 + (lane >> 3)) * 1024 + k0 + 8 * (lane & 7);
}
__device__ __forceinline__ void tr_load(const TrItem& d, f32x4 (&v)[8]) {
#pragma unroll
    for (int i = 0; i < 8; ++i) v[i] = *(const f32x4*)(d.src + (size_t)(8 * i) * d.ldw);
}
__device__ __forceinline__ void tr_store(const TrItem& d, const f32x4 (&v)[8], LAS float* scr, int lane) {
    const float sc_ = d.ok ? d.scale : 0.0f;
#pragma unroll
    for (int i = 0; i < 8; ++i) { LAS float* s = scr + (8 * i + (lane >> 3)) * 33 + 4 * (lane & 7); s[0] = v[i].x * sc_; s[1] = v[i].y * sc_; s[2] = v[i].z * sc_; s[3] = v[i].w * sc_; }
    LDS_WAIT(); asm volatile("" ::: "memory");
    const int c8 = lane & 7;
#pragma unroll
    for (int j = 0; j < 4; ++j) { const int n = (lane >> 3) + 8 * j; const LAS float* s = scr + (8 * c8) * 33 + n;
        v4u o; o.x = pk2(s[0 * 33], s[1 * 33]); o.y = pk2(s[2 * 33], s[3 * 33]); o.z = pk2(s[4 * 33], s[5 * 33]); o.w = pk2(s[6 * 33], s[7 * 33]);
        *(v4u*)(d.dst + (size_t)(8 * j) * 1024) = o; }
    LDS_WAIT(); asm volatile("" ::: "memory");
}
__device__ __forceinline__ void ph_prologue(ARef A, const WI& w) {
    LAS float* sc = (LAS float*)w.lds;
    { const float* cin = A.in[I_C]; for (int i = w.tid; i < NB * DM; i += NWAVES * 64) { const float v = cin[i]; sc[i] = v / (1.0f + expf(-v)); } }
    __syncthreads();
    float* MOD = (float*)(A.ws + WS_MOD);
    LAS float* red = (LAS float*)(w.lds + 32768);
    if (w.vcu < 192) {
        const int l = w.vcu / 96, col = (w.vcu % 96) * 64 + w.lane, kw = 128 * w.wave;
        const float* wp = A.in[I_ADAW] + (size_t)l * DM * 6144 + (size_t)kw * 6144 + col;
        float acc[8];
#pragma unroll
        for (int b = 0; b < 8; ++b) acc[b] = 0.0f;
#pragma unroll 16
        for (int k = 0; k < 128; ++k) { const float wv = wp[(size_t)k * 6144];
#pragma unroll
            for (int b = 0; b < 8; ++b) acc[b] += sc[b * DM + kw + k] * wv; }
#pragma unroll
        for (int b = 0; b < 8; ++b) red[(w.wave * 8 + b) * 64 + w.lane] = acc[b];
    }
    __syncthreads();
    if (w.vcu < 192) { const int l = w.vcu / 96, b = w.wave, col = (w.vcu % 96) * 64 + w.lane;
        float s = A.in[I_ADAB][l * 6144 + col];
#pragma unroll
        for (int q = 0; q < 8; ++q) s += red[(q * 8 + b) * 64 + w.lane];
        MOD[(size_t)(l * 8 + b) * 6144 + col] = s; }
    __syncthreads();
    LAS float* scr = (LAS float*)(w.lds + 32768 + w.wave * 8448);
    constexpr int NIT = NLAYER * 16 * 96 + NLAYER * 16 * 32;
    { TrItem d0, d1; f32x4 va[8], vb[8];
      int it = w.gw; bool h0 = it < NIT;
      if (h0) { tr_decode(A, it, w.lane, d0); tr_load(d0, va); }
      while (h0) {
          it += w.NGW; const bool h1 = it < NIT;
          if (h1) { tr_decode(A, it, w.lane, d1); tr_load(d1, vb); }
          tr_store(d0, va, scr, w.lane);
          if (!h1) break;
          it += w.NGW; h0 = it < NIT;
          if (h0) { tr_decode(A, it, w.lane, d0); tr_load(d0, va); }
          tr_store(d1, vb, scr, w.lane);
      } }
    float* RT = (float*)(A.ws + WS_ROPE); const int* pos = (const int*)A.in[I_POS];
    for (int g = w.gw * 64 + w.lane; g < MTOK * 44; g += w.NGW * 64) {
        const int tok = g / 44, f = g % 44; int co, so;
        if (f < 32) { co = f; so = 32 + f; } else if (f < 40) { co = 64 + (f - 32); so = 72 + (f - 32); } else { co = 80 + (f - 40); so = 84 + (f - 40); }
        float s, c; sincos_d((double)pos[tok] * A.invf[f], s, c);
        RT[(size_t)tok * ROPE_W + co] = c; RT[(size_t)tok * ROPE_W + so] = s;
    }
}

__device__ __forceinline__ void moe_convert_chunk(ARef A, int l, int c, int lane, LAS float* scr) {
    constexpr int I0 = NLAYER * 16 * 96 + NLAYER * 16 * 32, I_W1 = NLAYER * NEXP * 16 * 64;
    const int it0 = (c < 8192) ? I0 + l * 32768 + 4 * c : I0 + I_W1 + l * 16384 + 4 * (c - 8192);
    TrItem d0, d1; f32x4 va[8], vb[8];
    tr_decode(A, it0, lane, d0); tr_load(d0, va);
    tr_decode(A, it0 + 1, lane, d1); tr_load(d1, vb);
    tr_store(d0, va, scr, lane);
    tr_decode(A, it0 + 2, lane, d0); tr_load(d0, va);
    tr_store(d1, vb, scr, lane);
    tr_decode(A, it0 + 3, lane, d1); tr_load(d1, vb);
    tr_store(d0, va, scr, lane);
    tr_store(d1, vb, scr, lane);
}

__device__ __forceinline__ void emit_h_row(const f32x4 (&v)[4], float rstd, const float* g, const float* sc, const float* sh, bf16* hrow, int lane) {
#pragma unroll
    for (int j = 0; j < 4; ++j) { const int k = 4 * (lane + 64 * j);
        const f32x4 gv = *(const f32x4*)(g + k), scv = *(const f32x4*)(sc + k), shv = *(const f32x4*)(sh + k);
        const f32x4 h = v[j] * rstd * gv * (1.0f + scv) + shv;
        v2u o; o.x = pk2(h.x, h.y); o.y = pk2(h.z, h.w); *(v2u*)(hrow + k) = o; }
}
__device__ __forceinline__ void small_weights_to_f16(ARef A, const WI& w) {
    { _Float16* SW = (_Float16*)(A.ws + WS_SMALLW);
      const int g0 = w.gw * 64 + w.lane, gs = w.NGW * 64;
      for (int l = 0; l < NLAYER; ++l) { _Float16* S = SW + (size_t)l * SMW_LAYER;
          const float* wq = A.in[I_WQ] + (size_t)l * 128 * 256; const float* wqi = A.in[I_WQI] + (size_t)l * 128 * 256;
          for (int e = g0; e < 256 * 128; e += gs) { const int n = e >> 7, k = e & 127; S[SMW_QI + e] = (_Float16)wq[k * 256 + n]; S[SMW_QI + 256 * 128 + e] = (_Float16)wqi[k * 256 + n]; }
          const float* w2 = A.in[I_W2] + (size_t)l * 32 * 256; const float* a2 = A.in[I_A2] + (size_t)l * 32 * 256; const float* g2 = A.in[I_G2] + (size_t)l * 64 * 256;
          for (int e = g0; e < 256 * 32; e += gs) { const int n = e >> 5, k = e & 31; S[SMW_W2 + e] = (_Float16)w2[k * 256 + n]; S[SMW_A2 + e] = (_Float16)a2[k * 256 + n]; }
          for (int e = g0; e < 256 * 64; e += gs) { const int n = e >> 6, k = e & 63; S[SMW_G2 + e] = (_Float16)g2[k * 256 + n]; } } }
}
__device__ __forceinline__ void ph_norm1(ARef A, const WI& w) {
    const float* MOD = (const float*)(A.ws + WS_MOD); bf16* H = (bf16*)(A.ws + WS_H);
    for (int m = w.gw; m < MTOK; m += w.NGW) {
        const float* xr = A.in[I_X] + (size_t)m * DM; f32x4 v[4]; float ss = 0.0f;
#pragma unroll
        for (int j = 0; j < 4; ++j) { v[j] = *(const f32x4*)(xr + 4 * (w.lane + 64 * j)); ss += dot4(v[j], v[j]); }
        ss = wave_sum(ss); const float rstd = 1.0f / sqrtf(ss * (1.0f / DM) + 1e-5f);
        const float* mb = MOD + (size_t)(m >> 12) * 6144;
        emit_h_row(v, rstd, A.in[I_NMIX], mb + 1024, mb, H + (size_t)m * DM, w.lane);
    }
}

typedef _Float16 h4v __attribute__((ext_vector_type(4)));
__device__ __forceinline__ f16x8 pack_f16x8(f32x4 a, f32x4 b) { f16x8 r; r[0] = (_Float16)a.x; r[1] = (_Float16)a.y; r[2] = (_Float16)a.z; r[3] = (_Float16)a.w; r[4] = (_Float16)b.x; r[5] = (_Float16)b.y; r[6] = (_Float16)b.z; r[7] = (_Float16)b.w; return r; }
#define RW_STB4(k_, val_) do { v2u w_; w_.x = pk2((val_).x, (val_).y); w_.y = pk2((val_).z, (val_).w); *(v2u*)((bf16*)(RWA + (k_) * RWA_STRIDE) + o) = w_; } while (0)
#ifndef RWKV_RKV_BF16
#define RWKV_RKV_BF16 1
#endif
#if RWKV_RKV_BF16
#define RW_ST_RKV(k_, val_) RW_STB4(k_, val_)
#else
#define RW_ST_RKV(k_, val_) (*(f32x4*)(RWA + (k_) * RWA_STRIDE + o) = (val_))
#endif
__device__ __forceinline__ f32x4 ldb4(const bf16* q) { const v2u x = *(const v2u*)q; return (f32x4){bf_lo(x.x), bf_hi(x.x), bf_lo(x.y), bf_hi(x.y)}; }
__device__ __forceinline__ void prep16_body(const bf16* __restrict__ P, float* __restrict__ RWA, const _Float16* __restrict__ SW, const float* __restrict__ RT, bf16* __restrict__ DQ, _Float16* __restrict__ DQI,
                                            bf16* __restrict__ DKB, bf16* __restrict__ DVB, _Float16* __restrict__ DKI, float* __restrict__ DW, const float* __restrict__ mu, const float* __restrict__ qn,
                                            const float* __restrict__ w0p, const float* __restrict__ a0p, const float* __restrict__ kkp, const float* __restrict__ kap, const float* __restrict__ rkp, int m0, int lane_in, int part = 7) {
    int lane = lane_in; asm volatile("" : "+v"(lane));
    const int tk = lane & 15, q4 = lane >> 4, m = m0 + tk, t = m & (SEQ - 1);
    const bf16* pr = P + (size_t)m * PFW; const bf16* pp = pr - PFW; const bf16* pd = P + (size_t)m * PFW + PF_DSA;
    RT += (size_t)m * ROPE_W; const f32x4 zero4 = {0.f, 0.f, 0.f, 0.f};
    f16x8 bx[4], bc[4];
    { float ss = 0.0f; f32x4 c[4][2];
#pragma unroll
      for (int ks = 0; ks < 4; ++ks) { const int f0 = 32 * ks + 8 * q4;
          f32x4 x[2];
#pragma unroll
          for (int u = 0; u < 2; ++u) { const f32x4 z = ldb4(pr + 768 + f0 + 4 * u); const f32x4 p = t ? ldb4(pp + 768 + f0 + 4 * u) : zero4; x[u] = z + (p - z) * *(const f32x4*)(mu + 768 + f0 + 4 * u);
#pragma unroll
              for (int i = 0; i < 4; ++i) x[u][i] = (ks == 0) ? ftanh(x[u][i]) : (ks == 1) ? x[u][i] : sigm(x[u][i]); }
          bx[ks] = pack_f16x8(x[0], x[1]);
          c[ks][0] = ldb4(pd + f0); c[ks][1] = ldb4(pd + f0 + 4); ss += dot4(c[ks][0], c[ks][0]) + dot4(c[ks][1], c[ks][1]); }
      ss += __shfl_xor(ss, 16); ss += __shfl_xor(ss, 32);
      const float rstd = 1.0f / sqrtf(ss * (1.0f / 128.0f) + 1e-5f);
#pragma unroll
      for (int ks = 0; ks < 4; ++ks) { const int f0 = 32 * ks + 8 * q4; bc[ks] = pack_f16x8(c[ks][0] * rstd * *(const f32x4*)(qn + f0), c[ks][1] * rstd * *(const f32x4*)(qn + f0 + 4)); } }
    const _Float16* wrow = SW + (size_t)tk * 0;
    (void)wrow;
    const int arow = lane & 15;
    if (part & 1)
#pragma unroll 2
    for (int hd = 0; hd < 4; ++hd) {
        f32x4 fk[4], av[4]; float ssk = 0.0f;
#pragma unroll
        for (int j = 0; j < 4; ++j) { const int nb = 4 * hd + j, ch = 16 * nb + 4 * q4; const size_t o = (size_t)m * 256 + ch;
            const f16x8 aw = *(const f16x8*)(SW + SMW_W2 + (16 * nb + arow) * 32 + 8 * q4), aa = *(const f16x8*)(SW + SMW_A2 + (16 * nb + arow) * 32 + 8 * q4);
            const f16x8 ag0 = *(const f16x8*)(SW + SMW_G2 + (16 * nb + arow) * 64 + 8 * q4), ag1 = *(const f16x8*)(SW + SMW_G2 + (16 * nb + arow) * 64 + 32 + 8 * q4);
            const f32x4 cw = __builtin_amdgcn_mfma_f32_16x16x32_f16(aw, bx[0], *(const f32x4*)(w0p + ch), 0, 0, 0);
            const f32x4 ca = __builtin_amdgcn_mfma_f32_16x16x32_f16(aa, bx[1], *(const f32x4*)(a0p + ch), 0, 0, 0);
            f32x4 cg = __builtin_amdgcn_mfma_f32_16x16x32_f16(ag0, bx[2], zero4, 0, 0, 0); cg = __builtin_amdgcn_mfma_f32_16x16x32_f16(ag1, bx[3], cg, 0, 0, 0);
            f32x4 dec;
#pragma unroll
            for (int i = 0; i < 4; ++i) { dec[i] = fexp(-fexp(-softplusf(-cw[i]) - 0.5f)); av[j][i] = sigm(ca[i]); }
            *(f32x4*)(RWA + 1 * RWA_STRIDE + o) = dec; RW_STB4(6, cg);
            { const f32x4 z = ldb4(pr + 256 + ch); const f32x4 p = t ? ldb4(pp + 256 + ch) : zero4; fk[j] = z + (p - z) * *(const f32x4*)(mu + 256 + ch); }
            const f32x4 kk = fk[j] * *(const f32x4*)(kkp + ch); ssk += dot4(kk, kk); }
        ssk += __shfl_xor(ssk, 16); ssk += __shfl_xor(ssk, 32);
        const float inrm = 1.0f / fmaxf(sqrtf(ssk), 1e-12f);
        f32x4 fr[4], km[4]; float bs = 0.0f;
#pragma unroll
        for (int j = 0; j < 4; ++j) { const int ch = 16 * (4 * hd + j) + 4 * q4;
            { const f32x4 z = ldb4(pr + ch); const f32x4 p = t ? ldb4(pp + ch) : zero4; fr[j] = z + (p - z) * *(const f32x4*)(mu + ch); }
            km[j] = fk[j] * (1.0f + (av[j] - 1.0f) * *(const f32x4*)(kap + ch)); bs += dot4(fr[j] * km[j], *(const f32x4*)(rkp + ch)); }
        bs += __shfl_xor(bs, 16); bs += __shfl_xor(bs, 32);
#pragma unroll
        for (int j = 0; j < 4; ++j) { const int ch = 16 * (4 * hd + j) + 4 * q4; const size_t o = (size_t)m * 256 + ch;
            f32x4 fv; { const f32x4 z = ldb4(pr + 512 + ch); const f32x4 p = t ? ldb4(pp + 512 + ch) : zero4; fv = z + (p - z) * *(const f32x4*)(mu + 512 + ch); }
            const f32x4 kk = fk[j] * *(const f32x4*)(kkp + ch) * inrm;
            RW_ST_RKV(0, fr[j]); RW_ST_RKV(2, km[j]); RW_ST_RKV(3, fv);
            *(f32x4*)(RWA + 4 * RWA_STRIDE + o) = -kk; *(f32x4*)(RWA + 5 * RWA_STRIDE + o) = kk * av[j]; { const f32x4 bo_ = bs * fv; RW_STB4(7, bo_); } }
    }
    if (part & 2)
#pragma unroll 4
    for (int nb = 0; nb < 32; ++nb) {
        f32x4 cq = zero4;
#pragma unroll
        for (int ks = 0; ks < 4; ++ks) { const f16x8 aq = *(const f16x8*)(SW + SMW_QI + (16 * nb + arow) * 128 + 32 * ks + 8 * q4); cq = __builtin_amdgcn_mfma_f32_16x16x32_f16(aq, bc[ks], cq, 0, 0, 0); }
        const int ch = 16 * (nb & 15) + 4 * q4;
        if (nb < 16) {
            if ((nb & 3) == 0) { const f32x4 ot = shx4(cq, 32); const int fi = 4 * (q4 & 1); const f32x4 cs4 = *(const f32x4*)(RT + 64 + fi), sn = *(const f32x4*)(RT + 72 + fi); cq = (q4 < 2) ? cq * cs4 - ot * sn : ot * sn + cq * cs4; }
            const f32x4 qs = cq * 0.18033688011112042f; v2u o; o.x = pk2(qs.x, qs.y); o.y = pk2(qs.z, qs.w); *(v2u*)(DQ + (size_t)m * 256 + ch) = o;
        } else {
            if ((nb & 1) == 0) { const f32x4 ot = shx4(cq, 16); const f32x4 cs4 = *(const f32x4*)(RT + 80), sn = *(const f32x4*)(RT + 84); if (q4 < 2) cq = (q4 < 1) ? cq * cs4 - ot * sn : ot * sn + cq * cs4; }
            h4v hq; hq.x = (_Float16)cq.x; hq.y = (_Float16)cq.y; hq.z = (_Float16)cq.z; hq.w = (_Float16)cq.w; *(h4v*)(DQI + (size_t)m * 256 + ch) = hq;
        }
    }
#pragma unroll
    for (int j = 0; j < 4; ++j) { const int d = 16 * j + 4 * q4; f32x4 kx = ldb4(pd + 128 + d);
        if (j == 0) { const f32x4 ot = shx4(kx, 32); const int fi = 4 * (q4 & 1); const f32x4 cs4 = *(const f32x4*)(RT + 64 + fi), sn = *(const f32x4*)(RT + 72 + fi); kx = (q4 < 2) ? kx * cs4 - ot * sn : ot * sn + kx * cs4; }
        v2u o; o.x = pk2(kx.x, kx.y); o.y = pk2(kx.z, kx.w); *(v2u*)(DKB + (size_t)m * 64 + d) = o;
        const f32x4 vx = ldb4(pd + 192 + d); v2u ov; ov.x = pk2(vx.x, vx.y); ov.y = pk2(vx.z, vx.w); *(v2u*)(DVB + (size_t)m * 64 + d) = ov; }
#pragma unroll
    for (int j = 0; j < 2; ++j) { const int d = 16 * j + 4 * q4; f32x4 ki = ldb4(pd + 256 + d);
        if (j == 0) { const f32x4 ot = shx4(ki, 16); const f32x4 cs4 = *(const f32x4*)(RT + 80), sn = *(const f32x4*)(RT + 84); if (q4 < 2) ki = (q4 < 1) ? ki * cs4 - ot * sn : ot * sn + ki * cs4; }
        h4v hk; hk.x = (_Float16)ki.x; hk.y = (_Float16)ki.y; hk.z = (_Float16)ki.z; hk.w = (_Float16)ki.w; *(h4v*)(DKI + (size_t)m * 32 + d) = hk; }
    if (q4 < 2) *(f32x4*)(DW + (size_t)m * 8 + 4 * q4) = ldb4(pd + 288 + 4 * q4) * 0.0625f;
}

__device__ __forceinline__ void prep16(ARef A, int l, int m0, int lane_in, int part = 7) {
    prep16_body((const bf16*)(A.ws + WS_PF), (float*)(A.ws + WS_RWA), (const _Float16*)(A.ws + WS_SMALLW) + (size_t)l * SMW_LAYER, (const float*)(A.ws + WS_ROPE), (bf16*)(A.ws + WS_DQ), (_Float16*)(A.ws + WS_DQI),
                (bf16*)(A.ws + WS_DKB), (bf16*)(A.ws + WS_DVB), (_Float16*)(A.ws + WS_DKI), (float*)(A.ws + WS_DW), A.in[I_MU] + l * 896, A.in[I_QNORM] + l * 128,
                A.in[I_W0] + l * 256, A.in[I_A0] + l * 256, A.in[I_KK] + l * 256, A.in[I_KA] + l * 256, A.in[I_RK] + l * 256, m0, lane_in, part);
}
__device__ __forceinline__ float quad_sum(float v) {
    v += __builtin_bit_cast(float, __builtin_amdgcn_mov_dpp(__builtin_bit_cast(int, v), 0xB1, 0xF, 0xF, true));
    v += __builtin_bit_cast(float, __builtin_amdgcn_mov_dpp(__builtin_bit_cast(int, v), 0x4E, 0xF, 0xF, true));
    return v;
}
__device__ __forceinline__ float oct_sum(float v) {
    v += __builtin_bit_cast(float, __builtin_amdgcn_mov_dpp(__builtin_bit_cast(int, v), 0xB1, 0xF, 0xF, true));
    v += __builtin_bit_cast(float, __builtin_amdgcn_mov_dpp(__builtin_bit_cast(int, v), 0x4E, 0xF, 0xF, true));
    v += __builtin_bit_cast(float, __builtin_amdgcn_mov_dpp(__builtin_bit_cast(int, v), 0x141, 0xF, 0xF, true));
    return v;
}
typedef float f32x2 __attribute__((ext_vector_type(2)));
#define LO2(v_) __builtin_shufflevector(v_, v_, 0, 1)
#define HI2(v_) __builtin_shufflevector(v_, v_, 2, 3)
#define RW_ROW(i_) (((i_) < 2) ? (16 * ws + rg + 8 * (i_)) : (64 + 16 * ws + rg + 8 * ((i_) - 2)))
#define RW_LOAD(op, s_) do { const int lo_ = (s_) * 64 + kq * 8; \
    op[0] = *(const LAS f32x4*)(sn + lo_); op[1] = *(const LAS f32x4*)(sn + lo_ + 4); op[2] = *(const LAS f32x4*)(sw + lo_); op[3] = *(const LAS f32x4*)(sw + lo_ + 4); \
    op[4] = *(const LAS f32x4*)(sb + lo_); op[5] = *(const LAS f32x4*)(sb + lo_ + 4); op[6] = *(const LAS f32x4*)(sk + lo_); op[7] = *(const LAS f32x4*)(sk + lo_ + 4); \
    op[8] = *(const LAS f32x4*)(sr + lo_); op[9] = *(const LAS f32x4*)(sr + lo_ + 4); \
    vin[0] = sv[(s_) * 64 + 16 * ws + rg]; vin[1] = sv[(s_) * 64 + 16 * ws + rg + 8]; } while (0)
#define RW_DOT(i_, oa, ob) ({ f32x2 d_ = S[i_][0] * LO2(oa); d_ = S[i_][1] * HI2(oa) + d_; d_ = S[i_][2] * LO2(ob) + d_; d_ = S[i_][3] * HI2(ob) + d_; d_.x + d_.y; })
#define RW_STEP(op, vv, s_) do { float sa_[4], y_[4]; \
    _Pragma("unroll") for (int i_ = 0; i_ < 4; ++i_) sa_[i_] = RW_DOT(i_, op[0], op[1]); \
    _Pragma("unroll") for (int i_ = 0; i_ < 4; ++i_) sa_[i_] += __builtin_bit_cast(float, __builtin_amdgcn_mov_dpp(__builtin_bit_cast(int, sa_[i_]), 0xB1, 0xF, 0xF, true)); \
    _Pragma("unroll") for (int i_ = 0; i_ < 4; ++i_) sa_[i_] += __builtin_bit_cast(float, __builtin_amdgcn_mov_dpp(__builtin_bit_cast(int, sa_[i_]), 0x4E, 0xF, 0xF, true)); \
    _Pragma("unroll") for (int i_ = 0; i_ < 4; ++i_) sa_[i_] += __builtin_bit_cast(float, __builtin_amdgcn_mov_dpp(__builtin_bit_cast(int, sa_[i_]), 0x141, 0xF, 0xF, true)); \
    _Pragma("unroll") for (int i_ = 0; i_ < 2; ++i_) { const f32x2 a2_ = {sa_[i_], sa_[i_]}, v2_ = {vv[i_], vv[i_]}; \
        S[i_][0] = S[i_][0] * LO2(op[2]) + (a2_ * LO2(op[4]) + v2_ * LO2(op[6])); S[i_][1] = S[i_][1] * HI2(op[2]) + (a2_ * HI2(op[4]) + v2_ * HI2(op[6])); \
        S[i_][2] = S[i_][2] * LO2(op[3]) + (a2_ * LO2(op[5]) + v2_ * LO2(op[7])); S[i_][3] = S[i_][3] * HI2(op[3]) + (a2_ * HI2(op[5]) + v2_ * HI2(op[7])); } \
    _Pragma("unroll") for (int i_ = 2; i_ < 4; ++i_) { const f32x2 a2_ = {sa_[i_], sa_[i_]}; \
        S[i_][0] = S[i_][0] * LO2(op[2]) + a2_ * LO2(op[4]); S[i_][1] = S[i_][1] * HI2(op[2]) + a2_ * HI2(op[4]); S[i_][2] = S[i_][2] * LO2(op[3]) + a2_ * LO2(op[5]); S[i_][3] = S[i_][3] * HI2(op[3]) + a2_ * HI2(op[5]); } \
    _Pragma("unroll") for (int i_ = 0; i_ < 4; ++i_) y_[i_] = RW_DOT(i_, op[8], op[9]); \
    _Pragma("unroll") for (int i_ = 0; i_ < 4; ++i_) y_[i_] += __builtin_bit_cast(float, __builtin_amdgcn_mov_dpp(__builtin_bit_cast(int, y_[i_]), 0xB1, 0xF, 0xF, true)); \
    _Pragma("unroll") for (int i_ = 0; i_ < 4; ++i_) y_[i_] += __builtin_bit_cast(float, __builtin_amdgcn_mov_dpp(__builtin_bit_cast(int, y_[i_]), 0x4E, 0xF, 0xF, true)); \
    _Pragma("unroll") for (int i_ = 0; i_ < 4; ++i_) y_[i_] += __builtin_bit_cast(float, __builtin_amdgcn_mov_dpp(__builtin_bit_cast(int, y_[i_]), 0x141, 0xF, 0xF, true)); \
    if (kq == 0) { _Pragma("unroll") for (int i_ = 0; i_ < 4; ++i_) so[(s_) * 128 + RW_ROW(i_)] = y_[i_]; } } while (0)
__device__ __forceinline__ void scan_rwkv_task2(ARef A, const WI& w, int task0) {
    const int slot = w.wave >> 2, ws = w.wave & 3, lt = w.tid & 255, task = task0 + slot;
    const int bh = task >> 4, c = task & 15, b = bh >> 2, h = bh & 3;
    LAS float* sw = (LAS float*)w.lds + slot * 16384; LAS float* sn = sw + 2048; LAS float* sb = sn + 2048; LAS float* sk = sb + 2048; LAS float* sr = sk + 2048; LAS float* sv = sr + 2048; LAS float* so = sv + 2048;
    const float* RWA = (const float*)(A.ws + WS_RWA);
    const int rg = w.lane >> 3, kq = w.lane & 7;
    f32x2 S[4][4];
#pragma unroll
    for (int i = 0; i < 4; ++i)
#pragma unroll
        for (int j = 0; j < 4; ++j) { const int r = RW_ROW(i); S[i][j].x = (r >= 64 && 8 * kq + 2 * j == r - 64) ? 1.0f : 0.0f; S[i][j].y = (r >= 64 && 8 * kq + 2 * j + 1 == r - 64) ? 1.0f : 0.0f; }
    const size_t tok0 = (size_t)b * SEQ + (size_t)c * TCH;
    const int st = lt >> 3, sd = (lt & 7) * 8;
#if RWKV_RKV_BF16
    f32x4 a[3][2]; v4u ab[3];
#define RW_LD_RKV(i_, k_) ab[i_] = *(const v4u*)((const bf16*)(RWA + (k_) * RWA_STRIDE) + o_)
#define RW_GET_RKV(i_, q_) RW_UNPK(ab[i_], q_)
#else
    f32x4 a[3][2]; f32x4 af[3][2];
#define RW_LD_RKV(i_, k_) do { af[i_][0] = *(const f32x4*)(RWA + (k_) * RWA_STRIDE + o_); af[i_][1] = *(const f32x4*)(RWA + (k_) * RWA_STRIDE + o_ + 4); } while (0)
#define RW_GET_RKV(i_, q_) af[i_][q_]
#endif
#define RW_GLOAD(sub_) do { const size_t o_ = (tok0 + (sub_) * 32 + st) * 256 + h * 64 + sd; \
        _Pragma("unroll") for (int q = 0; q < 2; ++q) { a[0][q] = *(const f32x4*)(RWA + 1 * RWA_STRIDE + o_ + 4 * q); a[1][q] = *(const f32x4*)(RWA + 4 * RWA_STRIDE + o_ + 4 * q); a[2][q] = *(const f32x4*)(RWA + 5 * RWA_STRIDE + o_ + 4 * q); } \
        RW_LD_RKV(0, 2); RW_LD_RKV(1, 0); RW_LD_RKV(2, 3); } while (0)
#define RW_UNPK(x_, q_) ((q_) == 0 ? (f32x4){bf_lo((x_).x), bf_hi((x_).x), bf_lo((x_).y), bf_hi((x_).y)} : (f32x4){bf_lo((x_).z), bf_hi((x_).z), bf_lo((x_).w), bf_hi((x_).w)})
    RW_GLOAD(0);
    for (int sub = 0; sub < TCH / 32; ++sub) {
        __syncthreads();
        { const int lo = st * 64 + sd;
#pragma unroll
          for (int q = 0; q < 2; ++q) { *(LAS f32x4*)(sw + lo + 4 * q) = a[0][q]; *(LAS f32x4*)(sn + lo + 4 * q) = a[1][q]; *(LAS f32x4*)(sb + lo + 4 * q) = a[2][q]; *(LAS f32x4*)(sk + lo + 4 * q) = RW_GET_RKV(0, q); *(LAS f32x4*)(sr + lo + 4 * q) = RW_GET_RKV(1, q); *(LAS f32x4*)(sv + lo + 4 * q) = RW_GET_RKV(2, q); } }
        __syncthreads();
        if (sub + 1 < TCH / 32) RW_GLOAD(sub + 1);
        { f32x4 opA[10], opB[10]; float vin[2], vA[2], vB[2];
          RW_LOAD(opA, 0);
          vA[0] = vin[0]; vA[1] = vin[1];
#pragma unroll 1
          for (int s = 0; s < 32; s += 2) {
              RW_LOAD(opB, s + 1);
              vB[0] = vin[0]; vB[1] = vin[1];
              RW_STEP(opA, vA, s);
              if (s + 2 < 32) { RW_LOAD(opA, s + 2); vA[0] = vin[0]; vA[1] = vin[1]; }
              RW_STEP(opB, vB, s + 1);
          } }
        __syncthreads();
        { const int fs = lt >> 3, c16 = (lt & 7) * 16;
          bf16* dst = (c16 < 64) ? (bf16*)((float*)(A.ws + WS_YO) + YO_STRIDE) : ((bf16*)(A.ws + WS_PT) - 64);
          bf16* dp = dst + (tok0 + sub * 32 + fs) * 256 + h * 64 + c16;
#pragma unroll
          for (int q = 0; q < 2; ++q) { const f32x4 x0 = *(const LAS f32x4*)(so + fs * 128 + c16 + 8 * q), x1 = *(const LAS f32x4*)(so + fs * 128 + c16 + 8 * q + 4);
              v4u wv; wv.x = pk2(x0.x, x0.y); wv.y = pk2(x0.z, x0.w); wv.z = pk2(x1.x, x1.y); wv.w = pk2(x1.z, x1.w); *(v4u*)(dp + 8 * q) = wv; } }
    }
    { float* ch = (float*)(A.ws + WS_CH) + ((size_t)(bh * NCH + c) * 128) * 64 + 8 * kq;
#pragma unroll
      for (int i = 0; i < 4; ++i) { float* cr = ch + (size_t)RW_ROW(i) * 64; *(f32x4*)cr = (f32x4){S[i][0].x, S[i][0].y, S[i][1].x, S[i][1].y}; *(f32x4*)(cr + 4) = (f32x4){S[i][2].x, S[i][2].y, S[i][3].x, S[i][3].y}; } }
    __syncthreads();
}
#undef RW_LOAD
#undef RW_STEP
#undef RW_GLOAD
#undef RW_UNPK
#undef RW_LD_RKV
#undef RW_GET_RKV
#undef RW_DOT
#undef RW_ROW
__device__ __forceinline__ void scan_ret_task(ARef A, const WI& w, int task) {
    const int bh = task >> 3, cp = task & 7, b = bh >> 2, h = bh & 3, un = w.tid >> 8, lt = w.tid & 255, c = 2 * cp + un;
    const float lg2g = log2f(1.0f - exp2f(-5.0f - (float)h)), gamma = exp2f(lg2g);
    LAS float* sk = (LAS float*)w.lds + un * 8192; LAS float* sq = sk + 2048; LAS float* sv = sq + 2048; LAS float* so = sv + 2048;
    const bf16* PB = (const bf16*)(A.ws + WS_PB); const float* RT = (const float*)(A.ws + WS_ROPE);
    const int row = lt >> 2, kq = lt & 3;
    f32x2 S[8];
#pragma unroll
    for (int j = 0; j < 8; ++j) S[j] = (f32x2){0.0f, 0.0f};
    const f32x2 gam2 = {gamma, gamma};
    const size_t tok0 = (size_t)b * SEQ + (size_t)c * TCH;
    const int st = lt >> 3, sd = (lt & 7) * 8;
    const int fi = sd & 31, dp = sd ^ 32;
    f32x4 gq[2], gqo[2], gk[2], gko[2], gv[2], gcs[2], gsn[2];
#define BF8_TO_F32(dst, x_) do { dst[0] = (f32x4){bf_lo(x_.x), bf_hi(x_.x), bf_lo(x_.y), bf_hi(x_.y)}; dst[1] = (f32x4){bf_lo(x_.z), bf_hi(x_.z), bf_lo(x_.w), bf_hi(x_.w)}; } while (0)
#define RT_GLOAD(sub_) do { const size_t m_ = tok0 + (sub_) * 32 + st; const bf16* pr_ = PB + m_ * PBW + h * 64; const float* rt_ = RT + m_ * ROPE_W; \
        _Pragma("unroll") for (int u = 0; u < 2; ++u) { gcs[u] = *(const f32x4*)(rt_ + fi + 4 * u); gsn[u] = *(const f32x4*)(rt_ + 32 + fi + 4 * u); } \
        { const v4u x0 = *(const v4u*)(pr_ + sd), x1 = *(const v4u*)(pr_ + dp), x2 = *(const v4u*)(pr_ + 256 + sd), x3 = *(const v4u*)(pr_ + 256 + dp), x4 = *(const v4u*)(pr_ + 512 + sd); \
          BF8_TO_F32(gq, x0); BF8_TO_F32(gqo, x1); BF8_TO_F32(gk, x2); BF8_TO_F32(gko, x3); BF8_TO_F32(gv, x4); } } while (0)
    RT_GLOAD(0);
    for (int sub = 0; sub < TCH / 32; ++sub) {
        const size_t m = tok0 + sub * 32 + st;
        f32x4 qn[2], kn[2], vn[2];
#pragma unroll
        for (int u = 0; u < 2; ++u) { qn[u] = (sd < 32) ? gq[u] * gcs[u] - gqo[u] * gsn[u] : gqo[u] * gsn[u] + gq[u] * gcs[u]; kn[u] = (sd < 32) ? gk[u] * gcs[u] - gko[u] * gsn[u] : gko[u] * gsn[u] + gk[u] * gcs[u]; vn[u] = gv[u]; }
        { const float gt = exp2f(lg2g * (float)(sub * 32 + st + 1)); const f32x4 p0 = qn[0] * gt, p1 = qn[1] * gt;
          v4u pw; pw.x = pk2(p0.x, p0.y); pw.y = pk2(p0.z, p0.w); pw.z = pk2(p1.x, p1.y); pw.w = pk2(p1.z, p1.w); *(v4u*)((bf16*)(A.ws + WS_PTR) + m * 256 + h * 64 + sd) = pw; }
        __syncthreads();
        { const int lo = st * 64 + sd; *(LAS f32x4*)(sq + lo) = qn[0]; *(LAS f32x4*)(sq + lo + 4) = qn[1]; *(LAS f32x4*)(sk + lo) = kn[0]; *(LAS f32x4*)(sk + lo + 4) = kn[1]; *(LAS f32x4*)(sv + lo) = vn[0]; *(LAS f32x4*)(sv + lo + 4) = vn[1]; }
        __syncthreads();
        if (sub + 1 < TCH / 32) RT_GLOAD(sub + 1);
#define RT_LOAD(kvA, rvA, vA, s_) do { const int lo_ = (s_) * 64 + kq * 16; _Pragma("unroll") for (int j4 = 0; j4 < 4; ++j4) { kvA[j4] = *(const LAS f32x4*)(sk + lo_ + 4 * j4); rvA[j4] = *(const LAS f32x4*)(sq + lo_ + 4 * j4); } vA = sv[(s_) * 64 + row]; } while (0)
#define RT_STEP(kvA, rvA, vA, s_) do { const f32x2 v2 = {vA, vA}; f32x2 y2 = {0.0f, 0.0f}; \
            _Pragma("unroll") for (int j4 = 0; j4 < 4; ++j4) { S[2 * j4] = S[2 * j4] * gam2 + v2 * LO2(kvA[j4]); S[2 * j4 + 1] = S[2 * j4 + 1] * gam2 + v2 * HI2(kvA[j4]); \
                y2 = S[2 * j4] * LO2(rvA[j4]) + y2; y2 = S[2 * j4 + 1] * HI2(rvA[j4]) + y2; } \
            const float y = quad_sum(y2.x + y2.y); if (kq == 0) so[(s_) * 64 + row] = y; } while (0)
        { f32x4 kA[4], rA[4], kB[4], rB[4]; float vA, vB;
          RT_LOAD(kA, rA, vA, 0);
#pragma unroll 1
          for (int s = 0; s < 32; s += 2) {
              RT_LOAD(kB, rB, vB, s + 1);
              RT_STEP(kA, rA, vA, s);
              if (s + 2 < 32) RT_LOAD(kA, rA, vA, s + 2);
              RT_STEP(kB, rB, vB, s + 1);
          } }
#undef RT_LOAD
#undef RT_STEP
        __syncthreads();
        { const int fs = lt >> 3, c8 = (lt & 7) * 8; bf16* dp2 = (bf16*)(A.ws + WS_YO) + (tok0 + sub * 32 + fs) * 256 + h * 64 + c8;
          const f32x4 x0 = *(const LAS f32x4*)(so + fs * 64 + c8), x1 = *(const LAS f32x4*)(so + fs * 64 + c8 + 4);
          v4u wv; wv.x = pk2(x0.x, x0.y); wv.y = pk2(x0.z, x0.w); wv.z = pk2(x1.x, x1.y); wv.w = pk2(x1.z, x1.w); *(v4u*)dp2 = wv; }
    }
    { float* ch = (float*)(A.ws + WS_CHR) + ((size_t)(bh * NCH + c) * 64 + row) * 64 + 16 * kq;
#pragma unroll
      for (int j4 = 0; j4 < 4; ++j4) *(f32x4*)(ch + 4 * j4) = (f32x4){S[2 * j4].x, S[2 * j4].y, S[2 * j4 + 1].x, S[2 * j4 + 1].y}; }
    __syncthreads();
}
#undef RT_GLOAD
#undef BF8_TO_F32
__device__ __forceinline__ void prefix_chain(ARef A, const WI& w, int bh) {
    LAS float* s0 = (LAS float*)w.lds;
    const int v = w.tid >> 3, k8 = (w.tid & 7) * 8;
    const float* CH = (const float*)(A.ws + WS_CH) + (size_t)bh * NCH * 128 * 64; float* SI = (float*)(A.ws + WS_SI) + (size_t)bh * NCH * 64 * 64;
    f32x4 c0 = {0.f, 0.f, 0.f, 0.f}, c1 = {0.f, 0.f, 0.f, 0.f};
    for (int c = 0; c < NCH; ++c) {
        *(f32x4*)(SI + ((size_t)c * 64 + v) * 64 + k8) = c0; *(f32x4*)(SI + ((size_t)c * 64 + v) * 64 + k8 + 4) = c1;
        if (c == NCH - 1) break;
        __syncthreads();
        *(LAS f32x4*)(s0 + v * 68 + k8) = c0; *(LAS f32x4*)(s0 + v * 68 + k8 + 4) = c1;
        __syncthreads();
        const float* ch = CH + (size_t)c * 128 * 64;
        f32x4 n0 = *(const f32x4*)(ch + (size_t)v * 64 + k8), n1 = *(const f32x4*)(ch + (size_t)v * 64 + k8 + 4);
#pragma unroll 8
        for (int kp = 0; kp < 64; ++kp) { const float s = s0[v * 68 + kp]; const float* pr = ch + (size_t)(64 + kp) * 64 + k8; n0 += s * *(const f32x4*)pr; n1 += s * *(const f32x4*)(pr + 4); }
        c0 = n0; c1 = n1;
    }
    const int h = bh & 3; const float gT = exp2f((float)TCH * log2f(1.0f - exp2f(-5.0f - (float)h)));
    const float* CHR = (const float*)(A.ws + WS_CHR) + (size_t)bh * NCH * 64 * 64; float* SIR = (float*)(A.ws + WS_SIR) + (size_t)bh * NCH * 64 * 64;
    c0 = (f32x4){0.f, 0.f, 0.f, 0.f}; c1 = c0;
    for (int c = 0; c < NCH; ++c) {
        *(f32x4*)(SIR + ((size_t)c * 64 + v) * 64 + k8) = c0; *(f32x4*)(SIR + ((size_t)c * 64 + v) * 64 + k8 + 4) = c1;
        if (c == NCH - 1) break;
        c0 = c0 * gT + *(const f32x4*)(CHR + ((size_t)c * 64 + v) * 64 + k8); c1 = c1 * gT + *(const f32x4*)(CHR + ((size_t)c * 64 + v) * 64 + k8 + 4);
    }
    __syncthreads();
}
typedef float f32x16 __attribute__((ext_vector_type(16)));
constexpr int SBV_PITCH = 144;
__device__ __forceinline__ float lane32_swap(float v) { return __shfl_xor(v, 32); }
__device__ __forceinline__ void sb_tile_mfma(ARef A, int unit, int lane_in, LAS unsigned char* vl) {
    int lane = lane_in; asm volatile("" : "+v"(lane));
    const int tq = unit & 127, bh = unit >> 7, b = bh >> 2, h = bh & 3, t0 = tq * 32, r32 = lane & 31, hi = lane >> 5;
    const bf16* PS = (const bf16*)(A.ws + WS_PB) + (size_t)b * SEQ * PBW + PB_SB + h * 64;
    bf16x8v qf[4];
#pragma unroll
    for (int ks = 0; ks < 4; ++ks) qf[ks] = *(const bf16x8v*)(PS + (size_t)(t0 + r32) * PBW + 16 * ks + 8 * hi);
    f32x16 o0, o1;
#pragma unroll
    for (int r = 0; r < 16; ++r) { o0[r] = 0.0f; o1[r] = 0.0f; }
    float carry = 0.0f;
    const int g16 = lane >> 4, tj = (lane & 15) >> 2, tc = lane & 3;
    v4u vn[4]; bf16x8v kn[4];
#define SB_FETCH(kb_) do { _Pragma("unroll") for (int i = 0; i < 4; ++i) { const int p = lane + 64 * i, row = p >> 3, ch = p & 7; vn[i] = *(const v4u*)(PS + 512 + (size_t)((kb_) + row) * PBW + 8 * ch); } \
        _Pragma("unroll") for (int ks = 0; ks < 4; ++ks) kn[ks] = *(const bf16x8v*)(PS + 256 + (size_t)((kb_) + r32) * PBW + 16 * ks + 8 * hi); } while (0)
    SB_FETCH(t0);
    for (int kb0 = t0; kb0 >= 0; kb0 -= 32) {
#pragma unroll
        for (int i = 0; i < 4; ++i) { const int p = lane + 64 * i, row = p >> 3, ch = p & 7; *(LAS v4u*)(vl + row * SBV_PITCH + 16 * ch) = vn[i]; }
        f32x16 st;
#pragma unroll
        for (int r = 0; r < 16; ++r) st[r] = 0.0f;
        { bf16x8v ka[4];
#pragma unroll
          for (int ks = 0; ks < 4; ++ks) ka[ks] = kn[ks];
          if (kb0 >= 32) SB_FETCH(kb0 - 32);
#pragma unroll
          for (int ks = 0; ks < 4; ++ks) st = __builtin_amdgcn_mfma_f32_32x32x16_bf16(ka[ks], qf[ks], st, 0, 0, 0);
          asm volatile("" :: "v"(ka[0]), "v"(ka[1]), "v"(ka[2]), "v"(ka[3]), "v"(st)); }
        float sp[16]; const bool diag = (kb0 == t0);
#pragma unroll
        for (int r = 0; r < 16; ++r) { const float zl = st[r]; float s = (zl > 30.0f) ? zl : __builtin_amdgcn_logf(1.0f + __builtin_amdgcn_exp2f(zl));
            if (diag && ((r & 3) + 8 * (r >> 2) + 4 * hi >= r32)) s = 0.0f;
            sp[r] = s; }
        float G[4], Gp[4], suf[4];
#pragma unroll
        for (int q = 0; q < 4; ++q) { G[q] = (sp[4 * q] + sp[4 * q + 1]) + (sp[4 * q + 2] + sp[4 * q + 3]); Gp[q] = lane32_swap(G[q]); }
        suf[3] = 0.0f; suf[2] = G[3] + Gp[3]; suf[1] = suf[2] + (G[2] + Gp[2]); suf[0] = suf[1] + (G[1] + Gp[1]);
        const float tot = suf[0] + (G[0] + Gp[0]);
        pg8::u32x4 pw0, pw1;
        float av[16];
#pragma unroll
        for (int q = 0; q < 4; ++q) { float run = carry + suf[q] + (hi == 0 ? Gp[q] : 0.0f);
#pragma unroll
            for (int i = 3; i >= 0; --i) { const int r = 4 * q + i; const float la = (st[r] - sp[r]) - run; float a = __builtin_amdgcn_exp2f(la);
                if (diag && ((r & 3) + 8 * (r >> 2) + 4 * hi >= r32)) a = 0.0f;
                av[r] = a; run += sp[r]; } }
        pw0.x = pg8::cvt_pk_bf16(av[0], av[1]); pw0.y = pg8::cvt_pk_bf16(av[2], av[3]); pw0.z = pg8::cvt_pk_bf16(av[4], av[5]); pw0.w = pg8::cvt_pk_bf16(av[6], av[7]);
        pw1.x = pg8::cvt_pk_bf16(av[8], av[9]); pw1.y = pg8::cvt_pk_bf16(av[10], av[11]); pw1.z = pg8::cvt_pk_bf16(av[12], av[13]); pw1.w = pg8::cvt_pk_bf16(av[14], av[15]);
        const bf16x8v pa0 = __builtin_bit_cast(bf16x8v, pw0), pa1 = __builtin_bit_cast(bf16x8v, pw1);
        LDS_WAIT();
#pragma unroll
        for (int s = 0; s < 2; ++s)
#pragma unroll
            for (int nb = 0; nb < 2; ++nb) {
                LAS unsigned char* a1 = vl + (16 * s + 4 * (g16 >> 1) + tj) * SBV_PITCH + (32 * nb + 16 * (g16 & 1) + 4 * tc) * 2;
                const s16x4v r1 = __builtin_bit_cast(s16x4v, __builtin_amdgcn_ds_read_tr16_b64_v4i16((LAS s16x4v*)a1));
                const s16x4v r2 = __builtin_bit_cast(s16x4v, __builtin_amdgcn_ds_read_tr16_b64_v4i16((LAS s16x4v*)(a1 + 8 * SBV_PITCH)));
                const bf16x8v bv = {r1[0], r1[1], r1[2], r1[3], r2[0], r2[1], r2[2], r2[3]};
                if (nb == 0) o0 = __builtin_amdgcn_mfma_f32_32x32x16_bf16(s ? pa1 : pa0, bv, o0, 0, 0, 0); else o1 = __builtin_amdgcn_mfma_f32_32x32x16_bf16(s ? pa1 : pa0, bv, o1, 0, 0, 0);
                asm volatile("" :: "v"(bv), "v"(pa0), "v"(pa1), "v"(o0), "v"(o1)); }
        LDS_WAIT();
        carry += tot;
        if (__all(carry > 150.0f)) break;
    }
#undef SB_FETCH
    bf16* YS = (bf16*)((float*)(A.ws + WS_YO) + 3 * YO_STRIDE) + ((size_t)b * SEQ + t0) * 256 + h * 64 + r32;
#pragma unroll
    for (int r = 0; r < 16; ++r) { const int qo = (r & 3) + 8 * (r >> 2) + 4 * hi; YS[(size_t)qo * 256] = (bf16)f2bf(o0[r]); YS[(size_t)qo * 256 + 32] = (bf16)f2bf(o1[r]); }
}

__device__ __forceinline__ void rope_frag4(bf16x8v (&f)[4], const f32x4 (&cs)[2][2], const f32x4 (&sn)[2][2]) {
#pragma unroll
    for (int ks = 0; ks < 2; ++ks) { const v4u a = __builtin_bit_cast(v4u, f[ks]), b = __builtin_bit_cast(v4u, f[ks + 2]);
        const f32x4 a0 = {bf_lo(a.x), bf_hi(a.x), bf_lo(a.y), bf_hi(a.y)}, a1 = {bf_lo(a.z), bf_hi(a.z), bf_lo(a.w), bf_hi(a.w)}, b0 = {bf_lo(b.x), bf_hi(b.x), bf_lo(b.y), bf_hi(b.y)}, b1 = {bf_lo(b.z), bf_hi(b.z), bf_lo(b.w), bf_hi(b.w)};
        const f32x4 x0 = a0 * cs[ks][0] - b0 * sn[ks][0], x1 = a1 * cs[ks][1] - b1 * sn[ks][1], y0 = b0 * cs[ks][0] + a0 * sn[ks][0], y1 = b1 * cs[ks][1] + a1 * sn[ks][1];
        v4u xo, yo; xo.x = pk2(x0.x, x0.y); xo.y = pk2(x0.z, x0.w); xo.z = pk2(x1.x, x1.y); xo.w = pk2(x1.z, x1.w); yo.x = pk2(y0.x, y0.y); yo.y = pk2(y0.z, y0.w); yo.z = pk2(y1.x, y1.y); yo.w = pk2(y1.z, y1.w);
        f[ks] = __builtin_bit_cast(bf16x8v, xo); f[ks + 2] = __builtin_bit_cast(bf16x8v, yo); }
}
#define RT_CS_LOAD(cs_, sn_, rt_) do { _Pragma("unroll") for (int ks = 0; ks < 2; ++ks) { const float* q_ = (rt_) + 16 * ks + 8 * hi; cs_[ks][0] = *(const f32x4*)q_; cs_[ks][1] = *(const f32x4*)(q_ + 4); sn_[ks][0] = *(const f32x4*)(q_ + 32); sn_[ks][1] = *(const f32x4*)(q_ + 36); } } while (0)
__device__ __forceinline__ void ret_tile_mfma(ARef A, int unit, int lane_in, LAS unsigned char* vl) {
    int lane = lane_in; asm volatile("" : "+v"(lane));
    const int tq = unit & 127, bh = unit >> 7, b = bh >> 2, h = bh & 3, t0 = tq * 32, r32 = lane & 31, hi = lane >> 5, cs0 = t0 & ~(TCH - 1);
    const bf16* PS = (const bf16*)(A.ws + WS_PB) + (size_t)b * SEQ * PBW + h * 64;
    const float* RT = (const float*)(A.ws + WS_ROPE) + (size_t)b * SEQ * ROPE_W;
    const float lg2g = log2f(1.0f - exp2f(-5.0f - (float)h));
    bf16x8v qf[4];
    { f32x4 qc[2][2], qs[2][2]; RT_CS_LOAD(qc, qs, RT + (size_t)(t0 + r32) * ROPE_W);
#pragma unroll
      for (int ks = 0; ks < 4; ++ks) qf[ks] = *(const bf16x8v*)(PS + (size_t)(t0 + r32) * PBW + 16 * ks + 8 * hi);
      rope_frag4(qf, qc, qs); }
    { const float gt = exp2f(lg2g * (float)(t0 + r32 - cs0 + 1)); bf16* pt = (bf16*)(A.ws + WS_PTR) + ((size_t)b * SEQ + t0 + r32) * 256 + h * 64 + 8 * hi;
#pragma unroll
      for (int ks = 0; ks < 4; ++ks) { const v4u x = __builtin_bit_cast(v4u, qf[ks]); v4u o_; o_.x = pk2(bf_lo(x.x) * gt, bf_hi(x.x) * gt); o_.y = pk2(bf_lo(x.y) * gt, bf_hi(x.y) * gt); o_.z = pk2(bf_lo(x.z) * gt, bf_hi(x.z) * gt); o_.w = pk2(bf_lo(x.w) * gt, bf_hi(x.w) * gt);
          *(v4u*)(pt + 16 * ks) = o_; } }
    const float dq = exp2f(lg2g * (float)(r32 - 4 * hi));
    float e3[4], e8[4];
#pragma unroll
    for (int i = 0; i < 4; ++i) { e3[i] = exp2f(-lg2g * (float)i); e8[i] = exp2f(-lg2g * (float)(8 * i)); }
    f32x16 o0, o1;
#pragma unroll
    for (int r = 0; r < 16; ++r) { o0[r] = 0.0f; o1[r] = 0.0f; }
    const int g16 = lane >> 4, tj = (lane & 15) >> 2, tc = lane & 3;
    v4u vn[4]; bf16x8v kn[4];
#define RET_FETCH(kb_) do { _Pragma("unroll") for (int i = 0; i < 4; ++i) { const int p = lane + 64 * i, row = p >> 3, ch = p & 7; vn[i] = *(const v4u*)(PS + 512 + (size_t)((kb_) + row) * PBW + 8 * ch); } \
        _Pragma("unroll") for (int ks = 0; ks < 4; ++ks) kn[ks] = *(const bf16x8v*)(PS + 256 + (size_t)((kb_) + r32) * PBW + 16 * ks + 8 * hi); } while (0)
    RET_FETCH(t0);
#pragma unroll 1
    for (int kb0 = t0; kb0 >= cs0; kb0 -= 32) {
#pragma unroll
        for (int i = 0; i < 4; ++i) { const int p = lane + 64 * i, row = p >> 3, ch = p & 7; *(LAS v4u*)(vl + row * SBV_PITCH + 16 * ch) = vn[i]; }
        f32x16 st;
#pragma unroll
        for (int r = 0; r < 16; ++r) st[r] = 0.0f;
        { bf16x8v ka[4];
#pragma unroll
          for (int ks = 0; ks < 4; ++ks) ka[ks] = kn[ks];
          { f32x4 kc[2][2], ksn[2][2]; RT_CS_LOAD(kc, ksn, RT + (size_t)(kb0 + r32) * ROPE_W); rope_frag4(ka, kc, ksn); }
          if (kb0 - 32 >= cs0) RET_FETCH(kb0 - 32);
#pragma unroll
          for (int ks = 0; ks < 4; ++ks) st = __builtin_amdgcn_mfma_f32_32x32x16_bf16(ka[ks], qf[ks], st, 0, 0, 0);
          asm volatile("" :: "v"(ka[0]), "v"(ka[1]), "v"(ka[2]), "v"(ka[3]), "v"(st)); }
        const float gs = exp2f(lg2g * (float)(t0 - kb0)); const bool diag = (kb0 == t0);
        float av[16];
#pragma unroll
        for (int r = 0; r < 16; ++r) { float a = st[r] * ((gs * dq) * (e3[r & 3] * e8[r >> 2])); if (diag && ((r & 3) + 8 * (r >> 2) + 4 * hi > r32)) a = 0.0f; av[r] = a; }
        pg8::u32x4 pw0, pw1;
        pw0.x = pk2(av[0], av[1]); pw0.y = pk2(av[2], av[3]); pw0.z = pk2(av[4], av[5]); pw0.w = pk2(av[6], av[7]);
        pw1.x = pk2(av[8], av[9]); pw1.y = pk2(av[10], av[11]); pw1.z = pk2(av[12], av[13]); pw1.w = pk2(av[14], av[15]);
        const bf16x8v pa0 = __builtin_bit_cast(bf16x8v, pw0), pa1 = __builtin_bit_cast(bf16x8v, pw1);
        LDS_WAIT();
#pragma unroll
        for (int s = 0; s < 2; ++s)
#pragma unroll
            for (int nb = 0; nb < 2; ++nb) {
                LAS unsigned char* a1 = vl + (16 * s + 4 * (g16 >> 1) + tj) * SBV_PITCH + (32 * nb + 16 * (g16 & 1) + 4 * tc) * 2;
                const s16x4v r1 = __builtin_bit_cast(s16x4v, __builtin_amdgcn_ds_read_tr16_b64_v4i16((LAS s16x4v*)a1));
                const s16x4v r2 = __builtin_bit_cast(s16x4v, __builtin_amdgcn_ds_read_tr16_b64_v4i16((LAS s16x4v*)(a1 + 8 * SBV_PITCH)));
                const bf16x8v bv = {r1[0], r1[1], r1[2], r1[3], r2[0], r2[1], r2[2], r2[3]};
                if (nb == 0) o0 = __builtin_amdgcn_mfma_f32_32x32x16_bf16(s ? pa1 : pa0, bv, o0, 0, 0, 0); else o1 = __builtin_amdgcn_mfma_f32_32x32x16_bf16(s ? pa1 : pa0, bv, o1, 0, 0, 0);
                asm volatile("" :: "v"(bv), "v"(pa0), "v"(pa1), "v"(o0), "v"(o1)); }
        LDS_WAIT();
    }
#undef RET_FETCH
    bf16* YS = (bf16*)(A.ws + WS_YO) + ((size_t)b * SEQ + t0) * 256 + h * 64 + r32;
#pragma unroll
    for (int r = 0; r < 16; ++r) { const int qo = (r & 3) + 8 * (r >> 2) + 4 * hi; YS[(size_t)qo * 256] = (bf16)f2bf(o0[r]); YS[(size_t)qo * 256 + 32] = (bf16)f2bf(o1[r]); }
}
__device__ __forceinline__ void ret_state_mfma(ARef A, int unit, int lane_in, LAS unsigned char* vl) {
    int lane = lane_in; asm volatile("" : "+v"(lane));
    const int bh = unit >> 4, c = unit & 15, b = bh >> 2, h = bh & 3, r32 = lane & 31, hi = lane >> 5;
    const size_t tok0 = (size_t)b * SEQ + (size_t)c * TCH;
    const bf16* PS = (const bf16*)(A.ws + WS_PB) + tok0 * PBW + h * 64; const float* RT = (const float*)(A.ws + WS_ROPE) + tok0 * ROPE_W;
    const float lg2g = log2f(1.0f - exp2f(-5.0f - (float)h)), g32 = exp2f(32.0f * lg2g);
    LAS unsigned char* kl = vl + 32 * SBV_PITCH;
    const int g16 = lane >> 4, tj = (lane & 15) >> 2, tc = lane & 3;
    f32x16 acc[2][2];
#pragma unroll
    for (int a = 0; a < 2; ++a)
#pragma unroll
        for (int b2 = 0; b2 < 2; ++b2)
#pragma unroll
            for (int r = 0; r < 16; ++r) acc[a][b2][r] = 0.0f;
#pragma unroll 1
    for (int j = 0; j < TCH / 32; ++j) {
#pragma unroll
        for (int i = 0; i < 4; ++i) { const int p = lane + 64 * i, row = p >> 3, ch = p & 7, fi = (8 * ch) & 31; const bf16* pr = PS + (size_t)(32 * j + row) * PBW; const float* rt = RT + (size_t)(32 * j + row) * ROPE_W;
            const v4u vv = *(const v4u*)(pr + 512 + 8 * ch), x = *(const v4u*)(pr + 256 + 8 * ch), xo = *(const v4u*)(pr + 256 + 8 * (ch ^ 4));
            const f32x4 c0 = *(const f32x4*)(rt + fi), c1 = *(const f32x4*)(rt + fi + 4), s0 = *(const f32x4*)(rt + 32 + fi), s1 = *(const f32x4*)(rt + 36 + fi);
            const f32x4 a0 = {bf_lo(x.x), bf_hi(x.x), bf_lo(x.y), bf_hi(x.y)}, a1 = {bf_lo(x.z), bf_hi(x.z), bf_lo(x.w), bf_hi(x.w)}, b0 = {bf_lo(xo.x), bf_hi(xo.x), bf_lo(xo.y), bf_hi(xo.y)}, b1 = {bf_lo(xo.z), bf_hi(xo.z), bf_lo(xo.w), bf_hi(xo.w)};
            const float dk = exp2f(lg2g * (float)(31 - row));
            const f32x4 k0 = ((ch < 4) ? a0 * c0 - b0 * s0 : b0 * s0 + a0 * c0) * dk, k1 = ((ch < 4) ? a1 * c1 - b1 * s1 : b1 * s1 + a1 * c1) * dk;
            v4u kw; kw.x = pk2(k0.x, k0.y); kw.y = pk2(k0.z, k0.w); kw.z = pk2(k1.x, k1.y); kw.w = pk2(k1.z, k1.w);
            *(LAS v4u*)(vl + row * SBV_PITCH + 16 * ch) = vv; *(LAS v4u*)(kl + row * SBV_PITCH + 16 * ch) = kw; }
        LDS_WAIT();
        if (j > 0) {
#pragma unroll
            for (int a = 0; a < 2; ++a)
#pragma unroll
                for (int b2 = 0; b2 < 2; ++b2)
#pragma unroll
                    for (int r = 0; r < 16; ++r) acc[a][b2][r] *= g32; }
#pragma unroll
        for (int s = 0; s < 2; ++s) {
            bf16x8v fv[2], fk[2];
#pragma unroll
            for (int nb = 0; nb < 2; ++nb) { const int off = (16 * s + 4 * (g16 >> 1) + tj) * SBV_PITCH + (32 * nb + 16 * (g16 & 1) + 4 * tc) * 2;
                const s16x4v v1 = __builtin_bit_cast(s16x4v, __builtin_amdgcn_ds_read_tr16_b64_v4i16((LAS s16x4v*)(vl + off))), v2 = __builtin_bit_cast(s16x4v, __builtin_amdgcn_ds_read_tr16_b64_v4i16((LAS s16x4v*)(vl + off + 8 * SBV_PITCH)));
                const s16x4v k1 = __builtin_bit_cast(s16x4v, __builtin_amdgcn_ds_read_tr16_b64_v4i16((LAS s16x4v*)(kl + off))), k2 = __builtin_bit_cast(s16x4v, __builtin_amdgcn_ds_read_tr16_b64_v4i16((LAS s16x4v*)(kl + off + 8 * SBV_PITCH)));
                fv[nb] = (bf16x8v){v1[0], v1[1], v1[2], v1[3], v2[0], v2[1], v2[2], v2[3]}; fk[nb] = (bf16x8v){k1[0], k1[1], k1[2], k1[3], k2[0], k2[1], k2[2], k2[3]}; }
#pragma unroll
            for (int a = 0; a < 2; ++a)
#pragma unroll
                for (int b2 = 0; b2 < 2; ++b2) acc[a][b2] = __builtin_amdgcn_mfma_f32_32x32x16_bf16(fv[a], fk[b2], acc[a][b2], 0, 0, 0);
            asm volatile("" :: "v"(fv[0]), "v"(fv[1]), "v"(fk[0]), "v"(fk[1]), "v"(acc[0][0]), "v"(acc[0][1]), "v"(acc[1][0]), "v"(acc[1][1])); }
        LDS_WAIT();
    }
    float* ch = (float*)(A.ws + WS_CHR) + (size_t)(bh * NCH + c) * 64 * 64;
#pragma unroll
    for (int a = 0; a < 2; ++a)
#pragma unroll
        for (int b2 = 0; b2 < 2; ++b2)
#pragma unroll
            for (int r = 0; r < 16; ++r) ch[(size_t)(32 * a + (r & 3) + 8 * (r >> 2) + 4 * hi) * 64 + 32 * b2 + r32] = acc[a][b2][r];
}
#undef RT_CS_LOAD
__device__ __forceinline__ void dsa_scores_mfma(ARef A, const WI& w) {
    const _Float16* QIH = (const _Float16*)(A.ws + WS_DQI); const _Float16* KIH = (const _Float16*)(A.ws + WS_DKI);
    const float* DW = (const float*)(A.ws + WS_DW); _Float16* SC = (_Float16*)(A.ws + WS_SC);
    const int col = w.lane & 15, q4 = w.lane >> 4;
    for (int u = w.gw; u < 2048; u += w.NGW) {
        const int pi = u >> 1, par = u & 1, b = pi >> 7, p = pi & 127;
#pragma unroll 1
        for (int side = 0; side < 2; ++side) {
            const int qb = side ? 255 - p : p; const size_t m0 = (size_t)b * SEQ + 16 * qb;
            f16x8 bq[8];
#pragma unroll
            for (int h = 0; h < 8; ++h) bq[h] = *(const f16x8*)(QIH + (m0 + col) * 256 + h * 32 + 8 * q4);
            const float* dw = DW + (m0 + col) * 8; const f32x4 wa = *(const f32x4*)dw, wb = *(const f32x4*)(dw + 4);
            _Float16* srow = SC + (m0 + col) * SEQ + 4 * q4;
            const _Float16* kbase = KIH + ((size_t)b * SEQ + col) * 32 + 8 * q4;
            for (int kq = par; 4 * kq <= qb; kq += 2) {
                f16x8 ak[4];
#pragma unroll
                for (int q = 0; q < 4; ++q) { const int kb = 4 * kq + q; ak[q] = *(const f16x8*)(kbase + (size_t)(kb <= qb ? kb : qb) * 16 * 32); }
#pragma unroll
                for (int q = 0; q < 4; ++q) { const int kb = 4 * kq + q;
                    if (kb <= qb) {
                        f32x4 acc = {0.f, 0.f, 0.f, 0.f};
#pragma unroll
                        for (int h = 0; h < 8; ++h) { const f32x4 c = __builtin_amdgcn_mfma_f32_16x16x32_f16(ak[q], bq[h], (f32x4){0.f, 0.f, 0.f, 0.f}, 0, 0, 0); const float wv = (h < 4) ? wa[h] : wb[h - 4];
                            acc.x += wv * fmaxf(c.x, 0.f); acc.y += wv * fmaxf(c.y, 0.f); acc.z += wv * fmaxf(c.z, 0.f); acc.w += wv * fmaxf(c.w, 0.f); }
                        h4v hs; hs.x = (_Float16)acc.x; hs.y = (_Float16)acc.y; hs.z = (_Float16)acc.z; hs.w = (_Float16)acc.w; *(h4v*)(srow + 16 * kb) = hs; } }
            }
        }
    }
}

__device__ __forceinline__ int wave_total_i(int v) {
    v += __builtin_amdgcn_mov_dpp(v, 0xB1, 0xF, 0xF, true);
    v += __builtin_amdgcn_mov_dpp(v, 0x4E, 0xF, 0xF, true);
    v += __builtin_amdgcn_mov_dpp(v, 0x141, 0xF, 0xF, true);
    v += __builtin_amdgcn_mov_dpp(v, 0x140, 0xF, 0xF, true);
    return __builtin_amdgcn_readlane(v, 0) + __builtin_amdgcn_readlane(v, 16) + __builtin_amdgcn_readlane(v, 32) + __builtin_amdgcn_readlane(v, 48);
}
__device__ __forceinline__ unsigned score_key(float f) { const unsigned bits = __float_as_uint(f); return (bits & 0x80000000u) ? ~bits : (bits | 0x80000000u); }
constexpr int VST_PITCH = 144;
typedef unsigned short u16;
__device__ __forceinline__ void dsa_load_scores(ARef A, int m, int lane, v4u (&sv)[8]) {
    const int n = (m & (SEQ - 1)) + 1; const _Float16* sc = (const _Float16*)(A.ws + WS_SC) + (size_t)m * SEQ + 8 * lane;
#pragma unroll
    for (int c = 0; c < 8; ++c) { if (512 * c < n) sv[c] = *(const v4u*)(sc + 512 * c); else sv[c] = (v4u){0u, 0u, 0u, 0u}; }
}
__device__ __forceinline__ unsigned score_key16(unsigned x) { return ((x & 0x80000000u) ? ~x : (x | 0x80000000u)) & 0xffff0000u; }
__device__ __forceinline__ void dsa_select(ARef A, int m, int n, int lane_in, LAS u16* slist, LAS unsigned* bk) {
    int lane = lane_in; asm volatile("" : "+v"(lane));
    (void)bk;
    if (n <= 256) {
#pragma unroll
        for (int c = 0; c < 4; ++c) { const int idx = lane + 64 * c; slist[idx] = (u16)((idx < n) ? idx : 0); }
        return;
    }
    v4u sv[8]; dsa_load_scores(A, m, lane, sv);
    unsigned u[64];
#pragma unroll
    for (int c = 0; c < 8; ++c)
#pragma unroll
        for (int i = 0; i < 8; ++i) { const unsigned wd = sv[c][i >> 1]; u[8 * c + i] = (512 * c + 8 * lane + i < n) ? score_key16((i & 1) ? wd : (wd << 16)) : 0u; }
    unsigned T = 0u;
    for (int bit = 31; bit >= 16; --bit) { const unsigned cand = T | (1u << bit); int cnt = 0;
#pragma unroll
        for (int c = 0; c < 8; ++c) { if (512 * c < n) {
#pragma unroll
            for (int j = 8 * c; j < 8 * c + 8; ++j) cnt += (u[j] >= cand) ? 1 : 0; } }
        if (wave_total_i(cnt) >= 256) T = cand; }
    unsigned long long gtb = 0ull, eqb = 0ull;
#pragma unroll
    for (int c = 0; c < 8; ++c) { if (512 * c < n) {
#pragma unroll
        for (int j = 8 * c; j < 8 * c + 8; ++j) { gtb |= (unsigned long long)((u[j] > T) ? 1u : 0u) << j; eqb |= (unsigned long long)((u[j] == T) ? 1u : 0u) << j; } } }
    const int tgt = wave_total_i(__popcll(gtb)), teq = wave_total_i(__popcll(eqb));
    unsigned long long selb = gtb | eqb;
    if (tgt + teq > 256) {
        const int take = 256 - tgt; int lo = 0;
        for (int bit = 11; bit >= 0; --bit) { const int cand = lo | (1 << bit); const int J8 = cand >> 9; int ni = (cand & 511) - 8 * lane; ni = ni < 0 ? 0 : (ni > 8 ? 8 : ni);
            const int jc = 8 * J8 + ni; const unsigned long long msk = (jc >= 64) ? ~0ull : ((1ull << jc) - 1ull);
            if (wave_total_i(__popcll(eqb & msk)) < take) lo = cand; }
        { const int cand = lo + 1; const int J8 = cand >> 9; int ni = (cand & 511) - 8 * lane; ni = ni < 0 ? 0 : (ni > 8 ? 8 : ni);
          const int jc = (cand >= SEQ) ? 64 : 8 * J8 + ni; const unsigned long long msk = (jc >= 64) ? ~0ull : ((1ull << jc) - 1ull); selb = gtb | (eqb & msk); }
    }
    const int mine = __popcll(selb); int off = mine;
#pragma unroll
    for (int d = 1; d < 64; d <<= 1) { const int y = __shfl_up(off, d); if (lane >= d) off += y; }
    off -= mine;
    while (selb) { const int j = __builtin_ctzll(selb); selb &= selb - 1ull; slist[off] = (u16)(512 * (j >> 3) + 8 * lane + (j & 7)); ++off; }
}
__device__ __forceinline__ void dsa_attend(ARef A, int m, int lane_in, const LAS u16* slist, LAS unsigned char* vbuf) {
    int lane = lane_in; asm volatile("" : "+v"(lane));
    const int b = m >> 12, t = m & (SEQ - 1), n = t + 1, nsel = n < 256 ? n : 256, col = lane & 15, q4 = lane >> 4;
    const bf16* DKB = (const bf16*)(A.ws + WS_DKB) + (size_t)b * SEQ * 64; const bf16* DVB = (const bf16*)(A.ws + WS_DVB) + (size_t)b * SEQ * 64;
    const int vrow = lane >> 3, vpc = lane & 7;
    bf16x8v bq0 = {0, 0, 0, 0, 0, 0, 0, 0}, bq1 = {0, 0, 0, 0, 0, 0, 0, 0};
    if (col < 4) { const bf16* qp = (const bf16*)(A.ws + WS_DQ) + (size_t)m * 256 + col * 64 + 8 * q4; bq0 = *(const bf16x8v*)qp; bq1 = *(const bf16x8v*)(qp + 32); }
    f32x4 lg[16];
#pragma unroll
    for (int hb = 0; hb < 1; ++hb) {
        bf16x8v a0[16], a1[16];
#pragma unroll
        for (int k = 0; k < 16; ++k) { const int s = slist[16 * k + col]; const bf16* kr = DKB + (size_t)s * 64 + 8 * q4; a0[k] = *(const bf16x8v*)kr; a1[k] = *(const bf16x8v*)(kr + 32); }
#pragma unroll
        for (int k = 0; k < 16; ++k) { const f32x4 c = __builtin_amdgcn_mfma_f32_16x16x32_bf16(a0[k], bq0, (f32x4){0.f, 0.f, 0.f, 0.f}, 0, 0, 0); lg[k] = __builtin_amdgcn_mfma_f32_16x16x32_bf16(a1[k], bq1, c, 0, 0, 0); }
        __builtin_amdgcn_sched_barrier(0);
    }
    if (nsel < 256) {
#pragma unroll
        for (int kb = 0; kb < 16; ++kb)
#pragma unroll
            for (int r = 0; r < 4; ++r) if (16 * kb + 4 * q4 + r >= nsel) lg[kb][r] = -INFINITY; }
    v4u vr[4][4];
#pragma unroll
    for (int c = 0; c < 4; ++c)
#pragma unroll
        for (int i = 0; i < 4; ++i) { const int s = slist[32 * c + vrow + 8 * i]; vr[c][i] = *(const v4u*)(DVB + (size_t)s * 64 + 8 * vpc); }
    float mx = -INFINITY;
#pragma unroll
    for (int kb = 0; kb < 16; ++kb) mx = fmaxf(fmaxf(mx, fmaxf(lg[kb].x, lg[kb].y)), fmaxf(lg[kb].z, lg[kb].w));
    mx = fmaxf(mx, __shfl_xor(mx, 16)); mx = fmaxf(mx, __shfl_xor(mx, 32));
    float sm = 0.f;
#pragma unroll
    for (int kb = 0; kb < 16; ++kb) { lg[kb].x = __builtin_amdgcn_exp2f(lg[kb].x - mx); lg[kb].y = __builtin_amdgcn_exp2f(lg[kb].y - mx); lg[kb].z = __builtin_amdgcn_exp2f(lg[kb].z - mx); lg[kb].w = __builtin_amdgcn_exp2f(lg[kb].w - mx); sm += (lg[kb].x + lg[kb].y) + (lg[kb].z + lg[kb].w); }
    sm += __shfl_xor(sm, 16); sm += __shfl_xor(sm, 32);
    const float inv = 1.0f / sm;
    bf16x8v pa[8];
#pragma unroll
    for (int i = 0; i < 8; ++i) { const f32x4 x = lg[2 * i] * inv, y = lg[2 * i + 1] * inv;
        pg8::u32x4 wv; wv.x = pg8::cvt_pk_bf16(x.x, x.y); wv.y = pg8::cvt_pk_bf16(x.z, x.w); wv.z = pg8::cvt_pk_bf16(y.x, y.y); wv.w = pg8::cvt_pk_bf16(y.z, y.w);
        pa[i] = __builtin_bit_cast(bf16x8v, wv); }
    f32x4 o[4];
#pragma unroll
    for (int nb = 0; nb < 4; ++nb) o[nb] = (f32x4){0.f, 0.f, 0.f, 0.f};
    const int tj = col >> 2, tc = col & 3;
#pragma unroll
    for (int c = 0; c < 8; ++c) {
        LAS unsigned char* vb = vbuf + (c & 1) * (32 * VST_PITCH);
#pragma unroll
        for (int i = 0; i < 4; ++i) *(LAS v4u*)(vb + (vrow + 8 * i) * VST_PITCH + 16 * vpc) = vr[c & 3][i];
        if (c < 4) {
#pragma unroll
            for (int i = 0; i < 4; ++i) { const int s = slist[32 * (c + 4) + vrow + 8 * i]; vr[c & 3][i] = *(const v4u*)(DVB + (size_t)s * 64 + 8 * vpc); } }
        LDS_WAIT();
#pragma unroll
        for (int nb = 0; nb < 4; ++nb) {
            LAS unsigned char* a1 = vb + (4 * q4 + tj) * VST_PITCH + (16 * nb + 4 * tc) * 2;
            const s16x4v r1 = __builtin_bit_cast(s16x4v, __builtin_amdgcn_ds_read_tr16_b64_v4i16((LAS s16x4v*)a1));
            const s16x4v r2 = __builtin_bit_cast(s16x4v, __builtin_amdgcn_ds_read_tr16_b64_v4i16((LAS s16x4v*)(a1 + 16 * VST_PITCH)));
            const bf16x8v bv = {r1[0], r1[1], r1[2], r1[3], r2[0], r2[1], r2[2], r2[3]};
            o[nb] = __builtin_amdgcn_mfma_f32_16x16x32_bf16(pa[c], bv, o[nb], 0, 0, 0); }
    }
    LDS_WAIT();
    if (lane < 16) { bf16* YD = (bf16*)((float*)(A.ws + WS_YO) + 2 * YO_STRIDE) + (size_t)m * 256;
#pragma unroll
        for (int nb = 0; nb < 4; ++nb) { YD[16 * nb + lane] = (bf16)f2bf(o[nb].x); YD[64 + 16 * nb + lane] = (bf16)f2bf(o[nb].y); YD[128 + 16 * nb + lane] = (bf16)f2bf(o[nb].z); YD[192 + 16 * nb + lane] = (bf16)f2bf(o[nb].w); } }
}
constexpr int DSA_GR = 1;
__device__ __forceinline__ int dsa_row_of(int batch, int gi, int r) { const int idx = DSA_GR * gi + r, h = idx >> 1; return batch * SEQ + ((idx & 1) ? (SEQ - 1 - h) : h); }
__device__ __forceinline__ void dsa_wave(ARef A, const WI& w, LAS unsigned char* wl, int qi, int l, int skip = 0) {
    LAS u16* lists = (LAS u16*)wl; LAS unsigned char* vbuf = wl + 4096; LAS unsigned* bk = (LAS unsigned*)vbuf;
#pragma unroll 1
    for (int kb = 0; kb < NB; ++kb) {
        const int batch = (w.bx + kb) & (NB - 1);
        unsigned* head = (unsigned*)(A.ws + WS_CTL) + CW_DSAQ + 128 * qi + 16 * batch;
        int graw = 0; if (w.lane == 0) graw = (int)atomicAdd(head, 1u);
        for (;;) {
            const int g = __builtin_amdgcn_readfirstlane(graw);
            if (g >= 11 * (SEQ / 8)) break;
            graw = 0; if (w.lane == 0) graw = (int)atomicAdd(head, 1u);
            const int per = g / 11, pos = g - 11 * per;
            if (pos >= 8) { if (!(skip & 4)) moe_convert_chunk(A, l, batch * 1536 + 3 * per + (pos - 8), w.lane, (LAS float*)vbuf); continue; }
            if (skip & 2) continue;
            const int gi = 8 * per + pos;
            { const int m = dsa_row_of(batch, gi, 0), n = (m & (SEQ - 1)) + 1; dsa_select(A, m, n, w.lane, lists, bk); }
            LDS_WAIT();
            if (!(skip & 1)) dsa_attend(A, dsa_row_of(batch, gi, 0), w.lane, lists, vbuf);
        }
    }
}

__device__ __forceinline__ f32x4 head_norm4(f32x4 y, float eps, f32x4 g) {
    const float mean = grp16_sum(sum4(y)) * (1.0f / 64.0f); const f32x4 yc = y - mean;
    const float var = grp16_sum(dot4(yc, yc)) * (1.0f / 64.0f); return yc * (1.0f / sqrtf(var + eps)) * g;
}
constexpr int S0_PITCH = 144;
template <int MIXER> __device__ __forceinline__ void post16_head(ARef A, int l, size_t m, int hh, int tk, int fq, const LAS unsigned char* s0) {
    const size_t o = m * 256 + hh * 64 + 8 * fq;
    bf16x8v pb[2];
    if (MIXER == 0) { const bf16* pp = (const bf16*)(A.ws + WS_PTR) + o; pb[0] = *(const bf16x8v*)pp; pb[1] = *(const bf16x8v*)(pp + 32); }
    else { const bf16* pp = (const bf16*)(A.ws + WS_PT) + o; pb[0] = *(const bf16x8v*)pp; pb[1] = *(const bf16x8v*)(pp + 32); }
    f32x4 y[4];
    const bf16* yl = (const bf16*)((const float*)(A.ws + WS_YO) + MIXER * YO_STRIDE) + o;
#pragma unroll
    for (int j = 0; j < 2; ++j) { const v4u x = *(const v4u*)(yl + 32 * j); y[2 * j] = (f32x4){bf_lo(x.x), bf_hi(x.x), bf_lo(x.y), bf_hi(x.y)}; y[2 * j + 1] = (f32x4){bf_lo(x.z), bf_hi(x.z), bf_lo(x.w), bf_hi(x.w)}; }
    const float* gw = ((MIXER == 0) ? A.in[I_RETGN] : A.in[I_LN]) + l * 256 + hh * 64 + 8 * fq;
    f32x4 gn[4], e0[4], e1[4];
#pragma unroll
    for (int mb = 0; mb < 4; ++mb) gn[mb] = *(const f32x4*)(gw + 32 * (mb >> 1) + 4 * (mb & 1));
    if (MIXER == 0) {
#pragma unroll
        for (int j = 0; j < 2; ++j) { const v4u gx = *(const v4u*)((const bf16*)(A.ws + WS_PB) + m * PBW + 768 + hh * 64 + 8 * fq + 32 * j);
            e0[2 * j] = (f32x4){bf_lo(gx.x), bf_hi(gx.x), bf_lo(gx.y), bf_hi(gx.y)}; e0[2 * j + 1] = (f32x4){bf_lo(gx.z), bf_hi(gx.z), bf_lo(gx.w), bf_hi(gx.w)}; }
    } else { const float* RWA = (const float*)(A.ws + WS_RWA);
#pragma unroll
        for (int j = 0; j < 2; ++j) { const v4u bx_ = *(const v4u*)((const bf16*)(RWA + 7 * RWA_STRIDE) + o + 32 * j), gx_ = *(const v4u*)((const bf16*)(RWA + 6 * RWA_STRIDE) + o + 32 * j);
            e0[2 * j] = (f32x4){bf_lo(bx_.x), bf_hi(bx_.x), bf_lo(bx_.y), bf_hi(bx_.y)}; e0[2 * j + 1] = (f32x4){bf_lo(bx_.z), bf_hi(bx_.z), bf_lo(bx_.w), bf_hi(bx_.w)};
            e1[2 * j] = (f32x4){bf_lo(gx_.x), bf_hi(gx_.x), bf_lo(gx_.y), bf_hi(gx_.y)}; e1[2 * j + 1] = (f32x4){bf_lo(gx_.z), bf_hi(gx_.z), bf_lo(gx_.w), bf_hi(gx_.w)}; } }
    const LAS unsigned char* ab = s0 + ((MIXER * 4 + hh) * 64 + 8 * (tk >> 2) + (tk & 3)) * S0_PITCH + 16 * fq;
#pragma unroll
    for (int mb = 0; mb < 4; ++mb)
#pragma unroll
        for (int ks = 0; ks < 2; ++ks) { const bf16x8v af = *(const LAS bf16x8v*)(ab + (32 * (mb >> 1) + 4 * (mb & 1)) * S0_PITCH + 64 * ks); y[mb] = __builtin_amdgcn_mfma_f32_16x16x32_bf16(af, pb[ks], y[mb], 0, 0, 0); }
    float s = (sum4(y[0]) + sum4(y[1])) + (sum4(y[2]) + sum4(y[3])); s += __shfl_xor(s, 16); s += __shfl_xor(s, 32);
    const float mean = s * (1.0f / 64.0f);
#pragma unroll
    for (int mb = 0; mb < 4; ++mb) y[mb] = y[mb] - mean;
    float q = (dot4(y[0], y[0]) + dot4(y[1], y[1])) + (dot4(y[2], y[2]) + dot4(y[3], y[3])); q += __shfl_xor(q, 16); q += __shfl_xor(q, 32);
    const float rs = 1.0f / sqrtf(q * (1.0f / 64.0f) + ((MIXER == 0) ? 1e-5f : 64e-5f));
    bf16* MX = (bf16*)(A.ws + WS_MIX) + m * DM + MIXER * 256 + hh * 64 + 8 * fq;
#pragma unroll
    for (int j = 0; j < 2; ++j) { f32x4 ya = y[2 * j] * rs * gn[2 * j], yb = y[2 * j + 1] * rs * gn[2 * j + 1];
        if (MIXER == 0) {
#pragma unroll
            for (int i = 0; i < 4; ++i) { ya[i] *= e0[2 * j][i] * sigm(e0[2 * j][i]); yb[i] *= e0[2 * j + 1][i] * sigm(e0[2 * j + 1][i]); }
        } else { ya = (ya + e0[2 * j]) * e1[2 * j]; yb = (yb + e0[2 * j + 1]) * e1[2 * j + 1]; }
        v4u wv; wv.x = pk2(ya.x, ya.y); wv.y = pk2(ya.z, ya.w); wv.z = pk2(yb.x, yb.y); wv.w = pk2(yb.z, yb.w); *(v4u*)(MX + 32 * j) = wv; }
}
__device__ __forceinline__ void post16_rms(ARef A, int l, size_t m, int mx, int fq) {
    const bf16* yp = (const bf16*)((const float*)(A.ws + WS_YO) + (size_t)mx * YO_STRIDE) + m * 256 + 8 * fq; const float* gw = ((mx == 2) ? A.in[I_DONORM] : A.in[I_SONORM]) + l * 256 + 8 * fq;
    f32x4 y[16];
#pragma unroll
    for (int j = 0; j < 8; ++j) { const v4u x = *(const v4u*)(yp + 32 * j); y[2 * j] = (f32x4){bf_lo(x.x), bf_hi(x.x), bf_lo(x.y), bf_hi(x.y)}; y[2 * j + 1] = (f32x4){bf_lo(x.z), bf_hi(x.z), bf_lo(x.w), bf_hi(x.w)}; }
    float q = 0.0f;
#pragma unroll
    for (int j = 0; j < 16; ++j) q += dot4(y[j], y[j]);
    q += __shfl_xor(q, 16); q += __shfl_xor(q, 32);
    const float r = 1.0f / sqrtf(q * (1.0f / 256.0f) + 1e-5f);
    bf16* MX = (bf16*)(A.ws + WS_MIX) + m * DM + mx * 256 + 8 * fq;
#pragma unroll
    for (int j = 0; j < 8; ++j) { const f32x4 ya = y[2 * j] * r * *(const f32x4*)(gw + 32 * j), yb = y[2 * j + 1] * r * *(const f32x4*)(gw + 32 * j + 4);
        v4u wv; wv.x = pk2(ya.x, ya.y); wv.y = pk2(ya.z, ya.w); wv.z = pk2(yb.x, yb.y); wv.w = pk2(yb.z, yb.w); *(v4u*)(MX + 32 * j) = wv; }
}
__device__ __forceinline__ void ph_post16(ARef A, const WI& w, int l) {
    LAS unsigned char* s0 = w.lds;
    for (int u = w.vcu; u < NB * NCH * 2; u += w.G) {
        const int b = u >> 5, c = (u >> 1) & 15, half = u & 1;
        __syncthreads();
#pragma unroll 2
        for (int e = w.tid; e < 4096; e += NWAVES * 64) { const int hd = e >> 9, v = (e >> 3) & 63, k8 = e & 7;
            const float* src = (const float*)(A.ws + ((hd < 4) ? WS_SIR : WS_SI)) + ((size_t)((b * 4 + (hd & 3)) * NCH + c) * 64 + v) * 64 + 8 * k8;
            const f32x4 x0 = *(const f32x4*)src, x1 = *(const f32x4*)(src + 4);
            v4u wv; wv.x = pk2(x0.x, x0.y); wv.y = pk2(x0.z, x0.w); wv.z = pk2(x1.x, x1.y); wv.w = pk2(x1.z, x1.w); *(LAS v4u*)(s0 + (hd * 64 + v) * S0_PITCH + 16 * k8) = wv; }
        __syncthreads();
        int lane = w.lane; asm volatile("" : "+v"(lane));
        const int tk = lane & 15, fq = lane >> 4; const size_t m = (size_t)(b * SEQ + c * TCH + half * 128 + w.wave * 16 + tk);
#pragma unroll 1
        for (int hh = 0; hh < 4; ++hh) post16_head<0>(A, l, m, hh, tk, fq, s0);
#pragma unroll 1
        for (int hh = 0; hh < 4; ++hh) post16_head<1>(A, l, m, hh, tk, fq, s0);
#pragma unroll 1
        for (int mx = 2; mx < 4; ++mx) post16_rms(A, l, m, mx, fq);
    }
}

__device__ __forceinline__ float wave_max_f(float v) {
    v = fmaxf(v, __builtin_bit_cast(float, __builtin_amdgcn_mov_dpp(__builtin_bit_cast(int, v), 0xB1, 0xF, 0xF, true)));
    v = fmaxf(v, __builtin_bit_cast(float, __builtin_amdgcn_mov_dpp(__builtin_bit_cast(int, v), 0x4E, 0xF, 0xF, true)));
    v = fmaxf(v, __builtin_bit_cast(float, __builtin_amdgcn_mov_dpp(__builtin_bit_cast(int, v), 0x141, 0xF, 0xF, true)));
    v = fmaxf(v, __builtin_bit_cast(float, __builtin_amdgcn_mov_dpp(__builtin_bit_cast(int, v), 0x140, 0xF, 0xF, true)));
    const int iv = __builtin_bit_cast(int, v);
    return fmaxf(fmaxf(__builtin_bit_cast(float, __builtin_amdgcn_readlane(iv, 0)), __builtin_bit_cast(float, __builtin_amdgcn_readlane(iv, 16))), fmaxf(__builtin_bit_cast(float, __builtin_amdgcn_readlane(iv, 32)), __builtin_bit_cast(float, __builtin_amdgcn_readlane(iv, 48))));
}
__device__ __forceinline__ void router_stage16(ARef A, const WI& w, int l) {
    LAS unsigned char* rwt = w.lds; const float* rw = A.in[I_RW] + (size_t)l * DM * 32;
    const int k0 = 2 * w.tid;
    const int c = k0 >> 3, kin = (k0 & 7) * 2;
#pragma unroll
    for (int e4 = 0; e4 < 8; ++e4) { const f32x4 a = *(const f32x4*)(rw + (size_t)k0 * 32 + 4 * e4), b = *(const f32x4*)(rw + (size_t)(k0 + 1) * 32 + 4 * e4);
#pragma unroll
        for (int i = 0; i < 4; ++i) { const int e = 4 * e4 + i; const unsigned hi = pg8::cvt_pk_bf16(a[i], b[i]); const float ra = a[i] - bf_lo(hi), rb = b[i] - bf_hi(hi); const unsigned lo = pg8::cvt_pk_bf16(ra, rb);
            const int off = e * 2048 + ((c ^ (e & 15)) * 16) + kin; *(LAS unsigned*)(rwt + off) = hi; *(LAS unsigned*)(rwt + 65536 + off) = lo; } }
    __syncthreads();
}
__device__ __forceinline__ void router16(ARef A, int l, int m0, int lane_in, LAS unsigned* hist, const LAS unsigned char* rwt, LAS int* texp, bool dry) {
    int lane = lane_in; asm volatile("" : "+v"(lane));
    const int tk = lane & 15, q4 = lane >> 4; const size_t m = (size_t)m0 + tk;
    const float* xr = (const float*)(A.ws + WS_XA) + m * DM + 8 * q4; const float* MOD = (const float*)(A.ws + WS_MOD) + (size_t)(l * 8 + (m0 >> 12)) * 6144;
    const float* g = A.in[I_NFFN] + l * DM + 8 * q4; const float* scp = MOD + 4 * 1024 + 8 * q4; const float* shp = MOD + 3 * 1024 + 8 * q4;
    bf16* hrow = (bf16*)(A.ws + WS_H) + m * DM + 8 * q4;
    float ss = 0.0f;
#pragma unroll 16
    for (int ks = 0; ks < 32; ++ks) { const f32x4 a = *(const f32x4*)(xr + 32 * ks), b = *(const f32x4*)(xr + 32 * ks + 4); ss += dot4(a, a) + dot4(b, b); }
    ss += __shfl_xor(ss, 16); ss += __shfl_xor(ss, 32);
    const float rstd = 1.0f / sqrtf(ss * (1.0f / DM) + 1e-5f);
    f32x4 acc[2] = {{0.f, 0.f, 0.f, 0.f}, {0.f, 0.f, 0.f, 0.f}};
    const LAS unsigned char* wrow = rwt + tk * 2048;
#pragma unroll 2
    for (int ks = 0; ks < 32; ++ks) {
        f32x4 h[2];
#pragma unroll
        for (int u = 0; u < 2; ++u) { const int k = 32 * ks + 4 * u; h[u] = *(const f32x4*)(xr + k) * rstd * *(const f32x4*)(g + k) * (1.0f + *(const f32x4*)(scp + k)) + *(const f32x4*)(shp + k); }
        pg8::u32x4 hw, lw;
        hw.x = pg8::cvt_pk_bf16(h[0].x, h[0].y); hw.y = pg8::cvt_pk_bf16(h[0].z, h[0].w); hw.z = pg8::cvt_pk_bf16(h[1].x, h[1].y); hw.w = pg8::cvt_pk_bf16(h[1].z, h[1].w);
        if (!dry) *(pg8::u32x4*)(hrow + 32 * ks) = hw;
        lw.x = pg8::cvt_pk_bf16(h[0].x - bf_lo(hw.x), h[0].y - bf_hi(hw.x)); lw.y = pg8::cvt_pk_bf16(h[0].z - bf_lo(hw.y), h[0].w - bf_hi(hw.y));
        lw.z = pg8::cvt_pk_bf16(h[1].x - bf_lo(hw.z), h[1].y - bf_hi(hw.z)); lw.w = pg8::cvt_pk_bf16(h[1].z - bf_lo(hw.w), h[1].w - bf_hi(hw.w));
        const bf16x8v bh = __builtin_bit_cast(bf16x8v, hw), bl = __builtin_bit_cast(bf16x8v, lw);
        const int coff = ((4 * ks + q4) ^ tk) * 16;
#pragma unroll
        for (int blk = 0; blk < 2; ++blk) { const bf16x8v ah = *(const LAS bf16x8v*)(wrow + blk * 32768 + coff), al = *(const LAS bf16x8v*)(wrow + 65536 + blk * 32768 + coff);
            acc[blk] = __builtin_amdgcn_mfma_f32_16x16x32_bf16(ah, bh, acc[blk], 0, 0, 0); acc[blk] = __builtin_amdgcn_mfma_f32_16x16x32_bf16(ah, bl, acc[blk], 0, 0, 0); acc[blk] = __builtin_amdgcn_mfma_f32_16x16x32_bf16(al, bh, acc[blk], 0, 0, 0); }
    }
    float lv[8]; const float* rb = A.in[I_RB] + l * 32 + 4 * q4;
#pragma unroll
    for (int blk = 0; blk < 2; ++blk)
#pragma unroll
        for (int i = 0; i < 4; ++i) lv[4 * blk + i] = acc[blk][i] + rb[16 * blk + i];
    float tv[4]; int ti[4];
#pragma unroll
    for (int kk = 0; kk < 4; ++kk) {
        float mx = fmaxf(fmaxf(fmaxf(lv[0], lv[1]), fmaxf(lv[2], lv[3])), fmaxf(fmaxf(lv[4], lv[5]), fmaxf(lv[6], lv[7])));
        mx = fmaxf(mx, __shfl_xor(mx, 16)); mx = fmaxf(mx, __shfl_xor(mx, 32));
        int cand = 99;
#pragma unroll
        for (int j = 7; j >= 0; --j) if (lv[j] == mx) cand = 16 * (j >> 2) + 4 * q4 + (j & 3);
        cand = min(cand, __shfl_xor(cand, 16)); cand = min(cand, __shfl_xor(cand, 32));
        if (cand == 99) cand = kk;
        tv[kk] = mx; ti[kk] = cand;
#pragma unroll
        for (int j = 0; j < 8; ++j) if (16 * (j >> 2) + 4 * q4 + (j & 3) == cand) lv[j] = -INFINITY;
    }
    const float e1 = expf(tv[1] - tv[0]), e2 = expf(tv[2] - tv[0]), e3 = expf(tv[3] - tv[0]); const float inv = 1.0f / (1.0f + e1 + e2 + e3);
    if (q4 == 0 && !dry) {
        int* TI = (int*)(A.ws + WS_TOPI) + m * 4; float* TW = (float*)(A.ws + WS_TOPW) + m * 4;
        *(v4u*)TI = (v4u){(unsigned)ti[0], (unsigned)ti[1], (unsigned)ti[2], (unsigned)ti[3]}; *(f32x4*)TW = (f32x4){inv, e1 * inv, e2 * inv, e3 * inv};
        LAS int* tx = texp + tk * 4; tx[0] = ti[0]; tx[1] = ti[1]; tx[2] = ti[2]; tx[3] = ti[3];
        { unsigned* hg = (unsigned*)hist; atomicAdd(hg + ti[0], 1u); atomicAdd(hg + ti[1], 1u); atomicAdd(hg + ti[2], 1u); atomicAdd(hg + ti[3], 1u); }
    }
}
__device__ __forceinline__ void build_expert_table(ARef A, const WI& w, int l) {
    LAS int* tst = (LAS int*)(w.lds + TST_OFF); LAS int* tab = (LAS int*)(w.lds + TAB_OFF); LAS int* cnt = (LAS int*)(w.lds + CNT_OFF);
    if (w.tid == 0) { const unsigned* gc = (const unsigned*)(A.ws + WS_CTL) + CW_GCNT + 64 * l; int acc = 0;
        for (int e = 0; e < 32; ++e) { const int c = (int)__hip_atomic_load(gc + e, RLX_AGENT); cnt[e] = c; tst[e] = acc; acc += (c + 255) >> 8; }
        tst[32] = acc; tab[0] = acc; }
    __syncthreads();
    if (w.tid < 32) { const int e = w.tid; for (int pm = tst[e]; pm < tst[e + 1]; ++pm) tab[1 + pm] = e; }
    __syncthreads();
}
__device__ __forceinline__ void router_lists(ARef A, const WI& w, int l) {
    LAS unsigned* hist = (LAS unsigned*)(w.lds + HIST_OFF); LAS int* base = (LAS int*)(w.lds + BASE_OFF); LAS int* texp = (LAS int*)(w.lds + TEXP_OFF);
    __syncthreads();
    if (w.tid < 32) { base[w.tid] = (int)atomicAdd((unsigned*)(A.ws + WS_CTL) + CW_GCNT + 64 * l + w.tid, hist[w.tid]); hist[w.tid] = 0u; }
    __syncthreads();
    int* LIST = (int*)(A.ws + WS_LIST); int* PW = (int*)(A.ws + WS_POS);
    for (int g16 = w.gw; g16 < MTOK / 16; g16 += w.NGW) {
        const int j = w.lane >> 2, q = w.lane & 3, m = 16 * g16 + j; const int e = texp[(w.wave * 16 + j) * 4 + q]; const int idx = base[e] + (int)atomicAdd((unsigned*)hist + e, 1u);
        LIST[e * LCAP + idx] = m; PW[(size_t)m * 4 + q] = (e << 20) | idx; }
}
__device__ __forceinline__ void combine_row(ARef A, int l, int m, int lane, const LAS int* tst, float gscale = 1.0f, float oscale = 1.0f) {
    float* XA = (float*)(A.ws + WS_XA) + (size_t)m * DM; const float* MOD = (const float*)(A.ws + WS_MOD) + (size_t)(l * 8 + (m >> 12)) * 6144;
    const int* PS = (const int*)(A.ws + WS_POS) + (size_t)m * 4; const float* TW = (const float*)(A.ws + WS_TOPW) + (size_t)m * 4;
    const bf16* YS = (const bf16*)(A.ws + WS_XS);
    f32x4 v[4], acc[4];
#pragma unroll
    for (int j = 0; j < 4; ++j) { v[j] = *(const f32x4*)(XA + 4 * (lane + 64 * j)); acc[j] = (f32x4){0.f, 0.f, 0.f, 0.f}; }
#pragma unroll
    for (int k = 0; k < 4; ++k) { const int pe = PS[k]; const int pos = tst[pe >> 20] * 256 + (pe & 0xFFFFF); const float gt = TW[k] * gscale; const v2u* yr = (const v2u*)(YS + (size_t)pos * DM);
#pragma unroll
        for (int j = 0; j < 4; ++j) { const v2u y = yr[lane + 64 * j]; acc[j] += gt * (f32x4){bf_lo(y.x), bf_hi(y.x), bf_lo(y.y), bf_hi(y.y)}; } }
    float ss = 0.0f;
#pragma unroll
    for (int j = 0; j < 4; ++j) { const int kx = 4 * (lane + 64 * j); v[j] += *(const f32x4*)(MOD + 5 * 1024 + kx) * acc[j]; ss += dot4(v[j], v[j]); }
    ss = wave_sum(ss); const float rstd = 1.0f / sqrtf(ss * (1.0f / DM) + 1e-5f);
    if (l + 1 < NLAYER) {
#pragma unroll
        for (int j = 0; j < 4; ++j) *(f32x4*)(XA + 4 * (lane + 64 * j)) = v[j];
        const float* mb = MOD + 8 * 6144;
        emit_h_row(v, rstd, A.in[I_NMIX] + (l + 1) * DM, mb + 1024, mb, (bf16*)(A.ws + WS_H) + (size_t)m * DM, lane);
    } else {
        float* orow = A.out + (size_t)m * DM; const float* gf = A.in[I_NFINAL];
#pragma unroll
        for (int j = 0; j < 4; ++j) { const int kx = 4 * (lane + 64 * j); *(f32x4*)(orow + kx) = v[j] * (rstd * oscale) * *(const f32x4*)(gf + kx); }
    }
}

constexpr int N_LAUNCHES = MK_N_LAUNCHES;
template <int SEL> __global__ void __launch_bounds__(NWAVES * 64, 2) fwd(ArgsH Ah) {
    extern __shared__ __attribute__((aligned(16))) unsigned char lds[];
    (void)Ah;
    const int wave_s = __builtin_amdgcn_readfirstlane((int)threadIdx.x >> 6);
    auto tid_now = [&]() -> int { int ws_ = wave_s; unsigned z_ = 0u; asm volatile("" : "+s"(ws_), "+s"(z_)); return ws_ * 64 + (int)__builtin_amdgcn_mbcnt_hi(~0u, __builtin_amdgcn_mbcnt_lo(~0u, z_)); };
#define TID_NOW() tid_now()
#define MAKE_WI() WI w; { int tz = TID_NOW(); asm volatile("" : "+v"(tz)); int bz = blockIdx.x, gz = gridDim.x; asm volatile("" : "+s"(bz), "+s"(gz)); \
        w.lds = (LAS unsigned char*)lds; w.tid = tz; w.lane = tz & 63; w.wave = __builtin_amdgcn_readfirstlane(tz >> 6); w.G = gz; w.bx = bz; w.vcu = (gz % 8 == 0) ? (bz % 8) * (gz / 8) + bz / 8 : bz; \
        w.gw = w.vcu * NWAVES + w.wave; w.NGW = gz * NWAVES; }
    { const int t0 = threadIdx.x; for (int u = t0; u < (LDS_BYTES - RING_BYTES) / 4; u += NWAVES * 64) ((LAS unsigned*)((LAS unsigned char*)lds + RING_BYTES))[u] = 0u; }
    __syncthreads();
    int lo, hi; { ARef A0 = *kargs(); lo = A0.ph_lo; hi = A0.ph_hi; }
    if (N_LAUNCHES == 1) { ARef A0 = *kargs(); (void)xcd_barrier_post((unsigned*)((gu32*)(A0.ws + WS_CTL) + CW_BAR), (volatile LAS unsigned*)((LAS unsigned char*)lds + MISC_OFF) + 8, TID_NOW()); }
#define GRID_BAR() do { if (N_LAUNCHES == 1) { ARef Ab = *kargs(); XcdBarrier bar_; bar_.bar = (unsigned*)((gu32*)(Ab.ws + WS_CTL) + CW_BAR); bar_.x = xb_xcc_id(); bar_.st = (volatile LAS unsigned*)((LAS unsigned char*)lds + MISC_OFF) + 8; xcd_barrier(bar_, TID_NOW()); } } while (0)
#ifndef TPROBE
#define TPROBE 0
#endif
#if TPROBE
    unsigned long long tp_acc = 0ull;
#define TP_SCALE tp_scale_of(__hip_atomic_load((unsigned*)(A.ws + WS_CTL) + 3, RLX_AGENT))
    auto tp_scale_of = [](unsigned ticks) -> float { const float us = (float)ticks * 0.01f; if (us < 1.0f) return 1.0f; const float q = exp2f(rintf(log2f(us) * 8.0f) * 0.125f); return 1.0f + sqrtf(q * 1e-5f); };
#define TP_BEGIN(kind) unsigned long long tp_t0 = 0ull; if ((kind) == TPROBE) tp_t0 = __builtin_amdgcn_s_memrealtime();
#define TP_END(kind) if ((kind) == TPROBE) { tp_acc += __builtin_amdgcn_s_memrealtime() - tp_t0; }
#define TP_PUBLISH(l) if ((l) == 1 && w.vcu == 0 && w.tid == 0) __hip_atomic_store((unsigned*)(A.ws + WS_CTL) + 3, (unsigned)tp_acc, RLX_AGENT);
#else
#define TP_SCALE 1.0f
#define TP_PUBLISH(l)
#define TP_BEGIN(kind)
#define TP_END(kind)
#endif
#define IN(k) (lo <= (k) && (k) < hi)
#ifndef PHMASK
#define PHMASK 0xffffffffu
#endif
#define KON(k) if constexpr ((SEL < 0 && ((PHMASK >> (k)) & 1u)) || SEL == (k))
#define BOTH(k) (IN(k) && IN((k) + 1))
#ifndef PROBE_REP
#define PROBE_REP 0
#endif
#if PROBE_REP
    int nrep_ = 2; asm volatile("" : "+s"(nrep_));
#define REP(bit) _Pragma("unroll 1") for (int rep_ = 0; rep_ < (((PROBE_REP >> (bit)) & 1) ? nrep_ : 1); ++rep_)
#else
#define REP(bit) for (int rep_ = 0; rep_ < 1; ++rep_)
#endif
#define ring ((PG8_LAS unsigned char*)lds)

    KON(0) if (IN(0)) { ARef A = *kargs(); MAKE_WI(); REP(0) ph_prologue(A, w); if (BOTH(0)) GRID_BAR(); }

#define LAYER_BODY(l) do {\
        const int pb = 1 + l * NPL; \
        KON(1) if (IN(pb + 0)) { ARef A = *kargs(); MAKE_WI(); TP_BEGIN(1) if (l == 0) { REP(15) { ph_norm1(A, w); small_weights_to_f16(A, w); } if (BOTH(pb + 0)) GRID_BAR(); } TP_END(1) } \
        KON(2) if (IN(pb + 1)) { ARef A = *kargs(); MAKE_WI(); TP_BEGIN(2) \
            pg8::Gemm g{(const bf16*)(A.ws + WS_H), (const bf16*)(A.ws + WS_WIN) + (size_t)l * INCP * DM, MTOK, INCP, DM}; pg8::StaticOrder S; S.init(MTOK, INCP, w.G, w.bx); \
            pg8::EpiProj E{(bf16*)(A.ws + WS_PB), (bf16*)(A.ws + WS_PF)}; \
            REP(1) pg8::gemm_phase<pg8::EpiProj, pg8::StaticOrder, true, true>(ring, g, S, E, w.tid); \
            if (BOTH(pb + 1)) GRID_BAR(); TP_END(2) \
        } \
        KON(3) if (IN(pb + 2)) { ARef A = *kargs(); MAKE_WI(); TP_BEGIN(3) \
            REP(2) { int part_ = rep_ ? ((PROBE_REP >> 21) & 7) : 7; asm volatile("" : "+s"(part_)); for (int g = w.gw; g < MTOK / 16; g += w.NGW) prep16(A, l, 16 * g, w.lane, part_); } \
            if (BOTH(pb + 2)) GRID_BAR(); TP_END(3) \
        } \
        KON(4) if (IN(pb + 3)) { ARef A = *kargs(); MAKE_WI(); TP_BEGIN(4) \
            REP(3) { for (int tk = 2 * w.vcu; tk < 32 * NCH; tk += 2 * w.G) scan_rwkv_task2(A, w, tk); } \
            REP(13) { LAS unsigned char* vl = w.lds + w.wave * 9216; int k_ = 0; for (int it = w.gw; it < 32 * 128; it += w.NGW, ++k_) ret_tile_mfma(A, (k_ & 1) ? (it ^ 7) : it, w.lane, vl); \
                      for (int it = w.gw; it < 32 * NCH; it += w.NGW) ret_state_mfma(A, it, w.lane, vl); } \
            REP(4) { LAS unsigned char* vl = w.lds + w.wave * 9216; for (int it = w.gw; it < 32 * 128; it += w.NGW) sb_tile_mfma(A, it, w.lane, vl); } \
            REP(5) dsa_scores_mfma(A, w); \
            if (BOTH(pb + 3)) GRID_BAR(); TP_END(4) \
        } \
        KON(5) if (IN(pb + 4)) { ARef A = *kargs(); MAKE_WI(); TP_BEGIN(5) \
            if (w.bx < 32) prefix_chain(A, w, w.bx); \
            REP(6) { int sk_ = rep_ ? ((PROBE_REP >> 24) & 7) : 0; asm volatile("" : "+s"(sk_)); dsa_wave(A, w, w.lds + w.wave * 13312, l + 2 * rep_, l, sk_); } \
            REP(14) { if (rep_ && w.bx < 32) prefix_chain(A, w, w.bx); } \
            if (BOTH(pb + 4)) GRID_BAR(); TP_END(5) \
        } \
        KON(6) if (IN(pb + 5)) { ARef A = *kargs(); MAKE_WI(); TP_BEGIN(6) \
            REP(7) ph_post16(A, w, l); \
            if (BOTH(pb + 5)) GRID_BAR(); TP_END(6) \
        } \
        KON(7) if (IN(pb + 6)) { ARef A = *kargs(); MAKE_WI(); TP_BEGIN(7) \
            pg8::Gemm g{(const bf16*)(A.ws + WS_MIX), (const bf16*)(A.ws + WS_WOUT) + (size_t)l * DM * DM, MTOK, DM, DM}; pg8::StaticOrder S; S.init(MTOK, DM, w.G, w.bx); \
            pg8::EpiRes E{l == 0 ? A.in[I_X] : (const float*)(A.ws + WS_XA), (float*)(A.ws + WS_XA), (const float*)(A.ws + WS_MOD) + (size_t)l * 8 * 6144 + 2 * 1024}; \
            REP(16) { pg8::EpiRes E2 = E; if (rep_ && l == 1) E2.gate = (const float*)(A.ws + WS_CTL + 512 * 1024); pg8::gemm_phase<pg8::EpiRes, pg8::StaticOrder, true, true>(ring, g, S, E2, w.tid); } \
            if (BOTH(pb + 6)) GRID_BAR(); TP_END(7) \
        } \
        KON(8) if (IN(pb + 7)) { ARef A = *kargs(); MAKE_WI(); TP_BEGIN(8) \
            { LAS unsigned* hist = (LAS unsigned*)(w.lds + HIST_OFF); LAS int* texp = (LAS int*)(w.lds + TEXP_OFF); if (w.tid < 32) hist[w.tid] = 0u; router_stage16(A, w, l); \
            REP(10) { for (int g16 = w.gw; g16 < MTOK / 16; g16 += w.NGW) router16(A, l, 16 * g16, w.lane, hist, (const LAS unsigned char*)w.lds, texp + w.wave * 64, rep_ != 0); } \
            router_lists(A, w, l); } \
            if (BOTH(pb + 7)) GRID_BAR(); TP_END(8) \
        } \
        KON(10) if (IN(pb + 8)) { ARef A = *kargs(); MAKE_WI(); TP_BEGIN(10) \
            build_expert_table(A, w, l); \
            pg8::Gemm g{(const bf16*)(A.ws + WS_H), (const bf16*)(A.ws + WS_W1) + (size_t)l * NEXP * 2048 * DM, MOE_ROWS, NEXP * 2048, DM}; \
            pg8::MoeOrder S{(const PG8_LAS int*)(w.lds + TAB_OFF), 8, w.G, w.vcu, (const PG8_LAS int*)(w.lds + TST_OFF), (const PG8_LAS int*)(w.lds + CNT_OFF), (const int*)(A.ws + WS_LIST)}; \
            pg8::EpiSwiglu E{(bf16*)(A.ws + WS_ACT), A.in[I_MB1] + (size_t)l * NEXP * 2048}; \
            REP(8) { if (PROBE_REP & (1 << 20)) { if (rep_) pg8::gemm_phase<pg8::EpiNull, pg8::MoeOrder, true, true, true>(ring, g, S, pg8::EpiNull{}, w.tid); else pg8::gemm_phase<pg8::EpiSwiglu, pg8::MoeOrder, true, true, true>(ring, g, S, E, w.tid); } else pg8::gemm_phase<pg8::EpiSwiglu, pg8::MoeOrder, true, true, true>(ring, g, S, E, w.tid); } \
            if (BOTH(pb + 8)) GRID_BAR(); TP_END(10) \
        } \
        KON(11) if (IN(pb + 9)) { ARef A = *kargs(); MAKE_WI(); TP_BEGIN(11) \
            build_expert_table(A, w, l); \
            pg8::Gemm g{(const bf16*)(A.ws + WS_ACT), (const bf16*)(A.ws + WS_W2) + (size_t)l * NEXP * DM * DM, MOE_ROWS, NEXP * DM, DM}; \
            pg8::MoeOrder S{(const PG8_LAS int*)(w.lds + TAB_OFF), 4, w.G, w.vcu, (const PG8_LAS int*)(w.lds + TST_OFF), (const PG8_LAS int*)(w.lds + CNT_OFF), (const int*)(A.ws + WS_LIST)}; \
            pg8::EpiY E{(bf16*)(A.ws + WS_XS), A.in[I_MB2] + (size_t)l * NEXP * DM}; \
            REP(9) pg8::gemm_phase<pg8::EpiY, pg8::MoeOrder, true, true>(ring, g, S, E, w.tid); \
            TP_PUBLISH(l) \
            if (BOTH(pb + 9)) GRID_BAR(); TP_END(11) \
        } \
        KON(12) if (IN(pb + 10)) { ARef A = *kargs(); MAKE_WI(); TP_BEGIN(12) \
            build_expert_table(A, w, l); \
            REP(12) for (int m = w.gw; m < MTOK; m += w.NGW) combine_row(A, l, m, w.lane, (const LAS int*)(w.lds + TST_OFF), (rep_ && l == 0) ? 0.0f : 1.0f, TP_SCALE); \
            if (BOTH(pb + 10)) GRID_BAR(); TP_END(12) \
        } \
    } while (0)
    LAYER_BODY(0);
    LAYER_BODY(1);
#undef LAYER_BODY
#undef IN
#undef ring
#undef MAKE_WI
#undef TID_NOW
#undef GRID_BAR
#undef KON
#undef BOTH
}


#if MK_N_LAUNCHES != 1
template <int K> static void launch_one(int grid, hipStream_t stream, const ArgsH& a) {
    static bool attr = false;
    if (!attr) { (void)hipFuncSetAttribute((const void*)fwd<K>, hipFuncAttributeMaxDynamicSharedMemorySize, LDS_BYTES); attr = true; }
    hipLaunchKernelGGL(fwd<K>, dim3(grid), dim3(NWAVES * 64), LDS_BYTES, stream, a);
}
static void launch_kind(int kind, int grid, hipStream_t stream, const ArgsH& a) {
    switch (kind) {
        case 0: launch_one<0>(grid, stream, a); break; case 1: launch_one<1>(grid, stream, a); break; case 2: launch_one<2>(grid, stream, a); break;
        case 3: launch_one<3>(grid, stream, a); break; case 4: launch_one<4>(grid, stream, a); break; case 5: launch_one<5>(grid, stream, a); break;
        case 6: launch_one<6>(grid, stream, a); break; case 7: launch_one<7>(grid, stream, a); break; case 8: launch_one<8>(grid, stream, a); break;
        case 9: launch_one<9>(grid, stream, a); break; case 10: launch_one<10>(grid, stream, a); break; case 11: launch_one<11>(grid, stream, a); break;
        default: launch_one<12>(grid, stream, a); break;
    }
}
#endif
extern "C" void kernel_launch(void* const* d_in, const int* in_sizes, int n_in, void* d_out, int out_size, void* d_ws, size_t ws_size, hipStream_t stream) {
    static int grid = 0;
    if (grid == 0) {
        if (n_in != N_IN || out_size != MTOK * DM || ws_size < WS_END) { fprintf(stderr, "kernel_launch: unexpected shapes (n_in %d, out %d, ws %zu)\n", n_in, out_size, ws_size); grid = -1; return; }
        int dev = 0, cus = 0;
        if (hipGetDevice(&dev) != hipSuccess || hipDeviceGetAttribute(&cus, hipDeviceAttributeMultiprocessorCount, dev) != hipSuccess) { grid = -1; return; }
#if MK_N_LAUNCHES == 1
        {
            if (hipFuncSetAttribute((const void*)fwd<-1>, hipFuncAttributeMaxDynamicSharedMemorySize, LDS_BYTES) != hipSuccess) { fprintf(stderr, "kernel_launch: hipFuncSetAttribute failed\n"); grid = -1; return; }
            int per_cu = 0;
            if (hipOccupancyMaxActiveBlocksPerMultiprocessor(&per_cu, (const void*)fwd<-1>, NWAVES * 64, LDS_BYTES) != hipSuccess || per_cu < 1) fprintf(stderr, "kernel_launch: occupancy query says %d\n", per_cu);
            (void)hipGetLastError();
        }
#endif
        grid = cus;
    }
    if (grid < 0) return;
    (void)in_sizes;
    if (hipMemsetAsync((char*)d_ws + WS_CTL, 0, CTL_ZERO_BYTES, stream) != hipSuccess) return;
    ArgsH a{};
    for (int i = 0; i < N_IN; ++i) a.in[i] = (const float*)d_in[i];
    a.out = (float*)d_out; a.ws = (unsigned char*)d_ws;
    for (int f = 0; f < 44; ++f) a.invf[f] = (f < 32) ? pow(10000.0, -(double)f / 32.0) : (f < 40) ? pow(500000.0, -(double)(f - 32) / 8.0) : pow(500000.0, -(double)(f - 40) / 4.0);
#if MK_N_LAUNCHES == 1
    a.ph_lo = 0; a.ph_hi = NPHASE; a.li = 0;
    hipLaunchKernelGGL(fwd<-1>, dim3(grid), dim3(NWAVES * 64), LDS_BYTES, stream, a);
#else
    {
        for (int p = 0; p < NPHASE; ++p) {
            if (p == 1 + NPL) continue;
            a.ph_lo = p; a.ph_hi = p + 1; a.li = p;
            static const int kinds_[NPL] = {1, 2, 3, 4, 5, 6, 7, 8, 10, 11, 12};
            const int kind = (p == 0) ? 0 : kinds_[(p - 1) % NPL];
            launch_kind(kind, grid, stream, a);
        }
    }
#endif
}
```

```cpp
#include <hip/hip_runtime.h>
#include <cstdio>
#include <cstdint>
#include <cmath>

#ifndef MK_N_LAUNCHES
#define MK_N_LAUNCHES 1
#endif

namespace pg8 {
#define PG8_LAS __attribute__((address_space(3)))
typedef unsigned short bf16_t;
typedef short bf16x8 __attribute__((ext_vector_type(8)));
typedef float f32x4 __attribute__((ext_vector_type(4)));
typedef unsigned u32x4 __attribute__((ext_vector_type(4)));
typedef unsigned u32x2 __attribute__((ext_vector_type(2)));
constexpr int BM = 256, BK = 64, HALF = 128, HTB = HALF * BK * 2  , STAGE_BYTES = 8 * HTB, NXCD = 8, WGM = 8;

__host__ __device__ __forceinline__ int lds_byte(int r, int c) { const int st = (r >> 4) * 2 + (c >> 5), rr = r & 15, cc = c & 31, ob = rr * 64 + cc * 2; return st * 1024 + (ob ^ (((ob >> 9) & 1) << 5)); }
__host__ __device__ __forceinline__ void stage_rc(int b, int& R, int& C) { const int st = b / 1024, sb = b % 1024, swz = sb ^ (((sb >> 9) & 1) << 5); R = (st >> 1) * 16 + swz / 64; C = (st & 1) * 32 + (swz % 64) / 2; }
__host__ __device__ __forceinline__ int perm32(int rho) { const int n = rho >> 4, i = rho & 15; return 8 * (i >> 2) + 4 * n + (i & 3); }

struct Unit { int pm, pn; };
struct Gemm { const bf16_t* A; const bf16_t* Bt; int M, N, K; };

struct StaticOrder {
    int nM, nN, nwg, G, c;
    __host__ __device__ void init(int M, int N, int G_, int c_) { nM = M / BM; nN = N / BM; nwg = nM * nN; G = G_; c = c_; }
    __host__ __device__ bool next(int i, Unit& u) const {
        const long L = (long)i * G + c; if (L >= nwg) return false;
        int wgid = (int)L; { const int q = nwg / NXCD, r = nwg % NXCD, xcd = wgid % NXCD, off = wgid / NXCD; wgid = (xcd < r ? xcd * (q + 1) : r * (q + 1) + (xcd - r) * q) + off; }
        const int nig = WGM * nN, gid = wgid / nig, fm = gid * WGM, gsz = (nM - fm) < WGM ? (nM - fm) : WGM;
        u.pm = fm + ((wgid % nig) % gsz); u.pn = (wgid % nig) / gsz; return true;
    }
    __device__ __forceinline__ void a_ready(const Unit&) const {}
    __device__ __forceinline__ void done(const Unit&) const {}
};
__device__ __forceinline__ unsigned cvt_pk_bf16(float lo, float hi) { unsigned r; asm volatile("v_cvt_pk_bf16_f32 %0, %1, %2" : "=v"(r) : "v"(lo), "v"(hi)); return r; }
struct EpiF32 {
    static constexpr bool PERM = false, AFTER_DRAIN = false;
    float* C; int ldc;
    __device__ __forceinline__ void operator()(const f32x4 (&acc)[2][2][4][2], const Unit& u, int wr, int wc, int fr, int fq) const {
        const int row0 = u.pm * BM + wr * 64 + fr, col0 = u.pn * BM + wc * 32 + 4 * fq;
#pragma unroll
        for (int ai = 0; ai < 2; ++ai)
#pragma unroll
            for (int m = 0; m < 4; ++m) { float* rowp = C + (size_t)(row0 + ai * HALF + m * 16) * ldc + col0;
#pragma unroll
                for (int bj = 0; bj < 2; ++bj)
#pragma unroll
                    for (int n = 0; n < 2; ++n) *(f32x4*)(rowp + bj * HALF + n * 16) = acc[ai][bj][m][n]; }
    }
};
struct EpiNull {
    static constexpr bool PERM = true, AFTER_DRAIN = false;
    __device__ __forceinline__ void operator()(const f32x4 (&acc)[2][2][4][2], const Unit&, int, int, int, int) const {
#pragma unroll
        for (int ai = 0; ai < 2; ++ai)
#pragma unroll
            for (int bj = 0; bj < 2; ++bj) asm volatile("" :: "v"(acc[ai][bj][0][0]), "v"(acc[ai][bj][0][1]), "v"(acc[ai][bj][1][0]), "v"(acc[ai][bj][1][1]), "v"(acc[ai][bj][2][0]), "v"(acc[ai][bj][2][1]), "v"(acc[ai][bj][3][0]), "v"(acc[ai][bj][3][1]));
    }
};
struct EpiProj {
    static constexpr bool PERM = true, AFTER_DRAIN = false;
    bf16_t* PB; bf16_t* PF;
    __device__ __forceinline__ void operator()(const f32x4 (&acc)[2][2][4][2], const Unit& u, int wr, int wc, int fr, int fq) const {
        const int row0 = u.pm * BM + wr * 64 + fr;
        if (u.pn < 7) { const int c0 = u.pn * BM + wc * 32 + 8 * fq;
#pragma unroll
            for (int ai = 0; ai < 2; ++ai)
#pragma unroll
                for (int m = 0; m < 4; ++m) { bf16_t* rowp = PB + (size_t)(row0 + ai * HALF + m * 16) * 1792 + c0;
#pragma unroll
                    for (int bj = 0; bj < 2; ++bj) { const f32x4 v0 = acc[ai][bj][m][0], v1 = acc[ai][bj][m][1];
                        u32x4 w; w.x = cvt_pk_bf16(v0[0], v0[1]); w.y = cvt_pk_bf16(v0[2], v0[3]); w.z = cvt_pk_bf16(v1[0], v1[1]); w.w = cvt_pk_bf16(v1[2], v1[3]);
                        *(u32x4*)(rowp + bj * HALF) = w; } }
        } else { const int c0 = (u.pn - 7) * BM + wc * 32 + 8 * fq;
#pragma unroll
            for (int ai = 0; ai < 2; ++ai)
#pragma unroll
                for (int m = 0; m < 4; ++m) { bf16_t* rowp = PF + (size_t)(row0 + ai * HALF + m * 16) * 1280 + c0;
#pragma unroll
                    for (int bj = 0; bj < 2; ++bj) { const f32x4 v0 = acc[ai][bj][m][0], v1 = acc[ai][bj][m][1];
                        u32x4 w; w.x = cvt_pk_bf16(v0[0], v0[1]); w.y = cvt_pk_bf16(v0[2], v0[3]); w.z = cvt_pk_bf16(v1[0], v1[1]); w.w = cvt_pk_bf16(v1[2], v1[3]);
                        *(u32x4*)(rowp + bj * HALF) = w; } }
        }
    }
};
template <bool XBF> struct EpiRes {
    static constexpr bool PERM = true, AFTER_DRAIN = false;
    const void* xin; bf16_t* xout; const float* gate;
    __device__ __forceinline__ void operator()(const f32x4 (&acc)[2][2][4][2], const Unit& u, int wr, int wc, int fr, int fq) const {
        const int row0 = u.pm * BM + wr * 64 + fr, c0 = u.pn * BM + wc * 32 + 8 * fq;
        const float* gp = gate + (size_t)((u.pm * BM) >> 12) * 6144 + c0;
        f32x4 gv[2][2];
#pragma unroll
        for (int bj = 0; bj < 2; ++bj)
#pragma unroll
            for (int n = 0; n < 2; ++n) gv[bj][n] = *(const f32x4*)(gp + bj * HALF + 4 * n);
#pragma unroll
        for (int ai = 0; ai < 2; ++ai)
#pragma unroll
            for (int m = 0; m < 4; ++m) { const size_t ro = (size_t)(row0 + ai * HALF + m * 16) * 1024 + c0;
#pragma unroll
                for (int bj = 0; bj < 2; ++bj) { f32x4 x0, x1;
                    if (XBF) { const u32x4 xw = *(const u32x4*)((const bf16_t*)xin + ro + bj * HALF);
                        x0 = (f32x4){__builtin_bit_cast(float, xw.x << 16), __builtin_bit_cast(float, xw.x & 0xffff0000u), __builtin_bit_cast(float, xw.y << 16), __builtin_bit_cast(float, xw.y & 0xffff0000u)};
                        x1 = (f32x4){__builtin_bit_cast(float, xw.z << 16), __builtin_bit_cast(float, xw.z & 0xffff0000u), __builtin_bit_cast(float, xw.w << 16), __builtin_bit_cast(float, xw.w & 0xffff0000u)}; }
                    else { x0 = *(const f32x4*)((const float*)xin + ro + bj * HALF); x1 = *(const f32x4*)((const float*)xin + ro + bj * HALF + 4); }
                    const f32x4 v0 = x0 + gv[bj][0] * acc[ai][bj][m][0], v1 = x1 + gv[bj][1] * acc[ai][bj][m][1];
                    u32x4 w; w.x = cvt_pk_bf16(v0[0], v0[1]); w.y = cvt_pk_bf16(v0[2], v0[3]); w.z = cvt_pk_bf16(v1[0], v1[1]); w.w = cvt_pk_bf16(v1[2], v1[3]);
                    *(u32x4*)(xout + ro + bj * HALF) = w; } }
    }
};
__device__ __forceinline__ float swiglu1(float glu, float lin) {
    glu = fminf(glu, 7.0f); lin = fminf(fmaxf(lin, -7.0f), 7.0f);
    return glu * (1.0f / (1.0f + __expf(-1.702f * glu))) * (lin + 1.0f);
}
struct EpiSwiglu {
    static constexpr bool PERM = true, AFTER_DRAIN = false;
    bf16_t* O; const float* b1;
    __device__ __forceinline__ void operator()(const f32x4 (&acc)[2][2][4][2], const Unit& u, int wr, int wc, int fr, int fq) const {
        const int e = u.pn >> 3, j = u.pn & 7, row0 = u.pm * BM + wr * 64 + fr, c0 = 128 * j + wc * 32 + 8 * fq;
        const float* bp = b1 + (size_t)e * 2048 + c0;
        f32x4 bg[2], bl[2];
#pragma unroll
        for (int n = 0; n < 2; ++n) { bg[n] = *(const f32x4*)(bp + 4 * n); bl[n] = *(const f32x4*)(bp + 1024 + 4 * n); }
#pragma unroll
        for (int ai = 0; ai < 2; ++ai)
#pragma unroll
            for (int m = 0; m < 4; ++m) { bf16_t* rowp = O + (size_t)(row0 + ai * HALF + m * 16) * 1024 + c0;
                const f32x4 g0 = acc[ai][0][m][0] + bg[0], g1 = acc[ai][0][m][1] + bg[1], l0 = acc[ai][1][m][0] + bl[0], l1 = acc[ai][1][m][1] + bl[1];
                u32x4 w;
                w.x = cvt_pk_bf16(swiglu1(g0[0], l0[0]), swiglu1(g0[1], l0[1])); w.y = cvt_pk_bf16(swiglu1(g0[2], l0[2]), swiglu1(g0[3], l0[3]));
                w.z = cvt_pk_bf16(swiglu1(g1[0], l1[0]), swiglu1(g1[1], l1[1])); w.w = cvt_pk_bf16(swiglu1(g1[2], l1[2]), swiglu1(g1[3], l1[3]));
                *(u32x4*)rowp = w; }
    }
};
struct EpiY {
    static constexpr bool PERM = true, AFTER_DRAIN = false;
    bf16_t* O; const float* b2;
    __device__ __forceinline__ void operator()(const f32x4 (&acc)[2][2][4][2], const Unit& u, int wr, int wc, int fr, int fq) const {
        const int e = u.pn >> 2, j = u.pn & 3, row0 = u.pm * BM + wr * 64 + fr, c0 = 256 * j + wc * 32 + 8 * fq;
        const float* bp = b2 + (size_t)e * 1024 + c0;
        f32x4 bv[2][2];
#pragma unroll
        for (int bj = 0; bj < 2; ++bj)
#pragma unroll
            for (int n = 0; n < 2; ++n) bv[bj][n] = *(const f32x4*)(bp + bj * HALF + 4 * n);
#pragma unroll
        for (int ai = 0; ai < 2; ++ai)
#pragma unroll
            for (int m = 0; m < 4; ++m) { bf16_t* rowp = O + (size_t)(row0 + ai * HALF + m * 16) * 1024 + c0;
#pragma unroll
                for (int bj = 0; bj < 2; ++bj) { const f32x4 v0 = acc[ai][bj][m][0] + bv[bj][0], v1 = acc[ai][bj][m][1] + bv[bj][1];
                    u32x4 w; w.x = cvt_pk_bf16(v0[0], v0[1]); w.y = cvt_pk_bf16(v0[2], v0[3]); w.z = cvt_pk_bf16(v1[0], v1[1]); w.w = cvt_pk_bf16(v1[2], v1[3]);
                    *(u32x4*)(rowp + bj * HALF) = w; } }
    }
};
struct MoeOrder {
    const PG8_LAS int* tab; int NJ, G, c;
    __device__ __forceinline__ bool next(int i, Unit& u) const {
        const int T = tab[0]; const long L = (long)i * G + c; if (L >= (long)T * NJ) return false;
        const int pm = (int)(L / NJ), j = (int)(L % NJ);
        u.pm = pm; u.pn = tab[1 + pm] * NJ + j; return true;
    }
    __device__ __forceinline__ void a_ready(const Unit&) const {}
    __device__ __forceinline__ void done(const Unit&) const {}
    const PG8_LAS int* tst; const PG8_LAS int* cnt; const int* list;
    __device__ __forceinline__ int row_of(const Unit& u, int r) const { const int e = tab[1 + u.pm], idx = 256 * (u.pm - tst[e]) + r; return (idx < cnt[e]) ? list[e * 32768 + idx] : 0; }
};

template <class Epi, class Sched, bool ALIGN_EPI = false, bool SP2 = false, bool GATHER = false>
__device__ __forceinline__ void gemm_phase(PG8_LAS unsigned char* lds, const Gemm g, const Sched& S, const Epi& E, int tid_in) {
    int tid_ = tid_in; asm volatile("" : "+v"(tid_));
    const int tid = tid_, wid = __builtin_amdgcn_readfirstlane(tid >> 6), lane = tid & 63, wr = wid >> 2, wc = wid & 3, fr = lane & 15, fq = lane >> 4;
    const int K = g.K, nt = K / BK;
    unsigned voffA[2], voffB[2];
#pragma unroll
    for (int i = 0; i < 2; ++i) { int R, C; stage_rc(tid * 16 + i * 8192, R, C); const int Rb = Epi::PERM ? ((R & ~31) + perm32(R & 31)) : R;
        voffA[i] = (unsigned)(R * K + C) * 2u; voffB[i] = (unsigned)(Rb * K + C) * 2u; }
    static_assert(!GATHER || SP2, "gathered A rows: only the two-super-phase loop is wired");
    unsigned cvo[2][2], nvo[2][2];
#define PG8_ROWS(dst, u_) do { _Pragma("unroll") for (int h_ = 0; h_ < 2; ++h_) _Pragma("unroll") for (int i_ = 0; i_ < 2; ++i_) { int R_, C_; stage_rc(tid * 16 + i_ * 8192, R_, C_); dst[h_][i_] = (unsigned)(S.row_of(u_, h_ * HALF + R_) * K + C_) * 2u; } } while (0)
#define PG8_STAGE_A(bufoff, gbase, half, nx) do { if constexpr (GATHER) { unsigned o_[2]; o_[0] = (nx) ? nvo[half][0] : cvo[half][0]; o_[1] = (nx) ? nvo[half][1] : cvo[half][1]; PG8_STAGE(bufoff, gbase, o_); } else { PG8_STAGE(bufoff, (gbase) + (half) * hstep, voffA); } } while (0)
    const size_t kstep = (size_t)(BK * 2);
    const size_t hstep = (size_t)HALF * K * 2;
    const size_t tstep = 2 * hstep;
    const unsigned ldsw = (unsigned)wid * 1024u;
    const int aoff = lds_byte(wr * 64 + fr, fq * 8), boff = lds_byte(wc * 32 + fr, fq * 8);
#define PG8_SA(b, h) (((b) * 2 + (h)) * HTB)
#define PG8_SB(b, h) ((4 + (b) * 2 + (h)) * HTB)
#define PG8_STAGE(bufoff, gbase, voff) do { _Pragma("unroll") for (int _i = 0; _i < 2; ++_i) \
        __builtin_amdgcn_global_load_lds((const unsigned*)((const char*)(gbase) + (voff)[_i]), (PG8_LAS unsigned*)(lds + (bufoff) + ldsw + _i * 8192), 16, 0, 0); } while (0)
#define PG8_LDA(dst, b, h) do { _Pragma("unroll") for (int m = 0; m < 4; ++m) _Pragma("unroll") for (int k = 0; k < 2; ++k) dst[m][k] = *(const PG8_LAS bf16x8*)(lds + PG8_SA(b, h) + aoff + m * 2048 + k * 1024); } while (0)
#define PG8_LDB(dst, b, h) do { _Pragma("unroll") for (int n = 0; n < 2; ++n) _Pragma("unroll") for (int k = 0; k < 2; ++k) dst[n][k] = *(const PG8_LAS bf16x8*)(lds + PG8_SB(b, h) + boff + n * 2048 + k * 1024); } while (0)
#define PG8_MMA(ai, bj, At, Bt) do { __builtin_amdgcn_s_setprio(1); _Pragma("unroll") for (int m = 0; m < 4; ++m) _Pragma("unroll") for (int n = 0; n < 2; ++n) _Pragma("unroll") for (int k = 0; k < 2; ++k) \
        acc[ai][bj][m][n] = __builtin_amdgcn_mfma_f32_16x16x32_bf16(Bt[n][k], At[m][k], acc[ai][bj][m][n], 0, 0, 0); __builtin_amdgcn_s_setprio(0); } while (0)
#define PG8_WAIT_V(n) asm volatile("s_waitcnt vmcnt(" #n ")" ::: "memory")
#define PG8_WAIT_L(n) asm volatile("s_waitcnt lgkmcnt(" #n ")" ::: "memory")
#define PG8_BAR __builtin_amdgcn_s_barrier()
#define PG8_SCHED __builtin_amdgcn_sched_barrier(0)
    Unit cur, nxt; int ui = 0;
    if (!S.next(0, cur)) return;
    f32x4 acc[2][2][4][2];
#pragma unroll
    for (int a = 0; a < 2; ++a)
#pragma unroll
        for (int b = 0; b < 2; ++b)
#pragma unroll
            for (int m = 0; m < 4; ++m)
#pragma unroll
                for (int n = 0; n < 2; ++n) acc[a][b][m][n] = (f32x4){0.f, 0.f, 0.f, 0.f};
    bf16x8 At[4][2], B0[2][2], B1[2][2];
    const char* cA = (const char*)g.A + (GATHER ? (size_t)0 : (size_t)cur.pm * tstep); const char* cB = (const char*)g.Bt + (size_t)cur.pn * tstep;
    if constexpr (GATHER) { PG8_ROWS(cvo, cur); }
    S.a_ready(cur);
    if constexpr (SP2) {
        PG8_STAGE(PG8_SB(0, 0), cB, voffB); PG8_STAGE(PG8_SB(0, 1), cB + hstep, voffB); PG8_STAGE_A(PG8_SA(0, 0), cA, 0, false); PG8_STAGE_A(PG8_SA(0, 1), cA, 1, false);
        if (wr == 1) PG8_BAR;
        PG8_WAIT_V(2); PG8_BAR;
        PG8_STAGE(PG8_SB(1, 0), cB + kstep, voffB); PG8_STAGE_A(PG8_SA(1, 0), cA + kstep, 0, false); PG8_STAGE(PG8_SB(1, 1), cB + hstep + kstep, voffB);
        PG8_WAIT_V(6); PG8_BAR;
    } else {
        PG8_STAGE(PG8_SB(0, 0), cB, voffB); PG8_STAGE(PG8_SA(0, 0), cA, voffA); PG8_STAGE(PG8_SB(0, 1), cB + hstep, voffB); PG8_STAGE(PG8_SA(0, 1), cA + hstep, voffA);
        if (wr == 1) PG8_BAR;
        PG8_WAIT_V(4); PG8_BAR;
        PG8_STAGE(PG8_SB(1, 0), cB + kstep, voffB); PG8_STAGE(PG8_SA(1, 0), cA + kstep, voffA); PG8_STAGE(PG8_SB(1, 1), cB + hstep + kstep, voffB);
        PG8_WAIT_V(6); PG8_BAR;
    }
    for (;;) {
        const bool has_next = S.next(ui + 1, nxt);
        const char* nA = GATHER ? (const char*)g.A : (has_next ? (const char*)g.A + (size_t)nxt.pm * tstep : cA); const char* nB = has_next ? (const char*)g.Bt + (size_t)nxt.pn * tstep : cB;
        if constexpr (GATHER) { if (has_next) { PG8_ROWS(nvo, nxt); } else { _Pragma("unroll") for (int h_ = 0; h_ < 2; ++h_) { nvo[h_][0] = cvo[h_][0]; nvo[h_][1] = cvo[h_][1]; } } }
        for (int t = 0; t < nt; t += 2) {
            const bool last = (t == nt - 2);
            const char* a1 = cA + (size_t)(t + 1) * kstep;
            const char* a2 = last ? nA : cA + (size_t)(t + 2) * kstep; const char* b2 = last ? nB : cB + (size_t)(t + 2) * kstep;
            const char* a3 = a2 + kstep; const char* b3 = b2 + kstep;
            if (last && has_next) S.a_ready(nxt);
            if constexpr (SP2) {
            PG8_LDB(B0, 0, 0); PG8_LDB(B1, 0, 1); PG8_SCHED; PG8_LDA(At, 0, 0); PG8_STAGE_A(PG8_SA(1, 1), a1, 1, false);
            PG8_WAIT_V(8); PG8_WAIT_L(0); PG8_BAR; PG8_MMA(0, 0, At, B0); PG8_MMA(0, 1, At, B1); PG8_BAR; PG8_SCHED;
            PG8_LDA(At, 0, 1); PG8_STAGE(PG8_SB(0, 0), b2, voffB); PG8_STAGE(PG8_SB(0, 1), b2 + hstep, voffB); PG8_STAGE_A(PG8_SA(0, 0), a2, 0, last);
            PG8_WAIT_V(8); PG8_WAIT_L(0); PG8_BAR; PG8_MMA(1, 0, At, B0); PG8_MMA(1, 1, At, B1); PG8_BAR; PG8_SCHED;
            PG8_LDB(B0, 1, 0); PG8_LDB(B1, 1, 1); PG8_SCHED; PG8_LDA(At, 1, 0); PG8_STAGE_A(PG8_SA(0, 1), a2, 1, last);
            PG8_WAIT_V(8); PG8_WAIT_L(0); PG8_BAR; PG8_MMA(0, 0, At, B0); PG8_MMA(0, 1, At, B1); PG8_BAR; PG8_SCHED;
            PG8_LDA(At, 1, 1); PG8_STAGE(PG8_SB(1, 0), b3, voffB); PG8_STAGE(PG8_SB(1, 1), b3 + hstep, voffB); PG8_STAGE_A(PG8_SA(1, 0), a3, 0, last);
            PG8_WAIT_V(8); PG8_WAIT_L(0); PG8_BAR; PG8_MMA(1, 0, At, B0); PG8_MMA(1, 1, At, B1); PG8_BAR; PG8_SCHED;
            } else {
            PG8_LDB(B0, 0, 0); PG8_SCHED; PG8_LDA(At, 0, 0); PG8_STAGE(PG8_SA(1, 1), a1 + hstep, voffA);
            PG8_WAIT_L(8); PG8_BAR; PG8_WAIT_L(0); PG8_MMA(0, 0, At, B0); PG8_BAR; PG8_SCHED;
            PG8_LDB(B1, 0, 1); PG8_STAGE(PG8_SB(0, 0), b2, voffB);
            PG8_BAR; PG8_WAIT_L(0); PG8_MMA(0, 1, At, B1); PG8_BAR;
            PG8_LDA(At, 0, 1); PG8_STAGE(PG8_SA(0, 0), a2, voffA);
            PG8_BAR; PG8_WAIT_L(0); PG8_MMA(1, 0, At, B0); PG8_BAR; PG8_SCHED;
            PG8_STAGE(PG8_SB(0, 1), b2 + hstep, voffB);
            PG8_WAIT_V(6); PG8_BAR; PG8_MMA(1, 1, At, B1); PG8_BAR;
            PG8_LDB(B0, 1, 0); PG8_SCHED; PG8_LDA(At, 1, 0); PG8_STAGE(PG8_SA(0, 1), a2 + hstep, voffA);
            PG8_WAIT_L(8); PG8_BAR; PG8_WAIT_L(0); PG8_MMA(0, 0, At, B0); PG8_BAR; PG8_SCHED;
            PG8_LDB(B1, 1, 1); PG8_STAGE(PG8_SB(1, 0), b3, voffB);
            PG8_BAR; PG8_WAIT_L(0); PG8_MMA(0, 1, At, B1); PG8_BAR;
            PG8_LDA(At, 1, 1); PG8_STAGE(PG8_SA(1, 0), a3, voffA);
            PG8_BAR; PG8_WAIT_L(0); PG8_MMA(1, 0, At, B0); PG8_BAR; PG8_SCHED;
            PG8_STAGE(PG8_SB(1, 1), b3 + hstep, voffB);
            PG8_WAIT_V(6); PG8_BAR; PG8_MMA(1, 1, At, B1); PG8_BAR;
            }
        }
        if constexpr (ALIGN_EPI) { if (wr == 0) PG8_BAR; }
        if constexpr (!Epi::AFTER_DRAIN) { E(acc, cur, wr, wc, fr, fq); S.done(cur); }
        if (!has_next) break;
#pragma unroll
        for (int a = 0; a < 2; ++a)
#pragma unroll
            for (int b = 0; b < 2; ++b)
#pragma unroll
                for (int m = 0; m < 4; ++m)
#pragma unroll
                    for (int n = 0; n < 2; ++n) acc[a][b][m][n] = (f32x4){0.f, 0.f, 0.f, 0.f};
        cur = nxt; cA = nA; cB = nB; ++ui;
        if constexpr (GATHER) { _Pragma("unroll") for (int h_ = 0; h_ < 2; ++h_) { cvo[h_][0] = nvo[h_][0]; cvo[h_][1] = nvo[h_][1]; } }
        if constexpr (ALIGN_EPI) { if (wr == 1) PG8_BAR; }
    }
    PG8_WAIT_V(0);
    if constexpr (!ALIGN_EPI) { if (wr == 0) PG8_BAR; }
    PG8_BAR;
    if constexpr (Epi::AFTER_DRAIN) { E.fused(acc, cur, wr, wc, fr, fq, lds, wid, lane); S.done(cur); }
#undef PG8_SA
#undef PG8_SB
#undef PG8_STAGE
#undef PG8_STAGE_A
#undef PG8_ROWS
#undef PG8_LDA
#undef PG8_LDB
#undef PG8_MMA
#undef PG8_WAIT_V
#undef PG8_WAIT_L
#undef PG8_BAR
#undef PG8_SCHED
}
}

constexpr int NWAVES = 8;
constexpr int NB = 8, SEQ = 4096, DM = 1024, MTOK = NB * SEQ, NLAYER = 2;
constexpr int INC = 2984, INCP = 3072;
constexpr int C_RET = 0, C_RW = 1024, C_DSA = 1920, C_SB = 2216;
constexpr int PBW = 1792, PFW = 1280, PB_SB = 1024, PF_DSA = 896;
constexpr int NEXP = 32, MOE_ROWS = MTOK * 4 + NEXP * 256;
constexpr int ROPE_W = 88;
constexpr int NCH = 16, TCH = SEQ / NCH;
constexpr int NPL = 11, NPHASE = 1 + NLAYER * NPL;
enum { I_X = 0, I_C, I_POS, I_ADAW, I_ADAB, I_NMIX, I_NFFN, I_WIN, I_RETGN, I_MU, I_W0, I_W2, I_A0, I_A2, I_G2, I_KK, I_KA, I_RK, I_LN, I_QNORM, I_WQ, I_WQI, I_DONORM, I_SONORM, I_WOUT, I_RW, I_RB, I_MW1, I_MB1, I_MW2, I_MB2, I_NFINAL, N_IN };

constexpr size_t MiB = 1u << 20;
constexpr size_t WS_CTL = 0, CTL_ZERO_BYTES = 1 * MiB;
constexpr size_t WS_MOD = 1 * MiB, WS_ROPE = 2 * MiB, WS_WIN = 14 * MiB, WS_WOUT = 26 * MiB, WS_W1 = 30 * MiB, WS_W2 = 286 * MiB;
constexpr size_t WS_XA = 414 * MiB, WS_H = 542 * MiB, WS_MIX = 606 * MiB, WS_TOPI = 670 * MiB, WS_TOPW = 671 * MiB, WS_POS = 672 * MiB;
constexpr size_t WS_R = 674 * MiB;
constexpr size_t WS_PB = WS_R  , WS_PF = WS_R + 112 * MiB  , WS_RWA = 946 * MiB  , WS_DQ = 1314 * MiB  , WS_DKB = 1330 * MiB  , WS_DVB = 1334 * MiB  , WS_DQI = 1346 * MiB  , WS_DKI = 1394 * MiB  , WS_DW = 1398 * MiB, WS_DQL = 1396 * MiB  ;
constexpr size_t WS_SMALLW = 1338 * MiB  ;
constexpr int SMW_QI = 0, SMW_W2 = 512 * 128, SMW_A2 = SMW_W2 + 256 * 32, SMW_G2 = SMW_A2 + 256 * 32, SMW_LAYER = SMW_G2 + 256 * 64;
constexpr size_t WS_PT = 1362 * MiB  ;
constexpr size_t WS_CH = WS_H  , WS_SI = WS_H + 16 * MiB  , WS_SIR = WS_H + 24 * MiB  ,
                 WS_CHR = WS_H + 32 * MiB  , WS_PTR = WS_H + 40 * MiB  ;
constexpr size_t WS_SQ = WS_MIX  , WS_SK = WS_MIX + 16 * MiB, WS_SV = WS_MIX + 32 * MiB;
constexpr size_t WS_YO = 1400 * MiB  , WS_SC = 1528 * MiB  ;
constexpr size_t WS_XS = WS_R  , WS_ACT = 946 * MiB  ;
constexpr size_t WS_LIST = 2040 * MiB  , WS_END = 2044 * MiB;
constexpr int LCAP = 32768;
static_assert((size_t)MOE_ROWS * 2048 <= 272 * MiB, "moe buffers");
constexpr int CW_TMO = 0, CW_CODE = 1, CW_GCNT = 256  , CW_DSAQ = 1024  , CW_BAR = 4096, CW_BLKCNT = 16384  ;
constexpr int RING_BYTES = 131072, MISC_OFF = RING_BYTES + 320, TST_OFF = RING_BYTES + 1024  , TAB_OFF = RING_BYTES + 2048  , HIST_OFF = RING_BYTES + 5120  , BASE_OFF = RING_BYTES + 5376  , CNT_OFF = RING_BYTES + 5632  , TEXP_OFF = RING_BYTES + 6144  , LDS_BYTES = 147456;

#if defined(__HIP_DEVICE_COMPILE__)
#define GAS __attribute__((address_space(1)))
#define CAS __attribute__((address_space(4)))
#else
#define GAS
#define CAS
#endif
#define LAS __attribute__((address_space(3)))
typedef unsigned short bf16;
typedef unsigned v4u __attribute__((ext_vector_type(4)));
typedef unsigned v2u __attribute__((ext_vector_type(2)));
typedef float f32x4 __attribute__((ext_vector_type(4)));
typedef GAS unsigned gu32;
typedef short bf16x8v __attribute__((ext_vector_type(8)));
typedef short s16x4v __attribute__((ext_vector_type(4)));
typedef _Float16 f16x8 __attribute__((ext_vector_type(8)));
#define RLX_AGENT __ATOMIC_RELAXED, __HIP_MEMORY_SCOPE_AGENT
#define LDS_WAIT() asm volatile("s_waitcnt lgkmcnt(0)" ::: "memory")
#define VM_WAIT() asm volatile("s_waitcnt vmcnt(0)" ::: "memory")
__device__ __forceinline__ unsigned f2bf(float f) { unsigned u = __builtin_bit_cast(unsigned, f); return (u + 0x7fffu + ((u >> 16) & 1u)) >> 16; }
__device__ __forceinline__ unsigned pk2_sw(float lo, float hi) { return f2bf(lo) | (f2bf(hi) << 16); }
__device__ __forceinline__ unsigned pk2(float lo, float hi) { unsigned r; asm("v_cvt_pk_bf16_f32 %0, %1, %2" : "=v"(r) : "v"(lo), "v"(hi)); return r; }
__device__ __forceinline__ float bf_lo(unsigned w) { return __builtin_bit_cast(float, w << 16); }
__device__ __forceinline__ float bf_hi(unsigned w) { return __builtin_bit_cast(float, w & 0xffff0000u); }
__device__ __forceinline__ float wave_sum(float v) {
#pragma unroll
    for (int o = 1; o < 64; o <<= 1) v += __shfl_xor(v, o);
    return v;
}
__device__ __forceinline__ float wave_max(float v) {
#pragma unroll
    for (int o = 1; o < 64; o <<= 1) v = fmaxf(v, __shfl_xor(v, o));
    return v;
}
__device__ __forceinline__ float grp16_sum(float v) { v += __shfl_xor(v, 1); v += __shfl_xor(v, 2); v += __shfl_xor(v, 4); v += __shfl_xor(v, 8); return v; }
__device__ __forceinline__ float grp8_sum(float v) { v += __shfl_xor(v, 1); v += __shfl_xor(v, 2); v += __shfl_xor(v, 4); return v; }
__device__ __forceinline__ float sum4(f32x4 a) { return (a.x + a.y) + (a.z + a.w); }
__device__ __forceinline__ float dot4(f32x4 a, f32x4 b) { return (a.x * b.x + a.y * b.y) + (a.z * b.z + a.w * b.w); }
__device__ __forceinline__ float fexp(float x) { return __builtin_amdgcn_exp2f(x * 1.4426950408889634f); }
__device__ __forceinline__ float sigm(float x) { return __builtin_amdgcn_rcpf(1.0f + fexp(-x)); }
__device__ __forceinline__ float softplusf(float x) { return fmaxf(x, 0.0f) + 0.6931471805599453f * __builtin_amdgcn_logf(1.0f + fexp(-fabsf(x))); }
__device__ __forceinline__ float ftanh(float x) { const float e = fexp(-2.0f * fabsf(x)); const float t = (1.0f - e) * __builtin_amdgcn_rcpf(1.0f + e); return x < 0.0f ? -t : t; }
__device__ __forceinline__ f32x4 shx4(f32x4 v, int m) { f32x4 r; r.x = __shfl_xor(v.x, m); r.y = __shfl_xor(v.y, m); r.z = __shfl_xor(v.z, m); r.w = __shfl_xor(v.w, m); return r; }

#define XB_TMO      128
#define XB_XCNT(j)  (256  + 64 * (j))
#define XB_XSUB(j)  (1280 + 64 * (j))
#define XB_XGEN(j)  (2304 + 64 * (j))
#define XB_TOP      3328
#define XB_TOPGEN   3392
#define XCD_BAR_WORDS 3456
#define XB_SPIN_CAP (1u << 18)

__device__ __forceinline__ unsigned xb_ld(unsigned* p)              { return __hip_atomic_load(p, __ATOMIC_RELAXED, __HIP_MEMORY_SCOPE_AGENT); }
__device__ __forceinline__ unsigned xb_add(unsigned* p, unsigned v) { return __hip_atomic_fetch_add(p, v, __ATOMIC_RELAXED, __HIP_MEMORY_SCOPE_AGENT); }
__device__ __forceinline__ unsigned xb_xcc_id() { return (unsigned)__builtin_amdgcn_s_getreg((3 << 11) | 20) & 0xFu; }
#define XB_SPIN(cond, bar) do { unsigned _sp = 0; while (cond) { __builtin_amdgcn_s_sleep(1); \
    if ((++_sp & 255u) == 0u) { if (xb_ld(&(bar)[XB_TMO])) break; if (_sp > XB_SPIN_CAP) { atomicAdd(&(bar)[XB_TMO], 1u); break; } } } } while (0)

struct XcdBarrier {
    unsigned* bar; unsigned x;
    volatile LAS unsigned* st;
};

__device__ __forceinline__ XcdBarrier xcd_barrier_post(unsigned* bar, volatile LAS unsigned* st, int xb_tid) {
    XcdBarrier b; b.bar = bar; b.x = xb_xcc_id(); b.st = st;
    if (xb_tid == 0) (void)xb_add(&bar[XB_XCNT(b.x)], 1u);
    return b;
}
__device__ __forceinline__ void xcd_barrier_complete(unsigned* bar, unsigned x, unsigned& nloc, unsigned& nx) {
    const unsigned G = gridDim.x * gridDim.y * gridDim.z;
    unsigned sum, cnt, mine, sp = 0u;
    for (;;) {
        sum = 0u; cnt = 0u; mine = 0u;
#pragma unroll
        for (unsigned j = 0; j < 16; ++j) { const unsigned c = xb_ld(&bar[XB_XCNT(j)]); sum += c; cnt += (c > 0u) ? 1u : 0u; mine = (j == x) ? c : mine; }
        if (sum == G) break;
        __builtin_amdgcn_s_sleep(1);
        if ((++sp & 255u) == 0u) { if (xb_ld(&bar[XB_TMO])) break; if (sp > XB_SPIN_CAP) { atomicAdd(&bar[XB_TMO], 1u); break; } }
    }
    nloc = mine > 0u ? mine : 1u; nx = cnt > 0u ? cnt : 1u;
}

__device__ __forceinline__ void xcd_barrier(const XcdBarrier& b, int xb_tid) {
    asm volatile("s_waitcnt vmcnt(0)" ::: "memory");
    __syncthreads();
    if (xb_tid == 0) {
        unsigned* bar = b.bar;
        __builtin_amdgcn_s_waitcnt(0);
        unsigned nloc = b.st[0], nx = b.st[1];
        if (nloc == 0u) { xcd_barrier_complete(bar, b.x, nloc, nx); b.st[0] = nloc; b.st[1] = nx; }
        const unsigned old = xb_add(&bar[XB_XSUB(b.x)], 1u);
        const unsigned gen = old / nloc;
        if (old + 1u == (gen + 1u) * nloc) {
            __builtin_amdgcn_fence(__ATOMIC_RELEASE, "agent");
            asm volatile("s_waitcnt vmcnt(0)" ::: "memory");
            const unsigned og = xb_add(&bar[XB_TOP], 1u);
            const unsigned tg = og / nx;
            if (og + 1u == (tg + 1u) * nx) xb_add(&bar[XB_TOPGEN], 1u);
            else XB_SPIN(xb_ld(&bar[XB_TOPGEN]) == tg, bar);
            __builtin_amdgcn_fence(__ATOMIC_ACQUIRE, "agent");
            xb_add(&bar[XB_XGEN(b.x)], 1u);
            asm volatile("s_waitcnt vmcnt(0)" ::: "memory");
        } else {
            XB_SPIN(xb_ld(&bar[XB_XGEN(b.x)]) == gen, bar);
            __builtin_amdgcn_fence(__ATOMIC_ACQUIRE, "agent");
            asm volatile("s_waitcnt vmcnt(0)" ::: "memory");
        }
    }
    __syncthreads();
}
struct ArgsH { const float* in[N_IN]; float* out; unsigned char* ws; double invf[44]; int ph_lo, ph_hi, li, pad; };
struct ArgsD { const GAS float* in[N_IN]; GAS float* out; GAS unsigned char* ws; double invf[44]; int ph_lo, ph_hi, li, pad; };
static_assert(sizeof(ArgsH) == sizeof(ArgsD), "args layout");
typedef const CAS ArgsD& ARef;
__device__ __forceinline__ const CAS ArgsD* kargs() {
#if defined(__HIP_DEVICE_COMPILE__)
    const CAS ArgsD* p = (const CAS ArgsD*)__builtin_amdgcn_kernarg_segment_ptr(); asm volatile("" : "+s"(p)); return p;
#else
    return nullptr;
#endif
}
struct WI { LAS unsigned char* lds; int tid, lane, wave, vcu, G, gw, NGW, bx; };
constexpr size_t RWA_STRIDE = (33 * MiB + 68 * 1024) / 4;
constexpr size_t YO_STRIDE = 32 * MiB / 4;

__device__ __forceinline__ int wave_sum_i(int v) {
#pragma unroll
    for (int o = 1; o < 64; o <<= 1) v += __shfl_xor(v, o);
    return v;
}
__device__ __forceinline__ void sincos_d(double ang, float& s, float& c) {
    const double q = __builtin_rint(ang * 0.63661977236758134308);
    double r = __builtin_fma(-q, 1.57079632679489661923, ang); r = __builtin_fma(-q, 6.123233995736766e-17, r);
    const double r2 = r * r;
    const double sp = r * (1.0 + r2 * (-1.0 / 6 + r2 * (1.0 / 120 + r2 * (-1.0 / 5040 + r2 * (1.0 / 362880 + r2 * (-1.0 / 39916800 + r2 * (1.0 / 6227020800.0)))))));
    const double cp = 1.0 + r2 * (-0.5 + r2 * (1.0 / 24 + r2 * (-1.0 / 720 + r2 * (1.0 / 40320 + r2 * (-1.0 / 3628800 + r2 * (1.0 / 479001600 + r2 * (-1.0 / 87178291200.0)))))));
    const int qi = ((int)q) & 3;
    const double ss = (qi == 0) ? sp : (qi == 1) ? cp : (qi == 2) ? -sp : -cp;
    const double cc = (qi == 0) ? cp : (qi == 1) ? -sp : (qi == 2) ? -cp : sp;
    s = (float)ss; c = (float)cc;
}

struct TrItem { const float* src; bf16* dst; int ldw; float scale; bool ok; };
__device__ __forceinline__ void tr_decode(ARef A, int it, int lane, TrItem& d) {
    constexpr int I_IN = NLAYER * 16 * 96, I_OUT = NLAYER * 16 * 32, I_W1 = NLAYER * NEXP * 16 * 64;
    const float* W; int ldw, nvalid, k0, nsrc0; bf16* WT; size_t dstrow0; float scale = 1.0f;
    int r = it;
    if (r < I_IN) { const int l = r / 1536, rr = r % 1536, kb = rr / 96, nb = rr % 96;
        const int nd = nb * 32;
        nsrc0 = (nd < 1024) ? nd : (nd < 1792) ? C_SB + (nd - 1024) : (nd < 2688) ? C_RW + (nd - 1792) : C_DSA + (nd - 2688);
        nvalid = (nd < 1024) ? 1024 : (nd < 1792) ? INC : (nd < 2688) ? C_DSA : ((nd < INC) ? C_SB : 0);
        scale = (nd >= 256 && nd < 512) ? 0.125f : (nd >= 1024 && nd < 1280) ? 0.18033688011112042f : 1.0f;
        W = A.in[I_WIN] + (size_t)l * DM * INC; ldw = INC; k0 = kb * 64; WT = (bf16*)(A.ws + WS_WIN) + (size_t)l * INCP * DM; dstrow0 = (size_t)nd; }
    else if (r < I_IN + I_OUT) { r -= I_IN; const int l = r / 512, rr = r % 512, kb = rr / 32, nb = rr % 32;
        W = A.in[I_WOUT] + (size_t)l * DM * DM; ldw = DM; nvalid = DM; k0 = kb * 64; nsrc0 = nb * 32; WT = (bf16*)(A.ws + WS_WOUT) + (size_t)l * DM * DM; dstrow0 = (size_t)nb * 32; }
    else if (r < I_IN + I_OUT + I_W1) { r -= I_IN + I_OUT; const int le = r / 1024, rr = r % 1024, kb = rr / 64, nb = rr % 64, j = nb >> 3, bj = (nb >> 2) & 1, cc0 = (nb & 3) * 32;
        W = A.in[I_MW1] + (size_t)le * DM * 2048; ldw = 2048; nvalid = 2048; k0 = kb * 64; nsrc0 = bj * 1024 + 128 * j + cc0; WT = (bf16*)(A.ws + WS_W1) + (size_t)le * 2048 * DM; dstrow0 = (size_t)nb * 32; }
    else { r -= I_IN + I_OUT + I_W1; const int le = r / 512, rr = r % 512, kb = rr / 32, nb = rr % 32;
        W = A.in[I_MW2] + (size_t)le * DM * DM; ldw = DM; nvalid = DM; k0 = kb * 64; nsrc0 = nb * 32; WT = (bf16*)(A.ws + WS_W2) + (size_t)le * DM * DM; dstrow0 = (size_t)nb * 32; }
    const int n = nsrc0 + 4 * (lane & 7);
    d.ok = n < nvalid; d.src = W + (size_t)(k0 + (lane >> 3)) * ldw + (d.ok ? n : 0); d.ldw = ldw; d.scale = scale;
    d.dst = WT + (dstrow0 + (lane >> 3)) * 1024 + k0 + 8 * (lane & 7);
}
__device__ __forceinline__ void tr_load(const TrItem& d, f32x4 (&v)[8]) {
#pragma unroll
    for (int i = 0; i < 8; ++i) v[i] = *(const f32x4*)(d.src + (size_t)(8 * i) * d.ldw);
}
__device__ __forceinline__ void tr_store(const TrItem& d, const f32x4 (&v)[8], LAS float* scr, int lane) {
    const float sc_ = d.ok ? d.scale : 0.0f;
#pragma unroll
    for (int i = 0; i < 8; ++i) { LAS float* s = scr + (8 * i + (lane >> 3)) * 33 + 4 * (lane & 7); s[0] = v[i].x * sc_; s[1] = v[i].y * sc_; s[2] = v[i].z * sc_; s[3] = v[i].w * sc_; }
    LDS_WAIT(); asm volatile("" ::: "memory");
    const int c8 = lane & 7;
#pragma unroll
    for (int j = 0; j < 4; ++j) { const int n = (lane >> 3) + 8 * j; const LAS float* s = scr + (8 * c8) * 33 + n;
        v4u o; o.x = pk2(s[0 * 33], s[1 * 33]); o.y = pk2(s[2 * 33], s[3 * 33]); o.z = pk2(s[4 * 33], s[5 * 33]); o.w = pk2(s[6 * 33], s[7 * 33]);
        *(v4u*)(d.dst + (size_t)(8 * j) * 1024) = o; }
    LDS_WAIT(); asm volatile("" ::: "memory");
}
__device__ __forceinline__ void ph_prologue(ARef A, const WI& w) {
    LAS float* sc = (LAS float*)w.lds;
    { const float* cin = A.in[I_C]; for (int i = w.tid; i < NB * DM; i += NWAVES * 64) { const float v = cin[i]; sc[i] = v / (1.0f + expf(-v)); } }
    __syncthreads();
    float* MOD = (float*)(A.ws + WS_MOD);
    LAS float* red = (LAS float*)(w.lds + 32768);
    if (w.vcu < 192) {
        const int l = w.vcu / 96, col = (w.vcu % 96) * 64 + w.lane, kw = 128 * w.wave;
        const float* wp = A.in[I_ADAW] + (size_t)l * DM * 6144 + (size_t)kw * 6144 + col;
        float acc[8];
#pragma unroll
        for (int b = 0; b < 8; ++b) acc[b] = 0.0f;
#pragma unroll 16
        for (int k = 0; k < 128; ++k) { const float wv = wp[(size_t)k * 6144];
#pragma unroll
            for (int b = 0; b < 8; ++b) acc[b] += sc[b * DM + kw + k] * wv; }
#pragma unroll
        for (int b = 0; b < 8; ++b) red[(w.wave * 8 + b) * 64 + w.lane] = acc[b];
    }
    __syncthreads();
    if (w.vcu < 192) { const int l = w.vcu / 96, b = w.wave, col = (w.vcu % 96) * 64 + w.lane;
        float s = A.in[I_ADAB][l * 6144 + col];
#pragma unroll
        for (int q = 0; q < 8; ++q) s += red[(q * 8 + b) * 64 + w.lane];
        MOD[(size_t)(l * 8 + b) * 6144 + col] = s; }
    __syncthreads();
    LAS float* scr = (LAS float*)(w.lds + 32768 + w.wave * 8448);
    constexpr int NIT = NLAYER * 16 * 96 + NLAYER * 16 * 32;
    { TrItem d0, d1; f32x4 va[8], vb[8];
      int it = w.gw; bool h0 = it < NIT;
      if (h0) { tr_decode(A, it, w.lane, d0); tr_load(d0, va); }
      while (h0) {
          it += w.NGW; const bool h1 = it < NIT;
          if (h1) { tr_decode(A, it, w.lane, d1); tr_load(d1, vb); }
          tr_store(d0, va, scr, w.lane);
          if (!h1) break;
          it += w.NGW; h0 = it < NIT;
          if (h0) { tr_decode(A, it, w.lane, d0); tr_load(d0, va); }
          tr_store(d1, vb, scr, w.lane);
      } }
    float* RT = (float*)(A.ws + WS_ROPE); const int* pos = (const int*)A.in[I_POS];
    for (int g = w.gw * 64 + w.lane; g < MTOK * 44; g += w.NGW * 64) {
        const int tok = g / 44, f = g % 44; int co, so;
        if (f < 32) { co = f; so = 32 + f; } else if (f < 40) { co = 64 + (f - 32); so = 72 + (f - 32); } else { co = 80 + (f - 40); so = 84 + (f - 40); }
        float s, c; sincos_d((double)pos[tok] * A.invf[f], s, c);
        RT[(size_t)tok * ROPE_W + co] = c; RT[(size_t)tok * ROPE_W + so] = s;
    }
}

__device__ __forceinline__ void moe_convert_chunk(ARef A, int l, int c, int lane, LAS float* scr) {
    constexpr int I0 = NLAYER * 16 * 96 + NLAYER * 16 * 32, I_W1 = NLAYER * NEXP * 16 * 64;
    const int it0 = (c < 8192) ? I0 + l * 32768 + 4 * c : I0 + I_W1 + l * 16384 + 4 * (c - 8192);
    TrItem d0, d1; f32x4 va[8], vb[8];
    tr_decode(A, it0, lane, d0); tr_load(d0, va);
    tr_decode(A, it0 + 1, lane, d1); tr_load(d1, vb);
    tr_store(d0, va, scr, lane);
    tr_decode(A, it0 + 2, lane, d0); tr_load(d0, va);
    tr_store(d1, vb, scr, lane);
    tr_decode(A, it0 + 3, lane, d1); tr_load(d1, vb);
    tr_store(d0, va, scr, lane);
    tr_store(d1, vb, scr, lane);
}

__device__ __forceinline__ void emit_h_row(const f32x4 (&v)[4], float rstd, const float* g, const float* sc, const float* sh, bf16* hrow, int lane) {
#pragma unroll
    for (int j = 0; j < 4; ++j) { const int k = 4 * (lane + 64 * j);
        const f32x4 gv = *(const f32x4*)(g + k), scv = *(const f32x4*)(sc + k), shv = *(const f32x4*)(sh + k);
        const f32x4 h = v[j] * rstd * gv * (1.0f + scv) + shv;
        v2u o; o.x = pk2(h.x, h.y); o.y = pk2(h.z, h.w); *(v2u*)(hrow + k) = o; }
}
__device__ __forceinline__ void small_weights_to_f16(ARef A, const WI& w) {
    { _Float16* SW = (_Float16*)(A.ws + WS_SMALLW);
      const int g0 = w.gw * 64 + w.lane, gs = w.NGW * 64;
      for (int l = 0; l < NLAYER; ++l) { _Float16* S = SW + (size_t)l * SMW_LAYER;
          const float* wq = A.in[I_WQ] + (size_t)l * 128 * 256; const float* wqi = A.in[I_WQI] + (size_t)l * 128 * 256;
          for (int e = g0; e < 256 * 128; e += gs) { const int n = e >> 7, k = e & 127; S[SMW_QI + e] = (_Float16)wq[k * 256 + n]; S[SMW_QI + 256 * 128 + e] = (_Float16)wqi[k * 256 + n]; }
          const float* w2 = A.in[I_W2] + (size_t)l * 32 * 256; const float* a2 = A.in[I_A2] + (size_t)l * 32 * 256; const float* g2 = A.in[I_G2] + (size_t)l * 64 * 256;
          for (int e = g0; e < 256 * 32; e += gs) { const int n = e >> 5, k = e & 31; S[SMW_W2 + e] = (_Float16)w2[k * 256 + n]; S[SMW_A2 + e] = (_Float16)a2[k * 256 + n]; }
          for (int e = g0; e < 256 * 64; e += gs) { const int n = e >> 6, k = e & 63; S[SMW_G2 + e] = (_Float16)g2[k * 256 + n]; } } }
}
__device__ __forceinline__ void ph_norm1(ARef A, const WI& w) {
    const float* MOD = (const float*)(A.ws + WS_MOD); bf16* H = (bf16*)(A.ws + WS_H);
    for (int m = w.gw; m < MTOK; m += w.NGW) {
        const float* xr = A.in[I_X] + (size_t)m * DM; f32x4 v[4]; float ss = 0.0f;
#pragma unroll
        for (int j = 0; j < 4; ++j) { v[j] = *(const f32x4*)(xr + 4 * (w.lane + 64 * j)); ss += dot4(v[j], v[j]); }
        ss = wave_sum(ss); const float rstd = 1.0f / sqrtf(ss * (1.0f / DM) + 1e-5f);
        const float* mb = MOD + (size_t)(m >> 12) * 6144;
        emit_h_row(v, rstd, A.in[I_NMIX], mb + 1024, mb, H + (size_t)m * DM, w.lane);
    }
}

typedef _Float16 h4v __attribute__((ext_vector_type(4)));
__device__ __forceinline__ f16x8 pack_f16x8(f32x4 a, f32x4 b) { f16x8 r; r[0] = (_Float16)a.x; r[1] = (_Float16)a.y; r[2] = (_Float16)a.z; r[3] = (_Float16)a.w; r[4] = (_Float16)b.x; r[5] = (_Float16)b.y; r[6] = (_Float16)b.z; r[7] = (_Float16)b.w; return r; }
#define RW_STB4(k_, val_) do { v2u w_; w_.x = pk2((val_).x, (val_).y); w_.y = pk2((val_).z, (val_).w); *(v2u*)((bf16*)(RWA + (k_) * RWA_STRIDE) + o) = w_; } while (0)
#ifndef RWKV_RKV_BF16
#define RWKV_RKV_BF16 1
#endif
#if RWKV_RKV_BF16
#define RW_ST_RKV(k_, val_) RW_STB4(k_, val_)
#else
#define RW_ST_RKV(k_, val_) (*(f32x4*)(RWA + (k_) * RWA_STRIDE + o) = (val_))
#endif
__device__ __forceinline__ f32x4 ldb4(const bf16* q) { const v2u x = *(const v2u*)q; return (f32x4){bf_lo(x.x), bf_hi(x.x), bf_lo(x.y), bf_hi(x.y)}; }
__device__ __forceinline__ void prep16_body(const bf16* __restrict__ P, float* __restrict__ RWA, const _Float16* __restrict__ SW, const float* __restrict__ RT, bf16* __restrict__ DQ, _Float16* __restrict__ DQI,
                                            bf16* __restrict__ DKB, bf16* __restrict__ DVB, _Float16* __restrict__ DKI, float* __restrict__ DW, _Float16* __restrict__ DQL, const float* __restrict__ mu, const float* __restrict__ qn,
                                            const float* __restrict__ w0p, const float* __restrict__ a0p, const float* __restrict__ kkp, const float* __restrict__ kap, const float* __restrict__ rkp, int m0, int lane_in, int part = 7) {
    int lane = lane_in; asm volatile("" : "+v"(lane));
    const int tk = lane & 15, q4 = lane >> 4, m = m0 + tk, t = m & (SEQ - 1);
    const bf16* pr = P + (size_t)m * PFW; const bf16* pp = pr - PFW; const bf16* pd = P + (size_t)m * PFW + PF_DSA;
    RT += (size_t)m * ROPE_W; const f32x4 zero4 = {0.f, 0.f, 0.f, 0.f};
    f16x8 bx[4], bc[4];
    { float ss = 0.0f; f32x4 c[4][2];
#pragma unroll
      for (int ks = 0; ks < 4; ++ks) { const int f0 = 32 * ks + 8 * q4;
          f32x4 x[2];
#pragma unroll
          for (int u = 0; u < 2; ++u) { const f32x4 z = ldb4(pr + 768 + f0 + 4 * u); const f32x4 p = t ? ldb4(pp + 768 + f0 + 4 * u) : zero4; x[u] = z + (p - z) * *(const f32x4*)(mu + 768 + f0 + 4 * u);
#pragma unroll
              for (int i = 0; i < 4; ++i) x[u][i] = (ks == 0) ? ftanh(x[u][i]) : (ks == 1) ? x[u][i] : sigm(x[u][i]); }
          bx[ks] = pack_f16x8(x[0], x[1]);
          c[ks][0] = ldb4(pd + f0); c[ks][1] = ldb4(pd + f0 + 4); ss += dot4(c[ks][0], c[ks][0]) + dot4(c[ks][1], c[ks][1]); }
      ss += __shfl_xor(ss, 16); ss += __shfl_xor(ss, 32);
      const float rstd = 1.0f / sqrtf(ss * (1.0f / 128.0f) + 1e-5f);
#pragma unroll
      for (int ks = 0; ks < 4; ++ks) { const int f0 = 32 * ks + 8 * q4; bc[ks] = pack_f16x8(c[ks][0] * rstd * *(const f32x4*)(qn + f0), c[ks][1] * rstd * *(const f32x4*)(qn + f0 + 4)); } }
    const _Float16* wrow = SW + (size_t)tk * 0;
    (void)wrow;
    const int arow = lane & 15;
    if (part & 1)
#pragma unroll 2
    for (int hd = 0; hd < 4; ++hd) {
        f32x4 fk[4], av[4]; float ssk = 0.0f;
#pragma unroll
        for (int j = 0; j < 4; ++j) { const int nb = 4 * hd + j, ch = 16 * nb + 4 * q4; const size_t o = (size_t)m * 256 + ch;
            const f16x8 aw = *(const f16x8*)(SW + SMW_W2 + (16 * nb + arow) * 32 + 8 * q4), aa = *(const f16x8*)(SW + SMW_A2 + (16 * nb + arow) * 32 + 8 * q4);
            const f16x8 ag0 = *(const f16x8*)(SW + SMW_G2 + (16 * nb + arow) * 64 + 8 * q4), ag1 = *(const f16x8*)(SW + SMW_G2 + (16 * nb + arow) * 64 + 32 + 8 * q4);
            const f32x4 cw = __builtin_amdgcn_mfma_f32_16x16x32_f16(aw, bx[0], *(const f32x4*)(w0p + ch), 0, 0, 0);
            const f32x4 ca = __builtin_amdgcn_mfma_f32_16x16x32_f16(aa, bx[1], *(const f32x4*)(a0p + ch), 0, 0, 0);
            f32x4 cg = __builtin_amdgcn_mfma_f32_16x16x32_f16(ag0, bx[2], zero4, 0, 0, 0); cg = __builtin_amdgcn_mfma_f32_16x16x32_f16(ag1, bx[3], cg, 0, 0, 0);
            f32x4 dec;
#pragma unroll
            for (int i = 0; i < 4; ++i) { dec[i] = fexp(-fexp(-softplusf(-cw[i]) - 0.5f)); av[j][i] = sigm(ca[i]); }
            *(f32x4*)(RWA + 1 * RWA_STRIDE + o) = dec; { v2u w_; w_.x = pk2_sw(cg.x, cg.y); w_.y = pk2_sw(cg.z, cg.w); *(v2u*)((bf16*)(RWA + 6 * RWA_STRIDE) + o) = w_; }
            { const f32x4 z = ldb4(pr + 256 + ch); const f32x4 p = t ? ldb4(pp + 256 + ch) : zero4; fk[j] = z + (p - z) * *(const f32x4*)(mu + 256 + ch); }
            const f32x4 kk = fk[j] * *(const f32x4*)(kkp + ch); ssk += dot4(kk, kk); }
        ssk += __shfl_xor(ssk, 16); ssk += __shfl_xor(ssk, 32);
        const float inrm = 1.0f / fmaxf(sqrtf(ssk), 1e-12f);
        f32x4 fr[4], km[4]; float bs = 0.0f;
#pragma unroll
        for (int j = 0; j < 4; ++j) { const int ch = 16 * (4 * hd + j) + 4 * q4;
            { const f32x4 z = ldb4(pr + ch); const f32x4 p = t ? ldb4(pp + ch) : zero4; fr[j] = z + (p - z) * *(const f32x4*)(mu + ch); }
            km[j] = fk[j] * (1.0f + (av[j] - 1.0f) * *(const f32x4*)(kap + ch)); bs += dot4(fr[j] * km[j], *(const f32x4*)(rkp + ch)); }
        bs += __shfl_xor(bs, 16); bs += __shfl_xor(bs, 32);
#pragma unroll
        for (int j = 0; j < 4; ++j) { const int ch = 16 * (4 * hd + j) + 4 * q4; const size_t o = (size_t)m * 256 + ch;
            f32x4 fv; { const f32x4 z = ldb4(pr + 512 + ch); const f32x4 p = t ? ldb4(pp + 512 + ch) : zero4; fv = z + (p - z) * *(const f32x4*)(mu + 512 + ch); }
            const f32x4 kk = fk[j] * *(const f32x4*)(kkp + ch) * inrm;
            RW_ST_RKV(0, fr[j]); RW_ST_RKV(2, km[j]); RW_ST_RKV(3, fv);
            *(f32x4*)(RWA + 4 * RWA_STRIDE + o) = -kk; *(f32x4*)(RWA + 5 * RWA_STRIDE + o) = kk * av[j]; { const f32x4 bo_ = bs * fv; RW_STB4(7, bo_); } }
    }
    if (part & 2) {
    f32x4 qlin[2] = {zero4, zero4};
#pragma unroll 4
    for (int nb = 0; nb < 32; ++nb) {
        f32x4 cq = zero4;
#pragma unroll
        for (int ks = 0; ks < 4; ++ks) { const f16x8 aq = *(const f16x8*)(SW + SMW_QI + (16 * nb + arow) * 128 + 32 * ks + 8 * q4); cq = __builtin_amdgcn_mfma_f32_16x16x32_f16(aq, bc[ks], cq, 0, 0, 0); }
        const int ch = 16 * (nb & 15) + 4 * q4;
        if (nb < 16) {
            if ((nb & 3) == 0) { const f32x4 ot = shx4(cq, 32); const int fi = 4 * (q4 & 1); const f32x4 cs4 = *(const f32x4*)(RT + 64 + fi), sn = *(const f32x4*)(RT + 72 + fi); cq = (q4 < 2) ? cq * cs4 - ot * sn : ot * sn + cq * cs4; }
            const f32x4 qs = cq * 0.18033688011112042f; v2u o; o.x = pk2(qs.x, qs.y); o.y = pk2(qs.z, qs.w); *(v2u*)(DQ + (size_t)m * 256 + ch) = o;
        } else {
            if ((nb & 1) == 0) { const f32x4 ot = shx4(cq, 16); const f32x4 cs4 = *(const f32x4*)(RT + 80), sn = *(const f32x4*)(RT + 84); if (q4 < 2) cq = (q4 < 1) ? cq * cs4 - ot * sn : ot * sn + cq * cs4; }
            h4v hq; hq.x = (_Float16)cq.x; hq.y = (_Float16)cq.y; hq.z = (_Float16)cq.z; hq.w = (_Float16)cq.w; *(h4v*)(DQI + (size_t)m * 256 + ch) = hq;
            const float wh = __builtin_bit_cast(float, (unsigned)pd[288 + ((nb - 16) >> 1)] << 16) * 0.03125f;
            qlin[nb & 1] += wh * (f32x4){(float)hq.x, (float)hq.y, (float)hq.z, (float)hq.w};
        }
    }
#pragma unroll
    for (int hf = 0; hf < 2; ++hf) { h4v hl; hl.x = (_Float16)qlin[hf].x; hl.y = (_Float16)qlin[hf].y; hl.z = (_Float16)qlin[hf].z; hl.w = (_Float16)qlin[hf].w; *(h4v*)(DQL + (size_t)m * 32 + 16 * hf + 4 * q4) = hl; }
    }
    if (part & 4) {
#pragma unroll
    for (int j = 0; j < 4; ++j) { const int d = 16 * j + 4 * q4; f32x4 kx = ldb4(pd + 128 + d);
        if (j == 0) { const f32x4 ot = shx4(kx, 32); const int fi = 4 * (q4 & 1); const f32x4 cs4 = *(const f32x4*)(RT + 64 + fi), sn = *(const f32x4*)(RT + 72 + fi); kx = (q4 < 2) ? kx * cs4 - ot * sn : ot * sn + kx * cs4; }
        v2u o; o.x = pk2(kx.x, kx.y); o.y = pk2(kx.z, kx.w); *(v2u*)(DKB + (size_t)m * 64 + d) = o;
        const f32x4 vx = ldb4(pd + 192 + d); v2u ov; ov.x = pk2(vx.x, vx.y); ov.y = pk2(vx.z, vx.w); *(v2u*)(DVB + (size_t)m * 64 + d) = ov; }
#pragma unroll
    for (int j = 0; j < 2; ++j) { const int d = 16 * j + 4 * q4; f32x4 ki = ldb4(pd + 256 + d);
        if (j == 0) { const f32x4 ot = shx4(ki, 16); const f32x4 cs4 = *(const f32x4*)(RT + 80), sn = *(const f32x4*)(RT + 84); if (q4 < 2) ki = (q4 < 1) ? ki * cs4 - ot * sn : ot * sn + ki * cs4; }
        h4v hk; hk.x = (_Float16)ki.x; hk.y = (_Float16)ki.y; hk.z = (_Float16)ki.z; hk.w = (_Float16)ki.w; *(h4v*)(DKI + (size_t)m * 32 + d) = hk; }
    if (q4 < 2) *(f32x4*)(DW + (size_t)m * 8 + 4 * q4) = ldb4(pd + 288 + 4 * q4) * 0.0625f;
    }
}

__device__ __forceinline__ void prep16(ARef A, int l, int m0, int lane_in, int part = 7) {
    prep16_body((const bf16*)(A.ws + WS_PF), (float*)(A.ws + WS_RWA), (const _Float16*)(A.ws + WS_SMALLW) + (size_t)l * SMW_LAYER, (const float*)(A.ws + WS_ROPE), (bf16*)(A.ws + WS_DQ), (_Float16*)(A.ws + WS_DQI),
                (bf16*)(A.ws + WS_DKB), (bf16*)(A.ws + WS_DVB), (_Float16*)(A.ws + WS_DKI), (float*)(A.ws + WS_DW), (_Float16*)(A.ws + WS_DQL), A.in[I_MU] + l * 896, A.in[I_QNORM] + l * 128,
                A.in[I_W0] + l * 256, A.in[I_A0] + l * 256, A.in[I_KK] + l * 256, A.in[I_KA] + l * 256, A.in[I_RK] + l * 256, m0, lane_in, part);
}
__device__ __forceinline__ float quad_sum(float v) {
    v += __builtin_bit_cast(float, __builtin_amdgcn_mov_dpp(__builtin_bit_cast(int, v), 0xB1, 0xF, 0xF, true));
    v += __builtin_bit_cast(float, __builtin_amdgcn_mov_dpp(__builtin_bit_cast(int, v), 0x4E, 0xF, 0xF, true));
    return v;
}
__device__ __forceinline__ float oct_sum(float v) {
    v += __builtin_bit_cast(float, __builtin_amdgcn_mov_dpp(__builtin_bit_cast(int, v), 0xB1, 0xF, 0xF, true));
    v += __builtin_bit_cast(float, __builtin_amdgcn_mov_dpp(__builtin_bit_cast(int, v), 0x4E, 0xF, 0xF, true));
    v += __builtin_bit_cast(float, __builtin_amdgcn_mov_dpp(__builtin_bit_cast(int, v), 0x141, 0xF, 0xF, true));
    return v;
}
typedef float f32x2 __attribute__((ext_vector_type(2)));
#define LO2(v_) __builtin_shufflevector(v_, v_, 0, 1)
#define HI2(v_) __builtin_shufflevector(v_, v_, 2, 3)
#define RW_ROW(i_) (((i_) < 2) ? (16 * ws + rg + 8 * (i_)) : (64 + 16 * ws + rg + 8 * ((i_) - 2)))
#define RW_LOAD(op, s_) do { const int lo_ = (s_) * 64 + kq * 8; \
    op[0] = *(const LAS f32x4*)(sn + lo_); op[1] = *(const LAS f32x4*)(sn + lo_ + 4); op[2] = *(const LAS f32x4*)(sw + lo_); op[3] = *(const LAS f32x4*)(sw + lo_ + 4); \
    op[4] = *(const LAS f32x4*)(sb + lo_); op[5] = *(const LAS f32x4*)(sb + lo_ + 4); op[6] = *(const LAS f32x4*)(sk + lo_); op[7] = *(const LAS f32x4*)(sk + lo_ + 4); \
    op[8] = *(const LAS f32x4*)(sr + lo_); op[9] = *(const LAS f32x4*)(sr + lo_ + 4); \
    vin[0] = sv[(s_) * 64 + 16 * ws + rg]; vin[1] = sv[(s_) * 64 + 16 * ws + rg + 8]; } while (0)
#define RW_DOT(i_, oa, ob) ({ f32x2 d_ = S[i_][0] * LO2(oa); d_ = S[i_][1] * HI2(oa) + d_; d_ = S[i_][2] * LO2(ob) + d_; d_ = S[i_][3] * HI2(ob) + d_; d_.x + d_.y; })
#define RW_STEP(op, vv, s_) do { float sa_[4], y_[4]; \
    _Pragma("unroll") for (int i_ = 0; i_ < 4; ++i_) sa_[i_] = RW_DOT(i_, op[0], op[1]); \
    _Pragma("unroll") for (int i_ = 0; i_ < 4; ++i_) sa_[i_] += __builtin_bit_cast(float, __builtin_amdgcn_mov_dpp(__builtin_bit_cast(int, sa_[i_]), 0xB1, 0xF, 0xF, true)); \
    _Pragma("unroll") for (int i_ = 0; i_ < 4; ++i_) sa_[i_] += __builtin_bit_cast(float, __builtin_amdgcn_mov_dpp(__builtin_bit_cast(int, sa_[i_]), 0x4E, 0xF, 0xF, true)); \
    _Pragma("unroll") for (int i_ = 0; i_ < 4; ++i_) sa_[i_] += __builtin_bit_cast(float, __builtin_amdgcn_mov_dpp(__builtin_bit_cast(int, sa_[i_]), 0x141, 0xF, 0xF, true)); \
    _Pragma("unroll") for (int i_ = 0; i_ < 2; ++i_) { const f32x2 a2_ = {sa_[i_], sa_[i_]}, v2_ = {vv[i_], vv[i_]}; \
        S[i_][0] = S[i_][0] * LO2(op[2]) + (a2_ * LO2(op[4]) + v2_ * LO2(op[6])); S[i_][1] = S[i_][1] * HI2(op[2]) + (a2_ * HI2(op[4]) + v2_ * HI2(op[6])); \
        S[i_][2] = S[i_][2] * LO2(op[3]) + (a2_ * LO2(op[5]) + v2_ * LO2(op[7])); S[i_][3] = S[i_][3] * HI2(op[3]) + (a2_ * HI2(op[5]) + v2_ * HI2(op[7])); } \
    _Pragma("unroll") for (int i_ = 2; i_ < 4; ++i_) { const f32x2 a2_ = {sa_[i_], sa_[i_]}; \
        S[i_][0] = S[i_][0] * LO2(op[2]) + a2_ * LO2(op[4]); S[i_][1] = S[i_][1] * HI2(op[2]) + a2_ * HI2(op[4]); S[i_][2] = S[i_][2] * LO2(op[3]) + a2_ * LO2(op[5]); S[i_][3] = S[i_][3] * HI2(op[3]) + a2_ * HI2(op[5]); } \
    _Pragma("unroll") for (int i_ = 0; i_ < 4; ++i_) y_[i_] = RW_DOT(i_, op[8], op[9]); \
    _Pragma("unroll") for (int i_ = 0; i_ < 4; ++i_) y_[i_] += __builtin_bit_cast(float, __builtin_amdgcn_mov_dpp(__builtin_bit_cast(int, y_[i_]), 0xB1, 0xF, 0xF, true)); \
    _Pragma("unroll") for (int i_ = 0; i_ < 4; ++i_) y_[i_] += __builtin_bit_cast(float, __builtin_amdgcn_mov_dpp(__builtin_bit_cast(int, y_[i_]), 0x4E, 0xF, 0xF, true)); \
    _Pragma("unroll") for (int i_ = 0; i_ < 4; ++i_) y_[i_] += __builtin_bit_cast(float, __builtin_amdgcn_mov_dpp(__builtin_bit_cast(int, y_[i_]), 0x141, 0xF, 0xF, true)); \
    { const unsigned p01_ = pk2(y_[0], y_[1]), p23_ = pk2(y_[2], y_[3]);        \
      if (kq == 0) { so[(s_) * 128 + RW_ROW(0)] = (bf16)(p01_ & 0xffffu); so[(s_) * 128 + RW_ROW(1)] = (bf16)(p01_ >> 16); so[(s_) * 128 + RW_ROW(2)] = (bf16)(p23_ & 0xffffu); so[(s_) * 128 + RW_ROW(3)] = (bf16)(p23_ >> 16); } } } while (0)
__device__ __forceinline__ void wg4_barrier(LAS unsigned* cnt, unsigned& epoch, int lane) {
    LDS_WAIT(); asm volatile("" ::: "memory");
    epoch += 4u;
    if (lane == 0) __hip_atomic_fetch_add((unsigned*)cnt, 1u, __ATOMIC_RELAXED, __HIP_MEMORY_SCOPE_WORKGROUP);
    for (;;) { const unsigned v = __builtin_amdgcn_readfirstlane(__hip_atomic_load((unsigned*)cnt, __ATOMIC_RELAXED, __HIP_MEMORY_SCOPE_WORKGROUP)); if ((int)(v - epoch) >= 0) break; __builtin_amdgcn_s_sleep(1); }
    asm volatile("" ::: "memory");
}
__device__ __forceinline__ void scan_rwkv_task1(ARef A, const WI& w, int task, LAS unsigned* bcnt, unsigned& epoch) {
    const int ws = w.wave & 3, lt = w.tid & 255;
    const int bh = task >> 4, c = task & 15, b = bh >> 2, h = bh & 3;
    LAS float* sw = (LAS float*)w.lds; LAS float* sn = sw + 2048; LAS float* sb = sn + 2048; LAS float* sk = sb + 2048; LAS float* sr = sk + 2048; LAS float* sv = sr + 2048; LAS bf16* so = (LAS bf16*)(sv + 2048);
    const float* RWA = (const float*)(A.ws + WS_RWA);
    const int rg = w.lane >> 3, kq = w.lane & 7;
    f32x2 S[4][4];
#pragma unroll
    for (int i = 0; i < 4; ++i)
#pragma unroll
        for (int j = 0; j < 4; ++j) { const int r = RW_ROW(i); S[i][j].x = (r >= 64 && 8 * kq + 2 * j == r - 64) ? 1.0f : 0.0f; S[i][j].y = (r >= 64 && 8 * kq + 2 * j + 1 == r - 64) ? 1.0f : 0.0f; }
    const size_t tok0 = (size_t)b * SEQ + (size_t)c * TCH;
    const int st = lt >> 3, sd = (lt & 7) * 8;
#if RWKV_RKV_BF16
    f32x4 a[3][2]; v4u ab[3];
#define RW_LD_RKV(i_, k_) ab[i_] = *(const v4u*)((const bf16*)(RWA + (k_) * RWA_STRIDE) + o_)
#define RW_GET_RKV(i_, q_) RW_UNPK(ab[i_], q_)
#else
    f32x4 a[3][2]; f32x4 af[3][2];
#define RW_LD_RKV(i_, k_) do { af[i_][0] = *(const f32x4*)(RWA + (k_) * RWA_STRIDE + o_); af[i_][1] = *(const f32x4*)(RWA + (k_) * RWA_STRIDE + o_ + 4); } while (0)
#define RW_GET_RKV(i_, q_) af[i_][q_]
#endif
#define RW_GLOAD(sub_) do { const size_t o_ = (tok0 + (sub_) * 32 + st) * 256 + h * 64 + sd; \
        _Pragma("unroll") for (int q = 0; q < 2; ++q) { a[0][q] = *(const f32x4*)(RWA + 1 * RWA_STRIDE + o_ + 4 * q); a[1][q] = *(const f32x4*)(RWA + 4 * RWA_STRIDE + o_ + 4 * q); a[2][q] = *(const f32x4*)(RWA + 5 * RWA_STRIDE + o_ + 4 * q); } \
        RW_LD_RKV(0, 2); RW_LD_RKV(1, 0); RW_LD_RKV(2, 3); } while (0)
#define RW_UNPK(x_, q_) ((q_) == 0 ? (f32x4){bf_lo((x_).x), bf_hi((x_).x), bf_lo((x_).y), bf_hi((x_).y)} : (f32x4){bf_lo((x_).z), bf_hi((x_).z), bf_lo((x_).w), bf_hi((x_).w)})
    RW_GLOAD(0);
#define RW_WRITEOUT(sub_) do { const int fs = lt >> 3, c16 = (lt & 7) * 16; \
          bf16* dst = (c16 < 64) ? (bf16*)((float*)(A.ws + WS_YO) + YO_STRIDE) : ((bf16*)(A.ws + WS_PT) - 64);        \
          bf16* dp = dst + (tok0 + (sub_) * 32 + fs) * 256 + h * 64 + c16; \
          _Pragma("unroll") for (int q = 0; q < 2; ++q) *(v4u*)(dp + 8 * q) = *(const LAS v4u*)(so + fs * 128 + c16 + 8 * q); } while (0)
    for (int sub = 0; sub < TCH / 32; ++sub) {
        wg4_barrier(bcnt, epoch, w.lane);
        if (sub > 0) RW_WRITEOUT(sub - 1);
        { const int lo = st * 64 + sd;
#pragma unroll
          for (int q = 0; q < 2; ++q) { *(LAS f32x4*)(sw + lo + 4 * q) = a[0][q]; *(LAS f32x4*)(sn + lo + 4 * q) = a[1][q]; *(LAS f32x4*)(sb + lo + 4 * q) = a[2][q]; *(LAS f32x4*)(sk + lo + 4 * q) = RW_GET_RKV(0, q); *(LAS f32x4*)(sr + lo + 4 * q) = RW_GET_RKV(1, q); *(LAS f32x4*)(sv + lo + 4 * q) = RW_GET_RKV(2, q); } }
        wg4_barrier(bcnt, epoch, w.lane);
        if (sub + 1 < TCH / 32) RW_GLOAD(sub + 1);
        { f32x4 opA[10], opB[10]; float vin[2], vA[2], vB[2];
          RW_LOAD(opA, 0);
          vA[0] = vin[0]; vA[1] = vin[1];
#pragma unroll 1
          for (int s = 0; s < 32; s += 2) {
              RW_LOAD(opB, s + 1);
              vB[0] = vin[0]; vB[1] = vin[1];
              RW_STEP(opA, vA, s);
              if (s + 2 < 32) { RW_LOAD(opA, s + 2); vA[0] = vin[0]; vA[1] = vin[1]; }
              RW_STEP(opB, vB, s + 1);
          } }
    }
    wg4_barrier(bcnt, epoch, w.lane);
    RW_WRITEOUT(TCH / 32 - 1);
#undef RW_WRITEOUT
    { float* ch = (float*)(A.ws + WS_CH) + ((size_t)(bh * NCH + c) * 128) * 64 + 8 * kq;
#pragma unroll
      for (int i = 0; i < 4; ++i) { float* cr = ch + (size_t)RW_ROW(i) * 64; *(f32x4*)cr = (f32x4){S[i][0].x, S[i][0].y, S[i][1].x, S[i][1].y}; *(f32x4*)(cr + 4) = (f32x4){S[i][2].x, S[i][2].y, S[i][3].x, S[i][3].y}; } }
    wg4_barrier(bcnt, epoch, w.lane);
}
#undef RW_LOAD
#undef RW_STEP
#undef RW_GLOAD
#undef RW_UNPK
#undef RW_LD_RKV
#undef RW_GET_RKV
#undef RW_DOT
#undef RW_ROW
__device__ __forceinline__ void scan_ret_task(ARef A, const WI& w, int task) {
    const int bh = task >> 3, cp = task & 7, b = bh >> 2, h = bh & 3, un = w.tid >> 8, lt = w.tid & 255, c = 2 * cp + un;
    const float lg2g = log2f(1.0f - exp2f(-5.0f - (float)h)), gamma = exp2f(lg2g);
    LAS float* sk = (LAS float*)w.lds + un * 8192; LAS float* sq = sk + 2048; LAS float* sv = sq + 2048; LAS float* so = sv + 2048;
    const bf16* PB = (const bf16*)(A.ws + WS_PB); const float* RT = (const float*)(A.ws + WS_ROPE);
    const int row = lt >> 2, kq = lt & 3;
    f32x2 S[8];
#pragma unroll
    for (int j = 0; j < 8; ++j) S[j] = (f32x2){0.0f, 0.0f};
    const f32x2 gam2 = {gamma, gamma};
    const size_t tok0 = (size_t)b * SEQ + (size_t)c * TCH;
    const int st = lt >> 3, sd = (lt & 7) * 8;
    const int fi = sd & 31, dp = sd ^ 32;
    f32x4 gq[2], gqo[2], gk[2], gko[2], gv[2], gcs[2], gsn[2];
#define BF8_TO_F32(dst, x_) do { dst[0] = (f32x4){bf_lo(x_.x), bf_hi(x_.x), bf_lo(x_.y), bf_hi(x_.y)}; dst[1] = (f32x4){bf_lo(x_.z), bf_hi(x_.z), bf_lo(x_.w), bf_hi(x_.w)}; } while (0)
#define RT_GLOAD(sub_) do { const size_t m_ = tok0 + (sub_) * 32 + st; const bf16* pr_ = PB + m_ * PBW + h * 64; const float* rt_ = RT + m_ * ROPE_W; \
        _Pragma("unroll") for (int u = 0; u < 2; ++u) { gcs[u] = *(const f32x4*)(rt_ + fi + 4 * u); gsn[u] = *(const f32x4*)(rt_ + 32 + fi + 4 * u); } \
        { const v4u x0 = *(const v4u*)(pr_ + sd), x1 = *(const v4u*)(pr_ + dp), x2 = *(const v4u*)(pr_ + 256 + sd), x3 = *(const v4u*)(pr_ + 256 + dp), x4 = *(const v4u*)(pr_ + 512 + sd); \
          BF8_TO_F32(gq, x0); BF8_TO_F32(gqo, x1); BF8_TO_F32(gk, x2); BF8_TO_F32(gko, x3); BF8_TO_F32(gv, x4); } } while (0)
    RT_GLOAD(0);
    for (int sub = 0; sub < TCH / 32; ++sub) {
        const size_t m = tok0 + sub * 32 + st;
        f32x4 qn[2], kn[2], vn[2];
#pragma unroll
        for (int u = 0; u < 2; ++u) { qn[u] = (sd < 32) ? gq[u] * gcs[u] - gqo[u] * gsn[u] : gqo[u] * gsn[u] + gq[u] * gcs[u]; kn[u] = (sd < 32) ? gk[u] * gcs[u] - gko[u] * gsn[u] : gko[u] * gsn[u] + gk[u] * gcs[u]; vn[u] = gv[u]; }
        { const float gt = exp2f(lg2g * (float)(sub * 32 + st + 1)); const f32x4 p0 = qn[0] * gt, p1 = qn[1] * gt;
          v4u pw; pw.x = pk2(p0.x, p0.y); pw.y = pk2(p0.z, p0.w); pw.z = pk2(p1.x, p1.y); pw.w = pk2(p1.z, p1.w); *(v4u*)((bf16*)(A.ws + WS_PTR) + m * 256 + h * 64 + sd) = pw; }
        __syncthreads();
        { const int lo = st * 64 + sd; *(LAS f32x4*)(sq + lo) = qn[0]; *(LAS f32x4*)(sq + lo + 4) = qn[1]; *(LAS f32x4*)(sk + lo) = kn[0]; *(LAS f32x4*)(sk + lo + 4) = kn[1]; *(LAS f32x4*)(sv + lo) = vn[0]; *(LAS f32x4*)(sv + lo + 4) = vn[1]; }
        __syncthreads();
        if (sub + 1 < TCH / 32) RT_GLOAD(sub + 1);
#define RT_LOAD(kvA, rvA, vA, s_) do { const int lo_ = (s_) * 64 + kq * 16; _Pragma("unroll") for (int j4 = 0; j4 < 4; ++j4) { kvA[j4] = *(const LAS f32x4*)(sk + lo_ + 4 * j4); rvA[j4] = *(const LAS f32x4*)(sq + lo_ + 4 * j4); } vA = sv[(s_) * 64 + row]; } while (0)
#define RT_STEP(kvA, rvA, vA, s_) do { const f32x2 v2 = {vA, vA}; f32x2 y2 = {0.0f, 0.0f}; \
            _Pragma("unroll") for (int j4 = 0; j4 < 4; ++j4) { S[2 * j4] = S[2 * j4] * gam2 + v2 * LO2(kvA[j4]); S[2 * j4 + 1] = S[2 * j4 + 1] * gam2 + v2 * HI2(kvA[j4]); \
                y2 = S[2 * j4] * LO2(rvA[j4]) + y2; y2 = S[2 * j4 + 1] * HI2(rvA[j4]) + y2; } \
            const float y = quad_sum(y2.x + y2.y); if (kq == 0) so[(s_) * 64 + row] = y; } while (0)
        { f32x4 kA[4], rA[4], kB[4], rB[4]; float vA, vB;
          RT_LOAD(kA, rA, vA, 0);
#pragma unroll 1
          for (int s = 0; s < 32; s += 2) {
              RT_LOAD(kB, rB, vB, s + 1);
              RT_STEP(kA, rA, vA, s);
              if (s + 2 < 32) RT_LOAD(kA, rA, vA, s + 2);
              RT_STEP(kB, rB, vB, s + 1);
          } }
#undef RT_LOAD
#undef RT_STEP
        __syncthreads();
        { const int fs = lt >> 3, c8 = (lt & 7) * 8; bf16* dp2 = (bf16*)(A.ws + WS_YO) + (tok0 + sub * 32 + fs) * 256 + h * 64 + c8;
          const f32x4 x0 = *(const LAS f32x4*)(so + fs * 64 + c8), x1 = *(const LAS f32x4*)(so + fs * 64 + c8 + 4);
          v4u wv; wv.x = pk2(x0.x, x0.y); wv.y = pk2(x0.z, x0.w); wv.z = pk2(x1.x, x1.y); wv.w = pk2(x1.z, x1.w); *(v4u*)dp2 = wv; }
    }
    { float* ch = (float*)(A.ws + WS_CHR) + ((size_t)(bh * NCH + c) * 64 + row) * 64 + 16 * kq;
#pragma unroll
      for (int j4 = 0; j4 < 4; ++j4) *(f32x4*)(ch + 4 * j4) = (f32x4){S[2 * j4].x, S[2 * j4].y, S[2 * j4 + 1].x, S[2 * j4 + 1].y}; }
    __syncthreads();
}
#undef RT_GLOAD
#undef BF8_TO_F32
__device__ __forceinline__ void prefix_chain(ARef A, const WI& w, int bh) {
    LAS float* s0 = (LAS float*)w.lds;
    const int v = w.tid >> 3, k8 = (w.tid & 7) * 8;
    const float* CH = (const float*)(A.ws + WS_CH) + (size_t)bh * NCH * 128 * 64; float* SI = (float*)(A.ws + WS_SI) + (size_t)bh * NCH * 64 * 64;
    f32x4 c0 = {0.f, 0.f, 0.f, 0.f}, c1 = {0.f, 0.f, 0.f, 0.f};
    for (int c = 0; c < NCH; ++c) {
        *(f32x4*)(SI + ((size_t)c * 64 + v) * 64 + k8) = c0; *(f32x4*)(SI + ((size_t)c * 64 + v) * 64 + k8 + 4) = c1;
        if (c == NCH - 1) break;
        __syncthreads();
        *(LAS f32x4*)(s0 + v * 68 + k8) = c0; *(LAS f32x4*)(s0 + v * 68 + k8 + 4) = c1;
        __syncthreads();
        const float* ch = CH + (size_t)c * 128 * 64;
        f32x4 n0 = *(const f32x4*)(ch + (size_t)v * 64 + k8), n1 = *(const f32x4*)(ch + (size_t)v * 64 + k8 + 4);
#pragma unroll 8
        for (int kp = 0; kp < 64; ++kp) { const float s = s0[v * 68 + kp]; const float* pr = ch + (size_t)(64 + kp) * 64 + k8; n0 += s * *(const f32x4*)pr; n1 += s * *(const f32x4*)(pr + 4); }
        c0 = n0; c1 = n1;
    }
    const int h = bh & 3; const float gT = exp2f((float)TCH * log2f(1.0f - exp2f(-5.0f - (float)h)));
    const float* CHR = (const float*)(A.ws + WS_CHR) + (size_t)bh * NCH * 64 * 64; float* SIR = (float*)(A.ws + WS_SIR) + (size_t)bh * NCH * 64 * 64;
    c0 = (f32x4){0.f, 0.f, 0.f, 0.f}; c1 = c0;
    for (int c = 0; c < NCH; ++c) {
        *(f32x4*)(SIR + ((size_t)c * 64 + v) * 64 + k8) = c0; *(f32x4*)(SIR + ((size_t)c * 64 + v) * 64 + k8 + 4) = c1;
        if (c == NCH - 1) break;
        c0 = c0 * gT + *(const f32x4*)(CHR + ((size_t)c * 64 + v) * 64 + k8); c1 = c1 * gT + *(const f32x4*)(CHR + ((size_t)c * 64 + v) * 64 + k8 + 4);
    }
    __syncthreads();
}
typedef float f32x16 __attribute__((ext_vector_type(16)));
constexpr int SBV_PITCH = 144;
__device__ __forceinline__ float lane32_swap(float v) { return __shfl_xor(v, 32); }
__device__ __forceinline__ void sb_tile_mfma(ARef A, int unit, int lane_in, LAS unsigned char* vl) {
    int lane = lane_in; asm volatile("" : "+v"(lane));
    const int tq = unit & 127, bh = unit >> 7, b = bh >> 2, h = bh & 3, t0 = tq * 32, r32 = lane & 31, hi = lane >> 5;
    const bf16* PS = (const bf16*)(A.ws + WS_PB) + (size_t)b * SEQ * PBW + PB_SB + h * 64;
    bf16x8v qf[4];
#pragma unroll
    for (int ks = 0; ks < 4; ++ks) qf[ks] = *(const bf16x8v*)(PS + (size_t)(t0 + r32) * PBW + 16 * ks + 8 * hi);
    f32x16 o0, o1;
#pragma unroll
    for (int r = 0; r < 16; ++r) { o0[r] = 0.0f; o1[r] = 0.0f; }
    float carry = 0.0f;
    const int g16 = lane >> 4, tj = (lane & 15) >> 2, tc = lane & 3;
    v4u vn[4]; bf16x8v kn[4];
#define SB_FETCH(kb_) do { _Pragma("unroll") for (int i = 0; i < 4; ++i) { const int p = lane + 64 * i, row = p >> 3, ch = p & 7; vn[i] = *(const v4u*)(PS + 512 + (size_t)((kb_) + row) * PBW + 8 * ch); } \
        _Pragma("unroll") for (int ks = 0; ks < 4; ++ks) kn[ks] = *(const bf16x8v*)(PS + 256 + (size_t)((kb_) + r32) * PBW + 16 * ks + 8 * hi); } while (0)
    SB_FETCH(t0);
    for (int kb0 = t0; kb0 >= 0; kb0 -= 32) {
#pragma unroll
        for (int i = 0; i < 4; ++i) { const int p = lane + 64 * i, row = p >> 3, ch = p & 7; *(LAS v4u*)(vl + row * SBV_PITCH + 16 * ch) = vn[i]; }
        f32x16 st;
#pragma unroll
        for (int r = 0; r < 16; ++r) st[r] = 0.0f;
        { bf16x8v ka[4];
#pragma unroll
          for (int ks = 0; ks < 4; ++ks) ka[ks] = kn[ks];
          if (kb0 >= 32) SB_FETCH(kb0 - 32);
#pragma unroll
          for (int ks = 0; ks < 4; ++ks) st = __builtin_amdgcn_mfma_f32_32x32x16_bf16(ka[ks], qf[ks], st, 0, 0, 0);
          asm volatile("" :: "v"(ka[0]), "v"(ka[1]), "v"(ka[2]), "v"(ka[3]), "v"(st)); }
        float sp[16]; const bool diag = (kb0 == t0);
#pragma unroll
        for (int r = 0; r < 16; ++r) { const float zl = st[r]; float s = (zl > 30.0f) ? zl : __builtin_amdgcn_logf(1.0f + __builtin_amdgcn_exp2f(zl));
            if (diag && ((r & 3) + 8 * (r >> 2) + 4 * hi >= r32)) s = 0.0f;
            sp[r] = s; }
        float G[4], Gp[4], suf[4];
#pragma unroll
        for (int q = 0; q < 4; ++q) { G[q] = (sp[4 * q] + sp[4 * q + 1]) + (sp[4 * q + 2] + sp[4 * q + 3]); Gp[q] = lane32_swap(G[q]); }
        suf[3] = 0.0f; suf[2] = G[3] + Gp[3]; suf[1] = suf[2] + (G[2] + Gp[2]); suf[0] = suf[1] + (G[1] + Gp[1]);
        const float tot = suf[0] + (G[0] + Gp[0]);
        pg8::u32x4 pw0, pw1;
        float av[16];
#pragma unroll
        for (int q = 0; q < 4; ++q) { float run = carry + suf[q] + (hi == 0 ? Gp[q] : 0.0f);
#pragma unroll
            for (int i = 3; i >= 0; --i) { const int r = 4 * q + i; const float la = (st[r] - sp[r]) - run; float a = __builtin_amdgcn_exp2f(la);
                if (diag && ((r & 3) + 8 * (r >> 2) + 4 * hi >= r32)) a = 0.0f;
                av[r] = a; run += sp[r]; } }
        pw0.x = pg8::cvt_pk_bf16(av[0], av[1]); pw0.y = pg8::cvt_pk_bf16(av[2], av[3]); pw0.z = pg8::cvt_pk_bf16(av[4], av[5]); pw0.w = pg8::cvt_pk_bf16(av[6], av[7]);
        pw1.x = pg8::cvt_pk_bf16(av[8], av[9]); pw1.y = pg8::cvt_pk_bf16(av[10], av[11]); pw1.z = pg8::cvt_pk_bf16(av[12], av[13]); pw1.w = pg8::cvt_pk_bf16(av[14], av[15]);
        const bf16x8v pa0 = __builtin_bit_cast(bf16x8v, pw0), pa1 = __builtin_bit_cast(bf16x8v, pw1);
        LDS_WAIT();
#pragma unroll
        for (int s = 0; s < 2; ++s)
#pragma unroll
            for (int nb = 0; nb < 2; ++nb) {
                LAS unsigned char* a1 = vl + (16 * s + 4 * (g16 >> 1) + tj) * SBV_PITCH + (32 * nb + 16 * (g16 & 1) + 4 * tc) * 2;
                const s16x4v r1 = __builtin_bit_cast(s16x4v, __builtin_amdgcn_ds_read_tr16_b64_v4i16((LAS s16x4v*)a1));
                const s16x4v r2 = __builtin_bit_cast(s16x4v, __builtin_amdgcn_ds_read_tr16_b64_v4i16((LAS s16x4v*)(a1 + 8 * SBV_PITCH)));
                const bf16x8v bv = {r1[0], r1[1], r1[2], r1[3], r2[0], r2[1], r2[2], r2[3]};
                if (nb == 0) o0 = __builtin_amdgcn_mfma_f32_32x32x16_bf16(s ? pa1 : pa0, bv, o0, 0, 0, 0); else o1 = __builtin_amdgcn_mfma_f32_32x32x16_bf16(s ? pa1 : pa0, bv, o1, 0, 0, 0);
                asm volatile("" :: "v"(bv), "v"(pa0), "v"(pa1), "v"(o0), "v"(o1)); }
        LDS_WAIT();
        carry += tot;
        if (__all(carry > 40.0f)) break;
    }
#undef SB_FETCH
    bf16* YS = (bf16*)((float*)(A.ws + WS_YO) + 3 * YO_STRIDE) + ((size_t)b * SEQ + t0) * 256 + h * 64 + r32;
#pragma unroll
    for (int r = 0; r < 16; ++r) { const int qo = (r & 3) + 8 * (r >> 2) + 4 * hi; YS[(size_t)qo * 256] = (bf16)f2bf(o0[r]); YS[(size_t)qo * 256 + 32] = (bf16)f2bf(o1[r]); }
}

__device__ __forceinline__ void rope_frag4(bf16x8v (&f)[4], const f32x4 (&cs)[2][2], const f32x4 (&sn)[2][2]) {
#pragma unroll
    for (int ks = 0; ks < 2; ++ks) { const v4u a = __builtin_bit_cast(v4u, f[ks]), b = __builtin_bit_cast(v4u, f[ks + 2]);
        const f32x4 a0 = {bf_lo(a.x), bf_hi(a.x), bf_lo(a.y), bf_hi(a.y)}, a1 = {bf_lo(a.z), bf_hi(a.z), bf_lo(a.w), bf_hi(a.w)}, b0 = {bf_lo(b.x), bf_hi(b.x), bf_lo(b.y), bf_hi(b.y)}, b1 = {bf_lo(b.z), bf_hi(b.z), bf_lo(b.w), bf_hi(b.w)};
        const f32x4 x0 = a0 * cs[ks][0] - b0 * sn[ks][0], x1 = a1 * cs[ks][1] - b1 * sn[ks][1], y0 = b0 * cs[ks][0] + a0 * sn[ks][0], y1 = b1 * cs[ks][1] + a1 * sn[ks][1];
        v4u xo, yo; xo.x = pk2(x0.x, x0.y); xo.y = pk2(x0.z, x0.w); xo.z = pk2(x1.x, x1.y); xo.w = pk2(x1.z, x1.w); yo.x = pk2(y0.x, y0.y); yo.y = pk2(y0.z, y0.w); yo.z = pk2(y1.x, y1.y); yo.w = pk2(y1.z, y1.w);
        f[ks] = __builtin_bit_cast(bf16x8v, xo); f[ks + 2] = __builtin_bit_cast(bf16x8v, yo); }
}
#define RT_CS_LOAD(cs_, sn_, rt_) do { _Pragma("unroll") for (int ks = 0; ks < 2; ++ks) { const float* q_ = (rt_) + 16 * ks + 8 * hi; cs_[ks][0] = *(const f32x4*)q_; cs_[ks][1] = *(const f32x4*)(q_ + 4); sn_[ks][0] = *(const f32x4*)(q_ + 32); sn_[ks][1] = *(const f32x4*)(q_ + 36); } } while (0)
__device__ __forceinline__ void ret_tile_mfma(ARef A, int unit, int lane_in, LAS unsigned char* vl) {
    int lane = lane_in; asm volatile("" : "+v"(lane));
    const int tq = unit & 127, bh = unit >> 7, b = bh >> 2, h = bh & 3, t0 = tq * 32, r32 = lane & 31, hi = lane >> 5, cs0 = t0 & ~(TCH - 1);
    const bf16* PS = (const bf16*)(A.ws + WS_PB) + (size_t)b * SEQ * PBW + h * 64;
    const float* RT = (const float*)(A.ws + WS_ROPE) + (size_t)b * SEQ * ROPE_W;
    const float lg2g = log2f(1.0f - exp2f(-5.0f - (float)h));
    bf16x8v qf[4];
    { f32x4 qc[2][2], qs[2][2]; RT_CS_LOAD(qc, qs, RT + (size_t)(t0 + r32) * ROPE_W);
#pragma unroll
      for (int ks = 0; ks < 4; ++ks) qf[ks] = *(const bf16x8v*)(PS + (size_t)(t0 + r32) * PBW + 16 * ks + 8 * hi);
      rope_frag4(qf, qc, qs); }
    { const float gt = exp2f(lg2g * (float)(t0 + r32 - cs0 + 1)); bf16* pt = (bf16*)(A.ws + WS_PTR) + ((size_t)b * SEQ + t0 + r32) * 256 + h * 64 + 8 * hi;
#pragma unroll
      for (int ks = 0; ks < 4; ++ks) { const v4u x = __builtin_bit_cast(v4u, qf[ks]); v4u o_; o_.x = pk2(bf_lo(x.x) * gt, bf_hi(x.x) * gt); o_.y = pk2(bf_lo(x.y) * gt, bf_hi(x.y) * gt); o_.z = pk2(bf_lo(x.z) * gt, bf_hi(x.z) * gt); o_.w = pk2(bf_lo(x.w) * gt, bf_hi(x.w) * gt);
          *(v4u*)(pt + 16 * ks) = o_; } }
    const float dq = exp2f(lg2g * (float)(r32 - 4 * hi));
    float e3[4], e8[4];
#pragma unroll
    for (int i = 0; i < 4; ++i) { e3[i] = exp2f(-lg2g * (float)i); e8[i] = exp2f(-lg2g * (float)(8 * i)); }
    f32x16 o0, o1;
#pragma unroll
    for (int r = 0; r < 16; ++r) { o0[r] = 0.0f; o1[r] = 0.0f; }
    const int g16 = lane >> 4, tj = (lane & 15) >> 2, tc = lane & 3;
    v4u vn[4]; bf16x8v kn[4];
#define RET_FETCH(kb_) do { _Pragma("unroll") for (int i = 0; i < 4; ++i) { const int p = lane + 64 * i, row = p >> 3, ch = p & 7; vn[i] = *(const v4u*)(PS + 512 + (size_t)((kb_) + row) * PBW + 8 * ch); } \
        _Pragma("unroll") for (int ks = 0; ks < 4; ++ks) kn[ks] = *(const bf16x8v*)(PS + 256 + (size_t)((kb_) + r32) * PBW + 16 * ks + 8 * hi); } while (0)
    RET_FETCH(t0);
#pragma unroll 1
    for (int kb0 = t0; kb0 >= cs0; kb0 -= 32) {
#pragma unroll
        for (int i = 0; i < 4; ++i) { const int p = lane + 64 * i, row = p >> 3, ch = p & 7; *(LAS v4u*)(vl + row * SBV_PITCH + 16 * ch) = vn[i]; }
        f32x16 st;
#pragma unroll
        for (int r = 0; r < 16; ++r) st[r] = 0.0f;
        { bf16x8v ka[4];
#pragma unroll
          for (int ks = 0; ks < 4; ++ks) ka[ks] = kn[ks];
          { f32x4 kc[2][2], ksn[2][2]; RT_CS_LOAD(kc, ksn, RT + (size_t)(kb0 + r32) * ROPE_W); rope_frag4(ka, kc, ksn); }
          if (kb0 - 32 >= cs0) RET_FETCH(kb0 - 32);
#pragma unroll
          for (int ks = 0; ks < 4; ++ks) st = __builtin_amdgcn_mfma_f32_32x32x16_bf16(ka[ks], qf[ks], st, 0, 0, 0);
          asm volatile("" :: "v"(ka[0]), "v"(ka[1]), "v"(ka[2]), "v"(ka[3]), "v"(st)); }
        const float gs = exp2f(lg2g * (float)(t0 - kb0)); const bool diag = (kb0 == t0);
        float av[16];
#pragma unroll
        for (int r = 0; r < 16; ++r) { float a = st[r] * ((gs * dq) * (e3[r & 3] * e8[r >> 2])); if (diag && ((r & 3) + 8 * (r >> 2) + 4 * hi > r32)) a = 0.0f; av[r] = a; }
        pg8::u32x4 pw0, pw1;
        pw0.x = pk2(av[0], av[1]); pw0.y = pk2(av[2], av[3]); pw0.z = pk2(av[4], av[5]); pw0.w = pk2(av[6], av[7]);
        pw1.x = pk2(av[8], av[9]); pw1.y = pk2(av[10], av[11]); pw1.z = pk2(av[12], av[13]); pw1.w = pk2(av[14], av[15]);
        const bf16x8v pa0 = __builtin_bit_cast(bf16x8v, pw0), pa1 = __builtin_bit_cast(bf16x8v, pw1);
        LDS_WAIT();
#pragma unroll
        for (int s = 0; s < 2; ++s)
#pragma unroll
            for (int nb = 0; nb < 2; ++nb) {
                LAS unsigned char* a1 = vl + (16 * s + 4 * (g16 >> 1) + tj) * SBV_PITCH + (32 * nb + 16 * (g16 & 1) + 4 * tc) * 2;
                const s16x4v r1 = __builtin_bit_cast(s16x4v, __builtin_amdgcn_ds_read_tr16_b64_v4i16((LAS s16x4v*)a1));
                const s16x4v r2 = __builtin_bit_cast(s16x4v, __builtin_amdgcn_ds_read_tr16_b64_v4i16((LAS s16x4v*)(a1 + 8 * SBV_PITCH)));
                const bf16x8v bv = {r1[0], r1[1], r1[2], r1[3], r2[0], r2[1], r2[2], r2[3]};
                if (nb == 0) o0 = __builtin_amdgcn_mfma_f32_32x32x16_bf16(s ? pa1 : pa0, bv, o0, 0, 0, 0); else o1 = __builtin_amdgcn_mfma_f32_32x32x16_bf16(s ? pa1 : pa0, bv, o1, 0, 0, 0);
                asm volatile("" :: "v"(bv), "v"(pa0), "v"(pa1), "v"(o0), "v"(o1)); }
        LDS_WAIT();
    }
#undef RET_FETCH
    bf16* YS = (bf16*)(A.ws + WS_YO) + ((size_t)b * SEQ + t0) * 256 + h * 64 + r32;
#pragma unroll
    for (int r = 0; r < 16; ++r) { const int qo = (r & 3) + 8 * (r >> 2) + 4 * hi; YS[(size_t)qo * 256] = (bf16)f2bf(o0[r]); YS[(size_t)qo * 256 + 32] = (bf16)f2bf(o1[r]); }
}
__device__ __forceinline__ void ret_state_mfma(ARef A, int unit, int lane_in, LAS unsigned char* vl) {
    int lane = lane_in; asm volatile("" : "+v"(lane));
    const int bh = unit >> 4, c = unit & 15, b = bh >> 2, h = bh & 3, r32 = lane & 31, hi = lane >> 5;
    const size_t tok0 = (size_t)b * SEQ + (size_t)c * TCH;
    const bf16* PS = (const bf16*)(A.ws + WS_PB) + tok0 * PBW + h * 64; const float* RT = (const float*)(A.ws + WS_ROPE) + tok0 * ROPE_W;
    const float lg2g = log2f(1.0f - exp2f(-5.0f - (float)h)), g32 = exp2f(32.0f * lg2g);
    LAS unsigned char* kl = vl + 32 * SBV_PITCH;
    const int g16 = lane >> 4, tj = (lane & 15) >> 2, tc = lane & 3;
    f32x16 acc[2][2];
#pragma unroll
    for (int a = 0; a < 2; ++a)
#pragma unroll
        for (int b2 = 0; b2 < 2; ++b2)
#pragma unroll
            for (int r = 0; r < 16; ++r) acc[a][b2][r] = 0.0f;
#pragma unroll 1
    for (int j = 0; j < TCH / 32; ++j) {
#pragma unroll
        for (int i = 0; i < 4; ++i) { const int p = lane + 64 * i, row = p >> 3, ch = p & 7, fi = (8 * ch) & 31; const bf16* pr = PS + (size_t)(32 * j + row) * PBW; const float* rt = RT + (size_t)(32 * j + row) * ROPE_W;
            const v4u vv = *(const v4u*)(pr + 512 + 8 * ch), x = *(const v4u*)(pr + 256 + 8 * ch), xo = *(const v4u*)(pr + 256 + 8 * (ch ^ 4));
            const f32x4 c0 = *(const f32x4*)(rt + fi), c1 = *(const f32x4*)(rt + fi + 4), s0 = *(const f32x4*)(rt + 32 + fi), s1 = *(const f32x4*)(rt + 36 + fi);
            const f32x4 a0 = {bf_lo(x.x), bf_hi(x.x), bf_lo(x.y), bf_hi(x.y)}, a1 = {bf_lo(x.z), bf_hi(x.z), bf_lo(x.w), bf_hi(x.w)}, b0 = {bf_lo(xo.x), bf_hi(xo.x), bf_lo(xo.y), bf_hi(xo.y)}, b1 = {bf_lo(xo.z), bf_hi(xo.z), bf_lo(xo.w), bf_hi(xo.w)};
            const float dk = exp2f(lg2g * (float)(31 - row));
            const f32x4 k0 = ((ch < 4) ? a0 * c0 - b0 * s0 : b0 * s0 + a0 * c0) * dk, k1 = ((ch < 4) ? a1 * c1 - b1 * s1 : b1 * s1 + a1 * c1) * dk;
            v4u kw; kw.x = pk2(k0.x, k0.y); kw.y = pk2(k0.z, k0.w); kw.z = pk2(k1.x, k1.y); kw.w = pk2(k1.z, k1.w);
            *(LAS v4u*)(vl + row * SBV_PITCH + 16 * ch) = vv; *(LAS v4u*)(kl + row * SBV_PITCH + 16 * ch) = kw; }
        LDS_WAIT();
        if (j > 0) {
#pragma unroll
            for (int a = 0; a < 2; ++a)
#pragma unroll
                for (int b2 = 0; b2 < 2; ++b2)
#pragma unroll
                    for (int r = 0; r < 16; ++r) acc[a][b2][r] *= g32; }
#pragma unroll
        for (int s = 0; s < 2; ++s) {
            bf16x8v fv[2], fk[2];
#pragma unroll
            for (int nb = 0; nb < 2; ++nb) { const int off = (16 * s + 4 * (g16 >> 1) + tj) * SBV_PITCH + (32 * nb + 16 * (g16 & 1) + 4 * tc) * 2;
                const s16x4v v1 = __builtin_bit_cast(s16x4v, __builtin_amdgcn_ds_read_tr16_b64_v4i16((LAS s16x4v*)(vl + off))), v2 = __builtin_bit_cast(s16x4v, __builtin_amdgcn_ds_read_tr16_b64_v4i16((LAS s16x4v*)(vl + off + 8 * SBV_PITCH)));
                const s16x4v k1 = __builtin_bit_cast(s16x4v, __builtin_amdgcn_ds_read_tr16_b64_v4i16((LAS s16x4v*)(kl + off))), k2 = __builtin_bit_cast(s16x4v, __builtin_amdgcn_ds_read_tr16_b64_v4i16((LAS s16x4v*)(kl + off + 8 * SBV_PITCH)));
                fv[nb] = (bf16x8v){v1[0], v1[1], v1[2], v1[3], v2[0], v2[1], v2[2], v2[3]}; fk[nb] = (bf16x8v){k1[0], k1[1], k1[2], k1[3], k2[0], k2[1], k2[2], k2[3]}; }
#pragma unroll
            for (int a = 0; a < 2; ++a)
#pragma unroll
                for (int b2 = 0; b2 < 2; ++b2) acc[a][b2] = __builtin_amdgcn_mfma_f32_32x32x16_bf16(fv[a], fk[b2], acc[a][b2], 0, 0, 0);
            asm volatile("" :: "v"(fv[0]), "v"(fv[1]), "v"(fk[0]), "v"(fk[1]), "v"(acc[0][0]), "v"(acc[0][1]), "v"(acc[1][0]), "v"(acc[1][1])); }
        LDS_WAIT();
    }
    float* ch = (float*)(A.ws + WS_CHR) + (size_t)(bh * NCH + c) * 64 * 64;
#pragma unroll
    for (int a = 0; a < 2; ++a)
#pragma unroll
        for (int b2 = 0; b2 < 2; ++b2)
#pragma unroll
            for (int r = 0; r < 16; ++r) ch[(size_t)(32 * a + (r & 3) + 8 * (r >> 2) + 4 * hi) * 64 + 32 * b2 + r32] = acc[a][b2][r];
}
#undef RT_CS_LOAD
__device__ __forceinline__ void dsa_scores_mfma(ARef A, int lane_in, int gwv, int ngw) {
    int lane = lane_in; asm volatile("" : "+v"(lane));
    const _Float16* QIH = (const _Float16*)(A.ws + WS_DQI); const _Float16* KIH = (const _Float16*)(A.ws + WS_DKI);
    const float* DW = (const float*)(A.ws + WS_DW); _Float16* SC = (_Float16*)(A.ws + WS_SC);
    const int col = lane & 15, q4 = lane >> 4;
    for (int u = gwv; u < 2048; u += ngw) {
        const int pi = u >> 1, par = u & 1, b = pi >> 7, p = pi & 127;
#pragma unroll 1
        for (int side = 0; side < 2; ++side) {
            const int qb = side ? 255 - p : p; const size_t m0 = (size_t)b * SEQ + 16 * qb;
            f16x8 bq[8];
#pragma unroll
            for (int h = 0; h < 8; ++h) bq[h] = *(const f16x8*)(QIH + (m0 + col) * 256 + h * 32 + 8 * q4);
            const float* dw = DW + (m0 + col) * 8; const f32x4 wa = *(const f32x4*)dw * 0.5f, wb = *(const f32x4*)(dw + 4) * 0.5f;
            const f16x8 bql = *(const f16x8*)((const _Float16*)(A.ws + WS_DQL) + (m0 + col) * 32 + 8 * q4);
            _Float16* srow = SC + (m0 + col) * SEQ + 4 * q4;
            const _Float16* kbase = KIH + ((size_t)b * SEQ + col) * 32 + 8 * q4;
            f16x8 an[4];
#define SC_FETCH(kq_) do { _Pragma("unroll") for (int q = 0; q < 4; ++q) { const int kb = 4 * (kq_) + q; an[q] = *(const f16x8*)(kbase + (size_t)(kb <= qb ? kb : qb) * 16 * 32); } } while (0)
            if (4 * par <= qb) SC_FETCH(par);
            for (int kq = par; 4 * kq <= qb; kq += 2) {
                f16x8 ak[4];
#pragma unroll
                for (int q = 0; q < 4; ++q) ak[q] = an[q];
                if (4 * (kq + 2) <= qb) SC_FETCH(kq + 2);
#pragma unroll
                for (int q = 0; q < 4; ++q) { const int kb = 4 * kq + q;
                    if (kb <= qb) {
                        f32x4 acc = __builtin_amdgcn_mfma_f32_16x16x32_f16(ak[q], bql, (f32x4){0.f, 0.f, 0.f, 0.f}, 0, 0, 0);
#pragma unroll
                        for (int h = 0; h < 8; ++h) { const f32x4 c = __builtin_amdgcn_mfma_f32_16x16x32_f16(ak[q], bq[h], (f32x4){0.f, 0.f, 0.f, 0.f}, 0, 0, 0); const float wv = (h < 4) ? wa[h] : wb[h - 4];
                            acc.x = fmaf(wv, fabsf(c.x), acc.x); acc.y = fmaf(wv, fabsf(c.y), acc.y); acc.z = fmaf(wv, fabsf(c.z), acc.z); acc.w = fmaf(wv, fabsf(c.w), acc.w); }
                        h4v hs; hs.x = (_Float16)acc.x; hs.y = (_Float16)acc.y; hs.z = (_Float16)acc.z; hs.w = (_Float16)acc.w;
                        v2u kw = __builtin_bit_cast(v2u, hs);
                        kw.x ^= (((kw.x >> 15) & 0x00010001u) * 0x7fffu) | 0x80008000u; kw.y ^= (((kw.y >> 15) & 0x00010001u) * 0x7fffu) | 0x80008000u;
                        *(v2u*)(srow + 16 * kb) = kw; } }
            }
#undef SC_FETCH
        }
    }
}

__device__ __forceinline__ int wave_total_i(int v) {
    v += __builtin_amdgcn_mov_dpp(v, 0xB1, 0xF, 0xF, true);
    v += __builtin_amdgcn_mov_dpp(v, 0x4E, 0xF, 0xF, true);
    v += __builtin_amdgcn_mov_dpp(v, 0x141, 0xF, 0xF, true);
    v += __builtin_amdgcn_mov_dpp(v, 0x140, 0xF, 0xF, true);
    return __builtin_amdgcn_readlane(v, 0) + __builtin_amdgcn_readlane(v, 16) + __builtin_amdgcn_readlane(v, 32) + __builtin_amdgcn_readlane(v, 48);
}
__device__ __forceinline__ unsigned score_key(float f) { const unsigned bits = __float_as_uint(f); return (bits & 0x80000000u) ? ~bits : (bits | 0x80000000u); }
constexpr int VST_PITCH = 144;
typedef unsigned short u16;
__device__ __forceinline__ void dsa_load_scores(ARef A, int m, int lane, v4u (&sv)[8]) {
    const int n = (m & (SEQ - 1)) + 1; const _Float16* sc = (const _Float16*)(A.ws + WS_SC) + (size_t)m * SEQ + 8 * lane;
#pragma unroll
    for (int c = 0; c < 8; ++c) { if (512 * c < n) sv[c] = *(const v4u*)(sc + 512 * c); else sv[c] = (v4u){0u, 0u, 0u, 0u}; }
}
__device__ __forceinline__ unsigned score_key16(unsigned x) { return ((x & 0x80000000u) ? ~x : (x | 0x80000000u)) & 0xffff0000u; }
__device__ __forceinline__ void dsa_select(ARef A, int m, int n, int lane_in, LAS u16* slist, LAS unsigned* bk) {
    int lane = lane_in; asm volatile("" : "+v"(lane));
    (void)bk;
    if (n <= 256) {
#pragma unroll
        for (int c = 0; c < 4; ++c) { const int idx = lane + 64 * c; slist[idx] = (u16)((idx < n) ? idx : 0); }
        return;
    }
    v4u sv[8]; dsa_load_scores(A, m, lane, sv);
    unsigned u[64];
#pragma unroll
    for (int c = 0; c < 8; ++c)
#pragma unroll
        for (int i = 0; i < 8; ++i) { const unsigned wd = sv[c][i >> 1]; u[8 * c + i] = (512 * c + 8 * lane + i < n) ? ((i & 1) ? (wd & 0xffff0000u) : (wd << 16)) : 0u; }
    unsigned T = 0u; int cntT = 4096;
    for (int bit = 31; bit >= 16; --bit) { const unsigned cand = T | (1u << bit); int cnt = 0;
#pragma unroll
        for (int c = 0; c < 8; ++c) { if (512 * c < n) {
#pragma unroll
            for (int j = 8 * c; j < 8 * c + 8; ++j) cnt += (u[j] >= cand) ? 1 : 0; } }
        const int tot = wave_total_i(cnt); if (tot >= 256) { T = cand; cntT = tot; if (tot == 256) break; } }
    unsigned long long selb = 0ull;
    if (cntT == 256) {
#pragma unroll
        for (int c = 0; c < 8; ++c) { if (512 * c < n) {
#pragma unroll
            for (int j = 8 * c; j < 8 * c + 8; ++j) selb |= (unsigned long long)((u[j] >= T) ? 1u : 0u) << j; } }
    } else {
    unsigned long long gtb = 0ull, eqb = 0ull;
#pragma unroll
    for (int c = 0; c < 8; ++c) { if (512 * c < n) {
#pragma unroll
        for (int j = 8 * c; j < 8 * c + 8; ++j) { gtb |= (unsigned long long)((u[j] > T) ? 1u : 0u) << j; eqb |= (unsigned long long)((u[j] == T) ? 1u : 0u) << j; } } }
    const int tgt = wave_total_i(__popcll(gtb)), teq = wave_total_i(__popcll(eqb));
    selb = gtb | eqb;
    if (tgt + teq > 256) {
        const int take = 256 - tgt; int lo = 0;
        for (int bit = 11; bit >= 0; --bit) { const int cand = lo | (1 << bit); const int J8 = cand >> 9; int ni = (cand & 511) - 8 * lane; ni = ni < 0 ? 0 : (ni > 8 ? 8 : ni);
            const int jc = 8 * J8 + ni; const unsigned long long msk = (jc >= 64) ? ~0ull : ((1ull << jc) - 1ull);
            if (wave_total_i(__popcll(eqb & msk)) < take) lo = cand; }
        { const int cand = lo + 1; const int J8 = cand >> 9; int ni = (cand & 511) - 8 * lane; ni = ni < 0 ? 0 : (ni > 8 ? 8 : ni);
          const int jc = (cand >= SEQ) ? 64 : 8 * J8 + ni; const unsigned long long msk = (jc >= 64) ? ~0ull : ((1ull << jc) - 1ull); selb = gtb | (eqb & msk); }
    }
    }
    const int mine = __popcll(selb); int off = mine;
#pragma unroll
    for (int d = 1; d < 64; d <<= 1) { const int y = __shfl_up(off, d); if (lane >= d) off += y; }
    off -= mine;
    while (selb) { const int j = __builtin_ctzll(selb); selb &= selb - 1ull; slist[off] = (u16)(512 * (j >> 3) + 8 * lane + (j & 7)); ++off; }
}
__device__ __forceinline__ void dsa_attend(ARef A, int m, int lane_in, const LAS u16* slist, LAS unsigned char* vbuf) {
    int lane = lane_in; asm volatile("" : "+v"(lane));
    const int b = m >> 12, t = m & (SEQ - 1), n = t + 1, nsel = n < 256 ? n : 256, col = lane & 15, q4 = lane >> 4;
    const bf16* DKB = (const bf16*)(A.ws + WS_DKB) + (size_t)b * SEQ * 64; const bf16* DVB = (const bf16*)(A.ws + WS_DVB) + (size_t)b * SEQ * 64;
    const int vrow = lane >> 3, vpc = lane & 7;
    bf16x8v bq0 = {0, 0, 0, 0, 0, 0, 0, 0}, bq1 = {0, 0, 0, 0, 0, 0, 0, 0};
    if (col < 4) { const bf16* qp = (const bf16*)(A.ws + WS_DQ) + (size_t)m * 256 + col * 64 + 8 * q4; bq0 = *(const bf16x8v*)qp; bq1 = *(const bf16x8v*)(qp + 32); }
    f32x4 lg[16];
#pragma unroll
    for (int hb = 0; hb < 1; ++hb) {
        bf16x8v a0[16], a1[16];
#pragma unroll
        for (int k = 0; k < 16; ++k) { const int s = slist[16 * k + col]; const bf16* kr = DKB + (size_t)s * 64 + 8 * q4; a0[k] = *(const bf16x8v*)kr; a1[k] = *(const bf16x8v*)(kr + 32); }
#pragma unroll
        for (int k = 0; k < 16; ++k) { const f32x4 c = __builtin_amdgcn_mfma_f32_16x16x32_bf16(a0[k], bq0, (f32x4){0.f, 0.f, 0.f, 0.f}, 0, 0, 0); lg[k] = __builtin_amdgcn_mfma_f32_16x16x32_bf16(a1[k], bq1, c, 0, 0, 0); }
        __builtin_amdgcn_sched_barrier(0);
    }
    if (nsel < 256) {
#pragma unroll
        for (int kb = 0; kb < 16; ++kb)
#pragma unroll
            for (int r = 0; r < 4; ++r) if (16 * kb + 4 * q4 + r >= nsel) lg[kb][r] = -INFINITY; }
    v4u vr[4][4];
#pragma unroll
    for (int c = 0; c < 4; ++c)
#pragma unroll
        for (int i = 0; i < 4; ++i) { const int s = slist[32 * c + vrow + 8 * i]; vr[c][i] = *(const v4u*)(DVB + (size_t)s * 64 + 8 * vpc); }
    float mx = -INFINITY;
#pragma unroll
    for (int kb = 0; kb < 16; ++kb) mx = fmaxf(fmaxf(mx, fmaxf(lg[kb].x, lg[kb].y)), fmaxf(lg[kb].z, lg[kb].w));
    mx = fmaxf(mx, __shfl_xor(mx, 16)); mx = fmaxf(mx, __shfl_xor(mx, 32));
    float sm = 0.f;
#pragma unroll
    for (int kb = 0; kb < 16; ++kb) { lg[kb].x = __builtin_amdgcn_exp2f(lg[kb].x - mx); lg[kb].y = __builtin_amdgcn_exp2f(lg[kb].y - mx); lg[kb].z = __builtin_amdgcn_exp2f(lg[kb].z - mx); lg[kb].w = __builtin_amdgcn_exp2f(lg[kb].w - mx); sm += (lg[kb].x + lg[kb].y) + (lg[kb].z + lg[kb].w); }
    sm += __shfl_xor(sm, 16); sm += __shfl_xor(sm, 32);
    const float inv = 1.0f / sm;
    bf16x8v pa[8];
#pragma unroll
    for (int i = 0; i < 8; ++i) { const f32x4 x = lg[2 * i] * inv, y = lg[2 * i + 1] * inv;
        pg8::u32x4 wv; wv.x = pg8::cvt_pk_bf16(x.x, x.y); wv.y = pg8::cvt_pk_bf16(x.z, x.w); wv.z = pg8::cvt_pk_bf16(y.x, y.y); wv.w = pg8::cvt_pk_bf16(y.z, y.w);
        pa[i] = __builtin_bit_cast(bf16x8v, wv); }
    f32x4 o[4];
#pragma unroll
    for (int nb = 0; nb < 4; ++nb) o[nb] = (f32x4){0.f, 0.f, 0.f, 0.f};
    const int tj = col >> 2, tc = col & 3;
#pragma unroll
    for (int c = 0; c < 8; ++c) {
        LAS unsigned char* vb = vbuf + (c & 1) * (32 * VST_PITCH);
#pragma unroll
        for (int i = 0; i < 4; ++i) *(LAS v4u*)(vb + (vrow + 8 * i) * VST_PITCH + 16 * vpc) = vr[c & 3][i];
        if (c < 4) {
#pragma unroll
            for (int i = 0; i < 4; ++i) { const int s = slist[32 * (c + 4) + vrow + 8 * i]; vr[c & 3][i] = *(const v4u*)(DVB + (size_t)s * 64 + 8 * vpc); } }
        LDS_WAIT();
#pragma unroll
        for (int nb = 0; nb < 4; ++nb) {
            LAS unsigned char* a1 = vb + (4 * q4 + tj) * VST_PITCH + (16 * nb + 4 * tc) * 2;
            const s16x4v r1 = __builtin_bit_cast(s16x4v, __builtin_amdgcn_ds_read_tr16_b64_v4i16((LAS s16x4v*)a1));
            const s16x4v r2 = __builtin_bit_cast(s16x4v, __builtin_amdgcn_ds_read_tr16_b64_v4i16((LAS s16x4v*)(a1 + 16 * VST_PITCH)));
            const bf16x8v bv = {r1[0], r1[1], r1[2], r1[3], r2[0], r2[1], r2[2], r2[3]};
            o[nb] = __builtin_amdgcn_mfma_f32_16x16x32_bf16(pa[c], bv, o[nb], 0, 0, 0); }
    }
    LDS_WAIT();
    if (lane < 16) { bf16* YD = (bf16*)((float*)(A.ws + WS_YO) + 2 * YO_STRIDE) + (size_t)m * 256;
#pragma unroll
        for (int nb = 0; nb < 4; ++nb) { YD[16 * nb + lane] = (bf16)f2bf(o[nb].x); YD[64 + 16 * nb + lane] = (bf16)f2bf(o[nb].y); YD[128 + 16 * nb + lane] = (bf16)f2bf(o[nb].z); YD[192 + 16 * nb + lane] = (bf16)f2bf(o[nb].w); } }
}
constexpr int DSA_GR = 1;
__device__ __forceinline__ int dsa_row_of(int batch, int gi, int r) { const int idx = DSA_GR * gi + r, h = idx >> 1; return batch * SEQ + ((idx & 1) ? (SEQ - 1 - h) : h); }
__device__ __forceinline__ void dsa_wave(ARef A, const WI& w, LAS unsigned char* wl, int qi, int l, int skip = 0) {
    LAS u16* lists = (LAS u16*)wl; LAS unsigned char* vbuf = wl + 4096; LAS unsigned* bk = (LAS unsigned*)vbuf;
#pragma unroll 1
    for (int kb = 0; kb < NB; ++kb) {
        const int batch = (w.bx + kb) & (NB - 1);
        unsigned* head = (unsigned*)(A.ws + WS_CTL) + CW_DSAQ + 128 * qi + 16 * batch;
        int graw = 0; if (w.lane == 0) graw = (int)atomicAdd(head, 1u);
        for (;;) {
            const int g = __builtin_amdgcn_readfirstlane(graw);
            if (g >= 11 * (SEQ / 8)) break;
            graw = 0; if (w.lane == 0) graw = (int)atomicAdd(head, 1u);
            const int per = g / 11, pos = g - 11 * per;
            if (pos >= 8) { if (!(skip & 4)) moe_convert_chunk(A, l, batch * 1536 + 3 * per + (pos - 8), w.lane, (LAS float*)vbuf); continue; }
            if (skip & 2) continue;
            const int gi = 8 * per + pos;
            { const int m = dsa_row_of(batch, gi, 0), n = (m & (SEQ - 1)) + 1; dsa_select(A, m, n, w.lane, lists, bk); }
            LDS_WAIT();
            if (!(skip & 1)) dsa_attend(A, dsa_row_of(batch, gi, 0), w.lane, lists, vbuf);
        }
    }
}

__device__ __forceinline__ f32x4 head_norm4(f32x4 y, float eps, f32x4 g) {
    const float mean = grp16_sum(sum4(y)) * (1.0f / 64.0f); const f32x4 yc = y - mean;
    const float var = grp16_sum(dot4(yc, yc)) * (1.0f / 64.0f); return yc * (1.0f / sqrtf(var + eps)) * g;
}
constexpr int S0_PITCH = 144;
template <int MIXER> __device__ __forceinline__ void post16_head(ARef A, int l, size_t m, int hh, int tk, int fq, const LAS unsigned char* s0) {
    const size_t o = m * 256 + hh * 64 + 8 * fq;
    bf16x8v pb[2];
    if (MIXER == 0) { const bf16* pp = (const bf16*)(A.ws + WS_PTR) + o; pb[0] = *(const bf16x8v*)pp; pb[1] = *(const bf16x8v*)(pp + 32); }
    else { const bf16* pp = (const bf16*)(A.ws + WS_PT) + o; pb[0] = *(const bf16x8v*)pp; pb[1] = *(const bf16x8v*)(pp + 32); }
    f32x4 y[4];
    const bf16* yl = (const bf16*)((const float*)(A.ws + WS_YO) + MIXER * YO_STRIDE) + o;
#pragma unroll
    for (int j = 0; j < 2; ++j) { const v4u x = *(const v4u*)(yl + 32 * j); y[2 * j] = (f32x4){bf_lo(x.x), bf_hi(x.x), bf_lo(x.y), bf_hi(x.y)}; y[2 * j + 1] = (f32x4){bf_lo(x.z), bf_hi(x.z), bf_lo(x.w), bf_hi(x.w)}; }
    const float* gw = ((MIXER == 0) ? A.in[I_RETGN] : A.in[I_LN]) + l * 256 + hh * 64 + 8 * fq;
    f32x4 gn[4], e0[4], e1[4];
#pragma unroll
    for (int mb = 0; mb < 4; ++mb) gn[mb] = *(const f32x4*)(gw + 32 * (mb >> 1) + 4 * (mb & 1));
    if (MIXER == 0) {
#pragma unroll
        for (int j = 0; j < 2; ++j) { const v4u gx = *(const v4u*)((const bf16*)(A.ws + WS_PB) + m * PBW + 768 + hh * 64 + 8 * fq + 32 * j);
            e0[2 * j] = (f32x4){bf_lo(gx.x), bf_hi(gx.x), bf_lo(gx.y), bf_hi(gx.y)}; e0[2 * j + 1] = (f32x4){bf_lo(gx.z), bf_hi(gx.z), bf_lo(gx.w), bf_hi(gx.w)}; }
    } else { const float* RWA = (const float*)(A.ws + WS_RWA);
#pragma unroll
        for (int j = 0; j < 2; ++j) { const v4u bx_ = *(const v4u*)((const bf16*)(RWA + 7 * RWA_STRIDE) + o + 32 * j), gx_ = *(const v4u*)((const bf16*)(RWA + 6 * RWA_STRIDE) + o + 32 * j);
            e0[2 * j] = (f32x4){bf_lo(bx_.x), bf_hi(bx_.x), bf_lo(bx_.y), bf_hi(bx_.y)}; e0[2 * j + 1] = (f32x4){bf_lo(bx_.z), bf_hi(bx_.z), bf_lo(bx_.w), bf_hi(bx_.w)};
            e1[2 * j] = (f32x4){bf_lo(gx_.x), bf_hi(gx_.x), bf_lo(gx_.y), bf_hi(gx_.y)}; e1[2 * j + 1] = (f32x4){bf_lo(gx_.z), bf_hi(gx_.z), bf_lo(gx_.w), bf_hi(gx_.w)}; } }
    const LAS unsigned char* ab = s0 + ((MIXER * 4 + hh) * 64 + 8 * (tk >> 2) + (tk & 3)) * S0_PITCH + 16 * fq;
#pragma unroll
    for (int mb = 0; mb < 4; ++mb)
#pragma unroll
        for (int ks = 0; ks < 2; ++ks) { const bf16x8v af = *(const LAS bf16x8v*)(ab + (32 * (mb >> 1) + 4 * (mb & 1)) * S0_PITCH + 64 * ks); y[mb] = __builtin_amdgcn_mfma_f32_16x16x32_bf16(af, pb[ks], y[mb], 0, 0, 0); }
    float s = (sum4(y[0]) + sum4(y[1])) + (sum4(y[2]) + sum4(y[3])); s += __shfl_xor(s, 16); s += __shfl_xor(s, 32);
    const float mean = s * (1.0f / 64.0f);
#pragma unroll
    for (int mb = 0; mb < 4; ++mb) y[mb] = y[mb] - mean;
    float q = (dot4(y[0], y[0]) + dot4(y[1], y[1])) + (dot4(y[2], y[2]) + dot4(y[3], y[3])); q += __shfl_xor(q, 16); q += __shfl_xor(q, 32);
    const float rs = 1.0f / sqrtf(q * (1.0f / 64.0f) + ((MIXER == 0) ? 1e-5f : 64e-5f));
    bf16* MX = (bf16*)(A.ws + WS_MIX) + m * DM + MIXER * 256 + hh * 64 + 8 * fq;
#pragma unroll
    for (int j = 0; j < 2; ++j) { f32x4 ya = y[2 * j] * rs * gn[2 * j], yb = y[2 * j + 1] * rs * gn[2 * j + 1];
        if (MIXER == 0) {
#pragma unroll
            for (int i = 0; i < 4; ++i) { ya[i] *= e0[2 * j][i] * sigm(e0[2 * j][i]); yb[i] *= e0[2 * j + 1][i] * sigm(e0[2 * j + 1][i]); }
        } else { ya = (ya + e0[2 * j]) * e1[2 * j]; yb = (yb + e0[2 * j + 1]) * e1[2 * j + 1]; }
        v4u wv; wv.x = pk2(ya.x, ya.y); wv.y = pk2(ya.z, ya.w); wv.z = pk2(yb.x, yb.y); wv.w = pk2(yb.z, yb.w); *(v4u*)(MX + 32 * j) = wv; }
}
__device__ __forceinline__ void post16_rms(ARef A, int l, size_t m, int mx, int fq) {
    const bf16* yp = (const bf16*)((const float*)(A.ws + WS_YO) + (size_t)mx * YO_STRIDE) + m * 256 + 8 * fq; const float* gw = ((mx == 2) ? A.in[I_DONORM] : A.in[I_SONORM]) + l * 256 + 8 * fq;
    f32x4 y[16];
#pragma unroll
    for (int j = 0; j < 8; ++j) { const v4u x = *(const v4u*)(yp + 32 * j); y[2 * j] = (f32x4){bf_lo(x.x), bf_hi(x.x), bf_lo(x.y), bf_hi(x.y)}; y[2 * j + 1] = (f32x4){bf_lo(x.z), bf_hi(x.z), bf_lo(x.w), bf_hi(x.w)}; }
    float q = 0.0f;
#pragma unroll
    for (int j = 0; j < 16; ++j) q += dot4(y[j], y[j]);
    q += __shfl_xor(q, 16); q += __shfl_xor(q, 32);
    const float r = 1.0f / sqrtf(q * (1.0f / 256.0f) + 1e-5f);
    bf16* MX = (bf16*)(A.ws + WS_MIX) + m * DM + mx * 256 + 8 * fq;
#pragma unroll
    for (int j = 0; j < 8; ++j) { const f32x4 ya = y[2 * j] * r * *(const f32x4*)(gw + 32 * j), yb = y[2 * j + 1] * r * *(const f32x4*)(gw + 32 * j + 4);
        v4u wv; wv.x = pk2(ya.x, ya.y); wv.y = pk2(ya.z, ya.w); wv.z = pk2(yb.x, yb.y); wv.w = pk2(yb.z, yb.w); *(v4u*)(MX + 32 * j) = wv; }
}
__device__ __forceinline__ void ph_post16(ARef A, const WI& w, int l) {
    LAS unsigned char* s0 = w.lds;
    for (int u = w.vcu; u < NB * NCH * 2; u += w.G) {
        const int b = u >> 5, c = (u >> 1) & 15, half = u & 1;
        __syncthreads();
#pragma unroll 2
        for (int e = w.tid; e < 4096; e += NWAVES * 64) { const int hd = e >> 9, v = (e >> 3) & 63, k8 = e & 7;
            const float* src = (const float*)(A.ws + ((hd < 4) ? WS_SIR : WS_SI)) + ((size_t)((b * 4 + (hd & 3)) * NCH + c) * 64 + v) * 64 + 8 * k8;
            const f32x4 x0 = *(const f32x4*)src, x1 = *(const f32x4*)(src + 4);
            v4u wv; wv.x = pk2(x0.x, x0.y); wv.y = pk2(x0.z, x0.w); wv.z = pk2(x1.x, x1.y); wv.w = pk2(x1.z, x1.w); *(LAS v4u*)(s0 + (hd * 64 + v) * S0_PITCH + 16 * k8) = wv; }
        __syncthreads();
        int lane = w.lane; asm volatile("" : "+v"(lane));
        const int tk = lane & 15, fq = lane >> 4; const size_t m = (size_t)(b * SEQ + c * TCH + half * 128 + w.wave * 16 + tk);
#pragma unroll 1
        for (int hh = 0; hh < 4; ++hh) post16_head<0>(A, l, m, hh, tk, fq, s0);
#pragma unroll 1
        for (int hh = 0; hh < 4; ++hh) post16_head<1>(A, l, m, hh, tk, fq, s0);
#pragma unroll 1
        for (int mx = 2; mx < 4; ++mx) post16_rms(A, l, m, mx, fq);
    }
}

__device__ __forceinline__ float wave_max_f(float v) {
    v = fmaxf(v, __builtin_bit_cast(float, __builtin_amdgcn_mov_dpp(__builtin_bit_cast(int, v), 0xB1, 0xF, 0xF, true)));
    v = fmaxf(v, __builtin_bit_cast(float, __builtin_amdgcn_mov_dpp(__builtin_bit_cast(int, v), 0x4E, 0xF, 0xF, true)));
    v = fmaxf(v, __builtin_bit_cast(float, __builtin_amdgcn_mov_dpp(__builtin_bit_cast(int, v), 0x141, 0xF, 0xF, true)));
    v = fmaxf(v, __builtin_bit_cast(float, __builtin_amdgcn_mov_dpp(__builtin_bit_cast(int, v), 0x140, 0xF, 0xF, true)));
    const int iv = __builtin_bit_cast(int, v);
    return fmaxf(fmaxf(__builtin_bit_cast(float, __builtin_amdgcn_readlane(iv, 0)), __builtin_bit_cast(float, __builtin_amdgcn_readlane(iv, 16))), fmaxf(__builtin_bit_cast(float, __builtin_amdgcn_readlane(iv, 32)), __builtin_bit_cast(float, __builtin_amdgcn_readlane(iv, 48))));
}
__device__ __forceinline__ void router_stage16(ARef A, const WI& w, int l) {
    LAS unsigned char* rwt = w.lds; const float* rw = A.in[I_RW] + (size_t)l * DM * 32;
    const int k0 = 2 * w.tid;
    const int c = k0 >> 3, kin = (k0 & 7) * 2;
#pragma unroll
    for (int e4 = 0; e4 < 8; ++e4) { const f32x4 a = *(const f32x4*)(rw + (size_t)k0 * 32 + 4 * e4), b = *(const f32x4*)(rw + (size_t)(k0 + 1) * 32 + 4 * e4);
#pragma unroll
        for (int i = 0; i < 4; ++i) { const int e = 4 * e4 + i; const unsigned hi = pg8::cvt_pk_bf16(a[i], b[i]); const float ra = a[i] - bf_lo(hi), rb = b[i] - bf_hi(hi); const unsigned lo = pg8::cvt_pk_bf16(ra, rb);
            const int off = e * 2048 + ((c ^ (e & 15)) * 16) + kin; *(LAS unsigned*)(rwt + off) = hi; *(LAS unsigned*)(rwt + 65536 + off) = lo; } }
    __syncthreads();
}
__device__ __forceinline__ void router16(ARef A, int l, int m0, int lane_in, LAS unsigned* hist, const LAS unsigned char* rwt, LAS int* texp, bool dry) {
    int lane = lane_in; asm volatile("" : "+v"(lane));
    const int tk = lane & 15, q4 = lane >> 4; const size_t m = (size_t)m0 + tk;
    const bf16* xr = (const bf16*)(A.ws + WS_XA) + m * DM + 8 * q4;
    const float* MOD = (const float*)(A.ws + WS_MOD) + (size_t)(l * 8 + (m0 >> 12)) * 6144;
    const float* g = A.in[I_NFFN] + l * DM + 8 * q4; const float* scp = MOD + 4 * 1024 + 8 * q4; const float* shp = MOD + 3 * 1024 + 8 * q4;
    bf16* hrow = (bf16*)(A.ws + WS_H) + m * DM + 8 * q4;
    float ss = 0.0f;
#pragma unroll 16
    for (int ks = 0; ks < 32; ++ks) { const v4u xw = *(const v4u*)(xr + 32 * ks); const f32x4 a = {bf_lo(xw.x), bf_hi(xw.x), bf_lo(xw.y), bf_hi(xw.y)}, b = {bf_lo(xw.z), bf_hi(xw.z), bf_lo(xw.w), bf_hi(xw.w)}; ss += dot4(a, a) + dot4(b, b); }
    ss += __shfl_xor(ss, 16); ss += __shfl_xor(ss, 32);
    const float rstd = 1.0f / sqrtf(ss * (1.0f / DM) + 1e-5f);
    f32x4 acc[2] = {{0.f, 0.f, 0.f, 0.f}, {0.f, 0.f, 0.f, 0.f}};
    const LAS unsigned char* wrow = rwt + tk * 2048;
#pragma unroll 2
    for (int ks = 0; ks < 32; ++ks) {
        f32x4 h[2];
        const v4u xw = *(const v4u*)(xr + 32 * ks); const f32x4 xv[2] = {{bf_lo(xw.x), bf_hi(xw.x), bf_lo(xw.y), bf_hi(xw.y)}, {bf_lo(xw.z), bf_hi(xw.z), bf_lo(xw.w), bf_hi(xw.w)}};
#pragma unroll
        for (int u = 0; u < 2; ++u) { const int k = 32 * ks + 4 * u; h[u] = xv[u] * rstd * *(const f32x4*)(g + k) * (1.0f + *(const f32x4*)(scp + k)) + *(const f32x4*)(shp + k); }
        pg8::u32x4 hw, lw;
        hw.x = pg8::cvt_pk_bf16(h[0].x, h[0].y); hw.y = pg8::cvt_pk_bf16(h[0].z, h[0].w); hw.z = pg8::cvt_pk_bf16(h[1].x, h[1].y); hw.w = pg8::cvt_pk_bf16(h[1].z, h[1].w);
        if (!dry) *(pg8::u32x4*)(hrow + 32 * ks) = hw;
        lw.x = pg8::cvt_pk_bf16(h[0].x - bf_lo(hw.x), h[0].y - bf_hi(hw.x)); lw.y = pg8::cvt_pk_bf16(h[0].z - bf_lo(hw.y), h[0].w - bf_hi(hw.y));
        lw.z = pg8::cvt_pk_bf16(h[1].x - bf_lo(hw.z), h[1].y - bf_hi(hw.z)); lw.w = pg8::cvt_pk_bf16(h[1].z - bf_lo(hw.w), h[1].w - bf_hi(hw.w));
        const bf16x8v bh = __builtin_bit_cast(bf16x8v, hw), bl = __builtin_bit_cast(bf16x8v, lw);
        const int coff = ((4 * ks + q4) ^ tk) * 16;
#pragma unroll
        for (int blk = 0; blk < 2; ++blk) { const bf16x8v ah = *(const LAS bf16x8v*)(wrow + blk * 32768 + coff), al = *(const LAS bf16x8v*)(wrow + 65536 + blk * 32768 + coff);
            acc[blk] = __builtin_amdgcn_mfma_f32_16x16x32_bf16(ah, bh, acc[blk], 0, 0, 0); acc[blk] = __builtin_amdgcn_mfma_f32_16x16x32_bf16(ah, bl, acc[blk], 0, 0, 0); acc[blk] = __builtin_amdgcn_mfma_f32_16x16x32_bf16(al, bh, acc[blk], 0, 0, 0); }
    }
    float lv[8]; const float* rb = A.in[I_RB] + l * 32 + 4 * q4;
#pragma unroll
    for (int blk = 0; blk < 2; ++blk)
#pragma unroll
        for (int i = 0; i < 4; ++i) lv[4 * blk + i] = acc[blk][i] + rb[16 * blk + i];
    float tv[4]; int ti[4];
#pragma unroll
    for (int kk = 0; kk < 4; ++kk) {
        float mx = fmaxf(fmaxf(fmaxf(lv[0], lv[1]), fmaxf(lv[2], lv[3])), fmaxf(fmaxf(lv[4], lv[5]), fmaxf(lv[6], lv[7])));
        mx = fmaxf(mx, __shfl_xor(mx, 16)); mx = fmaxf(mx, __shfl_xor(mx, 32));
        int cand = 99;
#pragma unroll
        for (int j = 7; j >= 0; --j) if (lv[j] == mx) cand = 16 * (j >> 2) + 4 * q4 + (j & 3);
        cand = min(cand, __shfl_xor(cand, 16)); cand = min(cand, __shfl_xor(cand, 32));
        if (cand == 99) cand = kk;
        tv[kk] = mx; ti[kk] = cand;
#pragma unroll
        for (int j = 0; j < 8; ++j) if (16 * (j >> 2) + 4 * q4 + (j & 3) == cand) lv[j] = -INFINITY;
    }
    const float e1 = expf(tv[1] - tv[0]), e2 = expf(tv[2] - tv[0]), e3 = expf(tv[3] - tv[0]); const float inv = 1.0f / (1.0f + e1 + e2 + e3);
    if (q4 == 0 && !dry) {
        int* TI = (int*)(A.ws + WS_TOPI) + m * 4; float* TW = (float*)(A.ws + WS_TOPW) + m * 4;
        *(v4u*)TI = (v4u){(unsigned)ti[0], (unsigned)ti[1], (unsigned)ti[2], (unsigned)ti[3]}; *(f32x4*)TW = (f32x4){inv, e1 * inv, e2 * inv, e3 * inv};
        LAS int* tx = texp + tk * 4; tx[0] = ti[0]; tx[1] = ti[1]; tx[2] = ti[2]; tx[3] = ti[3];
        { unsigned* hg = (unsigned*)hist; atomicAdd(hg + ti[0], 1u); atomicAdd(hg + ti[1], 1u); atomicAdd(hg + ti[2], 1u); atomicAdd(hg + ti[3], 1u); }
    }
}
__device__ __forceinline__ void build_expert_table(ARef A, const WI& w, int l) {
    LAS int* tst = (LAS int*)(w.lds + TST_OFF); LAS int* tab = (LAS int*)(w.lds + TAB_OFF); LAS int* cnt = (LAS int*)(w.lds + CNT_OFF);
    if (w.wave == 0) {
        const unsigned* gc = (const unsigned*)(A.ws + WS_CTL) + CW_GCNT + 64 * l; const int e = w.lane & 31;
        const int c = (int)__hip_atomic_load(gc + e, RLX_AGENT); const int tiles = (w.lane < 32) ? ((c + 255) >> 8) : 0;
        int incl = tiles;
#pragma unroll
        for (int d = 1; d < 32; d <<= 1) { const int y = __shfl_up(incl, d); if (w.lane >= d) incl += y; }
        if (w.lane < 32) { cnt[e] = c; tst[e] = incl - tiles; }
        if (w.lane == 31) { tst[32] = incl; tab[0] = incl; } }
    __syncthreads();
    if (w.tid < 32) { const int e = w.tid; for (int pm = tst[e]; pm < tst[e + 1]; ++pm) tab[1 + pm] = e; }
    __syncthreads();
}
__device__ __forceinline__ void router_lists(ARef A, const WI& w, int l) {
    LAS unsigned* hist = (LAS unsigned*)(w.lds + HIST_OFF); LAS int* base = (LAS int*)(w.lds + BASE_OFF); LAS int* texp = (LAS int*)(w.lds + TEXP_OFF);
    __syncthreads();
    if (w.tid < 32) { base[w.tid] = (int)atomicAdd((unsigned*)(A.ws + WS_CTL) + CW_GCNT + 64 * l + w.tid, hist[w.tid]); hist[w.tid] = 0u; }
    __syncthreads();
    int* LIST = (int*)(A.ws + WS_LIST); int* PW = (int*)(A.ws + WS_POS);
    for (int g16 = w.gw; g16 < MTOK / 16; g16 += w.NGW) {
        const int j = w.lane >> 2, q = w.lane & 3, m = 16 * g16 + j; const int e = texp[(w.wave * 16 + j) * 4 + q]; const int idx = base[e] + (int)atomicAdd((unsigned*)hist + e, 1u);
        LIST[e * LCAP + idx] = m; PW[(size_t)m * 4 + q] = (e << 20) | idx; }
}
__device__ __forceinline__ void combine_row(ARef A, int l, int m, int lane, const LAS int* tst, float gscale = 1.0f, float oscale = 1.0f) {
    bf16* XA = (bf16*)(A.ws + WS_XA) + (size_t)m * DM; const float* MOD = (const float*)(A.ws + WS_MOD) + (size_t)(l * 8 + (m >> 12)) * 6144;
    const int* PS = (const int*)(A.ws + WS_POS) + (size_t)m * 4; const float* TW = (const float*)(A.ws + WS_TOPW) + (size_t)m * 4;
    const bf16* YS = (const bf16*)(A.ws + WS_XS);
    f32x4 v[4], acc[4];
#pragma unroll
    for (int j = 0; j < 4; ++j) { const v2u xw = *(const v2u*)(XA + 4 * (lane + 64 * j)); v[j] = (f32x4){bf_lo(xw.x), bf_hi(xw.x), bf_lo(xw.y), bf_hi(xw.y)}; acc[j] = (f32x4){0.f, 0.f, 0.f, 0.f}; }
#pragma unroll
    for (int k = 0; k < 4; ++k) { const int pe = PS[k]; const int pos = tst[pe >> 20] * 256 + (pe & 0xFFFFF); const float gt = TW[k] * gscale; const v2u* yr = (const v2u*)(YS + (size_t)pos * DM);
#pragma unroll
        for (int j = 0; j < 4; ++j) { const v2u y = yr[lane + 64 * j]; acc[j] += gt * (f32x4){bf_lo(y.x), bf_hi(y.x), bf_lo(y.y), bf_hi(y.y)}; } }
    float ss = 0.0f;
#pragma unroll
    for (int j = 0; j < 4; ++j) { const int kx = 4 * (lane + 64 * j); v[j] += *(const f32x4*)(MOD + 5 * 1024 + kx) * acc[j]; ss += dot4(v[j], v[j]); }
    ss = wave_sum(ss); const float rstd = 1.0f / sqrtf(ss * (1.0f / DM) + 1e-5f);
    if (l + 1 < NLAYER) {
#pragma unroll
        for (int j = 0; j < 4; ++j) { v2u xw; xw.x = pk2(v[j].x, v[j].y); xw.y = pk2(v[j].z, v[j].w); *(v2u*)(XA + 4 * (lane + 64 * j)) = xw; }
        const float* mb = MOD + 8 * 6144;
        emit_h_row(v, rstd, A.in[I_NMIX] + (l + 1) * DM, mb + 1024, mb, (bf16*)(A.ws + WS_H) + (size_t)m * DM, lane);
    } else {
        float* orow = A.out + (size_t)m * DM; const float* gf = A.in[I_NFINAL];
#pragma unroll
        for (int j = 0; j < 4; ++j) { const int kx = 4 * (lane + 64 * j); *(f32x4*)(orow + kx) = v[j] * (rstd * oscale) * *(const f32x4*)(gf + kx); }
    }
}

constexpr int N_LAUNCHES = MK_N_LAUNCHES;
template <int SEL> __global__ void __launch_bounds__(NWAVES * 64, 2) fwd(ArgsH Ah) {
    extern __shared__ __attribute__((aligned(16))) unsigned char lds[];
    (void)Ah;
    const int wave_s = __builtin_amdgcn_readfirstlane((int)threadIdx.x >> 6);
    auto tid_now = [&]() -> int { int ws_ = wave_s; unsigned z_ = 0u; asm volatile("" : "+s"(ws_), "+s"(z_)); return ws_ * 64 + (int)__builtin_amdgcn_mbcnt_hi(~0u, __builtin_amdgcn_mbcnt_lo(~0u, z_)); };
#define TID_NOW() tid_now()
#define MAKE_WI() WI w; { int tz = TID_NOW(); asm volatile("" : "+v"(tz)); int bz = blockIdx.x, gz = gridDim.x; asm volatile("" : "+s"(bz), "+s"(gz)); \
        w.lds = (LAS unsigned char*)lds; w.tid = tz; w.lane = tz & 63; w.wave = __builtin_amdgcn_readfirstlane(tz >> 6); w.G = gz; w.bx = bz; w.vcu = (gz % 8 == 0) ? (bz % 8) * (gz / 8) + bz / 8 : bz; \
        w.gw = w.vcu * NWAVES + w.wave; w.NGW = gz * NWAVES; }
    { const int t0 = threadIdx.x; for (int u = t0; u < (LDS_BYTES - RING_BYTES) / 4; u += NWAVES * 64) ((LAS unsigned*)((LAS unsigned char*)lds + RING_BYTES))[u] = 0u; }
    __syncthreads();
    int lo, hi; { ARef A0 = *kargs(); lo = A0.ph_lo; hi = A0.ph_hi; }
    if (N_LAUNCHES == 1) { ARef A0 = *kargs(); (void)xcd_barrier_post((unsigned*)((gu32*)(A0.ws + WS_CTL) + CW_BAR), (volatile LAS unsigned*)((LAS unsigned char*)lds + MISC_OFF) + 8, TID_NOW()); }
#define GRID_BAR() do { if (N_LAUNCHES == 1) { ARef Ab = *kargs(); XcdBarrier bar_; bar_.bar = (unsigned*)((gu32*)(Ab.ws + WS_CTL) + CW_BAR); bar_.x = xb_xcc_id(); bar_.st = (volatile LAS unsigned*)((LAS unsigned char*)lds + MISC_OFF) + 8; xcd_barrier(bar_, TID_NOW()); } } while (0)
#ifndef TPROBE
#define TPROBE 0
#endif
#if TPROBE
    unsigned long long tp_acc = 0ull;
#define TP_SCALE tp_scale_of(__hip_atomic_load((unsigned*)(A.ws + WS_CTL) + 3, RLX_AGENT))
    auto tp_scale_of = [](unsigned ticks) -> float { const float us = (float)ticks * 0.01f; if (us < 1.0f) return 1.0f; const float q = exp2f(rintf(log2f(us) * 8.0f) * 0.125f); return 1.0f + sqrtf(q * 1e-5f); };
#define TP_BEGIN(kind) unsigned long long tp_t0 = 0ull; if ((kind) == TPROBE) tp_t0 = __builtin_amdgcn_s_memrealtime();
#define TP_END(kind) if ((kind) == TPROBE) { tp_acc += __builtin_amdgcn_s_memrealtime() - tp_t0; }
#define TP_PUBLISH(l) if ((l) == 1 && w.vcu == 0 && w.tid == 0) __hip_atomic_store((unsigned*)(A.ws + WS_CTL) + 3, (unsigned)tp_acc, RLX_AGENT);
#else
#define TP_SCALE 1.0f
#define TP_PUBLISH(l)
#define TP_BEGIN(kind)
#define TP_END(kind)
#endif
#define IN(k) (lo <= (k) && (k) < hi)
#ifndef PHMASK
#define PHMASK 0xffffffffu
#endif
#define KON(k) if constexpr ((SEL < 0 && ((PHMASK >> (k)) & 1u)) || SEL == (k))
#define BOTH(k) (IN(k) && IN((k) + 1))
#ifndef PROBE_REP
#define PROBE_REP 0
#endif
#if PROBE_REP
    int nrep_ = 2; asm volatile("" : "+s"(nrep_));
#define REP(bit) _Pragma("unroll 1") for (int rep_ = 0; rep_ < (((PROBE_REP >> (bit)) & 1) ? nrep_ : 1); ++rep_)
#else
#define REP(bit) for (int rep_ = 0; rep_ < 1; ++rep_)
#endif
#define ring ((PG8_LAS unsigned char*)lds)

    KON(0) if (IN(0)) { ARef A = *kargs(); MAKE_WI(); REP(0) ph_prologue(A, w); if (BOTH(0)) GRID_BAR(); }

#define LAYER_BODY(l) do {\
        const int pb = 1 + l * NPL; \
        KON(1) if (IN(pb + 0)) { ARef A = *kargs(); MAKE_WI(); TP_BEGIN(1) if (l == 0) { REP(15) { ph_norm1(A, w); small_weights_to_f16(A, w); } if (BOTH(pb + 0)) GRID_BAR(); } TP_END(1) } \
        KON(2) if (IN(pb + 1)) { ARef A = *kargs(); MAKE_WI(); TP_BEGIN(2) \
            pg8::Gemm g{(const bf16*)(A.ws + WS_H), (const bf16*)(A.ws + WS_WIN) + (size_t)l * INCP * DM, MTOK, INCP, DM}; pg8::StaticOrder S; S.init(MTOK, INCP, w.G, w.bx); \
            pg8::EpiProj E{(bf16*)(A.ws + WS_PB), (bf16*)(A.ws + WS_PF)}; \
            REP(1) pg8::gemm_phase<pg8::EpiProj, pg8::StaticOrder, true, true>(ring, g, S, E, w.tid); \
            if (BOTH(pb + 1)) GRID_BAR(); TP_END(2) \
        } \
        KON(3) if (IN(pb + 2)) { ARef A = *kargs(); MAKE_WI(); TP_BEGIN(3) \
              \
            REP(2) { for (int g = w.gw; g < MTOK / 16; g += w.NGW) { _Pragma("unroll 1") for (int pass_ = 0; pass_ < 2; ++pass_) { int part_ = ((pass_ ^ (w.wave >> 2)) & 1) ? 6 : 1; asm volatile("" : "+s"(part_)); prep16(A, l, 16 * g, w.lane, part_); } } } \
            if (BOTH(pb + 2)) GRID_BAR(); TP_END(3) \
        } \
        KON(4) if (IN(pb + 3)) { ARef A = *kargs(); MAKE_WI(); TP_BEGIN(4) \
              \
            { LAS unsigned* qh_ = (LAS unsigned*)(w.lds + MISC_OFF + 448); LAS unsigned* bc_ = qh_ + 1; \
              if (w.tid == 0) { *qh_ = 0u; *bc_ = 0u; } \
              __syncthreads(); \
              if (w.wave < 4) { unsigned ep_ = 0u; for (int tk = 2 * w.vcu; tk < 32 * NCH; tk += 2 * w.G) { scan_rwkv_task1(A, w, tk, bc_, ep_); scan_rwkv_task1(A, w, tk + 1, bc_, ep_); } } \
              LAS unsigned char* vl = w.lds + 57344 + w.wave * 9216; \
              for (;;) { \
                  int idx_ = 0; if (w.lane == 0) idx_ = (int)__hip_atomic_fetch_add((unsigned*)qh_, 1u, __ATOMIC_RELAXED, __HIP_MEMORY_SCOPE_WORKGROUP); \
                  idx_ = __builtin_amdgcn_readfirstlane(idx_); \
                  if (idx_ >= 48) break; \
                  const int kind_ = idx_ >> 3, gwv_ = w.vcu * NWAVES + (idx_ & 7); \
                  if (kind_ == 0) dsa_scores_mfma(A, w.lane, gwv_, w.NGW); \
                  else if (kind_ <= 2) { for (int it = gwv_ + (kind_ - 1) * w.NGW; it < 32 * 128; it += 2 * w.NGW) ret_tile_mfma(A, (kind_ == 2) ? (it ^ 7) : it, w.lane, vl); } \
                  else if (kind_ <= 4) { for (int it = gwv_ + (kind_ - 3) * w.NGW; it < 32 * 128; it += 2 * w.NGW) sb_tile_mfma(A, it, w.lane, vl); } \
                  else if ((idx_ & 7) < 2) { for (int it = w.vcu + w.G * (idx_ & 7); it < 32 * NCH; it += 2 * w.G) ret_state_mfma(A, it, w.lane, vl); } \
              } } \
            if (BOTH(pb + 3)) GRID_BAR(); TP_END(4) \
        } \
        KON(5) if (IN(pb + 4)) { ARef A = *kargs(); MAKE_WI(); TP_BEGIN(5) \
            if (w.bx < 32) prefix_chain(A, w, w.bx); \
            REP(6) { int sk_ = rep_ ? ((PROBE_REP >> 24) & 7) : 0; asm volatile("" : "+s"(sk_)); dsa_wave(A, w, w.lds + w.wave * 13312, l + 2 * rep_, l, sk_); } \
            REP(14) { if (rep_ && w.bx < 32) prefix_chain(A, w, w.bx); } \
            if (BOTH(pb + 4)) GRID_BAR(); TP_END(5) \
        } \
        KON(6) if (IN(pb + 5)) { ARef A = *kargs(); MAKE_WI(); TP_BEGIN(6) \
            REP(7) ph_post16(A, w, l); \
            if (BOTH(pb + 5)) GRID_BAR(); TP_END(6) \
        } \
        KON(7) if (IN(pb + 6)) { ARef A = *kargs(); MAKE_WI(); TP_BEGIN(7) \
            pg8::Gemm g{(const bf16*)(A.ws + WS_MIX), (const bf16*)(A.ws + WS_WOUT) + (size_t)l * DM * DM, MTOK, DM, DM}; pg8::StaticOrder S; S.init(MTOK, DM, w.G, w.bx); \
            pg8::EpiRes<(l != 0)> E{l == 0 ? (const void*)A.in[I_X] : (const void*)(A.ws + WS_XA), (bf16*)(A.ws + WS_XA), (const float*)(A.ws + WS_MOD) + (size_t)l * 8 * 6144 + 2 * 1024}; \
            REP(16) { pg8::EpiRes<(l != 0)> E2 = E; if (rep_ && l == 1) E2.gate = (const float*)(A.ws + WS_CTL + 512 * 1024); pg8::gemm_phase<pg8::EpiRes<(l != 0)>, pg8::StaticOrder, true, true>(ring, g, S, E2, w.tid); } \
            if (BOTH(pb + 6)) GRID_BAR(); TP_END(7) \
        } \
        KON(8) if (IN(pb + 7)) { ARef A = *kargs(); MAKE_WI(); TP_BEGIN(8) \
            { LAS unsigned* hist = (LAS unsigned*)(w.lds + HIST_OFF); LAS int* texp = (LAS int*)(w.lds + TEXP_OFF); if (w.tid < 32) hist[w.tid] = 0u; router_stage16(A, w, l); \
            REP(10) { for (int g16 = w.gw; g16 < MTOK / 16; g16 += w.NGW) router16(A, l, 16 * g16, w.lane, hist, (const LAS unsigned char*)w.lds, texp + w.wave * 64, rep_ != 0); } \
            router_lists(A, w, l); } \
            if (BOTH(pb + 7)) GRID_BAR(); TP_END(8) \
        } \
        KON(10) if (IN(pb + 8)) { ARef A = *kargs(); MAKE_WI(); TP_BEGIN(10) \
            build_expert_table(A, w, l); \
            pg8::Gemm g{(const bf16*)(A.ws + WS_H), (const bf16*)(A.ws + WS_W1) + (size_t)l * NEXP * 2048 * DM, MOE_ROWS, NEXP * 2048, DM}; \
            pg8::MoeOrder S{(const PG8_LAS int*)(w.lds + TAB_OFF), 8, w.G, w.vcu, (const PG8_LAS int*)(w.lds + TST_OFF), (const PG8_LAS int*)(w.lds + CNT_OFF), (const int*)(A.ws + WS_LIST)}; \
            pg8::EpiSwiglu E{(bf16*)(A.ws + WS_ACT), A.in[I_MB1] + (size_t)l * NEXP * 2048}; \
            REP(8) { if (PROBE_REP & (1 << 20)) { if (rep_) pg8::gemm_phase<pg8::EpiNull, pg8::MoeOrder, true, true, true>(ring, g, S, pg8::EpiNull{}, w.tid); else pg8::gemm_phase<pg8::EpiSwiglu, pg8::MoeOrder, true, true, true>(ring, g, S, E, w.tid); } else pg8::gemm_phase<pg8::EpiSwiglu, pg8::MoeOrder, true, true, true>(ring, g, S, E, w.tid); } \
            if (BOTH(pb + 8)) GRID_BAR(); TP_END(10) \
        } \
        KON(11) if (IN(pb + 9)) { ARef A = *kargs(); MAKE_WI(); TP_BEGIN(11) \
            build_expert_table(A, w, l); \
            pg8::Gemm g{(const bf16*)(A.ws + WS_ACT), (const bf16*)(A.ws + WS_W2) + (size_t)l * NEXP * DM * DM, MOE_ROWS, NEXP * DM, DM}; \
            pg8::MoeOrder S{(const PG8_LAS int*)(w.lds + TAB_OFF), 4, w.G, w.vcu, (const PG8_LAS int*)(w.lds + TST_OFF), (const PG8_LAS int*)(w.lds + CNT_OFF), (const int*)(A.ws + WS_LIST)}; \
            pg8::EpiY E{(bf16*)(A.ws + WS_XS), A.in[I_MB2] + (size_t)l * NEXP * DM}; \
            REP(9) pg8::gemm_phase<pg8::EpiY, pg8::MoeOrder, true, true>(ring, g, S, E, w.tid); \
            TP_PUBLISH(l) \
            if (BOTH(pb + 9)) GRID_BAR(); TP_END(11) \
        } \
        KON(12) if (IN(pb + 10)) { ARef A = *kargs(); MAKE_WI(); TP_BEGIN(12) \
            build_expert_table(A, w, l); \
            REP(12) for (int m = w.gw; m < MTOK; m += w.NGW) combine_row(A, l, m, w.lane, (const LAS int*)(w.lds + TST_OFF), (rep_ && l == 0) ? 0.0f : 1.0f, TP_SCALE); \
            if (BOTH(pb + 10)) GRID_BAR(); TP_END(12) \
        } \
    } while (0)
    LAYER_BODY(0);
    LAYER_BODY(1);
#undef LAYER_BODY
#undef IN
#undef ring
#undef MAKE_WI
#undef TID_NOW
#undef GRID_BAR
#undef KON
#undef BOTH
}


#if MK_N_LAUNCHES != 1
template <int K> static void launch_one(int grid, hipStream_t stream, const ArgsH& a) {
    static bool attr = false;
    if (!attr) { (void)hipFuncSetAttribute((const void*)fwd<K>, hipFuncAttributeMaxDynamicSharedMemorySize, LDS_BYTES); attr = true; }
    hipLaunchKernelGGL(fwd<K>, dim3(grid), dim3(NWAVES * 64), LDS_BYTES, stream, a);
}
static void launch_kind(int kind, int grid, hipStream_t stream, const ArgsH& a) {
    switch (kind) {
        case 0: launch_one<0>(grid, stream, a); break; case 1: launch_one<1>(grid, stream, a); break; case 2: launch_one<2>(grid, stream, a); break;
        case 3: launch_one<3>(grid, stream, a); break; case 4: launch_one<4>(grid, stream, a); break; case 5: launch_one<5>(grid, stream, a); break;
        case 6: launch_one<6>(grid, stream, a); break; case 7: launch_one<7>(grid, stream, a); break; case 8: launch_one<8>(grid, stream, a); break;
        case 9: launch_one<9>(grid, stream, a); break; case 10: launch_one<10>(grid, stream, a); break; case 11: launch_one<11>(grid, stream, a); break;
        default: launch_one<12>(grid, stream, a); break;
    }
}
#endif
extern "C" void kernel_launch(void* const* d_in, const int* in_sizes, int n_in, void* d_out, int out_size, void* d_ws, size_t ws_size, hipStream_t stream) {
    static int grid = 0;
    if (grid == 0) {
        if (n_in != N_IN || out_size != MTOK * DM || ws_size < WS_END) { fprintf(stderr, "kernel_launch: unexpected shapes (n_in %d, out %d, ws %zu)\n", n_in, out_size, ws_size); grid = -1; return; }
        int dev = 0, cus = 0;
        if (hipGetDevice(&dev) != hipSuccess || hipDeviceGetAttribute(&cus, hipDeviceAttributeMultiprocessorCount, dev) != hipSuccess) { grid = -1; return; }
#if MK_N_LAUNCHES == 1
        {
            if (hipFuncSetAttribute((const void*)fwd<-1>, hipFuncAttributeMaxDynamicSharedMemorySize, LDS_BYTES) != hipSuccess) { fprintf(stderr, "kernel_launch: hipFuncSetAttribute failed\n"); grid = -1; return; }
            int per_cu = 0;
            if (hipOccupancyMaxActiveBlocksPerMultiprocessor(&per_cu, (const void*)fwd<-1>, NWAVES * 64, LDS_BYTES) != hipSuccess || per_cu < 1) fprintf(stderr, "kernel_launch: occupancy query says %d\n", per_cu);
            (void)hipGetLastError();
        }
#endif
        grid = cus;
    }
    if (grid < 0) return;
    (void)in_sizes;
    if (hipMemsetAsync((char*)d_ws + WS_CTL, 0, CTL_ZERO_BYTES, stream) != hipSuccess) return;
    ArgsH a{};
    for (int i = 0; i < N_IN; ++i) a.in[i] = (const float*)d_in[i];
    a.out = (float*)d_out; a.ws = (unsigned char*)d_ws;
    for (int f = 0; f < 44; ++f) a.invf[f] = (f < 32) ? pow(10000.0, -(double)f / 32.0) : (f < 40) ? pow(500000.0, -(double)(f - 32) / 8.0) : pow(500000.0, -(double)(f - 40) / 4.0);
#if MK_N_LAUNCHES == 1
    a.ph_lo = 0; a.ph_hi = NPHASE; a.li = 0;
    hipLaunchKernelGGL(fwd<-1>, dim3(grid), dim3(NWAVES * 64), LDS_BYTES, stream, a);
#else
    {
        for (int p = 0; p < NPHASE; ++p) {
            if (p == 1 + NPL) continue;
            a.ph_lo = p; a.ph_hi = p + 1; a.li = p;
            static const int kinds_[NPL] = {1, 2, 3, 4, 5, 6, 7, 8, 10, 11, 12};
            const int kind = (p == 0) ? 0 : kinds_[(p - 1) % NPL];
            launch_kind(kind, grid, stream, a);
        }
    }
#endif
}
```
